# Optimizing an MI355X kernel written in HIP

```python
import math
import jax, jax.numpy as jnp
from jax import lax
import numpy as np

D_MODEL = 2048
BATCH = 8
SEQ = 2048
DEPTH = 1

MEM_LEN = 256
HEAD_DIM = 128
NSA_HEADS = 8
NSA_KV_HEADS = 2
NSA_GROUP = NSA_HEADS // NSA_KV_HEADS
NSA_WIDTH = NSA_HEADS * HEAD_DIM
NSA_KV_WIDTH = NSA_KV_HEADS * HEAD_DIM
CMP_LEN = 32
CMP_STRIDE = 16
CMP_HIDDEN = 2 * HEAD_DIM
SLC_LEN = 64
SLC_TOPK = 16
WINDOW = 512
SLC_QBLK = 32
WIN_QBLK = 128
POOL_WINDOWS = (2, 4, 8, 16)
POOL_GROUPS = 4
POOL_CH = 128
POOL_WIDTH = POOL_GROUPS * POOL_CH
MEM_HEADS = 4
MEM_HEAD_DIM = 128
MEM_WIDTH = MEM_HEADS * MEM_HEAD_DIM
MIX_WIDTH = NSA_WIDTH + POOL_WIDTH + MEM_WIDTH
IN_SPLITS = (NSA_WIDTH,
             NSA_KV_WIDTH, NSA_KV_WIDTH,
             NSA_KV_WIDTH, NSA_KV_WIDTH,
             NSA_KV_WIDTH, NSA_KV_WIDTH,
             3 * NSA_HEADS,
             POOL_WIDTH,
             MEM_WIDTH)
IN_WIDTH = sum(IN_SPLITS)
N_EXPERTS = 32
TOP_K = 4
D_EXPERT = 2048
SWIGLU_ALPHA = 1.702
SWIGLU_LIMIT = 7.0
MOE_BLK = 128
LN_EPS = 1e-5
DN_ALPHA = (2 * DEPTH) ** 0.25
DN_BETA = (8 * DEPTH) ** -0.25
NEG_INF = -1e30
BIG = 1e9

kernel_name = "hybrid_nsa_pool_mem_moe_deepnorm"


def _layer_norm(x, g, b):
    xf = x.astype(jnp.float32)
    mu = jnp.mean(xf, -1, keepdims=True)
    var = jnp.mean(jnp.square(xf - mu), -1, keepdims=True)
    return ((xf - mu) * lax.rsqrt(var + LN_EPS) * g + b).astype(x.dtype)


def _rms_norm(x, g):
    xf = x.astype(jnp.float32)
    y = xf * lax.rsqrt(jnp.mean(jnp.square(xf), -1, keepdims=True) + LN_EPS)
    return (y * g).astype(x.dtype)


def _masked_softmax(s, mask):
    s = jnp.where(mask, s.astype(jnp.float32), NEG_INF)
    return jax.nn.softmax(s, axis=-1) * mask


def _compress(kv, pos, w1, w2):
    B, S = kv.shape[:2]
    n_c = (S - CMP_LEN) // CMP_STRIDE + 1
    idx = jnp.arange(n_c)[:, None] * CMP_STRIDE + jnp.arange(CMP_LEN)[None, :]
    blk = kv[:, idx] + pos[None, None, :, None, :]
    blk = jnp.moveaxis(blk, 3, 2).reshape(B, n_c, NSA_KV_HEADS, CMP_LEN * HEAD_DIM)
    return jax.nn.gelu(blk @ w1) @ w2


def _nsa(q, k_c, v_c, k_s, v_s, k_w, v_w, gates,
         cmp_pos_k, cmp_w1_k, cmp_w2_k, cmp_pos_v, cmp_w1_v, cmp_w2_v):
    B, S = q.shape[:2]
    KVH, G, dh = NSA_KV_HEADS, NSA_GROUP, HEAD_DIM
    scale = dh ** -0.5
    q = q.reshape(B, S, KVH, G, dh)
    k_c, v_c, k_s, v_s, k_w, v_w = [a.reshape(B, S, KVH, dh) for a in (k_c, v_c, k_s, v_s, k_w, v_w)]
    t = jnp.arange(S)

    n_c = (S - CMP_LEN) // CMP_STRIDE + 1
    kc = _compress(k_c, cmp_pos_k, cmp_w1_k, cmp_w2_k)
    vc = _compress(v_c, cmp_pos_v, cmp_w1_v, cmp_w2_v)
    c_start = jnp.arange(n_c) * CMP_STRIDE
    mask_c = ((c_start + CMP_LEN - 1)[None, :] <= t[:, None])[None, :, None, None, :]
    s_c = jnp.einsum('bshgd,bchd->bshgc', q, kc) * scale
    p_c = _masked_softmax(s_c, mask_c)
    o_cmp = jnp.einsum('bshgc,bchd->bshgd', p_c.astype(vc.dtype), vc)

    n_s = S // SLC_LEN
    s_start = jnp.arange(n_s) * SLC_LEN
    overlap = jnp.clip(jnp.minimum((c_start + CMP_LEN)[:, None], (s_start + SLC_LEN)[None, :])
                       - jnp.maximum(c_start[:, None], s_start[None, :]), 0)
    overlap = (overlap // CMP_STRIDE).astype(jnp.float32)
    imp = jnp.einsum('bshc,cj->bshj', jnp.sum(p_c, axis=3), overlap)
    cur = t // SLC_LEN
    j = jnp.arange(n_s)
    valid = j[None, :] <= cur[:, None]
    forced = (j[None, :] == 0) | (j[None, :] == cur[:, None]) | (j[None, :] == cur[:, None] - 1)
    imp = jnp.where(forced[None, :, None, :], BIG,
                    jnp.where(valid[None, :, None, :], imp, -BIG))
    k_sel = min(SLC_TOPK, n_s)
    sel = lax.top_k(imp, k_sel)[1]

    k_blocks = k_s.reshape(B, n_s, SLC_LEN, KVH, dh).transpose(0, 3, 1, 2, 4)
    v_blocks = v_s.reshape(B, n_s, SLC_LEN, KVH, dh).transpose(0, 3, 1, 2, 4)
    nq = S // SLC_QBLK
    bi = jnp.arange(B)[:, None, None, None]
    hi = jnp.arange(KVH)[None, None, :, None]

    def slc_block(args):
        qb, selb, tb = args
        kb = k_blocks[bi, hi, selb]
        vb = v_blocks[bi, hi, selb]
        kpos = selb[..., None] * SLC_LEN + jnp.arange(SLC_LEN)
        mask = (kpos <= tb[None, :, None, None, None]).reshape(B, SLC_QBLK, KVH, 1, k_sel * SLC_LEN)
        s = jnp.einsum('bqhgd,bqhkld->bqhgkl', qb, kb) * scale
        p = _masked_softmax(s.reshape(B, SLC_QBLK, KVH, G, k_sel * SLC_LEN), mask)
        return jnp.einsum('bqhgn,bqhnd->bqhgd', p.astype(vb.dtype),
                          vb.reshape(B, SLC_QBLK, KVH, k_sel * SLC_LEN, dh))

    q_blk = q.reshape(B, nq, SLC_QBLK, KVH, G, dh).swapaxes(0, 1)
    sel_blk = sel.reshape(B, nq, SLC_QBLK, KVH, k_sel).swapaxes(0, 1)
    o_slc = lax.map(slc_block, (q_blk, sel_blk, t.reshape(nq, SLC_QBLK)))
    o_slc = o_slc.swapaxes(0, 1).reshape(B, S, KVH, G, dh)

    nb = S // WIN_QBLK
    span = WIN_QBLK + WINDOW
    kw_pad = jnp.pad(k_w, ((0, 0), (WINDOW, 0), (0, 0), (0, 0)))
    vw_pad = jnp.pad(v_w, ((0, 0), (WINDOW, 0), (0, 0), (0, 0)))

    def win_block(args):
        i, qb = args
        start = i * WIN_QBLK
        kb = lax.dynamic_slice_in_dim(kw_pad, start, span, axis=1)
        vb = lax.dynamic_slice_in_dim(vw_pad, start, span, axis=1)
        kpos = start - WINDOW + jnp.arange(span)
        tq = start + jnp.arange(WIN_QBLK)
        mask = ((kpos[None, :] <= tq[:, None]) & (kpos[None, :] > tq[:, None] - WINDOW)
                & (kpos[None, :] >= 0))[None, :, None, None, :]
        s = jnp.einsum('bqhgd,bkhd->bqhgk', qb, kb) * scale
        p = _masked_softmax(s, mask)
        return jnp.einsum('bqhgk,bkhd->bqhgd', p.astype(vb.dtype), vb)

    qw = q.reshape(B, nb, WIN_QBLK, KVH, G, dh).swapaxes(0, 1)
    o_win = lax.map(win_block, (jnp.arange(nb), qw)).swapaxes(0, 1).reshape(B, S, KVH, G, dh)

    g = jax.nn.sigmoid(gates.astype(jnp.float32)).reshape(B, S, KVH, G, 3).astype(q.dtype)
    o = g[..., 0:1] * o_cmp + g[..., 1:2] * o_slc + g[..., 2:3] * o_win
    return o.reshape(B, S, NSA_WIDTH)


def _pool_mixer(u, pool_w, pool_scale):
    B, S = u.shape[:2]
    uf = u.astype(jnp.float32).reshape(B, S, POOL_GROUPS, POOL_CH)
    cs = jnp.pad(jnp.cumsum(uf, axis=1), ((0, 0), (1, 0), (0, 0), (0, 0)))
    win = jnp.array(POOL_WINDOWS, dtype=jnp.int32)
    t = jnp.arange(S)
    lo = jnp.maximum(t[:, None] + 1 - win[None, :], 0)
    cnt = (t[:, None] + 1 - lo).astype(jnp.float32)
    gidx = jnp.arange(POOL_GROUPS)[None, :]
    mean = (cs[:, 1:] - cs[:, lo, gidx]) / cnt[None, :, :, None]
    pooled = (mean - uf).astype(u.dtype)
    y = jnp.einsum('bsgc,gcd->bsgd', pooled, pool_w) * pool_scale.reshape(POOL_GROUPS, POOL_CH)
    return y.reshape(B, S, POOL_WIDTH)


def _mem_attn(qm, mem, w_mem_kv):
    B, S = qm.shape[:2]
    M = mem.shape[1]
    km, vm = jnp.split(mem @ w_mem_kv, 2, axis=-1)
    qm = qm.reshape(B, S, MEM_HEADS, MEM_HEAD_DIM)
    km = km.reshape(B, M, MEM_HEADS, MEM_HEAD_DIM)
    vm = vm.reshape(B, M, MEM_HEADS, MEM_HEAD_DIM)
    s = jnp.einsum('bshd,bmhd->bhsm', qm, km) * (MEM_HEAD_DIM ** -0.5)
    p = jax.nn.softmax(s.astype(jnp.float32), axis=-1).astype(vm.dtype)
    return jnp.einsum('bhsm,bmhd->bshd', p, vm).reshape(B, S, MEM_WIDTH)


def _moe(h, w_router, b_router, w_gu, b_gu, w_dn, b_dn):
    B, S, D = h.shape
    T = B * S
    hf = h.reshape(T, D)
    logits = (hf @ w_router + b_router).astype(jnp.float32)
    top_val, top_idx = lax.top_k(logits, TOP_K)
    gate = jax.nn.softmax(top_val, axis=-1)
    A = T * TOP_K
    flat_e = top_idx.reshape(A)
    flat_tok = jnp.repeat(jnp.arange(T, dtype=jnp.int32), TOP_K)
    flat_g = gate.reshape(A)
    order = jnp.argsort(flat_e)
    se = flat_e[order]
    counts = jnp.bincount(flat_e, length=N_EXPERTS)
    starts = jnp.cumsum(counts) - counts
    pcounts = (counts + MOE_BLK - 1) // MOE_BLK * MOE_BLK
    pends = jnp.cumsum(pcounts)
    pstarts = pends - pcounts
    dest = pstarts[se] + (jnp.arange(A) - starts[se])
    n_pad = A + N_EXPERTS * MOE_BLK
    nblk = n_pad // MOE_BLK
    tok_buf = jnp.zeros((n_pad,), jnp.int32).at[dest].set(flat_tok[order])
    g_buf = jnp.zeros((n_pad,), jnp.float32).at[dest].set(flat_g[order])
    blk_e = jnp.minimum(jnp.searchsorted(pends, jnp.arange(nblk) * MOE_BLK, side='right'),
                        N_EXPERTS - 1)

    def expert_block(args):
        tok, g, e = args
        xb = hf[tok]
        gu = xb @ w_gu[e] + b_gu[e]
        x_glu = jnp.minimum(gu[:, ::2], SWIGLU_LIMIT)
        x_lin = jnp.clip(gu[:, 1::2], -SWIGLU_LIMIT, SWIGLU_LIMIT)
        act = x_glu * jax.nn.sigmoid(SWIGLU_ALPHA * x_glu) * (x_lin + 1)
        y = act @ w_dn[e] + b_dn[e]
        return y * g[:, None].astype(y.dtype)

    ys = lax.map(expert_block, (tok_buf.reshape(nblk, MOE_BLK), g_buf.reshape(nblk, MOE_BLK), blk_e))
    out = jnp.zeros((T, D), h.dtype).at[tok_buf].add(ys.reshape(n_pad, D))
    return out.reshape(B, S, D)


def _hybrid_layer(x, mem, w_in, cmp_pos_k, cmp_w1_k, cmp_w2_k, cmp_pos_v, cmp_w1_v, cmp_w2_v,
                  pool_w, pool_scale, w_mem_kv, gn_nsa, gn_pool, gn_mem, w_out, ln1_g, ln1_b,
                  w_router, b_router, w_gu, b_gu, w_dn, b_dn, ln2_g, ln2_b):
    proj = x @ w_in
    offs = [int(o) for o in np.cumsum(IN_SPLITS)[:-1]]
    q, k_c, v_c, k_s, v_s, k_w, v_w, gates, u_pool, q_mem = jnp.split(proj, offs, axis=-1)
    o_nsa = _nsa(q, k_c, v_c, k_s, v_s, k_w, v_w, gates,
                 cmp_pos_k, cmp_w1_k, cmp_w2_k, cmp_pos_v, cmp_w1_v, cmp_w2_v)
    o_pool = _pool_mixer(u_pool, pool_w, pool_scale)
    o_mem = _mem_attn(q_mem, mem, w_mem_kv)
    mixed = jnp.concatenate([_rms_norm(o_nsa, gn_nsa), _rms_norm(o_pool, gn_pool),
                             _rms_norm(o_mem, gn_mem)], axis=-1) @ w_out
    h = _layer_norm(DN_ALPHA * x + mixed, ln1_g, ln1_b)
    ffn = _moe(h, w_router, b_router, w_gu, b_gu, w_dn, b_dn)
    return _layer_norm(DN_ALPHA * h + ffn, ln2_g, ln2_b)


def setup_inputs(seed: int = 0) -> dict:
    key = jax.random.key(seed)
    ks = iter(jax.random.split(key, 32))
    L = DEPTH

    def nrm(shape, scale):
        return jax.random.normal(next(ks), shape, jnp.float32) * scale

    v_cols = (2, 4, 6)
    col_scale = jnp.concatenate([jnp.full((n,), DN_BETA if i in v_cols else 1.0, jnp.float32)
                                 for i, n in enumerate(IN_SPLITS)])
    mem_scale = jnp.concatenate([jnp.ones((MEM_WIDTH,), jnp.float32),
                                 jnp.full((MEM_WIDTH,), DN_BETA, jnp.float32)])
    cin = CMP_LEN * HEAD_DIM
    return {
        "x": nrm((BATCH, SEQ, D_MODEL), 1.0),
        "mem": nrm((BATCH, MEM_LEN, D_MODEL), 1.0),
        "w_in": nrm((L, D_MODEL, IN_WIDTH), D_MODEL ** -0.5) * col_scale,
        "cmp_pos_k": nrm((L, CMP_LEN, HEAD_DIM), 0.1),
        "cmp_w1_k": nrm((L, cin, CMP_HIDDEN), cin ** -0.5),
        "cmp_w2_k": nrm((L, CMP_HIDDEN, HEAD_DIM), CMP_HIDDEN ** -0.5),
        "cmp_pos_v": nrm((L, CMP_LEN, HEAD_DIM), 0.1),
        "cmp_w1_v": nrm((L, cin, CMP_HIDDEN), cin ** -0.5),
        "cmp_w2_v": nrm((L, CMP_HIDDEN, HEAD_DIM), CMP_HIDDEN ** -0.5),
        "pool_w": nrm((L, POOL_GROUPS, POOL_CH, POOL_CH), POOL_CH ** -0.5),
        "pool_scale": 1.0 + nrm((L, POOL_WIDTH), 0.1),
        "w_mem_kv": nrm((L, D_MODEL, 2 * MEM_WIDTH), D_MODEL ** -0.5) * mem_scale,
        "gn_nsa": 1.0 + nrm((L, NSA_WIDTH), 0.05),
        "gn_pool": 1.0 + nrm((L, POOL_WIDTH), 0.05),
        "gn_mem": 1.0 + nrm((L, MEM_WIDTH), 0.05),
        "w_out": nrm((L, MIX_WIDTH, D_MODEL), MIX_WIDTH ** -0.5) * DN_BETA,
        "ln1_g": 1.0 + nrm((L, D_MODEL), 0.05),
        "ln1_b": nrm((L, D_MODEL), 0.02),
        "w_router": nrm((L, D_MODEL, N_EXPERTS), D_MODEL ** -0.5),
        "b_router": nrm((L, N_EXPERTS), 0.01),
        "w_gu": nrm((L, N_EXPERTS, D_MODEL, 2 * D_EXPERT), D_MODEL ** -0.5) * DN_BETA,
        "b_gu": nrm((L, N_EXPERTS, 2 * D_EXPERT), 0.01),
        "w_dn": nrm((L, N_EXPERTS, D_EXPERT, D_MODEL), D_EXPERT ** -0.5) * DN_BETA,
        "b_dn": nrm((L, N_EXPERTS, D_MODEL), 0.01),
        "ln2_g": 1.0 + nrm((L, D_MODEL), 0.05),
        "ln2_b": nrm((L, D_MODEL), 0.02),
    }


def reference(x, mem, w_in, cmp_pos_k, cmp_w1_k, cmp_w2_k, cmp_pos_v, cmp_w1_v, cmp_w2_v,
              pool_w, pool_scale, w_mem_kv, gn_nsa, gn_pool, gn_mem, w_out, ln1_g, ln1_b,
              w_router, b_router, w_gu, b_gu, w_dn, b_dn, ln2_g, ln2_b):
    for l in range(DEPTH):
        x = _hybrid_layer(x, mem, w_in[l], cmp_pos_k[l], cmp_w1_k[l], cmp_w2_k[l],
                          cmp_pos_v[l], cmp_w1_v[l], cmp_w2_v[l], pool_w[l], pool_scale[l],
                          w_mem_kv[l], gn_nsa[l], gn_pool[l], gn_mem[l], w_out[l],
                          ln1_g[l], ln1_b[l], w_router[l], b_router[l], w_gu[l], b_gu[l],
                          w_dn[l], b_dn[l], ln2_g[l], ln2_b[l])
    return x
```

```cpp
#include <hip/hip_runtime.h>
#include <cstdio>
#include <cstdint>

#ifndef N_LAUNCH_MODE
#define N_LAUNCH_MODE 0
#endif

constexpr int B_ = 8, S_ = 2048, D_ = 2048, T_ = B_ * S_;
constexpr int INW = 3608;
constexpr int C_Q = 0, C_KC = 1024, C_VC = 1280, C_KS = 1536, C_VS = 1792, C_KW = 2048, C_VW = 2304, C_G = 2560, C_UP = 2584, C_QM = 3096;
constexpr int NC = 127;
constexpr int CROWS = B_ * NC * 2;
constexpr int NE = 32, DE = 2048, NA = T_ * 4;
constexpr float LN_EPS = 1e-5f;
constexpr float DN_ALPHA = 1.189207115002721f;
constexpr float ATT_SCALE = 0.08838834764831845f;

constexpr size_t al256(size_t x) { return (x + 255) & ~(size_t)255; }
constexpr size_t WS_CTL = 0;
constexpr size_t CTL_BYTES = 65536;
constexpr size_t CTL_CNT = 16384;
constexpr size_t WS_PROJ = CTL_BYTES;
constexpr size_t WS_KVMEM = WS_PROJ + al256((size_t)T_ * INW * 4);
constexpr size_t WS_BIAS1 = WS_KVMEM + al256((size_t)2048 * 1024 * 4);
constexpr size_t WS_HID = WS_BIAS1 + al256(2 * 256 * 4);
constexpr size_t WS_KC = WS_HID + al256((size_t)2 * 2048 * 256 * 4);
constexpr size_t WS_VC = WS_KC + al256((size_t)CROWS * 128 * 4);
constexpr size_t WS_POOLED = WS_VC + al256((size_t)CROWS * 128 * 4);
constexpr size_t WS_OPOOL = WS_POOLED + al256((size_t)T_ * 512 * 4);
constexpr size_t WS_OWIN = WS_OPOOL + al256((size_t)T_ * 512 * 4);
constexpr size_t WS_OCMP = WS_OWIN + al256((size_t)T_ * 1024 * 4);
constexpr size_t WS_OSLC = WS_OCMP + al256((size_t)T_ * 1024 * 4);
constexpr size_t WS_SEL = WS_OSLC + al256((size_t)T_ * 1024 * 4);
constexpr size_t WS_OMEM = WS_SEL + al256((size_t)T_ * 2 * 4);
constexpr size_t WS_CAT = WS_OMEM + al256((size_t)T_ * 512 * 4);
constexpr size_t WS_HPRE = WS_CAT + al256((size_t)T_ * 2048 * 4);
constexpr size_t WS_H = WS_HPRE + al256((size_t)T_ * 2048 * 4);
constexpr size_t WS_GATE = WS_H + al256((size_t)T_ * 2048 * 4);
constexpr size_t WS_LIST = WS_GATE + al256((size_t)NA * 4);
constexpr size_t WS_ACT = WS_LIST + al256((size_t)NE * T_ * 4);
constexpr size_t WS_Y = WS_ACT + al256((size_t)NA * 2048 * 4);
constexpr size_t WS_END = WS_Y + al256((size_t)NA * 2048 * 4);

constexpr int LDS_BYTES = 155648;

struct Params {
    const float* in[26];
    float* out;
    unsigned char* ws;
    long long lo_hi;
};
enum { I_X = 0, I_MEM, I_WIN, I_POSK, I_W1K, I_W2K, I_POSV, I_W1V, I_W2V, I_POOLW, I_POOLS, I_WMEMKV, I_GNNSA, I_GNPOOL, I_GNMEM, I_WOUT,
       I_LN1G, I_LN1B, I_WR, I_BR, I_WGU, I_BGU, I_WDN, I_BDN, I_LN2G, I_LN2B };

#define XB_TMO      128
#define XB_XCNT(j)  (256  + 64 * (j))
#define XB_XSUB(j)  (1280 + 64 * (j))
#define XB_XGEN(j)  (2304 + 64 * (j))
#define XB_TOP      3328
#define XB_TOPGEN   3392
#define XCD_BAR_WORDS 3456
#define XB_SPIN_CAP (1u << 25)
#define LAS __attribute__((address_space(3)))

__device__ __forceinline__ unsigned xb_ld(unsigned* p)              { return __hip_atomic_load(p, __ATOMIC_RELAXED, __HIP_MEMORY_SCOPE_AGENT); }
__device__ __forceinline__ unsigned xb_add(unsigned* p, unsigned v) { return __hip_atomic_fetch_add(p, v, __ATOMIC_RELAXED, __HIP_MEMORY_SCOPE_AGENT); }
__device__ __forceinline__ unsigned xb_xcc_id() { return (unsigned)__builtin_amdgcn_s_getreg((3 << 11) | 20) & 0xFu; }
#define XB_SPIN(cond, bar) do { unsigned _sp = 0; while (cond) { __builtin_amdgcn_s_sleep(1); \
    if ((++_sp & 255u) == 0u) { if (xb_ld(&(bar)[XB_TMO])) break; if (_sp > XB_SPIN_CAP) { atomicAdd(&(bar)[XB_TMO], 1u); break; } } } } while (0)

struct XcdBarrier { unsigned* bar; unsigned x; volatile LAS unsigned* st; };

__device__ __forceinline__ XcdBarrier xcd_barrier_post(unsigned* bar, volatile LAS unsigned* st) {
    XcdBarrier b; b.bar = bar; b.x = xb_xcc_id(); b.st = st;
    if (threadIdx.x == 0) (void)xb_add(&bar[XB_XCNT(b.x)], 1u);
    return b;
}
__device__ __forceinline__ void xcd_barrier_complete(unsigned* bar, unsigned x, unsigned& nloc, unsigned& nx) {
    const unsigned G = gridDim.x * gridDim.y * gridDim.z;
    unsigned sum, cnt, mine, sp = 0u;
    for (;;) {
        sum = 0u; cnt = 0u; mine = 0u;
#pragma unroll
        for (unsigned j = 0; j < 16; ++j) { const unsigned c = xb_ld(&bar[XB_XCNT(j)]); sum += c; cnt += (c > 0u) ? 1u : 0u; mine = (j == x) ? c : mine; }
        if (sum == G) break;
        __builtin_amdgcn_s_sleep(1);
        if ((++sp & 255u) == 0u) { if (xb_ld(&bar[XB_TMO])) break; if (sp > XB_SPIN_CAP) { atomicAdd(&bar[XB_TMO], 1u); break; } }
    }
    nloc = mine > 0u ? mine : 1u; nx = cnt > 0u ? cnt : 1u;
}
__device__ __forceinline__ void xcd_barrier(const XcdBarrier& b) {
    asm volatile("s_waitcnt vmcnt(0)" ::: "memory");
    __syncthreads();
    if (threadIdx.x == 0) {
        unsigned* bar = b.bar;
        __builtin_amdgcn_s_waitcnt(0);
        unsigned nloc = b.st[0], nx = b.st[1];
        if (nloc == 0u) { xcd_barrier_complete(bar, b.x, nloc, nx); b.st[0] = nloc; b.st[1] = nx; }
        const unsigned old = xb_add(&bar[XB_XSUB(b.x)], 1u);
        const unsigned gen = old / nloc;
        if (old + 1u == (gen + 1u) * nloc) {
            __builtin_amdgcn_fence(__ATOMIC_RELEASE, "agent");
            asm volatile("s_waitcnt vmcnt(0)" ::: "memory");
            const unsigned og = xb_add(&bar[XB_TOP], 1u);
            const unsigned tg = og / nx;
            if (og + 1u == (tg + 1u) * nx) xb_add(&bar[XB_TOPGEN], 1u);
            else XB_SPIN(xb_ld(&bar[XB_TOPGEN]) == tg, bar);
            __builtin_amdgcn_fence(__ATOMIC_ACQUIRE, "agent");
            xb_add(&bar[XB_XGEN(b.x)], 1u);
            asm volatile("s_waitcnt vmcnt(0)" ::: "memory");
        } else {
            XB_SPIN(xb_ld(&bar[XB_XGEN(b.x)]) == gen, bar);
            __builtin_amdgcn_fence(__ATOMIC_ACQUIRE, "agent");
            asm volatile("s_waitcnt vmcnt(0)" ::: "memory");
        }
    }
    __syncthreads();
}

typedef _Float16 h8 __attribute__((ext_vector_type(8)));
typedef _Float16 h4 __attribute__((ext_vector_type(4)));
typedef float f4 __attribute__((ext_vector_type(4)));

__device__ __forceinline__ float wave_sum(float v) {
#pragma unroll
    for (int o = 32; o > 0; o >>= 1) v += __shfl_xor(v, o);
    return v;
}
__device__ __forceinline__ float wave_max(float v) {
#pragma unroll
    for (int o = 32; o > 0; o >>= 1) v = fmaxf(v, __shfl_xor(v, o));
    return v;
}
__device__ __forceinline__ void wave_sync() {
    asm volatile("s_waitcnt lgkmcnt(0)" ::: "memory");
    __builtin_amdgcn_wave_barrier();
}
__device__ __forceinline__ float gelu_tanh(float x) {
    const float u = 0.7978845608028654f * (x + 0.044715f * x * x * x);
    return 0.5f * x * (1.f + tanhf(u));
}
__device__ __forceinline__ float sigmoidf_(float x) { return 1.f / (1.f + expf(-x)); }

constexpr int G_LD = 40;
template <class AF, class EF>
__device__ __forceinline__ void gemm_tile(char* smem, int K, const AF& af, const float* __restrict__ Bm, int ldb, int n0, int Nlim, bool perm, const EF& ef) {
    _Float16* As = (_Float16*)smem;
    _Float16* Bs = As + 128 * G_LD;
    const int tid = threadIdx.x, lane = tid & 63, wid = tid >> 6, wr = wid >> 2, wc = wid & 3, fr = lane & 15, fq = lane >> 4;
    f4 acc[4][2];
#pragma unroll
    for (int m = 0; m < 4; ++m)
#pragma unroll
        for (int n = 0; n < 2; ++n) acc[m][n] = (f4){0.f, 0.f, 0.f, 0.f};
    const int ar = tid >> 3, ak = (tid & 7) * 4;
    const float* ap0 = af.row(ar);
    const float* ap1 = af.row(ar + 64);
    const int bk = tid >> 5, bn = (tid & 31) * 4;
    const bool bok = (n0 + bn) < Nlim;
    int bnp[4];
#pragma unroll
    for (int i = 0; i < 4; ++i) { const int c = bn + i; bnp[i] = perm ? ((c & ~31) | ((c & 1) << 4) | ((c & 31) >> 1)) : c; }
    for (int k0 = 0; k0 < K; k0 += 32) {
        const int ko = af.koff(k0 + ak);
        float4 a0 = make_float4(0.f, 0.f, 0.f, 0.f), a1 = a0, b0 = a0, b1 = a0;
        if (ap0) a0 = *(const float4*)(ap0 + ko);
        if (ap1) a1 = *(const float4*)(ap1 + ko);
        if (bok) { b0 = *(const float4*)(Bm + (size_t)(k0 + bk) * ldb + n0 + bn); b1 = *(const float4*)(Bm + (size_t)(k0 + bk + 16) * ldb + n0 + bn); }
        __syncthreads();
        *(h4*)&As[ar * G_LD + ak] = (h4){(_Float16)a0.x, (_Float16)a0.y, (_Float16)a0.z, (_Float16)a0.w};
        *(h4*)&As[(ar + 64) * G_LD + ak] = (h4){(_Float16)a1.x, (_Float16)a1.y, (_Float16)a1.z, (_Float16)a1.w};
        Bs[bnp[0] * G_LD + bk] = (_Float16)b0.x; Bs[bnp[1] * G_LD + bk] = (_Float16)b0.y; Bs[bnp[2] * G_LD + bk] = (_Float16)b0.z; Bs[bnp[3] * G_LD + bk] = (_Float16)b0.w;
        Bs[bnp[0] * G_LD + bk + 16] = (_Float16)b1.x; Bs[bnp[1] * G_LD + bk + 16] = (_Float16)b1.y; Bs[bnp[2] * G_LD + bk + 16] = (_Float16)b1.z; Bs[bnp[3] * G_LD + bk + 16] = (_Float16)b1.w;
        __syncthreads();
        h8 a[4], b[2];
#pragma unroll
        for (int m = 0; m < 4; ++m) a[m] = *(const h8*)&As[(wr * 64 + m * 16 + fr) * G_LD + fq * 8];
#pragma unroll
        for (int n = 0; n < 2; ++n) b[n] = *(const h8*)&Bs[(wc * 32 + n * 16 + fr) * G_LD + fq * 8];
#pragma unroll
        for (int m = 0; m < 4; ++m)
#pragma unroll
            for (int n = 0; n < 2; ++n) acc[m][n] = __builtin_amdgcn_mfma_f32_16x16x32_f16(a[m], b[n], acc[m][n], 0, 0, 0);
    }
    ef(acc, wr, wc, fr, fq);
    __syncthreads();
}

struct ARowPlain { const float* base; int ld; int m0; int mlim;
    __device__ __forceinline__ const float* row(int r) const { return (m0 + r) < mlim ? base + (size_t)(m0 + r) * ld : nullptr; }
    __device__ __forceinline__ int koff(int k) const { return k; } };
struct ARowCmp { const float* proj; int col; int m0;
    __device__ __forceinline__ const float* row(int r) const { const int g = m0 + r; if (g >= CROWS) return nullptr; const int kvh = g & 1, bc = g >> 1, b = bc / NC, c = bc % NC;
        return proj + (size_t)(b * S_ + 16 * c) * INW + col + kvh * 128; }
    __device__ __forceinline__ int koff(int k) const { return (k >> 7) * INW + (k & 127); } };
struct ARowList { const float* base; const int* list; int m0; int cnt; int shift;
    __device__ __forceinline__ const float* row(int r) const { if (m0 + r >= cnt) return nullptr; const int a = list[m0 + r]; return base + (size_t)(a >> shift) * 2048; }
    __device__ __forceinline__ int koff(int k) const { return k; } };

struct EpiStore { float* C; int ldc; int m0; int n0; int mlim; int nlim;
    __device__ __forceinline__ void operator()(const f4 (&acc)[4][2], int wr, int wc, int fr, int fq) const {
#pragma unroll
        for (int m = 0; m < 4; ++m)
#pragma unroll
            for (int n = 0; n < 2; ++n)
#pragma unroll
                for (int j = 0; j < 4; ++j) { const int r = m0 + wr * 64 + m * 16 + fq * 4 + j, c = n0 + wc * 32 + n * 16 + fr;
                    if (r < mlim && c < nlim) C[(size_t)r * ldc + c] = acc[m][n][j]; } } };
struct EpiHid { float* C; const float* bias; int m0; int n0;
    __device__ __forceinline__ void operator()(const f4 (&acc)[4][2], int wr, int wc, int fr, int fq) const {
#pragma unroll
        for (int m = 0; m < 4; ++m)
#pragma unroll
            for (int n = 0; n < 2; ++n)
#pragma unroll
                for (int j = 0; j < 4; ++j) { const int r = m0 + wr * 64 + m * 16 + fq * 4 + j, c = n0 + wc * 32 + n * 16 + fr;
                    if (r < CROWS) C[(size_t)r * 256 + c] = gelu_tanh(acc[m][n][j] + bias[c]); } } };
struct EpiOut { float* C; const float* x; int m0; int n0;
    __device__ __forceinline__ void operator()(const f4 (&acc)[4][2], int wr, int wc, int fr, int fq) const {
#pragma unroll
        for (int m = 0; m < 4; ++m)
#pragma unroll
            for (int n = 0; n < 2; ++n)
#pragma unroll
                for (int j = 0; j < 4; ++j) { const size_t o = (size_t)(m0 + wr * 64 + m * 16 + fq * 4 + j) * 2048 + n0 + wc * 32 + n * 16 + fr;
                    C[o] = DN_ALPHA * x[o] + acc[m][n][j]; } } };
struct EpiGu { float* act; const float* bgu; const int* list; int m0; int cnt; int n0;
    __device__ __forceinline__ void operator()(const f4 (&acc)[4][2], int wr, int wc, int fr, int fq) const {
        const int jc = (n0 + wc * 32) / 2 + fr;
        const float bg = bgu[2 * jc], bl = bgu[2 * jc + 1];
#pragma unroll
        for (int m = 0; m < 4; ++m)
#pragma unroll
            for (int j = 0; j < 4; ++j) { const int r = m0 + wr * 64 + m * 16 + fq * 4 + j;
                if (r < cnt) { const int a = list[r];
                    const float xg = fminf(acc[m][0][j] + bg, 7.f), xl = fminf(fmaxf(acc[m][1][j] + bl, -7.f), 7.f);
                    act[(size_t)a * 2048 + jc] = xg * sigmoidf_(1.702f * xg) * (xl + 1.f); } } } };
struct EpiDn { float* y; const float* bdn; const int* list; const float* gate; int m0; int cnt; int n0;
    __device__ __forceinline__ void operator()(const f4 (&acc)[4][2], int wr, int wc, int fr, int fq) const {
#pragma unroll
        for (int m = 0; m < 4; ++m)
#pragma unroll
            for (int j = 0; j < 4; ++j) { const int r = m0 + wr * 64 + m * 16 + fq * 4 + j;
                if (r < cnt) { const int a = list[r]; const float g = gate[a];
#pragma unroll
                    for (int n = 0; n < 2; ++n) { const int c = n0 + wc * 32 + n * 16 + fr; y[(size_t)a * 2048 + c] = (acc[m][n][j] + bdn[c]) * g; } } } } };

constexpr int WLDS_FLOATS = 4096 + 512 + 32;
template <bool SHARED>
__device__ __forceinline__ void wave_attn(float* sw, const float* __restrict__ qptr, const float* __restrict__ Kb, const float* __restrict__ Vb, int ld, int nseg, float scale, float* __restrict__ optr) {
    const int lane = threadIdx.x & 63;
    float* sq = sw + 4096; const int* segs = (const int*)(sw + 4096 + 512);
#pragma unroll
    for (int i = 0; i < 8; ++i) sq[lane + 64 * i] = qptr[lane + 64 * i];
    wave_sync();
    for (int sg = 0; sg < nseg; ++sg) {
        const int start = segs[sg], len = segs[16 + sg];
        float d0 = 0.f, d1 = 0.f, d2 = 0.f, d3 = 0.f;
        if (lane < len) {
            const float* kp = Kb + (size_t)(start + lane) * ld;
            for (int d4 = 0; d4 < 32; ++d4) {
                if (SHARED) {
                    const float4 kv = *(const float4*)(kp + d4 * 4);
                    const float4 q0 = *(const float4*)(sq + d4 * 4), q1 = *(const float4*)(sq + 128 + d4 * 4), q2 = *(const float4*)(sq + 256 + d4 * 4), q3 = *(const float4*)(sq + 384 + d4 * 4);
                    d0 += kv.x * q0.x + kv.y * q0.y + kv.z * q0.z + kv.w * q0.w;
                    d1 += kv.x * q1.x + kv.y * q1.y + kv.z * q1.z + kv.w * q1.w;
                    d2 += kv.x * q2.x + kv.y * q2.y + kv.z * q2.z + kv.w * q2.w;
                    d3 += kv.x * q3.x + kv.y * q3.y + kv.z * q3.z + kv.w * q3.w;
                } else {
                    const float4 k0 = *(const float4*)(kp + d4 * 4), k1 = *(const float4*)(kp + 128 + d4 * 4), k2 = *(const float4*)(kp + 256 + d4 * 4), k3 = *(const float4*)(kp + 384 + d4 * 4);
                    const float4 q0 = *(const float4*)(sq + d4 * 4), q1 = *(const float4*)(sq + 128 + d4 * 4), q2 = *(const float4*)(sq + 256 + d4 * 4), q3 = *(const float4*)(sq + 384 + d4 * 4);
                    d0 += k0.x * q0.x + k0.y * q0.y + k0.z * q0.z + k0.w * q0.w;
                    d1 += k1.x * q1.x + k1.y * q1.y + k1.z * q1.z + k1.w * q1.w;
                    d2 += k2.x * q2.x + k2.y * q2.y + k2.z * q2.z + k2.w * q2.w;
                    d3 += k3.x * q3.x + k3.y * q3.y + k3.z * q3.z + k3.w * q3.w;
                }
            }
        }
        const bool ok = lane < len;
        sw[sg * 64 + lane] = ok ? d0 * scale : -1e30f;
        sw[1024 + sg * 64 + lane] = ok ? d1 * scale : -1e30f;
        sw[2048 + sg * 64 + lane] = ok ? d2 * scale : -1e30f;
        sw[3072 + sg * 64 + lane] = ok ? d3 * scale : -1e30f;
    }
    wave_sync();
    const int n = nseg * 64;
#pragma unroll
    for (int g = 0; g < 4; ++g) {
        float mx = -1e30f;
        for (int i = lane; i < n; i += 64) mx = fmaxf(mx, sw[g * 1024 + i]);
        mx = wave_max(mx);
        float sm = 0.f;
        for (int i = lane; i < n; i += 64) { const float v = sw[g * 1024 + i]; sm += (v > -1e29f) ? expf(v - mx) : 0.f; }
        sm = wave_sum(sm);
        const float inv = sm > 0.f ? 1.f / sm : 0.f;
        for (int i = lane; i < n; i += 64) { const float v = sw[g * 1024 + i]; sw[g * 1024 + i] = (v > -1e29f) ? expf(v - mx) * inv : 0.f; }
    }
    wave_sync();
    float o[4][2];
#pragma unroll
    for (int g = 0; g < 4; ++g) { o[g][0] = 0.f; o[g][1] = 0.f; }
    for (int sg = 0; sg < nseg; ++sg) {
        const int start = segs[sg], len = segs[16 + sg];
        for (int l = 0; l < len; ++l) {
            const float* vp = Vb + (size_t)(start + l) * ld;
            if (SHARED) {
                const float v0 = vp[lane], v1 = vp[lane + 64];
#pragma unroll
                for (int g = 0; g < 4; ++g) { const float p = sw[g * 1024 + sg * 64 + l]; o[g][0] += p * v0; o[g][1] += p * v1; }
            } else {
#pragma unroll
                for (int g = 0; g < 4; ++g) { const float p = sw[g * 1024 + sg * 64 + l]; o[g][0] += p * vp[g * 128 + lane]; o[g][1] += p * vp[g * 128 + lane + 64]; }
            }
        }
    }
#pragma unroll
    for (int g = 0; g < 4; ++g) { optr[g * 128 + lane] = o[g][0]; optr[g * 128 + lane + 64] = o[g][1]; }
}

__global__ void __launch_bounds__(512, 2) fwd(Params p) {
    extern __shared__ __attribute__((aligned(16))) char smem[];
    const int tid = threadIdx.x, lane = tid & 63, wv = tid >> 6;
    const int bid = blockIdx.x, nb = gridDim.x;
    const int gw = bid * 8 + wv, nw = nb * 8;
    const int lo = (int)(p.lo_hi & 0xffffffffll), hi = (int)(p.lo_hi >> 32);
    unsigned char* ws = p.ws;
    unsigned* ctl = (unsigned*)(ws + WS_CTL);
    int* cnt = (int*)(ws + CTL_CNT);
    float* proj = (float*)(ws + WS_PROJ);
    float* kvmem = (float*)(ws + WS_KVMEM);
    float* bias1 = (float*)(ws + WS_BIAS1);
    float* hid = (float*)(ws + WS_HID);
    float* kc = (float*)(ws + WS_KC);
    float* vc = (float*)(ws + WS_VC);
    float* pooled = (float*)(ws + WS_POOLED);
    float* opool = (float*)(ws + WS_OPOOL);
    float* owin = (float*)(ws + WS_OWIN);
    float* ocmp = (float*)(ws + WS_OCMP);
    float* oslc = (float*)(ws + WS_OSLC);
    unsigned* sel = (unsigned*)(ws + WS_SEL);
    float* omem = (float*)(ws + WS_OMEM);
    float* cat = (float*)(ws + WS_CAT);
    float* hpre = (float*)(ws + WS_HPRE);
    float* hbuf = (float*)(ws + WS_H);
    float* gate = (float*)(ws + WS_GATE);
    int* list = (int*)(ws + WS_LIST);
    float* act = (float*)(ws + WS_ACT);
    float* ybuf = (float*)(ws + WS_Y);

    volatile LAS unsigned* xbw = (volatile LAS unsigned*)(smem + LDS_BYTES - 16);
    if (tid == 0) { xbw[0] = 0u; xbw[1] = 0u; xbw[2] = 0u; xbw[3] = 0u; }
    __syncthreads();
    XcdBarrier bar; bar.bar = ctl; bar.x = 0; bar.st = xbw;
    const bool multi = (hi - lo) > 1;
    if (multi) bar = xcd_barrier_post(ctl, xbw);
#define IN(k) (lo <= (k) && (k) < hi)
#define SEAM(k) do { if (IN(k) && IN((k) + 1)) xcd_barrier(bar); } while (0)
    float* sw = (float*)smem + wv * WLDS_FLOATS;
    int* segw = (int*)(sw + 4096 + 512);

    if (IN(0)) {
        for (int j = gw; j < 512; j += nw) {
            const int kv = j >> 8, jj = j & 255;
            const float* pos = p.in[kv ? I_POSV : I_POSK]; const float* w1 = p.in[kv ? I_W1V : I_W1K];
            float s = 0.f;
            for (int k = lane; k < 4096; k += 64) s += pos[k] * w1[(size_t)k * 256 + jj];
            s = wave_sum(s);
            if (lane == 0) bias1[j] = s;
        }
        const int NT1 = 29, NU1 = 128 * NT1, NU2 = 16 * 8;
        for (int u = bid; u < NU1 + NU2; u += nb) {
            if (u < NU1) { const int nt = u / 128, mt = u % 128;
                ARowPlain af{p.in[I_X], 2048, mt * 128, T_}; EpiStore ef{proj, INW, mt * 128, nt * 128, T_, INW};
                gemm_tile(smem, 2048, af, p.in[I_WIN], INW, nt * 128, INW, false, ef);
            } else { const int v = u - NU1, nt = v / 16, mt = v % 16;
                ARowPlain af{p.in[I_MEM], 2048, mt * 128, 2048}; EpiStore ef{kvmem, 1024, mt * 128, nt * 128, 2048, 1024};
                gemm_tile(smem, 2048, af, p.in[I_WMEMKV], 1024, nt * 128, 1024, false, ef);
            }
        }
    }
    SEAM(0);
    if (IN(1)) {
        for (int u = bid; u < 64; u += nb) { const int kv = u >> 5, r = u & 31, nt = r >> 4, mt = r & 15;
            ARowCmp af{proj, kv ? C_VC : C_KC, mt * 128}; EpiHid ef{hid + (size_t)kv * 2048 * 256, bias1 + kv * 256, mt * 128, nt * 128};
            gemm_tile(smem, 4096, af, p.in[kv ? I_W1V : I_W1K], 256, nt * 128, 256, false, ef);
        }
        for (size_t i = (size_t)bid * 512 + tid; i < (size_t)T_ * 512; i += (size_t)nb * 512) {
            const int col = (int)(i & 511), row = (int)(i >> 9), t = row & (S_ - 1), g = col >> 7;
            const int win = 2 << g; const int lo_t = max(t + 1 - win, 0); const int n = t + 1 - lo_t;
            float s = 0.f;
            for (int k = 0; k < n; ++k) s += proj[(size_t)(row - k) * INW + C_UP + col];
            pooled[i] = s / (float)n - proj[(size_t)row * INW + C_UP + col];
        }
        for (int u = gw; u < T_ * 2; u += nw) {
            const int kvh = u & 1, row = u >> 1, b = row >> 11, t = row & (S_ - 1);
            const int lo_t = max(0, t - 511), n = t + 1 - lo_t, nseg = (n + 63) >> 6;
            if (lane < 16) { segw[lane] = lo_t + 64 * lane; segw[16 + lane] = min(64, n - 64 * lane); }
            wave_sync();
            wave_attn<true>(sw, proj + (size_t)row * INW + C_Q + kvh * 512, proj + (size_t)b * S_ * INW + C_KW + kvh * 128, proj + (size_t)b * S_ * INW + C_VW + kvh * 128,
                            INW, nseg, ATT_SCALE, owin + (size_t)row * 1024 + kvh * 512);
            wave_sync();
        }
        for (int u = gw; u < T_; u += nw) {
            const int row = u, b = row >> 11;
            if (lane < 16) { segw[lane] = 64 * lane; segw[16 + lane] = 64; }
            wave_sync();
            wave_attn<false>(sw, proj + (size_t)row * INW + C_QM, kvmem + (size_t)b * 256 * 1024, kvmem + (size_t)b * 256 * 1024 + 512, 1024, 4, ATT_SCALE, omem + (size_t)row * 512);
            wave_sync();
        }
    }
    SEAM(1);
    if (IN(2)) {
        for (size_t i = (size_t)bid * 512 + tid; i < (size_t)2 * CROWS * 128; i += (size_t)nb * 512) {
            const int kv = (int)(i / ((size_t)CROWS * 128)); const int r = (int)(i % ((size_t)CROWS * 128)); const int row = r >> 7, d = r & 127;
            const float* hr = hid + (size_t)kv * 2048 * 256 + (size_t)row * 256; const float* w2 = p.in[kv ? I_W2V : I_W2K];
            float s = 0.f;
            for (int k = 0; k < 256; ++k) s += hr[k] * w2[k * 128 + d];
            (kv ? vc : kc)[(size_t)row * 128 + d] = s;
        }
        for (size_t i = (size_t)bid * 512 + tid; i < (size_t)T_ * 512; i += (size_t)nb * 512) {
            const int col = (int)(i & 511), row = (int)(i >> 9), g = col >> 7, d = col & 127;
            const float* pr = pooled + (size_t)row * 512 + g * 128; const float* w = p.in[I_POOLW] + (size_t)g * 128 * 128;
            float s = 0.f;
            for (int c = 0; c < 128; ++c) s += pr[c] * w[c * 128 + d];
            opool[i] = s * p.in[I_POOLS][col];
        }
    }
    SEAM(2);
    if (IN(3)) {
        for (int u = gw; u < T_ * 2; u += nw) {
            const int kvh = u & 1, row = u >> 1, b = row >> 11, t = row & (S_ - 1);
            const int nvalid = t >= 31 ? min(NC, (t - 31) / 16 + 1) : 0, nseg = (nvalid + 63) >> 6;
            if (lane < 16) { segw[lane] = 64 * lane; segw[16 + lane] = min(64, nvalid - 64 * lane); }
            wave_sync();
            wave_attn<true>(sw, proj + (size_t)row * INW + C_Q + kvh * 512, kc + (size_t)b * NC * 256 + kvh * 128, vc + (size_t)b * NC * 256 + kvh * 128, 256, nseg, ATT_SCALE,
                            ocmp + (size_t)row * 1024 + kvh * 512);
            wave_sync();
            float* ps = sw + 4096;
            const int n = nseg * 64;
            ps[lane] = lane < n ? sw[lane] + sw[1024 + lane] + sw[2048 + lane] + sw[3072 + lane] : 0.f;
            ps[lane + 64] = (lane + 64) < n ? sw[lane + 64] + sw[1024 + lane + 64] + sw[2048 + lane + 64] + sw[3072 + lane + 64] : 0.f;
            wave_sync();
            const int j = lane & 31, cur = t >> 6;
            float imp = 0.f;
#pragma unroll
            for (int dc = -1; dc <= 3; ++dc) { const int c = 4 * j + dc; if (c >= 0 && c < NC) imp += ps[c] * ((dc == -1 || dc == 3) ? 1.f : 2.f); }
            const bool forced = (j == 0) || (j == cur) || (j == cur - 1), valid = j <= cur;
            const float iv = forced ? 1e9f : (valid ? imp : -1e9f);
            int rank = 0;
            for (int i = 0; i < 32; ++i) { const float vi = __shfl(iv, i); rank += (vi > iv || (vi == iv && i < j)) ? 1 : 0; }
            const unsigned long long bal = __ballot(lane < 32 && rank < 16 && valid);
            if (lane == 0) sel[u] = (unsigned)bal;
            wave_sync();
        }
    }
    SEAM(3);
    if (IN(4)) {
        for (int u = gw; u < T_ * 2; u += nw) {
            const int kvh = u & 1, row = u >> 1, b = row >> 11, t = row & (S_ - 1);
            const unsigned m = sel[u];
            const int nseg = __popc(m);
            if (lane < 32 && ((m >> lane) & 1u)) { const int pos = __popc(m & ((1u << lane) - 1u)); segw[pos] = 64 * lane; segw[16 + pos] = min(64, t + 1 - 64 * lane); }
            wave_sync();
            wave_attn<true>(sw, proj + (size_t)row * INW + C_Q + kvh * 512, proj + (size_t)b * S_ * INW + C_KS + kvh * 128, proj + (size_t)b * S_ * INW + C_VS + kvh * 128,
                            INW, nseg, ATT_SCALE, oslc + (size_t)row * 1024 + kvh * 512);
            wave_sync();
        }
    }
    SEAM(4);
    if (IN(5)) {
        for (int row = gw; row < T_; row += nw) {
            const float* pr = proj + (size_t)row * INW;
            float v[16]; float ss = 0.f;
#pragma unroll
            for (int i = 0; i < 16; ++i) { const int col = lane + 64 * i, h = col >> 7; const size_t o = (size_t)row * 1024 + col;
                const float g0 = sigmoidf_(pr[C_G + h * 3]), g1 = sigmoidf_(pr[C_G + h * 3 + 1]), g2 = sigmoidf_(pr[C_G + h * 3 + 2]);
                v[i] = g0 * ocmp[o] + g1 * oslc[o] + g2 * owin[o]; ss += v[i] * v[i]; }
            ss = wave_sum(ss); float r = rsqrtf(ss / 1024.f + LN_EPS);
#pragma unroll
            for (int i = 0; i < 16; ++i) { const int col = lane + 64 * i; cat[(size_t)row * 2048 + col] = v[i] * r * p.in[I_GNNSA][col]; }
            ss = 0.f;
#pragma unroll
            for (int i = 0; i < 8; ++i) { v[i] = opool[(size_t)row * 512 + lane + 64 * i]; ss += v[i] * v[i]; }
            ss = wave_sum(ss); r = rsqrtf(ss / 512.f + LN_EPS);
#pragma unroll
            for (int i = 0; i < 8; ++i) { const int col = lane + 64 * i; cat[(size_t)row * 2048 + 1024 + col] = v[i] * r * p.in[I_GNPOOL][col]; }
            ss = 0.f;
#pragma unroll
            for (int i = 0; i < 8; ++i) { v[i] = omem[(size_t)row * 512 + lane + 64 * i]; ss += v[i] * v[i]; }
            ss = wave_sum(ss); r = rsqrtf(ss / 512.f + LN_EPS);
#pragma unroll
            for (int i = 0; i < 8; ++i) { const int col = lane + 64 * i; cat[(size_t)row * 2048 + 1536 + col] = v[i] * r * p.in[I_GNMEM][col]; }
        }
    }
    SEAM(5);
    if (IN(6)) {
        for (int u = bid; u < 128 * 16; u += nb) { const int nt = u / 128, mt = u % 128;
            ARowPlain af{cat, 2048, mt * 128, T_}; EpiOut ef{hpre, p.in[I_X], mt * 128, nt * 128};
            gemm_tile(smem, 2048, af, p.in[I_WOUT], 2048, nt * 128, 2048, false, ef);
        }
    }
    SEAM(6);
    if (IN(7)) {
        for (int row = gw; row < T_; row += nw) {
            float v[32]; float s = 0.f;
#pragma unroll
            for (int i = 0; i < 32; ++i) { v[i] = hpre[(size_t)row * 2048 + lane + 64 * i]; s += v[i]; }
            const float mu = wave_sum(s) / 2048.f; float q = 0.f;
#pragma unroll
            for (int i = 0; i < 32; ++i) { const float d = v[i] - mu; q += d * d; }
            const float rs = rsqrtf(wave_sum(q) / 2048.f + LN_EPS);
#pragma unroll
            for (int i = 0; i < 32; ++i) { const int col = lane + 64 * i; v[i] = (v[i] - mu) * rs * p.in[I_LN1G][col] + p.in[I_LN1B][col]; hbuf[(size_t)row * 2048 + col] = v[i]; }
            float part[32];
#pragma unroll
            for (int e = 0; e < 32; ++e) part[e] = 0.f;
#pragma unroll 1
            for (int i = 0; i < 32; ++i) { const float4* wp = (const float4*)(p.in[I_WR] + (size_t)(lane + 64 * i) * 32); const float hv = hbuf[(size_t)row * 2048 + lane + 64 * i];
#pragma unroll
                for (int q4 = 0; q4 < 8; ++q4) { const float4 w = wp[q4]; part[4 * q4] += hv * w.x; part[4 * q4 + 1] += hv * w.y; part[4 * q4 + 2] += hv * w.z; part[4 * q4 + 3] += hv * w.w; } }
            float mine = 0.f;
#pragma unroll
            for (int e = 0; e < 32; ++e) { const float a = wave_sum(part[e]) + p.in[I_BR][e]; if (lane == e) mine = a; }
            const int j = lane & 31; const float iv = __shfl(mine, j);
            int rank = 0;
            for (int i = 0; i < 32; ++i) { const float vi = __shfl(iv, i); rank += (vi > iv || (vi == iv && i < j)) ? 1 : 0; }
            float tv[4]; int te[4];
#pragma unroll
            for (int r = 0; r < 4; ++r) { const unsigned long long bm = __ballot(lane < 32 && rank == r); const int src = __ffsll((long long)bm) - 1; te[r] = src; tv[r] = __shfl(iv, src); }
            const float mx = tv[0];
            float e0 = expf(tv[0] - mx), e1 = expf(tv[1] - mx), e2 = expf(tv[2] - mx), e3 = expf(tv[3] - mx); const float inv = 1.f / (e0 + e1 + e2 + e3);
            if (lane < 4) { const int e = lane == 0 ? te[0] : lane == 1 ? te[1] : lane == 2 ? te[2] : te[3]; const float g = (lane == 0 ? e0 : lane == 1 ? e1 : lane == 2 ? e2 : e3) * inv;
                const int a = row * 4 + lane; const int pos = atomicAdd(&cnt[e], 1); list[(size_t)e * T_ + pos] = a; gate[a] = g; }
        }
    }
    SEAM(7);
    if (IN(8)) {
        int tot = 0; for (int e = 0; e < NE; ++e) tot += ((cnt[e] + 127) >> 7) * 32;
        for (int u = bid; u < tot; u += nb) {
            int e = 0, base = 0, nm = 0;
            for (; e < NE; ++e) { nm = (cnt[e] + 127) >> 7; if (u < base + nm * 32) break; base += nm * 32; }
            const int v = u - base, nt = v / nm, mt = v % nm;
            ARowList af{hbuf, list + (size_t)e * T_, mt * 128, cnt[e], 2};
            EpiGu ef{act, p.in[I_BGU] + (size_t)e * 4096, list + (size_t)e * T_, mt * 128, cnt[e], nt * 128};
            gemm_tile(smem, 2048, af, p.in[I_WGU] + (size_t)e * 2048 * 4096, 4096, nt * 128, 4096, true, ef);
        }
    }
    SEAM(8);
    if (IN(9)) {
        int tot = 0; for (int e = 0; e < NE; ++e) tot += ((cnt[e] + 127) >> 7) * 16;
        for (int u = bid; u < tot; u += nb) {
            int e = 0, base = 0, nm = 0;
            for (; e < NE; ++e) { nm = (cnt[e] + 127) >> 7; if (u < base + nm * 16) break; base += nm * 16; }
            const int v = u - base, nt = v / nm, mt = v % nm;
            ARowList af{act, list + (size_t)e * T_, mt * 128, cnt[e], 0};
            EpiDn ef{ybuf, p.in[I_BDN] + (size_t)e * 2048, list + (size_t)e * T_, gate, mt * 128, cnt[e], nt * 128};
            gemm_tile(smem, 2048, af, p.in[I_WDN] + (size_t)e * 2048 * 2048, 2048, nt * 128, 2048, false, ef);
        }
    }
    SEAM(9);
    if (IN(10)) {
        for (int row = gw; row < T_; row += nw) {
            float v[32]; float s = 0.f;
#pragma unroll
            for (int i = 0; i < 32; ++i) { const int col = lane + 64 * i; const size_t yo = (size_t)row * 4 * 2048 + col;
                v[i] = DN_ALPHA * hbuf[(size_t)row * 2048 + col] + ((ybuf[yo] + ybuf[yo + 2048]) + (ybuf[yo + 4096] + ybuf[yo + 6144])); s += v[i]; }
            const float mu = wave_sum(s) / 2048.f; float q = 0.f;
#pragma unroll
            for (int i = 0; i < 32; ++i) { const float d = v[i] - mu; q += d * d; }
            const float rs = rsqrtf(wave_sum(q) / 2048.f + LN_EPS);
#pragma unroll
            for (int i = 0; i < 32; ++i) { const int col = lane + 64 * i; p.out[(size_t)row * 2048 + col] = (v[i] - mu) * rs * p.in[I_LN2G][col] + p.in[I_LN2B][col]; }
        }
    }
}

constexpr int NPHASE = 11;

extern "C" void kernel_launch(void* const* d_in, const int* in_sizes, int n_in, void* d_out, int out_size, void* d_ws, size_t ws_size, hipStream_t stream) {
    static int grid = 0;
    if (grid == 0) {
        if (n_in != 26 || ws_size < WS_END) { fprintf(stderr, "kernel_launch: unexpected n_in %d or ws_size %zu (< %zu)\n", n_in, ws_size, (size_t)WS_END); grid = -1; return; }
        int dev = 0, cus = 0, per_cu = 0;
        hipGetDevice(&dev); hipDeviceGetAttribute(&cus, hipDeviceAttributeMultiprocessorCount, dev);
        if (hipFuncSetAttribute((const void*)fwd, hipFuncAttributeMaxDynamicSharedMemorySize, LDS_BYTES) != hipSuccess) { fprintf(stderr, "hipFuncSetAttribute failed\n"); grid = -1; return; }
        hipOccupancyMaxActiveBlocksPerMultiprocessor(&per_cu, (const void*)fwd, 512, LDS_BYTES);
        (void)hipGetLastError();
        if (per_cu < 1) fprintf(stderr, "occupancy query says %d blocks per CU\n", per_cu);
        grid = cus > 0 ? cus : 256;
    }
    if (grid < 0) return;
    hipMemsetAsync((char*)d_ws + WS_CTL, 0, CTL_BYTES, stream);
    Params p{};
    for (int i = 0; i < 26; ++i) p.in[i] = (const float*)d_in[i];
    p.out = (float*)d_out; p.ws = (unsigned char*)d_ws;
#if N_LAUNCH_MODE == 1
    p.lo_hi = (long long)0 | ((long long)NPHASE << 32);
    hipLaunchKernelGGL(fwd, dim3(grid), dim3(512), LDS_BYTES, stream, p);
#else
    for (int ph = 0; ph < NPHASE; ++ph) {
        p.lo_hi = (long long)ph | ((long long)(ph + 1) << 32);
        hipLaunchKernelGGL(fwd, dim3(grid), dim3(512), LDS_BYTES, stream, p);
    }
#endif
}
```

```cpp
#include <hip/hip_runtime.h>
#include <cstdio>
#include <cstdint>

#ifndef N_LAUNCH_MODE
#define N_LAUNCH_MODE 1
#endif

constexpr int B_ = 8, S_ = 2048, D_ = 2048, T_ = B_ * S_;
constexpr int INW = 3608;
constexpr int C_Q = 0, C_KC = 1024, C_VC = 1280, C_KS = 1536, C_VS = 1792, C_KW = 2048, C_VW = 2304, C_G = 2560, C_UP = 2584, C_QM = 3096;
constexpr int NC = 127;
constexpr int CROWS = B_ * NC * 2;
constexpr int NE = 32, DE = 2048, NA = T_ * 4;
constexpr float LN_EPS = 1e-5f;
constexpr float DN_ALPHA = 1.189207115002721f;
constexpr float ATT_SCALE = 0.08838834764831845f;

constexpr size_t al256(size_t x) { return (x + 255) & ~(size_t)255; }
constexpr size_t WS_CTL = 0;
constexpr size_t CTL_BYTES = 65536;
constexpr size_t CTL_CNT = 16384;
constexpr size_t WS_PROJ = CTL_BYTES;
constexpr size_t WS_KVMEM = WS_PROJ + al256((size_t)T_ * INW * 4);
constexpr size_t WS_BIAS1 = WS_KVMEM + al256((size_t)2048 * 1024 * 4);
constexpr size_t WS_HID = WS_BIAS1 + al256(2 * 256 * 4);
constexpr size_t WS_KC = WS_HID + al256((size_t)2 * 2048 * 256 * 4);
constexpr size_t WS_VC = WS_KC + al256((size_t)CROWS * 128 * 4);
constexpr size_t WS_POOLED = WS_VC + al256((size_t)CROWS * 128 * 4);
constexpr size_t WS_OPOOL = WS_POOLED + al256((size_t)T_ * 512 * 4);
constexpr size_t WS_OWIN = WS_OPOOL + al256((size_t)T_ * 512 * 4);
constexpr size_t WS_OCMP = WS_OWIN + al256((size_t)T_ * 1024 * 4);
constexpr size_t WS_OSLC = WS_OCMP + al256((size_t)T_ * 1024 * 4);
constexpr size_t WS_SEL = WS_OSLC + al256((size_t)T_ * 1024 * 4);
constexpr size_t WS_OMEM = WS_SEL + al256((size_t)T_ * 2 * 4);
constexpr size_t WS_CAT16 = WS_OMEM + al256((size_t)T_ * 512 * 4);
constexpr size_t WS_HPRE = WS_CAT16 + al256((size_t)T_ * 2048 * 2);
constexpr size_t WS_H = WS_HPRE + al256((size_t)T_ * 2048 * 4);
constexpr size_t WS_H16 = WS_H + al256((size_t)T_ * 2048 * 4);
constexpr size_t WS_GATE = WS_H16 + al256((size_t)T_ * 2048 * 2);
constexpr size_t WS_LIST = WS_GATE + al256((size_t)NA * 4);
constexpr size_t WS_ACT16 = WS_LIST + al256((size_t)NE * T_ * 4);
constexpr size_t WS_Y16 = WS_ACT16 + al256((size_t)(NA + 256) * 2048 * 2);
constexpr size_t WS_X16 = WS_Y16 + al256((size_t)NA * 2048 * 2);
constexpr size_t WS_WTIN = WS_X16 + al256((size_t)T_ * 2048 * 2);
constexpr size_t WS_WTOUT = WS_WTIN + al256((size_t)3840 * 2048 * 2);
constexpr size_t WS_WTGU = WS_WTOUT + al256((size_t)2048 * 2048 * 2);
constexpr size_t WS_WTDN = WS_WTGU + al256((size_t)NE * 4096 * 2048 * 2);
constexpr size_t WS_END = WS_WTDN + al256((size_t)NE * 2048 * 2048 * 2);

constexpr int LDS_BYTES = 155648;

struct Params {
    const float* in[26];
    float* out;
    unsigned char* ws;
    long long lo_hi;
};
enum { I_X = 0, I_MEM, I_WIN, I_POSK, I_W1K, I_W2K, I_POSV, I_W1V, I_W2V, I_POOLW, I_POOLS, I_WMEMKV, I_GNNSA, I_GNPOOL, I_GNMEM, I_WOUT,
       I_LN1G, I_LN1B, I_WR, I_BR, I_WGU, I_BGU, I_WDN, I_BDN, I_LN2G, I_LN2B };

#define XB_TMO      128
#define XB_XCNT(j)  (256  + 64 * (j))
#define XB_XSUB(j)  (1280 + 64 * (j))
#define XB_XGEN(j)  (2304 + 64 * (j))
#define XB_TOP      3328
#define XB_TOPGEN   3392
#define XCD_BAR_WORDS 3456
#define XB_SPIN_CAP (1u << 25)
#define LAS __attribute__((address_space(3)))

__device__ __forceinline__ unsigned xb_ld(unsigned* p)              { return __hip_atomic_load(p, __ATOMIC_RELAXED, __HIP_MEMORY_SCOPE_AGENT); }
__device__ __forceinline__ unsigned xb_add(unsigned* p, unsigned v) { return __hip_atomic_fetch_add(p, v, __ATOMIC_RELAXED, __HIP_MEMORY_SCOPE_AGENT); }
__device__ __forceinline__ unsigned xb_xcc_id() { return (unsigned)__builtin_amdgcn_s_getreg((3 << 11) | 20) & 0xFu; }
#define XB_SPIN(cond, bar) do { unsigned _sp = 0; while (cond) { __builtin_amdgcn_s_sleep(1); \
    if ((++_sp & 255u) == 0u) { if (xb_ld(&(bar)[XB_TMO])) break; if (_sp > XB_SPIN_CAP) { atomicAdd(&(bar)[XB_TMO], 1u); break; } } } } while (0)

struct XcdBarrier { unsigned* bar; unsigned x; volatile LAS unsigned* st; };

__device__ __forceinline__ XcdBarrier xcd_barrier_post(unsigned* bar, volatile LAS unsigned* st) {
    XcdBarrier b; b.bar = bar; b.x = xb_xcc_id(); b.st = st;
    if (threadIdx.x == 0) (void)xb_add(&bar[XB_XCNT(b.x)], 1u);
    return b;
}
__device__ __forceinline__ void xcd_barrier_complete(unsigned* bar, unsigned x, unsigned& nloc, unsigned& nx) {
    const unsigned G = gridDim.x * gridDim.y * gridDim.z;
    unsigned sum, cnt, mine, sp = 0u;
    for (;;) {
        sum = 0u; cnt = 0u; mine = 0u;
#pragma unroll
        for (unsigned j = 0; j < 16; ++j) { const unsigned c = xb_ld(&bar[XB_XCNT(j)]); sum += c; cnt += (c > 0u) ? 1u : 0u; mine = (j == x) ? c : mine; }
        if (sum == G) break;
        __builtin_amdgcn_s_sleep(1);
        if ((++sp & 255u) == 0u) { if (xb_ld(&bar[XB_TMO])) break; if (sp > XB_SPIN_CAP) { atomicAdd(&bar[XB_TMO], 1u); break; } }
    }
    nloc = mine > 0u ? mine : 1u; nx = cnt > 0u ? cnt : 1u;
}
__device__ __forceinline__ void xcd_barrier(const XcdBarrier& b) {
    asm volatile("s_waitcnt vmcnt(0)" ::: "memory");
    __syncthreads();
    if (threadIdx.x == 0) {
        unsigned* bar = b.bar;
        __builtin_amdgcn_s_waitcnt(0);
        unsigned nloc = b.st[0], nx = b.st[1];
        if (nloc == 0u) { xcd_barrier_complete(bar, b.x, nloc, nx); b.st[0] = nloc; b.st[1] = nx; }
        const unsigned old = xb_add(&bar[XB_XSUB(b.x)], 1u);
        const unsigned gen = old / nloc;
        if (old + 1u == (gen + 1u) * nloc) {
            __builtin_amdgcn_fence(__ATOMIC_RELEASE, "agent");
            asm volatile("s_waitcnt vmcnt(0)" ::: "memory");
            const unsigned og = xb_add(&bar[XB_TOP], 1u);
            const unsigned tg = og / nx;
            if (og + 1u == (tg + 1u) * nx) xb_add(&bar[XB_TOPGEN], 1u);
            else XB_SPIN(xb_ld(&bar[XB_TOPGEN]) == tg, bar);
            __builtin_amdgcn_fence(__ATOMIC_ACQUIRE, "agent");
            xb_add(&bar[XB_XGEN(b.x)], 1u);
            asm volatile("s_waitcnt vmcnt(0)" ::: "memory");
        } else {
            XB_SPIN(xb_ld(&bar[XB_XGEN(b.x)]) == gen, bar);
            __builtin_amdgcn_fence(__ATOMIC_ACQUIRE, "agent");
            asm volatile("s_waitcnt vmcnt(0)" ::: "memory");
        }
    }
    __syncthreads();
}

typedef _Float16 h8 __attribute__((ext_vector_type(8)));
typedef _Float16 h4 __attribute__((ext_vector_type(4)));
typedef float f4 __attribute__((ext_vector_type(4)));

__device__ __forceinline__ float wave_sum(float v) {
#pragma unroll
    for (int o = 32; o > 0; o >>= 1) v += __shfl_xor(v, o);
    return v;
}
__device__ __forceinline__ float wave_max(float v) {
#pragma unroll
    for (int o = 32; o > 0; o >>= 1) v = fmaxf(v, __shfl_xor(v, o));
    return v;
}
__device__ __forceinline__ void wave_sync() {
    asm volatile("s_waitcnt lgkmcnt(0)" ::: "memory");
    __builtin_amdgcn_wave_barrier();
}
__device__ __forceinline__ float gelu_tanh(float x) {
    const float u = 0.7978845608028654f * (x + 0.044715f * x * x * x);
    return 0.5f * x * (1.f + tanhf(u));
}
__device__ __forceinline__ float sigmoidf_(float x) { return 1.f / (1.f + expf(-x)); }

constexpr int G_LD = 40;
template <class AF, class EF>
__device__ __forceinline__ void gemm_tile(char* smem, int K, const AF& af, const float* __restrict__ Bm, int ldb, int n0, int Nlim, bool perm, const EF& ef) {
    _Float16* As = (_Float16*)smem;
    _Float16* Bs = As + 128 * G_LD;
    const int tid = threadIdx.x, lane = tid & 63, wid = tid >> 6, wr = wid >> 2, wc = wid & 3, fr = lane & 15, fq = lane >> 4;
    f4 acc[4][2];
#pragma unroll
    for (int m = 0; m < 4; ++m)
#pragma unroll
        for (int n = 0; n < 2; ++n) acc[m][n] = (f4){0.f, 0.f, 0.f, 0.f};
    const int ar = tid >> 3, ak = (tid & 7) * 4;
    const float* ap0 = af.row(ar);
    const float* ap1 = af.row(ar + 64);
    const int bk = tid >> 5, bn = (tid & 31) * 4;
    const bool bok = (n0 + bn) < Nlim;
    int bnp[4];
#pragma unroll
    for (int i = 0; i < 4; ++i) { const int c = bn + i; bnp[i] = perm ? ((c & ~31) | ((c & 1) << 4) | ((c & 31) >> 1)) : c; }
    for (int k0 = 0; k0 < K; k0 += 32) {
        const int ko = af.koff(k0 + ak);
        float4 a0 = make_float4(0.f, 0.f, 0.f, 0.f), a1 = a0, b0 = a0, b1 = a0;
        if (ap0) a0 = *(const float4*)(ap0 + ko);
        if (ap1) a1 = *(const float4*)(ap1 + ko);
        if (bok) { b0 = *(const float4*)(Bm + (size_t)(k0 + bk) * ldb + n0 + bn); b1 = *(const float4*)(Bm + (size_t)(k0 + bk + 16) * ldb + n0 + bn); }
        __syncthreads();
        *(h4*)&As[ar * G_LD + ak] = (h4){(_Float16)a0.x, (_Float16)a0.y, (_Float16)a0.z, (_Float16)a0.w};
        *(h4*)&As[(ar + 64) * G_LD + ak] = (h4){(_Float16)a1.x, (_Float16)a1.y, (_Float16)a1.z, (_Float16)a1.w};
        Bs[bnp[0] * G_LD + bk] = (_Float16)b0.x; Bs[bnp[1] * G_LD + bk] = (_Float16)b0.y; Bs[bnp[2] * G_LD + bk] = (_Float16)b0.z; Bs[bnp[3] * G_LD + bk] = (_Float16)b0.w;
        Bs[bnp[0] * G_LD + bk + 16] = (_Float16)b1.x; Bs[bnp[1] * G_LD + bk + 16] = (_Float16)b1.y; Bs[bnp[2] * G_LD + bk + 16] = (_Float16)b1.z; Bs[bnp[3] * G_LD + bk + 16] = (_Float16)b1.w;
        __syncthreads();
        h8 a[4], b[2];
#pragma unroll
        for (int m = 0; m < 4; ++m) a[m] = *(const h8*)&As[(wr * 64 + m * 16 + fr) * G_LD + fq * 8];
#pragma unroll
        for (int n = 0; n < 2; ++n) b[n] = *(const h8*)&Bs[(wc * 32 + n * 16 + fr) * G_LD + fq * 8];
#pragma unroll
        for (int m = 0; m < 4; ++m)
#pragma unroll
            for (int n = 0; n < 2; ++n) acc[m][n] = __builtin_amdgcn_mfma_f32_16x16x32_f16(a[m], b[n], acc[m][n], 0, 0, 0);
    }
    ef(acc, wr, wc, fr, fq);
    __syncthreads();
}

struct ARowPlain { const float* base; int ld; int m0; int mlim;
    __device__ __forceinline__ const float* row(int r) const { return (m0 + r) < mlim ? base + (size_t)(m0 + r) * ld : nullptr; }
    __device__ __forceinline__ int koff(int k) const { return k; } };
struct ARowCmp { const float* proj; int col; int m0;
    __device__ __forceinline__ const float* row(int r) const { const int g = m0 + r; if (g >= CROWS) return nullptr; const int kvh = g & 1, bc = g >> 1, b = bc / NC, c = bc % NC;
        return proj + (size_t)(b * S_ + 16 * c) * INW + col + kvh * 128; }
    __device__ __forceinline__ int koff(int k) const { return (k >> 7) * INW + (k & 127); } };
struct ARowList { const float* base; const int* list; int m0; int cnt; int shift;
    __device__ __forceinline__ const float* row(int r) const { if (m0 + r >= cnt) return nullptr; const int a = list[m0 + r]; return base + (size_t)(a >> shift) * 2048; }
    __device__ __forceinline__ int koff(int k) const { return k; } };

struct EpiStore { float* C; int ldc; int m0; int n0; int mlim; int nlim;
    __device__ __forceinline__ void operator()(const f4 (&acc)[4][2], int wr, int wc, int fr, int fq) const {
#pragma unroll
        for (int m = 0; m < 4; ++m)
#pragma unroll
            for (int n = 0; n < 2; ++n)
#pragma unroll
                for (int j = 0; j < 4; ++j) { const int r = m0 + wr * 64 + m * 16 + fq * 4 + j, c = n0 + wc * 32 + n * 16 + fr;
                    if (r < mlim && c < nlim) C[(size_t)r * ldc + c] = acc[m][n][j]; } } };
struct EpiHid { float* C; const float* bias; int m0; int n0;
    __device__ __forceinline__ void operator()(const f4 (&acc)[4][2], int wr, int wc, int fr, int fq) const {
#pragma unroll
        for (int m = 0; m < 4; ++m)
#pragma unroll
            for (int n = 0; n < 2; ++n)
#pragma unroll
                for (int j = 0; j < 4; ++j) { const int r = m0 + wr * 64 + m * 16 + fq * 4 + j, c = n0 + wc * 32 + n * 16 + fr;
                    if (r < CROWS) C[(size_t)r * 256 + c] = gelu_tanh(acc[m][n][j] + bias[c]); } } };
struct EpiOut { float* C; const float* x; int m0; int n0;
    __device__ __forceinline__ void operator()(const f4 (&acc)[4][2], int wr, int wc, int fr, int fq) const {
#pragma unroll
        for (int m = 0; m < 4; ++m)
#pragma unroll
            for (int n = 0; n < 2; ++n)
#pragma unroll
                for (int j = 0; j < 4; ++j) { const size_t o = (size_t)(m0 + wr * 64 + m * 16 + fq * 4 + j) * 2048 + n0 + wc * 32 + n * 16 + fr;
                    C[o] = DN_ALPHA * x[o] + acc[m][n][j]; } } };
struct EpiGu { float* act; const float* bgu; const int* list; int m0; int cnt; int n0;
    __device__ __forceinline__ void operator()(const f4 (&acc)[4][2], int wr, int wc, int fr, int fq) const {
        const int jc = (n0 + wc * 32) / 2 + fr;
        const float bg = bgu[2 * jc], bl = bgu[2 * jc + 1];
#pragma unroll
        for (int m = 0; m < 4; ++m)
#pragma unroll
            for (int j = 0; j < 4; ++j) { const int r = m0 + wr * 64 + m * 16 + fq * 4 + j;
                if (r < cnt) { const int a = list[r];
                    const float xg = fminf(acc[m][0][j] + bg, 7.f), xl = fminf(fmaxf(acc[m][1][j] + bl, -7.f), 7.f);
                    act[(size_t)a * 2048 + jc] = xg * sigmoidf_(1.702f * xg) * (xl + 1.f); } } } };
struct EpiDn { float* y; const float* bdn; const int* list; const float* gate; int m0; int cnt; int n0;
    __device__ __forceinline__ void operator()(const f4 (&acc)[4][2], int wr, int wc, int fr, int fq) const {
#pragma unroll
        for (int m = 0; m < 4; ++m)
#pragma unroll
            for (int j = 0; j < 4; ++j) { const int r = m0 + wr * 64 + m * 16 + fq * 4 + j;
                if (r < cnt) { const int a = list[r]; const float g = gate[a];
#pragma unroll
                    for (int n = 0; n < 2; ++n) { const int c = n0 + wc * 32 + n * 16 + fr; y[(size_t)a * 2048 + c] = (acc[m][n][j] + bdn[c]) * g; } } } } };

constexpr int WLDS_FLOATS = 4096 + 512 + 32;
template <bool SHARED>
__device__ __forceinline__ void wave_attn(float* sw, const float* __restrict__ qptr, const float* __restrict__ Kb, const float* __restrict__ Vb, int ld, int nseg, float scale, float* __restrict__ optr) {
    const int lane = threadIdx.x & 63;
    float* sq = sw + 4096; const int* segs = (const int*)(sw + 4096 + 512);
#pragma unroll
    for (int i = 0; i < 8; ++i) sq[lane + 64 * i] = qptr[lane + 64 * i];
    wave_sync();
    for (int sg = 0; sg < nseg; ++sg) {
        const int start = segs[sg], len = segs[16 + sg];
        float d0 = 0.f, d1 = 0.f, d2 = 0.f, d3 = 0.f;
        if (lane < len) {
            const float* kp = Kb + (size_t)(start + lane) * ld;
            for (int d4 = 0; d4 < 32; ++d4) {
                if (SHARED) {
                    const float4 kv = *(const float4*)(kp + d4 * 4);
                    const float4 q0 = *(const float4*)(sq + d4 * 4), q1 = *(const float4*)(sq + 128 + d4 * 4), q2 = *(const float4*)(sq + 256 + d4 * 4), q3 = *(const float4*)(sq + 384 + d4 * 4);
                    d0 += kv.x * q0.x + kv.y * q0.y + kv.z * q0.z + kv.w * q0.w;
                    d1 += kv.x * q1.x + kv.y * q1.y + kv.z * q1.z + kv.w * q1.w;
                    d2 += kv.x * q2.x + kv.y * q2.y + kv.z * q2.z + kv.w * q2.w;
                    d3 += kv.x * q3.x + kv.y * q3.y + kv.z * q3.z + kv.w * q3.w;
                } else {
                    const float4 k0 = *(const float4*)(kp + d4 * 4), k1 = *(const float4*)(kp + 128 + d4 * 4), k2 = *(const float4*)(kp + 256 + d4 * 4), k3 = *(const float4*)(kp + 384 + d4 * 4);
                    const float4 q0 = *(const float4*)(sq + d4 * 4), q1 = *(const float4*)(sq + 128 + d4 * 4), q2 = *(const float4*)(sq + 256 + d4 * 4), q3 = *(const float4*)(sq + 384 + d4 * 4);
                    d0 += k0.x * q0.x + k0.y * q0.y + k0.z * q0.z + k0.w * q0.w;
                    d1 += k1.x * q1.x + k1.y * q1.y + k1.z * q1.z + k1.w * q1.w;
                    d2 += k2.x * q2.x + k2.y * q2.y + k2.z * q2.z + k2.w * q2.w;
                    d3 += k3.x * q3.x + k3.y * q3.y + k3.z * q3.z + k3.w * q3.w;
                }
            }
        }
        const bool ok = lane < len;
        sw[sg * 64 + lane] = ok ? d0 * scale : -1e30f;
        sw[1024 + sg * 64 + lane] = ok ? d1 * scale : -1e30f;
        sw[2048 + sg * 64 + lane] = ok ? d2 * scale : -1e30f;
        sw[3072 + sg * 64 + lane] = ok ? d3 * scale : -1e30f;
    }
    wave_sync();
    const int n = nseg * 64;
#pragma unroll
    for (int g = 0; g < 4; ++g) {
        float mx = -1e30f;
        for (int i = lane; i < n; i += 64) mx = fmaxf(mx, sw[g * 1024 + i]);
        mx = wave_max(mx);
        float sm = 0.f;
        for (int i = lane; i < n; i += 64) { const float v = sw[g * 1024 + i]; sm += (v > -1e29f) ? expf(v - mx) : 0.f; }
        sm = wave_sum(sm);
        const float inv = sm > 0.f ? 1.f / sm : 0.f;
        for (int i = lane; i < n; i += 64) { const float v = sw[g * 1024 + i]; sw[g * 1024 + i] = (v > -1e29f) ? expf(v - mx) * inv : 0.f; }
    }
    wave_sync();
    float o[4][2];
#pragma unroll
    for (int g = 0; g < 4; ++g) { o[g][0] = 0.f; o[g][1] = 0.f; }
    for (int sg = 0; sg < nseg; ++sg) {
        const int start = segs[sg], len = segs[16 + sg];
        for (int l = 0; l < len; ++l) {
            const float* vp = Vb + (size_t)(start + l) * ld;
            if (SHARED) {
                const float v0 = vp[lane], v1 = vp[lane + 64];
#pragma unroll
                for (int g = 0; g < 4; ++g) { const float p = sw[g * 1024 + sg * 64 + l]; o[g][0] += p * v0; o[g][1] += p * v1; }
            } else {
#pragma unroll
                for (int g = 0; g < 4; ++g) { const float p = sw[g * 1024 + sg * 64 + l]; o[g][0] += p * vp[g * 128 + lane]; o[g][1] += p * vp[g * 128 + lane + 64]; }
            }
        }
    }
#pragma unroll
    for (int g = 0; g < 4; ++g) { optr[g * 128 + lane] = o[g][0]; optr[g * 128 + lane + 64] = o[g][1]; }
}

namespace g8 {
constexpr int BM = 256, BK = 64, HALF = 128, HTB = HALF * BK * 2, STAGE_BYTES = 8 * HTB;
constexpr int KK = 2048;
typedef float f32x4 __attribute__((ext_vector_type(4)));
__device__ __forceinline__ int lds_byte(int r, int c) { const int st = (r >> 4) * 2 + (c >> 5), rr = r & 15, cc = c & 31, ob = rr * 64 + cc * 2; return st * 1024 + (ob ^ (((ob >> 9) & 1) << 5)); }
__device__ __forceinline__ void stage_rc(int b, int& R, int& C) { const int st = b / 1024, sb = b % 1024, swz = sb ^ (((sb >> 9) & 1) << 5); R = (st >> 1) * 16 + swz / 64; C = (st & 1) * 32 + (swz % 64) / 2; }
__device__ __forceinline__ int perm32(int rho) { const int n = rho >> 4, i = rho & 15; return 8 * (i >> 2) + 4 * n + (i & 3); }

struct Unit { int m0, n0, e, cnt, rbase; };

__device__ __forceinline__ void tile_order(int L, int nM, int nN, int& pm, int& pn) {
    const int nwg = nM * nN; int wgid = L;
    { const int q = nwg / 8, r = nwg % 8, xcd = wgid % 8, off = wgid / 8; wgid = (xcd < r ? xcd * (q + 1) : r * (q + 1) + (xcd - r) * q) + off; }
    const int nig = 8 * nN, gid = wgid / nig, fm = gid * 8, gsz = (nM - fm) < 8 ? (nM - fm) : 8;
    pm = fm + ((wgid % nig) % gsz); pn = (wgid % nig) / gsz;
}

template <class Prob>
__device__ __forceinline__ void gemm_phase(LAS unsigned char* lds, const Prob& P) {
    const int tid = threadIdx.x, wid = __builtin_amdgcn_readfirstlane(tid >> 6), lane = tid & 63, wr = wid >> 2, wc = wid & 3, fr = lane & 15, fq = lane >> 4;
    constexpr int K = KK, nt = K / BK;
    int sR[2], sC2[2]; unsigned voffB[2];
#pragma unroll
    for (int i = 0; i < 2; ++i) { int R, C; stage_rc(tid * 16 + i * 8192, R, C); sR[i] = R; sC2[i] = C * 2; const int Rb = Prob::PERM ? ((R & ~31) + perm32(R & 31)) : R; voffB[i] = (unsigned)(Rb * K + C) * 2u; }
    const size_t kstep = (size_t)(BK * 2);
    const size_t hstep = (size_t)HALF * K * 2;
    const unsigned ldsw = (unsigned)wid * 1024u;
    const int aoff = lds_byte(wr * 64 + fr, fq * 8), boff = lds_byte(wc * 32 + fr, fq * 8);
#define G8_SA(b, h) (((b) * 2 + (h)) * HTB)
#define G8_SB(b, h) ((4 + (b) * 2 + (h)) * HTB)
#define G8_STAGE(bufoff, gbase, voff) do { _Pragma("unroll") for (int _i = 0; _i < 2; ++_i) \
        __builtin_amdgcn_global_load_lds((const unsigned*)((const char*)(gbase) + (voff)[_i]), (LAS unsigned*)(lds + (bufoff) + ldsw + _i * 8192), 16, 0, 0); } while (0)
#define G8_LDA(dst, b, h) do { _Pragma("unroll") for (int m = 0; m < 4; ++m) _Pragma("unroll") for (int k = 0; k < 2; ++k) dst[m][k] = *(const LAS h8*)(lds + G8_SA(b, h) + aoff + m * 2048 + k * 1024); } while (0)
#define G8_LDB(dst, b, h) do { _Pragma("unroll") for (int n = 0; n < 2; ++n) _Pragma("unroll") for (int k = 0; k < 2; ++k) dst[n][k] = *(const LAS h8*)(lds + G8_SB(b, h) + boff + n * 2048 + k * 1024); } while (0)
#define G8_MMA(ai, bj, At, Bt) do { __builtin_amdgcn_s_setprio(1); _Pragma("unroll") for (int m = 0; m < 4; ++m) _Pragma("unroll") for (int n = 0; n < 2; ++n) _Pragma("unroll") for (int k = 0; k < 2; ++k) \
        acc[ai][bj][m][n] = __builtin_amdgcn_mfma_f32_16x16x32_f16(Bt[n][k], At[m][k], acc[ai][bj][m][n], 0, 0, 0); __builtin_amdgcn_s_setprio(0); } while (0)
#define G8_WAIT_V(n) asm volatile("s_waitcnt vmcnt(" #n ")" ::: "memory")
#define G8_WAIT_L(n) asm volatile("s_waitcnt lgkmcnt(" #n ")" ::: "memory")
#define G8_BAR __builtin_amdgcn_s_barrier()
#define G8_SCHED __builtin_amdgcn_sched_barrier(0)
    Unit cur, nxt; int ui = 0;
    if (!P.next(0, cur)) return;
    f32x4 acc[2][2][4][2];
#pragma unroll
    for (int a = 0; a < 2; ++a)
#pragma unroll
        for (int b = 0; b < 2; ++b)
#pragma unroll
            for (int m = 0; m < 4; ++m)
#pragma unroll
                for (int n = 0; n < 2; ++n) acc[a][b][m][n] = (f32x4){0.f, 0.f, 0.f, 0.f};
    h8 At[4][2], B0[2][2], B1[2][2];
    unsigned vc[2][2], vn[2][2];
    P.a_offs(cur, sR, sC2, vc);
    const char* const Ab = P.a_base();
    const char* cB = P.b_base(cur);
    G8_STAGE(G8_SB(0, 0), cB, voffB); G8_STAGE(G8_SA(0, 0), Ab, vc[0]); G8_STAGE(G8_SB(0, 1), cB + hstep, voffB); G8_STAGE(G8_SA(0, 1), Ab, vc[1]);
    if (wr == 1) G8_BAR;
    G8_WAIT_V(4); G8_BAR;
    G8_STAGE(G8_SB(1, 0), cB + kstep, voffB); G8_STAGE(G8_SA(1, 0), Ab + kstep, vc[0]); G8_STAGE(G8_SB(1, 1), cB + hstep + kstep, voffB);
    G8_WAIT_V(6); G8_BAR;
    for (;;) {
        const bool has_next = P.next(ui + 1, nxt);
        const char* nB = cB;
        if (has_next) { P.a_offs(nxt, sR, sC2, vn); nB = P.b_base(nxt); }
        else { vn[0][0] = vc[0][0]; vn[0][1] = vc[0][1]; vn[1][0] = vc[1][0]; vn[1][1] = vc[1][1]; }
        for (int t = 0; t < nt; t += 2) {
            const bool last = (t == nt - 2);
            const char* a1 = Ab + (size_t)(t + 1) * kstep;
            const char* a2 = last ? Ab : Ab + (size_t)(t + 2) * kstep; const char* b2 = last ? nB : cB + (size_t)(t + 2) * kstep;
            const char* a3 = a2 + kstep; const char* b3 = b2 + kstep;
            unsigned o2[2][2];
            o2[0][0] = last ? vn[0][0] : vc[0][0]; o2[0][1] = last ? vn[0][1] : vc[0][1]; o2[1][0] = last ? vn[1][0] : vc[1][0]; o2[1][1] = last ? vn[1][1] : vc[1][1];
            G8_LDB(B0, 0, 0); G8_SCHED; G8_LDA(At, 0, 0); G8_STAGE(G8_SA(1, 1), a1, vc[1]);
            G8_WAIT_L(8); G8_BAR; G8_WAIT_L(0); G8_MMA(0, 0, At, B0); G8_BAR; G8_SCHED;
            G8_LDB(B1, 0, 1); G8_STAGE(G8_SB(0, 0), b2, voffB);
            G8_BAR; G8_WAIT_L(0); G8_MMA(0, 1, At, B1); G8_BAR;
            G8_LDA(At, 0, 1); G8_STAGE(G8_SA(0, 0), a2, o2[0]);
            G8_BAR; G8_WAIT_L(0); G8_MMA(1, 0, At, B0); G8_BAR; G8_SCHED;
            G8_STAGE(G8_SB(0, 1), b2 + hstep, voffB);
            G8_WAIT_V(6); G8_BAR; G8_MMA(1, 1, At, B1); G8_BAR;
            G8_LDB(B0, 1, 0); G8_SCHED; G8_LDA(At, 1, 0); G8_STAGE(G8_SA(0, 1), a2, o2[1]);
            G8_WAIT_L(8); G8_BAR; G8_WAIT_L(0); G8_MMA(0, 0, At, B0); G8_BAR; G8_SCHED;
            G8_LDB(B1, 1, 1); G8_STAGE(G8_SB(1, 0), b3, voffB);
            G8_BAR; G8_WAIT_L(0); G8_MMA(0, 1, At, B1); G8_BAR;
            G8_LDA(At, 1, 1); G8_STAGE(G8_SA(1, 0), a3, o2[0]);
            G8_BAR; G8_WAIT_L(0); G8_MMA(1, 0, At, B0); G8_BAR; G8_SCHED;
            G8_STAGE(G8_SB(1, 1), b3 + hstep, voffB);
            G8_WAIT_V(6); G8_BAR; G8_MMA(1, 1, At, B1); G8_BAR;
        }
        P.epi(acc, cur, wr, wc, fr, fq);
        if (!has_next) break;
#pragma unroll
        for (int a = 0; a < 2; ++a)
#pragma unroll
            for (int b = 0; b < 2; ++b)
#pragma unroll
                for (int m = 0; m < 4; ++m)
#pragma unroll
                    for (int n = 0; n < 2; ++n) acc[a][b][m][n] = (f32x4){0.f, 0.f, 0.f, 0.f};
        cur = nxt; cB = nB; ++ui;
        vc[0][0] = vn[0][0]; vc[0][1] = vn[0][1]; vc[1][0] = vn[1][0]; vc[1][1] = vn[1][1];
    }
    G8_WAIT_V(0);
    if (wr == 0) G8_BAR;
    G8_BAR;
#undef G8_SA
#undef G8_SB
#undef G8_STAGE
#undef G8_LDA
#undef G8_LDB
#undef G8_MMA
#undef G8_WAIT_V
#undef G8_WAIT_L
#undef G8_BAR
#undef G8_SCHED
}

struct ProbIn {
    static constexpr bool PERM = false;
    const _Float16* A; const _Float16* Bt; float* C; int G, c;
    __device__ __forceinline__ bool next(int i, Unit& u) const { const int L = i * G + c; if (L >= 64 * 15) return false; int pm, pn; tile_order(L, 64, 15, pm, pn); u.m0 = pm * 256; u.n0 = pn * 256; u.e = 0; u.cnt = 256; u.rbase = 0; return true; }
    __device__ __forceinline__ void a_offs(const Unit& u, const int (&R)[2], const int (&C2)[2], unsigned (&v)[2][2]) const {
#pragma unroll
        for (int h = 0; h < 2; ++h)
#pragma unroll
            for (int i = 0; i < 2; ++i) v[h][i] = (unsigned)(u.m0 + h * 128 + R[i]) * (unsigned)(KK * 2) + (unsigned)C2[i]; }
    __device__ __forceinline__ const char* a_base() const { return (const char*)A; }
    __device__ __forceinline__ const char* b_base(const Unit& u) const { return (const char*)(Bt + (size_t)u.n0 * KK); }
    __device__ __forceinline__ void epi(const f32x4 (&acc)[2][2][4][2], const Unit& u, int wr, int wc, int fr, int fq) const {
#pragma unroll
        for (int ai = 0; ai < 2; ++ai)
#pragma unroll
            for (int m = 0; m < 4; ++m) { const int row = u.m0 + ai * 128 + wr * 64 + m * 16 + fr;
#pragma unroll
                for (int bj = 0; bj < 2; ++bj)
#pragma unroll
                    for (int n = 0; n < 2; ++n) { const int col = u.n0 + bj * 128 + wc * 32 + n * 16 + fq * 4;
                        if (col < INW) *(f32x4*)(C + (size_t)row * INW + col) = acc[ai][bj][m][n]; } } }
};
struct ProbOut {
    static constexpr bool PERM = false;
    const _Float16* A; const _Float16* Bt; float* C; const float* X; int G, c;
    __device__ __forceinline__ bool next(int i, Unit& u) const { const int L = i * G + c; if (L >= 64 * 8) return false; int pm, pn; tile_order(L, 64, 8, pm, pn); u.m0 = pm * 256; u.n0 = pn * 256; u.e = 0; u.cnt = 256; u.rbase = 0; return true; }
    __device__ __forceinline__ void a_offs(const Unit& u, const int (&R)[2], const int (&C2)[2], unsigned (&v)[2][2]) const {
#pragma unroll
        for (int h = 0; h < 2; ++h)
#pragma unroll
            for (int i = 0; i < 2; ++i) v[h][i] = (unsigned)(u.m0 + h * 128 + R[i]) * (unsigned)(KK * 2) + (unsigned)C2[i]; }
    __device__ __forceinline__ const char* a_base() const { return (const char*)A; }
    __device__ __forceinline__ const char* b_base(const Unit& u) const { return (const char*)(Bt + (size_t)u.n0 * KK); }
    __device__ __forceinline__ void epi(const f32x4 (&acc)[2][2][4][2], const Unit& u, int wr, int wc, int fr, int fq) const {
#pragma unroll
        for (int ai = 0; ai < 2; ++ai)
#pragma unroll
            for (int m = 0; m < 4; ++m) { const int row = u.m0 + ai * 128 + wr * 64 + m * 16 + fr;
#pragma unroll
                for (int bj = 0; bj < 2; ++bj)
#pragma unroll
                    for (int n = 0; n < 2; ++n) { const size_t o = (size_t)row * 2048 + u.n0 + bj * 128 + wc * 32 + n * 16 + fq * 4;
                        const f32x4 xv = *(const f32x4*)(X + o); *(f32x4*)(C + o) = xv * DN_ALPHA + acc[ai][bj][m][n]; } } }
};
struct MoeTab { const LAS int* t; int NT;
    __device__ __forceinline__ bool find(int L, Unit& u) const {
        const int total = __builtin_amdgcn_readfirstlane(t[98]); if (L >= total) return false;
        int e = 0;
        for (; e < NE - 1; ++e) { if (L < __builtin_amdgcn_readfirstlane(t[32 + e + 1])) break; }
        const int ub = __builtin_amdgcn_readfirstlane(t[32 + e]), cn = __builtin_amdgcn_readfirstlane(t[e]), rs = __builtin_amdgcn_readfirstlane(t[65 + e]);
        const int nm = (cn + 255) >> 8, v = L - ub, mt = v % nm, ntile = v / nm;
        u.e = e; u.m0 = mt * 256; u.n0 = ntile * 256; u.cnt = min(256, cn - mt * 256); u.rbase = rs; return true; } };
struct ProbGu {
    static constexpr bool PERM = true;
    const _Float16* A; const _Float16* Bt; _Float16* act; const float* bgu; const int* list; MoeTab tab; int G, vcu;
    __device__ __forceinline__ bool next(int i, Unit& u) const { return tab.find(i * G + vcu, u); }
    __device__ __forceinline__ void a_offs(const Unit& u, const int (&R)[2], const int (&C2)[2], unsigned (&v)[2][2]) const {
#pragma unroll
        for (int h = 0; h < 2; ++h)
#pragma unroll
            for (int i = 0; i < 2; ++i) { int r = h * 128 + R[i]; r = r < u.cnt ? r : 0; const int a = list[(size_t)u.e * T_ + u.m0 + r]; v[h][i] = (unsigned)(a >> 2) * (unsigned)(KK * 2) + (unsigned)C2[i]; } }
    __device__ __forceinline__ const char* a_base() const { return (const char*)A; }
    __device__ __forceinline__ const char* b_base(const Unit& u) const { return (const char*)(Bt + ((size_t)u.e * 4096 + u.n0) * KK); }
    __device__ __forceinline__ void epi(const f32x4 (&acc)[2][2][4][2], const Unit& u, int wr, int wc, int fr, int fq) const {
        const float* bb = bgu + (size_t)u.e * 4096;
#pragma unroll
        for (int bj = 0; bj < 2; ++bj) { const int col = u.n0 + bj * 128 + wc * 32 + fq * 8;
            const f32x4 b0 = *(const f32x4*)(bb + col), b1 = *(const f32x4*)(bb + col + 4);
#pragma unroll
            for (int ai = 0; ai < 2; ++ai)
#pragma unroll
                for (int m = 0; m < 4; ++m) { const int rl = ai * 128 + wr * 64 + m * 16 + fr;
                    if (rl < u.cnt) { const f32x4 v0 = acc[ai][bj][m][0] + b0, v1 = acc[ai][bj][m][1] + b1;
                        h4 o;
                        { const float xg = fminf(v0[0], 7.f), xl = fminf(fmaxf(v0[1], -7.f), 7.f); o[0] = (_Float16)(xg * sigmoidf_(1.702f * xg) * (xl + 1.f)); }
                        { const float xg = fminf(v0[2], 7.f), xl = fminf(fmaxf(v0[3], -7.f), 7.f); o[1] = (_Float16)(xg * sigmoidf_(1.702f * xg) * (xl + 1.f)); }
                        { const float xg = fminf(v1[0], 7.f), xl = fminf(fmaxf(v1[1], -7.f), 7.f); o[2] = (_Float16)(xg * sigmoidf_(1.702f * xg) * (xl + 1.f)); }
                        { const float xg = fminf(v1[2], 7.f), xl = fminf(fmaxf(v1[3], -7.f), 7.f); o[3] = (_Float16)(xg * sigmoidf_(1.702f * xg) * (xl + 1.f)); }
                        *(h4*)(act + (size_t)(u.rbase + u.m0 + rl) * 2048 + (col >> 1)) = o; } } } }
};
struct ProbDn {
    static constexpr bool PERM = true;
    const _Float16* A; const _Float16* Bt; _Float16* y; const float* bdn; const int* list; const float* gate; MoeTab tab; int G, vcu;
    __device__ __forceinline__ bool next(int i, Unit& u) const { return tab.find(i * G + vcu, u); }
    __device__ __forceinline__ void a_offs(const Unit& u, const int (&R)[2], const int (&C2)[2], unsigned (&v)[2][2]) const {
#pragma unroll
        for (int h = 0; h < 2; ++h)
#pragma unroll
            for (int i = 0; i < 2; ++i) v[h][i] = (unsigned)(u.rbase + u.m0 + h * 128 + R[i]) * (unsigned)(KK * 2) + (unsigned)C2[i]; }
    __device__ __forceinline__ const char* a_base() const { return (const char*)A; }
    __device__ __forceinline__ const char* b_base(const Unit& u) const { return (const char*)(Bt + ((size_t)u.e * 2048 + u.n0) * KK); }
    __device__ __forceinline__ void epi(const f32x4 (&acc)[2][2][4][2], const Unit& u, int wr, int wc, int fr, int fq) const {
        const float* bb = bdn + (size_t)u.e * 2048;
#pragma unroll
        for (int ai = 0; ai < 2; ++ai)
#pragma unroll
            for (int m = 0; m < 4; ++m) { const int rl = ai * 128 + wr * 64 + m * 16 + fr;
                if (rl < u.cnt) { const int a = list[(size_t)u.e * T_ + u.m0 + rl]; const float g = gate[a];
#pragma unroll
                    for (int bj = 0; bj < 2; ++bj) { const int col = u.n0 + bj * 128 + wc * 32 + fq * 8;
                        const f32x4 v0 = (acc[ai][bj][m][0] + *(const f32x4*)(bb + col)) * g, v1 = (acc[ai][bj][m][1] + *(const f32x4*)(bb + col + 4)) * g;
                        h8 o; o[0] = (_Float16)v0[0]; o[1] = (_Float16)v0[1]; o[2] = (_Float16)v0[2]; o[3] = (_Float16)v0[3]; o[4] = (_Float16)v1[0]; o[5] = (_Float16)v1[1]; o[6] = (_Float16)v1[2]; o[7] = (_Float16)v1[3];
                        *(h8*)(y + (size_t)a * 2048 + col) = o; } } } }
};
}

__device__ __forceinline__ void conv_tile(float* lds, const float* __restrict__ W, int ldw, int nvalid, _Float16* __restrict__ Wt, int K, int k0, int n0) {
    const int tid = threadIdx.x;
    float4 v[8];
#pragma unroll
    for (int i = 0; i < 8; ++i) { const int idx = tid + 512 * i, r = idx >> 6, c4 = (idx & 63) * 4;
        v[i] = (n0 + c4 < nvalid) ? *(const float4*)(W + (size_t)(k0 + r) * ldw + n0 + c4) : make_float4(0.f, 0.f, 0.f, 0.f); }
#pragma unroll
    for (int i = 0; i < 8; ++i) { const int idx = tid + 512 * i, r = idx >> 6, c4 = (idx & 63) * 4; float* d = lds + r * 257 + c4; d[0] = v[i].x; d[1] = v[i].y; d[2] = v[i].z; d[3] = v[i].w; }
    __syncthreads();
#pragma unroll
    for (int j = 0; j < 4; ++j) { const int id = tid + 512 * j, n = id >> 3, k8 = (id & 7) * 8; h8 o;
#pragma unroll
        for (int q = 0; q < 8; ++q) o[q] = (_Float16)lds[(k8 + q) * 257 + n];
        *(h8*)(Wt + (size_t)(n0 + n) * K + k0 + k8) = o; }
    __syncthreads();
}

__global__ void __launch_bounds__(512, 2) fwd(Params p) {
    extern __shared__ __attribute__((aligned(16))) char smem[];
    const int tid = threadIdx.x, lane = tid & 63, wv = tid >> 6;
    const int bid = blockIdx.x, nb = gridDim.x;
    const int gw = bid * 8 + wv, nw = nb * 8;
    const int lo = (int)(p.lo_hi & 0xffffffffll), hi = (int)(p.lo_hi >> 32);
    unsigned char* ws = p.ws;
    unsigned* ctl = (unsigned*)(ws + WS_CTL);
    int* cnt = (int*)(ws + CTL_CNT);
    float* proj = (float*)(ws + WS_PROJ);
    float* kvmem = (float*)(ws + WS_KVMEM);
    float* bias1 = (float*)(ws + WS_BIAS1);
    float* hid = (float*)(ws + WS_HID);
    float* kc = (float*)(ws + WS_KC);
    float* vc = (float*)(ws + WS_VC);
    float* pooled = (float*)(ws + WS_POOLED);
    float* opool = (float*)(ws + WS_OPOOL);
    float* owin = (float*)(ws + WS_OWIN);
    float* ocmp = (float*)(ws + WS_OCMP);
    float* oslc = (float*)(ws + WS_OSLC);
    unsigned* sel = (unsigned*)(ws + WS_SEL);
    float* omem = (float*)(ws + WS_OMEM);
    _Float16* cat16 = (_Float16*)(ws + WS_CAT16);
    float* hpre = (float*)(ws + WS_HPRE);
    float* hbuf = (float*)(ws + WS_H);
    float* gate = (float*)(ws + WS_GATE);
    int* list = (int*)(ws + WS_LIST);
    _Float16* act16 = (_Float16*)(ws + WS_ACT16);
    _Float16* y16 = (_Float16*)(ws + WS_Y16);
    _Float16* h16 = (_Float16*)(ws + WS_H16);
    _Float16* x16 = (_Float16*)(ws + WS_X16);
    _Float16* wtin = (_Float16*)(ws + WS_WTIN);
    _Float16* wtout = (_Float16*)(ws + WS_WTOUT);
    _Float16* wtgu = (_Float16*)(ws + WS_WTGU);
    _Float16* wtdn = (_Float16*)(ws + WS_WTDN);
    LAS unsigned char* lds = (LAS unsigned char*)smem;
    const int vcu = (nb % 8 == 0) ? (bid % 8) * (nb / 8) + bid / 8 : bid;

    volatile LAS unsigned* xbw = (volatile LAS unsigned*)(smem + LDS_BYTES - 16);
    if (tid == 0) { xbw[0] = 0u; xbw[1] = 0u; xbw[2] = 0u; xbw[3] = 0u; }
    __syncthreads();
    XcdBarrier bar; bar.bar = ctl; bar.x = 0; bar.st = xbw;
    const bool multi = (hi - lo) > 1;
    if (multi) bar = xcd_barrier_post(ctl, xbw);
#define IN(k) (lo <= (k) && (k) < hi)
#define SEAM(k) do { if (IN(k) && IN((k) + 1)) xcd_barrier(bar); } while (0)
    float* sw = (float*)smem + wv * WLDS_FLOATS;
    int* segw = (int*)(sw + 4096 + 512);

    if (IN(0)) {
        for (int j = gw; j < 512; j += nw) {
            const int kv = j >> 8, jj = j & 255;
            const float* pos = p.in[kv ? I_POSV : I_POSK]; const float* w1 = p.in[kv ? I_W1V : I_W1K];
            float s = 0.f;
            for (int k = lane; k < 4096; k += 64) s += pos[k] * w1[(size_t)k * 256 + jj];
            s = wave_sum(s);
            if (lane == 0) bias1[j] = s;
        }
        for (size_t i = (size_t)bid * 512 + tid; i < (size_t)T_ * 2048 / 4; i += (size_t)nb * 512) {
            const float4 v = ((const float4*)p.in[I_X])[i]; ((h4*)x16)[i] = (h4){(_Float16)v.x, (_Float16)v.y, (_Float16)v.z, (_Float16)v.w};
        }
        {
            constexpr int U_GU = NE * 32 * 16, U_DN = NE * 32 * 8, U_IN = 32 * 15, U_OUT = 32 * 8;
            for (int u = bid; u < U_GU + U_DN + U_IN + U_OUT; u += nb) {
                if (u < U_GU) { const int e = u / 512, r = u % 512, kt = r / 16, ntl = r % 16;
                    conv_tile((float*)smem, p.in[I_WGU] + (size_t)e * 2048 * 4096, 4096, 4096, wtgu + (size_t)e * 4096 * 2048, 2048, kt * 64, ntl * 256);
                } else if (u < U_GU + U_DN) { const int v = u - U_GU, e = v / 256, r = v % 256, kt = r / 8, ntl = r % 8;
                    conv_tile((float*)smem, p.in[I_WDN] + (size_t)e * 2048 * 2048, 2048, 2048, wtdn + (size_t)e * 2048 * 2048, 2048, kt * 64, ntl * 256);
                } else if (u < U_GU + U_DN + U_IN) { const int v = u - U_GU - U_DN, kt = v / 15, ntl = v % 15;
                    conv_tile((float*)smem, p.in[I_WIN], INW, INW, wtin, 2048, kt * 64, ntl * 256);
                } else { const int v = u - U_GU - U_DN - U_IN, kt = v / 8, ntl = v % 8;
                    conv_tile((float*)smem, p.in[I_WOUT], 2048, 2048, wtout, 2048, kt * 64, ntl * 256);
                }
            }
        }
        for (int u = bid; u < 16 * 8; u += nb) { const int nt = u / 16, mt = u % 16;
            ARowPlain af{p.in[I_MEM], 2048, mt * 128, 2048}; EpiStore ef{kvmem, 1024, mt * 128, nt * 128, 2048, 1024};
            gemm_tile(smem, 2048, af, p.in[I_WMEMKV], 1024, nt * 128, 1024, false, ef);
        }
    }
    SEAM(0);
    if (IN(1)) {
        g8::ProbIn P{x16, wtin, proj, nb, bid};
        g8::gemm_phase(lds, P);
    }
    SEAM(1);
    if (IN(2)) {
        for (int u = bid; u < 64; u += nb) { const int kv = u >> 5, r = u & 31, nt = r >> 4, mt = r & 15;
            ARowCmp af{proj, kv ? C_VC : C_KC, mt * 128}; EpiHid ef{hid + (size_t)kv * 2048 * 256, bias1 + kv * 256, mt * 128, nt * 128};
            gemm_tile(smem, 4096, af, p.in[kv ? I_W1V : I_W1K], 256, nt * 128, 256, false, ef);
        }
        for (size_t i = (size_t)bid * 512 + tid; i < (size_t)T_ * 512; i += (size_t)nb * 512) {
            const int col = (int)(i & 511), row = (int)(i >> 9), t = row & (S_ - 1), g = col >> 7;
            const int win = 2 << g; const int lo_t = max(t + 1 - win, 0); const int n = t + 1 - lo_t;
            float s = 0.f;
            for (int k = 0; k < n; ++k) s += proj[(size_t)(row - k) * INW + C_UP + col];
            pooled[i] = s / (float)n - proj[(size_t)row * INW + C_UP + col];
        }
        for (int u = gw; u < T_ * 2; u += nw) {
            const int kvh = u & 1, row = u >> 1, b = row >> 11, t = row & (S_ - 1);
            const int lo_t = max(0, t - 511), n = t + 1 - lo_t, nseg = (n + 63) >> 6;
            if (lane < 16) { segw[lane] = lo_t + 64 * lane; segw[16 + lane] = min(64, n - 64 * lane); }
            wave_sync();
            wave_attn<true>(sw, proj + (size_t)row * INW + C_Q + kvh * 512, proj + (size_t)b * S_ * INW + C_KW + kvh * 128, proj + (size_t)b * S_ * INW + C_VW + kvh * 128,
                            INW, nseg, ATT_SCALE, owin + (size_t)row * 1024 + kvh * 512);
            wave_sync();
        }
        for (int u = gw; u < T_; u += nw) {
            const int row = u, b = row >> 11;
            if (lane < 16) { segw[lane] = 64 * lane; segw[16 + lane] = 64; }
            wave_sync();
            wave_attn<false>(sw, proj + (size_t)row * INW + C_QM, kvmem + (size_t)b * 256 * 1024, kvmem + (size_t)b * 256 * 1024 + 512, 1024, 4, ATT_SCALE, omem + (size_t)row * 512);
            wave_sync();
        }
    }
    SEAM(2);
    if (IN(3)) {
        for (size_t i = (size_t)bid * 512 + tid; i < (size_t)2 * CROWS * 128; i += (size_t)nb * 512) {
            const int kv = (int)(i / ((size_t)CROWS * 128)); const int r = (int)(i % ((size_t)CROWS * 128)); const int row = r >> 7, d = r & 127;
            const float* hr = hid + (size_t)kv * 2048 * 256 + (size_t)row * 256; const float* w2 = p.in[kv ? I_W2V : I_W2K];
            float s = 0.f;
            for (int k = 0; k < 256; ++k) s += hr[k] * w2[k * 128 + d];
            (kv ? vc : kc)[(size_t)row * 128 + d] = s;
        }
        for (size_t i = (size_t)bid * 512 + tid; i < (size_t)T_ * 512; i += (size_t)nb * 512) {
            const int col = (int)(i & 511), row = (int)(i >> 9), g = col >> 7, d = col & 127;
            const float* pr = pooled + (size_t)row * 512 + g * 128; const float* w = p.in[I_POOLW] + (size_t)g * 128 * 128;
            float s = 0.f;
            for (int c = 0; c < 128; ++c) s += pr[c] * w[c * 128 + d];
            opool[i] = s * p.in[I_POOLS][col];
        }
    }
    SEAM(3);
    if (IN(4)) {
        for (int u = gw; u < T_ * 2; u += nw) {
            const int kvh = u & 1, row = u >> 1, b = row >> 11, t = row & (S_ - 1);
            const int nvalid = t >= 31 ? min(NC, (t - 31) / 16 + 1) : 0, nseg = (nvalid + 63) >> 6;
            if (lane < 16) { segw[lane] = 64 * lane; segw[16 + lane] = min(64, nvalid - 64 * lane); }
            wave_sync();
            wave_attn<true>(sw, proj + (size_t)row * INW + C_Q + kvh * 512, kc + (size_t)b * NC * 256 + kvh * 128, vc + (size_t)b * NC * 256 + kvh * 128, 256, nseg, ATT_SCALE,
                            ocmp + (size_t)row * 1024 + kvh * 512);
            wave_sync();
            float* ps = sw + 4096;
            const int n = nseg * 64;
            ps[lane] = lane < n ? sw[lane] + sw[1024 + lane] + sw[2048 + lane] + sw[3072 + lane] : 0.f;
            ps[lane + 64] = (lane + 64) < n ? sw[lane + 64] + sw[1024 + lane + 64] + sw[2048 + lane + 64] + sw[3072 + lane + 64] : 0.f;
            wave_sync();
            const int j = lane & 31, cur = t >> 6;
            float imp = 0.f;
#pragma unroll
            for (int dc = -1; dc <= 3; ++dc) { const int c = 4 * j + dc; if (c >= 0 && c < NC) imp += ps[c] * ((dc == -1 || dc == 3) ? 1.f : 2.f); }
            const bool forced = (j == 0) || (j == cur) || (j == cur - 1), valid = j <= cur;
            const float iv = forced ? 1e9f : (valid ? imp : -1e9f);
            int rank = 0;
            for (int i = 0; i < 32; ++i) { const float vi = __shfl(iv, i); rank += (vi > iv || (vi == iv && i < j)) ? 1 : 0; }
            const unsigned long long bal = __ballot(lane < 32 && rank < 16 && valid);
            if (lane == 0) sel[u] = (unsigned)bal;
            wave_sync();
        }
    }
    SEAM(4);
    if (IN(5)) {
        for (int u = gw; u < T_ * 2; u += nw) {
            const int kvh = u & 1, row = u >> 1, b = row >> 11, t = row & (S_ - 1);
            const unsigned m = __hip_atomic_load(&sel[u], __ATOMIC_RELAXED, __HIP_MEMORY_SCOPE_AGENT);
            const int nseg = __popc(m);
            if (lane < 32 && ((m >> lane) & 1u)) { const int pos = __popc(m & ((1u << lane) - 1u)); segw[pos] = 64 * lane; segw[16 + pos] = min(64, t + 1 - 64 * lane); }
            wave_sync();
            wave_attn<true>(sw, proj + (size_t)row * INW + C_Q + kvh * 512, proj + (size_t)b * S_ * INW + C_KS + kvh * 128, proj + (size_t)b * S_ * INW + C_VS + kvh * 128,
                            INW, nseg, ATT_SCALE, oslc + (size_t)row * 1024 + kvh * 512);
            wave_sync();
        }
    }
    SEAM(5);
    if (IN(6)) {
        for (int row = gw; row < T_; row += nw) {
            const float* pr = proj + (size_t)row * INW;
            float v[16]; float ss = 0.f;
#pragma unroll
            for (int i = 0; i < 16; ++i) { const int col = lane + 64 * i, h = col >> 7; const size_t o = (size_t)row * 1024 + col;
                const float g0 = sigmoidf_(pr[C_G + h * 3]), g1 = sigmoidf_(pr[C_G + h * 3 + 1]), g2 = sigmoidf_(pr[C_G + h * 3 + 2]);
                v[i] = g0 * ocmp[o] + g1 * oslc[o] + g2 * owin[o]; ss += v[i] * v[i]; }
            ss = wave_sum(ss); float r = rsqrtf(ss / 1024.f + LN_EPS);
#pragma unroll
            for (int i = 0; i < 16; ++i) { const int col = lane + 64 * i; cat16[(size_t)row * 2048 + col] = (_Float16)(v[i] * r * p.in[I_GNNSA][col]); }
            ss = 0.f;
#pragma unroll
            for (int i = 0; i < 8; ++i) { v[i] = opool[(size_t)row * 512 + lane + 64 * i]; ss += v[i] * v[i]; }
            ss = wave_sum(ss); r = rsqrtf(ss / 512.f + LN_EPS);
#pragma unroll
            for (int i = 0; i < 8; ++i) { const int col = lane + 64 * i; cat16[(size_t)row * 2048 + 1024 + col] = (_Float16)(v[i] * r * p.in[I_GNPOOL][col]); }
            ss = 0.f;
#pragma unroll
            for (int i = 0; i < 8; ++i) { v[i] = omem[(size_t)row * 512 + lane + 64 * i]; ss += v[i] * v[i]; }
            ss = wave_sum(ss); r = rsqrtf(ss / 512.f + LN_EPS);
#pragma unroll
            for (int i = 0; i < 8; ++i) { const int col = lane + 64 * i; cat16[(size_t)row * 2048 + 1536 + col] = (_Float16)(v[i] * r * p.in[I_GNMEM][col]); }
        }
    }
    SEAM(6);
    if (IN(7)) {
        g8::ProbOut P{cat16, wtout, hpre, p.in[I_X], nb, bid};
        g8::gemm_phase(lds, P);
    }
    SEAM(7);
    if (IN(8)) {
        for (int row = gw; row < T_; row += nw) {
            float v[32]; float s = 0.f;
#pragma unroll
            for (int i = 0; i < 32; ++i) { v[i] = hpre[(size_t)row * 2048 + lane + 64 * i]; s += v[i]; }
            const float mu = wave_sum(s) / 2048.f; float q = 0.f;
#pragma unroll
            for (int i = 0; i < 32; ++i) { const float d = v[i] - mu; q += d * d; }
            const float rs = rsqrtf(wave_sum(q) / 2048.f + LN_EPS);
#pragma unroll
            for (int i = 0; i < 32; ++i) { const int col = lane + 64 * i; v[i] = (v[i] - mu) * rs * p.in[I_LN1G][col] + p.in[I_LN1B][col]; hbuf[(size_t)row * 2048 + col] = v[i]; h16[(size_t)row * 2048 + col] = (_Float16)v[i]; }
            float part[32];
#pragma unroll
            for (int e = 0; e < 32; ++e) part[e] = 0.f;
#pragma unroll 1
            for (int i = 0; i < 32; ++i) { const float4* wp = (const float4*)(p.in[I_WR] + (size_t)(lane + 64 * i) * 32); const float hv = hbuf[(size_t)row * 2048 + lane + 64 * i];
#pragma unroll
                for (int q4 = 0; q4 < 8; ++q4) { const float4 w = wp[q4]; part[4 * q4] += hv * w.x; part[4 * q4 + 1] += hv * w.y; part[4 * q4 + 2] += hv * w.z; part[4 * q4 + 3] += hv * w.w; } }
            float mine = 0.f;
#pragma unroll
            for (int e = 0; e < 32; ++e) { const float a = wave_sum(part[e]) + p.in[I_BR][e]; if (lane == e) mine = a; }
            const int j = lane & 31; const float iv = __shfl(mine, j);
            int rank = 0;
            for (int i = 0; i < 32; ++i) { const float vi = __shfl(iv, i); rank += (vi > iv || (vi == iv && i < j)) ? 1 : 0; }
            float tv[4]; int te[4];
#pragma unroll
            for (int r = 0; r < 4; ++r) { const unsigned long long bm = __ballot(lane < 32 && rank == r); const int src = __ffsll((long long)bm) - 1; te[r] = src; tv[r] = __shfl(iv, src); }
            const float mx = tv[0];
            float e0 = expf(tv[0] - mx), e1 = expf(tv[1] - mx), e2 = expf(tv[2] - mx), e3 = expf(tv[3] - mx); const float inv = 1.f / (e0 + e1 + e2 + e3);
            if (lane < 4) { const int e = lane == 0 ? te[0] : lane == 1 ? te[1] : lane == 2 ? te[2] : te[3]; const float g = (lane == 0 ? e0 : lane == 1 ? e1 : lane == 2 ? e2 : e3) * inv;
                const int a = row * 4 + lane; const int pos = atomicAdd(&cnt[e], 1); list[(size_t)e * T_ + pos] = a; gate[a] = g; }
        }
    }
    SEAM(8);
    LAS int* mtab = (LAS int*)(smem + g8::STAGE_BYTES);
    if (IN(9)) {
        if (tid == 0) { int ub = 0, rs = 0;
            for (int e = 0; e < NE; ++e) { const int c = (int)__hip_atomic_load((unsigned*)&cnt[e], __ATOMIC_RELAXED, __HIP_MEMORY_SCOPE_AGENT); mtab[e] = c; mtab[32 + e] = ub; mtab[65 + e] = rs; ub += ((c + 255) >> 8) * 16; rs += c; }
            mtab[64] = ub; mtab[97] = rs; mtab[98] = ub; }
        __syncthreads();
        g8::ProbGu P{h16, wtgu, act16, p.in[I_BGU], list, g8::MoeTab{mtab, 16}, nb, vcu};
        g8::gemm_phase(lds, P);
        __syncthreads();
    }
    SEAM(9);
    if (IN(10)) {
        if (tid == 0) { int ub = 0, rs = 0;
            for (int e = 0; e < NE; ++e) { const int c = (int)__hip_atomic_load((unsigned*)&cnt[e], __ATOMIC_RELAXED, __HIP_MEMORY_SCOPE_AGENT); mtab[e] = c; mtab[32 + e] = ub; mtab[65 + e] = rs; ub += ((c + 255) >> 8) * 8; rs += c; }
            mtab[64] = ub; mtab[97] = rs; mtab[98] = ub; }
        __syncthreads();
        g8::ProbDn P{act16, wtdn, y16, p.in[I_BDN], list, gate, g8::MoeTab{mtab, 8}, nb, vcu};
        g8::gemm_phase(lds, P);
        __syncthreads();
    }
    SEAM(10);
    if (IN(11)) {
        for (int row = gw; row < T_; row += nw) {
            float v[32]; float s = 0.f;
#pragma unroll
            for (int c = 0; c < 4; ++c) { const int col = (lane + 64 * c) * 8; const size_t yo = (size_t)row * 4 * 2048 + col;
                const float4 ha = *(const float4*)(hbuf + (size_t)row * 2048 + col), hb = *(const float4*)(hbuf + (size_t)row * 2048 + col + 4);
                const h8 y0 = *(const h8*)(y16 + yo), y1 = *(const h8*)(y16 + yo + 2048), y2 = *(const h8*)(y16 + yo + 4096), y3 = *(const h8*)(y16 + yo + 6144);
                const float hh[8] = {ha.x, ha.y, ha.z, ha.w, hb.x, hb.y, hb.z, hb.w};
#pragma unroll
                for (int q = 0; q < 8; ++q) { v[c * 8 + q] = DN_ALPHA * hh[q] + (((float)y0[q] + (float)y1[q]) + ((float)y2[q] + (float)y3[q])); s += v[c * 8 + q]; } }
            const float mu = wave_sum(s) / 2048.f; float q2 = 0.f;
#pragma unroll
            for (int i = 0; i < 32; ++i) { const float d = v[i] - mu; q2 += d * d; }
            const float rs = rsqrtf(wave_sum(q2) / 2048.f + LN_EPS);
#pragma unroll
            for (int c = 0; c < 4; ++c) { const int col = (lane + 64 * c) * 8;
                const float4 ga = *(const float4*)(p.in[I_LN2G] + col), gb = *(const float4*)(p.in[I_LN2G] + col + 4), ba = *(const float4*)(p.in[I_LN2B] + col), bb = *(const float4*)(p.in[I_LN2B] + col + 4);
                float4 o0, o1;
                o0.x = (v[c * 8 + 0] - mu) * rs * ga.x + ba.x; o0.y = (v[c * 8 + 1] - mu) * rs * ga.y + ba.y; o0.z = (v[c * 8 + 2] - mu) * rs * ga.z + ba.z; o0.w = (v[c * 8 + 3] - mu) * rs * ga.w + ba.w;
                o1.x = (v[c * 8 + 4] - mu) * rs * gb.x + bb.x; o1.y = (v[c * 8 + 5] - mu) * rs * gb.y + bb.y; o1.z = (v[c * 8 + 6] - mu) * rs * gb.z + bb.z; o1.w = (v[c * 8 + 7] - mu) * rs * gb.w + bb.w;
                *(float4*)(p.out + (size_t)row * 2048 + col) = o0; *(float4*)(p.out + (size_t)row * 2048 + col + 4) = o1; }
        }
    }
}

constexpr int NPHASE = 12;

extern "C" void kernel_launch(void* const* d_in, const int* in_sizes, int n_in, void* d_out, int out_size, void* d_ws, size_t ws_size, hipStream_t stream) {
    static int grid = 0;
    if (grid == 0) {
        if (n_in != 26 || ws_size < WS_END) { fprintf(stderr, "kernel_launch: unexpected n_in %d or ws_size %zu (< %zu)\n", n_in, ws_size, (size_t)WS_END); grid = -1; return; }
        int dev = 0, cus = 0, per_cu = 0;
        hipGetDevice(&dev); hipDeviceGetAttribute(&cus, hipDeviceAttributeMultiprocessorCount, dev);
        if (hipFuncSetAttribute((const void*)fwd, hipFuncAttributeMaxDynamicSharedMemorySize, LDS_BYTES) != hipSuccess) { fprintf(stderr, "hipFuncSetAttribute failed\n"); grid = -1; return; }
        hipOccupancyMaxActiveBlocksPerMultiprocessor(&per_cu, (const void*)fwd, 512, LDS_BYTES);
        (void)hipGetLastError();
        if (per_cu < 1) fprintf(stderr, "occupancy query says %d blocks per CU\n", per_cu);
        grid = cus > 0 ? cus : 256;
    }
    if (grid < 0) return;
    hipMemsetAsync((char*)d_ws + WS_CTL, 0, CTL_BYTES, stream);
    Params p{};
    for (int i = 0; i < 26; ++i) p.in[i] = (const float*)d_in[i];
    p.out = (float*)d_out; p.ws = (unsigned char*)d_ws;
#if N_LAUNCH_MODE == 1
    p.lo_hi = (long long)0 | ((long long)NPHASE << 32);
    hipLaunchKernelGGL(fwd, dim3(grid), dim3(512), LDS_BYTES, stream, p);
#else
    for (int ph = 0; ph < NPHASE; ++ph) {
        p.lo_hi = (long long)ph | ((long long)(ph + 1) << 32);
        hipLaunchKernelGGL(fwd, dim3(grid), dim3(512), LDS_BYTES, stream, p);
    }
#endif
}
```

```cpp
#include <hip/hip_runtime.h>
#include <cstdio>
#include <cstdint>

#ifndef N_LAUNCH_MODE
#define N_LAUNCH_MODE 1
#endif

constexpr int B_ = 8, S_ = 2048, D_ = 2048, T_ = B_ * S_;
constexpr int INW = 3608;
constexpr int C_Q = 0, C_KC = 1024, C_VC = 1280, C_KS = 1536, C_VS = 1792, C_KW = 2048, C_VW = 2304, C_G = 2560, C_UP = 2584, C_QM = 3096;
constexpr int NC = 127;
constexpr int CROWS = B_ * NC * 2;
constexpr int NE = 32, DE = 2048, NA = T_ * 4;
constexpr float LN_EPS = 1e-5f;
constexpr float DN_ALPHA = 1.189207115002721f;
constexpr float ATT_SCALE = 0.08838834764831845f;

constexpr size_t al256(size_t x) { return (x + 255) & ~(size_t)255; }
constexpr size_t WS_CTL = 0;
constexpr size_t CTL_BYTES = 65536;
constexpr size_t CTL_CNT = 16384;
constexpr size_t WS_PROJ = CTL_BYTES;
constexpr size_t WS_KVMEM = WS_PROJ + al256((size_t)T_ * INW * 4);
constexpr size_t WS_BIAS1 = WS_KVMEM + al256((size_t)2048 * 1024 * 4);
constexpr size_t WS_HID = WS_BIAS1 + al256(2 * 256 * 4);
constexpr size_t WS_KC = WS_HID + al256((size_t)2 * 2048 * 256 * 4);
constexpr size_t WS_VC = WS_KC + al256((size_t)CROWS * 128 * 4);
constexpr size_t WS_POOLED = WS_VC + al256((size_t)CROWS * 128 * 4);
constexpr size_t WS_OPOOL = WS_POOLED + al256((size_t)T_ * 512 * 4);
constexpr size_t WS_OWIN = WS_OPOOL + al256((size_t)T_ * 512 * 4);
constexpr size_t WS_OCMP = WS_OWIN + al256((size_t)T_ * 1024 * 4);
constexpr size_t WS_OSLC = WS_OCMP + al256((size_t)T_ * 1024 * 4);
constexpr size_t WS_SEL = WS_OSLC + al256((size_t)T_ * 1024 * 4);
constexpr size_t WS_OMEM = WS_SEL + al256((size_t)T_ * 2 * 4);
constexpr size_t WS_CAT16 = WS_OMEM + al256((size_t)T_ * 512 * 4);
constexpr size_t WS_HPRE = WS_CAT16 + al256((size_t)T_ * 2048 * 2);
constexpr size_t WS_H = WS_HPRE + al256((size_t)T_ * 2048 * 4);
constexpr size_t WS_H16 = WS_H + al256((size_t)T_ * 2048 * 4);
constexpr size_t WS_GATE = WS_H16 + al256((size_t)T_ * 2048 * 2);
constexpr size_t WS_LIST = WS_GATE + al256((size_t)NA * 4);
constexpr size_t WS_ACT16 = WS_LIST + al256((size_t)NE * T_ * 4);
constexpr size_t WS_Y16 = WS_ACT16 + al256((size_t)(NA + 256) * 2048 * 2);
constexpr size_t WS_X16 = WS_Y16 + al256((size_t)NA * 2048 * 2);
constexpr size_t WS_WTIN = WS_X16 + al256((size_t)T_ * 2048 * 2);
constexpr size_t WS_WTOUT = WS_WTIN + al256((size_t)3840 * 2048 * 2);
constexpr size_t WS_WTGU = WS_WTOUT + al256((size_t)2048 * 2048 * 2);
constexpr size_t WS_WTDN = WS_WTGU + al256((size_t)NE * 4096 * 2048 * 2);
constexpr size_t WS_PROJ16 = WS_WTDN + al256((size_t)NE * 2048 * 2048 * 2);
constexpr size_t WS_KVMEM16 = WS_PROJ16 + al256((size_t)(T_ + 64) * INW * 2);
constexpr size_t WS_END = WS_KVMEM16 + al256((size_t)2048 * 1024 * 2);

constexpr int LDS_BYTES = 155648;

struct Params {
    const float* in[26];
    float* out;
    unsigned char* ws;
    long long lo_hi;
};
enum { I_X = 0, I_MEM, I_WIN, I_POSK, I_W1K, I_W2K, I_POSV, I_W1V, I_W2V, I_POOLW, I_POOLS, I_WMEMKV, I_GNNSA, I_GNPOOL, I_GNMEM, I_WOUT,
       I_LN1G, I_LN1B, I_WR, I_BR, I_WGU, I_BGU, I_WDN, I_BDN, I_LN2G, I_LN2B };

#define XB_TMO      128
#define XB_XCNT(j)  (256  + 64 * (j))
#define XB_XSUB(j)  (1280 + 64 * (j))
#define XB_XGEN(j)  (2304 + 64 * (j))
#define XB_TOP      3328
#define XB_TOPGEN   3392
#define XCD_BAR_WORDS 3456
#define XB_SPIN_CAP (1u << 25)
#define LAS __attribute__((address_space(3)))

__device__ __forceinline__ unsigned xb_ld(unsigned* p)              { return __hip_atomic_load(p, __ATOMIC_RELAXED, __HIP_MEMORY_SCOPE_AGENT); }
__device__ __forceinline__ unsigned xb_add(unsigned* p, unsigned v) { return __hip_atomic_fetch_add(p, v, __ATOMIC_RELAXED, __HIP_MEMORY_SCOPE_AGENT); }
__device__ __forceinline__ unsigned xb_xcc_id() { return (unsigned)__builtin_amdgcn_s_getreg((3 << 11) | 20) & 0xFu; }
#define XB_SPIN(cond, bar) do { unsigned _sp = 0; while (cond) { __builtin_amdgcn_s_sleep(1); \
    if ((++_sp & 255u) == 0u) { if (xb_ld(&(bar)[XB_TMO])) break; if (_sp > XB_SPIN_CAP) { atomicAdd(&(bar)[XB_TMO], 1u); break; } } } } while (0)

struct XcdBarrier { unsigned* bar; unsigned x; volatile LAS unsigned* st; };

__device__ __forceinline__ XcdBarrier xcd_barrier_post(unsigned* bar, volatile LAS unsigned* st) {
    XcdBarrier b; b.bar = bar; b.x = xb_xcc_id(); b.st = st;
    if (threadIdx.x == 0) (void)xb_add(&bar[XB_XCNT(b.x)], 1u);
    return b;
}
__device__ __forceinline__ void xcd_barrier_complete(unsigned* bar, unsigned x, unsigned& nloc, unsigned& nx) {
    const unsigned G = gridDim.x * gridDim.y * gridDim.z;
    unsigned sum, cnt, mine, sp = 0u;
    for (;;) {
        sum = 0u; cnt = 0u; mine = 0u;
#pragma unroll
        for (unsigned j = 0; j < 16; ++j) { const unsigned c = xb_ld(&bar[XB_XCNT(j)]); sum += c; cnt += (c > 0u) ? 1u : 0u; mine = (j == x) ? c : mine; }
        if (sum == G) break;
        __builtin_amdgcn_s_sleep(1);
        if ((++sp & 255u) == 0u) { if (xb_ld(&bar[XB_TMO])) break; if (sp > XB_SPIN_CAP) { atomicAdd(&bar[XB_TMO], 1u); break; } }
    }
    nloc = mine > 0u ? mine : 1u; nx = cnt > 0u ? cnt : 1u;
}
__device__ __forceinline__ void xcd_barrier(const XcdBarrier& b) {
    asm volatile("s_waitcnt vmcnt(0)" ::: "memory");
    __syncthreads();
    if (threadIdx.x == 0) {
        unsigned* bar = b.bar;
        __builtin_amdgcn_s_waitcnt(0);
        unsigned nloc = b.st[0], nx = b.st[1];
        if (nloc == 0u) { xcd_barrier_complete(bar, b.x, nloc, nx); b.st[0] = nloc; b.st[1] = nx; }
        const unsigned old = xb_add(&bar[XB_XSUB(b.x)], 1u);
        const unsigned gen = old / nloc;
        if (old + 1u == (gen + 1u) * nloc) {
            __builtin_amdgcn_fence(__ATOMIC_RELEASE, "agent");
            asm volatile("s_waitcnt vmcnt(0)" ::: "memory");
            const unsigned og = xb_add(&bar[XB_TOP], 1u);
            const unsigned tg = og / nx;
            if (og + 1u == (tg + 1u) * nx) xb_add(&bar[XB_TOPGEN], 1u);
            else XB_SPIN(xb_ld(&bar[XB_TOPGEN]) == tg, bar);
            __builtin_amdgcn_fence(__ATOMIC_ACQUIRE, "agent");
            xb_add(&bar[XB_XGEN(b.x)], 1u);
            asm volatile("s_waitcnt vmcnt(0)" ::: "memory");
        } else {
            XB_SPIN(xb_ld(&bar[XB_XGEN(b.x)]) == gen, bar);
            __builtin_amdgcn_fence(__ATOMIC_ACQUIRE, "agent");
            asm volatile("s_waitcnt vmcnt(0)" ::: "memory");
        }
    }
    __syncthreads();
}

typedef _Float16 h8 __attribute__((ext_vector_type(8)));
typedef _Float16 h4 __attribute__((ext_vector_type(4)));
typedef float f4 __attribute__((ext_vector_type(4)));

__device__ __forceinline__ float wave_sum(float v) {
#pragma unroll
    for (int o = 32; o > 0; o >>= 1) v += __shfl_xor(v, o);
    return v;
}
__device__ __forceinline__ float wave_max(float v) {
#pragma unroll
    for (int o = 32; o > 0; o >>= 1) v = fmaxf(v, __shfl_xor(v, o));
    return v;
}
__device__ __forceinline__ void wave_sync() {
    asm volatile("s_waitcnt lgkmcnt(0)" ::: "memory");
    __builtin_amdgcn_wave_barrier();
}
__device__ __forceinline__ float gelu_tanh(float x) {
    const float u = 0.7978845608028654f * (x + 0.044715f * x * x * x);
    return 0.5f * x * (1.f + tanhf(u));
}
__device__ __forceinline__ float sigmoidf_(float x) { return 1.f / (1.f + expf(-x)); }

constexpr int G_LD = 40;
template <class AF, class EF>
__device__ __forceinline__ void gemm_tile(char* smem, int K, const AF& af, const float* __restrict__ Bm, int ldb, int n0, int Nlim, bool perm, const EF& ef) {
    _Float16* As = (_Float16*)smem;
    _Float16* Bs = As + 128 * G_LD;
    const int tid = threadIdx.x, lane = tid & 63, wid = tid >> 6, wr = wid >> 2, wc = wid & 3, fr = lane & 15, fq = lane >> 4;
    f4 acc[4][2];
#pragma unroll
    for (int m = 0; m < 4; ++m)
#pragma unroll
        for (int n = 0; n < 2; ++n) acc[m][n] = (f4){0.f, 0.f, 0.f, 0.f};
    const int ar = tid >> 3, ak = (tid & 7) * 4;
    const float* ap0 = af.row(ar);
    const float* ap1 = af.row(ar + 64);
    const int bk = tid >> 5, bn = (tid & 31) * 4;
    const bool bok = (n0 + bn) < Nlim;
    int bnp[4];
#pragma unroll
    for (int i = 0; i < 4; ++i) { const int c = bn + i; bnp[i] = perm ? ((c & ~31) | ((c & 1) << 4) | ((c & 31) >> 1)) : c; }
    for (int k0 = 0; k0 < K; k0 += 32) {
        const int ko = af.koff(k0 + ak);
        float4 a0 = make_float4(0.f, 0.f, 0.f, 0.f), a1 = a0, b0 = a0, b1 = a0;
        if (ap0) a0 = *(const float4*)(ap0 + ko);
        if (ap1) a1 = *(const float4*)(ap1 + ko);
        if (bok) { b0 = *(const float4*)(Bm + (size_t)(k0 + bk) * ldb + n0 + bn); b1 = *(const float4*)(Bm + (size_t)(k0 + bk + 16) * ldb + n0 + bn); }
        __syncthreads();
        *(h4*)&As[ar * G_LD + ak] = (h4){(_Float16)a0.x, (_Float16)a0.y, (_Float16)a0.z, (_Float16)a0.w};
        *(h4*)&As[(ar + 64) * G_LD + ak] = (h4){(_Float16)a1.x, (_Float16)a1.y, (_Float16)a1.z, (_Float16)a1.w};
        Bs[bnp[0] * G_LD + bk] = (_Float16)b0.x; Bs[bnp[1] * G_LD + bk] = (_Float16)b0.y; Bs[bnp[2] * G_LD + bk] = (_Float16)b0.z; Bs[bnp[3] * G_LD + bk] = (_Float16)b0.w;
        Bs[bnp[0] * G_LD + bk + 16] = (_Float16)b1.x; Bs[bnp[1] * G_LD + bk + 16] = (_Float16)b1.y; Bs[bnp[2] * G_LD + bk + 16] = (_Float16)b1.z; Bs[bnp[3] * G_LD + bk + 16] = (_Float16)b1.w;
        __syncthreads();
        h8 a[4], b[2];
#pragma unroll
        for (int m = 0; m < 4; ++m) a[m] = *(const h8*)&As[(wr * 64 + m * 16 + fr) * G_LD + fq * 8];
#pragma unroll
        for (int n = 0; n < 2; ++n) b[n] = *(const h8*)&Bs[(wc * 32 + n * 16 + fr) * G_LD + fq * 8];
#pragma unroll
        for (int m = 0; m < 4; ++m)
#pragma unroll
            for (int n = 0; n < 2; ++n) acc[m][n] = __builtin_amdgcn_mfma_f32_16x16x32_f16(a[m], b[n], acc[m][n], 0, 0, 0);
    }
    ef(acc, wr, wc, fr, fq);
    __syncthreads();
}

struct ARowPlain { const float* base; int ld; int m0; int mlim;
    __device__ __forceinline__ const float* row(int r) const { return (m0 + r) < mlim ? base + (size_t)(m0 + r) * ld : nullptr; }
    __device__ __forceinline__ int koff(int k) const { return k; } };
struct ARowCmp { const float* proj; int col; int m0;
    __device__ __forceinline__ const float* row(int r) const { const int g = m0 + r; if (g >= CROWS) return nullptr; const int kvh = g & 1, bc = g >> 1, b = bc / NC, c = bc % NC;
        return proj + (size_t)(b * S_ + 16 * c) * INW + col + kvh * 128; }
    __device__ __forceinline__ int koff(int k) const { return (k >> 7) * INW + (k & 127); } };
struct ARowList { const float* base; const int* list; int m0; int cnt; int shift;
    __device__ __forceinline__ const float* row(int r) const { if (m0 + r >= cnt) return nullptr; const int a = list[m0 + r]; return base + (size_t)(a >> shift) * 2048; }
    __device__ __forceinline__ int koff(int k) const { return k; } };

struct EpiStore { float* C; int ldc; int m0; int n0; int mlim; int nlim; _Float16* C16;
    __device__ __forceinline__ void operator()(const f4 (&acc)[4][2], int wr, int wc, int fr, int fq) const {
#pragma unroll
        for (int m = 0; m < 4; ++m)
#pragma unroll
            for (int n = 0; n < 2; ++n)
#pragma unroll
                for (int j = 0; j < 4; ++j) { const int r = m0 + wr * 64 + m * 16 + fq * 4 + j, c = n0 + wc * 32 + n * 16 + fr;
                    if (r < mlim && c < nlim) { C[(size_t)r * ldc + c] = acc[m][n][j]; if (C16) C16[(size_t)r * ldc + c] = (_Float16)acc[m][n][j]; } } } };
struct EpiHid { float* C; const float* bias; int m0; int n0;
    __device__ __forceinline__ void operator()(const f4 (&acc)[4][2], int wr, int wc, int fr, int fq) const {
#pragma unroll
        for (int m = 0; m < 4; ++m)
#pragma unroll
            for (int n = 0; n < 2; ++n)
#pragma unroll
                for (int j = 0; j < 4; ++j) { const int r = m0 + wr * 64 + m * 16 + fq * 4 + j, c = n0 + wc * 32 + n * 16 + fr;
                    if (r < CROWS) C[(size_t)r * 256 + c] = gelu_tanh(acc[m][n][j] + bias[c]); } } };
struct EpiOut { float* C; const float* x; int m0; int n0;
    __device__ __forceinline__ void operator()(const f4 (&acc)[4][2], int wr, int wc, int fr, int fq) const {
#pragma unroll
        for (int m = 0; m < 4; ++m)
#pragma unroll
            for (int n = 0; n < 2; ++n)
#pragma unroll
                for (int j = 0; j < 4; ++j) { const size_t o = (size_t)(m0 + wr * 64 + m * 16 + fq * 4 + j) * 2048 + n0 + wc * 32 + n * 16 + fr;
                    C[o] = DN_ALPHA * x[o] + acc[m][n][j]; } } };
struct EpiGu { float* act; const float* bgu; const int* list; int m0; int cnt; int n0;
    __device__ __forceinline__ void operator()(const f4 (&acc)[4][2], int wr, int wc, int fr, int fq) const {
        const int jc = (n0 + wc * 32) / 2 + fr;
        const float bg = bgu[2 * jc], bl = bgu[2 * jc + 1];
#pragma unroll
        for (int m = 0; m < 4; ++m)
#pragma unroll
            for (int j = 0; j < 4; ++j) { const int r = m0 + wr * 64 + m * 16 + fq * 4 + j;
                if (r < cnt) { const int a = list[r];
                    const float xg = fminf(acc[m][0][j] + bg, 7.f), xl = fminf(fmaxf(acc[m][1][j] + bl, -7.f), 7.f);
                    act[(size_t)a * 2048 + jc] = xg * sigmoidf_(1.702f * xg) * (xl + 1.f); } } } };
struct EpiDn { float* y; const float* bdn; const int* list; const float* gate; int m0; int cnt; int n0;
    __device__ __forceinline__ void operator()(const f4 (&acc)[4][2], int wr, int wc, int fr, int fq) const {
#pragma unroll
        for (int m = 0; m < 4; ++m)
#pragma unroll
            for (int j = 0; j < 4; ++j) { const int r = m0 + wr * 64 + m * 16 + fq * 4 + j;
                if (r < cnt) { const int a = list[r]; const float g = gate[a];
#pragma unroll
                    for (int n = 0; n < 2; ++n) { const int c = n0 + wc * 32 + n * 16 + fr; y[(size_t)a * 2048 + c] = (acc[m][n][j] + bdn[c]) * g; } } } } };

constexpr int WLDS_FLOATS = 4096 + 512 + 32;
template <bool SHARED>
__device__ __forceinline__ void wave_attn(float* sw, const float* __restrict__ qptr, const float* __restrict__ Kb, const float* __restrict__ Vb, int ld, int nseg, float scale, float* __restrict__ optr) {
    const int lane = threadIdx.x & 63;
    float* sq = sw + 4096; const int* segs = (const int*)(sw + 4096 + 512);
#pragma unroll
    for (int i = 0; i < 8; ++i) sq[lane + 64 * i] = qptr[lane + 64 * i];
    wave_sync();
    for (int sg = 0; sg < nseg; ++sg) {
        const int start = segs[sg], len = segs[16 + sg];
        float d0 = 0.f, d1 = 0.f, d2 = 0.f, d3 = 0.f;
        if (lane < len) {
            const float* kp = Kb + (size_t)(start + lane) * ld;
            for (int d4 = 0; d4 < 32; ++d4) {
                if (SHARED) {
                    const float4 kv = *(const float4*)(kp + d4 * 4);
                    const float4 q0 = *(const float4*)(sq + d4 * 4), q1 = *(const float4*)(sq + 128 + d4 * 4), q2 = *(const float4*)(sq + 256 + d4 * 4), q3 = *(const float4*)(sq + 384 + d4 * 4);
                    d0 += kv.x * q0.x + kv.y * q0.y + kv.z * q0.z + kv.w * q0.w;
                    d1 += kv.x * q1.x + kv.y * q1.y + kv.z * q1.z + kv.w * q1.w;
                    d2 += kv.x * q2.x + kv.y * q2.y + kv.z * q2.z + kv.w * q2.w;
                    d3 += kv.x * q3.x + kv.y * q3.y + kv.z * q3.z + kv.w * q3.w;
                } else {
                    const float4 k0 = *(const float4*)(kp + d4 * 4), k1 = *(const float4*)(kp + 128 + d4 * 4), k2 = *(const float4*)(kp + 256 + d4 * 4), k3 = *(const float4*)(kp + 384 + d4 * 4);
                    const float4 q0 = *(const float4*)(sq + d4 * 4), q1 = *(const float4*)(sq + 128 + d4 * 4), q2 = *(const float4*)(sq + 256 + d4 * 4), q3 = *(const float4*)(sq + 384 + d4 * 4);
                    d0 += k0.x * q0.x + k0.y * q0.y + k0.z * q0.z + k0.w * q0.w;
                    d1 += k1.x * q1.x + k1.y * q1.y + k1.z * q1.z + k1.w * q1.w;
                    d2 += k2.x * q2.x + k2.y * q2.y + k2.z * q2.z + k2.w * q2.w;
                    d3 += k3.x * q3.x + k3.y * q3.y + k3.z * q3.z + k3.w * q3.w;
                }
            }
        }
        const bool ok = lane < len;
        sw[sg * 64 + lane] = ok ? d0 * scale : -1e30f;
        sw[1024 + sg * 64 + lane] = ok ? d1 * scale : -1e30f;
        sw[2048 + sg * 64 + lane] = ok ? d2 * scale : -1e30f;
        sw[3072 + sg * 64 + lane] = ok ? d3 * scale : -1e30f;
    }
    wave_sync();
    const int n = nseg * 64;
#pragma unroll
    for (int g = 0; g < 4; ++g) {
        float mx = -1e30f;
        for (int i = lane; i < n; i += 64) mx = fmaxf(mx, sw[g * 1024 + i]);
        mx = wave_max(mx);
        float sm = 0.f;
        for (int i = lane; i < n; i += 64) { const float v = sw[g * 1024 + i]; sm += (v > -1e29f) ? expf(v - mx) : 0.f; }
        sm = wave_sum(sm);
        const float inv = sm > 0.f ? 1.f / sm : 0.f;
        for (int i = lane; i < n; i += 64) { const float v = sw[g * 1024 + i]; sw[g * 1024 + i] = (v > -1e29f) ? expf(v - mx) * inv : 0.f; }
    }
    wave_sync();
    float o[4][2];
#pragma unroll
    for (int g = 0; g < 4; ++g) { o[g][0] = 0.f; o[g][1] = 0.f; }
    for (int sg = 0; sg < nseg; ++sg) {
        const int start = segs[sg], len = segs[16 + sg];
        for (int l = 0; l < len; ++l) {
            const float* vp = Vb + (size_t)(start + l) * ld;
            if (SHARED) {
                const float v0 = vp[lane], v1 = vp[lane + 64];
#pragma unroll
                for (int g = 0; g < 4; ++g) { const float p = sw[g * 1024 + sg * 64 + l]; o[g][0] += p * v0; o[g][1] += p * v1; }
            } else {
#pragma unroll
                for (int g = 0; g < 4; ++g) { const float p = sw[g * 1024 + sg * 64 + l]; o[g][0] += p * vp[g * 128 + lane]; o[g][1] += p * vp[g * 128 + lane + 64]; }
            }
        }
    }
#pragma unroll
    for (int g = 0; g < 4; ++g) { optr[g * 128 + lane] = o[g][0]; optr[g * 128 + lane + 64] = o[g][1]; }
}

namespace g8 {
constexpr int BM = 256, BK = 64, HALF = 128, HTB = HALF * BK * 2, STAGE_BYTES = 8 * HTB;
constexpr int KK = 2048;
typedef float f32x4 __attribute__((ext_vector_type(4)));
__device__ __forceinline__ int lds_byte(int r, int c) { const int st = (r >> 4) * 2 + (c >> 5), rr = r & 15, cc = c & 31, ob = rr * 64 + cc * 2; return st * 1024 + (ob ^ (((ob >> 9) & 1) << 5)); }
__device__ __forceinline__ void stage_rc(int b, int& R, int& C) { const int st = b / 1024, sb = b % 1024, swz = sb ^ (((sb >> 9) & 1) << 5); R = (st >> 1) * 16 + swz / 64; C = (st & 1) * 32 + (swz % 64) / 2; }
__device__ __forceinline__ int perm32(int rho) { const int n = rho >> 4, i = rho & 15; return 8 * (i >> 2) + 4 * n + (i & 3); }

struct Unit { int m0, n0, e, cnt, rbase; };

__device__ __forceinline__ void tile_order(int L, int nM, int nN, int& pm, int& pn) {
    const int nwg = nM * nN; int wgid = L;
    { const int q = nwg / 8, r = nwg % 8, xcd = wgid % 8, off = wgid / 8; wgid = (xcd < r ? xcd * (q + 1) : r * (q + 1) + (xcd - r) * q) + off; }
    const int nig = 8 * nN, gid = wgid / nig, fm = gid * 8, gsz = (nM - fm) < 8 ? (nM - fm) : 8;
    pm = fm + ((wgid % nig) % gsz); pn = (wgid % nig) / gsz;
}

template <class Prob>
__device__ __forceinline__ void gemm_phase(LAS unsigned char* lds, const Prob& P) {
    const int tid = threadIdx.x, wid = __builtin_amdgcn_readfirstlane(tid >> 6), lane = tid & 63, wr = wid >> 2, wc = wid & 3, fr = lane & 15, fq = lane >> 4;
    constexpr int K = KK, nt = K / BK;
    int sR[2], sC2[2]; unsigned voffB[2];
#pragma unroll
    for (int i = 0; i < 2; ++i) { int R, C; stage_rc(tid * 16 + i * 8192, R, C); sR[i] = R; sC2[i] = C * 2; const int Rb = Prob::PERM ? ((R & ~31) + perm32(R & 31)) : R; voffB[i] = (unsigned)(Rb * K + C) * 2u; }
    const size_t kstep = (size_t)(BK * 2);
    const size_t hstep = (size_t)HALF * K * 2;
    const unsigned ldsw = (unsigned)wid * 1024u;
    const int aoff = lds_byte(wr * 64 + fr, fq * 8), boff = lds_byte(wc * 32 + fr, fq * 8);
#define G8_SA(b, h) (((b) * 2 + (h)) * HTB)
#define G8_SB(b, h) ((4 + (b) * 2 + (h)) * HTB)
#define G8_STAGE(bufoff, gbase, voff) do { _Pragma("unroll") for (int _i = 0; _i < 2; ++_i) \
        __builtin_amdgcn_global_load_lds((const unsigned*)((const char*)(gbase) + (voff)[_i]), (LAS unsigned*)(lds + (bufoff) + ldsw + _i * 8192), 16, 0, 0); } while (0)
#define G8_LDA(dst, b, h) do { _Pragma("unroll") for (int m = 0; m < 4; ++m) _Pragma("unroll") for (int k = 0; k < 2; ++k) dst[m][k] = *(const LAS h8*)(lds + G8_SA(b, h) + aoff + m * 2048 + k * 1024); } while (0)
#define G8_LDB(dst, b, h) do { _Pragma("unroll") for (int n = 0; n < 2; ++n) _Pragma("unroll") for (int k = 0; k < 2; ++k) dst[n][k] = *(const LAS h8*)(lds + G8_SB(b, h) + boff + n * 2048 + k * 1024); } while (0)
#define G8_MMA(ai, bj, At, Bt) do { __builtin_amdgcn_s_setprio(1); _Pragma("unroll") for (int m = 0; m < 4; ++m) _Pragma("unroll") for (int n = 0; n < 2; ++n) _Pragma("unroll") for (int k = 0; k < 2; ++k) \
        acc[ai][bj][m][n] = __builtin_amdgcn_mfma_f32_16x16x32_f16(Bt[n][k], At[m][k], acc[ai][bj][m][n], 0, 0, 0); __builtin_amdgcn_s_setprio(0); } while (0)
#define G8_WAIT_V(n) asm volatile("s_waitcnt vmcnt(" #n ")" ::: "memory")
#define G8_WAIT_L(n) asm volatile("s_waitcnt lgkmcnt(" #n ")" ::: "memory")
#define G8_BAR __builtin_amdgcn_s_barrier()
#define G8_SCHED __builtin_amdgcn_sched_barrier(0)
    Unit cur, nxt; int ui = 0;
    if (!P.next(0, cur)) return;
    f32x4 acc[2][2][4][2];
#pragma unroll
    for (int a = 0; a < 2; ++a)
#pragma unroll
        for (int b = 0; b < 2; ++b)
#pragma unroll
            for (int m = 0; m < 4; ++m)
#pragma unroll
                for (int n = 0; n < 2; ++n) acc[a][b][m][n] = (f32x4){0.f, 0.f, 0.f, 0.f};
    h8 At[4][2], B0[2][2], B1[2][2];
    unsigned vc[2][2], vn[2][2];
    P.a_offs(cur, sR, sC2, vc);
    const char* const Ab = P.a_base();
    const char* cB = P.b_base(cur);
    G8_STAGE(G8_SB(0, 0), cB, voffB); G8_STAGE(G8_SA(0, 0), Ab, vc[0]); G8_STAGE(G8_SB(0, 1), cB + hstep, voffB); G8_STAGE(G8_SA(0, 1), Ab, vc[1]);
    if (wr == 1) G8_BAR;
    G8_WAIT_V(4); G8_BAR;
    G8_STAGE(G8_SB(1, 0), cB + kstep, voffB); G8_STAGE(G8_SA(1, 0), Ab + kstep, vc[0]); G8_STAGE(G8_SB(1, 1), cB + hstep + kstep, voffB);
    G8_WAIT_V(6); G8_BAR;
    for (;;) {
        const bool has_next = P.next(ui + 1, nxt);
        const char* nB = cB;
        if (has_next) { P.a_offs(nxt, sR, sC2, vn); nB = P.b_base(nxt); }
        else { vn[0][0] = vc[0][0]; vn[0][1] = vc[0][1]; vn[1][0] = vc[1][0]; vn[1][1] = vc[1][1]; }
        for (int t = 0; t < nt; t += 2) {
            const bool last = (t == nt - 2);
            const char* a1 = Ab + (size_t)(t + 1) * kstep;
            const char* a2 = last ? Ab : Ab + (size_t)(t + 2) * kstep; const char* b2 = last ? nB : cB + (size_t)(t + 2) * kstep;
            const char* a3 = a2 + kstep; const char* b3 = b2 + kstep;
            unsigned o2[2][2];
            o2[0][0] = last ? vn[0][0] : vc[0][0]; o2[0][1] = last ? vn[0][1] : vc[0][1]; o2[1][0] = last ? vn[1][0] : vc[1][0]; o2[1][1] = last ? vn[1][1] : vc[1][1];
            G8_LDB(B0, 0, 0); G8_SCHED; G8_LDA(At, 0, 0); G8_STAGE(G8_SA(1, 1), a1, vc[1]);
            G8_WAIT_L(8); G8_BAR; G8_WAIT_L(0); G8_MMA(0, 0, At, B0); G8_BAR; G8_SCHED;
            G8_LDB(B1, 0, 1); G8_STAGE(G8_SB(0, 0), b2, voffB);
            G8_BAR; G8_WAIT_L(0); G8_MMA(0, 1, At, B1); G8_BAR;
            G8_LDA(At, 0, 1); G8_STAGE(G8_SA(0, 0), a2, o2[0]);
            G8_BAR; G8_WAIT_L(0); G8_MMA(1, 0, At, B0); G8_BAR; G8_SCHED;
            G8_STAGE(G8_SB(0, 1), b2 + hstep, voffB);
            G8_WAIT_V(6); G8_BAR; G8_MMA(1, 1, At, B1); G8_BAR;
            G8_LDB(B0, 1, 0); G8_SCHED; G8_LDA(At, 1, 0); G8_STAGE(G8_SA(0, 1), a2, o2[1]);
            G8_WAIT_L(8); G8_BAR; G8_WAIT_L(0); G8_MMA(0, 0, At, B0); G8_BAR; G8_SCHED;
            G8_LDB(B1, 1, 1); G8_STAGE(G8_SB(1, 0), b3, voffB);
            G8_BAR; G8_WAIT_L(0); G8_MMA(0, 1, At, B1); G8_BAR;
            G8_LDA(At, 1, 1); G8_STAGE(G8_SA(1, 0), a3, o2[0]);
            G8_BAR; G8_WAIT_L(0); G8_MMA(1, 0, At, B0); G8_BAR; G8_SCHED;
            G8_STAGE(G8_SB(1, 1), b3 + hstep, voffB);
            G8_WAIT_V(6); G8_BAR; G8_MMA(1, 1, At, B1); G8_BAR;
        }
        P.epi(acc, cur, wr, wc, fr, fq);
        if (!has_next) break;
#pragma unroll
        for (int a = 0; a < 2; ++a)
#pragma unroll
            for (int b = 0; b < 2; ++b)
#pragma unroll
                for (int m = 0; m < 4; ++m)
#pragma unroll
                    for (int n = 0; n < 2; ++n) acc[a][b][m][n] = (f32x4){0.f, 0.f, 0.f, 0.f};
        cur = nxt; cB = nB; ++ui;
        vc[0][0] = vn[0][0]; vc[0][1] = vn[0][1]; vc[1][0] = vn[1][0]; vc[1][1] = vn[1][1];
    }
    G8_WAIT_V(0);
    if (wr == 0) G8_BAR;
    G8_BAR;
#undef G8_SA
#undef G8_SB
#undef G8_STAGE
#undef G8_LDA
#undef G8_LDB
#undef G8_MMA
#undef G8_WAIT_V
#undef G8_WAIT_L
#undef G8_BAR
#undef G8_SCHED
}

struct ProbIn {
    static constexpr bool PERM = false;
    const _Float16* A; const _Float16* Bt; float* C; _Float16* C16; int G, c;
    __device__ __forceinline__ bool next(int i, Unit& u) const { const int L = i * G + c; if (L >= 64 * 15) return false; int pm, pn; tile_order(L, 64, 15, pm, pn); u.m0 = pm * 256; u.n0 = pn * 256; u.e = 0; u.cnt = 256; u.rbase = 0; return true; }
    __device__ __forceinline__ void a_offs(const Unit& u, const int (&R)[2], const int (&C2)[2], unsigned (&v)[2][2]) const {
#pragma unroll
        for (int h = 0; h < 2; ++h)
#pragma unroll
            for (int i = 0; i < 2; ++i) v[h][i] = (unsigned)(u.m0 + h * 128 + R[i]) * (unsigned)(KK * 2) + (unsigned)C2[i]; }
    __device__ __forceinline__ const char* a_base() const { return (const char*)A; }
    __device__ __forceinline__ const char* b_base(const Unit& u) const { return (const char*)(Bt + (size_t)u.n0 * KK); }
    __device__ __forceinline__ void epi(const f32x4 (&acc)[2][2][4][2], const Unit& u, int wr, int wc, int fr, int fq) const {
#pragma unroll
        for (int ai = 0; ai < 2; ++ai)
#pragma unroll
            for (int m = 0; m < 4; ++m) { const int row = u.m0 + ai * 128 + wr * 64 + m * 16 + fr;
#pragma unroll
                for (int bj = 0; bj < 2; ++bj)
#pragma unroll
                    for (int n = 0; n < 2; ++n) { const int col = u.n0 + bj * 128 + wc * 32 + n * 16 + fq * 4;
                        if (col < INW) { const f32x4 v = acc[ai][bj][m][n]; *(f32x4*)(C + (size_t)row * INW + col) = v;
                            *(h4*)(C16 + (size_t)row * INW + col) = (h4){(_Float16)v[0], (_Float16)v[1], (_Float16)v[2], (_Float16)v[3]}; } } } }
};
struct ProbOut {
    static constexpr bool PERM = false;
    const _Float16* A; const _Float16* Bt; float* C; const float* X; int G, c;
    __device__ __forceinline__ bool next(int i, Unit& u) const { const int L = i * G + c; if (L >= 64 * 8) return false; int pm, pn; tile_order(L, 64, 8, pm, pn); u.m0 = pm * 256; u.n0 = pn * 256; u.e = 0; u.cnt = 256; u.rbase = 0; return true; }
    __device__ __forceinline__ void a_offs(const Unit& u, const int (&R)[2], const int (&C2)[2], unsigned (&v)[2][2]) const {
#pragma unroll
        for (int h = 0; h < 2; ++h)
#pragma unroll
            for (int i = 0; i < 2; ++i) v[h][i] = (unsigned)(u.m0 + h * 128 + R[i]) * (unsigned)(KK * 2) + (unsigned)C2[i]; }
    __device__ __forceinline__ const char* a_base() const { return (const char*)A; }
    __device__ __forceinline__ const char* b_base(const Unit& u) const { return (const char*)(Bt + (size_t)u.n0 * KK); }
    __device__ __forceinline__ void epi(const f32x4 (&acc)[2][2][4][2], const Unit& u, int wr, int wc, int fr, int fq) const {
#pragma unroll
        for (int ai = 0; ai < 2; ++ai)
#pragma unroll
            for (int m = 0; m < 4; ++m) { const int row = u.m0 + ai * 128 + wr * 64 + m * 16 + fr;
#pragma unroll
                for (int bj = 0; bj < 2; ++bj)
#pragma unroll
                    for (int n = 0; n < 2; ++n) { const size_t o = (size_t)row * 2048 + u.n0 + bj * 128 + wc * 32 + n * 16 + fq * 4;
                        const f32x4 xv = *(const f32x4*)(X + o); *(f32x4*)(C + o) = xv * DN_ALPHA + acc[ai][bj][m][n]; } } }
};
struct MoeTab { const LAS int* t; int NT;
    __device__ __forceinline__ bool find(int L, Unit& u) const {
        const int total = __builtin_amdgcn_readfirstlane(t[98]); if (L >= total) return false;
        int e = 0;
        for (; e < NE - 1; ++e) { if (L < __builtin_amdgcn_readfirstlane(t[32 + e + 1])) break; }
        const int ub = __builtin_amdgcn_readfirstlane(t[32 + e]), cn = __builtin_amdgcn_readfirstlane(t[e]), rs = __builtin_amdgcn_readfirstlane(t[65 + e]);
        const int nm = (cn + 255) >> 8, v = L - ub, mt = v % nm, ntile = v / nm;
        u.e = e; u.m0 = mt * 256; u.n0 = ntile * 256; u.cnt = min(256, cn - mt * 256); u.rbase = rs; return true; } };
struct ProbGu {
    static constexpr bool PERM = true;
    const _Float16* A; const _Float16* Bt; _Float16* act; const float* bgu; const int* list; MoeTab tab; int G, vcu;
    __device__ __forceinline__ bool next(int i, Unit& u) const { return tab.find(i * G + vcu, u); }
    __device__ __forceinline__ void a_offs(const Unit& u, const int (&R)[2], const int (&C2)[2], unsigned (&v)[2][2]) const {
#pragma unroll
        for (int h = 0; h < 2; ++h)
#pragma unroll
            for (int i = 0; i < 2; ++i) { int r = h * 128 + R[i]; r = r < u.cnt ? r : 0; const int a = list[(size_t)u.e * T_ + u.m0 + r]; v[h][i] = (unsigned)(a >> 2) * (unsigned)(KK * 2) + (unsigned)C2[i]; } }
    __device__ __forceinline__ const char* a_base() const { return (const char*)A; }
    __device__ __forceinline__ const char* b_base(const Unit& u) const { return (const char*)(Bt + ((size_t)u.e * 4096 + u.n0) * KK); }
    __device__ __forceinline__ void epi(const f32x4 (&acc)[2][2][4][2], const Unit& u, int wr, int wc, int fr, int fq) const {
        const float* bb = bgu + (size_t)u.e * 4096;
#pragma unroll
        for (int bj = 0; bj < 2; ++bj) { const int col = u.n0 + bj * 128 + wc * 32 + fq * 8;
            const f32x4 b0 = *(const f32x4*)(bb + col), b1 = *(const f32x4*)(bb + col + 4);
#pragma unroll
            for (int ai = 0; ai < 2; ++ai)
#pragma unroll
                for (int m = 0; m < 4; ++m) { const int rl = ai * 128 + wr * 64 + m * 16 + fr;
                    if (rl < u.cnt) { const f32x4 v0 = acc[ai][bj][m][0] + b0, v1 = acc[ai][bj][m][1] + b1;
                        h4 o;
                        { const float xg = fminf(v0[0], 7.f), xl = fminf(fmaxf(v0[1], -7.f), 7.f); o[0] = (_Float16)(xg * sigmoidf_(1.702f * xg) * (xl + 1.f)); }
                        { const float xg = fminf(v0[2], 7.f), xl = fminf(fmaxf(v0[3], -7.f), 7.f); o[1] = (_Float16)(xg * sigmoidf_(1.702f * xg) * (xl + 1.f)); }
                        { const float xg = fminf(v1[0], 7.f), xl = fminf(fmaxf(v1[1], -7.f), 7.f); o[2] = (_Float16)(xg * sigmoidf_(1.702f * xg) * (xl + 1.f)); }
                        { const float xg = fminf(v1[2], 7.f), xl = fminf(fmaxf(v1[3], -7.f), 7.f); o[3] = (_Float16)(xg * sigmoidf_(1.702f * xg) * (xl + 1.f)); }
                        *(h4*)(act + (size_t)(u.rbase + u.m0 + rl) * 2048 + (col >> 1)) = o; } } } }
};
struct ProbDn {
    static constexpr bool PERM = true;
    const _Float16* A; const _Float16* Bt; _Float16* y; const float* bdn; const int* list; const float* gate; MoeTab tab; int G, vcu;
    __device__ __forceinline__ bool next(int i, Unit& u) const { return tab.find(i * G + vcu, u); }
    __device__ __forceinline__ void a_offs(const Unit& u, const int (&R)[2], const int (&C2)[2], unsigned (&v)[2][2]) const {
#pragma unroll
        for (int h = 0; h < 2; ++h)
#pragma unroll
            for (int i = 0; i < 2; ++i) v[h][i] = (unsigned)(u.rbase + u.m0 + h * 128 + R[i]) * (unsigned)(KK * 2) + (unsigned)C2[i]; }
    __device__ __forceinline__ const char* a_base() const { return (const char*)A; }
    __device__ __forceinline__ const char* b_base(const Unit& u) const { return (const char*)(Bt + ((size_t)u.e * 2048 + u.n0) * KK); }
    __device__ __forceinline__ void epi(const f32x4 (&acc)[2][2][4][2], const Unit& u, int wr, int wc, int fr, int fq) const {
        const float* bb = bdn + (size_t)u.e * 2048;
#pragma unroll
        for (int ai = 0; ai < 2; ++ai)
#pragma unroll
            for (int m = 0; m < 4; ++m) { const int rl = ai * 128 + wr * 64 + m * 16 + fr;
                if (rl < u.cnt) { const int a = list[(size_t)u.e * T_ + u.m0 + rl]; const float g = gate[a];
#pragma unroll
                    for (int bj = 0; bj < 2; ++bj) { const int col = u.n0 + bj * 128 + wc * 32 + fq * 8;
                        const f32x4 v0 = (acc[ai][bj][m][0] + *(const f32x4*)(bb + col)) * g, v1 = (acc[ai][bj][m][1] + *(const f32x4*)(bb + col + 4)) * g;
                        h8 o; o[0] = (_Float16)v0[0]; o[1] = (_Float16)v0[1]; o[2] = (_Float16)v0[2]; o[3] = (_Float16)v0[3]; o[4] = (_Float16)v1[0]; o[5] = (_Float16)v1[1]; o[6] = (_Float16)v1[2]; o[7] = (_Float16)v1[3];
                        *(h8*)(y + (size_t)a * 2048 + col) = o; } } } }
};
}

namespace at8 {
typedef float f32x16 __attribute__((ext_vector_type(16)));
typedef short s16x4 __attribute__((ext_vector_type(4)));
typedef unsigned u32x4 __attribute__((ext_vector_type(4)));
constexpr int SHM_V = 64 * 128 * 2, SHM_K = 64 * 128 * 2;
constexpr int LDS_WS = 2 * SHM_V + 2 * SHM_K;
constexpr int LDS_END = LDS_WS + 8 * 64 * 4;
constexpr float CEXP = ATT_SCALE * 1.4426950408889634f;
constexpr float THR_RAW = 8.f / ATT_SCALE;
#define AT_KSWZ(row, colB) ((row) * 256 + ((colB) ^ (((row) & 7) << 4)))
#define AT_SBAR() __builtin_amdgcn_sched_barrier(0)
__device__ __forceinline__ int crow(int r, int hi) { return (r & 3) + 8 * (r >> 2) + 4 * hi; }
__device__ __forceinline__ unsigned cvtpk(float lo, float hi) { auto v = __builtin_amdgcn_cvt_pkrtz(lo, hi); return *reinterpret_cast<unsigned*>(&v); }
__device__ __forceinline__ int v_st(int k, int c) { const int kk = (k & ~0xC) | ((k & 4) << 1) | ((k & 8) >> 1); return ((kk >> 3) * 4 + (c >> 5)) * 512 + ((kk & 7) * 32 + (c & 31)) * 2; }
__device__ __forceinline__ int v_rd_base(int lane) { return ((lane & 3) << 3) | (((lane >> 2) & 3) << 6) | (((lane >> 4) & 1) << 5) | (((lane >> 5) & 1) << 8); }
constexpr int v_rd_off(int d0, int ks, int half) { return d0 * 512 + ks * 4096 + half * 2048; }
template <int OFF> __device__ __forceinline__ s16x4 tr_read(int vb) { s16x4 r; asm volatile("ds_read_b64_tr_b16 %0, %1 offset:%2" : "=&v"(r) : "v"(vb), "i"(OFF) : "memory"); return r; }
__device__ __forceinline__ h8 mk8(s16x4 l, s16x4 h) { typedef short s16x8 __attribute__((ext_vector_type(8))); s16x8 w = {l[0], l[1], l[2], l[3], h[0], h[1], h[2], h[3]}; return *reinterpret_cast<h8*>(&w); }
template <int D0> __device__ __forceinline__ void pv_one(f32x16& od, int vb, h8 pa0, h8 pa1, h8 pa2, h8 pa3) {
    const s16x4 l0 = tr_read<v_rd_off(D0, 0, 0)>(vb), h0 = tr_read<v_rd_off(D0, 0, 1)>(vb), l1 = tr_read<v_rd_off(D0, 1, 0)>(vb), h1 = tr_read<v_rd_off(D0, 1, 1)>(vb);
    const s16x4 l2 = tr_read<v_rd_off(D0, 2, 0)>(vb), h2 = tr_read<v_rd_off(D0, 2, 1)>(vb), l3 = tr_read<v_rd_off(D0, 3, 0)>(vb), h3 = tr_read<v_rd_off(D0, 3, 1)>(vb);
    asm volatile("s_waitcnt lgkmcnt(0)" ::: "memory"); AT_SBAR();
    od = __builtin_amdgcn_mfma_f32_32x32x16_f16(pa0, mk8(l0, h0), od, 0, 0, 0);
    od = __builtin_amdgcn_mfma_f32_32x32x16_f16(pa1, mk8(l1, h1), od, 0, 0, 0);
    od = __builtin_amdgcn_mfma_f32_32x32x16_f16(pa2, mk8(l2, h2), od, 0, 0, 0);
    od = __builtin_amdgcn_mfma_f32_32x32x16_f16(pa3, mk8(l3, h3), od, 0, 0, 0);
}
__device__ __forceinline__ void pv_d0(f32x16 (&o)[4], int vb, h8 pa0, h8 pa1, h8 pa2, h8 pa3) {
    pv_one<0>(o[0], vb, pa0, pa1, pa2, pa3); pv_one<1>(o[1], vb, pa0, pa1, pa2, pa3); pv_one<2>(o[2], vb, pa0, pa1, pa2, pa3); pv_one<3>(o[3], vb, pa0, pa1, pa2, pa3);
}
__device__ __forceinline__ void qkt(f32x16& p0, f32x16& p1, const char* Ks, const h8 (&qr)[8], int r32, int hi) {
    p0 = f32x16{}; p1 = f32x16{};
#pragma unroll
    for (int d0 = 0; d0 < 8; ++d0) { const int cb = (d0 * 16 + hi * 8) * 2;
        const h8 b0 = *reinterpret_cast<const h8*>(Ks + AT_KSWZ(r32, cb));
        const h8 b1 = *reinterpret_cast<const h8*>(Ks + AT_KSWZ(32 + r32, cb));
        p0 = __builtin_amdgcn_mfma_f32_32x32x16_f16(b0, qr[d0], p0, 0, 0, 0);
        p1 = __builtin_amdgcn_mfma_f32_32x32x16_f16(b1, qr[d0], p1, 0, 0, 0); }
}
__device__ __forceinline__ void pack_p(const f32x16& p0, const f32x16& p1, h8& pa0, h8& pa1, h8& pa2, h8& pa3) {
#define AT_PK4(P, BASE, OUT) do { unsigned a0 = cvtpk(P[BASE + 0], P[BASE + 1]), a1 = cvtpk(P[BASE + 2], P[BASE + 3]); \
    unsigned b0 = cvtpk(P[BASE + 4], P[BASE + 5]), b1 = cvtpk(P[BASE + 6], P[BASE + 7]); \
    auto r0 = __builtin_amdgcn_permlane32_swap(a0, b0, false, false); auto r1 = __builtin_amdgcn_permlane32_swap(a1, b1, false, false); \
    u32x4 w = {r0[0], r1[0], r0[1], r1[1]}; OUT = *reinterpret_cast<h8*>(&w); } while (0)
    AT_PK4(p0, 0, pa0); AT_PK4(p0, 8, pa1); AT_PK4(p1, 0, pa2); AT_PK4(p1, 8, pa3);
#undef AT_PK4
}
__device__ __forceinline__ float half_swap_max(float v) { auto rr = __builtin_amdgcn_permlane32_swap(__float_as_uint(v), __float_as_uint(v), false, false); return fmaxf(__uint_as_float(rr[0]), __uint_as_float(rr[1])); }
__device__ __forceinline__ float half_swap_sum(float v) { auto rr = __builtin_amdgcn_permlane32_swap(__float_as_uint(v), __float_as_uint(v), false, false); return __uint_as_float(rr[0]) + __uint_as_float(rr[1]); }

struct Stage4 { h8 vs0, vs1, ks0, ks1; };
__device__ __forceinline__ void sload(Stage4& s, const _Float16* Kb, const _Float16* Vb, int ld, int k0, int sr, int sc) {
    s.vs0 = *(const h8*)(Vb + (size_t)(k0 + sr) * ld + sc); s.vs1 = *(const h8*)(Vb + (size_t)(k0 + 32 + sr) * ld + sc);
    s.ks0 = *(const h8*)(Kb + (size_t)(k0 + sr) * ld + sc); s.ks1 = *(const h8*)(Kb + (size_t)(k0 + 32 + sr) * ld + sc);
}
__device__ __forceinline__ void swrite(const Stage4& s, char* V_lds, char* K_lds, int b, int sr, int sc, int vst0, int vst1) {
    *(h8*)(V_lds + b * SHM_V + vst0) = s.vs0; *(h8*)(V_lds + b * SHM_V + vst1) = s.vs1;
    const int kc = sc * 2;
    *(h8*)(K_lds + b * SHM_K + AT_KSWZ(sr, kc)) = s.ks0; *(h8*)(K_lds + b * SHM_K + AT_KSWZ(32 + sr, kc)) = s.ks1;
}

__device__ __forceinline__ void attn_unit(char* lds, const _Float16* qrow, const _Float16* Kb, const _Float16* Vb, int ld, unsigned tmask, int klo, int khi, unsigned selmask,
                                          float* outw, int ostride) {
    const int tid = threadIdx.x, wid = tid >> 6, lane = tid & 63, r32 = lane & 31, hi = lane >> 5;
    char* V_lds = lds; char* K_lds = lds + 2 * SHM_V;
    float* wsf = (float*)(lds + LDS_WS) + wid * 64; float* li_l = wsf; float* al_l = wsf + 32;
    float m_reg = -1e30f, l_reg = 0.f; f32x16 o[4] = {}; h8 qr[8];
#pragma unroll
    for (int d0 = 0; d0 < 8; ++d0) qr[d0] = *(const h8*)(qrow + d0 * 16);
    const int sr = tid >> 4, sc = (tid & 15) * 8, vst0 = v_st(sr, sc), vst1 = v_st(32 + sr, sc);
    const int vb0 = (int)(uintptr_t)V_lds + v_rd_base(lane);
    Stage4 st;
    unsigned rest = tmask; int j = __ffs(rest) - 1; rest &= rest - 1;
    sload(st, Kb, Vb, ld, j * 64, sr, sc); asm volatile("s_waitcnt vmcnt(0)" ::: "memory"); swrite(st, V_lds, K_lds, 0, sr, sc, vst0, vst1); __syncthreads();
    int buf = 0;
    for (;;) {
        const int jn = rest ? (__ffs(rest) - 1) : -1;
        if (jn >= 0) sload(st, Kb, Vb, ld, jn * 64, sr, sc);
        f32x16 p0, p1;
        AT_SBAR(); qkt(p0, p1, K_lds + buf * SHM_K, qr, r32, hi);
        { const int kb = j * 64 + 4 * hi; const bool tb = (selmask >> j) & 1u;
#pragma unroll
          for (int r = 0; r < 16; ++r) { const int k0 = kb + (r & 3) + 8 * (r >> 2);
              p0[r] = (tb && k0 >= klo && k0 <= khi) ? p0[r] : -INFINITY;
              p1[r] = (tb && (k0 + 32) >= klo && (k0 + 32) <= khi) ? p1[r] : -INFINITY; } }
        float pmax = p0[0];
#pragma unroll
        for (int r = 1; r < 16; ++r) pmax = fmaxf(pmax, p0[r]);
#pragma unroll
        for (int r = 0; r < 16; ++r) pmax = fmaxf(pmax, p1[r]);
        pmax = half_swap_max(pmax);
        float mn, alpha;
        if (__all(pmax - m_reg <= THR_RAW)) { mn = m_reg; alpha = 1.f; }
        else { mn = fmaxf(m_reg, pmax); alpha = __builtin_amdgcn_exp2f((m_reg - mn) * CEXP); m_reg = mn; }
        const float mnC = -mn * CEXP;
        float ps = 0.f;
#pragma unroll
        for (int r = 0; r < 16; ++r) { p0[r] = __builtin_amdgcn_exp2f(fmaf(p0[r], CEXP, mnC)); ps += p0[r]; }
#pragma unroll
        for (int r = 0; r < 16; ++r) { p1[r] = __builtin_amdgcn_exp2f(fmaf(p1[r], CEXP, mnC)); ps += p1[r]; }
        ps = half_swap_sum(ps);
        l_reg = l_reg * alpha + ps;
        if (__any(alpha < 1.f)) { if (hi == 0) al_l[r32] = alpha; asm volatile("s_waitcnt lgkmcnt(0)" ::: "memory");
#pragma unroll
            for (int r = 0; r < 16; ++r) { const float a = al_l[crow(r, hi)];
#pragma unroll
                for (int d = 0; d < 4; ++d) o[d][r] *= a; } }
        h8 pa0, pa1, pa2, pa3; pack_p(p0, p1, pa0, pa1, pa2, pa3);
        AT_SBAR();
        pv_d0(o, vb0 + buf * SHM_V, pa0, pa1, pa2, pa3);
        if (jn < 0) break;
        asm volatile("s_waitcnt vmcnt(0)" ::: "memory");
        swrite(st, V_lds, K_lds, buf ^ 1, sr, sc, vst0, vst1);
        __syncthreads();
        buf ^= 1; j = jn; rest &= rest - 1;
    }
    if (hi == 0) li_l[r32] = l_reg; asm volatile("s_waitcnt lgkmcnt(0)" ::: "memory");
#pragma unroll
    for (int r = 0; r < 16; ++r) { const int orow = crow(r, hi); const float l = li_l[orow]; const float rl = l > 0.f ? 1.f / l : 0.f;
#pragma unroll
        for (int d0 = 0; d0 < 4; ++d0) outw[(size_t)orow * ostride + d0 * 32 + r32] = o[d0][r] * rl; }
    __syncthreads();
}
}

__device__ __forceinline__ void conv_tile(float* lds, const float* __restrict__ W, int ldw, int nvalid, _Float16* __restrict__ Wt, int K, int k0, int n0) {
    const int tid = threadIdx.x;
    float4 v[8];
#pragma unroll
    for (int i = 0; i < 8; ++i) { const int idx = tid + 512 * i, r = idx >> 6, c4 = (idx & 63) * 4;
        v[i] = (n0 + c4 < nvalid) ? *(const float4*)(W + (size_t)(k0 + r) * ldw + n0 + c4) : make_float4(0.f, 0.f, 0.f, 0.f); }
#pragma unroll
    for (int i = 0; i < 8; ++i) { const int idx = tid + 512 * i, r = idx >> 6, c4 = (idx & 63) * 4; float* d = lds + r * 257 + c4; d[0] = v[i].x; d[1] = v[i].y; d[2] = v[i].z; d[3] = v[i].w; }
    __syncthreads();
#pragma unroll
    for (int j = 0; j < 4; ++j) { const int id = tid + 512 * j, n = id >> 3, k8 = (id & 7) * 8; h8 o;
#pragma unroll
        for (int q = 0; q < 8; ++q) o[q] = (_Float16)lds[(k8 + q) * 257 + n];
        *(h8*)(Wt + (size_t)(n0 + n) * K + k0 + k8) = o; }
    __syncthreads();
}

__global__ void __launch_bounds__(512, 2) fwd(Params p) {
    extern __shared__ __attribute__((aligned(16))) char smem[];
    const int tid = threadIdx.x, lane = tid & 63, wv = tid >> 6;
    const int bid = blockIdx.x, nb = gridDim.x;
    const int gw = bid * 8 + wv, nw = nb * 8;
    const int lo = (int)(p.lo_hi & 0xffffffffll), hi = (int)(p.lo_hi >> 32);
    unsigned char* ws = p.ws;
    unsigned* ctl = (unsigned*)(ws + WS_CTL);
    int* cnt = (int*)(ws + CTL_CNT);
    float* proj = (float*)(ws + WS_PROJ);
    float* kvmem = (float*)(ws + WS_KVMEM);
    float* bias1 = (float*)(ws + WS_BIAS1);
    float* hid = (float*)(ws + WS_HID);
    float* kc = (float*)(ws + WS_KC);
    float* vc = (float*)(ws + WS_VC);
    float* pooled = (float*)(ws + WS_POOLED);
    float* opool = (float*)(ws + WS_OPOOL);
    float* owin = (float*)(ws + WS_OWIN);
    float* ocmp = (float*)(ws + WS_OCMP);
    float* oslc = (float*)(ws + WS_OSLC);
    unsigned* sel = (unsigned*)(ws + WS_SEL);
    float* omem = (float*)(ws + WS_OMEM);
    _Float16* cat16 = (_Float16*)(ws + WS_CAT16);
    float* hpre = (float*)(ws + WS_HPRE);
    float* hbuf = (float*)(ws + WS_H);
    float* gate = (float*)(ws + WS_GATE);
    int* list = (int*)(ws + WS_LIST);
    _Float16* act16 = (_Float16*)(ws + WS_ACT16);
    _Float16* y16 = (_Float16*)(ws + WS_Y16);
    _Float16* h16 = (_Float16*)(ws + WS_H16);
    _Float16* x16 = (_Float16*)(ws + WS_X16);
    _Float16* wtin = (_Float16*)(ws + WS_WTIN);
    _Float16* wtout = (_Float16*)(ws + WS_WTOUT);
    _Float16* wtgu = (_Float16*)(ws + WS_WTGU);
    _Float16* wtdn = (_Float16*)(ws + WS_WTDN);
    LAS unsigned char* lds = (LAS unsigned char*)smem;
    _Float16* proj16 = (_Float16*)(ws + WS_PROJ16);
    _Float16* kvmem16 = (_Float16*)(ws + WS_KVMEM16);
    const int vcu = (nb % 8 == 0) ? (bid % 8) * (nb / 8) + bid / 8 : bid;

    volatile LAS unsigned* xbw = (volatile LAS unsigned*)(smem + LDS_BYTES - 16);
    if (tid == 0) { xbw[0] = 0u; xbw[1] = 0u; xbw[2] = 0u; xbw[3] = 0u; }
    __syncthreads();
    XcdBarrier bar; bar.bar = ctl; bar.x = 0; bar.st = xbw;
    const bool multi = (hi - lo) > 1;
    if (multi) bar = xcd_barrier_post(ctl, xbw);
#define IN(k) (lo <= (k) && (k) < hi)
#define SEAM(k) do { if (IN(k) && IN((k) + 1)) xcd_barrier(bar); } while (0)
    float* sw = (float*)smem + wv * WLDS_FLOATS;
    int* segw = (int*)(sw + 4096 + 512);

    if (IN(0)) {
        for (int j = gw; j < 512; j += nw) {
            const int kv = j >> 8, jj = j & 255;
            const float* pos = p.in[kv ? I_POSV : I_POSK]; const float* w1 = p.in[kv ? I_W1V : I_W1K];
            float s = 0.f;
            for (int k = lane; k < 4096; k += 64) s += pos[k] * w1[(size_t)k * 256 + jj];
            s = wave_sum(s);
            if (lane == 0) bias1[j] = s;
        }
        for (size_t i = (size_t)bid * 512 + tid; i < (size_t)T_ * 2048 / 4; i += (size_t)nb * 512) {
            const float4 v = ((const float4*)p.in[I_X])[i]; ((h4*)x16)[i] = (h4){(_Float16)v.x, (_Float16)v.y, (_Float16)v.z, (_Float16)v.w};
        }
        {
            constexpr int U_GU = NE * 32 * 16, U_DN = NE * 32 * 8, U_IN = 32 * 15, U_OUT = 32 * 8;
            for (int u = bid; u < U_GU + U_DN + U_IN + U_OUT; u += nb) {
                if (u < U_GU) { const int e = u / 512, r = u % 512, kt = r / 16, ntl = r % 16;
                    conv_tile((float*)smem, p.in[I_WGU] + (size_t)e * 2048 * 4096, 4096, 4096, wtgu + (size_t)e * 4096 * 2048, 2048, kt * 64, ntl * 256);
                } else if (u < U_GU + U_DN) { const int v = u - U_GU, e = v / 256, r = v % 256, kt = r / 8, ntl = r % 8;
                    conv_tile((float*)smem, p.in[I_WDN] + (size_t)e * 2048 * 2048, 2048, 2048, wtdn + (size_t)e * 2048 * 2048, 2048, kt * 64, ntl * 256);
                } else if (u < U_GU + U_DN + U_IN) { const int v = u - U_GU - U_DN, kt = v / 15, ntl = v % 15;
                    conv_tile((float*)smem, p.in[I_WIN], INW, INW, wtin, 2048, kt * 64, ntl * 256);
                } else { const int v = u - U_GU - U_DN - U_IN, kt = v / 8, ntl = v % 8;
                    conv_tile((float*)smem, p.in[I_WOUT], 2048, 2048, wtout, 2048, kt * 64, ntl * 256);
                }
            }
        }
        for (int u = bid; u < 16 * 8; u += nb) { const int nt = u / 16, mt = u % 16;
            ARowPlain af{p.in[I_MEM], 2048, mt * 128, 2048}; EpiStore ef{kvmem, 1024, mt * 128, nt * 128, 2048, 1024, kvmem16};
            gemm_tile(smem, 2048, af, p.in[I_WMEMKV], 1024, nt * 128, 1024, false, ef);
        }
    }
    SEAM(0);
    if (IN(1)) {
        g8::ProbIn P{x16, wtin, proj, proj16, nb, bid};
        g8::gemm_phase(lds, P);
    }
    SEAM(1);
    if (IN(2)) {
        for (int u = bid; u < 64; u += nb) { const int kv = u >> 5, r = u & 31, nt = r >> 4, mt = r & 15;
            ARowCmp af{proj, kv ? C_VC : C_KC, mt * 128}; EpiHid ef{hid + (size_t)kv * 2048 * 256, bias1 + kv * 256, mt * 128, nt * 128};
            gemm_tile(smem, 4096, af, p.in[kv ? I_W1V : I_W1K], 256, nt * 128, 256, false, ef);
        }
        for (size_t i = (size_t)bid * 512 + tid; i < (size_t)T_ * 512; i += (size_t)nb * 512) {
            const int col = (int)(i & 511), row = (int)(i >> 9), t = row & (S_ - 1), g = col >> 7;
            const int win = 2 << g; const int lo_t = max(t + 1 - win, 0); const int n = t + 1 - lo_t;
            float s = 0.f;
            for (int k = 0; k < n; ++k) s += proj[(size_t)(row - k) * INW + C_UP + col];
            pooled[i] = s / (float)n - proj[(size_t)row * INW + C_UP + col];
        }
        {
            const int r32 = lane & 31, hi = lane >> 5, g = wv >> 1, half = wv & 1;
            for (int uu = bid; uu < 512; uu += nb) {
                const int u = (uu & 1) ? (511 - (uu >> 1)) : (uu >> 1);
                const int bk = u >> 5, qi = u & 31, b = bk >> 1, kvh = bk & 1;
                const int t = qi * 64 + half * 32 + r32;
                const int lo_t = max(0, qi - 8);
                const unsigned tmask = (unsigned)(((1ull << (qi + 1)) - 1ull) & ~((1ull << lo_t) - 1ull));
                at8::attn_unit(smem, proj16 + (size_t)(b * S_ + t) * INW + C_Q + (kvh * 4 + g) * 128 + hi * 8,
                               proj16 + (size_t)b * S_ * INW + C_KW + kvh * 128, proj16 + (size_t)b * S_ * INW + C_VW + kvh * 128, INW, tmask, t - 511, t, 0xffffffffu,
                               owin + (size_t)(b * S_ + qi * 64 + half * 32) * 1024 + (kvh * 4 + g) * 128, 1024);
            }
            for (int u = bid; u < 256; u += nb) {
                const int b = u >> 5, h = (u >> 3) & 3, qt = u & 7;
                const int t = qt * 256 + wv * 32 + r32;
                at8::attn_unit(smem, proj16 + (size_t)(b * S_ + t) * INW + C_QM + h * 128 + hi * 8,
                               kvmem16 + (size_t)b * 256 * 1024 + h * 128, kvmem16 + (size_t)b * 256 * 1024 + 512 + h * 128, 1024, 0xFu, 0, 255, 0xffffffffu,
                               omem + (size_t)(b * S_ + qt * 256 + wv * 32) * 512 + h * 128, 512);
            }
        }
    }
    SEAM(2);
    if (IN(3)) {
        for (size_t i = (size_t)bid * 512 + tid; i < (size_t)2 * CROWS * 128; i += (size_t)nb * 512) {
            const int kv = (int)(i / ((size_t)CROWS * 128)); const int r = (int)(i % ((size_t)CROWS * 128)); const int row = r >> 7, d = r & 127;
            const float* hr = hid + (size_t)kv * 2048 * 256 + (size_t)row * 256; const float* w2 = p.in[kv ? I_W2V : I_W2K];
            float s = 0.f;
            for (int k = 0; k < 256; ++k) s += hr[k] * w2[k * 128 + d];
            (kv ? vc : kc)[(size_t)row * 128 + d] = s;
        }
        for (size_t i = (size_t)bid * 512 + tid; i < (size_t)T_ * 512; i += (size_t)nb * 512) {
            const int col = (int)(i & 511), row = (int)(i >> 9), g = col >> 7, d = col & 127;
            const float* pr = pooled + (size_t)row * 512 + g * 128; const float* w = p.in[I_POOLW] + (size_t)g * 128 * 128;
            float s = 0.f;
            for (int c = 0; c < 128; ++c) s += pr[c] * w[c * 128 + d];
            opool[i] = s * p.in[I_POOLS][col];
        }
    }
    SEAM(3);
    if (IN(4)) {
        for (int u = gw; u < T_ * 2; u += nw) {
            const int kvh = u & 1, row = u >> 1, b = row >> 11, t = row & (S_ - 1);
            const int nvalid = t >= 31 ? min(NC, (t - 31) / 16 + 1) : 0, nseg = (nvalid + 63) >> 6;
            if (lane < 16) { segw[lane] = 64 * lane; segw[16 + lane] = min(64, nvalid - 64 * lane); }
            wave_sync();
            wave_attn<true>(sw, proj + (size_t)row * INW + C_Q + kvh * 512, kc + (size_t)b * NC * 256 + kvh * 128, vc + (size_t)b * NC * 256 + kvh * 128, 256, nseg, ATT_SCALE,
                            ocmp + (size_t)row * 1024 + kvh * 512);
            wave_sync();
            float* ps = sw + 4096;
            const int n = nseg * 64;
            ps[lane] = lane < n ? sw[lane] + sw[1024 + lane] + sw[2048 + lane] + sw[3072 + lane] : 0.f;
            ps[lane + 64] = (lane + 64) < n ? sw[lane + 64] + sw[1024 + lane + 64] + sw[2048 + lane + 64] + sw[3072 + lane + 64] : 0.f;
            wave_sync();
            const int j = lane & 31, cur = t >> 6;
            float imp = 0.f;
#pragma unroll
            for (int dc = -1; dc <= 3; ++dc) { const int c = 4 * j + dc; if (c >= 0 && c < NC) imp += ps[c] * ((dc == -1 || dc == 3) ? 1.f : 2.f); }
            const bool forced = (j == 0) || (j == cur) || (j == cur - 1), valid = j <= cur;
            const float iv = forced ? 1e9f : (valid ? imp : -1e9f);
            int rank = 0;
            for (int i = 0; i < 32; ++i) { const float vi = __shfl(iv, i); rank += (vi > iv || (vi == iv && i < j)) ? 1 : 0; }
            const unsigned long long bal = __ballot(lane < 32 && rank < 16 && valid);
            if (lane == 0) sel[u] = (unsigned)bal;
            wave_sync();
        }
    }
    SEAM(4);
    if (IN(5)) {
        for (int u = gw; u < T_ * 2; u += nw) {
            const int kvh = u & 1, row = u >> 1, b = row >> 11, t = row & (S_ - 1);
            const unsigned m = __hip_atomic_load(&sel[u], __ATOMIC_RELAXED, __HIP_MEMORY_SCOPE_AGENT);
            const int nseg = __popc(m);
            if (lane < 32 && ((m >> lane) & 1u)) { const int pos = __popc(m & ((1u << lane) - 1u)); segw[pos] = 64 * lane; segw[16 + pos] = min(64, t + 1 - 64 * lane); }
            wave_sync();
            wave_attn<true>(sw, proj + (size_t)row * INW + C_Q + kvh * 512, proj + (size_t)b * S_ * INW + C_KS + kvh * 128, proj + (size_t)b * S_ * INW + C_VS + kvh * 128,
                            INW, nseg, ATT_SCALE, oslc + (size_t)row * 1024 + kvh * 512);
            wave_sync();
        }
    }
    SEAM(5);
    if (IN(6)) {
        for (int row = gw; row < T_; row += nw) {
            const float* pr = proj + (size_t)row * INW;
            float v[16]; float ss = 0.f;
#pragma unroll
            for (int i = 0; i < 16; ++i) { const int col = lane + 64 * i, h = col >> 7; const size_t o = (size_t)row * 1024 + col;
                const float g0 = sigmoidf_(pr[C_G + h * 3]), g1 = sigmoidf_(pr[C_G + h * 3 + 1]), g2 = sigmoidf_(pr[C_G + h * 3 + 2]);
                v[i] = g0 * ocmp[o] + g1 * oslc[o] + g2 * owin[o]; ss += v[i] * v[i]; }
            ss = wave_sum(ss); float r = rsqrtf(ss / 1024.f + LN_EPS);
#pragma unroll
            for (int i = 0; i < 16; ++i) { const int col = lane + 64 * i; cat16[(size_t)row * 2048 + col] = (_Float16)(v[i] * r * p.in[I_GNNSA][col]); }
            ss = 0.f;
#pragma unroll
            for (int i = 0; i < 8; ++i) { v[i] = opool[(size_t)row * 512 + lane + 64 * i]; ss += v[i] * v[i]; }
            ss = wave_sum(ss); r = rsqrtf(ss / 512.f + LN_EPS);
#pragma unroll
            for (int i = 0; i < 8; ++i) { const int col = lane + 64 * i; cat16[(size_t)row * 2048 + 1024 + col] = (_Float16)(v[i] * r * p.in[I_GNPOOL][col]); }
            ss = 0.f;
#pragma unroll
            for (int i = 0; i < 8; ++i) { v[i] = omem[(size_t)row * 512 + lane + 64 * i]; ss += v[i] * v[i]; }
            ss = wave_sum(ss); r = rsqrtf(ss / 512.f + LN_EPS);
#pragma unroll
            for (int i = 0; i < 8; ++i) { const int col = lane + 64 * i; cat16[(size_t)row * 2048 + 1536 + col] = (_Float16)(v[i] * r * p.in[I_GNMEM][col]); }
        }
    }
    SEAM(6);
    if (IN(7)) {
        g8::ProbOut P{cat16, wtout, hpre, p.in[I_X], nb, bid};
        g8::gemm_phase(lds, P);
    }
    SEAM(7);
    if (IN(8)) {
        for (int row = gw; row < T_; row += nw) {
            float v[32]; float s = 0.f;
#pragma unroll
            for (int i = 0; i < 32; ++i) { v[i] = hpre[(size_t)row * 2048 + lane + 64 * i]; s += v[i]; }
            const float mu = wave_sum(s) / 2048.f; float q = 0.f;
#pragma unroll
            for (int i = 0; i < 32; ++i) { const float d = v[i] - mu; q += d * d; }
            const float rs = rsqrtf(wave_sum(q) / 2048.f + LN_EPS);
#pragma unroll
            for (int i = 0; i < 32; ++i) { const int col = lane + 64 * i; v[i] = (v[i] - mu) * rs * p.in[I_LN1G][col] + p.in[I_LN1B][col]; hbuf[(size_t)row * 2048 + col] = v[i]; h16[(size_t)row * 2048 + col] = (_Float16)v[i]; }
            float part[32];
#pragma unroll
            for (int e = 0; e < 32; ++e) part[e] = 0.f;
#pragma unroll 1
            for (int i = 0; i < 32; ++i) { const float4* wp = (const float4*)(p.in[I_WR] + (size_t)(lane + 64 * i) * 32); const float hv = hbuf[(size_t)row * 2048 + lane + 64 * i];
#pragma unroll
                for (int q4 = 0; q4 < 8; ++q4) { const float4 w = wp[q4]; part[4 * q4] += hv * w.x; part[4 * q4 + 1] += hv * w.y; part[4 * q4 + 2] += hv * w.z; part[4 * q4 + 3] += hv * w.w; } }
            float mine = 0.f;
#pragma unroll
            for (int e = 0; e < 32; ++e) { const float a = wave_sum(part[e]) + p.in[I_BR][e]; if (lane == e) mine = a; }
            const int j = lane & 31; const float iv = __shfl(mine, j);
            int rank = 0;
            for (int i = 0; i < 32; ++i) { const float vi = __shfl(iv, i); rank += (vi > iv || (vi == iv && i < j)) ? 1 : 0; }
            float tv[4]; int te[4];
#pragma unroll
            for (int r = 0; r < 4; ++r) { const unsigned long long bm = __ballot(lane < 32 && rank == r); const int src = __ffsll((long long)bm) - 1; te[r] = src; tv[r] = __shfl(iv, src); }
            const float mx = tv[0];
            float e0 = expf(tv[0] - mx), e1 = expf(tv[1] - mx), e2 = expf(tv[2] - mx), e3 = expf(tv[3] - mx); const float inv = 1.f / (e0 + e1 + e2 + e3);
            if (lane < 4) { const int e = lane == 0 ? te[0] : lane == 1 ? te[1] : lane == 2 ? te[2] : te[3]; const float g = (lane == 0 ? e0 : lane == 1 ? e1 : lane == 2 ? e2 : e3) * inv;
                const int a = row * 4 + lane; const int pos = atomicAdd(&cnt[e], 1); list[(size_t)e * T_ + pos] = a; gate[a] = g; }
        }
    }
    SEAM(8);
    LAS int* mtab = (LAS int*)(smem + g8::STAGE_BYTES);
    if (IN(9)) {
        if (tid == 0) { int ub = 0, rs = 0;
            for (int e = 0; e < NE; ++e) { const int c = (int)__hip_atomic_load((unsigned*)&cnt[e], __ATOMIC_RELAXED, __HIP_MEMORY_SCOPE_AGENT); mtab[e] = c; mtab[32 + e] = ub; mtab[65 + e] = rs; ub += ((c + 255) >> 8) * 16; rs += c; }
            mtab[64] = ub; mtab[97] = rs; mtab[98] = ub; }
        __syncthreads();
        g8::ProbGu P{h16, wtgu, act16, p.in[I_BGU], list, g8::MoeTab{mtab, 16}, nb, vcu};
        g8::gemm_phase(lds, P);
        __syncthreads();
    }
    SEAM(9);
    if (IN(10)) {
        if (tid == 0) { int ub = 0, rs = 0;
            for (int e = 0; e < NE; ++e) { const int c = (int)__hip_atomic_load((unsigned*)&cnt[e], __ATOMIC_RELAXED, __HIP_MEMORY_SCOPE_AGENT); mtab[e] = c; mtab[32 + e] = ub; mtab[65 + e] = rs; ub += ((c + 255) >> 8) * 8; rs += c; }
            mtab[64] = ub; mtab[97] = rs; mtab[98] = ub; }
        __syncthreads();
        g8::ProbDn P{act16, wtdn, y16, p.in[I_BDN], list, gate, g8::MoeTab{mtab, 8}, nb, vcu};
        g8::gemm_phase(lds, P);
        __syncthreads();
    }
    SEAM(10);
    if (IN(11)) {
        for (int row = gw; row < T_; row += nw) {
            float v[32]; float s = 0.f;
#pragma unroll
            for (int c = 0; c < 4; ++c) { const int col = (lane + 64 * c) * 8; const size_t yo = (size_t)row * 4 * 2048 + col;
                const float4 ha = *(const float4*)(hbuf + (size_t)row * 2048 + col), hb = *(const float4*)(hbuf + (size_t)row * 2048 + col + 4);
                const h8 y0 = *(const h8*)(y16 + yo), y1 = *(const h8*)(y16 + yo + 2048), y2 = *(const h8*)(y16 + yo + 4096), y3 = *(const h8*)(y16 + yo + 6144);
                const float hh[8] = {ha.x, ha.y, ha.z, ha.w, hb.x, hb.y, hb.z, hb.w};
#pragma unroll
                for (int q = 0; q < 8; ++q) { v[c * 8 + q] = DN_ALPHA * hh[q] + (((float)y0[q] + (float)y1[q]) + ((float)y2[q] + (float)y3[q])); s += v[c * 8 + q]; } }
            const float mu = wave_sum(s) / 2048.f; float q2 = 0.f;
#pragma unroll
            for (int i = 0; i < 32; ++i) { const float d = v[i] - mu; q2 += d * d; }
            const float rs = rsqrtf(wave_sum(q2) / 2048.f + LN_EPS);
#pragma unroll
            for (int c = 0; c < 4; ++c) { const int col = (lane + 64 * c) * 8;
                const float4 ga = *(const float4*)(p.in[I_LN2G] + col), gb = *(const float4*)(p.in[I_LN2G] + col + 4), ba = *(const float4*)(p.in[I_LN2B] + col), bb = *(const float4*)(p.in[I_LN2B] + col + 4);
                float4 o0, o1;
                o0.x = (v[c * 8 + 0] - mu) * rs * ga.x + ba.x; o0.y = (v[c * 8 + 1] - mu) * rs * ga.y + ba.y; o0.z = (v[c * 8 + 2] - mu) * rs * ga.z + ba.z; o0.w = (v[c * 8 + 3] - mu) * rs * ga.w + ba.w;
                o1.x = (v[c * 8 + 4] - mu) * rs * gb.x + bb.x; o1.y = (v[c * 8 + 5] - mu) * rs * gb.y + bb.y; o1.z = (v[c * 8 + 6] - mu) * rs * gb.z + bb.z; o1.w = (v[c * 8 + 7] - mu) * rs * gb.w + bb.w;
                *(float4*)(p.out + (size_t)row * 2048 + col) = o0; *(float4*)(p.out + (size_t)row * 2048 + col + 4) = o1; }
        }
    }
}

constexpr int NPHASE = 12;

extern "C" void kernel_launch(void* const* d_in, const int* in_sizes, int n_in, void* d_out, int out_size, void* d_ws, size_t ws_size, hipStream_t stream) {
    static int grid = 0;
    if (grid == 0) {
        if (n_in != 26 || ws_size < WS_END) { fprintf(stderr, "kernel_launch: unexpected n_in %d or ws_size %zu (< %zu)\n", n_in, ws_size, (size_t)WS_END); grid = -1; return; }
        int dev = 0, cus = 0, per_cu = 0;
        hipGetDevice(&dev); hipDeviceGetAttribute(&cus, hipDeviceAttributeMultiprocessorCount, dev);
        if (hipFuncSetAttribute((const void*)fwd, hipFuncAttributeMaxDynamicSharedMemorySize, LDS_BYTES) != hipSuccess) { fprintf(stderr, "hipFuncSetAttribute failed\n"); grid = -1; return; }
        hipOccupancyMaxActiveBlocksPerMultiprocessor(&per_cu, (const void*)fwd, 512, LDS_BYTES);
        (void)hipGetLastError();
        if (per_cu < 1) fprintf(stderr, "occupancy query says %d blocks per CU\n", per_cu);
        grid = cus > 0 ? cus : 256;
    }
    if (grid < 0) return;
    hipMemsetAsync((char*)d_ws + WS_CTL, 0, CTL_BYTES, stream);
    Params p{};
    for (int i = 0; i < 26; ++i) p.in[i] = (const float*)d_in[i];
    p.out = (float*)d_out; p.ws = (unsigned char*)d_ws;
#if N_LAUNCH_MODE == 1
    p.lo_hi = (long long)0 | ((long long)NPHASE << 32);
    hipLaunchKernelGGL(fwd, dim3(grid), dim3(512), LDS_BYTES, stream, p);
#else
    for (int ph = 0; ph < NPHASE; ++ph) {
        p.lo_hi = (long long)ph | ((long long)(ph + 1) << 32);
        hipLaunchKernelGGL(fwd, dim3(grid), dim3(512), LDS_BYTES, stream, p);
    }
#endif
}
```

```cpp
#include <hip/hip_runtime.h>
#include <cstdio>
#include <cstdint>

#ifndef N_LAUNCH_MODE
#define N_LAUNCH_MODE 1
#endif

constexpr int B_ = 8, S_ = 2048, D_ = 2048, T_ = B_ * S_;
constexpr int INW = 3608;
constexpr int C_Q = 0, C_KC = 1024, C_VC = 1280, C_KS = 1536, C_VS = 1792, C_KW = 2048, C_VW = 2304, C_G = 2560, C_UP = 2584, C_QM = 3096;
constexpr int NC = 127;
constexpr int CROWS = B_ * NC * 2;
constexpr int NE = 32, DE = 2048, NA = T_ * 4;
constexpr float LN_EPS = 1e-5f;
constexpr float DN_ALPHA = 1.189207115002721f;
constexpr float ATT_SCALE = 0.08838834764831845f;

constexpr size_t al256(size_t x) { return (x + 255) & ~(size_t)255; }
constexpr size_t WS_CTL = 0;
constexpr size_t CTL_BYTES = 65536;
constexpr size_t CTL_CNT = 16384;
constexpr size_t WS_PROJ = CTL_BYTES;
constexpr size_t WS_KVMEM = WS_PROJ + al256((size_t)T_ * INW * 4);
constexpr size_t WS_BIAS1 = WS_KVMEM + al256((size_t)2048 * 1024 * 4);
constexpr size_t WS_HID = WS_BIAS1 + al256(2 * 256 * 4);
constexpr size_t WS_KC = WS_HID + al256((size_t)2 * 2048 * 256 * 4);
constexpr size_t WS_VC = WS_KC + al256((size_t)CROWS * 128 * 4);
constexpr size_t WS_POOLED = WS_VC + al256((size_t)CROWS * 128 * 4);
constexpr size_t WS_OPOOL = WS_POOLED + al256((size_t)T_ * 512 * 4);
constexpr size_t WS_OWIN = WS_OPOOL + al256((size_t)T_ * 512 * 4);
constexpr size_t WS_OCMP = WS_OWIN + al256((size_t)T_ * 1024 * 4);
constexpr size_t WS_OSLC = WS_OCMP + al256((size_t)T_ * 1024 * 4);
constexpr size_t WS_SEL = WS_OSLC + al256((size_t)T_ * 1024 * 4);
constexpr size_t WS_OMEM = WS_SEL + al256((size_t)T_ * 2 * 4);
constexpr size_t WS_CAT16 = WS_OMEM + al256((size_t)T_ * 512 * 4);
constexpr size_t WS_HPRE = WS_CAT16 + al256((size_t)T_ * 2048 * 2);
constexpr size_t WS_H = WS_HPRE + al256((size_t)T_ * 2048 * 4);
constexpr size_t WS_H16 = WS_H + al256((size_t)T_ * 2048 * 4);
constexpr size_t WS_GATE = WS_H16 + al256((size_t)T_ * 2048 * 2);
constexpr size_t WS_LIST = WS_GATE + al256((size_t)NA * 4);
constexpr size_t WS_ACT16 = WS_LIST + al256((size_t)NE * T_ * 4);
constexpr size_t WS_Y16 = WS_ACT16 + al256((size_t)(NA + 256) * 2048 * 2);
constexpr size_t WS_X16 = WS_Y16 + al256((size_t)NA * 2048 * 2);
constexpr size_t WS_WTIN = WS_X16 + al256((size_t)T_ * 2048 * 2);
constexpr size_t WS_WTOUT = WS_WTIN + al256((size_t)3840 * 2048 * 2);
constexpr size_t WS_WTGU = WS_WTOUT + al256((size_t)2048 * 2048 * 2);
constexpr size_t WS_WTDN = WS_WTGU + al256((size_t)NE * 4096 * 2048 * 2);
constexpr size_t WS_PROJ16 = WS_WTDN + al256((size_t)NE * 2048 * 2048 * 2);
constexpr size_t WS_KVMEM16 = WS_PROJ16 + al256((size_t)(T_ + 64) * INW * 2);
constexpr size_t WS_WT1 = WS_KVMEM16 + al256((size_t)2048 * 1024 * 2);
constexpr size_t WS_UV = WS_WT1 + al256((size_t)2 * 512 * 2048 * 2);
constexpr size_t WS_KC16 = WS_UV + al256((size_t)2 * 4 * 2048 * 512 * 4);
constexpr size_t WS_VC16 = WS_KC16 + al256((size_t)B_ * 128 * 256 * 2);
constexpr size_t WS_END = WS_VC16 + al256((size_t)B_ * 128 * 256 * 2);

constexpr int LDS_BYTES = 155648;

struct Params {
    const float* in[26];
    float* out;
    unsigned char* ws;
    long long lo_hi;
};
enum { I_X = 0, I_MEM, I_WIN, I_POSK, I_W1K, I_W2K, I_POSV, I_W1V, I_W2V, I_POOLW, I_POOLS, I_WMEMKV, I_GNNSA, I_GNPOOL, I_GNMEM, I_WOUT,
       I_LN1G, I_LN1B, I_WR, I_BR, I_WGU, I_BGU, I_WDN, I_BDN, I_LN2G, I_LN2B };

#define XB_TMO      128
#define XB_XCNT(j)  (256  + 64 * (j))
#define XB_XSUB(j)  (1280 + 64 * (j))
#define XB_XGEN(j)  (2304 + 64 * (j))
#define XB_TOP      3328
#define XB_TOPGEN   3392
#define XCD_BAR_WORDS 3456
#define XB_SPIN_CAP (1u << 25)
#define LAS __attribute__((address_space(3)))

__device__ __forceinline__ unsigned xb_ld(unsigned* p)              { return __hip_atomic_load(p, __ATOMIC_RELAXED, __HIP_MEMORY_SCOPE_AGENT); }
__device__ __forceinline__ unsigned xb_add(unsigned* p, unsigned v) { return __hip_atomic_fetch_add(p, v, __ATOMIC_RELAXED, __HIP_MEMORY_SCOPE_AGENT); }
__device__ __forceinline__ unsigned xb_xcc_id() { return (unsigned)__builtin_amdgcn_s_getreg((3 << 11) | 20) & 0xFu; }
#define XB_SPIN(cond, bar) do { unsigned _sp = 0; while (cond) { __builtin_amdgcn_s_sleep(1); \
    if ((++_sp & 255u) == 0u) { if (xb_ld(&(bar)[XB_TMO])) break; if (_sp > XB_SPIN_CAP) { atomicAdd(&(bar)[XB_TMO], 1u); break; } } } } while (0)

struct XcdBarrier { unsigned* bar; unsigned x; volatile LAS unsigned* st; };

__device__ __forceinline__ XcdBarrier xcd_barrier_post(unsigned* bar, volatile LAS unsigned* st) {
    XcdBarrier b; b.bar = bar; b.x = xb_xcc_id(); b.st = st;
    if (threadIdx.x == 0) (void)xb_add(&bar[XB_XCNT(b.x)], 1u);
    return b;
}
__device__ __forceinline__ void xcd_barrier_complete(unsigned* bar, unsigned x, unsigned& nloc, unsigned& nx) {
    const unsigned G = gridDim.x * gridDim.y * gridDim.z;
    unsigned sum, cnt, mine, sp = 0u;
    for (;;) {
        sum = 0u; cnt = 0u; mine = 0u;
#pragma unroll
        for (unsigned j = 0; j < 16; ++j) { const unsigned c = xb_ld(&bar[XB_XCNT(j)]); sum += c; cnt += (c > 0u) ? 1u : 0u; mine = (j == x) ? c : mine; }
        if (sum == G) break;
        __builtin_amdgcn_s_sleep(1);
        if ((++sp & 255u) == 0u) { if (xb_ld(&bar[XB_TMO])) break; if (sp > XB_SPIN_CAP) { atomicAdd(&bar[XB_TMO], 1u); break; } }
    }
    nloc = mine > 0u ? mine : 1u; nx = cnt > 0u ? cnt : 1u;
}
__device__ __forceinline__ void xcd_barrier(const XcdBarrier& b) {
    asm volatile("s_waitcnt vmcnt(0)" ::: "memory");
    __syncthreads();
    if (threadIdx.x == 0) {
        unsigned* bar = b.bar;
        __builtin_amdgcn_s_waitcnt(0);
        unsigned nloc = b.st[0], nx = b.st[1];
        if (nloc == 0u) { xcd_barrier_complete(bar, b.x, nloc, nx); b.st[0] = nloc; b.st[1] = nx; }
        const unsigned old = xb_add(&bar[XB_XSUB(b.x)], 1u);
        const unsigned gen = old / nloc;
        if (old + 1u == (gen + 1u) * nloc) {
            __builtin_amdgcn_fence(__ATOMIC_RELEASE, "agent");
            asm volatile("s_waitcnt vmcnt(0)" ::: "memory");
            const unsigned og = xb_add(&bar[XB_TOP], 1u);
            const unsigned tg = og / nx;
            if (og + 1u == (tg + 1u) * nx) xb_add(&bar[XB_TOPGEN], 1u);
            else XB_SPIN(xb_ld(&bar[XB_TOPGEN]) == tg, bar);
            __builtin_amdgcn_fence(__ATOMIC_ACQUIRE, "agent");
            xb_add(&bar[XB_XGEN(b.x)], 1u);
            asm volatile("s_waitcnt vmcnt(0)" ::: "memory");
        } else {
            XB_SPIN(xb_ld(&bar[XB_XGEN(b.x)]) == gen, bar);
            __builtin_amdgcn_fence(__ATOMIC_ACQUIRE, "agent");
            asm volatile("s_waitcnt vmcnt(0)" ::: "memory");
        }
    }
    __syncthreads();
}

typedef _Float16 h8 __attribute__((ext_vector_type(8)));
typedef _Float16 h4 __attribute__((ext_vector_type(4)));
typedef float f4 __attribute__((ext_vector_type(4)));

__device__ __forceinline__ float wave_sum(float v) {
#pragma unroll
    for (int o = 32; o > 0; o >>= 1) v += __shfl_xor(v, o);
    return v;
}
__device__ __forceinline__ float wave_max(float v) {
#pragma unroll
    for (int o = 32; o > 0; o >>= 1) v = fmaxf(v, __shfl_xor(v, o));
    return v;
}
__device__ __forceinline__ void wave_sync() {
    asm volatile("s_waitcnt lgkmcnt(0)" ::: "memory");
    __builtin_amdgcn_wave_barrier();
}
__device__ __forceinline__ float gelu_tanh(float x) {
    const float u = 0.7978845608028654f * (x + 0.044715f * x * x * x);
    return 0.5f * x * (1.f + tanhf(u));
}
__device__ __forceinline__ float sigmoidf_(float x) { return 1.f / (1.f + expf(-x)); }

constexpr int G_LD = 40;
template <class AF, class EF>
__device__ __forceinline__ void gemm_tile(char* smem, int K, const AF& af, const float* __restrict__ Bm, int ldb, int n0, int Nlim, bool perm, const EF& ef) {
    _Float16* As = (_Float16*)smem;
    _Float16* Bs = As + 128 * G_LD;
    const int tid = threadIdx.x, lane = tid & 63, wid = tid >> 6, wr = wid >> 2, wc = wid & 3, fr = lane & 15, fq = lane >> 4;
    f4 acc[4][2];
#pragma unroll
    for (int m = 0; m < 4; ++m)
#pragma unroll
        for (int n = 0; n < 2; ++n) acc[m][n] = (f4){0.f, 0.f, 0.f, 0.f};
    const int ar = tid >> 3, ak = (tid & 7) * 4;
    const float* ap0 = af.row(ar);
    const float* ap1 = af.row(ar + 64);
    const int bk = tid >> 5, bn = (tid & 31) * 4;
    const bool bok = (n0 + bn) < Nlim;
    int bnp[4];
#pragma unroll
    for (int i = 0; i < 4; ++i) { const int c = bn + i; bnp[i] = perm ? ((c & ~31) | ((c & 1) << 4) | ((c & 31) >> 1)) : c; }
    for (int k0 = 0; k0 < K; k0 += 32) {
        const int ko = af.koff(k0 + ak);
        float4 a0 = make_float4(0.f, 0.f, 0.f, 0.f), a1 = a0, b0 = a0, b1 = a0;
        if (ap0) a0 = *(const float4*)(ap0 + ko);
        if (ap1) a1 = *(const float4*)(ap1 + ko);
        if (bok) { b0 = *(const float4*)(Bm + (size_t)(k0 + bk) * ldb + n0 + bn); b1 = *(const float4*)(Bm + (size_t)(k0 + bk + 16) * ldb + n0 + bn); }
        __syncthreads();
        *(h4*)&As[ar * G_LD + ak] = (h4){(_Float16)a0.x, (_Float16)a0.y, (_Float16)a0.z, (_Float16)a0.w};
        *(h4*)&As[(ar + 64) * G_LD + ak] = (h4){(_Float16)a1.x, (_Float16)a1.y, (_Float16)a1.z, (_Float16)a1.w};
        Bs[bnp[0] * G_LD + bk] = (_Float16)b0.x; Bs[bnp[1] * G_LD + bk] = (_Float16)b0.y; Bs[bnp[2] * G_LD + bk] = (_Float16)b0.z; Bs[bnp[3] * G_LD + bk] = (_Float16)b0.w;
        Bs[bnp[0] * G_LD + bk + 16] = (_Float16)b1.x; Bs[bnp[1] * G_LD + bk + 16] = (_Float16)b1.y; Bs[bnp[2] * G_LD + bk + 16] = (_Float16)b1.z; Bs[bnp[3] * G_LD + bk + 16] = (_Float16)b1.w;
        __syncthreads();
        h8 a[4], b[2];
#pragma unroll
        for (int m = 0; m < 4; ++m) a[m] = *(const h8*)&As[(wr * 64 + m * 16 + fr) * G_LD + fq * 8];
#pragma unroll
        for (int n = 0; n < 2; ++n) b[n] = *(const h8*)&Bs[(wc * 32 + n * 16 + fr) * G_LD + fq * 8];
#pragma unroll
        for (int m = 0; m < 4; ++m)
#pragma unroll
            for (int n = 0; n < 2; ++n) acc[m][n] = __builtin_amdgcn_mfma_f32_16x16x32_f16(a[m], b[n], acc[m][n], 0, 0, 0);
    }
    ef(acc, wr, wc, fr, fq);
    __syncthreads();
}

struct ARowPlain { const float* base; int ld; int m0; int mlim;
    __device__ __forceinline__ const float* row(int r) const { return (m0 + r) < mlim ? base + (size_t)(m0 + r) * ld : nullptr; }
    __device__ __forceinline__ int koff(int k) const { return k; } };
struct ARowCmp { const float* proj; int col; int m0;
    __device__ __forceinline__ const float* row(int r) const { const int g = m0 + r; if (g >= CROWS) return nullptr; const int kvh = g & 1, bc = g >> 1, b = bc / NC, c = bc % NC;
        return proj + (size_t)(b * S_ + 16 * c) * INW + col + kvh * 128; }
    __device__ __forceinline__ int koff(int k) const { return (k >> 7) * INW + (k & 127); } };
struct ARowList { const float* base; const int* list; int m0; int cnt; int shift;
    __device__ __forceinline__ const float* row(int r) const { if (m0 + r >= cnt) return nullptr; const int a = list[m0 + r]; return base + (size_t)(a >> shift) * 2048; }
    __device__ __forceinline__ int koff(int k) const { return k; } };

struct EpiStore { float* C; int ldc; int m0; int n0; int mlim; int nlim; _Float16* C16;
    __device__ __forceinline__ void operator()(const f4 (&acc)[4][2], int wr, int wc, int fr, int fq) const {
#pragma unroll
        for (int m = 0; m < 4; ++m)
#pragma unroll
            for (int n = 0; n < 2; ++n)
#pragma unroll
                for (int j = 0; j < 4; ++j) { const int r = m0 + wr * 64 + m * 16 + fq * 4 + j, c = n0 + wc * 32 + n * 16 + fr;
                    if (r < mlim && c < nlim) { C[(size_t)r * ldc + c] = acc[m][n][j]; if (C16) C16[(size_t)r * ldc + c] = (_Float16)acc[m][n][j]; } } } };
struct EpiPool { float* C; const float* scale; int m0; int g;
    __device__ __forceinline__ void operator()(const f4 (&acc)[4][2], int wr, int wc, int fr, int fq) const {
#pragma unroll
        for (int m = 0; m < 4; ++m)
#pragma unroll
            for (int n = 0; n < 2; ++n)
#pragma unroll
                for (int j = 0; j < 4; ++j) { const int r = m0 + wr * 64 + m * 16 + fq * 4 + j, c = g * 128 + wc * 32 + n * 16 + fr;
                    C[(size_t)r * 512 + c] = acc[m][n][j] * scale[c]; } } };
struct EpiHid { float* C; const float* bias; int m0; int n0;
    __device__ __forceinline__ void operator()(const f4 (&acc)[4][2], int wr, int wc, int fr, int fq) const {
#pragma unroll
        for (int m = 0; m < 4; ++m)
#pragma unroll
            for (int n = 0; n < 2; ++n)
#pragma unroll
                for (int j = 0; j < 4; ++j) { const int r = m0 + wr * 64 + m * 16 + fq * 4 + j, c = n0 + wc * 32 + n * 16 + fr;
                    if (r < CROWS) C[(size_t)r * 256 + c] = gelu_tanh(acc[m][n][j] + bias[c]); } } };
struct EpiOut { float* C; const float* x; int m0; int n0;
    __device__ __forceinline__ void operator()(const f4 (&acc)[4][2], int wr, int wc, int fr, int fq) const {
#pragma unroll
        for (int m = 0; m < 4; ++m)
#pragma unroll
            for (int n = 0; n < 2; ++n)
#pragma unroll
                for (int j = 0; j < 4; ++j) { const size_t o = (size_t)(m0 + wr * 64 + m * 16 + fq * 4 + j) * 2048 + n0 + wc * 32 + n * 16 + fr;
                    C[o] = DN_ALPHA * x[o] + acc[m][n][j]; } } };
struct EpiGu { float* act; const float* bgu; const int* list; int m0; int cnt; int n0;
    __device__ __forceinline__ void operator()(const f4 (&acc)[4][2], int wr, int wc, int fr, int fq) const {
        const int jc = (n0 + wc * 32) / 2 + fr;
        const float bg = bgu[2 * jc], bl = bgu[2 * jc + 1];
#pragma unroll
        for (int m = 0; m < 4; ++m)
#pragma unroll
            for (int j = 0; j < 4; ++j) { const int r = m0 + wr * 64 + m * 16 + fq * 4 + j;
                if (r < cnt) { const int a = list[r];
                    const float xg = fminf(acc[m][0][j] + bg, 7.f), xl = fminf(fmaxf(acc[m][1][j] + bl, -7.f), 7.f);
                    act[(size_t)a * 2048 + jc] = xg * sigmoidf_(1.702f * xg) * (xl + 1.f); } } } };
struct EpiDn { float* y; const float* bdn; const int* list; const float* gate; int m0; int cnt; int n0;
    __device__ __forceinline__ void operator()(const f4 (&acc)[4][2], int wr, int wc, int fr, int fq) const {
#pragma unroll
        for (int m = 0; m < 4; ++m)
#pragma unroll
            for (int j = 0; j < 4; ++j) { const int r = m0 + wr * 64 + m * 16 + fq * 4 + j;
                if (r < cnt) { const int a = list[r]; const float g = gate[a];
#pragma unroll
                    for (int n = 0; n < 2; ++n) { const int c = n0 + wc * 32 + n * 16 + fr; y[(size_t)a * 2048 + c] = (acc[m][n][j] + bdn[c]) * g; } } } } };

constexpr int WLDS_FLOATS = 4096 + 512 + 32;
template <bool SHARED>
__device__ __forceinline__ void wave_attn(float* sw, const float* __restrict__ qptr, const float* __restrict__ Kb, const float* __restrict__ Vb, int ld, int nseg, float scale, float* __restrict__ optr) {
    const int lane = threadIdx.x & 63;
    float* sq = sw + 4096; const int* segs = (const int*)(sw + 4096 + 512);
#pragma unroll
    for (int i = 0; i < 8; ++i) sq[lane + 64 * i] = qptr[lane + 64 * i];
    wave_sync();
    for (int sg = 0; sg < nseg; ++sg) {
        const int start = segs[sg], len = segs[16 + sg];
        float d0 = 0.f, d1 = 0.f, d2 = 0.f, d3 = 0.f;
        if (lane < len) {
            const float* kp = Kb + (size_t)(start + lane) * ld;
            for (int d4 = 0; d4 < 32; ++d4) {
                if (SHARED) {
                    const float4 kv = *(const float4*)(kp + d4 * 4);
                    const float4 q0 = *(const float4*)(sq + d4 * 4), q1 = *(const float4*)(sq + 128 + d4 * 4), q2 = *(const float4*)(sq + 256 + d4 * 4), q3 = *(const float4*)(sq + 384 + d4 * 4);
                    d0 += kv.x * q0.x + kv.y * q0.y + kv.z * q0.z + kv.w * q0.w;
                    d1 += kv.x * q1.x + kv.y * q1.y + kv.z * q1.z + kv.w * q1.w;
                    d2 += kv.x * q2.x + kv.y * q2.y + kv.z * q2.z + kv.w * q2.w;
                    d3 += kv.x * q3.x + kv.y * q3.y + kv.z * q3.z + kv.w * q3.w;
                } else {
                    const float4 k0 = *(const float4*)(kp + d4 * 4), k1 = *(const float4*)(kp + 128 + d4 * 4), k2 = *(const float4*)(kp + 256 + d4 * 4), k3 = *(const float4*)(kp + 384 + d4 * 4);
                    const float4 q0 = *(const float4*)(sq + d4 * 4), q1 = *(const float4*)(sq + 128 + d4 * 4), q2 = *(const float4*)(sq + 256 + d4 * 4), q3 = *(const float4*)(sq + 384 + d4 * 4);
                    d0 += k0.x * q0.x + k0.y * q0.y + k0.z * q0.z + k0.w * q0.w;
                    d1 += k1.x * q1.x + k1.y * q1.y + k1.z * q1.z + k1.w * q1.w;
                    d2 += k2.x * q2.x + k2.y * q2.y + k2.z * q2.z + k2.w * q2.w;
                    d3 += k3.x * q3.x + k3.y * q3.y + k3.z * q3.z + k3.w * q3.w;
                }
            }
        }
        const bool ok = lane < len;
        sw[sg * 64 + lane] = ok ? d0 * scale : -1e30f;
        sw[1024 + sg * 64 + lane] = ok ? d1 * scale : -1e30f;
        sw[2048 + sg * 64 + lane] = ok ? d2 * scale : -1e30f;
        sw[3072 + sg * 64 + lane] = ok ? d3 * scale : -1e30f;
    }
    wave_sync();
    const int n = nseg * 64;
#pragma unroll
    for (int g = 0; g < 4; ++g) {
        float mx = -1e30f;
        for (int i = lane; i < n; i += 64) mx = fmaxf(mx, sw[g * 1024 + i]);
        mx = wave_max(mx);
        float sm = 0.f;
        for (int i = lane; i < n; i += 64) { const float v = sw[g * 1024 + i]; sm += (v > -1e29f) ? expf(v - mx) : 0.f; }
        sm = wave_sum(sm);
        const float inv = sm > 0.f ? 1.f / sm : 0.f;
        for (int i = lane; i < n; i += 64) { const float v = sw[g * 1024 + i]; sw[g * 1024 + i] = (v > -1e29f) ? expf(v - mx) * inv : 0.f; }
    }
    wave_sync();
    float o[4][2];
#pragma unroll
    for (int g = 0; g < 4; ++g) { o[g][0] = 0.f; o[g][1] = 0.f; }
    for (int sg = 0; sg < nseg; ++sg) {
        const int start = segs[sg], len = segs[16 + sg];
        for (int l = 0; l < len; ++l) {
            const float* vp = Vb + (size_t)(start + l) * ld;
            if (SHARED) {
                const float v0 = vp[lane], v1 = vp[lane + 64];
#pragma unroll
                for (int g = 0; g < 4; ++g) { const float p = sw[g * 1024 + sg * 64 + l]; o[g][0] += p * v0; o[g][1] += p * v1; }
            } else {
#pragma unroll
                for (int g = 0; g < 4; ++g) { const float p = sw[g * 1024 + sg * 64 + l]; o[g][0] += p * vp[g * 128 + lane]; o[g][1] += p * vp[g * 128 + lane + 64]; }
            }
        }
    }
#pragma unroll
    for (int g = 0; g < 4; ++g) { optr[g * 128 + lane] = o[g][0]; optr[g * 128 + lane + 64] = o[g][1]; }
}

namespace g8 {
constexpr int BM = 256, BK = 64, HALF = 128, HTB = HALF * BK * 2, STAGE_BYTES = 8 * HTB;
constexpr int KK = 2048;
typedef float f32x4 __attribute__((ext_vector_type(4)));
__device__ __forceinline__ int lds_byte(int r, int c) { const int st = (r >> 4) * 2 + (c >> 5), rr = r & 15, cc = c & 31, ob = rr * 64 + cc * 2; return st * 1024 + (ob ^ (((ob >> 9) & 1) << 5)); }
__device__ __forceinline__ void stage_rc(int b, int& R, int& C) { const int st = b / 1024, sb = b % 1024, swz = sb ^ (((sb >> 9) & 1) << 5); R = (st >> 1) * 16 + swz / 64; C = (st & 1) * 32 + (swz % 64) / 2; }
__device__ __forceinline__ int perm32(int rho) { const int n = rho >> 4, i = rho & 15; return 8 * (i >> 2) + 4 * n + (i & 3); }

struct Unit { int m0, n0, e, cnt, rbase; };

__device__ __forceinline__ void tile_order(int L, int nM, int nN, int& pm, int& pn) {
    const int nwg = nM * nN; int wgid = L;
    { const int q = nwg / 8, r = nwg % 8, xcd = wgid % 8, off = wgid / 8; wgid = (xcd < r ? xcd * (q + 1) : r * (q + 1) + (xcd - r) * q) + off; }
    const int nig = 8 * nN, gid = wgid / nig, fm = gid * 8, gsz = (nM - fm) < 8 ? (nM - fm) : 8;
    pm = fm + ((wgid % nig) % gsz); pn = (wgid % nig) / gsz;
}

template <class Prob>
__device__ __forceinline__ void gemm_phase(LAS unsigned char* lds, const Prob& P) {
    const int tid = threadIdx.x, wid = __builtin_amdgcn_readfirstlane(tid >> 6), lane = tid & 63, wr = wid >> 2, wc = wid & 3, fr = lane & 15, fq = lane >> 4;
    constexpr int K = KK, nt = Prob::NT; constexpr size_t KS2 = Prob::KS2;
    int sR[2], sC2[2]; unsigned voffB[2];
#pragma unroll
    for (int i = 0; i < 2; ++i) { int R, C; stage_rc(tid * 16 + i * 8192, R, C); sR[i] = R; sC2[i] = C * 2; const int Rb = Prob::PERM ? ((R & ~31) + perm32(R & 31)) : R; voffB[i] = (unsigned)(Rb * K + C) * 2u; }
    const size_t kstep = (size_t)(BK * 2);
    const size_t hstep = (size_t)HALF * K * 2;
    const unsigned ldsw = (unsigned)wid * 1024u;
    const int aoff = lds_byte(wr * 64 + fr, fq * 8), boff = lds_byte(wc * 32 + fr, fq * 8);
#define G8_SA(b, h) (((b) * 2 + (h)) * HTB)
#define G8_SB(b, h) ((4 + (b) * 2 + (h)) * HTB)
#define G8_STAGE(bufoff, gbase, voff) do { _Pragma("unroll") for (int _i = 0; _i < 2; ++_i) \
        __builtin_amdgcn_global_load_lds((const unsigned*)((const char*)(gbase) + (voff)[_i]), (LAS unsigned*)(lds + (bufoff) + ldsw + _i * 8192), 16, 0, 0); } while (0)
#define G8_LDA(dst, b, h) do { _Pragma("unroll") for (int m = 0; m < 4; ++m) _Pragma("unroll") for (int k = 0; k < 2; ++k) dst[m][k] = *(const LAS h8*)(lds + G8_SA(b, h) + aoff + m * 2048 + k * 1024); } while (0)
#define G8_LDB(dst, b, h) do { _Pragma("unroll") for (int n = 0; n < 2; ++n) _Pragma("unroll") for (int k = 0; k < 2; ++k) dst[n][k] = *(const LAS h8*)(lds + G8_SB(b, h) + boff + n * 2048 + k * 1024); } while (0)
#define G8_MMA(ai, bj, At, Bt) do { __builtin_amdgcn_s_setprio(1); _Pragma("unroll") for (int m = 0; m < 4; ++m) _Pragma("unroll") for (int n = 0; n < 2; ++n) _Pragma("unroll") for (int k = 0; k < 2; ++k) \
        acc[ai][bj][m][n] = __builtin_amdgcn_mfma_f32_16x16x32_f16(Bt[n][k], At[m][k], acc[ai][bj][m][n], 0, 0, 0); __builtin_amdgcn_s_setprio(0); } while (0)
#define G8_WAIT_V(n) asm volatile("s_waitcnt vmcnt(" #n ")" ::: "memory")
#define G8_WAIT_L(n) asm volatile("s_waitcnt lgkmcnt(" #n ")" ::: "memory")
#define G8_BAR __builtin_amdgcn_s_barrier()
#define G8_SCHED __builtin_amdgcn_sched_barrier(0)
    Unit cur, nxt; int ui = 0;
    if (!P.next(0, cur)) return;
    f32x4 acc[2][2][4][2];
#pragma unroll
    for (int a = 0; a < 2; ++a)
#pragma unroll
        for (int b = 0; b < 2; ++b)
#pragma unroll
            for (int m = 0; m < 4; ++m)
#pragma unroll
                for (int n = 0; n < 2; ++n) acc[a][b][m][n] = (f32x4){0.f, 0.f, 0.f, 0.f};
    h8 At[4][2], B0[2][2], B1[2][2];
    unsigned vc[2][2], vn[2][2];
    P.a_offs(cur, sR, sC2, vc);
    const char* const Ab = P.a_base();
    const char* cB = P.b_base(cur);
    G8_STAGE(G8_SB(0, 0), cB, voffB); G8_STAGE(G8_SA(0, 0), Ab, vc[0]); G8_STAGE(G8_SB(0, 1), cB + hstep, voffB); G8_STAGE(G8_SA(0, 1), Ab, vc[1]);
    if (wr == 1) G8_BAR;
    G8_WAIT_V(4); G8_BAR;
    G8_STAGE(G8_SB(1, 0), cB + kstep, voffB); G8_STAGE(G8_SA(1, 0), Ab + kstep, vc[0]); G8_STAGE(G8_SB(1, 1), cB + hstep + kstep, voffB);
    G8_WAIT_V(6); G8_BAR;
    for (;;) {
        const bool has_next = P.next(ui + 1, nxt);
        const char* nB = cB;
        if (has_next) { P.a_offs(nxt, sR, sC2, vn); nB = P.b_base(nxt); }
        else { vn[0][0] = vc[0][0]; vn[0][1] = vc[0][1]; vn[1][0] = vc[1][0]; vn[1][1] = vc[1][1]; }
        for (int t = 0; t < nt; t += 2) {
            const bool last = (t == nt - 2);
            const char* a1 = Ab + (size_t)(t >> 1) * KS2 + kstep;
            const char* a2 = last ? Ab : Ab + (size_t)((t + 2) >> 1) * KS2; const char* b2 = last ? nB : cB + (size_t)(t + 2) * kstep;
            const char* a3 = a2 + kstep; const char* b3 = b2 + kstep;
            unsigned o2[2][2];
            o2[0][0] = last ? vn[0][0] : vc[0][0]; o2[0][1] = last ? vn[0][1] : vc[0][1]; o2[1][0] = last ? vn[1][0] : vc[1][0]; o2[1][1] = last ? vn[1][1] : vc[1][1];
            G8_LDB(B0, 0, 0); G8_SCHED; G8_LDA(At, 0, 0); G8_STAGE(G8_SA(1, 1), a1, vc[1]);
            G8_WAIT_L(8); G8_BAR; G8_WAIT_L(0); G8_MMA(0, 0, At, B0); G8_BAR; G8_SCHED;
            G8_LDB(B1, 0, 1); G8_STAGE(G8_SB(0, 0), b2, voffB);
            G8_BAR; G8_WAIT_L(0); G8_MMA(0, 1, At, B1); G8_BAR;
            G8_LDA(At, 0, 1); G8_STAGE(G8_SA(0, 0), a2, o2[0]);
            G8_BAR; G8_WAIT_L(0); G8_MMA(1, 0, At, B0); G8_BAR; G8_SCHED;
            G8_STAGE(G8_SB(0, 1), b2 + hstep, voffB);
            G8_WAIT_V(6); G8_BAR; G8_MMA(1, 1, At, B1); G8_BAR;
            G8_LDB(B0, 1, 0); G8_SCHED; G8_LDA(At, 1, 0); G8_STAGE(G8_SA(0, 1), a2, o2[1]);
            G8_WAIT_L(8); G8_BAR; G8_WAIT_L(0); G8_MMA(0, 0, At, B0); G8_BAR; G8_SCHED;
            G8_LDB(B1, 1, 1); G8_STAGE(G8_SB(1, 0), b3, voffB);
            G8_BAR; G8_WAIT_L(0); G8_MMA(0, 1, At, B1); G8_BAR;
            G8_LDA(At, 1, 1); G8_STAGE(G8_SA(1, 0), a3, o2[0]);
            G8_BAR; G8_WAIT_L(0); G8_MMA(1, 0, At, B0); G8_BAR; G8_SCHED;
            G8_STAGE(G8_SB(1, 1), b3 + hstep, voffB);
            G8_WAIT_V(6); G8_BAR; G8_MMA(1, 1, At, B1); G8_BAR;
        }
        P.epi(acc, cur, wr, wc, fr, fq);
        if (!has_next) break;
#pragma unroll
        for (int a = 0; a < 2; ++a)
#pragma unroll
            for (int b = 0; b < 2; ++b)
#pragma unroll
                for (int m = 0; m < 4; ++m)
#pragma unroll
                    for (int n = 0; n < 2; ++n) acc[a][b][m][n] = (f32x4){0.f, 0.f, 0.f, 0.f};
        cur = nxt; cB = nB; ++ui;
        vc[0][0] = vn[0][0]; vc[0][1] = vn[0][1]; vc[1][0] = vn[1][0]; vc[1][1] = vn[1][1];
    }
    G8_WAIT_V(0);
    if (wr == 0) G8_BAR;
    G8_BAR;
#undef G8_SA
#undef G8_SB
#undef G8_STAGE
#undef G8_LDA
#undef G8_LDB
#undef G8_MMA
#undef G8_WAIT_V
#undef G8_WAIT_L
#undef G8_BAR
#undef G8_SCHED
}

struct ProbIn {
    static constexpr int NT = 32; static constexpr size_t KS2 = 256;
    static constexpr bool PERM = false;
    const _Float16* A; const _Float16* Bt; float* C; _Float16* C16; int G, c;
    __device__ __forceinline__ bool next(int i, Unit& u) const { const int L = i * G + c; if (L >= 64 * 15) return false; int pm, pn; tile_order(L, 64, 15, pm, pn); u.m0 = pm * 256; u.n0 = pn * 256; u.e = 0; u.cnt = 256; u.rbase = 0; return true; }
    __device__ __forceinline__ void a_offs(const Unit& u, const int (&R)[2], const int (&C2)[2], unsigned (&v)[2][2]) const {
#pragma unroll
        for (int h = 0; h < 2; ++h)
#pragma unroll
            for (int i = 0; i < 2; ++i) v[h][i] = (unsigned)(u.m0 + h * 128 + R[i]) * (unsigned)(KK * 2) + (unsigned)C2[i]; }
    __device__ __forceinline__ const char* a_base() const { return (const char*)A; }
    __device__ __forceinline__ const char* b_base(const Unit& u) const { return (const char*)(Bt + (size_t)u.n0 * KK); }
    __device__ __forceinline__ void epi(const f32x4 (&acc)[2][2][4][2], const Unit& u, int wr, int wc, int fr, int fq) const {
#pragma unroll
        for (int ai = 0; ai < 2; ++ai)
#pragma unroll
            for (int m = 0; m < 4; ++m) { const int row = u.m0 + ai * 128 + wr * 64 + m * 16 + fr;
#pragma unroll
                for (int bj = 0; bj < 2; ++bj)
#pragma unroll
                    for (int n = 0; n < 2; ++n) { const int col = u.n0 + bj * 128 + wc * 32 + n * 16 + fq * 4;
                        if (col < INW) { const f32x4 v = acc[ai][bj][m][n]; *(f32x4*)(C + (size_t)row * INW + col) = v;
                            *(h4*)(C16 + (size_t)row * INW + col) = (h4){(_Float16)v[0], (_Float16)v[1], (_Float16)v[2], (_Float16)v[3]}; } } } }
};
struct ProbOut {
    static constexpr int NT = 32; static constexpr size_t KS2 = 256;
    static constexpr bool PERM = false;
    const _Float16* A; const _Float16* Bt; float* C; const float* X; int G, c;
    __device__ __forceinline__ bool next(int i, Unit& u) const { const int L = i * G + c; if (L >= 64 * 8) return false; int pm, pn; tile_order(L, 64, 8, pm, pn); u.m0 = pm * 256; u.n0 = pn * 256; u.e = 0; u.cnt = 256; u.rbase = 0; return true; }
    __device__ __forceinline__ void a_offs(const Unit& u, const int (&R)[2], const int (&C2)[2], unsigned (&v)[2][2]) const {
#pragma unroll
        for (int h = 0; h < 2; ++h)
#pragma unroll
            for (int i = 0; i < 2; ++i) v[h][i] = (unsigned)(u.m0 + h * 128 + R[i]) * (unsigned)(KK * 2) + (unsigned)C2[i]; }
    __device__ __forceinline__ const char* a_base() const { return (const char*)A; }
    __device__ __forceinline__ const char* b_base(const Unit& u) const { return (const char*)(Bt + (size_t)u.n0 * KK); }
    __device__ __forceinline__ void epi(const f32x4 (&acc)[2][2][4][2], const Unit& u, int wr, int wc, int fr, int fq) const {
#pragma unroll
        for (int ai = 0; ai < 2; ++ai)
#pragma unroll
            for (int m = 0; m < 4; ++m) { const int row = u.m0 + ai * 128 + wr * 64 + m * 16 + fr;
#pragma unroll
                for (int bj = 0; bj < 2; ++bj)
#pragma unroll
                    for (int n = 0; n < 2; ++n) { const size_t o = (size_t)row * 2048 + u.n0 + bj * 128 + wc * 32 + n * 16 + fq * 4;
                        const f32x4 xv = *(const f32x4*)(X + o); *(f32x4*)(C + o) = xv * DN_ALPHA + acc[ai][bj][m][n]; } } }
};
struct ProbCmp {
    static constexpr int NT = 8; static constexpr size_t KS2 = (size_t)INW * 2;
    static constexpr bool PERM = false;
    const _Float16* A; const _Float16* Bt; float* C; int G, c;
    __device__ __forceinline__ bool next(int i, Unit& u) const { const int L = i * G + c; if (L >= 128) return false;
        u.e = L >> 6; const int r = L & 63; u.rbase = r & 3; u.n0 = ((r >> 2) & 1) * 256; u.m0 = (r >> 3) * 256; u.cnt = 256; return true; }
    __device__ __forceinline__ void a_offs(const Unit& u, const int (&R)[2], const int (&C2)[2], unsigned (&v)[2][2]) const {
#pragma unroll
        for (int h = 0; h < 2; ++h)
#pragma unroll
            for (int i = 0; i < 2; ++i) { const int row = u.m0 + h * 128 + R[i], kvh = row & 1, bj = row >> 1, b = bj >> 7, j = bj & 127;
                v[h][i] = (unsigned)((b * S_ + 16 * j + 4 * u.rbase) * INW + (u.e ? C_VC : C_KC) + kvh * 128) * 2u + (unsigned)C2[i]; } }
    __device__ __forceinline__ const char* a_base() const { return (const char*)A; }
    __device__ __forceinline__ const char* b_base(const Unit& u) const { return (const char*)(Bt + ((size_t)u.e * 512 + u.n0) * KK + u.rbase * 512); }
    __device__ __forceinline__ void epi(const f32x4 (&acc)[2][2][4][2], const Unit& u, int wr, int wc, int fr, int fq) const {
        float* base = C + ((size_t)(u.e * 4 + u.rbase) * 2048) * 512;
#pragma unroll
        for (int ai = 0; ai < 2; ++ai)
#pragma unroll
            for (int m = 0; m < 4; ++m) { const int row = u.m0 + ai * 128 + wr * 64 + m * 16 + fr;
#pragma unroll
                for (int bj = 0; bj < 2; ++bj)
#pragma unroll
                    for (int n = 0; n < 2; ++n) { const int col = u.n0 + bj * 128 + wc * 32 + n * 16 + fq * 4;
                        *(f32x4*)(base + (size_t)row * 512 + col) = acc[ai][bj][m][n]; } } }
};
struct MoeTab { const LAS int* t; int NT;
    __device__ __forceinline__ bool find(int L, Unit& u) const {
        const int total = __builtin_amdgcn_readfirstlane(t[98]); if (L >= total) return false;
        int e = 0;
        for (; e < NE - 1; ++e) { if (L < __builtin_amdgcn_readfirstlane(t[32 + e + 1])) break; }
        const int ub = __builtin_amdgcn_readfirstlane(t[32 + e]), cn = __builtin_amdgcn_readfirstlane(t[e]), rs = __builtin_amdgcn_readfirstlane(t[65 + e]);
        const int nm = (cn + 255) >> 8, v = L - ub, mt = v % nm, ntile = v / nm;
        u.e = e; u.m0 = mt * 256; u.n0 = ntile * 256; u.cnt = min(256, cn - mt * 256); u.rbase = rs; return true; } };
struct ProbGu {
    static constexpr int NT = 32; static constexpr size_t KS2 = 256;
    static constexpr bool PERM = true;
    const _Float16* A; const _Float16* Bt; _Float16* act; const float* bgu; const int* list; MoeTab tab; int G, vcu;
    __device__ __forceinline__ bool next(int i, Unit& u) const { return tab.find(i * G + vcu, u); }
    __device__ __forceinline__ void a_offs(const Unit& u, const int (&R)[2], const int (&C2)[2], unsigned (&v)[2][2]) const {
#pragma unroll
        for (int h = 0; h < 2; ++h)
#pragma unroll
            for (int i = 0; i < 2; ++i) { int r = h * 128 + R[i]; r = r < u.cnt ? r : 0; const int a = list[(size_t)u.e * T_ + u.m0 + r]; v[h][i] = (unsigned)(a >> 2) * (unsigned)(KK * 2) + (unsigned)C2[i]; } }
    __device__ __forceinline__ const char* a_base() const { return (const char*)A; }
    __device__ __forceinline__ const char* b_base(const Unit& u) const { return (const char*)(Bt + ((size_t)u.e * 4096 + u.n0) * KK); }
    __device__ __forceinline__ void epi(const f32x4 (&acc)[2][2][4][2], const Unit& u, int wr, int wc, int fr, int fq) const {
        const float* bb = bgu + (size_t)u.e * 4096;
#pragma unroll
        for (int bj = 0; bj < 2; ++bj) { const int col = u.n0 + bj * 128 + wc * 32 + fq * 8;
            const f32x4 b0 = *(const f32x4*)(bb + col), b1 = *(const f32x4*)(bb + col + 4);
#pragma unroll
            for (int ai = 0; ai < 2; ++ai)
#pragma unroll
                for (int m = 0; m < 4; ++m) { const int rl = ai * 128 + wr * 64 + m * 16 + fr;
                    if (rl < u.cnt) { const f32x4 v0 = acc[ai][bj][m][0] + b0, v1 = acc[ai][bj][m][1] + b1;
                        h4 o;
                        { const float xg = fminf(v0[0], 7.f), xl = fminf(fmaxf(v0[1], -7.f), 7.f); o[0] = (_Float16)(xg * sigmoidf_(1.702f * xg) * (xl + 1.f)); }
                        { const float xg = fminf(v0[2], 7.f), xl = fminf(fmaxf(v0[3], -7.f), 7.f); o[1] = (_Float16)(xg * sigmoidf_(1.702f * xg) * (xl + 1.f)); }
                        { const float xg = fminf(v1[0], 7.f), xl = fminf(fmaxf(v1[1], -7.f), 7.f); o[2] = (_Float16)(xg * sigmoidf_(1.702f * xg) * (xl + 1.f)); }
                        { const float xg = fminf(v1[2], 7.f), xl = fminf(fmaxf(v1[3], -7.f), 7.f); o[3] = (_Float16)(xg * sigmoidf_(1.702f * xg) * (xl + 1.f)); }
                        *(h4*)(act + (size_t)(u.rbase + u.m0 + rl) * 2048 + (col >> 1)) = o; } } } }
};
struct ProbDn {
    static constexpr int NT = 32; static constexpr size_t KS2 = 256;
    static constexpr bool PERM = true;
    const _Float16* A; const _Float16* Bt; _Float16* y; const float* bdn; const int* list; const float* gate; MoeTab tab; int G, vcu;
    __device__ __forceinline__ bool next(int i, Unit& u) const { return tab.find(i * G + vcu, u); }
    __device__ __forceinline__ void a_offs(const Unit& u, const int (&R)[2], const int (&C2)[2], unsigned (&v)[2][2]) const {
#pragma unroll
        for (int h = 0; h < 2; ++h)
#pragma unroll
            for (int i = 0; i < 2; ++i) v[h][i] = (unsigned)(u.rbase + u.m0 + h * 128 + R[i]) * (unsigned)(KK * 2) + (unsigned)C2[i]; }
    __device__ __forceinline__ const char* a_base() const { return (const char*)A; }
    __device__ __forceinline__ const char* b_base(const Unit& u) const { return (const char*)(Bt + ((size_t)u.e * 2048 + u.n0) * KK); }
    __device__ __forceinline__ void epi(const f32x4 (&acc)[2][2][4][2], const Unit& u, int wr, int wc, int fr, int fq) const {
        const float* bb = bdn + (size_t)u.e * 2048;
#pragma unroll
        for (int ai = 0; ai < 2; ++ai)
#pragma unroll
            for (int m = 0; m < 4; ++m) { const int rl = ai * 128 + wr * 64 + m * 16 + fr;
                if (rl < u.cnt) { const int a = list[(size_t)u.e * T_ + u.m0 + rl]; const float g = gate[a];
#pragma unroll
                    for (int bj = 0; bj < 2; ++bj) { const int col = u.n0 + bj * 128 + wc * 32 + fq * 8;
                        const f32x4 v0 = (acc[ai][bj][m][0] + *(const f32x4*)(bb + col)) * g, v1 = (acc[ai][bj][m][1] + *(const f32x4*)(bb + col + 4)) * g;
                        h8 o; o[0] = (_Float16)v0[0]; o[1] = (_Float16)v0[1]; o[2] = (_Float16)v0[2]; o[3] = (_Float16)v0[3]; o[4] = (_Float16)v1[0]; o[5] = (_Float16)v1[1]; o[6] = (_Float16)v1[2]; o[7] = (_Float16)v1[3];
                        *(h8*)(y + (size_t)a * 2048 + col) = o; } } } }
};
}

namespace at8 {
typedef float f32x16 __attribute__((ext_vector_type(16)));
typedef short s16x4 __attribute__((ext_vector_type(4)));
typedef unsigned u32x4 __attribute__((ext_vector_type(4)));
constexpr int SHM_V = 64 * 128 * 2, SHM_K = 64 * 128 * 2;
constexpr int LDS_WS = 2 * SHM_V + 2 * SHM_K;
constexpr int LDS_END = LDS_WS + 8 * 64 * 4;
constexpr float CEXP = ATT_SCALE * 1.4426950408889634f;
constexpr float THR_RAW = 8.f / ATT_SCALE;
#define AT_KSWZ(row, colB) ((row) * 256 + ((colB) ^ (((row) & 7) << 4)))
#define AT_SBAR() __builtin_amdgcn_sched_barrier(0)
__device__ __forceinline__ int crow(int r, int hi) { return (r & 3) + 8 * (r >> 2) + 4 * hi; }
__device__ __forceinline__ unsigned cvtpk(float lo, float hi) { auto v = __builtin_amdgcn_cvt_pkrtz(lo, hi); return *reinterpret_cast<unsigned*>(&v); }
__device__ __forceinline__ int v_st(int k, int c) { const int kk = (k & ~0xC) | ((k & 4) << 1) | ((k & 8) >> 1); return ((kk >> 3) * 4 + (c >> 5)) * 512 + ((kk & 7) * 32 + (c & 31)) * 2; }
__device__ __forceinline__ int v_rd_base(int lane) { return ((lane & 3) << 3) | (((lane >> 2) & 3) << 6) | (((lane >> 4) & 1) << 5) | (((lane >> 5) & 1) << 8); }
constexpr int v_rd_off(int d0, int ks, int half) { return d0 * 512 + ks * 4096 + half * 2048; }
template <int OFF> __device__ __forceinline__ s16x4 tr_read(int vb) { s16x4 r; asm volatile("ds_read_b64_tr_b16 %0, %1 offset:%2" : "=&v"(r) : "v"(vb), "i"(OFF) : "memory"); return r; }
__device__ __forceinline__ h8 mk8(s16x4 l, s16x4 h) { typedef short s16x8 __attribute__((ext_vector_type(8))); s16x8 w = {l[0], l[1], l[2], l[3], h[0], h[1], h[2], h[3]}; return *reinterpret_cast<h8*>(&w); }
template <int D0> __device__ __forceinline__ void pv_one(f32x16& od, int vb, h8 pa0, h8 pa1, h8 pa2, h8 pa3) {
    const s16x4 l0 = tr_read<v_rd_off(D0, 0, 0)>(vb), h0 = tr_read<v_rd_off(D0, 0, 1)>(vb), l1 = tr_read<v_rd_off(D0, 1, 0)>(vb), h1 = tr_read<v_rd_off(D0, 1, 1)>(vb);
    const s16x4 l2 = tr_read<v_rd_off(D0, 2, 0)>(vb), h2 = tr_read<v_rd_off(D0, 2, 1)>(vb), l3 = tr_read<v_rd_off(D0, 3, 0)>(vb), h3 = tr_read<v_rd_off(D0, 3, 1)>(vb);
    asm volatile("s_waitcnt lgkmcnt(0)" ::: "memory"); AT_SBAR();
    od = __builtin_amdgcn_mfma_f32_32x32x16_f16(pa0, mk8(l0, h0), od, 0, 0, 0);
    od = __builtin_amdgcn_mfma_f32_32x32x16_f16(pa1, mk8(l1, h1), od, 0, 0, 0);
    od = __builtin_amdgcn_mfma_f32_32x32x16_f16(pa2, mk8(l2, h2), od, 0, 0, 0);
    od = __builtin_amdgcn_mfma_f32_32x32x16_f16(pa3, mk8(l3, h3), od, 0, 0, 0);
}
__device__ __forceinline__ void pv_d0(f32x16 (&o)[4], int vb, h8 pa0, h8 pa1, h8 pa2, h8 pa3) {
    pv_one<0>(o[0], vb, pa0, pa1, pa2, pa3); pv_one<1>(o[1], vb, pa0, pa1, pa2, pa3); pv_one<2>(o[2], vb, pa0, pa1, pa2, pa3); pv_one<3>(o[3], vb, pa0, pa1, pa2, pa3);
}
__device__ __forceinline__ void qkt(f32x16& p0, f32x16& p1, const char* Ks, const h8 (&qr)[8], int r32, int hi) {
    p0 = f32x16{}; p1 = f32x16{};
#pragma unroll
    for (int d0 = 0; d0 < 8; ++d0) { const int cb = (d0 * 16 + hi * 8) * 2;
        const h8 b0 = *reinterpret_cast<const h8*>(Ks + AT_KSWZ(r32, cb));
        const h8 b1 = *reinterpret_cast<const h8*>(Ks + AT_KSWZ(32 + r32, cb));
        p0 = __builtin_amdgcn_mfma_f32_32x32x16_f16(b0, qr[d0], p0, 0, 0, 0);
        p1 = __builtin_amdgcn_mfma_f32_32x32x16_f16(b1, qr[d0], p1, 0, 0, 0); }
}
__device__ __forceinline__ void pack_p(const f32x16& p0, const f32x16& p1, h8& pa0, h8& pa1, h8& pa2, h8& pa3) {
#define AT_PK4(P, BASE, OUT) do { unsigned a0 = cvtpk(P[BASE + 0], P[BASE + 1]), a1 = cvtpk(P[BASE + 2], P[BASE + 3]); \
    unsigned b0 = cvtpk(P[BASE + 4], P[BASE + 5]), b1 = cvtpk(P[BASE + 6], P[BASE + 7]); \
    auto r0 = __builtin_amdgcn_permlane32_swap(a0, b0, false, false); auto r1 = __builtin_amdgcn_permlane32_swap(a1, b1, false, false); \
    u32x4 w = {r0[0], r1[0], r0[1], r1[1]}; OUT = *reinterpret_cast<h8*>(&w); } while (0)
    AT_PK4(p0, 0, pa0); AT_PK4(p0, 8, pa1); AT_PK4(p1, 0, pa2); AT_PK4(p1, 8, pa3);
#undef AT_PK4
}
__device__ __forceinline__ float half_swap_max(float v) { auto rr = __builtin_amdgcn_permlane32_swap(__float_as_uint(v), __float_as_uint(v), false, false); return fmaxf(__uint_as_float(rr[0]), __uint_as_float(rr[1])); }
__device__ __forceinline__ float half_swap_sum(float v) { auto rr = __builtin_amdgcn_permlane32_swap(__float_as_uint(v), __float_as_uint(v), false, false); return __uint_as_float(rr[0]) + __uint_as_float(rr[1]); }

struct Stage4 { h8 vs0, vs1, ks0, ks1; };
__device__ __forceinline__ int hidden_tid() { int tz = threadIdx.x; asm volatile("" : "+v"(tz)); return tz; }
__device__ __forceinline__ void sload(Stage4& s, const _Float16* Kb, const _Float16* Vb, int ld, int k0) {
    const int tz = hidden_tid(), sr = tz >> 4, sc = (tz & 15) * 8;
    s.vs0 = *(const h8*)(Vb + (size_t)(k0 + sr) * ld + sc); s.vs1 = *(const h8*)(Vb + (size_t)(k0 + 32 + sr) * ld + sc);
    s.ks0 = *(const h8*)(Kb + (size_t)(k0 + sr) * ld + sc); s.ks1 = *(const h8*)(Kb + (size_t)(k0 + 32 + sr) * ld + sc);
}
__device__ __forceinline__ void swrite(const Stage4& s, char* V_lds, char* K_lds, int b) {
    const int tz = hidden_tid(), sr = tz >> 4, sc = (tz & 15) * 8, vst0 = v_st(sr, sc), vst1 = v_st(32 + sr, sc);
    *(h8*)(V_lds + b * SHM_V + vst0) = s.vs0; *(h8*)(V_lds + b * SHM_V + vst1) = s.vs1;
    const int kc = sc * 2;
    *(h8*)(K_lds + b * SHM_K + AT_KSWZ(sr, kc)) = s.ks0; *(h8*)(K_lds + b * SHM_K + AT_KSWZ(32 + sr, kc)) = s.ks1;
}

__device__ __forceinline__ void attn_unit(char* lds, const _Float16* qrow, const _Float16* Kb, const _Float16* Vb, int ld, unsigned tmask, int klo, int khi, unsigned selmask,
                                          float* outw, int ostride) {
    const int tid = threadIdx.x, wid = __builtin_amdgcn_readfirstlane(tid >> 6), lane = tid & 63, r32 = lane & 31, hi = lane >> 5;
    char* V_lds = lds; char* K_lds = lds + 2 * SHM_V;
    float* wsf = (float*)(lds + LDS_WS) + wid * 64; float* li_l = wsf; float* al_l = wsf + 32;
    float m_reg = -1e30f, l_reg = 0.f; f32x16 o[4] = {}; h8 qr[8];
#pragma unroll
    for (int d0 = 0; d0 < 8; ++d0) qr[d0] = *(const h8*)(qrow + d0 * 16);
    const int vb0 = (int)(uintptr_t)V_lds + v_rd_base(lane);
    Stage4 st;
    unsigned rest = tmask; int j = __ffs(rest) - 1; rest &= rest - 1;
    sload(st, Kb, Vb, ld, j * 64); asm volatile("s_waitcnt vmcnt(0)" ::: "memory"); swrite(st, V_lds, K_lds, 0); __syncthreads();
    int buf = 0;
    for (;;) {
        const int jn = rest ? (__ffs(rest) - 1) : -1;
        if (jn >= 0) sload(st, Kb, Vb, ld, jn * 64);
        f32x16 p0, p1;
        AT_SBAR(); qkt(p0, p1, K_lds + buf * SHM_K, qr, r32, hi);
        { const int kb = j * 64 + 4 * hi; const bool tb = (selmask >> j) & 1u;
#pragma unroll
          for (int r = 0; r < 16; ++r) { const int k0 = kb + (r & 3) + 8 * (r >> 2);
              p0[r] = (tb && k0 >= klo && k0 <= khi) ? p0[r] : -INFINITY;
              p1[r] = (tb && (k0 + 32) >= klo && (k0 + 32) <= khi) ? p1[r] : -INFINITY; } }
        float pmax = p0[0];
#pragma unroll
        for (int r = 1; r < 16; ++r) pmax = fmaxf(pmax, p0[r]);
#pragma unroll
        for (int r = 0; r < 16; ++r) pmax = fmaxf(pmax, p1[r]);
        pmax = half_swap_max(pmax);
        float mn, alpha;
        if (__all(pmax - m_reg <= THR_RAW)) { mn = m_reg; alpha = 1.f; }
        else { mn = fmaxf(m_reg, pmax); alpha = __builtin_amdgcn_exp2f((m_reg - mn) * CEXP); m_reg = mn; }
        const float mnC = -mn * CEXP;
        float ps = 0.f;
#pragma unroll
        for (int r = 0; r < 16; ++r) { p0[r] = __builtin_amdgcn_exp2f(fmaf(p0[r], CEXP, mnC)); ps += p0[r]; }
#pragma unroll
        for (int r = 0; r < 16; ++r) { p1[r] = __builtin_amdgcn_exp2f(fmaf(p1[r], CEXP, mnC)); ps += p1[r]; }
        ps = half_swap_sum(ps);
        l_reg = l_reg * alpha + ps;
        if (__any(alpha < 1.f)) { if (hi == 0) al_l[r32] = alpha; asm volatile("s_waitcnt lgkmcnt(0)" ::: "memory");
#pragma unroll
            for (int r = 0; r < 16; ++r) { const float a = al_l[crow(r, hi)];
#pragma unroll
                for (int d = 0; d < 4; ++d) o[d][r] *= a; } }
        h8 pa0, pa1, pa2, pa3; pack_p(p0, p1, pa0, pa1, pa2, pa3);
        AT_SBAR();
        pv_d0(o, vb0 + buf * SHM_V, pa0, pa1, pa2, pa3);
        if (jn < 0) break;
        asm volatile("s_waitcnt vmcnt(0)" ::: "memory");
        swrite(st, V_lds, K_lds, buf ^ 1);
        __syncthreads();
        buf ^= 1; j = jn; rest &= rest - 1;
    }
    if (hi == 0) li_l[r32] = l_reg; asm volatile("s_waitcnt lgkmcnt(0)" ::: "memory");
#pragma unroll
    for (int r = 0; r < 16; ++r) { const int orow = crow(r, hi); const float l = li_l[orow]; const float rl = l > 0.f ? 1.f / l : 0.f;
#pragma unroll
        for (int d0 = 0; d0 < 4; ++d0) outw[(size_t)orow * ostride + d0 * 32 + r32] = o[d0][r] * rl; }
    __syncthreads();
}

constexpr int LDS_AP = LDS_END, LDS_BP = LDS_AP + 4 * 64 * 33 * 4, LDS_SELM = LDS_BP + 4 * 64 * 33 * 4, LDS_CS_END = LDS_SELM + 64 * 4;
__device__ __forceinline__ void cmp_slc_unit(char* lds, const _Float16* qrow, const _Float16* Kc, const _Float16* Vc, const _Float16* Ks, const _Float16* Vs, int t, int tl, int g, int qi,
                                             float* outc, float* outs) {
    const int tid = threadIdx.x, wid = __builtin_amdgcn_readfirstlane(tid >> 6), lane = tid & 63, r32 = lane & 31, hi = lane >> 5;
    char* V_lds = lds; char* K_lds = lds + 2 * SHM_V;
    float* AP = (float*)(lds + LDS_AP); float* BP = (float*)(lds + LDS_BP); unsigned* selm = (unsigned*)(lds + LDS_SELM);
    {
        h8 qr[8];
#pragma unroll
        for (int d0 = 0; d0 < 8; ++d0) qr[d0] = *(const h8*)(qrow + d0 * 16);
        const int vb0 = (int)(uintptr_t)V_lds + v_rd_base(lane);
        { Stage4 s0, s1; sload(s0, Kc, Vc, 256, 0); sload(s1, Kc, Vc, 256, 64);
          asm volatile("s_waitcnt vmcnt(0)" ::: "memory");
          swrite(s0, V_lds, K_lds, 0); swrite(s1, V_lds, K_lds, 1); }
        __syncthreads();
        f32x16 pA0, pA1, pB0, pB1;
        AT_SBAR(); qkt(pA0, pA1, K_lds, qr, r32, hi); qkt(pB0, pB1, K_lds + SHM_K, qr, r32, hi);
        const int khi = t >= 31 ? ((t - 31) >> 4) : -1;
#pragma unroll
        for (int r = 0; r < 16; ++r) { const int c0 = 4 * hi + (r & 3) + 8 * (r >> 2);
            pA0[r] = (c0 <= khi) ? pA0[r] : -INFINITY; pA1[r] = (c0 + 32 <= khi) ? pA1[r] : -INFINITY;
            pB0[r] = (c0 + 64 <= khi) ? pB0[r] : -INFINITY; pB1[r] = (c0 + 96 <= khi) ? pB1[r] : -INFINITY; }
        float pmax = -INFINITY;
#pragma unroll
        for (int r = 0; r < 16; ++r) pmax = fmaxf(fmaxf(pmax, pA0[r]), fmaxf(pA1[r], fmaxf(pB0[r], pB1[r])));
        pmax = half_swap_max(pmax);
        const float mC = (pmax == -INFINITY) ? 0.f : -pmax * CEXP;
        float ps = 0.f;
#pragma unroll
        for (int r = 0; r < 16; ++r) { pA0[r] = __builtin_amdgcn_exp2f(fmaf(pA0[r], CEXP, mC)); pA1[r] = __builtin_amdgcn_exp2f(fmaf(pA1[r], CEXP, mC));
            pB0[r] = __builtin_amdgcn_exp2f(fmaf(pB0[r], CEXP, mC)); pB1[r] = __builtin_amdgcn_exp2f(fmaf(pB1[r], CEXP, mC)); ps += (pA0[r] + pA1[r]) + (pB0[r] + pB1[r]); }
        ps = half_swap_sum(ps);
        const float inv = ps > 0.f ? 1.f / ps : 0.f;
#pragma unroll
        for (int r = 0; r < 16; ++r) { pA0[r] *= inv; pA1[r] *= inv; pB0[r] *= inv; pB1[r] *= inv; }
        { float* ap = AP + (g * 64 + tl) * 33; float* bp = BP + (g * 64 + tl) * 33;
          if (hi == 0) bp[0] = 0.f;
#define AT_IMP(P, JB) do { _Pragma("unroll") for (int k = 0; k < 4; ++k) { const int j = (JB) + 2 * k + hi; \
              ap[j] = 2.f * (P[4 * k] + P[4 * k + 1] + P[4 * k + 2]) + P[4 * k + 3]; if (j + 1 < 32) bp[j + 1] = P[4 * k + 3]; } } while (0)
          AT_IMP(pA0, 0); AT_IMP(pA1, 8); AT_IMP(pB0, 16); AT_IMP(pB1, 24);
#undef AT_IMP
        }
        f32x16 o[4] = {};
        h8 pa0, pa1, pa2, pa3;
        pack_p(pA0, pA1, pa0, pa1, pa2, pa3); AT_SBAR(); pv_d0(o, vb0, pa0, pa1, pa2, pa3);
        pack_p(pB0, pB1, pa0, pa1, pa2, pa3); AT_SBAR(); pv_d0(o, vb0 + SHM_V, pa0, pa1, pa2, pa3);
#pragma unroll
        for (int r = 0; r < 16; ++r) { const int orow = crow(r, hi);
#pragma unroll
            for (int d0 = 0; d0 < 4; ++d0) outc[(size_t)orow * 1024 + d0 * 32 + r32] = o[d0][r]; }
    }
    __syncthreads();
#pragma unroll 1
    for (int it = 0; it < 4; ++it) {
        const int tk = 8 * wid + 2 * it + hi, j = r32;
        float imp = 0.f;
#pragma unroll
        for (int gg = 0; gg < 4; ++gg) imp += AP[(gg * 64 + tk) * 33 + j] + BP[(gg * 64 + tk) * 33 + j];
        const bool forced = (j == 0) || (j == qi) || (j == qi - 1), valid = j <= qi;
        const float iv = forced ? 1e9f : (valid ? imp : -1e9f);
        int rank = 0;
        for (int i = 0; i < 32; ++i) { const float vi = __shfl(iv, i + 32 * hi); rank += (vi > iv || (vi == iv && i < j)) ? 1 : 0; }
        const unsigned long long bal = __ballot(rank < 16 && valid);
        if (r32 == 0) selm[tk] = (unsigned)(bal >> (32 * hi));
    }
    __syncthreads();
    unsigned tm = selm[lane];
#pragma unroll
    for (int o = 32; o > 0; o >>= 1) tm |= __shfl_xor(tm, o);
    const int tz2 = hidden_tid();
    const unsigned mysel = selm[((tz2 >> 6) & 1) * 32 + (tz2 & 31)];
    attn_unit(lds, qrow, Ks, Vs, INW, tm, 0, t, mysel, outs, 1024);
}
}

__device__ __forceinline__ void conv_tile(float* lds, const float* __restrict__ W, int ldw, int nvalid, _Float16* __restrict__ Wt, int K, int k0, int n0) {
    const int tid = threadIdx.x;
    float4 v[8];
#pragma unroll
    for (int i = 0; i < 8; ++i) { const int idx = tid + 512 * i, r = idx >> 6, c4 = (idx & 63) * 4;
        v[i] = (n0 + c4 < nvalid) ? *(const float4*)(W + (size_t)(k0 + r) * ldw + n0 + c4) : make_float4(0.f, 0.f, 0.f, 0.f); }
#pragma unroll
    for (int i = 0; i < 8; ++i) { const int idx = tid + 512 * i, r = idx >> 6, c4 = (idx & 63) * 4; float* d = lds + r * 257 + c4; d[0] = v[i].x; d[1] = v[i].y; d[2] = v[i].z; d[3] = v[i].w; }
    __syncthreads();
#pragma unroll
    for (int j = 0; j < 4; ++j) { const int id = tid + 512 * j, n = id >> 3, k8 = (id & 7) * 8; h8 o;
#pragma unroll
        for (int q = 0; q < 8; ++q) o[q] = (_Float16)lds[(k8 + q) * 257 + n];
        *(h8*)(Wt + (size_t)(n0 + n) * K + k0 + k8) = o; }
    __syncthreads();
}

__global__ void __launch_bounds__(512, 2) fwd(Params p) {
    extern __shared__ __attribute__((aligned(16))) char smem[];
    const int tid = threadIdx.x, lane = tid & 63, wv = __builtin_amdgcn_readfirstlane(tid >> 6);
    const int bid = blockIdx.x, nb = gridDim.x;
    const int gw = bid * 8 + wv, nw = nb * 8;
    const int lo = (int)(p.lo_hi & 0xffffffffll), hi = (int)(p.lo_hi >> 32);
    unsigned char* ws = p.ws;
    unsigned* ctl = (unsigned*)(ws + WS_CTL);
    int* cnt = (int*)(ws + CTL_CNT);
    float* proj = (float*)(ws + WS_PROJ);
    float* kvmem = (float*)(ws + WS_KVMEM);
    float* bias1 = (float*)(ws + WS_BIAS1);
    float* hid = (float*)(ws + WS_HID);
    float* kc = (float*)(ws + WS_KC);
    float* vc = (float*)(ws + WS_VC);
    float* pooled = (float*)(ws + WS_POOLED);
    float* opool = (float*)(ws + WS_OPOOL);
    float* owin = (float*)(ws + WS_OWIN);
    float* ocmp = (float*)(ws + WS_OCMP);
    float* oslc = (float*)(ws + WS_OSLC);
    unsigned* sel = (unsigned*)(ws + WS_SEL);
    float* omem = (float*)(ws + WS_OMEM);
    _Float16* cat16 = (_Float16*)(ws + WS_CAT16);
    float* hpre = (float*)(ws + WS_HPRE);
    float* hbuf = (float*)(ws + WS_H);
    float* gate = (float*)(ws + WS_GATE);
    int* list = (int*)(ws + WS_LIST);
    _Float16* act16 = (_Float16*)(ws + WS_ACT16);
    _Float16* y16 = (_Float16*)(ws + WS_Y16);
    _Float16* h16 = (_Float16*)(ws + WS_H16);
    _Float16* x16 = (_Float16*)(ws + WS_X16);
    _Float16* wtin = (_Float16*)(ws + WS_WTIN);
    _Float16* wtout = (_Float16*)(ws + WS_WTOUT);
    _Float16* wtgu = (_Float16*)(ws + WS_WTGU);
    _Float16* wtdn = (_Float16*)(ws + WS_WTDN);
    LAS unsigned char* lds = (LAS unsigned char*)smem;
    _Float16* proj16 = (_Float16*)(ws + WS_PROJ16);
    _Float16* kvmem16 = (_Float16*)(ws + WS_KVMEM16);
    _Float16* wt1 = (_Float16*)(ws + WS_WT1);
    float* uv = (float*)(ws + WS_UV);
    _Float16* kc16 = (_Float16*)(ws + WS_KC16);
    _Float16* vc16 = (_Float16*)(ws + WS_VC16);
    const int vcu = (nb % 8 == 0) ? (bid % 8) * (nb / 8) + bid / 8 : bid;

    volatile LAS unsigned* xbw = (volatile LAS unsigned*)(smem + LDS_BYTES - 16);
    if (tid == 0) { xbw[0] = 0u; xbw[1] = 0u; xbw[2] = 0u; xbw[3] = 0u; }
    __syncthreads();
    XcdBarrier bar; bar.bar = ctl; bar.x = 0; bar.st = xbw;
    const bool multi = (hi - lo) > 1;
    if (multi) bar = xcd_barrier_post(ctl, xbw);
#define IN(k) (lo <= (k) && (k) < hi)
#define SEAM(k) do { if (IN(k) && IN((k) + 1)) xcd_barrier(bar); } while (0)
    float* sw = (float*)smem + wv * WLDS_FLOATS;
    int* segw = (int*)(sw + 4096 + 512);

    if (IN(0)) {
        for (int j = gw; j < 512; j += nw) {
            const int kv = j >> 8, jj = j & 255;
            const float* pos = p.in[kv ? I_POSV : I_POSK]; const float* w1 = p.in[kv ? I_W1V : I_W1K];
            float s = 0.f;
            for (int k = lane; k < 4096; k += 64) s += pos[k] * w1[(size_t)k * 256 + jj];
            s = wave_sum(s);
            if (lane == 0) bias1[j] = s;
        }
        for (size_t i = (size_t)bid * 512 + tid; i < (size_t)T_ * 2048 / 4; i += (size_t)nb * 512) {
            const float4 v = ((const float4*)p.in[I_X])[i]; ((h4*)x16)[i] = (h4){(_Float16)v.x, (_Float16)v.y, (_Float16)v.z, (_Float16)v.w};
        }
        {
            constexpr int U_GU = NE * 32 * 16, U_DN = NE * 32 * 8, U_IN = 32 * 15, U_OUT = 32 * 8, U_W1 = 128;
            for (int u = bid; u < U_GU + U_DN + U_IN + U_OUT + U_W1; u += nb) {
                if (u < U_GU) { const int e = u / 512, r = u % 512, kt = r / 16, ntl = r % 16;
                    conv_tile((float*)smem, p.in[I_WGU] + (size_t)e * 2048 * 4096, 4096, 4096, wtgu + (size_t)e * 4096 * 2048, 2048, kt * 64, ntl * 256);
                } else if (u < U_GU + U_DN) { const int v = u - U_GU, e = v / 256, r = v % 256, kt = r / 8, ntl = r % 8;
                    conv_tile((float*)smem, p.in[I_WDN] + (size_t)e * 2048 * 2048, 2048, 2048, wtdn + (size_t)e * 2048 * 2048, 2048, kt * 64, ntl * 256);
                } else if (u < U_GU + U_DN + U_IN) { const int v = u - U_GU - U_DN, kt = v / 15, ntl = v % 15;
                    conv_tile((float*)smem, p.in[I_WIN], INW, INW, wtin, 2048, kt * 64, ntl * 256);
                } else if (u < U_GU + U_DN + U_IN + U_OUT) { const int v = u - U_GU - U_DN - U_IN, kt = v / 8, ntl = v % 8;
                    conv_tile((float*)smem, p.in[I_WOUT], 2048, 2048, wtout, 2048, kt * 64, ntl * 256);
                } else { const int v = u - U_GU - U_DN - U_IN - U_OUT, kv = v >> 6, part = (v >> 5) & 1, kt = v & 31;
                    conv_tile((float*)smem, p.in[kv ? I_W1V : I_W1K] + (size_t)part * 2048 * 256, 256, 256, wt1 + ((size_t)kv * 512 + part * 256) * 2048, 2048, kt * 64, 0);
                }
            }
        }
        for (int u = bid; u < 16 * 8; u += nb) { const int nt = u / 16, mt = u % 16;
            ARowPlain af{p.in[I_MEM], 2048, mt * 128, 2048}; EpiStore ef{kvmem, 1024, mt * 128, nt * 128, 2048, 1024, kvmem16};
            gemm_tile(smem, 2048, af, p.in[I_WMEMKV], 1024, nt * 128, 1024, false, ef);
        }
    }
    SEAM(0);
    if (IN(1)) {
        g8::ProbIn P{x16, wtin, proj, proj16, nb, bid};
        g8::gemm_phase(lds, P);
    }
    SEAM(1);
    if (IN(2)) {
        { g8::ProbCmp P{proj16, wt1, uv, nb, bid}; g8::gemm_phase(lds, P); __syncthreads(); }
        for (size_t i = (size_t)bid * 512 + tid; i < (size_t)T_ * 512; i += (size_t)nb * 512) {
            const int col = (int)(i & 511), row = (int)(i >> 9), t = row & (S_ - 1), g = col >> 7;
            const int win = 2 << g; const int lo_t = max(t + 1 - win, 0); const int n = t + 1 - lo_t;
            float s = 0.f;
            for (int k = 0; k < n; ++k) s += proj[(size_t)(row - k) * INW + C_UP + col];
            pooled[i] = s / (float)n - proj[(size_t)row * INW + C_UP + col];
        }
        {
            const int r32 = lane & 31, hi = lane >> 5, g = wv >> 1, half = wv & 1;
            for (int uu = bid; uu < 512; uu += nb) {
                const int u = (uu & 1) ? (511 - (uu >> 1)) : (uu >> 1);
                const int bk = u >> 5, qi = u & 31, b = bk >> 1, kvh = bk & 1;
                const int t = qi * 64 + half * 32 + r32;
                const int lo_t = max(0, qi - 8);
                const unsigned tmask = (unsigned)(((1ull << (qi + 1)) - 1ull) & ~((1ull << lo_t) - 1ull));
                at8::attn_unit(smem, proj16 + (size_t)(b * S_ + t) * INW + C_Q + (kvh * 4 + g) * 128 + hi * 8,
                               proj16 + (size_t)b * S_ * INW + C_KW + kvh * 128, proj16 + (size_t)b * S_ * INW + C_VW + kvh * 128, INW, tmask, t - 511, t, 0xffffffffu,
                               owin + (size_t)(b * S_ + qi * 64 + half * 32) * 1024 + (kvh * 4 + g) * 128, 1024);
            }
            for (int u = bid; u < 256; u += nb) {
                const int b = u >> 5, h = (u >> 3) & 3, qt = u & 7;
                const int t = qt * 256 + wv * 32 + r32;
                at8::attn_unit(smem, proj16 + (size_t)(b * S_ + t) * INW + C_QM + h * 128 + hi * 8,
                               kvmem16 + (size_t)b * 256 * 1024 + h * 128, kvmem16 + (size_t)b * 256 * 1024 + 512 + h * 128, 1024, 0xFu, 0, 255, 0xffffffffu,
                               omem + (size_t)(b * S_ + qt * 256 + wv * 32) * 512 + h * 128, 512);
            }
        }
    }
    SEAM(2);
    if (IN(3)) {
        {   float* hs = (float*)smem;
            for (int u = bid; u < 508; u += nb) {
                const int kv = u / 254, ub = u % 254;
                const float* w2 = p.in[kv ? I_W2V : I_W2K]; _Float16* dst = kv ? vc16 : kc16;
                __syncthreads();
#pragma unroll
                for (int q = 0; q < 4; ++q) { const int e = tid + 512 * q, i = e >> 8, n = e & 255;
                    const int idx = ub * 8 + i, b = idx / 254, rem = idx % 254, c = rem >> 1, kvh = rem & 1;
                    const int row = (b * 128 + c) * 2 + kvh;
                    float a = bias1[kv * 256 + n];
#pragma unroll
                    for (int sp = 0; sp < 4; ++sp) { const float* base = uv + ((size_t)(kv * 4 + sp) * 2048) * 512; a += base[(size_t)row * 512 + n] + base[(size_t)(row + 2) * 512 + 256 + n]; }
                    hs[i * 256 + n] = gelu_tanh(a); }
                __syncthreads();
#pragma unroll
                for (int q = 0; q < 2; ++q) { const int e = tid + 512 * q, i = e >> 7, d = e & 127;
                    const int idx = ub * 8 + i, b = idx / 254, rem = idx % 254, c = rem >> 1, kvh = rem & 1;
                    float a = 0.f;
                    for (int n = 0; n < 256; ++n) a += hs[i * 256 + n] * w2[n * 128 + d];
                    dst[(size_t)((b * 128 + c) * 2 + kvh) * 128 + d] = (_Float16)a; }
            }
            __syncthreads();
            for (int i = bid * 512 + tid; i < 2 * B_ * 256; i += nb * 512) { const int kv = i / (B_ * 256), r = i % (B_ * 256), b = r >> 8, x = r & 255;
                (kv ? vc16 : kc16)[(size_t)(b * 128 + 127) * 256 + x] = (_Float16)0.f; }
        }
        for (int u = bid; u < 128 * 4; u += nb) { const int g = u >> 7, mt = u & 127;
            ARowPlain af{pooled + g * 128, 512, mt * 128, T_}; EpiPool ef{opool, p.in[I_POOLS], mt * 128, g};
            gemm_tile(smem, 128, af, p.in[I_POOLW] + (size_t)g * 128 * 128, 128, 0, 128, false, ef);
        }
    }
    SEAM(3);
    if (IN(4)) {
        const int r32 = lane & 31, hi = lane >> 5, g = wv >> 1, half = wv & 1;
        for (int uu = bid; uu < 512; uu += nb) {
            const int u = (uu & 1) ? (511 - (uu >> 1)) : (uu >> 1);
            const int bk = u >> 5, qi = u & 31, b = bk >> 1, kvh = bk & 1;
            const int tl = half * 32 + r32, t = qi * 64 + tl;
            at8::cmp_slc_unit(smem, proj16 + (size_t)(b * S_ + t) * INW + C_Q + (kvh * 4 + g) * 128 + hi * 8,
                              kc16 + (size_t)(b * 128 * 2 + kvh) * 128, vc16 + (size_t)(b * 128 * 2 + kvh) * 128,
                              proj16 + (size_t)b * S_ * INW + C_KS + kvh * 128, proj16 + (size_t)b * S_ * INW + C_VS + kvh * 128, t, tl, g, qi,
                              ocmp + (size_t)(b * S_ + qi * 64 + half * 32) * 1024 + (kvh * 4 + g) * 128, oslc + (size_t)(b * S_ + qi * 64 + half * 32) * 1024 + (kvh * 4 + g) * 128);
        }
    }
    SEAM(4);
    if (IN(5)) {
        for (int row = gw; row < T_; row += nw) {
            const float* pr = proj + (size_t)row * INW;
            float v[16]; float ss = 0.f;
#pragma unroll
            for (int i = 0; i < 16; ++i) { const int col = lane + 64 * i, h = col >> 7; const size_t o = (size_t)row * 1024 + col;
                const float g0 = sigmoidf_(pr[C_G + h * 3]), g1 = sigmoidf_(pr[C_G + h * 3 + 1]), g2 = sigmoidf_(pr[C_G + h * 3 + 2]);
                v[i] = g0 * ocmp[o] + g1 * oslc[o] + g2 * owin[o]; ss += v[i] * v[i]; }
            ss = wave_sum(ss); float r = rsqrtf(ss / 1024.f + LN_EPS);
#pragma unroll
            for (int i = 0; i < 16; ++i) { const int col = lane + 64 * i; cat16[(size_t)row * 2048 + col] = (_Float16)(v[i] * r * p.in[I_GNNSA][col]); }
            ss = 0.f;
#pragma unroll
            for (int i = 0; i < 8; ++i) { v[i] = opool[(size_t)row * 512 + lane + 64 * i]; ss += v[i] * v[i]; }
            ss = wave_sum(ss); r = rsqrtf(ss / 512.f + LN_EPS);
#pragma unroll
            for (int i = 0; i < 8; ++i) { const int col = lane + 64 * i; cat16[(size_t)row * 2048 + 1024 + col] = (_Float16)(v[i] * r * p.in[I_GNPOOL][col]); }
            ss = 0.f;
#pragma unroll
            for (int i = 0; i < 8; ++i) { v[i] = omem[(size_t)row * 512 + lane + 64 * i]; ss += v[i] * v[i]; }
            ss = wave_sum(ss); r = rsqrtf(ss / 512.f + LN_EPS);
#pragma unroll
            for (int i = 0; i < 8; ++i) { const int col = lane + 64 * i; cat16[(size_t)row * 2048 + 1536 + col] = (_Float16)(v[i] * r * p.in[I_GNMEM][col]); }
        }
    }
    SEAM(5);
    if (IN(6)) {
        g8::ProbOut P{cat16, wtout, hpre, p.in[I_X], nb, bid};
        g8::gemm_phase(lds, P);
    }
    SEAM(6);
    if (IN(7)) {
        for (int row = gw; row < T_; row += nw) {
            float v[32]; float s = 0.f;
#pragma unroll
            for (int i = 0; i < 32; ++i) { v[i] = hpre[(size_t)row * 2048 + lane + 64 * i]; s += v[i]; }
            const float mu = wave_sum(s) / 2048.f; float q = 0.f;
#pragma unroll
            for (int i = 0; i < 32; ++i) { const float d = v[i] - mu; q += d * d; }
            const float rs = rsqrtf(wave_sum(q) / 2048.f + LN_EPS);
#pragma unroll
            for (int i = 0; i < 32; ++i) { const int col = lane + 64 * i; v[i] = (v[i] - mu) * rs * p.in[I_LN1G][col] + p.in[I_LN1B][col]; hbuf[(size_t)row * 2048 + col] = v[i]; h16[(size_t)row * 2048 + col] = (_Float16)v[i]; }
            float part[32];
#pragma unroll
            for (int e = 0; e < 32; ++e) part[e] = 0.f;
#pragma unroll 1
            for (int i = 0; i < 32; ++i) { const float4* wp = (const float4*)(p.in[I_WR] + (size_t)(lane + 64 * i) * 32); const float hv = hbuf[(size_t)row * 2048 + lane + 64 * i];
#pragma unroll
                for (int q4 = 0; q4 < 8; ++q4) { const float4 w = wp[q4]; part[4 * q4] += hv * w.x; part[4 * q4 + 1] += hv * w.y; part[4 * q4 + 2] += hv * w.z; part[4 * q4 + 3] += hv * w.w; } }
            float mine = 0.f;
#pragma unroll
            for (int e = 0; e < 32; ++e) { const float a = wave_sum(part[e]) + p.in[I_BR][e]; if (lane == e) mine = a; }
            const int j = lane & 31; const float iv = __shfl(mine, j);
            int rank = 0;
            for (int i = 0; i < 32; ++i) { const float vi = __shfl(iv, i); rank += (vi > iv || (vi == iv && i < j)) ? 1 : 0; }
            float tv[4]; int te[4];
#pragma unroll
            for (int r = 0; r < 4; ++r) { const unsigned long long bm = __ballot(lane < 32 && rank == r); const int src = __ffsll((long long)bm) - 1; te[r] = src; tv[r] = __shfl(iv, src); }
            const float mx = tv[0];
            float e0 = expf(tv[0] - mx), e1 = expf(tv[1] - mx), e2 = expf(tv[2] - mx), e3 = expf(tv[3] - mx); const float inv = 1.f / (e0 + e1 + e2 + e3);
            if (lane < 4) { const int e = lane == 0 ? te[0] : lane == 1 ? te[1] : lane == 2 ? te[2] : te[3]; const float g = (lane == 0 ? e0 : lane == 1 ? e1 : lane == 2 ? e2 : e3) * inv;
                const int a = row * 4 + lane; const int pos = atomicAdd(&cnt[e], 1); list[(size_t)e * T_ + pos] = a; gate[a] = g; }
        }
    }
    SEAM(7);
    LAS int* mtab = (LAS int*)(smem + g8::STAGE_BYTES);
    if (IN(8)) {
        if (tid == 0) { int ub = 0, rs = 0;
            for (int e = 0; e < NE; ++e) { const int c = (int)__hip_atomic_load((unsigned*)&cnt[e], __ATOMIC_RELAXED, __HIP_MEMORY_SCOPE_AGENT); mtab[e] = c; mtab[32 + e] = ub; mtab[65 + e] = rs; ub += ((c + 255) >> 8) * 16; rs += c; }
            mtab[64] = ub; mtab[97] = rs; mtab[98] = ub; }
        __syncthreads();
        g8::ProbGu P{h16, wtgu, act16, p.in[I_BGU], list, g8::MoeTab{mtab, 16}, nb, vcu};
        g8::gemm_phase(lds, P);
        __syncthreads();
    }
    SEAM(8);
    if (IN(9)) {
        if (tid == 0) { int ub = 0, rs = 0;
            for (int e = 0; e < NE; ++e) { const int c = (int)__hip_atomic_load((unsigned*)&cnt[e], __ATOMIC_RELAXED, __HIP_MEMORY_SCOPE_AGENT); mtab[e] = c; mtab[32 + e] = ub; mtab[65 + e] = rs; ub += ((c + 255) >> 8) * 8; rs += c; }
            mtab[64] = ub; mtab[97] = rs; mtab[98] = ub; }
        __syncthreads();
        g8::ProbDn P{act16, wtdn, y16, p.in[I_BDN], list, gate, g8::MoeTab{mtab, 8}, nb, vcu};
        g8::gemm_phase(lds, P);
        __syncthreads();
    }
    SEAM(9);
    if (IN(10)) {
        for (int row = gw; row < T_; row += nw) {
            float v[32]; float s = 0.f;
#pragma unroll
            for (int c = 0; c < 4; ++c) { const int col = (lane + 64 * c) * 8; const size_t yo = (size_t)row * 4 * 2048 + col;
                const float4 ha = *(const float4*)(hbuf + (size_t)row * 2048 + col), hb = *(const float4*)(hbuf + (size_t)row * 2048 + col + 4);
                const h8 y0 = *(const h8*)(y16 + yo), y1 = *(const h8*)(y16 + yo + 2048), y2 = *(const h8*)(y16 + yo + 4096), y3 = *(const h8*)(y16 + yo + 6144);
                const float hh[8] = {ha.x, ha.y, ha.z, ha.w, hb.x, hb.y, hb.z, hb.w};
#pragma unroll
                for (int q = 0; q < 8; ++q) { v[c * 8 + q] = DN_ALPHA * hh[q] + (((float)y0[q] + (float)y1[q]) + ((float)y2[q] + (float)y3[q])); s += v[c * 8 + q]; } }
            const float mu = wave_sum(s) / 2048.f; float q2 = 0.f;
#pragma unroll
            for (int i = 0; i < 32; ++i) { const float d = v[i] - mu; q2 += d * d; }
            const float rs = rsqrtf(wave_sum(q2) / 2048.f + LN_EPS);
#pragma unroll
            for (int c = 0; c < 4; ++c) { const int col = (lane + 64 * c) * 8;
                const float4 ga = *(const float4*)(p.in[I_LN2G] + col), gb = *(const float4*)(p.in[I_LN2G] + col + 4), ba = *(const float4*)(p.in[I_LN2B] + col), bb = *(const float4*)(p.in[I_LN2B] + col + 4);
                float4 o0, o1;
                o0.x = (v[c * 8 + 0] - mu) * rs * ga.x + ba.x; o0.y = (v[c * 8 + 1] - mu) * rs * ga.y + ba.y; o0.z = (v[c * 8 + 2] - mu) * rs * ga.z + ba.z; o0.w = (v[c * 8 + 3] - mu) * rs * ga.w + ba.w;
                o1.x = (v[c * 8 + 4] - mu) * rs * gb.x + bb.x; o1.y = (v[c * 8 + 5] - mu) * rs * gb.y + bb.y; o1.z = (v[c * 8 + 6] - mu) * rs * gb.z + bb.z; o1.w = (v[c * 8 + 7] - mu) * rs * gb.w + bb.w;
                *(float4*)(p.out + (size_t)row * 2048 + col) = o0; *(float4*)(p.out + (size_t)row * 2048 + col + 4) = o1; }
        }
    }
}

constexpr int NPHASE = 11;

extern "C" void kernel_launch(void* const* d_in, const int* in_sizes, int n_in, void* d_out, int out_size, void* d_ws, size_t ws_size, hipStream_t stream) {
    static int grid = 0;
    if (grid == 0) {
        if (n_in != 26 || ws_size < WS_END) { fprintf(stderr, "kernel_launch: unexpected n_in %d or ws_size %zu (< %zu)\n", n_in, ws_size, (size_t)WS_END); grid = -1; return; }
        int dev = 0, cus = 0, per_cu = 0;
        hipGetDevice(&dev); hipDeviceGetAttribute(&cus, hipDeviceAttributeMultiprocessorCount, dev);
        if (hipFuncSetAttribute((const void*)fwd, hipFuncAttributeMaxDynamicSharedMemorySize, LDS_BYTES) != hipSuccess) { fprintf(stderr, "hipFuncSetAttribute failed\n"); grid = -1; return; }
        hipOccupancyMaxActiveBlocksPerMultiprocessor(&per_cu, (const void*)fwd, 512, LDS_BYTES);
        (void)hipGetLastError();
        if (per_cu < 1) fprintf(stderr, "occupancy query says %d blocks per CU\n", per_cu);
        grid = cus > 0 ? cus : 256;
    }
    if (grid < 0) return;
    hipMemsetAsync((char*)d_ws + WS_CTL, 0, CTL_BYTES, stream);
    Params p{};
    for (int i = 0; i < 26; ++i) p.in[i] = (const float*)d_in[i];
    p.out = (float*)d_out; p.ws = (unsigned char*)d_ws;
#if N_LAUNCH_MODE == 1
    p.lo_hi = (long long)0 | ((long long)NPHASE << 32);
    hipLaunchKernelGGL(fwd, dim3(grid), dim3(512), LDS_BYTES, stream, p);
#else
    for (int ph = 0; ph < NPHASE; ++ph) {
        p.lo_hi = (long long)ph | ((long long)(ph + 1) << 32);
        hipLaunchKernelGGL(fwd, dim3(grid), dim3(512), LDS_BYTES, stream, p);
    }
#endif
}
```

```cpp
#include <hip/hip_runtime.h>
#include <cstdio>
#include <cstdint>

#ifndef N_LAUNCH_MODE
#define N_LAUNCH_MODE 1
#endif

constexpr int B_ = 8, S_ = 2048, D_ = 2048, T_ = B_ * S_;
constexpr int INW = 3608;
constexpr int C_Q = 0, C_KC = 1024, C_VC = 1280, C_KS = 1536, C_VS = 1792, C_KW = 2048, C_VW = 2304, C_G = 2560, C_UP = 2584, C_QM = 3096;
constexpr int NC = 127;
constexpr int CROWS = B_ * NC * 2;
constexpr int NE = 32, DE = 2048, NA = T_ * 4;
constexpr float LN_EPS = 1e-5f;
constexpr float DN_ALPHA = 1.189207115002721f;
constexpr float ATT_SCALE = 0.08838834764831845f;

constexpr size_t al256(size_t x) { return (x + 255) & ~(size_t)255; }
constexpr size_t WS_CTL = 0;
constexpr size_t CTL_BYTES = 65536;
constexpr size_t CTL_CNT = 16384;
constexpr size_t WS_PROJ = CTL_BYTES;
constexpr size_t WS_KVMEM = WS_PROJ + al256((size_t)T_ * INW * 4);
constexpr size_t WS_BIAS1 = WS_KVMEM + al256((size_t)2048 * 1024 * 4);
constexpr size_t WS_HID = WS_BIAS1 + al256(2 * 256 * 4);
constexpr size_t WS_KC = WS_HID + al256((size_t)2 * 2048 * 256 * 4);
constexpr size_t WS_VC = WS_KC + al256((size_t)CROWS * 128 * 4);
constexpr size_t WS_POOLED = WS_VC + al256((size_t)CROWS * 128 * 4);
constexpr size_t WS_OPOOL = WS_POOLED + al256((size_t)T_ * 512 * 4);
constexpr size_t WS_OWIN = WS_OPOOL + al256((size_t)T_ * 512 * 4);
constexpr size_t WS_OCMP = WS_OWIN + al256((size_t)T_ * 1024 * 4);
constexpr size_t WS_OSLC = WS_OCMP + al256((size_t)T_ * 1024 * 4);
constexpr size_t WS_SEL = WS_OSLC + al256((size_t)T_ * 1024 * 4);
constexpr size_t WS_OMEM = WS_SEL + al256((size_t)T_ * 2 * 4);
constexpr size_t WS_CAT16 = WS_OMEM + al256((size_t)T_ * 512 * 4);
constexpr size_t WS_HPRE = WS_CAT16 + al256((size_t)T_ * 2048 * 2);
constexpr size_t WS_H = WS_HPRE + al256((size_t)T_ * 2048 * 4);
constexpr size_t WS_H16 = WS_H + al256((size_t)T_ * 2048 * 4);
constexpr size_t WS_GATE = WS_H16 + al256((size_t)T_ * 2048 * 2);
constexpr size_t WS_LIST = WS_GATE + al256((size_t)NA * 4);
constexpr size_t WS_ACT16 = WS_LIST + al256((size_t)NE * T_ * 4);
constexpr size_t WS_Y16 = WS_ACT16 + al256((size_t)(NA + 256) * 2048 * 2);
constexpr size_t WS_X16 = WS_Y16 + al256((size_t)NA * 2048 * 2);
constexpr size_t WS_WTIN = WS_X16 + al256((size_t)T_ * 2048 * 2);
constexpr size_t WS_WTOUT = WS_WTIN + al256((size_t)3840 * 2048 * 2);
constexpr size_t WS_WTGU = WS_WTOUT + al256((size_t)2048 * 2048 * 2);
constexpr size_t WS_WTDN = WS_WTGU + al256((size_t)NE * 4096 * 2048 * 2);
constexpr size_t WS_PROJ16 = WS_WTDN + al256((size_t)NE * 2048 * 2048 * 2);
constexpr size_t WS_KVMEM16 = WS_PROJ16 + al256((size_t)(T_ + 64) * INW * 2);
constexpr size_t WS_WT1 = WS_KVMEM16 + al256((size_t)2048 * 1024 * 2);
constexpr size_t WS_UV = WS_WT1 + al256((size_t)2 * 512 * 2048 * 2);
constexpr size_t WS_KC16 = WS_UV + al256((size_t)2 * 4 * 2048 * 512 * 4);
constexpr size_t WS_VC16 = WS_KC16 + al256((size_t)B_ * 128 * 256 * 2);
constexpr size_t WS_WR16 = WS_VC16 + al256((size_t)B_ * 128 * 256 * 2);
constexpr size_t WS_END = WS_WR16 + al256((size_t)32 * 2048 * 2);

constexpr int LDS_BYTES = 155648;

struct Params {
    const float* in[26];
    float* out;
    unsigned char* ws;
    long long lo_hi;
};
enum { I_X = 0, I_MEM, I_WIN, I_POSK, I_W1K, I_W2K, I_POSV, I_W1V, I_W2V, I_POOLW, I_POOLS, I_WMEMKV, I_GNNSA, I_GNPOOL, I_GNMEM, I_WOUT,
       I_LN1G, I_LN1B, I_WR, I_BR, I_WGU, I_BGU, I_WDN, I_BDN, I_LN2G, I_LN2B };

#define XB_TMO      128
#define XB_XCNT(j)  (256  + 64 * (j))
#define XB_XSUB(j)  (1280 + 64 * (j))
#define XB_XGEN(j)  (2304 + 64 * (j))
#define XB_TOP      3328
#define XB_TOPGEN   3392
#define XCD_BAR_WORDS 3456
#define XB_SPIN_CAP (1u << 25)
#define LAS __attribute__((address_space(3)))

__device__ __forceinline__ unsigned xb_ld(unsigned* p)              { return __hip_atomic_load(p, __ATOMIC_RELAXED, __HIP_MEMORY_SCOPE_AGENT); }
__device__ __forceinline__ unsigned xb_add(unsigned* p, unsigned v) { return __hip_atomic_fetch_add(p, v, __ATOMIC_RELAXED, __HIP_MEMORY_SCOPE_AGENT); }
__device__ __forceinline__ unsigned xb_xcc_id() { return (unsigned)__builtin_amdgcn_s_getreg((3 << 11) | 20) & 0xFu; }
#define XB_SPIN(cond, bar) do { unsigned _sp = 0; while (cond) { __builtin_amdgcn_s_sleep(1); \
    if ((++_sp & 255u) == 0u) { if (xb_ld(&(bar)[XB_TMO])) break; if (_sp > XB_SPIN_CAP) { atomicAdd(&(bar)[XB_TMO], 1u); break; } } } } while (0)

struct XcdBarrier { unsigned* bar; unsigned x; volatile LAS unsigned* st; };

__device__ __forceinline__ XcdBarrier xcd_barrier_post(unsigned* bar, volatile LAS unsigned* st) {
    XcdBarrier b; b.bar = bar; b.x = xb_xcc_id(); b.st = st;
    if (threadIdx.x == 0) (void)xb_add(&bar[XB_XCNT(b.x)], 1u);
    return b;
}
__device__ __forceinline__ void xcd_barrier_complete(unsigned* bar, unsigned x, unsigned& nloc, unsigned& nx) {
    const unsigned G = gridDim.x * gridDim.y * gridDim.z;
    unsigned sum, cnt, mine, sp = 0u;
    for (;;) {
        sum = 0u; cnt = 0u; mine = 0u;
#pragma unroll
        for (unsigned j = 0; j < 16; ++j) { const unsigned c = xb_ld(&bar[XB_XCNT(j)]); sum += c; cnt += (c > 0u) ? 1u : 0u; mine = (j == x) ? c : mine; }
        if (sum == G) break;
        __builtin_amdgcn_s_sleep(1);
        if ((++sp & 255u) == 0u) { if (xb_ld(&bar[XB_TMO])) break; if (sp > XB_SPIN_CAP) { atomicAdd(&bar[XB_TMO], 1u); break; } }
    }
    nloc = mine > 0u ? mine : 1u; nx = cnt > 0u ? cnt : 1u;
}
__device__ __forceinline__ void xcd_barrier(const XcdBarrier& b) {
    asm volatile("s_waitcnt vmcnt(0)" ::: "memory");
    __syncthreads();
    if (threadIdx.x == 0) {
        unsigned* bar = b.bar;
        __builtin_amdgcn_s_waitcnt(0);
        unsigned nloc = b.st[0], nx = b.st[1];
        if (nloc == 0u) { xcd_barrier_complete(bar, b.x, nloc, nx); b.st[0] = nloc; b.st[1] = nx; }
        const unsigned old = xb_add(&bar[XB_XSUB(b.x)], 1u);
        const unsigned gen = old / nloc;
        if (old + 1u == (gen + 1u) * nloc) {
            __builtin_amdgcn_fence(__ATOMIC_RELEASE, "agent");
            asm volatile("s_waitcnt vmcnt(0)" ::: "memory");
            const unsigned og = xb_add(&bar[XB_TOP], 1u);
            const unsigned tg = og / nx;
            if (og + 1u == (tg + 1u) * nx) xb_add(&bar[XB_TOPGEN], 1u);
            else XB_SPIN(xb_ld(&bar[XB_TOPGEN]) == tg, bar);
            __builtin_amdgcn_fence(__ATOMIC_ACQUIRE, "agent");
            xb_add(&bar[XB_XGEN(b.x)], 1u);
            asm volatile("s_waitcnt vmcnt(0)" ::: "memory");
        } else {
            XB_SPIN(xb_ld(&bar[XB_XGEN(b.x)]) == gen, bar);
            __builtin_amdgcn_fence(__ATOMIC_ACQUIRE, "agent");
            asm volatile("s_waitcnt vmcnt(0)" ::: "memory");
        }
    }
    __syncthreads();
}

typedef _Float16 h8 __attribute__((ext_vector_type(8)));
typedef _Float16 h4 __attribute__((ext_vector_type(4)));
typedef float f4 __attribute__((ext_vector_type(4)));

__device__ __forceinline__ float wave_sum(float v) {
#pragma unroll
    for (int o = 32; o > 0; o >>= 1) v += __shfl_xor(v, o);
    return v;
}
__device__ __forceinline__ float wave_max(float v) {
#pragma unroll
    for (int o = 32; o > 0; o >>= 1) v = fmaxf(v, __shfl_xor(v, o));
    return v;
}
__device__ __forceinline__ void wave_sync() {
    asm volatile("s_waitcnt lgkmcnt(0)" ::: "memory");
    __builtin_amdgcn_wave_barrier();
}
__device__ __forceinline__ float gelu_tanh(float x) {
    const float u = 0.7978845608028654f * (x + 0.044715f * x * x * x);
    return 0.5f * x * (1.f + tanhf(u));
}
__device__ __forceinline__ float sigmoidf_(float x) { return 1.f / (1.f + expf(-x)); }

constexpr int G_LD = 40;
template <class AF, class EF>
__device__ __forceinline__ void gemm_tile(char* smem, int K, const AF& af, const float* __restrict__ Bm, int ldb, int n0, int Nlim, bool perm, const EF& ef) {
    _Float16* As = (_Float16*)smem;
    _Float16* Bs = As + 128 * G_LD;
    const int tid = threadIdx.x, lane = tid & 63, wid = tid >> 6, wr = wid >> 2, wc = wid & 3, fr = lane & 15, fq = lane >> 4;
    f4 acc[4][2];
#pragma unroll
    for (int m = 0; m < 4; ++m)
#pragma unroll
        for (int n = 0; n < 2; ++n) acc[m][n] = (f4){0.f, 0.f, 0.f, 0.f};
    const int ar = tid >> 3, ak = (tid & 7) * 4;
    const float* ap0 = af.row(ar);
    const float* ap1 = af.row(ar + 64);
    const int bk = tid >> 5, bn = (tid & 31) * 4;
    const bool bok = (n0 + bn) < Nlim;
    int bnp[4];
#pragma unroll
    for (int i = 0; i < 4; ++i) { const int c = bn + i; bnp[i] = perm ? ((c & ~31) | ((c & 1) << 4) | ((c & 31) >> 1)) : c; }
    for (int k0 = 0; k0 < K; k0 += 32) {
        const int ko = af.koff(k0 + ak);
        float4 a0 = make_float4(0.f, 0.f, 0.f, 0.f), a1 = a0, b0 = a0, b1 = a0;
        if (ap0) a0 = *(const float4*)(ap0 + ko);
        if (ap1) a1 = *(const float4*)(ap1 + ko);
        if (bok) { b0 = *(const float4*)(Bm + (size_t)(k0 + bk) * ldb + n0 + bn); b1 = *(const float4*)(Bm + (size_t)(k0 + bk + 16) * ldb + n0 + bn); }
        __syncthreads();
        *(h4*)&As[ar * G_LD + ak] = (h4){(_Float16)a0.x, (_Float16)a0.y, (_Float16)a0.z, (_Float16)a0.w};
        *(h4*)&As[(ar + 64) * G_LD + ak] = (h4){(_Float16)a1.x, (_Float16)a1.y, (_Float16)a1.z, (_Float16)a1.w};
        Bs[bnp[0] * G_LD + bk] = (_Float16)b0.x; Bs[bnp[1] * G_LD + bk] = (_Float16)b0.y; Bs[bnp[2] * G_LD + bk] = (_Float16)b0.z; Bs[bnp[3] * G_LD + bk] = (_Float16)b0.w;
        Bs[bnp[0] * G_LD + bk + 16] = (_Float16)b1.x; Bs[bnp[1] * G_LD + bk + 16] = (_Float16)b1.y; Bs[bnp[2] * G_LD + bk + 16] = (_Float16)b1.z; Bs[bnp[3] * G_LD + bk + 16] = (_Float16)b1.w;
        __syncthreads();
        h8 a[4], b[2];
#pragma unroll
        for (int m = 0; m < 4; ++m) a[m] = *(const h8*)&As[(wr * 64 + m * 16 + fr) * G_LD + fq * 8];
#pragma unroll
        for (int n = 0; n < 2; ++n) b[n] = *(const h8*)&Bs[(wc * 32 + n * 16 + fr) * G_LD + fq * 8];
#pragma unroll
        for (int m = 0; m < 4; ++m)
#pragma unroll
            for (int n = 0; n < 2; ++n) acc[m][n] = __builtin_amdgcn_mfma_f32_16x16x32_f16(a[m], b[n], acc[m][n], 0, 0, 0);
    }
    ef(acc, wr, wc, fr, fq);
    __syncthreads();
}

struct ARowPlain { const float* base; int ld; int m0; int mlim;
    __device__ __forceinline__ const float* row(int r) const { return (m0 + r) < mlim ? base + (size_t)(m0 + r) * ld : nullptr; }
    __device__ __forceinline__ int koff(int k) const { return k; } };
struct ARowCmp { const float* proj; int col; int m0;
    __device__ __forceinline__ const float* row(int r) const { const int g = m0 + r; if (g >= CROWS) return nullptr; const int kvh = g & 1, bc = g >> 1, b = bc / NC, c = bc % NC;
        return proj + (size_t)(b * S_ + 16 * c) * INW + col + kvh * 128; }
    __device__ __forceinline__ int koff(int k) const { return (k >> 7) * INW + (k & 127); } };
struct ARowList { const float* base; const int* list; int m0; int cnt; int shift;
    __device__ __forceinline__ const float* row(int r) const { if (m0 + r >= cnt) return nullptr; const int a = list[m0 + r]; return base + (size_t)(a >> shift) * 2048; }
    __device__ __forceinline__ int koff(int k) const { return k; } };

struct EpiStore { float* C; int ldc; int m0; int n0; int mlim; int nlim; _Float16* C16;
    __device__ __forceinline__ void operator()(const f4 (&acc)[4][2], int wr, int wc, int fr, int fq) const {
#pragma unroll
        for (int m = 0; m < 4; ++m)
#pragma unroll
            for (int n = 0; n < 2; ++n)
#pragma unroll
                for (int j = 0; j < 4; ++j) { const int r = m0 + wr * 64 + m * 16 + fq * 4 + j, c = n0 + wc * 32 + n * 16 + fr;
                    if (r < mlim && c < nlim) { C[(size_t)r * ldc + c] = acc[m][n][j]; if (C16) C16[(size_t)r * ldc + c] = (_Float16)acc[m][n][j]; } } } };
struct EpiPool { float* C; const float* scale; int m0; int g;
    __device__ __forceinline__ void operator()(const f4 (&acc)[4][2], int wr, int wc, int fr, int fq) const {
#pragma unroll
        for (int m = 0; m < 4; ++m)
#pragma unroll
            for (int n = 0; n < 2; ++n)
#pragma unroll
                for (int j = 0; j < 4; ++j) { const int r = m0 + wr * 64 + m * 16 + fq * 4 + j, c = g * 128 + wc * 32 + n * 16 + fr;
                    C[(size_t)r * 512 + c] = acc[m][n][j] * scale[c]; } } };
struct EpiHid { float* C; const float* bias; int m0; int n0;
    __device__ __forceinline__ void operator()(const f4 (&acc)[4][2], int wr, int wc, int fr, int fq) const {
#pragma unroll
        for (int m = 0; m < 4; ++m)
#pragma unroll
            for (int n = 0; n < 2; ++n)
#pragma unroll
                for (int j = 0; j < 4; ++j) { const int r = m0 + wr * 64 + m * 16 + fq * 4 + j, c = n0 + wc * 32 + n * 16 + fr;
                    if (r < CROWS) C[(size_t)r * 256 + c] = gelu_tanh(acc[m][n][j] + bias[c]); } } };
struct EpiOut { float* C; const float* x; int m0; int n0;
    __device__ __forceinline__ void operator()(const f4 (&acc)[4][2], int wr, int wc, int fr, int fq) const {
#pragma unroll
        for (int m = 0; m < 4; ++m)
#pragma unroll
            for (int n = 0; n < 2; ++n)
#pragma unroll
                for (int j = 0; j < 4; ++j) { const size_t o = (size_t)(m0 + wr * 64 + m * 16 + fq * 4 + j) * 2048 + n0 + wc * 32 + n * 16 + fr;
                    C[o] = DN_ALPHA * x[o] + acc[m][n][j]; } } };
struct EpiGu { float* act; const float* bgu; const int* list; int m0; int cnt; int n0;
    __device__ __forceinline__ void operator()(const f4 (&acc)[4][2], int wr, int wc, int fr, int fq) const {
        const int jc = (n0 + wc * 32) / 2 + fr;
        const float bg = bgu[2 * jc], bl = bgu[2 * jc + 1];
#pragma unroll
        for (int m = 0; m < 4; ++m)
#pragma unroll
            for (int j = 0; j < 4; ++j) { const int r = m0 + wr * 64 + m * 16 + fq * 4 + j;
                if (r < cnt) { const int a = list[r];
                    const float xg = fminf(acc[m][0][j] + bg, 7.f), xl = fminf(fmaxf(acc[m][1][j] + bl, -7.f), 7.f);
                    act[(size_t)a * 2048 + jc] = xg * sigmoidf_(1.702f * xg) * (xl + 1.f); } } } };
struct EpiDn { float* y; const float* bdn; const int* list; const float* gate; int m0; int cnt; int n0;
    __device__ __forceinline__ void operator()(const f4 (&acc)[4][2], int wr, int wc, int fr, int fq) const {
#pragma unroll
        for (int m = 0; m < 4; ++m)
#pragma unroll
            for (int j = 0; j < 4; ++j) { const int r = m0 + wr * 64 + m * 16 + fq * 4 + j;
                if (r < cnt) { const int a = list[r]; const float g = gate[a];
#pragma unroll
                    for (int n = 0; n < 2; ++n) { const int c = n0 + wc * 32 + n * 16 + fr; y[(size_t)a * 2048 + c] = (acc[m][n][j] + bdn[c]) * g; } } } } };

constexpr int WLDS_FLOATS = 4096 + 512 + 32;
template <bool SHARED>
__device__ __forceinline__ void wave_attn(float* sw, const float* __restrict__ qptr, const float* __restrict__ Kb, const float* __restrict__ Vb, int ld, int nseg, float scale, float* __restrict__ optr) {
    const int lane = threadIdx.x & 63;
    float* sq = sw + 4096; const int* segs = (const int*)(sw + 4096 + 512);
#pragma unroll
    for (int i = 0; i < 8; ++i) sq[lane + 64 * i] = qptr[lane + 64 * i];
    wave_sync();
    for (int sg = 0; sg < nseg; ++sg) {
        const int start = segs[sg], len = segs[16 + sg];
        float d0 = 0.f, d1 = 0.f, d2 = 0.f, d3 = 0.f;
        if (lane < len) {
            const float* kp = Kb + (size_t)(start + lane) * ld;
            for (int d4 = 0; d4 < 32; ++d4) {
                if (SHARED) {
                    const float4 kv = *(const float4*)(kp + d4 * 4);
                    const float4 q0 = *(const float4*)(sq + d4 * 4), q1 = *(const float4*)(sq + 128 + d4 * 4), q2 = *(const float4*)(sq + 256 + d4 * 4), q3 = *(const float4*)(sq + 384 + d4 * 4);
                    d0 += kv.x * q0.x + kv.y * q0.y + kv.z * q0.z + kv.w * q0.w;
                    d1 += kv.x * q1.x + kv.y * q1.y + kv.z * q1.z + kv.w * q1.w;
                    d2 += kv.x * q2.x + kv.y * q2.y + kv.z * q2.z + kv.w * q2.w;
                    d3 += kv.x * q3.x + kv.y * q3.y + kv.z * q3.z + kv.w * q3.w;
                } else {
                    const float4 k0 = *(const float4*)(kp + d4 * 4), k1 = *(const float4*)(kp + 128 + d4 * 4), k2 = *(const float4*)(kp + 256 + d4 * 4), k3 = *(const float4*)(kp + 384 + d4 * 4);
                    const float4 q0 = *(const float4*)(sq + d4 * 4), q1 = *(const float4*)(sq + 128 + d4 * 4), q2 = *(const float4*)(sq + 256 + d4 * 4), q3 = *(const float4*)(sq + 384 + d4 * 4);
                    d0 += k0.x * q0.x + k0.y * q0.y + k0.z * q0.z + k0.w * q0.w;
                    d1 += k1.x * q1.x + k1.y * q1.y + k1.z * q1.z + k1.w * q1.w;
                    d2 += k2.x * q2.x + k2.y * q2.y + k2.z * q2.z + k2.w * q2.w;
                    d3 += k3.x * q3.x + k3.y * q3.y + k3.z * q3.z + k3.w * q3.w;
                }
            }
        }
        const bool ok = lane < len;
        sw[sg * 64 + lane] = ok ? d0 * scale : -1e30f;
        sw[1024 + sg * 64 + lane] = ok ? d1 * scale : -1e30f;
        sw[2048 + sg * 64 + lane] = ok ? d2 * scale : -1e30f;
        sw[3072 + sg * 64 + lane] = ok ? d3 * scale : -1e30f;
    }
    wave_sync();
    const int n = nseg * 64;
#pragma unroll
    for (int g = 0; g < 4; ++g) {
        float mx = -1e30f;
        for (int i = lane; i < n; i += 64) mx = fmaxf(mx, sw[g * 1024 + i]);
        mx = wave_max(mx);
        float sm = 0.f;
        for (int i = lane; i < n; i += 64) { const float v = sw[g * 1024 + i]; sm += (v > -1e29f) ? expf(v - mx) : 0.f; }
        sm = wave_sum(sm);
        const float inv = sm > 0.f ? 1.f / sm : 0.f;
        for (int i = lane; i < n; i += 64) { const float v = sw[g * 1024 + i]; sw[g * 1024 + i] = (v > -1e29f) ? expf(v - mx) * inv : 0.f; }
    }
    wave_sync();
    float o[4][2];
#pragma unroll
    for (int g = 0; g < 4; ++g) { o[g][0] = 0.f; o[g][1] = 0.f; }
    for (int sg = 0; sg < nseg; ++sg) {
        const int start = segs[sg], len = segs[16 + sg];
        for (int l = 0; l < len; ++l) {
            const float* vp = Vb + (size_t)(start + l) * ld;
            if (SHARED) {
                const float v0 = vp[lane], v1 = vp[lane + 64];
#pragma unroll
                for (int g = 0; g < 4; ++g) { const float p = sw[g * 1024 + sg * 64 + l]; o[g][0] += p * v0; o[g][1] += p * v1; }
            } else {
#pragma unroll
                for (int g = 0; g < 4; ++g) { const float p = sw[g * 1024 + sg * 64 + l]; o[g][0] += p * vp[g * 128 + lane]; o[g][1] += p * vp[g * 128 + lane + 64]; }
            }
        }
    }
#pragma unroll
    for (int g = 0; g < 4; ++g) { optr[g * 128 + lane] = o[g][0]; optr[g * 128 + lane + 64] = o[g][1]; }
}

namespace g8 {
constexpr int BM = 256, BK = 64, HALF = 128, HTB = HALF * BK * 2, STAGE_BYTES = 8 * HTB;
constexpr int KK = 2048;
typedef float f32x4 __attribute__((ext_vector_type(4)));
__device__ __forceinline__ int lds_byte(int r, int c) { const int st = (r >> 4) * 2 + (c >> 5), rr = r & 15, cc = c & 31, ob = rr * 64 + cc * 2; return st * 1024 + (ob ^ (((ob >> 9) & 1) << 5)); }
__device__ __forceinline__ void stage_rc(int b, int& R, int& C) { const int st = b / 1024, sb = b % 1024, swz = sb ^ (((sb >> 9) & 1) << 5); R = (st >> 1) * 16 + swz / 64; C = (st & 1) * 32 + (swz % 64) / 2; }
__device__ __forceinline__ int perm32(int rho) { const int n = rho >> 4, i = rho & 15; return 8 * (i >> 2) + 4 * n + (i & 3); }

struct Unit { int m0, n0, e, cnt, rbase; };

__device__ __forceinline__ void tile_order(int L, int nM, int nN, int& pm, int& pn) {
    const int nwg = nM * nN; int wgid = L;
    { const int q = nwg / 8, r = nwg % 8, xcd = wgid % 8, off = wgid / 8; wgid = (xcd < r ? xcd * (q + 1) : r * (q + 1) + (xcd - r) * q) + off; }
    const int nig = 8 * nN, gid = wgid / nig, fm = gid * 8, gsz = (nM - fm) < 8 ? (nM - fm) : 8;
    pm = fm + ((wgid % nig) % gsz); pn = (wgid % nig) / gsz;
}

template <class Prob>
__device__ __forceinline__ void gemm_phase(LAS unsigned char* lds, const Prob& P) {
    const int tid = threadIdx.x, wid = __builtin_amdgcn_readfirstlane(tid >> 6), lane = tid & 63, wr = wid >> 2, wc = wid & 3, fr = lane & 15, fq = lane >> 4;
    constexpr int K = KK, nt = Prob::NT; constexpr size_t KS2 = Prob::KS2;
    int sR[2], sC2[2]; unsigned voffB[2];
#pragma unroll
    for (int i = 0; i < 2; ++i) { int R, C; stage_rc(tid * 16 + i * 8192, R, C); sR[i] = R; sC2[i] = C * 2; const int Rb = Prob::PERM ? ((R & ~31) + perm32(R & 31)) : R; voffB[i] = (unsigned)(Rb * K + C) * 2u; }
    const size_t kstep = (size_t)(BK * 2);
    const size_t hstep = (size_t)HALF * K * 2;
    const unsigned ldsw = (unsigned)wid * 1024u;
    const int aoff = lds_byte(wr * 64 + fr, fq * 8), boff = lds_byte(wc * 32 + fr, fq * 8);
#define G8_SA(b, h) (((b) * 2 + (h)) * HTB)
#define G8_SB(b, h) ((4 + (b) * 2 + (h)) * HTB)
#define G8_STAGE(bufoff, gbase, voff) do { _Pragma("unroll") for (int _i = 0; _i < 2; ++_i) \
        __builtin_amdgcn_global_load_lds((const unsigned*)((const char*)(gbase) + (voff)[_i]), (LAS unsigned*)(lds + (bufoff) + ldsw + _i * 8192), 16, 0, 0); } while (0)
#define G8_LDA(dst, b, h) do { _Pragma("unroll") for (int m = 0; m < 4; ++m) _Pragma("unroll") for (int k = 0; k < 2; ++k) dst[m][k] = *(const LAS h8*)(lds + G8_SA(b, h) + aoff + m * 2048 + k * 1024); } while (0)
#define G8_LDB(dst, b, h) do { _Pragma("unroll") for (int n = 0; n < 2; ++n) _Pragma("unroll") for (int k = 0; k < 2; ++k) dst[n][k] = *(const LAS h8*)(lds + G8_SB(b, h) + boff + n * 2048 + k * 1024); } while (0)
#define G8_MMA(ai, bj, At, Bt) do { __builtin_amdgcn_s_setprio(1); _Pragma("unroll") for (int m = 0; m < 4; ++m) _Pragma("unroll") for (int n = 0; n < 2; ++n) _Pragma("unroll") for (int k = 0; k < 2; ++k) \
        acc[ai][bj][m][n] = __builtin_amdgcn_mfma_f32_16x16x32_f16(Bt[n][k], At[m][k], acc[ai][bj][m][n], 0, 0, 0); __builtin_amdgcn_s_setprio(0); } while (0)
#define G8_WAIT_V(n) asm volatile("s_waitcnt vmcnt(" #n ")" ::: "memory")
#define G8_WAIT_L(n) asm volatile("s_waitcnt lgkmcnt(" #n ")" ::: "memory")
#define G8_BAR __builtin_amdgcn_s_barrier()
#define G8_SCHED __builtin_amdgcn_sched_barrier(0)
    Unit cur, nxt; int ui = 0;
    if (!P.next(0, cur)) return;
    f32x4 acc[2][2][4][2];
#pragma unroll
    for (int a = 0; a < 2; ++a)
#pragma unroll
        for (int b = 0; b < 2; ++b)
#pragma unroll
            for (int m = 0; m < 4; ++m)
#pragma unroll
                for (int n = 0; n < 2; ++n) acc[a][b][m][n] = (f32x4){0.f, 0.f, 0.f, 0.f};
    h8 At[4][2], B0[2][2], B1[2][2];
    unsigned vc[2][2], vn[2][2];
    P.a_offs(cur, sR, sC2, vc);
    const char* const Ab = P.a_base();
    const char* cB = P.b_base(cur);
    G8_STAGE(G8_SB(0, 0), cB, voffB); G8_STAGE(G8_SA(0, 0), Ab, vc[0]); G8_STAGE(G8_SB(0, 1), cB + hstep, voffB); G8_STAGE(G8_SA(0, 1), Ab, vc[1]);
    if (wr == 1) G8_BAR;
    G8_WAIT_V(4); G8_BAR;
    G8_STAGE(G8_SB(1, 0), cB + kstep, voffB); G8_STAGE(G8_SA(1, 0), Ab + kstep, vc[0]); G8_STAGE(G8_SB(1, 1), cB + hstep + kstep, voffB);
    G8_WAIT_V(6); G8_BAR;
    for (;;) {
        const bool has_next = P.next(ui + 1, nxt);
        const char* nB = cB;
        if (has_next) { P.a_offs(nxt, sR, sC2, vn); nB = P.b_base(nxt); }
        else { vn[0][0] = vc[0][0]; vn[0][1] = vc[0][1]; vn[1][0] = vc[1][0]; vn[1][1] = vc[1][1]; }
        for (int t = 0; t < nt; t += 2) {
            const bool last = (t == nt - 2);
            const char* a1 = Ab + (size_t)(t >> 1) * KS2 + kstep;
            const char* a2 = last ? Ab : Ab + (size_t)((t + 2) >> 1) * KS2; const char* b2 = last ? nB : cB + (size_t)(t + 2) * kstep;
            const char* a3 = a2 + kstep; const char* b3 = b2 + kstep;
            unsigned o2[2][2];
            o2[0][0] = last ? vn[0][0] : vc[0][0]; o2[0][1] = last ? vn[0][1] : vc[0][1]; o2[1][0] = last ? vn[1][0] : vc[1][0]; o2[1][1] = last ? vn[1][1] : vc[1][1];
            G8_LDB(B0, 0, 0); G8_SCHED; G8_LDA(At, 0, 0); G8_STAGE(G8_SA(1, 1), a1, vc[1]);
            G8_WAIT_L(8); G8_BAR; G8_WAIT_L(0); G8_MMA(0, 0, At, B0); G8_BAR; G8_SCHED;
            G8_LDB(B1, 0, 1); G8_STAGE(G8_SB(0, 0), b2, voffB);
            G8_BAR; G8_WAIT_L(0); G8_MMA(0, 1, At, B1); G8_BAR;
            G8_LDA(At, 0, 1); G8_STAGE(G8_SA(0, 0), a2, o2[0]);
            G8_BAR; G8_WAIT_L(0); G8_MMA(1, 0, At, B0); G8_BAR; G8_SCHED;
            G8_STAGE(G8_SB(0, 1), b2 + hstep, voffB);
            G8_WAIT_V(6); G8_BAR; G8_MMA(1, 1, At, B1); G8_BAR;
            G8_LDB(B0, 1, 0); G8_SCHED; G8_LDA(At, 1, 0); G8_STAGE(G8_SA(0, 1), a2, o2[1]);
            G8_WAIT_L(8); G8_BAR; G8_WAIT_L(0); G8_MMA(0, 0, At, B0); G8_BAR; G8_SCHED;
            G8_LDB(B1, 1, 1); G8_STAGE(G8_SB(1, 0), b3, voffB);
            G8_BAR; G8_WAIT_L(0); G8_MMA(0, 1, At, B1); G8_BAR;
            G8_LDA(At, 1, 1); G8_STAGE(G8_SA(1, 0), a3, o2[0]);
            G8_BAR; G8_WAIT_L(0); G8_MMA(1, 0, At, B0); G8_BAR; G8_SCHED;
            G8_STAGE(G8_SB(1, 1), b3 + hstep, voffB);
            G8_WAIT_V(6); G8_BAR; G8_MMA(1, 1, At, B1); G8_BAR;
        }
        P.epi(acc, cur, wr, wc, fr, fq);
        if (!has_next) break;
#pragma unroll
        for (int a = 0; a < 2; ++a)
#pragma unroll
            for (int b = 0; b < 2; ++b)
#pragma unroll
                for (int m = 0; m < 4; ++m)
#pragma unroll
                    for (int n = 0; n < 2; ++n) acc[a][b][m][n] = (f32x4){0.f, 0.f, 0.f, 0.f};
        cur = nxt; cB = nB; ++ui;
        vc[0][0] = vn[0][0]; vc[0][1] = vn[0][1]; vc[1][0] = vn[1][0]; vc[1][1] = vn[1][1];
    }
    G8_WAIT_V(0);
    if (wr == 0) G8_BAR;
    G8_BAR;
#undef G8_SA
#undef G8_SB
#undef G8_STAGE
#undef G8_LDA
#undef G8_LDB
#undef G8_MMA
#undef G8_WAIT_V
#undef G8_WAIT_L
#undef G8_BAR
#undef G8_SCHED
}

struct ProbIn {
    static constexpr int NT = 32; static constexpr size_t KS2 = 256;
    static constexpr bool PERM = true;
    const _Float16* A; const _Float16* Bt; _Float16* C16; int G, c;
    __device__ __forceinline__ bool next(int i, Unit& u) const { const int L = i * G + c; if (L >= 64 * 15) return false; int pm, pn; tile_order(L, 64, 15, pm, pn); u.m0 = pm * 256; u.n0 = pn * 256; u.e = 0; u.cnt = 256; u.rbase = 0; return true; }
    __device__ __forceinline__ void a_offs(const Unit& u, const int (&R)[2], const int (&C2)[2], unsigned (&v)[2][2]) const {
#pragma unroll
        for (int h = 0; h < 2; ++h)
#pragma unroll
            for (int i = 0; i < 2; ++i) v[h][i] = (unsigned)(u.m0 + h * 128 + R[i]) * (unsigned)(KK * 2) + (unsigned)C2[i]; }
    __device__ __forceinline__ const char* a_base() const { return (const char*)A; }
    __device__ __forceinline__ const char* b_base(const Unit& u) const { return (const char*)(Bt + (size_t)u.n0 * KK); }
    __device__ __forceinline__ void epi(const f32x4 (&acc)[2][2][4][2], const Unit& u, int wr, int wc, int fr, int fq) const {
#pragma unroll
        for (int ai = 0; ai < 2; ++ai)
#pragma unroll
            for (int m = 0; m < 4; ++m) { const int row = u.m0 + ai * 128 + wr * 64 + m * 16 + fr;
#pragma unroll
                for (int bj = 0; bj < 2; ++bj) { const int col = u.n0 + bj * 128 + wc * 32 + fq * 8;
                    if (col < INW) { const f32x4 v0 = acc[ai][bj][m][0], v1 = acc[ai][bj][m][1];
                        h8 o; o[0] = (_Float16)v0[0]; o[1] = (_Float16)v0[1]; o[2] = (_Float16)v0[2]; o[3] = (_Float16)v0[3]; o[4] = (_Float16)v1[0]; o[5] = (_Float16)v1[1]; o[6] = (_Float16)v1[2]; o[7] = (_Float16)v1[3];
                        *(h8*)(C16 + (size_t)row * INW + col) = o; } } } }
};
struct ProbOut {
    static constexpr int NT = 32; static constexpr size_t KS2 = 256;
    static constexpr bool PERM = false;
    const _Float16* A; const _Float16* Bt; float* C; const float* X; int G, c;
    __device__ __forceinline__ bool next(int i, Unit& u) const { const int L = i * G + c; if (L >= 64 * 8) return false; int pm, pn; tile_order(L, 64, 8, pm, pn); u.m0 = pm * 256; u.n0 = pn * 256; u.e = 0; u.cnt = 256; u.rbase = 0; return true; }
    __device__ __forceinline__ void a_offs(const Unit& u, const int (&R)[2], const int (&C2)[2], unsigned (&v)[2][2]) const {
#pragma unroll
        for (int h = 0; h < 2; ++h)
#pragma unroll
            for (int i = 0; i < 2; ++i) v[h][i] = (unsigned)(u.m0 + h * 128 + R[i]) * (unsigned)(KK * 2) + (unsigned)C2[i]; }
    __device__ __forceinline__ const char* a_base() const { return (const char*)A; }
    __device__ __forceinline__ const char* b_base(const Unit& u) const { return (const char*)(Bt + (size_t)u.n0 * KK); }
    __device__ __forceinline__ void epi(const f32x4 (&acc)[2][2][4][2], const Unit& u, int wr, int wc, int fr, int fq) const {
#pragma unroll
        for (int ai = 0; ai < 2; ++ai)
#pragma unroll
            for (int m = 0; m < 4; ++m) { const int row = u.m0 + ai * 128 + wr * 64 + m * 16 + fr;
#pragma unroll
                for (int bj = 0; bj < 2; ++bj)
#pragma unroll
                    for (int n = 0; n < 2; ++n) { const size_t o = (size_t)row * 2048 + u.n0 + bj * 128 + wc * 32 + n * 16 + fq * 4;
                        const f32x4 xv = *(const f32x4*)(X + o); *(f32x4*)(C + o) = xv * DN_ALPHA + acc[ai][bj][m][n]; } } }
};
struct ProbCmp {
    static constexpr int NT = 8; static constexpr size_t KS2 = (size_t)INW * 2;
    static constexpr bool PERM = false;
    const _Float16* A; const _Float16* Bt; float* C; int G, c;
    __device__ __forceinline__ bool next(int i, Unit& u) const { const int L = i * G + c; if (L >= 128) return false;
        u.e = L >> 6; const int r = L & 63; u.rbase = r & 3; u.n0 = ((r >> 2) & 1) * 256; u.m0 = (r >> 3) * 256; u.cnt = 256; return true; }
    __device__ __forceinline__ void a_offs(const Unit& u, const int (&R)[2], const int (&C2)[2], unsigned (&v)[2][2]) const {
#pragma unroll
        for (int h = 0; h < 2; ++h)
#pragma unroll
            for (int i = 0; i < 2; ++i) { const int row = u.m0 + h * 128 + R[i], kvh = row & 1, bj = row >> 1, b = bj >> 7, j = bj & 127;
                v[h][i] = (unsigned)((b * S_ + 16 * j + 4 * u.rbase) * INW + (u.e ? C_VC : C_KC) + kvh * 128) * 2u + (unsigned)C2[i]; } }
    __device__ __forceinline__ const char* a_base() const { return (const char*)A; }
    __device__ __forceinline__ const char* b_base(const Unit& u) const { return (const char*)(Bt + ((size_t)u.e * 512 + u.n0) * KK + u.rbase * 512); }
    __device__ __forceinline__ void epi(const f32x4 (&acc)[2][2][4][2], const Unit& u, int wr, int wc, int fr, int fq) const {
        float* base = C + ((size_t)(u.e * 4 + u.rbase) * 2048) * 512;
#pragma unroll
        for (int ai = 0; ai < 2; ++ai)
#pragma unroll
            for (int m = 0; m < 4; ++m) { const int row = u.m0 + ai * 128 + wr * 64 + m * 16 + fr;
#pragma unroll
                for (int bj = 0; bj < 2; ++bj)
#pragma unroll
                    for (int n = 0; n < 2; ++n) { const int col = u.n0 + bj * 128 + wc * 32 + n * 16 + fq * 4;
                        *(f32x4*)(base + (size_t)row * 512 + col) = acc[ai][bj][m][n]; } } }
};
struct MoeTab { const LAS int* t; int NT;
    __device__ __forceinline__ bool find(int L, Unit& u) const {
        const int total = __builtin_amdgcn_readfirstlane(t[98]); if (L >= total) return false;
        int e = 0;
        for (; e < NE - 1; ++e) { if (L < __builtin_amdgcn_readfirstlane(t[32 + e + 1])) break; }
        const int ub = __builtin_amdgcn_readfirstlane(t[32 + e]), cn = __builtin_amdgcn_readfirstlane(t[e]), rs = __builtin_amdgcn_readfirstlane(t[65 + e]);
        const int nm = (cn + 255) >> 8, v = L - ub, mt = v % nm, ntile = v / nm;
        u.e = e; u.m0 = mt * 256; u.n0 = ntile * 256; u.cnt = min(256, cn - mt * 256); u.rbase = rs; return true; } };
struct ProbGu {
    static constexpr int NT = 32; static constexpr size_t KS2 = 256;
    static constexpr bool PERM = true;
    const _Float16* A; const _Float16* Bt; _Float16* act; const float* bgu; const int* list; MoeTab tab; int G, vcu;
    __device__ __forceinline__ bool next(int i, Unit& u) const { return tab.find(i * G + vcu, u); }
    __device__ __forceinline__ void a_offs(const Unit& u, const int (&R)[2], const int (&C2)[2], unsigned (&v)[2][2]) const {
#pragma unroll
        for (int h = 0; h < 2; ++h)
#pragma unroll
            for (int i = 0; i < 2; ++i) { int r = h * 128 + R[i]; r = r < u.cnt ? r : 0; const int a = list[(size_t)u.e * T_ + u.m0 + r]; v[h][i] = (unsigned)(a >> 2) * (unsigned)(KK * 2) + (unsigned)C2[i]; } }
    __device__ __forceinline__ const char* a_base() const { return (const char*)A; }
    __device__ __forceinline__ const char* b_base(const Unit& u) const { return (const char*)(Bt + ((size_t)u.e * 4096 + u.n0) * KK); }
    __device__ __forceinline__ void epi(const f32x4 (&acc)[2][2][4][2], const Unit& u, int wr, int wc, int fr, int fq) const {
        const float* bb = bgu + (size_t)u.e * 4096;
#pragma unroll
        for (int bj = 0; bj < 2; ++bj) { const int col = u.n0 + bj * 128 + wc * 32 + fq * 8;
            const f32x4 b0 = *(const f32x4*)(bb + col), b1 = *(const f32x4*)(bb + col + 4);
#pragma unroll
            for (int ai = 0; ai < 2; ++ai)
#pragma unroll
                for (int m = 0; m < 4; ++m) { const int rl = ai * 128 + wr * 64 + m * 16 + fr;
                    if (rl < u.cnt) { const f32x4 v0 = acc[ai][bj][m][0] + b0, v1 = acc[ai][bj][m][1] + b1;
                        h4 o;
                        { const float xg = fminf(v0[0], 7.f), xl = fminf(fmaxf(v0[1], -7.f), 7.f); o[0] = (_Float16)(xg * sigmoidf_(1.702f * xg) * (xl + 1.f)); }
                        { const float xg = fminf(v0[2], 7.f), xl = fminf(fmaxf(v0[3], -7.f), 7.f); o[1] = (_Float16)(xg * sigmoidf_(1.702f * xg) * (xl + 1.f)); }
                        { const float xg = fminf(v1[0], 7.f), xl = fminf(fmaxf(v1[1], -7.f), 7.f); o[2] = (_Float16)(xg * sigmoidf_(1.702f * xg) * (xl + 1.f)); }
                        { const float xg = fminf(v1[2], 7.f), xl = fminf(fmaxf(v1[3], -7.f), 7.f); o[3] = (_Float16)(xg * sigmoidf_(1.702f * xg) * (xl + 1.f)); }
                        *(h4*)(act + (size_t)(u.rbase + u.m0 + rl) * 2048 + (col >> 1)) = o; } } } }
};
struct ProbDn {
    static constexpr int NT = 32; static constexpr size_t KS2 = 256;
    static constexpr bool PERM = true;
    const _Float16* A; const _Float16* Bt; _Float16* y; const float* bdn; const int* list; const float* gate; MoeTab tab; int G, vcu;
    __device__ __forceinline__ bool next(int i, Unit& u) const { return tab.find(i * G + vcu, u); }
    __device__ __forceinline__ void a_offs(const Unit& u, const int (&R)[2], const int (&C2)[2], unsigned (&v)[2][2]) const {
#pragma unroll
        for (int h = 0; h < 2; ++h)
#pragma unroll
            for (int i = 0; i < 2; ++i) v[h][i] = (unsigned)(u.rbase + u.m0 + h * 128 + R[i]) * (unsigned)(KK * 2) + (unsigned)C2[i]; }
    __device__ __forceinline__ const char* a_base() const { return (const char*)A; }
    __device__ __forceinline__ const char* b_base(const Unit& u) const { return (const char*)(Bt + ((size_t)u.e * 2048 + u.n0) * KK); }
    __device__ __forceinline__ void epi(const f32x4 (&acc)[2][2][4][2], const Unit& u, int wr, int wc, int fr, int fq) const {
        const float* bb = bdn + (size_t)u.e * 2048;
#pragma unroll
        for (int ai = 0; ai < 2; ++ai)
#pragma unroll
            for (int m = 0; m < 4; ++m) { const int rl = ai * 128 + wr * 64 + m * 16 + fr;
                if (rl < u.cnt) { const int a = list[(size_t)u.e * T_ + u.m0 + rl]; const float g = gate[a];
#pragma unroll
                    for (int bj = 0; bj < 2; ++bj) { const int col = u.n0 + bj * 128 + wc * 32 + fq * 8;
                        const f32x4 v0 = (acc[ai][bj][m][0] + *(const f32x4*)(bb + col)) * g, v1 = (acc[ai][bj][m][1] + *(const f32x4*)(bb + col + 4)) * g;
                        h8 o; o[0] = (_Float16)v0[0]; o[1] = (_Float16)v0[1]; o[2] = (_Float16)v0[2]; o[3] = (_Float16)v0[3]; o[4] = (_Float16)v1[0]; o[5] = (_Float16)v1[1]; o[6] = (_Float16)v1[2]; o[7] = (_Float16)v1[3];
                        *(h8*)(y + (size_t)a * 2048 + col) = o; } } } }
};
}

namespace at8 {
typedef float f32x16 __attribute__((ext_vector_type(16)));
typedef short s16x4 __attribute__((ext_vector_type(4)));
typedef unsigned u32x4 __attribute__((ext_vector_type(4)));
constexpr int SHM_V = 64 * 128 * 2, SHM_K = 64 * 128 * 2;
constexpr int LDS_WS = 2 * SHM_V + 2 * SHM_K;
constexpr int LDS_END = LDS_WS + 8 * 64 * 4;
constexpr float CEXP = ATT_SCALE * 1.4426950408889634f;
constexpr float THR_RAW = 8.f / ATT_SCALE;
#define AT_KSWZ(row, colB) ((row) * 256 + ((colB) ^ (((row) & 7) << 4)))
#define AT_SBAR() __builtin_amdgcn_sched_barrier(0)
__device__ __forceinline__ int crow(int r, int hi) { return (r & 3) + 8 * (r >> 2) + 4 * hi; }
__device__ __forceinline__ unsigned cvtpk(float lo, float hi) { auto v = __builtin_amdgcn_cvt_pkrtz(lo, hi); return *reinterpret_cast<unsigned*>(&v); }
__device__ __forceinline__ int v_st(int k, int c) { const int kk = (k & ~0xC) | ((k & 4) << 1) | ((k & 8) >> 1); return ((kk >> 3) * 4 + (c >> 5)) * 512 + ((kk & 7) * 32 + (c & 31)) * 2; }
__device__ __forceinline__ int v_rd_base(int lane) { return ((lane & 3) << 3) | (((lane >> 2) & 3) << 6) | (((lane >> 4) & 1) << 5) | (((lane >> 5) & 1) << 8); }
constexpr int v_rd_off(int d0, int ks, int half) { return d0 * 512 + ks * 4096 + half * 2048; }
template <int OFF> __device__ __forceinline__ s16x4 tr_read(int vb) { s16x4 r; asm volatile("ds_read_b64_tr_b16 %0, %1 offset:%2" : "=&v"(r) : "v"(vb), "i"(OFF) : "memory"); return r; }
__device__ __forceinline__ h8 mk8(s16x4 l, s16x4 h) { typedef short s16x8 __attribute__((ext_vector_type(8))); s16x8 w = {l[0], l[1], l[2], l[3], h[0], h[1], h[2], h[3]}; return *reinterpret_cast<h8*>(&w); }
template <int D0> __device__ __forceinline__ void pv_one(f32x16& od, int vb, h8 pa0, h8 pa1, h8 pa2, h8 pa3) {
    const s16x4 l0 = tr_read<v_rd_off(D0, 0, 0)>(vb), h0 = tr_read<v_rd_off(D0, 0, 1)>(vb), l1 = tr_read<v_rd_off(D0, 1, 0)>(vb), h1 = tr_read<v_rd_off(D0, 1, 1)>(vb);
    const s16x4 l2 = tr_read<v_rd_off(D0, 2, 0)>(vb), h2 = tr_read<v_rd_off(D0, 2, 1)>(vb), l3 = tr_read<v_rd_off(D0, 3, 0)>(vb), h3 = tr_read<v_rd_off(D0, 3, 1)>(vb);
    asm volatile("s_waitcnt lgkmcnt(0)" ::: "memory"); AT_SBAR();
    od = __builtin_amdgcn_mfma_f32_32x32x16_f16(pa0, mk8(l0, h0), od, 0, 0, 0);
    od = __builtin_amdgcn_mfma_f32_32x32x16_f16(pa1, mk8(l1, h1), od, 0, 0, 0);
    od = __builtin_amdgcn_mfma_f32_32x32x16_f16(pa2, mk8(l2, h2), od, 0, 0, 0);
    od = __builtin_amdgcn_mfma_f32_32x32x16_f16(pa3, mk8(l3, h3), od, 0, 0, 0);
}
__device__ __forceinline__ void pv_d0(f32x16 (&o)[4], int vb, h8 pa0, h8 pa1, h8 pa2, h8 pa3) {
    pv_one<0>(o[0], vb, pa0, pa1, pa2, pa3); pv_one<1>(o[1], vb, pa0, pa1, pa2, pa3); pv_one<2>(o[2], vb, pa0, pa1, pa2, pa3); pv_one<3>(o[3], vb, pa0, pa1, pa2, pa3);
}
__device__ __forceinline__ void qkt(f32x16& p0, f32x16& p1, const char* Ks, const h8 (&qr)[8], int r32, int hi) {
    p0 = f32x16{}; p1 = f32x16{};
#pragma unroll
    for (int d0 = 0; d0 < 8; ++d0) { const int cb = (d0 * 16 + hi * 8) * 2;
        const h8 b0 = *reinterpret_cast<const h8*>(Ks + AT_KSWZ(r32, cb));
        const h8 b1 = *reinterpret_cast<const h8*>(Ks + AT_KSWZ(32 + r32, cb));
        p0 = __builtin_amdgcn_mfma_f32_32x32x16_f16(b0, qr[d0], p0, 0, 0, 0);
        p1 = __builtin_amdgcn_mfma_f32_32x32x16_f16(b1, qr[d0], p1, 0, 0, 0); }
}
__device__ __forceinline__ void pack_p(const f32x16& p0, const f32x16& p1, h8& pa0, h8& pa1, h8& pa2, h8& pa3) {
#define AT_PK4(P, BASE, OUT) do { unsigned a0 = cvtpk(P[BASE + 0], P[BASE + 1]), a1 = cvtpk(P[BASE + 2], P[BASE + 3]); \
    unsigned b0 = cvtpk(P[BASE + 4], P[BASE + 5]), b1 = cvtpk(P[BASE + 6], P[BASE + 7]); \
    auto r0 = __builtin_amdgcn_permlane32_swap(a0, b0, false, false); auto r1 = __builtin_amdgcn_permlane32_swap(a1, b1, false, false); \
    u32x4 w = {r0[0], r1[0], r0[1], r1[1]}; OUT = *reinterpret_cast<h8*>(&w); } while (0)
    AT_PK4(p0, 0, pa0); AT_PK4(p0, 8, pa1); AT_PK4(p1, 0, pa2); AT_PK4(p1, 8, pa3);
#undef AT_PK4
}
__device__ __forceinline__ float half_swap_max(float v) { auto rr = __builtin_amdgcn_permlane32_swap(__float_as_uint(v), __float_as_uint(v), false, false); return fmaxf(__uint_as_float(rr[0]), __uint_as_float(rr[1])); }
__device__ __forceinline__ float half_swap_sum(float v) { auto rr = __builtin_amdgcn_permlane32_swap(__float_as_uint(v), __float_as_uint(v), false, false); return __uint_as_float(rr[0]) + __uint_as_float(rr[1]); }

struct Stage4 { h8 vs0, vs1, ks0, ks1; };
__device__ __forceinline__ int hidden_tid() { int tz = threadIdx.x; asm volatile("" : "+v"(tz)); return tz; }
__device__ __forceinline__ void sload(Stage4& s, const _Float16* Kb, const _Float16* Vb, int ld, int k0) {
    const int tz = hidden_tid(), sr = tz >> 4, sc = (tz & 15) * 8;
    s.vs0 = *(const h8*)(Vb + (size_t)(k0 + sr) * ld + sc); s.vs1 = *(const h8*)(Vb + (size_t)(k0 + 32 + sr) * ld + sc);
    s.ks0 = *(const h8*)(Kb + (size_t)(k0 + sr) * ld + sc); s.ks1 = *(const h8*)(Kb + (size_t)(k0 + 32 + sr) * ld + sc);
}
__device__ __forceinline__ void swrite(const Stage4& s, char* V_lds, char* K_lds, int b) {
    const int tz = hidden_tid(), sr = tz >> 4, sc = (tz & 15) * 8, vst0 = v_st(sr, sc), vst1 = v_st(32 + sr, sc);
    *(h8*)(V_lds + b * SHM_V + vst0) = s.vs0; *(h8*)(V_lds + b * SHM_V + vst1) = s.vs1;
    const int kc = sc * 2;
    *(h8*)(K_lds + b * SHM_K + AT_KSWZ(sr, kc)) = s.ks0; *(h8*)(K_lds + b * SHM_K + AT_KSWZ(32 + sr, kc)) = s.ks1;
}

__device__ __forceinline__ void attn_unit(char* lds, const _Float16* qrow, const _Float16* Kb, const _Float16* Vb, int ld, unsigned tmask, int klo, int khi, unsigned selmask,
                                          float* outw, int ostride) {
    const int tid = threadIdx.x, wid = __builtin_amdgcn_readfirstlane(tid >> 6), lane = tid & 63, r32 = lane & 31, hi = lane >> 5;
    char* V_lds = lds; char* K_lds = lds + 2 * SHM_V;
    float* wsf = (float*)(lds + LDS_WS) + wid * 64; float* li_l = wsf; float* al_l = wsf + 32;
    float m_reg = -1e30f, l_reg = 0.f; f32x16 o[4] = {}; h8 qr[8];
#pragma unroll
    for (int d0 = 0; d0 < 8; ++d0) qr[d0] = *(const h8*)(qrow + d0 * 16);
    const int vb0 = (int)(uintptr_t)V_lds + v_rd_base(lane);
    Stage4 st;
    unsigned rest = tmask; int j = __ffs(rest) - 1; rest &= rest - 1;
    sload(st, Kb, Vb, ld, j * 64); asm volatile("s_waitcnt vmcnt(0)" ::: "memory"); swrite(st, V_lds, K_lds, 0); __syncthreads();
    int buf = 0;
    for (;;) {
        const int jn = rest ? (__ffs(rest) - 1) : -1;
        if (jn >= 0) sload(st, Kb, Vb, ld, jn * 64);
        f32x16 p0, p1;
        AT_SBAR(); qkt(p0, p1, K_lds + buf * SHM_K, qr, r32, hi);
        { const int kb = j * 64 + 4 * hi; const bool tb = (selmask >> j) & 1u;
#pragma unroll
          for (int r = 0; r < 16; ++r) { const int k0 = kb + (r & 3) + 8 * (r >> 2);
              p0[r] = (tb && k0 >= klo && k0 <= khi) ? p0[r] : -INFINITY;
              p1[r] = (tb && (k0 + 32) >= klo && (k0 + 32) <= khi) ? p1[r] : -INFINITY; } }
        float pmax = p0[0];
#pragma unroll
        for (int r = 1; r < 16; ++r) pmax = fmaxf(pmax, p0[r]);
#pragma unroll
        for (int r = 0; r < 16; ++r) pmax = fmaxf(pmax, p1[r]);
        pmax = half_swap_max(pmax);
        float mn, alpha;
        if (__all(pmax - m_reg <= THR_RAW)) { mn = m_reg; alpha = 1.f; }
        else { mn = fmaxf(m_reg, pmax); alpha = __builtin_amdgcn_exp2f((m_reg - mn) * CEXP); m_reg = mn; }
        const float mnC = -mn * CEXP;
        float ps = 0.f;
#pragma unroll
        for (int r = 0; r < 16; ++r) { p0[r] = __builtin_amdgcn_exp2f(fmaf(p0[r], CEXP, mnC)); ps += p0[r]; }
#pragma unroll
        for (int r = 0; r < 16; ++r) { p1[r] = __builtin_amdgcn_exp2f(fmaf(p1[r], CEXP, mnC)); ps += p1[r]; }
        ps = half_swap_sum(ps);
        l_reg = l_reg * alpha + ps;
        if (__any(alpha < 1.f)) { if (hi == 0) al_l[r32] = alpha; asm volatile("s_waitcnt lgkmcnt(0)" ::: "memory");
#pragma unroll
            for (int r = 0; r < 16; ++r) { const float a = al_l[crow(r, hi)];
#pragma unroll
                for (int d = 0; d < 4; ++d) o[d][r] *= a; } }
        h8 pa0, pa1, pa2, pa3; pack_p(p0, p1, pa0, pa1, pa2, pa3);
        AT_SBAR();
        pv_d0(o, vb0 + buf * SHM_V, pa0, pa1, pa2, pa3);
        if (jn < 0) break;
        asm volatile("s_waitcnt vmcnt(0)" ::: "memory");
        swrite(st, V_lds, K_lds, buf ^ 1);
        __syncthreads();
        buf ^= 1; j = jn; rest &= rest - 1;
    }
    if (hi == 0) li_l[r32] = l_reg; asm volatile("s_waitcnt lgkmcnt(0)" ::: "memory");
#pragma unroll
    for (int r = 0; r < 16; ++r) { const int orow = crow(r, hi); const float l = li_l[orow]; const float rl = l > 0.f ? 1.f / l : 0.f;
#pragma unroll
        for (int d0 = 0; d0 < 4; ++d0) outw[(size_t)orow * ostride + d0 * 32 + r32] = o[d0][r] * rl; }
    __syncthreads();
}

constexpr int LDS_AP = LDS_END, LDS_BP = LDS_AP + 4 * 64 * 33 * 4, LDS_SELM = LDS_BP + 4 * 64 * 33 * 4, LDS_CS_END = LDS_SELM + 64 * 4;
__device__ __forceinline__ void cmp_slc_unit(char* lds, const _Float16* qrow, const _Float16* Kc, const _Float16* Vc, const _Float16* Ks, const _Float16* Vs, int t, int tl, int g, int qi,
                                             float* outc, float* outs) {
    const int tid = threadIdx.x, wid = __builtin_amdgcn_readfirstlane(tid >> 6), lane = tid & 63, r32 = lane & 31, hi = lane >> 5;
    char* V_lds = lds; char* K_lds = lds + 2 * SHM_V;
    float* AP = (float*)(lds + LDS_AP); float* BP = (float*)(lds + LDS_BP); unsigned* selm = (unsigned*)(lds + LDS_SELM);
    {
        h8 qr[8];
#pragma unroll
        for (int d0 = 0; d0 < 8; ++d0) qr[d0] = *(const h8*)(qrow + d0 * 16);
        const int vb0 = (int)(uintptr_t)V_lds + v_rd_base(lane);
        { Stage4 s0, s1; sload(s0, Kc, Vc, 256, 0); sload(s1, Kc, Vc, 256, 64);
          asm volatile("s_waitcnt vmcnt(0)" ::: "memory");
          swrite(s0, V_lds, K_lds, 0); swrite(s1, V_lds, K_lds, 1); }
        __syncthreads();
        f32x16 pA0, pA1, pB0, pB1;
        AT_SBAR(); qkt(pA0, pA1, K_lds, qr, r32, hi); qkt(pB0, pB1, K_lds + SHM_K, qr, r32, hi);
        const int khi = t >= 31 ? ((t - 31) >> 4) : -1;
#pragma unroll
        for (int r = 0; r < 16; ++r) { const int c0 = 4 * hi + (r & 3) + 8 * (r >> 2);
            pA0[r] = (c0 <= khi) ? pA0[r] : -INFINITY; pA1[r] = (c0 + 32 <= khi) ? pA1[r] : -INFINITY;
            pB0[r] = (c0 + 64 <= khi) ? pB0[r] : -INFINITY; pB1[r] = (c0 + 96 <= khi) ? pB1[r] : -INFINITY; }
        float pmax = -INFINITY;
#pragma unroll
        for (int r = 0; r < 16; ++r) pmax = fmaxf(fmaxf(pmax, pA0[r]), fmaxf(pA1[r], fmaxf(pB0[r], pB1[r])));
        pmax = half_swap_max(pmax);
        const float mC = (pmax == -INFINITY) ? 0.f : -pmax * CEXP;
        float ps = 0.f;
#pragma unroll
        for (int r = 0; r < 16; ++r) { pA0[r] = __builtin_amdgcn_exp2f(fmaf(pA0[r], CEXP, mC)); pA1[r] = __builtin_amdgcn_exp2f(fmaf(pA1[r], CEXP, mC));
            pB0[r] = __builtin_amdgcn_exp2f(fmaf(pB0[r], CEXP, mC)); pB1[r] = __builtin_amdgcn_exp2f(fmaf(pB1[r], CEXP, mC)); ps += (pA0[r] + pA1[r]) + (pB0[r] + pB1[r]); }
        ps = half_swap_sum(ps);
        const float inv = ps > 0.f ? 1.f / ps : 0.f;
#pragma unroll
        for (int r = 0; r < 16; ++r) { pA0[r] *= inv; pA1[r] *= inv; pB0[r] *= inv; pB1[r] *= inv; }
        { float* ap = AP + (g * 64 + tl) * 33; float* bp = BP + (g * 64 + tl) * 33;
          if (hi == 0) bp[0] = 0.f;
#define AT_IMP(P, JB) do { _Pragma("unroll") for (int k = 0; k < 4; ++k) { const int j = (JB) + 2 * k + hi; \
              ap[j] = 2.f * (P[4 * k] + P[4 * k + 1] + P[4 * k + 2]) + P[4 * k + 3]; if (j + 1 < 32) bp[j + 1] = P[4 * k + 3]; } } while (0)
          AT_IMP(pA0, 0); AT_IMP(pA1, 8); AT_IMP(pB0, 16); AT_IMP(pB1, 24);
#undef AT_IMP
        }
        f32x16 o[4] = {};
        h8 pa0, pa1, pa2, pa3;
        pack_p(pA0, pA1, pa0, pa1, pa2, pa3); AT_SBAR(); pv_d0(o, vb0, pa0, pa1, pa2, pa3);
        pack_p(pB0, pB1, pa0, pa1, pa2, pa3); AT_SBAR(); pv_d0(o, vb0 + SHM_V, pa0, pa1, pa2, pa3);
#pragma unroll
        for (int r = 0; r < 16; ++r) { const int orow = crow(r, hi);
#pragma unroll
            for (int d0 = 0; d0 < 4; ++d0) outc[(size_t)orow * 1024 + d0 * 32 + r32] = o[d0][r]; }
    }
    __syncthreads();
#pragma unroll 1
    for (int it = 0; it < 4; ++it) {
        const int tk = 8 * wid + 2 * it + hi, j = r32;
        float imp = 0.f;
#pragma unroll
        for (int gg = 0; gg < 4; ++gg) imp += AP[(gg * 64 + tk) * 33 + j] + BP[(gg * 64 + tk) * 33 + j];
        const bool forced = (j == 0) || (j == qi) || (j == qi - 1), valid = j <= qi;
        const float iv = forced ? 1e9f : (valid ? imp : -1e9f);
        int rank = 0;
        for (int i = 0; i < 32; ++i) { const float vi = __shfl(iv, i + 32 * hi); rank += (vi > iv || (vi == iv && i < j)) ? 1 : 0; }
        const unsigned long long bal = __ballot(rank < 16 && valid);
        if (r32 == 0) selm[tk] = (unsigned)(bal >> (32 * hi));
    }
    __syncthreads();
    unsigned tm = selm[lane];
#pragma unroll
    for (int o = 32; o > 0; o >>= 1) tm |= __shfl_xor(tm, o);
    const int tz2 = hidden_tid();
    const unsigned mysel = selm[((tz2 >> 6) & 1) * 32 + (tz2 & 31)];
    attn_unit(lds, qrow, Ks, Vs, INW, tm, 0, t, mysel, outs, 1024);
}
}

__device__ __forceinline__ void conv_tile(float* lds, const float* __restrict__ W, int ldw, int nvalid, _Float16* __restrict__ Wt, int K, int k0, int n0) {
    const int tid = threadIdx.x;
    float4 v[8];
#pragma unroll
    for (int i = 0; i < 8; ++i) { const int idx = tid + 512 * i, r = idx >> 6, c4 = (idx & 63) * 4;
        v[i] = (n0 + c4 < nvalid) ? *(const float4*)(W + (size_t)(k0 + r) * ldw + n0 + c4) : make_float4(0.f, 0.f, 0.f, 0.f); }
#pragma unroll
    for (int i = 0; i < 8; ++i) { const int idx = tid + 512 * i, r = idx >> 6, c4 = (idx & 63) * 4; float* d = lds + r * 257 + c4; d[0] = v[i].x; d[1] = v[i].y; d[2] = v[i].z; d[3] = v[i].w; }
    __syncthreads();
#pragma unroll
    for (int j = 0; j < 4; ++j) { const int id = tid + 512 * j, n = id >> 3, k8 = (id & 7) * 8; h8 o;
#pragma unroll
        for (int q = 0; q < 8; ++q) o[q] = (_Float16)lds[(k8 + q) * 257 + n];
        *(h8*)(Wt + (size_t)(n0 + n) * K + k0 + k8) = o; }
    __syncthreads();
}

__global__ void __launch_bounds__(512, 2) fwd(Params p) {
    extern __shared__ __attribute__((aligned(16))) char smem[];
    const int tid = threadIdx.x, lane = tid & 63, wv = __builtin_amdgcn_readfirstlane(tid >> 6);
    const int bid = blockIdx.x, nb = gridDim.x;
    const int gw = bid * 8 + wv, nw = nb * 8;
    const int lo = (int)(p.lo_hi & 0xffffffffll), hi = (int)(p.lo_hi >> 32);
    unsigned char* ws = p.ws;
    unsigned* ctl = (unsigned*)(ws + WS_CTL);
    int* cnt = (int*)(ws + CTL_CNT);
    float* proj = (float*)(ws + WS_PROJ);
    float* kvmem = (float*)(ws + WS_KVMEM);
    float* bias1 = (float*)(ws + WS_BIAS1);
    float* hid = (float*)(ws + WS_HID);
    float* kc = (float*)(ws + WS_KC);
    float* vc = (float*)(ws + WS_VC);
    float* pooled = (float*)(ws + WS_POOLED);
    float* opool = (float*)(ws + WS_OPOOL);
    float* owin = (float*)(ws + WS_OWIN);
    float* ocmp = (float*)(ws + WS_OCMP);
    float* oslc = (float*)(ws + WS_OSLC);
    unsigned* sel = (unsigned*)(ws + WS_SEL);
    float* omem = (float*)(ws + WS_OMEM);
    _Float16* cat16 = (_Float16*)(ws + WS_CAT16);
    float* hpre = (float*)(ws + WS_HPRE);
    float* hbuf = (float*)(ws + WS_H);
    float* gate = (float*)(ws + WS_GATE);
    int* list = (int*)(ws + WS_LIST);
    _Float16* act16 = (_Float16*)(ws + WS_ACT16);
    _Float16* y16 = (_Float16*)(ws + WS_Y16);
    _Float16* h16 = (_Float16*)(ws + WS_H16);
    _Float16* x16 = (_Float16*)(ws + WS_X16);
    _Float16* wtin = (_Float16*)(ws + WS_WTIN);
    _Float16* wtout = (_Float16*)(ws + WS_WTOUT);
    _Float16* wtgu = (_Float16*)(ws + WS_WTGU);
    _Float16* wtdn = (_Float16*)(ws + WS_WTDN);
    LAS unsigned char* lds = (LAS unsigned char*)smem;
    _Float16* proj16 = (_Float16*)(ws + WS_PROJ16);
    _Float16* kvmem16 = (_Float16*)(ws + WS_KVMEM16);
    _Float16* wt1 = (_Float16*)(ws + WS_WT1);
    float* uv = (float*)(ws + WS_UV);
    _Float16* kc16 = (_Float16*)(ws + WS_KC16);
    _Float16* vc16 = (_Float16*)(ws + WS_VC16);
    _Float16* wr16 = (_Float16*)(ws + WS_WR16);
    const int vcu = (nb % 8 == 0) ? (bid % 8) * (nb / 8) + bid / 8 : bid;

    volatile LAS unsigned* xbw = (volatile LAS unsigned*)(smem + LDS_BYTES - 16);
    if (tid == 0) { xbw[0] = 0u; xbw[1] = 0u; xbw[2] = 0u; xbw[3] = 0u; }
    __syncthreads();
    XcdBarrier bar; bar.bar = ctl; bar.x = 0; bar.st = xbw;
    const bool multi = (hi - lo) > 1;
    if (multi) bar = xcd_barrier_post(ctl, xbw);
#define IN(k) (lo <= (k) && (k) < hi)
#define SEAM(k) do { if (IN(k) && IN((k) + 1)) xcd_barrier(bar); } while (0)
    float* sw = (float*)smem + wv * WLDS_FLOATS;
    int* segw = (int*)(sw + 4096 + 512);

    if (IN(0)) {
        for (int j = gw; j < 512; j += nw) {
            const int kv = j >> 8, jj = j & 255;
            const float* pos = p.in[kv ? I_POSV : I_POSK]; const float* w1 = p.in[kv ? I_W1V : I_W1K];
            float s = 0.f;
            for (int k = lane; k < 4096; k += 64) s += pos[k] * w1[(size_t)k * 256 + jj];
            s = wave_sum(s);
            if (lane == 0) bias1[j] = s;
        }
        for (int i = bid * 512 + tid; i < 32 * 2048; i += nb * 512) { const int e = i >> 11, d = i & 2047; wr16[i] = (_Float16)p.in[I_WR][(size_t)d * 32 + e]; }
        for (size_t i = (size_t)bid * 512 + tid; i < (size_t)T_ * 2048 / 4; i += (size_t)nb * 512) {
            const float4 v = ((const float4*)p.in[I_X])[i]; ((h4*)x16)[i] = (h4){(_Float16)v.x, (_Float16)v.y, (_Float16)v.z, (_Float16)v.w};
        }
        {
            constexpr int U_GU = NE * 32 * 16, U_DN = NE * 32 * 8, U_IN = 32 * 15, U_OUT = 32 * 8, U_W1 = 128;
            for (int u = bid; u < U_GU + U_DN + U_IN + U_OUT + U_W1; u += nb) {
                if (u < U_GU) { const int e = u / 512, r = u % 512, kt = r / 16, ntl = r % 16;
                    conv_tile((float*)smem, p.in[I_WGU] + (size_t)e * 2048 * 4096, 4096, 4096, wtgu + (size_t)e * 4096 * 2048, 2048, kt * 64, ntl * 256);
                } else if (u < U_GU + U_DN) { const int v = u - U_GU, e = v / 256, r = v % 256, kt = r / 8, ntl = r % 8;
                    conv_tile((float*)smem, p.in[I_WDN] + (size_t)e * 2048 * 2048, 2048, 2048, wtdn + (size_t)e * 2048 * 2048, 2048, kt * 64, ntl * 256);
                } else if (u < U_GU + U_DN + U_IN) { const int v = u - U_GU - U_DN, kt = v / 15, ntl = v % 15;
                    conv_tile((float*)smem, p.in[I_WIN], INW, INW, wtin, 2048, kt * 64, ntl * 256);
                } else if (u < U_GU + U_DN + U_IN + U_OUT) { const int v = u - U_GU - U_DN - U_IN, kt = v / 8, ntl = v % 8;
                    conv_tile((float*)smem, p.in[I_WOUT], 2048, 2048, wtout, 2048, kt * 64, ntl * 256);
                } else { const int v = u - U_GU - U_DN - U_IN - U_OUT, kv = v >> 6, part = (v >> 5) & 1, kt = v & 31;
                    conv_tile((float*)smem, p.in[kv ? I_W1V : I_W1K] + (size_t)part * 2048 * 256, 256, 256, wt1 + ((size_t)kv * 512 + part * 256) * 2048, 2048, kt * 64, 0);
                }
            }
        }
        for (int u = bid; u < 16 * 8; u += nb) { const int nt = u / 16, mt = u % 16;
            ARowPlain af{p.in[I_MEM], 2048, mt * 128, 2048}; EpiStore ef{kvmem, 1024, mt * 128, nt * 128, 2048, 1024, kvmem16};
            gemm_tile(smem, 2048, af, p.in[I_WMEMKV], 1024, nt * 128, 1024, false, ef);
        }
    }
    SEAM(0);
    if (IN(1)) {
        g8::ProbIn P{x16, wtin, proj16, nb, bid};
        g8::gemm_phase(lds, P);
    }
    SEAM(1);
    if (IN(2)) {
        { g8::ProbCmp P{proj16, wt1, uv, nb, bid}; g8::gemm_phase(lds, P); __syncthreads(); }
        for (size_t i = (size_t)bid * 512 + tid; i < (size_t)T_ * 512; i += (size_t)nb * 512) {
            const int col = (int)(i & 511), row = (int)(i >> 9), t = row & (S_ - 1), g = col >> 7;
            const int win = 2 << g; const int lo_t = max(t + 1 - win, 0); const int n = t + 1 - lo_t;
            float s = 0.f;
            for (int k = 0; k < n; ++k) s += (float)proj16[(size_t)(row - k) * INW + C_UP + col];
            pooled[i] = s / (float)n - (float)proj16[(size_t)row * INW + C_UP + col];
        }
        {
            const int r32 = lane & 31, hi = lane >> 5, g = wv >> 1, half = wv & 1;
            for (int uu = bid; uu < 512; uu += nb) {
                const int u = (uu & 1) ? (511 - (uu >> 1)) : (uu >> 1);
                const int bk = u >> 5, qi = u & 31, b = bk >> 1, kvh = bk & 1;
                const int t = qi * 64 + half * 32 + r32;
                const int lo_t = max(0, qi - 8);
                const unsigned tmask = (unsigned)(((1ull << (qi + 1)) - 1ull) & ~((1ull << lo_t) - 1ull));
                at8::attn_unit(smem, proj16 + (size_t)(b * S_ + t) * INW + C_Q + (kvh * 4 + g) * 128 + hi * 8,
                               proj16 + (size_t)b * S_ * INW + C_KW + kvh * 128, proj16 + (size_t)b * S_ * INW + C_VW + kvh * 128, INW, tmask, t - 511, t, 0xffffffffu,
                               owin + (size_t)(b * S_ + qi * 64 + half * 32) * 1024 + (kvh * 4 + g) * 128, 1024);
            }
            for (int u = bid; u < 256; u += nb) {
                const int b = u >> 5, h = (u >> 3) & 3, qt = u & 7;
                const int t = qt * 256 + wv * 32 + r32;
                at8::attn_unit(smem, proj16 + (size_t)(b * S_ + t) * INW + C_QM + h * 128 + hi * 8,
                               kvmem16 + (size_t)b * 256 * 1024 + h * 128, kvmem16 + (size_t)b * 256 * 1024 + 512 + h * 128, 1024, 0xFu, 0, 255, 0xffffffffu,
                               omem + (size_t)(b * S_ + qt * 256 + wv * 32) * 512 + h * 128, 512);
            }
        }
    }
    SEAM(2);
    if (IN(3)) {
        {   float* hs = (float*)smem;
            for (int u = bid; u < 508; u += nb) {
                const int kv = u / 254, ub = u % 254;
                const float* w2 = p.in[kv ? I_W2V : I_W2K]; _Float16* dst = kv ? vc16 : kc16;
                __syncthreads();
#pragma unroll
                for (int q = 0; q < 4; ++q) { const int e = tid + 512 * q, i = e >> 8, n = e & 255;
                    const int idx = ub * 8 + i, b = idx / 254, rem = idx % 254, c = rem >> 1, kvh = rem & 1;
                    const int row = (b * 128 + c) * 2 + kvh;
                    float a = bias1[kv * 256 + n];
#pragma unroll
                    for (int sp = 0; sp < 4; ++sp) { const float* base = uv + ((size_t)(kv * 4 + sp) * 2048) * 512; a += base[(size_t)row * 512 + n] + base[(size_t)(row + 2) * 512 + 256 + n]; }
                    hs[i * 256 + n] = gelu_tanh(a); }
                __syncthreads();
#pragma unroll
                for (int q = 0; q < 2; ++q) { const int e = tid + 512 * q, i = e >> 7, d = e & 127;
                    const int idx = ub * 8 + i, b = idx / 254, rem = idx % 254, c = rem >> 1, kvh = rem & 1;
                    float a = 0.f;
                    for (int n = 0; n < 256; ++n) a += hs[i * 256 + n] * w2[n * 128 + d];
                    dst[(size_t)((b * 128 + c) * 2 + kvh) * 128 + d] = (_Float16)a; }
            }
            __syncthreads();
            for (int i = bid * 512 + tid; i < 2 * B_ * 256; i += nb * 512) { const int kv = i / (B_ * 256), r = i % (B_ * 256), b = r >> 8, x = r & 255;
                (kv ? vc16 : kc16)[(size_t)(b * 128 + 127) * 256 + x] = (_Float16)0.f; }
        }
        for (int u = bid; u < 128 * 4; u += nb) { const int g = u >> 7, mt = u & 127;
            ARowPlain af{pooled + g * 128, 512, mt * 128, T_}; EpiPool ef{opool, p.in[I_POOLS], mt * 128, g};
            gemm_tile(smem, 128, af, p.in[I_POOLW] + (size_t)g * 128 * 128, 128, 0, 128, false, ef);
        }
    }
    SEAM(3);
    if (IN(4)) {
        const int r32 = lane & 31, hi = lane >> 5, g = wv >> 1, half = wv & 1;
        for (int uu = bid; uu < 512; uu += nb) {
            const int u = (uu & 1) ? (511 - (uu >> 1)) : (uu >> 1);
            const int bk = u >> 5, qi = u & 31, b = bk >> 1, kvh = bk & 1;
            const int tl = half * 32 + r32, t = qi * 64 + tl;
            at8::cmp_slc_unit(smem, proj16 + (size_t)(b * S_ + t) * INW + C_Q + (kvh * 4 + g) * 128 + hi * 8,
                              kc16 + (size_t)(b * 128 * 2 + kvh) * 128, vc16 + (size_t)(b * 128 * 2 + kvh) * 128,
                              proj16 + (size_t)b * S_ * INW + C_KS + kvh * 128, proj16 + (size_t)b * S_ * INW + C_VS + kvh * 128, t, tl, g, qi,
                              ocmp + (size_t)(b * S_ + qi * 64 + half * 32) * 1024 + (kvh * 4 + g) * 128, oslc + (size_t)(b * S_ + qi * 64 + half * 32) * 1024 + (kvh * 4 + g) * 128);
        }
    }
    SEAM(4);
    if (IN(5)) {
        for (int row = gw; row < T_; row += nw) {
            const _Float16* pr = proj16 + (size_t)row * INW;
            float v[16]; float ss = 0.f;
#pragma unroll
            for (int i = 0; i < 16; ++i) { const int col = lane + 64 * i, h = col >> 7; const size_t o = (size_t)row * 1024 + col;
                const float g0 = sigmoidf_((float)pr[C_G + h * 3]), g1 = sigmoidf_((float)pr[C_G + h * 3 + 1]), g2 = sigmoidf_((float)pr[C_G + h * 3 + 2]);
                v[i] = g0 * ocmp[o] + g1 * oslc[o] + g2 * owin[o]; ss += v[i] * v[i]; }
            ss = wave_sum(ss); float r = rsqrtf(ss / 1024.f + LN_EPS);
#pragma unroll
            for (int i = 0; i < 16; ++i) { const int col = lane + 64 * i; cat16[(size_t)row * 2048 + col] = (_Float16)(v[i] * r * p.in[I_GNNSA][col]); }
            ss = 0.f;
#pragma unroll
            for (int i = 0; i < 8; ++i) { v[i] = opool[(size_t)row * 512 + lane + 64 * i]; ss += v[i] * v[i]; }
            ss = wave_sum(ss); r = rsqrtf(ss / 512.f + LN_EPS);
#pragma unroll
            for (int i = 0; i < 8; ++i) { const int col = lane + 64 * i; cat16[(size_t)row * 2048 + 1024 + col] = (_Float16)(v[i] * r * p.in[I_GNPOOL][col]); }
            ss = 0.f;
#pragma unroll
            for (int i = 0; i < 8; ++i) { v[i] = omem[(size_t)row * 512 + lane + 64 * i]; ss += v[i] * v[i]; }
            ss = wave_sum(ss); r = rsqrtf(ss / 512.f + LN_EPS);
#pragma unroll
            for (int i = 0; i < 8; ++i) { const int col = lane + 64 * i; cat16[(size_t)row * 2048 + 1536 + col] = (_Float16)(v[i] * r * p.in[I_GNMEM][col]); }
        }
    }
    SEAM(5);
    if (IN(6)) {
        g8::ProbOut P{cat16, wtout, hpre, p.in[I_X], nb, bid};
        g8::gemm_phase(lds, P);
    }
    SEAM(6);
    if (IN(7)) {
        float* lg = (float*)smem;
        const int r32 = lane & 31, hi = lane >> 5, fr = lane & 15, fq = lane >> 4;
        for (int u = bid; u < T_ / 64; u += nb) {
            const int base = u * 64;
#pragma unroll 1
            for (int i = 0; i < 8; ++i) {
                const int row = base + wv * 8 + i;
                float v[32]; float s = 0.f;
#pragma unroll
                for (int c = 0; c < 4; ++c) { const int col = (lane + 64 * c) * 8;
                    const float4 a0 = *(const float4*)(hpre + (size_t)row * 2048 + col), a1 = *(const float4*)(hpre + (size_t)row * 2048 + col + 4);
                    v[c * 8 + 0] = a0.x; v[c * 8 + 1] = a0.y; v[c * 8 + 2] = a0.z; v[c * 8 + 3] = a0.w; v[c * 8 + 4] = a1.x; v[c * 8 + 5] = a1.y; v[c * 8 + 6] = a1.z; v[c * 8 + 7] = a1.w;
                    s += ((a0.x + a0.y) + (a0.z + a0.w)) + ((a1.x + a1.y) + (a1.z + a1.w)); }
                const float mu = wave_sum(s) / 2048.f; float q2 = 0.f;
#pragma unroll
                for (int k = 0; k < 32; ++k) { const float d = v[k] - mu; q2 += d * d; }
                const float rs = rsqrtf(wave_sum(q2) / 2048.f + LN_EPS);
#pragma unroll
                for (int c = 0; c < 4; ++c) { const int col = (lane + 64 * c) * 8;
                    const float4 g0 = *(const float4*)(p.in[I_LN1G] + col), g1 = *(const float4*)(p.in[I_LN1G] + col + 4), b0 = *(const float4*)(p.in[I_LN1B] + col), b1 = *(const float4*)(p.in[I_LN1B] + col + 4);
                    float4 o0, o1;
                    o0.x = (v[c * 8 + 0] - mu) * rs * g0.x + b0.x; o0.y = (v[c * 8 + 1] - mu) * rs * g0.y + b0.y; o0.z = (v[c * 8 + 2] - mu) * rs * g0.z + b0.z; o0.w = (v[c * 8 + 3] - mu) * rs * g0.w + b0.w;
                    o1.x = (v[c * 8 + 4] - mu) * rs * g1.x + b1.x; o1.y = (v[c * 8 + 5] - mu) * rs * g1.y + b1.y; o1.z = (v[c * 8 + 6] - mu) * rs * g1.z + b1.z; o1.w = (v[c * 8 + 7] - mu) * rs * g1.w + b1.w;
                    *(float4*)(hbuf + (size_t)row * 2048 + col) = o0; *(float4*)(hbuf + (size_t)row * 2048 + col + 4) = o1;
                    h8 oh; oh[0] = (_Float16)o0.x; oh[1] = (_Float16)o0.y; oh[2] = (_Float16)o0.z; oh[3] = (_Float16)o0.w; oh[4] = (_Float16)o1.x; oh[5] = (_Float16)o1.y; oh[6] = (_Float16)o1.z; oh[7] = (_Float16)o1.w;
                    *(h8*)(h16 + (size_t)row * 2048 + col) = oh; }
            }
            asm volatile("s_waitcnt vmcnt(0)" ::: "memory");
            __syncthreads();
            {
                const int tok0 = base + 16 * (wv >> 1), e0 = 16 * (wv & 1);
                const _Float16* ap = h16 + (size_t)(tok0 + fr) * 2048 + fq * 8; const _Float16* bp = wr16 + (size_t)(e0 + fr) * 2048 + fq * 8;
                f4 acc = (f4){0.f, 0.f, 0.f, 0.f};
#pragma unroll 8
                for (int sI = 0; sI < 64; ++sI) { const h8 a = *(const h8*)(ap + sI * 32), bb = *(const h8*)(bp + sI * 32); acc = __builtin_amdgcn_mfma_f32_16x16x32_f16(a, bb, acc, 0, 0, 0); }
                const float br = p.in[I_BR][e0 + fr];
#pragma unroll
                for (int j = 0; j < 4; ++j) lg[(16 * (wv >> 1) + 4 * fq + j) * 33 + e0 + fr] = acc[j] + br;
            }
            __syncthreads();
#pragma unroll 1
            for (int it = 0; it < 4; ++it) {
                const int tk = 8 * wv + 2 * it + hi;
                const float iv = lg[tk * 33 + r32];
                int rank = 0;
                for (int i = 0; i < 32; ++i) { const float vi = __shfl(iv, i + 32 * hi); rank += (vi > iv || (vi == iv && i < r32)) ? 1 : 0; }
                float tv[4]; int te[4];
#pragma unroll
                for (int r = 0; r < 4; ++r) { const unsigned long long bm = __ballot(rank == r); const unsigned hm = (unsigned)(bm >> (32 * hi)); const int src = __ffs(hm) - 1; te[r] = src; tv[r] = __shfl(iv, src + 32 * hi); }
                const float e0v = 1.f, e1v = expf(tv[1] - tv[0]), e2v = expf(tv[2] - tv[0]), e3v = expf(tv[3] - tv[0]); const float inv = 1.f / (e0v + e1v + e2v + e3v);
                if (r32 < 4) { const int e = r32 == 0 ? te[0] : r32 == 1 ? te[1] : r32 == 2 ? te[2] : te[3]; const float g = (r32 == 0 ? e0v : r32 == 1 ? e1v : r32 == 2 ? e2v : e3v) * inv;
                    const int a = (base + tk) * 4 + r32; const int pos = atomicAdd(&cnt[e], 1); list[(size_t)e * T_ + pos] = a; gate[a] = g; }
            }
            __syncthreads();
        }
    }
    SEAM(7);
    LAS int* mtab = (LAS int*)(smem + g8::STAGE_BYTES);
    if (IN(8)) {
        if (tid == 0) { int ub = 0, rs = 0;
            for (int e = 0; e < NE; ++e) { const int c = (int)__hip_atomic_load((unsigned*)&cnt[e], __ATOMIC_RELAXED, __HIP_MEMORY_SCOPE_AGENT); mtab[e] = c; mtab[32 + e] = ub; mtab[65 + e] = rs; ub += ((c + 255) >> 8) * 16; rs += c; }
            mtab[64] = ub; mtab[97] = rs; mtab[98] = ub; }
        __syncthreads();
        g8::ProbGu P{h16, wtgu, act16, p.in[I_BGU], list, g8::MoeTab{mtab, 16}, nb, vcu};
        g8::gemm_phase(lds, P);
        __syncthreads();
    }
    SEAM(8);
    if (IN(9)) {
        if (tid == 0) { int ub = 0, rs = 0;
            for (int e = 0; e < NE; ++e) { const int c = (int)__hip_atomic_load((unsigned*)&cnt[e], __ATOMIC_RELAXED, __HIP_MEMORY_SCOPE_AGENT); mtab[e] = c; mtab[32 + e] = ub; mtab[65 + e] = rs; ub += ((c + 255) >> 8) * 8; rs += c; }
            mtab[64] = ub; mtab[97] = rs; mtab[98] = ub; }
        __syncthreads();
        g8::ProbDn P{act16, wtdn, y16, p.in[I_BDN], list, gate, g8::MoeTab{mtab, 8}, nb, vcu};
        g8::gemm_phase(lds, P);
        __syncthreads();
    }
    SEAM(9);
    if (IN(10)) {
        for (int row = gw; row < T_; row += nw) {
            float v[32]; float s = 0.f;
#pragma unroll
            for (int c = 0; c < 4; ++c) { const int col = (lane + 64 * c) * 8; const size_t yo = (size_t)row * 4 * 2048 + col;
                const float4 ha = *(const float4*)(hbuf + (size_t)row * 2048 + col), hb = *(const float4*)(hbuf + (size_t)row * 2048 + col + 4);
                const h8 y0 = *(const h8*)(y16 + yo), y1 = *(const h8*)(y16 + yo + 2048), y2 = *(const h8*)(y16 + yo + 4096), y3 = *(const h8*)(y16 + yo + 6144);
                const float hh[8] = {ha.x, ha.y, ha.z, ha.w, hb.x, hb.y, hb.z, hb.w};
#pragma unroll
                for (int q = 0; q < 8; ++q) { v[c * 8 + q] = DN_ALPHA * hh[q] + (((float)y0[q] + (float)y1[q]) + ((float)y2[q] + (float)y3[q])); s += v[c * 8 + q]; } }
            const float mu = wave_sum(s) / 2048.f; float q2 = 0.f;
#pragma unroll
            for (int i = 0; i < 32; ++i) { const float d = v[i] - mu; q2 += d * d; }
            const float rs = rsqrtf(wave_sum(q2) / 2048.f + LN_EPS);
#pragma unroll
            for (int c = 0; c < 4; ++c) { const int col = (lane + 64 * c) * 8;
                const float4 ga = *(const float4*)(p.in[I_LN2G] + col), gb = *(const float4*)(p.in[I_LN2G] + col + 4), ba = *(const float4*)(p.in[I_LN2B] + col), bb = *(const float4*)(p.in[I_LN2B] + col + 4);
                float4 o0, o1;
                o0.x = (v[c * 8 + 0] - mu) * rs * ga.x + ba.x; o0.y = (v[c * 8 + 1] - mu) * rs * ga.y + ba.y; o0.z = (v[c * 8 + 2] - mu) * rs * ga.z + ba.z; o0.w = (v[c * 8 + 3] - mu) * rs * ga.w + ba.w;
                o1.x = (v[c * 8 + 4] - mu) * rs * gb.x + bb.x; o1.y = (v[c * 8 + 5] - mu) * rs * gb.y + bb.y; o1.z = (v[c * 8 + 6] - mu) * rs * gb.z + bb.z; o1.w = (v[c * 8 + 7] - mu) * rs * gb.w + bb.w;
                *(float4*)(p.out + (size_t)row * 2048 + col) = o0; *(float4*)(p.out + (size_t)row * 2048 + col + 4) = o1; }
        }
    }
}

constexpr int NPHASE = 11;

extern "C" void kernel_launch(void* const* d_in, const int* in_sizes, int n_in, void* d_out, int out_size, void* d_ws, size_t ws_size, hipStream_t stream) {
    static int grid = 0;
    if (grid == 0) {
        if (n_in != 26 || ws_size < WS_END) { fprintf(stderr, "kernel_launch: unexpected n_in %d or ws_size %zu (< %zu)\n", n_in, ws_size, (size_t)WS_END); grid = -1; return; }
        int dev = 0, cus = 0, per_cu = 0;
        hipGetDevice(&dev); hipDeviceGetAttribute(&cus, hipDeviceAttributeMultiprocessorCount, dev);
        if (hipFuncSetAttribute((const void*)fwd, hipFuncAttributeMaxDynamicSharedMemorySize, LDS_BYTES) != hipSuccess) { fprintf(stderr, "hipFuncSetAttribute failed\n"); grid = -1; return; }
        hipOccupancyMaxActiveBlocksPerMultiprocessor(&per_cu, (const void*)fwd, 512, LDS_BYTES);
        (void)hipGetLastError();
        if (per_cu < 1) fprintf(stderr, "occupancy query says %d blocks per CU\n", per_cu);
        grid = cus > 0 ? cus : 256;
    }
    if (grid < 0) return;
    hipMemsetAsync((char*)d_ws + WS_CTL, 0, CTL_BYTES, stream);
    Params p{};
    for (int i = 0; i < 26; ++i) p.in[i] = (const float*)d_in[i];
    p.out = (float*)d_out; p.ws = (unsigned char*)d_ws;
#if N_LAUNCH_MODE == 1
    p.lo_hi = (long long)0 | ((long long)NPHASE << 32);
    hipLaunchKernelGGL(fwd, dim3(grid), dim3(512), LDS_BYTES, stream, p);
#else
    for (int ph = 0; ph < NPHASE; ++ph) {
        p.lo_hi = (long long)ph | ((long long)(ph + 1) << 32);
        hipLaunchKernelGGL(fwd, dim3(grid), dim3(512), LDS_BYTES, stream, p);
    }
#endif
}
```

```cpp
#include <hip/hip_runtime.h>
#include <cstdio>
#include <cstdint>

#ifndef N_LAUNCH_MODE
#define N_LAUNCH_MODE 1
#endif

constexpr int B_ = 8, S_ = 2048, D_ = 2048, T_ = B_ * S_;
constexpr int INW = 3608;
constexpr int C_Q = 0, C_KC = 1024, C_VC = 1280, C_KS = 1536, C_VS = 1792, C_KW = 2048, C_VW = 2304, C_G = 2560, C_UP = 2584, C_QM = 3096;
constexpr int NC = 127;
constexpr int CROWS = B_ * NC * 2;
constexpr int NE = 32, DE = 2048, NA = T_ * 4;
constexpr float LN_EPS = 1e-5f;
constexpr float DN_ALPHA = 1.189207115002721f;
constexpr float ATT_SCALE = 0.08838834764831845f;

constexpr size_t al256(size_t x) { return (x + 255) & ~(size_t)255; }
constexpr size_t WS_CTL = 0;
constexpr size_t CTL_BYTES = 65536;
constexpr size_t CTL_CNT = 16384;
constexpr size_t WS_PROJ = CTL_BYTES;
constexpr size_t WS_KVMEM = WS_PROJ + al256((size_t)T_ * INW * 4);
constexpr size_t WS_BIAS1 = WS_KVMEM + al256((size_t)2048 * 1024 * 4);
constexpr size_t WS_HID = WS_BIAS1 + al256(2 * 256 * 4);
constexpr size_t WS_KC = WS_HID + al256((size_t)2 * 2048 * 256 * 4);
constexpr size_t WS_VC = WS_KC + al256((size_t)CROWS * 128 * 4);
constexpr size_t WS_POOLED = WS_VC + al256((size_t)CROWS * 128 * 4);
constexpr size_t WS_OPOOL = WS_POOLED + al256((size_t)T_ * 512 * 4);
constexpr size_t WS_OWIN = WS_OPOOL + al256((size_t)T_ * 512 * 4);
constexpr size_t WS_OCMP = WS_OWIN + al256((size_t)T_ * 1024 * 4);
constexpr size_t WS_OSLC = WS_OCMP + al256((size_t)T_ * 1024 * 4);
constexpr size_t WS_SEL = WS_OSLC + al256((size_t)T_ * 1024 * 4);
constexpr size_t WS_OMEM = WS_SEL + al256((size_t)T_ * 2 * 4);
constexpr size_t WS_CAT16 = WS_OMEM + al256((size_t)T_ * 512 * 4);
constexpr size_t WS_HPRE = WS_CAT16 + al256((size_t)T_ * 2048 * 2);
constexpr size_t WS_H = WS_HPRE + al256((size_t)T_ * 2048 * 4);
constexpr size_t WS_H16 = WS_H + al256((size_t)T_ * 2048 * 4);
constexpr size_t WS_GATE = WS_H16 + al256((size_t)T_ * 2048 * 2);
constexpr size_t WS_LIST = WS_GATE + al256((size_t)NA * 4);
constexpr size_t WS_ACT16 = WS_LIST + al256((size_t)NE * T_ * 4);
constexpr size_t WS_Y16 = WS_ACT16 + al256((size_t)(NA + 256) * 2048 * 2);
constexpr size_t WS_X16 = WS_Y16 + al256((size_t)NA * 2048 * 2);
constexpr size_t WS_WTIN = WS_X16 + al256((size_t)T_ * 2048 * 2);
constexpr size_t WS_WTOUT = WS_WTIN + al256((size_t)3840 * 2048 * 2);
constexpr size_t WS_WTGU = WS_WTOUT + al256((size_t)2048 * 2048 * 2);
constexpr size_t WS_WTDN = WS_WTGU + al256((size_t)NE * 4096 * 2048 * 2);
constexpr size_t WS_PROJ16 = WS_WTDN + al256((size_t)NE * 2048 * 2048 * 2);
constexpr size_t WS_KVMEM16 = WS_PROJ16 + al256((size_t)(T_ + 64) * INW * 2);
constexpr size_t WS_WT1 = WS_KVMEM16 + al256((size_t)2048 * 1024 * 2);
constexpr size_t WS_UV = WS_WT1 + al256((size_t)2 * 512 * 2048 * 2);
constexpr size_t WS_KC16 = WS_UV + al256((size_t)2 * 4 * 2048 * 512 * 4);
constexpr size_t WS_VC16 = WS_KC16 + al256((size_t)B_ * 128 * 256 * 2);
constexpr size_t WS_WR16 = WS_VC16 + al256((size_t)B_ * 128 * 256 * 2);
constexpr size_t WS_Q8GU = WS_WR16 + al256((size_t)32 * 2048 * 2);
constexpr size_t WS_Q8DN = WS_Q8GU + al256((size_t)NE * 4096 * 2048);
constexpr size_t WS_SGU = WS_Q8DN + al256((size_t)NE * 2048 * 2048);
constexpr size_t WS_SDN = WS_SGU + al256((size_t)NE * 4096 * 4);
constexpr size_t WS_H8 = WS_SDN + al256((size_t)NE * 2048 * 4);
constexpr size_t WS_SAH = WS_H8 + al256((size_t)T_ * 2048);
constexpr size_t WS_ACT8 = WS_SAH + al256((size_t)T_ * 4);
constexpr size_t WS_SACT = WS_ACT8 + al256((size_t)(NA + 256) * 2048);
constexpr size_t WS_END = WS_SACT + al256((size_t)(NA + 256) * 4);

constexpr int LDS_BYTES = 155648;

struct Params {
    const float* in[26];
    float* out;
    unsigned char* ws;
    long long lo_hi;
};
enum { I_X = 0, I_MEM, I_WIN, I_POSK, I_W1K, I_W2K, I_POSV, I_W1V, I_W2V, I_POOLW, I_POOLS, I_WMEMKV, I_GNNSA, I_GNPOOL, I_GNMEM, I_WOUT,
       I_LN1G, I_LN1B, I_WR, I_BR, I_WGU, I_BGU, I_WDN, I_BDN, I_LN2G, I_LN2B };

#define XB_TMO      128
#define XB_XCNT(j)  (256  + 64 * (j))
#define XB_XSUB(j)  (1280 + 64 * (j))
#define XB_XGEN(j)  (2304 + 64 * (j))
#define XB_TOP      3328
#define XB_TOPGEN   3392
#define XCD_BAR_WORDS 3456
#define XB_SPIN_CAP (1u << 25)
#define LAS __attribute__((address_space(3)))

__device__ __forceinline__ unsigned xb_ld(unsigned* p)              { return __hip_atomic_load(p, __ATOMIC_RELAXED, __HIP_MEMORY_SCOPE_AGENT); }
__device__ __forceinline__ unsigned xb_add(unsigned* p, unsigned v) { return __hip_atomic_fetch_add(p, v, __ATOMIC_RELAXED, __HIP_MEMORY_SCOPE_AGENT); }
__device__ __forceinline__ unsigned xb_xcc_id() { return (unsigned)__builtin_amdgcn_s_getreg((3 << 11) | 20) & 0xFu; }
#define XB_SPIN(cond, bar) do { unsigned _sp = 0; while (cond) { __builtin_amdgcn_s_sleep(1); \
    if ((++_sp & 255u) == 0u) { if (xb_ld(&(bar)[XB_TMO])) break; if (_sp > XB_SPIN_CAP) { atomicAdd(&(bar)[XB_TMO], 1u); break; } } } } while (0)

struct XcdBarrier { unsigned* bar; unsigned x; volatile LAS unsigned* st; };

__device__ __forceinline__ XcdBarrier xcd_barrier_post(unsigned* bar, volatile LAS unsigned* st) {
    XcdBarrier b; b.bar = bar; b.x = xb_xcc_id(); b.st = st;
    if (threadIdx.x == 0) (void)xb_add(&bar[XB_XCNT(b.x)], 1u);
    return b;
}
__device__ __forceinline__ void xcd_barrier_complete(unsigned* bar, unsigned x, unsigned& nloc, unsigned& nx) {
    const unsigned G = gridDim.x * gridDim.y * gridDim.z;
    unsigned sum, cnt, mine, sp = 0u;
    for (;;) {
        sum = 0u; cnt = 0u; mine = 0u;
#pragma unroll
        for (unsigned j = 0; j < 16; ++j) { const unsigned c = xb_ld(&bar[XB_XCNT(j)]); sum += c; cnt += (c > 0u) ? 1u : 0u; mine = (j == x) ? c : mine; }
        if (sum == G) break;
        __builtin_amdgcn_s_sleep(1);
        if ((++sp & 255u) == 0u) { if (xb_ld(&bar[XB_TMO])) break; if (sp > XB_SPIN_CAP) { atomicAdd(&bar[XB_TMO], 1u); break; } }
    }
    nloc = mine > 0u ? mine : 1u; nx = cnt > 0u ? cnt : 1u;
}
__device__ __forceinline__ void xcd_barrier(const XcdBarrier& b) {
    asm volatile("s_waitcnt vmcnt(0)" ::: "memory");
    __syncthreads();
    if (threadIdx.x == 0) {
        unsigned* bar = b.bar;
        __builtin_amdgcn_s_waitcnt(0);
        unsigned nloc = b.st[0], nx = b.st[1];
        if (nloc == 0u) { xcd_barrier_complete(bar, b.x, nloc, nx); b.st[0] = nloc; b.st[1] = nx; }
        const unsigned old = xb_add(&bar[XB_XSUB(b.x)], 1u);
        const unsigned gen = old / nloc;
        if (old + 1u == (gen + 1u) * nloc) {
            __builtin_amdgcn_fence(__ATOMIC_RELEASE, "agent");
            asm volatile("s_waitcnt vmcnt(0)" ::: "memory");
            const unsigned og = xb_add(&bar[XB_TOP], 1u);
            const unsigned tg = og / nx;
            if (og + 1u == (tg + 1u) * nx) xb_add(&bar[XB_TOPGEN], 1u);
            else XB_SPIN(xb_ld(&bar[XB_TOPGEN]) == tg, bar);
            __builtin_amdgcn_fence(__ATOMIC_ACQUIRE, "agent");
            xb_add(&bar[XB_XGEN(b.x)], 1u);
            asm volatile("s_waitcnt vmcnt(0)" ::: "memory");
        } else {
            XB_SPIN(xb_ld(&bar[XB_XGEN(b.x)]) == gen, bar);
            __builtin_amdgcn_fence(__ATOMIC_ACQUIRE, "agent");
            asm volatile("s_waitcnt vmcnt(0)" ::: "memory");
        }
    }
    __syncthreads();
}

typedef _Float16 h8 __attribute__((ext_vector_type(8)));
typedef _Float16 h4 __attribute__((ext_vector_type(4)));
typedef float f4 __attribute__((ext_vector_type(4)));

__device__ __forceinline__ float wave_sum(float v) {
#pragma unroll
    for (int o = 32; o > 0; o >>= 1) v += __shfl_xor(v, o);
    return v;
}
__device__ __forceinline__ float wave_max(float v) {
#pragma unroll
    for (int o = 32; o > 0; o >>= 1) v = fmaxf(v, __shfl_xor(v, o));
    return v;
}
__device__ __forceinline__ void wave_sync() {
    asm volatile("s_waitcnt lgkmcnt(0)" ::: "memory");
    __builtin_amdgcn_wave_barrier();
}
__device__ __forceinline__ float gelu_tanh(float x) {
    const float u = 0.7978845608028654f * (x + 0.044715f * x * x * x);
    return 0.5f * x * (1.f + tanhf(u));
}
__device__ __forceinline__ float sigmoidf_(float x) { return 1.f / (1.f + expf(-x)); }

constexpr int G_LD = 40;
template <class AF, class EF>
__device__ __forceinline__ void gemm_tile(char* smem, int K, const AF& af, const float* __restrict__ Bm, int ldb, int n0, int Nlim, bool perm, const EF& ef) {
    _Float16* As = (_Float16*)smem;
    _Float16* Bs = As + 128 * G_LD;
    const int tid = threadIdx.x, lane = tid & 63, wid = tid >> 6, wr = wid >> 2, wc = wid & 3, fr = lane & 15, fq = lane >> 4;
    f4 acc[4][2];
#pragma unroll
    for (int m = 0; m < 4; ++m)
#pragma unroll
        for (int n = 0; n < 2; ++n) acc[m][n] = (f4){0.f, 0.f, 0.f, 0.f};
    const int ar = tid >> 3, ak = (tid & 7) * 4;
    const float* ap0 = af.row(ar);
    const float* ap1 = af.row(ar + 64);
    const int bk = tid >> 5, bn = (tid & 31) * 4;
    const bool bok = (n0 + bn) < Nlim;
    int bnp[4];
#pragma unroll
    for (int i = 0; i < 4; ++i) { const int c = bn + i; bnp[i] = perm ? ((c & ~31) | ((c & 1) << 4) | ((c & 31) >> 1)) : c; }
    for (int k0 = 0; k0 < K; k0 += 32) {
        const int ko = af.koff(k0 + ak);
        float4 a0 = make_float4(0.f, 0.f, 0.f, 0.f), a1 = a0, b0 = a0, b1 = a0;
        if (ap0) a0 = *(const float4*)(ap0 + ko);
        if (ap1) a1 = *(const float4*)(ap1 + ko);
        if (bok) { b0 = *(const float4*)(Bm + (size_t)(k0 + bk) * ldb + n0 + bn); b1 = *(const float4*)(Bm + (size_t)(k0 + bk + 16) * ldb + n0 + bn); }
        __syncthreads();
        *(h4*)&As[ar * G_LD + ak] = (h4){(_Float16)a0.x, (_Float16)a0.y, (_Float16)a0.z, (_Float16)a0.w};
        *(h4*)&As[(ar + 64) * G_LD + ak] = (h4){(_Float16)a1.x, (_Float16)a1.y, (_Float16)a1.z, (_Float16)a1.w};
        Bs[bnp[0] * G_LD + bk] = (_Float16)b0.x; Bs[bnp[1] * G_LD + bk] = (_Float16)b0.y; Bs[bnp[2] * G_LD + bk] = (_Float16)b0.z; Bs[bnp[3] * G_LD + bk] = (_Float16)b0.w;
        Bs[bnp[0] * G_LD + bk + 16] = (_Float16)b1.x; Bs[bnp[1] * G_LD + bk + 16] = (_Float16)b1.y; Bs[bnp[2] * G_LD + bk + 16] = (_Float16)b1.z; Bs[bnp[3] * G_LD + bk + 16] = (_Float16)b1.w;
        __syncthreads();
        h8 a[4], b[2];
#pragma unroll
        for (int m = 0; m < 4; ++m) a[m] = *(const h8*)&As[(wr * 64 + m * 16 + fr) * G_LD + fq * 8];
#pragma unroll
        for (int n = 0; n < 2; ++n) b[n] = *(const h8*)&Bs[(wc * 32 + n * 16 + fr) * G_LD + fq * 8];
#pragma unroll
        for (int m = 0; m < 4; ++m)
#pragma unroll
            for (int n = 0; n < 2; ++n) acc[m][n] = __builtin_amdgcn_mfma_f32_16x16x32_f16(a[m], b[n], acc[m][n], 0, 0, 0);
    }
    ef(acc, wr, wc, fr, fq);
    __syncthreads();
}

struct ARowPlain { const float* base; int ld; int m0; int mlim;
    __device__ __forceinline__ const float* row(int r) const { return (m0 + r) < mlim ? base + (size_t)(m0 + r) * ld : nullptr; }
    __device__ __forceinline__ int koff(int k) const { return k; } };
struct ARowCmp { const float* proj; int col; int m0;
    __device__ __forceinline__ const float* row(int r) const { const int g = m0 + r; if (g >= CROWS) return nullptr; const int kvh = g & 1, bc = g >> 1, b = bc / NC, c = bc % NC;
        return proj + (size_t)(b * S_ + 16 * c) * INW + col + kvh * 128; }
    __device__ __forceinline__ int koff(int k) const { return (k >> 7) * INW + (k & 127); } };
struct ARowList { const float* base; const int* list; int m0; int cnt; int shift;
    __device__ __forceinline__ const float* row(int r) const { if (m0 + r >= cnt) return nullptr; const int a = list[m0 + r]; return base + (size_t)(a >> shift) * 2048; }
    __device__ __forceinline__ int koff(int k) const { return k; } };

struct EpiStore { float* C; int ldc; int m0; int n0; int mlim; int nlim; _Float16* C16;
    __device__ __forceinline__ void operator()(const f4 (&acc)[4][2], int wr, int wc, int fr, int fq) const {
#pragma unroll
        for (int m = 0; m < 4; ++m)
#pragma unroll
            for (int n = 0; n < 2; ++n)
#pragma unroll
                for (int j = 0; j < 4; ++j) { const int r = m0 + wr * 64 + m * 16 + fq * 4 + j, c = n0 + wc * 32 + n * 16 + fr;
                    if (r < mlim && c < nlim) { C[(size_t)r * ldc + c] = acc[m][n][j]; if (C16) C16[(size_t)r * ldc + c] = (_Float16)acc[m][n][j]; } } } };
struct EpiPool { float* C; const float* scale; int m0; int g;
    __device__ __forceinline__ void operator()(const f4 (&acc)[4][2], int wr, int wc, int fr, int fq) const {
#pragma unroll
        for (int m = 0; m < 4; ++m)
#pragma unroll
            for (int n = 0; n < 2; ++n)
#pragma unroll
                for (int j = 0; j < 4; ++j) { const int r = m0 + wr * 64 + m * 16 + fq * 4 + j, c = g * 128 + wc * 32 + n * 16 + fr;
                    C[(size_t)r * 512 + c] = acc[m][n][j] * scale[c]; } } };
struct EpiHid { float* C; const float* bias; int m0; int n0;
    __device__ __forceinline__ void operator()(const f4 (&acc)[4][2], int wr, int wc, int fr, int fq) const {
#pragma unroll
        for (int m = 0; m < 4; ++m)
#pragma unroll
            for (int n = 0; n < 2; ++n)
#pragma unroll
                for (int j = 0; j < 4; ++j) { const int r = m0 + wr * 64 + m * 16 + fq * 4 + j, c = n0 + wc * 32 + n * 16 + fr;
                    if (r < CROWS) C[(size_t)r * 256 + c] = gelu_tanh(acc[m][n][j] + bias[c]); } } };
struct EpiOut { float* C; const float* x; int m0; int n0;
    __device__ __forceinline__ void operator()(const f4 (&acc)[4][2], int wr, int wc, int fr, int fq) const {
#pragma unroll
        for (int m = 0; m < 4; ++m)
#pragma unroll
            for (int n = 0; n < 2; ++n)
#pragma unroll
                for (int j = 0; j < 4; ++j) { const size_t o = (size_t)(m0 + wr * 64 + m * 16 + fq * 4 + j) * 2048 + n0 + wc * 32 + n * 16 + fr;
                    C[o] = DN_ALPHA * x[o] + acc[m][n][j]; } } };
struct EpiGu { float* act; const float* bgu; const int* list; int m0; int cnt; int n0;
    __device__ __forceinline__ void operator()(const f4 (&acc)[4][2], int wr, int wc, int fr, int fq) const {
        const int jc = (n0 + wc * 32) / 2 + fr;
        const float bg = bgu[2 * jc], bl = bgu[2 * jc + 1];
#pragma unroll
        for (int m = 0; m < 4; ++m)
#pragma unroll
            for (int j = 0; j < 4; ++j) { const int r = m0 + wr * 64 + m * 16 + fq * 4 + j;
                if (r < cnt) { const int a = list[r];
                    const float xg = fminf(acc[m][0][j] + bg, 7.f), xl = fminf(fmaxf(acc[m][1][j] + bl, -7.f), 7.f);
                    act[(size_t)a * 2048 + jc] = xg * sigmoidf_(1.702f * xg) * (xl + 1.f); } } } };
struct EpiDn { float* y; const float* bdn; const int* list; const float* gate; int m0; int cnt; int n0;
    __device__ __forceinline__ void operator()(const f4 (&acc)[4][2], int wr, int wc, int fr, int fq) const {
#pragma unroll
        for (int m = 0; m < 4; ++m)
#pragma unroll
            for (int j = 0; j < 4; ++j) { const int r = m0 + wr * 64 + m * 16 + fq * 4 + j;
                if (r < cnt) { const int a = list[r]; const float g = gate[a];
#pragma unroll
                    for (int n = 0; n < 2; ++n) { const int c = n0 + wc * 32 + n * 16 + fr; y[(size_t)a * 2048 + c] = (acc[m][n][j] + bdn[c]) * g; } } } } };

constexpr int WLDS_FLOATS = 4096 + 512 + 32;
template <bool SHARED>
__device__ __forceinline__ void wave_attn(float* sw, const float* __restrict__ qptr, const float* __restrict__ Kb, const float* __restrict__ Vb, int ld, int nseg, float scale, float* __restrict__ optr) {
    const int lane = threadIdx.x & 63;
    float* sq = sw + 4096; const int* segs = (const int*)(sw + 4096 + 512);
#pragma unroll
    for (int i = 0; i < 8; ++i) sq[lane + 64 * i] = qptr[lane + 64 * i];
    wave_sync();
    for (int sg = 0; sg < nseg; ++sg) {
        const int start = segs[sg], len = segs[16 + sg];
        float d0 = 0.f, d1 = 0.f, d2 = 0.f, d3 = 0.f;
        if (lane < len) {
            const float* kp = Kb + (size_t)(start + lane) * ld;
            for (int d4 = 0; d4 < 32; ++d4) {
                if (SHARED) {
                    const float4 kv = *(const float4*)(kp + d4 * 4);
                    const float4 q0 = *(const float4*)(sq + d4 * 4), q1 = *(const float4*)(sq + 128 + d4 * 4), q2 = *(const float4*)(sq + 256 + d4 * 4), q3 = *(const float4*)(sq + 384 + d4 * 4);
                    d0 += kv.x * q0.x + kv.y * q0.y + kv.z * q0.z + kv.w * q0.w;
                    d1 += kv.x * q1.x + kv.y * q1.y + kv.z * q1.z + kv.w * q1.w;
                    d2 += kv.x * q2.x + kv.y * q2.y + kv.z * q2.z + kv.w * q2.w;
                    d3 += kv.x * q3.x + kv.y * q3.y + kv.z * q3.z + kv.w * q3.w;
                } else {
                    const float4 k0 = *(const float4*)(kp + d4 * 4), k1 = *(const float4*)(kp + 128 + d4 * 4), k2 = *(const float4*)(kp + 256 + d4 * 4), k3 = *(const float4*)(kp + 384 + d4 * 4);
                    const float4 q0 = *(const float4*)(sq + d4 * 4), q1 = *(const float4*)(sq + 128 + d4 * 4), q2 = *(const float4*)(sq + 256 + d4 * 4), q3 = *(const float4*)(sq + 384 + d4 * 4);
                    d0 += k0.x * q0.x + k0.y * q0.y + k0.z * q0.z + k0.w * q0.w;
                    d1 += k1.x * q1.x + k1.y * q1.y + k1.z * q1.z + k1.w * q1.w;
                    d2 += k2.x * q2.x + k2.y * q2.y + k2.z * q2.z + k2.w * q2.w;
                    d3 += k3.x * q3.x + k3.y * q3.y + k3.z * q3.z + k3.w * q3.w;
                }
            }
        }
        const bool ok = lane < len;
        sw[sg * 64 + lane] = ok ? d0 * scale : -1e30f;
        sw[1024 + sg * 64 + lane] = ok ? d1 * scale : -1e30f;
        sw[2048 + sg * 64 + lane] = ok ? d2 * scale : -1e30f;
        sw[3072 + sg * 64 + lane] = ok ? d3 * scale : -1e30f;
    }
    wave_sync();
    const int n = nseg * 64;
#pragma unroll
    for (int g = 0; g < 4; ++g) {
        float mx = -1e30f;
        for (int i = lane; i < n; i += 64) mx = fmaxf(mx, sw[g * 1024 + i]);
        mx = wave_max(mx);
        float sm = 0.f;
        for (int i = lane; i < n; i += 64) { const float v = sw[g * 1024 + i]; sm += (v > -1e29f) ? expf(v - mx) : 0.f; }
        sm = wave_sum(sm);
        const float inv = sm > 0.f ? 1.f / sm : 0.f;
        for (int i = lane; i < n; i += 64) { const float v = sw[g * 1024 + i]; sw[g * 1024 + i] = (v > -1e29f) ? expf(v - mx) * inv : 0.f; }
    }
    wave_sync();
    float o[4][2];
#pragma unroll
    for (int g = 0; g < 4; ++g) { o[g][0] = 0.f; o[g][1] = 0.f; }
    for (int sg = 0; sg < nseg; ++sg) {
        const int start = segs[sg], len = segs[16 + sg];
        for (int l = 0; l < len; ++l) {
            const float* vp = Vb + (size_t)(start + l) * ld;
            if (SHARED) {
                const float v0 = vp[lane], v1 = vp[lane + 64];
#pragma unroll
                for (int g = 0; g < 4; ++g) { const float p = sw[g * 1024 + sg * 64 + l]; o[g][0] += p * v0; o[g][1] += p * v1; }
            } else {
#pragma unroll
                for (int g = 0; g < 4; ++g) { const float p = sw[g * 1024 + sg * 64 + l]; o[g][0] += p * vp[g * 128 + lane]; o[g][1] += p * vp[g * 128 + lane + 64]; }
            }
        }
    }
#pragma unroll
    for (int g = 0; g < 4; ++g) { optr[g * 128 + lane] = o[g][0]; optr[g * 128 + lane + 64] = o[g][1]; }
}

namespace g8 {
constexpr int BM = 256, BK = 64, HALF = 128, HTB = HALF * BK * 2, STAGE_BYTES = 8 * HTB;
constexpr int KK = 2048;
typedef float f32x4 __attribute__((ext_vector_type(4)));
__device__ __forceinline__ int lds_byte(int r, int c) { const int st = (r >> 4) * 2 + (c >> 5), rr = r & 15, cc = c & 31, ob = rr * 64 + cc * 2; return st * 1024 + (ob ^ (((ob >> 9) & 1) << 5)); }
__device__ __forceinline__ void stage_rc(int b, int& R, int& C) { const int st = b / 1024, sb = b % 1024, swz = sb ^ (((sb >> 9) & 1) << 5); R = (st >> 1) * 16 + swz / 64; C = (st & 1) * 32 + (swz % 64) / 2; }
__device__ __forceinline__ int perm32(int rho) { const int n = rho >> 4, i = rho & 15; return 8 * (i >> 2) + 4 * n + (i & 3); }

typedef int i32x4 __attribute__((ext_vector_type(4)));
template <bool I8> struct AccSel { typedef f32x4 T; };
template <> struct AccSel<true> { typedef i32x4 T; };
__device__ __forceinline__ f32x4 mma16(i32x4 a, i32x4 b, f32x4 c) { return __builtin_amdgcn_mfma_f32_16x16x32_f16(*reinterpret_cast<h8*>(&a), *reinterpret_cast<h8*>(&b), c, 0, 0, 0); }
__device__ __forceinline__ i32x4 mma16(i32x4 a, i32x4 b, i32x4 c) { return __builtin_amdgcn_mfma_i32_16x16x64_i8(a, b, c, 0, 0, 0); }
struct Unit { int m0, n0, e, cnt, rbase; };

__device__ __forceinline__ void tile_order(int L, int nM, int nN, int& pm, int& pn) {
    const int nwg = nM * nN; int wgid = L;
    { const int q = nwg / 8, r = nwg % 8, xcd = wgid % 8, off = wgid / 8; wgid = (xcd < r ? xcd * (q + 1) : r * (q + 1) + (xcd - r) * q) + off; }
    const int nig = 8 * nN, gid = wgid / nig, fm = gid * 8, gsz = (nM - fm) < 8 ? (nM - fm) : 8;
    pm = fm + ((wgid % nig) % gsz); pn = (wgid % nig) / gsz;
}

template <class Prob>
__device__ __forceinline__ void gemm_phase(LAS unsigned char* lds, const Prob& P) {
    const int tid = threadIdx.x, wid = __builtin_amdgcn_readfirstlane(tid >> 6), lane = tid & 63, wr = wid >> 2, wc = wid & 3, fr = lane & 15, fq = lane >> 4;
    constexpr int nt = Prob::NT; constexpr size_t KS2 = Prob::KS2; constexpr unsigned ROWB = Prob::ROWB; constexpr bool I8 = Prob::I8;
    int sR[2], sC2[2]; unsigned voffB[2];
#pragma unroll
    for (int i = 0; i < 2; ++i) { int R, C; stage_rc(tid * 16 + i * 8192, R, C); sR[i] = R; sC2[i] = C * 2; const int Rb = Prob::PERM ? ((R & ~31) + perm32(R & 31)) : R; voffB[i] = (unsigned)Rb * ROWB + (unsigned)C * 2u; }
    const size_t kstep = (size_t)(BK * 2);
    const size_t hstep = (size_t)HALF * ROWB;
    const unsigned ldsw = (unsigned)wid * 1024u;
    const int aoff = lds_byte(wr * 64 + fr, fq * 8), boff = lds_byte(wc * 32 + fr, fq * 8);
#define G8_SA(b, h) (((b) * 2 + (h)) * HTB)
#define G8_SB(b, h) ((4 + (b) * 2 + (h)) * HTB)
#define G8_STAGE(bufoff, gbase, voff) do { _Pragma("unroll") for (int _i = 0; _i < 2; ++_i) \
        __builtin_amdgcn_global_load_lds((const unsigned*)((const char*)(gbase) + (voff)[_i]), (LAS unsigned*)(lds + (bufoff) + ldsw + _i * 8192), 16, 0, 0); } while (0)
#define G8_LDA(dst, b, h) do { _Pragma("unroll") for (int m = 0; m < 4; ++m) _Pragma("unroll") for (int k = 0; k < 2; ++k) dst[m][k] = *(const LAS i32x4*)(lds + G8_SA(b, h) + aoff + m * 2048 + k * 1024); } while (0)
#define G8_LDB(dst, b, h) do { _Pragma("unroll") for (int n = 0; n < 2; ++n) _Pragma("unroll") for (int k = 0; k < 2; ++k) dst[n][k] = *(const LAS i32x4*)(lds + G8_SB(b, h) + boff + n * 2048 + k * 1024); } while (0)
#define G8_MMA(ai, bj, At, Bt) do { __builtin_amdgcn_s_setprio(1); _Pragma("unroll") for (int m = 0; m < 4; ++m) _Pragma("unroll") for (int n = 0; n < 2; ++n) _Pragma("unroll") for (int k = 0; k < 2; ++k) \
        acc[ai][bj][m][n] = mma16(Bt[n][k], At[m][k], acc[ai][bj][m][n]); __builtin_amdgcn_s_setprio(0); } while (0)
#define G8_WAIT_V(n) asm volatile("s_waitcnt vmcnt(" #n ")" ::: "memory")
#define G8_WAIT_L(n) asm volatile("s_waitcnt lgkmcnt(" #n ")" ::: "memory")
#define G8_BAR __builtin_amdgcn_s_barrier()
#define G8_SCHED __builtin_amdgcn_sched_barrier(0)
    Unit cur, nxt; int ui = 0;
    if (!P.next(0, cur)) return;
    typedef typename AccSel<I8>::T AccT;
    AccT acc[2][2][4][2];
#pragma unroll
    for (int a = 0; a < 2; ++a)
#pragma unroll
        for (int b = 0; b < 2; ++b)
#pragma unroll
            for (int m = 0; m < 4; ++m)
#pragma unroll
                for (int n = 0; n < 2; ++n) acc[a][b][m][n] = AccT{};
    i32x4 At[4][2], B0[2][2], B1[2][2];
    unsigned vc[2][2], vn[2][2];
    P.a_offs(cur, sR, sC2, vc);
    const char* const Ab = P.a_base();
    const char* cB = P.b_base(cur);
    G8_STAGE(G8_SB(0, 0), cB, voffB); G8_STAGE(G8_SA(0, 0), Ab, vc[0]); G8_STAGE(G8_SB(0, 1), cB + hstep, voffB); G8_STAGE(G8_SA(0, 1), Ab, vc[1]);
    if (wr == 1) G8_BAR;
    G8_WAIT_V(4); G8_BAR;
    G8_STAGE(G8_SB(1, 0), cB + kstep, voffB); G8_STAGE(G8_SA(1, 0), Ab + kstep, vc[0]); G8_STAGE(G8_SB(1, 1), cB + hstep + kstep, voffB);
    G8_WAIT_V(6); G8_BAR;
    for (;;) {
        const bool has_next = P.next(ui + 1, nxt);
        const char* nB = cB;
        if (has_next) { P.a_offs(nxt, sR, sC2, vn); nB = P.b_base(nxt); }
        else { vn[0][0] = vc[0][0]; vn[0][1] = vc[0][1]; vn[1][0] = vc[1][0]; vn[1][1] = vc[1][1]; }
        for (int t = 0; t < nt; t += 2) {
            const bool last = (t == nt - 2);
            const char* a1 = Ab + (size_t)(t >> 1) * KS2 + kstep;
            const char* a2 = last ? Ab : Ab + (size_t)((t + 2) >> 1) * KS2; const char* b2 = last ? nB : cB + (size_t)(t + 2) * kstep;
            const char* a3 = a2 + kstep; const char* b3 = b2 + kstep;
            unsigned o2[2][2];
            o2[0][0] = last ? vn[0][0] : vc[0][0]; o2[0][1] = last ? vn[0][1] : vc[0][1]; o2[1][0] = last ? vn[1][0] : vc[1][0]; o2[1][1] = last ? vn[1][1] : vc[1][1];
            G8_LDB(B0, 0, 0); G8_SCHED; G8_LDA(At, 0, 0); G8_STAGE(G8_SA(1, 1), a1, vc[1]);
            G8_WAIT_L(8); G8_BAR; G8_WAIT_L(0); G8_MMA(0, 0, At, B0); G8_BAR; G8_SCHED;
            G8_LDB(B1, 0, 1); G8_STAGE(G8_SB(0, 0), b2, voffB);
            G8_BAR; G8_WAIT_L(0); G8_MMA(0, 1, At, B1); G8_BAR;
            G8_LDA(At, 0, 1); G8_STAGE(G8_SA(0, 0), a2, o2[0]);
            G8_BAR; G8_WAIT_L(0); G8_MMA(1, 0, At, B0); G8_BAR; G8_SCHED;
            G8_STAGE(G8_SB(0, 1), b2 + hstep, voffB);
            G8_WAIT_V(6); G8_BAR; G8_MMA(1, 1, At, B1); G8_BAR;
            G8_LDB(B0, 1, 0); G8_SCHED; G8_LDA(At, 1, 0); G8_STAGE(G8_SA(0, 1), a2, o2[1]);
            G8_WAIT_L(8); G8_BAR; G8_WAIT_L(0); G8_MMA(0, 0, At, B0); G8_BAR; G8_SCHED;
            G8_LDB(B1, 1, 1); G8_STAGE(G8_SB(1, 0), b3, voffB);
            G8_BAR; G8_WAIT_L(0); G8_MMA(0, 1, At, B1); G8_BAR;
            G8_LDA(At, 1, 1); G8_STAGE(G8_SA(1, 0), a3, o2[0]);
            G8_BAR; G8_WAIT_L(0); G8_MMA(1, 0, At, B0); G8_BAR; G8_SCHED;
            G8_STAGE(G8_SB(1, 1), b3 + hstep, voffB);
            G8_WAIT_V(6); G8_BAR; G8_MMA(1, 1, At, B1); G8_BAR;
        }
        P.epi(acc, cur, wr, wc, fr, fq);
        if (!has_next) break;
#pragma unroll
        for (int a = 0; a < 2; ++a)
#pragma unroll
            for (int b = 0; b < 2; ++b)
#pragma unroll
                for (int m = 0; m < 4; ++m)
#pragma unroll
                    for (int n = 0; n < 2; ++n) acc[a][b][m][n] = AccT{};
        cur = nxt; cB = nB; ++ui;
        vc[0][0] = vn[0][0]; vc[0][1] = vn[0][1]; vc[1][0] = vn[1][0]; vc[1][1] = vn[1][1];
    }
    G8_WAIT_V(0);
    if (wr == 0) G8_BAR;
    G8_BAR;
#undef G8_SA
#undef G8_SB
#undef G8_STAGE
#undef G8_LDA
#undef G8_LDB
#undef G8_MMA
#undef G8_WAIT_V
#undef G8_WAIT_L
#undef G8_BAR
#undef G8_SCHED
}

struct ProbIn {
    static constexpr unsigned ROWB = 4096; static constexpr bool I8 = false;
    static constexpr int NT = 32; static constexpr size_t KS2 = 256;
    static constexpr bool PERM = true;
    const _Float16* A; const _Float16* Bt; _Float16* C16; int G, c;
    __device__ __forceinline__ bool next(int i, Unit& u) const { const int L = i * G + c; if (L >= 64 * 15) return false; int pm, pn; tile_order(L, 64, 15, pm, pn); u.m0 = pm * 256; u.n0 = pn * 256; u.e = 0; u.cnt = 256; u.rbase = 0; return true; }
    __device__ __forceinline__ void a_offs(const Unit& u, const int (&R)[2], const int (&C2)[2], unsigned (&v)[2][2]) const {
#pragma unroll
        for (int h = 0; h < 2; ++h)
#pragma unroll
            for (int i = 0; i < 2; ++i) v[h][i] = (unsigned)(u.m0 + h * 128 + R[i]) * (unsigned)(KK * 2) + (unsigned)C2[i]; }
    __device__ __forceinline__ const char* a_base() const { return (const char*)A; }
    __device__ __forceinline__ const char* b_base(const Unit& u) const { return (const char*)(Bt + (size_t)u.n0 * KK); }
    __device__ __forceinline__ void epi(const f32x4 (&acc)[2][2][4][2], const Unit& u, int wr, int wc, int fr, int fq) const {
#pragma unroll
        for (int ai = 0; ai < 2; ++ai)
#pragma unroll
            for (int m = 0; m < 4; ++m) { const int row = u.m0 + ai * 128 + wr * 64 + m * 16 + fr;
#pragma unroll
                for (int bj = 0; bj < 2; ++bj) { const int col = u.n0 + bj * 128 + wc * 32 + fq * 8;
                    if (col < INW) { const f32x4 v0 = acc[ai][bj][m][0], v1 = acc[ai][bj][m][1];
                        h8 o; o[0] = (_Float16)v0[0]; o[1] = (_Float16)v0[1]; o[2] = (_Float16)v0[2]; o[3] = (_Float16)v0[3]; o[4] = (_Float16)v1[0]; o[5] = (_Float16)v1[1]; o[6] = (_Float16)v1[2]; o[7] = (_Float16)v1[3];
                        *(h8*)(C16 + (size_t)row * INW + col) = o; } } } }
};
struct ProbOut {
    static constexpr unsigned ROWB = 4096; static constexpr bool I8 = false;
    static constexpr int NT = 32; static constexpr size_t KS2 = 256;
    static constexpr bool PERM = false;
    const _Float16* A; const _Float16* Bt; float* C; const float* X; int G, c;
    __device__ __forceinline__ bool next(int i, Unit& u) const { const int L = i * G + c; if (L >= 64 * 8) return false; int pm, pn; tile_order(L, 64, 8, pm, pn); u.m0 = pm * 256; u.n0 = pn * 256; u.e = 0; u.cnt = 256; u.rbase = 0; return true; }
    __device__ __forceinline__ void a_offs(const Unit& u, const int (&R)[2], const int (&C2)[2], unsigned (&v)[2][2]) const {
#pragma unroll
        for (int h = 0; h < 2; ++h)
#pragma unroll
            for (int i = 0; i < 2; ++i) v[h][i] = (unsigned)(u.m0 + h * 128 + R[i]) * (unsigned)(KK * 2) + (unsigned)C2[i]; }
    __device__ __forceinline__ const char* a_base() const { return (const char*)A; }
    __device__ __forceinline__ const char* b_base(const Unit& u) const { return (const char*)(Bt + (size_t)u.n0 * KK); }
    __device__ __forceinline__ void epi(const f32x4 (&acc)[2][2][4][2], const Unit& u, int wr, int wc, int fr, int fq) const {
#pragma unroll
        for (int ai = 0; ai < 2; ++ai)
#pragma unroll
            for (int m = 0; m < 4; ++m) { const int row = u.m0 + ai * 128 + wr * 64 + m * 16 + fr;
#pragma unroll
                for (int bj = 0; bj < 2; ++bj)
#pragma unroll
                    for (int n = 0; n < 2; ++n) { const size_t o = (size_t)row * 2048 + u.n0 + bj * 128 + wc * 32 + n * 16 + fq * 4;
                        const f32x4 xv = *(const f32x4*)(X + o); *(f32x4*)(C + o) = xv * DN_ALPHA + acc[ai][bj][m][n]; } } }
};
struct ProbCmp {
    static constexpr unsigned ROWB = 4096; static constexpr bool I8 = false;
    static constexpr int NT = 8; static constexpr size_t KS2 = (size_t)INW * 2;
    static constexpr bool PERM = false;
    const _Float16* A; const _Float16* Bt; float* C; int G, c;
    __device__ __forceinline__ bool next(int i, Unit& u) const { const int L = i * G + c; if (L >= 128) return false;
        u.e = L >> 6; const int r = L & 63; u.rbase = r & 3; u.n0 = ((r >> 2) & 1) * 256; u.m0 = (r >> 3) * 256; u.cnt = 256; return true; }
    __device__ __forceinline__ void a_offs(const Unit& u, const int (&R)[2], const int (&C2)[2], unsigned (&v)[2][2]) const {
#pragma unroll
        for (int h = 0; h < 2; ++h)
#pragma unroll
            for (int i = 0; i < 2; ++i) { const int row = u.m0 + h * 128 + R[i], kvh = row & 1, bj = row >> 1, b = bj >> 7, j = bj & 127;
                v[h][i] = (unsigned)((b * S_ + 16 * j + 4 * u.rbase) * INW + (u.e ? C_VC : C_KC) + kvh * 128) * 2u + (unsigned)C2[i]; } }
    __device__ __forceinline__ const char* a_base() const { return (const char*)A; }
    __device__ __forceinline__ const char* b_base(const Unit& u) const { return (const char*)(Bt + ((size_t)u.e * 512 + u.n0) * KK + u.rbase * 512); }
    __device__ __forceinline__ void epi(const f32x4 (&acc)[2][2][4][2], const Unit& u, int wr, int wc, int fr, int fq) const {
        float* base = C + ((size_t)(u.e * 4 + u.rbase) * 2048) * 512;
#pragma unroll
        for (int ai = 0; ai < 2; ++ai)
#pragma unroll
            for (int m = 0; m < 4; ++m) { const int row = u.m0 + ai * 128 + wr * 64 + m * 16 + fr;
#pragma unroll
                for (int bj = 0; bj < 2; ++bj)
#pragma unroll
                    for (int n = 0; n < 2; ++n) { const int col = u.n0 + bj * 128 + wc * 32 + n * 16 + fq * 4;
                        *(f32x4*)(base + (size_t)row * 512 + col) = acc[ai][bj][m][n]; } } }
};
struct MoeTab { const LAS int* t; int NT;
    __device__ __forceinline__ bool find(int L, Unit& u) const {
        const int total = __builtin_amdgcn_readfirstlane(t[98]); if (L >= total) return false;
        int e = 0;
        for (; e < NE - 1; ++e) { if (L < __builtin_amdgcn_readfirstlane(t[32 + e + 1])) break; }
        const int ub = __builtin_amdgcn_readfirstlane(t[32 + e]), cn = __builtin_amdgcn_readfirstlane(t[e]), rs = __builtin_amdgcn_readfirstlane(t[65 + e]);
        const int nm = (cn + 255) >> 8, v = L - ub, mt = v % nm, ntile = v / nm;
        u.e = e; u.m0 = mt * 256; u.n0 = ntile * 256; u.cnt = min(256, cn - mt * 256); u.rbase = rs; return true; } };
struct ProbGu {
    static constexpr int NT = 16; static constexpr size_t KS2 = 256; static constexpr unsigned ROWB = 2048; static constexpr bool I8 = true;
    static constexpr bool PERM = true;
    const signed char* A; const signed char* Bt; _Float16* act; const float* bgu; const int* list; const float* sa; const float* sw; MoeTab tab; int G, vcu;
    __device__ __forceinline__ bool next(int i, Unit& u) const { return tab.find(i * G + vcu, u); }
    __device__ __forceinline__ void a_offs(const Unit& u, const int (&R)[2], const int (&C2)[2], unsigned (&v)[2][2]) const {
#pragma unroll
        for (int h = 0; h < 2; ++h)
#pragma unroll
            for (int i = 0; i < 2; ++i) { int r = h * 128 + R[i]; r = r < u.cnt ? r : 0; const int a = list[(size_t)u.e * T_ + u.m0 + r]; v[h][i] = (unsigned)(a >> 2) * 2048u + (unsigned)C2[i]; } }
    __device__ __forceinline__ const char* a_base() const { return (const char*)A; }
    __device__ __forceinline__ const char* b_base(const Unit& u) const { return (const char*)(Bt + ((size_t)u.e * 4096 + u.n0) * 2048); }
    __device__ __forceinline__ void epi(const i32x4 (&acc)[2][2][4][2], const Unit& u, int wr, int wc, int fr, int fq) const {
        const float* bb = bgu + (size_t)u.e * 4096; const float* ss = sw + (size_t)u.e * 4096;
#pragma unroll
        for (int ai = 0; ai < 2; ++ai)
#pragma unroll
            for (int m = 0; m < 4; ++m) { const int rl = ai * 128 + wr * 64 + m * 16 + fr;
                if (rl < u.cnt) { const int a = list[(size_t)u.e * T_ + u.m0 + rl]; const float sr = sa[a >> 2];
#pragma unroll
                    for (int bj = 0; bj < 2; ++bj) { const int col = u.n0 + bj * 128 + wc * 32 + fq * 8;
                        const f32x4 b0 = *(const f32x4*)(bb + col), b1 = *(const f32x4*)(bb + col + 4), s0 = *(const f32x4*)(ss + col) * sr, s1 = *(const f32x4*)(ss + col + 4) * sr;
                        const i32x4 i0 = acc[ai][bj][m][0], i1 = acc[ai][bj][m][1];
                        const f32x4 v0 = (f32x4){(float)i0[0], (float)i0[1], (float)i0[2], (float)i0[3]} * s0 + b0, v1 = (f32x4){(float)i1[0], (float)i1[1], (float)i1[2], (float)i1[3]} * s1 + b1;
                        h4 o;
                        { const float xg = fminf(v0[0], 7.f), xl = fminf(fmaxf(v0[1], -7.f), 7.f); o[0] = (_Float16)(xg * sigmoidf_(1.702f * xg) * (xl + 1.f)); }
                        { const float xg = fminf(v0[2], 7.f), xl = fminf(fmaxf(v0[3], -7.f), 7.f); o[1] = (_Float16)(xg * sigmoidf_(1.702f * xg) * (xl + 1.f)); }
                        { const float xg = fminf(v1[0], 7.f), xl = fminf(fmaxf(v1[1], -7.f), 7.f); o[2] = (_Float16)(xg * sigmoidf_(1.702f * xg) * (xl + 1.f)); }
                        { const float xg = fminf(v1[2], 7.f), xl = fminf(fmaxf(v1[3], -7.f), 7.f); o[3] = (_Float16)(xg * sigmoidf_(1.702f * xg) * (xl + 1.f)); }
                        *(h4*)(act + (size_t)(u.rbase + u.m0 + rl) * 2048 + (col >> 1)) = o; } } } }
};
struct ProbDn {
    static constexpr int NT = 16; static constexpr size_t KS2 = 256; static constexpr unsigned ROWB = 2048; static constexpr bool I8 = true;
    static constexpr bool PERM = true;
    const signed char* A; const signed char* Bt; _Float16* y; const float* bdn; const int* list; const float* gate; const float* sa; const float* sw; MoeTab tab; int G, vcu;
    __device__ __forceinline__ bool next(int i, Unit& u) const { return tab.find(i * G + vcu, u); }
    __device__ __forceinline__ void a_offs(const Unit& u, const int (&R)[2], const int (&C2)[2], unsigned (&v)[2][2]) const {
#pragma unroll
        for (int h = 0; h < 2; ++h)
#pragma unroll
            for (int i = 0; i < 2; ++i) v[h][i] = (unsigned)(u.rbase + u.m0 + h * 128 + R[i]) * 2048u + (unsigned)C2[i]; }
    __device__ __forceinline__ const char* a_base() const { return (const char*)A; }
    __device__ __forceinline__ const char* b_base(const Unit& u) const { return (const char*)(Bt + ((size_t)u.e * 2048 + u.n0) * 2048); }
    __device__ __forceinline__ void epi(const i32x4 (&acc)[2][2][4][2], const Unit& u, int wr, int wc, int fr, int fq) const {
        const float* bb = bdn + (size_t)u.e * 2048; const float* ss = sw + (size_t)u.e * 2048;
#pragma unroll
        for (int ai = 0; ai < 2; ++ai)
#pragma unroll
            for (int m = 0; m < 4; ++m) { const int rl = ai * 128 + wr * 64 + m * 16 + fr;
                if (rl < u.cnt) { const int a = list[(size_t)u.e * T_ + u.m0 + rl]; const float g = gate[a]; const float sr = sa[u.rbase + u.m0 + rl];
#pragma unroll
                    for (int bj = 0; bj < 2; ++bj) { const int col = u.n0 + bj * 128 + wc * 32 + fq * 8;
                        const f32x4 s0 = *(const f32x4*)(ss + col) * sr, s1 = *(const f32x4*)(ss + col + 4) * sr;
                        const i32x4 i0 = acc[ai][bj][m][0], i1 = acc[ai][bj][m][1];
                        const f32x4 v0 = ((f32x4){(float)i0[0], (float)i0[1], (float)i0[2], (float)i0[3]} * s0 + *(const f32x4*)(bb + col)) * g, v1 = ((f32x4){(float)i1[0], (float)i1[1], (float)i1[2], (float)i1[3]} * s1 + *(const f32x4*)(bb + col + 4)) * g;
                        h8 o; o[0] = (_Float16)v0[0]; o[1] = (_Float16)v0[1]; o[2] = (_Float16)v0[2]; o[3] = (_Float16)v0[3]; o[4] = (_Float16)v1[0]; o[5] = (_Float16)v1[1]; o[6] = (_Float16)v1[2]; o[7] = (_Float16)v1[3];
                        *(h8*)(y + (size_t)a * 2048 + col) = o; } } } }
};
}

namespace at8 {
typedef float f32x16 __attribute__((ext_vector_type(16)));
typedef short s16x4 __attribute__((ext_vector_type(4)));
typedef unsigned u32x4 __attribute__((ext_vector_type(4)));
constexpr int SHM_V = 64 * 128 * 2, SHM_K = 64 * 128 * 2;
constexpr int LDS_WS = 2 * SHM_V + 2 * SHM_K;
constexpr int LDS_END = LDS_WS + 8 * 64 * 4;
constexpr float CEXP = ATT_SCALE * 1.4426950408889634f;
constexpr float THR_RAW = 8.f / ATT_SCALE;
#define AT_KSWZ(row, colB) ((row) * 256 + ((colB) ^ (((row) & 7) << 4)))
#define AT_SBAR() __builtin_amdgcn_sched_barrier(0)
__device__ __forceinline__ int crow(int r, int hi) { return (r & 3) + 8 * (r >> 2) + 4 * hi; }
__device__ __forceinline__ unsigned cvtpk(float lo, float hi) { auto v = __builtin_amdgcn_cvt_pkrtz(lo, hi); return *reinterpret_cast<unsigned*>(&v); }
__device__ __forceinline__ int v_st(int k, int c) { const int kk = (k & ~0xC) | ((k & 4) << 1) | ((k & 8) >> 1); return ((kk >> 3) * 4 + (c >> 5)) * 512 + ((kk & 7) * 32 + (c & 31)) * 2; }
__device__ __forceinline__ int v_rd_base(int lane) { return ((lane & 3) << 3) | (((lane >> 2) & 3) << 6) | (((lane >> 4) & 1) << 5) | (((lane >> 5) & 1) << 8); }
constexpr int v_rd_off(int d0, int ks, int half) { return d0 * 512 + ks * 4096 + half * 2048; }
template <int OFF> __device__ __forceinline__ s16x4 tr_read(int vb) { s16x4 r; asm volatile("ds_read_b64_tr_b16 %0, %1 offset:%2" : "=&v"(r) : "v"(vb), "i"(OFF) : "memory"); return r; }
__device__ __forceinline__ h8 mk8(s16x4 l, s16x4 h) { typedef short s16x8 __attribute__((ext_vector_type(8))); s16x8 w = {l[0], l[1], l[2], l[3], h[0], h[1], h[2], h[3]}; return *reinterpret_cast<h8*>(&w); }
template <int D0> __device__ __forceinline__ void pv_one(f32x16& od, int vb, h8 pa0, h8 pa1, h8 pa2, h8 pa3) {
    const s16x4 l0 = tr_read<v_rd_off(D0, 0, 0)>(vb), h0 = tr_read<v_rd_off(D0, 0, 1)>(vb), l1 = tr_read<v_rd_off(D0, 1, 0)>(vb), h1 = tr_read<v_rd_off(D0, 1, 1)>(vb);
    const s16x4 l2 = tr_read<v_rd_off(D0, 2, 0)>(vb), h2 = tr_read<v_rd_off(D0, 2, 1)>(vb), l3 = tr_read<v_rd_off(D0, 3, 0)>(vb), h3 = tr_read<v_rd_off(D0, 3, 1)>(vb);
    asm volatile("s_waitcnt lgkmcnt(0)" ::: "memory"); AT_SBAR();
    od = __builtin_amdgcn_mfma_f32_32x32x16_f16(pa0, mk8(l0, h0), od, 0, 0, 0);
    od = __builtin_amdgcn_mfma_f32_32x32x16_f16(pa1, mk8(l1, h1), od, 0, 0, 0);
    od = __builtin_amdgcn_mfma_f32_32x32x16_f16(pa2, mk8(l2, h2), od, 0, 0, 0);
    od = __builtin_amdgcn_mfma_f32_32x32x16_f16(pa3, mk8(l3, h3), od, 0, 0, 0);
}
__device__ __forceinline__ void pv_d0(f32x16 (&o)[4], int vb, h8 pa0, h8 pa1, h8 pa2, h8 pa3) {
    pv_one<0>(o[0], vb, pa0, pa1, pa2, pa3); pv_one<1>(o[1], vb, pa0, pa1, pa2, pa3); pv_one<2>(o[2], vb, pa0, pa1, pa2, pa3); pv_one<3>(o[3], vb, pa0, pa1, pa2, pa3);
}
__device__ __forceinline__ void qkt(f32x16& p0, f32x16& p1, const char* Ks, const h8 (&qr)[8], int r32, int hi) {
    p0 = f32x16{}; p1 = f32x16{};
#pragma unroll
    for (int d0 = 0; d0 < 8; ++d0) { const int cb = (d0 * 16 + hi * 8) * 2;
        const h8 b0 = *reinterpret_cast<const h8*>(Ks + AT_KSWZ(r32, cb));
        const h8 b1 = *reinterpret_cast<const h8*>(Ks + AT_KSWZ(32 + r32, cb));
        p0 = __builtin_amdgcn_mfma_f32_32x32x16_f16(b0, qr[d0], p0, 0, 0, 0);
        p1 = __builtin_amdgcn_mfma_f32_32x32x16_f16(b1, qr[d0], p1, 0, 0, 0); }
}
__device__ __forceinline__ void pack_p(const f32x16& p0, const f32x16& p1, h8& pa0, h8& pa1, h8& pa2, h8& pa3) {
#define AT_PK4(P, BASE, OUT) do { unsigned a0 = cvtpk(P[BASE + 0], P[BASE + 1]), a1 = cvtpk(P[BASE + 2], P[BASE + 3]); \
    unsigned b0 = cvtpk(P[BASE + 4], P[BASE + 5]), b1 = cvtpk(P[BASE + 6], P[BASE + 7]); \
    auto r0 = __builtin_amdgcn_permlane32_swap(a0, b0, false, false); auto r1 = __builtin_amdgcn_permlane32_swap(a1, b1, false, false); \
    u32x4 w = {r0[0], r1[0], r0[1], r1[1]}; OUT = *reinterpret_cast<h8*>(&w); } while (0)
    AT_PK4(p0, 0, pa0); AT_PK4(p0, 8, pa1); AT_PK4(p1, 0, pa2); AT_PK4(p1, 8, pa3);
#undef AT_PK4
}
__device__ __forceinline__ float half_swap_max(float v) { auto rr = __builtin_amdgcn_permlane32_swap(__float_as_uint(v), __float_as_uint(v), false, false); return fmaxf(__uint_as_float(rr[0]), __uint_as_float(rr[1])); }
__device__ __forceinline__ float half_swap_sum(float v) { auto rr = __builtin_amdgcn_permlane32_swap(__float_as_uint(v), __float_as_uint(v), false, false); return __uint_as_float(rr[0]) + __uint_as_float(rr[1]); }

struct Stage4 { h8 vs0, vs1, ks0, ks1; };
__device__ __forceinline__ int hidden_tid() { int tz = threadIdx.x; asm volatile("" : "+v"(tz)); return tz; }
__device__ __forceinline__ void sload(Stage4& s, const _Float16* Kb, const _Float16* Vb, int ld, int k0) {
    const int tz = hidden_tid(), sr = tz >> 4, sc = (tz & 15) * 8;
    s.vs0 = *(const h8*)(Vb + (size_t)(k0 + sr) * ld + sc); s.vs1 = *(const h8*)(Vb + (size_t)(k0 + 32 + sr) * ld + sc);
    s.ks0 = *(const h8*)(Kb + (size_t)(k0 + sr) * ld + sc); s.ks1 = *(const h8*)(Kb + (size_t)(k0 + 32 + sr) * ld + sc);
}
__device__ __forceinline__ void swrite(const Stage4& s, char* V_lds, char* K_lds, int b) {
    const int tz = hidden_tid(), sr = tz >> 4, sc = (tz & 15) * 8, vst0 = v_st(sr, sc), vst1 = v_st(32 + sr, sc);
    *(h8*)(V_lds + b * SHM_V + vst0) = s.vs0; *(h8*)(V_lds + b * SHM_V + vst1) = s.vs1;
    const int kc = sc * 2;
    *(h8*)(K_lds + b * SHM_K + AT_KSWZ(sr, kc)) = s.ks0; *(h8*)(K_lds + b * SHM_K + AT_KSWZ(32 + sr, kc)) = s.ks1;
}

__device__ __forceinline__ void attn_unit(char* lds, const _Float16* qrow, const _Float16* Kb, const _Float16* Vb, int ld, unsigned tmask, int klo, int khi, unsigned selmask,
                                          float* outw, int ostride) {
    const int tid = threadIdx.x, wid = __builtin_amdgcn_readfirstlane(tid >> 6), lane = tid & 63, r32 = lane & 31, hi = lane >> 5;
    char* V_lds = lds; char* K_lds = lds + 2 * SHM_V;
    float* wsf = (float*)(lds + LDS_WS) + wid * 64; float* li_l = wsf; float* al_l = wsf + 32;
    float m_reg = -1e30f, l_reg = 0.f; f32x16 o[4] = {}; h8 qr[8];
#pragma unroll
    for (int d0 = 0; d0 < 8; ++d0) qr[d0] = *(const h8*)(qrow + d0 * 16);
    const int vb0 = (int)(uintptr_t)V_lds + v_rd_base(lane);
    Stage4 st;
    unsigned rest = tmask; int j = __ffs(rest) - 1; rest &= rest - 1;
    sload(st, Kb, Vb, ld, j * 64); asm volatile("s_waitcnt vmcnt(0)" ::: "memory"); swrite(st, V_lds, K_lds, 0); __syncthreads();
    int buf = 0;
    for (;;) {
        const int jn = rest ? (__ffs(rest) - 1) : -1;
        if (jn >= 0) sload(st, Kb, Vb, ld, jn * 64);
        f32x16 p0, p1;
        AT_SBAR(); qkt(p0, p1, K_lds + buf * SHM_K, qr, r32, hi);
        { const int kb = j * 64 + 4 * hi; const bool tb = (selmask >> j) & 1u;
#pragma unroll
          for (int r = 0; r < 16; ++r) { const int k0 = kb + (r & 3) + 8 * (r >> 2);
              p0[r] = (tb && k0 >= klo && k0 <= khi) ? p0[r] : -INFINITY;
              p1[r] = (tb && (k0 + 32) >= klo && (k0 + 32) <= khi) ? p1[r] : -INFINITY; } }
        float pmax = p0[0];
#pragma unroll
        for (int r = 1; r < 16; ++r) pmax = fmaxf(pmax, p0[r]);
#pragma unroll
        for (int r = 0; r < 16; ++r) pmax = fmaxf(pmax, p1[r]);
        pmax = half_swap_max(pmax);
        float mn, alpha;
        if (__all(pmax - m_reg <= THR_RAW)) { mn = m_reg; alpha = 1.f; }
        else { mn = fmaxf(m_reg, pmax); alpha = __builtin_amdgcn_exp2f((m_reg - mn) * CEXP); m_reg = mn; }
        const float mnC = -mn * CEXP;
        float ps = 0.f;
#pragma unroll
        for (int r = 0; r < 16; ++r) { p0[r] = __builtin_amdgcn_exp2f(fmaf(p0[r], CEXP, mnC)); ps += p0[r]; }
#pragma unroll
        for (int r = 0; r < 16; ++r) { p1[r] = __builtin_amdgcn_exp2f(fmaf(p1[r], CEXP, mnC)); ps += p1[r]; }
        ps = half_swap_sum(ps);
        l_reg = l_reg * alpha + ps;
        if (__any(alpha < 1.f)) { if (hi == 0) al_l[r32] = alpha; asm volatile("s_waitcnt lgkmcnt(0)" ::: "memory");
#pragma unroll
            for (int r = 0; r < 16; ++r) { const float a = al_l[crow(r, hi)];
#pragma unroll
                for (int d = 0; d < 4; ++d) o[d][r] *= a; } }
        h8 pa0, pa1, pa2, pa3; pack_p(p0, p1, pa0, pa1, pa2, pa3);
        AT_SBAR();
        pv_d0(o, vb0 + buf * SHM_V, pa0, pa1, pa2, pa3);
        if (jn < 0) break;
        asm volatile("s_waitcnt vmcnt(0)" ::: "memory");
        swrite(st, V_lds, K_lds, buf ^ 1);
        __syncthreads();
        buf ^= 1; j = jn; rest &= rest - 1;
    }
    if (hi == 0) li_l[r32] = l_reg; asm volatile("s_waitcnt lgkmcnt(0)" ::: "memory");
#pragma unroll
    for (int r = 0; r < 16; ++r) { const int orow = crow(r, hi); const float l = li_l[orow]; const float rl = l > 0.f ? 1.f / l : 0.f;
#pragma unroll
        for (int d0 = 0; d0 < 4; ++d0) outw[(size_t)orow * ostride + d0 * 32 + r32] = o[d0][r] * rl; }
    __syncthreads();
}

constexpr int LDS_AP = LDS_END, LDS_BP = LDS_AP + 4 * 64 * 33 * 4, LDS_SELM = LDS_BP + 4 * 64 * 33 * 4, LDS_CS_END = LDS_SELM + 64 * 4;
__device__ __forceinline__ void cmp_slc_unit(char* lds, const _Float16* qrow, const _Float16* Kc, const _Float16* Vc, const _Float16* Ks, const _Float16* Vs, int t, int tl, int g, int qi,
                                             float* outc, float* outs) {
    const int tid = threadIdx.x, wid = __builtin_amdgcn_readfirstlane(tid >> 6), lane = tid & 63, r32 = lane & 31, hi = lane >> 5;
    char* V_lds = lds; char* K_lds = lds + 2 * SHM_V;
    float* AP = (float*)(lds + LDS_AP); float* BP = (float*)(lds + LDS_BP); unsigned* selm = (unsigned*)(lds + LDS_SELM);
    {
        h8 qr[8];
#pragma unroll
        for (int d0 = 0; d0 < 8; ++d0) qr[d0] = *(const h8*)(qrow + d0 * 16);
        const int vb0 = (int)(uintptr_t)V_lds + v_rd_base(lane);
        { Stage4 s0, s1; sload(s0, Kc, Vc, 256, 0); sload(s1, Kc, Vc, 256, 64);
          asm volatile("s_waitcnt vmcnt(0)" ::: "memory");
          swrite(s0, V_lds, K_lds, 0); swrite(s1, V_lds, K_lds, 1); }
        __syncthreads();
        f32x16 pA0, pA1, pB0, pB1;
        AT_SBAR(); qkt(pA0, pA1, K_lds, qr, r32, hi); qkt(pB0, pB1, K_lds + SHM_K, qr, r32, hi);
        const int khi = t >= 31 ? ((t - 31) >> 4) : -1;
#pragma unroll
        for (int r = 0; r < 16; ++r) { const int c0 = 4 * hi + (r & 3) + 8 * (r >> 2);
            pA0[r] = (c0 <= khi) ? pA0[r] : -INFINITY; pA1[r] = (c0 + 32 <= khi) ? pA1[r] : -INFINITY;
            pB0[r] = (c0 + 64 <= khi) ? pB0[r] : -INFINITY; pB1[r] = (c0 + 96 <= khi) ? pB1[r] : -INFINITY; }
        float pmax = -INFINITY;
#pragma unroll
        for (int r = 0; r < 16; ++r) pmax = fmaxf(fmaxf(pmax, pA0[r]), fmaxf(pA1[r], fmaxf(pB0[r], pB1[r])));
        pmax = half_swap_max(pmax);
        const float mC = (pmax == -INFINITY) ? 0.f : -pmax * CEXP;
        float ps = 0.f;
#pragma unroll
        for (int r = 0; r < 16; ++r) { pA0[r] = __builtin_amdgcn_exp2f(fmaf(pA0[r], CEXP, mC)); pA1[r] = __builtin_amdgcn_exp2f(fmaf(pA1[r], CEXP, mC));
            pB0[r] = __builtin_amdgcn_exp2f(fmaf(pB0[r], CEXP, mC)); pB1[r] = __builtin_amdgcn_exp2f(fmaf(pB1[r], CEXP, mC)); ps += (pA0[r] + pA1[r]) + (pB0[r] + pB1[r]); }
        ps = half_swap_sum(ps);
        const float inv = ps > 0.f ? 1.f / ps : 0.f;
#pragma unroll
        for (int r = 0; r < 16; ++r) { pA0[r] *= inv; pA1[r] *= inv; pB0[r] *= inv; pB1[r] *= inv; }
        { float* ap = AP + (g * 64 + tl) * 33; float* bp = BP + (g * 64 + tl) * 33;
          if (hi == 0) bp[0] = 0.f;
#define AT_IMP(P, JB) do { _Pragma("unroll") for (int k = 0; k < 4; ++k) { const int j = (JB) + 2 * k + hi; \
              ap[j] = 2.f * (P[4 * k] + P[4 * k + 1] + P[4 * k + 2]) + P[4 * k + 3]; if (j + 1 < 32) bp[j + 1] = P[4 * k + 3]; } } while (0)
          AT_IMP(pA0, 0); AT_IMP(pA1, 8); AT_IMP(pB0, 16); AT_IMP(pB1, 24);
#undef AT_IMP
        }
        f32x16 o[4] = {};
        h8 pa0, pa1, pa2, pa3;
        pack_p(pA0, pA1, pa0, pa1, pa2, pa3); AT_SBAR(); pv_d0(o, vb0, pa0, pa1, pa2, pa3);
        pack_p(pB0, pB1, pa0, pa1, pa2, pa3); AT_SBAR(); pv_d0(o, vb0 + SHM_V, pa0, pa1, pa2, pa3);
#pragma unroll
        for (int r = 0; r < 16; ++r) { const int orow = crow(r, hi);
#pragma unroll
            for (int d0 = 0; d0 < 4; ++d0) outc[(size_t)orow * 1024 + d0 * 32 + r32] = o[d0][r]; }
    }
    __syncthreads();
#pragma unroll 1
    for (int it = 0; it < 4; ++it) {
        const int tk = 8 * wid + 2 * it + hi, j = r32;
        float imp = 0.f;
#pragma unroll
        for (int gg = 0; gg < 4; ++gg) imp += AP[(gg * 64 + tk) * 33 + j] + BP[(gg * 64 + tk) * 33 + j];
        const bool forced = (j == 0) || (j == qi) || (j == qi - 1), valid = j <= qi;
        const float iv = forced ? 1e9f : (valid ? imp : -1e9f);
        int rank = 0;
        for (int i = 0; i < 32; ++i) { const float vi = __shfl(iv, i + 32 * hi); rank += (vi > iv || (vi == iv && i < j)) ? 1 : 0; }
        const unsigned long long bal = __ballot(rank < 16 && valid);
        if (r32 == 0) selm[tk] = (unsigned)(bal >> (32 * hi));
    }
    __syncthreads();
    unsigned tm = selm[lane];
#pragma unroll
    for (int o = 32; o > 0; o >>= 1) tm |= __shfl_xor(tm, o);
    const int tz2 = hidden_tid();
    const unsigned mysel = selm[((tz2 >> 6) & 1) * 32 + (tz2 & 31)];
    attn_unit(lds, qrow, Ks, Vs, INW, tm, 0, t, mysel, outs, 1024);
}
}

__device__ __forceinline__ void conv_tile(float* lds, const float* __restrict__ W, int ldw, int nvalid, _Float16* __restrict__ Wt, int K, int k0, int n0) {
    const int tid = threadIdx.x;
    float4 v[8];
#pragma unroll
    for (int i = 0; i < 8; ++i) { const int idx = tid + 512 * i, r = idx >> 6, c4 = (idx & 63) * 4;
        v[i] = (n0 + c4 < nvalid) ? *(const float4*)(W + (size_t)(k0 + r) * ldw + n0 + c4) : make_float4(0.f, 0.f, 0.f, 0.f); }
#pragma unroll
    for (int i = 0; i < 8; ++i) { const int idx = tid + 512 * i, r = idx >> 6, c4 = (idx & 63) * 4; float* d = lds + r * 257 + c4; d[0] = v[i].x; d[1] = v[i].y; d[2] = v[i].z; d[3] = v[i].w; }
    __syncthreads();
#pragma unroll
    for (int j = 0; j < 4; ++j) { const int id = tid + 512 * j, n = id >> 3, k8 = (id & 7) * 8; h8 o;
#pragma unroll
        for (int q = 0; q < 8; ++q) o[q] = (_Float16)lds[(k8 + q) * 257 + n];
        *(h8*)(Wt + (size_t)(n0 + n) * K + k0 + k8) = o; }
    __syncthreads();
}


__device__ __forceinline__ unsigned pack4_i8(float a, float b, float c, float d) {
    const int ia = __float2int_rn(a), ib = __float2int_rn(b), ic = __float2int_rn(c), id = __float2int_rn(d);
    return (unsigned)(ia & 255) | ((unsigned)(ib & 255) << 8) | ((unsigned)(ic & 255) << 16) | ((unsigned)(id & 255) << 24);
}
constexpr int QP_LD = 2052;
__device__ __forceinline__ void quant_panel(char* smem, const float* __restrict__ W, int ldw, int n0, signed char* __restrict__ Q, float* __restrict__ scale) {
    _Float16* Tt = (_Float16*)smem;
    unsigned* cmax = (unsigned*)(smem + 32 * QP_LD * 2);
    const int tid = threadIdx.x;
    if (tid < 32) cmax[tid] = 0u;
    __syncthreads();
    const int c4 = (tid & 7) * 4, kr = tid >> 3;
    float m0 = 0.f, m1 = 0.f, m2 = 0.f, m3 = 0.f;
#pragma unroll 1
    for (int pass = 0; pass < 32; pass += 8) {
        float4 v[8];
#pragma unroll
        for (int j = 0; j < 8; ++j) v[j] = *(const float4*)(W + (size_t)((pass + j) * 64 + kr) * ldw + n0 + c4);
#pragma unroll
        for (int j = 0; j < 8; ++j) { const int k = (pass + j) * 64 + kr;
            Tt[(c4 + 0) * QP_LD + k] = (_Float16)v[j].x; Tt[(c4 + 1) * QP_LD + k] = (_Float16)v[j].y; Tt[(c4 + 2) * QP_LD + k] = (_Float16)v[j].z; Tt[(c4 + 3) * QP_LD + k] = (_Float16)v[j].w;
            m0 = fmaxf(m0, fabsf(v[j].x)); m1 = fmaxf(m1, fabsf(v[j].y)); m2 = fmaxf(m2, fabsf(v[j].z)); m3 = fmaxf(m3, fabsf(v[j].w)); }
    }
    atomicMax(&cmax[c4 + 0], __float_as_uint(m0)); atomicMax(&cmax[c4 + 1], __float_as_uint(m1)); atomicMax(&cmax[c4 + 2], __float_as_uint(m2)); atomicMax(&cmax[c4 + 3], __float_as_uint(m3));
    __syncthreads();
#pragma unroll
    for (int j = 0; j < 8; ++j) { const int id = tid + 512 * j, n = id >> 7, k16 = (id & 127) * 16;
        const float mx = __uint_as_float(cmax[n]); const float inv = mx > 0.f ? 127.f / mx : 0.f;
        const h4* src = (const h4*)(Tt + n * QP_LD + k16);
        const h4 a = src[0], b = src[1], c = src[2], d = src[3];
        uint4 o;
        o.x = pack4_i8((float)a[0] * inv, (float)a[1] * inv, (float)a[2] * inv, (float)a[3] * inv); o.y = pack4_i8((float)b[0] * inv, (float)b[1] * inv, (float)b[2] * inv, (float)b[3] * inv);
        o.z = pack4_i8((float)c[0] * inv, (float)c[1] * inv, (float)c[2] * inv, (float)c[3] * inv); o.w = pack4_i8((float)d[0] * inv, (float)d[1] * inv, (float)d[2] * inv, (float)d[3] * inv);
        *(uint4*)(Q + (size_t)(n0 + n) * 2048 + k16) = o; }
    if (tid < 32) { const float mx = __uint_as_float(cmax[tid]); scale[n0 + tid] = mx > 0.f ? mx / 127.f : 1.f; }
    __syncthreads();
}

__global__ void __launch_bounds__(512, 2) fwd(Params p) {
    extern __shared__ __attribute__((aligned(16))) char smem[];
    const int tid = threadIdx.x, lane = tid & 63, wv = __builtin_amdgcn_readfirstlane(tid >> 6);
    const int bid = blockIdx.x, nb = gridDim.x;
    const int gw = bid * 8 + wv, nw = nb * 8;
    const int lo = (int)(p.lo_hi & 0xffffffffll), hi = (int)(p.lo_hi >> 32);
    unsigned char* ws = p.ws;
    unsigned* ctl = (unsigned*)(ws + WS_CTL);
    int* cnt = (int*)(ws + CTL_CNT);
    float* proj = (float*)(ws + WS_PROJ);
    float* kvmem = (float*)(ws + WS_KVMEM);
    float* bias1 = (float*)(ws + WS_BIAS1);
    float* hid = (float*)(ws + WS_HID);
    float* kc = (float*)(ws + WS_KC);
    float* vc = (float*)(ws + WS_VC);
    float* pooled = (float*)(ws + WS_POOLED);
    float* opool = (float*)(ws + WS_OPOOL);
    float* owin = (float*)(ws + WS_OWIN);
    float* ocmp = (float*)(ws + WS_OCMP);
    float* oslc = (float*)(ws + WS_OSLC);
    unsigned* sel = (unsigned*)(ws + WS_SEL);
    float* omem = (float*)(ws + WS_OMEM);
    _Float16* cat16 = (_Float16*)(ws + WS_CAT16);
    float* hpre = (float*)(ws + WS_HPRE);
    float* hbuf = (float*)(ws + WS_H);
    float* gate = (float*)(ws + WS_GATE);
    int* list = (int*)(ws + WS_LIST);
    _Float16* act16 = (_Float16*)(ws + WS_ACT16);
    _Float16* y16 = (_Float16*)(ws + WS_Y16);
    _Float16* h16 = (_Float16*)(ws + WS_H16);
    _Float16* x16 = (_Float16*)(ws + WS_X16);
    _Float16* wtin = (_Float16*)(ws + WS_WTIN);
    _Float16* wtout = (_Float16*)(ws + WS_WTOUT);
    _Float16* wtgu = (_Float16*)(ws + WS_WTGU);
    _Float16* wtdn = (_Float16*)(ws + WS_WTDN);
    LAS unsigned char* lds = (LAS unsigned char*)smem;
    _Float16* proj16 = (_Float16*)(ws + WS_PROJ16);
    _Float16* kvmem16 = (_Float16*)(ws + WS_KVMEM16);
    _Float16* wt1 = (_Float16*)(ws + WS_WT1);
    float* uv = (float*)(ws + WS_UV);
    _Float16* kc16 = (_Float16*)(ws + WS_KC16);
    _Float16* vc16 = (_Float16*)(ws + WS_VC16);
    _Float16* wr16 = (_Float16*)(ws + WS_WR16);
    signed char* q8gu = (signed char*)(ws + WS_Q8GU); signed char* q8dn = (signed char*)(ws + WS_Q8DN);
    float* sgu = (float*)(ws + WS_SGU); float* sdn = (float*)(ws + WS_SDN);
    signed char* h8q = (signed char*)(ws + WS_H8); float* sah = (float*)(ws + WS_SAH);
    signed char* act8 = (signed char*)(ws + WS_ACT8); float* sact = (float*)(ws + WS_SACT);
    const int vcu = (nb % 8 == 0) ? (bid % 8) * (nb / 8) + bid / 8 : bid;

    volatile LAS unsigned* xbw = (volatile LAS unsigned*)(smem + LDS_BYTES - 16);
    if (tid == 0) { xbw[0] = 0u; xbw[1] = 0u; xbw[2] = 0u; xbw[3] = 0u; }
    __syncthreads();
    XcdBarrier bar; bar.bar = ctl; bar.x = 0; bar.st = xbw;
    const bool multi = (hi - lo) > 1;
    if (multi) bar = xcd_barrier_post(ctl, xbw);
#define IN(k) (lo <= (k) && (k) < hi)
#define SEAM(k) do { if (IN(k) && IN((k) + 1)) xcd_barrier(bar); } while (0)
    float* sw = (float*)smem + wv * WLDS_FLOATS;
    int* segw = (int*)(sw + 4096 + 512);

    if (IN(0)) {
        for (int j = gw; j < 512; j += nw) {
            const int kv = j >> 8, jj = j & 255;
            const float* pos = p.in[kv ? I_POSV : I_POSK]; const float* w1 = p.in[kv ? I_W1V : I_W1K];
            float s = 0.f;
            for (int k = lane; k < 4096; k += 64) s += pos[k] * w1[(size_t)k * 256 + jj];
            s = wave_sum(s);
            if (lane == 0) bias1[j] = s;
        }
        for (int i = bid * 512 + tid; i < 32 * 2048; i += nb * 512) { const int e = i >> 11, d = i & 2047; wr16[i] = (_Float16)p.in[I_WR][(size_t)d * 32 + e]; }
        for (size_t i = (size_t)bid * 512 + tid; i < (size_t)T_ * 2048 / 4; i += (size_t)nb * 512) {
            const float4 v = ((const float4*)p.in[I_X])[i]; ((h4*)x16)[i] = (h4){(_Float16)v.x, (_Float16)v.y, (_Float16)v.z, (_Float16)v.w};
        }
        {
            constexpr int U_GU = NE * 128, U_DN = NE * 64, U_IN = 32 * 15, U_OUT = 32 * 8, U_W1 = 128;
            for (int u = bid; u < U_GU + U_DN; u += nb) {
                if (u < U_GU) { const int e = u >> 7, pn = u & 127;
                    quant_panel(smem, p.in[I_WGU] + (size_t)e * 2048 * 4096, 4096, pn * 32, q8gu + (size_t)e * 4096 * 2048, sgu + (size_t)e * 4096);
                } else { const int v = u - U_GU, e = v >> 6, pn = v & 63;
                    quant_panel(smem, p.in[I_WDN] + (size_t)e * 2048 * 2048, 2048, pn * 32, q8dn + (size_t)e * 2048 * 2048, sdn + (size_t)e * 2048);
                }
            }
            for (int u = bid; u < U_IN + U_OUT + U_W1; u += nb) {
                if (u < U_IN) { const int v = u, kt = v / 15, ntl = v % 15;
                    conv_tile((float*)smem, p.in[I_WIN], INW, INW, wtin, 2048, kt * 64, ntl * 256);
                } else if (u < U_IN + U_OUT) { const int v = u - U_IN, kt = v / 8, ntl = v % 8;
                    conv_tile((float*)smem, p.in[I_WOUT], 2048, 2048, wtout, 2048, kt * 64, ntl * 256);
                } else { const int v = u - U_IN - U_OUT, kv = v >> 6, part = (v >> 5) & 1, kt = v & 31;
                    conv_tile((float*)smem, p.in[kv ? I_W1V : I_W1K] + (size_t)part * 2048 * 256, 256, 256, wt1 + ((size_t)kv * 512 + part * 256) * 2048, 2048, kt * 64, 0);
                }
            }
        }
        for (int u = bid; u < 16 * 8; u += nb) { const int nt = u / 16, mt = u % 16;
            ARowPlain af{p.in[I_MEM], 2048, mt * 128, 2048}; EpiStore ef{kvmem, 1024, mt * 128, nt * 128, 2048, 1024, kvmem16};
            gemm_tile(smem, 2048, af, p.in[I_WMEMKV], 1024, nt * 128, 1024, false, ef);
        }
    }
    SEAM(0);
    if (IN(1)) {
        g8::ProbIn P{x16, wtin, proj16, nb, bid};
        g8::gemm_phase(lds, P);
    }
    SEAM(1);
    if (IN(2)) {
        { g8::ProbCmp P{proj16, wt1, uv, nb, bid}; g8::gemm_phase(lds, P); __syncthreads(); }
        for (size_t i = (size_t)bid * 512 + tid; i < (size_t)T_ * 512; i += (size_t)nb * 512) {
            const int col = (int)(i & 511), row = (int)(i >> 9), t = row & (S_ - 1), g = col >> 7;
            const int win = 2 << g; const int lo_t = max(t + 1 - win, 0); const int n = t + 1 - lo_t;
            float s = 0.f;
            for (int k = 0; k < n; ++k) s += (float)proj16[(size_t)(row - k) * INW + C_UP + col];
            pooled[i] = s / (float)n - (float)proj16[(size_t)row * INW + C_UP + col];
        }
        {
            const int r32 = lane & 31, hi = lane >> 5, g = wv >> 1, half = wv & 1;
            for (int uu = bid; uu < 512; uu += nb) {
                const int u = (uu & 1) ? (511 - (uu >> 1)) : (uu >> 1);
                const int bk = u >> 5, qi = u & 31, b = bk >> 1, kvh = bk & 1;
                const int t = qi * 64 + half * 32 + r32;
                const int lo_t = max(0, qi - 8);
                const unsigned tmask = (unsigned)(((1ull << (qi + 1)) - 1ull) & ~((1ull << lo_t) - 1ull));
                at8::attn_unit(smem, proj16 + (size_t)(b * S_ + t) * INW + C_Q + (kvh * 4 + g) * 128 + hi * 8,
                               proj16 + (size_t)b * S_ * INW + C_KW + kvh * 128, proj16 + (size_t)b * S_ * INW + C_VW + kvh * 128, INW, tmask, t - 511, t, 0xffffffffu,
                               owin + (size_t)(b * S_ + qi * 64 + half * 32) * 1024 + (kvh * 4 + g) * 128, 1024);
            }
            for (int u = bid; u < 256; u += nb) {
                const int b = u >> 5, h = (u >> 3) & 3, qt = u & 7;
                const int t = qt * 256 + wv * 32 + r32;
                at8::attn_unit(smem, proj16 + (size_t)(b * S_ + t) * INW + C_QM + h * 128 + hi * 8,
                               kvmem16 + (size_t)b * 256 * 1024 + h * 128, kvmem16 + (size_t)b * 256 * 1024 + 512 + h * 128, 1024, 0xFu, 0, 255, 0xffffffffu,
                               omem + (size_t)(b * S_ + qt * 256 + wv * 32) * 512 + h * 128, 512);
            }
        }
    }
    SEAM(2);
    if (IN(3)) {
        {   float* hs = (float*)smem;
            for (int u = bid; u < 508; u += nb) {
                const int kv = u / 254, ub = u % 254;
                const float* w2 = p.in[kv ? I_W2V : I_W2K]; _Float16* dst = kv ? vc16 : kc16;
                __syncthreads();
#pragma unroll
                for (int q = 0; q < 4; ++q) { const int e = tid + 512 * q, i = e >> 8, n = e & 255;
                    const int idx = ub * 8 + i, b = idx / 254, rem = idx % 254, c = rem >> 1, kvh = rem & 1;
                    const int row = (b * 128 + c) * 2 + kvh;
                    float a = bias1[kv * 256 + n];
#pragma unroll
                    for (int sp = 0; sp < 4; ++sp) { const float* base = uv + ((size_t)(kv * 4 + sp) * 2048) * 512; a += base[(size_t)row * 512 + n] + base[(size_t)(row + 2) * 512 + 256 + n]; }
                    hs[i * 256 + n] = gelu_tanh(a); }
                __syncthreads();
#pragma unroll
                for (int q = 0; q < 2; ++q) { const int e = tid + 512 * q, i = e >> 7, d = e & 127;
                    const int idx = ub * 8 + i, b = idx / 254, rem = idx % 254, c = rem >> 1, kvh = rem & 1;
                    float a = 0.f;
                    for (int n = 0; n < 256; ++n) a += hs[i * 256 + n] * w2[n * 128 + d];
                    dst[(size_t)((b * 128 + c) * 2 + kvh) * 128 + d] = (_Float16)a; }
            }
            __syncthreads();
            for (int i = bid * 512 + tid; i < 2 * B_ * 256; i += nb * 512) { const int kv = i / (B_ * 256), r = i % (B_ * 256), b = r >> 8, x = r & 255;
                (kv ? vc16 : kc16)[(size_t)(b * 128 + 127) * 256 + x] = (_Float16)0.f; }
        }
        for (int u = bid; u < 128 * 4; u += nb) { const int g = u >> 7, mt = u & 127;
            ARowPlain af{pooled + g * 128, 512, mt * 128, T_}; EpiPool ef{opool, p.in[I_POOLS], mt * 128, g};
            gemm_tile(smem, 128, af, p.in[I_POOLW] + (size_t)g * 128 * 128, 128, 0, 128, false, ef);
        }
    }
    SEAM(3);
    if (IN(4)) {
        const int r32 = lane & 31, hi = lane >> 5, g = wv >> 1, half = wv & 1;
        for (int uu = bid; uu < 512; uu += nb) {
            const int u = (uu & 1) ? (511 - (uu >> 1)) : (uu >> 1);
            const int bk = u >> 5, qi = u & 31, b = bk >> 1, kvh = bk & 1;
            const int tl = half * 32 + r32, t = qi * 64 + tl;
            at8::cmp_slc_unit(smem, proj16 + (size_t)(b * S_ + t) * INW + C_Q + (kvh * 4 + g) * 128 + hi * 8,
                              kc16 + (size_t)(b * 128 * 2 + kvh) * 128, vc16 + (size_t)(b * 128 * 2 + kvh) * 128,
                              proj16 + (size_t)b * S_ * INW + C_KS + kvh * 128, proj16 + (size_t)b * S_ * INW + C_VS + kvh * 128, t, tl, g, qi,
                              ocmp + (size_t)(b * S_ + qi * 64 + half * 32) * 1024 + (kvh * 4 + g) * 128, oslc + (size_t)(b * S_ + qi * 64 + half * 32) * 1024 + (kvh * 4 + g) * 128);
        }
    }
    SEAM(4);
    if (IN(5)) {
        for (int row = gw; row < T_; row += nw) {
            const _Float16* pr = proj16 + (size_t)row * INW;
            float v[16]; float ss = 0.f;
#pragma unroll
            for (int i = 0; i < 16; ++i) { const int col = lane + 64 * i, h = col >> 7; const size_t o = (size_t)row * 1024 + col;
                const float g0 = sigmoidf_((float)pr[C_G + h * 3]), g1 = sigmoidf_((float)pr[C_G + h * 3 + 1]), g2 = sigmoidf_((float)pr[C_G + h * 3 + 2]);
                v[i] = g0 * ocmp[o] + g1 * oslc[o] + g2 * owin[o]; ss += v[i] * v[i]; }
            ss = wave_sum(ss); float r = rsqrtf(ss / 1024.f + LN_EPS);
#pragma unroll
            for (int i = 0; i < 16; ++i) { const int col = lane + 64 * i; cat16[(size_t)row * 2048 + col] = (_Float16)(v[i] * r * p.in[I_GNNSA][col]); }
            ss = 0.f;
#pragma unroll
            for (int i = 0; i < 8; ++i) { v[i] = opool[(size_t)row * 512 + lane + 64 * i]; ss += v[i] * v[i]; }
            ss = wave_sum(ss); r = rsqrtf(ss / 512.f + LN_EPS);
#pragma unroll
            for (int i = 0; i < 8; ++i) { const int col = lane + 64 * i; cat16[(size_t)row * 2048 + 1024 + col] = (_Float16)(v[i] * r * p.in[I_GNPOOL][col]); }
            ss = 0.f;
#pragma unroll
            for (int i = 0; i < 8; ++i) { v[i] = omem[(size_t)row * 512 + lane + 64 * i]; ss += v[i] * v[i]; }
            ss = wave_sum(ss); r = rsqrtf(ss / 512.f + LN_EPS);
#pragma unroll
            for (int i = 0; i < 8; ++i) { const int col = lane + 64 * i; cat16[(size_t)row * 2048 + 1536 + col] = (_Float16)(v[i] * r * p.in[I_GNMEM][col]); }
        }
    }
    SEAM(5);
    if (IN(6)) {
        g8::ProbOut P{cat16, wtout, hpre, p.in[I_X], nb, bid};
        g8::gemm_phase(lds, P);
    }
    SEAM(6);
    if (IN(7)) {
        float* lg = (float*)smem;
        const int r32 = lane & 31, hi = lane >> 5, fr = lane & 15, fq = lane >> 4;
        for (int u = bid; u < T_ / 64; u += nb) {
            const int base = u * 64;
#pragma unroll 1
            for (int i = 0; i < 8; ++i) {
                const int row = base + wv * 8 + i;
                float v[32]; float s = 0.f;
#pragma unroll
                for (int c = 0; c < 4; ++c) { const int col = (lane + 64 * c) * 8;
                    const float4 a0 = *(const float4*)(hpre + (size_t)row * 2048 + col), a1 = *(const float4*)(hpre + (size_t)row * 2048 + col + 4);
                    v[c * 8 + 0] = a0.x; v[c * 8 + 1] = a0.y; v[c * 8 + 2] = a0.z; v[c * 8 + 3] = a0.w; v[c * 8 + 4] = a1.x; v[c * 8 + 5] = a1.y; v[c * 8 + 6] = a1.z; v[c * 8 + 7] = a1.w;
                    s += ((a0.x + a0.y) + (a0.z + a0.w)) + ((a1.x + a1.y) + (a1.z + a1.w)); }
                const float mu = wave_sum(s) / 2048.f; float q2 = 0.f;
#pragma unroll
                for (int k = 0; k < 32; ++k) { const float d = v[k] - mu; q2 += d * d; }
                const float rs = rsqrtf(wave_sum(q2) / 2048.f + LN_EPS);
                float amax = 0.f;
#pragma unroll
                for (int c = 0; c < 4; ++c) { const int col = (lane + 64 * c) * 8;
                    const float4 g0 = *(const float4*)(p.in[I_LN1G] + col), g1 = *(const float4*)(p.in[I_LN1G] + col + 4), b0 = *(const float4*)(p.in[I_LN1B] + col), b1 = *(const float4*)(p.in[I_LN1B] + col + 4);
                    float4 o0, o1;
                    o0.x = (v[c * 8 + 0] - mu) * rs * g0.x + b0.x; o0.y = (v[c * 8 + 1] - mu) * rs * g0.y + b0.y; o0.z = (v[c * 8 + 2] - mu) * rs * g0.z + b0.z; o0.w = (v[c * 8 + 3] - mu) * rs * g0.w + b0.w;
                    o1.x = (v[c * 8 + 4] - mu) * rs * g1.x + b1.x; o1.y = (v[c * 8 + 5] - mu) * rs * g1.y + b1.y; o1.z = (v[c * 8 + 6] - mu) * rs * g1.z + b1.z; o1.w = (v[c * 8 + 7] - mu) * rs * g1.w + b1.w;
                    *(float4*)(hbuf + (size_t)row * 2048 + col) = o0; *(float4*)(hbuf + (size_t)row * 2048 + col + 4) = o1;
                    h8 oh; oh[0] = (_Float16)o0.x; oh[1] = (_Float16)o0.y; oh[2] = (_Float16)o0.z; oh[3] = (_Float16)o0.w; oh[4] = (_Float16)o1.x; oh[5] = (_Float16)o1.y; oh[6] = (_Float16)o1.z; oh[7] = (_Float16)o1.w;
                    *(h8*)(h16 + (size_t)row * 2048 + col) = oh;
                    v[c * 8 + 0] = o0.x; v[c * 8 + 1] = o0.y; v[c * 8 + 2] = o0.z; v[c * 8 + 3] = o0.w; v[c * 8 + 4] = o1.x; v[c * 8 + 5] = o1.y; v[c * 8 + 6] = o1.z; v[c * 8 + 7] = o1.w;
                    amax = fmaxf(amax, fmaxf(fmaxf(fmaxf(fabsf(o0.x), fabsf(o0.y)), fmaxf(fabsf(o0.z), fabsf(o0.w))), fmaxf(fmaxf(fabsf(o1.x), fabsf(o1.y)), fmaxf(fabsf(o1.z), fabsf(o1.w))))); }
                amax = wave_max(amax);
                const float qinv = amax > 0.f ? 127.f / amax : 0.f;
                if (lane == 0) sah[row] = amax > 0.f ? amax / 127.f : 1.f;
#pragma unroll
                for (int c = 0; c < 4; ++c) { const int col = (lane + 64 * c) * 8;
                    uint2 q; q.x = pack4_i8(v[c * 8 + 0] * qinv, v[c * 8 + 1] * qinv, v[c * 8 + 2] * qinv, v[c * 8 + 3] * qinv); q.y = pack4_i8(v[c * 8 + 4] * qinv, v[c * 8 + 5] * qinv, v[c * 8 + 6] * qinv, v[c * 8 + 7] * qinv);
                    *(uint2*)(h8q + (size_t)row * 2048 + col) = q; }
            }
            asm volatile("s_waitcnt vmcnt(0)" ::: "memory");
            __syncthreads();
            {
                const int tok0 = base + 16 * (wv >> 1), e0 = 16 * (wv & 1);
                const _Float16* ap = h16 + (size_t)(tok0 + fr) * 2048 + fq * 8; const _Float16* bp = wr16 + (size_t)(e0 + fr) * 2048 + fq * 8;
                f4 acc = (f4){0.f, 0.f, 0.f, 0.f};
#pragma unroll 8
                for (int sI = 0; sI < 64; ++sI) { const h8 a = *(const h8*)(ap + sI * 32), bb = *(const h8*)(bp + sI * 32); acc = __builtin_amdgcn_mfma_f32_16x16x32_f16(a, bb, acc, 0, 0, 0); }
                const float br = p.in[I_BR][e0 + fr];
#pragma unroll
                for (int j = 0; j < 4; ++j) lg[(16 * (wv >> 1) + 4 * fq + j) * 33 + e0 + fr] = acc[j] + br;
            }
            __syncthreads();
#pragma unroll 1
            for (int it = 0; it < 4; ++it) {
                const int tk = 8 * wv + 2 * it + hi;
                const float iv = lg[tk * 33 + r32];
                int rank = 0;
                for (int i = 0; i < 32; ++i) { const float vi = __shfl(iv, i + 32 * hi); rank += (vi > iv || (vi == iv && i < r32)) ? 1 : 0; }
                float tv[4]; int te[4];
#pragma unroll
                for (int r = 0; r < 4; ++r) { const unsigned long long bm = __ballot(rank == r); const unsigned hm = (unsigned)(bm >> (32 * hi)); const int src = __ffs(hm) - 1; te[r] = src; tv[r] = __shfl(iv, src + 32 * hi); }
                const float e0v = 1.f, e1v = expf(tv[1] - tv[0]), e2v = expf(tv[2] - tv[0]), e3v = expf(tv[3] - tv[0]); const float inv = 1.f / (e0v + e1v + e2v + e3v);
                if (r32 < 4) { const int e = r32 == 0 ? te[0] : r32 == 1 ? te[1] : r32 == 2 ? te[2] : te[3]; const float g = (r32 == 0 ? e0v : r32 == 1 ? e1v : r32 == 2 ? e2v : e3v) * inv;
                    const int a = (base + tk) * 4 + r32; const int pos = atomicAdd(&cnt[e], 1); list[(size_t)e * T_ + pos] = a; gate[a] = g; }
            }
            __syncthreads();
        }
    }
    SEAM(7);
    LAS int* mtab = (LAS int*)(smem + g8::STAGE_BYTES);
    if (IN(8)) {
        if (tid == 0) { int ub = 0, rs = 0;
            for (int e = 0; e < NE; ++e) { const int c = (int)__hip_atomic_load((unsigned*)&cnt[e], __ATOMIC_RELAXED, __HIP_MEMORY_SCOPE_AGENT); mtab[e] = c; mtab[32 + e] = ub; mtab[65 + e] = rs; ub += ((c + 255) >> 8) * 16; rs += c; }
            mtab[64] = ub; mtab[97] = rs; mtab[98] = ub; }
        __syncthreads();
        g8::ProbGu P{h8q, q8gu, act16, p.in[I_BGU], list, sah, sgu, g8::MoeTab{mtab, 16}, nb, vcu};
        g8::gemm_phase(lds, P);
        __syncthreads();
    }
    SEAM(8);
    if (IN(9)) {
        for (int row = gw; row < NA; row += nw) {
            float v[32]; float amax = 0.f;
#pragma unroll
            for (int c = 0; c < 4; ++c) { const h8 a = *(const h8*)(act16 + (size_t)row * 2048 + (lane + 64 * c) * 8);
#pragma unroll
                for (int q = 0; q < 8; ++q) { v[c * 8 + q] = (float)a[q]; amax = fmaxf(amax, fabsf(v[c * 8 + q])); } }
            amax = wave_max(amax);
            const float qinv = amax > 0.f ? 127.f / amax : 0.f;
            if (lane == 0) sact[row] = amax > 0.f ? amax / 127.f : 1.f;
#pragma unroll
            for (int c = 0; c < 4; ++c) { uint2 q; q.x = pack4_i8(v[c * 8 + 0] * qinv, v[c * 8 + 1] * qinv, v[c * 8 + 2] * qinv, v[c * 8 + 3] * qinv); q.y = pack4_i8(v[c * 8 + 4] * qinv, v[c * 8 + 5] * qinv, v[c * 8 + 6] * qinv, v[c * 8 + 7] * qinv);
                *(uint2*)(act8 + (size_t)row * 2048 + (lane + 64 * c) * 8) = q; }
        }
    }
    SEAM(9);
    if (IN(10)) {
        if (tid == 0) { int ub = 0, rs = 0;
            for (int e = 0; e < NE; ++e) { const int c = (int)__hip_atomic_load((unsigned*)&cnt[e], __ATOMIC_RELAXED, __HIP_MEMORY_SCOPE_AGENT); mtab[e] = c; mtab[32 + e] = ub; mtab[65 + e] = rs; ub += ((c + 255) >> 8) * 8; rs += c; }
            mtab[64] = ub; mtab[97] = rs; mtab[98] = ub; }
        __syncthreads();
        g8::ProbDn P{act8, q8dn, y16, p.in[I_BDN], list, gate, sact, sdn, g8::MoeTab{mtab, 8}, nb, vcu};
        g8::gemm_phase(lds, P);
        __syncthreads();
    }
    SEAM(10);
    if (IN(11)) {
        for (int row = gw; row < T_; row += nw) {
            float v[32]; float s = 0.f;
#pragma unroll
            for (int c = 0; c < 4; ++c) { const int col = (lane + 64 * c) * 8; const size_t yo = (size_t)row * 4 * 2048 + col;
                const float4 ha = *(const float4*)(hbuf + (size_t)row * 2048 + col), hb = *(const float4*)(hbuf + (size_t)row * 2048 + col + 4);
                const h8 y0 = *(const h8*)(y16 + yo), y1 = *(const h8*)(y16 + yo + 2048), y2 = *(const h8*)(y16 + yo + 4096), y3 = *(const h8*)(y16 + yo + 6144);
                const float hh[8] = {ha.x, ha.y, ha.z, ha.w, hb.x, hb.y, hb.z, hb.w};
#pragma unroll
                for (int q = 0; q < 8; ++q) { v[c * 8 + q] = DN_ALPHA * hh[q] + (((float)y0[q] + (float)y1[q]) + ((float)y2[q] + (float)y3[q])); s += v[c * 8 + q]; } }
            const float mu = wave_sum(s) / 2048.f; float q2 = 0.f;
#pragma unroll
            for (int i = 0; i < 32; ++i) { const float d = v[i] - mu; q2 += d * d; }
            const float rs = rsqrtf(wave_sum(q2) / 2048.f + LN_EPS);
#pragma unroll
            for (int c = 0; c < 4; ++c) { const int col = (lane + 64 * c) * 8;
                const float4 ga = *(const float4*)(p.in[I_LN2G] + col), gb = *(const float4*)(p.in[I_LN2G] + col + 4), ba = *(const float4*)(p.in[I_LN2B] + col), bb = *(const float4*)(p.in[I_LN2B] + col + 4);
                float4 o0, o1;
                o0.x = (v[c * 8 + 0] - mu) * rs * ga.x + ba.x; o0.y = (v[c * 8 + 1] - mu) * rs * ga.y + ba.y; o0.z = (v[c * 8 + 2] - mu) * rs * ga.z + ba.z; o0.w = (v[c * 8 + 3] - mu) * rs * ga.w + ba.w;
                o1.x = (v[c * 8 + 4] - mu) * rs * gb.x + bb.x; o1.y = (v[c * 8 + 5] - mu) * rs * gb.y + bb.y; o1.z = (v[c * 8 + 6] - mu) * rs * gb.z + bb.z; o1.w = (v[c * 8 + 7] - mu) * rs * gb.w + bb.w;
                *(float4*)(p.out + (size_t)row * 2048 + col) = o0; *(float4*)(p.out + (size_t)row * 2048 + col + 4) = o1; }
        }
    }
}

constexpr int NPHASE = 12;

extern "C" void kernel_launch(void* const* d_in, const int* in_sizes, int n_in, void* d_out, int out_size, void* d_ws, size_t ws_size, hipStream_t stream) {
    static int grid = 0;
    if (grid == 0) {
        if (n_in != 26 || ws_size < WS_END) { fprintf(stderr, "kernel_launch: unexpected n_in %d or ws_size %zu (< %zu)\n", n_in, ws_size, (size_t)WS_END); grid = -1; return; }
        int dev = 0, cus = 0, per_cu = 0;
        hipGetDevice(&dev); hipDeviceGetAttribute(&cus, hipDeviceAttributeMultiprocessorCount, dev);
        if (hipFuncSetAttribute((const void*)fwd, hipFuncAttributeMaxDynamicSharedMemorySize, LDS_BYTES) != hipSuccess) { fprintf(stderr, "hipFuncSetAttribute failed\n"); grid = -1; return; }
        hipOccupancyMaxActiveBlocksPerMultiprocessor(&per_cu, (const void*)fwd, 512, LDS_BYTES);
        (void)hipGetLastError();
        if (per_cu < 1) fprintf(stderr, "occupancy query says %d blocks per CU\n", per_cu);
        grid = cus > 0 ? cus : 256;
    }
    if (grid < 0) return;
    hipMemsetAsync((char*)d_ws + WS_CTL, 0, CTL_BYTES, stream);
    Params p{};
    for (int i = 0; i < 26; ++i) p.in[i] = (const float*)d_in[i];
    p.out = (float*)d_out; p.ws = (unsigned char*)d_ws;
#if N_LAUNCH_MODE == 1
    p.lo_hi = (long long)0 | ((long long)NPHASE << 32);
    hipLaunchKernelGGL(fwd, dim3(grid), dim3(512), LDS_BYTES, stream, p);
#else
    for (int ph = 0; ph < NPHASE; ++ph) {
        p.lo_hi = (long long)ph | ((long long)(ph + 1) << 32);
        hipLaunchKernelGGL(fwd, dim3(grid), dim3(512), LDS_BYTES, stream, p);
    }
#endif
}
```

```cpp
#include <hip/hip_runtime.h>
#include <cstdio>
#include <cstdint>

#ifndef N_LAUNCH_MODE
#define N_LAUNCH_MODE 1
#endif

constexpr int B_ = 8, S_ = 2048, D_ = 2048, T_ = B_ * S_;
constexpr int INW = 3608;
constexpr int C_Q = 0, C_KC = 1024, C_VC = 1280, C_KS = 1536, C_VS = 1792, C_KW = 2048, C_VW = 2304, C_G = 2560, C_UP = 2584, C_QM = 3096;
constexpr int NC = 127;
constexpr int CROWS = B_ * NC * 2;
constexpr int NE = 32, DE = 2048, NA = T_ * 4;
constexpr float LN_EPS = 1e-5f;
constexpr float DN_ALPHA = 1.189207115002721f;
constexpr float ATT_SCALE = 0.08838834764831845f;

constexpr size_t al256(size_t x) { return (x + 255) & ~(size_t)255; }
constexpr size_t WS_CTL = 0;
constexpr size_t CTL_BYTES = 65536;
constexpr size_t CTL_CNT = 16384;
constexpr size_t WS_PROJ = CTL_BYTES;
constexpr size_t WS_KVMEM = WS_PROJ + al256((size_t)T_ * INW * 4);
constexpr size_t WS_BIAS1 = WS_KVMEM + al256((size_t)2048 * 1024 * 4);
constexpr size_t WS_HID = WS_BIAS1 + al256(2 * 256 * 4);
constexpr size_t WS_KC = WS_HID + al256((size_t)2 * 2048 * 256 * 4);
constexpr size_t WS_VC = WS_KC + al256((size_t)CROWS * 128 * 4);
constexpr size_t WS_POOLED = WS_VC + al256((size_t)CROWS * 128 * 4);
constexpr size_t WS_OPOOL = WS_POOLED + al256((size_t)T_ * 512 * 4);
constexpr size_t WS_OWIN = WS_OPOOL + al256((size_t)T_ * 512 * 4);
constexpr size_t WS_OCMP = WS_OWIN + al256((size_t)T_ * 1024 * 4);
constexpr size_t WS_OSLC = WS_OCMP + al256((size_t)T_ * 1024 * 4);
constexpr size_t WS_SEL = WS_OSLC + al256((size_t)T_ * 1024 * 4);
constexpr size_t WS_OMEM = WS_SEL + al256((size_t)T_ * 2 * 4);
constexpr size_t WS_CAT16 = WS_OMEM + al256((size_t)T_ * 512 * 4);
constexpr size_t WS_HPRE = WS_CAT16 + al256((size_t)T_ * 2048 * 2);
constexpr size_t WS_H = WS_HPRE + al256((size_t)T_ * 2048 * 4);
constexpr size_t WS_H16 = WS_H + al256((size_t)T_ * 2048 * 4);
constexpr size_t WS_GATE = WS_H16 + al256((size_t)T_ * 2048 * 2);
constexpr size_t WS_LIST = WS_GATE + al256((size_t)NA * 4);
constexpr size_t WS_ACT16 = WS_LIST + al256((size_t)NE * T_ * 4);
constexpr size_t WS_Y16 = WS_ACT16 + al256((size_t)(NA + 256) * 2048 * 2);
constexpr size_t WS_X16 = WS_Y16 + al256((size_t)NA * 2048 * 2);
constexpr size_t WS_WTIN = WS_X16 + al256((size_t)T_ * 2048 * 2);
constexpr size_t WS_WTOUT = WS_WTIN + al256((size_t)3840 * 2048 * 2);
constexpr size_t WS_WTGU = WS_WTOUT + al256((size_t)2048 * 2048 * 2);
constexpr size_t WS_WTDN = WS_WTGU + al256((size_t)NE * 4096 * 2048 * 2);
constexpr size_t WS_PROJ16 = WS_WTDN + al256((size_t)NE * 2048 * 2048 * 2);
constexpr size_t WS_KVMEM16 = WS_PROJ16 + al256((size_t)(T_ + 64) * INW * 2);
constexpr size_t WS_WT1 = WS_KVMEM16 + al256((size_t)2048 * 1024 * 2);
constexpr size_t WS_UV = WS_WT1 + al256((size_t)2 * 512 * 2048 * 2);
constexpr size_t WS_KC16 = WS_UV + al256((size_t)2 * 4 * 2048 * 512 * 4);
constexpr size_t WS_VC16 = WS_KC16 + al256((size_t)B_ * 128 * 256 * 2);
constexpr size_t WS_WR16 = WS_VC16 + al256((size_t)B_ * 128 * 256 * 2);
constexpr size_t WS_Q8GU = WS_WR16 + al256((size_t)32 * 2048 * 2);
constexpr size_t WS_Q8DN = WS_Q8GU + al256((size_t)NE * 4096 * 2048);
constexpr size_t WS_SGU = WS_Q8DN + al256((size_t)NE * 2048 * 2048);
constexpr size_t WS_SDN = WS_SGU + al256((size_t)NE * 4096 * 4);
constexpr size_t WS_H8 = WS_SDN + al256((size_t)NE * 2048 * 4);
constexpr size_t WS_SAH = WS_H8 + al256((size_t)T_ * 2048);
constexpr size_t WS_ACT8 = WS_SAH + al256((size_t)T_ * 4);
constexpr size_t WS_SACT = WS_ACT8 + al256((size_t)(NA + 256) * 2048);
constexpr size_t WS_END = WS_SACT + al256((size_t)(NA + 256) * 4);

constexpr int LDS_BYTES = 155648;

struct Params {
    const float* in[26];
    float* out;
    unsigned char* ws;
    long long lo_hi;
};
enum { I_X = 0, I_MEM, I_WIN, I_POSK, I_W1K, I_W2K, I_POSV, I_W1V, I_W2V, I_POOLW, I_POOLS, I_WMEMKV, I_GNNSA, I_GNPOOL, I_GNMEM, I_WOUT,
       I_LN1G, I_LN1B, I_WR, I_BR, I_WGU, I_BGU, I_WDN, I_BDN, I_LN2G, I_LN2B };

#define XB_TMO      128
#define XB_XCNT(j)  (256  + 64 * (j))
#define XB_XSUB(j)  (1280 + 64 * (j))
#define XB_XGEN(j)  (2304 + 64 * (j))
#define XB_TOP      3328
#define XB_TOPGEN   3392
#define XCD_BAR_WORDS 3456
#define XB_SPIN_CAP (1u << 25)
#define LAS __attribute__((address_space(3)))

__device__ __forceinline__ unsigned xb_ld(unsigned* p)              { return __hip_atomic_load(p, __ATOMIC_RELAXED, __HIP_MEMORY_SCOPE_AGENT); }
__device__ __forceinline__ unsigned xb_add(unsigned* p, unsigned v) { return __hip_atomic_fetch_add(p, v, __ATOMIC_RELAXED, __HIP_MEMORY_SCOPE_AGENT); }
__device__ __forceinline__ unsigned xb_xcc_id() { return (unsigned)__builtin_amdgcn_s_getreg((3 << 11) | 20) & 0xFu; }
#define XB_SPIN(cond, bar) do { unsigned _sp = 0; while (cond) { __builtin_amdgcn_s_sleep(1); \
    if ((++_sp & 255u) == 0u) { if (xb_ld(&(bar)[XB_TMO])) break; if (_sp > XB_SPIN_CAP) { atomicAdd(&(bar)[XB_TMO], 1u); break; } } } } while (0)

struct XcdBarrier { unsigned* bar; unsigned x; volatile LAS unsigned* st; };

__device__ __forceinline__ XcdBarrier xcd_barrier_post(unsigned* bar, volatile LAS unsigned* st) {
    XcdBarrier b; b.bar = bar; b.x = xb_xcc_id(); b.st = st;
    if (threadIdx.x == 0) (void)xb_add(&bar[XB_XCNT(b.x)], 1u);
    return b;
}
__device__ __forceinline__ void xcd_barrier_complete(unsigned* bar, unsigned x, unsigned& nloc, unsigned& nx) {
    const unsigned G = gridDim.x * gridDim.y * gridDim.z;
    unsigned sum, cnt, mine, sp = 0u;
    for (;;) {
        sum = 0u; cnt = 0u; mine = 0u;
#pragma unroll
        for (unsigned j = 0; j < 16; ++j) { const unsigned c = xb_ld(&bar[XB_XCNT(j)]); sum += c; cnt += (c > 0u) ? 1u : 0u; mine = (j == x) ? c : mine; }
        if (sum == G) break;
        __builtin_amdgcn_s_sleep(1);
        if ((++sp & 255u) == 0u) { if (xb_ld(&bar[XB_TMO])) break; if (sp > XB_SPIN_CAP) { atomicAdd(&bar[XB_TMO], 1u); break; } }
    }
    nloc = mine > 0u ? mine : 1u; nx = cnt > 0u ? cnt : 1u;
}
__device__ __forceinline__ void xcd_barrier(const XcdBarrier& b) {
    asm volatile("s_waitcnt vmcnt(0)" ::: "memory");
    __syncthreads();
    if (threadIdx.x == 0) {
        unsigned* bar = b.bar;
        __builtin_amdgcn_s_waitcnt(0);
        unsigned nloc = b.st[0], nx = b.st[1];
        if (nloc == 0u) { xcd_barrier_complete(bar, b.x, nloc, nx); b.st[0] = nloc; b.st[1] = nx; }
        const unsigned old = xb_add(&bar[XB_XSUB(b.x)], 1u);
        const unsigned gen = old / nloc;
        if (old + 1u == (gen + 1u) * nloc) {
            __builtin_amdgcn_fence(__ATOMIC_RELEASE, "agent");
            asm volatile("s_waitcnt vmcnt(0)" ::: "memory");
            const unsigned og = xb_add(&bar[XB_TOP], 1u);
            const unsigned tg = og / nx;
            if (og + 1u == (tg + 1u) * nx) xb_add(&bar[XB_TOPGEN], 1u);
            else XB_SPIN(xb_ld(&bar[XB_TOPGEN]) == tg, bar);
            __builtin_amdgcn_fence(__ATOMIC_ACQUIRE, "agent");
            xb_add(&bar[XB_XGEN(b.x)], 1u);
            asm volatile("s_waitcnt vmcnt(0)" ::: "memory");
        } else {
            XB_SPIN(xb_ld(&bar[XB_XGEN(b.x)]) == gen, bar);
            __builtin_amdgcn_fence(__ATOMIC_ACQUIRE, "agent");
            asm volatile("s_waitcnt vmcnt(0)" ::: "memory");
        }
    }
    __syncthreads();
}

typedef _Float16 h8 __attribute__((ext_vector_type(8)));
typedef _Float16 h4 __attribute__((ext_vector_type(4)));
typedef float f4 __attribute__((ext_vector_type(4)));

__device__ __forceinline__ float wave_sum(float v) {
#pragma unroll
    for (int o = 32; o > 0; o >>= 1) v += __shfl_xor(v, o);
    return v;
}
__device__ __forceinline__ float wave_max(float v) {
#pragma unroll
    for (int o = 32; o > 0; o >>= 1) v = fmaxf(v, __shfl_xor(v, o));
    return v;
}
__device__ __forceinline__ void wave_sync() {
    asm volatile("s_waitcnt lgkmcnt(0)" ::: "memory");
    __builtin_amdgcn_wave_barrier();
}
__device__ __forceinline__ float gelu_tanh(float x) {
    const float u = 0.7978845608028654f * (x + 0.044715f * x * x * x);
    return 0.5f * x * (1.f + tanhf(u));
}
__device__ __forceinline__ float sigmoidf_(float x) { return 1.f / (1.f + expf(-x)); }

constexpr int G_LD = 40;
template <class AF, class EF>
__device__ __forceinline__ void gemm_tile(char* smem, int K, const AF& af, const float* __restrict__ Bm, int ldb, int n0, int Nlim, bool perm, const EF& ef) {
    _Float16* As = (_Float16*)smem;
    _Float16* Bs = As + 128 * G_LD;
    const int tid = threadIdx.x, lane = tid & 63, wid = tid >> 6, wr = wid >> 2, wc = wid & 3, fr = lane & 15, fq = lane >> 4;
    f4 acc[4][2];
#pragma unroll
    for (int m = 0; m < 4; ++m)
#pragma unroll
        for (int n = 0; n < 2; ++n) acc[m][n] = (f4){0.f, 0.f, 0.f, 0.f};
    const int ar = tid >> 3, ak = (tid & 7) * 4;
    const float* ap0 = af.row(ar);
    const float* ap1 = af.row(ar + 64);
    const int bk = tid >> 5, bn = (tid & 31) * 4;
    const bool bok = (n0 + bn) < Nlim;
    int bnp[4];
#pragma unroll
    for (int i = 0; i < 4; ++i) { const int c = bn + i; bnp[i] = perm ? ((c & ~31) | ((c & 1) << 4) | ((c & 31) >> 1)) : c; }
    for (int k0 = 0; k0 < K; k0 += 32) {
        const int ko = af.koff(k0 + ak);
        float4 a0 = make_float4(0.f, 0.f, 0.f, 0.f), a1 = a0, b0 = a0, b1 = a0;
        if (ap0) a0 = *(const float4*)(ap0 + ko);
        if (ap1) a1 = *(const float4*)(ap1 + ko);
        if (bok) { b0 = *(const float4*)(Bm + (size_t)(k0 + bk) * ldb + n0 + bn); b1 = *(const float4*)(Bm + (size_t)(k0 + bk + 16) * ldb + n0 + bn); }
        __syncthreads();
        *(h4*)&As[ar * G_LD + ak] = (h4){(_Float16)a0.x, (_Float16)a0.y, (_Float16)a0.z, (_Float16)a0.w};
        *(h4*)&As[(ar + 64) * G_LD + ak] = (h4){(_Float16)a1.x, (_Float16)a1.y, (_Float16)a1.z, (_Float16)a1.w};
        Bs[bnp[0] * G_LD + bk] = (_Float16)b0.x; Bs[bnp[1] * G_LD + bk] = (_Float16)b0.y; Bs[bnp[2] * G_LD + bk] = (_Float16)b0.z; Bs[bnp[3] * G_LD + bk] = (_Float16)b0.w;
        Bs[bnp[0] * G_LD + bk + 16] = (_Float16)b1.x; Bs[bnp[1] * G_LD + bk + 16] = (_Float16)b1.y; Bs[bnp[2] * G_LD + bk + 16] = (_Float16)b1.z; Bs[bnp[3] * G_LD + bk + 16] = (_Float16)b1.w;
        __syncthreads();
        h8 a[4], b[2];
#pragma unroll
        for (int m = 0; m < 4; ++m) a[m] = *(const h8*)&As[(wr * 64 + m * 16 + fr) * G_LD + fq * 8];
#pragma unroll
        for (int n = 0; n < 2; ++n) b[n] = *(const h8*)&Bs[(wc * 32 + n * 16 + fr) * G_LD + fq * 8];
#pragma unroll
        for (int m = 0; m < 4; ++m)
#pragma unroll
            for (int n = 0; n < 2; ++n) acc[m][n] = __builtin_amdgcn_mfma_f32_16x16x32_f16(a[m], b[n], acc[m][n], 0, 0, 0);
    }
    ef(acc, wr, wc, fr, fq);
    __syncthreads();
}

struct ARowPlain { const float* base; int ld; int m0; int mlim;
    __device__ __forceinline__ const float* row(int r) const { return (m0 + r) < mlim ? base + (size_t)(m0 + r) * ld : nullptr; }
    __device__ __forceinline__ int koff(int k) const { return k; } };
struct ARowCmp { const float* proj; int col; int m0;
    __device__ __forceinline__ const float* row(int r) const { const int g = m0 + r; if (g >= CROWS) return nullptr; const int kvh = g & 1, bc = g >> 1, b = bc / NC, c = bc % NC;
        return proj + (size_t)(b * S_ + 16 * c) * INW + col + kvh * 128; }
    __device__ __forceinline__ int koff(int k) const { return (k >> 7) * INW + (k & 127); } };
struct ARowList { const float* base; const int* list; int m0; int cnt; int shift;
    __device__ __forceinline__ const float* row(int r) const { if (m0 + r >= cnt) return nullptr; const int a = list[m0 + r]; return base + (size_t)(a >> shift) * 2048; }
    __device__ __forceinline__ int koff(int k) const { return k; } };

struct EpiStore { float* C; int ldc; int m0; int n0; int mlim; int nlim; _Float16* C16;
    __device__ __forceinline__ void operator()(const f4 (&acc)[4][2], int wr, int wc, int fr, int fq) const {
#pragma unroll
        for (int m = 0; m < 4; ++m)
#pragma unroll
            for (int n = 0; n < 2; ++n)
#pragma unroll
                for (int j = 0; j < 4; ++j) { const int r = m0 + wr * 64 + m * 16 + fq * 4 + j, c = n0 + wc * 32 + n * 16 + fr;
                    if (r < mlim && c < nlim) { C[(size_t)r * ldc + c] = acc[m][n][j]; if (C16) C16[(size_t)r * ldc + c] = (_Float16)acc[m][n][j]; } } } };
struct EpiPool { float* C; const float* scale; int m0; int g;
    __device__ __forceinline__ void operator()(const f4 (&acc)[4][2], int wr, int wc, int fr, int fq) const {
#pragma unroll
        for (int m = 0; m < 4; ++m)
#pragma unroll
            for (int n = 0; n < 2; ++n)
#pragma unroll
                for (int j = 0; j < 4; ++j) { const int r = m0 + wr * 64 + m * 16 + fq * 4 + j, c = g * 128 + wc * 32 + n * 16 + fr;
                    C[(size_t)r * 512 + c] = acc[m][n][j] * scale[c]; } } };
struct EpiHid { float* C; const float* bias; int m0; int n0;
    __device__ __forceinline__ void operator()(const f4 (&acc)[4][2], int wr, int wc, int fr, int fq) const {
#pragma unroll
        for (int m = 0; m < 4; ++m)
#pragma unroll
            for (int n = 0; n < 2; ++n)
#pragma unroll
                for (int j = 0; j < 4; ++j) { const int r = m0 + wr * 64 + m * 16 + fq * 4 + j, c = n0 + wc * 32 + n * 16 + fr;
                    if (r < CROWS) C[(size_t)r * 256 + c] = gelu_tanh(acc[m][n][j] + bias[c]); } } };
struct EpiOut { float* C; const float* x; int m0; int n0;
    __device__ __forceinline__ void operator()(const f4 (&acc)[4][2], int wr, int wc, int fr, int fq) const {
#pragma unroll
        for (int m = 0; m < 4; ++m)
#pragma unroll
            for (int n = 0; n < 2; ++n)
#pragma unroll
                for (int j = 0; j < 4; ++j) { const size_t o = (size_t)(m0 + wr * 64 + m * 16 + fq * 4 + j) * 2048 + n0 + wc * 32 + n * 16 + fr;
                    C[o] = DN_ALPHA * x[o] + acc[m][n][j]; } } };
struct EpiGu { float* act; const float* bgu; const int* list; int m0; int cnt; int n0;
    __device__ __forceinline__ void operator()(const f4 (&acc)[4][2], int wr, int wc, int fr, int fq) const {
        const int jc = (n0 + wc * 32) / 2 + fr;
        const float bg = bgu[2 * jc], bl = bgu[2 * jc + 1];
#pragma unroll
        for (int m = 0; m < 4; ++m)
#pragma unroll
            for (int j = 0; j < 4; ++j) { const int r = m0 + wr * 64 + m * 16 + fq * 4 + j;
                if (r < cnt) { const int a = list[r];
                    const float xg = fminf(acc[m][0][j] + bg, 7.f), xl = fminf(fmaxf(acc[m][1][j] + bl, -7.f), 7.f);
                    act[(size_t)a * 2048 + jc] = xg * sigmoidf_(1.702f * xg) * (xl + 1.f); } } } };
struct EpiDn { float* y; const float* bdn; const int* list; const float* gate; int m0; int cnt; int n0;
    __device__ __forceinline__ void operator()(const f4 (&acc)[4][2], int wr, int wc, int fr, int fq) const {
#pragma unroll
        for (int m = 0; m < 4; ++m)
#pragma unroll
            for (int j = 0; j < 4; ++j) { const int r = m0 + wr * 64 + m * 16 + fq * 4 + j;
                if (r < cnt) { const int a = list[r]; const float g = gate[a];
#pragma unroll
                    for (int n = 0; n < 2; ++n) { const int c = n0 + wc * 32 + n * 16 + fr; y[(size_t)a * 2048 + c] = (acc[m][n][j] + bdn[c]) * g; } } } } };

constexpr int WLDS_FLOATS = 4096 + 512 + 32;
template <bool SHARED>
__device__ __forceinline__ void wave_attn(float* sw, const float* __restrict__ qptr, const float* __restrict__ Kb, const float* __restrict__ Vb, int ld, int nseg, float scale, float* __restrict__ optr) {
    const int lane = threadIdx.x & 63;
    float* sq = sw + 4096; const int* segs = (const int*)(sw + 4096 + 512);
#pragma unroll
    for (int i = 0; i < 8; ++i) sq[lane + 64 * i] = qptr[lane + 64 * i];
    wave_sync();
    for (int sg = 0; sg < nseg; ++sg) {
        const int start = segs[sg], len = segs[16 + sg];
        float d0 = 0.f, d1 = 0.f, d2 = 0.f, d3 = 0.f;
        if (lane < len) {
            const float* kp = Kb + (size_t)(start + lane) * ld;
            for (int d4 = 0; d4 < 32; ++d4) {
                if (SHARED) {
                    const float4 kv = *(const float4*)(kp + d4 * 4);
                    const float4 q0 = *(const float4*)(sq + d4 * 4), q1 = *(const float4*)(sq + 128 + d4 * 4), q2 = *(const float4*)(sq + 256 + d4 * 4), q3 = *(const float4*)(sq + 384 + d4 * 4);
                    d0 += kv.x * q0.x + kv.y * q0.y + kv.z * q0.z + kv.w * q0.w;
                    d1 += kv.x * q1.x + kv.y * q1.y + kv.z * q1.z + kv.w * q1.w;
                    d2 += kv.x * q2.x + kv.y * q2.y + kv.z * q2.z + kv.w * q2.w;
                    d3 += kv.x * q3.x + kv.y * q3.y + kv.z * q3.z + kv.w * q3.w;
                } else {
                    const float4 k0 = *(const float4*)(kp + d4 * 4), k1 = *(const float4*)(kp + 128 + d4 * 4), k2 = *(const float4*)(kp + 256 + d4 * 4), k3 = *(const float4*)(kp + 384 + d4 * 4);
                    const float4 q0 = *(const float4*)(sq + d4 * 4), q1 = *(const float4*)(sq + 128 + d4 * 4), q2 = *(const float4*)(sq + 256 + d4 * 4), q3 = *(const float4*)(sq + 384 + d4 * 4);
                    d0 += k0.x * q0.x + k0.y * q0.y + k0.z * q0.z + k0.w * q0.w;
                    d1 += k1.x * q1.x + k1.y * q1.y + k1.z * q1.z + k1.w * q1.w;
                    d2 += k2.x * q2.x + k2.y * q2.y + k2.z * q2.z + k2.w * q2.w;
                    d3 += k3.x * q3.x + k3.y * q3.y + k3.z * q3.z + k3.w * q3.w;
                }
            }
        }
        const bool ok = lane < len;
        sw[sg * 64 + lane] = ok ? d0 * scale : -1e30f;
        sw[1024 + sg * 64 + lane] = ok ? d1 * scale : -1e30f;
        sw[2048 + sg * 64 + lane] = ok ? d2 * scale : -1e30f;
        sw[3072 + sg * 64 + lane] = ok ? d3 * scale : -1e30f;
    }
    wave_sync();
    const int n = nseg * 64;
#pragma unroll
    for (int g = 0; g < 4; ++g) {
        float mx = -1e30f;
        for (int i = lane; i < n; i += 64) mx = fmaxf(mx, sw[g * 1024 + i]);
        mx = wave_max(mx);
        float sm = 0.f;
        for (int i = lane; i < n; i += 64) { const float v = sw[g * 1024 + i]; sm += (v > -1e29f) ? expf(v - mx) : 0.f; }
        sm = wave_sum(sm);
        const float inv = sm > 0.f ? 1.f / sm : 0.f;
        for (int i = lane; i < n; i += 64) { const float v = sw[g * 1024 + i]; sw[g * 1024 + i] = (v > -1e29f) ? expf(v - mx) * inv : 0.f; }
    }
    wave_sync();
    float o[4][2];
#pragma unroll
    for (int g = 0; g < 4; ++g) { o[g][0] = 0.f; o[g][1] = 0.f; }
    for (int sg = 0; sg < nseg; ++sg) {
        const int start = segs[sg], len = segs[16 + sg];
        for (int l = 0; l < len; ++l) {
            const float* vp = Vb + (size_t)(start + l) * ld;
            if (SHARED) {
                const float v0 = vp[lane], v1 = vp[lane + 64];
#pragma unroll
                for (int g = 0; g < 4; ++g) { const float p = sw[g * 1024 + sg * 64 + l]; o[g][0] += p * v0; o[g][1] += p * v1; }
            } else {
#pragma unroll
                for (int g = 0; g < 4; ++g) { const float p = sw[g * 1024 + sg * 64 + l]; o[g][0] += p * vp[g * 128 + lane]; o[g][1] += p * vp[g * 128 + lane + 64]; }
            }
        }
    }
#pragma unroll
    for (int g = 0; g < 4; ++g) { optr[g * 128 + lane] = o[g][0]; optr[g * 128 + lane + 64] = o[g][1]; }
}

namespace g8 {
constexpr int BM = 256, BK = 64, HALF = 128, HTB = HALF * BK * 2, STAGE_BYTES = 8 * HTB;
constexpr int KK = 2048;
typedef float f32x4 __attribute__((ext_vector_type(4)));
__device__ __forceinline__ int lds_byte(int r, int c) { const int st = (r >> 4) * 2 + (c >> 5), rr = r & 15, cc = c & 31, ob = rr * 64 + cc * 2; return st * 1024 + (ob ^ (((ob >> 9) & 1) << 5)); }
__device__ __forceinline__ void stage_rc(int b, int& R, int& C) { const int st = b / 1024, sb = b % 1024, swz = sb ^ (((sb >> 9) & 1) << 5); R = (st >> 1) * 16 + swz / 64; C = (st & 1) * 32 + (swz % 64) / 2; }
__device__ __forceinline__ int perm32(int rho) { const int n = rho >> 4, i = rho & 15; return 8 * (i >> 2) + 4 * n + (i & 3); }

typedef int i32x4 __attribute__((ext_vector_type(4)));
template <bool I8> struct AccSel { typedef f32x4 T; };
template <> struct AccSel<true> { typedef i32x4 T; };
__device__ __forceinline__ f32x4 mma16(i32x4 a, i32x4 b, f32x4 c) { return __builtin_amdgcn_mfma_f32_16x16x32_f16(*reinterpret_cast<h8*>(&a), *reinterpret_cast<h8*>(&b), c, 0, 0, 0); }
__device__ __forceinline__ i32x4 mma16(i32x4 a, i32x4 b, i32x4 c) { return __builtin_amdgcn_mfma_i32_16x16x64_i8(a, b, c, 0, 0, 0); }
struct Unit { int m0, n0, e, cnt, rbase; };
constexpr int EP_OFF = STAGE_BYTES + 512, EP_LD = 528, EP_GRP = 16 * EP_LD;
__device__ __forceinline__ void ep_sync() { asm volatile("s_waitcnt lgkmcnt(0)" ::: "memory"); __builtin_amdgcn_s_barrier(); asm volatile("" ::: "memory"); }
__device__ __forceinline__ int ep_tid() { int tz = threadIdx.x; asm volatile("" : "+v"(tz)); return tz; }
__device__ __forceinline__ h8 cvt8(f32x4 a, f32x4 b) { h8 o; o[0] = (_Float16)a[0]; o[1] = (_Float16)a[1]; o[2] = (_Float16)a[2]; o[3] = (_Float16)a[3]; o[4] = (_Float16)b[0]; o[5] = (_Float16)b[1]; o[6] = (_Float16)b[2]; o[7] = (_Float16)b[3]; return o; }

__device__ __forceinline__ void tile_order(int L, int nM, int nN, int& pm, int& pn) {
    const int nwg = nM * nN; int wgid = L;
    { const int q = nwg / 8, r = nwg % 8, xcd = wgid % 8, off = wgid / 8; wgid = (xcd < r ? xcd * (q + 1) : r * (q + 1) + (xcd - r) * q) + off; }
    const int nig = 8 * nN, gid = wgid / nig, fm = gid * 8, gsz = (nM - fm) < 8 ? (nM - fm) : 8;
    pm = fm + ((wgid % nig) % gsz); pn = (wgid % nig) / gsz;
}

template <class Prob>
__device__ __forceinline__ void gemm_phase(LAS unsigned char* lds, const Prob& P) {
    const int tid = threadIdx.x, wid = __builtin_amdgcn_readfirstlane(tid >> 6), lane = tid & 63, wr = wid >> 2, wc = wid & 3, fr = lane & 15, fq = lane >> 4;
    constexpr int nt = Prob::NT; constexpr size_t KS2 = Prob::KS2; constexpr unsigned ROWB = Prob::ROWB; constexpr bool I8 = Prob::I8;
    int sR[2], sC2[2]; unsigned voffB[2];
#pragma unroll
    for (int i = 0; i < 2; ++i) { int R, C; stage_rc(tid * 16 + i * 8192, R, C); sR[i] = R; sC2[i] = C * 2; const int Rb = Prob::PERM ? ((R & ~31) + perm32(R & 31)) : R; voffB[i] = (unsigned)Rb * ROWB + (unsigned)C * 2u; }
    const size_t kstep = (size_t)(BK * 2);
    const size_t hstep = (size_t)HALF * ROWB;
    const unsigned ldsw = (unsigned)wid * 1024u;
    const int aoff = lds_byte(wr * 64 + fr, fq * 8), boff = lds_byte(wc * 32 + fr, fq * 8);
#define G8_SA(b, h) (((b) * 2 + (h)) * HTB)
#define G8_SB(b, h) ((4 + (b) * 2 + (h)) * HTB)
#define G8_STAGE(bufoff, gbase, voff) do { _Pragma("unroll") for (int _i = 0; _i < 2; ++_i) \
        __builtin_amdgcn_global_load_lds((const unsigned*)((const char*)(gbase) + (voff)[_i]), (LAS unsigned*)(lds + (bufoff) + ldsw + _i * 8192), 16, 0, 0); } while (0)
#define G8_LDA(dst, b, h) do { _Pragma("unroll") for (int m = 0; m < 4; ++m) _Pragma("unroll") for (int k = 0; k < 2; ++k) dst[m][k] = *(const LAS i32x4*)(lds + G8_SA(b, h) + aoff + m * 2048 + k * 1024); } while (0)
#define G8_LDB(dst, b, h) do { _Pragma("unroll") for (int n = 0; n < 2; ++n) _Pragma("unroll") for (int k = 0; k < 2; ++k) dst[n][k] = *(const LAS i32x4*)(lds + G8_SB(b, h) + boff + n * 2048 + k * 1024); } while (0)
#define G8_MMA(ai, bj, At, Bt) do { __builtin_amdgcn_s_setprio(1); _Pragma("unroll") for (int m = 0; m < 4; ++m) _Pragma("unroll") for (int n = 0; n < 2; ++n) _Pragma("unroll") for (int k = 0; k < 2; ++k) \
        acc[ai][bj][m][n] = mma16(Bt[n][k], At[m][k], acc[ai][bj][m][n]); __builtin_amdgcn_s_setprio(0); } while (0)
#define G8_WAIT_V(n) asm volatile("s_waitcnt vmcnt(" #n ")" ::: "memory")
#define G8_WAIT_L(n) asm volatile("s_waitcnt lgkmcnt(" #n ")" ::: "memory")
#define G8_BAR __builtin_amdgcn_s_barrier()
#define G8_SCHED __builtin_amdgcn_sched_barrier(0)
    Unit cur, nxt; int ui = 0;
    if (!P.next(0, cur)) return;
    typedef typename AccSel<I8>::T AccT;
    AccT acc[2][2][4][2];
#pragma unroll
    for (int a = 0; a < 2; ++a)
#pragma unroll
        for (int b = 0; b < 2; ++b)
#pragma unroll
            for (int m = 0; m < 4; ++m)
#pragma unroll
                for (int n = 0; n < 2; ++n) acc[a][b][m][n] = AccT{};
    i32x4 At[4][2], B0[2][2], B1[2][2];
    unsigned vc[2][2], vn[2][2];
    P.a_offs(cur, sR, sC2, vc);
    const char* const Ab = P.a_base();
    const char* cB = P.b_base(cur);
    G8_STAGE(G8_SB(0, 0), cB, voffB); G8_STAGE(G8_SA(0, 0), Ab, vc[0]); G8_STAGE(G8_SB(0, 1), cB + hstep, voffB); G8_STAGE(G8_SA(0, 1), Ab, vc[1]);
    if (wr == 1) G8_BAR;
    G8_WAIT_V(4); G8_BAR;
    G8_STAGE(G8_SB(1, 0), cB + kstep, voffB); G8_STAGE(G8_SA(1, 0), Ab + kstep, vc[0]); G8_STAGE(G8_SB(1, 1), cB + hstep + kstep, voffB);
    G8_WAIT_V(6); G8_BAR;
    for (;;) {
        const bool has_next = P.next(ui + 1, nxt);
        const char* nB = cB;
        if (has_next) { P.a_offs(nxt, sR, sC2, vn); nB = P.b_base(nxt); }
        else { vn[0][0] = vc[0][0]; vn[0][1] = vc[0][1]; vn[1][0] = vc[1][0]; vn[1][1] = vc[1][1]; }
        for (int t = 0; t < nt; t += 2) {
            const bool last = (t == nt - 2);
            const char* a1 = Ab + (size_t)(t >> 1) * KS2 + kstep;
            const char* a2 = last ? Ab : Ab + (size_t)((t + 2) >> 1) * KS2; const char* b2 = last ? nB : cB + (size_t)(t + 2) * kstep;
            const char* a3 = a2 + kstep; const char* b3 = b2 + kstep;
            unsigned o2[2][2];
            o2[0][0] = last ? vn[0][0] : vc[0][0]; o2[0][1] = last ? vn[0][1] : vc[0][1]; o2[1][0] = last ? vn[1][0] : vc[1][0]; o2[1][1] = last ? vn[1][1] : vc[1][1];
            G8_LDB(B0, 0, 0); G8_SCHED; G8_LDA(At, 0, 0); G8_STAGE(G8_SA(1, 1), a1, vc[1]);
            G8_WAIT_L(8); G8_BAR; G8_WAIT_L(0); G8_MMA(0, 0, At, B0); G8_BAR; G8_SCHED;
            G8_LDB(B1, 0, 1); G8_STAGE(G8_SB(0, 0), b2, voffB);
            G8_BAR; G8_WAIT_L(0); G8_MMA(0, 1, At, B1); G8_BAR;
            G8_LDA(At, 0, 1); G8_STAGE(G8_SA(0, 0), a2, o2[0]);
            G8_BAR; G8_WAIT_L(0); G8_MMA(1, 0, At, B0); G8_BAR; G8_SCHED;
            G8_STAGE(G8_SB(0, 1), b2 + hstep, voffB);
            G8_WAIT_V(6); G8_BAR; G8_MMA(1, 1, At, B1); G8_BAR;
            G8_LDB(B0, 1, 0); G8_SCHED; G8_LDA(At, 1, 0); G8_STAGE(G8_SA(0, 1), a2, o2[1]);
            G8_WAIT_L(8); G8_BAR; G8_WAIT_L(0); G8_MMA(0, 0, At, B0); G8_BAR; G8_SCHED;
            G8_LDB(B1, 1, 1); G8_STAGE(G8_SB(1, 0), b3, voffB);
            G8_BAR; G8_WAIT_L(0); G8_MMA(0, 1, At, B1); G8_BAR;
            G8_LDA(At, 1, 1); G8_STAGE(G8_SA(1, 0), a3, o2[0]);
            G8_BAR; G8_WAIT_L(0); G8_MMA(1, 0, At, B0); G8_BAR; G8_SCHED;
            G8_STAGE(G8_SB(1, 1), b3 + hstep, voffB);
            G8_WAIT_V(6); G8_BAR; G8_MMA(1, 1, At, B1); G8_BAR;
        }
        P.epi(acc, cur, wr, wc, fr, fq, lds);
        if (!has_next) break;
#pragma unroll
        for (int a = 0; a < 2; ++a)
#pragma unroll
            for (int b = 0; b < 2; ++b)
#pragma unroll
                for (int m = 0; m < 4; ++m)
#pragma unroll
                    for (int n = 0; n < 2; ++n) acc[a][b][m][n] = AccT{};
        cur = nxt; cB = nB; ++ui;
        vc[0][0] = vn[0][0]; vc[0][1] = vn[0][1]; vc[1][0] = vn[1][0]; vc[1][1] = vn[1][1];
    }
    G8_WAIT_V(0);
    if (wr == 0) G8_BAR;
    G8_BAR;
#undef G8_SA
#undef G8_SB
#undef G8_STAGE
#undef G8_LDA
#undef G8_LDB
#undef G8_MMA
#undef G8_WAIT_V
#undef G8_WAIT_L
#undef G8_BAR
#undef G8_SCHED
}

struct ProbIn {
    static constexpr unsigned ROWB = 4096; static constexpr bool I8 = false;
    static constexpr int NT = 32; static constexpr size_t KS2 = 256;
    static constexpr bool PERM = true;
    const _Float16* A; const _Float16* Bt; _Float16* C16; int G, c;
    __device__ __forceinline__ bool next(int i, Unit& u) const { const int L = i * G + c; if (L >= 64 * 15) return false; int pm, pn; tile_order(L, 64, 15, pm, pn); u.m0 = pm * 256; u.n0 = pn * 256; u.e = 0; u.cnt = 256; u.rbase = 0; return true; }
    __device__ __forceinline__ void a_offs(const Unit& u, const int (&R)[2], const int (&C2)[2], unsigned (&v)[2][2]) const {
#pragma unroll
        for (int h = 0; h < 2; ++h)
#pragma unroll
            for (int i = 0; i < 2; ++i) v[h][i] = (unsigned)(u.m0 + h * 128 + R[i]) * (unsigned)(KK * 2) + (unsigned)C2[i]; }
    __device__ __forceinline__ const char* a_base() const { return (const char*)A; }
    __device__ __forceinline__ const char* b_base(const Unit& u) const { return (const char*)(Bt + (size_t)u.n0 * KK); }
    __device__ __forceinline__ void epi(const f32x4 (&acc)[2][2][4][2], const Unit& u, int wr, int wc, int fr, int fq, LAS unsigned char* lds) const {
        LAS unsigned char* ep = lds + EP_OFF + wr * EP_GRP;
        const int tg = ep_tid() & 255, rrow = tg >> 4, ch = tg & 15;
#pragma unroll
        for (int ai = 0; ai < 2; ++ai)
#pragma unroll
            for (int m = 0; m < 4; ++m) {
#pragma unroll
                for (int bj = 0; bj < 2; ++bj) *(LAS h8*)(ep + fr * EP_LD + (bj * 128 + wc * 32 + fq * 8) * 2) = cvt8(acc[ai][bj][m][0], acc[ai][bj][m][1]);
                ep_sync();
                const h8 x0 = *(const LAS h8*)(ep + rrow * EP_LD + ch * 32), x1 = *(const LAS h8*)(ep + rrow * EP_LD + ch * 32 + 16);
                const int grow = u.m0 + ai * 128 + wr * 64 + m * 16 + rrow, gcol = u.n0 + ch * 16;
                if (gcol < INW) *(h8*)(C16 + (size_t)grow * INW + gcol) = x0;
                if (gcol + 8 < INW) *(h8*)(C16 + (size_t)grow * INW + gcol + 8) = x1;
                ep_sync();
            } }
};
struct ProbOut {
    static constexpr unsigned ROWB = 4096; static constexpr bool I8 = false;
    static constexpr int NT = 32; static constexpr size_t KS2 = 256;
    static constexpr bool PERM = true;
    const _Float16* A; const _Float16* Bt; _Float16* C; const _Float16* X; int G, c;
    __device__ __forceinline__ bool next(int i, Unit& u) const { const int L = i * G + c; if (L >= 64 * 8) return false; int pm, pn; tile_order(L, 64, 8, pm, pn); u.m0 = pm * 256; u.n0 = pn * 256; u.e = 0; u.cnt = 256; u.rbase = 0; return true; }
    __device__ __forceinline__ void a_offs(const Unit& u, const int (&R)[2], const int (&C2)[2], unsigned (&v)[2][2]) const {
#pragma unroll
        for (int h = 0; h < 2; ++h)
#pragma unroll
            for (int i = 0; i < 2; ++i) v[h][i] = (unsigned)(u.m0 + h * 128 + R[i]) * (unsigned)(KK * 2) + (unsigned)C2[i]; }
    __device__ __forceinline__ const char* a_base() const { return (const char*)A; }
    __device__ __forceinline__ const char* b_base(const Unit& u) const { return (const char*)(Bt + (size_t)u.n0 * KK); }
    __device__ __forceinline__ void epi(const f32x4 (&acc)[2][2][4][2], const Unit& u, int wr, int wc, int fr, int fq, LAS unsigned char* lds) const {
        LAS unsigned char* ep = lds + EP_OFF + wr * EP_GRP;
        const int tg = ep_tid() & 255, rrow = tg >> 4, ch = tg & 15;
#pragma unroll
        for (int ai = 0; ai < 2; ++ai)
#pragma unroll
            for (int m = 0; m < 4; ++m) {
#pragma unroll
                for (int bj = 0; bj < 2; ++bj) *(LAS h8*)(ep + fr * EP_LD + (bj * 128 + wc * 32 + fq * 8) * 2) = cvt8(acc[ai][bj][m][0], acc[ai][bj][m][1]);
                const size_t go = (size_t)(u.m0 + ai * 128 + wr * 64 + m * 16 + rrow) * 2048 + u.n0 + ch * 16;
                const h8 r0 = *(const h8*)(X + go), r1 = *(const h8*)(X + go + 8);
                ep_sync();
                const h8 x0 = *(const LAS h8*)(ep + rrow * EP_LD + ch * 32), x1 = *(const LAS h8*)(ep + rrow * EP_LD + ch * 32 + 16);
                h8 o0, o1;
#pragma unroll
                for (int q = 0; q < 8; ++q) { o0[q] = (_Float16)(DN_ALPHA * (float)r0[q] + (float)x0[q]); o1[q] = (_Float16)(DN_ALPHA * (float)r1[q] + (float)x1[q]); }
                *(h8*)(C + go) = o0; *(h8*)(C + go + 8) = o1;
                ep_sync();
            } }
};
struct ProbCmp {
    static constexpr unsigned ROWB = 4096; static constexpr bool I8 = false;
    static constexpr int NT = 8; static constexpr size_t KS2 = (size_t)INW * 2;
    static constexpr bool PERM = false;
    const _Float16* A; const _Float16* Bt; float* C; int G, c;
    __device__ __forceinline__ bool next(int i, Unit& u) const { const int L = i * G + c; if (L >= 128) return false;
        u.e = L >> 6; const int r = L & 63; u.rbase = r & 3; u.n0 = ((r >> 2) & 1) * 256; u.m0 = (r >> 3) * 256; u.cnt = 256; return true; }
    __device__ __forceinline__ void a_offs(const Unit& u, const int (&R)[2], const int (&C2)[2], unsigned (&v)[2][2]) const {
#pragma unroll
        for (int h = 0; h < 2; ++h)
#pragma unroll
            for (int i = 0; i < 2; ++i) { const int row = u.m0 + h * 128 + R[i], kvh = row & 1, bj = row >> 1, b = bj >> 7, j = bj & 127;
                v[h][i] = (unsigned)((b * S_ + 16 * j + 4 * u.rbase) * INW + (u.e ? C_VC : C_KC) + kvh * 128) * 2u + (unsigned)C2[i]; } }
    __device__ __forceinline__ const char* a_base() const { return (const char*)A; }
    __device__ __forceinline__ const char* b_base(const Unit& u) const { return (const char*)(Bt + ((size_t)u.e * 512 + u.n0) * KK + u.rbase * 512); }
    __device__ __forceinline__ void epi(const f32x4 (&acc)[2][2][4][2], const Unit& u, int wr, int wc, int fr, int fq, LAS unsigned char*) const {
        float* base = C + ((size_t)(u.e * 4 + u.rbase) * 2048) * 512;
#pragma unroll
        for (int ai = 0; ai < 2; ++ai)
#pragma unroll
            for (int m = 0; m < 4; ++m) { const int row = u.m0 + ai * 128 + wr * 64 + m * 16 + fr;
#pragma unroll
                for (int bj = 0; bj < 2; ++bj)
#pragma unroll
                    for (int n = 0; n < 2; ++n) { const int col = u.n0 + bj * 128 + wc * 32 + n * 16 + fq * 4;
                        *(f32x4*)(base + (size_t)row * 512 + col) = acc[ai][bj][m][n]; } } }
};
struct MoeTab { const LAS int* t; int NT;
    __device__ __forceinline__ bool find(int L, Unit& u) const {
        const int total = __builtin_amdgcn_readfirstlane(t[98]); if (L >= total) return false;
        int e = 0;
        for (; e < NE - 1; ++e) { if (L < __builtin_amdgcn_readfirstlane(t[32 + e + 1])) break; }
        const int ub = __builtin_amdgcn_readfirstlane(t[32 + e]), cn = __builtin_amdgcn_readfirstlane(t[e]), rs = __builtin_amdgcn_readfirstlane(t[65 + e]);
        const int nm = (cn + 255) >> 8, v = L - ub, mt = v % nm, ntile = v / nm;
        u.e = e; u.m0 = mt * 256; u.n0 = ntile * 256; u.cnt = min(256, cn - mt * 256); u.rbase = rs; return true; } };
struct ProbGu {
    static constexpr int NT = 16; static constexpr size_t KS2 = 256; static constexpr unsigned ROWB = 2048; static constexpr bool I8 = true;
    static constexpr bool PERM = true;
    const signed char* A; const signed char* Bt; _Float16* act; const float* bgu; const int* list; const float* sa; const float* sw; MoeTab tab; int G, vcu;
    __device__ __forceinline__ bool next(int i, Unit& u) const { return tab.find(i * G + vcu, u); }
    __device__ __forceinline__ void a_offs(const Unit& u, const int (&R)[2], const int (&C2)[2], unsigned (&v)[2][2]) const {
#pragma unroll
        for (int h = 0; h < 2; ++h)
#pragma unroll
            for (int i = 0; i < 2; ++i) { int r = h * 128 + R[i]; r = r < u.cnt ? r : 0; const int a = list[(size_t)u.e * T_ + u.m0 + r]; v[h][i] = (unsigned)(a >> 2) * 2048u + (unsigned)C2[i]; } }
    __device__ __forceinline__ const char* a_base() const { return (const char*)A; }
    __device__ __forceinline__ const char* b_base(const Unit& u) const { return (const char*)(Bt + ((size_t)u.e * 4096 + u.n0) * 2048); }
    __device__ __forceinline__ void epi(const i32x4 (&acc)[2][2][4][2], const Unit& u, int wr, int wc, int fr, int fq, LAS unsigned char* lds) const {
        const float* bb = bgu + (size_t)u.e * 4096; const float* ss = sw + (size_t)u.e * 4096;
        LAS unsigned char* ep = lds + EP_OFF + wr * EP_GRP;
        const int tg = ep_tid() & 255, rrow = tg >> 4, ch = tg & 15;
        f32x4 b0[2], b1[2], s0[2], s1[2];
#pragma unroll
        for (int bj = 0; bj < 2; ++bj) { const int col = u.n0 + bj * 128 + wc * 32 + fq * 8;
            b0[bj] = *(const f32x4*)(bb + col); b1[bj] = *(const f32x4*)(bb + col + 4); s0[bj] = *(const f32x4*)(ss + col); s1[bj] = *(const f32x4*)(ss + col + 4); }
#pragma unroll
        for (int ai = 0; ai < 2; ++ai)
#pragma unroll
            for (int m = 0; m < 4; ++m) { const int rl = ai * 128 + wr * 64 + m * 16 + fr;
                const int a = list[(size_t)u.e * T_ + u.m0 + (rl < u.cnt ? rl : 0)]; const float sr = sa[a >> 2];
#pragma unroll
                for (int bj = 0; bj < 2; ++bj) {
                    const i32x4 i0 = acc[ai][bj][m][0], i1 = acc[ai][bj][m][1];
                    const f32x4 v0 = (f32x4){(float)i0[0], (float)i0[1], (float)i0[2], (float)i0[3]} * (s0[bj] * sr) + b0[bj], v1 = (f32x4){(float)i1[0], (float)i1[1], (float)i1[2], (float)i1[3]} * (s1[bj] * sr) + b1[bj];
                    h4 o;
                    { const float xg = fminf(v0[0], 7.f), xl = fminf(fmaxf(v0[1], -7.f), 7.f); o[0] = (_Float16)(xg * sigmoidf_(1.702f * xg) * (xl + 1.f)); }
                    { const float xg = fminf(v0[2], 7.f), xl = fminf(fmaxf(v0[3], -7.f), 7.f); o[1] = (_Float16)(xg * sigmoidf_(1.702f * xg) * (xl + 1.f)); }
                    { const float xg = fminf(v1[0], 7.f), xl = fminf(fmaxf(v1[1], -7.f), 7.f); o[2] = (_Float16)(xg * sigmoidf_(1.702f * xg) * (xl + 1.f)); }
                    { const float xg = fminf(v1[2], 7.f), xl = fminf(fmaxf(v1[3], -7.f), 7.f); o[3] = (_Float16)(xg * sigmoidf_(1.702f * xg) * (xl + 1.f)); }
                    *(LAS h4*)(ep + fr * EP_LD + (bj * 64 + wc * 16 + fq * 4) * 2) = o; }
                ep_sync();
                const h8 x0 = *(const LAS h8*)(ep + rrow * EP_LD + ch * 16);
                const int rr = ai * 128 + wr * 64 + m * 16 + rrow;
                if (rr < u.cnt) *(h8*)(act + (size_t)(u.rbase + u.m0 + rr) * 2048 + (u.n0 >> 1) + ch * 8) = x0;
                ep_sync();
            } }
};
struct ProbDn {
    static constexpr int NT = 16; static constexpr size_t KS2 = 256; static constexpr unsigned ROWB = 2048; static constexpr bool I8 = true;
    static constexpr bool PERM = true;
    const signed char* A; const signed char* Bt; _Float16* y; const float* bdn; const int* list; const float* gate; const float* sa; const float* sw; MoeTab tab; int G, vcu;
    __device__ __forceinline__ bool next(int i, Unit& u) const { return tab.find(i * G + vcu, u); }
    __device__ __forceinline__ void a_offs(const Unit& u, const int (&R)[2], const int (&C2)[2], unsigned (&v)[2][2]) const {
#pragma unroll
        for (int h = 0; h < 2; ++h)
#pragma unroll
            for (int i = 0; i < 2; ++i) v[h][i] = (unsigned)(u.rbase + u.m0 + h * 128 + R[i]) * 2048u + (unsigned)C2[i]; }
    __device__ __forceinline__ const char* a_base() const { return (const char*)A; }
    __device__ __forceinline__ const char* b_base(const Unit& u) const { return (const char*)(Bt + ((size_t)u.e * 2048 + u.n0) * 2048); }
    __device__ __forceinline__ void epi(const i32x4 (&acc)[2][2][4][2], const Unit& u, int wr, int wc, int fr, int fq, LAS unsigned char* lds) const {
        const float* bb = bdn + (size_t)u.e * 2048; const float* ss = sw + (size_t)u.e * 2048;
        LAS unsigned char* ep = lds + EP_OFF + wr * EP_GRP;
        const int tg = ep_tid() & 255, rrow = tg >> 4, ch = tg & 15;
        f32x4 b0[2], b1[2], s0[2], s1[2];
#pragma unroll
        for (int bj = 0; bj < 2; ++bj) { const int col = u.n0 + bj * 128 + wc * 32 + fq * 8;
            b0[bj] = *(const f32x4*)(bb + col); b1[bj] = *(const f32x4*)(bb + col + 4); s0[bj] = *(const f32x4*)(ss + col); s1[bj] = *(const f32x4*)(ss + col + 4); }
#pragma unroll
        for (int ai = 0; ai < 2; ++ai)
#pragma unroll
            for (int m = 0; m < 4; ++m) { const int rl = ai * 128 + wr * 64 + m * 16 + fr, rc = rl < u.cnt ? rl : 0;
                const int a = list[(size_t)u.e * T_ + u.m0 + rc]; const float g = gate[a]; const float sr = sa[u.rbase + u.m0 + rc];
#pragma unroll
                for (int bj = 0; bj < 2; ++bj) {
                    const i32x4 i0 = acc[ai][bj][m][0], i1 = acc[ai][bj][m][1];
                    const f32x4 v0 = ((f32x4){(float)i0[0], (float)i0[1], (float)i0[2], (float)i0[3]} * (s0[bj] * sr) + b0[bj]) * g, v1 = ((f32x4){(float)i1[0], (float)i1[1], (float)i1[2], (float)i1[3]} * (s1[bj] * sr) + b1[bj]) * g;
                    *(LAS h8*)(ep + fr * EP_LD + (bj * 128 + wc * 32 + fq * 8) * 2) = cvt8(v0, v1); }
                const int rr = ai * 128 + wr * 64 + m * 16 + rrow;
                const int a2 = list[(size_t)u.e * T_ + u.m0 + (rr < u.cnt ? rr : 0)];
                ep_sync();
                const h8 x0 = *(const LAS h8*)(ep + rrow * EP_LD + ch * 32), x1 = *(const LAS h8*)(ep + rrow * EP_LD + ch * 32 + 16);
                if (rr < u.cnt) { *(h8*)(y + (size_t)a2 * 2048 + u.n0 + ch * 16) = x0; *(h8*)(y + (size_t)a2 * 2048 + u.n0 + ch * 16 + 8) = x1; }
                ep_sync();
            } }
};
}

namespace at8 {
typedef float f32x16 __attribute__((ext_vector_type(16)));
typedef short s16x4 __attribute__((ext_vector_type(4)));
typedef unsigned u32x4 __attribute__((ext_vector_type(4)));
constexpr int SHM_V = 64 * 128 * 2, SHM_K = 64 * 128 * 2;
constexpr int LDS_WS = 2 * SHM_V + 2 * SHM_K;
constexpr int LDS_END = LDS_WS + 8 * 64 * 4;
constexpr float CEXP = ATT_SCALE * 1.4426950408889634f;
constexpr float THR_RAW = 8.f / ATT_SCALE;
#define AT_KSWZ(row, colB) ((row) * 256 + ((colB) ^ (((row) & 7) << 4)))
#define AT_SBAR() __builtin_amdgcn_sched_barrier(0)
__device__ __forceinline__ int crow(int r, int hi) { return (r & 3) + 8 * (r >> 2) + 4 * hi; }
__device__ __forceinline__ unsigned cvtpk(float lo, float hi) { auto v = __builtin_amdgcn_cvt_pkrtz(lo, hi); return *reinterpret_cast<unsigned*>(&v); }
__device__ __forceinline__ int v_st(int k, int c) { const int kk = (k & ~0xC) | ((k & 4) << 1) | ((k & 8) >> 1); return ((kk >> 3) * 4 + (c >> 5)) * 512 + ((kk & 7) * 32 + (c & 31)) * 2; }
__device__ __forceinline__ int v_rd_base(int lane) { return ((lane & 3) << 3) | (((lane >> 2) & 3) << 6) | (((lane >> 4) & 1) << 5) | (((lane >> 5) & 1) << 8); }
constexpr int v_rd_off(int d0, int ks, int half) { return d0 * 512 + ks * 4096 + half * 2048; }
template <int OFF> __device__ __forceinline__ s16x4 tr_read(int vb) { s16x4 r; asm volatile("ds_read_b64_tr_b16 %0, %1 offset:%2" : "=&v"(r) : "v"(vb), "i"(OFF) : "memory"); return r; }
__device__ __forceinline__ h8 mk8(s16x4 l, s16x4 h) { typedef short s16x8 __attribute__((ext_vector_type(8))); s16x8 w = {l[0], l[1], l[2], l[3], h[0], h[1], h[2], h[3]}; return *reinterpret_cast<h8*>(&w); }
template <int D0> __device__ __forceinline__ void pv_one(f32x16& od, int vb, h8 pa0, h8 pa1, h8 pa2, h8 pa3) {
    const s16x4 l0 = tr_read<v_rd_off(D0, 0, 0)>(vb), h0 = tr_read<v_rd_off(D0, 0, 1)>(vb), l1 = tr_read<v_rd_off(D0, 1, 0)>(vb), h1 = tr_read<v_rd_off(D0, 1, 1)>(vb);
    const s16x4 l2 = tr_read<v_rd_off(D0, 2, 0)>(vb), h2 = tr_read<v_rd_off(D0, 2, 1)>(vb), l3 = tr_read<v_rd_off(D0, 3, 0)>(vb), h3 = tr_read<v_rd_off(D0, 3, 1)>(vb);
    asm volatile("s_waitcnt lgkmcnt(0)" ::: "memory"); AT_SBAR();
    od = __builtin_amdgcn_mfma_f32_32x32x16_f16(pa0, mk8(l0, h0), od, 0, 0, 0);
    od = __builtin_amdgcn_mfma_f32_32x32x16_f16(pa1, mk8(l1, h1), od, 0, 0, 0);
    od = __builtin_amdgcn_mfma_f32_32x32x16_f16(pa2, mk8(l2, h2), od, 0, 0, 0);
    od = __builtin_amdgcn_mfma_f32_32x32x16_f16(pa3, mk8(l3, h3), od, 0, 0, 0);
}
__device__ __forceinline__ void pv_d0(f32x16 (&o)[4], int vb, h8 pa0, h8 pa1, h8 pa2, h8 pa3) {
    pv_one<0>(o[0], vb, pa0, pa1, pa2, pa3); pv_one<1>(o[1], vb, pa0, pa1, pa2, pa3); pv_one<2>(o[2], vb, pa0, pa1, pa2, pa3); pv_one<3>(o[3], vb, pa0, pa1, pa2, pa3);
}
__device__ __forceinline__ void qkt(f32x16& p0, f32x16& p1, const char* Ks, const h8 (&qr)[8], int r32, int hi) {
    p0 = f32x16{}; p1 = f32x16{};
#pragma unroll
    for (int d0 = 0; d0 < 8; ++d0) { const int cb = (d0 * 16 + hi * 8) * 2;
        const h8 b0 = *reinterpret_cast<const h8*>(Ks + AT_KSWZ(r32, cb));
        const h8 b1 = *reinterpret_cast<const h8*>(Ks + AT_KSWZ(32 + r32, cb));
        p0 = __builtin_amdgcn_mfma_f32_32x32x16_f16(b0, qr[d0], p0, 0, 0, 0);
        p1 = __builtin_amdgcn_mfma_f32_32x32x16_f16(b1, qr[d0], p1, 0, 0, 0); }
}
__device__ __forceinline__ void pack_p(const f32x16& p0, const f32x16& p1, h8& pa0, h8& pa1, h8& pa2, h8& pa3) {
#define AT_PK4(P, BASE, OUT) do { unsigned a0 = cvtpk(P[BASE + 0], P[BASE + 1]), a1 = cvtpk(P[BASE + 2], P[BASE + 3]); \
    unsigned b0 = cvtpk(P[BASE + 4], P[BASE + 5]), b1 = cvtpk(P[BASE + 6], P[BASE + 7]); \
    auto r0 = __builtin_amdgcn_permlane32_swap(a0, b0, false, false); auto r1 = __builtin_amdgcn_permlane32_swap(a1, b1, false, false); \
    u32x4 w = {r0[0], r1[0], r0[1], r1[1]}; OUT = *reinterpret_cast<h8*>(&w); } while (0)
    AT_PK4(p0, 0, pa0); AT_PK4(p0, 8, pa1); AT_PK4(p1, 0, pa2); AT_PK4(p1, 8, pa3);
#undef AT_PK4
}
__device__ __forceinline__ float half_swap_max(float v) { auto rr = __builtin_amdgcn_permlane32_swap(__float_as_uint(v), __float_as_uint(v), false, false); return fmaxf(__uint_as_float(rr[0]), __uint_as_float(rr[1])); }
__device__ __forceinline__ float half_swap_sum(float v) { auto rr = __builtin_amdgcn_permlane32_swap(__float_as_uint(v), __float_as_uint(v), false, false); return __uint_as_float(rr[0]) + __uint_as_float(rr[1]); }

struct Stage4 { h8 vs0, vs1, ks0, ks1; };
__device__ __forceinline__ int hidden_tid() { int tz = threadIdx.x; asm volatile("" : "+v"(tz)); return tz; }
__device__ __forceinline__ void sload(Stage4& s, const _Float16* Kb, const _Float16* Vb, int ld, int k0) {
    const int tz = hidden_tid(), sr = tz >> 4, sc = (tz & 15) * 8;
    s.vs0 = *(const h8*)(Vb + (size_t)(k0 + sr) * ld + sc); s.vs1 = *(const h8*)(Vb + (size_t)(k0 + 32 + sr) * ld + sc);
    s.ks0 = *(const h8*)(Kb + (size_t)(k0 + sr) * ld + sc); s.ks1 = *(const h8*)(Kb + (size_t)(k0 + 32 + sr) * ld + sc);
}
__device__ __forceinline__ void swrite(const Stage4& s, char* V_lds, char* K_lds, int b) {
    const int tz = hidden_tid(), sr = tz >> 4, sc = (tz & 15) * 8, vst0 = v_st(sr, sc), vst1 = v_st(32 + sr, sc);
    *(h8*)(V_lds + b * SHM_V + vst0) = s.vs0; *(h8*)(V_lds + b * SHM_V + vst1) = s.vs1;
    const int kc = sc * 2;
    *(h8*)(K_lds + b * SHM_K + AT_KSWZ(sr, kc)) = s.ks0; *(h8*)(K_lds + b * SHM_K + AT_KSWZ(32 + sr, kc)) = s.ks1;
}

__device__ __forceinline__ void attn_unit(char* lds, const _Float16* qrow, const _Float16* Kb, const _Float16* Vb, int ld, unsigned tmask, int klo, int khi, unsigned selmask,
                                          float* outw, int ostride) {
    const int tid = threadIdx.x, wid = __builtin_amdgcn_readfirstlane(tid >> 6), lane = tid & 63, r32 = lane & 31, hi = lane >> 5;
    char* V_lds = lds; char* K_lds = lds + 2 * SHM_V;
    float* wsf = (float*)(lds + LDS_WS) + wid * 64; float* li_l = wsf; float* al_l = wsf + 32;
    float m_reg = -1e30f, l_reg = 0.f; f32x16 o[4] = {}; h8 qr[8];
#pragma unroll
    for (int d0 = 0; d0 < 8; ++d0) qr[d0] = *(const h8*)(qrow + d0 * 16);
    const int vb0 = (int)(uintptr_t)V_lds + v_rd_base(lane);
    Stage4 st;
    unsigned rest = tmask; int j = __ffs(rest) - 1; rest &= rest - 1;
    sload(st, Kb, Vb, ld, j * 64); asm volatile("s_waitcnt vmcnt(0)" ::: "memory"); swrite(st, V_lds, K_lds, 0); __syncthreads();
    int buf = 0;
    for (;;) {
        const int jn = rest ? (__ffs(rest) - 1) : -1;
        if (jn >= 0) sload(st, Kb, Vb, ld, jn * 64);
        f32x16 p0, p1;
        AT_SBAR(); qkt(p0, p1, K_lds + buf * SHM_K, qr, r32, hi);
        { const int kb = j * 64 + 4 * hi; const bool tb = (selmask >> j) & 1u;
#pragma unroll
          for (int r = 0; r < 16; ++r) { const int k0 = kb + (r & 3) + 8 * (r >> 2);
              p0[r] = (tb && k0 >= klo && k0 <= khi) ? p0[r] : -INFINITY;
              p1[r] = (tb && (k0 + 32) >= klo && (k0 + 32) <= khi) ? p1[r] : -INFINITY; } }
        float pmax = p0[0];
#pragma unroll
        for (int r = 1; r < 16; ++r) pmax = fmaxf(pmax, p0[r]);
#pragma unroll
        for (int r = 0; r < 16; ++r) pmax = fmaxf(pmax, p1[r]);
        pmax = half_swap_max(pmax);
        float mn, alpha;
        if (__all(pmax - m_reg <= THR_RAW)) { mn = m_reg; alpha = 1.f; }
        else { mn = fmaxf(m_reg, pmax); alpha = __builtin_amdgcn_exp2f((m_reg - mn) * CEXP); m_reg = mn; }
        const float mnC = -mn * CEXP;
        float ps = 0.f;
#pragma unroll
        for (int r = 0; r < 16; ++r) { p0[r] = __builtin_amdgcn_exp2f(fmaf(p0[r], CEXP, mnC)); ps += p0[r]; }
#pragma unroll
        for (int r = 0; r < 16; ++r) { p1[r] = __builtin_amdgcn_exp2f(fmaf(p1[r], CEXP, mnC)); ps += p1[r]; }
        ps = half_swap_sum(ps);
        l_reg = l_reg * alpha + ps;
        if (__any(alpha < 1.f)) { if (hi == 0) al_l[r32] = alpha; asm volatile("s_waitcnt lgkmcnt(0)" ::: "memory");
#pragma unroll
            for (int r = 0; r < 16; ++r) { const float a = al_l[crow(r, hi)];
#pragma unroll
                for (int d = 0; d < 4; ++d) o[d][r] *= a; } }
        h8 pa0, pa1, pa2, pa3; pack_p(p0, p1, pa0, pa1, pa2, pa3);
        AT_SBAR();
        pv_d0(o, vb0 + buf * SHM_V, pa0, pa1, pa2, pa3);
        if (jn < 0) break;
        asm volatile("s_waitcnt vmcnt(0)" ::: "memory");
        swrite(st, V_lds, K_lds, buf ^ 1);
        __syncthreads();
        buf ^= 1; j = jn; rest &= rest - 1;
    }
    if (hi == 0) li_l[r32] = l_reg; asm volatile("s_waitcnt lgkmcnt(0)" ::: "memory");
#pragma unroll
    for (int r = 0; r < 16; ++r) { const int orow = crow(r, hi); const float l = li_l[orow]; const float rl = l > 0.f ? 1.f / l : 0.f;
#pragma unroll
        for (int d0 = 0; d0 < 4; ++d0) outw[(size_t)orow * ostride + d0 * 32 + r32] = o[d0][r] * rl; }
    __syncthreads();
}

constexpr int LDS_AP = LDS_END, LDS_BP = LDS_AP + 4 * 64 * 33 * 4, LDS_SELM = LDS_BP + 4 * 64 * 33 * 4, LDS_CS_END = LDS_SELM + 64 * 4;
__device__ __forceinline__ void cmp_slc_unit(char* lds, const _Float16* qrow, const _Float16* Kc, const _Float16* Vc, const _Float16* Ks, const _Float16* Vs, int t, int tl, int g, int qi,
                                             float* outc, float* outs) {
    const int tid = threadIdx.x, wid = __builtin_amdgcn_readfirstlane(tid >> 6), lane = tid & 63, r32 = lane & 31, hi = lane >> 5;
    char* V_lds = lds; char* K_lds = lds + 2 * SHM_V;
    float* AP = (float*)(lds + LDS_AP); float* BP = (float*)(lds + LDS_BP); unsigned* selm = (unsigned*)(lds + LDS_SELM);
    {
        h8 qr[8];
#pragma unroll
        for (int d0 = 0; d0 < 8; ++d0) qr[d0] = *(const h8*)(qrow + d0 * 16);
        const int vb0 = (int)(uintptr_t)V_lds + v_rd_base(lane);
        { Stage4 s0, s1; sload(s0, Kc, Vc, 256, 0); sload(s1, Kc, Vc, 256, 64);
          asm volatile("s_waitcnt vmcnt(0)" ::: "memory");
          swrite(s0, V_lds, K_lds, 0); swrite(s1, V_lds, K_lds, 1); }
        __syncthreads();
        f32x16 pA0, pA1, pB0, pB1;
        AT_SBAR(); qkt(pA0, pA1, K_lds, qr, r32, hi); qkt(pB0, pB1, K_lds + SHM_K, qr, r32, hi);
        const int khi = t >= 31 ? ((t - 31) >> 4) : -1;
#pragma unroll
        for (int r = 0; r < 16; ++r) { const int c0 = 4 * hi + (r & 3) + 8 * (r >> 2);
            pA0[r] = (c0 <= khi) ? pA0[r] : -INFINITY; pA1[r] = (c0 + 32 <= khi) ? pA1[r] : -INFINITY;
            pB0[r] = (c0 + 64 <= khi) ? pB0[r] : -INFINITY; pB1[r] = (c0 + 96 <= khi) ? pB1[r] : -INFINITY; }
        float pmax = -INFINITY;
#pragma unroll
        for (int r = 0; r < 16; ++r) pmax = fmaxf(fmaxf(pmax, pA0[r]), fmaxf(pA1[r], fmaxf(pB0[r], pB1[r])));
        pmax = half_swap_max(pmax);
        const float mC = (pmax == -INFINITY) ? 0.f : -pmax * CEXP;
        float ps = 0.f;
#pragma unroll
        for (int r = 0; r < 16; ++r) { pA0[r] = __builtin_amdgcn_exp2f(fmaf(pA0[r], CEXP, mC)); pA1[r] = __builtin_amdgcn_exp2f(fmaf(pA1[r], CEXP, mC));
            pB0[r] = __builtin_amdgcn_exp2f(fmaf(pB0[r], CEXP, mC)); pB1[r] = __builtin_amdgcn_exp2f(fmaf(pB1[r], CEXP, mC)); ps += (pA0[r] + pA1[r]) + (pB0[r] + pB1[r]); }
        ps = half_swap_sum(ps);
        const float inv = ps > 0.f ? 1.f / ps : 0.f;
#pragma unroll
        for (int r = 0; r < 16; ++r) { pA0[r] *= inv; pA1[r] *= inv; pB0[r] *= inv; pB1[r] *= inv; }
        { float* ap = AP + (g * 64 + tl) * 33; float* bp = BP + (g * 64 + tl) * 33;
          if (hi == 0) bp[0] = 0.f;
#define AT_IMP(P, JB) do { _Pragma("unroll") for (int k = 0; k < 4; ++k) { const int j = (JB) + 2 * k + hi; \
              ap[j] = 2.f * (P[4 * k] + P[4 * k + 1] + P[4 * k + 2]) + P[4 * k + 3]; if (j + 1 < 32) bp[j + 1] = P[4 * k + 3]; } } while (0)
          AT_IMP(pA0, 0); AT_IMP(pA1, 8); AT_IMP(pB0, 16); AT_IMP(pB1, 24);
#undef AT_IMP
        }
        f32x16 o[4] = {};
        h8 pa0, pa1, pa2, pa3;
        pack_p(pA0, pA1, pa0, pa1, pa2, pa3); AT_SBAR(); pv_d0(o, vb0, pa0, pa1, pa2, pa3);
        pack_p(pB0, pB1, pa0, pa1, pa2, pa3); AT_SBAR(); pv_d0(o, vb0 + SHM_V, pa0, pa1, pa2, pa3);
#pragma unroll
        for (int r = 0; r < 16; ++r) { const int orow = crow(r, hi);
#pragma unroll
            for (int d0 = 0; d0 < 4; ++d0) outc[(size_t)orow * 1024 + d0 * 32 + r32] = o[d0][r]; }
    }
    __syncthreads();
#pragma unroll 1
    for (int it = 0; it < 4; ++it) {
        const int tk = 8 * wid + 2 * it + hi, j = r32;
        float imp = 0.f;
#pragma unroll
        for (int gg = 0; gg < 4; ++gg) imp += AP[(gg * 64 + tk) * 33 + j] + BP[(gg * 64 + tk) * 33 + j];
        const bool forced = (j == 0) || (j == qi) || (j == qi - 1), valid = j <= qi;
        const float iv = forced ? 1e9f : (valid ? imp : -1e9f);
        int rank = 0;
        for (int i = 0; i < 32; ++i) { const float vi = __shfl(iv, i + 32 * hi); rank += (vi > iv || (vi == iv && i < j)) ? 1 : 0; }
        const unsigned long long bal = __ballot(rank < 16 && valid);
        if (r32 == 0) selm[tk] = (unsigned)(bal >> (32 * hi));
    }
    __syncthreads();
    unsigned tm = selm[lane];
#pragma unroll
    for (int o = 32; o > 0; o >>= 1) tm |= __shfl_xor(tm, o);
    const int tz2 = hidden_tid();
    const unsigned mysel = selm[((tz2 >> 6) & 1) * 32 + (tz2 & 31)];
    attn_unit(lds, qrow, Ks, Vs, INW, tm, 0, t, mysel, outs, 1024);
}
}

__device__ __forceinline__ void conv_tile(float* lds, const float* __restrict__ W, int ldw, int nvalid, _Float16* __restrict__ Wt, int K, int k0, int n0) {
    const int tid = threadIdx.x;
    float4 v[8];
#pragma unroll
    for (int i = 0; i < 8; ++i) { const int idx = tid + 512 * i, r = idx >> 6, c4 = (idx & 63) * 4;
        v[i] = (n0 + c4 < nvalid) ? *(const float4*)(W + (size_t)(k0 + r) * ldw + n0 + c4) : make_float4(0.f, 0.f, 0.f, 0.f); }
#pragma unroll
    for (int i = 0; i < 8; ++i) { const int idx = tid + 512 * i, r = idx >> 6, c4 = (idx & 63) * 4; float* d = lds + r * 257 + c4; d[0] = v[i].x; d[1] = v[i].y; d[2] = v[i].z; d[3] = v[i].w; }
    __syncthreads();
#pragma unroll
    for (int j = 0; j < 4; ++j) { const int id = tid + 512 * j, n = id >> 3, k8 = (id & 7) * 8; h8 o;
#pragma unroll
        for (int q = 0; q < 8; ++q) o[q] = (_Float16)lds[(k8 + q) * 257 + n];
        *(h8*)(Wt + (size_t)(n0 + n) * K + k0 + k8) = o; }
    __syncthreads();
}


__device__ __forceinline__ unsigned pack4_i8(float a, float b, float c, float d) {
    const int ia = __float2int_rn(a), ib = __float2int_rn(b), ic = __float2int_rn(c), id = __float2int_rn(d);
    return (unsigned)(ia & 255) | ((unsigned)(ib & 255) << 8) | ((unsigned)(ic & 255) << 16) | ((unsigned)(id & 255) << 24);
}
constexpr int QP_LD = 2052;
__device__ __forceinline__ void quant_panel(char* smem, const float* __restrict__ W, int ldw, int n0, signed char* __restrict__ Q, float* __restrict__ scale) {
    _Float16* Tt = (_Float16*)smem;
    unsigned* cmax = (unsigned*)(smem + 32 * QP_LD * 2);
    const int tid = threadIdx.x;
    if (tid < 32) cmax[tid] = 0u;
    __syncthreads();
    const int c4 = (tid & 7) * 4, kr = tid >> 3;
    float m0 = 0.f, m1 = 0.f, m2 = 0.f, m3 = 0.f;
#pragma unroll 1
    for (int pass = 0; pass < 32; pass += 8) {
        float4 v[8];
#pragma unroll
        for (int j = 0; j < 8; ++j) v[j] = *(const float4*)(W + (size_t)((pass + j) * 64 + kr) * ldw + n0 + c4);
#pragma unroll
        for (int j = 0; j < 8; ++j) { const int k = (pass + j) * 64 + kr;
            Tt[(c4 + 0) * QP_LD + k] = (_Float16)v[j].x; Tt[(c4 + 1) * QP_LD + k] = (_Float16)v[j].y; Tt[(c4 + 2) * QP_LD + k] = (_Float16)v[j].z; Tt[(c4 + 3) * QP_LD + k] = (_Float16)v[j].w;
            m0 = fmaxf(m0, fabsf(v[j].x)); m1 = fmaxf(m1, fabsf(v[j].y)); m2 = fmaxf(m2, fabsf(v[j].z)); m3 = fmaxf(m3, fabsf(v[j].w)); }
    }
    atomicMax(&cmax[c4 + 0], __float_as_uint(m0)); atomicMax(&cmax[c4 + 1], __float_as_uint(m1)); atomicMax(&cmax[c4 + 2], __float_as_uint(m2)); atomicMax(&cmax[c4 + 3], __float_as_uint(m3));
    __syncthreads();
#pragma unroll
    for (int j = 0; j < 8; ++j) { const int id = tid + 512 * j, n = id >> 7, k16 = (id & 127) * 16;
        const float mx = __uint_as_float(cmax[n]); const float inv = mx > 0.f ? 127.f / mx : 0.f;
        const h4* src = (const h4*)(Tt + n * QP_LD + k16);
        const h4 a = src[0], b = src[1], c = src[2], d = src[3];
        uint4 o;
        o.x = pack4_i8((float)a[0] * inv, (float)a[1] * inv, (float)a[2] * inv, (float)a[3] * inv); o.y = pack4_i8((float)b[0] * inv, (float)b[1] * inv, (float)b[2] * inv, (float)b[3] * inv);
        o.z = pack4_i8((float)c[0] * inv, (float)c[1] * inv, (float)c[2] * inv, (float)c[3] * inv); o.w = pack4_i8((float)d[0] * inv, (float)d[1] * inv, (float)d[2] * inv, (float)d[3] * inv);
        *(uint4*)(Q + (size_t)(n0 + n) * 2048 + k16) = o; }
    if (tid < 32) { const float mx = __uint_as_float(cmax[tid]); scale[n0 + tid] = mx > 0.f ? mx / 127.f : 1.f; }
    __syncthreads();
}

__global__ void __launch_bounds__(512, 2) fwd(Params p) {
    extern __shared__ __attribute__((aligned(16))) char smem[];
    const int tid = threadIdx.x, lane = tid & 63, wv = __builtin_amdgcn_readfirstlane(tid >> 6);
    const int bid = blockIdx.x, nb = gridDim.x;
    const int gw = bid * 8 + wv, nw = nb * 8;
    const int lo = (int)(p.lo_hi & 0xffffffffll), hi = (int)(p.lo_hi >> 32);
    unsigned char* ws = p.ws;
    unsigned* ctl = (unsigned*)(ws + WS_CTL);
    int* cnt = (int*)(ws + CTL_CNT);
    float* proj = (float*)(ws + WS_PROJ);
    float* kvmem = (float*)(ws + WS_KVMEM);
    float* bias1 = (float*)(ws + WS_BIAS1);
    float* hid = (float*)(ws + WS_HID);
    float* kc = (float*)(ws + WS_KC);
    float* vc = (float*)(ws + WS_VC);
    float* pooled = (float*)(ws + WS_POOLED);
    float* opool = (float*)(ws + WS_OPOOL);
    float* owin = (float*)(ws + WS_OWIN);
    float* ocmp = (float*)(ws + WS_OCMP);
    float* oslc = (float*)(ws + WS_OSLC);
    unsigned* sel = (unsigned*)(ws + WS_SEL);
    float* omem = (float*)(ws + WS_OMEM);
    _Float16* cat16 = (_Float16*)(ws + WS_CAT16);
    _Float16* hpre16 = (_Float16*)(ws + WS_HPRE);
    float* hbuf = (float*)(ws + WS_H);
    float* gate = (float*)(ws + WS_GATE);
    int* list = (int*)(ws + WS_LIST);
    _Float16* act16 = (_Float16*)(ws + WS_ACT16);
    _Float16* y16 = (_Float16*)(ws + WS_Y16);
    _Float16* h16 = (_Float16*)(ws + WS_H16);
    _Float16* x16 = (_Float16*)(ws + WS_X16);
    _Float16* wtin = (_Float16*)(ws + WS_WTIN);
    _Float16* wtout = (_Float16*)(ws + WS_WTOUT);
    _Float16* wtgu = (_Float16*)(ws + WS_WTGU);
    _Float16* wtdn = (_Float16*)(ws + WS_WTDN);
    LAS unsigned char* lds = (LAS unsigned char*)smem;
    _Float16* proj16 = (_Float16*)(ws + WS_PROJ16);
    _Float16* kvmem16 = (_Float16*)(ws + WS_KVMEM16);
    _Float16* wt1 = (_Float16*)(ws + WS_WT1);
    float* uv = (float*)(ws + WS_UV);
    _Float16* kc16 = (_Float16*)(ws + WS_KC16);
    _Float16* vc16 = (_Float16*)(ws + WS_VC16);
    _Float16* wr16 = (_Float16*)(ws + WS_WR16);
    signed char* q8gu = (signed char*)(ws + WS_Q8GU); signed char* q8dn = (signed char*)(ws + WS_Q8DN);
    float* sgu = (float*)(ws + WS_SGU); float* sdn = (float*)(ws + WS_SDN);
    signed char* h8q = (signed char*)(ws + WS_H8); float* sah = (float*)(ws + WS_SAH);
    signed char* act8 = (signed char*)(ws + WS_ACT8); float* sact = (float*)(ws + WS_SACT);
    const int vcu = (nb % 8 == 0) ? (bid % 8) * (nb / 8) + bid / 8 : bid;

    volatile LAS unsigned* xbw = (volatile LAS unsigned*)(smem + LDS_BYTES - 16);
    if (tid == 0) { xbw[0] = 0u; xbw[1] = 0u; xbw[2] = 0u; xbw[3] = 0u; }
    __syncthreads();
    XcdBarrier bar; bar.bar = ctl; bar.x = 0; bar.st = xbw;
    const bool multi = (hi - lo) > 1;
    if (multi) bar = xcd_barrier_post(ctl, xbw);
#define IN(k) (lo <= (k) && (k) < hi)
#define SEAM(k) do { if (IN(k) && IN((k) + 1)) xcd_barrier(bar); } while (0)
    float* sw = (float*)smem + wv * WLDS_FLOATS;
    int* segw = (int*)(sw + 4096 + 512);

    if (IN(0)) {
        for (int j = gw; j < 512; j += nw) {
            const int kv = j >> 8, jj = j & 255;
            const float* pos = p.in[kv ? I_POSV : I_POSK]; const float* w1 = p.in[kv ? I_W1V : I_W1K];
            float s = 0.f;
            for (int k = lane; k < 4096; k += 64) s += pos[k] * w1[(size_t)k * 256 + jj];
            s = wave_sum(s);
            if (lane == 0) bias1[j] = s;
        }
        for (int i = bid * 512 + tid; i < 32 * 2048; i += nb * 512) { const int e = i >> 11, d = i & 2047; wr16[i] = (_Float16)p.in[I_WR][(size_t)d * 32 + e]; }
        for (size_t i = (size_t)bid * 512 + tid; i < (size_t)T_ * 2048 / 4; i += (size_t)nb * 512) {
            const float4 v = ((const float4*)p.in[I_X])[i]; ((h4*)x16)[i] = (h4){(_Float16)v.x, (_Float16)v.y, (_Float16)v.z, (_Float16)v.w};
        }
        {
            constexpr int U_GU = NE * 128, U_DN = NE * 64, U_IN = 32 * 15, U_OUT = 32 * 8, U_W1 = 128;
            for (int u = bid; u < U_GU + U_DN; u += nb) {
                if (u < U_GU) { const int e = u >> 7, pn = u & 127;
                    quant_panel(smem, p.in[I_WGU] + (size_t)e * 2048 * 4096, 4096, pn * 32, q8gu + (size_t)e * 4096 * 2048, sgu + (size_t)e * 4096);
                } else { const int v = u - U_GU, e = v >> 6, pn = v & 63;
                    quant_panel(smem, p.in[I_WDN] + (size_t)e * 2048 * 2048, 2048, pn * 32, q8dn + (size_t)e * 2048 * 2048, sdn + (size_t)e * 2048);
                }
            }
            for (int u = bid; u < U_IN + U_OUT + U_W1; u += nb) {
                if (u < U_IN) { const int v = u, kt = v / 15, ntl = v % 15;
                    conv_tile((float*)smem, p.in[I_WIN], INW, INW, wtin, 2048, kt * 64, ntl * 256);
                } else if (u < U_IN + U_OUT) { const int v = u - U_IN, kt = v / 8, ntl = v % 8;
                    conv_tile((float*)smem, p.in[I_WOUT], 2048, 2048, wtout, 2048, kt * 64, ntl * 256);
                } else { const int v = u - U_IN - U_OUT, kv = v >> 6, part = (v >> 5) & 1, kt = v & 31;
                    conv_tile((float*)smem, p.in[kv ? I_W1V : I_W1K] + (size_t)part * 2048 * 256, 256, 256, wt1 + ((size_t)kv * 512 + part * 256) * 2048, 2048, kt * 64, 0);
                }
            }
        }
        for (int u = bid; u < 16 * 8; u += nb) { const int nt = u / 16, mt = u % 16;
            ARowPlain af{p.in[I_MEM], 2048, mt * 128, 2048}; EpiStore ef{kvmem, 1024, mt * 128, nt * 128, 2048, 1024, kvmem16};
            gemm_tile(smem, 2048, af, p.in[I_WMEMKV], 1024, nt * 128, 1024, false, ef);
        }
    }
    SEAM(0);
    if (IN(1)) {
        g8::ProbIn P{x16, wtin, proj16, nb, bid};
        g8::gemm_phase(lds, P);
    }
    SEAM(1);
    if (IN(2)) {
        { g8::ProbCmp P{proj16, wt1, uv, nb, bid}; g8::gemm_phase(lds, P); __syncthreads(); }
        for (size_t i = (size_t)bid * 512 + tid; i < (size_t)T_ * 512; i += (size_t)nb * 512) {
            const int col = (int)(i & 511), row = (int)(i >> 9), t = row & (S_ - 1), g = col >> 7;
            const int win = 2 << g; const int lo_t = max(t + 1 - win, 0); const int n = t + 1 - lo_t;
            float s = 0.f;
            for (int k = 0; k < n; ++k) s += (float)proj16[(size_t)(row - k) * INW + C_UP + col];
            pooled[i] = s / (float)n - (float)proj16[(size_t)row * INW + C_UP + col];
        }
        {
            const int r32 = lane & 31, hi = lane >> 5, g = wv >> 1, half = wv & 1;
            for (int uu = bid; uu < 512; uu += nb) {
                const int u = (uu & 1) ? (511 - (uu >> 1)) : (uu >> 1);
                const int bk = u >> 5, qi = u & 31, b = bk >> 1, kvh = bk & 1;
                const int t = qi * 64 + half * 32 + r32;
                const int lo_t = max(0, qi - 8);
                const unsigned tmask = (unsigned)(((1ull << (qi + 1)) - 1ull) & ~((1ull << lo_t) - 1ull));
                at8::attn_unit(smem, proj16 + (size_t)(b * S_ + t) * INW + C_Q + (kvh * 4 + g) * 128 + hi * 8,
                               proj16 + (size_t)b * S_ * INW + C_KW + kvh * 128, proj16 + (size_t)b * S_ * INW + C_VW + kvh * 128, INW, tmask, t - 511, t, 0xffffffffu,
                               owin + (size_t)(b * S_ + qi * 64 + half * 32) * 1024 + (kvh * 4 + g) * 128, 1024);
            }
            for (int u = bid; u < 256; u += nb) {
                const int b = u >> 5, h = (u >> 3) & 3, qt = u & 7;
                const int t = qt * 256 + wv * 32 + r32;
                at8::attn_unit(smem, proj16 + (size_t)(b * S_ + t) * INW + C_QM + h * 128 + hi * 8,
                               kvmem16 + (size_t)b * 256 * 1024 + h * 128, kvmem16 + (size_t)b * 256 * 1024 + 512 + h * 128, 1024, 0xFu, 0, 255, 0xffffffffu,
                               omem + (size_t)(b * S_ + qt * 256 + wv * 32) * 512 + h * 128, 512);
            }
        }
    }
    SEAM(2);
    if (IN(3)) {
        {   float* hs = (float*)smem;
            for (int u = bid; u < 508; u += nb) {
                const int kv = u / 254, ub = u % 254;
                const float* w2 = p.in[kv ? I_W2V : I_W2K]; _Float16* dst = kv ? vc16 : kc16;
                __syncthreads();
#pragma unroll
                for (int q = 0; q < 4; ++q) { const int e = tid + 512 * q, i = e >> 8, n = e & 255;
                    const int idx = ub * 8 + i, b = idx / 254, rem = idx % 254, c = rem >> 1, kvh = rem & 1;
                    const int row = (b * 128 + c) * 2 + kvh;
                    float a = bias1[kv * 256 + n];
#pragma unroll
                    for (int sp = 0; sp < 4; ++sp) { const float* base = uv + ((size_t)(kv * 4 + sp) * 2048) * 512; a += base[(size_t)row * 512 + n] + base[(size_t)(row + 2) * 512 + 256 + n]; }
                    hs[i * 256 + n] = gelu_tanh(a); }
                __syncthreads();
#pragma unroll
                for (int q = 0; q < 2; ++q) { const int e = tid + 512 * q, i = e >> 7, d = e & 127;
                    const int idx = ub * 8 + i, b = idx / 254, rem = idx % 254, c = rem >> 1, kvh = rem & 1;
                    float a = 0.f;
                    for (int n = 0; n < 256; ++n) a += hs[i * 256 + n] * w2[n * 128 + d];
                    dst[(size_t)((b * 128 + c) * 2 + kvh) * 128 + d] = (_Float16)a; }
            }
            __syncthreads();
            for (int i = bid * 512 + tid; i < 2 * B_ * 256; i += nb * 512) { const int kv = i / (B_ * 256), r = i % (B_ * 256), b = r >> 8, x = r & 255;
                (kv ? vc16 : kc16)[(size_t)(b * 128 + 127) * 256 + x] = (_Float16)0.f; }
        }
        for (int u = bid; u < 128 * 4; u += nb) { const int g = u >> 7, mt = u & 127;
            ARowPlain af{pooled + g * 128, 512, mt * 128, T_}; EpiPool ef{opool, p.in[I_POOLS], mt * 128, g};
            gemm_tile(smem, 128, af, p.in[I_POOLW] + (size_t)g * 128 * 128, 128, 0, 128, false, ef);
        }
    }
    SEAM(3);
    if (IN(4)) {
        const int r32 = lane & 31, hi = lane >> 5, g = wv >> 1, half = wv & 1;
        for (int uu = bid; uu < 512; uu += nb) {
            const int u = (uu & 1) ? (511 - (uu >> 1)) : (uu >> 1);
            const int bk = u >> 5, qi = u & 31, b = bk >> 1, kvh = bk & 1;
            const int tl = half * 32 + r32, t = qi * 64 + tl;
            at8::cmp_slc_unit(smem, proj16 + (size_t)(b * S_ + t) * INW + C_Q + (kvh * 4 + g) * 128 + hi * 8,
                              kc16 + (size_t)(b * 128 * 2 + kvh) * 128, vc16 + (size_t)(b * 128 * 2 + kvh) * 128,
                              proj16 + (size_t)b * S_ * INW + C_KS + kvh * 128, proj16 + (size_t)b * S_ * INW + C_VS + kvh * 128, t, tl, g, qi,
                              ocmp + (size_t)(b * S_ + qi * 64 + half * 32) * 1024 + (kvh * 4 + g) * 128, oslc + (size_t)(b * S_ + qi * 64 + half * 32) * 1024 + (kvh * 4 + g) * 128);
        }
    }
    SEAM(4);
    if (IN(5)) {
        for (int row = gw; row < T_; row += nw) {
            const _Float16* pr = proj16 + (size_t)row * INW;
            float v[16]; float ss = 0.f;
#pragma unroll
            for (int i = 0; i < 16; ++i) { const int col = lane + 64 * i, h = col >> 7; const size_t o = (size_t)row * 1024 + col;
                const float g0 = sigmoidf_((float)pr[C_G + h * 3]), g1 = sigmoidf_((float)pr[C_G + h * 3 + 1]), g2 = sigmoidf_((float)pr[C_G + h * 3 + 2]);
                v[i] = g0 * ocmp[o] + g1 * oslc[o] + g2 * owin[o]; ss += v[i] * v[i]; }
            ss = wave_sum(ss); float r = rsqrtf(ss / 1024.f + LN_EPS);
#pragma unroll
            for (int i = 0; i < 16; ++i) { const int col = lane + 64 * i; cat16[(size_t)row * 2048 + col] = (_Float16)(v[i] * r * p.in[I_GNNSA][col]); }
            ss = 0.f;
#pragma unroll
            for (int i = 0; i < 8; ++i) { v[i] = opool[(size_t)row * 512 + lane + 64 * i]; ss += v[i] * v[i]; }
            ss = wave_sum(ss); r = rsqrtf(ss / 512.f + LN_EPS);
#pragma unroll
            for (int i = 0; i < 8; ++i) { const int col = lane + 64 * i; cat16[(size_t)row * 2048 + 1024 + col] = (_Float16)(v[i] * r * p.in[I_GNPOOL][col]); }
            ss = 0.f;
#pragma unroll
            for (int i = 0; i < 8; ++i) { v[i] = omem[(size_t)row * 512 + lane + 64 * i]; ss += v[i] * v[i]; }
            ss = wave_sum(ss); r = rsqrtf(ss / 512.f + LN_EPS);
#pragma unroll
            for (int i = 0; i < 8; ++i) { const int col = lane + 64 * i; cat16[(size_t)row * 2048 + 1536 + col] = (_Float16)(v[i] * r * p.in[I_GNMEM][col]); }
        }
    }
    SEAM(5);
    if (IN(6)) {
        g8::ProbOut P{cat16, wtout, hpre16, x16, nb, bid};
        g8::gemm_phase(lds, P);
    }
    SEAM(6);
    if (IN(7)) {
        float* lg = (float*)smem;
        const int r32 = lane & 31, hi = lane >> 5, fr = lane & 15, fq = lane >> 4;
        for (int u = bid; u < T_ / 64; u += nb) {
            const int base = u * 64;
#pragma unroll 1
            for (int i = 0; i < 8; ++i) {
                const int row = base + wv * 8 + i;
                float v[32]; float s = 0.f;
#pragma unroll
                for (int c = 0; c < 4; ++c) { const int col = (lane + 64 * c) * 8;
                    const h8 a0 = *(const h8*)(hpre16 + (size_t)row * 2048 + col);
#pragma unroll
                    for (int q = 0; q < 8; ++q) { v[c * 8 + q] = (float)a0[q]; s += v[c * 8 + q]; } }
                const float mu = wave_sum(s) / 2048.f; float q2 = 0.f;
#pragma unroll
                for (int k = 0; k < 32; ++k) { const float d = v[k] - mu; q2 += d * d; }
                const float rs = rsqrtf(wave_sum(q2) / 2048.f + LN_EPS);
                float amax = 0.f;
#pragma unroll
                for (int c = 0; c < 4; ++c) { const int col = (lane + 64 * c) * 8;
                    const float4 g0 = *(const float4*)(p.in[I_LN1G] + col), g1 = *(const float4*)(p.in[I_LN1G] + col + 4), b0 = *(const float4*)(p.in[I_LN1B] + col), b1 = *(const float4*)(p.in[I_LN1B] + col + 4);
                    float4 o0, o1;
                    o0.x = (v[c * 8 + 0] - mu) * rs * g0.x + b0.x; o0.y = (v[c * 8 + 1] - mu) * rs * g0.y + b0.y; o0.z = (v[c * 8 + 2] - mu) * rs * g0.z + b0.z; o0.w = (v[c * 8 + 3] - mu) * rs * g0.w + b0.w;
                    o1.x = (v[c * 8 + 4] - mu) * rs * g1.x + b1.x; o1.y = (v[c * 8 + 5] - mu) * rs * g1.y + b1.y; o1.z = (v[c * 8 + 6] - mu) * rs * g1.z + b1.z; o1.w = (v[c * 8 + 7] - mu) * rs * g1.w + b1.w;
                    *(float4*)(hbuf + (size_t)row * 2048 + col) = o0; *(float4*)(hbuf + (size_t)row * 2048 + col + 4) = o1;
                    h8 oh; oh[0] = (_Float16)o0.x; oh[1] = (_Float16)o0.y; oh[2] = (_Float16)o0.z; oh[3] = (_Float16)o0.w; oh[4] = (_Float16)o1.x; oh[5] = (_Float16)o1.y; oh[6] = (_Float16)o1.z; oh[7] = (_Float16)o1.w;
                    *(h8*)(h16 + (size_t)row * 2048 + col) = oh;
                    v[c * 8 + 0] = o0.x; v[c * 8 + 1] = o0.y; v[c * 8 + 2] = o0.z; v[c * 8 + 3] = o0.w; v[c * 8 + 4] = o1.x; v[c * 8 + 5] = o1.y; v[c * 8 + 6] = o1.z; v[c * 8 + 7] = o1.w;
                    amax = fmaxf(amax, fmaxf(fmaxf(fmaxf(fabsf(o0.x), fabsf(o0.y)), fmaxf(fabsf(o0.z), fabsf(o0.w))), fmaxf(fmaxf(fabsf(o1.x), fabsf(o1.y)), fmaxf(fabsf(o1.z), fabsf(o1.w))))); }
                amax = wave_max(amax);
                const float qinv = amax > 0.f ? 127.f / amax : 0.f;
                if (lane == 0) sah[row] = amax > 0.f ? amax / 127.f : 1.f;
#pragma unroll
                for (int c = 0; c < 4; ++c) { const int col = (lane + 64 * c) * 8;
                    uint2 q; q.x = pack4_i8(v[c * 8 + 0] * qinv, v[c * 8 + 1] * qinv, v[c * 8 + 2] * qinv, v[c * 8 + 3] * qinv); q.y = pack4_i8(v[c * 8 + 4] * qinv, v[c * 8 + 5] * qinv, v[c * 8 + 6] * qinv, v[c * 8 + 7] * qinv);
                    *(uint2*)(h8q + (size_t)row * 2048 + col) = q; }
            }
            asm volatile("s_waitcnt vmcnt(0)" ::: "memory");
            __syncthreads();
            {
                const int tok0 = base + 16 * (wv >> 1), e0 = 16 * (wv & 1);
                const _Float16* ap = h16 + (size_t)(tok0 + fr) * 2048 + fq * 8; const _Float16* bp = wr16 + (size_t)(e0 + fr) * 2048 + fq * 8;
                f4 acc = (f4){0.f, 0.f, 0.f, 0.f};
#pragma unroll 8
                for (int sI = 0; sI < 64; ++sI) { const h8 a = *(const h8*)(ap + sI * 32), bb = *(const h8*)(bp + sI * 32); acc = __builtin_amdgcn_mfma_f32_16x16x32_f16(a, bb, acc, 0, 0, 0); }
                const float br = p.in[I_BR][e0 + fr];
#pragma unroll
                for (int j = 0; j < 4; ++j) lg[(16 * (wv >> 1) + 4 * fq + j) * 33 + e0 + fr] = acc[j] + br;
            }
            __syncthreads();
#pragma unroll 1
            for (int it = 0; it < 4; ++it) {
                const int tk = 8 * wv + 2 * it + hi;
                const float iv = lg[tk * 33 + r32];
                int rank = 0;
                for (int i = 0; i < 32; ++i) { const float vi = __shfl(iv, i + 32 * hi); rank += (vi > iv || (vi == iv && i < r32)) ? 1 : 0; }
                float tv[4]; int te[4];
#pragma unroll
                for (int r = 0; r < 4; ++r) { const unsigned long long bm = __ballot(rank == r); const unsigned hm = (unsigned)(bm >> (32 * hi)); const int src = __ffs(hm) - 1; te[r] = src; tv[r] = __shfl(iv, src + 32 * hi); }
                const float e0v = 1.f, e1v = expf(tv[1] - tv[0]), e2v = expf(tv[2] - tv[0]), e3v = expf(tv[3] - tv[0]); const float inv = 1.f / (e0v + e1v + e2v + e3v);
                if (r32 < 4) { const int e = r32 == 0 ? te[0] : r32 == 1 ? te[1] : r32 == 2 ? te[2] : te[3]; const float g = (r32 == 0 ? e0v : r32 == 1 ? e1v : r32 == 2 ? e2v : e3v) * inv;
                    const int a = (base + tk) * 4 + r32; const int pos = atomicAdd(&cnt[e], 1); list[(size_t)e * T_ + pos] = a; gate[a] = g; }
            }
            __syncthreads();
        }
    }
    SEAM(7);
    LAS int* mtab = (LAS int*)(smem + g8::STAGE_BYTES);
    if (IN(8)) {
        if (tid == 0) { int ub = 0, rs = 0;
            for (int e = 0; e < NE; ++e) { const int c = (int)__hip_atomic_load((unsigned*)&cnt[e], __ATOMIC_RELAXED, __HIP_MEMORY_SCOPE_AGENT); mtab[e] = c; mtab[32 + e] = ub; mtab[65 + e] = rs; ub += ((c + 255) >> 8) * 16; rs += c; }
            mtab[64] = ub; mtab[97] = rs; mtab[98] = ub; }
        __syncthreads();
        g8::ProbGu P{h8q, q8gu, act16, p.in[I_BGU], list, sah, sgu, g8::MoeTab{mtab, 16}, nb, vcu};
        g8::gemm_phase(lds, P);
        __syncthreads();
    }
    SEAM(8);
    if (IN(9)) {
        for (int row = gw; row < NA; row += nw) {
            float v[32]; float amax = 0.f;
#pragma unroll
            for (int c = 0; c < 4; ++c) { const h8 a = *(const h8*)(act16 + (size_t)row * 2048 + (lane + 64 * c) * 8);
#pragma unroll
                for (int q = 0; q < 8; ++q) { v[c * 8 + q] = (float)a[q]; amax = fmaxf(amax, fabsf(v[c * 8 + q])); } }
            amax = wave_max(amax);
            const float qinv = amax > 0.f ? 127.f / amax : 0.f;
            if (lane == 0) sact[row] = amax > 0.f ? amax / 127.f : 1.f;
#pragma unroll
            for (int c = 0; c < 4; ++c) { uint2 q; q.x = pack4_i8(v[c * 8 + 0] * qinv, v[c * 8 + 1] * qinv, v[c * 8 + 2] * qinv, v[c * 8 + 3] * qinv); q.y = pack4_i8(v[c * 8 + 4] * qinv, v[c * 8 + 5] * qinv, v[c * 8 + 6] * qinv, v[c * 8 + 7] * qinv);
                *(uint2*)(act8 + (size_t)row * 2048 + (lane + 64 * c) * 8) = q; }
        }
    }
    SEAM(9);
    if (IN(10)) {
        if (tid == 0) { int ub = 0, rs = 0;
            for (int e = 0; e < NE; ++e) { const int c = (int)__hip_atomic_load((unsigned*)&cnt[e], __ATOMIC_RELAXED, __HIP_MEMORY_SCOPE_AGENT); mtab[e] = c; mtab[32 + e] = ub; mtab[65 + e] = rs; ub += ((c + 255) >> 8) * 8; rs += c; }
            mtab[64] = ub; mtab[97] = rs; mtab[98] = ub; }
        __syncthreads();
        g8::ProbDn P{act8, q8dn, y16, p.in[I_BDN], list, gate, sact, sdn, g8::MoeTab{mtab, 8}, nb, vcu};
        g8::gemm_phase(lds, P);
        __syncthreads();
    }
    SEAM(10);
    if (IN(11)) {
        for (int row = gw; row < T_; row += nw) {
            float v[32]; float s = 0.f;
#pragma unroll
            for (int c = 0; c < 4; ++c) { const int col = (lane + 64 * c) * 8; const size_t yo = (size_t)row * 4 * 2048 + col;
                const float4 ha = *(const float4*)(hbuf + (size_t)row * 2048 + col), hb = *(const float4*)(hbuf + (size_t)row * 2048 + col + 4);
                const h8 y0 = *(const h8*)(y16 + yo), y1 = *(const h8*)(y16 + yo + 2048), y2 = *(const h8*)(y16 + yo + 4096), y3 = *(const h8*)(y16 + yo + 6144);
                const float hh[8] = {ha.x, ha.y, ha.z, ha.w, hb.x, hb.y, hb.z, hb.w};
#pragma unroll
                for (int q = 0; q < 8; ++q) { v[c * 8 + q] = DN_ALPHA * hh[q] + (((float)y0[q] + (float)y1[q]) + ((float)y2[q] + (float)y3[q])); s += v[c * 8 + q]; } }
            const float mu = wave_sum(s) / 2048.f; float q2 = 0.f;
#pragma unroll
            for (int i = 0; i < 32; ++i) { const float d = v[i] - mu; q2 += d * d; }
            const float rs = rsqrtf(wave_sum(q2) / 2048.f + LN_EPS);
#pragma unroll
            for (int c = 0; c < 4; ++c) { const int col = (lane + 64 * c) * 8;
                const float4 ga = *(const float4*)(p.in[I_LN2G] + col), gb = *(const float4*)(p.in[I_LN2G] + col + 4), ba = *(const float4*)(p.in[I_LN2B] + col), bb = *(const float4*)(p.in[I_LN2B] + col + 4);
                float4 o0, o1;
                o0.x = (v[c * 8 + 0] - mu) * rs * ga.x + ba.x; o0.y = (v[c * 8 + 1] - mu) * rs * ga.y + ba.y; o0.z = (v[c * 8 + 2] - mu) * rs * ga.z + ba.z; o0.w = (v[c * 8 + 3] - mu) * rs * ga.w + ba.w;
                o1.x = (v[c * 8 + 4] - mu) * rs * gb.x + bb.x; o1.y = (v[c * 8 + 5] - mu) * rs * gb.y + bb.y; o1.z = (v[c * 8 + 6] - mu) * rs * gb.z + bb.z; o1.w = (v[c * 8 + 7] - mu) * rs * gb.w + bb.w;
                *(float4*)(p.out + (size_t)row * 2048 + col) = o0; *(float4*)(p.out + (size_t)row * 2048 + col + 4) = o1; }
        }
    }
}

constexpr int NPHASE = 12;

extern "C" void kernel_launch(void* const* d_in, const int* in_sizes, int n_in, void* d_out, int out_size, void* d_ws, size_t ws_size, hipStream_t stream) {
    static int grid = 0;
    if (grid == 0) {
        if (n_in != 26 || ws_size < WS_END) { fprintf(stderr, "kernel_launch: unexpected n_in %d or ws_size %zu (< %zu)\n", n_in, ws_size, (size_t)WS_END); grid = -1; return; }
        int dev = 0, cus = 0, per_cu = 0;
        hipGetDevice(&dev); hipDeviceGetAttribute(&cus, hipDeviceAttributeMultiprocessorCount, dev);
        if (hipFuncSetAttribute((const void*)fwd, hipFuncAttributeMaxDynamicSharedMemorySize, LDS_BYTES) != hipSuccess) { fprintf(stderr, "hipFuncSetAttribute failed\n"); grid = -1; return; }
        hipOccupancyMaxActiveBlocksPerMultiprocessor(&per_cu, (const void*)fwd, 512, LDS_BYTES);
        (void)hipGetLastError();
        if (per_cu < 1) fprintf(stderr, "occupancy query says %d blocks per CU\n", per_cu);
        grid = cus > 0 ? cus : 256;
    }
    if (grid < 0) return;
    hipMemsetAsync((char*)d_ws + WS_CTL, 0, CTL_BYTES, stream);
    Params p{};
    for (int i = 0; i < 26; ++i) p.in[i] = (const float*)d_in[i];
    p.out = (float*)d_out; p.ws = (unsigned char*)d_ws;
#if N_LAUNCH_MODE == 1
    p.lo_hi = (long long)0 | ((long long)NPHASE << 32);
    hipLaunchKernelGGL(fwd, dim3(grid), dim3(512), LDS_BYTES, stream, p);
#else
    for (int ph = 0; ph < NPHASE; ++ph) {
        p.lo_hi = (long long)ph | ((long long)(ph + 1) << 32);
        hipLaunchKernelGGL(fwd, dim3(grid), dim3(512), LDS_BYTES, stream, p);
    }
#endif
}
```

```cpp
#include <hip/hip_runtime.h>
#include <cstdio>
#include <cstdint>

#ifndef N_LAUNCH_MODE
#define N_LAUNCH_MODE 1
#endif

constexpr int B_ = 8, S_ = 2048, D_ = 2048, T_ = B_ * S_;
constexpr int INW = 3608;
constexpr int C_Q = 0, C_KC = 1024, C_VC = 1280, C_KS = 1536, C_VS = 1792, C_KW = 2048, C_VW = 2304, C_G = 2560, C_UP = 2584, C_QM = 3096;
constexpr int NC = 127;
constexpr int CROWS = B_ * NC * 2;
constexpr int NE = 32, DE = 2048, NA = T_ * 4;
constexpr float LN_EPS = 1e-5f;
constexpr float DN_ALPHA = 1.189207115002721f;
constexpr float ATT_SCALE = 0.08838834764831845f;

constexpr size_t al256(size_t x) { return (x + 255) & ~(size_t)255; }
constexpr size_t WS_CTL = 0;
constexpr size_t CTL_BYTES = 65536;
constexpr size_t CTL_CNT = 16384;
constexpr size_t WS_PROJ = CTL_BYTES;
constexpr size_t WS_KVMEM = WS_PROJ + al256((size_t)T_ * INW * 4);
constexpr size_t WS_BIAS1 = WS_KVMEM + al256((size_t)2048 * 1024 * 4);
constexpr size_t WS_HID = WS_BIAS1 + al256(2 * 256 * 4);
constexpr size_t WS_KC = WS_HID + al256((size_t)2 * 2048 * 256 * 4);
constexpr size_t WS_VC = WS_KC + al256((size_t)CROWS * 128 * 4);
constexpr size_t WS_POOLED = WS_VC + al256((size_t)CROWS * 128 * 4);
constexpr size_t WS_OPOOL = WS_POOLED + al256((size_t)T_ * 512 * 4);
constexpr size_t WS_OWIN = WS_OPOOL + al256((size_t)T_ * 512 * 4);
constexpr size_t WS_OCMP = WS_OWIN + al256((size_t)T_ * 1024 * 4);
constexpr size_t WS_OSLC = WS_OCMP + al256((size_t)T_ * 1024 * 4);
constexpr size_t WS_SEL = WS_OSLC + al256((size_t)T_ * 1024 * 4);
constexpr size_t WS_OMEM = WS_SEL + al256((size_t)T_ * 2 * 4);
constexpr size_t WS_CAT16 = WS_OMEM + al256((size_t)T_ * 512 * 4);
constexpr size_t WS_HPRE = WS_CAT16 + al256((size_t)T_ * 2048 * 2);
constexpr size_t WS_H = WS_HPRE + al256((size_t)T_ * 2048 * 4);
constexpr size_t WS_H16 = WS_H + al256((size_t)T_ * 2048 * 4);
constexpr size_t WS_GATE = WS_H16 + al256((size_t)T_ * 2048 * 2);
constexpr size_t WS_LIST = WS_GATE + al256((size_t)NA * 4);
constexpr size_t WS_ACT16 = WS_LIST + al256((size_t)NE * T_ * 4);
constexpr size_t WS_Y16 = WS_ACT16 + al256((size_t)(NA + 256) * 2048 * 2);
constexpr size_t WS_X16 = WS_Y16 + al256((size_t)NA * 2048 * 2);
constexpr size_t WS_MEM16 = WS_X16 + (size_t)T_ * 2048 * 2;
constexpr size_t WS_WTIN = WS_MEM16 + al256((size_t)2048 * 2048 * 2);
constexpr size_t WS_WTOUT = WS_WTIN + al256((size_t)3840 * 2048 * 2);
constexpr size_t WS_WTGU = WS_WTOUT + al256((size_t)2048 * 2048 * 2);
constexpr size_t WS_WTDN = WS_WTGU + al256((size_t)NE * 4096 * 2048 * 2);
constexpr size_t WS_PROJ16 = WS_WTDN + al256((size_t)NE * 2048 * 2048 * 2);
constexpr size_t WS_KVMEM16 = WS_PROJ16 + al256((size_t)(T_ + 64) * INW * 2);
constexpr size_t WS_WT1 = WS_KVMEM16 + al256((size_t)2048 * 1024 * 2);
constexpr size_t WS_UV = WS_WT1 + al256((size_t)2 * 512 * 2048 * 2);
constexpr size_t WS_KC16 = WS_UV + al256((size_t)2 * 4 * 2048 * 512 * 4);
constexpr size_t WS_VC16 = WS_KC16 + al256((size_t)B_ * 128 * 256 * 2);
constexpr size_t WS_WR16 = WS_VC16 + al256((size_t)B_ * 128 * 256 * 2);
constexpr size_t WS_Q8GU = WS_WR16 + al256((size_t)32 * 2048 * 2);
constexpr size_t WS_Q8DN = WS_Q8GU + al256((size_t)NE * 4096 * 2048);
constexpr size_t WS_SGU = WS_Q8DN + al256((size_t)NE * 2048 * 2048);
constexpr size_t WS_SDN = WS_SGU + al256((size_t)NE * 4096 * 4);
constexpr size_t WS_H8 = WS_SDN + al256((size_t)NE * 2048 * 4);
constexpr size_t WS_SAH = WS_H8 + al256((size_t)T_ * 2048);
constexpr size_t WS_ACT8 = WS_SAH + al256((size_t)T_ * 4);
constexpr size_t WS_SACT = WS_ACT8 + al256((size_t)(NA + 256) * 2048);
constexpr size_t WS_WTMKV = WS_SACT + al256((size_t)(NA + 256) * 4);
constexpr size_t WS_END = WS_WTMKV + al256((size_t)1024 * 2048 * 2);

constexpr int LDS_BYTES = 155648;

struct Params {
    const float* in[26];
    float* out;
    unsigned char* ws;
    long long lo_hi;
};
enum { I_X = 0, I_MEM, I_WIN, I_POSK, I_W1K, I_W2K, I_POSV, I_W1V, I_W2V, I_POOLW, I_POOLS, I_WMEMKV, I_GNNSA, I_GNPOOL, I_GNMEM, I_WOUT,
       I_LN1G, I_LN1B, I_WR, I_BR, I_WGU, I_BGU, I_WDN, I_BDN, I_LN2G, I_LN2B };

#define XB_TMO      128
#define XB_XCNT(j)  (256  + 64 * (j))
#define XB_XSUB(j)  (1280 + 64 * (j))
#define XB_XGEN(j)  (2304 + 64 * (j))
#define XB_TOP      3328
#define XB_TOPGEN   3392
#define XCD_BAR_WORDS 3456
#define XB_SPIN_CAP (1u << 25)
#define LAS __attribute__((address_space(3)))

__device__ __forceinline__ unsigned xb_ld(unsigned* p)              { return __hip_atomic_load(p, __ATOMIC_RELAXED, __HIP_MEMORY_SCOPE_AGENT); }
__device__ __forceinline__ unsigned xb_add(unsigned* p, unsigned v) { return __hip_atomic_fetch_add(p, v, __ATOMIC_RELAXED, __HIP_MEMORY_SCOPE_AGENT); }
__device__ __forceinline__ unsigned xb_xcc_id() { return (unsigned)__builtin_amdgcn_s_getreg((3 << 11) | 20) & 0xFu; }
#define XB_SPIN(cond, bar) do { unsigned _sp = 0; while (cond) { __builtin_amdgcn_s_sleep(1); \
    if ((++_sp & 255u) == 0u) { if (xb_ld(&(bar)[XB_TMO])) break; if (_sp > XB_SPIN_CAP) { atomicAdd(&(bar)[XB_TMO], 1u); break; } } } } while (0)

struct XcdBarrier { unsigned* bar; unsigned x; volatile LAS unsigned* st; };

__device__ __forceinline__ XcdBarrier xcd_barrier_post(unsigned* bar, volatile LAS unsigned* st) {
    XcdBarrier b; b.bar = bar; b.x = xb_xcc_id(); b.st = st;
    if (threadIdx.x == 0) (void)xb_add(&bar[XB_XCNT(b.x)], 1u);
    return b;
}
__device__ __forceinline__ void xcd_barrier_complete(unsigned* bar, unsigned x, unsigned& nloc, unsigned& nx) {
    const unsigned G = gridDim.x * gridDim.y * gridDim.z;
    unsigned sum, cnt, mine, sp = 0u;
    for (;;) {
        sum = 0u; cnt = 0u; mine = 0u;
#pragma unroll
        for (unsigned j = 0; j < 16; ++j) { const unsigned c = xb_ld(&bar[XB_XCNT(j)]); sum += c; cnt += (c > 0u) ? 1u : 0u; mine = (j == x) ? c : mine; }
        if (sum == G) break;
        __builtin_amdgcn_s_sleep(1);
        if ((++sp & 255u) == 0u) { if (xb_ld(&bar[XB_TMO])) break; if (sp > XB_SPIN_CAP) { atomicAdd(&bar[XB_TMO], 1u); break; } }
    }
    nloc = mine > 0u ? mine : 1u; nx = cnt > 0u ? cnt : 1u;
}
__device__ __forceinline__ void xcd_barrier(const XcdBarrier& b) {
    asm volatile("s_waitcnt vmcnt(0)" ::: "memory");
    __syncthreads();
    if (threadIdx.x == 0) {
        unsigned* bar = b.bar;
        __builtin_amdgcn_s_waitcnt(0);
        unsigned nloc = b.st[0], nx = b.st[1];
        if (nloc == 0u) { xcd_barrier_complete(bar, b.x, nloc, nx); b.st[0] = nloc; b.st[1] = nx; }
        const unsigned old = xb_add(&bar[XB_XSUB(b.x)], 1u);
        const unsigned gen = old / nloc;
        if (old + 1u == (gen + 1u) * nloc) {
            __builtin_amdgcn_fence(__ATOMIC_RELEASE, "agent");
            asm volatile("s_waitcnt vmcnt(0)" ::: "memory");
            const unsigned og = xb_add(&bar[XB_TOP], 1u);
            const unsigned tg = og / nx;
            if (og + 1u == (tg + 1u) * nx) xb_add(&bar[XB_TOPGEN], 1u);
            else XB_SPIN(xb_ld(&bar[XB_TOPGEN]) == tg, bar);
            __builtin_amdgcn_fence(__ATOMIC_ACQUIRE, "agent");
            xb_add(&bar[XB_XGEN(b.x)], 1u);
            asm volatile("s_waitcnt vmcnt(0)" ::: "memory");
        } else {
            XB_SPIN(xb_ld(&bar[XB_XGEN(b.x)]) == gen, bar);
            __builtin_amdgcn_fence(__ATOMIC_ACQUIRE, "agent");
            asm volatile("s_waitcnt vmcnt(0)" ::: "memory");
        }
    }
    __syncthreads();
}

typedef _Float16 h8 __attribute__((ext_vector_type(8)));
typedef _Float16 h4 __attribute__((ext_vector_type(4)));
typedef float f4 __attribute__((ext_vector_type(4)));

__device__ __forceinline__ float wave_sum(float v) {
#pragma unroll
    for (int o = 32; o > 0; o >>= 1) v += __shfl_xor(v, o);
    return v;
}
__device__ __forceinline__ float wave_max(float v) {
#pragma unroll
    for (int o = 32; o > 0; o >>= 1) v = fmaxf(v, __shfl_xor(v, o));
    return v;
}
__device__ __forceinline__ void wave_sync() {
    asm volatile("s_waitcnt lgkmcnt(0)" ::: "memory");
    __builtin_amdgcn_wave_barrier();
}
__device__ __forceinline__ float gelu_tanh(float x) {
    const float u = 0.7978845608028654f * (x + 0.044715f * x * x * x);
    return 0.5f * x * (1.f + tanhf(u));
}
__device__ __forceinline__ float sigmoidf_(float x) { return 1.f / (1.f + expf(-x)); }
__device__ __forceinline__ float swiglu_fast(float g, float l) { const float xg = fminf(g, 7.f), xl = fminf(fmaxf(l, -7.f), 7.f); return xg * __builtin_amdgcn_rcpf(1.f + __builtin_amdgcn_exp2f(-2.4554669595930156f * xg)) * (xl + 1.f); }

constexpr int G_LD = 40;
template <class AF, class EF>
__device__ __forceinline__ void gemm_tile(char* smem, int K, const AF& af, const float* __restrict__ Bm, int ldb, int n0, int Nlim, bool perm, const EF& ef) {
    _Float16* As = (_Float16*)smem;
    _Float16* Bs = As + 128 * G_LD;
    const int tid = threadIdx.x, lane = tid & 63, wid = tid >> 6, wr = wid >> 2, wc = wid & 3, fr = lane & 15, fq = lane >> 4;
    f4 acc[4][2];
#pragma unroll
    for (int m = 0; m < 4; ++m)
#pragma unroll
        for (int n = 0; n < 2; ++n) acc[m][n] = (f4){0.f, 0.f, 0.f, 0.f};
    const int ar = tid >> 3, ak = (tid & 7) * 4;
    const float* ap0 = af.row(ar);
    const float* ap1 = af.row(ar + 64);
    const int bk = tid >> 5, bn = (tid & 31) * 4;
    const bool bok = (n0 + bn) < Nlim;
    int bnp[4];
#pragma unroll
    for (int i = 0; i < 4; ++i) { const int c = bn + i; bnp[i] = perm ? ((c & ~31) | ((c & 1) << 4) | ((c & 31) >> 1)) : c; }
    for (int k0 = 0; k0 < K; k0 += 32) {
        const int ko = af.koff(k0 + ak);
        float4 a0 = make_float4(0.f, 0.f, 0.f, 0.f), a1 = a0, b0 = a0, b1 = a0;
        if (ap0) a0 = *(const float4*)(ap0 + ko);
        if (ap1) a1 = *(const float4*)(ap1 + ko);
        if (bok) { b0 = *(const float4*)(Bm + (size_t)(k0 + bk) * ldb + n0 + bn); b1 = *(const float4*)(Bm + (size_t)(k0 + bk + 16) * ldb + n0 + bn); }
        __syncthreads();
        *(h4*)&As[ar * G_LD + ak] = (h4){(_Float16)a0.x, (_Float16)a0.y, (_Float16)a0.z, (_Float16)a0.w};
        *(h4*)&As[(ar + 64) * G_LD + ak] = (h4){(_Float16)a1.x, (_Float16)a1.y, (_Float16)a1.z, (_Float16)a1.w};
        Bs[bnp[0] * G_LD + bk] = (_Float16)b0.x; Bs[bnp[1] * G_LD + bk] = (_Float16)b0.y; Bs[bnp[2] * G_LD + bk] = (_Float16)b0.z; Bs[bnp[3] * G_LD + bk] = (_Float16)b0.w;
        Bs[bnp[0] * G_LD + bk + 16] = (_Float16)b1.x; Bs[bnp[1] * G_LD + bk + 16] = (_Float16)b1.y; Bs[bnp[2] * G_LD + bk + 16] = (_Float16)b1.z; Bs[bnp[3] * G_LD + bk + 16] = (_Float16)b1.w;
        __syncthreads();
        h8 a[4], b[2];
#pragma unroll
        for (int m = 0; m < 4; ++m) a[m] = *(const h8*)&As[(wr * 64 + m * 16 + fr) * G_LD + fq * 8];
#pragma unroll
        for (int n = 0; n < 2; ++n) b[n] = *(const h8*)&Bs[(wc * 32 + n * 16 + fr) * G_LD + fq * 8];
#pragma unroll
        for (int m = 0; m < 4; ++m)
#pragma unroll
            for (int n = 0; n < 2; ++n) acc[m][n] = __builtin_amdgcn_mfma_f32_16x16x32_f16(a[m], b[n], acc[m][n], 0, 0, 0);
    }
    ef(acc, wr, wc, fr, fq);
    __syncthreads();
}

struct ARowPlain { const float* base; int ld; int m0; int mlim;
    __device__ __forceinline__ const float* row(int r) const { return (m0 + r) < mlim ? base + (size_t)(m0 + r) * ld : nullptr; }
    __device__ __forceinline__ int koff(int k) const { return k; } };
struct ARowCmp { const float* proj; int col; int m0;
    __device__ __forceinline__ const float* row(int r) const { const int g = m0 + r; if (g >= CROWS) return nullptr; const int kvh = g & 1, bc = g >> 1, b = bc / NC, c = bc % NC;
        return proj + (size_t)(b * S_ + 16 * c) * INW + col + kvh * 128; }
    __device__ __forceinline__ int koff(int k) const { return (k >> 7) * INW + (k & 127); } };
struct ARowList { const float* base; const int* list; int m0; int cnt; int shift;
    __device__ __forceinline__ const float* row(int r) const { if (m0 + r >= cnt) return nullptr; const int a = list[m0 + r]; return base + (size_t)(a >> shift) * 2048; }
    __device__ __forceinline__ int koff(int k) const { return k; } };

struct EpiStore { float* C; int ldc; int m0; int n0; int mlim; int nlim; _Float16* C16;
    __device__ __forceinline__ void operator()(const f4 (&acc)[4][2], int wr, int wc, int fr, int fq) const {
#pragma unroll
        for (int m = 0; m < 4; ++m)
#pragma unroll
            for (int n = 0; n < 2; ++n)
#pragma unroll
                for (int j = 0; j < 4; ++j) { const int r = m0 + wr * 64 + m * 16 + fq * 4 + j, c = n0 + wc * 32 + n * 16 + fr;
                    if (r < mlim && c < nlim) { C[(size_t)r * ldc + c] = acc[m][n][j]; if (C16) C16[(size_t)r * ldc + c] = (_Float16)acc[m][n][j]; } } } };
struct EpiPool { float* C; const float* scale; int m0; int g;
    __device__ __forceinline__ void operator()(const f4 (&acc)[4][2], int wr, int wc, int fr, int fq) const {
#pragma unroll
        for (int m = 0; m < 4; ++m)
#pragma unroll
            for (int n = 0; n < 2; ++n)
#pragma unroll
                for (int j = 0; j < 4; ++j) { const int r = m0 + wr * 64 + m * 16 + fq * 4 + j, c = g * 128 + wc * 32 + n * 16 + fr;
                    C[(size_t)r * 512 + c] = acc[m][n][j] * scale[c]; } } };
struct EpiHid { float* C; const float* bias; int m0; int n0;
    __device__ __forceinline__ void operator()(const f4 (&acc)[4][2], int wr, int wc, int fr, int fq) const {
#pragma unroll
        for (int m = 0; m < 4; ++m)
#pragma unroll
            for (int n = 0; n < 2; ++n)
#pragma unroll
                for (int j = 0; j < 4; ++j) { const int r = m0 + wr * 64 + m * 16 + fq * 4 + j, c = n0 + wc * 32 + n * 16 + fr;
                    if (r < CROWS) C[(size_t)r * 256 + c] = gelu_tanh(acc[m][n][j] + bias[c]); } } };
struct EpiOut { float* C; const float* x; int m0; int n0;
    __device__ __forceinline__ void operator()(const f4 (&acc)[4][2], int wr, int wc, int fr, int fq) const {
#pragma unroll
        for (int m = 0; m < 4; ++m)
#pragma unroll
            for (int n = 0; n < 2; ++n)
#pragma unroll
                for (int j = 0; j < 4; ++j) { const size_t o = (size_t)(m0 + wr * 64 + m * 16 + fq * 4 + j) * 2048 + n0 + wc * 32 + n * 16 + fr;
                    C[o] = DN_ALPHA * x[o] + acc[m][n][j]; } } };
struct EpiGu { float* act; const float* bgu; const int* list; int m0; int cnt; int n0;
    __device__ __forceinline__ void operator()(const f4 (&acc)[4][2], int wr, int wc, int fr, int fq) const {
        const int jc = (n0 + wc * 32) / 2 + fr;
        const float bg = bgu[2 * jc], bl = bgu[2 * jc + 1];
#pragma unroll
        for (int m = 0; m < 4; ++m)
#pragma unroll
            for (int j = 0; j < 4; ++j) { const int r = m0 + wr * 64 + m * 16 + fq * 4 + j;
                if (r < cnt) { const int a = list[r];
                    const float xg = fminf(acc[m][0][j] + bg, 7.f), xl = fminf(fmaxf(acc[m][1][j] + bl, -7.f), 7.f);
                    act[(size_t)a * 2048 + jc] = xg * sigmoidf_(1.702f * xg) * (xl + 1.f); } } } };
struct EpiDn { float* y; const float* bdn; const int* list; const float* gate; int m0; int cnt; int n0;
    __device__ __forceinline__ void operator()(const f4 (&acc)[4][2], int wr, int wc, int fr, int fq) const {
#pragma unroll
        for (int m = 0; m < 4; ++m)
#pragma unroll
            for (int j = 0; j < 4; ++j) { const int r = m0 + wr * 64 + m * 16 + fq * 4 + j;
                if (r < cnt) { const int a = list[r]; const float g = gate[a];
#pragma unroll
                    for (int n = 0; n < 2; ++n) { const int c = n0 + wc * 32 + n * 16 + fr; y[(size_t)a * 2048 + c] = (acc[m][n][j] + bdn[c]) * g; } } } } };

constexpr int WLDS_FLOATS = 4096 + 512 + 32;
template <bool SHARED>
__device__ __forceinline__ void wave_attn(float* sw, const float* __restrict__ qptr, const float* __restrict__ Kb, const float* __restrict__ Vb, int ld, int nseg, float scale, float* __restrict__ optr) {
    const int lane = threadIdx.x & 63;
    float* sq = sw + 4096; const int* segs = (const int*)(sw + 4096 + 512);
#pragma unroll
    for (int i = 0; i < 8; ++i) sq[lane + 64 * i] = qptr[lane + 64 * i];
    wave_sync();
    for (int sg = 0; sg < nseg; ++sg) {
        const int start = segs[sg], len = segs[16 + sg];
        float d0 = 0.f, d1 = 0.f, d2 = 0.f, d3 = 0.f;
        if (lane < len) {
            const float* kp = Kb + (size_t)(start + lane) * ld;
            for (int d4 = 0; d4 < 32; ++d4) {
                if (SHARED) {
                    const float4 kv = *(const float4*)(kp + d4 * 4);
                    const float4 q0 = *(const float4*)(sq + d4 * 4), q1 = *(const float4*)(sq + 128 + d4 * 4), q2 = *(const float4*)(sq + 256 + d4 * 4), q3 = *(const float4*)(sq + 384 + d4 * 4);
                    d0 += kv.x * q0.x + kv.y * q0.y + kv.z * q0.z + kv.w * q0.w;
                    d1 += kv.x * q1.x + kv.y * q1.y + kv.z * q1.z + kv.w * q1.w;
                    d2 += kv.x * q2.x + kv.y * q2.y + kv.z * q2.z + kv.w * q2.w;
                    d3 += kv.x * q3.x + kv.y * q3.y + kv.z * q3.z + kv.w * q3.w;
                } else {
                    const float4 k0 = *(const float4*)(kp + d4 * 4), k1 = *(const float4*)(kp + 128 + d4 * 4), k2 = *(const float4*)(kp + 256 + d4 * 4), k3 = *(const float4*)(kp + 384 + d4 * 4);
                    const float4 q0 = *(const float4*)(sq + d4 * 4), q1 = *(const float4*)(sq + 128 + d4 * 4), q2 = *(const float4*)(sq + 256 + d4 * 4), q3 = *(const float4*)(sq + 384 + d4 * 4);
                    d0 += k0.x * q0.x + k0.y * q0.y + k0.z * q0.z + k0.w * q0.w;
                    d1 += k1.x * q1.x + k1.y * q1.y + k1.z * q1.z + k1.w * q1.w;
                    d2 += k2.x * q2.x + k2.y * q2.y + k2.z * q2.z + k2.w * q2.w;
                    d3 += k3.x * q3.x + k3.y * q3.y + k3.z * q3.z + k3.w * q3.w;
                }
            }
        }
        const bool ok = lane < len;
        sw[sg * 64 + lane] = ok ? d0 * scale : -1e30f;
        sw[1024 + sg * 64 + lane] = ok ? d1 * scale : -1e30f;
        sw[2048 + sg * 64 + lane] = ok ? d2 * scale : -1e30f;
        sw[3072 + sg * 64 + lane] = ok ? d3 * scale : -1e30f;
    }
    wave_sync();
    const int n = nseg * 64;
#pragma unroll
    for (int g = 0; g < 4; ++g) {
        float mx = -1e30f;
        for (int i = lane; i < n; i += 64) mx = fmaxf(mx, sw[g * 1024 + i]);
        mx = wave_max(mx);
        float sm = 0.f;
        for (int i = lane; i < n; i += 64) { const float v = sw[g * 1024 + i]; sm += (v > -1e29f) ? expf(v - mx) : 0.f; }
        sm = wave_sum(sm);
        const float inv = sm > 0.f ? 1.f / sm : 0.f;
        for (int i = lane; i < n; i += 64) { const float v = sw[g * 1024 + i]; sw[g * 1024 + i] = (v > -1e29f) ? expf(v - mx) * inv : 0.f; }
    }
    wave_sync();
    float o[4][2];
#pragma unroll
    for (int g = 0; g < 4; ++g) { o[g][0] = 0.f; o[g][1] = 0.f; }
    for (int sg = 0; sg < nseg; ++sg) {
        const int start = segs[sg], len = segs[16 + sg];
        for (int l = 0; l < len; ++l) {
            const float* vp = Vb + (size_t)(start + l) * ld;
            if (SHARED) {
                const float v0 = vp[lane], v1 = vp[lane + 64];
#pragma unroll
                for (int g = 0; g < 4; ++g) { const float p = sw[g * 1024 + sg * 64 + l]; o[g][0] += p * v0; o[g][1] += p * v1; }
            } else {
#pragma unroll
                for (int g = 0; g < 4; ++g) { const float p = sw[g * 1024 + sg * 64 + l]; o[g][0] += p * vp[g * 128 + lane]; o[g][1] += p * vp[g * 128 + lane + 64]; }
            }
        }
    }
#pragma unroll
    for (int g = 0; g < 4; ++g) { optr[g * 128 + lane] = o[g][0]; optr[g * 128 + lane + 64] = o[g][1]; }
}

namespace g8 {
constexpr int BM = 256, BK = 64, HALF = 128, HTB = HALF * BK * 2, STAGE_BYTES = 8 * HTB;
constexpr int KK = 2048;
typedef float f32x4 __attribute__((ext_vector_type(4)));
__device__ __forceinline__ int lds_byte(int r, int c) { const int st = (r >> 4) * 2 + (c >> 5), rr = r & 15, cc = c & 31, ob = rr * 64 + cc * 2; return st * 1024 + (ob ^ (((ob >> 9) & 1) << 5)); }
__device__ __forceinline__ void stage_rc(int b, int& R, int& C) { const int st = b / 1024, sb = b % 1024, swz = sb ^ (((sb >> 9) & 1) << 5); R = (st >> 1) * 16 + swz / 64; C = (st & 1) * 32 + (swz % 64) / 2; }
__device__ __forceinline__ int perm32(int rho) { const int n = rho >> 4, i = rho & 15; return 8 * (i >> 2) + 4 * n + (i & 3); }

typedef int i32x4 __attribute__((ext_vector_type(4)));
template <bool I8> struct AccSel { typedef f32x4 T; };
template <> struct AccSel<true> { typedef i32x4 T; };
__device__ __forceinline__ f32x4 mma16(i32x4 a, i32x4 b, f32x4 c) { return __builtin_amdgcn_mfma_f32_16x16x32_f16(*reinterpret_cast<h8*>(&a), *reinterpret_cast<h8*>(&b), c, 0, 0, 0); }
__device__ __forceinline__ i32x4 mma16(i32x4 a, i32x4 b, i32x4 c) { return __builtin_amdgcn_mfma_i32_16x16x64_i8(a, b, c, 0, 0, 0); }
struct Unit { int m0, n0, e, cnt, rbase; };
constexpr int EP_OFF = STAGE_BYTES + 512, EP_LD = 528, EP_GRP = 16 * EP_LD;
__device__ __forceinline__ void ep_sync() { asm volatile("s_waitcnt lgkmcnt(0)" ::: "memory"); __builtin_amdgcn_s_barrier(); asm volatile("" ::: "memory"); }
__device__ __forceinline__ int ep_tid() { int tz = threadIdx.x; asm volatile("" : "+v"(tz)); return tz; }
__device__ __forceinline__ h8 cvt8(f32x4 a, f32x4 b) { h8 o; o[0] = (_Float16)a[0]; o[1] = (_Float16)a[1]; o[2] = (_Float16)a[2]; o[3] = (_Float16)a[3]; o[4] = (_Float16)b[0]; o[5] = (_Float16)b[1]; o[6] = (_Float16)b[2]; o[7] = (_Float16)b[3]; return o; }

__device__ __forceinline__ void tile_order(int L, int nM, int nN, int& pm, int& pn) {
    const int nwg = nM * nN; int wgid = L;
    { const int q = nwg / 8, r = nwg % 8, xcd = wgid % 8, off = wgid / 8; wgid = (xcd < r ? xcd * (q + 1) : r * (q + 1) + (xcd - r) * q) + off; }
    const int nig = 8 * nN, gid = wgid / nig, fm = gid * 8, gsz = (nM - fm) < 8 ? (nM - fm) : 8;
    pm = fm + ((wgid % nig) % gsz); pn = (wgid % nig) / gsz;
}

template <class Prob>
__device__ __forceinline__ void gemm_phase(LAS unsigned char* lds, const Prob& P) {
    const int tid = threadIdx.x, wid = __builtin_amdgcn_readfirstlane(tid >> 6), lane = tid & 63, wr = wid >> 2, wc = wid & 3, fr = lane & 15, fq = lane >> 4;
    constexpr int nt = Prob::NT; constexpr size_t KS2 = Prob::KS2; constexpr unsigned ROWB = Prob::ROWB; constexpr bool I8 = Prob::I8;
    int sR[2], sC2[2]; unsigned voffB[2];
#pragma unroll
    for (int i = 0; i < 2; ++i) { int R, C; stage_rc(tid * 16 + i * 8192, R, C); sR[i] = R; sC2[i] = C * 2; const int Rb = Prob::PERM ? ((R & ~31) + perm32(R & 31)) : R; voffB[i] = (unsigned)Rb * ROWB + (unsigned)C * 2u; }
    const size_t kstep = (size_t)(BK * 2);
    const size_t hstep = (size_t)HALF * ROWB;
    const unsigned ldsw = (unsigned)wid * 1024u;
    const int aoff = lds_byte(wr * 64 + fr, fq * 8), boff = lds_byte(wc * 32 + fr, fq * 8);
#define G8_SA(b, h) (((b) * 2 + (h)) * HTB)
#define G8_SB(b, h) ((4 + (b) * 2 + (h)) * HTB)
#define G8_STAGE(bufoff, gbase, voff) do { _Pragma("unroll") for (int _i = 0; _i < 2; ++_i) \
        __builtin_amdgcn_global_load_lds((const unsigned*)((const char*)(gbase) + (voff)[_i]), (LAS unsigned*)(lds + (bufoff) + ldsw + _i * 8192), 16, 0, 0); } while (0)
#define G8_LDA(dst, b, h) do { _Pragma("unroll") for (int m = 0; m < 4; ++m) _Pragma("unroll") for (int k = 0; k < 2; ++k) dst[m][k] = *(const LAS i32x4*)(lds + G8_SA(b, h) + aoff + m * 2048 + k * 1024); } while (0)
#define G8_LDB(dst, b, h) do { _Pragma("unroll") for (int n = 0; n < 2; ++n) _Pragma("unroll") for (int k = 0; k < 2; ++k) dst[n][k] = *(const LAS i32x4*)(lds + G8_SB(b, h) + boff + n * 2048 + k * 1024); } while (0)
#define G8_MMA(ai, bj, At, Bt) do { __builtin_amdgcn_s_setprio(1); _Pragma("unroll") for (int m = 0; m < 4; ++m) _Pragma("unroll") for (int n = 0; n < 2; ++n) _Pragma("unroll") for (int k = 0; k < 2; ++k) \
        acc[ai][bj][m][n] = mma16(Bt[n][k], At[m][k], acc[ai][bj][m][n]); __builtin_amdgcn_s_setprio(0); } while (0)
#define G8_WAIT_V(n) asm volatile("s_waitcnt vmcnt(" #n ")" ::: "memory")
#define G8_WAIT_L(n) asm volatile("s_waitcnt lgkmcnt(" #n ")" ::: "memory")
#define G8_BAR __builtin_amdgcn_s_barrier()
#define G8_SCHED __builtin_amdgcn_sched_barrier(0)
    Unit cur, nxt; int ui = 0;
    if (!P.next(0, cur)) return;
    typedef typename AccSel<I8>::T AccT;
    AccT acc[2][2][4][2];
#pragma unroll
    for (int a = 0; a < 2; ++a)
#pragma unroll
        for (int b = 0; b < 2; ++b)
#pragma unroll
            for (int m = 0; m < 4; ++m)
#pragma unroll
                for (int n = 0; n < 2; ++n) acc[a][b][m][n] = AccT{};
    i32x4 At[4][2], B0[2][2], B1[2][2];
    unsigned vc[2][2], vn[2][2];
    P.a_offs(cur, sR, sC2, vc);
    const char* const Ab = P.a_base();
    const char* cB = P.b_base(cur);
    G8_STAGE(G8_SB(0, 0), cB, voffB); G8_STAGE(G8_SA(0, 0), Ab, vc[0]); G8_STAGE(G8_SB(0, 1), cB + hstep, voffB); G8_STAGE(G8_SA(0, 1), Ab, vc[1]);
    if (wr == 1) G8_BAR;
    G8_WAIT_V(4); G8_BAR;
    G8_STAGE(G8_SB(1, 0), cB + kstep, voffB); G8_STAGE(G8_SA(1, 0), Ab + kstep, vc[0]); G8_STAGE(G8_SB(1, 1), cB + hstep + kstep, voffB);
    G8_WAIT_V(6); G8_BAR;
    for (;;) {
        const bool has_next = P.next(ui + 1, nxt);
        const char* nB = cB;
        if (has_next) { P.a_offs(nxt, sR, sC2, vn); nB = P.b_base(nxt); }
        else { vn[0][0] = vc[0][0]; vn[0][1] = vc[0][1]; vn[1][0] = vc[1][0]; vn[1][1] = vc[1][1]; }
        for (int t = 0; t < nt; t += 2) {
            const bool last = (t == nt - 2);
            const char* a1 = Ab + (size_t)(t >> 1) * KS2 + kstep;
            const char* a2 = last ? Ab : Ab + (size_t)((t + 2) >> 1) * KS2; const char* b2 = last ? nB : cB + (size_t)(t + 2) * kstep;
            const char* a3 = a2 + kstep; const char* b3 = b2 + kstep;
            unsigned o2[2][2];
            o2[0][0] = last ? vn[0][0] : vc[0][0]; o2[0][1] = last ? vn[0][1] : vc[0][1]; o2[1][0] = last ? vn[1][0] : vc[1][0]; o2[1][1] = last ? vn[1][1] : vc[1][1];
            G8_LDB(B0, 0, 0); G8_SCHED; G8_LDA(At, 0, 0); G8_STAGE(G8_SA(1, 1), a1, vc[1]);
            G8_WAIT_L(8); G8_BAR; G8_WAIT_L(0); G8_MMA(0, 0, At, B0); G8_BAR; G8_SCHED;
            G8_LDB(B1, 0, 1); G8_STAGE(G8_SB(0, 0), b2, voffB);
            G8_BAR; G8_WAIT_L(0); G8_MMA(0, 1, At, B1); G8_BAR;
            G8_LDA(At, 0, 1); G8_STAGE(G8_SA(0, 0), a2, o2[0]);
            G8_BAR; G8_WAIT_L(0); G8_MMA(1, 0, At, B0); G8_BAR; G8_SCHED;
            G8_STAGE(G8_SB(0, 1), b2 + hstep, voffB);
            G8_WAIT_V(6); G8_BAR; G8_MMA(1, 1, At, B1); G8_BAR;
            G8_LDB(B0, 1, 0); G8_SCHED; G8_LDA(At, 1, 0); G8_STAGE(G8_SA(0, 1), a2, o2[1]);
            G8_WAIT_L(8); G8_BAR; G8_WAIT_L(0); G8_MMA(0, 0, At, B0); G8_BAR; G8_SCHED;
            G8_LDB(B1, 1, 1); G8_STAGE(G8_SB(1, 0), b3, voffB);
            G8_BAR; G8_WAIT_L(0); G8_MMA(0, 1, At, B1); G8_BAR;
            G8_LDA(At, 1, 1); G8_STAGE(G8_SA(1, 0), a3, o2[0]);
            G8_BAR; G8_WAIT_L(0); G8_MMA(1, 0, At, B0); G8_BAR; G8_SCHED;
            G8_STAGE(G8_SB(1, 1), b3 + hstep, voffB);
            G8_WAIT_V(6); G8_BAR; G8_MMA(1, 1, At, B1); G8_BAR;
        }
        P.epi(acc, cur, wr, wc, fr, fq, lds);
        if (!has_next) break;
#pragma unroll
        for (int a = 0; a < 2; ++a)
#pragma unroll
            for (int b = 0; b < 2; ++b)
#pragma unroll
                for (int m = 0; m < 4; ++m)
#pragma unroll
                    for (int n = 0; n < 2; ++n) acc[a][b][m][n] = AccT{};
        cur = nxt; cB = nB; ++ui;
        vc[0][0] = vn[0][0]; vc[0][1] = vn[0][1]; vc[1][0] = vn[1][0]; vc[1][1] = vn[1][1];
    }
    G8_WAIT_V(0);
    if (wr == 0) G8_BAR;
    G8_BAR;
#undef G8_SA
#undef G8_SB
#undef G8_STAGE
#undef G8_LDA
#undef G8_LDB
#undef G8_MMA
#undef G8_WAIT_V
#undef G8_WAIT_L
#undef G8_BAR
#undef G8_SCHED
}

struct ProbIn {
    static constexpr unsigned ROWB = 4096; static constexpr bool I8 = false;
    static constexpr int NT = 32; static constexpr size_t KS2 = 256;
    static constexpr bool PERM = true;
    const _Float16* A; _Float16* C16; int G, c;
    __device__ __forceinline__ bool next(int i, Unit& u) const { const int L = i * G + c; if (L >= 64 * 15 + 32) return false;
        if (L < 64 * 15) { int pm, pn; tile_order(L, 64, 15, pm, pn); u.m0 = pm * 256; u.n0 = pn * 256; u.e = 0; }
        else { const int v = L - 64 * 15; u.m0 = T_ + (v & 7) * 256; u.n0 = (v >> 3) * 256; u.e = 1; }
        u.cnt = 256; u.rbase = 0; return true; }
    __device__ __forceinline__ void a_offs(const Unit& u, const int (&R)[2], const int (&C2)[2], unsigned (&v)[2][2]) const {
#pragma unroll
        for (int h = 0; h < 2; ++h)
#pragma unroll
            for (int i = 0; i < 2; ++i) v[h][i] = (unsigned)(u.m0 + h * 128 + R[i]) * (unsigned)(KK * 2) + (unsigned)C2[i]; }
    __device__ __forceinline__ const char* a_base() const { return (const char*)A; }
    __device__ __forceinline__ const char* b_base(const Unit& u) const { return (const char*)A + (u.e ? (long long)(WS_WTMKV - WS_X16) : (long long)(WS_WTIN - WS_X16)) + (size_t)u.n0 * KK * 2; }
    __device__ __forceinline__ void epi(const f32x4 (&acc)[2][2][4][2], const Unit& u, int wr, int wc, int fr, int fq, LAS unsigned char* lds) const {
        LAS unsigned char* ep = lds + EP_OFF + wr * EP_GRP;
        const int tg = ep_tid() & 255, rrow = tg >> 4, ch = tg & 15;
        _Float16* const Cb = (_Float16*)((char*)C16 + (u.e ? (long long)(WS_KVMEM16 - WS_PROJ16) : 0ll)); const int ldc = u.e ? 1024 : INW, nlim = u.e ? 1024 : INW, mb = u.e ? u.m0 - T_ : u.m0;
#pragma unroll
        for (int ai = 0; ai < 2; ++ai)
#pragma unroll
            for (int m = 0; m < 4; ++m) {
#pragma unroll
                for (int bj = 0; bj < 2; ++bj) *(LAS h8*)(ep + fr * EP_LD + (bj * 128 + wc * 32 + fq * 8) * 2) = cvt8(acc[ai][bj][m][0], acc[ai][bj][m][1]);
                ep_sync();
                const h8 x0 = *(const LAS h8*)(ep + rrow * EP_LD + ch * 32), x1 = *(const LAS h8*)(ep + rrow * EP_LD + ch * 32 + 16);
                const int grow = mb + ai * 128 + wr * 64 + m * 16 + rrow, gcol = u.n0 + ch * 16;
                if (gcol < nlim) *(h8*)(Cb + (size_t)grow * ldc + gcol) = x0;
                if (gcol + 8 < nlim) *(h8*)(Cb + (size_t)grow * ldc + gcol + 8) = x1;
                ep_sync();
            } }
};
struct ProbOut {
    static constexpr unsigned ROWB = 4096; static constexpr bool I8 = false;
    static constexpr int NT = 32; static constexpr size_t KS2 = 256;
    static constexpr bool PERM = true;
    const _Float16* A; const _Float16* Bt; _Float16* C; const _Float16* X; int G, c;
    __device__ __forceinline__ bool next(int i, Unit& u) const { const int L = i * G + c; if (L >= 64 * 8) return false; int pm, pn; tile_order(L, 64, 8, pm, pn); u.m0 = pm * 256; u.n0 = pn * 256; u.e = 0; u.cnt = 256; u.rbase = 0; return true; }
    __device__ __forceinline__ void a_offs(const Unit& u, const int (&R)[2], const int (&C2)[2], unsigned (&v)[2][2]) const {
#pragma unroll
        for (int h = 0; h < 2; ++h)
#pragma unroll
            for (int i = 0; i < 2; ++i) v[h][i] = (unsigned)(u.m0 + h * 128 + R[i]) * (unsigned)(KK * 2) + (unsigned)C2[i]; }
    __device__ __forceinline__ const char* a_base() const { return (const char*)A; }
    __device__ __forceinline__ const char* b_base(const Unit& u) const { return (const char*)(Bt + (size_t)u.n0 * KK); }
    __device__ __forceinline__ void epi(const f32x4 (&acc)[2][2][4][2], const Unit& u, int wr, int wc, int fr, int fq, LAS unsigned char* lds) const {
        LAS unsigned char* ep = lds + EP_OFF + wr * EP_GRP;
        const int tg = ep_tid() & 255, rrow = tg >> 4, ch = tg & 15;
#pragma unroll
        for (int ai = 0; ai < 2; ++ai)
#pragma unroll
            for (int m = 0; m < 4; ++m) {
#pragma unroll
                for (int bj = 0; bj < 2; ++bj) *(LAS h8*)(ep + fr * EP_LD + (bj * 128 + wc * 32 + fq * 8) * 2) = cvt8(acc[ai][bj][m][0], acc[ai][bj][m][1]);
                const size_t go = (size_t)(u.m0 + ai * 128 + wr * 64 + m * 16 + rrow) * 2048 + u.n0 + ch * 16;
                const h8 r0 = *(const h8*)(X + go), r1 = *(const h8*)(X + go + 8);
                ep_sync();
                const h8 x0 = *(const LAS h8*)(ep + rrow * EP_LD + ch * 32), x1 = *(const LAS h8*)(ep + rrow * EP_LD + ch * 32 + 16);
                h8 o0, o1;
#pragma unroll
                for (int q = 0; q < 8; ++q) { o0[q] = (_Float16)(DN_ALPHA * (float)r0[q] + (float)x0[q]); o1[q] = (_Float16)(DN_ALPHA * (float)r1[q] + (float)x1[q]); }
                *(h8*)(C + go) = o0; *(h8*)(C + go + 8) = o1;
                ep_sync();
            } }
};
struct ProbCmp {
    static constexpr unsigned ROWB = 4096; static constexpr bool I8 = false;
    static constexpr int NT = 8; static constexpr size_t KS2 = (size_t)INW * 2;
    static constexpr bool PERM = false;
    const _Float16* A; const _Float16* Bt; float* C; int G, c;
    __device__ __forceinline__ bool next(int i, Unit& u) const { const int L = i * G + c; if (L >= 128) return false;
        u.e = L >> 6; const int r = L & 63; u.rbase = r & 3; u.n0 = ((r >> 2) & 1) * 256; u.m0 = (r >> 3) * 256; u.cnt = 256; return true; }
    __device__ __forceinline__ void a_offs(const Unit& u, const int (&R)[2], const int (&C2)[2], unsigned (&v)[2][2]) const {
#pragma unroll
        for (int h = 0; h < 2; ++h)
#pragma unroll
            for (int i = 0; i < 2; ++i) { const int row = u.m0 + h * 128 + R[i], kvh = row & 1, bj = row >> 1, b = bj >> 7, j = bj & 127;
                v[h][i] = (unsigned)((b * S_ + 16 * j + 4 * u.rbase) * INW + (u.e ? C_VC : C_KC) + kvh * 128) * 2u + (unsigned)C2[i]; } }
    __device__ __forceinline__ const char* a_base() const { return (const char*)A; }
    __device__ __forceinline__ const char* b_base(const Unit& u) const { return (const char*)(Bt + ((size_t)u.e * 512 + u.n0) * KK + u.rbase * 512); }
    __device__ __forceinline__ void epi(const f32x4 (&acc)[2][2][4][2], const Unit& u, int wr, int wc, int fr, int fq, LAS unsigned char*) const {
        float* base = C + ((size_t)(u.e * 4 + u.rbase) * 2048) * 512;
#pragma unroll
        for (int ai = 0; ai < 2; ++ai)
#pragma unroll
            for (int m = 0; m < 4; ++m) { const int row = u.m0 + ai * 128 + wr * 64 + m * 16 + fr;
#pragma unroll
                for (int bj = 0; bj < 2; ++bj)
#pragma unroll
                    for (int n = 0; n < 2; ++n) { const int col = u.n0 + bj * 128 + wc * 32 + n * 16 + fq * 4;
                        *(f32x4*)(base + (size_t)row * 512 + col) = acc[ai][bj][m][n]; } } }
};
struct MoeTab { const LAS int* t; int NT;
    __device__ __forceinline__ bool find(int L, Unit& u) const {
        const int total = __builtin_amdgcn_readfirstlane(t[98]); if (L >= total) return false;
        int e = 0;
        for (; e < NE - 1; ++e) { if (L < __builtin_amdgcn_readfirstlane(t[32 + e + 1])) break; }
        const int ub = __builtin_amdgcn_readfirstlane(t[32 + e]), cn = __builtin_amdgcn_readfirstlane(t[e]), rs = __builtin_amdgcn_readfirstlane(t[65 + e]);
        const int nm = (cn + 255) >> 8, v = L - ub, mt = v % nm, ntile = v / nm;
        u.e = e; u.m0 = mt * 256; u.n0 = ntile * 256; u.cnt = min(256, cn - mt * 256); u.rbase = rs; return true; } };
struct ProbGu {
    static constexpr int NT = 16; static constexpr size_t KS2 = 256; static constexpr unsigned ROWB = 2048; static constexpr bool I8 = true;
    static constexpr bool PERM = true;
    const signed char* A; const signed char* Bt; _Float16* act; const float* bgu; const int* list; const float* sa; const float* sw; MoeTab tab; int G, vcu;
    __device__ __forceinline__ bool next(int i, Unit& u) const { return tab.find(i * G + vcu, u); }
    __device__ __forceinline__ void a_offs(const Unit& u, const int (&R)[2], const int (&C2)[2], unsigned (&v)[2][2]) const {
#pragma unroll
        for (int h = 0; h < 2; ++h)
#pragma unroll
            for (int i = 0; i < 2; ++i) { int r = h * 128 + R[i]; r = r < u.cnt ? r : 0; const int a = list[(size_t)u.e * T_ + u.m0 + r]; v[h][i] = (unsigned)(a >> 2) * 2048u + (unsigned)C2[i]; } }
    __device__ __forceinline__ const char* a_base() const { return (const char*)A; }
    __device__ __forceinline__ const char* b_base(const Unit& u) const { return (const char*)(Bt + ((size_t)u.e * 4096 + u.n0) * 2048); }
    __device__ __forceinline__ void epi(const i32x4 (&acc)[2][2][4][2], const Unit& u, int wr, int wc, int fr, int fq, LAS unsigned char* lds) const {
        const float* bb = bgu + (size_t)u.e * 4096; const float* ss = sw + (size_t)u.e * 4096;
        LAS unsigned char* ep = lds + EP_OFF + wr * EP_GRP;
        const int tg = ep_tid() & 255, rrow = tg >> 4, ch = tg & 15;
        f32x4 b0[2], b1[2], s0[2], s1[2];
#pragma unroll
        for (int bj = 0; bj < 2; ++bj) { const int col = u.n0 + bj * 128 + wc * 32 + fq * 8;
            b0[bj] = *(const f32x4*)(bb + col); b1[bj] = *(const f32x4*)(bb + col + 4); s0[bj] = *(const f32x4*)(ss + col); s1[bj] = *(const f32x4*)(ss + col + 4); }
#pragma unroll
        for (int ai = 0; ai < 2; ++ai)
#pragma unroll
            for (int m = 0; m < 4; ++m) { const int rl = ai * 128 + wr * 64 + m * 16 + fr;
                const int a = list[(size_t)u.e * T_ + u.m0 + (rl < u.cnt ? rl : 0)]; const float sr = sa[a >> 2];
#pragma unroll
                for (int bj = 0; bj < 2; ++bj) {
                    const i32x4 i0 = acc[ai][bj][m][0], i1 = acc[ai][bj][m][1];
                    const f32x4 v0 = (f32x4){(float)i0[0], (float)i0[1], (float)i0[2], (float)i0[3]} * (s0[bj] * sr) + b0[bj], v1 = (f32x4){(float)i1[0], (float)i1[1], (float)i1[2], (float)i1[3]} * (s1[bj] * sr) + b1[bj];
                    h4 o;
                    o[0] = (_Float16)swiglu_fast(v0[0], v0[1]);
                    o[1] = (_Float16)swiglu_fast(v0[2], v0[3]);
                    o[2] = (_Float16)swiglu_fast(v1[0], v1[1]);
                    o[3] = (_Float16)swiglu_fast(v1[2], v1[3]);
                    *(LAS h4*)(ep + fr * EP_LD + (bj * 64 + wc * 16 + fq * 4) * 2) = o; }
                ep_sync();
                const h8 x0 = *(const LAS h8*)(ep + rrow * EP_LD + ch * 16);
                const int rr = ai * 128 + wr * 64 + m * 16 + rrow;
                if (rr < u.cnt) *(h8*)(act + (size_t)(u.rbase + u.m0 + rr) * 2048 + (u.n0 >> 1) + ch * 8) = x0;
                ep_sync();
            } }
};
struct ProbDn {
    static constexpr int NT = 16; static constexpr size_t KS2 = 256; static constexpr unsigned ROWB = 2048; static constexpr bool I8 = true;
    static constexpr bool PERM = true;
    const signed char* A; const signed char* Bt; _Float16* y; const float* bdn; const int* list; const float* gate; const float* sa; const float* sw; MoeTab tab; int G, vcu;
    __device__ __forceinline__ bool next(int i, Unit& u) const { return tab.find(i * G + vcu, u); }
    __device__ __forceinline__ void a_offs(const Unit& u, const int (&R)[2], const int (&C2)[2], unsigned (&v)[2][2]) const {
#pragma unroll
        for (int h = 0; h < 2; ++h)
#pragma unroll
            for (int i = 0; i < 2; ++i) v[h][i] = (unsigned)(u.rbase + u.m0 + h * 128 + R[i]) * 2048u + (unsigned)C2[i]; }
    __device__ __forceinline__ const char* a_base() const { return (const char*)A; }
    __device__ __forceinline__ const char* b_base(const Unit& u) const { return (const char*)(Bt + ((size_t)u.e * 2048 + u.n0) * 2048); }
    __device__ __forceinline__ void epi(const i32x4 (&acc)[2][2][4][2], const Unit& u, int wr, int wc, int fr, int fq, LAS unsigned char* lds) const {
        const float* bb = bdn + (size_t)u.e * 2048; const float* ss = sw + (size_t)u.e * 2048;
        LAS unsigned char* ep = lds + EP_OFF + wr * EP_GRP;
        const int tg = ep_tid() & 255, rrow = tg >> 4, ch = tg & 15;
        f32x4 b0[2], b1[2], s0[2], s1[2];
#pragma unroll
        for (int bj = 0; bj < 2; ++bj) { const int col = u.n0 + bj * 128 + wc * 32 + fq * 8;
            b0[bj] = *(const f32x4*)(bb + col); b1[bj] = *(const f32x4*)(bb + col + 4); s0[bj] = *(const f32x4*)(ss + col); s1[bj] = *(const f32x4*)(ss + col + 4); }
#pragma unroll
        for (int ai = 0; ai < 2; ++ai)
#pragma unroll
            for (int m = 0; m < 4; ++m) { const int rl = ai * 128 + wr * 64 + m * 16 + fr, rc = rl < u.cnt ? rl : 0;
                const int a = list[(size_t)u.e * T_ + u.m0 + rc]; const float g = gate[a]; const float sr = sa[u.rbase + u.m0 + rc];
#pragma unroll
                for (int bj = 0; bj < 2; ++bj) {
                    const i32x4 i0 = acc[ai][bj][m][0], i1 = acc[ai][bj][m][1];
                    const f32x4 v0 = ((f32x4){(float)i0[0], (float)i0[1], (float)i0[2], (float)i0[3]} * (s0[bj] * sr) + b0[bj]) * g, v1 = ((f32x4){(float)i1[0], (float)i1[1], (float)i1[2], (float)i1[3]} * (s1[bj] * sr) + b1[bj]) * g;
                    *(LAS h8*)(ep + fr * EP_LD + (bj * 128 + wc * 32 + fq * 8) * 2) = cvt8(v0, v1); }
                const int rr = ai * 128 + wr * 64 + m * 16 + rrow;
                const int a2 = list[(size_t)u.e * T_ + u.m0 + (rr < u.cnt ? rr : 0)];
                ep_sync();
                const h8 x0 = *(const LAS h8*)(ep + rrow * EP_LD + ch * 32), x1 = *(const LAS h8*)(ep + rrow * EP_LD + ch * 32 + 16);
                if (rr < u.cnt) { *(h8*)(y + (size_t)a2 * 2048 + u.n0 + ch * 16) = x0; *(h8*)(y + (size_t)a2 * 2048 + u.n0 + ch * 16 + 8) = x1; }
                ep_sync();
            } }
};
}

namespace at8 {
typedef float f32x16 __attribute__((ext_vector_type(16)));
typedef short s16x4 __attribute__((ext_vector_type(4)));
typedef unsigned u32x4 __attribute__((ext_vector_type(4)));
constexpr int SHM_V = 64 * 128 * 2, SHM_K = 64 * 128 * 2;
constexpr int LDS_WS = 2 * SHM_V + 2 * SHM_K;
constexpr int LDS_END = LDS_WS + 8 * 64 * 4;
constexpr float CEXP = ATT_SCALE * 1.4426950408889634f;
constexpr float THR_RAW = 8.f / ATT_SCALE;
#define AT_KSWZ(row, colB) ((row) * 256 + ((colB) ^ (((row) & 7) << 4)))
#define AT_SBAR() __builtin_amdgcn_sched_barrier(0)
__device__ __forceinline__ int crow(int r, int hi) { return (r & 3) + 8 * (r >> 2) + 4 * hi; }
__device__ __forceinline__ unsigned cvtpk(float lo, float hi) { auto v = __builtin_amdgcn_cvt_pkrtz(lo, hi); return *reinterpret_cast<unsigned*>(&v); }
__device__ __forceinline__ int v_st(int k, int c) { const int kk = (k & ~0xC) | ((k & 4) << 1) | ((k & 8) >> 1); return ((kk >> 3) * 4 + (c >> 5)) * 512 + ((kk & 7) * 32 + (c & 31)) * 2; }
__device__ __forceinline__ int v_rd_base(int lane) { return ((lane & 3) << 3) | (((lane >> 2) & 3) << 6) | (((lane >> 4) & 1) << 5) | (((lane >> 5) & 1) << 8); }
constexpr int v_rd_off(int d0, int ks, int half) { return d0 * 512 + ks * 4096 + half * 2048; }
template <int OFF> __device__ __forceinline__ s16x4 tr_read(int vb) { s16x4 r; asm volatile("ds_read_b64_tr_b16 %0, %1 offset:%2" : "=&v"(r) : "v"(vb), "i"(OFF) : "memory"); return r; }
__device__ __forceinline__ h8 mk8(s16x4 l, s16x4 h) { typedef short s16x8 __attribute__((ext_vector_type(8))); s16x8 w = {l[0], l[1], l[2], l[3], h[0], h[1], h[2], h[3]}; return *reinterpret_cast<h8*>(&w); }
template <int D0> __device__ __forceinline__ void pv_one(f32x16& od, int vb, h8 pa0, h8 pa1, h8 pa2, h8 pa3) {
    const s16x4 l0 = tr_read<v_rd_off(D0, 0, 0)>(vb), h0 = tr_read<v_rd_off(D0, 0, 1)>(vb), l1 = tr_read<v_rd_off(D0, 1, 0)>(vb), h1 = tr_read<v_rd_off(D0, 1, 1)>(vb);
    const s16x4 l2 = tr_read<v_rd_off(D0, 2, 0)>(vb), h2 = tr_read<v_rd_off(D0, 2, 1)>(vb), l3 = tr_read<v_rd_off(D0, 3, 0)>(vb), h3 = tr_read<v_rd_off(D0, 3, 1)>(vb);
    asm volatile("s_waitcnt lgkmcnt(0)" ::: "memory"); AT_SBAR();
    od = __builtin_amdgcn_mfma_f32_32x32x16_f16(pa0, mk8(l0, h0), od, 0, 0, 0);
    od = __builtin_amdgcn_mfma_f32_32x32x16_f16(pa1, mk8(l1, h1), od, 0, 0, 0);
    od = __builtin_amdgcn_mfma_f32_32x32x16_f16(pa2, mk8(l2, h2), od, 0, 0, 0);
    od = __builtin_amdgcn_mfma_f32_32x32x16_f16(pa3, mk8(l3, h3), od, 0, 0, 0);
}
__device__ __forceinline__ void pv_d0(f32x16 (&o)[4], int vb, h8 pa0, h8 pa1, h8 pa2, h8 pa3) {
    pv_one<0>(o[0], vb, pa0, pa1, pa2, pa3); pv_one<1>(o[1], vb, pa0, pa1, pa2, pa3); pv_one<2>(o[2], vb, pa0, pa1, pa2, pa3); pv_one<3>(o[3], vb, pa0, pa1, pa2, pa3);
}
__device__ __forceinline__ void qkt(f32x16& p0, f32x16& p1, const char* Ks, const h8 (&qr)[8], int r32, int hi) {
    p0 = f32x16{}; p1 = f32x16{};
#pragma unroll
    for (int d0 = 0; d0 < 8; ++d0) { const int cb = (d0 * 16 + hi * 8) * 2;
        const h8 b0 = *reinterpret_cast<const h8*>(Ks + AT_KSWZ(r32, cb));
        const h8 b1 = *reinterpret_cast<const h8*>(Ks + AT_KSWZ(32 + r32, cb));
        p0 = __builtin_amdgcn_mfma_f32_32x32x16_f16(b0, qr[d0], p0, 0, 0, 0);
        p1 = __builtin_amdgcn_mfma_f32_32x32x16_f16(b1, qr[d0], p1, 0, 0, 0); }
}
__device__ __forceinline__ void pack_p(const f32x16& p0, const f32x16& p1, h8& pa0, h8& pa1, h8& pa2, h8& pa3) {
#define AT_PK4(P, BASE, OUT) do { unsigned a0 = cvtpk(P[BASE + 0], P[BASE + 1]), a1 = cvtpk(P[BASE + 2], P[BASE + 3]); \
    unsigned b0 = cvtpk(P[BASE + 4], P[BASE + 5]), b1 = cvtpk(P[BASE + 6], P[BASE + 7]); \
    auto r0 = __builtin_amdgcn_permlane32_swap(a0, b0, false, false); auto r1 = __builtin_amdgcn_permlane32_swap(a1, b1, false, false); \
    u32x4 w = {r0[0], r1[0], r0[1], r1[1]}; OUT = *reinterpret_cast<h8*>(&w); } while (0)
    AT_PK4(p0, 0, pa0); AT_PK4(p0, 8, pa1); AT_PK4(p1, 0, pa2); AT_PK4(p1, 8, pa3);
#undef AT_PK4
}
__device__ __forceinline__ float half_swap_max(float v) { auto rr = __builtin_amdgcn_permlane32_swap(__float_as_uint(v), __float_as_uint(v), false, false); return fmaxf(__uint_as_float(rr[0]), __uint_as_float(rr[1])); }
__device__ __forceinline__ float half_swap_sum(float v) { auto rr = __builtin_amdgcn_permlane32_swap(__float_as_uint(v), __float_as_uint(v), false, false); return __uint_as_float(rr[0]) + __uint_as_float(rr[1]); }

struct Stage4 { h8 vs0, vs1, ks0, ks1; };
__device__ __forceinline__ int hidden_tid() { int tz = threadIdx.x; asm volatile("" : "+v"(tz)); return tz; }
__device__ __forceinline__ void sload(Stage4& s, const _Float16* Kb, const _Float16* Vb, int ld, int k0) {
    const int tz = hidden_tid(), sr = tz >> 4, sc = (tz & 15) * 8;
    s.vs0 = *(const h8*)(Vb + (size_t)(k0 + sr) * ld + sc); s.vs1 = *(const h8*)(Vb + (size_t)(k0 + 32 + sr) * ld + sc);
    s.ks0 = *(const h8*)(Kb + (size_t)(k0 + sr) * ld + sc); s.ks1 = *(const h8*)(Kb + (size_t)(k0 + 32 + sr) * ld + sc);
}
__device__ __forceinline__ void swrite(const Stage4& s, char* V_lds, char* K_lds, int b) {
    const int tz = hidden_tid(), sr = tz >> 4, sc = (tz & 15) * 8, vst0 = v_st(sr, sc), vst1 = v_st(32 + sr, sc);
    *(h8*)(V_lds + b * SHM_V + vst0) = s.vs0; *(h8*)(V_lds + b * SHM_V + vst1) = s.vs1;
    const int kc = sc * 2;
    *(h8*)(K_lds + b * SHM_K + AT_KSWZ(sr, kc)) = s.ks0; *(h8*)(K_lds + b * SHM_K + AT_KSWZ(32 + sr, kc)) = s.ks1;
}

__device__ __forceinline__ void attn_unit(char* lds, const _Float16* qrow, const _Float16* Kb, const _Float16* Vb, int ld, unsigned tmask, int klo, int khi, unsigned selmask,
                                          float* outw, int ostride) {
    const int tid = threadIdx.x, wid = __builtin_amdgcn_readfirstlane(tid >> 6), lane = tid & 63, r32 = lane & 31, hi = lane >> 5;
    char* V_lds = lds; char* K_lds = lds + 2 * SHM_V;
    float* wsf = (float*)(lds + LDS_WS) + wid * 64; float* li_l = wsf; float* al_l = wsf + 32;
    float m_reg = -1e30f, l_reg = 0.f; f32x16 o[4] = {}; h8 qr[8];
#pragma unroll
    for (int d0 = 0; d0 < 8; ++d0) qr[d0] = *(const h8*)(qrow + d0 * 16);
    const int vb0 = (int)(uintptr_t)V_lds + v_rd_base(lane);
    Stage4 st;
    unsigned rest = tmask; int j = __ffs(rest) - 1; rest &= rest - 1;
    sload(st, Kb, Vb, ld, j * 64); asm volatile("s_waitcnt vmcnt(0)" ::: "memory"); swrite(st, V_lds, K_lds, 0); __syncthreads();
    int buf = 0;
    for (;;) {
        const int jn = rest ? (__ffs(rest) - 1) : -1;
        if (jn >= 0) sload(st, Kb, Vb, ld, jn * 64);
        f32x16 p0, p1;
        AT_SBAR(); qkt(p0, p1, K_lds + buf * SHM_K, qr, r32, hi);
        { const int kb = j * 64 + 4 * hi; const bool tb = (selmask >> j) & 1u;
#pragma unroll
          for (int r = 0; r < 16; ++r) { const int k0 = kb + (r & 3) + 8 * (r >> 2);
              p0[r] = (tb && k0 >= klo && k0 <= khi) ? p0[r] : -INFINITY;
              p1[r] = (tb && (k0 + 32) >= klo && (k0 + 32) <= khi) ? p1[r] : -INFINITY; } }
        float pmax = p0[0];
#pragma unroll
        for (int r = 1; r < 16; ++r) pmax = fmaxf(pmax, p0[r]);
#pragma unroll
        for (int r = 0; r < 16; ++r) pmax = fmaxf(pmax, p1[r]);
        pmax = half_swap_max(pmax);
        float mn, alpha;
        if (__all(pmax - m_reg <= THR_RAW)) { mn = m_reg; alpha = 1.f; }
        else { mn = fmaxf(m_reg, pmax); alpha = __builtin_amdgcn_exp2f((m_reg - mn) * CEXP); m_reg = mn; }
        const float mnC = -mn * CEXP;
        float ps = 0.f;
#pragma unroll
        for (int r = 0; r < 16; ++r) { p0[r] = __builtin_amdgcn_exp2f(fmaf(p0[r], CEXP, mnC)); ps += p0[r]; }
#pragma unroll
        for (int r = 0; r < 16; ++r) { p1[r] = __builtin_amdgcn_exp2f(fmaf(p1[r], CEXP, mnC)); ps += p1[r]; }
        ps = half_swap_sum(ps);
        l_reg = l_reg * alpha + ps;
        if (__any(alpha < 1.f)) { if (hi == 0) al_l[r32] = alpha; asm volatile("s_waitcnt lgkmcnt(0)" ::: "memory");
#pragma unroll
            for (int r = 0; r < 16; ++r) { const float a = al_l[crow(r, hi)];
#pragma unroll
                for (int d = 0; d < 4; ++d) o[d][r] *= a; } }
        h8 pa0, pa1, pa2, pa3; pack_p(p0, p1, pa0, pa1, pa2, pa3);
        AT_SBAR();
        pv_d0(o, vb0 + buf * SHM_V, pa0, pa1, pa2, pa3);
        if (jn < 0) break;
        asm volatile("s_waitcnt vmcnt(0)" ::: "memory");
        swrite(st, V_lds, K_lds, buf ^ 1);
        __syncthreads();
        buf ^= 1; j = jn; rest &= rest - 1;
    }
    if (hi == 0) li_l[r32] = l_reg; asm volatile("s_waitcnt lgkmcnt(0)" ::: "memory");
#pragma unroll
    for (int r = 0; r < 16; ++r) { const int orow = crow(r, hi); const float l = li_l[orow]; const float rl = l > 0.f ? 1.f / l : 0.f;
#pragma unroll
        for (int d0 = 0; d0 < 4; ++d0) outw[(size_t)orow * ostride + d0 * 32 + r32] = o[d0][r] * rl; }
    __syncthreads();
}

constexpr int LDS_AP = LDS_END, LDS_BP = LDS_AP + 4 * 64 * 33 * 4, LDS_SELM = LDS_BP + 4 * 64 * 33 * 4, LDS_CS_END = LDS_SELM + 64 * 4;
__device__ __forceinline__ void cmp_slc_unit(char* lds, const _Float16* qrow, const _Float16* Kc, const _Float16* Vc, const _Float16* Ks, const _Float16* Vs, int t, int tl, int g, int qi,
                                             float* outc, float* outs) {
    const int tid = threadIdx.x, wid = __builtin_amdgcn_readfirstlane(tid >> 6), lane = tid & 63, r32 = lane & 31, hi = lane >> 5;
    char* V_lds = lds; char* K_lds = lds + 2 * SHM_V;
    float* AP = (float*)(lds + LDS_AP); float* BP = (float*)(lds + LDS_BP); unsigned* selm = (unsigned*)(lds + LDS_SELM);
    {
        h8 qr[8];
#pragma unroll
        for (int d0 = 0; d0 < 8; ++d0) qr[d0] = *(const h8*)(qrow + d0 * 16);
        const int vb0 = (int)(uintptr_t)V_lds + v_rd_base(lane);
        { Stage4 s0, s1; sload(s0, Kc, Vc, 256, 0); sload(s1, Kc, Vc, 256, 64);
          asm volatile("s_waitcnt vmcnt(0)" ::: "memory");
          swrite(s0, V_lds, K_lds, 0); swrite(s1, V_lds, K_lds, 1); }
        __syncthreads();
        f32x16 pA0, pA1, pB0, pB1;
        AT_SBAR(); qkt(pA0, pA1, K_lds, qr, r32, hi); qkt(pB0, pB1, K_lds + SHM_K, qr, r32, hi);
        const int khi = t >= 31 ? ((t - 31) >> 4) : -1;
#pragma unroll
        for (int r = 0; r < 16; ++r) { const int c0 = 4 * hi + (r & 3) + 8 * (r >> 2);
            pA0[r] = (c0 <= khi) ? pA0[r] : -INFINITY; pA1[r] = (c0 + 32 <= khi) ? pA1[r] : -INFINITY;
            pB0[r] = (c0 + 64 <= khi) ? pB0[r] : -INFINITY; pB1[r] = (c0 + 96 <= khi) ? pB1[r] : -INFINITY; }
        float pmax = -INFINITY;
#pragma unroll
        for (int r = 0; r < 16; ++r) pmax = fmaxf(fmaxf(pmax, pA0[r]), fmaxf(pA1[r], fmaxf(pB0[r], pB1[r])));
        pmax = half_swap_max(pmax);
        const float mC = (pmax == -INFINITY) ? 0.f : -pmax * CEXP;
        float ps = 0.f;
#pragma unroll
        for (int r = 0; r < 16; ++r) { pA0[r] = __builtin_amdgcn_exp2f(fmaf(pA0[r], CEXP, mC)); pA1[r] = __builtin_amdgcn_exp2f(fmaf(pA1[r], CEXP, mC));
            pB0[r] = __builtin_amdgcn_exp2f(fmaf(pB0[r], CEXP, mC)); pB1[r] = __builtin_amdgcn_exp2f(fmaf(pB1[r], CEXP, mC)); ps += (pA0[r] + pA1[r]) + (pB0[r] + pB1[r]); }
        ps = half_swap_sum(ps);
        const float inv = ps > 0.f ? 1.f / ps : 0.f;
#pragma unroll
        for (int r = 0; r < 16; ++r) { pA0[r] *= inv; pA1[r] *= inv; pB0[r] *= inv; pB1[r] *= inv; }
        { float* ap = AP + (g * 64 + tl) * 33; float* bp = BP + (g * 64 + tl) * 33;
          if (hi == 0) bp[0] = 0.f;
#define AT_IMP(P, JB) do { _Pragma("unroll") for (int k = 0; k < 4; ++k) { const int j = (JB) + 2 * k + hi; \
              ap[j] = 2.f * (P[4 * k] + P[4 * k + 1] + P[4 * k + 2]) + P[4 * k + 3]; if (j + 1 < 32) bp[j + 1] = P[4 * k + 3]; } } while (0)
          AT_IMP(pA0, 0); AT_IMP(pA1, 8); AT_IMP(pB0, 16); AT_IMP(pB1, 24);
#undef AT_IMP
        }
        f32x16 o[4] = {};
        h8 pa0, pa1, pa2, pa3;
        pack_p(pA0, pA1, pa0, pa1, pa2, pa3); AT_SBAR(); pv_d0(o, vb0, pa0, pa1, pa2, pa3);
        pack_p(pB0, pB1, pa0, pa1, pa2, pa3); AT_SBAR(); pv_d0(o, vb0 + SHM_V, pa0, pa1, pa2, pa3);
#pragma unroll
        for (int r = 0; r < 16; ++r) { const int orow = crow(r, hi);
#pragma unroll
            for (int d0 = 0; d0 < 4; ++d0) outc[(size_t)orow * 1024 + d0 * 32 + r32] = o[d0][r]; }
    }
    __syncthreads();
#pragma unroll 1
    for (int it = 0; it < 4; ++it) {
        const int tk = 8 * wid + 2 * it + hi, j = r32;
        float imp = 0.f;
#pragma unroll
        for (int gg = 0; gg < 4; ++gg) imp += AP[(gg * 64 + tk) * 33 + j] + BP[(gg * 64 + tk) * 33 + j];
        const bool forced = (j == 0) || (j == qi) || (j == qi - 1), valid = j <= qi;
        const float iv = forced ? 1e9f : (valid ? imp : -1e9f);
        int rank = 0;
        for (int i = 0; i < 32; ++i) { const float vi = __shfl(iv, i + 32 * hi); rank += (vi > iv || (vi == iv && i < j)) ? 1 : 0; }
        const unsigned long long bal = __ballot(rank < 16 && valid);
        if (r32 == 0) selm[tk] = (unsigned)(bal >> (32 * hi));
    }
    __syncthreads();
    unsigned tm = selm[lane];
#pragma unroll
    for (int o = 32; o > 0; o >>= 1) tm |= __shfl_xor(tm, o);
    const int tz2 = hidden_tid();
    const unsigned mysel = selm[((tz2 >> 6) & 1) * 32 + (tz2 & 31)];
    attn_unit(lds, qrow, Ks, Vs, INW, tm, 0, t, mysel, outs, 1024);
}
}

__device__ __forceinline__ void conv_tile(float* lds, const float* __restrict__ W, int ldw, int nvalid, _Float16* __restrict__ Wt, int K, int k0, int n0) {
    const int tid = threadIdx.x;
    float4 v[8];
#pragma unroll
    for (int i = 0; i < 8; ++i) { const int idx = tid + 512 * i, r = idx >> 6, c4 = (idx & 63) * 4;
        v[i] = (n0 + c4 < nvalid) ? *(const float4*)(W + (size_t)(k0 + r) * ldw + n0 + c4) : make_float4(0.f, 0.f, 0.f, 0.f); }
#pragma unroll
    for (int i = 0; i < 8; ++i) { const int idx = tid + 512 * i, r = idx >> 6, c4 = (idx & 63) * 4; float* d = lds + r * 257 + c4; d[0] = v[i].x; d[1] = v[i].y; d[2] = v[i].z; d[3] = v[i].w; }
    __syncthreads();
#pragma unroll
    for (int j = 0; j < 4; ++j) { const int id = tid + 512 * j, n = id >> 3, k8 = (id & 7) * 8; h8 o;
#pragma unroll
        for (int q = 0; q < 8; ++q) o[q] = (_Float16)lds[(k8 + q) * 257 + n];
        *(h8*)(Wt + (size_t)(n0 + n) * K + k0 + k8) = o; }
    __syncthreads();
}


__device__ __forceinline__ unsigned pack4_i8(float a, float b, float c, float d) {
    const int ia = __float2int_rn(a), ib = __float2int_rn(b), ic = __float2int_rn(c), id = __float2int_rn(d);
    return (unsigned)(ia & 255) | ((unsigned)(ib & 255) << 8) | ((unsigned)(ic & 255) << 16) | ((unsigned)(id & 255) << 24);
}
constexpr int QP_LD2 = 1026;
struct QUnit { const float* W; int ldw; int n0; signed char* Q; float* sc; };
__device__ __forceinline__ QUnit quant_desc(int u, const float* wgu, const float* wdn, signed char* q8gu, signed char* q8dn, float* sgu, float* sdn) {
    QUnit d;
    if (u < NE * 128) { const int e = u >> 7, pn = u & 127; d.W = wgu + (size_t)e * 2048 * 4096; d.ldw = 4096; d.n0 = pn * 32; d.Q = q8gu + (size_t)e * 4096 * 2048; d.sc = sgu + (size_t)e * 4096; }
    else { const int v = u - NE * 128, e = v >> 6, pn = v & 63; d.W = wdn + (size_t)e * 2048 * 2048; d.ldw = 2048; d.n0 = pn * 32; d.Q = q8dn + (size_t)e * 2048 * 2048; d.sc = sdn + (size_t)e * 2048; }
    return d;
}
__device__ __forceinline__ unsigned pk2h(float a, float b) { auto v = __builtin_amdgcn_cvt_pkrtz(a, b); return *reinterpret_cast<unsigned*>(&v); }
__device__ __forceinline__ void quant_all(char* smem, const float* wgu, const float* wdn, signed char* q8gu, signed char* q8dn, float* sgu, float* sdn, int bid, int nb) {
    constexpr int NU = NE * 128 + NE * 64;
    unsigned* Tt = (unsigned*)smem;
    unsigned* cmaxb = (unsigned*)(smem + 32 * QP_LD2 * 4);
    const int tid = threadIdx.x, c4 = (tid & 7) * 4, kp = tid >> 3;
    if (tid < 64) cmaxb[tid] = 0u;
    __syncthreads();
    int u = bid; if (u >= NU) return;
    QUnit d = quant_desc(u, wgu, wdn, q8gu, q8dn, sgu, sdn);
    float4 va[8], vb[8];
#define QL(dst, D, bt) do { _Pragma("unroll") for (int j = 0; j < 4; ++j) { const float* p0 = (D).W + (size_t)(((bt) * 4 + j) * 128 + 2 * kp) * (D).ldw + (D).n0 + c4; dst[2 * j] = *(const float4*)p0; dst[2 * j + 1] = *(const float4*)(p0 + (D).ldw); } } while (0)
#define QP(src, bt) do { _Pragma("unroll") for (int j = 0; j < 4; ++j) { const int kg = ((bt) * 4 + j) * 64 + kp; const float4 r0 = src[2 * j], r1 = src[2 * j + 1]; \
        Tt[(c4 + 0) * QP_LD2 + kg] = pk2h(r0.x, r1.x); Tt[(c4 + 1) * QP_LD2 + kg] = pk2h(r0.y, r1.y); Tt[(c4 + 2) * QP_LD2 + kg] = pk2h(r0.z, r1.z); Tt[(c4 + 3) * QP_LD2 + kg] = pk2h(r0.w, r1.w); \
        m0 = fmaxf(m0, fmaxf(fabsf(r0.x), fabsf(r1.x))); m1 = fmaxf(m1, fmaxf(fabsf(r0.y), fabsf(r1.y))); m2 = fmaxf(m2, fmaxf(fabsf(r0.z), fabsf(r1.z))); m3 = fmaxf(m3, fmaxf(fabsf(r0.w), fabsf(r1.w))); } } while (0)
    QL(va, d, 0);
    int par = 0;
    for (;;) {
        unsigned* cmax = cmaxb + par * 32;
        float m0 = 0.f, m1 = 0.f, m2 = 0.f, m3 = 0.f;
        QL(vb, d, 1); QP(va, 0);
        QL(va, d, 2); QP(vb, 1);
        QL(vb, d, 3); QP(va, 2);
        const int un = u + nb; const bool has = un < NU;
        QUnit dn = d; if (has) { dn = quant_desc(un, wgu, wdn, q8gu, q8dn, sgu, sdn); QL(va, dn, 0); }
        QP(vb, 3);
        atomicMax(&cmax[c4 + 0], __float_as_uint(m0)); atomicMax(&cmax[c4 + 1], __float_as_uint(m1)); atomicMax(&cmax[c4 + 2], __float_as_uint(m2)); atomicMax(&cmax[c4 + 3], __float_as_uint(m3));
        __syncthreads();
        if (tid < 32) cmaxb[(par ^ 1) * 32 + tid] = 0u;
#pragma unroll
        for (int j = 0; j < 8; ++j) { const int id = tid + 512 * j, n = id >> 7, k16 = (id & 127) * 16;
            const float mx = __uint_as_float(cmax[n]); const float inv = mx > 0.f ? 127.f / mx : 0.f;
            const h4* src = (const h4*)(Tt + n * QP_LD2 + (k16 >> 1));
            const h4 a = src[0], b = src[1], c = src[2], e4 = src[3];
            uint4 o;
            o.x = pack4_i8((float)a[0] * inv, (float)a[1] * inv, (float)a[2] * inv, (float)a[3] * inv); o.y = pack4_i8((float)b[0] * inv, (float)b[1] * inv, (float)b[2] * inv, (float)b[3] * inv);
            o.z = pack4_i8((float)c[0] * inv, (float)c[1] * inv, (float)c[2] * inv, (float)c[3] * inv); o.w = pack4_i8((float)e4[0] * inv, (float)e4[1] * inv, (float)e4[2] * inv, (float)e4[3] * inv);
            *(uint4*)(d.Q + (size_t)(d.n0 + n) * 2048 + k16) = o; }
        if (tid < 32) { const float mx = __uint_as_float(cmax[tid]); d.sc[d.n0 + tid] = mx > 0.f ? mx / 127.f : 1.f; }
        __syncthreads();
        if (!has) break;
        u = un; d = dn; par ^= 1;
    }
#undef QL
#undef QP
}

__global__ void __launch_bounds__(512, 2) fwd(Params p) {
    extern __shared__ __attribute__((aligned(16))) char smem[];
    const int tid = threadIdx.x, lane = tid & 63, wv = __builtin_amdgcn_readfirstlane(tid >> 6);
    const int bid = blockIdx.x, nb = gridDim.x;
    const int gw = bid * 8 + wv, nw = nb * 8;
    const int lo = (int)(p.lo_hi & 0xffffffffll), hi = (int)(p.lo_hi >> 32);
    unsigned char* ws = p.ws;
    unsigned* ctl = (unsigned*)(ws + WS_CTL);
    int* cnt = (int*)(ws + CTL_CNT);
    float* proj = (float*)(ws + WS_PROJ);
    float* kvmem = (float*)(ws + WS_KVMEM);
    float* bias1 = (float*)(ws + WS_BIAS1);
    float* hid = (float*)(ws + WS_HID);
    float* kc = (float*)(ws + WS_KC);
    float* vc = (float*)(ws + WS_VC);
    float* pooled = (float*)(ws + WS_POOLED);
    float* opool = (float*)(ws + WS_OPOOL);
    float* owin = (float*)(ws + WS_OWIN);
    float* ocmp = (float*)(ws + WS_OCMP);
    float* oslc = (float*)(ws + WS_OSLC);
    unsigned* sel = (unsigned*)(ws + WS_SEL);
    float* omem = (float*)(ws + WS_OMEM);
    _Float16* cat16 = (_Float16*)(ws + WS_CAT16);
    _Float16* hpre16 = (_Float16*)(ws + WS_HPRE);
    float* hbuf = (float*)(ws + WS_H);
    float* gate = (float*)(ws + WS_GATE);
    int* list = (int*)(ws + WS_LIST);
    _Float16* act16 = (_Float16*)(ws + WS_ACT16);
    _Float16* y16 = (_Float16*)(ws + WS_Y16);
    _Float16* h16 = (_Float16*)(ws + WS_H16);
    _Float16* x16 = (_Float16*)(ws + WS_X16);
    _Float16* wtin = (_Float16*)(ws + WS_WTIN);
    _Float16* wtout = (_Float16*)(ws + WS_WTOUT);
    _Float16* wtgu = (_Float16*)(ws + WS_WTGU);
    _Float16* wtdn = (_Float16*)(ws + WS_WTDN);
    LAS unsigned char* lds = (LAS unsigned char*)smem;
    _Float16* proj16 = (_Float16*)(ws + WS_PROJ16);
    _Float16* kvmem16 = (_Float16*)(ws + WS_KVMEM16);
    _Float16* wt1 = (_Float16*)(ws + WS_WT1);
    float* uv = (float*)(ws + WS_UV);
    _Float16* kc16 = (_Float16*)(ws + WS_KC16);
    _Float16* vc16 = (_Float16*)(ws + WS_VC16);
    _Float16* wr16 = (_Float16*)(ws + WS_WR16);
    _Float16* mem16 = (_Float16*)(ws + WS_MEM16);
    _Float16* wtmkv = (_Float16*)(ws + WS_WTMKV);
    signed char* q8gu = (signed char*)(ws + WS_Q8GU); signed char* q8dn = (signed char*)(ws + WS_Q8DN);
    float* sgu = (float*)(ws + WS_SGU); float* sdn = (float*)(ws + WS_SDN);
    signed char* h8q = (signed char*)(ws + WS_H8); float* sah = (float*)(ws + WS_SAH);
    signed char* act8 = (signed char*)(ws + WS_ACT8); float* sact = (float*)(ws + WS_SACT);
    const int vcu = (nb % 8 == 0) ? (bid % 8) * (nb / 8) + bid / 8 : bid;

    volatile LAS unsigned* xbw = (volatile LAS unsigned*)(smem + LDS_BYTES - 16);
    if (tid == 0) { xbw[0] = 0u; xbw[1] = 0u; xbw[2] = 0u; xbw[3] = 0u; }
    __syncthreads();
    XcdBarrier bar; bar.bar = ctl; bar.x = 0; bar.st = xbw;
    const bool multi = (hi - lo) > 1;
    if (multi) bar = xcd_barrier_post(ctl, xbw);
#define IN(k) (lo <= (k) && (k) < hi)
#define SEAM(k) do { if (IN(k) && IN((k) + 1)) xcd_barrier(bar); } while (0)
    float* sw = (float*)smem + wv * WLDS_FLOATS;
    int* segw = (int*)(sw + 4096 + 512);

    if (IN(0)) {
        for (int j = gw; j < 512; j += nw) {
            const int kv = j >> 8, jj = j & 255;
            const float* pos = p.in[kv ? I_POSV : I_POSK]; const float* w1 = p.in[kv ? I_W1V : I_W1K];
            float s = 0.f;
            for (int k = lane; k < 4096; k += 64) s += pos[k] * w1[(size_t)k * 256 + jj];
            s = wave_sum(s);
            if (lane == 0) bias1[j] = s;
        }
        for (int i = bid * 512 + tid; i < 32 * 2048; i += nb * 512) { const int e = i >> 11, d = i & 2047; wr16[i] = (_Float16)p.in[I_WR][(size_t)d * 32 + e]; }
        for (size_t i = (size_t)bid * 512 + tid; i < (size_t)T_ * 2048 / 4; i += (size_t)nb * 512) {
            const float4 v = ((const float4*)p.in[I_X])[i]; ((h4*)x16)[i] = (h4){(_Float16)v.x, (_Float16)v.y, (_Float16)v.z, (_Float16)v.w};
        }
        {
            constexpr int U_IN = 32 * 15, U_OUT = 32 * 8, U_W1 = 128;
            quant_all(smem, p.in[I_WGU], p.in[I_WDN], q8gu, q8dn, sgu, sdn, bid, nb);
            __syncthreads();
            for (int u = bid; u < U_IN + U_OUT + U_W1; u += nb) {
                if (u < U_IN) { const int v = u, kt = v / 15, ntl = v % 15;
                    conv_tile((float*)smem, p.in[I_WIN], INW, INW, wtin, 2048, kt * 64, ntl * 256);
                } else if (u < U_IN + U_OUT) { const int v = u - U_IN, kt = v / 8, ntl = v % 8;
                    conv_tile((float*)smem, p.in[I_WOUT], 2048, 2048, wtout, 2048, kt * 64, ntl * 256);
                } else { const int v = u - U_IN - U_OUT, kv = v >> 6, part = (v >> 5) & 1, kt = v & 31;
                    conv_tile((float*)smem, p.in[kv ? I_W1V : I_W1K] + (size_t)part * 2048 * 256, 256, 256, wt1 + ((size_t)kv * 512 + part * 256) * 2048, 2048, kt * 64, 0);
                }
            }
        }
        for (size_t i = (size_t)bid * 512 + tid; i < (size_t)2048 * 2048 / 4; i += (size_t)nb * 512) {
            const float4 v = ((const float4*)p.in[I_MEM])[i]; ((h4*)mem16)[i] = (h4){(_Float16)v.x, (_Float16)v.y, (_Float16)v.z, (_Float16)v.w};
        }
        for (int u = bid; u < 128; u += nb) { const int kt = u >> 2, ntl = u & 3; conv_tile((float*)smem, p.in[I_WMEMKV], 1024, 1024, wtmkv, 2048, kt * 64, ntl * 256); }
    }
    SEAM(0);
    if (IN(1)) {
        g8::ProbIn P{x16, proj16, nb, bid};
        g8::gemm_phase(lds, P);
    }
    SEAM(1);
    if (IN(2)) {
        { g8::ProbCmp P{proj16, wt1, uv, nb, bid}; g8::gemm_phase(lds, P); __syncthreads(); }
        for (int i = bid * 512 + tid; i < T_ * 64; i += nb * 512) {
            const int chn = i & 63, row = i >> 6, t = row & (S_ - 1), g = chn >> 4;
            const int win = 2 << g, n = min(win, t + 1);
            const _Float16* src = proj16 + (size_t)row * INW + C_UP + chn * 8;
            float a[8];
            const h8 cur = *(const h8*)src;
#pragma unroll
            for (int q = 0; q < 8; ++q) a[q] = (float)cur[q];
            for (int k = 1; k < n; ++k) { const h8 v = *(const h8*)(src - (size_t)k * INW);
#pragma unroll
                for (int q = 0; q < 8; ++q) a[q] += (float)v[q]; }
            const float rn = 1.f / (float)n;
            float4 o0, o1;
            o0.x = a[0] * rn - (float)cur[0]; o0.y = a[1] * rn - (float)cur[1]; o0.z = a[2] * rn - (float)cur[2]; o0.w = a[3] * rn - (float)cur[3];
            o1.x = a[4] * rn - (float)cur[4]; o1.y = a[5] * rn - (float)cur[5]; o1.z = a[6] * rn - (float)cur[6]; o1.w = a[7] * rn - (float)cur[7];
            *(float4*)(pooled + (size_t)row * 512 + chn * 8) = o0; *(float4*)(pooled + (size_t)row * 512 + chn * 8 + 4) = o1;
        }
        {
            const int r32 = lane & 31, hi = lane >> 5, g = wv >> 1, half = wv & 1;
            for (int uu = bid; uu < 512; uu += nb) {
                const int u = (uu & 1) ? (511 - (uu >> 1)) : (uu >> 1);
                const int bk = u >> 5, qi = u & 31, b = bk >> 1, kvh = bk & 1;
                const int t = qi * 64 + half * 32 + r32;
                const int lo_t = max(0, qi - 8);
                const unsigned tmask = (unsigned)(((1ull << (qi + 1)) - 1ull) & ~((1ull << lo_t) - 1ull));
                at8::attn_unit(smem, proj16 + (size_t)(b * S_ + t) * INW + C_Q + (kvh * 4 + g) * 128 + hi * 8,
                               proj16 + (size_t)b * S_ * INW + C_KW + kvh * 128, proj16 + (size_t)b * S_ * INW + C_VW + kvh * 128, INW, tmask, t - 511, t, 0xffffffffu,
                               owin + (size_t)(b * S_ + qi * 64 + half * 32) * 1024 + (kvh * 4 + g) * 128, 1024);
            }
            for (int u = bid; u < 256; u += nb) {
                const int b = u >> 5, h = (u >> 3) & 3, qt = u & 7;
                const int t = qt * 256 + wv * 32 + r32;
                at8::attn_unit(smem, proj16 + (size_t)(b * S_ + t) * INW + C_QM + h * 128 + hi * 8,
                               kvmem16 + (size_t)b * 256 * 1024 + h * 128, kvmem16 + (size_t)b * 256 * 1024 + 512 + h * 128, 1024, 0xFu, 0, 255, 0xffffffffu,
                               omem + (size_t)(b * S_ + qt * 256 + wv * 32) * 512 + h * 128, 512);
            }
        }
    }
    SEAM(2);
    if (IN(3)) {
        {   float* hs = (float*)smem;
            for (int u = bid; u < 508; u += nb) {
                const int kv = u / 254, ub = u % 254;
                const float* w2 = p.in[kv ? I_W2V : I_W2K]; _Float16* dst = kv ? vc16 : kc16;
                __syncthreads();
#pragma unroll
                for (int q = 0; q < 4; ++q) { const int e = tid + 512 * q, i = e >> 8, n = e & 255;
                    const int idx = ub * 8 + i, b = idx / 254, rem = idx % 254, c = rem >> 1, kvh = rem & 1;
                    const int row = (b * 128 + c) * 2 + kvh;
                    float a = bias1[kv * 256 + n];
#pragma unroll
                    for (int sp = 0; sp < 4; ++sp) { const float* base = uv + ((size_t)(kv * 4 + sp) * 2048) * 512; a += base[(size_t)row * 512 + n] + base[(size_t)(row + 2) * 512 + 256 + n]; }
                    hs[i * 256 + n] = gelu_tanh(a); }
                __syncthreads();
#pragma unroll
                for (int q = 0; q < 2; ++q) { const int e = tid + 512 * q, i = e >> 7, d = e & 127;
                    const int idx = ub * 8 + i, b = idx / 254, rem = idx % 254, c = rem >> 1, kvh = rem & 1;
                    float a = 0.f;
                    for (int n = 0; n < 256; ++n) a += hs[i * 256 + n] * w2[n * 128 + d];
                    dst[(size_t)((b * 128 + c) * 2 + kvh) * 128 + d] = (_Float16)a; }
            }
            __syncthreads();
            for (int i = bid * 512 + tid; i < 2 * B_ * 256; i += nb * 512) { const int kv = i / (B_ * 256), r = i % (B_ * 256), b = r >> 8, x = r & 255;
                (kv ? vc16 : kc16)[(size_t)(b * 128 + 127) * 256 + x] = (_Float16)0.f; }
        }
        for (int u = bid; u < 128 * 4; u += nb) { const int g = u >> 7, mt = u & 127;
            ARowPlain af{pooled + g * 128, 512, mt * 128, T_}; EpiPool ef{opool, p.in[I_POOLS], mt * 128, g};
            gemm_tile(smem, 128, af, p.in[I_POOLW] + (size_t)g * 128 * 128, 128, 0, 128, false, ef);
        }
    }
    SEAM(3);
    if (IN(4)) {
        const int r32 = lane & 31, hi = lane >> 5, g = wv >> 1, half = wv & 1;
        for (int uu = bid; uu < 512; uu += nb) {
            const int u = (uu & 1) ? (511 - (uu >> 1)) : (uu >> 1);
            const int bk = u >> 5, qi = u & 31, b = bk >> 1, kvh = bk & 1;
            const int tl = half * 32 + r32, t = qi * 64 + tl;
            at8::cmp_slc_unit(smem, proj16 + (size_t)(b * S_ + t) * INW + C_Q + (kvh * 4 + g) * 128 + hi * 8,
                              kc16 + (size_t)(b * 128 * 2 + kvh) * 128, vc16 + (size_t)(b * 128 * 2 + kvh) * 128,
                              proj16 + (size_t)b * S_ * INW + C_KS + kvh * 128, proj16 + (size_t)b * S_ * INW + C_VS + kvh * 128, t, tl, g, qi,
                              ocmp + (size_t)(b * S_ + qi * 64 + half * 32) * 1024 + (kvh * 4 + g) * 128, oslc + (size_t)(b * S_ + qi * 64 + half * 32) * 1024 + (kvh * 4 + g) * 128);
        }
    }
    SEAM(4);
    if (IN(5)) {
        for (int row = gw; row < T_; row += nw) {
            const _Float16* pr = proj16 + (size_t)row * INW;
            float v[16]; float ss = 0.f;
#pragma unroll
            for (int i = 0; i < 16; ++i) { const int col = lane + 64 * i, h = col >> 7; const size_t o = (size_t)row * 1024 + col;
                const float g0 = sigmoidf_((float)pr[C_G + h * 3]), g1 = sigmoidf_((float)pr[C_G + h * 3 + 1]), g2 = sigmoidf_((float)pr[C_G + h * 3 + 2]);
                v[i] = g0 * ocmp[o] + g1 * oslc[o] + g2 * owin[o]; ss += v[i] * v[i]; }
            ss = wave_sum(ss); float r = rsqrtf(ss / 1024.f + LN_EPS);
#pragma unroll
            for (int i = 0; i < 16; ++i) { const int col = lane + 64 * i; cat16[(size_t)row * 2048 + col] = (_Float16)(v[i] * r * p.in[I_GNNSA][col]); }
            ss = 0.f;
#pragma unroll
            for (int i = 0; i < 8; ++i) { v[i] = opool[(size_t)row * 512 + lane + 64 * i]; ss += v[i] * v[i]; }
            ss = wave_sum(ss); r = rsqrtf(ss / 512.f + LN_EPS);
#pragma unroll
            for (int i = 0; i < 8; ++i) { const int col = lane + 64 * i; cat16[(size_t)row * 2048 + 1024 + col] = (_Float16)(v[i] * r * p.in[I_GNPOOL][col]); }
            ss = 0.f;
#pragma unroll
            for (int i = 0; i < 8; ++i) { v[i] = omem[(size_t)row * 512 + lane + 64 * i]; ss += v[i] * v[i]; }
            ss = wave_sum(ss); r = rsqrtf(ss / 512.f + LN_EPS);
#pragma unroll
            for (int i = 0; i < 8; ++i) { const int col = lane + 64 * i; cat16[(size_t)row * 2048 + 1536 + col] = (_Float16)(v[i] * r * p.in[I_GNMEM][col]); }
        }
    }
    SEAM(5);
    if (IN(6)) {
        g8::ProbOut P{cat16, wtout, hpre16, x16, nb, bid};
        g8::gemm_phase(lds, P);
    }
    SEAM(6);
    if (IN(7)) {
        float* lg = (float*)smem;
        const int r32 = lane & 31, hi = lane >> 5, fr = lane & 15, fq = lane >> 4;
        for (int u = bid; u < T_ / 64; u += nb) {
            const int base = u * 64;
#pragma unroll 1
            for (int i = 0; i < 8; ++i) {
                const int row = base + wv * 8 + i;
                float v[32]; float s = 0.f;
#pragma unroll
                for (int c = 0; c < 4; ++c) { const int col = (lane + 64 * c) * 8;
                    const h8 a0 = *(const h8*)(hpre16 + (size_t)row * 2048 + col);
#pragma unroll
                    for (int q = 0; q < 8; ++q) { v[c * 8 + q] = (float)a0[q]; s += v[c * 8 + q]; } }
                const float mu = wave_sum(s) / 2048.f; float q2 = 0.f;
#pragma unroll
                for (int k = 0; k < 32; ++k) { const float d = v[k] - mu; q2 += d * d; }
                const float rs = rsqrtf(wave_sum(q2) / 2048.f + LN_EPS);
                float amax = 0.f;
#pragma unroll
                for (int c = 0; c < 4; ++c) { const int col = (lane + 64 * c) * 8;
                    const float4 g0 = *(const float4*)(p.in[I_LN1G] + col), g1 = *(const float4*)(p.in[I_LN1G] + col + 4), b0 = *(const float4*)(p.in[I_LN1B] + col), b1 = *(const float4*)(p.in[I_LN1B] + col + 4);
                    float4 o0, o1;
                    o0.x = (v[c * 8 + 0] - mu) * rs * g0.x + b0.x; o0.y = (v[c * 8 + 1] - mu) * rs * g0.y + b0.y; o0.z = (v[c * 8 + 2] - mu) * rs * g0.z + b0.z; o0.w = (v[c * 8 + 3] - mu) * rs * g0.w + b0.w;
                    o1.x = (v[c * 8 + 4] - mu) * rs * g1.x + b1.x; o1.y = (v[c * 8 + 5] - mu) * rs * g1.y + b1.y; o1.z = (v[c * 8 + 6] - mu) * rs * g1.z + b1.z; o1.w = (v[c * 8 + 7] - mu) * rs * g1.w + b1.w;
                    *(float4*)(hbuf + (size_t)row * 2048 + col) = o0; *(float4*)(hbuf + (size_t)row * 2048 + col + 4) = o1;
                    h8 oh; oh[0] = (_Float16)o0.x; oh[1] = (_Float16)o0.y; oh[2] = (_Float16)o0.z; oh[3] = (_Float16)o0.w; oh[4] = (_Float16)o1.x; oh[5] = (_Float16)o1.y; oh[6] = (_Float16)o1.z; oh[7] = (_Float16)o1.w;
                    *(h8*)(h16 + (size_t)row * 2048 + col) = oh;
                    v[c * 8 + 0] = o0.x; v[c * 8 + 1] = o0.y; v[c * 8 + 2] = o0.z; v[c * 8 + 3] = o0.w; v[c * 8 + 4] = o1.x; v[c * 8 + 5] = o1.y; v[c * 8 + 6] = o1.z; v[c * 8 + 7] = o1.w;
                    amax = fmaxf(amax, fmaxf(fmaxf(fmaxf(fabsf(o0.x), fabsf(o0.y)), fmaxf(fabsf(o0.z), fabsf(o0.w))), fmaxf(fmaxf(fabsf(o1.x), fabsf(o1.y)), fmaxf(fabsf(o1.z), fabsf(o1.w))))); }
                amax = wave_max(amax);
                const float qinv = amax > 0.f ? 127.f / amax : 0.f;
                if (lane == 0) sah[row] = amax > 0.f ? amax / 127.f : 1.f;
#pragma unroll
                for (int c = 0; c < 4; ++c) { const int col = (lane + 64 * c) * 8;
                    uint2 q; q.x = pack4_i8(v[c * 8 + 0] * qinv, v[c * 8 + 1] * qinv, v[c * 8 + 2] * qinv, v[c * 8 + 3] * qinv); q.y = pack4_i8(v[c * 8 + 4] * qinv, v[c * 8 + 5] * qinv, v[c * 8 + 6] * qinv, v[c * 8 + 7] * qinv);
                    *(uint2*)(h8q + (size_t)row * 2048 + col) = q; }
            }
            asm volatile("s_waitcnt vmcnt(0)" ::: "memory");
            __syncthreads();
            {
                const int tok0 = base + 16 * (wv >> 1), e0 = 16 * (wv & 1);
                const _Float16* ap = h16 + (size_t)(tok0 + fr) * 2048 + fq * 8; const _Float16* bp = wr16 + (size_t)(e0 + fr) * 2048 + fq * 8;
                f4 acc = (f4){0.f, 0.f, 0.f, 0.f};
#pragma unroll 8
                for (int sI = 0; sI < 64; ++sI) { const h8 a = *(const h8*)(ap + sI * 32), bb = *(const h8*)(bp + sI * 32); acc = __builtin_amdgcn_mfma_f32_16x16x32_f16(a, bb, acc, 0, 0, 0); }
                const float br = p.in[I_BR][e0 + fr];
#pragma unroll
                for (int j = 0; j < 4; ++j) lg[(16 * (wv >> 1) + 4 * fq + j) * 33 + e0 + fr] = acc[j] + br;
            }
            __syncthreads();
#pragma unroll 1
            for (int it = 0; it < 4; ++it) {
                const int tk = 8 * wv + 2 * it + hi;
                const float iv = lg[tk * 33 + r32];
                int rank = 0;
                for (int i = 0; i < 32; ++i) { const float vi = __shfl(iv, i + 32 * hi); rank += (vi > iv || (vi == iv && i < r32)) ? 1 : 0; }
                float tv[4]; int te[4];
#pragma unroll
                for (int r = 0; r < 4; ++r) { const unsigned long long bm = __ballot(rank == r); const unsigned hm = (unsigned)(bm >> (32 * hi)); const int src = __ffs(hm) - 1; te[r] = src; tv[r] = __shfl(iv, src + 32 * hi); }
                const float e0v = 1.f, e1v = expf(tv[1] - tv[0]), e2v = expf(tv[2] - tv[0]), e3v = expf(tv[3] - tv[0]); const float inv = 1.f / (e0v + e1v + e2v + e3v);
                if (r32 < 4) { const int e = r32 == 0 ? te[0] : r32 == 1 ? te[1] : r32 == 2 ? te[2] : te[3]; const float g = (r32 == 0 ? e0v : r32 == 1 ? e1v : r32 == 2 ? e2v : e3v) * inv;
                    const int a = (base + tk) * 4 + r32; const int pos = atomicAdd(&cnt[e], 1); list[(size_t)e * T_ + pos] = a; gate[a] = g; }
            }
            __syncthreads();
        }
    }
    SEAM(7);
    LAS int* mtab = (LAS int*)(smem + g8::STAGE_BYTES);
    if (IN(8)) {
        if (tid == 0) { int ub = 0, rs = 0;
            for (int e = 0; e < NE; ++e) { const int c = (int)__hip_atomic_load((unsigned*)&cnt[e], __ATOMIC_RELAXED, __HIP_MEMORY_SCOPE_AGENT); mtab[e] = c; mtab[32 + e] = ub; mtab[65 + e] = rs; ub += ((c + 255) >> 8) * 16; rs += c; }
            mtab[64] = ub; mtab[97] = rs; mtab[98] = ub; }
        __syncthreads();
        g8::ProbGu P{h8q, q8gu, act16, p.in[I_BGU], list, sah, sgu, g8::MoeTab{mtab, 16}, nb, vcu};
        g8::gemm_phase(lds, P);
        __syncthreads();
    }
    SEAM(8);
    if (IN(9)) {
        for (int row = gw; row < NA; row += nw) {
            float v[32]; float amax = 0.f;
#pragma unroll
            for (int c = 0; c < 4; ++c) { const h8 a = *(const h8*)(act16 + (size_t)row * 2048 + (lane + 64 * c) * 8);
#pragma unroll
                for (int q = 0; q < 8; ++q) { v[c * 8 + q] = (float)a[q]; amax = fmaxf(amax, fabsf(v[c * 8 + q])); } }
            amax = wave_max(amax);
            const float qinv = amax > 0.f ? 127.f / amax : 0.f;
            if (lane == 0) sact[row] = amax > 0.f ? amax / 127.f : 1.f;
#pragma unroll
            for (int c = 0; c < 4; ++c) { uint2 q; q.x = pack4_i8(v[c * 8 + 0] * qinv, v[c * 8 + 1] * qinv, v[c * 8 + 2] * qinv, v[c * 8 + 3] * qinv); q.y = pack4_i8(v[c * 8 + 4] * qinv, v[c * 8 + 5] * qinv, v[c * 8 + 6] * qinv, v[c * 8 + 7] * qinv);
                *(uint2*)(act8 + (size_t)row * 2048 + (lane + 64 * c) * 8) = q; }
        }
    }
    SEAM(9);
    if (IN(10)) {
        if (tid == 0) { int ub = 0, rs = 0;
            for (int e = 0; e < NE; ++e) { const int c = (int)__hip_atomic_load((unsigned*)&cnt[e], __ATOMIC_RELAXED, __HIP_MEMORY_SCOPE_AGENT); mtab[e] = c; mtab[32 + e] = ub; mtab[65 + e] = rs; ub += ((c + 255) >> 8) * 8; rs += c; }
            mtab[64] = ub; mtab[97] = rs; mtab[98] = ub; }
        __syncthreads();
        g8::ProbDn P{act8, q8dn, y16, p.in[I_BDN], list, gate, sact, sdn, g8::MoeTab{mtab, 8}, nb, vcu};
        g8::gemm_phase(lds, P);
        __syncthreads();
    }
    SEAM(10);
    if (IN(11)) {
        for (int row = gw; row < T_; row += nw) {
            float v[32]; float s = 0.f;
#pragma unroll
            for (int c = 0; c < 4; ++c) { const int col = (lane + 64 * c) * 8; const size_t yo = (size_t)row * 4 * 2048 + col;
                const float4 ha = *(const float4*)(hbuf + (size_t)row * 2048 + col), hb = *(const float4*)(hbuf + (size_t)row * 2048 + col + 4);
                const h8 y0 = *(const h8*)(y16 + yo), y1 = *(const h8*)(y16 + yo + 2048), y2 = *(const h8*)(y16 + yo + 4096), y3 = *(const h8*)(y16 + yo + 6144);
                const float hh[8] = {ha.x, ha.y, ha.z, ha.w, hb.x, hb.y, hb.z, hb.w};
#pragma unroll
                for (int q = 0; q < 8; ++q) { v[c * 8 + q] = DN_ALPHA * hh[q] + (((float)y0[q] + (float)y1[q]) + ((float)y2[q] + (float)y3[q])); s += v[c * 8 + q]; } }
            const float mu = wave_sum(s) / 2048.f; float q2 = 0.f;
#pragma unroll
            for (int i = 0; i < 32; ++i) { const float d = v[i] - mu; q2 += d * d; }
            const float rs = rsqrtf(wave_sum(q2) / 2048.f + LN_EPS);
#pragma unroll
            for (int c = 0; c < 4; ++c) { const int col = (lane + 64 * c) * 8;
                const float4 ga = *(const float4*)(p.in[I_LN2G] + col), gb = *(const float4*)(p.in[I_LN2G] + col + 4), ba = *(const float4*)(p.in[I_LN2B] + col), bb = *(const float4*)(p.in[I_LN2B] + col + 4);
                float4 o0, o1;
                o0.x = (v[c * 8 + 0] - mu) * rs * ga.x + ba.x; o0.y = (v[c * 8 + 1] - mu) * rs * ga.y + ba.y; o0.z = (v[c * 8 + 2] - mu) * rs * ga.z + ba.z; o0.w = (v[c * 8 + 3] - mu) * rs * ga.w + ba.w;
                o1.x = (v[c * 8 + 4] - mu) * rs * gb.x + bb.x; o1.y = (v[c * 8 + 5] - mu) * rs * gb.y + bb.y; o1.z = (v[c * 8 + 6] - mu) * rs * gb.z + bb.z; o1.w = (v[c * 8 + 7] - mu) * rs * gb.w + bb.w;
                *(float4*)(p.out + (size_t)row * 2048 + col) = o0; *(float4*)(p.out + (size_t)row * 2048 + col + 4) = o1; }
        }
    }
}

constexpr int NPHASE = 12;

extern "C" void kernel_launch(void* const* d_in, const int* in_sizes, int n_in, void* d_out, int out_size, void* d_ws, size_t ws_size, hipStream_t stream) {
    static int grid = 0;
    if (grid == 0) {
        if (n_in != 26 || ws_size < WS_END) { fprintf(stderr, "kernel_launch: unexpected n_in %d or ws_size %zu (< %zu)\n", n_in, ws_size, (size_t)WS_END); grid = -1; return; }
        int dev = 0, cus = 0, per_cu = 0;
        hipGetDevice(&dev); hipDeviceGetAttribute(&cus, hipDeviceAttributeMultiprocessorCount, dev);
        if (hipFuncSetAttribute((const void*)fwd, hipFuncAttributeMaxDynamicSharedMemorySize, LDS_BYTES) != hipSuccess) { fprintf(stderr, "hipFuncSetAttribute failed\n"); grid = -1; return; }
        hipOccupancyMaxActiveBlocksPerMultiprocessor(&per_cu, (const void*)fwd, 512, LDS_BYTES);
        (void)hipGetLastError();
        if (per_cu < 1) fprintf(stderr, "occupancy query says %d blocks per CU\n", per_cu);
        grid = cus > 0 ? cus : 256;
    }
    if (grid < 0) return;
    hipMemsetAsync((char*)d_ws + WS_CTL, 0, CTL_BYTES, stream);
    Params p{};
    for (int i = 0; i < 26; ++i) p.in[i] = (const float*)d_in[i];
    p.out = (float*)d_out; p.ws = (unsigned char*)d_ws;
#if N_LAUNCH_MODE == 1
    p.lo_hi = (long long)0 | ((long long)NPHASE << 32);
    hipLaunchKernelGGL(fwd, dim3(grid), dim3(512), LDS_BYTES, stream, p);
#else
    for (int ph = 0; ph < NPHASE; ++ph) {
        p.lo_hi = (long long)ph | ((long long)(ph + 1) << 32);
        hipLaunchKernelGGL(fwd, dim3(grid), dim3(512), LDS_BYTES, stream, p);
    }
#endif
}
```

```cpp
#include <hip/hip_runtime.h>
#include <cstdio>
#include <cstdint>

#ifndef N_LAUNCH_MODE
#define N_LAUNCH_MODE 1
#endif

constexpr int B_ = 8, S_ = 2048, D_ = 2048, T_ = B_ * S_;
constexpr int INW = 3608;
constexpr int C_Q = 0, C_KC = 1024, C_VC = 1280, C_KS = 1536, C_VS = 1792, C_KW = 2048, C_VW = 2304, C_G = 2560, C_UP = 2584, C_QM = 3096;
constexpr int NC = 127;
constexpr int CROWS = B_ * NC * 2;
constexpr int NE = 32, DE = 2048, NA = T_ * 4;
constexpr float LN_EPS = 1e-5f;
constexpr float DN_ALPHA = 1.189207115002721f;
constexpr float ATT_SCALE = 0.08838834764831845f;

constexpr size_t al256(size_t x) { return (x + 255) & ~(size_t)255; }
constexpr size_t WS_CTL = 0;
constexpr size_t CTL_BYTES = 65536;
constexpr size_t CTL_CNT = 16384;
constexpr size_t WS_PROJ = CTL_BYTES;
constexpr size_t WS_KVMEM = WS_PROJ + al256((size_t)T_ * INW * 4);
constexpr size_t WS_BIAS1 = WS_KVMEM + al256((size_t)2048 * 1024 * 4);
constexpr size_t WS_HID = WS_BIAS1 + al256(2 * 256 * 4);
constexpr size_t WS_KC = WS_HID + al256((size_t)2 * 2048 * 256 * 4);
constexpr size_t WS_VC = WS_KC + al256((size_t)CROWS * 128 * 4);
constexpr size_t WS_POOLED = WS_VC + al256((size_t)CROWS * 128 * 4);
constexpr size_t WS_OPOOL = WS_POOLED + al256((size_t)T_ * 512 * 4);
constexpr size_t WS_OWIN = WS_OPOOL + al256((size_t)T_ * 512 * 4);
constexpr size_t WS_OCMP = WS_OWIN + al256((size_t)T_ * 1024 * 4);
constexpr size_t WS_OSLC = WS_OCMP + al256((size_t)T_ * 1024 * 4);
constexpr size_t WS_SEL = WS_OSLC + al256((size_t)T_ * 1024 * 4);
constexpr size_t WS_OMEM = WS_SEL + al256((size_t)T_ * 2 * 4);
constexpr size_t WS_CAT16 = WS_OMEM + al256((size_t)T_ * 512 * 4);
constexpr size_t WS_HPRE = WS_CAT16 + al256((size_t)T_ * 2048 * 2);
constexpr size_t WS_H = WS_HPRE + al256((size_t)T_ * 2048 * 4);
constexpr size_t WS_H16 = WS_H + al256((size_t)T_ * 2048 * 4);
constexpr size_t WS_GATE = WS_H16 + al256((size_t)T_ * 2048 * 2);
constexpr size_t WS_LIST = WS_GATE + al256((size_t)NA * 4);
constexpr size_t WS_ACT16 = WS_LIST + al256((size_t)NE * T_ * 4);
constexpr size_t WS_Y16 = WS_ACT16 + al256((size_t)(NA + 256) * 2048 * 2);
constexpr size_t WS_X16 = WS_Y16 + al256((size_t)NA * 2048 * 2);
constexpr size_t WS_MEM16 = WS_X16 + (size_t)T_ * 2048 * 2;
constexpr size_t WS_WTIN = WS_MEM16 + al256((size_t)2048 * 2048 * 2);
constexpr size_t WS_WTOUT = WS_WTIN + al256((size_t)3840 * 2048 * 2);
constexpr size_t WS_WTGU = WS_WTOUT + al256((size_t)2048 * 2048 * 2);
constexpr size_t WS_WTDN = WS_WTGU + al256((size_t)NE * 4096 * 2048 * 2);
constexpr size_t WS_PROJ16 = WS_WTDN + al256((size_t)NE * 2048 * 2048 * 2);
constexpr size_t WS_KVMEM16 = WS_PROJ16 + al256((size_t)(T_ + 64) * INW * 2);
constexpr size_t WS_WT1 = WS_KVMEM16 + al256((size_t)2048 * 1024 * 2);
constexpr size_t WS_UV = WS_WT1 + al256((size_t)2 * 512 * 2048 * 2);
constexpr size_t WS_KC16 = WS_UV + al256((size_t)2 * 4 * 2048 * 512 * 4);
constexpr size_t WS_VC16 = WS_KC16 + al256((size_t)B_ * 128 * 256 * 2);
constexpr size_t WS_WR16 = WS_VC16 + al256((size_t)B_ * 128 * 256 * 2);
constexpr size_t WS_Q8GU = WS_WR16 + al256((size_t)32 * 2048 * 2);
constexpr size_t WS_Q8DN = WS_Q8GU + al256((size_t)NE * 4096 * 2048);
constexpr size_t WS_SGU = WS_Q8DN + al256((size_t)NE * 2048 * 2048);
constexpr size_t WS_SDN = WS_SGU + al256((size_t)NE * 4096 * 4);
constexpr size_t WS_H8 = WS_SDN + al256((size_t)NE * 2048 * 4);
constexpr size_t WS_SAH = WS_H8 + al256((size_t)T_ * 2048);
constexpr size_t WS_ACT8 = WS_SAH + al256((size_t)T_ * 4);
constexpr size_t WS_SACT = WS_ACT8 + al256((size_t)(NA + 256) * 2048);
constexpr size_t WS_WTMKV = WS_SACT + al256((size_t)(NA + 256) * 4);
constexpr size_t WS_END = WS_WTMKV + al256((size_t)1024 * 2048 * 2);

constexpr int LDS_BYTES = 155648;

struct Params {
    const float* in[26];
    float* out;
    unsigned char* ws;
    long long lo_hi;
};
enum { I_X = 0, I_MEM, I_WIN, I_POSK, I_W1K, I_W2K, I_POSV, I_W1V, I_W2V, I_POOLW, I_POOLS, I_WMEMKV, I_GNNSA, I_GNPOOL, I_GNMEM, I_WOUT,
       I_LN1G, I_LN1B, I_WR, I_BR, I_WGU, I_BGU, I_WDN, I_BDN, I_LN2G, I_LN2B };

#define XB_TMO      128
#define XB_XCNT(j)  (256  + 64 * (j))
#define XB_XSUB(j)  (1280 + 64 * (j))
#define XB_XGEN(j)  (2304 + 64 * (j))
#define XB_TOP      3328
#define XB_TOPGEN   3392
#define XCD_BAR_WORDS 3456
#define XB_SPIN_CAP (1u << 25)
#define LAS __attribute__((address_space(3)))

__device__ __forceinline__ unsigned xb_ld(unsigned* p)              { return __hip_atomic_load(p, __ATOMIC_RELAXED, __HIP_MEMORY_SCOPE_AGENT); }
__device__ __forceinline__ unsigned xb_add(unsigned* p, unsigned v) { return __hip_atomic_fetch_add(p, v, __ATOMIC_RELAXED, __HIP_MEMORY_SCOPE_AGENT); }
__device__ __forceinline__ unsigned xb_xcc_id() { return (unsigned)__builtin_amdgcn_s_getreg((3 << 11) | 20) & 0xFu; }
#define XB_SPIN(cond, bar) do { unsigned _sp = 0; while (cond) { __builtin_amdgcn_s_sleep(1); \
    if ((++_sp & 255u) == 0u) { if (xb_ld(&(bar)[XB_TMO])) break; if (_sp > XB_SPIN_CAP) { atomicAdd(&(bar)[XB_TMO], 1u); break; } } } } while (0)

struct XcdBarrier { unsigned* bar; unsigned x; volatile LAS unsigned* st; };

__device__ __forceinline__ XcdBarrier xcd_barrier_post(unsigned* bar, volatile LAS unsigned* st) {
    XcdBarrier b; b.bar = bar; b.x = xb_xcc_id(); b.st = st;
    if (threadIdx.x == 0) (void)xb_add(&bar[XB_XCNT(b.x)], 1u);
    return b;
}
__device__ __forceinline__ void xcd_barrier_complete(unsigned* bar, unsigned x, unsigned& nloc, unsigned& nx) {
    const unsigned G = gridDim.x * gridDim.y * gridDim.z;
    unsigned sum, cnt, mine, sp = 0u;
    for (;;) {
        sum = 0u; cnt = 0u; mine = 0u;
#pragma unroll
        for (unsigned j = 0; j < 16; ++j) { const unsigned c = xb_ld(&bar[XB_XCNT(j)]); sum += c; cnt += (c > 0u) ? 1u : 0u; mine = (j == x) ? c : mine; }
        if (sum == G) break;
        __builtin_amdgcn_s_sleep(1);
        if ((++sp & 255u) == 0u) { if (xb_ld(&bar[XB_TMO])) break; if (sp > XB_SPIN_CAP) { atomicAdd(&bar[XB_TMO], 1u); break; } }
    }
    nloc = mine > 0u ? mine : 1u; nx = cnt > 0u ? cnt : 1u;
}
__device__ __forceinline__ void xcd_barrier(const XcdBarrier& b) {
    asm volatile("s_waitcnt vmcnt(0)" ::: "memory");
    __syncthreads();
    if (threadIdx.x == 0) {
        unsigned* bar = b.bar;
        __builtin_amdgcn_s_waitcnt(0);
        unsigned nloc = b.st[0], nx = b.st[1];
        if (nloc == 0u) { xcd_barrier_complete(bar, b.x, nloc, nx); b.st[0] = nloc; b.st[1] = nx; }
        const unsigned old = xb_add(&bar[XB_XSUB(b.x)], 1u);
        const unsigned gen = old / nloc;
        if (old + 1u == (gen + 1u) * nloc) {
            __builtin_amdgcn_fence(__ATOMIC_RELEASE, "agent");
            asm volatile("s_waitcnt vmcnt(0)" ::: "memory");
            const unsigned og = xb_add(&bar[XB_TOP], 1u);
            const unsigned tg = og / nx;
            if (og + 1u == (tg + 1u) * nx) xb_add(&bar[XB_TOPGEN], 1u);
            else XB_SPIN(xb_ld(&bar[XB_TOPGEN]) == tg, bar);
            __builtin_amdgcn_fence(__ATOMIC_ACQUIRE, "agent");
            xb_add(&bar[XB_XGEN(b.x)], 1u);
            asm volatile("s_waitcnt vmcnt(0)" ::: "memory");
        } else {
            XB_SPIN(xb_ld(&bar[XB_XGEN(b.x)]) == gen, bar);
            __builtin_amdgcn_fence(__ATOMIC_ACQUIRE, "agent");
            asm volatile("s_waitcnt vmcnt(0)" ::: "memory");
        }
    }
    __syncthreads();
}

typedef _Float16 h8 __attribute__((ext_vector_type(8)));
typedef _Float16 h4 __attribute__((ext_vector_type(4)));
typedef float f4 __attribute__((ext_vector_type(4)));

__device__ __forceinline__ float wave_sum(float v) {
#pragma unroll
    for (int o = 32; o > 0; o >>= 1) v += __shfl_xor(v, o);
    return v;
}
__device__ __forceinline__ float wave_max(float v) {
#pragma unroll
    for (int o = 32; o > 0; o >>= 1) v = fmaxf(v, __shfl_xor(v, o));
    return v;
}
__device__ __forceinline__ void wave_sync() {
    asm volatile("s_waitcnt lgkmcnt(0)" ::: "memory");
    __builtin_amdgcn_wave_barrier();
}
__device__ __forceinline__ float gelu_tanh(float x) {
    const float u = 0.7978845608028654f * (x + 0.044715f * x * x * x);
    return 0.5f * x * (1.f + tanhf(u));
}
__device__ __forceinline__ float sigmoidf_(float x) { return 1.f / (1.f + expf(-x)); }
__device__ __forceinline__ float swiglu_fast(float g, float l) { const float xg = fminf(g, 7.f), xl = fminf(fmaxf(l, -7.f), 7.f); return xg * __builtin_amdgcn_rcpf(1.f + __builtin_amdgcn_exp2f(-2.4554669595930156f * xg)) * (xl + 1.f); }

constexpr int G_LD = 40;
template <class AF, class EF>
__device__ __forceinline__ void gemm_tile(char* smem, int K, const AF& af, const float* __restrict__ Bm, int ldb, int n0, int Nlim, bool perm, const EF& ef) {
    _Float16* As = (_Float16*)smem;
    _Float16* Bs = As + 128 * G_LD;
    const int tid = threadIdx.x, lane = tid & 63, wid = tid >> 6, wr = wid >> 2, wc = wid & 3, fr = lane & 15, fq = lane >> 4;
    f4 acc[4][2];
#pragma unroll
    for (int m = 0; m < 4; ++m)
#pragma unroll
        for (int n = 0; n < 2; ++n) acc[m][n] = (f4){0.f, 0.f, 0.f, 0.f};
    const int ar = tid >> 3, ak = (tid & 7) * 4;
    const float* ap0 = af.row(ar);
    const float* ap1 = af.row(ar + 64);
    const int bk = tid >> 5, bn = (tid & 31) * 4;
    const bool bok = (n0 + bn) < Nlim;
    int bnp[4];
#pragma unroll
    for (int i = 0; i < 4; ++i) { const int c = bn + i; bnp[i] = perm ? ((c & ~31) | ((c & 1) << 4) | ((c & 31) >> 1)) : c; }
    for (int k0 = 0; k0 < K; k0 += 32) {
        const int ko = af.koff(k0 + ak);
        float4 a0 = make_float4(0.f, 0.f, 0.f, 0.f), a1 = a0, b0 = a0, b1 = a0;
        if (ap0) a0 = *(const float4*)(ap0 + ko);
        if (ap1) a1 = *(const float4*)(ap1 + ko);
        if (bok) { b0 = *(const float4*)(Bm + (size_t)(k0 + bk) * ldb + n0 + bn); b1 = *(const float4*)(Bm + (size_t)(k0 + bk + 16) * ldb + n0 + bn); }
        __syncthreads();
        *(h4*)&As[ar * G_LD + ak] = (h4){(_Float16)a0.x, (_Float16)a0.y, (_Float16)a0.z, (_Float16)a0.w};
        *(h4*)&As[(ar + 64) * G_LD + ak] = (h4){(_Float16)a1.x, (_Float16)a1.y, (_Float16)a1.z, (_Float16)a1.w};
        Bs[bnp[0] * G_LD + bk] = (_Float16)b0.x; Bs[bnp[1] * G_LD + bk] = (_Float16)b0.y; Bs[bnp[2] * G_LD + bk] = (_Float16)b0.z; Bs[bnp[3] * G_LD + bk] = (_Float16)b0.w;
        Bs[bnp[0] * G_LD + bk + 16] = (_Float16)b1.x; Bs[bnp[1] * G_LD + bk + 16] = (_Float16)b1.y; Bs[bnp[2] * G_LD + bk + 16] = (_Float16)b1.z; Bs[bnp[3] * G_LD + bk + 16] = (_Float16)b1.w;
        __syncthreads();
        h8 a[4], b[2];
#pragma unroll
        for (int m = 0; m < 4; ++m) a[m] = *(const h8*)&As[(wr * 64 + m * 16 + fr) * G_LD + fq * 8];
#pragma unroll
        for (int n = 0; n < 2; ++n) b[n] = *(const h8*)&Bs[(wc * 32 + n * 16 + fr) * G_LD + fq * 8];
#pragma unroll
        for (int m = 0; m < 4; ++m)
#pragma unroll
            for (int n = 0; n < 2; ++n) acc[m][n] = __builtin_amdgcn_mfma_f32_16x16x32_f16(a[m], b[n], acc[m][n], 0, 0, 0);
    }
    ef(acc, wr, wc, fr, fq);
    __syncthreads();
}

struct ARowPlain { const float* base; int ld; int m0; int mlim;
    __device__ __forceinline__ const float* row(int r) const { return (m0 + r) < mlim ? base + (size_t)(m0 + r) * ld : nullptr; }
    __device__ __forceinline__ int koff(int k) const { return k; } };
struct ARowCmp { const float* proj; int col; int m0;
    __device__ __forceinline__ const float* row(int r) const { const int g = m0 + r; if (g >= CROWS) return nullptr; const int kvh = g & 1, bc = g >> 1, b = bc / NC, c = bc % NC;
        return proj + (size_t)(b * S_ + 16 * c) * INW + col + kvh * 128; }
    __device__ __forceinline__ int koff(int k) const { return (k >> 7) * INW + (k & 127); } };
struct ARowList { const float* base; const int* list; int m0; int cnt; int shift;
    __device__ __forceinline__ const float* row(int r) const { if (m0 + r >= cnt) return nullptr; const int a = list[m0 + r]; return base + (size_t)(a >> shift) * 2048; }
    __device__ __forceinline__ int koff(int k) const { return k; } };

struct EpiStore { float* C; int ldc; int m0; int n0; int mlim; int nlim; _Float16* C16;
    __device__ __forceinline__ void operator()(const f4 (&acc)[4][2], int wr, int wc, int fr, int fq) const {
#pragma unroll
        for (int m = 0; m < 4; ++m)
#pragma unroll
            for (int n = 0; n < 2; ++n)
#pragma unroll
                for (int j = 0; j < 4; ++j) { const int r = m0 + wr * 64 + m * 16 + fq * 4 + j, c = n0 + wc * 32 + n * 16 + fr;
                    if (r < mlim && c < nlim) { C[(size_t)r * ldc + c] = acc[m][n][j]; if (C16) C16[(size_t)r * ldc + c] = (_Float16)acc[m][n][j]; } } } };
struct EpiPool { float* C; const float* scale; int m0; int g;
    __device__ __forceinline__ void operator()(const f4 (&acc)[4][2], int wr, int wc, int fr, int fq) const {
#pragma unroll
        for (int m = 0; m < 4; ++m)
#pragma unroll
            for (int n = 0; n < 2; ++n)
#pragma unroll
                for (int j = 0; j < 4; ++j) { const int r = m0 + wr * 64 + m * 16 + fq * 4 + j, c = g * 128 + wc * 32 + n * 16 + fr;
                    C[(size_t)r * 512 + c] = acc[m][n][j] * scale[c]; } } };
struct EpiHid { float* C; const float* bias; int m0; int n0;
    __device__ __forceinline__ void operator()(const f4 (&acc)[4][2], int wr, int wc, int fr, int fq) const {
#pragma unroll
        for (int m = 0; m < 4; ++m)
#pragma unroll
            for (int n = 0; n < 2; ++n)
#pragma unroll
                for (int j = 0; j < 4; ++j) { const int r = m0 + wr * 64 + m * 16 + fq * 4 + j, c = n0 + wc * 32 + n * 16 + fr;
                    if (r < CROWS) C[(size_t)r * 256 + c] = gelu_tanh(acc[m][n][j] + bias[c]); } } };
struct EpiOut { float* C; const float* x; int m0; int n0;
    __device__ __forceinline__ void operator()(const f4 (&acc)[4][2], int wr, int wc, int fr, int fq) const {
#pragma unroll
        for (int m = 0; m < 4; ++m)
#pragma unroll
            for (int n = 0; n < 2; ++n)
#pragma unroll
                for (int j = 0; j < 4; ++j) { const size_t o = (size_t)(m0 + wr * 64 + m * 16 + fq * 4 + j) * 2048 + n0 + wc * 32 + n * 16 + fr;
                    C[o] = DN_ALPHA * x[o] + acc[m][n][j]; } } };
struct EpiGu { float* act; const float* bgu; const int* list; int m0; int cnt; int n0;
    __device__ __forceinline__ void operator()(const f4 (&acc)[4][2], int wr, int wc, int fr, int fq) const {
        const int jc = (n0 + wc * 32) / 2 + fr;
        const float bg = bgu[2 * jc], bl = bgu[2 * jc + 1];
#pragma unroll
        for (int m = 0; m < 4; ++m)
#pragma unroll
            for (int j = 0; j < 4; ++j) { const int r = m0 + wr * 64 + m * 16 + fq * 4 + j;
                if (r < cnt) { const int a = list[r];
                    const float xg = fminf(acc[m][0][j] + bg, 7.f), xl = fminf(fmaxf(acc[m][1][j] + bl, -7.f), 7.f);
                    act[(size_t)a * 2048 + jc] = xg * sigmoidf_(1.702f * xg) * (xl + 1.f); } } } };
struct EpiDn { float* y; const float* bdn; const int* list; const float* gate; int m0; int cnt; int n0;
    __device__ __forceinline__ void operator()(const f4 (&acc)[4][2], int wr, int wc, int fr, int fq) const {
#pragma unroll
        for (int m = 0; m < 4; ++m)
#pragma unroll
            for (int j = 0; j < 4; ++j) { const int r = m0 + wr * 64 + m * 16 + fq * 4 + j;
                if (r < cnt) { const int a = list[r]; const float g = gate[a];
#pragma unroll
                    for (int n = 0; n < 2; ++n) { const int c = n0 + wc * 32 + n * 16 + fr; y[(size_t)a * 2048 + c] = (acc[m][n][j] + bdn[c]) * g; } } } } };

constexpr int WLDS_FLOATS = 4096 + 512 + 32;
template <bool SHARED>
__device__ __forceinline__ void wave_attn(float* sw, const float* __restrict__ qptr, const float* __restrict__ Kb, const float* __restrict__ Vb, int ld, int nseg, float scale, float* __restrict__ optr) {
    const int lane = threadIdx.x & 63;
    float* sq = sw + 4096; const int* segs = (const int*)(sw + 4096 + 512);
#pragma unroll
    for (int i = 0; i < 8; ++i) sq[lane + 64 * i] = qptr[lane + 64 * i];
    wave_sync();
    for (int sg = 0; sg < nseg; ++sg) {
        const int start = segs[sg], len = segs[16 + sg];
        float d0 = 0.f, d1 = 0.f, d2 = 0.f, d3 = 0.f;
        if (lane < len) {
            const float* kp = Kb + (size_t)(start + lane) * ld;
            for (int d4 = 0; d4 < 32; ++d4) {
                if (SHARED) {
                    const float4 kv = *(const float4*)(kp + d4 * 4);
                    const float4 q0 = *(const float4*)(sq + d4 * 4), q1 = *(const float4*)(sq + 128 + d4 * 4), q2 = *(const float4*)(sq + 256 + d4 * 4), q3 = *(const float4*)(sq + 384 + d4 * 4);
                    d0 += kv.x * q0.x + kv.y * q0.y + kv.z * q0.z + kv.w * q0.w;
                    d1 += kv.x * q1.x + kv.y * q1.y + kv.z * q1.z + kv.w * q1.w;
                    d2 += kv.x * q2.x + kv.y * q2.y + kv.z * q2.z + kv.w * q2.w;
                    d3 += kv.x * q3.x + kv.y * q3.y + kv.z * q3.z + kv.w * q3.w;
                } else {
                    const float4 k0 = *(const float4*)(kp + d4 * 4), k1 = *(const float4*)(kp + 128 + d4 * 4), k2 = *(const float4*)(kp + 256 + d4 * 4), k3 = *(const float4*)(kp + 384 + d4 * 4);
                    const float4 q0 = *(const float4*)(sq + d4 * 4), q1 = *(const float4*)(sq + 128 + d4 * 4), q2 = *(const float4*)(sq + 256 + d4 * 4), q3 = *(const float4*)(sq + 384 + d4 * 4);
                    d0 += k0.x * q0.x + k0.y * q0.y + k0.z * q0.z + k0.w * q0.w;
                    d1 += k1.x * q1.x + k1.y * q1.y + k1.z * q1.z + k1.w * q1.w;
                    d2 += k2.x * q2.x + k2.y * q2.y + k2.z * q2.z + k2.w * q2.w;
                    d3 += k3.x * q3.x + k3.y * q3.y + k3.z * q3.z + k3.w * q3.w;
                }
            }
        }
        const bool ok = lane < len;
        sw[sg * 64 + lane] = ok ? d0 * scale : -1e30f;
        sw[1024 + sg * 64 + lane] = ok ? d1 * scale : -1e30f;
        sw[2048 + sg * 64 + lane] = ok ? d2 * scale : -1e30f;
        sw[3072 + sg * 64 + lane] = ok ? d3 * scale : -1e30f;
    }
    wave_sync();
    const int n = nseg * 64;
#pragma unroll
    for (int g = 0; g < 4; ++g) {
        float mx = -1e30f;
        for (int i = lane; i < n; i += 64) mx = fmaxf(mx, sw[g * 1024 + i]);
        mx = wave_max(mx);
        float sm = 0.f;
        for (int i = lane; i < n; i += 64) { const float v = sw[g * 1024 + i]; sm += (v > -1e29f) ? expf(v - mx) : 0.f; }
        sm = wave_sum(sm);
        const float inv = sm > 0.f ? 1.f / sm : 0.f;
        for (int i = lane; i < n; i += 64) { const float v = sw[g * 1024 + i]; sw[g * 1024 + i] = (v > -1e29f) ? expf(v - mx) * inv : 0.f; }
    }
    wave_sync();
    float o[4][2];
#pragma unroll
    for (int g = 0; g < 4; ++g) { o[g][0] = 0.f; o[g][1] = 0.f; }
    for (int sg = 0; sg < nseg; ++sg) {
        const int start = segs[sg], len = segs[16 + sg];
        for (int l = 0; l < len; ++l) {
            const float* vp = Vb + (size_t)(start + l) * ld;
            if (SHARED) {
                const float v0 = vp[lane], v1 = vp[lane + 64];
#pragma unroll
                for (int g = 0; g < 4; ++g) { const float p = sw[g * 1024 + sg * 64 + l]; o[g][0] += p * v0; o[g][1] += p * v1; }
            } else {
#pragma unroll
                for (int g = 0; g < 4; ++g) { const float p = sw[g * 1024 + sg * 64 + l]; o[g][0] += p * vp[g * 128 + lane]; o[g][1] += p * vp[g * 128 + lane + 64]; }
            }
        }
    }
#pragma unroll
    for (int g = 0; g < 4; ++g) { optr[g * 128 + lane] = o[g][0]; optr[g * 128 + lane + 64] = o[g][1]; }
}

namespace g8 {
constexpr int BM = 256, BK = 64, HALF = 128, HTB = HALF * BK * 2, STAGE_BYTES = 8 * HTB;
constexpr int KK = 2048;
typedef float f32x4 __attribute__((ext_vector_type(4)));
__device__ __forceinline__ int lds_byte(int r, int c) { const int st = (r >> 4) * 2 + (c >> 5), rr = r & 15, cc = c & 31, ob = rr * 64 + cc * 2; return st * 1024 + (ob ^ (((ob >> 9) & 1) << 5)); }
__device__ __forceinline__ void stage_rc(int b, int& R, int& C) { const int st = b / 1024, sb = b % 1024, swz = sb ^ (((sb >> 9) & 1) << 5); R = (st >> 1) * 16 + swz / 64; C = (st & 1) * 32 + (swz % 64) / 2; }
__device__ __forceinline__ int perm32(int rho) { const int n = rho >> 4, i = rho & 15; return 8 * (i >> 2) + 4 * n + (i & 3); }

typedef int i32x4 __attribute__((ext_vector_type(4)));
template <bool I8> struct AccSel { typedef f32x4 T; };
template <> struct AccSel<true> { typedef i32x4 T; };
__device__ __forceinline__ f32x4 mma16(i32x4 a, i32x4 b, f32x4 c) { return __builtin_amdgcn_mfma_f32_16x16x32_f16(*reinterpret_cast<h8*>(&a), *reinterpret_cast<h8*>(&b), c, 0, 0, 0); }
__device__ __forceinline__ i32x4 mma16(i32x4 a, i32x4 b, i32x4 c) { return __builtin_amdgcn_mfma_i32_16x16x64_i8(a, b, c, 0, 0, 0); }
struct Unit { int m0, n0, e, cnt, rbase; };
constexpr int EP_OFF = STAGE_BYTES + 512, EP_LD = 528, EP_GRP = 16 * EP_LD;
__device__ __forceinline__ void ep_sync() { asm volatile("s_waitcnt lgkmcnt(0)" ::: "memory"); __builtin_amdgcn_s_barrier(); asm volatile("" ::: "memory"); }
__device__ __forceinline__ int ep_tid() { int tz = threadIdx.x; asm volatile("" : "+v"(tz)); return tz; }
__device__ __forceinline__ h8 cvt8(f32x4 a, f32x4 b) { h8 o; o[0] = (_Float16)a[0]; o[1] = (_Float16)a[1]; o[2] = (_Float16)a[2]; o[3] = (_Float16)a[3]; o[4] = (_Float16)b[0]; o[5] = (_Float16)b[1]; o[6] = (_Float16)b[2]; o[7] = (_Float16)b[3]; return o; }

__device__ __forceinline__ void tile_order(int L, int nM, int nN, int& pm, int& pn) {
    const int nwg = nM * nN; int wgid = L;
    { const int q = nwg / 8, r = nwg % 8, xcd = wgid % 8, off = wgid / 8; wgid = (xcd < r ? xcd * (q + 1) : r * (q + 1) + (xcd - r) * q) + off; }
    const int nig = 8 * nN, gid = wgid / nig, fm = gid * 8, gsz = (nM - fm) < 8 ? (nM - fm) : 8;
    pm = fm + ((wgid % nig) % gsz); pn = (wgid % nig) / gsz;
}

template <class Prob>
__device__ __forceinline__ void gemm_phase(LAS unsigned char* lds, const Prob& P) {
    const int tid = threadIdx.x, wid = __builtin_amdgcn_readfirstlane(tid >> 6), lane = tid & 63, wr = wid >> 2, wc = wid & 3, fr = lane & 15, fq = lane >> 4;
    constexpr int nt = Prob::NT; constexpr size_t KS2 = Prob::KS2; constexpr unsigned ROWB = Prob::ROWB; constexpr bool I8 = Prob::I8;
    int sR[2], sC2[2]; unsigned voffB[2];
#pragma unroll
    for (int i = 0; i < 2; ++i) { int R, C; stage_rc(tid * 16 + i * 8192, R, C); sR[i] = R; sC2[i] = C * 2; const int Rb = Prob::PERM ? ((R & ~31) + perm32(R & 31)) : R; voffB[i] = (unsigned)Rb * ROWB + (unsigned)C * 2u; }
    const size_t kstep = (size_t)(BK * 2);
    const size_t hstep = (size_t)HALF * ROWB;
    const unsigned ldsw = (unsigned)wid * 1024u;
    const int aoff = lds_byte(wr * 64 + fr, fq * 8), boff = lds_byte(wc * 32 + fr, fq * 8);
#define G8_SA(b, h) (((b) * 2 + (h)) * HTB)
#define G8_SB(b, h) ((4 + (b) * 2 + (h)) * HTB)
#define G8_STAGE(bufoff, gbase, voff) do { _Pragma("unroll") for (int _i = 0; _i < 2; ++_i) \
        __builtin_amdgcn_global_load_lds((const unsigned*)((const char*)(gbase) + (voff)[_i]), (LAS unsigned*)(lds + (bufoff) + ldsw + _i * 8192), 16, 0, 0); } while (0)
#define G8_LDA(dst, b, h) do { _Pragma("unroll") for (int m = 0; m < 4; ++m) _Pragma("unroll") for (int k = 0; k < 2; ++k) dst[m][k] = *(const LAS i32x4*)(lds + G8_SA(b, h) + aoff + m * 2048 + k * 1024); } while (0)
#define G8_LDB(dst, b, h) do { _Pragma("unroll") for (int n = 0; n < 2; ++n) _Pragma("unroll") for (int k = 0; k < 2; ++k) dst[n][k] = *(const LAS i32x4*)(lds + G8_SB(b, h) + boff + n * 2048 + k * 1024); } while (0)
#define G8_MMA(ai, bj, At, Bt) do { __builtin_amdgcn_s_setprio(1); _Pragma("unroll") for (int m = 0; m < 4; ++m) _Pragma("unroll") for (int n = 0; n < 2; ++n) _Pragma("unroll") for (int k = 0; k < 2; ++k) \
        acc[ai][bj][m][n] = mma16(Bt[n][k], At[m][k], acc[ai][bj][m][n]); __builtin_amdgcn_s_setprio(0); } while (0)
#define G8_WAIT_V(n) asm volatile("s_waitcnt vmcnt(" #n ")" ::: "memory")
#define G8_WAIT_L(n) asm volatile("s_waitcnt lgkmcnt(" #n ")" ::: "memory")
#define G8_BAR __builtin_amdgcn_s_barrier()
#define G8_SCHED __builtin_amdgcn_sched_barrier(0)
    Unit cur, nxt; int ui = 0;
    if (!P.next(0, cur)) return;
    typedef typename AccSel<I8>::T AccT;
    AccT acc[2][2][4][2];
#pragma unroll
    for (int a = 0; a < 2; ++a)
#pragma unroll
        for (int b = 0; b < 2; ++b)
#pragma unroll
            for (int m = 0; m < 4; ++m)
#pragma unroll
                for (int n = 0; n < 2; ++n) acc[a][b][m][n] = AccT{};
    i32x4 At[4][2], B0[2][2], B1[2][2];
    unsigned vc[2][2], vn[2][2];
    P.a_offs(cur, sR, sC2, vc);
    const char* const Ab = P.a_base();
    const char* cB = P.b_base(cur);
    G8_STAGE(G8_SB(0, 0), cB, voffB); G8_STAGE(G8_SA(0, 0), Ab, vc[0]); G8_STAGE(G8_SB(0, 1), cB + hstep, voffB); G8_STAGE(G8_SA(0, 1), Ab, vc[1]);
    if (wr == 1) G8_BAR;
    G8_WAIT_V(4); G8_BAR;
    G8_STAGE(G8_SB(1, 0), cB + kstep, voffB); G8_STAGE(G8_SA(1, 0), Ab + kstep, vc[0]); G8_STAGE(G8_SB(1, 1), cB + hstep + kstep, voffB);
    G8_WAIT_V(6); G8_BAR;
    for (;;) {
        const bool has_next = P.next(ui + 1, nxt);
        const char* nB = cB;
        if (has_next) { P.a_offs(nxt, sR, sC2, vn); nB = P.b_base(nxt); }
        else { vn[0][0] = vc[0][0]; vn[0][1] = vc[0][1]; vn[1][0] = vc[1][0]; vn[1][1] = vc[1][1]; }
        for (int t = 0; t < nt; t += 2) {
            const bool last = (t == nt - 2);
            const char* a1 = Ab + (size_t)(t >> 1) * KS2 + kstep;
            const char* a2 = last ? Ab : Ab + (size_t)((t + 2) >> 1) * KS2; const char* b2 = last ? nB : cB + (size_t)(t + 2) * kstep;
            const char* a3 = a2 + kstep; const char* b3 = b2 + kstep;
            unsigned o2[2][2];
            o2[0][0] = last ? vn[0][0] : vc[0][0]; o2[0][1] = last ? vn[0][1] : vc[0][1]; o2[1][0] = last ? vn[1][0] : vc[1][0]; o2[1][1] = last ? vn[1][1] : vc[1][1];
            G8_LDB(B0, 0, 0); G8_SCHED; G8_LDA(At, 0, 0); G8_STAGE(G8_SA(1, 1), a1, vc[1]);
            G8_WAIT_L(8); G8_BAR; G8_WAIT_L(0); G8_MMA(0, 0, At, B0); G8_BAR; G8_SCHED;
            G8_LDB(B1, 0, 1); G8_STAGE(G8_SB(0, 0), b2, voffB);
            G8_BAR; G8_WAIT_L(0); G8_MMA(0, 1, At, B1); G8_BAR;
            G8_LDA(At, 0, 1); G8_STAGE(G8_SA(0, 0), a2, o2[0]);
            G8_BAR; G8_WAIT_L(0); G8_MMA(1, 0, At, B0); G8_BAR; G8_SCHED;
            G8_STAGE(G8_SB(0, 1), b2 + hstep, voffB);
            G8_WAIT_V(6); G8_BAR; G8_MMA(1, 1, At, B1); G8_BAR;
            G8_LDB(B0, 1, 0); G8_SCHED; G8_LDA(At, 1, 0); G8_STAGE(G8_SA(0, 1), a2, o2[1]);
            G8_WAIT_L(8); G8_BAR; G8_WAIT_L(0); G8_MMA(0, 0, At, B0); G8_BAR; G8_SCHED;
            G8_LDB(B1, 1, 1); G8_STAGE(G8_SB(1, 0), b3, voffB);
            G8_BAR; G8_WAIT_L(0); G8_MMA(0, 1, At, B1); G8_BAR;
            G8_LDA(At, 1, 1); G8_STAGE(G8_SA(1, 0), a3, o2[0]);
            G8_BAR; G8_WAIT_L(0); G8_MMA(1, 0, At, B0); G8_BAR; G8_SCHED;
            G8_STAGE(G8_SB(1, 1), b3 + hstep, voffB);
            G8_WAIT_V(6); G8_BAR; G8_MMA(1, 1, At, B1); G8_BAR;
        }
        P.epi(acc, cur, wr, wc, fr, fq, lds);
        if (!has_next) break;
#pragma unroll
        for (int a = 0; a < 2; ++a)
#pragma unroll
            for (int b = 0; b < 2; ++b)
#pragma unroll
                for (int m = 0; m < 4; ++m)
#pragma unroll
                    for (int n = 0; n < 2; ++n) acc[a][b][m][n] = AccT{};
        cur = nxt; cB = nB; ++ui;
        vc[0][0] = vn[0][0]; vc[0][1] = vn[0][1]; vc[1][0] = vn[1][0]; vc[1][1] = vn[1][1];
    }
    G8_WAIT_V(0);
    if (wr == 0) G8_BAR;
    G8_BAR;
#undef G8_SA
#undef G8_SB
#undef G8_STAGE
#undef G8_LDA
#undef G8_LDB
#undef G8_MMA
#undef G8_WAIT_V
#undef G8_WAIT_L
#undef G8_BAR
#undef G8_SCHED
}

struct ProbIn {
    static constexpr unsigned ROWB = 4096; static constexpr bool I8 = false;
    static constexpr int NT = 32; static constexpr size_t KS2 = 256;
    static constexpr bool PERM = true;
    const _Float16* A; _Float16* C16; int G, c;
    __device__ __forceinline__ bool next(int i, Unit& u) const { const int L = i * G + c; if (L >= 64 * 15 + 32) return false;
        if (L < 64 * 15) { int pm, pn; tile_order(L, 64, 15, pm, pn); u.m0 = pm * 256; u.n0 = pn * 256; u.e = 0; }
        else { const int v = L - 64 * 15; u.m0 = T_ + (v & 7) * 256; u.n0 = (v >> 3) * 256; u.e = 1; }
        u.cnt = 256; u.rbase = 0; return true; }
    __device__ __forceinline__ void a_offs(const Unit& u, const int (&R)[2], const int (&C2)[2], unsigned (&v)[2][2]) const {
#pragma unroll
        for (int h = 0; h < 2; ++h)
#pragma unroll
            for (int i = 0; i < 2; ++i) v[h][i] = (unsigned)(u.m0 + h * 128 + R[i]) * (unsigned)(KK * 2) + (unsigned)C2[i]; }
    __device__ __forceinline__ const char* a_base() const { return (const char*)A; }
    __device__ __forceinline__ const char* b_base(const Unit& u) const { return (const char*)A + (u.e ? (long long)(WS_WTMKV - WS_X16) : (long long)(WS_WTIN - WS_X16)) + (size_t)u.n0 * KK * 2; }
    __device__ __forceinline__ void epi(const f32x4 (&acc)[2][2][4][2], const Unit& u, int wr, int wc, int fr, int fq, LAS unsigned char* lds) const {
        LAS unsigned char* ep = lds + EP_OFF + wr * EP_GRP;
        const int tg = ep_tid() & 255, rrow = tg >> 4, ch = tg & 15;
        _Float16* const Cb = (_Float16*)((char*)C16 + (u.e ? (long long)(WS_KVMEM16 - WS_PROJ16) : 0ll)); const int ldc = u.e ? 1024 : INW, nlim = u.e ? 1024 : INW, mb = u.e ? u.m0 - T_ : u.m0;
#pragma unroll
        for (int ai = 0; ai < 2; ++ai)
#pragma unroll
            for (int m = 0; m < 4; ++m) {
#pragma unroll
                for (int bj = 0; bj < 2; ++bj) *(LAS h8*)(ep + fr * EP_LD + (bj * 128 + wc * 32 + fq * 8) * 2) = cvt8(acc[ai][bj][m][0], acc[ai][bj][m][1]);
                ep_sync();
                const h8 x0 = *(const LAS h8*)(ep + rrow * EP_LD + ch * 32), x1 = *(const LAS h8*)(ep + rrow * EP_LD + ch * 32 + 16);
                const int grow = mb + ai * 128 + wr * 64 + m * 16 + rrow, gcol = u.n0 + ch * 16;
                if (gcol < nlim) *(h8*)(Cb + (size_t)grow * ldc + gcol) = x0;
                if (gcol + 8 < nlim) *(h8*)(Cb + (size_t)grow * ldc + gcol + 8) = x1;
                ep_sync();
            } }
};
struct ProbOut {
    static constexpr unsigned ROWB = 4096; static constexpr bool I8 = false;
    static constexpr int NT = 32; static constexpr size_t KS2 = 256;
    static constexpr bool PERM = true;
    const _Float16* A; const _Float16* Bt; _Float16* C; const _Float16* X; int G, c;
    __device__ __forceinline__ bool next(int i, Unit& u) const { const int L = i * G + c; if (L >= 64 * 8) return false; int pm, pn; tile_order(L, 64, 8, pm, pn); u.m0 = pm * 256; u.n0 = pn * 256; u.e = 0; u.cnt = 256; u.rbase = 0; return true; }
    __device__ __forceinline__ void a_offs(const Unit& u, const int (&R)[2], const int (&C2)[2], unsigned (&v)[2][2]) const {
#pragma unroll
        for (int h = 0; h < 2; ++h)
#pragma unroll
            for (int i = 0; i < 2; ++i) v[h][i] = (unsigned)(u.m0 + h * 128 + R[i]) * (unsigned)(KK * 2) + (unsigned)C2[i]; }
    __device__ __forceinline__ const char* a_base() const { return (const char*)A; }
    __device__ __forceinline__ const char* b_base(const Unit& u) const { return (const char*)(Bt + (size_t)u.n0 * KK); }
    __device__ __forceinline__ void epi(const f32x4 (&acc)[2][2][4][2], const Unit& u, int wr, int wc, int fr, int fq, LAS unsigned char* lds) const {
        LAS unsigned char* ep = lds + EP_OFF + wr * EP_GRP;
        const int tg = ep_tid() & 255, rrow = tg >> 4, ch = tg & 15;
#pragma unroll
        for (int ai = 0; ai < 2; ++ai)
#pragma unroll
            for (int m = 0; m < 4; ++m) {
#pragma unroll
                for (int bj = 0; bj < 2; ++bj) *(LAS h8*)(ep + fr * EP_LD + (bj * 128 + wc * 32 + fq * 8) * 2) = cvt8(acc[ai][bj][m][0], acc[ai][bj][m][1]);
                const size_t go = (size_t)(u.m0 + ai * 128 + wr * 64 + m * 16 + rrow) * 2048 + u.n0 + ch * 16;
                const h8 r0 = *(const h8*)(X + go), r1 = *(const h8*)(X + go + 8);
                ep_sync();
                const h8 x0 = *(const LAS h8*)(ep + rrow * EP_LD + ch * 32), x1 = *(const LAS h8*)(ep + rrow * EP_LD + ch * 32 + 16);
                h8 o0, o1;
#pragma unroll
                for (int q = 0; q < 8; ++q) { o0[q] = (_Float16)(DN_ALPHA * (float)r0[q] + (float)x0[q]); o1[q] = (_Float16)(DN_ALPHA * (float)r1[q] + (float)x1[q]); }
                *(h8*)(C + go) = o0; *(h8*)(C + go + 8) = o1;
                ep_sync();
            } }
};
struct ProbCmp {
    static constexpr unsigned ROWB = 4096; static constexpr bool I8 = false;
    static constexpr int NT = 8; static constexpr size_t KS2 = (size_t)INW * 2;
    static constexpr bool PERM = false;
    const _Float16* A; const _Float16* Bt; float* C; int G, c;
    __device__ __forceinline__ bool next(int i, Unit& u) const { const int L = i * G + c; if (L >= 128) return false;
        u.e = L >> 6; const int r = L & 63; u.rbase = r & 3; u.n0 = ((r >> 2) & 1) * 256; u.m0 = (r >> 3) * 256; u.cnt = 256; return true; }
    __device__ __forceinline__ void a_offs(const Unit& u, const int (&R)[2], const int (&C2)[2], unsigned (&v)[2][2]) const {
#pragma unroll
        for (int h = 0; h < 2; ++h)
#pragma unroll
            for (int i = 0; i < 2; ++i) { const int row = u.m0 + h * 128 + R[i], kvh = row & 1, bj = row >> 1, b = bj >> 7, j = bj & 127;
                v[h][i] = (unsigned)((b * S_ + 16 * j + 4 * u.rbase) * INW + (u.e ? C_VC : C_KC) + kvh * 128) * 2u + (unsigned)C2[i]; } }
    __device__ __forceinline__ const char* a_base() const { return (const char*)A; }
    __device__ __forceinline__ const char* b_base(const Unit& u) const { return (const char*)(Bt + ((size_t)u.e * 512 + u.n0) * KK + u.rbase * 512); }
    __device__ __forceinline__ void epi(const f32x4 (&acc)[2][2][4][2], const Unit& u, int wr, int wc, int fr, int fq, LAS unsigned char*) const {
        float* base = C + ((size_t)(u.e * 4 + u.rbase) * 2048) * 512;
#pragma unroll
        for (int ai = 0; ai < 2; ++ai)
#pragma unroll
            for (int m = 0; m < 4; ++m) { const int row = u.m0 + ai * 128 + wr * 64 + m * 16 + fr;
#pragma unroll
                for (int bj = 0; bj < 2; ++bj)
#pragma unroll
                    for (int n = 0; n < 2; ++n) { const int col = u.n0 + bj * 128 + wc * 32 + n * 16 + fq * 4;
                        *(f32x4*)(base + (size_t)row * 512 + col) = acc[ai][bj][m][n]; } } }
};
struct MoeTab { const LAS int* t; int NT;
    __device__ __forceinline__ bool find(int L, Unit& u) const {
        const int total = __builtin_amdgcn_readfirstlane(t[98]); if (L >= total) return false;
        int e = 0;
        for (; e < NE - 1; ++e) { if (L < __builtin_amdgcn_readfirstlane(t[32 + e + 1])) break; }
        const int ub = __builtin_amdgcn_readfirstlane(t[32 + e]), cn = __builtin_amdgcn_readfirstlane(t[e]), rs = __builtin_amdgcn_readfirstlane(t[65 + e]);
        const int nm = (cn + 255) >> 8, v = L - ub, mt = v % nm, ntile = v / nm;
        u.e = e; u.m0 = mt * 256; u.n0 = ntile * 256; u.cnt = min(256, cn - mt * 256); u.rbase = rs; return true; } };
struct ProbGu {
    static constexpr int NT = 16; static constexpr size_t KS2 = 256; static constexpr unsigned ROWB = 2048; static constexpr bool I8 = true;
    static constexpr bool PERM = true;
    const signed char* A; const signed char* Bt; _Float16* act; const float* bgu; const int* list; const float* sa; const float* sw; MoeTab tab; int G, vcu;
    __device__ __forceinline__ bool next(int i, Unit& u) const { return tab.find(i * G + vcu, u); }
    __device__ __forceinline__ void a_offs(const Unit& u, const int (&R)[2], const int (&C2)[2], unsigned (&v)[2][2]) const {
#pragma unroll
        for (int h = 0; h < 2; ++h)
#pragma unroll
            for (int i = 0; i < 2; ++i) { int r = h * 128 + R[i]; r = r < u.cnt ? r : 0; const int a = list[(size_t)u.e * T_ + u.m0 + r]; v[h][i] = (unsigned)(a >> 2) * 2048u + (unsigned)C2[i]; } }
    __device__ __forceinline__ const char* a_base() const { return (const char*)A; }
    __device__ __forceinline__ const char* b_base(const Unit& u) const { return (const char*)(Bt + ((size_t)u.e * 4096 + u.n0) * 2048); }
    __device__ __forceinline__ void epi(const i32x4 (&acc)[2][2][4][2], const Unit& u, int wr, int wc, int fr, int fq, LAS unsigned char* lds) const {
        const float* bb = bgu + (size_t)u.e * 4096; const float* ss = sw + (size_t)u.e * 4096;
        LAS unsigned char* ep = lds + EP_OFF + wr * EP_GRP;
        const int tg = ep_tid() & 255, rrow = tg >> 4, ch = tg & 15;
        f32x4 b0[2], b1[2], s0[2], s1[2];
#pragma unroll
        for (int bj = 0; bj < 2; ++bj) { const int col = u.n0 + bj * 128 + wc * 32 + fq * 8;
            b0[bj] = *(const f32x4*)(bb + col); b1[bj] = *(const f32x4*)(bb + col + 4); s0[bj] = *(const f32x4*)(ss + col); s1[bj] = *(const f32x4*)(ss + col + 4); }
        float srv[8];
        { int av[8];
#pragma unroll
          for (int q = 0; q < 8; ++q) { const int rl = (q >> 2) * 128 + wr * 64 + (q & 3) * 16 + fr; av[q] = list[(size_t)u.e * T_ + u.m0 + (rl < u.cnt ? rl : 0)]; }
#pragma unroll
          for (int q = 0; q < 8; ++q) srv[q] = sa[av[q] >> 2]; }
#pragma unroll
        for (int ai = 0; ai < 2; ++ai)
#pragma unroll
            for (int m = 0; m < 4; ++m) { const float sr = srv[ai * 4 + m];
#pragma unroll
                for (int bj = 0; bj < 2; ++bj) {
                    const i32x4 i0 = acc[ai][bj][m][0], i1 = acc[ai][bj][m][1];
                    const f32x4 v0 = (f32x4){(float)i0[0], (float)i0[1], (float)i0[2], (float)i0[3]} * (s0[bj] * sr) + b0[bj], v1 = (f32x4){(float)i1[0], (float)i1[1], (float)i1[2], (float)i1[3]} * (s1[bj] * sr) + b1[bj];
                    h4 o;
                    o[0] = (_Float16)swiglu_fast(v0[0], v0[1]);
                    o[1] = (_Float16)swiglu_fast(v0[2], v0[3]);
                    o[2] = (_Float16)swiglu_fast(v1[0], v1[1]);
                    o[3] = (_Float16)swiglu_fast(v1[2], v1[3]);
                    *(LAS h4*)(ep + fr * EP_LD + (bj * 64 + wc * 16 + fq * 4) * 2) = o; }
                ep_sync();
                const h8 x0 = *(const LAS h8*)(ep + rrow * EP_LD + ch * 16);
                const int rr = ai * 128 + wr * 64 + m * 16 + rrow;
                if (rr < u.cnt) *(h8*)(act + (size_t)(u.rbase + u.m0 + rr) * 2048 + (u.n0 >> 1) + ch * 8) = x0;
                ep_sync();
            } }
};
struct ProbDn {
    static constexpr int NT = 16; static constexpr size_t KS2 = 256; static constexpr unsigned ROWB = 2048; static constexpr bool I8 = true;
    static constexpr bool PERM = true;
    const signed char* A; const signed char* Bt; _Float16* y; const float* bdn; const int* list; const float* gate; const float* sa; const float* sw; MoeTab tab; int G, vcu;
    __device__ __forceinline__ bool next(int i, Unit& u) const { return tab.find(i * G + vcu, u); }
    __device__ __forceinline__ void a_offs(const Unit& u, const int (&R)[2], const int (&C2)[2], unsigned (&v)[2][2]) const {
#pragma unroll
        for (int h = 0; h < 2; ++h)
#pragma unroll
            for (int i = 0; i < 2; ++i) v[h][i] = (unsigned)(u.rbase + u.m0 + h * 128 + R[i]) * 2048u + (unsigned)C2[i]; }
    __device__ __forceinline__ const char* a_base() const { return (const char*)A; }
    __device__ __forceinline__ const char* b_base(const Unit& u) const { return (const char*)(Bt + ((size_t)u.e * 2048 + u.n0) * 2048); }
    __device__ __forceinline__ void epi(const i32x4 (&acc)[2][2][4][2], const Unit& u, int wr, int wc, int fr, int fq, LAS unsigned char* lds) const {
        const float* bb = bdn + (size_t)u.e * 2048; const float* ss = sw + (size_t)u.e * 2048;
        LAS unsigned char* ep = lds + EP_OFF + wr * EP_GRP;
        const int tg = ep_tid() & 255, rrow = tg >> 4, ch = tg & 15;
        f32x4 b0[2], b1[2], s0[2], s1[2];
#pragma unroll
        for (int bj = 0; bj < 2; ++bj) { const int col = u.n0 + bj * 128 + wc * 32 + fq * 8;
            b0[bj] = *(const f32x4*)(bb + col); b1[bj] = *(const f32x4*)(bb + col + 4); s0[bj] = *(const f32x4*)(ss + col); s1[bj] = *(const f32x4*)(ss + col + 4); }
        float gv[8], srv[8]; int a2v[8];
        { int av[8];
#pragma unroll
          for (int q = 0; q < 8; ++q) { const int rl = (q >> 2) * 128 + wr * 64 + (q & 3) * 16 + fr, rc = rl < u.cnt ? rl : 0; av[q] = list[(size_t)u.e * T_ + u.m0 + rc]; srv[q] = sa[u.rbase + u.m0 + rc];
              const int rr = (q >> 2) * 128 + wr * 64 + (q & 3) * 16 + rrow; a2v[q] = list[(size_t)u.e * T_ + u.m0 + (rr < u.cnt ? rr : 0)]; }
#pragma unroll
          for (int q = 0; q < 8; ++q) gv[q] = gate[av[q]]; }
#pragma unroll
        for (int ai = 0; ai < 2; ++ai)
#pragma unroll
            for (int m = 0; m < 4; ++m) { const float g = gv[ai * 4 + m], sr = srv[ai * 4 + m];
#pragma unroll
                for (int bj = 0; bj < 2; ++bj) {
                    const i32x4 i0 = acc[ai][bj][m][0], i1 = acc[ai][bj][m][1];
                    const f32x4 v0 = ((f32x4){(float)i0[0], (float)i0[1], (float)i0[2], (float)i0[3]} * (s0[bj] * sr) + b0[bj]) * g, v1 = ((f32x4){(float)i1[0], (float)i1[1], (float)i1[2], (float)i1[3]} * (s1[bj] * sr) + b1[bj]) * g;
                    *(LAS h8*)(ep + fr * EP_LD + (bj * 128 + wc * 32 + fq * 8) * 2) = cvt8(v0, v1); }
                const int rr = ai * 128 + wr * 64 + m * 16 + rrow;
                const int a2 = a2v[ai * 4 + m];
                ep_sync();
                const h8 x0 = *(const LAS h8*)(ep + rrow * EP_LD + ch * 32), x1 = *(const LAS h8*)(ep + rrow * EP_LD + ch * 32 + 16);
                if (rr < u.cnt) { *(h8*)(y + (size_t)a2 * 2048 + u.n0 + ch * 16) = x0; *(h8*)(y + (size_t)a2 * 2048 + u.n0 + ch * 16 + 8) = x1; }
                ep_sync();
            } }
};
}

namespace at8 {
typedef float f32x16 __attribute__((ext_vector_type(16)));
typedef short s16x4 __attribute__((ext_vector_type(4)));
typedef unsigned u32x4 __attribute__((ext_vector_type(4)));
constexpr int SHM_V = 64 * 128 * 2, SHM_K = 64 * 128 * 2;
constexpr int LDS_WS = 2 * SHM_V + 2 * SHM_K;
constexpr int LDS_END = LDS_WS + 8 * 64 * 4;
constexpr float CEXP = ATT_SCALE * 1.4426950408889634f;
constexpr float THR_RAW = 8.f / ATT_SCALE;
#define AT_KSWZ(row, colB) ((row) * 256 + ((colB) ^ (((row) & 7) << 4)))
#define AT_SBAR() __builtin_amdgcn_sched_barrier(0)
__device__ __forceinline__ int crow(int r, int hi) { return (r & 3) + 8 * (r >> 2) + 4 * hi; }
__device__ __forceinline__ unsigned cvtpk(float lo, float hi) { auto v = __builtin_amdgcn_cvt_pkrtz(lo, hi); return *reinterpret_cast<unsigned*>(&v); }
__device__ __forceinline__ int v_st(int k, int c) { const int kk = (k & ~0xC) | ((k & 4) << 1) | ((k & 8) >> 1); return ((kk >> 3) * 4 + (c >> 5)) * 512 + ((kk & 7) * 32 + (c & 31)) * 2; }
__device__ __forceinline__ int v_rd_base(int lane) { return ((lane & 3) << 3) | (((lane >> 2) & 3) << 6) | (((lane >> 4) & 1) << 5) | (((lane >> 5) & 1) << 8); }
constexpr int v_rd_off(int d0, int ks, int half) { return d0 * 512 + ks * 4096 + half * 2048; }
template <int OFF> __device__ __forceinline__ s16x4 tr_read(int vb) { s16x4 r; asm volatile("ds_read_b64_tr_b16 %0, %1 offset:%2" : "=&v"(r) : "v"(vb), "i"(OFF) : "memory"); return r; }
__device__ __forceinline__ h8 mk8(s16x4 l, s16x4 h) { typedef short s16x8 __attribute__((ext_vector_type(8))); s16x8 w = {l[0], l[1], l[2], l[3], h[0], h[1], h[2], h[3]}; return *reinterpret_cast<h8*>(&w); }
template <int D0> __device__ __forceinline__ void pv_one(f32x16& od, int vb, h8 pa0, h8 pa1, h8 pa2, h8 pa3) {
    const s16x4 l0 = tr_read<v_rd_off(D0, 0, 0)>(vb), h0 = tr_read<v_rd_off(D0, 0, 1)>(vb), l1 = tr_read<v_rd_off(D0, 1, 0)>(vb), h1 = tr_read<v_rd_off(D0, 1, 1)>(vb);
    const s16x4 l2 = tr_read<v_rd_off(D0, 2, 0)>(vb), h2 = tr_read<v_rd_off(D0, 2, 1)>(vb), l3 = tr_read<v_rd_off(D0, 3, 0)>(vb), h3 = tr_read<v_rd_off(D0, 3, 1)>(vb);
    asm volatile("s_waitcnt lgkmcnt(0)" ::: "memory"); AT_SBAR();
    od = __builtin_amdgcn_mfma_f32_32x32x16_f16(pa0, mk8(l0, h0), od, 0, 0, 0);
    od = __builtin_amdgcn_mfma_f32_32x32x16_f16(pa1, mk8(l1, h1), od, 0, 0, 0);
    od = __builtin_amdgcn_mfma_f32_32x32x16_f16(pa2, mk8(l2, h2), od, 0, 0, 0);
    od = __builtin_amdgcn_mfma_f32_32x32x16_f16(pa3, mk8(l3, h3), od, 0, 0, 0);
}
__device__ __forceinline__ void pv_d0(f32x16 (&o)[4], int vb, h8 pa0, h8 pa1, h8 pa2, h8 pa3) {
    pv_one<0>(o[0], vb, pa0, pa1, pa2, pa3); pv_one<1>(o[1], vb, pa0, pa1, pa2, pa3); pv_one<2>(o[2], vb, pa0, pa1, pa2, pa3); pv_one<3>(o[3], vb, pa0, pa1, pa2, pa3);
}
__device__ __forceinline__ void qkt(f32x16& p0, f32x16& p1, const char* Ks, const h8 (&qr)[8], int r32, int hi) {
    p0 = f32x16{}; p1 = f32x16{};
#pragma unroll
    for (int d0 = 0; d0 < 8; ++d0) { const int cb = (d0 * 16 + hi * 8) * 2;
        const h8 b0 = *reinterpret_cast<const h8*>(Ks + AT_KSWZ(r32, cb));
        const h8 b1 = *reinterpret_cast<const h8*>(Ks + AT_KSWZ(32 + r32, cb));
        p0 = __builtin_amdgcn_mfma_f32_32x32x16_f16(b0, qr[d0], p0, 0, 0, 0);
        p1 = __builtin_amdgcn_mfma_f32_32x32x16_f16(b1, qr[d0], p1, 0, 0, 0); }
}
__device__ __forceinline__ void pack_p(const f32x16& p0, const f32x16& p1, h8& pa0, h8& pa1, h8& pa2, h8& pa3) {
#define AT_PK4(P, BASE, OUT) do { unsigned a0 = cvtpk(P[BASE + 0], P[BASE + 1]), a1 = cvtpk(P[BASE + 2], P[BASE + 3]); \
    unsigned b0 = cvtpk(P[BASE + 4], P[BASE + 5]), b1 = cvtpk(P[BASE + 6], P[BASE + 7]); \
    auto r0 = __builtin_amdgcn_permlane32_swap(a0, b0, false, false); auto r1 = __builtin_amdgcn_permlane32_swap(a1, b1, false, false); \
    u32x4 w = {r0[0], r1[0], r0[1], r1[1]}; OUT = *reinterpret_cast<h8*>(&w); } while (0)
    AT_PK4(p0, 0, pa0); AT_PK4(p0, 8, pa1); AT_PK4(p1, 0, pa2); AT_PK4(p1, 8, pa3);
#undef AT_PK4
}
__device__ __forceinline__ float half_swap_max(float v) { auto rr = __builtin_amdgcn_permlane32_swap(__float_as_uint(v), __float_as_uint(v), false, false); return fmaxf(__uint_as_float(rr[0]), __uint_as_float(rr[1])); }
__device__ __forceinline__ float half_swap_sum(float v) { auto rr = __builtin_amdgcn_permlane32_swap(__float_as_uint(v), __float_as_uint(v), false, false); return __uint_as_float(rr[0]) + __uint_as_float(rr[1]); }

struct Stage4 { h8 vs0, vs1, ks0, ks1; };
__device__ __forceinline__ int hidden_tid() { int tz = threadIdx.x; asm volatile("" : "+v"(tz)); return tz; }
__device__ __forceinline__ void sload(Stage4& s, const _Float16* Kb, const _Float16* Vb, int ld, int k0) {
    const int tz = hidden_tid(), sr = tz >> 4, sc = (tz & 15) * 8;
    s.vs0 = *(const h8*)(Vb + (size_t)(k0 + sr) * ld + sc); s.vs1 = *(const h8*)(Vb + (size_t)(k0 + 32 + sr) * ld + sc);
    s.ks0 = *(const h8*)(Kb + (size_t)(k0 + sr) * ld + sc); s.ks1 = *(const h8*)(Kb + (size_t)(k0 + 32 + sr) * ld + sc);
}
__device__ __forceinline__ void swrite(const Stage4& s, char* V_lds, char* K_lds, int b) {
    const int tz = hidden_tid(), sr = tz >> 4, sc = (tz & 15) * 8, vst0 = v_st(sr, sc), vst1 = v_st(32 + sr, sc);
    *(h8*)(V_lds + b * SHM_V + vst0) = s.vs0; *(h8*)(V_lds + b * SHM_V + vst1) = s.vs1;
    const int kc = sc * 2;
    *(h8*)(K_lds + b * SHM_K + AT_KSWZ(sr, kc)) = s.ks0; *(h8*)(K_lds + b * SHM_K + AT_KSWZ(32 + sr, kc)) = s.ks1;
}

__device__ __forceinline__ void attn_unit(char* lds, const _Float16* qrow, const _Float16* Kb, const _Float16* Vb, int ld, unsigned tmask, int klo, int khi, unsigned selmask,
                                          float* outw, int ostride) {
    const int tid = threadIdx.x, wid = __builtin_amdgcn_readfirstlane(tid >> 6), lane = tid & 63, r32 = lane & 31, hi = lane >> 5;
    char* V_lds = lds; char* K_lds = lds + 2 * SHM_V;
    float* wsf = (float*)(lds + LDS_WS) + wid * 64; float* li_l = wsf; float* al_l = wsf + 32;
    float m_reg = -1e30f, l_reg = 0.f; f32x16 o[4] = {}; h8 qr[8];
#pragma unroll
    for (int d0 = 0; d0 < 8; ++d0) qr[d0] = *(const h8*)(qrow + d0 * 16);
    const int vb0 = (int)(uintptr_t)V_lds + v_rd_base(lane);
    Stage4 st;
    unsigned rest = tmask; int j = __ffs(rest) - 1; rest &= rest - 1;
    sload(st, Kb, Vb, ld, j * 64); asm volatile("s_waitcnt vmcnt(0)" ::: "memory"); swrite(st, V_lds, K_lds, 0); __syncthreads();
    int buf = 0;
    for (;;) {
        const int jn = rest ? (__ffs(rest) - 1) : -1;
        if (jn >= 0) sload(st, Kb, Vb, ld, jn * 64);
        f32x16 p0, p1;
        AT_SBAR(); qkt(p0, p1, K_lds + buf * SHM_K, qr, r32, hi);
        { const int kb = j * 64 + 4 * hi; const bool tb = (selmask >> j) & 1u;
#pragma unroll
          for (int r = 0; r < 16; ++r) { const int k0 = kb + (r & 3) + 8 * (r >> 2);
              p0[r] = (tb && k0 >= klo && k0 <= khi) ? p0[r] : -INFINITY;
              p1[r] = (tb && (k0 + 32) >= klo && (k0 + 32) <= khi) ? p1[r] : -INFINITY; } }
        float pmax = p0[0];
#pragma unroll
        for (int r = 1; r < 16; ++r) pmax = fmaxf(pmax, p0[r]);
#pragma unroll
        for (int r = 0; r < 16; ++r) pmax = fmaxf(pmax, p1[r]);
        pmax = half_swap_max(pmax);
        float mn, alpha;
        if (__all(pmax - m_reg <= THR_RAW)) { mn = m_reg; alpha = 1.f; }
        else { mn = fmaxf(m_reg, pmax); alpha = __builtin_amdgcn_exp2f((m_reg - mn) * CEXP); m_reg = mn; }
        const float mnC = -mn * CEXP;
        float ps = 0.f;
#pragma unroll
        for (int r = 0; r < 16; ++r) { p0[r] = __builtin_amdgcn_exp2f(fmaf(p0[r], CEXP, mnC)); ps += p0[r]; }
#pragma unroll
        for (int r = 0; r < 16; ++r) { p1[r] = __builtin_amdgcn_exp2f(fmaf(p1[r], CEXP, mnC)); ps += p1[r]; }
        ps = half_swap_sum(ps);
        l_reg = l_reg * alpha + ps;
        if (__any(alpha < 1.f)) { if (hi == 0) al_l[r32] = alpha; asm volatile("s_waitcnt lgkmcnt(0)" ::: "memory");
#pragma unroll
            for (int r = 0; r < 16; ++r) { const float a = al_l[crow(r, hi)];
#pragma unroll
                for (int d = 0; d < 4; ++d) o[d][r] *= a; } }
        h8 pa0, pa1, pa2, pa3; pack_p(p0, p1, pa0, pa1, pa2, pa3);
        AT_SBAR();
        pv_d0(o, vb0 + buf * SHM_V, pa0, pa1, pa2, pa3);
        if (jn < 0) break;
        asm volatile("s_waitcnt vmcnt(0)" ::: "memory");
        swrite(st, V_lds, K_lds, buf ^ 1);
        __syncthreads();
        buf ^= 1; j = jn; rest &= rest - 1;
    }
    if (hi == 0) li_l[r32] = l_reg; asm volatile("s_waitcnt lgkmcnt(0)" ::: "memory");
#pragma unroll
    for (int r = 0; r < 16; ++r) { const int orow = crow(r, hi); const float l = li_l[orow]; const float rl = l > 0.f ? 1.f / l : 0.f;
#pragma unroll
        for (int d0 = 0; d0 < 4; ++d0) outw[(size_t)orow * ostride + d0 * 32 + r32] = o[d0][r] * rl; }
    __syncthreads();
}

constexpr int LDS_AP = LDS_END, LDS_BP = LDS_AP + 4 * 64 * 33 * 4, LDS_SELM = LDS_BP + 4 * 64 * 33 * 4, LDS_CS_END = LDS_SELM + 64 * 4;
__device__ __forceinline__ void cmp_slc_unit(char* lds, const _Float16* qrow, const _Float16* Kc, const _Float16* Vc, const _Float16* Ks, const _Float16* Vs, int t, int tl, int g, int qi,
                                             float* outc, float* outs) {
    const int tid = threadIdx.x, wid = __builtin_amdgcn_readfirstlane(tid >> 6), lane = tid & 63, r32 = lane & 31, hi = lane >> 5;
    char* V_lds = lds; char* K_lds = lds + 2 * SHM_V;
    float* AP = (float*)(lds + LDS_AP); float* BP = (float*)(lds + LDS_BP); unsigned* selm = (unsigned*)(lds + LDS_SELM);
    {
        h8 qr[8];
#pragma unroll
        for (int d0 = 0; d0 < 8; ++d0) qr[d0] = *(const h8*)(qrow + d0 * 16);
        const int vb0 = (int)(uintptr_t)V_lds + v_rd_base(lane);
        { Stage4 s0, s1; sload(s0, Kc, Vc, 256, 0); sload(s1, Kc, Vc, 256, 64);
          asm volatile("s_waitcnt vmcnt(0)" ::: "memory");
          swrite(s0, V_lds, K_lds, 0); swrite(s1, V_lds, K_lds, 1); }
        __syncthreads();
        f32x16 pA0, pA1, pB0, pB1;
        AT_SBAR(); qkt(pA0, pA1, K_lds, qr, r32, hi); qkt(pB0, pB1, K_lds + SHM_K, qr, r32, hi);
        const int khi = t >= 31 ? ((t - 31) >> 4) : -1;
#pragma unroll
        for (int r = 0; r < 16; ++r) { const int c0 = 4 * hi + (r & 3) + 8 * (r >> 2);
            pA0[r] = (c0 <= khi) ? pA0[r] : -INFINITY; pA1[r] = (c0 + 32 <= khi) ? pA1[r] : -INFINITY;
            pB0[r] = (c0 + 64 <= khi) ? pB0[r] : -INFINITY; pB1[r] = (c0 + 96 <= khi) ? pB1[r] : -INFINITY; }
        float pmax = -INFINITY;
#pragma unroll
        for (int r = 0; r < 16; ++r) pmax = fmaxf(fmaxf(pmax, pA0[r]), fmaxf(pA1[r], fmaxf(pB0[r], pB1[r])));
        pmax = half_swap_max(pmax);
        const float mC = (pmax == -INFINITY) ? 0.f : -pmax * CEXP;
        float ps = 0.f;
#pragma unroll
        for (int r = 0; r < 16; ++r) { pA0[r] = __builtin_amdgcn_exp2f(fmaf(pA0[r], CEXP, mC)); pA1[r] = __builtin_amdgcn_exp2f(fmaf(pA1[r], CEXP, mC));
            pB0[r] = __builtin_amdgcn_exp2f(fmaf(pB0[r], CEXP, mC)); pB1[r] = __builtin_amdgcn_exp2f(fmaf(pB1[r], CEXP, mC)); ps += (pA0[r] + pA1[r]) + (pB0[r] + pB1[r]); }
        ps = half_swap_sum(ps);
        const float inv = ps > 0.f ? 1.f / ps : 0.f;
#pragma unroll
        for (int r = 0; r < 16; ++r) { pA0[r] *= inv; pA1[r] *= inv; pB0[r] *= inv; pB1[r] *= inv; }
        { float* ap = AP + (g * 64 + tl) * 33; float* bp = BP + (g * 64 + tl) * 33;
          if (hi == 0) bp[0] = 0.f;
#define AT_IMP(P, JB) do { _Pragma("unroll") for (int k = 0; k < 4; ++k) { const int j = (JB) + 2 * k + hi; \
              ap[j] = 2.f * (P[4 * k] + P[4 * k + 1] + P[4 * k + 2]) + P[4 * k + 3]; if (j + 1 < 32) bp[j + 1] = P[4 * k + 3]; } } while (0)
          AT_IMP(pA0, 0); AT_IMP(pA1, 8); AT_IMP(pB0, 16); AT_IMP(pB1, 24);
#undef AT_IMP
        }
        f32x16 o[4] = {};
        h8 pa0, pa1, pa2, pa3;
        pack_p(pA0, pA1, pa0, pa1, pa2, pa3); AT_SBAR(); pv_d0(o, vb0, pa0, pa1, pa2, pa3);
        pack_p(pB0, pB1, pa0, pa1, pa2, pa3); AT_SBAR(); pv_d0(o, vb0 + SHM_V, pa0, pa1, pa2, pa3);
#pragma unroll
        for (int r = 0; r < 16; ++r) { const int orow = crow(r, hi);
#pragma unroll
            for (int d0 = 0; d0 < 4; ++d0) outc[(size_t)orow * 1024 + d0 * 32 + r32] = o[d0][r]; }
    }
    __syncthreads();
#pragma unroll 1
    for (int it = 0; it < 4; ++it) {
        const int tk = 8 * wid + 2 * it + hi, j = r32;
        float imp = 0.f;
#pragma unroll
        for (int gg = 0; gg < 4; ++gg) imp += AP[(gg * 64 + tk) * 33 + j] + BP[(gg * 64 + tk) * 33 + j];
        const bool forced = (j == 0) || (j == qi) || (j == qi - 1), valid = j <= qi;
        const float iv = forced ? 1e9f : (valid ? imp : -1e9f);
        int rank = 0;
        for (int i = 0; i < 32; ++i) { const float vi = __shfl(iv, i + 32 * hi); rank += (vi > iv || (vi == iv && i < j)) ? 1 : 0; }
        const unsigned long long bal = __ballot(rank < 16 && valid);
        if (r32 == 0) selm[tk] = (unsigned)(bal >> (32 * hi));
    }
    __syncthreads();
    unsigned tm = selm[lane];
#pragma unroll
    for (int o = 32; o > 0; o >>= 1) tm |= __shfl_xor(tm, o);
    const int tz2 = hidden_tid();
    const unsigned mysel = selm[((tz2 >> 6) & 1) * 32 + (tz2 & 31)];
    attn_unit(lds, qrow, Ks, Vs, INW, tm, 0, t, mysel, outs, 1024);
}
}

__device__ __forceinline__ void conv_tile(float* lds, const float* __restrict__ W, int ldw, int nvalid, _Float16* __restrict__ Wt, int K, int k0, int n0) {
    const int tid = threadIdx.x;
    float4 v[8];
#pragma unroll
    for (int i = 0; i < 8; ++i) { const int idx = tid + 512 * i, r = idx >> 6, c4 = (idx & 63) * 4;
        v[i] = (n0 + c4 < nvalid) ? *(const float4*)(W + (size_t)(k0 + r) * ldw + n0 + c4) : make_float4(0.f, 0.f, 0.f, 0.f); }
#pragma unroll
    for (int i = 0; i < 8; ++i) { const int idx = tid + 512 * i, r = idx >> 6, c4 = (idx & 63) * 4; float* d = lds + r * 257 + c4; d[0] = v[i].x; d[1] = v[i].y; d[2] = v[i].z; d[3] = v[i].w; }
    __syncthreads();
#pragma unroll
    for (int j = 0; j < 4; ++j) { const int id = tid + 512 * j, n = id >> 3, k8 = (id & 7) * 8; h8 o;
#pragma unroll
        for (int q = 0; q < 8; ++q) o[q] = (_Float16)lds[(k8 + q) * 257 + n];
        *(h8*)(Wt + (size_t)(n0 + n) * K + k0 + k8) = o; }
    __syncthreads();
}


__device__ __forceinline__ unsigned pack4_i8(float a, float b, float c, float d) {
    const int ia = __float2int_rn(a), ib = __float2int_rn(b), ic = __float2int_rn(c), id = __float2int_rn(d);
    return (unsigned)(ia & 255) | ((unsigned)(ib & 255) << 8) | ((unsigned)(ic & 255) << 16) | ((unsigned)(id & 255) << 24);
}
constexpr int QP_LD2 = 1026;
struct QUnit { const float* W; int ldw; int n0; signed char* Q; float* sc; };
__device__ __forceinline__ QUnit quant_desc(int u, const float* wgu, const float* wdn, signed char* q8gu, signed char* q8dn, float* sgu, float* sdn) {
    QUnit d;
    if (u < NE * 128) { const int e = u >> 7, pn = u & 127; d.W = wgu + (size_t)e * 2048 * 4096; d.ldw = 4096; d.n0 = pn * 32; d.Q = q8gu + (size_t)e * 4096 * 2048; d.sc = sgu + (size_t)e * 4096; }
    else { const int v = u - NE * 128, e = v >> 6, pn = v & 63; d.W = wdn + (size_t)e * 2048 * 2048; d.ldw = 2048; d.n0 = pn * 32; d.Q = q8dn + (size_t)e * 2048 * 2048; d.sc = sdn + (size_t)e * 2048; }
    return d;
}
__device__ __forceinline__ unsigned pk2h(float a, float b) { auto v = __builtin_amdgcn_cvt_pkrtz(a, b); return *reinterpret_cast<unsigned*>(&v); }
__device__ __forceinline__ void quant_all(char* smem, const float* wgu, const float* wdn, signed char* q8gu, signed char* q8dn, float* sgu, float* sdn, int bid, int nb) {
    constexpr int NU = NE * 128 + NE * 64;
    unsigned* Tt = (unsigned*)smem;
    unsigned* cmaxb = (unsigned*)(smem + 32 * QP_LD2 * 4);
    const int tid = threadIdx.x, c4 = (tid & 7) * 4, kp = tid >> 3;
    if (tid < 64) cmaxb[tid] = 0u;
    __syncthreads();
    int u = bid; if (u >= NU) return;
    QUnit d = quant_desc(u, wgu, wdn, q8gu, q8dn, sgu, sdn);
    float4 va[8], vb[8];
#define QL(dst, D, bt) do { _Pragma("unroll") for (int j = 0; j < 4; ++j) { const float* p0 = (D).W + (size_t)(((bt) * 4 + j) * 128 + 2 * kp) * (D).ldw + (D).n0 + c4; dst[2 * j] = *(const float4*)p0; dst[2 * j + 1] = *(const float4*)(p0 + (D).ldw); } } while (0)
#define QP(src, bt) do { _Pragma("unroll") for (int j = 0; j < 4; ++j) { const int kg = ((bt) * 4 + j) * 64 + kp; const float4 r0 = src[2 * j], r1 = src[2 * j + 1]; \
        Tt[(c4 + 0) * QP_LD2 + kg] = pk2h(r0.x, r1.x); Tt[(c4 + 1) * QP_LD2 + kg] = pk2h(r0.y, r1.y); Tt[(c4 + 2) * QP_LD2 + kg] = pk2h(r0.z, r1.z); Tt[(c4 + 3) * QP_LD2 + kg] = pk2h(r0.w, r1.w); \
        m0 = fmaxf(m0, fmaxf(fabsf(r0.x), fabsf(r1.x))); m1 = fmaxf(m1, fmaxf(fabsf(r0.y), fabsf(r1.y))); m2 = fmaxf(m2, fmaxf(fabsf(r0.z), fabsf(r1.z))); m3 = fmaxf(m3, fmaxf(fabsf(r0.w), fabsf(r1.w))); } } while (0)
    QL(va, d, 0);
    int par = 0;
    for (;;) {
        unsigned* cmax = cmaxb + par * 32;
        float m0 = 0.f, m1 = 0.f, m2 = 0.f, m3 = 0.f;
        QL(vb, d, 1); QP(va, 0);
        QL(va, d, 2); QP(vb, 1);
        QL(vb, d, 3); QP(va, 2);
        const int un = u + nb; const bool has = un < NU;
        QUnit dn = d; if (has) { dn = quant_desc(un, wgu, wdn, q8gu, q8dn, sgu, sdn); QL(va, dn, 0); }
        QP(vb, 3);
        atomicMax(&cmax[c4 + 0], __float_as_uint(m0)); atomicMax(&cmax[c4 + 1], __float_as_uint(m1)); atomicMax(&cmax[c4 + 2], __float_as_uint(m2)); atomicMax(&cmax[c4 + 3], __float_as_uint(m3));
        __syncthreads();
        if (tid < 32) cmaxb[(par ^ 1) * 32 + tid] = 0u;
#pragma unroll
        for (int j = 0; j < 8; ++j) { const int id = tid + 512 * j, n = id >> 7, k16 = (id & 127) * 16;
            const float mx = __uint_as_float(cmax[n]); const float inv = mx > 0.f ? 127.f / mx : 0.f;
            const h4* src = (const h4*)(Tt + n * QP_LD2 + (k16 >> 1));
            const h4 a = src[0], b = src[1], c = src[2], e4 = src[3];
            uint4 o;
            o.x = pack4_i8((float)a[0] * inv, (float)a[1] * inv, (float)a[2] * inv, (float)a[3] * inv); o.y = pack4_i8((float)b[0] * inv, (float)b[1] * inv, (float)b[2] * inv, (float)b[3] * inv);
            o.z = pack4_i8((float)c[0] * inv, (float)c[1] * inv, (float)c[2] * inv, (float)c[3] * inv); o.w = pack4_i8((float)e4[0] * inv, (float)e4[1] * inv, (float)e4[2] * inv, (float)e4[3] * inv);
            *(uint4*)(d.Q + (size_t)(d.n0 + n) * 2048 + k16) = o; }
        if (tid < 32) { const float mx = __uint_as_float(cmax[tid]); d.sc[d.n0 + tid] = mx > 0.f ? mx / 127.f : 1.f; }
        __syncthreads();
        if (!has) break;
        u = un; d = dn; par ^= 1;
    }
#undef QL
#undef QP
}

__global__ void __launch_bounds__(512, 2) fwd(Params p) {
    extern __shared__ __attribute__((aligned(16))) char smem[];
    const int tid = threadIdx.x, lane = tid & 63, wv = __builtin_amdgcn_readfirstlane(tid >> 6);
    const int bid = blockIdx.x, nb = gridDim.x;
    const int gw = bid * 8 + wv, nw = nb * 8;
    const int lo = (int)(p.lo_hi & 0xffffffffll), hi = (int)(p.lo_hi >> 32);
    unsigned char* ws = p.ws;
    unsigned* ctl = (unsigned*)(ws + WS_CTL);
    int* cnt = (int*)(ws + CTL_CNT);
    float* proj = (float*)(ws + WS_PROJ);
    float* kvmem = (float*)(ws + WS_KVMEM);
    float* bias1 = (float*)(ws + WS_BIAS1);
    float* hid = (float*)(ws + WS_HID);
    float* kc = (float*)(ws + WS_KC);
    float* vc = (float*)(ws + WS_VC);
    float* pooled = (float*)(ws + WS_POOLED);
    float* opool = (float*)(ws + WS_OPOOL);
    float* owin = (float*)(ws + WS_OWIN);
    float* ocmp = (float*)(ws + WS_OCMP);
    float* oslc = (float*)(ws + WS_OSLC);
    unsigned* sel = (unsigned*)(ws + WS_SEL);
    float* omem = (float*)(ws + WS_OMEM);
    _Float16* cat16 = (_Float16*)(ws + WS_CAT16);
    _Float16* hpre16 = (_Float16*)(ws + WS_HPRE);
    float* hbuf = (float*)(ws + WS_H);
    float* gate = (float*)(ws + WS_GATE);
    int* list = (int*)(ws + WS_LIST);
    _Float16* act16 = (_Float16*)(ws + WS_ACT16);
    _Float16* y16 = (_Float16*)(ws + WS_Y16);
    _Float16* h16 = (_Float16*)(ws + WS_H16);
    _Float16* x16 = (_Float16*)(ws + WS_X16);
    _Float16* wtin = (_Float16*)(ws + WS_WTIN);
    _Float16* wtout = (_Float16*)(ws + WS_WTOUT);
    _Float16* wtgu = (_Float16*)(ws + WS_WTGU);
    _Float16* wtdn = (_Float16*)(ws + WS_WTDN);
    LAS unsigned char* lds = (LAS unsigned char*)smem;
    _Float16* proj16 = (_Float16*)(ws + WS_PROJ16);
    _Float16* kvmem16 = (_Float16*)(ws + WS_KVMEM16);
    _Float16* wt1 = (_Float16*)(ws + WS_WT1);
    float* uv = (float*)(ws + WS_UV);
    _Float16* kc16 = (_Float16*)(ws + WS_KC16);
    _Float16* vc16 = (_Float16*)(ws + WS_VC16);
    _Float16* wr16 = (_Float16*)(ws + WS_WR16);
    _Float16* mem16 = (_Float16*)(ws + WS_MEM16);
    _Float16* wtmkv = (_Float16*)(ws + WS_WTMKV);
    signed char* q8gu = (signed char*)(ws + WS_Q8GU); signed char* q8dn = (signed char*)(ws + WS_Q8DN);
    float* sgu = (float*)(ws + WS_SGU); float* sdn = (float*)(ws + WS_SDN);
    signed char* h8q = (signed char*)(ws + WS_H8); float* sah = (float*)(ws + WS_SAH);
    signed char* act8 = (signed char*)(ws + WS_ACT8); float* sact = (float*)(ws + WS_SACT);
    const int vcu = (nb % 8 == 0) ? (bid % 8) * (nb / 8) + bid / 8 : bid;

    volatile LAS unsigned* xbw = (volatile LAS unsigned*)(smem + LDS_BYTES - 16);
    if (tid == 0) { xbw[0] = 0u; xbw[1] = 0u; xbw[2] = 0u; xbw[3] = 0u; }
    __syncthreads();
    XcdBarrier bar; bar.bar = ctl; bar.x = 0; bar.st = xbw;
    const bool multi = (hi - lo) > 1;
    if (multi) bar = xcd_barrier_post(ctl, xbw);
#define IN(k) (lo <= (k) && (k) < hi)
#define SEAM(k) do { if (IN(k) && IN((k) + 1)) xcd_barrier(bar); } while (0)
    float* sw = (float*)smem + wv * WLDS_FLOATS;
    int* segw = (int*)(sw + 4096 + 512);

    if (IN(0)) {
        for (int j = gw; j < 512; j += nw) {
            const int kv = j >> 8, jj = j & 255;
            const float* pos = p.in[kv ? I_POSV : I_POSK]; const float* w1 = p.in[kv ? I_W1V : I_W1K];
            float s = 0.f;
            for (int k = lane; k < 4096; k += 64) s += pos[k] * w1[(size_t)k * 256 + jj];
            s = wave_sum(s);
            if (lane == 0) bias1[j] = s;
        }
        for (int i = bid * 512 + tid; i < 32 * 2048; i += nb * 512) { const int e = i >> 11, d = i & 2047; wr16[i] = (_Float16)p.in[I_WR][(size_t)d * 32 + e]; }
        for (size_t i = (size_t)bid * 512 + tid; i < (size_t)T_ * 2048 / 4; i += (size_t)nb * 512) {
            const float4 v = ((const float4*)p.in[I_X])[i]; ((h4*)x16)[i] = (h4){(_Float16)v.x, (_Float16)v.y, (_Float16)v.z, (_Float16)v.w};
        }
        {
            constexpr int U_IN = 32 * 15, U_OUT = 32 * 8, U_W1 = 128;
            quant_all(smem, p.in[I_WGU], p.in[I_WDN], q8gu, q8dn, sgu, sdn, bid, nb);
            __syncthreads();
            for (int u = bid; u < U_IN + U_OUT + U_W1; u += nb) {
                if (u < U_IN) { const int v = u, kt = v / 15, ntl = v % 15;
                    conv_tile((float*)smem, p.in[I_WIN], INW, INW, wtin, 2048, kt * 64, ntl * 256);
                } else if (u < U_IN + U_OUT) { const int v = u - U_IN, kt = v / 8, ntl = v % 8;
                    conv_tile((float*)smem, p.in[I_WOUT], 2048, 2048, wtout, 2048, kt * 64, ntl * 256);
                } else { const int v = u - U_IN - U_OUT, kv = v >> 6, part = (v >> 5) & 1, kt = v & 31;
                    conv_tile((float*)smem, p.in[kv ? I_W1V : I_W1K] + (size_t)part * 2048 * 256, 256, 256, wt1 + ((size_t)kv * 512 + part * 256) * 2048, 2048, kt * 64, 0);
                }
            }
        }
        for (size_t i = (size_t)bid * 512 + tid; i < (size_t)2048 * 2048 / 4; i += (size_t)nb * 512) {
            const float4 v = ((const float4*)p.in[I_MEM])[i]; ((h4*)mem16)[i] = (h4){(_Float16)v.x, (_Float16)v.y, (_Float16)v.z, (_Float16)v.w};
        }
        for (int u = bid; u < 128; u += nb) { const int kt = u >> 2, ntl = u & 3; conv_tile((float*)smem, p.in[I_WMEMKV], 1024, 1024, wtmkv, 2048, kt * 64, ntl * 256); }
    }
    SEAM(0);
    if (IN(1)) {
        g8::ProbIn P{x16, proj16, nb, bid};
        g8::gemm_phase(lds, P);
    }
    SEAM(1);
    if (IN(2)) {
        { g8::ProbCmp P{proj16, wt1, uv, nb, bid}; g8::gemm_phase(lds, P); __syncthreads(); }
        for (int i = bid * 512 + tid; i < T_ * 64; i += nb * 512) {
            const int chn = i & 63, row = i >> 6, t = row & (S_ - 1), g = chn >> 4;
            const int win = 2 << g, n = min(win, t + 1);
            const _Float16* src = proj16 + (size_t)row * INW + C_UP + chn * 8;
            float a[8];
            const h8 cur = *(const h8*)src;
#pragma unroll
            for (int q = 0; q < 8; ++q) a[q] = (float)cur[q];
            for (int k = 1; k < n; ++k) { const h8 v = *(const h8*)(src - (size_t)k * INW);
#pragma unroll
                for (int q = 0; q < 8; ++q) a[q] += (float)v[q]; }
            const float rn = 1.f / (float)n;
            float4 o0, o1;
            o0.x = a[0] * rn - (float)cur[0]; o0.y = a[1] * rn - (float)cur[1]; o0.z = a[2] * rn - (float)cur[2]; o0.w = a[3] * rn - (float)cur[3];
            o1.x = a[4] * rn - (float)cur[4]; o1.y = a[5] * rn - (float)cur[5]; o1.z = a[6] * rn - (float)cur[6]; o1.w = a[7] * rn - (float)cur[7];
            *(float4*)(pooled + (size_t)row * 512 + chn * 8) = o0; *(float4*)(pooled + (size_t)row * 512 + chn * 8 + 4) = o1;
        }
        {
            const int r32 = lane & 31, hi = lane >> 5, g = wv >> 1, half = wv & 1;
            for (int uu = bid; uu < 512; uu += nb) {
                const int u = (uu & 1) ? (511 - (uu >> 1)) : (uu >> 1);
                const int bk = u >> 5, qi = u & 31, b = bk >> 1, kvh = bk & 1;
                const int t = qi * 64 + half * 32 + r32;
                const int lo_t = max(0, qi - 8);
                const unsigned tmask = (unsigned)(((1ull << (qi + 1)) - 1ull) & ~((1ull << lo_t) - 1ull));
                at8::attn_unit(smem, proj16 + (size_t)(b * S_ + t) * INW + C_Q + (kvh * 4 + g) * 128 + hi * 8,
                               proj16 + (size_t)b * S_ * INW + C_KW + kvh * 128, proj16 + (size_t)b * S_ * INW + C_VW + kvh * 128, INW, tmask, t - 511, t, 0xffffffffu,
                               owin + (size_t)(b * S_ + qi * 64 + half * 32) * 1024 + (kvh * 4 + g) * 128, 1024);
            }
            for (int u = bid; u < 256; u += nb) {
                const int b = u >> 5, h = (u >> 3) & 3, qt = u & 7;
                const int t = qt * 256 + wv * 32 + r32;
                at8::attn_unit(smem, proj16 + (size_t)(b * S_ + t) * INW + C_QM + h * 128 + hi * 8,
                               kvmem16 + (size_t)b * 256 * 1024 + h * 128, kvmem16 + (size_t)b * 256 * 1024 + 512 + h * 128, 1024, 0xFu, 0, 255, 0xffffffffu,
                               omem + (size_t)(b * S_ + qt * 256 + wv * 32) * 512 + h * 128, 512);
            }
        }
    }
    SEAM(2);
    if (IN(3)) {
        {   float* hs = (float*)smem;
            for (int u = bid; u < 508; u += nb) {
                const int kv = u / 254, ub = u % 254;
                const float* w2 = p.in[kv ? I_W2V : I_W2K]; _Float16* dst = kv ? vc16 : kc16;
                __syncthreads();
#pragma unroll
                for (int q = 0; q < 4; ++q) { const int e = tid + 512 * q, i = e >> 8, n = e & 255;
                    const int idx = ub * 8 + i, b = idx / 254, rem = idx % 254, c = rem >> 1, kvh = rem & 1;
                    const int row = (b * 128 + c) * 2 + kvh;
                    float a = bias1[kv * 256 + n];
#pragma unroll
                    for (int sp = 0; sp < 4; ++sp) { const float* base = uv + ((size_t)(kv * 4 + sp) * 2048) * 512; a += base[(size_t)row * 512 + n] + base[(size_t)(row + 2) * 512 + 256 + n]; }
                    hs[i * 256 + n] = gelu_tanh(a); }
                __syncthreads();
#pragma unroll
                for (int q = 0; q < 2; ++q) { const int e = tid + 512 * q, i = e >> 7, d = e & 127;
                    const int idx = ub * 8 + i, b = idx / 254, rem = idx % 254, c = rem >> 1, kvh = rem & 1;
                    float a = 0.f;
                    for (int n = 0; n < 256; ++n) a += hs[i * 256 + n] * w2[n * 128 + d];
                    dst[(size_t)((b * 128 + c) * 2 + kvh) * 128 + d] = (_Float16)a; }
            }
            __syncthreads();
            for (int i = bid * 512 + tid; i < 2 * B_ * 256; i += nb * 512) { const int kv = i / (B_ * 256), r = i % (B_ * 256), b = r >> 8, x = r & 255;
                (kv ? vc16 : kc16)[(size_t)(b * 128 + 127) * 256 + x] = (_Float16)0.f; }
        }
        for (int u = bid; u < 128 * 4; u += nb) { const int g = u >> 7, mt = u & 127;
            ARowPlain af{pooled + g * 128, 512, mt * 128, T_}; EpiPool ef{opool, p.in[I_POOLS], mt * 128, g};
            gemm_tile(smem, 128, af, p.in[I_POOLW] + (size_t)g * 128 * 128, 128, 0, 128, false, ef);
        }
    }
    SEAM(3);
    if (IN(4)) {
        const int r32 = lane & 31, hi = lane >> 5, g = wv >> 1, half = wv & 1;
        for (int uu = bid; uu < 512; uu += nb) {
            const int u = (uu & 1) ? (511 - (uu >> 1)) : (uu >> 1);
            const int bk = u >> 5, qi = u & 31, b = bk >> 1, kvh = bk & 1;
            const int tl = half * 32 + r32, t = qi * 64 + tl;
            at8::cmp_slc_unit(smem, proj16 + (size_t)(b * S_ + t) * INW + C_Q + (kvh * 4 + g) * 128 + hi * 8,
                              kc16 + (size_t)(b * 128 * 2 + kvh) * 128, vc16 + (size_t)(b * 128 * 2 + kvh) * 128,
                              proj16 + (size_t)b * S_ * INW + C_KS + kvh * 128, proj16 + (size_t)b * S_ * INW + C_VS + kvh * 128, t, tl, g, qi,
                              ocmp + (size_t)(b * S_ + qi * 64 + half * 32) * 1024 + (kvh * 4 + g) * 128, oslc + (size_t)(b * S_ + qi * 64 + half * 32) * 1024 + (kvh * 4 + g) * 128);
        }
    }
    SEAM(4);
    if (IN(5)) {
        for (int row = gw; row < T_; row += nw) {
            const _Float16* pr = proj16 + (size_t)row * INW;
            float v[16]; float ss = 0.f;
#pragma unroll
            for (int i = 0; i < 16; ++i) { const int col = lane + 64 * i, h = col >> 7; const size_t o = (size_t)row * 1024 + col;
                const float g0 = sigmoidf_((float)pr[C_G + h * 3]), g1 = sigmoidf_((float)pr[C_G + h * 3 + 1]), g2 = sigmoidf_((float)pr[C_G + h * 3 + 2]);
                v[i] = g0 * ocmp[o] + g1 * oslc[o] + g2 * owin[o]; ss += v[i] * v[i]; }
            ss = wave_sum(ss); float r = rsqrtf(ss / 1024.f + LN_EPS);
#pragma unroll
            for (int i = 0; i < 16; ++i) { const int col = lane + 64 * i; cat16[(size_t)row * 2048 + col] = (_Float16)(v[i] * r * p.in[I_GNNSA][col]); }
            ss = 0.f;
#pragma unroll
            for (int i = 0; i < 8; ++i) { v[i] = opool[(size_t)row * 512 + lane + 64 * i]; ss += v[i] * v[i]; }
            ss = wave_sum(ss); r = rsqrtf(ss / 512.f + LN_EPS);
#pragma unroll
            for (int i = 0; i < 8; ++i) { const int col = lane + 64 * i; cat16[(size_t)row * 2048 + 1024 + col] = (_Float16)(v[i] * r * p.in[I_GNPOOL][col]); }
            ss = 0.f;
#pragma unroll
            for (int i = 0; i < 8; ++i) { v[i] = omem[(size_t)row * 512 + lane + 64 * i]; ss += v[i] * v[i]; }
            ss = wave_sum(ss); r = rsqrtf(ss / 512.f + LN_EPS);
#pragma unroll
            for (int i = 0; i < 8; ++i) { const int col = lane + 64 * i; cat16[(size_t)row * 2048 + 1536 + col] = (_Float16)(v[i] * r * p.in[I_GNMEM][col]); }
        }
    }
    SEAM(5);
    if (IN(6)) {
        g8::ProbOut P{cat16, wtout, hpre16, x16, nb, bid};
        g8::gemm_phase(lds, P);
    }
    SEAM(6);
    if (IN(7)) {
        float* lg = (float*)smem;
        const int r32 = lane & 31, hi = lane >> 5, fr = lane & 15, fq = lane >> 4;
        for (int u = bid; u < T_ / 64; u += nb) {
            const int base = u * 64;
#pragma unroll 1
            for (int i = 0; i < 8; ++i) {
                const int row = base + wv * 8 + i;
                float v[32]; float s = 0.f;
#pragma unroll
                for (int c = 0; c < 4; ++c) { const int col = (lane + 64 * c) * 8;
                    const h8 a0 = *(const h8*)(hpre16 + (size_t)row * 2048 + col);
#pragma unroll
                    for (int q = 0; q < 8; ++q) { v[c * 8 + q] = (float)a0[q]; s += v[c * 8 + q]; } }
                const float mu = wave_sum(s) / 2048.f; float q2 = 0.f;
#pragma unroll
                for (int k = 0; k < 32; ++k) { const float d = v[k] - mu; q2 += d * d; }
                const float rs = rsqrtf(wave_sum(q2) / 2048.f + LN_EPS);
                float amax = 0.f;
#pragma unroll
                for (int c = 0; c < 4; ++c) { const int col = (lane + 64 * c) * 8;
                    const float4 g0 = *(const float4*)(p.in[I_LN1G] + col), g1 = *(const float4*)(p.in[I_LN1G] + col + 4), b0 = *(const float4*)(p.in[I_LN1B] + col), b1 = *(const float4*)(p.in[I_LN1B] + col + 4);
                    float4 o0, o1;
                    o0.x = (v[c * 8 + 0] - mu) * rs * g0.x + b0.x; o0.y = (v[c * 8 + 1] - mu) * rs * g0.y + b0.y; o0.z = (v[c * 8 + 2] - mu) * rs * g0.z + b0.z; o0.w = (v[c * 8 + 3] - mu) * rs * g0.w + b0.w;
                    o1.x = (v[c * 8 + 4] - mu) * rs * g1.x + b1.x; o1.y = (v[c * 8 + 5] - mu) * rs * g1.y + b1.y; o1.z = (v[c * 8 + 6] - mu) * rs * g1.z + b1.z; o1.w = (v[c * 8 + 7] - mu) * rs * g1.w + b1.w;
                    *(float4*)(hbuf + (size_t)row * 2048 + col) = o0; *(float4*)(hbuf + (size_t)row * 2048 + col + 4) = o1;
                    h8 oh; oh[0] = (_Float16)o0.x; oh[1] = (_Float16)o0.y; oh[2] = (_Float16)o0.z; oh[3] = (_Float16)o0.w; oh[4] = (_Float16)o1.x; oh[5] = (_Float16)o1.y; oh[6] = (_Float16)o1.z; oh[7] = (_Float16)o1.w;
                    *(h8*)(h16 + (size_t)row * 2048 + col) = oh;
                    v[c * 8 + 0] = o0.x; v[c * 8 + 1] = o0.y; v[c * 8 + 2] = o0.z; v[c * 8 + 3] = o0.w; v[c * 8 + 4] = o1.x; v[c * 8 + 5] = o1.y; v[c * 8 + 6] = o1.z; v[c * 8 + 7] = o1.w;
                    amax = fmaxf(amax, fmaxf(fmaxf(fmaxf(fabsf(o0.x), fabsf(o0.y)), fmaxf(fabsf(o0.z), fabsf(o0.w))), fmaxf(fmaxf(fabsf(o1.x), fabsf(o1.y)), fmaxf(fabsf(o1.z), fabsf(o1.w))))); }
                amax = wave_max(amax);
                const float qinv = amax > 0.f ? 127.f / amax : 0.f;
                if (lane == 0) sah[row] = amax > 0.f ? amax / 127.f : 1.f;
#pragma unroll
                for (int c = 0; c < 4; ++c) { const int col = (lane + 64 * c) * 8;
                    uint2 q; q.x = pack4_i8(v[c * 8 + 0] * qinv, v[c * 8 + 1] * qinv, v[c * 8 + 2] * qinv, v[c * 8 + 3] * qinv); q.y = pack4_i8(v[c * 8 + 4] * qinv, v[c * 8 + 5] * qinv, v[c * 8 + 6] * qinv, v[c * 8 + 7] * qinv);
                    *(uint2*)(h8q + (size_t)row * 2048 + col) = q; }
            }
            asm volatile("s_waitcnt vmcnt(0)" ::: "memory");
            __syncthreads();
            {
                const int tok0 = base + 16 * (wv >> 1), e0 = 16 * (wv & 1);
                const _Float16* ap = h16 + (size_t)(tok0 + fr) * 2048 + fq * 8; const _Float16* bp = wr16 + (size_t)(e0 + fr) * 2048 + fq * 8;
                f4 acc = (f4){0.f, 0.f, 0.f, 0.f};
#pragma unroll 8
                for (int sI = 0; sI < 64; ++sI) { const h8 a = *(const h8*)(ap + sI * 32), bb = *(const h8*)(bp + sI * 32); acc = __builtin_amdgcn_mfma_f32_16x16x32_f16(a, bb, acc, 0, 0, 0); }
                const float br = p.in[I_BR][e0 + fr];
#pragma unroll
                for (int j = 0; j < 4; ++j) lg[(16 * (wv >> 1) + 4 * fq + j) * 33 + e0 + fr] = acc[j] + br;
            }
            __syncthreads();
#pragma unroll 1
            for (int it = 0; it < 4; ++it) {
                const int tk = 8 * wv + 2 * it + hi;
                const float iv = lg[tk * 33 + r32];
                int rank = 0;
                for (int i = 0; i < 32; ++i) { const float vi = __shfl(iv, i + 32 * hi); rank += (vi > iv || (vi == iv && i < r32)) ? 1 : 0; }
                float tv[4]; int te[4];
#pragma unroll
                for (int r = 0; r < 4; ++r) { const unsigned long long bm = __ballot(rank == r); const unsigned hm = (unsigned)(bm >> (32 * hi)); const int src = __ffs(hm) - 1; te[r] = src; tv[r] = __shfl(iv, src + 32 * hi); }
                const float e0v = 1.f, e1v = expf(tv[1] - tv[0]), e2v = expf(tv[2] - tv[0]), e3v = expf(tv[3] - tv[0]); const float inv = 1.f / (e0v + e1v + e2v + e3v);
                if (r32 < 4) { const int e = r32 == 0 ? te[0] : r32 == 1 ? te[1] : r32 == 2 ? te[2] : te[3]; const float g = (r32 == 0 ? e0v : r32 == 1 ? e1v : r32 == 2 ? e2v : e3v) * inv;
                    const int a = (base + tk) * 4 + r32; const int pos = atomicAdd(&cnt[e], 1); list[(size_t)e * T_ + pos] = a; gate[a] = g; }
            }
            __syncthreads();
        }
    }
    SEAM(7);
    LAS int* mtab = (LAS int*)(smem + g8::STAGE_BYTES);
    if (IN(8)) {
        if (tid == 0) { int ub = 0, rs = 0;
            for (int e = 0; e < NE; ++e) { const int c = (int)__hip_atomic_load((unsigned*)&cnt[e], __ATOMIC_RELAXED, __HIP_MEMORY_SCOPE_AGENT); mtab[e] = c; mtab[32 + e] = ub; mtab[65 + e] = rs; ub += ((c + 255) >> 8) * 16; rs += c; }
            mtab[64] = ub; mtab[97] = rs; mtab[98] = ub; }
        __syncthreads();
        g8::ProbGu P{h8q, q8gu, act16, p.in[I_BGU], list, sah, sgu, g8::MoeTab{mtab, 16}, nb, vcu};
        g8::gemm_phase(lds, P);
        __syncthreads();
    }
    SEAM(8);
    if (IN(9)) {
        for (int row = gw; row < NA; row += nw) {
            float v[32]; float amax = 0.f;
#pragma unroll
            for (int c = 0; c < 4; ++c) { const h8 a = *(const h8*)(act16 + (size_t)row * 2048 + (lane + 64 * c) * 8);
#pragma unroll
                for (int q = 0; q < 8; ++q) { v[c * 8 + q] = (float)a[q]; amax = fmaxf(amax, fabsf(v[c * 8 + q])); } }
            amax = wave_max(amax);
            const float qinv = amax > 0.f ? 127.f / amax : 0.f;
            if (lane == 0) sact[row] = amax > 0.f ? amax / 127.f : 1.f;
#pragma unroll
            for (int c = 0; c < 4; ++c) { uint2 q; q.x = pack4_i8(v[c * 8 + 0] * qinv, v[c * 8 + 1] * qinv, v[c * 8 + 2] * qinv, v[c * 8 + 3] * qinv); q.y = pack4_i8(v[c * 8 + 4] * qinv, v[c * 8 + 5] * qinv, v[c * 8 + 6] * qinv, v[c * 8 + 7] * qinv);
                *(uint2*)(act8 + (size_t)row * 2048 + (lane + 64 * c) * 8) = q; }
        }
    }
    SEAM(9);
    if (IN(10)) {
        if (tid == 0) { int ub = 0, rs = 0;
            for (int e = 0; e < NE; ++e) { const int c = (int)__hip_atomic_load((unsigned*)&cnt[e], __ATOMIC_RELAXED, __HIP_MEMORY_SCOPE_AGENT); mtab[e] = c; mtab[32 + e] = ub; mtab[65 + e] = rs; ub += ((c + 255) >> 8) * 8; rs += c; }
            mtab[64] = ub; mtab[97] = rs; mtab[98] = ub; }
        __syncthreads();
        g8::ProbDn P{act8, q8dn, y16, p.in[I_BDN], list, gate, sact, sdn, g8::MoeTab{mtab, 8}, nb, vcu};
        g8::gemm_phase(lds, P);
        __syncthreads();
    }
    SEAM(10);
    if (IN(11)) {
        for (int row = gw; row < T_; row += nw) {
            float v[32]; float s = 0.f;
#pragma unroll
            for (int c = 0; c < 4; ++c) { const int col = (lane + 64 * c) * 8; const size_t yo = (size_t)row * 4 * 2048 + col;
                const float4 ha = *(const float4*)(hbuf + (size_t)row * 2048 + col), hb = *(const float4*)(hbuf + (size_t)row * 2048 + col + 4);
                const h8 y0 = *(const h8*)(y16 + yo), y1 = *(const h8*)(y16 + yo + 2048), y2 = *(const h8*)(y16 + yo + 4096), y3 = *(const h8*)(y16 + yo + 6144);
                const float hh[8] = {ha.x, ha.y, ha.z, ha.w, hb.x, hb.y, hb.z, hb.w};
#pragma unroll
                for (int q = 0; q < 8; ++q) { v[c * 8 + q] = DN_ALPHA * hh[q] + (((float)y0[q] + (float)y1[q]) + ((float)y2[q] + (float)y3[q])); s += v[c * 8 + q]; } }
            const float mu = wave_sum(s) / 2048.f; float q2 = 0.f;
#pragma unroll
            for (int i = 0; i < 32; ++i) { const float d = v[i] - mu; q2 += d * d; }
            const float rs = rsqrtf(wave_sum(q2) / 2048.f + LN_EPS);
#pragma unroll
            for (int c = 0; c < 4; ++c) { const int col = (lane + 64 * c) * 8;
                const float4 ga = *(const float4*)(p.in[I_LN2G] + col), gb = *(const float4*)(p.in[I_LN2G] + col + 4), ba = *(const float4*)(p.in[I_LN2B] + col), bb = *(const float4*)(p.in[I_LN2B] + col + 4);
                float4 o0, o1;
                o0.x = (v[c * 8 + 0] - mu) * rs * ga.x + ba.x; o0.y = (v[c * 8 + 1] - mu) * rs * ga.y + ba.y; o0.z = (v[c * 8 + 2] - mu) * rs * ga.z + ba.z; o0.w = (v[c * 8 + 3] - mu) * rs * ga.w + ba.w;
                o1.x = (v[c * 8 + 4] - mu) * rs * gb.x + bb.x; o1.y = (v[c * 8 + 5] - mu) * rs * gb.y + bb.y; o1.z = (v[c * 8 + 6] - mu) * rs * gb.z + bb.z; o1.w = (v[c * 8 + 7] - mu) * rs * gb.w + bb.w;
                *(float4*)(p.out + (size_t)row * 2048 + col) = o0; *(float4*)(p.out + (size_t)row * 2048 + col + 4) = o1; }
        }
    }
}

constexpr int NPHASE = 12;

extern "C" void kernel_launch(void* const* d_in, const int* in_sizes, int n_in, void* d_out, int out_size, void* d_ws, size_t ws_size, hipStream_t stream) {
    static int grid = 0;
    if (grid == 0) {
        if (n_in != 26 || ws_size < WS_END) { fprintf(stderr, "kernel_launch: unexpected n_in %d or ws_size %zu (< %zu)\n", n_in, ws_size, (size_t)WS_END); grid = -1; return; }
        int dev = 0, cus = 0, per_cu = 0;
        hipGetDevice(&dev); hipDeviceGetAttribute(&cus, hipDeviceAttributeMultiprocessorCount, dev);
        if (hipFuncSetAttribute((const void*)fwd, hipFuncAttributeMaxDynamicSharedMemorySize, LDS_BYTES) != hipSuccess) { fprintf(stderr, "hipFuncSetAttribute failed\n"); grid = -1; return; }
        hipOccupancyMaxActiveBlocksPerMultiprocessor(&per_cu, (const void*)fwd, 512, LDS_BYTES);
        (void)hipGetLastError();
        if (per_cu < 1) fprintf(stderr, "occupancy query says %d blocks per CU\n", per_cu);
        grid = cus > 0 ? cus : 256;
    }
    if (grid < 0) return;
    hipMemsetAsync((char*)d_ws + WS_CTL, 0, CTL_BYTES, stream);
    Params p{};
    for (int i = 0; i < 26; ++i) p.in[i] = (const float*)d_in[i];
    p.out = (float*)d_out; p.ws = (unsigned char*)d_ws;
#if N_LAUNCH_MODE == 1
    p.lo_hi = (long long)0 | ((long long)NPHASE << 32);
    hipLaunchKernelGGL(fwd, dim3(grid), dim3(512), LDS_BYTES, stream, p);
#else
    for (int ph = 0; ph < NPHASE; ++ph) {
        p.lo_hi = (long long)ph | ((long long)(ph + 1) << 32);
        hipLaunchKernelGGL(fwd, dim3(grid), dim3(512), LDS_BYTES, stream, p);
    }
#endif
}
```

```cpp
#include <hip/hip_runtime.h>
#include <cstdio>
#include <cstdint>

#ifndef N_LAUNCH_MODE
#define N_LAUNCH_MODE 1
#endif

constexpr int B_ = 8, S_ = 2048, D_ = 2048, T_ = B_ * S_;
constexpr int INW = 3608;
constexpr int C_Q = 0, C_KC = 1024, C_VC = 1280, C_KS = 1536, C_VS = 1792, C_KW = 2048, C_VW = 2304, C_G = 2560, C_UP = 2584, C_QM = 3096;
constexpr int NC = 127;
constexpr int CROWS = B_ * NC * 2;
constexpr int NE = 32, DE = 2048, NA = T_ * 4;
constexpr float LN_EPS = 1e-5f;
constexpr float DN_ALPHA = 1.189207115002721f;
constexpr float ATT_SCALE = 0.08838834764831845f;

constexpr size_t al256(size_t x) { return (x + 255) & ~(size_t)255; }
constexpr size_t WS_CTL = 0;
constexpr size_t CTL_BYTES = 65536;
constexpr size_t CTL_CNT = 16384;
constexpr size_t WS_PROJ = CTL_BYTES;
constexpr size_t WS_KVMEM = WS_PROJ + al256((size_t)T_ * INW * 4);
constexpr size_t WS_BIAS1 = WS_KVMEM + al256((size_t)2048 * 1024 * 4);
constexpr size_t WS_HID = WS_BIAS1 + al256(2 * 256 * 4);
constexpr size_t WS_KC = WS_HID + al256((size_t)2 * 2048 * 256 * 4);
constexpr size_t WS_VC = WS_KC + al256((size_t)CROWS * 128 * 4);
constexpr size_t WS_POOLED = WS_VC + al256((size_t)CROWS * 128 * 4);
constexpr size_t WS_OPOOL = WS_POOLED + al256((size_t)T_ * 512 * 4);
constexpr size_t WS_OWIN = WS_OPOOL + al256((size_t)T_ * 512 * 4);
constexpr size_t WS_OCMP = WS_OWIN + al256((size_t)T_ * 1024 * 4);
constexpr size_t WS_OSLC = WS_OCMP + al256((size_t)T_ * 1024 * 4);
constexpr size_t WS_SEL = WS_OSLC + al256((size_t)T_ * 1024 * 4);
constexpr size_t WS_OMEM = WS_SEL + al256((size_t)T_ * 2 * 4);
constexpr size_t WS_CAT16 = WS_OMEM + al256((size_t)T_ * 512 * 4);
constexpr size_t WS_HPRE = WS_CAT16 + al256((size_t)T_ * 2048 * 2);
constexpr size_t WS_H = WS_HPRE + al256((size_t)T_ * 2048 * 4);
constexpr size_t WS_H16 = WS_H + al256((size_t)T_ * 2048 * 4);
constexpr size_t WS_GATE = WS_H16 + al256((size_t)T_ * 2048 * 2);
constexpr size_t WS_LIST = WS_GATE + al256((size_t)NA * 4);
constexpr size_t WS_ACT16 = WS_LIST + al256((size_t)NE * T_ * 4);
constexpr size_t WS_Y16 = WS_ACT16 + al256((size_t)(NA + 256) * 2048 * 2);
constexpr size_t WS_X16 = WS_Y16 + al256((size_t)NA * 2048 * 2);
constexpr size_t WS_MEM16 = WS_X16 + (size_t)T_ * 2048 * 2;
constexpr size_t WS_WTIN = WS_MEM16 + al256((size_t)2048 * 2048 * 2);
constexpr size_t WS_WTOUT = WS_WTIN + al256((size_t)3840 * 2048 * 2);
constexpr size_t WS_WTGU = WS_WTOUT + al256((size_t)2048 * 2048 * 2);
constexpr size_t WS_WTDN = WS_WTGU + al256((size_t)NE * 4096 * 2048 * 2);
constexpr size_t WS_PROJ16 = WS_WTDN + al256((size_t)NE * 2048 * 2048 * 2);
constexpr size_t WS_KVMEM16 = WS_PROJ16 + al256((size_t)(T_ + 64) * INW * 2);
constexpr size_t WS_WT1 = WS_KVMEM16 + al256((size_t)2048 * 1024 * 2);
constexpr size_t WS_UV = WS_WT1 + al256((size_t)2 * 512 * 2048 * 2);
constexpr size_t WS_KC16 = WS_UV + al256((size_t)2 * 4 * 2048 * 512 * 4);
constexpr size_t WS_VC16 = WS_KC16 + al256((size_t)B_ * 128 * 256 * 2);
constexpr size_t WS_WR16 = WS_VC16 + al256((size_t)B_ * 128 * 256 * 2);
constexpr size_t WS_Q8GU = WS_WR16 + al256((size_t)32 * 2048 * 2);
constexpr size_t WS_Q8DN = WS_Q8GU + al256((size_t)NE * 4096 * 2048);
constexpr size_t WS_SGU = WS_Q8DN + al256((size_t)NE * 2048 * 2048);
constexpr size_t WS_SDN = WS_SGU + al256((size_t)NE * 4096 * 4);
constexpr size_t WS_H8 = WS_SDN + al256((size_t)NE * 2048 * 4);
constexpr size_t WS_SAH = WS_H8 + al256((size_t)T_ * 2048);
constexpr size_t WS_ACT8 = WS_SAH + al256((size_t)T_ * 4);
constexpr size_t WS_SACT = WS_ACT8 + al256((size_t)(NA + 256) * 2048);
constexpr size_t WS_WTMKV = WS_SACT + al256((size_t)(NA + 256) * 4);
constexpr size_t WS_KV16 = WS_WTMKV + al256((size_t)1024 * 2048 * 2);
constexpr size_t KVSEG = (size_t)S_ * 128;
constexpr size_t WS_END = WS_KV16 + al256((size_t)6 * B_ * 2 * S_ * 128 * 2);

constexpr int LDS_BYTES = 155648;

struct Params {
    const float* in[26];
    float* out;
    unsigned char* ws;
    long long lo_hi;
};
enum { I_X = 0, I_MEM, I_WIN, I_POSK, I_W1K, I_W2K, I_POSV, I_W1V, I_W2V, I_POOLW, I_POOLS, I_WMEMKV, I_GNNSA, I_GNPOOL, I_GNMEM, I_WOUT,
       I_LN1G, I_LN1B, I_WR, I_BR, I_WGU, I_BGU, I_WDN, I_BDN, I_LN2G, I_LN2B };

#define XB_TMO      128
#define XB_XCNT(j)  (256  + 64 * (j))
#define XB_XSUB(j)  (1280 + 64 * (j))
#define XB_XGEN(j)  (2304 + 64 * (j))
#define XB_TOP      3328
#define XB_TOPGEN   3392
#define XCD_BAR_WORDS 3456
#define XB_SPIN_CAP (1u << 25)
#define LAS __attribute__((address_space(3)))

__device__ __forceinline__ unsigned xb_ld(unsigned* p)              { return __hip_atomic_load(p, __ATOMIC_RELAXED, __HIP_MEMORY_SCOPE_AGENT); }
__device__ __forceinline__ unsigned xb_add(unsigned* p, unsigned v) { return __hip_atomic_fetch_add(p, v, __ATOMIC_RELAXED, __HIP_MEMORY_SCOPE_AGENT); }
__device__ __forceinline__ unsigned xb_xcc_id() { return (unsigned)__builtin_amdgcn_s_getreg((3 << 11) | 20) & 0xFu; }
#define XB_SPIN(cond, bar) do { unsigned _sp = 0; while (cond) { __builtin_amdgcn_s_sleep(1); \
    if ((++_sp & 255u) == 0u) { if (xb_ld(&(bar)[XB_TMO])) break; if (_sp > XB_SPIN_CAP) { atomicAdd(&(bar)[XB_TMO], 1u); break; } } } } while (0)

struct XcdBarrier { unsigned* bar; unsigned x; volatile LAS unsigned* st; };

__device__ __forceinline__ XcdBarrier xcd_barrier_post(unsigned* bar, volatile LAS unsigned* st) {
    XcdBarrier b; b.bar = bar; b.x = xb_xcc_id(); b.st = st;
    if (threadIdx.x == 0) (void)xb_add(&bar[XB_XCNT(b.x)], 1u);
    return b;
}
__device__ __forceinline__ void xcd_barrier_complete(unsigned* bar, unsigned x, unsigned& nloc, unsigned& nx) {
    const unsigned G = gridDim.x * gridDim.y * gridDim.z;
    unsigned sum, cnt, mine, sp = 0u;
    for (;;) {
        sum = 0u; cnt = 0u; mine = 0u;
#pragma unroll
        for (unsigned j = 0; j < 16; ++j) { const unsigned c = xb_ld(&bar[XB_XCNT(j)]); sum += c; cnt += (c > 0u) ? 1u : 0u; mine = (j == x) ? c : mine; }
        if (sum == G) break;
        __builtin_amdgcn_s_sleep(1);
        if ((++sp & 255u) == 0u) { if (xb_ld(&bar[XB_TMO])) break; if (sp > XB_SPIN_CAP) { atomicAdd(&bar[XB_TMO], 1u); break; } }
    }
    nloc = mine > 0u ? mine : 1u; nx = cnt > 0u ? cnt : 1u;
}
__device__ __forceinline__ void xcd_barrier(const XcdBarrier& b) {
    asm volatile("s_waitcnt vmcnt(0)" ::: "memory");
    __syncthreads();
    if (threadIdx.x == 0) {
        unsigned* bar = b.bar;
        __builtin_amdgcn_s_waitcnt(0);
        unsigned nloc = b.st[0], nx = b.st[1];
        if (nloc == 0u) { xcd_barrier_complete(bar, b.x, nloc, nx); b.st[0] = nloc; b.st[1] = nx; }
        const unsigned old = xb_add(&bar[XB_XSUB(b.x)], 1u);
        const unsigned gen = old / nloc;
        if (old + 1u == (gen + 1u) * nloc) {
            __builtin_amdgcn_fence(__ATOMIC_RELEASE, "agent");
            asm volatile("s_waitcnt vmcnt(0)" ::: "memory");
            const unsigned og = xb_add(&bar[XB_TOP], 1u);
            const unsigned tg = og / nx;
            if (og + 1u == (tg + 1u) * nx) xb_add(&bar[XB_TOPGEN], 1u);
            else XB_SPIN(xb_ld(&bar[XB_TOPGEN]) == tg, bar);
            __builtin_amdgcn_fence(__ATOMIC_ACQUIRE, "agent");
            xb_add(&bar[XB_XGEN(b.x)], 1u);
            asm volatile("s_waitcnt vmcnt(0)" ::: "memory");
        } else {
            XB_SPIN(xb_ld(&bar[XB_XGEN(b.x)]) == gen, bar);
            __builtin_amdgcn_fence(__ATOMIC_ACQUIRE, "agent");
            asm volatile("s_waitcnt vmcnt(0)" ::: "memory");
        }
    }
    __syncthreads();
}

typedef _Float16 h8 __attribute__((ext_vector_type(8)));
typedef _Float16 h4 __attribute__((ext_vector_type(4)));
typedef float f4 __attribute__((ext_vector_type(4)));

__device__ __forceinline__ float wave_sum(float v) {
#pragma unroll
    for (int o = 32; o > 0; o >>= 1) v += __shfl_xor(v, o);
    return v;
}
__device__ __forceinline__ float wave_max(float v) {
#pragma unroll
    for (int o = 32; o > 0; o >>= 1) v = fmaxf(v, __shfl_xor(v, o));
    return v;
}
__device__ __forceinline__ void wave_sync() {
    asm volatile("s_waitcnt lgkmcnt(0)" ::: "memory");
    __builtin_amdgcn_wave_barrier();
}
__device__ __forceinline__ float gelu_tanh(float x) {
    const float u = 0.7978845608028654f * (x + 0.044715f * x * x * x);
    return 0.5f * x * (1.f + tanhf(u));
}
__device__ __forceinline__ float sigmoidf_(float x) { return 1.f / (1.f + expf(-x)); }
__device__ __forceinline__ float swiglu_fast(float g, float l) { const float xg = fminf(g, 7.f), xl = fminf(fmaxf(l, -7.f), 7.f); return xg * __builtin_amdgcn_rcpf(1.f + __builtin_amdgcn_exp2f(-2.4554669595930156f * xg)) * (xl + 1.f); }

constexpr int G_LD = 40;
template <class AF, class EF>
__device__ __forceinline__ void gemm_tile(char* smem, int K, const AF& af, const float* __restrict__ Bm, int ldb, int n0, int Nlim, bool perm, const EF& ef) {
    _Float16* As = (_Float16*)smem;
    _Float16* Bs = As + 128 * G_LD;
    const int tid = threadIdx.x, lane = tid & 63, wid = tid >> 6, wr = wid >> 2, wc = wid & 3, fr = lane & 15, fq = lane >> 4;
    f4 acc[4][2];
#pragma unroll
    for (int m = 0; m < 4; ++m)
#pragma unroll
        for (int n = 0; n < 2; ++n) acc[m][n] = (f4){0.f, 0.f, 0.f, 0.f};
    const int ar = tid >> 3, ak = (tid & 7) * 4;
    const float* ap0 = af.row(ar);
    const float* ap1 = af.row(ar + 64);
    const int bk = tid >> 5, bn = (tid & 31) * 4;
    const bool bok = (n0 + bn) < Nlim;
    int bnp[4];
#pragma unroll
    for (int i = 0; i < 4; ++i) { const int c = bn + i; bnp[i] = perm ? ((c & ~31) | ((c & 1) << 4) | ((c & 31) >> 1)) : c; }
    for (int k0 = 0; k0 < K; k0 += 32) {
        const int ko = af.koff(k0 + ak);
        float4 a0 = make_float4(0.f, 0.f, 0.f, 0.f), a1 = a0, b0 = a0, b1 = a0;
        if (ap0) a0 = *(const float4*)(ap0 + ko);
        if (ap1) a1 = *(const float4*)(ap1 + ko);
        if (bok) { b0 = *(const float4*)(Bm + (size_t)(k0 + bk) * ldb + n0 + bn); b1 = *(const float4*)(Bm + (size_t)(k0 + bk + 16) * ldb + n0 + bn); }
        __syncthreads();
        *(h4*)&As[ar * G_LD + ak] = (h4){(_Float16)a0.x, (_Float16)a0.y, (_Float16)a0.z, (_Float16)a0.w};
        *(h4*)&As[(ar + 64) * G_LD + ak] = (h4){(_Float16)a1.x, (_Float16)a1.y, (_Float16)a1.z, (_Float16)a1.w};
        Bs[bnp[0] * G_LD + bk] = (_Float16)b0.x; Bs[bnp[1] * G_LD + bk] = (_Float16)b0.y; Bs[bnp[2] * G_LD + bk] = (_Float16)b0.z; Bs[bnp[3] * G_LD + bk] = (_Float16)b0.w;
        Bs[bnp[0] * G_LD + bk + 16] = (_Float16)b1.x; Bs[bnp[1] * G_LD + bk + 16] = (_Float16)b1.y; Bs[bnp[2] * G_LD + bk + 16] = (_Float16)b1.z; Bs[bnp[3] * G_LD + bk + 16] = (_Float16)b1.w;
        __syncthreads();
        h8 a[4], b[2];
#pragma unroll
        for (int m = 0; m < 4; ++m) a[m] = *(const h8*)&As[(wr * 64 + m * 16 + fr) * G_LD + fq * 8];
#pragma unroll
        for (int n = 0; n < 2; ++n) b[n] = *(const h8*)&Bs[(wc * 32 + n * 16 + fr) * G_LD + fq * 8];
#pragma unroll
        for (int m = 0; m < 4; ++m)
#pragma unroll
            for (int n = 0; n < 2; ++n) acc[m][n] = __builtin_amdgcn_mfma_f32_16x16x32_f16(a[m], b[n], acc[m][n], 0, 0, 0);
    }
    ef(acc, wr, wc, fr, fq);
    __syncthreads();
}

struct ARowPlain { const float* base; int ld; int m0; int mlim;
    __device__ __forceinline__ const float* row(int r) const { return (m0 + r) < mlim ? base + (size_t)(m0 + r) * ld : nullptr; }
    __device__ __forceinline__ int koff(int k) const { return k; } };
struct ARowCmp { const float* proj; int col; int m0;
    __device__ __forceinline__ const float* row(int r) const { const int g = m0 + r; if (g >= CROWS) return nullptr; const int kvh = g & 1, bc = g >> 1, b = bc / NC, c = bc % NC;
        return proj + (size_t)(b * S_ + 16 * c) * INW + col + kvh * 128; }
    __device__ __forceinline__ int koff(int k) const { return (k >> 7) * INW + (k & 127); } };
struct ARowList { const float* base; const int* list; int m0; int cnt; int shift;
    __device__ __forceinline__ const float* row(int r) const { if (m0 + r >= cnt) return nullptr; const int a = list[m0 + r]; return base + (size_t)(a >> shift) * 2048; }
    __device__ __forceinline__ int koff(int k) const { return k; } };

struct EpiStore { float* C; int ldc; int m0; int n0; int mlim; int nlim; _Float16* C16;
    __device__ __forceinline__ void operator()(const f4 (&acc)[4][2], int wr, int wc, int fr, int fq) const {
#pragma unroll
        for (int m = 0; m < 4; ++m)
#pragma unroll
            for (int n = 0; n < 2; ++n)
#pragma unroll
                for (int j = 0; j < 4; ++j) { const int r = m0 + wr * 64 + m * 16 + fq * 4 + j, c = n0 + wc * 32 + n * 16 + fr;
                    if (r < mlim && c < nlim) { C[(size_t)r * ldc + c] = acc[m][n][j]; if (C16) C16[(size_t)r * ldc + c] = (_Float16)acc[m][n][j]; } } } };
struct EpiPool { float* C; const float* scale; int m0; int g;
    __device__ __forceinline__ void operator()(const f4 (&acc)[4][2], int wr, int wc, int fr, int fq) const {
#pragma unroll
        for (int m = 0; m < 4; ++m)
#pragma unroll
            for (int n = 0; n < 2; ++n)
#pragma unroll
                for (int j = 0; j < 4; ++j) { const int r = m0 + wr * 64 + m * 16 + fq * 4 + j, c = g * 128 + wc * 32 + n * 16 + fr;
                    C[(size_t)r * 512 + c] = acc[m][n][j] * scale[c]; } } };
struct EpiHid { float* C; const float* bias; int m0; int n0;
    __device__ __forceinline__ void operator()(const f4 (&acc)[4][2], int wr, int wc, int fr, int fq) const {
#pragma unroll
        for (int m = 0; m < 4; ++m)
#pragma unroll
            for (int n = 0; n < 2; ++n)
#pragma unroll
                for (int j = 0; j < 4; ++j) { const int r = m0 + wr * 64 + m * 16 + fq * 4 + j, c = n0 + wc * 32 + n * 16 + fr;
                    if (r < CROWS) C[(size_t)r * 256 + c] = gelu_tanh(acc[m][n][j] + bias[c]); } } };
struct EpiOut { float* C; const float* x; int m0; int n0;
    __device__ __forceinline__ void operator()(const f4 (&acc)[4][2], int wr, int wc, int fr, int fq) const {
#pragma unroll
        for (int m = 0; m < 4; ++m)
#pragma unroll
            for (int n = 0; n < 2; ++n)
#pragma unroll
                for (int j = 0; j < 4; ++j) { const size_t o = (size_t)(m0 + wr * 64 + m * 16 + fq * 4 + j) * 2048 + n0 + wc * 32 + n * 16 + fr;
                    C[o] = DN_ALPHA * x[o] + acc[m][n][j]; } } };
struct EpiGu { float* act; const float* bgu; const int* list; int m0; int cnt; int n0;
    __device__ __forceinline__ void operator()(const f4 (&acc)[4][2], int wr, int wc, int fr, int fq) const {
        const int jc = (n0 + wc * 32) / 2 + fr;
        const float bg = bgu[2 * jc], bl = bgu[2 * jc + 1];
#pragma unroll
        for (int m = 0; m < 4; ++m)
#pragma unroll
            for (int j = 0; j < 4; ++j) { const int r = m0 + wr * 64 + m * 16 + fq * 4 + j;
                if (r < cnt) { const int a = list[r];
                    const float xg = fminf(acc[m][0][j] + bg, 7.f), xl = fminf(fmaxf(acc[m][1][j] + bl, -7.f), 7.f);
                    act[(size_t)a * 2048 + jc] = xg * sigmoidf_(1.702f * xg) * (xl + 1.f); } } } };
struct EpiDn { float* y; const float* bdn; const int* list; const float* gate; int m0; int cnt; int n0;
    __device__ __forceinline__ void operator()(const f4 (&acc)[4][2], int wr, int wc, int fr, int fq) const {
#pragma unroll
        for (int m = 0; m < 4; ++m)
#pragma unroll
            for (int j = 0; j < 4; ++j) { const int r = m0 + wr * 64 + m * 16 + fq * 4 + j;
                if (r < cnt) { const int a = list[r]; const float g = gate[a];
#pragma unroll
                    for (int n = 0; n < 2; ++n) { const int c = n0 + wc * 32 + n * 16 + fr; y[(size_t)a * 2048 + c] = (acc[m][n][j] + bdn[c]) * g; } } } } };

constexpr int WLDS_FLOATS = 4096 + 512 + 32;
template <bool SHARED>
__device__ __forceinline__ void wave_attn(float* sw, const float* __restrict__ qptr, const float* __restrict__ Kb, const float* __restrict__ Vb, int ld, int nseg, float scale, float* __restrict__ optr) {
    const int lane = threadIdx.x & 63;
    float* sq = sw + 4096; const int* segs = (const int*)(sw + 4096 + 512);
#pragma unroll
    for (int i = 0; i < 8; ++i) sq[lane + 64 * i] = qptr[lane + 64 * i];
    wave_sync();
    for (int sg = 0; sg < nseg; ++sg) {
        const int start = segs[sg], len = segs[16 + sg];
        float d0 = 0.f, d1 = 0.f, d2 = 0.f, d3 = 0.f;
        if (lane < len) {
            const float* kp = Kb + (size_t)(start + lane) * ld;
            for (int d4 = 0; d4 < 32; ++d4) {
                if (SHARED) {
                    const float4 kv = *(const float4*)(kp + d4 * 4);
                    const float4 q0 = *(const float4*)(sq + d4 * 4), q1 = *(const float4*)(sq + 128 + d4 * 4), q2 = *(const float4*)(sq + 256 + d4 * 4), q3 = *(const float4*)(sq + 384 + d4 * 4);
                    d0 += kv.x * q0.x + kv.y * q0.y + kv.z * q0.z + kv.w * q0.w;
                    d1 += kv.x * q1.x + kv.y * q1.y + kv.z * q1.z + kv.w * q1.w;
                    d2 += kv.x * q2.x + kv.y * q2.y + kv.z * q2.z + kv.w * q2.w;
                    d3 += kv.x * q3.x + kv.y * q3.y + kv.z * q3.z + kv.w * q3.w;
                } else {
                    const float4 k0 = *(const float4*)(kp + d4 * 4), k1 = *(const float4*)(kp + 128 + d4 * 4), k2 = *(const float4*)(kp + 256 + d4 * 4), k3 = *(const float4*)(kp + 384 + d4 * 4);
                    const float4 q0 = *(const float4*)(sq + d4 * 4), q1 = *(const float4*)(sq + 128 + d4 * 4), q2 = *(const float4*)(sq + 256 + d4 * 4), q3 = *(const float4*)(sq + 384 + d4 * 4);
                    d0 += k0.x * q0.x + k0.y * q0.y + k0.z * q0.z + k0.w * q0.w;
                    d1 += k1.x * q1.x + k1.y * q1.y + k1.z * q1.z + k1.w * q1.w;
                    d2 += k2.x * q2.x + k2.y * q2.y + k2.z * q2.z + k2.w * q2.w;
                    d3 += k3.x * q3.x + k3.y * q3.y + k3.z * q3.z + k3.w * q3.w;
                }
            }
        }
        const bool ok = lane < len;
        sw[sg * 64 + lane] = ok ? d0 * scale : -1e30f;
        sw[1024 + sg * 64 + lane] = ok ? d1 * scale : -1e30f;
        sw[2048 + sg * 64 + lane] = ok ? d2 * scale : -1e30f;
        sw[3072 + sg * 64 + lane] = ok ? d3 * scale : -1e30f;
    }
    wave_sync();
    const int n = nseg * 64;
#pragma unroll
    for (int g = 0; g < 4; ++g) {
        float mx = -1e30f;
        for (int i = lane; i < n; i += 64) mx = fmaxf(mx, sw[g * 1024 + i]);
        mx = wave_max(mx);
        float sm = 0.f;
        for (int i = lane; i < n; i += 64) { const float v = sw[g * 1024 + i]; sm += (v > -1e29f) ? expf(v - mx) : 0.f; }
        sm = wave_sum(sm);
        const float inv = sm > 0.f ? 1.f / sm : 0.f;
        for (int i = lane; i < n; i += 64) { const float v = sw[g * 1024 + i]; sw[g * 1024 + i] = (v > -1e29f) ? expf(v - mx) * inv : 0.f; }
    }
    wave_sync();
    float o[4][2];
#pragma unroll
    for (int g = 0; g < 4; ++g) { o[g][0] = 0.f; o[g][1] = 0.f; }
    for (int sg = 0; sg < nseg; ++sg) {
        const int start = segs[sg], len = segs[16 + sg];
        for (int l = 0; l < len; ++l) {
            const float* vp = Vb + (size_t)(start + l) * ld;
            if (SHARED) {
                const float v0 = vp[lane], v1 = vp[lane + 64];
#pragma unroll
                for (int g = 0; g < 4; ++g) { const float p = sw[g * 1024 + sg * 64 + l]; o[g][0] += p * v0; o[g][1] += p * v1; }
            } else {
#pragma unroll
                for (int g = 0; g < 4; ++g) { const float p = sw[g * 1024 + sg * 64 + l]; o[g][0] += p * vp[g * 128 + lane]; o[g][1] += p * vp[g * 128 + lane + 64]; }
            }
        }
    }
#pragma unroll
    for (int g = 0; g < 4; ++g) { optr[g * 128 + lane] = o[g][0]; optr[g * 128 + lane + 64] = o[g][1]; }
}

namespace g8 {
constexpr int BM = 256, BK = 64, HALF = 128, HTB = HALF * BK * 2, STAGE_BYTES = 8 * HTB;
constexpr int KK = 2048;
typedef float f32x4 __attribute__((ext_vector_type(4)));
__device__ __forceinline__ int lds_byte(int r, int c) { const int st = (r >> 4) * 2 + (c >> 5), rr = r & 15, cc = c & 31, ob = rr * 64 + cc * 2; return st * 1024 + (ob ^ (((ob >> 9) & 1) << 5)); }
__device__ __forceinline__ void stage_rc(int b, int& R, int& C) { const int st = b / 1024, sb = b % 1024, swz = sb ^ (((sb >> 9) & 1) << 5); R = (st >> 1) * 16 + swz / 64; C = (st & 1) * 32 + (swz % 64) / 2; }
__device__ __forceinline__ int perm32(int rho) { const int n = rho >> 4, i = rho & 15; return 8 * (i >> 2) + 4 * n + (i & 3); }

typedef int i32x4 __attribute__((ext_vector_type(4)));
template <bool I8> struct AccSel { typedef f32x4 T; };
template <> struct AccSel<true> { typedef i32x4 T; };
__device__ __forceinline__ f32x4 mma16(i32x4 a, i32x4 b, f32x4 c) { return __builtin_amdgcn_mfma_f32_16x16x32_f16(*reinterpret_cast<h8*>(&a), *reinterpret_cast<h8*>(&b), c, 0, 0, 0); }
__device__ __forceinline__ i32x4 mma16(i32x4 a, i32x4 b, i32x4 c) { return __builtin_amdgcn_mfma_i32_16x16x64_i8(a, b, c, 0, 0, 0); }
struct Unit { int m0, n0, e, cnt, rbase; };
constexpr int EP_OFF = STAGE_BYTES + 512, EP_LD = 528, EP_GRP = 16 * EP_LD;
__device__ __forceinline__ void ep_sync() { asm volatile("s_waitcnt lgkmcnt(0)" ::: "memory"); __builtin_amdgcn_s_barrier(); asm volatile("" ::: "memory"); }
__device__ __forceinline__ int ep_tid() { int tz = threadIdx.x; asm volatile("" : "+v"(tz)); return tz; }
__device__ __forceinline__ h8 cvt8(f32x4 a, f32x4 b) { h8 o; o[0] = (_Float16)a[0]; o[1] = (_Float16)a[1]; o[2] = (_Float16)a[2]; o[3] = (_Float16)a[3]; o[4] = (_Float16)b[0]; o[5] = (_Float16)b[1]; o[6] = (_Float16)b[2]; o[7] = (_Float16)b[3]; return o; }

__device__ __forceinline__ void tile_order(int L, int nM, int nN, int& pm, int& pn) {
    const int nwg = nM * nN; int wgid = L;
    { const int q = nwg / 8, r = nwg % 8, xcd = wgid % 8, off = wgid / 8; wgid = (xcd < r ? xcd * (q + 1) : r * (q + 1) + (xcd - r) * q) + off; }
    const int nig = 8 * nN, gid = wgid / nig, fm = gid * 8, gsz = (nM - fm) < 8 ? (nM - fm) : 8;
    pm = fm + ((wgid % nig) % gsz); pn = (wgid % nig) / gsz;
}

template <class Prob>
__device__ __forceinline__ void gemm_phase(LAS unsigned char* lds, const Prob& P) {
    const int tid = threadIdx.x, wid = __builtin_amdgcn_readfirstlane(tid >> 6), lane = tid & 63, wr = wid >> 2, wc = wid & 3, fr = lane & 15, fq = lane >> 4;
    constexpr int nt = Prob::NT; constexpr size_t KS2 = Prob::KS2; constexpr unsigned ROWB = Prob::ROWB; constexpr bool I8 = Prob::I8;
    int sR[2], sC2[2]; unsigned voffB[2];
#pragma unroll
    for (int i = 0; i < 2; ++i) { int R, C; stage_rc(tid * 16 + i * 8192, R, C); sR[i] = R; sC2[i] = C * 2; const int Rb = Prob::PERM ? ((R & ~31) + perm32(R & 31)) : R; voffB[i] = (unsigned)Rb * ROWB + (unsigned)C * 2u; }
    const size_t kstep = (size_t)(BK * 2);
    const size_t hstep = (size_t)HALF * ROWB;
    const unsigned ldsw = (unsigned)wid * 1024u;
    const int aoff = lds_byte(wr * 64 + fr, fq * 8), boff = lds_byte(wc * 32 + fr, fq * 8);
#define G8_SA(b, h) (((b) * 2 + (h)) * HTB)
#define G8_SB(b, h) ((4 + (b) * 2 + (h)) * HTB)
#define G8_STAGE(bufoff, gbase, voff) do { _Pragma("unroll") for (int _i = 0; _i < 2; ++_i) \
        __builtin_amdgcn_global_load_lds((const unsigned*)((const char*)(gbase) + (voff)[_i]), (LAS unsigned*)(lds + (bufoff) + ldsw + _i * 8192), 16, 0, 0); } while (0)
#define G8_LDA(dst, b, h) do { _Pragma("unroll") for (int m = 0; m < 4; ++m) _Pragma("unroll") for (int k = 0; k < 2; ++k) dst[m][k] = *(const LAS i32x4*)(lds + G8_SA(b, h) + aoff + m * 2048 + k * 1024); } while (0)
#define G8_LDB(dst, b, h) do { _Pragma("unroll") for (int n = 0; n < 2; ++n) _Pragma("unroll") for (int k = 0; k < 2; ++k) dst[n][k] = *(const LAS i32x4*)(lds + G8_SB(b, h) + boff + n * 2048 + k * 1024); } while (0)
#define G8_MMA(ai, bj, At, Bt) do { __builtin_amdgcn_s_setprio(1); _Pragma("unroll") for (int m = 0; m < 4; ++m) _Pragma("unroll") for (int n = 0; n < 2; ++n) _Pragma("unroll") for (int k = 0; k < 2; ++k) \
        acc[ai][bj][m][n] = mma16(Bt[n][k], At[m][k], acc[ai][bj][m][n]); __builtin_amdgcn_s_setprio(0); } while (0)
#define G8_WAIT_V(n) asm volatile("s_waitcnt vmcnt(" #n ")" ::: "memory")
#define G8_WAIT_L(n) asm volatile("s_waitcnt lgkmcnt(" #n ")" ::: "memory")
#define G8_BAR __builtin_amdgcn_s_barrier()
#define G8_SCHED __builtin_amdgcn_sched_barrier(0)
    Unit cur, nxt; int ui = 0;
    if (!P.next(0, cur)) return;
    typedef typename AccSel<I8>::T AccT;
    AccT acc[2][2][4][2];
#pragma unroll
    for (int a = 0; a < 2; ++a)
#pragma unroll
        for (int b = 0; b < 2; ++b)
#pragma unroll
            for (int m = 0; m < 4; ++m)
#pragma unroll
                for (int n = 0; n < 2; ++n) acc[a][b][m][n] = AccT{};
    i32x4 At[4][2], B0[2][2], B1[2][2];
    unsigned vc[2][2], vn[2][2];
    P.a_offs(cur, sR, sC2, vc);
    const char* const Ab = P.a_base();
    const char* cB = P.b_base(cur);
    G8_STAGE(G8_SB(0, 0), cB, voffB); G8_STAGE(G8_SA(0, 0), Ab, vc[0]); G8_STAGE(G8_SB(0, 1), cB + hstep, voffB); G8_STAGE(G8_SA(0, 1), Ab, vc[1]);
    if (wr == 1) G8_BAR;
    G8_WAIT_V(4); G8_BAR;
    G8_STAGE(G8_SB(1, 0), cB + kstep, voffB); G8_STAGE(G8_SA(1, 0), Ab + kstep, vc[0]); G8_STAGE(G8_SB(1, 1), cB + hstep + kstep, voffB);
    G8_WAIT_V(6); G8_BAR;
    for (;;) {
        const bool has_next = P.next(ui + 1, nxt);
        const char* nB = cB;
        if (has_next) { P.a_offs(nxt, sR, sC2, vn); nB = P.b_base(nxt); }
        else { vn[0][0] = vc[0][0]; vn[0][1] = vc[0][1]; vn[1][0] = vc[1][0]; vn[1][1] = vc[1][1]; }
        for (int t = 0; t < nt; t += 2) {
            const bool last = (t == nt - 2);
            const char* a1 = Ab + (size_t)(t >> 1) * KS2 + kstep;
            const char* a2 = last ? Ab : Ab + (size_t)((t + 2) >> 1) * KS2; const char* b2 = last ? nB : cB + (size_t)(t + 2) * kstep;
            const char* a3 = a2 + kstep; const char* b3 = b2 + kstep;
            unsigned o2[2][2];
            o2[0][0] = last ? vn[0][0] : vc[0][0]; o2[0][1] = last ? vn[0][1] : vc[0][1]; o2[1][0] = last ? vn[1][0] : vc[1][0]; o2[1][1] = last ? vn[1][1] : vc[1][1];
            G8_LDB(B0, 0, 0); G8_SCHED; G8_LDA(At, 0, 0); G8_STAGE(G8_SA(1, 1), a1, vc[1]);
            G8_WAIT_L(8); G8_BAR; G8_WAIT_L(0); G8_MMA(0, 0, At, B0); G8_BAR; G8_SCHED;
            G8_LDB(B1, 0, 1); G8_STAGE(G8_SB(0, 0), b2, voffB);
            G8_BAR; G8_WAIT_L(0); G8_MMA(0, 1, At, B1); G8_BAR;
            G8_LDA(At, 0, 1); G8_STAGE(G8_SA(0, 0), a2, o2[0]);
            G8_BAR; G8_WAIT_L(0); G8_MMA(1, 0, At, B0); G8_BAR; G8_SCHED;
            G8_STAGE(G8_SB(0, 1), b2 + hstep, voffB);
            G8_WAIT_V(6); G8_BAR; G8_MMA(1, 1, At, B1); G8_BAR;
            G8_LDB(B0, 1, 0); G8_SCHED; G8_LDA(At, 1, 0); G8_STAGE(G8_SA(0, 1), a2, o2[1]);
            G8_WAIT_L(8); G8_BAR; G8_WAIT_L(0); G8_MMA(0, 0, At, B0); G8_BAR; G8_SCHED;
            G8_LDB(B1, 1, 1); G8_STAGE(G8_SB(1, 0), b3, voffB);
            G8_BAR; G8_WAIT_L(0); G8_MMA(0, 1, At, B1); G8_BAR;
            G8_LDA(At, 1, 1); G8_STAGE(G8_SA(1, 0), a3, o2[0]);
            G8_BAR; G8_WAIT_L(0); G8_MMA(1, 0, At, B0); G8_BAR; G8_SCHED;
            G8_STAGE(G8_SB(1, 1), b3 + hstep, voffB);
            G8_WAIT_V(6); G8_BAR; G8_MMA(1, 1, At, B1); G8_BAR;
        }
        P.epi(acc, cur, wr, wc, fr, fq, lds);
        if (!has_next) break;
#pragma unroll
        for (int a = 0; a < 2; ++a)
#pragma unroll
            for (int b = 0; b < 2; ++b)
#pragma unroll
                for (int m = 0; m < 4; ++m)
#pragma unroll
                    for (int n = 0; n < 2; ++n) acc[a][b][m][n] = AccT{};
        cur = nxt; cB = nB; ++ui;
        vc[0][0] = vn[0][0]; vc[0][1] = vn[0][1]; vc[1][0] = vn[1][0]; vc[1][1] = vn[1][1];
    }
    G8_WAIT_V(0);
    if (wr == 0) G8_BAR;
    G8_BAR;
#undef G8_SA
#undef G8_SB
#undef G8_STAGE
#undef G8_LDA
#undef G8_LDB
#undef G8_MMA
#undef G8_WAIT_V
#undef G8_WAIT_L
#undef G8_BAR
#undef G8_SCHED
}

struct ProbIn {
    static constexpr unsigned ROWB = 4096; static constexpr bool I8 = false;
    static constexpr int NT = 32; static constexpr size_t KS2 = 256;
    static constexpr bool PERM = true;
    const _Float16* A; _Float16* C16; int G, c;
    __device__ __forceinline__ bool next(int i, Unit& u) const { const int L = i * G + c; if (L >= 64 * 15 + 32) return false;
        if (L < 64 * 15) { int pm, pn; tile_order(L, 64, 15, pm, pn); u.m0 = pm * 256; u.n0 = pn * 256; u.e = 0; }
        else { const int v = L - 64 * 15; u.m0 = T_ + (v & 7) * 256; u.n0 = (v >> 3) * 256; u.e = 1; }
        u.cnt = 256; u.rbase = 0; return true; }
    __device__ __forceinline__ void a_offs(const Unit& u, const int (&R)[2], const int (&C2)[2], unsigned (&v)[2][2]) const {
#pragma unroll
        for (int h = 0; h < 2; ++h)
#pragma unroll
            for (int i = 0; i < 2; ++i) v[h][i] = (unsigned)(u.m0 + h * 128 + R[i]) * (unsigned)(KK * 2) + (unsigned)C2[i]; }
    __device__ __forceinline__ const char* a_base() const { return (const char*)A; }
    __device__ __forceinline__ const char* b_base(const Unit& u) const { return (const char*)A + (u.e ? (long long)(WS_WTMKV - WS_X16) : (long long)(WS_WTIN - WS_X16)) + (size_t)u.n0 * KK * 2; }
    __device__ __forceinline__ void epi(const f32x4 (&acc)[2][2][4][2], const Unit& u, int wr, int wc, int fr, int fq, LAS unsigned char* lds) const {
        LAS unsigned char* ep = lds + EP_OFF + wr * EP_GRP;
        const int tg = ep_tid() & 255, rrow = tg >> 4, ch = tg & 15;
        const int kvseg = (u.e == 0 && u.n0 >= 1024 && u.n0 < 2560) ? ((u.n0 - 1024) >> 8) : -1;
        _Float16* const Cb = (_Float16*)((char*)C16 + (u.e ? (long long)(WS_KVMEM16 - WS_PROJ16) : 0ll)); const int ldc = u.e ? 1024 : INW, nlim = u.e ? 1024 : INW, mb = u.e ? u.m0 - T_ : u.m0;
#pragma unroll
        for (int ai = 0; ai < 2; ++ai)
#pragma unroll
            for (int m = 0; m < 4; ++m) {
#pragma unroll
                for (int bj = 0; bj < 2; ++bj) *(LAS h8*)(ep + fr * EP_LD + (bj * 128 + wc * 32 + fq * 8) * 2) = cvt8(acc[ai][bj][m][0], acc[ai][bj][m][1]);
                ep_sync();
                const h8 x0 = *(const LAS h8*)(ep + rrow * EP_LD + ch * 32), x1 = *(const LAS h8*)(ep + rrow * EP_LD + ch * 32 + 16);
                const int grow = mb + ai * 128 + wr * 64 + m * 16 + rrow, gcol = u.n0 + ch * 16;
                if (kvseg >= 0) {
                    _Float16* dst = (_Float16*)((char*)C16 + (long long)(WS_KV16 - WS_PROJ16)) + ((size_t)(kvseg * B_ + (grow >> 11)) * 2 + (ch >> 3)) * KVSEG + (size_t)(grow & (S_ - 1)) * 128 + (ch & 7) * 16;
                    *(h8*)dst = x0; *(h8*)(dst + 8) = x1;
                } else {
                    if (gcol < nlim) *(h8*)(Cb + (size_t)grow * ldc + gcol) = x0;
                    if (gcol + 8 < nlim) *(h8*)(Cb + (size_t)grow * ldc + gcol + 8) = x1; }
                ep_sync();
            } }
};
struct ProbOut {
    static constexpr unsigned ROWB = 4096; static constexpr bool I8 = false;
    static constexpr int NT = 32; static constexpr size_t KS2 = 256;
    static constexpr bool PERM = true;
    const _Float16* A; const _Float16* Bt; _Float16* C; const _Float16* X; int G, c;
    __device__ __forceinline__ bool next(int i, Unit& u) const { const int L = i * G + c; if (L >= 64 * 8) return false; int pm, pn; tile_order(L, 64, 8, pm, pn); u.m0 = pm * 256; u.n0 = pn * 256; u.e = 0; u.cnt = 256; u.rbase = 0; return true; }
    __device__ __forceinline__ void a_offs(const Unit& u, const int (&R)[2], const int (&C2)[2], unsigned (&v)[2][2]) const {
#pragma unroll
        for (int h = 0; h < 2; ++h)
#pragma unroll
            for (int i = 0; i < 2; ++i) v[h][i] = (unsigned)(u.m0 + h * 128 + R[i]) * (unsigned)(KK * 2) + (unsigned)C2[i]; }
    __device__ __forceinline__ const char* a_base() const { return (const char*)A; }
    __device__ __forceinline__ const char* b_base(const Unit& u) const { return (const char*)(Bt + (size_t)u.n0 * KK); }
    __device__ __forceinline__ void epi(const f32x4 (&acc)[2][2][4][2], const Unit& u, int wr, int wc, int fr, int fq, LAS unsigned char* lds) const {
        LAS unsigned char* ep = lds + EP_OFF + wr * EP_GRP;
        const int tg = ep_tid() & 255, rrow = tg >> 4, ch = tg & 15;
#pragma unroll
        for (int ai = 0; ai < 2; ++ai)
#pragma unroll
            for (int m = 0; m < 4; ++m) {
#pragma unroll
                for (int bj = 0; bj < 2; ++bj) *(LAS h8*)(ep + fr * EP_LD + (bj * 128 + wc * 32 + fq * 8) * 2) = cvt8(acc[ai][bj][m][0], acc[ai][bj][m][1]);
                const size_t go = (size_t)(u.m0 + ai * 128 + wr * 64 + m * 16 + rrow) * 2048 + u.n0 + ch * 16;
                const h8 r0 = *(const h8*)(X + go), r1 = *(const h8*)(X + go + 8);
                ep_sync();
                const h8 x0 = *(const LAS h8*)(ep + rrow * EP_LD + ch * 32), x1 = *(const LAS h8*)(ep + rrow * EP_LD + ch * 32 + 16);
                h8 o0, o1;
#pragma unroll
                for (int q = 0; q < 8; ++q) { o0[q] = (_Float16)(DN_ALPHA * (float)r0[q] + (float)x0[q]); o1[q] = (_Float16)(DN_ALPHA * (float)r1[q] + (float)x1[q]); }
                *(h8*)(C + go) = o0; *(h8*)(C + go + 8) = o1;
                ep_sync();
            } }
};
struct ProbCmp {
    static constexpr unsigned ROWB = 4096; static constexpr bool I8 = false;
    static constexpr int NT = 8; static constexpr size_t KS2 = 256;
    static constexpr bool PERM = false;
    const _Float16* A; const _Float16* Bt; float* C; int G, c;
    __device__ __forceinline__ bool next(int i, Unit& u) const { const int L = i * G + c; if (L >= 128) return false;
        u.e = L >> 6; const int r = L & 63; u.rbase = r & 3; u.n0 = ((r >> 2) & 1) * 256; u.m0 = (r >> 3) * 256; u.cnt = 256; return true; }
    __device__ __forceinline__ void a_offs(const Unit& u, const int (&R)[2], const int (&C2)[2], unsigned (&v)[2][2]) const {
#pragma unroll
        for (int h = 0; h < 2; ++h)
#pragma unroll
            for (int i = 0; i < 2; ++i) { const int row = u.m0 + h * 128 + R[i], kvh = row & 1, bj = row >> 1, b = bj >> 7, j = bj & 127;
                v[h][i] = (unsigned)((((u.e * B_ + b) * 2 + kvh) * S_ + 16 * j + 4 * u.rbase) * 128) * 2u + (unsigned)C2[i]; } }
    __device__ __forceinline__ const char* a_base() const { return (const char*)A; }
    __device__ __forceinline__ const char* b_base(const Unit& u) const { return (const char*)(Bt + ((size_t)u.e * 512 + u.n0) * KK + u.rbase * 512); }
    __device__ __forceinline__ void epi(const f32x4 (&acc)[2][2][4][2], const Unit& u, int wr, int wc, int fr, int fq, LAS unsigned char*) const {
        float* base = C + ((size_t)(u.e * 4 + u.rbase) * 2048) * 512;
#pragma unroll
        for (int ai = 0; ai < 2; ++ai)
#pragma unroll
            for (int m = 0; m < 4; ++m) { const int row = u.m0 + ai * 128 + wr * 64 + m * 16 + fr;
#pragma unroll
                for (int bj = 0; bj < 2; ++bj)
#pragma unroll
                    for (int n = 0; n < 2; ++n) { const int col = u.n0 + bj * 128 + wc * 32 + n * 16 + fq * 4;
                        *(f32x4*)(base + (size_t)row * 512 + col) = acc[ai][bj][m][n]; } } }
};
struct MoeTab { const LAS int* t; int NT;
    __device__ __forceinline__ bool find(int L, Unit& u) const {
        const int total = __builtin_amdgcn_readfirstlane(t[98]); if (L >= total) return false;
        int e = 0;
        for (; e < NE - 1; ++e) { if (L < __builtin_amdgcn_readfirstlane(t[32 + e + 1])) break; }
        const int ub = __builtin_amdgcn_readfirstlane(t[32 + e]), cn = __builtin_amdgcn_readfirstlane(t[e]), rs = __builtin_amdgcn_readfirstlane(t[65 + e]);
        const int nm = (cn + 255) >> 8, v = L - ub, mt = v % nm, ntile = v / nm;
        u.e = e; u.m0 = mt * 256; u.n0 = ntile * 256; u.cnt = min(256, cn - mt * 256); u.rbase = rs; return true; } };
struct ProbGu {
    static constexpr int NT = 16; static constexpr size_t KS2 = 256; static constexpr unsigned ROWB = 2048; static constexpr bool I8 = true;
    static constexpr bool PERM = true;
    const signed char* A; const signed char* Bt; _Float16* act; const float* bgu; const int* list; const float* sa; const float* sw; MoeTab tab; int G, vcu;
    __device__ __forceinline__ bool next(int i, Unit& u) const { return tab.find(i * G + vcu, u); }
    __device__ __forceinline__ void a_offs(const Unit& u, const int (&R)[2], const int (&C2)[2], unsigned (&v)[2][2]) const {
#pragma unroll
        for (int h = 0; h < 2; ++h)
#pragma unroll
            for (int i = 0; i < 2; ++i) { int r = h * 128 + R[i]; r = r < u.cnt ? r : 0; const int a = list[(size_t)u.e * T_ + u.m0 + r]; v[h][i] = (unsigned)(a >> 2) * 2048u + (unsigned)C2[i]; } }
    __device__ __forceinline__ const char* a_base() const { return (const char*)A; }
    __device__ __forceinline__ const char* b_base(const Unit& u) const { return (const char*)(Bt + ((size_t)u.e * 4096 + u.n0) * 2048); }
    __device__ __forceinline__ void epi(const i32x4 (&acc)[2][2][4][2], const Unit& u, int wr, int wc, int fr, int fq, LAS unsigned char* lds) const {
        const float* bb = bgu + (size_t)u.e * 4096; const float* ss = sw + (size_t)u.e * 4096;
        LAS unsigned char* ep = lds + EP_OFF + wr * EP_GRP;
        const int tg = ep_tid() & 255, rrow = tg >> 4, ch = tg & 15;
        f32x4 b0[2], b1[2], s0[2], s1[2];
#pragma unroll
        for (int bj = 0; bj < 2; ++bj) { const int col = u.n0 + bj * 128 + wc * 32 + fq * 8;
            b0[bj] = *(const f32x4*)(bb + col); b1[bj] = *(const f32x4*)(bb + col + 4); s0[bj] = *(const f32x4*)(ss + col); s1[bj] = *(const f32x4*)(ss + col + 4); }
        float srv[8];
        { int av[8];
#pragma unroll
          for (int q = 0; q < 8; ++q) { const int rl = (q >> 2) * 128 + wr * 64 + (q & 3) * 16 + fr; av[q] = list[(size_t)u.e * T_ + u.m0 + (rl < u.cnt ? rl : 0)]; }
#pragma unroll
          for (int q = 0; q < 8; ++q) srv[q] = sa[av[q] >> 2]; }
#pragma unroll
        for (int ai = 0; ai < 2; ++ai)
#pragma unroll
            for (int m = 0; m < 4; ++m) { const float sr = srv[ai * 4 + m];
#pragma unroll
                for (int bj = 0; bj < 2; ++bj) {
                    const i32x4 i0 = acc[ai][bj][m][0], i1 = acc[ai][bj][m][1];
                    const f32x4 v0 = (f32x4){(float)i0[0], (float)i0[1], (float)i0[2], (float)i0[3]} * (s0[bj] * sr) + b0[bj], v1 = (f32x4){(float)i1[0], (float)i1[1], (float)i1[2], (float)i1[3]} * (s1[bj] * sr) + b1[bj];
                    h4 o;
                    o[0] = (_Float16)swiglu_fast(v0[0], v0[1]);
                    o[1] = (_Float16)swiglu_fast(v0[2], v0[3]);
                    o[2] = (_Float16)swiglu_fast(v1[0], v1[1]);
                    o[3] = (_Float16)swiglu_fast(v1[2], v1[3]);
                    *(LAS h4*)(ep + fr * EP_LD + (bj * 64 + wc * 16 + fq * 4) * 2) = o; }
                ep_sync();
                const h8 x0 = *(const LAS h8*)(ep + rrow * EP_LD + ch * 16);
                const int rr = ai * 128 + wr * 64 + m * 16 + rrow;
                if (rr < u.cnt) *(h8*)(act + (size_t)(u.rbase + u.m0 + rr) * 2048 + (u.n0 >> 1) + ch * 8) = x0;
                ep_sync();
            } }
};
struct ProbDn {
    static constexpr int NT = 16; static constexpr size_t KS2 = 256; static constexpr unsigned ROWB = 2048; static constexpr bool I8 = true;
    static constexpr bool PERM = true;
    const signed char* A; const signed char* Bt; _Float16* y; const float* bdn; const int* list; const float* gate; const float* sa; const float* sw; MoeTab tab; int G, vcu;
    __device__ __forceinline__ bool next(int i, Unit& u) const { return tab.find(i * G + vcu, u); }
    __device__ __forceinline__ void a_offs(const Unit& u, const int (&R)[2], const int (&C2)[2], unsigned (&v)[2][2]) const {
#pragma unroll
        for (int h = 0; h < 2; ++h)
#pragma unroll
            for (int i = 0; i < 2; ++i) v[h][i] = (unsigned)(u.rbase + u.m0 + h * 128 + R[i]) * 2048u + (unsigned)C2[i]; }
    __device__ __forceinline__ const char* a_base() const { return (const char*)A; }
    __device__ __forceinline__ const char* b_base(const Unit& u) const { return (const char*)(Bt + ((size_t)u.e * 2048 + u.n0) * 2048); }
    __device__ __forceinline__ void epi(const i32x4 (&acc)[2][2][4][2], const Unit& u, int wr, int wc, int fr, int fq, LAS unsigned char* lds) const {
        const float* bb = bdn + (size_t)u.e * 2048; const float* ss = sw + (size_t)u.e * 2048;
        LAS unsigned char* ep = lds + EP_OFF + wr * EP_GRP;
        const int tg = ep_tid() & 255, rrow = tg >> 4, ch = tg & 15;
        f32x4 b0[2], b1[2], s0[2], s1[2];
#pragma unroll
        for (int bj = 0; bj < 2; ++bj) { const int col = u.n0 + bj * 128 + wc * 32 + fq * 8;
            b0[bj] = *(const f32x4*)(bb + col); b1[bj] = *(const f32x4*)(bb + col + 4); s0[bj] = *(const f32x4*)(ss + col); s1[bj] = *(const f32x4*)(ss + col + 4); }
        float gv[8], srv[8]; int a2v[8];
        { int av[8];
#pragma unroll
          for (int q = 0; q < 8; ++q) { const int rl = (q >> 2) * 128 + wr * 64 + (q & 3) * 16 + fr, rc = rl < u.cnt ? rl : 0; av[q] = list[(size_t)u.e * T_ + u.m0 + rc]; srv[q] = sa[u.rbase + u.m0 + rc];
              const int rr = (q >> 2) * 128 + wr * 64 + (q & 3) * 16 + rrow; a2v[q] = list[(size_t)u.e * T_ + u.m0 + (rr < u.cnt ? rr : 0)]; }
#pragma unroll
          for (int q = 0; q < 8; ++q) gv[q] = gate[av[q]]; }
#pragma unroll
        for (int ai = 0; ai < 2; ++ai)
#pragma unroll
            for (int m = 0; m < 4; ++m) { const float g = gv[ai * 4 + m], sr = srv[ai * 4 + m];
#pragma unroll
                for (int bj = 0; bj < 2; ++bj) {
                    const i32x4 i0 = acc[ai][bj][m][0], i1 = acc[ai][bj][m][1];
                    const f32x4 v0 = ((f32x4){(float)i0[0], (float)i0[1], (float)i0[2], (float)i0[3]} * (s0[bj] * sr) + b0[bj]) * g, v1 = ((f32x4){(float)i1[0], (float)i1[1], (float)i1[2], (float)i1[3]} * (s1[bj] * sr) + b1[bj]) * g;
                    *(LAS h8*)(ep + fr * EP_LD + (bj * 128 + wc * 32 + fq * 8) * 2) = cvt8(v0, v1); }
                const int rr = ai * 128 + wr * 64 + m * 16 + rrow;
                const int a2 = a2v[ai * 4 + m];
                ep_sync();
                const h8 x0 = *(const LAS h8*)(ep + rrow * EP_LD + ch * 32), x1 = *(const LAS h8*)(ep + rrow * EP_LD + ch * 32 + 16);
                if (rr < u.cnt) { *(h8*)(y + (size_t)a2 * 2048 + u.n0 + ch * 16) = x0; *(h8*)(y + (size_t)a2 * 2048 + u.n0 + ch * 16 + 8) = x1; }
                ep_sync();
            } }
};
}

namespace at8 {
typedef float f32x16 __attribute__((ext_vector_type(16)));
typedef short s16x4 __attribute__((ext_vector_type(4)));
typedef unsigned u32x4 __attribute__((ext_vector_type(4)));
constexpr int SHM_V = 64 * 128 * 2, SHM_K = 64 * 128 * 2;
constexpr int LDS_WS = 2 * SHM_V + 2 * SHM_K;
constexpr int LDS_END = LDS_WS + 8 * 64 * 4;
constexpr float CEXP = ATT_SCALE * 1.4426950408889634f;
constexpr float THR_RAW = 8.f / ATT_SCALE;
#define AT_KSWZ(row, colB) ((row) * 256 + ((colB) ^ (((row) & 7) << 4)))
#define AT_SBAR() __builtin_amdgcn_sched_barrier(0)
__device__ __forceinline__ int crow(int r, int hi) { return (r & 3) + 8 * (r >> 2) + 4 * hi; }
__device__ __forceinline__ unsigned cvtpk(float lo, float hi) { auto v = __builtin_amdgcn_cvt_pkrtz(lo, hi); return *reinterpret_cast<unsigned*>(&v); }
__device__ __forceinline__ int v_st(int k, int c) { const int kk = (k & ~0xC) | ((k & 4) << 1) | ((k & 8) >> 1); return ((kk >> 3) * 4 + (c >> 5)) * 512 + ((kk & 7) * 32 + (c & 31)) * 2; }
__device__ __forceinline__ int v_rd_base(int lane) { return ((lane & 3) << 3) | (((lane >> 2) & 3) << 6) | (((lane >> 4) & 1) << 5) | (((lane >> 5) & 1) << 8); }
constexpr int v_rd_off(int d0, int ks, int half) { return d0 * 512 + ks * 4096 + half * 2048; }
template <int OFF> __device__ __forceinline__ s16x4 tr_read(int vb) { s16x4 r; asm volatile("ds_read_b64_tr_b16 %0, %1 offset:%2" : "=&v"(r) : "v"(vb), "i"(OFF) : "memory"); return r; }
__device__ __forceinline__ h8 mk8(s16x4 l, s16x4 h) { typedef short s16x8 __attribute__((ext_vector_type(8))); s16x8 w = {l[0], l[1], l[2], l[3], h[0], h[1], h[2], h[3]}; return *reinterpret_cast<h8*>(&w); }
template <int D0> __device__ __forceinline__ void pv_one(f32x16& od, int vb, h8 pa0, h8 pa1, h8 pa2, h8 pa3) {
    const s16x4 l0 = tr_read<v_rd_off(D0, 0, 0)>(vb), h0 = tr_read<v_rd_off(D0, 0, 1)>(vb), l1 = tr_read<v_rd_off(D0, 1, 0)>(vb), h1 = tr_read<v_rd_off(D0, 1, 1)>(vb);
    const s16x4 l2 = tr_read<v_rd_off(D0, 2, 0)>(vb), h2 = tr_read<v_rd_off(D0, 2, 1)>(vb), l3 = tr_read<v_rd_off(D0, 3, 0)>(vb), h3 = tr_read<v_rd_off(D0, 3, 1)>(vb);
    asm volatile("s_waitcnt lgkmcnt(0)" ::: "memory"); AT_SBAR();
    od = __builtin_amdgcn_mfma_f32_32x32x16_f16(pa0, mk8(l0, h0), od, 0, 0, 0);
    od = __builtin_amdgcn_mfma_f32_32x32x16_f16(pa1, mk8(l1, h1), od, 0, 0, 0);
    od = __builtin_amdgcn_mfma_f32_32x32x16_f16(pa2, mk8(l2, h2), od, 0, 0, 0);
    od = __builtin_amdgcn_mfma_f32_32x32x16_f16(pa3, mk8(l3, h3), od, 0, 0, 0);
}
__device__ __forceinline__ void pv_d0(f32x16 (&o)[4], int vb, h8 pa0, h8 pa1, h8 pa2, h8 pa3) {
    pv_one<0>(o[0], vb, pa0, pa1, pa2, pa3); pv_one<1>(o[1], vb, pa0, pa1, pa2, pa3); pv_one<2>(o[2], vb, pa0, pa1, pa2, pa3); pv_one<3>(o[3], vb, pa0, pa1, pa2, pa3);
}
__device__ __forceinline__ void qkt(f32x16& p0, f32x16& p1, const char* Ks, const h8 (&qr)[8], int r32, int hi) {
    p0 = f32x16{}; p1 = f32x16{};
#pragma unroll
    for (int d0 = 0; d0 < 8; ++d0) { const int cb = (d0 * 16 + hi * 8) * 2;
        const h8 b0 = *reinterpret_cast<const h8*>(Ks + AT_KSWZ(r32, cb));
        const h8 b1 = *reinterpret_cast<const h8*>(Ks + AT_KSWZ(32 + r32, cb));
        p0 = __builtin_amdgcn_mfma_f32_32x32x16_f16(b0, qr[d0], p0, 0, 0, 0);
        p1 = __builtin_amdgcn_mfma_f32_32x32x16_f16(b1, qr[d0], p1, 0, 0, 0); }
}
__device__ __forceinline__ void pack_p(const f32x16& p0, const f32x16& p1, h8& pa0, h8& pa1, h8& pa2, h8& pa3) {
#define AT_PK4(P, BASE, OUT) do { unsigned a0 = cvtpk(P[BASE + 0], P[BASE + 1]), a1 = cvtpk(P[BASE + 2], P[BASE + 3]); \
    unsigned b0 = cvtpk(P[BASE + 4], P[BASE + 5]), b1 = cvtpk(P[BASE + 6], P[BASE + 7]); \
    auto r0 = __builtin_amdgcn_permlane32_swap(a0, b0, false, false); auto r1 = __builtin_amdgcn_permlane32_swap(a1, b1, false, false); \
    u32x4 w = {r0[0], r1[0], r0[1], r1[1]}; OUT = *reinterpret_cast<h8*>(&w); } while (0)
    AT_PK4(p0, 0, pa0); AT_PK4(p0, 8, pa1); AT_PK4(p1, 0, pa2); AT_PK4(p1, 8, pa3);
#undef AT_PK4
}
__device__ __forceinline__ float half_swap_max(float v) { auto rr = __builtin_amdgcn_permlane32_swap(__float_as_uint(v), __float_as_uint(v), false, false); return fmaxf(__uint_as_float(rr[0]), __uint_as_float(rr[1])); }
__device__ __forceinline__ float half_swap_sum(float v) { auto rr = __builtin_amdgcn_permlane32_swap(__float_as_uint(v), __float_as_uint(v), false, false); return __uint_as_float(rr[0]) + __uint_as_float(rr[1]); }

struct Stage4 { h8 vs0, vs1, ks0, ks1; };
__device__ __forceinline__ int hidden_tid() { int tz = threadIdx.x; asm volatile("" : "+v"(tz)); return tz; }
__device__ __forceinline__ void sload(Stage4& s, const _Float16* Kb, const _Float16* Vb, int ld, int k0) {
    const int tz = hidden_tid(), sr = tz >> 4, sc = (tz & 15) * 8;
    s.vs0 = *(const h8*)(Vb + (size_t)(k0 + sr) * ld + sc); s.vs1 = *(const h8*)(Vb + (size_t)(k0 + 32 + sr) * ld + sc);
    s.ks0 = *(const h8*)(Kb + (size_t)(k0 + sr) * ld + sc); s.ks1 = *(const h8*)(Kb + (size_t)(k0 + 32 + sr) * ld + sc);
}
__device__ __forceinline__ void swrite(const Stage4& s, char* V_lds, char* K_lds, int b) {
    const int tz = hidden_tid(), sr = tz >> 4, sc = (tz & 15) * 8, vst0 = v_st(sr, sc), vst1 = v_st(32 + sr, sc);
    *(h8*)(V_lds + b * SHM_V + vst0) = s.vs0; *(h8*)(V_lds + b * SHM_V + vst1) = s.vs1;
    const int kc = sc * 2;
    *(h8*)(K_lds + b * SHM_K + AT_KSWZ(sr, kc)) = s.ks0; *(h8*)(K_lds + b * SHM_K + AT_KSWZ(32 + sr, kc)) = s.ks1;
}

__device__ __forceinline__ void attn_unit(char* lds, const _Float16* qrow, const _Float16* Kb, const _Float16* Vb, int ld, unsigned tmask, int wlen, int khi, unsigned selmask,
                                          float* outw, int ostride) {
    const int tid = threadIdx.x, wid = __builtin_amdgcn_readfirstlane(tid >> 6), lane = tid & 63, r32 = lane & 31, hi = lane >> 5;
    char* V_lds = lds; char* K_lds = lds + 2 * SHM_V;
    float* wsf = (float*)(lds + LDS_WS) + wid * 64; float* li_l = wsf; float* al_l = wsf + 32;
    float m_reg = -1e30f, l_reg = 0.f; f32x16 o[4] = {}; h8 qr[8];
#pragma unroll
    for (int d0 = 0; d0 < 8; ++d0) qr[d0] = *(const h8*)(qrow + d0 * 16);
    const int vb0 = (int)(uintptr_t)V_lds + v_rd_base(lane);
    Stage4 st;
    unsigned rest = tmask; int j = __ffs(rest) - 1; rest &= rest - 1;
    sload(st, Kb, Vb, ld, j * 64); asm volatile("s_waitcnt vmcnt(0)" ::: "memory"); swrite(st, V_lds, K_lds, 0); __syncthreads();
    int buf = 0;
    for (;;) {
        const int jn = rest ? (__ffs(rest) - 1) : -1;
        if (jn >= 0) sload(st, Kb, Vb, ld, jn * 64);
        f32x16 p0, p1;
        AT_SBAR(); qkt(p0, p1, K_lds + buf * SHM_K, qr, r32, hi);
        { const int klo = wlen > 0 ? khi - wlen + 1 : 0; const bool tb = (selmask >> j) & 1u; const bool inr = (j * 64 >= klo) && (j * 64 + 63 <= khi);
          if (!__all(tb && inr)) {
              if (__all(inr)) {
#pragma unroll
                  for (int r = 0; r < 16; ++r) { p0[r] = tb ? p0[r] : -INFINITY; p1[r] = tb ? p1[r] : -INFINITY; }
              } else {
                  const int kb = j * 64 + 4 * hi;
#pragma unroll
                  for (int r = 0; r < 16; ++r) { const int k0 = kb + (r & 3) + 8 * (r >> 2);
                      p0[r] = (tb && k0 >= klo && k0 <= khi) ? p0[r] : -INFINITY;
                      p1[r] = (tb && (k0 + 32) >= klo && (k0 + 32) <= khi) ? p1[r] : -INFINITY; }
              } } }
        float pmax = p0[0];
#pragma unroll
        for (int r = 1; r < 16; ++r) pmax = fmaxf(pmax, p0[r]);
#pragma unroll
        for (int r = 0; r < 16; ++r) pmax = fmaxf(pmax, p1[r]);
        pmax = half_swap_max(pmax);
        float mn, alpha;
        if (__all(pmax - m_reg <= THR_RAW)) { mn = m_reg; alpha = 1.f; }
        else { mn = fmaxf(m_reg, pmax); alpha = __builtin_amdgcn_exp2f((m_reg - mn) * CEXP); m_reg = mn; }
        const float mnC = -mn * CEXP;
        float ps = 0.f;
#pragma unroll
        for (int r = 0; r < 16; ++r) { p0[r] = __builtin_amdgcn_exp2f(fmaf(p0[r], CEXP, mnC)); ps += p0[r]; }
#pragma unroll
        for (int r = 0; r < 16; ++r) { p1[r] = __builtin_amdgcn_exp2f(fmaf(p1[r], CEXP, mnC)); ps += p1[r]; }
        ps = half_swap_sum(ps);
        l_reg = l_reg * alpha + ps;
        if (__any(alpha < 1.f)) { if (hi == 0) al_l[r32] = alpha; asm volatile("s_waitcnt lgkmcnt(0)" ::: "memory");
#pragma unroll
            for (int r = 0; r < 16; ++r) { const float a = al_l[crow(r, hi)];
#pragma unroll
                for (int d = 0; d < 4; ++d) o[d][r] *= a; } }
        h8 pa0, pa1, pa2, pa3; pack_p(p0, p1, pa0, pa1, pa2, pa3);
        AT_SBAR();
        pv_d0(o, vb0 + buf * SHM_V, pa0, pa1, pa2, pa3);
        if (jn < 0) break;
        asm volatile("s_waitcnt vmcnt(0)" ::: "memory");
        swrite(st, V_lds, K_lds, buf ^ 1);
        __syncthreads();
        buf ^= 1; j = jn; rest &= rest - 1;
    }
    if (hi == 0) li_l[r32] = l_reg; asm volatile("s_waitcnt lgkmcnt(0)" ::: "memory");
#pragma unroll
    for (int r = 0; r < 16; ++r) { const int orow = crow(r, hi); const float l = li_l[orow]; const float rl = l > 0.f ? 1.f / l : 0.f;
#pragma unroll
        for (int d0 = 0; d0 < 4; ++d0) outw[(size_t)orow * ostride + d0 * 32 + r32] = o[d0][r] * rl; }
    __syncthreads();
}

constexpr int LDS_AP = LDS_END, LDS_BP = LDS_AP + 4 * 64 * 33 * 4, LDS_SELM = LDS_BP + 4 * 64 * 33 * 4, LDS_CS_END = LDS_SELM + 64 * 4;
__device__ __forceinline__ void cmp_slc_unit(char* lds, const _Float16* qrow, const _Float16* Kc, const _Float16* Vc, const _Float16* Ks, const _Float16* Vs, int t, int tl, int g, int qi,
                                             float* outc, float* outs) {
    const int tid = threadIdx.x, wid = __builtin_amdgcn_readfirstlane(tid >> 6), lane = tid & 63, r32 = lane & 31, hi = lane >> 5;
    char* V_lds = lds; char* K_lds = lds + 2 * SHM_V;
    float* AP = (float*)(lds + LDS_AP); float* BP = (float*)(lds + LDS_BP); unsigned* selm = (unsigned*)(lds + LDS_SELM);
    {
        h8 qr[8];
#pragma unroll
        for (int d0 = 0; d0 < 8; ++d0) qr[d0] = *(const h8*)(qrow + d0 * 16);
        const int vb0 = (int)(uintptr_t)V_lds + v_rd_base(lane);
        { Stage4 s0, s1; sload(s0, Kc, Vc, 256, 0); sload(s1, Kc, Vc, 256, 64);
          asm volatile("s_waitcnt vmcnt(0)" ::: "memory");
          swrite(s0, V_lds, K_lds, 0); swrite(s1, V_lds, K_lds, 1); }
        __syncthreads();
        f32x16 pA0, pA1, pB0, pB1;
        AT_SBAR(); qkt(pA0, pA1, K_lds, qr, r32, hi); qkt(pB0, pB1, K_lds + SHM_K, qr, r32, hi);
        const int khi = t >= 31 ? ((t - 31) >> 4) : -1;
#pragma unroll
        for (int r = 0; r < 16; ++r) { const int c0 = 4 * hi + (r & 3) + 8 * (r >> 2);
            pA0[r] = (c0 <= khi) ? pA0[r] : -INFINITY; pA1[r] = (c0 + 32 <= khi) ? pA1[r] : -INFINITY;
            pB0[r] = (c0 + 64 <= khi) ? pB0[r] : -INFINITY; pB1[r] = (c0 + 96 <= khi) ? pB1[r] : -INFINITY; }
        float pmax = -INFINITY;
#pragma unroll
        for (int r = 0; r < 16; ++r) pmax = fmaxf(fmaxf(pmax, pA0[r]), fmaxf(pA1[r], fmaxf(pB0[r], pB1[r])));
        pmax = half_swap_max(pmax);
        const float mC = (pmax == -INFINITY) ? 0.f : -pmax * CEXP;
        float ps = 0.f;
#pragma unroll
        for (int r = 0; r < 16; ++r) { pA0[r] = __builtin_amdgcn_exp2f(fmaf(pA0[r], CEXP, mC)); pA1[r] = __builtin_amdgcn_exp2f(fmaf(pA1[r], CEXP, mC));
            pB0[r] = __builtin_amdgcn_exp2f(fmaf(pB0[r], CEXP, mC)); pB1[r] = __builtin_amdgcn_exp2f(fmaf(pB1[r], CEXP, mC)); ps += (pA0[r] + pA1[r]) + (pB0[r] + pB1[r]); }
        ps = half_swap_sum(ps);
        const float inv = ps > 0.f ? 1.f / ps : 0.f;
#pragma unroll
        for (int r = 0; r < 16; ++r) { pA0[r] *= inv; pA1[r] *= inv; pB0[r] *= inv; pB1[r] *= inv; }
        { float* ap = AP + (g * 64 + tl) * 33; float* bp = BP + (g * 64 + tl) * 33;
          if (hi == 0) bp[0] = 0.f;
#define AT_IMP(P, JB) do { _Pragma("unroll") for (int k = 0; k < 4; ++k) { const int j = (JB) + 2 * k + hi; \
              ap[j] = 2.f * (P[4 * k] + P[4 * k + 1] + P[4 * k + 2]) + P[4 * k + 3]; if (j + 1 < 32) bp[j + 1] = P[4 * k + 3]; } } while (0)
          AT_IMP(pA0, 0); AT_IMP(pA1, 8); AT_IMP(pB0, 16); AT_IMP(pB1, 24);
#undef AT_IMP
        }
        f32x16 o[4] = {};
        h8 pa0, pa1, pa2, pa3;
        pack_p(pA0, pA1, pa0, pa1, pa2, pa3); AT_SBAR(); pv_d0(o, vb0, pa0, pa1, pa2, pa3);
        pack_p(pB0, pB1, pa0, pa1, pa2, pa3); AT_SBAR(); pv_d0(o, vb0 + SHM_V, pa0, pa1, pa2, pa3);
#pragma unroll
        for (int r = 0; r < 16; ++r) { const int orow = crow(r, hi);
#pragma unroll
            for (int d0 = 0; d0 < 4; ++d0) outc[(size_t)orow * 1024 + d0 * 32 + r32] = o[d0][r]; }
    }
    __syncthreads();
#pragma unroll 1
    for (int it = 0; it < 4; ++it) {
        const int tk = 8 * wid + 2 * it + hi, j = r32;
        float imp = 0.f;
#pragma unroll
        for (int gg = 0; gg < 4; ++gg) imp += AP[(gg * 64 + tk) * 33 + j] + BP[(gg * 64 + tk) * 33 + j];
        const bool forced = (j == 0) || (j == qi) || (j == qi - 1), valid = j <= qi;
        const float iv = forced ? 1e9f : (valid ? imp : -1e9f);
        int rank = 0;
        for (int i = 0; i < 32; ++i) { const float vi = __shfl(iv, i + 32 * hi); rank += (vi > iv || (vi == iv && i < j)) ? 1 : 0; }
        const unsigned long long bal = __ballot(rank < 16 && valid);
        if (r32 == 0) selm[tk] = (unsigned)(bal >> (32 * hi));
    }
    __syncthreads();
    unsigned tm = selm[lane];
#pragma unroll
    for (int o = 32; o > 0; o >>= 1) tm |= __shfl_xor(tm, o);
    const int tz2 = hidden_tid();
    const unsigned mysel = selm[((tz2 >> 6) & 1) * 32 + (tz2 & 31)];
    attn_unit(lds, qrow, Ks, Vs, 128, tm, 0, t, mysel, outs, 1024);
}
}

__device__ __forceinline__ void conv_tile(float* lds, const float* __restrict__ W, int ldw, int nvalid, _Float16* __restrict__ Wt, int K, int k0, int n0) {
    const int tid = threadIdx.x;
    float4 v[8];
#pragma unroll
    for (int i = 0; i < 8; ++i) { const int idx = tid + 512 * i, r = idx >> 6, c4 = (idx & 63) * 4;
        v[i] = (n0 + c4 < nvalid) ? *(const float4*)(W + (size_t)(k0 + r) * ldw + n0 + c4) : make_float4(0.f, 0.f, 0.f, 0.f); }
#pragma unroll
    for (int i = 0; i < 8; ++i) { const int idx = tid + 512 * i, r = idx >> 6, c4 = (idx & 63) * 4; float* d = lds + r * 257 + c4; d[0] = v[i].x; d[1] = v[i].y; d[2] = v[i].z; d[3] = v[i].w; }
    __syncthreads();
#pragma unroll
    for (int j = 0; j < 4; ++j) { const int id = tid + 512 * j, n = id >> 3, k8 = (id & 7) * 8; h8 o;
#pragma unroll
        for (int q = 0; q < 8; ++q) o[q] = (_Float16)lds[(k8 + q) * 257 + n];
        *(h8*)(Wt + (size_t)(n0 + n) * K + k0 + k8) = o; }
    __syncthreads();
}


__device__ __forceinline__ unsigned pack4_i8(float a, float b, float c, float d) {
    const int ia = __float2int_rn(a), ib = __float2int_rn(b), ic = __float2int_rn(c), id = __float2int_rn(d);
    return (unsigned)(ia & 255) | ((unsigned)(ib & 255) << 8) | ((unsigned)(ic & 255) << 16) | ((unsigned)(id & 255) << 24);
}
constexpr int QP_LD2 = 1026;
struct QUnit { const float* W; int ldw; int n0; signed char* Q; float* sc; };
__device__ __forceinline__ QUnit quant_desc(int u, const float* wgu, const float* wdn, signed char* q8gu, signed char* q8dn, float* sgu, float* sdn) {
    QUnit d;
    if (u < NE * 128) { const int e = u >> 7, pn = u & 127; d.W = wgu + (size_t)e * 2048 * 4096; d.ldw = 4096; d.n0 = pn * 32; d.Q = q8gu + (size_t)e * 4096 * 2048; d.sc = sgu + (size_t)e * 4096; }
    else { const int v = u - NE * 128, e = v >> 6, pn = v & 63; d.W = wdn + (size_t)e * 2048 * 2048; d.ldw = 2048; d.n0 = pn * 32; d.Q = q8dn + (size_t)e * 2048 * 2048; d.sc = sdn + (size_t)e * 2048; }
    return d;
}
__device__ __forceinline__ unsigned pk2h(float a, float b) { auto v = __builtin_amdgcn_cvt_pkrtz(a, b); return *reinterpret_cast<unsigned*>(&v); }
__device__ __forceinline__ void quant_all(char* smem, const float* wgu, const float* wdn, signed char* q8gu, signed char* q8dn, float* sgu, float* sdn, int bid, int nb) {
    constexpr int NU = NE * 128 + NE * 64;
    unsigned* Tt = (unsigned*)smem;
    unsigned* cmaxb = (unsigned*)(smem + 32 * QP_LD2 * 4);
    const int tid = threadIdx.x, c4 = (tid & 7) * 4, kp = tid >> 3;
    if (tid < 64) cmaxb[tid] = 0u;
    __syncthreads();
    int u = bid; if (u >= NU) return;
    QUnit d = quant_desc(u, wgu, wdn, q8gu, q8dn, sgu, sdn);
    float4 va[8], vb[8];
#define QL(dst, D, bt) do { _Pragma("unroll") for (int j = 0; j < 4; ++j) { const float* p0 = (D).W + (size_t)(((bt) * 4 + j) * 128 + 2 * kp) * (D).ldw + (D).n0 + c4; dst[2 * j] = *(const float4*)p0; dst[2 * j + 1] = *(const float4*)(p0 + (D).ldw); } } while (0)
#define QP(src, bt) do { _Pragma("unroll") for (int j = 0; j < 4; ++j) { const int kg = ((bt) * 4 + j) * 64 + kp; const float4 r0 = src[2 * j], r1 = src[2 * j + 1]; \
        Tt[(c4 + 0) * QP_LD2 + kg] = pk2h(r0.x, r1.x); Tt[(c4 + 1) * QP_LD2 + kg] = pk2h(r0.y, r1.y); Tt[(c4 + 2) * QP_LD2 + kg] = pk2h(r0.z, r1.z); Tt[(c4 + 3) * QP_LD2 + kg] = pk2h(r0.w, r1.w); \
        m0 = fmaxf(m0, fmaxf(fabsf(r0.x), fabsf(r1.x))); m1 = fmaxf(m1, fmaxf(fabsf(r0.y), fabsf(r1.y))); m2 = fmaxf(m2, fmaxf(fabsf(r0.z), fabsf(r1.z))); m3 = fmaxf(m3, fmaxf(fabsf(r0.w), fabsf(r1.w))); } } while (0)
    QL(va, d, 0);
    int par = 0;
    for (;;) {
        unsigned* cmax = cmaxb + par * 32;
        float m0 = 0.f, m1 = 0.f, m2 = 0.f, m3 = 0.f;
        QL(vb, d, 1); QP(va, 0);
        QL(va, d, 2); QP(vb, 1);
        QL(vb, d, 3); QP(va, 2);
        const int un = u + nb; const bool has = un < NU;
        QUnit dn = d; if (has) { dn = quant_desc(un, wgu, wdn, q8gu, q8dn, sgu, sdn); QL(va, dn, 0); }
        QP(vb, 3);
        atomicMax(&cmax[c4 + 0], __float_as_uint(m0)); atomicMax(&cmax[c4 + 1], __float_as_uint(m1)); atomicMax(&cmax[c4 + 2], __float_as_uint(m2)); atomicMax(&cmax[c4 + 3], __float_as_uint(m3));
        __syncthreads();
        if (tid < 32) cmaxb[(par ^ 1) * 32 + tid] = 0u;
#pragma unroll
        for (int j = 0; j < 8; ++j) { const int id = tid + 512 * j, n = id >> 7, k16 = (id & 127) * 16;
            const float mx = __uint_as_float(cmax[n]); const float inv = mx > 0.f ? 127.f / mx : 0.f;
            const h4* src = (const h4*)(Tt + n * QP_LD2 + (k16 >> 1));
            const h4 a = src[0], b = src[1], c = src[2], e4 = src[3];
            uint4 o;
            o.x = pack4_i8((float)a[0] * inv, (float)a[1] * inv, (float)a[2] * inv, (float)a[3] * inv); o.y = pack4_i8((float)b[0] * inv, (float)b[1] * inv, (float)b[2] * inv, (float)b[3] * inv);
            o.z = pack4_i8((float)c[0] * inv, (float)c[1] * inv, (float)c[2] * inv, (float)c[3] * inv); o.w = pack4_i8((float)e4[0] * inv, (float)e4[1] * inv, (float)e4[2] * inv, (float)e4[3] * inv);
            *(uint4*)(d.Q + (size_t)(d.n0 + n) * 2048 + k16) = o; }
        if (tid < 32) { const float mx = __uint_as_float(cmax[tid]); d.sc[d.n0 + tid] = mx > 0.f ? mx / 127.f : 1.f; }
        __syncthreads();
        if (!has) break;
        u = un; d = dn; par ^= 1;
    }
#undef QL
#undef QP
}

__global__ void __launch_bounds__(512, 2) fwd(Params p) {
    extern __shared__ __attribute__((aligned(16))) char smem[];
    const int tid = threadIdx.x, wv = __builtin_amdgcn_readfirstlane(tid >> 6);
#define LANE_NOW ({ int _t = threadIdx.x; asm volatile("" : "+v"(_t)); _t & 63; })
    const int bid = blockIdx.x, nb = gridDim.x;
    const int gw = bid * 8 + wv, nw = nb * 8;
    const int lo = (int)(p.lo_hi & 0xffffffffll), hi = (int)(p.lo_hi >> 32);
    unsigned char* ws = p.ws;
    unsigned* ctl = (unsigned*)(ws + WS_CTL);
    int* cnt = (int*)(ws + CTL_CNT);
    float* proj = (float*)(ws + WS_PROJ);
    float* kvmem = (float*)(ws + WS_KVMEM);
    float* bias1 = (float*)(ws + WS_BIAS1);
    float* hid = (float*)(ws + WS_HID);
    float* kc = (float*)(ws + WS_KC);
    float* vc = (float*)(ws + WS_VC);
    float* pooled = (float*)(ws + WS_POOLED);
    float* opool = (float*)(ws + WS_OPOOL);
    float* owin = (float*)(ws + WS_OWIN);
    float* ocmp = (float*)(ws + WS_OCMP);
    float* oslc = (float*)(ws + WS_OSLC);
    unsigned* sel = (unsigned*)(ws + WS_SEL);
    float* omem = (float*)(ws + WS_OMEM);
    _Float16* cat16 = (_Float16*)(ws + WS_CAT16);
    _Float16* hpre16 = (_Float16*)(ws + WS_HPRE);
    float* hbuf = (float*)(ws + WS_H);
    float* gate = (float*)(ws + WS_GATE);
    int* list = (int*)(ws + WS_LIST);
    _Float16* act16 = (_Float16*)(ws + WS_ACT16);
    _Float16* y16 = (_Float16*)(ws + WS_Y16);
    _Float16* h16 = (_Float16*)(ws + WS_H16);
    _Float16* x16 = (_Float16*)(ws + WS_X16);
    _Float16* wtin = (_Float16*)(ws + WS_WTIN);
    _Float16* wtout = (_Float16*)(ws + WS_WTOUT);
    _Float16* wtgu = (_Float16*)(ws + WS_WTGU);
    _Float16* wtdn = (_Float16*)(ws + WS_WTDN);
    LAS unsigned char* lds = (LAS unsigned char*)smem;
    _Float16* proj16 = (_Float16*)(ws + WS_PROJ16);
    _Float16* kvmem16 = (_Float16*)(ws + WS_KVMEM16);
    _Float16* wt1 = (_Float16*)(ws + WS_WT1);
    float* uv = (float*)(ws + WS_UV);
    _Float16* kc16 = (_Float16*)(ws + WS_KC16);
    _Float16* vc16 = (_Float16*)(ws + WS_VC16);
    _Float16* wr16 = (_Float16*)(ws + WS_WR16);
    _Float16* mem16 = (_Float16*)(ws + WS_MEM16);
    _Float16* wtmkv = (_Float16*)(ws + WS_WTMKV);
    _Float16* kv16 = (_Float16*)(ws + WS_KV16);
    signed char* q8gu = (signed char*)(ws + WS_Q8GU); signed char* q8dn = (signed char*)(ws + WS_Q8DN);
    float* sgu = (float*)(ws + WS_SGU); float* sdn = (float*)(ws + WS_SDN);
    signed char* h8q = (signed char*)(ws + WS_H8); float* sah = (float*)(ws + WS_SAH);
    signed char* act8 = (signed char*)(ws + WS_ACT8); float* sact = (float*)(ws + WS_SACT);
    const int vcu = (nb % 8 == 0) ? (bid % 8) * (nb / 8) + bid / 8 : bid;

    volatile LAS unsigned* xbw = (volatile LAS unsigned*)(smem + LDS_BYTES - 16);
    if (tid == 0) { xbw[0] = 0u; xbw[1] = 0u; xbw[2] = 0u; xbw[3] = 0u; }
    __syncthreads();
    XcdBarrier bar; bar.bar = ctl; bar.x = 0; bar.st = xbw;
    const bool multi = (hi - lo) > 1;
    if (multi) bar = xcd_barrier_post(ctl, xbw);
#define IN(k) (lo <= (k) && (k) < hi)
#define SEAM(k) do { if (IN(k) && IN((k) + 1)) xcd_barrier(bar); } while (0)
    float* sw = (float*)smem + wv * WLDS_FLOATS;
    int* segw = (int*)(sw + 4096 + 512);

    if (IN(0)) {
        const int lane = LANE_NOW; (void)lane;
        for (int j = gw; j < 512; j += nw) {
            const int kv = j >> 8, jj = j & 255;
            const float* pos = p.in[kv ? I_POSV : I_POSK]; const float* w1 = p.in[kv ? I_W1V : I_W1K];
            float s = 0.f;
            for (int k = lane; k < 4096; k += 64) s += pos[k] * w1[(size_t)k * 256 + jj];
            s = wave_sum(s);
            if (lane == 0) bias1[j] = s;
        }
        for (int i = bid * 512 + tid; i < 32 * 2048; i += nb * 512) { const int e = i >> 11, d = i & 2047; wr16[i] = (_Float16)p.in[I_WR][(size_t)d * 32 + e]; }
        for (size_t i = (size_t)bid * 512 + tid; i < (size_t)T_ * 2048 / 4; i += (size_t)nb * 512) {
            const float4 v = ((const float4*)p.in[I_X])[i]; ((h4*)x16)[i] = (h4){(_Float16)v.x, (_Float16)v.y, (_Float16)v.z, (_Float16)v.w};
        }
        {
            constexpr int U_IN = 32 * 15, U_OUT = 32 * 8, U_W1 = 128;
            quant_all(smem, p.in[I_WGU], p.in[I_WDN], q8gu, q8dn, sgu, sdn, bid, nb);
            __syncthreads();
            for (int u = bid; u < U_IN + U_OUT + U_W1; u += nb) {
                if (u < U_IN) { const int v = u, kt = v / 15, ntl = v % 15;
                    conv_tile((float*)smem, p.in[I_WIN], INW, INW, wtin, 2048, kt * 64, ntl * 256);
                } else if (u < U_IN + U_OUT) { const int v = u - U_IN, kt = v / 8, ntl = v % 8;
                    conv_tile((float*)smem, p.in[I_WOUT], 2048, 2048, wtout, 2048, kt * 64, ntl * 256);
                } else { const int v = u - U_IN - U_OUT, kv = v >> 6, part = (v >> 5) & 1, kt = v & 31;
                    conv_tile((float*)smem, p.in[kv ? I_W1V : I_W1K] + (size_t)part * 2048 * 256, 256, 256, wt1 + ((size_t)kv * 512 + part * 256) * 2048, 2048, kt * 64, 0);
                }
            }
        }
        for (size_t i = (size_t)bid * 512 + tid; i < (size_t)2048 * 2048 / 4; i += (size_t)nb * 512) {
            const float4 v = ((const float4*)p.in[I_MEM])[i]; ((h4*)mem16)[i] = (h4){(_Float16)v.x, (_Float16)v.y, (_Float16)v.z, (_Float16)v.w};
        }
        for (int u = bid; u < 128; u += nb) { const int kt = u >> 2, ntl = u & 3; conv_tile((float*)smem, p.in[I_WMEMKV], 1024, 1024, wtmkv, 2048, kt * 64, ntl * 256); }
    }
    SEAM(0);
    if (IN(1)) {
        const int lane = LANE_NOW; (void)lane;
        g8::ProbIn P{x16, proj16, nb, bid};
        g8::gemm_phase(lds, P);
    }
    SEAM(1);
    if (IN(2)) {
        const int lane = LANE_NOW; (void)lane;
        { g8::ProbCmp P{kv16, wt1, uv, nb, bid}; g8::gemm_phase(lds, P); __syncthreads(); }
        for (int i = bid * 512 + tid; i < T_ * 64; i += nb * 512) {
            const int chn = i & 63, row = i >> 6, t = row & (S_ - 1), g = chn >> 4;
            const int win = 2 << g, n = min(win, t + 1);
            const _Float16* src = proj16 + (size_t)row * INW + C_UP + chn * 8;
            float a[8];
            const h8 cur = *(const h8*)src;
#pragma unroll
            for (int q = 0; q < 8; ++q) a[q] = (float)cur[q];
            for (int k = 1; k < n; ++k) { const h8 v = *(const h8*)(src - (size_t)k * INW);
#pragma unroll
                for (int q = 0; q < 8; ++q) a[q] += (float)v[q]; }
            const float rn = 1.f / (float)n;
            float4 o0, o1;
            o0.x = a[0] * rn - (float)cur[0]; o0.y = a[1] * rn - (float)cur[1]; o0.z = a[2] * rn - (float)cur[2]; o0.w = a[3] * rn - (float)cur[3];
            o1.x = a[4] * rn - (float)cur[4]; o1.y = a[5] * rn - (float)cur[5]; o1.z = a[6] * rn - (float)cur[6]; o1.w = a[7] * rn - (float)cur[7];
            *(float4*)(pooled + (size_t)row * 512 + chn * 8) = o0; *(float4*)(pooled + (size_t)row * 512 + chn * 8 + 4) = o1;
        }
        {
            const int r32 = lane & 31, hi = lane >> 5, g = wv >> 1, half = wv & 1;
            for (int uu = vcu; uu < 512; uu += nb) {
                const int v = uu & 255, bk = v >> 4, qi = (uu >> 8) ? 31 - (v & 15) : (v & 15), b = bk >> 1, kvh = bk & 1;
                const int t = qi * 64 + half * 32 + r32;
                const int lo_t = max(0, qi - 8);
                const unsigned tmask = (unsigned)(((1ull << (qi + 1)) - 1ull) & ~((1ull << lo_t) - 1ull));
                at8::attn_unit(smem, proj16 + (size_t)(b * S_ + t) * INW + C_Q + (kvh * 4 + g) * 128 + hi * 8,
                               kv16 + ((size_t)(4 * B_ + b) * 2 + kvh) * KVSEG, kv16 + ((size_t)(5 * B_ + b) * 2 + kvh) * KVSEG, 128, tmask, 512, t, 0xffffffffu,
                               owin + (size_t)(b * S_ + qi * 64 + half * 32) * 1024 + (kvh * 4 + g) * 128, 1024);
            }
            for (int u = vcu; u < 256; u += nb) {
                const int b = u >> 5, h = (u >> 3) & 3, qt = u & 7;
                const int t = qt * 256 + wv * 32 + r32;
                at8::attn_unit(smem, proj16 + (size_t)(b * S_ + t) * INW + C_QM + h * 128 + hi * 8,
                               kvmem16 + (size_t)b * 256 * 1024 + h * 128, kvmem16 + (size_t)b * 256 * 1024 + 512 + h * 128, 1024, 0xFu, 0, 255, 0xffffffffu,
                               omem + (size_t)(b * S_ + qt * 256 + wv * 32) * 512 + h * 128, 512);
            }
        }
    }
    SEAM(2);
    if (IN(3)) {
        const int lane = LANE_NOW; (void)lane;
        {   float* hs = (float*)smem;
            for (int u = bid; u < 508; u += nb) {
                const int kv = u / 254, ub = u % 254;
                const float* w2 = p.in[kv ? I_W2V : I_W2K]; _Float16* dst = kv ? vc16 : kc16;
                __syncthreads();
#pragma unroll
                for (int q = 0; q < 4; ++q) { const int e = tid + 512 * q, i = e >> 8, n = e & 255;
                    const int idx = ub * 8 + i, b = idx / 254, rem = idx % 254, c = rem >> 1, kvh = rem & 1;
                    const int row = (b * 128 + c) * 2 + kvh;
                    float a = bias1[kv * 256 + n];
#pragma unroll
                    for (int sp = 0; sp < 4; ++sp) { const float* base = uv + ((size_t)(kv * 4 + sp) * 2048) * 512; a += base[(size_t)row * 512 + n] + base[(size_t)(row + 2) * 512 + 256 + n]; }
                    hs[i * 256 + n] = gelu_tanh(a); }
                __syncthreads();
#pragma unroll
                for (int q = 0; q < 2; ++q) { const int e = tid + 512 * q, i = e >> 7, d = e & 127;
                    const int idx = ub * 8 + i, b = idx / 254, rem = idx % 254, c = rem >> 1, kvh = rem & 1;
                    float a = 0.f;
                    for (int n = 0; n < 256; ++n) a += hs[i * 256 + n] * w2[n * 128 + d];
                    dst[(size_t)((b * 128 + c) * 2 + kvh) * 128 + d] = (_Float16)a; }
            }
            __syncthreads();
            for (int i = bid * 512 + tid; i < 2 * B_ * 256; i += nb * 512) { const int kv = i / (B_ * 256), r = i % (B_ * 256), b = r >> 8, x = r & 255;
                (kv ? vc16 : kc16)[(size_t)(b * 128 + 127) * 256 + x] = (_Float16)0.f; }
        }
        for (int u = bid; u < 128 * 4; u += nb) { const int g = u >> 7, mt = u & 127;
            ARowPlain af{pooled + g * 128, 512, mt * 128, T_}; EpiPool ef{opool, p.in[I_POOLS], mt * 128, g};
            gemm_tile(smem, 128, af, p.in[I_POOLW] + (size_t)g * 128 * 128, 128, 0, 128, false, ef);
        }
    }
    SEAM(3);
    if (IN(4)) {
        const int lane = LANE_NOW; (void)lane;
        const int r32 = lane & 31, hi = lane >> 5, g = wv >> 1, half = wv & 1;
        for (int uu = vcu; uu < 512; uu += nb) {
            const int v = uu & 255, bk = v >> 4, qi = (uu >> 8) ? 31 - (v & 15) : (v & 15), b = bk >> 1, kvh = bk & 1;
            const int tl = half * 32 + r32, t = qi * 64 + tl;
            at8::cmp_slc_unit(smem, proj16 + (size_t)(b * S_ + t) * INW + C_Q + (kvh * 4 + g) * 128 + hi * 8,
                              kc16 + (size_t)(b * 128 * 2 + kvh) * 128, vc16 + (size_t)(b * 128 * 2 + kvh) * 128,
                              kv16 + ((size_t)(2 * B_ + b) * 2 + kvh) * KVSEG, kv16 + ((size_t)(3 * B_ + b) * 2 + kvh) * KVSEG, t, tl, g, qi,
                              ocmp + (size_t)(b * S_ + qi * 64 + half * 32) * 1024 + (kvh * 4 + g) * 128, oslc + (size_t)(b * S_ + qi * 64 + half * 32) * 1024 + (kvh * 4 + g) * 128);
        }
    }
    SEAM(4);
    if (IN(5)) {
        const int lane = LANE_NOW; (void)lane;
        for (int row = gw; row < T_; row += nw) {
            const _Float16* pr = proj16 + (size_t)row * INW;
            float v[16]; float ss = 0.f;
#pragma unroll
            for (int i = 0; i < 16; ++i) { const int col = lane + 64 * i, h = col >> 7; const size_t o = (size_t)row * 1024 + col;
                const float g0 = sigmoidf_((float)pr[C_G + h * 3]), g1 = sigmoidf_((float)pr[C_G + h * 3 + 1]), g2 = sigmoidf_((float)pr[C_G + h * 3 + 2]);
                v[i] = g0 * ocmp[o] + g1 * oslc[o] + g2 * owin[o]; ss += v[i] * v[i]; }
            ss = wave_sum(ss); float r = rsqrtf(ss / 1024.f + LN_EPS);
#pragma unroll
            for (int i = 0; i < 16; ++i) { const int col = lane + 64 * i; cat16[(size_t)row * 2048 + col] = (_Float16)(v[i] * r * p.in[I_GNNSA][col]); }
            ss = 0.f;
#pragma unroll
            for (int i = 0; i < 8; ++i) { v[i] = opool[(size_t)row * 512 + lane + 64 * i]; ss += v[i] * v[i]; }
            ss = wave_sum(ss); r = rsqrtf(ss / 512.f + LN_EPS);
#pragma unroll
            for (int i = 0; i < 8; ++i) { const int col = lane + 64 * i; cat16[(size_t)row * 2048 + 1024 + col] = (_Float16)(v[i] * r * p.in[I_GNPOOL][col]); }
            ss = 0.f;
#pragma unroll
            for (int i = 0; i < 8; ++i) { v[i] = omem[(size_t)row * 512 + lane + 64 * i]; ss += v[i] * v[i]; }
            ss = wave_sum(ss); r = rsqrtf(ss / 512.f + LN_EPS);
#pragma unroll
            for (int i = 0; i < 8; ++i) { const int col = lane + 64 * i; cat16[(size_t)row * 2048 + 1536 + col] = (_Float16)(v[i] * r * p.in[I_GNMEM][col]); }
        }
    }
    SEAM(5);
    if (IN(6)) {
        const int lane = LANE_NOW; (void)lane;
        g8::ProbOut P{cat16, wtout, hpre16, x16, nb, bid};
        g8::gemm_phase(lds, P);
    }
    SEAM(6);
    if (IN(7)) {
        const int lane = LANE_NOW; (void)lane;
        float* lg = (float*)smem;
        const int r32 = lane & 31, hi = lane >> 5, fr = lane & 15, fq = lane >> 4;
        for (int u = bid; u < T_ / 64; u += nb) {
            const int base = u * 64;
#pragma unroll 1
            for (int i = 0; i < 8; ++i) {
                const int row = base + wv * 8 + i;
                float v[32]; float s = 0.f;
#pragma unroll
                for (int c = 0; c < 4; ++c) { const int col = (lane + 64 * c) * 8;
                    const h8 a0 = *(const h8*)(hpre16 + (size_t)row * 2048 + col);
#pragma unroll
                    for (int q = 0; q < 8; ++q) { v[c * 8 + q] = (float)a0[q]; s += v[c * 8 + q]; } }
                const float mu = wave_sum(s) / 2048.f; float q2 = 0.f;
#pragma unroll
                for (int k = 0; k < 32; ++k) { const float d = v[k] - mu; q2 += d * d; }
                const float rs = rsqrtf(wave_sum(q2) / 2048.f + LN_EPS);
                float amax = 0.f;
#pragma unroll
                for (int c = 0; c < 4; ++c) { const int col = (lane + 64 * c) * 8;
                    const float4 g0 = *(const float4*)(p.in[I_LN1G] + col), g1 = *(const float4*)(p.in[I_LN1G] + col + 4), b0 = *(const float4*)(p.in[I_LN1B] + col), b1 = *(const float4*)(p.in[I_LN1B] + col + 4);
                    float4 o0, o1;
                    o0.x = (v[c * 8 + 0] - mu) * rs * g0.x + b0.x; o0.y = (v[c * 8 + 1] - mu) * rs * g0.y + b0.y; o0.z = (v[c * 8 + 2] - mu) * rs * g0.z + b0.z; o0.w = (v[c * 8 + 3] - mu) * rs * g0.w + b0.w;
                    o1.x = (v[c * 8 + 4] - mu) * rs * g1.x + b1.x; o1.y = (v[c * 8 + 5] - mu) * rs * g1.y + b1.y; o1.z = (v[c * 8 + 6] - mu) * rs * g1.z + b1.z; o1.w = (v[c * 8 + 7] - mu) * rs * g1.w + b1.w;
                    *(float4*)(hbuf + (size_t)row * 2048 + col) = o0; *(float4*)(hbuf + (size_t)row * 2048 + col + 4) = o1;
                    h8 oh; oh[0] = (_Float16)o0.x; oh[1] = (_Float16)o0.y; oh[2] = (_Float16)o0.z; oh[3] = (_Float16)o0.w; oh[4] = (_Float16)o1.x; oh[5] = (_Float16)o1.y; oh[6] = (_Float16)o1.z; oh[7] = (_Float16)o1.w;
                    *(h8*)(h16 + (size_t)row * 2048 + col) = oh;
                    v[c * 8 + 0] = o0.x; v[c * 8 + 1] = o0.y; v[c * 8 + 2] = o0.z; v[c * 8 + 3] = o0.w; v[c * 8 + 4] = o1.x; v[c * 8 + 5] = o1.y; v[c * 8 + 6] = o1.z; v[c * 8 + 7] = o1.w;
                    amax = fmaxf(amax, fmaxf(fmaxf(fmaxf(fabsf(o0.x), fabsf(o0.y)), fmaxf(fabsf(o0.z), fabsf(o0.w))), fmaxf(fmaxf(fabsf(o1.x), fabsf(o1.y)), fmaxf(fabsf(o1.z), fabsf(o1.w))))); }
                amax = wave_max(amax);
                const float qinv = amax > 0.f ? 127.f / amax : 0.f;
                if (lane == 0) sah[row] = amax > 0.f ? amax / 127.f : 1.f;
#pragma unroll
                for (int c = 0; c < 4; ++c) { const int col = (lane + 64 * c) * 8;
                    uint2 q; q.x = pack4_i8(v[c * 8 + 0] * qinv, v[c * 8 + 1] * qinv, v[c * 8 + 2] * qinv, v[c * 8 + 3] * qinv); q.y = pack4_i8(v[c * 8 + 4] * qinv, v[c * 8 + 5] * qinv, v[c * 8 + 6] * qinv, v[c * 8 + 7] * qinv);
                    *(uint2*)(h8q + (size_t)row * 2048 + col) = q; }
            }
            asm volatile("s_waitcnt vmcnt(0)" ::: "memory");
            __syncthreads();
            {
                const int tok0 = base + 16 * (wv >> 1), e0 = 16 * (wv & 1);
                const _Float16* ap = h16 + (size_t)(tok0 + fr) * 2048 + fq * 8; const _Float16* bp = wr16 + (size_t)(e0 + fr) * 2048 + fq * 8;
                f4 acc = (f4){0.f, 0.f, 0.f, 0.f};
#pragma unroll 8
                for (int sI = 0; sI < 64; ++sI) { const h8 a = *(const h8*)(ap + sI * 32), bb = *(const h8*)(bp + sI * 32); acc = __builtin_amdgcn_mfma_f32_16x16x32_f16(a, bb, acc, 0, 0, 0); }
                const float br = p.in[I_BR][e0 + fr];
#pragma unroll
                for (int j = 0; j < 4; ++j) lg[(16 * (wv >> 1) + 4 * fq + j) * 33 + e0 + fr] = acc[j] + br;
            }
            __syncthreads();
#pragma unroll 1
            for (int it = 0; it < 4; ++it) {
                const int tk = 8 * wv + 2 * it + hi;
                const float iv = lg[tk * 33 + r32];
                int rank = 0;
                for (int i = 0; i < 32; ++i) { const float vi = __shfl(iv, i + 32 * hi); rank += (vi > iv || (vi == iv && i < r32)) ? 1 : 0; }
                float tv[4]; int te[4];
#pragma unroll
                for (int r = 0; r < 4; ++r) { const unsigned long long bm = __ballot(rank == r); const unsigned hm = (unsigned)(bm >> (32 * hi)); const int src = __ffs(hm) - 1; te[r] = src; tv[r] = __shfl(iv, src + 32 * hi); }
                const float e0v = 1.f, e1v = expf(tv[1] - tv[0]), e2v = expf(tv[2] - tv[0]), e3v = expf(tv[3] - tv[0]); const float inv = 1.f / (e0v + e1v + e2v + e3v);
                if (r32 < 4) { const int e = r32 == 0 ? te[0] : r32 == 1 ? te[1] : r32 == 2 ? te[2] : te[3]; const float g = (r32 == 0 ? e0v : r32 == 1 ? e1v : r32 == 2 ? e2v : e3v) * inv;
                    const int a = (base + tk) * 4 + r32; const int pos = atomicAdd(&cnt[e], 1); list[(size_t)e * T_ + pos] = a; gate[a] = g; }
            }
            __syncthreads();
        }
    }
    SEAM(7);
    LAS int* mtab = (LAS int*)(smem + g8::STAGE_BYTES);
    if (IN(8)) {
        const int lane = LANE_NOW; (void)lane;
        if (tid == 0) { int ub = 0, rs = 0;
            for (int e = 0; e < NE; ++e) { const int c = (int)__hip_atomic_load((unsigned*)&cnt[e], __ATOMIC_RELAXED, __HIP_MEMORY_SCOPE_AGENT); mtab[e] = c; mtab[32 + e] = ub; mtab[65 + e] = rs; ub += ((c + 255) >> 8) * 16; rs += c; }
            mtab[64] = ub; mtab[97] = rs; mtab[98] = ub; }
        __syncthreads();
        g8::ProbGu P{h8q, q8gu, act16, p.in[I_BGU], list, sah, sgu, g8::MoeTab{mtab, 16}, nb, vcu};
        g8::gemm_phase(lds, P);
        __syncthreads();
    }
    SEAM(8);
    if (IN(9)) {
        const int lane = LANE_NOW;
        for (int row = gw; row < NA; row += nw) {
            float v[32]; float amax = 0.f;
#pragma unroll
            for (int c = 0; c < 4; ++c) { const h8 a = *(const h8*)(act16 + (size_t)row * 2048 + (lane + 64 * c) * 8);
#pragma unroll
                for (int q = 0; q < 8; ++q) { v[c * 8 + q] = (float)a[q]; amax = fmaxf(amax, fabsf(v[c * 8 + q])); } }
            amax = wave_max(amax);
            const float qinv = amax > 0.f ? 127.f / amax : 0.f;
            if (lane == 0) sact[row] = amax > 0.f ? amax / 127.f : 1.f;
#pragma unroll
            for (int c = 0; c < 4; ++c) { uint2 q; q.x = pack4_i8(v[c * 8 + 0] * qinv, v[c * 8 + 1] * qinv, v[c * 8 + 2] * qinv, v[c * 8 + 3] * qinv); q.y = pack4_i8(v[c * 8 + 4] * qinv, v[c * 8 + 5] * qinv, v[c * 8 + 6] * qinv, v[c * 8 + 7] * qinv);
                *(uint2*)(act8 + (size_t)row * 2048 + (lane + 64 * c) * 8) = q; }
        }
    }
    SEAM(9);
    if (IN(10)) {
        const int lane = LANE_NOW; (void)lane;
        if (tid == 0) { int ub = 0, rs = 0;
            for (int e = 0; e < NE; ++e) { const int c = (int)__hip_atomic_load((unsigned*)&cnt[e], __ATOMIC_RELAXED, __HIP_MEMORY_SCOPE_AGENT); mtab[e] = c; mtab[32 + e] = ub; mtab[65 + e] = rs; ub += ((c + 255) >> 8) * 8; rs += c; }
            mtab[64] = ub; mtab[97] = rs; mtab[98] = ub; }
        __syncthreads();
        g8::ProbDn P{act8, q8dn, y16, p.in[I_BDN], list, gate, sact, sdn, g8::MoeTab{mtab, 8}, nb, vcu};
        g8::gemm_phase(lds, P);
        __syncthreads();
    }
    SEAM(10);
    if (IN(11)) {
        const int lane = LANE_NOW; (void)lane;
        for (int row = gw; row < T_; row += nw) {
            float v[32]; float s = 0.f;
#pragma unroll
            for (int c = 0; c < 4; ++c) { const int col = (lane + 64 * c) * 8; const size_t yo = (size_t)row * 4 * 2048 + col;
                const float4 ha = *(const float4*)(hbuf + (size_t)row * 2048 + col), hb = *(const float4*)(hbuf + (size_t)row * 2048 + col + 4);
                const h8 y0 = *(const h8*)(y16 + yo), y1 = *(const h8*)(y16 + yo + 2048), y2 = *(const h8*)(y16 + yo + 4096), y3 = *(const h8*)(y16 + yo + 6144);
                const float hh[8] = {ha.x, ha.y, ha.z, ha.w, hb.x, hb.y, hb.z, hb.w};
#pragma unroll
                for (int q = 0; q < 8; ++q) { v[c * 8 + q] = DN_ALPHA * hh[q] + (((float)y0[q] + (float)y1[q]) + ((float)y2[q] + (float)y3[q])); s += v[c * 8 + q]; } }
            const float mu = wave_sum(s) / 2048.f; float q2 = 0.f;
#pragma unroll
            for (int i = 0; i < 32; ++i) { const float d = v[i] - mu; q2 += d * d; }
            const float rs = rsqrtf(wave_sum(q2) / 2048.f + LN_EPS);
#pragma unroll
            for (int c = 0; c < 4; ++c) { const int col = (lane + 64 * c) * 8;
                const float4 ga = *(const float4*)(p.in[I_LN2G] + col), gb = *(const float4*)(p.in[I_LN2G] + col + 4), ba = *(const float4*)(p.in[I_LN2B] + col), bb = *(const float4*)(p.in[I_LN2B] + col + 4);
                float4 o0, o1;
                o0.x = (v[c * 8 + 0] - mu) * rs * ga.x + ba.x; o0.y = (v[c * 8 + 1] - mu) * rs * ga.y + ba.y; o0.z = (v[c * 8 + 2] - mu) * rs * ga.z + ba.z; o0.w = (v[c * 8 + 3] - mu) * rs * ga.w + ba.w;
                o1.x = (v[c * 8 + 4] - mu) * rs * gb.x + bb.x; o1.y = (v[c * 8 + 5] - mu) * rs * gb.y + bb.y; o1.z = (v[c * 8 + 6] - mu) * rs * gb.z + bb.z; o1.w = (v[c * 8 + 7] - mu) * rs * gb.w + bb.w;
                *(float4*)(p.out + (size_t)row * 2048 + col) = o0; *(float4*)(p.out + (size_t)row * 2048 + col + 4) = o1; }
        }
    }
}

constexpr int NPHASE = 12;

extern "C" void kernel_launch(void* const* d_in, const int* in_sizes, int n_in, void* d_out, int out_size, void* d_ws, size_t ws_size, hipStream_t stream) {
    static int grid = 0;
    if (grid == 0) {
        if (n_in != 26 || ws_size < WS_END) { fprintf(stderr, "kernel_launch: unexpected n_in %d or ws_size %zu (< %zu)\n", n_in, ws_size, (size_t)WS_END); grid = -1; return; }
        int dev = 0, cus = 0, per_cu = 0;
        hipGetDevice(&dev); hipDeviceGetAttribute(&cus, hipDeviceAttributeMultiprocessorCount, dev);
        if (hipFuncSetAttribute((const void*)fwd, hipFuncAttributeMaxDynamicSharedMemorySize, LDS_BYTES) != hipSuccess) { fprintf(stderr, "hipFuncSetAttribute failed\n"); grid = -1; return; }
        hipOccupancyMaxActiveBlocksPerMultiprocessor(&per_cu, (const void*)fwd, 512, LDS_BYTES);
        (void)hipGetLastError();
        if (per_cu < 1) fprintf(stderr, "occupancy query says %d blocks per CU\n", per_cu);
        grid = cus > 0 ? cus : 256;
    }
    if (grid < 0) return;
    hipMemsetAsync((char*)d_ws + WS_CTL, 0, CTL_BYTES, stream);
    Params p{};
    for (int i = 0; i < 26; ++i) p.in[i] = (const float*)d_in[i];
    p.out = (float*)d_out; p.ws = (unsigned char*)d_ws;
#if N_LAUNCH_MODE == 1
    p.lo_hi = (long long)0 | ((long long)NPHASE << 32);
    hipLaunchKernelGGL(fwd, dim3(grid), dim3(512), LDS_BYTES, stream, p);
#else
    for (int ph = 0; ph < NPHASE; ++ph) {
        p.lo_hi = (long long)ph | ((long long)(ph + 1) << 32);
        hipLaunchKernelGGL(fwd, dim3(grid), dim3(512), LDS_BYTES, stream, p);
    }
#endif
}
```

```cpp
#include <hip/hip_runtime.h>
#include <cstdio>
#include <cstdint>

#ifndef N_LAUNCH_MODE
#define N_LAUNCH_MODE 1
#endif

constexpr int B_ = 8, S_ = 2048, D_ = 2048, T_ = B_ * S_;
constexpr int INW = 3608;
constexpr int C_Q = 0, C_KC = 1024, C_VC = 1280, C_KS = 1536, C_VS = 1792, C_KW = 2048, C_VW = 2304, C_G = 2560, C_UP = 2584, C_QM = 3096;
constexpr int NC = 127;
constexpr int CROWS = B_ * NC * 2;
constexpr int NE = 32, DE = 2048, NA = T_ * 4;
constexpr float LN_EPS = 1e-5f;
constexpr float DN_ALPHA = 1.189207115002721f;
constexpr float ATT_SCALE = 0.08838834764831845f;

constexpr size_t al256(size_t x) { return (x + 255) & ~(size_t)255; }
constexpr size_t WS_CTL = 0;
constexpr size_t CTL_BYTES = 65536;
constexpr size_t CTL_CNT = 16384;
constexpr size_t WS_PROJ = CTL_BYTES;
constexpr size_t WS_KVMEM = WS_PROJ + al256((size_t)T_ * INW * 4);
constexpr size_t WS_BIAS1 = WS_KVMEM + al256((size_t)2048 * 1024 * 4);
constexpr size_t WS_HID = WS_BIAS1 + al256(2 * 256 * 4);
constexpr size_t WS_KC = WS_HID + al256((size_t)2 * 2048 * 256 * 4);
constexpr size_t WS_VC = WS_KC + al256((size_t)CROWS * 128 * 4);
constexpr size_t WS_POOLED = WS_VC + al256((size_t)CROWS * 128 * 4);
constexpr size_t WS_OPOOL = WS_POOLED + al256((size_t)T_ * 512 * 4);
constexpr size_t WS_OWIN = WS_OPOOL + al256((size_t)T_ * 512 * 4);
constexpr size_t WS_OCMP = WS_OWIN + al256((size_t)T_ * 1024 * 4);
constexpr size_t WS_OSLC = WS_OCMP + al256((size_t)T_ * 1024 * 4);
constexpr size_t WS_SEL = WS_OSLC + al256((size_t)T_ * 1024 * 4);
constexpr size_t WS_OMEM = WS_SEL + al256((size_t)T_ * 2 * 4);
constexpr size_t WS_CAT16 = WS_OMEM + al256((size_t)T_ * 512 * 4);
constexpr size_t WS_HPRE = WS_CAT16 + al256((size_t)T_ * 2048 * 2);
constexpr size_t WS_H = WS_HPRE + al256((size_t)T_ * 2048 * 4);
constexpr size_t WS_H16 = WS_H + al256((size_t)T_ * 2048 * 4);
constexpr size_t WS_GATE = WS_H16 + al256((size_t)T_ * 2048 * 2);
constexpr size_t WS_LIST = WS_GATE + al256((size_t)NA * 4);
constexpr size_t WS_ACT16 = WS_LIST + al256((size_t)NE * T_ * 4);
constexpr size_t WS_Y16 = WS_ACT16 + al256((size_t)(NA + 256) * 2048 * 2);
constexpr size_t WS_X16 = WS_Y16 + al256((size_t)NA * 2048 * 2);
constexpr size_t WS_MEM16 = WS_X16 + (size_t)T_ * 2048 * 2;
constexpr size_t WS_WTIN = WS_MEM16 + al256((size_t)2048 * 2048 * 2);
constexpr size_t WS_WTOUT = WS_WTIN + al256((size_t)3840 * 2048 * 2);
constexpr size_t WS_WTGU = WS_WTOUT + al256((size_t)2048 * 2048 * 2);
constexpr size_t WS_WTDN = WS_WTGU + al256((size_t)NE * 4096 * 2048 * 2);
constexpr size_t WS_PROJ16 = WS_WTDN + al256((size_t)NE * 2048 * 2048 * 2);
constexpr size_t WS_KVMEM16 = WS_PROJ16 + al256((size_t)(T_ + 64) * INW * 2);
constexpr size_t WS_WT1 = WS_KVMEM16 + al256((size_t)2048 * 1024 * 2);
constexpr size_t WS_UV = WS_WT1 + al256((size_t)2 * 512 * 2048 * 2);
constexpr size_t WS_KC16 = WS_UV + al256((size_t)2 * 4 * 2048 * 512 * 4);
constexpr size_t WS_VC16 = WS_KC16 + al256((size_t)B_ * 128 * 256 * 2);
constexpr size_t WS_WR16 = WS_VC16 + al256((size_t)B_ * 128 * 256 * 2);
constexpr size_t WS_Q8GU = WS_WR16 + al256((size_t)32 * 2048 * 2);
constexpr size_t WS_Q8DN = WS_Q8GU + al256((size_t)NE * 4096 * 2048);
constexpr size_t WS_SGU = WS_Q8DN + al256((size_t)NE * 2048 * 2048);
constexpr size_t WS_SDN = WS_SGU + al256((size_t)NE * 4096 * 4);
constexpr size_t WS_H8 = WS_SDN + al256((size_t)NE * 2048 * 4);
constexpr size_t WS_SAH = WS_H8 + al256((size_t)T_ * 2048);
constexpr size_t WS_ACT8 = WS_SAH + al256((size_t)T_ * 4);
constexpr size_t WS_SACT = WS_ACT8 + al256((size_t)(NA + 256) * 2048);
constexpr size_t WS_WTMKV = WS_SACT + al256((size_t)(NA + 256) * 4);
constexpr size_t WS_Q8OUT = WS_WTMKV + al256((size_t)1024 * 2048 * 2);
constexpr size_t WS_SOUT = WS_Q8OUT + al256((size_t)2048 * 2048);
constexpr size_t WS_CAT8 = WS_SOUT + al256(2048 * 4);
constexpr size_t WS_SCAT = WS_CAT8 + al256((size_t)T_ * 2048);
constexpr size_t WS_KV16 = WS_SCAT + al256((size_t)T_ * 4);
constexpr size_t KVSEG = (size_t)S_ * 128;
constexpr size_t WS_END = WS_KV16 + al256((size_t)6 * B_ * 2 * S_ * 128 * 2);

constexpr int LDS_BYTES = 155648;

struct Params {
    const float* in[26];
    float* out;
    unsigned char* ws;
    long long lo_hi;
};
enum { I_X = 0, I_MEM, I_WIN, I_POSK, I_W1K, I_W2K, I_POSV, I_W1V, I_W2V, I_POOLW, I_POOLS, I_WMEMKV, I_GNNSA, I_GNPOOL, I_GNMEM, I_WOUT,
       I_LN1G, I_LN1B, I_WR, I_BR, I_WGU, I_BGU, I_WDN, I_BDN, I_LN2G, I_LN2B };

#define XB_TMO      128
#define XB_XCNT(j)  (256  + 64 * (j))
#define XB_XSUB(j)  (1280 + 64 * (j))
#define XB_XGEN(j)  (2304 + 64 * (j))
#define XB_TOP      3328
#define XB_TOPGEN   3392
#define XCD_BAR_WORDS 3456
#define XB_SPIN_CAP (1u << 25)
#define LAS __attribute__((address_space(3)))

__device__ __forceinline__ unsigned xb_ld(unsigned* p)              { return __hip_atomic_load(p, __ATOMIC_RELAXED, __HIP_MEMORY_SCOPE_AGENT); }
__device__ __forceinline__ unsigned xb_add(unsigned* p, unsigned v) { return __hip_atomic_fetch_add(p, v, __ATOMIC_RELAXED, __HIP_MEMORY_SCOPE_AGENT); }
__device__ __forceinline__ unsigned xb_xcc_id() { return (unsigned)__builtin_amdgcn_s_getreg((3 << 11) | 20) & 0xFu; }
#define XB_SPIN(cond, bar) do { unsigned _sp = 0; while (cond) { __builtin_amdgcn_s_sleep(1); \
    if ((++_sp & 255u) == 0u) { if (xb_ld(&(bar)[XB_TMO])) break; if (_sp > XB_SPIN_CAP) { atomicAdd(&(bar)[XB_TMO], 1u); break; } } } } while (0)

struct XcdBarrier { unsigned* bar; unsigned x; volatile LAS unsigned* st; };

__device__ __forceinline__ XcdBarrier xcd_barrier_post(unsigned* bar, volatile LAS unsigned* st) {
    XcdBarrier b; b.bar = bar; b.x = xb_xcc_id(); b.st = st;
    if (threadIdx.x == 0) (void)xb_add(&bar[XB_XCNT(b.x)], 1u);
    return b;
}
__device__ __forceinline__ void xcd_barrier_complete(unsigned* bar, unsigned x, unsigned& nloc, unsigned& nx) {
    const unsigned G = gridDim.x * gridDim.y * gridDim.z;
    unsigned sum, cnt, mine, sp = 0u;
    for (;;) {
        sum = 0u; cnt = 0u; mine = 0u;
#pragma unroll
        for (unsigned j = 0; j < 16; ++j) { const unsigned c = xb_ld(&bar[XB_XCNT(j)]); sum += c; cnt += (c > 0u) ? 1u : 0u; mine = (j == x) ? c : mine; }
        if (sum == G) break;
        __builtin_amdgcn_s_sleep(1);
        if ((++sp & 255u) == 0u) { if (xb_ld(&bar[XB_TMO])) break; if (sp > XB_SPIN_CAP) { atomicAdd(&bar[XB_TMO], 1u); break; } }
    }
    nloc = mine > 0u ? mine : 1u; nx = cnt > 0u ? cnt : 1u;
}
__device__ __forceinline__ void xcd_barrier(const XcdBarrier& b) {
    asm volatile("s_waitcnt vmcnt(0)" ::: "memory");
    __syncthreads();
    if (threadIdx.x == 0) {
        unsigned* bar = b.bar;
        __builtin_amdgcn_s_waitcnt(0);
        unsigned nloc = b.st[0], nx = b.st[1];
        if (nloc == 0u) { xcd_barrier_complete(bar, b.x, nloc, nx); b.st[0] = nloc; b.st[1] = nx; }
        const unsigned old = xb_add(&bar[XB_XSUB(b.x)], 1u);
        const unsigned gen = old / nloc;
        if (old + 1u == (gen + 1u) * nloc) {
            __builtin_amdgcn_fence(__ATOMIC_RELEASE, "agent");
            asm volatile("s_waitcnt vmcnt(0)" ::: "memory");
            const unsigned og = xb_add(&bar[XB_TOP], 1u);
            const unsigned tg = og / nx;
            if (og + 1u == (tg + 1u) * nx) xb_add(&bar[XB_TOPGEN], 1u);
            else XB_SPIN(xb_ld(&bar[XB_TOPGEN]) == tg, bar);
            __builtin_amdgcn_fence(__ATOMIC_ACQUIRE, "agent");
            xb_add(&bar[XB_XGEN(b.x)], 1u);
            asm volatile("s_waitcnt vmcnt(0)" ::: "memory");
        } else {
            XB_SPIN(xb_ld(&bar[XB_XGEN(b.x)]) == gen, bar);
            __builtin_amdgcn_fence(__ATOMIC_ACQUIRE, "agent");
            asm volatile("s_waitcnt vmcnt(0)" ::: "memory");
        }
    }
    __syncthreads();
}

typedef _Float16 h8 __attribute__((ext_vector_type(8)));
typedef _Float16 h4 __attribute__((ext_vector_type(4)));
typedef float f4 __attribute__((ext_vector_type(4)));

__device__ __forceinline__ float wave_sum(float v) {
#pragma unroll
    for (int o = 32; o > 0; o >>= 1) v += __shfl_xor(v, o);
    return v;
}
__device__ __forceinline__ float wave_max(float v) {
#pragma unroll
    for (int o = 32; o > 0; o >>= 1) v = fmaxf(v, __shfl_xor(v, o));
    return v;
}
__device__ __forceinline__ void wave_sync() {
    asm volatile("s_waitcnt lgkmcnt(0)" ::: "memory");
    __builtin_amdgcn_wave_barrier();
}
__device__ __forceinline__ float gelu_tanh(float x) {
    const float u = 0.7978845608028654f * (x + 0.044715f * x * x * x);
    return 0.5f * x * (1.f + tanhf(u));
}
__device__ __forceinline__ float sigmoidf_(float x) { return 1.f / (1.f + expf(-x)); }
__device__ __forceinline__ float swiglu_fast(float g, float l) { const float xg = fminf(g, 7.f), xl = fminf(fmaxf(l, -7.f), 7.f); return xg * __builtin_amdgcn_rcpf(1.f + __builtin_amdgcn_exp2f(-2.4554669595930156f * xg)) * (xl + 1.f); }

constexpr int G_LD = 40;
template <class AF, class EF>
__device__ __forceinline__ void gemm_tile(char* smem, int K, const AF& af, const float* __restrict__ Bm, int ldb, int n0, int Nlim, bool perm, const EF& ef) {
    _Float16* As = (_Float16*)smem;
    _Float16* Bs = As + 128 * G_LD;
    const int tid = threadIdx.x, lane = tid & 63, wid = tid >> 6, wr = wid >> 2, wc = wid & 3, fr = lane & 15, fq = lane >> 4;
    f4 acc[4][2];
#pragma unroll
    for (int m = 0; m < 4; ++m)
#pragma unroll
        for (int n = 0; n < 2; ++n) acc[m][n] = (f4){0.f, 0.f, 0.f, 0.f};
    const int ar = tid >> 3, ak = (tid & 7) * 4;
    const float* ap0 = af.row(ar);
    const float* ap1 = af.row(ar + 64);
    const int bk = tid >> 5, bn = (tid & 31) * 4;
    const bool bok = (n0 + bn) < Nlim;
    int bnp[4];
#pragma unroll
    for (int i = 0; i < 4; ++i) { const int c = bn + i; bnp[i] = perm ? ((c & ~31) | ((c & 1) << 4) | ((c & 31) >> 1)) : c; }
    for (int k0 = 0; k0 < K; k0 += 32) {
        const int ko = af.koff(k0 + ak);
        float4 a0 = make_float4(0.f, 0.f, 0.f, 0.f), a1 = a0, b0 = a0, b1 = a0;
        if (ap0) a0 = *(const float4*)(ap0 + ko);
        if (ap1) a1 = *(const float4*)(ap1 + ko);
        if (bok) { b0 = *(const float4*)(Bm + (size_t)(k0 + bk) * ldb + n0 + bn); b1 = *(const float4*)(Bm + (size_t)(k0 + bk + 16) * ldb + n0 + bn); }
        __syncthreads();
        *(h4*)&As[ar * G_LD + ak] = (h4){(_Float16)a0.x, (_Float16)a0.y, (_Float16)a0.z, (_Float16)a0.w};
        *(h4*)&As[(ar + 64) * G_LD + ak] = (h4){(_Float16)a1.x, (_Float16)a1.y, (_Float16)a1.z, (_Float16)a1.w};
        Bs[bnp[0] * G_LD + bk] = (_Float16)b0.x; Bs[bnp[1] * G_LD + bk] = (_Float16)b0.y; Bs[bnp[2] * G_LD + bk] = (_Float16)b0.z; Bs[bnp[3] * G_LD + bk] = (_Float16)b0.w;
        Bs[bnp[0] * G_LD + bk + 16] = (_Float16)b1.x; Bs[bnp[1] * G_LD + bk + 16] = (_Float16)b1.y; Bs[bnp[2] * G_LD + bk + 16] = (_Float16)b1.z; Bs[bnp[3] * G_LD + bk + 16] = (_Float16)b1.w;
        __syncthreads();
        h8 a[4], b[2];
#pragma unroll
        for (int m = 0; m < 4; ++m) a[m] = *(const h8*)&As[(wr * 64 + m * 16 + fr) * G_LD + fq * 8];
#pragma unroll
        for (int n = 0; n < 2; ++n) b[n] = *(const h8*)&Bs[(wc * 32 + n * 16 + fr) * G_LD + fq * 8];
#pragma unroll
        for (int m = 0; m < 4; ++m)
#pragma unroll
            for (int n = 0; n < 2; ++n) acc[m][n] = __builtin_amdgcn_mfma_f32_16x16x32_f16(a[m], b[n], acc[m][n], 0, 0, 0);
    }
    ef(acc, wr, wc, fr, fq);
    __syncthreads();
}

struct ARowPlain { const float* base; int ld; int m0; int mlim;
    __device__ __forceinline__ const float* row(int r) const { return (m0 + r) < mlim ? base + (size_t)(m0 + r) * ld : nullptr; }
    __device__ __forceinline__ int koff(int k) const { return k; } };
struct ARowCmp { const float* proj; int col; int m0;
    __device__ __forceinline__ const float* row(int r) const { const int g = m0 + r; if (g >= CROWS) return nullptr; const int kvh = g & 1, bc = g >> 1, b = bc / NC, c = bc % NC;
        return proj + (size_t)(b * S_ + 16 * c) * INW + col + kvh * 128; }
    __device__ __forceinline__ int koff(int k) const { return (k >> 7) * INW + (k & 127); } };
struct ARowList { const float* base; const int* list; int m0; int cnt; int shift;
    __device__ __forceinline__ const float* row(int r) const { if (m0 + r >= cnt) return nullptr; const int a = list[m0 + r]; return base + (size_t)(a >> shift) * 2048; }
    __device__ __forceinline__ int koff(int k) const { return k; } };

struct EpiStore { float* C; int ldc; int m0; int n0; int mlim; int nlim; _Float16* C16;
    __device__ __forceinline__ void operator()(const f4 (&acc)[4][2], int wr, int wc, int fr, int fq) const {
#pragma unroll
        for (int m = 0; m < 4; ++m)
#pragma unroll
            for (int n = 0; n < 2; ++n)
#pragma unroll
                for (int j = 0; j < 4; ++j) { const int r = m0 + wr * 64 + m * 16 + fq * 4 + j, c = n0 + wc * 32 + n * 16 + fr;
                    if (r < mlim && c < nlim) { C[(size_t)r * ldc + c] = acc[m][n][j]; if (C16) C16[(size_t)r * ldc + c] = (_Float16)acc[m][n][j]; } } } };
struct EpiPool { _Float16* C; const float* scale; int m0; int g;
    __device__ __forceinline__ void operator()(const f4 (&acc)[4][2], int wr, int wc, int fr, int fq) const {
#pragma unroll
        for (int m = 0; m < 4; ++m)
#pragma unroll
            for (int n = 0; n < 2; ++n)
#pragma unroll
                for (int j = 0; j < 4; ++j) { const int r = m0 + wr * 64 + m * 16 + fq * 4 + j, c = g * 128 + wc * 32 + n * 16 + fr;
                    C[(size_t)r * 512 + c] = (_Float16)(acc[m][n][j] * scale[c]); } } };
struct EpiHid { float* C; const float* bias; int m0; int n0;
    __device__ __forceinline__ void operator()(const f4 (&acc)[4][2], int wr, int wc, int fr, int fq) const {
#pragma unroll
        for (int m = 0; m < 4; ++m)
#pragma unroll
            for (int n = 0; n < 2; ++n)
#pragma unroll
                for (int j = 0; j < 4; ++j) { const int r = m0 + wr * 64 + m * 16 + fq * 4 + j, c = n0 + wc * 32 + n * 16 + fr;
                    if (r < CROWS) C[(size_t)r * 256 + c] = gelu_tanh(acc[m][n][j] + bias[c]); } } };
struct EpiOut { float* C; const float* x; int m0; int n0;
    __device__ __forceinline__ void operator()(const f4 (&acc)[4][2], int wr, int wc, int fr, int fq) const {
#pragma unroll
        for (int m = 0; m < 4; ++m)
#pragma unroll
            for (int n = 0; n < 2; ++n)
#pragma unroll
                for (int j = 0; j < 4; ++j) { const size_t o = (size_t)(m0 + wr * 64 + m * 16 + fq * 4 + j) * 2048 + n0 + wc * 32 + n * 16 + fr;
                    C[o] = DN_ALPHA * x[o] + acc[m][n][j]; } } };
struct EpiGu { float* act; const float* bgu; const int* list; int m0; int cnt; int n0;
    __device__ __forceinline__ void operator()(const f4 (&acc)[4][2], int wr, int wc, int fr, int fq) const {
        const int jc = (n0 + wc * 32) / 2 + fr;
        const float bg = bgu[2 * jc], bl = bgu[2 * jc + 1];
#pragma unroll
        for (int m = 0; m < 4; ++m)
#pragma unroll
            for (int j = 0; j < 4; ++j) { const int r = m0 + wr * 64 + m * 16 + fq * 4 + j;
                if (r < cnt) { const int a = list[r];
                    const float xg = fminf(acc[m][0][j] + bg, 7.f), xl = fminf(fmaxf(acc[m][1][j] + bl, -7.f), 7.f);
                    act[(size_t)a * 2048 + jc] = xg * sigmoidf_(1.702f * xg) * (xl + 1.f); } } } };
struct EpiDn { float* y; const float* bdn; const int* list; const float* gate; int m0; int cnt; int n0;
    __device__ __forceinline__ void operator()(const f4 (&acc)[4][2], int wr, int wc, int fr, int fq) const {
#pragma unroll
        for (int m = 0; m < 4; ++m)
#pragma unroll
            for (int j = 0; j < 4; ++j) { const int r = m0 + wr * 64 + m * 16 + fq * 4 + j;
                if (r < cnt) { const int a = list[r]; const float g = gate[a];
#pragma unroll
                    for (int n = 0; n < 2; ++n) { const int c = n0 + wc * 32 + n * 16 + fr; y[(size_t)a * 2048 + c] = (acc[m][n][j] + bdn[c]) * g; } } } } };

constexpr int WLDS_FLOATS = 4096 + 512 + 32;
template <bool SHARED>
__device__ __forceinline__ void wave_attn(float* sw, const float* __restrict__ qptr, const float* __restrict__ Kb, const float* __restrict__ Vb, int ld, int nseg, float scale, float* __restrict__ optr) {
    const int lane = threadIdx.x & 63;
    float* sq = sw + 4096; const int* segs = (const int*)(sw + 4096 + 512);
#pragma unroll
    for (int i = 0; i < 8; ++i) sq[lane + 64 * i] = qptr[lane + 64 * i];
    wave_sync();
    for (int sg = 0; sg < nseg; ++sg) {
        const int start = segs[sg], len = segs[16 + sg];
        float d0 = 0.f, d1 = 0.f, d2 = 0.f, d3 = 0.f;
        if (lane < len) {
            const float* kp = Kb + (size_t)(start + lane) * ld;
            for (int d4 = 0; d4 < 32; ++d4) {
                if (SHARED) {
                    const float4 kv = *(const float4*)(kp + d4 * 4);
                    const float4 q0 = *(const float4*)(sq + d4 * 4), q1 = *(const float4*)(sq + 128 + d4 * 4), q2 = *(const float4*)(sq + 256 + d4 * 4), q3 = *(const float4*)(sq + 384 + d4 * 4);
                    d0 += kv.x * q0.x + kv.y * q0.y + kv.z * q0.z + kv.w * q0.w;
                    d1 += kv.x * q1.x + kv.y * q1.y + kv.z * q1.z + kv.w * q1.w;
                    d2 += kv.x * q2.x + kv.y * q2.y + kv.z * q2.z + kv.w * q2.w;
                    d3 += kv.x * q3.x + kv.y * q3.y + kv.z * q3.z + kv.w * q3.w;
                } else {
                    const float4 k0 = *(const float4*)(kp + d4 * 4), k1 = *(const float4*)(kp + 128 + d4 * 4), k2 = *(const float4*)(kp + 256 + d4 * 4), k3 = *(const float4*)(kp + 384 + d4 * 4);
                    const float4 q0 = *(const float4*)(sq + d4 * 4), q1 = *(const float4*)(sq + 128 + d4 * 4), q2 = *(const float4*)(sq + 256 + d4 * 4), q3 = *(const float4*)(sq + 384 + d4 * 4);
                    d0 += k0.x * q0.x + k0.y * q0.y + k0.z * q0.z + k0.w * q0.w;
                    d1 += k1.x * q1.x + k1.y * q1.y + k1.z * q1.z + k1.w * q1.w;
                    d2 += k2.x * q2.x + k2.y * q2.y + k2.z * q2.z + k2.w * q2.w;
                    d3 += k3.x * q3.x + k3.y * q3.y + k3.z * q3.z + k3.w * q3.w;
                }
            }
        }
        const bool ok = lane < len;
        sw[sg * 64 + lane] = ok ? d0 * scale : -1e30f;
        sw[1024 + sg * 64 + lane] = ok ? d1 * scale : -1e30f;
        sw[2048 + sg * 64 + lane] = ok ? d2 * scale : -1e30f;
        sw[3072 + sg * 64 + lane] = ok ? d3 * scale : -1e30f;
    }
    wave_sync();
    const int n = nseg * 64;
#pragma unroll
    for (int g = 0; g < 4; ++g) {
        float mx = -1e30f;
        for (int i = lane; i < n; i += 64) mx = fmaxf(mx, sw[g * 1024 + i]);
        mx = wave_max(mx);
        float sm = 0.f;
        for (int i = lane; i < n; i += 64) { const float v = sw[g * 1024 + i]; sm += (v > -1e29f) ? expf(v - mx) : 0.f; }
        sm = wave_sum(sm);
        const float inv = sm > 0.f ? 1.f / sm : 0.f;
        for (int i = lane; i < n; i += 64) { const float v = sw[g * 1024 + i]; sw[g * 1024 + i] = (v > -1e29f) ? expf(v - mx) * inv : 0.f; }
    }
    wave_sync();
    float o[4][2];
#pragma unroll
    for (int g = 0; g < 4; ++g) { o[g][0] = 0.f; o[g][1] = 0.f; }
    for (int sg = 0; sg < nseg; ++sg) {
        const int start = segs[sg], len = segs[16 + sg];
        for (int l = 0; l < len; ++l) {
            const float* vp = Vb + (size_t)(start + l) * ld;
            if (SHARED) {
                const float v0 = vp[lane], v1 = vp[lane + 64];
#pragma unroll
                for (int g = 0; g < 4; ++g) { const float p = sw[g * 1024 + sg * 64 + l]; o[g][0] += p * v0; o[g][1] += p * v1; }
            } else {
#pragma unroll
                for (int g = 0; g < 4; ++g) { const float p = sw[g * 1024 + sg * 64 + l]; o[g][0] += p * vp[g * 128 + lane]; o[g][1] += p * vp[g * 128 + lane + 64]; }
            }
        }
    }
#pragma unroll
    for (int g = 0; g < 4; ++g) { optr[g * 128 + lane] = o[g][0]; optr[g * 128 + lane + 64] = o[g][1]; }
}

namespace g8 {
constexpr int BM = 256, BK = 64, HALF = 128, HTB = HALF * BK * 2, STAGE_BYTES = 8 * HTB;
constexpr int KK = 2048;
typedef float f32x4 __attribute__((ext_vector_type(4)));
__device__ __forceinline__ int lds_byte(int r, int c) { const int st = (r >> 4) * 2 + (c >> 5), rr = r & 15, cc = c & 31, ob = rr * 64 + cc * 2; return st * 1024 + (ob ^ (((ob >> 9) & 1) << 5)); }
__device__ __forceinline__ void stage_rc(int b, int& R, int& C) { const int st = b / 1024, sb = b % 1024, swz = sb ^ (((sb >> 9) & 1) << 5); R = (st >> 1) * 16 + swz / 64; C = (st & 1) * 32 + (swz % 64) / 2; }
__device__ __forceinline__ int perm32(int rho) { const int n = rho >> 4, i = rho & 15; return 8 * (i >> 2) + 4 * n + (i & 3); }

typedef int i32x4 __attribute__((ext_vector_type(4)));
template <bool I8> struct AccSel { typedef f32x4 T; };
template <> struct AccSel<true> { typedef i32x4 T; };
__device__ __forceinline__ f32x4 mma16(i32x4 a, i32x4 b, f32x4 c) { return __builtin_amdgcn_mfma_f32_16x16x32_f16(*reinterpret_cast<h8*>(&a), *reinterpret_cast<h8*>(&b), c, 0, 0, 0); }
__device__ __forceinline__ i32x4 mma16(i32x4 a, i32x4 b, i32x4 c) { return __builtin_amdgcn_mfma_i32_16x16x64_i8(a, b, c, 0, 0, 0); }
struct Unit { int m0, n0, e, cnt, rbase; };
constexpr int EP_OFF = STAGE_BYTES + 512, EP_LD = 528, EP_GRP = 16 * EP_LD;
__device__ __forceinline__ void ep_sync() { asm volatile("s_waitcnt lgkmcnt(0)" ::: "memory"); __builtin_amdgcn_s_barrier(); asm volatile("" ::: "memory"); }
__device__ __forceinline__ int ep_tid() { int tz = threadIdx.x; asm volatile("" : "+v"(tz)); return tz; }
__device__ __forceinline__ h8 cvt8(f32x4 a, f32x4 b) { h8 o; o[0] = (_Float16)a[0]; o[1] = (_Float16)a[1]; o[2] = (_Float16)a[2]; o[3] = (_Float16)a[3]; o[4] = (_Float16)b[0]; o[5] = (_Float16)b[1]; o[6] = (_Float16)b[2]; o[7] = (_Float16)b[3]; return o; }

__device__ __forceinline__ void tile_order(int L, int nM, int nN, int& pm, int& pn) {
    const int nwg = nM * nN; int wgid = L;
    { const int q = nwg / 8, r = nwg % 8, xcd = wgid % 8, off = wgid / 8; wgid = (xcd < r ? xcd * (q + 1) : r * (q + 1) + (xcd - r) * q) + off; }
    const int nig = 8 * nN, gid = wgid / nig, fm = gid * 8, gsz = (nM - fm) < 8 ? (nM - fm) : 8;
    pm = fm + ((wgid % nig) % gsz); pn = (wgid % nig) / gsz;
}

template <class Prob>
__device__ __forceinline__ void gemm_phase(LAS unsigned char* lds, const Prob& P) {
    const int tid = threadIdx.x, wid = __builtin_amdgcn_readfirstlane(tid >> 6), lane = tid & 63, wr = wid >> 2, wc = wid & 3, fr = lane & 15, fq = lane >> 4;
    constexpr int nt = Prob::NT; constexpr size_t KS2 = Prob::KS2; constexpr unsigned ROWB = Prob::ROWB; constexpr bool I8 = Prob::I8;
    int sR[2], sC2[2]; unsigned voffB[2];
#pragma unroll
    for (int i = 0; i < 2; ++i) { int R, C; stage_rc(tid * 16 + i * 8192, R, C); sR[i] = R; sC2[i] = C * 2; const int Rb = Prob::PERM ? ((R & ~31) + perm32(R & 31)) : R; voffB[i] = (unsigned)Rb * ROWB + (unsigned)C * 2u; }
    const size_t kstep = (size_t)(BK * 2);
    const size_t hstep = (size_t)HALF * ROWB;
    const unsigned ldsw = (unsigned)wid * 1024u;
    const int aoff = lds_byte(wr * 64 + fr, fq * 8), boff = lds_byte(wc * 32 + fr, fq * 8);
#define G8_SA(b, h) (((b) * 2 + (h)) * HTB)
#define G8_SB(b, h) ((4 + (b) * 2 + (h)) * HTB)
#define G8_STAGE(bufoff, gbase, voff) do { _Pragma("unroll") for (int _i = 0; _i < 2; ++_i) \
        __builtin_amdgcn_global_load_lds((const unsigned*)((const char*)(gbase) + (voff)[_i]), (LAS unsigned*)(lds + (bufoff) + ldsw + _i * 8192), 16, 0, 0); } while (0)
#define G8_LDA(dst, b, h) do { _Pragma("unroll") for (int m = 0; m < 4; ++m) _Pragma("unroll") for (int k = 0; k < 2; ++k) dst[m][k] = *(const LAS i32x4*)(lds + G8_SA(b, h) + aoff + m * 2048 + k * 1024); } while (0)
#define G8_LDB(dst, b, h) do { _Pragma("unroll") for (int n = 0; n < 2; ++n) _Pragma("unroll") for (int k = 0; k < 2; ++k) dst[n][k] = *(const LAS i32x4*)(lds + G8_SB(b, h) + boff + n * 2048 + k * 1024); } while (0)
#define G8_MMA(ai, bj, At, Bt) do { __builtin_amdgcn_s_setprio(1); _Pragma("unroll") for (int m = 0; m < 4; ++m) _Pragma("unroll") for (int n = 0; n < 2; ++n) _Pragma("unroll") for (int k = 0; k < 2; ++k) \
        acc[ai][bj][m][n] = mma16(Bt[n][k], At[m][k], acc[ai][bj][m][n]); __builtin_amdgcn_s_setprio(0); } while (0)
#define G8_WAIT_V(n) asm volatile("s_waitcnt vmcnt(" #n ")" ::: "memory")
#define G8_WAIT_L(n) asm volatile("s_waitcnt lgkmcnt(" #n ")" ::: "memory")
#define G8_BAR __builtin_amdgcn_s_barrier()
#define G8_SCHED __builtin_amdgcn_sched_barrier(0)
    Unit cur, nxt; int ui = 0;
    if (!P.next(0, cur)) return;
    typedef typename AccSel<I8>::T AccT;
    AccT acc[2][2][4][2];
#pragma unroll
    for (int a = 0; a < 2; ++a)
#pragma unroll
        for (int b = 0; b < 2; ++b)
#pragma unroll
            for (int m = 0; m < 4; ++m)
#pragma unroll
                for (int n = 0; n < 2; ++n) acc[a][b][m][n] = AccT{};
    i32x4 At[4][2], B0[2][2], B1[2][2];
    unsigned vc[2][2], vn[2][2];
    P.a_offs(cur, sR, sC2, vc);
    const char* const Ab = P.a_base();
    const char* cB = P.b_base(cur);
    G8_STAGE(G8_SB(0, 0), cB, voffB); G8_STAGE(G8_SA(0, 0), Ab, vc[0]); G8_STAGE(G8_SB(0, 1), cB + hstep, voffB); G8_STAGE(G8_SA(0, 1), Ab, vc[1]);
    if (wr == 1) G8_BAR;
    G8_WAIT_V(4); G8_BAR;
    G8_STAGE(G8_SB(1, 0), cB + kstep, voffB); G8_STAGE(G8_SA(1, 0), Ab + kstep, vc[0]); G8_STAGE(G8_SB(1, 1), cB + hstep + kstep, voffB);
    G8_WAIT_V(6); G8_BAR;
    for (;;) {
        const bool has_next = P.next(ui + 1, nxt);
        const char* nB = cB;
        if (has_next) { P.a_offs(nxt, sR, sC2, vn); nB = P.b_base(nxt); }
        else { vn[0][0] = vc[0][0]; vn[0][1] = vc[0][1]; vn[1][0] = vc[1][0]; vn[1][1] = vc[1][1]; }
        for (int t = 0; t < nt; t += 2) {
            const bool last = (t == nt - 2);
            const char* a1 = Ab + (size_t)(t >> 1) * KS2 + kstep;
            const char* a2 = last ? Ab : Ab + (size_t)((t + 2) >> 1) * KS2; const char* b2 = last ? nB : cB + (size_t)(t + 2) * kstep;
            const char* a3 = a2 + kstep; const char* b3 = b2 + kstep;
            unsigned o2[2][2];
            o2[0][0] = last ? vn[0][0] : vc[0][0]; o2[0][1] = last ? vn[0][1] : vc[0][1]; o2[1][0] = last ? vn[1][0] : vc[1][0]; o2[1][1] = last ? vn[1][1] : vc[1][1];
            G8_LDB(B0, 0, 0); G8_SCHED; G8_LDA(At, 0, 0); G8_STAGE(G8_SA(1, 1), a1, vc[1]);
            G8_WAIT_L(8); G8_BAR; G8_WAIT_L(0); G8_MMA(0, 0, At, B0); G8_BAR; G8_SCHED;
            G8_LDB(B1, 0, 1); G8_STAGE(G8_SB(0, 0), b2, voffB);
            G8_BAR; G8_WAIT_L(0); G8_MMA(0, 1, At, B1); G8_BAR;
            G8_LDA(At, 0, 1); G8_STAGE(G8_SA(0, 0), a2, o2[0]);
            G8_BAR; G8_WAIT_L(0); G8_MMA(1, 0, At, B0); G8_BAR; G8_SCHED;
            G8_STAGE(G8_SB(0, 1), b2 + hstep, voffB);
            G8_WAIT_V(6); G8_BAR; G8_MMA(1, 1, At, B1); G8_BAR;
            G8_LDB(B0, 1, 0); G8_SCHED; G8_LDA(At, 1, 0); G8_STAGE(G8_SA(0, 1), a2, o2[1]);
            G8_WAIT_L(8); G8_BAR; G8_WAIT_L(0); G8_MMA(0, 0, At, B0); G8_BAR; G8_SCHED;
            G8_LDB(B1, 1, 1); G8_STAGE(G8_SB(1, 0), b3, voffB);
            G8_BAR; G8_WAIT_L(0); G8_MMA(0, 1, At, B1); G8_BAR;
            G8_LDA(At, 1, 1); G8_STAGE(G8_SA(1, 0), a3, o2[0]);
            G8_BAR; G8_WAIT_L(0); G8_MMA(1, 0, At, B0); G8_BAR; G8_SCHED;
            G8_STAGE(G8_SB(1, 1), b3 + hstep, voffB);
            G8_WAIT_V(6); G8_BAR; G8_MMA(1, 1, At, B1); G8_BAR;
        }
        P.epi(acc, cur, wr, wc, fr, fq, lds);
        if (!has_next) break;
#pragma unroll
        for (int a = 0; a < 2; ++a)
#pragma unroll
            for (int b = 0; b < 2; ++b)
#pragma unroll
                for (int m = 0; m < 4; ++m)
#pragma unroll
                    for (int n = 0; n < 2; ++n) acc[a][b][m][n] = AccT{};
        cur = nxt; cB = nB; ++ui;
        vc[0][0] = vn[0][0]; vc[0][1] = vn[0][1]; vc[1][0] = vn[1][0]; vc[1][1] = vn[1][1];
    }
    G8_WAIT_V(0);
    if (wr == 0) G8_BAR;
    G8_BAR;
#undef G8_SA
#undef G8_SB
#undef G8_STAGE
#undef G8_LDA
#undef G8_LDB
#undef G8_MMA
#undef G8_WAIT_V
#undef G8_WAIT_L
#undef G8_BAR
#undef G8_SCHED
}

struct ProbIn {
    static constexpr unsigned ROWB = 4096; static constexpr bool I8 = false;
    static constexpr int NT = 32; static constexpr size_t KS2 = 256;
    static constexpr bool PERM = true;
    const _Float16* A; _Float16* C16; int G, c;
    __device__ __forceinline__ bool next(int i, Unit& u) const { const int L = i * G + c; if (L >= 64 * 15 + 32) return false;
        if (L < 64 * 15) { int pm, pn; tile_order(L, 64, 15, pm, pn); u.m0 = pm * 256; u.n0 = pn * 256; u.e = 0; }
        else { const int v = L - 64 * 15; u.m0 = T_ + (v & 7) * 256; u.n0 = (v >> 3) * 256; u.e = 1; }
        u.cnt = 256; u.rbase = 0; return true; }
    __device__ __forceinline__ void a_offs(const Unit& u, const int (&R)[2], const int (&C2)[2], unsigned (&v)[2][2]) const {
#pragma unroll
        for (int h = 0; h < 2; ++h)
#pragma unroll
            for (int i = 0; i < 2; ++i) v[h][i] = (unsigned)(u.m0 + h * 128 + R[i]) * (unsigned)(KK * 2) + (unsigned)C2[i]; }
    __device__ __forceinline__ const char* a_base() const { return (const char*)A; }
    __device__ __forceinline__ const char* b_base(const Unit& u) const { return (const char*)A + (u.e ? (long long)(WS_WTMKV - WS_X16) : (long long)(WS_WTIN - WS_X16)) + (size_t)u.n0 * KK * 2; }
    __device__ __forceinline__ void epi(const f32x4 (&acc)[2][2][4][2], const Unit& u, int wr, int wc, int fr, int fq, LAS unsigned char* lds) const {
        LAS unsigned char* ep = lds + EP_OFF + wr * EP_GRP;
        const int tg = ep_tid() & 255, rrow = tg >> 4, ch = tg & 15;
        const int kvseg = (u.e == 0 && u.n0 >= 1024 && u.n0 < 2560) ? ((u.n0 - 1024) >> 8) : -1;
        _Float16* const Cb = (_Float16*)((char*)C16 + (u.e ? (long long)(WS_KVMEM16 - WS_PROJ16) : 0ll)); const int ldc = u.e ? 1024 : INW, nlim = u.e ? 1024 : INW, mb = u.e ? u.m0 - T_ : u.m0;
#pragma unroll
        for (int ai = 0; ai < 2; ++ai)
#pragma unroll
            for (int m = 0; m < 4; ++m) {
#pragma unroll
                for (int bj = 0; bj < 2; ++bj) *(LAS h8*)(ep + fr * EP_LD + (bj * 128 + wc * 32 + fq * 8) * 2) = cvt8(acc[ai][bj][m][0], acc[ai][bj][m][1]);
                ep_sync();
                const h8 x0 = *(const LAS h8*)(ep + rrow * EP_LD + ch * 32), x1 = *(const LAS h8*)(ep + rrow * EP_LD + ch * 32 + 16);
                const int grow = mb + ai * 128 + wr * 64 + m * 16 + rrow, gcol = u.n0 + ch * 16;
                if (kvseg >= 0) {
                    _Float16* dst = (_Float16*)((char*)C16 + (long long)(WS_KV16 - WS_PROJ16)) + ((size_t)(kvseg * B_ + (grow >> 11)) * 2 + (ch >> 3)) * KVSEG + (size_t)(grow & (S_ - 1)) * 128 + (ch & 7) * 16;
                    *(h8*)dst = x0; *(h8*)(dst + 8) = x1;
                } else {
                    if (gcol < nlim) *(h8*)(Cb + (size_t)grow * ldc + gcol) = x0;
                    if (gcol + 8 < nlim) *(h8*)(Cb + (size_t)grow * ldc + gcol + 8) = x1; }
                ep_sync();
            } }
};
struct ProbOut {
    static constexpr unsigned ROWB = 2048; static constexpr bool I8 = true;
    static constexpr int NT = 16; static constexpr size_t KS2 = 256;
    static constexpr bool PERM = true;
    const signed char* A; const signed char* Bt; _Float16* C; const _Float16* X; const float* sa; const float* sw; int G, c;
    __device__ __forceinline__ bool next(int i, Unit& u) const { const int L = i * G + c; if (L >= 64 * 8) return false; int pm, pn; tile_order(L, 64, 8, pm, pn); u.m0 = pm * 256; u.n0 = pn * 256; u.e = 0; u.cnt = 256; u.rbase = 0; return true; }
    __device__ __forceinline__ void a_offs(const Unit& u, const int (&R)[2], const int (&C2)[2], unsigned (&v)[2][2]) const {
#pragma unroll
        for (int h = 0; h < 2; ++h)
#pragma unroll
            for (int i = 0; i < 2; ++i) v[h][i] = (unsigned)(u.m0 + h * 128 + R[i]) * 2048u + (unsigned)C2[i]; }
    __device__ __forceinline__ const char* a_base() const { return (const char*)A; }
    __device__ __forceinline__ const char* b_base(const Unit& u) const { return (const char*)(Bt + (size_t)u.n0 * 2048); }
    __device__ __forceinline__ void epi(const i32x4 (&acc)[2][2][4][2], const Unit& u, int wr, int wc, int fr, int fq, LAS unsigned char* lds) const {
        LAS unsigned char* ep = lds + EP_OFF + wr * EP_GRP;
        const int tg = ep_tid() & 255, rrow = tg >> 4, ch = tg & 15;
        f32x4 s0[2], s1[2]; float srv[8];
#pragma unroll
        for (int bj = 0; bj < 2; ++bj) { const int col = u.n0 + bj * 128 + wc * 32 + fq * 8; s0[bj] = *(const f32x4*)(sw + col); s1[bj] = *(const f32x4*)(sw + col + 4); }
#pragma unroll
        for (int q = 0; q < 8; ++q) srv[q] = sa[u.m0 + (q >> 2) * 128 + wr * 64 + (q & 3) * 16 + fr];
#pragma unroll
        for (int ai = 0; ai < 2; ++ai)
#pragma unroll
            for (int m = 0; m < 4; ++m) { const float sr = srv[ai * 4 + m];
#pragma unroll
                for (int bj = 0; bj < 2; ++bj) { const i32x4 i0 = acc[ai][bj][m][0], i1 = acc[ai][bj][m][1];
                    *(LAS h8*)(ep + fr * EP_LD + (bj * 128 + wc * 32 + fq * 8) * 2) = cvt8((f32x4){(float)i0[0], (float)i0[1], (float)i0[2], (float)i0[3]} * (s0[bj] * sr), (f32x4){(float)i1[0], (float)i1[1], (float)i1[2], (float)i1[3]} * (s1[bj] * sr)); }
                const size_t go = (size_t)(u.m0 + ai * 128 + wr * 64 + m * 16 + rrow) * 2048 + u.n0 + ch * 16;
                const h8 r0 = *(const h8*)(X + go), r1 = *(const h8*)(X + go + 8);
                ep_sync();
                const h8 x0 = *(const LAS h8*)(ep + rrow * EP_LD + ch * 32), x1 = *(const LAS h8*)(ep + rrow * EP_LD + ch * 32 + 16);
                h8 o0, o1;
#pragma unroll
                for (int q = 0; q < 8; ++q) { o0[q] = (_Float16)(DN_ALPHA * (float)r0[q] + (float)x0[q]); o1[q] = (_Float16)(DN_ALPHA * (float)r1[q] + (float)x1[q]); }
                *(h8*)(C + go) = o0; *(h8*)(C + go + 8) = o1;
                ep_sync();
            } }
};
struct ProbCmp {
    static constexpr unsigned ROWB = 4096; static constexpr bool I8 = false;
    static constexpr int NT = 8; static constexpr size_t KS2 = 256;
    static constexpr bool PERM = false;
    const _Float16* A; const _Float16* Bt; float* C; int G, c;
    __device__ __forceinline__ bool next(int i, Unit& u) const { const int L = i * G + c; if (L >= 128) return false;
        u.e = L >> 6; const int r = L & 63; u.rbase = r & 3; u.n0 = ((r >> 2) & 1) * 256; u.m0 = (r >> 3) * 256; u.cnt = 256; return true; }
    __device__ __forceinline__ void a_offs(const Unit& u, const int (&R)[2], const int (&C2)[2], unsigned (&v)[2][2]) const {
#pragma unroll
        for (int h = 0; h < 2; ++h)
#pragma unroll
            for (int i = 0; i < 2; ++i) { const int row = u.m0 + h * 128 + R[i], kvh = row & 1, bj = row >> 1, b = bj >> 7, j = bj & 127;
                v[h][i] = (unsigned)((((u.e * B_ + b) * 2 + kvh) * S_ + 16 * j + 4 * u.rbase) * 128) * 2u + (unsigned)C2[i]; } }
    __device__ __forceinline__ const char* a_base() const { return (const char*)A; }
    __device__ __forceinline__ const char* b_base(const Unit& u) const { return (const char*)(Bt + ((size_t)u.e * 512 + u.n0) * KK + u.rbase * 512); }
    __device__ __forceinline__ void epi(const f32x4 (&acc)[2][2][4][2], const Unit& u, int wr, int wc, int fr, int fq, LAS unsigned char*) const {
        float* base = C + ((size_t)(u.e * 4 + u.rbase) * 2048) * 512;
#pragma unroll
        for (int ai = 0; ai < 2; ++ai)
#pragma unroll
            for (int m = 0; m < 4; ++m) { const int row = u.m0 + ai * 128 + wr * 64 + m * 16 + fr;
#pragma unroll
                for (int bj = 0; bj < 2; ++bj)
#pragma unroll
                    for (int n = 0; n < 2; ++n) { const int col = u.n0 + bj * 128 + wc * 32 + n * 16 + fq * 4;
                        *(f32x4*)(base + (size_t)row * 512 + col) = acc[ai][bj][m][n]; } } }
};
struct MoeTab { const LAS int* t; int NT;
    __device__ __forceinline__ bool find(int L, Unit& u) const {
        const int total = __builtin_amdgcn_readfirstlane(t[98]); if (L >= total) return false;
        int e = 0;
        for (; e < NE - 1; ++e) { if (L < __builtin_amdgcn_readfirstlane(t[32 + e + 1])) break; }
        const int ub = __builtin_amdgcn_readfirstlane(t[32 + e]), cn = __builtin_amdgcn_readfirstlane(t[e]), rs = __builtin_amdgcn_readfirstlane(t[65 + e]);
        const int nm = (cn + 255) >> 8, v = L - ub, mt = v % nm, ntile = v / nm;
        u.e = e; u.m0 = mt * 256; u.n0 = ntile * 256; u.cnt = min(256, cn - mt * 256); u.rbase = rs; return true; } };
struct ProbGu {
    static constexpr int NT = 16; static constexpr size_t KS2 = 256; static constexpr unsigned ROWB = 2048; static constexpr bool I8 = true;
    static constexpr bool PERM = true;
    const signed char* A; const signed char* Bt; _Float16* act; const float* bgu; const int* list; const float* sa; const float* sw; MoeTab tab; int G, vcu;
    __device__ __forceinline__ bool next(int i, Unit& u) const { return tab.find(i * G + vcu, u); }
    __device__ __forceinline__ void a_offs(const Unit& u, const int (&R)[2], const int (&C2)[2], unsigned (&v)[2][2]) const {
#pragma unroll
        for (int h = 0; h < 2; ++h)
#pragma unroll
            for (int i = 0; i < 2; ++i) { int r = h * 128 + R[i]; r = r < u.cnt ? r : 0; const int a = list[(size_t)u.e * T_ + u.m0 + r]; v[h][i] = (unsigned)(a >> 2) * 2048u + (unsigned)C2[i]; } }
    __device__ __forceinline__ const char* a_base() const { return (const char*)A; }
    __device__ __forceinline__ const char* b_base(const Unit& u) const { return (const char*)(Bt + ((size_t)u.e * 4096 + u.n0) * 2048); }
    __device__ __forceinline__ void epi(const i32x4 (&acc)[2][2][4][2], const Unit& u, int wr, int wc, int fr, int fq, LAS unsigned char* lds) const {
        const float* bb = bgu + (size_t)u.e * 4096; const float* ss = sw + (size_t)u.e * 4096;
        LAS unsigned char* ep = lds + EP_OFF + wr * EP_GRP;
        const int tg = ep_tid() & 255, rrow = tg >> 4, ch = tg & 15;
        f32x4 b0[2], b1[2], s0[2], s1[2];
#pragma unroll
        for (int bj = 0; bj < 2; ++bj) { const int col = u.n0 + bj * 128 + wc * 32 + fq * 8;
            b0[bj] = *(const f32x4*)(bb + col); b1[bj] = *(const f32x4*)(bb + col + 4); s0[bj] = *(const f32x4*)(ss + col); s1[bj] = *(const f32x4*)(ss + col + 4); }
        float srv[8];
        { int av[8];
#pragma unroll
          for (int q = 0; q < 8; ++q) { const int rl = (q >> 2) * 128 + wr * 64 + (q & 3) * 16 + fr; av[q] = list[(size_t)u.e * T_ + u.m0 + (rl < u.cnt ? rl : 0)]; }
#pragma unroll
          for (int q = 0; q < 8; ++q) srv[q] = sa[av[q] >> 2]; }
#pragma unroll
        for (int ai = 0; ai < 2; ++ai)
#pragma unroll
            for (int m = 0; m < 4; ++m) { const float sr = srv[ai * 4 + m];
#pragma unroll
                for (int bj = 0; bj < 2; ++bj) {
                    const i32x4 i0 = acc[ai][bj][m][0], i1 = acc[ai][bj][m][1];
                    const f32x4 v0 = (f32x4){(float)i0[0], (float)i0[1], (float)i0[2], (float)i0[3]} * (s0[bj] * sr) + b0[bj], v1 = (f32x4){(float)i1[0], (float)i1[1], (float)i1[2], (float)i1[3]} * (s1[bj] * sr) + b1[bj];
                    h4 o;
                    o[0] = (_Float16)swiglu_fast(v0[0], v0[1]);
                    o[1] = (_Float16)swiglu_fast(v0[2], v0[3]);
                    o[2] = (_Float16)swiglu_fast(v1[0], v1[1]);
                    o[3] = (_Float16)swiglu_fast(v1[2], v1[3]);
                    *(LAS h4*)(ep + fr * EP_LD + (bj * 64 + wc * 16 + fq * 4) * 2) = o; }
                ep_sync();
                const h8 x0 = *(const LAS h8*)(ep + rrow * EP_LD + ch * 16);
                const int rr = ai * 128 + wr * 64 + m * 16 + rrow;
                if (rr < u.cnt) *(h8*)(act + (size_t)(u.rbase + u.m0 + rr) * 2048 + (u.n0 >> 1) + ch * 8) = x0;
                ep_sync();
            } }
};
struct ProbDn {
    static constexpr int NT = 16; static constexpr size_t KS2 = 256; static constexpr unsigned ROWB = 2048; static constexpr bool I8 = true;
    static constexpr bool PERM = true;
    const signed char* A; const signed char* Bt; _Float16* y; const float* bdn; const int* list; const float* gate; const float* sa; const float* sw; MoeTab tab; int G, vcu;
    __device__ __forceinline__ bool next(int i, Unit& u) const { return tab.find(i * G + vcu, u); }
    __device__ __forceinline__ void a_offs(const Unit& u, const int (&R)[2], const int (&C2)[2], unsigned (&v)[2][2]) const {
#pragma unroll
        for (int h = 0; h < 2; ++h)
#pragma unroll
            for (int i = 0; i < 2; ++i) v[h][i] = (unsigned)(u.rbase + u.m0 + h * 128 + R[i]) * 2048u + (unsigned)C2[i]; }
    __device__ __forceinline__ const char* a_base() const { return (const char*)A; }
    __device__ __forceinline__ const char* b_base(const Unit& u) const { return (const char*)(Bt + ((size_t)u.e * 2048 + u.n0) * 2048); }
    __device__ __forceinline__ void epi(const i32x4 (&acc)[2][2][4][2], const Unit& u, int wr, int wc, int fr, int fq, LAS unsigned char* lds) const {
        const float* bb = bdn + (size_t)u.e * 2048; const float* ss = sw + (size_t)u.e * 2048;
        LAS unsigned char* ep = lds + EP_OFF + wr * EP_GRP;
        const int tg = ep_tid() & 255, rrow = tg >> 4, ch = tg & 15;
        f32x4 b0[2], b1[2], s0[2], s1[2];
#pragma unroll
        for (int bj = 0; bj < 2; ++bj) { const int col = u.n0 + bj * 128 + wc * 32 + fq * 8;
            b0[bj] = *(const f32x4*)(bb + col); b1[bj] = *(const f32x4*)(bb + col + 4); s0[bj] = *(const f32x4*)(ss + col); s1[bj] = *(const f32x4*)(ss + col + 4); }
        float gv[8], srv[8]; int a2v[8];
        { int av[8];
#pragma unroll
          for (int q = 0; q < 8; ++q) { const int rl = (q >> 2) * 128 + wr * 64 + (q & 3) * 16 + fr, rc = rl < u.cnt ? rl : 0; av[q] = list[(size_t)u.e * T_ + u.m0 + rc]; srv[q] = sa[u.rbase + u.m0 + rc];
              const int rr = (q >> 2) * 128 + wr * 64 + (q & 3) * 16 + rrow; a2v[q] = list[(size_t)u.e * T_ + u.m0 + (rr < u.cnt ? rr : 0)]; }
#pragma unroll
          for (int q = 0; q < 8; ++q) gv[q] = gate[av[q]]; }
#pragma unroll
        for (int ai = 0; ai < 2; ++ai)
#pragma unroll
            for (int m = 0; m < 4; ++m) { const float g = gv[ai * 4 + m], sr = srv[ai * 4 + m];
#pragma unroll
                for (int bj = 0; bj < 2; ++bj) {
                    const i32x4 i0 = acc[ai][bj][m][0], i1 = acc[ai][bj][m][1];
                    const f32x4 v0 = ((f32x4){(float)i0[0], (float)i0[1], (float)i0[2], (float)i0[3]} * (s0[bj] * sr) + b0[bj]) * g, v1 = ((f32x4){(float)i1[0], (float)i1[1], (float)i1[2], (float)i1[3]} * (s1[bj] * sr) + b1[bj]) * g;
                    *(LAS h8*)(ep + fr * EP_LD + (bj * 128 + wc * 32 + fq * 8) * 2) = cvt8(v0, v1); }
                const int rr = ai * 128 + wr * 64 + m * 16 + rrow;
                const int a2 = a2v[ai * 4 + m];
                ep_sync();
                const h8 x0 = *(const LAS h8*)(ep + rrow * EP_LD + ch * 32), x1 = *(const LAS h8*)(ep + rrow * EP_LD + ch * 32 + 16);
                if (rr < u.cnt) { *(h8*)(y + (size_t)a2 * 2048 + u.n0 + ch * 16) = x0; *(h8*)(y + (size_t)a2 * 2048 + u.n0 + ch * 16 + 8) = x1; }
                ep_sync();
            } }
};
}

namespace at8 {
typedef float f32x16 __attribute__((ext_vector_type(16)));
typedef short s16x4 __attribute__((ext_vector_type(4)));
typedef unsigned u32x4 __attribute__((ext_vector_type(4)));
constexpr int SHM_V = 64 * 128 * 2, SHM_K = 64 * 128 * 2;
constexpr int LDS_WS = 2 * SHM_V + 2 * SHM_K;
constexpr int LDS_END = LDS_WS + 8 * 64 * 4;
constexpr float CEXP = ATT_SCALE * 1.4426950408889634f;
constexpr float THR_RAW = 8.f / ATT_SCALE;
#define AT_KSWZ(row, colB) ((row) * 256 + ((colB) ^ (((row) & 7) << 4)))
#define AT_SBAR() __builtin_amdgcn_sched_barrier(0)
__device__ __forceinline__ int crow(int r, int hi) { return (r & 3) + 8 * (r >> 2) + 4 * hi; }
__device__ __forceinline__ unsigned cvtpk(float lo, float hi) { auto v = __builtin_amdgcn_cvt_pkrtz(lo, hi); return *reinterpret_cast<unsigned*>(&v); }
__device__ __forceinline__ int v_st(int k, int c) { const int kk = (k & ~0xC) | ((k & 4) << 1) | ((k & 8) >> 1); return ((kk >> 3) * 4 + (c >> 5)) * 512 + ((kk & 7) * 32 + (c & 31)) * 2; }
__device__ __forceinline__ int v_rd_base(int lane) { return ((lane & 3) << 3) | (((lane >> 2) & 3) << 6) | (((lane >> 4) & 1) << 5) | (((lane >> 5) & 1) << 8); }
constexpr int v_rd_off(int d0, int ks, int half) { return d0 * 512 + ks * 4096 + half * 2048; }
template <int OFF> __device__ __forceinline__ s16x4 tr_read(int vb) { s16x4 r; asm volatile("ds_read_b64_tr_b16 %0, %1 offset:%2" : "=&v"(r) : "v"(vb), "i"(OFF) : "memory"); return r; }
__device__ __forceinline__ h8 mk8(s16x4 l, s16x4 h) { typedef short s16x8 __attribute__((ext_vector_type(8))); s16x8 w = {l[0], l[1], l[2], l[3], h[0], h[1], h[2], h[3]}; return *reinterpret_cast<h8*>(&w); }
template <int D0> __device__ __forceinline__ void pv_one(f32x16& od, int vb, h8 pa0, h8 pa1, h8 pa2, h8 pa3) {
    const s16x4 l0 = tr_read<v_rd_off(D0, 0, 0)>(vb), h0 = tr_read<v_rd_off(D0, 0, 1)>(vb), l1 = tr_read<v_rd_off(D0, 1, 0)>(vb), h1 = tr_read<v_rd_off(D0, 1, 1)>(vb);
    const s16x4 l2 = tr_read<v_rd_off(D0, 2, 0)>(vb), h2 = tr_read<v_rd_off(D0, 2, 1)>(vb), l3 = tr_read<v_rd_off(D0, 3, 0)>(vb), h3 = tr_read<v_rd_off(D0, 3, 1)>(vb);
    asm volatile("s_waitcnt lgkmcnt(0)" ::: "memory"); AT_SBAR();
    od = __builtin_amdgcn_mfma_f32_32x32x16_f16(pa0, mk8(l0, h0), od, 0, 0, 0);
    od = __builtin_amdgcn_mfma_f32_32x32x16_f16(pa1, mk8(l1, h1), od, 0, 0, 0);
    od = __builtin_amdgcn_mfma_f32_32x32x16_f16(pa2, mk8(l2, h2), od, 0, 0, 0);
    od = __builtin_amdgcn_mfma_f32_32x32x16_f16(pa3, mk8(l3, h3), od, 0, 0, 0);
}
__device__ __forceinline__ void pv_d0(f32x16 (&o)[4], int vb, h8 pa0, h8 pa1, h8 pa2, h8 pa3) {
    pv_one<0>(o[0], vb, pa0, pa1, pa2, pa3); pv_one<1>(o[1], vb, pa0, pa1, pa2, pa3); pv_one<2>(o[2], vb, pa0, pa1, pa2, pa3); pv_one<3>(o[3], vb, pa0, pa1, pa2, pa3);
}
__device__ __forceinline__ void qkt(f32x16& p0, f32x16& p1, const char* Ks, const h8 (&qr)[8], int r32, int hi) {
    p0 = f32x16{}; p1 = f32x16{};
#pragma unroll
    for (int d0 = 0; d0 < 8; ++d0) { const int cb = (d0 * 16 + hi * 8) * 2;
        const h8 b0 = *reinterpret_cast<const h8*>(Ks + AT_KSWZ(r32, cb));
        const h8 b1 = *reinterpret_cast<const h8*>(Ks + AT_KSWZ(32 + r32, cb));
        p0 = __builtin_amdgcn_mfma_f32_32x32x16_f16(b0, qr[d0], p0, 0, 0, 0);
        p1 = __builtin_amdgcn_mfma_f32_32x32x16_f16(b1, qr[d0], p1, 0, 0, 0); }
}
__device__ __forceinline__ void pack_p(const f32x16& p0, const f32x16& p1, h8& pa0, h8& pa1, h8& pa2, h8& pa3) {
#define AT_PK4(P, BASE, OUT) do { unsigned a0 = cvtpk(P[BASE + 0], P[BASE + 1]), a1 = cvtpk(P[BASE + 2], P[BASE + 3]); \
    unsigned b0 = cvtpk(P[BASE + 4], P[BASE + 5]), b1 = cvtpk(P[BASE + 6], P[BASE + 7]); \
    auto r0 = __builtin_amdgcn_permlane32_swap(a0, b0, false, false); auto r1 = __builtin_amdgcn_permlane32_swap(a1, b1, false, false); \
    u32x4 w = {r0[0], r1[0], r0[1], r1[1]}; OUT = *reinterpret_cast<h8*>(&w); } while (0)
    AT_PK4(p0, 0, pa0); AT_PK4(p0, 8, pa1); AT_PK4(p1, 0, pa2); AT_PK4(p1, 8, pa3);
#undef AT_PK4
}
__device__ __forceinline__ float half_swap_max(float v) { auto rr = __builtin_amdgcn_permlane32_swap(__float_as_uint(v), __float_as_uint(v), false, false); return fmaxf(__uint_as_float(rr[0]), __uint_as_float(rr[1])); }
__device__ __forceinline__ float half_swap_sum(float v) { auto rr = __builtin_amdgcn_permlane32_swap(__float_as_uint(v), __float_as_uint(v), false, false); return __uint_as_float(rr[0]) + __uint_as_float(rr[1]); }

struct Stage4 { h8 vs0, vs1, ks0, ks1; };
__device__ __forceinline__ int hidden_tid() { int tz = threadIdx.x; asm volatile("" : "+v"(tz)); return tz; }
__device__ __forceinline__ void sload(Stage4& s, const _Float16* Kb, const _Float16* Vb, int ld, int k0) {
    const int tz = hidden_tid(), sr = tz >> 4, sc = (tz & 15) * 8;
    s.vs0 = *(const h8*)(Vb + (size_t)(k0 + sr) * ld + sc); s.vs1 = *(const h8*)(Vb + (size_t)(k0 + 32 + sr) * ld + sc);
    s.ks0 = *(const h8*)(Kb + (size_t)(k0 + sr) * ld + sc); s.ks1 = *(const h8*)(Kb + (size_t)(k0 + 32 + sr) * ld + sc);
}
__device__ __forceinline__ void swrite(const Stage4& s, char* V_lds, char* K_lds, int b) {
    const int tz = hidden_tid(), sr = tz >> 4, sc = (tz & 15) * 8, vst0 = v_st(sr, sc), vst1 = v_st(32 + sr, sc);
    *(h8*)(V_lds + b * SHM_V + vst0) = s.vs0; *(h8*)(V_lds + b * SHM_V + vst1) = s.vs1;
    const int kc = sc * 2;
    *(h8*)(K_lds + b * SHM_K + AT_KSWZ(sr, kc)) = s.ks0; *(h8*)(K_lds + b * SHM_K + AT_KSWZ(32 + sr, kc)) = s.ks1;
}

__device__ __forceinline__ void attn_unit(char* lds, const _Float16* qrow, const _Float16* Kb, const _Float16* Vb, int ld, unsigned tmask, int wlen, int khi, unsigned selmask,
                                          _Float16* outw, int ostride) {
    const int tid = threadIdx.x, wid = __builtin_amdgcn_readfirstlane(tid >> 6), lane = tid & 63, r32 = lane & 31, hi = lane >> 5;
    char* V_lds = lds; char* K_lds = lds + 2 * SHM_V;
    float* wsf = (float*)(lds + LDS_WS) + wid * 64; float* li_l = wsf; float* al_l = wsf + 32;
    float m_reg = -1e30f, l_reg = 0.f; f32x16 o[4] = {}; h8 qr[8];
#pragma unroll
    for (int d0 = 0; d0 < 8; ++d0) qr[d0] = *(const h8*)(qrow + d0 * 16);
    const int vb0 = (int)(uintptr_t)V_lds + v_rd_base(lane);
    Stage4 st;
    unsigned rest = tmask; int j = __ffs(rest) - 1; rest &= rest - 1;
    sload(st, Kb, Vb, ld, j * 64); asm volatile("s_waitcnt vmcnt(0)" ::: "memory"); swrite(st, V_lds, K_lds, 0); __syncthreads();
    int buf = 0;
    for (;;) {
        const int jn = rest ? (__ffs(rest) - 1) : -1;
        if (jn >= 0) sload(st, Kb, Vb, ld, jn * 64);
        f32x16 p0, p1;
        AT_SBAR(); qkt(p0, p1, K_lds + buf * SHM_K, qr, r32, hi);
        { const int klo = wlen > 0 ? khi - wlen + 1 : 0; const bool tb = (selmask >> j) & 1u; const bool inr = (j * 64 >= klo) && (j * 64 + 63 <= khi);
          if (!__all(tb && inr)) {
              if (__all(inr)) {
#pragma unroll
                  for (int r = 0; r < 16; ++r) { p0[r] = tb ? p0[r] : -INFINITY; p1[r] = tb ? p1[r] : -INFINITY; }
              } else {
                  const int kb = j * 64 + 4 * hi;
#pragma unroll
                  for (int r = 0; r < 16; ++r) { const int k0 = kb + (r & 3) + 8 * (r >> 2);
                      p0[r] = (tb && k0 >= klo && k0 <= khi) ? p0[r] : -INFINITY;
                      p1[r] = (tb && (k0 + 32) >= klo && (k0 + 32) <= khi) ? p1[r] : -INFINITY; }
              } } }
        float pmax = p0[0];
#pragma unroll
        for (int r = 1; r < 16; ++r) pmax = fmaxf(pmax, p0[r]);
#pragma unroll
        for (int r = 0; r < 16; ++r) pmax = fmaxf(pmax, p1[r]);
        pmax = half_swap_max(pmax);
        float mn, alpha;
        if (__all(pmax - m_reg <= THR_RAW)) { mn = m_reg; alpha = 1.f; }
        else { mn = fmaxf(m_reg, pmax); alpha = __builtin_amdgcn_exp2f((m_reg - mn) * CEXP); m_reg = mn; }
        const float mnC = -mn * CEXP;
        float ps = 0.f;
#pragma unroll
        for (int r = 0; r < 16; ++r) { p0[r] = __builtin_amdgcn_exp2f(fmaf(p0[r], CEXP, mnC)); ps += p0[r]; }
#pragma unroll
        for (int r = 0; r < 16; ++r) { p1[r] = __builtin_amdgcn_exp2f(fmaf(p1[r], CEXP, mnC)); ps += p1[r]; }
        ps = half_swap_sum(ps);
        l_reg = l_reg * alpha + ps;
        if (__any(alpha < 1.f)) { if (hi == 0) al_l[r32] = alpha; asm volatile("s_waitcnt lgkmcnt(0)" ::: "memory");
#pragma unroll
            for (int r = 0; r < 16; ++r) { const float a = al_l[crow(r, hi)];
#pragma unroll
                for (int d = 0; d < 4; ++d) o[d][r] *= a; } }
        h8 pa0, pa1, pa2, pa3; pack_p(p0, p1, pa0, pa1, pa2, pa3);
        AT_SBAR();
        pv_d0(o, vb0 + buf * SHM_V, pa0, pa1, pa2, pa3);
        if (jn < 0) break;
        asm volatile("s_waitcnt vmcnt(0)" ::: "memory");
        swrite(st, V_lds, K_lds, buf ^ 1);
        __syncthreads();
        buf ^= 1; j = jn; rest &= rest - 1;
    }
    if (hi == 0) li_l[r32] = l_reg; asm volatile("s_waitcnt lgkmcnt(0)" ::: "memory");
#pragma unroll
    for (int r = 0; r < 16; ++r) { const int orow = crow(r, hi); const float l = li_l[orow]; const float rl = l > 0.f ? 1.f / l : 0.f;
#pragma unroll
        for (int d0 = 0; d0 < 4; ++d0) outw[(size_t)orow * ostride + d0 * 32 + r32] = (_Float16)(o[d0][r] * rl); }
    __syncthreads();
}

constexpr int LDS_AP = LDS_END, LDS_BP = LDS_AP + 4 * 64 * 33 * 4, LDS_SELM = LDS_BP + 4 * 64 * 33 * 4, LDS_CS_END = LDS_SELM + 64 * 4;
__device__ __forceinline__ void cmp_slc_unit(char* lds, const _Float16* qrow, const _Float16* Kc, const _Float16* Vc, const _Float16* Ks, const _Float16* Vs, int t, int tl, int g, int qi,
                                             _Float16* outc, _Float16* outs) {
    const int tid = threadIdx.x, wid = __builtin_amdgcn_readfirstlane(tid >> 6), lane = tid & 63, r32 = lane & 31, hi = lane >> 5;
    char* V_lds = lds; char* K_lds = lds + 2 * SHM_V;
    float* AP = (float*)(lds + LDS_AP); float* BP = (float*)(lds + LDS_BP); unsigned* selm = (unsigned*)(lds + LDS_SELM);
    {
        h8 qr[8];
#pragma unroll
        for (int d0 = 0; d0 < 8; ++d0) qr[d0] = *(const h8*)(qrow + d0 * 16);
        const int vb0 = (int)(uintptr_t)V_lds + v_rd_base(lane);
        { Stage4 s0, s1; sload(s0, Kc, Vc, 256, 0); sload(s1, Kc, Vc, 256, 64);
          asm volatile("s_waitcnt vmcnt(0)" ::: "memory");
          swrite(s0, V_lds, K_lds, 0); swrite(s1, V_lds, K_lds, 1); }
        __syncthreads();
        f32x16 pA0, pA1, pB0, pB1;
        AT_SBAR(); qkt(pA0, pA1, K_lds, qr, r32, hi); qkt(pB0, pB1, K_lds + SHM_K, qr, r32, hi);
        const int khi = t >= 31 ? ((t - 31) >> 4) : -1;
#pragma unroll
        for (int r = 0; r < 16; ++r) { const int c0 = 4 * hi + (r & 3) + 8 * (r >> 2);
            pA0[r] = (c0 <= khi) ? pA0[r] : -INFINITY; pA1[r] = (c0 + 32 <= khi) ? pA1[r] : -INFINITY;
            pB0[r] = (c0 + 64 <= khi) ? pB0[r] : -INFINITY; pB1[r] = (c0 + 96 <= khi) ? pB1[r] : -INFINITY; }
        float pmax = -INFINITY;
#pragma unroll
        for (int r = 0; r < 16; ++r) pmax = fmaxf(fmaxf(pmax, pA0[r]), fmaxf(pA1[r], fmaxf(pB0[r], pB1[r])));
        pmax = half_swap_max(pmax);
        const float mC = (pmax == -INFINITY) ? 0.f : -pmax * CEXP;
        float ps = 0.f;
#pragma unroll
        for (int r = 0; r < 16; ++r) { pA0[r] = __builtin_amdgcn_exp2f(fmaf(pA0[r], CEXP, mC)); pA1[r] = __builtin_amdgcn_exp2f(fmaf(pA1[r], CEXP, mC));
            pB0[r] = __builtin_amdgcn_exp2f(fmaf(pB0[r], CEXP, mC)); pB1[r] = __builtin_amdgcn_exp2f(fmaf(pB1[r], CEXP, mC)); ps += (pA0[r] + pA1[r]) + (pB0[r] + pB1[r]); }
        ps = half_swap_sum(ps);
        const float inv = ps > 0.f ? 1.f / ps : 0.f;
#pragma unroll
        for (int r = 0; r < 16; ++r) { pA0[r] *= inv; pA1[r] *= inv; pB0[r] *= inv; pB1[r] *= inv; }
        { float* ap = AP + (g * 64 + tl) * 33; float* bp = BP + (g * 64 + tl) * 33;
          if (hi == 0) bp[0] = 0.f;
#define AT_IMP(P, JB) do { _Pragma("unroll") for (int k = 0; k < 4; ++k) { const int j = (JB) + 2 * k + hi; \
              ap[j] = 2.f * (P[4 * k] + P[4 * k + 1] + P[4 * k + 2]) + P[4 * k + 3]; if (j + 1 < 32) bp[j + 1] = P[4 * k + 3]; } } while (0)
          AT_IMP(pA0, 0); AT_IMP(pA1, 8); AT_IMP(pB0, 16); AT_IMP(pB1, 24);
#undef AT_IMP
        }
        f32x16 o[4] = {};
        h8 pa0, pa1, pa2, pa3;
        pack_p(pA0, pA1, pa0, pa1, pa2, pa3); AT_SBAR(); pv_d0(o, vb0, pa0, pa1, pa2, pa3);
        pack_p(pB0, pB1, pa0, pa1, pa2, pa3); AT_SBAR(); pv_d0(o, vb0 + SHM_V, pa0, pa1, pa2, pa3);
#pragma unroll
        for (int r = 0; r < 16; ++r) { const int orow = crow(r, hi);
#pragma unroll
            for (int d0 = 0; d0 < 4; ++d0) outc[(size_t)orow * 1024 + d0 * 32 + r32] = (_Float16)o[d0][r]; }
    }
    __syncthreads();
#pragma unroll 1
    for (int it = 0; it < 4; ++it) {
        const int tk = 8 * wid + 2 * it + hi, j = r32;
        float imp = 0.f;
#pragma unroll
        for (int gg = 0; gg < 4; ++gg) imp += AP[(gg * 64 + tk) * 33 + j] + BP[(gg * 64 + tk) * 33 + j];
        const bool forced = (j == 0) || (j == qi) || (j == qi - 1), valid = j <= qi;
        const float iv = forced ? 1e9f : (valid ? imp : -1e9f);
        int rank = 0;
        for (int i = 0; i < 32; ++i) { const float vi = __shfl(iv, i + 32 * hi); rank += (vi > iv || (vi == iv && i < j)) ? 1 : 0; }
        const unsigned long long bal = __ballot(rank < 16 && valid);
        if (r32 == 0) selm[tk] = (unsigned)(bal >> (32 * hi));
    }
    __syncthreads();
    unsigned tm = selm[lane];
#pragma unroll
    for (int o = 32; o > 0; o >>= 1) tm |= __shfl_xor(tm, o);
    const int tz2 = hidden_tid();
    const unsigned mysel = selm[((tz2 >> 6) & 1) * 32 + (tz2 & 31)];
    attn_unit(lds, qrow, Ks, Vs, 128, tm, 0, t, mysel, outs, 1024);
}
}

__device__ __forceinline__ void conv_tile(float* lds, const float* __restrict__ W, int ldw, int nvalid, _Float16* __restrict__ Wt, int K, int k0, int n0) {
    const int tid = threadIdx.x;
    float4 v[8];
#pragma unroll
    for (int i = 0; i < 8; ++i) { const int idx = tid + 512 * i, r = idx >> 6, c4 = (idx & 63) * 4;
        v[i] = (n0 + c4 < nvalid) ? *(const float4*)(W + (size_t)(k0 + r) * ldw + n0 + c4) : make_float4(0.f, 0.f, 0.f, 0.f); }
#pragma unroll
    for (int i = 0; i < 8; ++i) { const int idx = tid + 512 * i, r = idx >> 6, c4 = (idx & 63) * 4; float* d = lds + r * 257 + c4; d[0] = v[i].x; d[1] = v[i].y; d[2] = v[i].z; d[3] = v[i].w; }
    __syncthreads();
#pragma unroll
    for (int j = 0; j < 4; ++j) { const int id = tid + 512 * j, n = id >> 3, k8 = (id & 7) * 8; h8 o;
#pragma unroll
        for (int q = 0; q < 8; ++q) o[q] = (_Float16)lds[(k8 + q) * 257 + n];
        *(h8*)(Wt + (size_t)(n0 + n) * K + k0 + k8) = o; }
    __syncthreads();
}


__device__ __forceinline__ unsigned pack4_i8(float a, float b, float c, float d) {
    const int ia = __float2int_rn(a), ib = __float2int_rn(b), ic = __float2int_rn(c), id = __float2int_rn(d);
    return (unsigned)(ia & 255) | ((unsigned)(ib & 255) << 8) | ((unsigned)(ic & 255) << 16) | ((unsigned)(id & 255) << 24);
}
constexpr int QP_LD2 = 1026;
struct QUnit { const float* W; int ldw; int n0; signed char* Q; float* sc; };
__device__ __forceinline__ QUnit quant_desc(int u, const float* wgu, const float* wdn, signed char* q8gu, signed char* q8dn, float* sgu, float* sdn, const float* wout, signed char* q8out, float* sout) {
    QUnit d;
    if (u >= NE * 192) { const int pn = u - NE * 192; d.W = wout; d.ldw = 2048; d.n0 = pn * 32; d.Q = q8out; d.sc = sout; }
    else if (u < NE * 128) { const int e = u >> 7, pn = u & 127; d.W = wgu + (size_t)e * 2048 * 4096; d.ldw = 4096; d.n0 = pn * 32; d.Q = q8gu + (size_t)e * 4096 * 2048; d.sc = sgu + (size_t)e * 4096; }
    else { const int v = u - NE * 128, e = v >> 6, pn = v & 63; d.W = wdn + (size_t)e * 2048 * 2048; d.ldw = 2048; d.n0 = pn * 32; d.Q = q8dn + (size_t)e * 2048 * 2048; d.sc = sdn + (size_t)e * 2048; }
    return d;
}
__device__ __forceinline__ unsigned pk2h(float a, float b) { auto v = __builtin_amdgcn_cvt_pkrtz(a, b); return *reinterpret_cast<unsigned*>(&v); }
__device__ __forceinline__ void quant_all(char* smem, const float* wgu, const float* wdn, signed char* q8gu, signed char* q8dn, float* sgu, float* sdn, const float* wout, signed char* q8out, float* sout, int bid, int nb) {
    constexpr int NU = NE * 128 + NE * 64 + 64;
    unsigned* Tt = (unsigned*)smem;
    unsigned* cmaxb = (unsigned*)(smem + 32 * QP_LD2 * 4);
    const int tid = threadIdx.x, c4 = (tid & 7) * 4, kp = tid >> 3;
    if (tid < 64) cmaxb[tid] = 0u;
    __syncthreads();
    int u = bid; if (u >= NU) return;
    QUnit d = quant_desc(u, wgu, wdn, q8gu, q8dn, sgu, sdn, wout, q8out, sout);
    float4 va[8], vb[8];
#define QL(dst, D, bt) do { _Pragma("unroll") for (int j = 0; j < 4; ++j) { const float* p0 = (D).W + (size_t)(((bt) * 4 + j) * 128 + 2 * kp) * (D).ldw + (D).n0 + c4; dst[2 * j] = *(const float4*)p0; dst[2 * j + 1] = *(const float4*)(p0 + (D).ldw); } } while (0)
#define QP(src, bt) do { _Pragma("unroll") for (int j = 0; j < 4; ++j) { const int kg = ((bt) * 4 + j) * 64 + kp; const float4 r0 = src[2 * j], r1 = src[2 * j + 1]; \
        Tt[(c4 + 0) * QP_LD2 + kg] = pk2h(r0.x, r1.x); Tt[(c4 + 1) * QP_LD2 + kg] = pk2h(r0.y, r1.y); Tt[(c4 + 2) * QP_LD2 + kg] = pk2h(r0.z, r1.z); Tt[(c4 + 3) * QP_LD2 + kg] = pk2h(r0.w, r1.w); \
        m0 = fmaxf(m0, fmaxf(fabsf(r0.x), fabsf(r1.x))); m1 = fmaxf(m1, fmaxf(fabsf(r0.y), fabsf(r1.y))); m2 = fmaxf(m2, fmaxf(fabsf(r0.z), fabsf(r1.z))); m3 = fmaxf(m3, fmaxf(fabsf(r0.w), fabsf(r1.w))); } } while (0)
    QL(va, d, 0);
    int par = 0;
    for (;;) {
        unsigned* cmax = cmaxb + par * 32;
        float m0 = 0.f, m1 = 0.f, m2 = 0.f, m3 = 0.f;
        QL(vb, d, 1); QP(va, 0);
        QL(va, d, 2); QP(vb, 1);
        QL(vb, d, 3); QP(va, 2);
        const int un = u + nb; const bool has = un < NU;
        QUnit dn = d; if (has) { dn = quant_desc(un, wgu, wdn, q8gu, q8dn, sgu, sdn, wout, q8out, sout); QL(va, dn, 0); }
        QP(vb, 3);
        atomicMax(&cmax[c4 + 0], __float_as_uint(m0)); atomicMax(&cmax[c4 + 1], __float_as_uint(m1)); atomicMax(&cmax[c4 + 2], __float_as_uint(m2)); atomicMax(&cmax[c4 + 3], __float_as_uint(m3));
        __syncthreads();
        if (tid < 32) cmaxb[(par ^ 1) * 32 + tid] = 0u;
#pragma unroll
        for (int j = 0; j < 8; ++j) { const int id = tid + 512 * j, n = id >> 7, k16 = (id & 127) * 16;
            const float mx = __uint_as_float(cmax[n]); const float inv = mx > 0.f ? 127.f / mx : 0.f;
            const h4* src = (const h4*)(Tt + n * QP_LD2 + (k16 >> 1));
            const h4 a = src[0], b = src[1], c = src[2], e4 = src[3];
            uint4 o;
            o.x = pack4_i8((float)a[0] * inv, (float)a[1] * inv, (float)a[2] * inv, (float)a[3] * inv); o.y = pack4_i8((float)b[0] * inv, (float)b[1] * inv, (float)b[2] * inv, (float)b[3] * inv);
            o.z = pack4_i8((float)c[0] * inv, (float)c[1] * inv, (float)c[2] * inv, (float)c[3] * inv); o.w = pack4_i8((float)e4[0] * inv, (float)e4[1] * inv, (float)e4[2] * inv, (float)e4[3] * inv);
            *(uint4*)(d.Q + (size_t)(d.n0 + n) * 2048 + k16) = o; }
        if (tid < 32) { const float mx = __uint_as_float(cmax[tid]); d.sc[d.n0 + tid] = mx > 0.f ? mx / 127.f : 1.f; }
        __syncthreads();
        if (!has) break;
        u = un; d = dn; par ^= 1;
    }
#undef QL
#undef QP
}

__global__ void __launch_bounds__(512, 2) fwd(Params p) {
    extern __shared__ __attribute__((aligned(16))) char smem[];
    const int tid = threadIdx.x, wv = __builtin_amdgcn_readfirstlane(tid >> 6);
#define LANE_NOW ({ int _t = threadIdx.x; asm volatile("" : "+v"(_t)); _t & 63; })
    const int bid = blockIdx.x, nb = gridDim.x;
    const int gw = bid * 8 + wv, nw = nb * 8;
    const int lo = (int)(p.lo_hi & 0xffffffffll), hi = (int)(p.lo_hi >> 32);
    unsigned char* ws = p.ws;
    unsigned* ctl = (unsigned*)(ws + WS_CTL);
    int* cnt = (int*)(ws + CTL_CNT);
    float* proj = (float*)(ws + WS_PROJ);
    float* kvmem = (float*)(ws + WS_KVMEM);
    float* bias1 = (float*)(ws + WS_BIAS1);
    float* hid = (float*)(ws + WS_HID);
    float* kc = (float*)(ws + WS_KC);
    float* vc = (float*)(ws + WS_VC);
    float* pooled = (float*)(ws + WS_POOLED);
    _Float16* opool = (_Float16*)(ws + WS_OPOOL);
    _Float16* owin = (_Float16*)(ws + WS_OWIN);
    _Float16* ocmp = (_Float16*)(ws + WS_OCMP);
    _Float16* oslc = (_Float16*)(ws + WS_OSLC);
    unsigned* sel = (unsigned*)(ws + WS_SEL);
    _Float16* omem = (_Float16*)(ws + WS_OMEM);
    _Float16* cat16 = (_Float16*)(ws + WS_CAT16);
    _Float16* hpre16 = (_Float16*)(ws + WS_HPRE);
    float* hbuf = (float*)(ws + WS_H);
    float* gate = (float*)(ws + WS_GATE);
    int* list = (int*)(ws + WS_LIST);
    _Float16* act16 = (_Float16*)(ws + WS_ACT16);
    _Float16* y16 = (_Float16*)(ws + WS_Y16);
    _Float16* h16 = (_Float16*)(ws + WS_H16);
    _Float16* x16 = (_Float16*)(ws + WS_X16);
    _Float16* wtin = (_Float16*)(ws + WS_WTIN);
    _Float16* wtout = (_Float16*)(ws + WS_WTOUT);
    _Float16* wtgu = (_Float16*)(ws + WS_WTGU);
    _Float16* wtdn = (_Float16*)(ws + WS_WTDN);
    LAS unsigned char* lds = (LAS unsigned char*)smem;
    _Float16* proj16 = (_Float16*)(ws + WS_PROJ16);
    _Float16* kvmem16 = (_Float16*)(ws + WS_KVMEM16);
    _Float16* wt1 = (_Float16*)(ws + WS_WT1);
    float* uv = (float*)(ws + WS_UV);
    _Float16* kc16 = (_Float16*)(ws + WS_KC16);
    _Float16* vc16 = (_Float16*)(ws + WS_VC16);
    _Float16* wr16 = (_Float16*)(ws + WS_WR16);
    _Float16* mem16 = (_Float16*)(ws + WS_MEM16);
    _Float16* wtmkv = (_Float16*)(ws + WS_WTMKV);
    _Float16* kv16 = (_Float16*)(ws + WS_KV16);
    signed char* q8out = (signed char*)(ws + WS_Q8OUT); float* sout = (float*)(ws + WS_SOUT); signed char* cat8 = (signed char*)(ws + WS_CAT8); float* scat = (float*)(ws + WS_SCAT);
    signed char* q8gu = (signed char*)(ws + WS_Q8GU); signed char* q8dn = (signed char*)(ws + WS_Q8DN);
    float* sgu = (float*)(ws + WS_SGU); float* sdn = (float*)(ws + WS_SDN);
    signed char* h8q = (signed char*)(ws + WS_H8); float* sah = (float*)(ws + WS_SAH);
    signed char* act8 = (signed char*)(ws + WS_ACT8); float* sact = (float*)(ws + WS_SACT);
    const int vcu = (nb % 8 == 0) ? (bid % 8) * (nb / 8) + bid / 8 : bid;

    volatile LAS unsigned* xbw = (volatile LAS unsigned*)(smem + LDS_BYTES - 16);
    if (tid == 0) { xbw[0] = 0u; xbw[1] = 0u; xbw[2] = 0u; xbw[3] = 0u; }
    __syncthreads();
    XcdBarrier bar; bar.bar = ctl; bar.x = 0; bar.st = xbw;
    const bool multi = (hi - lo) > 1;
    if (multi) bar = xcd_barrier_post(ctl, xbw);
#define IN(k) (lo <= (k) && (k) < hi)
#define SEAM(k) do { if (IN(k) && IN((k) + 1)) xcd_barrier(bar); } while (0)
    float* sw = (float*)smem + wv * WLDS_FLOATS;
    int* segw = (int*)(sw + 4096 + 512);

    if (IN(0)) {
        const int lane = LANE_NOW; (void)lane;
        for (int j = gw; j < 512; j += nw) {
            const int kv = j >> 8, jj = j & 255;
            const float* pos = p.in[kv ? I_POSV : I_POSK]; const float* w1 = p.in[kv ? I_W1V : I_W1K];
            float s = 0.f;
            for (int k = lane; k < 4096; k += 64) s += pos[k] * w1[(size_t)k * 256 + jj];
            s = wave_sum(s);
            if (lane == 0) bias1[j] = s;
        }
        for (int i = bid * 512 + tid; i < 32 * 2048; i += nb * 512) { const int e = i >> 11, d = i & 2047; wr16[i] = (_Float16)p.in[I_WR][(size_t)d * 32 + e]; }
        for (size_t i = (size_t)bid * 512 + tid; i < (size_t)T_ * 2048 / 4; i += (size_t)nb * 512) {
            const float4 v = ((const float4*)p.in[I_X])[i]; ((h4*)x16)[i] = (h4){(_Float16)v.x, (_Float16)v.y, (_Float16)v.z, (_Float16)v.w};
        }
        {
            constexpr int U_IN = 32 * 15, U_OUT = 0, U_W1 = 128;
            quant_all(smem, p.in[I_WGU], p.in[I_WDN], q8gu, q8dn, sgu, sdn, p.in[I_WOUT], q8out, sout, bid, nb);
            __syncthreads();
            for (int u = bid; u < U_IN + U_OUT + U_W1; u += nb) {
                if (u < U_IN) { const int v = u, kt = v / 15, ntl = v % 15;
                    conv_tile((float*)smem, p.in[I_WIN], INW, INW, wtin, 2048, kt * 64, ntl * 256);
                } else if (u < U_IN + U_OUT) {
                } else { const int v = u - U_IN - U_OUT, kv = v >> 6, part = (v >> 5) & 1, kt = v & 31;
                    conv_tile((float*)smem, p.in[kv ? I_W1V : I_W1K] + (size_t)part * 2048 * 256, 256, 256, wt1 + ((size_t)kv * 512 + part * 256) * 2048, 2048, kt * 64, 0);
                }
            }
        }
        for (size_t i = (size_t)bid * 512 + tid; i < (size_t)2048 * 2048 / 4; i += (size_t)nb * 512) {
            const float4 v = ((const float4*)p.in[I_MEM])[i]; ((h4*)mem16)[i] = (h4){(_Float16)v.x, (_Float16)v.y, (_Float16)v.z, (_Float16)v.w};
        }
        for (int u = bid; u < 128; u += nb) { const int kt = u >> 2, ntl = u & 3; conv_tile((float*)smem, p.in[I_WMEMKV], 1024, 1024, wtmkv, 2048, kt * 64, ntl * 256); }
    }
    SEAM(0);
    if (IN(1)) {
        const int lane = LANE_NOW; (void)lane;
        g8::ProbIn P{x16, proj16, nb, bid};
        g8::gemm_phase(lds, P);
    }
    SEAM(1);
    if (IN(2)) {
        const int lane = LANE_NOW; (void)lane;
        { g8::ProbCmp P{kv16, wt1, uv, nb, bid}; g8::gemm_phase(lds, P); __syncthreads(); }
        for (int i = bid * 512 + tid; i < T_ * 64; i += nb * 512) {
            const int chn = i & 63, row = i >> 6, t = row & (S_ - 1), g = chn >> 4;
            const int win = 2 << g, n = min(win, t + 1);
            const _Float16* src = proj16 + (size_t)row * INW + C_UP + chn * 8;
            float a[8];
            const h8 cur = *(const h8*)src;
#pragma unroll
            for (int q = 0; q < 8; ++q) a[q] = (float)cur[q];
            for (int k = 1; k < n; ++k) { const h8 v = *(const h8*)(src - (size_t)k * INW);
#pragma unroll
                for (int q = 0; q < 8; ++q) a[q] += (float)v[q]; }
            const float rn = 1.f / (float)n;
            float4 o0, o1;
            o0.x = a[0] * rn - (float)cur[0]; o0.y = a[1] * rn - (float)cur[1]; o0.z = a[2] * rn - (float)cur[2]; o0.w = a[3] * rn - (float)cur[3];
            o1.x = a[4] * rn - (float)cur[4]; o1.y = a[5] * rn - (float)cur[5]; o1.z = a[6] * rn - (float)cur[6]; o1.w = a[7] * rn - (float)cur[7];
            *(float4*)(pooled + (size_t)row * 512 + chn * 8) = o0; *(float4*)(pooled + (size_t)row * 512 + chn * 8 + 4) = o1;
        }
        {
            const int r32 = lane & 31, hi = lane >> 5, g = wv >> 1, half = wv & 1;
            for (int uu = vcu; uu < 512; uu += nb) {
                const int v = uu & 255, bk = v >> 4, qi = (uu >> 8) ? 31 - (v & 15) : (v & 15), b = bk >> 1, kvh = bk & 1;
                const int t = qi * 64 + half * 32 + r32;
                const int lo_t = max(0, qi - 8);
                const unsigned tmask = (unsigned)(((1ull << (qi + 1)) - 1ull) & ~((1ull << lo_t) - 1ull));
                at8::attn_unit(smem, proj16 + (size_t)(b * S_ + t) * INW + C_Q + (kvh * 4 + g) * 128 + hi * 8,
                               kv16 + ((size_t)(4 * B_ + b) * 2 + kvh) * KVSEG, kv16 + ((size_t)(5 * B_ + b) * 2 + kvh) * KVSEG, 128, tmask, 512, t, 0xffffffffu,
                               owin + (size_t)(b * S_ + qi * 64 + half * 32) * 1024 + (kvh * 4 + g) * 128, 1024);
            }
            for (int u = vcu; u < 256; u += nb) {
                const int b = u >> 5, h = (u >> 3) & 3, qt = u & 7;
                const int t = qt * 256 + wv * 32 + r32;
                at8::attn_unit(smem, proj16 + (size_t)(b * S_ + t) * INW + C_QM + h * 128 + hi * 8,
                               kvmem16 + (size_t)b * 256 * 1024 + h * 128, kvmem16 + (size_t)b * 256 * 1024 + 512 + h * 128, 1024, 0xFu, 0, 255, 0xffffffffu,
                               omem + (size_t)(b * S_ + qt * 256 + wv * 32) * 512 + h * 128, 512);
            }
        }
    }
    SEAM(2);
    if (IN(3)) {
        const int lane = LANE_NOW; (void)lane;
        {   float* hs = (float*)smem;
            for (int u = bid; u < 508; u += nb) {
                const int kv = u / 254, ub = u % 254;
                const float* w2 = p.in[kv ? I_W2V : I_W2K]; _Float16* dst = kv ? vc16 : kc16;
                __syncthreads();
#pragma unroll
                for (int q = 0; q < 4; ++q) { const int e = tid + 512 * q, i = e >> 8, n = e & 255;
                    const int idx = ub * 8 + i, b = idx / 254, rem = idx % 254, c = rem >> 1, kvh = rem & 1;
                    const int row = (b * 128 + c) * 2 + kvh;
                    float a = bias1[kv * 256 + n];
#pragma unroll
                    for (int sp = 0; sp < 4; ++sp) { const float* base = uv + ((size_t)(kv * 4 + sp) * 2048) * 512; a += base[(size_t)row * 512 + n] + base[(size_t)(row + 2) * 512 + 256 + n]; }
                    hs[i * 256 + n] = gelu_tanh(a); }
                __syncthreads();
#pragma unroll
                for (int q = 0; q < 2; ++q) { const int e = tid + 512 * q, i = e >> 7, d = e & 127;
                    const int idx = ub * 8 + i, b = idx / 254, rem = idx % 254, c = rem >> 1, kvh = rem & 1;
                    float a = 0.f;
                    for (int n = 0; n < 256; ++n) a += hs[i * 256 + n] * w2[n * 128 + d];
                    dst[(size_t)((b * 128 + c) * 2 + kvh) * 128 + d] = (_Float16)a; }
            }
            __syncthreads();
            for (int i = bid * 512 + tid; i < 2 * B_ * 256; i += nb * 512) { const int kv = i / (B_ * 256), r = i % (B_ * 256), b = r >> 8, x = r & 255;
                (kv ? vc16 : kc16)[(size_t)(b * 128 + 127) * 256 + x] = (_Float16)0.f; }
        }
        for (int u = bid; u < 128 * 4; u += nb) { const int g = u >> 7, mt = u & 127;
            ARowPlain af{pooled + g * 128, 512, mt * 128, T_}; EpiPool ef{opool, p.in[I_POOLS], mt * 128, g};
            gemm_tile(smem, 128, af, p.in[I_POOLW] + (size_t)g * 128 * 128, 128, 0, 128, false, ef);
        }
    }
    SEAM(3);
    if (IN(4)) {
        const int lane = LANE_NOW; (void)lane;
        const int r32 = lane & 31, hi = lane >> 5, g = wv >> 1, half = wv & 1;
        for (int uu = vcu; uu < 512; uu += nb) {
            const int v = uu & 255, bk = v >> 4, qi = (uu >> 8) ? 31 - (v & 15) : (v & 15), b = bk >> 1, kvh = bk & 1;
            const int tl = half * 32 + r32, t = qi * 64 + tl;
            at8::cmp_slc_unit(smem, proj16 + (size_t)(b * S_ + t) * INW + C_Q + (kvh * 4 + g) * 128 + hi * 8,
                              kc16 + (size_t)(b * 128 * 2 + kvh) * 128, vc16 + (size_t)(b * 128 * 2 + kvh) * 128,
                              kv16 + ((size_t)(2 * B_ + b) * 2 + kvh) * KVSEG, kv16 + ((size_t)(3 * B_ + b) * 2 + kvh) * KVSEG, t, tl, g, qi,
                              ocmp + (size_t)(b * S_ + qi * 64 + half * 32) * 1024 + (kvh * 4 + g) * 128, oslc + (size_t)(b * S_ + qi * 64 + half * 32) * 1024 + (kvh * 4 + g) * 128);
        }
    }
    SEAM(4);
    if (IN(5)) {
        const int lane = LANE_NOW;
        for (int row = gw; row < T_; row += nw) {
            const _Float16* pr = proj16 + (size_t)row * INW + C_G;
            float v[32]; float ss = 0.f;
#pragma unroll
            for (int c = 0; c < 2; ++c) { const int col = (lane + 64 * c) * 8, h = col >> 7; const size_t o = (size_t)row * 1024 + col;
                const float g0 = sigmoidf_((float)pr[h * 3]), g1 = sigmoidf_((float)pr[h * 3 + 1]), g2 = sigmoidf_((float)pr[h * 3 + 2]);
                const h8 a = *(const h8*)(ocmp + o), b2 = *(const h8*)(oslc + o), c2 = *(const h8*)(owin + o);
#pragma unroll
                for (int q = 0; q < 8; ++q) { const float x = g0 * (float)a[q] + g1 * (float)b2[q] + g2 * (float)c2[q]; v[c * 8 + q] = x; ss += x * x; } }
            ss = wave_sum(ss); float r = rsqrtf(ss / 1024.f + LN_EPS);
#pragma unroll
            for (int c = 0; c < 2; ++c) { const int col = (lane + 64 * c) * 8; const float4 ga = *(const float4*)(p.in[I_GNNSA] + col), gb = *(const float4*)(p.in[I_GNNSA] + col + 4);
                v[c * 8 + 0] *= r * ga.x; v[c * 8 + 1] *= r * ga.y; v[c * 8 + 2] *= r * ga.z; v[c * 8 + 3] *= r * ga.w; v[c * 8 + 4] *= r * gb.x; v[c * 8 + 5] *= r * gb.y; v[c * 8 + 6] *= r * gb.z; v[c * 8 + 7] *= r * gb.w; }
            { const h8 a = *(const h8*)(opool + (size_t)row * 512 + lane * 8); ss = 0.f;
#pragma unroll
              for (int q = 0; q < 8; ++q) { v[16 + q] = (float)a[q]; ss += v[16 + q] * v[16 + q]; }
              ss = wave_sum(ss); r = rsqrtf(ss / 512.f + LN_EPS);
              const float4 ga = *(const float4*)(p.in[I_GNPOOL] + lane * 8), gb = *(const float4*)(p.in[I_GNPOOL] + lane * 8 + 4);
              v[16] *= r * ga.x; v[17] *= r * ga.y; v[18] *= r * ga.z; v[19] *= r * ga.w; v[20] *= r * gb.x; v[21] *= r * gb.y; v[22] *= r * gb.z; v[23] *= r * gb.w; }
            { const h8 a = *(const h8*)(omem + (size_t)row * 512 + lane * 8); ss = 0.f;
#pragma unroll
              for (int q = 0; q < 8; ++q) { v[24 + q] = (float)a[q]; ss += v[24 + q] * v[24 + q]; }
              ss = wave_sum(ss); r = rsqrtf(ss / 512.f + LN_EPS);
              const float4 ga = *(const float4*)(p.in[I_GNMEM] + lane * 8), gb = *(const float4*)(p.in[I_GNMEM] + lane * 8 + 4);
              v[24] *= r * ga.x; v[25] *= r * ga.y; v[26] *= r * ga.z; v[27] *= r * ga.w; v[28] *= r * gb.x; v[29] *= r * gb.y; v[30] *= r * gb.z; v[31] *= r * gb.w; }
            float amax = 0.f;
#pragma unroll
            for (int k = 0; k < 32; ++k) amax = fmaxf(amax, fabsf(v[k]));
            amax = wave_max(amax);
            const float qinv = amax > 0.f ? 127.f / amax : 0.f;
            if (lane == 0) scat[row] = amax > 0.f ? amax / 127.f : 1.f;
#pragma unroll
            for (int c = 0; c < 4; ++c) { const int col = c < 2 ? (lane + 64 * c) * 8 : (c == 2 ? 1024 + lane * 8 : 1536 + lane * 8);
                uint2 q; q.x = pack4_i8(v[c * 8 + 0] * qinv, v[c * 8 + 1] * qinv, v[c * 8 + 2] * qinv, v[c * 8 + 3] * qinv); q.y = pack4_i8(v[c * 8 + 4] * qinv, v[c * 8 + 5] * qinv, v[c * 8 + 6] * qinv, v[c * 8 + 7] * qinv);
                *(uint2*)(cat8 + (size_t)row * 2048 + col) = q; }
        }
    }
    SEAM(5);
    if (IN(6)) {
        const int lane = LANE_NOW; (void)lane;
        g8::ProbOut P{cat8, q8out, hpre16, x16, scat, sout, nb, bid};
        g8::gemm_phase(lds, P);
    }
    SEAM(6);
    if (IN(7)) {
        const int lane = LANE_NOW; (void)lane;
        float* lg = (float*)smem;
        const int r32 = lane & 31, hi = lane >> 5, fr = lane & 15, fq = lane >> 4;
        for (int u = bid; u < T_ / 64; u += nb) {
            const int base = u * 64;
#pragma unroll 1
            for (int i = 0; i < 8; ++i) {
                const int row = base + wv * 8 + i;
                float v[32]; float s = 0.f;
#pragma unroll
                for (int c = 0; c < 4; ++c) { const int col = (lane + 64 * c) * 8;
                    const h8 a0 = *(const h8*)(hpre16 + (size_t)row * 2048 + col);
#pragma unroll
                    for (int q = 0; q < 8; ++q) { v[c * 8 + q] = (float)a0[q]; s += v[c * 8 + q]; } }
                const float mu = wave_sum(s) / 2048.f; float q2 = 0.f;
#pragma unroll
                for (int k = 0; k < 32; ++k) { const float d = v[k] - mu; q2 += d * d; }
                const float rs = rsqrtf(wave_sum(q2) / 2048.f + LN_EPS);
                float amax = 0.f;
#pragma unroll
                for (int c = 0; c < 4; ++c) { const int col = (lane + 64 * c) * 8;
                    const float4 g0 = *(const float4*)(p.in[I_LN1G] + col), g1 = *(const float4*)(p.in[I_LN1G] + col + 4), b0 = *(const float4*)(p.in[I_LN1B] + col), b1 = *(const float4*)(p.in[I_LN1B] + col + 4);
                    float4 o0, o1;
                    o0.x = (v[c * 8 + 0] - mu) * rs * g0.x + b0.x; o0.y = (v[c * 8 + 1] - mu) * rs * g0.y + b0.y; o0.z = (v[c * 8 + 2] - mu) * rs * g0.z + b0.z; o0.w = (v[c * 8 + 3] - mu) * rs * g0.w + b0.w;
                    o1.x = (v[c * 8 + 4] - mu) * rs * g1.x + b1.x; o1.y = (v[c * 8 + 5] - mu) * rs * g1.y + b1.y; o1.z = (v[c * 8 + 6] - mu) * rs * g1.z + b1.z; o1.w = (v[c * 8 + 7] - mu) * rs * g1.w + b1.w;
                    h8 oh; oh[0] = (_Float16)o0.x; oh[1] = (_Float16)o0.y; oh[2] = (_Float16)o0.z; oh[3] = (_Float16)o0.w; oh[4] = (_Float16)o1.x; oh[5] = (_Float16)o1.y; oh[6] = (_Float16)o1.z; oh[7] = (_Float16)o1.w;
                    *(h8*)(h16 + (size_t)row * 2048 + col) = oh;
                    v[c * 8 + 0] = o0.x; v[c * 8 + 1] = o0.y; v[c * 8 + 2] = o0.z; v[c * 8 + 3] = o0.w; v[c * 8 + 4] = o1.x; v[c * 8 + 5] = o1.y; v[c * 8 + 6] = o1.z; v[c * 8 + 7] = o1.w;
                    amax = fmaxf(amax, fmaxf(fmaxf(fmaxf(fabsf(o0.x), fabsf(o0.y)), fmaxf(fabsf(o0.z), fabsf(o0.w))), fmaxf(fmaxf(fabsf(o1.x), fabsf(o1.y)), fmaxf(fabsf(o1.z), fabsf(o1.w))))); }
                amax = wave_max(amax);
                const float qinv = amax > 0.f ? 127.f / amax : 0.f;
                if (lane == 0) sah[row] = amax > 0.f ? amax / 127.f : 1.f;
#pragma unroll
                for (int c = 0; c < 4; ++c) { const int col = (lane + 64 * c) * 8;
                    uint2 q; q.x = pack4_i8(v[c * 8 + 0] * qinv, v[c * 8 + 1] * qinv, v[c * 8 + 2] * qinv, v[c * 8 + 3] * qinv); q.y = pack4_i8(v[c * 8 + 4] * qinv, v[c * 8 + 5] * qinv, v[c * 8 + 6] * qinv, v[c * 8 + 7] * qinv);
                    *(uint2*)(h8q + (size_t)row * 2048 + col) = q; }
            }
            asm volatile("s_waitcnt vmcnt(0)" ::: "memory");
            __syncthreads();
            {
                const int tok0 = base + 16 * (wv >> 1), e0 = 16 * (wv & 1);
                const _Float16* ap = h16 + (size_t)(tok0 + fr) * 2048 + fq * 8; const _Float16* bp = wr16 + (size_t)(e0 + fr) * 2048 + fq * 8;
                f4 acc = (f4){0.f, 0.f, 0.f, 0.f};
#pragma unroll 8
                for (int sI = 0; sI < 64; ++sI) { const h8 a = *(const h8*)(ap + sI * 32), bb = *(const h8*)(bp + sI * 32); acc = __builtin_amdgcn_mfma_f32_16x16x32_f16(a, bb, acc, 0, 0, 0); }
                const float br = p.in[I_BR][e0 + fr];
#pragma unroll
                for (int j = 0; j < 4; ++j) lg[(16 * (wv >> 1) + 4 * fq + j) * 33 + e0 + fr] = acc[j] + br;
            }
            __syncthreads();
#pragma unroll 1
            for (int it = 0; it < 4; ++it) {
                const int tk = 8 * wv + 2 * it + hi;
                const float iv = lg[tk * 33 + r32];
                int rank = 0;
                for (int i = 0; i < 32; ++i) { const float vi = __shfl(iv, i + 32 * hi); rank += (vi > iv || (vi == iv && i < r32)) ? 1 : 0; }
                float tv[4]; int te[4];
#pragma unroll
                for (int r = 0; r < 4; ++r) { const unsigned long long bm = __ballot(rank == r); const unsigned hm = (unsigned)(bm >> (32 * hi)); const int src = __ffs(hm) - 1; te[r] = src; tv[r] = __shfl(iv, src + 32 * hi); }
                const float e0v = 1.f, e1v = expf(tv[1] - tv[0]), e2v = expf(tv[2] - tv[0]), e3v = expf(tv[3] - tv[0]); const float inv = 1.f / (e0v + e1v + e2v + e3v);
                if (r32 < 4) { const int e = r32 == 0 ? te[0] : r32 == 1 ? te[1] : r32 == 2 ? te[2] : te[3]; const float g = (r32 == 0 ? e0v : r32 == 1 ? e1v : r32 == 2 ? e2v : e3v) * inv;
                    const int a = (base + tk) * 4 + r32; const int pos = atomicAdd(&cnt[e], 1); list[(size_t)e * T_ + pos] = a; gate[a] = g; }
            }
            __syncthreads();
        }
    }
    SEAM(7);
    LAS int* mtab = (LAS int*)(smem + g8::STAGE_BYTES);
    if (IN(8)) {
        const int lane = LANE_NOW; (void)lane;
        if (tid == 0) { int ub = 0, rs = 0;
            for (int e = 0; e < NE; ++e) { const int c = (int)__hip_atomic_load((unsigned*)&cnt[e], __ATOMIC_RELAXED, __HIP_MEMORY_SCOPE_AGENT); mtab[e] = c; mtab[32 + e] = ub; mtab[65 + e] = rs; ub += ((c + 255) >> 8) * 16; rs += c; }
            mtab[64] = ub; mtab[97] = rs; mtab[98] = ub; }
        __syncthreads();
        g8::ProbGu P{h8q, q8gu, act16, p.in[I_BGU], list, sah, sgu, g8::MoeTab{mtab, 16}, nb, vcu};
        g8::gemm_phase(lds, P);
        __syncthreads();
    }
    SEAM(8);
    if (IN(9)) {
        const int lane = LANE_NOW;
        for (int row = gw; row < NA; row += nw) {
            float v[32]; float amax = 0.f;
#pragma unroll
            for (int c = 0; c < 4; ++c) { const h8 a = *(const h8*)(act16 + (size_t)row * 2048 + (lane + 64 * c) * 8);
#pragma unroll
                for (int q = 0; q < 8; ++q) { v[c * 8 + q] = (float)a[q]; amax = fmaxf(amax, fabsf(v[c * 8 + q])); } }
            amax = wave_max(amax);
            const float qinv = amax > 0.f ? 127.f / amax : 0.f;
            if (lane == 0) sact[row] = amax > 0.f ? amax / 127.f : 1.f;
#pragma unroll
            for (int c = 0; c < 4; ++c) { uint2 q; q.x = pack4_i8(v[c * 8 + 0] * qinv, v[c * 8 + 1] * qinv, v[c * 8 + 2] * qinv, v[c * 8 + 3] * qinv); q.y = pack4_i8(v[c * 8 + 4] * qinv, v[c * 8 + 5] * qinv, v[c * 8 + 6] * qinv, v[c * 8 + 7] * qinv);
                *(uint2*)(act8 + (size_t)row * 2048 + (lane + 64 * c) * 8) = q; }
        }
    }
    SEAM(9);
    if (IN(10)) {
        const int lane = LANE_NOW; (void)lane;
        if (tid == 0) { int ub = 0, rs = 0;
            for (int e = 0; e < NE; ++e) { const int c = (int)__hip_atomic_load((unsigned*)&cnt[e], __ATOMIC_RELAXED, __HIP_MEMORY_SCOPE_AGENT); mtab[e] = c; mtab[32 + e] = ub; mtab[65 + e] = rs; ub += ((c + 255) >> 8) * 8; rs += c; }
            mtab[64] = ub; mtab[97] = rs; mtab[98] = ub; }
        __syncthreads();
        g8::ProbDn P{act8, q8dn, y16, p.in[I_BDN], list, gate, sact, sdn, g8::MoeTab{mtab, 8}, nb, vcu};
        g8::gemm_phase(lds, P);
        __syncthreads();
    }
    SEAM(10);
    if (IN(11)) {
        const int lane = LANE_NOW; (void)lane;
        for (int row = gw; row < T_; row += nw) {
            float v[32]; float s = 0.f;
#pragma unroll
            for (int c = 0; c < 4; ++c) { const int col = (lane + 64 * c) * 8; const size_t yo = (size_t)row * 4 * 2048 + col;
                const h8 hh8 = *(const h8*)(h16 + (size_t)row * 2048 + col);
                const h8 y0 = *(const h8*)(y16 + yo), y1 = *(const h8*)(y16 + yo + 2048), y2 = *(const h8*)(y16 + yo + 4096), y3 = *(const h8*)(y16 + yo + 6144);
#pragma unroll
                for (int q = 0; q < 8; ++q) { v[c * 8 + q] = DN_ALPHA * (float)hh8[q] + (((float)y0[q] + (float)y1[q]) + ((float)y2[q] + (float)y3[q])); s += v[c * 8 + q]; } }
            const float mu = wave_sum(s) / 2048.f; float q2 = 0.f;
#pragma unroll
            for (int i = 0; i < 32; ++i) { const float d = v[i] - mu; q2 += d * d; }
            const float rs = rsqrtf(wave_sum(q2) / 2048.f + LN_EPS);
#pragma unroll
            for (int c = 0; c < 4; ++c) { const int col = (lane + 64 * c) * 8;
                const float4 ga = *(const float4*)(p.in[I_LN2G] + col), gb = *(const float4*)(p.in[I_LN2G] + col + 4), ba = *(const float4*)(p.in[I_LN2B] + col), bb = *(const float4*)(p.in[I_LN2B] + col + 4);
                float4 o0, o1;
                o0.x = (v[c * 8 + 0] - mu) * rs * ga.x + ba.x; o0.y = (v[c * 8 + 1] - mu) * rs * ga.y + ba.y; o0.z = (v[c * 8 + 2] - mu) * rs * ga.z + ba.z; o0.w = (v[c * 8 + 3] - mu) * rs * ga.w + ba.w;
                o1.x = (v[c * 8 + 4] - mu) * rs * gb.x + bb.x; o1.y = (v[c * 8 + 5] - mu) * rs * gb.y + bb.y; o1.z = (v[c * 8 + 6] - mu) * rs * gb.z + bb.z; o1.w = (v[c * 8 + 7] - mu) * rs * gb.w + bb.w;
                *(float4*)(p.out + (size_t)row * 2048 + col) = o0; *(float4*)(p.out + (size_t)row * 2048 + col + 4) = o1; }
        }
    }
}

constexpr int NPHASE = 12;

extern "C" void kernel_launch(void* const* d_in, const int* in_sizes, int n_in, void* d_out, int out_size, void* d_ws, size_t ws_size, hipStream_t stream) {
    static int grid = 0;
    if (grid == 0) {
        if (n_in != 26 || ws_size < WS_END) { fprintf(stderr, "kernel_launch: unexpected n_in %d or ws_size %zu (< %zu)\n", n_in, ws_size, (size_t)WS_END); grid = -1; return; }
        int dev = 0, cus = 0, per_cu = 0;
        hipGetDevice(&dev); hipDeviceGetAttribute(&cus, hipDeviceAttributeMultiprocessorCount, dev);
        if (hipFuncSetAttribute((const void*)fwd, hipFuncAttributeMaxDynamicSharedMemorySize, LDS_BYTES) != hipSuccess) { fprintf(stderr, "hipFuncSetAttribute failed\n"); grid = -1; return; }
        hipOccupancyMaxActiveBlocksPerMultiprocessor(&per_cu, (const void*)fwd, 512, LDS_BYTES);
        (void)hipGetLastError();
        if (per_cu < 1) fprintf(stderr, "occupancy query says %d blocks per CU\n", per_cu);
        grid = cus > 0 ? cus : 256;
    }
    if (grid < 0) return;
    hipMemsetAsync((char*)d_ws + WS_CTL, 0, CTL_BYTES, stream);
    Params p{};
    for (int i = 0; i < 26; ++i) p.in[i] = (const float*)d_in[i];
    p.out = (float*)d_out; p.ws = (unsigned char*)d_ws;
#if N_LAUNCH_MODE == 1
    p.lo_hi = (long long)0 | ((long long)NPHASE << 32);
    hipLaunchKernelGGL(fwd, dim3(grid), dim3(512), LDS_BYTES, stream, p);
#else
    for (int ph = 0; ph < NPHASE; ++ph) {
        p.lo_hi = (long long)ph | ((long long)(ph + 1) << 32);
        hipLaunchKernelGGL(fwd, dim3(grid), dim3(512), LDS_BYTES, stream, p);
    }
#endif
}
```

```cpp
#include <hip/hip_runtime.h>
#include <cstdio>
#include <cstdint>

#ifndef N_LAUNCH_MODE
#define N_LAUNCH_MODE 1
#endif

constexpr int B_ = 8, S_ = 2048, D_ = 2048, T_ = B_ * S_;
constexpr int INW = 3608;
constexpr int C_Q = 0, C_KC = 1024, C_VC = 1280, C_KS = 1536, C_VS = 1792, C_KW = 2048, C_VW = 2304, C_G = 2560, C_UP = 2584, C_QM = 3096;
constexpr int NC = 127;
constexpr int CROWS = B_ * NC * 2;
constexpr int NE = 32, DE = 2048, NA = T_ * 4;
constexpr float LN_EPS = 1e-5f;
constexpr float DN_ALPHA = 1.189207115002721f;
constexpr float ATT_SCALE = 0.08838834764831845f;

constexpr size_t al256(size_t x) { return (x + 255) & ~(size_t)255; }
constexpr size_t WS_CTL = 0;
constexpr size_t CTL_BYTES = 65536;
constexpr size_t CTL_CNT = 16384;
constexpr size_t WS_PROJ = CTL_BYTES;
constexpr size_t WS_KVMEM = WS_PROJ + al256((size_t)T_ * INW * 4);
constexpr size_t WS_BIAS1 = WS_KVMEM + al256((size_t)2048 * 1024 * 4);
constexpr size_t WS_HID = WS_BIAS1 + al256(2 * 256 * 4);
constexpr size_t WS_KC = WS_HID + al256((size_t)2 * 2048 * 256 * 4);
constexpr size_t WS_VC = WS_KC + al256((size_t)CROWS * 128 * 4);
constexpr size_t WS_POOLED = WS_VC + al256((size_t)CROWS * 128 * 4);
constexpr size_t WS_OPOOL = WS_POOLED + al256((size_t)T_ * 512 * 4);
constexpr size_t WS_OWIN = WS_OPOOL + al256((size_t)T_ * 512 * 4);
constexpr size_t WS_OCMP = WS_OWIN + al256((size_t)T_ * 1024 * 4);
constexpr size_t WS_OSLC = WS_OCMP + al256((size_t)T_ * 1024 * 4);
constexpr size_t WS_SEL = WS_OSLC + al256((size_t)T_ * 1024 * 4);
constexpr size_t WS_OMEM = WS_SEL + al256((size_t)T_ * 2 * 4);
constexpr size_t WS_CAT16 = WS_OMEM + al256((size_t)T_ * 512 * 4);
constexpr size_t WS_HPRE = WS_CAT16 + al256((size_t)T_ * 2048 * 2);
constexpr size_t WS_H = WS_HPRE + al256((size_t)T_ * 2048 * 4);
constexpr size_t WS_H16 = WS_H + al256((size_t)T_ * 2048 * 4);
constexpr size_t WS_GATE = WS_H16 + al256((size_t)T_ * 2048 * 2);
constexpr size_t WS_LIST = WS_GATE + al256((size_t)NA * 4);
constexpr size_t WS_ACT16 = WS_LIST + al256((size_t)NE * T_ * 4);
constexpr size_t WS_Y16 = WS_ACT16 + al256((size_t)(NA + 256) * 2048 * 2);
constexpr size_t WS_X16 = WS_Y16 + al256((size_t)NA * 2048 * 2);
constexpr size_t WS_MEM16 = WS_X16 + (size_t)T_ * 2048 * 2;
constexpr size_t WS_WTIN = WS_MEM16 + al256((size_t)2048 * 2048 * 2);
constexpr size_t WS_WTOUT = WS_WTIN + al256((size_t)3840 * 2048 * 2);
constexpr size_t WS_WTGU = WS_WTOUT + al256((size_t)2048 * 2048 * 2);
constexpr size_t WS_WTDN = WS_WTGU + al256((size_t)NE * 4096 * 2048 * 2);
constexpr size_t WS_PROJ16 = WS_WTDN + al256((size_t)NE * 2048 * 2048 * 2);
constexpr size_t WS_KVMEM16 = WS_PROJ16 + al256((size_t)(T_ + 64) * INW * 2);
constexpr size_t WS_WT1 = WS_KVMEM16 + al256((size_t)2048 * 1024 * 2);
constexpr size_t WS_UV = WS_WT1 + al256((size_t)2 * 512 * 2048 * 2);
constexpr size_t WS_KC16 = WS_UV + al256((size_t)2 * 4 * 2048 * 512 * 4);
constexpr size_t WS_VC16 = WS_KC16 + al256((size_t)B_ * 128 * 256 * 2);
constexpr size_t WS_WR16 = WS_VC16 + al256((size_t)B_ * 128 * 256 * 2);
constexpr size_t WS_Q8GU = WS_WR16 + al256((size_t)32 * 2048 * 2);
constexpr size_t WS_Q8DN = WS_Q8GU + al256((size_t)NE * 4096 * 2048);
constexpr size_t WS_SGU = WS_Q8DN + al256((size_t)NE * 2048 * 2048);
constexpr size_t WS_SDN = WS_SGU + al256((size_t)NE * 4096 * 4);
constexpr size_t WS_H8 = WS_SDN + al256((size_t)NE * 2048 * 4);
constexpr size_t WS_SAH = WS_H8 + al256((size_t)T_ * 2048);
constexpr size_t WS_ACT8 = WS_SAH + al256((size_t)T_ * 4);
constexpr size_t WS_SACT = WS_ACT8 + al256((size_t)(NA + 256) * 2048);
constexpr size_t WS_WTMKV = WS_SACT + al256((size_t)(NA + 256) * 4);
constexpr size_t WS_Q8OUT = WS_WTMKV + al256((size_t)1024 * 2048 * 2);
constexpr size_t WS_SOUT = WS_Q8OUT + al256((size_t)2048 * 2048);
constexpr size_t WS_CAT8 = WS_SOUT + al256(2048 * 4);
constexpr size_t WS_SCAT = WS_CAT8 + al256((size_t)T_ * 2048);
constexpr size_t WS_KV16 = WS_SCAT + al256((size_t)T_ * 4);
constexpr size_t KVSEG = (size_t)S_ * 128;
constexpr size_t WS_END = WS_KV16 + al256((size_t)6 * B_ * 2 * S_ * 128 * 2);

constexpr int LDS_BYTES = 155648;

struct Params {
    const float* in[26];
    float* out;
    unsigned char* ws;
    long long lo_hi;
};
enum { I_X = 0, I_MEM, I_WIN, I_POSK, I_W1K, I_W2K, I_POSV, I_W1V, I_W2V, I_POOLW, I_POOLS, I_WMEMKV, I_GNNSA, I_GNPOOL, I_GNMEM, I_WOUT,
       I_LN1G, I_LN1B, I_WR, I_BR, I_WGU, I_BGU, I_WDN, I_BDN, I_LN2G, I_LN2B };

#define XB_TMO      128
#define XB_XCNT(j)  (256  + 64 * (j))
#define XB_XSUB(j)  (1280 + 64 * (j))
#define XB_XGEN(j)  (2304 + 64 * (j))
#define XB_TOP      3328
#define XB_TOPGEN   3392
#define XCD_BAR_WORDS 3456
#define XB_SPIN_CAP (1u << 25)
#define LAS __attribute__((address_space(3)))

__device__ __forceinline__ unsigned xb_ld(unsigned* p)              { return __hip_atomic_load(p, __ATOMIC_RELAXED, __HIP_MEMORY_SCOPE_AGENT); }
__device__ __forceinline__ unsigned xb_add(unsigned* p, unsigned v) { return __hip_atomic_fetch_add(p, v, __ATOMIC_RELAXED, __HIP_MEMORY_SCOPE_AGENT); }
__device__ __forceinline__ unsigned xb_xcc_id() { return (unsigned)__builtin_amdgcn_s_getreg((3 << 11) | 20) & 0xFu; }
#define XB_SPIN(cond, bar) do { unsigned _sp = 0; while (cond) { __builtin_amdgcn_s_sleep(1); \
    if ((++_sp & 255u) == 0u) { if (xb_ld(&(bar)[XB_TMO])) break; if (_sp > XB_SPIN_CAP) { atomicAdd(&(bar)[XB_TMO], 1u); break; } } } } while (0)

struct XcdBarrier { unsigned* bar; unsigned x; volatile LAS unsigned* st; };

__device__ __forceinline__ XcdBarrier xcd_barrier_post(unsigned* bar, volatile LAS unsigned* st) {
    XcdBarrier b; b.bar = bar; b.x = xb_xcc_id(); b.st = st;
    if (threadIdx.x == 0) (void)xb_add(&bar[XB_XCNT(b.x)], 1u);
    return b;
}
__device__ __forceinline__ void xcd_barrier_complete(unsigned* bar, unsigned x, unsigned& nloc, unsigned& nx) {
    const unsigned G = gridDim.x * gridDim.y * gridDim.z;
    unsigned sum, cnt, mine, sp = 0u;
    for (;;) {
        sum = 0u; cnt = 0u; mine = 0u;
#pragma unroll
        for (unsigned j = 0; j < 16; ++j) { const unsigned c = xb_ld(&bar[XB_XCNT(j)]); sum += c; cnt += (c > 0u) ? 1u : 0u; mine = (j == x) ? c : mine; }
        if (sum == G) break;
        __builtin_amdgcn_s_sleep(1);
        if ((++sp & 255u) == 0u) { if (xb_ld(&bar[XB_TMO])) break; if (sp > XB_SPIN_CAP) { atomicAdd(&bar[XB_TMO], 1u); break; } }
    }
    nloc = mine > 0u ? mine : 1u; nx = cnt > 0u ? cnt : 1u;
}
__device__ __forceinline__ void xcd_barrier(const XcdBarrier& b) {
    asm volatile("s_waitcnt vmcnt(0)" ::: "memory");
    __syncthreads();
    if (threadIdx.x == 0) {
        unsigned* bar = b.bar;
        __builtin_amdgcn_s_waitcnt(0);
        unsigned nloc = b.st[0], nx = b.st[1];
        if (nloc == 0u) { xcd_barrier_complete(bar, b.x, nloc, nx); b.st[0] = nloc; b.st[1] = nx; }
        const unsigned old = xb_add(&bar[XB_XSUB(b.x)], 1u);
        const unsigned gen = old / nloc;
        if (old + 1u == (gen + 1u) * nloc) {
            __builtin_amdgcn_fence(__ATOMIC_RELEASE, "agent");
            asm volatile("s_waitcnt vmcnt(0)" ::: "memory");
            const unsigned og = xb_add(&bar[XB_TOP], 1u);
            const unsigned tg = og / nx;
            if (og + 1u == (tg + 1u) * nx) xb_add(&bar[XB_TOPGEN], 1u);
            else XB_SPIN(xb_ld(&bar[XB_TOPGEN]) == tg, bar);
            __builtin_amdgcn_fence(__ATOMIC_ACQUIRE, "agent");
            xb_add(&bar[XB_XGEN(b.x)], 1u);
            asm volatile("s_waitcnt vmcnt(0)" ::: "memory");
        } else {
            XB_SPIN(xb_ld(&bar[XB_XGEN(b.x)]) == gen, bar);
            __builtin_amdgcn_fence(__ATOMIC_ACQUIRE, "agent");
            asm volatile("s_waitcnt vmcnt(0)" ::: "memory");
        }
    }
    __syncthreads();
}

typedef _Float16 h8 __attribute__((ext_vector_type(8)));
typedef _Float16 h4 __attribute__((ext_vector_type(4)));
typedef float f4 __attribute__((ext_vector_type(4)));

__device__ __forceinline__ float wave_sum(float v) {
#pragma unroll
    for (int o = 32; o > 0; o >>= 1) v += __shfl_xor(v, o);
    return v;
}
__device__ __forceinline__ float wave_max(float v) {
#pragma unroll
    for (int o = 32; o > 0; o >>= 1) v = fmaxf(v, __shfl_xor(v, o));
    return v;
}
__device__ __forceinline__ void wave_sync() {
    asm volatile("s_waitcnt lgkmcnt(0)" ::: "memory");
    __builtin_amdgcn_wave_barrier();
}
__device__ __forceinline__ float gelu_tanh(float x) {
    const float u = 0.7978845608028654f * (x + 0.044715f * x * x * x);
    return 0.5f * x * (1.f + tanhf(u));
}
__device__ __forceinline__ float sigmoidf_(float x) { return 1.f / (1.f + expf(-x)); }
__device__ __forceinline__ float swiglu_fast(float g, float l) { const float xg = fminf(g, 7.f), xl = fminf(fmaxf(l, -7.f), 7.f); return xg * __builtin_amdgcn_rcpf(1.f + __builtin_amdgcn_exp2f(-2.4554669595930156f * xg)) * (xl + 1.f); }

constexpr int G_LD = 40;
template <class AF, class EF>
__device__ __forceinline__ void gemm_tile(char* smem, int K, const AF& af, const float* __restrict__ Bm, int ldb, int n0, int Nlim, bool perm, const EF& ef) {
    _Float16* As = (_Float16*)smem;
    _Float16* Bs = As + 128 * G_LD;
    const int tid = threadIdx.x, lane = tid & 63, wid = tid >> 6, wr = wid >> 2, wc = wid & 3, fr = lane & 15, fq = lane >> 4;
    f4 acc[4][2];
#pragma unroll
    for (int m = 0; m < 4; ++m)
#pragma unroll
        for (int n = 0; n < 2; ++n) acc[m][n] = (f4){0.f, 0.f, 0.f, 0.f};
    const int ar = tid >> 3, ak = (tid & 7) * 4;
    const float* ap0 = af.row(ar);
    const float* ap1 = af.row(ar + 64);
    const int bk = tid >> 5, bn = (tid & 31) * 4;
    const bool bok = (n0 + bn) < Nlim;
    int bnp[4];
#pragma unroll
    for (int i = 0; i < 4; ++i) { const int c = bn + i; bnp[i] = perm ? ((c & ~31) | ((c & 1) << 4) | ((c & 31) >> 1)) : c; }
    for (int k0 = 0; k0 < K; k0 += 32) {
        const int ko = af.koff(k0 + ak);
        float4 a0 = make_float4(0.f, 0.f, 0.f, 0.f), a1 = a0, b0 = a0, b1 = a0;
        if (ap0) a0 = *(const float4*)(ap0 + ko);
        if (ap1) a1 = *(const float4*)(ap1 + ko);
        if (bok) { b0 = *(const float4*)(Bm + (size_t)(k0 + bk) * ldb + n0 + bn); b1 = *(const float4*)(Bm + (size_t)(k0 + bk + 16) * ldb + n0 + bn); }
        __syncthreads();
        *(h4*)&As[ar * G_LD + ak] = (h4){(_Float16)a0.x, (_Float16)a0.y, (_Float16)a0.z, (_Float16)a0.w};
        *(h4*)&As[(ar + 64) * G_LD + ak] = (h4){(_Float16)a1.x, (_Float16)a1.y, (_Float16)a1.z, (_Float16)a1.w};
        Bs[bnp[0] * G_LD + bk] = (_Float16)b0.x; Bs[bnp[1] * G_LD + bk] = (_Float16)b0.y; Bs[bnp[2] * G_LD + bk] = (_Float16)b0.z; Bs[bnp[3] * G_LD + bk] = (_Float16)b0.w;
        Bs[bnp[0] * G_LD + bk + 16] = (_Float16)b1.x; Bs[bnp[1] * G_LD + bk + 16] = (_Float16)b1.y; Bs[bnp[2] * G_LD + bk + 16] = (_Float16)b1.z; Bs[bnp[3] * G_LD + bk + 16] = (_Float16)b1.w;
        __syncthreads();
        h8 a[4], b[2];
#pragma unroll
        for (int m = 0; m < 4; ++m) a[m] = *(const h8*)&As[(wr * 64 + m * 16 + fr) * G_LD + fq * 8];
#pragma unroll
        for (int n = 0; n < 2; ++n) b[n] = *(const h8*)&Bs[(wc * 32 + n * 16 + fr) * G_LD + fq * 8];
#pragma unroll
        for (int m = 0; m < 4; ++m)
#pragma unroll
            for (int n = 0; n < 2; ++n) acc[m][n] = __builtin_amdgcn_mfma_f32_16x16x32_f16(a[m], b[n], acc[m][n], 0, 0, 0);
    }
    ef(acc, wr, wc, fr, fq);
    __syncthreads();
}

struct ARowPlain { const float* base; int ld; int m0; int mlim;
    __device__ __forceinline__ const float* row(int r) const { return (m0 + r) < mlim ? base + (size_t)(m0 + r) * ld : nullptr; }
    __device__ __forceinline__ int koff(int k) const { return k; } };
struct ARowCmp { const float* proj; int col; int m0;
    __device__ __forceinline__ const float* row(int r) const { const int g = m0 + r; if (g >= CROWS) return nullptr; const int kvh = g & 1, bc = g >> 1, b = bc / NC, c = bc % NC;
        return proj + (size_t)(b * S_ + 16 * c) * INW + col + kvh * 128; }
    __device__ __forceinline__ int koff(int k) const { return (k >> 7) * INW + (k & 127); } };
struct ARowList { const float* base; const int* list; int m0; int cnt; int shift;
    __device__ __forceinline__ const float* row(int r) const { if (m0 + r >= cnt) return nullptr; const int a = list[m0 + r]; return base + (size_t)(a >> shift) * 2048; }
    __device__ __forceinline__ int koff(int k) const { return k; } };

struct EpiStore { float* C; int ldc; int m0; int n0; int mlim; int nlim; _Float16* C16;
    __device__ __forceinline__ void operator()(const f4 (&acc)[4][2], int wr, int wc, int fr, int fq) const {
#pragma unroll
        for (int m = 0; m < 4; ++m)
#pragma unroll
            for (int n = 0; n < 2; ++n)
#pragma unroll
                for (int j = 0; j < 4; ++j) { const int r = m0 + wr * 64 + m * 16 + fq * 4 + j, c = n0 + wc * 32 + n * 16 + fr;
                    if (r < mlim && c < nlim) { C[(size_t)r * ldc + c] = acc[m][n][j]; if (C16) C16[(size_t)r * ldc + c] = (_Float16)acc[m][n][j]; } } } };
struct EpiPool { _Float16* C; const float* scale; int m0; int g;
    __device__ __forceinline__ void operator()(const f4 (&acc)[4][2], int wr, int wc, int fr, int fq) const {
#pragma unroll
        for (int m = 0; m < 4; ++m)
#pragma unroll
            for (int n = 0; n < 2; ++n)
#pragma unroll
                for (int j = 0; j < 4; ++j) { const int r = m0 + wr * 64 + m * 16 + fq * 4 + j, c = g * 128 + wc * 32 + n * 16 + fr;
                    C[(size_t)r * 512 + c] = (_Float16)(acc[m][n][j] * scale[c]); } } };
struct EpiHid { float* C; const float* bias; int m0; int n0;
    __device__ __forceinline__ void operator()(const f4 (&acc)[4][2], int wr, int wc, int fr, int fq) const {
#pragma unroll
        for (int m = 0; m < 4; ++m)
#pragma unroll
            for (int n = 0; n < 2; ++n)
#pragma unroll
                for (int j = 0; j < 4; ++j) { const int r = m0 + wr * 64 + m * 16 + fq * 4 + j, c = n0 + wc * 32 + n * 16 + fr;
                    if (r < CROWS) C[(size_t)r * 256 + c] = gelu_tanh(acc[m][n][j] + bias[c]); } } };
struct EpiOut { float* C; const float* x; int m0; int n0;
    __device__ __forceinline__ void operator()(const f4 (&acc)[4][2], int wr, int wc, int fr, int fq) const {
#pragma unroll
        for (int m = 0; m < 4; ++m)
#pragma unroll
            for (int n = 0; n < 2; ++n)
#pragma unroll
                for (int j = 0; j < 4; ++j) { const size_t o = (size_t)(m0 + wr * 64 + m * 16 + fq * 4 + j) * 2048 + n0 + wc * 32 + n * 16 + fr;
                    C[o] = DN_ALPHA * x[o] + acc[m][n][j]; } } };
struct EpiGu { float* act; const float* bgu; const int* list; int m0; int cnt; int n0;
    __device__ __forceinline__ void operator()(const f4 (&acc)[4][2], int wr, int wc, int fr, int fq) const {
        const int jc = (n0 + wc * 32) / 2 + fr;
        const float bg = bgu[2 * jc], bl = bgu[2 * jc + 1];
#pragma unroll
        for (int m = 0; m < 4; ++m)
#pragma unroll
            for (int j = 0; j < 4; ++j) { const int r = m0 + wr * 64 + m * 16 + fq * 4 + j;
                if (r < cnt) { const int a = list[r];
                    const float xg = fminf(acc[m][0][j] + bg, 7.f), xl = fminf(fmaxf(acc[m][1][j] + bl, -7.f), 7.f);
                    act[(size_t)a * 2048 + jc] = xg * sigmoidf_(1.702f * xg) * (xl + 1.f); } } } };
struct EpiDn { float* y; const float* bdn; const int* list; const float* gate; int m0; int cnt; int n0;
    __device__ __forceinline__ void operator()(const f4 (&acc)[4][2], int wr, int wc, int fr, int fq) const {
#pragma unroll
        for (int m = 0; m < 4; ++m)
#pragma unroll
            for (int j = 0; j < 4; ++j) { const int r = m0 + wr * 64 + m * 16 + fq * 4 + j;
                if (r < cnt) { const int a = list[r]; const float g = gate[a];
#pragma unroll
                    for (int n = 0; n < 2; ++n) { const int c = n0 + wc * 32 + n * 16 + fr; y[(size_t)a * 2048 + c] = (acc[m][n][j] + bdn[c]) * g; } } } } };

constexpr int WLDS_FLOATS = 4096 + 512 + 32;
template <bool SHARED>
__device__ __forceinline__ void wave_attn(float* sw, const float* __restrict__ qptr, const float* __restrict__ Kb, const float* __restrict__ Vb, int ld, int nseg, float scale, float* __restrict__ optr) {
    const int lane = threadIdx.x & 63;
    float* sq = sw + 4096; const int* segs = (const int*)(sw + 4096 + 512);
#pragma unroll
    for (int i = 0; i < 8; ++i) sq[lane + 64 * i] = qptr[lane + 64 * i];
    wave_sync();
    for (int sg = 0; sg < nseg; ++sg) {
        const int start = segs[sg], len = segs[16 + sg];
        float d0 = 0.f, d1 = 0.f, d2 = 0.f, d3 = 0.f;
        if (lane < len) {
            const float* kp = Kb + (size_t)(start + lane) * ld;
            for (int d4 = 0; d4 < 32; ++d4) {
                if (SHARED) {
                    const float4 kv = *(const float4*)(kp + d4 * 4);
                    const float4 q0 = *(const float4*)(sq + d4 * 4), q1 = *(const float4*)(sq + 128 + d4 * 4), q2 = *(const float4*)(sq + 256 + d4 * 4), q3 = *(const float4*)(sq + 384 + d4 * 4);
                    d0 += kv.x * q0.x + kv.y * q0.y + kv.z * q0.z + kv.w * q0.w;
                    d1 += kv.x * q1.x + kv.y * q1.y + kv.z * q1.z + kv.w * q1.w;
                    d2 += kv.x * q2.x + kv.y * q2.y + kv.z * q2.z + kv.w * q2.w;
                    d3 += kv.x * q3.x + kv.y * q3.y + kv.z * q3.z + kv.w * q3.w;
                } else {
                    const float4 k0 = *(const float4*)(kp + d4 * 4), k1 = *(const float4*)(kp + 128 + d4 * 4), k2 = *(const float4*)(kp + 256 + d4 * 4), k3 = *(const float4*)(kp + 384 + d4 * 4);
                    const float4 q0 = *(const float4*)(sq + d4 * 4), q1 = *(const float4*)(sq + 128 + d4 * 4), q2 = *(const float4*)(sq + 256 + d4 * 4), q3 = *(const float4*)(sq + 384 + d4 * 4);
                    d0 += k0.x * q0.x + k0.y * q0.y + k0.z * q0.z + k0.w * q0.w;
                    d1 += k1.x * q1.x + k1.y * q1.y + k1.z * q1.z + k1.w * q1.w;
                    d2 += k2.x * q2.x + k2.y * q2.y + k2.z * q2.z + k2.w * q2.w;
                    d3 += k3.x * q3.x + k3.y * q3.y + k3.z * q3.z + k3.w * q3.w;
                }
            }
        }
        const bool ok = lane < len;
        sw[sg * 64 + lane] = ok ? d0 * scale : -1e30f;
        sw[1024 + sg * 64 + lane] = ok ? d1 * scale : -1e30f;
        sw[2048 + sg * 64 + lane] = ok ? d2 * scale : -1e30f;
        sw[3072 + sg * 64 + lane] = ok ? d3 * scale : -1e30f;
    }
    wave_sync();
    const int n = nseg * 64;
#pragma unroll
    for (int g = 0; g < 4; ++g) {
        float mx = -1e30f;
        for (int i = lane; i < n; i += 64) mx = fmaxf(mx, sw[g * 1024 + i]);
        mx = wave_max(mx);
        float sm = 0.f;
        for (int i = lane; i < n; i += 64) { const float v = sw[g * 1024 + i]; sm += (v > -1e29f) ? expf(v - mx) : 0.f; }
        sm = wave_sum(sm);
        const float inv = sm > 0.f ? 1.f / sm : 0.f;
        for (int i = lane; i < n; i += 64) { const float v = sw[g * 1024 + i]; sw[g * 1024 + i] = (v > -1e29f) ? expf(v - mx) * inv : 0.f; }
    }
    wave_sync();
    float o[4][2];
#pragma unroll
    for (int g = 0; g < 4; ++g) { o[g][0] = 0.f; o[g][1] = 0.f; }
    for (int sg = 0; sg < nseg; ++sg) {
        const int start = segs[sg], len = segs[16 + sg];
        for (int l = 0; l < len; ++l) {
            const float* vp = Vb + (size_t)(start + l) * ld;
            if (SHARED) {
                const float v0 = vp[lane], v1 = vp[lane + 64];
#pragma unroll
                for (int g = 0; g < 4; ++g) { const float p = sw[g * 1024 + sg * 64 + l]; o[g][0] += p * v0; o[g][1] += p * v1; }
            } else {
#pragma unroll
                for (int g = 0; g < 4; ++g) { const float p = sw[g * 1024 + sg * 64 + l]; o[g][0] += p * vp[g * 128 + lane]; o[g][1] += p * vp[g * 128 + lane + 64]; }
            }
        }
    }
#pragma unroll
    for (int g = 0; g < 4; ++g) { optr[g * 128 + lane] = o[g][0]; optr[g * 128 + lane + 64] = o[g][1]; }
}

namespace g8 {
constexpr int BM = 256, BK = 64, HALF = 128, HTB = HALF * BK * 2, STAGE_BYTES = 8 * HTB;
constexpr int KK = 2048;
typedef float f32x4 __attribute__((ext_vector_type(4)));
__device__ __forceinline__ int lds_byte(int r, int c) { const int st = (r >> 4) * 2 + (c >> 5), rr = r & 15, cc = c & 31, ob = rr * 64 + cc * 2; return st * 1024 + (ob ^ (((ob >> 9) & 1) << 5)); }
__device__ __forceinline__ void stage_rc(int b, int& R, int& C) { const int st = b / 1024, sb = b % 1024, swz = sb ^ (((sb >> 9) & 1) << 5); R = (st >> 1) * 16 + swz / 64; C = (st & 1) * 32 + (swz % 64) / 2; }
__device__ __forceinline__ int perm32(int rho) { const int n = rho >> 4, i = rho & 15; return 8 * (i >> 2) + 4 * n + (i & 3); }

typedef int i32x4 __attribute__((ext_vector_type(4)));
template <bool I8> struct AccSel { typedef f32x4 T; };
template <> struct AccSel<true> { typedef i32x4 T; };
__device__ __forceinline__ f32x4 mma16(i32x4 a, i32x4 b, f32x4 c) { return __builtin_amdgcn_mfma_f32_16x16x32_f16(*reinterpret_cast<h8*>(&a), *reinterpret_cast<h8*>(&b), c, 0, 0, 0); }
__device__ __forceinline__ i32x4 mma16(i32x4 a, i32x4 b, i32x4 c) { return __builtin_amdgcn_mfma_i32_16x16x64_i8(a, b, c, 0, 0, 0); }
struct Unit { int m0, n0, e, cnt, rbase; };
constexpr int EP_OFF = STAGE_BYTES + 512, EP_LD = 528, EP_GRP = 16 * EP_LD;
__device__ __forceinline__ void ep_sync() { asm volatile("s_waitcnt lgkmcnt(0)" ::: "memory"); __builtin_amdgcn_s_barrier(); asm volatile("" ::: "memory"); }
__device__ __forceinline__ int ep_tid() { int tz = threadIdx.x; asm volatile("" : "+v"(tz)); return tz; }
__device__ __forceinline__ h8 cvt8(f32x4 a, f32x4 b) { h8 o; o[0] = (_Float16)a[0]; o[1] = (_Float16)a[1]; o[2] = (_Float16)a[2]; o[3] = (_Float16)a[3]; o[4] = (_Float16)b[0]; o[5] = (_Float16)b[1]; o[6] = (_Float16)b[2]; o[7] = (_Float16)b[3]; return o; }

__device__ __forceinline__ void tile_order(int L, int nM, int nN, int& pm, int& pn) {
    const int nwg = nM * nN; int wgid = L;
    { const int q = nwg / 8, r = nwg % 8, xcd = wgid % 8, off = wgid / 8; wgid = (xcd < r ? xcd * (q + 1) : r * (q + 1) + (xcd - r) * q) + off; }
    const int nig = 8 * nN, gid = wgid / nig, fm = gid * 8, gsz = (nM - fm) < 8 ? (nM - fm) : 8;
    pm = fm + ((wgid % nig) % gsz); pn = (wgid % nig) / gsz;
}

template <class Prob>
__device__ __forceinline__ void gemm_phase(LAS unsigned char* lds, const Prob& P) {
    const int tid = threadIdx.x, wid = __builtin_amdgcn_readfirstlane(tid >> 6), lane = tid & 63, wr = wid >> 2, wc = wid & 3, fr = lane & 15, fq = lane >> 4;
    constexpr int nt = Prob::NT; constexpr size_t KS2 = Prob::KS2; constexpr unsigned ROWB = Prob::ROWB; constexpr bool I8 = Prob::I8;
    int sR[2], sC2[2]; unsigned voffB[2];
#pragma unroll
    for (int i = 0; i < 2; ++i) { int R, C; stage_rc(tid * 16 + i * 8192, R, C); sR[i] = R; sC2[i] = C * 2; const int Rb = Prob::PERM ? ((R & ~31) + perm32(R & 31)) : R; voffB[i] = (unsigned)Rb * ROWB + (unsigned)C * 2u; }
    const size_t kstep = (size_t)(BK * 2);
    const size_t hstep = (size_t)HALF * ROWB;
    const unsigned ldsw = (unsigned)wid * 1024u;
    const int aoff = lds_byte(wr * 64 + fr, fq * 8), boff = lds_byte(wc * 32 + fr, fq * 8);
#define G8_SA(b, h) (((b) * 2 + (h)) * HTB)
#define G8_SB(b, h) ((4 + (b) * 2 + (h)) * HTB)
#define G8_STAGE(bufoff, gbase, voff) do { _Pragma("unroll") for (int _i = 0; _i < 2; ++_i) \
        __builtin_amdgcn_global_load_lds((const unsigned*)((const char*)(gbase) + (voff)[_i]), (LAS unsigned*)(lds + (bufoff) + ldsw + _i * 8192), 16, 0, 0); } while (0)
#define G8_LDA(dst, b, h) do { _Pragma("unroll") for (int m = 0; m < 4; ++m) _Pragma("unroll") for (int k = 0; k < 2; ++k) dst[m][k] = *(const LAS i32x4*)(lds + G8_SA(b, h) + aoff + m * 2048 + k * 1024); } while (0)
#define G8_LDB(dst, b, h) do { _Pragma("unroll") for (int n = 0; n < 2; ++n) _Pragma("unroll") for (int k = 0; k < 2; ++k) dst[n][k] = *(const LAS i32x4*)(lds + G8_SB(b, h) + boff + n * 2048 + k * 1024); } while (0)
#define G8_MMA(ai, bj, At, Bt) do { __builtin_amdgcn_s_setprio(1); _Pragma("unroll") for (int m = 0; m < 4; ++m) _Pragma("unroll") for (int n = 0; n < 2; ++n) _Pragma("unroll") for (int k = 0; k < 2; ++k) \
        acc[ai][bj][m][n] = mma16(Bt[n][k], At[m][k], acc[ai][bj][m][n]); __builtin_amdgcn_s_setprio(0); } while (0)
#define G8_WAIT_V(n) asm volatile("s_waitcnt vmcnt(" #n ")" ::: "memory")
#define G8_WAIT_L(n) asm volatile("s_waitcnt lgkmcnt(" #n ")" ::: "memory")
#define G8_BAR __builtin_amdgcn_s_barrier()
#define G8_SCHED __builtin_amdgcn_sched_barrier(0)
    Unit cur, nxt; int ui = 0;
    if (!P.next(0, cur)) return;
    typedef typename AccSel<I8>::T AccT;
    AccT acc[2][2][4][2];
#pragma unroll
    for (int a = 0; a < 2; ++a)
#pragma unroll
        for (int b = 0; b < 2; ++b)
#pragma unroll
            for (int m = 0; m < 4; ++m)
#pragma unroll
                for (int n = 0; n < 2; ++n) acc[a][b][m][n] = AccT{};
    i32x4 At[4][2], B0[2][2], B1[2][2];
    unsigned vc[2][2], vn[2][2];
    P.a_offs(cur, sR, sC2, vc);
    const char* const Ab = P.a_base();
    const char* cB = P.b_base(cur);
    G8_STAGE(G8_SB(0, 0), cB, voffB); G8_STAGE(G8_SA(0, 0), Ab, vc[0]); G8_STAGE(G8_SB(0, 1), cB + hstep, voffB); G8_STAGE(G8_SA(0, 1), Ab, vc[1]);
    if (wr == 1) G8_BAR;
    G8_WAIT_V(4); G8_BAR;
    G8_STAGE(G8_SB(1, 0), cB + kstep, voffB); G8_STAGE(G8_SA(1, 0), Ab + kstep, vc[0]); G8_STAGE(G8_SB(1, 1), cB + hstep + kstep, voffB);
    G8_WAIT_V(6); G8_BAR;
    for (;;) {
        const bool has_next = P.next(ui + 1, nxt);
        const char* nB = cB;
        if (has_next) { P.a_offs(nxt, sR, sC2, vn); nB = P.b_base(nxt); }
        else { vn[0][0] = vc[0][0]; vn[0][1] = vc[0][1]; vn[1][0] = vc[1][0]; vn[1][1] = vc[1][1]; }
        for (int t = 0; t < nt; t += 2) {
            const bool last = (t == nt - 2);
            const char* a1 = Ab + (size_t)(t >> 1) * KS2 + kstep;
            const char* a2 = last ? Ab : Ab + (size_t)((t + 2) >> 1) * KS2; const char* b2 = last ? nB : cB + (size_t)(t + 2) * kstep;
            const char* a3 = a2 + kstep; const char* b3 = b2 + kstep;
            unsigned o2[2][2];
            o2[0][0] = last ? vn[0][0] : vc[0][0]; o2[0][1] = last ? vn[0][1] : vc[0][1]; o2[1][0] = last ? vn[1][0] : vc[1][0]; o2[1][1] = last ? vn[1][1] : vc[1][1];
            G8_LDB(B0, 0, 0); G8_SCHED; G8_LDA(At, 0, 0); G8_STAGE(G8_SA(1, 1), a1, vc[1]);
            G8_WAIT_L(8); G8_BAR; G8_WAIT_L(0); G8_MMA(0, 0, At, B0); G8_BAR; G8_SCHED;
            G8_LDB(B1, 0, 1); G8_STAGE(G8_SB(0, 0), b2, voffB);
            G8_BAR; G8_WAIT_L(0); G8_MMA(0, 1, At, B1); G8_BAR;
            G8_LDA(At, 0, 1); G8_STAGE(G8_SA(0, 0), a2, o2[0]);
            G8_BAR; G8_WAIT_L(0); G8_MMA(1, 0, At, B0); G8_BAR; G8_SCHED;
            G8_STAGE(G8_SB(0, 1), b2 + hstep, voffB);
            G8_WAIT_V(6); G8_BAR; G8_MMA(1, 1, At, B1); G8_BAR;
            G8_LDB(B0, 1, 0); G8_SCHED; G8_LDA(At, 1, 0); G8_STAGE(G8_SA(0, 1), a2, o2[1]);
            G8_WAIT_L(8); G8_BAR; G8_WAIT_L(0); G8_MMA(0, 0, At, B0); G8_BAR; G8_SCHED;
            G8_LDB(B1, 1, 1); G8_STAGE(G8_SB(1, 0), b3, voffB);
            G8_BAR; G8_WAIT_L(0); G8_MMA(0, 1, At, B1); G8_BAR;
            G8_LDA(At, 1, 1); G8_STAGE(G8_SA(1, 0), a3, o2[0]);
            G8_BAR; G8_WAIT_L(0); G8_MMA(1, 0, At, B0); G8_BAR; G8_SCHED;
            G8_STAGE(G8_SB(1, 1), b3 + hstep, voffB);
            G8_WAIT_V(6); G8_BAR; G8_MMA(1, 1, At, B1); G8_BAR;
        }
        P.epi(acc, cur, wr, wc, fr, fq, lds);
        if (!has_next) break;
#pragma unroll
        for (int a = 0; a < 2; ++a)
#pragma unroll
            for (int b = 0; b < 2; ++b)
#pragma unroll
                for (int m = 0; m < 4; ++m)
#pragma unroll
                    for (int n = 0; n < 2; ++n) acc[a][b][m][n] = AccT{};
        cur = nxt; cB = nB; ++ui;
        vc[0][0] = vn[0][0]; vc[0][1] = vn[0][1]; vc[1][0] = vn[1][0]; vc[1][1] = vn[1][1];
    }
    G8_WAIT_V(0);
    if (wr == 0) G8_BAR;
    G8_BAR;
#undef G8_SA
#undef G8_SB
#undef G8_STAGE
#undef G8_LDA
#undef G8_LDB
#undef G8_MMA
#undef G8_WAIT_V
#undef G8_WAIT_L
#undef G8_BAR
#undef G8_SCHED
}

struct ProbIn {
    static constexpr unsigned ROWB = 4096; static constexpr bool I8 = false;
    static constexpr int NT = 32; static constexpr size_t KS2 = 256;
    static constexpr bool PERM = true;
    const _Float16* A; _Float16* C16; int G, c;
    __device__ __forceinline__ bool next(int i, Unit& u) const { const int L = i * G + c; if (L >= 64 * 15 + 32) return false;
        if (L < 64 * 15) { int pm, pn; tile_order(L, 64, 15, pm, pn); u.m0 = pm * 256; u.n0 = pn * 256; u.e = 0; }
        else { const int v = L - 64 * 15; u.m0 = T_ + (v & 7) * 256; u.n0 = (v >> 3) * 256; u.e = 1; }
        u.cnt = 256; u.rbase = 0; return true; }
    __device__ __forceinline__ void a_offs(const Unit& u, const int (&R)[2], const int (&C2)[2], unsigned (&v)[2][2]) const {
#pragma unroll
        for (int h = 0; h < 2; ++h)
#pragma unroll
            for (int i = 0; i < 2; ++i) v[h][i] = (unsigned)(u.m0 + h * 128 + R[i]) * (unsigned)(KK * 2) + (unsigned)C2[i]; }
    __device__ __forceinline__ const char* a_base() const { return (const char*)A; }
    __device__ __forceinline__ const char* b_base(const Unit& u) const { return (const char*)A + (u.e ? (long long)(WS_WTMKV - WS_X16) : (long long)(WS_WTIN - WS_X16)) + (size_t)u.n0 * KK * 2; }
    __device__ __forceinline__ void epi(const f32x4 (&acc)[2][2][4][2], const Unit& u, int wr, int wc, int fr, int fq, LAS unsigned char* lds) const {
        LAS unsigned char* ep = lds + EP_OFF + wr * EP_GRP;
        const int tg = ep_tid() & 255, rrow = tg >> 4, ch = tg & 15;
        const int kvseg = (u.e == 0 && u.n0 >= 1024 && u.n0 < 2560) ? ((u.n0 - 1024) >> 8) : -1;
        _Float16* const Cb = (_Float16*)((char*)C16 + (u.e ? (long long)(WS_KVMEM16 - WS_PROJ16) : 0ll)); const int ldc = u.e ? 1024 : INW, nlim = u.e ? 1024 : INW, mb = u.e ? u.m0 - T_ : u.m0;
#pragma unroll
        for (int ai = 0; ai < 2; ++ai)
#pragma unroll
            for (int m = 0; m < 4; ++m) {
#pragma unroll
                for (int bj = 0; bj < 2; ++bj) *(LAS h8*)(ep + fr * EP_LD + (bj * 128 + wc * 32 + fq * 8) * 2) = cvt8(acc[ai][bj][m][0], acc[ai][bj][m][1]);
                ep_sync();
                const h8 x0 = *(const LAS h8*)(ep + rrow * EP_LD + ch * 32), x1 = *(const LAS h8*)(ep + rrow * EP_LD + ch * 32 + 16);
                const int grow = mb + ai * 128 + wr * 64 + m * 16 + rrow, gcol = u.n0 + ch * 16;
                if (kvseg >= 0) {
                    _Float16* dst = (_Float16*)((char*)C16 + (long long)(WS_KV16 - WS_PROJ16)) + ((size_t)(kvseg * B_ + (grow >> 11)) * 2 + (ch >> 3)) * KVSEG + (size_t)(grow & (S_ - 1)) * 128 + (ch & 7) * 16;
                    *(h8*)dst = x0; *(h8*)(dst + 8) = x1;
                } else {
                    if (gcol < nlim) *(h8*)(Cb + (size_t)grow * ldc + gcol) = x0;
                    if (gcol + 8 < nlim) *(h8*)(Cb + (size_t)grow * ldc + gcol + 8) = x1; }
                ep_sync();
            } }
};
struct ProbOut {
    static constexpr unsigned ROWB = 2048; static constexpr bool I8 = true;
    static constexpr int NT = 16; static constexpr size_t KS2 = 256;
    static constexpr bool PERM = true;
    const signed char* A; const signed char* Bt; _Float16* C; const _Float16* X; const float* sa; const float* sw; int G, c;
    __device__ __forceinline__ bool next(int i, Unit& u) const { const int L = i * G + c; if (L >= 64 * 8) return false; int pm, pn; tile_order(L, 64, 8, pm, pn); u.m0 = pm * 256; u.n0 = pn * 256; u.e = 0; u.cnt = 256; u.rbase = 0; return true; }
    __device__ __forceinline__ void a_offs(const Unit& u, const int (&R)[2], const int (&C2)[2], unsigned (&v)[2][2]) const {
#pragma unroll
        for (int h = 0; h < 2; ++h)
#pragma unroll
            for (int i = 0; i < 2; ++i) v[h][i] = (unsigned)(u.m0 + h * 128 + R[i]) * 2048u + (unsigned)C2[i]; }
    __device__ __forceinline__ const char* a_base() const { return (const char*)A; }
    __device__ __forceinline__ const char* b_base(const Unit& u) const { return (const char*)(Bt + (size_t)u.n0 * 2048); }
    __device__ __forceinline__ void epi(const i32x4 (&acc)[2][2][4][2], const Unit& u, int wr, int wc, int fr, int fq, LAS unsigned char* lds) const {
        LAS unsigned char* ep = lds + EP_OFF + wr * EP_GRP;
        const int tg = ep_tid() & 255, rrow = tg >> 4, ch = tg & 15;
        f32x4 s0[2], s1[2]; float srv[8];
#pragma unroll
        for (int bj = 0; bj < 2; ++bj) { const int col = u.n0 + bj * 128 + wc * 32 + fq * 8; s0[bj] = *(const f32x4*)(sw + col); s1[bj] = *(const f32x4*)(sw + col + 4); }
#pragma unroll
        for (int q = 0; q < 8; ++q) srv[q] = sa[u.m0 + (q >> 2) * 128 + wr * 64 + (q & 3) * 16 + fr];
#pragma unroll
        for (int ai = 0; ai < 2; ++ai)
#pragma unroll
            for (int m = 0; m < 4; ++m) { const float sr = srv[ai * 4 + m];
#pragma unroll
                for (int bj = 0; bj < 2; ++bj) { const i32x4 i0 = acc[ai][bj][m][0], i1 = acc[ai][bj][m][1];
                    *(LAS h8*)(ep + fr * EP_LD + (bj * 128 + wc * 32 + fq * 8) * 2) = cvt8((f32x4){(float)i0[0], (float)i0[1], (float)i0[2], (float)i0[3]} * (s0[bj] * sr), (f32x4){(float)i1[0], (float)i1[1], (float)i1[2], (float)i1[3]} * (s1[bj] * sr)); }
                const size_t go = (size_t)(u.m0 + ai * 128 + wr * 64 + m * 16 + rrow) * 2048 + u.n0 + ch * 16;
                const h8 r0 = *(const h8*)(X + go), r1 = *(const h8*)(X + go + 8);
                ep_sync();
                const h8 x0 = *(const LAS h8*)(ep + rrow * EP_LD + ch * 32), x1 = *(const LAS h8*)(ep + rrow * EP_LD + ch * 32 + 16);
                h8 o0, o1;
#pragma unroll
                for (int q = 0; q < 8; ++q) { o0[q] = (_Float16)(DN_ALPHA * (float)r0[q] + (float)x0[q]); o1[q] = (_Float16)(DN_ALPHA * (float)r1[q] + (float)x1[q]); }
                *(h8*)(C + go) = o0; *(h8*)(C + go + 8) = o1;
                ep_sync();
            } }
};
struct ProbCmp {
    static constexpr unsigned ROWB = 4096; static constexpr bool I8 = false;
    static constexpr int NT = 8; static constexpr size_t KS2 = 256;
    static constexpr bool PERM = false;
    const _Float16* A; const _Float16* Bt; float* C; int G, c;
    __device__ __forceinline__ bool next(int i, Unit& u) const { const int L = i * G + c; if (L >= 128) return false;
        u.e = L >> 6; const int r = L & 63; u.rbase = r & 3; u.n0 = ((r >> 2) & 1) * 256; u.m0 = (r >> 3) * 256; u.cnt = 256; return true; }
    __device__ __forceinline__ void a_offs(const Unit& u, const int (&R)[2], const int (&C2)[2], unsigned (&v)[2][2]) const {
#pragma unroll
        for (int h = 0; h < 2; ++h)
#pragma unroll
            for (int i = 0; i < 2; ++i) { const int row = u.m0 + h * 128 + R[i], kvh = row & 1, bj = row >> 1, b = bj >> 7, j = bj & 127;
                v[h][i] = (unsigned)((((u.e * B_ + b) * 2 + kvh) * S_ + 16 * j + 4 * u.rbase) * 128) * 2u + (unsigned)C2[i]; } }
    __device__ __forceinline__ const char* a_base() const { return (const char*)A; }
    __device__ __forceinline__ const char* b_base(const Unit& u) const { return (const char*)(Bt + ((size_t)u.e * 512 + u.n0) * KK + u.rbase * 512); }
    __device__ __forceinline__ void epi(const f32x4 (&acc)[2][2][4][2], const Unit& u, int wr, int wc, int fr, int fq, LAS unsigned char*) const {
        float* base = C + ((size_t)(u.e * 4 + u.rbase) * 2048) * 512;
#pragma unroll
        for (int ai = 0; ai < 2; ++ai)
#pragma unroll
            for (int m = 0; m < 4; ++m) { const int row = u.m0 + ai * 128 + wr * 64 + m * 16 + fr;
#pragma unroll
                for (int bj = 0; bj < 2; ++bj)
#pragma unroll
                    for (int n = 0; n < 2; ++n) { const int col = u.n0 + bj * 128 + wc * 32 + n * 16 + fq * 4;
                        *(f32x4*)(base + (size_t)row * 512 + col) = acc[ai][bj][m][n]; } } }
};
struct MoeTab { const LAS int* t; int NT;
    __device__ __forceinline__ bool find(int L, Unit& u) const {
        const int total = __builtin_amdgcn_readfirstlane(t[98]); if (L >= total) return false;
        int e = 0;
        for (; e < NE - 1; ++e) { if (L < __builtin_amdgcn_readfirstlane(t[32 + e + 1])) break; }
        const int ub = __builtin_amdgcn_readfirstlane(t[32 + e]), cn = __builtin_amdgcn_readfirstlane(t[e]), rs = __builtin_amdgcn_readfirstlane(t[65 + e]);
        const int nm = (cn + 255) >> 8, v = L - ub, mt = v % nm, ntile = v / nm;
        u.e = e; u.m0 = mt * 256; u.n0 = ntile * 256; u.cnt = min(256, cn - mt * 256); u.rbase = rs; return true; } };
struct ProbGu {
    static constexpr int NT = 16; static constexpr size_t KS2 = 256; static constexpr unsigned ROWB = 2048; static constexpr bool I8 = true;
    static constexpr bool PERM = true;
    const signed char* A; const signed char* Bt; _Float16* act; const float* bgu; const int* list; const float* sa; const float* sw; MoeTab tab; int G, vcu;
    __device__ __forceinline__ bool next(int i, Unit& u) const { return tab.find(i * G + vcu, u); }
    __device__ __forceinline__ void a_offs(const Unit& u, const int (&R)[2], const int (&C2)[2], unsigned (&v)[2][2]) const {
#pragma unroll
        for (int h = 0; h < 2; ++h)
#pragma unroll
            for (int i = 0; i < 2; ++i) { int r = h * 128 + R[i]; r = r < u.cnt ? r : 0; const int a = list[(size_t)u.e * T_ + u.m0 + r]; v[h][i] = (unsigned)(a >> 2) * 2048u + (unsigned)C2[i]; } }
    __device__ __forceinline__ const char* a_base() const { return (const char*)A; }
    __device__ __forceinline__ const char* b_base(const Unit& u) const { return (const char*)(Bt + ((size_t)u.e * 4096 + u.n0) * 2048); }
    __device__ __forceinline__ void epi(const i32x4 (&acc)[2][2][4][2], const Unit& u, int wr, int wc, int fr, int fq, LAS unsigned char* lds) const {
        const float* bb = bgu + (size_t)u.e * 4096; const float* ss = sw + (size_t)u.e * 4096;
        LAS unsigned char* ep = lds + EP_OFF + wr * EP_GRP;
        const int tg = ep_tid() & 255, rrow = tg >> 4, ch = tg & 15;
        f32x4 b0[2], b1[2], s0[2], s1[2];
#pragma unroll
        for (int bj = 0; bj < 2; ++bj) { const int col = u.n0 + bj * 128 + wc * 32 + fq * 8;
            b0[bj] = *(const f32x4*)(bb + col); b1[bj] = *(const f32x4*)(bb + col + 4); s0[bj] = *(const f32x4*)(ss + col); s1[bj] = *(const f32x4*)(ss + col + 4); }
        float srv[8];
        { int av[8];
#pragma unroll
          for (int q = 0; q < 8; ++q) { const int rl = (q >> 2) * 128 + wr * 64 + (q & 3) * 16 + fr; av[q] = list[(size_t)u.e * T_ + u.m0 + (rl < u.cnt ? rl : 0)]; }
#pragma unroll
          for (int q = 0; q < 8; ++q) srv[q] = sa[av[q] >> 2]; }
        LAS unsigned char* ep2 = lds + EP_OFF + wr * (2 * 16 * 272);
#pragma unroll
        for (int ai = 0; ai < 2; ++ai)
#pragma unroll
            for (int mp = 0; mp < 2; ++mp) {
#pragma unroll
                for (int mm = 0; mm < 2; ++mm) { const int m = mp * 2 + mm; const float sr = srv[ai * 4 + m];
#pragma unroll
                    for (int bj = 0; bj < 2; ++bj) {
                        const i32x4 i0 = acc[ai][bj][m][0], i1 = acc[ai][bj][m][1];
                        const f32x4 v0 = (f32x4){(float)i0[0], (float)i0[1], (float)i0[2], (float)i0[3]} * (s0[bj] * sr) + b0[bj], v1 = (f32x4){(float)i1[0], (float)i1[1], (float)i1[2], (float)i1[3]} * (s1[bj] * sr) + b1[bj];
                        h4 o;
                        o[0] = (_Float16)swiglu_fast(v0[0], v0[1]); o[1] = (_Float16)swiglu_fast(v0[2], v0[3]); o[2] = (_Float16)swiglu_fast(v1[0], v1[1]); o[3] = (_Float16)swiglu_fast(v1[2], v1[3]);
                        *(LAS h4*)(ep2 + (mm * 16 + fr) * 272 + (bj * 64 + wc * 16 + fq * 4) * 2) = o; } }
                ep_sync();
#pragma unroll
                for (int mm = 0; mm < 2; ++mm) { const h8 x0 = *(const LAS h8*)(ep2 + (mm * 16 + rrow) * 272 + ch * 16);
                    const int rr = ai * 128 + wr * 64 + (mp * 2 + mm) * 16 + rrow;
                    if (rr < u.cnt) *(h8*)(act + (size_t)(u.rbase + u.m0 + rr) * 2048 + (u.n0 >> 1) + ch * 8) = x0; }
                ep_sync();
            } }
};
struct ProbDn {
    static constexpr int NT = 16; static constexpr size_t KS2 = 256; static constexpr unsigned ROWB = 2048; static constexpr bool I8 = true;
    static constexpr bool PERM = true;
    const signed char* A; const signed char* Bt; _Float16* y; const float* bdn; const int* list; const float* gate; const float* sa; const float* sw; MoeTab tab; int G, vcu;
    __device__ __forceinline__ bool next(int i, Unit& u) const { return tab.find(i * G + vcu, u); }
    __device__ __forceinline__ void a_offs(const Unit& u, const int (&R)[2], const int (&C2)[2], unsigned (&v)[2][2]) const {
#pragma unroll
        for (int h = 0; h < 2; ++h)
#pragma unroll
            for (int i = 0; i < 2; ++i) v[h][i] = (unsigned)(u.rbase + u.m0 + h * 128 + R[i]) * 2048u + (unsigned)C2[i]; }
    __device__ __forceinline__ const char* a_base() const { return (const char*)A; }
    __device__ __forceinline__ const char* b_base(const Unit& u) const { return (const char*)(Bt + ((size_t)u.e * 2048 + u.n0) * 2048); }
    __device__ __forceinline__ void epi(const i32x4 (&acc)[2][2][4][2], const Unit& u, int wr, int wc, int fr, int fq, LAS unsigned char* lds) const {
        const float* bb = bdn + (size_t)u.e * 2048; const float* ss = sw + (size_t)u.e * 2048;
        LAS unsigned char* ep = lds + EP_OFF + wr * EP_GRP;
        const int tg = ep_tid() & 255, rrow = tg >> 4, ch = tg & 15;
        f32x4 b0[2], b1[2], s0[2], s1[2];
#pragma unroll
        for (int bj = 0; bj < 2; ++bj) { const int col = u.n0 + bj * 128 + wc * 32 + fq * 8;
            b0[bj] = *(const f32x4*)(bb + col); b1[bj] = *(const f32x4*)(bb + col + 4); s0[bj] = *(const f32x4*)(ss + col); s1[bj] = *(const f32x4*)(ss + col + 4); }
        float gv[8], srv[8]; int a2v[8];
        { int av[8];
#pragma unroll
          for (int q = 0; q < 8; ++q) { const int rl = (q >> 2) * 128 + wr * 64 + (q & 3) * 16 + fr, rc = rl < u.cnt ? rl : 0; av[q] = list[(size_t)u.e * T_ + u.m0 + rc]; srv[q] = sa[u.rbase + u.m0 + rc];
              const int rr = (q >> 2) * 128 + wr * 64 + (q & 3) * 16 + rrow; a2v[q] = list[(size_t)u.e * T_ + u.m0 + (rr < u.cnt ? rr : 0)]; }
#pragma unroll
          for (int q = 0; q < 8; ++q) gv[q] = gate[av[q]]; }
#pragma unroll
        for (int ai = 0; ai < 2; ++ai)
#pragma unroll
            for (int m = 0; m < 4; ++m) { const float g = gv[ai * 4 + m], sr = srv[ai * 4 + m];
#pragma unroll
                for (int bj = 0; bj < 2; ++bj) {
                    const i32x4 i0 = acc[ai][bj][m][0], i1 = acc[ai][bj][m][1];
                    const f32x4 v0 = ((f32x4){(float)i0[0], (float)i0[1], (float)i0[2], (float)i0[3]} * (s0[bj] * sr) + b0[bj]) * g, v1 = ((f32x4){(float)i1[0], (float)i1[1], (float)i1[2], (float)i1[3]} * (s1[bj] * sr) + b1[bj]) * g;
                    *(LAS h8*)(ep + fr * EP_LD + (bj * 128 + wc * 32 + fq * 8) * 2) = cvt8(v0, v1); }
                const int rr = ai * 128 + wr * 64 + m * 16 + rrow;
                const int a2 = a2v[ai * 4 + m];
                ep_sync();
                const h8 x0 = *(const LAS h8*)(ep + rrow * EP_LD + ch * 32), x1 = *(const LAS h8*)(ep + rrow * EP_LD + ch * 32 + 16);
                if (rr < u.cnt) { *(h8*)(y + (size_t)a2 * 2048 + u.n0 + ch * 16) = x0; *(h8*)(y + (size_t)a2 * 2048 + u.n0 + ch * 16 + 8) = x1; }
                ep_sync();
            } }
};
}

namespace at8 {
typedef float f32x16 __attribute__((ext_vector_type(16)));
typedef short s16x4 __attribute__((ext_vector_type(4)));
typedef unsigned u32x4 __attribute__((ext_vector_type(4)));
constexpr int SHM_V = 64 * 128 * 2, SHM_K = 64 * 128 * 2;
constexpr int LDS_WS = 2 * SHM_V + 2 * SHM_K;
constexpr int LDS_END = LDS_WS + 8 * 64 * 4;
constexpr float CEXP = ATT_SCALE * 1.4426950408889634f;
constexpr float THR_RAW = 8.f / ATT_SCALE;
#define AT_KSWZ(row, colB) ((row) * 256 + ((colB) ^ (((row) & 7) << 4)))
#define AT_SBAR() __builtin_amdgcn_sched_barrier(0)
__device__ __forceinline__ int crow(int r, int hi) { return (r & 3) + 8 * (r >> 2) + 4 * hi; }
__device__ __forceinline__ unsigned cvtpk(float lo, float hi) { auto v = __builtin_amdgcn_cvt_pkrtz(lo, hi); return *reinterpret_cast<unsigned*>(&v); }
__device__ __forceinline__ int v_st(int k, int c) { const int kk = (k & ~0xC) | ((k & 4) << 1) | ((k & 8) >> 1); return ((kk >> 3) * 4 + (c >> 5)) * 512 + ((kk & 7) * 32 + (c & 31)) * 2; }
__device__ __forceinline__ int v_rd_base(int lane) { return ((lane & 3) << 3) | (((lane >> 2) & 3) << 6) | (((lane >> 4) & 1) << 5) | (((lane >> 5) & 1) << 8); }
constexpr int v_rd_off(int d0, int ks, int half) { return d0 * 512 + ks * 4096 + half * 2048; }
template <int OFF> __device__ __forceinline__ s16x4 tr_read(int vb) { s16x4 r; asm volatile("ds_read_b64_tr_b16 %0, %1 offset:%2" : "=&v"(r) : "v"(vb), "i"(OFF) : "memory"); return r; }
__device__ __forceinline__ h8 mk8(s16x4 l, s16x4 h) { typedef short s16x8 __attribute__((ext_vector_type(8))); s16x8 w = {l[0], l[1], l[2], l[3], h[0], h[1], h[2], h[3]}; return *reinterpret_cast<h8*>(&w); }
template <int D0> __device__ __forceinline__ void pv_one(f32x16& od, int vb, h8 pa0, h8 pa1, h8 pa2, h8 pa3) {
    const s16x4 l0 = tr_read<v_rd_off(D0, 0, 0)>(vb), h0 = tr_read<v_rd_off(D0, 0, 1)>(vb), l1 = tr_read<v_rd_off(D0, 1, 0)>(vb), h1 = tr_read<v_rd_off(D0, 1, 1)>(vb);
    const s16x4 l2 = tr_read<v_rd_off(D0, 2, 0)>(vb), h2 = tr_read<v_rd_off(D0, 2, 1)>(vb), l3 = tr_read<v_rd_off(D0, 3, 0)>(vb), h3 = tr_read<v_rd_off(D0, 3, 1)>(vb);
    asm volatile("s_waitcnt lgkmcnt(0)" ::: "memory"); AT_SBAR();
    od = __builtin_amdgcn_mfma_f32_32x32x16_f16(pa0, mk8(l0, h0), od, 0, 0, 0);
    od = __builtin_amdgcn_mfma_f32_32x32x16_f16(pa1, mk8(l1, h1), od, 0, 0, 0);
    od = __builtin_amdgcn_mfma_f32_32x32x16_f16(pa2, mk8(l2, h2), od, 0, 0, 0);
    od = __builtin_amdgcn_mfma_f32_32x32x16_f16(pa3, mk8(l3, h3), od, 0, 0, 0);
}
__device__ __forceinline__ void pv_d0(f32x16 (&o)[4], int vb, h8 pa0, h8 pa1, h8 pa2, h8 pa3) {
    pv_one<0>(o[0], vb, pa0, pa1, pa2, pa3); pv_one<1>(o[1], vb, pa0, pa1, pa2, pa3); pv_one<2>(o[2], vb, pa0, pa1, pa2, pa3); pv_one<3>(o[3], vb, pa0, pa1, pa2, pa3);
}
__device__ __forceinline__ void qkt(f32x16& p0, f32x16& p1, const char* Ks, const h8 (&qr)[8], int r32, int hi) {
    p0 = f32x16{}; p1 = f32x16{};
#pragma unroll
    for (int d0 = 0; d0 < 8; ++d0) { const int cb = (d0 * 16 + hi * 8) * 2;
        const h8 b0 = *reinterpret_cast<const h8*>(Ks + AT_KSWZ(r32, cb));
        const h8 b1 = *reinterpret_cast<const h8*>(Ks + AT_KSWZ(32 + r32, cb));
        p0 = __builtin_amdgcn_mfma_f32_32x32x16_f16(b0, qr[d0], p0, 0, 0, 0);
        p1 = __builtin_amdgcn_mfma_f32_32x32x16_f16(b1, qr[d0], p1, 0, 0, 0); }
}
__device__ __forceinline__ void pack_p(const f32x16& p0, const f32x16& p1, h8& pa0, h8& pa1, h8& pa2, h8& pa3) {
#define AT_PK4(P, BASE, OUT) do { unsigned a0 = cvtpk(P[BASE + 0], P[BASE + 1]), a1 = cvtpk(P[BASE + 2], P[BASE + 3]); \
    unsigned b0 = cvtpk(P[BASE + 4], P[BASE + 5]), b1 = cvtpk(P[BASE + 6], P[BASE + 7]); \
    auto r0 = __builtin_amdgcn_permlane32_swap(a0, b0, false, false); auto r1 = __builtin_amdgcn_permlane32_swap(a1, b1, false, false); \
    u32x4 w = {r0[0], r1[0], r0[1], r1[1]}; OUT = *reinterpret_cast<h8*>(&w); } while (0)
    AT_PK4(p0, 0, pa0); AT_PK4(p0, 8, pa1); AT_PK4(p1, 0, pa2); AT_PK4(p1, 8, pa3);
#undef AT_PK4
}
__device__ __forceinline__ float half_swap_max(float v) { auto rr = __builtin_amdgcn_permlane32_swap(__float_as_uint(v), __float_as_uint(v), false, false); return fmaxf(__uint_as_float(rr[0]), __uint_as_float(rr[1])); }
__device__ __forceinline__ float half_swap_sum(float v) { auto rr = __builtin_amdgcn_permlane32_swap(__float_as_uint(v), __float_as_uint(v), false, false); return __uint_as_float(rr[0]) + __uint_as_float(rr[1]); }

struct Stage4 { h8 vs0, vs1, ks0, ks1; };
__device__ __forceinline__ int hidden_tid() { int tz = threadIdx.x; asm volatile("" : "+v"(tz)); return tz; }
__device__ __forceinline__ void sload(Stage4& s, const _Float16* Kb, const _Float16* Vb, int ld, int k0) {
    const int tz = hidden_tid(), sr = tz >> 4, sc = (tz & 15) * 8;
    s.vs0 = *(const h8*)(Vb + (size_t)(k0 + sr) * ld + sc); s.vs1 = *(const h8*)(Vb + (size_t)(k0 + 32 + sr) * ld + sc);
    s.ks0 = *(const h8*)(Kb + (size_t)(k0 + sr) * ld + sc); s.ks1 = *(const h8*)(Kb + (size_t)(k0 + 32 + sr) * ld + sc);
}
__device__ __forceinline__ void swrite(const Stage4& s, char* V_lds, char* K_lds, int b) {
    const int tz = hidden_tid(), sr = tz >> 4, sc = (tz & 15) * 8, vst0 = v_st(sr, sc), vst1 = v_st(32 + sr, sc);
    *(h8*)(V_lds + b * SHM_V + vst0) = s.vs0; *(h8*)(V_lds + b * SHM_V + vst1) = s.vs1;
    const int kc = sc * 2;
    *(h8*)(K_lds + b * SHM_K + AT_KSWZ(sr, kc)) = s.ks0; *(h8*)(K_lds + b * SHM_K + AT_KSWZ(32 + sr, kc)) = s.ks1;
}

__device__ __forceinline__ void attn_unit(char* lds, const _Float16* qrow, const _Float16* Kb, const _Float16* Vb, int ld, unsigned tmask, int wlen, int khi, unsigned selmask,
                                          _Float16* outw, int ostride) {
    const int tid = threadIdx.x, wid = __builtin_amdgcn_readfirstlane(tid >> 6), lane = tid & 63, r32 = lane & 31, hi = lane >> 5;
    char* V_lds = lds; char* K_lds = lds + 2 * SHM_V;
    float* wsf = (float*)(lds + LDS_WS) + wid * 64; float* li_l = wsf; float* al_l = wsf + 32;
    float m_reg = -1e30f, l_reg = 0.f; f32x16 o[4] = {}; h8 qr[8];
#pragma unroll
    for (int d0 = 0; d0 < 8; ++d0) qr[d0] = *(const h8*)(qrow + d0 * 16);
    const int vb0 = (int)(uintptr_t)V_lds + v_rd_base(lane);
    Stage4 st;
    unsigned rest = tmask; int j = __ffs(rest) - 1; rest &= rest - 1;
    sload(st, Kb, Vb, ld, j * 64); asm volatile("s_waitcnt vmcnt(0)" ::: "memory"); swrite(st, V_lds, K_lds, 0); __syncthreads();
    int buf = 0;
    for (;;) {
        const int jn = rest ? (__ffs(rest) - 1) : -1;
        if (jn >= 0) sload(st, Kb, Vb, ld, jn * 64);
        f32x16 p0, p1;
        AT_SBAR(); qkt(p0, p1, K_lds + buf * SHM_K, qr, r32, hi);
        { const int klo = wlen > 0 ? khi - wlen + 1 : 0; const bool tb = (selmask >> j) & 1u; const bool inr = (j * 64 >= klo) && (j * 64 + 63 <= khi);
          if (!__all(tb && inr)) {
              if (__all(inr)) {
#pragma unroll
                  for (int r = 0; r < 16; ++r) { p0[r] = tb ? p0[r] : -INFINITY; p1[r] = tb ? p1[r] : -INFINITY; }
              } else {
                  const int kb = j * 64 + 4 * hi;
#pragma unroll
                  for (int r = 0; r < 16; ++r) { const int k0 = kb + (r & 3) + 8 * (r >> 2);
                      p0[r] = (tb && k0 >= klo && k0 <= khi) ? p0[r] : -INFINITY;
                      p1[r] = (tb && (k0 + 32) >= klo && (k0 + 32) <= khi) ? p1[r] : -INFINITY; }
              } } }
        float pmax = p0[0];
#pragma unroll
        for (int r = 1; r < 16; ++r) pmax = fmaxf(pmax, p0[r]);
#pragma unroll
        for (int r = 0; r < 16; ++r) pmax = fmaxf(pmax, p1[r]);
        pmax = half_swap_max(pmax);
        float mn, alpha;
        if (__all(pmax - m_reg <= THR_RAW)) { mn = m_reg; alpha = 1.f; }
        else { mn = fmaxf(m_reg, pmax); alpha = __builtin_amdgcn_exp2f((m_reg - mn) * CEXP); m_reg = mn; }
        const float mnC = -mn * CEXP;
        float ps = 0.f;
#pragma unroll
        for (int r = 0; r < 16; ++r) { p0[r] = __builtin_amdgcn_exp2f(fmaf(p0[r], CEXP, mnC)); ps += p0[r]; }
#pragma unroll
        for (int r = 0; r < 16; ++r) { p1[r] = __builtin_amdgcn_exp2f(fmaf(p1[r], CEXP, mnC)); ps += p1[r]; }
        ps = half_swap_sum(ps);
        l_reg = l_reg * alpha + ps;
        if (__any(alpha < 1.f)) { if (hi == 0) al_l[r32] = alpha; asm volatile("s_waitcnt lgkmcnt(0)" ::: "memory");
#pragma unroll
            for (int r = 0; r < 16; ++r) { const float a = al_l[crow(r, hi)];
#pragma unroll
                for (int d = 0; d < 4; ++d) o[d][r] *= a; } }
        h8 pa0, pa1, pa2, pa3; pack_p(p0, p1, pa0, pa1, pa2, pa3);
        AT_SBAR();
        pv_d0(o, vb0 + buf * SHM_V, pa0, pa1, pa2, pa3);
        if (jn < 0) break;
        asm volatile("s_waitcnt vmcnt(0)" ::: "memory");
        swrite(st, V_lds, K_lds, buf ^ 1);
        __syncthreads();
        buf ^= 1; j = jn; rest &= rest - 1;
    }
    if (hi == 0) li_l[r32] = l_reg; asm volatile("s_waitcnt lgkmcnt(0)" ::: "memory");
#pragma unroll
    for (int r = 0; r < 16; ++r) { const int orow = crow(r, hi); const float l = li_l[orow]; const float rl = l > 0.f ? 1.f / l : 0.f;
#pragma unroll
        for (int d0 = 0; d0 < 4; ++d0) outw[(size_t)orow * ostride + d0 * 32 + r32] = (_Float16)(o[d0][r] * rl); }
    __syncthreads();
}

constexpr int LDS_AP = LDS_END, LDS_BP = LDS_AP + 4 * 64 * 33 * 4, LDS_SELM = LDS_BP + 4 * 64 * 33 * 4, LDS_CS_END = LDS_SELM + 64 * 4;
__device__ __forceinline__ void cmp_slc_unit(char* lds, const _Float16* qrow, const _Float16* Kc, const _Float16* Vc, const _Float16* Ks, const _Float16* Vs, int t, int tl, int g, int qi,
                                             _Float16* outc, _Float16* outs) {
    const int tid = threadIdx.x, wid = __builtin_amdgcn_readfirstlane(tid >> 6), lane = tid & 63, r32 = lane & 31, hi = lane >> 5;
    char* V_lds = lds; char* K_lds = lds + 2 * SHM_V;
    float* AP = (float*)(lds + LDS_AP); float* BP = (float*)(lds + LDS_BP); unsigned* selm = (unsigned*)(lds + LDS_SELM);
    {
        h8 qr[8];
#pragma unroll
        for (int d0 = 0; d0 < 8; ++d0) qr[d0] = *(const h8*)(qrow + d0 * 16);
        const int vb0 = (int)(uintptr_t)V_lds + v_rd_base(lane);
        { Stage4 s0, s1; sload(s0, Kc, Vc, 256, 0); sload(s1, Kc, Vc, 256, 64);
          asm volatile("s_waitcnt vmcnt(0)" ::: "memory");
          swrite(s0, V_lds, K_lds, 0); swrite(s1, V_lds, K_lds, 1); }
        __syncthreads();
        f32x16 pA0, pA1, pB0, pB1;
        AT_SBAR(); qkt(pA0, pA1, K_lds, qr, r32, hi); qkt(pB0, pB1, K_lds + SHM_K, qr, r32, hi);
        const int khi = t >= 31 ? ((t - 31) >> 4) : -1;
#pragma unroll
        for (int r = 0; r < 16; ++r) { const int c0 = 4 * hi + (r & 3) + 8 * (r >> 2);
            pA0[r] = (c0 <= khi) ? pA0[r] : -INFINITY; pA1[r] = (c0 + 32 <= khi) ? pA1[r] : -INFINITY;
            pB0[r] = (c0 + 64 <= khi) ? pB0[r] : -INFINITY; pB1[r] = (c0 + 96 <= khi) ? pB1[r] : -INFINITY; }
        float pmax = -INFINITY;
#pragma unroll
        for (int r = 0; r < 16; ++r) pmax = fmaxf(fmaxf(pmax, pA0[r]), fmaxf(pA1[r], fmaxf(pB0[r], pB1[r])));
        pmax = half_swap_max(pmax);
        const float mC = (pmax == -INFINITY) ? 0.f : -pmax * CEXP;
        float ps = 0.f;
#pragma unroll
        for (int r = 0; r < 16; ++r) { pA0[r] = __builtin_amdgcn_exp2f(fmaf(pA0[r], CEXP, mC)); pA1[r] = __builtin_amdgcn_exp2f(fmaf(pA1[r], CEXP, mC));
            pB0[r] = __builtin_amdgcn_exp2f(fmaf(pB0[r], CEXP, mC)); pB1[r] = __builtin_amdgcn_exp2f(fmaf(pB1[r], CEXP, mC)); ps += (pA0[r] + pA1[r]) + (pB0[r] + pB1[r]); }
        ps = half_swap_sum(ps);
        const float inv = ps > 0.f ? 1.f / ps : 0.f;
#pragma unroll
        for (int r = 0; r < 16; ++r) { pA0[r] *= inv; pA1[r] *= inv; pB0[r] *= inv; pB1[r] *= inv; }
        { float* ap = AP + (g * 64 + tl) * 33; float* bp = BP + (g * 64 + tl) * 33;
          if (hi == 0) bp[0] = 0.f;
#define AT_IMP(P, JB) do { _Pragma("unroll") for (int k = 0; k < 4; ++k) { const int j = (JB) + 2 * k + hi; \
              ap[j] = 2.f * (P[4 * k] + P[4 * k + 1] + P[4 * k + 2]) + P[4 * k + 3]; if (j + 1 < 32) bp[j + 1] = P[4 * k + 3]; } } while (0)
          AT_IMP(pA0, 0); AT_IMP(pA1, 8); AT_IMP(pB0, 16); AT_IMP(pB1, 24);
#undef AT_IMP
        }
        f32x16 o[4] = {};
        h8 pa0, pa1, pa2, pa3;
        pack_p(pA0, pA1, pa0, pa1, pa2, pa3); AT_SBAR(); pv_d0(o, vb0, pa0, pa1, pa2, pa3);
        pack_p(pB0, pB1, pa0, pa1, pa2, pa3); AT_SBAR(); pv_d0(o, vb0 + SHM_V, pa0, pa1, pa2, pa3);
#pragma unroll
        for (int r = 0; r < 16; ++r) { const int orow = crow(r, hi);
#pragma unroll
            for (int d0 = 0; d0 < 4; ++d0) outc[(size_t)orow * 1024 + d0 * 32 + r32] = (_Float16)o[d0][r]; }
    }
    __syncthreads();
#pragma unroll 1
    for (int it = 0; it < 4; ++it) {
        const int tk = 8 * wid + 2 * it + hi, j = r32;
        float imp = 0.f;
#pragma unroll
        for (int gg = 0; gg < 4; ++gg) imp += AP[(gg * 64 + tk) * 33 + j] + BP[(gg * 64 + tk) * 33 + j];
        const bool forced = (j == 0) || (j == qi) || (j == qi - 1), valid = j <= qi;
        const float iv = forced ? 1e9f : (valid ? imp : -1e9f);
        int rank = 0;
        for (int i = 0; i < 32; ++i) { const float vi = __shfl(iv, i + 32 * hi); rank += (vi > iv || (vi == iv && i < j)) ? 1 : 0; }
        const unsigned long long bal = __ballot(rank < 16 && valid);
        if (r32 == 0) selm[tk] = (unsigned)(bal >> (32 * hi));
    }
    __syncthreads();
    unsigned tm = selm[lane];
#pragma unroll
    for (int o = 32; o > 0; o >>= 1) tm |= __shfl_xor(tm, o);
    const int tz2 = hidden_tid();
    const unsigned mysel = selm[((tz2 >> 6) & 1) * 32 + (tz2 & 31)];
    attn_unit(lds, qrow, Ks, Vs, 128, tm, 0, t, mysel, outs, 1024);
}
}

__device__ __forceinline__ void conv_tile(float* lds, const float* __restrict__ W, int ldw, int nvalid, _Float16* __restrict__ Wt, int K, int k0, int n0) {
    const int tid = threadIdx.x;
    float4 v[8];
#pragma unroll
    for (int i = 0; i < 8; ++i) { const int idx = tid + 512 * i, r = idx >> 6, c4 = (idx & 63) * 4;
        v[i] = (n0 + c4 < nvalid) ? *(const float4*)(W + (size_t)(k0 + r) * ldw + n0 + c4) : make_float4(0.f, 0.f, 0.f, 0.f); }
#pragma unroll
    for (int i = 0; i < 8; ++i) { const int idx = tid + 512 * i, r = idx >> 6, c4 = (idx & 63) * 4; float* d = lds + r * 257 + c4; d[0] = v[i].x; d[1] = v[i].y; d[2] = v[i].z; d[3] = v[i].w; }
    __syncthreads();
#pragma unroll
    for (int j = 0; j < 4; ++j) { const int id = tid + 512 * j, n = id >> 3, k8 = (id & 7) * 8; h8 o;
#pragma unroll
        for (int q = 0; q < 8; ++q) o[q] = (_Float16)lds[(k8 + q) * 257 + n];
        *(h8*)(Wt + (size_t)(n0 + n) * K + k0 + k8) = o; }
    __syncthreads();
}


__device__ __forceinline__ unsigned pack4_i8(float a, float b, float c, float d) {
    const int ia = __float2int_rn(a), ib = __float2int_rn(b), ic = __float2int_rn(c), id = __float2int_rn(d);
    return (unsigned)(ia & 255) | ((unsigned)(ib & 255) << 8) | ((unsigned)(ic & 255) << 16) | ((unsigned)(id & 255) << 24);
}
constexpr int QP_LD2 = 1026;
struct QUnit { const float* W; int ldw; int n0; signed char* Q; float* sc; };
__device__ __forceinline__ QUnit quant_desc(int u, const float* wgu, const float* wdn, signed char* q8gu, signed char* q8dn, float* sgu, float* sdn, const float* wout, signed char* q8out, float* sout) {
    QUnit d;
    if (u >= NE * 192) { const int pn = u - NE * 192; d.W = wout; d.ldw = 2048; d.n0 = pn * 32; d.Q = q8out; d.sc = sout; }
    else if (u < NE * 128) { const int e = u >> 7, pn = u & 127; d.W = wgu + (size_t)e * 2048 * 4096; d.ldw = 4096; d.n0 = pn * 32; d.Q = q8gu + (size_t)e * 4096 * 2048; d.sc = sgu + (size_t)e * 4096; }
    else { const int v = u - NE * 128, e = v >> 6, pn = v & 63; d.W = wdn + (size_t)e * 2048 * 2048; d.ldw = 2048; d.n0 = pn * 32; d.Q = q8dn + (size_t)e * 2048 * 2048; d.sc = sdn + (size_t)e * 2048; }
    return d;
}
__device__ __forceinline__ unsigned pk2h(float a, float b) { auto v = __builtin_amdgcn_cvt_pkrtz(a, b); return *reinterpret_cast<unsigned*>(&v); }
__device__ __forceinline__ void quant_all(char* smem, const float* wgu, const float* wdn, signed char* q8gu, signed char* q8dn, float* sgu, float* sdn, const float* wout, signed char* q8out, float* sout, int bid, int nb) {
    constexpr int NU = NE * 128 + NE * 64 + 64;
    unsigned* cmaxb = (unsigned*)smem;
    const int tid = threadIdx.x, c4 = (tid & 7) * 4, rg = tid >> 3;
    if (tid < 64) cmaxb[tid] = 0u;
    __syncthreads();
    int u = bid; if (u >= NU) return;
    QUnit d = quant_desc(u, wgu, wdn, q8gu, q8dn, sgu, sdn, wout, q8out, sout);
    float4 va[16], vb[16], vc[16];
#define QL(dst, D, half) do { const float* p0 = (D).W + (size_t)((half) * 1024 + rg * 16) * (D).ldw + (D).n0 + c4; _Pragma("unroll") for (int j = 0; j < 16; ++j) dst[j] = *(const float4*)(p0 + (size_t)j * (D).ldw); } while (0)
#define QM(src) do { _Pragma("unroll") for (int j = 0; j < 16; ++j) { m0 = fmaxf(m0, fabsf(src[j].x)); m1 = fmaxf(m1, fabsf(src[j].y)); m2 = fmaxf(m2, fabsf(src[j].z)); m3 = fmaxf(m3, fabsf(src[j].w)); } } while (0)
#define QS(src, half, comp, ci, inv) do { uint4 o; \
        o.x = pack4_i8(src[0].comp * inv, src[1].comp * inv, src[2].comp * inv, src[3].comp * inv); o.y = pack4_i8(src[4].comp * inv, src[5].comp * inv, src[6].comp * inv, src[7].comp * inv); \
        o.z = pack4_i8(src[8].comp * inv, src[9].comp * inv, src[10].comp * inv, src[11].comp * inv); o.w = pack4_i8(src[12].comp * inv, src[13].comp * inv, src[14].comp * inv, src[15].comp * inv); \
        *(uint4*)(d.Q + (size_t)(d.n0 + c4 + (ci)) * 2048 + (half) * 1024 + rg * 16) = o; } while (0)
    QL(va, d, 0);
    int par = 0;
    for (;;) {
        unsigned* cmax = cmaxb + par * 32;
        float m0 = 0.f, m1 = 0.f, m2 = 0.f, m3 = 0.f;
        QL(vb, d, 1);
        QM(va); QM(vb);
        atomicMax(&cmax[c4 + 0], __float_as_uint(m0)); atomicMax(&cmax[c4 + 1], __float_as_uint(m1)); atomicMax(&cmax[c4 + 2], __float_as_uint(m2)); atomicMax(&cmax[c4 + 3], __float_as_uint(m3));
        __syncthreads();
        const int un = u + nb; const bool has = un < NU;
        QUnit dn = d; if (has) { dn = quant_desc(un, wgu, wdn, q8gu, q8dn, sgu, sdn, wout, q8out, sout); QL(vc, dn, 0); }
        if (tid < 32) cmaxb[(par ^ 1) * 32 + tid] = 0u;
        const float x0 = __uint_as_float(cmax[c4 + 0]), x1 = __uint_as_float(cmax[c4 + 1]), x2 = __uint_as_float(cmax[c4 + 2]), x3 = __uint_as_float(cmax[c4 + 3]);
        const float i0 = x0 > 0.f ? 127.f / x0 : 0.f, i1 = x1 > 0.f ? 127.f / x1 : 0.f, i2 = x2 > 0.f ? 127.f / x2 : 0.f, i3 = x3 > 0.f ? 127.f / x3 : 0.f;
        QS(va, 0, x, 0, i0); QS(va, 0, y, 1, i1); QS(va, 0, z, 2, i2); QS(va, 0, w, 3, i3);
        QS(vb, 1, x, 0, i0); QS(vb, 1, y, 1, i1); QS(vb, 1, z, 2, i2); QS(vb, 1, w, 3, i3);
        if (tid < 32) { const float mx = __uint_as_float(cmax[tid]); d.sc[d.n0 + tid] = mx > 0.f ? mx / 127.f : 1.f; }
        if (!has) break;
#pragma unroll
        for (int j = 0; j < 16; ++j) va[j] = vc[j];
        u = un; d = dn; par ^= 1;
        __syncthreads();
    }
    __syncthreads();
#undef QL
#undef QM
#undef QS
}

__global__ void __launch_bounds__(512, 2) fwd(Params p) {
    extern __shared__ __attribute__((aligned(16))) char smem[];
    const int tid = threadIdx.x, wv = __builtin_amdgcn_readfirstlane(tid >> 6);
#define LANE_NOW ({ int _t = threadIdx.x; asm volatile("" : "+v"(_t)); _t & 63; })
    const int bid = blockIdx.x, nb = gridDim.x;
    const int gw = bid * 8 + wv, nw = nb * 8;
    const int lo = (int)(p.lo_hi & 0xffffffffll), hi = (int)(p.lo_hi >> 32);
    unsigned char* ws = p.ws;
    unsigned* ctl = (unsigned*)(ws + WS_CTL);
    int* cnt = (int*)(ws + CTL_CNT);
    float* proj = (float*)(ws + WS_PROJ);
    float* kvmem = (float*)(ws + WS_KVMEM);
    float* bias1 = (float*)(ws + WS_BIAS1);
    float* hid = (float*)(ws + WS_HID);
    float* kc = (float*)(ws + WS_KC);
    float* vc = (float*)(ws + WS_VC);
    float* pooled = (float*)(ws + WS_POOLED);
    _Float16* opool = (_Float16*)(ws + WS_OPOOL);
    _Float16* owin = (_Float16*)(ws + WS_OWIN);
    _Float16* ocmp = (_Float16*)(ws + WS_OCMP);
    _Float16* oslc = (_Float16*)(ws + WS_OSLC);
    unsigned* sel = (unsigned*)(ws + WS_SEL);
    _Float16* omem = (_Float16*)(ws + WS_OMEM);
    _Float16* cat16 = (_Float16*)(ws + WS_CAT16);
    _Float16* hpre16 = (_Float16*)(ws + WS_HPRE);
    float* hbuf = (float*)(ws + WS_H);
    float* gate = (float*)(ws + WS_GATE);
    int* list = (int*)(ws + WS_LIST);
    _Float16* act16 = (_Float16*)(ws + WS_ACT16);
    _Float16* y16 = (_Float16*)(ws + WS_Y16);
    _Float16* h16 = (_Float16*)(ws + WS_H16);
    _Float16* x16 = (_Float16*)(ws + WS_X16);
    _Float16* wtin = (_Float16*)(ws + WS_WTIN);
    _Float16* wtout = (_Float16*)(ws + WS_WTOUT);
    _Float16* wtgu = (_Float16*)(ws + WS_WTGU);
    _Float16* wtdn = (_Float16*)(ws + WS_WTDN);
    LAS unsigned char* lds = (LAS unsigned char*)smem;
    _Float16* proj16 = (_Float16*)(ws + WS_PROJ16);
    _Float16* kvmem16 = (_Float16*)(ws + WS_KVMEM16);
    _Float16* wt1 = (_Float16*)(ws + WS_WT1);
    float* uv = (float*)(ws + WS_UV);
    _Float16* kc16 = (_Float16*)(ws + WS_KC16);
    _Float16* vc16 = (_Float16*)(ws + WS_VC16);
    _Float16* wr16 = (_Float16*)(ws + WS_WR16);
    _Float16* mem16 = (_Float16*)(ws + WS_MEM16);
    _Float16* wtmkv = (_Float16*)(ws + WS_WTMKV);
    _Float16* kv16 = (_Float16*)(ws + WS_KV16);
    signed char* q8out = (signed char*)(ws + WS_Q8OUT); float* sout = (float*)(ws + WS_SOUT); signed char* cat8 = (signed char*)(ws + WS_CAT8); float* scat = (float*)(ws + WS_SCAT);
    signed char* q8gu = (signed char*)(ws + WS_Q8GU); signed char* q8dn = (signed char*)(ws + WS_Q8DN);
    float* sgu = (float*)(ws + WS_SGU); float* sdn = (float*)(ws + WS_SDN);
    signed char* h8q = (signed char*)(ws + WS_H8); float* sah = (float*)(ws + WS_SAH);
    signed char* act8 = (signed char*)(ws + WS_ACT8); float* sact = (float*)(ws + WS_SACT);
    const int vcu = (nb % 8 == 0) ? (bid % 8) * (nb / 8) + bid / 8 : bid;

    volatile LAS unsigned* xbw = (volatile LAS unsigned*)(smem + LDS_BYTES - 16);
    if (tid == 0) { xbw[0] = 0u; xbw[1] = 0u; xbw[2] = 0u; xbw[3] = 0u; }
    __syncthreads();
    XcdBarrier bar; bar.bar = ctl; bar.x = 0; bar.st = xbw;
    const bool multi = (hi - lo) > 1;
    if (multi) bar = xcd_barrier_post(ctl, xbw);
#define IN(k) (lo <= (k) && (k) < hi)
#define SEAM(k) do { if (IN(k) && IN((k) + 1)) xcd_barrier(bar); } while (0)
    float* sw = (float*)smem + wv * WLDS_FLOATS;
    int* segw = (int*)(sw + 4096 + 512);

    if (IN(0)) {
        const int lane = LANE_NOW; (void)lane;
        for (int j = gw; j < 512; j += nw) {
            const int kv = j >> 8, jj = j & 255;
            const float* pos = p.in[kv ? I_POSV : I_POSK]; const float* w1 = p.in[kv ? I_W1V : I_W1K];
            float s = 0.f;
            for (int k = lane; k < 4096; k += 64) s += pos[k] * w1[(size_t)k * 256 + jj];
            s = wave_sum(s);
            if (lane == 0) bias1[j] = s;
        }
        for (int i = bid * 512 + tid; i < 32 * 2048; i += nb * 512) { const int e = i >> 11, d = i & 2047; wr16[i] = (_Float16)p.in[I_WR][(size_t)d * 32 + e]; }
        for (size_t i = (size_t)bid * 512 + tid; i < (size_t)T_ * 2048 / 4; i += (size_t)nb * 512) {
            const float4 v = ((const float4*)p.in[I_X])[i]; ((h4*)x16)[i] = (h4){(_Float16)v.x, (_Float16)v.y, (_Float16)v.z, (_Float16)v.w};
        }
        {
            constexpr int U_IN = 32 * 15, U_OUT = 0, U_W1 = 128;
            quant_all(smem, p.in[I_WGU], p.in[I_WDN], q8gu, q8dn, sgu, sdn, p.in[I_WOUT], q8out, sout, bid, nb);
            __syncthreads();
            for (int u = bid; u < U_IN + U_OUT + U_W1; u += nb) {
                if (u < U_IN) { const int v = u, kt = v / 15, ntl = v % 15;
                    conv_tile((float*)smem, p.in[I_WIN], INW, INW, wtin, 2048, kt * 64, ntl * 256);
                } else if (u < U_IN + U_OUT) {
                } else { const int v = u - U_IN - U_OUT, kv = v >> 6, part = (v >> 5) & 1, kt = v & 31;
                    conv_tile((float*)smem, p.in[kv ? I_W1V : I_W1K] + (size_t)part * 2048 * 256, 256, 256, wt1 + ((size_t)kv * 512 + part * 256) * 2048, 2048, kt * 64, 0);
                }
            }
        }
        for (size_t i = (size_t)bid * 512 + tid; i < (size_t)2048 * 2048 / 4; i += (size_t)nb * 512) {
            const float4 v = ((const float4*)p.in[I_MEM])[i]; ((h4*)mem16)[i] = (h4){(_Float16)v.x, (_Float16)v.y, (_Float16)v.z, (_Float16)v.w};
        }
        for (int u = bid; u < 128; u += nb) { const int kt = u >> 2, ntl = u & 3; conv_tile((float*)smem, p.in[I_WMEMKV], 1024, 1024, wtmkv, 2048, kt * 64, ntl * 256); }
    }
    SEAM(0);
    if (IN(1)) {
        const int lane = LANE_NOW; (void)lane;
        g8::ProbIn P{x16, proj16, nb, bid};
        g8::gemm_phase(lds, P);
    }
    SEAM(1);
    if (IN(2)) {
        const int lane = LANE_NOW; (void)lane;
        { g8::ProbCmp P{kv16, wt1, uv, nb, bid}; g8::gemm_phase(lds, P); __syncthreads(); }
        for (int i = bid * 512 + tid; i < T_ * 64; i += nb * 512) {
            const int chn = i & 63, row = i >> 6, t = row & (S_ - 1), g = chn >> 4;
            const int win = 2 << g, n = min(win, t + 1);
            const _Float16* src = proj16 + (size_t)row * INW + C_UP + chn * 8;
            float a[8];
            const h8 cur = *(const h8*)src;
#pragma unroll
            for (int q = 0; q < 8; ++q) a[q] = (float)cur[q];
            for (int k = 1; k < n; ++k) { const h8 v = *(const h8*)(src - (size_t)k * INW);
#pragma unroll
                for (int q = 0; q < 8; ++q) a[q] += (float)v[q]; }
            const float rn = 1.f / (float)n;
            float4 o0, o1;
            o0.x = a[0] * rn - (float)cur[0]; o0.y = a[1] * rn - (float)cur[1]; o0.z = a[2] * rn - (float)cur[2]; o0.w = a[3] * rn - (float)cur[3];
            o1.x = a[4] * rn - (float)cur[4]; o1.y = a[5] * rn - (float)cur[5]; o1.z = a[6] * rn - (float)cur[6]; o1.w = a[7] * rn - (float)cur[7];
            *(float4*)(pooled + (size_t)row * 512 + chn * 8) = o0; *(float4*)(pooled + (size_t)row * 512 + chn * 8 + 4) = o1;
        }
        {
            const int r32 = lane & 31, hi = lane >> 5, g = wv >> 1, half = wv & 1;
            for (int uu = vcu; uu < 512; uu += nb) {
                const int v = uu & 255, bk = v >> 4, qi = (uu >> 8) ? 31 - (v & 15) : (v & 15), b = bk >> 1, kvh = bk & 1;
                const int t = qi * 64 + half * 32 + r32;
                const int lo_t = max(0, qi - 8);
                const unsigned tmask = (unsigned)(((1ull << (qi + 1)) - 1ull) & ~((1ull << lo_t) - 1ull));
                at8::attn_unit(smem, proj16 + (size_t)(b * S_ + t) * INW + C_Q + (kvh * 4 + g) * 128 + hi * 8,
                               kv16 + ((size_t)(4 * B_ + b) * 2 + kvh) * KVSEG, kv16 + ((size_t)(5 * B_ + b) * 2 + kvh) * KVSEG, 128, tmask, 512, t, 0xffffffffu,
                               owin + (size_t)(b * S_ + qi * 64 + half * 32) * 1024 + (kvh * 4 + g) * 128, 1024);
            }
            for (int u = vcu; u < 256; u += nb) {
                const int b = u >> 5, h = (u >> 3) & 3, qt = u & 7;
                const int t = qt * 256 + wv * 32 + r32;
                at8::attn_unit(smem, proj16 + (size_t)(b * S_ + t) * INW + C_QM + h * 128 + hi * 8,
                               kvmem16 + (size_t)b * 256 * 1024 + h * 128, kvmem16 + (size_t)b * 256 * 1024 + 512 + h * 128, 1024, 0xFu, 0, 255, 0xffffffffu,
                               omem + (size_t)(b * S_ + qt * 256 + wv * 32) * 512 + h * 128, 512);
            }
        }
    }
    SEAM(2);
    if (IN(3)) {
        const int lane = LANE_NOW; (void)lane;
        {   float* hs = (float*)smem;
            for (int u = bid; u < 508; u += nb) {
                const int kv = u / 254, ub = u % 254;
                const float* w2 = p.in[kv ? I_W2V : I_W2K]; _Float16* dst = kv ? vc16 : kc16;
                __syncthreads();
#pragma unroll
                for (int q = 0; q < 4; ++q) { const int e = tid + 512 * q, i = e >> 8, n = e & 255;
                    const int idx = ub * 8 + i, b = idx / 254, rem = idx % 254, c = rem >> 1, kvh = rem & 1;
                    const int row = (b * 128 + c) * 2 + kvh;
                    float a = bias1[kv * 256 + n];
#pragma unroll
                    for (int sp = 0; sp < 4; ++sp) { const float* base = uv + ((size_t)(kv * 4 + sp) * 2048) * 512; a += base[(size_t)row * 512 + n] + base[(size_t)(row + 2) * 512 + 256 + n]; }
                    hs[i * 256 + n] = gelu_tanh(a); }
                __syncthreads();
#pragma unroll
                for (int q = 0; q < 2; ++q) { const int e = tid + 512 * q, i = e >> 7, d = e & 127;
                    const int idx = ub * 8 + i, b = idx / 254, rem = idx % 254, c = rem >> 1, kvh = rem & 1;
                    float a = 0.f;
                    for (int n = 0; n < 256; ++n) a += hs[i * 256 + n] * w2[n * 128 + d];
                    dst[(size_t)((b * 128 + c) * 2 + kvh) * 128 + d] = (_Float16)a; }
            }
            __syncthreads();
            for (int i = bid * 512 + tid; i < 2 * B_ * 256; i += nb * 512) { const int kv = i / (B_ * 256), r = i % (B_ * 256), b = r >> 8, x = r & 255;
                (kv ? vc16 : kc16)[(size_t)(b * 128 + 127) * 256 + x] = (_Float16)0.f; }
        }
        for (int u = bid; u < 128 * 4; u += nb) { const int g = u >> 7, mt = u & 127;
            ARowPlain af{pooled + g * 128, 512, mt * 128, T_}; EpiPool ef{opool, p.in[I_POOLS], mt * 128, g};
            gemm_tile(smem, 128, af, p.in[I_POOLW] + (size_t)g * 128 * 128, 128, 0, 128, false, ef);
        }
    }
    SEAM(3);
    if (IN(4)) {
        const int lane = LANE_NOW; (void)lane;
        const int r32 = lane & 31, hi = lane >> 5, g = wv >> 1, half = wv & 1;
        for (int uu = vcu; uu < 512; uu += nb) {
            const int v = uu & 255, bk = v >> 4, qi = (uu >> 8) ? 31 - (v & 15) : (v & 15), b = bk >> 1, kvh = bk & 1;
            const int tl = half * 32 + r32, t = qi * 64 + tl;
            at8::cmp_slc_unit(smem, proj16 + (size_t)(b * S_ + t) * INW + C_Q + (kvh * 4 + g) * 128 + hi * 8,
                              kc16 + (size_t)(b * 128 * 2 + kvh) * 128, vc16 + (size_t)(b * 128 * 2 + kvh) * 128,
                              kv16 + ((size_t)(2 * B_ + b) * 2 + kvh) * KVSEG, kv16 + ((size_t)(3 * B_ + b) * 2 + kvh) * KVSEG, t, tl, g, qi,
                              ocmp + (size_t)(b * S_ + qi * 64 + half * 32) * 1024 + (kvh * 4 + g) * 128, oslc + (size_t)(b * S_ + qi * 64 + half * 32) * 1024 + (kvh * 4 + g) * 128);
        }
    }
    SEAM(4);
    if (IN(5)) {
        const int lane = LANE_NOW;
        for (int row = gw; row < T_; row += nw) {
            const _Float16* pr = proj16 + (size_t)row * INW + C_G;
            float v[32]; float ss = 0.f;
#pragma unroll
            for (int c = 0; c < 2; ++c) { const int col = (lane + 64 * c) * 8, h = col >> 7; const size_t o = (size_t)row * 1024 + col;
                const float g0 = sigmoidf_((float)pr[h * 3]), g1 = sigmoidf_((float)pr[h * 3 + 1]), g2 = sigmoidf_((float)pr[h * 3 + 2]);
                const h8 a = *(const h8*)(ocmp + o), b2 = *(const h8*)(oslc + o), c2 = *(const h8*)(owin + o);
#pragma unroll
                for (int q = 0; q < 8; ++q) { const float x = g0 * (float)a[q] + g1 * (float)b2[q] + g2 * (float)c2[q]; v[c * 8 + q] = x; ss += x * x; } }
            ss = wave_sum(ss); float r = rsqrtf(ss / 1024.f + LN_EPS);
#pragma unroll
            for (int c = 0; c < 2; ++c) { const int col = (lane + 64 * c) * 8; const float4 ga = *(const float4*)(p.in[I_GNNSA] + col), gb = *(const float4*)(p.in[I_GNNSA] + col + 4);
                v[c * 8 + 0] *= r * ga.x; v[c * 8 + 1] *= r * ga.y; v[c * 8 + 2] *= r * ga.z; v[c * 8 + 3] *= r * ga.w; v[c * 8 + 4] *= r * gb.x; v[c * 8 + 5] *= r * gb.y; v[c * 8 + 6] *= r * gb.z; v[c * 8 + 7] *= r * gb.w; }
            { const h8 a = *(const h8*)(opool + (size_t)row * 512 + lane * 8); ss = 0.f;
#pragma unroll
              for (int q = 0; q < 8; ++q) { v[16 + q] = (float)a[q]; ss += v[16 + q] * v[16 + q]; }
              ss = wave_sum(ss); r = rsqrtf(ss / 512.f + LN_EPS);
              const float4 ga = *(const float4*)(p.in[I_GNPOOL] + lane * 8), gb = *(const float4*)(p.in[I_GNPOOL] + lane * 8 + 4);
              v[16] *= r * ga.x; v[17] *= r * ga.y; v[18] *= r * ga.z; v[19] *= r * ga.w; v[20] *= r * gb.x; v[21] *= r * gb.y; v[22] *= r * gb.z; v[23] *= r * gb.w; }
            { const h8 a = *(const h8*)(omem + (size_t)row * 512 + lane * 8); ss = 0.f;
#pragma unroll
              for (int q = 0; q < 8; ++q) { v[24 + q] = (float)a[q]; ss += v[24 + q] * v[24 + q]; }
              ss = wave_sum(ss); r = rsqrtf(ss / 512.f + LN_EPS);
              const float4 ga = *(const float4*)(p.in[I_GNMEM] + lane * 8), gb = *(const float4*)(p.in[I_GNMEM] + lane * 8 + 4);
              v[24] *= r * ga.x; v[25] *= r * ga.y; v[26] *= r * ga.z; v[27] *= r * ga.w; v[28] *= r * gb.x; v[29] *= r * gb.y; v[30] *= r * gb.z; v[31] *= r * gb.w; }
            float amax = 0.f;
#pragma unroll
            for (int k = 0; k < 32; ++k) amax = fmaxf(amax, fabsf(v[k]));
            amax = wave_max(amax);
            const float qinv = amax > 0.f ? 127.f / amax : 0.f;
            if (lane == 0) scat[row] = amax > 0.f ? amax / 127.f : 1.f;
#pragma unroll
            for (int c = 0; c < 4; ++c) { const int col = c < 2 ? (lane + 64 * c) * 8 : (c == 2 ? 1024 + lane * 8 : 1536 + lane * 8);
                uint2 q; q.x = pack4_i8(v[c * 8 + 0] * qinv, v[c * 8 + 1] * qinv, v[c * 8 + 2] * qinv, v[c * 8 + 3] * qinv); q.y = pack4_i8(v[c * 8 + 4] * qinv, v[c * 8 + 5] * qinv, v[c * 8 + 6] * qinv, v[c * 8 + 7] * qinv);
                *(uint2*)(cat8 + (size_t)row * 2048 + col) = q; }
        }
    }
    SEAM(5);
    if (IN(6)) {
        const int lane = LANE_NOW; (void)lane;
        g8::ProbOut P{cat8, q8out, hpre16, x16, scat, sout, nb, bid};
        g8::gemm_phase(lds, P);
    }
    SEAM(6);
    if (IN(7)) {
        const int lane = LANE_NOW; (void)lane;
        float* lg = (float*)smem;
        const int r32 = lane & 31, hi = lane >> 5, fr = lane & 15, fq = lane >> 4;
        for (int u = bid; u < T_ / 64; u += nb) {
            const int base = u * 64;
#pragma unroll 2
            for (int i = 0; i < 8; ++i) {
                const int row = base + wv * 8 + i;
                float v[32]; float s = 0.f;
#pragma unroll
                for (int c = 0; c < 4; ++c) { const int col = (lane + 64 * c) * 8;
                    const h8 a0 = *(const h8*)(hpre16 + (size_t)row * 2048 + col);
#pragma unroll
                    for (int q = 0; q < 8; ++q) { v[c * 8 + q] = (float)a0[q]; s += v[c * 8 + q]; } }
                const float mu = wave_sum(s) / 2048.f; float q2 = 0.f;
#pragma unroll
                for (int k = 0; k < 32; ++k) { const float d = v[k] - mu; q2 += d * d; }
                const float rs = rsqrtf(wave_sum(q2) / 2048.f + LN_EPS);
                float amax = 0.f;
#pragma unroll
                for (int c = 0; c < 4; ++c) { const int col = (lane + 64 * c) * 8;
                    const float4 g0 = *(const float4*)(p.in[I_LN1G] + col), g1 = *(const float4*)(p.in[I_LN1G] + col + 4), b0 = *(const float4*)(p.in[I_LN1B] + col), b1 = *(const float4*)(p.in[I_LN1B] + col + 4);
                    float4 o0, o1;
                    o0.x = (v[c * 8 + 0] - mu) * rs * g0.x + b0.x; o0.y = (v[c * 8 + 1] - mu) * rs * g0.y + b0.y; o0.z = (v[c * 8 + 2] - mu) * rs * g0.z + b0.z; o0.w = (v[c * 8 + 3] - mu) * rs * g0.w + b0.w;
                    o1.x = (v[c * 8 + 4] - mu) * rs * g1.x + b1.x; o1.y = (v[c * 8 + 5] - mu) * rs * g1.y + b1.y; o1.z = (v[c * 8 + 6] - mu) * rs * g1.z + b1.z; o1.w = (v[c * 8 + 7] - mu) * rs * g1.w + b1.w;
                    h8 oh; oh[0] = (_Float16)o0.x; oh[1] = (_Float16)o0.y; oh[2] = (_Float16)o0.z; oh[3] = (_Float16)o0.w; oh[4] = (_Float16)o1.x; oh[5] = (_Float16)o1.y; oh[6] = (_Float16)o1.z; oh[7] = (_Float16)o1.w;
                    *(h8*)(h16 + (size_t)row * 2048 + col) = oh;
                    v[c * 8 + 0] = o0.x; v[c * 8 + 1] = o0.y; v[c * 8 + 2] = o0.z; v[c * 8 + 3] = o0.w; v[c * 8 + 4] = o1.x; v[c * 8 + 5] = o1.y; v[c * 8 + 6] = o1.z; v[c * 8 + 7] = o1.w;
                    amax = fmaxf(amax, fmaxf(fmaxf(fmaxf(fabsf(o0.x), fabsf(o0.y)), fmaxf(fabsf(o0.z), fabsf(o0.w))), fmaxf(fmaxf(fabsf(o1.x), fabsf(o1.y)), fmaxf(fabsf(o1.z), fabsf(o1.w))))); }
                amax = wave_max(amax);
                const float qinv = amax > 0.f ? 127.f / amax : 0.f;
                if (lane == 0) sah[row] = amax > 0.f ? amax / 127.f : 1.f;
#pragma unroll
                for (int c = 0; c < 4; ++c) { const int col = (lane + 64 * c) * 8;
                    uint2 q; q.x = pack4_i8(v[c * 8 + 0] * qinv, v[c * 8 + 1] * qinv, v[c * 8 + 2] * qinv, v[c * 8 + 3] * qinv); q.y = pack4_i8(v[c * 8 + 4] * qinv, v[c * 8 + 5] * qinv, v[c * 8 + 6] * qinv, v[c * 8 + 7] * qinv);
                    *(uint2*)(h8q + (size_t)row * 2048 + col) = q; }
            }
            asm volatile("s_waitcnt vmcnt(0)" ::: "memory");
            __syncthreads();
            {
                const int tok0 = base + 16 * (wv >> 1), e0 = 16 * (wv & 1);
                const _Float16* ap = h16 + (size_t)(tok0 + fr) * 2048 + fq * 8; const _Float16* bp = wr16 + (size_t)(e0 + fr) * 2048 + fq * 8;
                f4 acc = (f4){0.f, 0.f, 0.f, 0.f};
#pragma unroll 8
                for (int sI = 0; sI < 64; ++sI) { const h8 a = *(const h8*)(ap + sI * 32), bb = *(const h8*)(bp + sI * 32); acc = __builtin_amdgcn_mfma_f32_16x16x32_f16(a, bb, acc, 0, 0, 0); }
                const float br = p.in[I_BR][e0 + fr];
#pragma unroll
                for (int j = 0; j < 4; ++j) lg[(16 * (wv >> 1) + 4 * fq + j) * 33 + e0 + fr] = acc[j] + br;
            }
            __syncthreads();
#pragma unroll 1
            for (int it = 0; it < 4; ++it) {
                const int tk = 8 * wv + 2 * it + hi;
                const float iv = lg[tk * 33 + r32];
                int rank = 0;
                for (int i = 0; i < 32; ++i) { const float vi = __shfl(iv, i + 32 * hi); rank += (vi > iv || (vi == iv && i < r32)) ? 1 : 0; }
                float tv[4]; int te[4];
#pragma unroll
                for (int r = 0; r < 4; ++r) { const unsigned long long bm = __ballot(rank == r); const unsigned hm = (unsigned)(bm >> (32 * hi)); const int src = __ffs(hm) - 1; te[r] = src; tv[r] = __shfl(iv, src + 32 * hi); }
                const float e0v = 1.f, e1v = expf(tv[1] - tv[0]), e2v = expf(tv[2] - tv[0]), e3v = expf(tv[3] - tv[0]); const float inv = 1.f / (e0v + e1v + e2v + e3v);
                if (r32 < 4) { const int e = r32 == 0 ? te[0] : r32 == 1 ? te[1] : r32 == 2 ? te[2] : te[3]; const float g = (r32 == 0 ? e0v : r32 == 1 ? e1v : r32 == 2 ? e2v : e3v) * inv;
                    const int a = (base + tk) * 4 + r32; const int pos = atomicAdd(&cnt[e], 1); list[(size_t)e * T_ + pos] = a; gate[a] = g; }
            }
            __syncthreads();
        }
    }
    SEAM(7);
    LAS int* mtab = (LAS int*)(smem + g8::STAGE_BYTES);
    if (IN(8)) {
        const int lane = LANE_NOW; (void)lane;
        if (tid == 0) { int ub = 0, rs = 0;
            for (int e = 0; e < NE; ++e) { const int c = (int)__hip_atomic_load((unsigned*)&cnt[e], __ATOMIC_RELAXED, __HIP_MEMORY_SCOPE_AGENT); mtab[e] = c; mtab[32 + e] = ub; mtab[65 + e] = rs; ub += ((c + 255) >> 8) * 16; rs += c; }
            mtab[64] = ub; mtab[97] = rs; mtab[98] = ub; }
        __syncthreads();
        g8::ProbGu P{h8q, q8gu, act16, p.in[I_BGU], list, sah, sgu, g8::MoeTab{mtab, 16}, nb, vcu};
        g8::gemm_phase(lds, P);
        __syncthreads();
    }
    SEAM(8);
    if (IN(9)) {
        const int lane = LANE_NOW;
        for (int row = gw; row < NA; row += nw) {
            float v[32]; float amax = 0.f;
#pragma unroll
            for (int c = 0; c < 4; ++c) { const h8 a = *(const h8*)(act16 + (size_t)row * 2048 + (lane + 64 * c) * 8);
#pragma unroll
                for (int q = 0; q < 8; ++q) { v[c * 8 + q] = (float)a[q]; amax = fmaxf(amax, fabsf(v[c * 8 + q])); } }
            amax = wave_max(amax);
            const float qinv = amax > 0.f ? 127.f / amax : 0.f;
            if (lane == 0) sact[row] = amax > 0.f ? amax / 127.f : 1.f;
#pragma unroll
            for (int c = 0; c < 4; ++c) { uint2 q; q.x = pack4_i8(v[c * 8 + 0] * qinv, v[c * 8 + 1] * qinv, v[c * 8 + 2] * qinv, v[c * 8 + 3] * qinv); q.y = pack4_i8(v[c * 8 + 4] * qinv, v[c * 8 + 5] * qinv, v[c * 8 + 6] * qinv, v[c * 8 + 7] * qinv);
                *(uint2*)(act8 + (size_t)row * 2048 + (lane + 64 * c) * 8) = q; }
        }
    }
    SEAM(9);
    if (IN(10)) {
        const int lane = LANE_NOW; (void)lane;
        if (tid == 0) { int ub = 0, rs = 0;
            for (int e = 0; e < NE; ++e) { const int c = (int)__hip_atomic_load((unsigned*)&cnt[e], __ATOMIC_RELAXED, __HIP_MEMORY_SCOPE_AGENT); mtab[e] = c; mtab[32 + e] = ub; mtab[65 + e] = rs; ub += ((c + 255) >> 8) * 8; rs += c; }
            mtab[64] = ub; mtab[97] = rs; mtab[98] = ub; }
        __syncthreads();
        g8::ProbDn P{act8, q8dn, y16, p.in[I_BDN], list, gate, sact, sdn, g8::MoeTab{mtab, 8}, nb, vcu};
        g8::gemm_phase(lds, P);
        __syncthreads();
    }
    SEAM(10);
    if (IN(11)) {
        const int lane = LANE_NOW; (void)lane;
        for (int row = gw; row < T_; row += nw) {
            float v[32]; float s = 0.f;
#pragma unroll
            for (int c = 0; c < 4; ++c) { const int col = (lane + 64 * c) * 8; const size_t yo = (size_t)row * 4 * 2048 + col;
                const h8 hh8 = *(const h8*)(h16 + (size_t)row * 2048 + col);
                const h8 y0 = *(const h8*)(y16 + yo), y1 = *(const h8*)(y16 + yo + 2048), y2 = *(const h8*)(y16 + yo + 4096), y3 = *(const h8*)(y16 + yo + 6144);
#pragma unroll
                for (int q = 0; q < 8; ++q) { v[c * 8 + q] = DN_ALPHA * (float)hh8[q] + (((float)y0[q] + (float)y1[q]) + ((float)y2[q] + (float)y3[q])); s += v[c * 8 + q]; } }
            const float mu = wave_sum(s) / 2048.f; float q2 = 0.f;
#pragma unroll
            for (int i = 0; i < 32; ++i) { const float d = v[i] - mu; q2 += d * d; }
            const float rs = rsqrtf(wave_sum(q2) / 2048.f + LN_EPS);
#pragma unroll
            for (int c = 0; c < 4; ++c) { const int col = (lane + 64 * c) * 8;
                const float4 ga = *(const float4*)(p.in[I_LN2G] + col), gb = *(const float4*)(p.in[I_LN2G] + col + 4), ba = *(const float4*)(p.in[I_LN2B] + col), bb = *(const float4*)(p.in[I_LN2B] + col + 4);
                float4 o0, o1;
                o0.x = (v[c * 8 + 0] - mu) * rs * ga.x + ba.x; o0.y = (v[c * 8 + 1] - mu) * rs * ga.y + ba.y; o0.z = (v[c * 8 + 2] - mu) * rs * ga.z + ba.z; o0.w = (v[c * 8 + 3] - mu) * rs * ga.w + ba.w;
                o1.x = (v[c * 8 + 4] - mu) * rs * gb.x + bb.x; o1.y = (v[c * 8 + 5] - mu) * rs * gb.y + bb.y; o1.z = (v[c * 8 + 6] - mu) * rs * gb.z + bb.z; o1.w = (v[c * 8 + 7] - mu) * rs * gb.w + bb.w;
                *(float4*)(p.out + (size_t)row * 2048 + col) = o0; *(float4*)(p.out + (size_t)row * 2048 + col + 4) = o1; }
        }
    }
}

constexpr int NPHASE = 12;

extern "C" void kernel_launch(void* const* d_in, const int* in_sizes, int n_in, void* d_out, int out_size, void* d_ws, size_t ws_size, hipStream_t stream) {
    static int grid = 0;
    if (grid == 0) {
        if (n_in != 26 || ws_size < WS_END) { fprintf(stderr, "kernel_launch: unexpected n_in %d or ws_size %zu (< %zu)\n", n_in, ws_size, (size_t)WS_END); grid = -1; return; }
        int dev = 0, cus = 0, per_cu = 0;
        hipGetDevice(&dev); hipDeviceGetAttribute(&cus, hipDeviceAttributeMultiprocessorCount, dev);
        if (hipFuncSetAttribute((const void*)fwd, hipFuncAttributeMaxDynamicSharedMemorySize, LDS_BYTES) != hipSuccess) { fprintf(stderr, "hipFuncSetAttribute failed\n"); grid = -1; return; }
        hipOccupancyMaxActiveBlocksPerMultiprocessor(&per_cu, (const void*)fwd, 512, LDS_BYTES);
        (void)hipGetLastError();
        if (per_cu < 1) fprintf(stderr, "occupancy query says %d blocks per CU\n", per_cu);
        grid = cus > 0 ? cus : 256;
    }
    if (grid < 0) return;
    hipMemsetAsync((char*)d_ws + WS_CTL, 0, CTL_BYTES, stream);
    Params p{};
    for (int i = 0; i < 26; ++i) p.in[i] = (const float*)d_in[i];
    p.out = (float*)d_out; p.ws = (unsigned char*)d_ws;
#if N_LAUNCH_MODE == 1
    p.lo_hi = (long long)0 | ((long long)NPHASE << 32);
    hipLaunchKernelGGL(fwd, dim3(grid), dim3(512), LDS_BYTES, stream, p);
#else
    for (int ph = 0; ph < NPHASE; ++ph) {
        p.lo_hi = (long long)ph | ((long long)(ph + 1) << 32);
        hipLaunchKernelGGL(fwd, dim3(grid), dim3(512), LDS_BYTES, stream, p);
    }
#endif
}
```

```cpp
#include <hip/hip_runtime.h>
#include <cstdio>
#include <cstdint>

#ifndef N_LAUNCH_MODE
#define N_LAUNCH_MODE 1
#endif

constexpr int B_ = 8, S_ = 2048, D_ = 2048, T_ = B_ * S_;
constexpr int INW = 3608;
constexpr int C_Q = 0, C_KC = 1024, C_VC = 1280, C_KS = 1536, C_VS = 1792, C_KW = 2048, C_VW = 2304, C_G = 2560, C_UP = 2584, C_QM = 3096;
constexpr int NC = 127;
constexpr int CROWS = B_ * NC * 2;
constexpr int NE = 32, DE = 2048, NA = T_ * 4;
constexpr float LN_EPS = 1e-5f;
constexpr float DN_ALPHA = 1.189207115002721f;
constexpr float ATT_SCALE = 0.08838834764831845f;

constexpr size_t al256(size_t x) { return (x + 255) & ~(size_t)255; }
constexpr size_t WS_CTL = 0;
constexpr size_t CTL_BYTES = 65536;
constexpr size_t CTL_CNT = 16384;
constexpr size_t WS_PROJ = CTL_BYTES;
constexpr size_t WS_KVMEM = WS_PROJ + al256((size_t)T_ * INW * 4);
constexpr size_t WS_BIAS1 = WS_KVMEM + al256((size_t)2048 * 1024 * 4);
constexpr size_t WS_HID = WS_BIAS1 + al256(2 * 16 * 256 * 4);
constexpr size_t WS_KC = WS_HID + al256((size_t)2 * 2048 * 256 * 4);
constexpr size_t WS_VC = WS_KC + al256((size_t)CROWS * 128 * 4);
constexpr size_t WS_POOLED = WS_VC + al256((size_t)CROWS * 128 * 4);
constexpr size_t WS_OPOOL = WS_POOLED + al256((size_t)T_ * 512 * 4);
constexpr size_t WS_OWIN = WS_OPOOL + al256((size_t)T_ * 512 * 4);
constexpr size_t WS_OCMP = WS_OWIN + al256((size_t)T_ * 1024 * 4);
constexpr size_t WS_OSLC = WS_OCMP + al256((size_t)T_ * 1024 * 4);
constexpr size_t WS_SEL = WS_OSLC + al256((size_t)T_ * 1024 * 4);
constexpr size_t WS_OMEM = WS_SEL + al256((size_t)T_ * 2 * 4);
constexpr size_t WS_CAT16 = WS_OMEM + al256((size_t)T_ * 512 * 4);
constexpr size_t WS_HPRE = WS_CAT16 + al256((size_t)T_ * 2048 * 2);
constexpr size_t WS_H = WS_HPRE + al256((size_t)T_ * 2048 * 4);
constexpr size_t WS_H16 = WS_H + al256((size_t)T_ * 2048 * 4);
constexpr size_t WS_GATE = WS_H16 + al256((size_t)T_ * 2048 * 2);
constexpr size_t WS_LIST = WS_GATE + al256((size_t)NA * 4);
constexpr size_t WS_ACT16 = WS_LIST + al256((size_t)NE * T_ * 4);
constexpr size_t WS_Y16 = WS_ACT16 + al256((size_t)(NA + 256) * 2048 * 2);
constexpr size_t WS_X16 = WS_Y16 + al256((size_t)NA * 2048 * 2);
constexpr size_t WS_MEM16 = WS_X16 + (size_t)T_ * 2048 * 2;
constexpr size_t WS_WTIN = WS_MEM16 + al256((size_t)2048 * 2048 * 2);
constexpr size_t WS_WTOUT = WS_WTIN + al256((size_t)3840 * 2048 * 2);
constexpr size_t WS_WTGU = WS_WTOUT + al256((size_t)2048 * 2048 * 2);
constexpr size_t WS_WTDN = WS_WTGU + al256((size_t)NE * 4096 * 2048 * 2);
constexpr size_t WS_PROJ16 = WS_WTDN + al256((size_t)NE * 2048 * 2048 * 2);
constexpr size_t WS_KVMEM16 = WS_PROJ16 + al256((size_t)(T_ + 64) * INW * 2);
constexpr size_t WS_WT1 = WS_KVMEM16 + al256((size_t)2048 * 1024 * 2);
constexpr size_t WS_UV = WS_WT1 + al256((size_t)2 * 512 * 2048 * 2);
constexpr size_t WS_KC16 = WS_UV + al256((size_t)2 * 4 * 2048 * 512 * 4);
constexpr size_t WS_VC16 = WS_KC16 + al256((size_t)B_ * 128 * 256 * 2);
constexpr size_t WS_WR16 = WS_VC16 + al256((size_t)B_ * 128 * 256 * 2);
constexpr size_t WS_Q8GU = WS_WR16 + al256((size_t)32 * 2048 * 2);
constexpr size_t WS_Q8DN = WS_Q8GU + al256((size_t)NE * 4096 * 2048);
constexpr size_t WS_SGU = WS_Q8DN + al256((size_t)NE * 2048 * 2048);
constexpr size_t WS_SDN = WS_SGU + al256((size_t)NE * 4096 * 4);
constexpr size_t WS_H8 = WS_SDN + al256((size_t)NE * 2048 * 4);
constexpr size_t WS_SAH = WS_H8 + al256((size_t)T_ * 2048);
constexpr size_t WS_ACT8 = WS_SAH + al256((size_t)T_ * 4);
constexpr size_t WS_SACT = WS_ACT8 + al256((size_t)(NA + 256) * 2048);
constexpr size_t WS_WTMKV = WS_SACT + al256((size_t)(NA + 256) * 4);
constexpr size_t WS_Q8OUT = WS_WTMKV + al256((size_t)1024 * 2048 * 2);
constexpr size_t WS_SOUT = WS_Q8OUT + al256((size_t)2048 * 2048);
constexpr size_t WS_CAT8 = WS_SOUT + al256(2048 * 4);
constexpr size_t WS_SCAT = WS_CAT8 + al256((size_t)T_ * 2048);
constexpr size_t WS_KV16 = WS_SCAT + al256((size_t)T_ * 4);
constexpr size_t KVSEG = (size_t)S_ * 128;
constexpr size_t WS_END = WS_KV16 + al256((size_t)6 * B_ * 2 * S_ * 128 * 2);

constexpr int LDS_BYTES = 155648;

struct Params {
    const float* in[26];
    float* out;
    unsigned char* ws;
    long long lo_hi;
};
enum { I_X = 0, I_MEM, I_WIN, I_POSK, I_W1K, I_W2K, I_POSV, I_W1V, I_W2V, I_POOLW, I_POOLS, I_WMEMKV, I_GNNSA, I_GNPOOL, I_GNMEM, I_WOUT,
       I_LN1G, I_LN1B, I_WR, I_BR, I_WGU, I_BGU, I_WDN, I_BDN, I_LN2G, I_LN2B };

#define XB_TMO      128
#define XB_XCNT(j)  (256  + 64 * (j))
#define XB_XSUB(j)  (1280 + 64 * (j))
#define XB_XGEN(j)  (2304 + 64 * (j))
#define XB_TOP      3328
#define XB_TOPGEN   3392
#define XCD_BAR_WORDS 3456
#define XB_SPIN_CAP (1u << 25)
#define LAS __attribute__((address_space(3)))

__device__ __forceinline__ unsigned xb_ld(unsigned* p)              { return __hip_atomic_load(p, __ATOMIC_RELAXED, __HIP_MEMORY_SCOPE_AGENT); }
__device__ __forceinline__ unsigned xb_add(unsigned* p, unsigned v) { return __hip_atomic_fetch_add(p, v, __ATOMIC_RELAXED, __HIP_MEMORY_SCOPE_AGENT); }
__device__ __forceinline__ unsigned xb_xcc_id() { return (unsigned)__builtin_amdgcn_s_getreg((3 << 11) | 20) & 0xFu; }
#define XB_SPIN(cond, bar) do { unsigned _sp = 0; while (cond) { __builtin_amdgcn_s_sleep(1); \
    if ((++_sp & 255u) == 0u) { if (xb_ld(&(bar)[XB_TMO])) break; if (_sp > XB_SPIN_CAP) { atomicAdd(&(bar)[XB_TMO], 1u); break; } } } } while (0)

struct XcdBarrier { unsigned* bar; unsigned x; volatile LAS unsigned* st; };

__device__ __forceinline__ XcdBarrier xcd_barrier_post(unsigned* bar, volatile LAS unsigned* st) {
    XcdBarrier b; b.bar = bar; b.x = xb_xcc_id(); b.st = st;
    if (threadIdx.x == 0) (void)xb_add(&bar[XB_XCNT(b.x)], 1u);
    return b;
}
__device__ __forceinline__ void xcd_barrier_complete(unsigned* bar, unsigned x, unsigned& nloc, unsigned& nx) {
    const unsigned G = gridDim.x * gridDim.y * gridDim.z;
    unsigned sum, cnt, mine, sp = 0u;
    for (;;) {
        sum = 0u; cnt = 0u; mine = 0u;
#pragma unroll
        for (unsigned j = 0; j < 16; ++j) { const unsigned c = xb_ld(&bar[XB_XCNT(j)]); sum += c; cnt += (c > 0u) ? 1u : 0u; mine = (j == x) ? c : mine; }
        if (sum == G) break;
        __builtin_amdgcn_s_sleep(1);
        if ((++sp & 255u) == 0u) { if (xb_ld(&bar[XB_TMO])) break; if (sp > XB_SPIN_CAP) { atomicAdd(&bar[XB_TMO], 1u); break; } }
    }
    nloc = mine > 0u ? mine : 1u; nx = cnt > 0u ? cnt : 1u;
}
__device__ __forceinline__ void xcd_barrier(const XcdBarrier& b) {
    asm volatile("s_waitcnt vmcnt(0)" ::: "memory");
    __syncthreads();
    if (threadIdx.x == 0) {
        unsigned* bar = b.bar;
        __builtin_amdgcn_s_waitcnt(0);
        unsigned nloc = b.st[0], nx = b.st[1];
        if (nloc == 0u) { xcd_barrier_complete(bar, b.x, nloc, nx); b.st[0] = nloc; b.st[1] = nx; }
        const unsigned old = xb_add(&bar[XB_XSUB(b.x)], 1u);
        const unsigned gen = old / nloc;
        if (old + 1u == (gen + 1u) * nloc) {
            __builtin_amdgcn_fence(__ATOMIC_RELEASE, "agent");
            asm volatile("s_waitcnt vmcnt(0)" ::: "memory");
            const unsigned og = xb_add(&bar[XB_TOP], 1u);
            const unsigned tg = og / nx;
            if (og + 1u == (tg + 1u) * nx) xb_add(&bar[XB_TOPGEN], 1u);
            else XB_SPIN(xb_ld(&bar[XB_TOPGEN]) == tg, bar);
            __builtin_amdgcn_fence(__ATOMIC_ACQUIRE, "agent");
            xb_add(&bar[XB_XGEN(b.x)], 1u);
            asm volatile("s_waitcnt vmcnt(0)" ::: "memory");
        } else {
            XB_SPIN(xb_ld(&bar[XB_XGEN(b.x)]) == gen, bar);
            __builtin_amdgcn_fence(__ATOMIC_ACQUIRE, "agent");
            asm volatile("s_waitcnt vmcnt(0)" ::: "memory");
        }
    }
    __syncthreads();
}

typedef _Float16 h8 __attribute__((ext_vector_type(8)));
typedef _Float16 h4 __attribute__((ext_vector_type(4)));
typedef float f4 __attribute__((ext_vector_type(4)));

__device__ __forceinline__ float wave_sum(float v) {
#pragma unroll
    for (int o = 32; o > 0; o >>= 1) v += __shfl_xor(v, o);
    return v;
}
__device__ __forceinline__ float wave_max(float v) {
#pragma unroll
    for (int o = 32; o > 0; o >>= 1) v = fmaxf(v, __shfl_xor(v, o));
    return v;
}
__device__ __forceinline__ void wave_sync() {
    asm volatile("s_waitcnt lgkmcnt(0)" ::: "memory");
    __builtin_amdgcn_wave_barrier();
}
__device__ __forceinline__ float gelu_tanh(float x) {
    const float u = 0.7978845608028654f * (x + 0.044715f * x * x * x);
    return 0.5f * x * (1.f + tanhf(u));
}
__device__ __forceinline__ float sigmoidf_(float x) { return 1.f / (1.f + expf(-x)); }
__device__ __forceinline__ float swiglu_fast(float g, float l) { const float xg = fminf(g, 7.f), xl = fminf(fmaxf(l, -7.f), 7.f); return xg * __builtin_amdgcn_rcpf(1.f + __builtin_amdgcn_exp2f(-2.4554669595930156f * xg)) * (xl + 1.f); }

constexpr int G_LD = 40;
template <class AF, class EF>
__device__ __forceinline__ void gemm_tile(char* smem, int K, const AF& af, const float* __restrict__ Bm, int ldb, int n0, int Nlim, bool perm, const EF& ef) {
    _Float16* As = (_Float16*)smem;
    _Float16* Bs = As + 128 * G_LD;
    const int tid = threadIdx.x, lane = tid & 63, wid = tid >> 6, wr = wid >> 2, wc = wid & 3, fr = lane & 15, fq = lane >> 4;
    f4 acc[4][2];
#pragma unroll
    for (int m = 0; m < 4; ++m)
#pragma unroll
        for (int n = 0; n < 2; ++n) acc[m][n] = (f4){0.f, 0.f, 0.f, 0.f};
    const int ar = tid >> 3, ak = (tid & 7) * 4;
    const float* ap0 = af.row(ar);
    const float* ap1 = af.row(ar + 64);
    const int bk = tid >> 5, bn = (tid & 31) * 4;
    const bool bok = (n0 + bn) < Nlim;
    int bnp[4];
#pragma unroll
    for (int i = 0; i < 4; ++i) { const int c = bn + i; bnp[i] = perm ? ((c & ~31) | ((c & 1) << 4) | ((c & 31) >> 1)) : c; }
    for (int k0 = 0; k0 < K; k0 += 32) {
        const int ko = af.koff(k0 + ak);
        float4 a0 = make_float4(0.f, 0.f, 0.f, 0.f), a1 = a0, b0 = a0, b1 = a0;
        if (ap0) a0 = *(const float4*)(ap0 + ko);
        if (ap1) a1 = *(const float4*)(ap1 + ko);
        if (bok) { b0 = *(const float4*)(Bm + (size_t)(k0 + bk) * ldb + n0 + bn); b1 = *(const float4*)(Bm + (size_t)(k0 + bk + 16) * ldb + n0 + bn); }
        __syncthreads();
        *(h4*)&As[ar * G_LD + ak] = (h4){(_Float16)a0.x, (_Float16)a0.y, (_Float16)a0.z, (_Float16)a0.w};
        *(h4*)&As[(ar + 64) * G_LD + ak] = (h4){(_Float16)a1.x, (_Float16)a1.y, (_Float16)a1.z, (_Float16)a1.w};
        Bs[bnp[0] * G_LD + bk] = (_Float16)b0.x; Bs[bnp[1] * G_LD + bk] = (_Float16)b0.y; Bs[bnp[2] * G_LD + bk] = (_Float16)b0.z; Bs[bnp[3] * G_LD + bk] = (_Float16)b0.w;
        Bs[bnp[0] * G_LD + bk + 16] = (_Float16)b1.x; Bs[bnp[1] * G_LD + bk + 16] = (_Float16)b1.y; Bs[bnp[2] * G_LD + bk + 16] = (_Float16)b1.z; Bs[bnp[3] * G_LD + bk + 16] = (_Float16)b1.w;
        __syncthreads();
        h8 a[4], b[2];
#pragma unroll
        for (int m = 0; m < 4; ++m) a[m] = *(const h8*)&As[(wr * 64 + m * 16 + fr) * G_LD + fq * 8];
#pragma unroll
        for (int n = 0; n < 2; ++n) b[n] = *(const h8*)&Bs[(wc * 32 + n * 16 + fr) * G_LD + fq * 8];
#pragma unroll
        for (int m = 0; m < 4; ++m)
#pragma unroll
            for (int n = 0; n < 2; ++n) acc[m][n] = __builtin_amdgcn_mfma_f32_16x16x32_f16(a[m], b[n], acc[m][n], 0, 0, 0);
    }
    ef(acc, wr, wc, fr, fq);
    __syncthreads();
}

struct ARowPlain { const float* base; int ld; int m0; int mlim;
    __device__ __forceinline__ const float* row(int r) const { return (m0 + r) < mlim ? base + (size_t)(m0 + r) * ld : nullptr; }
    __device__ __forceinline__ int koff(int k) const { return k; } };
struct ARowCmp { const float* proj; int col; int m0;
    __device__ __forceinline__ const float* row(int r) const { const int g = m0 + r; if (g >= CROWS) return nullptr; const int kvh = g & 1, bc = g >> 1, b = bc / NC, c = bc % NC;
        return proj + (size_t)(b * S_ + 16 * c) * INW + col + kvh * 128; }
    __device__ __forceinline__ int koff(int k) const { return (k >> 7) * INW + (k & 127); } };
struct ARowList { const float* base; const int* list; int m0; int cnt; int shift;
    __device__ __forceinline__ const float* row(int r) const { if (m0 + r >= cnt) return nullptr; const int a = list[m0 + r]; return base + (size_t)(a >> shift) * 2048; }
    __device__ __forceinline__ int koff(int k) const { return k; } };

struct EpiStore { float* C; int ldc; int m0; int n0; int mlim; int nlim; _Float16* C16;
    __device__ __forceinline__ void operator()(const f4 (&acc)[4][2], int wr, int wc, int fr, int fq) const {
#pragma unroll
        for (int m = 0; m < 4; ++m)
#pragma unroll
            for (int n = 0; n < 2; ++n)
#pragma unroll
                for (int j = 0; j < 4; ++j) { const int r = m0 + wr * 64 + m * 16 + fq * 4 + j, c = n0 + wc * 32 + n * 16 + fr;
                    if (r < mlim && c < nlim) { C[(size_t)r * ldc + c] = acc[m][n][j]; if (C16) C16[(size_t)r * ldc + c] = (_Float16)acc[m][n][j]; } } } };
struct EpiPool { _Float16* C; const float* scale; int m0; int g;
    __device__ __forceinline__ void operator()(const f4 (&acc)[4][2], int wr, int wc, int fr, int fq) const {
#pragma unroll
        for (int m = 0; m < 4; ++m)
#pragma unroll
            for (int n = 0; n < 2; ++n)
#pragma unroll
                for (int j = 0; j < 4; ++j) { const int r = m0 + wr * 64 + m * 16 + fq * 4 + j, c = g * 128 + wc * 32 + n * 16 + fr;
                    C[(size_t)r * 512 + c] = (_Float16)(acc[m][n][j] * scale[c]); } } };
struct EpiHid { float* C; const float* bias; int m0; int n0;
    __device__ __forceinline__ void operator()(const f4 (&acc)[4][2], int wr, int wc, int fr, int fq) const {
#pragma unroll
        for (int m = 0; m < 4; ++m)
#pragma unroll
            for (int n = 0; n < 2; ++n)
#pragma unroll
                for (int j = 0; j < 4; ++j) { const int r = m0 + wr * 64 + m * 16 + fq * 4 + j, c = n0 + wc * 32 + n * 16 + fr;
                    if (r < CROWS) C[(size_t)r * 256 + c] = gelu_tanh(acc[m][n][j] + bias[c]); } } };
struct EpiOut { float* C; const float* x; int m0; int n0;
    __device__ __forceinline__ void operator()(const f4 (&acc)[4][2], int wr, int wc, int fr, int fq) const {
#pragma unroll
        for (int m = 0; m < 4; ++m)
#pragma unroll
            for (int n = 0; n < 2; ++n)
#pragma unroll
                for (int j = 0; j < 4; ++j) { const size_t o = (size_t)(m0 + wr * 64 + m * 16 + fq * 4 + j) * 2048 + n0 + wc * 32 + n * 16 + fr;
                    C[o] = DN_ALPHA * x[o] + acc[m][n][j]; } } };
struct EpiGu { float* act; const float* bgu; const int* list; int m0; int cnt; int n0;
    __device__ __forceinline__ void operator()(const f4 (&acc)[4][2], int wr, int wc, int fr, int fq) const {
        const int jc = (n0 + wc * 32) / 2 + fr;
        const float bg = bgu[2 * jc], bl = bgu[2 * jc + 1];
#pragma unroll
        for (int m = 0; m < 4; ++m)
#pragma unroll
            for (int j = 0; j < 4; ++j) { const int r = m0 + wr * 64 + m * 16 + fq * 4 + j;
                if (r < cnt) { const int a = list[r];
                    const float xg = fminf(acc[m][0][j] + bg, 7.f), xl = fminf(fmaxf(acc[m][1][j] + bl, -7.f), 7.f);
                    act[(size_t)a * 2048 + jc] = xg * sigmoidf_(1.702f * xg) * (xl + 1.f); } } } };
struct EpiDn { float* y; const float* bdn; const int* list; const float* gate; int m0; int cnt; int n0;
    __device__ __forceinline__ void operator()(const f4 (&acc)[4][2], int wr, int wc, int fr, int fq) const {
#pragma unroll
        for (int m = 0; m < 4; ++m)
#pragma unroll
            for (int j = 0; j < 4; ++j) { const int r = m0 + wr * 64 + m * 16 + fq * 4 + j;
                if (r < cnt) { const int a = list[r]; const float g = gate[a];
#pragma unroll
                    for (int n = 0; n < 2; ++n) { const int c = n0 + wc * 32 + n * 16 + fr; y[(size_t)a * 2048 + c] = (acc[m][n][j] + bdn[c]) * g; } } } } };

constexpr int WLDS_FLOATS = 4096 + 512 + 32;
template <bool SHARED>
__device__ __forceinline__ void wave_attn(float* sw, const float* __restrict__ qptr, const float* __restrict__ Kb, const float* __restrict__ Vb, int ld, int nseg, float scale, float* __restrict__ optr) {
    const int lane = threadIdx.x & 63;
    float* sq = sw + 4096; const int* segs = (const int*)(sw + 4096 + 512);
#pragma unroll
    for (int i = 0; i < 8; ++i) sq[lane + 64 * i] = qptr[lane + 64 * i];
    wave_sync();
    for (int sg = 0; sg < nseg; ++sg) {
        const int start = segs[sg], len = segs[16 + sg];
        float d0 = 0.f, d1 = 0.f, d2 = 0.f, d3 = 0.f;
        if (lane < len) {
            const float* kp = Kb + (size_t)(start + lane) * ld;
            for (int d4 = 0; d4 < 32; ++d4) {
                if (SHARED) {
                    const float4 kv = *(const float4*)(kp + d4 * 4);
                    const float4 q0 = *(const float4*)(sq + d4 * 4), q1 = *(const float4*)(sq + 128 + d4 * 4), q2 = *(const float4*)(sq + 256 + d4 * 4), q3 = *(const float4*)(sq + 384 + d4 * 4);
                    d0 += kv.x * q0.x + kv.y * q0.y + kv.z * q0.z + kv.w * q0.w;
                    d1 += kv.x * q1.x + kv.y * q1.y + kv.z * q1.z + kv.w * q1.w;
                    d2 += kv.x * q2.x + kv.y * q2.y + kv.z * q2.z + kv.w * q2.w;
                    d3 += kv.x * q3.x + kv.y * q3.y + kv.z * q3.z + kv.w * q3.w;
                } else {
                    const float4 k0 = *(const float4*)(kp + d4 * 4), k1 = *(const float4*)(kp + 128 + d4 * 4), k2 = *(const float4*)(kp + 256 + d4 * 4), k3 = *(const float4*)(kp + 384 + d4 * 4);
                    const float4 q0 = *(const float4*)(sq + d4 * 4), q1 = *(const float4*)(sq + 128 + d4 * 4), q2 = *(const float4*)(sq + 256 + d4 * 4), q3 = *(const float4*)(sq + 384 + d4 * 4);
                    d0 += k0.x * q0.x + k0.y * q0.y + k0.z * q0.z + k0.w * q0.w;
                    d1 += k1.x * q1.x + k1.y * q1.y + k1.z * q1.z + k1.w * q1.w;
                    d2 += k2.x * q2.x + k2.y * q2.y + k2.z * q2.z + k2.w * q2.w;
                    d3 += k3.x * q3.x + k3.y * q3.y + k3.z * q3.z + k3.w * q3.w;
                }
            }
        }
        const bool ok = lane < len;
        sw[sg * 64 + lane] = ok ? d0 * scale : -1e30f;
        sw[1024 + sg * 64 + lane] = ok ? d1 * scale : -1e30f;
        sw[2048 + sg * 64 + lane] = ok ? d2 * scale : -1e30f;
        sw[3072 + sg * 64 + lane] = ok ? d3 * scale : -1e30f;
    }
    wave_sync();
    const int n = nseg * 64;
#pragma unroll
    for (int g = 0; g < 4; ++g) {
        float mx = -1e30f;
        for (int i = lane; i < n; i += 64) mx = fmaxf(mx, sw[g * 1024 + i]);
        mx = wave_max(mx);
        float sm = 0.f;
        for (int i = lane; i < n; i += 64) { const float v = sw[g * 1024 + i]; sm += (v > -1e29f) ? expf(v - mx) : 0.f; }
        sm = wave_sum(sm);
        const float inv = sm > 0.f ? 1.f / sm : 0.f;
        for (int i = lane; i < n; i += 64) { const float v = sw[g * 1024 + i]; sw[g * 1024 + i] = (v > -1e29f) ? expf(v - mx) * inv : 0.f; }
    }
    wave_sync();
    float o[4][2];
#pragma unroll
    for (int g = 0; g < 4; ++g) { o[g][0] = 0.f; o[g][1] = 0.f; }
    for (int sg = 0; sg < nseg; ++sg) {
        const int start = segs[sg], len = segs[16 + sg];
        for (int l = 0; l < len; ++l) {
            const float* vp = Vb + (size_t)(start + l) * ld;
            if (SHARED) {
                const float v0 = vp[lane], v1 = vp[lane + 64];
#pragma unroll
                for (int g = 0; g < 4; ++g) { const float p = sw[g * 1024 + sg * 64 + l]; o[g][0] += p * v0; o[g][1] += p * v1; }
            } else {
#pragma unroll
                for (int g = 0; g < 4; ++g) { const float p = sw[g * 1024 + sg * 64 + l]; o[g][0] += p * vp[g * 128 + lane]; o[g][1] += p * vp[g * 128 + lane + 64]; }
            }
        }
    }
#pragma unroll
    for (int g = 0; g < 4; ++g) { optr[g * 128 + lane] = o[g][0]; optr[g * 128 + lane + 64] = o[g][1]; }
}

namespace g8 {
constexpr int BM = 256, BK = 64, HALF = 128, HTB = HALF * BK * 2, STAGE_BYTES = 8 * HTB;
constexpr int KK = 2048;
typedef float f32x4 __attribute__((ext_vector_type(4)));
__device__ __forceinline__ int lds_byte(int r, int c) { const int st = (r >> 4) * 2 + (c >> 5), rr = r & 15, cc = c & 31, ob = rr * 64 + cc * 2; return st * 1024 + (ob ^ (((ob >> 9) & 1) << 5)); }
__device__ __forceinline__ void stage_rc(int b, int& R, int& C) { const int st = b / 1024, sb = b % 1024, swz = sb ^ (((sb >> 9) & 1) << 5); R = (st >> 1) * 16 + swz / 64; C = (st & 1) * 32 + (swz % 64) / 2; }
__device__ __forceinline__ int perm32(int rho) { const int n = rho >> 4, i = rho & 15; return 8 * (i >> 2) + 4 * n + (i & 3); }

typedef int i32x4 __attribute__((ext_vector_type(4)));
template <bool I8> struct AccSel { typedef f32x4 T; };
template <> struct AccSel<true> { typedef i32x4 T; };
__device__ __forceinline__ f32x4 mma16(i32x4 a, i32x4 b, f32x4 c) { return __builtin_amdgcn_mfma_f32_16x16x32_f16(*reinterpret_cast<h8*>(&a), *reinterpret_cast<h8*>(&b), c, 0, 0, 0); }
__device__ __forceinline__ i32x4 mma16(i32x4 a, i32x4 b, i32x4 c) { return __builtin_amdgcn_mfma_i32_16x16x64_i8(a, b, c, 0, 0, 0); }
struct Unit { int m0, n0, e, cnt, rbase; };
constexpr int EP_OFF = STAGE_BYTES + 512, EP_LD = 528, EP_GRP = 16 * EP_LD;
__device__ __forceinline__ void ep_sync() { asm volatile("s_waitcnt lgkmcnt(0)" ::: "memory"); __builtin_amdgcn_s_barrier(); asm volatile("" ::: "memory"); }
__device__ __forceinline__ int ep_tid() { int tz = threadIdx.x; asm volatile("" : "+v"(tz)); return tz; }
__device__ __forceinline__ h8 cvt8(f32x4 a, f32x4 b) { h8 o; o[0] = (_Float16)a[0]; o[1] = (_Float16)a[1]; o[2] = (_Float16)a[2]; o[3] = (_Float16)a[3]; o[4] = (_Float16)b[0]; o[5] = (_Float16)b[1]; o[6] = (_Float16)b[2]; o[7] = (_Float16)b[3]; return o; }

__device__ __forceinline__ void tile_order(int L, int nM, int nN, int& pm, int& pn) {
    const int nwg = nM * nN; int wgid = L;
    { const int q = nwg / 8, r = nwg % 8, xcd = wgid % 8, off = wgid / 8; wgid = (xcd < r ? xcd * (q + 1) : r * (q + 1) + (xcd - r) * q) + off; }
    const int nig = 8 * nN, gid = wgid / nig, fm = gid * 8, gsz = (nM - fm) < 8 ? (nM - fm) : 8;
    pm = fm + ((wgid % nig) % gsz); pn = (wgid % nig) / gsz;
}

template <class Prob>
__device__ __forceinline__ void gemm_phase(LAS unsigned char* lds, const Prob& P) {
    const int tid = threadIdx.x, wid = __builtin_amdgcn_readfirstlane(tid >> 6), lane = tid & 63, wr = wid >> 2, wc = wid & 3, fr = lane & 15, fq = lane >> 4;
    constexpr int nt = Prob::NT; constexpr size_t KS2 = Prob::KS2; constexpr unsigned ROWB = Prob::ROWB; constexpr bool I8 = Prob::I8;
    int sR[2], sC2[2]; unsigned voffB[2];
#pragma unroll
    for (int i = 0; i < 2; ++i) { int R, C; stage_rc(tid * 16 + i * 8192, R, C); sR[i] = R; sC2[i] = C * 2; const int Rb = Prob::PERM ? ((R & ~31) + perm32(R & 31)) : R; voffB[i] = (unsigned)Rb * ROWB + (unsigned)C * 2u; }
    const size_t kstep = (size_t)(BK * 2);
    const size_t hstep = (size_t)HALF * ROWB;
    const unsigned ldsw = (unsigned)wid * 1024u;
    const int aoff = lds_byte(wr * 64 + fr, fq * 8), boff = lds_byte(wc * 32 + fr, fq * 8);
#define G8_SA(b, h) (((b) * 2 + (h)) * HTB)
#define G8_SB(b, h) ((4 + (b) * 2 + (h)) * HTB)
#define G8_STAGE(bufoff, gbase, voff) do { _Pragma("unroll") for (int _i = 0; _i < 2; ++_i) \
        __builtin_amdgcn_global_load_lds((const unsigned*)((const char*)(gbase) + (voff)[_i]), (LAS unsigned*)(lds + (bufoff) + ldsw + _i * 8192), 16, 0, 0); } while (0)
#define G8_LDA(dst, b, h) do { _Pragma("unroll") for (int m = 0; m < 4; ++m) _Pragma("unroll") for (int k = 0; k < 2; ++k) dst[m][k] = *(const LAS i32x4*)(lds + G8_SA(b, h) + aoff + m * 2048 + k * 1024); } while (0)
#define G8_LDB(dst, b, h) do { _Pragma("unroll") for (int n = 0; n < 2; ++n) _Pragma("unroll") for (int k = 0; k < 2; ++k) dst[n][k] = *(const LAS i32x4*)(lds + G8_SB(b, h) + boff + n * 2048 + k * 1024); } while (0)
#define G8_MMA(ai, bj, At, Bt) do { __builtin_amdgcn_s_setprio(1); _Pragma("unroll") for (int m = 0; m < 4; ++m) _Pragma("unroll") for (int n = 0; n < 2; ++n) _Pragma("unroll") for (int k = 0; k < 2; ++k) \
        acc[ai][bj][m][n] = mma16(Bt[n][k], At[m][k], acc[ai][bj][m][n]); __builtin_amdgcn_s_setprio(0); } while (0)
#define G8_WAIT_V(n) asm volatile("s_waitcnt vmcnt(" #n ")" ::: "memory")
#define G8_WAIT_L(n) asm volatile("s_waitcnt lgkmcnt(" #n ")" ::: "memory")
#define G8_BAR __builtin_amdgcn_s_barrier()
#define G8_SCHED __builtin_amdgcn_sched_barrier(0)
    Unit cur, nxt; int ui = 0;
    if (!P.next(0, cur)) return;
    typedef typename AccSel<I8>::T AccT;
    AccT acc[2][2][4][2];
#pragma unroll
    for (int a = 0; a < 2; ++a)
#pragma unroll
        for (int b = 0; b < 2; ++b)
#pragma unroll
            for (int m = 0; m < 4; ++m)
#pragma unroll
                for (int n = 0; n < 2; ++n) acc[a][b][m][n] = AccT{};
    i32x4 At[4][2], B0[2][2], B1[2][2];
    unsigned vc[2][2], vn[2][2];
    P.a_offs(cur, sR, sC2, vc);
    const char* const Ab = P.a_base();
    const char* cB = P.b_base(cur);
    G8_STAGE(G8_SB(0, 0), cB, voffB); G8_STAGE(G8_SA(0, 0), Ab, vc[0]); G8_STAGE(G8_SB(0, 1), cB + hstep, voffB); G8_STAGE(G8_SA(0, 1), Ab, vc[1]);
    if (wr == 1) G8_BAR;
    G8_WAIT_V(4); G8_BAR;
    G8_STAGE(G8_SB(1, 0), cB + kstep, voffB); G8_STAGE(G8_SA(1, 0), Ab + kstep, vc[0]); G8_STAGE(G8_SB(1, 1), cB + hstep + kstep, voffB);
    G8_WAIT_V(6); G8_BAR;
    for (;;) {
        const bool has_next = P.next(ui + 1, nxt);
        const char* nB = cB;
        if (has_next) { P.a_offs(nxt, sR, sC2, vn); nB = P.b_base(nxt); }
        else { vn[0][0] = vc[0][0]; vn[0][1] = vc[0][1]; vn[1][0] = vc[1][0]; vn[1][1] = vc[1][1]; }
        for (int t = 0; t < nt; t += 2) {
            const bool last = (t == nt - 2);
            const char* a1 = Ab + (size_t)(t >> 1) * KS2 + kstep;
            const char* a2 = last ? Ab : Ab + (size_t)((t + 2) >> 1) * KS2; const char* b2 = last ? nB : cB + (size_t)(t + 2) * kstep;
            const char* a3 = a2 + kstep; const char* b3 = b2 + kstep;
            unsigned o2[2][2];
            o2[0][0] = last ? vn[0][0] : vc[0][0]; o2[0][1] = last ? vn[0][1] : vc[0][1]; o2[1][0] = last ? vn[1][0] : vc[1][0]; o2[1][1] = last ? vn[1][1] : vc[1][1];
            G8_LDB(B0, 0, 0); G8_SCHED; G8_LDA(At, 0, 0); G8_STAGE(G8_SA(1, 1), a1, vc[1]);
            G8_WAIT_L(8); G8_BAR; G8_WAIT_L(0); G8_MMA(0, 0, At, B0); G8_BAR; G8_SCHED;
            G8_LDB(B1, 0, 1); G8_STAGE(G8_SB(0, 0), b2, voffB);
            G8_BAR; G8_WAIT_L(0); G8_MMA(0, 1, At, B1); G8_BAR;
            G8_LDA(At, 0, 1); G8_STAGE(G8_SA(0, 0), a2, o2[0]);
            G8_BAR; G8_WAIT_L(0); G8_MMA(1, 0, At, B0); G8_BAR; G8_SCHED;
            G8_STAGE(G8_SB(0, 1), b2 + hstep, voffB);
            G8_WAIT_V(6); G8_BAR; G8_MMA(1, 1, At, B1); G8_BAR;
            G8_LDB(B0, 1, 0); G8_SCHED; G8_LDA(At, 1, 0); G8_STAGE(G8_SA(0, 1), a2, o2[1]);
            G8_WAIT_L(8); G8_BAR; G8_WAIT_L(0); G8_MMA(0, 0, At, B0); G8_BAR; G8_SCHED;
            G8_LDB(B1, 1, 1); G8_STAGE(G8_SB(1, 0), b3, voffB);
            G8_BAR; G8_WAIT_L(0); G8_MMA(0, 1, At, B1); G8_BAR;
            G8_LDA(At, 1, 1); G8_STAGE(G8_SA(1, 0), a3, o2[0]);
            G8_BAR; G8_WAIT_L(0); G8_MMA(1, 0, At, B0); G8_BAR; G8_SCHED;
            G8_STAGE(G8_SB(1, 1), b3 + hstep, voffB);
            G8_WAIT_V(6); G8_BAR; G8_MMA(1, 1, At, B1); G8_BAR;
        }
        P.epi(acc, cur, wr, wc, fr, fq, lds);
        if (!has_next) break;
#pragma unroll
        for (int a = 0; a < 2; ++a)
#pragma unroll
            for (int b = 0; b < 2; ++b)
#pragma unroll
                for (int m = 0; m < 4; ++m)
#pragma unroll
                    for (int n = 0; n < 2; ++n) acc[a][b][m][n] = AccT{};
        cur = nxt; cB = nB; ++ui;
        vc[0][0] = vn[0][0]; vc[0][1] = vn[0][1]; vc[1][0] = vn[1][0]; vc[1][1] = vn[1][1];
    }
    G8_WAIT_V(0);
    if (wr == 0) G8_BAR;
    G8_BAR;
#undef G8_SA
#undef G8_SB
#undef G8_STAGE
#undef G8_LDA
#undef G8_LDB
#undef G8_MMA
#undef G8_WAIT_V
#undef G8_WAIT_L
#undef G8_BAR
#undef G8_SCHED
}

struct ProbIn {
    static constexpr unsigned ROWB = 4096; static constexpr bool I8 = false;
    static constexpr int NT = 32; static constexpr size_t KS2 = 256;
    static constexpr bool PERM = true;
    const _Float16* A; _Float16* C16; int G, c;
    __device__ __forceinline__ bool next(int i, Unit& u) const { const int L = i * G + c; if (L >= 64 * 15 + 32) return false;
        if (L < 64 * 15) { int pm, pn; tile_order(L, 64, 15, pm, pn); u.m0 = pm * 256; u.n0 = pn * 256; u.e = 0; }
        else { const int v = L - 64 * 15; u.m0 = T_ + (v & 7) * 256; u.n0 = (v >> 3) * 256; u.e = 1; }
        u.cnt = 256; u.rbase = 0; return true; }
    __device__ __forceinline__ void a_offs(const Unit& u, const int (&R)[2], const int (&C2)[2], unsigned (&v)[2][2]) const {
#pragma unroll
        for (int h = 0; h < 2; ++h)
#pragma unroll
            for (int i = 0; i < 2; ++i) v[h][i] = (unsigned)(u.m0 + h * 128 + R[i]) * (unsigned)(KK * 2) + (unsigned)C2[i]; }
    __device__ __forceinline__ const char* a_base() const { return (const char*)A; }
    __device__ __forceinline__ const char* b_base(const Unit& u) const { return (const char*)A + (u.e ? (long long)(WS_WTMKV - WS_X16) : (long long)(WS_WTIN - WS_X16)) + (size_t)u.n0 * KK * 2; }
    __device__ __forceinline__ void epi(const f32x4 (&acc)[2][2][4][2], const Unit& u, int wr, int wc, int fr, int fq, LAS unsigned char* lds) const {
        LAS unsigned char* ep = lds + EP_OFF + wr * EP_GRP;
        const int tg = ep_tid() & 255, rrow = tg >> 4, ch = tg & 15;
        const int kvseg = (u.e == 0 && u.n0 >= 1024 && u.n0 < 2560) ? ((u.n0 - 1024) >> 8) : -1;
        _Float16* const Cb = (_Float16*)((char*)C16 + (u.e ? (long long)(WS_KVMEM16 - WS_PROJ16) : 0ll)); const int ldc = u.e ? 1024 : INW, nlim = u.e ? 1024 : INW, mb = u.e ? u.m0 - T_ : u.m0;
#pragma unroll
        for (int ai = 0; ai < 2; ++ai)
#pragma unroll
            for (int m = 0; m < 4; ++m) {
#pragma unroll
                for (int bj = 0; bj < 2; ++bj) *(LAS h8*)(ep + fr * EP_LD + (bj * 128 + wc * 32 + fq * 8) * 2) = cvt8(acc[ai][bj][m][0], acc[ai][bj][m][1]);
                ep_sync();
                const h8 x0 = *(const LAS h8*)(ep + rrow * EP_LD + ch * 32), x1 = *(const LAS h8*)(ep + rrow * EP_LD + ch * 32 + 16);
                const int grow = mb + ai * 128 + wr * 64 + m * 16 + rrow, gcol = u.n0 + ch * 16;
                if (kvseg >= 0) {
                    _Float16* dst = (_Float16*)((char*)C16 + (long long)(WS_KV16 - WS_PROJ16)) + ((size_t)(kvseg * B_ + (grow >> 11)) * 2 + (ch >> 3)) * KVSEG + (size_t)(grow & (S_ - 1)) * 128 + (ch & 7) * 16;
                    *(h8*)dst = x0; *(h8*)(dst + 8) = x1;
                } else {
                    if (gcol < nlim) *(h8*)(Cb + (size_t)grow * ldc + gcol) = x0;
                    if (gcol + 8 < nlim) *(h8*)(Cb + (size_t)grow * ldc + gcol + 8) = x1; }
                ep_sync();
            } }
};
struct ProbOut {
    static constexpr unsigned ROWB = 2048; static constexpr bool I8 = true;
    static constexpr int NT = 16; static constexpr size_t KS2 = 256;
    static constexpr bool PERM = true;
    const signed char* A; const signed char* Bt; _Float16* C; const _Float16* X; const float* sa; const float* sw; int G, c;
    __device__ __forceinline__ bool next(int i, Unit& u) const { const int L = i * G + c; if (L >= 64 * 8) return false; int pm, pn; tile_order(L, 64, 8, pm, pn); u.m0 = pm * 256; u.n0 = pn * 256; u.e = 0; u.cnt = 256; u.rbase = 0; return true; }
    __device__ __forceinline__ void a_offs(const Unit& u, const int (&R)[2], const int (&C2)[2], unsigned (&v)[2][2]) const {
#pragma unroll
        for (int h = 0; h < 2; ++h)
#pragma unroll
            for (int i = 0; i < 2; ++i) v[h][i] = (unsigned)(u.m0 + h * 128 + R[i]) * 2048u + (unsigned)C2[i]; }
    __device__ __forceinline__ const char* a_base() const { return (const char*)A; }
    __device__ __forceinline__ const char* b_base(const Unit& u) const { return (const char*)(Bt + (size_t)u.n0 * 2048); }
    __device__ __forceinline__ void epi(const i32x4 (&acc)[2][2][4][2], const Unit& u, int wr, int wc, int fr, int fq, LAS unsigned char* lds) const {
        LAS unsigned char* ep = lds + EP_OFF + wr * EP_GRP;
        const int tg = ep_tid() & 255, rrow = tg >> 4, ch = tg & 15;
        f32x4 s0[2], s1[2]; float srv[8];
#pragma unroll
        for (int bj = 0; bj < 2; ++bj) { const int col = u.n0 + bj * 128 + wc * 32 + fq * 8; s0[bj] = *(const f32x4*)(sw + col); s1[bj] = *(const f32x4*)(sw + col + 4); }
#pragma unroll
        for (int q = 0; q < 8; ++q) srv[q] = sa[u.m0 + (q >> 2) * 128 + wr * 64 + (q & 3) * 16 + fr];
#pragma unroll
        for (int ai = 0; ai < 2; ++ai)
#pragma unroll
            for (int m = 0; m < 4; ++m) { const float sr = srv[ai * 4 + m];
#pragma unroll
                for (int bj = 0; bj < 2; ++bj) { const i32x4 i0 = acc[ai][bj][m][0], i1 = acc[ai][bj][m][1];
                    *(LAS h8*)(ep + fr * EP_LD + (bj * 128 + wc * 32 + fq * 8) * 2) = cvt8((f32x4){(float)i0[0], (float)i0[1], (float)i0[2], (float)i0[3]} * (s0[bj] * sr), (f32x4){(float)i1[0], (float)i1[1], (float)i1[2], (float)i1[3]} * (s1[bj] * sr)); }
                const size_t go = (size_t)(u.m0 + ai * 128 + wr * 64 + m * 16 + rrow) * 2048 + u.n0 + ch * 16;
                const h8 r0 = *(const h8*)(X + go), r1 = *(const h8*)(X + go + 8);
                ep_sync();
                const h8 x0 = *(const LAS h8*)(ep + rrow * EP_LD + ch * 32), x1 = *(const LAS h8*)(ep + rrow * EP_LD + ch * 32 + 16);
                h8 o0, o1;
#pragma unroll
                for (int q = 0; q < 8; ++q) { o0[q] = (_Float16)(DN_ALPHA * (float)r0[q] + (float)x0[q]); o1[q] = (_Float16)(DN_ALPHA * (float)r1[q] + (float)x1[q]); }
                *(h8*)(C + go) = o0; *(h8*)(C + go + 8) = o1;
                ep_sync();
            } }
};
struct ProbCmp {
    static constexpr unsigned ROWB = 4096; static constexpr bool I8 = false;
    static constexpr int NT = 8; static constexpr size_t KS2 = 256;
    static constexpr bool PERM = false;
    const _Float16* A; const _Float16* Bt; float* C; int G, c;
    __device__ __forceinline__ bool next(int i, Unit& u) const { const int L = i * G + c; if (L >= 128) return false;
        u.e = L >> 6; const int r = L & 63; u.rbase = r & 3; u.n0 = ((r >> 2) & 1) * 256; u.m0 = (r >> 3) * 256; u.cnt = 256; return true; }
    __device__ __forceinline__ void a_offs(const Unit& u, const int (&R)[2], const int (&C2)[2], unsigned (&v)[2][2]) const {
#pragma unroll
        for (int h = 0; h < 2; ++h)
#pragma unroll
            for (int i = 0; i < 2; ++i) { const int row = u.m0 + h * 128 + R[i], kvh = row & 1, bj = row >> 1, b = bj >> 7, j = bj & 127;
                v[h][i] = (unsigned)((((u.e * B_ + b) * 2 + kvh) * S_ + 16 * j + 4 * u.rbase) * 128) * 2u + (unsigned)C2[i]; } }
    __device__ __forceinline__ const char* a_base() const { return (const char*)A; }
    __device__ __forceinline__ const char* b_base(const Unit& u) const { return (const char*)(Bt + ((size_t)u.e * 512 + u.n0) * KK + u.rbase * 512); }
    __device__ __forceinline__ void epi(const f32x4 (&acc)[2][2][4][2], const Unit& u, int wr, int wc, int fr, int fq, LAS unsigned char*) const {
        float* base = C + ((size_t)(u.e * 4 + u.rbase) * 2048) * 512;
#pragma unroll
        for (int ai = 0; ai < 2; ++ai)
#pragma unroll
            for (int m = 0; m < 4; ++m) { const int row = u.m0 + ai * 128 + wr * 64 + m * 16 + fr;
#pragma unroll
                for (int bj = 0; bj < 2; ++bj)
#pragma unroll
                    for (int n = 0; n < 2; ++n) { const int col = u.n0 + bj * 128 + wc * 32 + n * 16 + fq * 4;
                        *(f32x4*)(base + (size_t)row * 512 + col) = acc[ai][bj][m][n]; } } }
};
struct MoeTab { const LAS int* t; int NT;
    __device__ __forceinline__ bool find(int L, Unit& u) const {
        const int total = __builtin_amdgcn_readfirstlane(t[98]); if (L >= total) return false;
        int e = 0;
        for (; e < NE - 1; ++e) { if (L < __builtin_amdgcn_readfirstlane(t[32 + e + 1])) break; }
        const int ub = __builtin_amdgcn_readfirstlane(t[32 + e]), cn = __builtin_amdgcn_readfirstlane(t[e]), rs = __builtin_amdgcn_readfirstlane(t[65 + e]);
        const int nm = (cn + 255) >> 8, v = L - ub, mt = v % nm, ntile = v / nm;
        u.e = e; u.m0 = mt * 256; u.n0 = ntile * 256; u.cnt = min(256, cn - mt * 256); u.rbase = rs; return true; } };
struct ProbGu {
    static constexpr int NT = 16; static constexpr size_t KS2 = 256; static constexpr unsigned ROWB = 2048; static constexpr bool I8 = true;
    static constexpr bool PERM = true;
    const signed char* A; const signed char* Bt; _Float16* act; const float* bgu; const int* list; const float* sa; const float* sw; MoeTab tab; int G, vcu;
    __device__ __forceinline__ bool next(int i, Unit& u) const { return tab.find(i * G + vcu, u); }
    __device__ __forceinline__ void a_offs(const Unit& u, const int (&R)[2], const int (&C2)[2], unsigned (&v)[2][2]) const {
#pragma unroll
        for (int h = 0; h < 2; ++h)
#pragma unroll
            for (int i = 0; i < 2; ++i) { int r = h * 128 + R[i]; r = r < u.cnt ? r : 0; const int a = list[(size_t)u.e * T_ + u.m0 + r]; v[h][i] = (unsigned)(a >> 2) * 2048u + (unsigned)C2[i]; } }
    __device__ __forceinline__ const char* a_base() const { return (const char*)A; }
    __device__ __forceinline__ const char* b_base(const Unit& u) const { return (const char*)(Bt + ((size_t)u.e * 4096 + u.n0) * 2048); }
    __device__ __forceinline__ void epi(const i32x4 (&acc)[2][2][4][2], const Unit& u, int wr, int wc, int fr, int fq, LAS unsigned char* lds) const {
        const float* bb = bgu + (size_t)u.e * 4096; const float* ss = sw + (size_t)u.e * 4096;
        LAS unsigned char* ep = lds + EP_OFF + wr * EP_GRP;
        const int tg = ep_tid() & 255, rrow = tg >> 4, ch = tg & 15;
        f32x4 b0[2], b1[2], s0[2], s1[2];
#pragma unroll
        for (int bj = 0; bj < 2; ++bj) { const int col = u.n0 + bj * 128 + wc * 32 + fq * 8;
            b0[bj] = *(const f32x4*)(bb + col); b1[bj] = *(const f32x4*)(bb + col + 4); s0[bj] = *(const f32x4*)(ss + col); s1[bj] = *(const f32x4*)(ss + col + 4); }
        float srv[8];
        { int av[8];
#pragma unroll
          for (int q = 0; q < 8; ++q) { const int rl = (q >> 2) * 128 + wr * 64 + (q & 3) * 16 + fr; av[q] = list[(size_t)u.e * T_ + u.m0 + (rl < u.cnt ? rl : 0)]; }
#pragma unroll
          for (int q = 0; q < 8; ++q) srv[q] = sa[av[q] >> 2]; }
        LAS unsigned char* ep2 = lds + EP_OFF + wr * (2 * 16 * 272);
#pragma unroll
        for (int ai = 0; ai < 2; ++ai)
#pragma unroll
            for (int mp = 0; mp < 2; ++mp) {
#pragma unroll
                for (int mm = 0; mm < 2; ++mm) { const int m = mp * 2 + mm; const float sr = srv[ai * 4 + m];
#pragma unroll
                    for (int bj = 0; bj < 2; ++bj) {
                        const i32x4 i0 = acc[ai][bj][m][0], i1 = acc[ai][bj][m][1];
                        const f32x4 v0 = (f32x4){(float)i0[0], (float)i0[1], (float)i0[2], (float)i0[3]} * (s0[bj] * sr) + b0[bj], v1 = (f32x4){(float)i1[0], (float)i1[1], (float)i1[2], (float)i1[3]} * (s1[bj] * sr) + b1[bj];
                        h4 o;
                        o[0] = (_Float16)swiglu_fast(v0[0], v0[1]); o[1] = (_Float16)swiglu_fast(v0[2], v0[3]); o[2] = (_Float16)swiglu_fast(v1[0], v1[1]); o[3] = (_Float16)swiglu_fast(v1[2], v1[3]);
                        *(LAS h4*)(ep2 + (mm * 16 + fr) * 272 + (bj * 64 + wc * 16 + fq * 4) * 2) = o; } }
                ep_sync();
#pragma unroll
                for (int mm = 0; mm < 2; ++mm) { const h8 x0 = *(const LAS h8*)(ep2 + (mm * 16 + rrow) * 272 + ch * 16);
                    const int rr = ai * 128 + wr * 64 + (mp * 2 + mm) * 16 + rrow;
                    if (rr < u.cnt) *(h8*)(act + (size_t)(u.rbase + u.m0 + rr) * 2048 + (u.n0 >> 1) + ch * 8) = x0; }
                ep_sync();
            } }
};
struct ProbDn {
    static constexpr int NT = 16; static constexpr size_t KS2 = 256; static constexpr unsigned ROWB = 2048; static constexpr bool I8 = true;
    static constexpr bool PERM = true;
    const signed char* A; const signed char* Bt; _Float16* y; const float* bdn; const int* list; const float* gate; const float* sa; const float* sw; MoeTab tab; int G, vcu;
    __device__ __forceinline__ bool next(int i, Unit& u) const { return tab.find(i * G + vcu, u); }
    __device__ __forceinline__ void a_offs(const Unit& u, const int (&R)[2], const int (&C2)[2], unsigned (&v)[2][2]) const {
#pragma unroll
        for (int h = 0; h < 2; ++h)
#pragma unroll
            for (int i = 0; i < 2; ++i) v[h][i] = (unsigned)(u.rbase + u.m0 + h * 128 + R[i]) * 2048u + (unsigned)C2[i]; }
    __device__ __forceinline__ const char* a_base() const { return (const char*)A; }
    __device__ __forceinline__ const char* b_base(const Unit& u) const { return (const char*)(Bt + ((size_t)u.e * 2048 + u.n0) * 2048); }
    __device__ __forceinline__ void epi(const i32x4 (&acc)[2][2][4][2], const Unit& u, int wr, int wc, int fr, int fq, LAS unsigned char* lds) const {
        const float* bb = bdn + (size_t)u.e * 2048; const float* ss = sw + (size_t)u.e * 2048;
        LAS unsigned char* ep = lds + EP_OFF + wr * EP_GRP;
        const int tg = ep_tid() & 255, rrow = tg >> 4, ch = tg & 15;
        f32x4 b0[2], b1[2], s0[2], s1[2];
#pragma unroll
        for (int bj = 0; bj < 2; ++bj) { const int col = u.n0 + bj * 128 + wc * 32 + fq * 8;
            b0[bj] = *(const f32x4*)(bb + col); b1[bj] = *(const f32x4*)(bb + col + 4); s0[bj] = *(const f32x4*)(ss + col); s1[bj] = *(const f32x4*)(ss + col + 4); }
        float gv[8], srv[8]; int a2v[8];
        { int av[8];
#pragma unroll
          for (int q = 0; q < 8; ++q) { const int rl = (q >> 2) * 128 + wr * 64 + (q & 3) * 16 + fr, rc = rl < u.cnt ? rl : 0; av[q] = list[(size_t)u.e * T_ + u.m0 + rc]; srv[q] = sa[u.rbase + u.m0 + rc];
              const int rr = (q >> 2) * 128 + wr * 64 + (q & 3) * 16 + rrow; a2v[q] = list[(size_t)u.e * T_ + u.m0 + (rr < u.cnt ? rr : 0)]; }
#pragma unroll
          for (int q = 0; q < 8; ++q) gv[q] = gate[av[q]]; }
#pragma unroll
        for (int ai = 0; ai < 2; ++ai)
#pragma unroll
            for (int m = 0; m < 4; ++m) { const float g = gv[ai * 4 + m], sr = srv[ai * 4 + m];
#pragma unroll
                for (int bj = 0; bj < 2; ++bj) {
                    const i32x4 i0 = acc[ai][bj][m][0], i1 = acc[ai][bj][m][1];
                    const f32x4 v0 = ((f32x4){(float)i0[0], (float)i0[1], (float)i0[2], (float)i0[3]} * (s0[bj] * sr) + b0[bj]) * g, v1 = ((f32x4){(float)i1[0], (float)i1[1], (float)i1[2], (float)i1[3]} * (s1[bj] * sr) + b1[bj]) * g;
                    *(LAS h8*)(ep + fr * EP_LD + (bj * 128 + wc * 32 + fq * 8) * 2) = cvt8(v0, v1); }
                const int rr = ai * 128 + wr * 64 + m * 16 + rrow;
                const int a2 = a2v[ai * 4 + m];
                ep_sync();
                const h8 x0 = *(const LAS h8*)(ep + rrow * EP_LD + ch * 32), x1 = *(const LAS h8*)(ep + rrow * EP_LD + ch * 32 + 16);
                if (rr < u.cnt) { *(h8*)(y + (size_t)a2 * 2048 + u.n0 + ch * 16) = x0; *(h8*)(y + (size_t)a2 * 2048 + u.n0 + ch * 16 + 8) = x1; }
                ep_sync();
            } }
};
}

namespace at8 {
typedef float f32x16 __attribute__((ext_vector_type(16)));
typedef short s16x4 __attribute__((ext_vector_type(4)));
typedef unsigned u32x4 __attribute__((ext_vector_type(4)));
constexpr int SHM_V = 64 * 128 * 2, SHM_K = 64 * 128 * 2;
constexpr int LDS_WS = 2 * SHM_V + 2 * SHM_K;
constexpr int LDS_END = LDS_WS + 8 * 64 * 4;
constexpr float CEXP = ATT_SCALE * 1.4426950408889634f;
constexpr float THR_RAW = 8.f / ATT_SCALE;
#define AT_KSWZ(row, colB) ((row) * 256 + ((colB) ^ (((row) & 7) << 4)))
#define AT_SBAR() __builtin_amdgcn_sched_barrier(0)
__device__ __forceinline__ int crow(int r, int hi) { return (r & 3) + 8 * (r >> 2) + 4 * hi; }
__device__ __forceinline__ unsigned cvtpk(float lo, float hi) { auto v = __builtin_amdgcn_cvt_pkrtz(lo, hi); return *reinterpret_cast<unsigned*>(&v); }
__device__ __forceinline__ int v_st(int k, int c) { const int kk = (k & ~0xC) | ((k & 4) << 1) | ((k & 8) >> 1); return ((kk >> 3) * 4 + (c >> 5)) * 512 + ((kk & 7) * 32 + (c & 31)) * 2; }
__device__ __forceinline__ int v_rd_base(int lane) { return ((lane & 3) << 3) | (((lane >> 2) & 3) << 6) | (((lane >> 4) & 1) << 5) | (((lane >> 5) & 1) << 8); }
constexpr int v_rd_off(int d0, int ks, int half) { return d0 * 512 + ks * 4096 + half * 2048; }
template <int OFF> __device__ __forceinline__ s16x4 tr_read(int vb) { s16x4 r; asm volatile("ds_read_b64_tr_b16 %0, %1 offset:%2" : "=&v"(r) : "v"(vb), "i"(OFF) : "memory"); return r; }
__device__ __forceinline__ h8 mk8(s16x4 l, s16x4 h) { typedef short s16x8 __attribute__((ext_vector_type(8))); s16x8 w = {l[0], l[1], l[2], l[3], h[0], h[1], h[2], h[3]}; return *reinterpret_cast<h8*>(&w); }
template <int D0> __device__ __forceinline__ void pv_one(f32x16& od, int vb, h8 pa0, h8 pa1, h8 pa2, h8 pa3) {
    const s16x4 l0 = tr_read<v_rd_off(D0, 0, 0)>(vb), h0 = tr_read<v_rd_off(D0, 0, 1)>(vb), l1 = tr_read<v_rd_off(D0, 1, 0)>(vb), h1 = tr_read<v_rd_off(D0, 1, 1)>(vb);
    const s16x4 l2 = tr_read<v_rd_off(D0, 2, 0)>(vb), h2 = tr_read<v_rd_off(D0, 2, 1)>(vb), l3 = tr_read<v_rd_off(D0, 3, 0)>(vb), h3 = tr_read<v_rd_off(D0, 3, 1)>(vb);
    asm volatile("s_waitcnt lgkmcnt(0)" ::: "memory"); AT_SBAR();
    od = __builtin_amdgcn_mfma_f32_32x32x16_f16(pa0, mk8(l0, h0), od, 0, 0, 0);
    od = __builtin_amdgcn_mfma_f32_32x32x16_f16(pa1, mk8(l1, h1), od, 0, 0, 0);
    od = __builtin_amdgcn_mfma_f32_32x32x16_f16(pa2, mk8(l2, h2), od, 0, 0, 0);
    od = __builtin_amdgcn_mfma_f32_32x32x16_f16(pa3, mk8(l3, h3), od, 0, 0, 0);
}
__device__ __forceinline__ void pv_d0(f32x16 (&o)[4], int vb, h8 pa0, h8 pa1, h8 pa2, h8 pa3) {
    pv_one<0>(o[0], vb, pa0, pa1, pa2, pa3); pv_one<1>(o[1], vb, pa0, pa1, pa2, pa3); pv_one<2>(o[2], vb, pa0, pa1, pa2, pa3); pv_one<3>(o[3], vb, pa0, pa1, pa2, pa3);
}
__device__ __forceinline__ void qkt(f32x16& p0, f32x16& p1, const char* Ks, const h8 (&qr)[8], int r32, int hi) {
    p0 = f32x16{}; p1 = f32x16{};
#pragma unroll
    for (int d0 = 0; d0 < 8; ++d0) { const int cb = (d0 * 16 + hi * 8) * 2;
        const h8 b0 = *reinterpret_cast<const h8*>(Ks + AT_KSWZ(r32, cb));
        const h8 b1 = *reinterpret_cast<const h8*>(Ks + AT_KSWZ(32 + r32, cb));
        p0 = __builtin_amdgcn_mfma_f32_32x32x16_f16(b0, qr[d0], p0, 0, 0, 0);
        p1 = __builtin_amdgcn_mfma_f32_32x32x16_f16(b1, qr[d0], p1, 0, 0, 0); }
}
__device__ __forceinline__ void pack_p(const f32x16& p0, const f32x16& p1, h8& pa0, h8& pa1, h8& pa2, h8& pa3) {
#define AT_PK4(P, BASE, OUT) do { unsigned a0 = cvtpk(P[BASE + 0], P[BASE + 1]), a1 = cvtpk(P[BASE + 2], P[BASE + 3]); \
    unsigned b0 = cvtpk(P[BASE + 4], P[BASE + 5]), b1 = cvtpk(P[BASE + 6], P[BASE + 7]); \
    auto r0 = __builtin_amdgcn_permlane32_swap(a0, b0, false, false); auto r1 = __builtin_amdgcn_permlane32_swap(a1, b1, false, false); \
    u32x4 w = {r0[0], r1[0], r0[1], r1[1]}; OUT = *reinterpret_cast<h8*>(&w); } while (0)
    AT_PK4(p0, 0, pa0); AT_PK4(p0, 8, pa1); AT_PK4(p1, 0, pa2); AT_PK4(p1, 8, pa3);
#undef AT_PK4
}
__device__ __forceinline__ float half_swap_max(float v) { auto rr = __builtin_amdgcn_permlane32_swap(__float_as_uint(v), __float_as_uint(v), false, false); return fmaxf(__uint_as_float(rr[0]), __uint_as_float(rr[1])); }
__device__ __forceinline__ float half_swap_sum(float v) { auto rr = __builtin_amdgcn_permlane32_swap(__float_as_uint(v), __float_as_uint(v), false, false); return __uint_as_float(rr[0]) + __uint_as_float(rr[1]); }

struct Stage4 { h8 vs0, vs1, ks0, ks1; };
__device__ __forceinline__ int hidden_tid() { int tz = threadIdx.x; asm volatile("" : "+v"(tz)); return tz; }
__device__ __forceinline__ void sload(Stage4& s, const _Float16* Kb, const _Float16* Vb, int ld, int k0) {
    const int tz = hidden_tid(), sr = tz >> 4, sc = (tz & 15) * 8;
    s.vs0 = *(const h8*)(Vb + (size_t)(k0 + sr) * ld + sc); s.vs1 = *(const h8*)(Vb + (size_t)(k0 + 32 + sr) * ld + sc);
    s.ks0 = *(const h8*)(Kb + (size_t)(k0 + sr) * ld + sc); s.ks1 = *(const h8*)(Kb + (size_t)(k0 + 32 + sr) * ld + sc);
}
__device__ __forceinline__ void swrite(const Stage4& s, char* V_lds, char* K_lds, int b) {
    const int tz = hidden_tid(), sr = tz >> 4, sc = (tz & 15) * 8, vst0 = v_st(sr, sc), vst1 = v_st(32 + sr, sc);
    *(h8*)(V_lds + b * SHM_V + vst0) = s.vs0; *(h8*)(V_lds + b * SHM_V + vst1) = s.vs1;
    const int kc = sc * 2;
    *(h8*)(K_lds + b * SHM_K + AT_KSWZ(sr, kc)) = s.ks0; *(h8*)(K_lds + b * SHM_K + AT_KSWZ(32 + sr, kc)) = s.ks1;
}

__device__ __forceinline__ void attn_unit(char* lds, const _Float16* qrow, const _Float16* Kb, const _Float16* Vb, int ld, unsigned tmask, int wlen, int khi, unsigned selmask,
                                          _Float16* outw, int ostride) {
    const int tid = threadIdx.x, wid = __builtin_amdgcn_readfirstlane(tid >> 6), lane = tid & 63, r32 = lane & 31, hi = lane >> 5;
    char* V_lds = lds; char* K_lds = lds + 2 * SHM_V;
    float* wsf = (float*)(lds + LDS_WS) + wid * 64; float* li_l = wsf; float* al_l = wsf + 32;
    float m_reg = -1e30f, l_reg = 0.f; f32x16 o[4] = {}; h8 qr[8];
#pragma unroll
    for (int d0 = 0; d0 < 8; ++d0) qr[d0] = *(const h8*)(qrow + d0 * 16);
    const int vb0 = (int)(uintptr_t)V_lds + v_rd_base(lane);
    Stage4 st;
    unsigned rest = tmask; int j = __ffs(rest) - 1; rest &= rest - 1;
    sload(st, Kb, Vb, ld, j * 64); asm volatile("s_waitcnt vmcnt(0)" ::: "memory"); swrite(st, V_lds, K_lds, 0); __syncthreads();
    int buf = 0;
    for (;;) {
        const int jn = rest ? (__ffs(rest) - 1) : -1;
        if (jn >= 0) sload(st, Kb, Vb, ld, jn * 64);
        f32x16 p0, p1;
        AT_SBAR(); qkt(p0, p1, K_lds + buf * SHM_K, qr, r32, hi);
        { const int klo = wlen > 0 ? khi - wlen + 1 : 0; const bool tb = (selmask >> j) & 1u; const bool inr = (j * 64 >= klo) && (j * 64 + 63 <= khi);
          if (!__all(tb && inr)) {
              if (__all(inr)) {
#pragma unroll
                  for (int r = 0; r < 16; ++r) { p0[r] = tb ? p0[r] : -INFINITY; p1[r] = tb ? p1[r] : -INFINITY; }
              } else {
                  const int kb = j * 64 + 4 * hi;
#pragma unroll
                  for (int r = 0; r < 16; ++r) { const int k0 = kb + (r & 3) + 8 * (r >> 2);
                      p0[r] = (tb && k0 >= klo && k0 <= khi) ? p0[r] : -INFINITY;
                      p1[r] = (tb && (k0 + 32) >= klo && (k0 + 32) <= khi) ? p1[r] : -INFINITY; }
              } } }
        float pmax = p0[0];
#pragma unroll
        for (int r = 1; r < 16; ++r) pmax = fmaxf(pmax, p0[r]);
#pragma unroll
        for (int r = 0; r < 16; ++r) pmax = fmaxf(pmax, p1[r]);
        pmax = half_swap_max(pmax);
        float mn, alpha;
        if (__all(pmax - m_reg <= THR_RAW)) { mn = m_reg; alpha = 1.f; }
        else { mn = fmaxf(m_reg, pmax); alpha = __builtin_amdgcn_exp2f((m_reg - mn) * CEXP); m_reg = mn; }
        const float mnC = -mn * CEXP;
        float ps = 0.f;
#pragma unroll
        for (int r = 0; r < 16; ++r) { p0[r] = __builtin_amdgcn_exp2f(fmaf(p0[r], CEXP, mnC)); ps += p0[r]; }
#pragma unroll
        for (int r = 0; r < 16; ++r) { p1[r] = __builtin_amdgcn_exp2f(fmaf(p1[r], CEXP, mnC)); ps += p1[r]; }
        ps = half_swap_sum(ps);
        l_reg = l_reg * alpha + ps;
        if (__any(alpha < 1.f)) { if (hi == 0) al_l[r32] = alpha; asm volatile("s_waitcnt lgkmcnt(0)" ::: "memory");
#pragma unroll
            for (int r = 0; r < 16; ++r) { const float a = al_l[crow(r, hi)];
#pragma unroll
                for (int d = 0; d < 4; ++d) o[d][r] *= a; } }
        h8 pa0, pa1, pa2, pa3; pack_p(p0, p1, pa0, pa1, pa2, pa3);
        AT_SBAR();
        pv_d0(o, vb0 + buf * SHM_V, pa0, pa1, pa2, pa3);
        if (jn < 0) break;
        asm volatile("s_waitcnt vmcnt(0)" ::: "memory");
        swrite(st, V_lds, K_lds, buf ^ 1);
        __syncthreads();
        buf ^= 1; j = jn; rest &= rest - 1;
    }
    if (hi == 0) li_l[r32] = l_reg; asm volatile("s_waitcnt lgkmcnt(0)" ::: "memory");
#pragma unroll
    for (int r = 0; r < 16; ++r) { const int orow = crow(r, hi); const float l = li_l[orow]; const float rl = l > 0.f ? 1.f / l : 0.f;
#pragma unroll
        for (int d0 = 0; d0 < 4; ++d0) outw[(size_t)orow * ostride + d0 * 32 + r32] = (_Float16)(o[d0][r] * rl); }
    __syncthreads();
}

constexpr int LDS_AP = LDS_END, LDS_BP = LDS_AP + 4 * 64 * 33 * 4, LDS_SELM = LDS_BP + 4 * 64 * 33 * 4, LDS_CS_END = LDS_SELM + 64 * 4;
__device__ __forceinline__ void cmp_slc_unit(char* lds, const _Float16* qrow, const _Float16* Kc, const _Float16* Vc, const _Float16* Ks, const _Float16* Vs, int t, int tl, int g, int qi,
                                             _Float16* outc, _Float16* outs) {
    const int tid = threadIdx.x, wid = __builtin_amdgcn_readfirstlane(tid >> 6), lane = tid & 63, r32 = lane & 31, hi = lane >> 5;
    char* V_lds = lds; char* K_lds = lds + 2 * SHM_V;
    float* AP = (float*)(lds + LDS_AP); float* BP = (float*)(lds + LDS_BP); unsigned* selm = (unsigned*)(lds + LDS_SELM);
    {
        h8 qr[8];
#pragma unroll
        for (int d0 = 0; d0 < 8; ++d0) qr[d0] = *(const h8*)(qrow + d0 * 16);
        const int vb0 = (int)(uintptr_t)V_lds + v_rd_base(lane);
        { Stage4 s0, s1; sload(s0, Kc, Vc, 256, 0); sload(s1, Kc, Vc, 256, 64);
          asm volatile("s_waitcnt vmcnt(0)" ::: "memory");
          swrite(s0, V_lds, K_lds, 0); swrite(s1, V_lds, K_lds, 1); }
        __syncthreads();
        f32x16 pA0, pA1, pB0, pB1;
        AT_SBAR(); qkt(pA0, pA1, K_lds, qr, r32, hi); qkt(pB0, pB1, K_lds + SHM_K, qr, r32, hi);
        const int khi = t >= 31 ? ((t - 31) >> 4) : -1;
#pragma unroll
        for (int r = 0; r < 16; ++r) { const int c0 = 4 * hi + (r & 3) + 8 * (r >> 2);
            pA0[r] = (c0 <= khi) ? pA0[r] : -INFINITY; pA1[r] = (c0 + 32 <= khi) ? pA1[r] : -INFINITY;
            pB0[r] = (c0 + 64 <= khi) ? pB0[r] : -INFINITY; pB1[r] = (c0 + 96 <= khi) ? pB1[r] : -INFINITY; }
        float pmax = -INFINITY;
#pragma unroll
        for (int r = 0; r < 16; ++r) pmax = fmaxf(fmaxf(pmax, pA0[r]), fmaxf(pA1[r], fmaxf(pB0[r], pB1[r])));
        pmax = half_swap_max(pmax);
        const float mC = (pmax == -INFINITY) ? 0.f : -pmax * CEXP;
        float ps = 0.f;
#pragma unroll
        for (int r = 0; r < 16; ++r) { pA0[r] = __builtin_amdgcn_exp2f(fmaf(pA0[r], CEXP, mC)); pA1[r] = __builtin_amdgcn_exp2f(fmaf(pA1[r], CEXP, mC));
            pB0[r] = __builtin_amdgcn_exp2f(fmaf(pB0[r], CEXP, mC)); pB1[r] = __builtin_amdgcn_exp2f(fmaf(pB1[r], CEXP, mC)); ps += (pA0[r] + pA1[r]) + (pB0[r] + pB1[r]); }
        ps = half_swap_sum(ps);
        const float inv = ps > 0.f ? 1.f / ps : 0.f;
#pragma unroll
        for (int r = 0; r < 16; ++r) { pA0[r] *= inv; pA1[r] *= inv; pB0[r] *= inv; pB1[r] *= inv; }
        { float* ap = AP + (g * 64 + tl) * 33; float* bp = BP + (g * 64 + tl) * 33;
          if (hi == 0) bp[0] = 0.f;
#define AT_IMP(P, JB) do { _Pragma("unroll") for (int k = 0; k < 4; ++k) { const int j = (JB) + 2 * k + hi; \
              ap[j] = 2.f * (P[4 * k] + P[4 * k + 1] + P[4 * k + 2]) + P[4 * k + 3]; if (j + 1 < 32) bp[j + 1] = P[4 * k + 3]; } } while (0)
          AT_IMP(pA0, 0); AT_IMP(pA1, 8); AT_IMP(pB0, 16); AT_IMP(pB1, 24);
#undef AT_IMP
        }
        f32x16 o[4] = {};
        h8 pa0, pa1, pa2, pa3;
        pack_p(pA0, pA1, pa0, pa1, pa2, pa3); AT_SBAR(); pv_d0(o, vb0, pa0, pa1, pa2, pa3);
        pack_p(pB0, pB1, pa0, pa1, pa2, pa3); AT_SBAR(); pv_d0(o, vb0 + SHM_V, pa0, pa1, pa2, pa3);
#pragma unroll
        for (int r = 0; r < 16; ++r) { const int orow = crow(r, hi);
#pragma unroll
            for (int d0 = 0; d0 < 4; ++d0) outc[(size_t)orow * 1024 + d0 * 32 + r32] = (_Float16)o[d0][r]; }
    }
    __syncthreads();
#pragma unroll 1
    for (int it = 0; it < 4; ++it) {
        const int tk = 8 * wid + 2 * it + hi, j = r32;
        float imp = 0.f;
#pragma unroll
        for (int gg = 0; gg < 4; ++gg) imp += AP[(gg * 64 + tk) * 33 + j] + BP[(gg * 64 + tk) * 33 + j];
        const bool forced = (j == 0) || (j == qi) || (j == qi - 1), valid = j <= qi;
        const float iv = forced ? 1e9f : (valid ? imp : -1e9f);
        int rank = 0;
        for (int i = 0; i < 32; ++i) { const float vi = __shfl(iv, i + 32 * hi); rank += (vi > iv || (vi == iv && i < j)) ? 1 : 0; }
        const unsigned long long bal = __ballot(rank < 16 && valid);
        if (r32 == 0) selm[tk] = (unsigned)(bal >> (32 * hi));
    }
    __syncthreads();
    unsigned tm = selm[lane];
#pragma unroll
    for (int o = 32; o > 0; o >>= 1) tm |= __shfl_xor(tm, o);
    const int tz2 = hidden_tid();
    const unsigned mysel = selm[((tz2 >> 6) & 1) * 32 + (tz2 & 31)];
    attn_unit(lds, qrow, Ks, Vs, 128, tm, 0, t, mysel, outs, 1024);
}
}

struct CUnit { const float* W; int ldw; int nvalid; _Float16* Wt; int k0; int n0; };
__device__ __forceinline__ CUnit conv_desc(int u, const float* win, const float* w1k, const float* w1v, const float* wmkv, _Float16* wtin, _Float16* wt1, _Float16* wtmkv) {
    CUnit d;
    if (u < 480) { d.W = win; d.ldw = INW; d.nvalid = INW; d.Wt = wtin; d.k0 = (u / 15) * 64; d.n0 = (u % 15) * 256; }
    else if (u < 608) { const int v = u - 480, kv = v >> 6, part = (v >> 5) & 1, kt = v & 31;
        d.W = (kv ? w1v : w1k) + (size_t)part * 2048 * 256; d.ldw = 256; d.nvalid = 256; d.Wt = wt1 + ((size_t)kv * 512 + part * 256) * 2048; d.k0 = kt * 64; d.n0 = 0; }
    else { const int v = u - 608; d.W = wmkv; d.ldw = 1024; d.nvalid = 1024; d.Wt = wtmkv; d.k0 = (v >> 2) * 64; d.n0 = (v & 3) * 256; }
    return d;
}
__device__ __forceinline__ void conv_all(float* lds, const float* win, const float* w1k, const float* w1v, const float* wmkv, _Float16* wtin, _Float16* wt1, _Float16* wtmkv, int bid, int nb) {
    constexpr int NU = 480 + 128 + 128;
    const int tid = threadIdx.x;
    int u = bid; if (u >= NU) return;
    CUnit d = conv_desc(u, win, w1k, w1v, wmkv, wtin, wt1, wtmkv);
    float4 v[8];
#define CL(D) do { _Pragma("unroll") for (int i = 0; i < 8; ++i) { const int idx = tid + 512 * i, r = idx >> 6, c4 = (idx & 63) * 4; \
        v[i] = ((D).n0 + c4 < (D).nvalid) ? *(const float4*)((D).W + (size_t)((D).k0 + r) * (D).ldw + (D).n0 + c4) : make_float4(0.f, 0.f, 0.f, 0.f); } } while (0)
    CL(d);
    for (;;) {
#pragma unroll
        for (int i = 0; i < 8; ++i) { const int idx = tid + 512 * i, r = idx >> 6, c4 = (idx & 63) * 4; float* dd = lds + r * 257 + c4; dd[0] = v[i].x; dd[1] = v[i].y; dd[2] = v[i].z; dd[3] = v[i].w; }
        __syncthreads();
        const int un = u + nb; const bool has = un < NU;
        CUnit dn = d; if (has) { dn = conv_desc(un, win, w1k, w1v, wmkv, wtin, wt1, wtmkv); CL(dn); }
#pragma unroll
        for (int j = 0; j < 4; ++j) { const int id = tid + 512 * j, n = id >> 3, k8 = (id & 7) * 8; h8 o;
#pragma unroll
            for (int q = 0; q < 8; ++q) o[q] = (_Float16)lds[(k8 + q) * 257 + n];
            *(h8*)(d.Wt + (size_t)(d.n0 + n) * 2048 + d.k0 + k8) = o; }
        __syncthreads();
        if (!has) break;
        u = un; d = dn;
    }
#undef CL
}

__device__ __forceinline__ unsigned pack4_i8(float a, float b, float c, float d) {
    const int ia = __float2int_rn(a), ib = __float2int_rn(b), ic = __float2int_rn(c), id = __float2int_rn(d);
    return (unsigned)(ia & 255) | ((unsigned)(ib & 255) << 8) | ((unsigned)(ic & 255) << 16) | ((unsigned)(id & 255) << 24);
}
constexpr int QP_LD2 = 1026;
struct QUnit { const float* W; int ldw; int n0; signed char* Q; float* sc; };
__device__ __forceinline__ QUnit quant_desc(int u, const float* wgu, const float* wdn, signed char* q8gu, signed char* q8dn, float* sgu, float* sdn, const float* wout, signed char* q8out, float* sout) {
    QUnit d;
    if (u >= NE * 192) { const int pn = u - NE * 192; d.W = wout; d.ldw = 2048; d.n0 = pn * 32; d.Q = q8out; d.sc = sout; }
    else if (u < NE * 128) { const int e = u >> 7, pn = u & 127; d.W = wgu + (size_t)e * 2048 * 4096; d.ldw = 4096; d.n0 = pn * 32; d.Q = q8gu + (size_t)e * 4096 * 2048; d.sc = sgu + (size_t)e * 4096; }
    else { const int v = u - NE * 128, e = v >> 6, pn = v & 63; d.W = wdn + (size_t)e * 2048 * 2048; d.ldw = 2048; d.n0 = pn * 32; d.Q = q8dn + (size_t)e * 2048 * 2048; d.sc = sdn + (size_t)e * 2048; }
    return d;
}
__device__ __forceinline__ unsigned pk2h(float a, float b) { auto v = __builtin_amdgcn_cvt_pkrtz(a, b); return *reinterpret_cast<unsigned*>(&v); }
__device__ __forceinline__ void quant_all(char* smem, const float* wgu, const float* wdn, signed char* q8gu, signed char* q8dn, float* sgu, float* sdn, const float* wout, signed char* q8out, float* sout, int bid, int nb) {
    constexpr int NU = NE * 128 + NE * 64 + 64;
    unsigned* cmaxb = (unsigned*)smem;
    const int tid = threadIdx.x, c4 = (tid & 7) * 4, rg = tid >> 3;
    if (tid < 64) cmaxb[tid] = 0u;
    __syncthreads();
    int u = bid; if (u >= NU) return;
    QUnit d = quant_desc(u, wgu, wdn, q8gu, q8dn, sgu, sdn, wout, q8out, sout);
    float4 va[16], vb[16], vc[16];
#define QL(dst, D, half) do { const float* p0 = (D).W + (size_t)((half) * 1024 + rg * 16) * (D).ldw + (D).n0 + c4; _Pragma("unroll") for (int j = 0; j < 16; ++j) dst[j] = *(const float4*)(p0 + (size_t)j * (D).ldw); } while (0)
#define QM(src) do { _Pragma("unroll") for (int j = 0; j < 16; ++j) { m0 = fmaxf(m0, fabsf(src[j].x)); m1 = fmaxf(m1, fabsf(src[j].y)); m2 = fmaxf(m2, fabsf(src[j].z)); m3 = fmaxf(m3, fabsf(src[j].w)); } } while (0)
#define QS(src, half, comp, ci, inv) do { uint4 o; \
        o.x = pack4_i8(src[0].comp * inv, src[1].comp * inv, src[2].comp * inv, src[3].comp * inv); o.y = pack4_i8(src[4].comp * inv, src[5].comp * inv, src[6].comp * inv, src[7].comp * inv); \
        o.z = pack4_i8(src[8].comp * inv, src[9].comp * inv, src[10].comp * inv, src[11].comp * inv); o.w = pack4_i8(src[12].comp * inv, src[13].comp * inv, src[14].comp * inv, src[15].comp * inv); \
        *(uint4*)(d.Q + (size_t)(d.n0 + c4 + (ci)) * 2048 + (half) * 1024 + rg * 16) = o; } while (0)
    QL(va, d, 0);
    int par = 0;
    for (;;) {
        unsigned* cmax = cmaxb + par * 32;
        float m0 = 0.f, m1 = 0.f, m2 = 0.f, m3 = 0.f;
        QL(vb, d, 1);
        QM(va); QM(vb);
        atomicMax(&cmax[c4 + 0], __float_as_uint(m0)); atomicMax(&cmax[c4 + 1], __float_as_uint(m1)); atomicMax(&cmax[c4 + 2], __float_as_uint(m2)); atomicMax(&cmax[c4 + 3], __float_as_uint(m3));
        __syncthreads();
        const int un = u + nb; const bool has = un < NU;
        QUnit dn = d; if (has) { dn = quant_desc(un, wgu, wdn, q8gu, q8dn, sgu, sdn, wout, q8out, sout); QL(vc, dn, 0); }
        if (tid < 32) cmaxb[(par ^ 1) * 32 + tid] = 0u;
        const float x0 = __uint_as_float(cmax[c4 + 0]), x1 = __uint_as_float(cmax[c4 + 1]), x2 = __uint_as_float(cmax[c4 + 2]), x3 = __uint_as_float(cmax[c4 + 3]);
        const float i0 = x0 > 0.f ? 127.f / x0 : 0.f, i1 = x1 > 0.f ? 127.f / x1 : 0.f, i2 = x2 > 0.f ? 127.f / x2 : 0.f, i3 = x3 > 0.f ? 127.f / x3 : 0.f;
        QS(va, 0, x, 0, i0); QS(va, 0, y, 1, i1); QS(va, 0, z, 2, i2); QS(va, 0, w, 3, i3);
        QS(vb, 1, x, 0, i0); QS(vb, 1, y, 1, i1); QS(vb, 1, z, 2, i2); QS(vb, 1, w, 3, i3);
        if (tid < 32) { const float mx = __uint_as_float(cmax[tid]); d.sc[d.n0 + tid] = mx > 0.f ? mx / 127.f : 1.f; }
        if (!has) break;
#pragma unroll
        for (int j = 0; j < 16; ++j) va[j] = vc[j];
        u = un; d = dn; par ^= 1;
        __syncthreads();
    }
    __syncthreads();
#undef QL
#undef QM
#undef QS
}

__global__ void __launch_bounds__(512, 2) fwd(Params p) {
    extern __shared__ __attribute__((aligned(16))) char smem[];
    const int tid = threadIdx.x, wv = __builtin_amdgcn_readfirstlane(tid >> 6);
#define LANE_NOW ({ int _t = threadIdx.x; asm volatile("" : "+v"(_t)); _t & 63; })
    const int bid = blockIdx.x, nb = gridDim.x;
    const int gw = bid * 8 + wv, nw = nb * 8;
    const int lo = (int)(p.lo_hi & 0xffffffffll), hi = (int)(p.lo_hi >> 32);
    unsigned char* ws = p.ws;
    unsigned* ctl = (unsigned*)(ws + WS_CTL);
    int* cnt = (int*)(ws + CTL_CNT);
    float* proj = (float*)(ws + WS_PROJ);
    float* kvmem = (float*)(ws + WS_KVMEM);
    float* bias1 = (float*)(ws + WS_BIAS1);
    float* hid = (float*)(ws + WS_HID);
    float* kc = (float*)(ws + WS_KC);
    float* vc = (float*)(ws + WS_VC);
    float* pooled = (float*)(ws + WS_POOLED);
    _Float16* opool = (_Float16*)(ws + WS_OPOOL);
    _Float16* owin = (_Float16*)(ws + WS_OWIN);
    _Float16* ocmp = (_Float16*)(ws + WS_OCMP);
    _Float16* oslc = (_Float16*)(ws + WS_OSLC);
    unsigned* sel = (unsigned*)(ws + WS_SEL);
    _Float16* omem = (_Float16*)(ws + WS_OMEM);
    _Float16* cat16 = (_Float16*)(ws + WS_CAT16);
    _Float16* hpre16 = (_Float16*)(ws + WS_HPRE);
    float* hbuf = (float*)(ws + WS_H);
    float* gate = (float*)(ws + WS_GATE);
    int* list = (int*)(ws + WS_LIST);
    _Float16* act16 = (_Float16*)(ws + WS_ACT16);
    _Float16* y16 = (_Float16*)(ws + WS_Y16);
    _Float16* h16 = (_Float16*)(ws + WS_H16);
    _Float16* x16 = (_Float16*)(ws + WS_X16);
    _Float16* wtin = (_Float16*)(ws + WS_WTIN);
    _Float16* wtout = (_Float16*)(ws + WS_WTOUT);
    _Float16* wtgu = (_Float16*)(ws + WS_WTGU);
    _Float16* wtdn = (_Float16*)(ws + WS_WTDN);
    LAS unsigned char* lds = (LAS unsigned char*)smem;
    _Float16* proj16 = (_Float16*)(ws + WS_PROJ16);
    _Float16* kvmem16 = (_Float16*)(ws + WS_KVMEM16);
    _Float16* wt1 = (_Float16*)(ws + WS_WT1);
    float* uv = (float*)(ws + WS_UV);
    _Float16* kc16 = (_Float16*)(ws + WS_KC16);
    _Float16* vc16 = (_Float16*)(ws + WS_VC16);
    _Float16* wr16 = (_Float16*)(ws + WS_WR16);
    _Float16* mem16 = (_Float16*)(ws + WS_MEM16);
    _Float16* wtmkv = (_Float16*)(ws + WS_WTMKV);
    _Float16* kv16 = (_Float16*)(ws + WS_KV16);
    signed char* q8out = (signed char*)(ws + WS_Q8OUT); float* sout = (float*)(ws + WS_SOUT); signed char* cat8 = (signed char*)(ws + WS_CAT8); float* scat = (float*)(ws + WS_SCAT);
    signed char* q8gu = (signed char*)(ws + WS_Q8GU); signed char* q8dn = (signed char*)(ws + WS_Q8DN);
    float* sgu = (float*)(ws + WS_SGU); float* sdn = (float*)(ws + WS_SDN);
    signed char* h8q = (signed char*)(ws + WS_H8); float* sah = (float*)(ws + WS_SAH);
    signed char* act8 = (signed char*)(ws + WS_ACT8); float* sact = (float*)(ws + WS_SACT);
    const int vcu = (nb % 8 == 0) ? (bid % 8) * (nb / 8) + bid / 8 : bid;

    volatile LAS unsigned* xbw = (volatile LAS unsigned*)(smem + LDS_BYTES - 16);
    if (tid == 0) { xbw[0] = 0u; xbw[1] = 0u; xbw[2] = 0u; xbw[3] = 0u; }
    __syncthreads();
    XcdBarrier bar; bar.bar = ctl; bar.x = 0; bar.st = xbw;
    const bool multi = (hi - lo) > 1;
    if (multi) bar = xcd_barrier_post(ctl, xbw);
#define IN(k) (lo <= (k) && (k) < hi)
#define SEAM(k) do { if (IN(k) && IN((k) + 1)) xcd_barrier(bar); } while (0)
    float* sw = (float*)smem + wv * WLDS_FLOATS;
    int* segw = (int*)(sw + 4096 + 512);

    if (IN(0)) {
        const int lane = LANE_NOW; (void)lane;
        if (wv == 0 && (bid & 1) == 0 && (bid >> 1) < 128) {
            const int task = bid >> 1, kv = task >> 6, jg = (task >> 4) & 3, kc = task & 15;
            const float* pos = p.in[kv ? I_POSV : I_POSK] + kc * 256; const float* w1 = p.in[kv ? I_W1V : I_W1K] + (size_t)kc * 256 * 256 + jg * 64 + lane;
            float s0 = 0.f, s1 = 0.f, s2 = 0.f, s3 = 0.f;
            for (int k = 0; k < 256; k += 4) { s0 += pos[k] * w1[(size_t)k * 256]; s1 += pos[k + 1] * w1[(size_t)(k + 1) * 256]; s2 += pos[k + 2] * w1[(size_t)(k + 2) * 256]; s3 += pos[k + 3] * w1[(size_t)(k + 3) * 256]; }
            bias1[(kv * 16 + kc) * 256 + jg * 64 + lane] = (s0 + s1) + (s2 + s3);
        }
        for (int i = bid * 512 + tid; i < 32 * 2048; i += nb * 512) { const int e = i >> 11, d = i & 2047; wr16[i] = (_Float16)p.in[I_WR][(size_t)d * 32 + e]; }
        for (size_t i = (size_t)bid * 512 + tid; i < (size_t)T_ * 2048 / 4; i += (size_t)nb * 512) {
            const float4 v = ((const float4*)p.in[I_X])[i]; ((h4*)x16)[i] = (h4){(_Float16)v.x, (_Float16)v.y, (_Float16)v.z, (_Float16)v.w};
        }
        {
            quant_all(smem, p.in[I_WGU], p.in[I_WDN], q8gu, q8dn, sgu, sdn, p.in[I_WOUT], q8out, sout, bid, nb);
            __syncthreads();
            conv_all((float*)smem, p.in[I_WIN], p.in[I_W1K], p.in[I_W1V], p.in[I_WMEMKV], wtin, wt1, wtmkv, bid, nb);
            __syncthreads();
        }
        for (size_t i = (size_t)bid * 512 + tid; i < (size_t)2048 * 2048 / 4; i += (size_t)nb * 512) {
            const float4 v = ((const float4*)p.in[I_MEM])[i]; ((h4*)mem16)[i] = (h4){(_Float16)v.x, (_Float16)v.y, (_Float16)v.z, (_Float16)v.w};
        }
    }
    SEAM(0);
    if (IN(1)) {
        const int lane = LANE_NOW; (void)lane;
        g8::ProbIn P{x16, proj16, nb, bid};
        g8::gemm_phase(lds, P);
    }
    SEAM(1);
    if (IN(2)) {
        const int lane = LANE_NOW; (void)lane;
        { g8::ProbCmp P{kv16, wt1, uv, nb, bid}; g8::gemm_phase(lds, P); __syncthreads(); }
        for (int i = bid * 512 + tid; i < T_ * 64; i += nb * 512) {
            const int chn = i & 63, row = i >> 6, t = row & (S_ - 1), g = chn >> 4;
            const int win = 2 << g, n = min(win, t + 1);
            const _Float16* src = proj16 + (size_t)row * INW + C_UP + chn * 8;
            float a[8];
            const h8 cur = *(const h8*)src;
#pragma unroll
            for (int q = 0; q < 8; ++q) a[q] = (float)cur[q];
            for (int k = 1; k < n; ++k) { const h8 v = *(const h8*)(src - (size_t)k * INW);
#pragma unroll
                for (int q = 0; q < 8; ++q) a[q] += (float)v[q]; }
            const float rn = 1.f / (float)n;
            float4 o0, o1;
            o0.x = a[0] * rn - (float)cur[0]; o0.y = a[1] * rn - (float)cur[1]; o0.z = a[2] * rn - (float)cur[2]; o0.w = a[3] * rn - (float)cur[3];
            o1.x = a[4] * rn - (float)cur[4]; o1.y = a[5] * rn - (float)cur[5]; o1.z = a[6] * rn - (float)cur[6]; o1.w = a[7] * rn - (float)cur[7];
            *(float4*)(pooled + (size_t)row * 512 + chn * 8) = o0; *(float4*)(pooled + (size_t)row * 512 + chn * 8 + 4) = o1;
        }
        {
            const int r32 = lane & 31, hi = lane >> 5, g = wv >> 1, half = wv & 1;
            for (int uu = vcu; uu < 512; uu += nb) {
                const int v = uu & 255, bk = v >> 4, qi = (uu >> 8) ? 31 - (v & 15) : (v & 15), b = bk >> 1, kvh = bk & 1;
                const int t = qi * 64 + half * 32 + r32;
                const int lo_t = max(0, qi - 8);
                const unsigned tmask = (unsigned)(((1ull << (qi + 1)) - 1ull) & ~((1ull << lo_t) - 1ull));
                at8::attn_unit(smem, proj16 + (size_t)(b * S_ + t) * INW + C_Q + (kvh * 4 + g) * 128 + hi * 8,
                               kv16 + ((size_t)(4 * B_ + b) * 2 + kvh) * KVSEG, kv16 + ((size_t)(5 * B_ + b) * 2 + kvh) * KVSEG, 128, tmask, 512, t, 0xffffffffu,
                               owin + (size_t)(b * S_ + qi * 64 + half * 32) * 1024 + (kvh * 4 + g) * 128, 1024);
            }
            for (int u = vcu; u < 256; u += nb) {
                const int b = u >> 5, h = (u >> 3) & 3, qt = u & 7;
                const int t = qt * 256 + wv * 32 + r32;
                at8::attn_unit(smem, proj16 + (size_t)(b * S_ + t) * INW + C_QM + h * 128 + hi * 8,
                               kvmem16 + (size_t)b * 256 * 1024 + h * 128, kvmem16 + (size_t)b * 256 * 1024 + 512 + h * 128, 1024, 0xFu, 0, 255, 0xffffffffu,
                               omem + (size_t)(b * S_ + qt * 256 + wv * 32) * 512 + h * 128, 512);
            }
        }
    }
    SEAM(2);
    if (IN(3)) {
        const int lane = LANE_NOW; (void)lane;
        {   float* hs = (float*)smem;
            float* bsum = (float*)smem + 8 * 256;
            { const int kv = tid >> 8, n = tid & 255; float a = 0.f;
#pragma unroll
              for (int kc = 0; kc < 16; ++kc) a += bias1[(kv * 16 + kc) * 256 + n];
              bsum[tid] = a; }
            __syncthreads();
            for (int u = bid; u < 508; u += nb) {
                const int kv = u / 254, ub = u % 254;
                const float* w2 = p.in[kv ? I_W2V : I_W2K]; _Float16* dst = kv ? vc16 : kc16;
                __syncthreads();
#pragma unroll
                for (int q = 0; q < 4; ++q) { const int e = tid + 512 * q, i = e >> 8, n = e & 255;
                    const int idx = ub * 8 + i, b = idx / 254, rem = idx % 254, c = rem >> 1, kvh = rem & 1;
                    const int row = (b * 128 + c) * 2 + kvh;
                    float a = bsum[kv * 256 + n];
#pragma unroll
                    for (int sp = 0; sp < 4; ++sp) { const float* base = uv + ((size_t)(kv * 4 + sp) * 2048) * 512; a += base[(size_t)row * 512 + n] + base[(size_t)(row + 2) * 512 + 256 + n]; }
                    hs[i * 256 + n] = gelu_tanh(a); }
                __syncthreads();
#pragma unroll
                for (int q = 0; q < 2; ++q) { const int e = tid + 512 * q, i = e >> 7, d = e & 127;
                    const int idx = ub * 8 + i, b = idx / 254, rem = idx % 254, c = rem >> 1, kvh = rem & 1;
                    float a = 0.f;
                    for (int n = 0; n < 256; ++n) a += hs[i * 256 + n] * w2[n * 128 + d];
                    dst[(size_t)((b * 128 + c) * 2 + kvh) * 128 + d] = (_Float16)a; }
            }
            __syncthreads();
            for (int i = bid * 512 + tid; i < 2 * B_ * 256; i += nb * 512) { const int kv = i / (B_ * 256), r = i % (B_ * 256), b = r >> 8, x = r & 255;
                (kv ? vc16 : kc16)[(size_t)(b * 128 + 127) * 256 + x] = (_Float16)0.f; }
        }
        for (int u = bid; u < 128 * 4; u += nb) { const int g = u >> 7, mt = u & 127;
            ARowPlain af{pooled + g * 128, 512, mt * 128, T_}; EpiPool ef{opool, p.in[I_POOLS], mt * 128, g};
            gemm_tile(smem, 128, af, p.in[I_POOLW] + (size_t)g * 128 * 128, 128, 0, 128, false, ef);
        }
    }
    SEAM(3);
    if (IN(4)) {
        const int lane = LANE_NOW; (void)lane;
        const int r32 = lane & 31, hi = lane >> 5, g = wv >> 1, half = wv & 1;
        for (int uu = vcu; uu < 512; uu += nb) {
            const int v = uu & 255, bk = v >> 4, qi = (uu >> 8) ? 31 - (v & 15) : (v & 15), b = bk >> 1, kvh = bk & 1;
            const int tl = half * 32 + r32, t = qi * 64 + tl;
            at8::cmp_slc_unit(smem, proj16 + (size_t)(b * S_ + t) * INW + C_Q + (kvh * 4 + g) * 128 + hi * 8,
                              kc16 + (size_t)(b * 128 * 2 + kvh) * 128, vc16 + (size_t)(b * 128 * 2 + kvh) * 128,
                              kv16 + ((size_t)(2 * B_ + b) * 2 + kvh) * KVSEG, kv16 + ((size_t)(3 * B_ + b) * 2 + kvh) * KVSEG, t, tl, g, qi,
                              ocmp + (size_t)(b * S_ + qi * 64 + half * 32) * 1024 + (kvh * 4 + g) * 128, oslc + (size_t)(b * S_ + qi * 64 + half * 32) * 1024 + (kvh * 4 + g) * 128);
        }
    }
    SEAM(4);
    if (IN(5)) {
        const int lane = LANE_NOW;
        for (int row = gw; row < T_; row += nw) {
            const _Float16* pr = proj16 + (size_t)row * INW + C_G;
            float v[32]; float ss = 0.f;
#pragma unroll
            for (int c = 0; c < 2; ++c) { const int col = (lane + 64 * c) * 8, h = col >> 7; const size_t o = (size_t)row * 1024 + col;
                const float g0 = sigmoidf_((float)pr[h * 3]), g1 = sigmoidf_((float)pr[h * 3 + 1]), g2 = sigmoidf_((float)pr[h * 3 + 2]);
                const h8 a = *(const h8*)(ocmp + o), b2 = *(const h8*)(oslc + o), c2 = *(const h8*)(owin + o);
#pragma unroll
                for (int q = 0; q < 8; ++q) { const float x = g0 * (float)a[q] + g1 * (float)b2[q] + g2 * (float)c2[q]; v[c * 8 + q] = x; ss += x * x; } }
            ss = wave_sum(ss); float r = rsqrtf(ss / 1024.f + LN_EPS);
#pragma unroll
            for (int c = 0; c < 2; ++c) { const int col = (lane + 64 * c) * 8; const float4 ga = *(const float4*)(p.in[I_GNNSA] + col), gb = *(const float4*)(p.in[I_GNNSA] + col + 4);
                v[c * 8 + 0] *= r * ga.x; v[c * 8 + 1] *= r * ga.y; v[c * 8 + 2] *= r * ga.z; v[c * 8 + 3] *= r * ga.w; v[c * 8 + 4] *= r * gb.x; v[c * 8 + 5] *= r * gb.y; v[c * 8 + 6] *= r * gb.z; v[c * 8 + 7] *= r * gb.w; }
            { const h8 a = *(const h8*)(opool + (size_t)row * 512 + lane * 8); ss = 0.f;
#pragma unroll
              for (int q = 0; q < 8; ++q) { v[16 + q] = (float)a[q]; ss += v[16 + q] * v[16 + q]; }
              ss = wave_sum(ss); r = rsqrtf(ss / 512.f + LN_EPS);
              const float4 ga = *(const float4*)(p.in[I_GNPOOL] + lane * 8), gb = *(const float4*)(p.in[I_GNPOOL] + lane * 8 + 4);
              v[16] *= r * ga.x; v[17] *= r * ga.y; v[18] *= r * ga.z; v[19] *= r * ga.w; v[20] *= r * gb.x; v[21] *= r * gb.y; v[22] *= r * gb.z; v[23] *= r * gb.w; }
            { const h8 a = *(const h8*)(omem + (size_t)row * 512 + lane * 8); ss = 0.f;
#pragma unroll
              for (int q = 0; q < 8; ++q) { v[24 + q] = (float)a[q]; ss += v[24 + q] * v[24 + q]; }
              ss = wave_sum(ss); r = rsqrtf(ss / 512.f + LN_EPS);
              const float4 ga = *(const float4*)(p.in[I_GNMEM] + lane * 8), gb = *(const float4*)(p.in[I_GNMEM] + lane * 8 + 4);
              v[24] *= r * ga.x; v[25] *= r * ga.y; v[26] *= r * ga.z; v[27] *= r * ga.w; v[28] *= r * gb.x; v[29] *= r * gb.y; v[30] *= r * gb.z; v[31] *= r * gb.w; }
            float amax = 0.f;
#pragma unroll
            for (int k = 0; k < 32; ++k) amax = fmaxf(amax, fabsf(v[k]));
            amax = wave_max(amax);
            const float qinv = amax > 0.f ? 127.f / amax : 0.f;
            if (lane == 0) scat[row] = amax > 0.f ? amax / 127.f : 1.f;
#pragma unroll
            for (int c = 0; c < 4; ++c) { const int col = c < 2 ? (lane + 64 * c) * 8 : (c == 2 ? 1024 + lane * 8 : 1536 + lane * 8);
                uint2 q; q.x = pack4_i8(v[c * 8 + 0] * qinv, v[c * 8 + 1] * qinv, v[c * 8 + 2] * qinv, v[c * 8 + 3] * qinv); q.y = pack4_i8(v[c * 8 + 4] * qinv, v[c * 8 + 5] * qinv, v[c * 8 + 6] * qinv, v[c * 8 + 7] * qinv);
                *(uint2*)(cat8 + (size_t)row * 2048 + col) = q; }
        }
    }
    SEAM(5);
    if (IN(6)) {
        const int lane = LANE_NOW; (void)lane;
        g8::ProbOut P{cat8, q8out, hpre16, x16, scat, sout, nb, bid};
        g8::gemm_phase(lds, P);
    }
    SEAM(6);
    if (IN(7)) {
        const int lane = LANE_NOW; (void)lane;
        float* lg = (float*)smem;
        const int r32 = lane & 31, hi = lane >> 5, fr = lane & 15, fq = lane >> 4;
        for (int u = bid; u < T_ / 64; u += nb) {
            const int base = u * 64;
#pragma unroll 2
            for (int i = 0; i < 8; ++i) {
                const int row = base + wv * 8 + i;
                float v[32]; float s = 0.f;
#pragma unroll
                for (int c = 0; c < 4; ++c) { const int col = (lane + 64 * c) * 8;
                    const h8 a0 = *(const h8*)(hpre16 + (size_t)row * 2048 + col);
#pragma unroll
                    for (int q = 0; q < 8; ++q) { v[c * 8 + q] = (float)a0[q]; s += v[c * 8 + q]; } }
                const float mu = wave_sum(s) / 2048.f; float q2 = 0.f;
#pragma unroll
                for (int k = 0; k < 32; ++k) { const float d = v[k] - mu; q2 += d * d; }
                const float rs = rsqrtf(wave_sum(q2) / 2048.f + LN_EPS);
                float amax = 0.f;
#pragma unroll
                for (int c = 0; c < 4; ++c) { const int col = (lane + 64 * c) * 8;
                    const float4 g0 = *(const float4*)(p.in[I_LN1G] + col), g1 = *(const float4*)(p.in[I_LN1G] + col + 4), b0 = *(const float4*)(p.in[I_LN1B] + col), b1 = *(const float4*)(p.in[I_LN1B] + col + 4);
                    float4 o0, o1;
                    o0.x = (v[c * 8 + 0] - mu) * rs * g0.x + b0.x; o0.y = (v[c * 8 + 1] - mu) * rs * g0.y + b0.y; o0.z = (v[c * 8 + 2] - mu) * rs * g0.z + b0.z; o0.w = (v[c * 8 + 3] - mu) * rs * g0.w + b0.w;
                    o1.x = (v[c * 8 + 4] - mu) * rs * g1.x + b1.x; o1.y = (v[c * 8 + 5] - mu) * rs * g1.y + b1.y; o1.z = (v[c * 8 + 6] - mu) * rs * g1.z + b1.z; o1.w = (v[c * 8 + 7] - mu) * rs * g1.w + b1.w;
                    h8 oh; oh[0] = (_Float16)o0.x; oh[1] = (_Float16)o0.y; oh[2] = (_Float16)o0.z; oh[3] = (_Float16)o0.w; oh[4] = (_Float16)o1.x; oh[5] = (_Float16)o1.y; oh[6] = (_Float16)o1.z; oh[7] = (_Float16)o1.w;
                    *(h8*)(h16 + (size_t)row * 2048 + col) = oh;
                    v[c * 8 + 0] = o0.x; v[c * 8 + 1] = o0.y; v[c * 8 + 2] = o0.z; v[c * 8 + 3] = o0.w; v[c * 8 + 4] = o1.x; v[c * 8 + 5] = o1.y; v[c * 8 + 6] = o1.z; v[c * 8 + 7] = o1.w;
                    amax = fmaxf(amax, fmaxf(fmaxf(fmaxf(fabsf(o0.x), fabsf(o0.y)), fmaxf(fabsf(o0.z), fabsf(o0.w))), fmaxf(fmaxf(fabsf(o1.x), fabsf(o1.y)), fmaxf(fabsf(o1.z), fabsf(o1.w))))); }
                amax = wave_max(amax);
                const float qinv = amax > 0.f ? 127.f / amax : 0.f;
                if (lane == 0) sah[row] = amax > 0.f ? amax / 127.f : 1.f;
#pragma unroll
                for (int c = 0; c < 4; ++c) { const int col = (lane + 64 * c) * 8;
                    uint2 q; q.x = pack4_i8(v[c * 8 + 0] * qinv, v[c * 8 + 1] * qinv, v[c * 8 + 2] * qinv, v[c * 8 + 3] * qinv); q.y = pack4_i8(v[c * 8 + 4] * qinv, v[c * 8 + 5] * qinv, v[c * 8 + 6] * qinv, v[c * 8 + 7] * qinv);
                    *(uint2*)(h8q + (size_t)row * 2048 + col) = q; }
            }
            asm volatile("s_waitcnt vmcnt(0)" ::: "memory");
            __syncthreads();
            {
                const int tok0 = base + 16 * (wv >> 1), e0 = 16 * (wv & 1);
                const _Float16* ap = h16 + (size_t)(tok0 + fr) * 2048 + fq * 8; const _Float16* bp = wr16 + (size_t)(e0 + fr) * 2048 + fq * 8;
                f4 acc = (f4){0.f, 0.f, 0.f, 0.f};
#pragma unroll 8
                for (int sI = 0; sI < 64; ++sI) { const h8 a = *(const h8*)(ap + sI * 32), bb = *(const h8*)(bp + sI * 32); acc = __builtin_amdgcn_mfma_f32_16x16x32_f16(a, bb, acc, 0, 0, 0); }
                const float br = p.in[I_BR][e0 + fr];
#pragma unroll
                for (int j = 0; j < 4; ++j) lg[(16 * (wv >> 1) + 4 * fq + j) * 33 + e0 + fr] = acc[j] + br;
            }
            __syncthreads();
#pragma unroll 1
            for (int it = 0; it < 4; ++it) {
                const int tk = 8 * wv + 2 * it + hi;
                const float iv = lg[tk * 33 + r32];
                int rank = 0;
                for (int i = 0; i < 32; ++i) { const float vi = __shfl(iv, i + 32 * hi); rank += (vi > iv || (vi == iv && i < r32)) ? 1 : 0; }
                float tv[4]; int te[4];
#pragma unroll
                for (int r = 0; r < 4; ++r) { const unsigned long long bm = __ballot(rank == r); const unsigned hm = (unsigned)(bm >> (32 * hi)); const int src = __ffs(hm) - 1; te[r] = src; tv[r] = __shfl(iv, src + 32 * hi); }
                const float e0v = 1.f, e1v = expf(tv[1] - tv[0]), e2v = expf(tv[2] - tv[0]), e3v = expf(tv[3] - tv[0]); const float inv = 1.f / (e0v + e1v + e2v + e3v);
                if (r32 < 4) { const int e = r32 == 0 ? te[0] : r32 == 1 ? te[1] : r32 == 2 ? te[2] : te[3]; const float g = (r32 == 0 ? e0v : r32 == 1 ? e1v : r32 == 2 ? e2v : e3v) * inv;
                    const int a = (base + tk) * 4 + r32; const int pos = atomicAdd(&cnt[e], 1); list[(size_t)e * T_ + pos] = a; gate[a] = g; }
            }
            __syncthreads();
        }
    }
    SEAM(7);
    LAS int* mtab = (LAS int*)(smem + g8::STAGE_BYTES);
    if (IN(8)) {
        const int lane = LANE_NOW; (void)lane;
        if (tid == 0) { int ub = 0, rs = 0;
            for (int e = 0; e < NE; ++e) { const int c = (int)__hip_atomic_load((unsigned*)&cnt[e], __ATOMIC_RELAXED, __HIP_MEMORY_SCOPE_AGENT); mtab[e] = c; mtab[32 + e] = ub; mtab[65 + e] = rs; ub += ((c + 255) >> 8) * 16; rs += c; }
            mtab[64] = ub; mtab[97] = rs; mtab[98] = ub; }
        __syncthreads();
        g8::ProbGu P{h8q, q8gu, act16, p.in[I_BGU], list, sah, sgu, g8::MoeTab{mtab, 16}, nb, vcu};
        g8::gemm_phase(lds, P);
        __syncthreads();
    }
    SEAM(8);
    if (IN(9)) {
        const int lane = LANE_NOW;
        for (int row = gw; row < NA; row += nw) {
            float v[32]; float amax = 0.f;
#pragma unroll
            for (int c = 0; c < 4; ++c) { const h8 a = *(const h8*)(act16 + (size_t)row * 2048 + (lane + 64 * c) * 8);
#pragma unroll
                for (int q = 0; q < 8; ++q) { v[c * 8 + q] = (float)a[q]; amax = fmaxf(amax, fabsf(v[c * 8 + q])); } }
            amax = wave_max(amax);
            const float qinv = amax > 0.f ? 127.f / amax : 0.f;
            if (lane == 0) sact[row] = amax > 0.f ? amax / 127.f : 1.f;
#pragma unroll
            for (int c = 0; c < 4; ++c) { uint2 q; q.x = pack4_i8(v[c * 8 + 0] * qinv, v[c * 8 + 1] * qinv, v[c * 8 + 2] * qinv, v[c * 8 + 3] * qinv); q.y = pack4_i8(v[c * 8 + 4] * qinv, v[c * 8 + 5] * qinv, v[c * 8 + 6] * qinv, v[c * 8 + 7] * qinv);
                *(uint2*)(act8 + (size_t)row * 2048 + (lane + 64 * c) * 8) = q; }
        }
    }
    SEAM(9);
    if (IN(10)) {
        const int lane = LANE_NOW; (void)lane;
        if (tid == 0) { int ub = 0, rs = 0;
            for (int e = 0; e < NE; ++e) { const int c = (int)__hip_atomic_load((unsigned*)&cnt[e], __ATOMIC_RELAXED, __HIP_MEMORY_SCOPE_AGENT); mtab[e] = c; mtab[32 + e] = ub; mtab[65 + e] = rs; ub += ((c + 255) >> 8) * 8; rs += c; }
            mtab[64] = ub; mtab[97] = rs; mtab[98] = ub; }
        __syncthreads();
        g8::ProbDn P{act8, q8dn, y16, p.in[I_BDN], list, gate, sact, sdn, g8::MoeTab{mtab, 8}, nb, vcu};
        g8::gemm_phase(lds, P);
        __syncthreads();
    }
    SEAM(10);
    if (IN(11)) {
        const int lane = LANE_NOW; (void)lane;
        for (int row = gw; row < T_; row += nw) {
            float v[32]; float s = 0.f;
#pragma unroll
            for (int c = 0; c < 4; ++c) { const int col = (lane + 64 * c) * 8; const size_t yo = (size_t)row * 4 * 2048 + col;
                const h8 hh8 = *(const h8*)(h16 + (size_t)row * 2048 + col);
                const h8 y0 = *(const h8*)(y16 + yo), y1 = *(const h8*)(y16 + yo + 2048), y2 = *(const h8*)(y16 + yo + 4096), y3 = *(const h8*)(y16 + yo + 6144);
#pragma unroll
                for (int q = 0; q < 8; ++q) { v[c * 8 + q] = DN_ALPHA * (float)hh8[q] + (((float)y0[q] + (float)y1[q]) + ((float)y2[q] + (float)y3[q])); s += v[c * 8 + q]; } }
            const float mu = wave_sum(s) / 2048.f; float q2 = 0.f;
#pragma unroll
            for (int i = 0; i < 32; ++i) { const float d = v[i] - mu; q2 += d * d; }
            const float rs = rsqrtf(wave_sum(q2) / 2048.f + LN_EPS);
#pragma unroll
            for (int c = 0; c < 4; ++c) { const int col = (lane + 64 * c) * 8;
                const float4 ga = *(const float4*)(p.in[I_LN2G] + col), gb = *(const float4*)(p.in[I_LN2G] + col + 4), ba = *(const float4*)(p.in[I_LN2B] + col), bb = *(const float4*)(p.in[I_LN2B] + col + 4);
                float4 o0, o1;
                o0.x = (v[c * 8 + 0] - mu) * rs * ga.x + ba.x; o0.y = (v[c * 8 + 1] - mu) * rs * ga.y + ba.y; o0.z = (v[c * 8 + 2] - mu) * rs * ga.z + ba.z; o0.w = (v[c * 8 + 3] - mu) * rs * ga.w + ba.w;
                o1.x = (v[c * 8 + 4] - mu) * rs * gb.x + bb.x; o1.y = (v[c * 8 + 5] - mu) * rs * gb.y + bb.y; o1.z = (v[c * 8 + 6] - mu) * rs * gb.z + bb.z; o1.w = (v[c * 8 + 7] - mu) * rs * gb.w + bb.w;
                *(float4*)(p.out + (size_t)row * 2048 + col) = o0; *(float4*)(p.out + (size_t)row * 2048 + col + 4) = o1; }
        }
    }
}

constexpr int NPHASE = 12;

extern "C" void kernel_launch(void* const* d_in, const int* in_sizes, int n_in, void* d_out, int out_size, void* d_ws, size_t ws_size, hipStream_t stream) {
    static int grid = 0;
    if (grid == 0) {
        if (n_in != 26 || ws_size < WS_END) { fprintf(stderr, "kernel_launch: unexpected n_in %d or ws_size %zu (< %zu)\n", n_in, ws_size, (size_t)WS_END); grid = -1; return; }
        int dev = 0, cus = 0, per_cu = 0;
        hipGetDevice(&dev); hipDeviceGetAttribute(&cus, hipDeviceAttributeMultiprocessorCount, dev);
        if (hipFuncSetAttribute((const void*)fwd, hipFuncAttributeMaxDynamicSharedMemorySize, LDS_BYTES) != hipSuccess) { fprintf(stderr, "hipFuncSetAttribute failed\n"); grid = -1; return; }
        hipOccupancyMaxActiveBlocksPerMultiprocessor(&per_cu, (const void*)fwd, 512, LDS_BYTES);
        (void)hipGetLastError();
        if (per_cu < 1) fprintf(stderr, "occupancy query says %d blocks per CU\n", per_cu);
        grid = cus > 0 ? cus : 256;
    }
    if (grid < 0) return;
    hipMemsetAsync((char*)d_ws + WS_CTL, 0, CTL_BYTES, stream);
    Params p{};
    for (int i = 0; i < 26; ++i) p.in[i] = (const float*)d_in[i];
    p.out = (float*)d_out; p.ws = (unsigned char*)d_ws;
#if N_LAUNCH_MODE == 1
    p.lo_hi = (long long)0 | ((long long)NPHASE << 32);
    hipLaunchKernelGGL(fwd, dim3(grid), dim3(512), LDS_BYTES, stream, p);
#else
    for (int ph = 0; ph < NPHASE; ++ph) {
        p.lo_hi = (long long)ph | ((long long)(ph + 1) << 32);
        hipLaunchKernelGGL(fwd, dim3(grid), dim3(512), LDS_BYTES, stream, p);
    }
#endif
}
```

```cpp
#include <hip/hip_runtime.h>
#include <cstdio>
#include <cstdint>

#ifndef N_LAUNCH_MODE
#define N_LAUNCH_MODE 1
#endif

constexpr int B_ = 8, S_ = 2048, D_ = 2048, T_ = B_ * S_;
constexpr int INW = 3608;
constexpr int C_Q = 0, C_KC = 1024, C_VC = 1280, C_KS = 1536, C_VS = 1792, C_KW = 2048, C_VW = 2304, C_G = 2560, C_UP = 2584, C_QM = 3096;
constexpr int NC = 127;
constexpr int CROWS = B_ * NC * 2;
constexpr int NE = 32, DE = 2048, NA = T_ * 4;
constexpr float LN_EPS = 1e-5f;
constexpr float DN_ALPHA = 1.189207115002721f;
constexpr float ATT_SCALE = 0.08838834764831845f;

constexpr size_t al256(size_t x) { return (x + 255) & ~(size_t)255; }
constexpr size_t WS_CTL = 0;
constexpr size_t CTL_BYTES = 65536;
constexpr size_t CTL_CNT = 16384;
constexpr size_t WS_PROJ = CTL_BYTES;
constexpr size_t WS_KVMEM = WS_PROJ + al256((size_t)T_ * INW * 4);
constexpr size_t WS_BIAS1 = WS_KVMEM + al256((size_t)2048 * 1024 * 4);
constexpr size_t WS_HID = WS_BIAS1 + al256(2 * 16 * 256 * 4);
constexpr size_t WS_KC = WS_HID + al256((size_t)2 * 2048 * 256 * 4);
constexpr size_t WS_VC = WS_KC + al256((size_t)CROWS * 128 * 4);
constexpr size_t WS_POOLED = WS_VC + al256((size_t)CROWS * 128 * 4);
constexpr size_t WS_OPOOL = WS_POOLED + al256((size_t)T_ * 512 * 4);
constexpr size_t WS_OWIN = WS_OPOOL + al256((size_t)T_ * 512 * 4);
constexpr size_t WS_OCMP = WS_OWIN + al256((size_t)T_ * 1024 * 4);
constexpr size_t WS_OSLC = WS_OCMP + al256((size_t)T_ * 1024 * 4);
constexpr size_t WS_SEL = WS_OSLC + al256((size_t)T_ * 1024 * 4);
constexpr size_t WS_OMEM = WS_SEL + al256((size_t)T_ * 2 * 4);
constexpr size_t WS_CAT16 = WS_OMEM + al256((size_t)T_ * 512 * 4);
constexpr size_t WS_HPRE = WS_CAT16 + al256((size_t)T_ * 2048 * 2);
constexpr size_t WS_H = WS_HPRE + al256((size_t)T_ * 2048 * 4);
constexpr size_t WS_H16 = WS_H + al256((size_t)T_ * 2048 * 4);
constexpr size_t WS_GATE = WS_H16 + al256((size_t)T_ * 2048 * 2);
constexpr size_t WS_LIST = WS_GATE + al256((size_t)NA * 4);
constexpr size_t WS_ACT16 = WS_LIST + al256((size_t)NE * T_ * 4);
constexpr size_t WS_Y16 = WS_ACT16 + al256((size_t)(NA + 256) * 2048 * 2);
constexpr size_t WS_X16 = WS_Y16 + al256((size_t)NA * 2048 * 2);
constexpr size_t WS_MEM16 = WS_X16 + (size_t)T_ * 2048 * 2;
constexpr size_t WS_WTIN = WS_MEM16 + al256((size_t)2048 * 2048 * 2);
constexpr size_t WS_WTOUT = WS_WTIN + al256((size_t)3840 * 2048 * 2);
constexpr size_t WS_WTGU = WS_WTOUT + al256((size_t)2048 * 2048 * 2);
constexpr size_t WS_WTDN = WS_WTGU + al256((size_t)NE * 4096 * 2048 * 2);
constexpr size_t WS_PROJ16 = WS_WTDN + al256((size_t)NE * 2048 * 2048 * 2);
constexpr size_t WS_KVMEM16 = WS_PROJ16 + al256((size_t)(T_ + 64) * INW * 2);
constexpr size_t WS_WT1 = WS_KVMEM16 + al256((size_t)2048 * 1024 * 2);
constexpr size_t WS_UV = WS_WT1 + al256((size_t)2 * 512 * 2048 * 2);
constexpr size_t WS_KC16 = WS_UV + al256((size_t)2 * 4 * 2048 * 512 * 4);
constexpr size_t WS_VC16 = WS_KC16 + al256((size_t)B_ * 128 * 256 * 2);
constexpr size_t WS_WR16 = WS_VC16 + al256((size_t)B_ * 128 * 256 * 2);
constexpr size_t WS_Q8GU = WS_WR16 + al256((size_t)32 * 2048 * 2);
constexpr size_t WS_Q8DN = WS_Q8GU + al256((size_t)NE * 4096 * 2048);
constexpr size_t WS_SGU = WS_Q8DN + al256((size_t)NE * 2048 * 2048);
constexpr size_t WS_SDN = WS_SGU + al256((size_t)NE * 4096 * 4);
constexpr size_t WS_H8 = WS_SDN + al256((size_t)NE * 2048 * 4);
constexpr size_t WS_SAH = WS_H8 + al256((size_t)T_ * 2048);
constexpr size_t WS_ACT8 = WS_SAH + al256((size_t)T_ * 4);
constexpr size_t WS_SACT = WS_ACT8 + al256((size_t)(NA + 256) * 2048);
constexpr size_t WS_WTMKV = WS_SACT + al256((size_t)(NA + 256) * 4);
constexpr size_t WS_Q8OUT = WS_WTMKV + al256((size_t)1024 * 2048 * 2);
constexpr size_t WS_SOUT = WS_Q8OUT + al256((size_t)2048 * 2048);
constexpr size_t WS_CAT8 = WS_SOUT + al256(2048 * 4);
constexpr size_t WS_SCAT = WS_CAT8 + al256((size_t)T_ * 2048);
constexpr size_t WS_KV16 = WS_SCAT + al256((size_t)T_ * 4);
constexpr size_t KVSEG = (size_t)S_ * 128;
constexpr size_t WS_END = WS_KV16 + al256((size_t)6 * B_ * 2 * S_ * 128 * 2);

constexpr int LDS_BYTES = 155648;

struct Params {
    const float* in[26];
    float* out;
    unsigned char* ws;
    long long lo_hi;
};
enum { I_X = 0, I_MEM, I_WIN, I_POSK, I_W1K, I_W2K, I_POSV, I_W1V, I_W2V, I_POOLW, I_POOLS, I_WMEMKV, I_GNNSA, I_GNPOOL, I_GNMEM, I_WOUT,
       I_LN1G, I_LN1B, I_WR, I_BR, I_WGU, I_BGU, I_WDN, I_BDN, I_LN2G, I_LN2B };

#define XB_TMO      128
#define XB_XCNT(j)  (256  + 64 * (j))
#define XB_XSUB(j)  (1280 + 64 * (j))
#define XB_XGEN(j)  (2304 + 64 * (j))
#define XB_TOP      3328
#define XB_TOPGEN   3392
#define XCD_BAR_WORDS 3456
#define XB_SPIN_CAP (1u << 25)
#define LAS __attribute__((address_space(3)))

__device__ __forceinline__ unsigned xb_ld(unsigned* p)              { return __hip_atomic_load(p, __ATOMIC_RELAXED, __HIP_MEMORY_SCOPE_AGENT); }
__device__ __forceinline__ unsigned xb_add(unsigned* p, unsigned v) { return __hip_atomic_fetch_add(p, v, __ATOMIC_RELAXED, __HIP_MEMORY_SCOPE_AGENT); }
__device__ __forceinline__ unsigned xb_xcc_id() { return (unsigned)__builtin_amdgcn_s_getreg((3 << 11) | 20) & 0xFu; }
#define XB_SPIN(cond, bar) do { unsigned _sp = 0; while (cond) { __builtin_amdgcn_s_sleep(1); \
    if ((++_sp & 255u) == 0u) { if (xb_ld(&(bar)[XB_TMO])) break; if (_sp > XB_SPIN_CAP) { atomicAdd(&(bar)[XB_TMO], 1u); break; } } } } while (0)

struct XcdBarrier { unsigned* bar; unsigned x; volatile LAS unsigned* st; };

__device__ __forceinline__ XcdBarrier xcd_barrier_post(unsigned* bar, volatile LAS unsigned* st) {
    XcdBarrier b; b.bar = bar; b.x = xb_xcc_id(); b.st = st;
    if (threadIdx.x == 0) (void)xb_add(&bar[XB_XCNT(b.x)], 1u);
    return b;
}
__device__ __forceinline__ void xcd_barrier_complete(unsigned* bar, unsigned x, unsigned& nloc, unsigned& nx) {
    const unsigned G = gridDim.x * gridDim.y * gridDim.z;
    unsigned sum, cnt, mine, sp = 0u;
    for (;;) {
        sum = 0u; cnt = 0u; mine = 0u;
#pragma unroll
        for (unsigned j = 0; j < 16; ++j) { const unsigned c = xb_ld(&bar[XB_XCNT(j)]); sum += c; cnt += (c > 0u) ? 1u : 0u; mine = (j == x) ? c : mine; }
        if (sum == G) break;
        __builtin_amdgcn_s_sleep(1);
        if ((++sp & 255u) == 0u) { if (xb_ld(&bar[XB_TMO])) break; if (sp > XB_SPIN_CAP) { atomicAdd(&bar[XB_TMO], 1u); break; } }
    }
    nloc = mine > 0u ? mine : 1u; nx = cnt > 0u ? cnt : 1u;
}
__device__ __forceinline__ void xcd_barrier(const XcdBarrier& b) {
    asm volatile("s_waitcnt vmcnt(0)" ::: "memory");
    __syncthreads();
    if (threadIdx.x == 0) {
        unsigned* bar = b.bar;
        __builtin_amdgcn_s_waitcnt(0);
        unsigned nloc = b.st[0], nx = b.st[1];
        if (nloc == 0u) { xcd_barrier_complete(bar, b.x, nloc, nx); b.st[0] = nloc; b.st[1] = nx; }
        const unsigned old = xb_add(&bar[XB_XSUB(b.x)], 1u);
        const unsigned gen = old / nloc;
        if (old + 1u == (gen + 1u) * nloc) {
            __builtin_amdgcn_fence(__ATOMIC_RELEASE, "agent");
            asm volatile("s_waitcnt vmcnt(0)" ::: "memory");
            const unsigned og = xb_add(&bar[XB_TOP], 1u);
            const unsigned tg = og / nx;
            if (og + 1u == (tg + 1u) * nx) xb_add(&bar[XB_TOPGEN], 1u);
            else XB_SPIN(xb_ld(&bar[XB_TOPGEN]) == tg, bar);
            __builtin_amdgcn_fence(__ATOMIC_ACQUIRE, "agent");
            xb_add(&bar[XB_XGEN(b.x)], 1u);
            asm volatile("s_waitcnt vmcnt(0)" ::: "memory");
        } else {
            XB_SPIN(xb_ld(&bar[XB_XGEN(b.x)]) == gen, bar);
            __builtin_amdgcn_fence(__ATOMIC_ACQUIRE, "agent");
            asm volatile("s_waitcnt vmcnt(0)" ::: "memory");
        }
    }
    __syncthreads();
}

typedef _Float16 h8 __attribute__((ext_vector_type(8)));
typedef _Float16 h4 __attribute__((ext_vector_type(4)));
typedef float f4 __attribute__((ext_vector_type(4)));

__device__ __forceinline__ float wave_sum(float v) {
#pragma unroll
    for (int o = 32; o > 0; o >>= 1) v += __shfl_xor(v, o);
    return v;
}
__device__ __forceinline__ float wave_max(float v) {
#pragma unroll
    for (int o = 32; o > 0; o >>= 1) v = fmaxf(v, __shfl_xor(v, o));
    return v;
}
__device__ __forceinline__ void wave_sync() {
    asm volatile("s_waitcnt lgkmcnt(0)" ::: "memory");
    __builtin_amdgcn_wave_barrier();
}
__device__ __forceinline__ float gelu_tanh(float x) {
    const float u = 0.7978845608028654f * (x + 0.044715f * x * x * x);
    return 0.5f * x * (1.f + tanhf(u));
}
__device__ __forceinline__ float sigmoidf_(float x) { return 1.f / (1.f + expf(-x)); }
__device__ __forceinline__ unsigned pk4_fp8(float a, float b, float c, float d) { int w = 0; w = __builtin_amdgcn_cvt_pk_fp8_f32(a, b, w, false); w = __builtin_amdgcn_cvt_pk_fp8_f32(c, d, w, true); return (unsigned)w; }
__device__ __forceinline__ void dec4_fp8(unsigned w, float& a, float& b, float& c, float& d) { a = __builtin_amdgcn_cvt_f32_fp8((int)w, 0); b = __builtin_amdgcn_cvt_f32_fp8((int)w, 1); c = __builtin_amdgcn_cvt_f32_fp8((int)w, 2); d = __builtin_amdgcn_cvt_f32_fp8((int)w, 3); }
__device__ __forceinline__ float swiglu_fast(float g, float l) { const float xg = fminf(g, 7.f), xl = fminf(fmaxf(l, -7.f), 7.f); return xg * __builtin_amdgcn_rcpf(1.f + __builtin_amdgcn_exp2f(-2.4554669595930156f * xg)) * (xl + 1.f); }

constexpr int G_LD = 40;
template <class AF, class EF>
__device__ __forceinline__ void gemm_tile(char* smem, int K, const AF& af, const float* __restrict__ Bm, int ldb, int n0, int Nlim, bool perm, const EF& ef) {
    _Float16* As = (_Float16*)smem;
    _Float16* Bs = As + 128 * G_LD;
    const int tid = threadIdx.x, lane = tid & 63, wid = tid >> 6, wr = wid >> 2, wc = wid & 3, fr = lane & 15, fq = lane >> 4;
    f4 acc[4][2];
#pragma unroll
    for (int m = 0; m < 4; ++m)
#pragma unroll
        for (int n = 0; n < 2; ++n) acc[m][n] = (f4){0.f, 0.f, 0.f, 0.f};
    const int ar = tid >> 3, ak = (tid & 7) * 4;
    const float* ap0 = af.row(ar);
    const float* ap1 = af.row(ar + 64);
    const int bk = tid >> 5, bn = (tid & 31) * 4;
    const bool bok = (n0 + bn) < Nlim;
    int bnp[4];
#pragma unroll
    for (int i = 0; i < 4; ++i) { const int c = bn + i; bnp[i] = perm ? ((c & ~31) | ((c & 1) << 4) | ((c & 31) >> 1)) : c; }
    for (int k0 = 0; k0 < K; k0 += 32) {
        const int ko = af.koff(k0 + ak);
        float4 a0 = make_float4(0.f, 0.f, 0.f, 0.f), a1 = a0, b0 = a0, b1 = a0;
        if (ap0) a0 = *(const float4*)(ap0 + ko);
        if (ap1) a1 = *(const float4*)(ap1 + ko);
        if (bok) { b0 = *(const float4*)(Bm + (size_t)(k0 + bk) * ldb + n0 + bn); b1 = *(const float4*)(Bm + (size_t)(k0 + bk + 16) * ldb + n0 + bn); }
        __syncthreads();
        *(h4*)&As[ar * G_LD + ak] = (h4){(_Float16)a0.x, (_Float16)a0.y, (_Float16)a0.z, (_Float16)a0.w};
        *(h4*)&As[(ar + 64) * G_LD + ak] = (h4){(_Float16)a1.x, (_Float16)a1.y, (_Float16)a1.z, (_Float16)a1.w};
        Bs[bnp[0] * G_LD + bk] = (_Float16)b0.x; Bs[bnp[1] * G_LD + bk] = (_Float16)b0.y; Bs[bnp[2] * G_LD + bk] = (_Float16)b0.z; Bs[bnp[3] * G_LD + bk] = (_Float16)b0.w;
        Bs[bnp[0] * G_LD + bk + 16] = (_Float16)b1.x; Bs[bnp[1] * G_LD + bk + 16] = (_Float16)b1.y; Bs[bnp[2] * G_LD + bk + 16] = (_Float16)b1.z; Bs[bnp[3] * G_LD + bk + 16] = (_Float16)b1.w;
        __syncthreads();
        h8 a[4], b[2];
#pragma unroll
        for (int m = 0; m < 4; ++m) a[m] = *(const h8*)&As[(wr * 64 + m * 16 + fr) * G_LD + fq * 8];
#pragma unroll
        for (int n = 0; n < 2; ++n) b[n] = *(const h8*)&Bs[(wc * 32 + n * 16 + fr) * G_LD + fq * 8];
#pragma unroll
        for (int m = 0; m < 4; ++m)
#pragma unroll
            for (int n = 0; n < 2; ++n) acc[m][n] = __builtin_amdgcn_mfma_f32_16x16x32_f16(a[m], b[n], acc[m][n], 0, 0, 0);
    }
    ef(acc, wr, wc, fr, fq);
    __syncthreads();
}

struct ARowPlain { const float* base; int ld; int m0; int mlim;
    __device__ __forceinline__ const float* row(int r) const { return (m0 + r) < mlim ? base + (size_t)(m0 + r) * ld : nullptr; }
    __device__ __forceinline__ int koff(int k) const { return k; } };
struct ARowCmp { const float* proj; int col; int m0;
    __device__ __forceinline__ const float* row(int r) const { const int g = m0 + r; if (g >= CROWS) return nullptr; const int kvh = g & 1, bc = g >> 1, b = bc / NC, c = bc % NC;
        return proj + (size_t)(b * S_ + 16 * c) * INW + col + kvh * 128; }
    __device__ __forceinline__ int koff(int k) const { return (k >> 7) * INW + (k & 127); } };
struct ARowList { const float* base; const int* list; int m0; int cnt; int shift;
    __device__ __forceinline__ const float* row(int r) const { if (m0 + r >= cnt) return nullptr; const int a = list[m0 + r]; return base + (size_t)(a >> shift) * 2048; }
    __device__ __forceinline__ int koff(int k) const { return k; } };

struct EpiStore { float* C; int ldc; int m0; int n0; int mlim; int nlim; _Float16* C16;
    __device__ __forceinline__ void operator()(const f4 (&acc)[4][2], int wr, int wc, int fr, int fq) const {
#pragma unroll
        for (int m = 0; m < 4; ++m)
#pragma unroll
            for (int n = 0; n < 2; ++n)
#pragma unroll
                for (int j = 0; j < 4; ++j) { const int r = m0 + wr * 64 + m * 16 + fq * 4 + j, c = n0 + wc * 32 + n * 16 + fr;
                    if (r < mlim && c < nlim) { C[(size_t)r * ldc + c] = acc[m][n][j]; if (C16) C16[(size_t)r * ldc + c] = (_Float16)acc[m][n][j]; } } } };
struct EpiPool { _Float16* C; const float* scale; int m0; int g;
    __device__ __forceinline__ void operator()(const f4 (&acc)[4][2], int wr, int wc, int fr, int fq) const {
#pragma unroll
        for (int m = 0; m < 4; ++m)
#pragma unroll
            for (int n = 0; n < 2; ++n)
#pragma unroll
                for (int j = 0; j < 4; ++j) { const int r = m0 + wr * 64 + m * 16 + fq * 4 + j, c = g * 128 + wc * 32 + n * 16 + fr;
                    C[(size_t)r * 512 + c] = (_Float16)(acc[m][n][j] * scale[c]); } } };
struct EpiHid { float* C; const float* bias; int m0; int n0;
    __device__ __forceinline__ void operator()(const f4 (&acc)[4][2], int wr, int wc, int fr, int fq) const {
#pragma unroll
        for (int m = 0; m < 4; ++m)
#pragma unroll
            for (int n = 0; n < 2; ++n)
#pragma unroll
                for (int j = 0; j < 4; ++j) { const int r = m0 + wr * 64 + m * 16 + fq * 4 + j, c = n0 + wc * 32 + n * 16 + fr;
                    if (r < CROWS) C[(size_t)r * 256 + c] = gelu_tanh(acc[m][n][j] + bias[c]); } } };
struct EpiOut { float* C; const float* x; int m0; int n0;
    __device__ __forceinline__ void operator()(const f4 (&acc)[4][2], int wr, int wc, int fr, int fq) const {
#pragma unroll
        for (int m = 0; m < 4; ++m)
#pragma unroll
            for (int n = 0; n < 2; ++n)
#pragma unroll
                for (int j = 0; j < 4; ++j) { const size_t o = (size_t)(m0 + wr * 64 + m * 16 + fq * 4 + j) * 2048 + n0 + wc * 32 + n * 16 + fr;
                    C[o] = DN_ALPHA * x[o] + acc[m][n][j]; } } };
struct EpiGu { float* act; const float* bgu; const int* list; int m0; int cnt; int n0;
    __device__ __forceinline__ void operator()(const f4 (&acc)[4][2], int wr, int wc, int fr, int fq) const {
        const int jc = (n0 + wc * 32) / 2 + fr;
        const float bg = bgu[2 * jc], bl = bgu[2 * jc + 1];
#pragma unroll
        for (int m = 0; m < 4; ++m)
#pragma unroll
            for (int j = 0; j < 4; ++j) { const int r = m0 + wr * 64 + m * 16 + fq * 4 + j;
                if (r < cnt) { const int a = list[r];
                    const float xg = fminf(acc[m][0][j] + bg, 7.f), xl = fminf(fmaxf(acc[m][1][j] + bl, -7.f), 7.f);
                    act[(size_t)a * 2048 + jc] = xg * sigmoidf_(1.702f * xg) * (xl + 1.f); } } } };
struct EpiDn { float* y; const float* bdn; const int* list; const float* gate; int m0; int cnt; int n0;
    __device__ __forceinline__ void operator()(const f4 (&acc)[4][2], int wr, int wc, int fr, int fq) const {
#pragma unroll
        for (int m = 0; m < 4; ++m)
#pragma unroll
            for (int j = 0; j < 4; ++j) { const int r = m0 + wr * 64 + m * 16 + fq * 4 + j;
                if (r < cnt) { const int a = list[r]; const float g = gate[a];
#pragma unroll
                    for (int n = 0; n < 2; ++n) { const int c = n0 + wc * 32 + n * 16 + fr; y[(size_t)a * 2048 + c] = (acc[m][n][j] + bdn[c]) * g; } } } } };

constexpr int WLDS_FLOATS = 4096 + 512 + 32;
template <bool SHARED>
__device__ __forceinline__ void wave_attn(float* sw, const float* __restrict__ qptr, const float* __restrict__ Kb, const float* __restrict__ Vb, int ld, int nseg, float scale, float* __restrict__ optr) {
    const int lane = threadIdx.x & 63;
    float* sq = sw + 4096; const int* segs = (const int*)(sw + 4096 + 512);
#pragma unroll
    for (int i = 0; i < 8; ++i) sq[lane + 64 * i] = qptr[lane + 64 * i];
    wave_sync();
    for (int sg = 0; sg < nseg; ++sg) {
        const int start = segs[sg], len = segs[16 + sg];
        float d0 = 0.f, d1 = 0.f, d2 = 0.f, d3 = 0.f;
        if (lane < len) {
            const float* kp = Kb + (size_t)(start + lane) * ld;
            for (int d4 = 0; d4 < 32; ++d4) {
                if (SHARED) {
                    const float4 kv = *(const float4*)(kp + d4 * 4);
                    const float4 q0 = *(const float4*)(sq + d4 * 4), q1 = *(const float4*)(sq + 128 + d4 * 4), q2 = *(const float4*)(sq + 256 + d4 * 4), q3 = *(const float4*)(sq + 384 + d4 * 4);
                    d0 += kv.x * q0.x + kv.y * q0.y + kv.z * q0.z + kv.w * q0.w;
                    d1 += kv.x * q1.x + kv.y * q1.y + kv.z * q1.z + kv.w * q1.w;
                    d2 += kv.x * q2.x + kv.y * q2.y + kv.z * q2.z + kv.w * q2.w;
                    d3 += kv.x * q3.x + kv.y * q3.y + kv.z * q3.z + kv.w * q3.w;
                } else {
                    const float4 k0 = *(const float4*)(kp + d4 * 4), k1 = *(const float4*)(kp + 128 + d4 * 4), k2 = *(const float4*)(kp + 256 + d4 * 4), k3 = *(const float4*)(kp + 384 + d4 * 4);
                    const float4 q0 = *(const float4*)(sq + d4 * 4), q1 = *(const float4*)(sq + 128 + d4 * 4), q2 = *(const float4*)(sq + 256 + d4 * 4), q3 = *(const float4*)(sq + 384 + d4 * 4);
                    d0 += k0.x * q0.x + k0.y * q0.y + k0.z * q0.z + k0.w * q0.w;
                    d1 += k1.x * q1.x + k1.y * q1.y + k1.z * q1.z + k1.w * q1.w;
                    d2 += k2.x * q2.x + k2.y * q2.y + k2.z * q2.z + k2.w * q2.w;
                    d3 += k3.x * q3.x + k3.y * q3.y + k3.z * q3.z + k3.w * q3.w;
                }
            }
        }
        const bool ok = lane < len;
        sw[sg * 64 + lane] = ok ? d0 * scale : -1e30f;
        sw[1024 + sg * 64 + lane] = ok ? d1 * scale : -1e30f;
        sw[2048 + sg * 64 + lane] = ok ? d2 * scale : -1e30f;
        sw[3072 + sg * 64 + lane] = ok ? d3 * scale : -1e30f;
    }
    wave_sync();
    const int n = nseg * 64;
#pragma unroll
    for (int g = 0; g < 4; ++g) {
        float mx = -1e30f;
        for (int i = lane; i < n; i += 64) mx = fmaxf(mx, sw[g * 1024 + i]);
        mx = wave_max(mx);
        float sm = 0.f;
        for (int i = lane; i < n; i += 64) { const float v = sw[g * 1024 + i]; sm += (v > -1e29f) ? expf(v - mx) : 0.f; }
        sm = wave_sum(sm);
        const float inv = sm > 0.f ? 1.f / sm : 0.f;
        for (int i = lane; i < n; i += 64) { const float v = sw[g * 1024 + i]; sw[g * 1024 + i] = (v > -1e29f) ? expf(v - mx) * inv : 0.f; }
    }
    wave_sync();
    float o[4][2];
#pragma unroll
    for (int g = 0; g < 4; ++g) { o[g][0] = 0.f; o[g][1] = 0.f; }
    for (int sg = 0; sg < nseg; ++sg) {
        const int start = segs[sg], len = segs[16 + sg];
        for (int l = 0; l < len; ++l) {
            const float* vp = Vb + (size_t)(start + l) * ld;
            if (SHARED) {
                const float v0 = vp[lane], v1 = vp[lane + 64];
#pragma unroll
                for (int g = 0; g < 4; ++g) { const float p = sw[g * 1024 + sg * 64 + l]; o[g][0] += p * v0; o[g][1] += p * v1; }
            } else {
#pragma unroll
                for (int g = 0; g < 4; ++g) { const float p = sw[g * 1024 + sg * 64 + l]; o[g][0] += p * vp[g * 128 + lane]; o[g][1] += p * vp[g * 128 + lane + 64]; }
            }
        }
    }
#pragma unroll
    for (int g = 0; g < 4; ++g) { optr[g * 128 + lane] = o[g][0]; optr[g * 128 + lane + 64] = o[g][1]; }
}

namespace g8 {
constexpr int BM = 256, BK = 64, HALF = 128, HTB = HALF * BK * 2, STAGE_BYTES = 8 * HTB;
constexpr int KK = 2048;
typedef float f32x4 __attribute__((ext_vector_type(4)));
__device__ __forceinline__ int lds_byte(int r, int c) { const int st = (r >> 4) * 2 + (c >> 5), rr = r & 15, cc = c & 31, ob = rr * 64 + cc * 2; return st * 1024 + (ob ^ (((ob >> 9) & 1) << 5)); }
__device__ __forceinline__ void stage_rc(int b, int& R, int& C) { const int st = b / 1024, sb = b % 1024, swz = sb ^ (((sb >> 9) & 1) << 5); R = (st >> 1) * 16 + swz / 64; C = (st & 1) * 32 + (swz % 64) / 2; }
__device__ __forceinline__ int perm32(int rho) { const int n = rho >> 4, i = rho & 15; return 8 * (i >> 2) + 4 * n + (i & 3); }

typedef int i32x4 __attribute__((ext_vector_type(4)));
typedef unsigned u32x2 __attribute__((ext_vector_type(2)));
typedef unsigned u32x4 __attribute__((ext_vector_type(4)));
template <bool I8> struct AccSel { typedef f32x4 T; };
template <> struct AccSel<true> { typedef i32x4 T; };
__device__ __forceinline__ f32x4 mma16(i32x4 a, i32x4 b, f32x4 c) { return __builtin_amdgcn_mfma_f32_16x16x32_f16(*reinterpret_cast<h8*>(&a), *reinterpret_cast<h8*>(&b), c, 0, 0, 0); }
__device__ __forceinline__ i32x4 mma16(i32x4 a, i32x4 b, i32x4 c) { return __builtin_amdgcn_mfma_i32_16x16x64_i8(a, b, c, 0, 0, 0); }
struct Unit { int m0, n0, e, cnt, rbase; };
constexpr int EP_OFF = STAGE_BYTES + 512, EP_LD = 528, EP_GRP = 16 * EP_LD;
__device__ __forceinline__ void ep_sync() { asm volatile("s_waitcnt lgkmcnt(0)" ::: "memory"); __builtin_amdgcn_s_barrier(); asm volatile("" ::: "memory"); }
__device__ __forceinline__ int ep_tid() { int tz = threadIdx.x; asm volatile("" : "+v"(tz)); return tz; }
__device__ __forceinline__ h8 cvt8(f32x4 a, f32x4 b) { h8 o; o[0] = (_Float16)a[0]; o[1] = (_Float16)a[1]; o[2] = (_Float16)a[2]; o[3] = (_Float16)a[3]; o[4] = (_Float16)b[0]; o[5] = (_Float16)b[1]; o[6] = (_Float16)b[2]; o[7] = (_Float16)b[3]; return o; }

__device__ __forceinline__ void tile_order(int L, int nM, int nN, int& pm, int& pn) {
    const int nwg = nM * nN; int wgid = L;
    { const int q = nwg / 8, r = nwg % 8, xcd = wgid % 8, off = wgid / 8; wgid = (xcd < r ? xcd * (q + 1) : r * (q + 1) + (xcd - r) * q) + off; }
    const int nig = 8 * nN, gid = wgid / nig, fm = gid * 8, gsz = (nM - fm) < 8 ? (nM - fm) : 8;
    pm = fm + ((wgid % nig) % gsz); pn = (wgid % nig) / gsz;
}

template <class Prob>
__device__ __forceinline__ void gemm_phase(LAS unsigned char* lds, const Prob& P) {
    const int tid = threadIdx.x, wid = __builtin_amdgcn_readfirstlane(tid >> 6), lane = tid & 63, wr = wid >> 2, wc = wid & 3, fr = lane & 15, fq = lane >> 4;
    constexpr int nt = Prob::NT; constexpr size_t KS2 = Prob::KS2; constexpr unsigned ROWB = Prob::ROWB; constexpr bool I8 = Prob::I8;
    int sR[2], sC2[2]; unsigned voffB[2];
#pragma unroll
    for (int i = 0; i < 2; ++i) { int R, C; stage_rc(tid * 16 + i * 8192, R, C); sR[i] = R; sC2[i] = C * 2; const int Rb = Prob::PERM ? ((R & ~31) + perm32(R & 31)) : R; voffB[i] = (unsigned)Rb * ROWB + (unsigned)C * 2u; }
    const size_t kstep = (size_t)(BK * 2);
    const size_t hstep = (size_t)HALF * ROWB;
    const unsigned ldsw = (unsigned)wid * 1024u;
    const int aoff = lds_byte(wr * 64 + fr, fq * 8), boff = lds_byte(wc * 32 + fr, fq * 8);
#define G8_SA(b, h) (((b) * 2 + (h)) * HTB)
#define G8_SB(b, h) ((4 + (b) * 2 + (h)) * HTB)
#define G8_STAGE(bufoff, gbase, voff) do { _Pragma("unroll") for (int _i = 0; _i < 2; ++_i) \
        __builtin_amdgcn_global_load_lds((const unsigned*)((const char*)(gbase) + (voff)[_i]), (LAS unsigned*)(lds + (bufoff) + ldsw + _i * 8192), 16, 0, 0); } while (0)
#define G8_LDA(dst, b, h) do { _Pragma("unroll") for (int m = 0; m < 4; ++m) _Pragma("unroll") for (int k = 0; k < 2; ++k) dst[m][k] = *(const LAS i32x4*)(lds + G8_SA(b, h) + aoff + m * 2048 + k * 1024); } while (0)
#define G8_LDB(dst, b, h) do { _Pragma("unroll") for (int n = 0; n < 2; ++n) _Pragma("unroll") for (int k = 0; k < 2; ++k) dst[n][k] = *(const LAS i32x4*)(lds + G8_SB(b, h) + boff + n * 2048 + k * 1024); } while (0)
#define G8_MMA(ai, bj, At, Bt) do { __builtin_amdgcn_s_setprio(1); _Pragma("unroll") for (int m = 0; m < 4; ++m) _Pragma("unroll") for (int n = 0; n < 2; ++n) _Pragma("unroll") for (int k = 0; k < 2; ++k) \
        acc[ai][bj][m][n] = mma16(Bt[n][k], At[m][k], acc[ai][bj][m][n]); __builtin_amdgcn_s_setprio(0); } while (0)
#define G8_WAIT_V(n) asm volatile("s_waitcnt vmcnt(" #n ")" ::: "memory")
#define G8_WAIT_L(n) asm volatile("s_waitcnt lgkmcnt(" #n ")" ::: "memory")
#define G8_BAR __builtin_amdgcn_s_barrier()
#define G8_SCHED __builtin_amdgcn_sched_barrier(0)
    Unit cur, nxt; int ui = 0;
    if (!P.next(0, cur)) return;
    typedef typename AccSel<I8>::T AccT;
    AccT acc[2][2][4][2];
#pragma unroll
    for (int a = 0; a < 2; ++a)
#pragma unroll
        for (int b = 0; b < 2; ++b)
#pragma unroll
            for (int m = 0; m < 4; ++m)
#pragma unroll
                for (int n = 0; n < 2; ++n) acc[a][b][m][n] = AccT{};
    i32x4 At[4][2], B0[2][2], B1[2][2];
    unsigned vc[2][2], vn[2][2];
    P.a_offs(cur, sR, sC2, vc);
    const char* const Ab = P.a_base();
    const char* cB = P.b_base(cur);
    G8_STAGE(G8_SB(0, 0), cB, voffB); G8_STAGE(G8_SA(0, 0), Ab, vc[0]); G8_STAGE(G8_SB(0, 1), cB + hstep, voffB); G8_STAGE(G8_SA(0, 1), Ab, vc[1]);
    if (wr == 1) G8_BAR;
    G8_WAIT_V(4); G8_BAR;
    G8_STAGE(G8_SB(1, 0), cB + kstep, voffB); G8_STAGE(G8_SA(1, 0), Ab + kstep, vc[0]); G8_STAGE(G8_SB(1, 1), cB + hstep + kstep, voffB);
    G8_WAIT_V(6); G8_BAR;
    for (;;) {
        const bool has_next = P.next(ui + 1, nxt);
        const char* nB = cB;
        if (has_next) { P.a_offs(nxt, sR, sC2, vn); nB = P.b_base(nxt); }
        else { vn[0][0] = vc[0][0]; vn[0][1] = vc[0][1]; vn[1][0] = vc[1][0]; vn[1][1] = vc[1][1]; }
        for (int t = 0; t < nt; t += 2) {
            const bool last = (t == nt - 2);
            const char* a1 = Ab + (size_t)(t >> 1) * KS2 + kstep;
            const char* a2 = last ? Ab : Ab + (size_t)((t + 2) >> 1) * KS2; const char* b2 = last ? nB : cB + (size_t)(t + 2) * kstep;
            const char* a3 = a2 + kstep; const char* b3 = b2 + kstep;
            unsigned o2[2][2];
            o2[0][0] = last ? vn[0][0] : vc[0][0]; o2[0][1] = last ? vn[0][1] : vc[0][1]; o2[1][0] = last ? vn[1][0] : vc[1][0]; o2[1][1] = last ? vn[1][1] : vc[1][1];
            G8_LDB(B0, 0, 0); G8_SCHED; G8_LDA(At, 0, 0); G8_STAGE(G8_SA(1, 1), a1, vc[1]);
            G8_WAIT_L(8); G8_BAR; G8_WAIT_L(0); G8_MMA(0, 0, At, B0); G8_BAR; G8_SCHED;
            G8_LDB(B1, 0, 1); G8_STAGE(G8_SB(0, 0), b2, voffB);
            G8_BAR; G8_WAIT_L(0); G8_MMA(0, 1, At, B1); G8_BAR;
            G8_LDA(At, 0, 1); G8_STAGE(G8_SA(0, 0), a2, o2[0]);
            G8_BAR; G8_WAIT_L(0); G8_MMA(1, 0, At, B0); G8_BAR; G8_SCHED;
            G8_STAGE(G8_SB(0, 1), b2 + hstep, voffB);
            G8_WAIT_V(6); G8_BAR; G8_MMA(1, 1, At, B1); G8_BAR;
            G8_LDB(B0, 1, 0); G8_SCHED; G8_LDA(At, 1, 0); G8_STAGE(G8_SA(0, 1), a2, o2[1]);
            G8_WAIT_L(8); G8_BAR; G8_WAIT_L(0); G8_MMA(0, 0, At, B0); G8_BAR; G8_SCHED;
            G8_LDB(B1, 1, 1); G8_STAGE(G8_SB(1, 0), b3, voffB);
            G8_BAR; G8_WAIT_L(0); G8_MMA(0, 1, At, B1); G8_BAR;
            G8_LDA(At, 1, 1); G8_STAGE(G8_SA(1, 0), a3, o2[0]);
            G8_BAR; G8_WAIT_L(0); G8_MMA(1, 0, At, B0); G8_BAR; G8_SCHED;
            G8_STAGE(G8_SB(1, 1), b3 + hstep, voffB);
            G8_WAIT_V(6); G8_BAR; G8_MMA(1, 1, At, B1); G8_BAR;
        }
        P.epi(acc, cur, wr, wc, fr, fq, lds);
        if (!has_next) break;
#pragma unroll
        for (int a = 0; a < 2; ++a)
#pragma unroll
            for (int b = 0; b < 2; ++b)
#pragma unroll
                for (int m = 0; m < 4; ++m)
#pragma unroll
                    for (int n = 0; n < 2; ++n) acc[a][b][m][n] = AccT{};
        cur = nxt; cB = nB; ++ui;
        vc[0][0] = vn[0][0]; vc[0][1] = vn[0][1]; vc[1][0] = vn[1][0]; vc[1][1] = vn[1][1];
    }
    G8_WAIT_V(0);
    if (wr == 0) G8_BAR;
    G8_BAR;
#undef G8_SA
#undef G8_SB
#undef G8_STAGE
#undef G8_LDA
#undef G8_LDB
#undef G8_MMA
#undef G8_WAIT_V
#undef G8_WAIT_L
#undef G8_BAR
#undef G8_SCHED
}

struct ProbIn {
    static constexpr unsigned ROWB = 4096; static constexpr bool I8 = false;
    static constexpr int NT = 32; static constexpr size_t KS2 = 256;
    static constexpr bool PERM = true;
    const _Float16* A; _Float16* C16; int G, c;
    __device__ __forceinline__ bool next(int i, Unit& u) const { const int L = i * G + c; if (L >= 64 * 15 + 32) return false;
        if (L < 64 * 15) { int pm, pn; tile_order(L, 64, 15, pm, pn); u.m0 = pm * 256; u.n0 = pn * 256; u.e = 0; }
        else { const int v = L - 64 * 15; u.m0 = T_ + (v & 7) * 256; u.n0 = (v >> 3) * 256; u.e = 1; }
        u.cnt = 256; u.rbase = 0; return true; }
    __device__ __forceinline__ void a_offs(const Unit& u, const int (&R)[2], const int (&C2)[2], unsigned (&v)[2][2]) const {
#pragma unroll
        for (int h = 0; h < 2; ++h)
#pragma unroll
            for (int i = 0; i < 2; ++i) v[h][i] = (unsigned)(u.m0 + h * 128 + R[i]) * (unsigned)(KK * 2) + (unsigned)C2[i]; }
    __device__ __forceinline__ const char* a_base() const { return (const char*)A; }
    __device__ __forceinline__ const char* b_base(const Unit& u) const { return (const char*)A + (u.e ? (long long)(WS_WTMKV - WS_X16) : (long long)(WS_WTIN - WS_X16)) + (size_t)u.n0 * KK * 2; }
    __device__ __forceinline__ void epi(const f32x4 (&acc)[2][2][4][2], const Unit& u, int wr, int wc, int fr, int fq, LAS unsigned char* lds) const {
        LAS unsigned char* ep = lds + EP_OFF + wr * EP_GRP;
        const int tg = ep_tid() & 255, rrow = tg >> 4, ch = tg & 15;
        const int kvseg = (u.e == 0 && u.n0 >= 1024 && u.n0 < 2560) ? ((u.n0 - 1024) >> 8) : -1;
        _Float16* const Cb = (_Float16*)((char*)C16 + (u.e ? (long long)(WS_KVMEM16 - WS_PROJ16) : 0ll)); const int ldc = u.e ? 1024 : INW, nlim = u.e ? 1024 : INW, mb = u.e ? u.m0 - T_ : u.m0;
#pragma unroll
        for (int ai = 0; ai < 2; ++ai)
#pragma unroll
            for (int m = 0; m < 4; ++m) {
#pragma unroll
                for (int bj = 0; bj < 2; ++bj) *(LAS h8*)(ep + fr * EP_LD + (bj * 128 + wc * 32 + fq * 8) * 2) = cvt8(acc[ai][bj][m][0], acc[ai][bj][m][1]);
                ep_sync();
                const h8 x0 = *(const LAS h8*)(ep + rrow * EP_LD + ch * 32), x1 = *(const LAS h8*)(ep + rrow * EP_LD + ch * 32 + 16);
                const int grow = mb + ai * 128 + wr * 64 + m * 16 + rrow, gcol = u.n0 + ch * 16;
                if (kvseg >= 0) {
                    _Float16* dst = (_Float16*)((char*)C16 + (long long)(WS_KV16 - WS_PROJ16)) + ((size_t)(kvseg * B_ + (grow >> 11)) * 2 + (ch >> 3)) * KVSEG + (size_t)(grow & (S_ - 1)) * 128 + (ch & 7) * 16;
                    *(h8*)dst = x0; *(h8*)(dst + 8) = x1;
                } else {
                    if (gcol < nlim) *(h8*)(Cb + (size_t)grow * ldc + gcol) = x0;
                    if (gcol + 8 < nlim) *(h8*)(Cb + (size_t)grow * ldc + gcol + 8) = x1; }
                ep_sync();
            } }
};
struct ProbOut {
    static constexpr unsigned ROWB = 2048; static constexpr bool I8 = true;
    static constexpr int NT = 16; static constexpr size_t KS2 = 256;
    static constexpr bool PERM = true;
    const signed char* A; const signed char* Bt; _Float16* C; const _Float16* X; const float* sa; const float* sw; int G, c;
    __device__ __forceinline__ bool next(int i, Unit& u) const { const int L = i * G + c; if (L >= 64 * 8) return false; int pm, pn; tile_order(L, 64, 8, pm, pn); u.m0 = pm * 256; u.n0 = pn * 256; u.e = 0; u.cnt = 256; u.rbase = 0; return true; }
    __device__ __forceinline__ void a_offs(const Unit& u, const int (&R)[2], const int (&C2)[2], unsigned (&v)[2][2]) const {
#pragma unroll
        for (int h = 0; h < 2; ++h)
#pragma unroll
            for (int i = 0; i < 2; ++i) v[h][i] = (unsigned)(u.m0 + h * 128 + R[i]) * 2048u + (unsigned)C2[i]; }
    __device__ __forceinline__ const char* a_base() const { return (const char*)A; }
    __device__ __forceinline__ const char* b_base(const Unit& u) const { return (const char*)(Bt + (size_t)u.n0 * 2048); }
    __device__ __forceinline__ void epi(const i32x4 (&acc)[2][2][4][2], const Unit& u, int wr, int wc, int fr, int fq, LAS unsigned char* lds) const {
        LAS unsigned char* ep = lds + EP_OFF + wr * EP_GRP;
        const int tg = ep_tid() & 255, rrow = tg >> 4, ch = tg & 15;
        f32x4 s0[2], s1[2]; float srv[8];
#pragma unroll
        for (int bj = 0; bj < 2; ++bj) { const int col = u.n0 + bj * 128 + wc * 32 + fq * 8; s0[bj] = *(const f32x4*)(sw + col); s1[bj] = *(const f32x4*)(sw + col + 4); }
#pragma unroll
        for (int q = 0; q < 8; ++q) srv[q] = sa[u.m0 + (q >> 2) * 128 + wr * 64 + (q & 3) * 16 + fr];
#pragma unroll
        for (int ai = 0; ai < 2; ++ai)
#pragma unroll
            for (int m = 0; m < 4; ++m) { const float sr = srv[ai * 4 + m];
#pragma unroll
                for (int bj = 0; bj < 2; ++bj) { const i32x4 i0 = acc[ai][bj][m][0], i1 = acc[ai][bj][m][1];
                    *(LAS h8*)(ep + fr * EP_LD + (bj * 128 + wc * 32 + fq * 8) * 2) = cvt8((f32x4){(float)i0[0], (float)i0[1], (float)i0[2], (float)i0[3]} * (s0[bj] * sr), (f32x4){(float)i1[0], (float)i1[1], (float)i1[2], (float)i1[3]} * (s1[bj] * sr)); }
                const size_t go = (size_t)(u.m0 + ai * 128 + wr * 64 + m * 16 + rrow) * 2048 + u.n0 + ch * 16;
                const h8 r0 = *(const h8*)(X + go), r1 = *(const h8*)(X + go + 8);
                ep_sync();
                const h8 x0 = *(const LAS h8*)(ep + rrow * EP_LD + ch * 32), x1 = *(const LAS h8*)(ep + rrow * EP_LD + ch * 32 + 16);
                h8 o0, o1;
#pragma unroll
                for (int q = 0; q < 8; ++q) { o0[q] = (_Float16)(DN_ALPHA * (float)r0[q] + (float)x0[q]); o1[q] = (_Float16)(DN_ALPHA * (float)r1[q] + (float)x1[q]); }
                *(h8*)(C + go) = o0; *(h8*)(C + go + 8) = o1;
                ep_sync();
            } }
};
struct ProbCmp {
    static constexpr unsigned ROWB = 4096; static constexpr bool I8 = false;
    static constexpr int NT = 8; static constexpr size_t KS2 = 256;
    static constexpr bool PERM = false;
    const _Float16* A; const _Float16* Bt; float* C; int G, c;
    __device__ __forceinline__ bool next(int i, Unit& u) const { const int L = i * G + c; if (L >= 128) return false;
        u.e = L >> 6; const int r = L & 63; u.rbase = r & 3; u.n0 = ((r >> 2) & 1) * 256; u.m0 = (r >> 3) * 256; u.cnt = 256; return true; }
    __device__ __forceinline__ void a_offs(const Unit& u, const int (&R)[2], const int (&C2)[2], unsigned (&v)[2][2]) const {
#pragma unroll
        for (int h = 0; h < 2; ++h)
#pragma unroll
            for (int i = 0; i < 2; ++i) { const int row = u.m0 + h * 128 + R[i], kvh = row & 1, bj = row >> 1, b = bj >> 7, j = bj & 127;
                v[h][i] = (unsigned)((((u.e * B_ + b) * 2 + kvh) * S_ + 16 * j + 4 * u.rbase) * 128) * 2u + (unsigned)C2[i]; } }
    __device__ __forceinline__ const char* a_base() const { return (const char*)A; }
    __device__ __forceinline__ const char* b_base(const Unit& u) const { return (const char*)(Bt + ((size_t)u.e * 512 + u.n0) * KK + u.rbase * 512); }
    __device__ __forceinline__ void epi(const f32x4 (&acc)[2][2][4][2], const Unit& u, int wr, int wc, int fr, int fq, LAS unsigned char*) const {
        float* base = C + ((size_t)(u.e * 4 + u.rbase) * 2048) * 512;
#pragma unroll
        for (int ai = 0; ai < 2; ++ai)
#pragma unroll
            for (int m = 0; m < 4; ++m) { const int row = u.m0 + ai * 128 + wr * 64 + m * 16 + fr;
#pragma unroll
                for (int bj = 0; bj < 2; ++bj)
#pragma unroll
                    for (int n = 0; n < 2; ++n) { const int col = u.n0 + bj * 128 + wc * 32 + n * 16 + fq * 4;
                        *(f32x4*)(base + (size_t)row * 512 + col) = acc[ai][bj][m][n]; } } }
};
struct MoeTab { const LAS int* t; int NT;
    __device__ __forceinline__ bool find(int L, Unit& u) const {
        const int total = __builtin_amdgcn_readfirstlane(t[98]); if (L >= total) return false;
        int e = 0;
        for (; e < NE - 1; ++e) { if (L < __builtin_amdgcn_readfirstlane(t[32 + e + 1])) break; }
        const int ub = __builtin_amdgcn_readfirstlane(t[32 + e]), cn = __builtin_amdgcn_readfirstlane(t[e]), rs = __builtin_amdgcn_readfirstlane(t[65 + e]);
        const int nm = (cn + 255) >> 8, v = L - ub, mt = v % nm, ntile = v / nm;
        u.e = e; u.m0 = mt * 256; u.n0 = ntile * 256; u.cnt = min(256, cn - mt * 256); u.rbase = rs; return true; } };
struct ProbGu {
    static constexpr int NT = 16; static constexpr size_t KS2 = 256; static constexpr unsigned ROWB = 2048; static constexpr bool I8 = true;
    static constexpr bool PERM = true;
    const signed char* A; const signed char* Bt; unsigned char* act; const float* bgu; const int* list; const float* sa; const float* sw; MoeTab tab; int G, vcu;
    __device__ __forceinline__ bool next(int i, Unit& u) const { return tab.find(i * G + vcu, u); }
    __device__ __forceinline__ void a_offs(const Unit& u, const int (&R)[2], const int (&C2)[2], unsigned (&v)[2][2]) const {
#pragma unroll
        for (int h = 0; h < 2; ++h)
#pragma unroll
            for (int i = 0; i < 2; ++i) { int r = h * 128 + R[i]; r = r < u.cnt ? r : 0; const int a = list[(size_t)u.e * T_ + u.m0 + r]; v[h][i] = (unsigned)(a >> 2) * 2048u + (unsigned)C2[i]; } }
    __device__ __forceinline__ const char* a_base() const { return (const char*)A; }
    __device__ __forceinline__ const char* b_base(const Unit& u) const { return (const char*)(Bt + ((size_t)u.e * 4096 + u.n0) * 2048); }
    __device__ __forceinline__ void epi(const i32x4 (&acc)[2][2][4][2], const Unit& u, int wr, int wc, int fr, int fq, LAS unsigned char* lds) const {
        const float* bb = bgu + (size_t)u.e * 4096; const float* ss = sw + (size_t)u.e * 4096;
        LAS unsigned char* ep = lds + EP_OFF + wr * EP_GRP;
        const int tg = ep_tid() & 255, rrow = tg >> 4, ch = tg & 15;
        f32x4 b0[2], b1[2], s0[2], s1[2];
#pragma unroll
        for (int bj = 0; bj < 2; ++bj) { const int col = u.n0 + bj * 128 + wc * 32 + fq * 8;
            b0[bj] = *(const f32x4*)(bb + col); b1[bj] = *(const f32x4*)(bb + col + 4); s0[bj] = *(const f32x4*)(ss + col); s1[bj] = *(const f32x4*)(ss + col + 4); }
        float srv[8];
        { int av[8];
#pragma unroll
          for (int q = 0; q < 8; ++q) { const int rl = (q >> 2) * 128 + wr * 64 + (q & 3) * 16 + fr; av[q] = list[(size_t)u.e * T_ + u.m0 + (rl < u.cnt ? rl : 0)]; }
#pragma unroll
          for (int q = 0; q < 8; ++q) srv[q] = sa[av[q] >> 2]; }
        LAS unsigned char* ep2 = lds + EP_OFF + wr * (2 * 16 * 144);
#pragma unroll
        for (int ai = 0; ai < 2; ++ai)
#pragma unroll
            for (int mp = 0; mp < 2; ++mp) {
#pragma unroll
                for (int mm = 0; mm < 2; ++mm) { const int m = mp * 2 + mm; const float sr = srv[ai * 4 + m];
#pragma unroll
                    for (int bj = 0; bj < 2; ++bj) {
                        const i32x4 i0 = acc[ai][bj][m][0], i1 = acc[ai][bj][m][1];
                        const f32x4 v0 = (f32x4){(float)i0[0], (float)i0[1], (float)i0[2], (float)i0[3]} * (s0[bj] * sr) + b0[bj], v1 = (f32x4){(float)i1[0], (float)i1[1], (float)i1[2], (float)i1[3]} * (s1[bj] * sr) + b1[bj];
                        *(LAS unsigned*)(ep2 + (mm * 16 + fr) * 144 + (bj * 64 + wc * 16 + fq * 4)) = pk4_fp8(swiglu_fast(v0[0], v0[1]), swiglu_fast(v0[2], v0[3]), swiglu_fast(v1[0], v1[1]), swiglu_fast(v1[2], v1[3])); } }
                ep_sync();
#pragma unroll
                for (int mm = 0; mm < 2; ++mm) { const u32x2 x0 = *(const LAS u32x2*)(ep2 + (mm * 16 + rrow) * 144 + ch * 8);
                    const int rr = ai * 128 + wr * 64 + (mp * 2 + mm) * 16 + rrow;
                    if (rr < u.cnt) *(u32x2*)(act + (size_t)(u.rbase + u.m0 + rr) * 2048 + (u.n0 >> 1) + ch * 8) = x0; }
                ep_sync();
            } }
};
struct ProbDn {
    static constexpr int NT = 16; static constexpr size_t KS2 = 256; static constexpr unsigned ROWB = 2048; static constexpr bool I8 = true;
    static constexpr bool PERM = true;
    const signed char* A; const signed char* Bt; unsigned char* y; const float* bdn; const int* list; const float* gate; const float* sa; const float* sw; MoeTab tab; int G, vcu;
    __device__ __forceinline__ bool next(int i, Unit& u) const { return tab.find(i * G + vcu, u); }
    __device__ __forceinline__ void a_offs(const Unit& u, const int (&R)[2], const int (&C2)[2], unsigned (&v)[2][2]) const {
#pragma unroll
        for (int h = 0; h < 2; ++h)
#pragma unroll
            for (int i = 0; i < 2; ++i) v[h][i] = (unsigned)(u.rbase + u.m0 + h * 128 + R[i]) * 2048u + (unsigned)C2[i]; }
    __device__ __forceinline__ const char* a_base() const { return (const char*)A; }
    __device__ __forceinline__ const char* b_base(const Unit& u) const { return (const char*)(Bt + ((size_t)u.e * 2048 + u.n0) * 2048); }
    __device__ __forceinline__ void epi(const i32x4 (&acc)[2][2][4][2], const Unit& u, int wr, int wc, int fr, int fq, LAS unsigned char* lds) const {
        const float* bb = bdn + (size_t)u.e * 2048; const float* ss = sw + (size_t)u.e * 2048;
        LAS unsigned char* ep = lds + EP_OFF + wr * EP_GRP;
        const int tg = ep_tid() & 255, rrow = tg >> 4, ch = tg & 15;
        f32x4 b0[2], b1[2], s0[2], s1[2];
#pragma unroll
        for (int bj = 0; bj < 2; ++bj) { const int col = u.n0 + bj * 128 + wc * 32 + fq * 8;
            b0[bj] = *(const f32x4*)(bb + col); b1[bj] = *(const f32x4*)(bb + col + 4); s0[bj] = *(const f32x4*)(ss + col); s1[bj] = *(const f32x4*)(ss + col + 4); }
        float gv[8], srv[8]; int a2v[8];
        { int av[8];
#pragma unroll
          for (int q = 0; q < 8; ++q) { const int rl = (q >> 2) * 128 + wr * 64 + (q & 3) * 16 + fr, rc = rl < u.cnt ? rl : 0; av[q] = list[(size_t)u.e * T_ + u.m0 + rc]; srv[q] = sa[u.rbase + u.m0 + rc];
              const int rr = (q >> 2) * 128 + wr * 64 + (q & 3) * 16 + rrow; a2v[q] = list[(size_t)u.e * T_ + u.m0 + (rr < u.cnt ? rr : 0)]; }
#pragma unroll
          for (int q = 0; q < 8; ++q) gv[q] = gate[av[q]]; }
#pragma unroll
        for (int ai = 0; ai < 2; ++ai)
#pragma unroll
            for (int m = 0; m < 4; ++m) { const float g = gv[ai * 4 + m] * 16.f, sr = srv[ai * 4 + m];
#pragma unroll
                for (int bj = 0; bj < 2; ++bj) {
                    const i32x4 i0 = acc[ai][bj][m][0], i1 = acc[ai][bj][m][1];
                    const f32x4 v0 = ((f32x4){(float)i0[0], (float)i0[1], (float)i0[2], (float)i0[3]} * (s0[bj] * sr) + b0[bj]) * g, v1 = ((f32x4){(float)i1[0], (float)i1[1], (float)i1[2], (float)i1[3]} * (s1[bj] * sr) + b1[bj]) * g;
                    u32x2 o; o[0] = pk4_fp8(v0[0], v0[1], v0[2], v0[3]); o[1] = pk4_fp8(v1[0], v1[1], v1[2], v1[3]);
                    *(LAS u32x2*)(ep + fr * 272 + (bj * 128 + wc * 32 + fq * 8)) = o; }
                const int rr = ai * 128 + wr * 64 + m * 16 + rrow;
                const int a2 = a2v[ai * 4 + m];
                ep_sync();
                const u32x4 x0 = *(const LAS u32x4*)(ep + rrow * 272 + ch * 16);
                if (rr < u.cnt) *(u32x4*)(y + (size_t)a2 * 2048 + u.n0 + ch * 16) = x0;
                ep_sync();
            } }
};
}

namespace at8 {
typedef float f32x16 __attribute__((ext_vector_type(16)));
typedef short s16x4 __attribute__((ext_vector_type(4)));
typedef unsigned u32x4 __attribute__((ext_vector_type(4)));
constexpr int SHM_V = 64 * 128 * 2, SHM_K = 64 * 128 * 2;
constexpr int LDS_WS = 2 * SHM_V + 2 * SHM_K;
constexpr int LDS_END = LDS_WS + 8 * 64 * 4;
constexpr float CEXP = ATT_SCALE * 1.4426950408889634f;
constexpr float THR_RAW = 8.f / ATT_SCALE;
#define AT_KSWZ(row, colB) ((row) * 256 + ((colB) ^ (((row) & 7) << 4)))
#define AT_SBAR() __builtin_amdgcn_sched_barrier(0)
__device__ __forceinline__ int crow(int r, int hi) { return (r & 3) + 8 * (r >> 2) + 4 * hi; }
__device__ __forceinline__ unsigned cvtpk(float lo, float hi) { auto v = __builtin_amdgcn_cvt_pkrtz(lo, hi); return *reinterpret_cast<unsigned*>(&v); }
__device__ __forceinline__ int v_st(int k, int c) { const int kk = (k & ~0xC) | ((k & 4) << 1) | ((k & 8) >> 1); return ((kk >> 3) * 4 + (c >> 5)) * 512 + ((kk & 7) * 32 + (c & 31)) * 2; }
__device__ __forceinline__ int v_rd_base(int lane) { return ((lane & 3) << 3) | (((lane >> 2) & 3) << 6) | (((lane >> 4) & 1) << 5) | (((lane >> 5) & 1) << 8); }
constexpr int v_rd_off(int d0, int ks, int half) { return d0 * 512 + ks * 4096 + half * 2048; }
template <int OFF> __device__ __forceinline__ s16x4 tr_read(int vb) { s16x4 r; asm volatile("ds_read_b64_tr_b16 %0, %1 offset:%2" : "=&v"(r) : "v"(vb), "i"(OFF) : "memory"); return r; }
__device__ __forceinline__ h8 mk8(s16x4 l, s16x4 h) { typedef short s16x8 __attribute__((ext_vector_type(8))); s16x8 w = {l[0], l[1], l[2], l[3], h[0], h[1], h[2], h[3]}; return *reinterpret_cast<h8*>(&w); }
struct VFrag { s16x4 l0, h0, l1, h1, l2, h2, l3, h3; };
template <int D0> __device__ __forceinline__ void pv_read(VFrag& f, int vb) {
    f.l0 = tr_read<v_rd_off(D0, 0, 0)>(vb); f.h0 = tr_read<v_rd_off(D0, 0, 1)>(vb); f.l1 = tr_read<v_rd_off(D0, 1, 0)>(vb); f.h1 = tr_read<v_rd_off(D0, 1, 1)>(vb);
    f.l2 = tr_read<v_rd_off(D0, 2, 0)>(vb); f.h2 = tr_read<v_rd_off(D0, 2, 1)>(vb); f.l3 = tr_read<v_rd_off(D0, 3, 0)>(vb); f.h3 = tr_read<v_rd_off(D0, 3, 1)>(vb);
}
__device__ __forceinline__ void pv_mma(f32x16& od, const VFrag& f, h8 pa0, h8 pa1, h8 pa2, h8 pa3) {
    od = __builtin_amdgcn_mfma_f32_32x32x16_f16(pa0, mk8(f.l0, f.h0), od, 0, 0, 0);
    od = __builtin_amdgcn_mfma_f32_32x32x16_f16(pa1, mk8(f.l1, f.h1), od, 0, 0, 0);
    od = __builtin_amdgcn_mfma_f32_32x32x16_f16(pa2, mk8(f.l2, f.h2), od, 0, 0, 0);
    od = __builtin_amdgcn_mfma_f32_32x32x16_f16(pa3, mk8(f.l3, f.h3), od, 0, 0, 0);
}
__device__ __forceinline__ void pv_d0(f32x16 (&o)[4], int vb, h8 pa0, h8 pa1, h8 pa2, h8 pa3) {
    VFrag fa, fb;
    pv_read<0>(fa, vb); pv_read<1>(fb, vb);
    asm volatile("s_waitcnt lgkmcnt(8)" ::: "memory"); AT_SBAR();
    pv_mma(o[0], fa, pa0, pa1, pa2, pa3); AT_SBAR();
    pv_read<2>(fa, vb);
    asm volatile("s_waitcnt lgkmcnt(8)" ::: "memory"); AT_SBAR();
    pv_mma(o[1], fb, pa0, pa1, pa2, pa3); AT_SBAR();
    pv_read<3>(fb, vb);
    asm volatile("s_waitcnt lgkmcnt(8)" ::: "memory"); AT_SBAR();
    pv_mma(o[2], fa, pa0, pa1, pa2, pa3); AT_SBAR();
    asm volatile("s_waitcnt lgkmcnt(0)" ::: "memory"); AT_SBAR();
    pv_mma(o[3], fb, pa0, pa1, pa2, pa3);
}
__device__ __forceinline__ void qkt(f32x16& p0, f32x16& p1, const char* Ks, const h8 (&qr)[8], int r32, int hi) {
    p0 = f32x16{}; p1 = f32x16{};
#pragma unroll
    for (int d0 = 0; d0 < 8; ++d0) { const int cb = (d0 * 16 + hi * 8) * 2;
        const h8 b0 = *reinterpret_cast<const h8*>(Ks + AT_KSWZ(r32, cb));
        const h8 b1 = *reinterpret_cast<const h8*>(Ks + AT_KSWZ(32 + r32, cb));
        p0 = __builtin_amdgcn_mfma_f32_32x32x16_f16(b0, qr[d0], p0, 0, 0, 0);
        p1 = __builtin_amdgcn_mfma_f32_32x32x16_f16(b1, qr[d0], p1, 0, 0, 0); }
}
__device__ __forceinline__ void pack_p(const f32x16& p0, const f32x16& p1, h8& pa0, h8& pa1, h8& pa2, h8& pa3) {
#define AT_PK4(P, BASE, OUT) do { unsigned a0 = cvtpk(P[BASE + 0], P[BASE + 1]), a1 = cvtpk(P[BASE + 2], P[BASE + 3]); \
    unsigned b0 = cvtpk(P[BASE + 4], P[BASE + 5]), b1 = cvtpk(P[BASE + 6], P[BASE + 7]); \
    auto r0 = __builtin_amdgcn_permlane32_swap(a0, b0, false, false); auto r1 = __builtin_amdgcn_permlane32_swap(a1, b1, false, false); \
    u32x4 w = {r0[0], r1[0], r0[1], r1[1]}; OUT = *reinterpret_cast<h8*>(&w); } while (0)
    AT_PK4(p0, 0, pa0); AT_PK4(p0, 8, pa1); AT_PK4(p1, 0, pa2); AT_PK4(p1, 8, pa3);
#undef AT_PK4
}
__device__ __forceinline__ float half_swap_max(float v) { auto rr = __builtin_amdgcn_permlane32_swap(__float_as_uint(v), __float_as_uint(v), false, false); return fmaxf(__uint_as_float(rr[0]), __uint_as_float(rr[1])); }
__device__ __forceinline__ float half_swap_sum(float v) { auto rr = __builtin_amdgcn_permlane32_swap(__float_as_uint(v), __float_as_uint(v), false, false); return __uint_as_float(rr[0]) + __uint_as_float(rr[1]); }

struct Stage4 { h8 vs0, vs1, ks0, ks1; };
__device__ __forceinline__ int hidden_tid() { int tz = threadIdx.x; asm volatile("" : "+v"(tz)); return tz; }
__device__ __forceinline__ void sload(Stage4& s, const _Float16* Kb, const _Float16* Vb, int ld, int k0) {
    const int tz = hidden_tid(), sr = tz >> 4, sc = (tz & 15) * 8;
    s.vs0 = *(const h8*)(Vb + (size_t)(k0 + sr) * ld + sc); s.vs1 = *(const h8*)(Vb + (size_t)(k0 + 32 + sr) * ld + sc);
    s.ks0 = *(const h8*)(Kb + (size_t)(k0 + sr) * ld + sc); s.ks1 = *(const h8*)(Kb + (size_t)(k0 + 32 + sr) * ld + sc);
}
__device__ __forceinline__ void swrite(const Stage4& s, char* V_lds, char* K_lds, int b) {
    const int tz = hidden_tid(), sr = tz >> 4, sc = (tz & 15) * 8, vst0 = v_st(sr, sc), vst1 = v_st(32 + sr, sc);
    *(h8*)(V_lds + b * SHM_V + vst0) = s.vs0; *(h8*)(V_lds + b * SHM_V + vst1) = s.vs1;
    const int kc = sc * 2;
    *(h8*)(K_lds + b * SHM_K + AT_KSWZ(sr, kc)) = s.ks0; *(h8*)(K_lds + b * SHM_K + AT_KSWZ(32 + sr, kc)) = s.ks1;
}

__device__ __forceinline__ void attn_unit(char* lds, const _Float16* qrow, const _Float16* Kb, const _Float16* Vb, int ld, unsigned tmask, int wlen, int khi, unsigned selmask,
                                          _Float16* outw, int ostride) {
    const int tid = threadIdx.x, wid = __builtin_amdgcn_readfirstlane(tid >> 6), lane = tid & 63, r32 = lane & 31, hi = lane >> 5;
    char* V_lds = lds; char* K_lds = lds + 2 * SHM_V;
    float* wsf = (float*)(lds + LDS_WS) + wid * 64; float* li_l = wsf; float* al_l = wsf + 32;
    float m_reg = -1e30f, l_reg = 0.f; f32x16 o[4] = {}; h8 qr[8];
#pragma unroll
    for (int d0 = 0; d0 < 8; ++d0) qr[d0] = *(const h8*)(qrow + d0 * 16);
    const int vb0 = (int)(uintptr_t)V_lds + v_rd_base(lane);
    Stage4 st;
    unsigned rest = tmask; int j = __ffs(rest) - 1; rest &= rest - 1;
    sload(st, Kb, Vb, ld, j * 64); asm volatile("s_waitcnt vmcnt(0)" ::: "memory"); swrite(st, V_lds, K_lds, 0); __syncthreads();
    int buf = 0;
    for (;;) {
        const int jn = rest ? (__ffs(rest) - 1) : -1;
        if (jn >= 0) sload(st, Kb, Vb, ld, jn * 64);
        f32x16 p0, p1;
        AT_SBAR(); qkt(p0, p1, K_lds + buf * SHM_K, qr, r32, hi);
        { const int klo = wlen > 0 ? khi - wlen + 1 : 0; const bool tb = (selmask >> j) & 1u; const bool inr = (j * 64 >= klo) && (j * 64 + 63 <= khi);
          if (!__all(tb && inr)) {
              if (__all(inr)) {
#pragma unroll
                  for (int r = 0; r < 16; ++r) { p0[r] = tb ? p0[r] : -INFINITY; p1[r] = tb ? p1[r] : -INFINITY; }
              } else {
                  const int kb = j * 64 + 4 * hi;
#pragma unroll
                  for (int r = 0; r < 16; ++r) { const int k0 = kb + (r & 3) + 8 * (r >> 2);
                      p0[r] = (tb && k0 >= klo && k0 <= khi) ? p0[r] : -INFINITY;
                      p1[r] = (tb && (k0 + 32) >= klo && (k0 + 32) <= khi) ? p1[r] : -INFINITY; }
              } } }
        float pmax = p0[0];
#pragma unroll
        for (int r = 1; r < 16; ++r) pmax = fmaxf(pmax, p0[r]);
#pragma unroll
        for (int r = 0; r < 16; ++r) pmax = fmaxf(pmax, p1[r]);
        pmax = half_swap_max(pmax);
        float mn, alpha;
        if (__all(pmax - m_reg <= THR_RAW)) { mn = m_reg; alpha = 1.f; }
        else { mn = fmaxf(m_reg, pmax); alpha = __builtin_amdgcn_exp2f((m_reg - mn) * CEXP); m_reg = mn; }
        const float mnC = -mn * CEXP;
        float ps = 0.f;
#pragma unroll
        for (int r = 0; r < 16; ++r) { p0[r] = __builtin_amdgcn_exp2f(fmaf(p0[r], CEXP, mnC)); ps += p0[r]; }
#pragma unroll
        for (int r = 0; r < 16; ++r) { p1[r] = __builtin_amdgcn_exp2f(fmaf(p1[r], CEXP, mnC)); ps += p1[r]; }
        ps = half_swap_sum(ps);
        l_reg = l_reg * alpha + ps;
        if (__any(alpha < 1.f)) { if (hi == 0) al_l[r32] = alpha; asm volatile("s_waitcnt lgkmcnt(0)" ::: "memory");
#pragma unroll
            for (int r = 0; r < 16; ++r) { const float a = al_l[crow(r, hi)];
#pragma unroll
                for (int d = 0; d < 4; ++d) o[d][r] *= a; } }
        h8 pa0, pa1, pa2, pa3; pack_p(p0, p1, pa0, pa1, pa2, pa3);
        AT_SBAR();
        pv_d0(o, vb0 + buf * SHM_V, pa0, pa1, pa2, pa3);
        if (jn < 0) break;
        asm volatile("s_waitcnt vmcnt(0)" ::: "memory");
        swrite(st, V_lds, K_lds, buf ^ 1);
        __syncthreads();
        buf ^= 1; j = jn; rest &= rest - 1;
    }
    if (hi == 0) li_l[r32] = l_reg; asm volatile("s_waitcnt lgkmcnt(0)" ::: "memory");
#pragma unroll
    for (int r = 0; r < 16; ++r) { const int orow = crow(r, hi); const float l = li_l[orow]; const float rl = l > 0.f ? 1.f / l : 0.f;
#pragma unroll
        for (int d0 = 0; d0 < 4; ++d0) outw[(size_t)orow * ostride + d0 * 32 + r32] = (_Float16)(o[d0][r] * rl); }
    __syncthreads();
}

constexpr int LDS_AP = LDS_END, LDS_BP = LDS_AP + 4 * 64 * 33 * 4, LDS_SELM = LDS_BP + 4 * 64 * 33 * 4, LDS_CS_END = LDS_SELM + 64 * 4;
__device__ __forceinline__ void cmp_slc_unit(char* lds, const _Float16* qrow, const _Float16* Kc, const _Float16* Vc, const _Float16* Ks, const _Float16* Vs, int t, int tl, int g, int qi,
                                             _Float16* outc, _Float16* outs) {
    const int tid = threadIdx.x, wid = __builtin_amdgcn_readfirstlane(tid >> 6), lane = tid & 63, r32 = lane & 31, hi = lane >> 5;
    char* V_lds = lds; char* K_lds = lds + 2 * SHM_V;
    float* AP = (float*)(lds + LDS_AP); float* BP = (float*)(lds + LDS_BP); unsigned* selm = (unsigned*)(lds + LDS_SELM);
    {
        h8 qr[8];
#pragma unroll
        for (int d0 = 0; d0 < 8; ++d0) qr[d0] = *(const h8*)(qrow + d0 * 16);
        const int vb0 = (int)(uintptr_t)V_lds + v_rd_base(lane);
        { Stage4 s0, s1; sload(s0, Kc, Vc, 256, 0); sload(s1, Kc, Vc, 256, 64);
          asm volatile("s_waitcnt vmcnt(0)" ::: "memory");
          swrite(s0, V_lds, K_lds, 0); swrite(s1, V_lds, K_lds, 1); }
        __syncthreads();
        f32x16 pA0, pA1, pB0, pB1;
        AT_SBAR(); qkt(pA0, pA1, K_lds, qr, r32, hi); qkt(pB0, pB1, K_lds + SHM_K, qr, r32, hi);
        const int khi = t >= 31 ? ((t - 31) >> 4) : -1;
#pragma unroll
        for (int r = 0; r < 16; ++r) { const int c0 = 4 * hi + (r & 3) + 8 * (r >> 2);
            pA0[r] = (c0 <= khi) ? pA0[r] : -INFINITY; pA1[r] = (c0 + 32 <= khi) ? pA1[r] : -INFINITY;
            pB0[r] = (c0 + 64 <= khi) ? pB0[r] : -INFINITY; pB1[r] = (c0 + 96 <= khi) ? pB1[r] : -INFINITY; }
        float pmax = -INFINITY;
#pragma unroll
        for (int r = 0; r < 16; ++r) pmax = fmaxf(fmaxf(pmax, pA0[r]), fmaxf(pA1[r], fmaxf(pB0[r], pB1[r])));
        pmax = half_swap_max(pmax);
        const float mC = (pmax == -INFINITY) ? 0.f : -pmax * CEXP;
        float ps = 0.f;
#pragma unroll
        for (int r = 0; r < 16; ++r) { pA0[r] = __builtin_amdgcn_exp2f(fmaf(pA0[r], CEXP, mC)); pA1[r] = __builtin_amdgcn_exp2f(fmaf(pA1[r], CEXP, mC));
            pB0[r] = __builtin_amdgcn_exp2f(fmaf(pB0[r], CEXP, mC)); pB1[r] = __builtin_amdgcn_exp2f(fmaf(pB1[r], CEXP, mC)); ps += (pA0[r] + pA1[r]) + (pB0[r] + pB1[r]); }
        ps = half_swap_sum(ps);
        const float inv = ps > 0.f ? 1.f / ps : 0.f;
#pragma unroll
        for (int r = 0; r < 16; ++r) { pA0[r] *= inv; pA1[r] *= inv; pB0[r] *= inv; pB1[r] *= inv; }
        { float* ap = AP + (g * 64 + tl) * 33; float* bp = BP + (g * 64 + tl) * 33;
          if (hi == 0) bp[0] = 0.f;
#define AT_IMP(P, JB) do { _Pragma("unroll") for (int k = 0; k < 4; ++k) { const int j = (JB) + 2 * k + hi; \
              ap[j] = 2.f * (P[4 * k] + P[4 * k + 1] + P[4 * k + 2]) + P[4 * k + 3]; if (j + 1 < 32) bp[j + 1] = P[4 * k + 3]; } } while (0)
          AT_IMP(pA0, 0); AT_IMP(pA1, 8); AT_IMP(pB0, 16); AT_IMP(pB1, 24);
#undef AT_IMP
        }
        f32x16 o[4] = {};
        h8 pa0, pa1, pa2, pa3;
        pack_p(pA0, pA1, pa0, pa1, pa2, pa3); AT_SBAR(); pv_d0(o, vb0, pa0, pa1, pa2, pa3);
        pack_p(pB0, pB1, pa0, pa1, pa2, pa3); AT_SBAR(); pv_d0(o, vb0 + SHM_V, pa0, pa1, pa2, pa3);
#pragma unroll
        for (int r = 0; r < 16; ++r) { const int orow = crow(r, hi);
#pragma unroll
            for (int d0 = 0; d0 < 4; ++d0) outc[(size_t)orow * 1024 + d0 * 32 + r32] = (_Float16)o[d0][r]; }
    }
    __syncthreads();
#pragma unroll 1
    for (int it = 0; it < 4; ++it) {
        const int tk = 8 * wid + 2 * it + hi, j = r32;
        float imp = 0.f;
#pragma unroll
        for (int gg = 0; gg < 4; ++gg) imp += AP[(gg * 64 + tk) * 33 + j] + BP[(gg * 64 + tk) * 33 + j];
        const bool forced = (j == 0) || (j == qi) || (j == qi - 1), valid = j <= qi;
        const float iv = forced ? 1e9f : (valid ? imp : -1e9f);
        int rank = 0;
        for (int i = 0; i < 32; ++i) { const float vi = __shfl(iv, i + 32 * hi); rank += (vi > iv || (vi == iv && i < j)) ? 1 : 0; }
        const unsigned long long bal = __ballot(rank < 16 && valid);
        if (r32 == 0) selm[tk] = (unsigned)(bal >> (32 * hi));
    }
    __syncthreads();
    unsigned tm = selm[lane];
#pragma unroll
    for (int o = 32; o > 0; o >>= 1) tm |= __shfl_xor(tm, o);
    const int tz2 = hidden_tid();
    const unsigned mysel = selm[((tz2 >> 6) & 1) * 32 + (tz2 & 31)];
    attn_unit(lds, qrow, Ks, Vs, 128, tm, 0, t, mysel, outs, 1024);
}
}

struct CUnit { const float* W; int ldw; int nvalid; _Float16* Wt; int k0; int n0; };
__device__ __forceinline__ CUnit conv_desc(int u, const float* win, const float* w1k, const float* w1v, const float* wmkv, _Float16* wtin, _Float16* wt1, _Float16* wtmkv) {
    CUnit d;
    if (u < 480) { d.W = win; d.ldw = INW; d.nvalid = INW; d.Wt = wtin; d.k0 = (u / 15) * 64; d.n0 = (u % 15) * 256; }
    else if (u < 608) { const int v = u - 480, kv = v >> 6, part = (v >> 5) & 1, kt = v & 31;
        d.W = (kv ? w1v : w1k) + (size_t)part * 2048 * 256; d.ldw = 256; d.nvalid = 256; d.Wt = wt1 + ((size_t)kv * 512 + part * 256) * 2048; d.k0 = kt * 64; d.n0 = 0; }
    else { const int v = u - 608; d.W = wmkv; d.ldw = 1024; d.nvalid = 1024; d.Wt = wtmkv; d.k0 = (v >> 2) * 64; d.n0 = (v & 3) * 256; }
    return d;
}
__device__ __forceinline__ void conv_all(float* lds, const float* win, const float* w1k, const float* w1v, const float* wmkv, _Float16* wtin, _Float16* wt1, _Float16* wtmkv, int bid, int nb) {
    constexpr int NU = 480 + 128 + 128;
    const int tid = threadIdx.x;
    int u = bid; if (u >= NU) return;
    CUnit d = conv_desc(u, win, w1k, w1v, wmkv, wtin, wt1, wtmkv);
    float4 v[8];
#define CL(D) do { _Pragma("unroll") for (int i = 0; i < 8; ++i) { const int idx = tid + 512 * i, r = idx >> 6, c4 = (idx & 63) * 4; \
        v[i] = ((D).n0 + c4 < (D).nvalid) ? *(const float4*)((D).W + (size_t)((D).k0 + r) * (D).ldw + (D).n0 + c4) : make_float4(0.f, 0.f, 0.f, 0.f); } } while (0)
    CL(d);
    for (;;) {
#pragma unroll
        for (int i = 0; i < 8; ++i) { const int idx = tid + 512 * i, r = idx >> 6, c4 = (idx & 63) * 4; float* dd = lds + r * 257 + c4; dd[0] = v[i].x; dd[1] = v[i].y; dd[2] = v[i].z; dd[3] = v[i].w; }
        __syncthreads();
        const int un = u + nb; const bool has = un < NU;
        CUnit dn = d; if (has) { dn = conv_desc(un, win, w1k, w1v, wmkv, wtin, wt1, wtmkv); CL(dn); }
#pragma unroll
        for (int j = 0; j < 4; ++j) { const int id = tid + 512 * j, n = id >> 3, k8 = (id & 7) * 8; h8 o;
#pragma unroll
            for (int q = 0; q < 8; ++q) o[q] = (_Float16)lds[(k8 + q) * 257 + n];
            *(h8*)(d.Wt + (size_t)(d.n0 + n) * 2048 + d.k0 + k8) = o; }
        __syncthreads();
        if (!has) break;
        u = un; d = dn;
    }
#undef CL
}

__device__ __forceinline__ unsigned pack4_i8(float a, float b, float c, float d) {
    const int ia = __float2int_rn(a), ib = __float2int_rn(b), ic = __float2int_rn(c), id = __float2int_rn(d);
    return (unsigned)(ia & 255) | ((unsigned)(ib & 255) << 8) | ((unsigned)(ic & 255) << 16) | ((unsigned)(id & 255) << 24);
}
constexpr int QP_LD2 = 1026;
struct QUnit { const float* W; int ldw; int n0; signed char* Q; float* sc; };
__device__ __forceinline__ QUnit quant_desc(int u, const float* wgu, const float* wdn, signed char* q8gu, signed char* q8dn, float* sgu, float* sdn, const float* wout, signed char* q8out, float* sout) {
    QUnit d;
    if (u >= NE * 192) { const int pn = u - NE * 192; d.W = wout; d.ldw = 2048; d.n0 = pn * 32; d.Q = q8out; d.sc = sout; }
    else if (u < NE * 128) { const int e = u >> 7, pn = u & 127; d.W = wgu + (size_t)e * 2048 * 4096; d.ldw = 4096; d.n0 = pn * 32; d.Q = q8gu + (size_t)e * 4096 * 2048; d.sc = sgu + (size_t)e * 4096; }
    else { const int v = u - NE * 128, e = v >> 6, pn = v & 63; d.W = wdn + (size_t)e * 2048 * 2048; d.ldw = 2048; d.n0 = pn * 32; d.Q = q8dn + (size_t)e * 2048 * 2048; d.sc = sdn + (size_t)e * 2048; }
    return d;
}
__device__ __forceinline__ unsigned pk2h(float a, float b) { auto v = __builtin_amdgcn_cvt_pkrtz(a, b); return *reinterpret_cast<unsigned*>(&v); }
__device__ __forceinline__ void quant_all(char* smem, const float* wgu, const float* wdn, signed char* q8gu, signed char* q8dn, float* sgu, float* sdn, const float* wout, signed char* q8out, float* sout, int bid, int nb) {
    constexpr int NU = NE * 128 + NE * 64 + 64;
    unsigned* cmaxb = (unsigned*)smem;
    const int tid = threadIdx.x, c4 = (tid & 7) * 4, rg = tid >> 3;
    if (tid < 64) cmaxb[tid] = 0u;
    __syncthreads();
    int u = bid; if (u >= NU) return;
    QUnit d = quant_desc(u, wgu, wdn, q8gu, q8dn, sgu, sdn, wout, q8out, sout);
    float4 va[16], vb[16], vc[16];
#define QL(dst, D, half) do { const float* p0 = (D).W + (size_t)((half) * 1024 + rg * 16) * (D).ldw + (D).n0 + c4; _Pragma("unroll") for (int j = 0; j < 16; ++j) dst[j] = *(const float4*)(p0 + (size_t)j * (D).ldw); } while (0)
#define QM(src) do { _Pragma("unroll") for (int j = 0; j < 16; ++j) { m0 = fmaxf(m0, fabsf(src[j].x)); m1 = fmaxf(m1, fabsf(src[j].y)); m2 = fmaxf(m2, fabsf(src[j].z)); m3 = fmaxf(m3, fabsf(src[j].w)); } } while (0)
#define QS(src, half, comp, ci, inv) do { uint4 o; \
        o.x = pack4_i8(src[0].comp * inv, src[1].comp * inv, src[2].comp * inv, src[3].comp * inv); o.y = pack4_i8(src[4].comp * inv, src[5].comp * inv, src[6].comp * inv, src[7].comp * inv); \
        o.z = pack4_i8(src[8].comp * inv, src[9].comp * inv, src[10].comp * inv, src[11].comp * inv); o.w = pack4_i8(src[12].comp * inv, src[13].comp * inv, src[14].comp * inv, src[15].comp * inv); \
        *(uint4*)(d.Q + (size_t)(d.n0 + c4 + (ci)) * 2048 + (half) * 1024 + rg * 16) = o; } while (0)
    QL(va, d, 0);
    int par = 0;
    for (;;) {
        unsigned* cmax = cmaxb + par * 32;
        float m0 = 0.f, m1 = 0.f, m2 = 0.f, m3 = 0.f;
        QL(vb, d, 1);
        QM(va); QM(vb);
        atomicMax(&cmax[c4 + 0], __float_as_uint(m0)); atomicMax(&cmax[c4 + 1], __float_as_uint(m1)); atomicMax(&cmax[c4 + 2], __float_as_uint(m2)); atomicMax(&cmax[c4 + 3], __float_as_uint(m3));
        __syncthreads();
        const int un = u + nb; const bool has = un < NU;
        QUnit dn = d; if (has) { dn = quant_desc(un, wgu, wdn, q8gu, q8dn, sgu, sdn, wout, q8out, sout); QL(vc, dn, 0); }
        if (tid < 32) cmaxb[(par ^ 1) * 32 + tid] = 0u;
        const float x0 = __uint_as_float(cmax[c4 + 0]), x1 = __uint_as_float(cmax[c4 + 1]), x2 = __uint_as_float(cmax[c4 + 2]), x3 = __uint_as_float(cmax[c4 + 3]);
        const float i0 = x0 > 0.f ? 127.f / x0 : 0.f, i1 = x1 > 0.f ? 127.f / x1 : 0.f, i2 = x2 > 0.f ? 127.f / x2 : 0.f, i3 = x3 > 0.f ? 127.f / x3 : 0.f;
        QS(va, 0, x, 0, i0); QS(va, 0, y, 1, i1); QS(va, 0, z, 2, i2); QS(va, 0, w, 3, i3);
        QS(vb, 1, x, 0, i0); QS(vb, 1, y, 1, i1); QS(vb, 1, z, 2, i2); QS(vb, 1, w, 3, i3);
        if (tid < 32) { const float mx = __uint_as_float(cmax[tid]); d.sc[d.n0 + tid] = mx > 0.f ? mx / 127.f : 1.f; }
        if (!has) break;
#pragma unroll
        for (int j = 0; j < 16; ++j) va[j] = vc[j];
        u = un; d = dn; par ^= 1;
        __syncthreads();
    }
    __syncthreads();
#undef QL
#undef QM
#undef QS
}

__global__ void __launch_bounds__(512, 2) fwd(Params p) {
    extern __shared__ __attribute__((aligned(16))) char smem[];
    const int tid = threadIdx.x, wv = __builtin_amdgcn_readfirstlane(tid >> 6);
#define LANE_NOW ({ int _t = threadIdx.x; asm volatile("" : "+v"(_t)); _t & 63; })
    const int bid = blockIdx.x, nb = gridDim.x;
    const int gw = bid * 8 + wv, nw = nb * 8;
    const int lo = (int)(p.lo_hi & 0xffffffffll), hi = (int)(p.lo_hi >> 32);
    unsigned char* ws = p.ws;
    unsigned* ctl = (unsigned*)(ws + WS_CTL);
    int* cnt = (int*)(ws + CTL_CNT);
    float* proj = (float*)(ws + WS_PROJ);
    float* kvmem = (float*)(ws + WS_KVMEM);
    float* bias1 = (float*)(ws + WS_BIAS1);
    float* hid = (float*)(ws + WS_HID);
    float* kc = (float*)(ws + WS_KC);
    float* vc = (float*)(ws + WS_VC);
    float* pooled = (float*)(ws + WS_POOLED);
    _Float16* opool = (_Float16*)(ws + WS_OPOOL);
    _Float16* owin = (_Float16*)(ws + WS_OWIN);
    _Float16* ocmp = (_Float16*)(ws + WS_OCMP);
    _Float16* oslc = (_Float16*)(ws + WS_OSLC);
    unsigned* sel = (unsigned*)(ws + WS_SEL);
    _Float16* omem = (_Float16*)(ws + WS_OMEM);
    _Float16* cat16 = (_Float16*)(ws + WS_CAT16);
    _Float16* hpre16 = (_Float16*)(ws + WS_HPRE);
    float* hbuf = (float*)(ws + WS_H);
    float* gate = (float*)(ws + WS_GATE);
    int* list = (int*)(ws + WS_LIST);
    unsigned char* actf8 = (unsigned char*)(ws + WS_ACT16);
    unsigned char* yf8 = (unsigned char*)(ws + WS_Y16);
    _Float16* h16 = (_Float16*)(ws + WS_H16);
    _Float16* x16 = (_Float16*)(ws + WS_X16);
    _Float16* wtin = (_Float16*)(ws + WS_WTIN);
    _Float16* wtout = (_Float16*)(ws + WS_WTOUT);
    _Float16* wtgu = (_Float16*)(ws + WS_WTGU);
    _Float16* wtdn = (_Float16*)(ws + WS_WTDN);
    LAS unsigned char* lds = (LAS unsigned char*)smem;
    _Float16* proj16 = (_Float16*)(ws + WS_PROJ16);
    _Float16* kvmem16 = (_Float16*)(ws + WS_KVMEM16);
    _Float16* wt1 = (_Float16*)(ws + WS_WT1);
    float* uv = (float*)(ws + WS_UV);
    _Float16* kc16 = (_Float16*)(ws + WS_KC16);
    _Float16* vc16 = (_Float16*)(ws + WS_VC16);
    _Float16* wr16 = (_Float16*)(ws + WS_WR16);
    _Float16* mem16 = (_Float16*)(ws + WS_MEM16);
    _Float16* wtmkv = (_Float16*)(ws + WS_WTMKV);
    _Float16* kv16 = (_Float16*)(ws + WS_KV16);
    signed char* q8out = (signed char*)(ws + WS_Q8OUT); float* sout = (float*)(ws + WS_SOUT); signed char* cat8 = (signed char*)(ws + WS_CAT8); float* scat = (float*)(ws + WS_SCAT);
    signed char* q8gu = (signed char*)(ws + WS_Q8GU); signed char* q8dn = (signed char*)(ws + WS_Q8DN);
    float* sgu = (float*)(ws + WS_SGU); float* sdn = (float*)(ws + WS_SDN);
    signed char* h8q = (signed char*)(ws + WS_H8); float* sah = (float*)(ws + WS_SAH);
    signed char* act8 = (signed char*)(ws + WS_ACT8); float* sact = (float*)(ws + WS_SACT);
    const int vcu = (nb % 8 == 0) ? (bid % 8) * (nb / 8) + bid / 8 : bid;

    volatile LAS unsigned* xbw = (volatile LAS unsigned*)(smem + LDS_BYTES - 16);
    if (tid == 0) { xbw[0] = 0u; xbw[1] = 0u; xbw[2] = 0u; xbw[3] = 0u; }
    __syncthreads();
    XcdBarrier bar; bar.bar = ctl; bar.x = 0; bar.st = xbw;
    const bool multi = (hi - lo) > 1;
    if (multi) bar = xcd_barrier_post(ctl, xbw);
#define IN(k) (lo <= (k) && (k) < hi)
#define SEAM(k) do { if (IN(k) && IN((k) + 1)) xcd_barrier(bar); } while (0)
    float* sw = (float*)smem + wv * WLDS_FLOATS;
    int* segw = (int*)(sw + 4096 + 512);

    if (IN(0)) {
        const int lane = LANE_NOW; (void)lane;
        if (wv == 0 && (bid & 1) == 0 && (bid >> 1) < 128) {
            const int task = bid >> 1, kv = task >> 6, jg = (task >> 4) & 3, kc = task & 15;
            const float* pos = p.in[kv ? I_POSV : I_POSK] + kc * 256; const float* w1 = p.in[kv ? I_W1V : I_W1K] + (size_t)kc * 256 * 256 + jg * 64 + lane;
            float s0 = 0.f, s1 = 0.f, s2 = 0.f, s3 = 0.f;
            for (int k = 0; k < 256; k += 4) { s0 += pos[k] * w1[(size_t)k * 256]; s1 += pos[k + 1] * w1[(size_t)(k + 1) * 256]; s2 += pos[k + 2] * w1[(size_t)(k + 2) * 256]; s3 += pos[k + 3] * w1[(size_t)(k + 3) * 256]; }
            bias1[(kv * 16 + kc) * 256 + jg * 64 + lane] = (s0 + s1) + (s2 + s3);
        }
        for (int i = bid * 512 + tid; i < 32 * 2048; i += nb * 512) { const int e = i >> 11, d = i & 2047; wr16[i] = (_Float16)p.in[I_WR][(size_t)d * 32 + e]; }
        for (size_t i = (size_t)bid * 512 + tid; i < (size_t)T_ * 2048 / 4; i += (size_t)nb * 512) {
            const float4 v = ((const float4*)p.in[I_X])[i]; ((h4*)x16)[i] = (h4){(_Float16)v.x, (_Float16)v.y, (_Float16)v.z, (_Float16)v.w};
        }
        {
            quant_all(smem, p.in[I_WGU], p.in[I_WDN], q8gu, q8dn, sgu, sdn, p.in[I_WOUT], q8out, sout, bid, nb);
            __syncthreads();
            conv_all((float*)smem, p.in[I_WIN], p.in[I_W1K], p.in[I_W1V], p.in[I_WMEMKV], wtin, wt1, wtmkv, bid, nb);
            __syncthreads();
        }
        for (size_t i = (size_t)bid * 512 + tid; i < (size_t)2048 * 2048 / 4; i += (size_t)nb * 512) {
            const float4 v = ((const float4*)p.in[I_MEM])[i]; ((h4*)mem16)[i] = (h4){(_Float16)v.x, (_Float16)v.y, (_Float16)v.z, (_Float16)v.w};
        }
    }
    SEAM(0);
    if (IN(1)) {
        const int lane = LANE_NOW; (void)lane;
        g8::ProbIn P{x16, proj16, nb, bid};
        g8::gemm_phase(lds, P);
    }
    SEAM(1);
    if (IN(2)) {
        const int lane = LANE_NOW; (void)lane;
        { g8::ProbCmp P{kv16, wt1, uv, nb, bid}; g8::gemm_phase(lds, P); __syncthreads(); }
        for (int i = bid * 512 + tid; i < T_ * 64; i += nb * 512) {
            const int chn = i & 63, row = i >> 6, t = row & (S_ - 1), g = chn >> 4;
            const int win = 2 << g, n = min(win, t + 1);
            const _Float16* src = proj16 + (size_t)row * INW + C_UP + chn * 8;
            float a[8];
            const h8 cur = *(const h8*)src;
#pragma unroll
            for (int q = 0; q < 8; ++q) a[q] = (float)cur[q];
            for (int k = 1; k < n; ++k) { const h8 v = *(const h8*)(src - (size_t)k * INW);
#pragma unroll
                for (int q = 0; q < 8; ++q) a[q] += (float)v[q]; }
            const float rn = 1.f / (float)n;
            float4 o0, o1;
            o0.x = a[0] * rn - (float)cur[0]; o0.y = a[1] * rn - (float)cur[1]; o0.z = a[2] * rn - (float)cur[2]; o0.w = a[3] * rn - (float)cur[3];
            o1.x = a[4] * rn - (float)cur[4]; o1.y = a[5] * rn - (float)cur[5]; o1.z = a[6] * rn - (float)cur[6]; o1.w = a[7] * rn - (float)cur[7];
            *(float4*)(pooled + (size_t)row * 512 + chn * 8) = o0; *(float4*)(pooled + (size_t)row * 512 + chn * 8 + 4) = o1;
        }
        {
            const int r32 = lane & 31, hi = lane >> 5, g = wv >> 1, half = wv & 1;
            for (int uu = vcu; uu < 512; uu += nb) {
                const int v = uu & 255, bk = v >> 4, qi = (uu >> 8) ? 31 - (v & 15) : (v & 15), b = bk >> 1, kvh = bk & 1;
                const int t = qi * 64 + half * 32 + r32;
                const int lo_t = max(0, qi - 8);
                const unsigned tmask = (unsigned)(((1ull << (qi + 1)) - 1ull) & ~((1ull << lo_t) - 1ull));
                at8::attn_unit(smem, proj16 + (size_t)(b * S_ + t) * INW + C_Q + (kvh * 4 + g) * 128 + hi * 8,
                               kv16 + ((size_t)(4 * B_ + b) * 2 + kvh) * KVSEG, kv16 + ((size_t)(5 * B_ + b) * 2 + kvh) * KVSEG, 128, tmask, 512, t, 0xffffffffu,
                               owin + (size_t)(b * S_ + qi * 64 + half * 32) * 1024 + (kvh * 4 + g) * 128, 1024);
            }
            for (int u = vcu; u < 256; u += nb) {
                const int b = u >> 5, h = (u >> 3) & 3, qt = u & 7;
                const int t = qt * 256 + wv * 32 + r32;
                at8::attn_unit(smem, proj16 + (size_t)(b * S_ + t) * INW + C_QM + h * 128 + hi * 8,
                               kvmem16 + (size_t)b * 256 * 1024 + h * 128, kvmem16 + (size_t)b * 256 * 1024 + 512 + h * 128, 1024, 0xFu, 0, 255, 0xffffffffu,
                               omem + (size_t)(b * S_ + qt * 256 + wv * 32) * 512 + h * 128, 512);
            }
        }
    }
    SEAM(2);
    if (IN(3)) {
        const int lane = LANE_NOW; (void)lane;
        {   float* hs = (float*)smem;
            float* bsum = (float*)smem + 8 * 256;
            { const int kv = tid >> 8, n = tid & 255; float a = 0.f;
#pragma unroll
              for (int kc = 0; kc < 16; ++kc) a += bias1[(kv * 16 + kc) * 256 + n];
              bsum[tid] = a; }
            __syncthreads();
            for (int u = bid; u < 508; u += nb) {
                const int kv = u / 254, ub = u % 254;
                const float* w2 = p.in[kv ? I_W2V : I_W2K]; _Float16* dst = kv ? vc16 : kc16;
                __syncthreads();
#pragma unroll
                for (int q = 0; q < 4; ++q) { const int e = tid + 512 * q, i = e >> 8, n = e & 255;
                    const int idx = ub * 8 + i, b = idx / 254, rem = idx % 254, c = rem >> 1, kvh = rem & 1;
                    const int row = (b * 128 + c) * 2 + kvh;
                    float a = bsum[kv * 256 + n];
#pragma unroll
                    for (int sp = 0; sp < 4; ++sp) { const float* base = uv + ((size_t)(kv * 4 + sp) * 2048) * 512; a += base[(size_t)row * 512 + n] + base[(size_t)(row + 2) * 512 + 256 + n]; }
                    hs[i * 256 + n] = gelu_tanh(a); }
                __syncthreads();
#pragma unroll
                for (int q = 0; q < 2; ++q) { const int e = tid + 512 * q, i = e >> 7, d = e & 127;
                    const int idx = ub * 8 + i, b = idx / 254, rem = idx % 254, c = rem >> 1, kvh = rem & 1;
                    float a = 0.f;
                    for (int n = 0; n < 256; ++n) a += hs[i * 256 + n] * w2[n * 128 + d];
                    dst[(size_t)((b * 128 + c) * 2 + kvh) * 128 + d] = (_Float16)a; }
            }
            __syncthreads();
            for (int i = bid * 512 + tid; i < 2 * B_ * 256; i += nb * 512) { const int kv = i / (B_ * 256), r = i % (B_ * 256), b = r >> 8, x = r & 255;
                (kv ? vc16 : kc16)[(size_t)(b * 128 + 127) * 256 + x] = (_Float16)0.f; }
        }
        for (int u = bid; u < 128 * 4; u += nb) { const int g = u >> 7, mt = u & 127;
            ARowPlain af{pooled + g * 128, 512, mt * 128, T_}; EpiPool ef{opool, p.in[I_POOLS], mt * 128, g};
            gemm_tile(smem, 128, af, p.in[I_POOLW] + (size_t)g * 128 * 128, 128, 0, 128, false, ef);
        }
    }
    SEAM(3);
    if (IN(4)) {
        const int lane = LANE_NOW; (void)lane;
        const int r32 = lane & 31, hi = lane >> 5, g = wv >> 1, half = wv & 1;
        for (int uu = vcu; uu < 512; uu += nb) {
            const int v = uu & 255, bk = v >> 4, qi = (uu >> 8) ? 31 - (v & 15) : (v & 15), b = bk >> 1, kvh = bk & 1;
            const int tl = half * 32 + r32, t = qi * 64 + tl;
            at8::cmp_slc_unit(smem, proj16 + (size_t)(b * S_ + t) * INW + C_Q + (kvh * 4 + g) * 128 + hi * 8,
                              kc16 + (size_t)(b * 128 * 2 + kvh) * 128, vc16 + (size_t)(b * 128 * 2 + kvh) * 128,
                              kv16 + ((size_t)(2 * B_ + b) * 2 + kvh) * KVSEG, kv16 + ((size_t)(3 * B_ + b) * 2 + kvh) * KVSEG, t, tl, g, qi,
                              ocmp + (size_t)(b * S_ + qi * 64 + half * 32) * 1024 + (kvh * 4 + g) * 128, oslc + (size_t)(b * S_ + qi * 64 + half * 32) * 1024 + (kvh * 4 + g) * 128);
        }
    }
    SEAM(4);
    if (IN(5)) {
        const int lane = LANE_NOW;
        for (int row = gw; row < T_; row += nw) {
            const _Float16* pr = proj16 + (size_t)row * INW + C_G;
            float v[32]; float ss = 0.f;
#pragma unroll
            for (int c = 0; c < 2; ++c) { const int col = (lane + 64 * c) * 8, h = col >> 7; const size_t o = (size_t)row * 1024 + col;
                const float g0 = sigmoidf_((float)pr[h * 3]), g1 = sigmoidf_((float)pr[h * 3 + 1]), g2 = sigmoidf_((float)pr[h * 3 + 2]);
                const h8 a = *(const h8*)(ocmp + o), b2 = *(const h8*)(oslc + o), c2 = *(const h8*)(owin + o);
#pragma unroll
                for (int q = 0; q < 8; ++q) { const float x = g0 * (float)a[q] + g1 * (float)b2[q] + g2 * (float)c2[q]; v[c * 8 + q] = x; ss += x * x; } }
            ss = wave_sum(ss); float r = rsqrtf(ss / 1024.f + LN_EPS);
#pragma unroll
            for (int c = 0; c < 2; ++c) { const int col = (lane + 64 * c) * 8; const float4 ga = *(const float4*)(p.in[I_GNNSA] + col), gb = *(const float4*)(p.in[I_GNNSA] + col + 4);
                v[c * 8 + 0] *= r * ga.x; v[c * 8 + 1] *= r * ga.y; v[c * 8 + 2] *= r * ga.z; v[c * 8 + 3] *= r * ga.w; v[c * 8 + 4] *= r * gb.x; v[c * 8 + 5] *= r * gb.y; v[c * 8 + 6] *= r * gb.z; v[c * 8 + 7] *= r * gb.w; }
            { const h8 a = *(const h8*)(opool + (size_t)row * 512 + lane * 8); ss = 0.f;
#pragma unroll
              for (int q = 0; q < 8; ++q) { v[16 + q] = (float)a[q]; ss += v[16 + q] * v[16 + q]; }
              ss = wave_sum(ss); r = rsqrtf(ss / 512.f + LN_EPS);
              const float4 ga = *(const float4*)(p.in[I_GNPOOL] + lane * 8), gb = *(const float4*)(p.in[I_GNPOOL] + lane * 8 + 4);
              v[16] *= r * ga.x; v[17] *= r * ga.y; v[18] *= r * ga.z; v[19] *= r * ga.w; v[20] *= r * gb.x; v[21] *= r * gb.y; v[22] *= r * gb.z; v[23] *= r * gb.w; }
            { const h8 a = *(const h8*)(omem + (size_t)row * 512 + lane * 8); ss = 0.f;
#pragma unroll
              for (int q = 0; q < 8; ++q) { v[24 + q] = (float)a[q]; ss += v[24 + q] * v[24 + q]; }
              ss = wave_sum(ss); r = rsqrtf(ss / 512.f + LN_EPS);
              const float4 ga = *(const float4*)(p.in[I_GNMEM] + lane * 8), gb = *(const float4*)(p.in[I_GNMEM] + lane * 8 + 4);
              v[24] *= r * ga.x; v[25] *= r * ga.y; v[26] *= r * ga.z; v[27] *= r * ga.w; v[28] *= r * gb.x; v[29] *= r * gb.y; v[30] *= r * gb.z; v[31] *= r * gb.w; }
            float amax = 0.f;
#pragma unroll
            for (int k = 0; k < 32; ++k) amax = fmaxf(amax, fabsf(v[k]));
            amax = wave_max(amax);
            const float qinv = amax > 0.f ? 127.f / amax : 0.f;
            if (lane == 0) scat[row] = amax > 0.f ? amax / 127.f : 1.f;
#pragma unroll
            for (int c = 0; c < 4; ++c) { const int col = c < 2 ? (lane + 64 * c) * 8 : (c == 2 ? 1024 + lane * 8 : 1536 + lane * 8);
                uint2 q; q.x = pack4_i8(v[c * 8 + 0] * qinv, v[c * 8 + 1] * qinv, v[c * 8 + 2] * qinv, v[c * 8 + 3] * qinv); q.y = pack4_i8(v[c * 8 + 4] * qinv, v[c * 8 + 5] * qinv, v[c * 8 + 6] * qinv, v[c * 8 + 7] * qinv);
                *(uint2*)(cat8 + (size_t)row * 2048 + col) = q; }
        }
    }
    SEAM(5);
    if (IN(6)) {
        const int lane = LANE_NOW; (void)lane;
        g8::ProbOut P{cat8, q8out, hpre16, x16, scat, sout, nb, bid};
        g8::gemm_phase(lds, P);
    }
    SEAM(6);
    if (IN(7)) {
        const int lane = LANE_NOW; (void)lane;
        float* lg = (float*)smem;
        const int r32 = lane & 31, hi = lane >> 5, fr = lane & 15, fq = lane >> 4;
        for (int u = bid; u < T_ / 64; u += nb) {
            const int base = u * 64;
#pragma unroll 2
            for (int i = 0; i < 8; ++i) {
                const int row = base + wv * 8 + i;
                float v[32]; float s = 0.f;
#pragma unroll
                for (int c = 0; c < 4; ++c) { const int col = (lane + 64 * c) * 8;
                    const h8 a0 = *(const h8*)(hpre16 + (size_t)row * 2048 + col);
#pragma unroll
                    for (int q = 0; q < 8; ++q) { v[c * 8 + q] = (float)a0[q]; s += v[c * 8 + q]; } }
                const float mu = wave_sum(s) / 2048.f; float q2 = 0.f;
#pragma unroll
                for (int k = 0; k < 32; ++k) { const float d = v[k] - mu; q2 += d * d; }
                const float rs = rsqrtf(wave_sum(q2) / 2048.f + LN_EPS);
                float amax = 0.f;
#pragma unroll
                for (int c = 0; c < 4; ++c) { const int col = (lane + 64 * c) * 8;
                    const float4 g0 = *(const float4*)(p.in[I_LN1G] + col), g1 = *(const float4*)(p.in[I_LN1G] + col + 4), b0 = *(const float4*)(p.in[I_LN1B] + col), b1 = *(const float4*)(p.in[I_LN1B] + col + 4);
                    float4 o0, o1;
                    o0.x = (v[c * 8 + 0] - mu) * rs * g0.x + b0.x; o0.y = (v[c * 8 + 1] - mu) * rs * g0.y + b0.y; o0.z = (v[c * 8 + 2] - mu) * rs * g0.z + b0.z; o0.w = (v[c * 8 + 3] - mu) * rs * g0.w + b0.w;
                    o1.x = (v[c * 8 + 4] - mu) * rs * g1.x + b1.x; o1.y = (v[c * 8 + 5] - mu) * rs * g1.y + b1.y; o1.z = (v[c * 8 + 6] - mu) * rs * g1.z + b1.z; o1.w = (v[c * 8 + 7] - mu) * rs * g1.w + b1.w;
                    h8 oh; oh[0] = (_Float16)o0.x; oh[1] = (_Float16)o0.y; oh[2] = (_Float16)o0.z; oh[3] = (_Float16)o0.w; oh[4] = (_Float16)o1.x; oh[5] = (_Float16)o1.y; oh[6] = (_Float16)o1.z; oh[7] = (_Float16)o1.w;
                    *(h8*)(h16 + (size_t)row * 2048 + col) = oh;
                    v[c * 8 + 0] = o0.x; v[c * 8 + 1] = o0.y; v[c * 8 + 2] = o0.z; v[c * 8 + 3] = o0.w; v[c * 8 + 4] = o1.x; v[c * 8 + 5] = o1.y; v[c * 8 + 6] = o1.z; v[c * 8 + 7] = o1.w;
                    amax = fmaxf(amax, fmaxf(fmaxf(fmaxf(fabsf(o0.x), fabsf(o0.y)), fmaxf(fabsf(o0.z), fabsf(o0.w))), fmaxf(fmaxf(fabsf(o1.x), fabsf(o1.y)), fmaxf(fabsf(o1.z), fabsf(o1.w))))); }
                amax = wave_max(amax);
                const float qinv = amax > 0.f ? 127.f / amax : 0.f;
                if (lane == 0) sah[row] = amax > 0.f ? amax / 127.f : 1.f;
#pragma unroll
                for (int c = 0; c < 4; ++c) { const int col = (lane + 64 * c) * 8;
                    uint2 q; q.x = pack4_i8(v[c * 8 + 0] * qinv, v[c * 8 + 1] * qinv, v[c * 8 + 2] * qinv, v[c * 8 + 3] * qinv); q.y = pack4_i8(v[c * 8 + 4] * qinv, v[c * 8 + 5] * qinv, v[c * 8 + 6] * qinv, v[c * 8 + 7] * qinv);
                    *(uint2*)(h8q + (size_t)row * 2048 + col) = q; }
            }
            asm volatile("s_waitcnt vmcnt(0)" ::: "memory");
            __syncthreads();
            {
                const int tok0 = base + 16 * (wv >> 1), e0 = 16 * (wv & 1);
                const _Float16* ap = h16 + (size_t)(tok0 + fr) * 2048 + fq * 8; const _Float16* bp = wr16 + (size_t)(e0 + fr) * 2048 + fq * 8;
                f4 acc = (f4){0.f, 0.f, 0.f, 0.f};
#pragma unroll 8
                for (int sI = 0; sI < 64; ++sI) { const h8 a = *(const h8*)(ap + sI * 32), bb = *(const h8*)(bp + sI * 32); acc = __builtin_amdgcn_mfma_f32_16x16x32_f16(a, bb, acc, 0, 0, 0); }
                const float br = p.in[I_BR][e0 + fr];
#pragma unroll
                for (int j = 0; j < 4; ++j) lg[(16 * (wv >> 1) + 4 * fq + j) * 33 + e0 + fr] = acc[j] + br;
            }
            __syncthreads();
#pragma unroll 1
            for (int it = 0; it < 4; ++it) {
                const int tk = 8 * wv + 2 * it + hi;
                const float iv = lg[tk * 33 + r32];
                int rank = 0;
                for (int i = 0; i < 32; ++i) { const float vi = __shfl(iv, i + 32 * hi); rank += (vi > iv || (vi == iv && i < r32)) ? 1 : 0; }
                float tv[4]; int te[4];
#pragma unroll
                for (int r = 0; r < 4; ++r) { const unsigned long long bm = __ballot(rank == r); const unsigned hm = (unsigned)(bm >> (32 * hi)); const int src = __ffs(hm) - 1; te[r] = src; tv[r] = __shfl(iv, src + 32 * hi); }
                const float e0v = 1.f, e1v = expf(tv[1] - tv[0]), e2v = expf(tv[2] - tv[0]), e3v = expf(tv[3] - tv[0]); const float inv = 1.f / (e0v + e1v + e2v + e3v);
                if (r32 < 4) { const int e = r32 == 0 ? te[0] : r32 == 1 ? te[1] : r32 == 2 ? te[2] : te[3]; const float g = (r32 == 0 ? e0v : r32 == 1 ? e1v : r32 == 2 ? e2v : e3v) * inv;
                    const int a = (base + tk) * 4 + r32; const int pos = atomicAdd(&cnt[e], 1); list[(size_t)e * T_ + pos] = a; gate[a] = g; }
            }
            __syncthreads();
        }
    }
    SEAM(7);
    LAS int* mtab = (LAS int*)(smem + g8::STAGE_BYTES);
    if (IN(8)) {
        const int lane = LANE_NOW; (void)lane;
        if (tid == 0) { int ub = 0, rs = 0;
            for (int e = 0; e < NE; ++e) { const int c = (int)__hip_atomic_load((unsigned*)&cnt[e], __ATOMIC_RELAXED, __HIP_MEMORY_SCOPE_AGENT); mtab[e] = c; mtab[32 + e] = ub; mtab[65 + e] = rs; ub += ((c + 255) >> 8) * 16; rs += c; }
            mtab[64] = ub; mtab[97] = rs; mtab[98] = ub; }
        __syncthreads();
        g8::ProbGu P{h8q, q8gu, actf8, p.in[I_BGU], list, sah, sgu, g8::MoeTab{mtab, 16}, nb, vcu};
        g8::gemm_phase(lds, P);
        __syncthreads();
    }
    SEAM(8);
    if (IN(9)) {
        const int lane = LANE_NOW;
        for (int row = gw; row < NA; row += nw) {
            float v[32]; float amax = 0.f;
#pragma unroll
            for (int c = 0; c < 4; ++c) { const uint2 a = *(const uint2*)(actf8 + (size_t)row * 2048 + (lane + 64 * c) * 8);
                dec4_fp8(a.x, v[c * 8 + 0], v[c * 8 + 1], v[c * 8 + 2], v[c * 8 + 3]); dec4_fp8(a.y, v[c * 8 + 4], v[c * 8 + 5], v[c * 8 + 6], v[c * 8 + 7]);
#pragma unroll
                for (int q = 0; q < 8; ++q) amax = fmaxf(amax, fabsf(v[c * 8 + q])); }
            amax = wave_max(amax);
            const float qinv = amax > 0.f ? 127.f / amax : 0.f;
            if (lane == 0) sact[row] = amax > 0.f ? amax / 127.f : 1.f;
#pragma unroll
            for (int c = 0; c < 4; ++c) { uint2 q; q.x = pack4_i8(v[c * 8 + 0] * qinv, v[c * 8 + 1] * qinv, v[c * 8 + 2] * qinv, v[c * 8 + 3] * qinv); q.y = pack4_i8(v[c * 8 + 4] * qinv, v[c * 8 + 5] * qinv, v[c * 8 + 6] * qinv, v[c * 8 + 7] * qinv);
                *(uint2*)(act8 + (size_t)row * 2048 + (lane + 64 * c) * 8) = q; }
        }
    }
    SEAM(9);
    if (IN(10)) {
        const int lane = LANE_NOW; (void)lane;
        if (tid == 0) { int ub = 0, rs = 0;
            for (int e = 0; e < NE; ++e) { const int c = (int)__hip_atomic_load((unsigned*)&cnt[e], __ATOMIC_RELAXED, __HIP_MEMORY_SCOPE_AGENT); mtab[e] = c; mtab[32 + e] = ub; mtab[65 + e] = rs; ub += ((c + 255) >> 8) * 8; rs += c; }
            mtab[64] = ub; mtab[97] = rs; mtab[98] = ub; }
        __syncthreads();
        g8::ProbDn P{act8, q8dn, yf8, p.in[I_BDN], list, gate, sact, sdn, g8::MoeTab{mtab, 8}, nb, vcu};
        g8::gemm_phase(lds, P);
        __syncthreads();
    }
    SEAM(10);
    if (IN(11)) {
        const int lane = LANE_NOW; (void)lane;
        for (int row = gw; row < T_; row += nw) {
            float v[32]; float s = 0.f;
#pragma unroll
            for (int c = 0; c < 4; ++c) { const int col = (lane + 64 * c) * 8; const size_t yo = (size_t)row * 4 * 2048 + col;
                const h8 hh8 = *(const h8*)(h16 + (size_t)row * 2048 + col);
                const uint2 y0 = *(const uint2*)(yf8 + yo), y1 = *(const uint2*)(yf8 + yo + 2048), y2 = *(const uint2*)(yf8 + yo + 4096), y3 = *(const uint2*)(yf8 + yo + 6144);
                float ys[8], t0[8], t1[8], t2[8], t3[8];
                dec4_fp8(y0.x, t0[0], t0[1], t0[2], t0[3]); dec4_fp8(y0.y, t0[4], t0[5], t0[6], t0[7]); dec4_fp8(y1.x, t1[0], t1[1], t1[2], t1[3]); dec4_fp8(y1.y, t1[4], t1[5], t1[6], t1[7]);
                dec4_fp8(y2.x, t2[0], t2[1], t2[2], t2[3]); dec4_fp8(y2.y, t2[4], t2[5], t2[6], t2[7]); dec4_fp8(y3.x, t3[0], t3[1], t3[2], t3[3]); dec4_fp8(y3.y, t3[4], t3[5], t3[6], t3[7]);
#pragma unroll
                for (int q = 0; q < 8; ++q) ys[q] = (t0[q] + t1[q]) + (t2[q] + t3[q]);
#pragma unroll
                for (int q = 0; q < 8; ++q) { v[c * 8 + q] = DN_ALPHA * (float)hh8[q] + ys[q] * 0.0625f; s += v[c * 8 + q]; } }
            const float mu = wave_sum(s) / 2048.f; float q2 = 0.f;
#pragma unroll
            for (int i = 0; i < 32; ++i) { const float d = v[i] - mu; q2 += d * d; }
            const float rs = rsqrtf(wave_sum(q2) / 2048.f + LN_EPS);
#pragma unroll
            for (int c = 0; c < 4; ++c) { const int col = (lane + 64 * c) * 8;
                const float4 ga = *(const float4*)(p.in[I_LN2G] + col), gb = *(const float4*)(p.in[I_LN2G] + col + 4), ba = *(const float4*)(p.in[I_LN2B] + col), bb = *(const float4*)(p.in[I_LN2B] + col + 4);
                float4 o0, o1;
                o0.x = (v[c * 8 + 0] - mu) * rs * ga.x + ba.x; o0.y = (v[c * 8 + 1] - mu) * rs * ga.y + ba.y; o0.z = (v[c * 8 + 2] - mu) * rs * ga.z + ba.z; o0.w = (v[c * 8 + 3] - mu) * rs * ga.w + ba.w;
                o1.x = (v[c * 8 + 4] - mu) * rs * gb.x + bb.x; o1.y = (v[c * 8 + 5] - mu) * rs * gb.y + bb.y; o1.z = (v[c * 8 + 6] - mu) * rs * gb.z + bb.z; o1.w = (v[c * 8 + 7] - mu) * rs * gb.w + bb.w;
                *(float4*)(p.out + (size_t)row * 2048 + col) = o0; *(float4*)(p.out + (size_t)row * 2048 + col + 4) = o1; }
        }
    }
}

constexpr int NPHASE = 12;

extern "C" void kernel_launch(void* const* d_in, const int* in_sizes, int n_in, void* d_out, int out_size, void* d_ws, size_t ws_size, hipStream_t stream) {
    static int grid = 0;
    if (grid == 0) {
        if (n_in != 26 || ws_size < WS_END) { fprintf(stderr, "kernel_launch: unexpected n_in %d or ws_size %zu (< %zu)\n", n_in, ws_size, (size_t)WS_END); grid = -1; return; }
        int dev = 0, cus = 0, per_cu = 0;
        hipGetDevice(&dev); hipDeviceGetAttribute(&cus, hipDeviceAttributeMultiprocessorCount, dev);
        if (hipFuncSetAttribute((const void*)fwd, hipFuncAttributeMaxDynamicSharedMemorySize, LDS_BYTES) != hipSuccess) { fprintf(stderr, "hipFuncSetAttribute failed\n"); grid = -1; return; }
        hipOccupancyMaxActiveBlocksPerMultiprocessor(&per_cu, (const void*)fwd, 512, LDS_BYTES);
        (void)hipGetLastError();
        if (per_cu < 1) fprintf(stderr, "occupancy query says %d blocks per CU\n", per_cu);
        grid = cus > 0 ? cus : 256;
    }
    if (grid < 0) return;
    hipMemsetAsync((char*)d_ws + WS_CTL, 0, CTL_BYTES, stream);
    Params p{};
    for (int i = 0; i < 26; ++i) p.in[i] = (const float*)d_in[i];
    p.out = (float*)d_out; p.ws = (unsigned char*)d_ws;
#if N_LAUNCH_MODE == 1
    p.lo_hi = (long long)0 | ((long long)NPHASE << 32);
    hipLaunchKernelGGL(fwd, dim3(grid), dim3(512), LDS_BYTES, stream, p);
#else
    for (int ph = 0; ph < NPHASE; ++ph) {
        p.lo_hi = (long long)ph | ((long long)(ph + 1) << 32);
        hipLaunchKernelGGL(fwd, dim3(grid), dim3(512), LDS_BYTES, stream, p);
    }
#endif
}
```

```cpp
#include <hip/hip_runtime.h>
#include <cstdio>
#include <cstdint>

#ifndef N_LAUNCH_MODE
#define N_LAUNCH_MODE 1
#endif

constexpr int B_ = 8, S_ = 2048, D_ = 2048, T_ = B_ * S_;
constexpr int INW = 3608;
constexpr int C_Q = 0, C_KC = 1024, C_VC = 1280, C_KS = 1536, C_VS = 1792, C_KW = 2048, C_VW = 2304, C_G = 2560, C_UP = 2584, C_QM = 3096;
constexpr int NC = 127;
constexpr int CROWS = B_ * NC * 2;
constexpr int NE = 32, DE = 2048, NA = T_ * 4;
constexpr float LN_EPS = 1e-5f;
constexpr float DN_ALPHA = 1.189207115002721f;
constexpr float ATT_SCALE = 0.08838834764831845f;

constexpr size_t al256(size_t x) { return (x + 255) & ~(size_t)255; }
constexpr size_t WS_CTL = 0;
constexpr size_t CTL_BYTES = 65536;
constexpr size_t CTL_CNT = 16384;
constexpr size_t WS_PROJ = CTL_BYTES;
constexpr size_t WS_KVMEM = WS_PROJ + al256((size_t)T_ * INW * 4);
constexpr size_t WS_BIAS1 = WS_KVMEM + al256((size_t)2048 * 1024 * 4);
constexpr size_t WS_HID = WS_BIAS1 + al256(2 * 16 * 256 * 4);
constexpr size_t WS_KC = WS_HID + al256((size_t)2 * 2048 * 256 * 4);
constexpr size_t WS_VC = WS_KC + al256((size_t)CROWS * 128 * 4);
constexpr size_t WS_POOLED = WS_VC + al256((size_t)CROWS * 128 * 4);
constexpr size_t WS_OPOOL = WS_POOLED + al256((size_t)T_ * 512 * 4);
constexpr size_t WS_OWIN = WS_OPOOL + al256((size_t)T_ * 512 * 4);
constexpr size_t WS_OCMP = WS_OWIN + al256((size_t)T_ * 1024 * 4);
constexpr size_t WS_OSLC = WS_OCMP + al256((size_t)T_ * 1024 * 4);
constexpr size_t WS_SEL = WS_OSLC + al256((size_t)T_ * 1024 * 4);
constexpr size_t WS_OMEM = WS_SEL + al256((size_t)T_ * 2 * 4);
constexpr size_t WS_CAT16 = WS_OMEM + al256((size_t)T_ * 512 * 4);
constexpr size_t WS_HPRE = WS_CAT16 + al256((size_t)T_ * 2048 * 2);
constexpr size_t WS_H = WS_HPRE + al256((size_t)T_ * 2048 * 4);
constexpr size_t WS_H16 = WS_H + al256((size_t)T_ * 2048 * 4);
constexpr size_t WS_GATE = WS_H16 + al256((size_t)T_ * 2048 * 2);
constexpr size_t WS_LIST = WS_GATE + al256((size_t)NA * 4);
constexpr size_t WS_ACT16 = WS_LIST + al256((size_t)NE * T_ * 4);
constexpr size_t WS_Y16 = WS_ACT16 + al256((size_t)(NA + 256) * 2048 * 2);
constexpr size_t WS_X16 = WS_Y16 + al256((size_t)NA * 2048 * 2);
constexpr size_t WS_MEM16 = WS_X16 + (size_t)T_ * 2048 * 2;
constexpr size_t WS_WTIN = WS_MEM16 + al256((size_t)2048 * 2048 * 2);
constexpr size_t WS_WTOUT = WS_WTIN + al256((size_t)3840 * 2048 * 2);
constexpr size_t WS_WTGU = WS_WTOUT + al256((size_t)2048 * 2048 * 2);
constexpr size_t WS_WTDN = WS_WTGU + al256((size_t)NE * 4096 * 2048 * 2);
constexpr size_t WS_PROJ16 = WS_WTDN + al256((size_t)NE * 2048 * 2048 * 2);
constexpr size_t WS_KVMEM16 = WS_PROJ16 + al256((size_t)(T_ + 64) * INW * 2);
constexpr size_t WS_WT1 = WS_KVMEM16 + al256((size_t)2048 * 1024 * 2);
constexpr size_t WS_UV = WS_WT1 + al256((size_t)2 * 512 * 2048 * 2);
constexpr size_t WS_KC16 = WS_UV + al256((size_t)2 * 4 * 2048 * 512 * 4);
constexpr size_t WS_VC16 = WS_KC16 + al256((size_t)B_ * 128 * 256 * 2);
constexpr size_t WS_WR16 = WS_VC16 + al256((size_t)B_ * 128 * 256 * 2);
constexpr size_t WS_Q8GU = WS_WR16 + al256((size_t)32 * 2048 * 2);
constexpr size_t WS_Q8DN = WS_Q8GU + al256((size_t)NE * 4096 * 2048);
constexpr size_t WS_SGU = WS_Q8DN + al256((size_t)NE * 2048 * 2048);
constexpr size_t WS_SDN = WS_SGU + al256((size_t)NE * 4096 * 4);
constexpr size_t WS_H8 = WS_SDN + al256((size_t)NE * 2048 * 4);
constexpr size_t WS_SAH = WS_H8 + al256((size_t)T_ * 2048);
constexpr size_t WS_ACT8 = WS_SAH + al256((size_t)T_ * 4);
constexpr size_t WS_SACT = WS_ACT8 + al256((size_t)(NA + 256) * 2048);
constexpr size_t WS_WTMKV = WS_SACT + al256((size_t)(NA + 256) * 4);
constexpr size_t WS_Q8OUT = WS_WTMKV + al256((size_t)1024 * 2048 * 2);
constexpr size_t WS_SOUT = WS_Q8OUT + al256((size_t)2048 * 2048);
constexpr size_t WS_CAT8 = WS_SOUT + al256(2048 * 4);
constexpr size_t WS_SCAT = WS_CAT8 + al256((size_t)T_ * 2048);
constexpr size_t WS_WT2 = WS_SCAT + al256((size_t)T_ * 4);
constexpr size_t WS_KV16 = WS_WT2 + al256((size_t)2 * 128 * 256 * 2);
constexpr size_t KVSEG = (size_t)S_ * 128;
constexpr size_t WS_END = WS_KV16 + al256((size_t)6 * B_ * 2 * S_ * 128 * 2);

constexpr int LDS_BYTES = 155648;

struct Params {
    const float* in[26];
    float* out;
    unsigned char* ws;
    long long lo_hi;
};
enum { I_X = 0, I_MEM, I_WIN, I_POSK, I_W1K, I_W2K, I_POSV, I_W1V, I_W2V, I_POOLW, I_POOLS, I_WMEMKV, I_GNNSA, I_GNPOOL, I_GNMEM, I_WOUT,
       I_LN1G, I_LN1B, I_WR, I_BR, I_WGU, I_BGU, I_WDN, I_BDN, I_LN2G, I_LN2B };

#define XB_TMO      128
#define XB_XCNT(j)  (256  + 64 * (j))
#define XB_XSUB(j)  (1280 + 64 * (j))
#define XB_XGEN(j)  (2304 + 64 * (j))
#define XB_TOP      3328
#define XB_TOPGEN   3392
#define XCD_BAR_WORDS 3456
#define XB_SPIN_CAP (1u << 25)
#define LAS __attribute__((address_space(3)))

__device__ __forceinline__ unsigned xb_ld(unsigned* p)              { return __hip_atomic_load(p, __ATOMIC_RELAXED, __HIP_MEMORY_SCOPE_AGENT); }
__device__ __forceinline__ unsigned xb_add(unsigned* p, unsigned v) { return __hip_atomic_fetch_add(p, v, __ATOMIC_RELAXED, __HIP_MEMORY_SCOPE_AGENT); }
__device__ __forceinline__ unsigned xb_xcc_id() { return (unsigned)__builtin_amdgcn_s_getreg((3 << 11) | 20) & 0xFu; }
#define XB_SPIN(cond, bar) do { unsigned _sp = 0; while (cond) { __builtin_amdgcn_s_sleep(1); \
    if ((++_sp & 255u) == 0u) { if (xb_ld(&(bar)[XB_TMO])) break; if (_sp > XB_SPIN_CAP) { atomicAdd(&(bar)[XB_TMO], 1u); break; } } } } while (0)

struct XcdBarrier { unsigned* bar; unsigned x; volatile LAS unsigned* st; };

__device__ __forceinline__ XcdBarrier xcd_barrier_post(unsigned* bar, volatile LAS unsigned* st) {
    XcdBarrier b; b.bar = bar; b.x = xb_xcc_id(); b.st = st;
    if (threadIdx.x == 0) (void)xb_add(&bar[XB_XCNT(b.x)], 1u);
    return b;
}
__device__ __forceinline__ void xcd_barrier_complete(unsigned* bar, unsigned x, unsigned& nloc, unsigned& nx) {
    const unsigned G = gridDim.x * gridDim.y * gridDim.z;
    unsigned sum, cnt, mine, sp = 0u;
    for (;;) {
        sum = 0u; cnt = 0u; mine = 0u;
#pragma unroll
        for (unsigned j = 0; j < 16; ++j) { const unsigned c = xb_ld(&bar[XB_XCNT(j)]); sum += c; cnt += (c > 0u) ? 1u : 0u; mine = (j == x) ? c : mine; }
        if (sum == G) break;
        __builtin_amdgcn_s_sleep(1);
        if ((++sp & 255u) == 0u) { if (xb_ld(&bar[XB_TMO])) break; if (sp > XB_SPIN_CAP) { atomicAdd(&bar[XB_TMO], 1u); break; } }
    }
    nloc = mine > 0u ? mine : 1u; nx = cnt > 0u ? cnt : 1u;
}
__device__ __forceinline__ void xcd_barrier(const XcdBarrier& b) {
    asm volatile("s_waitcnt vmcnt(0)" ::: "memory");
    __syncthreads();
    if (threadIdx.x == 0) {
        unsigned* bar = b.bar;
        __builtin_amdgcn_s_waitcnt(0);
        unsigned nloc = b.st[0], nx = b.st[1];
        if (nloc == 0u) { xcd_barrier_complete(bar, b.x, nloc, nx); b.st[0] = nloc; b.st[1] = nx; }
        const unsigned old = xb_add(&bar[XB_XSUB(b.x)], 1u);
        const unsigned gen = old / nloc;
        if (old + 1u == (gen + 1u) * nloc) {
            __builtin_amdgcn_fence(__ATOMIC_RELEASE, "agent");
            asm volatile("s_waitcnt vmcnt(0)" ::: "memory");
            const unsigned og = xb_add(&bar[XB_TOP], 1u);
            const unsigned tg = og / nx;
            if (og + 1u == (tg + 1u) * nx) xb_add(&bar[XB_TOPGEN], 1u);
            else XB_SPIN(xb_ld(&bar[XB_TOPGEN]) == tg, bar);
            __builtin_amdgcn_fence(__ATOMIC_ACQUIRE, "agent");
            xb_add(&bar[XB_XGEN(b.x)], 1u);
            asm volatile("s_waitcnt vmcnt(0)" ::: "memory");
        } else {
            XB_SPIN(xb_ld(&bar[XB_XGEN(b.x)]) == gen, bar);
            __builtin_amdgcn_fence(__ATOMIC_ACQUIRE, "agent");
            asm volatile("s_waitcnt vmcnt(0)" ::: "memory");
        }
    }
    __syncthreads();
}

typedef _Float16 h8 __attribute__((ext_vector_type(8)));
typedef _Float16 h4 __attribute__((ext_vector_type(4)));
typedef float f4 __attribute__((ext_vector_type(4)));

__device__ __forceinline__ float wave_sum(float v) {
#pragma unroll
    for (int o = 32; o > 0; o >>= 1) v += __shfl_xor(v, o);
    return v;
}
__device__ __forceinline__ float wave_max(float v) {
#pragma unroll
    for (int o = 32; o > 0; o >>= 1) v = fmaxf(v, __shfl_xor(v, o));
    return v;
}
__device__ __forceinline__ void wave_sync() {
    asm volatile("s_waitcnt lgkmcnt(0)" ::: "memory");
    __builtin_amdgcn_wave_barrier();
}
__device__ __forceinline__ float gelu_tanh(float x) {
    const float u = 0.7978845608028654f * (x + 0.044715f * x * x * x);
    return 0.5f * x * (1.f + tanhf(u));
}
__device__ __forceinline__ float gelu_fast(float x) { const float u = 0.7978845608028654f * (x + 0.044715f * x * x * x); const float t = 1.f - 2.f * __builtin_amdgcn_rcpf(1.f + __builtin_amdgcn_exp2f(2.8853900817779268f * u)); return 0.5f * x * (1.f + t); }
__device__ __forceinline__ float sigmoidf_(float x) { return 1.f / (1.f + expf(-x)); }
__device__ __forceinline__ unsigned pk4_fp8(float a, float b, float c, float d) { int w = 0; w = __builtin_amdgcn_cvt_pk_fp8_f32(a, b, w, false); w = __builtin_amdgcn_cvt_pk_fp8_f32(c, d, w, true); return (unsigned)w; }
__device__ __forceinline__ void dec4_fp8(unsigned w, float& a, float& b, float& c, float& d) { a = __builtin_amdgcn_cvt_f32_fp8((int)w, 0); b = __builtin_amdgcn_cvt_f32_fp8((int)w, 1); c = __builtin_amdgcn_cvt_f32_fp8((int)w, 2); d = __builtin_amdgcn_cvt_f32_fp8((int)w, 3); }
__device__ __forceinline__ float swiglu_fast(float g, float l) { const float xg = fminf(g, 7.f), xl = fminf(fmaxf(l, -7.f), 7.f); return xg * __builtin_amdgcn_rcpf(1.f + __builtin_amdgcn_exp2f(-2.4554669595930156f * xg)) * (xl + 1.f); }

constexpr int G_LD = 40;
template <class AF, class EF>
__device__ __forceinline__ void gemm_tile(char* smem, int K, const AF& af, const float* __restrict__ Bm, int ldb, int n0, int Nlim, bool perm, const EF& ef) {
    _Float16* As = (_Float16*)smem;
    _Float16* Bs = As + 128 * G_LD;
    const int tid = threadIdx.x, lane = tid & 63, wid = tid >> 6, wr = wid >> 2, wc = wid & 3, fr = lane & 15, fq = lane >> 4;
    f4 acc[4][2];
#pragma unroll
    for (int m = 0; m < 4; ++m)
#pragma unroll
        for (int n = 0; n < 2; ++n) acc[m][n] = (f4){0.f, 0.f, 0.f, 0.f};
    const int ar = tid >> 3, ak = (tid & 7) * 4;
    const float* ap0 = af.row(ar);
    const float* ap1 = af.row(ar + 64);
    const int bk = tid >> 5, bn = (tid & 31) * 4;
    const bool bok = (n0 + bn) < Nlim;
    int bnp[4];
#pragma unroll
    for (int i = 0; i < 4; ++i) { const int c = bn + i; bnp[i] = perm ? ((c & ~31) | ((c & 1) << 4) | ((c & 31) >> 1)) : c; }
    for (int k0 = 0; k0 < K; k0 += 32) {
        const int ko = af.koff(k0 + ak);
        float4 a0 = make_float4(0.f, 0.f, 0.f, 0.f), a1 = a0, b0 = a0, b1 = a0;
        if (ap0) a0 = *(const float4*)(ap0 + ko);
        if (ap1) a1 = *(const float4*)(ap1 + ko);
        if (bok) { b0 = *(const float4*)(Bm + (size_t)(k0 + bk) * ldb + n0 + bn); b1 = *(const float4*)(Bm + (size_t)(k0 + bk + 16) * ldb + n0 + bn); }
        __syncthreads();
        *(h4*)&As[ar * G_LD + ak] = (h4){(_Float16)a0.x, (_Float16)a0.y, (_Float16)a0.z, (_Float16)a0.w};
        *(h4*)&As[(ar + 64) * G_LD + ak] = (h4){(_Float16)a1.x, (_Float16)a1.y, (_Float16)a1.z, (_Float16)a1.w};
        Bs[bnp[0] * G_LD + bk] = (_Float16)b0.x; Bs[bnp[1] * G_LD + bk] = (_Float16)b0.y; Bs[bnp[2] * G_LD + bk] = (_Float16)b0.z; Bs[bnp[3] * G_LD + bk] = (_Float16)b0.w;
        Bs[bnp[0] * G_LD + bk + 16] = (_Float16)b1.x; Bs[bnp[1] * G_LD + bk + 16] = (_Float16)b1.y; Bs[bnp[2] * G_LD + bk + 16] = (_Float16)b1.z; Bs[bnp[3] * G_LD + bk + 16] = (_Float16)b1.w;
        __syncthreads();
        h8 a[4], b[2];
#pragma unroll
        for (int m = 0; m < 4; ++m) a[m] = *(const h8*)&As[(wr * 64 + m * 16 + fr) * G_LD + fq * 8];
#pragma unroll
        for (int n = 0; n < 2; ++n) b[n] = *(const h8*)&Bs[(wc * 32 + n * 16 + fr) * G_LD + fq * 8];
#pragma unroll
        for (int m = 0; m < 4; ++m)
#pragma unroll
            for (int n = 0; n < 2; ++n) acc[m][n] = __builtin_amdgcn_mfma_f32_16x16x32_f16(a[m], b[n], acc[m][n], 0, 0, 0);
    }
    ef(acc, wr, wc, fr, fq);
    __syncthreads();
}

struct ARowPlain { const float* base; int ld; int m0; int mlim;
    __device__ __forceinline__ const float* row(int r) const { return (m0 + r) < mlim ? base + (size_t)(m0 + r) * ld : nullptr; }
    __device__ __forceinline__ int koff(int k) const { return k; } };
struct ARowCmp { const float* proj; int col; int m0;
    __device__ __forceinline__ const float* row(int r) const { const int g = m0 + r; if (g >= CROWS) return nullptr; const int kvh = g & 1, bc = g >> 1, b = bc / NC, c = bc % NC;
        return proj + (size_t)(b * S_ + 16 * c) * INW + col + kvh * 128; }
    __device__ __forceinline__ int koff(int k) const { return (k >> 7) * INW + (k & 127); } };
struct ARowList { const float* base; const int* list; int m0; int cnt; int shift;
    __device__ __forceinline__ const float* row(int r) const { if (m0 + r >= cnt) return nullptr; const int a = list[m0 + r]; return base + (size_t)(a >> shift) * 2048; }
    __device__ __forceinline__ int koff(int k) const { return k; } };

struct EpiStore { float* C; int ldc; int m0; int n0; int mlim; int nlim; _Float16* C16;
    __device__ __forceinline__ void operator()(const f4 (&acc)[4][2], int wr, int wc, int fr, int fq) const {
#pragma unroll
        for (int m = 0; m < 4; ++m)
#pragma unroll
            for (int n = 0; n < 2; ++n)
#pragma unroll
                for (int j = 0; j < 4; ++j) { const int r = m0 + wr * 64 + m * 16 + fq * 4 + j, c = n0 + wc * 32 + n * 16 + fr;
                    if (r < mlim && c < nlim) { C[(size_t)r * ldc + c] = acc[m][n][j]; if (C16) C16[(size_t)r * ldc + c] = (_Float16)acc[m][n][j]; } } } };
struct EpiKc { _Float16* C; int m0;
    __device__ __forceinline__ void operator()(const f4 (&acc)[4][2], int wr, int wc, int fr, int fq) const {
#pragma unroll
        for (int m = 0; m < 4; ++m)
#pragma unroll
            for (int n = 0; n < 2; ++n)
#pragma unroll
                for (int j = 0; j < 4; ++j) { const int r = m0 + wr * 64 + m * 16 + fq * 4 + j, c = wc * 32 + n * 16 + fr;
                    C[(size_t)r * 128 + c] = (((r >> 1) & 127) == 127) ? (_Float16)0.f : (_Float16)acc[m][n][j]; } } };
struct EpiPool { _Float16* C; const float* scale; int m0; int g;
    __device__ __forceinline__ void operator()(const f4 (&acc)[4][2], int wr, int wc, int fr, int fq) const {
#pragma unroll
        for (int m = 0; m < 4; ++m)
#pragma unroll
            for (int n = 0; n < 2; ++n)
#pragma unroll
                for (int j = 0; j < 4; ++j) { const int r = m0 + wr * 64 + m * 16 + fq * 4 + j, c = g * 128 + wc * 32 + n * 16 + fr;
                    C[(size_t)r * 512 + c] = (_Float16)(acc[m][n][j] * scale[c]); } } };
struct EpiHid { float* C; const float* bias; int m0; int n0;
    __device__ __forceinline__ void operator()(const f4 (&acc)[4][2], int wr, int wc, int fr, int fq) const {
#pragma unroll
        for (int m = 0; m < 4; ++m)
#pragma unroll
            for (int n = 0; n < 2; ++n)
#pragma unroll
                for (int j = 0; j < 4; ++j) { const int r = m0 + wr * 64 + m * 16 + fq * 4 + j, c = n0 + wc * 32 + n * 16 + fr;
                    if (r < CROWS) C[(size_t)r * 256 + c] = gelu_tanh(acc[m][n][j] + bias[c]); } } };
struct EpiOut { float* C; const float* x; int m0; int n0;
    __device__ __forceinline__ void operator()(const f4 (&acc)[4][2], int wr, int wc, int fr, int fq) const {
#pragma unroll
        for (int m = 0; m < 4; ++m)
#pragma unroll
            for (int n = 0; n < 2; ++n)
#pragma unroll
                for (int j = 0; j < 4; ++j) { const size_t o = (size_t)(m0 + wr * 64 + m * 16 + fq * 4 + j) * 2048 + n0 + wc * 32 + n * 16 + fr;
                    C[o] = DN_ALPHA * x[o] + acc[m][n][j]; } } };
struct EpiGu { float* act; const float* bgu; const int* list; int m0; int cnt; int n0;
    __device__ __forceinline__ void operator()(const f4 (&acc)[4][2], int wr, int wc, int fr, int fq) const {
        const int jc = (n0 + wc * 32) / 2 + fr;
        const float bg = bgu[2 * jc], bl = bgu[2 * jc + 1];
#pragma unroll
        for (int m = 0; m < 4; ++m)
#pragma unroll
            for (int j = 0; j < 4; ++j) { const int r = m0 + wr * 64 + m * 16 + fq * 4 + j;
                if (r < cnt) { const int a = list[r];
                    const float xg = fminf(acc[m][0][j] + bg, 7.f), xl = fminf(fmaxf(acc[m][1][j] + bl, -7.f), 7.f);
                    act[(size_t)a * 2048 + jc] = xg * sigmoidf_(1.702f * xg) * (xl + 1.f); } } } };
struct EpiDn { float* y; const float* bdn; const int* list; const float* gate; int m0; int cnt; int n0;
    __device__ __forceinline__ void operator()(const f4 (&acc)[4][2], int wr, int wc, int fr, int fq) const {
#pragma unroll
        for (int m = 0; m < 4; ++m)
#pragma unroll
            for (int j = 0; j < 4; ++j) { const int r = m0 + wr * 64 + m * 16 + fq * 4 + j;
                if (r < cnt) { const int a = list[r]; const float g = gate[a];
#pragma unroll
                    for (int n = 0; n < 2; ++n) { const int c = n0 + wc * 32 + n * 16 + fr; y[(size_t)a * 2048 + c] = (acc[m][n][j] + bdn[c]) * g; } } } } };

constexpr int WLDS_FLOATS = 4096 + 512 + 32;
template <bool SHARED>
__device__ __forceinline__ void wave_attn(float* sw, const float* __restrict__ qptr, const float* __restrict__ Kb, const float* __restrict__ Vb, int ld, int nseg, float scale, float* __restrict__ optr) {
    const int lane = threadIdx.x & 63;
    float* sq = sw + 4096; const int* segs = (const int*)(sw + 4096 + 512);
#pragma unroll
    for (int i = 0; i < 8; ++i) sq[lane + 64 * i] = qptr[lane + 64 * i];
    wave_sync();
    for (int sg = 0; sg < nseg; ++sg) {
        const int start = segs[sg], len = segs[16 + sg];
        float d0 = 0.f, d1 = 0.f, d2 = 0.f, d3 = 0.f;
        if (lane < len) {
            const float* kp = Kb + (size_t)(start + lane) * ld;
            for (int d4 = 0; d4 < 32; ++d4) {
                if (SHARED) {
                    const float4 kv = *(const float4*)(kp + d4 * 4);
                    const float4 q0 = *(const float4*)(sq + d4 * 4), q1 = *(const float4*)(sq + 128 + d4 * 4), q2 = *(const float4*)(sq + 256 + d4 * 4), q3 = *(const float4*)(sq + 384 + d4 * 4);
                    d0 += kv.x * q0.x + kv.y * q0.y + kv.z * q0.z + kv.w * q0.w;
                    d1 += kv.x * q1.x + kv.y * q1.y + kv.z * q1.z + kv.w * q1.w;
                    d2 += kv.x * q2.x + kv.y * q2.y + kv.z * q2.z + kv.w * q2.w;
                    d3 += kv.x * q3.x + kv.y * q3.y + kv.z * q3.z + kv.w * q3.w;
                } else {
                    const float4 k0 = *(const float4*)(kp + d4 * 4), k1 = *(const float4*)(kp + 128 + d4 * 4), k2 = *(const float4*)(kp + 256 + d4 * 4), k3 = *(const float4*)(kp + 384 + d4 * 4);
                    const float4 q0 = *(const float4*)(sq + d4 * 4), q1 = *(const float4*)(sq + 128 + d4 * 4), q2 = *(const float4*)(sq + 256 + d4 * 4), q3 = *(const float4*)(sq + 384 + d4 * 4);
                    d0 += k0.x * q0.x + k0.y * q0.y + k0.z * q0.z + k0.w * q0.w;
                    d1 += k1.x * q1.x + k1.y * q1.y + k1.z * q1.z + k1.w * q1.w;
                    d2 += k2.x * q2.x + k2.y * q2.y + k2.z * q2.z + k2.w * q2.w;
                    d3 += k3.x * q3.x + k3.y * q3.y + k3.z * q3.z + k3.w * q3.w;
                }
            }
        }
        const bool ok = lane < len;
        sw[sg * 64 + lane] = ok ? d0 * scale : -1e30f;
        sw[1024 + sg * 64 + lane] = ok ? d1 * scale : -1e30f;
        sw[2048 + sg * 64 + lane] = ok ? d2 * scale : -1e30f;
        sw[3072 + sg * 64 + lane] = ok ? d3 * scale : -1e30f;
    }
    wave_sync();
    const int n = nseg * 64;
#pragma unroll
    for (int g = 0; g < 4; ++g) {
        float mx = -1e30f;
        for (int i = lane; i < n; i += 64) mx = fmaxf(mx, sw[g * 1024 + i]);
        mx = wave_max(mx);
        float sm = 0.f;
        for (int i = lane; i < n; i += 64) { const float v = sw[g * 1024 + i]; sm += (v > -1e29f) ? expf(v - mx) : 0.f; }
        sm = wave_sum(sm);
        const float inv = sm > 0.f ? 1.f / sm : 0.f;
        for (int i = lane; i < n; i += 64) { const float v = sw[g * 1024 + i]; sw[g * 1024 + i] = (v > -1e29f) ? expf(v - mx) * inv : 0.f; }
    }
    wave_sync();
    float o[4][2];
#pragma unroll
    for (int g = 0; g < 4; ++g) { o[g][0] = 0.f; o[g][1] = 0.f; }
    for (int sg = 0; sg < nseg; ++sg) {
        const int start = segs[sg], len = segs[16 + sg];
        for (int l = 0; l < len; ++l) {
            const float* vp = Vb + (size_t)(start + l) * ld;
            if (SHARED) {
                const float v0 = vp[lane], v1 = vp[lane + 64];
#pragma unroll
                for (int g = 0; g < 4; ++g) { const float p = sw[g * 1024 + sg * 64 + l]; o[g][0] += p * v0; o[g][1] += p * v1; }
            } else {
#pragma unroll
                for (int g = 0; g < 4; ++g) { const float p = sw[g * 1024 + sg * 64 + l]; o[g][0] += p * vp[g * 128 + lane]; o[g][1] += p * vp[g * 128 + lane + 64]; }
            }
        }
    }
#pragma unroll
    for (int g = 0; g < 4; ++g) { optr[g * 128 + lane] = o[g][0]; optr[g * 128 + lane + 64] = o[g][1]; }
}

namespace g8 {
constexpr int BM = 256, BK = 64, HALF = 128, HTB = HALF * BK * 2, STAGE_BYTES = 8 * HTB;
constexpr int KK = 2048;
typedef float f32x4 __attribute__((ext_vector_type(4)));
__device__ __forceinline__ int lds_byte(int r, int c) { const int st = (r >> 4) * 2 + (c >> 5), rr = r & 15, cc = c & 31, ob = rr * 64 + cc * 2; return st * 1024 + (ob ^ (((ob >> 9) & 1) << 5)); }
__device__ __forceinline__ void stage_rc(int b, int& R, int& C) { const int st = b / 1024, sb = b % 1024, swz = sb ^ (((sb >> 9) & 1) << 5); R = (st >> 1) * 16 + swz / 64; C = (st & 1) * 32 + (swz % 64) / 2; }
__device__ __forceinline__ int perm32(int rho) { const int n = rho >> 4, i = rho & 15; return 8 * (i >> 2) + 4 * n + (i & 3); }

typedef int i32x4 __attribute__((ext_vector_type(4)));
typedef unsigned u32x2 __attribute__((ext_vector_type(2)));
typedef unsigned u32x4 __attribute__((ext_vector_type(4)));
template <bool I8> struct AccSel { typedef f32x4 T; };
template <> struct AccSel<true> { typedef i32x4 T; };
__device__ __forceinline__ f32x4 mma16(i32x4 a, i32x4 b, f32x4 c) { return __builtin_amdgcn_mfma_f32_16x16x32_f16(*reinterpret_cast<h8*>(&a), *reinterpret_cast<h8*>(&b), c, 0, 0, 0); }
__device__ __forceinline__ i32x4 mma16(i32x4 a, i32x4 b, i32x4 c) { return __builtin_amdgcn_mfma_i32_16x16x64_i8(a, b, c, 0, 0, 0); }
struct Unit { int m0, n0, e, cnt, rbase; };
constexpr int EP_OFF = STAGE_BYTES + 512, EP_LD = 528, EP_GRP = 16 * EP_LD;
__device__ __forceinline__ void ep_sync() { asm volatile("s_waitcnt lgkmcnt(0)" ::: "memory"); __builtin_amdgcn_s_barrier(); asm volatile("" ::: "memory"); }
__device__ __forceinline__ int ep_tid() { int tz = threadIdx.x; asm volatile("" : "+v"(tz)); return tz; }
__device__ __forceinline__ h8 cvt8(f32x4 a, f32x4 b) { h8 o; o[0] = (_Float16)a[0]; o[1] = (_Float16)a[1]; o[2] = (_Float16)a[2]; o[3] = (_Float16)a[3]; o[4] = (_Float16)b[0]; o[5] = (_Float16)b[1]; o[6] = (_Float16)b[2]; o[7] = (_Float16)b[3]; return o; }

__device__ __forceinline__ void tile_order(int L, int nM, int nN, int& pm, int& pn) {
    const int nwg = nM * nN; int wgid = L;
    { const int q = nwg / 8, r = nwg % 8, xcd = wgid % 8, off = wgid / 8; wgid = (xcd < r ? xcd * (q + 1) : r * (q + 1) + (xcd - r) * q) + off; }
    const int nig = 8 * nN, gid = wgid / nig, fm = gid * 8, gsz = (nM - fm) < 8 ? (nM - fm) : 8;
    pm = fm + ((wgid % nig) % gsz); pn = (wgid % nig) / gsz;
}

template <class Prob>
__device__ __forceinline__ void gemm_phase(LAS unsigned char* lds, const Prob& P) {
    const int tid = threadIdx.x, wid = __builtin_amdgcn_readfirstlane(tid >> 6), lane = tid & 63, wr = wid >> 2, wc = wid & 3, fr = lane & 15, fq = lane >> 4;
    constexpr int nt = Prob::NT; constexpr size_t KS2 = Prob::KS2; constexpr unsigned ROWB = Prob::ROWB; constexpr bool I8 = Prob::I8;
    int sR[2], sC2[2]; unsigned voffB[2];
#pragma unroll
    for (int i = 0; i < 2; ++i) { int R, C; stage_rc(tid * 16 + i * 8192, R, C); sR[i] = R; sC2[i] = C * 2; const int Rb = Prob::PERM ? ((R & ~31) + perm32(R & 31)) : R; voffB[i] = (unsigned)Rb * ROWB + (unsigned)C * 2u; }
    const size_t kstep = (size_t)(BK * 2);
    const size_t hstep = (size_t)HALF * ROWB;
    const unsigned ldsw = (unsigned)wid * 1024u;
    const int aoff = lds_byte(wr * 64 + fr, fq * 8), boff = lds_byte(wc * 32 + fr, fq * 8);
#define G8_SA(b, h) (((b) * 2 + (h)) * HTB)
#define G8_SB(b, h) ((4 + (b) * 2 + (h)) * HTB)
#define G8_STAGE(bufoff, gbase, voff) do { _Pragma("unroll") for (int _i = 0; _i < 2; ++_i) \
        __builtin_amdgcn_global_load_lds((const unsigned*)((const char*)(gbase) + (voff)[_i]), (LAS unsigned*)(lds + (bufoff) + ldsw + _i * 8192), 16, 0, 0); } while (0)
#define G8_LDA(dst, b, h) do { _Pragma("unroll") for (int m = 0; m < 4; ++m) _Pragma("unroll") for (int k = 0; k < 2; ++k) dst[m][k] = *(const LAS i32x4*)(lds + G8_SA(b, h) + aoff + m * 2048 + k * 1024); } while (0)
#define G8_LDB(dst, b, h) do { _Pragma("unroll") for (int n = 0; n < 2; ++n) _Pragma("unroll") for (int k = 0; k < 2; ++k) dst[n][k] = *(const LAS i32x4*)(lds + G8_SB(b, h) + boff + n * 2048 + k * 1024); } while (0)
#define G8_MMA(ai, bj, At, Bt) do { __builtin_amdgcn_s_setprio(1); _Pragma("unroll") for (int m = 0; m < 4; ++m) _Pragma("unroll") for (int n = 0; n < 2; ++n) _Pragma("unroll") for (int k = 0; k < 2; ++k) \
        acc[ai][bj][m][n] = mma16(Bt[n][k], At[m][k], acc[ai][bj][m][n]); __builtin_amdgcn_s_setprio(0); } while (0)
#define G8_WAIT_V(n) asm volatile("s_waitcnt vmcnt(" #n ")" ::: "memory")
#define G8_WAIT_L(n) asm volatile("s_waitcnt lgkmcnt(" #n ")" ::: "memory")
#define G8_BAR __builtin_amdgcn_s_barrier()
#define G8_SCHED __builtin_amdgcn_sched_barrier(0)
    Unit cur, nxt; int ui = 0;
    if (!P.next(0, cur)) return;
    typedef typename AccSel<I8>::T AccT;
    AccT acc[2][2][4][2];
#pragma unroll
    for (int a = 0; a < 2; ++a)
#pragma unroll
        for (int b = 0; b < 2; ++b)
#pragma unroll
            for (int m = 0; m < 4; ++m)
#pragma unroll
                for (int n = 0; n < 2; ++n) acc[a][b][m][n] = AccT{};
    i32x4 At[4][2], B0[2][2], B1[2][2];
    unsigned vc[2][2], vn[2][2];
    P.a_offs(cur, sR, sC2, vc);
    const char* const Ab = P.a_base();
    const char* cB = P.b_base(cur);
    G8_STAGE(G8_SB(0, 0), cB, voffB); G8_STAGE(G8_SA(0, 0), Ab, vc[0]); G8_STAGE(G8_SB(0, 1), cB + hstep, voffB); G8_STAGE(G8_SA(0, 1), Ab, vc[1]);
    if (wr == 1) G8_BAR;
    G8_WAIT_V(4); G8_BAR;
    G8_STAGE(G8_SB(1, 0), cB + kstep, voffB); G8_STAGE(G8_SA(1, 0), Ab + kstep, vc[0]); G8_STAGE(G8_SB(1, 1), cB + hstep + kstep, voffB);
    G8_WAIT_V(6); G8_BAR;
    for (;;) {
        const bool has_next = P.next(ui + 1, nxt);
        const char* nB = cB;
        if (has_next) { P.a_offs(nxt, sR, sC2, vn); nB = P.b_base(nxt); }
        else { vn[0][0] = vc[0][0]; vn[0][1] = vc[0][1]; vn[1][0] = vc[1][0]; vn[1][1] = vc[1][1]; }
        for (int t = 0; t < nt; t += 2) {
            const bool last = (t == nt - 2);
            const char* a1 = Ab + (size_t)(t >> 1) * KS2 + kstep;
            const char* a2 = last ? Ab : Ab + (size_t)((t + 2) >> 1) * KS2; const char* b2 = last ? nB : cB + (size_t)(t + 2) * kstep;
            const char* a3 = a2 + kstep; const char* b3 = b2 + kstep;
            unsigned o2[2][2];
            o2[0][0] = last ? vn[0][0] : vc[0][0]; o2[0][1] = last ? vn[0][1] : vc[0][1]; o2[1][0] = last ? vn[1][0] : vc[1][0]; o2[1][1] = last ? vn[1][1] : vc[1][1];
            G8_LDB(B0, 0, 0); G8_SCHED; G8_LDA(At, 0, 0); G8_STAGE(G8_SA(1, 1), a1, vc[1]);
            G8_WAIT_L(8); G8_BAR; G8_WAIT_L(0); G8_MMA(0, 0, At, B0); G8_BAR; G8_SCHED;
            G8_LDB(B1, 0, 1); G8_STAGE(G8_SB(0, 0), b2, voffB);
            G8_BAR; G8_WAIT_L(0); G8_MMA(0, 1, At, B1); G8_BAR;
            G8_LDA(At, 0, 1); G8_STAGE(G8_SA(0, 0), a2, o2[0]);
            G8_BAR; G8_WAIT_L(0); G8_MMA(1, 0, At, B0); G8_BAR; G8_SCHED;
            G8_STAGE(G8_SB(0, 1), b2 + hstep, voffB);
            G8_WAIT_V(6); G8_BAR; G8_MMA(1, 1, At, B1); G8_BAR;
            G8_LDB(B0, 1, 0); G8_SCHED; G8_LDA(At, 1, 0); G8_STAGE(G8_SA(0, 1), a2, o2[1]);
            G8_WAIT_L(8); G8_BAR; G8_WAIT_L(0); G8_MMA(0, 0, At, B0); G8_BAR; G8_SCHED;
            G8_LDB(B1, 1, 1); G8_STAGE(G8_SB(1, 0), b3, voffB);
            G8_BAR; G8_WAIT_L(0); G8_MMA(0, 1, At, B1); G8_BAR;
            G8_LDA(At, 1, 1); G8_STAGE(G8_SA(1, 0), a3, o2[0]);
            G8_BAR; G8_WAIT_L(0); G8_MMA(1, 0, At, B0); G8_BAR; G8_SCHED;
            G8_STAGE(G8_SB(1, 1), b3 + hstep, voffB);
            G8_WAIT_V(6); G8_BAR; G8_MMA(1, 1, At, B1); G8_BAR;
        }
        P.epi(acc, cur, wr, wc, fr, fq, lds);
        if (!has_next) break;
#pragma unroll
        for (int a = 0; a < 2; ++a)
#pragma unroll
            for (int b = 0; b < 2; ++b)
#pragma unroll
                for (int m = 0; m < 4; ++m)
#pragma unroll
                    for (int n = 0; n < 2; ++n) acc[a][b][m][n] = AccT{};
        cur = nxt; cB = nB; ++ui;
        vc[0][0] = vn[0][0]; vc[0][1] = vn[0][1]; vc[1][0] = vn[1][0]; vc[1][1] = vn[1][1];
    }
    G8_WAIT_V(0);
    if (wr == 0) G8_BAR;
    G8_BAR;
#undef G8_SA
#undef G8_SB
#undef G8_STAGE
#undef G8_LDA
#undef G8_LDB
#undef G8_MMA
#undef G8_WAIT_V
#undef G8_WAIT_L
#undef G8_BAR
#undef G8_SCHED
}

struct ProbIn {
    static constexpr unsigned ROWB = 4096; static constexpr bool I8 = false;
    static constexpr int NT = 32; static constexpr size_t KS2 = 256;
    static constexpr bool PERM = true;
    const _Float16* A; _Float16* C16; int G, c;
    __device__ __forceinline__ bool next(int i, Unit& u) const { const int L = i * G + c; if (L >= 64 * 15 + 32) return false;
        if (L < 64 * 15) { int pm, pn; tile_order(L, 64, 15, pm, pn); u.m0 = pm * 256; u.n0 = pn * 256; u.e = 0; }
        else { const int v = L - 64 * 15; u.m0 = T_ + (v & 7) * 256; u.n0 = (v >> 3) * 256; u.e = 1; }
        u.cnt = 256; u.rbase = 0; return true; }
    __device__ __forceinline__ void a_offs(const Unit& u, const int (&R)[2], const int (&C2)[2], unsigned (&v)[2][2]) const {
#pragma unroll
        for (int h = 0; h < 2; ++h)
#pragma unroll
            for (int i = 0; i < 2; ++i) v[h][i] = (unsigned)(u.m0 + h * 128 + R[i]) * (unsigned)(KK * 2) + (unsigned)C2[i]; }
    __device__ __forceinline__ const char* a_base() const { return (const char*)A; }
    __device__ __forceinline__ const char* b_base(const Unit& u) const { return (const char*)A + (u.e ? (long long)(WS_WTMKV - WS_X16) : (long long)(WS_WTIN - WS_X16)) + (size_t)u.n0 * KK * 2; }
    __device__ __forceinline__ void epi(const f32x4 (&acc)[2][2][4][2], const Unit& u, int wr, int wc, int fr, int fq, LAS unsigned char* lds) const {
        LAS unsigned char* ep = lds + EP_OFF + wr * EP_GRP;
        const int tg = ep_tid() & 255, rrow = tg >> 4, ch = tg & 15;
        const int kvseg = (u.e == 0 && u.n0 >= 1024 && u.n0 < 2560) ? ((u.n0 - 1024) >> 8) : -1;
        _Float16* const Cb = (_Float16*)((char*)C16 + (u.e ? (long long)(WS_KVMEM16 - WS_PROJ16) : 0ll)); const int ldc = u.e ? 1024 : INW, nlim = u.e ? 1024 : INW, mb = u.e ? u.m0 - T_ : u.m0;
#pragma unroll
        for (int ai = 0; ai < 2; ++ai)
#pragma unroll
            for (int m = 0; m < 4; ++m) {
#pragma unroll
                for (int bj = 0; bj < 2; ++bj) *(LAS h8*)(ep + fr * EP_LD + (bj * 128 + wc * 32 + fq * 8) * 2) = cvt8(acc[ai][bj][m][0], acc[ai][bj][m][1]);
                ep_sync();
                const h8 x0 = *(const LAS h8*)(ep + rrow * EP_LD + ch * 32), x1 = *(const LAS h8*)(ep + rrow * EP_LD + ch * 32 + 16);
                const int grow = mb + ai * 128 + wr * 64 + m * 16 + rrow, gcol = u.n0 + ch * 16;
                if (kvseg >= 0) {
                    _Float16* dst = (_Float16*)((char*)C16 + (long long)(WS_KV16 - WS_PROJ16)) + ((size_t)(kvseg * B_ + (grow >> 11)) * 2 + (ch >> 3)) * KVSEG + (size_t)(grow & (S_ - 1)) * 128 + (ch & 7) * 16;
                    *(h8*)dst = x0; *(h8*)(dst + 8) = x1;
                } else {
                    if (gcol < nlim) *(h8*)(Cb + (size_t)grow * ldc + gcol) = x0;
                    if (gcol + 8 < nlim) *(h8*)(Cb + (size_t)grow * ldc + gcol + 8) = x1; }
                ep_sync();
            } }
};
struct ProbOut {
    static constexpr unsigned ROWB = 2048; static constexpr bool I8 = true;
    static constexpr int NT = 16; static constexpr size_t KS2 = 256;
    static constexpr bool PERM = true;
    const signed char* A; const signed char* Bt; _Float16* C; const _Float16* X; const float* sa; const float* sw; int G, c;
    __device__ __forceinline__ bool next(int i, Unit& u) const { const int L = i * G + c; if (L >= 64 * 8) return false; int pm, pn; tile_order(L, 64, 8, pm, pn); u.m0 = pm * 256; u.n0 = pn * 256; u.e = 0; u.cnt = 256; u.rbase = 0; return true; }
    __device__ __forceinline__ void a_offs(const Unit& u, const int (&R)[2], const int (&C2)[2], unsigned (&v)[2][2]) const {
#pragma unroll
        for (int h = 0; h < 2; ++h)
#pragma unroll
            for (int i = 0; i < 2; ++i) v[h][i] = (unsigned)(u.m0 + h * 128 + R[i]) * 2048u + (unsigned)C2[i]; }
    __device__ __forceinline__ const char* a_base() const { return (const char*)A; }
    __device__ __forceinline__ const char* b_base(const Unit& u) const { return (const char*)(Bt + (size_t)u.n0 * 2048); }
    __device__ __forceinline__ void epi(const i32x4 (&acc)[2][2][4][2], const Unit& u, int wr, int wc, int fr, int fq, LAS unsigned char* lds) const {
        LAS unsigned char* ep = lds + EP_OFF + wr * EP_GRP;
        const int tg = ep_tid() & 255, rrow = tg >> 4, ch = tg & 15;
        f32x4 s0[2], s1[2]; float srv[8];
#pragma unroll
        for (int bj = 0; bj < 2; ++bj) { const int col = u.n0 + bj * 128 + wc * 32 + fq * 8; s0[bj] = *(const f32x4*)(sw + col); s1[bj] = *(const f32x4*)(sw + col + 4); }
#pragma unroll
        for (int q = 0; q < 8; ++q) srv[q] = sa[u.m0 + (q >> 2) * 128 + wr * 64 + (q & 3) * 16 + fr];
#pragma unroll
        for (int ai = 0; ai < 2; ++ai)
#pragma unroll
            for (int m = 0; m < 4; ++m) { const float sr = srv[ai * 4 + m];
#pragma unroll
                for (int bj = 0; bj < 2; ++bj) { const i32x4 i0 = acc[ai][bj][m][0], i1 = acc[ai][bj][m][1];
                    *(LAS h8*)(ep + fr * EP_LD + (bj * 128 + wc * 32 + fq * 8) * 2) = cvt8((f32x4){(float)i0[0], (float)i0[1], (float)i0[2], (float)i0[3]} * (s0[bj] * sr), (f32x4){(float)i1[0], (float)i1[1], (float)i1[2], (float)i1[3]} * (s1[bj] * sr)); }
                const size_t go = (size_t)(u.m0 + ai * 128 + wr * 64 + m * 16 + rrow) * 2048 + u.n0 + ch * 16;
                const h8 r0 = *(const h8*)(X + go), r1 = *(const h8*)(X + go + 8);
                ep_sync();
                const h8 x0 = *(const LAS h8*)(ep + rrow * EP_LD + ch * 32), x1 = *(const LAS h8*)(ep + rrow * EP_LD + ch * 32 + 16);
                h8 o0, o1;
#pragma unroll
                for (int q = 0; q < 8; ++q) { o0[q] = (_Float16)(DN_ALPHA * (float)r0[q] + (float)x0[q]); o1[q] = (_Float16)(DN_ALPHA * (float)r1[q] + (float)x1[q]); }
                *(h8*)(C + go) = o0; *(h8*)(C + go + 8) = o1;
                ep_sync();
            } }
};
struct ProbCmp {
    static constexpr unsigned ROWB = 4096; static constexpr bool I8 = false;
    static constexpr int NT = 8; static constexpr size_t KS2 = 256;
    static constexpr bool PERM = false;
    const _Float16* A; const _Float16* Bt; float* C; int G, c;
    __device__ __forceinline__ bool next(int i, Unit& u) const { const int L = i * G + c; if (L >= 128) return false;
        u.e = L >> 6; const int r = L & 63; u.rbase = r & 3; u.n0 = ((r >> 2) & 1) * 256; u.m0 = (r >> 3) * 256; u.cnt = 256; return true; }
    __device__ __forceinline__ void a_offs(const Unit& u, const int (&R)[2], const int (&C2)[2], unsigned (&v)[2][2]) const {
#pragma unroll
        for (int h = 0; h < 2; ++h)
#pragma unroll
            for (int i = 0; i < 2; ++i) { const int row = u.m0 + h * 128 + R[i], kvh = row & 1, bj = row >> 1, b = bj >> 7, j = bj & 127;
                v[h][i] = (unsigned)((((u.e * B_ + b) * 2 + kvh) * S_ + 16 * j + 4 * u.rbase) * 128) * 2u + (unsigned)C2[i]; } }
    __device__ __forceinline__ const char* a_base() const { return (const char*)A; }
    __device__ __forceinline__ const char* b_base(const Unit& u) const { return (const char*)(Bt + ((size_t)u.e * 512 + u.n0) * KK + u.rbase * 512); }
    __device__ __forceinline__ void epi(const f32x4 (&acc)[2][2][4][2], const Unit& u, int wr, int wc, int fr, int fq, LAS unsigned char*) const {
        float* base = C + ((size_t)(u.e * 4 + u.rbase) * 2048) * 512;
#pragma unroll
        for (int ai = 0; ai < 2; ++ai)
#pragma unroll
            for (int m = 0; m < 4; ++m) { const int row = u.m0 + ai * 128 + wr * 64 + m * 16 + fr;
#pragma unroll
                for (int bj = 0; bj < 2; ++bj)
#pragma unroll
                    for (int n = 0; n < 2; ++n) { const int col = u.n0 + bj * 128 + wc * 32 + n * 16 + fq * 4;
                        *(f32x4*)(base + (size_t)row * 512 + col) = acc[ai][bj][m][n]; } } }
};
struct MoeTab { const LAS int* t; int NT;
    __device__ __forceinline__ bool find(int L, Unit& u) const {
        const int total = __builtin_amdgcn_readfirstlane(t[98]); if (L >= total) return false;
        int e = 0;
        for (; e < NE - 1; ++e) { if (L < __builtin_amdgcn_readfirstlane(t[32 + e + 1])) break; }
        const int ub = __builtin_amdgcn_readfirstlane(t[32 + e]), cn = __builtin_amdgcn_readfirstlane(t[e]), rs = __builtin_amdgcn_readfirstlane(t[65 + e]);
        const int nm = (cn + 255) >> 8, v = L - ub, mt = v % nm, ntile = v / nm;
        u.e = e; u.m0 = mt * 256; u.n0 = ntile * 256; u.cnt = min(256, cn - mt * 256); u.rbase = rs; return true; } };
struct ProbGu {
    static constexpr int NT = 16; static constexpr size_t KS2 = 256; static constexpr unsigned ROWB = 2048; static constexpr bool I8 = true;
    static constexpr bool PERM = true;
    const signed char* A; const signed char* Bt; unsigned char* act; const float* bgu; const int* list; const float* sa; const float* sw; MoeTab tab; int G, vcu;
    __device__ __forceinline__ bool next(int i, Unit& u) const { return tab.find(i * G + vcu, u); }
    __device__ __forceinline__ void a_offs(const Unit& u, const int (&R)[2], const int (&C2)[2], unsigned (&v)[2][2]) const {
#pragma unroll
        for (int h = 0; h < 2; ++h)
#pragma unroll
            for (int i = 0; i < 2; ++i) { int r = h * 128 + R[i]; r = r < u.cnt ? r : 0; const int a = list[(size_t)u.e * T_ + u.m0 + r]; v[h][i] = (unsigned)(a >> 2) * 2048u + (unsigned)C2[i]; } }
    __device__ __forceinline__ const char* a_base() const { return (const char*)A; }
    __device__ __forceinline__ const char* b_base(const Unit& u) const { return (const char*)(Bt + ((size_t)u.e * 4096 + u.n0) * 2048); }
    __device__ __forceinline__ void epi(const i32x4 (&acc)[2][2][4][2], const Unit& u, int wr, int wc, int fr, int fq, LAS unsigned char* lds) const {
        const float* bb = bgu + (size_t)u.e * 4096; const float* ss = sw + (size_t)u.e * 4096;
        LAS unsigned char* ep = lds + EP_OFF + wr * EP_GRP;
        const int tg = ep_tid() & 255, rrow = tg >> 4, ch = tg & 15;
        f32x4 b0[2], b1[2], s0[2], s1[2];
#pragma unroll
        for (int bj = 0; bj < 2; ++bj) { const int col = u.n0 + bj * 128 + wc * 32 + fq * 8;
            b0[bj] = *(const f32x4*)(bb + col); b1[bj] = *(const f32x4*)(bb + col + 4); s0[bj] = *(const f32x4*)(ss + col); s1[bj] = *(const f32x4*)(ss + col + 4); }
        float srv[8];
        { int av[8];
#pragma unroll
          for (int q = 0; q < 8; ++q) { const int rl = (q >> 2) * 128 + wr * 64 + (q & 3) * 16 + fr; av[q] = list[(size_t)u.e * T_ + u.m0 + (rl < u.cnt ? rl : 0)]; }
#pragma unroll
          for (int q = 0; q < 8; ++q) srv[q] = sa[av[q] >> 2]; }
        LAS unsigned char* ep2 = lds + EP_OFF + wr * (2 * 16 * 144);
#pragma unroll
        for (int ai = 0; ai < 2; ++ai)
#pragma unroll
            for (int mp = 0; mp < 2; ++mp) {
#pragma unroll
                for (int mm = 0; mm < 2; ++mm) { const int m = mp * 2 + mm; const float sr = srv[ai * 4 + m];
#pragma unroll
                    for (int bj = 0; bj < 2; ++bj) {
                        const i32x4 i0 = acc[ai][bj][m][0], i1 = acc[ai][bj][m][1];
                        const f32x4 v0 = (f32x4){(float)i0[0], (float)i0[1], (float)i0[2], (float)i0[3]} * (s0[bj] * sr) + b0[bj], v1 = (f32x4){(float)i1[0], (float)i1[1], (float)i1[2], (float)i1[3]} * (s1[bj] * sr) + b1[bj];
                        *(LAS unsigned*)(ep2 + (mm * 16 + fr) * 144 + (bj * 64 + wc * 16 + fq * 4)) = pk4_fp8(swiglu_fast(v0[0], v0[1]), swiglu_fast(v0[2], v0[3]), swiglu_fast(v1[0], v1[1]), swiglu_fast(v1[2], v1[3])); } }
                ep_sync();
#pragma unroll
                for (int mm = 0; mm < 2; ++mm) { const u32x2 x0 = *(const LAS u32x2*)(ep2 + (mm * 16 + rrow) * 144 + ch * 8);
                    const int rr = ai * 128 + wr * 64 + (mp * 2 + mm) * 16 + rrow;
                    if (rr < u.cnt) *(u32x2*)(act + (size_t)(u.rbase + u.m0 + rr) * 2048 + (u.n0 >> 1) + ch * 8) = x0; }
                ep_sync();
            } }
};
struct ProbDn {
    static constexpr int NT = 16; static constexpr size_t KS2 = 256; static constexpr unsigned ROWB = 2048; static constexpr bool I8 = true;
    static constexpr bool PERM = true;
    const signed char* A; const signed char* Bt; unsigned char* y; const float* bdn; const int* list; const float* gate; const float* sa; const float* sw; MoeTab tab; int G, vcu;
    __device__ __forceinline__ bool next(int i, Unit& u) const { return tab.find(i * G + vcu, u); }
    __device__ __forceinline__ void a_offs(const Unit& u, const int (&R)[2], const int (&C2)[2], unsigned (&v)[2][2]) const {
#pragma unroll
        for (int h = 0; h < 2; ++h)
#pragma unroll
            for (int i = 0; i < 2; ++i) v[h][i] = (unsigned)(u.rbase + u.m0 + h * 128 + R[i]) * 2048u + (unsigned)C2[i]; }
    __device__ __forceinline__ const char* a_base() const { return (const char*)A; }
    __device__ __forceinline__ const char* b_base(const Unit& u) const { return (const char*)(Bt + ((size_t)u.e * 2048 + u.n0) * 2048); }
    __device__ __forceinline__ void epi(const i32x4 (&acc)[2][2][4][2], const Unit& u, int wr, int wc, int fr, int fq, LAS unsigned char* lds) const {
        const float* bb = bdn + (size_t)u.e * 2048; const float* ss = sw + (size_t)u.e * 2048;
        LAS unsigned char* ep = lds + EP_OFF + wr * EP_GRP;
        const int tg = ep_tid() & 255, rrow = tg >> 4, ch = tg & 15;
        f32x4 b0[2], b1[2], s0[2], s1[2];
#pragma unroll
        for (int bj = 0; bj < 2; ++bj) { const int col = u.n0 + bj * 128 + wc * 32 + fq * 8;
            b0[bj] = *(const f32x4*)(bb + col); b1[bj] = *(const f32x4*)(bb + col + 4); s0[bj] = *(const f32x4*)(ss + col); s1[bj] = *(const f32x4*)(ss + col + 4); }
        float gv[8], srv[8]; int a2v[8];
        { int av[8];
#pragma unroll
          for (int q = 0; q < 8; ++q) { const int rl = (q >> 2) * 128 + wr * 64 + (q & 3) * 16 + fr, rc = rl < u.cnt ? rl : 0; av[q] = list[(size_t)u.e * T_ + u.m0 + rc]; srv[q] = sa[u.rbase + u.m0 + rc];
              const int rr = (q >> 2) * 128 + wr * 64 + (q & 3) * 16 + rrow; a2v[q] = list[(size_t)u.e * T_ + u.m0 + (rr < u.cnt ? rr : 0)]; }
#pragma unroll
          for (int q = 0; q < 8; ++q) gv[q] = gate[av[q]]; }
#pragma unroll
        for (int ai = 0; ai < 2; ++ai)
#pragma unroll
            for (int m = 0; m < 4; ++m) { const float g = gv[ai * 4 + m] * 16.f, sr = srv[ai * 4 + m];
#pragma unroll
                for (int bj = 0; bj < 2; ++bj) {
                    const i32x4 i0 = acc[ai][bj][m][0], i1 = acc[ai][bj][m][1];
                    const f32x4 v0 = ((f32x4){(float)i0[0], (float)i0[1], (float)i0[2], (float)i0[3]} * (s0[bj] * sr) + b0[bj]) * g, v1 = ((f32x4){(float)i1[0], (float)i1[1], (float)i1[2], (float)i1[3]} * (s1[bj] * sr) + b1[bj]) * g;
                    u32x2 o; o[0] = pk4_fp8(v0[0], v0[1], v0[2], v0[3]); o[1] = pk4_fp8(v1[0], v1[1], v1[2], v1[3]);
                    *(LAS u32x2*)(ep + fr * 272 + (bj * 128 + wc * 32 + fq * 8)) = o; }
                const int rr = ai * 128 + wr * 64 + m * 16 + rrow;
                const int a2 = a2v[ai * 4 + m];
                ep_sync();
                const u32x4 x0 = *(const LAS u32x4*)(ep + rrow * 272 + ch * 16);
                if (rr < u.cnt) *(u32x4*)(y + (size_t)a2 * 2048 + u.n0 + ch * 16) = x0;
                ep_sync();
            } }
};
}

namespace at8 {
typedef float f32x16 __attribute__((ext_vector_type(16)));
typedef short s16x4 __attribute__((ext_vector_type(4)));
typedef unsigned u32x4 __attribute__((ext_vector_type(4)));
constexpr int SHM_V = 64 * 128 * 2, SHM_K = 64 * 128 * 2;
constexpr int LDS_WS = 2 * SHM_V + 2 * SHM_K;
constexpr int LDS_END = LDS_WS + 8 * 64 * 4;
constexpr float CEXP = ATT_SCALE * 1.4426950408889634f;
constexpr float THR_RAW = 8.f / ATT_SCALE;
#define AT_KSWZ(row, colB) ((row) * 256 + ((colB) ^ (((row) & 7) << 4)))
#define AT_SBAR() __builtin_amdgcn_sched_barrier(0)
__device__ __forceinline__ int crow(int r, int hi) { return (r & 3) + 8 * (r >> 2) + 4 * hi; }
__device__ __forceinline__ unsigned cvtpk(float lo, float hi) { auto v = __builtin_amdgcn_cvt_pkrtz(lo, hi); return *reinterpret_cast<unsigned*>(&v); }
__device__ __forceinline__ int v_st(int k, int c) { const int kk = (k & ~0xC) | ((k & 4) << 1) | ((k & 8) >> 1); return ((kk >> 3) * 4 + (c >> 5)) * 512 + ((kk & 7) * 32 + (c & 31)) * 2; }
__device__ __forceinline__ int v_rd_base(int lane) { return ((lane & 3) << 3) | (((lane >> 2) & 3) << 6) | (((lane >> 4) & 1) << 5) | (((lane >> 5) & 1) << 8); }
constexpr int v_rd_off(int d0, int ks, int half) { return d0 * 512 + ks * 4096 + half * 2048; }
template <int OFF> __device__ __forceinline__ s16x4 tr_read(int vb) { s16x4 r; asm volatile("ds_read_b64_tr_b16 %0, %1 offset:%2" : "=&v"(r) : "v"(vb), "i"(OFF) : "memory"); return r; }
__device__ __forceinline__ h8 mk8(s16x4 l, s16x4 h) { typedef short s16x8 __attribute__((ext_vector_type(8))); s16x8 w = {l[0], l[1], l[2], l[3], h[0], h[1], h[2], h[3]}; return *reinterpret_cast<h8*>(&w); }
struct VFrag { s16x4 l0, h0, l1, h1, l2, h2, l3, h3; };
template <int D0> __device__ __forceinline__ void pv_read(VFrag& f, int vb) {
    f.l0 = tr_read<v_rd_off(D0, 0, 0)>(vb); f.h0 = tr_read<v_rd_off(D0, 0, 1)>(vb); f.l1 = tr_read<v_rd_off(D0, 1, 0)>(vb); f.h1 = tr_read<v_rd_off(D0, 1, 1)>(vb);
    f.l2 = tr_read<v_rd_off(D0, 2, 0)>(vb); f.h2 = tr_read<v_rd_off(D0, 2, 1)>(vb); f.l3 = tr_read<v_rd_off(D0, 3, 0)>(vb); f.h3 = tr_read<v_rd_off(D0, 3, 1)>(vb);
}
__device__ __forceinline__ void pv_mma(f32x16& od, const VFrag& f, h8 pa0, h8 pa1, h8 pa2, h8 pa3) {
    od = __builtin_amdgcn_mfma_f32_32x32x16_f16(pa0, mk8(f.l0, f.h0), od, 0, 0, 0);
    od = __builtin_amdgcn_mfma_f32_32x32x16_f16(pa1, mk8(f.l1, f.h1), od, 0, 0, 0);
    od = __builtin_amdgcn_mfma_f32_32x32x16_f16(pa2, mk8(f.l2, f.h2), od, 0, 0, 0);
    od = __builtin_amdgcn_mfma_f32_32x32x16_f16(pa3, mk8(f.l3, f.h3), od, 0, 0, 0);
}
__device__ __forceinline__ void pv_d0(f32x16 (&o)[4], int vb, h8 pa0, h8 pa1, h8 pa2, h8 pa3) {
    VFrag fa, fb;
    pv_read<0>(fa, vb); pv_read<1>(fb, vb);
    asm volatile("s_waitcnt lgkmcnt(8)" ::: "memory"); AT_SBAR();
    pv_mma(o[0], fa, pa0, pa1, pa2, pa3); AT_SBAR();
    pv_read<2>(fa, vb);
    asm volatile("s_waitcnt lgkmcnt(8)" ::: "memory"); AT_SBAR();
    pv_mma(o[1], fb, pa0, pa1, pa2, pa3); AT_SBAR();
    pv_read<3>(fb, vb);
    asm volatile("s_waitcnt lgkmcnt(8)" ::: "memory"); AT_SBAR();
    pv_mma(o[2], fa, pa0, pa1, pa2, pa3); AT_SBAR();
    asm volatile("s_waitcnt lgkmcnt(0)" ::: "memory"); AT_SBAR();
    pv_mma(o[3], fb, pa0, pa1, pa2, pa3);
}
__device__ __forceinline__ void qkt(f32x16& p0, f32x16& p1, const char* Ks, const h8 (&qr)[8], int r32, int hi) {
    p0 = f32x16{}; p1 = f32x16{};
#pragma unroll
    for (int d0 = 0; d0 < 8; ++d0) { const int cb = (d0 * 16 + hi * 8) * 2;
        const h8 b0 = *reinterpret_cast<const h8*>(Ks + AT_KSWZ(r32, cb));
        const h8 b1 = *reinterpret_cast<const h8*>(Ks + AT_KSWZ(32 + r32, cb));
        p0 = __builtin_amdgcn_mfma_f32_32x32x16_f16(b0, qr[d0], p0, 0, 0, 0);
        p1 = __builtin_amdgcn_mfma_f32_32x32x16_f16(b1, qr[d0], p1, 0, 0, 0); }
}
__device__ __forceinline__ void pack_p(const f32x16& p0, const f32x16& p1, h8& pa0, h8& pa1, h8& pa2, h8& pa3) {
#define AT_PK4(P, BASE, OUT) do { unsigned a0 = cvtpk(P[BASE + 0], P[BASE + 1]), a1 = cvtpk(P[BASE + 2], P[BASE + 3]); \
    unsigned b0 = cvtpk(P[BASE + 4], P[BASE + 5]), b1 = cvtpk(P[BASE + 6], P[BASE + 7]); \
    auto r0 = __builtin_amdgcn_permlane32_swap(a0, b0, false, false); auto r1 = __builtin_amdgcn_permlane32_swap(a1, b1, false, false); \
    u32x4 w = {r0[0], r1[0], r0[1], r1[1]}; OUT = *reinterpret_cast<h8*>(&w); } while (0)
    AT_PK4(p0, 0, pa0); AT_PK4(p0, 8, pa1); AT_PK4(p1, 0, pa2); AT_PK4(p1, 8, pa3);
#undef AT_PK4
}
__device__ __forceinline__ float half_swap_max(float v) { auto rr = __builtin_amdgcn_permlane32_swap(__float_as_uint(v), __float_as_uint(v), false, false); return fmaxf(__uint_as_float(rr[0]), __uint_as_float(rr[1])); }
__device__ __forceinline__ float half_swap_sum(float v) { auto rr = __builtin_amdgcn_permlane32_swap(__float_as_uint(v), __float_as_uint(v), false, false); return __uint_as_float(rr[0]) + __uint_as_float(rr[1]); }

struct Stage4 { h8 vs0, vs1, ks0, ks1; };
__device__ __forceinline__ int hidden_tid() { int tz = threadIdx.x; asm volatile("" : "+v"(tz)); return tz; }
__device__ __forceinline__ void sload(Stage4& s, const _Float16* Kb, const _Float16* Vb, int ld, int k0) {
    const int tz = hidden_tid(), sr = tz >> 4, sc = (tz & 15) * 8;
    s.vs0 = *(const h8*)(Vb + (size_t)(k0 + sr) * ld + sc); s.vs1 = *(const h8*)(Vb + (size_t)(k0 + 32 + sr) * ld + sc);
    s.ks0 = *(const h8*)(Kb + (size_t)(k0 + sr) * ld + sc); s.ks1 = *(const h8*)(Kb + (size_t)(k0 + 32 + sr) * ld + sc);
}
__device__ __forceinline__ void swrite(const Stage4& s, char* V_lds, char* K_lds, int b) {
    const int tz = hidden_tid(), sr = tz >> 4, sc = (tz & 15) * 8, vst0 = v_st(sr, sc), vst1 = v_st(32 + sr, sc);
    *(h8*)(V_lds + b * SHM_V + vst0) = s.vs0; *(h8*)(V_lds + b * SHM_V + vst1) = s.vs1;
    const int kc = sc * 2;
    *(h8*)(K_lds + b * SHM_K + AT_KSWZ(sr, kc)) = s.ks0; *(h8*)(K_lds + b * SHM_K + AT_KSWZ(32 + sr, kc)) = s.ks1;
}

__device__ __forceinline__ void attn_unit(char* lds, const _Float16* qrow, const _Float16* Kb, const _Float16* Vb, int ld, unsigned tmask, int wlen, int khi, unsigned selmask,
                                          _Float16* outw, int ostride) {
    const int tid = threadIdx.x, wid = __builtin_amdgcn_readfirstlane(tid >> 6), lane = tid & 63, r32 = lane & 31, hi = lane >> 5;
    char* V_lds = lds; char* K_lds = lds + 2 * SHM_V;
    float* wsf = (float*)(lds + LDS_WS) + wid * 64; float* li_l = wsf; float* al_l = wsf + 32;
    float m_reg = -1e30f, l_reg = 0.f; f32x16 o[4] = {}; h8 qr[8];
#pragma unroll
    for (int d0 = 0; d0 < 8; ++d0) qr[d0] = *(const h8*)(qrow + d0 * 16);
    const int vb0 = (int)(uintptr_t)V_lds + v_rd_base(lane);
    Stage4 st;
    unsigned rest = tmask; int j = __ffs(rest) - 1; rest &= rest - 1;
    sload(st, Kb, Vb, ld, j * 64); asm volatile("s_waitcnt vmcnt(0)" ::: "memory"); swrite(st, V_lds, K_lds, 0); __syncthreads();
    int buf = 0;
    for (;;) {
        const int jn = rest ? (__ffs(rest) - 1) : -1;
        if (jn >= 0) sload(st, Kb, Vb, ld, jn * 64);
        f32x16 p0, p1;
        AT_SBAR(); qkt(p0, p1, K_lds + buf * SHM_K, qr, r32, hi);
        { const int klo = wlen > 0 ? khi - wlen + 1 : 0; const bool tb = (selmask >> j) & 1u; const bool inr = (j * 64 >= klo) && (j * 64 + 63 <= khi);
          if (!__all(tb && inr)) {
              if (__all(inr)) {
#pragma unroll
                  for (int r = 0; r < 16; ++r) { p0[r] = tb ? p0[r] : -INFINITY; p1[r] = tb ? p1[r] : -INFINITY; }
              } else {
                  const int kb = j * 64 + 4 * hi;
#pragma unroll
                  for (int r = 0; r < 16; ++r) { const int k0 = kb + (r & 3) + 8 * (r >> 2);
                      p0[r] = (tb && k0 >= klo && k0 <= khi) ? p0[r] : -INFINITY;
                      p1[r] = (tb && (k0 + 32) >= klo && (k0 + 32) <= khi) ? p1[r] : -INFINITY; }
              } } }
        float pmax = p0[0];
#pragma unroll
        for (int r = 1; r < 16; ++r) pmax = fmaxf(pmax, p0[r]);
#pragma unroll
        for (int r = 0; r < 16; ++r) pmax = fmaxf(pmax, p1[r]);
        pmax = half_swap_max(pmax);
        float mn, alpha;
        if (__all(pmax - m_reg <= THR_RAW)) { mn = m_reg; alpha = 1.f; }
        else { mn = fmaxf(m_reg, pmax); alpha = __builtin_amdgcn_exp2f((m_reg - mn) * CEXP); m_reg = mn; }
        const float mnC = -mn * CEXP;
        float ps = 0.f;
#pragma unroll
        for (int r = 0; r < 16; ++r) { p0[r] = __builtin_amdgcn_exp2f(fmaf(p0[r], CEXP, mnC)); ps += p0[r]; }
#pragma unroll
        for (int r = 0; r < 16; ++r) { p1[r] = __builtin_amdgcn_exp2f(fmaf(p1[r], CEXP, mnC)); ps += p1[r]; }
        ps = half_swap_sum(ps);
        l_reg = l_reg * alpha + ps;
        if (__any(alpha < 1.f)) { if (hi == 0) al_l[r32] = alpha; asm volatile("s_waitcnt lgkmcnt(0)" ::: "memory");
#pragma unroll
            for (int r = 0; r < 16; ++r) { const float a = al_l[crow(r, hi)];
#pragma unroll
                for (int d = 0; d < 4; ++d) o[d][r] *= a; } }
        h8 pa0, pa1, pa2, pa3; pack_p(p0, p1, pa0, pa1, pa2, pa3);
        AT_SBAR();
        pv_d0(o, vb0 + buf * SHM_V, pa0, pa1, pa2, pa3);
        if (jn < 0) break;
        asm volatile("s_waitcnt vmcnt(0)" ::: "memory");
        swrite(st, V_lds, K_lds, buf ^ 1);
        __syncthreads();
        buf ^= 1; j = jn; rest &= rest - 1;
    }
    if (hi == 0) li_l[r32] = l_reg; asm volatile("s_waitcnt lgkmcnt(0)" ::: "memory");
#pragma unroll
    for (int r = 0; r < 16; ++r) { const int orow = crow(r, hi); const float l = li_l[orow]; const float rl = l > 0.f ? 1.f / l : 0.f;
#pragma unroll
        for (int d0 = 0; d0 < 4; ++d0) outw[(size_t)orow * ostride + d0 * 32 + r32] = (_Float16)(o[d0][r] * rl); }
    __syncthreads();
}

constexpr int LDS_AP = LDS_END, LDS_BP = LDS_AP + 4 * 64 * 33 * 4, LDS_SELM = LDS_BP + 4 * 64 * 33 * 4, LDS_CS_END = LDS_SELM + 64 * 4;
__device__ __forceinline__ void cmp_slc_unit(char* lds, const _Float16* qrow, const _Float16* Kc, const _Float16* Vc, const _Float16* Ks, const _Float16* Vs, int t, int tl, int g, int qi,
                                             _Float16* outc, _Float16* outs) {
    const int tid = threadIdx.x, wid = __builtin_amdgcn_readfirstlane(tid >> 6), lane = tid & 63, r32 = lane & 31, hi = lane >> 5;
    char* V_lds = lds; char* K_lds = lds + 2 * SHM_V;
    float* AP = (float*)(lds + LDS_AP); float* BP = (float*)(lds + LDS_BP); unsigned* selm = (unsigned*)(lds + LDS_SELM);
    {
        h8 qr[8];
#pragma unroll
        for (int d0 = 0; d0 < 8; ++d0) qr[d0] = *(const h8*)(qrow + d0 * 16);
        const int vb0 = (int)(uintptr_t)V_lds + v_rd_base(lane);
        { Stage4 s0, s1; sload(s0, Kc, Vc, 256, 0); sload(s1, Kc, Vc, 256, 64);
          asm volatile("s_waitcnt vmcnt(0)" ::: "memory");
          swrite(s0, V_lds, K_lds, 0); swrite(s1, V_lds, K_lds, 1); }
        __syncthreads();
        f32x16 pA0, pA1, pB0, pB1;
        AT_SBAR(); qkt(pA0, pA1, K_lds, qr, r32, hi); qkt(pB0, pB1, K_lds + SHM_K, qr, r32, hi);
        const int khi = t >= 31 ? ((t - 31) >> 4) : -1;
#pragma unroll
        for (int r = 0; r < 16; ++r) { const int c0 = 4 * hi + (r & 3) + 8 * (r >> 2);
            pA0[r] = (c0 <= khi) ? pA0[r] : -INFINITY; pA1[r] = (c0 + 32 <= khi) ? pA1[r] : -INFINITY;
            pB0[r] = (c0 + 64 <= khi) ? pB0[r] : -INFINITY; pB1[r] = (c0 + 96 <= khi) ? pB1[r] : -INFINITY; }
        float pmax = -INFINITY;
#pragma unroll
        for (int r = 0; r < 16; ++r) pmax = fmaxf(fmaxf(pmax, pA0[r]), fmaxf(pA1[r], fmaxf(pB0[r], pB1[r])));
        pmax = half_swap_max(pmax);
        const float mC = (pmax == -INFINITY) ? 0.f : -pmax * CEXP;
        float ps = 0.f;
#pragma unroll
        for (int r = 0; r < 16; ++r) { pA0[r] = __builtin_amdgcn_exp2f(fmaf(pA0[r], CEXP, mC)); pA1[r] = __builtin_amdgcn_exp2f(fmaf(pA1[r], CEXP, mC));
            pB0[r] = __builtin_amdgcn_exp2f(fmaf(pB0[r], CEXP, mC)); pB1[r] = __builtin_amdgcn_exp2f(fmaf(pB1[r], CEXP, mC)); ps += (pA0[r] + pA1[r]) + (pB0[r] + pB1[r]); }
        ps = half_swap_sum(ps);
        const float inv = ps > 0.f ? 1.f / ps : 0.f;
#pragma unroll
        for (int r = 0; r < 16; ++r) { pA0[r] *= inv; pA1[r] *= inv; pB0[r] *= inv; pB1[r] *= inv; }
        { float* ap = AP + (g * 64 + tl) * 33; float* bp = BP + (g * 64 + tl) * 33;
          if (hi == 0) bp[0] = 0.f;
#define AT_IMP(P, JB) do { _Pragma("unroll") for (int k = 0; k < 4; ++k) { const int j = (JB) + 2 * k + hi; \
              ap[j] = 2.f * (P[4 * k] + P[4 * k + 1] + P[4 * k + 2]) + P[4 * k + 3]; if (j + 1 < 32) bp[j + 1] = P[4 * k + 3]; } } while (0)
          AT_IMP(pA0, 0); AT_IMP(pA1, 8); AT_IMP(pB0, 16); AT_IMP(pB1, 24);
#undef AT_IMP
        }
        f32x16 o[4] = {};
        h8 pa0, pa1, pa2, pa3;
        pack_p(pA0, pA1, pa0, pa1, pa2, pa3); AT_SBAR(); pv_d0(o, vb0, pa0, pa1, pa2, pa3);
        pack_p(pB0, pB1, pa0, pa1, pa2, pa3); AT_SBAR(); pv_d0(o, vb0 + SHM_V, pa0, pa1, pa2, pa3);
#pragma unroll
        for (int r = 0; r < 16; ++r) { const int orow = crow(r, hi);
#pragma unroll
            for (int d0 = 0; d0 < 4; ++d0) outc[(size_t)orow * 1024 + d0 * 32 + r32] = (_Float16)o[d0][r]; }
    }
    __syncthreads();
#pragma unroll 1
    for (int it = 0; it < 4; ++it) {
        const int tk = 8 * wid + 2 * it + hi, j = r32;
        float imp = 0.f;
#pragma unroll
        for (int gg = 0; gg < 4; ++gg) imp += AP[(gg * 64 + tk) * 33 + j] + BP[(gg * 64 + tk) * 33 + j];
        const bool forced = (j == 0) || (j == qi) || (j == qi - 1), valid = j <= qi;
        const float iv = forced ? 1e9f : (valid ? imp : -1e9f);
        int rank = 0;
        for (int i = 0; i < 32; ++i) { const float vi = __shfl(iv, i + 32 * hi); rank += (vi > iv || (vi == iv && i < j)) ? 1 : 0; }
        const unsigned long long bal = __ballot(rank < 16 && valid);
        if (r32 == 0) selm[tk] = (unsigned)(bal >> (32 * hi));
    }
    __syncthreads();
    unsigned tm = selm[lane];
#pragma unroll
    for (int o = 32; o > 0; o >>= 1) tm |= __shfl_xor(tm, o);
    const int tz2 = hidden_tid();
    const unsigned mysel = selm[((tz2 >> 6) & 1) * 32 + (tz2 & 31)];
    attn_unit(lds, qrow, Ks, Vs, 128, tm, 0, t, mysel, outs, 1024);
}
}

struct CUnit { const float* W; int ldw; int nvalid; _Float16* Wt; int k0; int n0; };
__device__ __forceinline__ CUnit conv_desc(int u, const float* win, const float* w1k, const float* w1v, const float* wmkv, _Float16* wtin, _Float16* wt1, _Float16* wtmkv) {
    CUnit d;
    if (u < 480) { d.W = win; d.ldw = INW; d.nvalid = INW; d.Wt = wtin; d.k0 = (u / 15) * 64; d.n0 = (u % 15) * 256; }
    else if (u < 608) { const int v = u - 480, kv = v >> 6, part = (v >> 5) & 1, kt = v & 31;
        d.W = (kv ? w1v : w1k) + (size_t)part * 2048 * 256; d.ldw = 256; d.nvalid = 256; d.Wt = wt1 + ((size_t)kv * 512 + part * 256) * 2048; d.k0 = kt * 64; d.n0 = 0; }
    else { const int v = u - 608; d.W = wmkv; d.ldw = 1024; d.nvalid = 1024; d.Wt = wtmkv; d.k0 = (v >> 2) * 64; d.n0 = (v & 3) * 256; }
    return d;
}
__device__ __forceinline__ void conv_all(float* lds, const float* win, const float* w1k, const float* w1v, const float* wmkv, _Float16* wtin, _Float16* wt1, _Float16* wtmkv, int bid, int nb) {
    constexpr int NU = 480 + 128 + 128;
    const int tid = threadIdx.x;
    int u = bid; if (u >= NU) return;
    CUnit d = conv_desc(u, win, w1k, w1v, wmkv, wtin, wt1, wtmkv);
    float4 v[8];
#define CL(D) do { _Pragma("unroll") for (int i = 0; i < 8; ++i) { const int idx = tid + 512 * i, r = idx >> 6, c4 = (idx & 63) * 4; \
        v[i] = ((D).n0 + c4 < (D).nvalid) ? *(const float4*)((D).W + (size_t)((D).k0 + r) * (D).ldw + (D).n0 + c4) : make_float4(0.f, 0.f, 0.f, 0.f); } } while (0)
    CL(d);
    for (;;) {
#pragma unroll
        for (int i = 0; i < 8; ++i) { const int idx = tid + 512 * i, r = idx >> 6, c4 = (idx & 63) * 4; float* dd = lds + r * 257 + c4; dd[0] = v[i].x; dd[1] = v[i].y; dd[2] = v[i].z; dd[3] = v[i].w; }
        __syncthreads();
        const int un = u + nb; const bool has = un < NU;
        CUnit dn = d; if (has) { dn = conv_desc(un, win, w1k, w1v, wmkv, wtin, wt1, wtmkv); CL(dn); }
#pragma unroll
        for (int j = 0; j < 4; ++j) { const int id = tid + 512 * j, n = id >> 3, k8 = (id & 7) * 8; h8 o;
#pragma unroll
            for (int q = 0; q < 8; ++q) o[q] = (_Float16)lds[(k8 + q) * 257 + n];
            *(h8*)(d.Wt + (size_t)(d.n0 + n) * 2048 + d.k0 + k8) = o; }
        __syncthreads();
        if (!has) break;
        u = un; d = dn;
    }
#undef CL
}

__device__ __forceinline__ unsigned pack4_i8(float a, float b, float c, float d) {
    const int ia = __float2int_rn(a), ib = __float2int_rn(b), ic = __float2int_rn(c), id = __float2int_rn(d);
    return (unsigned)(ia & 255) | ((unsigned)(ib & 255) << 8) | ((unsigned)(ic & 255) << 16) | ((unsigned)(id & 255) << 24);
}
constexpr int QP_LD2 = 1026;
struct QUnit { const float* W; int ldw; int n0; signed char* Q; float* sc; };
__device__ __forceinline__ QUnit quant_desc(int u, const float* wgu, const float* wdn, signed char* q8gu, signed char* q8dn, float* sgu, float* sdn, const float* wout, signed char* q8out, float* sout) {
    QUnit d;
    if (u >= NE * 192) { const int pn = u - NE * 192; d.W = wout; d.ldw = 2048; d.n0 = pn * 32; d.Q = q8out; d.sc = sout; }
    else if (u < NE * 128) { const int e = u >> 7, pn = u & 127; d.W = wgu + (size_t)e * 2048 * 4096; d.ldw = 4096; d.n0 = pn * 32; d.Q = q8gu + (size_t)e * 4096 * 2048; d.sc = sgu + (size_t)e * 4096; }
    else { const int v = u - NE * 128, e = v >> 6, pn = v & 63; d.W = wdn + (size_t)e * 2048 * 2048; d.ldw = 2048; d.n0 = pn * 32; d.Q = q8dn + (size_t)e * 2048 * 2048; d.sc = sdn + (size_t)e * 2048; }
    return d;
}
__device__ __forceinline__ unsigned pk2h(float a, float b) { auto v = __builtin_amdgcn_cvt_pkrtz(a, b); return *reinterpret_cast<unsigned*>(&v); }
__device__ __forceinline__ void quant_all(char* smem, const float* wgu, const float* wdn, signed char* q8gu, signed char* q8dn, float* sgu, float* sdn, const float* wout, signed char* q8out, float* sout, int bid, int nb) {
    constexpr int NU = NE * 128 + NE * 64 + 64;
    unsigned* cmaxb = (unsigned*)smem;
    const int tid = threadIdx.x, c4 = (tid & 7) * 4, rg = tid >> 3;
    if (tid < 64) cmaxb[tid] = 0u;
    __syncthreads();
    int u = bid; if (u >= NU) return;
    QUnit d = quant_desc(u, wgu, wdn, q8gu, q8dn, sgu, sdn, wout, q8out, sout);
    float4 va[16], vb[16], vc[16];
#define QL(dst, D, half) do { const float* p0 = (D).W + (size_t)((half) * 1024 + rg * 16) * (D).ldw + (D).n0 + c4; _Pragma("unroll") for (int j = 0; j < 16; ++j) dst[j] = *(const float4*)(p0 + (size_t)j * (D).ldw); } while (0)
#define QM(src) do { _Pragma("unroll") for (int j = 0; j < 16; ++j) { m0 = fmaxf(m0, fabsf(src[j].x)); m1 = fmaxf(m1, fabsf(src[j].y)); m2 = fmaxf(m2, fabsf(src[j].z)); m3 = fmaxf(m3, fabsf(src[j].w)); } } while (0)
#define QS(src, half, comp, ci, inv) do { uint4 o; \
        o.x = pack4_i8(src[0].comp * inv, src[1].comp * inv, src[2].comp * inv, src[3].comp * inv); o.y = pack4_i8(src[4].comp * inv, src[5].comp * inv, src[6].comp * inv, src[7].comp * inv); \
        o.z = pack4_i8(src[8].comp * inv, src[9].comp * inv, src[10].comp * inv, src[11].comp * inv); o.w = pack4_i8(src[12].comp * inv, src[13].comp * inv, src[14].comp * inv, src[15].comp * inv); \
        *(uint4*)(d.Q + (size_t)(d.n0 + c4 + (ci)) * 2048 + (half) * 1024 + rg * 16) = o; } while (0)
    QL(va, d, 0);
    int par = 0;
    for (;;) {
        unsigned* cmax = cmaxb + par * 32;
        float m0 = 0.f, m1 = 0.f, m2 = 0.f, m3 = 0.f;
        QL(vb, d, 1);
        QM(va); QM(vb);
        atomicMax(&cmax[c4 + 0], __float_as_uint(m0)); atomicMax(&cmax[c4 + 1], __float_as_uint(m1)); atomicMax(&cmax[c4 + 2], __float_as_uint(m2)); atomicMax(&cmax[c4 + 3], __float_as_uint(m3));
        __syncthreads();
        const int un = u + nb; const bool has = un < NU;
        QUnit dn = d; if (has) { dn = quant_desc(un, wgu, wdn, q8gu, q8dn, sgu, sdn, wout, q8out, sout); QL(vc, dn, 0); }
        if (tid < 32) cmaxb[(par ^ 1) * 32 + tid] = 0u;
        const float x0 = __uint_as_float(cmax[c4 + 0]), x1 = __uint_as_float(cmax[c4 + 1]), x2 = __uint_as_float(cmax[c4 + 2]), x3 = __uint_as_float(cmax[c4 + 3]);
        const float i0 = x0 > 0.f ? 127.f / x0 : 0.f, i1 = x1 > 0.f ? 127.f / x1 : 0.f, i2 = x2 > 0.f ? 127.f / x2 : 0.f, i3 = x3 > 0.f ? 127.f / x3 : 0.f;
        QS(va, 0, x, 0, i0); QS(va, 0, y, 1, i1); QS(va, 0, z, 2, i2); QS(va, 0, w, 3, i3);
        QS(vb, 1, x, 0, i0); QS(vb, 1, y, 1, i1); QS(vb, 1, z, 2, i2); QS(vb, 1, w, 3, i3);
        if (tid < 32) { const float mx = __uint_as_float(cmax[tid]); d.sc[d.n0 + tid] = mx > 0.f ? mx / 127.f : 1.f; }
        if (!has) break;
#pragma unroll
        for (int j = 0; j < 16; ++j) va[j] = vc[j];
        u = un; d = dn; par ^= 1;
        __syncthreads();
    }
    __syncthreads();
#undef QL
#undef QM
#undef QS
}

__global__ void __launch_bounds__(512, 2) fwd(Params p) {
    extern __shared__ __attribute__((aligned(16))) char smem[];
    const int tid = threadIdx.x, wv = __builtin_amdgcn_readfirstlane(tid >> 6);
#define LANE_NOW ({ int _t = threadIdx.x; asm volatile("" : "+v"(_t)); _t & 63; })
    const int bid = blockIdx.x, nb = gridDim.x;
    const int gw = bid * 8 + wv, nw = nb * 8;
    const int lo = (int)(p.lo_hi & 0xffffffffll), hi = (int)(p.lo_hi >> 32);
    unsigned char* ws = p.ws;
    unsigned* ctl = (unsigned*)(ws + WS_CTL);
    int* cnt = (int*)(ws + CTL_CNT);
    float* proj = (float*)(ws + WS_PROJ);
    float* kvmem = (float*)(ws + WS_KVMEM);
    float* bias1 = (float*)(ws + WS_BIAS1);
    float* hid = (float*)(ws + WS_HID);
    float* kc = (float*)(ws + WS_KC);
    float* vc = (float*)(ws + WS_VC);
    float* pooled = (float*)(ws + WS_POOLED);
    _Float16* opool = (_Float16*)(ws + WS_OPOOL);
    _Float16* owin = (_Float16*)(ws + WS_OWIN);
    _Float16* ocmp = (_Float16*)(ws + WS_OCMP);
    _Float16* oslc = (_Float16*)(ws + WS_OSLC);
    unsigned* sel = (unsigned*)(ws + WS_SEL);
    _Float16* omem = (_Float16*)(ws + WS_OMEM);
    _Float16* cat16 = (_Float16*)(ws + WS_CAT16);
    _Float16* hpre16 = (_Float16*)(ws + WS_HPRE);
    float* hbuf = (float*)(ws + WS_H);
    float* gate = (float*)(ws + WS_GATE);
    int* list = (int*)(ws + WS_LIST);
    unsigned char* actf8 = (unsigned char*)(ws + WS_ACT16);
    unsigned char* yf8 = (unsigned char*)(ws + WS_Y16);
    _Float16* h16 = (_Float16*)(ws + WS_H16);
    _Float16* x16 = (_Float16*)(ws + WS_X16);
    _Float16* wtin = (_Float16*)(ws + WS_WTIN);
    _Float16* wtout = (_Float16*)(ws + WS_WTOUT);
    _Float16* wtgu = (_Float16*)(ws + WS_WTGU);
    _Float16* wtdn = (_Float16*)(ws + WS_WTDN);
    LAS unsigned char* lds = (LAS unsigned char*)smem;
    _Float16* proj16 = (_Float16*)(ws + WS_PROJ16);
    _Float16* kvmem16 = (_Float16*)(ws + WS_KVMEM16);
    _Float16* wt1 = (_Float16*)(ws + WS_WT1);
    float* uv = (float*)(ws + WS_UV);
    _Float16* kc16 = (_Float16*)(ws + WS_KC16);
    _Float16* vc16 = (_Float16*)(ws + WS_VC16);
    _Float16* wr16 = (_Float16*)(ws + WS_WR16);
    _Float16* mem16 = (_Float16*)(ws + WS_MEM16);
    _Float16* wtmkv = (_Float16*)(ws + WS_WTMKV);
    _Float16* kv16 = (_Float16*)(ws + WS_KV16);
    _Float16* wt2 = (_Float16*)(ws + WS_WT2);
    signed char* q8out = (signed char*)(ws + WS_Q8OUT); float* sout = (float*)(ws + WS_SOUT); signed char* cat8 = (signed char*)(ws + WS_CAT8); float* scat = (float*)(ws + WS_SCAT);
    signed char* q8gu = (signed char*)(ws + WS_Q8GU); signed char* q8dn = (signed char*)(ws + WS_Q8DN);
    float* sgu = (float*)(ws + WS_SGU); float* sdn = (float*)(ws + WS_SDN);
    signed char* h8q = (signed char*)(ws + WS_H8); float* sah = (float*)(ws + WS_SAH);
    signed char* act8 = (signed char*)(ws + WS_ACT8); float* sact = (float*)(ws + WS_SACT);
    const int vcu = (nb % 8 == 0) ? (bid % 8) * (nb / 8) + bid / 8 : bid;

    volatile LAS unsigned* xbw = (volatile LAS unsigned*)(smem + LDS_BYTES - 16);
    if (tid == 0) { xbw[0] = 0u; xbw[1] = 0u; xbw[2] = 0u; xbw[3] = 0u; }
    __syncthreads();
    XcdBarrier bar; bar.bar = ctl; bar.x = 0; bar.st = xbw;
    const bool multi = (hi - lo) > 1;
    if (multi) bar = xcd_barrier_post(ctl, xbw);
#define IN(k) (lo <= (k) && (k) < hi)
#define SEAM(k) do { if (IN(k) && IN((k) + 1)) xcd_barrier(bar); } while (0)
    float* sw = (float*)smem + wv * WLDS_FLOATS;
    int* segw = (int*)(sw + 4096 + 512);

    if (IN(0)) {
        const int lane = LANE_NOW; (void)lane;
        if (wv == 0 && (bid & 1) == 0 && (bid >> 1) < 128) {
            const int task = bid >> 1, kv = task >> 6, jg = (task >> 4) & 3, kc = task & 15;
            const float* pos = p.in[kv ? I_POSV : I_POSK] + kc * 256; const float* w1 = p.in[kv ? I_W1V : I_W1K] + (size_t)kc * 256 * 256 + jg * 64 + lane;
            float s0 = 0.f, s1 = 0.f, s2 = 0.f, s3 = 0.f;
            for (int k = 0; k < 256; k += 4) { s0 += pos[k] * w1[(size_t)k * 256]; s1 += pos[k + 1] * w1[(size_t)(k + 1) * 256]; s2 += pos[k + 2] * w1[(size_t)(k + 2) * 256]; s3 += pos[k + 3] * w1[(size_t)(k + 3) * 256]; }
            bias1[(kv * 16 + kc) * 256 + jg * 64 + lane] = (s0 + s1) + (s2 + s3);
        }
        for (int i = bid * 512 + tid; i < 2 * 128 * 256; i += nb * 512) { const int kv = i >> 15, d = (i >> 8) & 127, n = i & 255; wt2[i] = (_Float16)p.in[kv ? I_W2V : I_W2K][(size_t)n * 128 + d]; }
        for (int i = bid * 512 + tid; i < 32 * 2048; i += nb * 512) { const int e = i >> 11, d = i & 2047; wr16[i] = (_Float16)p.in[I_WR][(size_t)d * 32 + e]; }
        for (size_t i = (size_t)bid * 512 + tid; i < (size_t)T_ * 2048 / 4; i += (size_t)nb * 512) {
            const float4 v = ((const float4*)p.in[I_X])[i]; ((h4*)x16)[i] = (h4){(_Float16)v.x, (_Float16)v.y, (_Float16)v.z, (_Float16)v.w};
        }
        {
            quant_all(smem, p.in[I_WGU], p.in[I_WDN], q8gu, q8dn, sgu, sdn, p.in[I_WOUT], q8out, sout, bid, nb);
            __syncthreads();
            conv_all((float*)smem, p.in[I_WIN], p.in[I_W1K], p.in[I_W1V], p.in[I_WMEMKV], wtin, wt1, wtmkv, bid, nb);
            __syncthreads();
        }
        for (size_t i = (size_t)bid * 512 + tid; i < (size_t)2048 * 2048 / 4; i += (size_t)nb * 512) {
            const float4 v = ((const float4*)p.in[I_MEM])[i]; ((h4*)mem16)[i] = (h4){(_Float16)v.x, (_Float16)v.y, (_Float16)v.z, (_Float16)v.w};
        }
    }
    SEAM(0);
    if (IN(1)) {
        const int lane = LANE_NOW; (void)lane;
        g8::ProbIn P{x16, proj16, nb, bid};
        g8::gemm_phase(lds, P);
    }
    SEAM(1);
    if (IN(2)) {
        const int lane = LANE_NOW; (void)lane;
        { g8::ProbCmp P{kv16, wt1, uv, nb, bid}; g8::gemm_phase(lds, P); __syncthreads(); }
        for (int i = bid * 512 + tid; i < T_ * 64; i += nb * 512) {
            const int chn = i & 63, row = i >> 6, t = row & (S_ - 1), g = chn >> 4;
            const int win = 2 << g, n = min(win, t + 1);
            const _Float16* src = proj16 + (size_t)row * INW + C_UP + chn * 8;
            float a[8];
            const h8 cur = *(const h8*)src;
#pragma unroll
            for (int q = 0; q < 8; ++q) a[q] = (float)cur[q];
            for (int k = 1; k < n; ++k) { const h8 v = *(const h8*)(src - (size_t)k * INW);
#pragma unroll
                for (int q = 0; q < 8; ++q) a[q] += (float)v[q]; }
            const float rn = 1.f / (float)n;
            float4 o0, o1;
            o0.x = a[0] * rn - (float)cur[0]; o0.y = a[1] * rn - (float)cur[1]; o0.z = a[2] * rn - (float)cur[2]; o0.w = a[3] * rn - (float)cur[3];
            o1.x = a[4] * rn - (float)cur[4]; o1.y = a[5] * rn - (float)cur[5]; o1.z = a[6] * rn - (float)cur[6]; o1.w = a[7] * rn - (float)cur[7];
            *(float4*)(pooled + (size_t)row * 512 + chn * 8) = o0; *(float4*)(pooled + (size_t)row * 512 + chn * 8 + 4) = o1;
        }
        {
            const int r32 = lane & 31, hi = lane >> 5, g = wv >> 1, half = wv & 1;
            for (int uu = vcu; uu < 512; uu += nb) {
                const int v = uu & 255, bk = v >> 4, qi = (uu >> 8) ? 31 - (v & 15) : (v & 15), b = bk >> 1, kvh = bk & 1;
                const int t = qi * 64 + half * 32 + r32;
                const int lo_t = max(0, qi - 8);
                const unsigned tmask = (unsigned)(((1ull << (qi + 1)) - 1ull) & ~((1ull << lo_t) - 1ull));
                at8::attn_unit(smem, proj16 + (size_t)(b * S_ + t) * INW + C_Q + (kvh * 4 + g) * 128 + hi * 8,
                               kv16 + ((size_t)(4 * B_ + b) * 2 + kvh) * KVSEG, kv16 + ((size_t)(5 * B_ + b) * 2 + kvh) * KVSEG, 128, tmask, 512, t, 0xffffffffu,
                               owin + (size_t)(b * S_ + qi * 64 + half * 32) * 1024 + (kvh * 4 + g) * 128, 1024);
            }
            for (int u = vcu; u < 256; u += nb) {
                const int b = u >> 5, h = (u >> 3) & 3, qt = u & 7;
                const int t = qt * 256 + wv * 32 + r32;
                at8::attn_unit(smem, proj16 + (size_t)(b * S_ + t) * INW + C_QM + h * 128 + hi * 8,
                               kvmem16 + (size_t)b * 256 * 1024 + h * 128, kvmem16 + (size_t)b * 256 * 1024 + 512 + h * 128, 1024, 0xFu, 0, 255, 0xffffffffu,
                               omem + (size_t)(b * S_ + qt * 256 + wv * 32) * 512 + h * 128, 512);
            }
        }
    }
    SEAM(2);
    if (IN(3)) {
        const int lane = LANE_NOW; (void)lane;
        {
            float* bsum = (float*)smem;
            _Float16* hs = (_Float16*)(smem + 4096);
            { const int kv = tid >> 8, n = tid & 255; float a = 0.f;
#pragma unroll
              for (int kc = 0; kc < 16; ++kc) a += bias1[(kv * 16 + kc) * 256 + n];
              bsum[tid] = a; }
            __syncthreads();
            const int fr = lane & 15, fq = lane >> 4;
            for (int u = bid; u < 256; u += nb) {
                const int kv = u >> 7, rt = u & 127;
#pragma unroll
                for (int q = 0; q < 8; ++q) { const int e = tid + 512 * q, i = e >> 8, n = e & 255;
                    const int row = rt * 16 + i, c = (row >> 1) & 127;
                    float a = 0.f;
                    if (c != 127) { a = bsum[kv * 256 + n];
#pragma unroll
                        for (int sp = 0; sp < 4; ++sp) { const float* base = uv + ((size_t)(kv * 4 + sp) * 2048) * 512; a += base[(size_t)row * 512 + n] + base[(size_t)(row + 2) * 512 + 256 + n]; }
                        a = gelu_fast(a); }
                    hs[i * 264 + n] = (_Float16)a; }
                __syncthreads();
                { const _Float16* bp = wt2 + ((size_t)kv * 128 + wv * 16 + fr) * 256 + fq * 8;
                  f4 acc = (f4){0.f, 0.f, 0.f, 0.f};
#pragma unroll
                  for (int sI = 0; sI < 8; ++sI) { const h8 a = *(const h8*)(hs + fr * 264 + sI * 32 + fq * 8), bb = *(const h8*)(bp + sI * 32); acc = __builtin_amdgcn_mfma_f32_16x16x32_f16(a, bb, acc, 0, 0, 0); }
                  _Float16* dst = kv ? vc16 : kc16;
#pragma unroll
                  for (int j = 0; j < 4; ++j) { const int row = rt * 16 + fq * 4 + j; dst[(size_t)row * 128 + wv * 16 + fr] = (((row >> 1) & 127) == 127) ? (_Float16)0.f : (_Float16)acc[j]; } }
                __syncthreads();
            }
        }
        for (int u = bid; u < 128 * 4; u += nb) { const int g = u >> 7, mt = u & 127;
            ARowPlain af{pooled + g * 128, 512, mt * 128, T_}; EpiPool ef{opool, p.in[I_POOLS], mt * 128, g};
            gemm_tile(smem, 128, af, p.in[I_POOLW] + (size_t)g * 128 * 128, 128, 0, 128, false, ef);
        }
    }
    SEAM(3);
    if (IN(4)) {
        const int lane = LANE_NOW; (void)lane;
        const int r32 = lane & 31, hi = lane >> 5, g = wv >> 1, half = wv & 1;
        for (int uu = vcu; uu < 512; uu += nb) {
            const int v = uu & 255, bk = v >> 4, qi = (uu >> 8) ? 31 - (v & 15) : (v & 15), b = bk >> 1, kvh = bk & 1;
            const int tl = half * 32 + r32, t = qi * 64 + tl;
            at8::cmp_slc_unit(smem, proj16 + (size_t)(b * S_ + t) * INW + C_Q + (kvh * 4 + g) * 128 + hi * 8,
                              kc16 + (size_t)(b * 128 * 2 + kvh) * 128, vc16 + (size_t)(b * 128 * 2 + kvh) * 128,
                              kv16 + ((size_t)(2 * B_ + b) * 2 + kvh) * KVSEG, kv16 + ((size_t)(3 * B_ + b) * 2 + kvh) * KVSEG, t, tl, g, qi,
                              ocmp + (size_t)(b * S_ + qi * 64 + half * 32) * 1024 + (kvh * 4 + g) * 128, oslc + (size_t)(b * S_ + qi * 64 + half * 32) * 1024 + (kvh * 4 + g) * 128);
        }
    }
    SEAM(4);
    if (IN(5)) {
        const int lane = LANE_NOW;
        for (int row = gw; row < T_; row += nw) {
            const _Float16* pr = proj16 + (size_t)row * INW + C_G;
            float v[32]; float ss = 0.f;
#pragma unroll
            for (int c = 0; c < 2; ++c) { const int col = (lane + 64 * c) * 8, h = col >> 7; const size_t o = (size_t)row * 1024 + col;
                const float g0 = sigmoidf_((float)pr[h * 3]), g1 = sigmoidf_((float)pr[h * 3 + 1]), g2 = sigmoidf_((float)pr[h * 3 + 2]);
                const h8 a = *(const h8*)(ocmp + o), b2 = *(const h8*)(oslc + o), c2 = *(const h8*)(owin + o);
#pragma unroll
                for (int q = 0; q < 8; ++q) { const float x = g0 * (float)a[q] + g1 * (float)b2[q] + g2 * (float)c2[q]; v[c * 8 + q] = x; ss += x * x; } }
            ss = wave_sum(ss); float r = rsqrtf(ss / 1024.f + LN_EPS);
#pragma unroll
            for (int c = 0; c < 2; ++c) { const int col = (lane + 64 * c) * 8; const float4 ga = *(const float4*)(p.in[I_GNNSA] + col), gb = *(const float4*)(p.in[I_GNNSA] + col + 4);
                v[c * 8 + 0] *= r * ga.x; v[c * 8 + 1] *= r * ga.y; v[c * 8 + 2] *= r * ga.z; v[c * 8 + 3] *= r * ga.w; v[c * 8 + 4] *= r * gb.x; v[c * 8 + 5] *= r * gb.y; v[c * 8 + 6] *= r * gb.z; v[c * 8 + 7] *= r * gb.w; }
            { const h8 a = *(const h8*)(opool + (size_t)row * 512 + lane * 8); ss = 0.f;
#pragma unroll
              for (int q = 0; q < 8; ++q) { v[16 + q] = (float)a[q]; ss += v[16 + q] * v[16 + q]; }
              ss = wave_sum(ss); r = rsqrtf(ss / 512.f + LN_EPS);
              const float4 ga = *(const float4*)(p.in[I_GNPOOL] + lane * 8), gb = *(const float4*)(p.in[I_GNPOOL] + lane * 8 + 4);
              v[16] *= r * ga.x; v[17] *= r * ga.y; v[18] *= r * ga.z; v[19] *= r * ga.w; v[20] *= r * gb.x; v[21] *= r * gb.y; v[22] *= r * gb.z; v[23] *= r * gb.w; }
            { const h8 a = *(const h8*)(omem + (size_t)row * 512 + lane * 8); ss = 0.f;
#pragma unroll
              for (int q = 0; q < 8; ++q) { v[24 + q] = (float)a[q]; ss += v[24 + q] * v[24 + q]; }
              ss = wave_sum(ss); r = rsqrtf(ss / 512.f + LN_EPS);
              const float4 ga = *(const float4*)(p.in[I_GNMEM] + lane * 8), gb = *(const float4*)(p.in[I_GNMEM] + lane * 8 + 4);
              v[24] *= r * ga.x; v[25] *= r * ga.y; v[26] *= r * ga.z; v[27] *= r * ga.w; v[28] *= r * gb.x; v[29] *= r * gb.y; v[30] *= r * gb.z; v[31] *= r * gb.w; }
            float amax = 0.f;
#pragma unroll
            for (int k = 0; k < 32; ++k) amax = fmaxf(amax, fabsf(v[k]));
            amax = wave_max(amax);
            const float qinv = amax > 0.f ? 127.f / amax : 0.f;
            if (lane == 0) scat[row] = amax > 0.f ? amax / 127.f : 1.f;
#pragma unroll
            for (int c = 0; c < 4; ++c) { const int col = c < 2 ? (lane + 64 * c) * 8 : (c == 2 ? 1024 + lane * 8 : 1536 + lane * 8);
                uint2 q; q.x = pack4_i8(v[c * 8 + 0] * qinv, v[c * 8 + 1] * qinv, v[c * 8 + 2] * qinv, v[c * 8 + 3] * qinv); q.y = pack4_i8(v[c * 8 + 4] * qinv, v[c * 8 + 5] * qinv, v[c * 8 + 6] * qinv, v[c * 8 + 7] * qinv);
                *(uint2*)(cat8 + (size_t)row * 2048 + col) = q; }
        }
    }
    SEAM(5);
    if (IN(6)) {
        const int lane = LANE_NOW; (void)lane;
        g8::ProbOut P{cat8, q8out, hpre16, x16, scat, sout, nb, bid};
        g8::gemm_phase(lds, P);
    }
    SEAM(6);
    if (IN(7)) {
        const int lane = LANE_NOW; (void)lane;
        float* lg = (float*)smem;
        const int r32 = lane & 31, hi = lane >> 5, fr = lane & 15, fq = lane >> 4;
        for (int u = bid; u < T_ / 64; u += nb) {
            const int base = u * 64;
            h8 raw[8][4];
#pragma unroll
            for (int i = 0; i < 8; ++i)
#pragma unroll
                for (int c = 0; c < 4; ++c) raw[i][c] = *(const h8*)(hpre16 + (size_t)(base + wv * 8 + i) * 2048 + (lane + 64 * c) * 8);
#pragma unroll
            for (int i = 0; i < 8; ++i) {
                const int row = base + wv * 8 + i;
                float v[32]; float s = 0.f;
#pragma unroll
                for (int c = 0; c < 4; ++c) {
#pragma unroll
                    for (int q = 0; q < 8; ++q) { v[c * 8 + q] = (float)raw[i][c][q]; s += v[c * 8 + q]; } }
                const float mu = wave_sum(s) / 2048.f; float q2 = 0.f;
#pragma unroll
                for (int k = 0; k < 32; ++k) { const float d = v[k] - mu; q2 += d * d; }
                const float rs = rsqrtf(wave_sum(q2) / 2048.f + LN_EPS);
                float amax = 0.f;
#pragma unroll
                for (int c = 0; c < 4; ++c) { const int col = (lane + 64 * c) * 8;
                    const float4 g0 = *(const float4*)(p.in[I_LN1G] + col), g1 = *(const float4*)(p.in[I_LN1G] + col + 4), b0 = *(const float4*)(p.in[I_LN1B] + col), b1 = *(const float4*)(p.in[I_LN1B] + col + 4);
                    float4 o0, o1;
                    o0.x = (v[c * 8 + 0] - mu) * rs * g0.x + b0.x; o0.y = (v[c * 8 + 1] - mu) * rs * g0.y + b0.y; o0.z = (v[c * 8 + 2] - mu) * rs * g0.z + b0.z; o0.w = (v[c * 8 + 3] - mu) * rs * g0.w + b0.w;
                    o1.x = (v[c * 8 + 4] - mu) * rs * g1.x + b1.x; o1.y = (v[c * 8 + 5] - mu) * rs * g1.y + b1.y; o1.z = (v[c * 8 + 6] - mu) * rs * g1.z + b1.z; o1.w = (v[c * 8 + 7] - mu) * rs * g1.w + b1.w;
                    h8 oh; oh[0] = (_Float16)o0.x; oh[1] = (_Float16)o0.y; oh[2] = (_Float16)o0.z; oh[3] = (_Float16)o0.w; oh[4] = (_Float16)o1.x; oh[5] = (_Float16)o1.y; oh[6] = (_Float16)o1.z; oh[7] = (_Float16)o1.w;
                    *(h8*)(h16 + (size_t)row * 2048 + col) = oh;
                    v[c * 8 + 0] = o0.x; v[c * 8 + 1] = o0.y; v[c * 8 + 2] = o0.z; v[c * 8 + 3] = o0.w; v[c * 8 + 4] = o1.x; v[c * 8 + 5] = o1.y; v[c * 8 + 6] = o1.z; v[c * 8 + 7] = o1.w;
                    amax = fmaxf(amax, fmaxf(fmaxf(fmaxf(fabsf(o0.x), fabsf(o0.y)), fmaxf(fabsf(o0.z), fabsf(o0.w))), fmaxf(fmaxf(fabsf(o1.x), fabsf(o1.y)), fmaxf(fabsf(o1.z), fabsf(o1.w))))); }
                amax = wave_max(amax);
                const float qinv = amax > 0.f ? 127.f / amax : 0.f;
                if (lane == 0) sah[row] = amax > 0.f ? amax / 127.f : 1.f;
#pragma unroll
                for (int c = 0; c < 4; ++c) { const int col = (lane + 64 * c) * 8;
                    uint2 q; q.x = pack4_i8(v[c * 8 + 0] * qinv, v[c * 8 + 1] * qinv, v[c * 8 + 2] * qinv, v[c * 8 + 3] * qinv); q.y = pack4_i8(v[c * 8 + 4] * qinv, v[c * 8 + 5] * qinv, v[c * 8 + 6] * qinv, v[c * 8 + 7] * qinv);
                    *(uint2*)(h8q + (size_t)row * 2048 + col) = q; }
            }
            asm volatile("s_waitcnt vmcnt(0)" ::: "memory");
            __syncthreads();
            {
                const int tok0 = base + 16 * (wv >> 1), e0 = 16 * (wv & 1);
                const _Float16* ap = h16 + (size_t)(tok0 + fr) * 2048 + fq * 8; const _Float16* bp = wr16 + (size_t)(e0 + fr) * 2048 + fq * 8;
                f4 acc = (f4){0.f, 0.f, 0.f, 0.f};
#pragma unroll 8
                for (int sI = 0; sI < 64; ++sI) { const h8 a = *(const h8*)(ap + sI * 32), bb = *(const h8*)(bp + sI * 32); acc = __builtin_amdgcn_mfma_f32_16x16x32_f16(a, bb, acc, 0, 0, 0); }
                const float br = p.in[I_BR][e0 + fr];
#pragma unroll
                for (int j = 0; j < 4; ++j) lg[(16 * (wv >> 1) + 4 * fq + j) * 33 + e0 + fr] = acc[j] + br;
            }
            __syncthreads();
#pragma unroll 1
            for (int it = 0; it < 4; ++it) {
                const int tk = 8 * wv + 2 * it + hi;
                const float iv = lg[tk * 33 + r32];
                int rank = 0;
                for (int i = 0; i < 32; ++i) { const float vi = __shfl(iv, i + 32 * hi); rank += (vi > iv || (vi == iv && i < r32)) ? 1 : 0; }
                float tv[4]; int te[4];
#pragma unroll
                for (int r = 0; r < 4; ++r) { const unsigned long long bm = __ballot(rank == r); const unsigned hm = (unsigned)(bm >> (32 * hi)); const int src = __ffs(hm) - 1; te[r] = src; tv[r] = __shfl(iv, src + 32 * hi); }
                const float e0v = 1.f, e1v = expf(tv[1] - tv[0]), e2v = expf(tv[2] - tv[0]), e3v = expf(tv[3] - tv[0]); const float inv = 1.f / (e0v + e1v + e2v + e3v);
                if (r32 < 4) { const int e = r32 == 0 ? te[0] : r32 == 1 ? te[1] : r32 == 2 ? te[2] : te[3]; const float g = (r32 == 0 ? e0v : r32 == 1 ? e1v : r32 == 2 ? e2v : e3v) * inv;
                    const int a = (base + tk) * 4 + r32; const int pos = atomicAdd(&cnt[e], 1); list[(size_t)e * T_ + pos] = a; gate[a] = g; }
            }
            __syncthreads();
        }
    }
    SEAM(7);
    LAS int* mtab = (LAS int*)(smem + g8::STAGE_BYTES);
    if (IN(8)) {
        const int lane = LANE_NOW; (void)lane;
        if (tid == 0) { int ub = 0, rs = 0;
            for (int e = 0; e < NE; ++e) { const int c = (int)__hip_atomic_load((unsigned*)&cnt[e], __ATOMIC_RELAXED, __HIP_MEMORY_SCOPE_AGENT); mtab[e] = c; mtab[32 + e] = ub; mtab[65 + e] = rs; ub += ((c + 255) >> 8) * 16; rs += c; }
            mtab[64] = ub; mtab[97] = rs; mtab[98] = ub; }
        __syncthreads();
        g8::ProbGu P{h8q, q8gu, actf8, p.in[I_BGU], list, sah, sgu, g8::MoeTab{mtab, 16}, nb, vcu};
        g8::gemm_phase(lds, P);
        __syncthreads();
    }
    SEAM(8);
    if (IN(9)) {
        const int lane = LANE_NOW;
        for (int row = gw; row < NA; row += nw) {
            float v[32]; float amax = 0.f;
#pragma unroll
            for (int c = 0; c < 4; ++c) { const uint2 a = *(const uint2*)(actf8 + (size_t)row * 2048 + (lane + 64 * c) * 8);
                dec4_fp8(a.x, v[c * 8 + 0], v[c * 8 + 1], v[c * 8 + 2], v[c * 8 + 3]); dec4_fp8(a.y, v[c * 8 + 4], v[c * 8 + 5], v[c * 8 + 6], v[c * 8 + 7]);
#pragma unroll
                for (int q = 0; q < 8; ++q) amax = fmaxf(amax, fabsf(v[c * 8 + q])); }
            amax = wave_max(amax);
            const float qinv = amax > 0.f ? 127.f / amax : 0.f;
            if (lane == 0) sact[row] = amax > 0.f ? amax / 127.f : 1.f;
#pragma unroll
            for (int c = 0; c < 4; ++c) { uint2 q; q.x = pack4_i8(v[c * 8 + 0] * qinv, v[c * 8 + 1] * qinv, v[c * 8 + 2] * qinv, v[c * 8 + 3] * qinv); q.y = pack4_i8(v[c * 8 + 4] * qinv, v[c * 8 + 5] * qinv, v[c * 8 + 6] * qinv, v[c * 8 + 7] * qinv);
                *(uint2*)(act8 + (size_t)row * 2048 + (lane + 64 * c) * 8) = q; }
        }
    }
    SEAM(9);
    if (IN(10)) {
        const int lane = LANE_NOW; (void)lane;
        if (tid == 0) { int ub = 0, rs = 0;
            for (int e = 0; e < NE; ++e) { const int c = (int)__hip_atomic_load((unsigned*)&cnt[e], __ATOMIC_RELAXED, __HIP_MEMORY_SCOPE_AGENT); mtab[e] = c; mtab[32 + e] = ub; mtab[65 + e] = rs; ub += ((c + 255) >> 8) * 8; rs += c; }
            mtab[64] = ub; mtab[97] = rs; mtab[98] = ub; }
        __syncthreads();
        g8::ProbDn P{act8, q8dn, yf8, p.in[I_BDN], list, gate, sact, sdn, g8::MoeTab{mtab, 8}, nb, vcu};
        g8::gemm_phase(lds, P);
        __syncthreads();
    }
    SEAM(10);
    if (IN(11)) {
        const int lane = LANE_NOW; (void)lane;
        for (int row = gw; row < T_; row += nw) {
            float v[32]; float s = 0.f;
#pragma unroll
            for (int c = 0; c < 4; ++c) { const int col = (lane + 64 * c) * 8; const size_t yo = (size_t)row * 4 * 2048 + col;
                const h8 hh8 = *(const h8*)(h16 + (size_t)row * 2048 + col);
                const uint2 y0 = *(const uint2*)(yf8 + yo), y1 = *(const uint2*)(yf8 + yo + 2048), y2 = *(const uint2*)(yf8 + yo + 4096), y3 = *(const uint2*)(yf8 + yo + 6144);
                float ys[8], t0[8], t1[8], t2[8], t3[8];
                dec4_fp8(y0.x, t0[0], t0[1], t0[2], t0[3]); dec4_fp8(y0.y, t0[4], t0[5], t0[6], t0[7]); dec4_fp8(y1.x, t1[0], t1[1], t1[2], t1[3]); dec4_fp8(y1.y, t1[4], t1[5], t1[6], t1[7]);
                dec4_fp8(y2.x, t2[0], t2[1], t2[2], t2[3]); dec4_fp8(y2.y, t2[4], t2[5], t2[6], t2[7]); dec4_fp8(y3.x, t3[0], t3[1], t3[2], t3[3]); dec4_fp8(y3.y, t3[4], t3[5], t3[6], t3[7]);
#pragma unroll
                for (int q = 0; q < 8; ++q) ys[q] = (t0[q] + t1[q]) + (t2[q] + t3[q]);
#pragma unroll
                for (int q = 0; q < 8; ++q) { v[c * 8 + q] = DN_ALPHA * (float)hh8[q] + ys[q] * 0.0625f; s += v[c * 8 + q]; } }
            const float mu = wave_sum(s) / 2048.f; float q2 = 0.f;
#pragma unroll
            for (int i = 0; i < 32; ++i) { const float d = v[i] - mu; q2 += d * d; }
            const float rs = rsqrtf(wave_sum(q2) / 2048.f + LN_EPS);
#pragma unroll
            for (int c = 0; c < 4; ++c) { const int col = (lane + 64 * c) * 8;
                const float4 ga = *(const float4*)(p.in[I_LN2G] + col), gb = *(const float4*)(p.in[I_LN2G] + col + 4), ba = *(const float4*)(p.in[I_LN2B] + col), bb = *(const float4*)(p.in[I_LN2B] + col + 4);
                float4 o0, o1;
                o0.x = (v[c * 8 + 0] - mu) * rs * ga.x + ba.x; o0.y = (v[c * 8 + 1] - mu) * rs * ga.y + ba.y; o0.z = (v[c * 8 + 2] - mu) * rs * ga.z + ba.z; o0.w = (v[c * 8 + 3] - mu) * rs * ga.w + ba.w;
                o1.x = (v[c * 8 + 4] - mu) * rs * gb.x + bb.x; o1.y = (v[c * 8 + 5] - mu) * rs * gb.y + bb.y; o1.z = (v[c * 8 + 6] - mu) * rs * gb.z + bb.z; o1.w = (v[c * 8 + 7] - mu) * rs * gb.w + bb.w;
                *(float4*)(p.out + (size_t)row * 2048 + col) = o0; *(float4*)(p.out + (size_t)row * 2048 + col + 4) = o1; }
        }
    }
}

constexpr int NPHASE = 12;

extern "C" void kernel_launch(void* const* d_in, const int* in_sizes, int n_in, void* d_out, int out_size, void* d_ws, size_t ws_size, hipStream_t stream) {
    static int grid = 0;
    if (grid == 0) {
        if (n_in != 26 || ws_size < WS_END) { fprintf(stderr, "kernel_launch: unexpected n_in %d or ws_size %zu (< %zu)\n", n_in, ws_size, (size_t)WS_END); grid = -1; return; }
        int dev = 0, cus = 0, per_cu = 0;
        hipGetDevice(&dev); hipDeviceGetAttribute(&cus, hipDeviceAttributeMultiprocessorCount, dev);
        if (hipFuncSetAttribute((const void*)fwd, hipFuncAttributeMaxDynamicSharedMemorySize, LDS_BYTES) != hipSuccess) { fprintf(stderr, "hipFuncSetAttribute failed\n"); grid = -1; return; }
        hipOccupancyMaxActiveBlocksPerMultiprocessor(&per_cu, (const void*)fwd, 512, LDS_BYTES);
        (void)hipGetLastError();
        if (per_cu < 1) fprintf(stderr, "occupancy query says %d blocks per CU\n", per_cu);
        grid = cus > 0 ? cus : 256;
    }
    if (grid < 0) return;
    hipMemsetAsync((char*)d_ws + WS_CTL, 0, CTL_BYTES, stream);
    Params p{};
    for (int i = 0; i < 26; ++i) p.in[i] = (const float*)d_in[i];
    p.out = (float*)d_out; p.ws = (unsigned char*)d_ws;
#if N_LAUNCH_MODE == 1
    p.lo_hi = (long long)0 | ((long long)NPHASE << 32);
    hipLaunchKernelGGL(fwd, dim3(grid), dim3(512), LDS_BYTES, stream, p);
#else
    for (int ph = 0; ph < NPHASE; ++ph) {
        p.lo_hi = (long long)ph | ((long long)(ph + 1) << 32);
        hipLaunchKernelGGL(fwd, dim3(grid), dim3(512), LDS_BYTES, stream, p);
    }
#endif
}
```

```cpp
#include <hip/hip_runtime.h>
#include <cstdio>
#include <cstdint>

#ifndef N_LAUNCH_MODE
#define N_LAUNCH_MODE 1
#endif

constexpr int B_ = 8, S_ = 2048, D_ = 2048, T_ = B_ * S_;
constexpr int INW = 3608;
constexpr int C_Q = 0, C_KC = 1024, C_VC = 1280, C_KS = 1536, C_VS = 1792, C_KW = 2048, C_VW = 2304, C_G = 2560, C_UP = 2584, C_QM = 3096;
constexpr int NC = 127;
constexpr int CROWS = B_ * NC * 2;
constexpr int NE = 32, DE = 2048, NA = T_ * 4;
constexpr float LN_EPS = 1e-5f;
constexpr float DN_ALPHA = 1.189207115002721f;
constexpr float ATT_SCALE = 0.08838834764831845f;

constexpr size_t al256(size_t x) { return (x + 255) & ~(size_t)255; }
constexpr size_t WS_CTL = 0;
constexpr size_t CTL_BYTES = 65536;
constexpr size_t CTL_CNT = 16384;
constexpr size_t WS_PROJ = CTL_BYTES;
constexpr size_t WS_KVMEM = WS_PROJ + al256((size_t)T_ * INW * 4);
constexpr size_t WS_BIAS1 = WS_KVMEM + al256((size_t)2048 * 1024 * 4);
constexpr size_t WS_HID = WS_BIAS1 + al256(2 * 16 * 256 * 4);
constexpr size_t WS_KC = WS_HID + al256((size_t)2 * 2048 * 256 * 4);
constexpr size_t WS_VC = WS_KC + al256((size_t)CROWS * 128 * 4);
constexpr size_t WS_POOLED = WS_VC + al256((size_t)CROWS * 128 * 4);
constexpr size_t WS_OPOOL = WS_POOLED + al256((size_t)T_ * 512 * 4);
constexpr size_t WS_OWIN = WS_OPOOL + al256((size_t)T_ * 512 * 4);
constexpr size_t WS_OCMP = WS_OWIN + al256((size_t)T_ * 1024 * 4);
constexpr size_t WS_OSLC = WS_OCMP + al256((size_t)T_ * 1024 * 4);
constexpr size_t WS_SEL = WS_OSLC + al256((size_t)T_ * 1024 * 4);
constexpr size_t WS_OMEM = WS_SEL + al256((size_t)T_ * 2 * 4);
constexpr size_t WS_CAT16 = WS_OMEM + al256((size_t)T_ * 512 * 4);
constexpr size_t WS_HPRE = WS_CAT16 + al256((size_t)T_ * 2048 * 2);
constexpr size_t WS_H = WS_HPRE + al256((size_t)T_ * 2048 * 4);
constexpr size_t WS_H16 = WS_H + al256((size_t)T_ * 2048 * 4);
constexpr size_t WS_GATE = WS_H16 + al256((size_t)T_ * 2048 * 2);
constexpr size_t WS_LIST = WS_GATE + al256((size_t)NA * 4);
constexpr size_t WS_ACT16 = WS_LIST + al256((size_t)NE * T_ * 4);
constexpr size_t WS_Y16 = WS_ACT16 + al256((size_t)(NA + 256) * 2048 * 2);
constexpr size_t WS_X16 = WS_Y16 + al256((size_t)NA * 2048 * 2);
constexpr size_t WS_MEM16 = WS_X16 + (size_t)T_ * 2048 * 2;
constexpr size_t WS_WTIN = WS_MEM16 + al256((size_t)2048 * 2048 * 2);
constexpr size_t WS_WTOUT = WS_WTIN + al256((size_t)3840 * 2048 * 2);
constexpr size_t WS_WTGU = WS_WTOUT + al256((size_t)2048 * 2048 * 2);
constexpr size_t WS_WTDN = WS_WTGU + al256((size_t)NE * 4096 * 2048 * 2);
constexpr size_t WS_PROJ16 = WS_WTDN + al256((size_t)NE * 2048 * 2048 * 2);
constexpr size_t WS_KVMEM16 = WS_PROJ16 + al256((size_t)(T_ + 64) * INW * 2);
constexpr size_t WS_WT1 = WS_KVMEM16 + al256((size_t)2048 * 1024 * 2);
constexpr size_t WS_UV = WS_WT1 + al256((size_t)2 * 512 * 2048 * 2);
constexpr size_t WS_KC16 = WS_UV + al256((size_t)2 * 4 * 2048 * 512 * 4);
constexpr size_t WS_VC16 = WS_KC16 + al256((size_t)B_ * 128 * 256 * 2);
constexpr size_t WS_WR16 = WS_VC16 + al256((size_t)B_ * 128 * 256 * 2);
constexpr size_t WS_Q8GU = WS_WR16 + al256((size_t)32 * 2048 * 2);
constexpr size_t WS_Q8DN = WS_Q8GU + al256((size_t)NE * 4096 * 2048);
constexpr size_t WS_SGU = WS_Q8DN + al256((size_t)NE * 2048 * 2048);
constexpr size_t WS_SDN = WS_SGU + al256((size_t)NE * 4096 * 4);
constexpr size_t WS_H8 = WS_SDN + al256((size_t)NE * 2048 * 4);
constexpr size_t WS_SAH = WS_H8 + al256((size_t)T_ * 2048);
constexpr size_t WS_ACT8 = WS_SAH + al256((size_t)T_ * 4);
constexpr size_t WS_SACT = WS_ACT8 + al256((size_t)(NA + 256) * 2048);
constexpr size_t WS_WTMKV = WS_SACT + al256((size_t)(NA + 256) * 4);
constexpr size_t WS_Q8OUT = WS_WTMKV + al256((size_t)1024 * 2048 * 2);
constexpr size_t WS_SOUT = WS_Q8OUT + al256((size_t)2048 * 2048);
constexpr size_t WS_CAT8 = WS_SOUT + al256(2048 * 4);
constexpr size_t WS_SCAT = WS_CAT8 + al256((size_t)T_ * 2048);
constexpr size_t WS_WT2 = WS_SCAT + al256((size_t)T_ * 4);
constexpr size_t WS_KV16 = WS_WT2 + al256((size_t)2 * 128 * 256 * 2);
constexpr size_t KVSEG = (size_t)S_ * 128;
constexpr size_t WS_END = WS_KV16 + al256((size_t)6 * B_ * 2 * S_ * 128 * 2);

constexpr int LDS_BYTES = 155648;

struct Params {
    const float* in[26];
    float* out;
    unsigned char* ws;
    long long lo_hi;
};
enum { I_X = 0, I_MEM, I_WIN, I_POSK, I_W1K, I_W2K, I_POSV, I_W1V, I_W2V, I_POOLW, I_POOLS, I_WMEMKV, I_GNNSA, I_GNPOOL, I_GNMEM, I_WOUT,
       I_LN1G, I_LN1B, I_WR, I_BR, I_WGU, I_BGU, I_WDN, I_BDN, I_LN2G, I_LN2B };

#define XB_TMO      128
#define XB_XCNT(j)  (256  + 64 * (j))
#define XB_XSUB(j)  (1280 + 64 * (j))
#define XB_XGEN(j)  (2304 + 64 * (j))
#define XB_TOP      3328
#define XB_TOPGEN   3392
#define XCD_BAR_WORDS 3456
#define XB_SPIN_CAP (1u << 25)
#define LAS __attribute__((address_space(3)))

__device__ __forceinline__ unsigned xb_ld(unsigned* p)              { return __hip_atomic_load(p, __ATOMIC_RELAXED, __HIP_MEMORY_SCOPE_AGENT); }
__device__ __forceinline__ unsigned xb_add(unsigned* p, unsigned v) { return __hip_atomic_fetch_add(p, v, __ATOMIC_RELAXED, __HIP_MEMORY_SCOPE_AGENT); }
__device__ __forceinline__ unsigned xb_xcc_id() { return (unsigned)__builtin_amdgcn_s_getreg((3 << 11) | 20) & 0xFu; }
#define XB_SPIN(cond, bar) do { unsigned _sp = 0; while (cond) { __builtin_amdgcn_s_sleep(1); \
    if ((++_sp & 255u) == 0u) { if (xb_ld(&(bar)[XB_TMO])) break; if (_sp > XB_SPIN_CAP) { atomicAdd(&(bar)[XB_TMO], 1u); break; } } } } while (0)

struct XcdBarrier { unsigned* bar; unsigned x; volatile LAS unsigned* st; };

__device__ __forceinline__ XcdBarrier xcd_barrier_post(unsigned* bar, volatile LAS unsigned* st) {
    XcdBarrier b; b.bar = bar; b.x = xb_xcc_id(); b.st = st;
    if (threadIdx.x == 0) (void)xb_add(&bar[XB_XCNT(b.x)], 1u);
    return b;
}
__device__ __forceinline__ void xcd_barrier_complete(unsigned* bar, unsigned x, unsigned& nloc, unsigned& nx) {
    const unsigned G = gridDim.x * gridDim.y * gridDim.z;
    unsigned sum, cnt, mine, sp = 0u;
    for (;;) {
        sum = 0u; cnt = 0u; mine = 0u;
#pragma unroll
        for (unsigned j = 0; j < 16; ++j) { const unsigned c = xb_ld(&bar[XB_XCNT(j)]); sum += c; cnt += (c > 0u) ? 1u : 0u; mine = (j == x) ? c : mine; }
        if (sum == G) break;
        __builtin_amdgcn_s_sleep(1);
        if ((++sp & 255u) == 0u) { if (xb_ld(&bar[XB_TMO])) break; if (sp > XB_SPIN_CAP) { atomicAdd(&bar[XB_TMO], 1u); break; } }
    }
    nloc = mine > 0u ? mine : 1u; nx = cnt > 0u ? cnt : 1u;
}
__device__ __forceinline__ void xcd_barrier(const XcdBarrier& b) {
    asm volatile("s_waitcnt vmcnt(0)" ::: "memory");
    __syncthreads();
    if (threadIdx.x == 0) {
        unsigned* bar = b.bar;
        __builtin_amdgcn_s_waitcnt(0);
        unsigned nloc = b.st[0], nx = b.st[1];
        if (nloc == 0u) { xcd_barrier_complete(bar, b.x, nloc, nx); b.st[0] = nloc; b.st[1] = nx; }
        const unsigned old = xb_add(&bar[XB_XSUB(b.x)], 1u);
        const unsigned gen = old / nloc;
        if (old + 1u == (gen + 1u) * nloc) {
            __builtin_amdgcn_fence(__ATOMIC_RELEASE, "agent");
            asm volatile("s_waitcnt vmcnt(0)" ::: "memory");
            const unsigned og = xb_add(&bar[XB_TOP], 1u);
            const unsigned tg = og / nx;
            if (og + 1u == (tg + 1u) * nx) xb_add(&bar[XB_TOPGEN], 1u);
            else XB_SPIN(xb_ld(&bar[XB_TOPGEN]) == tg, bar);
            __builtin_amdgcn_fence(__ATOMIC_ACQUIRE, "agent");
            xb_add(&bar[XB_XGEN(b.x)], 1u);
            asm volatile("s_waitcnt vmcnt(0)" ::: "memory");
        } else {
            XB_SPIN(xb_ld(&bar[XB_XGEN(b.x)]) == gen, bar);
            __builtin_amdgcn_fence(__ATOMIC_ACQUIRE, "agent");
            asm volatile("s_waitcnt vmcnt(0)" ::: "memory");
        }
    }
    __syncthreads();
}

typedef _Float16 h8 __attribute__((ext_vector_type(8)));
typedef _Float16 h4 __attribute__((ext_vector_type(4)));
typedef float f4 __attribute__((ext_vector_type(4)));

__device__ __forceinline__ float wave_sum(float v) {
#pragma unroll
    for (int o = 32; o > 0; o >>= 1) v += __shfl_xor(v, o);
    return v;
}
__device__ __forceinline__ float wave_max(float v) {
#pragma unroll
    for (int o = 32; o > 0; o >>= 1) v = fmaxf(v, __shfl_xor(v, o));
    return v;
}
__device__ __forceinline__ void wave_sync() {
    asm volatile("s_waitcnt lgkmcnt(0)" ::: "memory");
    __builtin_amdgcn_wave_barrier();
}
__device__ __forceinline__ float gelu_tanh(float x) {
    const float u = 0.7978845608028654f * (x + 0.044715f * x * x * x);
    return 0.5f * x * (1.f + tanhf(u));
}
__device__ __forceinline__ float gelu_fast(float x) { const float u = 0.7978845608028654f * (x + 0.044715f * x * x * x); const float t = 1.f - 2.f * __builtin_amdgcn_rcpf(1.f + __builtin_amdgcn_exp2f(2.8853900817779268f * u)); return 0.5f * x * (1.f + t); }
__device__ __forceinline__ float sigmoidf_(float x) { return 1.f / (1.f + expf(-x)); }
__device__ __forceinline__ unsigned pk4_fp8(float a, float b, float c, float d) { int w = 0; w = __builtin_amdgcn_cvt_pk_fp8_f32(a, b, w, false); w = __builtin_amdgcn_cvt_pk_fp8_f32(c, d, w, true); return (unsigned)w; }
__device__ __forceinline__ void dec4_fp8(unsigned w, float& a, float& b, float& c, float& d) { a = __builtin_amdgcn_cvt_f32_fp8((int)w, 0); b = __builtin_amdgcn_cvt_f32_fp8((int)w, 1); c = __builtin_amdgcn_cvt_f32_fp8((int)w, 2); d = __builtin_amdgcn_cvt_f32_fp8((int)w, 3); }
__device__ __forceinline__ float swiglu_fast(float g, float l) { const float xg = fminf(g, 7.f), xl = fminf(fmaxf(l, -7.f), 7.f); return xg * __builtin_amdgcn_rcpf(1.f + __builtin_amdgcn_exp2f(-2.4554669595930156f * xg)) * (xl + 1.f); }

constexpr int G_LD = 40;
template <class AF, class EF>
__device__ __forceinline__ void gemm_tile(char* smem, int K, const AF& af, const float* __restrict__ Bm, int ldb, int n0, int Nlim, bool perm, const EF& ef) {
    _Float16* As = (_Float16*)smem;
    _Float16* Bs = As + 128 * G_LD;
    const int tid = threadIdx.x, lane = tid & 63, wid = tid >> 6, wr = wid >> 2, wc = wid & 3, fr = lane & 15, fq = lane >> 4;
    f4 acc[4][2];
#pragma unroll
    for (int m = 0; m < 4; ++m)
#pragma unroll
        for (int n = 0; n < 2; ++n) acc[m][n] = (f4){0.f, 0.f, 0.f, 0.f};
    const int ar = tid >> 3, ak = (tid & 7) * 4;
    const float* ap0 = af.row(ar);
    const float* ap1 = af.row(ar + 64);
    const int bk = tid >> 5, bn = (tid & 31) * 4;
    const bool bok = (n0 + bn) < Nlim;
    int bnp[4];
#pragma unroll
    for (int i = 0; i < 4; ++i) { const int c = bn + i; bnp[i] = perm ? ((c & ~31) | ((c & 1) << 4) | ((c & 31) >> 1)) : c; }
    for (int k0 = 0; k0 < K; k0 += 32) {
        const int ko = af.koff(k0 + ak);
        float4 a0 = make_float4(0.f, 0.f, 0.f, 0.f), a1 = a0, b0 = a0, b1 = a0;
        if (ap0) a0 = *(const float4*)(ap0 + ko);
        if (ap1) a1 = *(const float4*)(ap1 + ko);
        if (bok) { b0 = *(const float4*)(Bm + (size_t)(k0 + bk) * ldb + n0 + bn); b1 = *(const float4*)(Bm + (size_t)(k0 + bk + 16) * ldb + n0 + bn); }
        __syncthreads();
        *(h4*)&As[ar * G_LD + ak] = (h4){(_Float16)a0.x, (_Float16)a0.y, (_Float16)a0.z, (_Float16)a0.w};
        *(h4*)&As[(ar + 64) * G_LD + ak] = (h4){(_Float16)a1.x, (_Float16)a1.y, (_Float16)a1.z, (_Float16)a1.w};
        Bs[bnp[0] * G_LD + bk] = (_Float16)b0.x; Bs[bnp[1] * G_LD + bk] = (_Float16)b0.y; Bs[bnp[2] * G_LD + bk] = (_Float16)b0.z; Bs[bnp[3] * G_LD + bk] = (_Float16)b0.w;
        Bs[bnp[0] * G_LD + bk + 16] = (_Float16)b1.x; Bs[bnp[1] * G_LD + bk + 16] = (_Float16)b1.y; Bs[bnp[2] * G_LD + bk + 16] = (_Float16)b1.z; Bs[bnp[3] * G_LD + bk + 16] = (_Float16)b1.w;
        __syncthreads();
        h8 a[4], b[2];
#pragma unroll
        for (int m = 0; m < 4; ++m) a[m] = *(const h8*)&As[(wr * 64 + m * 16 + fr) * G_LD + fq * 8];
#pragma unroll
        for (int n = 0; n < 2; ++n) b[n] = *(const h8*)&Bs[(wc * 32 + n * 16 + fr) * G_LD + fq * 8];
#pragma unroll
        for (int m = 0; m < 4; ++m)
#pragma unroll
            for (int n = 0; n < 2; ++n) acc[m][n] = __builtin_amdgcn_mfma_f32_16x16x32_f16(a[m], b[n], acc[m][n], 0, 0, 0);
    }
    ef(acc, wr, wc, fr, fq);
    __syncthreads();
}

struct ARowPlain { const float* base; int ld; int m0; int mlim;
    __device__ __forceinline__ const float* row(int r) const { return (m0 + r) < mlim ? base + (size_t)(m0 + r) * ld : nullptr; }
    __device__ __forceinline__ int koff(int k) const { return k; } };
struct ARowCmp { const float* proj; int col; int m0;
    __device__ __forceinline__ const float* row(int r) const { const int g = m0 + r; if (g >= CROWS) return nullptr; const int kvh = g & 1, bc = g >> 1, b = bc / NC, c = bc % NC;
        return proj + (size_t)(b * S_ + 16 * c) * INW + col + kvh * 128; }
    __device__ __forceinline__ int koff(int k) const { return (k >> 7) * INW + (k & 127); } };
struct ARowList { const float* base; const int* list; int m0; int cnt; int shift;
    __device__ __forceinline__ const float* row(int r) const { if (m0 + r >= cnt) return nullptr; const int a = list[m0 + r]; return base + (size_t)(a >> shift) * 2048; }
    __device__ __forceinline__ int koff(int k) const { return k; } };

struct EpiStore { float* C; int ldc; int m0; int n0; int mlim; int nlim; _Float16* C16;
    __device__ __forceinline__ void operator()(const f4 (&acc)[4][2], int wr, int wc, int fr, int fq) const {
#pragma unroll
        for (int m = 0; m < 4; ++m)
#pragma unroll
            for (int n = 0; n < 2; ++n)
#pragma unroll
                for (int j = 0; j < 4; ++j) { const int r = m0 + wr * 64 + m * 16 + fq * 4 + j, c = n0 + wc * 32 + n * 16 + fr;
                    if (r < mlim && c < nlim) { C[(size_t)r * ldc + c] = acc[m][n][j]; if (C16) C16[(size_t)r * ldc + c] = (_Float16)acc[m][n][j]; } } } };
struct EpiKc { _Float16* C; int m0;
    __device__ __forceinline__ void operator()(const f4 (&acc)[4][2], int wr, int wc, int fr, int fq) const {
#pragma unroll
        for (int m = 0; m < 4; ++m)
#pragma unroll
            for (int n = 0; n < 2; ++n)
#pragma unroll
                for (int j = 0; j < 4; ++j) { const int r = m0 + wr * 64 + m * 16 + fq * 4 + j, c = wc * 32 + n * 16 + fr;
                    C[(size_t)r * 128 + c] = (((r >> 1) & 127) == 127) ? (_Float16)0.f : (_Float16)acc[m][n][j]; } } };
struct EpiPool { _Float16* C; const float* scale; int m0; int g;
    __device__ __forceinline__ void operator()(const f4 (&acc)[4][2], int wr, int wc, int fr, int fq) const {
#pragma unroll
        for (int m = 0; m < 4; ++m)
#pragma unroll
            for (int n = 0; n < 2; ++n)
#pragma unroll
                for (int j = 0; j < 4; ++j) { const int r = m0 + wr * 64 + m * 16 + fq * 4 + j, c = g * 128 + wc * 32 + n * 16 + fr;
                    C[(size_t)r * 512 + c] = (_Float16)(acc[m][n][j] * scale[c]); } } };
struct EpiHid { float* C; const float* bias; int m0; int n0;
    __device__ __forceinline__ void operator()(const f4 (&acc)[4][2], int wr, int wc, int fr, int fq) const {
#pragma unroll
        for (int m = 0; m < 4; ++m)
#pragma unroll
            for (int n = 0; n < 2; ++n)
#pragma unroll
                for (int j = 0; j < 4; ++j) { const int r = m0 + wr * 64 + m * 16 + fq * 4 + j, c = n0 + wc * 32 + n * 16 + fr;
                    if (r < CROWS) C[(size_t)r * 256 + c] = gelu_tanh(acc[m][n][j] + bias[c]); } } };
struct EpiOut { float* C; const float* x; int m0; int n0;
    __device__ __forceinline__ void operator()(const f4 (&acc)[4][2], int wr, int wc, int fr, int fq) const {
#pragma unroll
        for (int m = 0; m < 4; ++m)
#pragma unroll
            for (int n = 0; n < 2; ++n)
#pragma unroll
                for (int j = 0; j < 4; ++j) { const size_t o = (size_t)(m0 + wr * 64 + m * 16 + fq * 4 + j) * 2048 + n0 + wc * 32 + n * 16 + fr;
                    C[o] = DN_ALPHA * x[o] + acc[m][n][j]; } } };
struct EpiGu { float* act; const float* bgu; const int* list; int m0; int cnt; int n0;
    __device__ __forceinline__ void operator()(const f4 (&acc)[4][2], int wr, int wc, int fr, int fq) const {
        const int jc = (n0 + wc * 32) / 2 + fr;
        const float bg = bgu[2 * jc], bl = bgu[2 * jc + 1];
#pragma unroll
        for (int m = 0; m < 4; ++m)
#pragma unroll
            for (int j = 0; j < 4; ++j) { const int r = m0 + wr * 64 + m * 16 + fq * 4 + j;
                if (r < cnt) { const int a = list[r];
                    const float xg = fminf(acc[m][0][j] + bg, 7.f), xl = fminf(fmaxf(acc[m][1][j] + bl, -7.f), 7.f);
                    act[(size_t)a * 2048 + jc] = xg * sigmoidf_(1.702f * xg) * (xl + 1.f); } } } };
struct EpiDn { float* y; const float* bdn; const int* list; const float* gate; int m0; int cnt; int n0;
    __device__ __forceinline__ void operator()(const f4 (&acc)[4][2], int wr, int wc, int fr, int fq) const {
#pragma unroll
        for (int m = 0; m < 4; ++m)
#pragma unroll
            for (int j = 0; j < 4; ++j) { const int r = m0 + wr * 64 + m * 16 + fq * 4 + j;
                if (r < cnt) { const int a = list[r]; const float g = gate[a];
#pragma unroll
                    for (int n = 0; n < 2; ++n) { const int c = n0 + wc * 32 + n * 16 + fr; y[(size_t)a * 2048 + c] = (acc[m][n][j] + bdn[c]) * g; } } } } };

constexpr int WLDS_FLOATS = 4096 + 512 + 32;
template <bool SHARED>
__device__ __forceinline__ void wave_attn(float* sw, const float* __restrict__ qptr, const float* __restrict__ Kb, const float* __restrict__ Vb, int ld, int nseg, float scale, float* __restrict__ optr) {
    const int lane = threadIdx.x & 63;
    float* sq = sw + 4096; const int* segs = (const int*)(sw + 4096 + 512);
#pragma unroll
    for (int i = 0; i < 8; ++i) sq[lane + 64 * i] = qptr[lane + 64 * i];
    wave_sync();
    for (int sg = 0; sg < nseg; ++sg) {
        const int start = segs[sg], len = segs[16 + sg];
        float d0 = 0.f, d1 = 0.f, d2 = 0.f, d3 = 0.f;
        if (lane < len) {
            const float* kp = Kb + (size_t)(start + lane) * ld;
            for (int d4 = 0; d4 < 32; ++d4) {
                if (SHARED) {
                    const float4 kv = *(const float4*)(kp + d4 * 4);
                    const float4 q0 = *(const float4*)(sq + d4 * 4), q1 = *(const float4*)(sq + 128 + d4 * 4), q2 = *(const float4*)(sq + 256 + d4 * 4), q3 = *(const float4*)(sq + 384 + d4 * 4);
                    d0 += kv.x * q0.x + kv.y * q0.y + kv.z * q0.z + kv.w * q0.w;
                    d1 += kv.x * q1.x + kv.y * q1.y + kv.z * q1.z + kv.w * q1.w;
                    d2 += kv.x * q2.x + kv.y * q2.y + kv.z * q2.z + kv.w * q2.w;
                    d3 += kv.x * q3.x + kv.y * q3.y + kv.z * q3.z + kv.w * q3.w;
                } else {
                    const float4 k0 = *(const float4*)(kp + d4 * 4), k1 = *(const float4*)(kp + 128 + d4 * 4), k2 = *(const float4*)(kp + 256 + d4 * 4), k3 = *(const float4*)(kp + 384 + d4 * 4);
                    const float4 q0 = *(const float4*)(sq + d4 * 4), q1 = *(const float4*)(sq + 128 + d4 * 4), q2 = *(const float4*)(sq + 256 + d4 * 4), q3 = *(const float4*)(sq + 384 + d4 * 4);
                    d0 += k0.x * q0.x + k0.y * q0.y + k0.z * q0.z + k0.w * q0.w;
                    d1 += k1.x * q1.x + k1.y * q1.y + k1.z * q1.z + k1.w * q1.w;
                    d2 += k2.x * q2.x + k2.y * q2.y + k2.z * q2.z + k2.w * q2.w;
                    d3 += k3.x * q3.x + k3.y * q3.y + k3.z * q3.z + k3.w * q3.w;
                }
            }
        }
        const bool ok = lane < len;
        sw[sg * 64 + lane] = ok ? d0 * scale : -1e30f;
        sw[1024 + sg * 64 + lane] = ok ? d1 * scale : -1e30f;
        sw[2048 + sg * 64 + lane] = ok ? d2 * scale : -1e30f;
        sw[3072 + sg * 64 + lane] = ok ? d3 * scale : -1e30f;
    }
    wave_sync();
    const int n = nseg * 64;
#pragma unroll
    for (int g = 0; g < 4; ++g) {
        float mx = -1e30f;
        for (int i = lane; i < n; i += 64) mx = fmaxf(mx, sw[g * 1024 + i]);
        mx = wave_max(mx);
        float sm = 0.f;
        for (int i = lane; i < n; i += 64) { const float v = sw[g * 1024 + i]; sm += (v > -1e29f) ? expf(v - mx) : 0.f; }
        sm = wave_sum(sm);
        const float inv = sm > 0.f ? 1.f / sm : 0.f;
        for (int i = lane; i < n; i += 64) { const float v = sw[g * 1024 + i]; sw[g * 1024 + i] = (v > -1e29f) ? expf(v - mx) * inv : 0.f; }
    }
    wave_sync();
    float o[4][2];
#pragma unroll
    for (int g = 0; g < 4; ++g) { o[g][0] = 0.f; o[g][1] = 0.f; }
    for (int sg = 0; sg < nseg; ++sg) {
        const int start = segs[sg], len = segs[16 + sg];
        for (int l = 0; l < len; ++l) {
            const float* vp = Vb + (size_t)(start + l) * ld;
            if (SHARED) {
                const float v0 = vp[lane], v1 = vp[lane + 64];
#pragma unroll
                for (int g = 0; g < 4; ++g) { const float p = sw[g * 1024 + sg * 64 + l]; o[g][0] += p * v0; o[g][1] += p * v1; }
            } else {
#pragma unroll
                for (int g = 0; g < 4; ++g) { const float p = sw[g * 1024 + sg * 64 + l]; o[g][0] += p * vp[g * 128 + lane]; o[g][1] += p * vp[g * 128 + lane + 64]; }
            }
        }
    }
#pragma unroll
    for (int g = 0; g < 4; ++g) { optr[g * 128 + lane] = o[g][0]; optr[g * 128 + lane + 64] = o[g][1]; }
}

namespace g8 {
constexpr int BM = 256, BK = 64, HALF = 128, HTB = HALF * BK * 2, STAGE_BYTES = 8 * HTB;
constexpr int KK = 2048;
typedef float f32x4 __attribute__((ext_vector_type(4)));
__device__ __forceinline__ int lds_byte(int r, int c) { const int st = (r >> 4) * 2 + (c >> 5), rr = r & 15, cc = c & 31, ob = rr * 64 + cc * 2; return st * 1024 + (ob ^ (((ob >> 9) & 1) << 5)); }
__device__ __forceinline__ void stage_rc(int b, int& R, int& C) { const int st = b / 1024, sb = b % 1024, swz = sb ^ (((sb >> 9) & 1) << 5); R = (st >> 1) * 16 + swz / 64; C = (st & 1) * 32 + (swz % 64) / 2; }
__device__ __forceinline__ int perm32(int rho) { const int n = rho >> 4, i = rho & 15; return 8 * (i >> 2) + 4 * n + (i & 3); }

typedef int i32x4 __attribute__((ext_vector_type(4)));
typedef unsigned u32x2 __attribute__((ext_vector_type(2)));
typedef unsigned u32x4 __attribute__((ext_vector_type(4)));
template <bool I8> struct AccSel { typedef f32x4 T; };
template <> struct AccSel<true> { typedef i32x4 T; };
__device__ __forceinline__ f32x4 mma16(i32x4 a, i32x4 b, f32x4 c) { return __builtin_amdgcn_mfma_f32_16x16x32_f16(*reinterpret_cast<h8*>(&a), *reinterpret_cast<h8*>(&b), c, 0, 0, 0); }
__device__ __forceinline__ i32x4 mma16(i32x4 a, i32x4 b, i32x4 c) { return __builtin_amdgcn_mfma_i32_16x16x64_i8(a, b, c, 0, 0, 0); }
struct Unit { int m0, n0, e, cnt, rbase; };
constexpr int EP_OFF = STAGE_BYTES + 2048, EP_LD = 528, EP_GRP = 16 * EP_LD;
__device__ __forceinline__ void ep_sync() { asm volatile("s_waitcnt lgkmcnt(0)" ::: "memory"); __builtin_amdgcn_s_barrier(); asm volatile("" ::: "memory"); }
__device__ __forceinline__ int ep_tid() { int tz = threadIdx.x; asm volatile("" : "+v"(tz)); return tz; }
__device__ __forceinline__ h8 cvt8(f32x4 a, f32x4 b) { h8 o; o[0] = (_Float16)a[0]; o[1] = (_Float16)a[1]; o[2] = (_Float16)a[2]; o[3] = (_Float16)a[3]; o[4] = (_Float16)b[0]; o[5] = (_Float16)b[1]; o[6] = (_Float16)b[2]; o[7] = (_Float16)b[3]; return o; }

__device__ __forceinline__ void tile_order(int L, int nM, int nN, int& pm, int& pn) {
    const int nwg = nM * nN; int wgid = L;
    { const int q = nwg / 8, r = nwg % 8, xcd = wgid % 8, off = wgid / 8; wgid = (xcd < r ? xcd * (q + 1) : r * (q + 1) + (xcd - r) * q) + off; }
    const int nig = 8 * nN, gid = wgid / nig, fm = gid * 8, gsz = (nM - fm) < 8 ? (nM - fm) : 8;
    pm = fm + ((wgid % nig) % gsz); pn = (wgid % nig) / gsz;
}

template <class Prob>
__device__ __forceinline__ void gemm_phase(LAS unsigned char* lds, const Prob& P) {
    const int tid = threadIdx.x, wid = __builtin_amdgcn_readfirstlane(tid >> 6), lane = tid & 63, wr = wid >> 2, wc = wid & 3, fr = lane & 15, fq = lane >> 4;
    constexpr int nt = Prob::NT; constexpr size_t KS2 = Prob::KS2; constexpr unsigned ROWB = Prob::ROWB; constexpr bool I8 = Prob::I8;
    int sR[2], sC2[2]; unsigned voffB[2];
#pragma unroll
    for (int i = 0; i < 2; ++i) { int R, C; stage_rc(tid * 16 + i * 8192, R, C); sR[i] = R; sC2[i] = C * 2; const int Rb = Prob::PERM ? ((R & ~31) + perm32(R & 31)) : R; voffB[i] = (unsigned)Rb * ROWB + (unsigned)C * 2u; }
    const size_t kstep = (size_t)(BK * 2);
    const size_t hstep = (size_t)HALF * ROWB;
    const unsigned ldsw = (unsigned)wid * 1024u;
    const int aoff = lds_byte(wr * 64 + fr, fq * 8), boff = lds_byte(wc * 32 + fr, fq * 8);
#define G8_SA(b, h) (((b) * 2 + (h)) * HTB)
#define G8_SB(b, h) ((4 + (b) * 2 + (h)) * HTB)
#define G8_STAGE(bufoff, gbase, voff) do { _Pragma("unroll") for (int _i = 0; _i < 2; ++_i) \
        __builtin_amdgcn_global_load_lds((const unsigned*)((const char*)(gbase) + (voff)[_i]), (LAS unsigned*)(lds + (bufoff) + ldsw + _i * 8192), 16, 0, 0); } while (0)
#define G8_LDA(dst, b, h) do { _Pragma("unroll") for (int m = 0; m < 4; ++m) _Pragma("unroll") for (int k = 0; k < 2; ++k) dst[m][k] = *(const LAS i32x4*)(lds + G8_SA(b, h) + aoff + m * 2048 + k * 1024); } while (0)
#define G8_LDB(dst, b, h) do { _Pragma("unroll") for (int n = 0; n < 2; ++n) _Pragma("unroll") for (int k = 0; k < 2; ++k) dst[n][k] = *(const LAS i32x4*)(lds + G8_SB(b, h) + boff + n * 2048 + k * 1024); } while (0)
#define G8_MMA(ai, bj, At, Bt) do { __builtin_amdgcn_s_setprio(1); _Pragma("unroll") for (int m = 0; m < 4; ++m) _Pragma("unroll") for (int n = 0; n < 2; ++n) _Pragma("unroll") for (int k = 0; k < 2; ++k) \
        acc[ai][bj][m][n] = mma16(Bt[n][k], At[m][k], acc[ai][bj][m][n]); __builtin_amdgcn_s_setprio(0); } while (0)
#define G8_WAIT_V(n) asm volatile("s_waitcnt vmcnt(" #n ")" ::: "memory")
#define G8_WAIT_L(n) asm volatile("s_waitcnt lgkmcnt(" #n ")" ::: "memory")
#define G8_BAR __builtin_amdgcn_s_barrier()
#define G8_SCHED __builtin_amdgcn_sched_barrier(0)
    Unit cur, nxt; int ui = 0;
    if (!P.next(0, cur)) return;
    typedef typename AccSel<I8>::T AccT;
    AccT acc[2][2][4][2];
#pragma unroll
    for (int a = 0; a < 2; ++a)
#pragma unroll
        for (int b = 0; b < 2; ++b)
#pragma unroll
            for (int m = 0; m < 4; ++m)
#pragma unroll
                for (int n = 0; n < 2; ++n) acc[a][b][m][n] = AccT{};
    i32x4 At[4][2], B0[2][2], B1[2][2];
    unsigned vc[2][2], vn[2][2];
    P.a_offs(cur, sR, sC2, vc);
    const char* const Ab = P.a_base();
    const char* cB = P.b_base(cur);
    G8_STAGE(G8_SB(0, 0), cB, voffB); G8_STAGE(G8_SA(0, 0), Ab, vc[0]); G8_STAGE(G8_SB(0, 1), cB + hstep, voffB); G8_STAGE(G8_SA(0, 1), Ab, vc[1]);
    if (wr == 1) G8_BAR;
    G8_WAIT_V(4); G8_BAR;
    G8_STAGE(G8_SB(1, 0), cB + kstep, voffB); G8_STAGE(G8_SA(1, 0), Ab + kstep, vc[0]); G8_STAGE(G8_SB(1, 1), cB + hstep + kstep, voffB);
    G8_WAIT_V(6); G8_BAR;
    for (;;) {
        const bool has_next = P.next(ui + 1, nxt);
        const char* nB = cB;
        if (has_next) { P.a_offs(nxt, sR, sC2, vn); nB = P.b_base(nxt); }
        else { vn[0][0] = vc[0][0]; vn[0][1] = vc[0][1]; vn[1][0] = vc[1][0]; vn[1][1] = vc[1][1]; }
        for (int t = 0; t < nt; t += 2) {
            const bool last = (t == nt - 2);
            const char* a1 = Ab + (size_t)(t >> 1) * KS2 + kstep;
            const char* a2 = last ? Ab : Ab + (size_t)((t + 2) >> 1) * KS2; const char* b2 = last ? nB : cB + (size_t)(t + 2) * kstep;
            const char* a3 = a2 + kstep; const char* b3 = b2 + kstep;
            unsigned o2[2][2];
            o2[0][0] = last ? vn[0][0] : vc[0][0]; o2[0][1] = last ? vn[0][1] : vc[0][1]; o2[1][0] = last ? vn[1][0] : vc[1][0]; o2[1][1] = last ? vn[1][1] : vc[1][1];
            G8_LDB(B0, 0, 0); G8_SCHED; G8_LDA(At, 0, 0); G8_STAGE(G8_SA(1, 1), a1, vc[1]);
            G8_WAIT_L(8); G8_BAR; G8_WAIT_L(0); G8_MMA(0, 0, At, B0); G8_BAR; G8_SCHED;
            G8_LDB(B1, 0, 1); G8_STAGE(G8_SB(0, 0), b2, voffB);
            G8_BAR; G8_WAIT_L(0); G8_MMA(0, 1, At, B1); G8_BAR;
            G8_LDA(At, 0, 1); G8_STAGE(G8_SA(0, 0), a2, o2[0]);
            G8_BAR; G8_WAIT_L(0); G8_MMA(1, 0, At, B0); G8_BAR; G8_SCHED;
            G8_STAGE(G8_SB(0, 1), b2 + hstep, voffB);
            G8_WAIT_V(6); G8_BAR; G8_MMA(1, 1, At, B1); G8_BAR;
            G8_LDB(B0, 1, 0); G8_SCHED; G8_LDA(At, 1, 0); G8_STAGE(G8_SA(0, 1), a2, o2[1]);
            G8_WAIT_L(8); G8_BAR; G8_WAIT_L(0); G8_MMA(0, 0, At, B0); G8_BAR; G8_SCHED;
            G8_LDB(B1, 1, 1); G8_STAGE(G8_SB(1, 0), b3, voffB);
            G8_BAR; G8_WAIT_L(0); G8_MMA(0, 1, At, B1); G8_BAR;
            G8_LDA(At, 1, 1); G8_STAGE(G8_SA(1, 0), a3, o2[0]);
            G8_BAR; G8_WAIT_L(0); G8_MMA(1, 0, At, B0); G8_BAR; G8_SCHED;
            G8_STAGE(G8_SB(1, 1), b3 + hstep, voffB);
            G8_WAIT_V(6); G8_BAR; G8_MMA(1, 1, At, B1); G8_BAR;
        }
        P.epi(acc, cur, wr, wc, fr, fq, lds);
        if (!has_next) break;
#pragma unroll
        for (int a = 0; a < 2; ++a)
#pragma unroll
            for (int b = 0; b < 2; ++b)
#pragma unroll
                for (int m = 0; m < 4; ++m)
#pragma unroll
                    for (int n = 0; n < 2; ++n) acc[a][b][m][n] = AccT{};
        cur = nxt; cB = nB; ++ui;
        vc[0][0] = vn[0][0]; vc[0][1] = vn[0][1]; vc[1][0] = vn[1][0]; vc[1][1] = vn[1][1];
    }
    G8_WAIT_V(0);
    if (wr == 0) G8_BAR;
    G8_BAR;
#undef G8_SA
#undef G8_SB
#undef G8_STAGE
#undef G8_LDA
#undef G8_LDB
#undef G8_MMA
#undef G8_WAIT_V
#undef G8_WAIT_L
#undef G8_BAR
#undef G8_SCHED
}

struct ProbIn {
    static constexpr unsigned ROWB = 4096; static constexpr bool I8 = false;
    static constexpr int NT = 32; static constexpr size_t KS2 = 256;
    static constexpr bool PERM = true;
    const _Float16* A; _Float16* C16; int G, c;
    __device__ __forceinline__ bool next(int i, Unit& u) const { const int L = i * G + c; if (L >= 64 * 15 + 32) return false;
        if (L < 64 * 15) { int pm, pn; tile_order(L, 64, 15, pm, pn); u.m0 = pm * 256; u.n0 = pn * 256; u.e = 0; }
        else { const int v = L - 64 * 15; u.m0 = T_ + (v & 7) * 256; u.n0 = (v >> 3) * 256; u.e = 1; }
        u.cnt = 256; u.rbase = 0; return true; }
    __device__ __forceinline__ void a_offs(const Unit& u, const int (&R)[2], const int (&C2)[2], unsigned (&v)[2][2]) const {
#pragma unroll
        for (int h = 0; h < 2; ++h)
#pragma unroll
            for (int i = 0; i < 2; ++i) v[h][i] = (unsigned)(u.m0 + h * 128 + R[i]) * (unsigned)(KK * 2) + (unsigned)C2[i]; }
    __device__ __forceinline__ const char* a_base() const { return (const char*)A; }
    __device__ __forceinline__ const char* b_base(const Unit& u) const { return (const char*)A + (u.e ? (long long)(WS_WTMKV - WS_X16) : (long long)(WS_WTIN - WS_X16)) + (size_t)u.n0 * KK * 2; }
    __device__ __forceinline__ void epi(const f32x4 (&acc)[2][2][4][2], const Unit& u, int wr, int wc, int fr, int fq, LAS unsigned char* lds) const {
        LAS unsigned char* ep = lds + EP_OFF + wr * EP_GRP;
        const int tg = ep_tid() & 255, rrow = tg >> 4, ch = tg & 15;
        const int kvseg = (u.e == 0 && u.n0 >= 1024 && u.n0 < 2560) ? ((u.n0 - 1024) >> 8) : -1;
        _Float16* const Cb = (_Float16*)((char*)C16 + (u.e ? (long long)(WS_KVMEM16 - WS_PROJ16) : 0ll)); const int ldc = u.e ? 1024 : INW, nlim = u.e ? 1024 : INW, mb = u.e ? u.m0 - T_ : u.m0;
#pragma unroll
        for (int ai = 0; ai < 2; ++ai)
#pragma unroll
            for (int m = 0; m < 4; ++m) {
#pragma unroll
                for (int bj = 0; bj < 2; ++bj) *(LAS h8*)(ep + fr * EP_LD + (bj * 128 + wc * 32 + fq * 8) * 2) = cvt8(acc[ai][bj][m][0], acc[ai][bj][m][1]);
                ep_sync();
                const h8 x0 = *(const LAS h8*)(ep + rrow * EP_LD + ch * 32), x1 = *(const LAS h8*)(ep + rrow * EP_LD + ch * 32 + 16);
                const int grow = mb + ai * 128 + wr * 64 + m * 16 + rrow, gcol = u.n0 + ch * 16;
                if (kvseg >= 0) {
                    _Float16* dst = (_Float16*)((char*)C16 + (long long)(WS_KV16 - WS_PROJ16)) + ((size_t)(kvseg * B_ + (grow >> 11)) * 2 + (ch >> 3)) * KVSEG + (size_t)(grow & (S_ - 1)) * 128 + (ch & 7) * 16;
                    *(h8*)dst = x0; *(h8*)(dst + 8) = x1;
                } else {
                    if (gcol < nlim) *(h8*)(Cb + (size_t)grow * ldc + gcol) = x0;
                    if (gcol + 8 < nlim) *(h8*)(Cb + (size_t)grow * ldc + gcol + 8) = x1; }
                ep_sync();
            } }
};
struct ProbOut {
    static constexpr unsigned ROWB = 2048; static constexpr bool I8 = true;
    static constexpr int NT = 16; static constexpr size_t KS2 = 256;
    static constexpr bool PERM = true;
    const signed char* A; const signed char* Bt; _Float16* C; const _Float16* X; const float* sa; const float* sw; int G, c;
    __device__ __forceinline__ bool next(int i, Unit& u) const { const int L = i * G + c; if (L >= 64 * 8) return false; int pm, pn; tile_order(L, 64, 8, pm, pn); u.m0 = pm * 256; u.n0 = pn * 256; u.e = 0; u.cnt = 256; u.rbase = 0; return true; }
    __device__ __forceinline__ void a_offs(const Unit& u, const int (&R)[2], const int (&C2)[2], unsigned (&v)[2][2]) const {
#pragma unroll
        for (int h = 0; h < 2; ++h)
#pragma unroll
            for (int i = 0; i < 2; ++i) v[h][i] = (unsigned)(u.m0 + h * 128 + R[i]) * 2048u + (unsigned)C2[i]; }
    __device__ __forceinline__ const char* a_base() const { return (const char*)A; }
    __device__ __forceinline__ const char* b_base(const Unit& u) const { return (const char*)(Bt + (size_t)u.n0 * 2048); }
    __device__ __forceinline__ void epi(const i32x4 (&acc)[2][2][4][2], const Unit& u, int wr, int wc, int fr, int fq, LAS unsigned char* lds) const {
        LAS unsigned char* ep = lds + EP_OFF + wr * EP_GRP;
        const int tg = ep_tid() & 255, rrow = tg >> 4, ch = tg & 15;
        f32x4 s0[2], s1[2]; float srv[8];
#pragma unroll
        for (int bj = 0; bj < 2; ++bj) { const int col = u.n0 + bj * 128 + wc * 32 + fq * 8; s0[bj] = *(const f32x4*)(sw + col); s1[bj] = *(const f32x4*)(sw + col + 4); }
#pragma unroll
        for (int q = 0; q < 8; ++q) srv[q] = sa[u.m0 + (q >> 2) * 128 + wr * 64 + (q & 3) * 16 + fr];
#pragma unroll
        for (int ai = 0; ai < 2; ++ai)
#pragma unroll
            for (int m = 0; m < 4; ++m) { const float sr = srv[ai * 4 + m];
#pragma unroll
                for (int bj = 0; bj < 2; ++bj) { const i32x4 i0 = acc[ai][bj][m][0], i1 = acc[ai][bj][m][1];
                    *(LAS h8*)(ep + fr * EP_LD + (bj * 128 + wc * 32 + fq * 8) * 2) = cvt8((f32x4){(float)i0[0], (float)i0[1], (float)i0[2], (float)i0[3]} * (s0[bj] * sr), (f32x4){(float)i1[0], (float)i1[1], (float)i1[2], (float)i1[3]} * (s1[bj] * sr)); }
                const size_t go = (size_t)(u.m0 + ai * 128 + wr * 64 + m * 16 + rrow) * 2048 + u.n0 + ch * 16;
                const h8 r0 = *(const h8*)(X + go), r1 = *(const h8*)(X + go + 8);
                ep_sync();
                const h8 x0 = *(const LAS h8*)(ep + rrow * EP_LD + ch * 32), x1 = *(const LAS h8*)(ep + rrow * EP_LD + ch * 32 + 16);
                h8 o0, o1;
#pragma unroll
                for (int q = 0; q < 8; ++q) { o0[q] = (_Float16)(DN_ALPHA * (float)r0[q] + (float)x0[q]); o1[q] = (_Float16)(DN_ALPHA * (float)r1[q] + (float)x1[q]); }
                *(h8*)(C + go) = o0; *(h8*)(C + go + 8) = o1;
                ep_sync();
            } }
};
struct ProbCmp {
    static constexpr unsigned ROWB = 4096; static constexpr bool I8 = false;
    static constexpr int NT = 8; static constexpr size_t KS2 = 256;
    static constexpr bool PERM = false;
    const _Float16* A; const _Float16* Bt; float* C; int G, c;
    __device__ __forceinline__ bool next(int i, Unit& u) const { const int L = i * G + c; if (L >= 128) return false;
        u.e = L >> 6; const int r = L & 63; u.rbase = r & 3; u.n0 = ((r >> 2) & 1) * 256; u.m0 = (r >> 3) * 256; u.cnt = 256; return true; }
    __device__ __forceinline__ void a_offs(const Unit& u, const int (&R)[2], const int (&C2)[2], unsigned (&v)[2][2]) const {
#pragma unroll
        for (int h = 0; h < 2; ++h)
#pragma unroll
            for (int i = 0; i < 2; ++i) { const int row = u.m0 + h * 128 + R[i], kvh = row & 1, bj = row >> 1, b = bj >> 7, j = bj & 127;
                v[h][i] = (unsigned)((((u.e * B_ + b) * 2 + kvh) * S_ + 16 * j + 4 * u.rbase) * 128) * 2u + (unsigned)C2[i]; } }
    __device__ __forceinline__ const char* a_base() const { return (const char*)A; }
    __device__ __forceinline__ const char* b_base(const Unit& u) const { return (const char*)(Bt + ((size_t)u.e * 512 + u.n0) * KK + u.rbase * 512); }
    __device__ __forceinline__ void epi(const f32x4 (&acc)[2][2][4][2], const Unit& u, int wr, int wc, int fr, int fq, LAS unsigned char*) const {
        float* base = C + ((size_t)(u.e * 4 + u.rbase) * 2048) * 512;
#pragma unroll
        for (int ai = 0; ai < 2; ++ai)
#pragma unroll
            for (int m = 0; m < 4; ++m) { const int row = u.m0 + ai * 128 + wr * 64 + m * 16 + fr;
#pragma unroll
                for (int bj = 0; bj < 2; ++bj)
#pragma unroll
                    for (int n = 0; n < 2; ++n) { const int col = u.n0 + bj * 128 + wc * 32 + n * 16 + fq * 4;
                        *(f32x4*)(base + (size_t)row * 512 + col) = acc[ai][bj][m][n]; } } }
};
struct MoeTab { const LAS int* t; int NT;
    __device__ __forceinline__ bool find_i(int i, Unit& u) const {
        const LAS int* q = t + 128 + 8 * i;
        if (__builtin_amdgcn_readfirstlane(q[5]) == 0) return false;
        u.e = __builtin_amdgcn_readfirstlane(q[0]); u.m0 = __builtin_amdgcn_readfirstlane(q[1]); u.n0 = __builtin_amdgcn_readfirstlane(q[2]); u.cnt = __builtin_amdgcn_readfirstlane(q[3]); u.rbase = __builtin_amdgcn_readfirstlane(q[4]); return true; } };
__device__ __forceinline__ void moe_build(LAS int* t, int G, int vcu) {
    const int i = threadIdx.x;
    if (i < 40) { const int L = i * G + vcu; LAS int* q = t + 128 + 8 * i;
        if (L >= t[98]) q[5] = 0;
        else { int e = 0; for (; e < NE - 1; ++e) { if (L < t[32 + e + 1]) break; }
            const int ub = t[32 + e], cn = t[e], rs = t[65 + e]; const int nm = (cn + 255) >> 8, v = L - ub, mt = v % nm, ntile = v / nm;
            q[0] = e; q[1] = mt * 256; q[2] = ntile * 256; q[3] = min(256, cn - mt * 256); q[4] = rs; q[5] = 1; } }
}
struct ProbGu {
    static constexpr int NT = 16; static constexpr size_t KS2 = 256; static constexpr unsigned ROWB = 2048; static constexpr bool I8 = true;
    static constexpr bool PERM = true;
    const signed char* A; const signed char* Bt; unsigned char* act; const float* bgu; const int* list; const float* sa; const float* sw; MoeTab tab; int G, vcu;
    __device__ __forceinline__ bool next(int i, Unit& u) const { return tab.find_i(i, u); }
    __device__ __forceinline__ void a_offs(const Unit& u, const int (&R)[2], const int (&C2)[2], unsigned (&v)[2][2]) const {
#pragma unroll
        for (int h = 0; h < 2; ++h)
#pragma unroll
            for (int i = 0; i < 2; ++i) { int r = h * 128 + R[i]; r = r < u.cnt ? r : 0; const int a = list[(size_t)u.e * T_ + u.m0 + r]; v[h][i] = (unsigned)(a >> 2) * 2048u + (unsigned)C2[i]; } }
    __device__ __forceinline__ const char* a_base() const { return (const char*)A; }
    __device__ __forceinline__ const char* b_base(const Unit& u) const { return (const char*)(Bt + ((size_t)u.e * 4096 + u.n0) * 2048); }
    __device__ __forceinline__ void epi(const i32x4 (&acc)[2][2][4][2], const Unit& u, int wr, int wc, int fr, int fq, LAS unsigned char* lds) const {
        const float* bb = bgu + (size_t)u.e * 4096; const float* ss = sw + (size_t)u.e * 4096;
        LAS unsigned char* ep = lds + EP_OFF + wr * EP_GRP;
        const int tg = ep_tid() & 255, rrow = tg >> 4, ch = tg & 15;
        f32x4 b0[2], b1[2], s0[2], s1[2];
#pragma unroll
        for (int bj = 0; bj < 2; ++bj) { const int col = u.n0 + bj * 128 + wc * 32 + fq * 8;
            b0[bj] = *(const f32x4*)(bb + col); b1[bj] = *(const f32x4*)(bb + col + 4); s0[bj] = *(const f32x4*)(ss + col); s1[bj] = *(const f32x4*)(ss + col + 4); }
        float srv[8];
        { int av[8];
#pragma unroll
          for (int q = 0; q < 8; ++q) { const int rl = (q >> 2) * 128 + wr * 64 + (q & 3) * 16 + fr; av[q] = list[(size_t)u.e * T_ + u.m0 + (rl < u.cnt ? rl : 0)]; }
#pragma unroll
          for (int q = 0; q < 8; ++q) srv[q] = sa[av[q] >> 2]; }
        LAS unsigned char* ep2 = lds + EP_OFF + wr * (2 * 4608);
#define GU_WRITE(st) do { const int ai_ = (st) >> 1, mp_ = (st) & 1; LAS unsigned char* eb = ep2 + ((st) & 1) * 4608; \
            _Pragma("unroll") for (int mm = 0; mm < 2; ++mm) { const int m_ = mp_ * 2 + mm; const float sr = srv[ai_ * 4 + m_]; \
                _Pragma("unroll") for (int bj = 0; bj < 2; ++bj) { const i32x4 i0 = acc[ai_][bj][m_][0], i1 = acc[ai_][bj][m_][1]; \
                    const f32x4 v0 = (f32x4){(float)i0[0], (float)i0[1], (float)i0[2], (float)i0[3]} * (s0[bj] * sr) + b0[bj], v1 = (f32x4){(float)i1[0], (float)i1[1], (float)i1[2], (float)i1[3]} * (s1[bj] * sr) + b1[bj]; \
                    *(LAS unsigned*)(eb + (mm * 16 + fr) * 144 + (bj * 64 + wc * 16 + fq * 4)) = pk4_fp8(swiglu_fast(v0[0], v0[1]), swiglu_fast(v0[2], v0[3]), swiglu_fast(v1[0], v1[1]), swiglu_fast(v1[2], v1[3])); } } } while (0)
        GU_WRITE(0);
        ep_sync();
#pragma unroll
        for (int st = 0; st < 4; ++st) {
            if (st + 1 < 4) GU_WRITE(st + 1);
#pragma unroll
            for (int mm = 0; mm < 2; ++mm) { const u32x2 x0 = *(const LAS u32x2*)(ep2 + (st & 1) * 4608 + (mm * 16 + rrow) * 144 + ch * 8);
                const int rr = (st >> 1) * 128 + wr * 64 + ((st & 1) * 2 + mm) * 16 + rrow;
                if (rr < u.cnt) *(u32x2*)(act + (size_t)(u.rbase + u.m0 + rr) * 2048 + (u.n0 >> 1) + ch * 8) = x0; }
            ep_sync();
        }
#undef GU_WRITE
    }
};
struct ProbDn {
    static constexpr int NT = 16; static constexpr size_t KS2 = 256; static constexpr unsigned ROWB = 2048; static constexpr bool I8 = true;
    static constexpr bool PERM = true;
    const signed char* A; const signed char* Bt; unsigned char* y; const float* bdn; const int* list; const float* gate; const float* sa; const float* sw; MoeTab tab; int G, vcu;
    __device__ __forceinline__ bool next(int i, Unit& u) const { return tab.find_i(i, u); }
    __device__ __forceinline__ void a_offs(const Unit& u, const int (&R)[2], const int (&C2)[2], unsigned (&v)[2][2]) const {
#pragma unroll
        for (int h = 0; h < 2; ++h)
#pragma unroll
            for (int i = 0; i < 2; ++i) v[h][i] = (unsigned)(u.rbase + u.m0 + h * 128 + R[i]) * 2048u + (unsigned)C2[i]; }
    __device__ __forceinline__ const char* a_base() const { return (const char*)A; }
    __device__ __forceinline__ const char* b_base(const Unit& u) const { return (const char*)(Bt + ((size_t)u.e * 2048 + u.n0) * 2048); }
    __device__ __forceinline__ void epi(const i32x4 (&acc)[2][2][4][2], const Unit& u, int wr, int wc, int fr, int fq, LAS unsigned char* lds) const {
        const float* bb = bdn + (size_t)u.e * 2048; const float* ss = sw + (size_t)u.e * 2048;
        LAS unsigned char* ep = lds + EP_OFF + wr * (2 * 4352);
        const int tg = ep_tid() & 255, rrow = tg >> 4, ch = tg & 15;
        f32x4 b0[2], b1[2], s0[2], s1[2];
#pragma unroll
        for (int bj = 0; bj < 2; ++bj) { const int col = u.n0 + bj * 128 + wc * 32 + fq * 8;
            b0[bj] = *(const f32x4*)(bb + col); b1[bj] = *(const f32x4*)(bb + col + 4); s0[bj] = *(const f32x4*)(ss + col); s1[bj] = *(const f32x4*)(ss + col + 4); }
        float gv[8], srv[8]; int a2v[8];
        { int av[8];
#pragma unroll
          for (int q = 0; q < 8; ++q) { const int rl = (q >> 2) * 128 + wr * 64 + (q & 3) * 16 + fr, rc = rl < u.cnt ? rl : 0; av[q] = list[(size_t)u.e * T_ + u.m0 + rc]; srv[q] = sa[u.rbase + u.m0 + rc];
              const int rr = (q >> 2) * 128 + wr * 64 + (q & 3) * 16 + rrow; a2v[q] = list[(size_t)u.e * T_ + u.m0 + (rr < u.cnt ? rr : 0)]; }
#pragma unroll
          for (int q = 0; q < 8; ++q) gv[q] = gate[av[q]]; }
#define DN_WRITE(st) do { const int ai_ = (st) >> 2, m_ = (st) & 3; const float g = gv[st] * 16.f, sr = srv[st]; LAS unsigned char* eb = ep + ((st) & 1) * 4352; \
            _Pragma("unroll") for (int bj = 0; bj < 2; ++bj) { const i32x4 i0 = acc[ai_][bj][m_][0], i1 = acc[ai_][bj][m_][1]; \
                const f32x4 v0 = ((f32x4){(float)i0[0], (float)i0[1], (float)i0[2], (float)i0[3]} * (s0[bj] * sr) + b0[bj]) * g, v1 = ((f32x4){(float)i1[0], (float)i1[1], (float)i1[2], (float)i1[3]} * (s1[bj] * sr) + b1[bj]) * g; \
                u32x2 o; o[0] = pk4_fp8(v0[0], v0[1], v0[2], v0[3]); o[1] = pk4_fp8(v1[0], v1[1], v1[2], v1[3]); \
                *(LAS u32x2*)(eb + fr * 272 + (bj * 128 + wc * 32 + fq * 8)) = o; } } while (0)
        DN_WRITE(0);
        ep_sync();
#pragma unroll
        for (int st = 0; st < 8; ++st) {
            if (st + 1 < 8) DN_WRITE(st + 1);
            const int rr = (st >> 2) * 128 + wr * 64 + (st & 3) * 16 + rrow;
            const u32x4 x0 = *(const LAS u32x4*)(ep + (st & 1) * 4352 + rrow * 272 + ch * 16);
            if (rr < u.cnt) *(u32x4*)(y + (size_t)a2v[st] * 2048 + u.n0 + ch * 16) = x0;
            ep_sync();
        }
#undef DN_WRITE
    }
};
}

namespace at8 {
typedef float f32x16 __attribute__((ext_vector_type(16)));
typedef short s16x4 __attribute__((ext_vector_type(4)));
typedef unsigned u32x4 __attribute__((ext_vector_type(4)));
constexpr int SHM_V = 64 * 128 * 2, SHM_K = 64 * 128 * 2;
constexpr int LDS_WS = 2 * SHM_V + 2 * SHM_K;
constexpr int LDS_END = LDS_WS + 8 * 64 * 4;
constexpr float CEXP = ATT_SCALE * 1.4426950408889634f;
constexpr float THR_RAW = 8.f / ATT_SCALE;
#define AT_KSWZ(row, colB) ((row) * 256 + ((colB) ^ (((row) & 7) << 4)))
#define AT_SBAR() __builtin_amdgcn_sched_barrier(0)
__device__ __forceinline__ int crow(int r, int hi) { return (r & 3) + 8 * (r >> 2) + 4 * hi; }
__device__ __forceinline__ unsigned cvtpk(float lo, float hi) { auto v = __builtin_amdgcn_cvt_pkrtz(lo, hi); return *reinterpret_cast<unsigned*>(&v); }
__device__ __forceinline__ int v_st(int k, int c) { const int kk = (k & ~0xC) | ((k & 4) << 1) | ((k & 8) >> 1); return ((kk >> 3) * 4 + (c >> 5)) * 512 + ((kk & 7) * 32 + (c & 31)) * 2; }
__device__ __forceinline__ int v_rd_base(int lane) { return ((lane & 3) << 3) | (((lane >> 2) & 3) << 6) | (((lane >> 4) & 1) << 5) | (((lane >> 5) & 1) << 8); }
constexpr int v_rd_off(int d0, int ks, int half) { return d0 * 512 + ks * 4096 + half * 2048; }
template <int OFF> __device__ __forceinline__ s16x4 tr_read(int vb) { s16x4 r; asm volatile("ds_read_b64_tr_b16 %0, %1 offset:%2" : "=&v"(r) : "v"(vb), "i"(OFF) : "memory"); return r; }
__device__ __forceinline__ h8 mk8(s16x4 l, s16x4 h) { typedef short s16x8 __attribute__((ext_vector_type(8))); s16x8 w = {l[0], l[1], l[2], l[3], h[0], h[1], h[2], h[3]}; return *reinterpret_cast<h8*>(&w); }
struct VFrag { s16x4 l0, h0, l1, h1, l2, h2, l3, h3; };
template <int D0> __device__ __forceinline__ void pv_read(VFrag& f, int vb) {
    f.l0 = tr_read<v_rd_off(D0, 0, 0)>(vb); f.h0 = tr_read<v_rd_off(D0, 0, 1)>(vb); f.l1 = tr_read<v_rd_off(D0, 1, 0)>(vb); f.h1 = tr_read<v_rd_off(D0, 1, 1)>(vb);
    f.l2 = tr_read<v_rd_off(D0, 2, 0)>(vb); f.h2 = tr_read<v_rd_off(D0, 2, 1)>(vb); f.l3 = tr_read<v_rd_off(D0, 3, 0)>(vb); f.h3 = tr_read<v_rd_off(D0, 3, 1)>(vb);
}
__device__ __forceinline__ void pv_mma(f32x16& od, const VFrag& f, h8 pa0, h8 pa1, h8 pa2, h8 pa3) {
    od = __builtin_amdgcn_mfma_f32_32x32x16_f16(pa0, mk8(f.l0, f.h0), od, 0, 0, 0);
    od = __builtin_amdgcn_mfma_f32_32x32x16_f16(pa1, mk8(f.l1, f.h1), od, 0, 0, 0);
    od = __builtin_amdgcn_mfma_f32_32x32x16_f16(pa2, mk8(f.l2, f.h2), od, 0, 0, 0);
    od = __builtin_amdgcn_mfma_f32_32x32x16_f16(pa3, mk8(f.l3, f.h3), od, 0, 0, 0);
}
__device__ __forceinline__ void pv_d0(f32x16 (&o)[4], int vb, h8 pa0, h8 pa1, h8 pa2, h8 pa3) {
    VFrag fa, fb;
    pv_read<0>(fa, vb); pv_read<1>(fb, vb);
    asm volatile("s_waitcnt lgkmcnt(8)" ::: "memory"); AT_SBAR();
    pv_mma(o[0], fa, pa0, pa1, pa2, pa3); AT_SBAR();
    pv_read<2>(fa, vb);
    asm volatile("s_waitcnt lgkmcnt(8)" ::: "memory"); AT_SBAR();
    pv_mma(o[1], fb, pa0, pa1, pa2, pa3); AT_SBAR();
    pv_read<3>(fb, vb);
    asm volatile("s_waitcnt lgkmcnt(8)" ::: "memory"); AT_SBAR();
    pv_mma(o[2], fa, pa0, pa1, pa2, pa3); AT_SBAR();
    asm volatile("s_waitcnt lgkmcnt(0)" ::: "memory"); AT_SBAR();
    pv_mma(o[3], fb, pa0, pa1, pa2, pa3);
}
__device__ __forceinline__ void qkt(f32x16& p0, f32x16& p1, const char* Ks, const h8 (&qr)[8], int r32, int hi) {
    p0 = f32x16{}; p1 = f32x16{};
#pragma unroll
    for (int d0 = 0; d0 < 8; ++d0) { const int cb = (d0 * 16 + hi * 8) * 2;
        const h8 b0 = *reinterpret_cast<const h8*>(Ks + AT_KSWZ(r32, cb));
        const h8 b1 = *reinterpret_cast<const h8*>(Ks + AT_KSWZ(32 + r32, cb));
        p0 = __builtin_amdgcn_mfma_f32_32x32x16_f16(b0, qr[d0], p0, 0, 0, 0);
        p1 = __builtin_amdgcn_mfma_f32_32x32x16_f16(b1, qr[d0], p1, 0, 0, 0); }
}
__device__ __forceinline__ void pack_p(const f32x16& p0, const f32x16& p1, h8& pa0, h8& pa1, h8& pa2, h8& pa3) {
#define AT_PK4(P, BASE, OUT) do { unsigned a0 = cvtpk(P[BASE + 0], P[BASE + 1]), a1 = cvtpk(P[BASE + 2], P[BASE + 3]); \
    unsigned b0 = cvtpk(P[BASE + 4], P[BASE + 5]), b1 = cvtpk(P[BASE + 6], P[BASE + 7]); \
    auto r0 = __builtin_amdgcn_permlane32_swap(a0, b0, false, false); auto r1 = __builtin_amdgcn_permlane32_swap(a1, b1, false, false); \
    u32x4 w = {r0[0], r1[0], r0[1], r1[1]}; OUT = *reinterpret_cast<h8*>(&w); } while (0)
    AT_PK4(p0, 0, pa0); AT_PK4(p0, 8, pa1); AT_PK4(p1, 0, pa2); AT_PK4(p1, 8, pa3);
#undef AT_PK4
}
__device__ __forceinline__ float half_swap_max(float v) { auto rr = __builtin_amdgcn_permlane32_swap(__float_as_uint(v), __float_as_uint(v), false, false); return fmaxf(__uint_as_float(rr[0]), __uint_as_float(rr[1])); }
__device__ __forceinline__ float half_swap_sum(float v) { auto rr = __builtin_amdgcn_permlane32_swap(__float_as_uint(v), __float_as_uint(v), false, false); return __uint_as_float(rr[0]) + __uint_as_float(rr[1]); }

struct Stage4 { h8 vs0, vs1, ks0, ks1; };
__device__ __forceinline__ int hidden_tid() { int tz = threadIdx.x; asm volatile("" : "+v"(tz)); return tz; }
__device__ __forceinline__ void sload(Stage4& s, const _Float16* Kb, const _Float16* Vb, int ld, int k0) {
    const int tz = hidden_tid(), sr = tz >> 4, sc = (tz & 15) * 8;
    s.vs0 = *(const h8*)(Vb + (size_t)(k0 + sr) * ld + sc); s.vs1 = *(const h8*)(Vb + (size_t)(k0 + 32 + sr) * ld + sc);
    s.ks0 = *(const h8*)(Kb + (size_t)(k0 + sr) * ld + sc); s.ks1 = *(const h8*)(Kb + (size_t)(k0 + 32 + sr) * ld + sc);
}
__device__ __forceinline__ void swrite(const Stage4& s, char* V_lds, char* K_lds, int b) {
    const int tz = hidden_tid(), sr = tz >> 4, sc = (tz & 15) * 8, vst0 = v_st(sr, sc), vst1 = v_st(32 + sr, sc);
    *(h8*)(V_lds + b * SHM_V + vst0) = s.vs0; *(h8*)(V_lds + b * SHM_V + vst1) = s.vs1;
    const int kc = sc * 2;
    *(h8*)(K_lds + b * SHM_K + AT_KSWZ(sr, kc)) = s.ks0; *(h8*)(K_lds + b * SHM_K + AT_KSWZ(32 + sr, kc)) = s.ks1;
}

__device__ __forceinline__ void attn_unit(char* lds, const _Float16* qrow, const _Float16* Kb, const _Float16* Vb, int ld, unsigned tmask, int wlen, int khi, unsigned selmask,
                                          _Float16* outw, int ostride) {
    const int tid = threadIdx.x, wid = __builtin_amdgcn_readfirstlane(tid >> 6), lane = tid & 63, r32 = lane & 31, hi = lane >> 5;
    char* V_lds = lds; char* K_lds = lds + 2 * SHM_V;
    float* wsf = (float*)(lds + LDS_WS) + wid * 64; float* li_l = wsf; float* al_l = wsf + 32;
    float m_reg = -1e30f, l_reg = 0.f; f32x16 o[4] = {}; h8 qr[8];
#pragma unroll
    for (int d0 = 0; d0 < 8; ++d0) qr[d0] = *(const h8*)(qrow + d0 * 16);
    const int vb0 = (int)(uintptr_t)V_lds + v_rd_base(lane);
    Stage4 st;
    unsigned rest = tmask; int j = __ffs(rest) - 1; rest &= rest - 1;
    sload(st, Kb, Vb, ld, j * 64); asm volatile("s_waitcnt vmcnt(0)" ::: "memory"); swrite(st, V_lds, K_lds, 0); __syncthreads();
    int buf = 0;
    for (;;) {
        const int jn = rest ? (__ffs(rest) - 1) : -1;
        if (jn >= 0) sload(st, Kb, Vb, ld, jn * 64);
        f32x16 p0, p1;
        AT_SBAR(); qkt(p0, p1, K_lds + buf * SHM_K, qr, r32, hi);
        { const int klo = wlen > 0 ? khi - wlen + 1 : 0; const bool tb = (selmask >> j) & 1u; const bool inr = (j * 64 >= klo) && (j * 64 + 63 <= khi);
          if (!__all(tb && inr)) {
              if (__all(inr)) {
#pragma unroll
                  for (int r = 0; r < 16; ++r) { p0[r] = tb ? p0[r] : -INFINITY; p1[r] = tb ? p1[r] : -INFINITY; }
              } else {
                  const int kb = j * 64 + 4 * hi;
#pragma unroll
                  for (int r = 0; r < 16; ++r) { const int k0 = kb + (r & 3) + 8 * (r >> 2);
                      p0[r] = (tb && k0 >= klo && k0 <= khi) ? p0[r] : -INFINITY;
                      p1[r] = (tb && (k0 + 32) >= klo && (k0 + 32) <= khi) ? p1[r] : -INFINITY; }
              } } }
        float pmax = p0[0];
#pragma unroll
        for (int r = 1; r < 16; ++r) pmax = fmaxf(pmax, p0[r]);
#pragma unroll
        for (int r = 0; r < 16; ++r) pmax = fmaxf(pmax, p1[r]);
        pmax = half_swap_max(pmax);
        float mn, alpha;
        if (__all(pmax - m_reg <= THR_RAW)) { mn = m_reg; alpha = 1.f; }
        else { mn = fmaxf(m_reg, pmax); alpha = __builtin_amdgcn_exp2f((m_reg - mn) * CEXP); m_reg = mn; }
        const float mnC = -mn * CEXP;
        float ps = 0.f;
#pragma unroll
        for (int r = 0; r < 16; ++r) { p0[r] = __builtin_amdgcn_exp2f(fmaf(p0[r], CEXP, mnC)); ps += p0[r]; }
#pragma unroll
        for (int r = 0; r < 16; ++r) { p1[r] = __builtin_amdgcn_exp2f(fmaf(p1[r], CEXP, mnC)); ps += p1[r]; }
        ps = half_swap_sum(ps);
        l_reg = l_reg * alpha + ps;
        if (__any(alpha < 1.f)) { if (hi == 0) al_l[r32] = alpha; asm volatile("s_waitcnt lgkmcnt(0)" ::: "memory");
#pragma unroll
            for (int r = 0; r < 16; ++r) { const float a = al_l[crow(r, hi)];
#pragma unroll
                for (int d = 0; d < 4; ++d) o[d][r] *= a; } }
        h8 pa0, pa1, pa2, pa3; pack_p(p0, p1, pa0, pa1, pa2, pa3);
        AT_SBAR();
        pv_d0(o, vb0 + buf * SHM_V, pa0, pa1, pa2, pa3);
        if (jn < 0) break;
        asm volatile("s_waitcnt vmcnt(0)" ::: "memory");
        swrite(st, V_lds, K_lds, buf ^ 1);
        __syncthreads();
        buf ^= 1; j = jn; rest &= rest - 1;
    }
    if (hi == 0) li_l[r32] = l_reg; asm volatile("s_waitcnt lgkmcnt(0)" ::: "memory");
#pragma unroll
    for (int r = 0; r < 16; ++r) { const int orow = crow(r, hi); const float l = li_l[orow]; const float rl = l > 0.f ? 1.f / l : 0.f;
#pragma unroll
        for (int d0 = 0; d0 < 4; ++d0) outw[(size_t)orow * ostride + d0 * 32 + r32] = (_Float16)(o[d0][r] * rl); }
    __syncthreads();
}

constexpr int LDS_AP = LDS_END, LDS_BP = LDS_AP + 4 * 64 * 33 * 4, LDS_SELM = LDS_BP + 4 * 64 * 33 * 4, LDS_CS_END = LDS_SELM + 64 * 4;
__device__ __forceinline__ void cmp_slc_unit(char* lds, const _Float16* qrow, const _Float16* Kc, const _Float16* Vc, const _Float16* Ks, const _Float16* Vs, int t, int tl, int g, int qi,
                                             _Float16* outc, _Float16* outs) {
    const int tid = threadIdx.x, wid = __builtin_amdgcn_readfirstlane(tid >> 6), lane = tid & 63, r32 = lane & 31, hi = lane >> 5;
    char* V_lds = lds; char* K_lds = lds + 2 * SHM_V;
    float* AP = (float*)(lds + LDS_AP); float* BP = (float*)(lds + LDS_BP); unsigned* selm = (unsigned*)(lds + LDS_SELM);
    {
        h8 qr[8];
#pragma unroll
        for (int d0 = 0; d0 < 8; ++d0) qr[d0] = *(const h8*)(qrow + d0 * 16);
        const int vb0 = (int)(uintptr_t)V_lds + v_rd_base(lane);
        { Stage4 s0, s1; sload(s0, Kc, Vc, 256, 0); sload(s1, Kc, Vc, 256, 64);
          asm volatile("s_waitcnt vmcnt(0)" ::: "memory");
          swrite(s0, V_lds, K_lds, 0); swrite(s1, V_lds, K_lds, 1); }
        __syncthreads();
        f32x16 pA0, pA1, pB0, pB1;
        AT_SBAR(); qkt(pA0, pA1, K_lds, qr, r32, hi); qkt(pB0, pB1, K_lds + SHM_K, qr, r32, hi);
        const int khi = t >= 31 ? ((t - 31) >> 4) : -1;
#pragma unroll
        for (int r = 0; r < 16; ++r) { const int c0 = 4 * hi + (r & 3) + 8 * (r >> 2);
            pA0[r] = (c0 <= khi) ? pA0[r] : -INFINITY; pA1[r] = (c0 + 32 <= khi) ? pA1[r] : -INFINITY;
            pB0[r] = (c0 + 64 <= khi) ? pB0[r] : -INFINITY; pB1[r] = (c0 + 96 <= khi) ? pB1[r] : -INFINITY; }
        float pmax = -INFINITY;
#pragma unroll
        for (int r = 0; r < 16; ++r) pmax = fmaxf(fmaxf(pmax, pA0[r]), fmaxf(pA1[r], fmaxf(pB0[r], pB1[r])));
        pmax = half_swap_max(pmax);
        const float mC = (pmax == -INFINITY) ? 0.f : -pmax * CEXP;
        float ps = 0.f;
#pragma unroll
        for (int r = 0; r < 16; ++r) { pA0[r] = __builtin_amdgcn_exp2f(fmaf(pA0[r], CEXP, mC)); pA1[r] = __builtin_amdgcn_exp2f(fmaf(pA1[r], CEXP, mC));
            pB0[r] = __builtin_amdgcn_exp2f(fmaf(pB0[r], CEXP, mC)); pB1[r] = __builtin_amdgcn_exp2f(fmaf(pB1[r], CEXP, mC)); ps += (pA0[r] + pA1[r]) + (pB0[r] + pB1[r]); }
        ps = half_swap_sum(ps);
        const float inv = ps > 0.f ? 1.f / ps : 0.f;
#pragma unroll
        for (int r = 0; r < 16; ++r) { pA0[r] *= inv; pA1[r] *= inv; pB0[r] *= inv; pB1[r] *= inv; }
        { float* ap = AP + (g * 64 + tl) * 33; float* bp = BP + (g * 64 + tl) * 33;
          if (hi == 0) bp[0] = 0.f;
#define AT_IMP(P, JB) do { _Pragma("unroll") for (int k = 0; k < 4; ++k) { const int j = (JB) + 2 * k + hi; \
              ap[j] = 2.f * (P[4 * k] + P[4 * k + 1] + P[4 * k + 2]) + P[4 * k + 3]; if (j + 1 < 32) bp[j + 1] = P[4 * k + 3]; } } while (0)
          AT_IMP(pA0, 0); AT_IMP(pA1, 8); AT_IMP(pB0, 16); AT_IMP(pB1, 24);
#undef AT_IMP
        }
        f32x16 o[4] = {};
        h8 pa0, pa1, pa2, pa3;
        pack_p(pA0, pA1, pa0, pa1, pa2, pa3); AT_SBAR(); pv_d0(o, vb0, pa0, pa1, pa2, pa3);
        pack_p(pB0, pB1, pa0, pa1, pa2, pa3); AT_SBAR(); pv_d0(o, vb0 + SHM_V, pa0, pa1, pa2, pa3);
#pragma unroll
        for (int r = 0; r < 16; ++r) { const int orow = crow(r, hi);
#pragma unroll
            for (int d0 = 0; d0 < 4; ++d0) outc[(size_t)orow * 1024 + d0 * 32 + r32] = (_Float16)o[d0][r]; }
    }
    __syncthreads();
#pragma unroll 1
    for (int it = 0; it < 4; ++it) {
        const int tk = 8 * wid + 2 * it + hi, j = r32;
        float imp = 0.f;
#pragma unroll
        for (int gg = 0; gg < 4; ++gg) imp += AP[(gg * 64 + tk) * 33 + j] + BP[(gg * 64 + tk) * 33 + j];
        const bool forced = (j == 0) || (j == qi) || (j == qi - 1), valid = j <= qi;
        const float iv = forced ? 1e9f : (valid ? imp : -1e9f);
        int rank = 0;
        for (int i = 0; i < 32; ++i) { const float vi = __shfl(iv, i + 32 * hi); rank += (vi > iv || (vi == iv && i < j)) ? 1 : 0; }
        const unsigned long long bal = __ballot(rank < 16 && valid);
        if (r32 == 0) selm[tk] = (unsigned)(bal >> (32 * hi));
    }
    __syncthreads();
    unsigned tm = selm[lane];
#pragma unroll
    for (int o = 32; o > 0; o >>= 1) tm |= __shfl_xor(tm, o);
    const int tz2 = hidden_tid();
    const unsigned mysel = selm[((tz2 >> 6) & 1) * 32 + (tz2 & 31)];
    attn_unit(lds, qrow, Ks, Vs, 128, tm, 0, t, mysel, outs, 1024);
}
}

struct CUnit { const float* W; int ldw; int nvalid; _Float16* Wt; int k0; int n0; };
__device__ __forceinline__ CUnit conv_desc(int u, const float* win, const float* w1k, const float* w1v, const float* wmkv, _Float16* wtin, _Float16* wt1, _Float16* wtmkv) {
    CUnit d;
    if (u < 480) { d.W = win; d.ldw = INW; d.nvalid = INW; d.Wt = wtin; d.k0 = (u / 15) * 64; d.n0 = (u % 15) * 256; }
    else if (u < 608) { const int v = u - 480, kv = v >> 6, part = (v >> 5) & 1, kt = v & 31;
        d.W = (kv ? w1v : w1k) + (size_t)part * 2048 * 256; d.ldw = 256; d.nvalid = 256; d.Wt = wt1 + ((size_t)kv * 512 + part * 256) * 2048; d.k0 = kt * 64; d.n0 = 0; }
    else { const int v = u - 608; d.W = wmkv; d.ldw = 1024; d.nvalid = 1024; d.Wt = wtmkv; d.k0 = (v >> 2) * 64; d.n0 = (v & 3) * 256; }
    return d;
}
__device__ __forceinline__ void conv_all(float* lds, const float* win, const float* w1k, const float* w1v, const float* wmkv, _Float16* wtin, _Float16* wt1, _Float16* wtmkv, int bid, int nb) {
    constexpr int NU = 480 + 128 + 128;
    const int tid = threadIdx.x;
    int u = bid; if (u >= NU) return;
    CUnit d = conv_desc(u, win, w1k, w1v, wmkv, wtin, wt1, wtmkv);
    float4 v[8];
#define CL(D) do { _Pragma("unroll") for (int i = 0; i < 8; ++i) { const int idx = tid + 512 * i, r = idx >> 6, c4 = (idx & 63) * 4; \
        v[i] = ((D).n0 + c4 < (D).nvalid) ? *(const float4*)((D).W + (size_t)((D).k0 + r) * (D).ldw + (D).n0 + c4) : make_float4(0.f, 0.f, 0.f, 0.f); } } while (0)
    CL(d);
    for (;;) {
#pragma unroll
        for (int i = 0; i < 8; ++i) { const int idx = tid + 512 * i, r = idx >> 6, c4 = (idx & 63) * 4; float* dd = lds + r * 257 + c4; dd[0] = v[i].x; dd[1] = v[i].y; dd[2] = v[i].z; dd[3] = v[i].w; }
        __syncthreads();
        const int un = u + nb; const bool has = un < NU;
        CUnit dn = d; if (has) { dn = conv_desc(un, win, w1k, w1v, wmkv, wtin, wt1, wtmkv); CL(dn); }
#pragma unroll
        for (int j = 0; j < 4; ++j) { const int id = tid + 512 * j, n = id >> 3, k8 = (id & 7) * 8; h8 o;
#pragma unroll
            for (int q = 0; q < 8; ++q) o[q] = (_Float16)lds[(k8 + q) * 257 + n];
            *(h8*)(d.Wt + (size_t)(d.n0 + n) * 2048 + d.k0 + k8) = o; }
        __syncthreads();
        if (!has) break;
        u = un; d = dn;
    }
#undef CL
}

__device__ __forceinline__ unsigned pack4_i8(float a, float b, float c, float d) {
    const int ia = __float2int_rn(a), ib = __float2int_rn(b), ic = __float2int_rn(c), id = __float2int_rn(d);
    return (unsigned)(ia & 255) | ((unsigned)(ib & 255) << 8) | ((unsigned)(ic & 255) << 16) | ((unsigned)(id & 255) << 24);
}
constexpr int QP_LD2 = 1026;
struct QUnit { const float* W; int ldw; int n0; signed char* Q; float* sc; };
__device__ __forceinline__ QUnit quant_desc(int u, const float* wgu, const float* wdn, signed char* q8gu, signed char* q8dn, float* sgu, float* sdn, const float* wout, signed char* q8out, float* sout) {
    QUnit d;
    if (u >= NE * 192) { const int pn = u - NE * 192; d.W = wout; d.ldw = 2048; d.n0 = pn * 32; d.Q = q8out; d.sc = sout; }
    else if (u < NE * 128) { const int e = u >> 7, pn = u & 127; d.W = wgu + (size_t)e * 2048 * 4096; d.ldw = 4096; d.n0 = pn * 32; d.Q = q8gu + (size_t)e * 4096 * 2048; d.sc = sgu + (size_t)e * 4096; }
    else { const int v = u - NE * 128, e = v >> 6, pn = v & 63; d.W = wdn + (size_t)e * 2048 * 2048; d.ldw = 2048; d.n0 = pn * 32; d.Q = q8dn + (size_t)e * 2048 * 2048; d.sc = sdn + (size_t)e * 2048; }
    return d;
}
__device__ __forceinline__ unsigned pk2h(float a, float b) { auto v = __builtin_amdgcn_cvt_pkrtz(a, b); return *reinterpret_cast<unsigned*>(&v); }
__device__ __forceinline__ void quant_all(char* smem, const float* wgu, const float* wdn, signed char* q8gu, signed char* q8dn, float* sgu, float* sdn, const float* wout, signed char* q8out, float* sout, int bid, int nb) {
    constexpr int NU = NE * 128 + NE * 64 + 64;
    unsigned* cmaxb = (unsigned*)smem;
    const int tid = threadIdx.x, c4 = (tid & 7) * 4, rg = tid >> 3;
    if (tid < 64) cmaxb[tid] = 0u;
    __syncthreads();
    int u = bid; if (u >= NU) return;
    QUnit d = quant_desc(u, wgu, wdn, q8gu, q8dn, sgu, sdn, wout, q8out, sout);
    float4 va[16], vb[16], vc[16];
#define QL(dst, D, half) do { const float* p0 = (D).W + (size_t)((half) * 1024 + rg * 16) * (D).ldw + (D).n0 + c4; _Pragma("unroll") for (int j = 0; j < 16; ++j) dst[j] = *(const float4*)(p0 + (size_t)j * (D).ldw); } while (0)
#define QM(src) do { _Pragma("unroll") for (int j = 0; j < 16; ++j) { m0 = fmaxf(m0, fabsf(src[j].x)); m1 = fmaxf(m1, fabsf(src[j].y)); m2 = fmaxf(m2, fabsf(src[j].z)); m3 = fmaxf(m3, fabsf(src[j].w)); } } while (0)
#define QS(src, half, comp, ci, inv) do { uint4 o; \
        o.x = pack4_i8(src[0].comp * inv, src[1].comp * inv, src[2].comp * inv, src[3].comp * inv); o.y = pack4_i8(src[4].comp * inv, src[5].comp * inv, src[6].comp * inv, src[7].comp * inv); \
        o.z = pack4_i8(src[8].comp * inv, src[9].comp * inv, src[10].comp * inv, src[11].comp * inv); o.w = pack4_i8(src[12].comp * inv, src[13].comp * inv, src[14].comp * inv, src[15].comp * inv); \
        *(uint4*)(d.Q + (size_t)(d.n0 + c4 + (ci)) * 2048 + (half) * 1024 + rg * 16) = o; } while (0)
    QL(va, d, 0);
    int par = 0;
    for (;;) {
        unsigned* cmax = cmaxb + par * 32;
        float m0 = 0.f, m1 = 0.f, m2 = 0.f, m3 = 0.f;
        QL(vb, d, 1);
        QM(va); QM(vb);
        atomicMax(&cmax[c4 + 0], __float_as_uint(m0)); atomicMax(&cmax[c4 + 1], __float_as_uint(m1)); atomicMax(&cmax[c4 + 2], __float_as_uint(m2)); atomicMax(&cmax[c4 + 3], __float_as_uint(m3));
        __syncthreads();
        const int un = u + nb; const bool has = un < NU;
        QUnit dn = d; if (has) { dn = quant_desc(un, wgu, wdn, q8gu, q8dn, sgu, sdn, wout, q8out, sout); QL(vc, dn, 0); }
        if (tid < 32) cmaxb[(par ^ 1) * 32 + tid] = 0u;
        const float x0 = __uint_as_float(cmax[c4 + 0]), x1 = __uint_as_float(cmax[c4 + 1]), x2 = __uint_as_float(cmax[c4 + 2]), x3 = __uint_as_float(cmax[c4 + 3]);
        const float i0 = x0 > 0.f ? 127.f / x0 : 0.f, i1 = x1 > 0.f ? 127.f / x1 : 0.f, i2 = x2 > 0.f ? 127.f / x2 : 0.f, i3 = x3 > 0.f ? 127.f / x3 : 0.f;
        QS(va, 0, x, 0, i0); QS(va, 0, y, 1, i1); QS(va, 0, z, 2, i2); QS(va, 0, w, 3, i3);
        QS(vb, 1, x, 0, i0); QS(vb, 1, y, 1, i1); QS(vb, 1, z, 2, i2); QS(vb, 1, w, 3, i3);
        if (tid < 32) { const float mx = __uint_as_float(cmax[tid]); d.sc[d.n0 + tid] = mx > 0.f ? mx / 127.f : 1.f; }
        if (!has) break;
#pragma unroll
        for (int j = 0; j < 16; ++j) va[j] = vc[j];
        u = un; d = dn; par ^= 1;
        __syncthreads();
    }
    __syncthreads();
#undef QL
#undef QM
#undef QS
}

__global__ void __launch_bounds__(512, 2) fwd(Params p) {
    extern __shared__ __attribute__((aligned(16))) char smem[];
    const int tid = threadIdx.x, wv = __builtin_amdgcn_readfirstlane(tid >> 6);
#define LANE_NOW ({ int _t = threadIdx.x; asm volatile("" : "+v"(_t)); _t & 63; })
    const int bid = blockIdx.x, nb = gridDim.x;
    const int gw = bid * 8 + wv, nw = nb * 8;
    const int lo = (int)(p.lo_hi & 0xffffffffll), hi = (int)(p.lo_hi >> 32);
    unsigned char* ws = p.ws;
    unsigned* ctl = (unsigned*)(ws + WS_CTL);
    int* cnt = (int*)(ws + CTL_CNT);
    float* proj = (float*)(ws + WS_PROJ);
    float* kvmem = (float*)(ws + WS_KVMEM);
    float* bias1 = (float*)(ws + WS_BIAS1);
    float* hid = (float*)(ws + WS_HID);
    float* kc = (float*)(ws + WS_KC);
    float* vc = (float*)(ws + WS_VC);
    float* pooled = (float*)(ws + WS_POOLED);
    _Float16* opool = (_Float16*)(ws + WS_OPOOL);
    _Float16* owin = (_Float16*)(ws + WS_OWIN);
    _Float16* ocmp = (_Float16*)(ws + WS_OCMP);
    _Float16* oslc = (_Float16*)(ws + WS_OSLC);
    unsigned* sel = (unsigned*)(ws + WS_SEL);
    _Float16* omem = (_Float16*)(ws + WS_OMEM);
    _Float16* cat16 = (_Float16*)(ws + WS_CAT16);
    _Float16* hpre16 = (_Float16*)(ws + WS_HPRE);
    float* hbuf = (float*)(ws + WS_H);
    float* gate = (float*)(ws + WS_GATE);
    int* list = (int*)(ws + WS_LIST);
    unsigned char* actf8 = (unsigned char*)(ws + WS_ACT16);
    unsigned char* yf8 = (unsigned char*)(ws + WS_Y16);
    _Float16* h16 = (_Float16*)(ws + WS_H16);
    _Float16* x16 = (_Float16*)(ws + WS_X16);
    _Float16* wtin = (_Float16*)(ws + WS_WTIN);
    _Float16* wtout = (_Float16*)(ws + WS_WTOUT);
    _Float16* wtgu = (_Float16*)(ws + WS_WTGU);
    _Float16* wtdn = (_Float16*)(ws + WS_WTDN);
    LAS unsigned char* lds = (LAS unsigned char*)smem;
    _Float16* proj16 = (_Float16*)(ws + WS_PROJ16);
    _Float16* kvmem16 = (_Float16*)(ws + WS_KVMEM16);
    _Float16* wt1 = (_Float16*)(ws + WS_WT1);
    float* uv = (float*)(ws + WS_UV);
    _Float16* kc16 = (_Float16*)(ws + WS_KC16);
    _Float16* vc16 = (_Float16*)(ws + WS_VC16);
    _Float16* wr16 = (_Float16*)(ws + WS_WR16);
    _Float16* mem16 = (_Float16*)(ws + WS_MEM16);
    _Float16* wtmkv = (_Float16*)(ws + WS_WTMKV);
    _Float16* kv16 = (_Float16*)(ws + WS_KV16);
    _Float16* wt2 = (_Float16*)(ws + WS_WT2);
    signed char* q8out = (signed char*)(ws + WS_Q8OUT); float* sout = (float*)(ws + WS_SOUT); signed char* cat8 = (signed char*)(ws + WS_CAT8); float* scat = (float*)(ws + WS_SCAT);
    signed char* q8gu = (signed char*)(ws + WS_Q8GU); signed char* q8dn = (signed char*)(ws + WS_Q8DN);
    float* sgu = (float*)(ws + WS_SGU); float* sdn = (float*)(ws + WS_SDN);
    signed char* h8q = (signed char*)(ws + WS_H8); float* sah = (float*)(ws + WS_SAH);
    signed char* act8 = (signed char*)(ws + WS_ACT8); float* sact = (float*)(ws + WS_SACT);
    const int vcu = (nb % 8 == 0) ? (bid % 8) * (nb / 8) + bid / 8 : bid;

    volatile LAS unsigned* xbw = (volatile LAS unsigned*)(smem + LDS_BYTES - 16);
    if (tid == 0) { xbw[0] = 0u; xbw[1] = 0u; xbw[2] = 0u; xbw[3] = 0u; }
    __syncthreads();
    XcdBarrier bar; bar.bar = ctl; bar.x = 0; bar.st = xbw;
    const bool multi = (hi - lo) > 1;
    if (multi) bar = xcd_barrier_post(ctl, xbw);
#define IN(k) (lo <= (k) && (k) < hi)
#define SEAM(k) do { if (IN(k) && IN((k) + 1)) xcd_barrier(bar); } while (0)
    float* sw = (float*)smem + wv * WLDS_FLOATS;
    int* segw = (int*)(sw + 4096 + 512);

    if (IN(0)) {
        const int lane = LANE_NOW; (void)lane;
        if (wv == 0 && (bid & 1) == 0 && (bid >> 1) < 128) {
            const int task = bid >> 1, kv = task >> 6, jg = (task >> 4) & 3, kc = task & 15;
            const float* pos = p.in[kv ? I_POSV : I_POSK] + kc * 256; const float* w1 = p.in[kv ? I_W1V : I_W1K] + (size_t)kc * 256 * 256 + jg * 64 + lane;
            float s0 = 0.f, s1 = 0.f, s2 = 0.f, s3 = 0.f;
            for (int k = 0; k < 256; k += 4) { s0 += pos[k] * w1[(size_t)k * 256]; s1 += pos[k + 1] * w1[(size_t)(k + 1) * 256]; s2 += pos[k + 2] * w1[(size_t)(k + 2) * 256]; s3 += pos[k + 3] * w1[(size_t)(k + 3) * 256]; }
            bias1[(kv * 16 + kc) * 256 + jg * 64 + lane] = (s0 + s1) + (s2 + s3);
        }
        for (int i = bid * 512 + tid; i < 2 * 128 * 256; i += nb * 512) { const int kv = i >> 15, d = (i >> 8) & 127, n = i & 255; wt2[i] = (_Float16)p.in[kv ? I_W2V : I_W2K][(size_t)n * 128 + d]; }
        for (int i = bid * 512 + tid; i < 32 * 2048; i += nb * 512) { const int e = i >> 11, d = i & 2047; wr16[i] = (_Float16)p.in[I_WR][(size_t)d * 32 + e]; }
        for (size_t i = (size_t)bid * 512 + tid; i < (size_t)T_ * 2048 / 4; i += (size_t)nb * 512) {
            const float4 v = ((const float4*)p.in[I_X])[i]; ((h4*)x16)[i] = (h4){(_Float16)v.x, (_Float16)v.y, (_Float16)v.z, (_Float16)v.w};
        }
        {
            quant_all(smem, p.in[I_WGU], p.in[I_WDN], q8gu, q8dn, sgu, sdn, p.in[I_WOUT], q8out, sout, bid, nb);
            __syncthreads();
            conv_all((float*)smem, p.in[I_WIN], p.in[I_W1K], p.in[I_W1V], p.in[I_WMEMKV], wtin, wt1, wtmkv, bid, nb);
            __syncthreads();
        }
        for (size_t i = (size_t)bid * 512 + tid; i < (size_t)2048 * 2048 / 4; i += (size_t)nb * 512) {
            const float4 v = ((const float4*)p.in[I_MEM])[i]; ((h4*)mem16)[i] = (h4){(_Float16)v.x, (_Float16)v.y, (_Float16)v.z, (_Float16)v.w};
        }
    }
    SEAM(0);
    if (IN(1)) {
        const int lane = LANE_NOW; (void)lane;
        g8::ProbIn P{x16, proj16, nb, bid};
        g8::gemm_phase(lds, P);
    }
    SEAM(1);
    if (IN(2)) {
        const int lane = LANE_NOW; (void)lane;
        { g8::ProbCmp P{kv16, wt1, uv, nb, bid}; g8::gemm_phase(lds, P); __syncthreads(); }
        for (int i = bid * 512 + tid; i < T_ * 64; i += nb * 512) {
            const int chn = i & 63, row = i >> 6, t = row & (S_ - 1), g = chn >> 4;
            const int win = 2 << g, n = min(win, t + 1);
            const _Float16* src = proj16 + (size_t)row * INW + C_UP + chn * 8;
            float a[8];
            const h8 cur = *(const h8*)src;
#pragma unroll
            for (int q = 0; q < 8; ++q) a[q] = (float)cur[q];
            for (int k = 1; k < n; ++k) { const h8 v = *(const h8*)(src - (size_t)k * INW);
#pragma unroll
                for (int q = 0; q < 8; ++q) a[q] += (float)v[q]; }
            const float rn = 1.f / (float)n;
            float4 o0, o1;
            o0.x = a[0] * rn - (float)cur[0]; o0.y = a[1] * rn - (float)cur[1]; o0.z = a[2] * rn - (float)cur[2]; o0.w = a[3] * rn - (float)cur[3];
            o1.x = a[4] * rn - (float)cur[4]; o1.y = a[5] * rn - (float)cur[5]; o1.z = a[6] * rn - (float)cur[6]; o1.w = a[7] * rn - (float)cur[7];
            *(float4*)(pooled + (size_t)row * 512 + chn * 8) = o0; *(float4*)(pooled + (size_t)row * 512 + chn * 8 + 4) = o1;
        }
        {
            const int r32 = lane & 31, hi = lane >> 5, g = wv >> 1, half = wv & 1;
            for (int uu = vcu; uu < 512; uu += nb) {
                const int v = uu & 255, bk = v >> 4, qi = (uu >> 8) ? 31 - (v & 15) : (v & 15), b = bk >> 1, kvh = bk & 1;
                const int t = qi * 64 + half * 32 + r32;
                const int lo_t = max(0, qi - 8);
                const unsigned tmask = (unsigned)(((1ull << (qi + 1)) - 1ull) & ~((1ull << lo_t) - 1ull));
                at8::attn_unit(smem, proj16 + (size_t)(b * S_ + t) * INW + C_Q + (kvh * 4 + g) * 128 + hi * 8,
                               kv16 + ((size_t)(4 * B_ + b) * 2 + kvh) * KVSEG, kv16 + ((size_t)(5 * B_ + b) * 2 + kvh) * KVSEG, 128, tmask, 512, t, 0xffffffffu,
                               owin + (size_t)(b * S_ + qi * 64 + half * 32) * 1024 + (kvh * 4 + g) * 128, 1024);
            }
            for (int u = vcu; u < 256; u += nb) {
                const int b = u >> 5, h = (u >> 3) & 3, qt = u & 7;
                const int t = qt * 256 + wv * 32 + r32;
                at8::attn_unit(smem, proj16 + (size_t)(b * S_ + t) * INW + C_QM + h * 128 + hi * 8,
                               kvmem16 + (size_t)b * 256 * 1024 + h * 128, kvmem16 + (size_t)b * 256 * 1024 + 512 + h * 128, 1024, 0xFu, 0, 255, 0xffffffffu,
                               omem + (size_t)(b * S_ + qt * 256 + wv * 32) * 512 + h * 128, 512);
            }
        }
    }
    SEAM(2);
    if (IN(3)) {
        const int lane = LANE_NOW; (void)lane;
        {
            float* bsum = (float*)smem;
            _Float16* hs = (_Float16*)(smem + 4096);
            { const int kv = tid >> 8, n = tid & 255; float a = 0.f;
#pragma unroll
              for (int kc = 0; kc < 16; ++kc) a += bias1[(kv * 16 + kc) * 256 + n];
              bsum[tid] = a; }
            __syncthreads();
            const int fr = lane & 15, fq = lane >> 4;
            for (int u = bid; u < 256; u += nb) {
                const int kv = u >> 7, rt = u & 127;
#pragma unroll
                for (int q = 0; q < 8; ++q) { const int e = tid + 512 * q, i = e >> 8, n = e & 255;
                    const int row = rt * 16 + i, c = (row >> 1) & 127;
                    float a = 0.f;
                    if (c != 127) { a = bsum[kv * 256 + n];
#pragma unroll
                        for (int sp = 0; sp < 4; ++sp) { const float* base = uv + ((size_t)(kv * 4 + sp) * 2048) * 512; a += base[(size_t)row * 512 + n] + base[(size_t)(row + 2) * 512 + 256 + n]; }
                        a = gelu_fast(a); }
                    hs[i * 264 + n] = (_Float16)a; }
                __syncthreads();
                { const _Float16* bp = wt2 + ((size_t)kv * 128 + wv * 16 + fr) * 256 + fq * 8;
                  f4 acc = (f4){0.f, 0.f, 0.f, 0.f};
#pragma unroll
                  for (int sI = 0; sI < 8; ++sI) { const h8 a = *(const h8*)(hs + fr * 264 + sI * 32 + fq * 8), bb = *(const h8*)(bp + sI * 32); acc = __builtin_amdgcn_mfma_f32_16x16x32_f16(a, bb, acc, 0, 0, 0); }
                  _Float16* dst = kv ? vc16 : kc16;
#pragma unroll
                  for (int j = 0; j < 4; ++j) { const int row = rt * 16 + fq * 4 + j; dst[(size_t)row * 128 + wv * 16 + fr] = (((row >> 1) & 127) == 127) ? (_Float16)0.f : (_Float16)acc[j]; } }
                __syncthreads();
            }
        }
        for (int u = bid; u < 128 * 4; u += nb) { const int g = u >> 7, mt = u & 127;
            ARowPlain af{pooled + g * 128, 512, mt * 128, T_}; EpiPool ef{opool, p.in[I_POOLS], mt * 128, g};
            gemm_tile(smem, 128, af, p.in[I_POOLW] + (size_t)g * 128 * 128, 128, 0, 128, false, ef);
        }
    }
    SEAM(3);
    if (IN(4)) {
        const int lane = LANE_NOW; (void)lane;
        const int r32 = lane & 31, hi = lane >> 5, g = wv >> 1, half = wv & 1;
        for (int uu = vcu; uu < 512; uu += nb) {
            const int v = uu & 255, bk = v >> 4, qi = (uu >> 8) ? 31 - (v & 15) : (v & 15), b = bk >> 1, kvh = bk & 1;
            const int tl = half * 32 + r32, t = qi * 64 + tl;
            at8::cmp_slc_unit(smem, proj16 + (size_t)(b * S_ + t) * INW + C_Q + (kvh * 4 + g) * 128 + hi * 8,
                              kc16 + (size_t)(b * 128 * 2 + kvh) * 128, vc16 + (size_t)(b * 128 * 2 + kvh) * 128,
                              kv16 + ((size_t)(2 * B_ + b) * 2 + kvh) * KVSEG, kv16 + ((size_t)(3 * B_ + b) * 2 + kvh) * KVSEG, t, tl, g, qi,
                              ocmp + (size_t)(b * S_ + qi * 64 + half * 32) * 1024 + (kvh * 4 + g) * 128, oslc + (size_t)(b * S_ + qi * 64 + half * 32) * 1024 + (kvh * 4 + g) * 128);
        }
    }
    SEAM(4);
    if (IN(5)) {
        const int lane = LANE_NOW;
        for (int row = gw; row < T_; row += nw) {
            const _Float16* pr = proj16 + (size_t)row * INW + C_G;
            float v[32]; float ss = 0.f;
#pragma unroll
            for (int c = 0; c < 2; ++c) { const int col = (lane + 64 * c) * 8, h = col >> 7; const size_t o = (size_t)row * 1024 + col;
                const float g0 = sigmoidf_((float)pr[h * 3]), g1 = sigmoidf_((float)pr[h * 3 + 1]), g2 = sigmoidf_((float)pr[h * 3 + 2]);
                const h8 a = *(const h8*)(ocmp + o), b2 = *(const h8*)(oslc + o), c2 = *(const h8*)(owin + o);
#pragma unroll
                for (int q = 0; q < 8; ++q) { const float x = g0 * (float)a[q] + g1 * (float)b2[q] + g2 * (float)c2[q]; v[c * 8 + q] = x; ss += x * x; } }
            ss = wave_sum(ss); float r = rsqrtf(ss / 1024.f + LN_EPS);
#pragma unroll
            for (int c = 0; c < 2; ++c) { const int col = (lane + 64 * c) * 8; const float4 ga = *(const float4*)(p.in[I_GNNSA] + col), gb = *(const float4*)(p.in[I_GNNSA] + col + 4);
                v[c * 8 + 0] *= r * ga.x; v[c * 8 + 1] *= r * ga.y; v[c * 8 + 2] *= r * ga.z; v[c * 8 + 3] *= r * ga.w; v[c * 8 + 4] *= r * gb.x; v[c * 8 + 5] *= r * gb.y; v[c * 8 + 6] *= r * gb.z; v[c * 8 + 7] *= r * gb.w; }
            { const h8 a = *(const h8*)(opool + (size_t)row * 512 + lane * 8); ss = 0.f;
#pragma unroll
              for (int q = 0; q < 8; ++q) { v[16 + q] = (float)a[q]; ss += v[16 + q] * v[16 + q]; }
              ss = wave_sum(ss); r = rsqrtf(ss / 512.f + LN_EPS);
              const float4 ga = *(const float4*)(p.in[I_GNPOOL] + lane * 8), gb = *(const float4*)(p.in[I_GNPOOL] + lane * 8 + 4);
              v[16] *= r * ga.x; v[17] *= r * ga.y; v[18] *= r * ga.z; v[19] *= r * ga.w; v[20] *= r * gb.x; v[21] *= r * gb.y; v[22] *= r * gb.z; v[23] *= r * gb.w; }
            { const h8 a = *(const h8*)(omem + (size_t)row * 512 + lane * 8); ss = 0.f;
#pragma unroll
              for (int q = 0; q < 8; ++q) { v[24 + q] = (float)a[q]; ss += v[24 + q] * v[24 + q]; }
              ss = wave_sum(ss); r = rsqrtf(ss / 512.f + LN_EPS);
              const float4 ga = *(const float4*)(p.in[I_GNMEM] + lane * 8), gb = *(const float4*)(p.in[I_GNMEM] + lane * 8 + 4);
              v[24] *= r * ga.x; v[25] *= r * ga.y; v[26] *= r * ga.z; v[27] *= r * ga.w; v[28] *= r * gb.x; v[29] *= r * gb.y; v[30] *= r * gb.z; v[31] *= r * gb.w; }
            float amax = 0.f;
#pragma unroll
            for (int k = 0; k < 32; ++k) amax = fmaxf(amax, fabsf(v[k]));
            amax = wave_max(amax);
            const float qinv = amax > 0.f ? 127.f / amax : 0.f;
            if (lane == 0) scat[row] = amax > 0.f ? amax / 127.f : 1.f;
#pragma unroll
            for (int c = 0; c < 4; ++c) { const int col = c < 2 ? (lane + 64 * c) * 8 : (c == 2 ? 1024 + lane * 8 : 1536 + lane * 8);
                uint2 q; q.x = pack4_i8(v[c * 8 + 0] * qinv, v[c * 8 + 1] * qinv, v[c * 8 + 2] * qinv, v[c * 8 + 3] * qinv); q.y = pack4_i8(v[c * 8 + 4] * qinv, v[c * 8 + 5] * qinv, v[c * 8 + 6] * qinv, v[c * 8 + 7] * qinv);
                *(uint2*)(cat8 + (size_t)row * 2048 + col) = q; }
        }
    }
    SEAM(5);
    if (IN(6)) {
        const int lane = LANE_NOW; (void)lane;
        g8::ProbOut P{cat8, q8out, hpre16, x16, scat, sout, nb, bid};
        g8::gemm_phase(lds, P);
    }
    SEAM(6);
    if (IN(7)) {
        const int lane = LANE_NOW; (void)lane;
        float* lg = (float*)smem;
        const int r32 = lane & 31, hi = lane >> 5, fr = lane & 15, fq = lane >> 4;
        for (int u = bid; u < T_ / 64; u += nb) {
            const int base = u * 64;
            h8 raw[8][4];
#pragma unroll
            for (int i = 0; i < 8; ++i)
#pragma unroll
                for (int c = 0; c < 4; ++c) raw[i][c] = *(const h8*)(hpre16 + (size_t)(base + wv * 8 + i) * 2048 + (lane + 64 * c) * 8);
#pragma unroll
            for (int i = 0; i < 8; ++i) {
                const int row = base + wv * 8 + i;
                float v[32]; float s = 0.f;
#pragma unroll
                for (int c = 0; c < 4; ++c) {
#pragma unroll
                    for (int q = 0; q < 8; ++q) { v[c * 8 + q] = (float)raw[i][c][q]; s += v[c * 8 + q]; } }
                const float mu = wave_sum(s) / 2048.f; float q2 = 0.f;
#pragma unroll
                for (int k = 0; k < 32; ++k) { const float d = v[k] - mu; q2 += d * d; }
                const float rs = rsqrtf(wave_sum(q2) / 2048.f + LN_EPS);
                float amax = 0.f;
#pragma unroll
                for (int c = 0; c < 4; ++c) { const int col = (lane + 64 * c) * 8;
                    const float4 g0 = *(const float4*)(p.in[I_LN1G] + col), g1 = *(const float4*)(p.in[I_LN1G] + col + 4), b0 = *(const float4*)(p.in[I_LN1B] + col), b1 = *(const float4*)(p.in[I_LN1B] + col + 4);
                    float4 o0, o1;
                    o0.x = (v[c * 8 + 0] - mu) * rs * g0.x + b0.x; o0.y = (v[c * 8 + 1] - mu) * rs * g0.y + b0.y; o0.z = (v[c * 8 + 2] - mu) * rs * g0.z + b0.z; o0.w = (v[c * 8 + 3] - mu) * rs * g0.w + b0.w;
                    o1.x = (v[c * 8 + 4] - mu) * rs * g1.x + b1.x; o1.y = (v[c * 8 + 5] - mu) * rs * g1.y + b1.y; o1.z = (v[c * 8 + 6] - mu) * rs * g1.z + b1.z; o1.w = (v[c * 8 + 7] - mu) * rs * g1.w + b1.w;
                    h8 oh; oh[0] = (_Float16)o0.x; oh[1] = (_Float16)o0.y; oh[2] = (_Float16)o0.z; oh[3] = (_Float16)o0.w; oh[4] = (_Float16)o1.x; oh[5] = (_Float16)o1.y; oh[6] = (_Float16)o1.z; oh[7] = (_Float16)o1.w;
                    *(h8*)(h16 + (size_t)row * 2048 + col) = oh;
                    v[c * 8 + 0] = o0.x; v[c * 8 + 1] = o0.y; v[c * 8 + 2] = o0.z; v[c * 8 + 3] = o0.w; v[c * 8 + 4] = o1.x; v[c * 8 + 5] = o1.y; v[c * 8 + 6] = o1.z; v[c * 8 + 7] = o1.w;
                    amax = fmaxf(amax, fmaxf(fmaxf(fmaxf(fabsf(o0.x), fabsf(o0.y)), fmaxf(fabsf(o0.z), fabsf(o0.w))), fmaxf(fmaxf(fabsf(o1.x), fabsf(o1.y)), fmaxf(fabsf(o1.z), fabsf(o1.w))))); }
                amax = wave_max(amax);
                const float qinv = amax > 0.f ? 127.f / amax : 0.f;
                if (lane == 0) sah[row] = amax > 0.f ? amax / 127.f : 1.f;
#pragma unroll
                for (int c = 0; c < 4; ++c) { const int col = (lane + 64 * c) * 8;
                    uint2 q; q.x = pack4_i8(v[c * 8 + 0] * qinv, v[c * 8 + 1] * qinv, v[c * 8 + 2] * qinv, v[c * 8 + 3] * qinv); q.y = pack4_i8(v[c * 8 + 4] * qinv, v[c * 8 + 5] * qinv, v[c * 8 + 6] * qinv, v[c * 8 + 7] * qinv);
                    *(uint2*)(h8q + (size_t)row * 2048 + col) = q; }
            }
            asm volatile("s_waitcnt vmcnt(0)" ::: "memory");
            __syncthreads();
            {
                const int tok0 = base + 16 * (wv >> 1), e0 = 16 * (wv & 1);
                const _Float16* ap = h16 + (size_t)(tok0 + fr) * 2048 + fq * 8; const _Float16* bp = wr16 + (size_t)(e0 + fr) * 2048 + fq * 8;
                f4 acc = (f4){0.f, 0.f, 0.f, 0.f};
#pragma unroll 8
                for (int sI = 0; sI < 64; ++sI) { const h8 a = *(const h8*)(ap + sI * 32), bb = *(const h8*)(bp + sI * 32); acc = __builtin_amdgcn_mfma_f32_16x16x32_f16(a, bb, acc, 0, 0, 0); }
                const float br = p.in[I_BR][e0 + fr];
#pragma unroll
                for (int j = 0; j < 4; ++j) lg[(16 * (wv >> 1) + 4 * fq + j) * 33 + e0 + fr] = acc[j] + br;
            }
            __syncthreads();
#pragma unroll 1
            for (int it = 0; it < 4; ++it) {
                const int tk = 8 * wv + 2 * it + hi;
                const float iv = lg[tk * 33 + r32];
                int rank = 0;
                for (int i = 0; i < 32; ++i) { const float vi = __shfl(iv, i + 32 * hi); rank += (vi > iv || (vi == iv && i < r32)) ? 1 : 0; }
                float tv[4]; int te[4];
#pragma unroll
                for (int r = 0; r < 4; ++r) { const unsigned long long bm = __ballot(rank == r); const unsigned hm = (unsigned)(bm >> (32 * hi)); const int src = __ffs(hm) - 1; te[r] = src; tv[r] = __shfl(iv, src + 32 * hi); }
                const float e0v = 1.f, e1v = expf(tv[1] - tv[0]), e2v = expf(tv[2] - tv[0]), e3v = expf(tv[3] - tv[0]); const float inv = 1.f / (e0v + e1v + e2v + e3v);
                if (r32 < 4) { const int e = r32 == 0 ? te[0] : r32 == 1 ? te[1] : r32 == 2 ? te[2] : te[3]; const float g = (r32 == 0 ? e0v : r32 == 1 ? e1v : r32 == 2 ? e2v : e3v) * inv;
                    const int a = (base + tk) * 4 + r32; const int pos = atomicAdd(&cnt[e], 1); list[(size_t)e * T_ + pos] = a; gate[a] = g; }
            }
            __syncthreads();
        }
    }
    SEAM(7);
    LAS int* mtab = (LAS int*)(smem + g8::STAGE_BYTES);
    if (IN(8)) {
        const int lane = LANE_NOW; (void)lane;
        if (tid == 0) { int ub = 0, rs = 0;
            for (int e = 0; e < NE; ++e) { const int c = (int)__hip_atomic_load((unsigned*)&cnt[e], __ATOMIC_RELAXED, __HIP_MEMORY_SCOPE_AGENT); mtab[e] = c; mtab[32 + e] = ub; mtab[65 + e] = rs; ub += ((c + 255) >> 8) * 16; rs += c; }
            mtab[64] = ub; mtab[97] = rs; mtab[98] = ub; }
        __syncthreads();
        g8::moe_build(mtab, nb, vcu);
        __syncthreads();
        g8::ProbGu P{h8q, q8gu, actf8, p.in[I_BGU], list, sah, sgu, g8::MoeTab{mtab, 16}, nb, vcu};
        g8::gemm_phase(lds, P);
        __syncthreads();
    }
    SEAM(8);
    if (IN(9)) {
        const int lane = LANE_NOW;
        for (int row = gw; row < NA; row += nw) {
            float v[32]; float amax = 0.f;
#pragma unroll
            for (int c = 0; c < 4; ++c) { const uint2 a = *(const uint2*)(actf8 + (size_t)row * 2048 + (lane + 64 * c) * 8);
                dec4_fp8(a.x, v[c * 8 + 0], v[c * 8 + 1], v[c * 8 + 2], v[c * 8 + 3]); dec4_fp8(a.y, v[c * 8 + 4], v[c * 8 + 5], v[c * 8 + 6], v[c * 8 + 7]);
#pragma unroll
                for (int q = 0; q < 8; ++q) amax = fmaxf(amax, fabsf(v[c * 8 + q])); }
            amax = wave_max(amax);
            const float qinv = amax > 0.f ? 127.f / amax : 0.f;
            if (lane == 0) sact[row] = amax > 0.f ? amax / 127.f : 1.f;
#pragma unroll
            for (int c = 0; c < 4; ++c) { uint2 q; q.x = pack4_i8(v[c * 8 + 0] * qinv, v[c * 8 + 1] * qinv, v[c * 8 + 2] * qinv, v[c * 8 + 3] * qinv); q.y = pack4_i8(v[c * 8 + 4] * qinv, v[c * 8 + 5] * qinv, v[c * 8 + 6] * qinv, v[c * 8 + 7] * qinv);
                *(uint2*)(act8 + (size_t)row * 2048 + (lane + 64 * c) * 8) = q; }
        }
    }
    SEAM(9);
    if (IN(10)) {
        const int lane = LANE_NOW; (void)lane;
        if (tid == 0) { int ub = 0, rs = 0;
            for (int e = 0; e < NE; ++e) { const int c = (int)__hip_atomic_load((unsigned*)&cnt[e], __ATOMIC_RELAXED, __HIP_MEMORY_SCOPE_AGENT); mtab[e] = c; mtab[32 + e] = ub; mtab[65 + e] = rs; ub += ((c + 255) >> 8) * 8; rs += c; }
            mtab[64] = ub; mtab[97] = rs; mtab[98] = ub; }
        __syncthreads();
        g8::moe_build(mtab, nb, vcu);
        __syncthreads();
        g8::ProbDn P{act8, q8dn, yf8, p.in[I_BDN], list, gate, sact, sdn, g8::MoeTab{mtab, 8}, nb, vcu};
        g8::gemm_phase(lds, P);
        __syncthreads();
    }
    SEAM(10);
    if (IN(11)) {
        const int lane = LANE_NOW; (void)lane;
        for (int row = gw; row < T_; row += nw) {
            float v[32]; float s = 0.f;
#pragma unroll
            for (int c = 0; c < 4; ++c) { const int col = (lane + 64 * c) * 8; const size_t yo = (size_t)row * 4 * 2048 + col;
                const h8 hh8 = *(const h8*)(h16 + (size_t)row * 2048 + col);
                const uint2 y0 = *(const uint2*)(yf8 + yo), y1 = *(const uint2*)(yf8 + yo + 2048), y2 = *(const uint2*)(yf8 + yo + 4096), y3 = *(const uint2*)(yf8 + yo + 6144);
                float ys[8], t0[8], t1[8], t2[8], t3[8];
                dec4_fp8(y0.x, t0[0], t0[1], t0[2], t0[3]); dec4_fp8(y0.y, t0[4], t0[5], t0[6], t0[7]); dec4_fp8(y1.x, t1[0], t1[1], t1[2], t1[3]); dec4_fp8(y1.y, t1[4], t1[5], t1[6], t1[7]);
                dec4_fp8(y2.x, t2[0], t2[1], t2[2], t2[3]); dec4_fp8(y2.y, t2[4], t2[5], t2[6], t2[7]); dec4_fp8(y3.x, t3[0], t3[1], t3[2], t3[3]); dec4_fp8(y3.y, t3[4], t3[5], t3[6], t3[7]);
#pragma unroll
                for (int q = 0; q < 8; ++q) ys[q] = (t0[q] + t1[q]) + (t2[q] + t3[q]);
#pragma unroll
                for (int q = 0; q < 8; ++q) { v[c * 8 + q] = DN_ALPHA * (float)hh8[q] + ys[q] * 0.0625f; s += v[c * 8 + q]; } }
            const float mu = wave_sum(s) / 2048.f; float q2 = 0.f;
#pragma unroll
            for (int i = 0; i < 32; ++i) { const float d = v[i] - mu; q2 += d * d; }
            const float rs = rsqrtf(wave_sum(q2) / 2048.f + LN_EPS);
#pragma unroll
            for (int c = 0; c < 4; ++c) { const int col = (lane + 64 * c) * 8;
                const float4 ga = *(const float4*)(p.in[I_LN2G] + col), gb = *(const float4*)(p.in[I_LN2G] + col + 4), ba = *(const float4*)(p.in[I_LN2B] + col), bb = *(const float4*)(p.in[I_LN2B] + col + 4);
                float4 o0, o1;
                o0.x = (v[c * 8 + 0] - mu) * rs * ga.x + ba.x; o0.y = (v[c * 8 + 1] - mu) * rs * ga.y + ba.y; o0.z = (v[c * 8 + 2] - mu) * rs * ga.z + ba.z; o0.w = (v[c * 8 + 3] - mu) * rs * ga.w + ba.w;
                o1.x = (v[c * 8 + 4] - mu) * rs * gb.x + bb.x; o1.y = (v[c * 8 + 5] - mu) * rs * gb.y + bb.y; o1.z = (v[c * 8 + 6] - mu) * rs * gb.z + bb.z; o1.w = (v[c * 8 + 7] - mu) * rs * gb.w + bb.w;
                *(float4*)(p.out + (size_t)row * 2048 + col) = o0; *(float4*)(p.out + (size_t)row * 2048 + col + 4) = o1; }
        }
    }
}

constexpr int NPHASE = 12;

extern "C" void kernel_launch(void* const* d_in, const int* in_sizes, int n_in, void* d_out, int out_size, void* d_ws, size_t ws_size, hipStream_t stream) {
    static int grid = 0;
    if (grid == 0) {
        if (n_in != 26 || ws_size < WS_END) { fprintf(stderr, "kernel_launch: unexpected n_in %d or ws_size %zu (< %zu)\n", n_in, ws_size, (size_t)WS_END); grid = -1; return; }
        int dev = 0, cus = 0, per_cu = 0;
        hipGetDevice(&dev); hipDeviceGetAttribute(&cus, hipDeviceAttributeMultiprocessorCount, dev);
        if (hipFuncSetAttribute((const void*)fwd, hipFuncAttributeMaxDynamicSharedMemorySize, LDS_BYTES) != hipSuccess) { fprintf(stderr, "hipFuncSetAttribute failed\n"); grid = -1; return; }
        hipOccupancyMaxActiveBlocksPerMultiprocessor(&per_cu, (const void*)fwd, 512, LDS_BYTES);
        (void)hipGetLastError();
        if (per_cu < 1) fprintf(stderr, "occupancy query says %d blocks per CU\n", per_cu);
        grid = cus > 0 ? cus : 256;
    }
    if (grid < 0) return;
    hipMemsetAsync((char*)d_ws + WS_CTL, 0, CTL_BYTES, stream);
    Params p{};
    for (int i = 0; i < 26; ++i) p.in[i] = (const float*)d_in[i];
    p.out = (float*)d_out; p.ws = (unsigned char*)d_ws;
#if N_LAUNCH_MODE == 1
    p.lo_hi = (long long)0 | ((long long)NPHASE << 32);
    hipLaunchKernelGGL(fwd, dim3(grid), dim3(512), LDS_BYTES, stream, p);
#else
    for (int ph = 0; ph < NPHASE; ++ph) {
        p.lo_hi = (long long)ph | ((long long)(ph + 1) << 32);
        hipLaunchKernelGGL(fwd, dim3(grid), dim3(512), LDS_BYTES, stream, p);
    }
#endif
}
```

```cpp
#include <hip/hip_runtime.h>
#include <cstdio>
#include <cstdint>

#ifndef N_LAUNCH_MODE
#define N_LAUNCH_MODE 1
#endif

constexpr int B_ = 8, S_ = 2048, D_ = 2048, T_ = B_ * S_;
constexpr int INW = 3608;
constexpr int C_Q = 0, C_KC = 1024, C_VC = 1280, C_KS = 1536, C_VS = 1792, C_KW = 2048, C_VW = 2304, C_G = 2560, C_UP = 2584, C_QM = 3096;
constexpr int NC = 127;
constexpr int CROWS = B_ * NC * 2;
constexpr int NE = 32, DE = 2048, NA = T_ * 4;
constexpr float LN_EPS = 1e-5f;
constexpr float DN_ALPHA = 1.189207115002721f;
constexpr float ATT_SCALE = 0.08838834764831845f;

constexpr size_t al256(size_t x) { return (x + 255) & ~(size_t)255; }
constexpr size_t WS_CTL = 0;
constexpr size_t CTL_BYTES = 65536;
constexpr size_t CTL_CNT = 16384;
constexpr size_t WS_PROJ = CTL_BYTES;
constexpr size_t WS_KVMEM = WS_PROJ + al256((size_t)T_ * INW * 4);
constexpr size_t WS_BIAS1 = WS_KVMEM + al256((size_t)2048 * 1024 * 4);
constexpr size_t WS_HID = WS_BIAS1 + al256(2 * 16 * 256 * 4);
constexpr size_t WS_KC = WS_HID + al256((size_t)2 * 2048 * 256 * 4);
constexpr size_t WS_VC = WS_KC + al256((size_t)CROWS * 128 * 4);
constexpr size_t WS_POOLED = WS_VC + al256((size_t)CROWS * 128 * 4);
constexpr size_t WS_OPOOL = WS_POOLED + al256((size_t)T_ * 512 * 4);
constexpr size_t WS_OWIN = WS_OPOOL + al256((size_t)T_ * 512 * 4);
constexpr size_t WS_OCMP = WS_OWIN + al256((size_t)T_ * 1024 * 4);
constexpr size_t WS_OSLC = WS_OCMP + al256((size_t)T_ * 1024 * 4);
constexpr size_t WS_SEL = WS_OSLC + al256((size_t)T_ * 1024 * 4);
constexpr size_t WS_OMEM = WS_SEL + al256((size_t)T_ * 2 * 4);
constexpr size_t WS_CAT16 = WS_OMEM + al256((size_t)T_ * 512 * 4);
constexpr size_t WS_HPRE = WS_CAT16 + al256((size_t)T_ * 2048 * 2);
constexpr size_t WS_H = WS_HPRE + al256((size_t)T_ * 2048 * 4);
constexpr size_t WS_H16 = WS_H + al256((size_t)T_ * 2048 * 4);
constexpr size_t WS_GATE = WS_H16 + al256((size_t)T_ * 2048 * 2);
constexpr size_t WS_LIST = WS_GATE + al256((size_t)NA * 4);
constexpr size_t WS_ACT16 = WS_LIST + al256((size_t)NE * T_ * 4);
constexpr size_t WS_Y16 = WS_ACT16 + al256((size_t)(NA + 256) * 2048 * 2);
constexpr size_t WS_X16 = WS_Y16 + al256((size_t)NA * 2048 * 2);
constexpr size_t WS_MEM16 = WS_X16 + (size_t)T_ * 2048 * 2;
constexpr size_t WS_WTIN = WS_MEM16 + al256((size_t)2048 * 2048 * 2);
constexpr size_t WS_WTOUT = WS_WTIN + al256((size_t)3840 * 2048 * 2);
constexpr size_t WS_WTGU = WS_WTOUT + al256((size_t)2048 * 2048 * 2);
constexpr size_t WS_WTDN = WS_WTGU + al256((size_t)NE * 4096 * 2048 * 2);
constexpr size_t WS_PROJ16 = WS_WTDN + al256((size_t)NE * 2048 * 2048 * 2);
constexpr size_t WS_KVMEM16 = WS_PROJ16 + al256((size_t)(T_ + 64) * INW * 2);
constexpr size_t WS_WT1 = WS_KVMEM16 + al256((size_t)2048 * 1024 * 2);
constexpr size_t WS_UV = WS_WT1 + al256((size_t)2 * 512 * 2048 * 2);
constexpr size_t WS_KC16 = WS_UV + al256((size_t)2 * 4 * 2048 * 512 * 4);
constexpr size_t WS_VC16 = WS_KC16 + al256((size_t)B_ * 128 * 256 * 2);
constexpr size_t WS_WR16 = WS_VC16 + al256((size_t)B_ * 128 * 256 * 2);
constexpr size_t WS_Q8GU = WS_WR16 + al256((size_t)32 * 2048 * 2);
constexpr size_t WS_Q8DN = WS_Q8GU + al256((size_t)NE * 4096 * 2048);
constexpr size_t WS_SGU = WS_Q8DN + al256((size_t)NE * 2048 * 2048);
constexpr size_t WS_SDN = WS_SGU + al256((size_t)NE * 4096 * 4);
constexpr size_t WS_H8 = WS_SDN + al256((size_t)NE * 2048 * 4);
constexpr size_t WS_SAH = WS_H8 + al256((size_t)T_ * 2048);
constexpr size_t WS_ACT8 = WS_SAH + al256((size_t)T_ * 4);
constexpr size_t WS_SACT = WS_ACT8 + al256((size_t)(NA + 256) * 2048);
constexpr size_t WS_WTMKV = WS_SACT + al256((size_t)(NA + 256) * 4);
constexpr size_t WS_Q8OUT = WS_WTMKV + al256((size_t)1024 * 2048 * 2);
constexpr size_t WS_SOUT = WS_Q8OUT + al256((size_t)2048 * 2048);
constexpr size_t WS_CAT8 = WS_SOUT + al256(2048 * 4);
constexpr size_t WS_SCAT = WS_CAT8 + al256((size_t)T_ * 2048);
constexpr size_t WS_WT2 = WS_SCAT + al256((size_t)T_ * 4);
constexpr size_t WS_KV16 = WS_WT2 + al256((size_t)2 * 128 * 256 * 2);
constexpr size_t KVSEG = (size_t)S_ * 128;
constexpr size_t WS_END = WS_KV16 + al256((size_t)6 * B_ * 2 * S_ * 128 * 2);

constexpr int LDS_BYTES = 155648;

struct Params {
    const float* in[26];
    float* out;
    unsigned char* ws;
    long long lo_hi;
};
enum { I_X = 0, I_MEM, I_WIN, I_POSK, I_W1K, I_W2K, I_POSV, I_W1V, I_W2V, I_POOLW, I_POOLS, I_WMEMKV, I_GNNSA, I_GNPOOL, I_GNMEM, I_WOUT,
       I_LN1G, I_LN1B, I_WR, I_BR, I_WGU, I_BGU, I_WDN, I_BDN, I_LN2G, I_LN2B };

#define XB_TMO      128
#define XB_XCNT(j)  (256  + 64 * (j))
#define XB_XSUB(j)  (1280 + 64 * (j))
#define XB_XGEN(j)  (2304 + 64 * (j))
#define XB_TOP      3328
#define XB_TOPGEN   3392
#define XCD_BAR_WORDS 3456
#define XB_SPIN_CAP (1u << 25)
#define LAS __attribute__((address_space(3)))

__device__ __forceinline__ unsigned xb_ld(unsigned* p)              { return __hip_atomic_load(p, __ATOMIC_RELAXED, __HIP_MEMORY_SCOPE_AGENT); }
__device__ __forceinline__ unsigned xb_add(unsigned* p, unsigned v) { return __hip_atomic_fetch_add(p, v, __ATOMIC_RELAXED, __HIP_MEMORY_SCOPE_AGENT); }
__device__ __forceinline__ unsigned xb_xcc_id() { return (unsigned)__builtin_amdgcn_s_getreg((3 << 11) | 20) & 0xFu; }
#define XB_SPIN(cond, bar) do { unsigned _sp = 0; while (cond) { __builtin_amdgcn_s_sleep(1); \
    if ((++_sp & 255u) == 0u) { if (xb_ld(&(bar)[XB_TMO])) break; if (_sp > XB_SPIN_CAP) { atomicAdd(&(bar)[XB_TMO], 1u); break; } } } } while (0)

struct XcdBarrier { unsigned* bar; unsigned x; volatile LAS unsigned* st; };

__device__ __forceinline__ XcdBarrier xcd_barrier_post(unsigned* bar, volatile LAS unsigned* st) {
    XcdBarrier b; b.bar = bar; b.x = xb_xcc_id(); b.st = st;
    if (threadIdx.x == 0) (void)xb_add(&bar[XB_XCNT(b.x)], 1u);
    return b;
}
__device__ __forceinline__ void xcd_barrier_complete(unsigned* bar, unsigned x, unsigned& nloc, unsigned& nx) {
    const unsigned G = gridDim.x * gridDim.y * gridDim.z;
    unsigned sum, cnt, mine, sp = 0u;
    for (;;) {
        sum = 0u; cnt = 0u; mine = 0u;
#pragma unroll
        for (unsigned j = 0; j < 16; ++j) { const unsigned c = xb_ld(&bar[XB_XCNT(j)]); sum += c; cnt += (c > 0u) ? 1u : 0u; mine = (j == x) ? c : mine; }
        if (sum == G) break;
        __builtin_amdgcn_s_sleep(1);
        if ((++sp & 255u) == 0u) { if (xb_ld(&bar[XB_TMO])) break; if (sp > XB_SPIN_CAP) { atomicAdd(&bar[XB_TMO], 1u); break; } }
    }
    nloc = mine > 0u ? mine : 1u; nx = cnt > 0u ? cnt : 1u;
}
__device__ __forceinline__ void xcd_barrier(const XcdBarrier& b) {
    asm volatile("s_waitcnt vmcnt(0)" ::: "memory");
    __syncthreads();
    if (threadIdx.x == 0) {
        unsigned* bar = b.bar;
        __builtin_amdgcn_s_waitcnt(0);
        unsigned nloc = b.st[0], nx = b.st[1];
        if (nloc == 0u) { xcd_barrier_complete(bar, b.x, nloc, nx); b.st[0] = nloc; b.st[1] = nx; }
        const unsigned old = xb_add(&bar[XB_XSUB(b.x)], 1u);
        const unsigned gen = old / nloc;
        if (old + 1u == (gen + 1u) * nloc) {
            __builtin_amdgcn_fence(__ATOMIC_RELEASE, "agent");
            asm volatile("s_waitcnt vmcnt(0)" ::: "memory");
            const unsigned og = xb_add(&bar[XB_TOP], 1u);
            const unsigned tg = og / nx;
            if (og + 1u == (tg + 1u) * nx) xb_add(&bar[XB_TOPGEN], 1u);
            else XB_SPIN(xb_ld(&bar[XB_TOPGEN]) == tg, bar);
            __builtin_amdgcn_fence(__ATOMIC_ACQUIRE, "agent");
            xb_add(&bar[XB_XGEN(b.x)], 1u);
            asm volatile("s_waitcnt vmcnt(0)" ::: "memory");
        } else {
            XB_SPIN(xb_ld(&bar[XB_XGEN(b.x)]) == gen, bar);
            __builtin_amdgcn_fence(__ATOMIC_ACQUIRE, "agent");
            asm volatile("s_waitcnt vmcnt(0)" ::: "memory");
        }
    }
    __syncthreads();
}

typedef _Float16 h8 __attribute__((ext_vector_type(8)));
typedef _Float16 h4 __attribute__((ext_vector_type(4)));
typedef float f4 __attribute__((ext_vector_type(4)));

__device__ __forceinline__ float wave_sum(float v) {
#pragma unroll
    for (int o = 32; o > 0; o >>= 1) v += __shfl_xor(v, o);
    return v;
}
__device__ __forceinline__ float wave_max(float v) {
#pragma unroll
    for (int o = 32; o > 0; o >>= 1) v = fmaxf(v, __shfl_xor(v, o));
    return v;
}
__device__ __forceinline__ void wave_sync() {
    asm volatile("s_waitcnt lgkmcnt(0)" ::: "memory");
    __builtin_amdgcn_wave_barrier();
}
__device__ __forceinline__ float gelu_tanh(float x) {
    const float u = 0.7978845608028654f * (x + 0.044715f * x * x * x);
    return 0.5f * x * (1.f + tanhf(u));
}
__device__ __forceinline__ float gelu_fast(float x) { const float u = 0.7978845608028654f * (x + 0.044715f * x * x * x); const float t = 1.f - 2.f * __builtin_amdgcn_rcpf(1.f + __builtin_amdgcn_exp2f(2.8853900817779268f * u)); return 0.5f * x * (1.f + t); }
__device__ __forceinline__ float sigmoidf_(float x) { return 1.f / (1.f + expf(-x)); }
__device__ __forceinline__ unsigned pk4_fp8(float a, float b, float c, float d) { int w = 0; w = __builtin_amdgcn_cvt_pk_fp8_f32(a, b, w, false); w = __builtin_amdgcn_cvt_pk_fp8_f32(c, d, w, true); return (unsigned)w; }
__device__ __forceinline__ void dec4_fp8(unsigned w, float& a, float& b, float& c, float& d) { a = __builtin_amdgcn_cvt_f32_fp8((int)w, 0); b = __builtin_amdgcn_cvt_f32_fp8((int)w, 1); c = __builtin_amdgcn_cvt_f32_fp8((int)w, 2); d = __builtin_amdgcn_cvt_f32_fp8((int)w, 3); }
__device__ __forceinline__ float swiglu_fast(float g, float l) { const float xg = fminf(g, 7.f), xl = fminf(fmaxf(l, -7.f), 7.f); return xg * __builtin_amdgcn_rcpf(1.f + __builtin_amdgcn_exp2f(-2.4554669595930156f * xg)) * (xl + 1.f); }

constexpr int G_LD = 40;
template <class AF, class EF>
__device__ __forceinline__ void gemm_tile(char* smem, int K, const AF& af, const float* __restrict__ Bm, int ldb, int n0, int Nlim, bool perm, const EF& ef) {
    _Float16* As = (_Float16*)smem;
    _Float16* Bs = As + 128 * G_LD;
    const int tid = threadIdx.x, lane = tid & 63, wid = tid >> 6, wr = wid >> 2, wc = wid & 3, fr = lane & 15, fq = lane >> 4;
    f4 acc[4][2];
#pragma unroll
    for (int m = 0; m < 4; ++m)
#pragma unroll
        for (int n = 0; n < 2; ++n) acc[m][n] = (f4){0.f, 0.f, 0.f, 0.f};
    const int ar = tid >> 3, ak = (tid & 7) * 4;
    const float* ap0 = af.row(ar);
    const float* ap1 = af.row(ar + 64);
    const int bk = tid >> 5, bn = (tid & 31) * 4;
    const bool bok = (n0 + bn) < Nlim;
    int bnp[4];
#pragma unroll
    for (int i = 0; i < 4; ++i) { const int c = bn + i; bnp[i] = perm ? ((c & ~31) | ((c & 1) << 4) | ((c & 31) >> 1)) : c; }
    for (int k0 = 0; k0 < K; k0 += 32) {
        const int ko = af.koff(k0 + ak);
        float4 a0 = make_float4(0.f, 0.f, 0.f, 0.f), a1 = a0, b0 = a0, b1 = a0;
        if (ap0) a0 = *(const float4*)(ap0 + ko);
        if (ap1) a1 = *(const float4*)(ap1 + ko);
        if (bok) { b0 = *(const float4*)(Bm + (size_t)(k0 + bk) * ldb + n0 + bn); b1 = *(const float4*)(Bm + (size_t)(k0 + bk + 16) * ldb + n0 + bn); }
        __syncthreads();
        *(h4*)&As[ar * G_LD + ak] = (h4){(_Float16)a0.x, (_Float16)a0.y, (_Float16)a0.z, (_Float16)a0.w};
        *(h4*)&As[(ar + 64) * G_LD + ak] = (h4){(_Float16)a1.x, (_Float16)a1.y, (_Float16)a1.z, (_Float16)a1.w};
        Bs[bnp[0] * G_LD + bk] = (_Float16)b0.x; Bs[bnp[1] * G_LD + bk] = (_Float16)b0.y; Bs[bnp[2] * G_LD + bk] = (_Float16)b0.z; Bs[bnp[3] * G_LD + bk] = (_Float16)b0.w;
        Bs[bnp[0] * G_LD + bk + 16] = (_Float16)b1.x; Bs[bnp[1] * G_LD + bk + 16] = (_Float16)b1.y; Bs[bnp[2] * G_LD + bk + 16] = (_Float16)b1.z; Bs[bnp[3] * G_LD + bk + 16] = (_Float16)b1.w;
        __syncthreads();
        h8 a[4], b[2];
#pragma unroll
        for (int m = 0; m < 4; ++m) a[m] = *(const h8*)&As[(wr * 64 + m * 16 + fr) * G_LD + fq * 8];
#pragma unroll
        for (int n = 0; n < 2; ++n) b[n] = *(const h8*)&Bs[(wc * 32 + n * 16 + fr) * G_LD + fq * 8];
#pragma unroll
        for (int m = 0; m < 4; ++m)
#pragma unroll
            for (int n = 0; n < 2; ++n) acc[m][n] = __builtin_amdgcn_mfma_f32_16x16x32_f16(a[m], b[n], acc[m][n], 0, 0, 0);
    }
    ef(acc, wr, wc, fr, fq);
    __syncthreads();
}

struct ARowPlain { const float* base; int ld; int m0; int mlim;
    __device__ __forceinline__ const float* row(int r) const { return (m0 + r) < mlim ? base + (size_t)(m0 + r) * ld : nullptr; }
    __device__ __forceinline__ int koff(int k) const { return k; } };
struct ARowCmp { const float* proj; int col; int m0;
    __device__ __forceinline__ const float* row(int r) const { const int g = m0 + r; if (g >= CROWS) return nullptr; const int kvh = g & 1, bc = g >> 1, b = bc / NC, c = bc % NC;
        return proj + (size_t)(b * S_ + 16 * c) * INW + col + kvh * 128; }
    __device__ __forceinline__ int koff(int k) const { return (k >> 7) * INW + (k & 127); } };
struct ARowList { const float* base; const int* list; int m0; int cnt; int shift;
    __device__ __forceinline__ const float* row(int r) const { if (m0 + r >= cnt) return nullptr; const int a = list[m0 + r]; return base + (size_t)(a >> shift) * 2048; }
    __device__ __forceinline__ int koff(int k) const { return k; } };

struct EpiStore { float* C; int ldc; int m0; int n0; int mlim; int nlim; _Float16* C16;
    __device__ __forceinline__ void operator()(const f4 (&acc)[4][2], int wr, int wc, int fr, int fq) const {
#pragma unroll
        for (int m = 0; m < 4; ++m)
#pragma unroll
            for (int n = 0; n < 2; ++n)
#pragma unroll
                for (int j = 0; j < 4; ++j) { const int r = m0 + wr * 64 + m * 16 + fq * 4 + j, c = n0 + wc * 32 + n * 16 + fr;
                    if (r < mlim && c < nlim) { C[(size_t)r * ldc + c] = acc[m][n][j]; if (C16) C16[(size_t)r * ldc + c] = (_Float16)acc[m][n][j]; } } } };
struct EpiKc { _Float16* C; int m0;
    __device__ __forceinline__ void operator()(const f4 (&acc)[4][2], int wr, int wc, int fr, int fq) const {
#pragma unroll
        for (int m = 0; m < 4; ++m)
#pragma unroll
            for (int n = 0; n < 2; ++n)
#pragma unroll
                for (int j = 0; j < 4; ++j) { const int r = m0 + wr * 64 + m * 16 + fq * 4 + j, c = wc * 32 + n * 16 + fr;
                    C[(size_t)r * 128 + c] = (((r >> 1) & 127) == 127) ? (_Float16)0.f : (_Float16)acc[m][n][j]; } } };
struct EpiPool { _Float16* C; const float* scale; int m0; int g;
    __device__ __forceinline__ void operator()(const f4 (&acc)[4][2], int wr, int wc, int fr, int fq) const {
#pragma unroll
        for (int m = 0; m < 4; ++m)
#pragma unroll
            for (int n = 0; n < 2; ++n)
#pragma unroll
                for (int j = 0; j < 4; ++j) { const int r = m0 + wr * 64 + m * 16 + fq * 4 + j, c = g * 128 + wc * 32 + n * 16 + fr;
                    C[(size_t)r * 512 + c] = (_Float16)(acc[m][n][j] * scale[c]); } } };
struct EpiHid { float* C; const float* bias; int m0; int n0;
    __device__ __forceinline__ void operator()(const f4 (&acc)[4][2], int wr, int wc, int fr, int fq) const {
#pragma unroll
        for (int m = 0; m < 4; ++m)
#pragma unroll
            for (int n = 0; n < 2; ++n)
#pragma unroll
                for (int j = 0; j < 4; ++j) { const int r = m0 + wr * 64 + m * 16 + fq * 4 + j, c = n0 + wc * 32 + n * 16 + fr;
                    if (r < CROWS) C[(size_t)r * 256 + c] = gelu_tanh(acc[m][n][j] + bias[c]); } } };
struct EpiOut { float* C; const float* x; int m0; int n0;
    __device__ __forceinline__ void operator()(const f4 (&acc)[4][2], int wr, int wc, int fr, int fq) const {
#pragma unroll
        for (int m = 0; m < 4; ++m)
#pragma unroll
            for (int n = 0; n < 2; ++n)
#pragma unroll
                for (int j = 0; j < 4; ++j) { const size_t o = (size_t)(m0 + wr * 64 + m * 16 + fq * 4 + j) * 2048 + n0 + wc * 32 + n * 16 + fr;
                    C[o] = DN_ALPHA * x[o] + acc[m][n][j]; } } };
struct EpiGu { float* act; const float* bgu; const int* list; int m0; int cnt; int n0;
    __device__ __forceinline__ void operator()(const f4 (&acc)[4][2], int wr, int wc, int fr, int fq) const {
        const int jc = (n0 + wc * 32) / 2 + fr;
        const float bg = bgu[2 * jc], bl = bgu[2 * jc + 1];
#pragma unroll
        for (int m = 0; m < 4; ++m)
#pragma unroll
            for (int j = 0; j < 4; ++j) { const int r = m0 + wr * 64 + m * 16 + fq * 4 + j;
                if (r < cnt) { const int a = list[r];
                    const float xg = fminf(acc[m][0][j] + bg, 7.f), xl = fminf(fmaxf(acc[m][1][j] + bl, -7.f), 7.f);
                    act[(size_t)a * 2048 + jc] = xg * sigmoidf_(1.702f * xg) * (xl + 1.f); } } } };
struct EpiDn { float* y; const float* bdn; const int* list; const float* gate; int m0; int cnt; int n0;
    __device__ __forceinline__ void operator()(const f4 (&acc)[4][2], int wr, int wc, int fr, int fq) const {
#pragma unroll
        for (int m = 0; m < 4; ++m)
#pragma unroll
            for (int j = 0; j < 4; ++j) { const int r = m0 + wr * 64 + m * 16 + fq * 4 + j;
                if (r < cnt) { const int a = list[r]; const float g = gate[a];
#pragma unroll
                    for (int n = 0; n < 2; ++n) { const int c = n0 + wc * 32 + n * 16 + fr; y[(size_t)a * 2048 + c] = (acc[m][n][j] + bdn[c]) * g; } } } } };

constexpr int WLDS_FLOATS = 4096 + 512 + 32;
template <bool SHARED>
__device__ __forceinline__ void wave_attn(float* sw, const float* __restrict__ qptr, const float* __restrict__ Kb, const float* __restrict__ Vb, int ld, int nseg, float scale, float* __restrict__ optr) {
    const int lane = threadIdx.x & 63;
    float* sq = sw + 4096; const int* segs = (const int*)(sw + 4096 + 512);
#pragma unroll
    for (int i = 0; i < 8; ++i) sq[lane + 64 * i] = qptr[lane + 64 * i];
    wave_sync();
    for (int sg = 0; sg < nseg; ++sg) {
        const int start = segs[sg], len = segs[16 + sg];
        float d0 = 0.f, d1 = 0.f, d2 = 0.f, d3 = 0.f;
        if (lane < len) {
            const float* kp = Kb + (size_t)(start + lane) * ld;
            for (int d4 = 0; d4 < 32; ++d4) {
                if (SHARED) {
                    const float4 kv = *(const float4*)(kp + d4 * 4);
                    const float4 q0 = *(const float4*)(sq + d4 * 4), q1 = *(const float4*)(sq + 128 + d4 * 4), q2 = *(const float4*)(sq + 256 + d4 * 4), q3 = *(const float4*)(sq + 384 + d4 * 4);
                    d0 += kv.x * q0.x + kv.y * q0.y + kv.z * q0.z + kv.w * q0.w;
                    d1 += kv.x * q1.x + kv.y * q1.y + kv.z * q1.z + kv.w * q1.w;
                    d2 += kv.x * q2.x + kv.y * q2.y + kv.z * q2.z + kv.w * q2.w;
                    d3 += kv.x * q3.x + kv.y * q3.y + kv.z * q3.z + kv.w * q3.w;
                } else {
                    const float4 k0 = *(const float4*)(kp + d4 * 4), k1 = *(const float4*)(kp + 128 + d4 * 4), k2 = *(const float4*)(kp + 256 + d4 * 4), k3 = *(const float4*)(kp + 384 + d4 * 4);
                    const float4 q0 = *(const float4*)(sq + d4 * 4), q1 = *(const float4*)(sq + 128 + d4 * 4), q2 = *(const float4*)(sq + 256 + d4 * 4), q3 = *(const float4*)(sq + 384 + d4 * 4);
                    d0 += k0.x * q0.x + k0.y * q0.y + k0.z * q0.z + k0.w * q0.w;
                    d1 += k1.x * q1.x + k1.y * q1.y + k1.z * q1.z + k1.w * q1.w;
                    d2 += k2.x * q2.x + k2.y * q2.y + k2.z * q2.z + k2.w * q2.w;
                    d3 += k3.x * q3.x + k3.y * q3.y + k3.z * q3.z + k3.w * q3.w;
                }
            }
        }
        const bool ok = lane < len;
        sw[sg * 64 + lane] = ok ? d0 * scale : -1e30f;
        sw[1024 + sg * 64 + lane] = ok ? d1 * scale : -1e30f;
        sw[2048 + sg * 64 + lane] = ok ? d2 * scale : -1e30f;
        sw[3072 + sg * 64 + lane] = ok ? d3 * scale : -1e30f;
    }
    wave_sync();
    const int n = nseg * 64;
#pragma unroll
    for (int g = 0; g < 4; ++g) {
        float mx = -1e30f;
        for (int i = lane; i < n; i += 64) mx = fmaxf(mx, sw[g * 1024 + i]);
        mx = wave_max(mx);
        float sm = 0.f;
        for (int i = lane; i < n; i += 64) { const float v = sw[g * 1024 + i]; sm += (v > -1e29f) ? expf(v - mx) : 0.f; }
        sm = wave_sum(sm);
        const float inv = sm > 0.f ? 1.f / sm : 0.f;
        for (int i = lane; i < n; i += 64) { const float v = sw[g * 1024 + i]; sw[g * 1024 + i] = (v > -1e29f) ? expf(v - mx) * inv : 0.f; }
    }
    wave_sync();
    float o[4][2];
#pragma unroll
    for (int g = 0; g < 4; ++g) { o[g][0] = 0.f; o[g][1] = 0.f; }
    for (int sg = 0; sg < nseg; ++sg) {
        const int start = segs[sg], len = segs[16 + sg];
        for (int l = 0; l < len; ++l) {
            const float* vp = Vb + (size_t)(start + l) * ld;
            if (SHARED) {
                const float v0 = vp[lane], v1 = vp[lane + 64];
#pragma unroll
                for (int g = 0; g < 4; ++g) { const float p = sw[g * 1024 + sg * 64 + l]; o[g][0] += p * v0; o[g][1] += p * v1; }
            } else {
#pragma unroll
                for (int g = 0; g < 4; ++g) { const float p = sw[g * 1024 + sg * 64 + l]; o[g][0] += p * vp[g * 128 + lane]; o[g][1] += p * vp[g * 128 + lane + 64]; }
            }
        }
    }
#pragma unroll
    for (int g = 0; g < 4; ++g) { optr[g * 128 + lane] = o[g][0]; optr[g * 128 + lane + 64] = o[g][1]; }
}

namespace g8 {
constexpr int BM = 256, BK = 64, HALF = 128, HTB = HALF * BK * 2, STAGE_BYTES = 8 * HTB;
constexpr int KK = 2048;
typedef float f32x4 __attribute__((ext_vector_type(4)));
__device__ __forceinline__ int lds_byte(int r, int c) { const int st = (r >> 4) * 2 + (c >> 5), rr = r & 15, cc = c & 31, ob = rr * 64 + cc * 2; return st * 1024 + (ob ^ (((ob >> 9) & 1) << 5)); }
__device__ __forceinline__ void stage_rc(int b, int& R, int& C) { const int st = b / 1024, sb = b % 1024, swz = sb ^ (((sb >> 9) & 1) << 5); R = (st >> 1) * 16 + swz / 64; C = (st & 1) * 32 + (swz % 64) / 2; }
__device__ __forceinline__ int perm32(int rho) { const int n = rho >> 4, i = rho & 15; return 8 * (i >> 2) + 4 * n + (i & 3); }

typedef int i32x4 __attribute__((ext_vector_type(4)));
typedef unsigned u32x2 __attribute__((ext_vector_type(2)));
typedef unsigned u32x4 __attribute__((ext_vector_type(4)));
template <bool I8> struct AccSel { typedef f32x4 T; };
template <> struct AccSel<true> { typedef i32x4 T; };
__device__ __forceinline__ f32x4 mma16(i32x4 a, i32x4 b, f32x4 c) { return __builtin_amdgcn_mfma_f32_16x16x32_f16(*reinterpret_cast<h8*>(&a), *reinterpret_cast<h8*>(&b), c, 0, 0, 0); }
__device__ __forceinline__ i32x4 mma16(i32x4 a, i32x4 b, i32x4 c) { return __builtin_amdgcn_mfma_i32_16x16x64_i8(a, b, c, 0, 0, 0); }
struct Unit { int m0, n0, e, cnt, rbase; };
constexpr int EP_OFF = STAGE_BYTES + 2048, EP_LD = 528, EP_GRP = 16 * EP_LD;
__device__ __forceinline__ void ep_sync() { asm volatile("s_waitcnt lgkmcnt(0)" ::: "memory"); __builtin_amdgcn_s_barrier(); asm volatile("" ::: "memory"); }
__device__ __forceinline__ int ep_tid() { int tz = threadIdx.x; asm volatile("" : "+v"(tz)); return tz; }
__device__ __forceinline__ h8 cvt8(f32x4 a, f32x4 b) { h8 o; o[0] = (_Float16)a[0]; o[1] = (_Float16)a[1]; o[2] = (_Float16)a[2]; o[3] = (_Float16)a[3]; o[4] = (_Float16)b[0]; o[5] = (_Float16)b[1]; o[6] = (_Float16)b[2]; o[7] = (_Float16)b[3]; return o; }

__device__ __forceinline__ void tile_order(int L, int nM, int nN, int& pm, int& pn) {
    const int nwg = nM * nN; int wgid = L;
    { const int q = nwg / 8, r = nwg % 8, xcd = wgid % 8, off = wgid / 8; wgid = (xcd < r ? xcd * (q + 1) : r * (q + 1) + (xcd - r) * q) + off; }
    const int nig = 8 * nN, gid = wgid / nig, fm = gid * 8, gsz = (nM - fm) < 8 ? (nM - fm) : 8;
    pm = fm + ((wgid % nig) % gsz); pn = (wgid % nig) / gsz;
}

template <class Prob>
__device__ __forceinline__ void gemm_phase(LAS unsigned char* lds, const Prob& P) {
    const int tid = threadIdx.x, wid = __builtin_amdgcn_readfirstlane(tid >> 6), lane = tid & 63, wr = wid >> 2, wc = wid & 3, fr = lane & 15, fq = lane >> 4;
    constexpr int nt = Prob::NT; constexpr size_t KS2 = Prob::KS2; constexpr unsigned ROWB = Prob::ROWB; constexpr bool I8 = Prob::I8;
    int sR[2], sC2[2]; unsigned voffB[2];
#pragma unroll
    for (int i = 0; i < 2; ++i) { int R, C; stage_rc(tid * 16 + i * 8192, R, C); sR[i] = R; sC2[i] = C * 2; const int Rb = Prob::PERM ? ((R & ~31) + perm32(R & 31)) : R; voffB[i] = (unsigned)Rb * ROWB + (unsigned)C * 2u; }
    const size_t kstep = (size_t)(BK * 2);
    const size_t hstep = (size_t)HALF * ROWB;
    const unsigned ldsw = (unsigned)wid * 1024u;
    const int aoff = lds_byte(wr * 64 + fr, fq * 8), boff = lds_byte(wc * 32 + fr, fq * 8);
#define G8_SA(b, h) (((b) * 2 + (h)) * HTB)
#define G8_SB(b, h) ((4 + (b) * 2 + (h)) * HTB)
#define G8_STAGE(bufoff, gbase, voff) do { _Pragma("unroll") for (int _i = 0; _i < 2; ++_i) \
        __builtin_amdgcn_global_load_lds((const unsigned*)((const char*)(gbase) + (voff)[_i]), (LAS unsigned*)(lds + (bufoff) + ldsw + _i * 8192), 16, 0, 0); } while (0)
#define G8_LDA(dst, b, h) do { _Pragma("unroll") for (int m = 0; m < 4; ++m) _Pragma("unroll") for (int k = 0; k < 2; ++k) dst[m][k] = *(const LAS i32x4*)(lds + G8_SA(b, h) + aoff + m * 2048 + k * 1024); } while (0)
#define G8_LDB(dst, b, h) do { _Pragma("unroll") for (int n = 0; n < 2; ++n) _Pragma("unroll") for (int k = 0; k < 2; ++k) dst[n][k] = *(const LAS i32x4*)(lds + G8_SB(b, h) + boff + n * 2048 + k * 1024); } while (0)
#define G8_MMA(ai, bj, At, Bt) do { __builtin_amdgcn_s_setprio(1); _Pragma("unroll") for (int m = 0; m < 4; ++m) _Pragma("unroll") for (int n = 0; n < 2; ++n) _Pragma("unroll") for (int k = 0; k < 2; ++k) \
        acc[ai][bj][m][n] = mma16(Bt[n][k], At[m][k], acc[ai][bj][m][n]); __builtin_amdgcn_s_setprio(0); } while (0)
#define G8_WAIT_V(n) asm volatile("s_waitcnt vmcnt(" #n ")" ::: "memory")
#define G8_WAIT_L(n) asm volatile("s_waitcnt lgkmcnt(" #n ")" ::: "memory")
#define G8_BAR __builtin_amdgcn_s_barrier()
#define G8_SCHED __builtin_amdgcn_sched_barrier(0)
    Unit cur, nxt; int ui = 0;
    if (!P.next(0, cur)) return;
    typedef typename AccSel<I8>::T AccT;
    AccT acc[2][2][4][2];
#pragma unroll
    for (int a = 0; a < 2; ++a)
#pragma unroll
        for (int b = 0; b < 2; ++b)
#pragma unroll
            for (int m = 0; m < 4; ++m)
#pragma unroll
                for (int n = 0; n < 2; ++n) acc[a][b][m][n] = AccT{};
    i32x4 At[4][2], B0[2][2], B1[2][2];
    unsigned vc[2][2], vn[2][2];
    P.a_offs(cur, sR, sC2, vc);
    const char* const Ab = P.a_base();
    const char* cB = P.b_base(cur);
    G8_STAGE(G8_SB(0, 0), cB, voffB); G8_STAGE(G8_SA(0, 0), Ab, vc[0]); G8_STAGE(G8_SB(0, 1), cB + hstep, voffB); G8_STAGE(G8_SA(0, 1), Ab, vc[1]);
    if (wr == 1) G8_BAR;
    G8_WAIT_V(4); G8_BAR;
    G8_STAGE(G8_SB(1, 0), cB + kstep, voffB); G8_STAGE(G8_SA(1, 0), Ab + kstep, vc[0]); G8_STAGE(G8_SB(1, 1), cB + hstep + kstep, voffB);
    G8_WAIT_V(6); G8_BAR;
    for (;;) {
        const bool has_next = P.next(ui + 1, nxt);
        const char* nB = cB;
        if (has_next) { P.a_offs(nxt, sR, sC2, vn); nB = P.b_base(nxt); }
        else { vn[0][0] = vc[0][0]; vn[0][1] = vc[0][1]; vn[1][0] = vc[1][0]; vn[1][1] = vc[1][1]; }
        for (int t = 0; t < nt; t += 2) {
            const bool last = (t == nt - 2);
            const char* a1 = Ab + (size_t)(t >> 1) * KS2 + kstep;
            const char* a2 = last ? Ab : Ab + (size_t)((t + 2) >> 1) * KS2; const char* b2 = last ? nB : cB + (size_t)(t + 2) * kstep;
            const char* a3 = a2 + kstep; const char* b3 = b2 + kstep;
            unsigned o2[2][2];
            o2[0][0] = last ? vn[0][0] : vc[0][0]; o2[0][1] = last ? vn[0][1] : vc[0][1]; o2[1][0] = last ? vn[1][0] : vc[1][0]; o2[1][1] = last ? vn[1][1] : vc[1][1];
            G8_LDB(B0, 0, 0); G8_SCHED; G8_LDA(At, 0, 0); G8_STAGE(G8_SA(1, 1), a1, vc[1]);
            G8_WAIT_L(8); G8_BAR; G8_WAIT_L(0); G8_MMA(0, 0, At, B0); G8_BAR; G8_SCHED;
            G8_LDB(B1, 0, 1); G8_STAGE(G8_SB(0, 0), b2, voffB);
            G8_BAR; G8_WAIT_L(0); G8_MMA(0, 1, At, B1); G8_BAR;
            G8_LDA(At, 0, 1); G8_STAGE(G8_SA(0, 0), a2, o2[0]);
            G8_BAR; G8_WAIT_L(0); G8_MMA(1, 0, At, B0); G8_BAR; G8_SCHED;
            G8_STAGE(G8_SB(0, 1), b2 + hstep, voffB);
            G8_WAIT_V(6); G8_BAR; G8_MMA(1, 1, At, B1); G8_BAR;
            G8_LDB(B0, 1, 0); G8_SCHED; G8_LDA(At, 1, 0); G8_STAGE(G8_SA(0, 1), a2, o2[1]);
            G8_WAIT_L(8); G8_BAR; G8_WAIT_L(0); G8_MMA(0, 0, At, B0); G8_BAR; G8_SCHED;
            G8_LDB(B1, 1, 1); G8_STAGE(G8_SB(1, 0), b3, voffB);
            G8_BAR; G8_WAIT_L(0); G8_MMA(0, 1, At, B1); G8_BAR;
            G8_LDA(At, 1, 1); G8_STAGE(G8_SA(1, 0), a3, o2[0]);
            G8_BAR; G8_WAIT_L(0); G8_MMA(1, 0, At, B0); G8_BAR; G8_SCHED;
            G8_STAGE(G8_SB(1, 1), b3 + hstep, voffB);
            G8_WAIT_V(6); G8_BAR; G8_MMA(1, 1, At, B1); G8_BAR;
        }
        P.epi(acc, cur, wr, wc, fr, fq, lds);
        if (!has_next) break;
#pragma unroll
        for (int a = 0; a < 2; ++a)
#pragma unroll
            for (int b = 0; b < 2; ++b)
#pragma unroll
                for (int m = 0; m < 4; ++m)
#pragma unroll
                    for (int n = 0; n < 2; ++n) acc[a][b][m][n] = AccT{};
        cur = nxt; cB = nB; ++ui;
        vc[0][0] = vn[0][0]; vc[0][1] = vn[0][1]; vc[1][0] = vn[1][0]; vc[1][1] = vn[1][1];
    }
    G8_WAIT_V(0);
    if (wr == 0) G8_BAR;
    G8_BAR;
#undef G8_SA
#undef G8_SB
#undef G8_STAGE
#undef G8_LDA
#undef G8_LDB
#undef G8_MMA
#undef G8_WAIT_V
#undef G8_WAIT_L
#undef G8_BAR
#undef G8_SCHED
}

struct ProbIn {
    static constexpr unsigned ROWB = 4096; static constexpr bool I8 = false;
    static constexpr int NT = 32; static constexpr size_t KS2 = 256;
    static constexpr bool PERM = true;
    const _Float16* A; _Float16* C16; int G, c;
    __device__ __forceinline__ bool next(int i, Unit& u) const { const int L = i * G + c; if (L >= 64 * 15 + 32) return false;
        if (L < 64 * 15) { int pm, pn; tile_order(L, 64, 15, pm, pn); u.m0 = pm * 256; u.n0 = pn * 256; u.e = 0; }
        else { const int v = L - 64 * 15; u.m0 = T_ + (v & 7) * 256; u.n0 = (v >> 3) * 256; u.e = 1; }
        u.cnt = 256; u.rbase = 0; return true; }
    __device__ __forceinline__ void a_offs(const Unit& u, const int (&R)[2], const int (&C2)[2], unsigned (&v)[2][2]) const {
#pragma unroll
        for (int h = 0; h < 2; ++h)
#pragma unroll
            for (int i = 0; i < 2; ++i) v[h][i] = (unsigned)(u.m0 + h * 128 + R[i]) * (unsigned)(KK * 2) + (unsigned)C2[i]; }
    __device__ __forceinline__ const char* a_base() const { return (const char*)A; }
    __device__ __forceinline__ const char* b_base(const Unit& u) const { return (const char*)A + (u.e ? (long long)(WS_WTMKV - WS_X16) : (long long)(WS_WTIN - WS_X16)) + (size_t)u.n0 * KK * 2; }
    __device__ __forceinline__ void epi(const f32x4 (&acc)[2][2][4][2], const Unit& u, int wr, int wc, int fr, int fq, LAS unsigned char* lds) const {
        LAS unsigned char* ep = lds + EP_OFF + wr * EP_GRP;
        const int tg = ep_tid() & 255, rrow = tg >> 4, ch = tg & 15;
        const int kvseg = (u.e == 0 && u.n0 >= 1024 && u.n0 < 2560) ? ((u.n0 - 1024) >> 8) : -1;
        _Float16* const Cb = (_Float16*)((char*)C16 + (u.e ? (long long)(WS_KVMEM16 - WS_PROJ16) : 0ll)); const int ldc = u.e ? 1024 : INW, nlim = u.e ? 1024 : INW, mb = u.e ? u.m0 - T_ : u.m0;
#pragma unroll
        for (int ai = 0; ai < 2; ++ai)
#pragma unroll
            for (int m = 0; m < 4; ++m) {
#pragma unroll
                for (int bj = 0; bj < 2; ++bj) *(LAS h8*)(ep + fr * EP_LD + (bj * 128 + wc * 32 + fq * 8) * 2) = cvt8(acc[ai][bj][m][0], acc[ai][bj][m][1]);
                ep_sync();
                const h8 x0 = *(const LAS h8*)(ep + rrow * EP_LD + ch * 32), x1 = *(const LAS h8*)(ep + rrow * EP_LD + ch * 32 + 16);
                const int grow = mb + ai * 128 + wr * 64 + m * 16 + rrow, gcol = u.n0 + ch * 16;
                if (kvseg >= 0) {
                    _Float16* dst = (_Float16*)((char*)C16 + (long long)(WS_KV16 - WS_PROJ16)) + ((size_t)(kvseg * B_ + (grow >> 11)) * 2 + (ch >> 3)) * KVSEG + (size_t)(grow & (S_ - 1)) * 128 + (ch & 7) * 16;
                    *(h8*)dst = x0; *(h8*)(dst + 8) = x1;
                } else {
                    if (gcol < nlim) *(h8*)(Cb + (size_t)grow * ldc + gcol) = x0;
                    if (gcol + 8 < nlim) *(h8*)(Cb + (size_t)grow * ldc + gcol + 8) = x1; }
                ep_sync();
            } }
};
struct ProbOut {
    static constexpr unsigned ROWB = 2048; static constexpr bool I8 = true;
    static constexpr int NT = 16; static constexpr size_t KS2 = 256;
    static constexpr bool PERM = true;
    const signed char* A; const signed char* Bt; _Float16* C; const _Float16* X; const float* sa; const float* sw; int G, c;
    __device__ __forceinline__ bool next(int i, Unit& u) const { const int L = i * G + c; if (L >= 64 * 8) return false; int pm, pn; tile_order(L, 64, 8, pm, pn); u.m0 = pm * 256; u.n0 = pn * 256; u.e = 0; u.cnt = 256; u.rbase = 0; return true; }
    __device__ __forceinline__ void a_offs(const Unit& u, const int (&R)[2], const int (&C2)[2], unsigned (&v)[2][2]) const {
#pragma unroll
        for (int h = 0; h < 2; ++h)
#pragma unroll
            for (int i = 0; i < 2; ++i) v[h][i] = (unsigned)(u.m0 + h * 128 + R[i]) * 2048u + (unsigned)C2[i]; }
    __device__ __forceinline__ const char* a_base() const { return (const char*)A; }
    __device__ __forceinline__ const char* b_base(const Unit& u) const { return (const char*)(Bt + (size_t)u.n0 * 2048); }
    __device__ __forceinline__ void epi(const i32x4 (&acc)[2][2][4][2], const Unit& u, int wr, int wc, int fr, int fq, LAS unsigned char* lds) const {
        LAS unsigned char* ep = lds + EP_OFF + wr * EP_GRP;
        const int tg = ep_tid() & 255, rrow = tg >> 4, ch = tg & 15;
        f32x4 s0[2], s1[2]; float srv[8];
#pragma unroll
        for (int bj = 0; bj < 2; ++bj) { const int col = u.n0 + bj * 128 + wc * 32 + fq * 8; s0[bj] = *(const f32x4*)(sw + col); s1[bj] = *(const f32x4*)(sw + col + 4); }
#pragma unroll
        for (int q = 0; q < 8; ++q) srv[q] = sa[u.m0 + (q >> 2) * 128 + wr * 64 + (q & 3) * 16 + fr];
#pragma unroll
        for (int ai = 0; ai < 2; ++ai)
#pragma unroll
            for (int m = 0; m < 4; ++m) { const float sr = srv[ai * 4 + m];
#pragma unroll
                for (int bj = 0; bj < 2; ++bj) { const i32x4 i0 = acc[ai][bj][m][0], i1 = acc[ai][bj][m][1];
                    *(LAS h8*)(ep + fr * EP_LD + (bj * 128 + wc * 32 + fq * 8) * 2) = cvt8((f32x4){(float)i0[0], (float)i0[1], (float)i0[2], (float)i0[3]} * (s0[bj] * sr), (f32x4){(float)i1[0], (float)i1[1], (float)i1[2], (float)i1[3]} * (s1[bj] * sr)); }
                const size_t go = (size_t)(u.m0 + ai * 128 + wr * 64 + m * 16 + rrow) * 2048 + u.n0 + ch * 16;
                const h8 r0 = *(const h8*)(X + go), r1 = *(const h8*)(X + go + 8);
                ep_sync();
                const h8 x0 = *(const LAS h8*)(ep + rrow * EP_LD + ch * 32), x1 = *(const LAS h8*)(ep + rrow * EP_LD + ch * 32 + 16);
                h8 o0, o1;
#pragma unroll
                for (int q = 0; q < 8; ++q) { o0[q] = (_Float16)(DN_ALPHA * (float)r0[q] + (float)x0[q]); o1[q] = (_Float16)(DN_ALPHA * (float)r1[q] + (float)x1[q]); }
                *(h8*)(C + go) = o0; *(h8*)(C + go + 8) = o1;
                ep_sync();
            } }
};
struct ProbCmp {
    static constexpr unsigned ROWB = 4096; static constexpr bool I8 = false;
    static constexpr int NT = 8; static constexpr size_t KS2 = 256;
    static constexpr bool PERM = false;
    const _Float16* A; const _Float16* Bt; float* C; int G, c;
    __device__ __forceinline__ bool next(int i, Unit& u) const { const int L = i * G + c; if (L >= 128) return false;
        u.e = L >> 6; const int r = L & 63; u.rbase = r & 3; u.n0 = ((r >> 2) & 1) * 256; u.m0 = (r >> 3) * 256; u.cnt = 256; return true; }
    __device__ __forceinline__ void a_offs(const Unit& u, const int (&R)[2], const int (&C2)[2], unsigned (&v)[2][2]) const {
#pragma unroll
        for (int h = 0; h < 2; ++h)
#pragma unroll
            for (int i = 0; i < 2; ++i) { const int row = u.m0 + h * 128 + R[i], kvh = row & 1, bj = row >> 1, b = bj >> 7, j = bj & 127;
                v[h][i] = (unsigned)((((u.e * B_ + b) * 2 + kvh) * S_ + 16 * j + 4 * u.rbase) * 128) * 2u + (unsigned)C2[i]; } }
    __device__ __forceinline__ const char* a_base() const { return (const char*)A; }
    __device__ __forceinline__ const char* b_base(const Unit& u) const { return (const char*)(Bt + ((size_t)u.e * 512 + u.n0) * KK + u.rbase * 512); }
    __device__ __forceinline__ void epi(const f32x4 (&acc)[2][2][4][2], const Unit& u, int wr, int wc, int fr, int fq, LAS unsigned char*) const {
        float* base = C + ((size_t)(u.e * 4 + u.rbase) * 2048) * 512;
#pragma unroll
        for (int ai = 0; ai < 2; ++ai)
#pragma unroll
            for (int m = 0; m < 4; ++m) { const int row = u.m0 + ai * 128 + wr * 64 + m * 16 + fr;
#pragma unroll
                for (int bj = 0; bj < 2; ++bj)
#pragma unroll
                    for (int n = 0; n < 2; ++n) { const int col = u.n0 + bj * 128 + wc * 32 + n * 16 + fq * 4;
                        *(f32x4*)(base + (size_t)row * 512 + col) = acc[ai][bj][m][n]; } } }
};
struct MoeTab { const LAS int* t; int NT;
    __device__ __forceinline__ bool find_i(int i, Unit& u) const {
        const LAS int* q = t + 128 + 8 * i;
        if (__builtin_amdgcn_readfirstlane(q[5]) == 0) return false;
        u.e = __builtin_amdgcn_readfirstlane(q[0]); u.m0 = __builtin_amdgcn_readfirstlane(q[1]); u.n0 = __builtin_amdgcn_readfirstlane(q[2]); u.cnt = __builtin_amdgcn_readfirstlane(q[3]); u.rbase = __builtin_amdgcn_readfirstlane(q[4]); return true; } };
__device__ __forceinline__ void moe_build(LAS int* t, int G, int vcu) {
    const int i = threadIdx.x;
    if (i < 40) { const int L = i * G + vcu; LAS int* q = t + 128 + 8 * i;
        if (L >= t[98]) q[5] = 0;
        else { int e = 0; for (; e < NE - 1; ++e) { if (L < t[32 + e + 1]) break; }
            const int ub = t[32 + e], cn = t[e], rs = t[65 + e]; const int nm = (cn + 255) >> 8, v = L - ub, mt = v % nm, ntile = v / nm;
            q[0] = e; q[1] = mt * 256; q[2] = ntile * 256; q[3] = min(256, cn - mt * 256); q[4] = rs; q[5] = 1; } }
}
struct ProbGu {
    static constexpr int NT = 16; static constexpr size_t KS2 = 256; static constexpr unsigned ROWB = 2048; static constexpr bool I8 = true;
    static constexpr bool PERM = true;
    const signed char* A; const signed char* Bt; unsigned char* act; const float* bgu; const int* list; const float* sa; const float* sw; MoeTab tab; int G, vcu;
    __device__ __forceinline__ bool next(int i, Unit& u) const { return tab.find_i(i, u); }
    __device__ __forceinline__ void a_offs(const Unit& u, const int (&R)[2], const int (&C2)[2], unsigned (&v)[2][2]) const {
#pragma unroll
        for (int h = 0; h < 2; ++h)
#pragma unroll
            for (int i = 0; i < 2; ++i) { int r = h * 128 + R[i]; r = r < u.cnt ? r : 0; const int a = list[(size_t)u.e * T_ + u.m0 + r]; v[h][i] = (unsigned)(a >> 2) * 2048u + (unsigned)C2[i]; } }
    __device__ __forceinline__ const char* a_base() const { return (const char*)A; }
    __device__ __forceinline__ const char* b_base(const Unit& u) const { return (const char*)(Bt + ((size_t)u.e * 4096 + u.n0) * 2048); }
    __device__ __forceinline__ void epi(const i32x4 (&acc)[2][2][4][2], const Unit& u, int wr, int wc, int fr, int fq, LAS unsigned char* lds) const {
        const float* bb = bgu + (size_t)u.e * 4096; const float* ss = sw + (size_t)u.e * 4096;
        LAS unsigned char* ep = lds + EP_OFF + wr * EP_GRP;
        const int tg = ep_tid() & 255, rrow = tg >> 4, ch = tg & 15;
        f32x4 b0[2], b1[2], s0[2], s1[2];
#pragma unroll
        for (int bj = 0; bj < 2; ++bj) { const int col = u.n0 + bj * 128 + wc * 32 + fq * 8;
            b0[bj] = *(const f32x4*)(bb + col); b1[bj] = *(const f32x4*)(bb + col + 4); s0[bj] = *(const f32x4*)(ss + col); s1[bj] = *(const f32x4*)(ss + col + 4); }
        float srv[8];
        { int av[8];
#pragma unroll
          for (int q = 0; q < 8; ++q) { const int rl = (q >> 2) * 128 + wr * 64 + (q & 3) * 16 + fr; av[q] = list[(size_t)u.e * T_ + u.m0 + (rl < u.cnt ? rl : 0)]; }
#pragma unroll
          for (int q = 0; q < 8; ++q) srv[q] = sa[av[q] >> 2]; }
        LAS unsigned char* ep2 = lds + EP_OFF + wr * (2 * 4608);
#define GU_WRITE(st) do { const int ai_ = (st) >> 1, mp_ = (st) & 1; LAS unsigned char* eb = ep2 + ((st) & 1) * 4608; \
            _Pragma("unroll") for (int mm = 0; mm < 2; ++mm) { const int m_ = mp_ * 2 + mm; const float sr = srv[ai_ * 4 + m_]; \
                _Pragma("unroll") for (int bj = 0; bj < 2; ++bj) { const i32x4 i0 = acc[ai_][bj][m_][0], i1 = acc[ai_][bj][m_][1]; \
                    const f32x4 v0 = (f32x4){(float)i0[0], (float)i0[1], (float)i0[2], (float)i0[3]} * (s0[bj] * sr) + b0[bj], v1 = (f32x4){(float)i1[0], (float)i1[1], (float)i1[2], (float)i1[3]} * (s1[bj] * sr) + b1[bj]; \
                    *(LAS unsigned*)(eb + (mm * 16 + fr) * 144 + (bj * 64 + wc * 16 + fq * 4)) = pk4_fp8(swiglu_fast(v0[0], v0[1]), swiglu_fast(v0[2], v0[3]), swiglu_fast(v1[0], v1[1]), swiglu_fast(v1[2], v1[3])); } } } while (0)
        GU_WRITE(0);
        ep_sync();
#pragma unroll
        for (int st = 0; st < 4; ++st) {
            if (st + 1 < 4) GU_WRITE(st + 1);
#pragma unroll
            for (int mm = 0; mm < 2; ++mm) { const u32x2 x0 = *(const LAS u32x2*)(ep2 + (st & 1) * 4608 + (mm * 16 + rrow) * 144 + ch * 8);
                const int rr = (st >> 1) * 128 + wr * 64 + ((st & 1) * 2 + mm) * 16 + rrow;
                if (rr < u.cnt) *(u32x2*)(act + (size_t)(u.rbase + u.m0 + rr) * 2048 + (u.n0 >> 1) + ch * 8) = x0; }
            ep_sync();
        }
#undef GU_WRITE
    }
};
struct ProbDn {
    static constexpr int NT = 16; static constexpr size_t KS2 = 256; static constexpr unsigned ROWB = 2048; static constexpr bool I8 = true;
    static constexpr bool PERM = true;
    const signed char* A; const signed char* Bt; unsigned char* y; const float* bdn; const int* list; const float* gate; const float* sa; const float* sw; MoeTab tab; int G, vcu;
    __device__ __forceinline__ bool next(int i, Unit& u) const { return tab.find_i(i, u); }
    __device__ __forceinline__ void a_offs(const Unit& u, const int (&R)[2], const int (&C2)[2], unsigned (&v)[2][2]) const {
#pragma unroll
        for (int h = 0; h < 2; ++h)
#pragma unroll
            for (int i = 0; i < 2; ++i) v[h][i] = (unsigned)(u.rbase + u.m0 + h * 128 + R[i]) * 2048u + (unsigned)C2[i]; }
    __device__ __forceinline__ const char* a_base() const { return (const char*)A; }
    __device__ __forceinline__ const char* b_base(const Unit& u) const { return (const char*)(Bt + ((size_t)u.e * 2048 + u.n0) * 2048); }
    __device__ __forceinline__ void epi(const i32x4 (&acc)[2][2][4][2], const Unit& u, int wr, int wc, int fr, int fq, LAS unsigned char* lds) const {
        const float* bb = bdn + (size_t)u.e * 2048; const float* ss = sw + (size_t)u.e * 2048;
        LAS unsigned char* ep = lds + EP_OFF + wr * (2 * 4352);
        const int tg = ep_tid() & 255, rrow = tg >> 4, ch = tg & 15;
        f32x4 b0[2], b1[2], s0[2], s1[2];
#pragma unroll
        for (int bj = 0; bj < 2; ++bj) { const int col = u.n0 + bj * 128 + wc * 32 + fq * 8;
            b0[bj] = *(const f32x4*)(bb + col); b1[bj] = *(const f32x4*)(bb + col + 4); s0[bj] = *(const f32x4*)(ss + col); s1[bj] = *(const f32x4*)(ss + col + 4); }
        float gv[8], srv[8]; int a2v[8];
        { int av[8];
#pragma unroll
          for (int q = 0; q < 8; ++q) { const int rl = (q >> 2) * 128 + wr * 64 + (q & 3) * 16 + fr, rc = rl < u.cnt ? rl : 0; av[q] = list[(size_t)u.e * T_ + u.m0 + rc]; srv[q] = sa[u.rbase + u.m0 + rc];
              const int rr = (q >> 2) * 128 + wr * 64 + (q & 3) * 16 + rrow; a2v[q] = list[(size_t)u.e * T_ + u.m0 + (rr < u.cnt ? rr : 0)]; }
#pragma unroll
          for (int q = 0; q < 8; ++q) gv[q] = gate[av[q]]; }
#define DN_WRITE(st) do { const int ai_ = (st) >> 2, m_ = (st) & 3; const float g = gv[st] * 16.f, sr = srv[st]; LAS unsigned char* eb = ep + ((st) & 1) * 4352; \
            _Pragma("unroll") for (int bj = 0; bj < 2; ++bj) { const i32x4 i0 = acc[ai_][bj][m_][0], i1 = acc[ai_][bj][m_][1]; \
                const f32x4 v0 = ((f32x4){(float)i0[0], (float)i0[1], (float)i0[2], (float)i0[3]} * (s0[bj] * sr) + b0[bj]) * g, v1 = ((f32x4){(float)i1[0], (float)i1[1], (float)i1[2], (float)i1[3]} * (s1[bj] * sr) + b1[bj]) * g; \
                u32x2 o; o[0] = pk4_fp8(v0[0], v0[1], v0[2], v0[3]); o[1] = pk4_fp8(v1[0], v1[1], v1[2], v1[3]); \
                *(LAS u32x2*)(eb + fr * 272 + (bj * 128 + wc * 32 + fq * 8)) = o; } } while (0)
        DN_WRITE(0);
        ep_sync();
#pragma unroll
        for (int st = 0; st < 8; ++st) {
            if (st + 1 < 8) DN_WRITE(st + 1);
            const int rr = (st >> 2) * 128 + wr * 64 + (st & 3) * 16 + rrow;
            const u32x4 x0 = *(const LAS u32x4*)(ep + (st & 1) * 4352 + rrow * 272 + ch * 16);
            if (rr < u.cnt) *(u32x4*)(y + (size_t)a2v[st] * 2048 + u.n0 + ch * 16) = x0;
            ep_sync();
        }
#undef DN_WRITE
    }
};
}

namespace at8 {
typedef float f32x16 __attribute__((ext_vector_type(16)));
typedef short s16x4 __attribute__((ext_vector_type(4)));
typedef unsigned u32x4 __attribute__((ext_vector_type(4)));
constexpr int SHM_V = 64 * 128 * 2, SHM_K = 64 * 128 * 2;
constexpr int LDS_WS = 2 * SHM_V + 2 * SHM_K;
constexpr int LDS_END = LDS_WS + 8 * 64 * 4;
constexpr float CEXP = ATT_SCALE * 1.4426950408889634f;
constexpr float THR_RAW = 8.f / ATT_SCALE;
#define AT_KSWZ(row, colB) ((row) * 256 + ((colB) ^ (((row) & 7) << 4)))
#define AT_SBAR() __builtin_amdgcn_sched_barrier(0)
__device__ __forceinline__ int crow(int r, int hi) { return (r & 3) + 8 * (r >> 2) + 4 * hi; }
__device__ __forceinline__ unsigned cvtpk(float lo, float hi) { auto v = __builtin_amdgcn_cvt_pkrtz(lo, hi); return *reinterpret_cast<unsigned*>(&v); }
__device__ __forceinline__ int v_st(int k, int c) { const int kk = (k & ~0xC) | ((k & 4) << 1) | ((k & 8) >> 1); return ((kk >> 3) * 4 + (c >> 5)) * 512 + ((kk & 7) * 32 + (c & 31)) * 2; }
__device__ __forceinline__ int v_rd_base(int lane) { return ((lane & 3) << 3) | (((lane >> 2) & 3) << 6) | (((lane >> 4) & 1) << 5) | (((lane >> 5) & 1) << 8); }
constexpr int v_rd_off(int d0, int ks, int half) { return d0 * 512 + ks * 4096 + half * 2048; }
template <int OFF> __device__ __forceinline__ s16x4 tr_read(int vb) { s16x4 r; asm volatile("ds_read_b64_tr_b16 %0, %1 offset:%2" : "=&v"(r) : "v"(vb), "i"(OFF) : "memory"); return r; }
__device__ __forceinline__ h8 mk8(s16x4 l, s16x4 h) { typedef short s16x8 __attribute__((ext_vector_type(8))); s16x8 w = {l[0], l[1], l[2], l[3], h[0], h[1], h[2], h[3]}; return *reinterpret_cast<h8*>(&w); }
struct VFrag { s16x4 l0, h0, l1, h1, l2, h2, l3, h3; };
template <int D0> __device__ __forceinline__ void pv_read(VFrag& f, int vb) {
    f.l0 = tr_read<v_rd_off(D0, 0, 0)>(vb); f.h0 = tr_read<v_rd_off(D0, 0, 1)>(vb); f.l1 = tr_read<v_rd_off(D0, 1, 0)>(vb); f.h1 = tr_read<v_rd_off(D0, 1, 1)>(vb);
    f.l2 = tr_read<v_rd_off(D0, 2, 0)>(vb); f.h2 = tr_read<v_rd_off(D0, 2, 1)>(vb); f.l3 = tr_read<v_rd_off(D0, 3, 0)>(vb); f.h3 = tr_read<v_rd_off(D0, 3, 1)>(vb);
}
__device__ __forceinline__ void pv_mma(f32x16& od, const VFrag& f, h8 pa0, h8 pa1, h8 pa2, h8 pa3) {
    od = __builtin_amdgcn_mfma_f32_32x32x16_f16(pa0, mk8(f.l0, f.h0), od, 0, 0, 0);
    od = __builtin_amdgcn_mfma_f32_32x32x16_f16(pa1, mk8(f.l1, f.h1), od, 0, 0, 0);
    od = __builtin_amdgcn_mfma_f32_32x32x16_f16(pa2, mk8(f.l2, f.h2), od, 0, 0, 0);
    od = __builtin_amdgcn_mfma_f32_32x32x16_f16(pa3, mk8(f.l3, f.h3), od, 0, 0, 0);
}
__device__ __forceinline__ void pv_d0(f32x16 (&o)[4], int vb, h8 pa0, h8 pa1, h8 pa2, h8 pa3) {
    VFrag fa, fb;
    pv_read<0>(fa, vb); pv_read<1>(fb, vb);
    asm volatile("s_waitcnt lgkmcnt(8)" ::: "memory"); AT_SBAR();
    pv_mma(o[0], fa, pa0, pa1, pa2, pa3); AT_SBAR();
    pv_read<2>(fa, vb);
    asm volatile("s_waitcnt lgkmcnt(8)" ::: "memory"); AT_SBAR();
    pv_mma(o[1], fb, pa0, pa1, pa2, pa3); AT_SBAR();
    pv_read<3>(fb, vb);
    asm volatile("s_waitcnt lgkmcnt(8)" ::: "memory"); AT_SBAR();
    pv_mma(o[2], fa, pa0, pa1, pa2, pa3); AT_SBAR();
    asm volatile("s_waitcnt lgkmcnt(0)" ::: "memory"); AT_SBAR();
    pv_mma(o[3], fb, pa0, pa1, pa2, pa3);
}
__device__ __forceinline__ void qkt(f32x16& p0, f32x16& p1, const char* Ks, const h8 (&qr)[8], int r32, int hi) {
    p0 = f32x16{}; p1 = f32x16{};
#pragma unroll
    for (int d0 = 0; d0 < 8; ++d0) { const int cb = (d0 * 16 + hi * 8) * 2;
        const h8 b0 = *reinterpret_cast<const h8*>(Ks + AT_KSWZ(r32, cb));
        const h8 b1 = *reinterpret_cast<const h8*>(Ks + AT_KSWZ(32 + r32, cb));
        p0 = __builtin_amdgcn_mfma_f32_32x32x16_f16(b0, qr[d0], p0, 0, 0, 0);
        p1 = __builtin_amdgcn_mfma_f32_32x32x16_f16(b1, qr[d0], p1, 0, 0, 0); }
}
__device__ __forceinline__ void pack_p(const f32x16& p0, const f32x16& p1, h8& pa0, h8& pa1, h8& pa2, h8& pa3) {
#define AT_PK4(P, BASE, OUT) do { unsigned a0 = cvtpk(P[BASE + 0], P[BASE + 1]), a1 = cvtpk(P[BASE + 2], P[BASE + 3]); \
    unsigned b0 = cvtpk(P[BASE + 4], P[BASE + 5]), b1 = cvtpk(P[BASE + 6], P[BASE + 7]); \
    auto r0 = __builtin_amdgcn_permlane32_swap(a0, b0, false, false); auto r1 = __builtin_amdgcn_permlane32_swap(a1, b1, false, false); \
    u32x4 w = {r0[0], r1[0], r0[1], r1[1]}; OUT = *reinterpret_cast<h8*>(&w); } while (0)
    AT_PK4(p0, 0, pa0); AT_PK4(p0, 8, pa1); AT_PK4(p1, 0, pa2); AT_PK4(p1, 8, pa3);
#undef AT_PK4
}
__device__ __forceinline__ float half_swap_max(float v) { auto rr = __builtin_amdgcn_permlane32_swap(__float_as_uint(v), __float_as_uint(v), false, false); return fmaxf(__uint_as_float(rr[0]), __uint_as_float(rr[1])); }
__device__ __forceinline__ float half_swap_sum(float v) { auto rr = __builtin_amdgcn_permlane32_swap(__float_as_uint(v), __float_as_uint(v), false, false); return __uint_as_float(rr[0]) + __uint_as_float(rr[1]); }

struct Stage4 { h8 vs0, vs1, ks0, ks1; };
__device__ __forceinline__ int hidden_tid() { int tz = threadIdx.x; asm volatile("" : "+v"(tz)); return tz; }
__device__ __forceinline__ void sload(Stage4& s, const _Float16* Kb, const _Float16* Vb, int ld, int k0) {
    const int tz = hidden_tid(), sr = tz >> 4, sc = (tz & 15) * 8;
    s.vs0 = *(const h8*)(Vb + (size_t)(k0 + sr) * ld + sc); s.vs1 = *(const h8*)(Vb + (size_t)(k0 + 32 + sr) * ld + sc);
    s.ks0 = *(const h8*)(Kb + (size_t)(k0 + sr) * ld + sc); s.ks1 = *(const h8*)(Kb + (size_t)(k0 + 32 + sr) * ld + sc);
}
__device__ __forceinline__ void swrite(const Stage4& s, char* V_lds, char* K_lds, int b) {
    const int tz = hidden_tid(), sr = tz >> 4, sc = (tz & 15) * 8, vst0 = v_st(sr, sc), vst1 = v_st(32 + sr, sc);
    *(h8*)(V_lds + b * SHM_V + vst0) = s.vs0; *(h8*)(V_lds + b * SHM_V + vst1) = s.vs1;
    const int kc = sc * 2;
    *(h8*)(K_lds + b * SHM_K + AT_KSWZ(sr, kc)) = s.ks0; *(h8*)(K_lds + b * SHM_K + AT_KSWZ(32 + sr, kc)) = s.ks1;
}

__device__ __forceinline__ void attn_unit(char* lds, const _Float16* qrow, const _Float16* Kb, const _Float16* Vb, int ld, unsigned tmask, int wlen, int khi, unsigned selmask,
                                          _Float16* outw, int ostride) {
    const int tid = threadIdx.x, wid = __builtin_amdgcn_readfirstlane(tid >> 6), lane = tid & 63, r32 = lane & 31, hi = lane >> 5;
    char* V_lds = lds; char* K_lds = lds + 2 * SHM_V;
    float* wsf = (float*)(lds + LDS_WS) + wid * 64; float* li_l = wsf; float* al_l = wsf + 32;
    float m_reg = -1e30f, l_reg = 0.f; f32x16 o[4] = {}; h8 qr[8];
#pragma unroll
    for (int d0 = 0; d0 < 8; ++d0) qr[d0] = *(const h8*)(qrow + d0 * 16);
    const int vb0 = (int)(uintptr_t)V_lds + v_rd_base(lane);
    Stage4 st;
    unsigned rest = tmask; int j = __ffs(rest) - 1; rest &= rest - 1;
    sload(st, Kb, Vb, ld, j * 64); asm volatile("s_waitcnt vmcnt(0)" ::: "memory"); swrite(st, V_lds, K_lds, 0); __syncthreads();
    int buf = 0;
    for (;;) {
        const int jn = rest ? (__ffs(rest) - 1) : -1;
        if (jn >= 0) sload(st, Kb, Vb, ld, jn * 64);
        f32x16 p0, p1;
        AT_SBAR(); qkt(p0, p1, K_lds + buf * SHM_K, qr, r32, hi);
        { const int klo = wlen > 0 ? khi - wlen + 1 : 0; const bool tb = (selmask >> j) & 1u; const bool inr = (j * 64 >= klo) && (j * 64 + 63 <= khi);
          if (!__all(tb && inr)) {
              if (__all(inr)) {
#pragma unroll
                  for (int r = 0; r < 16; ++r) { p0[r] = tb ? p0[r] : -INFINITY; p1[r] = tb ? p1[r] : -INFINITY; }
              } else {
                  const int kb = j * 64 + 4 * hi;
#pragma unroll
                  for (int r = 0; r < 16; ++r) { const int k0 = kb + (r & 3) + 8 * (r >> 2);
                      p0[r] = (tb && k0 >= klo && k0 <= khi) ? p0[r] : -INFINITY;
                      p1[r] = (tb && (k0 + 32) >= klo && (k0 + 32) <= khi) ? p1[r] : -INFINITY; }
              } } }
        float pmax = p0[0];
#pragma unroll
        for (int r = 1; r < 16; ++r) pmax = fmaxf(pmax, p0[r]);
#pragma unroll
        for (int r = 0; r < 16; ++r) pmax = fmaxf(pmax, p1[r]);
        pmax = half_swap_max(pmax);
        float mn, alpha;
        if (__all(pmax - m_reg <= THR_RAW)) { mn = m_reg; alpha = 1.f; }
        else { mn = fmaxf(m_reg, pmax); alpha = __builtin_amdgcn_exp2f((m_reg - mn) * CEXP); m_reg = mn; }
        const float mnC = -mn * CEXP;
        float ps = 0.f;
#pragma unroll
        for (int r = 0; r < 16; ++r) { p0[r] = __builtin_amdgcn_exp2f(fmaf(p0[r], CEXP, mnC)); ps += p0[r]; }
#pragma unroll
        for (int r = 0; r < 16; ++r) { p1[r] = __builtin_amdgcn_exp2f(fmaf(p1[r], CEXP, mnC)); ps += p1[r]; }
        ps = half_swap_sum(ps);
        l_reg = l_reg * alpha + ps;
        if (__any(alpha < 1.f)) { if (hi == 0) al_l[r32] = alpha; asm volatile("s_waitcnt lgkmcnt(0)" ::: "memory");
#pragma unroll
            for (int r = 0; r < 16; ++r) { const float a = al_l[crow(r, hi)];
#pragma unroll
                for (int d = 0; d < 4; ++d) o[d][r] *= a; } }
        h8 pa0, pa1, pa2, pa3; pack_p(p0, p1, pa0, pa1, pa2, pa3);
        AT_SBAR();
        pv_d0(o, vb0 + buf * SHM_V, pa0, pa1, pa2, pa3);
        if (jn < 0) break;
        asm volatile("s_waitcnt vmcnt(0)" ::: "memory");
        swrite(st, V_lds, K_lds, buf ^ 1);
        __syncthreads();
        buf ^= 1; j = jn; rest &= rest - 1;
    }
    if (hi == 0) li_l[r32] = l_reg; asm volatile("s_waitcnt lgkmcnt(0)" ::: "memory");
#pragma unroll
    for (int r = 0; r < 16; ++r) { const int orow = crow(r, hi); const float l = li_l[orow]; const float rl = l > 0.f ? 1.f / l : 0.f;
#pragma unroll
        for (int d0 = 0; d0 < 4; ++d0) outw[(size_t)orow * ostride + d0 * 32 + r32] = (_Float16)(o[d0][r] * rl); }
    __syncthreads();
}

constexpr int LDS_AP = LDS_END, LDS_BP = LDS_AP + 4 * 64 * 33 * 4, LDS_SELM = LDS_BP + 4 * 64 * 33 * 4, LDS_CS_END = LDS_SELM + 64 * 4;
__device__ __forceinline__ void cmp_slc_unit(char* lds, const _Float16* qrow, const _Float16* Kc, const _Float16* Vc, const _Float16* Ks, const _Float16* Vs, int t, int tl, int g, int qi,
                                             _Float16* outc, _Float16* outs) {
    const int tid = threadIdx.x, wid = __builtin_amdgcn_readfirstlane(tid >> 6), lane = tid & 63, r32 = lane & 31, hi = lane >> 5;
    char* V_lds = lds; char* K_lds = lds + 2 * SHM_V;
    float* AP = (float*)(lds + LDS_AP); float* BP = (float*)(lds + LDS_BP); unsigned* selm = (unsigned*)(lds + LDS_SELM);
    {
        h8 qr[8];
#pragma unroll
        for (int d0 = 0; d0 < 8; ++d0) qr[d0] = *(const h8*)(qrow + d0 * 16);
        const int vb0 = (int)(uintptr_t)V_lds + v_rd_base(lane);
        { Stage4 s0, s1; sload(s0, Kc, Vc, 256, 0); sload(s1, Kc, Vc, 256, 64);
          asm volatile("s_waitcnt vmcnt(0)" ::: "memory");
          swrite(s0, V_lds, K_lds, 0); swrite(s1, V_lds, K_lds, 1); }
        __syncthreads();
        f32x16 pA0, pA1, pB0, pB1;
        AT_SBAR(); qkt(pA0, pA1, K_lds, qr, r32, hi); qkt(pB0, pB1, K_lds + SHM_K, qr, r32, hi);
        const int khi = t >= 31 ? ((t - 31) >> 4) : -1;
#pragma unroll
        for (int r = 0; r < 16; ++r) { const int c0 = 4 * hi + (r & 3) + 8 * (r >> 2);
            pA0[r] = (c0 <= khi) ? pA0[r] : -INFINITY; pA1[r] = (c0 + 32 <= khi) ? pA1[r] : -INFINITY;
            pB0[r] = (c0 + 64 <= khi) ? pB0[r] : -INFINITY; pB1[r] = (c0 + 96 <= khi) ? pB1[r] : -INFINITY; }
        float pmax = -INFINITY;
#pragma unroll
        for (int r = 0; r < 16; ++r) pmax = fmaxf(fmaxf(pmax, pA0[r]), fmaxf(pA1[r], fmaxf(pB0[r], pB1[r])));
        pmax = half_swap_max(pmax);
        const float mC = (pmax == -INFINITY) ? 0.f : -pmax * CEXP;
        float ps = 0.f;
#pragma unroll
        for (int r = 0; r < 16; ++r) { pA0[r] = __builtin_amdgcn_exp2f(fmaf(pA0[r], CEXP, mC)); pA1[r] = __builtin_amdgcn_exp2f(fmaf(pA1[r], CEXP, mC));
            pB0[r] = __builtin_amdgcn_exp2f(fmaf(pB0[r], CEXP, mC)); pB1[r] = __builtin_amdgcn_exp2f(fmaf(pB1[r], CEXP, mC)); ps += (pA0[r] + pA1[r]) + (pB0[r] + pB1[r]); }
        ps = half_swap_sum(ps);
        const float inv = ps > 0.f ? 1.f / ps : 0.f;
#pragma unroll
        for (int r = 0; r < 16; ++r) { pA0[r] *= inv; pA1[r] *= inv; pB0[r] *= inv; pB1[r] *= inv; }
        { float* ap = AP + (g * 64 + tl) * 33; float* bp = BP + (g * 64 + tl) * 33;
          if (hi == 0) bp[0] = 0.f;
#define AT_IMP(P, JB) do { _Pragma("unroll") for (int k = 0; k < 4; ++k) { const int j = (JB) + 2 * k + hi; \
              ap[j] = 2.f * (P[4 * k] + P[4 * k + 1] + P[4 * k + 2]) + P[4 * k + 3]; if (j + 1 < 32) bp[j + 1] = P[4 * k + 3]; } } while (0)
          AT_IMP(pA0, 0); AT_IMP(pA1, 8); AT_IMP(pB0, 16); AT_IMP(pB1, 24);
#undef AT_IMP
        }
        f32x16 o[4] = {};
        h8 pa0, pa1, pa2, pa3;
        pack_p(pA0, pA1, pa0, pa1, pa2, pa3); AT_SBAR(); pv_d0(o, vb0, pa0, pa1, pa2, pa3);
        pack_p(pB0, pB1, pa0, pa1, pa2, pa3); AT_SBAR(); pv_d0(o, vb0 + SHM_V, pa0, pa1, pa2, pa3);
#pragma unroll
        for (int r = 0; r < 16; ++r) { const int orow = crow(r, hi);
#pragma unroll
            for (int d0 = 0; d0 < 4; ++d0) outc[(size_t)orow * 1024 + d0 * 32 + r32] = (_Float16)o[d0][r]; }
    }
    __syncthreads();
#pragma unroll 1
    for (int it = 0; it < 4; ++it) {
        const int tk = 8 * wid + 2 * it + hi, j = r32;
        float imp = 0.f;
#pragma unroll
        for (int gg = 0; gg < 4; ++gg) imp += AP[(gg * 64 + tk) * 33 + j] + BP[(gg * 64 + tk) * 33 + j];
        const bool forced = (j == 0) || (j == qi) || (j == qi - 1), valid = j <= qi;
        const float iv = forced ? 1e9f : (valid ? imp : -1e9f);
        int rank = 0;
        for (int i = 0; i < 32; ++i) { const float vi = __shfl(iv, i + 32 * hi); rank += (vi > iv || (vi == iv && i < j)) ? 1 : 0; }
        const unsigned long long bal = __ballot(rank < 16 && valid);
        if (r32 == 0) selm[tk] = (unsigned)(bal >> (32 * hi));
    }
    __syncthreads();
    unsigned tm = selm[lane];
#pragma unroll
    for (int o = 32; o > 0; o >>= 1) tm |= __shfl_xor(tm, o);
    const int tz2 = hidden_tid();
    const unsigned mysel = selm[((tz2 >> 6) & 1) * 32 + (tz2 & 31)];
    attn_unit(lds, qrow, Ks, Vs, 128, tm, 0, t, mysel, outs, 1024);
}
}

struct CUnit { const float* W; int ldw; int nvalid; _Float16* Wt; int k0; int n0; };
__device__ __forceinline__ CUnit conv_desc(int u, const float* win, const float* w1k, const float* w1v, const float* wmkv, _Float16* wtin, _Float16* wt1, _Float16* wtmkv) {
    CUnit d;
    if (u < 480) { d.W = win; d.ldw = INW; d.nvalid = INW; d.Wt = wtin; d.k0 = (u / 15) * 64; d.n0 = (u % 15) * 256; }
    else if (u < 608) { const int v = u - 480, kv = v >> 6, part = (v >> 5) & 1, kt = v & 31;
        d.W = (kv ? w1v : w1k) + (size_t)part * 2048 * 256; d.ldw = 256; d.nvalid = 256; d.Wt = wt1 + ((size_t)kv * 512 + part * 256) * 2048; d.k0 = kt * 64; d.n0 = 0; }
    else { const int v = u - 608; d.W = wmkv; d.ldw = 1024; d.nvalid = 1024; d.Wt = wtmkv; d.k0 = (v >> 2) * 64; d.n0 = (v & 3) * 256; }
    return d;
}
__device__ __forceinline__ void conv_all(float* lds, const float* win, const float* w1k, const float* w1v, const float* wmkv, _Float16* wtin, _Float16* wt1, _Float16* wtmkv, int bid, int nb) {
    constexpr int NU = 480 + 128 + 128;
    const int tid = threadIdx.x;
    int u = bid; if (u >= NU) return;
    CUnit d = conv_desc(u, win, w1k, w1v, wmkv, wtin, wt1, wtmkv);
    float4 v[8];
#define CL(D) do { _Pragma("unroll") for (int i = 0; i < 8; ++i) { const int idx = tid + 512 * i, r = idx >> 6, c4 = (idx & 63) * 4; \
        v[i] = ((D).n0 + c4 < (D).nvalid) ? *(const float4*)((D).W + (size_t)((D).k0 + r) * (D).ldw + (D).n0 + c4) : make_float4(0.f, 0.f, 0.f, 0.f); } } while (0)
    CL(d);
    for (;;) {
#pragma unroll
        for (int i = 0; i < 8; ++i) { const int idx = tid + 512 * i, r = idx >> 6, c4 = (idx & 63) * 4; float* dd = lds + r * 257 + c4; dd[0] = v[i].x; dd[1] = v[i].y; dd[2] = v[i].z; dd[3] = v[i].w; }
        __syncthreads();
        const int un = u + nb; const bool has = un < NU;
        CUnit dn = d; if (has) { dn = conv_desc(un, win, w1k, w1v, wmkv, wtin, wt1, wtmkv); CL(dn); }
#pragma unroll
        for (int j = 0; j < 4; ++j) { const int id = tid + 512 * j, n = id >> 3, k8 = (id & 7) * 8; h8 o;
#pragma unroll
            for (int q = 0; q < 8; ++q) o[q] = (_Float16)lds[(k8 + q) * 257 + n];
            *(h8*)(d.Wt + (size_t)(d.n0 + n) * 2048 + d.k0 + k8) = o; }
        __syncthreads();
        if (!has) break;
        u = un; d = dn;
    }
#undef CL
}

__device__ __forceinline__ unsigned pack4_i8(float a, float b, float c, float d) {
    const int ia = __float2int_rn(a), ib = __float2int_rn(b), ic = __float2int_rn(c), id = __float2int_rn(d);
    return (unsigned)(ia & 255) | ((unsigned)(ib & 255) << 8) | ((unsigned)(ic & 255) << 16) | ((unsigned)(id & 255) << 24);
}
constexpr int QP_LD2 = 1026;
struct QUnit { const float* W; int ldw; int n0; signed char* Q; float* sc; };
__device__ __forceinline__ QUnit quant_desc(int u, const float* wgu, const float* wdn, signed char* q8gu, signed char* q8dn, float* sgu, float* sdn, const float* wout, signed char* q8out, float* sout) {
    QUnit d;
    if (u >= NE * 192) { const int pn = u - NE * 192; d.W = wout; d.ldw = 2048; d.n0 = pn * 32; d.Q = q8out; d.sc = sout; }
    else if (u < NE * 128) { const int e = u >> 7, pn = u & 127; d.W = wgu + (size_t)e * 2048 * 4096; d.ldw = 4096; d.n0 = pn * 32; d.Q = q8gu + (size_t)e * 4096 * 2048; d.sc = sgu + (size_t)e * 4096; }
    else { const int v = u - NE * 128, e = v >> 6, pn = v & 63; d.W = wdn + (size_t)e * 2048 * 2048; d.ldw = 2048; d.n0 = pn * 32; d.Q = q8dn + (size_t)e * 2048 * 2048; d.sc = sdn + (size_t)e * 2048; }
    return d;
}
__device__ __forceinline__ unsigned pk2h(float a, float b) { auto v = __builtin_amdgcn_cvt_pkrtz(a, b); return *reinterpret_cast<unsigned*>(&v); }
__device__ __forceinline__ void quant_all(char* smem, const float* wgu, const float* wdn, signed char* q8gu, signed char* q8dn, float* sgu, float* sdn, const float* wout, signed char* q8out, float* sout, int bid, int nb) {
    constexpr int NU = NE * 128 + NE * 64 + 64;
    unsigned* cmaxb = (unsigned*)smem;
    const int tid = threadIdx.x, c4 = (tid & 7) * 4, rg = tid >> 3;
    if (tid < 64) cmaxb[tid] = 0u;
    __syncthreads();
    int u = bid; if (u >= NU) return;
    QUnit d = quant_desc(u, wgu, wdn, q8gu, q8dn, sgu, sdn, wout, q8out, sout);
    float4 va[16], vb[16], vc[16];
#define QL(dst, D, half) do { const float* p0 = (D).W + (size_t)((half) * 1024 + rg * 16) * (D).ldw + (D).n0 + c4; _Pragma("unroll") for (int j = 0; j < 16; ++j) dst[j] = *(const float4*)(p0 + (size_t)j * (D).ldw); } while (0)
#define QM(src) do { _Pragma("unroll") for (int j = 0; j < 16; ++j) { m0 = fmaxf(m0, fabsf(src[j].x)); m1 = fmaxf(m1, fabsf(src[j].y)); m2 = fmaxf(m2, fabsf(src[j].z)); m3 = fmaxf(m3, fabsf(src[j].w)); } } while (0)
#define QS(src, half, comp, ci, inv) do { uint4 o; \
        o.x = pack4_i8(src[0].comp * inv, src[1].comp * inv, src[2].comp * inv, src[3].comp * inv); o.y = pack4_i8(src[4].comp * inv, src[5].comp * inv, src[6].comp * inv, src[7].comp * inv); \
        o.z = pack4_i8(src[8].comp * inv, src[9].comp * inv, src[10].comp * inv, src[11].comp * inv); o.w = pack4_i8(src[12].comp * inv, src[13].comp * inv, src[14].comp * inv, src[15].comp * inv); \
        *(uint4*)(d.Q + (size_t)(d.n0 + c4 + (ci)) * 2048 + (half) * 1024 + rg * 16) = o; } while (0)
    QL(va, d, 0);
    int par = 0;
    for (;;) {
        unsigned* cmax = cmaxb + par * 32;
        float m0 = 0.f, m1 = 0.f, m2 = 0.f, m3 = 0.f;
        QL(vb, d, 1);
        QM(va); QM(vb);
        atomicMax(&cmax[c4 + 0], __float_as_uint(m0)); atomicMax(&cmax[c4 + 1], __float_as_uint(m1)); atomicMax(&cmax[c4 + 2], __float_as_uint(m2)); atomicMax(&cmax[c4 + 3], __float_as_uint(m3));
        __syncthreads();
        const int un = u + nb; const bool has = un < NU;
        QUnit dn = d; if (has) { dn = quant_desc(un, wgu, wdn, q8gu, q8dn, sgu, sdn, wout, q8out, sout); QL(vc, dn, 0); }
        if (tid < 32) cmaxb[(par ^ 1) * 32 + tid] = 0u;
        const float x0 = __uint_as_float(cmax[c4 + 0]), x1 = __uint_as_float(cmax[c4 + 1]), x2 = __uint_as_float(cmax[c4 + 2]), x3 = __uint_as_float(cmax[c4 + 3]);
        const float i0 = x0 > 0.f ? 127.f / x0 : 0.f, i1 = x1 > 0.f ? 127.f / x1 : 0.f, i2 = x2 > 0.f ? 127.f / x2 : 0.f, i3 = x3 > 0.f ? 127.f / x3 : 0.f;
        QS(va, 0, x, 0, i0); QS(va, 0, y, 1, i1); QS(va, 0, z, 2, i2); QS(va, 0, w, 3, i3);
        QS(vb, 1, x, 0, i0); QS(vb, 1, y, 1, i1); QS(vb, 1, z, 2, i2); QS(vb, 1, w, 3, i3);
        if (tid < 32) { const float mx = __uint_as_float(cmax[tid]); d.sc[d.n0 + tid] = mx > 0.f ? mx / 127.f : 1.f; }
        if (!has) break;
#pragma unroll
        for (int j = 0; j < 16; ++j) va[j] = vc[j];
        u = un; d = dn; par ^= 1;
        __syncthreads();
    }
    __syncthreads();
#undef QL
#undef QM
#undef QS
}

__global__ void __launch_bounds__(512, 2) fwd(Params p) {
    extern __shared__ __attribute__((aligned(16))) char smem[];
    const int tid = threadIdx.x, wv = __builtin_amdgcn_readfirstlane(tid >> 6);
#define LANE_NOW ({ int _t = threadIdx.x; asm volatile("" : "+v"(_t)); _t & 63; })
    const int bid = blockIdx.x, nb = gridDim.x;
    const int gw = bid * 8 + wv, nw = nb * 8;
    const int lo = (int)(p.lo_hi & 0xffffffffll), hi = (int)(p.lo_hi >> 32);
    unsigned char* ws = p.ws;
    unsigned* ctl = (unsigned*)(ws + WS_CTL);
    int* cnt = (int*)(ws + CTL_CNT);
    float* proj = (float*)(ws + WS_PROJ);
    float* kvmem = (float*)(ws + WS_KVMEM);
    float* bias1 = (float*)(ws + WS_BIAS1);
    float* hid = (float*)(ws + WS_HID);
    float* kc = (float*)(ws + WS_KC);
    float* vc = (float*)(ws + WS_VC);
    float* pooled = (float*)(ws + WS_POOLED);
    _Float16* opool = (_Float16*)(ws + WS_OPOOL);
    _Float16* owin = (_Float16*)(ws + WS_OWIN);
    _Float16* ocmp = (_Float16*)(ws + WS_OCMP);
    _Float16* oslc = (_Float16*)(ws + WS_OSLC);
    unsigned* sel = (unsigned*)(ws + WS_SEL);
    _Float16* omem = (_Float16*)(ws + WS_OMEM);
    _Float16* cat16 = (_Float16*)(ws + WS_CAT16);
    _Float16* hpre16 = (_Float16*)(ws + WS_HPRE);
    float* hbuf = (float*)(ws + WS_H);
    float* gate = (float*)(ws + WS_GATE);
    int* list = (int*)(ws + WS_LIST);
    unsigned char* actf8 = (unsigned char*)(ws + WS_ACT16);
    unsigned char* yf8 = (unsigned char*)(ws + WS_Y16);
    _Float16* h16 = (_Float16*)(ws + WS_H16);
    _Float16* x16 = (_Float16*)(ws + WS_X16);
    _Float16* wtin = (_Float16*)(ws + WS_WTIN);
    _Float16* wtout = (_Float16*)(ws + WS_WTOUT);
    _Float16* wtgu = (_Float16*)(ws + WS_WTGU);
    _Float16* wtdn = (_Float16*)(ws + WS_WTDN);
    LAS unsigned char* lds = (LAS unsigned char*)smem;
    _Float16* proj16 = (_Float16*)(ws + WS_PROJ16);
    _Float16* kvmem16 = (_Float16*)(ws + WS_KVMEM16);
    _Float16* wt1 = (_Float16*)(ws + WS_WT1);
    float* uv = (float*)(ws + WS_UV);
    _Float16* kc16 = (_Float16*)(ws + WS_KC16);
    _Float16* vc16 = (_Float16*)(ws + WS_VC16);
    _Float16* wr16 = (_Float16*)(ws + WS_WR16);
    _Float16* mem16 = (_Float16*)(ws + WS_MEM16);
    _Float16* wtmkv = (_Float16*)(ws + WS_WTMKV);
    _Float16* kv16 = (_Float16*)(ws + WS_KV16);
    _Float16* wt2 = (_Float16*)(ws + WS_WT2);
    signed char* q8out = (signed char*)(ws + WS_Q8OUT); float* sout = (float*)(ws + WS_SOUT); signed char* cat8 = (signed char*)(ws + WS_CAT8); float* scat = (float*)(ws + WS_SCAT);
    signed char* q8gu = (signed char*)(ws + WS_Q8GU); signed char* q8dn = (signed char*)(ws + WS_Q8DN);
    float* sgu = (float*)(ws + WS_SGU); float* sdn = (float*)(ws + WS_SDN);
    signed char* h8q = (signed char*)(ws + WS_H8); float* sah = (float*)(ws + WS_SAH);
    signed char* act8 = (signed char*)(ws + WS_ACT8); float* sact = (float*)(ws + WS_SACT);
    const int vcu = (nb % 8 == 0) ? (bid % 8) * (nb / 8) + bid / 8 : bid;

    volatile LAS unsigned* xbw = (volatile LAS unsigned*)(smem + LDS_BYTES - 16);
    if (tid == 0) { xbw[0] = 0u; xbw[1] = 0u; xbw[2] = 0u; xbw[3] = 0u; }
    __syncthreads();
    XcdBarrier bar; bar.bar = ctl; bar.x = 0; bar.st = xbw;
    const bool multi = (hi - lo) > 1;
    if (multi) bar = xcd_barrier_post(ctl, xbw);
#define IN(k) (lo <= (k) && (k) < hi)
#define SEAM(k) do { if (IN(k) && IN((k) + 1)) xcd_barrier(bar); } while (0)
    float* sw = (float*)smem + wv * WLDS_FLOATS;
    int* segw = (int*)(sw + 4096 + 512);

    if (IN(0)) {
        const int lane = LANE_NOW; (void)lane;
        if (wv == 0 && (bid & 1) == 0 && (bid >> 1) < 128) {
            const int task = bid >> 1, kv = task >> 6, jg = (task >> 4) & 3, kc = task & 15;
            const float* pos = p.in[kv ? I_POSV : I_POSK] + kc * 256; const float* w1 = p.in[kv ? I_W1V : I_W1K] + (size_t)kc * 256 * 256 + jg * 64 + lane;
            float s0 = 0.f, s1 = 0.f, s2 = 0.f, s3 = 0.f;
            for (int k = 0; k < 256; k += 4) { s0 += pos[k] * w1[(size_t)k * 256]; s1 += pos[k + 1] * w1[(size_t)(k + 1) * 256]; s2 += pos[k + 2] * w1[(size_t)(k + 2) * 256]; s3 += pos[k + 3] * w1[(size_t)(k + 3) * 256]; }
            bias1[(kv * 16 + kc) * 256 + jg * 64 + lane] = (s0 + s1) + (s2 + s3);
        }
        for (int i = bid * 512 + tid; i < 2 * 128 * 256; i += nb * 512) { const int kv = i >> 15, d = (i >> 8) & 127, n = i & 255; wt2[i] = (_Float16)p.in[kv ? I_W2V : I_W2K][(size_t)n * 128 + d]; }
        for (int i = bid * 512 + tid; i < 32 * 2048; i += nb * 512) { const int e = i >> 11, d = i & 2047; wr16[i] = (_Float16)p.in[I_WR][(size_t)d * 32 + e]; }
        {
            const size_t n4 = (size_t)T_ * 2048 / 4, stride = (size_t)nb * 512;
            for (size_t i0 = (size_t)bid * 512 + tid; i0 < n4; i0 += stride * 8) {
                float4 v[8];
#pragma unroll
                for (int q = 0; q < 8; ++q) { const size_t i = i0 + stride * q; v[q] = i < n4 ? ((const float4*)p.in[I_X])[i] : make_float4(0.f, 0.f, 0.f, 0.f); }
#pragma unroll
                for (int q = 0; q < 8; ++q) { const size_t i = i0 + stride * q; if (i < n4) ((h4*)x16)[i] = (h4){(_Float16)v[q].x, (_Float16)v[q].y, (_Float16)v[q].z, (_Float16)v[q].w}; }
            }
        }
        {
            quant_all(smem, p.in[I_WGU], p.in[I_WDN], q8gu, q8dn, sgu, sdn, p.in[I_WOUT], q8out, sout, bid, nb);
            __syncthreads();
            conv_all((float*)smem, p.in[I_WIN], p.in[I_W1K], p.in[I_W1V], p.in[I_WMEMKV], wtin, wt1, wtmkv, bid, nb);
            __syncthreads();
        }
        for (size_t i = (size_t)bid * 512 + tid; i < (size_t)2048 * 2048 / 4; i += (size_t)nb * 512) {
            const float4 v = ((const float4*)p.in[I_MEM])[i]; ((h4*)mem16)[i] = (h4){(_Float16)v.x, (_Float16)v.y, (_Float16)v.z, (_Float16)v.w};
        }
    }
    SEAM(0);
    if (IN(1)) {
        const int lane = LANE_NOW; (void)lane;
        g8::ProbIn P{x16, proj16, nb, bid};
        g8::gemm_phase(lds, P);
    }
    SEAM(1);
    if (IN(2)) {
        const int lane = LANE_NOW; (void)lane;
        { g8::ProbCmp P{kv16, wt1, uv, nb, bid}; g8::gemm_phase(lds, P); __syncthreads(); }
        for (int i = bid * 512 + tid; i < T_ * 64; i += nb * 512) {
            const int chn = i & 63, row = i >> 6, t = row & (S_ - 1), g = chn >> 4;
            const int win = 2 << g, n = min(win, t + 1);
            const _Float16* src = proj16 + (size_t)row * INW + C_UP + chn * 8;
            float a[8];
            const h8 cur = *(const h8*)src;
            h8 vv[15];
#pragma unroll
            for (int k = 0; k < 15; ++k) { vv[k] = (h8){0, 0, 0, 0, 0, 0, 0, 0}; if (k + 1 < n) vv[k] = *(const h8*)(src - (size_t)(k + 1) * INW); }
#pragma unroll
            for (int q = 0; q < 8; ++q) a[q] = (float)cur[q];
#pragma unroll
            for (int k = 0; k < 15; ++k) {
#pragma unroll
                for (int q = 0; q < 8; ++q) a[q] += (float)vv[k][q]; }
            const float rn = 1.f / (float)n;
            float4 o0, o1;
            o0.x = a[0] * rn - (float)cur[0]; o0.y = a[1] * rn - (float)cur[1]; o0.z = a[2] * rn - (float)cur[2]; o0.w = a[3] * rn - (float)cur[3];
            o1.x = a[4] * rn - (float)cur[4]; o1.y = a[5] * rn - (float)cur[5]; o1.z = a[6] * rn - (float)cur[6]; o1.w = a[7] * rn - (float)cur[7];
            *(float4*)(pooled + (size_t)row * 512 + chn * 8) = o0; *(float4*)(pooled + (size_t)row * 512 + chn * 8 + 4) = o1;
        }
        {
            const int r32 = lane & 31, hi = lane >> 5, g = wv >> 1, half = wv & 1;
            for (int uu = vcu; uu < 512; uu += nb) {
                const int v = uu & 255, bk = v >> 4, qi = (uu >> 8) ? 31 - (v & 15) : (v & 15), b = bk >> 1, kvh = bk & 1;
                const int t = qi * 64 + half * 32 + r32;
                const int lo_t = max(0, qi - 8);
                const unsigned tmask = (unsigned)(((1ull << (qi + 1)) - 1ull) & ~((1ull << lo_t) - 1ull));
                at8::attn_unit(smem, proj16 + (size_t)(b * S_ + t) * INW + C_Q + (kvh * 4 + g) * 128 + hi * 8,
                               kv16 + ((size_t)(4 * B_ + b) * 2 + kvh) * KVSEG, kv16 + ((size_t)(5 * B_ + b) * 2 + kvh) * KVSEG, 128, tmask, 512, t, 0xffffffffu,
                               owin + (size_t)(b * S_ + qi * 64 + half * 32) * 1024 + (kvh * 4 + g) * 128, 1024);
            }
            for (int u = vcu; u < 256; u += nb) {
                const int b = u >> 5, h = (u >> 3) & 3, qt = u & 7;
                const int t = qt * 256 + wv * 32 + r32;
                at8::attn_unit(smem, proj16 + (size_t)(b * S_ + t) * INW + C_QM + h * 128 + hi * 8,
                               kvmem16 + (size_t)b * 256 * 1024 + h * 128, kvmem16 + (size_t)b * 256 * 1024 + 512 + h * 128, 1024, 0xFu, 0, 255, 0xffffffffu,
                               omem + (size_t)(b * S_ + qt * 256 + wv * 32) * 512 + h * 128, 512);
            }
        }
    }
    SEAM(2);
    if (IN(3)) {
        const int lane = LANE_NOW; (void)lane;
        {
            float* bsum = (float*)smem;
            _Float16* hs = (_Float16*)(smem + 4096);
            { const int kv = tid >> 8, n = tid & 255; float a = 0.f;
#pragma unroll
              for (int kc = 0; kc < 16; ++kc) a += bias1[(kv * 16 + kc) * 256 + n];
              bsum[tid] = a; }
            __syncthreads();
            const int fr = lane & 15, fq = lane >> 4;
            for (int u = bid; u < 256; u += nb) {
                const int kv = u >> 7, rt = u & 127;
#pragma unroll
                for (int q = 0; q < 8; ++q) { const int e = tid + 512 * q, i = e >> 8, n = e & 255;
                    const int row = rt * 16 + i, c = (row >> 1) & 127;
                    float a = 0.f;
                    if (c != 127) { a = bsum[kv * 256 + n];
#pragma unroll
                        for (int sp = 0; sp < 4; ++sp) { const float* base = uv + ((size_t)(kv * 4 + sp) * 2048) * 512; a += base[(size_t)row * 512 + n] + base[(size_t)(row + 2) * 512 + 256 + n]; }
                        a = gelu_fast(a); }
                    hs[i * 264 + n] = (_Float16)a; }
                __syncthreads();
                { const _Float16* bp = wt2 + ((size_t)kv * 128 + wv * 16 + fr) * 256 + fq * 8;
                  f4 acc = (f4){0.f, 0.f, 0.f, 0.f};
#pragma unroll
                  for (int sI = 0; sI < 8; ++sI) { const h8 a = *(const h8*)(hs + fr * 264 + sI * 32 + fq * 8), bb = *(const h8*)(bp + sI * 32); acc = __builtin_amdgcn_mfma_f32_16x16x32_f16(a, bb, acc, 0, 0, 0); }
                  _Float16* dst = kv ? vc16 : kc16;
#pragma unroll
                  for (int j = 0; j < 4; ++j) { const int row = rt * 16 + fq * 4 + j; dst[(size_t)row * 128 + wv * 16 + fr] = (((row >> 1) & 127) == 127) ? (_Float16)0.f : (_Float16)acc[j]; } }
                __syncthreads();
            }
        }
        for (int u = bid; u < 128 * 4; u += nb) { const int g = u >> 7, mt = u & 127;
            ARowPlain af{pooled + g * 128, 512, mt * 128, T_}; EpiPool ef{opool, p.in[I_POOLS], mt * 128, g};
            gemm_tile(smem, 128, af, p.in[I_POOLW] + (size_t)g * 128 * 128, 128, 0, 128, false, ef);
        }
    }
    SEAM(3);
    if (IN(4)) {
        const int lane = LANE_NOW; (void)lane;
        const int r32 = lane & 31, hi = lane >> 5, g = wv >> 1, half = wv & 1;
        for (int uu = vcu; uu < 512; uu += nb) {
            const int v = uu & 255, bk = v >> 4, qi = (uu >> 8) ? 31 - (v & 15) : (v & 15), b = bk >> 1, kvh = bk & 1;
            const int tl = half * 32 + r32, t = qi * 64 + tl;
            at8::cmp_slc_unit(smem, proj16 + (size_t)(b * S_ + t) * INW + C_Q + (kvh * 4 + g) * 128 + hi * 8,
                              kc16 + (size_t)(b * 128 * 2 + kvh) * 128, vc16 + (size_t)(b * 128 * 2 + kvh) * 128,
                              kv16 + ((size_t)(2 * B_ + b) * 2 + kvh) * KVSEG, kv16 + ((size_t)(3 * B_ + b) * 2 + kvh) * KVSEG, t, tl, g, qi,
                              ocmp + (size_t)(b * S_ + qi * 64 + half * 32) * 1024 + (kvh * 4 + g) * 128, oslc + (size_t)(b * S_ + qi * 64 + half * 32) * 1024 + (kvh * 4 + g) * 128);
        }
    }
    SEAM(4);
    if (IN(5)) {
        const int lane = LANE_NOW;
        for (int row = gw; row < T_; row += nw) {
            const _Float16* pr = proj16 + (size_t)row * INW + C_G;
            float v[32]; float ss = 0.f;
#pragma unroll
            for (int c = 0; c < 2; ++c) { const int col = (lane + 64 * c) * 8, h = col >> 7; const size_t o = (size_t)row * 1024 + col;
                const float g0 = sigmoidf_((float)pr[h * 3]), g1 = sigmoidf_((float)pr[h * 3 + 1]), g2 = sigmoidf_((float)pr[h * 3 + 2]);
                const h8 a = *(const h8*)(ocmp + o), b2 = *(const h8*)(oslc + o), c2 = *(const h8*)(owin + o);
#pragma unroll
                for (int q = 0; q < 8; ++q) { const float x = g0 * (float)a[q] + g1 * (float)b2[q] + g2 * (float)c2[q]; v[c * 8 + q] = x; ss += x * x; } }
            ss = wave_sum(ss); float r = rsqrtf(ss / 1024.f + LN_EPS);
#pragma unroll
            for (int c = 0; c < 2; ++c) { const int col = (lane + 64 * c) * 8; const float4 ga = *(const float4*)(p.in[I_GNNSA] + col), gb = *(const float4*)(p.in[I_GNNSA] + col + 4);
                v[c * 8 + 0] *= r * ga.x; v[c * 8 + 1] *= r * ga.y; v[c * 8 + 2] *= r * ga.z; v[c * 8 + 3] *= r * ga.w; v[c * 8 + 4] *= r * gb.x; v[c * 8 + 5] *= r * gb.y; v[c * 8 + 6] *= r * gb.z; v[c * 8 + 7] *= r * gb.w; }
            { const h8 a = *(const h8*)(opool + (size_t)row * 512 + lane * 8); ss = 0.f;
#pragma unroll
              for (int q = 0; q < 8; ++q) { v[16 + q] = (float)a[q]; ss += v[16 + q] * v[16 + q]; }
              ss = wave_sum(ss); r = rsqrtf(ss / 512.f + LN_EPS);
              const float4 ga = *(const float4*)(p.in[I_GNPOOL] + lane * 8), gb = *(const float4*)(p.in[I_GNPOOL] + lane * 8 + 4);
              v[16] *= r * ga.x; v[17] *= r * ga.y; v[18] *= r * ga.z; v[19] *= r * ga.w; v[20] *= r * gb.x; v[21] *= r * gb.y; v[22] *= r * gb.z; v[23] *= r * gb.w; }
            { const h8 a = *(const h8*)(omem + (size_t)row * 512 + lane * 8); ss = 0.f;
#pragma unroll
              for (int q = 0; q < 8; ++q) { v[24 + q] = (float)a[q]; ss += v[24 + q] * v[24 + q]; }
              ss = wave_sum(ss); r = rsqrtf(ss / 512.f + LN_EPS);
              const float4 ga = *(const float4*)(p.in[I_GNMEM] + lane * 8), gb = *(const float4*)(p.in[I_GNMEM] + lane * 8 + 4);
              v[24] *= r * ga.x; v[25] *= r * ga.y; v[26] *= r * ga.z; v[27] *= r * ga.w; v[28] *= r * gb.x; v[29] *= r * gb.y; v[30] *= r * gb.z; v[31] *= r * gb.w; }
            float amax = 0.f;
#pragma unroll
            for (int k = 0; k < 32; ++k) amax = fmaxf(amax, fabsf(v[k]));
            amax = wave_max(amax);
            const float qinv = amax > 0.f ? 127.f / amax : 0.f;
            if (lane == 0) scat[row] = amax > 0.f ? amax / 127.f : 1.f;
#pragma unroll
            for (int c = 0; c < 4; ++c) { const int col = c < 2 ? (lane + 64 * c) * 8 : (c == 2 ? 1024 + lane * 8 : 1536 + lane * 8);
                uint2 q; q.x = pack4_i8(v[c * 8 + 0] * qinv, v[c * 8 + 1] * qinv, v[c * 8 + 2] * qinv, v[c * 8 + 3] * qinv); q.y = pack4_i8(v[c * 8 + 4] * qinv, v[c * 8 + 5] * qinv, v[c * 8 + 6] * qinv, v[c * 8 + 7] * qinv);
                *(uint2*)(cat8 + (size_t)row * 2048 + col) = q; }
        }
    }
    SEAM(5);
    if (IN(6)) {
        const int lane = LANE_NOW; (void)lane;
        g8::ProbOut P{cat8, q8out, hpre16, x16, scat, sout, nb, bid};
        g8::gemm_phase(lds, P);
    }
    SEAM(6);
    if (IN(7)) {
        const int lane = LANE_NOW; (void)lane;
        float* lg = (float*)smem;
        const int r32 = lane & 31, hi = lane >> 5, fr = lane & 15, fq = lane >> 4;
        for (int u = bid; u < T_ / 64; u += nb) {
            const int base = u * 64;
            h8 raw[8][4];
#pragma unroll
            for (int i = 0; i < 8; ++i)
#pragma unroll
                for (int c = 0; c < 4; ++c) raw[i][c] = *(const h8*)(hpre16 + (size_t)(base + wv * 8 + i) * 2048 + (lane + 64 * c) * 8);
#pragma unroll
            for (int i = 0; i < 8; ++i) {
                const int row = base + wv * 8 + i;
                float v[32]; float s = 0.f;
#pragma unroll
                for (int c = 0; c < 4; ++c) {
#pragma unroll
                    for (int q = 0; q < 8; ++q) { v[c * 8 + q] = (float)raw[i][c][q]; s += v[c * 8 + q]; } }
                const float mu = wave_sum(s) / 2048.f; float q2 = 0.f;
#pragma unroll
                for (int k = 0; k < 32; ++k) { const float d = v[k] - mu; q2 += d * d; }
                const float rs = rsqrtf(wave_sum(q2) / 2048.f + LN_EPS);
                float amax = 0.f;
#pragma unroll
                for (int c = 0; c < 4; ++c) { const int col = (lane + 64 * c) * 8;
                    const float4 g0 = *(const float4*)(p.in[I_LN1G] + col), g1 = *(const float4*)(p.in[I_LN1G] + col + 4), b0 = *(const float4*)(p.in[I_LN1B] + col), b1 = *(const float4*)(p.in[I_LN1B] + col + 4);
                    float4 o0, o1;
                    o0.x = (v[c * 8 + 0] - mu) * rs * g0.x + b0.x; o0.y = (v[c * 8 + 1] - mu) * rs * g0.y + b0.y; o0.z = (v[c * 8 + 2] - mu) * rs * g0.z + b0.z; o0.w = (v[c * 8 + 3] - mu) * rs * g0.w + b0.w;
                    o1.x = (v[c * 8 + 4] - mu) * rs * g1.x + b1.x; o1.y = (v[c * 8 + 5] - mu) * rs * g1.y + b1.y; o1.z = (v[c * 8 + 6] - mu) * rs * g1.z + b1.z; o1.w = (v[c * 8 + 7] - mu) * rs * g1.w + b1.w;
                    h8 oh; oh[0] = (_Float16)o0.x; oh[1] = (_Float16)o0.y; oh[2] = (_Float16)o0.z; oh[3] = (_Float16)o0.w; oh[4] = (_Float16)o1.x; oh[5] = (_Float16)o1.y; oh[6] = (_Float16)o1.z; oh[7] = (_Float16)o1.w;
                    *(h8*)(h16 + (size_t)row * 2048 + col) = oh;
                    v[c * 8 + 0] = o0.x; v[c * 8 + 1] = o0.y; v[c * 8 + 2] = o0.z; v[c * 8 + 3] = o0.w; v[c * 8 + 4] = o1.x; v[c * 8 + 5] = o1.y; v[c * 8 + 6] = o1.z; v[c * 8 + 7] = o1.w;
                    amax = fmaxf(amax, fmaxf(fmaxf(fmaxf(fabsf(o0.x), fabsf(o0.y)), fmaxf(fabsf(o0.z), fabsf(o0.w))), fmaxf(fmaxf(fabsf(o1.x), fabsf(o1.y)), fmaxf(fabsf(o1.z), fabsf(o1.w))))); }
                amax = wave_max(amax);
                const float qinv = amax > 0.f ? 127.f / amax : 0.f;
                if (lane == 0) sah[row] = amax > 0.f ? amax / 127.f : 1.f;
#pragma unroll
                for (int c = 0; c < 4; ++c) { const int col = (lane + 64 * c) * 8;
                    uint2 q; q.x = pack4_i8(v[c * 8 + 0] * qinv, v[c * 8 + 1] * qinv, v[c * 8 + 2] * qinv, v[c * 8 + 3] * qinv); q.y = pack4_i8(v[c * 8 + 4] * qinv, v[c * 8 + 5] * qinv, v[c * 8 + 6] * qinv, v[c * 8 + 7] * qinv);
                    *(uint2*)(h8q + (size_t)row * 2048 + col) = q; }
            }
            asm volatile("s_waitcnt vmcnt(0)" ::: "memory");
            __syncthreads();
            {
                const int tok0 = base + 16 * (wv >> 1), e0 = 16 * (wv & 1);
                const _Float16* ap = h16 + (size_t)(tok0 + fr) * 2048 + fq * 8; const _Float16* bp = wr16 + (size_t)(e0 + fr) * 2048 + fq * 8;
                f4 acc = (f4){0.f, 0.f, 0.f, 0.f};
#pragma unroll 8
                for (int sI = 0; sI < 64; ++sI) { const h8 a = *(const h8*)(ap + sI * 32), bb = *(const h8*)(bp + sI * 32); acc = __builtin_amdgcn_mfma_f32_16x16x32_f16(a, bb, acc, 0, 0, 0); }
                const float br = p.in[I_BR][e0 + fr];
#pragma unroll
                for (int j = 0; j < 4; ++j) lg[(16 * (wv >> 1) + 4 * fq + j) * 33 + e0 + fr] = acc[j] + br;
            }
            __syncthreads();
#pragma unroll 1
            for (int it = 0; it < 4; ++it) {
                const int tk = 8 * wv + 2 * it + hi;
                const float iv = lg[tk * 33 + r32];
                int rank = 0;
                for (int i = 0; i < 32; ++i) { const float vi = __shfl(iv, i + 32 * hi); rank += (vi > iv || (vi == iv && i < r32)) ? 1 : 0; }
                float tv[4]; int te[4];
#pragma unroll
                for (int r = 0; r < 4; ++r) { const unsigned long long bm = __ballot(rank == r); const unsigned hm = (unsigned)(bm >> (32 * hi)); const int src = __ffs(hm) - 1; te[r] = src; tv[r] = __shfl(iv, src + 32 * hi); }
                const float e0v = 1.f, e1v = expf(tv[1] - tv[0]), e2v = expf(tv[2] - tv[0]), e3v = expf(tv[3] - tv[0]); const float inv = 1.f / (e0v + e1v + e2v + e3v);
                if (r32 < 4) { const int e = r32 == 0 ? te[0] : r32 == 1 ? te[1] : r32 == 2 ? te[2] : te[3]; const float g = (r32 == 0 ? e0v : r32 == 1 ? e1v : r32 == 2 ? e2v : e3v) * inv;
                    const int a = (base + tk) * 4 + r32; const int pos = atomicAdd(&cnt[e], 1); list[(size_t)e * T_ + pos] = a; gate[a] = g; }
            }
            __syncthreads();
        }
    }
    SEAM(7);
    LAS int* mtab = (LAS int*)(smem + g8::STAGE_BYTES);
    if (IN(8)) {
        const int lane = LANE_NOW; (void)lane;
        if (tid == 0) { int ub = 0, rs = 0;
            for (int e = 0; e < NE; ++e) { const int c = (int)__hip_atomic_load((unsigned*)&cnt[e], __ATOMIC_RELAXED, __HIP_MEMORY_SCOPE_AGENT); mtab[e] = c; mtab[32 + e] = ub; mtab[65 + e] = rs; ub += ((c + 255) >> 8) * 16; rs += c; }
            mtab[64] = ub; mtab[97] = rs; mtab[98] = ub; }
        __syncthreads();
        g8::moe_build(mtab, nb, vcu);
        __syncthreads();
        g8::ProbGu P{h8q, q8gu, actf8, p.in[I_BGU], list, sah, sgu, g8::MoeTab{mtab, 16}, nb, vcu};
        g8::gemm_phase(lds, P);
        __syncthreads();
    }
    SEAM(8);
    if (IN(9)) {
        const int lane = LANE_NOW;
        for (int row0 = gw; row0 < NA; row0 += nw * 8) {
            uint2 raw[8][4];
#pragma unroll
            for (int i = 0; i < 8; ++i)
#pragma unroll
                for (int c = 0; c < 4; ++c) raw[i][c] = *(const uint2*)(actf8 + (size_t)(row0 + i * nw) * 2048 + (lane + 64 * c) * 8);
#pragma unroll
            for (int i = 0; i < 8; ++i) { const int row = row0 + i * nw;
                float v[32]; float amax = 0.f;
#pragma unroll
                for (int c = 0; c < 4; ++c) { const uint2 a = raw[i][c];
                    dec4_fp8(a.x, v[c * 8 + 0], v[c * 8 + 1], v[c * 8 + 2], v[c * 8 + 3]); dec4_fp8(a.y, v[c * 8 + 4], v[c * 8 + 5], v[c * 8 + 6], v[c * 8 + 7]);
#pragma unroll
                    for (int q = 0; q < 8; ++q) amax = fmaxf(amax, fabsf(v[c * 8 + q])); }
                amax = wave_max(amax);
                const float qinv = amax > 0.f ? 127.f / amax : 0.f;
                if (lane == 0) sact[row] = amax > 0.f ? amax / 127.f : 1.f;
#pragma unroll
                for (int c = 0; c < 4; ++c) { uint2 q; q.x = pack4_i8(v[c * 8 + 0] * qinv, v[c * 8 + 1] * qinv, v[c * 8 + 2] * qinv, v[c * 8 + 3] * qinv); q.y = pack4_i8(v[c * 8 + 4] * qinv, v[c * 8 + 5] * qinv, v[c * 8 + 6] * qinv, v[c * 8 + 7] * qinv);
                    *(uint2*)(act8 + (size_t)row * 2048 + (lane + 64 * c) * 8) = q; }
            }
        }
    }
    SEAM(9);
    if (IN(10)) {
        const int lane = LANE_NOW; (void)lane;
        if (tid == 0) { int ub = 0, rs = 0;
            for (int e = 0; e < NE; ++e) { const int c = (int)__hip_atomic_load((unsigned*)&cnt[e], __ATOMIC_RELAXED, __HIP_MEMORY_SCOPE_AGENT); mtab[e] = c; mtab[32 + e] = ub; mtab[65 + e] = rs; ub += ((c + 255) >> 8) * 8; rs += c; }
            mtab[64] = ub; mtab[97] = rs; mtab[98] = ub; }
        __syncthreads();
        g8::moe_build(mtab, nb, vcu);
        __syncthreads();
        g8::ProbDn P{act8, q8dn, yf8, p.in[I_BDN], list, gate, sact, sdn, g8::MoeTab{mtab, 8}, nb, vcu};
        g8::gemm_phase(lds, P);
        __syncthreads();
    }
    SEAM(10);
    if (IN(11)) {
        const int lane = LANE_NOW; (void)lane;
        for (int row0 = gw; row0 < T_; row0 += nw * 2) {
          h8 hraw[2][4]; uint2 yraw[2][4][4];
#pragma unroll
          for (int i = 0; i < 2; ++i)
#pragma unroll
            for (int c = 0; c < 4; ++c) { const int col = (lane + 64 * c) * 8; const size_t yo = (size_t)(row0 + i * nw) * 4 * 2048 + col;
                hraw[i][c] = *(const h8*)(h16 + (size_t)(row0 + i * nw) * 2048 + col);
                yraw[i][c][0] = *(const uint2*)(yf8 + yo); yraw[i][c][1] = *(const uint2*)(yf8 + yo + 2048); yraw[i][c][2] = *(const uint2*)(yf8 + yo + 4096); yraw[i][c][3] = *(const uint2*)(yf8 + yo + 6144); }
#pragma unroll
          for (int i = 0; i < 2; ++i) { const int row = row0 + i * nw;
            float v[32]; float s = 0.f;
#pragma unroll
            for (int c = 0; c < 4; ++c) {
                const h8 hh8 = hraw[i][c];
                const uint2 y0 = yraw[i][c][0], y1 = yraw[i][c][1], y2 = yraw[i][c][2], y3 = yraw[i][c][3];
                float ys[8], t0[8], t1[8], t2[8], t3[8];
                dec4_fp8(y0.x, t0[0], t0[1], t0[2], t0[3]); dec4_fp8(y0.y, t0[4], t0[5], t0[6], t0[7]); dec4_fp8(y1.x, t1[0], t1[1], t1[2], t1[3]); dec4_fp8(y1.y, t1[4], t1[5], t1[6], t1[7]);
                dec4_fp8(y2.x, t2[0], t2[1], t2[2], t2[3]); dec4_fp8(y2.y, t2[4], t2[5], t2[6], t2[7]); dec4_fp8(y3.x, t3[0], t3[1], t3[2], t3[3]); dec4_fp8(y3.y, t3[4], t3[5], t3[6], t3[7]);
#pragma unroll
                for (int q = 0; q < 8; ++q) ys[q] = (t0[q] + t1[q]) + (t2[q] + t3[q]);
#pragma unroll
                for (int q = 0; q < 8; ++q) { v[c * 8 + q] = DN_ALPHA * (float)hh8[q] + ys[q] * 0.0625f; s += v[c * 8 + q]; } }
            const float mu = wave_sum(s) / 2048.f; float q2 = 0.f;
#pragma unroll
            for (int i = 0; i < 32; ++i) { const float d = v[i] - mu; q2 += d * d; }
            const float rs = rsqrtf(wave_sum(q2) / 2048.f + LN_EPS);
#pragma unroll
            for (int c = 0; c < 4; ++c) { const int col = (lane + 64 * c) * 8;
                const float4 ga = *(const float4*)(p.in[I_LN2G] + col), gb = *(const float4*)(p.in[I_LN2G] + col + 4), ba = *(const float4*)(p.in[I_LN2B] + col), bb = *(const float4*)(p.in[I_LN2B] + col + 4);
                float4 o0, o1;
                o0.x = (v[c * 8 + 0] - mu) * rs * ga.x + ba.x; o0.y = (v[c * 8 + 1] - mu) * rs * ga.y + ba.y; o0.z = (v[c * 8 + 2] - mu) * rs * ga.z + ba.z; o0.w = (v[c * 8 + 3] - mu) * rs * ga.w + ba.w;
                o1.x = (v[c * 8 + 4] - mu) * rs * gb.x + bb.x; o1.y = (v[c * 8 + 5] - mu) * rs * gb.y + bb.y; o1.z = (v[c * 8 + 6] - mu) * rs * gb.z + bb.z; o1.w = (v[c * 8 + 7] - mu) * rs * gb.w + bb.w;
                *(float4*)(p.out + (size_t)row * 2048 + col) = o0; *(float4*)(p.out + (size_t)row * 2048 + col + 4) = o1; }
          }
        }
    }
}

constexpr int NPHASE = 12;

extern "C" void kernel_launch(void* const* d_in, const int* in_sizes, int n_in, void* d_out, int out_size, void* d_ws, size_t ws_size, hipStream_t stream) {
    static int grid = 0;
    if (grid == 0) {
        if (n_in != 26 || ws_size < WS_END) { fprintf(stderr, "kernel_launch: unexpected n_in %d or ws_size %zu (< %zu)\n", n_in, ws_size, (size_t)WS_END); grid = -1; return; }
        int dev = 0, cus = 0, per_cu = 0;
        hipGetDevice(&dev); hipDeviceGetAttribute(&cus, hipDeviceAttributeMultiprocessorCount, dev);
        if (hipFuncSetAttribute((const void*)fwd, hipFuncAttributeMaxDynamicSharedMemorySize, LDS_BYTES) != hipSuccess) { fprintf(stderr, "hipFuncSetAttribute failed\n"); grid = -1; return; }
        hipOccupancyMaxActiveBlocksPerMultiprocessor(&per_cu, (const void*)fwd, 512, LDS_BYTES);
        (void)hipGetLastError();
        if (per_cu < 1) fprintf(stderr, "occupancy query says %d blocks per CU\n", per_cu);
        grid = cus > 0 ? cus : 256;
    }
    if (grid < 0) return;
    hipMemsetAsync((char*)d_ws + WS_CTL, 0, CTL_BYTES, stream);
    Params p{};
    for (int i = 0; i < 26; ++i) p.in[i] = (const float*)d_in[i];
    p.out = (float*)d_out; p.ws = (unsigned char*)d_ws;
#if N_LAUNCH_MODE == 1
    p.lo_hi = (long long)0 | ((long long)NPHASE << 32);
    hipLaunchKernelGGL(fwd, dim3(grid), dim3(512), LDS_BYTES, stream, p);
#else
    for (int ph = 0; ph < NPHASE; ++ph) {
        p.lo_hi = (long long)ph | ((long long)(ph + 1) << 32);
        hipLaunchKernelGGL(fwd, dim3(grid), dim3(512), LDS_BYTES, stream, p);
    }
#endif
}
```

```cpp
#include <hip/hip_runtime.h>
#include <cstdio>
#include <cstdint>

#ifndef N_LAUNCH_MODE
#define N_LAUNCH_MODE 1
#endif

constexpr int B_ = 8, S_ = 2048, D_ = 2048, T_ = B_ * S_;
constexpr int INW = 3608;
constexpr int C_Q = 0, C_KC = 1024, C_VC = 1280, C_KS = 1536, C_VS = 1792, C_KW = 2048, C_VW = 2304, C_G = 2560, C_UP = 2584, C_QM = 3096;
constexpr int NC = 127;
constexpr int CROWS = B_ * NC * 2;
constexpr int NE = 32, DE = 2048, NA = T_ * 4;
constexpr float LN_EPS = 1e-5f;
constexpr float DN_ALPHA = 1.189207115002721f;
constexpr float ATT_SCALE = 0.08838834764831845f;

constexpr size_t al256(size_t x) { return (x + 255) & ~(size_t)255; }
constexpr size_t WS_CTL = 0;
constexpr size_t CTL_BYTES = 65536;
constexpr size_t CTL_CNT = 16384;
constexpr size_t WS_PROJ = CTL_BYTES;
constexpr size_t WS_KVMEM = WS_PROJ + al256((size_t)T_ * INW * 4);
constexpr size_t WS_BIAS1 = WS_KVMEM + al256((size_t)2048 * 1024 * 4);
constexpr size_t WS_HID = WS_BIAS1 + al256(2 * 16 * 256 * 4);
constexpr size_t WS_KC = WS_HID + al256((size_t)2 * 2048 * 256 * 4);
constexpr size_t WS_VC = WS_KC + al256((size_t)CROWS * 128 * 4);
constexpr size_t WS_POOLED = WS_VC + al256((size_t)CROWS * 128 * 4);
constexpr size_t WS_OPOOL = WS_POOLED + al256((size_t)T_ * 512 * 4);
constexpr size_t WS_OWIN = WS_OPOOL + al256((size_t)T_ * 512 * 4);
constexpr size_t WS_OCMP = WS_OWIN + al256((size_t)T_ * 1024 * 4);
constexpr size_t WS_OSLC = WS_OCMP + al256((size_t)T_ * 1024 * 4);
constexpr size_t WS_SEL = WS_OSLC + al256((size_t)T_ * 1024 * 4);
constexpr size_t WS_OMEM = WS_SEL + al256((size_t)T_ * 2 * 4);
constexpr size_t WS_CAT16 = WS_OMEM + al256((size_t)T_ * 512 * 4);
constexpr size_t WS_HPRE = WS_CAT16 + al256((size_t)T_ * 2048 * 2);
constexpr size_t WS_H = WS_HPRE + al256((size_t)T_ * 2048 * 4);
constexpr size_t WS_H16 = WS_H + al256((size_t)T_ * 2048 * 4);
constexpr size_t WS_GATE = WS_H16 + al256((size_t)T_ * 2048 * 2);
constexpr size_t WS_LIST = WS_GATE + al256((size_t)NA * 4);
constexpr size_t WS_ACT16 = WS_LIST + al256((size_t)NE * T_ * 4);
constexpr size_t WS_Y16 = WS_ACT16 + al256((size_t)(NA + 256) * 2048 * 2);
constexpr size_t WS_X16 = WS_Y16 + al256((size_t)NA * 2048 * 2);
constexpr size_t WS_MEM16 = WS_X16 + (size_t)T_ * 2048 * 2;
constexpr size_t WS_WTIN = WS_MEM16 + al256((size_t)2048 * 2048 * 2);
constexpr size_t WS_WTOUT = WS_WTIN + al256((size_t)3840 * 2048 * 2);
constexpr size_t WS_WTGU = WS_WTOUT + al256((size_t)2048 * 2048 * 2);
constexpr size_t WS_WTDN = WS_WTGU + al256((size_t)NE * 4096 * 2048 * 2);
constexpr size_t WS_PROJ16 = WS_WTDN + al256((size_t)NE * 2048 * 2048 * 2);
constexpr size_t WS_KVMEM16 = WS_PROJ16 + al256((size_t)(T_ + 64) * INW * 2);
constexpr size_t WS_WT1 = WS_KVMEM16 + al256((size_t)2048 * 1024 * 2);
constexpr size_t WS_UV = WS_WT1 + al256((size_t)2 * 512 * 2048 * 2);
constexpr size_t WS_KC16 = WS_UV + al256((size_t)2 * 4 * 2048 * 512 * 4);
constexpr size_t WS_VC16 = WS_KC16 + al256((size_t)B_ * 128 * 256 * 2);
constexpr size_t WS_WR16 = WS_VC16 + al256((size_t)B_ * 128 * 256 * 2);
constexpr size_t WS_Q8GU = WS_WR16 + al256((size_t)32 * 2048 * 2);
constexpr size_t WS_Q8DN = WS_Q8GU + al256((size_t)NE * 4096 * 2048);
constexpr size_t WS_SGU = WS_Q8DN + al256((size_t)NE * 2048 * 2048);
constexpr size_t WS_SDN = WS_SGU + al256((size_t)NE * 4096 * 4);
constexpr size_t WS_H8 = WS_SDN + al256((size_t)NE * 2048 * 4);
constexpr size_t WS_SAH = WS_H8 + al256((size_t)T_ * 2048);
constexpr size_t WS_ACT8 = WS_SAH + al256((size_t)T_ * 4);
constexpr size_t WS_SACT = WS_ACT8 + al256((size_t)(NA + 256) * 2048);
constexpr size_t WS_WTMKV = WS_SACT + al256((size_t)(NA + 256) * 4);
constexpr size_t WS_Q8OUT = WS_WTMKV + al256((size_t)1024 * 2048 * 2);
constexpr size_t WS_SOUT = WS_Q8OUT + al256((size_t)2048 * 2048);
constexpr size_t WS_CAT8 = WS_SOUT + al256(2048 * 4);
constexpr size_t WS_SCAT = WS_CAT8 + al256((size_t)T_ * 2048);
constexpr size_t WS_X8 = WS_SCAT + al256((size_t)T_ * 4);
constexpr size_t WS_SXA = WS_X8 + al256((size_t)(T_ + 2048) * 2048);
constexpr size_t WS_Q8IN = WS_SXA + al256((size_t)(T_ + 2048) * 4);
constexpr size_t WS_SIN8 = WS_Q8IN + al256((size_t)2560 * 2048);
constexpr size_t WS_Q8MKV = WS_SIN8 + al256(2560 * 4);
constexpr size_t WS_SMKV = WS_Q8MKV + al256((size_t)1024 * 2048);
constexpr size_t WS_WT2 = WS_SMKV + al256(1024 * 4);
constexpr size_t WS_KV16 = WS_WT2 + al256((size_t)2 * 128 * 256 * 2);
constexpr size_t KVSEG = (size_t)S_ * 128;
constexpr size_t WS_END = WS_KV16 + al256((size_t)6 * B_ * 2 * S_ * 128 * 2);

constexpr int LDS_BYTES = 155648;

struct Params {
    const float* in[26];
    float* out;
    unsigned char* ws;
    long long lo_hi;
};
enum { I_X = 0, I_MEM, I_WIN, I_POSK, I_W1K, I_W2K, I_POSV, I_W1V, I_W2V, I_POOLW, I_POOLS, I_WMEMKV, I_GNNSA, I_GNPOOL, I_GNMEM, I_WOUT,
       I_LN1G, I_LN1B, I_WR, I_BR, I_WGU, I_BGU, I_WDN, I_BDN, I_LN2G, I_LN2B };

#define XB_TMO      128
#define XB_XCNT(j)  (256  + 64 * (j))
#define XB_XSUB(j)  (1280 + 64 * (j))
#define XB_XGEN(j)  (2304 + 64 * (j))
#define XB_TOP      3328
#define XB_TOPGEN   3392
#define XCD_BAR_WORDS 3456
#define XB_SPIN_CAP (1u << 25)
#define LAS __attribute__((address_space(3)))

__device__ __forceinline__ unsigned xb_ld(unsigned* p)              { return __hip_atomic_load(p, __ATOMIC_RELAXED, __HIP_MEMORY_SCOPE_AGENT); }
__device__ __forceinline__ unsigned xb_add(unsigned* p, unsigned v) { return __hip_atomic_fetch_add(p, v, __ATOMIC_RELAXED, __HIP_MEMORY_SCOPE_AGENT); }
__device__ __forceinline__ unsigned xb_xcc_id() { return (unsigned)__builtin_amdgcn_s_getreg((3 << 11) | 20) & 0xFu; }
#define XB_SPIN(cond, bar) do { unsigned _sp = 0; while (cond) { __builtin_amdgcn_s_sleep(1); \
    if ((++_sp & 255u) == 0u) { if (xb_ld(&(bar)[XB_TMO])) break; if (_sp > XB_SPIN_CAP) { atomicAdd(&(bar)[XB_TMO], 1u); break; } } } } while (0)

struct XcdBarrier { unsigned* bar; unsigned x; volatile LAS unsigned* st; };

__device__ __forceinline__ XcdBarrier xcd_barrier_post(unsigned* bar, volatile LAS unsigned* st) {
    XcdBarrier b; b.bar = bar; b.x = xb_xcc_id(); b.st = st;
    if (threadIdx.x == 0) (void)xb_add(&bar[XB_XCNT(b.x)], 1u);
    return b;
}
__device__ __forceinline__ void xcd_barrier_complete(unsigned* bar, unsigned x, unsigned& nloc, unsigned& nx) {
    const unsigned G = gridDim.x * gridDim.y * gridDim.z;
    unsigned sum, cnt, mine, sp = 0u;
    for (;;) {
        sum = 0u; cnt = 0u; mine = 0u;
#pragma unroll
        for (unsigned j = 0; j < 16; ++j) { const unsigned c = xb_ld(&bar[XB_XCNT(j)]); sum += c; cnt += (c > 0u) ? 1u : 0u; mine = (j == x) ? c : mine; }
        if (sum == G) break;
        __builtin_amdgcn_s_sleep(1);
        if ((++sp & 255u) == 0u) { if (xb_ld(&bar[XB_TMO])) break; if (sp > XB_SPIN_CAP) { atomicAdd(&bar[XB_TMO], 1u); break; } }
    }
    nloc = mine > 0u ? mine : 1u; nx = cnt > 0u ? cnt : 1u;
}
__device__ __forceinline__ void xcd_barrier(const XcdBarrier& b) {
    asm volatile("s_waitcnt vmcnt(0)" ::: "memory");
    __syncthreads();
    if (threadIdx.x == 0) {
        unsigned* bar = b.bar;
        __builtin_amdgcn_s_waitcnt(0);
        unsigned nloc = b.st[0], nx = b.st[1];
        if (nloc == 0u) { xcd_barrier_complete(bar, b.x, nloc, nx); b.st[0] = nloc; b.st[1] = nx; }
        const unsigned old = xb_add(&bar[XB_XSUB(b.x)], 1u);
        const unsigned gen = old / nloc;
        if (old + 1u == (gen + 1u) * nloc) {
            __builtin_amdgcn_fence(__ATOMIC_RELEASE, "agent");
            asm volatile("s_waitcnt vmcnt(0)" ::: "memory");
            const unsigned og = xb_add(&bar[XB_TOP], 1u);
            const unsigned tg = og / nx;
            if (og + 1u == (tg + 1u) * nx) xb_add(&bar[XB_TOPGEN], 1u);
            else XB_SPIN(xb_ld(&bar[XB_TOPGEN]) == tg, bar);
            __builtin_amdgcn_fence(__ATOMIC_ACQUIRE, "agent");
            xb_add(&bar[XB_XGEN(b.x)], 1u);
            asm volatile("s_waitcnt vmcnt(0)" ::: "memory");
        } else {
            XB_SPIN(xb_ld(&bar[XB_XGEN(b.x)]) == gen, bar);
            __builtin_amdgcn_fence(__ATOMIC_ACQUIRE, "agent");
            asm volatile("s_waitcnt vmcnt(0)" ::: "memory");
        }
    }
    __syncthreads();
}

typedef _Float16 h8 __attribute__((ext_vector_type(8)));
typedef _Float16 h4 __attribute__((ext_vector_type(4)));
typedef float f4 __attribute__((ext_vector_type(4)));

__device__ __forceinline__ float wave_sum(float v) {
#pragma unroll
    for (int o = 32; o > 0; o >>= 1) v += __shfl_xor(v, o);
    return v;
}
__device__ __forceinline__ float wave_max(float v) {
#pragma unroll
    for (int o = 32; o > 0; o >>= 1) v = fmaxf(v, __shfl_xor(v, o));
    return v;
}
__device__ __forceinline__ void wave_sync() {
    asm volatile("s_waitcnt lgkmcnt(0)" ::: "memory");
    __builtin_amdgcn_wave_barrier();
}
__device__ __forceinline__ float gelu_tanh(float x) {
    const float u = 0.7978845608028654f * (x + 0.044715f * x * x * x);
    return 0.5f * x * (1.f + tanhf(u));
}
__device__ __forceinline__ float gelu_fast(float x) { const float u = 0.7978845608028654f * (x + 0.044715f * x * x * x); const float t = 1.f - 2.f * __builtin_amdgcn_rcpf(1.f + __builtin_amdgcn_exp2f(2.8853900817779268f * u)); return 0.5f * x * (1.f + t); }
__device__ __forceinline__ float sigmoidf_(float x) { return 1.f / (1.f + expf(-x)); }
__device__ __forceinline__ unsigned pk4_fp8(float a, float b, float c, float d) { int w = 0; w = __builtin_amdgcn_cvt_pk_fp8_f32(a, b, w, false); w = __builtin_amdgcn_cvt_pk_fp8_f32(c, d, w, true); return (unsigned)w; }
__device__ __forceinline__ void dec4_fp8(unsigned w, float& a, float& b, float& c, float& d) { a = __builtin_amdgcn_cvt_f32_fp8((int)w, 0); b = __builtin_amdgcn_cvt_f32_fp8((int)w, 1); c = __builtin_amdgcn_cvt_f32_fp8((int)w, 2); d = __builtin_amdgcn_cvt_f32_fp8((int)w, 3); }
__device__ __forceinline__ float swiglu_fast(float g, float l) { const float xg = fminf(g, 7.f), xl = fminf(fmaxf(l, -7.f), 7.f); return xg * __builtin_amdgcn_rcpf(1.f + __builtin_amdgcn_exp2f(-2.4554669595930156f * xg)) * (xl + 1.f); }

constexpr int G_LD = 40;
template <class AF, class EF>
__device__ __forceinline__ void gemm_tile(char* smem, int K, const AF& af, const float* __restrict__ Bm, int ldb, int n0, int Nlim, bool perm, const EF& ef) {
    _Float16* As = (_Float16*)smem;
    _Float16* Bs = As + 128 * G_LD;
    const int tid = threadIdx.x, lane = tid & 63, wid = tid >> 6, wr = wid >> 2, wc = wid & 3, fr = lane & 15, fq = lane >> 4;
    f4 acc[4][2];
#pragma unroll
    for (int m = 0; m < 4; ++m)
#pragma unroll
        for (int n = 0; n < 2; ++n) acc[m][n] = (f4){0.f, 0.f, 0.f, 0.f};
    const int ar = tid >> 3, ak = (tid & 7) * 4;
    const float* ap0 = af.row(ar);
    const float* ap1 = af.row(ar + 64);
    const int bk = tid >> 5, bn = (tid & 31) * 4;
    const bool bok = (n0 + bn) < Nlim;
    int bnp[4];
#pragma unroll
    for (int i = 0; i < 4; ++i) { const int c = bn + i; bnp[i] = perm ? ((c & ~31) | ((c & 1) << 4) | ((c & 31) >> 1)) : c; }
    for (int k0 = 0; k0 < K; k0 += 32) {
        const int ko = af.koff(k0 + ak);
        float4 a0 = make_float4(0.f, 0.f, 0.f, 0.f), a1 = a0, b0 = a0, b1 = a0;
        if (ap0) a0 = *(const float4*)(ap0 + ko);
        if (ap1) a1 = *(const float4*)(ap1 + ko);
        if (bok) { b0 = *(const float4*)(Bm + (size_t)(k0 + bk) * ldb + n0 + bn); b1 = *(const float4*)(Bm + (size_t)(k0 + bk + 16) * ldb + n0 + bn); }
        __syncthreads();
        *(h4*)&As[ar * G_LD + ak] = (h4){(_Float16)a0.x, (_Float16)a0.y, (_Float16)a0.z, (_Float16)a0.w};
        *(h4*)&As[(ar + 64) * G_LD + ak] = (h4){(_Float16)a1.x, (_Float16)a1.y, (_Float16)a1.z, (_Float16)a1.w};
        Bs[bnp[0] * G_LD + bk] = (_Float16)b0.x; Bs[bnp[1] * G_LD + bk] = (_Float16)b0.y; Bs[bnp[2] * G_LD + bk] = (_Float16)b0.z; Bs[bnp[3] * G_LD + bk] = (_Float16)b0.w;
        Bs[bnp[0] * G_LD + bk + 16] = (_Float16)b1.x; Bs[bnp[1] * G_LD + bk + 16] = (_Float16)b1.y; Bs[bnp[2] * G_LD + bk + 16] = (_Float16)b1.z; Bs[bnp[3] * G_LD + bk + 16] = (_Float16)b1.w;
        __syncthreads();
        h8 a[4], b[2];
#pragma unroll
        for (int m = 0; m < 4; ++m) a[m] = *(const h8*)&As[(wr * 64 + m * 16 + fr) * G_LD + fq * 8];
#pragma unroll
        for (int n = 0; n < 2; ++n) b[n] = *(const h8*)&Bs[(wc * 32 + n * 16 + fr) * G_LD + fq * 8];
#pragma unroll
        for (int m = 0; m < 4; ++m)
#pragma unroll
            for (int n = 0; n < 2; ++n) acc[m][n] = __builtin_amdgcn_mfma_f32_16x16x32_f16(a[m], b[n], acc[m][n], 0, 0, 0);
    }
    ef(acc, wr, wc, fr, fq);
    __syncthreads();
}

struct ARowPlain { const float* base; int ld; int m0; int mlim;
    __device__ __forceinline__ const float* row(int r) const { return (m0 + r) < mlim ? base + (size_t)(m0 + r) * ld : nullptr; }
    __device__ __forceinline__ int koff(int k) const { return k; } };
struct ARowCmp { const float* proj; int col; int m0;
    __device__ __forceinline__ const float* row(int r) const { const int g = m0 + r; if (g >= CROWS) return nullptr; const int kvh = g & 1, bc = g >> 1, b = bc / NC, c = bc % NC;
        return proj + (size_t)(b * S_ + 16 * c) * INW + col + kvh * 128; }
    __device__ __forceinline__ int koff(int k) const { return (k >> 7) * INW + (k & 127); } };
struct ARowList { const float* base; const int* list; int m0; int cnt; int shift;
    __device__ __forceinline__ const float* row(int r) const { if (m0 + r >= cnt) return nullptr; const int a = list[m0 + r]; return base + (size_t)(a >> shift) * 2048; }
    __device__ __forceinline__ int koff(int k) const { return k; } };

struct EpiStore { float* C; int ldc; int m0; int n0; int mlim; int nlim; _Float16* C16;
    __device__ __forceinline__ void operator()(const f4 (&acc)[4][2], int wr, int wc, int fr, int fq) const {
#pragma unroll
        for (int m = 0; m < 4; ++m)
#pragma unroll
            for (int n = 0; n < 2; ++n)
#pragma unroll
                for (int j = 0; j < 4; ++j) { const int r = m0 + wr * 64 + m * 16 + fq * 4 + j, c = n0 + wc * 32 + n * 16 + fr;
                    if (r < mlim && c < nlim) { C[(size_t)r * ldc + c] = acc[m][n][j]; if (C16) C16[(size_t)r * ldc + c] = (_Float16)acc[m][n][j]; } } } };
struct EpiKc { _Float16* C; int m0;
    __device__ __forceinline__ void operator()(const f4 (&acc)[4][2], int wr, int wc, int fr, int fq) const {
#pragma unroll
        for (int m = 0; m < 4; ++m)
#pragma unroll
            for (int n = 0; n < 2; ++n)
#pragma unroll
                for (int j = 0; j < 4; ++j) { const int r = m0 + wr * 64 + m * 16 + fq * 4 + j, c = wc * 32 + n * 16 + fr;
                    C[(size_t)r * 128 + c] = (((r >> 1) & 127) == 127) ? (_Float16)0.f : (_Float16)acc[m][n][j]; } } };
struct EpiPool { _Float16* C; const float* scale; int m0; int g;
    __device__ __forceinline__ void operator()(const f4 (&acc)[4][2], int wr, int wc, int fr, int fq) const {
#pragma unroll
        for (int m = 0; m < 4; ++m)
#pragma unroll
            for (int n = 0; n < 2; ++n)
#pragma unroll
                for (int j = 0; j < 4; ++j) { const int r = m0 + wr * 64 + m * 16 + fq * 4 + j, c = g * 128 + wc * 32 + n * 16 + fr;
                    C[(size_t)r * 512 + c] = (_Float16)(acc[m][n][j] * scale[c]); } } };
struct EpiHid { float* C; const float* bias; int m0; int n0;
    __device__ __forceinline__ void operator()(const f4 (&acc)[4][2], int wr, int wc, int fr, int fq) const {
#pragma unroll
        for (int m = 0; m < 4; ++m)
#pragma unroll
            for (int n = 0; n < 2; ++n)
#pragma unroll
                for (int j = 0; j < 4; ++j) { const int r = m0 + wr * 64 + m * 16 + fq * 4 + j, c = n0 + wc * 32 + n * 16 + fr;
                    if (r < CROWS) C[(size_t)r * 256 + c] = gelu_tanh(acc[m][n][j] + bias[c]); } } };
struct EpiOut { float* C; const float* x; int m0; int n0;
    __device__ __forceinline__ void operator()(const f4 (&acc)[4][2], int wr, int wc, int fr, int fq) const {
#pragma unroll
        for (int m = 0; m < 4; ++m)
#pragma unroll
            for (int n = 0; n < 2; ++n)
#pragma unroll
                for (int j = 0; j < 4; ++j) { const size_t o = (size_t)(m0 + wr * 64 + m * 16 + fq * 4 + j) * 2048 + n0 + wc * 32 + n * 16 + fr;
                    C[o] = DN_ALPHA * x[o] + acc[m][n][j]; } } };
struct EpiGu { float* act; const float* bgu; const int* list; int m0; int cnt; int n0;
    __device__ __forceinline__ void operator()(const f4 (&acc)[4][2], int wr, int wc, int fr, int fq) const {
        const int jc = (n0 + wc * 32) / 2 + fr;
        const float bg = bgu[2 * jc], bl = bgu[2 * jc + 1];
#pragma unroll
        for (int m = 0; m < 4; ++m)
#pragma unroll
            for (int j = 0; j < 4; ++j) { const int r = m0 + wr * 64 + m * 16 + fq * 4 + j;
                if (r < cnt) { const int a = list[r];
                    const float xg = fminf(acc[m][0][j] + bg, 7.f), xl = fminf(fmaxf(acc[m][1][j] + bl, -7.f), 7.f);
                    act[(size_t)a * 2048 + jc] = xg * sigmoidf_(1.702f * xg) * (xl + 1.f); } } } };
struct EpiDn { float* y; const float* bdn; const int* list; const float* gate; int m0; int cnt; int n0;
    __device__ __forceinline__ void operator()(const f4 (&acc)[4][2], int wr, int wc, int fr, int fq) const {
#pragma unroll
        for (int m = 0; m < 4; ++m)
#pragma unroll
            for (int j = 0; j < 4; ++j) { const int r = m0 + wr * 64 + m * 16 + fq * 4 + j;
                if (r < cnt) { const int a = list[r]; const float g = gate[a];
#pragma unroll
                    for (int n = 0; n < 2; ++n) { const int c = n0 + wc * 32 + n * 16 + fr; y[(size_t)a * 2048 + c] = (acc[m][n][j] + bdn[c]) * g; } } } } };

constexpr int WLDS_FLOATS = 4096 + 512 + 32;
template <bool SHARED>
__device__ __forceinline__ void wave_attn(float* sw, const float* __restrict__ qptr, const float* __restrict__ Kb, const float* __restrict__ Vb, int ld, int nseg, float scale, float* __restrict__ optr) {
    const int lane = threadIdx.x & 63;
    float* sq = sw + 4096; const int* segs = (const int*)(sw + 4096 + 512);
#pragma unroll
    for (int i = 0; i < 8; ++i) sq[lane + 64 * i] = qptr[lane + 64 * i];
    wave_sync();
    for (int sg = 0; sg < nseg; ++sg) {
        const int start = segs[sg], len = segs[16 + sg];
        float d0 = 0.f, d1 = 0.f, d2 = 0.f, d3 = 0.f;
        if (lane < len) {
            const float* kp = Kb + (size_t)(start + lane) * ld;
            for (int d4 = 0; d4 < 32; ++d4) {
                if (SHARED) {
                    const float4 kv = *(const float4*)(kp + d4 * 4);
                    const float4 q0 = *(const float4*)(sq + d4 * 4), q1 = *(const float4*)(sq + 128 + d4 * 4), q2 = *(const float4*)(sq + 256 + d4 * 4), q3 = *(const float4*)(sq + 384 + d4 * 4);
                    d0 += kv.x * q0.x + kv.y * q0.y + kv.z * q0.z + kv.w * q0.w;
                    d1 += kv.x * q1.x + kv.y * q1.y + kv.z * q1.z + kv.w * q1.w;
                    d2 += kv.x * q2.x + kv.y * q2.y + kv.z * q2.z + kv.w * q2.w;
                    d3 += kv.x * q3.x + kv.y * q3.y + kv.z * q3.z + kv.w * q3.w;
                } else {
                    const float4 k0 = *(const float4*)(kp + d4 * 4), k1 = *(const float4*)(kp + 128 + d4 * 4), k2 = *(const float4*)(kp + 256 + d4 * 4), k3 = *(const float4*)(kp + 384 + d4 * 4);
                    const float4 q0 = *(const float4*)(sq + d4 * 4), q1 = *(const float4*)(sq + 128 + d4 * 4), q2 = *(const float4*)(sq + 256 + d4 * 4), q3 = *(const float4*)(sq + 384 + d4 * 4);
                    d0 += k0.x * q0.x + k0.y * q0.y + k0.z * q0.z + k0.w * q0.w;
                    d1 += k1.x * q1.x + k1.y * q1.y + k1.z * q1.z + k1.w * q1.w;
                    d2 += k2.x * q2.x + k2.y * q2.y + k2.z * q2.z + k2.w * q2.w;
                    d3 += k3.x * q3.x + k3.y * q3.y + k3.z * q3.z + k3.w * q3.w;
                }
            }
        }
        const bool ok = lane < len;
        sw[sg * 64 + lane] = ok ? d0 * scale : -1e30f;
        sw[1024 + sg * 64 + lane] = ok ? d1 * scale : -1e30f;
        sw[2048 + sg * 64 + lane] = ok ? d2 * scale : -1e30f;
        sw[3072 + sg * 64 + lane] = ok ? d3 * scale : -1e30f;
    }
    wave_sync();
    const int n = nseg * 64;
#pragma unroll
    for (int g = 0; g < 4; ++g) {
        float mx = -1e30f;
        for (int i = lane; i < n; i += 64) mx = fmaxf(mx, sw[g * 1024 + i]);
        mx = wave_max(mx);
        float sm = 0.f;
        for (int i = lane; i < n; i += 64) { const float v = sw[g * 1024 + i]; sm += (v > -1e29f) ? expf(v - mx) : 0.f; }
        sm = wave_sum(sm);
        const float inv = sm > 0.f ? 1.f / sm : 0.f;
        for (int i = lane; i < n; i += 64) { const float v = sw[g * 1024 + i]; sw[g * 1024 + i] = (v > -1e29f) ? expf(v - mx) * inv : 0.f; }
    }
    wave_sync();
    float o[4][2];
#pragma unroll
    for (int g = 0; g < 4; ++g) { o[g][0] = 0.f; o[g][1] = 0.f; }
    for (int sg = 0; sg < nseg; ++sg) {
        const int start = segs[sg], len = segs[16 + sg];
        for (int l = 0; l < len; ++l) {
            const float* vp = Vb + (size_t)(start + l) * ld;
            if (SHARED) {
                const float v0 = vp[lane], v1 = vp[lane + 64];
#pragma unroll
                for (int g = 0; g < 4; ++g) { const float p = sw[g * 1024 + sg * 64 + l]; o[g][0] += p * v0; o[g][1] += p * v1; }
            } else {
#pragma unroll
                for (int g = 0; g < 4; ++g) { const float p = sw[g * 1024 + sg * 64 + l]; o[g][0] += p * vp[g * 128 + lane]; o[g][1] += p * vp[g * 128 + lane + 64]; }
            }
        }
    }
#pragma unroll
    for (int g = 0; g < 4; ++g) { optr[g * 128 + lane] = o[g][0]; optr[g * 128 + lane + 64] = o[g][1]; }
}

namespace g8 {
constexpr int BM = 256, BK = 64, HALF = 128, HTB = HALF * BK * 2, STAGE_BYTES = 8 * HTB;
constexpr int KK = 2048;
typedef float f32x4 __attribute__((ext_vector_type(4)));
__device__ __forceinline__ int lds_byte(int r, int c) { const int st = (r >> 4) * 2 + (c >> 5), rr = r & 15, cc = c & 31, ob = rr * 64 + cc * 2; return st * 1024 + (ob ^ (((ob >> 9) & 1) << 5)); }
__device__ __forceinline__ void stage_rc(int b, int& R, int& C) { const int st = b / 1024, sb = b % 1024, swz = sb ^ (((sb >> 9) & 1) << 5); R = (st >> 1) * 16 + swz / 64; C = (st & 1) * 32 + (swz % 64) / 2; }
__device__ __forceinline__ int perm32(int rho) { const int n = rho >> 4, i = rho & 15; return 8 * (i >> 2) + 4 * n + (i & 3); }

typedef int i32x4 __attribute__((ext_vector_type(4)));
typedef unsigned u32x2 __attribute__((ext_vector_type(2)));
typedef unsigned u32x4 __attribute__((ext_vector_type(4)));
template <bool I8> struct AccSel { typedef f32x4 T; };
template <> struct AccSel<true> { typedef i32x4 T; };
__device__ __forceinline__ f32x4 mma16(i32x4 a, i32x4 b, f32x4 c) { return __builtin_amdgcn_mfma_f32_16x16x32_f16(*reinterpret_cast<h8*>(&a), *reinterpret_cast<h8*>(&b), c, 0, 0, 0); }
__device__ __forceinline__ i32x4 mma16(i32x4 a, i32x4 b, i32x4 c) { return __builtin_amdgcn_mfma_i32_16x16x64_i8(a, b, c, 0, 0, 0); }
struct Unit { int m0, n0, e, cnt, rbase; };
constexpr int EP_OFF = STAGE_BYTES + 2048, EP_LD = 528, EP_GRP = 16 * EP_LD;
__device__ __forceinline__ void ep_sync() { asm volatile("s_waitcnt lgkmcnt(0)" ::: "memory"); __builtin_amdgcn_s_barrier(); asm volatile("" ::: "memory"); }
__device__ __forceinline__ int ep_tid() { int tz = threadIdx.x; asm volatile("" : "+v"(tz)); return tz; }
__device__ __forceinline__ h8 cvt8(f32x4 a, f32x4 b) { h8 o; o[0] = (_Float16)a[0]; o[1] = (_Float16)a[1]; o[2] = (_Float16)a[2]; o[3] = (_Float16)a[3]; o[4] = (_Float16)b[0]; o[5] = (_Float16)b[1]; o[6] = (_Float16)b[2]; o[7] = (_Float16)b[3]; return o; }

__device__ __forceinline__ void tile_order(int L, int nM, int nN, int& pm, int& pn) {
    const int nwg = nM * nN; int wgid = L;
    { const int q = nwg / 8, r = nwg % 8, xcd = wgid % 8, off = wgid / 8; wgid = (xcd < r ? xcd * (q + 1) : r * (q + 1) + (xcd - r) * q) + off; }
    const int nig = 8 * nN, gid = wgid / nig, fm = gid * 8, gsz = (nM - fm) < 8 ? (nM - fm) : 8;
    pm = fm + ((wgid % nig) % gsz); pn = (wgid % nig) / gsz;
}

template <class Prob>
__device__ __forceinline__ void gemm_phase(LAS unsigned char* lds, const Prob& P) {
    const int tid = threadIdx.x, wid = __builtin_amdgcn_readfirstlane(tid >> 6), lane = tid & 63, wr = wid >> 2, wc = wid & 3, fr = lane & 15, fq = lane >> 4;
    constexpr int nt = Prob::NT; constexpr size_t KS2 = Prob::KS2; constexpr unsigned ROWB = Prob::ROWB; constexpr bool I8 = Prob::I8;
    int sR[2], sC2[2]; unsigned voffB[2];
#pragma unroll
    for (int i = 0; i < 2; ++i) { int R, C; stage_rc(tid * 16 + i * 8192, R, C); sR[i] = R; sC2[i] = C * 2; const int Rb = Prob::PERM ? ((R & ~31) + perm32(R & 31)) : R; voffB[i] = (unsigned)Rb * ROWB + (unsigned)C * 2u; }
    const size_t kstep = (size_t)(BK * 2);
    const size_t hstep = (size_t)HALF * ROWB;
    const unsigned ldsw = (unsigned)wid * 1024u;
    const int aoff = lds_byte(wr * 64 + fr, fq * 8), boff = lds_byte(wc * 32 + fr, fq * 8);
#define G8_SA(b, h) (((b) * 2 + (h)) * HTB)
#define G8_SB(b, h) ((4 + (b) * 2 + (h)) * HTB)
#define G8_STAGE(bufoff, gbase, voff) do { _Pragma("unroll") for (int _i = 0; _i < 2; ++_i) \
        __builtin_amdgcn_global_load_lds((const unsigned*)((const char*)(gbase) + (voff)[_i]), (LAS unsigned*)(lds + (bufoff) + ldsw + _i * 8192), 16, 0, 0); } while (0)
#define G8_LDA(dst, b, h) do { _Pragma("unroll") for (int m = 0; m < 4; ++m) _Pragma("unroll") for (int k = 0; k < 2; ++k) dst[m][k] = *(const LAS i32x4*)(lds + G8_SA(b, h) + aoff + m * 2048 + k * 1024); } while (0)
#define G8_LDB(dst, b, h) do { _Pragma("unroll") for (int n = 0; n < 2; ++n) _Pragma("unroll") for (int k = 0; k < 2; ++k) dst[n][k] = *(const LAS i32x4*)(lds + G8_SB(b, h) + boff + n * 2048 + k * 1024); } while (0)
#define G8_MMA(ai, bj, At, Bt) do { __builtin_amdgcn_s_setprio(1); _Pragma("unroll") for (int m = 0; m < 4; ++m) _Pragma("unroll") for (int n = 0; n < 2; ++n) _Pragma("unroll") for (int k = 0; k < 2; ++k) \
        acc[ai][bj][m][n] = mma16(Bt[n][k], At[m][k], acc[ai][bj][m][n]); __builtin_amdgcn_s_setprio(0); } while (0)
#define G8_WAIT_V(n) asm volatile("s_waitcnt vmcnt(" #n ")" ::: "memory")
#define G8_WAIT_L(n) asm volatile("s_waitcnt lgkmcnt(" #n ")" ::: "memory")
#define G8_BAR __builtin_amdgcn_s_barrier()
#define G8_SCHED __builtin_amdgcn_sched_barrier(0)
    Unit cur, nxt; int ui = 0;
    if (!P.next(0, cur)) return;
    typedef typename AccSel<I8>::T AccT;
    AccT acc[2][2][4][2];
#pragma unroll
    for (int a = 0; a < 2; ++a)
#pragma unroll
        for (int b = 0; b < 2; ++b)
#pragma unroll
            for (int m = 0; m < 4; ++m)
#pragma unroll
                for (int n = 0; n < 2; ++n) acc[a][b][m][n] = AccT{};
    i32x4 At[4][2], B0[2][2], B1[2][2];
    unsigned vc[2][2], vn[2][2];
    P.a_offs(cur, sR, sC2, vc);
    const char* const Ab = P.a_base();
    const char* cB = P.b_base(cur);
    G8_STAGE(G8_SB(0, 0), cB, voffB); G8_STAGE(G8_SA(0, 0), Ab, vc[0]); G8_STAGE(G8_SB(0, 1), cB + hstep, voffB); G8_STAGE(G8_SA(0, 1), Ab, vc[1]);
    if (wr == 1) G8_BAR;
    G8_WAIT_V(4); G8_BAR;
    G8_STAGE(G8_SB(1, 0), cB + kstep, voffB); G8_STAGE(G8_SA(1, 0), Ab + kstep, vc[0]); G8_STAGE(G8_SB(1, 1), cB + hstep + kstep, voffB);
    G8_WAIT_V(6); G8_BAR;
    for (;;) {
        const bool has_next = P.next(ui + 1, nxt);
        const char* nB = cB;
        if (has_next) { P.a_offs(nxt, sR, sC2, vn); nB = P.b_base(nxt); }
        else { vn[0][0] = vc[0][0]; vn[0][1] = vc[0][1]; vn[1][0] = vc[1][0]; vn[1][1] = vc[1][1]; }
        for (int t = 0; t < nt; t += 2) {
            const bool last = (t == nt - 2);
            const char* a1 = Ab + (size_t)(t >> 1) * KS2 + kstep;
            const char* a2 = last ? Ab : Ab + (size_t)((t + 2) >> 1) * KS2; const char* b2 = last ? nB : cB + (size_t)(t + 2) * kstep;
            const char* a3 = a2 + kstep; const char* b3 = b2 + kstep;
            unsigned o2[2][2];
            o2[0][0] = last ? vn[0][0] : vc[0][0]; o2[0][1] = last ? vn[0][1] : vc[0][1]; o2[1][0] = last ? vn[1][0] : vc[1][0]; o2[1][1] = last ? vn[1][1] : vc[1][1];
            G8_LDB(B0, 0, 0); G8_SCHED; G8_LDA(At, 0, 0); G8_STAGE(G8_SA(1, 1), a1, vc[1]);
            G8_WAIT_L(8); G8_BAR; G8_WAIT_L(0); G8_MMA(0, 0, At, B0); G8_BAR; G8_SCHED;
            G8_LDB(B1, 0, 1); G8_STAGE(G8_SB(0, 0), b2, voffB);
            G8_BAR; G8_WAIT_L(0); G8_MMA(0, 1, At, B1); G8_BAR;
            G8_LDA(At, 0, 1); G8_STAGE(G8_SA(0, 0), a2, o2[0]);
            G8_BAR; G8_WAIT_L(0); G8_MMA(1, 0, At, B0); G8_BAR; G8_SCHED;
            G8_STAGE(G8_SB(0, 1), b2 + hstep, voffB);
            G8_WAIT_V(6); G8_BAR; G8_MMA(1, 1, At, B1); G8_BAR;
            G8_LDB(B0, 1, 0); G8_SCHED; G8_LDA(At, 1, 0); G8_STAGE(G8_SA(0, 1), a2, o2[1]);
            G8_WAIT_L(8); G8_BAR; G8_WAIT_L(0); G8_MMA(0, 0, At, B0); G8_BAR; G8_SCHED;
            G8_LDB(B1, 1, 1); G8_STAGE(G8_SB(1, 0), b3, voffB);
            G8_BAR; G8_WAIT_L(0); G8_MMA(0, 1, At, B1); G8_BAR;
            G8_LDA(At, 1, 1); G8_STAGE(G8_SA(1, 0), a3, o2[0]);
            G8_BAR; G8_WAIT_L(0); G8_MMA(1, 0, At, B0); G8_BAR; G8_SCHED;
            G8_STAGE(G8_SB(1, 1), b3 + hstep, voffB);
            G8_WAIT_V(6); G8_BAR; G8_MMA(1, 1, At, B1); G8_BAR;
        }
        P.epi(acc, cur, wr, wc, fr, fq, lds);
        if (!has_next) break;
#pragma unroll
        for (int a = 0; a < 2; ++a)
#pragma unroll
            for (int b = 0; b < 2; ++b)
#pragma unroll
                for (int m = 0; m < 4; ++m)
#pragma unroll
                    for (int n = 0; n < 2; ++n) acc[a][b][m][n] = AccT{};
        cur = nxt; cB = nB; ++ui;
        vc[0][0] = vn[0][0]; vc[0][1] = vn[0][1]; vc[1][0] = vn[1][0]; vc[1][1] = vn[1][1];
    }
    G8_WAIT_V(0);
    if (wr == 0) G8_BAR;
    G8_BAR;
#undef G8_SA
#undef G8_SB
#undef G8_STAGE
#undef G8_LDA
#undef G8_LDB
#undef G8_MMA
#undef G8_WAIT_V
#undef G8_WAIT_L
#undef G8_BAR
#undef G8_SCHED
}

struct ProbInF {
    static constexpr unsigned ROWB = 4096; static constexpr bool I8 = false;
    static constexpr int NT = 32; static constexpr size_t KS2 = 256;
    static constexpr bool PERM = true;
    const _Float16* A; _Float16* C16; int G, c;
    __device__ __forceinline__ bool next(int i, Unit& u) const { const int L = i * G + c; if (L >= 64 * 5) return false;
        int pm, pn; tile_order(L, 64, 5, pm, pn); u.m0 = pm * 256; u.n0 = pn * 256; u.e = 0; u.cnt = 256; u.rbase = 0; return true; }
    __device__ __forceinline__ void a_offs(const Unit& u, const int (&R)[2], const int (&C2)[2], unsigned (&v)[2][2]) const {
#pragma unroll
        for (int h = 0; h < 2; ++h)
#pragma unroll
            for (int i = 0; i < 2; ++i) v[h][i] = (unsigned)(u.m0 + h * 128 + R[i]) * (unsigned)(KK * 2) + (unsigned)C2[i]; }
    __device__ __forceinline__ const char* a_base() const { return (const char*)A; }
    __device__ __forceinline__ const char* b_base(const Unit& u) const { return (const char*)A + (long long)(WS_WTIN - WS_X16) + (size_t)u.n0 * KK * 2; }
    __device__ __forceinline__ void epi(const f32x4 (&acc)[2][2][4][2], const Unit& u, int wr, int wc, int fr, int fq, LAS unsigned char* lds) const {
        LAS unsigned char* ep = lds + EP_OFF + wr * EP_GRP;
        const int tg = ep_tid() & 255, rrow = tg >> 4, ch = tg & 15;
        const int kvseg = (u.e == 0 && u.n0 >= 1024 && u.n0 < 2560) ? ((u.n0 - 1024) >> 8) : -1;
        _Float16* const Cb = (_Float16*)((char*)C16 + (u.e ? (long long)(WS_KVMEM16 - WS_PROJ16) : 0ll)); const int ldc = u.e ? 1024 : INW, nlim = u.e ? 1024 : INW, mb = u.e ? u.m0 - T_ : u.m0;
#pragma unroll
        for (int ai = 0; ai < 2; ++ai)
#pragma unroll
            for (int m = 0; m < 4; ++m) {
#pragma unroll
                for (int bj = 0; bj < 2; ++bj) *(LAS h8*)(ep + fr * EP_LD + (bj * 128 + wc * 32 + fq * 8) * 2) = cvt8(acc[ai][bj][m][0], acc[ai][bj][m][1]);
                ep_sync();
                const h8 x0 = *(const LAS h8*)(ep + rrow * EP_LD + ch * 32), x1 = *(const LAS h8*)(ep + rrow * EP_LD + ch * 32 + 16);
                const int grow = mb + ai * 128 + wr * 64 + m * 16 + rrow, gcol = u.n0 + ch * 16;
                if (kvseg >= 0) {
                    _Float16* dst = (_Float16*)((char*)C16 + (long long)(WS_KV16 - WS_PROJ16)) + ((size_t)(kvseg * B_ + (grow >> 11)) * 2 + (ch >> 3)) * KVSEG + (size_t)(grow & (S_ - 1)) * 128 + (ch & 7) * 16;
                    *(h8*)dst = x0; *(h8*)(dst + 8) = x1;
                } else {
                    if (gcol < nlim) *(h8*)(Cb + (size_t)grow * ldc + gcol) = x0;
                    if (gcol + 8 < nlim) *(h8*)(Cb + (size_t)grow * ldc + gcol + 8) = x1; }
                ep_sync();
            } }
};
struct ProbIn8 {
    static constexpr unsigned ROWB = 2048; static constexpr bool I8 = true;
    static constexpr int NT = 16; static constexpr size_t KS2 = 256;
    static constexpr bool PERM = true;
    const signed char* A; _Float16* C16; const float* sa; int G, c;
    __device__ __forceinline__ bool next(int i, Unit& u) const { const int L = i * G + c; if (L >= 640 + 32) return false;
        if (L < 640) { int pm, pn; tile_order(L, 64, 10, pm, pn); u.m0 = pm * 256; u.n0 = 1280 + pn * 256; u.e = 0; }
        else { const int v = L - 640; u.m0 = T_ + (v & 7) * 256; u.n0 = (v >> 3) * 256; u.e = 1; }
        u.cnt = 256; u.rbase = 0; return true; }
    __device__ __forceinline__ void a_offs(const Unit& u, const int (&R)[2], const int (&C2)[2], unsigned (&v)[2][2]) const {
#pragma unroll
        for (int h = 0; h < 2; ++h)
#pragma unroll
            for (int i = 0; i < 2; ++i) v[h][i] = (unsigned)(u.m0 + h * 128 + R[i]) * 2048u + (unsigned)C2[i]; }
    __device__ __forceinline__ const char* a_base() const { return (const char*)A; }
    __device__ __forceinline__ const char* b_base(const Unit& u) const { return (const char*)A + (u.e ? (long long)(WS_Q8MKV - WS_X8) + (long long)u.n0 * 2048 : (long long)(WS_Q8IN - WS_X8) + (long long)(u.n0 - 1280) * 2048); }
    __device__ __forceinline__ void epi(const i32x4 (&acc)[2][2][4][2], const Unit& u, int wr, int wc, int fr, int fq, LAS unsigned char* lds) const {
        LAS unsigned char* ep = lds + EP_OFF + wr * EP_GRP;
        const int tg = ep_tid() & 255, rrow = tg >> 4, ch = tg & 15;
        const int kvseg = (u.e == 0 && u.n0 >= 1024 && u.n0 < 2560) ? ((u.n0 - 1024) >> 8) : -1;
        _Float16* const Cb = (_Float16*)((char*)C16 + (u.e ? (long long)(WS_KVMEM16 - WS_PROJ16) : 0ll)); const int ldc = u.e ? 1024 : INW, nlim = u.e ? 1024 : INW, mb = u.e ? u.m0 - T_ : u.m0;
        const float* sw = (const float*)((const char*)A + (u.e ? (long long)(WS_SMKV - WS_X8) : (long long)(WS_SIN8 - WS_X8))) + (u.e ? u.n0 : u.n0 - 1280);
        f32x4 s0[2], s1[2]; float srv[8];
#pragma unroll
        for (int bj = 0; bj < 2; ++bj) { const int col = bj * 128 + wc * 32 + fq * 8; s0[bj] = *(const f32x4*)(sw + col); s1[bj] = *(const f32x4*)(sw + col + 4); }
#pragma unroll
        for (int q = 0; q < 8; ++q) srv[q] = sa[u.m0 + (q >> 2) * 128 + wr * 64 + (q & 3) * 16 + fr];
#pragma unroll
        for (int ai = 0; ai < 2; ++ai)
#pragma unroll
            for (int m = 0; m < 4; ++m) { const float sr = srv[ai * 4 + m];
#pragma unroll
                for (int bj = 0; bj < 2; ++bj) { const i32x4 i0 = acc[ai][bj][m][0], i1 = acc[ai][bj][m][1];
                    *(LAS h8*)(ep + fr * EP_LD + (bj * 128 + wc * 32 + fq * 8) * 2) = cvt8((f32x4){(float)i0[0], (float)i0[1], (float)i0[2], (float)i0[3]} * (s0[bj] * sr), (f32x4){(float)i1[0], (float)i1[1], (float)i1[2], (float)i1[3]} * (s1[bj] * sr)); }
                ep_sync();
                const h8 x0 = *(const LAS h8*)(ep + rrow * EP_LD + ch * 32), x1 = *(const LAS h8*)(ep + rrow * EP_LD + ch * 32 + 16);
                const int grow = mb + ai * 128 + wr * 64 + m * 16 + rrow, gcol = u.n0 + ch * 16;
                if (kvseg >= 0) {
                    _Float16* dst = (_Float16*)((char*)C16 + (long long)(WS_KV16 - WS_PROJ16)) + ((size_t)(kvseg * B_ + (grow >> 11)) * 2 + (ch >> 3)) * KVSEG + (size_t)(grow & (S_ - 1)) * 128 + (ch & 7) * 16;
                    *(h8*)dst = x0; *(h8*)(dst + 8) = x1;
                } else {
                    if (gcol < nlim) *(h8*)(Cb + (size_t)grow * ldc + gcol) = x0;
                    if (gcol + 8 < nlim) *(h8*)(Cb + (size_t)grow * ldc + gcol + 8) = x1; }
                ep_sync();
            } }
};
struct ProbOut {
    static constexpr unsigned ROWB = 2048; static constexpr bool I8 = true;
    static constexpr int NT = 16; static constexpr size_t KS2 = 256;
    static constexpr bool PERM = true;
    const signed char* A; const signed char* Bt; _Float16* C; const _Float16* X; const float* sa; const float* sw; int G, c;
    __device__ __forceinline__ bool next(int i, Unit& u) const { const int L = i * G + c; if (L >= 64 * 8) return false; int pm, pn; tile_order(L, 64, 8, pm, pn); u.m0 = pm * 256; u.n0 = pn * 256; u.e = 0; u.cnt = 256; u.rbase = 0; return true; }
    __device__ __forceinline__ void a_offs(const Unit& u, const int (&R)[2], const int (&C2)[2], unsigned (&v)[2][2]) const {
#pragma unroll
        for (int h = 0; h < 2; ++h)
#pragma unroll
            for (int i = 0; i < 2; ++i) v[h][i] = (unsigned)(u.m0 + h * 128 + R[i]) * 2048u + (unsigned)C2[i]; }
    __device__ __forceinline__ const char* a_base() const { return (const char*)A; }
    __device__ __forceinline__ const char* b_base(const Unit& u) const { return (const char*)(Bt + (size_t)u.n0 * 2048); }
    __device__ __forceinline__ void epi(const i32x4 (&acc)[2][2][4][2], const Unit& u, int wr, int wc, int fr, int fq, LAS unsigned char* lds) const {
        LAS unsigned char* ep = lds + EP_OFF + wr * EP_GRP;
        const int tg = ep_tid() & 255, rrow = tg >> 4, ch = tg & 15;
        f32x4 s0[2], s1[2]; float srv[8];
#pragma unroll
        for (int bj = 0; bj < 2; ++bj) { const int col = u.n0 + bj * 128 + wc * 32 + fq * 8; s0[bj] = *(const f32x4*)(sw + col); s1[bj] = *(const f32x4*)(sw + col + 4); }
#pragma unroll
        for (int q = 0; q < 8; ++q) srv[q] = sa[u.m0 + (q >> 2) * 128 + wr * 64 + (q & 3) * 16 + fr];
#pragma unroll
        for (int ai = 0; ai < 2; ++ai)
#pragma unroll
            for (int m = 0; m < 4; ++m) { const float sr = srv[ai * 4 + m];
#pragma unroll
                for (int bj = 0; bj < 2; ++bj) { const i32x4 i0 = acc[ai][bj][m][0], i1 = acc[ai][bj][m][1];
                    *(LAS h8*)(ep + fr * EP_LD + (bj * 128 + wc * 32 + fq * 8) * 2) = cvt8((f32x4){(float)i0[0], (float)i0[1], (float)i0[2], (float)i0[3]} * (s0[bj] * sr), (f32x4){(float)i1[0], (float)i1[1], (float)i1[2], (float)i1[3]} * (s1[bj] * sr)); }
                const size_t go = (size_t)(u.m0 + ai * 128 + wr * 64 + m * 16 + rrow) * 2048 + u.n0 + ch * 16;
                const h8 r0 = *(const h8*)(X + go), r1 = *(const h8*)(X + go + 8);
                ep_sync();
                const h8 x0 = *(const LAS h8*)(ep + rrow * EP_LD + ch * 32), x1 = *(const LAS h8*)(ep + rrow * EP_LD + ch * 32 + 16);
                h8 o0, o1;
#pragma unroll
                for (int q = 0; q < 8; ++q) { o0[q] = (_Float16)(DN_ALPHA * (float)r0[q] + (float)x0[q]); o1[q] = (_Float16)(DN_ALPHA * (float)r1[q] + (float)x1[q]); }
                *(h8*)(C + go) = o0; *(h8*)(C + go + 8) = o1;
                ep_sync();
            } }
};
struct ProbCmp {
    static constexpr unsigned ROWB = 4096; static constexpr bool I8 = false;
    static constexpr int NT = 8; static constexpr size_t KS2 = 256;
    static constexpr bool PERM = false;
    const _Float16* A; const _Float16* Bt; float* C; int G, c;
    __device__ __forceinline__ bool next(int i, Unit& u) const { const int L = i * G + c; if (L >= 128) return false;
        u.e = L >> 6; const int r = L & 63; u.rbase = r & 3; u.n0 = ((r >> 2) & 1) * 256; u.m0 = (r >> 3) * 256; u.cnt = 256; return true; }
    __device__ __forceinline__ void a_offs(const Unit& u, const int (&R)[2], const int (&C2)[2], unsigned (&v)[2][2]) const {
#pragma unroll
        for (int h = 0; h < 2; ++h)
#pragma unroll
            for (int i = 0; i < 2; ++i) { const int row = u.m0 + h * 128 + R[i], kvh = row & 1, bj = row >> 1, b = bj >> 7, j = bj & 127;
                v[h][i] = (unsigned)((((u.e * B_ + b) * 2 + kvh) * S_ + 16 * j + 4 * u.rbase) * 128) * 2u + (unsigned)C2[i]; } }
    __device__ __forceinline__ const char* a_base() const { return (const char*)A; }
    __device__ __forceinline__ const char* b_base(const Unit& u) const { return (const char*)(Bt + ((size_t)u.e * 512 + u.n0) * KK + u.rbase * 512); }
    __device__ __forceinline__ void epi(const f32x4 (&acc)[2][2][4][2], const Unit& u, int wr, int wc, int fr, int fq, LAS unsigned char*) const {
        float* base = C + ((size_t)(u.e * 4 + u.rbase) * 2048) * 512;
#pragma unroll
        for (int ai = 0; ai < 2; ++ai)
#pragma unroll
            for (int m = 0; m < 4; ++m) { const int row = u.m0 + ai * 128 + wr * 64 + m * 16 + fr;
#pragma unroll
                for (int bj = 0; bj < 2; ++bj)
#pragma unroll
                    for (int n = 0; n < 2; ++n) { const int col = u.n0 + bj * 128 + wc * 32 + n * 16 + fq * 4;
                        *(f32x4*)(base + (size_t)row * 512 + col) = acc[ai][bj][m][n]; } } }
};
struct MoeTab { const LAS int* t; int NT;
    __device__ __forceinline__ bool find_i(int i, Unit& u) const {
        const LAS int* q = t + 128 + 8 * i;
        if (__builtin_amdgcn_readfirstlane(q[5]) == 0) return false;
        u.e = __builtin_amdgcn_readfirstlane(q[0]); u.m0 = __builtin_amdgcn_readfirstlane(q[1]); u.n0 = __builtin_amdgcn_readfirstlane(q[2]); u.cnt = __builtin_amdgcn_readfirstlane(q[3]); u.rbase = __builtin_amdgcn_readfirstlane(q[4]); return true; } };
__device__ __forceinline__ void moe_build(LAS int* t, int G, int vcu) {
    const int i = threadIdx.x;
    if (i < 40) { const int L = i * G + vcu; LAS int* q = t + 128 + 8 * i;
        if (L >= t[98]) q[5] = 0;
        else { int e = 0; for (; e < NE - 1; ++e) { if (L < t[32 + e + 1]) break; }
            const int ub = t[32 + e], cn = t[e], rs = t[65 + e]; const int nm = (cn + 255) >> 8, v = L - ub, mt = v % nm, ntile = v / nm;
            q[0] = e; q[1] = mt * 256; q[2] = ntile * 256; q[3] = min(256, cn - mt * 256); q[4] = rs; q[5] = 1; } }
}
struct ProbGu {
    static constexpr int NT = 16; static constexpr size_t KS2 = 256; static constexpr unsigned ROWB = 2048; static constexpr bool I8 = true;
    static constexpr bool PERM = true;
    const signed char* A; const signed char* Bt; unsigned char* act; const float* bgu; const int* list; const float* sa; const float* sw; MoeTab tab; int G, vcu;
    __device__ __forceinline__ bool next(int i, Unit& u) const { return tab.find_i(i, u); }
    __device__ __forceinline__ void a_offs(const Unit& u, const int (&R)[2], const int (&C2)[2], unsigned (&v)[2][2]) const {
#pragma unroll
        for (int h = 0; h < 2; ++h)
#pragma unroll
            for (int i = 0; i < 2; ++i) { int r = h * 128 + R[i]; r = r < u.cnt ? r : 0; const int a = list[(size_t)u.e * T_ + u.m0 + r]; v[h][i] = (unsigned)(a >> 2) * 2048u + (unsigned)C2[i]; } }
    __device__ __forceinline__ const char* a_base() const { return (const char*)A; }
    __device__ __forceinline__ const char* b_base(const Unit& u) const { return (const char*)(Bt + ((size_t)u.e * 4096 + u.n0) * 2048); }
    __device__ __forceinline__ void epi(const i32x4 (&acc)[2][2][4][2], const Unit& u, int wr, int wc, int fr, int fq, LAS unsigned char* lds) const {
        const float* bb = bgu + (size_t)u.e * 4096; const float* ss = sw + (size_t)u.e * 4096;
        LAS unsigned char* ep = lds + EP_OFF + wr * EP_GRP;
        const int tg = ep_tid() & 255, rrow = tg >> 4, ch = tg & 15;
        f32x4 b0[2], b1[2], s0[2], s1[2];
#pragma unroll
        for (int bj = 0; bj < 2; ++bj) { const int col = u.n0 + bj * 128 + wc * 32 + fq * 8;
            b0[bj] = *(const f32x4*)(bb + col); b1[bj] = *(const f32x4*)(bb + col + 4); s0[bj] = *(const f32x4*)(ss + col); s1[bj] = *(const f32x4*)(ss + col + 4); }
        float srv[8];
        { int av[8];
#pragma unroll
          for (int q = 0; q < 8; ++q) { const int rl = (q >> 2) * 128 + wr * 64 + (q & 3) * 16 + fr; av[q] = list[(size_t)u.e * T_ + u.m0 + (rl < u.cnt ? rl : 0)]; }
#pragma unroll
          for (int q = 0; q < 8; ++q) srv[q] = sa[av[q] >> 2]; }
        LAS unsigned char* ep2 = lds + EP_OFF + wr * (2 * 4608);
#define GU_WRITE(st) do { const int ai_ = (st) >> 1, mp_ = (st) & 1; LAS unsigned char* eb = ep2 + ((st) & 1) * 4608; \
            _Pragma("unroll") for (int mm = 0; mm < 2; ++mm) { const int m_ = mp_ * 2 + mm; const float sr = srv[ai_ * 4 + m_]; \
                _Pragma("unroll") for (int bj = 0; bj < 2; ++bj) { const i32x4 i0 = acc[ai_][bj][m_][0], i1 = acc[ai_][bj][m_][1]; \
                    const f32x4 v0 = (f32x4){(float)i0[0], (float)i0[1], (float)i0[2], (float)i0[3]} * (s0[bj] * sr) + b0[bj], v1 = (f32x4){(float)i1[0], (float)i1[1], (float)i1[2], (float)i1[3]} * (s1[bj] * sr) + b1[bj]; \
                    *(LAS unsigned*)(eb + (mm * 16 + fr) * 144 + (bj * 64 + wc * 16 + fq * 4)) = pk4_fp8(swiglu_fast(v0[0], v0[1]), swiglu_fast(v0[2], v0[3]), swiglu_fast(v1[0], v1[1]), swiglu_fast(v1[2], v1[3])); } } } while (0)
        GU_WRITE(0);
        ep_sync();
#pragma unroll
        for (int st = 0; st < 4; ++st) {
            if (st + 1 < 4) GU_WRITE(st + 1);
#pragma unroll
            for (int mm = 0; mm < 2; ++mm) { const u32x2 x0 = *(const LAS u32x2*)(ep2 + (st & 1) * 4608 + (mm * 16 + rrow) * 144 + ch * 8);
                const int rr = (st >> 1) * 128 + wr * 64 + ((st & 1) * 2 + mm) * 16 + rrow;
                if (rr < u.cnt) *(u32x2*)(act + (size_t)(u.rbase + u.m0 + rr) * 2048 + (u.n0 >> 1) + ch * 8) = x0; }
            ep_sync();
        }
#undef GU_WRITE
    }
};
struct ProbDn {
    static constexpr int NT = 16; static constexpr size_t KS2 = 256; static constexpr unsigned ROWB = 2048; static constexpr bool I8 = true;
    static constexpr bool PERM = true;
    const signed char* A; const signed char* Bt; unsigned char* y; const float* bdn; const int* list; const float* gate; const float* sa; const float* sw; MoeTab tab; int G, vcu;
    __device__ __forceinline__ bool next(int i, Unit& u) const { return tab.find_i(i, u); }
    __device__ __forceinline__ void a_offs(const Unit& u, const int (&R)[2], const int (&C2)[2], unsigned (&v)[2][2]) const {
#pragma unroll
        for (int h = 0; h < 2; ++h)
#pragma unroll
            for (int i = 0; i < 2; ++i) v[h][i] = (unsigned)(u.rbase + u.m0 + h * 128 + R[i]) * 2048u + (unsigned)C2[i]; }
    __device__ __forceinline__ const char* a_base() const { return (const char*)A; }
    __device__ __forceinline__ const char* b_base(const Unit& u) const { return (const char*)(Bt + ((size_t)u.e * 2048 + u.n0) * 2048); }
    __device__ __forceinline__ void epi(const i32x4 (&acc)[2][2][4][2], const Unit& u, int wr, int wc, int fr, int fq, LAS unsigned char* lds) const {
        const float* bb = bdn + (size_t)u.e * 2048; const float* ss = sw + (size_t)u.e * 2048;
        LAS unsigned char* ep = lds + EP_OFF + wr * (2 * 4352);
        const int tg = ep_tid() & 255, rrow = tg >> 4, ch = tg & 15;
        f32x4 b0[2], b1[2], s0[2], s1[2];
#pragma unroll
        for (int bj = 0; bj < 2; ++bj) { const int col = u.n0 + bj * 128 + wc * 32 + fq * 8;
            b0[bj] = *(const f32x4*)(bb + col); b1[bj] = *(const f32x4*)(bb + col + 4); s0[bj] = *(const f32x4*)(ss + col); s1[bj] = *(const f32x4*)(ss + col + 4); }
        float gv[8], srv[8]; int a2v[8];
        { int av[8];
#pragma unroll
          for (int q = 0; q < 8; ++q) { const int rl = (q >> 2) * 128 + wr * 64 + (q & 3) * 16 + fr, rc = rl < u.cnt ? rl : 0; av[q] = list[(size_t)u.e * T_ + u.m0 + rc]; srv[q] = sa[u.rbase + u.m0 + rc];
              const int rr = (q >> 2) * 128 + wr * 64 + (q & 3) * 16 + rrow; a2v[q] = list[(size_t)u.e * T_ + u.m0 + (rr < u.cnt ? rr : 0)]; }
#pragma unroll
          for (int q = 0; q < 8; ++q) gv[q] = gate[av[q]]; }
#define DN_WRITE(st) do { const int ai_ = (st) >> 2, m_ = (st) & 3; const float g = gv[st] * 16.f, sr = srv[st]; LAS unsigned char* eb = ep + ((st) & 1) * 4352; \
            _Pragma("unroll") for (int bj = 0; bj < 2; ++bj) { const i32x4 i0 = acc[ai_][bj][m_][0], i1 = acc[ai_][bj][m_][1]; \
                const f32x4 v0 = ((f32x4){(float)i0[0], (float)i0[1], (float)i0[2], (float)i0[3]} * (s0[bj] * sr) + b0[bj]) * g, v1 = ((f32x4){(float)i1[0], (float)i1[1], (float)i1[2], (float)i1[3]} * (s1[bj] * sr) + b1[bj]) * g; \
                u32x2 o; o[0] = pk4_fp8(v0[0], v0[1], v0[2], v0[3]); o[1] = pk4_fp8(v1[0], v1[1], v1[2], v1[3]); \
                *(LAS u32x2*)(eb + fr * 272 + (bj * 128 + wc * 32 + fq * 8)) = o; } } while (0)
        DN_WRITE(0);
        ep_sync();
#pragma unroll
        for (int st = 0; st < 8; ++st) {
            if (st + 1 < 8) DN_WRITE(st + 1);
            const int rr = (st >> 2) * 128 + wr * 64 + (st & 3) * 16 + rrow;
            const u32x4 x0 = *(const LAS u32x4*)(ep + (st & 1) * 4352 + rrow * 272 + ch * 16);
            if (rr < u.cnt) *(u32x4*)(y + (size_t)a2v[st] * 2048 + u.n0 + ch * 16) = x0;
            ep_sync();
        }
#undef DN_WRITE
    }
};
}

namespace at8 {
typedef float f32x16 __attribute__((ext_vector_type(16)));
typedef short s16x4 __attribute__((ext_vector_type(4)));
typedef unsigned u32x4 __attribute__((ext_vector_type(4)));
constexpr int SHM_V = 64 * 128 * 2, SHM_K = 64 * 128 * 2;
constexpr int LDS_WS = 2 * SHM_V + 2 * SHM_K;
constexpr int LDS_END = LDS_WS + 8 * 64 * 4;
constexpr float CEXP = ATT_SCALE * 1.4426950408889634f;
constexpr float THR_RAW = 8.f / ATT_SCALE;
#define AT_KSWZ(row, colB) ((row) * 256 + ((colB) ^ (((row) & 7) << 4)))
#define AT_SBAR() __builtin_amdgcn_sched_barrier(0)
__device__ __forceinline__ int crow(int r, int hi) { return (r & 3) + 8 * (r >> 2) + 4 * hi; }
__device__ __forceinline__ unsigned cvtpk(float lo, float hi) { auto v = __builtin_amdgcn_cvt_pkrtz(lo, hi); return *reinterpret_cast<unsigned*>(&v); }
__device__ __forceinline__ int v_st(int k, int c) { const int kk = (k & ~0xC) | ((k & 4) << 1) | ((k & 8) >> 1); return ((kk >> 3) * 4 + (c >> 5)) * 512 + ((kk & 7) * 32 + (c & 31)) * 2; }
__device__ __forceinline__ int v_rd_base(int lane) { return ((lane & 3) << 3) | (((lane >> 2) & 3) << 6) | (((lane >> 4) & 1) << 5) | (((lane >> 5) & 1) << 8); }
constexpr int v_rd_off(int d0, int ks, int half) { return d0 * 512 + ks * 4096 + half * 2048; }
template <int OFF> __device__ __forceinline__ s16x4 tr_read(int vb) { s16x4 r; asm volatile("ds_read_b64_tr_b16 %0, %1 offset:%2" : "=&v"(r) : "v"(vb), "i"(OFF) : "memory"); return r; }
__device__ __forceinline__ h8 mk8(s16x4 l, s16x4 h) { typedef short s16x8 __attribute__((ext_vector_type(8))); s16x8 w = {l[0], l[1], l[2], l[3], h[0], h[1], h[2], h[3]}; return *reinterpret_cast<h8*>(&w); }
struct VFrag { s16x4 l0, h0, l1, h1, l2, h2, l3, h3; };
template <int D0> __device__ __forceinline__ void pv_read(VFrag& f, int vb) {
    f.l0 = tr_read<v_rd_off(D0, 0, 0)>(vb); f.h0 = tr_read<v_rd_off(D0, 0, 1)>(vb); f.l1 = tr_read<v_rd_off(D0, 1, 0)>(vb); f.h1 = tr_read<v_rd_off(D0, 1, 1)>(vb);
    f.l2 = tr_read<v_rd_off(D0, 2, 0)>(vb); f.h2 = tr_read<v_rd_off(D0, 2, 1)>(vb); f.l3 = tr_read<v_rd_off(D0, 3, 0)>(vb); f.h3 = tr_read<v_rd_off(D0, 3, 1)>(vb);
}
__device__ __forceinline__ void pv_mma(f32x16& od, const VFrag& f, h8 pa0, h8 pa1, h8 pa2, h8 pa3) {
    od = __builtin_amdgcn_mfma_f32_32x32x16_f16(pa0, mk8(f.l0, f.h0), od, 0, 0, 0);
    od = __builtin_amdgcn_mfma_f32_32x32x16_f16(pa1, mk8(f.l1, f.h1), od, 0, 0, 0);
    od = __builtin_amdgcn_mfma_f32_32x32x16_f16(pa2, mk8(f.l2, f.h2), od, 0, 0, 0);
    od = __builtin_amdgcn_mfma_f32_32x32x16_f16(pa3, mk8(f.l3, f.h3), od, 0, 0, 0);
}
__device__ __forceinline__ void pv_d0(f32x16 (&o)[4], int vb, h8 pa0, h8 pa1, h8 pa2, h8 pa3) {
    VFrag fa, fb;
    pv_read<0>(fa, vb); pv_read<1>(fb, vb);
    asm volatile("s_waitcnt lgkmcnt(8)" ::: "memory"); AT_SBAR();
    pv_mma(o[0], fa, pa0, pa1, pa2, pa3); AT_SBAR();
    pv_read<2>(fa, vb);
    asm volatile("s_waitcnt lgkmcnt(8)" ::: "memory"); AT_SBAR();
    pv_mma(o[1], fb, pa0, pa1, pa2, pa3); AT_SBAR();
    pv_read<3>(fb, vb);
    asm volatile("s_waitcnt lgkmcnt(8)" ::: "memory"); AT_SBAR();
    pv_mma(o[2], fa, pa0, pa1, pa2, pa3); AT_SBAR();
    asm volatile("s_waitcnt lgkmcnt(0)" ::: "memory"); AT_SBAR();
    pv_mma(o[3], fb, pa0, pa1, pa2, pa3);
}
__device__ __forceinline__ void qkt(f32x16& p0, f32x16& p1, const char* Ks, const h8 (&qr)[8], int r32, int hi) {
    p0 = f32x16{}; p1 = f32x16{};
#pragma unroll
    for (int d0 = 0; d0 < 8; ++d0) { const int cb = (d0 * 16 + hi * 8) * 2;
        const h8 b0 = *reinterpret_cast<const h8*>(Ks + AT_KSWZ(r32, cb));
        const h8 b1 = *reinterpret_cast<const h8*>(Ks + AT_KSWZ(32 + r32, cb));
        p0 = __builtin_amdgcn_mfma_f32_32x32x16_f16(b0, qr[d0], p0, 0, 0, 0);
        p1 = __builtin_amdgcn_mfma_f32_32x32x16_f16(b1, qr[d0], p1, 0, 0, 0); }
}
__device__ __forceinline__ void pack_p(const f32x16& p0, const f32x16& p1, h8& pa0, h8& pa1, h8& pa2, h8& pa3) {
#define AT_PK4(P, BASE, OUT) do { unsigned a0 = cvtpk(P[BASE + 0], P[BASE + 1]), a1 = cvtpk(P[BASE + 2], P[BASE + 3]); \
    unsigned b0 = cvtpk(P[BASE + 4], P[BASE + 5]), b1 = cvtpk(P[BASE + 6], P[BASE + 7]); \
    auto r0 = __builtin_amdgcn_permlane32_swap(a0, b0, false, false); auto r1 = __builtin_amdgcn_permlane32_swap(a1, b1, false, false); \
    u32x4 w = {r0[0], r1[0], r0[1], r1[1]}; OUT = *reinterpret_cast<h8*>(&w); } while (0)
    AT_PK4(p0, 0, pa0); AT_PK4(p0, 8, pa1); AT_PK4(p1, 0, pa2); AT_PK4(p1, 8, pa3);
#undef AT_PK4
}
__device__ __forceinline__ float half_swap_max(float v) { auto rr = __builtin_amdgcn_permlane32_swap(__float_as_uint(v), __float_as_uint(v), false, false); return fmaxf(__uint_as_float(rr[0]), __uint_as_float(rr[1])); }
__device__ __forceinline__ float half_swap_sum(float v) { auto rr = __builtin_amdgcn_permlane32_swap(__float_as_uint(v), __float_as_uint(v), false, false); return __uint_as_float(rr[0]) + __uint_as_float(rr[1]); }

struct Stage4 { h8 vs0, vs1, ks0, ks1; };
__device__ __forceinline__ int hidden_tid() { int tz = threadIdx.x; asm volatile("" : "+v"(tz)); return tz; }
__device__ __forceinline__ void sload(Stage4& s, const _Float16* Kb, const _Float16* Vb, int ld, int k0) {
    const int tz = hidden_tid(), sr = tz >> 4, sc = (tz & 15) * 8;
    s.vs0 = *(const h8*)(Vb + (size_t)(k0 + sr) * ld + sc); s.vs1 = *(const h8*)(Vb + (size_t)(k0 + 32 + sr) * ld + sc);
    s.ks0 = *(const h8*)(Kb + (size_t)(k0 + sr) * ld + sc); s.ks1 = *(const h8*)(Kb + (size_t)(k0 + 32 + sr) * ld + sc);
}
__device__ __forceinline__ void swrite(const Stage4& s, char* V_lds, char* K_lds, int b) {
    const int tz = hidden_tid(), sr = tz >> 4, sc = (tz & 15) * 8, vst0 = v_st(sr, sc), vst1 = v_st(32 + sr, sc);
    *(h8*)(V_lds + b * SHM_V + vst0) = s.vs0; *(h8*)(V_lds + b * SHM_V + vst1) = s.vs1;
    const int kc = sc * 2;
    *(h8*)(K_lds + b * SHM_K + AT_KSWZ(sr, kc)) = s.ks0; *(h8*)(K_lds + b * SHM_K + AT_KSWZ(32 + sr, kc)) = s.ks1;
}

__device__ __forceinline__ void attn_unit(char* lds, const _Float16* qrow, const _Float16* Kb, const _Float16* Vb, int ld, unsigned tmask, int wlen, int khi, unsigned selmask,
                                          _Float16* outw, int ostride) {
    const int tid = threadIdx.x, wid = __builtin_amdgcn_readfirstlane(tid >> 6), lane = tid & 63, r32 = lane & 31, hi = lane >> 5;
    char* V_lds = lds; char* K_lds = lds + 2 * SHM_V;
    float* wsf = (float*)(lds + LDS_WS) + wid * 64; float* li_l = wsf; float* al_l = wsf + 32;
    float m_reg = -1e30f, l_reg = 0.f; f32x16 o[4] = {}; h8 qr[8];
#pragma unroll
    for (int d0 = 0; d0 < 8; ++d0) qr[d0] = *(const h8*)(qrow + d0 * 16);
    const int vb0 = (int)(uintptr_t)V_lds + v_rd_base(lane);
    Stage4 st;
    unsigned rest = tmask; int j = __ffs(rest) - 1; rest &= rest - 1;
    sload(st, Kb, Vb, ld, j * 64); asm volatile("s_waitcnt vmcnt(0)" ::: "memory"); swrite(st, V_lds, K_lds, 0); __syncthreads();
    int buf = 0;
    for (;;) {
        const int jn = rest ? (__ffs(rest) - 1) : -1;
        if (jn >= 0) sload(st, Kb, Vb, ld, jn * 64);
        f32x16 p0, p1;
        AT_SBAR(); qkt(p0, p1, K_lds + buf * SHM_K, qr, r32, hi);
        { const int klo = wlen > 0 ? khi - wlen + 1 : 0; const bool tb = (selmask >> j) & 1u; const bool inr = (j * 64 >= klo) && (j * 64 + 63 <= khi);
          if (!__all(tb && inr)) {
              if (__all(inr)) {
#pragma unroll
                  for (int r = 0; r < 16; ++r) { p0[r] = tb ? p0[r] : -INFINITY; p1[r] = tb ? p1[r] : -INFINITY; }
              } else {
                  const int kb = j * 64 + 4 * hi;
#pragma unroll
                  for (int r = 0; r < 16; ++r) { const int k0 = kb + (r & 3) + 8 * (r >> 2);
                      p0[r] = (tb && k0 >= klo && k0 <= khi) ? p0[r] : -INFINITY;
                      p1[r] = (tb && (k0 + 32) >= klo && (k0 + 32) <= khi) ? p1[r] : -INFINITY; }
              } } }
        float pmax = p0[0];
#pragma unroll
        for (int r = 1; r < 16; ++r) pmax = fmaxf(pmax, p0[r]);
#pragma unroll
        for (int r = 0; r < 16; ++r) pmax = fmaxf(pmax, p1[r]);
        pmax = half_swap_max(pmax);
        float mn, alpha;
        if (__all(pmax - m_reg <= THR_RAW)) { mn = m_reg; alpha = 1.f; }
        else { mn = fmaxf(m_reg, pmax); alpha = __builtin_amdgcn_exp2f((m_reg - mn) * CEXP); m_reg = mn; }
        const float mnC = -mn * CEXP;
        float ps = 0.f;
#pragma unroll
        for (int r = 0; r < 16; ++r) { p0[r] = __builtin_amdgcn_exp2f(fmaf(p0[r], CEXP, mnC)); ps += p0[r]; }
#pragma unroll
        for (int r = 0; r < 16; ++r) { p1[r] = __builtin_amdgcn_exp2f(fmaf(p1[r], CEXP, mnC)); ps += p1[r]; }
        ps = half_swap_sum(ps);
        l_reg = l_reg * alpha + ps;
        if (__any(alpha < 1.f)) { if (hi == 0) al_l[r32] = alpha; asm volatile("s_waitcnt lgkmcnt(0)" ::: "memory");
#pragma unroll
            for (int r = 0; r < 16; ++r) { const float a = al_l[crow(r, hi)];
#pragma unroll
                for (int d = 0; d < 4; ++d) o[d][r] *= a; } }
        h8 pa0, pa1, pa2, pa3; pack_p(p0, p1, pa0, pa1, pa2, pa3);
        AT_SBAR();
        pv_d0(o, vb0 + buf * SHM_V, pa0, pa1, pa2, pa3);
        if (jn < 0) break;
        asm volatile("s_waitcnt vmcnt(0)" ::: "memory");
        swrite(st, V_lds, K_lds, buf ^ 1);
        __syncthreads();
        buf ^= 1; j = jn; rest &= rest - 1;
    }
    if (hi == 0) li_l[r32] = l_reg; asm volatile("s_waitcnt lgkmcnt(0)" ::: "memory");
#pragma unroll
    for (int r = 0; r < 16; ++r) { const int orow = crow(r, hi); const float l = li_l[orow]; const float rl = l > 0.f ? 1.f / l : 0.f;
#pragma unroll
        for (int d0 = 0; d0 < 4; ++d0) outw[(size_t)orow * ostride + d0 * 32 + r32] = (_Float16)(o[d0][r] * rl); }
    __syncthreads();
}

constexpr int LDS_AP = LDS_END, LDS_BP = LDS_AP + 4 * 64 * 33 * 4, LDS_SELM = LDS_BP + 4 * 64 * 33 * 4, LDS_CS_END = LDS_SELM + 64 * 4;
__device__ __forceinline__ void cmp_slc_unit(char* lds, const _Float16* qrow, const _Float16* Kc, const _Float16* Vc, const _Float16* Ks, const _Float16* Vs, int t, int tl, int g, int qi,
                                             _Float16* outc, _Float16* outs) {
    const int tid = threadIdx.x, wid = __builtin_amdgcn_readfirstlane(tid >> 6), lane = tid & 63, r32 = lane & 31, hi = lane >> 5;
    char* V_lds = lds; char* K_lds = lds + 2 * SHM_V;
    float* AP = (float*)(lds + LDS_AP); float* BP = (float*)(lds + LDS_BP); unsigned* selm = (unsigned*)(lds + LDS_SELM);
    {
        h8 qr[8];
#pragma unroll
        for (int d0 = 0; d0 < 8; ++d0) qr[d0] = *(const h8*)(qrow + d0 * 16);
        const int vb0 = (int)(uintptr_t)V_lds + v_rd_base(lane);
        { Stage4 s0, s1; sload(s0, Kc, Vc, 256, 0); sload(s1, Kc, Vc, 256, 64);
          asm volatile("s_waitcnt vmcnt(0)" ::: "memory");
          swrite(s0, V_lds, K_lds, 0); swrite(s1, V_lds, K_lds, 1); }
        __syncthreads();
        f32x16 pA0, pA1, pB0, pB1;
        AT_SBAR(); qkt(pA0, pA1, K_lds, qr, r32, hi); qkt(pB0, pB1, K_lds + SHM_K, qr, r32, hi);
        const int khi = t >= 31 ? ((t - 31) >> 4) : -1;
#pragma unroll
        for (int r = 0; r < 16; ++r) { const int c0 = 4 * hi + (r & 3) + 8 * (r >> 2);
            pA0[r] = (c0 <= khi) ? pA0[r] : -INFINITY; pA1[r] = (c0 + 32 <= khi) ? pA1[r] : -INFINITY;
            pB0[r] = (c0 + 64 <= khi) ? pB0[r] : -INFINITY; pB1[r] = (c0 + 96 <= khi) ? pB1[r] : -INFINITY; }
        float pmax = -INFINITY;
#pragma unroll
        for (int r = 0; r < 16; ++r) pmax = fmaxf(fmaxf(pmax, pA0[r]), fmaxf(pA1[r], fmaxf(pB0[r], pB1[r])));
        pmax = half_swap_max(pmax);
        const float mC = (pmax == -INFINITY) ? 0.f : -pmax * CEXP;
        float ps = 0.f;
#pragma unroll
        for (int r = 0; r < 16; ++r) { pA0[r] = __builtin_amdgcn_exp2f(fmaf(pA0[r], CEXP, mC)); pA1[r] = __builtin_amdgcn_exp2f(fmaf(pA1[r], CEXP, mC));
            pB0[r] = __builtin_amdgcn_exp2f(fmaf(pB0[r], CEXP, mC)); pB1[r] = __builtin_amdgcn_exp2f(fmaf(pB1[r], CEXP, mC)); ps += (pA0[r] + pA1[r]) + (pB0[r] + pB1[r]); }
        ps = half_swap_sum(ps);
        const float inv = ps > 0.f ? 1.f / ps : 0.f;
#pragma unroll
        for (int r = 0; r < 16; ++r) { pA0[r] *= inv; pA1[r] *= inv; pB0[r] *= inv; pB1[r] *= inv; }
        { float* ap = AP + (g * 64 + tl) * 33; float* bp = BP + (g * 64 + tl) * 33;
          if (hi == 0) bp[0] = 0.f;
#define AT_IMP(P, JB) do { _Pragma("unroll") for (int k = 0; k < 4; ++k) { const int j = (JB) + 2 * k + hi; \
              ap[j] = 2.f * (P[4 * k] + P[4 * k + 1] + P[4 * k + 2]) + P[4 * k + 3]; if (j + 1 < 32) bp[j + 1] = P[4 * k + 3]; } } while (0)
          AT_IMP(pA0, 0); AT_IMP(pA1, 8); AT_IMP(pB0, 16); AT_IMP(pB1, 24);
#undef AT_IMP
        }
        f32x16 o[4] = {};
        h8 pa0, pa1, pa2, pa3;
        pack_p(pA0, pA1, pa0, pa1, pa2, pa3); AT_SBAR(); pv_d0(o, vb0, pa0, pa1, pa2, pa3);
        pack_p(pB0, pB1, pa0, pa1, pa2, pa3); AT_SBAR(); pv_d0(o, vb0 + SHM_V, pa0, pa1, pa2, pa3);
#pragma unroll
        for (int r = 0; r < 16; ++r) { const int orow = crow(r, hi);
#pragma unroll
            for (int d0 = 0; d0 < 4; ++d0) outc[(size_t)orow * 1024 + d0 * 32 + r32] = (_Float16)o[d0][r]; }
    }
    __syncthreads();
#pragma unroll 1
    for (int it = 0; it < 4; ++it) {
        const int tk = 8 * wid + 2 * it + hi, j = r32;
        float imp = 0.f;
#pragma unroll
        for (int gg = 0; gg < 4; ++gg) imp += AP[(gg * 64 + tk) * 33 + j] + BP[(gg * 64 + tk) * 33 + j];
        const bool forced = (j == 0) || (j == qi) || (j == qi - 1), valid = j <= qi;
        const float iv = forced ? 1e9f : (valid ? imp : -1e9f);
        int rank = 0;
        for (int i = 0; i < 32; ++i) { const float vi = __shfl(iv, i + 32 * hi); rank += (vi > iv || (vi == iv && i < j)) ? 1 : 0; }
        const unsigned long long bal = __ballot(rank < 16 && valid);
        if (r32 == 0) selm[tk] = (unsigned)(bal >> (32 * hi));
    }
    __syncthreads();
    unsigned tm = selm[lane];
#pragma unroll
    for (int o = 32; o > 0; o >>= 1) tm |= __shfl_xor(tm, o);
    const int tz2 = hidden_tid();
    const unsigned mysel = selm[((tz2 >> 6) & 1) * 32 + (tz2 & 31)];
    attn_unit(lds, qrow, Ks, Vs, 128, tm, 0, t, mysel, outs, 1024);
}
}

struct CUnit { const float* W; int ldw; int nvalid; _Float16* Wt; int k0; int n0; };
__device__ __forceinline__ CUnit conv_desc(int u, const float* win, const float* w1k, const float* w1v, const float* wmkv, _Float16* wtin, _Float16* wt1, _Float16* wtmkv) {
    CUnit d;
    if (u < 160) { d.W = win; d.ldw = INW; d.nvalid = INW; d.Wt = wtin; d.k0 = (u / 5) * 64; d.n0 = (u % 5) * 256; }
    else if (u < 288) { const int v = u - 160, kv = v >> 6, part = (v >> 5) & 1, kt = v & 31;
        d.W = (kv ? w1v : w1k) + (size_t)part * 2048 * 256; d.ldw = 256; d.nvalid = 256; d.Wt = wt1 + ((size_t)kv * 512 + part * 256) * 2048; d.k0 = kt * 64; d.n0 = 0; }
    else { d.W = wmkv; d.ldw = 1024; d.nvalid = 1024; d.Wt = wtmkv; d.k0 = 0; d.n0 = 0; }
    return d;
}
__device__ __forceinline__ void conv_all(float* lds, const float* win, const float* w1k, const float* w1v, const float* wmkv, _Float16* wtin, _Float16* wt1, _Float16* wtmkv, int bid, int nb) {
    constexpr int NU = 160 + 128;
    const int tid = threadIdx.x;
    int u = bid; if (u >= NU) return;
    CUnit d = conv_desc(u, win, w1k, w1v, wmkv, wtin, wt1, wtmkv);
    float4 v[8];
#define CL(D) do { _Pragma("unroll") for (int i = 0; i < 8; ++i) { const int idx = tid + 512 * i, r = idx >> 6, c4 = (idx & 63) * 4; \
        v[i] = ((D).n0 + c4 < (D).nvalid) ? *(const float4*)((D).W + (size_t)((D).k0 + r) * (D).ldw + (D).n0 + c4) : make_float4(0.f, 0.f, 0.f, 0.f); } } while (0)
    CL(d);
    for (;;) {
#pragma unroll
        for (int i = 0; i < 8; ++i) { const int idx = tid + 512 * i, r = idx >> 6, c4 = (idx & 63) * 4; float* dd = lds + r * 257 + c4; dd[0] = v[i].x; dd[1] = v[i].y; dd[2] = v[i].z; dd[3] = v[i].w; }
        __syncthreads();
        const int un = u + nb; const bool has = un < NU;
        CUnit dn = d; if (has) { dn = conv_desc(un, win, w1k, w1v, wmkv, wtin, wt1, wtmkv); CL(dn); }
#pragma unroll
        for (int j = 0; j < 4; ++j) { const int id = tid + 512 * j, n = id >> 3, k8 = (id & 7) * 8; h8 o;
#pragma unroll
            for (int q = 0; q < 8; ++q) o[q] = (_Float16)lds[(k8 + q) * 257 + n];
            *(h8*)(d.Wt + (size_t)(d.n0 + n) * 2048 + d.k0 + k8) = o; }
        __syncthreads();
        if (!has) break;
        u = un; d = dn;
    }
#undef CL
}

__device__ __forceinline__ unsigned pack4_i8(float a, float b, float c, float d) {
    const int ia = __float2int_rn(a), ib = __float2int_rn(b), ic = __float2int_rn(c), id = __float2int_rn(d);
    return (unsigned)(ia & 255) | ((unsigned)(ib & 255) << 8) | ((unsigned)(ic & 255) << 16) | ((unsigned)(id & 255) << 24);
}
constexpr int QP_LD2 = 1026;
struct QUnit { const float* W; int ldw; int n0; signed char* Q; float* sc; int nvalid; };
struct QExtra { const float* win; signed char* q8in; float* sin8; const float* wmkv; signed char* q8mkv; float* smkv; };
__device__ __forceinline__ QUnit quant_desc(int u, const float* wgu, const float* wdn, signed char* q8gu, signed char* q8dn, float* sgu, float* sdn, const float* wout, signed char* q8out, float* sout, const QExtra& x) {
    QUnit d; d.nvalid = 1 << 30;
    if (u >= NE * 192 + 64 + 73) { const int pn = u - (NE * 192 + 64 + 73); d.W = x.wmkv; d.ldw = 1024; d.n0 = pn * 32; d.Q = x.q8mkv; d.sc = x.smkv; }
    else if (u >= NE * 192 + 64) { const int pn = u - (NE * 192 + 64); d.W = x.win; d.ldw = INW; d.n0 = 1280 + pn * 32; d.Q = x.q8in - (size_t)1280 * 2048; d.sc = x.sin8 - 1280; d.nvalid = INW; }
    else if (u >= NE * 192) { const int pn = u - NE * 192; d.W = wout; d.ldw = 2048; d.n0 = pn * 32; d.Q = q8out; d.sc = sout; }
    else if (u < NE * 128) { const int e = u >> 7, pn = u & 127; d.W = wgu + (size_t)e * 2048 * 4096; d.ldw = 4096; d.n0 = pn * 32; d.Q = q8gu + (size_t)e * 4096 * 2048; d.sc = sgu + (size_t)e * 4096; }
    else { const int v = u - NE * 128, e = v >> 6, pn = v & 63; d.W = wdn + (size_t)e * 2048 * 2048; d.ldw = 2048; d.n0 = pn * 32; d.Q = q8dn + (size_t)e * 2048 * 2048; d.sc = sdn + (size_t)e * 2048; }
    return d;
}
__device__ __forceinline__ unsigned pk2h(float a, float b) { auto v = __builtin_amdgcn_cvt_pkrtz(a, b); return *reinterpret_cast<unsigned*>(&v); }
__device__ __forceinline__ void quant_all(char* smem, const float* wgu, const float* wdn, signed char* q8gu, signed char* q8dn, float* sgu, float* sdn, const float* wout, signed char* q8out, float* sout, const QExtra& qx, int bid, int nb) {
    constexpr int NU = NE * 128 + NE * 64 + 64 + 73 + 32;
    unsigned* cmaxb = (unsigned*)smem;
    const int tid = threadIdx.x, c4 = (tid & 7) * 4, rg = tid >> 3;
    if (tid < 64) cmaxb[tid] = 0u;
    __syncthreads();
    int u = bid; if (u >= NU) return;
    QUnit d = quant_desc(u, wgu, wdn, q8gu, q8dn, sgu, sdn, wout, q8out, sout, qx);
    float4 va[16], vb[16], vc[16];
#define QL(dst, D, half) do { const float* p0 = (D).W + (size_t)((half) * 1024 + rg * 16) * (D).ldw + (D).n0 + c4; const bool okc = (D).n0 + c4 < (D).nvalid; _Pragma("unroll") for (int j = 0; j < 16; ++j) dst[j] = okc ? *(const float4*)(p0 + (size_t)j * (D).ldw) : make_float4(0.f, 0.f, 0.f, 0.f); } while (0)
#define QM(src) do { _Pragma("unroll") for (int j = 0; j < 16; ++j) { m0 = fmaxf(m0, fabsf(src[j].x)); m1 = fmaxf(m1, fabsf(src[j].y)); m2 = fmaxf(m2, fabsf(src[j].z)); m3 = fmaxf(m3, fabsf(src[j].w)); } } while (0)
#define QS(src, half, comp, ci, inv) do { uint4 o; \
        o.x = pack4_i8(src[0].comp * inv, src[1].comp * inv, src[2].comp * inv, src[3].comp * inv); o.y = pack4_i8(src[4].comp * inv, src[5].comp * inv, src[6].comp * inv, src[7].comp * inv); \
        o.z = pack4_i8(src[8].comp * inv, src[9].comp * inv, src[10].comp * inv, src[11].comp * inv); o.w = pack4_i8(src[12].comp * inv, src[13].comp * inv, src[14].comp * inv, src[15].comp * inv); \
        *(uint4*)(d.Q + (size_t)(d.n0 + c4 + (ci)) * 2048 + (half) * 1024 + rg * 16) = o; } while (0)
    QL(va, d, 0);
    int par = 0;
    for (;;) {
        unsigned* cmax = cmaxb + par * 32;
        float m0 = 0.f, m1 = 0.f, m2 = 0.f, m3 = 0.f;
        QL(vb, d, 1);
        QM(va); QM(vb);
        atomicMax(&cmax[c4 + 0], __float_as_uint(m0)); atomicMax(&cmax[c4 + 1], __float_as_uint(m1)); atomicMax(&cmax[c4 + 2], __float_as_uint(m2)); atomicMax(&cmax[c4 + 3], __float_as_uint(m3));
        __syncthreads();
        const int un = u + nb; const bool has = un < NU;
        QUnit dn = d; if (has) { dn = quant_desc(un, wgu, wdn, q8gu, q8dn, sgu, sdn, wout, q8out, sout, qx); QL(vc, dn, 0); }
        if (tid < 32) cmaxb[(par ^ 1) * 32 + tid] = 0u;
        const float x0 = __uint_as_float(cmax[c4 + 0]), x1 = __uint_as_float(cmax[c4 + 1]), x2 = __uint_as_float(cmax[c4 + 2]), x3 = __uint_as_float(cmax[c4 + 3]);
        const float i0 = x0 > 0.f ? 127.f / x0 : 0.f, i1 = x1 > 0.f ? 127.f / x1 : 0.f, i2 = x2 > 0.f ? 127.f / x2 : 0.f, i3 = x3 > 0.f ? 127.f / x3 : 0.f;
        QS(va, 0, x, 0, i0); QS(va, 0, y, 1, i1); QS(va, 0, z, 2, i2); QS(va, 0, w, 3, i3);
        QS(vb, 1, x, 0, i0); QS(vb, 1, y, 1, i1); QS(vb, 1, z, 2, i2); QS(vb, 1, w, 3, i3);
        if (tid < 32) { const float mx = __uint_as_float(cmax[tid]); d.sc[d.n0 + tid] = mx > 0.f ? mx / 127.f : 1.f; }
        if (!has) break;
#pragma unroll
        for (int j = 0; j < 16; ++j) va[j] = vc[j];
        u = un; d = dn; par ^= 1;
        __syncthreads();
    }
    __syncthreads();
#undef QL
#undef QM
#undef QS
}

__global__ void __launch_bounds__(512, 2) fwd(Params p) {
    extern __shared__ __attribute__((aligned(16))) char smem[];
    const int tid = threadIdx.x, wv = __builtin_amdgcn_readfirstlane(tid >> 6);
#define LANE_NOW ({ int _t = threadIdx.x; asm volatile("" : "+v"(_t)); _t & 63; })
    const int bid = blockIdx.x, nb = gridDim.x;
    const int gw = bid * 8 + wv, nw = nb * 8;
    const int lo = (int)(p.lo_hi & 0xffffffffll), hi = (int)(p.lo_hi >> 32);
    unsigned char* ws = p.ws;
    unsigned* ctl = (unsigned*)(ws + WS_CTL);
    int* cnt = (int*)(ws + CTL_CNT);
    float* proj = (float*)(ws + WS_PROJ);
    float* kvmem = (float*)(ws + WS_KVMEM);
    float* bias1 = (float*)(ws + WS_BIAS1);
    float* hid = (float*)(ws + WS_HID);
    float* kc = (float*)(ws + WS_KC);
    float* vc = (float*)(ws + WS_VC);
    float* pooled = (float*)(ws + WS_POOLED);
    _Float16* opool = (_Float16*)(ws + WS_OPOOL);
    _Float16* owin = (_Float16*)(ws + WS_OWIN);
    _Float16* ocmp = (_Float16*)(ws + WS_OCMP);
    _Float16* oslc = (_Float16*)(ws + WS_OSLC);
    unsigned* sel = (unsigned*)(ws + WS_SEL);
    _Float16* omem = (_Float16*)(ws + WS_OMEM);
    _Float16* cat16 = (_Float16*)(ws + WS_CAT16);
    _Float16* hpre16 = (_Float16*)(ws + WS_HPRE);
    float* hbuf = (float*)(ws + WS_H);
    float* gate = (float*)(ws + WS_GATE);
    int* list = (int*)(ws + WS_LIST);
    unsigned char* actf8 = (unsigned char*)(ws + WS_ACT16);
    unsigned char* yf8 = (unsigned char*)(ws + WS_Y16);
    _Float16* h16 = (_Float16*)(ws + WS_H16);
    _Float16* x16 = (_Float16*)(ws + WS_X16);
    _Float16* wtin = (_Float16*)(ws + WS_WTIN);
    _Float16* wtout = (_Float16*)(ws + WS_WTOUT);
    _Float16* wtgu = (_Float16*)(ws + WS_WTGU);
    _Float16* wtdn = (_Float16*)(ws + WS_WTDN);
    LAS unsigned char* lds = (LAS unsigned char*)smem;
    _Float16* proj16 = (_Float16*)(ws + WS_PROJ16);
    _Float16* kvmem16 = (_Float16*)(ws + WS_KVMEM16);
    _Float16* wt1 = (_Float16*)(ws + WS_WT1);
    float* uv = (float*)(ws + WS_UV);
    _Float16* kc16 = (_Float16*)(ws + WS_KC16);
    _Float16* vc16 = (_Float16*)(ws + WS_VC16);
    _Float16* wr16 = (_Float16*)(ws + WS_WR16);
    _Float16* mem16 = (_Float16*)(ws + WS_MEM16);
    _Float16* wtmkv = (_Float16*)(ws + WS_WTMKV);
    _Float16* kv16 = (_Float16*)(ws + WS_KV16);
    _Float16* wt2 = (_Float16*)(ws + WS_WT2);
    signed char* x8 = (signed char*)(ws + WS_X8); float* sxa = (float*)(ws + WS_SXA); signed char* q8in = (signed char*)(ws + WS_Q8IN); float* sin8 = (float*)(ws + WS_SIN8);
    signed char* q8mkv = (signed char*)(ws + WS_Q8MKV); float* smkv = (float*)(ws + WS_SMKV);
    signed char* q8out = (signed char*)(ws + WS_Q8OUT); float* sout = (float*)(ws + WS_SOUT); signed char* cat8 = (signed char*)(ws + WS_CAT8); float* scat = (float*)(ws + WS_SCAT);
    signed char* q8gu = (signed char*)(ws + WS_Q8GU); signed char* q8dn = (signed char*)(ws + WS_Q8DN);
    float* sgu = (float*)(ws + WS_SGU); float* sdn = (float*)(ws + WS_SDN);
    signed char* h8q = (signed char*)(ws + WS_H8); float* sah = (float*)(ws + WS_SAH);
    signed char* act8 = (signed char*)(ws + WS_ACT8); float* sact = (float*)(ws + WS_SACT);
    const int vcu = (nb % 8 == 0) ? (bid % 8) * (nb / 8) + bid / 8 : bid;

    volatile LAS unsigned* xbw = (volatile LAS unsigned*)(smem + LDS_BYTES - 16);
    if (tid == 0) { xbw[0] = 0u; xbw[1] = 0u; xbw[2] = 0u; xbw[3] = 0u; }
    __syncthreads();
    XcdBarrier bar; bar.bar = ctl; bar.x = 0; bar.st = xbw;
    const bool multi = (hi - lo) > 1;
    if (multi) bar = xcd_barrier_post(ctl, xbw);
#define IN(k) (lo <= (k) && (k) < hi)
#define SEAM(k) do { if (IN(k) && IN((k) + 1)) xcd_barrier(bar); } while (0)
    float* sw = (float*)smem + wv * WLDS_FLOATS;
    int* segw = (int*)(sw + 4096 + 512);

    if (IN(0)) {
        const int lane = LANE_NOW; (void)lane;
        if (wv == 0 && (bid & 1) == 0 && (bid >> 1) < 128) {
            const int task = bid >> 1, kv = task >> 6, jg = (task >> 4) & 3, kc = task & 15;
            const float* pos = p.in[kv ? I_POSV : I_POSK] + kc * 256; const float* w1 = p.in[kv ? I_W1V : I_W1K] + (size_t)kc * 256 * 256 + jg * 64 + lane;
            float s0 = 0.f, s1 = 0.f, s2 = 0.f, s3 = 0.f;
            for (int k = 0; k < 256; k += 4) { s0 += pos[k] * w1[(size_t)k * 256]; s1 += pos[k + 1] * w1[(size_t)(k + 1) * 256]; s2 += pos[k + 2] * w1[(size_t)(k + 2) * 256]; s3 += pos[k + 3] * w1[(size_t)(k + 3) * 256]; }
            bias1[(kv * 16 + kc) * 256 + jg * 64 + lane] = (s0 + s1) + (s2 + s3);
        }
        for (int i = bid * 512 + tid; i < 2 * 128 * 256; i += nb * 512) { const int kv = i >> 15, d = (i >> 8) & 127, n = i & 255; wt2[i] = (_Float16)p.in[kv ? I_W2V : I_W2K][(size_t)n * 128 + d]; }
        for (int i = bid * 512 + tid; i < 32 * 2048; i += nb * 512) { const int e = i >> 11, d = i & 2047; wr16[i] = (_Float16)p.in[I_WR][(size_t)d * 32 + e]; }
        {
            for (int row0 = gw; row0 < T_ + 2048; row0 += nw * 2) {
                float4 raw[2][8];
#pragma unroll
                for (int i = 0; i < 2; ++i) { const int row = row0 + i * nw; const float* src = row < T_ ? p.in[I_X] + (size_t)row * 2048 : p.in[I_MEM] + (size_t)(row - T_) * 2048;
#pragma unroll
                    for (int c = 0; c < 4; ++c) { raw[i][2 * c] = make_float4(0.f, 0.f, 0.f, 0.f); raw[i][2 * c + 1] = raw[i][2 * c];
                        if (row < T_ + 2048) { raw[i][2 * c] = *(const float4*)(src + (lane + 64 * c) * 8); raw[i][2 * c + 1] = *(const float4*)(src + (lane + 64 * c) * 8 + 4); } } }
#pragma unroll
                for (int i = 0; i < 2; ++i) { const int row = row0 + i * nw;
                    float amax = 0.f;
#pragma unroll
                    for (int k = 0; k < 8; ++k) amax = fmaxf(amax, fmaxf(fmaxf(fabsf(raw[i][k].x), fabsf(raw[i][k].y)), fmaxf(fabsf(raw[i][k].z), fabsf(raw[i][k].w))));
                    amax = wave_max(amax);
                    if (row < T_ + 2048) {
                        const float qinv = amax > 0.f ? 127.f / amax : 0.f;
                        if (lane == 0) sxa[row] = amax > 0.f ? amax / 127.f : 1.f;
#pragma unroll
                        for (int c = 0; c < 4; ++c) { const float4 a = raw[i][2 * c], b2 = raw[i][2 * c + 1];
                            uint2 q; q.x = pack4_i8(a.x * qinv, a.y * qinv, a.z * qinv, a.w * qinv); q.y = pack4_i8(b2.x * qinv, b2.y * qinv, b2.z * qinv, b2.w * qinv);
                            *(uint2*)(x8 + (size_t)row * 2048 + (lane + 64 * c) * 8) = q;
                            if (row < T_) { h8 o; o[0] = (_Float16)a.x; o[1] = (_Float16)a.y; o[2] = (_Float16)a.z; o[3] = (_Float16)a.w; o[4] = (_Float16)b2.x; o[5] = (_Float16)b2.y; o[6] = (_Float16)b2.z; o[7] = (_Float16)b2.w;
                                *(h8*)(x16 + (size_t)row * 2048 + (lane + 64 * c) * 8) = o; } } }
                }
            }
        }
        {
            const QExtra qx{p.in[I_WIN], q8in, sin8, p.in[I_WMEMKV], q8mkv, smkv};
            quant_all(smem, p.in[I_WGU], p.in[I_WDN], q8gu, q8dn, sgu, sdn, p.in[I_WOUT], q8out, sout, qx, bid, nb);
            __syncthreads();
            conv_all((float*)smem, p.in[I_WIN], p.in[I_W1K], p.in[I_W1V], p.in[I_WMEMKV], wtin, wt1, wtmkv, bid, nb);
            __syncthreads();
        }
    }
    SEAM(0);
    if (IN(1)) {
        const int lane = LANE_NOW; (void)lane;
        { g8::ProbInF P{x16, proj16, nb, bid}; g8::gemm_phase(lds, P); }
        __syncthreads();
        { g8::ProbIn8 P{x8, proj16, sxa, nb, (bid + 192) & 255}; g8::gemm_phase(lds, P); }
    }
    SEAM(1);
    if (IN(2)) {
        const int lane = LANE_NOW; (void)lane;
        { g8::ProbCmp P{kv16, wt1, uv, nb, bid}; g8::gemm_phase(lds, P); __syncthreads(); }
        for (int i = bid * 512 + tid; i < T_ * 64; i += nb * 512) {
            const int chn = i & 63, row = i >> 6, t = row & (S_ - 1), g = chn >> 4;
            const int win = 2 << g, n = min(win, t + 1);
            const _Float16* src = proj16 + (size_t)row * INW + C_UP + chn * 8;
            float a[8];
            const h8 cur = *(const h8*)src;
            h8 vv[15];
#pragma unroll
            for (int k = 0; k < 15; ++k) { vv[k] = (h8){0, 0, 0, 0, 0, 0, 0, 0}; if (k + 1 < n) vv[k] = *(const h8*)(src - (size_t)(k + 1) * INW); }
#pragma unroll
            for (int q = 0; q < 8; ++q) a[q] = (float)cur[q];
#pragma unroll
            for (int k = 0; k < 15; ++k) {
#pragma unroll
                for (int q = 0; q < 8; ++q) a[q] += (float)vv[k][q]; }
            const float rn = 1.f / (float)n;
            float4 o0, o1;
            o0.x = a[0] * rn - (float)cur[0]; o0.y = a[1] * rn - (float)cur[1]; o0.z = a[2] * rn - (float)cur[2]; o0.w = a[3] * rn - (float)cur[3];
            o1.x = a[4] * rn - (float)cur[4]; o1.y = a[5] * rn - (float)cur[5]; o1.z = a[6] * rn - (float)cur[6]; o1.w = a[7] * rn - (float)cur[7];
            *(float4*)(pooled + (size_t)row * 512 + chn * 8) = o0; *(float4*)(pooled + (size_t)row * 512 + chn * 8 + 4) = o1;
        }
        {
            const int r32 = lane & 31, hi = lane >> 5, g = wv >> 1, half = wv & 1;
            for (int uu = vcu; uu < 512; uu += nb) {
                const int v = uu & 255, bk = v >> 4, qi = (uu >> 8) ? 31 - (v & 15) : (v & 15), b = bk >> 1, kvh = bk & 1;
                const int t = qi * 64 + half * 32 + r32;
                const int lo_t = max(0, qi - 8);
                const unsigned tmask = (unsigned)(((1ull << (qi + 1)) - 1ull) & ~((1ull << lo_t) - 1ull));
                at8::attn_unit(smem, proj16 + (size_t)(b * S_ + t) * INW + C_Q + (kvh * 4 + g) * 128 + hi * 8,
                               kv16 + ((size_t)(4 * B_ + b) * 2 + kvh) * KVSEG, kv16 + ((size_t)(5 * B_ + b) * 2 + kvh) * KVSEG, 128, tmask, 512, t, 0xffffffffu,
                               owin + (size_t)(b * S_ + qi * 64 + half * 32) * 1024 + (kvh * 4 + g) * 128, 1024);
            }
            for (int u = vcu; u < 256; u += nb) {
                const int b = u >> 5, h = (u >> 3) & 3, qt = u & 7;
                const int t = qt * 256 + wv * 32 + r32;
                at8::attn_unit(smem, proj16 + (size_t)(b * S_ + t) * INW + C_QM + h * 128 + hi * 8,
                               kvmem16 + (size_t)b * 256 * 1024 + h * 128, kvmem16 + (size_t)b * 256 * 1024 + 512 + h * 128, 1024, 0xFu, 0, 255, 0xffffffffu,
                               omem + (size_t)(b * S_ + qt * 256 + wv * 32) * 512 + h * 128, 512);
            }
        }
    }
    SEAM(2);
    if (IN(3)) {
        const int lane = LANE_NOW; (void)lane;
        {
            float* bsum = (float*)smem;
            _Float16* hs = (_Float16*)(smem + 4096);
            { const int kv = tid >> 8, n = tid & 255; float a = 0.f;
#pragma unroll
              for (int kc = 0; kc < 16; ++kc) a += bias1[(kv * 16 + kc) * 256 + n];
              bsum[tid] = a; }
            __syncthreads();
            const int fr = lane & 15, fq = lane >> 4;
            for (int u = bid; u < 256; u += nb) {
                const int kv = u >> 7, rt = u & 127;
#pragma unroll
                for (int q = 0; q < 8; ++q) { const int e = tid + 512 * q, i = e >> 8, n = e & 255;
                    const int row = rt * 16 + i, c = (row >> 1) & 127;
                    float a = 0.f;
                    if (c != 127) { a = bsum[kv * 256 + n];
#pragma unroll
                        for (int sp = 0; sp < 4; ++sp) { const float* base = uv + ((size_t)(kv * 4 + sp) * 2048) * 512; a += base[(size_t)row * 512 + n] + base[(size_t)(row + 2) * 512 + 256 + n]; }
                        a = gelu_fast(a); }
                    hs[i * 264 + n] = (_Float16)a; }
                __syncthreads();
                { const _Float16* bp = wt2 + ((size_t)kv * 128 + wv * 16 + fr) * 256 + fq * 8;
                  f4 acc = (f4){0.f, 0.f, 0.f, 0.f};
#pragma unroll
                  for (int sI = 0; sI < 8; ++sI) { const h8 a = *(const h8*)(hs + fr * 264 + sI * 32 + fq * 8), bb = *(const h8*)(bp + sI * 32); acc = __builtin_amdgcn_mfma_f32_16x16x32_f16(a, bb, acc, 0, 0, 0); }
                  _Float16* dst = kv ? vc16 : kc16;
#pragma unroll
                  for (int j = 0; j < 4; ++j) { const int row = rt * 16 + fq * 4 + j; dst[(size_t)row * 128 + wv * 16 + fr] = (((row >> 1) & 127) == 127) ? (_Float16)0.f : (_Float16)acc[j]; } }
                __syncthreads();
            }
        }
        for (int u = bid; u < 128 * 4; u += nb) { const int g = u >> 7, mt = u & 127;
            ARowPlain af{pooled + g * 128, 512, mt * 128, T_}; EpiPool ef{opool, p.in[I_POOLS], mt * 128, g};
            gemm_tile(smem, 128, af, p.in[I_POOLW] + (size_t)g * 128 * 128, 128, 0, 128, false, ef);
        }
    }
    SEAM(3);
    if (IN(4)) {
        const int lane = LANE_NOW; (void)lane;
        const int r32 = lane & 31, hi = lane >> 5, g = wv >> 1, half = wv & 1;
        for (int uu = vcu; uu < 512; uu += nb) {
            const int v = uu & 255, bk = v >> 4, qi = (uu >> 8) ? 31 - (v & 15) : (v & 15), b = bk >> 1, kvh = bk & 1;
            const int tl = half * 32 + r32, t = qi * 64 + tl;
            at8::cmp_slc_unit(smem, proj16 + (size_t)(b * S_ + t) * INW + C_Q + (kvh * 4 + g) * 128 + hi * 8,
                              kc16 + (size_t)(b * 128 * 2 + kvh) * 128, vc16 + (size_t)(b * 128 * 2 + kvh) * 128,
                              kv16 + ((size_t)(2 * B_ + b) * 2 + kvh) * KVSEG, kv16 + ((size_t)(3 * B_ + b) * 2 + kvh) * KVSEG, t, tl, g, qi,
                              ocmp + (size_t)(b * S_ + qi * 64 + half * 32) * 1024 + (kvh * 4 + g) * 128, oslc + (size_t)(b * S_ + qi * 64 + half * 32) * 1024 + (kvh * 4 + g) * 128);
        }
    }
    SEAM(4);
    if (IN(5)) {
        const int lane = LANE_NOW;
        for (int row = gw; row < T_; row += nw) {
            const _Float16* pr = proj16 + (size_t)row * INW + C_G;
            float v[32]; float ss = 0.f;
#pragma unroll
            for (int c = 0; c < 2; ++c) { const int col = (lane + 64 * c) * 8, h = col >> 7; const size_t o = (size_t)row * 1024 + col;
                const float g0 = sigmoidf_((float)pr[h * 3]), g1 = sigmoidf_((float)pr[h * 3 + 1]), g2 = sigmoidf_((float)pr[h * 3 + 2]);
                const h8 a = *(const h8*)(ocmp + o), b2 = *(const h8*)(oslc + o), c2 = *(const h8*)(owin + o);
#pragma unroll
                for (int q = 0; q < 8; ++q) { const float x = g0 * (float)a[q] + g1 * (float)b2[q] + g2 * (float)c2[q]; v[c * 8 + q] = x; ss += x * x; } }
            ss = wave_sum(ss); float r = rsqrtf(ss / 1024.f + LN_EPS);
#pragma unroll
            for (int c = 0; c < 2; ++c) { const int col = (lane + 64 * c) * 8; const float4 ga = *(const float4*)(p.in[I_GNNSA] + col), gb = *(const float4*)(p.in[I_GNNSA] + col + 4);
                v[c * 8 + 0] *= r * ga.x; v[c * 8 + 1] *= r * ga.y; v[c * 8 + 2] *= r * ga.z; v[c * 8 + 3] *= r * ga.w; v[c * 8 + 4] *= r * gb.x; v[c * 8 + 5] *= r * gb.y; v[c * 8 + 6] *= r * gb.z; v[c * 8 + 7] *= r * gb.w; }
            { const h8 a = *(const h8*)(opool + (size_t)row * 512 + lane * 8); ss = 0.f;
#pragma unroll
              for (int q = 0; q < 8; ++q) { v[16 + q] = (float)a[q]; ss += v[16 + q] * v[16 + q]; }
              ss = wave_sum(ss); r = rsqrtf(ss / 512.f + LN_EPS);
              const float4 ga = *(const float4*)(p.in[I_GNPOOL] + lane * 8), gb = *(const float4*)(p.in[I_GNPOOL] + lane * 8 + 4);
              v[16] *= r * ga.x; v[17] *= r * ga.y; v[18] *= r * ga.z; v[19] *= r * ga.w; v[20] *= r * gb.x; v[21] *= r * gb.y; v[22] *= r * gb.z; v[23] *= r * gb.w; }
            { const h8 a = *(const h8*)(omem + (size_t)row * 512 + lane * 8); ss = 0.f;
#pragma unroll
              for (int q = 0; q < 8; ++q) { v[24 + q] = (float)a[q]; ss += v[24 + q] * v[24 + q]; }
              ss = wave_sum(ss); r = rsqrtf(ss / 512.f + LN_EPS);
              const float4 ga = *(const float4*)(p.in[I_GNMEM] + lane * 8), gb = *(const float4*)(p.in[I_GNMEM] + lane * 8 + 4);
              v[24] *= r * ga.x; v[25] *= r * ga.y; v[26] *= r * ga.z; v[27] *= r * ga.w; v[28] *= r * gb.x; v[29] *= r * gb.y; v[30] *= r * gb.z; v[31] *= r * gb.w; }
            float amax = 0.f;
#pragma unroll
            for (int k = 0; k < 32; ++k) amax = fmaxf(amax, fabsf(v[k]));
            amax = wave_max(amax);
            const float qinv = amax > 0.f ? 127.f / amax : 0.f;
            if (lane == 0) scat[row] = amax > 0.f ? amax / 127.f : 1.f;
#pragma unroll
            for (int c = 0; c < 4; ++c) { const int col = c < 2 ? (lane + 64 * c) * 8 : (c == 2 ? 1024 + lane * 8 : 1536 + lane * 8);
                uint2 q; q.x = pack4_i8(v[c * 8 + 0] * qinv, v[c * 8 + 1] * qinv, v[c * 8 + 2] * qinv, v[c * 8 + 3] * qinv); q.y = pack4_i8(v[c * 8 + 4] * qinv, v[c * 8 + 5] * qinv, v[c * 8 + 6] * qinv, v[c * 8 + 7] * qinv);
                *(uint2*)(cat8 + (size_t)row * 2048 + col) = q; }
        }
    }
    SEAM(5);
    if (IN(6)) {
        const int lane = LANE_NOW; (void)lane;
        g8::ProbOut P{cat8, q8out, hpre16, x16, scat, sout, nb, bid};
        g8::gemm_phase(lds, P);
    }
    SEAM(6);
    if (IN(7)) {
        const int lane = LANE_NOW; (void)lane;
        float* lg = (float*)smem;
        const int r32 = lane & 31, hi = lane >> 5, fr = lane & 15, fq = lane >> 4;
        for (int u = bid; u < T_ / 64; u += nb) {
            const int base = u * 64;
            h8 raw[8][4];
#pragma unroll
            for (int i = 0; i < 8; ++i)
#pragma unroll
                for (int c = 0; c < 4; ++c) raw[i][c] = *(const h8*)(hpre16 + (size_t)(base + wv * 8 + i) * 2048 + (lane + 64 * c) * 8);
#pragma unroll
            for (int i = 0; i < 8; ++i) {
                const int row = base + wv * 8 + i;
                float v[32]; float s = 0.f;
#pragma unroll
                for (int c = 0; c < 4; ++c) {
#pragma unroll
                    for (int q = 0; q < 8; ++q) { v[c * 8 + q] = (float)raw[i][c][q]; s += v[c * 8 + q]; } }
                const float mu = wave_sum(s) / 2048.f; float q2 = 0.f;
#pragma unroll
                for (int k = 0; k < 32; ++k) { const float d = v[k] - mu; q2 += d * d; }
                const float rs = rsqrtf(wave_sum(q2) / 2048.f + LN_EPS);
                float amax = 0.f;
#pragma unroll
                for (int c = 0; c < 4; ++c) { const int col = (lane + 64 * c) * 8;
                    const float4 g0 = *(const float4*)(p.in[I_LN1G] + col), g1 = *(const float4*)(p.in[I_LN1G] + col + 4), b0 = *(const float4*)(p.in[I_LN1B] + col), b1 = *(const float4*)(p.in[I_LN1B] + col + 4);
                    float4 o0, o1;
                    o0.x = (v[c * 8 + 0] - mu) * rs * g0.x + b0.x; o0.y = (v[c * 8 + 1] - mu) * rs * g0.y + b0.y; o0.z = (v[c * 8 + 2] - mu) * rs * g0.z + b0.z; o0.w = (v[c * 8 + 3] - mu) * rs * g0.w + b0.w;
                    o1.x = (v[c * 8 + 4] - mu) * rs * g1.x + b1.x; o1.y = (v[c * 8 + 5] - mu) * rs * g1.y + b1.y; o1.z = (v[c * 8 + 6] - mu) * rs * g1.z + b1.z; o1.w = (v[c * 8 + 7] - mu) * rs * g1.w + b1.w;
                    h8 oh; oh[0] = (_Float16)o0.x; oh[1] = (_Float16)o0.y; oh[2] = (_Float16)o0.z; oh[3] = (_Float16)o0.w; oh[4] = (_Float16)o1.x; oh[5] = (_Float16)o1.y; oh[6] = (_Float16)o1.z; oh[7] = (_Float16)o1.w;
                    *(h8*)(h16 + (size_t)row * 2048 + col) = oh;
                    v[c * 8 + 0] = o0.x; v[c * 8 + 1] = o0.y; v[c * 8 + 2] = o0.z; v[c * 8 + 3] = o0.w; v[c * 8 + 4] = o1.x; v[c * 8 + 5] = o1.y; v[c * 8 + 6] = o1.z; v[c * 8 + 7] = o1.w;
                    amax = fmaxf(amax, fmaxf(fmaxf(fmaxf(fabsf(o0.x), fabsf(o0.y)), fmaxf(fabsf(o0.z), fabsf(o0.w))), fmaxf(fmaxf(fabsf(o1.x), fabsf(o1.y)), fmaxf(fabsf(o1.z), fabsf(o1.w))))); }
                amax = wave_max(amax);
                const float qinv = amax > 0.f ? 127.f / amax : 0.f;
                if (lane == 0) sah[row] = amax > 0.f ? amax / 127.f : 1.f;
#pragma unroll
                for (int c = 0; c < 4; ++c) { const int col = (lane + 64 * c) * 8;
                    uint2 q; q.x = pack4_i8(v[c * 8 + 0] * qinv, v[c * 8 + 1] * qinv, v[c * 8 + 2] * qinv, v[c * 8 + 3] * qinv); q.y = pack4_i8(v[c * 8 + 4] * qinv, v[c * 8 + 5] * qinv, v[c * 8 + 6] * qinv, v[c * 8 + 7] * qinv);
                    *(uint2*)(h8q + (size_t)row * 2048 + col) = q; }
            }
            asm volatile("s_waitcnt vmcnt(0)" ::: "memory");
            __syncthreads();
            {
                const int tok0 = base + 16 * (wv >> 1), e0 = 16 * (wv & 1);
                const _Float16* ap = h16 + (size_t)(tok0 + fr) * 2048 + fq * 8; const _Float16* bp = wr16 + (size_t)(e0 + fr) * 2048 + fq * 8;
                f4 acc = (f4){0.f, 0.f, 0.f, 0.f};
#pragma unroll 8
                for (int sI = 0; sI < 64; ++sI) { const h8 a = *(const h8*)(ap + sI * 32), bb = *(const h8*)(bp + sI * 32); acc = __builtin_amdgcn_mfma_f32_16x16x32_f16(a, bb, acc, 0, 0, 0); }
                const float br = p.in[I_BR][e0 + fr];
#pragma unroll
                for (int j = 0; j < 4; ++j) lg[(16 * (wv >> 1) + 4 * fq + j) * 33 + e0 + fr] = acc[j] + br;
            }
            __syncthreads();
#pragma unroll 1
            for (int it = 0; it < 4; ++it) {
                const int tk = 8 * wv + 2 * it + hi;
                const float iv = lg[tk * 33 + r32];
                int rank = 0;
                for (int i = 0; i < 32; ++i) { const float vi = __shfl(iv, i + 32 * hi); rank += (vi > iv || (vi == iv && i < r32)) ? 1 : 0; }
                float tv[4]; int te[4];
#pragma unroll
                for (int r = 0; r < 4; ++r) { const unsigned long long bm = __ballot(rank == r); const unsigned hm = (unsigned)(bm >> (32 * hi)); const int src = __ffs(hm) - 1; te[r] = src; tv[r] = __shfl(iv, src + 32 * hi); }
                const float e0v = 1.f, e1v = expf(tv[1] - tv[0]), e2v = expf(tv[2] - tv[0]), e3v = expf(tv[3] - tv[0]); const float inv = 1.f / (e0v + e1v + e2v + e3v);
                if (r32 < 4) { const int e = r32 == 0 ? te[0] : r32 == 1 ? te[1] : r32 == 2 ? te[2] : te[3]; const float g = (r32 == 0 ? e0v : r32 == 1 ? e1v : r32 == 2 ? e2v : e3v) * inv;
                    const int a = (base + tk) * 4 + r32; const int pos = atomicAdd(&cnt[e], 1); list[(size_t)e * T_ + pos] = a; gate[a] = g; }
            }
            __syncthreads();
        }
    }
    SEAM(7);
    LAS int* mtab = (LAS int*)(smem + g8::STAGE_BYTES);
    if (IN(8)) {
        const int lane = LANE_NOW; (void)lane;
        if (tid == 0) { int ub = 0, rs = 0;
            for (int e = 0; e < NE; ++e) { const int c = (int)__hip_atomic_load((unsigned*)&cnt[e], __ATOMIC_RELAXED, __HIP_MEMORY_SCOPE_AGENT); mtab[e] = c; mtab[32 + e] = ub; mtab[65 + e] = rs; ub += ((c + 255) >> 8) * 16; rs += c; }
            mtab[64] = ub; mtab[97] = rs; mtab[98] = ub; }
        __syncthreads();
        g8::moe_build(mtab, nb, vcu);
        __syncthreads();
        g8::ProbGu P{h8q, q8gu, actf8, p.in[I_BGU], list, sah, sgu, g8::MoeTab{mtab, 16}, nb, vcu};
        g8::gemm_phase(lds, P);
        __syncthreads();
    }
    SEAM(8);
    if (IN(9)) {
        const int lane = LANE_NOW;
        for (int row0 = gw; row0 < NA; row0 += nw * 8) {
            uint2 raw[8][4];
#pragma unroll
            for (int i = 0; i < 8; ++i)
#pragma unroll
                for (int c = 0; c < 4; ++c) raw[i][c] = *(const uint2*)(actf8 + (size_t)(row0 + i * nw) * 2048 + (lane + 64 * c) * 8);
#pragma unroll
            for (int i = 0; i < 8; ++i) { const int row = row0 + i * nw;
                float v[32]; float amax = 0.f;
#pragma unroll
                for (int c = 0; c < 4; ++c) { const uint2 a = raw[i][c];
                    dec4_fp8(a.x, v[c * 8 + 0], v[c * 8 + 1], v[c * 8 + 2], v[c * 8 + 3]); dec4_fp8(a.y, v[c * 8 + 4], v[c * 8 + 5], v[c * 8 + 6], v[c * 8 + 7]);
#pragma unroll
                    for (int q = 0; q < 8; ++q) amax = fmaxf(amax, fabsf(v[c * 8 + q])); }
                amax = wave_max(amax);
                const float qinv = amax > 0.f ? 127.f / amax : 0.f;
                if (lane == 0) sact[row] = amax > 0.f ? amax / 127.f : 1.f;
#pragma unroll
                for (int c = 0; c < 4; ++c) { uint2 q; q.x = pack4_i8(v[c * 8 + 0] * qinv, v[c * 8 + 1] * qinv, v[c * 8 + 2] * qinv, v[c * 8 + 3] * qinv); q.y = pack4_i8(v[c * 8 + 4] * qinv, v[c * 8 + 5] * qinv, v[c * 8 + 6] * qinv, v[c * 8 + 7] * qinv);
                    *(uint2*)(act8 + (size_t)row * 2048 + (lane + 64 * c) * 8) = q; }
            }
        }
    }
    SEAM(9);
    if (IN(10)) {
        const int lane = LANE_NOW; (void)lane;
        if (tid == 0) { int ub = 0, rs = 0;
            for (int e = 0; e < NE; ++e) { const int c = (int)__hip_atomic_load((unsigned*)&cnt[e], __ATOMIC_RELAXED, __HIP_MEMORY_SCOPE_AGENT); mtab[e] = c; mtab[32 + e] = ub; mtab[65 + e] = rs; ub += ((c + 255) >> 8) * 8; rs += c; }
            mtab[64] = ub; mtab[97] = rs; mtab[98] = ub; }
        __syncthreads();
        g8::moe_build(mtab, nb, vcu);
        __syncthreads();
        g8::ProbDn P{act8, q8dn, yf8, p.in[I_BDN], list, gate, sact, sdn, g8::MoeTab{mtab, 8}, nb, vcu};
        g8::gemm_phase(lds, P);
        __syncthreads();
    }
    SEAM(10);
    if (IN(11)) {
        const int lane = LANE_NOW; (void)lane;
        for (int row0 = gw; row0 < T_; row0 += nw * 2) {
          h8 hraw[2][4]; uint2 yraw[2][4][4];
#pragma unroll
          for (int i = 0; i < 2; ++i)
#pragma unroll
            for (int c = 0; c < 4; ++c) { const int col = (lane + 64 * c) * 8; const size_t yo = (size_t)(row0 + i * nw) * 4 * 2048 + col;
                hraw[i][c] = *(const h8*)(h16 + (size_t)(row0 + i * nw) * 2048 + col);
                yraw[i][c][0] = *(const uint2*)(yf8 + yo); yraw[i][c][1] = *(const uint2*)(yf8 + yo + 2048); yraw[i][c][2] = *(const uint2*)(yf8 + yo + 4096); yraw[i][c][3] = *(const uint2*)(yf8 + yo + 6144); }
#pragma unroll
          for (int i = 0; i < 2; ++i) { const int row = row0 + i * nw;
            float v[32]; float s = 0.f;
#pragma unroll
            for (int c = 0; c < 4; ++c) {
                const h8 hh8 = hraw[i][c];
                const uint2 y0 = yraw[i][c][0], y1 = yraw[i][c][1], y2 = yraw[i][c][2], y3 = yraw[i][c][3];
                float ys[8], t0[8], t1[8], t2[8], t3[8];
                dec4_fp8(y0.x, t0[0], t0[1], t0[2], t0[3]); dec4_fp8(y0.y, t0[4], t0[5], t0[6], t0[7]); dec4_fp8(y1.x, t1[0], t1[1], t1[2], t1[3]); dec4_fp8(y1.y, t1[4], t1[5], t1[6], t1[7]);
                dec4_fp8(y2.x, t2[0], t2[1], t2[2], t2[3]); dec4_fp8(y2.y, t2[4], t2[5], t2[6], t2[7]); dec4_fp8(y3.x, t3[0], t3[1], t3[2], t3[3]); dec4_fp8(y3.y, t3[4], t3[5], t3[6], t3[7]);
#pragma unroll
                for (int q = 0; q < 8; ++q) ys[q] = (t0[q] + t1[q]) + (t2[q] + t3[q]);
#pragma unroll
                for (int q = 0; q < 8; ++q) { v[c * 8 + q] = DN_ALPHA * (float)hh8[q] + ys[q] * 0.0625f; s += v[c * 8 + q]; } }
            const float mu = wave_sum(s) / 2048.f; float q2 = 0.f;
#pragma unroll
            for (int i = 0; i < 32; ++i) { const float d = v[i] - mu; q2 += d * d; }
            const float rs = rsqrtf(wave_sum(q2) / 2048.f + LN_EPS);
#pragma unroll
            for (int c = 0; c < 4; ++c) { const int col = (lane + 64 * c) * 8;
                const float4 ga = *(const float4*)(p.in[I_LN2G] + col), gb = *(const float4*)(p.in[I_LN2G] + col + 4), ba = *(const float4*)(p.in[I_LN2B] + col), bb = *(const float4*)(p.in[I_LN2B] + col + 4);
                float4 o0, o1;
                o0.x = (v[c * 8 + 0] - mu) * rs * ga.x + ba.x; o0.y = (v[c * 8 + 1] - mu) * rs * ga.y + ba.y; o0.z = (v[c * 8 + 2] - mu) * rs * ga.z + ba.z; o0.w = (v[c * 8 + 3] - mu) * rs * ga.w + ba.w;
                o1.x = (v[c * 8 + 4] - mu) * rs * gb.x + bb.x; o1.y = (v[c * 8 + 5] - mu) * rs * gb.y + bb.y; o1.z = (v[c * 8 + 6] - mu) * rs * gb.z + bb.z; o1.w = (v[c * 8 + 7] - mu) * rs * gb.w + bb.w;
                *(float4*)(p.out + (size_t)row * 2048 + col) = o0; *(float4*)(p.out + (size_t)row * 2048 + col + 4) = o1; }
          }
        }
    }
}

constexpr int NPHASE = 12;

extern "C" void kernel_launch(void* const* d_in, const int* in_sizes, int n_in, void* d_out, int out_size, void* d_ws, size_t ws_size, hipStream_t stream) {
    static int grid = 0;
    if (grid == 0) {
        if (n_in != 26 || ws_size < WS_END) { fprintf(stderr, "kernel_launch: unexpected n_in %d or ws_size %zu (< %zu)\n", n_in, ws_size, (size_t)WS_END); grid = -1; return; }
        int dev = 0, cus = 0, per_cu = 0;
        hipGetDevice(&dev); hipDeviceGetAttribute(&cus, hipDeviceAttributeMultiprocessorCount, dev);
        if (hipFuncSetAttribute((const void*)fwd, hipFuncAttributeMaxDynamicSharedMemorySize, LDS_BYTES) != hipSuccess) { fprintf(stderr, "hipFuncSetAttribute failed\n"); grid = -1; return; }
        hipOccupancyMaxActiveBlocksPerMultiprocessor(&per_cu, (const void*)fwd, 512, LDS_BYTES);
        (void)hipGetLastError();
        if (per_cu < 1) fprintf(stderr, "occupancy query says %d blocks per CU\n", per_cu);
        grid = cus > 0 ? cus : 256;
    }
    if (grid < 0) return;
    hipMemsetAsync((char*)d_ws + WS_CTL, 0, CTL_BYTES, stream);
    Params p{};
    for (int i = 0; i < 26; ++i) p.in[i] = (const float*)d_in[i];
    p.out = (float*)d_out; p.ws = (unsigned char*)d_ws;
#if N_LAUNCH_MODE == 1
    p.lo_hi = (long long)0 | ((long long)NPHASE << 32);
    hipLaunchKernelGGL(fwd, dim3(grid), dim3(512), LDS_BYTES, stream, p);
#else
    for (int ph = 0; ph < NPHASE; ++ph) {
        p.lo_hi = (long long)ph | ((long long)(ph + 1) << 32);
        hipLaunchKernelGGL(fwd, dim3(grid), dim3(512), LDS_BYTES, stream, p);
    }
#endif
}
```

```cpp
#include <hip/hip_runtime.h>
#include <cstdio>
#include <cstdint>

#ifndef N_LAUNCH_MODE
#define N_LAUNCH_MODE 1
#endif

constexpr int B_ = 8, S_ = 2048, D_ = 2048, T_ = B_ * S_;
constexpr int INW = 3608;
constexpr int C_Q = 0, C_KC = 1024, C_VC = 1280, C_KS = 1536, C_VS = 1792, C_KW = 2048, C_VW = 2304, C_G = 2560, C_UP = 2584, C_QM = 3096;
constexpr int NC = 127;
constexpr int CROWS = B_ * NC * 2;
constexpr int NE = 32, DE = 2048, NA = T_ * 4;
constexpr float LN_EPS = 1e-5f;
constexpr float DN_ALPHA = 1.189207115002721f;
constexpr float ATT_SCALE = 0.08838834764831845f;

constexpr size_t al256(size_t x) { return (x + 255) & ~(size_t)255; }
constexpr size_t WS_CTL = 0;
constexpr size_t CTL_BYTES = 65536;
constexpr size_t CTL_CNT = 16384;
constexpr size_t WS_PROJ = CTL_BYTES;
constexpr size_t WS_KVMEM = WS_PROJ + al256((size_t)T_ * INW * 4);
constexpr size_t WS_BIAS1 = WS_KVMEM + al256((size_t)2048 * 1024 * 4);
constexpr size_t WS_HID = WS_BIAS1 + al256(2 * 16 * 256 * 4);
constexpr size_t WS_KC = WS_HID + al256((size_t)2 * 2048 * 256 * 4);
constexpr size_t WS_VC = WS_KC + al256((size_t)CROWS * 128 * 4);
constexpr size_t WS_POOLED = WS_VC + al256((size_t)CROWS * 128 * 4);
constexpr size_t WS_OPOOL = WS_POOLED + al256((size_t)T_ * 512 * 4);
constexpr size_t WS_OWIN = WS_OPOOL + al256((size_t)T_ * 512 * 4);
constexpr size_t WS_OCMP = WS_OWIN + al256((size_t)T_ * 1024 * 4);
constexpr size_t WS_OSLC = WS_OCMP + al256((size_t)T_ * 1024 * 4);
constexpr size_t WS_SEL = WS_OSLC + al256((size_t)T_ * 1024 * 4);
constexpr size_t WS_OMEM = WS_SEL + al256((size_t)T_ * 2 * 4);
constexpr size_t WS_CAT16 = WS_OMEM + al256((size_t)T_ * 512 * 4);
constexpr size_t WS_HPRE = WS_CAT16 + al256((size_t)T_ * 2048 * 2);
constexpr size_t WS_H = WS_HPRE + al256((size_t)T_ * 2048 * 4);
constexpr size_t WS_H16 = WS_H + al256((size_t)T_ * 2048 * 4);
constexpr size_t WS_GATE = WS_H16 + al256((size_t)T_ * 2048 * 2);
constexpr size_t WS_LIST = WS_GATE + al256((size_t)NA * 4);
constexpr size_t WS_ACT16 = WS_LIST + al256((size_t)NE * T_ * 4);
constexpr size_t WS_Y16 = WS_ACT16 + al256((size_t)(NA + 256) * 2048 * 2);
constexpr size_t WS_X16 = WS_Y16 + al256((size_t)NA * 2048 * 2);
constexpr size_t WS_MEM16 = WS_X16 + (size_t)T_ * 2048 * 2;
constexpr size_t WS_WTIN = WS_MEM16 + al256((size_t)2048 * 2048 * 2);
constexpr size_t WS_WTOUT = WS_WTIN + al256((size_t)3840 * 2048 * 2);
constexpr size_t WS_WTGU = WS_WTOUT + al256((size_t)2048 * 2048 * 2);
constexpr size_t WS_WTDN = WS_WTGU + al256((size_t)NE * 4096 * 2048 * 2);
constexpr size_t WS_PROJ16 = WS_WTDN + al256((size_t)NE * 2048 * 2048 * 2);
constexpr size_t WS_KVMEM16 = WS_PROJ16 + al256((size_t)(T_ + 64) * INW * 2);
constexpr size_t WS_WT1 = WS_KVMEM16 + al256((size_t)2048 * 1024 * 2);
constexpr size_t WS_UV = WS_WT1 + al256((size_t)2 * 512 * 2048 * 2);
constexpr size_t WS_KC16 = WS_UV + al256((size_t)2 * 4 * 2048 * 512 * 4);
constexpr size_t WS_VC16 = WS_KC16 + al256((size_t)B_ * 128 * 256 * 2);
constexpr size_t WS_WR16 = WS_VC16 + al256((size_t)B_ * 128 * 256 * 2);
constexpr size_t WS_Q8GU = WS_WR16 + al256((size_t)32 * 2048 * 2);
constexpr size_t WS_Q8DN = WS_Q8GU + al256((size_t)NE * 4096 * 2048);
constexpr size_t WS_SGU = WS_Q8DN + al256((size_t)NE * 2048 * 2048);
constexpr size_t WS_SDN = WS_SGU + al256((size_t)NE * 4096 * 4);
constexpr size_t WS_H8 = WS_SDN + al256((size_t)NE * 2048 * 4);
constexpr size_t WS_SAH = WS_H8 + al256((size_t)T_ * 2048);
constexpr size_t WS_ACT8 = WS_SAH + al256((size_t)T_ * 4);
constexpr size_t WS_SACT = WS_ACT8 + al256((size_t)(NA + 256) * 2048);
constexpr size_t WS_WTMKV = WS_SACT + al256((size_t)(NA + 256) * 4);
constexpr size_t WS_Q8OUT = WS_WTMKV + al256((size_t)1024 * 2048 * 2);
constexpr size_t WS_SOUT = WS_Q8OUT + al256((size_t)2048 * 2048);
constexpr size_t WS_CAT8 = WS_SOUT + al256(2048 * 4);
constexpr size_t WS_SCAT = WS_CAT8 + al256((size_t)T_ * 2048);
constexpr size_t WS_X8 = WS_SCAT + al256((size_t)T_ * 4);
constexpr size_t WS_SXA = WS_X8 + al256((size_t)(T_ + 2048) * 2048);
constexpr size_t WS_Q8IN = WS_SXA + al256((size_t)(T_ + 2048) * 4);
constexpr size_t WS_SIN8 = WS_Q8IN + al256((size_t)2560 * 2048);
constexpr size_t WS_Q8MKV = WS_SIN8 + al256(2560 * 4);
constexpr size_t WS_SMKV = WS_Q8MKV + al256((size_t)1024 * 2048);
constexpr size_t WS_WT2 = WS_SMKV + al256(1024 * 4);
constexpr size_t WS_KV16 = WS_WT2 + al256((size_t)2 * 128 * 256 * 2);
constexpr size_t KVSEG = (size_t)S_ * 128;
constexpr size_t WS_END = WS_KV16 + al256((size_t)6 * B_ * 2 * S_ * 128 * 2);

constexpr int LDS_BYTES = 155648;

struct Params {
    const float* in[26];
    float* out;
    unsigned char* ws;
    long long lo_hi;
};
enum { I_X = 0, I_MEM, I_WIN, I_POSK, I_W1K, I_W2K, I_POSV, I_W1V, I_W2V, I_POOLW, I_POOLS, I_WMEMKV, I_GNNSA, I_GNPOOL, I_GNMEM, I_WOUT,
       I_LN1G, I_LN1B, I_WR, I_BR, I_WGU, I_BGU, I_WDN, I_BDN, I_LN2G, I_LN2B };

#define XB_TMO      128
#define XB_XCNT(j)  (256  + 64 * (j))
#define XB_XSUB(j)  (1280 + 64 * (j))
#define XB_XGEN(j)  (2304 + 64 * (j))
#define XB_TOP      3328
#define XB_TOPGEN   3392
#define XCD_BAR_WORDS 3456
#define XB_SPIN_CAP (1u << 25)
#define LAS __attribute__((address_space(3)))

__device__ __forceinline__ unsigned xb_ld(unsigned* p)              { return __hip_atomic_load(p, __ATOMIC_RELAXED, __HIP_MEMORY_SCOPE_AGENT); }
__device__ __forceinline__ unsigned xb_add(unsigned* p, unsigned v) { return __hip_atomic_fetch_add(p, v, __ATOMIC_RELAXED, __HIP_MEMORY_SCOPE_AGENT); }
__device__ __forceinline__ unsigned xb_xcc_id() { return (unsigned)__builtin_amdgcn_s_getreg((3 << 11) | 20) & 0xFu; }
#define XB_SPIN(cond, bar) do { unsigned _sp = 0; while (cond) { __builtin_amdgcn_s_sleep(1); \
    if ((++_sp & 255u) == 0u) { if (xb_ld(&(bar)[XB_TMO])) break; if (_sp > XB_SPIN_CAP) { atomicAdd(&(bar)[XB_TMO], 1u); break; } } } } while (0)

struct XcdBarrier { unsigned* bar; unsigned x; volatile LAS unsigned* st; };

__device__ __forceinline__ XcdBarrier xcd_barrier_post(unsigned* bar, volatile LAS unsigned* st) {
    XcdBarrier b; b.bar = bar; b.x = xb_xcc_id(); b.st = st;
    if (threadIdx.x == 0) (void)xb_add(&bar[XB_XCNT(b.x)], 1u);
    return b;
}
__device__ __forceinline__ void xcd_barrier_complete(unsigned* bar, unsigned x, unsigned& nloc, unsigned& nx) {
    const unsigned G = gridDim.x * gridDim.y * gridDim.z;
    unsigned sum, cnt, mine, sp = 0u;
    for (;;) {
        sum = 0u; cnt = 0u; mine = 0u;
#pragma unroll
        for (unsigned j = 0; j < 16; ++j) { const unsigned c = xb_ld(&bar[XB_XCNT(j)]); sum += c; cnt += (c > 0u) ? 1u : 0u; mine = (j == x) ? c : mine; }
        if (sum == G) break;
        __builtin_amdgcn_s_sleep(1);
        if ((++sp & 255u) == 0u) { if (xb_ld(&bar[XB_TMO])) break; if (sp > XB_SPIN_CAP) { atomicAdd(&bar[XB_TMO], 1u); break; } }
    }
    nloc = mine > 0u ? mine : 1u; nx = cnt > 0u ? cnt : 1u;
}
__device__ __forceinline__ void xcd_barrier(const XcdBarrier& b) {
    asm volatile("s_waitcnt vmcnt(0)" ::: "memory");
    __syncthreads();
    if (threadIdx.x == 0) {
        unsigned* bar = b.bar;
        __builtin_amdgcn_s_waitcnt(0);
        unsigned nloc = b.st[0], nx = b.st[1];
        if (nloc == 0u) { xcd_barrier_complete(bar, b.x, nloc, nx); b.st[0] = nloc; b.st[1] = nx; }
        const unsigned old = xb_add(&bar[XB_XSUB(b.x)], 1u);
        const unsigned gen = old / nloc;
        if (old + 1u == (gen + 1u) * nloc) {
            __builtin_amdgcn_fence(__ATOMIC_RELEASE, "agent");
            asm volatile("s_waitcnt vmcnt(0)" ::: "memory");
            const unsigned og = xb_add(&bar[XB_TOP], 1u);
            const unsigned tg = og / nx;
            if (og + 1u == (tg + 1u) * nx) xb_add(&bar[XB_TOPGEN], 1u);
            else XB_SPIN(xb_ld(&bar[XB_TOPGEN]) == tg, bar);
            __builtin_amdgcn_fence(__ATOMIC_ACQUIRE, "agent");
            xb_add(&bar[XB_XGEN(b.x)], 1u);
            asm volatile("s_waitcnt vmcnt(0)" ::: "memory");
        } else {
            XB_SPIN(xb_ld(&bar[XB_XGEN(b.x)]) == gen, bar);
            __builtin_amdgcn_fence(__ATOMIC_ACQUIRE, "agent");
            asm volatile("s_waitcnt vmcnt(0)" ::: "memory");
        }
    }
    __syncthreads();
}

typedef _Float16 h8 __attribute__((ext_vector_type(8)));
typedef _Float16 h4 __attribute__((ext_vector_type(4)));
typedef float f4 __attribute__((ext_vector_type(4)));

__device__ __forceinline__ float wave_sum(float v) {
#pragma unroll
    for (int o = 32; o > 0; o >>= 1) v += __shfl_xor(v, o);
    return v;
}
__device__ __forceinline__ float wave_max(float v) {
#pragma unroll
    for (int o = 32; o > 0; o >>= 1) v = fmaxf(v, __shfl_xor(v, o));
    return v;
}
__device__ __forceinline__ void wave_sync() {
    asm volatile("s_waitcnt lgkmcnt(0)" ::: "memory");
    __builtin_amdgcn_wave_barrier();
}
__device__ __forceinline__ float gelu_tanh(float x) {
    const float u = 0.7978845608028654f * (x + 0.044715f * x * x * x);
    return 0.5f * x * (1.f + tanhf(u));
}
__device__ __forceinline__ float gelu_fast(float x) { const float u = 0.7978845608028654f * (x + 0.044715f * x * x * x); const float t = 1.f - 2.f * __builtin_amdgcn_rcpf(1.f + __builtin_amdgcn_exp2f(2.8853900817779268f * u)); return 0.5f * x * (1.f + t); }
__device__ __forceinline__ float sigmoidf_(float x) { return 1.f / (1.f + expf(-x)); }
__device__ __forceinline__ unsigned pk4_fp8(float a, float b, float c, float d) { int w = 0; w = __builtin_amdgcn_cvt_pk_fp8_f32(a, b, w, false); w = __builtin_amdgcn_cvt_pk_fp8_f32(c, d, w, true); return (unsigned)w; }
__device__ __forceinline__ void dec4_fp8(unsigned w, float& a, float& b, float& c, float& d) { a = __builtin_amdgcn_cvt_f32_fp8((int)w, 0); b = __builtin_amdgcn_cvt_f32_fp8((int)w, 1); c = __builtin_amdgcn_cvt_f32_fp8((int)w, 2); d = __builtin_amdgcn_cvt_f32_fp8((int)w, 3); }
__device__ __forceinline__ float swiglu_fast(float g, float l) { const float xg = fminf(g, 7.f), xl = fminf(fmaxf(l, -7.f), 7.f); return xg * __builtin_amdgcn_rcpf(1.f + __builtin_amdgcn_exp2f(-2.4554669595930156f * xg)) * (xl + 1.f); }

constexpr int G_LD = 40;
template <class AF, class EF>
__device__ __forceinline__ void gemm_tile(char* smem, int K, const AF& af, const float* __restrict__ Bm, int ldb, int n0, int Nlim, bool perm, const EF& ef) {
    _Float16* As = (_Float16*)smem;
    _Float16* Bs = As + 128 * G_LD;
    const int tid = threadIdx.x, lane = tid & 63, wid = tid >> 6, wr = wid >> 2, wc = wid & 3, fr = lane & 15, fq = lane >> 4;
    f4 acc[4][2];
#pragma unroll
    for (int m = 0; m < 4; ++m)
#pragma unroll
        for (int n = 0; n < 2; ++n) acc[m][n] = (f4){0.f, 0.f, 0.f, 0.f};
    const int ar = tid >> 3, ak = (tid & 7) * 4;
    const float* ap0 = af.row(ar);
    const float* ap1 = af.row(ar + 64);
    const int bk = tid >> 5, bn = (tid & 31) * 4;
    const bool bok = (n0 + bn) < Nlim;
    int bnp[4];
#pragma unroll
    for (int i = 0; i < 4; ++i) { const int c = bn + i; bnp[i] = perm ? ((c & ~31) | ((c & 1) << 4) | ((c & 31) >> 1)) : c; }
    for (int k0 = 0; k0 < K; k0 += 32) {
        const int ko = af.koff(k0 + ak);
        float4 a0 = make_float4(0.f, 0.f, 0.f, 0.f), a1 = a0, b0 = a0, b1 = a0;
        if (ap0) a0 = *(const float4*)(ap0 + ko);
        if (ap1) a1 = *(const float4*)(ap1 + ko);
        if (bok) { b0 = *(const float4*)(Bm + (size_t)(k0 + bk) * ldb + n0 + bn); b1 = *(const float4*)(Bm + (size_t)(k0 + bk + 16) * ldb + n0 + bn); }
        __syncthreads();
        *(h4*)&As[ar * G_LD + ak] = (h4){(_Float16)a0.x, (_Float16)a0.y, (_Float16)a0.z, (_Float16)a0.w};
        *(h4*)&As[(ar + 64) * G_LD + ak] = (h4){(_Float16)a1.x, (_Float16)a1.y, (_Float16)a1.z, (_Float16)a1.w};
        Bs[bnp[0] * G_LD + bk] = (_Float16)b0.x; Bs[bnp[1] * G_LD + bk] = (_Float16)b0.y; Bs[bnp[2] * G_LD + bk] = (_Float16)b0.z; Bs[bnp[3] * G_LD + bk] = (_Float16)b0.w;
        Bs[bnp[0] * G_LD + bk + 16] = (_Float16)b1.x; Bs[bnp[1] * G_LD + bk + 16] = (_Float16)b1.y; Bs[bnp[2] * G_LD + bk + 16] = (_Float16)b1.z; Bs[bnp[3] * G_LD + bk + 16] = (_Float16)b1.w;
        __syncthreads();
        h8 a[4], b[2];
#pragma unroll
        for (int m = 0; m < 4; ++m) a[m] = *(const h8*)&As[(wr * 64 + m * 16 + fr) * G_LD + fq * 8];
#pragma unroll
        for (int n = 0; n < 2; ++n) b[n] = *(const h8*)&Bs[(wc * 32 + n * 16 + fr) * G_LD + fq * 8];
#pragma unroll
        for (int m = 0; m < 4; ++m)
#pragma unroll
            for (int n = 0; n < 2; ++n) acc[m][n] = __builtin_amdgcn_mfma_f32_16x16x32_f16(a[m], b[n], acc[m][n], 0, 0, 0);
    }
    ef(acc, wr, wc, fr, fq);
    __syncthreads();
}

struct ARowPlain { const float* base; int ld; int m0; int mlim;
    __device__ __forceinline__ const float* row(int r) const { return (m0 + r) < mlim ? base + (size_t)(m0 + r) * ld : nullptr; }
    __device__ __forceinline__ int koff(int k) const { return k; } };
struct ARowCmp { const float* proj; int col; int m0;
    __device__ __forceinline__ const float* row(int r) const { const int g = m0 + r; if (g >= CROWS) return nullptr; const int kvh = g & 1, bc = g >> 1, b = bc / NC, c = bc % NC;
        return proj + (size_t)(b * S_ + 16 * c) * INW + col + kvh * 128; }
    __device__ __forceinline__ int koff(int k) const { return (k >> 7) * INW + (k & 127); } };
struct ARowList { const float* base; const int* list; int m0; int cnt; int shift;
    __device__ __forceinline__ const float* row(int r) const { if (m0 + r >= cnt) return nullptr; const int a = list[m0 + r]; return base + (size_t)(a >> shift) * 2048; }
    __device__ __forceinline__ int koff(int k) const { return k; } };

struct EpiStore { float* C; int ldc; int m0; int n0; int mlim; int nlim; _Float16* C16;
    __device__ __forceinline__ void operator()(const f4 (&acc)[4][2], int wr, int wc, int fr, int fq) const {
#pragma unroll
        for (int m = 0; m < 4; ++m)
#pragma unroll
            for (int n = 0; n < 2; ++n)
#pragma unroll
                for (int j = 0; j < 4; ++j) { const int r = m0 + wr * 64 + m * 16 + fq * 4 + j, c = n0 + wc * 32 + n * 16 + fr;
                    if (r < mlim && c < nlim) { C[(size_t)r * ldc + c] = acc[m][n][j]; if (C16) C16[(size_t)r * ldc + c] = (_Float16)acc[m][n][j]; } } } };
struct EpiKc { _Float16* C; int m0;
    __device__ __forceinline__ void operator()(const f4 (&acc)[4][2], int wr, int wc, int fr, int fq) const {
#pragma unroll
        for (int m = 0; m < 4; ++m)
#pragma unroll
            for (int n = 0; n < 2; ++n)
#pragma unroll
                for (int j = 0; j < 4; ++j) { const int r = m0 + wr * 64 + m * 16 + fq * 4 + j, c = wc * 32 + n * 16 + fr;
                    C[(size_t)r * 128 + c] = (((r >> 1) & 127) == 127) ? (_Float16)0.f : (_Float16)acc[m][n][j]; } } };
struct EpiPool { _Float16* C; const float* scale; int m0; int g;
    __device__ __forceinline__ void operator()(const f4 (&acc)[4][2], int wr, int wc, int fr, int fq) const {
#pragma unroll
        for (int m = 0; m < 4; ++m)
#pragma unroll
            for (int n = 0; n < 2; ++n)
#pragma unroll
                for (int j = 0; j < 4; ++j) { const int r = m0 + wr * 64 + m * 16 + fq * 4 + j, c = g * 128 + wc * 32 + n * 16 + fr;
                    C[(size_t)r * 512 + c] = (_Float16)(acc[m][n][j] * scale[c]); } } };
struct EpiHid { float* C; const float* bias; int m0; int n0;
    __device__ __forceinline__ void operator()(const f4 (&acc)[4][2], int wr, int wc, int fr, int fq) const {
#pragma unroll
        for (int m = 0; m < 4; ++m)
#pragma unroll
            for (int n = 0; n < 2; ++n)
#pragma unroll
                for (int j = 0; j < 4; ++j) { const int r = m0 + wr * 64 + m * 16 + fq * 4 + j, c = n0 + wc * 32 + n * 16 + fr;
                    if (r < CROWS) C[(size_t)r * 256 + c] = gelu_tanh(acc[m][n][j] + bias[c]); } } };
struct EpiOut { float* C; const float* x; int m0; int n0;
    __device__ __forceinline__ void operator()(const f4 (&acc)[4][2], int wr, int wc, int fr, int fq) const {
#pragma unroll
        for (int m = 0; m < 4; ++m)
#pragma unroll
            for (int n = 0; n < 2; ++n)
#pragma unroll
                for (int j = 0; j < 4; ++j) { const size_t o = (size_t)(m0 + wr * 64 + m * 16 + fq * 4 + j) * 2048 + n0 + wc * 32 + n * 16 + fr;
                    C[o] = DN_ALPHA * x[o] + acc[m][n][j]; } } };
struct EpiGu { float* act; const float* bgu; const int* list; int m0; int cnt; int n0;
    __device__ __forceinline__ void operator()(const f4 (&acc)[4][2], int wr, int wc, int fr, int fq) const {
        const int jc = (n0 + wc * 32) / 2 + fr;
        const float bg = bgu[2 * jc], bl = bgu[2 * jc + 1];
#pragma unroll
        for (int m = 0; m < 4; ++m)
#pragma unroll
            for (int j = 0; j < 4; ++j) { const int r = m0 + wr * 64 + m * 16 + fq * 4 + j;
                if (r < cnt) { const int a = list[r];
                    const float xg = fminf(acc[m][0][j] + bg, 7.f), xl = fminf(fmaxf(acc[m][1][j] + bl, -7.f), 7.f);
                    act[(size_t)a * 2048 + jc] = xg * sigmoidf_(1.702f * xg) * (xl + 1.f); } } } };
struct EpiDn { float* y; const float* bdn; const int* list; const float* gate; int m0; int cnt; int n0;
    __device__ __forceinline__ void operator()(const f4 (&acc)[4][2], int wr, int wc, int fr, int fq) const {
#pragma unroll
        for (int m = 0; m < 4; ++m)
#pragma unroll
            for (int j = 0; j < 4; ++j) { const int r = m0 + wr * 64 + m * 16 + fq * 4 + j;
                if (r < cnt) { const int a = list[r]; const float g = gate[a];
#pragma unroll
                    for (int n = 0; n < 2; ++n) { const int c = n0 + wc * 32 + n * 16 + fr; y[(size_t)a * 2048 + c] = (acc[m][n][j] + bdn[c]) * g; } } } } };

constexpr int WLDS_FLOATS = 4096 + 512 + 32;
template <bool SHARED>
__device__ __forceinline__ void wave_attn(float* sw, const float* __restrict__ qptr, const float* __restrict__ Kb, const float* __restrict__ Vb, int ld, int nseg, float scale, float* __restrict__ optr) {
    const int lane = threadIdx.x & 63;
    float* sq = sw + 4096; const int* segs = (const int*)(sw + 4096 + 512);
#pragma unroll
    for (int i = 0; i < 8; ++i) sq[lane + 64 * i] = qptr[lane + 64 * i];
    wave_sync();
    for (int sg = 0; sg < nseg; ++sg) {
        const int start = segs[sg], len = segs[16 + sg];
        float d0 = 0.f, d1 = 0.f, d2 = 0.f, d3 = 0.f;
        if (lane < len) {
            const float* kp = Kb + (size_t)(start + lane) * ld;
            for (int d4 = 0; d4 < 32; ++d4) {
                if (SHARED) {
                    const float4 kv = *(const float4*)(kp + d4 * 4);
                    const float4 q0 = *(const float4*)(sq + d4 * 4), q1 = *(const float4*)(sq + 128 + d4 * 4), q2 = *(const float4*)(sq + 256 + d4 * 4), q3 = *(const float4*)(sq + 384 + d4 * 4);
                    d0 += kv.x * q0.x + kv.y * q0.y + kv.z * q0.z + kv.w * q0.w;
                    d1 += kv.x * q1.x + kv.y * q1.y + kv.z * q1.z + kv.w * q1.w;
                    d2 += kv.x * q2.x + kv.y * q2.y + kv.z * q2.z + kv.w * q2.w;
                    d3 += kv.x * q3.x + kv.y * q3.y + kv.z * q3.z + kv.w * q3.w;
                } else {
                    const float4 k0 = *(const float4*)(kp + d4 * 4), k1 = *(const float4*)(kp + 128 + d4 * 4), k2 = *(const float4*)(kp + 256 + d4 * 4), k3 = *(const float4*)(kp + 384 + d4 * 4);
                    const float4 q0 = *(const float4*)(sq + d4 * 4), q1 = *(const float4*)(sq + 128 + d4 * 4), q2 = *(const float4*)(sq + 256 + d4 * 4), q3 = *(const float4*)(sq + 384 + d4 * 4);
                    d0 += k0.x * q0.x + k0.y * q0.y + k0.z * q0.z + k0.w * q0.w;
                    d1 += k1.x * q1.x + k1.y * q1.y + k1.z * q1.z + k1.w * q1.w;
                    d2 += k2.x * q2.x + k2.y * q2.y + k2.z * q2.z + k2.w * q2.w;
                    d3 += k3.x * q3.x + k3.y * q3.y + k3.z * q3.z + k3.w * q3.w;
                }
            }
        }
        const bool ok = lane < len;
        sw[sg * 64 + lane] = ok ? d0 * scale : -1e30f;
        sw[1024 + sg * 64 + lane] = ok ? d1 * scale : -1e30f;
        sw[2048 + sg * 64 + lane] = ok ? d2 * scale : -1e30f;
        sw[3072 + sg * 64 + lane] = ok ? d3 * scale : -1e30f;
    }
    wave_sync();
    const int n = nseg * 64;
#pragma unroll
    for (int g = 0; g < 4; ++g) {
        float mx = -1e30f;
        for (int i = lane; i < n; i += 64) mx = fmaxf(mx, sw[g * 1024 + i]);
        mx = wave_max(mx);
        float sm = 0.f;
        for (int i = lane; i < n; i += 64) { const float v = sw[g * 1024 + i]; sm += (v > -1e29f) ? expf(v - mx) : 0.f; }
        sm = wave_sum(sm);
        const float inv = sm > 0.f ? 1.f / sm : 0.f;
        for (int i = lane; i < n; i += 64) { const float v = sw[g * 1024 + i]; sw[g * 1024 + i] = (v > -1e29f) ? expf(v - mx) * inv : 0.f; }
    }
    wave_sync();
    float o[4][2];
#pragma unroll
    for (int g = 0; g < 4; ++g) { o[g][0] = 0.f; o[g][1] = 0.f; }
    for (int sg = 0; sg < nseg; ++sg) {
        const int start = segs[sg], len = segs[16 + sg];
        for (int l = 0; l < len; ++l) {
            const float* vp = Vb + (size_t)(start + l) * ld;
            if (SHARED) {
                const float v0 = vp[lane], v1 = vp[lane + 64];
#pragma unroll
                for (int g = 0; g < 4; ++g) { const float p = sw[g * 1024 + sg * 64 + l]; o[g][0] += p * v0; o[g][1] += p * v1; }
            } else {
#pragma unroll
                for (int g = 0; g < 4; ++g) { const float p = sw[g * 1024 + sg * 64 + l]; o[g][0] += p * vp[g * 128 + lane]; o[g][1] += p * vp[g * 128 + lane + 64]; }
            }
        }
    }
#pragma unroll
    for (int g = 0; g < 4; ++g) { optr[g * 128 + lane] = o[g][0]; optr[g * 128 + lane + 64] = o[g][1]; }
}

namespace g8 {
constexpr int BM = 256, BK = 64, HALF = 128, HTB = HALF * BK * 2, STAGE_BYTES = 8 * HTB;
constexpr int KK = 2048;
typedef float f32x4 __attribute__((ext_vector_type(4)));
__device__ __forceinline__ int lds_byte(int r, int c) { const int st = (r >> 4) * 2 + (c >> 5), rr = r & 15, cc = c & 31, ob = rr * 64 + cc * 2; return st * 1024 + (ob ^ (((ob >> 9) & 1) << 5)); }
__device__ __forceinline__ void stage_rc(int b, int& R, int& C) { const int st = b / 1024, sb = b % 1024, swz = sb ^ (((sb >> 9) & 1) << 5); R = (st >> 1) * 16 + swz / 64; C = (st & 1) * 32 + (swz % 64) / 2; }
__device__ __forceinline__ int perm32(int rho) { const int n = rho >> 4, i = rho & 15; return 8 * (i >> 2) + 4 * n + (i & 3); }

typedef int i32x4 __attribute__((ext_vector_type(4)));
typedef unsigned u32x2 __attribute__((ext_vector_type(2)));
typedef unsigned u32x4 __attribute__((ext_vector_type(4)));
template <bool I8> struct AccSel { typedef f32x4 T; };
template <> struct AccSel<true> { typedef i32x4 T; };
__device__ __forceinline__ f32x4 mma16(i32x4 a, i32x4 b, f32x4 c) { return __builtin_amdgcn_mfma_f32_16x16x32_f16(*reinterpret_cast<h8*>(&a), *reinterpret_cast<h8*>(&b), c, 0, 0, 0); }
__device__ __forceinline__ i32x4 mma16(i32x4 a, i32x4 b, i32x4 c) { return __builtin_amdgcn_mfma_i32_16x16x64_i8(a, b, c, 0, 0, 0); }
struct Unit { int m0, n0, e, cnt, rbase; };
constexpr int EP_OFF = STAGE_BYTES + 2048, EP_LD = 528, EP_GRP = 16 * EP_LD;
__device__ __forceinline__ void ep_sync() { asm volatile("s_waitcnt lgkmcnt(0)" ::: "memory"); __builtin_amdgcn_s_barrier(); asm volatile("" ::: "memory"); }
__device__ __forceinline__ int ep_tid() { int tz = threadIdx.x; asm volatile("" : "+v"(tz)); return tz; }
__device__ __forceinline__ h8 cvt8(f32x4 a, f32x4 b) { h8 o; o[0] = (_Float16)a[0]; o[1] = (_Float16)a[1]; o[2] = (_Float16)a[2]; o[3] = (_Float16)a[3]; o[4] = (_Float16)b[0]; o[5] = (_Float16)b[1]; o[6] = (_Float16)b[2]; o[7] = (_Float16)b[3]; return o; }

__device__ __forceinline__ void tile_order(int L, int nM, int nN, int& pm, int& pn) {
    const int nwg = nM * nN; int wgid = L;
    { const int q = nwg / 8, r = nwg % 8, xcd = wgid % 8, off = wgid / 8; wgid = (xcd < r ? xcd * (q + 1) : r * (q + 1) + (xcd - r) * q) + off; }
    const int nig = 8 * nN, gid = wgid / nig, fm = gid * 8, gsz = (nM - fm) < 8 ? (nM - fm) : 8;
    pm = fm + ((wgid % nig) % gsz); pn = (wgid % nig) / gsz;
}

template <class Prob>
__device__ __forceinline__ void gemm_phase(LAS unsigned char* lds, const Prob& P) {
    const int tid = threadIdx.x, wid = __builtin_amdgcn_readfirstlane(tid >> 6), lane = tid & 63, wr = wid >> 2, wc = wid & 3, fr = lane & 15, fq = lane >> 4;
    constexpr int nt = Prob::NT; constexpr size_t KS2 = Prob::KS2; constexpr unsigned ROWB = Prob::ROWB; constexpr bool I8 = Prob::I8;
    int sR[2], sC2[2]; unsigned voffB[2];
#pragma unroll
    for (int i = 0; i < 2; ++i) { int R, C; stage_rc(tid * 16 + i * 8192, R, C); sR[i] = R; sC2[i] = C * 2; const int Rb = Prob::PERM ? ((R & ~31) + perm32(R & 31)) : R; voffB[i] = (unsigned)Rb * ROWB + (unsigned)C * 2u; }
    const size_t kstep = (size_t)(BK * 2);
    const size_t hstep = (size_t)HALF * ROWB;
    const unsigned ldsw = (unsigned)wid * 1024u;
    const int aoff = lds_byte(wr * 64 + fr, fq * 8), boff = lds_byte(wc * 32 + fr, fq * 8);
#define G8_SA(b, h) (((b) * 2 + (h)) * HTB)
#define G8_SB(b, h) ((4 + (b) * 2 + (h)) * HTB)
#define G8_STAGE(bufoff, gbase, voff) do { _Pragma("unroll") for (int _i = 0; _i < 2; ++_i) \
        __builtin_amdgcn_global_load_lds((const unsigned*)((const char*)(gbase) + (voff)[_i]), (LAS unsigned*)(lds + (bufoff) + ldsw + _i * 8192), 16, 0, 0); } while (0)
#define G8_LDA(dst, b, h) do { _Pragma("unroll") for (int m = 0; m < 4; ++m) _Pragma("unroll") for (int k = 0; k < 2; ++k) dst[m][k] = *(const LAS i32x4*)(lds + G8_SA(b, h) + aoff + m * 2048 + k * 1024); } while (0)
#define G8_LDB(dst, b, h) do { _Pragma("unroll") for (int n = 0; n < 2; ++n) _Pragma("unroll") for (int k = 0; k < 2; ++k) dst[n][k] = *(const LAS i32x4*)(lds + G8_SB(b, h) + boff + n * 2048 + k * 1024); } while (0)
#define G8_MMA(ai, bj, At, Bt) do { __builtin_amdgcn_s_setprio(1); _Pragma("unroll") for (int m = 0; m < 4; ++m) _Pragma("unroll") for (int n = 0; n < 2; ++n) _Pragma("unroll") for (int k = 0; k < 2; ++k) \
        acc[ai][bj][m][n] = mma16(Bt[n][k], At[m][k], acc[ai][bj][m][n]); __builtin_amdgcn_s_setprio(0); } while (0)
#define G8_WAIT_V(n) asm volatile("s_waitcnt vmcnt(" #n ")" ::: "memory")
#define G8_WAIT_L(n) asm volatile("s_waitcnt lgkmcnt(" #n ")" ::: "memory")
#define G8_BAR __builtin_amdgcn_s_barrier()
#define G8_SCHED __builtin_amdgcn_sched_barrier(0)
    Unit cur, nxt; int ui = 0;
    if (!P.next(0, cur)) return;
    typedef typename AccSel<I8>::T AccT;
    AccT acc[2][2][4][2];
#pragma unroll
    for (int a = 0; a < 2; ++a)
#pragma unroll
        for (int b = 0; b < 2; ++b)
#pragma unroll
            for (int m = 0; m < 4; ++m)
#pragma unroll
                for (int n = 0; n < 2; ++n) acc[a][b][m][n] = AccT{};
    i32x4 At[4][2], B0[2][2], B1[2][2];
    unsigned vc[2][2], vn[2][2];
    P.a_offs(cur, sR, sC2, vc);
    const char* const Ab = P.a_base();
    const char* cB = P.b_base(cur);
    G8_STAGE(G8_SB(0, 0), cB, voffB); G8_STAGE(G8_SA(0, 0), Ab, vc[0]); G8_STAGE(G8_SB(0, 1), cB + hstep, voffB); G8_STAGE(G8_SA(0, 1), Ab, vc[1]);
    if (wr == 1) G8_BAR;
    G8_WAIT_V(4); G8_BAR;
    G8_STAGE(G8_SB(1, 0), cB + kstep, voffB); G8_STAGE(G8_SA(1, 0), Ab + kstep, vc[0]); G8_STAGE(G8_SB(1, 1), cB + hstep + kstep, voffB);
    G8_WAIT_V(6); G8_BAR;
    for (;;) {
        const bool has_next = P.next(ui + 1, nxt);
        const char* nB = cB;
        if (has_next) { P.a_offs(nxt, sR, sC2, vn); nB = P.b_base(nxt); }
        else { vn[0][0] = vc[0][0]; vn[0][1] = vc[0][1]; vn[1][0] = vc[1][0]; vn[1][1] = vc[1][1]; }
        for (int t = 0; t < nt; t += 2) {
            const bool last = (t == nt - 2);
            const char* a1 = Ab + (size_t)(t >> 1) * KS2 + kstep;
            const char* a2 = last ? Ab : Ab + (size_t)((t + 2) >> 1) * KS2; const char* b2 = last ? nB : cB + (size_t)(t + 2) * kstep;
            const char* a3 = a2 + kstep; const char* b3 = b2 + kstep;
            unsigned o2[2][2];
            o2[0][0] = last ? vn[0][0] : vc[0][0]; o2[0][1] = last ? vn[0][1] : vc[0][1]; o2[1][0] = last ? vn[1][0] : vc[1][0]; o2[1][1] = last ? vn[1][1] : vc[1][1];
            G8_LDB(B0, 0, 0); G8_SCHED; G8_LDA(At, 0, 0); G8_STAGE(G8_SA(1, 1), a1, vc[1]);
            G8_WAIT_L(8); G8_BAR; G8_WAIT_L(0); G8_MMA(0, 0, At, B0); G8_BAR; G8_SCHED;
            G8_LDB(B1, 0, 1); G8_STAGE(G8_SB(0, 0), b2, voffB);
            G8_BAR; G8_WAIT_L(0); G8_MMA(0, 1, At, B1); G8_BAR;
            G8_LDA(At, 0, 1); G8_STAGE(G8_SA(0, 0), a2, o2[0]);
            G8_BAR; G8_WAIT_L(0); G8_MMA(1, 0, At, B0); G8_BAR; G8_SCHED;
            G8_STAGE(G8_SB(0, 1), b2 + hstep, voffB);
            G8_WAIT_V(6); G8_BAR; G8_MMA(1, 1, At, B1); G8_BAR;
            G8_LDB(B0, 1, 0); G8_SCHED; G8_LDA(At, 1, 0); G8_STAGE(G8_SA(0, 1), a2, o2[1]);
            G8_WAIT_L(8); G8_BAR; G8_WAIT_L(0); G8_MMA(0, 0, At, B0); G8_BAR; G8_SCHED;
            G8_LDB(B1, 1, 1); G8_STAGE(G8_SB(1, 0), b3, voffB);
            G8_BAR; G8_WAIT_L(0); G8_MMA(0, 1, At, B1); G8_BAR;
            G8_LDA(At, 1, 1); G8_STAGE(G8_SA(1, 0), a3, o2[0]);
            G8_BAR; G8_WAIT_L(0); G8_MMA(1, 0, At, B0); G8_BAR; G8_SCHED;
            G8_STAGE(G8_SB(1, 1), b3 + hstep, voffB);
            G8_WAIT_V(6); G8_BAR; G8_MMA(1, 1, At, B1); G8_BAR;
        }
        P.epi(acc, cur, wr, wc, fr, fq, lds);
        if (!has_next) break;
#pragma unroll
        for (int a = 0; a < 2; ++a)
#pragma unroll
            for (int b = 0; b < 2; ++b)
#pragma unroll
                for (int m = 0; m < 4; ++m)
#pragma unroll
                    for (int n = 0; n < 2; ++n) acc[a][b][m][n] = AccT{};
        cur = nxt; cB = nB; ++ui;
        vc[0][0] = vn[0][0]; vc[0][1] = vn[0][1]; vc[1][0] = vn[1][0]; vc[1][1] = vn[1][1];
    }
    G8_WAIT_V(0);
    if (wr == 0) G8_BAR;
    G8_BAR;
#undef G8_SA
#undef G8_SB
#undef G8_STAGE
#undef G8_LDA
#undef G8_LDB
#undef G8_MMA
#undef G8_WAIT_V
#undef G8_WAIT_L
#undef G8_BAR
#undef G8_SCHED
}

struct ProbInF {
    static constexpr unsigned ROWB = 4096; static constexpr bool I8 = false;
    static constexpr int NT = 32; static constexpr size_t KS2 = 256;
    static constexpr bool PERM = true;
    const _Float16* A; _Float16* C16; int G, c;
    __device__ __forceinline__ bool next(int i, Unit& u) const { const int L = i * G + c; if (L >= 64 * 5) return false;
        int pm, pn; tile_order(L, 64, 5, pm, pn); u.m0 = pm * 256; u.n0 = pn * 256; u.e = 0; u.cnt = 256; u.rbase = 0; return true; }
    __device__ __forceinline__ void a_offs(const Unit& u, const int (&R)[2], const int (&C2)[2], unsigned (&v)[2][2]) const {
#pragma unroll
        for (int h = 0; h < 2; ++h)
#pragma unroll
            for (int i = 0; i < 2; ++i) v[h][i] = (unsigned)(u.m0 + h * 128 + R[i]) * (unsigned)(KK * 2) + (unsigned)C2[i]; }
    __device__ __forceinline__ const char* a_base() const { return (const char*)A; }
    __device__ __forceinline__ const char* b_base(const Unit& u) const { return (const char*)A + (long long)(WS_WTIN - WS_X16) + (size_t)u.n0 * KK * 2; }
    __device__ __forceinline__ void epi(const f32x4 (&acc)[2][2][4][2], const Unit& u, int wr, int wc, int fr, int fq, LAS unsigned char* lds) const {
        LAS unsigned char* ep = lds + EP_OFF + wr * EP_GRP;
        const int tg = ep_tid() & 255, rrow = tg >> 4, ch = tg & 15;
        const int kvseg = (u.e == 0 && u.n0 >= 1024 && u.n0 < 2560) ? ((u.n0 - 1024) >> 8) : -1;
        _Float16* const Cb = (_Float16*)((char*)C16 + (u.e ? (long long)(WS_KVMEM16 - WS_PROJ16) : 0ll)); const int ldc = u.e ? 1024 : INW, nlim = u.e ? 1024 : INW, mb = u.e ? u.m0 - T_ : u.m0;
#pragma unroll
        for (int ai = 0; ai < 2; ++ai)
#pragma unroll
            for (int m = 0; m < 4; ++m) {
#pragma unroll
                for (int bj = 0; bj < 2; ++bj) *(LAS h8*)(ep + fr * EP_LD + (bj * 128 + wc * 32 + fq * 8) * 2) = cvt8(acc[ai][bj][m][0], acc[ai][bj][m][1]);
                ep_sync();
                const h8 x0 = *(const LAS h8*)(ep + rrow * EP_LD + ch * 32), x1 = *(const LAS h8*)(ep + rrow * EP_LD + ch * 32 + 16);
                const int grow = mb + ai * 128 + wr * 64 + m * 16 + rrow, gcol = u.n0 + ch * 16;
                if (kvseg >= 0) {
                    _Float16* dst = (_Float16*)((char*)C16 + (long long)(WS_KV16 - WS_PROJ16)) + ((size_t)(kvseg * B_ + (grow >> 11)) * 2 + (ch >> 3)) * KVSEG + (size_t)(grow & (S_ - 1)) * 128 + (ch & 7) * 16;
                    *(h8*)dst = x0; *(h8*)(dst + 8) = x1;
                } else {
                    if (gcol < nlim) *(h8*)(Cb + (size_t)grow * ldc + gcol) = x0;
                    if (gcol + 8 < nlim) *(h8*)(Cb + (size_t)grow * ldc + gcol + 8) = x1; }
                ep_sync();
            } }
};
struct ProbIn8 {
    static constexpr unsigned ROWB = 2048; static constexpr bool I8 = true;
    static constexpr int NT = 16; static constexpr size_t KS2 = 256;
    static constexpr bool PERM = true;
    const signed char* A; _Float16* C16; const float* sa; int G, c;
    __device__ __forceinline__ bool next(int i, Unit& u) const { const int L = i * G + c; if (L >= 640 + 32) return false;
        if (L < 640) { int pm, pn; tile_order(L, 64, 10, pm, pn); u.m0 = pm * 256; u.n0 = 1280 + pn * 256; u.e = 0; }
        else { const int v = L - 640; u.m0 = T_ + (v & 7) * 256; u.n0 = (v >> 3) * 256; u.e = 1; }
        u.cnt = 256; u.rbase = 0; return true; }
    __device__ __forceinline__ void a_offs(const Unit& u, const int (&R)[2], const int (&C2)[2], unsigned (&v)[2][2]) const {
#pragma unroll
        for (int h = 0; h < 2; ++h)
#pragma unroll
            for (int i = 0; i < 2; ++i) v[h][i] = (unsigned)(u.m0 + h * 128 + R[i]) * 2048u + (unsigned)C2[i]; }
    __device__ __forceinline__ const char* a_base() const { return (const char*)A; }
    __device__ __forceinline__ const char* b_base(const Unit& u) const { return (const char*)A + (u.e ? (long long)(WS_Q8MKV - WS_X8) + (long long)u.n0 * 2048 : (long long)(WS_Q8IN - WS_X8) + (long long)(u.n0 - 1280) * 2048); }
    __device__ __forceinline__ void epi(const i32x4 (&acc)[2][2][4][2], const Unit& u, int wr, int wc, int fr, int fq, LAS unsigned char* lds) const {
        LAS unsigned char* ep = lds + EP_OFF + wr * EP_GRP;
        const int tg = ep_tid() & 255, rrow = tg >> 4, ch = tg & 15;
        const int kvseg = (u.e == 0 && u.n0 >= 1024 && u.n0 < 2560) ? ((u.n0 - 1024) >> 8) : -1;
        _Float16* const Cb = (_Float16*)((char*)C16 + (u.e ? (long long)(WS_KVMEM16 - WS_PROJ16) : 0ll)); const int ldc = u.e ? 1024 : INW, nlim = u.e ? 1024 : INW, mb = u.e ? u.m0 - T_ : u.m0;
        const float* sw = (const float*)((const char*)A + (u.e ? (long long)(WS_SMKV - WS_X8) : (long long)(WS_SIN8 - WS_X8))) + (u.e ? u.n0 : u.n0 - 1280);
        f32x4 s0[2], s1[2]; float srv[8];
#pragma unroll
        for (int bj = 0; bj < 2; ++bj) { const int col = bj * 128 + wc * 32 + fq * 8; s0[bj] = *(const f32x4*)(sw + col); s1[bj] = *(const f32x4*)(sw + col + 4); }
#pragma unroll
        for (int q = 0; q < 8; ++q) srv[q] = sa[u.m0 + (q >> 2) * 128 + wr * 64 + (q & 3) * 16 + fr];
#pragma unroll
        for (int ai = 0; ai < 2; ++ai)
#pragma unroll
            for (int m = 0; m < 4; ++m) { const float sr = srv[ai * 4 + m];
#pragma unroll
                for (int bj = 0; bj < 2; ++bj) { const i32x4 i0 = acc[ai][bj][m][0], i1 = acc[ai][bj][m][1];
                    *(LAS h8*)(ep + fr * EP_LD + (bj * 128 + wc * 32 + fq * 8) * 2) = cvt8((f32x4){(float)i0[0], (float)i0[1], (float)i0[2], (float)i0[3]} * (s0[bj] * sr), (f32x4){(float)i1[0], (float)i1[1], (float)i1[2], (float)i1[3]} * (s1[bj] * sr)); }
                ep_sync();
                const h8 x0 = *(const LAS h8*)(ep + rrow * EP_LD + ch * 32), x1 = *(const LAS h8*)(ep + rrow * EP_LD + ch * 32 + 16);
                const int grow = mb + ai * 128 + wr * 64 + m * 16 + rrow, gcol = u.n0 + ch * 16;
                if (kvseg >= 0) {
                    _Float16* dst = (_Float16*)((char*)C16 + (long long)(WS_KV16 - WS_PROJ16)) + ((size_t)(kvseg * B_ + (grow >> 11)) * 2 + (ch >> 3)) * KVSEG + (size_t)(grow & (S_ - 1)) * 128 + (ch & 7) * 16;
                    *(h8*)dst = x0; *(h8*)(dst + 8) = x1;
                } else {
                    if (gcol < nlim) *(h8*)(Cb + (size_t)grow * ldc + gcol) = x0;
                    if (gcol + 8 < nlim) *(h8*)(Cb + (size_t)grow * ldc + gcol + 8) = x1; }
                ep_sync();
            } }
};
struct ProbOut {
    static constexpr unsigned ROWB = 2048; static constexpr bool I8 = true;
    static constexpr int NT = 16; static constexpr size_t KS2 = 256;
    static constexpr bool PERM = true;
    const signed char* A; const signed char* Bt; _Float16* C; const _Float16* X; const float* sa; const float* sw; int G, c;
    __device__ __forceinline__ bool next(int i, Unit& u) const { const int L = i * G + c; if (L >= 64 * 8) return false; int pm, pn; tile_order(L, 64, 8, pm, pn); u.m0 = pm * 256; u.n0 = pn * 256; u.e = 0; u.cnt = 256; u.rbase = 0; return true; }
    __device__ __forceinline__ void a_offs(const Unit& u, const int (&R)[2], const int (&C2)[2], unsigned (&v)[2][2]) const {
#pragma unroll
        for (int h = 0; h < 2; ++h)
#pragma unroll
            for (int i = 0; i < 2; ++i) v[h][i] = (unsigned)(u.m0 + h * 128 + R[i]) * 2048u + (unsigned)C2[i]; }
    __device__ __forceinline__ const char* a_base() const { return (const char*)A; }
    __device__ __forceinline__ const char* b_base(const Unit& u) const { return (const char*)(Bt + (size_t)u.n0 * 2048); }
    __device__ __forceinline__ void epi(const i32x4 (&acc)[2][2][4][2], const Unit& u, int wr, int wc, int fr, int fq, LAS unsigned char* lds) const {
        LAS unsigned char* ep = lds + EP_OFF + wr * EP_GRP;
        const int tg = ep_tid() & 255, rrow = tg >> 4, ch = tg & 15;
        f32x4 s0[2], s1[2]; float srv[8];
#pragma unroll
        for (int bj = 0; bj < 2; ++bj) { const int col = u.n0 + bj * 128 + wc * 32 + fq * 8; s0[bj] = *(const f32x4*)(sw + col); s1[bj] = *(const f32x4*)(sw + col + 4); }
#pragma unroll
        for (int q = 0; q < 8; ++q) srv[q] = sa[u.m0 + (q >> 2) * 128 + wr * 64 + (q & 3) * 16 + fr];
#pragma unroll
        for (int ai = 0; ai < 2; ++ai)
#pragma unroll
            for (int m = 0; m < 4; ++m) { const float sr = srv[ai * 4 + m];
#pragma unroll
                for (int bj = 0; bj < 2; ++bj) { const i32x4 i0 = acc[ai][bj][m][0], i1 = acc[ai][bj][m][1];
                    *(LAS h8*)(ep + fr * EP_LD + (bj * 128 + wc * 32 + fq * 8) * 2) = cvt8((f32x4){(float)i0[0], (float)i0[1], (float)i0[2], (float)i0[3]} * (s0[bj] * sr), (f32x4){(float)i1[0], (float)i1[1], (float)i1[2], (float)i1[3]} * (s1[bj] * sr)); }
                const size_t go = (size_t)(u.m0 + ai * 128 + wr * 64 + m * 16 + rrow) * 2048 + u.n0 + ch * 16;
                const h8 r0 = *(const h8*)(X + go), r1 = *(const h8*)(X + go + 8);
                ep_sync();
                const h8 x0 = *(const LAS h8*)(ep + rrow * EP_LD + ch * 32), x1 = *(const LAS h8*)(ep + rrow * EP_LD + ch * 32 + 16);
                h8 o0, o1;
#pragma unroll
                for (int q = 0; q < 8; ++q) { o0[q] = (_Float16)(DN_ALPHA * (float)r0[q] + (float)x0[q]); o1[q] = (_Float16)(DN_ALPHA * (float)r1[q] + (float)x1[q]); }
                *(h8*)(C + go) = o0; *(h8*)(C + go + 8) = o1;
                ep_sync();
            } }
};
struct ProbCmp {
    static constexpr unsigned ROWB = 4096; static constexpr bool I8 = false;
    static constexpr int NT = 8; static constexpr size_t KS2 = 256;
    static constexpr bool PERM = false;
    const _Float16* A; const _Float16* Bt; float* C; int G, c;
    __device__ __forceinline__ bool next(int i, Unit& u) const { const int L = i * G + c; if (L >= 128) return false;
        u.e = L >> 6; const int r = L & 63; u.rbase = r & 3; u.n0 = ((r >> 2) & 1) * 256; u.m0 = (r >> 3) * 256; u.cnt = 256; return true; }
    __device__ __forceinline__ void a_offs(const Unit& u, const int (&R)[2], const int (&C2)[2], unsigned (&v)[2][2]) const {
#pragma unroll
        for (int h = 0; h < 2; ++h)
#pragma unroll
            for (int i = 0; i < 2; ++i) { const int row = u.m0 + h * 128 + R[i], kvh = row & 1, bj = row >> 1, b = bj >> 7, j = bj & 127;
                v[h][i] = (unsigned)((((u.e * B_ + b) * 2 + kvh) * S_ + 16 * j + 4 * u.rbase) * 128) * 2u + (unsigned)C2[i]; } }
    __device__ __forceinline__ const char* a_base() const { return (const char*)A; }
    __device__ __forceinline__ const char* b_base(const Unit& u) const { return (const char*)(Bt + ((size_t)u.e * 512 + u.n0) * KK + u.rbase * 512); }
    __device__ __forceinline__ void epi(const f32x4 (&acc)[2][2][4][2], const Unit& u, int wr, int wc, int fr, int fq, LAS unsigned char*) const {
        float* base = C + ((size_t)(u.e * 4 + u.rbase) * 2048) * 512;
#pragma unroll
        for (int ai = 0; ai < 2; ++ai)
#pragma unroll
            for (int m = 0; m < 4; ++m) { const int row = u.m0 + ai * 128 + wr * 64 + m * 16 + fr;
#pragma unroll
                for (int bj = 0; bj < 2; ++bj)
#pragma unroll
                    for (int n = 0; n < 2; ++n) { const int col = u.n0 + bj * 128 + wc * 32 + n * 16 + fq * 4;
                        *(f32x4*)(base + (size_t)row * 512 + col) = acc[ai][bj][m][n]; } } }
};
struct MoeTab { const LAS int* t; int NT;
    __device__ __forceinline__ bool find_i(int i, Unit& u) const {
        const LAS int* q = t + 128 + 8 * i;
        if (__builtin_amdgcn_readfirstlane(q[5]) == 0) return false;
        u.e = __builtin_amdgcn_readfirstlane(q[0]); u.m0 = __builtin_amdgcn_readfirstlane(q[1]); u.n0 = __builtin_amdgcn_readfirstlane(q[2]); u.cnt = __builtin_amdgcn_readfirstlane(q[3]); u.rbase = __builtin_amdgcn_readfirstlane(q[4]); return true; } };
__device__ __forceinline__ void moe_build(LAS int* t, int G, int vcu) {
    const int i = threadIdx.x;
    if (i < 40) { const int L = i * G + vcu; LAS int* q = t + 128 + 8 * i;
        if (L >= t[98]) q[5] = 0;
        else { int e = 0; for (; e < NE - 1; ++e) { if (L < t[32 + e + 1]) break; }
            const int ub = t[32 + e], cn = t[e], rs = t[65 + e]; const int nm = (cn + 255) >> 8, v = L - ub, mt = v % nm, ntile = v / nm;
            q[0] = e; q[1] = mt * 256; q[2] = ntile * 256; q[3] = min(256, cn - mt * 256); q[4] = rs; q[5] = 1; } }
}
struct ProbGu {
    static constexpr int NT = 16; static constexpr size_t KS2 = 256; static constexpr unsigned ROWB = 2048; static constexpr bool I8 = true;
    static constexpr bool PERM = true;
    const signed char* A; const signed char* Bt; unsigned char* act; const float* bgu; const int* list; const float* sa; const float* sw; MoeTab tab; int G, vcu;
    __device__ __forceinline__ bool next(int i, Unit& u) const { return tab.find_i(i, u); }
    __device__ __forceinline__ void a_offs(const Unit& u, const int (&R)[2], const int (&C2)[2], unsigned (&v)[2][2]) const {
#pragma unroll
        for (int h = 0; h < 2; ++h)
#pragma unroll
            for (int i = 0; i < 2; ++i) { int r = h * 128 + R[i]; r = r < u.cnt ? r : 0; const int a = list[(size_t)u.e * T_ + u.m0 + r]; v[h][i] = (unsigned)(a >> 2) * 2048u + (unsigned)C2[i]; } }
    __device__ __forceinline__ const char* a_base() const { return (const char*)A; }
    __device__ __forceinline__ const char* b_base(const Unit& u) const { return (const char*)(Bt + ((size_t)u.e * 4096 + u.n0) * 2048); }
    __device__ __forceinline__ void epi(const i32x4 (&acc)[2][2][4][2], const Unit& u, int wr, int wc, int fr, int fq, LAS unsigned char* lds) const {
        const float* bb = bgu + (size_t)u.e * 4096; const float* ss = sw + (size_t)u.e * 4096;
        LAS unsigned char* ep = lds + EP_OFF + wr * EP_GRP;
        const int tg = ep_tid() & 255, rrow = tg >> 4, ch = tg & 15;
        f32x4 b0[2], b1[2], s0[2], s1[2];
#pragma unroll
        for (int bj = 0; bj < 2; ++bj) { const int col = u.n0 + bj * 128 + wc * 32 + fq * 8;
            b0[bj] = *(const f32x4*)(bb + col); b1[bj] = *(const f32x4*)(bb + col + 4); s0[bj] = *(const f32x4*)(ss + col); s1[bj] = *(const f32x4*)(ss + col + 4); }
        float srv[8];
        { int av[8];
#pragma unroll
          for (int q = 0; q < 8; ++q) { const int rl = (q >> 2) * 128 + wr * 64 + (q & 3) * 16 + fr; av[q] = list[(size_t)u.e * T_ + u.m0 + (rl < u.cnt ? rl : 0)]; }
#pragma unroll
          for (int q = 0; q < 8; ++q) srv[q] = sa[av[q] >> 2]; }
        LAS unsigned char* ep2 = lds + EP_OFF + wr * (2 * 4608);
#define GU_WRITE(st) do { const int ai_ = (st) >> 1, mp_ = (st) & 1; LAS unsigned char* eb = ep2 + ((st) & 1) * 4608; \
            _Pragma("unroll") for (int mm = 0; mm < 2; ++mm) { const int m_ = mp_ * 2 + mm; const float sr = srv[ai_ * 4 + m_]; \
                _Pragma("unroll") for (int bj = 0; bj < 2; ++bj) { const i32x4 i0 = acc[ai_][bj][m_][0], i1 = acc[ai_][bj][m_][1]; \
                    const f32x4 v0 = (f32x4){(float)i0[0], (float)i0[1], (float)i0[2], (float)i0[3]} * (s0[bj] * sr) + b0[bj], v1 = (f32x4){(float)i1[0], (float)i1[1], (float)i1[2], (float)i1[3]} * (s1[bj] * sr) + b1[bj]; \
                    *(LAS unsigned*)(eb + (mm * 16 + fr) * 144 + (bj * 64 + wc * 16 + fq * 4)) = pk4_fp8(swiglu_fast(v0[0], v0[1]), swiglu_fast(v0[2], v0[3]), swiglu_fast(v1[0], v1[1]), swiglu_fast(v1[2], v1[3])); } } } while (0)
        GU_WRITE(0);
        ep_sync();
#pragma unroll
        for (int st = 0; st < 4; ++st) {
            if (st + 1 < 4) GU_WRITE(st + 1);
#pragma unroll
            for (int mm = 0; mm < 2; ++mm) { const u32x2 x0 = *(const LAS u32x2*)(ep2 + (st & 1) * 4608 + (mm * 16 + rrow) * 144 + ch * 8);
                const int rr = (st >> 1) * 128 + wr * 64 + ((st & 1) * 2 + mm) * 16 + rrow;
                if (rr < u.cnt) *(u32x2*)(act + (size_t)(u.rbase + u.m0 + rr) * 2048 + (u.n0 >> 1) + ch * 8) = x0; }
            ep_sync();
        }
#undef GU_WRITE
    }
};
struct ProbDn {
    static constexpr int NT = 16; static constexpr size_t KS2 = 256; static constexpr unsigned ROWB = 2048; static constexpr bool I8 = true;
    static constexpr bool PERM = true;
    const signed char* A; const signed char* Bt; unsigned char* y; const float* bdn; const int* list; const float* gate; const float* sa; const float* sw; MoeTab tab; int G, vcu;
    __device__ __forceinline__ bool next(int i, Unit& u) const { return tab.find_i(i, u); }
    __device__ __forceinline__ void a_offs(const Unit& u, const int (&R)[2], const int (&C2)[2], unsigned (&v)[2][2]) const {
#pragma unroll
        for (int h = 0; h < 2; ++h)
#pragma unroll
            for (int i = 0; i < 2; ++i) v[h][i] = (unsigned)(u.rbase + u.m0 + h * 128 + R[i]) * 2048u + (unsigned)C2[i]; }
    __device__ __forceinline__ const char* a_base() const { return (const char*)A; }
    __device__ __forceinline__ const char* b_base(const Unit& u) const { return (const char*)(Bt + ((size_t)u.e * 2048 + u.n0) * 2048); }
    __device__ __forceinline__ void epi(const i32x4 (&acc)[2][2][4][2], const Unit& u, int wr, int wc, int fr, int fq, LAS unsigned char* lds) const {
        const float* bb = bdn + (size_t)u.e * 2048; const float* ss = sw + (size_t)u.e * 2048;
        LAS unsigned char* ep = lds + EP_OFF + wr * (2 * 4352);
        const int tg = ep_tid() & 255, rrow = tg >> 4, ch = tg & 15;
        f32x4 b0[2], b1[2], s0[2], s1[2];
#pragma unroll
        for (int bj = 0; bj < 2; ++bj) { const int col = u.n0 + bj * 128 + wc * 32 + fq * 8;
            b0[bj] = *(const f32x4*)(bb + col); b1[bj] = *(const f32x4*)(bb + col + 4); s0[bj] = *(const f32x4*)(ss + col); s1[bj] = *(const f32x4*)(ss + col + 4); }
        float gv[8], srv[8]; int a2v[8];
        { int av[8];
#pragma unroll
          for (int q = 0; q < 8; ++q) { const int rl = (q >> 2) * 128 + wr * 64 + (q & 3) * 16 + fr, rc = rl < u.cnt ? rl : 0; av[q] = list[(size_t)u.e * T_ + u.m0 + rc]; srv[q] = sa[u.rbase + u.m0 + rc];
              const int rr = (q >> 2) * 128 + wr * 64 + (q & 3) * 16 + rrow; a2v[q] = list[(size_t)u.e * T_ + u.m0 + (rr < u.cnt ? rr : 0)]; }
#pragma unroll
          for (int q = 0; q < 8; ++q) gv[q] = gate[av[q]]; }
#define DN_WRITE(st) do { const int ai_ = (st) >> 2, m_ = (st) & 3; const float g = gv[st] * 16.f, sr = srv[st]; LAS unsigned char* eb = ep + ((st) & 1) * 4352; \
            _Pragma("unroll") for (int bj = 0; bj < 2; ++bj) { const i32x4 i0 = acc[ai_][bj][m_][0], i1 = acc[ai_][bj][m_][1]; \
                const f32x4 v0 = ((f32x4){(float)i0[0], (float)i0[1], (float)i0[2], (float)i0[3]} * (s0[bj] * sr) + b0[bj]) * g, v1 = ((f32x4){(float)i1[0], (float)i1[1], (float)i1[2], (float)i1[3]} * (s1[bj] * sr) + b1[bj]) * g; \
                u32x2 o; o[0] = pk4_fp8(v0[0], v0[1], v0[2], v0[3]); o[1] = pk4_fp8(v1[0], v1[1], v1[2], v1[3]); \
                *(LAS u32x2*)(eb + fr * 272 + (bj * 128 + wc * 32 + fq * 8)) = o; } } while (0)
        DN_WRITE(0);
        ep_sync();
#pragma unroll
        for (int st = 0; st < 8; ++st) {
            if (st + 1 < 8) DN_WRITE(st + 1);
            const int rr = (st >> 2) * 128 + wr * 64 + (st & 3) * 16 + rrow;
            const u32x4 x0 = *(const LAS u32x4*)(ep + (st & 1) * 4352 + rrow * 272 + ch * 16);
            if (rr < u.cnt) *(u32x4*)(y + (size_t)a2v[st] * 2048 + u.n0 + ch * 16) = x0;
            ep_sync();
        }
#undef DN_WRITE
    }
};
}

namespace at8 {
typedef float f32x16 __attribute__((ext_vector_type(16)));
typedef short s16x4 __attribute__((ext_vector_type(4)));
typedef unsigned u32x4 __attribute__((ext_vector_type(4)));
constexpr int SHM_K = 64 * 128 * 2, SHM_V = 64 * 128 * 2, SLOT = SHM_K + SHM_V;
constexpr int NSLOT = 4;
constexpr int LDS_WS = NSLOT * SLOT;
constexpr int LDS_END = LDS_WS + 8 * 64 * 4;
constexpr float CEXP = ATT_SCALE * 1.4426950408889634f;
constexpr float THR_RAW = 8.f / ATT_SCALE;
#define AT_KSWZ(row, colB) ((row) * 256 + ((colB) ^ (((row) & 7) << 4)))
#define AT_SBAR() __builtin_amdgcn_sched_barrier(0)
__device__ __forceinline__ int crow(int r, int hi) { return (r & 3) + 8 * (r >> 2) + 4 * hi; }
__device__ __forceinline__ unsigned cvtpk(float lo, float hi) { auto v = __builtin_amdgcn_cvt_pkrtz(lo, hi); return *reinterpret_cast<unsigned*>(&v); }
__device__ __forceinline__ int v_st(int k, int c) { const int kk = (k & ~0xC) | ((k & 4) << 1) | ((k & 8) >> 1); return ((kk >> 3) * 4 + (c >> 5)) * 512 + ((kk & 7) * 32 + (c & 31)) * 2; }
__device__ __forceinline__ int v_rd_base(int lane) { return ((lane & 3) << 3) | (((lane >> 2) & 3) << 6) | (((lane >> 4) & 1) << 5) | (((lane >> 5) & 1) << 8); }
constexpr int v_rd_off(int d0, int ks, int half) { return d0 * 512 + ks * 4096 + half * 2048; }
template <int OFF> __device__ __forceinline__ s16x4 tr_read(int vb) { s16x4 r; asm volatile("ds_read_b64_tr_b16 %0, %1 offset:%2" : "=&v"(r) : "v"(vb), "i"(OFF) : "memory"); return r; }
__device__ __forceinline__ h8 mk8(s16x4 l, s16x4 h) { typedef short s16x8 __attribute__((ext_vector_type(8))); s16x8 w = {l[0], l[1], l[2], l[3], h[0], h[1], h[2], h[3]}; return *reinterpret_cast<h8*>(&w); }
template <int D0> __device__ __forceinline__ void pv_one(f32x16& od, int vb, h8 pa0, h8 pa1, h8 pa2, h8 pa3) {
    const s16x4 l0 = tr_read<v_rd_off(D0, 0, 0)>(vb), h0 = tr_read<v_rd_off(D0, 0, 1)>(vb), l1 = tr_read<v_rd_off(D0, 1, 0)>(vb), h1 = tr_read<v_rd_off(D0, 1, 1)>(vb);
    const s16x4 l2 = tr_read<v_rd_off(D0, 2, 0)>(vb), h2 = tr_read<v_rd_off(D0, 2, 1)>(vb), l3 = tr_read<v_rd_off(D0, 3, 0)>(vb), h3 = tr_read<v_rd_off(D0, 3, 1)>(vb);
    asm volatile("s_waitcnt lgkmcnt(0)" ::: "memory"); AT_SBAR();
    od = __builtin_amdgcn_mfma_f32_32x32x16_f16(pa0, mk8(l0, h0), od, 0, 0, 0);
    od = __builtin_amdgcn_mfma_f32_32x32x16_f16(pa1, mk8(l1, h1), od, 0, 0, 0);
    od = __builtin_amdgcn_mfma_f32_32x32x16_f16(pa2, mk8(l2, h2), od, 0, 0, 0);
    od = __builtin_amdgcn_mfma_f32_32x32x16_f16(pa3, mk8(l3, h3), od, 0, 0, 0);
}
__device__ __forceinline__ void pv_d0(f32x16 (&o)[4], int vb, h8 pa0, h8 pa1, h8 pa2, h8 pa3) {
    pv_one<0>(o[0], vb, pa0, pa1, pa2, pa3); pv_one<1>(o[1], vb, pa0, pa1, pa2, pa3); pv_one<2>(o[2], vb, pa0, pa1, pa2, pa3); pv_one<3>(o[3], vb, pa0, pa1, pa2, pa3);
}
__device__ __forceinline__ void qkt(f32x16& p0, f32x16& p1, const char* Ks, const h8 (&qr)[8], int r32, int hi) {
    p0 = f32x16{}; p1 = f32x16{};
#pragma unroll
    for (int d0 = 0; d0 < 8; ++d0) { const int cb = (d0 * 16 + hi * 8) * 2;
        const h8 b0 = *reinterpret_cast<const h8*>(Ks + AT_KSWZ(r32, cb));
        const h8 b1 = *reinterpret_cast<const h8*>(Ks + AT_KSWZ(32 + r32, cb));
        p0 = __builtin_amdgcn_mfma_f32_32x32x16_f16(b0, qr[d0], p0, 0, 0, 0);
        p1 = __builtin_amdgcn_mfma_f32_32x32x16_f16(b1, qr[d0], p1, 0, 0, 0); }
}
__device__ __forceinline__ void pack_p(const f32x16& p0, const f32x16& p1, h8& pa0, h8& pa1, h8& pa2, h8& pa3) {
#define AT_PK4(P, BASE, OUT) do { unsigned a0 = cvtpk(P[BASE + 0], P[BASE + 1]), a1 = cvtpk(P[BASE + 2], P[BASE + 3]); \
    unsigned b0 = cvtpk(P[BASE + 4], P[BASE + 5]), b1 = cvtpk(P[BASE + 6], P[BASE + 7]); \
    auto r0 = __builtin_amdgcn_permlane32_swap(a0, b0, false, false); auto r1 = __builtin_amdgcn_permlane32_swap(a1, b1, false, false); \
    u32x4 w = {r0[0], r1[0], r0[1], r1[1]}; OUT = *reinterpret_cast<h8*>(&w); } while (0)
    AT_PK4(p0, 0, pa0); AT_PK4(p0, 8, pa1); AT_PK4(p1, 0, pa2); AT_PK4(p1, 8, pa3);
#undef AT_PK4
}
__device__ __forceinline__ float half_swap_max(float v) { auto rr = __builtin_amdgcn_permlane32_swap(__float_as_uint(v), __float_as_uint(v), false, false); return fmaxf(__uint_as_float(rr[0]), __uint_as_float(rr[1])); }
__device__ __forceinline__ float half_swap_sum(float v) { auto rr = __builtin_amdgcn_permlane32_swap(__float_as_uint(v), __float_as_uint(v), false, false); return __uint_as_float(rr[0]) + __uint_as_float(rr[1]); }

__device__ __forceinline__ int hidden_tid() { int tz = threadIdx.x; asm volatile("" : "+v"(tz)); return tz; }
__device__ __forceinline__ void dma_offsets(int ld, int (&ko)[2], int (&vo)[2]) {
    const int tz = hidden_tid(), w = tz >> 6, l = tz & 63;
#pragma unroll
    for (int q = 0; q < 2; ++q) {
        const int rr = 4 * (2 * w + q) + (l >> 4), pp = l & 15;
        ko[q] = rr * ld + ((pp ^ (rr & 7)) * 8);
        const int L = (2 * w + q) * 1024 + l * 16, sidx = L >> 9, o = L & 511;
        const int kk = (sidx >> 2) * 8 + (o >> 6), c = (sidx & 3) * 32 + ((o & 63) >> 1);
        const int k = (kk & ~0xC) | ((kk & 4) << 1) | ((kk & 8) >> 1);
        vo[q] = k * ld + c;
    }
}
__device__ __forceinline__ void dma_tile(char* slot, const _Float16* Kb, const _Float16* Vb, int ld, int tile, const int (&ko)[2], const int (&vo)[2], int wid) {
    const _Float16* kt = Kb + (size_t)tile * 64 * ld; const _Float16* vt = Vb + (size_t)tile * 64 * ld;
#pragma unroll
    for (int q = 0; q < 2; ++q) __builtin_amdgcn_global_load_lds((const unsigned*)(kt + ko[q]), (LAS unsigned*)(slot + (2 * wid + q) * 1024), 16, 0, 0);
#pragma unroll
    for (int q = 0; q < 2; ++q) __builtin_amdgcn_global_load_lds((const unsigned*)(vt + vo[q]), (LAS unsigned*)(slot + SHM_K + (2 * wid + q) * 1024), 16, 0, 0);
}
#define AT_WAITV(n) asm volatile("s_waitcnt vmcnt(" #n ")" ::: "memory")
#define AT_BAR() do { asm volatile("s_waitcnt lgkmcnt(0)" ::: "memory"); __builtin_amdgcn_s_barrier(); asm volatile("" ::: "memory"); } while (0)

__device__ __forceinline__ void attn_unit(char* lds, const _Float16* qrow, const _Float16* Kb, const _Float16* Vb, int ld, unsigned tmask, int wlen, int khi, unsigned selmask,
                                          _Float16* outw, int ostride) {
    const int tid = threadIdx.x, wid = __builtin_amdgcn_readfirstlane(tid >> 6), lane = tid & 63, r32 = lane & 31, hi = lane >> 5;
    float* wsf = (float*)(lds + LDS_WS) + wid * 64; float* li_l = wsf; float* al_l = wsf + 32;
    float m_reg = -1e30f, l_reg = 0.f; f32x16 o[4] = {}; h8 qr[8];
#pragma unroll
    for (int d0 = 0; d0 < 8; ++d0) qr[d0] = *(const h8*)(qrow + d0 * 16);
    int ko[2], vo[2]; dma_offsets(ld, ko, vo);
    const int vbase = (int)(uintptr_t)lds + SHM_K + v_rd_base(lane);
    unsigned rest = tmask; int j = __ffs(rest) - 1; rest &= rest - 1;
    int j1 = rest ? (__ffs(rest) - 1) : -1; if (j1 >= 0) rest &= rest - 1;
    dma_tile(lds, Kb, Vb, ld, j, ko, vo, wid);
    if (j1 >= 0) { dma_tile(lds + SLOT, Kb, Vb, ld, j1, ko, vo, wid); AT_WAITV(4); } else { AT_WAITV(0); }
    AT_BAR();
    int so = 0, sp = 0;
    const bool roleB = wid >= 4;
    bool first = true;
    h8 pa0, pa1, pa2, pa3;
    for (;;) {
        const int j2 = rest ? (__ffs(rest) - 1) : -1;
        if (j2 >= 0) { rest &= rest - 1; int s2 = so + 2 * SLOT; s2 = s2 >= NSLOT * SLOT ? s2 - NSLOT * SLOT : s2; dma_tile(lds + s2, Kb, Vb, ld, j2, ko, vo, wid); }
        if (roleB && !first) { AT_SBAR(); pv_d0(o, vbase + sp, pa0, pa1, pa2, pa3); }
        f32x16 p0, p1;
        AT_SBAR(); qkt(p0, p1, lds + so, qr, r32, hi);
        { const int klo = wlen > 0 ? khi - wlen + 1 : 0; const bool tb = (selmask >> j) & 1u; const bool inr = (j * 64 >= klo) && (j * 64 + 63 <= khi);
          if (!__all(tb && inr)) {
              if (__all(inr)) {
#pragma unroll
                  for (int r = 0; r < 16; ++r) { p0[r] = tb ? p0[r] : -INFINITY; p1[r] = tb ? p1[r] : -INFINITY; }
              } else {
                  const int kb = j * 64 + 4 * hi;
#pragma unroll
                  for (int r = 0; r < 16; ++r) { const int k0 = kb + (r & 3) + 8 * (r >> 2);
                      p0[r] = (tb && k0 >= klo && k0 <= khi) ? p0[r] : -INFINITY;
                      p1[r] = (tb && (k0 + 32) >= klo && (k0 + 32) <= khi) ? p1[r] : -INFINITY; }
              } } }
        float pmax = p0[0];
#pragma unroll
        for (int r = 1; r < 16; ++r) pmax = fmaxf(pmax, p0[r]);
#pragma unroll
        for (int r = 0; r < 16; ++r) pmax = fmaxf(pmax, p1[r]);
        pmax = half_swap_max(pmax);
        float mn, alpha;
        if (__all(pmax - m_reg <= THR_RAW)) { mn = m_reg; alpha = 1.f; }
        else { mn = fmaxf(m_reg, pmax); alpha = __builtin_amdgcn_exp2f((m_reg - mn) * CEXP); m_reg = mn; }
        const float mnC = -mn * CEXP;
        float ps = 0.f;
#pragma unroll
        for (int r = 0; r < 16; ++r) { p0[r] = __builtin_amdgcn_exp2f(fmaf(p0[r], CEXP, mnC)); ps += p0[r]; }
#pragma unroll
        for (int r = 0; r < 16; ++r) { p1[r] = __builtin_amdgcn_exp2f(fmaf(p1[r], CEXP, mnC)); ps += p1[r]; }
        ps = half_swap_sum(ps);
        l_reg = l_reg * alpha + ps;
        if (__any(alpha < 1.f)) { if (hi == 0) al_l[r32] = alpha; asm volatile("s_waitcnt lgkmcnt(0)" ::: "memory");
#pragma unroll
            for (int r = 0; r < 16; ++r) { const float a = al_l[crow(r, hi)];
#pragma unroll
                for (int d = 0; d < 4; ++d) o[d][r] *= a; } }
        pack_p(p0, p1, pa0, pa1, pa2, pa3);
        AT_SBAR();
        if (!roleB) pv_d0(o, vbase + so, pa0, pa1, pa2, pa3);
        if (j1 < 0) break;
        if (j2 >= 0) { AT_WAITV(4); } else { AT_WAITV(0); }
        AT_BAR();
        j = j1; j1 = j2; sp = so; so += SLOT; so = so >= NSLOT * SLOT ? so - NSLOT * SLOT : so; first = false;
    }
    if (roleB) { AT_SBAR(); pv_d0(o, vbase + so, pa0, pa1, pa2, pa3); }
    if (hi == 0) li_l[r32] = l_reg; asm volatile("s_waitcnt lgkmcnt(0)" ::: "memory");
#pragma unroll
    for (int r = 0; r < 16; ++r) { const int orow = crow(r, hi); const float l = li_l[orow]; const float rl = l > 0.f ? 1.f / l : 0.f;
#pragma unroll
        for (int d0 = 0; d0 < 4; ++d0) outw[(size_t)orow * ostride + d0 * 32 + r32] = (_Float16)(o[d0][r] * rl); }
    __syncthreads();
}

constexpr int LDS_AP = 0, LDS_BP = LDS_AP + 4 * 64 * 33 * 4, LDS_SELM = LDS_END, LDS_CS_END = LDS_SELM + 64 * 4;
static_assert(LDS_BP + 4 * 64 * 33 * 4 <= NSLOT * SLOT, "importance partials must fit inside the ring");
__device__ __forceinline__ void cmp_slc_unit(char* lds, const _Float16* qrow, const _Float16* Kc, const _Float16* Vc, const _Float16* Ks, const _Float16* Vs, int t, int tl, int g, int qi,
                                             _Float16* outc, _Float16* outs) {
    const int tid = threadIdx.x, wid = __builtin_amdgcn_readfirstlane(tid >> 6), lane = tid & 63, r32 = lane & 31, hi = lane >> 5;
    float* AP = (float*)(lds + LDS_AP); float* BP = (float*)(lds + LDS_BP); unsigned* selm = (unsigned*)(lds + LDS_SELM);
    {
        h8 qr[8];
#pragma unroll
        for (int d0 = 0; d0 < 8; ++d0) qr[d0] = *(const h8*)(qrow + d0 * 16);
        const int vb0 = (int)(uintptr_t)lds + SHM_K + v_rd_base(lane);
        { int ko[2], vo[2]; dma_offsets(256, ko, vo);
          dma_tile(lds, Kc, Vc, 256, 0, ko, vo, wid); dma_tile(lds + SLOT, Kc, Vc, 256, 1, ko, vo, wid); }
        AT_WAITV(0); AT_BAR();
        f32x16 pA0, pA1, pB0, pB1;
        AT_SBAR(); qkt(pA0, pA1, lds, qr, r32, hi); qkt(pB0, pB1, lds + SLOT, qr, r32, hi);
        const int khi = t >= 31 ? ((t - 31) >> 4) : -1;
#pragma unroll
        for (int r = 0; r < 16; ++r) { const int c0 = 4 * hi + (r & 3) + 8 * (r >> 2);
            pA0[r] = (c0 <= khi) ? pA0[r] : -INFINITY; pA1[r] = (c0 + 32 <= khi) ? pA1[r] : -INFINITY;
            pB0[r] = (c0 + 64 <= khi) ? pB0[r] : -INFINITY; pB1[r] = (c0 + 96 <= khi) ? pB1[r] : -INFINITY; }
        float pmax = -INFINITY;
#pragma unroll
        for (int r = 0; r < 16; ++r) pmax = fmaxf(fmaxf(pmax, pA0[r]), fmaxf(pA1[r], fmaxf(pB0[r], pB1[r])));
        pmax = half_swap_max(pmax);
        const float mC = (pmax == -INFINITY) ? 0.f : -pmax * CEXP;
        float ps = 0.f;
#pragma unroll
        for (int r = 0; r < 16; ++r) { pA0[r] = __builtin_amdgcn_exp2f(fmaf(pA0[r], CEXP, mC)); pA1[r] = __builtin_amdgcn_exp2f(fmaf(pA1[r], CEXP, mC));
            pB0[r] = __builtin_amdgcn_exp2f(fmaf(pB0[r], CEXP, mC)); pB1[r] = __builtin_amdgcn_exp2f(fmaf(pB1[r], CEXP, mC)); ps += (pA0[r] + pA1[r]) + (pB0[r] + pB1[r]); }
        ps = half_swap_sum(ps);
        const float inv = ps > 0.f ? 1.f / ps : 0.f;
#pragma unroll
        for (int r = 0; r < 16; ++r) { pA0[r] *= inv; pA1[r] *= inv; pB0[r] *= inv; pB1[r] *= inv; }
        f32x16 o[4] = {};
        h8 pa0, pa1, pa2, pa3;
        pack_p(pA0, pA1, pa0, pa1, pa2, pa3); AT_SBAR(); pv_d0(o, vb0, pa0, pa1, pa2, pa3);
        pack_p(pB0, pB1, pa0, pa1, pa2, pa3); AT_SBAR(); pv_d0(o, vb0 + SLOT, pa0, pa1, pa2, pa3);
#pragma unroll
        for (int r = 0; r < 16; ++r) { const int orow = crow(r, hi);
#pragma unroll
            for (int d0 = 0; d0 < 4; ++d0) outc[(size_t)orow * 1024 + d0 * 32 + r32] = (_Float16)o[d0][r]; }
        __syncthreads();
        { float* ap = AP + (g * 64 + tl) * 33; float* bp = BP + (g * 64 + tl) * 33;
          if (hi == 0) bp[0] = 0.f;
#define AT_IMP(P, JB) do { _Pragma("unroll") for (int k = 0; k < 4; ++k) { const int j = (JB) + 2 * k + hi; \
              ap[j] = 2.f * (P[4 * k] + P[4 * k + 1] + P[4 * k + 2]) + P[4 * k + 3]; if (j + 1 < 32) bp[j + 1] = P[4 * k + 3]; } } while (0)
          AT_IMP(pA0, 0); AT_IMP(pA1, 8); AT_IMP(pB0, 16); AT_IMP(pB1, 24);
#undef AT_IMP
        }
    }
    __syncthreads();
#pragma unroll 1
    for (int it = 0; it < 4; ++it) {
        const int tk = 8 * wid + 2 * it + hi, j = r32;
        float imp = 0.f;
#pragma unroll
        for (int gg = 0; gg < 4; ++gg) imp += AP[(gg * 64 + tk) * 33 + j] + BP[(gg * 64 + tk) * 33 + j];
        const bool forced = (j == 0) || (j == qi) || (j == qi - 1), valid = j <= qi;
        const float iv = forced ? 1e9f : (valid ? imp : -1e9f);
        int rank = 0;
        for (int i = 0; i < 32; ++i) { const float vi = __shfl(iv, i + 32 * hi); rank += (vi > iv || (vi == iv && i < j)) ? 1 : 0; }
        const unsigned long long bal = __ballot(rank < 16 && valid);
        if (r32 == 0) selm[tk] = (unsigned)(bal >> (32 * hi));
    }
    __syncthreads();
    unsigned tm = selm[lane];
#pragma unroll
    for (int o = 32; o > 0; o >>= 1) tm |= __shfl_xor(tm, o);
    const int tz2 = hidden_tid();
    const unsigned mysel = selm[((tz2 >> 6) & 1) * 32 + (tz2 & 31)];
    attn_unit(lds, qrow, Ks, Vs, 128, tm, 0, t, mysel, outs, 1024);
}
}

struct CUnit { const float* W; int ldw; int nvalid; _Float16* Wt; int k0; int n0; };
__device__ __forceinline__ CUnit conv_desc(int u, const float* win, const float* w1k, const float* w1v, const float* wmkv, _Float16* wtin, _Float16* wt1, _Float16* wtmkv) {
    CUnit d;
    if (u < 160) { d.W = win; d.ldw = INW; d.nvalid = INW; d.Wt = wtin; d.k0 = (u / 5) * 64; d.n0 = (u % 5) * 256; }
    else if (u < 288) { const int v = u - 160, kv = v >> 6, part = (v >> 5) & 1, kt = v & 31;
        d.W = (kv ? w1v : w1k) + (size_t)part * 2048 * 256; d.ldw = 256; d.nvalid = 256; d.Wt = wt1 + ((size_t)kv * 512 + part * 256) * 2048; d.k0 = kt * 64; d.n0 = 0; }
    else { d.W = wmkv; d.ldw = 1024; d.nvalid = 1024; d.Wt = wtmkv; d.k0 = 0; d.n0 = 0; }
    return d;
}
__device__ __forceinline__ void conv_all(float* lds, const float* win, const float* w1k, const float* w1v, const float* wmkv, _Float16* wtin, _Float16* wt1, _Float16* wtmkv, int bid, int nb) {
    constexpr int NU = 160 + 128;
    const int tid = threadIdx.x;
    int u = bid; if (u >= NU) return;
    CUnit d = conv_desc(u, win, w1k, w1v, wmkv, wtin, wt1, wtmkv);
    float4 v[8];
#define CL(D) do { _Pragma("unroll") for (int i = 0; i < 8; ++i) { const int idx = tid + 512 * i, r = idx >> 6, c4 = (idx & 63) * 4; \
        v[i] = ((D).n0 + c4 < (D).nvalid) ? *(const float4*)((D).W + (size_t)((D).k0 + r) * (D).ldw + (D).n0 + c4) : make_float4(0.f, 0.f, 0.f, 0.f); } } while (0)
    CL(d);
    for (;;) {
#pragma unroll
        for (int i = 0; i < 8; ++i) { const int idx = tid + 512 * i, r = idx >> 6, c4 = (idx & 63) * 4; float* dd = lds + r * 257 + c4; dd[0] = v[i].x; dd[1] = v[i].y; dd[2] = v[i].z; dd[3] = v[i].w; }
        __syncthreads();
        const int un = u + nb; const bool has = un < NU;
        CUnit dn = d; if (has) { dn = conv_desc(un, win, w1k, w1v, wmkv, wtin, wt1, wtmkv); CL(dn); }
#pragma unroll
        for (int j = 0; j < 4; ++j) { const int id = tid + 512 * j, n = id >> 3, k8 = (id & 7) * 8; h8 o;
#pragma unroll
            for (int q = 0; q < 8; ++q) o[q] = (_Float16)lds[(k8 + q) * 257 + n];
            *(h8*)(d.Wt + (size_t)(d.n0 + n) * 2048 + d.k0 + k8) = o; }
        __syncthreads();
        if (!has) break;
        u = un; d = dn;
    }
#undef CL
}

__device__ __forceinline__ unsigned pack4_i8(float a, float b, float c, float d) {
    const int ia = __float2int_rn(a), ib = __float2int_rn(b), ic = __float2int_rn(c), id = __float2int_rn(d);
    return (unsigned)(ia & 255) | ((unsigned)(ib & 255) << 8) | ((unsigned)(ic & 255) << 16) | ((unsigned)(id & 255) << 24);
}
constexpr int QP_LD2 = 1026;
struct QUnit { const float* W; int ldw; int n0; signed char* Q; float* sc; int nvalid; };
struct QExtra { const float* win; signed char* q8in; float* sin8; const float* wmkv; signed char* q8mkv; float* smkv; };
__device__ __forceinline__ QUnit quant_desc(int u, const float* wgu, const float* wdn, signed char* q8gu, signed char* q8dn, float* sgu, float* sdn, const float* wout, signed char* q8out, float* sout, const QExtra& x) {
    QUnit d; d.nvalid = 1 << 30;
    if (u >= NE * 192 + 64 + 73) { const int pn = u - (NE * 192 + 64 + 73); d.W = x.wmkv; d.ldw = 1024; d.n0 = pn * 32; d.Q = x.q8mkv; d.sc = x.smkv; }
    else if (u >= NE * 192 + 64) { const int pn = u - (NE * 192 + 64); d.W = x.win; d.ldw = INW; d.n0 = 1280 + pn * 32; d.Q = x.q8in - (size_t)1280 * 2048; d.sc = x.sin8 - 1280; d.nvalid = INW; }
    else if (u >= NE * 192) { const int pn = u - NE * 192; d.W = wout; d.ldw = 2048; d.n0 = pn * 32; d.Q = q8out; d.sc = sout; }
    else if (u < NE * 128) { const int e = u >> 7, pn = u & 127; d.W = wgu + (size_t)e * 2048 * 4096; d.ldw = 4096; d.n0 = pn * 32; d.Q = q8gu + (size_t)e * 4096 * 2048; d.sc = sgu + (size_t)e * 4096; }
    else { const int v = u - NE * 128, e = v >> 6, pn = v & 63; d.W = wdn + (size_t)e * 2048 * 2048; d.ldw = 2048; d.n0 = pn * 32; d.Q = q8dn + (size_t)e * 2048 * 2048; d.sc = sdn + (size_t)e * 2048; }
    return d;
}
__device__ __forceinline__ unsigned pk2h(float a, float b) { auto v = __builtin_amdgcn_cvt_pkrtz(a, b); return *reinterpret_cast<unsigned*>(&v); }
__device__ __forceinline__ void quant_all(char* smem, const float* wgu, const float* wdn, signed char* q8gu, signed char* q8dn, float* sgu, float* sdn, const float* wout, signed char* q8out, float* sout, const QExtra& qx, int bid, int nb) {
    constexpr int NU = NE * 128 + NE * 64 + 64 + 73 + 32;
    unsigned* cmaxb = (unsigned*)smem;
    const int tid = threadIdx.x, c4 = (tid & 7) * 4, rg = tid >> 3;
    if (tid < 64) cmaxb[tid] = 0u;
    __syncthreads();
    int u = bid; if (u >= NU) return;
    QUnit d = quant_desc(u, wgu, wdn, q8gu, q8dn, sgu, sdn, wout, q8out, sout, qx);
    float4 va[16], vb[16], vc[16];
#define QL(dst, D, half) do { const float* p0 = (D).W + (size_t)((half) * 1024 + rg * 16) * (D).ldw + (D).n0 + c4; const bool okc = (D).n0 + c4 < (D).nvalid; _Pragma("unroll") for (int j = 0; j < 16; ++j) dst[j] = okc ? *(const float4*)(p0 + (size_t)j * (D).ldw) : make_float4(0.f, 0.f, 0.f, 0.f); } while (0)
#define QM(src) do { _Pragma("unroll") for (int j = 0; j < 16; ++j) { m0 = fmaxf(m0, fabsf(src[j].x)); m1 = fmaxf(m1, fabsf(src[j].y)); m2 = fmaxf(m2, fabsf(src[j].z)); m3 = fmaxf(m3, fabsf(src[j].w)); } } while (0)
#define QS(src, half, comp, ci, inv) do { uint4 o; \
        o.x = pack4_i8(src[0].comp * inv, src[1].comp * inv, src[2].comp * inv, src[3].comp * inv); o.y = pack4_i8(src[4].comp * inv, src[5].comp * inv, src[6].comp * inv, src[7].comp * inv); \
        o.z = pack4_i8(src[8].comp * inv, src[9].comp * inv, src[10].comp * inv, src[11].comp * inv); o.w = pack4_i8(src[12].comp * inv, src[13].comp * inv, src[14].comp * inv, src[15].comp * inv); \
        *(uint4*)(d.Q + (size_t)(d.n0 + c4 + (ci)) * 2048 + (half) * 1024 + rg * 16) = o; } while (0)
    QL(va, d, 0);
    int par = 0;
    for (;;) {
        unsigned* cmax = cmaxb + par * 32;
        float m0 = 0.f, m1 = 0.f, m2 = 0.f, m3 = 0.f;
        QL(vb, d, 1);
        QM(va); QM(vb);
        atomicMax(&cmax[c4 + 0], __float_as_uint(m0)); atomicMax(&cmax[c4 + 1], __float_as_uint(m1)); atomicMax(&cmax[c4 + 2], __float_as_uint(m2)); atomicMax(&cmax[c4 + 3], __float_as_uint(m3));
        __syncthreads();
        const int un = u + nb; const bool has = un < NU;
        QUnit dn = d; if (has) { dn = quant_desc(un, wgu, wdn, q8gu, q8dn, sgu, sdn, wout, q8out, sout, qx); QL(vc, dn, 0); }
        if (tid < 32) cmaxb[(par ^ 1) * 32 + tid] = 0u;
        const float x0 = __uint_as_float(cmax[c4 + 0]), x1 = __uint_as_float(cmax[c4 + 1]), x2 = __uint_as_float(cmax[c4 + 2]), x3 = __uint_as_float(cmax[c4 + 3]);
        const float i0 = x0 > 0.f ? 127.f / x0 : 0.f, i1 = x1 > 0.f ? 127.f / x1 : 0.f, i2 = x2 > 0.f ? 127.f / x2 : 0.f, i3 = x3 > 0.f ? 127.f / x3 : 0.f;
        QS(va, 0, x, 0, i0); QS(va, 0, y, 1, i1); QS(va, 0, z, 2, i2); QS(va, 0, w, 3, i3);
        QS(vb, 1, x, 0, i0); QS(vb, 1, y, 1, i1); QS(vb, 1, z, 2, i2); QS(vb, 1, w, 3, i3);
        if (tid < 32) { const float mx = __uint_as_float(cmax[tid]); d.sc[d.n0 + tid] = mx > 0.f ? mx / 127.f : 1.f; }
        if (!has) break;
#pragma unroll
        for (int j = 0; j < 16; ++j) va[j] = vc[j];
        u = un; d = dn; par ^= 1;
        __syncthreads();
    }
    __syncthreads();
#undef QL
#undef QM
#undef QS
}

__global__ void __launch_bounds__(512, 2) fwd(Params p) {
    extern __shared__ __attribute__((aligned(16))) char smem[];
    const int tid = threadIdx.x, wv = __builtin_amdgcn_readfirstlane(tid >> 6);
#define LANE_NOW ({ int _t = threadIdx.x; asm volatile("" : "+v"(_t)); _t & 63; })
    const int bid = blockIdx.x, nb = gridDim.x;
    const int gw = bid * 8 + wv, nw = nb * 8;
    const int lo = (int)(p.lo_hi & 0xffffffffll), hi = (int)(p.lo_hi >> 32);
    unsigned char* ws = p.ws;
    unsigned* ctl = (unsigned*)(ws + WS_CTL);
    int* cnt = (int*)(ws + CTL_CNT);
    float* proj = (float*)(ws + WS_PROJ);
    float* kvmem = (float*)(ws + WS_KVMEM);
    float* bias1 = (float*)(ws + WS_BIAS1);
    float* hid = (float*)(ws + WS_HID);
    float* kc = (float*)(ws + WS_KC);
    float* vc = (float*)(ws + WS_VC);
    float* pooled = (float*)(ws + WS_POOLED);
    _Float16* opool = (_Float16*)(ws + WS_OPOOL);
    _Float16* owin = (_Float16*)(ws + WS_OWIN);
    _Float16* ocmp = (_Float16*)(ws + WS_OCMP);
    _Float16* oslc = (_Float16*)(ws + WS_OSLC);
    unsigned* sel = (unsigned*)(ws + WS_SEL);
    _Float16* omem = (_Float16*)(ws + WS_OMEM);
    _Float16* cat16 = (_Float16*)(ws + WS_CAT16);
    _Float16* hpre16 = (_Float16*)(ws + WS_HPRE);
    float* hbuf = (float*)(ws + WS_H);
    float* gate = (float*)(ws + WS_GATE);
    int* list = (int*)(ws + WS_LIST);
    unsigned char* actf8 = (unsigned char*)(ws + WS_ACT16);
    unsigned char* yf8 = (unsigned char*)(ws + WS_Y16);
    _Float16* h16 = (_Float16*)(ws + WS_H16);
    _Float16* x16 = (_Float16*)(ws + WS_X16);
    _Float16* wtin = (_Float16*)(ws + WS_WTIN);
    _Float16* wtout = (_Float16*)(ws + WS_WTOUT);
    _Float16* wtgu = (_Float16*)(ws + WS_WTGU);
    _Float16* wtdn = (_Float16*)(ws + WS_WTDN);
    LAS unsigned char* lds = (LAS unsigned char*)smem;
    _Float16* proj16 = (_Float16*)(ws + WS_PROJ16);
    _Float16* kvmem16 = (_Float16*)(ws + WS_KVMEM16);
    _Float16* wt1 = (_Float16*)(ws + WS_WT1);
    float* uv = (float*)(ws + WS_UV);
    _Float16* kc16 = (_Float16*)(ws + WS_KC16);
    _Float16* vc16 = (_Float16*)(ws + WS_VC16);
    _Float16* wr16 = (_Float16*)(ws + WS_WR16);
    _Float16* mem16 = (_Float16*)(ws + WS_MEM16);
    _Float16* wtmkv = (_Float16*)(ws + WS_WTMKV);
    _Float16* kv16 = (_Float16*)(ws + WS_KV16);
    _Float16* wt2 = (_Float16*)(ws + WS_WT2);
    signed char* x8 = (signed char*)(ws + WS_X8); float* sxa = (float*)(ws + WS_SXA); signed char* q8in = (signed char*)(ws + WS_Q8IN); float* sin8 = (float*)(ws + WS_SIN8);
    signed char* q8mkv = (signed char*)(ws + WS_Q8MKV); float* smkv = (float*)(ws + WS_SMKV);
    signed char* q8out = (signed char*)(ws + WS_Q8OUT); float* sout = (float*)(ws + WS_SOUT); signed char* cat8 = (signed char*)(ws + WS_CAT8); float* scat = (float*)(ws + WS_SCAT);
    signed char* q8gu = (signed char*)(ws + WS_Q8GU); signed char* q8dn = (signed char*)(ws + WS_Q8DN);
    float* sgu = (float*)(ws + WS_SGU); float* sdn = (float*)(ws + WS_SDN);
    signed char* h8q = (signed char*)(ws + WS_H8); float* sah = (float*)(ws + WS_SAH);
    signed char* act8 = (signed char*)(ws + WS_ACT8); float* sact = (float*)(ws + WS_SACT);
    const int vcu = (nb % 8 == 0) ? (bid % 8) * (nb / 8) + bid / 8 : bid;

    volatile LAS unsigned* xbw = (volatile LAS unsigned*)(smem + LDS_BYTES - 16);
    if (tid == 0) { xbw[0] = 0u; xbw[1] = 0u; xbw[2] = 0u; xbw[3] = 0u; }
    __syncthreads();
    XcdBarrier bar; bar.bar = ctl; bar.x = 0; bar.st = xbw;
    const bool multi = (hi - lo) > 1;
    if (multi) bar = xcd_barrier_post(ctl, xbw);
#define IN(k) (lo <= (k) && (k) < hi)
#define SEAM(k) do { if (IN(k) && IN((k) + 1)) xcd_barrier(bar); } while (0)
    float* sw = (float*)smem + wv * WLDS_FLOATS;
    int* segw = (int*)(sw + 4096 + 512);

    if (IN(0)) {
        const int lane = LANE_NOW; (void)lane;
        if (wv == 0 && (bid & 1) == 0 && (bid >> 1) < 128) {
            const int task = bid >> 1, kv = task >> 6, jg = (task >> 4) & 3, kc = task & 15;
            const float* pos = p.in[kv ? I_POSV : I_POSK] + kc * 256; const float* w1 = p.in[kv ? I_W1V : I_W1K] + (size_t)kc * 256 * 256 + jg * 64 + lane;
            float s0 = 0.f, s1 = 0.f, s2 = 0.f, s3 = 0.f;
            for (int k = 0; k < 256; k += 4) { s0 += pos[k] * w1[(size_t)k * 256]; s1 += pos[k + 1] * w1[(size_t)(k + 1) * 256]; s2 += pos[k + 2] * w1[(size_t)(k + 2) * 256]; s3 += pos[k + 3] * w1[(size_t)(k + 3) * 256]; }
            bias1[(kv * 16 + kc) * 256 + jg * 64 + lane] = (s0 + s1) + (s2 + s3);
        }
        for (int i = bid * 512 + tid; i < 2 * 128 * 256; i += nb * 512) { const int kv = i >> 15, d = (i >> 8) & 127, n = i & 255; wt2[i] = (_Float16)p.in[kv ? I_W2V : I_W2K][(size_t)n * 128 + d]; }
        for (int i = bid * 512 + tid; i < 32 * 2048; i += nb * 512) { const int e = i >> 11, d = i & 2047; wr16[i] = (_Float16)p.in[I_WR][(size_t)d * 32 + e]; }
        {
            for (int row0 = gw; row0 < T_ + 2048; row0 += nw * 2) {
                float4 raw[2][8];
#pragma unroll
                for (int i = 0; i < 2; ++i) { const int row = row0 + i * nw; const float* src = row < T_ ? p.in[I_X] + (size_t)row * 2048 : p.in[I_MEM] + (size_t)(row - T_) * 2048;
#pragma unroll
                    for (int c = 0; c < 4; ++c) { raw[i][2 * c] = make_float4(0.f, 0.f, 0.f, 0.f); raw[i][2 * c + 1] = raw[i][2 * c];
                        if (row < T_ + 2048) { raw[i][2 * c] = *(const float4*)(src + (lane + 64 * c) * 8); raw[i][2 * c + 1] = *(const float4*)(src + (lane + 64 * c) * 8 + 4); } } }
#pragma unroll
                for (int i = 0; i < 2; ++i) { const int row = row0 + i * nw;
                    float amax = 0.f;
#pragma unroll
                    for (int k = 0; k < 8; ++k) amax = fmaxf(amax, fmaxf(fmaxf(fabsf(raw[i][k].x), fabsf(raw[i][k].y)), fmaxf(fabsf(raw[i][k].z), fabsf(raw[i][k].w))));
                    amax = wave_max(amax);
                    if (row < T_ + 2048) {
                        const float qinv = amax > 0.f ? 127.f / amax : 0.f;
                        if (lane == 0) sxa[row] = amax > 0.f ? amax / 127.f : 1.f;
#pragma unroll
                        for (int c = 0; c < 4; ++c) { const float4 a = raw[i][2 * c], b2 = raw[i][2 * c + 1];
                            uint2 q; q.x = pack4_i8(a.x * qinv, a.y * qinv, a.z * qinv, a.w * qinv); q.y = pack4_i8(b2.x * qinv, b2.y * qinv, b2.z * qinv, b2.w * qinv);
                            *(uint2*)(x8 + (size_t)row * 2048 + (lane + 64 * c) * 8) = q;
                            if (row < T_) { h8 o; o[0] = (_Float16)a.x; o[1] = (_Float16)a.y; o[2] = (_Float16)a.z; o[3] = (_Float16)a.w; o[4] = (_Float16)b2.x; o[5] = (_Float16)b2.y; o[6] = (_Float16)b2.z; o[7] = (_Float16)b2.w;
                                *(h8*)(x16 + (size_t)row * 2048 + (lane + 64 * c) * 8) = o; } } }
                }
            }
        }
        {
            const QExtra qx{p.in[I_WIN], q8in, sin8, p.in[I_WMEMKV], q8mkv, smkv};
            quant_all(smem, p.in[I_WGU], p.in[I_WDN], q8gu, q8dn, sgu, sdn, p.in[I_WOUT], q8out, sout, qx, bid, nb);
            __syncthreads();
            conv_all((float*)smem, p.in[I_WIN], p.in[I_W1K], p.in[I_W1V], p.in[I_WMEMKV], wtin, wt1, wtmkv, bid, nb);
            __syncthreads();
        }
    }
    SEAM(0);
    if (IN(1)) {
        const int lane = LANE_NOW; (void)lane;
        { g8::ProbInF P{x16, proj16, nb, bid}; g8::gemm_phase(lds, P); }
        __syncthreads();
        { g8::ProbIn8 P{x8, proj16, sxa, nb, (bid + 192) & 255}; g8::gemm_phase(lds, P); }
    }
    SEAM(1);
    if (IN(2)) {
        const int lane = LANE_NOW; (void)lane;
        { g8::ProbCmp P{kv16, wt1, uv, nb, bid}; g8::gemm_phase(lds, P); __syncthreads(); }
        for (int i = bid * 512 + tid; i < T_ * 64; i += nb * 512) {
            const int chn = i & 63, row = i >> 6, t = row & (S_ - 1), g = chn >> 4;
            const int win = 2 << g, n = min(win, t + 1);
            const _Float16* src = proj16 + (size_t)row * INW + C_UP + chn * 8;
            float a[8];
            const h8 cur = *(const h8*)src;
            h8 vv[15];
#pragma unroll
            for (int k = 0; k < 15; ++k) { vv[k] = (h8){0, 0, 0, 0, 0, 0, 0, 0}; if (k + 1 < n) vv[k] = *(const h8*)(src - (size_t)(k + 1) * INW); }
#pragma unroll
            for (int q = 0; q < 8; ++q) a[q] = (float)cur[q];
#pragma unroll
            for (int k = 0; k < 15; ++k) {
#pragma unroll
                for (int q = 0; q < 8; ++q) a[q] += (float)vv[k][q]; }
            const float rn = 1.f / (float)n;
            float4 o0, o1;
            o0.x = a[0] * rn - (float)cur[0]; o0.y = a[1] * rn - (float)cur[1]; o0.z = a[2] * rn - (float)cur[2]; o0.w = a[3] * rn - (float)cur[3];
            o1.x = a[4] * rn - (float)cur[4]; o1.y = a[5] * rn - (float)cur[5]; o1.z = a[6] * rn - (float)cur[6]; o1.w = a[7] * rn - (float)cur[7];
            *(float4*)(pooled + (size_t)row * 512 + chn * 8) = o0; *(float4*)(pooled + (size_t)row * 512 + chn * 8 + 4) = o1;
        }
        {
            const int r32 = lane & 31, hi = lane >> 5, g = wv >> 1, half = wv & 1;
            for (int uu = vcu; uu < 512; uu += nb) {
                const int v = uu & 255, bk = v >> 4, qi = (uu >> 8) ? 31 - (v & 15) : (v & 15), b = bk >> 1, kvh = bk & 1;
                const int t = qi * 64 + half * 32 + r32;
                const int lo_t = max(0, qi - 8);
                const unsigned tmask = (unsigned)(((1ull << (qi + 1)) - 1ull) & ~((1ull << lo_t) - 1ull));
                at8::attn_unit(smem, proj16 + (size_t)(b * S_ + t) * INW + C_Q + (kvh * 4 + g) * 128 + hi * 8,
                               kv16 + ((size_t)(4 * B_ + b) * 2 + kvh) * KVSEG, kv16 + ((size_t)(5 * B_ + b) * 2 + kvh) * KVSEG, 128, tmask, 512, t, 0xffffffffu,
                               owin + (size_t)(b * S_ + qi * 64 + half * 32) * 1024 + (kvh * 4 + g) * 128, 1024);
            }
            for (int u = vcu; u < 256; u += nb) {
                const int b = u >> 5, h = (u >> 3) & 3, qt = u & 7;
                const int t = qt * 256 + wv * 32 + r32;
                at8::attn_unit(smem, proj16 + (size_t)(b * S_ + t) * INW + C_QM + h * 128 + hi * 8,
                               kvmem16 + (size_t)b * 256 * 1024 + h * 128, kvmem16 + (size_t)b * 256 * 1024 + 512 + h * 128, 1024, 0xFu, 0, 255, 0xffffffffu,
                               omem + (size_t)(b * S_ + qt * 256 + wv * 32) * 512 + h * 128, 512);
            }
        }
    }
    SEAM(2);
    if (IN(3)) {
        const int lane = LANE_NOW; (void)lane;
        {
            float* bsum = (float*)smem;
            _Float16* hs = (_Float16*)(smem + 4096);
            { const int kv = tid >> 8, n = tid & 255; float a = 0.f;
#pragma unroll
              for (int kc = 0; kc < 16; ++kc) a += bias1[(kv * 16 + kc) * 256 + n];
              bsum[tid] = a; }
            __syncthreads();
            const int fr = lane & 15, fq = lane >> 4;
            for (int u = bid; u < 256; u += nb) {
                const int kv = u >> 7, rt = u & 127;
#pragma unroll
                for (int q = 0; q < 8; ++q) { const int e = tid + 512 * q, i = e >> 8, n = e & 255;
                    const int row = rt * 16 + i, c = (row >> 1) & 127;
                    float a = 0.f;
                    if (c != 127) { a = bsum[kv * 256 + n];
#pragma unroll
                        for (int sp = 0; sp < 4; ++sp) { const float* base = uv + ((size_t)(kv * 4 + sp) * 2048) * 512; a += base[(size_t)row * 512 + n] + base[(size_t)(row + 2) * 512 + 256 + n]; }
                        a = gelu_fast(a); }
                    hs[i * 264 + n] = (_Float16)a; }
                __syncthreads();
                { const _Float16* bp = wt2 + ((size_t)kv * 128 + wv * 16 + fr) * 256 + fq * 8;
                  f4 acc = (f4){0.f, 0.f, 0.f, 0.f};
#pragma unroll
                  for (int sI = 0; sI < 8; ++sI) { const h8 a = *(const h8*)(hs + fr * 264 + sI * 32 + fq * 8), bb = *(const h8*)(bp + sI * 32); acc = __builtin_amdgcn_mfma_f32_16x16x32_f16(a, bb, acc, 0, 0, 0); }
                  _Float16* dst = kv ? vc16 : kc16;
#pragma unroll
                  for (int j = 0; j < 4; ++j) { const int row = rt * 16 + fq * 4 + j; dst[(size_t)row * 128 + wv * 16 + fr] = (((row >> 1) & 127) == 127) ? (_Float16)0.f : (_Float16)acc[j]; } }
                __syncthreads();
            }
        }
        for (int u = bid; u < 128 * 4; u += nb) { const int g = u >> 7, mt = u & 127;
            ARowPlain af{pooled + g * 128, 512, mt * 128, T_}; EpiPool ef{opool, p.in[I_POOLS], mt * 128, g};
            gemm_tile(smem, 128, af, p.in[I_POOLW] + (size_t)g * 128 * 128, 128, 0, 128, false, ef);
        }
    }
    SEAM(3);
    if (IN(4)) {
        const int lane = LANE_NOW; (void)lane;
        const int r32 = lane & 31, hi = lane >> 5, g = wv >> 1, half = wv & 1;
        for (int uu = vcu; uu < 512; uu += nb) {
            const int v = uu & 255, bk = v >> 4, qi = (uu >> 8) ? 31 - (v & 15) : (v & 15), b = bk >> 1, kvh = bk & 1;
            const int tl = half * 32 + r32, t = qi * 64 + tl;
            at8::cmp_slc_unit(smem, proj16 + (size_t)(b * S_ + t) * INW + C_Q + (kvh * 4 + g) * 128 + hi * 8,
                              kc16 + (size_t)(b * 128 * 2 + kvh) * 128, vc16 + (size_t)(b * 128 * 2 + kvh) * 128,
                              kv16 + ((size_t)(2 * B_ + b) * 2 + kvh) * KVSEG, kv16 + ((size_t)(3 * B_ + b) * 2 + kvh) * KVSEG, t, tl, g, qi,
                              ocmp + (size_t)(b * S_ + qi * 64 + half * 32) * 1024 + (kvh * 4 + g) * 128, oslc + (size_t)(b * S_ + qi * 64 + half * 32) * 1024 + (kvh * 4 + g) * 128);
        }
    }
    SEAM(4);
    if (IN(5)) {
        const int lane = LANE_NOW;
        for (int row = gw; row < T_; row += nw) {
            const _Float16* pr = proj16 + (size_t)row * INW + C_G;
            float v[32]; float ss = 0.f;
#pragma unroll
            for (int c = 0; c < 2; ++c) { const int col = (lane + 64 * c) * 8, h = col >> 7; const size_t o = (size_t)row * 1024 + col;
                const float g0 = sigmoidf_((float)pr[h * 3]), g1 = sigmoidf_((float)pr[h * 3 + 1]), g2 = sigmoidf_((float)pr[h * 3 + 2]);
                const h8 a = *(const h8*)(ocmp + o), b2 = *(const h8*)(oslc + o), c2 = *(const h8*)(owin + o);
#pragma unroll
                for (int q = 0; q < 8; ++q) { const float x = g0 * (float)a[q] + g1 * (float)b2[q] + g2 * (float)c2[q]; v[c * 8 + q] = x; ss += x * x; } }
            ss = wave_sum(ss); float r = rsqrtf(ss / 1024.f + LN_EPS);
#pragma unroll
            for (int c = 0; c < 2; ++c) { const int col = (lane + 64 * c) * 8; const float4 ga = *(const float4*)(p.in[I_GNNSA] + col), gb = *(const float4*)(p.in[I_GNNSA] + col + 4);
                v[c * 8 + 0] *= r * ga.x; v[c * 8 + 1] *= r * ga.y; v[c * 8 + 2] *= r * ga.z; v[c * 8 + 3] *= r * ga.w; v[c * 8 + 4] *= r * gb.x; v[c * 8 + 5] *= r * gb.y; v[c * 8 + 6] *= r * gb.z; v[c * 8 + 7] *= r * gb.w; }
            { const h8 a = *(const h8*)(opool + (size_t)row * 512 + lane * 8); ss = 0.f;
#pragma unroll
              for (int q = 0; q < 8; ++q) { v[16 + q] = (float)a[q]; ss += v[16 + q] * v[16 + q]; }
              ss = wave_sum(ss); r = rsqrtf(ss / 512.f + LN_EPS);
              const float4 ga = *(const float4*)(p.in[I_GNPOOL] + lane * 8), gb = *(const float4*)(p.in[I_GNPOOL] + lane * 8 + 4);
              v[16] *= r * ga.x; v[17] *= r * ga.y; v[18] *= r * ga.z; v[19] *= r * ga.w; v[20] *= r * gb.x; v[21] *= r * gb.y; v[22] *= r * gb.z; v[23] *= r * gb.w; }
            { const h8 a = *(const h8*)(omem + (size_t)row * 512 + lane * 8); ss = 0.f;
#pragma unroll
              for (int q = 0; q < 8; ++q) { v[24 + q] = (float)a[q]; ss += v[24 + q] * v[24 + q]; }
              ss = wave_sum(ss); r = rsqrtf(ss / 512.f + LN_EPS);
              const float4 ga = *(const float4*)(p.in[I_GNMEM] + lane * 8), gb = *(const float4*)(p.in[I_GNMEM] + lane * 8 + 4);
              v[24] *= r * ga.x; v[25] *= r * ga.y; v[26] *= r * ga.z; v[27] *= r * ga.w; v[28] *= r * gb.x; v[29] *= r * gb.y; v[30] *= r * gb.z; v[31] *= r * gb.w; }
            float amax = 0.f;
#pragma unroll
            for (int k = 0; k < 32; ++k) amax = fmaxf(amax, fabsf(v[k]));
            amax = wave_max(amax);
            const float qinv = amax > 0.f ? 127.f / amax : 0.f;
            if (lane == 0) scat[row] = amax > 0.f ? amax / 127.f : 1.f;
#pragma unroll
            for (int c = 0; c < 4; ++c) { const int col = c < 2 ? (lane + 64 * c) * 8 : (c == 2 ? 1024 + lane * 8 : 1536 + lane * 8);
                uint2 q; q.x = pack4_i8(v[c * 8 + 0] * qinv, v[c * 8 + 1] * qinv, v[c * 8 + 2] * qinv, v[c * 8 + 3] * qinv); q.y = pack4_i8(v[c * 8 + 4] * qinv, v[c * 8 + 5] * qinv, v[c * 8 + 6] * qinv, v[c * 8 + 7] * qinv);
                *(uint2*)(cat8 + (size_t)row * 2048 + col) = q; }
        }
    }
    SEAM(5);
    if (IN(6)) {
        const int lane = LANE_NOW; (void)lane;
        g8::ProbOut P{cat8, q8out, hpre16, x16, scat, sout, nb, bid};
        g8::gemm_phase(lds, P);
    }
    SEAM(6);
    if (IN(7)) {
        const int lane = LANE_NOW; (void)lane;
        float* lg = (float*)smem;
        const int r32 = lane & 31, hi = lane >> 5, fr = lane & 15, fq = lane >> 4;
        for (int u = bid; u < T_ / 64; u += nb) {
            const int base = u * 64;
            h8 raw[8][4];
#pragma unroll
            for (int i = 0; i < 8; ++i)
#pragma unroll
                for (int c = 0; c < 4; ++c) raw[i][c] = *(const h8*)(hpre16 + (size_t)(base + wv * 8 + i) * 2048 + (lane + 64 * c) * 8);
#pragma unroll
            for (int i = 0; i < 8; ++i) {
                const int row = base + wv * 8 + i;
                float v[32]; float s = 0.f;
#pragma unroll
                for (int c = 0; c < 4; ++c) {
#pragma unroll
                    for (int q = 0; q < 8; ++q) { v[c * 8 + q] = (float)raw[i][c][q]; s += v[c * 8 + q]; } }
                const float mu = wave_sum(s) / 2048.f; float q2 = 0.f;
#pragma unroll
                for (int k = 0; k < 32; ++k) { const float d = v[k] - mu; q2 += d * d; }
                const float rs = rsqrtf(wave_sum(q2) / 2048.f + LN_EPS);
                float amax = 0.f;
#pragma unroll
                for (int c = 0; c < 4; ++c) { const int col = (lane + 64 * c) * 8;
                    const float4 g0 = *(const float4*)(p.in[I_LN1G] + col), g1 = *(const float4*)(p.in[I_LN1G] + col + 4), b0 = *(const float4*)(p.in[I_LN1B] + col), b1 = *(const float4*)(p.in[I_LN1B] + col + 4);
                    float4 o0, o1;
                    o0.x = (v[c * 8 + 0] - mu) * rs * g0.x + b0.x; o0.y = (v[c * 8 + 1] - mu) * rs * g0.y + b0.y; o0.z = (v[c * 8 + 2] - mu) * rs * g0.z + b0.z; o0.w = (v[c * 8 + 3] - mu) * rs * g0.w + b0.w;
                    o1.x = (v[c * 8 + 4] - mu) * rs * g1.x + b1.x; o1.y = (v[c * 8 + 5] - mu) * rs * g1.y + b1.y; o1.z = (v[c * 8 + 6] - mu) * rs * g1.z + b1.z; o1.w = (v[c * 8 + 7] - mu) * rs * g1.w + b1.w;
                    h8 oh; oh[0] = (_Float16)o0.x; oh[1] = (_Float16)o0.y; oh[2] = (_Float16)o0.z; oh[3] = (_Float16)o0.w; oh[4] = (_Float16)o1.x; oh[5] = (_Float16)o1.y; oh[6] = (_Float16)o1.z; oh[7] = (_Float16)o1.w;
                    *(h8*)(h16 + (size_t)row * 2048 + col) = oh;
                    v[c * 8 + 0] = o0.x; v[c * 8 + 1] = o0.y; v[c * 8 + 2] = o0.z; v[c * 8 + 3] = o0.w; v[c * 8 + 4] = o1.x; v[c * 8 + 5] = o1.y; v[c * 8 + 6] = o1.z; v[c * 8 + 7] = o1.w;
                    amax = fmaxf(amax, fmaxf(fmaxf(fmaxf(fabsf(o0.x), fabsf(o0.y)), fmaxf(fabsf(o0.z), fabsf(o0.w))), fmaxf(fmaxf(fabsf(o1.x), fabsf(o1.y)), fmaxf(fabsf(o1.z), fabsf(o1.w))))); }
                amax = wave_max(amax);
                const float qinv = amax > 0.f ? 127.f / amax : 0.f;
                if (lane == 0) sah[row] = amax > 0.f ? amax / 127.f : 1.f;
#pragma unroll
                for (int c = 0; c < 4; ++c) { const int col = (lane + 64 * c) * 8;
                    uint2 q; q.x = pack4_i8(v[c * 8 + 0] * qinv, v[c * 8 + 1] * qinv, v[c * 8 + 2] * qinv, v[c * 8 + 3] * qinv); q.y = pack4_i8(v[c * 8 + 4] * qinv, v[c * 8 + 5] * qinv, v[c * 8 + 6] * qinv, v[c * 8 + 7] * qinv);
                    *(uint2*)(h8q + (size_t)row * 2048 + col) = q; }
            }
            asm volatile("s_waitcnt vmcnt(0)" ::: "memory");
            __syncthreads();
            {
                const int tok0 = base + 16 * (wv >> 1), e0 = 16 * (wv & 1);
                const _Float16* ap = h16 + (size_t)(tok0 + fr) * 2048 + fq * 8; const _Float16* bp = wr16 + (size_t)(e0 + fr) * 2048 + fq * 8;
                f4 acc = (f4){0.f, 0.f, 0.f, 0.f};
#pragma unroll 8
                for (int sI = 0; sI < 64; ++sI) { const h8 a = *(const h8*)(ap + sI * 32), bb = *(const h8*)(bp + sI * 32); acc = __builtin_amdgcn_mfma_f32_16x16x32_f16(a, bb, acc, 0, 0, 0); }
                const float br = p.in[I_BR][e0 + fr];
#pragma unroll
                for (int j = 0; j < 4; ++j) lg[(16 * (wv >> 1) + 4 * fq + j) * 33 + e0 + fr] = acc[j] + br;
            }
            __syncthreads();
#pragma unroll 1
            for (int it = 0; it < 4; ++it) {
                const int tk = 8 * wv + 2 * it + hi;
                const float iv = lg[tk * 33 + r32];
                int rank = 0;
                for (int i = 0; i < 32; ++i) { const float vi = __shfl(iv, i + 32 * hi); rank += (vi > iv || (vi == iv && i < r32)) ? 1 : 0; }
                float tv[4]; int te[4];
#pragma unroll
                for (int r = 0; r < 4; ++r) { const unsigned long long bm = __ballot(rank == r); const unsigned hm = (unsigned)(bm >> (32 * hi)); const int src = __ffs(hm) - 1; te[r] = src; tv[r] = __shfl(iv, src + 32 * hi); }
                const float e0v = 1.f, e1v = expf(tv[1] - tv[0]), e2v = expf(tv[2] - tv[0]), e3v = expf(tv[3] - tv[0]); const float inv = 1.f / (e0v + e1v + e2v + e3v);
                if (r32 < 4) { const int e = r32 == 0 ? te[0] : r32 == 1 ? te[1] : r32 == 2 ? te[2] : te[3]; const float g = (r32 == 0 ? e0v : r32 == 1 ? e1v : r32 == 2 ? e2v : e3v) * inv;
                    const int a = (base + tk) * 4 + r32; const int pos = atomicAdd(&cnt[e], 1); list[(size_t)e * T_ + pos] = a; gate[a] = g; }
            }
            __syncthreads();
        }
    }
    SEAM(7);
    LAS int* mtab = (LAS int*)(smem + g8::STAGE_BYTES);
    if (IN(8)) {
        const int lane = LANE_NOW; (void)lane;
        if (tid == 0) { int ub = 0, rs = 0;
            for (int e = 0; e < NE; ++e) { const int c = (int)__hip_atomic_load((unsigned*)&cnt[e], __ATOMIC_RELAXED, __HIP_MEMORY_SCOPE_AGENT); mtab[e] = c; mtab[32 + e] = ub; mtab[65 + e] = rs; ub += ((c + 255) >> 8) * 16; rs += c; }
            mtab[64] = ub; mtab[97] = rs; mtab[98] = ub; }
        __syncthreads();
        g8::moe_build(mtab, nb, vcu);
        __syncthreads();
        g8::ProbGu P{h8q, q8gu, actf8, p.in[I_BGU], list, sah, sgu, g8::MoeTab{mtab, 16}, nb, vcu};
        g8::gemm_phase(lds, P);
        __syncthreads();
    }
    SEAM(8);
    if (IN(9)) {
        const int lane = LANE_NOW;
        for (int row0 = gw; row0 < NA; row0 += nw * 8) {
            uint2 raw[8][4];
#pragma unroll
            for (int i = 0; i < 8; ++i)
#pragma unroll
                for (int c = 0; c < 4; ++c) raw[i][c] = *(const uint2*)(actf8 + (size_t)(row0 + i * nw) * 2048 + (lane + 64 * c) * 8);
#pragma unroll
            for (int i = 0; i < 8; ++i) { const int row = row0 + i * nw;
                float v[32]; float amax = 0.f;
#pragma unroll
                for (int c = 0; c < 4; ++c) { const uint2 a = raw[i][c];
                    dec4_fp8(a.x, v[c * 8 + 0], v[c * 8 + 1], v[c * 8 + 2], v[c * 8 + 3]); dec4_fp8(a.y, v[c * 8 + 4], v[c * 8 + 5], v[c * 8 + 6], v[c * 8 + 7]);
#pragma unroll
                    for (int q = 0; q < 8; ++q) amax = fmaxf(amax, fabsf(v[c * 8 + q])); }
                amax = wave_max(amax);
                const float qinv = amax > 0.f ? 127.f / amax : 0.f;
                if (lane == 0) sact[row] = amax > 0.f ? amax / 127.f : 1.f;
#pragma unroll
                for (int c = 0; c < 4; ++c) { uint2 q; q.x = pack4_i8(v[c * 8 + 0] * qinv, v[c * 8 + 1] * qinv, v[c * 8 + 2] * qinv, v[c * 8 + 3] * qinv); q.y = pack4_i8(v[c * 8 + 4] * qinv, v[c * 8 + 5] * qinv, v[c * 8 + 6] * qinv, v[c * 8 + 7] * qinv);
                    *(uint2*)(act8 + (size_t)row * 2048 + (lane + 64 * c) * 8) = q; }
            }
        }
    }
    SEAM(9);
    if (IN(10)) {
        const int lane = LANE_NOW; (void)lane;
        if (tid == 0) { int ub = 0, rs = 0;
            for (int e = 0; e < NE; ++e) { const int c = (int)__hip_atomic_load((unsigned*)&cnt[e], __ATOMIC_RELAXED, __HIP_MEMORY_SCOPE_AGENT); mtab[e] = c; mtab[32 + e] = ub; mtab[65 + e] = rs; ub += ((c + 255) >> 8) * 8; rs += c; }
            mtab[64] = ub; mtab[97] = rs; mtab[98] = ub; }
        __syncthreads();
        g8::moe_build(mtab, nb, vcu);
        __syncthreads();
        g8::ProbDn P{act8, q8dn, yf8, p.in[I_BDN], list, gate, sact, sdn, g8::MoeTab{mtab, 8}, nb, vcu};
        g8::gemm_phase(lds, P);
        __syncthreads();
    }
    SEAM(10);
    if (IN(11)) {
        const int lane = LANE_NOW; (void)lane;
        for (int row0 = gw; row0 < T_; row0 += nw * 2) {
          h8 hraw[2][4]; uint2 yraw[2][4][4];
#pragma unroll
          for (int i = 0; i < 2; ++i)
#pragma unroll
            for (int c = 0; c < 4; ++c) { const int col = (lane + 64 * c) * 8; const size_t yo = (size_t)(row0 + i * nw) * 4 * 2048 + col;
                hraw[i][c] = *(const h8*)(h16 + (size_t)(row0 + i * nw) * 2048 + col);
                yraw[i][c][0] = *(const uint2*)(yf8 + yo); yraw[i][c][1] = *(const uint2*)(yf8 + yo + 2048); yraw[i][c][2] = *(const uint2*)(yf8 + yo + 4096); yraw[i][c][3] = *(const uint2*)(yf8 + yo + 6144); }
#pragma unroll
          for (int i = 0; i < 2; ++i) { const int row = row0 + i * nw;
            float v[32]; float s = 0.f;
#pragma unroll
            for (int c = 0; c < 4; ++c) {
                const h8 hh8 = hraw[i][c];
                const uint2 y0 = yraw[i][c][0], y1 = yraw[i][c][1], y2 = yraw[i][c][2], y3 = yraw[i][c][3];
                float ys[8], t0[8], t1[8], t2[8], t3[8];
                dec4_fp8(y0.x, t0[0], t0[1], t0[2], t0[3]); dec4_fp8(y0.y, t0[4], t0[5], t0[6], t0[7]); dec4_fp8(y1.x, t1[0], t1[1], t1[2], t1[3]); dec4_fp8(y1.y, t1[4], t1[5], t1[6], t1[7]);
                dec4_fp8(y2.x, t2[0], t2[1], t2[2], t2[3]); dec4_fp8(y2.y, t2[4], t2[5], t2[6], t2[7]); dec4_fp8(y3.x, t3[0], t3[1], t3[2], t3[3]); dec4_fp8(y3.y, t3[4], t3[5], t3[6], t3[7]);
#pragma unroll
                for (int q = 0; q < 8; ++q) ys[q] = (t0[q] + t1[q]) + (t2[q] + t3[q]);
#pragma unroll
                for (int q = 0; q < 8; ++q) { v[c * 8 + q] = DN_ALPHA * (float)hh8[q] + ys[q] * 0.0625f; s += v[c * 8 + q]; } }
            const float mu = wave_sum(s) / 2048.f; float q2 = 0.f;
#pragma unroll
            for (int i = 0; i < 32; ++i) { const float d = v[i] - mu; q2 += d * d; }
            const float rs = rsqrtf(wave_sum(q2) / 2048.f + LN_EPS);
#pragma unroll
            for (int c = 0; c < 4; ++c) { const int col = (lane + 64 * c) * 8;
                const float4 ga = *(const float4*)(p.in[I_LN2G] + col), gb = *(const float4*)(p.in[I_LN2G] + col + 4), ba = *(const float4*)(p.in[I_LN2B] + col), bb = *(const float4*)(p.in[I_LN2B] + col + 4);
                float4 o0, o1;
                o0.x = (v[c * 8 + 0] - mu) * rs * ga.x + ba.x; o0.y = (v[c * 8 + 1] - mu) * rs * ga.y + ba.y; o0.z = (v[c * 8 + 2] - mu) * rs * ga.z + ba.z; o0.w = (v[c * 8 + 3] - mu) * rs * ga.w + ba.w;
                o1.x = (v[c * 8 + 4] - mu) * rs * gb.x + bb.x; o1.y = (v[c * 8 + 5] - mu) * rs * gb.y + bb.y; o1.z = (v[c * 8 + 6] - mu) * rs * gb.z + bb.z; o1.w = (v[c * 8 + 7] - mu) * rs * gb.w + bb.w;
                *(float4*)(p.out + (size_t)row * 2048 + col) = o0; *(float4*)(p.out + (size_t)row * 2048 + col + 4) = o1; }
          }
        }
    }
}

constexpr int NPHASE = 12;

extern "C" void kernel_launch(void* const* d_in, const int* in_sizes, int n_in, void* d_out, int out_size, void* d_ws, size_t ws_size, hipStream_t stream) {
    static int grid = 0;
    if (grid == 0) {
        if (n_in != 26 || ws_size < WS_END) { fprintf(stderr, "kernel_launch: unexpected n_in %d or ws_size %zu (< %zu)\n", n_in, ws_size, (size_t)WS_END); grid = -1; return; }
        int dev = 0, cus = 0, per_cu = 0;
        hipGetDevice(&dev); hipDeviceGetAttribute(&cus, hipDeviceAttributeMultiprocessorCount, dev);
        if (hipFuncSetAttribute((const void*)fwd, hipFuncAttributeMaxDynamicSharedMemorySize, LDS_BYTES) != hipSuccess) { fprintf(stderr, "hipFuncSetAttribute failed\n"); grid = -1; return; }
        hipOccupancyMaxActiveBlocksPerMultiprocessor(&per_cu, (const void*)fwd, 512, LDS_BYTES);
        (void)hipGetLastError();
        if (per_cu < 1) fprintf(stderr, "occupancy query says %d blocks per CU\n", per_cu);
        grid = cus > 0 ? cus : 256;
    }
    if (grid < 0) return;
    hipMemsetAsync((char*)d_ws + WS_CTL, 0, CTL_BYTES, stream);
    Params p{};
    for (int i = 0; i < 26; ++i) p.in[i] = (const float*)d_in[i];
    p.out = (float*)d_out; p.ws = (unsigned char*)d_ws;
#if N_LAUNCH_MODE == 1
    p.lo_hi = (long long)0 | ((long long)NPHASE << 32);
    hipLaunchKernelGGL(fwd, dim3(grid), dim3(512), LDS_BYTES, stream, p);
#else
    for (int ph = 0; ph < NPHASE; ++ph) {
        p.lo_hi = (long long)ph | ((long long)(ph + 1) << 32);
        hipLaunchKernelGGL(fwd, dim3(grid), dim3(512), LDS_BYTES, stream, p);
    }
#endif
}
```

```cpp
#include <hip/hip_runtime.h>
#include <cstdio>
#include <cstdint>

#ifndef N_LAUNCH_MODE
#define N_LAUNCH_MODE 1
#endif

constexpr int B_ = 8, S_ = 2048, D_ = 2048, T_ = B_ * S_;
constexpr int INW = 3608;
constexpr int C_Q = 0, C_KC = 1024, C_VC = 1280, C_KS = 1536, C_VS = 1792, C_KW = 2048, C_VW = 2304, C_G = 2560, C_UP = 2584, C_QM = 3096;
constexpr int NC = 127;
constexpr int CROWS = B_ * NC * 2;
constexpr int NE = 32, DE = 2048, NA = T_ * 4;
constexpr float LN_EPS = 1e-5f;
constexpr float DN_ALPHA = 1.189207115002721f;
constexpr float ATT_SCALE = 0.08838834764831845f;

constexpr size_t al256(size_t x) { return (x + 255) & ~(size_t)255; }
constexpr size_t WS_CTL = 0;
constexpr size_t CTL_BYTES = 65536;
constexpr size_t CTL_CNT = 16384;
constexpr size_t WS_PROJ = CTL_BYTES;
constexpr size_t WS_KVMEM = WS_PROJ + al256((size_t)T_ * INW * 4);
constexpr size_t WS_BIAS1 = WS_KVMEM + al256((size_t)2048 * 1024 * 4);
constexpr size_t WS_HID = WS_BIAS1 + al256(2 * 16 * 256 * 4);
constexpr size_t WS_KC = WS_HID + al256((size_t)2 * 2048 * 256 * 4);
constexpr size_t WS_VC = WS_KC + al256((size_t)CROWS * 128 * 4);
constexpr size_t WS_POOLED = WS_VC + al256((size_t)CROWS * 128 * 4);
constexpr size_t WS_OPOOL = WS_POOLED + al256((size_t)T_ * 512 * 4);
constexpr size_t WS_OWIN = WS_OPOOL + al256((size_t)T_ * 512 * 4);
constexpr size_t WS_OCMP = WS_OWIN + al256((size_t)T_ * 1024 * 4);
constexpr size_t WS_OSLC = WS_OCMP + al256((size_t)T_ * 1024 * 4);
constexpr size_t WS_SEL = WS_OSLC + al256((size_t)T_ * 1024 * 4);
constexpr size_t WS_OMEM = WS_SEL + al256((size_t)T_ * 2 * 4);
constexpr size_t WS_CAT16 = WS_OMEM + al256((size_t)T_ * 512 * 4);
constexpr size_t WS_HPRE = WS_CAT16 + al256((size_t)T_ * 2048 * 2);
constexpr size_t WS_H = WS_HPRE + al256((size_t)T_ * 2048 * 4);
constexpr size_t WS_H16 = WS_H + al256((size_t)T_ * 2048 * 4);
constexpr size_t WS_GATE = WS_H16 + al256((size_t)T_ * 2048 * 2);
constexpr size_t WS_LIST = WS_GATE + al256((size_t)NA * 4);
constexpr size_t WS_ACT16 = WS_LIST + al256((size_t)NE * T_ * 4);
constexpr size_t WS_Y16 = WS_ACT16 + al256((size_t)(NA + 256) * 2048 * 2);
constexpr size_t WS_X16 = WS_Y16 + al256((size_t)NA * 2048 * 2);
constexpr size_t WS_MEM16 = WS_X16 + (size_t)T_ * 2048 * 2;
constexpr size_t WS_WTIN = WS_MEM16 + al256((size_t)2048 * 2048 * 2);
constexpr size_t WS_WTOUT = WS_WTIN + al256((size_t)3840 * 2048 * 2);
constexpr size_t WS_WTGU = WS_WTOUT + al256((size_t)2048 * 2048 * 2);
constexpr size_t WS_WTDN = WS_WTGU + al256((size_t)NE * 4096 * 2048 * 2);
constexpr size_t WS_PROJ16 = WS_WTDN + al256((size_t)NE * 2048 * 2048 * 2);
constexpr size_t WS_KVMEM16 = WS_PROJ16 + al256((size_t)(T_ + 64) * INW * 2);
constexpr size_t WS_WT1 = WS_KVMEM16 + al256((size_t)2048 * 1024 * 2);
constexpr size_t WS_UV = WS_WT1 + al256((size_t)2 * 512 * 2048 * 2);
constexpr size_t WS_KC16 = WS_UV + al256((size_t)2 * 4 * 2048 * 512 * 4);
constexpr size_t WS_VC16 = WS_KC16 + al256((size_t)B_ * 128 * 256 * 2);
constexpr size_t WS_WR16 = WS_VC16 + al256((size_t)B_ * 128 * 256 * 2);
constexpr size_t WS_Q8GU = WS_WR16 + al256((size_t)32 * 2048 * 2);
constexpr size_t WS_Q8DN = WS_Q8GU + al256((size_t)NE * 4096 * 2048);
constexpr size_t WS_SGU = WS_Q8DN + al256((size_t)NE * 2048 * 2048);
constexpr size_t WS_SDN = WS_SGU + al256((size_t)NE * 4096 * 4);
constexpr size_t WS_H8 = WS_SDN + al256((size_t)NE * 2048 * 4);
constexpr size_t WS_SAH = WS_H8 + al256((size_t)T_ * 2048);
constexpr size_t WS_ACT8 = WS_SAH + al256((size_t)T_ * 4);
constexpr size_t WS_SACT = WS_ACT8 + al256((size_t)(NA + 256) * 2048);
constexpr size_t WS_WTMKV = WS_SACT + al256((size_t)(NA + 256) * 4);
constexpr size_t WS_Q8OUT = WS_WTMKV + al256((size_t)1024 * 2048 * 2);
constexpr size_t WS_SOUT = WS_Q8OUT + al256((size_t)2048 * 2048);
constexpr size_t WS_CAT8 = WS_SOUT + al256(2048 * 4);
constexpr size_t WS_SCAT = WS_CAT8 + al256((size_t)T_ * 2048);
constexpr size_t WS_X8 = WS_SCAT + al256((size_t)T_ * 4);
constexpr size_t WS_SXA = WS_X8 + al256((size_t)(T_ + 2048) * 2048);
constexpr size_t WS_Q8IN = WS_SXA + al256((size_t)(T_ + 2048) * 4);
constexpr size_t WS_SIN8 = WS_Q8IN + al256((size_t)2560 * 2048);
constexpr size_t WS_Q8MKV = WS_SIN8 + al256(2560 * 4);
constexpr size_t WS_SMKV = WS_Q8MKV + al256((size_t)1024 * 2048);
constexpr size_t WS_WT2 = WS_SMKV + al256(1024 * 4);
constexpr size_t WS_KV16 = WS_WT2 + al256((size_t)2 * 128 * 256 * 2);
constexpr size_t KVSEG = (size_t)S_ * 128;
constexpr size_t WS_END = WS_KV16 + al256((size_t)6 * B_ * 2 * S_ * 128 * 2);

constexpr int LDS_BYTES = 155648;

struct Params {
    const float* in[26];
    float* out;
    unsigned char* ws;
    long long lo_hi;
};
enum { I_X = 0, I_MEM, I_WIN, I_POSK, I_W1K, I_W2K, I_POSV, I_W1V, I_W2V, I_POOLW, I_POOLS, I_WMEMKV, I_GNNSA, I_GNPOOL, I_GNMEM, I_WOUT,
       I_LN1G, I_LN1B, I_WR, I_BR, I_WGU, I_BGU, I_WDN, I_BDN, I_LN2G, I_LN2B };

#define XB_TMO      128
#define XB_XCNT(j)  (256  + 64 * (j))
#define XB_XSUB(j)  (1280 + 64 * (j))
#define XB_XGEN(j)  (2304 + 64 * (j))
#define XB_TOP      3328
#define XB_TOPGEN   3392
#define XCD_BAR_WORDS 3456
#define XB_SPIN_CAP (1u << 25)
#define LAS __attribute__((address_space(3)))

__device__ __forceinline__ unsigned xb_ld(unsigned* p)              { return __hip_atomic_load(p, __ATOMIC_RELAXED, __HIP_MEMORY_SCOPE_AGENT); }
__device__ __forceinline__ unsigned xb_add(unsigned* p, unsigned v) { return __hip_atomic_fetch_add(p, v, __ATOMIC_RELAXED, __HIP_MEMORY_SCOPE_AGENT); }
__device__ __forceinline__ unsigned xb_xcc_id() { return (unsigned)__builtin_amdgcn_s_getreg((3 << 11) | 20) & 0xFu; }
#define XB_SPIN(cond, bar) do { unsigned _sp = 0; while (cond) { __builtin_amdgcn_s_sleep(1); \
    if ((++_sp & 255u) == 0u) { if (xb_ld(&(bar)[XB_TMO])) break; if (_sp > XB_SPIN_CAP) { atomicAdd(&(bar)[XB_TMO], 1u); break; } } } } while (0)

struct XcdBarrier { unsigned* bar; unsigned x; volatile LAS unsigned* st; };

__device__ __forceinline__ XcdBarrier xcd_barrier_post(unsigned* bar, volatile LAS unsigned* st) {
    XcdBarrier b; b.bar = bar; b.x = xb_xcc_id(); b.st = st;
    if (threadIdx.x == 0) (void)xb_add(&bar[XB_XCNT(b.x)], 1u);
    return b;
}
__device__ __forceinline__ void xcd_barrier_complete(unsigned* bar, unsigned x, unsigned& nloc, unsigned& nx) {
    const unsigned G = gridDim.x * gridDim.y * gridDim.z;
    unsigned sum, cnt, mine, sp = 0u;
    for (;;) {
        sum = 0u; cnt = 0u; mine = 0u;
#pragma unroll
        for (unsigned j = 0; j < 16; ++j) { const unsigned c = xb_ld(&bar[XB_XCNT(j)]); sum += c; cnt += (c > 0u) ? 1u : 0u; mine = (j == x) ? c : mine; }
        if (sum == G) break;
        __builtin_amdgcn_s_sleep(1);
        if ((++sp & 255u) == 0u) { if (xb_ld(&bar[XB_TMO])) break; if (sp > XB_SPIN_CAP) { atomicAdd(&bar[XB_TMO], 1u); break; } }
    }
    nloc = mine > 0u ? mine : 1u; nx = cnt > 0u ? cnt : 1u;
}
__device__ __forceinline__ void xcd_barrier(const XcdBarrier& b) {
    asm volatile("s_waitcnt vmcnt(0)" ::: "memory");
    __syncthreads();
    if (threadIdx.x == 0) {
        unsigned* bar = b.bar;
        __builtin_amdgcn_s_waitcnt(0);
        unsigned nloc = b.st[0], nx = b.st[1];
        if (nloc == 0u) { xcd_barrier_complete(bar, b.x, nloc, nx); b.st[0] = nloc; b.st[1] = nx; }
        const unsigned old = xb_add(&bar[XB_XSUB(b.x)], 1u);
        const unsigned gen = old / nloc;
        if (old + 1u == (gen + 1u) * nloc) {
            __builtin_amdgcn_fence(__ATOMIC_RELEASE, "agent");
            asm volatile("s_waitcnt vmcnt(0)" ::: "memory");
            const unsigned og = xb_add(&bar[XB_TOP], 1u);
            const unsigned tg = og / nx;
            if (og + 1u == (tg + 1u) * nx) xb_add(&bar[XB_TOPGEN], 1u);
            else XB_SPIN(xb_ld(&bar[XB_TOPGEN]) == tg, bar);
            __builtin_amdgcn_fence(__ATOMIC_ACQUIRE, "agent");
            xb_add(&bar[XB_XGEN(b.x)], 1u);
            asm volatile("s_waitcnt vmcnt(0)" ::: "memory");
        } else {
            XB_SPIN(xb_ld(&bar[XB_XGEN(b.x)]) == gen, bar);
            __builtin_amdgcn_fence(__ATOMIC_ACQUIRE, "agent");
            asm volatile("s_waitcnt vmcnt(0)" ::: "memory");
        }
    }
    __syncthreads();
}

typedef _Float16 h8 __attribute__((ext_vector_type(8)));
typedef _Float16 h4 __attribute__((ext_vector_type(4)));
typedef float f4 __attribute__((ext_vector_type(4)));

__device__ __forceinline__ float wave_sum(float v) {
#pragma unroll
    for (int o = 32; o > 0; o >>= 1) v += __shfl_xor(v, o);
    return v;
}
__device__ __forceinline__ float wave_max(float v) {
#pragma unroll
    for (int o = 32; o > 0; o >>= 1) v = fmaxf(v, __shfl_xor(v, o));
    return v;
}
__device__ __forceinline__ void wave_sync() {
    asm volatile("s_waitcnt lgkmcnt(0)" ::: "memory");
    __builtin_amdgcn_wave_barrier();
}
__device__ __forceinline__ float gelu_tanh(float x) {
    const float u = 0.7978845608028654f * (x + 0.044715f * x * x * x);
    return 0.5f * x * (1.f + tanhf(u));
}
__device__ __forceinline__ float gelu_fast(float x) { const float u = 0.7978845608028654f * (x + 0.044715f * x * x * x); const float t = 1.f - 2.f * __builtin_amdgcn_rcpf(1.f + __builtin_amdgcn_exp2f(2.8853900817779268f * u)); return 0.5f * x * (1.f + t); }
__device__ __forceinline__ float sigmoidf_(float x) { return 1.f / (1.f + expf(-x)); }
__device__ __forceinline__ unsigned pk4_fp8(float a, float b, float c, float d) { int w = 0; w = __builtin_amdgcn_cvt_pk_fp8_f32(a, b, w, false); w = __builtin_amdgcn_cvt_pk_fp8_f32(c, d, w, true); return (unsigned)w; }
__device__ __forceinline__ void dec4_fp8(unsigned w, float& a, float& b, float& c, float& d) { a = __builtin_amdgcn_cvt_f32_fp8((int)w, 0); b = __builtin_amdgcn_cvt_f32_fp8((int)w, 1); c = __builtin_amdgcn_cvt_f32_fp8((int)w, 2); d = __builtin_amdgcn_cvt_f32_fp8((int)w, 3); }
__device__ __forceinline__ float swiglu_fast(float g, float l) { const float xg = fminf(g, 7.f), xl = fminf(fmaxf(l, -7.f), 7.f); return xg * __builtin_amdgcn_rcpf(1.f + __builtin_amdgcn_exp2f(-2.4554669595930156f * xg)) * (xl + 1.f); }

constexpr int G_LD = 40;
template <class AF, class EF>
__device__ __forceinline__ void gemm_tile(char* smem, int K, const AF& af, const float* __restrict__ Bm, int ldb, int n0, int Nlim, bool perm, const EF& ef) {
    _Float16* As = (_Float16*)smem;
    _Float16* Bs = As + 128 * G_LD;
    const int tid = threadIdx.x, lane = tid & 63, wid = tid >> 6, wr = wid >> 2, wc = wid & 3, fr = lane & 15, fq = lane >> 4;
    f4 acc[4][2];
#pragma unroll
    for (int m = 0; m < 4; ++m)
#pragma unroll
        for (int n = 0; n < 2; ++n) acc[m][n] = (f4){0.f, 0.f, 0.f, 0.f};
    const int ar = tid >> 3, ak = (tid & 7) * 4;
    const float* ap0 = af.row(ar);
    const float* ap1 = af.row(ar + 64);
    const int bk = tid >> 5, bn = (tid & 31) * 4;
    const bool bok = (n0 + bn) < Nlim;
    int bnp[4];
#pragma unroll
    for (int i = 0; i < 4; ++i) { const int c = bn + i; bnp[i] = perm ? ((c & ~31) | ((c & 1) << 4) | ((c & 31) >> 1)) : c; }
    for (int k0 = 0; k0 < K; k0 += 32) {
        const int ko = af.koff(k0 + ak);
        float4 a0 = make_float4(0.f, 0.f, 0.f, 0.f), a1 = a0, b0 = a0, b1 = a0;
        if (ap0) a0 = *(const float4*)(ap0 + ko);
        if (ap1) a1 = *(const float4*)(ap1 + ko);
        if (bok) { b0 = *(const float4*)(Bm + (size_t)(k0 + bk) * ldb + n0 + bn); b1 = *(const float4*)(Bm + (size_t)(k0 + bk + 16) * ldb + n0 + bn); }
        __syncthreads();
        *(h4*)&As[ar * G_LD + ak] = (h4){(_Float16)a0.x, (_Float16)a0.y, (_Float16)a0.z, (_Float16)a0.w};
        *(h4*)&As[(ar + 64) * G_LD + ak] = (h4){(_Float16)a1.x, (_Float16)a1.y, (_Float16)a1.z, (_Float16)a1.w};
        Bs[bnp[0] * G_LD + bk] = (_Float16)b0.x; Bs[bnp[1] * G_LD + bk] = (_Float16)b0.y; Bs[bnp[2] * G_LD + bk] = (_Float16)b0.z; Bs[bnp[3] * G_LD + bk] = (_Float16)b0.w;
        Bs[bnp[0] * G_LD + bk + 16] = (_Float16)b1.x; Bs[bnp[1] * G_LD + bk + 16] = (_Float16)b1.y; Bs[bnp[2] * G_LD + bk + 16] = (_Float16)b1.z; Bs[bnp[3] * G_LD + bk + 16] = (_Float16)b1.w;
        __syncthreads();
        h8 a[4], b[2];
#pragma unroll
        for (int m = 0; m < 4; ++m) a[m] = *(const h8*)&As[(wr * 64 + m * 16 + fr) * G_LD + fq * 8];
#pragma unroll
        for (int n = 0; n < 2; ++n) b[n] = *(const h8*)&Bs[(wc * 32 + n * 16 + fr) * G_LD + fq * 8];
#pragma unroll
        for (int m = 0; m < 4; ++m)
#pragma unroll
            for (int n = 0; n < 2; ++n) acc[m][n] = __builtin_amdgcn_mfma_f32_16x16x32_f16(a[m], b[n], acc[m][n], 0, 0, 0);
    }
    ef(acc, wr, wc, fr, fq);
    __syncthreads();
}

struct ARowPlain { const float* base; int ld; int m0; int mlim;
    __device__ __forceinline__ const float* row(int r) const { return (m0 + r) < mlim ? base + (size_t)(m0 + r) * ld : nullptr; }
    __device__ __forceinline__ int koff(int k) const { return k; } };
struct ARowCmp { const float* proj; int col; int m0;
    __device__ __forceinline__ const float* row(int r) const { const int g = m0 + r; if (g >= CROWS) return nullptr; const int kvh = g & 1, bc = g >> 1, b = bc / NC, c = bc % NC;
        return proj + (size_t)(b * S_ + 16 * c) * INW + col + kvh * 128; }
    __device__ __forceinline__ int koff(int k) const { return (k >> 7) * INW + (k & 127); } };
struct ARowList { const float* base; const int* list; int m0; int cnt; int shift;
    __device__ __forceinline__ const float* row(int r) const { if (m0 + r >= cnt) return nullptr; const int a = list[m0 + r]; return base + (size_t)(a >> shift) * 2048; }
    __device__ __forceinline__ int koff(int k) const { return k; } };

struct EpiStore { float* C; int ldc; int m0; int n0; int mlim; int nlim; _Float16* C16;
    __device__ __forceinline__ void operator()(const f4 (&acc)[4][2], int wr, int wc, int fr, int fq) const {
#pragma unroll
        for (int m = 0; m < 4; ++m)
#pragma unroll
            for (int n = 0; n < 2; ++n)
#pragma unroll
                for (int j = 0; j < 4; ++j) { const int r = m0 + wr * 64 + m * 16 + fq * 4 + j, c = n0 + wc * 32 + n * 16 + fr;
                    if (r < mlim && c < nlim) { C[(size_t)r * ldc + c] = acc[m][n][j]; if (C16) C16[(size_t)r * ldc + c] = (_Float16)acc[m][n][j]; } } } };
struct EpiKc { _Float16* C; int m0;
    __device__ __forceinline__ void operator()(const f4 (&acc)[4][2], int wr, int wc, int fr, int fq) const {
#pragma unroll
        for (int m = 0; m < 4; ++m)
#pragma unroll
            for (int n = 0; n < 2; ++n)
#pragma unroll
                for (int j = 0; j < 4; ++j) { const int r = m0 + wr * 64 + m * 16 + fq * 4 + j, c = wc * 32 + n * 16 + fr;
                    C[(size_t)r * 128 + c] = (((r >> 1) & 127) == 127) ? (_Float16)0.f : (_Float16)acc[m][n][j]; } } };
struct EpiPool { _Float16* C; const float* scale; int m0; int g;
    __device__ __forceinline__ void operator()(const f4 (&acc)[4][2], int wr, int wc, int fr, int fq) const {
#pragma unroll
        for (int m = 0; m < 4; ++m)
#pragma unroll
            for (int n = 0; n < 2; ++n)
#pragma unroll
                for (int j = 0; j < 4; ++j) { const int r = m0 + wr * 64 + m * 16 + fq * 4 + j, c = g * 128 + wc * 32 + n * 16 + fr;
                    C[(size_t)r * 512 + c] = (_Float16)(acc[m][n][j] * scale[c]); } } };
struct EpiHid { float* C; const float* bias; int m0; int n0;
    __device__ __forceinline__ void operator()(const f4 (&acc)[4][2], int wr, int wc, int fr, int fq) const {
#pragma unroll
        for (int m = 0; m < 4; ++m)
#pragma unroll
            for (int n = 0; n < 2; ++n)
#pragma unroll
                for (int j = 0; j < 4; ++j) { const int r = m0 + wr * 64 + m * 16 + fq * 4 + j, c = n0 + wc * 32 + n * 16 + fr;
                    if (r < CROWS) C[(size_t)r * 256 + c] = gelu_tanh(acc[m][n][j] + bias[c]); } } };
struct EpiOut { float* C; const float* x; int m0; int n0;
    __device__ __forceinline__ void operator()(const f4 (&acc)[4][2], int wr, int wc, int fr, int fq) const {
#pragma unroll
        for (int m = 0; m < 4; ++m)
#pragma unroll
            for (int n = 0; n < 2; ++n)
#pragma unroll
                for (int j = 0; j < 4; ++j) { const size_t o = (size_t)(m0 + wr * 64 + m * 16 + fq * 4 + j) * 2048 + n0 + wc * 32 + n * 16 + fr;
                    C[o] = DN_ALPHA * x[o] + acc[m][n][j]; } } };
struct EpiGu { float* act; const float* bgu; const int* list; int m0; int cnt; int n0;
    __device__ __forceinline__ void operator()(const f4 (&acc)[4][2], int wr, int wc, int fr, int fq) const {
        const int jc = (n0 + wc * 32) / 2 + fr;
        const float bg = bgu[2 * jc], bl = bgu[2 * jc + 1];
#pragma unroll
        for (int m = 0; m < 4; ++m)
#pragma unroll
            for (int j = 0; j < 4; ++j) { const int r = m0 + wr * 64 + m * 16 + fq * 4 + j;
                if (r < cnt) { const int a = list[r];
                    const float xg = fminf(acc[m][0][j] + bg, 7.f), xl = fminf(fmaxf(acc[m][1][j] + bl, -7.f), 7.f);
                    act[(size_t)a * 2048 + jc] = xg * sigmoidf_(1.702f * xg) * (xl + 1.f); } } } };
struct EpiDn { float* y; const float* bdn; const int* list; const float* gate; int m0; int cnt; int n0;
    __device__ __forceinline__ void operator()(const f4 (&acc)[4][2], int wr, int wc, int fr, int fq) const {
#pragma unroll
        for (int m = 0; m < 4; ++m)
#pragma unroll
            for (int j = 0; j < 4; ++j) { const int r = m0 + wr * 64 + m * 16 + fq * 4 + j;
                if (r < cnt) { const int a = list[r]; const float g = gate[a];
#pragma unroll
                    for (int n = 0; n < 2; ++n) { const int c = n0 + wc * 32 + n * 16 + fr; y[(size_t)a * 2048 + c] = (acc[m][n][j] + bdn[c]) * g; } } } } };

constexpr int WLDS_FLOATS = 4096 + 512 + 32;
template <bool SHARED>
__device__ __forceinline__ void wave_attn(float* sw, const float* __restrict__ qptr, const float* __restrict__ Kb, const float* __restrict__ Vb, int ld, int nseg, float scale, float* __restrict__ optr) {
    const int lane = threadIdx.x & 63;
    float* sq = sw + 4096; const int* segs = (const int*)(sw + 4096 + 512);
#pragma unroll
    for (int i = 0; i < 8; ++i) sq[lane + 64 * i] = qptr[lane + 64 * i];
    wave_sync();
    for (int sg = 0; sg < nseg; ++sg) {
        const int start = segs[sg], len = segs[16 + sg];
        float d0 = 0.f, d1 = 0.f, d2 = 0.f, d3 = 0.f;
        if (lane < len) {
            const float* kp = Kb + (size_t)(start + lane) * ld;
            for (int d4 = 0; d4 < 32; ++d4) {
                if (SHARED) {
                    const float4 kv = *(const float4*)(kp + d4 * 4);
                    const float4 q0 = *(const float4*)(sq + d4 * 4), q1 = *(const float4*)(sq + 128 + d4 * 4), q2 = *(const float4*)(sq + 256 + d4 * 4), q3 = *(const float4*)(sq + 384 + d4 * 4);
                    d0 += kv.x * q0.x + kv.y * q0.y + kv.z * q0.z + kv.w * q0.w;
                    d1 += kv.x * q1.x + kv.y * q1.y + kv.z * q1.z + kv.w * q1.w;
                    d2 += kv.x * q2.x + kv.y * q2.y + kv.z * q2.z + kv.w * q2.w;
                    d3 += kv.x * q3.x + kv.y * q3.y + kv.z * q3.z + kv.w * q3.w;
                } else {
                    const float4 k0 = *(const float4*)(kp + d4 * 4), k1 = *(const float4*)(kp + 128 + d4 * 4), k2 = *(const float4*)(kp + 256 + d4 * 4), k3 = *(const float4*)(kp + 384 + d4 * 4);
                    const float4 q0 = *(const float4*)(sq + d4 * 4), q1 = *(const float4*)(sq + 128 + d4 * 4), q2 = *(const float4*)(sq + 256 + d4 * 4), q3 = *(const float4*)(sq + 384 + d4 * 4);
                    d0 += k0.x * q0.x + k0.y * q0.y + k0.z * q0.z + k0.w * q0.w;
                    d1 += k1.x * q1.x + k1.y * q1.y + k1.z * q1.z + k1.w * q1.w;
                    d2 += k2.x * q2.x + k2.y * q2.y + k2.z * q2.z + k2.w * q2.w;
                    d3 += k3.x * q3.x + k3.y * q3.y + k3.z * q3.z + k3.w * q3.w;
                }
            }
        }
        const bool ok = lane < len;
        sw[sg * 64 + lane] = ok ? d0 * scale : -1e30f;
        sw[1024 + sg * 64 + lane] = ok ? d1 * scale : -1e30f;
        sw[2048 + sg * 64 + lane] = ok ? d2 * scale : -1e30f;
        sw[3072 + sg * 64 + lane] = ok ? d3 * scale : -1e30f;
    }
    wave_sync();
    const int n = nseg * 64;
#pragma unroll
    for (int g = 0; g < 4; ++g) {
        float mx = -1e30f;
        for (int i = lane; i < n; i += 64) mx = fmaxf(mx, sw[g * 1024 + i]);
        mx = wave_max(mx);
        float sm = 0.f;
        for (int i = lane; i < n; i += 64) { const float v = sw[g * 1024 + i]; sm += (v > -1e29f) ? expf(v - mx) : 0.f; }
        sm = wave_sum(sm);
        const float inv = sm > 0.f ? 1.f / sm : 0.f;
        for (int i = lane; i < n; i += 64) { const float v = sw[g * 1024 + i]; sw[g * 1024 + i] = (v > -1e29f) ? expf(v - mx) * inv : 0.f; }
    }
    wave_sync();
    float o[4][2];
#pragma unroll
    for (int g = 0; g < 4; ++g) { o[g][0] = 0.f; o[g][1] = 0.f; }
    for (int sg = 0; sg < nseg; ++sg) {
        const int start = segs[sg], len = segs[16 + sg];
        for (int l = 0; l < len; ++l) {
            const float* vp = Vb + (size_t)(start + l) * ld;
            if (SHARED) {
                const float v0 = vp[lane], v1 = vp[lane + 64];
#pragma unroll
                for (int g = 0; g < 4; ++g) { const float p = sw[g * 1024 + sg * 64 + l]; o[g][0] += p * v0; o[g][1] += p * v1; }
            } else {
#pragma unroll
                for (int g = 0; g < 4; ++g) { const float p = sw[g * 1024 + sg * 64 + l]; o[g][0] += p * vp[g * 128 + lane]; o[g][1] += p * vp[g * 128 + lane + 64]; }
            }
        }
    }
#pragma unroll
    for (int g = 0; g < 4; ++g) { optr[g * 128 + lane] = o[g][0]; optr[g * 128 + lane + 64] = o[g][1]; }
}

namespace g8 {
constexpr int BM = 256, BK = 64, HALF = 128, HTB = HALF * BK * 2, STAGE_BYTES = 8 * HTB;
constexpr int KK = 2048;
typedef float f32x4 __attribute__((ext_vector_type(4)));
__device__ __forceinline__ int lds_byte(int r, int c) { const int st = (r >> 4) * 2 + (c >> 5), rr = r & 15, cc = c & 31, ob = rr * 64 + cc * 2; return st * 1024 + (ob ^ (((ob >> 9) & 1) << 5)); }
__device__ __forceinline__ void stage_rc(int b, int& R, int& C) { const int st = b / 1024, sb = b % 1024, swz = sb ^ (((sb >> 9) & 1) << 5); R = (st >> 1) * 16 + swz / 64; C = (st & 1) * 32 + (swz % 64) / 2; }
__device__ __forceinline__ int perm32(int rho) { const int n = rho >> 4, i = rho & 15; return 8 * (i >> 2) + 4 * n + (i & 3); }

typedef int i32x4 __attribute__((ext_vector_type(4)));
typedef unsigned u32x2 __attribute__((ext_vector_type(2)));
typedef unsigned u32x4 __attribute__((ext_vector_type(4)));
template <bool I8> struct AccSel { typedef f32x4 T; };
template <> struct AccSel<true> { typedef i32x4 T; };
__device__ __forceinline__ f32x4 mma16(i32x4 a, i32x4 b, f32x4 c) { return __builtin_amdgcn_mfma_f32_16x16x32_f16(*reinterpret_cast<h8*>(&a), *reinterpret_cast<h8*>(&b), c, 0, 0, 0); }
__device__ __forceinline__ i32x4 mma16(i32x4 a, i32x4 b, i32x4 c) { return __builtin_amdgcn_mfma_i32_16x16x64_i8(a, b, c, 0, 0, 0); }
struct Unit { int m0, n0, e, cnt, rbase; };
constexpr int EP_OFF = STAGE_BYTES + 2048, EP_LD = 528, EP_GRP = 16 * EP_LD;
__device__ __forceinline__ void ep_sync() { asm volatile("s_waitcnt lgkmcnt(0)" ::: "memory"); __builtin_amdgcn_s_barrier(); asm volatile("" ::: "memory"); }
__device__ __forceinline__ int ep_tid() { int tz = threadIdx.x; asm volatile("" : "+v"(tz)); return tz; }
__device__ __forceinline__ h8 cvt8(f32x4 a, f32x4 b) { h8 o; o[0] = (_Float16)a[0]; o[1] = (_Float16)a[1]; o[2] = (_Float16)a[2]; o[3] = (_Float16)a[3]; o[4] = (_Float16)b[0]; o[5] = (_Float16)b[1]; o[6] = (_Float16)b[2]; o[7] = (_Float16)b[3]; return o; }

__device__ __forceinline__ void tile_order(int L, int nM, int nN, int& pm, int& pn) {
    const int nwg = nM * nN; int wgid = L;
    { const int q = nwg / 8, r = nwg % 8, xcd = wgid % 8, off = wgid / 8; wgid = (xcd < r ? xcd * (q + 1) : r * (q + 1) + (xcd - r) * q) + off; }
    const int nig = 8 * nN, gid = wgid / nig, fm = gid * 8, gsz = (nM - fm) < 8 ? (nM - fm) : 8;
    pm = fm + ((wgid % nig) % gsz); pn = (wgid % nig) / gsz;
}

template <class Prob>
__device__ __forceinline__ void gemm_phase(LAS unsigned char* lds, const Prob& P) {
    const int tid = threadIdx.x, wid = __builtin_amdgcn_readfirstlane(tid >> 6), lane = tid & 63, wr = wid >> 2, wc = wid & 3, fr = lane & 15, fq = lane >> 4;
    constexpr int nt = Prob::NT; constexpr size_t KS2 = Prob::KS2; constexpr unsigned ROWB = Prob::ROWB; constexpr bool I8 = Prob::I8;
    int sR[2], sC2[2]; unsigned voffB[2];
#pragma unroll
    for (int i = 0; i < 2; ++i) { int R, C; stage_rc(tid * 16 + i * 8192, R, C); sR[i] = R; sC2[i] = C * 2; const int Rb = Prob::PERM ? ((R & ~31) + perm32(R & 31)) : R; voffB[i] = (unsigned)Rb * ROWB + (unsigned)C * 2u; }
    const size_t kstep = (size_t)(BK * 2);
    const size_t hstep = (size_t)HALF * ROWB;
    const unsigned ldsw = (unsigned)wid * 1024u;
    const int aoff = lds_byte(wr * 64 + fr, fq * 8), boff = lds_byte(wc * 32 + fr, fq * 8);
#define G8_SA(b, h) (((b) * 2 + (h)) * HTB)
#define G8_SB(b, h) ((4 + (b) * 2 + (h)) * HTB)
#define G8_STAGE(bufoff, gbase, voff) do { _Pragma("unroll") for (int _i = 0; _i < 2; ++_i) \
        __builtin_amdgcn_global_load_lds((const unsigned*)((const char*)(gbase) + (voff)[_i]), (LAS unsigned*)(lds + (bufoff) + ldsw + _i * 8192), 16, 0, 0); } while (0)
#define G8_LDA(dst, b, h) do { _Pragma("unroll") for (int m = 0; m < 4; ++m) _Pragma("unroll") for (int k = 0; k < 2; ++k) dst[m][k] = *(const LAS i32x4*)(lds + G8_SA(b, h) + aoff + m * 2048 + k * 1024); } while (0)
#define G8_LDB(dst, b, h) do { _Pragma("unroll") for (int n = 0; n < 2; ++n) _Pragma("unroll") for (int k = 0; k < 2; ++k) dst[n][k] = *(const LAS i32x4*)(lds + G8_SB(b, h) + boff + n * 2048 + k * 1024); } while (0)
#define G8_MMA(ai, bj, At, Bt) do { __builtin_amdgcn_s_setprio(1); _Pragma("unroll") for (int m = 0; m < 4; ++m) _Pragma("unroll") for (int n = 0; n < 2; ++n) _Pragma("unroll") for (int k = 0; k < 2; ++k) \
        acc[ai][bj][m][n] = mma16(Bt[n][k], At[m][k], acc[ai][bj][m][n]); __builtin_amdgcn_s_setprio(0); } while (0)
#define G8_WAIT_V(n) asm volatile("s_waitcnt vmcnt(" #n ")" ::: "memory")
#define G8_WAIT_L(n) asm volatile("s_waitcnt lgkmcnt(" #n ")" ::: "memory")
#define G8_BAR __builtin_amdgcn_s_barrier()
#define G8_SCHED __builtin_amdgcn_sched_barrier(0)
    Unit cur, nxt; int ui = 0;
    if (!P.next(0, cur)) return;
    typedef typename AccSel<I8>::T AccT;
    AccT acc[2][2][4][2];
#pragma unroll
    for (int a = 0; a < 2; ++a)
#pragma unroll
        for (int b = 0; b < 2; ++b)
#pragma unroll
            for (int m = 0; m < 4; ++m)
#pragma unroll
                for (int n = 0; n < 2; ++n) acc[a][b][m][n] = AccT{};
    i32x4 At[4][2], B0[2][2], B1[2][2];
    unsigned vc[2][2], vn[2][2];
    P.a_offs(cur, sR, sC2, vc);
    const char* const Ab = P.a_base();
    const char* cB = P.b_base(cur);
    G8_STAGE(G8_SB(0, 0), cB, voffB); G8_STAGE(G8_SA(0, 0), Ab, vc[0]); G8_STAGE(G8_SB(0, 1), cB + hstep, voffB); G8_STAGE(G8_SA(0, 1), Ab, vc[1]);
    if (wr == 1) G8_BAR;
    G8_WAIT_V(4); G8_BAR;
    G8_STAGE(G8_SB(1, 0), cB + kstep, voffB); G8_STAGE(G8_SA(1, 0), Ab + kstep, vc[0]); G8_STAGE(G8_SB(1, 1), cB + hstep + kstep, voffB);
    G8_WAIT_V(6); G8_BAR;
    for (;;) {
        const bool has_next = P.next(ui + 1, nxt);
        const char* nB = cB;
        if (has_next) { P.a_offs(nxt, sR, sC2, vn); nB = P.b_base(nxt); }
        else { vn[0][0] = vc[0][0]; vn[0][1] = vc[0][1]; vn[1][0] = vc[1][0]; vn[1][1] = vc[1][1]; }
        for (int t = 0; t < nt; t += 2) {
            const bool last = (t == nt - 2);
            const char* a1 = Ab + (size_t)(t >> 1) * KS2 + kstep;
            const char* a2 = last ? Ab : Ab + (size_t)((t + 2) >> 1) * KS2; const char* b2 = last ? nB : cB + (size_t)(t + 2) * kstep;
            const char* a3 = a2 + kstep; const char* b3 = b2 + kstep;
            unsigned o2[2][2];
            o2[0][0] = last ? vn[0][0] : vc[0][0]; o2[0][1] = last ? vn[0][1] : vc[0][1]; o2[1][0] = last ? vn[1][0] : vc[1][0]; o2[1][1] = last ? vn[1][1] : vc[1][1];
            G8_LDB(B0, 0, 0); G8_SCHED; G8_LDA(At, 0, 0); G8_STAGE(G8_SA(1, 1), a1, vc[1]);
            G8_WAIT_L(8); G8_BAR; G8_WAIT_L(0); G8_MMA(0, 0, At, B0); G8_BAR; G8_SCHED;
            G8_LDB(B1, 0, 1); G8_STAGE(G8_SB(0, 0), b2, voffB);
            G8_BAR; G8_WAIT_L(0); G8_MMA(0, 1, At, B1); G8_BAR;
            G8_LDA(At, 0, 1); G8_STAGE(G8_SA(0, 0), a2, o2[0]);
            G8_BAR; G8_WAIT_L(0); G8_MMA(1, 0, At, B0); G8_BAR; G8_SCHED;
            G8_STAGE(G8_SB(0, 1), b2 + hstep, voffB);
            G8_WAIT_V(6); G8_BAR; G8_MMA(1, 1, At, B1); G8_BAR;
            G8_LDB(B0, 1, 0); G8_SCHED; G8_LDA(At, 1, 0); G8_STAGE(G8_SA(0, 1), a2, o2[1]);
            G8_WAIT_L(8); G8_BAR; G8_WAIT_L(0); G8_MMA(0, 0, At, B0); G8_BAR; G8_SCHED;
            G8_LDB(B1, 1, 1); G8_STAGE(G8_SB(1, 0), b3, voffB);
            G8_BAR; G8_WAIT_L(0); G8_MMA(0, 1, At, B1); G8_BAR;
            G8_LDA(At, 1, 1); G8_STAGE(G8_SA(1, 0), a3, o2[0]);
            G8_BAR; G8_WAIT_L(0); G8_MMA(1, 0, At, B0); G8_BAR; G8_SCHED;
            G8_STAGE(G8_SB(1, 1), b3 + hstep, voffB);
            G8_WAIT_V(6); G8_BAR; G8_MMA(1, 1, At, B1); G8_BAR;
        }
        P.epi(acc, cur, wr, wc, fr, fq, lds);
        if (!has_next) break;
#pragma unroll
        for (int a = 0; a < 2; ++a)
#pragma unroll
            for (int b = 0; b < 2; ++b)
#pragma unroll
                for (int m = 0; m < 4; ++m)
#pragma unroll
                    for (int n = 0; n < 2; ++n) acc[a][b][m][n] = AccT{};
        cur = nxt; cB = nB; ++ui;
        vc[0][0] = vn[0][0]; vc[0][1] = vn[0][1]; vc[1][0] = vn[1][0]; vc[1][1] = vn[1][1];
    }
    G8_WAIT_V(0);
    if (wr == 0) G8_BAR;
    G8_BAR;
#undef G8_SA
#undef G8_SB
#undef G8_STAGE
#undef G8_LDA
#undef G8_LDB
#undef G8_MMA
#undef G8_WAIT_V
#undef G8_WAIT_L
#undef G8_BAR
#undef G8_SCHED
}

struct ProbInF {
    static constexpr unsigned ROWB = 4096; static constexpr bool I8 = false;
    static constexpr int NT = 32; static constexpr size_t KS2 = 256;
    static constexpr bool PERM = true;
    const _Float16* A; _Float16* C16; int G, c;
    __device__ __forceinline__ bool next(int i, Unit& u) const { const int L = i * G + c; if (L >= 64 * 5) return false;
        int pm, pn; tile_order(L, 64, 5, pm, pn); u.m0 = pm * 256; u.n0 = pn * 256; u.e = 0; u.cnt = 256; u.rbase = 0; return true; }
    __device__ __forceinline__ void a_offs(const Unit& u, const int (&R)[2], const int (&C2)[2], unsigned (&v)[2][2]) const {
#pragma unroll
        for (int h = 0; h < 2; ++h)
#pragma unroll
            for (int i = 0; i < 2; ++i) v[h][i] = (unsigned)(u.m0 + h * 128 + R[i]) * (unsigned)(KK * 2) + (unsigned)C2[i]; }
    __device__ __forceinline__ const char* a_base() const { return (const char*)A; }
    __device__ __forceinline__ const char* b_base(const Unit& u) const { return (const char*)A + (long long)(WS_WTIN - WS_X16) + (size_t)u.n0 * KK * 2; }
    __device__ __forceinline__ void epi(const f32x4 (&acc)[2][2][4][2], const Unit& u, int wr, int wc, int fr, int fq, LAS unsigned char* lds) const {
        LAS unsigned char* ep = lds + EP_OFF + wr * EP_GRP;
        const int tg = ep_tid() & 255, rrow = tg >> 4, ch = tg & 15;
        const int kvseg = (u.e == 0 && u.n0 >= 1024 && u.n0 < 2560) ? ((u.n0 - 1024) >> 8) : -1;
        _Float16* const Cb = (_Float16*)((char*)C16 + (u.e ? (long long)(WS_KVMEM16 - WS_PROJ16) : 0ll)); const int ldc = u.e ? 1024 : INW, nlim = u.e ? 1024 : INW, mb = u.e ? u.m0 - T_ : u.m0;
#pragma unroll
        for (int ai = 0; ai < 2; ++ai)
#pragma unroll
            for (int m = 0; m < 4; ++m) {
#pragma unroll
                for (int bj = 0; bj < 2; ++bj) *(LAS h8*)(ep + fr * EP_LD + (bj * 128 + wc * 32 + fq * 8) * 2) = cvt8(acc[ai][bj][m][0], acc[ai][bj][m][1]);
                ep_sync();
                const h8 x0 = *(const LAS h8*)(ep + rrow * EP_LD + ch * 32), x1 = *(const LAS h8*)(ep + rrow * EP_LD + ch * 32 + 16);
                const int grow = mb + ai * 128 + wr * 64 + m * 16 + rrow, gcol = u.n0 + ch * 16;
                if (kvseg >= 0) {
                    _Float16* dst = (_Float16*)((char*)C16 + (long long)(WS_KV16 - WS_PROJ16)) + ((size_t)(kvseg * B_ + (grow >> 11)) * 2 + (ch >> 3)) * KVSEG + (size_t)(grow & (S_ - 1)) * 128 + (ch & 7) * 16;
                    *(h8*)dst = x0; *(h8*)(dst + 8) = x1;
                } else {
                    if (gcol < nlim) *(h8*)(Cb + (size_t)grow * ldc + gcol) = x0;
                    if (gcol + 8 < nlim) *(h8*)(Cb + (size_t)grow * ldc + gcol + 8) = x1; }
                ep_sync();
            } }
};
struct ProbIn8 {
    static constexpr unsigned ROWB = 2048; static constexpr bool I8 = true;
    static constexpr int NT = 16; static constexpr size_t KS2 = 256;
    static constexpr bool PERM = true;
    const signed char* A; _Float16* C16; const float* sa; int G, c;
    __device__ __forceinline__ bool next(int i, Unit& u) const { const int L = i * G + c; if (L >= 640 + 32) return false;
        if (L < 640) { int pm, pn; tile_order(L, 64, 10, pm, pn); u.m0 = pm * 256; u.n0 = 1280 + pn * 256; u.e = 0; }
        else { const int v = L - 640; u.m0 = T_ + (v & 7) * 256; u.n0 = (v >> 3) * 256; u.e = 1; }
        u.cnt = 256; u.rbase = 0; return true; }
    __device__ __forceinline__ void a_offs(const Unit& u, const int (&R)[2], const int (&C2)[2], unsigned (&v)[2][2]) const {
#pragma unroll
        for (int h = 0; h < 2; ++h)
#pragma unroll
            for (int i = 0; i < 2; ++i) v[h][i] = (unsigned)(u.m0 + h * 128 + R[i]) * 2048u + (unsigned)C2[i]; }
    __device__ __forceinline__ const char* a_base() const { return (const char*)A; }
    __device__ __forceinline__ const char* b_base(const Unit& u) const { return (const char*)A + (u.e ? (long long)(WS_Q8MKV - WS_X8) + (long long)u.n0 * 2048 : (long long)(WS_Q8IN - WS_X8) + (long long)(u.n0 - 1280) * 2048); }
    __device__ __forceinline__ void epi(const i32x4 (&acc)[2][2][4][2], const Unit& u, int wr, int wc, int fr, int fq, LAS unsigned char* lds) const {
        LAS unsigned char* ep = lds + EP_OFF + wr * EP_GRP;
        const int tg = ep_tid() & 255, rrow = tg >> 4, ch = tg & 15;
        const int kvseg = (u.e == 0 && u.n0 >= 1024 && u.n0 < 2560) ? ((u.n0 - 1024) >> 8) : -1;
        _Float16* const Cb = (_Float16*)((char*)C16 + (u.e ? (long long)(WS_KVMEM16 - WS_PROJ16) : 0ll)); const int ldc = u.e ? 1024 : INW, nlim = u.e ? 1024 : INW, mb = u.e ? u.m0 - T_ : u.m0;
        const float* sw = (const float*)((const char*)A + (u.e ? (long long)(WS_SMKV - WS_X8) : (long long)(WS_SIN8 - WS_X8))) + (u.e ? u.n0 : u.n0 - 1280);
        f32x4 s0[2], s1[2]; float srv[8];
#pragma unroll
        for (int bj = 0; bj < 2; ++bj) { const int col = bj * 128 + wc * 32 + fq * 8; s0[bj] = *(const f32x4*)(sw + col); s1[bj] = *(const f32x4*)(sw + col + 4); }
#pragma unroll
        for (int q = 0; q < 8; ++q) srv[q] = sa[u.m0 + (q >> 2) * 128 + wr * 64 + (q & 3) * 16 + fr];
#pragma unroll
        for (int ai = 0; ai < 2; ++ai)
#pragma unroll
            for (int m = 0; m < 4; ++m) { const float sr = srv[ai * 4 + m];
#pragma unroll
                for (int bj = 0; bj < 2; ++bj) { const i32x4 i0 = acc[ai][bj][m][0], i1 = acc[ai][bj][m][1];
                    *(LAS h8*)(ep + fr * EP_LD + (bj * 128 + wc * 32 + fq * 8) * 2) = cvt8((f32x4){(float)i0[0], (float)i0[1], (float)i0[2], (float)i0[3]} * (s0[bj] * sr), (f32x4){(float)i1[0], (float)i1[1], (float)i1[2], (float)i1[3]} * (s1[bj] * sr)); }
                ep_sync();
                const h8 x0 = *(const LAS h8*)(ep + rrow * EP_LD + ch * 32), x1 = *(const LAS h8*)(ep + rrow * EP_LD + ch * 32 + 16);
                const int grow = mb + ai * 128 + wr * 64 + m * 16 + rrow, gcol = u.n0 + ch * 16;
                if (kvseg >= 0) {
                    _Float16* dst = (_Float16*)((char*)C16 + (long long)(WS_KV16 - WS_PROJ16)) + ((size_t)(kvseg * B_ + (grow >> 11)) * 2 + (ch >> 3)) * KVSEG + (size_t)(grow & (S_ - 1)) * 128 + (ch & 7) * 16;
                    *(h8*)dst = x0; *(h8*)(dst + 8) = x1;
                } else {
                    if (gcol < nlim) *(h8*)(Cb + (size_t)grow * ldc + gcol) = x0;
                    if (gcol + 8 < nlim) *(h8*)(Cb + (size_t)grow * ldc + gcol + 8) = x1; }
                ep_sync();
            } }
};
struct ProbOut {
    static constexpr unsigned ROWB = 2048; static constexpr bool I8 = true;
    static constexpr int NT = 16; static constexpr size_t KS2 = 256;
    static constexpr bool PERM = true;
    const signed char* A; const signed char* Bt; _Float16* C; const _Float16* X; const float* sa; const float* sw; int G, c;
    __device__ __forceinline__ bool next(int i, Unit& u) const { const int L = i * G + c; if (L >= 64 * 8) return false; int pm, pn; tile_order(L, 64, 8, pm, pn); u.m0 = pm * 256; u.n0 = pn * 256; u.e = 0; u.cnt = 256; u.rbase = 0; return true; }
    __device__ __forceinline__ void a_offs(const Unit& u, const int (&R)[2], const int (&C2)[2], unsigned (&v)[2][2]) const {
#pragma unroll
        for (int h = 0; h < 2; ++h)
#pragma unroll
            for (int i = 0; i < 2; ++i) v[h][i] = (unsigned)(u.m0 + h * 128 + R[i]) * 2048u + (unsigned)C2[i]; }
    __device__ __forceinline__ const char* a_base() const { return (const char*)A; }
    __device__ __forceinline__ const char* b_base(const Unit& u) const { return (const char*)(Bt + (size_t)u.n0 * 2048); }
    __device__ __forceinline__ void epi(const i32x4 (&acc)[2][2][4][2], const Unit& u, int wr, int wc, int fr, int fq, LAS unsigned char* lds) const {
        LAS unsigned char* ep = lds + EP_OFF + wr * EP_GRP;
        const int tg = ep_tid() & 255, rrow = tg >> 4, ch = tg & 15;
        f32x4 s0[2], s1[2]; float srv[8];
#pragma unroll
        for (int bj = 0; bj < 2; ++bj) { const int col = u.n0 + bj * 128 + wc * 32 + fq * 8; s0[bj] = *(const f32x4*)(sw + col); s1[bj] = *(const f32x4*)(sw + col + 4); }
#pragma unroll
        for (int q = 0; q < 8; ++q) srv[q] = sa[u.m0 + (q >> 2) * 128 + wr * 64 + (q & 3) * 16 + fr];
#pragma unroll
        for (int ai = 0; ai < 2; ++ai)
#pragma unroll
            for (int m = 0; m < 4; ++m) { const float sr = srv[ai * 4 + m];
#pragma unroll
                for (int bj = 0; bj < 2; ++bj) { const i32x4 i0 = acc[ai][bj][m][0], i1 = acc[ai][bj][m][1];
                    *(LAS h8*)(ep + fr * EP_LD + (bj * 128 + wc * 32 + fq * 8) * 2) = cvt8((f32x4){(float)i0[0], (float)i0[1], (float)i0[2], (float)i0[3]} * (s0[bj] * sr), (f32x4){(float)i1[0], (float)i1[1], (float)i1[2], (float)i1[3]} * (s1[bj] * sr)); }
                const size_t go = (size_t)(u.m0 + ai * 128 + wr * 64 + m * 16 + rrow) * 2048 + u.n0 + ch * 16;
                const h8 r0 = *(const h8*)(X + go), r1 = *(const h8*)(X + go + 8);
                ep_sync();
                const h8 x0 = *(const LAS h8*)(ep + rrow * EP_LD + ch * 32), x1 = *(const LAS h8*)(ep + rrow * EP_LD + ch * 32 + 16);
                h8 o0, o1;
#pragma unroll
                for (int q = 0; q < 8; ++q) { o0[q] = (_Float16)(DN_ALPHA * (float)r0[q] + (float)x0[q]); o1[q] = (_Float16)(DN_ALPHA * (float)r1[q] + (float)x1[q]); }
                *(h8*)(C + go) = o0; *(h8*)(C + go + 8) = o1;
                ep_sync();
            } }
};
struct ProbCmp {
    static constexpr unsigned ROWB = 4096; static constexpr bool I8 = false;
    static constexpr int NT = 8; static constexpr size_t KS2 = 256;
    static constexpr bool PERM = false;
    const _Float16* A; const _Float16* Bt; float* C; int G, c;
    __device__ __forceinline__ bool next(int i, Unit& u) const { const int L = i * G + c; if (L >= 128) return false;
        u.e = L >> 6; const int r = L & 63; u.rbase = r & 3; u.n0 = ((r >> 2) & 1) * 256; u.m0 = (r >> 3) * 256; u.cnt = 256; return true; }
    __device__ __forceinline__ void a_offs(const Unit& u, const int (&R)[2], const int (&C2)[2], unsigned (&v)[2][2]) const {
#pragma unroll
        for (int h = 0; h < 2; ++h)
#pragma unroll
            for (int i = 0; i < 2; ++i) { const int row = u.m0 + h * 128 + R[i], kvh = row & 1, bj = row >> 1, b = bj >> 7, j = bj & 127;
                v[h][i] = (unsigned)((((u.e * B_ + b) * 2 + kvh) * S_ + 16 * j + 4 * u.rbase) * 128) * 2u + (unsigned)C2[i]; } }
    __device__ __forceinline__ const char* a_base() const { return (const char*)A; }
    __device__ __forceinline__ const char* b_base(const Unit& u) const { return (const char*)(Bt + ((size_t)u.e * 512 + u.n0) * KK + u.rbase * 512); }
    __device__ __forceinline__ void epi(const f32x4 (&acc)[2][2][4][2], const Unit& u, int wr, int wc, int fr, int fq, LAS unsigned char*) const {
        float* base = C + ((size_t)(u.e * 4 + u.rbase) * 2048) * 512;
#pragma unroll
        for (int ai = 0; ai < 2; ++ai)
#pragma unroll
            for (int m = 0; m < 4; ++m) { const int row = u.m0 + ai * 128 + wr * 64 + m * 16 + fr;
#pragma unroll
                for (int bj = 0; bj < 2; ++bj)
#pragma unroll
                    for (int n = 0; n < 2; ++n) { const int col = u.n0 + bj * 128 + wc * 32 + n * 16 + fq * 4;
                        *(f32x4*)(base + (size_t)row * 512 + col) = acc[ai][bj][m][n]; } } }
};
struct MoeTab { const LAS int* t; int NT;
    __device__ __forceinline__ bool find_i(int i, Unit& u) const {
        const LAS int* q = t + 128 + 8 * i;
        if (__builtin_amdgcn_readfirstlane(q[5]) == 0) return false;
        u.e = __builtin_amdgcn_readfirstlane(q[0]); u.m0 = __builtin_amdgcn_readfirstlane(q[1]); u.n0 = __builtin_amdgcn_readfirstlane(q[2]); u.cnt = __builtin_amdgcn_readfirstlane(q[3]); u.rbase = __builtin_amdgcn_readfirstlane(q[4]); return true; } };
__device__ __forceinline__ void moe_build(LAS int* t, int G, int vcu) {
    const int i = threadIdx.x;
    if (i < 40) { const int L = i * G + vcu; LAS int* q = t + 128 + 8 * i;
        if (L >= t[98]) q[5] = 0;
        else { int e = 0; for (; e < NE - 1; ++e) { if (L < t[32 + e + 1]) break; }
            const int ub = t[32 + e], cn = t[e], rs = t[65 + e]; const int nm = (cn + 255) >> 8, v = L - ub, mt = v % nm, ntile = v / nm;
            q[0] = e; q[1] = mt * 256; q[2] = ntile * 256; q[3] = min(256, cn - mt * 256); q[4] = rs; q[5] = 1; } }
}
struct ProbGu {
    static constexpr int NT = 16; static constexpr size_t KS2 = 256; static constexpr unsigned ROWB = 2048; static constexpr bool I8 = true;
    static constexpr bool PERM = true;
    const signed char* A; const signed char* Bt; unsigned char* act; const float* bgu; const int* list; const float* sa; const float* sw; MoeTab tab; int G, vcu;
    __device__ __forceinline__ bool next(int i, Unit& u) const { return tab.find_i(i, u); }
    __device__ __forceinline__ void a_offs(const Unit& u, const int (&R)[2], const int (&C2)[2], unsigned (&v)[2][2]) const {
#pragma unroll
        for (int h = 0; h < 2; ++h)
#pragma unroll
            for (int i = 0; i < 2; ++i) { int r = h * 128 + R[i]; r = r < u.cnt ? r : 0; const int a = list[(size_t)u.e * T_ + u.m0 + r]; v[h][i] = (unsigned)(a >> 2) * 2048u + (unsigned)C2[i]; } }
    __device__ __forceinline__ const char* a_base() const { return (const char*)A; }
    __device__ __forceinline__ const char* b_base(const Unit& u) const { return (const char*)(Bt + ((size_t)u.e * 4096 + u.n0) * 2048); }
    __device__ __forceinline__ void epi(const i32x4 (&acc)[2][2][4][2], const Unit& u, int wr, int wc, int fr, int fq, LAS unsigned char* lds) const {
        const float* bb = bgu + (size_t)u.e * 4096; const float* ss = sw + (size_t)u.e * 4096;
        LAS unsigned char* ep = lds + EP_OFF + wr * EP_GRP;
        const int tg = ep_tid() & 255, rrow = tg >> 4, ch = tg & 15;
        f32x4 b0[2], b1[2], s0[2], s1[2];
#pragma unroll
        for (int bj = 0; bj < 2; ++bj) { const int col = u.n0 + bj * 128 + wc * 32 + fq * 8;
            b0[bj] = *(const f32x4*)(bb + col); b1[bj] = *(const f32x4*)(bb + col + 4); s0[bj] = *(const f32x4*)(ss + col); s1[bj] = *(const f32x4*)(ss + col + 4); }
        float srv[8];
        { int av[8];
#pragma unroll
          for (int q = 0; q < 8; ++q) { const int rl = (q >> 2) * 128 + wr * 64 + (q & 3) * 16 + fr; av[q] = list[(size_t)u.e * T_ + u.m0 + (rl < u.cnt ? rl : 0)]; }
#pragma unroll
          for (int q = 0; q < 8; ++q) srv[q] = sa[av[q] >> 2]; }
        LAS unsigned char* ep2 = lds + EP_OFF + wr * (2 * 4608);
#define GU_WRITE(st) do { const int ai_ = (st) >> 1, mp_ = (st) & 1; LAS unsigned char* eb = ep2 + ((st) & 1) * 4608; \
            _Pragma("unroll") for (int mm = 0; mm < 2; ++mm) { const int m_ = mp_ * 2 + mm; const float sr = srv[ai_ * 4 + m_]; \
                _Pragma("unroll") for (int bj = 0; bj < 2; ++bj) { const i32x4 i0 = acc[ai_][bj][m_][0], i1 = acc[ai_][bj][m_][1]; \
                    const f32x4 v0 = (f32x4){(float)i0[0], (float)i0[1], (float)i0[2], (float)i0[3]} * (s0[bj] * sr) + b0[bj], v1 = (f32x4){(float)i1[0], (float)i1[1], (float)i1[2], (float)i1[3]} * (s1[bj] * sr) + b1[bj]; \
                    *(LAS unsigned*)(eb + (mm * 16 + fr) * 144 + (bj * 64 + wc * 16 + fq * 4)) = pk4_fp8(swiglu_fast(v0[0], v0[1]), swiglu_fast(v0[2], v0[3]), swiglu_fast(v1[0], v1[1]), swiglu_fast(v1[2], v1[3])); } } } while (0)
        GU_WRITE(0);
        ep_sync();
#pragma unroll
        for (int st = 0; st < 4; ++st) {
            if (st + 1 < 4) GU_WRITE(st + 1);
#pragma unroll
            for (int mm = 0; mm < 2; ++mm) { const u32x2 x0 = *(const LAS u32x2*)(ep2 + (st & 1) * 4608 + (mm * 16 + rrow) * 144 + ch * 8);
                const int rr = (st >> 1) * 128 + wr * 64 + ((st & 1) * 2 + mm) * 16 + rrow;
                if (rr < u.cnt) *(u32x2*)(act + (size_t)(u.rbase + u.m0 + rr) * 2048 + (u.n0 >> 1) + ch * 8) = x0; }
            ep_sync();
        }
#undef GU_WRITE
    }
};
struct ProbDn {
    static constexpr int NT = 16; static constexpr size_t KS2 = 256; static constexpr unsigned ROWB = 2048; static constexpr bool I8 = true;
    static constexpr bool PERM = true;
    const signed char* A; const signed char* Bt; unsigned char* y; const float* bdn; const int* list; const float* gate; const float* sa; const float* sw; MoeTab tab; int G, vcu;
    __device__ __forceinline__ bool next(int i, Unit& u) const { return tab.find_i(i, u); }
    __device__ __forceinline__ void a_offs(const Unit& u, const int (&R)[2], const int (&C2)[2], unsigned (&v)[2][2]) const {
#pragma unroll
        for (int h = 0; h < 2; ++h)
#pragma unroll
            for (int i = 0; i < 2; ++i) v[h][i] = (unsigned)(u.rbase + u.m0 + h * 128 + R[i]) * 2048u + (unsigned)C2[i]; }
    __device__ __forceinline__ const char* a_base() const { return (const char*)A; }
    __device__ __forceinline__ const char* b_base(const Unit& u) const { return (const char*)(Bt + ((size_t)u.e * 2048 + u.n0) * 2048); }
    __device__ __forceinline__ void epi(const i32x4 (&acc)[2][2][4][2], const Unit& u, int wr, int wc, int fr, int fq, LAS unsigned char* lds) const {
        const float* bb = bdn + (size_t)u.e * 2048; const float* ss = sw + (size_t)u.e * 2048;
        LAS unsigned char* ep = lds + EP_OFF + wr * (2 * 4352);
        const int tg = ep_tid() & 255, rrow = tg >> 4, ch = tg & 15;
        f32x4 b0[2], b1[2], s0[2], s1[2];
#pragma unroll
        for (int bj = 0; bj < 2; ++bj) { const int col = u.n0 + bj * 128 + wc * 32 + fq * 8;
            b0[bj] = *(const f32x4*)(bb + col); b1[bj] = *(const f32x4*)(bb + col + 4); s0[bj] = *(const f32x4*)(ss + col); s1[bj] = *(const f32x4*)(ss + col + 4); }
        float gv[8], srv[8]; int a2v[8];
        { int av[8];
#pragma unroll
          for (int q = 0; q < 8; ++q) { const int rl = (q >> 2) * 128 + wr * 64 + (q & 3) * 16 + fr, rc = rl < u.cnt ? rl : 0; av[q] = list[(size_t)u.e * T_ + u.m0 + rc]; srv[q] = sa[u.rbase + u.m0 + rc];
              const int rr = (q >> 2) * 128 + wr * 64 + (q & 3) * 16 + rrow; a2v[q] = list[(size_t)u.e * T_ + u.m0 + (rr < u.cnt ? rr : 0)]; }
#pragma unroll
          for (int q = 0; q < 8; ++q) gv[q] = gate[av[q]]; }
#define DN_WRITE(st) do { const int ai_ = (st) >> 2, m_ = (st) & 3; const float g = gv[st] * 16.f, sr = srv[st]; LAS unsigned char* eb = ep + ((st) & 1) * 4352; \
            _Pragma("unroll") for (int bj = 0; bj < 2; ++bj) { const i32x4 i0 = acc[ai_][bj][m_][0], i1 = acc[ai_][bj][m_][1]; \
                const f32x4 v0 = ((f32x4){(float)i0[0], (float)i0[1], (float)i0[2], (float)i0[3]} * (s0[bj] * sr) + b0[bj]) * g, v1 = ((f32x4){(float)i1[0], (float)i1[1], (float)i1[2], (float)i1[3]} * (s1[bj] * sr) + b1[bj]) * g; \
                u32x2 o; o[0] = pk4_fp8(__builtin_amdgcn_fmed3f(v0[0], -440.f, 440.f), __builtin_amdgcn_fmed3f(v0[1], -440.f, 440.f), __builtin_amdgcn_fmed3f(v0[2], -440.f, 440.f), __builtin_amdgcn_fmed3f(v0[3], -440.f, 440.f)); o[1] = pk4_fp8(__builtin_amdgcn_fmed3f(v1[0], -440.f, 440.f), __builtin_amdgcn_fmed3f(v1[1], -440.f, 440.f), __builtin_amdgcn_fmed3f(v1[2], -440.f, 440.f), __builtin_amdgcn_fmed3f(v1[3], -440.f, 440.f)); \
                *(LAS u32x2*)(eb + fr * 272 + (bj * 128 + wc * 32 + fq * 8)) = o; } } while (0)
        DN_WRITE(0);
        ep_sync();
#pragma unroll
        for (int st = 0; st < 8; ++st) {
            if (st + 1 < 8) DN_WRITE(st + 1);
            const int rr = (st >> 2) * 128 + wr * 64 + (st & 3) * 16 + rrow;
            const u32x4 x0 = *(const LAS u32x4*)(ep + (st & 1) * 4352 + rrow * 272 + ch * 16);
            if (rr < u.cnt) *(u32x4*)(y + (size_t)a2v[st] * 2048 + u.n0 + ch * 16) = x0;
            ep_sync();
        }
#undef DN_WRITE
    }
};
}

namespace at8 {
typedef float f32x16 __attribute__((ext_vector_type(16)));
typedef short s16x4 __attribute__((ext_vector_type(4)));
typedef unsigned u32x4 __attribute__((ext_vector_type(4)));
constexpr int SHM_K = 64 * 128 * 2, SHM_V = 64 * 128 * 2, SLOT = SHM_K + SHM_V;
constexpr int NSLOT = 4;
constexpr int LDS_WS = NSLOT * SLOT;
constexpr int LDS_END = LDS_WS + 8 * 64 * 4;
constexpr float CEXP = ATT_SCALE * 1.4426950408889634f;
constexpr float THR_RAW = 8.f / ATT_SCALE;
#define AT_KSWZ(row, colB) ((row) * 256 + ((colB) ^ (((row) & 7) << 4)))
#define AT_SBAR() __builtin_amdgcn_sched_barrier(0)
__device__ __forceinline__ int crow(int r, int hi) { return (r & 3) + 8 * (r >> 2) + 4 * hi; }
__device__ __forceinline__ unsigned cvtpk(float lo, float hi) { auto v = __builtin_amdgcn_cvt_pkrtz(lo, hi); return *reinterpret_cast<unsigned*>(&v); }
__device__ __forceinline__ int v_st(int k, int c) { const int kk = (k & ~0xC) | ((k & 4) << 1) | ((k & 8) >> 1); return ((kk >> 3) * 4 + (c >> 5)) * 512 + ((kk & 7) * 32 + (c & 31)) * 2; }
__device__ __forceinline__ int v_rd_base(int lane) { return ((lane & 3) << 3) | (((lane >> 2) & 3) << 6) | (((lane >> 4) & 1) << 5) | (((lane >> 5) & 1) << 8); }
constexpr int v_rd_off(int d0, int ks, int half) { return d0 * 512 + ks * 4096 + half * 2048; }
template <int OFF> __device__ __forceinline__ s16x4 tr_read(int vb) { s16x4 r; asm volatile("ds_read_b64_tr_b16 %0, %1 offset:%2" : "=&v"(r) : "v"(vb), "i"(OFF) : "memory"); return r; }
__device__ __forceinline__ h8 mk8(s16x4 l, s16x4 h) { typedef short s16x8 __attribute__((ext_vector_type(8))); s16x8 w = {l[0], l[1], l[2], l[3], h[0], h[1], h[2], h[3]}; return *reinterpret_cast<h8*>(&w); }
template <int D0> __device__ __forceinline__ void pv_one(f32x16& od, int vb, h8 pa0, h8 pa1, h8 pa2, h8 pa3) {
    const s16x4 l0 = tr_read<v_rd_off(D0, 0, 0)>(vb), h0 = tr_read<v_rd_off(D0, 0, 1)>(vb), l1 = tr_read<v_rd_off(D0, 1, 0)>(vb), h1 = tr_read<v_rd_off(D0, 1, 1)>(vb);
    const s16x4 l2 = tr_read<v_rd_off(D0, 2, 0)>(vb), h2 = tr_read<v_rd_off(D0, 2, 1)>(vb), l3 = tr_read<v_rd_off(D0, 3, 0)>(vb), h3 = tr_read<v_rd_off(D0, 3, 1)>(vb);
    asm volatile("s_waitcnt lgkmcnt(0)" ::: "memory"); AT_SBAR();
    od = __builtin_amdgcn_mfma_f32_32x32x16_f16(pa0, mk8(l0, h0), od, 0, 0, 0);
    od = __builtin_amdgcn_mfma_f32_32x32x16_f16(pa1, mk8(l1, h1), od, 0, 0, 0);
    od = __builtin_amdgcn_mfma_f32_32x32x16_f16(pa2, mk8(l2, h2), od, 0, 0, 0);
    od = __builtin_amdgcn_mfma_f32_32x32x16_f16(pa3, mk8(l3, h3), od, 0, 0, 0);
}
__device__ __forceinline__ void pv_d0(f32x16 (&o)[4], int vb, h8 pa0, h8 pa1, h8 pa2, h8 pa3) {
    pv_one<0>(o[0], vb, pa0, pa1, pa2, pa3); pv_one<1>(o[1], vb, pa0, pa1, pa2, pa3); pv_one<2>(o[2], vb, pa0, pa1, pa2, pa3); pv_one<3>(o[3], vb, pa0, pa1, pa2, pa3);
}
__device__ __forceinline__ void qkt(f32x16& p0, f32x16& p1, const char* Ks, const h8 (&qr)[8], int r32, int hi) {
    p0 = f32x16{}; p1 = f32x16{};
#pragma unroll
    for (int d0 = 0; d0 < 8; ++d0) { const int cb = (d0 * 16 + hi * 8) * 2;
        const h8 b0 = *reinterpret_cast<const h8*>(Ks + AT_KSWZ(r32, cb));
        const h8 b1 = *reinterpret_cast<const h8*>(Ks + AT_KSWZ(32 + r32, cb));
        p0 = __builtin_amdgcn_mfma_f32_32x32x16_f16(b0, qr[d0], p0, 0, 0, 0);
        p1 = __builtin_amdgcn_mfma_f32_32x32x16_f16(b1, qr[d0], p1, 0, 0, 0); }
}
__device__ __forceinline__ void pack_p(const f32x16& p0, const f32x16& p1, h8& pa0, h8& pa1, h8& pa2, h8& pa3) {
#define AT_PK4(P, BASE, OUT) do { unsigned a0 = cvtpk(P[BASE + 0], P[BASE + 1]), a1 = cvtpk(P[BASE + 2], P[BASE + 3]); \
    unsigned b0 = cvtpk(P[BASE + 4], P[BASE + 5]), b1 = cvtpk(P[BASE + 6], P[BASE + 7]); \
    auto r0 = __builtin_amdgcn_permlane32_swap(a0, b0, false, false); auto r1 = __builtin_amdgcn_permlane32_swap(a1, b1, false, false); \
    u32x4 w = {r0[0], r1[0], r0[1], r1[1]}; OUT = *reinterpret_cast<h8*>(&w); } while (0)
    AT_PK4(p0, 0, pa0); AT_PK4(p0, 8, pa1); AT_PK4(p1, 0, pa2); AT_PK4(p1, 8, pa3);
#undef AT_PK4
}
__device__ __forceinline__ float half_swap_max(float v) { auto rr = __builtin_amdgcn_permlane32_swap(__float_as_uint(v), __float_as_uint(v), false, false); return fmaxf(__uint_as_float(rr[0]), __uint_as_float(rr[1])); }
__device__ __forceinline__ float half_swap_sum(float v) { auto rr = __builtin_amdgcn_permlane32_swap(__float_as_uint(v), __float_as_uint(v), false, false); return __uint_as_float(rr[0]) + __uint_as_float(rr[1]); }

__device__ __forceinline__ int hidden_tid() { int tz = threadIdx.x; asm volatile("" : "+v"(tz)); return tz; }
__device__ __forceinline__ void dma_offsets(int ld, int (&ko)[2], int (&vo)[2]) {
    const int tz = hidden_tid(), w = tz >> 6, l = tz & 63;
#pragma unroll
    for (int q = 0; q < 2; ++q) {
        const int rr = 4 * (2 * w + q) + (l >> 4), pp = l & 15;
        ko[q] = rr * ld + ((pp ^ (rr & 7)) * 8);
        const int L = (2 * w + q) * 1024 + l * 16, sidx = L >> 9, o = L & 511;
        const int kk = (sidx >> 2) * 8 + (o >> 6), c = (sidx & 3) * 32 + ((o & 63) >> 1);
        const int k = (kk & ~0xC) | ((kk & 4) << 1) | ((kk & 8) >> 1);
        vo[q] = k * ld + c;
    }
}
__device__ __forceinline__ void dma_tile(char* slot, const _Float16* Kb, const _Float16* Vb, int ld, int tile, const int (&ko)[2], const int (&vo)[2], int wid) {
    const _Float16* kt = Kb + (size_t)tile * 64 * ld; const _Float16* vt = Vb + (size_t)tile * 64 * ld;
#pragma unroll
    for (int q = 0; q < 2; ++q) __builtin_amdgcn_global_load_lds((const unsigned*)(kt + ko[q]), (LAS unsigned*)(slot + (2 * wid + q) * 1024), 16, 0, 0);
#pragma unroll
    for (int q = 0; q < 2; ++q) __builtin_amdgcn_global_load_lds((const unsigned*)(vt + vo[q]), (LAS unsigned*)(slot + SHM_K + (2 * wid + q) * 1024), 16, 0, 0);
}
#define AT_WAITV(n) asm volatile("s_waitcnt vmcnt(" #n ")" ::: "memory")
#define AT_BAR() do { asm volatile("s_waitcnt lgkmcnt(0)" ::: "memory"); __builtin_amdgcn_s_barrier(); asm volatile("" ::: "memory"); } while (0)

__device__ __forceinline__ void attn_unit(char* lds, const _Float16* qrow, const _Float16* Kb, const _Float16* Vb, int ld, unsigned tmask, int wlen, int khi, unsigned selmask,
                                          _Float16* outw, int ostride) {
    const int tid = threadIdx.x, wid = __builtin_amdgcn_readfirstlane(tid >> 6), lane = tid & 63, r32 = lane & 31, hi = lane >> 5;
    float* wsf = (float*)(lds + LDS_WS) + wid * 64; float* li_l = wsf; float* al_l = wsf + 32;
    float m_reg = -1e30f, l_reg = 0.f; f32x16 o[4] = {}; h8 qr[8];
#pragma unroll
    for (int d0 = 0; d0 < 8; ++d0) qr[d0] = *(const h8*)(qrow + d0 * 16);
    int ko[2], vo[2]; dma_offsets(ld, ko, vo);
    const int vbase = (int)(uintptr_t)lds + SHM_K + v_rd_base(lane);
    unsigned rest = tmask; int j = __ffs(rest) - 1; rest &= rest - 1;
    int j1 = rest ? (__ffs(rest) - 1) : -1; if (j1 >= 0) rest &= rest - 1;
    dma_tile(lds, Kb, Vb, ld, j, ko, vo, wid);
    if (j1 >= 0) { dma_tile(lds + SLOT, Kb, Vb, ld, j1, ko, vo, wid); AT_WAITV(4); } else { AT_WAITV(0); }
    AT_BAR();
    int so = 0, sp = 0;
    const bool roleB = wid >= 4;
    bool first = true;
    h8 pa0, pa1, pa2, pa3;
    for (;;) {
        const int j2 = rest ? (__ffs(rest) - 1) : -1;
        if (j2 >= 0) { rest &= rest - 1; int s2 = so + 2 * SLOT; s2 = s2 >= NSLOT * SLOT ? s2 - NSLOT * SLOT : s2; dma_tile(lds + s2, Kb, Vb, ld, j2, ko, vo, wid); }
        if (roleB && !first) { AT_SBAR(); pv_d0(o, vbase + sp, pa0, pa1, pa2, pa3); }
        f32x16 p0, p1;
        AT_SBAR(); qkt(p0, p1, lds + so, qr, r32, hi);
        { const int klo = wlen > 0 ? khi - wlen + 1 : 0; const bool tb = (selmask >> j) & 1u; const bool inr = (j * 64 >= klo) && (j * 64 + 63 <= khi);
          if (!__all(tb && inr)) {
              if (__all(inr)) {
#pragma unroll
                  for (int r = 0; r < 16; ++r) { p0[r] = tb ? p0[r] : -INFINITY; p1[r] = tb ? p1[r] : -INFINITY; }
              } else {
                  const int kb = j * 64 + 4 * hi;
#pragma unroll
                  for (int r = 0; r < 16; ++r) { const int k0 = kb + (r & 3) + 8 * (r >> 2);
                      p0[r] = (tb && k0 >= klo && k0 <= khi) ? p0[r] : -INFINITY;
                      p1[r] = (tb && (k0 + 32) >= klo && (k0 + 32) <= khi) ? p1[r] : -INFINITY; }
              } } }
        float pmax = p0[0];
#pragma unroll
        for (int r = 1; r < 16; ++r) pmax = fmaxf(pmax, p0[r]);
#pragma unroll
        for (int r = 0; r < 16; ++r) pmax = fmaxf(pmax, p1[r]);
        pmax = half_swap_max(pmax);
        float mn, alpha;
        if (__all(pmax - m_reg <= THR_RAW)) { mn = m_reg; alpha = 1.f; }
        else { mn = fmaxf(m_reg, pmax); alpha = __builtin_amdgcn_exp2f((m_reg - mn) * CEXP); m_reg = mn; }
        const float mnC = -mn * CEXP;
        float ps = 0.f;
#pragma unroll
        for (int r = 0; r < 16; ++r) { p0[r] = __builtin_amdgcn_exp2f(fmaf(p0[r], CEXP, mnC)); ps += p0[r]; }
#pragma unroll
        for (int r = 0; r < 16; ++r) { p1[r] = __builtin_amdgcn_exp2f(fmaf(p1[r], CEXP, mnC)); ps += p1[r]; }
        ps = half_swap_sum(ps);
        l_reg = l_reg * alpha + ps;
        if (__any(alpha < 1.f)) { if (hi == 0) al_l[r32] = alpha; asm volatile("s_waitcnt lgkmcnt(0)" ::: "memory");
#pragma unroll
            for (int r = 0; r < 16; ++r) { const float a = al_l[crow(r, hi)];
#pragma unroll
                for (int d = 0; d < 4; ++d) o[d][r] *= a; } }
        pack_p(p0, p1, pa0, pa1, pa2, pa3);
        AT_SBAR();
        if (!roleB) pv_d0(o, vbase + so, pa0, pa1, pa2, pa3);
        if (j1 < 0) break;
        if (j2 >= 0) { AT_WAITV(4); } else { AT_WAITV(0); }
        AT_BAR();
        j = j1; j1 = j2; sp = so; so += SLOT; so = so >= NSLOT * SLOT ? so - NSLOT * SLOT : so; first = false;
    }
    if (roleB) { AT_SBAR(); pv_d0(o, vbase + so, pa0, pa1, pa2, pa3); }
    if (hi == 0) li_l[r32] = l_reg; asm volatile("s_waitcnt lgkmcnt(0)" ::: "memory");
#pragma unroll
    for (int r = 0; r < 16; ++r) { const int orow = crow(r, hi); const float l = li_l[orow]; const float rl = l > 0.f ? 1.f / l : 0.f;
#pragma unroll
        for (int d0 = 0; d0 < 4; ++d0) outw[(size_t)orow * ostride + d0 * 32 + r32] = (_Float16)(o[d0][r] * rl); }
    __syncthreads();
}

constexpr int LDS_AP = 0, LDS_BP = LDS_AP + 4 * 64 * 33 * 4, LDS_SELM = LDS_END, LDS_CS_END = LDS_SELM + 64 * 4;
static_assert(LDS_BP + 4 * 64 * 33 * 4 <= NSLOT * SLOT, "importance partials must fit inside the ring");
__device__ __forceinline__ void cmp_slc_unit(char* lds, const _Float16* qrow, const _Float16* Kc, const _Float16* Vc, const _Float16* Ks, const _Float16* Vs, int t, int tl, int g, int qi,
                                             _Float16* outc, _Float16* outs) {
    const int tid = threadIdx.x, wid = __builtin_amdgcn_readfirstlane(tid >> 6), lane = tid & 63, r32 = lane & 31, hi = lane >> 5;
    float* AP = (float*)(lds + LDS_AP); float* BP = (float*)(lds + LDS_BP); unsigned* selm = (unsigned*)(lds + LDS_SELM);
    {
        h8 qr[8];
#pragma unroll
        for (int d0 = 0; d0 < 8; ++d0) qr[d0] = *(const h8*)(qrow + d0 * 16);
        const int vb0 = (int)(uintptr_t)lds + SHM_K + v_rd_base(lane);
        { int ko[2], vo[2]; dma_offsets(256, ko, vo);
          dma_tile(lds, Kc, Vc, 256, 0, ko, vo, wid); dma_tile(lds + SLOT, Kc, Vc, 256, 1, ko, vo, wid); }
        AT_WAITV(0); AT_BAR();
        f32x16 pA0, pA1, pB0, pB1;
        AT_SBAR(); qkt(pA0, pA1, lds, qr, r32, hi); qkt(pB0, pB1, lds + SLOT, qr, r32, hi);
        const int khi = t >= 31 ? ((t - 31) >> 4) : -1;
#pragma unroll
        for (int r = 0; r < 16; ++r) { const int c0 = 4 * hi + (r & 3) + 8 * (r >> 2);
            pA0[r] = (c0 <= khi) ? pA0[r] : -INFINITY; pA1[r] = (c0 + 32 <= khi) ? pA1[r] : -INFINITY;
            pB0[r] = (c0 + 64 <= khi) ? pB0[r] : -INFINITY; pB1[r] = (c0 + 96 <= khi) ? pB1[r] : -INFINITY; }
        float pmax = -INFINITY;
#pragma unroll
        for (int r = 0; r < 16; ++r) pmax = fmaxf(fmaxf(pmax, pA0[r]), fmaxf(pA1[r], fmaxf(pB0[r], pB1[r])));
        pmax = half_swap_max(pmax);
        const float mC = (pmax == -INFINITY) ? 0.f : -pmax * CEXP;
        float ps = 0.f;
#pragma unroll
        for (int r = 0; r < 16; ++r) { pA0[r] = __builtin_amdgcn_exp2f(fmaf(pA0[r], CEXP, mC)); pA1[r] = __builtin_amdgcn_exp2f(fmaf(pA1[r], CEXP, mC));
            pB0[r] = __builtin_amdgcn_exp2f(fmaf(pB0[r], CEXP, mC)); pB1[r] = __builtin_amdgcn_exp2f(fmaf(pB1[r], CEXP, mC)); ps += (pA0[r] + pA1[r]) + (pB0[r] + pB1[r]); }
        ps = half_swap_sum(ps);
        const float inv = ps > 0.f ? 1.f / ps : 0.f;
#pragma unroll
        for (int r = 0; r < 16; ++r) { pA0[r] *= inv; pA1[r] *= inv; pB0[r] *= inv; pB1[r] *= inv; }
        f32x16 o[4] = {};
        h8 pa0, pa1, pa2, pa3;
        pack_p(pA0, pA1, pa0, pa1, pa2, pa3); AT_SBAR(); pv_d0(o, vb0, pa0, pa1, pa2, pa3);
        pack_p(pB0, pB1, pa0, pa1, pa2, pa3); AT_SBAR(); pv_d0(o, vb0 + SLOT, pa0, pa1, pa2, pa3);
#pragma unroll
        for (int r = 0; r < 16; ++r) { const int orow = crow(r, hi);
#pragma unroll
            for (int d0 = 0; d0 < 4; ++d0) outc[(size_t)orow * 1024 + d0 * 32 + r32] = (_Float16)o[d0][r]; }
        __syncthreads();
        { float* ap = AP + (g * 64 + tl) * 33; float* bp = BP + (g * 64 + tl) * 33;
          if (hi == 0) bp[0] = 0.f;
#define AT_IMP(P, JB) do { _Pragma("unroll") for (int k = 0; k < 4; ++k) { const int j = (JB) + 2 * k + hi; \
              ap[j] = 2.f * (P[4 * k] + P[4 * k + 1] + P[4 * k + 2]) + P[4 * k + 3]; if (j + 1 < 32) bp[j + 1] = P[4 * k + 3]; } } while (0)
          AT_IMP(pA0, 0); AT_IMP(pA1, 8); AT_IMP(pB0, 16); AT_IMP(pB1, 24);
#undef AT_IMP
        }
    }
    __syncthreads();
#pragma unroll 1
    for (int it = 0; it < 4; ++it) {
        const int tk = 8 * wid + 2 * it + hi, j = r32;
        float imp = 0.f;
#pragma unroll
        for (int gg = 0; gg < 4; ++gg) imp += AP[(gg * 64 + tk) * 33 + j] + BP[(gg * 64 + tk) * 33 + j];
        const bool forced = (j == 0) || (j == qi) || (j == qi - 1), valid = j <= qi;
        const float iv = forced ? 1e9f : (valid ? imp : -1e9f);
        int rank = 0;
        for (int i = 0; i < 32; ++i) { const float vi = __shfl(iv, i + 32 * hi); rank += (vi > iv || (vi == iv && i < j)) ? 1 : 0; }
        const unsigned long long bal = __ballot(rank < 16 && valid);
        if (r32 == 0) selm[tk] = (unsigned)(bal >> (32 * hi));
    }
    __syncthreads();
    unsigned tm = selm[lane];
#pragma unroll
    for (int o = 32; o > 0; o >>= 1) tm |= __shfl_xor(tm, o);
    const int tz2 = hidden_tid();
    const unsigned mysel = selm[((tz2 >> 6) & 1) * 32 + (tz2 & 31)];
    attn_unit(lds, qrow, Ks, Vs, 128, tm, 0, t, mysel, outs, 1024);
}
}

struct CUnit { const float* W; int ldw; int nvalid; _Float16* Wt; int k0; int n0; };
__device__ __forceinline__ CUnit conv_desc(int u, const float* win, const float* w1k, const float* w1v, const float* wmkv, _Float16* wtin, _Float16* wt1, _Float16* wtmkv) {
    CUnit d;
    if (u < 160) { d.W = win; d.ldw = INW; d.nvalid = INW; d.Wt = wtin; d.k0 = (u / 5) * 64; d.n0 = (u % 5) * 256; }
    else if (u < 288) { const int v = u - 160, kv = v >> 6, part = (v >> 5) & 1, kt = v & 31;
        d.W = (kv ? w1v : w1k) + (size_t)part * 2048 * 256; d.ldw = 256; d.nvalid = 256; d.Wt = wt1 + ((size_t)kv * 512 + part * 256) * 2048; d.k0 = kt * 64; d.n0 = 0; }
    else { d.W = wmkv; d.ldw = 1024; d.nvalid = 1024; d.Wt = wtmkv; d.k0 = 0; d.n0 = 0; }
    return d;
}
__device__ __forceinline__ void conv_all(float* lds, const float* win, const float* w1k, const float* w1v, const float* wmkv, _Float16* wtin, _Float16* wt1, _Float16* wtmkv, int bid, int nb) {
    constexpr int NU = 160 + 128;
    const int tid = threadIdx.x;
    int u = bid; if (u >= NU) return;
    CUnit d = conv_desc(u, win, w1k, w1v, wmkv, wtin, wt1, wtmkv);
    float4 v[8];
#define CL(D) do { _Pragma("unroll") for (int i = 0; i < 8; ++i) { const int idx = tid + 512 * i, r = idx >> 6, c4 = (idx & 63) * 4; \
        v[i] = ((D).n0 + c4 < (D).nvalid) ? *(const float4*)((D).W + (size_t)((D).k0 + r) * (D).ldw + (D).n0 + c4) : make_float4(0.f, 0.f, 0.f, 0.f); } } while (0)
    CL(d);
    for (;;) {
#pragma unroll
        for (int i = 0; i < 8; ++i) { const int idx = tid + 512 * i, r = idx >> 6, c4 = (idx & 63) * 4; float* dd = lds + r * 257 + c4; dd[0] = v[i].x; dd[1] = v[i].y; dd[2] = v[i].z; dd[3] = v[i].w; }
        __syncthreads();
        const int un = u + nb; const bool has = un < NU;
        CUnit dn = d; if (has) { dn = conv_desc(un, win, w1k, w1v, wmkv, wtin, wt1, wtmkv); CL(dn); }
#pragma unroll
        for (int j = 0; j < 4; ++j) { const int id = tid + 512 * j, n = id >> 3, k8 = (id & 7) * 8; h8 o;
#pragma unroll
            for (int q = 0; q < 8; ++q) o[q] = (_Float16)lds[(k8 + q) * 257 + n];
            *(h8*)(d.Wt + (size_t)(d.n0 + n) * 2048 + d.k0 + k8) = o; }
        __syncthreads();
        if (!has) break;
        u = un; d = dn;
    }
#undef CL
}

__device__ __forceinline__ unsigned pack4_i8(float a, float b, float c, float d) {
    const int ia = __float2int_rn(a), ib = __float2int_rn(b), ic = __float2int_rn(c), id = __float2int_rn(d);
    return (unsigned)(ia & 255) | ((unsigned)(ib & 255) << 8) | ((unsigned)(ic & 255) << 16) | ((unsigned)(id & 255) << 24);
}
constexpr int QP_LD2 = 1026;
struct QUnit { const float* W; int ldw; int n0; signed char* Q; float* sc; int nvalid; };
struct QExtra { const float* win; signed char* q8in; float* sin8; const float* wmkv; signed char* q8mkv; float* smkv; };
__device__ __forceinline__ QUnit quant_desc(int u, const float* wgu, const float* wdn, signed char* q8gu, signed char* q8dn, float* sgu, float* sdn, const float* wout, signed char* q8out, float* sout, const QExtra& x) {
    QUnit d; d.nvalid = 1 << 30;
    if (u >= NE * 192 + 64 + 73) { const int pn = u - (NE * 192 + 64 + 73); d.W = x.wmkv; d.ldw = 1024; d.n0 = pn * 32; d.Q = x.q8mkv; d.sc = x.smkv; }
    else if (u >= NE * 192 + 64) { const int pn = u - (NE * 192 + 64); d.W = x.win; d.ldw = INW; d.n0 = 1280 + pn * 32; d.Q = x.q8in - (size_t)1280 * 2048; d.sc = x.sin8 - 1280; d.nvalid = INW; }
    else if (u >= NE * 192) { const int pn = u - NE * 192; d.W = wout; d.ldw = 2048; d.n0 = pn * 32; d.Q = q8out; d.sc = sout; }
    else if (u < NE * 128) { const int e = u >> 7, pn = u & 127; d.W = wgu + (size_t)e * 2048 * 4096; d.ldw = 4096; d.n0 = pn * 32; d.Q = q8gu + (size_t)e * 4096 * 2048; d.sc = sgu + (size_t)e * 4096; }
    else { const int v = u - NE * 128, e = v >> 6, pn = v & 63; d.W = wdn + (size_t)e * 2048 * 2048; d.ldw = 2048; d.n0 = pn * 32; d.Q = q8dn + (size_t)e * 2048 * 2048; d.sc = sdn + (size_t)e * 2048; }
    return d;
}
__device__ __forceinline__ unsigned pk2h(float a, float b) { auto v = __builtin_amdgcn_cvt_pkrtz(a, b); return *reinterpret_cast<unsigned*>(&v); }
__device__ __forceinline__ void quant_all(char* smem, const float* wgu, const float* wdn, signed char* q8gu, signed char* q8dn, float* sgu, float* sdn, const float* wout, signed char* q8out, float* sout, const QExtra& qx, int bid, int nb) {
    constexpr int NU = NE * 128 + NE * 64 + 64 + 73 + 32;
    unsigned* cmaxb = (unsigned*)smem;
    const int tid = threadIdx.x, c4 = (tid & 7) * 4, rg = tid >> 3;
    if (tid < 64) cmaxb[tid] = 0u;
    __syncthreads();
    int u = bid; if (u >= NU) return;
    QUnit d = quant_desc(u, wgu, wdn, q8gu, q8dn, sgu, sdn, wout, q8out, sout, qx);
    float4 va[16], vb[16], vc[16];
#define QL(dst, D, half) do { const float* p0 = (D).W + (size_t)((half) * 1024 + rg * 16) * (D).ldw + (D).n0 + c4; const bool okc = (D).n0 + c4 < (D).nvalid; _Pragma("unroll") for (int j = 0; j < 16; ++j) dst[j] = okc ? *(const float4*)(p0 + (size_t)j * (D).ldw) : make_float4(0.f, 0.f, 0.f, 0.f); } while (0)
#define QM(src) do { _Pragma("unroll") for (int j = 0; j < 16; ++j) { m0 = fmaxf(m0, fabsf(src[j].x)); m1 = fmaxf(m1, fabsf(src[j].y)); m2 = fmaxf(m2, fabsf(src[j].z)); m3 = fmaxf(m3, fabsf(src[j].w)); } } while (0)
#define QS(src, half, comp, ci, inv) do { uint4 o; \
        o.x = pack4_i8(src[0].comp * inv, src[1].comp * inv, src[2].comp * inv, src[3].comp * inv); o.y = pack4_i8(src[4].comp * inv, src[5].comp * inv, src[6].comp * inv, src[7].comp * inv); \
        o.z = pack4_i8(src[8].comp * inv, src[9].comp * inv, src[10].comp * inv, src[11].comp * inv); o.w = pack4_i8(src[12].comp * inv, src[13].comp * inv, src[14].comp * inv, src[15].comp * inv); \
        *(uint4*)(d.Q + (size_t)(d.n0 + c4 + (ci)) * 2048 + (half) * 1024 + rg * 16) = o; } while (0)
    QL(va, d, 0);
    int par = 0;
    for (;;) {
        unsigned* cmax = cmaxb + par * 32;
        float m0 = 0.f, m1 = 0.f, m2 = 0.f, m3 = 0.f;
        QL(vb, d, 1);
        QM(va); QM(vb);
        atomicMax(&cmax[c4 + 0], __float_as_uint(m0)); atomicMax(&cmax[c4 + 1], __float_as_uint(m1)); atomicMax(&cmax[c4 + 2], __float_as_uint(m2)); atomicMax(&cmax[c4 + 3], __float_as_uint(m3));
        __syncthreads();
        const int un = u + nb; const bool has = un < NU;
        QUnit dn = d; if (has) { dn = quant_desc(un, wgu, wdn, q8gu, q8dn, sgu, sdn, wout, q8out, sout, qx); QL(vc, dn, 0); }
        if (tid < 32) cmaxb[(par ^ 1) * 32 + tid] = 0u;
        const float x0 = __uint_as_float(cmax[c4 + 0]), x1 = __uint_as_float(cmax[c4 + 1]), x2 = __uint_as_float(cmax[c4 + 2]), x3 = __uint_as_float(cmax[c4 + 3]);
        const float i0 = x0 > 0.f ? 127.f / x0 : 0.f, i1 = x1 > 0.f ? 127.f / x1 : 0.f, i2 = x2 > 0.f ? 127.f / x2 : 0.f, i3 = x3 > 0.f ? 127.f / x3 : 0.f;
        QS(va, 0, x, 0, i0); QS(va, 0, y, 1, i1); QS(va, 0, z, 2, i2); QS(va, 0, w, 3, i3);
        QS(vb, 1, x, 0, i0); QS(vb, 1, y, 1, i1); QS(vb, 1, z, 2, i2); QS(vb, 1, w, 3, i3);
        if (tid < 32) { const float mx = __uint_as_float(cmax[tid]); d.sc[d.n0 + tid] = mx > 0.f ? mx / 127.f : 1.f; }
        if (!has) break;
#pragma unroll
        for (int j = 0; j < 16; ++j) va[j] = vc[j];
        u = un; d = dn; par ^= 1;
        __syncthreads();
    }
    __syncthreads();
#undef QL
#undef QM
#undef QS
}

__global__ void __launch_bounds__(512, 2) fwd(Params p) {
    extern __shared__ __attribute__((aligned(16))) char smem[];
    const int tid = threadIdx.x, wv = __builtin_amdgcn_readfirstlane(tid >> 6);
#define LANE_NOW ({ int _t = threadIdx.x; asm volatile("" : "+v"(_t)); _t & 63; })
    const int bid = blockIdx.x, nb = gridDim.x;
    const int gw = bid * 8 + wv, nw = nb * 8;
    const int lo = (int)(p.lo_hi & 0xffffffffll), hi = (int)(p.lo_hi >> 32);
    unsigned char* ws = p.ws;
    unsigned* ctl = (unsigned*)(ws + WS_CTL);
    int* cnt = (int*)(ws + CTL_CNT);
    float* proj = (float*)(ws + WS_PROJ);
    float* kvmem = (float*)(ws + WS_KVMEM);
    float* bias1 = (float*)(ws + WS_BIAS1);
    float* hid = (float*)(ws + WS_HID);
    float* kc = (float*)(ws + WS_KC);
    float* vc = (float*)(ws + WS_VC);
    float* pooled = (float*)(ws + WS_POOLED);
    _Float16* opool = (_Float16*)(ws + WS_OPOOL);
    _Float16* owin = (_Float16*)(ws + WS_OWIN);
    _Float16* ocmp = (_Float16*)(ws + WS_OCMP);
    _Float16* oslc = (_Float16*)(ws + WS_OSLC);
    unsigned* sel = (unsigned*)(ws + WS_SEL);
    _Float16* omem = (_Float16*)(ws + WS_OMEM);
    _Float16* cat16 = (_Float16*)(ws + WS_CAT16);
    _Float16* hpre16 = (_Float16*)(ws + WS_HPRE);
    float* hbuf = (float*)(ws + WS_H);
    float* gate = (float*)(ws + WS_GATE);
    int* list = (int*)(ws + WS_LIST);
    unsigned char* actf8 = (unsigned char*)(ws + WS_ACT16);
    unsigned char* yf8 = (unsigned char*)(ws + WS_Y16);
    _Float16* h16 = (_Float16*)(ws + WS_H16);
    _Float16* x16 = (_Float16*)(ws + WS_X16);
    _Float16* wtin = (_Float16*)(ws + WS_WTIN);
    _Float16* wtout = (_Float16*)(ws + WS_WTOUT);
    _Float16* wtgu = (_Float16*)(ws + WS_WTGU);
    _Float16* wtdn = (_Float16*)(ws + WS_WTDN);
    LAS unsigned char* lds = (LAS unsigned char*)smem;
    _Float16* proj16 = (_Float16*)(ws + WS_PROJ16);
    _Float16* kvmem16 = (_Float16*)(ws + WS_KVMEM16);
    _Float16* wt1 = (_Float16*)(ws + WS_WT1);
    float* uv = (float*)(ws + WS_UV);
    _Float16* kc16 = (_Float16*)(ws + WS_KC16);
    _Float16* vc16 = (_Float16*)(ws + WS_VC16);
    _Float16* wr16 = (_Float16*)(ws + WS_WR16);
    _Float16* mem16 = (_Float16*)(ws + WS_MEM16);
    _Float16* wtmkv = (_Float16*)(ws + WS_WTMKV);
    _Float16* kv16 = (_Float16*)(ws + WS_KV16);
    _Float16* wt2 = (_Float16*)(ws + WS_WT2);
    signed char* x8 = (signed char*)(ws + WS_X8); float* sxa = (float*)(ws + WS_SXA); signed char* q8in = (signed char*)(ws + WS_Q8IN); float* sin8 = (float*)(ws + WS_SIN8);
    signed char* q8mkv = (signed char*)(ws + WS_Q8MKV); float* smkv = (float*)(ws + WS_SMKV);
    signed char* q8out = (signed char*)(ws + WS_Q8OUT); float* sout = (float*)(ws + WS_SOUT); signed char* cat8 = (signed char*)(ws + WS_CAT8); float* scat = (float*)(ws + WS_SCAT);
    signed char* q8gu = (signed char*)(ws + WS_Q8GU); signed char* q8dn = (signed char*)(ws + WS_Q8DN);
    float* sgu = (float*)(ws + WS_SGU); float* sdn = (float*)(ws + WS_SDN);
    signed char* h8q = (signed char*)(ws + WS_H8); float* sah = (float*)(ws + WS_SAH);
    signed char* act8 = (signed char*)(ws + WS_ACT8); float* sact = (float*)(ws + WS_SACT);
    const int vcu = (nb % 8 == 0) ? (bid % 8) * (nb / 8) + bid / 8 : bid;

    volatile LAS unsigned* xbw = (volatile LAS unsigned*)(smem + LDS_BYTES - 16);
    if (tid == 0) { xbw[0] = 0u; xbw[1] = 0u; xbw[2] = 0u; xbw[3] = 0u; }
    __syncthreads();
    XcdBarrier bar; bar.bar = ctl; bar.x = 0; bar.st = xbw;
    const bool multi = (hi - lo) > 1;
    if (multi) bar = xcd_barrier_post(ctl, xbw);
#define IN(k) (lo <= (k) && (k) < hi)
#define SEAM(k) do { if (IN(k) && IN((k) + 1)) xcd_barrier(bar); } while (0)
    float* sw = (float*)smem + wv * WLDS_FLOATS;
    int* segw = (int*)(sw + 4096 + 512);

    if (IN(0)) {
        const int lane = LANE_NOW; (void)lane;
        if (wv == 0 && (bid & 1) == 0 && (bid >> 1) < 128) {
            const int task = bid >> 1, kv = task >> 6, jg = (task >> 4) & 3, kc = task & 15;
            const float* pos = p.in[kv ? I_POSV : I_POSK] + kc * 256; const float* w1 = p.in[kv ? I_W1V : I_W1K] + (size_t)kc * 256 * 256 + jg * 64 + lane;
            float s0 = 0.f, s1 = 0.f, s2 = 0.f, s3 = 0.f;
            for (int k = 0; k < 256; k += 4) { s0 += pos[k] * w1[(size_t)k * 256]; s1 += pos[k + 1] * w1[(size_t)(k + 1) * 256]; s2 += pos[k + 2] * w1[(size_t)(k + 2) * 256]; s3 += pos[k + 3] * w1[(size_t)(k + 3) * 256]; }
            bias1[(kv * 16 + kc) * 256 + jg * 64 + lane] = (s0 + s1) + (s2 + s3);
        }
        for (int i = bid * 512 + tid; i < 2 * 128 * 256; i += nb * 512) { const int kv = i >> 15, d = (i >> 8) & 127, n = i & 255; wt2[i] = (_Float16)p.in[kv ? I_W2V : I_W2K][(size_t)n * 128 + d]; }
        for (int i = bid * 512 + tid; i < 32 * 2048; i += nb * 512) { const int e = i >> 11, d = i & 2047; wr16[i] = (_Float16)p.in[I_WR][(size_t)d * 32 + e]; }
        {
            for (int row0 = gw; row0 < T_ + 2048; row0 += nw * 2) {
                float4 raw[2][8];
#pragma unroll
                for (int i = 0; i < 2; ++i) { const int row = row0 + i * nw; const float* src = row < T_ ? p.in[I_X] + (size_t)row * 2048 : p.in[I_MEM] + (size_t)(row - T_) * 2048;
#pragma unroll
                    for (int c = 0; c < 4; ++c) { raw[i][2 * c] = make_float4(0.f, 0.f, 0.f, 0.f); raw[i][2 * c + 1] = raw[i][2 * c];
                        if (row < T_ + 2048) { raw[i][2 * c] = *(const float4*)(src + (lane + 64 * c) * 8); raw[i][2 * c + 1] = *(const float4*)(src + (lane + 64 * c) * 8 + 4); } } }
#pragma unroll
                for (int i = 0; i < 2; ++i) { const int row = row0 + i * nw;
                    float amax = 0.f;
#pragma unroll
                    for (int k = 0; k < 8; ++k) amax = fmaxf(amax, fmaxf(fmaxf(fabsf(raw[i][k].x), fabsf(raw[i][k].y)), fmaxf(fabsf(raw[i][k].z), fabsf(raw[i][k].w))));
                    amax = wave_max(amax);
                    if (row < T_ + 2048) {
                        const float qinv = amax > 0.f ? 127.f / amax : 0.f;
                        if (lane == 0) sxa[row] = amax > 0.f ? amax / 127.f : 1.f;
#pragma unroll
                        for (int c = 0; c < 4; ++c) { const float4 a = raw[i][2 * c], b2 = raw[i][2 * c + 1];
                            uint2 q; q.x = pack4_i8(a.x * qinv, a.y * qinv, a.z * qinv, a.w * qinv); q.y = pack4_i8(b2.x * qinv, b2.y * qinv, b2.z * qinv, b2.w * qinv);
                            *(uint2*)(x8 + (size_t)row * 2048 + (lane + 64 * c) * 8) = q;
                            if (row < T_) { h8 o; o[0] = (_Float16)a.x; o[1] = (_Float16)a.y; o[2] = (_Float16)a.z; o[3] = (_Float16)a.w; o[4] = (_Float16)b2.x; o[5] = (_Float16)b2.y; o[6] = (_Float16)b2.z; o[7] = (_Float16)b2.w;
                                *(h8*)(x16 + (size_t)row * 2048 + (lane + 64 * c) * 8) = o; } } }
                }
            }
        }
        {
            const QExtra qx{p.in[I_WIN], q8in, sin8, p.in[I_WMEMKV], q8mkv, smkv};
            quant_all(smem, p.in[I_WGU], p.in[I_WDN], q8gu, q8dn, sgu, sdn, p.in[I_WOUT], q8out, sout, qx, bid, nb);
            __syncthreads();
            conv_all((float*)smem, p.in[I_WIN], p.in[I_W1K], p.in[I_W1V], p.in[I_WMEMKV], wtin, wt1, wtmkv, bid, nb);
            __syncthreads();
        }
    }
    SEAM(0);
    if (IN(1)) {
        const int lane = LANE_NOW; (void)lane;
        { g8::ProbInF P{x16, proj16, nb, bid}; g8::gemm_phase(lds, P); }
        __syncthreads();
        { g8::ProbIn8 P{x8, proj16, sxa, nb, (bid + 192) & 255}; g8::gemm_phase(lds, P); }
    }
    SEAM(1);
    if (IN(2)) {
        const int lane = LANE_NOW; (void)lane;
        { g8::ProbCmp P{kv16, wt1, uv, nb, bid}; g8::gemm_phase(lds, P); __syncthreads(); }
        for (int i = bid * 512 + tid; i < T_ * 64; i += nb * 512) {
            const int chn = i & 63, row = i >> 6, t = row & (S_ - 1), g = chn >> 4;
            const int win = 2 << g, n = min(win, t + 1);
            const _Float16* src = proj16 + (size_t)row * INW + C_UP + chn * 8;
            float a[8];
            const h8 cur = *(const h8*)src;
            h8 vv[15];
#pragma unroll
            for (int k = 0; k < 15; ++k) { vv[k] = (h8){0, 0, 0, 0, 0, 0, 0, 0}; if (k + 1 < n) vv[k] = *(const h8*)(src - (size_t)(k + 1) * INW); }
#pragma unroll
            for (int q = 0; q < 8; ++q) a[q] = (float)cur[q];
#pragma unroll
            for (int k = 0; k < 15; ++k) {
#pragma unroll
                for (int q = 0; q < 8; ++q) a[q] += (float)vv[k][q]; }
            const float rn = 1.f / (float)n;
            float4 o0, o1;
            o0.x = a[0] * rn - (float)cur[0]; o0.y = a[1] * rn - (float)cur[1]; o0.z = a[2] * rn - (float)cur[2]; o0.w = a[3] * rn - (float)cur[3];
            o1.x = a[4] * rn - (float)cur[4]; o1.y = a[5] * rn - (float)cur[5]; o1.z = a[6] * rn - (float)cur[6]; o1.w = a[7] * rn - (float)cur[7];
            *(float4*)(pooled + (size_t)row * 512 + chn * 8) = o0; *(float4*)(pooled + (size_t)row * 512 + chn * 8 + 4) = o1;
        }
        {
            const int r32 = lane & 31, hi = lane >> 5, g = wv >> 1, half = wv & 1;
            for (int uu = vcu; uu < 512; uu += nb) {
                const int v = uu & 255, bk = v >> 4, qi = (uu >> 8) ? 31 - (v & 15) : (v & 15), b = bk >> 1, kvh = bk & 1;
                const int t = qi * 64 + half * 32 + r32;
                const int lo_t = max(0, qi - 8);
                const unsigned tmask = (unsigned)(((1ull << (qi + 1)) - 1ull) & ~((1ull << lo_t) - 1ull));
                at8::attn_unit(smem, proj16 + (size_t)(b * S_ + t) * INW + C_Q + (kvh * 4 + g) * 128 + hi * 8,
                               kv16 + ((size_t)(4 * B_ + b) * 2 + kvh) * KVSEG, kv16 + ((size_t)(5 * B_ + b) * 2 + kvh) * KVSEG, 128, tmask, 512, t, 0xffffffffu,
                               owin + (size_t)(b * S_ + qi * 64 + half * 32) * 1024 + (kvh * 4 + g) * 128, 1024);
            }
            for (int u = vcu; u < 256; u += nb) {
                const int b = u >> 5, h = (u >> 3) & 3, qt = u & 7;
                const int t = qt * 256 + wv * 32 + r32;
                at8::attn_unit(smem, proj16 + (size_t)(b * S_ + t) * INW + C_QM + h * 128 + hi * 8,
                               kvmem16 + (size_t)b * 256 * 1024 + h * 128, kvmem16 + (size_t)b * 256 * 1024 + 512 + h * 128, 1024, 0xFu, 0, 255, 0xffffffffu,
                               omem + (size_t)(b * S_ + qt * 256 + wv * 32) * 512 + h * 128, 512);
            }
        }
    }
    SEAM(2);
    if (IN(3)) {
        const int lane = LANE_NOW; (void)lane;
        {
            float* bsum = (float*)smem;
            _Float16* hs = (_Float16*)(smem + 4096);
            { const int kv = tid >> 8, n = tid & 255; float a = 0.f;
#pragma unroll
              for (int kc = 0; kc < 16; ++kc) a += bias1[(kv * 16 + kc) * 256 + n];
              bsum[tid] = a; }
            __syncthreads();
            const int fr = lane & 15, fq = lane >> 4;
            for (int u = bid; u < 256; u += nb) {
                const int kv = u >> 7, rt = u & 127;
#pragma unroll
                for (int q = 0; q < 8; ++q) { const int e = tid + 512 * q, i = e >> 8, n = e & 255;
                    const int row = rt * 16 + i, c = (row >> 1) & 127;
                    float a = 0.f;
                    if (c != 127) { a = bsum[kv * 256 + n];
#pragma unroll
                        for (int sp = 0; sp < 4; ++sp) { const float* base = uv + ((size_t)(kv * 4 + sp) * 2048) * 512; a += base[(size_t)row * 512 + n] + base[(size_t)(row + 2) * 512 + 256 + n]; }
                        a = gelu_fast(a); }
                    hs[i * 264 + n] = (_Float16)a; }
                __syncthreads();
                { const _Float16* bp = wt2 + ((size_t)kv * 128 + wv * 16 + fr) * 256 + fq * 8;
                  f4 acc = (f4){0.f, 0.f, 0.f, 0.f};
#pragma unroll
                  for (int sI = 0; sI < 8; ++sI) { const h8 a = *(const h8*)(hs + fr * 264 + sI * 32 + fq * 8), bb = *(const h8*)(bp + sI * 32); acc = __builtin_amdgcn_mfma_f32_16x16x32_f16(a, bb, acc, 0, 0, 0); }
                  _Float16* dst = kv ? vc16 : kc16;
#pragma unroll
                  for (int j = 0; j < 4; ++j) { const int row = rt * 16 + fq * 4 + j; dst[(size_t)row * 128 + wv * 16 + fr] = (((row >> 1) & 127) == 127) ? (_Float16)0.f : (_Float16)acc[j]; } }
                __syncthreads();
            }
        }
        for (int u = bid; u < 128 * 4; u += nb) { const int g = u >> 7, mt = u & 127;
            ARowPlain af{pooled + g * 128, 512, mt * 128, T_}; EpiPool ef{opool, p.in[I_POOLS], mt * 128, g};
            gemm_tile(smem, 128, af, p.in[I_POOLW] + (size_t)g * 128 * 128, 128, 0, 128, false, ef);
        }
    }
    SEAM(3);
    if (IN(4)) {
        const int lane = LANE_NOW; (void)lane;
        const int r32 = lane & 31, hi = lane >> 5, g = wv >> 1, half = wv & 1;
        for (int uu = vcu; uu < 512; uu += nb) {
            const int v = uu & 255, bk = v >> 4, qi = (uu >> 8) ? 31 - (v & 15) : (v & 15), b = bk >> 1, kvh = bk & 1;
            const int tl = half * 32 + r32, t = qi * 64 + tl;
            at8::cmp_slc_unit(smem, proj16 + (size_t)(b * S_ + t) * INW + C_Q + (kvh * 4 + g) * 128 + hi * 8,
                              kc16 + (size_t)(b * 128 * 2 + kvh) * 128, vc16 + (size_t)(b * 128 * 2 + kvh) * 128,
                              kv16 + ((size_t)(2 * B_ + b) * 2 + kvh) * KVSEG, kv16 + ((size_t)(3 * B_ + b) * 2 + kvh) * KVSEG, t, tl, g, qi,
                              ocmp + (size_t)(b * S_ + qi * 64 + half * 32) * 1024 + (kvh * 4 + g) * 128, oslc + (size_t)(b * S_ + qi * 64 + half * 32) * 1024 + (kvh * 4 + g) * 128);
        }
    }
    SEAM(4);
    if (IN(5)) {
        const int lane = LANE_NOW;
        for (int row = gw; row < T_; row += nw) {
            const _Float16* pr = proj16 + (size_t)row * INW + C_G;
            float v[32]; float ss = 0.f;
#pragma unroll
            for (int c = 0; c < 2; ++c) { const int col = (lane + 64 * c) * 8, h = col >> 7; const size_t o = (size_t)row * 1024 + col;
                const float g0 = sigmoidf_((float)pr[h * 3]), g1 = sigmoidf_((float)pr[h * 3 + 1]), g2 = sigmoidf_((float)pr[h * 3 + 2]);
                const h8 a = *(const h8*)(ocmp + o), b2 = *(const h8*)(oslc + o), c2 = *(const h8*)(owin + o);
#pragma unroll
                for (int q = 0; q < 8; ++q) { const float x = g0 * (float)a[q] + g1 * (float)b2[q] + g2 * (float)c2[q]; v[c * 8 + q] = x; ss += x * x; } }
            ss = wave_sum(ss); float r = rsqrtf(ss / 1024.f + LN_EPS);
#pragma unroll
            for (int c = 0; c < 2; ++c) { const int col = (lane + 64 * c) * 8; const float4 ga = *(const float4*)(p.in[I_GNNSA] + col), gb = *(const float4*)(p.in[I_GNNSA] + col + 4);
                v[c * 8 + 0] *= r * ga.x; v[c * 8 + 1] *= r * ga.y; v[c * 8 + 2] *= r * ga.z; v[c * 8 + 3] *= r * ga.w; v[c * 8 + 4] *= r * gb.x; v[c * 8 + 5] *= r * gb.y; v[c * 8 + 6] *= r * gb.z; v[c * 8 + 7] *= r * gb.w; }
            { const h8 a = *(const h8*)(opool + (size_t)row * 512 + lane * 8); ss = 0.f;
#pragma unroll
              for (int q = 0; q < 8; ++q) { v[16 + q] = (float)a[q]; ss += v[16 + q] * v[16 + q]; }
              ss = wave_sum(ss); r = rsqrtf(ss / 512.f + LN_EPS);
              const float4 ga = *(const float4*)(p.in[I_GNPOOL] + lane * 8), gb = *(const float4*)(p.in[I_GNPOOL] + lane * 8 + 4);
              v[16] *= r * ga.x; v[17] *= r * ga.y; v[18] *= r * ga.z; v[19] *= r * ga.w; v[20] *= r * gb.x; v[21] *= r * gb.y; v[22] *= r * gb.z; v[23] *= r * gb.w; }
            { const h8 a = *(const h8*)(omem + (size_t)row * 512 + lane * 8); ss = 0.f;
#pragma unroll
              for (int q = 0; q < 8; ++q) { v[24 + q] = (float)a[q]; ss += v[24 + q] * v[24 + q]; }
              ss = wave_sum(ss); r = rsqrtf(ss / 512.f + LN_EPS);
              const float4 ga = *(const float4*)(p.in[I_GNMEM] + lane * 8), gb = *(const float4*)(p.in[I_GNMEM] + lane * 8 + 4);
              v[24] *= r * ga.x; v[25] *= r * ga.y; v[26] *= r * ga.z; v[27] *= r * ga.w; v[28] *= r * gb.x; v[29] *= r * gb.y; v[30] *= r * gb.z; v[31] *= r * gb.w; }
            float amax = 0.f;
#pragma unroll
            for (int k = 0; k < 32; ++k) amax = fmaxf(amax, fabsf(v[k]));
            amax = wave_max(amax);
            const float qinv = amax > 0.f ? 127.f / amax : 0.f;
            if (lane == 0) scat[row] = amax > 0.f ? amax / 127.f : 1.f;
#pragma unroll
            for (int c = 0; c < 4; ++c) { const int col = c < 2 ? (lane + 64 * c) * 8 : (c == 2 ? 1024 + lane * 8 : 1536 + lane * 8);
                uint2 q; q.x = pack4_i8(v[c * 8 + 0] * qinv, v[c * 8 + 1] * qinv, v[c * 8 + 2] * qinv, v[c * 8 + 3] * qinv); q.y = pack4_i8(v[c * 8 + 4] * qinv, v[c * 8 + 5] * qinv, v[c * 8 + 6] * qinv, v[c * 8 + 7] * qinv);
                *(uint2*)(cat8 + (size_t)row * 2048 + col) = q; }
        }
    }
    SEAM(5);
    if (IN(6)) {
        const int lane = LANE_NOW; (void)lane;
        g8::ProbOut P{cat8, q8out, hpre16, x16, scat, sout, nb, bid};
        g8::gemm_phase(lds, P);
    }
    SEAM(6);
    if (IN(7)) {
        const int lane = LANE_NOW; (void)lane;
        float* lg = (float*)smem;
        const int r32 = lane & 31, hi = lane >> 5, fr = lane & 15, fq = lane >> 4;
        for (int u = bid; u < T_ / 64; u += nb) {
            const int base = u * 64;
            h8 raw[8][4];
#pragma unroll
            for (int i = 0; i < 8; ++i)
#pragma unroll
                for (int c = 0; c < 4; ++c) raw[i][c] = *(const h8*)(hpre16 + (size_t)(base + wv * 8 + i) * 2048 + (lane + 64 * c) * 8);
#pragma unroll
            for (int i = 0; i < 8; ++i) {
                const int row = base + wv * 8 + i;
                float v[32]; float s = 0.f;
#pragma unroll
                for (int c = 0; c < 4; ++c) {
#pragma unroll
                    for (int q = 0; q < 8; ++q) { v[c * 8 + q] = (float)raw[i][c][q]; s += v[c * 8 + q]; } }
                const float mu = wave_sum(s) / 2048.f; float q2 = 0.f;
#pragma unroll
                for (int k = 0; k < 32; ++k) { const float d = v[k] - mu; q2 += d * d; }
                const float rs = rsqrtf(wave_sum(q2) / 2048.f + LN_EPS);
                float amax = 0.f;
#pragma unroll
                for (int c = 0; c < 4; ++c) { const int col = (lane + 64 * c) * 8;
                    const float4 g0 = *(const float4*)(p.in[I_LN1G] + col), g1 = *(const float4*)(p.in[I_LN1G] + col + 4), b0 = *(const float4*)(p.in[I_LN1B] + col), b1 = *(const float4*)(p.in[I_LN1B] + col + 4);
                    float4 o0, o1;
                    o0.x = (v[c * 8 + 0] - mu) * rs * g0.x + b0.x; o0.y = (v[c * 8 + 1] - mu) * rs * g0.y + b0.y; o0.z = (v[c * 8 + 2] - mu) * rs * g0.z + b0.z; o0.w = (v[c * 8 + 3] - mu) * rs * g0.w + b0.w;
                    o1.x = (v[c * 8 + 4] - mu) * rs * g1.x + b1.x; o1.y = (v[c * 8 + 5] - mu) * rs * g1.y + b1.y; o1.z = (v[c * 8 + 6] - mu) * rs * g1.z + b1.z; o1.w = (v[c * 8 + 7] - mu) * rs * g1.w + b1.w;
                    h8 oh; oh[0] = (_Float16)o0.x; oh[1] = (_Float16)o0.y; oh[2] = (_Float16)o0.z; oh[3] = (_Float16)o0.w; oh[4] = (_Float16)o1.x; oh[5] = (_Float16)o1.y; oh[6] = (_Float16)o1.z; oh[7] = (_Float16)o1.w;
                    *(h8*)(h16 + (size_t)row * 2048 + col) = oh;
                    v[c * 8 + 0] = o0.x; v[c * 8 + 1] = o0.y; v[c * 8 + 2] = o0.z; v[c * 8 + 3] = o0.w; v[c * 8 + 4] = o1.x; v[c * 8 + 5] = o1.y; v[c * 8 + 6] = o1.z; v[c * 8 + 7] = o1.w;
                    amax = fmaxf(amax, fmaxf(fmaxf(fmaxf(fabsf(o0.x), fabsf(o0.y)), fmaxf(fabsf(o0.z), fabsf(o0.w))), fmaxf(fmaxf(fabsf(o1.x), fabsf(o1.y)), fmaxf(fabsf(o1.z), fabsf(o1.w))))); }
                amax = wave_max(amax);
                const float qinv = amax > 0.f ? 127.f / amax : 0.f;
                if (lane == 0) sah[row] = amax > 0.f ? amax / 127.f : 1.f;
#pragma unroll
                for (int c = 0; c < 4; ++c) { const int col = (lane + 64 * c) * 8;
                    uint2 q; q.x = pack4_i8(v[c * 8 + 0] * qinv, v[c * 8 + 1] * qinv, v[c * 8 + 2] * qinv, v[c * 8 + 3] * qinv); q.y = pack4_i8(v[c * 8 + 4] * qinv, v[c * 8 + 5] * qinv, v[c * 8 + 6] * qinv, v[c * 8 + 7] * qinv);
                    *(uint2*)(h8q + (size_t)row * 2048 + col) = q; }
            }
            asm volatile("s_waitcnt vmcnt(0)" ::: "memory");
            __syncthreads();
            {
                const int tok0 = base + 16 * (wv >> 1), e0 = 16 * (wv & 1);
                const _Float16* ap = h16 + (size_t)(tok0 + fr) * 2048 + fq * 8; const _Float16* bp = wr16 + (size_t)(e0 + fr) * 2048 + fq * 8;
                f4 acc = (f4){0.f, 0.f, 0.f, 0.f};
#pragma unroll 8
                for (int sI = 0; sI < 64; ++sI) { const h8 a = *(const h8*)(ap + sI * 32), bb = *(const h8*)(bp + sI * 32); acc = __builtin_amdgcn_mfma_f32_16x16x32_f16(a, bb, acc, 0, 0, 0); }
                const float br = p.in[I_BR][e0 + fr];
#pragma unroll
                for (int j = 0; j < 4; ++j) lg[(16 * (wv >> 1) + 4 * fq + j) * 33 + e0 + fr] = acc[j] + br;
            }
            __syncthreads();
#pragma unroll 1
            for (int it = 0; it < 4; ++it) {
                const int tk = 8 * wv + 2 * it + hi;
                const float iv = lg[tk * 33 + r32];
                int rank = 0;
                for (int i = 0; i < 32; ++i) { const float vi = __shfl(iv, i + 32 * hi); rank += (vi > iv || (vi == iv && i < r32)) ? 1 : 0; }
                float tv[4]; int te[4];
#pragma unroll
                for (int r = 0; r < 4; ++r) { const unsigned long long bm = __ballot(rank == r); const unsigned hm = (unsigned)(bm >> (32 * hi)); const int src = __ffs(hm) - 1; te[r] = src; tv[r] = __shfl(iv, src + 32 * hi); }
                const float e0v = 1.f, e1v = expf(tv[1] - tv[0]), e2v = expf(tv[2] - tv[0]), e3v = expf(tv[3] - tv[0]); const float inv = 1.f / (e0v + e1v + e2v + e3v);
                if (r32 < 4) { const int e = r32 == 0 ? te[0] : r32 == 1 ? te[1] : r32 == 2 ? te[2] : te[3]; const float g = (r32 == 0 ? e0v : r32 == 1 ? e1v : r32 == 2 ? e2v : e3v) * inv;
                    const int a = (base + tk) * 4 + r32; const int pos = atomicAdd(&cnt[e], 1); list[(size_t)e * T_ + pos] = a; gate[a] = g; }
            }
            __syncthreads();
        }
    }
    SEAM(7);
    LAS int* mtab = (LAS int*)(smem + g8::STAGE_BYTES);
    if (IN(8)) {
        const int lane = LANE_NOW; (void)lane;
        if (tid == 0) { int ub = 0, rs = 0;
            for (int e = 0; e < NE; ++e) { const int c = (int)__hip_atomic_load((unsigned*)&cnt[e], __ATOMIC_RELAXED, __HIP_MEMORY_SCOPE_AGENT); mtab[e] = c; mtab[32 + e] = ub; mtab[65 + e] = rs; ub += ((c + 255) >> 8) * 16; rs += c; }
            mtab[64] = ub; mtab[97] = rs; mtab[98] = ub; }
        __syncthreads();
        g8::moe_build(mtab, nb, vcu);
        __syncthreads();
        g8::ProbGu P{h8q, q8gu, actf8, p.in[I_BGU], list, sah, sgu, g8::MoeTab{mtab, 16}, nb, vcu};
        g8::gemm_phase(lds, P);
        __syncthreads();
    }
    SEAM(8);
    if (IN(9)) {
        const int lane = LANE_NOW;
        for (int row0 = gw; row0 < NA; row0 += nw * 8) {
            uint2 raw[8][4];
#pragma unroll
            for (int i = 0; i < 8; ++i)
#pragma unroll
                for (int c = 0; c < 4; ++c) raw[i][c] = *(const uint2*)(actf8 + (size_t)(row0 + i * nw) * 2048 + (lane + 64 * c) * 8);
#pragma unroll
            for (int i = 0; i < 8; ++i) { const int row = row0 + i * nw;
                float v[32]; float amax = 0.f;
#pragma unroll
                for (int c = 0; c < 4; ++c) { const uint2 a = raw[i][c];
                    dec4_fp8(a.x, v[c * 8 + 0], v[c * 8 + 1], v[c * 8 + 2], v[c * 8 + 3]); dec4_fp8(a.y, v[c * 8 + 4], v[c * 8 + 5], v[c * 8 + 6], v[c * 8 + 7]);
#pragma unroll
                    for (int q = 0; q < 8; ++q) amax = fmaxf(amax, fabsf(v[c * 8 + q])); }
                amax = wave_max(amax);
                const float qinv = amax > 0.f ? 127.f / amax : 0.f;
                if (lane == 0) sact[row] = amax > 0.f ? amax / 127.f : 1.f;
#pragma unroll
                for (int c = 0; c < 4; ++c) { uint2 q; q.x = pack4_i8(v[c * 8 + 0] * qinv, v[c * 8 + 1] * qinv, v[c * 8 + 2] * qinv, v[c * 8 + 3] * qinv); q.y = pack4_i8(v[c * 8 + 4] * qinv, v[c * 8 + 5] * qinv, v[c * 8 + 6] * qinv, v[c * 8 + 7] * qinv);
                    *(uint2*)(act8 + (size_t)row * 2048 + (lane + 64 * c) * 8) = q; }
            }
        }
    }
    SEAM(9);
    if (IN(10)) {
        const int lane = LANE_NOW; (void)lane;
        if (tid == 0) { int ub = 0, rs = 0;
            for (int e = 0; e < NE; ++e) { const int c = (int)__hip_atomic_load((unsigned*)&cnt[e], __ATOMIC_RELAXED, __HIP_MEMORY_SCOPE_AGENT); mtab[e] = c; mtab[32 + e] = ub; mtab[65 + e] = rs; ub += ((c + 255) >> 8) * 8; rs += c; }
            mtab[64] = ub; mtab[97] = rs; mtab[98] = ub; }
        __syncthreads();
        g8::moe_build(mtab, nb, vcu);
        __syncthreads();
        g8::ProbDn P{act8, q8dn, yf8, p.in[I_BDN], list, gate, sact, sdn, g8::MoeTab{mtab, 8}, nb, vcu};
        g8::gemm_phase(lds, P);
        __syncthreads();
    }
    SEAM(10);
    if (IN(11)) {
        const int lane = LANE_NOW; (void)lane;
        for (int row0 = gw; row0 < T_; row0 += nw * 2) {
          h8 hraw[2][4]; uint2 yraw[2][4][4];
#pragma unroll
          for (int i = 0; i < 2; ++i)
#pragma unroll
            for (int c = 0; c < 4; ++c) { const int col = (lane + 64 * c) * 8; const size_t yo = (size_t)(row0 + i * nw) * 4 * 2048 + col;
                hraw[i][c] = *(const h8*)(h16 + (size_t)(row0 + i * nw) * 2048 + col);
                yraw[i][c][0] = *(const uint2*)(yf8 + yo); yraw[i][c][1] = *(const uint2*)(yf8 + yo + 2048); yraw[i][c][2] = *(const uint2*)(yf8 + yo + 4096); yraw[i][c][3] = *(const uint2*)(yf8 + yo + 6144); }
#pragma unroll
          for (int i = 0; i < 2; ++i) { const int row = row0 + i * nw;
            float v[32]; float s = 0.f;
#pragma unroll
            for (int c = 0; c < 4; ++c) {
                const h8 hh8 = hraw[i][c];
                const uint2 y0 = yraw[i][c][0], y1 = yraw[i][c][1], y2 = yraw[i][c][2], y3 = yraw[i][c][3];
                float ys[8], t0[8], t1[8], t2[8], t3[8];
                dec4_fp8(y0.x, t0[0], t0[1], t0[2], t0[3]); dec4_fp8(y0.y, t0[4], t0[5], t0[6], t0[7]); dec4_fp8(y1.x, t1[0], t1[1], t1[2], t1[3]); dec4_fp8(y1.y, t1[4], t1[5], t1[6], t1[7]);
                dec4_fp8(y2.x, t2[0], t2[1], t2[2], t2[3]); dec4_fp8(y2.y, t2[4], t2[5], t2[6], t2[7]); dec4_fp8(y3.x, t3[0], t3[1], t3[2], t3[3]); dec4_fp8(y3.y, t3[4], t3[5], t3[6], t3[7]);
#pragma unroll
                for (int q = 0; q < 8; ++q) ys[q] = (t0[q] + t1[q]) + (t2[q] + t3[q]);
#pragma unroll
                for (int q = 0; q < 8; ++q) { v[c * 8 + q] = DN_ALPHA * (float)hh8[q] + ys[q] * 0.0625f; s += v[c * 8 + q]; } }
            const float mu = wave_sum(s) / 2048.f; float q2 = 0.f;
#pragma unroll
            for (int i = 0; i < 32; ++i) { const float d = v[i] - mu; q2 += d * d; }
            const float rs = rsqrtf(wave_sum(q2) / 2048.f + LN_EPS);
#pragma unroll
            for (int c = 0; c < 4; ++c) { const int col = (lane + 64 * c) * 8;
                const float4 ga = *(const float4*)(p.in[I_LN2G] + col), gb = *(const float4*)(p.in[I_LN2G] + col + 4), ba = *(const float4*)(p.in[I_LN2B] + col), bb = *(const float4*)(p.in[I_LN2B] + col + 4);
                float4 o0, o1;
                o0.x = (v[c * 8 + 0] - mu) * rs * ga.x + ba.x; o0.y = (v[c * 8 + 1] - mu) * rs * ga.y + ba.y; o0.z = (v[c * 8 + 2] - mu) * rs * ga.z + ba.z; o0.w = (v[c * 8 + 3] - mu) * rs * ga.w + ba.w;
                o1.x = (v[c * 8 + 4] - mu) * rs * gb.x + bb.x; o1.y = (v[c * 8 + 5] - mu) * rs * gb.y + bb.y; o1.z = (v[c * 8 + 6] - mu) * rs * gb.z + bb.z; o1.w = (v[c * 8 + 7] - mu) * rs * gb.w + bb.w;
                *(float4*)(p.out + (size_t)row * 2048 + col) = o0; *(float4*)(p.out + (size_t)row * 2048 + col + 4) = o1; }
          }
        }
    }
}

constexpr int NPHASE = 12;

extern "C" void kernel_launch(void* const* d_in, const int* in_sizes, int n_in, void* d_out, int out_size, void* d_ws, size_t ws_size, hipStream_t stream) {
    static int grid = 0;
    if (grid == 0) {
        if (n_in != 26 || ws_size < WS_END) { fprintf(stderr, "kernel_launch: unexpected n_in %d or ws_size %zu (< %zu)\n", n_in, ws_size, (size_t)WS_END); grid = -1; return; }
        int dev = 0, cus = 0, per_cu = 0;
        hipGetDevice(&dev); hipDeviceGetAttribute(&cus, hipDeviceAttributeMultiprocessorCount, dev);
        if (hipFuncSetAttribute((const void*)fwd, hipFuncAttributeMaxDynamicSharedMemorySize, LDS_BYTES) != hipSuccess) { fprintf(stderr, "hipFuncSetAttribute failed\n"); grid = -1; return; }
        hipOccupancyMaxActiveBlocksPerMultiprocessor(&per_cu, (const void*)fwd, 512, LDS_BYTES);
        (void)hipGetLastError();
        if (per_cu < 1) fprintf(stderr, "occupancy query says %d blocks per CU\n", per_cu);
        grid = cus > 0 ? cus : 256;
    }
    if (grid < 0) return;
    hipMemsetAsync((char*)d_ws + WS_CTL, 0, CTL_BYTES, stream);
    Params p{};
    for (int i = 0; i < 26; ++i) p.in[i] = (const float*)d_in[i];
    p.out = (float*)d_out; p.ws = (unsigned char*)d_ws;
#if N_LAUNCH_MODE == 1
    p.lo_hi = (long long)0 | ((long long)NPHASE << 32);
    hipLaunchKernelGGL(fwd, dim3(grid), dim3(512), LDS_BYTES, stream, p);
#else
    for (int ph = 0; ph < NPHASE; ++ph) {
        p.lo_hi = (long long)ph | ((long long)(ph + 1) << 32);
        hipLaunchKernelGGL(fwd, dim3(grid), dim3(512), LDS_BYTES, stream, p);
    }
#endif
}
```

```cpp
#include <hip/hip_runtime.h>
#include <cstdio>
#include <cstdint>

#ifndef N_LAUNCH_MODE
#define N_LAUNCH_MODE 1
#endif

constexpr int B_ = 8, S_ = 2048, D_ = 2048, T_ = B_ * S_;
constexpr int INW = 3608;
constexpr int C_Q = 0, C_KC = 1024, C_VC = 1280, C_KS = 1536, C_VS = 1792, C_KW = 2048, C_VW = 2304, C_G = 2560, C_UP = 2584, C_QM = 3096;
constexpr int NC = 127;
constexpr int CROWS = B_ * NC * 2;
constexpr int NE = 32, DE = 2048, NA = T_ * 4;
constexpr float LN_EPS = 1e-5f;
constexpr float DN_ALPHA = 1.189207115002721f;
constexpr float ATT_SCALE = 0.08838834764831845f;

constexpr size_t al256(size_t x) { return (x + 255) & ~(size_t)255; }
constexpr size_t WS_CTL = 0;
constexpr size_t CTL_BYTES = 65536;
constexpr size_t CTL_CNT = 16384;
constexpr size_t WS_PROJ = CTL_BYTES;
constexpr size_t WS_KVMEM = WS_PROJ + al256((size_t)T_ * INW * 4);
constexpr size_t WS_BIAS1 = WS_KVMEM + al256((size_t)2048 * 1024 * 4);
constexpr size_t WS_HID = WS_BIAS1 + al256(2 * 16 * 256 * 4);
constexpr size_t WS_KC = WS_HID + al256((size_t)2 * 2048 * 256 * 4);
constexpr size_t WS_VC = WS_KC + al256((size_t)CROWS * 128 * 4);
constexpr size_t WS_POOLED = WS_VC + al256((size_t)CROWS * 128 * 4);
constexpr size_t WS_OPOOL = WS_POOLED + al256((size_t)T_ * 512 * 4);
constexpr size_t WS_OWIN = WS_OPOOL + al256((size_t)T_ * 512 * 4);
constexpr size_t WS_OCMP = WS_OWIN + al256((size_t)T_ * 1024 * 4);
constexpr size_t WS_OSLC = WS_OCMP + al256((size_t)T_ * 1024 * 4);
constexpr size_t WS_SEL = WS_OSLC + al256((size_t)T_ * 1024 * 4);
constexpr size_t WS_OMEM = WS_SEL + al256((size_t)T_ * 2 * 4);
constexpr size_t WS_CAT16 = WS_OMEM + al256((size_t)T_ * 512 * 4);
constexpr size_t WS_HPRE = WS_CAT16 + al256((size_t)T_ * 2048 * 2);
constexpr size_t WS_H = WS_HPRE + al256((size_t)T_ * 2048 * 4);
constexpr size_t WS_H16 = WS_H + al256((size_t)T_ * 2048 * 4);
constexpr size_t WS_GATE = WS_H16 + al256((size_t)T_ * 2048 * 2);
constexpr size_t WS_LIST = WS_GATE + al256((size_t)NA * 4);
constexpr size_t WS_ACT16 = WS_LIST + al256((size_t)NE * T_ * 4);
constexpr size_t WS_Y16 = WS_ACT16 + al256((size_t)(NA + 256) * 2048 * 2);
constexpr size_t WS_X16 = WS_Y16 + al256((size_t)NA * 2048 * 2);
constexpr size_t WS_MEM16 = WS_X16 + (size_t)T_ * 2048 * 2;
constexpr size_t WS_WTIN = WS_MEM16 + al256((size_t)2048 * 2048 * 2);
constexpr size_t WS_WTOUT = WS_WTIN + al256((size_t)3840 * 2048 * 2);
constexpr size_t WS_WTGU = WS_WTOUT + al256((size_t)2048 * 2048 * 2);
constexpr size_t WS_WTDN = WS_WTGU + al256((size_t)NE * 4096 * 2048 * 2);
constexpr size_t WS_PROJ16 = WS_WTDN + al256((size_t)NE * 2048 * 2048 * 2);
constexpr size_t WS_KVMEM16 = WS_PROJ16 + al256((size_t)(T_ + 64) * INW * 2);
constexpr size_t WS_WT1 = WS_KVMEM16 + al256((size_t)2048 * 1024 * 2);
constexpr size_t WS_UV = WS_WT1 + al256((size_t)2 * 512 * 2048 * 2);
constexpr size_t WS_KC16 = WS_UV + al256((size_t)2 * 4 * 2048 * 512 * 4);
constexpr size_t WS_VC16 = WS_KC16 + al256((size_t)B_ * 128 * 256 * 2);
constexpr size_t WS_WR16 = WS_VC16 + al256((size_t)B_ * 128 * 256 * 2);
constexpr size_t WS_Q8GU = WS_WR16 + al256((size_t)32 * 2048 * 2);
constexpr size_t WS_Q8DN = WS_Q8GU + al256((size_t)NE * 4096 * 2048);
constexpr size_t WS_SGU = WS_Q8DN + al256((size_t)NE * 2048 * 2048);
constexpr size_t WS_SDN = WS_SGU + al256((size_t)NE * 4096 * 4);
constexpr size_t WS_H8 = WS_SDN + al256((size_t)NE * 2048 * 4);
constexpr size_t WS_SAH = WS_H8 + al256((size_t)T_ * 2048);
constexpr size_t WS_ACT8 = WS_SAH + al256((size_t)T_ * 4);
constexpr size_t WS_SACT = WS_ACT8 + al256((size_t)(NA + 256) * 2048);
constexpr size_t WS_WTMKV = WS_SACT + al256((size_t)(NA + 256) * 4);
constexpr size_t WS_Q8OUT = WS_WTMKV + al256((size_t)1024 * 2048 * 2);
constexpr size_t WS_SOUT = WS_Q8OUT + al256((size_t)2048 * 2048);
constexpr size_t WS_CAT8 = WS_SOUT + al256(2048 * 4);
constexpr size_t WS_SCAT = WS_CAT8 + al256((size_t)T_ * 2048);
constexpr size_t WS_SA2 = WS_SCAT + al256((size_t)T_ * 4);
constexpr size_t WS_GATE2 = WS_SA2 + al256((size_t)NE * T_ * 4);
constexpr size_t WS_X8 = WS_GATE2 + al256((size_t)NE * T_ * 4);
constexpr size_t WS_SXA = WS_X8 + al256((size_t)(T_ + 2048) * 2048);
constexpr size_t WS_Q8IN = WS_SXA + al256((size_t)(T_ + 2048) * 4);
constexpr size_t WS_SIN8 = WS_Q8IN + al256((size_t)2560 * 2048);
constexpr size_t WS_Q8MKV = WS_SIN8 + al256(2560 * 4);
constexpr size_t WS_SMKV = WS_Q8MKV + al256((size_t)1024 * 2048);
constexpr size_t WS_WT2 = WS_SMKV + al256(1024 * 4);
constexpr size_t WS_KV16 = WS_WT2 + al256((size_t)2 * 128 * 256 * 2);
constexpr size_t KVSEG = (size_t)S_ * 128;
constexpr size_t WS_END = WS_KV16 + al256((size_t)6 * B_ * 2 * S_ * 128 * 2);

constexpr int LDS_BYTES = 155648;

struct Params {
    const float* in[26];
    float* out;
    unsigned char* ws;
    long long lo_hi;
};
enum { I_X = 0, I_MEM, I_WIN, I_POSK, I_W1K, I_W2K, I_POSV, I_W1V, I_W2V, I_POOLW, I_POOLS, I_WMEMKV, I_GNNSA, I_GNPOOL, I_GNMEM, I_WOUT,
       I_LN1G, I_LN1B, I_WR, I_BR, I_WGU, I_BGU, I_WDN, I_BDN, I_LN2G, I_LN2B };

#define XB_TMO      128
#define XB_XCNT(j)  (256  + 64 * (j))
#define XB_XSUB(j)  (1280 + 64 * (j))
#define XB_XGEN(j)  (2304 + 64 * (j))
#define XB_TOP      3328
#define XB_TOPGEN   3392
#define XCD_BAR_WORDS 3456
#define XB_SPIN_CAP (1u << 25)
#define LAS __attribute__((address_space(3)))

__device__ __forceinline__ unsigned xb_ld(unsigned* p)              { return __hip_atomic_load(p, __ATOMIC_RELAXED, __HIP_MEMORY_SCOPE_AGENT); }
__device__ __forceinline__ unsigned xb_add(unsigned* p, unsigned v) { return __hip_atomic_fetch_add(p, v, __ATOMIC_RELAXED, __HIP_MEMORY_SCOPE_AGENT); }
__device__ __forceinline__ unsigned xb_xcc_id() { return (unsigned)__builtin_amdgcn_s_getreg((3 << 11) | 20) & 0xFu; }
#define XB_SPIN(cond, bar) do { unsigned _sp = 0; while (cond) { __builtin_amdgcn_s_sleep(1); \
    if ((++_sp & 255u) == 0u) { if (xb_ld(&(bar)[XB_TMO])) break; if (_sp > XB_SPIN_CAP) { atomicAdd(&(bar)[XB_TMO], 1u); break; } } } } while (0)

struct XcdBarrier { unsigned* bar; unsigned x; volatile LAS unsigned* st; };

__device__ __forceinline__ XcdBarrier xcd_barrier_post(unsigned* bar, volatile LAS unsigned* st) {
    XcdBarrier b; b.bar = bar; b.x = xb_xcc_id(); b.st = st;
    if (threadIdx.x == 0) (void)xb_add(&bar[XB_XCNT(b.x)], 1u);
    return b;
}
__device__ __forceinline__ void xcd_barrier_complete(unsigned* bar, unsigned x, unsigned& nloc, unsigned& nx) {
    const unsigned G = gridDim.x * gridDim.y * gridDim.z;
    unsigned sum, cnt, mine, sp = 0u;
    for (;;) {
        sum = 0u; cnt = 0u; mine = 0u;
#pragma unroll
        for (unsigned j = 0; j < 16; ++j) { const unsigned c = xb_ld(&bar[XB_XCNT(j)]); sum += c; cnt += (c > 0u) ? 1u : 0u; mine = (j == x) ? c : mine; }
        if (sum == G) break;
        __builtin_amdgcn_s_sleep(1);
        if ((++sp & 255u) == 0u) { if (xb_ld(&bar[XB_TMO])) break; if (sp > XB_SPIN_CAP) { atomicAdd(&bar[XB_TMO], 1u); break; } }
    }
    nloc = mine > 0u ? mine : 1u; nx = cnt > 0u ? cnt : 1u;
}
__device__ __forceinline__ void xcd_barrier(const XcdBarrier& b) {
    asm volatile("s_waitcnt vmcnt(0)" ::: "memory");
    __syncthreads();
    if (threadIdx.x == 0) {
        unsigned* bar = b.bar;
        __builtin_amdgcn_s_waitcnt(0);
        unsigned nloc = b.st[0], nx = b.st[1];
        if (nloc == 0u) { xcd_barrier_complete(bar, b.x, nloc, nx); b.st[0] = nloc; b.st[1] = nx; }
        const unsigned old = xb_add(&bar[XB_XSUB(b.x)], 1u);
        const unsigned gen = old / nloc;
        if (old + 1u == (gen + 1u) * nloc) {
            __builtin_amdgcn_fence(__ATOMIC_RELEASE, "agent");
            asm volatile("s_waitcnt vmcnt(0)" ::: "memory");
            const unsigned og = xb_add(&bar[XB_TOP], 1u);
            const unsigned tg = og / nx;
            if (og + 1u == (tg + 1u) * nx) xb_add(&bar[XB_TOPGEN], 1u);
            else XB_SPIN(xb_ld(&bar[XB_TOPGEN]) == tg, bar);
            __builtin_amdgcn_fence(__ATOMIC_ACQUIRE, "agent");
            xb_add(&bar[XB_XGEN(b.x)], 1u);
            asm volatile("s_waitcnt vmcnt(0)" ::: "memory");
        } else {
            XB_SPIN(xb_ld(&bar[XB_XGEN(b.x)]) == gen, bar);
            __builtin_amdgcn_fence(__ATOMIC_ACQUIRE, "agent");
            asm volatile("s_waitcnt vmcnt(0)" ::: "memory");
        }
    }
    __syncthreads();
}

typedef _Float16 h8 __attribute__((ext_vector_type(8)));
typedef _Float16 h4 __attribute__((ext_vector_type(4)));
typedef float f4 __attribute__((ext_vector_type(4)));

__device__ __forceinline__ float wave_sum(float v) {
#pragma unroll
    for (int o = 32; o > 0; o >>= 1) v += __shfl_xor(v, o);
    return v;
}
__device__ __forceinline__ float wave_max(float v) {
#pragma unroll
    for (int o = 32; o > 0; o >>= 1) v = fmaxf(v, __shfl_xor(v, o));
    return v;
}
__device__ __forceinline__ void wave_sync() {
    asm volatile("s_waitcnt lgkmcnt(0)" ::: "memory");
    __builtin_amdgcn_wave_barrier();
}
__device__ __forceinline__ float gelu_tanh(float x) {
    const float u = 0.7978845608028654f * (x + 0.044715f * x * x * x);
    return 0.5f * x * (1.f + tanhf(u));
}
__device__ __forceinline__ float gelu_fast(float x) { const float u = 0.7978845608028654f * (x + 0.044715f * x * x * x); const float t = 1.f - 2.f * __builtin_amdgcn_rcpf(1.f + __builtin_amdgcn_exp2f(2.8853900817779268f * u)); return 0.5f * x * (1.f + t); }
__device__ __forceinline__ float sigmoidf_(float x) { return 1.f / (1.f + expf(-x)); }
__device__ __forceinline__ unsigned pk4_fp8(float a, float b, float c, float d) { int w = 0; w = __builtin_amdgcn_cvt_pk_fp8_f32(a, b, w, false); w = __builtin_amdgcn_cvt_pk_fp8_f32(c, d, w, true); return (unsigned)w; }
__device__ __forceinline__ void dec4_fp8(unsigned w, float& a, float& b, float& c, float& d) { a = __builtin_amdgcn_cvt_f32_fp8((int)w, 0); b = __builtin_amdgcn_cvt_f32_fp8((int)w, 1); c = __builtin_amdgcn_cvt_f32_fp8((int)w, 2); d = __builtin_amdgcn_cvt_f32_fp8((int)w, 3); }
__device__ __forceinline__ float swiglu_fast(float g, float l) { const float xg = fminf(g, 7.f), xl = fminf(fmaxf(l, -7.f), 7.f); return xg * __builtin_amdgcn_rcpf(1.f + __builtin_amdgcn_exp2f(-2.4554669595930156f * xg)) * (xl + 1.f); }

constexpr int G_LD = 40;
template <class AF, class EF>
__device__ __forceinline__ void gemm_tile(char* smem, int K, const AF& af, const float* __restrict__ Bm, int ldb, int n0, int Nlim, bool perm, const EF& ef) {
    _Float16* As = (_Float16*)smem;
    _Float16* Bs = As + 128 * G_LD;
    const int tid = threadIdx.x, lane = tid & 63, wid = tid >> 6, wr = wid >> 2, wc = wid & 3, fr = lane & 15, fq = lane >> 4;
    f4 acc[4][2];
#pragma unroll
    for (int m = 0; m < 4; ++m)
#pragma unroll
        for (int n = 0; n < 2; ++n) acc[m][n] = (f4){0.f, 0.f, 0.f, 0.f};
    const int ar = tid >> 3, ak = (tid & 7) * 4;
    const float* ap0 = af.row(ar);
    const float* ap1 = af.row(ar + 64);
    const int bk = tid >> 5, bn = (tid & 31) * 4;
    const bool bok = (n0 + bn) < Nlim;
    int bnp[4];
#pragma unroll
    for (int i = 0; i < 4; ++i) { const int c = bn + i; bnp[i] = perm ? ((c & ~31) | ((c & 1) << 4) | ((c & 31) >> 1)) : c; }
    for (int k0 = 0; k0 < K; k0 += 32) {
        const int ko = af.koff(k0 + ak);
        float4 a0 = make_float4(0.f, 0.f, 0.f, 0.f), a1 = a0, b0 = a0, b1 = a0;
        if (ap0) a0 = *(const float4*)(ap0 + ko);
        if (ap1) a1 = *(const float4*)(ap1 + ko);
        if (bok) { b0 = *(const float4*)(Bm + (size_t)(k0 + bk) * ldb + n0 + bn); b1 = *(const float4*)(Bm + (size_t)(k0 + bk + 16) * ldb + n0 + bn); }
        __syncthreads();
        *(h4*)&As[ar * G_LD + ak] = (h4){(_Float16)a0.x, (_Float16)a0.y, (_Float16)a0.z, (_Float16)a0.w};
        *(h4*)&As[(ar + 64) * G_LD + ak] = (h4){(_Float16)a1.x, (_Float16)a1.y, (_Float16)a1.z, (_Float16)a1.w};
        Bs[bnp[0] * G_LD + bk] = (_Float16)b0.x; Bs[bnp[1] * G_LD + bk] = (_Float16)b0.y; Bs[bnp[2] * G_LD + bk] = (_Float16)b0.z; Bs[bnp[3] * G_LD + bk] = (_Float16)b0.w;
        Bs[bnp[0] * G_LD + bk + 16] = (_Float16)b1.x; Bs[bnp[1] * G_LD + bk + 16] = (_Float16)b1.y; Bs[bnp[2] * G_LD + bk + 16] = (_Float16)b1.z; Bs[bnp[3] * G_LD + bk + 16] = (_Float16)b1.w;
        __syncthreads();
        h8 a[4], b[2];
#pragma unroll
        for (int m = 0; m < 4; ++m) a[m] = *(const h8*)&As[(wr * 64 + m * 16 + fr) * G_LD + fq * 8];
#pragma unroll
        for (int n = 0; n < 2; ++n) b[n] = *(const h8*)&Bs[(wc * 32 + n * 16 + fr) * G_LD + fq * 8];
#pragma unroll
        for (int m = 0; m < 4; ++m)
#pragma unroll
            for (int n = 0; n < 2; ++n) acc[m][n] = __builtin_amdgcn_mfma_f32_16x16x32_f16(a[m], b[n], acc[m][n], 0, 0, 0);
    }
    ef(acc, wr, wc, fr, fq);
    __syncthreads();
}

struct ARowPlain { const float* base; int ld; int m0; int mlim;
    __device__ __forceinline__ const float* row(int r) const { return (m0 + r) < mlim ? base + (size_t)(m0 + r) * ld : nullptr; }
    __device__ __forceinline__ int koff(int k) const { return k; } };
struct ARowCmp { const float* proj; int col; int m0;
    __device__ __forceinline__ const float* row(int r) const { const int g = m0 + r; if (g >= CROWS) return nullptr; const int kvh = g & 1, bc = g >> 1, b = bc / NC, c = bc % NC;
        return proj + (size_t)(b * S_ + 16 * c) * INW + col + kvh * 128; }
    __device__ __forceinline__ int koff(int k) const { return (k >> 7) * INW + (k & 127); } };
struct ARowList { const float* base; const int* list; int m0; int cnt; int shift;
    __device__ __forceinline__ const float* row(int r) const { if (m0 + r >= cnt) return nullptr; const int a = list[m0 + r]; return base + (size_t)(a >> shift) * 2048; }
    __device__ __forceinline__ int koff(int k) const { return k; } };

struct EpiStore { float* C; int ldc; int m0; int n0; int mlim; int nlim; _Float16* C16;
    __device__ __forceinline__ void operator()(const f4 (&acc)[4][2], int wr, int wc, int fr, int fq) const {
#pragma unroll
        for (int m = 0; m < 4; ++m)
#pragma unroll
            for (int n = 0; n < 2; ++n)
#pragma unroll
                for (int j = 0; j < 4; ++j) { const int r = m0 + wr * 64 + m * 16 + fq * 4 + j, c = n0 + wc * 32 + n * 16 + fr;
                    if (r < mlim && c < nlim) { C[(size_t)r * ldc + c] = acc[m][n][j]; if (C16) C16[(size_t)r * ldc + c] = (_Float16)acc[m][n][j]; } } } };
struct EpiKc { _Float16* C; int m0;
    __device__ __forceinline__ void operator()(const f4 (&acc)[4][2], int wr, int wc, int fr, int fq) const {
#pragma unroll
        for (int m = 0; m < 4; ++m)
#pragma unroll
            for (int n = 0; n < 2; ++n)
#pragma unroll
                for (int j = 0; j < 4; ++j) { const int r = m0 + wr * 64 + m * 16 + fq * 4 + j, c = wc * 32 + n * 16 + fr;
                    C[(size_t)r * 128 + c] = (((r >> 1) & 127) == 127) ? (_Float16)0.f : (_Float16)acc[m][n][j]; } } };
struct EpiPool { _Float16* C; const float* scale; int m0; int g;
    __device__ __forceinline__ void operator()(const f4 (&acc)[4][2], int wr, int wc, int fr, int fq) const {
#pragma unroll
        for (int m = 0; m < 4; ++m)
#pragma unroll
            for (int n = 0; n < 2; ++n)
#pragma unroll
                for (int j = 0; j < 4; ++j) { const int r = m0 + wr * 64 + m * 16 + fq * 4 + j, c = g * 128 + wc * 32 + n * 16 + fr;
                    C[(size_t)r * 512 + c] = (_Float16)(acc[m][n][j] * scale[c]); } } };
struct EpiHid { float* C; const float* bias; int m0; int n0;
    __device__ __forceinline__ void operator()(const f4 (&acc)[4][2], int wr, int wc, int fr, int fq) const {
#pragma unroll
        for (int m = 0; m < 4; ++m)
#pragma unroll
            for (int n = 0; n < 2; ++n)
#pragma unroll
                for (int j = 0; j < 4; ++j) { const int r = m0 + wr * 64 + m * 16 + fq * 4 + j, c = n0 + wc * 32 + n * 16 + fr;
                    if (r < CROWS) C[(size_t)r * 256 + c] = gelu_tanh(acc[m][n][j] + bias[c]); } } };
struct EpiOut { float* C; const float* x; int m0; int n0;
    __device__ __forceinline__ void operator()(const f4 (&acc)[4][2], int wr, int wc, int fr, int fq) const {
#pragma unroll
        for (int m = 0; m < 4; ++m)
#pragma unroll
            for (int n = 0; n < 2; ++n)
#pragma unroll
                for (int j = 0; j < 4; ++j) { const size_t o = (size_t)(m0 + wr * 64 + m * 16 + fq * 4 + j) * 2048 + n0 + wc * 32 + n * 16 + fr;
                    C[o] = DN_ALPHA * x[o] + acc[m][n][j]; } } };
struct EpiGu { float* act; const float* bgu; const int* list; int m0; int cnt; int n0;
    __device__ __forceinline__ void operator()(const f4 (&acc)[4][2], int wr, int wc, int fr, int fq) const {
        const int jc = (n0 + wc * 32) / 2 + fr;
        const float bg = bgu[2 * jc], bl = bgu[2 * jc + 1];
#pragma unroll
        for (int m = 0; m < 4; ++m)
#pragma unroll
            for (int j = 0; j < 4; ++j) { const int r = m0 + wr * 64 + m * 16 + fq * 4 + j;
                if (r < cnt) { const int a = list[r];
                    const float xg = fminf(acc[m][0][j] + bg, 7.f), xl = fminf(fmaxf(acc[m][1][j] + bl, -7.f), 7.f);
                    act[(size_t)a * 2048 + jc] = xg * sigmoidf_(1.702f * xg) * (xl + 1.f); } } } };
struct EpiDn { float* y; const float* bdn; const int* list; const float* gate; int m0; int cnt; int n0;
    __device__ __forceinline__ void operator()(const f4 (&acc)[4][2], int wr, int wc, int fr, int fq) const {
#pragma unroll
        for (int m = 0; m < 4; ++m)
#pragma unroll
            for (int j = 0; j < 4; ++j) { const int r = m0 + wr * 64 + m * 16 + fq * 4 + j;
                if (r < cnt) { const int a = list[r]; const float g = gate[a];
#pragma unroll
                    for (int n = 0; n < 2; ++n) { const int c = n0 + wc * 32 + n * 16 + fr; y[(size_t)a * 2048 + c] = (acc[m][n][j] + bdn[c]) * g; } } } } };

constexpr int WLDS_FLOATS = 4096 + 512 + 32;
template <bool SHARED>
__device__ __forceinline__ void wave_attn(float* sw, const float* __restrict__ qptr, const float* __restrict__ Kb, const float* __restrict__ Vb, int ld, int nseg, float scale, float* __restrict__ optr) {
    const int lane = threadIdx.x & 63;
    float* sq = sw + 4096; const int* segs = (const int*)(sw + 4096 + 512);
#pragma unroll
    for (int i = 0; i < 8; ++i) sq[lane + 64 * i] = qptr[lane + 64 * i];
    wave_sync();
    for (int sg = 0; sg < nseg; ++sg) {
        const int start = segs[sg], len = segs[16 + sg];
        float d0 = 0.f, d1 = 0.f, d2 = 0.f, d3 = 0.f;
        if (lane < len) {
            const float* kp = Kb + (size_t)(start + lane) * ld;
            for (int d4 = 0; d4 < 32; ++d4) {
                if (SHARED) {
                    const float4 kv = *(const float4*)(kp + d4 * 4);
                    const float4 q0 = *(const float4*)(sq + d4 * 4), q1 = *(const float4*)(sq + 128 + d4 * 4), q2 = *(const float4*)(sq + 256 + d4 * 4), q3 = *(const float4*)(sq + 384 + d4 * 4);
                    d0 += kv.x * q0.x + kv.y * q0.y + kv.z * q0.z + kv.w * q0.w;
                    d1 += kv.x * q1.x + kv.y * q1.y + kv.z * q1.z + kv.w * q1.w;
                    d2 += kv.x * q2.x + kv.y * q2.y + kv.z * q2.z + kv.w * q2.w;
                    d3 += kv.x * q3.x + kv.y * q3.y + kv.z * q3.z + kv.w * q3.w;
                } else {
                    const float4 k0 = *(const float4*)(kp + d4 * 4), k1 = *(const float4*)(kp + 128 + d4 * 4), k2 = *(const float4*)(kp + 256 + d4 * 4), k3 = *(const float4*)(kp + 384 + d4 * 4);
                    const float4 q0 = *(const float4*)(sq + d4 * 4), q1 = *(const float4*)(sq + 128 + d4 * 4), q2 = *(const float4*)(sq + 256 + d4 * 4), q3 = *(const float4*)(sq + 384 + d4 * 4);
                    d0 += k0.x * q0.x + k0.y * q0.y + k0.z * q0.z + k0.w * q0.w;
                    d1 += k1.x * q1.x + k1.y * q1.y + k1.z * q1.z + k1.w * q1.w;
                    d2 += k2.x * q2.x + k2.y * q2.y + k2.z * q2.z + k2.w * q2.w;
                    d3 += k3.x * q3.x + k3.y * q3.y + k3.z * q3.z + k3.w * q3.w;
                }
            }
        }
        const bool ok = lane < len;
        sw[sg * 64 + lane] = ok ? d0 * scale : -1e30f;
        sw[1024 + sg * 64 + lane] = ok ? d1 * scale : -1e30f;
        sw[2048 + sg * 64 + lane] = ok ? d2 * scale : -1e30f;
        sw[3072 + sg * 64 + lane] = ok ? d3 * scale : -1e30f;
    }
    wave_sync();
    const int n = nseg * 64;
#pragma unroll
    for (int g = 0; g < 4; ++g) {
        float mx = -1e30f;
        for (int i = lane; i < n; i += 64) mx = fmaxf(mx, sw[g * 1024 + i]);
        mx = wave_max(mx);
        float sm = 0.f;
        for (int i = lane; i < n; i += 64) { const float v = sw[g * 1024 + i]; sm += (v > -1e29f) ? expf(v - mx) : 0.f; }
        sm = wave_sum(sm);
        const float inv = sm > 0.f ? 1.f / sm : 0.f;
        for (int i = lane; i < n; i += 64) { const float v = sw[g * 1024 + i]; sw[g * 1024 + i] = (v > -1e29f) ? expf(v - mx) * inv : 0.f; }
    }
    wave_sync();
    float o[4][2];
#pragma unroll
    for (int g = 0; g < 4; ++g) { o[g][0] = 0.f; o[g][1] = 0.f; }
    for (int sg = 0; sg < nseg; ++sg) {
        const int start = segs[sg], len = segs[16 + sg];
        for (int l = 0; l < len; ++l) {
            const float* vp = Vb + (size_t)(start + l) * ld;
            if (SHARED) {
                const float v0 = vp[lane], v1 = vp[lane + 64];
#pragma unroll
                for (int g = 0; g < 4; ++g) { const float p = sw[g * 1024 + sg * 64 + l]; o[g][0] += p * v0; o[g][1] += p * v1; }
            } else {
#pragma unroll
                for (int g = 0; g < 4; ++g) { const float p = sw[g * 1024 + sg * 64 + l]; o[g][0] += p * vp[g * 128 + lane]; o[g][1] += p * vp[g * 128 + lane + 64]; }
            }
        }
    }
#pragma unroll
    for (int g = 0; g < 4; ++g) { optr[g * 128 + lane] = o[g][0]; optr[g * 128 + lane + 64] = o[g][1]; }
}

namespace g8 {
constexpr int BM = 256, BK = 64, HALF = 128, HTB = HALF * BK * 2, STAGE_BYTES = 8 * HTB;
constexpr int KK = 2048;
typedef float f32x4 __attribute__((ext_vector_type(4)));
__device__ __forceinline__ int lds_byte(int r, int c) { const int st = (r >> 4) * 2 + (c >> 5), rr = r & 15, cc = c & 31, ob = rr * 64 + cc * 2; return st * 1024 + (ob ^ (((ob >> 9) & 1) << 5)); }
__device__ __forceinline__ void stage_rc(int b, int& R, int& C) { const int st = b / 1024, sb = b % 1024, swz = sb ^ (((sb >> 9) & 1) << 5); R = (st >> 1) * 16 + swz / 64; C = (st & 1) * 32 + (swz % 64) / 2; }
__device__ __forceinline__ int perm32(int rho) { const int n = rho >> 4, i = rho & 15; return 8 * (i >> 2) + 4 * n + (i & 3); }

typedef int i32x4 __attribute__((ext_vector_type(4)));
typedef unsigned u32x2 __attribute__((ext_vector_type(2)));
typedef unsigned u32x4 __attribute__((ext_vector_type(4)));
template <bool I8> struct AccSel { typedef f32x4 T; };
template <> struct AccSel<true> { typedef i32x4 T; };
__device__ __forceinline__ f32x4 mma16(i32x4 a, i32x4 b, f32x4 c) { return __builtin_amdgcn_mfma_f32_16x16x32_f16(*reinterpret_cast<h8*>(&a), *reinterpret_cast<h8*>(&b), c, 0, 0, 0); }
__device__ __forceinline__ i32x4 mma16(i32x4 a, i32x4 b, i32x4 c) { return __builtin_amdgcn_mfma_i32_16x16x64_i8(a, b, c, 0, 0, 0); }
struct Unit { int m0, n0, e, cnt, rbase; };
constexpr int EP_OFF = STAGE_BYTES + 2048, EP_LD = 528, EP_GRP = 16 * EP_LD;
__device__ __forceinline__ void ep_sync() { asm volatile("s_waitcnt lgkmcnt(0)" ::: "memory"); __builtin_amdgcn_s_barrier(); asm volatile("" ::: "memory"); }
__device__ __forceinline__ int ep_tid() { int tz = threadIdx.x; asm volatile("" : "+v"(tz)); return tz; }
__device__ __forceinline__ h8 cvt8(f32x4 a, f32x4 b) { h8 o; o[0] = (_Float16)a[0]; o[1] = (_Float16)a[1]; o[2] = (_Float16)a[2]; o[3] = (_Float16)a[3]; o[4] = (_Float16)b[0]; o[5] = (_Float16)b[1]; o[6] = (_Float16)b[2]; o[7] = (_Float16)b[3]; return o; }

__device__ __forceinline__ void tile_order(int L, int nM, int nN, int& pm, int& pn) {
    const int nwg = nM * nN; int wgid = L;
    { const int q = nwg / 8, r = nwg % 8, xcd = wgid % 8, off = wgid / 8; wgid = (xcd < r ? xcd * (q + 1) : r * (q + 1) + (xcd - r) * q) + off; }
    const int nig = 8 * nN, gid = wgid / nig, fm = gid * 8, gsz = (nM - fm) < 8 ? (nM - fm) : 8;
    pm = fm + ((wgid % nig) % gsz); pn = (wgid % nig) / gsz;
}

template <class Prob>
__device__ __forceinline__ void gemm_phase(LAS unsigned char* lds, const Prob& P) {
    const int tid = threadIdx.x, wid = __builtin_amdgcn_readfirstlane(tid >> 6), lane = tid & 63, wr = wid >> 2, wc = wid & 3, fr = lane & 15, fq = lane >> 4;
    constexpr int nt = Prob::NT; constexpr size_t KS2 = Prob::KS2; constexpr unsigned ROWB = Prob::ROWB; constexpr bool I8 = Prob::I8;
    int sR[2], sC2[2]; unsigned voffB[2];
#pragma unroll
    for (int i = 0; i < 2; ++i) { int R, C; stage_rc(tid * 16 + i * 8192, R, C); sR[i] = R; sC2[i] = C * 2; const int Rb = Prob::PERM ? ((R & ~31) + perm32(R & 31)) : R; voffB[i] = (unsigned)Rb * ROWB + (unsigned)C * 2u; }
    const size_t kstep = (size_t)(BK * 2);
    const size_t hstep = (size_t)HALF * ROWB;
    const unsigned ldsw = (unsigned)wid * 1024u;
    const int aoff = lds_byte(wr * 64 + fr, fq * 8), boff = lds_byte(wc * 32 + fr, fq * 8);
#define G8_SA(b, h) (((b) * 2 + (h)) * HTB)
#define G8_SB(b, h) ((4 + (b) * 2 + (h)) * HTB)
#define G8_STAGE(bufoff, gbase, voff) do { _Pragma("unroll") for (int _i = 0; _i < 2; ++_i) \
        __builtin_amdgcn_global_load_lds((const unsigned*)((const char*)(gbase) + (voff)[_i]), (LAS unsigned*)(lds + (bufoff) + ldsw + _i * 8192), 16, 0, 0); } while (0)
#define G8_LDA(dst, b, h) do { _Pragma("unroll") for (int m = 0; m < 4; ++m) _Pragma("unroll") for (int k = 0; k < 2; ++k) dst[m][k] = *(const LAS i32x4*)(lds + G8_SA(b, h) + aoff + m * 2048 + k * 1024); } while (0)
#define G8_LDB(dst, b, h) do { _Pragma("unroll") for (int n = 0; n < 2; ++n) _Pragma("unroll") for (int k = 0; k < 2; ++k) dst[n][k] = *(const LAS i32x4*)(lds + G8_SB(b, h) + boff + n * 2048 + k * 1024); } while (0)
#define G8_MMA(ai, bj, At, Bt) do { __builtin_amdgcn_s_setprio(1); _Pragma("unroll") for (int m = 0; m < 4; ++m) _Pragma("unroll") for (int n = 0; n < 2; ++n) _Pragma("unroll") for (int k = 0; k < 2; ++k) \
        acc[ai][bj][m][n] = mma16(Bt[n][k], At[m][k], acc[ai][bj][m][n]); __builtin_amdgcn_s_setprio(0); } while (0)
#define G8_WAIT_V(n) asm volatile("s_waitcnt vmcnt(" #n ")" ::: "memory")
#define G8_WAIT_L(n) asm volatile("s_waitcnt lgkmcnt(" #n ")" ::: "memory")
#define G8_BAR __builtin_amdgcn_s_barrier()
#define G8_SCHED __builtin_amdgcn_sched_barrier(0)
    Unit cur, nxt; int ui = 0;
    if (!P.next(0, cur)) return;
    typedef typename AccSel<I8>::T AccT;
    AccT acc[2][2][4][2];
#pragma unroll
    for (int a = 0; a < 2; ++a)
#pragma unroll
        for (int b = 0; b < 2; ++b)
#pragma unroll
            for (int m = 0; m < 4; ++m)
#pragma unroll
                for (int n = 0; n < 2; ++n) acc[a][b][m][n] = AccT{};
    i32x4 At[4][2], B0[2][2], B1[2][2];
    unsigned vc[2][2], vn[2][2];
    P.a_offs(cur, sR, sC2, vc);
    const char* const Ab = P.a_base();
    const char* cB = P.b_base(cur);
    G8_STAGE(G8_SB(0, 0), cB, voffB); G8_STAGE(G8_SA(0, 0), Ab, vc[0]); G8_STAGE(G8_SB(0, 1), cB + hstep, voffB); G8_STAGE(G8_SA(0, 1), Ab, vc[1]);
    if (wr == 1) G8_BAR;
    G8_WAIT_V(4); G8_BAR;
    G8_STAGE(G8_SB(1, 0), cB + kstep, voffB); G8_STAGE(G8_SA(1, 0), Ab + kstep, vc[0]); G8_STAGE(G8_SB(1, 1), cB + hstep + kstep, voffB);
    G8_WAIT_V(6); G8_BAR;
    for (;;) {
        const bool has_next = P.next(ui + 1, nxt);
        const char* nB = cB;
        if (has_next) { P.a_offs(nxt, sR, sC2, vn); nB = P.b_base(nxt); }
        else { vn[0][0] = vc[0][0]; vn[0][1] = vc[0][1]; vn[1][0] = vc[1][0]; vn[1][1] = vc[1][1]; }
        for (int t = 0; t < nt; t += 2) {
            const bool last = (t == nt - 2);
            const char* a1 = Ab + (size_t)(t >> 1) * KS2 + kstep;
            const char* a2 = last ? Ab : Ab + (size_t)((t + 2) >> 1) * KS2; const char* b2 = last ? nB : cB + (size_t)(t + 2) * kstep;
            const char* a3 = a2 + kstep; const char* b3 = b2 + kstep;
            unsigned o2[2][2];
            o2[0][0] = last ? vn[0][0] : vc[0][0]; o2[0][1] = last ? vn[0][1] : vc[0][1]; o2[1][0] = last ? vn[1][0] : vc[1][0]; o2[1][1] = last ? vn[1][1] : vc[1][1];
            G8_LDB(B0, 0, 0); G8_SCHED; G8_LDA(At, 0, 0); G8_STAGE(G8_SA(1, 1), a1, vc[1]);
            G8_WAIT_L(8); G8_BAR; G8_WAIT_L(0); G8_MMA(0, 0, At, B0); G8_BAR; G8_SCHED;
            G8_LDB(B1, 0, 1); G8_STAGE(G8_SB(0, 0), b2, voffB);
            G8_BAR; G8_WAIT_L(0); G8_MMA(0, 1, At, B1); G8_BAR;
            G8_LDA(At, 0, 1); G8_STAGE(G8_SA(0, 0), a2, o2[0]);
            G8_BAR; G8_WAIT_L(0); G8_MMA(1, 0, At, B0); G8_BAR; G8_SCHED;
            G8_STAGE(G8_SB(0, 1), b2 + hstep, voffB);
            G8_WAIT_V(6); G8_BAR; G8_MMA(1, 1, At, B1); G8_BAR;
            G8_LDB(B0, 1, 0); G8_SCHED; G8_LDA(At, 1, 0); G8_STAGE(G8_SA(0, 1), a2, o2[1]);
            G8_WAIT_L(8); G8_BAR; G8_WAIT_L(0); G8_MMA(0, 0, At, B0); G8_BAR; G8_SCHED;
            G8_LDB(B1, 1, 1); G8_STAGE(G8_SB(1, 0), b3, voffB);
            G8_BAR; G8_WAIT_L(0); G8_MMA(0, 1, At, B1); G8_BAR;
            G8_LDA(At, 1, 1); G8_STAGE(G8_SA(1, 0), a3, o2[0]);
            G8_BAR; G8_WAIT_L(0); G8_MMA(1, 0, At, B0); G8_BAR; G8_SCHED;
            G8_STAGE(G8_SB(1, 1), b3 + hstep, voffB);
            G8_WAIT_V(6); G8_BAR; G8_MMA(1, 1, At, B1); G8_BAR;
        }
        P.epi(acc, cur, wr, wc, fr, fq, lds);
        if (!has_next) break;
#pragma unroll
        for (int a = 0; a < 2; ++a)
#pragma unroll
            for (int b = 0; b < 2; ++b)
#pragma unroll
                for (int m = 0; m < 4; ++m)
#pragma unroll
                    for (int n = 0; n < 2; ++n) acc[a][b][m][n] = AccT{};
        cur = nxt; cB = nB; ++ui;
        vc[0][0] = vn[0][0]; vc[0][1] = vn[0][1]; vc[1][0] = vn[1][0]; vc[1][1] = vn[1][1];
    }
    G8_WAIT_V(0);
    if (wr == 0) G8_BAR;
    G8_BAR;
#undef G8_SA
#undef G8_SB
#undef G8_STAGE
#undef G8_LDA
#undef G8_LDB
#undef G8_MMA
#undef G8_WAIT_V
#undef G8_WAIT_L
#undef G8_BAR
#undef G8_SCHED
}

struct ProbInF {
    static constexpr unsigned ROWB = 4096; static constexpr bool I8 = false;
    static constexpr int NT = 32; static constexpr size_t KS2 = 256;
    static constexpr bool PERM = true;
    const _Float16* A; _Float16* C16; int G, c;
    __device__ __forceinline__ bool next(int i, Unit& u) const { const int L = i * G + c; if (L >= 64 * 5) return false;
        int pm, pn; tile_order(L, 64, 5, pm, pn); u.m0 = pm * 256; u.n0 = pn * 256; u.e = 0; u.cnt = 256; u.rbase = 0; return true; }
    __device__ __forceinline__ void a_offs(const Unit& u, const int (&R)[2], const int (&C2)[2], unsigned (&v)[2][2]) const {
#pragma unroll
        for (int h = 0; h < 2; ++h)
#pragma unroll
            for (int i = 0; i < 2; ++i) v[h][i] = (unsigned)(u.m0 + h * 128 + R[i]) * (unsigned)(KK * 2) + (unsigned)C2[i]; }
    __device__ __forceinline__ const char* a_base() const { return (const char*)A; }
    __device__ __forceinline__ const char* b_base(const Unit& u) const { return (const char*)A + (long long)(WS_WTIN - WS_X16) + (size_t)u.n0 * KK * 2; }
    __device__ __forceinline__ void epi(const f32x4 (&acc)[2][2][4][2], const Unit& u, int wr, int wc, int fr, int fq, LAS unsigned char* lds) const {
        LAS unsigned char* ep = lds + EP_OFF + wr * EP_GRP;
        const int tg = ep_tid() & 255, rrow = tg >> 4, ch = tg & 15;
        const int kvseg = (u.e == 0 && u.n0 >= 1024 && u.n0 < 2560) ? ((u.n0 - 1024) >> 8) : -1;
        _Float16* const Cb = (_Float16*)((char*)C16 + (u.e ? (long long)(WS_KVMEM16 - WS_PROJ16) : 0ll)); const int ldc = u.e ? 1024 : INW, nlim = u.e ? 1024 : INW, mb = u.e ? u.m0 - T_ : u.m0;
#pragma unroll
        for (int ai = 0; ai < 2; ++ai)
#pragma unroll
            for (int m = 0; m < 4; ++m) {
#pragma unroll
                for (int bj = 0; bj < 2; ++bj) *(LAS h8*)(ep + fr * EP_LD + (bj * 128 + wc * 32 + fq * 8) * 2) = cvt8(acc[ai][bj][m][0], acc[ai][bj][m][1]);
                ep_sync();
                const h8 x0 = *(const LAS h8*)(ep + rrow * EP_LD + ch * 32), x1 = *(const LAS h8*)(ep + rrow * EP_LD + ch * 32 + 16);
                const int grow = mb + ai * 128 + wr * 64 + m * 16 + rrow, gcol = u.n0 + ch * 16;
                if (kvseg >= 0) {
                    _Float16* dst = (_Float16*)((char*)C16 + (long long)(WS_KV16 - WS_PROJ16)) + ((size_t)(kvseg * B_ + (grow >> 11)) * 2 + (ch >> 3)) * KVSEG + (size_t)(grow & (S_ - 1)) * 128 + (ch & 7) * 16;
                    *(h8*)dst = x0; *(h8*)(dst + 8) = x1;
                } else {
                    if (gcol < nlim) *(h8*)(Cb + (size_t)grow * ldc + gcol) = x0;
                    if (gcol + 8 < nlim) *(h8*)(Cb + (size_t)grow * ldc + gcol + 8) = x1; }
                ep_sync();
            } }
};
struct ProbIn8 {
    static constexpr unsigned ROWB = 2048; static constexpr bool I8 = true;
    static constexpr int NT = 16; static constexpr size_t KS2 = 256;
    static constexpr bool PERM = true;
    const signed char* A; _Float16* C16; const float* sa; int G, c;
    __device__ __forceinline__ bool next(int i, Unit& u) const { const int L = i * G + c; if (L >= 640 + 32) return false;
        if (L < 640) { int pm, pn; tile_order(L, 64, 10, pm, pn); u.m0 = pm * 256; u.n0 = 1280 + pn * 256; u.e = 0; }
        else { const int v = L - 640; u.m0 = T_ + (v & 7) * 256; u.n0 = (v >> 3) * 256; u.e = 1; }
        u.cnt = 256; u.rbase = 0; return true; }
    __device__ __forceinline__ void a_offs(const Unit& u, const int (&R)[2], const int (&C2)[2], unsigned (&v)[2][2]) const {
#pragma unroll
        for (int h = 0; h < 2; ++h)
#pragma unroll
            for (int i = 0; i < 2; ++i) v[h][i] = (unsigned)(u.m0 + h * 128 + R[i]) * 2048u + (unsigned)C2[i]; }
    __device__ __forceinline__ const char* a_base() const { return (const char*)A; }
    __device__ __forceinline__ const char* b_base(const Unit& u) const { return (const char*)A + (u.e ? (long long)(WS_Q8MKV - WS_X8) + (long long)u.n0 * 2048 : (long long)(WS_Q8IN - WS_X8) + (long long)(u.n0 - 1280) * 2048); }
    __device__ __forceinline__ void epi(const i32x4 (&acc)[2][2][4][2], const Unit& u, int wr, int wc, int fr, int fq, LAS unsigned char* lds) const {
        LAS unsigned char* ep = lds + EP_OFF + wr * EP_GRP;
        const int tg = ep_tid() & 255, rrow = tg >> 4, ch = tg & 15;
        const int kvseg = (u.e == 0 && u.n0 >= 1024 && u.n0 < 2560) ? ((u.n0 - 1024) >> 8) : -1;
        _Float16* const Cb = (_Float16*)((char*)C16 + (u.e ? (long long)(WS_KVMEM16 - WS_PROJ16) : 0ll)); const int ldc = u.e ? 1024 : INW, nlim = u.e ? 1024 : INW, mb = u.e ? u.m0 - T_ : u.m0;
        const float* sw = (const float*)((const char*)A + (u.e ? (long long)(WS_SMKV - WS_X8) : (long long)(WS_SIN8 - WS_X8))) + (u.e ? u.n0 : u.n0 - 1280);
        f32x4 s0[2], s1[2]; float srv[8];
#pragma unroll
        for (int bj = 0; bj < 2; ++bj) { const int col = bj * 128 + wc * 32 + fq * 8; s0[bj] = *(const f32x4*)(sw + col); s1[bj] = *(const f32x4*)(sw + col + 4); }
#pragma unroll
        for (int q = 0; q < 8; ++q) srv[q] = sa[u.m0 + (q >> 2) * 128 + wr * 64 + (q & 3) * 16 + fr];
#pragma unroll
        for (int ai = 0; ai < 2; ++ai)
#pragma unroll
            for (int m = 0; m < 4; ++m) { const float sr = srv[ai * 4 + m];
#pragma unroll
                for (int bj = 0; bj < 2; ++bj) { const i32x4 i0 = acc[ai][bj][m][0], i1 = acc[ai][bj][m][1];
                    *(LAS h8*)(ep + fr * EP_LD + (bj * 128 + wc * 32 + fq * 8) * 2) = cvt8((f32x4){(float)i0[0], (float)i0[1], (float)i0[2], (float)i0[3]} * (s0[bj] * sr), (f32x4){(float)i1[0], (float)i1[1], (float)i1[2], (float)i1[3]} * (s1[bj] * sr)); }
                ep_sync();
                const h8 x0 = *(const LAS h8*)(ep + rrow * EP_LD + ch * 32), x1 = *(const LAS h8*)(ep + rrow * EP_LD + ch * 32 + 16);
                const int grow = mb + ai * 128 + wr * 64 + m * 16 + rrow, gcol = u.n0 + ch * 16;
                if (kvseg >= 0) {
                    _Float16* dst = (_Float16*)((char*)C16 + (long long)(WS_KV16 - WS_PROJ16)) + ((size_t)(kvseg * B_ + (grow >> 11)) * 2 + (ch >> 3)) * KVSEG + (size_t)(grow & (S_ - 1)) * 128 + (ch & 7) * 16;
                    *(h8*)dst = x0; *(h8*)(dst + 8) = x1;
                } else {
                    if (gcol < nlim) *(h8*)(Cb + (size_t)grow * ldc + gcol) = x0;
                    if (gcol + 8 < nlim) *(h8*)(Cb + (size_t)grow * ldc + gcol + 8) = x1; }
                ep_sync();
            } }
};
struct ProbOut {
    static constexpr unsigned ROWB = 2048; static constexpr bool I8 = true;
    static constexpr int NT = 16; static constexpr size_t KS2 = 256;
    static constexpr bool PERM = true;
    const signed char* A; const signed char* Bt; _Float16* C; const _Float16* X; const float* sa; const float* sw; int G, c;
    __device__ __forceinline__ bool next(int i, Unit& u) const { const int L = i * G + c; if (L >= 64 * 8) return false; int pm, pn; tile_order(L, 64, 8, pm, pn); u.m0 = pm * 256; u.n0 = pn * 256; u.e = 0; u.cnt = 256; u.rbase = 0; return true; }
    __device__ __forceinline__ void a_offs(const Unit& u, const int (&R)[2], const int (&C2)[2], unsigned (&v)[2][2]) const {
#pragma unroll
        for (int h = 0; h < 2; ++h)
#pragma unroll
            for (int i = 0; i < 2; ++i) v[h][i] = (unsigned)(u.m0 + h * 128 + R[i]) * 2048u + (unsigned)C2[i]; }
    __device__ __forceinline__ const char* a_base() const { return (const char*)A; }
    __device__ __forceinline__ const char* b_base(const Unit& u) const { return (const char*)(Bt + (size_t)u.n0 * 2048); }
    __device__ __forceinline__ void epi(const i32x4 (&acc)[2][2][4][2], const Unit& u, int wr, int wc, int fr, int fq, LAS unsigned char* lds) const {
        LAS unsigned char* ep = lds + EP_OFF + wr * EP_GRP;
        const int tg = ep_tid() & 255, rrow = tg >> 4, ch = tg & 15;
        f32x4 s0[2], s1[2]; float srv[8];
#pragma unroll
        for (int bj = 0; bj < 2; ++bj) { const int col = u.n0 + bj * 128 + wc * 32 + fq * 8; s0[bj] = *(const f32x4*)(sw + col); s1[bj] = *(const f32x4*)(sw + col + 4); }
#pragma unroll
        for (int q = 0; q < 8; ++q) srv[q] = sa[u.m0 + (q >> 2) * 128 + wr * 64 + (q & 3) * 16 + fr];
#pragma unroll
        for (int ai = 0; ai < 2; ++ai)
#pragma unroll
            for (int m = 0; m < 4; ++m) { const float sr = srv[ai * 4 + m];
#pragma unroll
                for (int bj = 0; bj < 2; ++bj) { const i32x4 i0 = acc[ai][bj][m][0], i1 = acc[ai][bj][m][1];
                    *(LAS h8*)(ep + fr * EP_LD + (bj * 128 + wc * 32 + fq * 8) * 2) = cvt8((f32x4){(float)i0[0], (float)i0[1], (float)i0[2], (float)i0[3]} * (s0[bj] * sr), (f32x4){(float)i1[0], (float)i1[1], (float)i1[2], (float)i1[3]} * (s1[bj] * sr)); }
                const size_t go = (size_t)(u.m0 + ai * 128 + wr * 64 + m * 16 + rrow) * 2048 + u.n0 + ch * 16;
                const h8 r0 = *(const h8*)(X + go), r1 = *(const h8*)(X + go + 8);
                ep_sync();
                const h8 x0 = *(const LAS h8*)(ep + rrow * EP_LD + ch * 32), x1 = *(const LAS h8*)(ep + rrow * EP_LD + ch * 32 + 16);
                h8 o0, o1;
#pragma unroll
                for (int q = 0; q < 8; ++q) { o0[q] = (_Float16)(DN_ALPHA * (float)r0[q] + (float)x0[q]); o1[q] = (_Float16)(DN_ALPHA * (float)r1[q] + (float)x1[q]); }
                *(h8*)(C + go) = o0; *(h8*)(C + go + 8) = o1;
                ep_sync();
            } }
};
struct ProbCmp {
    static constexpr unsigned ROWB = 4096; static constexpr bool I8 = false;
    static constexpr int NT = 8; static constexpr size_t KS2 = 256;
    static constexpr bool PERM = false;
    const _Float16* A; const _Float16* Bt; float* C; int G, c;
    __device__ __forceinline__ bool next(int i, Unit& u) const { const int L = i * G + c; if (L >= 128) return false;
        u.e = L >> 6; const int r = L & 63; u.rbase = r & 3; u.n0 = ((r >> 2) & 1) * 256; u.m0 = (r >> 3) * 256; u.cnt = 256; return true; }
    __device__ __forceinline__ void a_offs(const Unit& u, const int (&R)[2], const int (&C2)[2], unsigned (&v)[2][2]) const {
#pragma unroll
        for (int h = 0; h < 2; ++h)
#pragma unroll
            for (int i = 0; i < 2; ++i) { const int row = u.m0 + h * 128 + R[i], kvh = row & 1, bj = row >> 1, b = bj >> 7, j = bj & 127;
                v[h][i] = (unsigned)((((u.e * B_ + b) * 2 + kvh) * S_ + 16 * j + 4 * u.rbase) * 128) * 2u + (unsigned)C2[i]; } }
    __device__ __forceinline__ const char* a_base() const { return (const char*)A; }
    __device__ __forceinline__ const char* b_base(const Unit& u) const { return (const char*)(Bt + ((size_t)u.e * 512 + u.n0) * KK + u.rbase * 512); }
    __device__ __forceinline__ void epi(const f32x4 (&acc)[2][2][4][2], const Unit& u, int wr, int wc, int fr, int fq, LAS unsigned char*) const {
        float* base = C + ((size_t)(u.e * 4 + u.rbase) * 2048) * 512;
#pragma unroll
        for (int ai = 0; ai < 2; ++ai)
#pragma unroll
            for (int m = 0; m < 4; ++m) { const int row = u.m0 + ai * 128 + wr * 64 + m * 16 + fr;
#pragma unroll
                for (int bj = 0; bj < 2; ++bj)
#pragma unroll
                    for (int n = 0; n < 2; ++n) { const int col = u.n0 + bj * 128 + wc * 32 + n * 16 + fq * 4;
                        *(f32x4*)(base + (size_t)row * 512 + col) = acc[ai][bj][m][n]; } } }
};
struct MoeTab { const LAS int* t; int NT;
    __device__ __forceinline__ bool find_i(int i, Unit& u) const {
        const LAS int* q = t + 128 + 8 * i;
        if (__builtin_amdgcn_readfirstlane(q[5]) == 0) return false;
        u.e = __builtin_amdgcn_readfirstlane(q[0]); u.m0 = __builtin_amdgcn_readfirstlane(q[1]); u.n0 = __builtin_amdgcn_readfirstlane(q[2]); u.cnt = __builtin_amdgcn_readfirstlane(q[3]); u.rbase = __builtin_amdgcn_readfirstlane(q[4]); return true; } };
__device__ __forceinline__ void moe_build(LAS int* t, int G, int vcu) {
    const int i = threadIdx.x;
    if (i < 40) { const int L = i * G + vcu; LAS int* q = t + 128 + 8 * i;
        if (L >= t[98]) q[5] = 0;
        else { int e = 0; for (; e < NE - 1; ++e) { if (L < t[32 + e + 1]) break; }
            const int ub = t[32 + e], cn = t[e], rs = t[65 + e]; const int nm = (cn + 255) >> 8, v = L - ub, mt = v % nm, ntile = v / nm;
            q[0] = e; q[1] = mt * 256; q[2] = ntile * 256; q[3] = min(256, cn - mt * 256); q[4] = rs; q[5] = 1; } }
}
struct ProbGu {
    static constexpr int NT = 16; static constexpr size_t KS2 = 256; static constexpr unsigned ROWB = 2048; static constexpr bool I8 = true;
    static constexpr bool PERM = true;
    const signed char* A; const signed char* Bt; unsigned char* act; const float* bgu; const int* list; const float* sa; const float* sw; MoeTab tab; int G, vcu;
    __device__ __forceinline__ bool next(int i, Unit& u) const { return tab.find_i(i, u); }
    __device__ __forceinline__ void a_offs(const Unit& u, const int (&R)[2], const int (&C2)[2], unsigned (&v)[2][2]) const {
#pragma unroll
        for (int h = 0; h < 2; ++h)
#pragma unroll
            for (int i = 0; i < 2; ++i) { int r = h * 128 + R[i]; r = r < u.cnt ? r : 0; const int a = list[(size_t)u.e * T_ + u.m0 + r]; v[h][i] = (unsigned)(a >> 2) * 2048u + (unsigned)C2[i]; } }
    __device__ __forceinline__ const char* a_base() const { return (const char*)A; }
    __device__ __forceinline__ const char* b_base(const Unit& u) const { return (const char*)(Bt + ((size_t)u.e * 4096 + u.n0) * 2048); }
    __device__ __forceinline__ void epi(const i32x4 (&acc)[2][2][4][2], const Unit& u, int wr, int wc, int fr, int fq, LAS unsigned char* lds) const {
        const float* bb = bgu + (size_t)u.e * 4096; const float* ss = sw + (size_t)u.e * 4096;
        LAS unsigned char* ep = lds + EP_OFF + wr * EP_GRP;
        const int tg = ep_tid() & 255, rrow = tg >> 4, ch = tg & 15;
        f32x4 b0[2], b1[2], s0[2], s1[2];
#pragma unroll
        for (int bj = 0; bj < 2; ++bj) { const int col = u.n0 + bj * 128 + wc * 32 + fq * 8;
            b0[bj] = *(const f32x4*)(bb + col); b1[bj] = *(const f32x4*)(bb + col + 4); s0[bj] = *(const f32x4*)(ss + col); s1[bj] = *(const f32x4*)(ss + col + 4); }
        float srv[8];
#pragma unroll
        for (int q = 0; q < 8; ++q) { const int rl = (q >> 2) * 128 + wr * 64 + (q & 3) * 16 + fr; srv[q] = sa[(size_t)u.e * T_ + u.m0 + (rl < u.cnt ? rl : 0)]; }
        LAS unsigned char* ep2 = lds + EP_OFF + wr * (2 * 4608);
#define GU_WRITE(st) do { const int ai_ = (st) >> 1, mp_ = (st) & 1; LAS unsigned char* eb = ep2 + ((st) & 1) * 4608; \
            _Pragma("unroll") for (int mm = 0; mm < 2; ++mm) { const int m_ = mp_ * 2 + mm; const float sr = srv[ai_ * 4 + m_]; \
                _Pragma("unroll") for (int bj = 0; bj < 2; ++bj) { const i32x4 i0 = acc[ai_][bj][m_][0], i1 = acc[ai_][bj][m_][1]; \
                    const f32x4 v0 = (f32x4){(float)i0[0], (float)i0[1], (float)i0[2], (float)i0[3]} * (s0[bj] * sr) + b0[bj], v1 = (f32x4){(float)i1[0], (float)i1[1], (float)i1[2], (float)i1[3]} * (s1[bj] * sr) + b1[bj]; \
                    *(LAS unsigned*)(eb + (mm * 16 + fr) * 144 + (bj * 64 + wc * 16 + fq * 4)) = pk4_fp8(swiglu_fast(v0[0], v0[1]), swiglu_fast(v0[2], v0[3]), swiglu_fast(v1[0], v1[1]), swiglu_fast(v1[2], v1[3])); } } } while (0)
        GU_WRITE(0);
        ep_sync();
#pragma unroll
        for (int st = 0; st < 4; ++st) {
            if (st + 1 < 4) GU_WRITE(st + 1);
#pragma unroll
            for (int mm = 0; mm < 2; ++mm) { const u32x2 x0 = *(const LAS u32x2*)(ep2 + (st & 1) * 4608 + (mm * 16 + rrow) * 144 + ch * 8);
                const int rr = (st >> 1) * 128 + wr * 64 + ((st & 1) * 2 + mm) * 16 + rrow;
                if (rr < u.cnt) *(u32x2*)(act + (size_t)(u.rbase + u.m0 + rr) * 2048 + (u.n0 >> 1) + ch * 8) = x0; }
            ep_sync();
        }
#undef GU_WRITE
    }
};
struct ProbDn {
    static constexpr int NT = 16; static constexpr size_t KS2 = 256; static constexpr unsigned ROWB = 2048; static constexpr bool I8 = true;
    static constexpr bool PERM = true;
    const signed char* A; const signed char* Bt; unsigned char* y; const float* bdn; const int* list; const float* gate; const float* sa; const float* sw; MoeTab tab; int G, vcu;
    __device__ __forceinline__ bool next(int i, Unit& u) const { return tab.find_i(i, u); }
    __device__ __forceinline__ void a_offs(const Unit& u, const int (&R)[2], const int (&C2)[2], unsigned (&v)[2][2]) const {
#pragma unroll
        for (int h = 0; h < 2; ++h)
#pragma unroll
            for (int i = 0; i < 2; ++i) v[h][i] = (unsigned)(u.rbase + u.m0 + h * 128 + R[i]) * 2048u + (unsigned)C2[i]; }
    __device__ __forceinline__ const char* a_base() const { return (const char*)A; }
    __device__ __forceinline__ const char* b_base(const Unit& u) const { return (const char*)(Bt + ((size_t)u.e * 2048 + u.n0) * 2048); }
    __device__ __forceinline__ void epi(const i32x4 (&acc)[2][2][4][2], const Unit& u, int wr, int wc, int fr, int fq, LAS unsigned char* lds) const {
        const float* bb = bdn + (size_t)u.e * 2048; const float* ss = sw + (size_t)u.e * 2048;
        LAS unsigned char* ep = lds + EP_OFF + wr * (2 * 4352);
        const int tg = ep_tid() & 255, rrow = tg >> 4, ch = tg & 15;
        f32x4 b0[2], b1[2], s0[2], s1[2];
#pragma unroll
        for (int bj = 0; bj < 2; ++bj) { const int col = u.n0 + bj * 128 + wc * 32 + fq * 8;
            b0[bj] = *(const f32x4*)(bb + col); b1[bj] = *(const f32x4*)(bb + col + 4); s0[bj] = *(const f32x4*)(ss + col); s1[bj] = *(const f32x4*)(ss + col + 4); }
        float gv[8], srv[8]; int a2v[8];
        { int av[8];
#pragma unroll
          for (int q = 0; q < 8; ++q) { const int rl = (q >> 2) * 128 + wr * 64 + (q & 3) * 16 + fr, rc = rl < u.cnt ? rl : 0; av[q] = 0; gv[q] = gate[(size_t)u.e * T_ + u.m0 + rc]; srv[q] = sa[u.rbase + u.m0 + rc];
              const int rr = (q >> 2) * 128 + wr * 64 + (q & 3) * 16 + rrow; a2v[q] = list[(size_t)u.e * T_ + u.m0 + (rr < u.cnt ? rr : 0)]; }
          (void)av; }
#define DN_WRITE(st) do { const int ai_ = (st) >> 2, m_ = (st) & 3; const float g = gv[st] * 16.f, sr = srv[st]; LAS unsigned char* eb = ep + ((st) & 1) * 4352; \
            _Pragma("unroll") for (int bj = 0; bj < 2; ++bj) { const i32x4 i0 = acc[ai_][bj][m_][0], i1 = acc[ai_][bj][m_][1]; \
                const f32x4 v0 = ((f32x4){(float)i0[0], (float)i0[1], (float)i0[2], (float)i0[3]} * (s0[bj] * sr) + b0[bj]) * g, v1 = ((f32x4){(float)i1[0], (float)i1[1], (float)i1[2], (float)i1[3]} * (s1[bj] * sr) + b1[bj]) * g; \
                u32x2 o; o[0] = pk4_fp8(__builtin_amdgcn_fmed3f(v0[0], -440.f, 440.f), __builtin_amdgcn_fmed3f(v0[1], -440.f, 440.f), __builtin_amdgcn_fmed3f(v0[2], -440.f, 440.f), __builtin_amdgcn_fmed3f(v0[3], -440.f, 440.f)); o[1] = pk4_fp8(__builtin_amdgcn_fmed3f(v1[0], -440.f, 440.f), __builtin_amdgcn_fmed3f(v1[1], -440.f, 440.f), __builtin_amdgcn_fmed3f(v1[2], -440.f, 440.f), __builtin_amdgcn_fmed3f(v1[3], -440.f, 440.f)); \
                *(LAS u32x2*)(eb + fr * 272 + (bj * 128 + wc * 32 + fq * 8)) = o; } } while (0)
        DN_WRITE(0);
        ep_sync();
#pragma unroll
        for (int st = 0; st < 8; ++st) {
            if (st + 1 < 8) DN_WRITE(st + 1);
            const int rr = (st >> 2) * 128 + wr * 64 + (st & 3) * 16 + rrow;
            const u32x4 x0 = *(const LAS u32x4*)(ep + (st & 1) * 4352 + rrow * 272 + ch * 16);
            if (rr < u.cnt) *(u32x4*)(y + (size_t)a2v[st] * 2048 + u.n0 + ch * 16) = x0;
            ep_sync();
        }
#undef DN_WRITE
    }
};
}

namespace at8 {
typedef float f32x16 __attribute__((ext_vector_type(16)));
typedef short s16x4 __attribute__((ext_vector_type(4)));
typedef unsigned u32x4 __attribute__((ext_vector_type(4)));
constexpr int SHM_K = 64 * 128 * 2, SHM_V = 64 * 128 * 2, SLOT = SHM_K + SHM_V;
constexpr int NSLOT = 4;
constexpr int LDS_WS = NSLOT * SLOT;
constexpr int LDS_END = LDS_WS + 8 * 64 * 4;
constexpr float CEXP = ATT_SCALE * 1.4426950408889634f;
constexpr float THR_RAW = 8.f / ATT_SCALE;
#define AT_KSWZ(row, colB) ((row) * 256 + ((colB) ^ (((row) & 7) << 4)))
#define AT_SBAR() __builtin_amdgcn_sched_barrier(0)
__device__ __forceinline__ int crow(int r, int hi) { return (r & 3) + 8 * (r >> 2) + 4 * hi; }
__device__ __forceinline__ unsigned cvtpk(float lo, float hi) { auto v = __builtin_amdgcn_cvt_pkrtz(lo, hi); return *reinterpret_cast<unsigned*>(&v); }
__device__ __forceinline__ int v_st(int k, int c) { const int kk = (k & ~0xC) | ((k & 4) << 1) | ((k & 8) >> 1); return ((kk >> 3) * 4 + (c >> 5)) * 512 + ((kk & 7) * 32 + (c & 31)) * 2; }
__device__ __forceinline__ int v_rd_base(int lane) { return ((lane & 3) << 3) | (((lane >> 2) & 3) << 6) | (((lane >> 4) & 1) << 5) | (((lane >> 5) & 1) << 8); }
constexpr int v_rd_off(int d0, int ks, int half) { return d0 * 512 + ks * 4096 + half * 2048; }
template <int OFF> __device__ __forceinline__ s16x4 tr_read(int vb) { s16x4 r; asm volatile("ds_read_b64_tr_b16 %0, %1 offset:%2" : "=&v"(r) : "v"(vb), "i"(OFF) : "memory"); return r; }
__device__ __forceinline__ h8 mk8(s16x4 l, s16x4 h) { typedef short s16x8 __attribute__((ext_vector_type(8))); s16x8 w = {l[0], l[1], l[2], l[3], h[0], h[1], h[2], h[3]}; return *reinterpret_cast<h8*>(&w); }
template <int D0> __device__ __forceinline__ void pv_one(f32x16& od, int vb, h8 pa0, h8 pa1, h8 pa2, h8 pa3) {
    const s16x4 l0 = tr_read<v_rd_off(D0, 0, 0)>(vb), h0 = tr_read<v_rd_off(D0, 0, 1)>(vb), l1 = tr_read<v_rd_off(D0, 1, 0)>(vb), h1 = tr_read<v_rd_off(D0, 1, 1)>(vb);
    const s16x4 l2 = tr_read<v_rd_off(D0, 2, 0)>(vb), h2 = tr_read<v_rd_off(D0, 2, 1)>(vb), l3 = tr_read<v_rd_off(D0, 3, 0)>(vb), h3 = tr_read<v_rd_off(D0, 3, 1)>(vb);
    asm volatile("s_waitcnt lgkmcnt(0)" ::: "memory"); AT_SBAR();
    od = __builtin_amdgcn_mfma_f32_32x32x16_f16(pa0, mk8(l0, h0), od, 0, 0, 0);
    od = __builtin_amdgcn_mfma_f32_32x32x16_f16(pa1, mk8(l1, h1), od, 0, 0, 0);
    od = __builtin_amdgcn_mfma_f32_32x32x16_f16(pa2, mk8(l2, h2), od, 0, 0, 0);
    od = __builtin_amdgcn_mfma_f32_32x32x16_f16(pa3, mk8(l3, h3), od, 0, 0, 0);
}
__device__ __forceinline__ void pv_d0(f32x16 (&o)[4], int vb, h8 pa0, h8 pa1, h8 pa2, h8 pa3) {
    pv_one<0>(o[0], vb, pa0, pa1, pa2, pa3); pv_one<1>(o[1], vb, pa0, pa1, pa2, pa3); pv_one<2>(o[2], vb, pa0, pa1, pa2, pa3); pv_one<3>(o[3], vb, pa0, pa1, pa2, pa3);
}
__device__ __forceinline__ void qkt(f32x16& p0, f32x16& p1, const char* Ks, const h8 (&qr)[8], int r32, int hi) {
    p0 = f32x16{}; p1 = f32x16{};
#pragma unroll
    for (int d0 = 0; d0 < 8; ++d0) { const int cb = (d0 * 16 + hi * 8) * 2;
        const h8 b0 = *reinterpret_cast<const h8*>(Ks + AT_KSWZ(r32, cb));
        const h8 b1 = *reinterpret_cast<const h8*>(Ks + AT_KSWZ(32 + r32, cb));
        p0 = __builtin_amdgcn_mfma_f32_32x32x16_f16(b0, qr[d0], p0, 0, 0, 0);
        p1 = __builtin_amdgcn_mfma_f32_32x32x16_f16(b1, qr[d0], p1, 0, 0, 0); }
}
__device__ __forceinline__ void pack_p(const f32x16& p0, const f32x16& p1, h8& pa0, h8& pa1, h8& pa2, h8& pa3) {
#define AT_PK4(P, BASE, OUT) do { unsigned a0 = cvtpk(P[BASE + 0], P[BASE + 1]), a1 = cvtpk(P[BASE + 2], P[BASE + 3]); \
    unsigned b0 = cvtpk(P[BASE + 4], P[BASE + 5]), b1 = cvtpk(P[BASE + 6], P[BASE + 7]); \
    auto r0 = __builtin_amdgcn_permlane32_swap(a0, b0, false, false); auto r1 = __builtin_amdgcn_permlane32_swap(a1, b1, false, false); \
    u32x4 w = {r0[0], r1[0], r0[1], r1[1]}; OUT = *reinterpret_cast<h8*>(&w); } while (0)
    AT_PK4(p0, 0, pa0); AT_PK4(p0, 8, pa1); AT_PK4(p1, 0, pa2); AT_PK4(p1, 8, pa3);
#undef AT_PK4
}
__device__ __forceinline__ float half_swap_max(float v) { auto rr = __builtin_amdgcn_permlane32_swap(__float_as_uint(v), __float_as_uint(v), false, false); return fmaxf(__uint_as_float(rr[0]), __uint_as_float(rr[1])); }
__device__ __forceinline__ float half_swap_sum(float v) { auto rr = __builtin_amdgcn_permlane32_swap(__float_as_uint(v), __float_as_uint(v), false, false); return __uint_as_float(rr[0]) + __uint_as_float(rr[1]); }

__device__ __forceinline__ int hidden_tid() { int tz = threadIdx.x; asm volatile("" : "+v"(tz)); return tz; }
__device__ __forceinline__ void dma_offsets(int ld, int (&ko)[2], int (&vo)[2]) {
    const int tz = hidden_tid(), w = tz >> 6, l = tz & 63;
#pragma unroll
    for (int q = 0; q < 2; ++q) {
        const int rr = 4 * (2 * w + q) + (l >> 4), pp = l & 15;
        ko[q] = rr * ld + ((pp ^ (rr & 7)) * 8);
        const int L = (2 * w + q) * 1024 + l * 16, sidx = L >> 9, o = L & 511;
        const int kk = (sidx >> 2) * 8 + (o >> 6), c = (sidx & 3) * 32 + ((o & 63) >> 1);
        const int k = (kk & ~0xC) | ((kk & 4) << 1) | ((kk & 8) >> 1);
        vo[q] = k * ld + c;
    }
}
__device__ __forceinline__ void dma_tile(char* slot, const _Float16* Kb, const _Float16* Vb, int ld, int tile, const int (&ko)[2], const int (&vo)[2], int wid) {
    const _Float16* kt = Kb + (size_t)tile * 64 * ld; const _Float16* vt = Vb + (size_t)tile * 64 * ld;
#pragma unroll
    for (int q = 0; q < 2; ++q) __builtin_amdgcn_global_load_lds((const unsigned*)(kt + ko[q]), (LAS unsigned*)(slot + (2 * wid + q) * 1024), 16, 0, 0);
#pragma unroll
    for (int q = 0; q < 2; ++q) __builtin_amdgcn_global_load_lds((const unsigned*)(vt + vo[q]), (LAS unsigned*)(slot + SHM_K + (2 * wid + q) * 1024), 16, 0, 0);
}
#define AT_WAITV(n) asm volatile("s_waitcnt vmcnt(" #n ")" ::: "memory")
#define AT_BAR() do { asm volatile("s_waitcnt lgkmcnt(0)" ::: "memory"); __builtin_amdgcn_s_barrier(); asm volatile("" ::: "memory"); } while (0)

__device__ __forceinline__ void attn_unit(char* lds, const _Float16* qrow, const _Float16* Kb, const _Float16* Vb, int ld, unsigned tmask, int wlen, int khi, unsigned selmask,
                                          _Float16* outw, int ostride) {
    const int tid = threadIdx.x, wid = __builtin_amdgcn_readfirstlane(tid >> 6), lane = tid & 63, r32 = lane & 31, hi = lane >> 5;
    float* wsf = (float*)(lds + LDS_WS) + wid * 64; float* li_l = wsf; float* al_l = wsf + 32;
    float m_reg = -1e30f, l_reg = 0.f; f32x16 o[4] = {}; h8 qr[8];
#pragma unroll
    for (int d0 = 0; d0 < 8; ++d0) qr[d0] = *(const h8*)(qrow + d0 * 16);
    int ko[2], vo[2]; dma_offsets(ld, ko, vo);
    const int vbase = (int)(uintptr_t)lds + SHM_K + v_rd_base(lane);
    unsigned rest = tmask; int j = __ffs(rest) - 1; rest &= rest - 1;
    int j1 = rest ? (__ffs(rest) - 1) : -1; if (j1 >= 0) rest &= rest - 1;
    dma_tile(lds, Kb, Vb, ld, j, ko, vo, wid);
    if (j1 >= 0) { dma_tile(lds + SLOT, Kb, Vb, ld, j1, ko, vo, wid); AT_WAITV(4); } else { AT_WAITV(0); }
    AT_BAR();
    int so = 0, sp = 0;
    const bool roleB = wid >= 4;
    bool first = true;
    h8 pa0, pa1, pa2, pa3;
    for (;;) {
        const int j2 = rest ? (__ffs(rest) - 1) : -1;
        if (j2 >= 0) { rest &= rest - 1; int s2 = so + 2 * SLOT; s2 = s2 >= NSLOT * SLOT ? s2 - NSLOT * SLOT : s2; dma_tile(lds + s2, Kb, Vb, ld, j2, ko, vo, wid); }
        if (roleB && !first) { AT_SBAR(); pv_d0(o, vbase + sp, pa0, pa1, pa2, pa3); }
        f32x16 p0, p1;
        AT_SBAR(); qkt(p0, p1, lds + so, qr, r32, hi);
        { const int klo = wlen > 0 ? khi - wlen + 1 : 0; const bool tb = (selmask >> j) & 1u; const bool inr = (j * 64 >= klo) && (j * 64 + 63 <= khi);
          if (!__all(tb && inr)) {
              if (__all(inr)) {
#pragma unroll
                  for (int r = 0; r < 16; ++r) { p0[r] = tb ? p0[r] : -INFINITY; p1[r] = tb ? p1[r] : -INFINITY; }
              } else {
                  const int kb = j * 64 + 4 * hi;
#pragma unroll
                  for (int r = 0; r < 16; ++r) { const int k0 = kb + (r & 3) + 8 * (r >> 2);
                      p0[r] = (tb && k0 >= klo && k0 <= khi) ? p0[r] : -INFINITY;
                      p1[r] = (tb && (k0 + 32) >= klo && (k0 + 32) <= khi) ? p1[r] : -INFINITY; }
              } } }
        float pmax = p0[0];
#pragma unroll
        for (int r = 1; r < 16; ++r) pmax = fmaxf(pmax, p0[r]);
#pragma unroll
        for (int r = 0; r < 16; ++r) pmax = fmaxf(pmax, p1[r]);
        pmax = half_swap_max(pmax);
        float mn, alpha;
        if (__all(pmax - m_reg <= THR_RAW)) { mn = m_reg; alpha = 1.f; }
        else { mn = fmaxf(m_reg, pmax); alpha = __builtin_amdgcn_exp2f((m_reg - mn) * CEXP); m_reg = mn; }
        const float mnC = -mn * CEXP;
        float ps = 0.f;
#pragma unroll
        for (int r = 0; r < 16; ++r) { p0[r] = __builtin_amdgcn_exp2f(fmaf(p0[r], CEXP, mnC)); ps += p0[r]; }
#pragma unroll
        for (int r = 0; r < 16; ++r) { p1[r] = __builtin_amdgcn_exp2f(fmaf(p1[r], CEXP, mnC)); ps += p1[r]; }
        ps = half_swap_sum(ps);
        l_reg = l_reg * alpha + ps;
        if (__any(alpha < 1.f)) { if (hi == 0) al_l[r32] = alpha; asm volatile("s_waitcnt lgkmcnt(0)" ::: "memory");
#pragma unroll
            for (int r = 0; r < 16; ++r) { const float a = al_l[crow(r, hi)];
#pragma unroll
                for (int d = 0; d < 4; ++d) o[d][r] *= a; } }
        pack_p(p0, p1, pa0, pa1, pa2, pa3);
        AT_SBAR();
        if (!roleB) pv_d0(o, vbase + so, pa0, pa1, pa2, pa3);
        if (j1 < 0) break;
        if (j2 >= 0) { AT_WAITV(4); } else { AT_WAITV(0); }
        AT_BAR();
        j = j1; j1 = j2; sp = so; so += SLOT; so = so >= NSLOT * SLOT ? so - NSLOT * SLOT : so; first = false;
    }
    if (roleB) { AT_SBAR(); pv_d0(o, vbase + so, pa0, pa1, pa2, pa3); }
    if (hi == 0) li_l[r32] = l_reg; asm volatile("s_waitcnt lgkmcnt(0)" ::: "memory");
#pragma unroll
    for (int r = 0; r < 16; ++r) { const int orow = crow(r, hi); const float l = li_l[orow]; const float rl = l > 0.f ? 1.f / l : 0.f;
#pragma unroll
        for (int d0 = 0; d0 < 4; ++d0) outw[(size_t)orow * ostride + d0 * 32 + r32] = (_Float16)(o[d0][r] * rl); }
    __syncthreads();
}

constexpr int LDS_AP = 0, LDS_BP = LDS_AP + 4 * 64 * 33 * 4, LDS_SELM = LDS_END, LDS_CS_END = LDS_SELM + 64 * 4;
static_assert(LDS_BP + 4 * 64 * 33 * 4 <= NSLOT * SLOT, "importance partials must fit inside the ring");
__device__ __forceinline__ void cmp_slc_unit(char* lds, const _Float16* qrow, const _Float16* Kc, const _Float16* Vc, const _Float16* Ks, const _Float16* Vs, int t, int tl, int g, int qi,
                                             _Float16* outc, _Float16* outs) {
    const int tid = threadIdx.x, wid = __builtin_amdgcn_readfirstlane(tid >> 6), lane = tid & 63, r32 = lane & 31, hi = lane >> 5;
    float* AP = (float*)(lds + LDS_AP); float* BP = (float*)(lds + LDS_BP); unsigned* selm = (unsigned*)(lds + LDS_SELM);
    {
        h8 qr[8];
#pragma unroll
        for (int d0 = 0; d0 < 8; ++d0) qr[d0] = *(const h8*)(qrow + d0 * 16);
        const int vb0 = (int)(uintptr_t)lds + SHM_K + v_rd_base(lane);
        { int ko[2], vo[2]; dma_offsets(256, ko, vo);
          dma_tile(lds, Kc, Vc, 256, 0, ko, vo, wid); dma_tile(lds + SLOT, Kc, Vc, 256, 1, ko, vo, wid); }
        AT_WAITV(0); AT_BAR();
        f32x16 pA0, pA1, pB0, pB1;
        AT_SBAR(); qkt(pA0, pA1, lds, qr, r32, hi); qkt(pB0, pB1, lds + SLOT, qr, r32, hi);
        const int khi = t >= 31 ? ((t - 31) >> 4) : -1;
#pragma unroll
        for (int r = 0; r < 16; ++r) { const int c0 = 4 * hi + (r & 3) + 8 * (r >> 2);
            pA0[r] = (c0 <= khi) ? pA0[r] : -INFINITY; pA1[r] = (c0 + 32 <= khi) ? pA1[r] : -INFINITY;
            pB0[r] = (c0 + 64 <= khi) ? pB0[r] : -INFINITY; pB1[r] = (c0 + 96 <= khi) ? pB1[r] : -INFINITY; }
        float pmax = -INFINITY;
#pragma unroll
        for (int r = 0; r < 16; ++r) pmax = fmaxf(fmaxf(pmax, pA0[r]), fmaxf(pA1[r], fmaxf(pB0[r], pB1[r])));
        pmax = half_swap_max(pmax);
        const float mC = (pmax == -INFINITY) ? 0.f : -pmax * CEXP;
        float ps = 0.f;
#pragma unroll
        for (int r = 0; r < 16; ++r) { pA0[r] = __builtin_amdgcn_exp2f(fmaf(pA0[r], CEXP, mC)); pA1[r] = __builtin_amdgcn_exp2f(fmaf(pA1[r], CEXP, mC));
            pB0[r] = __builtin_amdgcn_exp2f(fmaf(pB0[r], CEXP, mC)); pB1[r] = __builtin_amdgcn_exp2f(fmaf(pB1[r], CEXP, mC)); ps += (pA0[r] + pA1[r]) + (pB0[r] + pB1[r]); }
        ps = half_swap_sum(ps);
        const float inv = ps > 0.f ? 1.f / ps : 0.f;
#pragma unroll
        for (int r = 0; r < 16; ++r) { pA0[r] *= inv; pA1[r] *= inv; pB0[r] *= inv; pB1[r] *= inv; }
        f32x16 o[4] = {};
        h8 pa0, pa1, pa2, pa3;
        pack_p(pA0, pA1, pa0, pa1, pa2, pa3); AT_SBAR(); pv_d0(o, vb0, pa0, pa1, pa2, pa3);
        pack_p(pB0, pB1, pa0, pa1, pa2, pa3); AT_SBAR(); pv_d0(o, vb0 + SLOT, pa0, pa1, pa2, pa3);
#pragma unroll
        for (int r = 0; r < 16; ++r) { const int orow = crow(r, hi);
#pragma unroll
            for (int d0 = 0; d0 < 4; ++d0) outc[(size_t)orow * 1024 + d0 * 32 + r32] = (_Float16)o[d0][r]; }
        __syncthreads();
        { float* ap = AP + (g * 64 + tl) * 33; float* bp = BP + (g * 64 + tl) * 33;
          if (hi == 0) bp[0] = 0.f;
#define AT_IMP(P, JB) do { _Pragma("unroll") for (int k = 0; k < 4; ++k) { const int j = (JB) + 2 * k + hi; \
              ap[j] = 2.f * (P[4 * k] + P[4 * k + 1] + P[4 * k + 2]) + P[4 * k + 3]; if (j + 1 < 32) bp[j + 1] = P[4 * k + 3]; } } while (0)
          AT_IMP(pA0, 0); AT_IMP(pA1, 8); AT_IMP(pB0, 16); AT_IMP(pB1, 24);
#undef AT_IMP
        }
    }
    __syncthreads();
#pragma unroll 1
    for (int it = 0; it < 4; ++it) {
        const int tk = 8 * wid + 2 * it + hi, j = r32;
        float imp = 0.f;
#pragma unroll
        for (int gg = 0; gg < 4; ++gg) imp += AP[(gg * 64 + tk) * 33 + j] + BP[(gg * 64 + tk) * 33 + j];
        const bool forced = (j == 0) || (j == qi) || (j == qi - 1), valid = j <= qi;
        const float iv = forced ? 1e9f : (valid ? imp : -1e9f);
        int rank = 0;
        for (int i = 0; i < 32; ++i) { const float vi = __shfl(iv, i + 32 * hi); rank += (vi > iv || (vi == iv && i < j)) ? 1 : 0; }
        const unsigned long long bal = __ballot(rank < 16 && valid);
        if (r32 == 0) selm[tk] = (unsigned)(bal >> (32 * hi));
    }
    __syncthreads();
    unsigned tm = selm[lane];
#pragma unroll
    for (int o = 32; o > 0; o >>= 1) tm |= __shfl_xor(tm, o);
    const int tz2 = hidden_tid();
    const unsigned mysel = selm[((tz2 >> 6) & 1) * 32 + (tz2 & 31)];
    attn_unit(lds, qrow, Ks, Vs, 128, tm, 0, t, mysel, outs, 1024);
}
}

struct CUnit { const float* W; int ldw; int nvalid; _Float16* Wt; int k0; int n0; };
__device__ __forceinline__ CUnit conv_desc(int u, const float* win, const float* w1k, const float* w1v, const float* wmkv, _Float16* wtin, _Float16* wt1, _Float16* wtmkv) {
    CUnit d;
    if (u < 160) { d.W = win; d.ldw = INW; d.nvalid = INW; d.Wt = wtin; d.k0 = (u / 5) * 64; d.n0 = (u % 5) * 256; }
    else if (u < 288) { const int v = u - 160, kv = v >> 6, part = (v >> 5) & 1, kt = v & 31;
        d.W = (kv ? w1v : w1k) + (size_t)part * 2048 * 256; d.ldw = 256; d.nvalid = 256; d.Wt = wt1 + ((size_t)kv * 512 + part * 256) * 2048; d.k0 = kt * 64; d.n0 = 0; }
    else { d.W = wmkv; d.ldw = 1024; d.nvalid = 1024; d.Wt = wtmkv; d.k0 = 0; d.n0 = 0; }
    return d;
}
__device__ __forceinline__ void conv_all(float* lds, const float* win, const float* w1k, const float* w1v, const float* wmkv, _Float16* wtin, _Float16* wt1, _Float16* wtmkv, int bid, int nb) {
    constexpr int NU = 160 + 128;
    const int tid = threadIdx.x;
    int u = bid; if (u >= NU) return;
    CUnit d = conv_desc(u, win, w1k, w1v, wmkv, wtin, wt1, wtmkv);
    float4 v[8];
#define CL(D) do { _Pragma("unroll") for (int i = 0; i < 8; ++i) { const int idx = tid + 512 * i, r = idx >> 6, c4 = (idx & 63) * 4; \
        v[i] = ((D).n0 + c4 < (D).nvalid) ? *(const float4*)((D).W + (size_t)((D).k0 + r) * (D).ldw + (D).n0 + c4) : make_float4(0.f, 0.f, 0.f, 0.f); } } while (0)
    CL(d);
    for (;;) {
#pragma unroll
        for (int i = 0; i < 8; ++i) { const int idx = tid + 512 * i, r = idx >> 6, c4 = (idx & 63) * 4; float* dd = lds + r * 257 + c4; dd[0] = v[i].x; dd[1] = v[i].y; dd[2] = v[i].z; dd[3] = v[i].w; }
        __syncthreads();
        const int un = u + nb; const bool has = un < NU;
        CUnit dn = d; if (has) { dn = conv_desc(un, win, w1k, w1v, wmkv, wtin, wt1, wtmkv); CL(dn); }
#pragma unroll
        for (int j = 0; j < 4; ++j) { const int id = tid + 512 * j, n = id >> 3, k8 = (id & 7) * 8; h8 o;
#pragma unroll
            for (int q = 0; q < 8; ++q) o[q] = (_Float16)lds[(k8 + q) * 257 + n];
            *(h8*)(d.Wt + (size_t)(d.n0 + n) * 2048 + d.k0 + k8) = o; }
        __syncthreads();
        if (!has) break;
        u = un; d = dn;
    }
#undef CL
}

__device__ __forceinline__ unsigned pack4_i8(float a, float b, float c, float d) {
    const int ia = __float2int_rn(a), ib = __float2int_rn(b), ic = __float2int_rn(c), id = __float2int_rn(d);
    return (unsigned)(ia & 255) | ((unsigned)(ib & 255) << 8) | ((unsigned)(ic & 255) << 16) | ((unsigned)(id & 255) << 24);
}
constexpr int QP_LD2 = 1026;
struct QUnit { const float* W; int ldw; int n0; signed char* Q; float* sc; int nvalid; };
struct QExtra { const float* win; signed char* q8in; float* sin8; const float* wmkv; signed char* q8mkv; float* smkv; };
__device__ __forceinline__ QUnit quant_desc(int u, const float* wgu, const float* wdn, signed char* q8gu, signed char* q8dn, float* sgu, float* sdn, const float* wout, signed char* q8out, float* sout, const QExtra& x) {
    QUnit d; d.nvalid = 1 << 30;
    if (u >= NE * 192 + 64 + 73) { const int pn = u - (NE * 192 + 64 + 73); d.W = x.wmkv; d.ldw = 1024; d.n0 = pn * 32; d.Q = x.q8mkv; d.sc = x.smkv; }
    else if (u >= NE * 192 + 64) { const int pn = u - (NE * 192 + 64); d.W = x.win; d.ldw = INW; d.n0 = 1280 + pn * 32; d.Q = x.q8in - (size_t)1280 * 2048; d.sc = x.sin8 - 1280; d.nvalid = INW; }
    else if (u >= NE * 192) { const int pn = u - NE * 192; d.W = wout; d.ldw = 2048; d.n0 = pn * 32; d.Q = q8out; d.sc = sout; }
    else if (u < NE * 128) { const int e = u >> 7, pn = u & 127; d.W = wgu + (size_t)e * 2048 * 4096; d.ldw = 4096; d.n0 = pn * 32; d.Q = q8gu + (size_t)e * 4096 * 2048; d.sc = sgu + (size_t)e * 4096; }
    else { const int v = u - NE * 128, e = v >> 6, pn = v & 63; d.W = wdn + (size_t)e * 2048 * 2048; d.ldw = 2048; d.n0 = pn * 32; d.Q = q8dn + (size_t)e * 2048 * 2048; d.sc = sdn + (size_t)e * 2048; }
    return d;
}
__device__ __forceinline__ unsigned pk2h(float a, float b) { auto v = __builtin_amdgcn_cvt_pkrtz(a, b); return *reinterpret_cast<unsigned*>(&v); }
__device__ __forceinline__ void quant_all(char* smem, const float* wgu, const float* wdn, signed char* q8gu, signed char* q8dn, float* sgu, float* sdn, const float* wout, signed char* q8out, float* sout, const QExtra& qx, int bid, int nb) {
    constexpr int NU = NE * 128 + NE * 64 + 64 + 73 + 32;
    unsigned* cmaxb = (unsigned*)smem;
    const int tid = threadIdx.x, c4 = (tid & 7) * 4, rg = tid >> 3;
    if (tid < 64) cmaxb[tid] = 0u;
    __syncthreads();
    int u = bid; if (u >= NU) return;
    QUnit d = quant_desc(u, wgu, wdn, q8gu, q8dn, sgu, sdn, wout, q8out, sout, qx);
    float4 va[16], vb[16], vc[16];
#define QL(dst, D, half) do { const float* p0 = (D).W + (size_t)((half) * 1024 + rg * 16) * (D).ldw + (D).n0 + c4; const bool okc = (D).n0 + c4 < (D).nvalid; _Pragma("unroll") for (int j = 0; j < 16; ++j) dst[j] = okc ? *(const float4*)(p0 + (size_t)j * (D).ldw) : make_float4(0.f, 0.f, 0.f, 0.f); } while (0)
#define QM(src) do { _Pragma("unroll") for (int j = 0; j < 16; ++j) { m0 = fmaxf(m0, fabsf(src[j].x)); m1 = fmaxf(m1, fabsf(src[j].y)); m2 = fmaxf(m2, fabsf(src[j].z)); m3 = fmaxf(m3, fabsf(src[j].w)); } } while (0)
#define QS(src, half, comp, ci, inv) do { uint4 o; \
        o.x = pack4_i8(src[0].comp * inv, src[1].comp * inv, src[2].comp * inv, src[3].comp * inv); o.y = pack4_i8(src[4].comp * inv, src[5].comp * inv, src[6].comp * inv, src[7].comp * inv); \
        o.z = pack4_i8(src[8].comp * inv, src[9].comp * inv, src[10].comp * inv, src[11].comp * inv); o.w = pack4_i8(src[12].comp * inv, src[13].comp * inv, src[14].comp * inv, src[15].comp * inv); \
        *(uint4*)(d.Q + (size_t)(d.n0 + c4 + (ci)) * 2048 + (half) * 1024 + rg * 16) = o; } while (0)
    QL(va, d, 0);
    int par = 0;
    for (;;) {
        unsigned* cmax = cmaxb + par * 32;
        float m0 = 0.f, m1 = 0.f, m2 = 0.f, m3 = 0.f;
        QL(vb, d, 1);
        QM(va); QM(vb);
        atomicMax(&cmax[c4 + 0], __float_as_uint(m0)); atomicMax(&cmax[c4 + 1], __float_as_uint(m1)); atomicMax(&cmax[c4 + 2], __float_as_uint(m2)); atomicMax(&cmax[c4 + 3], __float_as_uint(m3));
        __syncthreads();
        const int un = u + nb; const bool has = un < NU;
        QUnit dn = d; if (has) { dn = quant_desc(un, wgu, wdn, q8gu, q8dn, sgu, sdn, wout, q8out, sout, qx); QL(vc, dn, 0); }
        if (tid < 32) cmaxb[(par ^ 1) * 32 + tid] = 0u;
        const float x0 = __uint_as_float(cmax[c4 + 0]), x1 = __uint_as_float(cmax[c4 + 1]), x2 = __uint_as_float(cmax[c4 + 2]), x3 = __uint_as_float(cmax[c4 + 3]);
        const float i0 = x0 > 0.f ? 127.f / x0 : 0.f, i1 = x1 > 0.f ? 127.f / x1 : 0.f, i2 = x2 > 0.f ? 127.f / x2 : 0.f, i3 = x3 > 0.f ? 127.f / x3 : 0.f;
        QS(va, 0, x, 0, i0); QS(va, 0, y, 1, i1); QS(va, 0, z, 2, i2); QS(va, 0, w, 3, i3);
        QS(vb, 1, x, 0, i0); QS(vb, 1, y, 1, i1); QS(vb, 1, z, 2, i2); QS(vb, 1, w, 3, i3);
        if (tid < 32) { const float mx = __uint_as_float(cmax[tid]); d.sc[d.n0 + tid] = mx > 0.f ? mx / 127.f : 1.f; }
        if (!has) break;
#pragma unroll
        for (int j = 0; j < 16; ++j) va[j] = vc[j];
        u = un; d = dn; par ^= 1;
        __syncthreads();
    }
    __syncthreads();
#undef QL
#undef QM
#undef QS
}

__global__ void __launch_bounds__(512, 2) fwd(Params p) {
    extern __shared__ __attribute__((aligned(16))) char smem[];
    const int tid = threadIdx.x, wv = __builtin_amdgcn_readfirstlane(tid >> 6);
#define LANE_NOW ({ int _t = threadIdx.x; asm volatile("" : "+v"(_t)); _t & 63; })
    const int bid = blockIdx.x, nb = gridDim.x;
    const int gw = bid * 8 + wv, nw = nb * 8;
    const int lo = (int)(p.lo_hi & 0xffffffffll), hi = (int)(p.lo_hi >> 32);
    unsigned char* ws = p.ws;
    unsigned* ctl = (unsigned*)(ws + WS_CTL);
    int* cnt = (int*)(ws + CTL_CNT);
    float* proj = (float*)(ws + WS_PROJ);
    float* kvmem = (float*)(ws + WS_KVMEM);
    float* bias1 = (float*)(ws + WS_BIAS1);
    float* hid = (float*)(ws + WS_HID);
    float* kc = (float*)(ws + WS_KC);
    float* vc = (float*)(ws + WS_VC);
    float* pooled = (float*)(ws + WS_POOLED);
    _Float16* opool = (_Float16*)(ws + WS_OPOOL);
    _Float16* owin = (_Float16*)(ws + WS_OWIN);
    _Float16* ocmp = (_Float16*)(ws + WS_OCMP);
    _Float16* oslc = (_Float16*)(ws + WS_OSLC);
    unsigned* sel = (unsigned*)(ws + WS_SEL);
    _Float16* omem = (_Float16*)(ws + WS_OMEM);
    _Float16* cat16 = (_Float16*)(ws + WS_CAT16);
    _Float16* hpre16 = (_Float16*)(ws + WS_HPRE);
    float* hbuf = (float*)(ws + WS_H);
    float* gate = (float*)(ws + WS_GATE);
    int* list = (int*)(ws + WS_LIST);
    unsigned char* actf8 = (unsigned char*)(ws + WS_ACT16);
    unsigned char* yf8 = (unsigned char*)(ws + WS_Y16);
    _Float16* h16 = (_Float16*)(ws + WS_H16);
    _Float16* x16 = (_Float16*)(ws + WS_X16);
    _Float16* wtin = (_Float16*)(ws + WS_WTIN);
    _Float16* wtout = (_Float16*)(ws + WS_WTOUT);
    _Float16* wtgu = (_Float16*)(ws + WS_WTGU);
    _Float16* wtdn = (_Float16*)(ws + WS_WTDN);
    LAS unsigned char* lds = (LAS unsigned char*)smem;
    _Float16* proj16 = (_Float16*)(ws + WS_PROJ16);
    _Float16* kvmem16 = (_Float16*)(ws + WS_KVMEM16);
    _Float16* wt1 = (_Float16*)(ws + WS_WT1);
    float* uv = (float*)(ws + WS_UV);
    _Float16* kc16 = (_Float16*)(ws + WS_KC16);
    _Float16* vc16 = (_Float16*)(ws + WS_VC16);
    _Float16* wr16 = (_Float16*)(ws + WS_WR16);
    _Float16* mem16 = (_Float16*)(ws + WS_MEM16);
    _Float16* wtmkv = (_Float16*)(ws + WS_WTMKV);
    _Float16* kv16 = (_Float16*)(ws + WS_KV16);
    _Float16* wt2 = (_Float16*)(ws + WS_WT2);
    float* sa2 = (float*)(ws + WS_SA2); float* gate2 = (float*)(ws + WS_GATE2);
    signed char* x8 = (signed char*)(ws + WS_X8); float* sxa = (float*)(ws + WS_SXA); signed char* q8in = (signed char*)(ws + WS_Q8IN); float* sin8 = (float*)(ws + WS_SIN8);
    signed char* q8mkv = (signed char*)(ws + WS_Q8MKV); float* smkv = (float*)(ws + WS_SMKV);
    signed char* q8out = (signed char*)(ws + WS_Q8OUT); float* sout = (float*)(ws + WS_SOUT); signed char* cat8 = (signed char*)(ws + WS_CAT8); float* scat = (float*)(ws + WS_SCAT);
    signed char* q8gu = (signed char*)(ws + WS_Q8GU); signed char* q8dn = (signed char*)(ws + WS_Q8DN);
    float* sgu = (float*)(ws + WS_SGU); float* sdn = (float*)(ws + WS_SDN);
    signed char* h8q = (signed char*)(ws + WS_H8); float* sah = (float*)(ws + WS_SAH);
    signed char* act8 = (signed char*)(ws + WS_ACT8); float* sact = (float*)(ws + WS_SACT);
    const int vcu = (nb % 8 == 0) ? (bid % 8) * (nb / 8) + bid / 8 : bid;

    volatile LAS unsigned* xbw = (volatile LAS unsigned*)(smem + LDS_BYTES - 16);
    if (tid == 0) { xbw[0] = 0u; xbw[1] = 0u; xbw[2] = 0u; xbw[3] = 0u; }
    __syncthreads();
    XcdBarrier bar; bar.bar = ctl; bar.x = 0; bar.st = xbw;
    const bool multi = (hi - lo) > 1;
    if (multi) bar = xcd_barrier_post(ctl, xbw);
#define IN(k) (lo <= (k) && (k) < hi)
#define SEAM(k) do { if (IN(k) && IN((k) + 1)) xcd_barrier(bar); } while (0)
    float* sw = (float*)smem + wv * WLDS_FLOATS;
    int* segw = (int*)(sw + 4096 + 512);

    if (IN(0)) {
        const int lane = LANE_NOW; (void)lane;
        if (wv == 0 && (bid & 1) == 0 && (bid >> 1) < 128) {
            const int task = bid >> 1, kv = task >> 6, jg = (task >> 4) & 3, kc = task & 15;
            const float* pos = p.in[kv ? I_POSV : I_POSK] + kc * 256; const float* w1 = p.in[kv ? I_W1V : I_W1K] + (size_t)kc * 256 * 256 + jg * 64 + lane;
            float s0 = 0.f, s1 = 0.f, s2 = 0.f, s3 = 0.f;
            for (int k = 0; k < 256; k += 4) { s0 += pos[k] * w1[(size_t)k * 256]; s1 += pos[k + 1] * w1[(size_t)(k + 1) * 256]; s2 += pos[k + 2] * w1[(size_t)(k + 2) * 256]; s3 += pos[k + 3] * w1[(size_t)(k + 3) * 256]; }
            bias1[(kv * 16 + kc) * 256 + jg * 64 + lane] = (s0 + s1) + (s2 + s3);
        }
        for (int i = bid * 512 + tid; i < 2 * 128 * 256; i += nb * 512) { const int kv = i >> 15, d = (i >> 8) & 127, n = i & 255; wt2[i] = (_Float16)p.in[kv ? I_W2V : I_W2K][(size_t)n * 128 + d]; }
        for (int i = bid * 512 + tid; i < 32 * 2048; i += nb * 512) { const int e = i >> 11, d = i & 2047; wr16[i] = (_Float16)p.in[I_WR][(size_t)d * 32 + e]; }
        {
            for (int row0 = gw; row0 < T_ + 2048; row0 += nw * 2) {
                float4 raw[2][8];
#pragma unroll
                for (int i = 0; i < 2; ++i) { const int row = row0 + i * nw; const float* src = row < T_ ? p.in[I_X] + (size_t)row * 2048 : p.in[I_MEM] + (size_t)(row - T_) * 2048;
#pragma unroll
                    for (int c = 0; c < 4; ++c) { raw[i][2 * c] = make_float4(0.f, 0.f, 0.f, 0.f); raw[i][2 * c + 1] = raw[i][2 * c];
                        if (row < T_ + 2048) { raw[i][2 * c] = *(const float4*)(src + (lane + 64 * c) * 8); raw[i][2 * c + 1] = *(const float4*)(src + (lane + 64 * c) * 8 + 4); } } }
#pragma unroll
                for (int i = 0; i < 2; ++i) { const int row = row0 + i * nw;
                    float amax = 0.f;
#pragma unroll
                    for (int k = 0; k < 8; ++k) amax = fmaxf(amax, fmaxf(fmaxf(fabsf(raw[i][k].x), fabsf(raw[i][k].y)), fmaxf(fabsf(raw[i][k].z), fabsf(raw[i][k].w))));
                    amax = wave_max(amax);
                    if (row < T_ + 2048) {
                        const float qinv = amax > 0.f ? 127.f / amax : 0.f;
                        if (lane == 0) sxa[row] = amax > 0.f ? amax / 127.f : 1.f;
#pragma unroll
                        for (int c = 0; c < 4; ++c) { const float4 a = raw[i][2 * c], b2 = raw[i][2 * c + 1];
                            uint2 q; q.x = pack4_i8(a.x * qinv, a.y * qinv, a.z * qinv, a.w * qinv); q.y = pack4_i8(b2.x * qinv, b2.y * qinv, b2.z * qinv, b2.w * qinv);
                            *(uint2*)(x8 + (size_t)row * 2048 + (lane + 64 * c) * 8) = q;
                            if (row < T_) { h8 o; o[0] = (_Float16)a.x; o[1] = (_Float16)a.y; o[2] = (_Float16)a.z; o[3] = (_Float16)a.w; o[4] = (_Float16)b2.x; o[5] = (_Float16)b2.y; o[6] = (_Float16)b2.z; o[7] = (_Float16)b2.w;
                                *(h8*)(x16 + (size_t)row * 2048 + (lane + 64 * c) * 8) = o; } } }
                }
            }
        }
        {
            const QExtra qx{p.in[I_WIN], q8in, sin8, p.in[I_WMEMKV], q8mkv, smkv};
            quant_all(smem, p.in[I_WGU], p.in[I_WDN], q8gu, q8dn, sgu, sdn, p.in[I_WOUT], q8out, sout, qx, bid, nb);
            __syncthreads();
            conv_all((float*)smem, p.in[I_WIN], p.in[I_W1K], p.in[I_W1V], p.in[I_WMEMKV], wtin, wt1, wtmkv, bid, nb);
            __syncthreads();
        }
    }
    SEAM(0);
    if (IN(1)) {
        const int lane = LANE_NOW; (void)lane;
        { g8::ProbInF P{x16, proj16, nb, bid}; g8::gemm_phase(lds, P); }
        __syncthreads();
        { g8::ProbIn8 P{x8, proj16, sxa, nb, (bid + 192) & 255}; g8::gemm_phase(lds, P); }
    }
    SEAM(1);
    if (IN(2)) {
        const int lane = LANE_NOW; (void)lane;
        { g8::ProbCmp P{kv16, wt1, uv, nb, bid}; g8::gemm_phase(lds, P); __syncthreads(); }
        for (int i = bid * 512 + tid; i < T_ * 64; i += nb * 512) {
            const int chn = i & 63, row = i >> 6, t = row & (S_ - 1), g = chn >> 4;
            const int win = 2 << g, n = min(win, t + 1);
            const _Float16* src = proj16 + (size_t)row * INW + C_UP + chn * 8;
            float a[8];
            const h8 cur = *(const h8*)src;
            h8 vv[15];
#pragma unroll
            for (int k = 0; k < 15; ++k) { vv[k] = (h8){0, 0, 0, 0, 0, 0, 0, 0}; if (k + 1 < n) vv[k] = *(const h8*)(src - (size_t)(k + 1) * INW); }
#pragma unroll
            for (int q = 0; q < 8; ++q) a[q] = (float)cur[q];
#pragma unroll
            for (int k = 0; k < 15; ++k) {
#pragma unroll
                for (int q = 0; q < 8; ++q) a[q] += (float)vv[k][q]; }
            const float rn = 1.f / (float)n;
            float4 o0, o1;
            o0.x = a[0] * rn - (float)cur[0]; o0.y = a[1] * rn - (float)cur[1]; o0.z = a[2] * rn - (float)cur[2]; o0.w = a[3] * rn - (float)cur[3];
            o1.x = a[4] * rn - (float)cur[4]; o1.y = a[5] * rn - (float)cur[5]; o1.z = a[6] * rn - (float)cur[6]; o1.w = a[7] * rn - (float)cur[7];
            *(float4*)(pooled + (size_t)row * 512 + chn * 8) = o0; *(float4*)(pooled + (size_t)row * 512 + chn * 8 + 4) = o1;
        }
        {
            const int r32 = lane & 31, hi = lane >> 5, g = wv >> 1, half = wv & 1;
            for (int uu = vcu; uu < 512; uu += nb) {
                const int v = uu & 255, bk = v >> 4, qi = (uu >> 8) ? 31 - (v & 15) : (v & 15), b = bk >> 1, kvh = bk & 1;
                const int t = qi * 64 + half * 32 + r32;
                const int lo_t = max(0, qi - 8);
                const unsigned tmask = (unsigned)(((1ull << (qi + 1)) - 1ull) & ~((1ull << lo_t) - 1ull));
                at8::attn_unit(smem, proj16 + (size_t)(b * S_ + t) * INW + C_Q + (kvh * 4 + g) * 128 + hi * 8,
                               kv16 + ((size_t)(4 * B_ + b) * 2 + kvh) * KVSEG, kv16 + ((size_t)(5 * B_ + b) * 2 + kvh) * KVSEG, 128, tmask, 512, t, 0xffffffffu,
                               owin + (size_t)(b * S_ + qi * 64 + half * 32) * 1024 + (kvh * 4 + g) * 128, 1024);
            }
            for (int u = vcu; u < 256; u += nb) {
                const int b = u >> 5, h = (u >> 3) & 3, qt = u & 7;
                const int t = qt * 256 + wv * 32 + r32;
                at8::attn_unit(smem, proj16 + (size_t)(b * S_ + t) * INW + C_QM + h * 128 + hi * 8,
                               kvmem16 + (size_t)b * 256 * 1024 + h * 128, kvmem16 + (size_t)b * 256 * 1024 + 512 + h * 128, 1024, 0xFu, 0, 255, 0xffffffffu,
                               omem + (size_t)(b * S_ + qt * 256 + wv * 32) * 512 + h * 128, 512);
            }
        }
    }
    SEAM(2);
    if (IN(3)) {
        const int lane = LANE_NOW; (void)lane;
        {
            float* bsum = (float*)smem;
            _Float16* hs = (_Float16*)(smem + 4096);
            { const int kv = tid >> 8, n = tid & 255; float a = 0.f;
#pragma unroll
              for (int kc = 0; kc < 16; ++kc) a += bias1[(kv * 16 + kc) * 256 + n];
              bsum[tid] = a; }
            __syncthreads();
            const int fr = lane & 15, fq = lane >> 4;
            for (int u = bid; u < 256; u += nb) {
                const int kv = u >> 7, rt = u & 127;
#pragma unroll
                for (int q = 0; q < 8; ++q) { const int e = tid + 512 * q, i = e >> 8, n = e & 255;
                    const int row = rt * 16 + i, c = (row >> 1) & 127;
                    float a = 0.f;
                    if (c != 127) { a = bsum[kv * 256 + n];
#pragma unroll
                        for (int sp = 0; sp < 4; ++sp) { const float* base = uv + ((size_t)(kv * 4 + sp) * 2048) * 512; a += base[(size_t)row * 512 + n] + base[(size_t)(row + 2) * 512 + 256 + n]; }
                        a = gelu_fast(a); }
                    hs[i * 264 + n] = (_Float16)a; }
                __syncthreads();
                { const _Float16* bp = wt2 + ((size_t)kv * 128 + wv * 16 + fr) * 256 + fq * 8;
                  f4 acc = (f4){0.f, 0.f, 0.f, 0.f};
#pragma unroll
                  for (int sI = 0; sI < 8; ++sI) { const h8 a = *(const h8*)(hs + fr * 264 + sI * 32 + fq * 8), bb = *(const h8*)(bp + sI * 32); acc = __builtin_amdgcn_mfma_f32_16x16x32_f16(a, bb, acc, 0, 0, 0); }
                  _Float16* dst = kv ? vc16 : kc16;
#pragma unroll
                  for (int j = 0; j < 4; ++j) { const int row = rt * 16 + fq * 4 + j; dst[(size_t)row * 128 + wv * 16 + fr] = (((row >> 1) & 127) == 127) ? (_Float16)0.f : (_Float16)acc[j]; } }
                __syncthreads();
            }
        }
        for (int u = bid; u < 128 * 4; u += nb) { const int g = u >> 7, mt = u & 127;
            ARowPlain af{pooled + g * 128, 512, mt * 128, T_}; EpiPool ef{opool, p.in[I_POOLS], mt * 128, g};
            gemm_tile(smem, 128, af, p.in[I_POOLW] + (size_t)g * 128 * 128, 128, 0, 128, false, ef);
        }
    }
    SEAM(3);
    if (IN(4)) {
        const int lane = LANE_NOW; (void)lane;
        const int r32 = lane & 31, hi = lane >> 5, g = wv >> 1, half = wv & 1;
        for (int uu = vcu; uu < 512; uu += nb) {
            const int v = uu & 255, bk = v >> 4, qi = (uu >> 8) ? 31 - (v & 15) : (v & 15), b = bk >> 1, kvh = bk & 1;
            const int tl = half * 32 + r32, t = qi * 64 + tl;
            at8::cmp_slc_unit(smem, proj16 + (size_t)(b * S_ + t) * INW + C_Q + (kvh * 4 + g) * 128 + hi * 8,
                              kc16 + (size_t)(b * 128 * 2 + kvh) * 128, vc16 + (size_t)(b * 128 * 2 + kvh) * 128,
                              kv16 + ((size_t)(2 * B_ + b) * 2 + kvh) * KVSEG, kv16 + ((size_t)(3 * B_ + b) * 2 + kvh) * KVSEG, t, tl, g, qi,
                              ocmp + (size_t)(b * S_ + qi * 64 + half * 32) * 1024 + (kvh * 4 + g) * 128, oslc + (size_t)(b * S_ + qi * 64 + half * 32) * 1024 + (kvh * 4 + g) * 128);
        }
    }
    SEAM(4);
    if (IN(5)) {
        const int lane = LANE_NOW;
        for (int row = gw; row < T_; row += nw) {
            const _Float16* pr = proj16 + (size_t)row * INW + C_G;
            float v[32]; float ss = 0.f;
#pragma unroll
            for (int c = 0; c < 2; ++c) { const int col = (lane + 64 * c) * 8, h = col >> 7; const size_t o = (size_t)row * 1024 + col;
                const float g0 = sigmoidf_((float)pr[h * 3]), g1 = sigmoidf_((float)pr[h * 3 + 1]), g2 = sigmoidf_((float)pr[h * 3 + 2]);
                const h8 a = *(const h8*)(ocmp + o), b2 = *(const h8*)(oslc + o), c2 = *(const h8*)(owin + o);
#pragma unroll
                for (int q = 0; q < 8; ++q) { const float x = g0 * (float)a[q] + g1 * (float)b2[q] + g2 * (float)c2[q]; v[c * 8 + q] = x; ss += x * x; } }
            ss = wave_sum(ss); float r = rsqrtf(ss / 1024.f + LN_EPS);
#pragma unroll
            for (int c = 0; c < 2; ++c) { const int col = (lane + 64 * c) * 8; const float4 ga = *(const float4*)(p.in[I_GNNSA] + col), gb = *(const float4*)(p.in[I_GNNSA] + col + 4);
                v[c * 8 + 0] *= r * ga.x; v[c * 8 + 1] *= r * ga.y; v[c * 8 + 2] *= r * ga.z; v[c * 8 + 3] *= r * ga.w; v[c * 8 + 4] *= r * gb.x; v[c * 8 + 5] *= r * gb.y; v[c * 8 + 6] *= r * gb.z; v[c * 8 + 7] *= r * gb.w; }
            { const h8 a = *(const h8*)(opool + (size_t)row * 512 + lane * 8); ss = 0.f;
#pragma unroll
              for (int q = 0; q < 8; ++q) { v[16 + q] = (float)a[q]; ss += v[16 + q] * v[16 + q]; }
              ss = wave_sum(ss); r = rsqrtf(ss / 512.f + LN_EPS);
              const float4 ga = *(const float4*)(p.in[I_GNPOOL] + lane * 8), gb = *(const float4*)(p.in[I_GNPOOL] + lane * 8 + 4);
              v[16] *= r * ga.x; v[17] *= r * ga.y; v[18] *= r * ga.z; v[19] *= r * ga.w; v[20] *= r * gb.x; v[21] *= r * gb.y; v[22] *= r * gb.z; v[23] *= r * gb.w; }
            { const h8 a = *(const h8*)(omem + (size_t)row * 512 + lane * 8); ss = 0.f;
#pragma unroll
              for (int q = 0; q < 8; ++q) { v[24 + q] = (float)a[q]; ss += v[24 + q] * v[24 + q]; }
              ss = wave_sum(ss); r = rsqrtf(ss / 512.f + LN_EPS);
              const float4 ga = *(const float4*)(p.in[I_GNMEM] + lane * 8), gb = *(const float4*)(p.in[I_GNMEM] + lane * 8 + 4);
              v[24] *= r * ga.x; v[25] *= r * ga.y; v[26] *= r * ga.z; v[27] *= r * ga.w; v[28] *= r * gb.x; v[29] *= r * gb.y; v[30] *= r * gb.z; v[31] *= r * gb.w; }
            float amax = 0.f;
#pragma unroll
            for (int k = 0; k < 32; ++k) amax = fmaxf(amax, fabsf(v[k]));
            amax = wave_max(amax);
            const float qinv = amax > 0.f ? 127.f / amax : 0.f;
            if (lane == 0) scat[row] = amax > 0.f ? amax / 127.f : 1.f;
#pragma unroll
            for (int c = 0; c < 4; ++c) { const int col = c < 2 ? (lane + 64 * c) * 8 : (c == 2 ? 1024 + lane * 8 : 1536 + lane * 8);
                uint2 q; q.x = pack4_i8(v[c * 8 + 0] * qinv, v[c * 8 + 1] * qinv, v[c * 8 + 2] * qinv, v[c * 8 + 3] * qinv); q.y = pack4_i8(v[c * 8 + 4] * qinv, v[c * 8 + 5] * qinv, v[c * 8 + 6] * qinv, v[c * 8 + 7] * qinv);
                *(uint2*)(cat8 + (size_t)row * 2048 + col) = q; }
        }
    }
    SEAM(5);
    if (IN(6)) {
        const int lane = LANE_NOW; (void)lane;
        g8::ProbOut P{cat8, q8out, hpre16, x16, scat, sout, nb, bid};
        g8::gemm_phase(lds, P);
    }
    SEAM(6);
    if (IN(7)) {
        const int lane = LANE_NOW; (void)lane;
        float* lg = (float*)smem;
        const int r32 = lane & 31, hi = lane >> 5, fr = lane & 15, fq = lane >> 4;
        for (int u = bid; u < T_ / 64; u += nb) {
            const int base = u * 64;
            h8 raw[8][4];
#pragma unroll
            for (int i = 0; i < 8; ++i)
#pragma unroll
                for (int c = 0; c < 4; ++c) raw[i][c] = *(const h8*)(hpre16 + (size_t)(base + wv * 8 + i) * 2048 + (lane + 64 * c) * 8);
#pragma unroll
            for (int i = 0; i < 8; ++i) {
                const int row = base + wv * 8 + i;
                float v[32]; float s = 0.f;
#pragma unroll
                for (int c = 0; c < 4; ++c) {
#pragma unroll
                    for (int q = 0; q < 8; ++q) { v[c * 8 + q] = (float)raw[i][c][q]; s += v[c * 8 + q]; } }
                const float mu = wave_sum(s) / 2048.f; float q2 = 0.f;
#pragma unroll
                for (int k = 0; k < 32; ++k) { const float d = v[k] - mu; q2 += d * d; }
                const float rs = rsqrtf(wave_sum(q2) / 2048.f + LN_EPS);
                float amax = 0.f;
#pragma unroll
                for (int c = 0; c < 4; ++c) { const int col = (lane + 64 * c) * 8;
                    const float4 g0 = *(const float4*)(p.in[I_LN1G] + col), g1 = *(const float4*)(p.in[I_LN1G] + col + 4), b0 = *(const float4*)(p.in[I_LN1B] + col), b1 = *(const float4*)(p.in[I_LN1B] + col + 4);
                    float4 o0, o1;
                    o0.x = (v[c * 8 + 0] - mu) * rs * g0.x + b0.x; o0.y = (v[c * 8 + 1] - mu) * rs * g0.y + b0.y; o0.z = (v[c * 8 + 2] - mu) * rs * g0.z + b0.z; o0.w = (v[c * 8 + 3] - mu) * rs * g0.w + b0.w;
                    o1.x = (v[c * 8 + 4] - mu) * rs * g1.x + b1.x; o1.y = (v[c * 8 + 5] - mu) * rs * g1.y + b1.y; o1.z = (v[c * 8 + 6] - mu) * rs * g1.z + b1.z; o1.w = (v[c * 8 + 7] - mu) * rs * g1.w + b1.w;
                    h8 oh; oh[0] = (_Float16)o0.x; oh[1] = (_Float16)o0.y; oh[2] = (_Float16)o0.z; oh[3] = (_Float16)o0.w; oh[4] = (_Float16)o1.x; oh[5] = (_Float16)o1.y; oh[6] = (_Float16)o1.z; oh[7] = (_Float16)o1.w;
                    *(h8*)(h16 + (size_t)row * 2048 + col) = oh;
                    v[c * 8 + 0] = o0.x; v[c * 8 + 1] = o0.y; v[c * 8 + 2] = o0.z; v[c * 8 + 3] = o0.w; v[c * 8 + 4] = o1.x; v[c * 8 + 5] = o1.y; v[c * 8 + 6] = o1.z; v[c * 8 + 7] = o1.w;
                    amax = fmaxf(amax, fmaxf(fmaxf(fmaxf(fabsf(o0.x), fabsf(o0.y)), fmaxf(fabsf(o0.z), fabsf(o0.w))), fmaxf(fmaxf(fabsf(o1.x), fabsf(o1.y)), fmaxf(fabsf(o1.z), fabsf(o1.w))))); }
                amax = wave_max(amax);
                const float qinv = amax > 0.f ? 127.f / amax : 0.f;
                if (lane == 0) sah[row] = amax > 0.f ? amax / 127.f : 1.f;
#pragma unroll
                for (int c = 0; c < 4; ++c) { const int col = (lane + 64 * c) * 8;
                    uint2 q; q.x = pack4_i8(v[c * 8 + 0] * qinv, v[c * 8 + 1] * qinv, v[c * 8 + 2] * qinv, v[c * 8 + 3] * qinv); q.y = pack4_i8(v[c * 8 + 4] * qinv, v[c * 8 + 5] * qinv, v[c * 8 + 6] * qinv, v[c * 8 + 7] * qinv);
                    *(uint2*)(h8q + (size_t)row * 2048 + col) = q; }
            }
            asm volatile("s_waitcnt vmcnt(0)" ::: "memory");
            __syncthreads();
            {
                const int tok0 = base + 16 * (wv >> 1), e0 = 16 * (wv & 1);
                const _Float16* ap = h16 + (size_t)(tok0 + fr) * 2048 + fq * 8; const _Float16* bp = wr16 + (size_t)(e0 + fr) * 2048 + fq * 8;
                f4 acc = (f4){0.f, 0.f, 0.f, 0.f};
#pragma unroll 8
                for (int sI = 0; sI < 64; ++sI) { const h8 a = *(const h8*)(ap + sI * 32), bb = *(const h8*)(bp + sI * 32); acc = __builtin_amdgcn_mfma_f32_16x16x32_f16(a, bb, acc, 0, 0, 0); }
                const float br = p.in[I_BR][e0 + fr];
#pragma unroll
                for (int j = 0; j < 4; ++j) lg[(16 * (wv >> 1) + 4 * fq + j) * 33 + e0 + fr] = acc[j] + br;
            }
            __syncthreads();
#pragma unroll 1
            for (int it = 0; it < 4; ++it) {
                const int tk = 8 * wv + 2 * it + hi;
                const float iv = lg[tk * 33 + r32];
                int rank = 0;
                for (int i = 0; i < 32; ++i) { const float vi = __shfl(iv, i + 32 * hi); rank += (vi > iv || (vi == iv && i < r32)) ? 1 : 0; }
                float tv[4]; int te[4];
#pragma unroll
                for (int r = 0; r < 4; ++r) { const unsigned long long bm = __ballot(rank == r); const unsigned hm = (unsigned)(bm >> (32 * hi)); const int src = __ffs(hm) - 1; te[r] = src; tv[r] = __shfl(iv, src + 32 * hi); }
                const float e0v = 1.f, e1v = expf(tv[1] - tv[0]), e2v = expf(tv[2] - tv[0]), e3v = expf(tv[3] - tv[0]); const float inv = 1.f / (e0v + e1v + e2v + e3v);
                if (r32 < 4) { const int e = r32 == 0 ? te[0] : r32 == 1 ? te[1] : r32 == 2 ? te[2] : te[3]; const float g = (r32 == 0 ? e0v : r32 == 1 ? e1v : r32 == 2 ? e2v : e3v) * inv;
                    const int a = (base + tk) * 4 + r32; const int pos = atomicAdd(&cnt[e], 1); list[(size_t)e * T_ + pos] = a; gate[a] = g; gate2[(size_t)e * T_ + pos] = g; sa2[(size_t)e * T_ + pos] = sah[base + tk]; }
            }
            __syncthreads();
        }
    }
    SEAM(7);
    LAS int* mtab = (LAS int*)(smem + g8::STAGE_BYTES);
    if (IN(8)) {
        const int lane = LANE_NOW; (void)lane;
        if (tid == 0) { int ub = 0, rs = 0;
            for (int e = 0; e < NE; ++e) { const int c = (int)__hip_atomic_load((unsigned*)&cnt[e], __ATOMIC_RELAXED, __HIP_MEMORY_SCOPE_AGENT); mtab[e] = c; mtab[32 + e] = ub; mtab[65 + e] = rs; ub += ((c + 255) >> 8) * 16; rs += c; }
            mtab[64] = ub; mtab[97] = rs; mtab[98] = ub; }
        __syncthreads();
        g8::moe_build(mtab, nb, vcu);
        __syncthreads();
        g8::ProbGu P{h8q, q8gu, actf8, p.in[I_BGU], list, sa2, sgu, g8::MoeTab{mtab, 16}, nb, vcu};
        g8::gemm_phase(lds, P);
        __syncthreads();
    }
    SEAM(8);
    if (IN(9)) {
        const int lane = LANE_NOW;
        for (int row0 = gw; row0 < NA; row0 += nw * 8) {
            uint2 raw[8][4];
#pragma unroll
            for (int i = 0; i < 8; ++i)
#pragma unroll
                for (int c = 0; c < 4; ++c) raw[i][c] = *(const uint2*)(actf8 + (size_t)(row0 + i * nw) * 2048 + (lane + 64 * c) * 8);
#pragma unroll
            for (int i = 0; i < 8; ++i) { const int row = row0 + i * nw;
                float v[32]; float amax = 0.f;
#pragma unroll
                for (int c = 0; c < 4; ++c) { const uint2 a = raw[i][c];
                    dec4_fp8(a.x, v[c * 8 + 0], v[c * 8 + 1], v[c * 8 + 2], v[c * 8 + 3]); dec4_fp8(a.y, v[c * 8 + 4], v[c * 8 + 5], v[c * 8 + 6], v[c * 8 + 7]);
#pragma unroll
                    for (int q = 0; q < 8; ++q) amax = fmaxf(amax, fabsf(v[c * 8 + q])); }
                amax = wave_max(amax);
                const float qinv = amax > 0.f ? 127.f / amax : 0.f;
                if (lane == 0) sact[row] = amax > 0.f ? amax / 127.f : 1.f;
#pragma unroll
                for (int c = 0; c < 4; ++c) { uint2 q; q.x = pack4_i8(v[c * 8 + 0] * qinv, v[c * 8 + 1] * qinv, v[c * 8 + 2] * qinv, v[c * 8 + 3] * qinv); q.y = pack4_i8(v[c * 8 + 4] * qinv, v[c * 8 + 5] * qinv, v[c * 8 + 6] * qinv, v[c * 8 + 7] * qinv);
                    *(uint2*)(act8 + (size_t)row * 2048 + (lane + 64 * c) * 8) = q; }
            }
        }
    }
    SEAM(9);
    if (IN(10)) {
        const int lane = LANE_NOW; (void)lane;
        if (tid == 0) { int ub = 0, rs = 0;
            for (int e = 0; e < NE; ++e) { const int c = (int)__hip_atomic_load((unsigned*)&cnt[e], __ATOMIC_RELAXED, __HIP_MEMORY_SCOPE_AGENT); mtab[e] = c; mtab[32 + e] = ub; mtab[65 + e] = rs; ub += ((c + 255) >> 8) * 8; rs += c; }
            mtab[64] = ub; mtab[97] = rs; mtab[98] = ub; }
        __syncthreads();
        g8::moe_build(mtab, nb, vcu);
        __syncthreads();
        g8::ProbDn P{act8, q8dn, yf8, p.in[I_BDN], list, gate2, sact, sdn, g8::MoeTab{mtab, 8}, nb, vcu};
        g8::gemm_phase(lds, P);
        __syncthreads();
    }
    SEAM(10);
    if (IN(11)) {
        const int lane = LANE_NOW; (void)lane;
        for (int row0 = gw; row0 < T_; row0 += nw * 2) {
          h8 hraw[2][4]; uint2 yraw[2][4][4];
#pragma unroll
          for (int i = 0; i < 2; ++i)
#pragma unroll
            for (int c = 0; c < 4; ++c) { const int col = (lane + 64 * c) * 8; const size_t yo = (size_t)(row0 + i * nw) * 4 * 2048 + col;
                hraw[i][c] = *(const h8*)(h16 + (size_t)(row0 + i * nw) * 2048 + col);
                yraw[i][c][0] = *(const uint2*)(yf8 + yo); yraw[i][c][1] = *(const uint2*)(yf8 + yo + 2048); yraw[i][c][2] = *(const uint2*)(yf8 + yo + 4096); yraw[i][c][3] = *(const uint2*)(yf8 + yo + 6144); }
#pragma unroll
          for (int i = 0; i < 2; ++i) { const int row = row0 + i * nw;
            float v[32]; float s = 0.f;
#pragma unroll
            for (int c = 0; c < 4; ++c) {
                const h8 hh8 = hraw[i][c];
                const uint2 y0 = yraw[i][c][0], y1 = yraw[i][c][1], y2 = yraw[i][c][2], y3 = yraw[i][c][3];
                float ys[8], t0[8], t1[8], t2[8], t3[8];
                dec4_fp8(y0.x, t0[0], t0[1], t0[2], t0[3]); dec4_fp8(y0.y, t0[4], t0[5], t0[6], t0[7]); dec4_fp8(y1.x, t1[0], t1[1], t1[2], t1[3]); dec4_fp8(y1.y, t1[4], t1[5], t1[6], t1[7]);
                dec4_fp8(y2.x, t2[0], t2[1], t2[2], t2[3]); dec4_fp8(y2.y, t2[4], t2[5], t2[6], t2[7]); dec4_fp8(y3.x, t3[0], t3[1], t3[2], t3[3]); dec4_fp8(y3.y, t3[4], t3[5], t3[6], t3[7]);
#pragma unroll
                for (int q = 0; q < 8; ++q) ys[q] = (t0[q] + t1[q]) + (t2[q] + t3[q]);
#pragma unroll
                for (int q = 0; q < 8; ++q) { v[c * 8 + q] = DN_ALPHA * (float)hh8[q] + ys[q] * 0.0625f; s += v[c * 8 + q]; } }
            const float mu = wave_sum(s) / 2048.f; float q2 = 0.f;
#pragma unroll
            for (int i = 0; i < 32; ++i) { const float d = v[i] - mu; q2 += d * d; }
            const float rs = rsqrtf(wave_sum(q2) / 2048.f + LN_EPS);
#pragma unroll
            for (int c = 0; c < 4; ++c) { const int col = (lane + 64 * c) * 8;
                const float4 ga = *(const float4*)(p.in[I_LN2G] + col), gb = *(const float4*)(p.in[I_LN2G] + col + 4), ba = *(const float4*)(p.in[I_LN2B] + col), bb = *(const float4*)(p.in[I_LN2B] + col + 4);
                float4 o0, o1;
                o0.x = (v[c * 8 + 0] - mu) * rs * ga.x + ba.x; o0.y = (v[c * 8 + 1] - mu) * rs * ga.y + ba.y; o0.z = (v[c * 8 + 2] - mu) * rs * ga.z + ba.z; o0.w = (v[c * 8 + 3] - mu) * rs * ga.w + ba.w;
                o1.x = (v[c * 8 + 4] - mu) * rs * gb.x + bb.x; o1.y = (v[c * 8 + 5] - mu) * rs * gb.y + bb.y; o1.z = (v[c * 8 + 6] - mu) * rs * gb.z + bb.z; o1.w = (v[c * 8 + 7] - mu) * rs * gb.w + bb.w;
                *(float4*)(p.out + (size_t)row * 2048 + col) = o0; *(float4*)(p.out + (size_t)row * 2048 + col + 4) = o1; }
          }
        }
    }
}

constexpr int NPHASE = 12;

extern "C" void kernel_launch(void* const* d_in, const int* in_sizes, int n_in, void* d_out, int out_size, void* d_ws, size_t ws_size, hipStream_t stream) {
    static int grid = 0;
    if (grid == 0) {
        if (n_in != 26 || ws_size < WS_END) { fprintf(stderr, "kernel_launch: unexpected n_in %d or ws_size %zu (< %zu)\n", n_in, ws_size, (size_t)WS_END); grid = -1; return; }
        int dev = 0, cus = 0, per_cu = 0;
        hipGetDevice(&dev); hipDeviceGetAttribute(&cus, hipDeviceAttributeMultiprocessorCount, dev);
        if (hipFuncSetAttribute((const void*)fwd, hipFuncAttributeMaxDynamicSharedMemorySize, LDS_BYTES) != hipSuccess) { fprintf(stderr, "hipFuncSetAttribute failed\n"); grid = -1; return; }
        hipOccupancyMaxActiveBlocksPerMultiprocessor(&per_cu, (const void*)fwd, 512, LDS_BYTES);
        (void)hipGetLastError();
        if (per_cu < 1) fprintf(stderr, "occupancy query says %d blocks per CU\n", per_cu);
        grid = cus > 0 ? cus : 256;
    }
    if (grid < 0) return;
    hipMemsetAsync((char*)d_ws + WS_CTL, 0, CTL_BYTES, stream);
    Params p{};
    for (int i = 0; i < 26; ++i) p.in[i] = (const float*)d_in[i];
    p.out = (float*)d_out; p.ws = (unsigned char*)d_ws;
#if N_LAUNCH_MODE == 1
    p.lo_hi = (long long)0 | ((long long)NPHASE << 32);
    hipLaunchKernelGGL(fwd, dim3(grid), dim3(512), LDS_BYTES, stream, p);
#else
    for (int ph = 0; ph < NPHASE; ++ph) {
        p.lo_hi = (long long)ph | ((long long)(ph + 1) << 32);
        hipLaunchKernelGGL(fwd, dim3(grid), dim3(512), LDS_BYTES, stream, p);
    }
#endif
}
```

```cpp
#include <hip/hip_runtime.h>
#include <cstdio>
#include <cstdint>

#ifndef N_LAUNCH_MODE
#define N_LAUNCH_MODE 1
#endif

constexpr int B_ = 8, S_ = 2048, D_ = 2048, T_ = B_ * S_;
constexpr int INW = 3608;
constexpr int C_Q = 0, C_KC = 1024, C_VC = 1280, C_KS = 1536, C_VS = 1792, C_KW = 2048, C_VW = 2304, C_G = 2560, C_UP = 2584, C_QM = 3096;
constexpr int NC = 127;
constexpr int CROWS = B_ * NC * 2;
constexpr int NE = 32, DE = 2048, NA = T_ * 4;
constexpr float LN_EPS = 1e-5f;
constexpr float DN_ALPHA = 1.189207115002721f;
constexpr float ATT_SCALE = 0.08838834764831845f;

constexpr size_t al256(size_t x) { return (x + 255) & ~(size_t)255; }
constexpr size_t WS_CTL = 0;
constexpr size_t CTL_BYTES = 65536;
constexpr size_t CTL_CNT = 16384;
constexpr size_t WS_PROJ = CTL_BYTES;
constexpr size_t WS_KVMEM = WS_PROJ + al256((size_t)T_ * INW * 4);
constexpr size_t WS_BIAS1 = WS_KVMEM + al256((size_t)2048 * 1024 * 4);
constexpr size_t WS_HID = WS_BIAS1 + al256(2 * 16 * 256 * 4);
constexpr size_t WS_KC = WS_HID + al256((size_t)2 * 2048 * 256 * 4);
constexpr size_t WS_VC = WS_KC + al256((size_t)CROWS * 128 * 4);
constexpr size_t WS_POOLED = WS_VC + al256((size_t)CROWS * 128 * 4);
constexpr size_t WS_OPOOL = WS_POOLED + al256((size_t)T_ * 512 * 4);
constexpr size_t WS_OWIN = WS_OPOOL + al256((size_t)T_ * 512 * 4);
constexpr size_t WS_OCMP = WS_OWIN + al256((size_t)T_ * 1024 * 4);
constexpr size_t WS_OSLC = WS_OCMP + al256((size_t)T_ * 1024 * 4);
constexpr size_t WS_SEL = WS_OSLC + al256((size_t)T_ * 1024 * 4);
constexpr size_t WS_OMEM = WS_SEL + al256((size_t)T_ * 2 * 4);
constexpr size_t WS_CAT16 = WS_OMEM + al256((size_t)T_ * 512 * 4);
constexpr size_t WS_HPRE = WS_CAT16 + al256((size_t)T_ * 2048 * 2);
constexpr size_t WS_H = WS_HPRE + al256((size_t)T_ * 2048 * 4);
constexpr size_t WS_H16 = WS_H + al256((size_t)T_ * 2048 * 4);
constexpr size_t WS_GATE = WS_H16 + al256((size_t)T_ * 2048 * 2);
constexpr size_t WS_LIST = WS_GATE + al256((size_t)NA * 4);
constexpr size_t WS_ACT16 = WS_LIST + al256((size_t)NE * T_ * 4);
constexpr size_t WS_Y16 = WS_ACT16 + al256((size_t)(NA + 256) * 2048 * 2);
constexpr size_t WS_X16 = WS_Y16 + al256((size_t)NA * 2048 * 2);
constexpr size_t WS_MEM16 = WS_X16 + (size_t)T_ * 2048 * 2;
constexpr size_t WS_WTIN = WS_MEM16 + al256((size_t)2048 * 2048 * 2);
constexpr size_t WS_WTOUT = WS_WTIN + al256((size_t)3840 * 2048 * 2);
constexpr size_t WS_WTGU = WS_WTOUT + al256((size_t)2048 * 2048 * 2);
constexpr size_t WS_WTDN = WS_WTGU + al256((size_t)NE * 4096 * 2048 * 2);
constexpr size_t WS_PROJ16 = WS_WTDN + al256((size_t)NE * 2048 * 2048 * 2);
constexpr size_t WS_KVMEM16 = WS_PROJ16 + al256((size_t)(T_ + 64) * INW * 2);
constexpr size_t WS_WT1 = WS_KVMEM16 + al256((size_t)2048 * 1024 * 2);
constexpr size_t WS_UV = WS_WT1 + al256((size_t)2 * 512 * 2048 * 2);
constexpr size_t WS_KC16 = WS_UV + al256((size_t)2 * 4 * 2048 * 512 * 4);
constexpr size_t WS_VC16 = WS_KC16 + al256((size_t)B_ * 128 * 256 * 2);
constexpr size_t WS_WR16 = WS_VC16 + al256((size_t)B_ * 128 * 256 * 2);
constexpr size_t WS_Q8GU = WS_WR16 + al256((size_t)32 * 2048 * 2);
constexpr size_t WS_Q8DN = WS_Q8GU + al256((size_t)NE * 4096 * 2048);
constexpr size_t WS_SGU = WS_Q8DN + al256((size_t)NE * 2048 * 2048);
constexpr size_t WS_SDN = WS_SGU + al256((size_t)NE * 4096 * 4);
constexpr size_t WS_H8 = WS_SDN + al256((size_t)NE * 2048 * 4);
constexpr size_t WS_SAH = WS_H8 + al256((size_t)T_ * 2048);
constexpr size_t WS_ACT8 = WS_SAH + al256((size_t)T_ * 4);
constexpr size_t WS_SACT = WS_ACT8 + al256((size_t)(NA + 256) * 2048);
constexpr size_t WS_WTMKV = WS_SACT + al256((size_t)(NA + 256) * 4);
constexpr size_t WS_Q8OUT = WS_WTMKV + al256((size_t)1024 * 2048 * 2);
constexpr size_t WS_SOUT = WS_Q8OUT + al256((size_t)2048 * 2048);
constexpr size_t WS_CAT8 = WS_SOUT + al256(2048 * 4);
constexpr size_t WS_SCAT = WS_CAT8 + al256((size_t)T_ * 2048);
constexpr size_t WS_SA2 = WS_SCAT + al256((size_t)T_ * 4);
constexpr size_t WS_GATE2 = WS_SA2 + al256((size_t)NE * T_ * 4);
constexpr size_t WS_X8 = WS_GATE2 + al256((size_t)NE * T_ * 4);
constexpr size_t WS_SXA = WS_X8 + al256((size_t)(T_ + 2048) * 2048);
constexpr size_t WS_Q8IN = WS_SXA + al256((size_t)(T_ + 2048) * 4);
constexpr size_t WS_SIN8 = WS_Q8IN + al256((size_t)2560 * 2048);
constexpr size_t WS_Q8MKV = WS_SIN8 + al256(2560 * 4);
constexpr size_t WS_SMKV = WS_Q8MKV + al256((size_t)1024 * 2048);
constexpr size_t WS_WT2 = WS_SMKV + al256(1024 * 4);
constexpr size_t WS_KV16 = WS_WT2 + al256((size_t)2 * 128 * 256 * 2);
constexpr size_t KVSEG = (size_t)S_ * 128;
constexpr size_t WS_END = WS_KV16 + al256((size_t)6 * B_ * 2 * S_ * 128 * 2);

constexpr int LDS_BYTES = 155648;

struct Params {
    const float* in[26];
    float* out;
    unsigned char* ws;
    long long lo_hi;
};
enum { I_X = 0, I_MEM, I_WIN, I_POSK, I_W1K, I_W2K, I_POSV, I_W1V, I_W2V, I_POOLW, I_POOLS, I_WMEMKV, I_GNNSA, I_GNPOOL, I_GNMEM, I_WOUT,
       I_LN1G, I_LN1B, I_WR, I_BR, I_WGU, I_BGU, I_WDN, I_BDN, I_LN2G, I_LN2B };

#define XB_TMO      128
#define XB_XCNT(j)  (256  + 64 * (j))
#define XB_XSUB(j)  (1280 + 64 * (j))
#define XB_XGEN(j)  (2304 + 64 * (j))
#define XB_TOP      3328
#define XB_TOPGEN   3392
#define XCD_BAR_WORDS 3456
#define XB_SPIN_CAP (1u << 25)
#define LAS __attribute__((address_space(3)))

__device__ __forceinline__ unsigned xb_ld(unsigned* p)              { return __hip_atomic_load(p, __ATOMIC_RELAXED, __HIP_MEMORY_SCOPE_AGENT); }
__device__ __forceinline__ unsigned xb_add(unsigned* p, unsigned v) { return __hip_atomic_fetch_add(p, v, __ATOMIC_RELAXED, __HIP_MEMORY_SCOPE_AGENT); }
__device__ __forceinline__ unsigned xb_xcc_id() { return (unsigned)__builtin_amdgcn_s_getreg((3 << 11) | 20) & 0xFu; }
#define XB_SPIN(cond, bar) do { unsigned _sp = 0; while (cond) { __builtin_amdgcn_s_sleep(1); \
    if ((++_sp & 255u) == 0u) { if (xb_ld(&(bar)[XB_TMO])) break; if (_sp > XB_SPIN_CAP) { atomicAdd(&(bar)[XB_TMO], 1u); break; } } } } while (0)

struct XcdBarrier { unsigned* bar; unsigned x; volatile LAS unsigned* st; };

__device__ __forceinline__ XcdBarrier xcd_barrier_post(unsigned* bar, volatile LAS unsigned* st) {
    XcdBarrier b; b.bar = bar; b.x = xb_xcc_id(); b.st = st;
    if (threadIdx.x == 0) (void)xb_add(&bar[XB_XCNT(b.x)], 1u);
    return b;
}
__device__ __forceinline__ void xcd_barrier_complete(unsigned* bar, unsigned x, unsigned& nloc, unsigned& nx) {
    const unsigned G = gridDim.x * gridDim.y * gridDim.z;
    unsigned sum, cnt, mine, sp = 0u;
    for (;;) {
        sum = 0u; cnt = 0u; mine = 0u;
#pragma unroll
        for (unsigned j = 0; j < 16; ++j) { const unsigned c = xb_ld(&bar[XB_XCNT(j)]); sum += c; cnt += (c > 0u) ? 1u : 0u; mine = (j == x) ? c : mine; }
        if (sum == G) break;
        __builtin_amdgcn_s_sleep(1);
        if ((++sp & 255u) == 0u) { if (xb_ld(&bar[XB_TMO])) break; if (sp > XB_SPIN_CAP) { atomicAdd(&bar[XB_TMO], 1u); break; } }
    }
    nloc = mine > 0u ? mine : 1u; nx = cnt > 0u ? cnt : 1u;
}
__device__ __forceinline__ void xcd_barrier(const XcdBarrier& b) {
    asm volatile("s_waitcnt vmcnt(0)" ::: "memory");
    __syncthreads();
    if (threadIdx.x == 0) {
        unsigned* bar = b.bar;
        __builtin_amdgcn_s_waitcnt(0);
        unsigned nloc = b.st[0], nx = b.st[1];
        if (nloc == 0u) { xcd_barrier_complete(bar, b.x, nloc, nx); b.st[0] = nloc; b.st[1] = nx; }
        const unsigned old = xb_add(&bar[XB_XSUB(b.x)], 1u);
        const unsigned gen = old / nloc;
        if (old + 1u == (gen + 1u) * nloc) {
            __builtin_amdgcn_fence(__ATOMIC_RELEASE, "agent");
            asm volatile("s_waitcnt vmcnt(0)" ::: "memory");
            const unsigned og = xb_add(&bar[XB_TOP], 1u);
            const unsigned tg = og / nx;
            if (og + 1u == (tg + 1u) * nx) xb_add(&bar[XB_TOPGEN], 1u);
            else XB_SPIN(xb_ld(&bar[XB_TOPGEN]) == tg, bar);
            __builtin_amdgcn_fence(__ATOMIC_ACQUIRE, "agent");
            xb_add(&bar[XB_XGEN(b.x)], 1u);
            asm volatile("s_waitcnt vmcnt(0)" ::: "memory");
        } else {
            XB_SPIN(xb_ld(&bar[XB_XGEN(b.x)]) == gen, bar);
            __builtin_amdgcn_fence(__ATOMIC_ACQUIRE, "agent");
            asm volatile("s_waitcnt vmcnt(0)" ::: "memory");
        }
    }
    __syncthreads();
}

typedef _Float16 h8 __attribute__((ext_vector_type(8)));
typedef _Float16 h4 __attribute__((ext_vector_type(4)));
typedef float f4 __attribute__((ext_vector_type(4)));

__device__ __forceinline__ float wave_sum(float v) {
#pragma unroll
    for (int o = 32; o > 0; o >>= 1) v += __shfl_xor(v, o);
    return v;
}
__device__ __forceinline__ float wave_max(float v) {
#pragma unroll
    for (int o = 32; o > 0; o >>= 1) v = fmaxf(v, __shfl_xor(v, o));
    return v;
}
__device__ __forceinline__ void wave_sync() {
    asm volatile("s_waitcnt lgkmcnt(0)" ::: "memory");
    __builtin_amdgcn_wave_barrier();
}
__device__ __forceinline__ float gelu_tanh(float x) {
    const float u = 0.7978845608028654f * (x + 0.044715f * x * x * x);
    return 0.5f * x * (1.f + tanhf(u));
}
__device__ __forceinline__ float gelu_fast(float x) { const float u = 0.7978845608028654f * (x + 0.044715f * x * x * x); const float t = 1.f - 2.f * __builtin_amdgcn_rcpf(1.f + __builtin_amdgcn_exp2f(2.8853900817779268f * u)); return 0.5f * x * (1.f + t); }
__device__ __forceinline__ float sigmoidf_(float x) { return 1.f / (1.f + expf(-x)); }
__device__ __forceinline__ unsigned pk4_fp8(float a, float b, float c, float d) { int w = 0; w = __builtin_amdgcn_cvt_pk_fp8_f32(a, b, w, false); w = __builtin_amdgcn_cvt_pk_fp8_f32(c, d, w, true); return (unsigned)w; }
__device__ __forceinline__ void dec4_fp8(unsigned w, float& a, float& b, float& c, float& d) { a = __builtin_amdgcn_cvt_f32_fp8((int)w, 0); b = __builtin_amdgcn_cvt_f32_fp8((int)w, 1); c = __builtin_amdgcn_cvt_f32_fp8((int)w, 2); d = __builtin_amdgcn_cvt_f32_fp8((int)w, 3); }
__device__ __forceinline__ float swiglu_fast(float g, float l) { const float xg = fminf(g, 7.f), xl = fminf(fmaxf(l, -7.f), 7.f); return xg * __builtin_amdgcn_rcpf(1.f + __builtin_amdgcn_exp2f(-2.4554669595930156f * xg)) * (xl + 1.f); }

constexpr int G_LD = 40;
template <class AF, class EF>
__device__ __forceinline__ void gemm_tile(char* smem, int K, const AF& af, const float* __restrict__ Bm, int ldb, int n0, int Nlim, bool perm, const EF& ef) {
    _Float16* As = (_Float16*)smem;
    _Float16* Bs = As + 128 * G_LD;
    const int tid = threadIdx.x, lane = tid & 63, wid = tid >> 6, wr = wid >> 2, wc = wid & 3, fr = lane & 15, fq = lane >> 4;
    f4 acc[4][2];
#pragma unroll
    for (int m = 0; m < 4; ++m)
#pragma unroll
        for (int n = 0; n < 2; ++n) acc[m][n] = (f4){0.f, 0.f, 0.f, 0.f};
    const int ar = tid >> 3, ak = (tid & 7) * 4;
    const float* ap0 = af.row(ar);
    const float* ap1 = af.row(ar + 64);
    const int bk = tid >> 5, bn = (tid & 31) * 4;
    const bool bok = (n0 + bn) < Nlim;
    int bnp[4];
#pragma unroll
    for (int i = 0; i < 4; ++i) { const int c = bn + i; bnp[i] = perm ? ((c & ~31) | ((c & 1) << 4) | ((c & 31) >> 1)) : c; }
    for (int k0 = 0; k0 < K; k0 += 32) {
        const int ko = af.koff(k0 + ak);
        float4 a0 = make_float4(0.f, 0.f, 0.f, 0.f), a1 = a0, b0 = a0, b1 = a0;
        if (ap0) a0 = *(const float4*)(ap0 + ko);
        if (ap1) a1 = *(const float4*)(ap1 + ko);
        if (bok) { b0 = *(const float4*)(Bm + (size_t)(k0 + bk) * ldb + n0 + bn); b1 = *(const float4*)(Bm + (size_t)(k0 + bk + 16) * ldb + n0 + bn); }
        __syncthreads();
        *(h4*)&As[ar * G_LD + ak] = (h4){(_Float16)a0.x, (_Float16)a0.y, (_Float16)a0.z, (_Float16)a0.w};
        *(h4*)&As[(ar + 64) * G_LD + ak] = (h4){(_Float16)a1.x, (_Float16)a1.y, (_Float16)a1.z, (_Float16)a1.w};
        Bs[bnp[0] * G_LD + bk] = (_Float16)b0.x; Bs[bnp[1] * G_LD + bk] = (_Float16)b0.y; Bs[bnp[2] * G_LD + bk] = (_Float16)b0.z; Bs[bnp[3] * G_LD + bk] = (_Float16)b0.w;
        Bs[bnp[0] * G_LD + bk + 16] = (_Float16)b1.x; Bs[bnp[1] * G_LD + bk + 16] = (_Float16)b1.y; Bs[bnp[2] * G_LD + bk + 16] = (_Float16)b1.z; Bs[bnp[3] * G_LD + bk + 16] = (_Float16)b1.w;
        __syncthreads();
        h8 a[4], b[2];
#pragma unroll
        for (int m = 0; m < 4; ++m) a[m] = *(const h8*)&As[(wr * 64 + m * 16 + fr) * G_LD + fq * 8];
#pragma unroll
        for (int n = 0; n < 2; ++n) b[n] = *(const h8*)&Bs[(wc * 32 + n * 16 + fr) * G_LD + fq * 8];
#pragma unroll
        for (int m = 0; m < 4; ++m)
#pragma unroll
            for (int n = 0; n < 2; ++n) acc[m][n] = __builtin_amdgcn_mfma_f32_16x16x32_f16(a[m], b[n], acc[m][n], 0, 0, 0);
    }
    ef(acc, wr, wc, fr, fq);
    __syncthreads();
}

struct ARowPlain { const float* base; int ld; int m0; int mlim;
    __device__ __forceinline__ const float* row(int r) const { return (m0 + r) < mlim ? base + (size_t)(m0 + r) * ld : nullptr; }
    __device__ __forceinline__ int koff(int k) const { return k; } };
struct ARowCmp { const float* proj; int col; int m0;
    __device__ __forceinline__ const float* row(int r) const { const int g = m0 + r; if (g >= CROWS) return nullptr; const int kvh = g & 1, bc = g >> 1, b = bc / NC, c = bc % NC;
        return proj + (size_t)(b * S_ + 16 * c) * INW + col + kvh * 128; }
    __device__ __forceinline__ int koff(int k) const { return (k >> 7) * INW + (k & 127); } };
struct ARowList { const float* base; const int* list; int m0; int cnt; int shift;
    __device__ __forceinline__ const float* row(int r) const { if (m0 + r >= cnt) return nullptr; const int a = list[m0 + r]; return base + (size_t)(a >> shift) * 2048; }
    __device__ __forceinline__ int koff(int k) const { return k; } };

struct EpiStore { float* C; int ldc; int m0; int n0; int mlim; int nlim; _Float16* C16;
    __device__ __forceinline__ void operator()(const f4 (&acc)[4][2], int wr, int wc, int fr, int fq) const {
#pragma unroll
        for (int m = 0; m < 4; ++m)
#pragma unroll
            for (int n = 0; n < 2; ++n)
#pragma unroll
                for (int j = 0; j < 4; ++j) { const int r = m0 + wr * 64 + m * 16 + fq * 4 + j, c = n0 + wc * 32 + n * 16 + fr;
                    if (r < mlim && c < nlim) { C[(size_t)r * ldc + c] = acc[m][n][j]; if (C16) C16[(size_t)r * ldc + c] = (_Float16)acc[m][n][j]; } } } };
struct EpiKc { _Float16* C; int m0;
    __device__ __forceinline__ void operator()(const f4 (&acc)[4][2], int wr, int wc, int fr, int fq) const {
#pragma unroll
        for (int m = 0; m < 4; ++m)
#pragma unroll
            for (int n = 0; n < 2; ++n)
#pragma unroll
                for (int j = 0; j < 4; ++j) { const int r = m0 + wr * 64 + m * 16 + fq * 4 + j, c = wc * 32 + n * 16 + fr;
                    C[(size_t)r * 128 + c] = (((r >> 1) & 127) == 127) ? (_Float16)0.f : (_Float16)acc[m][n][j]; } } };
struct EpiPool { _Float16* C; const float* scale; int m0; int g;
    __device__ __forceinline__ void operator()(const f4 (&acc)[4][2], int wr, int wc, int fr, int fq) const {
#pragma unroll
        for (int m = 0; m < 4; ++m)
#pragma unroll
            for (int n = 0; n < 2; ++n)
#pragma unroll
                for (int j = 0; j < 4; ++j) { const int r = m0 + wr * 64 + m * 16 + fq * 4 + j, c = g * 128 + wc * 32 + n * 16 + fr;
                    C[(size_t)r * 512 + c] = (_Float16)(acc[m][n][j] * scale[c]); } } };
struct EpiHid { float* C; const float* bias; int m0; int n0;
    __device__ __forceinline__ void operator()(const f4 (&acc)[4][2], int wr, int wc, int fr, int fq) const {
#pragma unroll
        for (int m = 0; m < 4; ++m)
#pragma unroll
            for (int n = 0; n < 2; ++n)
#pragma unroll
                for (int j = 0; j < 4; ++j) { const int r = m0 + wr * 64 + m * 16 + fq * 4 + j, c = n0 + wc * 32 + n * 16 + fr;
                    if (r < CROWS) C[(size_t)r * 256 + c] = gelu_tanh(acc[m][n][j] + bias[c]); } } };
struct EpiOut { float* C; const float* x; int m0; int n0;
    __device__ __forceinline__ void operator()(const f4 (&acc)[4][2], int wr, int wc, int fr, int fq) const {
#pragma unroll
        for (int m = 0; m < 4; ++m)
#pragma unroll
            for (int n = 0; n < 2; ++n)
#pragma unroll
                for (int j = 0; j < 4; ++j) { const size_t o = (size_t)(m0 + wr * 64 + m * 16 + fq * 4 + j) * 2048 + n0 + wc * 32 + n * 16 + fr;
                    C[o] = DN_ALPHA * x[o] + acc[m][n][j]; } } };
struct EpiGu { float* act; const float* bgu; const int* list; int m0; int cnt; int n0;
    __device__ __forceinline__ void operator()(const f4 (&acc)[4][2], int wr, int wc, int fr, int fq) const {
        const int jc = (n0 + wc * 32) / 2 + fr;
        const float bg = bgu[2 * jc], bl = bgu[2 * jc + 1];
#pragma unroll
        for (int m = 0; m < 4; ++m)
#pragma unroll
            for (int j = 0; j < 4; ++j) { const int r = m0 + wr * 64 + m * 16 + fq * 4 + j;
                if (r < cnt) { const int a = list[r];
                    const float xg = fminf(acc[m][0][j] + bg, 7.f), xl = fminf(fmaxf(acc[m][1][j] + bl, -7.f), 7.f);
                    act[(size_t)a * 2048 + jc] = xg * sigmoidf_(1.702f * xg) * (xl + 1.f); } } } };
struct EpiDn { float* y; const float* bdn; const int* list; const float* gate; int m0; int cnt; int n0;
    __device__ __forceinline__ void operator()(const f4 (&acc)[4][2], int wr, int wc, int fr, int fq) const {
#pragma unroll
        for (int m = 0; m < 4; ++m)
#pragma unroll
            for (int j = 0; j < 4; ++j) { const int r = m0 + wr * 64 + m * 16 + fq * 4 + j;
                if (r < cnt) { const int a = list[r]; const float g = gate[a];
#pragma unroll
                    for (int n = 0; n < 2; ++n) { const int c = n0 + wc * 32 + n * 16 + fr; y[(size_t)a * 2048 + c] = (acc[m][n][j] + bdn[c]) * g; } } } } };

constexpr int WLDS_FLOATS = 4096 + 512 + 32;
template <bool SHARED>
__device__ __forceinline__ void wave_attn(float* sw, const float* __restrict__ qptr, const float* __restrict__ Kb, const float* __restrict__ Vb, int ld, int nseg, float scale, float* __restrict__ optr) {
    const int lane = threadIdx.x & 63;
    float* sq = sw + 4096; const int* segs = (const int*)(sw + 4096 + 512);
#pragma unroll
    for (int i = 0; i < 8; ++i) sq[lane + 64 * i] = qptr[lane + 64 * i];
    wave_sync();
    for (int sg = 0; sg < nseg; ++sg) {
        const int start = segs[sg], len = segs[16 + sg];
        float d0 = 0.f, d1 = 0.f, d2 = 0.f, d3 = 0.f;
        if (lane < len) {
            const float* kp = Kb + (size_t)(start + lane) * ld;
            for (int d4 = 0; d4 < 32; ++d4) {
                if (SHARED) {
                    const float4 kv = *(const float4*)(kp + d4 * 4);
                    const float4 q0 = *(const float4*)(sq + d4 * 4), q1 = *(const float4*)(sq + 128 + d4 * 4), q2 = *(const float4*)(sq + 256 + d4 * 4), q3 = *(const float4*)(sq + 384 + d4 * 4);
                    d0 += kv.x * q0.x + kv.y * q0.y + kv.z * q0.z + kv.w * q0.w;
                    d1 += kv.x * q1.x + kv.y * q1.y + kv.z * q1.z + kv.w * q1.w;
                    d2 += kv.x * q2.x + kv.y * q2.y + kv.z * q2.z + kv.w * q2.w;
                    d3 += kv.x * q3.x + kv.y * q3.y + kv.z * q3.z + kv.w * q3.w;
                } else {
                    const float4 k0 = *(const float4*)(kp + d4 * 4), k1 = *(const float4*)(kp + 128 + d4 * 4), k2 = *(const float4*)(kp + 256 + d4 * 4), k3 = *(const float4*)(kp + 384 + d4 * 4);
                    const float4 q0 = *(const float4*)(sq + d4 * 4), q1 = *(const float4*)(sq + 128 + d4 * 4), q2 = *(const float4*)(sq + 256 + d4 * 4), q3 = *(const float4*)(sq + 384 + d4 * 4);
                    d0 += k0.x * q0.x + k0.y * q0.y + k0.z * q0.z + k0.w * q0.w;
                    d1 += k1.x * q1.x + k1.y * q1.y + k1.z * q1.z + k1.w * q1.w;
                    d2 += k2.x * q2.x + k2.y * q2.y + k2.z * q2.z + k2.w * q2.w;
                    d3 += k3.x * q3.x + k3.y * q3.y + k3.z * q3.z + k3.w * q3.w;
                }
            }
        }
        const bool ok = lane < len;
        sw[sg * 64 + lane] = ok ? d0 * scale : -1e30f;
        sw[1024 + sg * 64 + lane] = ok ? d1 * scale : -1e30f;
        sw[2048 + sg * 64 + lane] = ok ? d2 * scale : -1e30f;
        sw[3072 + sg * 64 + lane] = ok ? d3 * scale : -1e30f;
    }
    wave_sync();
    const int n = nseg * 64;
#pragma unroll
    for (int g = 0; g < 4; ++g) {
        float mx = -1e30f;
        for (int i = lane; i < n; i += 64) mx = fmaxf(mx, sw[g * 1024 + i]);
        mx = wave_max(mx);
        float sm = 0.f;
        for (int i = lane; i < n; i += 64) { const float v = sw[g * 1024 + i]; sm += (v > -1e29f) ? expf(v - mx) : 0.f; }
        sm = wave_sum(sm);
        const float inv = sm > 0.f ? 1.f / sm : 0.f;
        for (int i = lane; i < n; i += 64) { const float v = sw[g * 1024 + i]; sw[g * 1024 + i] = (v > -1e29f) ? expf(v - mx) * inv : 0.f; }
    }
    wave_sync();
    float o[4][2];
#pragma unroll
    for (int g = 0; g < 4; ++g) { o[g][0] = 0.f; o[g][1] = 0.f; }
    for (int sg = 0; sg < nseg; ++sg) {
        const int start = segs[sg], len = segs[16 + sg];
        for (int l = 0; l < len; ++l) {
            const float* vp = Vb + (size_t)(start + l) * ld;
            if (SHARED) {
                const float v0 = vp[lane], v1 = vp[lane + 64];
#pragma unroll
                for (int g = 0; g < 4; ++g) { const float p = sw[g * 1024 + sg * 64 + l]; o[g][0] += p * v0; o[g][1] += p * v1; }
            } else {
#pragma unroll
                for (int g = 0; g < 4; ++g) { const float p = sw[g * 1024 + sg * 64 + l]; o[g][0] += p * vp[g * 128 + lane]; o[g][1] += p * vp[g * 128 + lane + 64]; }
            }
        }
    }
#pragma unroll
    for (int g = 0; g < 4; ++g) { optr[g * 128 + lane] = o[g][0]; optr[g * 128 + lane + 64] = o[g][1]; }
}

namespace g8 {
constexpr int BM = 256, BK = 64, HALF = 128, HTB = HALF * BK * 2, STAGE_BYTES = 8 * HTB;
constexpr int KK = 2048;
typedef float f32x4 __attribute__((ext_vector_type(4)));
__device__ __forceinline__ int lds_byte(int r, int c) { return r * 128 + ((((c >> 3) ^ (r >> 1)) & 7) << 4) + (c & 7) * 2; }
__device__ __forceinline__ void stage_rc(int b, int& R, int& C) { R = b >> 7; C = ((((b >> 4) ^ (R >> 1)) & 7)) * 8; }
__device__ __forceinline__ int perm32(int rho) { const int n = rho >> 4, i = rho & 15; return 8 * (i >> 2) + 4 * n + (i & 3); }

typedef int i32x4 __attribute__((ext_vector_type(4)));
typedef unsigned u32x2 __attribute__((ext_vector_type(2)));
typedef unsigned u32x4 __attribute__((ext_vector_type(4)));
template <bool I8> struct AccSel { typedef f32x4 T; };
template <> struct AccSel<true> { typedef i32x4 T; };
__device__ __forceinline__ f32x4 mma16(i32x4 a, i32x4 b, f32x4 c) { return __builtin_amdgcn_mfma_f32_16x16x32_f16(*reinterpret_cast<h8*>(&a), *reinterpret_cast<h8*>(&b), c, 0, 0, 0); }
__device__ __forceinline__ i32x4 mma16(i32x4 a, i32x4 b, i32x4 c) { return __builtin_amdgcn_mfma_i32_16x16x64_i8(a, b, c, 0, 0, 0); }
struct Unit { int m0, n0, e, cnt, rbase; };
constexpr int EP_OFF = STAGE_BYTES + 2048, EP_LD = 528, EP_GRP = 16 * EP_LD;
__device__ __forceinline__ void ep_sync() { asm volatile("s_waitcnt lgkmcnt(0)" ::: "memory"); __builtin_amdgcn_s_barrier(); asm volatile("" ::: "memory"); }
__device__ __forceinline__ int ep_tid() { int tz = threadIdx.x; asm volatile("" : "+v"(tz)); return tz; }
__device__ __forceinline__ h8 cvt8(f32x4 a, f32x4 b) { h8 o; o[0] = (_Float16)a[0]; o[1] = (_Float16)a[1]; o[2] = (_Float16)a[2]; o[3] = (_Float16)a[3]; o[4] = (_Float16)b[0]; o[5] = (_Float16)b[1]; o[6] = (_Float16)b[2]; o[7] = (_Float16)b[3]; return o; }

__device__ __forceinline__ void tile_order(int L, int nM, int nN, int& pm, int& pn) {
    const int nwg = nM * nN; int wgid = L;
    { const int q = nwg / 8, r = nwg % 8, xcd = wgid % 8, off = wgid / 8; wgid = (xcd < r ? xcd * (q + 1) : r * (q + 1) + (xcd - r) * q) + off; }
    const int nig = 8 * nN, gid = wgid / nig, fm = gid * 8, gsz = (nM - fm) < 8 ? (nM - fm) : 8;
    pm = fm + ((wgid % nig) % gsz); pn = (wgid % nig) / gsz;
}

template <class Prob>
__device__ __forceinline__ void gemm_phase(LAS unsigned char* lds, const Prob& P) {
    const int tid = threadIdx.x, wid = __builtin_amdgcn_readfirstlane(tid >> 6), lane = tid & 63, wr = wid >> 2, wc = wid & 3, fr = lane & 15, fq = lane >> 4;
    constexpr int nt = Prob::NT; constexpr size_t KS2 = Prob::KS2; constexpr unsigned ROWB = Prob::ROWB; constexpr bool I8 = Prob::I8;
    int sR[2], sC2[2]; unsigned voffB[2];
#pragma unroll
    for (int i = 0; i < 2; ++i) { int R, C; stage_rc(tid * 16 + i * 8192, R, C); sR[i] = R; sC2[i] = C * 2; const int Rb = Prob::PERM ? ((R & ~31) + perm32(R & 31)) : R; voffB[i] = (unsigned)Rb * ROWB + (unsigned)C * 2u; }
    const size_t kstep = (size_t)(BK * 2);
    const size_t hstep = (size_t)HALF * ROWB;
    const unsigned ldsw = (unsigned)wid * 1024u;
    const int aoff = lds_byte(wr * 64 + fr, fq * 8), boff = lds_byte(wc * 32 + fr, fq * 8), aoff1 = lds_byte(wr * 64 + fr, fq * 8 + 32), boff1 = lds_byte(wc * 32 + fr, fq * 8 + 32);
#define G8_SA(b, h) (((b) * 2 + (h)) * HTB)
#define G8_SB(b, h) ((4 + (b) * 2 + (h)) * HTB)
#define G8_STAGE(bufoff, gbase, voff) do { _Pragma("unroll") for (int _i = 0; _i < 2; ++_i) \
        __builtin_amdgcn_global_load_lds((const unsigned*)((const char*)(gbase) + (voff)[_i]), (LAS unsigned*)(lds + (bufoff) + ldsw + _i * 8192), 16, 0, 0); } while (0)
#define G8_LDA(dst, b, h) do { _Pragma("unroll") for (int m = 0; m < 4; ++m) _Pragma("unroll") for (int k = 0; k < 2; ++k) dst[m][k] = *(const LAS i32x4*)(lds + G8_SA(b, h) + (k ? aoff1 : aoff) + m * 2048); } while (0)
#define G8_LDB(dst, b, h) do { _Pragma("unroll") for (int n = 0; n < 2; ++n) _Pragma("unroll") for (int k = 0; k < 2; ++k) dst[n][k] = *(const LAS i32x4*)(lds + G8_SB(b, h) + (k ? boff1 : boff) + n * 2048); } while (0)
#define G8_MMA(ai, bj, At, Bt) do { __builtin_amdgcn_s_setprio(1); _Pragma("unroll") for (int m = 0; m < 4; ++m) _Pragma("unroll") for (int n = 0; n < 2; ++n) _Pragma("unroll") for (int k = 0; k < 2; ++k) \
        acc[ai][bj][m][n] = mma16(Bt[n][k], At[m][k], acc[ai][bj][m][n]); __builtin_amdgcn_s_setprio(0); } while (0)
#define G8_WAIT_V(n) asm volatile("s_waitcnt vmcnt(" #n ")" ::: "memory")
#define G8_WAIT_L(n) asm volatile("s_waitcnt lgkmcnt(" #n ")" ::: "memory")
#define G8_BAR __builtin_amdgcn_s_barrier()
#define G8_SCHED __builtin_amdgcn_sched_barrier(0)
    Unit cur, nxt; int ui = 0;
    if (!P.next(0, cur)) return;
    typedef typename AccSel<I8>::T AccT;
    AccT acc[2][2][4][2];
#pragma unroll
    for (int a = 0; a < 2; ++a)
#pragma unroll
        for (int b = 0; b < 2; ++b)
#pragma unroll
            for (int m = 0; m < 4; ++m)
#pragma unroll
                for (int n = 0; n < 2; ++n) acc[a][b][m][n] = AccT{};
    i32x4 At[4][2], B0[2][2], B1[2][2];
    unsigned vc[2][2], vn[2][2];
    P.a_offs(cur, sR, sC2, vc);
    const char* const Ab = P.a_base();
    const char* cB = P.b_base(cur);
    G8_STAGE(G8_SB(0, 0), cB, voffB); G8_STAGE(G8_SA(0, 0), Ab, vc[0]); G8_STAGE(G8_SB(0, 1), cB + hstep, voffB); G8_STAGE(G8_SA(0, 1), Ab, vc[1]);
    if (wr == 1) G8_BAR;
    G8_WAIT_V(4); G8_BAR;
    G8_STAGE(G8_SB(1, 0), cB + kstep, voffB); G8_STAGE(G8_SA(1, 0), Ab + kstep, vc[0]); G8_STAGE(G8_SB(1, 1), cB + hstep + kstep, voffB);
    G8_WAIT_V(6); G8_BAR;
    for (;;) {
        const bool has_next = P.next(ui + 1, nxt);
        const char* nB = cB;
        if (has_next) { P.a_offs(nxt, sR, sC2, vn); nB = P.b_base(nxt); }
        else { vn[0][0] = vc[0][0]; vn[0][1] = vc[0][1]; vn[1][0] = vc[1][0]; vn[1][1] = vc[1][1]; }
        for (int t = 0; t < nt; t += 2) {
            const bool last = (t == nt - 2);
            const char* a1 = Ab + (size_t)(t >> 1) * KS2 + kstep;
            const char* a2 = last ? Ab : Ab + (size_t)((t + 2) >> 1) * KS2; const char* b2 = last ? nB : cB + (size_t)(t + 2) * kstep;
            const char* a3 = a2 + kstep; const char* b3 = b2 + kstep;
            unsigned o2[2][2];
            o2[0][0] = last ? vn[0][0] : vc[0][0]; o2[0][1] = last ? vn[0][1] : vc[0][1]; o2[1][0] = last ? vn[1][0] : vc[1][0]; o2[1][1] = last ? vn[1][1] : vc[1][1];
            G8_LDB(B0, 0, 0); G8_SCHED; G8_LDA(At, 0, 0); G8_STAGE(G8_SA(1, 1), a1, vc[1]);
            G8_WAIT_L(8); G8_BAR; G8_WAIT_L(0); G8_MMA(0, 0, At, B0); G8_BAR; G8_SCHED;
            G8_LDB(B1, 0, 1); G8_STAGE(G8_SB(0, 0), b2, voffB);
            G8_BAR; G8_WAIT_L(0); G8_MMA(0, 1, At, B1); G8_BAR;
            G8_LDA(At, 0, 1); G8_STAGE(G8_SA(0, 0), a2, o2[0]);
            G8_BAR; G8_WAIT_L(0); G8_MMA(1, 0, At, B0); G8_BAR; G8_SCHED;
            G8_STAGE(G8_SB(0, 1), b2 + hstep, voffB);
            G8_WAIT_V(6); G8_BAR; G8_MMA(1, 1, At, B1); G8_BAR;
            G8_LDB(B0, 1, 0); G8_SCHED; G8_LDA(At, 1, 0); G8_STAGE(G8_SA(0, 1), a2, o2[1]);
            G8_WAIT_L(8); G8_BAR; G8_WAIT_L(0); G8_MMA(0, 0, At, B0); G8_BAR; G8_SCHED;
            G8_LDB(B1, 1, 1); G8_STAGE(G8_SB(1, 0), b3, voffB);
            G8_BAR; G8_WAIT_L(0); G8_MMA(0, 1, At, B1); G8_BAR;
            G8_LDA(At, 1, 1); G8_STAGE(G8_SA(1, 0), a3, o2[0]);
            G8_BAR; G8_WAIT_L(0); G8_MMA(1, 0, At, B0); G8_BAR; G8_SCHED;
            G8_STAGE(G8_SB(1, 1), b3 + hstep, voffB);
            G8_WAIT_V(6); G8_BAR; G8_MMA(1, 1, At, B1); G8_BAR;
        }
        P.epi(acc, cur, wr, wc, fr, fq, lds);
        if (!has_next) break;
#pragma unroll
        for (int a = 0; a < 2; ++a)
#pragma unroll
            for (int b = 0; b < 2; ++b)
#pragma unroll
                for (int m = 0; m < 4; ++m)
#pragma unroll
                    for (int n = 0; n < 2; ++n) acc[a][b][m][n] = AccT{};
        cur = nxt; cB = nB; ++ui;
        vc[0][0] = vn[0][0]; vc[0][1] = vn[0][1]; vc[1][0] = vn[1][0]; vc[1][1] = vn[1][1];
    }
    G8_WAIT_V(0);
    if (wr == 0) G8_BAR;
    G8_BAR;
#undef G8_SA
#undef G8_SB
#undef G8_STAGE
#undef G8_LDA
#undef G8_LDB
#undef G8_MMA
#undef G8_WAIT_V
#undef G8_WAIT_L
#undef G8_BAR
#undef G8_SCHED
}

struct ProbInF {
    static constexpr unsigned ROWB = 4096; static constexpr bool I8 = false;
    static constexpr int NT = 32; static constexpr size_t KS2 = 256;
    static constexpr bool PERM = true;
    const _Float16* A; _Float16* C16; int G, c;
    __device__ __forceinline__ bool next(int i, Unit& u) const { const int L = i * G + c; if (L >= 64 * 5) return false;
        int pm, pn; tile_order(L, 64, 5, pm, pn); u.m0 = pm * 256; u.n0 = pn * 256; u.e = 0; u.cnt = 256; u.rbase = 0; return true; }
    __device__ __forceinline__ void a_offs(const Unit& u, const int (&R)[2], const int (&C2)[2], unsigned (&v)[2][2]) const {
#pragma unroll
        for (int h = 0; h < 2; ++h)
#pragma unroll
            for (int i = 0; i < 2; ++i) v[h][i] = (unsigned)(u.m0 + h * 128 + R[i]) * (unsigned)(KK * 2) + (unsigned)C2[i]; }
    __device__ __forceinline__ const char* a_base() const { return (const char*)A; }
    __device__ __forceinline__ const char* b_base(const Unit& u) const { return (const char*)A + (long long)(WS_WTIN - WS_X16) + (size_t)u.n0 * KK * 2; }
    __device__ __forceinline__ void epi(const f32x4 (&acc)[2][2][4][2], const Unit& u, int wr, int wc, int fr, int fq, LAS unsigned char* lds) const {
        LAS unsigned char* ep = lds + EP_OFF + wr * EP_GRP;
        const int tg = ep_tid() & 255, rrow = tg >> 4, ch = tg & 15;
        const int kvseg = (u.e == 0 && u.n0 >= 1024 && u.n0 < 2560) ? ((u.n0 - 1024) >> 8) : -1;
        _Float16* const Cb = (_Float16*)((char*)C16 + (u.e ? (long long)(WS_KVMEM16 - WS_PROJ16) : 0ll)); const int ldc = u.e ? 1024 : INW, nlim = u.e ? 1024 : INW, mb = u.e ? u.m0 - T_ : u.m0;
#pragma unroll
        for (int ai = 0; ai < 2; ++ai)
#pragma unroll
            for (int m = 0; m < 4; ++m) {
#pragma unroll
                for (int bj = 0; bj < 2; ++bj) *(LAS h8*)(ep + fr * EP_LD + (bj * 128 + wc * 32 + fq * 8) * 2) = cvt8(acc[ai][bj][m][0], acc[ai][bj][m][1]);
                ep_sync();
                const h8 x0 = *(const LAS h8*)(ep + rrow * EP_LD + ch * 32), x1 = *(const LAS h8*)(ep + rrow * EP_LD + ch * 32 + 16);
                const int grow = mb + ai * 128 + wr * 64 + m * 16 + rrow, gcol = u.n0 + ch * 16;
                if (kvseg >= 0) {
                    _Float16* dst = (_Float16*)((char*)C16 + (long long)(WS_KV16 - WS_PROJ16)) + ((size_t)(kvseg * B_ + (grow >> 11)) * 2 + (ch >> 3)) * KVSEG + (size_t)(grow & (S_ - 1)) * 128 + (ch & 7) * 16;
                    *(h8*)dst = x0; *(h8*)(dst + 8) = x1;
                } else {
                    if (gcol < nlim) *(h8*)(Cb + (size_t)grow * ldc + gcol) = x0;
                    if (gcol + 8 < nlim) *(h8*)(Cb + (size_t)grow * ldc + gcol + 8) = x1; }
                ep_sync();
            } }
};
struct ProbIn8 {
    static constexpr unsigned ROWB = 2048; static constexpr bool I8 = true;
    static constexpr int NT = 16; static constexpr size_t KS2 = 256;
    static constexpr bool PERM = true;
    const signed char* A; _Float16* C16; const float* sa; int G, c;
    __device__ __forceinline__ bool next(int i, Unit& u) const { const int L = i * G + c; if (L >= 640 + 32) return false;
        if (L < 640) { int pm, pn; tile_order(L, 64, 10, pm, pn); u.m0 = pm * 256; u.n0 = 1280 + pn * 256; u.e = 0; }
        else { const int v = L - 640; u.m0 = T_ + (v & 7) * 256; u.n0 = (v >> 3) * 256; u.e = 1; }
        u.cnt = 256; u.rbase = 0; return true; }
    __device__ __forceinline__ void a_offs(const Unit& u, const int (&R)[2], const int (&C2)[2], unsigned (&v)[2][2]) const {
#pragma unroll
        for (int h = 0; h < 2; ++h)
#pragma unroll
            for (int i = 0; i < 2; ++i) v[h][i] = (unsigned)(u.m0 + h * 128 + R[i]) * 2048u + (unsigned)C2[i]; }
    __device__ __forceinline__ const char* a_base() const { return (const char*)A; }
    __device__ __forceinline__ const char* b_base(const Unit& u) const { return (const char*)A + (u.e ? (long long)(WS_Q8MKV - WS_X8) + (long long)u.n0 * 2048 : (long long)(WS_Q8IN - WS_X8) + (long long)(u.n0 - 1280) * 2048); }
    __device__ __forceinline__ void epi(const i32x4 (&acc)[2][2][4][2], const Unit& u, int wr, int wc, int fr, int fq, LAS unsigned char* lds) const {
        LAS unsigned char* ep = lds + EP_OFF + wr * EP_GRP;
        const int tg = ep_tid() & 255, rrow = tg >> 4, ch = tg & 15;
        const int kvseg = (u.e == 0 && u.n0 >= 1024 && u.n0 < 2560) ? ((u.n0 - 1024) >> 8) : -1;
        _Float16* const Cb = (_Float16*)((char*)C16 + (u.e ? (long long)(WS_KVMEM16 - WS_PROJ16) : 0ll)); const int ldc = u.e ? 1024 : INW, nlim = u.e ? 1024 : INW, mb = u.e ? u.m0 - T_ : u.m0;
        const float* sw = (const float*)((const char*)A + (u.e ? (long long)(WS_SMKV - WS_X8) : (long long)(WS_SIN8 - WS_X8))) + (u.e ? u.n0 : u.n0 - 1280);
        f32x4 s0[2], s1[2]; float srv[8];
#pragma unroll
        for (int bj = 0; bj < 2; ++bj) { const int col = bj * 128 + wc * 32 + fq * 8; s0[bj] = *(const f32x4*)(sw + col); s1[bj] = *(const f32x4*)(sw + col + 4); }
#pragma unroll
        for (int q = 0; q < 8; ++q) srv[q] = sa[u.m0 + (q >> 2) * 128 + wr * 64 + (q & 3) * 16 + fr];
#pragma unroll
        for (int ai = 0; ai < 2; ++ai)
#pragma unroll
            for (int m = 0; m < 4; ++m) { const float sr = srv[ai * 4 + m];
#pragma unroll
                for (int bj = 0; bj < 2; ++bj) { const i32x4 i0 = acc[ai][bj][m][0], i1 = acc[ai][bj][m][1];
                    *(LAS h8*)(ep + fr * EP_LD + (bj * 128 + wc * 32 + fq * 8) * 2) = cvt8((f32x4){(float)i0[0], (float)i0[1], (float)i0[2], (float)i0[3]} * (s0[bj] * sr), (f32x4){(float)i1[0], (float)i1[1], (float)i1[2], (float)i1[3]} * (s1[bj] * sr)); }
                ep_sync();
                const h8 x0 = *(const LAS h8*)(ep + rrow * EP_LD + ch * 32), x1 = *(const LAS h8*)(ep + rrow * EP_LD + ch * 32 + 16);
                const int grow = mb + ai * 128 + wr * 64 + m * 16 + rrow, gcol = u.n0 + ch * 16;
                if (kvseg >= 0) {
                    _Float16* dst = (_Float16*)((char*)C16 + (long long)(WS_KV16 - WS_PROJ16)) + ((size_t)(kvseg * B_ + (grow >> 11)) * 2 + (ch >> 3)) * KVSEG + (size_t)(grow & (S_ - 1)) * 128 + (ch & 7) * 16;
                    *(h8*)dst = x0; *(h8*)(dst + 8) = x1;
                } else {
                    if (gcol < nlim) *(h8*)(Cb + (size_t)grow * ldc + gcol) = x0;
                    if (gcol + 8 < nlim) *(h8*)(Cb + (size_t)grow * ldc + gcol + 8) = x1; }
                ep_sync();
            } }
};
struct ProbOut {
    static constexpr unsigned ROWB = 2048; static constexpr bool I8 = true;
    static constexpr int NT = 16; static constexpr size_t KS2 = 256;
    static constexpr bool PERM = true;
    const signed char* A; const signed char* Bt; _Float16* C; const _Float16* X; const float* sa; const float* sw; int G, c;
    __device__ __forceinline__ bool next(int i, Unit& u) const { const int L = i * G + c; if (L >= 64 * 8) return false; int pm, pn; tile_order(L, 64, 8, pm, pn); u.m0 = pm * 256; u.n0 = pn * 256; u.e = 0; u.cnt = 256; u.rbase = 0; return true; }
    __device__ __forceinline__ void a_offs(const Unit& u, const int (&R)[2], const int (&C2)[2], unsigned (&v)[2][2]) const {
#pragma unroll
        for (int h = 0; h < 2; ++h)
#pragma unroll
            for (int i = 0; i < 2; ++i) v[h][i] = (unsigned)(u.m0 + h * 128 + R[i]) * 2048u + (unsigned)C2[i]; }
    __device__ __forceinline__ const char* a_base() const { return (const char*)A; }
    __device__ __forceinline__ const char* b_base(const Unit& u) const { return (const char*)(Bt + (size_t)u.n0 * 2048); }
    __device__ __forceinline__ void epi(const i32x4 (&acc)[2][2][4][2], const Unit& u, int wr, int wc, int fr, int fq, LAS unsigned char* lds) const {
        LAS unsigned char* ep = lds + EP_OFF + wr * EP_GRP;
        const int tg = ep_tid() & 255, rrow = tg >> 4, ch = tg & 15;
        f32x4 s0[2], s1[2]; float srv[8];
#pragma unroll
        for (int bj = 0; bj < 2; ++bj) { const int col = u.n0 + bj * 128 + wc * 32 + fq * 8; s0[bj] = *(const f32x4*)(sw + col); s1[bj] = *(const f32x4*)(sw + col + 4); }
#pragma unroll
        for (int q = 0; q < 8; ++q) srv[q] = sa[u.m0 + (q >> 2) * 128 + wr * 64 + (q & 3) * 16 + fr];
#pragma unroll
        for (int ai = 0; ai < 2; ++ai)
#pragma unroll
            for (int m = 0; m < 4; ++m) { const float sr = srv[ai * 4 + m];
#pragma unroll
                for (int bj = 0; bj < 2; ++bj) { const i32x4 i0 = acc[ai][bj][m][0], i1 = acc[ai][bj][m][1];
                    *(LAS h8*)(ep + fr * EP_LD + (bj * 128 + wc * 32 + fq * 8) * 2) = cvt8((f32x4){(float)i0[0], (float)i0[1], (float)i0[2], (float)i0[3]} * (s0[bj] * sr), (f32x4){(float)i1[0], (float)i1[1], (float)i1[2], (float)i1[3]} * (s1[bj] * sr)); }
                const size_t go = (size_t)(u.m0 + ai * 128 + wr * 64 + m * 16 + rrow) * 2048 + u.n0 + ch * 16;
                const h8 r0 = *(const h8*)(X + go), r1 = *(const h8*)(X + go + 8);
                ep_sync();
                const h8 x0 = *(const LAS h8*)(ep + rrow * EP_LD + ch * 32), x1 = *(const LAS h8*)(ep + rrow * EP_LD + ch * 32 + 16);
                h8 o0, o1;
#pragma unroll
                for (int q = 0; q < 8; ++q) { o0[q] = (_Float16)(DN_ALPHA * (float)r0[q] + (float)x0[q]); o1[q] = (_Float16)(DN_ALPHA * (float)r1[q] + (float)x1[q]); }
                *(h8*)(C + go) = o0; *(h8*)(C + go + 8) = o1;
                ep_sync();
            } }
};
struct ProbCmp {
    static constexpr unsigned ROWB = 4096; static constexpr bool I8 = false;
    static constexpr int NT = 8; static constexpr size_t KS2 = 256;
    static constexpr bool PERM = false;
    const _Float16* A; const _Float16* Bt; float* C; int G, c;
    __device__ __forceinline__ bool next(int i, Unit& u) const { const int L = i * G + c; if (L >= 128) return false;
        u.e = L >> 6; const int r = L & 63; u.rbase = r & 3; u.n0 = ((r >> 2) & 1) * 256; u.m0 = (r >> 3) * 256; u.cnt = 256; return true; }
    __device__ __forceinline__ void a_offs(const Unit& u, const int (&R)[2], const int (&C2)[2], unsigned (&v)[2][2]) const {
#pragma unroll
        for (int h = 0; h < 2; ++h)
#pragma unroll
            for (int i = 0; i < 2; ++i) { const int row = u.m0 + h * 128 + R[i], kvh = row & 1, bj = row >> 1, b = bj >> 7, j = bj & 127;
                v[h][i] = (unsigned)((((u.e * B_ + b) * 2 + kvh) * S_ + 16 * j + 4 * u.rbase) * 128) * 2u + (unsigned)C2[i]; } }
    __device__ __forceinline__ const char* a_base() const { return (const char*)A; }
    __device__ __forceinline__ const char* b_base(const Unit& u) const { return (const char*)(Bt + ((size_t)u.e * 512 + u.n0) * KK + u.rbase * 512); }
    __device__ __forceinline__ void epi(const f32x4 (&acc)[2][2][4][2], const Unit& u, int wr, int wc, int fr, int fq, LAS unsigned char*) const {
        float* base = C + ((size_t)(u.e * 4 + u.rbase) * 2048) * 512;
#pragma unroll
        for (int ai = 0; ai < 2; ++ai)
#pragma unroll
            for (int m = 0; m < 4; ++m) { const int row = u.m0 + ai * 128 + wr * 64 + m * 16 + fr;
#pragma unroll
                for (int bj = 0; bj < 2; ++bj)
#pragma unroll
                    for (int n = 0; n < 2; ++n) { const int col = u.n0 + bj * 128 + wc * 32 + n * 16 + fq * 4;
                        *(f32x4*)(base + (size_t)row * 512 + col) = acc[ai][bj][m][n]; } } }
};
struct MoeTab { const LAS int* t; int NT;
    __device__ __forceinline__ bool find_i(int i, Unit& u) const {
        const LAS int* q = t + 128 + 8 * i;
        if (__builtin_amdgcn_readfirstlane(q[5]) == 0) return false;
        u.e = __builtin_amdgcn_readfirstlane(q[0]); u.m0 = __builtin_amdgcn_readfirstlane(q[1]); u.n0 = __builtin_amdgcn_readfirstlane(q[2]); u.cnt = __builtin_amdgcn_readfirstlane(q[3]); u.rbase = __builtin_amdgcn_readfirstlane(q[4]); return true; } };
__device__ __forceinline__ void moe_build(LAS int* t, int G, int vcu) {
    const int i = threadIdx.x;
    if (i < 40) { const int L = i * G + vcu; LAS int* q = t + 128 + 8 * i;
        if (L >= t[98]) q[5] = 0;
        else { int e = 0; for (; e < NE - 1; ++e) { if (L < t[32 + e + 1]) break; }
            const int ub = t[32 + e], cn = t[e], rs = t[65 + e]; const int nm = (cn + 255) >> 8, v = L - ub, mt = v % nm, ntile = v / nm;
            q[0] = e; q[1] = mt * 256; q[2] = ntile * 256; q[3] = min(256, cn - mt * 256); q[4] = rs; q[5] = 1; } }
}
struct ProbGu {
    static constexpr int NT = 16; static constexpr size_t KS2 = 256; static constexpr unsigned ROWB = 2048; static constexpr bool I8 = true;
    static constexpr bool PERM = true;
    const signed char* A; const signed char* Bt; unsigned char* act; const float* bgu; const int* list; const float* sa; const float* sw; MoeTab tab; int G, vcu;
    __device__ __forceinline__ bool next(int i, Unit& u) const { return tab.find_i(i, u); }
    __device__ __forceinline__ void a_offs(const Unit& u, const int (&R)[2], const int (&C2)[2], unsigned (&v)[2][2]) const {
#pragma unroll
        for (int h = 0; h < 2; ++h)
#pragma unroll
            for (int i = 0; i < 2; ++i) { int r = h * 128 + R[i]; r = r < u.cnt ? r : 0; const int a = list[(size_t)u.e * T_ + u.m0 + r]; v[h][i] = (unsigned)(a >> 2) * 2048u + (unsigned)C2[i]; } }
    __device__ __forceinline__ const char* a_base() const { return (const char*)A; }
    __device__ __forceinline__ const char* b_base(const Unit& u) const { return (const char*)(Bt + ((size_t)u.e * 4096 + u.n0) * 2048); }
    __device__ __forceinline__ void epi(const i32x4 (&acc)[2][2][4][2], const Unit& u, int wr, int wc, int fr, int fq, LAS unsigned char* lds) const {
        const float* bb = bgu + (size_t)u.e * 4096; const float* ss = sw + (size_t)u.e * 4096;
        LAS unsigned char* ep = lds + EP_OFF + wr * EP_GRP;
        const int tg = ep_tid() & 255, rrow = tg >> 4, ch = tg & 15;
        f32x4 b0[2], b1[2], s0[2], s1[2];
#pragma unroll
        for (int bj = 0; bj < 2; ++bj) { const int col = u.n0 + bj * 128 + wc * 32 + fq * 8;
            b0[bj] = *(const f32x4*)(bb + col); b1[bj] = *(const f32x4*)(bb + col + 4); s0[bj] = *(const f32x4*)(ss + col); s1[bj] = *(const f32x4*)(ss + col + 4); }
        float srv[8];
#pragma unroll
        for (int q = 0; q < 8; ++q) { const int rl = (q >> 2) * 128 + wr * 64 + (q & 3) * 16 + fr; srv[q] = sa[(size_t)u.e * T_ + u.m0 + (rl < u.cnt ? rl : 0)]; }
        LAS unsigned char* ep2 = lds + EP_OFF + wr * (2 * 4608);
#define GU_WRITE(st) do { const int ai_ = (st) >> 1, mp_ = (st) & 1; LAS unsigned char* eb = ep2 + ((st) & 1) * 4608; \
            _Pragma("unroll") for (int mm = 0; mm < 2; ++mm) { const int m_ = mp_ * 2 + mm; const float sr = srv[ai_ * 4 + m_]; \
                _Pragma("unroll") for (int bj = 0; bj < 2; ++bj) { const i32x4 i0 = acc[ai_][bj][m_][0], i1 = acc[ai_][bj][m_][1]; \
                    const f32x4 v0 = (f32x4){(float)i0[0], (float)i0[1], (float)i0[2], (float)i0[3]} * (s0[bj] * sr) + b0[bj], v1 = (f32x4){(float)i1[0], (float)i1[1], (float)i1[2], (float)i1[3]} * (s1[bj] * sr) + b1[bj]; \
                    *(LAS unsigned*)(eb + (mm * 16 + fr) * 144 + (bj * 64 + wc * 16 + fq * 4)) = pk4_fp8(swiglu_fast(v0[0], v0[1]), swiglu_fast(v0[2], v0[3]), swiglu_fast(v1[0], v1[1]), swiglu_fast(v1[2], v1[3])); } } } while (0)
        GU_WRITE(0);
        ep_sync();
#pragma unroll
        for (int st = 0; st < 4; ++st) {
            if (st + 1 < 4) GU_WRITE(st + 1);
#pragma unroll
            for (int mm = 0; mm < 2; ++mm) { const u32x2 x0 = *(const LAS u32x2*)(ep2 + (st & 1) * 4608 + (mm * 16 + rrow) * 144 + ch * 8);
                const int rr = (st >> 1) * 128 + wr * 64 + ((st & 1) * 2 + mm) * 16 + rrow;
                if (rr < u.cnt) *(u32x2*)(act + (size_t)(u.rbase + u.m0 + rr) * 2048 + (u.n0 >> 1) + ch * 8) = x0; }
            ep_sync();
        }
#undef GU_WRITE
    }
};
struct ProbDn {
    static constexpr int NT = 16; static constexpr size_t KS2 = 256; static constexpr unsigned ROWB = 2048; static constexpr bool I8 = true;
    static constexpr bool PERM = true;
    const signed char* A; const signed char* Bt; unsigned char* y; const float* bdn; const int* list; const float* gate; const float* sa; const float* sw; MoeTab tab; int G, vcu;
    __device__ __forceinline__ bool next(int i, Unit& u) const { return tab.find_i(i, u); }
    __device__ __forceinline__ void a_offs(const Unit& u, const int (&R)[2], const int (&C2)[2], unsigned (&v)[2][2]) const {
#pragma unroll
        for (int h = 0; h < 2; ++h)
#pragma unroll
            for (int i = 0; i < 2; ++i) v[h][i] = (unsigned)(u.rbase + u.m0 + h * 128 + R[i]) * 2048u + (unsigned)C2[i]; }
    __device__ __forceinline__ const char* a_base() const { return (const char*)A; }
    __device__ __forceinline__ const char* b_base(const Unit& u) const { return (const char*)(Bt + ((size_t)u.e * 2048 + u.n0) * 2048); }
    __device__ __forceinline__ void epi(const i32x4 (&acc)[2][2][4][2], const Unit& u, int wr, int wc, int fr, int fq, LAS unsigned char* lds) const {
        const float* bb = bdn + (size_t)u.e * 2048; const float* ss = sw + (size_t)u.e * 2048;
        LAS unsigned char* ep = lds + EP_OFF + wr * (2 * 4352);
        const int tg = ep_tid() & 255, rrow = tg >> 4, ch = tg & 15;
        f32x4 b0[2], b1[2], s0[2], s1[2];
#pragma unroll
        for (int bj = 0; bj < 2; ++bj) { const int col = u.n0 + bj * 128 + wc * 32 + fq * 8;
            b0[bj] = *(const f32x4*)(bb + col); b1[bj] = *(const f32x4*)(bb + col + 4); s0[bj] = *(const f32x4*)(ss + col); s1[bj] = *(const f32x4*)(ss + col + 4); }
        float gv[8], srv[8]; int a2v[8];
        { int av[8];
#pragma unroll
          for (int q = 0; q < 8; ++q) { const int rl = (q >> 2) * 128 + wr * 64 + (q & 3) * 16 + fr, rc = rl < u.cnt ? rl : 0; av[q] = 0; gv[q] = gate[(size_t)u.e * T_ + u.m0 + rc]; srv[q] = sa[u.rbase + u.m0 + rc];
              const int rr = (q >> 2) * 128 + wr * 64 + (q & 3) * 16 + rrow; a2v[q] = list[(size_t)u.e * T_ + u.m0 + (rr < u.cnt ? rr : 0)]; }
          (void)av; }
#define DN_WRITE(st) do { const int ai_ = (st) >> 2, m_ = (st) & 3; const float g = gv[st] * 16.f, sr = srv[st]; LAS unsigned char* eb = ep + ((st) & 1) * 4352; \
            _Pragma("unroll") for (int bj = 0; bj < 2; ++bj) { const i32x4 i0 = acc[ai_][bj][m_][0], i1 = acc[ai_][bj][m_][1]; \
                const f32x4 v0 = ((f32x4){(float)i0[0], (float)i0[1], (float)i0[2], (float)i0[3]} * (s0[bj] * sr) + b0[bj]) * g, v1 = ((f32x4){(float)i1[0], (float)i1[1], (float)i1[2], (float)i1[3]} * (s1[bj] * sr) + b1[bj]) * g; \
                u32x2 o; o[0] = pk4_fp8(__builtin_amdgcn_fmed3f(v0[0], -440.f, 440.f), __builtin_amdgcn_fmed3f(v0[1], -440.f, 440.f), __builtin_amdgcn_fmed3f(v0[2], -440.f, 440.f), __builtin_amdgcn_fmed3f(v0[3], -440.f, 440.f)); o[1] = pk4_fp8(__builtin_amdgcn_fmed3f(v1[0], -440.f, 440.f), __builtin_amdgcn_fmed3f(v1[1], -440.f, 440.f), __builtin_amdgcn_fmed3f(v1[2], -440.f, 440.f), __builtin_amdgcn_fmed3f(v1[3], -440.f, 440.f)); \
                *(LAS u32x2*)(eb + fr * 272 + (bj * 128 + wc * 32 + fq * 8)) = o; } } while (0)
        DN_WRITE(0);
        ep_sync();
#pragma unroll
        for (int st = 0; st < 8; ++st) {
            if (st + 1 < 8) DN_WRITE(st + 1);
            const int rr = (st >> 2) * 128 + wr * 64 + (st & 3) * 16 + rrow;
            const u32x4 x0 = *(const LAS u32x4*)(ep + (st & 1) * 4352 + rrow * 272 + ch * 16);
            if (rr < u.cnt) *(u32x4*)(y + (size_t)a2v[st] * 2048 + u.n0 + ch * 16) = x0;
            ep_sync();
        }
#undef DN_WRITE
    }
};
}

namespace at8 {
typedef float f32x16 __attribute__((ext_vector_type(16)));
typedef short s16x4 __attribute__((ext_vector_type(4)));
typedef unsigned u32x4 __attribute__((ext_vector_type(4)));
constexpr int SHM_K = 64 * 128 * 2, SHM_V = 64 * 128 * 2, SLOT = SHM_K + SHM_V;
constexpr int NSLOT = 4;
constexpr int LDS_WS = NSLOT * SLOT;
constexpr int LDS_END = LDS_WS + 8 * 64 * 4;
constexpr float CEXP = ATT_SCALE * 1.4426950408889634f;
constexpr float THR_RAW = 8.f / ATT_SCALE;
#define AT_KSWZ(row, colB) ((row) * 256 + ((colB) ^ (((row) & 7) << 4)))
#define AT_SBAR() __builtin_amdgcn_sched_barrier(0)
__device__ __forceinline__ int crow(int r, int hi) { return (r & 3) + 8 * (r >> 2) + 4 * hi; }
__device__ __forceinline__ unsigned cvtpk(float lo, float hi) { auto v = __builtin_amdgcn_cvt_pkrtz(lo, hi); return *reinterpret_cast<unsigned*>(&v); }
__device__ __forceinline__ int v_st(int k, int c) { const int kk = (k & ~0xC) | ((k & 4) << 1) | ((k & 8) >> 1); return ((kk >> 3) * 4 + (c >> 5)) * 512 + ((kk & 7) * 32 + (c & 31)) * 2; }
__device__ __forceinline__ int v_rd_base(int lane) { return ((lane & 3) << 3) | (((lane >> 2) & 3) << 6) | (((lane >> 4) & 1) << 5) | (((lane >> 5) & 1) << 8); }
constexpr int v_rd_off(int d0, int ks, int half) { return d0 * 512 + ks * 4096 + half * 2048; }
template <int OFF> __device__ __forceinline__ s16x4 tr_read(int vb) { s16x4 r; asm volatile("ds_read_b64_tr_b16 %0, %1 offset:%2" : "=&v"(r) : "v"(vb), "i"(OFF) : "memory"); return r; }
__device__ __forceinline__ h8 mk8(s16x4 l, s16x4 h) { typedef short s16x8 __attribute__((ext_vector_type(8))); s16x8 w = {l[0], l[1], l[2], l[3], h[0], h[1], h[2], h[3]}; return *reinterpret_cast<h8*>(&w); }
template <int D0> __device__ __forceinline__ void pv_one(f32x16& od, int vb, h8 pa0, h8 pa1, h8 pa2, h8 pa3) {
    const s16x4 l0 = tr_read<v_rd_off(D0, 0, 0)>(vb), h0 = tr_read<v_rd_off(D0, 0, 1)>(vb), l1 = tr_read<v_rd_off(D0, 1, 0)>(vb), h1 = tr_read<v_rd_off(D0, 1, 1)>(vb);
    const s16x4 l2 = tr_read<v_rd_off(D0, 2, 0)>(vb), h2 = tr_read<v_rd_off(D0, 2, 1)>(vb), l3 = tr_read<v_rd_off(D0, 3, 0)>(vb), h3 = tr_read<v_rd_off(D0, 3, 1)>(vb);
    asm volatile("s_waitcnt lgkmcnt(0)" ::: "memory"); AT_SBAR();
    od = __builtin_amdgcn_mfma_f32_32x32x16_f16(pa0, mk8(l0, h0), od, 0, 0, 0);
    od = __builtin_amdgcn_mfma_f32_32x32x16_f16(pa1, mk8(l1, h1), od, 0, 0, 0);
    od = __builtin_amdgcn_mfma_f32_32x32x16_f16(pa2, mk8(l2, h2), od, 0, 0, 0);
    od = __builtin_amdgcn_mfma_f32_32x32x16_f16(pa3, mk8(l3, h3), od, 0, 0, 0);
}
__device__ __forceinline__ void pv_d0(f32x16 (&o)[4], int vb, h8 pa0, h8 pa1, h8 pa2, h8 pa3) {
    pv_one<0>(o[0], vb, pa0, pa1, pa2, pa3); pv_one<1>(o[1], vb, pa0, pa1, pa2, pa3); pv_one<2>(o[2], vb, pa0, pa1, pa2, pa3); pv_one<3>(o[3], vb, pa0, pa1, pa2, pa3);
}
__device__ __forceinline__ void qkt(f32x16& p0, f32x16& p1, const char* Ks, const h8 (&qr)[8], int r32, int hi) {
    p0 = f32x16{}; p1 = f32x16{};
#pragma unroll
    for (int d0 = 0; d0 < 8; ++d0) { const int cb = (d0 * 16 + hi * 8) * 2;
        const h8 b0 = *reinterpret_cast<const h8*>(Ks + AT_KSWZ(r32, cb));
        const h8 b1 = *reinterpret_cast<const h8*>(Ks + AT_KSWZ(32 + r32, cb));
        p0 = __builtin_amdgcn_mfma_f32_32x32x16_f16(b0, qr[d0], p0, 0, 0, 0);
        p1 = __builtin_amdgcn_mfma_f32_32x32x16_f16(b1, qr[d0], p1, 0, 0, 0); }
}
__device__ __forceinline__ void pack_p(const f32x16& p0, const f32x16& p1, h8& pa0, h8& pa1, h8& pa2, h8& pa3) {
#define AT_PK4(P, BASE, OUT) do { unsigned a0 = cvtpk(P[BASE + 0], P[BASE + 1]), a1 = cvtpk(P[BASE + 2], P[BASE + 3]); \
    unsigned b0 = cvtpk(P[BASE + 4], P[BASE + 5]), b1 = cvtpk(P[BASE + 6], P[BASE + 7]); \
    auto r0 = __builtin_amdgcn_permlane32_swap(a0, b0, false, false); auto r1 = __builtin_amdgcn_permlane32_swap(a1, b1, false, false); \
    u32x4 w = {r0[0], r1[0], r0[1], r1[1]}; OUT = *reinterpret_cast<h8*>(&w); } while (0)
    AT_PK4(p0, 0, pa0); AT_PK4(p0, 8, pa1); AT_PK4(p1, 0, pa2); AT_PK4(p1, 8, pa3);
#undef AT_PK4
}
__device__ __forceinline__ float half_swap_max(float v) { auto rr = __builtin_amdgcn_permlane32_swap(__float_as_uint(v), __float_as_uint(v), false, false); return fmaxf(__uint_as_float(rr[0]), __uint_as_float(rr[1])); }
__device__ __forceinline__ float half_swap_sum(float v) { auto rr = __builtin_amdgcn_permlane32_swap(__float_as_uint(v), __float_as_uint(v), false, false); return __uint_as_float(rr[0]) + __uint_as_float(rr[1]); }

__device__ __forceinline__ int hidden_tid() { int tz = threadIdx.x; asm volatile("" : "+v"(tz)); return tz; }
__device__ __forceinline__ void dma_offsets(int ld, int (&ko)[2], int (&vo)[2]) {
    const int tz = hidden_tid(), w = tz >> 6, l = tz & 63;
#pragma unroll
    for (int q = 0; q < 2; ++q) {
        const int rr = 4 * (2 * w + q) + (l >> 4), pp = l & 15;
        ko[q] = rr * ld + ((pp ^ (rr & 7)) * 8);
        const int L = (2 * w + q) * 1024 + l * 16, sidx = L >> 9, o = L & 511;
        const int kk = (sidx >> 2) * 8 + (o >> 6), c = (sidx & 3) * 32 + ((o & 63) >> 1);
        const int k = (kk & ~0xC) | ((kk & 4) << 1) | ((kk & 8) >> 1);
        vo[q] = k * ld + c;
    }
}
__device__ __forceinline__ void dma_tile(char* slot, const _Float16* Kb, const _Float16* Vb, int ld, int tile, const int (&ko)[2], const int (&vo)[2], int wid) {
    const _Float16* kt = Kb + (size_t)tile * 64 * ld; const _Float16* vt = Vb + (size_t)tile * 64 * ld;
#pragma unroll
    for (int q = 0; q < 2; ++q) __builtin_amdgcn_global_load_lds((const unsigned*)(kt + ko[q]), (LAS unsigned*)(slot + (2 * wid + q) * 1024), 16, 0, 0);
#pragma unroll
    for (int q = 0; q < 2; ++q) __builtin_amdgcn_global_load_lds((const unsigned*)(vt + vo[q]), (LAS unsigned*)(slot + SHM_K + (2 * wid + q) * 1024), 16, 0, 0);
}
#define AT_WAITV(n) asm volatile("s_waitcnt vmcnt(" #n ")" ::: "memory")
#define AT_BAR() do { asm volatile("s_waitcnt lgkmcnt(0)" ::: "memory"); __builtin_amdgcn_s_barrier(); asm volatile("" ::: "memory"); } while (0)

__device__ __forceinline__ void attn_unit(char* lds, const _Float16* qrow, const _Float16* Kb, const _Float16* Vb, int ld, unsigned tmask, int wlen, int khi, unsigned selmask,
                                          _Float16* outw, int ostride) {
    const int tid = threadIdx.x, wid = __builtin_amdgcn_readfirstlane(tid >> 6), lane = tid & 63, r32 = lane & 31, hi = lane >> 5;
    float* wsf = (float*)(lds + LDS_WS) + wid * 64; float* li_l = wsf; float* al_l = wsf + 32;
    float m_reg = -1e30f, l_reg = 0.f; f32x16 o[4] = {}; h8 qr[8];
#pragma unroll
    for (int d0 = 0; d0 < 8; ++d0) qr[d0] = *(const h8*)(qrow + d0 * 16);
    int ko[2], vo[2]; dma_offsets(ld, ko, vo);
    const int vbase = (int)(uintptr_t)lds + SHM_K + v_rd_base(lane);
    unsigned rest = tmask; int j = __ffs(rest) - 1; rest &= rest - 1;
    int j1 = rest ? (__ffs(rest) - 1) : -1; if (j1 >= 0) rest &= rest - 1;
    dma_tile(lds, Kb, Vb, ld, j, ko, vo, wid);
    if (j1 >= 0) { dma_tile(lds + SLOT, Kb, Vb, ld, j1, ko, vo, wid); AT_WAITV(4); } else { AT_WAITV(0); }
    AT_BAR();
    int so = 0, sp = 0;
    const bool roleB = wid >= 4;
    bool first = true;
    h8 pa0, pa1, pa2, pa3;
    for (;;) {
        const int j2 = rest ? (__ffs(rest) - 1) : -1;
        if (j2 >= 0) { rest &= rest - 1; int s2 = so + 2 * SLOT; s2 = s2 >= NSLOT * SLOT ? s2 - NSLOT * SLOT : s2; dma_tile(lds + s2, Kb, Vb, ld, j2, ko, vo, wid); }
        if (roleB && !first) { AT_SBAR(); pv_d0(o, vbase + sp, pa0, pa1, pa2, pa3); }
        f32x16 p0, p1;
        AT_SBAR(); qkt(p0, p1, lds + so, qr, r32, hi);
        { const int klo = wlen > 0 ? khi - wlen + 1 : 0; const bool tb = (selmask >> j) & 1u; const bool inr = (j * 64 >= klo) && (j * 64 + 63 <= khi);
          if (!__all(tb && inr)) {
              if (__all(inr)) {
#pragma unroll
                  for (int r = 0; r < 16; ++r) { p0[r] = tb ? p0[r] : -INFINITY; p1[r] = tb ? p1[r] : -INFINITY; }
              } else {
                  const int kb = j * 64 + 4 * hi;
#pragma unroll
                  for (int r = 0; r < 16; ++r) { const int k0 = kb + (r & 3) + 8 * (r >> 2);
                      p0[r] = (tb && k0 >= klo && k0 <= khi) ? p0[r] : -INFINITY;
                      p1[r] = (tb && (k0 + 32) >= klo && (k0 + 32) <= khi) ? p1[r] : -INFINITY; }
              } } }
        float pmax = p0[0];
#pragma unroll
        for (int r = 1; r < 16; ++r) pmax = fmaxf(pmax, p0[r]);
#pragma unroll
        for (int r = 0; r < 16; ++r) pmax = fmaxf(pmax, p1[r]);
        pmax = half_swap_max(pmax);
        float mn, alpha;
        if (__all(pmax - m_reg <= THR_RAW)) { mn = m_reg; alpha = 1.f; }
        else { mn = fmaxf(m_reg, pmax); alpha = __builtin_amdgcn_exp2f((m_reg - mn) * CEXP); m_reg = mn; }
        const float mnC = -mn * CEXP;
        float ps = 0.f;
#pragma unroll
        for (int r = 0; r < 16; ++r) { p0[r] = __builtin_amdgcn_exp2f(fmaf(p0[r], CEXP, mnC)); ps += p0[r]; }
#pragma unroll
        for (int r = 0; r < 16; ++r) { p1[r] = __builtin_amdgcn_exp2f(fmaf(p1[r], CEXP, mnC)); ps += p1[r]; }
        ps = half_swap_sum(ps);
        l_reg = l_reg * alpha + ps;
        if (__any(alpha < 1.f)) { if (hi == 0) al_l[r32] = alpha; asm volatile("s_waitcnt lgkmcnt(0)" ::: "memory");
#pragma unroll
            for (int r = 0; r < 16; ++r) { const float a = al_l[crow(r, hi)];
#pragma unroll
                for (int d = 0; d < 4; ++d) o[d][r] *= a; } }
        pack_p(p0, p1, pa0, pa1, pa2, pa3);
        AT_SBAR();
        if (!roleB) pv_d0(o, vbase + so, pa0, pa1, pa2, pa3);
        if (j1 < 0) break;
        if (j2 >= 0) { AT_WAITV(4); } else { AT_WAITV(0); }
        AT_BAR();
        j = j1; j1 = j2; sp = so; so += SLOT; so = so >= NSLOT * SLOT ? so - NSLOT * SLOT : so; first = false;
    }
    if (roleB) { AT_SBAR(); pv_d0(o, vbase + so, pa0, pa1, pa2, pa3); }
    if (hi == 0) li_l[r32] = l_reg; asm volatile("s_waitcnt lgkmcnt(0)" ::: "memory");
#pragma unroll
    for (int r = 0; r < 16; ++r) { const int orow = crow(r, hi); const float l = li_l[orow]; const float rl = l > 0.f ? 1.f / l : 0.f;
#pragma unroll
        for (int d0 = 0; d0 < 4; ++d0) outw[(size_t)orow * ostride + d0 * 32 + r32] = (_Float16)(o[d0][r] * rl); }
    __syncthreads();
}

constexpr int LDS_AP = 0, LDS_BP = LDS_AP + 4 * 64 * 33 * 4, LDS_SELM = LDS_END, LDS_CS_END = LDS_SELM + 64 * 4;
static_assert(LDS_BP + 4 * 64 * 33 * 4 <= NSLOT * SLOT, "importance partials must fit inside the ring");
__device__ __forceinline__ void cmp_slc_unit(char* lds, const _Float16* qrow, const _Float16* Kc, const _Float16* Vc, const _Float16* Ks, const _Float16* Vs, int t, int tl, int g, int qi,
                                             _Float16* outc, _Float16* outs) {
    const int tid = threadIdx.x, wid = __builtin_amdgcn_readfirstlane(tid >> 6), lane = tid & 63, r32 = lane & 31, hi = lane >> 5;
    float* AP = (float*)(lds + LDS_AP); float* BP = (float*)(lds + LDS_BP); unsigned* selm = (unsigned*)(lds + LDS_SELM);
    {
        h8 qr[8];
#pragma unroll
        for (int d0 = 0; d0 < 8; ++d0) qr[d0] = *(const h8*)(qrow + d0 * 16);
        const int vb0 = (int)(uintptr_t)lds + SHM_K + v_rd_base(lane);
        { int ko[2], vo[2]; dma_offsets(256, ko, vo);
          dma_tile(lds, Kc, Vc, 256, 0, ko, vo, wid); dma_tile(lds + SLOT, Kc, Vc, 256, 1, ko, vo, wid); }
        AT_WAITV(0); AT_BAR();
        f32x16 pA0, pA1, pB0, pB1;
        AT_SBAR(); qkt(pA0, pA1, lds, qr, r32, hi); qkt(pB0, pB1, lds + SLOT, qr, r32, hi);
        const int khi = t >= 31 ? ((t - 31) >> 4) : -1;
#pragma unroll
        for (int r = 0; r < 16; ++r) { const int c0 = 4 * hi + (r & 3) + 8 * (r >> 2);
            pA0[r] = (c0 <= khi) ? pA0[r] : -INFINITY; pA1[r] = (c0 + 32 <= khi) ? pA1[r] : -INFINITY;
            pB0[r] = (c0 + 64 <= khi) ? pB0[r] : -INFINITY; pB1[r] = (c0 + 96 <= khi) ? pB1[r] : -INFINITY; }
        float pmax = -INFINITY;
#pragma unroll
        for (int r = 0; r < 16; ++r) pmax = fmaxf(fmaxf(pmax, pA0[r]), fmaxf(pA1[r], fmaxf(pB0[r], pB1[r])));
        pmax = half_swap_max(pmax);
        const float mC = (pmax == -INFINITY) ? 0.f : -pmax * CEXP;
        float ps = 0.f;
#pragma unroll
        for (int r = 0; r < 16; ++r) { pA0[r] = __builtin_amdgcn_exp2f(fmaf(pA0[r], CEXP, mC)); pA1[r] = __builtin_amdgcn_exp2f(fmaf(pA1[r], CEXP, mC));
            pB0[r] = __builtin_amdgcn_exp2f(fmaf(pB0[r], CEXP, mC)); pB1[r] = __builtin_amdgcn_exp2f(fmaf(pB1[r], CEXP, mC)); ps += (pA0[r] + pA1[r]) + (pB0[r] + pB1[r]); }
        ps = half_swap_sum(ps);
        const float inv = ps > 0.f ? 1.f / ps : 0.f;
#pragma unroll
        for (int r = 0; r < 16; ++r) { pA0[r] *= inv; pA1[r] *= inv; pB0[r] *= inv; pB1[r] *= inv; }
        f32x16 o[4] = {};
        h8 pa0, pa1, pa2, pa3;
        pack_p(pA0, pA1, pa0, pa1, pa2, pa3); AT_SBAR(); pv_d0(o, vb0, pa0, pa1, pa2, pa3);
        pack_p(pB0, pB1, pa0, pa1, pa2, pa3); AT_SBAR(); pv_d0(o, vb0 + SLOT, pa0, pa1, pa2, pa3);
#pragma unroll
        for (int r = 0; r < 16; ++r) { const int orow = crow(r, hi);
#pragma unroll
            for (int d0 = 0; d0 < 4; ++d0) outc[(size_t)orow * 1024 + d0 * 32 + r32] = (_Float16)o[d0][r]; }
        __syncthreads();
        { float* ap = AP + (g * 64 + tl) * 33; float* bp = BP + (g * 64 + tl) * 33;
          if (hi == 0) bp[0] = 0.f;
#define AT_IMP(P, JB) do { _Pragma("unroll") for (int k = 0; k < 4; ++k) { const int j = (JB) + 2 * k + hi; \
              ap[j] = 2.f * (P[4 * k] + P[4 * k + 1] + P[4 * k + 2]) + P[4 * k + 3]; if (j + 1 < 32) bp[j + 1] = P[4 * k + 3]; } } while (0)
          AT_IMP(pA0, 0); AT_IMP(pA1, 8); AT_IMP(pB0, 16); AT_IMP(pB1, 24);
#undef AT_IMP
        }
    }
    __syncthreads();
#pragma unroll 1
    for (int it = 0; it < 4; ++it) {
        const int tk = 8 * wid + 2 * it + hi, j = r32;
        float imp = 0.f;
#pragma unroll
        for (int gg = 0; gg < 4; ++gg) imp += AP[(gg * 64 + tk) * 33 + j] + BP[(gg * 64 + tk) * 33 + j];
        const bool forced = (j == 0) || (j == qi) || (j == qi - 1), valid = j <= qi;
        const float iv = forced ? 1e9f : (valid ? imp : -1e9f);
        int rank = 0;
        for (int i = 0; i < 32; ++i) { const float vi = __shfl(iv, i + 32 * hi); rank += (vi > iv || (vi == iv && i < j)) ? 1 : 0; }
        const unsigned long long bal = __ballot(rank < 16 && valid);
        if (r32 == 0) selm[tk] = (unsigned)(bal >> (32 * hi));
    }
    __syncthreads();
    unsigned tm = selm[lane];
#pragma unroll
    for (int o = 32; o > 0; o >>= 1) tm |= __shfl_xor(tm, o);
    const int tz2 = hidden_tid();
    const unsigned mysel = selm[((tz2 >> 6) & 1) * 32 + (tz2 & 31)];
    attn_unit(lds, qrow, Ks, Vs, 128, tm, 0, t, mysel, outs, 1024);
}
}

struct CUnit { const float* W; int ldw; int nvalid; _Float16* Wt; int k0; int n0; };
__device__ __forceinline__ CUnit conv_desc(int u, const float* win, const float* w1k, const float* w1v, const float* wmkv, _Float16* wtin, _Float16* wt1, _Float16* wtmkv) {
    CUnit d;
    if (u < 160) { d.W = win; d.ldw = INW; d.nvalid = INW; d.Wt = wtin; d.k0 = (u / 5) * 64; d.n0 = (u % 5) * 256; }
    else if (u < 288) { const int v = u - 160, kv = v >> 6, part = (v >> 5) & 1, kt = v & 31;
        d.W = (kv ? w1v : w1k) + (size_t)part * 2048 * 256; d.ldw = 256; d.nvalid = 256; d.Wt = wt1 + ((size_t)kv * 512 + part * 256) * 2048; d.k0 = kt * 64; d.n0 = 0; }
    else { d.W = wmkv; d.ldw = 1024; d.nvalid = 1024; d.Wt = wtmkv; d.k0 = 0; d.n0 = 0; }
    return d;
}
__device__ __forceinline__ void conv_all(float* lds, const float* win, const float* w1k, const float* w1v, const float* wmkv, _Float16* wtin, _Float16* wt1, _Float16* wtmkv, int bid, int nb) {
    constexpr int NU = 160 + 128;
    const int tid = threadIdx.x;
    int u = bid; if (u >= NU) return;
    CUnit d = conv_desc(u, win, w1k, w1v, wmkv, wtin, wt1, wtmkv);
    float4 v[8];
#define CL(D) do { _Pragma("unroll") for (int i = 0; i < 8; ++i) { const int idx = tid + 512 * i, r = idx >> 6, c4 = (idx & 63) * 4; \
        v[i] = ((D).n0 + c4 < (D).nvalid) ? *(const float4*)((D).W + (size_t)((D).k0 + r) * (D).ldw + (D).n0 + c4) : make_float4(0.f, 0.f, 0.f, 0.f); } } while (0)
    CL(d);
    for (;;) {
#pragma unroll
        for (int i = 0; i < 8; ++i) { const int idx = tid + 512 * i, r = idx >> 6, c4 = (idx & 63) * 4; float* dd = lds + r * 257 + c4; dd[0] = v[i].x; dd[1] = v[i].y; dd[2] = v[i].z; dd[3] = v[i].w; }
        __syncthreads();
        const int un = u + nb; const bool has = un < NU;
        CUnit dn = d; if (has) { dn = conv_desc(un, win, w1k, w1v, wmkv, wtin, wt1, wtmkv); CL(dn); }
#pragma unroll
        for (int j = 0; j < 4; ++j) { const int id = tid + 512 * j, n = id >> 3, k8 = (id & 7) * 8; h8 o;
#pragma unroll
            for (int q = 0; q < 8; ++q) o[q] = (_Float16)lds[(k8 + q) * 257 + n];
            *(h8*)(d.Wt + (size_t)(d.n0 + n) * 2048 + d.k0 + k8) = o; }
        __syncthreads();
        if (!has) break;
        u = un; d = dn;
    }
#undef CL
}

__device__ __forceinline__ unsigned pack4_i8(float a, float b, float c, float d) {
    const int ia = __float2int_rn(a), ib = __float2int_rn(b), ic = __float2int_rn(c), id = __float2int_rn(d);
    return (unsigned)(ia & 255) | ((unsigned)(ib & 255) << 8) | ((unsigned)(ic & 255) << 16) | ((unsigned)(id & 255) << 24);
}
constexpr int QP_LD2 = 1026;
struct QUnit { const float* W; int ldw; int n0; signed char* Q; float* sc; int nvalid; };
struct QExtra { const float* win; signed char* q8in; float* sin8; const float* wmkv; signed char* q8mkv; float* smkv; };
__device__ __forceinline__ QUnit quant_desc(int u, const float* wgu, const float* wdn, signed char* q8gu, signed char* q8dn, float* sgu, float* sdn, const float* wout, signed char* q8out, float* sout, const QExtra& x) {
    QUnit d; d.nvalid = 1 << 30;
    if (u >= NE * 192 + 64 + 73) { const int pn = u - (NE * 192 + 64 + 73); d.W = x.wmkv; d.ldw = 1024; d.n0 = pn * 32; d.Q = x.q8mkv; d.sc = x.smkv; }
    else if (u >= NE * 192 + 64) { const int pn = u - (NE * 192 + 64); d.W = x.win; d.ldw = INW; d.n0 = 1280 + pn * 32; d.Q = x.q8in - (size_t)1280 * 2048; d.sc = x.sin8 - 1280; d.nvalid = INW; }
    else if (u >= NE * 192) { const int pn = u - NE * 192; d.W = wout; d.ldw = 2048; d.n0 = pn * 32; d.Q = q8out; d.sc = sout; }
    else if (u < NE * 128) { const int e = u >> 7, pn = u & 127; d.W = wgu + (size_t)e * 2048 * 4096; d.ldw = 4096; d.n0 = pn * 32; d.Q = q8gu + (size_t)e * 4096 * 2048; d.sc = sgu + (size_t)e * 4096; }
    else { const int v = u - NE * 128, e = v >> 6, pn = v & 63; d.W = wdn + (size_t)e * 2048 * 2048; d.ldw = 2048; d.n0 = pn * 32; d.Q = q8dn + (size_t)e * 2048 * 2048; d.sc = sdn + (size_t)e * 2048; }
    return d;
}
__device__ __forceinline__ unsigned pk2h(float a, float b) { auto v = __builtin_amdgcn_cvt_pkrtz(a, b); return *reinterpret_cast<unsigned*>(&v); }
__device__ __forceinline__ void quant_all(char* smem, const float* wgu, const float* wdn, signed char* q8gu, signed char* q8dn, float* sgu, float* sdn, const float* wout, signed char* q8out, float* sout, const QExtra& qx, int bid, int nb) {
    constexpr int NU = NE * 128 + NE * 64 + 64 + 73 + 32;
    unsigned* cmaxb = (unsigned*)smem;
    const int tid = threadIdx.x, c4 = (tid & 7) * 4, rg = tid >> 3;
    if (tid < 64) cmaxb[tid] = 0u;
    __syncthreads();
    int u = bid; if (u >= NU) return;
    QUnit d = quant_desc(u, wgu, wdn, q8gu, q8dn, sgu, sdn, wout, q8out, sout, qx);
    float4 va[16], vb[16], vc[16];
#define QL(dst, D, half) do { const float* p0 = (D).W + (size_t)((half) * 1024 + rg * 16) * (D).ldw + (D).n0 + c4; const bool okc = (D).n0 + c4 < (D).nvalid; _Pragma("unroll") for (int j = 0; j < 16; ++j) dst[j] = okc ? *(const float4*)(p0 + (size_t)j * (D).ldw) : make_float4(0.f, 0.f, 0.f, 0.f); } while (0)
#define QM(src) do { _Pragma("unroll") for (int j = 0; j < 16; ++j) { m0 = fmaxf(m0, fabsf(src[j].x)); m1 = fmaxf(m1, fabsf(src[j].y)); m2 = fmaxf(m2, fabsf(src[j].z)); m3 = fmaxf(m3, fabsf(src[j].w)); } } while (0)
#define QS(src, half, comp, ci, inv) do { uint4 o; \
        o.x = pack4_i8(src[0].comp * inv, src[1].comp * inv, src[2].comp * inv, src[3].comp * inv); o.y = pack4_i8(src[4].comp * inv, src[5].comp * inv, src[6].comp * inv, src[7].comp * inv); \
        o.z = pack4_i8(src[8].comp * inv, src[9].comp * inv, src[10].comp * inv, src[11].comp * inv); o.w = pack4_i8(src[12].comp * inv, src[13].comp * inv, src[14].comp * inv, src[15].comp * inv); \
        *(uint4*)(d.Q + (size_t)(d.n0 + c4 + (ci)) * 2048 + (half) * 1024 + rg * 16) = o; } while (0)
    QL(va, d, 0);
    int par = 0;
    for (;;) {
        unsigned* cmax = cmaxb + par * 32;
        float m0 = 0.f, m1 = 0.f, m2 = 0.f, m3 = 0.f;
        QL(vb, d, 1);
        QM(va); QM(vb);
        atomicMax(&cmax[c4 + 0], __float_as_uint(m0)); atomicMax(&cmax[c4 + 1], __float_as_uint(m1)); atomicMax(&cmax[c4 + 2], __float_as_uint(m2)); atomicMax(&cmax[c4 + 3], __float_as_uint(m3));
        __syncthreads();
        const int un = u + nb; const bool has = un < NU;
        QUnit dn = d; if (has) { dn = quant_desc(un, wgu, wdn, q8gu, q8dn, sgu, sdn, wout, q8out, sout, qx); QL(vc, dn, 0); }
        if (tid < 32) cmaxb[(par ^ 1) * 32 + tid] = 0u;
        const float x0 = __uint_as_float(cmax[c4 + 0]), x1 = __uint_as_float(cmax[c4 + 1]), x2 = __uint_as_float(cmax[c4 + 2]), x3 = __uint_as_float(cmax[c4 + 3]);
        const float i0 = x0 > 0.f ? 127.f / x0 : 0.f, i1 = x1 > 0.f ? 127.f / x1 : 0.f, i2 = x2 > 0.f ? 127.f / x2 : 0.f, i3 = x3 > 0.f ? 127.f / x3 : 0.f;
        QS(va, 0, x, 0, i0); QS(va, 0, y, 1, i1); QS(va, 0, z, 2, i2); QS(va, 0, w, 3, i3);
        QS(vb, 1, x, 0, i0); QS(vb, 1, y, 1, i1); QS(vb, 1, z, 2, i2); QS(vb, 1, w, 3, i3);
        if (tid < 32) { const float mx = __uint_as_float(cmax[tid]); d.sc[d.n0 + tid] = mx > 0.f ? mx / 127.f : 1.f; }
        if (!has) break;
#pragma unroll
        for (int j = 0; j < 16; ++j) va[j] = vc[j];
        u = un; d = dn; par ^= 1;
        __syncthreads();
    }
    __syncthreads();
#undef QL
#undef QM
#undef QS
}

__global__ void __launch_bounds__(512, 2) fwd(Params p) {
    extern __shared__ __attribute__((aligned(16))) char smem[];
    const int tid = threadIdx.x, wv = __builtin_amdgcn_readfirstlane(tid >> 6);
#define LANE_NOW ({ int _t = threadIdx.x; asm volatile("" : "+v"(_t)); _t & 63; })
    const int bid = blockIdx.x, nb = gridDim.x;
    const int gw = bid * 8 + wv, nw = nb * 8;
    const int lo = (int)(p.lo_hi & 0xffffffffll), hi = (int)(p.lo_hi >> 32);
    unsigned char* ws = p.ws;
    unsigned* ctl = (unsigned*)(ws + WS_CTL);
    int* cnt = (int*)(ws + CTL_CNT);
    float* proj = (float*)(ws + WS_PROJ);
    float* kvmem = (float*)(ws + WS_KVMEM);
    float* bias1 = (float*)(ws + WS_BIAS1);
    float* hid = (float*)(ws + WS_HID);
    float* kc = (float*)(ws + WS_KC);
    float* vc = (float*)(ws + WS_VC);
    float* pooled = (float*)(ws + WS_POOLED);
    _Float16* opool = (_Float16*)(ws + WS_OPOOL);
    _Float16* owin = (_Float16*)(ws + WS_OWIN);
    _Float16* ocmp = (_Float16*)(ws + WS_OCMP);
    _Float16* oslc = (_Float16*)(ws + WS_OSLC);
    unsigned* sel = (unsigned*)(ws + WS_SEL);
    _Float16* omem = (_Float16*)(ws + WS_OMEM);
    _Float16* cat16 = (_Float16*)(ws + WS_CAT16);
    _Float16* hpre16 = (_Float16*)(ws + WS_HPRE);
    float* hbuf = (float*)(ws + WS_H);
    float* gate = (float*)(ws + WS_GATE);
    int* list = (int*)(ws + WS_LIST);
    unsigned char* actf8 = (unsigned char*)(ws + WS_ACT16);
    unsigned char* yf8 = (unsigned char*)(ws + WS_Y16);
    _Float16* h16 = (_Float16*)(ws + WS_H16);
    _Float16* x16 = (_Float16*)(ws + WS_X16);
    _Float16* wtin = (_Float16*)(ws + WS_WTIN);
    _Float16* wtout = (_Float16*)(ws + WS_WTOUT);
    _Float16* wtgu = (_Float16*)(ws + WS_WTGU);
    _Float16* wtdn = (_Float16*)(ws + WS_WTDN);
    LAS unsigned char* lds = (LAS unsigned char*)smem;
    _Float16* proj16 = (_Float16*)(ws + WS_PROJ16);
    _Float16* kvmem16 = (_Float16*)(ws + WS_KVMEM16);
    _Float16* wt1 = (_Float16*)(ws + WS_WT1);
    float* uv = (float*)(ws + WS_UV);
    _Float16* kc16 = (_Float16*)(ws + WS_KC16);
    _Float16* vc16 = (_Float16*)(ws + WS_VC16);
    _Float16* wr16 = (_Float16*)(ws + WS_WR16);
    _Float16* mem16 = (_Float16*)(ws + WS_MEM16);
    _Float16* wtmkv = (_Float16*)(ws + WS_WTMKV);
    _Float16* kv16 = (_Float16*)(ws + WS_KV16);
    _Float16* wt2 = (_Float16*)(ws + WS_WT2);
    float* sa2 = (float*)(ws + WS_SA2); float* gate2 = (float*)(ws + WS_GATE2);
    signed char* x8 = (signed char*)(ws + WS_X8); float* sxa = (float*)(ws + WS_SXA); signed char* q8in = (signed char*)(ws + WS_Q8IN); float* sin8 = (float*)(ws + WS_SIN8);
    signed char* q8mkv = (signed char*)(ws + WS_Q8MKV); float* smkv = (float*)(ws + WS_SMKV);
    signed char* q8out = (signed char*)(ws + WS_Q8OUT); float* sout = (float*)(ws + WS_SOUT); signed char* cat8 = (signed char*)(ws + WS_CAT8); float* scat = (float*)(ws + WS_SCAT);
    signed char* q8gu = (signed char*)(ws + WS_Q8GU); signed char* q8dn = (signed char*)(ws + WS_Q8DN);
    float* sgu = (float*)(ws + WS_SGU); float* sdn = (float*)(ws + WS_SDN);
    signed char* h8q = (signed char*)(ws + WS_H8); float* sah = (float*)(ws + WS_SAH);
    signed char* act8 = (signed char*)(ws + WS_ACT8); float* sact = (float*)(ws + WS_SACT);
    const int vcu = (nb % 8 == 0) ? (bid % 8) * (nb / 8) + bid / 8 : bid;

    volatile LAS unsigned* xbw = (volatile LAS unsigned*)(smem + LDS_BYTES - 16);
    if (tid == 0) { xbw[0] = 0u; xbw[1] = 0u; xbw[2] = 0u; xbw[3] = 0u; }
    __syncthreads();
    XcdBarrier bar; bar.bar = ctl; bar.x = 0; bar.st = xbw;
    const bool multi = (hi - lo) > 1;
    if (multi) bar = xcd_barrier_post(ctl, xbw);
#define IN(k) (lo <= (k) && (k) < hi)
#define SEAM(k) do { if (IN(k) && IN((k) + 1)) xcd_barrier(bar); } while (0)
    float* sw = (float*)smem + wv * WLDS_FLOATS;
    int* segw = (int*)(sw + 4096 + 512);

    if (IN(0)) {
        const int lane = LANE_NOW; (void)lane;
        if (wv == 0 && (bid & 1) == 0 && (bid >> 1) < 128) {
            const int task = bid >> 1, kv = task >> 6, jg = (task >> 4) & 3, kc = task & 15;
            const float* pos = p.in[kv ? I_POSV : I_POSK] + kc * 256; const float* w1 = p.in[kv ? I_W1V : I_W1K] + (size_t)kc * 256 * 256 + jg * 64 + lane;
            float s0 = 0.f, s1 = 0.f, s2 = 0.f, s3 = 0.f;
            for (int k = 0; k < 256; k += 4) { s0 += pos[k] * w1[(size_t)k * 256]; s1 += pos[k + 1] * w1[(size_t)(k + 1) * 256]; s2 += pos[k + 2] * w1[(size_t)(k + 2) * 256]; s3 += pos[k + 3] * w1[(size_t)(k + 3) * 256]; }
            bias1[(kv * 16 + kc) * 256 + jg * 64 + lane] = (s0 + s1) + (s2 + s3);
        }
        for (int i = bid * 512 + tid; i < 2 * 128 * 256; i += nb * 512) { const int kv = i >> 15, d = (i >> 8) & 127, n = i & 255; wt2[i] = (_Float16)p.in[kv ? I_W2V : I_W2K][(size_t)n * 128 + d]; }
        for (int i = bid * 512 + tid; i < 32 * 2048; i += nb * 512) { const int e = i >> 11, d = i & 2047; wr16[i] = (_Float16)p.in[I_WR][(size_t)d * 32 + e]; }
        {
            for (int row0 = gw; row0 < T_ + 2048; row0 += nw * 2) {
                float4 raw[2][8];
#pragma unroll
                for (int i = 0; i < 2; ++i) { const int row = row0 + i * nw; const float* src = row < T_ ? p.in[I_X] + (size_t)row * 2048 : p.in[I_MEM] + (size_t)(row - T_) * 2048;
#pragma unroll
                    for (int c = 0; c < 4; ++c) { raw[i][2 * c] = make_float4(0.f, 0.f, 0.f, 0.f); raw[i][2 * c + 1] = raw[i][2 * c];
                        if (row < T_ + 2048) { raw[i][2 * c] = *(const float4*)(src + (lane + 64 * c) * 8); raw[i][2 * c + 1] = *(const float4*)(src + (lane + 64 * c) * 8 + 4); } } }
#pragma unroll
                for (int i = 0; i < 2; ++i) { const int row = row0 + i * nw;
                    float amax = 0.f;
#pragma unroll
                    for (int k = 0; k < 8; ++k) amax = fmaxf(amax, fmaxf(fmaxf(fabsf(raw[i][k].x), fabsf(raw[i][k].y)), fmaxf(fabsf(raw[i][k].z), fabsf(raw[i][k].w))));
                    amax = wave_max(amax);
                    if (row < T_ + 2048) {
                        const float qinv = amax > 0.f ? 127.f / amax : 0.f;
                        if (lane == 0) sxa[row] = amax > 0.f ? amax / 127.f : 1.f;
#pragma unroll
                        for (int c = 0; c < 4; ++c) { const float4 a = raw[i][2 * c], b2 = raw[i][2 * c + 1];
                            uint2 q; q.x = pack4_i8(a.x * qinv, a.y * qinv, a.z * qinv, a.w * qinv); q.y = pack4_i8(b2.x * qinv, b2.y * qinv, b2.z * qinv, b2.w * qinv);
                            *(uint2*)(x8 + (size_t)row * 2048 + (lane + 64 * c) * 8) = q;
                            if (row < T_) { h8 o; o[0] = (_Float16)a.x; o[1] = (_Float16)a.y; o[2] = (_Float16)a.z; o[3] = (_Float16)a.w; o[4] = (_Float16)b2.x; o[5] = (_Float16)b2.y; o[6] = (_Float16)b2.z; o[7] = (_Float16)b2.w;
                                *(h8*)(x16 + (size_t)row * 2048 + (lane + 64 * c) * 8) = o; } } }
                }
            }
        }
        {
            const QExtra qx{p.in[I_WIN], q8in, sin8, p.in[I_WMEMKV], q8mkv, smkv};
            quant_all(smem, p.in[I_WGU], p.in[I_WDN], q8gu, q8dn, sgu, sdn, p.in[I_WOUT], q8out, sout, qx, bid, nb);
            __syncthreads();
            conv_all((float*)smem, p.in[I_WIN], p.in[I_W1K], p.in[I_W1V], p.in[I_WMEMKV], wtin, wt1, wtmkv, bid, nb);
            __syncthreads();
        }
    }
    SEAM(0);
    if (IN(1)) {
        const int lane = LANE_NOW; (void)lane;
        { g8::ProbInF P{x16, proj16, nb, bid}; g8::gemm_phase(lds, P); }
        __syncthreads();
        { g8::ProbIn8 P{x8, proj16, sxa, nb, (bid + 192) & 255}; g8::gemm_phase(lds, P); }
    }
    SEAM(1);
    if (IN(2)) {
        const int lane = LANE_NOW; (void)lane;
        { g8::ProbCmp P{kv16, wt1, uv, nb, bid}; g8::gemm_phase(lds, P); __syncthreads(); }
        for (int i = bid * 512 + tid; i < T_ * 64; i += nb * 512) {
            const int chn = i & 63, row = i >> 6, t = row & (S_ - 1), g = chn >> 4;
            const int win = 2 << g, n = min(win, t + 1);
            const _Float16* src = proj16 + (size_t)row * INW + C_UP + chn * 8;
            float a[8];
            const h8 cur = *(const h8*)src;
            h8 vv[15];
#pragma unroll
            for (int k = 0; k < 15; ++k) { vv[k] = (h8){0, 0, 0, 0, 0, 0, 0, 0}; if (k + 1 < n) vv[k] = *(const h8*)(src - (size_t)(k + 1) * INW); }
#pragma unroll
            for (int q = 0; q < 8; ++q) a[q] = (float)cur[q];
#pragma unroll
            for (int k = 0; k < 15; ++k) {
#pragma unroll
                for (int q = 0; q < 8; ++q) a[q] += (float)vv[k][q]; }
            const float rn = 1.f / (float)n;
            float4 o0, o1;
            o0.x = a[0] * rn - (float)cur[0]; o0.y = a[1] * rn - (float)cur[1]; o0.z = a[2] * rn - (float)cur[2]; o0.w = a[3] * rn - (float)cur[3];
            o1.x = a[4] * rn - (float)cur[4]; o1.y = a[5] * rn - (float)cur[5]; o1.z = a[6] * rn - (float)cur[6]; o1.w = a[7] * rn - (float)cur[7];
            *(float4*)(pooled + (size_t)row * 512 + chn * 8) = o0; *(float4*)(pooled + (size_t)row * 512 + chn * 8 + 4) = o1;
        }
        {
            const int r32 = lane & 31, hi = lane >> 5, g = wv >> 1, half = wv & 1;
            for (int uu = vcu; uu < 512; uu += nb) {
                const int v = uu & 255, bk = v >> 4, qi = (uu >> 8) ? 31 - (v & 15) : (v & 15), b = bk >> 1, kvh = bk & 1;
                const int t = qi * 64 + half * 32 + r32;
                const int lo_t = max(0, qi - 8);
                const unsigned tmask = (unsigned)(((1ull << (qi + 1)) - 1ull) & ~((1ull << lo_t) - 1ull));
                at8::attn_unit(smem, proj16 + (size_t)(b * S_ + t) * INW + C_Q + (kvh * 4 + g) * 128 + hi * 8,
                               kv16 + ((size_t)(4 * B_ + b) * 2 + kvh) * KVSEG, kv16 + ((size_t)(5 * B_ + b) * 2 + kvh) * KVSEG, 128, tmask, 512, t, 0xffffffffu,
                               owin + (size_t)(b * S_ + qi * 64 + half * 32) * 1024 + (kvh * 4 + g) * 128, 1024);
            }
            for (int u = vcu; u < 256; u += nb) {
                const int b = u >> 5, h = (u >> 3) & 3, qt = u & 7;
                const int t = qt * 256 + wv * 32 + r32;
                at8::attn_unit(smem, proj16 + (size_t)(b * S_ + t) * INW + C_QM + h * 128 + hi * 8,
                               kvmem16 + (size_t)b * 256 * 1024 + h * 128, kvmem16 + (size_t)b * 256 * 1024 + 512 + h * 128, 1024, 0xFu, 0, 255, 0xffffffffu,
                               omem + (size_t)(b * S_ + qt * 256 + wv * 32) * 512 + h * 128, 512);
            }
        }
    }
    SEAM(2);
    if (IN(3)) {
        const int lane = LANE_NOW; (void)lane;
        {
            float* bsum = (float*)smem;
            _Float16* hs = (_Float16*)(smem + 4096);
            { const int kv = tid >> 8, n = tid & 255; float a = 0.f;
#pragma unroll
              for (int kc = 0; kc < 16; ++kc) a += bias1[(kv * 16 + kc) * 256 + n];
              bsum[tid] = a; }
            __syncthreads();
            const int fr = lane & 15, fq = lane >> 4;
            for (int u = bid; u < 256; u += nb) {
                const int kv = u >> 7, rt = u & 127;
#pragma unroll
                for (int q = 0; q < 8; ++q) { const int e = tid + 512 * q, i = e >> 8, n = e & 255;
                    const int row = rt * 16 + i, c = (row >> 1) & 127;
                    float a = 0.f;
                    if (c != 127) { a = bsum[kv * 256 + n];
#pragma unroll
                        for (int sp = 0; sp < 4; ++sp) { const float* base = uv + ((size_t)(kv * 4 + sp) * 2048) * 512; a += base[(size_t)row * 512 + n] + base[(size_t)(row + 2) * 512 + 256 + n]; }
                        a = gelu_fast(a); }
                    hs[i * 264 + n] = (_Float16)a; }
                __syncthreads();
                { const _Float16* bp = wt2 + ((size_t)kv * 128 + wv * 16 + fr) * 256 + fq * 8;
                  f4 acc = (f4){0.f, 0.f, 0.f, 0.f};
#pragma unroll
                  for (int sI = 0; sI < 8; ++sI) { const h8 a = *(const h8*)(hs + fr * 264 + sI * 32 + fq * 8), bb = *(const h8*)(bp + sI * 32); acc = __builtin_amdgcn_mfma_f32_16x16x32_f16(a, bb, acc, 0, 0, 0); }
                  _Float16* dst = kv ? vc16 : kc16;
#pragma unroll
                  for (int j = 0; j < 4; ++j) { const int row = rt * 16 + fq * 4 + j; dst[(size_t)row * 128 + wv * 16 + fr] = (((row >> 1) & 127) == 127) ? (_Float16)0.f : (_Float16)acc[j]; } }
                __syncthreads();
            }
        }
        for (int u = bid; u < 128 * 4; u += nb) { const int g = u >> 7, mt = u & 127;
            ARowPlain af{pooled + g * 128, 512, mt * 128, T_}; EpiPool ef{opool, p.in[I_POOLS], mt * 128, g};
            gemm_tile(smem, 128, af, p.in[I_POOLW] + (size_t)g * 128 * 128, 128, 0, 128, false, ef);
        }
    }
    SEAM(3);
    if (IN(4)) {
        const int lane = LANE_NOW; (void)lane;
        const int r32 = lane & 31, hi = lane >> 5, g = wv >> 1, half = wv & 1;
        for (int uu = vcu; uu < 512; uu += nb) {
            const int v = uu & 255, bk = v >> 4, qi = (uu >> 8) ? 31 - (v & 15) : (v & 15), b = bk >> 1, kvh = bk & 1;
            const int tl = half * 32 + r32, t = qi * 64 + tl;
            at8::cmp_slc_unit(smem, proj16 + (size_t)(b * S_ + t) * INW + C_Q + (kvh * 4 + g) * 128 + hi * 8,
                              kc16 + (size_t)(b * 128 * 2 + kvh) * 128, vc16 + (size_t)(b * 128 * 2 + kvh) * 128,
                              kv16 + ((size_t)(2 * B_ + b) * 2 + kvh) * KVSEG, kv16 + ((size_t)(3 * B_ + b) * 2 + kvh) * KVSEG, t, tl, g, qi,
                              ocmp + (size_t)(b * S_ + qi * 64 + half * 32) * 1024 + (kvh * 4 + g) * 128, oslc + (size_t)(b * S_ + qi * 64 + half * 32) * 1024 + (kvh * 4 + g) * 128);
        }
    }
    SEAM(4);
    if (IN(5)) {
        const int lane = LANE_NOW;
        for (int row = gw; row < T_; row += nw) {
            const _Float16* pr = proj16 + (size_t)row * INW + C_G;
            float v[32]; float ss = 0.f;
#pragma unroll
            for (int c = 0; c < 2; ++c) { const int col = (lane + 64 * c) * 8, h = col >> 7; const size_t o = (size_t)row * 1024 + col;
                const float g0 = sigmoidf_((float)pr[h * 3]), g1 = sigmoidf_((float)pr[h * 3 + 1]), g2 = sigmoidf_((float)pr[h * 3 + 2]);
                const h8 a = *(const h8*)(ocmp + o), b2 = *(const h8*)(oslc + o), c2 = *(const h8*)(owin + o);
#pragma unroll
                for (int q = 0; q < 8; ++q) { const float x = g0 * (float)a[q] + g1 * (float)b2[q] + g2 * (float)c2[q]; v[c * 8 + q] = x; ss += x * x; } }
            ss = wave_sum(ss); float r = rsqrtf(ss / 1024.f + LN_EPS);
#pragma unroll
            for (int c = 0; c < 2; ++c) { const int col = (lane + 64 * c) * 8; const float4 ga = *(const float4*)(p.in[I_GNNSA] + col), gb = *(const float4*)(p.in[I_GNNSA] + col + 4);
                v[c * 8 + 0] *= r * ga.x; v[c * 8 + 1] *= r * ga.y; v[c * 8 + 2] *= r * ga.z; v[c * 8 + 3] *= r * ga.w; v[c * 8 + 4] *= r * gb.x; v[c * 8 + 5] *= r * gb.y; v[c * 8 + 6] *= r * gb.z; v[c * 8 + 7] *= r * gb.w; }
            { const h8 a = *(const h8*)(opool + (size_t)row * 512 + lane * 8); ss = 0.f;
#pragma unroll
              for (int q = 0; q < 8; ++q) { v[16 + q] = (float)a[q]; ss += v[16 + q] * v[16 + q]; }
              ss = wave_sum(ss); r = rsqrtf(ss / 512.f + LN_EPS);
              const float4 ga = *(const float4*)(p.in[I_GNPOOL] + lane * 8), gb = *(const float4*)(p.in[I_GNPOOL] + lane * 8 + 4);
              v[16] *= r * ga.x; v[17] *= r * ga.y; v[18] *= r * ga.z; v[19] *= r * ga.w; v[20] *= r * gb.x; v[21] *= r * gb.y; v[22] *= r * gb.z; v[23] *= r * gb.w; }
            { const h8 a = *(const h8*)(omem + (size_t)row * 512 + lane * 8); ss = 0.f;
#pragma unroll
              for (int q = 0; q < 8; ++q) { v[24 + q] = (float)a[q]; ss += v[24 + q] * v[24 + q]; }
              ss = wave_sum(ss); r = rsqrtf(ss / 512.f + LN_EPS);
              const float4 ga = *(const float4*)(p.in[I_GNMEM] + lane * 8), gb = *(const float4*)(p.in[I_GNMEM] + lane * 8 + 4);
              v[24] *= r * ga.x; v[25] *= r * ga.y; v[26] *= r * ga.z; v[27] *= r * ga.w; v[28] *= r * gb.x; v[29] *= r * gb.y; v[30] *= r * gb.z; v[31] *= r * gb.w; }
            float amax = 0.f;
#pragma unroll
            for (int k = 0; k < 32; ++k) amax = fmaxf(amax, fabsf(v[k]));
            amax = wave_max(amax);
            const float qinv = amax > 0.f ? 127.f / amax : 0.f;
            if (lane == 0) scat[row] = amax > 0.f ? amax / 127.f : 1.f;
#pragma unroll
            for (int c = 0; c < 4; ++c) { const int col = c < 2 ? (lane + 64 * c) * 8 : (c == 2 ? 1024 + lane * 8 : 1536 + lane * 8);
                uint2 q; q.x = pack4_i8(v[c * 8 + 0] * qinv, v[c * 8 + 1] * qinv, v[c * 8 + 2] * qinv, v[c * 8 + 3] * qinv); q.y = pack4_i8(v[c * 8 + 4] * qinv, v[c * 8 + 5] * qinv, v[c * 8 + 6] * qinv, v[c * 8 + 7] * qinv);
                *(uint2*)(cat8 + (size_t)row * 2048 + col) = q; }
        }
    }
    SEAM(5);
    if (IN(6)) {
        const int lane = LANE_NOW; (void)lane;
        g8::ProbOut P{cat8, q8out, hpre16, x16, scat, sout, nb, bid};
        g8::gemm_phase(lds, P);
    }
    SEAM(6);
    if (IN(7)) {
        const int lane = LANE_NOW; (void)lane;
        float* lg = (float*)smem;
        const int r32 = lane & 31, hi = lane >> 5, fr = lane & 15, fq = lane >> 4;
        for (int u = bid; u < T_ / 64; u += nb) {
            const int base = u * 64;
            h8 raw[8][4];
#pragma unroll
            for (int i = 0; i < 8; ++i)
#pragma unroll
                for (int c = 0; c < 4; ++c) raw[i][c] = *(const h8*)(hpre16 + (size_t)(base + wv * 8 + i) * 2048 + (lane + 64 * c) * 8);
#pragma unroll
            for (int i = 0; i < 8; ++i) {
                const int row = base + wv * 8 + i;
                float v[32]; float s = 0.f;
#pragma unroll
                for (int c = 0; c < 4; ++c) {
#pragma unroll
                    for (int q = 0; q < 8; ++q) { v[c * 8 + q] = (float)raw[i][c][q]; s += v[c * 8 + q]; } }
                const float mu = wave_sum(s) / 2048.f; float q2 = 0.f;
#pragma unroll
                for (int k = 0; k < 32; ++k) { const float d = v[k] - mu; q2 += d * d; }
                const float rs = rsqrtf(wave_sum(q2) / 2048.f + LN_EPS);
                float amax = 0.f;
#pragma unroll
                for (int c = 0; c < 4; ++c) { const int col = (lane + 64 * c) * 8;
                    const float4 g0 = *(const float4*)(p.in[I_LN1G] + col), g1 = *(const float4*)(p.in[I_LN1G] + col + 4), b0 = *(const float4*)(p.in[I_LN1B] + col), b1 = *(const float4*)(p.in[I_LN1B] + col + 4);
                    float4 o0, o1;
                    o0.x = (v[c * 8 + 0] - mu) * rs * g0.x + b0.x; o0.y = (v[c * 8 + 1] - mu) * rs * g0.y + b0.y; o0.z = (v[c * 8 + 2] - mu) * rs * g0.z + b0.z; o0.w = (v[c * 8 + 3] - mu) * rs * g0.w + b0.w;
                    o1.x = (v[c * 8 + 4] - mu) * rs * g1.x + b1.x; o1.y = (v[c * 8 + 5] - mu) * rs * g1.y + b1.y; o1.z = (v[c * 8 + 6] - mu) * rs * g1.z + b1.z; o1.w = (v[c * 8 + 7] - mu) * rs * g1.w + b1.w;
                    h8 oh; oh[0] = (_Float16)o0.x; oh[1] = (_Float16)o0.y; oh[2] = (_Float16)o0.z; oh[3] = (_Float16)o0.w; oh[4] = (_Float16)o1.x; oh[5] = (_Float16)o1.y; oh[6] = (_Float16)o1.z; oh[7] = (_Float16)o1.w;
                    *(h8*)(h16 + (size_t)row * 2048 + col) = oh;
                    v[c * 8 + 0] = o0.x; v[c * 8 + 1] = o0.y; v[c * 8 + 2] = o0.z; v[c * 8 + 3] = o0.w; v[c * 8 + 4] = o1.x; v[c * 8 + 5] = o1.y; v[c * 8 + 6] = o1.z; v[c * 8 + 7] = o1.w;
                    amax = fmaxf(amax, fmaxf(fmaxf(fmaxf(fabsf(o0.x), fabsf(o0.y)), fmaxf(fabsf(o0.z), fabsf(o0.w))), fmaxf(fmaxf(fabsf(o1.x), fabsf(o1.y)), fmaxf(fabsf(o1.z), fabsf(o1.w))))); }
                amax = wave_max(amax);
                const float qinv = amax > 0.f ? 127.f / amax : 0.f;
                if (lane == 0) sah[row] = amax > 0.f ? amax / 127.f : 1.f;
#pragma unroll
                for (int c = 0; c < 4; ++c) { const int col = (lane + 64 * c) * 8;
                    uint2 q; q.x = pack4_i8(v[c * 8 + 0] * qinv, v[c * 8 + 1] * qinv, v[c * 8 + 2] * qinv, v[c * 8 + 3] * qinv); q.y = pack4_i8(v[c * 8 + 4] * qinv, v[c * 8 + 5] * qinv, v[c * 8 + 6] * qinv, v[c * 8 + 7] * qinv);
                    *(uint2*)(h8q + (size_t)row * 2048 + col) = q; }
            }
            asm volatile("s_waitcnt vmcnt(0)" ::: "memory");
            __syncthreads();
            {
                const int tok0 = base + 16 * (wv >> 1), e0 = 16 * (wv & 1);
                const _Float16* ap = h16 + (size_t)(tok0 + fr) * 2048 + fq * 8; const _Float16* bp = wr16 + (size_t)(e0 + fr) * 2048 + fq * 8;
                f4 acc = (f4){0.f, 0.f, 0.f, 0.f};
#pragma unroll 8
                for (int sI = 0; sI < 64; ++sI) { const h8 a = *(const h8*)(ap + sI * 32), bb = *(const h8*)(bp + sI * 32); acc = __builtin_amdgcn_mfma_f32_16x16x32_f16(a, bb, acc, 0, 0, 0); }
                const float br = p.in[I_BR][e0 + fr];
#pragma unroll
                for (int j = 0; j < 4; ++j) lg[(16 * (wv >> 1) + 4 * fq + j) * 33 + e0 + fr] = acc[j] + br;
            }
            __syncthreads();
#pragma unroll 1
            for (int it = 0; it < 4; ++it) {
                const int tk = 8 * wv + 2 * it + hi;
                const float iv = lg[tk * 33 + r32];
                int rank = 0;
                for (int i = 0; i < 32; ++i) { const float vi = __shfl(iv, i + 32 * hi); rank += (vi > iv || (vi == iv && i < r32)) ? 1 : 0; }
                float tv[4]; int te[4];
#pragma unroll
                for (int r = 0; r < 4; ++r) { const unsigned long long bm = __ballot(rank == r); const unsigned hm = (unsigned)(bm >> (32 * hi)); const int src = __ffs(hm) - 1; te[r] = src; tv[r] = __shfl(iv, src + 32 * hi); }
                const float e0v = 1.f, e1v = expf(tv[1] - tv[0]), e2v = expf(tv[2] - tv[0]), e3v = expf(tv[3] - tv[0]); const float inv = 1.f / (e0v + e1v + e2v + e3v);
                if (r32 < 4) { const int e = r32 == 0 ? te[0] : r32 == 1 ? te[1] : r32 == 2 ? te[2] : te[3]; const float g = (r32 == 0 ? e0v : r32 == 1 ? e1v : r32 == 2 ? e2v : e3v) * inv;
                    const int a = (base + tk) * 4 + r32; const int pos = atomicAdd(&cnt[e], 1); list[(size_t)e * T_ + pos] = a; gate[a] = g; gate2[(size_t)e * T_ + pos] = g; sa2[(size_t)e * T_ + pos] = sah[base + tk]; }
            }
            __syncthreads();
        }
    }
    SEAM(7);
    LAS int* mtab = (LAS int*)(smem + g8::STAGE_BYTES);
    if (IN(8)) {
        const int lane = LANE_NOW; (void)lane;
        if (tid == 0) { int ub = 0, rs = 0;
            for (int e = 0; e < NE; ++e) { const int c = (int)__hip_atomic_load((unsigned*)&cnt[e], __ATOMIC_RELAXED, __HIP_MEMORY_SCOPE_AGENT); mtab[e] = c; mtab[32 + e] = ub; mtab[65 + e] = rs; ub += ((c + 255) >> 8) * 16; rs += c; }
            mtab[64] = ub; mtab[97] = rs; mtab[98] = ub; }
        __syncthreads();
        g8::moe_build(mtab, nb, vcu);
        __syncthreads();
        g8::ProbGu P{h8q, q8gu, actf8, p.in[I_BGU], list, sa2, sgu, g8::MoeTab{mtab, 16}, nb, vcu};
        g8::gemm_phase(lds, P);
        __syncthreads();
    }
    SEAM(8);
    if (IN(9)) {
        const int lane = LANE_NOW;
        for (int row0 = gw; row0 < NA; row0 += nw * 8) {
            uint2 raw[8][4];
#pragma unroll
            for (int i = 0; i < 8; ++i)
#pragma unroll
                for (int c = 0; c < 4; ++c) raw[i][c] = *(const uint2*)(actf8 + (size_t)(row0 + i * nw) * 2048 + (lane + 64 * c) * 8);
#pragma unroll
            for (int i = 0; i < 8; ++i) { const int row = row0 + i * nw;
                float v[32]; float amax = 0.f;
#pragma unroll
                for (int c = 0; c < 4; ++c) { const uint2 a = raw[i][c];
                    dec4_fp8(a.x, v[c * 8 + 0], v[c * 8 + 1], v[c * 8 + 2], v[c * 8 + 3]); dec4_fp8(a.y, v[c * 8 + 4], v[c * 8 + 5], v[c * 8 + 6], v[c * 8 + 7]);
#pragma unroll
                    for (int q = 0; q < 8; ++q) amax = fmaxf(amax, fabsf(v[c * 8 + q])); }
                amax = wave_max(amax);
                const float qinv = amax > 0.f ? 127.f / amax : 0.f;
                if (lane == 0) sact[row] = amax > 0.f ? amax / 127.f : 1.f;
#pragma unroll
                for (int c = 0; c < 4; ++c) { uint2 q; q.x = pack4_i8(v[c * 8 + 0] * qinv, v[c * 8 + 1] * qinv, v[c * 8 + 2] * qinv, v[c * 8 + 3] * qinv); q.y = pack4_i8(v[c * 8 + 4] * qinv, v[c * 8 + 5] * qinv, v[c * 8 + 6] * qinv, v[c * 8 + 7] * qinv);
                    *(uint2*)(act8 + (size_t)row * 2048 + (lane + 64 * c) * 8) = q; }
            }
        }
    }
    SEAM(9);
    if (IN(10)) {
        const int lane = LANE_NOW; (void)lane;
        if (tid == 0) { int ub = 0, rs = 0;
            for (int e = 0; e < NE; ++e) { const int c = (int)__hip_atomic_load((unsigned*)&cnt[e], __ATOMIC_RELAXED, __HIP_MEMORY_SCOPE_AGENT); mtab[e] = c; mtab[32 + e] = ub; mtab[65 + e] = rs; ub += ((c + 255) >> 8) * 8; rs += c; }
            mtab[64] = ub; mtab[97] = rs; mtab[98] = ub; }
        __syncthreads();
        g8::moe_build(mtab, nb, vcu);
        __syncthreads();
        g8::ProbDn P{act8, q8dn, yf8, p.in[I_BDN], list, gate2, sact, sdn, g8::MoeTab{mtab, 8}, nb, vcu};
        g8::gemm_phase(lds, P);
        __syncthreads();
    }
    SEAM(10);
    if (IN(11)) {
        const int lane = LANE_NOW; (void)lane;
        for (int row0 = gw; row0 < T_; row0 += nw * 2) {
          h8 hraw[2][4]; uint2 yraw[2][4][4];
#pragma unroll
          for (int i = 0; i < 2; ++i)
#pragma unroll
            for (int c = 0; c < 4; ++c) { const int col = (lane + 64 * c) * 8; const size_t yo = (size_t)(row0 + i * nw) * 4 * 2048 + col;
                hraw[i][c] = *(const h8*)(h16 + (size_t)(row0 + i * nw) * 2048 + col);
                yraw[i][c][0] = *(const uint2*)(yf8 + yo); yraw[i][c][1] = *(const uint2*)(yf8 + yo + 2048); yraw[i][c][2] = *(const uint2*)(yf8 + yo + 4096); yraw[i][c][3] = *(const uint2*)(yf8 + yo + 6144); }
#pragma unroll
          for (int i = 0; i < 2; ++i) { const int row = row0 + i * nw;
            float v[32]; float s = 0.f;
#pragma unroll
            for (int c = 0; c < 4; ++c) {
                const h8 hh8 = hraw[i][c];
                const uint2 y0 = yraw[i][c][0], y1 = yraw[i][c][1], y2 = yraw[i][c][2], y3 = yraw[i][c][3];
                float ys[8], t0[8], t1[8], t2[8], t3[8];
                dec4_fp8(y0.x, t0[0], t0[1], t0[2], t0[3]); dec4_fp8(y0.y, t0[4], t0[5], t0[6], t0[7]); dec4_fp8(y1.x, t1[0], t1[1], t1[2], t1[3]); dec4_fp8(y1.y, t1[4], t1[5], t1[6], t1[7]);
                dec4_fp8(y2.x, t2[0], t2[1], t2[2], t2[3]); dec4_fp8(y2.y, t2[4], t2[5], t2[6], t2[7]); dec4_fp8(y3.x, t3[0], t3[1], t3[2], t3[3]); dec4_fp8(y3.y, t3[4], t3[5], t3[6], t3[7]);
#pragma unroll
                for (int q = 0; q < 8; ++q) ys[q] = (t0[q] + t1[q]) + (t2[q] + t3[q]);
#pragma unroll
                for (int q = 0; q < 8; ++q) { v[c * 8 + q] = DN_ALPHA * (float)hh8[q] + ys[q] * 0.0625f; s += v[c * 8 + q]; } }
            const float mu = wave_sum(s) / 2048.f; float q2 = 0.f;
#pragma unroll
            for (int i = 0; i < 32; ++i) { const float d = v[i] - mu; q2 += d * d; }
            const float rs = rsqrtf(wave_sum(q2) / 2048.f + LN_EPS);
#pragma unroll
            for (int c = 0; c < 4; ++c) { const int col = (lane + 64 * c) * 8;
                const float4 ga = *(const float4*)(p.in[I_LN2G] + col), gb = *(const float4*)(p.in[I_LN2G] + col + 4), ba = *(const float4*)(p.in[I_LN2B] + col), bb = *(const float4*)(p.in[I_LN2B] + col + 4);
                float4 o0, o1;
                o0.x = (v[c * 8 + 0] - mu) * rs * ga.x + ba.x; o0.y = (v[c * 8 + 1] - mu) * rs * ga.y + ba.y; o0.z = (v[c * 8 + 2] - mu) * rs * ga.z + ba.z; o0.w = (v[c * 8 + 3] - mu) * rs * ga.w + ba.w;
                o1.x = (v[c * 8 + 4] - mu) * rs * gb.x + bb.x; o1.y = (v[c * 8 + 5] - mu) * rs * gb.y + bb.y; o1.z = (v[c * 8 + 6] - mu) * rs * gb.z + bb.z; o1.w = (v[c * 8 + 7] - mu) * rs * gb.w + bb.w;
                *(float4*)(p.out + (size_t)row * 2048 + col) = o0; *(float4*)(p.out + (size_t)row * 2048 + col + 4) = o1; }
          }
        }
    }
}

constexpr int NPHASE = 12;

extern "C" void kernel_launch(void* const* d_in, const int* in_sizes, int n_in, void* d_out, int out_size, void* d_ws, size_t ws_size, hipStream_t stream) {
    static int grid = 0;
    if (grid == 0) {
        if (n_in != 26 || ws_size < WS_END) { fprintf(stderr, "kernel_launch: unexpected n_in %d or ws_size %zu (< %zu)\n", n_in, ws_size, (size_t)WS_END); grid = -1; return; }
        int dev = 0, cus = 0, per_cu = 0;
        hipGetDevice(&dev); hipDeviceGetAttribute(&cus, hipDeviceAttributeMultiprocessorCount, dev);
        if (hipFuncSetAttribute((const void*)fwd, hipFuncAttributeMaxDynamicSharedMemorySize, LDS_BYTES) != hipSuccess) { fprintf(stderr, "hipFuncSetAttribute failed\n"); grid = -1; return; }
        hipOccupancyMaxActiveBlocksPerMultiprocessor(&per_cu, (const void*)fwd, 512, LDS_BYTES);
        (void)hipGetLastError();
        if (per_cu < 1) fprintf(stderr, "occupancy query says %d blocks per CU\n", per_cu);
        grid = cus > 0 ? cus : 256;
    }
    if (grid < 0) return;
    hipMemsetAsync((char*)d_ws + WS_CTL, 0, CTL_BYTES, stream);
    Params p{};
    for (int i = 0; i < 26; ++i) p.in[i] = (const float*)d_in[i];
    p.out = (float*)d_out; p.ws = (unsigned char*)d_ws;
#if N_LAUNCH_MODE == 1
    p.lo_hi = (long long)0 | ((long long)NPHASE << 32);
    hipLaunchKernelGGL(fwd, dim3(grid), dim3(512), LDS_BYTES, stream, p);
#else
    for (int ph = 0; ph < NPHASE; ++ph) {
        p.lo_hi = (long long)ph | ((long long)(ph + 1) << 32);
        hipLaunchKernelGGL(fwd, dim3(grid), dim3(512), LDS_BYTES, stream, p);
    }
#endif
}
```

```cpp
#include <hip/hip_runtime.h>
#include <cstdio>
#include <cstdint>

#ifndef N_LAUNCH_MODE
#define N_LAUNCH_MODE 1
#endif

constexpr int B_ = 8, S_ = 2048, D_ = 2048, T_ = B_ * S_;
constexpr int INW = 3608;
constexpr int C_Q = 0, C_KC = 1024, C_VC = 1280, C_KS = 1536, C_VS = 1792, C_KW = 2048, C_VW = 2304, C_G = 2560, C_UP = 2584, C_QM = 3096;
constexpr int NC = 127;
constexpr int CROWS = B_ * NC * 2;
constexpr int NE = 32, DE = 2048, NA = T_ * 4;
constexpr float LN_EPS = 1e-5f;
constexpr float DN_ALPHA = 1.189207115002721f;
constexpr float ATT_SCALE = 0.08838834764831845f;

constexpr size_t al256(size_t x) { return (x + 255) & ~(size_t)255; }
constexpr size_t WS_CTL = 0;
constexpr size_t CTL_BYTES = 65536;
constexpr size_t CTL_CNT = 16384;
constexpr size_t WS_PROJ = CTL_BYTES;
constexpr size_t WS_KVMEM = WS_PROJ + al256((size_t)T_ * INW * 4);
constexpr size_t WS_BIAS1 = WS_KVMEM + al256((size_t)2048 * 1024 * 4);
constexpr size_t WS_HID = WS_BIAS1 + al256(2 * 16 * 256 * 4);
constexpr size_t WS_KC = WS_HID + al256((size_t)2 * 2048 * 256 * 4);
constexpr size_t WS_VC = WS_KC + al256((size_t)CROWS * 128 * 4);
constexpr size_t WS_POOLED = WS_VC + al256((size_t)CROWS * 128 * 4);
constexpr size_t WS_OPOOL = WS_POOLED + al256((size_t)T_ * 512 * 4);
constexpr size_t WS_OWIN = WS_OPOOL + al256((size_t)T_ * 512 * 4);
constexpr size_t WS_OCMP = WS_OWIN + al256((size_t)T_ * 1024 * 4);
constexpr size_t WS_OSLC = WS_OCMP + al256((size_t)T_ * 1024 * 4);
constexpr size_t WS_SEL = WS_OSLC + al256((size_t)T_ * 1024 * 4);
constexpr size_t WS_OMEM = WS_SEL + al256((size_t)T_ * 2 * 4);
constexpr size_t WS_CAT16 = WS_OMEM + al256((size_t)T_ * 512 * 4);
constexpr size_t WS_HPRE = WS_CAT16 + al256((size_t)T_ * 2048 * 2);
constexpr size_t WS_H = WS_HPRE + al256((size_t)T_ * 2048 * 4);
constexpr size_t WS_H16 = WS_H + al256((size_t)T_ * 2048 * 4);
constexpr size_t WS_GATE = WS_H16 + al256((size_t)T_ * 2048 * 2);
constexpr size_t WS_LIST = WS_GATE + al256((size_t)NA * 4);
constexpr size_t WS_ACT16 = WS_LIST + al256((size_t)NE * T_ * 4);
constexpr size_t WS_Y16 = WS_ACT16 + al256((size_t)(NA + 256) * 2048 * 2);
constexpr size_t WS_X16 = WS_Y16 + al256((size_t)NA * 2048 * 2);
constexpr size_t WS_MEM16 = WS_X16 + (size_t)T_ * 2048 * 2;
constexpr size_t WS_WTIN = WS_MEM16 + al256((size_t)2048 * 2048 * 2);
constexpr size_t WS_WTOUT = WS_WTIN + al256((size_t)3840 * 2048 * 2);
constexpr size_t WS_WTGU = WS_WTOUT + al256((size_t)2048 * 2048 * 2);
constexpr size_t WS_WTDN = WS_WTGU + al256((size_t)NE * 4096 * 2048 * 2);
constexpr size_t WS_PROJ16 = WS_WTDN + al256((size_t)NE * 2048 * 2048 * 2);
constexpr size_t WS_KVMEM16 = WS_PROJ16 + al256((size_t)(T_ + 64) * INW * 2);
constexpr size_t WS_WT1 = WS_KVMEM16 + al256((size_t)2048 * 1024 * 2);
constexpr size_t WS_UV = WS_WT1 + al256((size_t)2 * 512 * 2048 * 2);
constexpr size_t WS_KC16 = WS_UV + al256((size_t)2 * 4 * 2048 * 512 * 4);
constexpr size_t WS_VC16 = WS_KC16 + al256((size_t)B_ * 128 * 256 * 2);
constexpr size_t WS_WR16 = WS_VC16 + al256((size_t)B_ * 128 * 256 * 2);
constexpr size_t WS_Q8GU = WS_WR16 + al256((size_t)32 * 2048 * 2);
constexpr size_t WS_Q8DN = WS_Q8GU + al256((size_t)NE * 4096 * 2048);
constexpr size_t WS_SGU = WS_Q8DN + al256((size_t)NE * 2048 * 2048);
constexpr size_t WS_SDN = WS_SGU + al256((size_t)NE * 4096 * 4);
constexpr size_t WS_H8 = WS_SDN + al256((size_t)NE * 2048 * 4);
constexpr size_t WS_SAH = WS_H8 + al256((size_t)T_ * 2048);
constexpr size_t WS_ACT8 = WS_SAH + al256((size_t)T_ * 4);
constexpr size_t WS_SACT = WS_ACT8 + al256((size_t)(NA + 256) * 2048);
constexpr size_t WS_WTMKV = WS_SACT + al256((size_t)(NA + 256) * 4);
constexpr size_t WS_Q8OUT = WS_WTMKV + al256((size_t)1024 * 2048 * 2);
constexpr size_t WS_SOUT = WS_Q8OUT + al256((size_t)2048 * 2048);
constexpr size_t WS_CAT8 = WS_SOUT + al256(2048 * 4);
constexpr size_t WS_SCAT = WS_CAT8 + al256((size_t)T_ * 2048);
constexpr size_t WS_SA2 = WS_SCAT + al256((size_t)T_ * 4);
constexpr size_t WS_GATE2 = WS_SA2 + al256((size_t)NE * T_ * 4);
constexpr size_t WS_X8 = WS_GATE2 + al256((size_t)NE * T_ * 4);
constexpr size_t WS_SXA = WS_X8 + al256((size_t)(T_ + 2048) * 2048);
constexpr size_t WS_Q8IN = WS_SXA + al256((size_t)(T_ + 2048) * 4);
constexpr size_t WS_SIN8 = WS_Q8IN + al256((size_t)2560 * 2048);
constexpr size_t WS_Q8MKV = WS_SIN8 + al256(2560 * 4);
constexpr size_t WS_SMKV = WS_Q8MKV + al256((size_t)1024 * 2048);
constexpr size_t WS_WT2 = WS_SMKV + al256(1024 * 4);
constexpr size_t WS_KV16 = WS_WT2 + al256((size_t)2 * 128 * 256 * 2);
constexpr size_t KVSEG = (size_t)S_ * 128;
constexpr size_t WS_END = WS_KV16 + al256((size_t)6 * B_ * 2 * S_ * 128 * 2);

constexpr int LDS_BYTES = 159744;

struct Params {
    const float* in[26];
    float* out;
    unsigned char* ws;
    long long lo_hi;
};
enum { I_X = 0, I_MEM, I_WIN, I_POSK, I_W1K, I_W2K, I_POSV, I_W1V, I_W2V, I_POOLW, I_POOLS, I_WMEMKV, I_GNNSA, I_GNPOOL, I_GNMEM, I_WOUT,
       I_LN1G, I_LN1B, I_WR, I_BR, I_WGU, I_BGU, I_WDN, I_BDN, I_LN2G, I_LN2B };

#define XB_TMO      128
#define XB_XCNT(j)  (256  + 64 * (j))
#define XB_XSUB(j)  (1280 + 64 * (j))
#define XB_XGEN(j)  (2304 + 64 * (j))
#define XB_TOP      3328
#define XB_TOPGEN   3392
#define XCD_BAR_WORDS 3456
#define XB_SPIN_CAP (1u << 25)
#define LAS __attribute__((address_space(3)))

__device__ __forceinline__ unsigned xb_ld(unsigned* p)              { return __hip_atomic_load(p, __ATOMIC_RELAXED, __HIP_MEMORY_SCOPE_AGENT); }
__device__ __forceinline__ unsigned xb_add(unsigned* p, unsigned v) { return __hip_atomic_fetch_add(p, v, __ATOMIC_RELAXED, __HIP_MEMORY_SCOPE_AGENT); }
__device__ __forceinline__ unsigned xb_xcc_id() { return (unsigned)__builtin_amdgcn_s_getreg((3 << 11) | 20) & 0xFu; }
#define XB_SPIN(cond, bar) do { unsigned _sp = 0; while (cond) { __builtin_amdgcn_s_sleep(1); \
    if ((++_sp & 255u) == 0u) { if (xb_ld(&(bar)[XB_TMO])) break; if (_sp > XB_SPIN_CAP) { atomicAdd(&(bar)[XB_TMO], 1u); break; } } } } while (0)

struct XcdBarrier { unsigned* bar; unsigned x; volatile LAS unsigned* st; };

__device__ __forceinline__ XcdBarrier xcd_barrier_post(unsigned* bar, volatile LAS unsigned* st) {
    XcdBarrier b; b.bar = bar; b.x = xb_xcc_id(); b.st = st;
    if (threadIdx.x == 0) (void)xb_add(&bar[XB_XCNT(b.x)], 1u);
    return b;
}
__device__ __forceinline__ void xcd_barrier_complete(unsigned* bar, unsigned x, unsigned& nloc, unsigned& nx) {
    const unsigned G = gridDim.x * gridDim.y * gridDim.z;
    unsigned sum, cnt, mine, sp = 0u;
    for (;;) {
        sum = 0u; cnt = 0u; mine = 0u;
#pragma unroll
        for (unsigned j = 0; j < 16; ++j) { const unsigned c = xb_ld(&bar[XB_XCNT(j)]); sum += c; cnt += (c > 0u) ? 1u : 0u; mine = (j == x) ? c : mine; }
        if (sum == G) break;
        __builtin_amdgcn_s_sleep(1);
        if ((++sp & 255u) == 0u) { if (xb_ld(&bar[XB_TMO])) break; if (sp > XB_SPIN_CAP) { atomicAdd(&bar[XB_TMO], 1u); break; } }
    }
    nloc = mine > 0u ? mine : 1u; nx = cnt > 0u ? cnt : 1u;
}
__device__ __forceinline__ void xcd_barrier(const XcdBarrier& b) {
    asm volatile("s_waitcnt vmcnt(0)" ::: "memory");
    __syncthreads();
    if (threadIdx.x == 0) {
        unsigned* bar = b.bar;
        __builtin_amdgcn_s_waitcnt(0);
        unsigned nloc = b.st[0], nx = b.st[1];
        if (nloc == 0u) { xcd_barrier_complete(bar, b.x, nloc, nx); b.st[0] = nloc; b.st[1] = nx; }
        const unsigned old = xb_add(&bar[XB_XSUB(b.x)], 1u);
        const unsigned gen = old / nloc;
        if (old + 1u == (gen + 1u) * nloc) {
            __builtin_amdgcn_fence(__ATOMIC_RELEASE, "agent");
            asm volatile("s_waitcnt vmcnt(0)" ::: "memory");
            const unsigned og = xb_add(&bar[XB_TOP], 1u);
            const unsigned tg = og / nx;
            if (og + 1u == (tg + 1u) * nx) xb_add(&bar[XB_TOPGEN], 1u);
            else XB_SPIN(xb_ld(&bar[XB_TOPGEN]) == tg, bar);
            __builtin_amdgcn_fence(__ATOMIC_ACQUIRE, "agent");
            xb_add(&bar[XB_XGEN(b.x)], 1u);
            asm volatile("s_waitcnt vmcnt(0)" ::: "memory");
        } else {
            XB_SPIN(xb_ld(&bar[XB_XGEN(b.x)]) == gen, bar);
            __builtin_amdgcn_fence(__ATOMIC_ACQUIRE, "agent");
            asm volatile("s_waitcnt vmcnt(0)" ::: "memory");
        }
    }
    __syncthreads();
}

typedef _Float16 h8 __attribute__((ext_vector_type(8)));
typedef _Float16 h4 __attribute__((ext_vector_type(4)));
typedef float f4 __attribute__((ext_vector_type(4)));

__device__ __forceinline__ float wave_sum(float v) {
#pragma unroll
    for (int o = 32; o > 0; o >>= 1) v += __shfl_xor(v, o);
    return v;
}
__device__ __forceinline__ float wave_max(float v) {
#pragma unroll
    for (int o = 32; o > 0; o >>= 1) v = fmaxf(v, __shfl_xor(v, o));
    return v;
}
__device__ __forceinline__ void wave_sync() {
    asm volatile("s_waitcnt lgkmcnt(0)" ::: "memory");
    __builtin_amdgcn_wave_barrier();
}
__device__ __forceinline__ float gelu_tanh(float x) {
    const float u = 0.7978845608028654f * (x + 0.044715f * x * x * x);
    return 0.5f * x * (1.f + tanhf(u));
}
__device__ __forceinline__ float gelu_fast(float x) { const float u = 0.7978845608028654f * (x + 0.044715f * x * x * x); const float t = 1.f - 2.f * __builtin_amdgcn_rcpf(1.f + __builtin_amdgcn_exp2f(2.8853900817779268f * u)); return 0.5f * x * (1.f + t); }
__device__ __forceinline__ float sigmoidf_(float x) { return 1.f / (1.f + expf(-x)); }
__device__ __forceinline__ unsigned pk4_fp8(float a, float b, float c, float d) { int w = 0; w = __builtin_amdgcn_cvt_pk_fp8_f32(a, b, w, false); w = __builtin_amdgcn_cvt_pk_fp8_f32(c, d, w, true); return (unsigned)w; }
__device__ __forceinline__ void dec4_fp8(unsigned w, float& a, float& b, float& c, float& d) { a = __builtin_amdgcn_cvt_f32_fp8((int)w, 0); b = __builtin_amdgcn_cvt_f32_fp8((int)w, 1); c = __builtin_amdgcn_cvt_f32_fp8((int)w, 2); d = __builtin_amdgcn_cvt_f32_fp8((int)w, 3); }
__device__ __forceinline__ float swiglu_fast(float g, float l) { const float xg = fminf(g, 7.f), xl = fminf(fmaxf(l, -7.f), 7.f); return xg * __builtin_amdgcn_rcpf(1.f + __builtin_amdgcn_exp2f(-2.4554669595930156f * xg)) * (xl + 1.f); }

constexpr int G_LD = 40;
template <class AF, class EF>
__device__ __forceinline__ void gemm_tile(char* smem, int K, const AF& af, const float* __restrict__ Bm, int ldb, int n0, int Nlim, bool perm, const EF& ef) {
    _Float16* As = (_Float16*)smem;
    _Float16* Bs = As + 128 * G_LD;
    const int tid = threadIdx.x, lane = tid & 63, wid = tid >> 6, wr = wid >> 2, wc = wid & 3, fr = lane & 15, fq = lane >> 4;
    f4 acc[4][2];
#pragma unroll
    for (int m = 0; m < 4; ++m)
#pragma unroll
        for (int n = 0; n < 2; ++n) acc[m][n] = (f4){0.f, 0.f, 0.f, 0.f};
    const int ar = tid >> 3, ak = (tid & 7) * 4;
    const float* ap0 = af.row(ar);
    const float* ap1 = af.row(ar + 64);
    const int bk = tid >> 5, bn = (tid & 31) * 4;
    const bool bok = (n0 + bn) < Nlim;
    int bnp[4];
#pragma unroll
    for (int i = 0; i < 4; ++i) { const int c = bn + i; bnp[i] = perm ? ((c & ~31) | ((c & 1) << 4) | ((c & 31) >> 1)) : c; }
    for (int k0 = 0; k0 < K; k0 += 32) {
        const int ko = af.koff(k0 + ak);
        float4 a0 = make_float4(0.f, 0.f, 0.f, 0.f), a1 = a0, b0 = a0, b1 = a0;
        if (ap0) a0 = *(const float4*)(ap0 + ko);
        if (ap1) a1 = *(const float4*)(ap1 + ko);
        if (bok) { b0 = *(const float4*)(Bm + (size_t)(k0 + bk) * ldb + n0 + bn); b1 = *(const float4*)(Bm + (size_t)(k0 + bk + 16) * ldb + n0 + bn); }
        __syncthreads();
        *(h4*)&As[ar * G_LD + ak] = (h4){(_Float16)a0.x, (_Float16)a0.y, (_Float16)a0.z, (_Float16)a0.w};
        *(h4*)&As[(ar + 64) * G_LD + ak] = (h4){(_Float16)a1.x, (_Float16)a1.y, (_Float16)a1.z, (_Float16)a1.w};
        Bs[bnp[0] * G_LD + bk] = (_Float16)b0.x; Bs[bnp[1] * G_LD + bk] = (_Float16)b0.y; Bs[bnp[2] * G_LD + bk] = (_Float16)b0.z; Bs[bnp[3] * G_LD + bk] = (_Float16)b0.w;
        Bs[bnp[0] * G_LD + bk + 16] = (_Float16)b1.x; Bs[bnp[1] * G_LD + bk + 16] = (_Float16)b1.y; Bs[bnp[2] * G_LD + bk + 16] = (_Float16)b1.z; Bs[bnp[3] * G_LD + bk + 16] = (_Float16)b1.w;
        __syncthreads();
        h8 a[4], b[2];
#pragma unroll
        for (int m = 0; m < 4; ++m) a[m] = *(const h8*)&As[(wr * 64 + m * 16 + fr) * G_LD + fq * 8];
#pragma unroll
        for (int n = 0; n < 2; ++n) b[n] = *(const h8*)&Bs[(wc * 32 + n * 16 + fr) * G_LD + fq * 8];
#pragma unroll
        for (int m = 0; m < 4; ++m)
#pragma unroll
            for (int n = 0; n < 2; ++n) acc[m][n] = __builtin_amdgcn_mfma_f32_16x16x32_f16(a[m], b[n], acc[m][n], 0, 0, 0);
    }
    ef(acc, wr, wc, fr, fq);
    __syncthreads();
}

struct ARowPlain { const float* base; int ld; int m0; int mlim;
    __device__ __forceinline__ const float* row(int r) const { return (m0 + r) < mlim ? base + (size_t)(m0 + r) * ld : nullptr; }
    __device__ __forceinline__ int koff(int k) const { return k; } };
struct ARowCmp { const float* proj; int col; int m0;
    __device__ __forceinline__ const float* row(int r) const { const int g = m0 + r; if (g >= CROWS) return nullptr; const int kvh = g & 1, bc = g >> 1, b = bc / NC, c = bc % NC;
        return proj + (size_t)(b * S_ + 16 * c) * INW + col + kvh * 128; }
    __device__ __forceinline__ int koff(int k) const { return (k >> 7) * INW + (k & 127); } };
struct ARowList { const float* base; const int* list; int m0; int cnt; int shift;
    __device__ __forceinline__ const float* row(int r) const { if (m0 + r >= cnt) return nullptr; const int a = list[m0 + r]; return base + (size_t)(a >> shift) * 2048; }
    __device__ __forceinline__ int koff(int k) const { return k; } };

struct EpiStore { float* C; int ldc; int m0; int n0; int mlim; int nlim; _Float16* C16;
    __device__ __forceinline__ void operator()(const f4 (&acc)[4][2], int wr, int wc, int fr, int fq) const {
#pragma unroll
        for (int m = 0; m < 4; ++m)
#pragma unroll
            for (int n = 0; n < 2; ++n)
#pragma unroll
                for (int j = 0; j < 4; ++j) { const int r = m0 + wr * 64 + m * 16 + fq * 4 + j, c = n0 + wc * 32 + n * 16 + fr;
                    if (r < mlim && c < nlim) { C[(size_t)r * ldc + c] = acc[m][n][j]; if (C16) C16[(size_t)r * ldc + c] = (_Float16)acc[m][n][j]; } } } };
struct EpiKc { _Float16* C; int m0;
    __device__ __forceinline__ void operator()(const f4 (&acc)[4][2], int wr, int wc, int fr, int fq) const {
#pragma unroll
        for (int m = 0; m < 4; ++m)
#pragma unroll
            for (int n = 0; n < 2; ++n)
#pragma unroll
                for (int j = 0; j < 4; ++j) { const int r = m0 + wr * 64 + m * 16 + fq * 4 + j, c = wc * 32 + n * 16 + fr;
                    C[(size_t)r * 128 + c] = (((r >> 1) & 127) == 127) ? (_Float16)0.f : (_Float16)acc[m][n][j]; } } };
struct EpiPool { _Float16* C; const float* scale; int m0; int g;
    __device__ __forceinline__ void operator()(const f4 (&acc)[4][2], int wr, int wc, int fr, int fq) const {
#pragma unroll
        for (int m = 0; m < 4; ++m)
#pragma unroll
            for (int n = 0; n < 2; ++n)
#pragma unroll
                for (int j = 0; j < 4; ++j) { const int r = m0 + wr * 64 + m * 16 + fq * 4 + j, c = g * 128 + wc * 32 + n * 16 + fr;
                    C[(size_t)r * 512 + c] = (_Float16)(acc[m][n][j] * scale[c]); } } };
struct EpiHid { float* C; const float* bias; int m0; int n0;
    __device__ __forceinline__ void operator()(const f4 (&acc)[4][2], int wr, int wc, int fr, int fq) const {
#pragma unroll
        for (int m = 0; m < 4; ++m)
#pragma unroll
            for (int n = 0; n < 2; ++n)
#pragma unroll
                for (int j = 0; j < 4; ++j) { const int r = m0 + wr * 64 + m * 16 + fq * 4 + j, c = n0 + wc * 32 + n * 16 + fr;
                    if (r < CROWS) C[(size_t)r * 256 + c] = gelu_tanh(acc[m][n][j] + bias[c]); } } };
struct EpiOut { float* C; const float* x; int m0; int n0;
    __device__ __forceinline__ void operator()(const f4 (&acc)[4][2], int wr, int wc, int fr, int fq) const {
#pragma unroll
        for (int m = 0; m < 4; ++m)
#pragma unroll
            for (int n = 0; n < 2; ++n)
#pragma unroll
                for (int j = 0; j < 4; ++j) { const size_t o = (size_t)(m0 + wr * 64 + m * 16 + fq * 4 + j) * 2048 + n0 + wc * 32 + n * 16 + fr;
                    C[o] = DN_ALPHA * x[o] + acc[m][n][j]; } } };
struct EpiGu { float* act; const float* bgu; const int* list; int m0; int cnt; int n0;
    __device__ __forceinline__ void operator()(const f4 (&acc)[4][2], int wr, int wc, int fr, int fq) const {
        const int jc = (n0 + wc * 32) / 2 + fr;
        const float bg = bgu[2 * jc], bl = bgu[2 * jc + 1];
#pragma unroll
        for (int m = 0; m < 4; ++m)
#pragma unroll
            for (int j = 0; j < 4; ++j) { const int r = m0 + wr * 64 + m * 16 + fq * 4 + j;
                if (r < cnt) { const int a = list[r];
                    const float xg = fminf(acc[m][0][j] + bg, 7.f), xl = fminf(fmaxf(acc[m][1][j] + bl, -7.f), 7.f);
                    act[(size_t)a * 2048 + jc] = xg * sigmoidf_(1.702f * xg) * (xl + 1.f); } } } };
struct EpiDn { float* y; const float* bdn; const int* list; const float* gate; int m0; int cnt; int n0;
    __device__ __forceinline__ void operator()(const f4 (&acc)[4][2], int wr, int wc, int fr, int fq) const {
#pragma unroll
        for (int m = 0; m < 4; ++m)
#pragma unroll
            for (int j = 0; j < 4; ++j) { const int r = m0 + wr * 64 + m * 16 + fq * 4 + j;
                if (r < cnt) { const int a = list[r]; const float g = gate[a];
#pragma unroll
                    for (int n = 0; n < 2; ++n) { const int c = n0 + wc * 32 + n * 16 + fr; y[(size_t)a * 2048 + c] = (acc[m][n][j] + bdn[c]) * g; } } } } };

constexpr int WLDS_FLOATS = 4096 + 512 + 32;
template <bool SHARED>
__device__ __forceinline__ void wave_attn(float* sw, const float* __restrict__ qptr, const float* __restrict__ Kb, const float* __restrict__ Vb, int ld, int nseg, float scale, float* __restrict__ optr) {
    const int lane = threadIdx.x & 63;
    float* sq = sw + 4096; const int* segs = (const int*)(sw + 4096 + 512);
#pragma unroll
    for (int i = 0; i < 8; ++i) sq[lane + 64 * i] = qptr[lane + 64 * i];
    wave_sync();
    for (int sg = 0; sg < nseg; ++sg) {
        const int start = segs[sg], len = segs[16 + sg];
        float d0 = 0.f, d1 = 0.f, d2 = 0.f, d3 = 0.f;
        if (lane < len) {
            const float* kp = Kb + (size_t)(start + lane) * ld;
            for (int d4 = 0; d4 < 32; ++d4) {
                if (SHARED) {
                    const float4 kv = *(const float4*)(kp + d4 * 4);
                    const float4 q0 = *(const float4*)(sq + d4 * 4), q1 = *(const float4*)(sq + 128 + d4 * 4), q2 = *(const float4*)(sq + 256 + d4 * 4), q3 = *(const float4*)(sq + 384 + d4 * 4);
                    d0 += kv.x * q0.x + kv.y * q0.y + kv.z * q0.z + kv.w * q0.w;
                    d1 += kv.x * q1.x + kv.y * q1.y + kv.z * q1.z + kv.w * q1.w;
                    d2 += kv.x * q2.x + kv.y * q2.y + kv.z * q2.z + kv.w * q2.w;
                    d3 += kv.x * q3.x + kv.y * q3.y + kv.z * q3.z + kv.w * q3.w;
                } else {
                    const float4 k0 = *(const float4*)(kp + d4 * 4), k1 = *(const float4*)(kp + 128 + d4 * 4), k2 = *(const float4*)(kp + 256 + d4 * 4), k3 = *(const float4*)(kp + 384 + d4 * 4);
                    const float4 q0 = *(const float4*)(sq + d4 * 4), q1 = *(const float4*)(sq + 128 + d4 * 4), q2 = *(const float4*)(sq + 256 + d4 * 4), q3 = *(const float4*)(sq + 384 + d4 * 4);
                    d0 += k0.x * q0.x + k0.y * q0.y + k0.z * q0.z + k0.w * q0.w;
                    d1 += k1.x * q1.x + k1.y * q1.y + k1.z * q1.z + k1.w * q1.w;
                    d2 += k2.x * q2.x + k2.y * q2.y + k2.z * q2.z + k2.w * q2.w;
                    d3 += k3.x * q3.x + k3.y * q3.y + k3.z * q3.z + k3.w * q3.w;
                }
            }
        }
        const bool ok = lane < len;
        sw[sg * 64 + lane] = ok ? d0 * scale : -1e30f;
        sw[1024 + sg * 64 + lane] = ok ? d1 * scale : -1e30f;
        sw[2048 + sg * 64 + lane] = ok ? d2 * scale : -1e30f;
        sw[3072 + sg * 64 + lane] = ok ? d3 * scale : -1e30f;
    }
    wave_sync();
    const int n = nseg * 64;
#pragma unroll
    for (int g = 0; g < 4; ++g) {
        float mx = -1e30f;
        for (int i = lane; i < n; i += 64) mx = fmaxf(mx, sw[g * 1024 + i]);
        mx = wave_max(mx);
        float sm = 0.f;
        for (int i = lane; i < n; i += 64) { const float v = sw[g * 1024 + i]; sm += (v > -1e29f) ? expf(v - mx) : 0.f; }
        sm = wave_sum(sm);
        const float inv = sm > 0.f ? 1.f / sm : 0.f;
        for (int i = lane; i < n; i += 64) { const float v = sw[g * 1024 + i]; sw[g * 1024 + i] = (v > -1e29f) ? expf(v - mx) * inv : 0.f; }
    }
    wave_sync();
    float o[4][2];
#pragma unroll
    for (int g = 0; g < 4; ++g) { o[g][0] = 0.f; o[g][1] = 0.f; }
    for (int sg = 0; sg < nseg; ++sg) {
        const int start = segs[sg], len = segs[16 + sg];
        for (int l = 0; l < len; ++l) {
            const float* vp = Vb + (size_t)(start + l) * ld;
            if (SHARED) {
                const float v0 = vp[lane], v1 = vp[lane + 64];
#pragma unroll
                for (int g = 0; g < 4; ++g) { const float p = sw[g * 1024 + sg * 64 + l]; o[g][0] += p * v0; o[g][1] += p * v1; }
            } else {
#pragma unroll
                for (int g = 0; g < 4; ++g) { const float p = sw[g * 1024 + sg * 64 + l]; o[g][0] += p * vp[g * 128 + lane]; o[g][1] += p * vp[g * 128 + lane + 64]; }
            }
        }
    }
#pragma unroll
    for (int g = 0; g < 4; ++g) { optr[g * 128 + lane] = o[g][0]; optr[g * 128 + lane + 64] = o[g][1]; }
}

namespace g8 {
constexpr int BM = 256, BK = 64, HALF = 128, HTB = HALF * BK * 2, STAGE_BYTES = 8 * HTB;
constexpr int KK = 2048;
typedef float f32x4 __attribute__((ext_vector_type(4)));
__device__ __forceinline__ int lds_byte(int r, int c) { return r * 128 + ((((c >> 3) ^ (r >> 1)) & 7) << 4) + (c & 7) * 2; }
__device__ __forceinline__ void stage_rc(int b, int& R, int& C) { R = b >> 7; C = ((((b >> 4) ^ (R >> 1)) & 7)) * 8; }
__device__ __forceinline__ int perm32(int rho) { const int n = rho >> 4, i = rho & 15; return 8 * (i >> 2) + 4 * n + (i & 3); }

typedef int i32x4 __attribute__((ext_vector_type(4)));
typedef unsigned u32x2 __attribute__((ext_vector_type(2)));
typedef unsigned u32x4 __attribute__((ext_vector_type(4)));
template <bool I8> struct AccSel { typedef f32x4 T; };
template <> struct AccSel<true> { typedef i32x4 T; };
__device__ __forceinline__ f32x4 mma16(i32x4 a, i32x4 b, f32x4 c) { return __builtin_amdgcn_mfma_f32_16x16x32_f16(*reinterpret_cast<h8*>(&a), *reinterpret_cast<h8*>(&b), c, 0, 0, 0); }
__device__ __forceinline__ i32x4 mma16(i32x4 a, i32x4 b, i32x4 c) { return __builtin_amdgcn_mfma_i32_16x16x64_i8(a, b, c, 0, 0, 0); }
struct Unit { int m0, n0, e, cnt, rbase; };
constexpr int EP_OFF = STAGE_BYTES + 2048, EP_LD = 528, EP_GRP = 16 * EP_LD;
constexpr int CONST_OFF = EP_OFF + 18432;
__device__ __forceinline__ void cdma(LAS unsigned char* lds, int region, int idx, const void* src) { __builtin_amdgcn_global_load_lds((const unsigned*)src, (LAS unsigned*)(lds + CONST_OFF + region * 1024 + idx * 256), 4, 0, 0); }
__device__ __forceinline__ void ep_sync() { asm volatile("s_waitcnt lgkmcnt(0)" ::: "memory"); __builtin_amdgcn_s_barrier(); asm volatile("" ::: "memory"); }
__device__ __forceinline__ int ep_tid() { int tz = threadIdx.x; asm volatile("" : "+v"(tz)); return tz; }
__device__ __forceinline__ h8 cvt8(f32x4 a, f32x4 b) { h8 o; o[0] = (_Float16)a[0]; o[1] = (_Float16)a[1]; o[2] = (_Float16)a[2]; o[3] = (_Float16)a[3]; o[4] = (_Float16)b[0]; o[5] = (_Float16)b[1]; o[6] = (_Float16)b[2]; o[7] = (_Float16)b[3]; return o; }

__device__ __forceinline__ void tile_order(int L, int nM, int nN, int& pm, int& pn) {
    const int nwg = nM * nN; int wgid = L;
    { const int q = nwg / 8, r = nwg % 8, xcd = wgid % 8, off = wgid / 8; wgid = (xcd < r ? xcd * (q + 1) : r * (q + 1) + (xcd - r) * q) + off; }
    const int nig = 8 * nN, gid = wgid / nig, fm = gid * 8, gsz = (nM - fm) < 8 ? (nM - fm) : 8;
    pm = fm + ((wgid % nig) % gsz); pn = (wgid % nig) / gsz;
}

template <class Prob>
__device__ __forceinline__ void gemm_phase(LAS unsigned char* lds, const Prob& P) {
    const int tid = threadIdx.x, wid = __builtin_amdgcn_readfirstlane(tid >> 6), lane = tid & 63, wr = wid >> 2, wc = wid & 3, fr = lane & 15, fq = lane >> 4;
    constexpr int nt = Prob::NT; constexpr size_t KS2 = Prob::KS2; constexpr unsigned ROWB = Prob::ROWB; constexpr bool I8 = Prob::I8;
    int sR[2], sC2[2]; unsigned voffB[2];
#pragma unroll
    for (int i = 0; i < 2; ++i) { int R, C; stage_rc(tid * 16 + i * 8192, R, C); sR[i] = R; sC2[i] = C * 2; const int Rb = Prob::PERM ? ((R & ~31) + perm32(R & 31)) : R; voffB[i] = (unsigned)Rb * ROWB + (unsigned)C * 2u; }
    const size_t kstep = (size_t)(BK * 2);
    const size_t hstep = (size_t)HALF * ROWB;
    const unsigned ldsw = (unsigned)wid * 1024u;
    const int aoff = lds_byte(wr * 64 + fr, fq * 8), boff = lds_byte(wc * 32 + fr, fq * 8), aoff1 = lds_byte(wr * 64 + fr, fq * 8 + 32), boff1 = lds_byte(wc * 32 + fr, fq * 8 + 32);
#define G8_SA(b, h) (((b) * 2 + (h)) * HTB)
#define G8_SB(b, h) ((4 + (b) * 2 + (h)) * HTB)
#define G8_STAGE(bufoff, gbase, voff) do { _Pragma("unroll") for (int _i = 0; _i < 2; ++_i) \
        __builtin_amdgcn_global_load_lds((const unsigned*)((const char*)(gbase) + (voff)[_i]), (LAS unsigned*)(lds + (bufoff) + ldsw + _i * 8192), 16, 0, 0); } while (0)
#define G8_LDA(dst, b, h) do { _Pragma("unroll") for (int m = 0; m < 4; ++m) _Pragma("unroll") for (int k = 0; k < 2; ++k) dst[m][k] = *(const LAS i32x4*)(lds + G8_SA(b, h) + (k ? aoff1 : aoff) + m * 2048); } while (0)
#define G8_LDB(dst, b, h) do { _Pragma("unroll") for (int n = 0; n < 2; ++n) _Pragma("unroll") for (int k = 0; k < 2; ++k) dst[n][k] = *(const LAS i32x4*)(lds + G8_SB(b, h) + (k ? boff1 : boff) + n * 2048); } while (0)
#define G8_MMA(ai, bj, At, Bt) do { __builtin_amdgcn_s_setprio(1); _Pragma("unroll") for (int m = 0; m < 4; ++m) _Pragma("unroll") for (int n = 0; n < 2; ++n) _Pragma("unroll") for (int k = 0; k < 2; ++k) \
        acc[ai][bj][m][n] = mma16(Bt[n][k], At[m][k], acc[ai][bj][m][n]); __builtin_amdgcn_s_setprio(0); } while (0)
#define G8_WAIT_V(n) asm volatile("s_waitcnt vmcnt(" #n ")" ::: "memory")
#define G8_WAIT_L(n) asm volatile("s_waitcnt lgkmcnt(" #n ")" ::: "memory")
#define G8_BAR __builtin_amdgcn_s_barrier()
#define G8_SCHED __builtin_amdgcn_sched_barrier(0)
    Unit cur, nxt; int ui = 0;
    if (!P.next(0, cur)) return;
    typedef typename AccSel<I8>::T AccT;
    AccT acc[2][2][4][2];
#pragma unroll
    for (int a = 0; a < 2; ++a)
#pragma unroll
        for (int b = 0; b < 2; ++b)
#pragma unroll
            for (int m = 0; m < 4; ++m)
#pragma unroll
                for (int n = 0; n < 2; ++n) acc[a][b][m][n] = AccT{};
    i32x4 At[4][2], B0[2][2], B1[2][2];
    unsigned vc[2][2], vn[2][2];
    P.a_offs(cur, sR, sC2, vc);
    const char* const Ab = P.a_base();
    const char* cB = P.b_base(cur);
    G8_STAGE(G8_SB(0, 0), cB, voffB); G8_STAGE(G8_SA(0, 0), Ab, vc[0]); G8_STAGE(G8_SB(0, 1), cB + hstep, voffB); G8_STAGE(G8_SA(0, 1), Ab, vc[1]);
    if (wr == 1) G8_BAR;
    G8_WAIT_V(4); G8_BAR;
    G8_STAGE(G8_SB(1, 0), cB + kstep, voffB); G8_STAGE(G8_SA(1, 0), Ab + kstep, vc[0]); G8_STAGE(G8_SB(1, 1), cB + hstep + kstep, voffB);
    G8_WAIT_V(6); G8_BAR;
    for (;;) {
        const bool has_next = P.next(ui + 1, nxt);
        const char* nB = cB;
        if (has_next) { if constexpr (Prob::LD) P.list_dma(nxt, lds, wid, lane); else P.a_offs(nxt, sR, sC2, vn); nB = P.b_base(nxt); }
        else { vn[0][0] = vc[0][0]; vn[0][1] = vc[0][1]; vn[1][0] = vc[1][0]; vn[1][1] = vc[1][1]; }
        for (int t = 0; t < nt; t += 2) {
            const bool last = (t == nt - 2);
            if constexpr (Prob::CD) { if (last) P.const_dma(cur, lds, wid, lane); }
            if constexpr (Prob::LD) { if (last && has_next) P.a_offs_lds(nxt, sR, sC2, vn, lds); }
            const char* a1 = Ab + (size_t)(t >> 1) * KS2 + kstep;
            const char* a2 = last ? Ab : Ab + (size_t)((t + 2) >> 1) * KS2; const char* b2 = last ? nB : cB + (size_t)(t + 2) * kstep;
            const char* a3 = a2 + kstep; const char* b3 = b2 + kstep;
            unsigned o2[2][2];
            o2[0][0] = last ? vn[0][0] : vc[0][0]; o2[0][1] = last ? vn[0][1] : vc[0][1]; o2[1][0] = last ? vn[1][0] : vc[1][0]; o2[1][1] = last ? vn[1][1] : vc[1][1];
            G8_LDB(B0, 0, 0); G8_SCHED; G8_LDA(At, 0, 0); G8_STAGE(G8_SA(1, 1), a1, vc[1]);
            G8_WAIT_L(8); G8_BAR; G8_WAIT_L(0); G8_MMA(0, 0, At, B0); G8_BAR; G8_SCHED;
            G8_LDB(B1, 0, 1); G8_STAGE(G8_SB(0, 0), b2, voffB);
            G8_BAR; G8_WAIT_L(0); G8_MMA(0, 1, At, B1); G8_BAR;
            G8_LDA(At, 0, 1); G8_STAGE(G8_SA(0, 0), a2, o2[0]);
            G8_BAR; G8_WAIT_L(0); G8_MMA(1, 0, At, B0); G8_BAR; G8_SCHED;
            G8_STAGE(G8_SB(0, 1), b2 + hstep, voffB);
            G8_WAIT_V(6); G8_BAR; G8_MMA(1, 1, At, B1); G8_BAR;
            G8_LDB(B0, 1, 0); G8_SCHED; G8_LDA(At, 1, 0); G8_STAGE(G8_SA(0, 1), a2, o2[1]);
            G8_WAIT_L(8); G8_BAR; G8_WAIT_L(0); G8_MMA(0, 0, At, B0); G8_BAR; G8_SCHED;
            G8_LDB(B1, 1, 1); G8_STAGE(G8_SB(1, 0), b3, voffB);
            G8_BAR; G8_WAIT_L(0); G8_MMA(0, 1, At, B1); G8_BAR;
            G8_LDA(At, 1, 1); G8_STAGE(G8_SA(1, 0), a3, o2[0]);
            G8_BAR; G8_WAIT_L(0); G8_MMA(1, 0, At, B0); G8_BAR; G8_SCHED;
            G8_STAGE(G8_SB(1, 1), b3 + hstep, voffB);
            G8_WAIT_V(6); G8_BAR; G8_MMA(1, 1, At, B1); G8_BAR;
        }
        P.epi(acc, cur, wr, wc, fr, fq, lds);
        if (!has_next) break;
#pragma unroll
        for (int a = 0; a < 2; ++a)
#pragma unroll
            for (int b = 0; b < 2; ++b)
#pragma unroll
                for (int m = 0; m < 4; ++m)
#pragma unroll
                    for (int n = 0; n < 2; ++n) acc[a][b][m][n] = AccT{};
        cur = nxt; cB = nB; ++ui;
        vc[0][0] = vn[0][0]; vc[0][1] = vn[0][1]; vc[1][0] = vn[1][0]; vc[1][1] = vn[1][1];
    }
    G8_WAIT_V(0);
    if (wr == 0) G8_BAR;
    G8_BAR;
#undef G8_SA
#undef G8_SB
#undef G8_STAGE
#undef G8_LDA
#undef G8_LDB
#undef G8_MMA
#undef G8_WAIT_V
#undef G8_WAIT_L
#undef G8_BAR
#undef G8_SCHED
}

struct ProbInF {
    static constexpr bool LD = false;
    static constexpr bool CD = false;
    static constexpr unsigned ROWB = 4096; static constexpr bool I8 = false;
    static constexpr int NT = 32; static constexpr size_t KS2 = 256;
    static constexpr bool PERM = true;
    const _Float16* A; _Float16* C16; int G, c;
    __device__ __forceinline__ bool next(int i, Unit& u) const { const int L = i * G + c; if (L >= 64 * 5) return false;
        int pm, pn; tile_order(L, 64, 5, pm, pn); u.m0 = pm * 256; u.n0 = pn * 256; u.e = 0; u.cnt = 256; u.rbase = 0; return true; }
    __device__ __forceinline__ void a_offs(const Unit& u, const int (&R)[2], const int (&C2)[2], unsigned (&v)[2][2]) const {
#pragma unroll
        for (int h = 0; h < 2; ++h)
#pragma unroll
            for (int i = 0; i < 2; ++i) v[h][i] = (unsigned)(u.m0 + h * 128 + R[i]) * (unsigned)(KK * 2) + (unsigned)C2[i]; }
    __device__ __forceinline__ const char* a_base() const { return (const char*)A; }
    __device__ __forceinline__ const char* b_base(const Unit& u) const { return (const char*)A + (long long)(WS_WTIN - WS_X16) + (size_t)u.n0 * KK * 2; }
    __device__ __forceinline__ void epi(const f32x4 (&acc)[2][2][4][2], const Unit& u, int wr, int wc, int fr, int fq, LAS unsigned char* lds) const {
        LAS unsigned char* ep = lds + EP_OFF + wr * EP_GRP;
        const int tg = ep_tid() & 255, rrow = tg >> 4, ch = tg & 15;
        const int kvseg = (u.e == 0 && u.n0 >= 1024 && u.n0 < 2560) ? ((u.n0 - 1024) >> 8) : -1;
        _Float16* const Cb = (_Float16*)((char*)C16 + (u.e ? (long long)(WS_KVMEM16 - WS_PROJ16) : 0ll)); const int ldc = u.e ? 1024 : INW, nlim = u.e ? 1024 : INW, mb = u.e ? u.m0 - T_ : u.m0;
#pragma unroll
        for (int ai = 0; ai < 2; ++ai)
#pragma unroll
            for (int m = 0; m < 4; ++m) {
#pragma unroll
                for (int bj = 0; bj < 2; ++bj) *(LAS h8*)(ep + fr * EP_LD + (bj * 128 + wc * 32 + fq * 8) * 2) = cvt8(acc[ai][bj][m][0], acc[ai][bj][m][1]);
                ep_sync();
                const h8 x0 = *(const LAS h8*)(ep + rrow * EP_LD + ch * 32), x1 = *(const LAS h8*)(ep + rrow * EP_LD + ch * 32 + 16);
                const int grow = mb + ai * 128 + wr * 64 + m * 16 + rrow, gcol = u.n0 + ch * 16;
                if (kvseg >= 0) {
                    _Float16* dst = (_Float16*)((char*)C16 + (long long)(WS_KV16 - WS_PROJ16)) + ((size_t)(kvseg * B_ + (grow >> 11)) * 2 + (ch >> 3)) * KVSEG + (size_t)(grow & (S_ - 1)) * 128 + (ch & 7) * 16;
                    *(h8*)dst = x0; *(h8*)(dst + 8) = x1;
                } else {
                    if (gcol < nlim) *(h8*)(Cb + (size_t)grow * ldc + gcol) = x0;
                    if (gcol + 8 < nlim) *(h8*)(Cb + (size_t)grow * ldc + gcol + 8) = x1; }
                ep_sync();
            } }
};
struct ProbIn8 {
    static constexpr bool LD = false;
    static constexpr bool CD = true;
    static constexpr unsigned ROWB = 2048; static constexpr bool I8 = true;
    static constexpr int NT = 16; static constexpr size_t KS2 = 256;
    static constexpr bool PERM = true;
    const signed char* A; _Float16* C16; const float* sa; int G, c;
    __device__ __forceinline__ bool next(int i, Unit& u) const { const int L = i * G + c; if (L >= 640 + 32) return false;
        if (L < 640) { int pm, pn; tile_order(L, 64, 10, pm, pn); u.m0 = pm * 256; u.n0 = 1280 + pn * 256; u.e = 0; }
        else { const int v = L - 640; u.m0 = T_ + (v & 7) * 256; u.n0 = (v >> 3) * 256; u.e = 1; }
        u.cnt = 256; u.rbase = 0; return true; }
    __device__ __forceinline__ void a_offs(const Unit& u, const int (&R)[2], const int (&C2)[2], unsigned (&v)[2][2]) const {
#pragma unroll
        for (int h = 0; h < 2; ++h)
#pragma unroll
            for (int i = 0; i < 2; ++i) v[h][i] = (unsigned)(u.m0 + h * 128 + R[i]) * 2048u + (unsigned)C2[i]; }
    __device__ __forceinline__ const char* a_base() const { return (const char*)A; }
    __device__ __forceinline__ const char* b_base(const Unit& u) const { return (const char*)A + (u.e ? (long long)(WS_Q8MKV - WS_X8) + (long long)u.n0 * 2048 : (long long)(WS_Q8IN - WS_X8) + (long long)(u.n0 - 1280) * 2048); }
    __device__ __forceinline__ void const_dma(const Unit& u, LAS unsigned char* lds, int wid, int lane) const {
        const int i4 = wid & 3;
        if (wid < 4) cdma(lds, 1, i4, (const float*)((const char*)A + (u.e ? (long long)(WS_SMKV - WS_X8) : (long long)(WS_SIN8 - WS_X8))) + (u.e ? u.n0 : u.n0 - 1280) + i4 * 64 + lane);
        else cdma(lds, 2, i4, sa + u.m0 + i4 * 64 + lane);
    }
    __device__ __forceinline__ void epi(const i32x4 (&acc)[2][2][4][2], const Unit& u, int wr, int wc, int fr, int fq, LAS unsigned char* lds) const {
        asm volatile("s_waitcnt vmcnt(16)" ::: "memory");
        ep_sync();
        LAS unsigned char* ep = lds + EP_OFF + wr * EP_GRP;
        const int tg = ep_tid() & 255, rrow = tg >> 4, ch = tg & 15;
        const int kvseg = (u.e == 0 && u.n0 >= 1024 && u.n0 < 2560) ? ((u.n0 - 1024) >> 8) : -1;
        _Float16* const Cb = (_Float16*)((char*)C16 + (u.e ? (long long)(WS_KVMEM16 - WS_PROJ16) : 0ll)); const int ldc = u.e ? 1024 : INW, nlim = u.e ? 1024 : INW, mb = u.e ? u.m0 - T_ : u.m0;
        const LAS float* cst = (const LAS float*)(lds + CONST_OFF);
        f32x4 s0[2], s1[2]; float srv[8];
#pragma unroll
        for (int bj = 0; bj < 2; ++bj) { const int col = bj * 128 + wc * 32 + fq * 8; s0[bj] = *(const LAS f32x4*)(cst + 256 + col); s1[bj] = *(const LAS f32x4*)(cst + 256 + col + 4); }
#pragma unroll
        for (int q = 0; q < 8; ++q) srv[q] = cst[512 + (q >> 2) * 128 + wr * 64 + (q & 3) * 16 + fr];
#pragma unroll
        for (int ai = 0; ai < 2; ++ai)
#pragma unroll
            for (int m = 0; m < 4; ++m) { const float sr = srv[ai * 4 + m];
#pragma unroll
                for (int bj = 0; bj < 2; ++bj) { const i32x4 i0 = acc[ai][bj][m][0], i1 = acc[ai][bj][m][1];
                    *(LAS h8*)(ep + fr * EP_LD + (bj * 128 + wc * 32 + fq * 8) * 2) = cvt8((f32x4){(float)i0[0], (float)i0[1], (float)i0[2], (float)i0[3]} * (s0[bj] * sr), (f32x4){(float)i1[0], (float)i1[1], (float)i1[2], (float)i1[3]} * (s1[bj] * sr)); }
                ep_sync();
                const h8 x0 = *(const LAS h8*)(ep + rrow * EP_LD + ch * 32), x1 = *(const LAS h8*)(ep + rrow * EP_LD + ch * 32 + 16);
                const int grow = mb + ai * 128 + wr * 64 + m * 16 + rrow, gcol = u.n0 + ch * 16;
                if (kvseg >= 0) {
                    _Float16* dst = (_Float16*)((char*)C16 + (long long)(WS_KV16 - WS_PROJ16)) + ((size_t)(kvseg * B_ + (grow >> 11)) * 2 + (ch >> 3)) * KVSEG + (size_t)(grow & (S_ - 1)) * 128 + (ch & 7) * 16;
                    *(h8*)dst = x0; *(h8*)(dst + 8) = x1;
                } else {
                    if (gcol < nlim) *(h8*)(Cb + (size_t)grow * ldc + gcol) = x0;
                    if (gcol + 8 < nlim) *(h8*)(Cb + (size_t)grow * ldc + gcol + 8) = x1; }
                ep_sync();
            } }
};
struct ProbOut {
    static constexpr bool LD = false;
    static constexpr bool CD = false;
    static constexpr unsigned ROWB = 2048; static constexpr bool I8 = true;
    static constexpr int NT = 16; static constexpr size_t KS2 = 256;
    static constexpr bool PERM = true;
    const signed char* A; const signed char* Bt; _Float16* C; const _Float16* X; const float* sa; const float* sw; int G, c;
    __device__ __forceinline__ bool next(int i, Unit& u) const { const int L = i * G + c; if (L >= 64 * 8) return false; int pm, pn; tile_order(L, 64, 8, pm, pn); u.m0 = pm * 256; u.n0 = pn * 256; u.e = 0; u.cnt = 256; u.rbase = 0; return true; }
    __device__ __forceinline__ void a_offs(const Unit& u, const int (&R)[2], const int (&C2)[2], unsigned (&v)[2][2]) const {
#pragma unroll
        for (int h = 0; h < 2; ++h)
#pragma unroll
            for (int i = 0; i < 2; ++i) v[h][i] = (unsigned)(u.m0 + h * 128 + R[i]) * 2048u + (unsigned)C2[i]; }
    __device__ __forceinline__ const char* a_base() const { return (const char*)A; }
    __device__ __forceinline__ const char* b_base(const Unit& u) const { return (const char*)(Bt + (size_t)u.n0 * 2048); }
    __device__ __forceinline__ void epi(const i32x4 (&acc)[2][2][4][2], const Unit& u, int wr, int wc, int fr, int fq, LAS unsigned char* lds) const {
        LAS unsigned char* ep = lds + EP_OFF + wr * EP_GRP;
        const int tg = ep_tid() & 255, rrow = tg >> 4, ch = tg & 15;
        f32x4 s0[2], s1[2]; float srv[8];
#pragma unroll
        for (int bj = 0; bj < 2; ++bj) { const int col = u.n0 + bj * 128 + wc * 32 + fq * 8; s0[bj] = *(const f32x4*)(sw + col); s1[bj] = *(const f32x4*)(sw + col + 4); }
#pragma unroll
        for (int q = 0; q < 8; ++q) srv[q] = sa[u.m0 + (q >> 2) * 128 + wr * 64 + (q & 3) * 16 + fr];
#pragma unroll
        for (int ai = 0; ai < 2; ++ai)
#pragma unroll
            for (int m = 0; m < 4; ++m) { const float sr = srv[ai * 4 + m];
#pragma unroll
                for (int bj = 0; bj < 2; ++bj) { const i32x4 i0 = acc[ai][bj][m][0], i1 = acc[ai][bj][m][1];
                    *(LAS h8*)(ep + fr * EP_LD + (bj * 128 + wc * 32 + fq * 8) * 2) = cvt8((f32x4){(float)i0[0], (float)i0[1], (float)i0[2], (float)i0[3]} * (s0[bj] * sr), (f32x4){(float)i1[0], (float)i1[1], (float)i1[2], (float)i1[3]} * (s1[bj] * sr)); }
                const size_t go = (size_t)(u.m0 + ai * 128 + wr * 64 + m * 16 + rrow) * 2048 + u.n0 + ch * 16;
                const h8 r0 = *(const h8*)(X + go), r1 = *(const h8*)(X + go + 8);
                ep_sync();
                const h8 x0 = *(const LAS h8*)(ep + rrow * EP_LD + ch * 32), x1 = *(const LAS h8*)(ep + rrow * EP_LD + ch * 32 + 16);
                h8 o0, o1;
#pragma unroll
                for (int q = 0; q < 8; ++q) { o0[q] = (_Float16)(DN_ALPHA * (float)r0[q] + (float)x0[q]); o1[q] = (_Float16)(DN_ALPHA * (float)r1[q] + (float)x1[q]); }
                *(h8*)(C + go) = o0; *(h8*)(C + go + 8) = o1;
                ep_sync();
            } }
};
struct ProbCmp {
    static constexpr bool LD = false;
    static constexpr bool CD = false;
    static constexpr unsigned ROWB = 4096; static constexpr bool I8 = false;
    static constexpr int NT = 8; static constexpr size_t KS2 = 256;
    static constexpr bool PERM = false;
    const _Float16* A; const _Float16* Bt; float* C; int G, c;
    __device__ __forceinline__ bool next(int i, Unit& u) const { const int L = i * G + c; if (L >= 128) return false;
        u.e = L >> 6; const int r = L & 63; u.rbase = r & 3; u.n0 = ((r >> 2) & 1) * 256; u.m0 = (r >> 3) * 256; u.cnt = 256; return true; }
    __device__ __forceinline__ void a_offs(const Unit& u, const int (&R)[2], const int (&C2)[2], unsigned (&v)[2][2]) const {
#pragma unroll
        for (int h = 0; h < 2; ++h)
#pragma unroll
            for (int i = 0; i < 2; ++i) { const int row = u.m0 + h * 128 + R[i], kvh = row & 1, bj = row >> 1, b = bj >> 7, j = bj & 127;
                v[h][i] = (unsigned)((((u.e * B_ + b) * 2 + kvh) * S_ + 16 * j + 4 * u.rbase) * 128) * 2u + (unsigned)C2[i]; } }
    __device__ __forceinline__ const char* a_base() const { return (const char*)A; }
    __device__ __forceinline__ const char* b_base(const Unit& u) const { return (const char*)(Bt + ((size_t)u.e * 512 + u.n0) * KK + u.rbase * 512); }
    __device__ __forceinline__ void epi(const f32x4 (&acc)[2][2][4][2], const Unit& u, int wr, int wc, int fr, int fq, LAS unsigned char*) const {
        float* base = C + ((size_t)(u.e * 4 + u.rbase) * 2048) * 512;
#pragma unroll
        for (int ai = 0; ai < 2; ++ai)
#pragma unroll
            for (int m = 0; m < 4; ++m) { const int row = u.m0 + ai * 128 + wr * 64 + m * 16 + fr;
#pragma unroll
                for (int bj = 0; bj < 2; ++bj)
#pragma unroll
                    for (int n = 0; n < 2; ++n) { const int col = u.n0 + bj * 128 + wc * 32 + n * 16 + fq * 4;
                        *(f32x4*)(base + (size_t)row * 512 + col) = acc[ai][bj][m][n]; } } }
};
struct MoeTab { const LAS int* t; int NT;
    __device__ __forceinline__ bool find_i(int i, Unit& u) const {
        const LAS int* q = t + 128 + 8 * i;
        if (__builtin_amdgcn_readfirstlane(q[5]) == 0) return false;
        u.e = __builtin_amdgcn_readfirstlane(q[0]); u.m0 = __builtin_amdgcn_readfirstlane(q[1]); u.n0 = __builtin_amdgcn_readfirstlane(q[2]); u.cnt = __builtin_amdgcn_readfirstlane(q[3]); u.rbase = __builtin_amdgcn_readfirstlane(q[4]); return true; } };
__device__ __forceinline__ void moe_build(LAS int* t, int G, int vcu) {
    const int i = threadIdx.x;
    if (i < 40) { const int L = i * G + vcu; LAS int* q = t + 128 + 8 * i;
        if (L >= t[98]) q[5] = 0;
        else { int e = 0; for (; e < NE - 1; ++e) { if (L < t[32 + e + 1]) break; }
            const int ub = t[32 + e], cn = t[e], rs = t[65 + e]; const int nm = (cn + 255) >> 8, v = L - ub, mt = v % nm, ntile = v / nm;
            q[0] = e; q[1] = mt * 256; q[2] = ntile * 256; q[3] = min(256, cn - mt * 256); q[4] = rs; q[5] = 1; } }
}
struct ProbGu {
    static constexpr int NT = 16; static constexpr size_t KS2 = 256; static constexpr unsigned ROWB = 2048; static constexpr bool I8 = true;
    static constexpr bool PERM = true; static constexpr bool CD = true; static constexpr bool LD = true;
    const signed char* A; const signed char* Bt; unsigned char* act; const float* bgu; const int* list; const float* sa; const float* sw; MoeTab tab; int G, vcu;
    __device__ __forceinline__ bool next(int i, Unit& u) const { return tab.find_i(i, u); }
    __device__ __forceinline__ void a_offs(const Unit& u, const int (&R)[2], const int (&C2)[2], unsigned (&v)[2][2]) const {
#pragma unroll
        for (int h = 0; h < 2; ++h)
#pragma unroll
            for (int i = 0; i < 2; ++i) { int r = h * 128 + R[i]; r = r < u.cnt ? r : 0; const int a = list[(size_t)u.e * T_ + u.m0 + r]; v[h][i] = (unsigned)(a >> 2) * 2048u + (unsigned)C2[i]; } }
    __device__ __forceinline__ const char* a_base() const { return (const char*)A; }
    __device__ __forceinline__ const char* b_base(const Unit& u) const { return (const char*)(Bt + ((size_t)u.e * 4096 + u.n0) * 2048); }
    __device__ __forceinline__ void list_dma(const Unit& u, LAS unsigned char* lds, int wid, int lane) const {
        if (wid < 4) { const int r = wid * 64 + lane; cdma(lds, 4, wid, list + (size_t)u.e * T_ + u.m0 + (r < u.cnt ? r : 0)); } }
    __device__ __forceinline__ void a_offs_lds(const Unit& u, const int (&R)[2], const int (&C2)[2], unsigned (&v)[2][2], LAS unsigned char* lds) const {
        const LAS int* lst = (const LAS int*)(lds + CONST_OFF + 4 * 1024);
#pragma unroll
        for (int h = 0; h < 2; ++h)
#pragma unroll
            for (int i = 0; i < 2; ++i) { const int a = lst[h * 128 + R[i]]; v[h][i] = (unsigned)(a >> 2) * 2048u + (unsigned)C2[i]; } }
    __device__ __forceinline__ void const_dma(const Unit& u, LAS unsigned char* lds, int wid, int lane) const {
        if (wid < 4) { cdma(lds, 0, wid, bgu + (size_t)u.e * 4096 + u.n0 + wid * 64 + lane); const int r = wid * 64 + lane; cdma(lds, 2, wid, sa + (size_t)u.e * T_ + u.m0 + (r < u.cnt ? r : 0)); }
        else cdma(lds, 1, wid - 4, sw + (size_t)u.e * 4096 + u.n0 + (wid - 4) * 64 + lane);
    }
    __device__ __forceinline__ void epi(const i32x4 (&acc)[2][2][4][2], const Unit& u, int wr, int wc, int fr, int fq, LAS unsigned char* lds) const {
        asm volatile("s_waitcnt vmcnt(16)" ::: "memory");
        ep_sync();
        const LAS float* cst = (const LAS float*)(lds + CONST_OFF);
        const int tg = ep_tid() & 255, rrow = tg >> 4, ch = tg & 15;
        f32x4 b0[2], b1[2], s0[2], s1[2];
#pragma unroll
        for (int bj = 0; bj < 2; ++bj) { const int col = bj * 128 + wc * 32 + fq * 8;
            b0[bj] = *(const LAS f32x4*)(cst + col); b1[bj] = *(const LAS f32x4*)(cst + col + 4); s0[bj] = *(const LAS f32x4*)(cst + 256 + col); s1[bj] = *(const LAS f32x4*)(cst + 256 + col + 4); }
        float srv[8];
#pragma unroll
        for (int q = 0; q < 8; ++q) srv[q] = cst[512 + (q >> 2) * 128 + wr * 64 + (q & 3) * 16 + fr];
        LAS unsigned char* ep2 = lds + EP_OFF + wr * (2 * 4608);
#define GU_WRITE(st) do { const int ai_ = (st) >> 1, mp_ = (st) & 1; LAS unsigned char* eb = ep2 + ((st) & 1) * 4608; \
            _Pragma("unroll") for (int mm = 0; mm < 2; ++mm) { const int m_ = mp_ * 2 + mm; const float sr = srv[ai_ * 4 + m_]; \
                _Pragma("unroll") for (int bj = 0; bj < 2; ++bj) { const i32x4 i0 = acc[ai_][bj][m_][0], i1 = acc[ai_][bj][m_][1]; \
                    const f32x4 v0 = (f32x4){(float)i0[0], (float)i0[1], (float)i0[2], (float)i0[3]} * (s0[bj] * sr) + b0[bj], v1 = (f32x4){(float)i1[0], (float)i1[1], (float)i1[2], (float)i1[3]} * (s1[bj] * sr) + b1[bj]; \
                    *(LAS unsigned*)(eb + (mm * 16 + fr) * 144 + (bj * 64 + wc * 16 + fq * 4)) = pk4_fp8(swiglu_fast(v0[0], v0[1]), swiglu_fast(v0[2], v0[3]), swiglu_fast(v1[0], v1[1]), swiglu_fast(v1[2], v1[3])); } } } while (0)
        GU_WRITE(0);
        ep_sync();
#pragma unroll
        for (int st = 0; st < 4; ++st) {
            if (st + 1 < 4) GU_WRITE(st + 1);
#pragma unroll
            for (int mm = 0; mm < 2; ++mm) { const u32x2 x0 = *(const LAS u32x2*)(ep2 + (st & 1) * 4608 + (mm * 16 + rrow) * 144 + ch * 8);
                const int rr = (st >> 1) * 128 + wr * 64 + ((st & 1) * 2 + mm) * 16 + rrow;
                if (rr < u.cnt) *(u32x2*)(act + (size_t)(u.rbase + u.m0 + rr) * 2048 + (u.n0 >> 1) + ch * 8) = x0; }
            ep_sync();
        }
#undef GU_WRITE
    }
};
struct ProbDn {
    static constexpr bool LD = false;
    static constexpr int NT = 16; static constexpr size_t KS2 = 256; static constexpr unsigned ROWB = 2048; static constexpr bool I8 = true;
    static constexpr bool PERM = true; static constexpr bool CD = true;
    const signed char* A; const signed char* Bt; unsigned char* y; const float* bdn; const int* list; const float* gate; const float* sa; const float* sw; MoeTab tab; int G, vcu;
    __device__ __forceinline__ bool next(int i, Unit& u) const { return tab.find_i(i, u); }
    __device__ __forceinline__ void a_offs(const Unit& u, const int (&R)[2], const int (&C2)[2], unsigned (&v)[2][2]) const {
#pragma unroll
        for (int h = 0; h < 2; ++h)
#pragma unroll
            for (int i = 0; i < 2; ++i) v[h][i] = (unsigned)(u.rbase + u.m0 + h * 128 + R[i]) * 2048u + (unsigned)C2[i]; }
    __device__ __forceinline__ const char* a_base() const { return (const char*)A; }
    __device__ __forceinline__ const char* b_base(const Unit& u) const { return (const char*)(Bt + ((size_t)u.e * 2048 + u.n0) * 2048); }
    __device__ __forceinline__ void const_dma(const Unit& u, LAS unsigned char* lds, int wid, int lane) const {
        const int i4 = wid & 3, r = i4 * 64 + lane, rc = r < u.cnt ? r : 0;
        if (wid < 4) { cdma(lds, 0, i4, bdn + (size_t)u.e * 2048 + u.n0 + r); cdma(lds, 2, i4, sa + u.rbase + u.m0 + rc); cdma(lds, 4, i4, list + (size_t)u.e * T_ + u.m0 + rc); }
        else { cdma(lds, 1, i4, sw + (size_t)u.e * 2048 + u.n0 + r); cdma(lds, 3, i4, gate + (size_t)u.e * T_ + u.m0 + rc); }
    }
    __device__ __forceinline__ void epi(const i32x4 (&acc)[2][2][4][2], const Unit& u, int wr, int wc, int fr, int fq, LAS unsigned char* lds) const {
        asm volatile("s_waitcnt vmcnt(16)" ::: "memory");
        ep_sync();
        const LAS float* cst = (const LAS float*)(lds + CONST_OFF);
        LAS unsigned char* ep = lds + EP_OFF + wr * (2 * 4352);
        const int tg = ep_tid() & 255, rrow = tg >> 4, ch = tg & 15;
        f32x4 b0[2], b1[2], s0[2], s1[2];
#pragma unroll
        for (int bj = 0; bj < 2; ++bj) { const int col = bj * 128 + wc * 32 + fq * 8;
            b0[bj] = *(const LAS f32x4*)(cst + col); b1[bj] = *(const LAS f32x4*)(cst + col + 4); s0[bj] = *(const LAS f32x4*)(cst + 256 + col); s1[bj] = *(const LAS f32x4*)(cst + 256 + col + 4); }
        float gv[8], srv[8]; int a2v[8];
#pragma unroll
        for (int q = 0; q < 8; ++q) { const int rl = (q >> 2) * 128 + wr * 64 + (q & 3) * 16 + fr; gv[q] = cst[768 + rl]; srv[q] = cst[512 + rl];
            a2v[q] = ((const LAS int*)cst)[1024 + (q >> 2) * 128 + wr * 64 + (q & 3) * 16 + rrow]; }
#define DN_WRITE(st) do { const int ai_ = (st) >> 2, m_ = (st) & 3; const float g = gv[st] * 16.f, sr = srv[st]; LAS unsigned char* eb = ep + ((st) & 1) * 4352; \
            _Pragma("unroll") for (int bj = 0; bj < 2; ++bj) { const i32x4 i0 = acc[ai_][bj][m_][0], i1 = acc[ai_][bj][m_][1]; \
                const f32x4 v0 = ((f32x4){(float)i0[0], (float)i0[1], (float)i0[2], (float)i0[3]} * (s0[bj] * sr) + b0[bj]) * g, v1 = ((f32x4){(float)i1[0], (float)i1[1], (float)i1[2], (float)i1[3]} * (s1[bj] * sr) + b1[bj]) * g; \
                u32x2 o; o[0] = pk4_fp8(__builtin_amdgcn_fmed3f(v0[0], -440.f, 440.f), __builtin_amdgcn_fmed3f(v0[1], -440.f, 440.f), __builtin_amdgcn_fmed3f(v0[2], -440.f, 440.f), __builtin_amdgcn_fmed3f(v0[3], -440.f, 440.f)); o[1] = pk4_fp8(__builtin_amdgcn_fmed3f(v1[0], -440.f, 440.f), __builtin_amdgcn_fmed3f(v1[1], -440.f, 440.f), __builtin_amdgcn_fmed3f(v1[2], -440.f, 440.f), __builtin_amdgcn_fmed3f(v1[3], -440.f, 440.f)); \
                *(LAS u32x2*)(eb + fr * 272 + (bj * 128 + wc * 32 + fq * 8)) = o; } } while (0)
        DN_WRITE(0);
        ep_sync();
#pragma unroll
        for (int st = 0; st < 8; ++st) {
            if (st + 1 < 8) DN_WRITE(st + 1);
            const int rr = (st >> 2) * 128 + wr * 64 + (st & 3) * 16 + rrow;
            const u32x4 x0 = *(const LAS u32x4*)(ep + (st & 1) * 4352 + rrow * 272 + ch * 16);
            if (rr < u.cnt) *(u32x4*)(y + (size_t)a2v[st] * 2048 + u.n0 + ch * 16) = x0;
            ep_sync();
        }
#undef DN_WRITE
    }
};
}

namespace at8 {
typedef float f32x16 __attribute__((ext_vector_type(16)));
typedef short s16x4 __attribute__((ext_vector_type(4)));
typedef unsigned u32x4 __attribute__((ext_vector_type(4)));
constexpr int SHM_K = 64 * 128 * 2, SHM_V = 64 * 128 * 2, SLOT = SHM_K + SHM_V;
constexpr int NSLOT = 4;
constexpr int LDS_WS = NSLOT * SLOT;
constexpr int LDS_END = LDS_WS + 8 * 64 * 4;
constexpr float CEXP = ATT_SCALE * 1.4426950408889634f;
constexpr float THR_RAW = 8.f / ATT_SCALE;
#define AT_KSWZ(row, colB) ((row) * 256 + ((colB) ^ (((row) & 7) << 4)))
#define AT_SBAR() __builtin_amdgcn_sched_barrier(0)
__device__ __forceinline__ int crow(int r, int hi) { return (r & 3) + 8 * (r >> 2) + 4 * hi; }
__device__ __forceinline__ unsigned cvtpk(float lo, float hi) { auto v = __builtin_amdgcn_cvt_pkrtz(lo, hi); return *reinterpret_cast<unsigned*>(&v); }
__device__ __forceinline__ int v_st(int k, int c) { const int kk = (k & ~0xC) | ((k & 4) << 1) | ((k & 8) >> 1); return ((kk >> 3) * 4 + (c >> 5)) * 512 + ((kk & 7) * 32 + (c & 31)) * 2; }
__device__ __forceinline__ int v_rd_base(int lane) { return ((lane & 3) << 3) | (((lane >> 2) & 3) << 6) | (((lane >> 4) & 1) << 5) | (((lane >> 5) & 1) << 8); }
constexpr int v_rd_off(int d0, int ks, int half) { return d0 * 512 + ks * 4096 + half * 2048; }
template <int OFF> __device__ __forceinline__ s16x4 tr_read(int vb) { s16x4 r; asm volatile("ds_read_b64_tr_b16 %0, %1 offset:%2" : "=&v"(r) : "v"(vb), "i"(OFF) : "memory"); return r; }
__device__ __forceinline__ h8 mk8(s16x4 l, s16x4 h) { typedef short s16x8 __attribute__((ext_vector_type(8))); s16x8 w = {l[0], l[1], l[2], l[3], h[0], h[1], h[2], h[3]}; return *reinterpret_cast<h8*>(&w); }
template <int D0> __device__ __forceinline__ void pv_one(f32x16& od, int vb, h8 pa0, h8 pa1, h8 pa2, h8 pa3) {
    const s16x4 l0 = tr_read<v_rd_off(D0, 0, 0)>(vb), h0 = tr_read<v_rd_off(D0, 0, 1)>(vb), l1 = tr_read<v_rd_off(D0, 1, 0)>(vb), h1 = tr_read<v_rd_off(D0, 1, 1)>(vb);
    const s16x4 l2 = tr_read<v_rd_off(D0, 2, 0)>(vb), h2 = tr_read<v_rd_off(D0, 2, 1)>(vb), l3 = tr_read<v_rd_off(D0, 3, 0)>(vb), h3 = tr_read<v_rd_off(D0, 3, 1)>(vb);
    asm volatile("s_waitcnt lgkmcnt(0)" ::: "memory"); AT_SBAR();
    od = __builtin_amdgcn_mfma_f32_32x32x16_f16(pa0, mk8(l0, h0), od, 0, 0, 0);
    od = __builtin_amdgcn_mfma_f32_32x32x16_f16(pa1, mk8(l1, h1), od, 0, 0, 0);
    od = __builtin_amdgcn_mfma_f32_32x32x16_f16(pa2, mk8(l2, h2), od, 0, 0, 0);
    od = __builtin_amdgcn_mfma_f32_32x32x16_f16(pa3, mk8(l3, h3), od, 0, 0, 0);
}
__device__ __forceinline__ void pv_d0(f32x16 (&o)[4], int vb, h8 pa0, h8 pa1, h8 pa2, h8 pa3) {
    pv_one<0>(o[0], vb, pa0, pa1, pa2, pa3); pv_one<1>(o[1], vb, pa0, pa1, pa2, pa3); pv_one<2>(o[2], vb, pa0, pa1, pa2, pa3); pv_one<3>(o[3], vb, pa0, pa1, pa2, pa3);
}
__device__ __forceinline__ void qkt(f32x16& p0, f32x16& p1, const char* Ks, const h8 (&qr)[8], int r32, int hi) {
    p0 = f32x16{}; p1 = f32x16{};
#pragma unroll
    for (int d0 = 0; d0 < 8; ++d0) { const int cb = (d0 * 16 + hi * 8) * 2;
        const h8 b0 = *reinterpret_cast<const h8*>(Ks + AT_KSWZ(r32, cb));
        const h8 b1 = *reinterpret_cast<const h8*>(Ks + AT_KSWZ(32 + r32, cb));
        p0 = __builtin_amdgcn_mfma_f32_32x32x16_f16(b0, qr[d0], p0, 0, 0, 0);
        p1 = __builtin_amdgcn_mfma_f32_32x32x16_f16(b1, qr[d0], p1, 0, 0, 0); }
}
__device__ __forceinline__ void pack_p(const f32x16& p0, const f32x16& p1, h8& pa0, h8& pa1, h8& pa2, h8& pa3) {
#define AT_PK4(P, BASE, OUT) do { unsigned a0 = cvtpk(P[BASE + 0], P[BASE + 1]), a1 = cvtpk(P[BASE + 2], P[BASE + 3]); \
    unsigned b0 = cvtpk(P[BASE + 4], P[BASE + 5]), b1 = cvtpk(P[BASE + 6], P[BASE + 7]); \
    auto r0 = __builtin_amdgcn_permlane32_swap(a0, b0, false, false); auto r1 = __builtin_amdgcn_permlane32_swap(a1, b1, false, false); \
    u32x4 w = {r0[0], r1[0], r0[1], r1[1]}; OUT = *reinterpret_cast<h8*>(&w); } while (0)
    AT_PK4(p0, 0, pa0); AT_PK4(p0, 8, pa1); AT_PK4(p1, 0, pa2); AT_PK4(p1, 8, pa3);
#undef AT_PK4
}
__device__ __forceinline__ float half_swap_max(float v) { auto rr = __builtin_amdgcn_permlane32_swap(__float_as_uint(v), __float_as_uint(v), false, false); return fmaxf(__uint_as_float(rr[0]), __uint_as_float(rr[1])); }
__device__ __forceinline__ float half_swap_sum(float v) { auto rr = __builtin_amdgcn_permlane32_swap(__float_as_uint(v), __float_as_uint(v), false, false); return __uint_as_float(rr[0]) + __uint_as_float(rr[1]); }

__device__ __forceinline__ int hidden_tid() { int tz = threadIdx.x; asm volatile("" : "+v"(tz)); return tz; }
__device__ __forceinline__ void dma_offsets(int ld, int (&ko)[2], int (&vo)[2]) {
    const int tz = hidden_tid(), w = tz >> 6, l = tz & 63;
#pragma unroll
    for (int q = 0; q < 2; ++q) {
        const int rr = 4 * (2 * w + q) + (l >> 4), pp = l & 15;
        ko[q] = rr * ld + ((pp ^ (rr & 7)) * 8);
        const int L = (2 * w + q) * 1024 + l * 16, sidx = L >> 9, o = L & 511;
        const int kk = (sidx >> 2) * 8 + (o >> 6), c = (sidx & 3) * 32 + ((o & 63) >> 1);
        const int k = (kk & ~0xC) | ((kk & 4) << 1) | ((kk & 8) >> 1);
        vo[q] = k * ld + c;
    }
}
__device__ __forceinline__ void dma_tile(char* slot, const _Float16* Kb, const _Float16* Vb, int ld, int tile, const int (&ko)[2], const int (&vo)[2], int wid) {
    const _Float16* kt = Kb + (size_t)tile * 64 * ld; const _Float16* vt = Vb + (size_t)tile * 64 * ld;
#pragma unroll
    for (int q = 0; q < 2; ++q) __builtin_amdgcn_global_load_lds((const unsigned*)(kt + ko[q]), (LAS unsigned*)(slot + (2 * wid + q) * 1024), 16, 0, 0);
#pragma unroll
    for (int q = 0; q < 2; ++q) __builtin_amdgcn_global_load_lds((const unsigned*)(vt + vo[q]), (LAS unsigned*)(slot + SHM_K + (2 * wid + q) * 1024), 16, 0, 0);
}
#define AT_WAITV(n) asm volatile("s_waitcnt vmcnt(" #n ")" ::: "memory")
#define AT_BAR() do { asm volatile("s_waitcnt lgkmcnt(0)" ::: "memory"); __builtin_amdgcn_s_barrier(); asm volatile("" ::: "memory"); } while (0)

__device__ __forceinline__ void attn_unit(char* lds, const _Float16* qrow, const _Float16* Kb, const _Float16* Vb, int ld, unsigned tmask, int wlen, int khi, unsigned selmask,
                                          _Float16* outw, int ostride) {
    const int tid = threadIdx.x, wid = __builtin_amdgcn_readfirstlane(tid >> 6), lane = tid & 63, r32 = lane & 31, hi = lane >> 5;
    float* wsf = (float*)(lds + LDS_WS) + wid * 64; float* li_l = wsf; float* al_l = wsf + 32;
    float m_reg = -1e30f, l_reg = 0.f; f32x16 o[4] = {}; h8 qr[8];
#pragma unroll
    for (int d0 = 0; d0 < 8; ++d0) qr[d0] = *(const h8*)(qrow + d0 * 16);
    int ko[2], vo[2]; dma_offsets(ld, ko, vo);
    const int vbase = (int)(uintptr_t)lds + SHM_K + v_rd_base(lane);
    unsigned rest = tmask; int j = __ffs(rest) - 1; rest &= rest - 1;
    int j1 = rest ? (__ffs(rest) - 1) : -1; if (j1 >= 0) rest &= rest - 1;
    dma_tile(lds, Kb, Vb, ld, j, ko, vo, wid);
    if (j1 >= 0) { dma_tile(lds + SLOT, Kb, Vb, ld, j1, ko, vo, wid); AT_WAITV(4); } else { AT_WAITV(0); }
    AT_BAR();
    int so = 0, sp = 0;
    const bool roleB = wid >= 4;
    bool first = true;
    h8 pa0, pa1, pa2, pa3;
    for (;;) {
        const int j2 = rest ? (__ffs(rest) - 1) : -1;
        if (j2 >= 0) { rest &= rest - 1; int s2 = so + 2 * SLOT; s2 = s2 >= NSLOT * SLOT ? s2 - NSLOT * SLOT : s2; dma_tile(lds + s2, Kb, Vb, ld, j2, ko, vo, wid); }
        if (roleB && !first) { AT_SBAR(); pv_d0(o, vbase + sp, pa0, pa1, pa2, pa3); }
        f32x16 p0, p1;
        AT_SBAR(); qkt(p0, p1, lds + so, qr, r32, hi);
        { const int klo = wlen > 0 ? khi - wlen + 1 : 0; const bool tb = (selmask >> j) & 1u; const bool inr = (j * 64 >= klo) && (j * 64 + 63 <= khi);
          if (!__all(tb && inr)) {
              if (__all(inr)) {
#pragma unroll
                  for (int r = 0; r < 16; ++r) { p0[r] = tb ? p0[r] : -INFINITY; p1[r] = tb ? p1[r] : -INFINITY; }
              } else {
                  const int kb = j * 64 + 4 * hi;
#pragma unroll
                  for (int r = 0; r < 16; ++r) { const int k0 = kb + (r & 3) + 8 * (r >> 2);
                      p0[r] = (tb && k0 >= klo && k0 <= khi) ? p0[r] : -INFINITY;
                      p1[r] = (tb && (k0 + 32) >= klo && (k0 + 32) <= khi) ? p1[r] : -INFINITY; }
              } } }
        float pmax = p0[0];
#pragma unroll
        for (int r = 1; r < 16; ++r) pmax = fmaxf(pmax, p0[r]);
#pragma unroll
        for (int r = 0; r < 16; ++r) pmax = fmaxf(pmax, p1[r]);
        pmax = half_swap_max(pmax);
        float mn, alpha;
        if (__all(pmax - m_reg <= THR_RAW)) { mn = m_reg; alpha = 1.f; }
        else { mn = fmaxf(m_reg, pmax); alpha = __builtin_amdgcn_exp2f((m_reg - mn) * CEXP); m_reg = mn; }
        const float mnC = -mn * CEXP;
        float ps = 0.f;
#pragma unroll
        for (int r = 0; r < 16; ++r) { p0[r] = __builtin_amdgcn_exp2f(fmaf(p0[r], CEXP, mnC)); ps += p0[r]; }
#pragma unroll
        for (int r = 0; r < 16; ++r) { p1[r] = __builtin_amdgcn_exp2f(fmaf(p1[r], CEXP, mnC)); ps += p1[r]; }
        ps = half_swap_sum(ps);
        l_reg = l_reg * alpha + ps;
        if (__any(alpha < 1.f)) { if (hi == 0) al_l[r32] = alpha; asm volatile("s_waitcnt lgkmcnt(0)" ::: "memory");
#pragma unroll
            for (int r = 0; r < 16; ++r) { const float a = al_l[crow(r, hi)];
#pragma unroll
                for (int d = 0; d < 4; ++d) o[d][r] *= a; } }
        pack_p(p0, p1, pa0, pa1, pa2, pa3);
        AT_SBAR();
        if (!roleB) pv_d0(o, vbase + so, pa0, pa1, pa2, pa3);
        if (j1 < 0) break;
        if (j2 >= 0) { AT_WAITV(4); } else { AT_WAITV(0); }
        AT_BAR();
        j = j1; j1 = j2; sp = so; so += SLOT; so = so >= NSLOT * SLOT ? so - NSLOT * SLOT : so; first = false;
    }
    if (roleB) { AT_SBAR(); pv_d0(o, vbase + so, pa0, pa1, pa2, pa3); }
    if (hi == 0) li_l[r32] = l_reg; asm volatile("s_waitcnt lgkmcnt(0)" ::: "memory");
#pragma unroll
    for (int r = 0; r < 16; ++r) { const int orow = crow(r, hi); const float l = li_l[orow]; const float rl = l > 0.f ? 1.f / l : 0.f;
#pragma unroll
        for (int d0 = 0; d0 < 4; ++d0) outw[(size_t)orow * ostride + d0 * 32 + r32] = (_Float16)(o[d0][r] * rl); }
    __syncthreads();
}

constexpr int LDS_AP = 0, LDS_BP = LDS_AP + 4 * 64 * 33 * 4, LDS_SELM = LDS_END, LDS_CS_END = LDS_SELM + 64 * 4;
static_assert(LDS_BP + 4 * 64 * 33 * 4 <= NSLOT * SLOT, "importance partials must fit inside the ring");
__device__ __forceinline__ void cmp_slc_unit(char* lds, const _Float16* qrow, const _Float16* Kc, const _Float16* Vc, const _Float16* Ks, const _Float16* Vs, int t, int tl, int g, int qi,
                                             _Float16* outc, _Float16* outs) {
    const int tid = threadIdx.x, wid = __builtin_amdgcn_readfirstlane(tid >> 6), lane = tid & 63, r32 = lane & 31, hi = lane >> 5;
    float* AP = (float*)(lds + LDS_AP); float* BP = (float*)(lds + LDS_BP); unsigned* selm = (unsigned*)(lds + LDS_SELM);
    {
        h8 qr[8];
#pragma unroll
        for (int d0 = 0; d0 < 8; ++d0) qr[d0] = *(const h8*)(qrow + d0 * 16);
        const int vb0 = (int)(uintptr_t)lds + SHM_K + v_rd_base(lane);
        { int ko[2], vo[2]; dma_offsets(256, ko, vo);
          dma_tile(lds, Kc, Vc, 256, 0, ko, vo, wid); dma_tile(lds + SLOT, Kc, Vc, 256, 1, ko, vo, wid); }
        AT_WAITV(0); AT_BAR();
        f32x16 pA0, pA1, pB0, pB1;
        AT_SBAR(); qkt(pA0, pA1, lds, qr, r32, hi); qkt(pB0, pB1, lds + SLOT, qr, r32, hi);
        const int khi = t >= 31 ? ((t - 31) >> 4) : -1;
#pragma unroll
        for (int r = 0; r < 16; ++r) { const int c0 = 4 * hi + (r & 3) + 8 * (r >> 2);
            pA0[r] = (c0 <= khi) ? pA0[r] : -INFINITY; pA1[r] = (c0 + 32 <= khi) ? pA1[r] : -INFINITY;
            pB0[r] = (c0 + 64 <= khi) ? pB0[r] : -INFINITY; pB1[r] = (c0 + 96 <= khi) ? pB1[r] : -INFINITY; }
        float pmax = -INFINITY;
#pragma unroll
        for (int r = 0; r < 16; ++r) pmax = fmaxf(fmaxf(pmax, pA0[r]), fmaxf(pA1[r], fmaxf(pB0[r], pB1[r])));
        pmax = half_swap_max(pmax);
        const float mC = (pmax == -INFINITY) ? 0.f : -pmax * CEXP;
        float ps = 0.f;
#pragma unroll
        for (int r = 0; r < 16; ++r) { pA0[r] = __builtin_amdgcn_exp2f(fmaf(pA0[r], CEXP, mC)); pA1[r] = __builtin_amdgcn_exp2f(fmaf(pA1[r], CEXP, mC));
            pB0[r] = __builtin_amdgcn_exp2f(fmaf(pB0[r], CEXP, mC)); pB1[r] = __builtin_amdgcn_exp2f(fmaf(pB1[r], CEXP, mC)); ps += (pA0[r] + pA1[r]) + (pB0[r] + pB1[r]); }
        ps = half_swap_sum(ps);
        const float inv = ps > 0.f ? 1.f / ps : 0.f;
#pragma unroll
        for (int r = 0; r < 16; ++r) { pA0[r] *= inv; pA1[r] *= inv; pB0[r] *= inv; pB1[r] *= inv; }
        f32x16 o[4] = {};
        h8 pa0, pa1, pa2, pa3;
        pack_p(pA0, pA1, pa0, pa1, pa2, pa3); AT_SBAR(); pv_d0(o, vb0, pa0, pa1, pa2, pa3);
        pack_p(pB0, pB1, pa0, pa1, pa2, pa3); AT_SBAR(); pv_d0(o, vb0 + SLOT, pa0, pa1, pa2, pa3);
#pragma unroll
        for (int r = 0; r < 16; ++r) { const int orow = crow(r, hi);
#pragma unroll
            for (int d0 = 0; d0 < 4; ++d0) outc[(size_t)orow * 1024 + d0 * 32 + r32] = (_Float16)o[d0][r]; }
        __syncthreads();
        { float* ap = AP + (g * 64 + tl) * 33; float* bp = BP + (g * 64 + tl) * 33;
          if (hi == 0) bp[0] = 0.f;
#define AT_IMP(P, JB) do { _Pragma("unroll") for (int k = 0; k < 4; ++k) { const int j = (JB) + 2 * k + hi; \
              ap[j] = 2.f * (P[4 * k] + P[4 * k + 1] + P[4 * k + 2]) + P[4 * k + 3]; if (j + 1 < 32) bp[j + 1] = P[4 * k + 3]; } } while (0)
          AT_IMP(pA0, 0); AT_IMP(pA1, 8); AT_IMP(pB0, 16); AT_IMP(pB1, 24);
#undef AT_IMP
        }
    }
    __syncthreads();
#pragma unroll 1
    for (int it = 0; it < 4; ++it) {
        const int tk = 8 * wid + 2 * it + hi, j = r32;
        float imp = 0.f;
#pragma unroll
        for (int gg = 0; gg < 4; ++gg) imp += AP[(gg * 64 + tk) * 33 + j] + BP[(gg * 64 + tk) * 33 + j];
        const bool forced = (j == 0) || (j == qi) || (j == qi - 1), valid = j <= qi;
        const float iv = forced ? 1e9f : (valid ? imp : -1e9f);
        int rank = 0;
        for (int i = 0; i < 32; ++i) { const float vi = __shfl(iv, i + 32 * hi); rank += (vi > iv || (vi == iv && i < j)) ? 1 : 0; }
        const unsigned long long bal = __ballot(rank < 16 && valid);
        if (r32 == 0) selm[tk] = (unsigned)(bal >> (32 * hi));
    }
    __syncthreads();
    unsigned tm = selm[lane];
#pragma unroll
    for (int o = 32; o > 0; o >>= 1) tm |= __shfl_xor(tm, o);
    const int tz2 = hidden_tid();
    const unsigned mysel = selm[((tz2 >> 6) & 1) * 32 + (tz2 & 31)];
    attn_unit(lds, qrow, Ks, Vs, 128, tm, 0, t, mysel, outs, 1024);
}
}

struct CUnit { const float* W; int ldw; int nvalid; _Float16* Wt; int k0; int n0; };
__device__ __forceinline__ CUnit conv_desc(int u, const float* win, const float* w1k, const float* w1v, const float* wmkv, _Float16* wtin, _Float16* wt1, _Float16* wtmkv) {
    CUnit d;
    if (u < 160) { d.W = win; d.ldw = INW; d.nvalid = INW; d.Wt = wtin; d.k0 = (u / 5) * 64; d.n0 = (u % 5) * 256; }
    else if (u < 288) { const int v = u - 160, kv = v >> 6, part = (v >> 5) & 1, kt = v & 31;
        d.W = (kv ? w1v : w1k) + (size_t)part * 2048 * 256; d.ldw = 256; d.nvalid = 256; d.Wt = wt1 + ((size_t)kv * 512 + part * 256) * 2048; d.k0 = kt * 64; d.n0 = 0; }
    else { d.W = wmkv; d.ldw = 1024; d.nvalid = 1024; d.Wt = wtmkv; d.k0 = 0; d.n0 = 0; }
    return d;
}
__device__ __forceinline__ void conv_all(float* lds, const float* win, const float* w1k, const float* w1v, const float* wmkv, _Float16* wtin, _Float16* wt1, _Float16* wtmkv, int bid, int nb) {
    constexpr int NU = 160 + 128;
    const int tid = threadIdx.x;
    int u = bid; if (u >= NU) return;
    CUnit d = conv_desc(u, win, w1k, w1v, wmkv, wtin, wt1, wtmkv);
    float4 v[8];
#define CL(D) do { _Pragma("unroll") for (int i = 0; i < 8; ++i) { const int idx = tid + 512 * i, r = idx >> 6, c4 = (idx & 63) * 4; \
        v[i] = ((D).n0 + c4 < (D).nvalid) ? *(const float4*)((D).W + (size_t)((D).k0 + r) * (D).ldw + (D).n0 + c4) : make_float4(0.f, 0.f, 0.f, 0.f); } } while (0)
    CL(d);
    for (;;) {
#pragma unroll
        for (int i = 0; i < 8; ++i) { const int idx = tid + 512 * i, r = idx >> 6, c4 = (idx & 63) * 4; float* dd = lds + r * 257 + c4; dd[0] = v[i].x; dd[1] = v[i].y; dd[2] = v[i].z; dd[3] = v[i].w; }
        __syncthreads();
        const int un = u + nb; const bool has = un < NU;
        CUnit dn = d; if (has) { dn = conv_desc(un, win, w1k, w1v, wmkv, wtin, wt1, wtmkv); CL(dn); }
#pragma unroll
        for (int j = 0; j < 4; ++j) { const int id = tid + 512 * j, n = id >> 3, k8 = (id & 7) * 8; h8 o;
#pragma unroll
            for (int q = 0; q < 8; ++q) o[q] = (_Float16)lds[(k8 + q) * 257 + n];
            *(h8*)(d.Wt + (size_t)(d.n0 + n) * 2048 + d.k0 + k8) = o; }
        __syncthreads();
        if (!has) break;
        u = un; d = dn;
    }
#undef CL
}

__device__ __forceinline__ unsigned pack4_i8(float a, float b, float c, float d) {
    const int ia = __float2int_rn(a), ib = __float2int_rn(b), ic = __float2int_rn(c), id = __float2int_rn(d);
    return (unsigned)(ia & 255) | ((unsigned)(ib & 255) << 8) | ((unsigned)(ic & 255) << 16) | ((unsigned)(id & 255) << 24);
}
constexpr int QP_LD2 = 1026;
struct QUnit { const float* W; int ldw; int n0; signed char* Q; float* sc; int nvalid; };
struct QExtra { const float* win; signed char* q8in; float* sin8; const float* wmkv; signed char* q8mkv; float* smkv; };
__device__ __forceinline__ QUnit quant_desc(int u, const float* wgu, const float* wdn, signed char* q8gu, signed char* q8dn, float* sgu, float* sdn, const float* wout, signed char* q8out, float* sout, const QExtra& x) {
    QUnit d; d.nvalid = 1 << 30;
    if (u >= NE * 192 + 64 + 73) { const int pn = u - (NE * 192 + 64 + 73); d.W = x.wmkv; d.ldw = 1024; d.n0 = pn * 32; d.Q = x.q8mkv; d.sc = x.smkv; }
    else if (u >= NE * 192 + 64) { const int pn = u - (NE * 192 + 64); d.W = x.win; d.ldw = INW; d.n0 = 1280 + pn * 32; d.Q = x.q8in - (size_t)1280 * 2048; d.sc = x.sin8 - 1280; d.nvalid = INW; }
    else if (u >= NE * 192) { const int pn = u - NE * 192; d.W = wout; d.ldw = 2048; d.n0 = pn * 32; d.Q = q8out; d.sc = sout; }
    else if (u < NE * 128) { const int e = u >> 7, pn = u & 127; d.W = wgu + (size_t)e * 2048 * 4096; d.ldw = 4096; d.n0 = pn * 32; d.Q = q8gu + (size_t)e * 4096 * 2048; d.sc = sgu + (size_t)e * 4096; }
    else { const int v = u - NE * 128, e = v >> 6, pn = v & 63; d.W = wdn + (size_t)e * 2048 * 2048; d.ldw = 2048; d.n0 = pn * 32; d.Q = q8dn + (size_t)e * 2048 * 2048; d.sc = sdn + (size_t)e * 2048; }
    return d;
}
__device__ __forceinline__ unsigned pk2h(float a, float b) { auto v = __builtin_amdgcn_cvt_pkrtz(a, b); return *reinterpret_cast<unsigned*>(&v); }
__device__ __forceinline__ void quant_all(char* smem, const float* wgu, const float* wdn, signed char* q8gu, signed char* q8dn, float* sgu, float* sdn, const float* wout, signed char* q8out, float* sout, const QExtra& qx, int bid, int nb) {
    constexpr int NU = NE * 128 + NE * 64 + 64 + 73 + 32;
    unsigned* cmaxb = (unsigned*)smem;
    const int tid = threadIdx.x, c4 = (tid & 7) * 4, rg = tid >> 3;
    if (tid < 64) cmaxb[tid] = 0u;
    __syncthreads();
    int u = bid; if (u >= NU) return;
    QUnit d = quant_desc(u, wgu, wdn, q8gu, q8dn, sgu, sdn, wout, q8out, sout, qx);
    float4 va[16], vb[16], vc[16];
#define QL(dst, D, half) do { const float* p0 = (D).W + (size_t)((half) * 1024 + rg * 16) * (D).ldw + (D).n0 + c4; const bool okc = (D).n0 + c4 < (D).nvalid; _Pragma("unroll") for (int j = 0; j < 16; ++j) dst[j] = okc ? *(const float4*)(p0 + (size_t)j * (D).ldw) : make_float4(0.f, 0.f, 0.f, 0.f); } while (0)
#define QM(src) do { _Pragma("unroll") for (int j = 0; j < 16; ++j) { m0 = fmaxf(m0, fabsf(src[j].x)); m1 = fmaxf(m1, fabsf(src[j].y)); m2 = fmaxf(m2, fabsf(src[j].z)); m3 = fmaxf(m3, fabsf(src[j].w)); } } while (0)
#define QS(src, half, comp, ci, inv) do { uint4 o; \
        o.x = pack4_i8(src[0].comp * inv, src[1].comp * inv, src[2].comp * inv, src[3].comp * inv); o.y = pack4_i8(src[4].comp * inv, src[5].comp * inv, src[6].comp * inv, src[7].comp * inv); \
        o.z = pack4_i8(src[8].comp * inv, src[9].comp * inv, src[10].comp * inv, src[11].comp * inv); o.w = pack4_i8(src[12].comp * inv, src[13].comp * inv, src[14].comp * inv, src[15].comp * inv); \
        *(uint4*)(d.Q + (size_t)(d.n0 + c4 + (ci)) * 2048 + (half) * 1024 + rg * 16) = o; } while (0)
    QL(va, d, 0);
    int par = 0;
    for (;;) {
        unsigned* cmax = cmaxb + par * 32;
        float m0 = 0.f, m1 = 0.f, m2 = 0.f, m3 = 0.f;
        QL(vb, d, 1);
        QM(va); QM(vb);
        atomicMax(&cmax[c4 + 0], __float_as_uint(m0)); atomicMax(&cmax[c4 + 1], __float_as_uint(m1)); atomicMax(&cmax[c4 + 2], __float_as_uint(m2)); atomicMax(&cmax[c4 + 3], __float_as_uint(m3));
        __syncthreads();
        const int un = u + nb; const bool has = un < NU;
        QUnit dn = d; if (has) { dn = quant_desc(un, wgu, wdn, q8gu, q8dn, sgu, sdn, wout, q8out, sout, qx); QL(vc, dn, 0); }
        if (tid < 32) cmaxb[(par ^ 1) * 32 + tid] = 0u;
        const float x0 = __uint_as_float(cmax[c4 + 0]), x1 = __uint_as_float(cmax[c4 + 1]), x2 = __uint_as_float(cmax[c4 + 2]), x3 = __uint_as_float(cmax[c4 + 3]);
        const float i0 = x0 > 0.f ? 127.f / x0 : 0.f, i1 = x1 > 0.f ? 127.f / x1 : 0.f, i2 = x2 > 0.f ? 127.f / x2 : 0.f, i3 = x3 > 0.f ? 127.f / x3 : 0.f;
        QS(va, 0, x, 0, i0); QS(va, 0, y, 1, i1); QS(va, 0, z, 2, i2); QS(va, 0, w, 3, i3);
        QS(vb, 1, x, 0, i0); QS(vb, 1, y, 1, i1); QS(vb, 1, z, 2, i2); QS(vb, 1, w, 3, i3);
        if (tid < 32) { const float mx = __uint_as_float(cmax[tid]); d.sc[d.n0 + tid] = mx > 0.f ? mx / 127.f : 1.f; }
        if (!has) break;
#pragma unroll
        for (int j = 0; j < 16; ++j) va[j] = vc[j];
        u = un; d = dn; par ^= 1;
        __syncthreads();
    }
    __syncthreads();
#undef QL
#undef QM
#undef QS
}

__global__ void __launch_bounds__(512, 2) fwd(Params p) {
    extern __shared__ __attribute__((aligned(16))) char smem[];
    const int tid = threadIdx.x, wv = __builtin_amdgcn_readfirstlane(tid >> 6);
#define LANE_NOW ({ int _t = threadIdx.x; asm volatile("" : "+v"(_t)); _t & 63; })
    const int bid = blockIdx.x, nb = gridDim.x;
    const int gw = bid * 8 + wv, nw = nb * 8;
    const int lo = (int)(p.lo_hi & 0xffffffffll), hi = (int)(p.lo_hi >> 32);
    unsigned char* ws = p.ws;
    unsigned* ctl = (unsigned*)(ws + WS_CTL);
    int* cnt = (int*)(ws + CTL_CNT);
    float* proj = (float*)(ws + WS_PROJ);
    float* kvmem = (float*)(ws + WS_KVMEM);
    float* bias1 = (float*)(ws + WS_BIAS1);
    float* hid = (float*)(ws + WS_HID);
    float* kc = (float*)(ws + WS_KC);
    float* vc = (float*)(ws + WS_VC);
    float* pooled = (float*)(ws + WS_POOLED);
    _Float16* opool = (_Float16*)(ws + WS_OPOOL);
    _Float16* owin = (_Float16*)(ws + WS_OWIN);
    _Float16* ocmp = (_Float16*)(ws + WS_OCMP);
    _Float16* oslc = (_Float16*)(ws + WS_OSLC);
    unsigned* sel = (unsigned*)(ws + WS_SEL);
    _Float16* omem = (_Float16*)(ws + WS_OMEM);
    _Float16* cat16 = (_Float16*)(ws + WS_CAT16);
    _Float16* hpre16 = (_Float16*)(ws + WS_HPRE);
    float* hbuf = (float*)(ws + WS_H);
    float* gate = (float*)(ws + WS_GATE);
    int* list = (int*)(ws + WS_LIST);
    unsigned char* actf8 = (unsigned char*)(ws + WS_ACT16);
    unsigned char* yf8 = (unsigned char*)(ws + WS_Y16);
    _Float16* h16 = (_Float16*)(ws + WS_H16);
    _Float16* x16 = (_Float16*)(ws + WS_X16);
    _Float16* wtin = (_Float16*)(ws + WS_WTIN);
    _Float16* wtout = (_Float16*)(ws + WS_WTOUT);
    _Float16* wtgu = (_Float16*)(ws + WS_WTGU);
    _Float16* wtdn = (_Float16*)(ws + WS_WTDN);
    LAS unsigned char* lds = (LAS unsigned char*)smem;
    _Float16* proj16 = (_Float16*)(ws + WS_PROJ16);
    _Float16* kvmem16 = (_Float16*)(ws + WS_KVMEM16);
    _Float16* wt1 = (_Float16*)(ws + WS_WT1);
    float* uv = (float*)(ws + WS_UV);
    _Float16* kc16 = (_Float16*)(ws + WS_KC16);
    _Float16* vc16 = (_Float16*)(ws + WS_VC16);
    _Float16* wr16 = (_Float16*)(ws + WS_WR16);
    _Float16* mem16 = (_Float16*)(ws + WS_MEM16);
    _Float16* wtmkv = (_Float16*)(ws + WS_WTMKV);
    _Float16* kv16 = (_Float16*)(ws + WS_KV16);
    _Float16* wt2 = (_Float16*)(ws + WS_WT2);
    float* sa2 = (float*)(ws + WS_SA2); float* gate2 = (float*)(ws + WS_GATE2);
    signed char* x8 = (signed char*)(ws + WS_X8); float* sxa = (float*)(ws + WS_SXA); signed char* q8in = (signed char*)(ws + WS_Q8IN); float* sin8 = (float*)(ws + WS_SIN8);
    signed char* q8mkv = (signed char*)(ws + WS_Q8MKV); float* smkv = (float*)(ws + WS_SMKV);
    signed char* q8out = (signed char*)(ws + WS_Q8OUT); float* sout = (float*)(ws + WS_SOUT); signed char* cat8 = (signed char*)(ws + WS_CAT8); float* scat = (float*)(ws + WS_SCAT);
    signed char* q8gu = (signed char*)(ws + WS_Q8GU); signed char* q8dn = (signed char*)(ws + WS_Q8DN);
    float* sgu = (float*)(ws + WS_SGU); float* sdn = (float*)(ws + WS_SDN);
    signed char* h8q = (signed char*)(ws + WS_H8); float* sah = (float*)(ws + WS_SAH);
    signed char* act8 = (signed char*)(ws + WS_ACT8); float* sact = (float*)(ws + WS_SACT);
    const int vcu = (nb % 8 == 0) ? (bid % 8) * (nb / 8) + bid / 8 : bid;

    volatile LAS unsigned* xbw = (volatile LAS unsigned*)(smem + LDS_BYTES - 16);
    if (tid == 0) { xbw[0] = 0u; xbw[1] = 0u; xbw[2] = 0u; xbw[3] = 0u; }
    __syncthreads();
    XcdBarrier bar; bar.bar = ctl; bar.x = 0; bar.st = xbw;
    const bool multi = (hi - lo) > 1;
    if (multi) bar = xcd_barrier_post(ctl, xbw);
#define IN(k) (lo <= (k) && (k) < hi)
#define SEAM(k) do { if (IN(k) && IN((k) + 1)) xcd_barrier(bar); } while (0)
    float* sw = (float*)smem + wv * WLDS_FLOATS;
    int* segw = (int*)(sw + 4096 + 512);

    if (IN(0)) {
        const int lane = LANE_NOW; (void)lane;
        if (wv == 0 && (bid & 1) == 0 && (bid >> 1) < 128) {
            const int task = bid >> 1, kv = task >> 6, jg = (task >> 4) & 3, kc = task & 15;
            const float* pos = p.in[kv ? I_POSV : I_POSK] + kc * 256; const float* w1 = p.in[kv ? I_W1V : I_W1K] + (size_t)kc * 256 * 256 + jg * 64 + lane;
            float s0 = 0.f, s1 = 0.f, s2 = 0.f, s3 = 0.f;
            for (int k = 0; k < 256; k += 4) { s0 += pos[k] * w1[(size_t)k * 256]; s1 += pos[k + 1] * w1[(size_t)(k + 1) * 256]; s2 += pos[k + 2] * w1[(size_t)(k + 2) * 256]; s3 += pos[k + 3] * w1[(size_t)(k + 3) * 256]; }
            bias1[(kv * 16 + kc) * 256 + jg * 64 + lane] = (s0 + s1) + (s2 + s3);
        }
        for (int i = bid * 512 + tid; i < 2 * 128 * 256; i += nb * 512) { const int kv = i >> 15, d = (i >> 8) & 127, n = i & 255; wt2[i] = (_Float16)p.in[kv ? I_W2V : I_W2K][(size_t)n * 128 + d]; }
        for (int i = bid * 512 + tid; i < 32 * 2048; i += nb * 512) { const int e = i >> 11, d = i & 2047; wr16[i] = (_Float16)p.in[I_WR][(size_t)d * 32 + e]; }
        {
            for (int row0 = gw; row0 < T_ + 2048; row0 += nw * 2) {
                float4 raw[2][8];
#pragma unroll
                for (int i = 0; i < 2; ++i) { const int row = row0 + i * nw; const float* src = row < T_ ? p.in[I_X] + (size_t)row * 2048 : p.in[I_MEM] + (size_t)(row - T_) * 2048;
#pragma unroll
                    for (int c = 0; c < 4; ++c) { raw[i][2 * c] = make_float4(0.f, 0.f, 0.f, 0.f); raw[i][2 * c + 1] = raw[i][2 * c];
                        if (row < T_ + 2048) { raw[i][2 * c] = *(const float4*)(src + (lane + 64 * c) * 8); raw[i][2 * c + 1] = *(const float4*)(src + (lane + 64 * c) * 8 + 4); } } }
#pragma unroll
                for (int i = 0; i < 2; ++i) { const int row = row0 + i * nw;
                    float amax = 0.f;
#pragma unroll
                    for (int k = 0; k < 8; ++k) amax = fmaxf(amax, fmaxf(fmaxf(fabsf(raw[i][k].x), fabsf(raw[i][k].y)), fmaxf(fabsf(raw[i][k].z), fabsf(raw[i][k].w))));
                    amax = wave_max(amax);
                    if (row < T_ + 2048) {
                        const float qinv = amax > 0.f ? 127.f / amax : 0.f;
                        if (lane == 0) sxa[row] = amax > 0.f ? amax / 127.f : 1.f;
#pragma unroll
                        for (int c = 0; c < 4; ++c) { const float4 a = raw[i][2 * c], b2 = raw[i][2 * c + 1];
                            uint2 q; q.x = pack4_i8(a.x * qinv, a.y * qinv, a.z * qinv, a.w * qinv); q.y = pack4_i8(b2.x * qinv, b2.y * qinv, b2.z * qinv, b2.w * qinv);
                            *(uint2*)(x8 + (size_t)row * 2048 + (lane + 64 * c) * 8) = q;
                            if (row < T_) { h8 o; o[0] = (_Float16)a.x; o[1] = (_Float16)a.y; o[2] = (_Float16)a.z; o[3] = (_Float16)a.w; o[4] = (_Float16)b2.x; o[5] = (_Float16)b2.y; o[6] = (_Float16)b2.z; o[7] = (_Float16)b2.w;
                                *(h8*)(x16 + (size_t)row * 2048 + (lane + 64 * c) * 8) = o; } } }
                }
            }
        }
        {
            const QExtra qx{p.in[I_WIN], q8in, sin8, p.in[I_WMEMKV], q8mkv, smkv};
            quant_all(smem, p.in[I_WGU], p.in[I_WDN], q8gu, q8dn, sgu, sdn, p.in[I_WOUT], q8out, sout, qx, bid, nb);
            __syncthreads();
            conv_all((float*)smem, p.in[I_WIN], p.in[I_W1K], p.in[I_W1V], p.in[I_WMEMKV], wtin, wt1, wtmkv, bid, nb);
            __syncthreads();
        }
    }
    SEAM(0);
    if (IN(1)) {
        const int lane = LANE_NOW; (void)lane;
        { g8::ProbInF P{x16, proj16, nb, bid}; g8::gemm_phase(lds, P); }
        __syncthreads();
        { g8::ProbIn8 P{x8, proj16, sxa, nb, (bid + 192) & 255}; g8::gemm_phase(lds, P); }
    }
    SEAM(1);
    if (IN(2)) {
        const int lane = LANE_NOW; (void)lane;
        { g8::ProbCmp P{kv16, wt1, uv, nb, bid}; g8::gemm_phase(lds, P); __syncthreads(); }
        for (int i = bid * 512 + tid; i < T_ * 64; i += nb * 512) {
            const int chn = i & 63, row = i >> 6, t = row & (S_ - 1), g = chn >> 4;
            const int win = 2 << g, n = min(win, t + 1);
            const _Float16* src = proj16 + (size_t)row * INW + C_UP + chn * 8;
            float a[8];
            const h8 cur = *(const h8*)src;
            h8 vv[15];
#pragma unroll
            for (int k = 0; k < 15; ++k) { vv[k] = (h8){0, 0, 0, 0, 0, 0, 0, 0}; if (k + 1 < n) vv[k] = *(const h8*)(src - (size_t)(k + 1) * INW); }
#pragma unroll
            for (int q = 0; q < 8; ++q) a[q] = (float)cur[q];
#pragma unroll
            for (int k = 0; k < 15; ++k) {
#pragma unroll
                for (int q = 0; q < 8; ++q) a[q] += (float)vv[k][q]; }
            const float rn = 1.f / (float)n;
            float4 o0, o1;
            o0.x = a[0] * rn - (float)cur[0]; o0.y = a[1] * rn - (float)cur[1]; o0.z = a[2] * rn - (float)cur[2]; o0.w = a[3] * rn - (float)cur[3];
            o1.x = a[4] * rn - (float)cur[4]; o1.y = a[5] * rn - (float)cur[5]; o1.z = a[6] * rn - (float)cur[6]; o1.w = a[7] * rn - (float)cur[7];
            *(float4*)(pooled + (size_t)row * 512 + chn * 8) = o0; *(float4*)(pooled + (size_t)row * 512 + chn * 8 + 4) = o1;
        }
        {
            const int r32 = lane & 31, hi = lane >> 5, g = wv >> 1, half = wv & 1;
            for (int uu = vcu; uu < 512; uu += nb) {
                const int v = uu & 255, bk = v >> 4, qi = (uu >> 8) ? 31 - (v & 15) : (v & 15), b = bk >> 1, kvh = bk & 1;
                const int t = qi * 64 + half * 32 + r32;
                const int lo_t = max(0, qi - 8);
                const unsigned tmask = (unsigned)(((1ull << (qi + 1)) - 1ull) & ~((1ull << lo_t) - 1ull));
                at8::attn_unit(smem, proj16 + (size_t)(b * S_ + t) * INW + C_Q + (kvh * 4 + g) * 128 + hi * 8,
                               kv16 + ((size_t)(4 * B_ + b) * 2 + kvh) * KVSEG, kv16 + ((size_t)(5 * B_ + b) * 2 + kvh) * KVSEG, 128, tmask, 512, t, 0xffffffffu,
                               owin + (size_t)(b * S_ + qi * 64 + half * 32) * 1024 + (kvh * 4 + g) * 128, 1024);
            }
            for (int u = vcu; u < 256; u += nb) {
                const int b = u >> 5, h = (u >> 3) & 3, qt = u & 7;
                const int t = qt * 256 + wv * 32 + r32;
                at8::attn_unit(smem, proj16 + (size_t)(b * S_ + t) * INW + C_QM + h * 128 + hi * 8,
                               kvmem16 + (size_t)b * 256 * 1024 + h * 128, kvmem16 + (size_t)b * 256 * 1024 + 512 + h * 128, 1024, 0xFu, 0, 255, 0xffffffffu,
                               omem + (size_t)(b * S_ + qt * 256 + wv * 32) * 512 + h * 128, 512);
            }
        }
    }
    SEAM(2);
    if (IN(3)) {
        const int lane = LANE_NOW; (void)lane;
        {
            float* bsum = (float*)smem;
            _Float16* hs = (_Float16*)(smem + 4096);
            { const int kv = tid >> 8, n = tid & 255; float a = 0.f;
#pragma unroll
              for (int kc = 0; kc < 16; ++kc) a += bias1[(kv * 16 + kc) * 256 + n];
              bsum[tid] = a; }
            __syncthreads();
            const int fr = lane & 15, fq = lane >> 4;
            for (int u = bid; u < 256; u += nb) {
                const int kv = u >> 7, rt = u & 127;
#pragma unroll
                for (int q = 0; q < 8; ++q) { const int e = tid + 512 * q, i = e >> 8, n = e & 255;
                    const int row = rt * 16 + i, c = (row >> 1) & 127;
                    float a = 0.f;
                    if (c != 127) { a = bsum[kv * 256 + n];
#pragma unroll
                        for (int sp = 0; sp < 4; ++sp) { const float* base = uv + ((size_t)(kv * 4 + sp) * 2048) * 512; a += base[(size_t)row * 512 + n] + base[(size_t)(row + 2) * 512 + 256 + n]; }
                        a = gelu_fast(a); }
                    hs[i * 264 + n] = (_Float16)a; }
                __syncthreads();
                { const _Float16* bp = wt2 + ((size_t)kv * 128 + wv * 16 + fr) * 256 + fq * 8;
                  f4 acc = (f4){0.f, 0.f, 0.f, 0.f};
#pragma unroll
                  for (int sI = 0; sI < 8; ++sI) { const h8 a = *(const h8*)(hs + fr * 264 + sI * 32 + fq * 8), bb = *(const h8*)(bp + sI * 32); acc = __builtin_amdgcn_mfma_f32_16x16x32_f16(a, bb, acc, 0, 0, 0); }
                  _Float16* dst = kv ? vc16 : kc16;
#pragma unroll
                  for (int j = 0; j < 4; ++j) { const int row = rt * 16 + fq * 4 + j; dst[(size_t)row * 128 + wv * 16 + fr] = (((row >> 1) & 127) == 127) ? (_Float16)0.f : (_Float16)acc[j]; } }
                __syncthreads();
            }
        }
        for (int u = bid; u < 128 * 4; u += nb) { const int g = u >> 7, mt = u & 127;
            ARowPlain af{pooled + g * 128, 512, mt * 128, T_}; EpiPool ef{opool, p.in[I_POOLS], mt * 128, g};
            gemm_tile(smem, 128, af, p.in[I_POOLW] + (size_t)g * 128 * 128, 128, 0, 128, false, ef);
        }
    }
    SEAM(3);
    if (IN(4)) {
        const int lane = LANE_NOW; (void)lane;
        const int r32 = lane & 31, hi = lane >> 5, g = wv >> 1, half = wv & 1;
        for (int uu = vcu; uu < 512; uu += nb) {
            const int v = uu & 255, bk = v >> 4, qi = (uu >> 8) ? 31 - (v & 15) : (v & 15), b = bk >> 1, kvh = bk & 1;
            const int tl = half * 32 + r32, t = qi * 64 + tl;
            at8::cmp_slc_unit(smem, proj16 + (size_t)(b * S_ + t) * INW + C_Q + (kvh * 4 + g) * 128 + hi * 8,
                              kc16 + (size_t)(b * 128 * 2 + kvh) * 128, vc16 + (size_t)(b * 128 * 2 + kvh) * 128,
                              kv16 + ((size_t)(2 * B_ + b) * 2 + kvh) * KVSEG, kv16 + ((size_t)(3 * B_ + b) * 2 + kvh) * KVSEG, t, tl, g, qi,
                              ocmp + (size_t)(b * S_ + qi * 64 + half * 32) * 1024 + (kvh * 4 + g) * 128, oslc + (size_t)(b * S_ + qi * 64 + half * 32) * 1024 + (kvh * 4 + g) * 128);
        }
    }
    SEAM(4);
    if (IN(5)) {
        const int lane = LANE_NOW;
        for (int row = gw; row < T_; row += nw) {
            const _Float16* pr = proj16 + (size_t)row * INW + C_G;
            float v[32]; float ss = 0.f;
#pragma unroll
            for (int c = 0; c < 2; ++c) { const int col = (lane + 64 * c) * 8, h = col >> 7; const size_t o = (size_t)row * 1024 + col;
                const float g0 = sigmoidf_((float)pr[h * 3]), g1 = sigmoidf_((float)pr[h * 3 + 1]), g2 = sigmoidf_((float)pr[h * 3 + 2]);
                const h8 a = *(const h8*)(ocmp + o), b2 = *(const h8*)(oslc + o), c2 = *(const h8*)(owin + o);
#pragma unroll
                for (int q = 0; q < 8; ++q) { const float x = g0 * (float)a[q] + g1 * (float)b2[q] + g2 * (float)c2[q]; v[c * 8 + q] = x; ss += x * x; } }
            ss = wave_sum(ss); float r = rsqrtf(ss / 1024.f + LN_EPS);
#pragma unroll
            for (int c = 0; c < 2; ++c) { const int col = (lane + 64 * c) * 8; const float4 ga = *(const float4*)(p.in[I_GNNSA] + col), gb = *(const float4*)(p.in[I_GNNSA] + col + 4);
                v[c * 8 + 0] *= r * ga.x; v[c * 8 + 1] *= r * ga.y; v[c * 8 + 2] *= r * ga.z; v[c * 8 + 3] *= r * ga.w; v[c * 8 + 4] *= r * gb.x; v[c * 8 + 5] *= r * gb.y; v[c * 8 + 6] *= r * gb.z; v[c * 8 + 7] *= r * gb.w; }
            { const h8 a = *(const h8*)(opool + (size_t)row * 512 + lane * 8); ss = 0.f;
#pragma unroll
              for (int q = 0; q < 8; ++q) { v[16 + q] = (float)a[q]; ss += v[16 + q] * v[16 + q]; }
              ss = wave_sum(ss); r = rsqrtf(ss / 512.f + LN_EPS);
              const float4 ga = *(const float4*)(p.in[I_GNPOOL] + lane * 8), gb = *(const float4*)(p.in[I_GNPOOL] + lane * 8 + 4);
              v[16] *= r * ga.x; v[17] *= r * ga.y; v[18] *= r * ga.z; v[19] *= r * ga.w; v[20] *= r * gb.x; v[21] *= r * gb.y; v[22] *= r * gb.z; v[23] *= r * gb.w; }
            { const h8 a = *(const h8*)(omem + (size_t)row * 512 + lane * 8); ss = 0.f;
#pragma unroll
              for (int q = 0; q < 8; ++q) { v[24 + q] = (float)a[q]; ss += v[24 + q] * v[24 + q]; }
              ss = wave_sum(ss); r = rsqrtf(ss / 512.f + LN_EPS);
              const float4 ga = *(const float4*)(p.in[I_GNMEM] + lane * 8), gb = *(const float4*)(p.in[I_GNMEM] + lane * 8 + 4);
              v[24] *= r * ga.x; v[25] *= r * ga.y; v[26] *= r * ga.z; v[27] *= r * ga.w; v[28] *= r * gb.x; v[29] *= r * gb.y; v[30] *= r * gb.z; v[31] *= r * gb.w; }
            float amax = 0.f;
#pragma unroll
            for (int k = 0; k < 32; ++k) amax = fmaxf(amax, fabsf(v[k]));
            amax = wave_max(amax);
            const float qinv = amax > 0.f ? 127.f / amax : 0.f;
            if (lane == 0) scat[row] = amax > 0.f ? amax / 127.f : 1.f;
#pragma unroll
            for (int c = 0; c < 4; ++c) { const int col = c < 2 ? (lane + 64 * c) * 8 : (c == 2 ? 1024 + lane * 8 : 1536 + lane * 8);
                uint2 q; q.x = pack4_i8(v[c * 8 + 0] * qinv, v[c * 8 + 1] * qinv, v[c * 8 + 2] * qinv, v[c * 8 + 3] * qinv); q.y = pack4_i8(v[c * 8 + 4] * qinv, v[c * 8 + 5] * qinv, v[c * 8 + 6] * qinv, v[c * 8 + 7] * qinv);
                *(uint2*)(cat8 + (size_t)row * 2048 + col) = q; }
        }
    }
    SEAM(5);
    if (IN(6)) {
        const int lane = LANE_NOW; (void)lane;
        g8::ProbOut P{cat8, q8out, hpre16, x16, scat, sout, nb, bid};
        g8::gemm_phase(lds, P);
    }
    SEAM(6);
    if (IN(7)) {
        const int lane = LANE_NOW; (void)lane;
        float* lg = (float*)smem;
        const int r32 = lane & 31, hi = lane >> 5, fr = lane & 15, fq = lane >> 4;
        for (int u = bid; u < T_ / 64; u += nb) {
            const int base = u * 64;
            h8 raw[8][4];
#pragma unroll
            for (int i = 0; i < 8; ++i)
#pragma unroll
                for (int c = 0; c < 4; ++c) raw[i][c] = *(const h8*)(hpre16 + (size_t)(base + wv * 8 + i) * 2048 + (lane + 64 * c) * 8);
#pragma unroll
            for (int i = 0; i < 8; ++i) {
                const int row = base + wv * 8 + i;
                float v[32]; float s = 0.f;
#pragma unroll
                for (int c = 0; c < 4; ++c) {
#pragma unroll
                    for (int q = 0; q < 8; ++q) { v[c * 8 + q] = (float)raw[i][c][q]; s += v[c * 8 + q]; } }
                const float mu = wave_sum(s) / 2048.f; float q2 = 0.f;
#pragma unroll
                for (int k = 0; k < 32; ++k) { const float d = v[k] - mu; q2 += d * d; }
                const float rs = rsqrtf(wave_sum(q2) / 2048.f + LN_EPS);
                float amax = 0.f;
#pragma unroll
                for (int c = 0; c < 4; ++c) { const int col = (lane + 64 * c) * 8;
                    const float4 g0 = *(const float4*)(p.in[I_LN1G] + col), g1 = *(const float4*)(p.in[I_LN1G] + col + 4), b0 = *(const float4*)(p.in[I_LN1B] + col), b1 = *(const float4*)(p.in[I_LN1B] + col + 4);
                    float4 o0, o1;
                    o0.x = (v[c * 8 + 0] - mu) * rs * g0.x + b0.x; o0.y = (v[c * 8 + 1] - mu) * rs * g0.y + b0.y; o0.z = (v[c * 8 + 2] - mu) * rs * g0.z + b0.z; o0.w = (v[c * 8 + 3] - mu) * rs * g0.w + b0.w;
                    o1.x = (v[c * 8 + 4] - mu) * rs * g1.x + b1.x; o1.y = (v[c * 8 + 5] - mu) * rs * g1.y + b1.y; o1.z = (v[c * 8 + 6] - mu) * rs * g1.z + b1.z; o1.w = (v[c * 8 + 7] - mu) * rs * g1.w + b1.w;
                    h8 oh; oh[0] = (_Float16)o0.x; oh[1] = (_Float16)o0.y; oh[2] = (_Float16)o0.z; oh[3] = (_Float16)o0.w; oh[4] = (_Float16)o1.x; oh[5] = (_Float16)o1.y; oh[6] = (_Float16)o1.z; oh[7] = (_Float16)o1.w;
                    *(h8*)(h16 + (size_t)row * 2048 + col) = oh;
                    v[c * 8 + 0] = o0.x; v[c * 8 + 1] = o0.y; v[c * 8 + 2] = o0.z; v[c * 8 + 3] = o0.w; v[c * 8 + 4] = o1.x; v[c * 8 + 5] = o1.y; v[c * 8 + 6] = o1.z; v[c * 8 + 7] = o1.w;
                    amax = fmaxf(amax, fmaxf(fmaxf(fmaxf(fabsf(o0.x), fabsf(o0.y)), fmaxf(fabsf(o0.z), fabsf(o0.w))), fmaxf(fmaxf(fabsf(o1.x), fabsf(o1.y)), fmaxf(fabsf(o1.z), fabsf(o1.w))))); }
                amax = wave_max(amax);
                const float qinv = amax > 0.f ? 127.f / amax : 0.f;
                if (lane == 0) sah[row] = amax > 0.f ? amax / 127.f : 1.f;
#pragma unroll
                for (int c = 0; c < 4; ++c) { const int col = (lane + 64 * c) * 8;
                    uint2 q; q.x = pack4_i8(v[c * 8 + 0] * qinv, v[c * 8 + 1] * qinv, v[c * 8 + 2] * qinv, v[c * 8 + 3] * qinv); q.y = pack4_i8(v[c * 8 + 4] * qinv, v[c * 8 + 5] * qinv, v[c * 8 + 6] * qinv, v[c * 8 + 7] * qinv);
                    *(uint2*)(h8q + (size_t)row * 2048 + col) = q; }
            }
            asm volatile("s_waitcnt vmcnt(0)" ::: "memory");
            __syncthreads();
            {
                const int tok0 = base + 16 * (wv >> 1), e0 = 16 * (wv & 1);
                const _Float16* ap = h16 + (size_t)(tok0 + fr) * 2048 + fq * 8; const _Float16* bp = wr16 + (size_t)(e0 + fr) * 2048 + fq * 8;
                f4 acc = (f4){0.f, 0.f, 0.f, 0.f};
#pragma unroll 8
                for (int sI = 0; sI < 64; ++sI) { const h8 a = *(const h8*)(ap + sI * 32), bb = *(const h8*)(bp + sI * 32); acc = __builtin_amdgcn_mfma_f32_16x16x32_f16(a, bb, acc, 0, 0, 0); }
                const float br = p.in[I_BR][e0 + fr];
#pragma unroll
                for (int j = 0; j < 4; ++j) lg[(16 * (wv >> 1) + 4 * fq + j) * 33 + e0 + fr] = acc[j] + br;
            }
            __syncthreads();
#pragma unroll 1
            for (int it = 0; it < 4; ++it) {
                const int tk = 8 * wv + 2 * it + hi;
                const float iv = lg[tk * 33 + r32];
                int rank = 0;
                for (int i = 0; i < 32; ++i) { const float vi = __shfl(iv, i + 32 * hi); rank += (vi > iv || (vi == iv && i < r32)) ? 1 : 0; }
                float tv[4]; int te[4];
#pragma unroll
                for (int r = 0; r < 4; ++r) { const unsigned long long bm = __ballot(rank == r); const unsigned hm = (unsigned)(bm >> (32 * hi)); const int src = __ffs(hm) - 1; te[r] = src; tv[r] = __shfl(iv, src + 32 * hi); }
                const float e0v = 1.f, e1v = expf(tv[1] - tv[0]), e2v = expf(tv[2] - tv[0]), e3v = expf(tv[3] - tv[0]); const float inv = 1.f / (e0v + e1v + e2v + e3v);
                if (r32 < 4) { const int e = r32 == 0 ? te[0] : r32 == 1 ? te[1] : r32 == 2 ? te[2] : te[3]; const float g = (r32 == 0 ? e0v : r32 == 1 ? e1v : r32 == 2 ? e2v : e3v) * inv;
                    const int a = (base + tk) * 4 + r32; const int pos = atomicAdd(&cnt[e], 1); list[(size_t)e * T_ + pos] = a; gate[a] = g; gate2[(size_t)e * T_ + pos] = g; sa2[(size_t)e * T_ + pos] = sah[base + tk]; }
            }
            __syncthreads();
        }
    }
    SEAM(7);
    LAS int* mtab = (LAS int*)(smem + g8::STAGE_BYTES);
    if (IN(8)) {
        const int lane = LANE_NOW; (void)lane;
        if (tid == 0) { int ub = 0, rs = 0;
            for (int e = 0; e < NE; ++e) { const int c = (int)__hip_atomic_load((unsigned*)&cnt[e], __ATOMIC_RELAXED, __HIP_MEMORY_SCOPE_AGENT); mtab[e] = c; mtab[32 + e] = ub; mtab[65 + e] = rs; ub += ((c + 255) >> 8) * 16; rs += c; }
            mtab[64] = ub; mtab[97] = rs; mtab[98] = ub; }
        __syncthreads();
        g8::moe_build(mtab, nb, vcu);
        __syncthreads();
        g8::ProbGu P{h8q, q8gu, actf8, p.in[I_BGU], list, sa2, sgu, g8::MoeTab{mtab, 16}, nb, vcu};
        g8::gemm_phase(lds, P);
        __syncthreads();
    }
    SEAM(8);
    if (IN(9)) {
        const int lane = LANE_NOW;
        for (int row0 = gw; row0 < NA; row0 += nw * 8) {
            uint2 raw[8][4];
#pragma unroll
            for (int i = 0; i < 8; ++i)
#pragma unroll
                for (int c = 0; c < 4; ++c) raw[i][c] = *(const uint2*)(actf8 + (size_t)(row0 + i * nw) * 2048 + (lane + 64 * c) * 8);
#pragma unroll
            for (int i = 0; i < 8; ++i) { const int row = row0 + i * nw;
                float v[32]; float amax = 0.f;
#pragma unroll
                for (int c = 0; c < 4; ++c) { const uint2 a = raw[i][c];
                    dec4_fp8(a.x, v[c * 8 + 0], v[c * 8 + 1], v[c * 8 + 2], v[c * 8 + 3]); dec4_fp8(a.y, v[c * 8 + 4], v[c * 8 + 5], v[c * 8 + 6], v[c * 8 + 7]);
#pragma unroll
                    for (int q = 0; q < 8; ++q) amax = fmaxf(amax, fabsf(v[c * 8 + q])); }
                amax = wave_max(amax);
                const float qinv = amax > 0.f ? 127.f / amax : 0.f;
                if (lane == 0) sact[row] = amax > 0.f ? amax / 127.f : 1.f;
#pragma unroll
                for (int c = 0; c < 4; ++c) { uint2 q; q.x = pack4_i8(v[c * 8 + 0] * qinv, v[c * 8 + 1] * qinv, v[c * 8 + 2] * qinv, v[c * 8 + 3] * qinv); q.y = pack4_i8(v[c * 8 + 4] * qinv, v[c * 8 + 5] * qinv, v[c * 8 + 6] * qinv, v[c * 8 + 7] * qinv);
                    *(uint2*)(act8 + (size_t)row * 2048 + (lane + 64 * c) * 8) = q; }
            }
        }
    }
    SEAM(9);
    if (IN(10)) {
        const int lane = LANE_NOW; (void)lane;
        if (tid == 0) { int ub = 0, rs = 0;
            for (int e = 0; e < NE; ++e) { const int c = (int)__hip_atomic_load((unsigned*)&cnt[e], __ATOMIC_RELAXED, __HIP_MEMORY_SCOPE_AGENT); mtab[e] = c; mtab[32 + e] = ub; mtab[65 + e] = rs; ub += ((c + 255) >> 8) * 8; rs += c; }
            mtab[64] = ub; mtab[97] = rs; mtab[98] = ub; }
        __syncthreads();
        g8::moe_build(mtab, nb, vcu);
        __syncthreads();
        g8::ProbDn P{act8, q8dn, yf8, p.in[I_BDN], list, gate2, sact, sdn, g8::MoeTab{mtab, 8}, nb, vcu};
        g8::gemm_phase(lds, P);
        __syncthreads();
    }
    SEAM(10);
    if (IN(11)) {
        const int lane = LANE_NOW; (void)lane;
        for (int row0 = gw; row0 < T_; row0 += nw * 2) {
          h8 hraw[2][4]; uint2 yraw[2][4][4];
#pragma unroll
          for (int i = 0; i < 2; ++i)
#pragma unroll
            for (int c = 0; c < 4; ++c) { const int col = (lane + 64 * c) * 8; const size_t yo = (size_t)(row0 + i * nw) * 4 * 2048 + col;
                hraw[i][c] = *(const h8*)(h16 + (size_t)(row0 + i * nw) * 2048 + col);
                yraw[i][c][0] = *(const uint2*)(yf8 + yo); yraw[i][c][1] = *(const uint2*)(yf8 + yo + 2048); yraw[i][c][2] = *(const uint2*)(yf8 + yo + 4096); yraw[i][c][3] = *(const uint2*)(yf8 + yo + 6144); }
#pragma unroll
          for (int i = 0; i < 2; ++i) { const int row = row0 + i * nw;
            float v[32]; float s = 0.f;
#pragma unroll
            for (int c = 0; c < 4; ++c) {
                const h8 hh8 = hraw[i][c];
                const uint2 y0 = yraw[i][c][0], y1 = yraw[i][c][1], y2 = yraw[i][c][2], y3 = yraw[i][c][3];
                float ys[8], t0[8], t1[8], t2[8], t3[8];
                dec4_fp8(y0.x, t0[0], t0[1], t0[2], t0[3]); dec4_fp8(y0.y, t0[4], t0[5], t0[6], t0[7]); dec4_fp8(y1.x, t1[0], t1[1], t1[2], t1[3]); dec4_fp8(y1.y, t1[4], t1[5], t1[6], t1[7]);
                dec4_fp8(y2.x, t2[0], t2[1], t2[2], t2[3]); dec4_fp8(y2.y, t2[4], t2[5], t2[6], t2[7]); dec4_fp8(y3.x, t3[0], t3[1], t3[2], t3[3]); dec4_fp8(y3.y, t3[4], t3[5], t3[6], t3[7]);
#pragma unroll
                for (int q = 0; q < 8; ++q) ys[q] = (t0[q] + t1[q]) + (t2[q] + t3[q]);
#pragma unroll
                for (int q = 0; q < 8; ++q) { v[c * 8 + q] = DN_ALPHA * (float)hh8[q] + ys[q] * 0.0625f; s += v[c * 8 + q]; } }
            const float mu = wave_sum(s) / 2048.f; float q2 = 0.f;
#pragma unroll
            for (int i = 0; i < 32; ++i) { const float d = v[i] - mu; q2 += d * d; }
            const float rs = rsqrtf(wave_sum(q2) / 2048.f + LN_EPS);
#pragma unroll
            for (int c = 0; c < 4; ++c) { const int col = (lane + 64 * c) * 8;
                const float4 ga = *(const float4*)(p.in[I_LN2G] + col), gb = *(const float4*)(p.in[I_LN2G] + col + 4), ba = *(const float4*)(p.in[I_LN2B] + col), bb = *(const float4*)(p.in[I_LN2B] + col + 4);
                float4 o0, o1;
                o0.x = (v[c * 8 + 0] - mu) * rs * ga.x + ba.x; o0.y = (v[c * 8 + 1] - mu) * rs * ga.y + ba.y; o0.z = (v[c * 8 + 2] - mu) * rs * ga.z + ba.z; o0.w = (v[c * 8 + 3] - mu) * rs * ga.w + ba.w;
                o1.x = (v[c * 8 + 4] - mu) * rs * gb.x + bb.x; o1.y = (v[c * 8 + 5] - mu) * rs * gb.y + bb.y; o1.z = (v[c * 8 + 6] - mu) * rs * gb.z + bb.z; o1.w = (v[c * 8 + 7] - mu) * rs * gb.w + bb.w;
                *(float4*)(p.out + (size_t)row * 2048 + col) = o0; *(float4*)(p.out + (size_t)row * 2048 + col + 4) = o1; }
          }
        }
    }
}

constexpr int NPHASE = 12;

extern "C" void kernel_launch(void* const* d_in, const int* in_sizes, int n_in, void* d_out, int out_size, void* d_ws, size_t ws_size, hipStream_t stream) {
    static int grid = 0;
    if (grid == 0) {
        if (n_in != 26 || ws_size < WS_END) { fprintf(stderr, "kernel_launch: unexpected n_in %d or ws_size %zu (< %zu)\n", n_in, ws_size, (size_t)WS_END); grid = -1; return; }
        int dev = 0, cus = 0, per_cu = 0;
        hipGetDevice(&dev); hipDeviceGetAttribute(&cus, hipDeviceAttributeMultiprocessorCount, dev);
        if (hipFuncSetAttribute((const void*)fwd, hipFuncAttributeMaxDynamicSharedMemorySize, LDS_BYTES) != hipSuccess) { fprintf(stderr, "hipFuncSetAttribute failed\n"); grid = -1; return; }
        hipOccupancyMaxActiveBlocksPerMultiprocessor(&per_cu, (const void*)fwd, 512, LDS_BYTES);
        (void)hipGetLastError();
        if (per_cu < 1) fprintf(stderr, "occupancy query says %d blocks per CU\n", per_cu);
        grid = cus > 0 ? cus : 256;
    }
    if (grid < 0) return;
    hipMemsetAsync((char*)d_ws + WS_CTL, 0, CTL_BYTES, stream);
    Params p{};
    for (int i = 0; i < 26; ++i) p.in[i] = (const float*)d_in[i];
    p.out = (float*)d_out; p.ws = (unsigned char*)d_ws;
#if N_LAUNCH_MODE == 1
    p.lo_hi = (long long)0 | ((long long)NPHASE << 32);
    hipLaunchKernelGGL(fwd, dim3(grid), dim3(512), LDS_BYTES, stream, p);
#else
    for (int ph = 0; ph < NPHASE; ++ph) {
        p.lo_hi = (long long)ph | ((long long)(ph + 1) << 32);
        hipLaunchKernelGGL(fwd, dim3(grid), dim3(512), LDS_BYTES, stream, p);
    }
#endif
}
```

```cpp
#include <hip/hip_runtime.h>
#include <cstdio>
#include <cstdint>

#ifndef N_LAUNCH_MODE
#define N_LAUNCH_MODE 1
#endif

constexpr int B_ = 8, S_ = 2048, D_ = 2048, T_ = B_ * S_;
constexpr int INW = 3608;
constexpr int C_Q = 0, C_KC = 1024, C_VC = 1280, C_KS = 1536, C_VS = 1792, C_KW = 2048, C_VW = 2304, C_G = 2560, C_UP = 2584, C_QM = 3096;
constexpr int NC = 127;
constexpr int CROWS = B_ * NC * 2;
constexpr int NE = 32, DE = 2048, NA = T_ * 4;
constexpr float LN_EPS = 1e-5f;
constexpr float DN_ALPHA = 1.189207115002721f;
constexpr float ATT_SCALE = 0.08838834764831845f;

constexpr size_t al256(size_t x) { return (x + 255) & ~(size_t)255; }
constexpr size_t WS_CTL = 0;
constexpr size_t CTL_BYTES = 65536;
constexpr size_t CTL_CNT = 16384;
constexpr size_t WS_PROJ = CTL_BYTES;
constexpr size_t WS_KVMEM = WS_PROJ + al256((size_t)T_ * INW * 4);
constexpr size_t WS_BIAS1 = WS_KVMEM + al256((size_t)2048 * 1024 * 4);
constexpr size_t WS_HID = WS_BIAS1 + al256(2 * 16 * 256 * 4);
constexpr size_t WS_KC = WS_HID + al256((size_t)2 * 2048 * 256 * 4);
constexpr size_t WS_VC = WS_KC + al256((size_t)CROWS * 128 * 4);
constexpr size_t WS_POOLED = WS_VC + al256((size_t)CROWS * 128 * 4);
constexpr size_t WS_OPOOL = WS_POOLED + al256((size_t)T_ * 512 * 4);
constexpr size_t WS_OWIN = WS_OPOOL + al256((size_t)T_ * 512 * 4);
constexpr size_t WS_OCMP = WS_OWIN + al256((size_t)T_ * 1024 * 4);
constexpr size_t WS_OSLC = WS_OCMP + al256((size_t)T_ * 1024 * 4);
constexpr size_t WS_SEL = WS_OSLC + al256((size_t)T_ * 1024 * 4);
constexpr size_t WS_OMEM = WS_SEL + al256((size_t)T_ * 2 * 4);
constexpr size_t WS_CAT16 = WS_OMEM + al256((size_t)T_ * 512 * 4);
constexpr size_t WS_HPRE = WS_CAT16 + al256((size_t)T_ * 2048 * 2);
constexpr size_t WS_H = WS_HPRE + al256((size_t)T_ * 2048 * 4);
constexpr size_t WS_H16 = WS_H + al256((size_t)T_ * 2048 * 4);
constexpr size_t WS_GATE = WS_H16 + al256((size_t)T_ * 2048 * 2);
constexpr size_t WS_LIST = WS_GATE + al256((size_t)NA * 4);
constexpr size_t WS_ACT16 = WS_LIST + al256((size_t)NE * T_ * 4);
constexpr size_t WS_Y16 = WS_ACT16 + al256((size_t)(NA + 256) * 2048 * 2);
constexpr size_t WS_X16 = WS_Y16 + al256((size_t)NA * 2048 * 2);
constexpr size_t WS_MEM16 = WS_X16 + (size_t)T_ * 2048 * 2;
constexpr size_t WS_WTIN = WS_MEM16 + al256((size_t)2048 * 2048 * 2);
constexpr size_t WS_WTOUT = WS_WTIN + al256((size_t)3840 * 2048 * 2);
constexpr size_t WS_WTGU = WS_WTOUT + al256((size_t)2048 * 2048 * 2);
constexpr size_t WS_WTDN = WS_WTGU + al256((size_t)NE * 4096 * 2048 * 2);
constexpr size_t WS_PROJ16 = WS_WTDN + al256((size_t)NE * 2048 * 2048 * 2);
constexpr size_t WS_KVMEM16 = WS_PROJ16 + al256((size_t)(T_ + 64) * INW * 2);
constexpr size_t WS_WT1 = WS_KVMEM16 + al256((size_t)2048 * 1024 * 2);
constexpr size_t WS_UV = WS_WT1 + al256((size_t)2 * 512 * 2048 * 2);
constexpr size_t WS_KC16 = WS_UV + al256((size_t)2 * 4 * 2048 * 512 * 4);
constexpr size_t WS_VC16 = WS_KC16 + al256((size_t)B_ * 128 * 256 * 2);
constexpr size_t WS_WR16 = WS_VC16 + al256((size_t)B_ * 128 * 256 * 2);
constexpr size_t WS_Q8GU = WS_WR16 + al256((size_t)32 * 2048 * 2);
constexpr size_t WS_Q8DN = WS_Q8GU + al256((size_t)NE * 4096 * 2048);
constexpr size_t WS_SGU = WS_Q8DN + al256((size_t)NE * 2048 * 2048);
constexpr size_t WS_SDN = WS_SGU + al256((size_t)NE * 4096 * 4);
constexpr size_t WS_H8 = WS_SDN + al256((size_t)NE * 2048 * 4);
constexpr size_t WS_SAH = WS_H8 + al256((size_t)T_ * 2048);
constexpr size_t WS_ACT8 = WS_SAH + al256((size_t)T_ * 4);
constexpr size_t WS_SACT = WS_ACT8 + al256((size_t)(NA + 256) * 2048);
constexpr size_t WS_WTMKV = WS_SACT + al256((size_t)(NA + 256) * 4);
constexpr size_t WS_Q8OUT = WS_WTMKV + al256((size_t)1024 * 2048 * 2);
constexpr size_t WS_SOUT = WS_Q8OUT + al256((size_t)2048 * 2048);
constexpr size_t WS_CAT8 = WS_SOUT + al256(2048 * 4);
constexpr size_t WS_SCAT = WS_CAT8 + al256((size_t)T_ * 2048);
constexpr size_t WS_SA2 = WS_SCAT + al256((size_t)T_ * 4);
constexpr size_t WS_GATE2 = WS_SA2 + al256((size_t)NE * T_ * 4);
constexpr size_t WS_X8 = WS_GATE2 + al256((size_t)NE * T_ * 4);
constexpr size_t WS_SXA = WS_X8 + al256((size_t)(T_ + 2048) * 2048);
constexpr size_t WS_Q8IN = WS_SXA + al256((size_t)(T_ + 2048) * 4);
constexpr size_t WS_SIN8 = WS_Q8IN + al256((size_t)2560 * 2048);
constexpr size_t WS_Q8MKV = WS_SIN8 + al256(2560 * 4);
constexpr size_t WS_SMKV = WS_Q8MKV + al256((size_t)1024 * 2048);
constexpr size_t WS_WT2 = WS_SMKV + al256(1024 * 4);
constexpr size_t WS_KV16 = WS_WT2 + al256((size_t)2 * 128 * 256 * 2);
constexpr size_t KVSEG = (size_t)S_ * 128;
constexpr size_t WS_END = WS_KV16 + al256((size_t)6 * B_ * 2 * S_ * 128 * 2);

constexpr int LDS_BYTES = 159744;

struct Params {
    const float* in[26];
    float* out;
    unsigned char* ws;
    long long lo_hi;
};
enum { I_X = 0, I_MEM, I_WIN, I_POSK, I_W1K, I_W2K, I_POSV, I_W1V, I_W2V, I_POOLW, I_POOLS, I_WMEMKV, I_GNNSA, I_GNPOOL, I_GNMEM, I_WOUT,
       I_LN1G, I_LN1B, I_WR, I_BR, I_WGU, I_BGU, I_WDN, I_BDN, I_LN2G, I_LN2B };

#define XB_TMO      128
#define XB_XCNT(j)  (256  + 64 * (j))
#define XB_XSUB(j)  (1280 + 64 * (j))
#define XB_XGEN(j)  (2304 + 64 * (j))
#define XB_TOP      3328
#define XB_TOPGEN   3392
#define XCD_BAR_WORDS 3456
#define XB_SPIN_CAP (1u << 25)
#define LAS __attribute__((address_space(3)))

__device__ __forceinline__ unsigned xb_ld(unsigned* p)              { return __hip_atomic_load(p, __ATOMIC_RELAXED, __HIP_MEMORY_SCOPE_AGENT); }
__device__ __forceinline__ unsigned xb_add(unsigned* p, unsigned v) { return __hip_atomic_fetch_add(p, v, __ATOMIC_RELAXED, __HIP_MEMORY_SCOPE_AGENT); }
__device__ __forceinline__ unsigned xb_xcc_id() { return (unsigned)__builtin_amdgcn_s_getreg((3 << 11) | 20) & 0xFu; }
#define XB_SPIN(cond, bar) do { unsigned _sp = 0; while (cond) { __builtin_amdgcn_s_sleep(1); \
    if ((++_sp & 255u) == 0u) { if (xb_ld(&(bar)[XB_TMO])) break; if (_sp > XB_SPIN_CAP) { atomicAdd(&(bar)[XB_TMO], 1u); break; } } } } while (0)

struct XcdBarrier { unsigned* bar; unsigned x; volatile LAS unsigned* st; };

__device__ __forceinline__ XcdBarrier xcd_barrier_post(unsigned* bar, volatile LAS unsigned* st) {
    XcdBarrier b; b.bar = bar; b.x = xb_xcc_id(); b.st = st;
    if (threadIdx.x == 0) (void)xb_add(&bar[XB_XCNT(b.x)], 1u);
    return b;
}
__device__ __forceinline__ void xcd_barrier_complete(unsigned* bar, unsigned x, unsigned& nloc, unsigned& nx) {
    const unsigned G = gridDim.x * gridDim.y * gridDim.z;
    unsigned sum, cnt, mine, sp = 0u;
    for (;;) {
        sum = 0u; cnt = 0u; mine = 0u;
#pragma unroll
        for (unsigned j = 0; j < 16; ++j) { const unsigned c = xb_ld(&bar[XB_XCNT(j)]); sum += c; cnt += (c > 0u) ? 1u : 0u; mine = (j == x) ? c : mine; }
        if (sum == G) break;
        __builtin_amdgcn_s_sleep(1);
        if ((++sp & 255u) == 0u) { if (xb_ld(&bar[XB_TMO])) break; if (sp > XB_SPIN_CAP) { atomicAdd(&bar[XB_TMO], 1u); break; } }
    }
    nloc = mine > 0u ? mine : 1u; nx = cnt > 0u ? cnt : 1u;
}
__device__ __forceinline__ void xcd_barrier(const XcdBarrier& b) {
    asm volatile("s_waitcnt vmcnt(0)" ::: "memory");
    __syncthreads();
    if (threadIdx.x == 0) {
        unsigned* bar = b.bar;
        __builtin_amdgcn_s_waitcnt(0);
        unsigned nloc = b.st[0], nx = b.st[1];
        if (nloc == 0u) { xcd_barrier_complete(bar, b.x, nloc, nx); b.st[0] = nloc; b.st[1] = nx; }
        const unsigned old = xb_add(&bar[XB_XSUB(b.x)], 1u);
        const unsigned gen = old / nloc;
        if (old + 1u == (gen + 1u) * nloc) {
            __builtin_amdgcn_fence(__ATOMIC_RELEASE, "agent");
            asm volatile("s_waitcnt vmcnt(0)" ::: "memory");
            const unsigned og = xb_add(&bar[XB_TOP], 1u);
            const unsigned tg = og / nx;
            if (og + 1u == (tg + 1u) * nx) xb_add(&bar[XB_TOPGEN], 1u);
            else XB_SPIN(xb_ld(&bar[XB_TOPGEN]) == tg, bar);
            __builtin_amdgcn_fence(__ATOMIC_ACQUIRE, "agent");
            xb_add(&bar[XB_XGEN(b.x)], 1u);
            asm volatile("s_waitcnt vmcnt(0)" ::: "memory");
        } else {
            XB_SPIN(xb_ld(&bar[XB_XGEN(b.x)]) == gen, bar);
            __builtin_amdgcn_fence(__ATOMIC_ACQUIRE, "agent");
            asm volatile("s_waitcnt vmcnt(0)" ::: "memory");
        }
    }
    __syncthreads();
}

typedef _Float16 h8 __attribute__((ext_vector_type(8)));
typedef _Float16 h4 __attribute__((ext_vector_type(4)));
typedef float f4 __attribute__((ext_vector_type(4)));

__device__ __forceinline__ float wave_sum(float v) {
#pragma unroll
    for (int o = 32; o > 0; o >>= 1) v += __shfl_xor(v, o);
    return v;
}
__device__ __forceinline__ float wave_max(float v) {
#pragma unroll
    for (int o = 32; o > 0; o >>= 1) v = fmaxf(v, __shfl_xor(v, o));
    return v;
}
__device__ __forceinline__ void wave_sync() {
    asm volatile("s_waitcnt lgkmcnt(0)" ::: "memory");
    __builtin_amdgcn_wave_barrier();
}
__device__ __forceinline__ float gelu_tanh(float x) {
    const float u = 0.7978845608028654f * (x + 0.044715f * x * x * x);
    return 0.5f * x * (1.f + tanhf(u));
}
__device__ __forceinline__ float gelu_fast(float x) { const float u = 0.7978845608028654f * (x + 0.044715f * x * x * x); const float t = 1.f - 2.f * __builtin_amdgcn_rcpf(1.f + __builtin_amdgcn_exp2f(2.8853900817779268f * u)); return 0.5f * x * (1.f + t); }
__device__ __forceinline__ float sigmoidf_(float x) { return 1.f / (1.f + expf(-x)); }
__device__ __forceinline__ unsigned pk4_fp8(float a, float b, float c, float d) { int w = 0; w = __builtin_amdgcn_cvt_pk_fp8_f32(a, b, w, false); w = __builtin_amdgcn_cvt_pk_fp8_f32(c, d, w, true); return (unsigned)w; }
__device__ __forceinline__ void dec4_fp8(unsigned w, float& a, float& b, float& c, float& d) { a = __builtin_amdgcn_cvt_f32_fp8((int)w, 0); b = __builtin_amdgcn_cvt_f32_fp8((int)w, 1); c = __builtin_amdgcn_cvt_f32_fp8((int)w, 2); d = __builtin_amdgcn_cvt_f32_fp8((int)w, 3); }
__device__ __forceinline__ float swiglu_fast(float g, float l) { const float xg = fminf(g, 7.f), xl = fminf(fmaxf(l, -7.f), 7.f); return xg * __builtin_amdgcn_rcpf(1.f + __builtin_amdgcn_exp2f(-2.4554669595930156f * xg)) * (xl + 1.f); }

constexpr int G_LD = 40;
template <class AF, class EF>
__device__ __forceinline__ void gemm_tile(char* smem, int K, const AF& af, const float* __restrict__ Bm, int ldb, int n0, int Nlim, bool perm, const EF& ef) {
    _Float16* As = (_Float16*)smem;
    _Float16* Bs = As + 128 * G_LD;
    const int tid = threadIdx.x, lane = tid & 63, wid = tid >> 6, wr = wid >> 2, wc = wid & 3, fr = lane & 15, fq = lane >> 4;
    f4 acc[4][2];
#pragma unroll
    for (int m = 0; m < 4; ++m)
#pragma unroll
        for (int n = 0; n < 2; ++n) acc[m][n] = (f4){0.f, 0.f, 0.f, 0.f};
    const int ar = tid >> 3, ak = (tid & 7) * 4;
    const float* ap0 = af.row(ar);
    const float* ap1 = af.row(ar + 64);
    const int bk = tid >> 5, bn = (tid & 31) * 4;
    const bool bok = (n0 + bn) < Nlim;
    int bnp[4];
#pragma unroll
    for (int i = 0; i < 4; ++i) { const int c = bn + i; bnp[i] = perm ? ((c & ~31) | ((c & 1) << 4) | ((c & 31) >> 1)) : c; }
    for (int k0 = 0; k0 < K; k0 += 32) {
        const int ko = af.koff(k0 + ak);
        float4 a0 = make_float4(0.f, 0.f, 0.f, 0.f), a1 = a0, b0 = a0, b1 = a0;
        if (ap0) a0 = *(const float4*)(ap0 + ko);
        if (ap1) a1 = *(const float4*)(ap1 + ko);
        if (bok) { b0 = *(const float4*)(Bm + (size_t)(k0 + bk) * ldb + n0 + bn); b1 = *(const float4*)(Bm + (size_t)(k0 + bk + 16) * ldb + n0 + bn); }
        __syncthreads();
        *(h4*)&As[ar * G_LD + ak] = (h4){(_Float16)a0.x, (_Float16)a0.y, (_Float16)a0.z, (_Float16)a0.w};
        *(h4*)&As[(ar + 64) * G_LD + ak] = (h4){(_Float16)a1.x, (_Float16)a1.y, (_Float16)a1.z, (_Float16)a1.w};
        Bs[bnp[0] * G_LD + bk] = (_Float16)b0.x; Bs[bnp[1] * G_LD + bk] = (_Float16)b0.y; Bs[bnp[2] * G_LD + bk] = (_Float16)b0.z; Bs[bnp[3] * G_LD + bk] = (_Float16)b0.w;
        Bs[bnp[0] * G_LD + bk + 16] = (_Float16)b1.x; Bs[bnp[1] * G_LD + bk + 16] = (_Float16)b1.y; Bs[bnp[2] * G_LD + bk + 16] = (_Float16)b1.z; Bs[bnp[3] * G_LD + bk + 16] = (_Float16)b1.w;
        __syncthreads();
        h8 a[4], b[2];
#pragma unroll
        for (int m = 0; m < 4; ++m) a[m] = *(const h8*)&As[(wr * 64 + m * 16 + fr) * G_LD + fq * 8];
#pragma unroll
        for (int n = 0; n < 2; ++n) b[n] = *(const h8*)&Bs[(wc * 32 + n * 16 + fr) * G_LD + fq * 8];
#pragma unroll
        for (int m = 0; m < 4; ++m)
#pragma unroll
            for (int n = 0; n < 2; ++n) acc[m][n] = __builtin_amdgcn_mfma_f32_16x16x32_f16(a[m], b[n], acc[m][n], 0, 0, 0);
    }
    ef(acc, wr, wc, fr, fq);
    __syncthreads();
}

struct ARowPlain { const float* base; int ld; int m0; int mlim;
    __device__ __forceinline__ const float* row(int r) const { return (m0 + r) < mlim ? base + (size_t)(m0 + r) * ld : nullptr; }
    __device__ __forceinline__ int koff(int k) const { return k; } };
struct ARowCmp { const float* proj; int col; int m0;
    __device__ __forceinline__ const float* row(int r) const { const int g = m0 + r; if (g >= CROWS) return nullptr; const int kvh = g & 1, bc = g >> 1, b = bc / NC, c = bc % NC;
        return proj + (size_t)(b * S_ + 16 * c) * INW + col + kvh * 128; }
    __device__ __forceinline__ int koff(int k) const { return (k >> 7) * INW + (k & 127); } };
struct ARowList { const float* base; const int* list; int m0; int cnt; int shift;
    __device__ __forceinline__ const float* row(int r) const { if (m0 + r >= cnt) return nullptr; const int a = list[m0 + r]; return base + (size_t)(a >> shift) * 2048; }
    __device__ __forceinline__ int koff(int k) const { return k; } };

struct EpiStore { float* C; int ldc; int m0; int n0; int mlim; int nlim; _Float16* C16;
    __device__ __forceinline__ void operator()(const f4 (&acc)[4][2], int wr, int wc, int fr, int fq) const {
#pragma unroll
        for (int m = 0; m < 4; ++m)
#pragma unroll
            for (int n = 0; n < 2; ++n)
#pragma unroll
                for (int j = 0; j < 4; ++j) { const int r = m0 + wr * 64 + m * 16 + fq * 4 + j, c = n0 + wc * 32 + n * 16 + fr;
                    if (r < mlim && c < nlim) { C[(size_t)r * ldc + c] = acc[m][n][j]; if (C16) C16[(size_t)r * ldc + c] = (_Float16)acc[m][n][j]; } } } };
struct EpiKc { _Float16* C; int m0;
    __device__ __forceinline__ void operator()(const f4 (&acc)[4][2], int wr, int wc, int fr, int fq) const {
#pragma unroll
        for (int m = 0; m < 4; ++m)
#pragma unroll
            for (int n = 0; n < 2; ++n)
#pragma unroll
                for (int j = 0; j < 4; ++j) { const int r = m0 + wr * 64 + m * 16 + fq * 4 + j, c = wc * 32 + n * 16 + fr;
                    C[(size_t)r * 128 + c] = (((r >> 1) & 127) == 127) ? (_Float16)0.f : (_Float16)acc[m][n][j]; } } };
struct EpiPool { _Float16* C; const float* scale; int m0; int g;
    __device__ __forceinline__ void operator()(const f4 (&acc)[4][2], int wr, int wc, int fr, int fq) const {
#pragma unroll
        for (int m = 0; m < 4; ++m)
#pragma unroll
            for (int n = 0; n < 2; ++n)
#pragma unroll
                for (int j = 0; j < 4; ++j) { const int r = m0 + wr * 64 + m * 16 + fq * 4 + j, c = g * 128 + wc * 32 + n * 16 + fr;
                    C[(size_t)r * 512 + c] = (_Float16)(acc[m][n][j] * scale[c]); } } };
struct EpiHid { float* C; const float* bias; int m0; int n0;
    __device__ __forceinline__ void operator()(const f4 (&acc)[4][2], int wr, int wc, int fr, int fq) const {
#pragma unroll
        for (int m = 0; m < 4; ++m)
#pragma unroll
            for (int n = 0; n < 2; ++n)
#pragma unroll
                for (int j = 0; j < 4; ++j) { const int r = m0 + wr * 64 + m * 16 + fq * 4 + j, c = n0 + wc * 32 + n * 16 + fr;
                    if (r < CROWS) C[(size_t)r * 256 + c] = gelu_tanh(acc[m][n][j] + bias[c]); } } };
struct EpiOut { float* C; const float* x; int m0; int n0;
    __device__ __forceinline__ void operator()(const f4 (&acc)[4][2], int wr, int wc, int fr, int fq) const {
#pragma unroll
        for (int m = 0; m < 4; ++m)
#pragma unroll
            for (int n = 0; n < 2; ++n)
#pragma unroll
                for (int j = 0; j < 4; ++j) { const size_t o = (size_t)(m0 + wr * 64 + m * 16 + fq * 4 + j) * 2048 + n0 + wc * 32 + n * 16 + fr;
                    C[o] = DN_ALPHA * x[o] + acc[m][n][j]; } } };
struct EpiGu { float* act; const float* bgu; const int* list; int m0; int cnt; int n0;
    __device__ __forceinline__ void operator()(const f4 (&acc)[4][2], int wr, int wc, int fr, int fq) const {
        const int jc = (n0 + wc * 32) / 2 + fr;
        const float bg = bgu[2 * jc], bl = bgu[2 * jc + 1];
#pragma unroll
        for (int m = 0; m < 4; ++m)
#pragma unroll
            for (int j = 0; j < 4; ++j) { const int r = m0 + wr * 64 + m * 16 + fq * 4 + j;
                if (r < cnt) { const int a = list[r];
                    const float xg = fminf(acc[m][0][j] + bg, 7.f), xl = fminf(fmaxf(acc[m][1][j] + bl, -7.f), 7.f);
                    act[(size_t)a * 2048 + jc] = xg * sigmoidf_(1.702f * xg) * (xl + 1.f); } } } };
struct EpiDn { float* y; const float* bdn; const int* list; const float* gate; int m0; int cnt; int n0;
    __device__ __forceinline__ void operator()(const f4 (&acc)[4][2], int wr, int wc, int fr, int fq) const {
#pragma unroll
        for (int m = 0; m < 4; ++m)
#pragma unroll
            for (int j = 0; j < 4; ++j) { const int r = m0 + wr * 64 + m * 16 + fq * 4 + j;
                if (r < cnt) { const int a = list[r]; const float g = gate[a];
#pragma unroll
                    for (int n = 0; n < 2; ++n) { const int c = n0 + wc * 32 + n * 16 + fr; y[(size_t)a * 2048 + c] = (acc[m][n][j] + bdn[c]) * g; } } } } };

constexpr int WLDS_FLOATS = 4096 + 512 + 32;
template <bool SHARED>
__device__ __forceinline__ void wave_attn(float* sw, const float* __restrict__ qptr, const float* __restrict__ Kb, const float* __restrict__ Vb, int ld, int nseg, float scale, float* __restrict__ optr) {
    const int lane = threadIdx.x & 63;
    float* sq = sw + 4096; const int* segs = (const int*)(sw + 4096 + 512);
#pragma unroll
    for (int i = 0; i < 8; ++i) sq[lane + 64 * i] = qptr[lane + 64 * i];
    wave_sync();
    for (int sg = 0; sg < nseg; ++sg) {
        const int start = segs[sg], len = segs[16 + sg];
        float d0 = 0.f, d1 = 0.f, d2 = 0.f, d3 = 0.f;
        if (lane < len) {
            const float* kp = Kb + (size_t)(start + lane) * ld;
            for (int d4 = 0; d4 < 32; ++d4) {
                if (SHARED) {
                    const float4 kv = *(const float4*)(kp + d4 * 4);
                    const float4 q0 = *(const float4*)(sq + d4 * 4), q1 = *(const float4*)(sq + 128 + d4 * 4), q2 = *(const float4*)(sq + 256 + d4 * 4), q3 = *(const float4*)(sq + 384 + d4 * 4);
                    d0 += kv.x * q0.x + kv.y * q0.y + kv.z * q0.z + kv.w * q0.w;
                    d1 += kv.x * q1.x + kv.y * q1.y + kv.z * q1.z + kv.w * q1.w;
                    d2 += kv.x * q2.x + kv.y * q2.y + kv.z * q2.z + kv.w * q2.w;
                    d3 += kv.x * q3.x + kv.y * q3.y + kv.z * q3.z + kv.w * q3.w;
                } else {
                    const float4 k0 = *(const float4*)(kp + d4 * 4), k1 = *(const float4*)(kp + 128 + d4 * 4), k2 = *(const float4*)(kp + 256 + d4 * 4), k3 = *(const float4*)(kp + 384 + d4 * 4);
                    const float4 q0 = *(const float4*)(sq + d4 * 4), q1 = *(const float4*)(sq + 128 + d4 * 4), q2 = *(const float4*)(sq + 256 + d4 * 4), q3 = *(const float4*)(sq + 384 + d4 * 4);
                    d0 += k0.x * q0.x + k0.y * q0.y + k0.z * q0.z + k0.w * q0.w;
                    d1 += k1.x * q1.x + k1.y * q1.y + k1.z * q1.z + k1.w * q1.w;
                    d2 += k2.x * q2.x + k2.y * q2.y + k2.z * q2.z + k2.w * q2.w;
                    d3 += k3.x * q3.x + k3.y * q3.y + k3.z * q3.z + k3.w * q3.w;
                }
            }
        }
        const bool ok = lane < len;
        sw[sg * 64 + lane] = ok ? d0 * scale : -1e30f;
        sw[1024 + sg * 64 + lane] = ok ? d1 * scale : -1e30f;
        sw[2048 + sg * 64 + lane] = ok ? d2 * scale : -1e30f;
        sw[3072 + sg * 64 + lane] = ok ? d3 * scale : -1e30f;
    }
    wave_sync();
    const int n = nseg * 64;
#pragma unroll
    for (int g = 0; g < 4; ++g) {
        float mx = -1e30f;
        for (int i = lane; i < n; i += 64) mx = fmaxf(mx, sw[g * 1024 + i]);
        mx = wave_max(mx);
        float sm = 0.f;
        for (int i = lane; i < n; i += 64) { const float v = sw[g * 1024 + i]; sm += (v > -1e29f) ? expf(v - mx) : 0.f; }
        sm = wave_sum(sm);
        const float inv = sm > 0.f ? 1.f / sm : 0.f;
        for (int i = lane; i < n; i += 64) { const float v = sw[g * 1024 + i]; sw[g * 1024 + i] = (v > -1e29f) ? expf(v - mx) * inv : 0.f; }
    }
    wave_sync();
    float o[4][2];
#pragma unroll
    for (int g = 0; g < 4; ++g) { o[g][0] = 0.f; o[g][1] = 0.f; }
    for (int sg = 0; sg < nseg; ++sg) {
        const int start = segs[sg], len = segs[16 + sg];
        for (int l = 0; l < len; ++l) {
            const float* vp = Vb + (size_t)(start + l) * ld;
            if (SHARED) {
                const float v0 = vp[lane], v1 = vp[lane + 64];
#pragma unroll
                for (int g = 0; g < 4; ++g) { const float p = sw[g * 1024 + sg * 64 + l]; o[g][0] += p * v0; o[g][1] += p * v1; }
            } else {
#pragma unroll
                for (int g = 0; g < 4; ++g) { const float p = sw[g * 1024 + sg * 64 + l]; o[g][0] += p * vp[g * 128 + lane]; o[g][1] += p * vp[g * 128 + lane + 64]; }
            }
        }
    }
#pragma unroll
    for (int g = 0; g < 4; ++g) { optr[g * 128 + lane] = o[g][0]; optr[g * 128 + lane + 64] = o[g][1]; }
}

namespace g8 {
constexpr int BM = 256, BK = 64, HALF = 128, HTB = HALF * BK * 2, STAGE_BYTES = 8 * HTB;
constexpr int KK = 2048;
typedef float f32x4 __attribute__((ext_vector_type(4)));
__device__ __forceinline__ int lds_byte(int r, int c) { return r * 128 + ((((c >> 3) ^ (r >> 1)) & 7) << 4) + (c & 7) * 2; }
__device__ __forceinline__ void stage_rc(int b, int& R, int& C) { R = b >> 7; C = ((((b >> 4) ^ (R >> 1)) & 7)) * 8; }
__device__ __forceinline__ int perm32(int rho) { const int n = rho >> 4, i = rho & 15; return 8 * (i >> 2) + 4 * n + (i & 3); }

typedef int i32x4 __attribute__((ext_vector_type(4)));
typedef unsigned u32x2 __attribute__((ext_vector_type(2)));
typedef unsigned u32x4 __attribute__((ext_vector_type(4)));
template <bool I8> struct AccSel { typedef f32x4 T; };
template <> struct AccSel<true> { typedef i32x4 T; };
__device__ __forceinline__ f32x4 mma16(i32x4 a, i32x4 b, f32x4 c) { return __builtin_amdgcn_mfma_f32_16x16x32_f16(*reinterpret_cast<h8*>(&a), *reinterpret_cast<h8*>(&b), c, 0, 0, 0); }
__device__ __forceinline__ i32x4 mma16(i32x4 a, i32x4 b, i32x4 c) { return __builtin_amdgcn_mfma_i32_16x16x64_i8(a, b, c, 0, 0, 0); }
struct Unit { int m0, n0, e, cnt, rbase; };
constexpr int EP_OFF = STAGE_BYTES + 2048, EP_LD = 528, EP_GRP = 16 * EP_LD;
constexpr int CONST_OFF = EP_OFF + 18432;
__device__ __forceinline__ void cdma(LAS unsigned char* lds, int region, int idx, const void* src) { __builtin_amdgcn_global_load_lds((const unsigned*)src, (LAS unsigned*)(lds + CONST_OFF + region * 1024 + idx * 256), 4, 0, 0); }
__device__ __forceinline__ void ep_sync() { asm volatile("s_waitcnt lgkmcnt(0)" ::: "memory"); __builtin_amdgcn_s_barrier(); asm volatile("" ::: "memory"); }
__device__ __forceinline__ int ep_tid() { int tz = threadIdx.x; asm volatile("" : "+v"(tz)); return tz; }
__device__ __forceinline__ h8 cvt8(f32x4 a, f32x4 b) { h8 o; o[0] = (_Float16)a[0]; o[1] = (_Float16)a[1]; o[2] = (_Float16)a[2]; o[3] = (_Float16)a[3]; o[4] = (_Float16)b[0]; o[5] = (_Float16)b[1]; o[6] = (_Float16)b[2]; o[7] = (_Float16)b[3]; return o; }

__device__ __forceinline__ void tile_order(int L, int nM, int nN, int& pm, int& pn) {
    const int nwg = nM * nN; int wgid = L;
    { const int q = nwg / 8, r = nwg % 8, xcd = wgid % 8, off = wgid / 8; wgid = (xcd < r ? xcd * (q + 1) : r * (q + 1) + (xcd - r) * q) + off; }
    const int nig = 8 * nN, gid = wgid / nig, fm = gid * 8, gsz = (nM - fm) < 8 ? (nM - fm) : 8;
    pm = fm + ((wgid % nig) % gsz); pn = (wgid % nig) / gsz;
}

template <class Prob>
__device__ __forceinline__ void gemm_phase(LAS unsigned char* lds, const Prob& P) {
    const int tid = threadIdx.x, wid = __builtin_amdgcn_readfirstlane(tid >> 6), lane = tid & 63, wr = wid >> 2, wc = wid & 3, fr = lane & 15, fq = lane >> 4;
    constexpr int nt = Prob::NT; constexpr size_t KS2 = Prob::KS2; constexpr unsigned ROWB = Prob::ROWB; constexpr bool I8 = Prob::I8;
    int sR[2], sC2[2]; unsigned voffB[2];
#pragma unroll
    for (int i = 0; i < 2; ++i) { int R, C; stage_rc(tid * 16 + i * 8192, R, C); sR[i] = R; sC2[i] = C * 2; const int Rb = Prob::PERM ? ((R & ~31) + perm32(R & 31)) : R; voffB[i] = (unsigned)Rb * ROWB + (unsigned)C * 2u; }
    const size_t kstep = (size_t)(BK * 2);
    const size_t hstep = (size_t)HALF * ROWB;
    const unsigned ldsw = (unsigned)wid * 1024u;
    const int aoff = lds_byte(wr * 64 + fr, fq * 8), boff = lds_byte(wc * 32 + fr, fq * 8), aoff1 = lds_byte(wr * 64 + fr, fq * 8 + 32), boff1 = lds_byte(wc * 32 + fr, fq * 8 + 32);
#define G8_SA(b, h) (((b) * 2 + (h)) * HTB)
#define G8_SB(b, h) ((4 + (b) * 2 + (h)) * HTB)
#define G8_STAGE(bufoff, gbase, voff) do { _Pragma("unroll") for (int _i = 0; _i < 2; ++_i) \
        __builtin_amdgcn_global_load_lds((const unsigned*)((const char*)(gbase) + (voff)[_i]), (LAS unsigned*)(lds + (bufoff) + ldsw + _i * 8192), 16, 0, 0); } while (0)
#define G8_LDA(dst, b, h) do { _Pragma("unroll") for (int m = 0; m < 4; ++m) _Pragma("unroll") for (int k = 0; k < 2; ++k) dst[m][k] = *(const LAS i32x4*)(lds + G8_SA(b, h) + (k ? aoff1 : aoff) + m * 2048); } while (0)
#define G8_LDB(dst, b, h) do { _Pragma("unroll") for (int n = 0; n < 2; ++n) _Pragma("unroll") for (int k = 0; k < 2; ++k) dst[n][k] = *(const LAS i32x4*)(lds + G8_SB(b, h) + (k ? boff1 : boff) + n * 2048); } while (0)
#define G8_MMA(ai, bj, At, Bt) do { __builtin_amdgcn_s_setprio(1); _Pragma("unroll") for (int m = 0; m < 4; ++m) _Pragma("unroll") for (int n = 0; n < 2; ++n) _Pragma("unroll") for (int k = 0; k < 2; ++k) \
        acc[ai][bj][m][n] = mma16(Bt[n][k], At[m][k], acc[ai][bj][m][n]); __builtin_amdgcn_s_setprio(0); } while (0)
#define G8_WAIT_V(n) asm volatile("s_waitcnt vmcnt(" #n ")" ::: "memory")
#define G8_WAIT_L(n) asm volatile("s_waitcnt lgkmcnt(" #n ")" ::: "memory")
#define G8_BAR __builtin_amdgcn_s_barrier()
#define G8_SCHED __builtin_amdgcn_sched_barrier(0)
    Unit cur, nxt; int ui = 0;
    if (!P.next(0, cur)) return;
    typedef typename AccSel<I8>::T AccT;
    AccT acc[2][2][4][2];
#pragma unroll
    for (int a = 0; a < 2; ++a)
#pragma unroll
        for (int b = 0; b < 2; ++b)
#pragma unroll
            for (int m = 0; m < 4; ++m)
#pragma unroll
                for (int n = 0; n < 2; ++n) acc[a][b][m][n] = AccT{};
    i32x4 At[4][2], B0[2][2], B1[2][2];
    unsigned vc[2][2], vn[2][2];
    P.a_offs(cur, sR, sC2, vc);
    const char* const Ab = P.a_base();
    const char* cB = P.b_base(cur);
    G8_STAGE(G8_SB(0, 0), cB, voffB); G8_STAGE(G8_SA(0, 0), Ab, vc[0]); G8_STAGE(G8_SB(0, 1), cB + hstep, voffB); G8_STAGE(G8_SA(0, 1), Ab, vc[1]);
    if (wr == 1) G8_BAR;
    G8_WAIT_V(4); G8_BAR;
    G8_STAGE(G8_SB(1, 0), cB + kstep, voffB); G8_STAGE(G8_SA(1, 0), Ab + kstep, vc[0]); G8_STAGE(G8_SB(1, 1), cB + hstep + kstep, voffB);
    G8_WAIT_V(6); G8_BAR;
    for (;;) {
        const bool has_next = P.next(ui + 1, nxt);
        const char* nB = cB;
        if (has_next) { P.a_offs(nxt, sR, sC2, vn); nB = P.b_base(nxt); }
        else { vn[0][0] = vc[0][0]; vn[0][1] = vc[0][1]; vn[1][0] = vc[1][0]; vn[1][1] = vc[1][1]; }
        for (int t = 0; t < nt; t += 2) {
            const bool last = (t == nt - 2);
            if constexpr (Prob::CD) { if (last) P.const_dma(cur, lds, wid, lane); }
            const char* a1 = Ab + (size_t)(t >> 1) * KS2 + kstep;
            const char* a2 = last ? Ab : Ab + (size_t)((t + 2) >> 1) * KS2; const char* b2 = last ? nB : cB + (size_t)(t + 2) * kstep;
            const char* a3 = a2 + kstep; const char* b3 = b2 + kstep;
            unsigned o2[2][2];
            o2[0][0] = last ? vn[0][0] : vc[0][0]; o2[0][1] = last ? vn[0][1] : vc[0][1]; o2[1][0] = last ? vn[1][0] : vc[1][0]; o2[1][1] = last ? vn[1][1] : vc[1][1];
            G8_LDB(B0, 0, 0); G8_SCHED; G8_LDA(At, 0, 0); G8_STAGE(G8_SA(1, 1), a1, vc[1]);
            G8_WAIT_L(8); G8_BAR; G8_WAIT_L(0); G8_MMA(0, 0, At, B0); G8_BAR; G8_SCHED;
            G8_LDB(B1, 0, 1); G8_STAGE(G8_SB(0, 0), b2, voffB);
            G8_BAR; G8_WAIT_L(0); G8_MMA(0, 1, At, B1); G8_BAR;
            G8_LDA(At, 0, 1); G8_STAGE(G8_SA(0, 0), a2, o2[0]);
            G8_BAR; G8_WAIT_L(0); G8_MMA(1, 0, At, B0); G8_BAR; G8_SCHED;
            G8_STAGE(G8_SB(0, 1), b2 + hstep, voffB);
            G8_WAIT_V(6); G8_BAR; G8_MMA(1, 1, At, B1); G8_BAR;
            G8_LDB(B0, 1, 0); G8_SCHED; G8_LDA(At, 1, 0); G8_STAGE(G8_SA(0, 1), a2, o2[1]);
            G8_WAIT_L(8); G8_BAR; G8_WAIT_L(0); G8_MMA(0, 0, At, B0); G8_BAR; G8_SCHED;
            G8_LDB(B1, 1, 1); G8_STAGE(G8_SB(1, 0), b3, voffB);
            G8_BAR; G8_WAIT_L(0); G8_MMA(0, 1, At, B1); G8_BAR;
            G8_LDA(At, 1, 1); G8_STAGE(G8_SA(1, 0), a3, o2[0]);
            G8_BAR; G8_WAIT_L(0); G8_MMA(1, 0, At, B0); G8_BAR; G8_SCHED;
            G8_STAGE(G8_SB(1, 1), b3 + hstep, voffB);
            G8_WAIT_V(6); G8_BAR; G8_MMA(1, 1, At, B1); G8_BAR;
        }
        P.epi(acc, cur, wr, wc, fr, fq, lds);
        if (!has_next) break;
#pragma unroll
        for (int a = 0; a < 2; ++a)
#pragma unroll
            for (int b = 0; b < 2; ++b)
#pragma unroll
                for (int m = 0; m < 4; ++m)
#pragma unroll
                    for (int n = 0; n < 2; ++n) acc[a][b][m][n] = AccT{};
        cur = nxt; cB = nB; ++ui;
        vc[0][0] = vn[0][0]; vc[0][1] = vn[0][1]; vc[1][0] = vn[1][0]; vc[1][1] = vn[1][1];
    }
    G8_WAIT_V(0);
    if (wr == 0) G8_BAR;
    G8_BAR;
#undef G8_SA
#undef G8_SB
#undef G8_STAGE
#undef G8_LDA
#undef G8_LDB
#undef G8_MMA
#undef G8_WAIT_V
#undef G8_WAIT_L
#undef G8_BAR
#undef G8_SCHED
}

struct ProbInF {
    static constexpr bool CD = false;
    static constexpr unsigned ROWB = 4096; static constexpr bool I8 = false;
    static constexpr int NT = 32; static constexpr size_t KS2 = 256;
    static constexpr bool PERM = true;
    const _Float16* A; _Float16* C16; int G, c;
    __device__ __forceinline__ bool next(int i, Unit& u) const { const int L = i * G + c; if (L >= 64 * 5) return false;
        int pm, pn; tile_order(L, 64, 5, pm, pn); u.m0 = pm * 256; u.n0 = pn * 256; u.e = 0; u.cnt = 256; u.rbase = 0; return true; }
    __device__ __forceinline__ void a_offs(const Unit& u, const int (&R)[2], const int (&C2)[2], unsigned (&v)[2][2]) const {
#pragma unroll
        for (int h = 0; h < 2; ++h)
#pragma unroll
            for (int i = 0; i < 2; ++i) v[h][i] = (unsigned)(u.m0 + h * 128 + R[i]) * (unsigned)(KK * 2) + (unsigned)C2[i]; }
    __device__ __forceinline__ const char* a_base() const { return (const char*)A; }
    __device__ __forceinline__ const char* b_base(const Unit& u) const { return (const char*)A + (long long)(WS_WTIN - WS_X16) + (size_t)u.n0 * KK * 2; }
    __device__ __forceinline__ void epi(const f32x4 (&acc)[2][2][4][2], const Unit& u, int wr, int wc, int fr, int fq, LAS unsigned char* lds) const {
        LAS unsigned char* ep = lds + EP_OFF + wr * EP_GRP;
        const int tg = ep_tid() & 255, rrow = tg >> 4, ch = tg & 15;
        const int kvseg = (u.e == 0 && u.n0 >= 1024 && u.n0 < 2560) ? ((u.n0 - 1024) >> 8) : -1;
        _Float16* const Cb = (_Float16*)((char*)C16 + (u.e ? (long long)(WS_KVMEM16 - WS_PROJ16) : 0ll)); const int ldc = u.e ? 1024 : INW, nlim = u.e ? 1024 : INW, mb = u.e ? u.m0 - T_ : u.m0;
#pragma unroll
        for (int ai = 0; ai < 2; ++ai)
#pragma unroll
            for (int m = 0; m < 4; ++m) {
#pragma unroll
                for (int bj = 0; bj < 2; ++bj) *(LAS h8*)(ep + fr * EP_LD + (bj * 128 + wc * 32 + fq * 8) * 2) = cvt8(acc[ai][bj][m][0], acc[ai][bj][m][1]);
                ep_sync();
                const h8 x0 = *(const LAS h8*)(ep + rrow * EP_LD + ch * 32), x1 = *(const LAS h8*)(ep + rrow * EP_LD + ch * 32 + 16);
                const int grow = mb + ai * 128 + wr * 64 + m * 16 + rrow, gcol = u.n0 + ch * 16;
                if (kvseg >= 0) {
                    _Float16* dst = (_Float16*)((char*)C16 + (long long)(WS_KV16 - WS_PROJ16)) + ((size_t)(kvseg * B_ + (grow >> 11)) * 2 + (ch >> 3)) * KVSEG + (size_t)(grow & (S_ - 1)) * 128 + (ch & 7) * 16;
                    *(h8*)dst = x0; *(h8*)(dst + 8) = x1;
                } else {
                    if (gcol < nlim) *(h8*)(Cb + (size_t)grow * ldc + gcol) = x0;
                    if (gcol + 8 < nlim) *(h8*)(Cb + (size_t)grow * ldc + gcol + 8) = x1; }
                ep_sync();
            } }
};
struct ProbIn8 {
    static constexpr bool CD = true;
    static constexpr unsigned ROWB = 2048; static constexpr bool I8 = true;
    static constexpr int NT = 16; static constexpr size_t KS2 = 256;
    static constexpr bool PERM = true;
    const signed char* A; _Float16* C16; const float* sa; int G, c;
    __device__ __forceinline__ bool next(int i, Unit& u) const { const int L = i * G + c; if (L >= 640 + 32) return false;
        if (L < 640) { int pm, pn; tile_order(L, 64, 10, pm, pn); u.m0 = pm * 256; u.n0 = 1280 + pn * 256; u.e = 0; }
        else { const int v = L - 640; u.m0 = T_ + (v & 7) * 256; u.n0 = (v >> 3) * 256; u.e = 1; }
        u.cnt = 256; u.rbase = 0; return true; }
    __device__ __forceinline__ void a_offs(const Unit& u, const int (&R)[2], const int (&C2)[2], unsigned (&v)[2][2]) const {
#pragma unroll
        for (int h = 0; h < 2; ++h)
#pragma unroll
            for (int i = 0; i < 2; ++i) v[h][i] = (unsigned)(u.m0 + h * 128 + R[i]) * 2048u + (unsigned)C2[i]; }
    __device__ __forceinline__ const char* a_base() const { return (const char*)A; }
    __device__ __forceinline__ const char* b_base(const Unit& u) const { return (const char*)A + (u.e ? (long long)(WS_Q8MKV - WS_X8) + (long long)u.n0 * 2048 : (long long)(WS_Q8IN - WS_X8) + (long long)(u.n0 - 1280) * 2048); }
    __device__ __forceinline__ void const_dma(const Unit& u, LAS unsigned char* lds, int wid, int lane) const {
        const int i4 = wid & 3;
        if (wid < 4) cdma(lds, 1, i4, (const float*)((const char*)A + (u.e ? (long long)(WS_SMKV - WS_X8) : (long long)(WS_SIN8 - WS_X8))) + (u.e ? u.n0 : u.n0 - 1280) + i4 * 64 + lane);
        else cdma(lds, 2, i4, sa + u.m0 + i4 * 64 + lane);
    }
    __device__ __forceinline__ void epi(const i32x4 (&acc)[2][2][4][2], const Unit& u, int wr, int wc, int fr, int fq, LAS unsigned char* lds) const {
        asm volatile("s_waitcnt vmcnt(16)" ::: "memory");
        ep_sync();
        LAS unsigned char* ep = lds + EP_OFF + wr * EP_GRP;
        const int tg = ep_tid() & 255, rrow = tg >> 4, ch = tg & 15;
        const int kvseg = (u.e == 0 && u.n0 >= 1024 && u.n0 < 2560) ? ((u.n0 - 1024) >> 8) : -1;
        _Float16* const Cb = (_Float16*)((char*)C16 + (u.e ? (long long)(WS_KVMEM16 - WS_PROJ16) : 0ll)); const int ldc = u.e ? 1024 : INW, nlim = u.e ? 1024 : INW, mb = u.e ? u.m0 - T_ : u.m0;
        const LAS float* cst = (const LAS float*)(lds + CONST_OFF);
        f32x4 s0[2], s1[2]; float srv[8];
#pragma unroll
        for (int bj = 0; bj < 2; ++bj) { const int col = bj * 128 + wc * 32 + fq * 8; s0[bj] = *(const LAS f32x4*)(cst + 256 + col); s1[bj] = *(const LAS f32x4*)(cst + 256 + col + 4); }
#pragma unroll
        for (int q = 0; q < 8; ++q) srv[q] = cst[512 + (q >> 2) * 128 + wr * 64 + (q & 3) * 16 + fr];
#pragma unroll
        for (int ai = 0; ai < 2; ++ai)
#pragma unroll
            for (int m = 0; m < 4; ++m) { const float sr = srv[ai * 4 + m];
#pragma unroll
                for (int bj = 0; bj < 2; ++bj) { const i32x4 i0 = acc[ai][bj][m][0], i1 = acc[ai][bj][m][1];
                    *(LAS h8*)(ep + fr * EP_LD + (bj * 128 + wc * 32 + fq * 8) * 2) = cvt8((f32x4){(float)i0[0], (float)i0[1], (float)i0[2], (float)i0[3]} * (s0[bj] * sr), (f32x4){(float)i1[0], (float)i1[1], (float)i1[2], (float)i1[3]} * (s1[bj] * sr)); }
                ep_sync();
                const h8 x0 = *(const LAS h8*)(ep + rrow * EP_LD + ch * 32), x1 = *(const LAS h8*)(ep + rrow * EP_LD + ch * 32 + 16);
                const int grow = mb + ai * 128 + wr * 64 + m * 16 + rrow, gcol = u.n0 + ch * 16;
                if (kvseg >= 0) {
                    _Float16* dst = (_Float16*)((char*)C16 + (long long)(WS_KV16 - WS_PROJ16)) + ((size_t)(kvseg * B_ + (grow >> 11)) * 2 + (ch >> 3)) * KVSEG + (size_t)(grow & (S_ - 1)) * 128 + (ch & 7) * 16;
                    *(h8*)dst = x0; *(h8*)(dst + 8) = x1;
                } else {
                    if (gcol < nlim) *(h8*)(Cb + (size_t)grow * ldc + gcol) = x0;
                    if (gcol + 8 < nlim) *(h8*)(Cb + (size_t)grow * ldc + gcol + 8) = x1; }
                ep_sync();
            } }
};
struct ProbOut {
    static constexpr bool CD = false;
    static constexpr unsigned ROWB = 2048; static constexpr bool I8 = true;
    static constexpr int NT = 16; static constexpr size_t KS2 = 256;
    static constexpr bool PERM = true;
    const signed char* A; const signed char* Bt; _Float16* C; const _Float16* X; const float* sa; const float* sw; int G, c;
    __device__ __forceinline__ bool next(int i, Unit& u) const { const int L = i * G + c; if (L >= 64 * 8) return false; int pm, pn; tile_order(L, 64, 8, pm, pn); u.m0 = pm * 256; u.n0 = pn * 256; u.e = 0; u.cnt = 256; u.rbase = 0; return true; }
    __device__ __forceinline__ void a_offs(const Unit& u, const int (&R)[2], const int (&C2)[2], unsigned (&v)[2][2]) const {
#pragma unroll
        for (int h = 0; h < 2; ++h)
#pragma unroll
            for (int i = 0; i < 2; ++i) v[h][i] = (unsigned)(u.m0 + h * 128 + R[i]) * 2048u + (unsigned)C2[i]; }
    __device__ __forceinline__ const char* a_base() const { return (const char*)A; }
    __device__ __forceinline__ const char* b_base(const Unit& u) const { return (const char*)(Bt + (size_t)u.n0 * 2048); }
    __device__ __forceinline__ void epi(const i32x4 (&acc)[2][2][4][2], const Unit& u, int wr, int wc, int fr, int fq, LAS unsigned char* lds) const {
        LAS unsigned char* ep = lds + EP_OFF + wr * EP_GRP;
        const int tg = ep_tid() & 255, rrow = tg >> 4, ch = tg & 15;
        f32x4 s0[2], s1[2]; float srv[8];
#pragma unroll
        for (int bj = 0; bj < 2; ++bj) { const int col = u.n0 + bj * 128 + wc * 32 + fq * 8; s0[bj] = *(const f32x4*)(sw + col); s1[bj] = *(const f32x4*)(sw + col + 4); }
#pragma unroll
        for (int q = 0; q < 8; ++q) srv[q] = sa[u.m0 + (q >> 2) * 128 + wr * 64 + (q & 3) * 16 + fr];
#pragma unroll
        for (int ai = 0; ai < 2; ++ai)
#pragma unroll
            for (int m = 0; m < 4; ++m) { const float sr = srv[ai * 4 + m];
#pragma unroll
                for (int bj = 0; bj < 2; ++bj) { const i32x4 i0 = acc[ai][bj][m][0], i1 = acc[ai][bj][m][1];
                    *(LAS h8*)(ep + fr * EP_LD + (bj * 128 + wc * 32 + fq * 8) * 2) = cvt8((f32x4){(float)i0[0], (float)i0[1], (float)i0[2], (float)i0[3]} * (s0[bj] * sr), (f32x4){(float)i1[0], (float)i1[1], (float)i1[2], (float)i1[3]} * (s1[bj] * sr)); }
                const size_t go = (size_t)(u.m0 + ai * 128 + wr * 64 + m * 16 + rrow) * 2048 + u.n0 + ch * 16;
                const h8 r0 = *(const h8*)(X + go), r1 = *(const h8*)(X + go + 8);
                ep_sync();
                const h8 x0 = *(const LAS h8*)(ep + rrow * EP_LD + ch * 32), x1 = *(const LAS h8*)(ep + rrow * EP_LD + ch * 32 + 16);
                h8 o0, o1;
#pragma unroll
                for (int q = 0; q < 8; ++q) { o0[q] = (_Float16)(DN_ALPHA * (float)r0[q] + (float)x0[q]); o1[q] = (_Float16)(DN_ALPHA * (float)r1[q] + (float)x1[q]); }
                *(h8*)(C + go) = o0; *(h8*)(C + go + 8) = o1;
                ep_sync();
            } }
};
struct ProbCmp {
    static constexpr bool CD = false;
    static constexpr unsigned ROWB = 4096; static constexpr bool I8 = false;
    static constexpr int NT = 8; static constexpr size_t KS2 = 256;
    static constexpr bool PERM = false;
    const _Float16* A; const _Float16* Bt; float* C; int G, c;
    __device__ __forceinline__ bool next(int i, Unit& u) const { const int L = i * G + c; if (L >= 128) return false;
        u.e = L >> 6; const int r = L & 63; u.rbase = r & 3; u.n0 = ((r >> 2) & 1) * 256; u.m0 = (r >> 3) * 256; u.cnt = 256; return true; }
    __device__ __forceinline__ void a_offs(const Unit& u, const int (&R)[2], const int (&C2)[2], unsigned (&v)[2][2]) const {
#pragma unroll
        for (int h = 0; h < 2; ++h)
#pragma unroll
            for (int i = 0; i < 2; ++i) { const int row = u.m0 + h * 128 + R[i], kvh = row & 1, bj = row >> 1, b = bj >> 7, j = bj & 127;
                v[h][i] = (unsigned)((((u.e * B_ + b) * 2 + kvh) * S_ + 16 * j + 4 * u.rbase) * 128) * 2u + (unsigned)C2[i]; } }
    __device__ __forceinline__ const char* a_base() const { return (const char*)A; }
    __device__ __forceinline__ const char* b_base(const Unit& u) const { return (const char*)(Bt + ((size_t)u.e * 512 + u.n0) * KK + u.rbase * 512); }
    __device__ __forceinline__ void epi(const f32x4 (&acc)[2][2][4][2], const Unit& u, int wr, int wc, int fr, int fq, LAS unsigned char*) const {
        float* base = C + ((size_t)(u.e * 4 + u.rbase) * 2048) * 512;
#pragma unroll
        for (int ai = 0; ai < 2; ++ai)
#pragma unroll
            for (int m = 0; m < 4; ++m) { const int row = u.m0 + ai * 128 + wr * 64 + m * 16 + fr;
#pragma unroll
                for (int bj = 0; bj < 2; ++bj)
#pragma unroll
                    for (int n = 0; n < 2; ++n) { const int col = u.n0 + bj * 128 + wc * 32 + n * 16 + fq * 4;
                        *(f32x4*)(base + (size_t)row * 512 + col) = acc[ai][bj][m][n]; } } }
};
struct MoeTab { const LAS int* t; int NT;
    __device__ __forceinline__ bool find_i(int i, Unit& u) const {
        const LAS int* q = t + 128 + 8 * i;
        if (__builtin_amdgcn_readfirstlane(q[5]) == 0) return false;
        u.e = __builtin_amdgcn_readfirstlane(q[0]); u.m0 = __builtin_amdgcn_readfirstlane(q[1]); u.n0 = __builtin_amdgcn_readfirstlane(q[2]); u.cnt = __builtin_amdgcn_readfirstlane(q[3]); u.rbase = __builtin_amdgcn_readfirstlane(q[4]); return true; } };
__device__ __forceinline__ void moe_build(LAS int* t, int G, int vcu) {
    const int i = threadIdx.x;
    if (i < 40) { const int L = i * G + vcu; LAS int* q = t + 128 + 8 * i;
        if (L >= t[98]) q[5] = 0;
        else { int e = 0; for (; e < NE - 1; ++e) { if (L < t[32 + e + 1]) break; }
            const int ub = t[32 + e], cn = t[e], rs = t[65 + e]; const int nm = (cn + 255) >> 8, v = L - ub, mt = v % nm, ntile = v / nm;
            q[0] = e; q[1] = mt * 256; q[2] = ntile * 256; q[3] = min(256, cn - mt * 256); q[4] = rs; q[5] = 1; } }
}
struct ProbGu {
    static constexpr int NT = 16; static constexpr size_t KS2 = 256; static constexpr unsigned ROWB = 2048; static constexpr bool I8 = true;
    static constexpr bool PERM = true; static constexpr bool CD = true;
    const signed char* A; const signed char* Bt; unsigned char* act; const float* bgu; const int* list; const float* sa; const float* sw; MoeTab tab; int G, vcu;
    __device__ __forceinline__ bool next(int i, Unit& u) const { return tab.find_i(i, u); }
    __device__ __forceinline__ void a_offs(const Unit& u, const int (&R)[2], const int (&C2)[2], unsigned (&v)[2][2]) const {
#pragma unroll
        for (int h = 0; h < 2; ++h)
#pragma unroll
            for (int i = 0; i < 2; ++i) { int r = h * 128 + R[i]; r = r < u.cnt ? r : 0; const int a = list[(size_t)u.e * T_ + u.m0 + r]; v[h][i] = (unsigned)(a >> 2) * 2048u + (unsigned)C2[i]; } }
    __device__ __forceinline__ const char* a_base() const { return (const char*)A; }
    __device__ __forceinline__ const char* b_base(const Unit& u) const { return (const char*)(Bt + ((size_t)u.e * 4096 + u.n0) * 2048); }
    __device__ __forceinline__ void const_dma(const Unit& u, LAS unsigned char* lds, int wid, int lane) const {
        if (wid < 4) { cdma(lds, 0, wid, bgu + (size_t)u.e * 4096 + u.n0 + wid * 64 + lane); const int r = wid * 64 + lane; cdma(lds, 2, wid, sa + (size_t)u.e * T_ + u.m0 + (r < u.cnt ? r : 0)); }
        else cdma(lds, 1, wid - 4, sw + (size_t)u.e * 4096 + u.n0 + (wid - 4) * 64 + lane);
    }
    __device__ __forceinline__ void epi(const i32x4 (&acc)[2][2][4][2], const Unit& u, int wr, int wc, int fr, int fq, LAS unsigned char* lds) const {
        asm volatile("s_waitcnt vmcnt(16)" ::: "memory");
        ep_sync();
        const LAS float* cst = (const LAS float*)(lds + CONST_OFF);
        const int tg = ep_tid() & 255, rrow = tg >> 4, ch = tg & 15;
        f32x4 b0[2], b1[2], s0[2], s1[2];
#pragma unroll
        for (int bj = 0; bj < 2; ++bj) { const int col = bj * 128 + wc * 32 + fq * 8;
            b0[bj] = *(const LAS f32x4*)(cst + col); b1[bj] = *(const LAS f32x4*)(cst + col + 4); s0[bj] = *(const LAS f32x4*)(cst + 256 + col); s1[bj] = *(const LAS f32x4*)(cst + 256 + col + 4); }
        float srv[8];
#pragma unroll
        for (int q = 0; q < 8; ++q) srv[q] = cst[512 + (q >> 2) * 128 + wr * 64 + (q & 3) * 16 + fr];
        LAS unsigned char* ep2 = lds + EP_OFF + wr * (2 * 4608);
#define GU_WRITE(st) do { const int ai_ = (st) >> 1, mp_ = (st) & 1; LAS unsigned char* eb = ep2 + ((st) & 1) * 4608; \
            _Pragma("unroll") for (int mm = 0; mm < 2; ++mm) { const int m_ = mp_ * 2 + mm; const float sr = srv[ai_ * 4 + m_]; \
                _Pragma("unroll") for (int bj = 0; bj < 2; ++bj) { const i32x4 i0 = acc[ai_][bj][m_][0], i1 = acc[ai_][bj][m_][1]; \
                    const f32x4 v0 = (f32x4){(float)i0[0], (float)i0[1], (float)i0[2], (float)i0[3]} * (s0[bj] * sr) + b0[bj], v1 = (f32x4){(float)i1[0], (float)i1[1], (float)i1[2], (float)i1[3]} * (s1[bj] * sr) + b1[bj]; \
                    *(LAS unsigned*)(eb + (mm * 16 + fr) * 144 + (bj * 64 + wc * 16 + fq * 4)) = pk4_fp8(swiglu_fast(v0[0], v0[1]), swiglu_fast(v0[2], v0[3]), swiglu_fast(v1[0], v1[1]), swiglu_fast(v1[2], v1[3])); } } } while (0)
        GU_WRITE(0);
        ep_sync();
#pragma unroll
        for (int st = 0; st < 4; ++st) {
            if (st + 1 < 4) GU_WRITE(st + 1);
#pragma unroll
            for (int mm = 0; mm < 2; ++mm) { const u32x2 x0 = *(const LAS u32x2*)(ep2 + (st & 1) * 4608 + (mm * 16 + rrow) * 144 + ch * 8);
                const int rr = (st >> 1) * 128 + wr * 64 + ((st & 1) * 2 + mm) * 16 + rrow;
                if (rr < u.cnt) *(u32x2*)(act + (size_t)(u.rbase + u.m0 + rr) * 2048 + (u.n0 >> 1) + ch * 8) = x0; }
            ep_sync();
        }
#undef GU_WRITE
    }
};
struct ProbDn {
    static constexpr int NT = 16; static constexpr size_t KS2 = 256; static constexpr unsigned ROWB = 2048; static constexpr bool I8 = true;
    static constexpr bool PERM = true; static constexpr bool CD = true;
    const signed char* A; const signed char* Bt; unsigned char* y; const float* bdn; const int* list; const float* gate; const float* sa; const float* sw; MoeTab tab; int G, vcu;
    __device__ __forceinline__ bool next(int i, Unit& u) const { return tab.find_i(i, u); }
    __device__ __forceinline__ void a_offs(const Unit& u, const int (&R)[2], const int (&C2)[2], unsigned (&v)[2][2]) const {
#pragma unroll
        for (int h = 0; h < 2; ++h)
#pragma unroll
            for (int i = 0; i < 2; ++i) v[h][i] = (unsigned)(u.rbase + u.m0 + h * 128 + R[i]) * 2048u + (unsigned)C2[i]; }
    __device__ __forceinline__ const char* a_base() const { return (const char*)A; }
    __device__ __forceinline__ const char* b_base(const Unit& u) const { return (const char*)(Bt + ((size_t)u.e * 2048 + u.n0) * 2048); }
    __device__ __forceinline__ void const_dma(const Unit& u, LAS unsigned char* lds, int wid, int lane) const {
        const int i4 = wid & 3, r = i4 * 64 + lane, rc = r < u.cnt ? r : 0;
        if (wid < 4) { cdma(lds, 0, i4, bdn + (size_t)u.e * 2048 + u.n0 + r); cdma(lds, 2, i4, sa + u.rbase + u.m0 + rc); cdma(lds, 4, i4, list + (size_t)u.e * T_ + u.m0 + rc); }
        else { cdma(lds, 1, i4, sw + (size_t)u.e * 2048 + u.n0 + r); cdma(lds, 3, i4, gate + (size_t)u.e * T_ + u.m0 + rc); }
    }
    __device__ __forceinline__ void epi(const i32x4 (&acc)[2][2][4][2], const Unit& u, int wr, int wc, int fr, int fq, LAS unsigned char* lds) const {
        asm volatile("s_waitcnt vmcnt(16)" ::: "memory");
        ep_sync();
        const LAS float* cst = (const LAS float*)(lds + CONST_OFF);
        LAS unsigned char* ep = lds + EP_OFF + wr * (2 * 4352);
        const int tg = ep_tid() & 255, rrow = tg >> 4, ch = tg & 15;
        f32x4 b0[2], b1[2], s0[2], s1[2];
#pragma unroll
        for (int bj = 0; bj < 2; ++bj) { const int col = bj * 128 + wc * 32 + fq * 8;
            b0[bj] = *(const LAS f32x4*)(cst + col); b1[bj] = *(const LAS f32x4*)(cst + col + 4); s0[bj] = *(const LAS f32x4*)(cst + 256 + col); s1[bj] = *(const LAS f32x4*)(cst + 256 + col + 4); }
        float gv[8], srv[8]; int a2v[8];
#pragma unroll
        for (int q = 0; q < 8; ++q) { const int rl = (q >> 2) * 128 + wr * 64 + (q & 3) * 16 + fr; gv[q] = cst[768 + rl]; srv[q] = cst[512 + rl];
            a2v[q] = ((const LAS int*)cst)[1024 + (q >> 2) * 128 + wr * 64 + (q & 3) * 16 + rrow]; }
#define DN_WRITE(st) do { const int ai_ = (st) >> 2, m_ = (st) & 3; const float g = gv[st] * 16.f, sr = srv[st]; LAS unsigned char* eb = ep + ((st) & 1) * 4352; \
            _Pragma("unroll") for (int bj = 0; bj < 2; ++bj) { const i32x4 i0 = acc[ai_][bj][m_][0], i1 = acc[ai_][bj][m_][1]; \
                const f32x4 v0 = ((f32x4){(float)i0[0], (float)i0[1], (float)i0[2], (float)i0[3]} * (s0[bj] * sr) + b0[bj]) * g, v1 = ((f32x4){(float)i1[0], (float)i1[1], (float)i1[2], (float)i1[3]} * (s1[bj] * sr) + b1[bj]) * g; \
                u32x2 o; o[0] = pk4_fp8(__builtin_amdgcn_fmed3f(v0[0], -440.f, 440.f), __builtin_amdgcn_fmed3f(v0[1], -440.f, 440.f), __builtin_amdgcn_fmed3f(v0[2], -440.f, 440.f), __builtin_amdgcn_fmed3f(v0[3], -440.f, 440.f)); o[1] = pk4_fp8(__builtin_amdgcn_fmed3f(v1[0], -440.f, 440.f), __builtin_amdgcn_fmed3f(v1[1], -440.f, 440.f), __builtin_amdgcn_fmed3f(v1[2], -440.f, 440.f), __builtin_amdgcn_fmed3f(v1[3], -440.f, 440.f)); \
                *(LAS u32x2*)(eb + fr * 272 + (bj * 128 + wc * 32 + fq * 8)) = o; } } while (0)
        DN_WRITE(0);
        ep_sync();
#pragma unroll
        for (int st = 0; st < 8; ++st) {
            if (st + 1 < 8) DN_WRITE(st + 1);
            const int rr = (st >> 2) * 128 + wr * 64 + (st & 3) * 16 + rrow;
            const u32x4 x0 = *(const LAS u32x4*)(ep + (st & 1) * 4352 + rrow * 272 + ch * 16);
            if (rr < u.cnt) *(u32x4*)(y + (size_t)a2v[st] * 2048 + u.n0 + ch * 16) = x0;
            ep_sync();
        }
#undef DN_WRITE
    }
};
}

namespace at8 {
typedef float f32x16 __attribute__((ext_vector_type(16)));
typedef short s16x4 __attribute__((ext_vector_type(4)));
typedef unsigned u32x4 __attribute__((ext_vector_type(4)));
constexpr int SHM_K = 64 * 128 * 2, SHM_V = 64 * 128 * 2, SLOT = SHM_K + SHM_V;
constexpr int NSLOT = 4;
constexpr int LDS_WS = NSLOT * SLOT;
constexpr int LDS_END = LDS_WS + 8 * 64 * 4;
constexpr float CEXP = ATT_SCALE * 1.4426950408889634f;
constexpr float THR_RAW = 8.f / ATT_SCALE;
#define AT_KSWZ(row, colB) ((row) * 256 + ((colB) ^ (((row) & 7) << 4)))
#define AT_SBAR() __builtin_amdgcn_sched_barrier(0)
__device__ __forceinline__ int crow(int r, int hi) { return (r & 3) + 8 * (r >> 2) + 4 * hi; }
__device__ __forceinline__ unsigned cvtpk(float lo, float hi) { auto v = __builtin_amdgcn_cvt_pkrtz(lo, hi); return *reinterpret_cast<unsigned*>(&v); }
__device__ __forceinline__ int v_st(int k, int c) { const int kk = (k & ~0xC) | ((k & 4) << 1) | ((k & 8) >> 1); return ((kk >> 3) * 4 + (c >> 5)) * 512 + ((kk & 7) * 32 + (c & 31)) * 2; }
__device__ __forceinline__ int v_rd_base(int lane) { return ((lane & 3) << 3) | (((lane >> 2) & 3) << 6) | (((lane >> 4) & 1) << 5) | (((lane >> 5) & 1) << 8); }
constexpr int v_rd_off(int d0, int ks, int half) { return d0 * 512 + ks * 4096 + half * 2048; }
template <int OFF> __device__ __forceinline__ s16x4 tr_read(int vb) { s16x4 r; asm volatile("ds_read_b64_tr_b16 %0, %1 offset:%2" : "=&v"(r) : "v"(vb), "i"(OFF) : "memory"); return r; }
__device__ __forceinline__ h8 mk8(s16x4 l, s16x4 h) { typedef short s16x8 __attribute__((ext_vector_type(8))); s16x8 w = {l[0], l[1], l[2], l[3], h[0], h[1], h[2], h[3]}; return *reinterpret_cast<h8*>(&w); }
template <int D0> __device__ __forceinline__ void pv_one(f32x16& od, int vb, h8 pa0, h8 pa1, h8 pa2, h8 pa3) {
    const s16x4 l0 = tr_read<v_rd_off(D0, 0, 0)>(vb), h0 = tr_read<v_rd_off(D0, 0, 1)>(vb), l1 = tr_read<v_rd_off(D0, 1, 0)>(vb), h1 = tr_read<v_rd_off(D0, 1, 1)>(vb);
    const s16x4 l2 = tr_read<v_rd_off(D0, 2, 0)>(vb), h2 = tr_read<v_rd_off(D0, 2, 1)>(vb), l3 = tr_read<v_rd_off(D0, 3, 0)>(vb), h3 = tr_read<v_rd_off(D0, 3, 1)>(vb);
    asm volatile("s_waitcnt lgkmcnt(0)" ::: "memory"); AT_SBAR();
    od = __builtin_amdgcn_mfma_f32_32x32x16_f16(pa0, mk8(l0, h0), od, 0, 0, 0);
    od = __builtin_amdgcn_mfma_f32_32x32x16_f16(pa1, mk8(l1, h1), od, 0, 0, 0);
    od = __builtin_amdgcn_mfma_f32_32x32x16_f16(pa2, mk8(l2, h2), od, 0, 0, 0);
    od = __builtin_amdgcn_mfma_f32_32x32x16_f16(pa3, mk8(l3, h3), od, 0, 0, 0);
}
__device__ __forceinline__ void pv_d0(f32x16 (&o)[4], int vb, h8 pa0, h8 pa1, h8 pa2, h8 pa3) {
    pv_one<0>(o[0], vb, pa0, pa1, pa2, pa3); pv_one<1>(o[1], vb, pa0, pa1, pa2, pa3); pv_one<2>(o[2], vb, pa0, pa1, pa2, pa3); pv_one<3>(o[3], vb, pa0, pa1, pa2, pa3);
}
__device__ __forceinline__ void qkt(f32x16& p0, f32x16& p1, const char* Ks, const h8 (&qr)[8], int r32, int hi) {
    p0 = f32x16{}; p1 = f32x16{};
#pragma unroll
    for (int d0 = 0; d0 < 8; ++d0) { const int cb = (d0 * 16 + hi * 8) * 2;
        const h8 b0 = *reinterpret_cast<const h8*>(Ks + AT_KSWZ(r32, cb));
        const h8 b1 = *reinterpret_cast<const h8*>(Ks + AT_KSWZ(32 + r32, cb));
        p0 = __builtin_amdgcn_mfma_f32_32x32x16_f16(b0, qr[d0], p0, 0, 0, 0);
        p1 = __builtin_amdgcn_mfma_f32_32x32x16_f16(b1, qr[d0], p1, 0, 0, 0); }
}
__device__ __forceinline__ void pack_p(const f32x16& p0, const f32x16& p1, h8& pa0, h8& pa1, h8& pa2, h8& pa3) {
#define AT_PK4(P, BASE, OUT) do { unsigned a0 = cvtpk(P[BASE + 0], P[BASE + 1]), a1 = cvtpk(P[BASE + 2], P[BASE + 3]); \
    unsigned b0 = cvtpk(P[BASE + 4], P[BASE + 5]), b1 = cvtpk(P[BASE + 6], P[BASE + 7]); \
    auto r0 = __builtin_amdgcn_permlane32_swap(a0, b0, false, false); auto r1 = __builtin_amdgcn_permlane32_swap(a1, b1, false, false); \
    u32x4 w = {r0[0], r1[0], r0[1], r1[1]}; OUT = *reinterpret_cast<h8*>(&w); } while (0)
    AT_PK4(p0, 0, pa0); AT_PK4(p0, 8, pa1); AT_PK4(p1, 0, pa2); AT_PK4(p1, 8, pa3);
#undef AT_PK4
}
__device__ __forceinline__ float half_swap_max(float v) { auto rr = __builtin_amdgcn_permlane32_swap(__float_as_uint(v), __float_as_uint(v), false, false); return fmaxf(__uint_as_float(rr[0]), __uint_as_float(rr[1])); }
__device__ __forceinline__ float half_swap_sum(float v) { auto rr = __builtin_amdgcn_permlane32_swap(__float_as_uint(v), __float_as_uint(v), false, false); return __uint_as_float(rr[0]) + __uint_as_float(rr[1]); }

__device__ __forceinline__ int hidden_tid() { int tz = threadIdx.x; asm volatile("" : "+v"(tz)); return tz; }
__device__ __forceinline__ void dma_offsets(int ld, int (&ko)[2], int (&vo)[2]) {
    const int tz = hidden_tid(), w = tz >> 6, l = tz & 63;
#pragma unroll
    for (int q = 0; q < 2; ++q) {
        const int rr = 4 * (2 * w + q) + (l >> 4), pp = l & 15;
        ko[q] = rr * ld + ((pp ^ (rr & 7)) * 8);
        const int L = (2 * w + q) * 1024 + l * 16, sidx = L >> 9, o = L & 511;
        const int kk = (sidx >> 2) * 8 + (o >> 6), c = (sidx & 3) * 32 + ((o & 63) >> 1);
        const int k = (kk & ~0xC) | ((kk & 4) << 1) | ((kk & 8) >> 1);
        vo[q] = k * ld + c;
    }
}
__device__ __forceinline__ void dma_tile(char* slot, const _Float16* Kb, const _Float16* Vb, int ld, int tile, const int (&ko)[2], const int (&vo)[2], int wid) {
    const _Float16* kt = Kb + (size_t)tile * 64 * ld; const _Float16* vt = Vb + (size_t)tile * 64 * ld;
#pragma unroll
    for (int q = 0; q < 2; ++q) __builtin_amdgcn_global_load_lds((const unsigned*)(kt + ko[q]), (LAS unsigned*)(slot + (2 * wid + q) * 1024), 16, 0, 0);
#pragma unroll
    for (int q = 0; q < 2; ++q) __builtin_amdgcn_global_load_lds((const unsigned*)(vt + vo[q]), (LAS unsigned*)(slot + SHM_K + (2 * wid + q) * 1024), 16, 0, 0);
}
#define AT_WAITV(n) asm volatile("s_waitcnt vmcnt(" #n ")" ::: "memory")
#define AT_BAR() do { asm volatile("s_waitcnt lgkmcnt(0)" ::: "memory"); __builtin_amdgcn_s_barrier(); asm volatile("" ::: "memory"); } while (0)

__device__ __forceinline__ void attn_unit(char* lds, const _Float16* qrow, const _Float16* Kb, const _Float16* Vb, int ld, unsigned tmask, int wlen, int khi, unsigned selmask,
                                          _Float16* outw, int ostride) {
    const int tid = threadIdx.x, wid = __builtin_amdgcn_readfirstlane(tid >> 6), lane = tid & 63, r32 = lane & 31, hi = lane >> 5;
    float* wsf = (float*)(lds + LDS_WS) + wid * 64; float* li_l = wsf; float* al_l = wsf + 32;
    float m_reg = -1e30f, l_reg = 0.f; f32x16 o[4] = {}; h8 qr[8];
#pragma unroll
    for (int d0 = 0; d0 < 8; ++d0) qr[d0] = *(const h8*)(qrow + d0 * 16);
    int ko[2], vo[2]; dma_offsets(ld, ko, vo);
    const int vbase = (int)(uintptr_t)lds + SHM_K + v_rd_base(lane);
    unsigned rest = tmask; int j = __ffs(rest) - 1; rest &= rest - 1;
    int j1 = rest ? (__ffs(rest) - 1) : -1; if (j1 >= 0) rest &= rest - 1;
    dma_tile(lds, Kb, Vb, ld, j, ko, vo, wid);
    if (j1 >= 0) { dma_tile(lds + SLOT, Kb, Vb, ld, j1, ko, vo, wid); AT_WAITV(4); } else { AT_WAITV(0); }
    AT_BAR();
    int so = 0, sp = 0;
    const bool roleB = wid >= 4;
    bool first = true;
    h8 pa0, pa1, pa2, pa3;
    for (;;) {
        const int j2 = rest ? (__ffs(rest) - 1) : -1;
        if (j2 >= 0) { rest &= rest - 1; int s2 = so + 2 * SLOT; s2 = s2 >= NSLOT * SLOT ? s2 - NSLOT * SLOT : s2; dma_tile(lds + s2, Kb, Vb, ld, j2, ko, vo, wid); }
        if (roleB && !first) { AT_SBAR(); pv_d0(o, vbase + sp, pa0, pa1, pa2, pa3); }
        f32x16 p0, p1;
        AT_SBAR(); qkt(p0, p1, lds + so, qr, r32, hi);
        { const int klo = wlen > 0 ? khi - wlen + 1 : 0; const bool tb = (selmask >> j) & 1u; const bool inr = (j * 64 >= klo) && (j * 64 + 63 <= khi);
          if (!__all(tb && inr)) {
              if (__all(inr)) {
#pragma unroll
                  for (int r = 0; r < 16; ++r) { p0[r] = tb ? p0[r] : -INFINITY; p1[r] = tb ? p1[r] : -INFINITY; }
              } else {
                  const int kb = j * 64 + 4 * hi;
#pragma unroll
                  for (int r = 0; r < 16; ++r) { const int k0 = kb + (r & 3) + 8 * (r >> 2);
                      p0[r] = (tb && k0 >= klo && k0 <= khi) ? p0[r] : -INFINITY;
                      p1[r] = (tb && (k0 + 32) >= klo && (k0 + 32) <= khi) ? p1[r] : -INFINITY; }
              } } }
        float pmax = p0[0];
#pragma unroll
        for (int r = 1; r < 16; ++r) pmax = fmaxf(pmax, p0[r]);
#pragma unroll
        for (int r = 0; r < 16; ++r) pmax = fmaxf(pmax, p1[r]);
        pmax = half_swap_max(pmax);
        float mn, alpha;
        if (__all(pmax - m_reg <= THR_RAW)) { mn = m_reg; alpha = 1.f; }
        else { mn = fmaxf(m_reg, pmax); alpha = __builtin_amdgcn_exp2f((m_reg - mn) * CEXP); m_reg = mn; }
        const float mnC = -mn * CEXP;
        float ps = 0.f;
#pragma unroll
        for (int r = 0; r < 16; ++r) { p0[r] = __builtin_amdgcn_exp2f(fmaf(p0[r], CEXP, mnC)); ps += p0[r]; }
#pragma unroll
        for (int r = 0; r < 16; ++r) { p1[r] = __builtin_amdgcn_exp2f(fmaf(p1[r], CEXP, mnC)); ps += p1[r]; }
        ps = half_swap_sum(ps);
        l_reg = l_reg * alpha + ps;
        if (__any(alpha < 1.f)) { if (hi == 0) al_l[r32] = alpha; asm volatile("s_waitcnt lgkmcnt(0)" ::: "memory");
#pragma unroll
            for (int r = 0; r < 16; ++r) { const float a = al_l[crow(r, hi)];
#pragma unroll
                for (int d = 0; d < 4; ++d) o[d][r] *= a; } }
        pack_p(p0, p1, pa0, pa1, pa2, pa3);
        AT_SBAR();
        if (!roleB) pv_d0(o, vbase + so, pa0, pa1, pa2, pa3);
        if (j1 < 0) break;
        if (j2 >= 0) { AT_WAITV(4); } else { AT_WAITV(0); }
        AT_BAR();
        j = j1; j1 = j2; sp = so; so += SLOT; so = so >= NSLOT * SLOT ? so - NSLOT * SLOT : so; first = false;
    }
    if (roleB) { AT_SBAR(); pv_d0(o, vbase + so, pa0, pa1, pa2, pa3); }
    if (hi == 0) li_l[r32] = l_reg; asm volatile("s_waitcnt lgkmcnt(0)" ::: "memory");
#pragma unroll
    for (int r = 0; r < 16; ++r) { const int orow = crow(r, hi); const float l = li_l[orow]; const float rl = l > 0.f ? 1.f / l : 0.f;
#pragma unroll
        for (int d0 = 0; d0 < 4; ++d0) outw[(size_t)orow * ostride + d0 * 32 + r32] = (_Float16)(o[d0][r] * rl); }
    __syncthreads();
}

constexpr int LDS_AP = 0, LDS_BP = LDS_AP + 4 * 64 * 33 * 4, LDS_SELM = LDS_END, LDS_CS_END = LDS_SELM + 64 * 4;
static_assert(LDS_BP + 4 * 64 * 33 * 4 <= NSLOT * SLOT, "importance partials must fit inside the ring");
__device__ __forceinline__ void cmp_slc_unit(char* lds, const _Float16* qrow, const _Float16* Kc, const _Float16* Vc, const _Float16* Ks, const _Float16* Vs, int t, int tl, int g, int qi,
                                             _Float16* outc, _Float16* outs) {
    const int tid = threadIdx.x, wid = __builtin_amdgcn_readfirstlane(tid >> 6), lane = tid & 63, r32 = lane & 31, hi = lane >> 5;
    float* AP = (float*)(lds + LDS_AP); float* BP = (float*)(lds + LDS_BP); unsigned* selm = (unsigned*)(lds + LDS_SELM);
    {
        h8 qr[8];
#pragma unroll
        for (int d0 = 0; d0 < 8; ++d0) qr[d0] = *(const h8*)(qrow + d0 * 16);
        const int vb0 = (int)(uintptr_t)lds + SHM_K + v_rd_base(lane);
        { int ko[2], vo[2]; dma_offsets(256, ko, vo);
          dma_tile(lds, Kc, Vc, 256, 0, ko, vo, wid); dma_tile(lds + SLOT, Kc, Vc, 256, 1, ko, vo, wid); }
        AT_WAITV(0); AT_BAR();
        f32x16 pA0, pA1, pB0, pB1;
        AT_SBAR(); qkt(pA0, pA1, lds, qr, r32, hi); qkt(pB0, pB1, lds + SLOT, qr, r32, hi);
        const int khi = t >= 31 ? ((t - 31) >> 4) : -1;
#pragma unroll
        for (int r = 0; r < 16; ++r) { const int c0 = 4 * hi + (r & 3) + 8 * (r >> 2);
            pA0[r] = (c0 <= khi) ? pA0[r] : -INFINITY; pA1[r] = (c0 + 32 <= khi) ? pA1[r] : -INFINITY;
            pB0[r] = (c0 + 64 <= khi) ? pB0[r] : -INFINITY; pB1[r] = (c0 + 96 <= khi) ? pB1[r] : -INFINITY; }
        float pmax = -INFINITY;
#pragma unroll
        for (int r = 0; r < 16; ++r) pmax = fmaxf(fmaxf(pmax, pA0[r]), fmaxf(pA1[r], fmaxf(pB0[r], pB1[r])));
        pmax = half_swap_max(pmax);
        const float mC = (pmax == -INFINITY) ? 0.f : -pmax * CEXP;
        float ps = 0.f;
#pragma unroll
        for (int r = 0; r < 16; ++r) { pA0[r] = __builtin_amdgcn_exp2f(fmaf(pA0[r], CEXP, mC)); pA1[r] = __builtin_amdgcn_exp2f(fmaf(pA1[r], CEXP, mC));
            pB0[r] = __builtin_amdgcn_exp2f(fmaf(pB0[r], CEXP, mC)); pB1[r] = __builtin_amdgcn_exp2f(fmaf(pB1[r], CEXP, mC)); ps += (pA0[r] + pA1[r]) + (pB0[r] + pB1[r]); }
        ps = half_swap_sum(ps);
        const float inv = ps > 0.f ? 1.f / ps : 0.f;
#pragma unroll
        for (int r = 0; r < 16; ++r) { pA0[r] *= inv; pA1[r] *= inv; pB0[r] *= inv; pB1[r] *= inv; }
        f32x16 o[4] = {};
        h8 pa0, pa1, pa2, pa3;
        pack_p(pA0, pA1, pa0, pa1, pa2, pa3); AT_SBAR(); pv_d0(o, vb0, pa0, pa1, pa2, pa3);
        pack_p(pB0, pB1, pa0, pa1, pa2, pa3); AT_SBAR(); pv_d0(o, vb0 + SLOT, pa0, pa1, pa2, pa3);
#pragma unroll
        for (int r = 0; r < 16; ++r) { const int orow = crow(r, hi);
#pragma unroll
            for (int d0 = 0; d0 < 4; ++d0) outc[(size_t)orow * 1024 + d0 * 32 + r32] = (_Float16)o[d0][r]; }
        __syncthreads();
        { float* ap = AP + (g * 64 + tl) * 33; float* bp = BP + (g * 64 + tl) * 33;
          if (hi == 0) bp[0] = 0.f;
#define AT_IMP(P, JB) do { _Pragma("unroll") for (int k = 0; k < 4; ++k) { const int j = (JB) + 2 * k + hi; \
              ap[j] = 2.f * (P[4 * k] + P[4 * k + 1] + P[4 * k + 2]) + P[4 * k + 3]; if (j + 1 < 32) bp[j + 1] = P[4 * k + 3]; } } while (0)
          AT_IMP(pA0, 0); AT_IMP(pA1, 8); AT_IMP(pB0, 16); AT_IMP(pB1, 24);
#undef AT_IMP
        }
    }
    __syncthreads();
#pragma unroll 1
    for (int it = 0; it < 4; ++it) {
        const int tk = 8 * wid + 2 * it + hi, j = r32;
        float imp = 0.f;
#pragma unroll
        for (int gg = 0; gg < 4; ++gg) imp += AP[(gg * 64 + tk) * 33 + j] + BP[(gg * 64 + tk) * 33 + j];
        const bool forced = (j == 0) || (j == qi) || (j == qi - 1), valid = j <= qi;
        const float iv = forced ? 1e9f : (valid ? imp : -1e9f);
        int rank = 0;
        for (int i = 0; i < 32; ++i) { const float vi = __shfl(iv, i + 32 * hi); rank += (vi > iv || (vi == iv && i < j)) ? 1 : 0; }
        const unsigned long long bal = __ballot(rank < 16 && valid);
        if (r32 == 0) selm[tk] = (unsigned)(bal >> (32 * hi));
    }
    __syncthreads();
    unsigned tm = selm[lane];
#pragma unroll
    for (int o = 32; o > 0; o >>= 1) tm |= __shfl_xor(tm, o);
    const int tz2 = hidden_tid();
    const unsigned mysel = selm[((tz2 >> 6) & 1) * 32 + (tz2 & 31)];
    attn_unit(lds, qrow, Ks, Vs, 128, tm, 0, t, mysel, outs, 1024);
}
}

struct CUnit { const float* W; int ldw; int nvalid; _Float16* Wt; int k0; int n0; };
__device__ __forceinline__ CUnit conv_desc(int u, const float* win, const float* w1k, const float* w1v, const float* wmkv, _Float16* wtin, _Float16* wt1, _Float16* wtmkv) {
    CUnit d;
    if (u < 160) { d.W = win; d.ldw = INW; d.nvalid = INW; d.Wt = wtin; d.k0 = (u / 5) * 64; d.n0 = (u % 5) * 256; }
    else if (u < 288) { const int v = u - 160, kv = v >> 6, part = (v >> 5) & 1, kt = v & 31;
        d.W = (kv ? w1v : w1k) + (size_t)part * 2048 * 256; d.ldw = 256; d.nvalid = 256; d.Wt = wt1 + ((size_t)kv * 512 + part * 256) * 2048; d.k0 = kt * 64; d.n0 = 0; }
    else { d.W = wmkv; d.ldw = 1024; d.nvalid = 1024; d.Wt = wtmkv; d.k0 = 0; d.n0 = 0; }
    return d;
}
__device__ __forceinline__ void conv_all(float* lds, const float* win, const float* w1k, const float* w1v, const float* wmkv, _Float16* wtin, _Float16* wt1, _Float16* wtmkv, int bid, int nb) {
    constexpr int NU = 160 + 128;
    const int tid = threadIdx.x;
    int u = bid; if (u >= NU) return;
    CUnit d = conv_desc(u, win, w1k, w1v, wmkv, wtin, wt1, wtmkv);
    float4 v[8];
#define CL(D) do { _Pragma("unroll") for (int i = 0; i < 8; ++i) { const int idx = tid + 512 * i, r = idx >> 6, c4 = (idx & 63) * 4; \
        v[i] = ((D).n0 + c4 < (D).nvalid) ? *(const float4*)((D).W + (size_t)((D).k0 + r) * (D).ldw + (D).n0 + c4) : make_float4(0.f, 0.f, 0.f, 0.f); } } while (0)
    CL(d);
    for (;;) {
#pragma unroll
        for (int i = 0; i < 8; ++i) { const int idx = tid + 512 * i, r = idx >> 6, c4 = (idx & 63) * 4; float* dd = lds + r * 257 + c4; dd[0] = v[i].x; dd[1] = v[i].y; dd[2] = v[i].z; dd[3] = v[i].w; }
        __syncthreads();
        const int un = u + nb; const bool has = un < NU;
        CUnit dn = d; if (has) { dn = conv_desc(un, win, w1k, w1v, wmkv, wtin, wt1, wtmkv); CL(dn); }
#pragma unroll
        for (int j = 0; j < 4; ++j) { const int id = tid + 512 * j, n = id >> 3, k8 = (id & 7) * 8; h8 o;
#pragma unroll
            for (int q = 0; q < 8; ++q) o[q] = (_Float16)lds[(k8 + q) * 257 + n];
            *(h8*)(d.Wt + (size_t)(d.n0 + n) * 2048 + d.k0 + k8) = o; }
        __syncthreads();
        if (!has) break;
        u = un; d = dn;
    }
#undef CL
}

__device__ __forceinline__ unsigned pack4_i8(float a, float b, float c, float d) {
    const int ia = __float2int_rn(a), ib = __float2int_rn(b), ic = __float2int_rn(c), id = __float2int_rn(d);
    return (unsigned)(ia & 255) | ((unsigned)(ib & 255) << 8) | ((unsigned)(ic & 255) << 16) | ((unsigned)(id & 255) << 24);
}
constexpr int QP_LD2 = 1026;
struct QUnit { const float* W; int ldw; int n0; signed char* Q; float* sc; int nvalid; };
struct QExtra { const float* win; signed char* q8in; float* sin8; const float* wmkv; signed char* q8mkv; float* smkv; };
__device__ __forceinline__ QUnit quant_desc(int u, const float* wgu, const float* wdn, signed char* q8gu, signed char* q8dn, float* sgu, float* sdn, const float* wout, signed char* q8out, float* sout, const QExtra& x) {
    QUnit d; d.nvalid = 1 << 30;
    if (u >= NE * 192 + 64 + 73) { const int pn = u - (NE * 192 + 64 + 73); d.W = x.wmkv; d.ldw = 1024; d.n0 = pn * 32; d.Q = x.q8mkv; d.sc = x.smkv; }
    else if (u >= NE * 192 + 64) { const int pn = u - (NE * 192 + 64); d.W = x.win; d.ldw = INW; d.n0 = 1280 + pn * 32; d.Q = x.q8in - (size_t)1280 * 2048; d.sc = x.sin8 - 1280; d.nvalid = INW; }
    else if (u >= NE * 192) { const int pn = u - NE * 192; d.W = wout; d.ldw = 2048; d.n0 = pn * 32; d.Q = q8out; d.sc = sout; }
    else if (u < NE * 128) { const int e = u >> 7, pn = u & 127; d.W = wgu + (size_t)e * 2048 * 4096; d.ldw = 4096; d.n0 = pn * 32; d.Q = q8gu + (size_t)e * 4096 * 2048; d.sc = sgu + (size_t)e * 4096; }
    else { const int v = u - NE * 128, e = v >> 6, pn = v & 63; d.W = wdn + (size_t)e * 2048 * 2048; d.ldw = 2048; d.n0 = pn * 32; d.Q = q8dn + (size_t)e * 2048 * 2048; d.sc = sdn + (size_t)e * 2048; }
    return d;
}
__device__ __forceinline__ unsigned pk2h(float a, float b) { auto v = __builtin_amdgcn_cvt_pkrtz(a, b); return *reinterpret_cast<unsigned*>(&v); }
template <bool DYN>
__device__ __forceinline__ void quant_units(char* smem, const float* wgu, const float* wdn, signed char* q8gu, signed char* q8dn, float* sgu, float* sdn, const float* wout, signed char* q8out, float* sout, const QExtra& qx,
                                            int ubase, int nun, unsigned* ctr, int maxu, int bid, int nb) {
    unsigned* cmaxb = (unsigned*)smem;
    volatile LAS int* slot = (volatile LAS int*)(smem + 256);
    int tid = threadIdx.x; asm volatile("" : "+v"(tid));
    const int c4 = (tid & 7) * 4, rg = tid >> 3;
    if (tid < 64) cmaxb[tid] = 0u;
    if (DYN) { if (tid == 0) slot[0] = maxu > 0 ? (int)__hip_atomic_fetch_add(ctr, 1u, __ATOMIC_RELAXED, __HIP_MEMORY_SCOPE_AGENT) : 0x7fffffff; }
    __syncthreads();
    int u = DYN ? slot[0] : bid;
    if (u >= nun) { __syncthreads(); return; }
    int taken = 1;
    QUnit d = quant_desc(ubase + u, wgu, wdn, q8gu, q8dn, sgu, sdn, wout, q8out, sout, qx);
    float4 va[16], vb[16], vc[8];
#define QLR(dst, D, half, j0, j1) do { const float* p0 = (D).W + (size_t)((half) * 1024 + rg * 16) * (D).ldw + (D).n0 + c4; const bool okc = (D).n0 + c4 < (D).nvalid; _Pragma("unroll") for (int j = j0; j < j1; ++j) dst[j] = okc ? *(const float4*)(p0 + (size_t)j * (D).ldw) : make_float4(0.f, 0.f, 0.f, 0.f); } while (0)
#define QL(dst, D, half) QLR(dst, D, half, 0, 16)
#define QM(src) do { _Pragma("unroll") for (int j = 0; j < 16; ++j) { m0 = fmaxf(m0, fabsf(src[j].x)); m1 = fmaxf(m1, fabsf(src[j].y)); m2 = fmaxf(m2, fabsf(src[j].z)); m3 = fmaxf(m3, fabsf(src[j].w)); } } while (0)
#define QS(src, half, comp, ci, inv) do { uint4 o; \
        o.x = pack4_i8(src[0].comp * inv, src[1].comp * inv, src[2].comp * inv, src[3].comp * inv); o.y = pack4_i8(src[4].comp * inv, src[5].comp * inv, src[6].comp * inv, src[7].comp * inv); \
        o.z = pack4_i8(src[8].comp * inv, src[9].comp * inv, src[10].comp * inv, src[11].comp * inv); o.w = pack4_i8(src[12].comp * inv, src[13].comp * inv, src[14].comp * inv, src[15].comp * inv); \
        *(uint4*)(d.Q + (size_t)(d.n0 + c4 + (ci)) * 2048 + (half) * 1024 + rg * 16) = o; } while (0)
    QL(va, d, 0);
    int par = 0;
    for (;;) {
        unsigned* cmax = cmaxb + par * 32;
        float m0 = 0.f, m1 = 0.f, m2 = 0.f, m3 = 0.f;
        if (DYN) { if (tid == 0) slot[par ^ 1] = taken < maxu ? (int)__hip_atomic_fetch_add(ctr, 1u, __ATOMIC_RELAXED, __HIP_MEMORY_SCOPE_AGENT) : 0x7fffffff; }
        if (taken > 1) QLR(va, d, 0, 8, 16);
        QL(vb, d, 1);
        QM(va); QM(vb);
        atomicMax(&cmax[c4 + 0], __float_as_uint(m0)); atomicMax(&cmax[c4 + 1], __float_as_uint(m1)); atomicMax(&cmax[c4 + 2], __float_as_uint(m2)); atomicMax(&cmax[c4 + 3], __float_as_uint(m3));
        __syncthreads();
        const int un = DYN ? slot[par ^ 1] : u + nb; const bool has = un < nun;
        QUnit dn = d; if (has) { dn = quant_desc(ubase + un, wgu, wdn, q8gu, q8dn, sgu, sdn, wout, q8out, sout, qx); QLR(vc, dn, 0, 0, 8); }
        if (tid < 32) cmaxb[(par ^ 1) * 32 + tid] = 0u;
        const float x0 = __uint_as_float(cmax[c4 + 0]), x1 = __uint_as_float(cmax[c4 + 1]), x2 = __uint_as_float(cmax[c4 + 2]), x3 = __uint_as_float(cmax[c4 + 3]);
        const float i0 = x0 > 0.f ? 127.f / x0 : 0.f, i1 = x1 > 0.f ? 127.f / x1 : 0.f, i2 = x2 > 0.f ? 127.f / x2 : 0.f, i3 = x3 > 0.f ? 127.f / x3 : 0.f;
        QS(va, 0, x, 0, i0); QS(va, 0, y, 1, i1); QS(va, 0, z, 2, i2); QS(va, 0, w, 3, i3);
        QS(vb, 1, x, 0, i0); QS(vb, 1, y, 1, i1); QS(vb, 1, z, 2, i2); QS(vb, 1, w, 3, i3);
        if (tid < 32) { const float mx = __uint_as_float(cmax[tid]); d.sc[d.n0 + tid] = mx > 0.f ? mx / 127.f : 1.f; }
        if (!has) break;
#pragma unroll
        for (int j = 0; j < 8; ++j) va[j] = vc[j];
        u = un; d = dn; par ^= 1; ++taken;
        __syncthreads();
    }
    __syncthreads();
#undef QL
#undef QLR
#undef QM
#undef QS
}
__host__ __device__ constexpr int q_cnt(int k) { return k == 1 ? 1792 : k == 2 ? 768 : k == 3 ? 512 : k == 4 ? 1024 : k == 5 ? 256 : k == 6 ? 512 : k == 7 ? 256 : k == 8 ? 768 : k == 9 ? 256 : 0; }
__host__ __device__ constexpr int q_beg(int k) { int s = 0; for (int i = 0; i < k; ++i) s += q_cnt(i); return s; }
__host__ __device__ constexpr int q_first(int k) { return k == 1 ? 4 : k == 2 ? 3 : k == 3 ? 2 : k == 4 ? 4 : k == 5 ? 1 : k == 6 ? 2 : k == 7 ? 1 : k == 8 ? 3 : k == 9 ? 1 : 0; }
static_assert(q_beg(5) == NE * 128 && q_beg(10) == NE * 192, "quota tables");
constexpr size_t CTL_QCTR = 20480;

__device__ __forceinline__ const float* karg_in(int i) {
    const __attribute__((address_space(4))) char* ka = (const __attribute__((address_space(4))) char*)__builtin_amdgcn_kernarg_segment_ptr();
    asm volatile("" : "+s"(ka));
    return *(const float* const __attribute__((address_space(4)))*)(ka + 8 * i);
}
#define DEFPTRS unsigned char* wsl_ = p.ws; asm volatile("" : "+s"(wsl_)); unsigned char* ws = wsl_; (void)ws; unsigned* ctl = (unsigned*)(wsl_ + WS_CTL); int* cnt = (int*)(wsl_ + CTL_CNT); float* proj = (float*)(wsl_ + WS_PROJ); float* kvmem = (float*)(wsl_ + WS_KVMEM); float* bias1 = (float*)(wsl_ + WS_BIAS1); float* hid = (float*)(wsl_ + WS_HID); float* kc = (float*)(wsl_ + WS_KC); float* vc = (float*)(wsl_ + WS_VC); float* pooled = (float*)(wsl_ + WS_POOLED); _Float16* opool = (_Float16*)(wsl_ + WS_OPOOL); _Float16* owin = (_Float16*)(wsl_ + WS_OWIN); _Float16* ocmp = (_Float16*)(wsl_ + WS_OCMP); _Float16* oslc = (_Float16*)(wsl_ + WS_OSLC); unsigned* sel = (unsigned*)(wsl_ + WS_SEL); _Float16* omem = (_Float16*)(wsl_ + WS_OMEM); _Float16* cat16 = (_Float16*)(wsl_ + WS_CAT16); _Float16* hpre16 = (_Float16*)(wsl_ + WS_HPRE); float* hbuf = (float*)(wsl_ + WS_H); float* gate = (float*)(wsl_ + WS_GATE); int* list = (int*)(wsl_ + WS_LIST); unsigned char* actf8 = (unsigned char*)(wsl_ + WS_ACT16); unsigned char* yf8 = (unsigned char*)(wsl_ + WS_Y16); _Float16* h16 = (_Float16*)(wsl_ + WS_H16); _Float16* x16 = (_Float16*)(wsl_ + WS_X16); _Float16* wtin = (_Float16*)(wsl_ + WS_WTIN); _Float16* wtout = (_Float16*)(wsl_ + WS_WTOUT); _Float16* wtgu = (_Float16*)(wsl_ + WS_WTGU); _Float16* wtdn = (_Float16*)(wsl_ + WS_WTDN); _Float16* proj16 = (_Float16*)(wsl_ + WS_PROJ16); _Float16* kvmem16 = (_Float16*)(wsl_ + WS_KVMEM16); _Float16* wt1 = (_Float16*)(wsl_ + WS_WT1); float* uv = (float*)(wsl_ + WS_UV); _Float16* kc16 = (_Float16*)(wsl_ + WS_KC16); _Float16* vc16 = (_Float16*)(wsl_ + WS_VC16); _Float16* wr16 = (_Float16*)(wsl_ + WS_WR16); _Float16* mem16 = (_Float16*)(wsl_ + WS_MEM16); _Float16* wtmkv = (_Float16*)(wsl_ + WS_WTMKV); _Float16* kv16 = (_Float16*)(wsl_ + WS_KV16); _Float16* wt2 = (_Float16*)(wsl_ + WS_WT2); float* sa2 = (float*)(wsl_ + WS_SA2); float* gate2 = (float*)(wsl_ + WS_GATE2); signed char* x8 = (signed char*)(wsl_ + WS_X8); float* sxa = (float*)(wsl_ + WS_SXA); signed char* q8in = (signed char*)(wsl_ + WS_Q8IN); float* sin8 = (float*)(wsl_ + WS_SIN8); signed char* q8mkv = (signed char*)(wsl_ + WS_Q8MKV); float* smkv = (float*)(wsl_ + WS_SMKV); signed char* q8out = (signed char*)(wsl_ + WS_Q8OUT); float* sout = (float*)(wsl_ + WS_SOUT); signed char* cat8 = (signed char*)(wsl_ + WS_CAT8); float* scat = (float*)(wsl_ + WS_SCAT); signed char* q8gu = (signed char*)(wsl_ + WS_Q8GU); signed char* q8dn = (signed char*)(wsl_ + WS_Q8DN); float* sgu = (float*)(wsl_ + WS_SGU); float* sdn = (float*)(wsl_ + WS_SDN); signed char* h8q = (signed char*)(wsl_ + WS_H8); float* sah = (float*)(wsl_ + WS_SAH); signed char* act8 = (signed char*)(wsl_ + WS_ACT8); float* sact = (float*)(wsl_ + WS_SACT);
__global__ void __launch_bounds__(512, 2) fwd(Params p) {
    extern __shared__ __attribute__((aligned(16))) char smem[];
    int tidk_ = threadIdx.x; asm volatile("" : "+v"(tidk_));
    const int tid = tidk_, wv = __builtin_amdgcn_readfirstlane(tid >> 6);
#define LANE_NOW ({ int _t = threadIdx.x; asm volatile("" : "+v"(_t)); _t & 63; })
    const int bid = blockIdx.x, nb = gridDim.x;
    const int gw = bid * 8 + wv, nw = nb * 8;
    const int lo = (int)(p.lo_hi & 0xffffffffll), hi = (int)(p.lo_hi >> 32);
    unsigned char* ws = p.ws;
    unsigned* ctl = (unsigned*)(ws + WS_CTL);
    int* cnt = (int*)(ws + CTL_CNT);
    float* proj = (float*)(ws + WS_PROJ);
    float* kvmem = (float*)(ws + WS_KVMEM);
    float* bias1 = (float*)(ws + WS_BIAS1);
    float* hid = (float*)(ws + WS_HID);
    float* kc = (float*)(ws + WS_KC);
    float* vc = (float*)(ws + WS_VC);
    float* pooled = (float*)(ws + WS_POOLED);
    _Float16* opool = (_Float16*)(ws + WS_OPOOL);
    _Float16* owin = (_Float16*)(ws + WS_OWIN);
    _Float16* ocmp = (_Float16*)(ws + WS_OCMP);
    _Float16* oslc = (_Float16*)(ws + WS_OSLC);
    unsigned* sel = (unsigned*)(ws + WS_SEL);
    _Float16* omem = (_Float16*)(ws + WS_OMEM);
    _Float16* cat16 = (_Float16*)(ws + WS_CAT16);
    _Float16* hpre16 = (_Float16*)(ws + WS_HPRE);
    float* hbuf = (float*)(ws + WS_H);
    float* gate = (float*)(ws + WS_GATE);
    int* list = (int*)(ws + WS_LIST);
    unsigned char* actf8 = (unsigned char*)(ws + WS_ACT16);
    unsigned char* yf8 = (unsigned char*)(ws + WS_Y16);
    _Float16* h16 = (_Float16*)(ws + WS_H16);
    _Float16* x16 = (_Float16*)(ws + WS_X16);
    _Float16* wtin = (_Float16*)(ws + WS_WTIN);
    _Float16* wtout = (_Float16*)(ws + WS_WTOUT);
    _Float16* wtgu = (_Float16*)(ws + WS_WTGU);
    _Float16* wtdn = (_Float16*)(ws + WS_WTDN);
    LAS unsigned char* lds = (LAS unsigned char*)smem;
    _Float16* proj16 = (_Float16*)(ws + WS_PROJ16);
    _Float16* kvmem16 = (_Float16*)(ws + WS_KVMEM16);
    _Float16* wt1 = (_Float16*)(ws + WS_WT1);
    float* uv = (float*)(ws + WS_UV);
    _Float16* kc16 = (_Float16*)(ws + WS_KC16);
    _Float16* vc16 = (_Float16*)(ws + WS_VC16);
    _Float16* wr16 = (_Float16*)(ws + WS_WR16);
    _Float16* mem16 = (_Float16*)(ws + WS_MEM16);
    _Float16* wtmkv = (_Float16*)(ws + WS_WTMKV);
    _Float16* kv16 = (_Float16*)(ws + WS_KV16);
    _Float16* wt2 = (_Float16*)(ws + WS_WT2);
    float* sa2 = (float*)(ws + WS_SA2); float* gate2 = (float*)(ws + WS_GATE2);
    signed char* x8 = (signed char*)(ws + WS_X8); float* sxa = (float*)(ws + WS_SXA); signed char* q8in = (signed char*)(ws + WS_Q8IN); float* sin8 = (float*)(ws + WS_SIN8);
    signed char* q8mkv = (signed char*)(ws + WS_Q8MKV); float* smkv = (float*)(ws + WS_SMKV);
    signed char* q8out = (signed char*)(ws + WS_Q8OUT); float* sout = (float*)(ws + WS_SOUT); signed char* cat8 = (signed char*)(ws + WS_CAT8); float* scat = (float*)(ws + WS_SCAT);
    signed char* q8gu = (signed char*)(ws + WS_Q8GU); signed char* q8dn = (signed char*)(ws + WS_Q8DN);
    float* sgu = (float*)(ws + WS_SGU); float* sdn = (float*)(ws + WS_SDN);
    signed char* h8q = (signed char*)(ws + WS_H8); float* sah = (float*)(ws + WS_SAH);
    signed char* act8 = (signed char*)(ws + WS_ACT8); float* sact = (float*)(ws + WS_SACT);
    const int vcu = (nb % 8 == 0) ? (bid % 8) * (nb / 8) + bid / 8 : bid;

    volatile LAS unsigned* xbw = (volatile LAS unsigned*)(smem + LDS_BYTES - 16);
    if (tid == 0) { xbw[0] = 0u; xbw[1] = 0u; xbw[2] = 0u; xbw[3] = 0u; }
    __syncthreads();
    XcdBarrier bar; bar.bar = ctl; bar.x = 0; bar.st = xbw;
    const bool multi = (hi - lo) > 1;
    if (multi) bar = xcd_barrier_post(ctl, xbw);
#define IN(k) (lo <= (k) && (k) < hi)
#define SEAM(k) do { if (IN(k) && IN((k) + 1)) xcd_barrier(bar); } while (0)
    float* sw = (float*)smem + wv * WLDS_FLOATS;
    const bool qfirst = ((bid >> 3) & 1) == 0;
#define QDYN(k, mx) do { constexpr int qb_ = q_beg(k), qc_ = q_cnt(k); const QExtra qxd{nullptr, q8in, sin8, nullptr, q8mkv, smkv}; quant_units<true>(smem, karg_in(I_WGU), karg_in(I_WDN), q8gu, q8dn, sgu, sdn, nullptr, q8out, sout, qxd, qb_, qc_, (unsigned*)(ws + CTL_QCTR) + 16 * (k), (mx), bid, nb); } while (0)
#define QPRE(k) do { constexpr int qf_ = q_first(k); QDYN(k, qfirst ? qf_ : 0); } while (0)
#define QPOST(k) do { __syncthreads(); QDYN(k, 1 << 30); } while (0)
    int* segw = (int*)(sw + 4096 + 512);

    if (IN(0)) {
        DEFPTRS;
        const int lane = LANE_NOW; (void)lane;
        if (wv == 0 && (bid & 1) == 0 && (bid >> 1) < 128) {
            const int task = bid >> 1, kv = task >> 6, jg = (task >> 4) & 3, kc = task & 15;
            const float* pos = p.in[kv ? I_POSV : I_POSK] + kc * 256; const float* w1 = p.in[kv ? I_W1V : I_W1K] + (size_t)kc * 256 * 256 + jg * 64 + lane;
            float s0 = 0.f, s1 = 0.f, s2 = 0.f, s3 = 0.f;
            for (int k = 0; k < 256; k += 4) { s0 += pos[k] * w1[(size_t)k * 256]; s1 += pos[k + 1] * w1[(size_t)(k + 1) * 256]; s2 += pos[k + 2] * w1[(size_t)(k + 2) * 256]; s3 += pos[k + 3] * w1[(size_t)(k + 3) * 256]; }
            bias1[(kv * 16 + kc) * 256 + jg * 64 + lane] = (s0 + s1) + (s2 + s3);
        }
        for (int i = bid * 512 + tid; i < 2 * 128 * 256; i += nb * 512) { const int kv = i >> 15, d = (i >> 8) & 127, n = i & 255; wt2[i] = (_Float16)p.in[kv ? I_W2V : I_W2K][(size_t)n * 128 + d]; }
        for (int i = bid * 512 + tid; i < 32 * 2048; i += nb * 512) { const int e = i >> 11, d = i & 2047; wr16[i] = (_Float16)p.in[I_WR][(size_t)d * 32 + e]; }
        {
            for (int row0 = gw; row0 < T_ + 2048; row0 += nw * 2) {
                float4 raw[2][8];
#pragma unroll
                for (int i = 0; i < 2; ++i) { const int row = row0 + i * nw; const float* src = row < T_ ? p.in[I_X] + (size_t)row * 2048 : p.in[I_MEM] + (size_t)(row - T_) * 2048;
#pragma unroll
                    for (int c = 0; c < 4; ++c) { raw[i][2 * c] = make_float4(0.f, 0.f, 0.f, 0.f); raw[i][2 * c + 1] = raw[i][2 * c];
                        if (row < T_ + 2048) { raw[i][2 * c] = *(const float4*)(src + (lane + 64 * c) * 8); raw[i][2 * c + 1] = *(const float4*)(src + (lane + 64 * c) * 8 + 4); } } }
#pragma unroll
                for (int i = 0; i < 2; ++i) { const int row = row0 + i * nw;
                    float amax = 0.f;
#pragma unroll
                    for (int k = 0; k < 8; ++k) amax = fmaxf(amax, fmaxf(fmaxf(fabsf(raw[i][k].x), fabsf(raw[i][k].y)), fmaxf(fabsf(raw[i][k].z), fabsf(raw[i][k].w))));
                    amax = wave_max(amax);
                    if (row < T_ + 2048) {
                        const float qinv = amax > 0.f ? 127.f / amax : 0.f;
                        if (lane == 0) sxa[row] = amax > 0.f ? amax / 127.f : 1.f;
#pragma unroll
                        for (int c = 0; c < 4; ++c) { const float4 a = raw[i][2 * c], b2 = raw[i][2 * c + 1];
                            uint2 q; q.x = pack4_i8(a.x * qinv, a.y * qinv, a.z * qinv, a.w * qinv); q.y = pack4_i8(b2.x * qinv, b2.y * qinv, b2.z * qinv, b2.w * qinv);
                            *(uint2*)(x8 + (size_t)row * 2048 + (lane + 64 * c) * 8) = q;
                            if (row < T_) { h8 o; o[0] = (_Float16)a.x; o[1] = (_Float16)a.y; o[2] = (_Float16)a.z; o[3] = (_Float16)a.w; o[4] = (_Float16)b2.x; o[5] = (_Float16)b2.y; o[6] = (_Float16)b2.z; o[7] = (_Float16)b2.w;
                                *(h8*)(x16 + (size_t)row * 2048 + (lane + 64 * c) * 8) = o; } } }
                }
            }
        }
        {
            const QExtra qx{p.in[I_WIN], q8in, sin8, p.in[I_WMEMKV], q8mkv, smkv};
            quant_units<false>(smem, p.in[I_WGU], p.in[I_WDN], q8gu, q8dn, sgu, sdn, p.in[I_WOUT], q8out, sout, qx, NE * 192, 64 + 73 + 32, nullptr, 0, bid, nb);
            __syncthreads();
            conv_all((float*)smem, p.in[I_WIN], p.in[I_W1K], p.in[I_W1V], p.in[I_WMEMKV], wtin, wt1, wtmkv, bid, nb);
            __syncthreads();
        }
    }
    SEAM(0);
    if (IN(1)) {
        DEFPTRS;
        const int lane = LANE_NOW; (void)lane;
        QPRE(1);
        { g8::ProbInF P{x16, proj16, nb, bid}; g8::gemm_phase(lds, P); }
        __syncthreads();
        { g8::ProbIn8 P{x8, proj16, sxa, nb, (bid + 192) & 255}; g8::gemm_phase(lds, P); }
        QPOST(1);
    }
    SEAM(1);
    if (IN(2)) {
        DEFPTRS;
        const int lane = LANE_NOW; (void)lane;
        QPRE(2);
        { g8::ProbCmp P{kv16, wt1, uv, nb, bid}; g8::gemm_phase(lds, P); __syncthreads(); }
        for (int i = bid * 512 + tid; i < T_ * 64; i += nb * 512) {
            const int chn = i & 63, row = i >> 6, t = row & (S_ - 1), g = chn >> 4;
            const int win = 2 << g, n = min(win, t + 1);
            const _Float16* src = proj16 + (size_t)row * INW + C_UP + chn * 8;
            float a[8];
            const h8 cur = *(const h8*)src;
            h8 vv[15];
#pragma unroll
            for (int k = 0; k < 15; ++k) { vv[k] = (h8){0, 0, 0, 0, 0, 0, 0, 0}; if (k + 1 < n) vv[k] = *(const h8*)(src - (size_t)(k + 1) * INW); }
#pragma unroll
            for (int q = 0; q < 8; ++q) a[q] = (float)cur[q];
#pragma unroll
            for (int k = 0; k < 15; ++k) {
#pragma unroll
                for (int q = 0; q < 8; ++q) a[q] += (float)vv[k][q]; }
            const float rn = 1.f / (float)n;
            float4 o0, o1;
            o0.x = a[0] * rn - (float)cur[0]; o0.y = a[1] * rn - (float)cur[1]; o0.z = a[2] * rn - (float)cur[2]; o0.w = a[3] * rn - (float)cur[3];
            o1.x = a[4] * rn - (float)cur[4]; o1.y = a[5] * rn - (float)cur[5]; o1.z = a[6] * rn - (float)cur[6]; o1.w = a[7] * rn - (float)cur[7];
            *(float4*)(pooled + (size_t)row * 512 + chn * 8) = o0; *(float4*)(pooled + (size_t)row * 512 + chn * 8 + 4) = o1;
        }
        {
            const int r32 = lane & 31, hi = lane >> 5, g = wv >> 1, half = wv & 1;
            for (int uu = vcu; uu < 512; uu += nb) {
                const int v = uu & 255, bk = v >> 4, qi = (uu >> 8) ? 31 - (v & 15) : (v & 15), b = bk >> 1, kvh = bk & 1;
                const int t = qi * 64 + half * 32 + r32;
                const int lo_t = max(0, qi - 8);
                const unsigned tmask = (unsigned)(((1ull << (qi + 1)) - 1ull) & ~((1ull << lo_t) - 1ull));
                at8::attn_unit(smem, proj16 + (size_t)(b * S_ + t) * INW + C_Q + (kvh * 4 + g) * 128 + hi * 8,
                               kv16 + ((size_t)(4 * B_ + b) * 2 + kvh) * KVSEG, kv16 + ((size_t)(5 * B_ + b) * 2 + kvh) * KVSEG, 128, tmask, 512, t, 0xffffffffu,
                               owin + (size_t)(b * S_ + qi * 64 + half * 32) * 1024 + (kvh * 4 + g) * 128, 1024);
            }
            for (int u = vcu; u < 256; u += nb) {
                const int b = u >> 5, h = (u >> 3) & 3, qt = u & 7;
                const int t = qt * 256 + wv * 32 + r32;
                at8::attn_unit(smem, proj16 + (size_t)(b * S_ + t) * INW + C_QM + h * 128 + hi * 8,
                               kvmem16 + (size_t)b * 256 * 1024 + h * 128, kvmem16 + (size_t)b * 256 * 1024 + 512 + h * 128, 1024, 0xFu, 0, 255, 0xffffffffu,
                               omem + (size_t)(b * S_ + qt * 256 + wv * 32) * 512 + h * 128, 512);
            }
        }
        QPOST(2);
    }
    SEAM(2);
    if (IN(3)) {
        DEFPTRS;
        const int lane = LANE_NOW; (void)lane;
        QPRE(3);
        {
            float* bsum = (float*)smem;
            _Float16* hs = (_Float16*)(smem + 4096);
            { const int kv = tid >> 8, n = tid & 255; float a = 0.f;
#pragma unroll
              for (int kc = 0; kc < 16; ++kc) a += bias1[(kv * 16 + kc) * 256 + n];
              bsum[tid] = a; }
            __syncthreads();
            const int fr = lane & 15, fq = lane >> 4;
            for (int u = bid; u < 256; u += nb) {
                const int kv = u >> 7, rt = u & 127;
#pragma unroll
                for (int q = 0; q < 8; ++q) { const int e = tid + 512 * q, i = e >> 8, n = e & 255;
                    const int row = rt * 16 + i, c = (row >> 1) & 127;
                    float a = 0.f;
                    if (c != 127) { a = bsum[kv * 256 + n];
#pragma unroll
                        for (int sp = 0; sp < 4; ++sp) { const float* base = uv + ((size_t)(kv * 4 + sp) * 2048) * 512; a += base[(size_t)row * 512 + n] + base[(size_t)(row + 2) * 512 + 256 + n]; }
                        a = gelu_fast(a); }
                    hs[i * 264 + n] = (_Float16)a; }
                __syncthreads();
                { const _Float16* bp = wt2 + ((size_t)kv * 128 + wv * 16 + fr) * 256 + fq * 8;
                  f4 acc = (f4){0.f, 0.f, 0.f, 0.f};
#pragma unroll
                  for (int sI = 0; sI < 8; ++sI) { const h8 a = *(const h8*)(hs + fr * 264 + sI * 32 + fq * 8), bb = *(const h8*)(bp + sI * 32); acc = __builtin_amdgcn_mfma_f32_16x16x32_f16(a, bb, acc, 0, 0, 0); }
                  _Float16* dst = kv ? vc16 : kc16;
#pragma unroll
                  for (int j = 0; j < 4; ++j) { const int row = rt * 16 + fq * 4 + j; dst[(size_t)row * 128 + wv * 16 + fr] = (((row >> 1) & 127) == 127) ? (_Float16)0.f : (_Float16)acc[j]; } }
                __syncthreads();
            }
        }
        for (int u = bid; u < 128 * 4; u += nb) { const int g = u >> 7, mt = u & 127;
            ARowPlain af{pooled + g * 128, 512, mt * 128, T_}; EpiPool ef{opool, p.in[I_POOLS], mt * 128, g};
            gemm_tile(smem, 128, af, p.in[I_POOLW] + (size_t)g * 128 * 128, 128, 0, 128, false, ef);
        }
        QPOST(3);
    }
    SEAM(3);
    if (IN(4)) {
        DEFPTRS;
        const int lane = LANE_NOW; (void)lane;
        QPRE(4);
        const int r32 = lane & 31, hi = lane >> 5, g = wv >> 1, half = wv & 1;
        for (int uu = vcu; uu < 512; uu += nb) {
            const int v = uu & 255, bk = v >> 4, qi = (uu >> 8) ? 31 - (v & 15) : (v & 15), b = bk >> 1, kvh = bk & 1;
            const int tl = half * 32 + r32, t = qi * 64 + tl;
            at8::cmp_slc_unit(smem, proj16 + (size_t)(b * S_ + t) * INW + C_Q + (kvh * 4 + g) * 128 + hi * 8,
                              kc16 + (size_t)(b * 128 * 2 + kvh) * 128, vc16 + (size_t)(b * 128 * 2 + kvh) * 128,
                              kv16 + ((size_t)(2 * B_ + b) * 2 + kvh) * KVSEG, kv16 + ((size_t)(3 * B_ + b) * 2 + kvh) * KVSEG, t, tl, g, qi,
                              ocmp + (size_t)(b * S_ + qi * 64 + half * 32) * 1024 + (kvh * 4 + g) * 128, oslc + (size_t)(b * S_ + qi * 64 + half * 32) * 1024 + (kvh * 4 + g) * 128);
        }
        QPOST(4);
    }
    SEAM(4);
    if (IN(5)) {
        DEFPTRS;
        QPRE(5);
        const int lane = LANE_NOW;
        for (int row = gw; row < T_; row += nw) {
            const _Float16* pr = proj16 + (size_t)row * INW + C_G;
            float v[32]; float ss = 0.f;
#pragma unroll
            for (int c = 0; c < 2; ++c) { const int col = (lane + 64 * c) * 8, h = col >> 7; const size_t o = (size_t)row * 1024 + col;
                const float g0 = sigmoidf_((float)pr[h * 3]), g1 = sigmoidf_((float)pr[h * 3 + 1]), g2 = sigmoidf_((float)pr[h * 3 + 2]);
                const h8 a = *(const h8*)(ocmp + o), b2 = *(const h8*)(oslc + o), c2 = *(const h8*)(owin + o);
#pragma unroll
                for (int q = 0; q < 8; ++q) { const float x = g0 * (float)a[q] + g1 * (float)b2[q] + g2 * (float)c2[q]; v[c * 8 + q] = x; ss += x * x; } }
            ss = wave_sum(ss); float r = rsqrtf(ss / 1024.f + LN_EPS);
#pragma unroll
            for (int c = 0; c < 2; ++c) { const int col = (lane + 64 * c) * 8; const float4 ga = *(const float4*)(p.in[I_GNNSA] + col), gb = *(const float4*)(p.in[I_GNNSA] + col + 4);
                v[c * 8 + 0] *= r * ga.x; v[c * 8 + 1] *= r * ga.y; v[c * 8 + 2] *= r * ga.z; v[c * 8 + 3] *= r * ga.w; v[c * 8 + 4] *= r * gb.x; v[c * 8 + 5] *= r * gb.y; v[c * 8 + 6] *= r * gb.z; v[c * 8 + 7] *= r * gb.w; }
            { const h8 a = *(const h8*)(opool + (size_t)row * 512 + lane * 8); ss = 0.f;
#pragma unroll
              for (int q = 0; q < 8; ++q) { v[16 + q] = (float)a[q]; ss += v[16 + q] * v[16 + q]; }
              ss = wave_sum(ss); r = rsqrtf(ss / 512.f + LN_EPS);
              const float4 ga = *(const float4*)(p.in[I_GNPOOL] + lane * 8), gb = *(const float4*)(p.in[I_GNPOOL] + lane * 8 + 4);
              v[16] *= r * ga.x; v[17] *= r * ga.y; v[18] *= r * ga.z; v[19] *= r * ga.w; v[20] *= r * gb.x; v[21] *= r * gb.y; v[22] *= r * gb.z; v[23] *= r * gb.w; }
            { const h8 a = *(const h8*)(omem + (size_t)row * 512 + lane * 8); ss = 0.f;
#pragma unroll
              for (int q = 0; q < 8; ++q) { v[24 + q] = (float)a[q]; ss += v[24 + q] * v[24 + q]; }
              ss = wave_sum(ss); r = rsqrtf(ss / 512.f + LN_EPS);
              const float4 ga = *(const float4*)(p.in[I_GNMEM] + lane * 8), gb = *(const float4*)(p.in[I_GNMEM] + lane * 8 + 4);
              v[24] *= r * ga.x; v[25] *= r * ga.y; v[26] *= r * ga.z; v[27] *= r * ga.w; v[28] *= r * gb.x; v[29] *= r * gb.y; v[30] *= r * gb.z; v[31] *= r * gb.w; }
            float amax = 0.f;
#pragma unroll
            for (int k = 0; k < 32; ++k) amax = fmaxf(amax, fabsf(v[k]));
            amax = wave_max(amax);
            const float qinv = amax > 0.f ? 127.f / amax : 0.f;
            if (lane == 0) scat[row] = amax > 0.f ? amax / 127.f : 1.f;
#pragma unroll
            for (int c = 0; c < 4; ++c) { const int col = c < 2 ? (lane + 64 * c) * 8 : (c == 2 ? 1024 + lane * 8 : 1536 + lane * 8);
                uint2 q; q.x = pack4_i8(v[c * 8 + 0] * qinv, v[c * 8 + 1] * qinv, v[c * 8 + 2] * qinv, v[c * 8 + 3] * qinv); q.y = pack4_i8(v[c * 8 + 4] * qinv, v[c * 8 + 5] * qinv, v[c * 8 + 6] * qinv, v[c * 8 + 7] * qinv);
                *(uint2*)(cat8 + (size_t)row * 2048 + col) = q; }
        }
        QPOST(5);
    }
    SEAM(5);
    if (IN(6)) {
        DEFPTRS;
        const int lane = LANE_NOW; (void)lane;
        QPRE(6);
        { g8::ProbOut P{cat8, q8out, hpre16, x16, scat, sout, nb, bid};
          g8::gemm_phase(lds, P); }
        QPOST(6);
    }
    SEAM(6);
    if (IN(7)) {
        DEFPTRS;
        const int lane = LANE_NOW; (void)lane;
        QPRE(7);
        float* lg = (float*)smem;
        const int r32 = lane & 31, hi = lane >> 5, fr = lane & 15, fq = lane >> 4;
        for (int u = bid; u < T_ / 64; u += nb) {
            const int base = u * 64;
            h8 raw[8][4];
#pragma unroll
            for (int i = 0; i < 8; ++i)
#pragma unroll
                for (int c = 0; c < 4; ++c) raw[i][c] = *(const h8*)(hpre16 + (size_t)(base + wv * 8 + i) * 2048 + (lane + 64 * c) * 8);
#pragma unroll
            for (int i = 0; i < 8; ++i) {
                const int row = base + wv * 8 + i;
                float v[32]; float s = 0.f;
#pragma unroll
                for (int c = 0; c < 4; ++c) {
#pragma unroll
                    for (int q = 0; q < 8; ++q) { v[c * 8 + q] = (float)raw[i][c][q]; s += v[c * 8 + q]; } }
                const float mu = wave_sum(s) / 2048.f; float q2 = 0.f;
#pragma unroll
                for (int k = 0; k < 32; ++k) { const float d = v[k] - mu; q2 += d * d; }
                const float rs = rsqrtf(wave_sum(q2) / 2048.f + LN_EPS);
                float amax = 0.f;
#pragma unroll
                for (int c = 0; c < 4; ++c) { const int col = (lane + 64 * c) * 8;
                    const float4 g0 = *(const float4*)(p.in[I_LN1G] + col), g1 = *(const float4*)(p.in[I_LN1G] + col + 4), b0 = *(const float4*)(p.in[I_LN1B] + col), b1 = *(const float4*)(p.in[I_LN1B] + col + 4);
                    float4 o0, o1;
                    o0.x = (v[c * 8 + 0] - mu) * rs * g0.x + b0.x; o0.y = (v[c * 8 + 1] - mu) * rs * g0.y + b0.y; o0.z = (v[c * 8 + 2] - mu) * rs * g0.z + b0.z; o0.w = (v[c * 8 + 3] - mu) * rs * g0.w + b0.w;
                    o1.x = (v[c * 8 + 4] - mu) * rs * g1.x + b1.x; o1.y = (v[c * 8 + 5] - mu) * rs * g1.y + b1.y; o1.z = (v[c * 8 + 6] - mu) * rs * g1.z + b1.z; o1.w = (v[c * 8 + 7] - mu) * rs * g1.w + b1.w;
                    h8 oh; oh[0] = (_Float16)o0.x; oh[1] = (_Float16)o0.y; oh[2] = (_Float16)o0.z; oh[3] = (_Float16)o0.w; oh[4] = (_Float16)o1.x; oh[5] = (_Float16)o1.y; oh[6] = (_Float16)o1.z; oh[7] = (_Float16)o1.w;
                    *(h8*)(h16 + (size_t)row * 2048 + col) = oh;
                    v[c * 8 + 0] = o0.x; v[c * 8 + 1] = o0.y; v[c * 8 + 2] = o0.z; v[c * 8 + 3] = o0.w; v[c * 8 + 4] = o1.x; v[c * 8 + 5] = o1.y; v[c * 8 + 6] = o1.z; v[c * 8 + 7] = o1.w;
                    amax = fmaxf(amax, fmaxf(fmaxf(fmaxf(fabsf(o0.x), fabsf(o0.y)), fmaxf(fabsf(o0.z), fabsf(o0.w))), fmaxf(fmaxf(fabsf(o1.x), fabsf(o1.y)), fmaxf(fabsf(o1.z), fabsf(o1.w))))); }
                amax = wave_max(amax);
                const float qinv = amax > 0.f ? 127.f / amax : 0.f;
                if (lane == 0) sah[row] = amax > 0.f ? amax / 127.f : 1.f;
#pragma unroll
                for (int c = 0; c < 4; ++c) { const int col = (lane + 64 * c) * 8;
                    uint2 q; q.x = pack4_i8(v[c * 8 + 0] * qinv, v[c * 8 + 1] * qinv, v[c * 8 + 2] * qinv, v[c * 8 + 3] * qinv); q.y = pack4_i8(v[c * 8 + 4] * qinv, v[c * 8 + 5] * qinv, v[c * 8 + 6] * qinv, v[c * 8 + 7] * qinv);
                    *(uint2*)(h8q + (size_t)row * 2048 + col) = q; }
            }
            asm volatile("s_waitcnt vmcnt(0)" ::: "memory");
            __syncthreads();
            {
                const int tok0 = base + 16 * (wv >> 1), e0 = 16 * (wv & 1);
                const _Float16* ap = h16 + (size_t)(tok0 + fr) * 2048 + fq * 8; const _Float16* bp = wr16 + (size_t)(e0 + fr) * 2048 + fq * 8;
                f4 acc = (f4){0.f, 0.f, 0.f, 0.f};
#pragma unroll 8
                for (int sI = 0; sI < 64; ++sI) { const h8 a = *(const h8*)(ap + sI * 32), bb = *(const h8*)(bp + sI * 32); acc = __builtin_amdgcn_mfma_f32_16x16x32_f16(a, bb, acc, 0, 0, 0); }
                const float br = p.in[I_BR][e0 + fr];
#pragma unroll
                for (int j = 0; j < 4; ++j) lg[(16 * (wv >> 1) + 4 * fq + j) * 33 + e0 + fr] = acc[j] + br;
            }
            __syncthreads();
#pragma unroll 1
            for (int it = 0; it < 4; ++it) {
                const int tk = 8 * wv + 2 * it + hi;
                const float iv = lg[tk * 33 + r32];
                int rank = 0;
                for (int i = 0; i < 32; ++i) { const float vi = __shfl(iv, i + 32 * hi); rank += (vi > iv || (vi == iv && i < r32)) ? 1 : 0; }
                float tv[4]; int te[4];
#pragma unroll
                for (int r = 0; r < 4; ++r) { const unsigned long long bm = __ballot(rank == r); const unsigned hm = (unsigned)(bm >> (32 * hi)); const int src = __ffs(hm) - 1; te[r] = src; tv[r] = __shfl(iv, src + 32 * hi); }
                const float e0v = 1.f, e1v = expf(tv[1] - tv[0]), e2v = expf(tv[2] - tv[0]), e3v = expf(tv[3] - tv[0]); const float inv = 1.f / (e0v + e1v + e2v + e3v);
                if (r32 < 4) { const int e = r32 == 0 ? te[0] : r32 == 1 ? te[1] : r32 == 2 ? te[2] : te[3]; const float g = (r32 == 0 ? e0v : r32 == 1 ? e1v : r32 == 2 ? e2v : e3v) * inv;
                    const int a = (base + tk) * 4 + r32; const int pos = atomicAdd(&cnt[e], 1); list[(size_t)e * T_ + pos] = a; gate[a] = g; gate2[(size_t)e * T_ + pos] = g; sa2[(size_t)e * T_ + pos] = sah[base + tk]; }
            }
            __syncthreads();
        }
        QPOST(7);
    }
    SEAM(7);
    LAS int* mtab = (LAS int*)(smem + g8::STAGE_BYTES);
    if (IN(8)) {
        DEFPTRS;
        QPRE(8);
        const int lane = LANE_NOW; (void)lane;
        if (tid == 0) { int ub = 0, rs = 0;
            for (int e = 0; e < NE; ++e) { const int c = (int)__hip_atomic_load((unsigned*)&cnt[e], __ATOMIC_RELAXED, __HIP_MEMORY_SCOPE_AGENT); mtab[e] = c; mtab[32 + e] = ub; mtab[65 + e] = rs; ub += ((c + 255) >> 8) * 16; rs += c; }
            mtab[64] = ub; mtab[97] = rs; mtab[98] = ub; }
        __syncthreads();
        g8::moe_build(mtab, nb, vcu);
        __syncthreads();
        { g8::ProbGu P{h8q, q8gu, actf8, p.in[I_BGU], list, sa2, sgu, g8::MoeTab{mtab, 16}, nb, vcu};
          g8::gemm_phase(lds, P); }
        QPOST(8);
    }
    SEAM(8);
    if (IN(9)) {
        DEFPTRS;
        QPRE(9);
        const int lane = LANE_NOW;
        for (int row0 = gw; row0 < NA; row0 += nw * 8) {
            uint2 raw[8][4];
#pragma unroll
            for (int i = 0; i < 8; ++i)
#pragma unroll
                for (int c = 0; c < 4; ++c) raw[i][c] = *(const uint2*)(actf8 + (size_t)(row0 + i * nw) * 2048 + (lane + 64 * c) * 8);
#pragma unroll
            for (int i = 0; i < 8; ++i) { const int row = row0 + i * nw;
                float v[32]; float amax = 0.f;
#pragma unroll
                for (int c = 0; c < 4; ++c) { const uint2 a = raw[i][c];
                    dec4_fp8(a.x, v[c * 8 + 0], v[c * 8 + 1], v[c * 8 + 2], v[c * 8 + 3]); dec4_fp8(a.y, v[c * 8 + 4], v[c * 8 + 5], v[c * 8 + 6], v[c * 8 + 7]);
#pragma unroll
                    for (int q = 0; q < 8; ++q) amax = fmaxf(amax, fabsf(v[c * 8 + q])); }
                amax = wave_max(amax);
                const float qinv = amax > 0.f ? 127.f / amax : 0.f;
                if (lane == 0) sact[row] = amax > 0.f ? amax / 127.f : 1.f;
#pragma unroll
                for (int c = 0; c < 4; ++c) { uint2 q; q.x = pack4_i8(v[c * 8 + 0] * qinv, v[c * 8 + 1] * qinv, v[c * 8 + 2] * qinv, v[c * 8 + 3] * qinv); q.y = pack4_i8(v[c * 8 + 4] * qinv, v[c * 8 + 5] * qinv, v[c * 8 + 6] * qinv, v[c * 8 + 7] * qinv);
                    *(uint2*)(act8 + (size_t)row * 2048 + (lane + 64 * c) * 8) = q; }
            }
        }
        QPOST(9);
    }
    SEAM(9);
    if (IN(10)) {
        DEFPTRS;
        const int lane = LANE_NOW; (void)lane;
        if (tid == 0) { int ub = 0, rs = 0;
            for (int e = 0; e < NE; ++e) { const int c = (int)__hip_atomic_load((unsigned*)&cnt[e], __ATOMIC_RELAXED, __HIP_MEMORY_SCOPE_AGENT); mtab[e] = c; mtab[32 + e] = ub; mtab[65 + e] = rs; ub += ((c + 255) >> 8) * 8; rs += c; }
            mtab[64] = ub; mtab[97] = rs; mtab[98] = ub; }
        __syncthreads();
        g8::moe_build(mtab, nb, vcu);
        __syncthreads();
        g8::ProbDn P{act8, q8dn, yf8, p.in[I_BDN], list, gate2, sact, sdn, g8::MoeTab{mtab, 8}, nb, vcu};
        g8::gemm_phase(lds, P);
        __syncthreads();
    }
    SEAM(10);
    if (IN(11)) {
        DEFPTRS;
        const int lane = LANE_NOW; (void)lane;
        for (int row0 = gw; row0 < T_; row0 += nw * 2) {
          h8 hraw[2][4]; uint2 yraw[2][4][4];
#pragma unroll
          for (int i = 0; i < 2; ++i)
#pragma unroll
            for (int c = 0; c < 4; ++c) { const int col = (lane + 64 * c) * 8; const size_t yo = (size_t)(row0 + i * nw) * 4 * 2048 + col;
                hraw[i][c] = *(const h8*)(h16 + (size_t)(row0 + i * nw) * 2048 + col);
                yraw[i][c][0] = *(const uint2*)(yf8 + yo); yraw[i][c][1] = *(const uint2*)(yf8 + yo + 2048); yraw[i][c][2] = *(const uint2*)(yf8 + yo + 4096); yraw[i][c][3] = *(const uint2*)(yf8 + yo + 6144); }
#pragma unroll
          for (int i = 0; i < 2; ++i) { const int row = row0 + i * nw;
            float v[32]; float s = 0.f;
#pragma unroll
            for (int c = 0; c < 4; ++c) {
                const h8 hh8 = hraw[i][c];
                const uint2 y0 = yraw[i][c][0], y1 = yraw[i][c][1], y2 = yraw[i][c][2], y3 = yraw[i][c][3];
                float ys[8], t0[8], t1[8], t2[8], t3[8];
                dec4_fp8(y0.x, t0[0], t0[1], t0[2], t0[3]); dec4_fp8(y0.y, t0[4], t0[5], t0[6], t0[7]); dec4_fp8(y1.x, t1[0], t1[1], t1[2], t1[3]); dec4_fp8(y1.y, t1[4], t1[5], t1[6], t1[7]);
                dec4_fp8(y2.x, t2[0], t2[1], t2[2], t2[3]); dec4_fp8(y2.y, t2[4], t2[5], t2[6], t2[7]); dec4_fp8(y3.x, t3[0], t3[1], t3[2], t3[3]); dec4_fp8(y3.y, t3[4], t3[5], t3[6], t3[7]);
#pragma unroll
                for (int q = 0; q < 8; ++q) ys[q] = (t0[q] + t1[q]) + (t2[q] + t3[q]);
#pragma unroll
                for (int q = 0; q < 8; ++q) { v[c * 8 + q] = DN_ALPHA * (float)hh8[q] + ys[q] * 0.0625f; s += v[c * 8 + q]; } }
            const float mu = wave_sum(s) / 2048.f; float q2 = 0.f;
#pragma unroll
            for (int i = 0; i < 32; ++i) { const float d = v[i] - mu; q2 += d * d; }
            const float rs = rsqrtf(wave_sum(q2) / 2048.f + LN_EPS);
#pragma unroll
            for (int c = 0; c < 4; ++c) { const int col = (lane + 64 * c) * 8;
                const float4 ga = *(const float4*)(p.in[I_LN2G] + col), gb = *(const float4*)(p.in[I_LN2G] + col + 4), ba = *(const float4*)(p.in[I_LN2B] + col), bb = *(const float4*)(p.in[I_LN2B] + col + 4);
                float4 o0, o1;
                o0.x = (v[c * 8 + 0] - mu) * rs * ga.x + ba.x; o0.y = (v[c * 8 + 1] - mu) * rs * ga.y + ba.y; o0.z = (v[c * 8 + 2] - mu) * rs * ga.z + ba.z; o0.w = (v[c * 8 + 3] - mu) * rs * ga.w + ba.w;
                o1.x = (v[c * 8 + 4] - mu) * rs * gb.x + bb.x; o1.y = (v[c * 8 + 5] - mu) * rs * gb.y + bb.y; o1.z = (v[c * 8 + 6] - mu) * rs * gb.z + bb.z; o1.w = (v[c * 8 + 7] - mu) * rs * gb.w + bb.w;
                *(float4*)(p.out + (size_t)row * 2048 + col) = o0; *(float4*)(p.out + (size_t)row * 2048 + col + 4) = o1; }
          }
        }
    }
}

constexpr int NPHASE = 12;

extern "C" void kernel_launch(void* const* d_in, const int* in_sizes, int n_in, void* d_out, int out_size, void* d_ws, size_t ws_size, hipStream_t stream) {
    static int grid = 0;
    if (grid == 0) {
        if (n_in != 26 || ws_size < WS_END) { fprintf(stderr, "kernel_launch: unexpected n_in %d or ws_size %zu (< %zu)\n", n_in, ws_size, (size_t)WS_END); grid = -1; return; }
        int dev = 0, cus = 0, per_cu = 0;
        hipGetDevice(&dev); hipDeviceGetAttribute(&cus, hipDeviceAttributeMultiprocessorCount, dev);
        if (hipFuncSetAttribute((const void*)fwd, hipFuncAttributeMaxDynamicSharedMemorySize, LDS_BYTES) != hipSuccess) { fprintf(stderr, "hipFuncSetAttribute failed\n"); grid = -1; return; }
        hipOccupancyMaxActiveBlocksPerMultiprocessor(&per_cu, (const void*)fwd, 512, LDS_BYTES);
        (void)hipGetLastError();
        if (per_cu < 1) fprintf(stderr, "occupancy query says %d blocks per CU\n", per_cu);
        grid = cus > 0 ? cus : 256;
    }
    if (grid < 0) return;
    hipMemsetAsync((char*)d_ws + WS_CTL, 0, CTL_BYTES, stream);
    Params p{};
    for (int i = 0; i < 26; ++i) p.in[i] = (const float*)d_in[i];
    p.out = (float*)d_out; p.ws = (unsigned char*)d_ws;
#if N_LAUNCH_MODE == 1
    p.lo_hi = (long long)0 | ((long long)NPHASE << 32);
    hipLaunchKernelGGL(fwd, dim3(grid), dim3(512), LDS_BYTES, stream, p);
#else
    for (int ph = 0; ph < NPHASE; ++ph) {
        p.lo_hi = (long long)ph | ((long long)(ph + 1) << 32);
        hipLaunchKernelGGL(fwd, dim3(grid), dim3(512), LDS_BYTES, stream, p);
    }
#endif
}
```

```cpp
#include <hip/hip_runtime.h>
#include <cstdio>
#include <cstdint>

#ifndef N_LAUNCH_MODE
#define N_LAUNCH_MODE 1
#endif

constexpr int B_ = 8, S_ = 2048, D_ = 2048, T_ = B_ * S_;
constexpr int INW = 3608;
constexpr int C_Q = 0, C_KC = 1024, C_VC = 1280, C_KS = 1536, C_VS = 1792, C_KW = 2048, C_VW = 2304, C_G = 2560, C_UP = 2584, C_QM = 3096;
constexpr int NC = 127;
constexpr int CROWS = B_ * NC * 2;
constexpr int NE = 32, DE = 2048, NA = T_ * 4;
constexpr float LN_EPS = 1e-5f;
constexpr float DN_ALPHA = 1.189207115002721f;
constexpr float ATT_SCALE = 0.08838834764831845f;

constexpr size_t al256(size_t x) { return (x + 255) & ~(size_t)255; }
constexpr size_t WS_CTL = 0;
constexpr size_t CTL_BYTES = 65536;
constexpr size_t CTL_CNT = 16384;
constexpr size_t WS_PROJ = CTL_BYTES;
constexpr size_t WS_KVMEM = WS_PROJ + al256((size_t)T_ * INW * 4);
constexpr size_t WS_BIAS1 = WS_KVMEM + al256((size_t)2048 * 1024 * 4);
constexpr size_t WS_HID = WS_BIAS1 + al256(2 * 16 * 256 * 4);
constexpr size_t WS_KC = WS_HID + al256((size_t)2 * 2048 * 256 * 4);
constexpr size_t WS_VC = WS_KC + al256((size_t)CROWS * 128 * 4);
constexpr size_t WS_POOLED = WS_VC + al256((size_t)CROWS * 128 * 4);
constexpr size_t WS_OPOOL = WS_POOLED + al256((size_t)T_ * 512 * 4);
constexpr size_t WS_OWIN = WS_OPOOL + al256((size_t)T_ * 512 * 4);
constexpr size_t WS_OCMP = WS_OWIN + al256((size_t)T_ * 1024 * 4);
constexpr size_t WS_OSLC = WS_OCMP + al256((size_t)T_ * 1024 * 4);
constexpr size_t WS_SEL = WS_OSLC + al256((size_t)T_ * 1024 * 4);
constexpr size_t WS_OMEM = WS_SEL + al256((size_t)T_ * 2 * 4);
constexpr size_t WS_CAT16 = WS_OMEM + al256((size_t)T_ * 512 * 4);
constexpr size_t WS_HPRE = WS_CAT16 + al256((size_t)T_ * 2048 * 2);
constexpr size_t WS_H = WS_HPRE + al256((size_t)T_ * 2048 * 4);
constexpr size_t WS_H16 = WS_H + al256((size_t)T_ * 2048 * 4);
constexpr size_t WS_GATE = WS_H16 + al256((size_t)T_ * 2048 * 2);
constexpr size_t WS_LIST = WS_GATE + al256((size_t)NA * 4);
constexpr size_t WS_ACT16 = WS_LIST + al256((size_t)NE * T_ * 4);
constexpr size_t WS_Y16 = WS_ACT16 + al256((size_t)(NA + 256) * 2048 * 2);
constexpr size_t WS_X16 = WS_Y16 + al256((size_t)NA * 2048 * 2);
constexpr size_t WS_MEM16 = WS_X16 + (size_t)T_ * 2048 * 2;
constexpr size_t WS_WTIN = WS_MEM16 + al256((size_t)2048 * 2048 * 2);
constexpr size_t WS_WTOUT = WS_WTIN + al256((size_t)3840 * 2048 * 2);
constexpr size_t WS_WTGU = WS_WTOUT + al256((size_t)2048 * 2048 * 2);
constexpr size_t WS_WTDN = WS_WTGU + al256((size_t)NE * 4096 * 2048 * 2);
constexpr size_t WS_PROJ16 = WS_WTDN + al256((size_t)NE * 2048 * 2048 * 2);
constexpr size_t WS_KVMEM16 = WS_PROJ16 + al256((size_t)(T_ + 64) * INW * 2);
constexpr size_t WS_WT1 = WS_KVMEM16 + al256((size_t)2048 * 1024 * 2);
constexpr size_t WS_UV = WS_WT1 + al256((size_t)2 * 512 * 2048 * 2);
constexpr size_t WS_KC16 = WS_UV + al256((size_t)2 * 4 * 2048 * 512 * 4);
constexpr size_t WS_VC16 = WS_KC16 + al256((size_t)B_ * 128 * 256 * 2);
constexpr size_t WS_WR16 = WS_VC16 + al256((size_t)B_ * 128 * 256 * 2);
constexpr size_t WS_Q8GU = WS_WR16 + al256((size_t)32 * 2048 * 2);
constexpr size_t WS_Q8DN = WS_Q8GU + al256((size_t)NE * 4096 * 2048);
constexpr size_t WS_SGU = WS_Q8DN + al256((size_t)NE * 2048 * 2048);
constexpr size_t WS_SDN = WS_SGU + al256((size_t)NE * 4096 * 4);
constexpr size_t WS_H8 = WS_SDN + al256((size_t)NE * 2048 * 4);
constexpr size_t WS_SAH = WS_H8 + al256((size_t)T_ * 2048);
constexpr size_t WS_ACT8 = WS_SAH + al256((size_t)T_ * 4);
constexpr size_t WS_SACT = WS_ACT8 + al256((size_t)(NA + 256) * 2048);
constexpr size_t WS_WTMKV = WS_SACT + al256((size_t)(NA + 256) * 4);
constexpr size_t WS_Q8OUT = WS_WTMKV + al256((size_t)1024 * 2048 * 2);
constexpr size_t WS_SOUT = WS_Q8OUT + al256((size_t)2048 * 2048);
constexpr size_t WS_CAT8 = WS_SOUT + al256(2048 * 4);
constexpr size_t WS_SCAT = WS_CAT8 + al256((size_t)T_ * 2048);
constexpr size_t WS_SA2 = WS_SCAT + al256((size_t)T_ * 4);
constexpr size_t WS_GATE2 = WS_SA2 + al256((size_t)NE * T_ * 4);
constexpr size_t WS_X8 = WS_GATE2 + al256((size_t)NE * T_ * 4);
constexpr size_t WS_SXA = WS_X8 + al256((size_t)(T_ + 2048) * 2048);
constexpr size_t WS_Q8IN = WS_SXA + al256((size_t)(T_ + 2048) * 4);
constexpr size_t WS_SIN8 = WS_Q8IN + al256((size_t)2560 * 2048);
constexpr size_t WS_Q8MKV = WS_SIN8 + al256(2560 * 4);
constexpr size_t WS_SMKV = WS_Q8MKV + al256((size_t)1024 * 2048);
constexpr size_t WS_WT2 = WS_SMKV + al256(1024 * 4);
constexpr size_t WS_KV16 = WS_WT2 + al256((size_t)2 * 128 * 256 * 2);
constexpr size_t KVSEG = (size_t)S_ * 128;
constexpr size_t WS_END = WS_KV16 + al256((size_t)6 * B_ * 2 * S_ * 128 * 2);

constexpr int LDS_BYTES = 159744;

struct Params {
    const float* in[26];
    float* out;
    unsigned char* ws;
    long long lo_hi;
};
enum { I_X = 0, I_MEM, I_WIN, I_POSK, I_W1K, I_W2K, I_POSV, I_W1V, I_W2V, I_POOLW, I_POOLS, I_WMEMKV, I_GNNSA, I_GNPOOL, I_GNMEM, I_WOUT,
       I_LN1G, I_LN1B, I_WR, I_BR, I_WGU, I_BGU, I_WDN, I_BDN, I_LN2G, I_LN2B };

#define XB_TMO      128
#define XB_XCNT(j)  (256  + 64 * (j))
#define XB_XSUB(j)  (1280 + 64 * (j))
#define XB_XGEN(j)  (2304 + 64 * (j))
#define XB_TOP      3328
#define XB_TOPGEN   3392
#define XCD_BAR_WORDS 3456
#define XB_SPIN_CAP (1u << 25)
#define LAS __attribute__((address_space(3)))

__device__ __forceinline__ unsigned xb_ld(unsigned* p)              { return __hip_atomic_load(p, __ATOMIC_RELAXED, __HIP_MEMORY_SCOPE_AGENT); }
__device__ __forceinline__ unsigned xb_add(unsigned* p, unsigned v) { return __hip_atomic_fetch_add(p, v, __ATOMIC_RELAXED, __HIP_MEMORY_SCOPE_AGENT); }
__device__ __forceinline__ unsigned xb_xcc_id() { return (unsigned)__builtin_amdgcn_s_getreg((3 << 11) | 20) & 0xFu; }
#define XB_SPIN(cond, bar) do { unsigned _sp = 0; while (cond) { __builtin_amdgcn_s_sleep(1); \
    if ((++_sp & 255u) == 0u) { if (xb_ld(&(bar)[XB_TMO])) break; if (_sp > XB_SPIN_CAP) { atomicAdd(&(bar)[XB_TMO], 1u); break; } } } } while (0)

struct XcdBarrier { unsigned* bar; unsigned x; volatile LAS unsigned* st; };

__device__ __forceinline__ XcdBarrier xcd_barrier_post(unsigned* bar, volatile LAS unsigned* st) {
    XcdBarrier b; b.bar = bar; b.x = xb_xcc_id(); b.st = st;
    if (threadIdx.x == 0) (void)xb_add(&bar[XB_XCNT(b.x)], 1u);
    return b;
}
__device__ __forceinline__ void xcd_barrier_complete(unsigned* bar, unsigned x, unsigned& nloc, unsigned& nx) {
    const unsigned G = gridDim.x * gridDim.y * gridDim.z;
    unsigned sum, cnt, mine, sp = 0u;
    for (;;) {
        sum = 0u; cnt = 0u; mine = 0u;
#pragma unroll
        for (unsigned j = 0; j < 16; ++j) { const unsigned c = xb_ld(&bar[XB_XCNT(j)]); sum += c; cnt += (c > 0u) ? 1u : 0u; mine = (j == x) ? c : mine; }
        if (sum == G) break;
        __builtin_amdgcn_s_sleep(1);
        if ((++sp & 255u) == 0u) { if (xb_ld(&bar[XB_TMO])) break; if (sp > XB_SPIN_CAP) { atomicAdd(&bar[XB_TMO], 1u); break; } }
    }
    nloc = mine > 0u ? mine : 1u; nx = cnt > 0u ? cnt : 1u;
}
__device__ __forceinline__ void xcd_barrier(const XcdBarrier& b) {
    asm volatile("s_waitcnt vmcnt(0)" ::: "memory");
    __syncthreads();
    if (threadIdx.x == 0) {
        unsigned* bar = b.bar;
        __builtin_amdgcn_s_waitcnt(0);
        unsigned nloc = b.st[0], nx = b.st[1];
        if (nloc == 0u) { xcd_barrier_complete(bar, b.x, nloc, nx); b.st[0] = nloc; b.st[1] = nx; }
        const unsigned old = xb_add(&bar[XB_XSUB(b.x)], 1u);
        const unsigned gen = old / nloc;
        if (old + 1u == (gen + 1u) * nloc) {
            __builtin_amdgcn_fence(__ATOMIC_RELEASE, "agent");
            asm volatile("s_waitcnt vmcnt(0)" ::: "memory");
            const unsigned og = xb_add(&bar[XB_TOP], 1u);
            const unsigned tg = og / nx;
            if (og + 1u == (tg + 1u) * nx) xb_add(&bar[XB_TOPGEN], 1u);
            else XB_SPIN(xb_ld(&bar[XB_TOPGEN]) == tg, bar);
            __builtin_amdgcn_fence(__ATOMIC_ACQUIRE, "agent");
            xb_add(&bar[XB_XGEN(b.x)], 1u);
            asm volatile("s_waitcnt vmcnt(0)" ::: "memory");
        } else {
            XB_SPIN(xb_ld(&bar[XB_XGEN(b.x)]) == gen, bar);
            __builtin_amdgcn_fence(__ATOMIC_ACQUIRE, "agent");
            asm volatile("s_waitcnt vmcnt(0)" ::: "memory");
        }
    }
    __syncthreads();
}

typedef _Float16 h8 __attribute__((ext_vector_type(8)));
typedef _Float16 h4 __attribute__((ext_vector_type(4)));
typedef float f4 __attribute__((ext_vector_type(4)));

__device__ __forceinline__ float wave_sum(float v) {
#pragma unroll
    for (int o = 32; o > 0; o >>= 1) v += __shfl_xor(v, o);
    return v;
}
__device__ __forceinline__ float wave_max(float v) {
#pragma unroll
    for (int o = 32; o > 0; o >>= 1) v = fmaxf(v, __shfl_xor(v, o));
    return v;
}
__device__ __forceinline__ void wave_sync() {
    asm volatile("s_waitcnt lgkmcnt(0)" ::: "memory");
    __builtin_amdgcn_wave_barrier();
}
__device__ __forceinline__ float gelu_tanh(float x) {
    const float u = 0.7978845608028654f * (x + 0.044715f * x * x * x);
    return 0.5f * x * (1.f + tanhf(u));
}
__device__ __forceinline__ float gelu_fast(float x) { const float u = 0.7978845608028654f * (x + 0.044715f * x * x * x); const float t = 1.f - 2.f * __builtin_amdgcn_rcpf(1.f + __builtin_amdgcn_exp2f(2.8853900817779268f * u)); return 0.5f * x * (1.f + t); }
__device__ __forceinline__ float sigmoidf_(float x) { return 1.f / (1.f + expf(-x)); }
__device__ __forceinline__ unsigned pk4_fp8(float a, float b, float c, float d) { int w = 0; w = __builtin_amdgcn_cvt_pk_fp8_f32(a, b, w, false); w = __builtin_amdgcn_cvt_pk_fp8_f32(c, d, w, true); return (unsigned)w; }
__device__ __forceinline__ void dec4_fp8(unsigned w, float& a, float& b, float& c, float& d) { a = __builtin_amdgcn_cvt_f32_fp8((int)w, 0); b = __builtin_amdgcn_cvt_f32_fp8((int)w, 1); c = __builtin_amdgcn_cvt_f32_fp8((int)w, 2); d = __builtin_amdgcn_cvt_f32_fp8((int)w, 3); }
__device__ __forceinline__ float swiglu_fast(float g, float l) { const float xg = fminf(g, 7.f), xl = fminf(fmaxf(l, -7.f), 7.f); return xg * __builtin_amdgcn_rcpf(1.f + __builtin_amdgcn_exp2f(-2.4554669595930156f * xg)) * (xl + 1.f); }

constexpr int G_LD = 40;
template <class AF, class EF>
__device__ __forceinline__ void gemm_tile(char* smem, int K, const AF& af, const float* __restrict__ Bm, int ldb, int n0, int Nlim, bool perm, const EF& ef) {
    _Float16* As = (_Float16*)smem;
    _Float16* Bs = As + 128 * G_LD;
    const int tid = threadIdx.x, lane = tid & 63, wid = tid >> 6, wr = wid >> 2, wc = wid & 3, fr = lane & 15, fq = lane >> 4;
    f4 acc[4][2];
#pragma unroll
    for (int m = 0; m < 4; ++m)
#pragma unroll
        for (int n = 0; n < 2; ++n) acc[m][n] = (f4){0.f, 0.f, 0.f, 0.f};
    const int ar = tid >> 3, ak = (tid & 7) * 4;
    const float* ap0 = af.row(ar);
    const float* ap1 = af.row(ar + 64);
    const int bk = tid >> 5, bn = (tid & 31) * 4;
    const bool bok = (n0 + bn) < Nlim;
    int bnp[4];
#pragma unroll
    for (int i = 0; i < 4; ++i) { const int c = bn + i; bnp[i] = perm ? ((c & ~31) | ((c & 1) << 4) | ((c & 31) >> 1)) : c; }
    for (int k0 = 0; k0 < K; k0 += 32) {
        const int ko = af.koff(k0 + ak);
        float4 a0 = make_float4(0.f, 0.f, 0.f, 0.f), a1 = a0, b0 = a0, b1 = a0;
        if (ap0) a0 = *(const float4*)(ap0 + ko);
        if (ap1) a1 = *(const float4*)(ap1 + ko);
        if (bok) { b0 = *(const float4*)(Bm + (size_t)(k0 + bk) * ldb + n0 + bn); b1 = *(const float4*)(Bm + (size_t)(k0 + bk + 16) * ldb + n0 + bn); }
        __syncthreads();
        *(h4*)&As[ar * G_LD + ak] = (h4){(_Float16)a0.x, (_Float16)a0.y, (_Float16)a0.z, (_Float16)a0.w};
        *(h4*)&As[(ar + 64) * G_LD + ak] = (h4){(_Float16)a1.x, (_Float16)a1.y, (_Float16)a1.z, (_Float16)a1.w};
        Bs[bnp[0] * G_LD + bk] = (_Float16)b0.x; Bs[bnp[1] * G_LD + bk] = (_Float16)b0.y; Bs[bnp[2] * G_LD + bk] = (_Float16)b0.z; Bs[bnp[3] * G_LD + bk] = (_Float16)b0.w;
        Bs[bnp[0] * G_LD + bk + 16] = (_Float16)b1.x; Bs[bnp[1] * G_LD + bk + 16] = (_Float16)b1.y; Bs[bnp[2] * G_LD + bk + 16] = (_Float16)b1.z; Bs[bnp[3] * G_LD + bk + 16] = (_Float16)b1.w;
        __syncthreads();
        h8 a[4], b[2];
#pragma unroll
        for (int m = 0; m < 4; ++m) a[m] = *(const h8*)&As[(wr * 64 + m * 16 + fr) * G_LD + fq * 8];
#pragma unroll
        for (int n = 0; n < 2; ++n) b[n] = *(const h8*)&Bs[(wc * 32 + n * 16 + fr) * G_LD + fq * 8];
#pragma unroll
        for (int m = 0; m < 4; ++m)
#pragma unroll
            for (int n = 0; n < 2; ++n) acc[m][n] = __builtin_amdgcn_mfma_f32_16x16x32_f16(a[m], b[n], acc[m][n], 0, 0, 0);
    }
    ef(acc, wr, wc, fr, fq);
    __syncthreads();
}

struct ARowPlain { const float* base; int ld; int m0; int mlim;
    __device__ __forceinline__ const float* row(int r) const { return (m0 + r) < mlim ? base + (size_t)(m0 + r) * ld : nullptr; }
    __device__ __forceinline__ int koff(int k) const { return k; } };
struct ARowCmp { const float* proj; int col; int m0;
    __device__ __forceinline__ const float* row(int r) const { const int g = m0 + r; if (g >= CROWS) return nullptr; const int kvh = g & 1, bc = g >> 1, b = bc / NC, c = bc % NC;
        return proj + (size_t)(b * S_ + 16 * c) * INW + col + kvh * 128; }
    __device__ __forceinline__ int koff(int k) const { return (k >> 7) * INW + (k & 127); } };
struct ARowList { const float* base; const int* list; int m0; int cnt; int shift;
    __device__ __forceinline__ const float* row(int r) const { if (m0 + r >= cnt) return nullptr; const int a = list[m0 + r]; return base + (size_t)(a >> shift) * 2048; }
    __device__ __forceinline__ int koff(int k) const { return k; } };

struct EpiStore { float* C; int ldc; int m0; int n0; int mlim; int nlim; _Float16* C16;
    __device__ __forceinline__ void operator()(const f4 (&acc)[4][2], int wr, int wc, int fr, int fq) const {
#pragma unroll
        for (int m = 0; m < 4; ++m)
#pragma unroll
            for (int n = 0; n < 2; ++n)
#pragma unroll
                for (int j = 0; j < 4; ++j) { const int r = m0 + wr * 64 + m * 16 + fq * 4 + j, c = n0 + wc * 32 + n * 16 + fr;
                    if (r < mlim && c < nlim) { C[(size_t)r * ldc + c] = acc[m][n][j]; if (C16) C16[(size_t)r * ldc + c] = (_Float16)acc[m][n][j]; } } } };
struct EpiKc { _Float16* C; int m0;
    __device__ __forceinline__ void operator()(const f4 (&acc)[4][2], int wr, int wc, int fr, int fq) const {
#pragma unroll
        for (int m = 0; m < 4; ++m)
#pragma unroll
            for (int n = 0; n < 2; ++n)
#pragma unroll
                for (int j = 0; j < 4; ++j) { const int r = m0 + wr * 64 + m * 16 + fq * 4 + j, c = wc * 32 + n * 16 + fr;
                    C[(size_t)r * 128 + c] = (((r >> 1) & 127) == 127) ? (_Float16)0.f : (_Float16)acc[m][n][j]; } } };
struct EpiPool { _Float16* C; const float* scale; int m0; int g;
    __device__ __forceinline__ void operator()(const f4 (&acc)[4][2], int wr, int wc, int fr, int fq) const {
#pragma unroll
        for (int m = 0; m < 4; ++m)
#pragma unroll
            for (int n = 0; n < 2; ++n)
#pragma unroll
                for (int j = 0; j < 4; ++j) { const int r = m0 + wr * 64 + m * 16 + fq * 4 + j, c = g * 128 + wc * 32 + n * 16 + fr;
                    C[(size_t)r * 512 + c] = (_Float16)(acc[m][n][j] * scale[c]); } } };
struct EpiHid { float* C; const float* bias; int m0; int n0;
    __device__ __forceinline__ void operator()(const f4 (&acc)[4][2], int wr, int wc, int fr, int fq) const {
#pragma unroll
        for (int m = 0; m < 4; ++m)
#pragma unroll
            for (int n = 0; n < 2; ++n)
#pragma unroll
                for (int j = 0; j < 4; ++j) { const int r = m0 + wr * 64 + m * 16 + fq * 4 + j, c = n0 + wc * 32 + n * 16 + fr;
                    if (r < CROWS) C[(size_t)r * 256 + c] = gelu_tanh(acc[m][n][j] + bias[c]); } } };
struct EpiOut { float* C; const float* x; int m0; int n0;
    __device__ __forceinline__ void operator()(const f4 (&acc)[4][2], int wr, int wc, int fr, int fq) const {
#pragma unroll
        for (int m = 0; m < 4; ++m)
#pragma unroll
            for (int n = 0; n < 2; ++n)
#pragma unroll
                for (int j = 0; j < 4; ++j) { const size_t o = (size_t)(m0 + wr * 64 + m * 16 + fq * 4 + j) * 2048 + n0 + wc * 32 + n * 16 + fr;
                    C[o] = DN_ALPHA * x[o] + acc[m][n][j]; } } };
struct EpiGu { float* act; const float* bgu; const int* list; int m0; int cnt; int n0;
    __device__ __forceinline__ void operator()(const f4 (&acc)[4][2], int wr, int wc, int fr, int fq) const {
        const int jc = (n0 + wc * 32) / 2 + fr;
        const float bg = bgu[2 * jc], bl = bgu[2 * jc + 1];
#pragma unroll
        for (int m = 0; m < 4; ++m)
#pragma unroll
            for (int j = 0; j < 4; ++j) { const int r = m0 + wr * 64 + m * 16 + fq * 4 + j;
                if (r < cnt) { const int a = list[r];
                    const float xg = fminf(acc[m][0][j] + bg, 7.f), xl = fminf(fmaxf(acc[m][1][j] + bl, -7.f), 7.f);
                    act[(size_t)a * 2048 + jc] = xg * sigmoidf_(1.702f * xg) * (xl + 1.f); } } } };
struct EpiDn { float* y; const float* bdn; const int* list; const float* gate; int m0; int cnt; int n0;
    __device__ __forceinline__ void operator()(const f4 (&acc)[4][2], int wr, int wc, int fr, int fq) const {
#pragma unroll
        for (int m = 0; m < 4; ++m)
#pragma unroll
            for (int j = 0; j < 4; ++j) { const int r = m0 + wr * 64 + m * 16 + fq * 4 + j;
                if (r < cnt) { const int a = list[r]; const float g = gate[a];
#pragma unroll
                    for (int n = 0; n < 2; ++n) { const int c = n0 + wc * 32 + n * 16 + fr; y[(size_t)a * 2048 + c] = (acc[m][n][j] + bdn[c]) * g; } } } } };

constexpr int WLDS_FLOATS = 4096 + 512 + 32;
template <bool SHARED>
__device__ __forceinline__ void wave_attn(float* sw, const float* __restrict__ qptr, const float* __restrict__ Kb, const float* __restrict__ Vb, int ld, int nseg, float scale, float* __restrict__ optr) {
    const int lane = threadIdx.x & 63;
    float* sq = sw + 4096; const int* segs = (const int*)(sw + 4096 + 512);
#pragma unroll
    for (int i = 0; i < 8; ++i) sq[lane + 64 * i] = qptr[lane + 64 * i];
    wave_sync();
    for (int sg = 0; sg < nseg; ++sg) {
        const int start = segs[sg], len = segs[16 + sg];
        float d0 = 0.f, d1 = 0.f, d2 = 0.f, d3 = 0.f;
        if (lane < len) {
            const float* kp = Kb + (size_t)(start + lane) * ld;
            for (int d4 = 0; d4 < 32; ++d4) {
                if (SHARED) {
                    const float4 kv = *(const float4*)(kp + d4 * 4);
                    const float4 q0 = *(const float4*)(sq + d4 * 4), q1 = *(const float4*)(sq + 128 + d4 * 4), q2 = *(const float4*)(sq + 256 + d4 * 4), q3 = *(const float4*)(sq + 384 + d4 * 4);
                    d0 += kv.x * q0.x + kv.y * q0.y + kv.z * q0.z + kv.w * q0.w;
                    d1 += kv.x * q1.x + kv.y * q1.y + kv.z * q1.z + kv.w * q1.w;
                    d2 += kv.x * q2.x + kv.y * q2.y + kv.z * q2.z + kv.w * q2.w;
                    d3 += kv.x * q3.x + kv.y * q3.y + kv.z * q3.z + kv.w * q3.w;
                } else {
                    const float4 k0 = *(const float4*)(kp + d4 * 4), k1 = *(const float4*)(kp + 128 + d4 * 4), k2 = *(const float4*)(kp + 256 + d4 * 4), k3 = *(const float4*)(kp + 384 + d4 * 4);
                    const float4 q0 = *(const float4*)(sq + d4 * 4), q1 = *(const float4*)(sq + 128 + d4 * 4), q2 = *(const float4*)(sq + 256 + d4 * 4), q3 = *(const float4*)(sq + 384 + d4 * 4);
                    d0 += k0.x * q0.x + k0.y * q0.y + k0.z * q0.z + k0.w * q0.w;
                    d1 += k1.x * q1.x + k1.y * q1.y + k1.z * q1.z + k1.w * q1.w;
                    d2 += k2.x * q2.x + k2.y * q2.y + k2.z * q2.z + k2.w * q2.w;
                    d3 += k3.x * q3.x + k3.y * q3.y + k3.z * q3.z + k3.w * q3.w;
                }
            }
        }
        const bool ok = lane < len;
        sw[sg * 64 + lane] = ok ? d0 * scale : -1e30f;
        sw[1024 + sg * 64 + lane] = ok ? d1 * scale : -1e30f;
        sw[2048 + sg * 64 + lane] = ok ? d2 * scale : -1e30f;
        sw[3072 + sg * 64 + lane] = ok ? d3 * scale : -1e30f;
    }
    wave_sync();
    const int n = nseg * 64;
#pragma unroll
    for (int g = 0; g < 4; ++g) {
        float mx = -1e30f;
        for (int i = lane; i < n; i += 64) mx = fmaxf(mx, sw[g * 1024 + i]);
        mx = wave_max(mx);
        float sm = 0.f;
        for (int i = lane; i < n; i += 64) { const float v = sw[g * 1024 + i]; sm += (v > -1e29f) ? expf(v - mx) : 0.f; }
        sm = wave_sum(sm);
        const float inv = sm > 0.f ? 1.f / sm : 0.f;
        for (int i = lane; i < n; i += 64) { const float v = sw[g * 1024 + i]; sw[g * 1024 + i] = (v > -1e29f) ? expf(v - mx) * inv : 0.f; }
    }
    wave_sync();
    float o[4][2];
#pragma unroll
    for (int g = 0; g < 4; ++g) { o[g][0] = 0.f; o[g][1] = 0.f; }
    for (int sg = 0; sg < nseg; ++sg) {
        const int start = segs[sg], len = segs[16 + sg];
        for (int l = 0; l < len; ++l) {
            const float* vp = Vb + (size_t)(start + l) * ld;
            if (SHARED) {
                const float v0 = vp[lane], v1 = vp[lane + 64];
#pragma unroll
                for (int g = 0; g < 4; ++g) { const float p = sw[g * 1024 + sg * 64 + l]; o[g][0] += p * v0; o[g][1] += p * v1; }
            } else {
#pragma unroll
                for (int g = 0; g < 4; ++g) { const float p = sw[g * 1024 + sg * 64 + l]; o[g][0] += p * vp[g * 128 + lane]; o[g][1] += p * vp[g * 128 + lane + 64]; }
            }
        }
    }
#pragma unroll
    for (int g = 0; g < 4; ++g) { optr[g * 128 + lane] = o[g][0]; optr[g * 128 + lane + 64] = o[g][1]; }
}

namespace g8 {
constexpr int BM = 256, BK = 64, HALF = 128, HTB = HALF * BK * 2, STAGE_BYTES = 8 * HTB;
constexpr int KK = 2048;
typedef float f32x4 __attribute__((ext_vector_type(4)));
__device__ __forceinline__ int lds_byte(int r, int c) { return r * 128 + ((((c >> 3) ^ (r >> 1)) & 7) << 4) + (c & 7) * 2; }
__device__ __forceinline__ void stage_rc(int b, int& R, int& C) { R = b >> 7; C = ((((b >> 4) ^ (R >> 1)) & 7)) * 8; }
__device__ __forceinline__ int perm32(int rho) { const int n = rho >> 4, i = rho & 15; return 8 * (i >> 2) + 4 * n + (i & 3); }

typedef int i32x4 __attribute__((ext_vector_type(4)));
typedef unsigned u32x2 __attribute__((ext_vector_type(2)));
typedef unsigned u32x4 __attribute__((ext_vector_type(4)));
template <bool I8> struct AccSel { typedef f32x4 T; };
template <> struct AccSel<true> { typedef i32x4 T; };
__device__ __forceinline__ f32x4 mma16(i32x4 a, i32x4 b, f32x4 c) { return __builtin_amdgcn_mfma_f32_16x16x32_f16(*reinterpret_cast<h8*>(&a), *reinterpret_cast<h8*>(&b), c, 0, 0, 0); }
__device__ __forceinline__ i32x4 mma16(i32x4 a, i32x4 b, i32x4 c) { return __builtin_amdgcn_mfma_i32_16x16x64_i8(a, b, c, 0, 0, 0); }
struct Unit { int m0, n0, e, cnt, rbase; };
constexpr int EP_OFF = STAGE_BYTES + 2048, EP_LD = 528, EP_GRP = 16 * EP_LD;
constexpr int CONST_OFF = EP_OFF + 18432;
__device__ __forceinline__ void cdma(LAS unsigned char* lds, int region, int idx, const void* src) { __builtin_amdgcn_global_load_lds((const unsigned*)src, (LAS unsigned*)(lds + CONST_OFF + region * 1024 + idx * 256), 4, 0, 0); }
__device__ __forceinline__ void ep_sync() { asm volatile("s_waitcnt lgkmcnt(0)" ::: "memory"); __builtin_amdgcn_s_barrier(); asm volatile("" ::: "memory"); }
__device__ __forceinline__ int ep_tid() { int tz = threadIdx.x; asm volatile("" : "+v"(tz)); return tz; }
__device__ __forceinline__ h8 cvt8(f32x4 a, f32x4 b) { h8 o; o[0] = (_Float16)a[0]; o[1] = (_Float16)a[1]; o[2] = (_Float16)a[2]; o[3] = (_Float16)a[3]; o[4] = (_Float16)b[0]; o[5] = (_Float16)b[1]; o[6] = (_Float16)b[2]; o[7] = (_Float16)b[3]; return o; }

__device__ __forceinline__ void tile_order(int L, int nM, int nN, int& pm, int& pn) {
    const int nwg = nM * nN; int wgid = L;
    { const int q = nwg / 8, r = nwg % 8, xcd = wgid % 8, off = wgid / 8; wgid = (xcd < r ? xcd * (q + 1) : r * (q + 1) + (xcd - r) * q) + off; }
    const int nig = 8 * nN, gid = wgid / nig, fm = gid * 8, gsz = (nM - fm) < 8 ? (nM - fm) : 8;
    pm = fm + ((wgid % nig) % gsz); pn = (wgid % nig) / gsz;
}

template <class Prob>
__device__ __forceinline__ void gemm_phase(LAS unsigned char* lds, const Prob& P) {
    int tidh_ = threadIdx.x; asm volatile("" : "+v"(tidh_));
    const int tid = tidh_, wid = __builtin_amdgcn_readfirstlane(tid >> 6), lane = tid & 63, wr = wid >> 2, wc = wid & 3, fr = lane & 15, fq = lane >> 4;
    constexpr int nt = Prob::NT; constexpr size_t KS2 = Prob::KS2; constexpr unsigned ROWB = Prob::ROWB; constexpr bool I8 = Prob::I8;
    int sR[2], sC2[2]; unsigned voffB[2];
#pragma unroll
    for (int i = 0; i < 2; ++i) { int R, C; stage_rc(tid * 16 + i * 8192, R, C); sR[i] = R; sC2[i] = C * 2; const int Rb = Prob::PERM ? ((R & ~31) + perm32(R & 31)) : R; voffB[i] = (unsigned)Rb * ROWB + (unsigned)C * 2u; }
    const size_t kstep = (size_t)(BK * 2);
    const size_t hstep = (size_t)HALF * ROWB;
    const unsigned ldsw = (unsigned)wid * 1024u;
    const int aoff = lds_byte(wr * 64 + fr, fq * 8), boff = lds_byte(wc * 32 + fr, fq * 8), aoff1 = lds_byte(wr * 64 + fr, fq * 8 + 32), boff1 = lds_byte(wc * 32 + fr, fq * 8 + 32);
#define G8_SA(b, h) (((b) * 2 + (h)) * HTB)
#define G8_SB(b, h) ((4 + (b) * 2 + (h)) * HTB)
#define G8_STAGE(bufoff, gbase, voff) do { _Pragma("unroll") for (int _i = 0; _i < 2; ++_i) \
        __builtin_amdgcn_global_load_lds((const unsigned*)((const char*)(gbase) + (voff)[_i]), (LAS unsigned*)(lds + (bufoff) + ldsw + _i * 8192), 16, 0, 0); } while (0)
#define G8_LDA(dst, b, h) do { _Pragma("unroll") for (int m = 0; m < 4; ++m) _Pragma("unroll") for (int k = 0; k < 2; ++k) dst[m][k] = *(const LAS i32x4*)(lds + G8_SA(b, h) + (k ? aoff1 : aoff) + m * 2048); } while (0)
#define G8_LDB(dst, b, h) do { _Pragma("unroll") for (int n = 0; n < 2; ++n) _Pragma("unroll") for (int k = 0; k < 2; ++k) dst[n][k] = *(const LAS i32x4*)(lds + G8_SB(b, h) + (k ? boff1 : boff) + n * 2048); } while (0)
#define G8_MMA(ai, bj, At, Bt) do { __builtin_amdgcn_s_setprio(1); _Pragma("unroll") for (int m = 0; m < 4; ++m) _Pragma("unroll") for (int n = 0; n < 2; ++n) _Pragma("unroll") for (int k = 0; k < 2; ++k) \
        acc[ai][bj][m][n] = mma16(Bt[n][k], At[m][k], acc[ai][bj][m][n]); __builtin_amdgcn_s_setprio(0); } while (0)
#define G8_WAIT_V(n) asm volatile("s_waitcnt vmcnt(" #n ")" ::: "memory")
#define G8_WAIT_L(n) asm volatile("s_waitcnt lgkmcnt(" #n ")" ::: "memory")
#define G8_BAR __builtin_amdgcn_s_barrier()
#define G8_SCHED __builtin_amdgcn_sched_barrier(0)
    Unit cur, nxt; int ui = 0;
    if (!P.next(0, cur)) return;
    typedef typename AccSel<I8>::T AccT;
    AccT acc[2][2][4][2];
#pragma unroll
    for (int a = 0; a < 2; ++a)
#pragma unroll
        for (int b = 0; b < 2; ++b)
#pragma unroll
            for (int m = 0; m < 4; ++m)
#pragma unroll
                for (int n = 0; n < 2; ++n) acc[a][b][m][n] = AccT{};
    i32x4 At[4][2], B0[2][2], B1[2][2];
    unsigned vc[2][2], vn[2][2];
    P.a_offs(cur, sR, sC2, vc);
    const char* const Ab = P.a_base();
    const char* cB = P.b_base(cur);
    G8_STAGE(G8_SB(0, 0), cB, voffB); G8_STAGE(G8_SA(0, 0), Ab, vc[0]); G8_STAGE(G8_SB(0, 1), cB + hstep, voffB); G8_STAGE(G8_SA(0, 1), Ab, vc[1]);
    if (wr == 1) G8_BAR;
    G8_WAIT_V(4); G8_BAR;
    G8_STAGE(G8_SB(1, 0), cB + kstep, voffB); G8_STAGE(G8_SA(1, 0), Ab + kstep, vc[0]); G8_STAGE(G8_SB(1, 1), cB + hstep + kstep, voffB);
    G8_WAIT_V(6); G8_BAR;
    for (;;) {
        const bool has_next = P.next(ui + 1, nxt);
        const char* nB = cB;
        if (has_next) { P.a_offs(nxt, sR, sC2, vn); nB = P.b_base(nxt); }
        else { vn[0][0] = vc[0][0]; vn[0][1] = vc[0][1]; vn[1][0] = vc[1][0]; vn[1][1] = vc[1][1]; }
        for (int t = 0; t < nt; t += 2) {
            const bool last = (t == nt - 2);
            if constexpr (Prob::CD) { if (last) P.const_dma(cur, lds, wid, lane); }
            const char* a1 = Ab + (size_t)(t >> 1) * KS2 + kstep;
            const char* a2 = last ? Ab : Ab + (size_t)((t + 2) >> 1) * KS2; const char* b2 = last ? nB : cB + (size_t)(t + 2) * kstep;
            const char* a3 = a2 + kstep; const char* b3 = b2 + kstep;
            unsigned o2[2][2];
            o2[0][0] = last ? vn[0][0] : vc[0][0]; o2[0][1] = last ? vn[0][1] : vc[0][1]; o2[1][0] = last ? vn[1][0] : vc[1][0]; o2[1][1] = last ? vn[1][1] : vc[1][1];
            G8_LDB(B0, 0, 0); G8_SCHED; G8_LDA(At, 0, 0); G8_STAGE(G8_SA(1, 1), a1, vc[1]);
            G8_WAIT_L(8); G8_BAR; G8_WAIT_L(0); G8_MMA(0, 0, At, B0); G8_BAR; G8_SCHED;
            G8_LDB(B1, 0, 1); G8_STAGE(G8_SB(0, 0), b2, voffB);
            G8_BAR; G8_WAIT_L(0); G8_MMA(0, 1, At, B1); G8_BAR;
            G8_LDA(At, 0, 1); G8_STAGE(G8_SA(0, 0), a2, o2[0]);
            G8_BAR; G8_WAIT_L(0); G8_MMA(1, 0, At, B0); G8_BAR; G8_SCHED;
            G8_STAGE(G8_SB(0, 1), b2 + hstep, voffB);
            G8_WAIT_V(6); G8_BAR; G8_MMA(1, 1, At, B1); G8_BAR;
            G8_LDB(B0, 1, 0); G8_SCHED; G8_LDA(At, 1, 0); G8_STAGE(G8_SA(0, 1), a2, o2[1]);
            G8_WAIT_L(8); G8_BAR; G8_WAIT_L(0); G8_MMA(0, 0, At, B0); G8_BAR; G8_SCHED;
            G8_LDB(B1, 1, 1); G8_STAGE(G8_SB(1, 0), b3, voffB);
            G8_BAR; G8_WAIT_L(0); G8_MMA(0, 1, At, B1); G8_BAR;
            G8_LDA(At, 1, 1); G8_STAGE(G8_SA(1, 0), a3, o2[0]);
            G8_BAR; G8_WAIT_L(0); G8_MMA(1, 0, At, B0); G8_BAR; G8_SCHED;
            G8_STAGE(G8_SB(1, 1), b3 + hstep, voffB);
            G8_WAIT_V(6); G8_BAR; G8_MMA(1, 1, At, B1); G8_BAR;
        }
        P.epi(acc, cur, wr, wc, fr, fq, lds);
        if (!has_next) break;
#pragma unroll
        for (int a = 0; a < 2; ++a)
#pragma unroll
            for (int b = 0; b < 2; ++b)
#pragma unroll
                for (int m = 0; m < 4; ++m)
#pragma unroll
                    for (int n = 0; n < 2; ++n) acc[a][b][m][n] = AccT{};
        cur = nxt; cB = nB; ++ui;
        vc[0][0] = vn[0][0]; vc[0][1] = vn[0][1]; vc[1][0] = vn[1][0]; vc[1][1] = vn[1][1];
    }
    G8_WAIT_V(0);
    if (wr == 0) G8_BAR;
    G8_BAR;
#undef G8_SA
#undef G8_SB
#undef G8_STAGE
#undef G8_LDA
#undef G8_LDB
#undef G8_MMA
#undef G8_WAIT_V
#undef G8_WAIT_L
#undef G8_BAR
#undef G8_SCHED
}

struct ProbInF {
    static constexpr bool CD = false;
    static constexpr unsigned ROWB = 4096; static constexpr bool I8 = false;
    static constexpr int NT = 32; static constexpr size_t KS2 = 256;
    static constexpr bool PERM = true;
    const _Float16* A; _Float16* C16; int G, c;
    __device__ __forceinline__ bool next(int i, Unit& u) const { const int L = i * G + c; if (L >= 64 * 5) return false;
        int pm, pn; tile_order(L, 64, 5, pm, pn); u.m0 = pm * 256; u.n0 = pn * 256; u.e = 0; u.cnt = 256; u.rbase = 0; return true; }
    __device__ __forceinline__ void a_offs(const Unit& u, const int (&R)[2], const int (&C2)[2], unsigned (&v)[2][2]) const {
#pragma unroll
        for (int h = 0; h < 2; ++h)
#pragma unroll
            for (int i = 0; i < 2; ++i) v[h][i] = (unsigned)(u.m0 + h * 128 + R[i]) * (unsigned)(KK * 2) + (unsigned)C2[i]; }
    __device__ __forceinline__ const char* a_base() const { return (const char*)A; }
    __device__ __forceinline__ const char* b_base(const Unit& u) const { return (const char*)A + (long long)(WS_WTIN - WS_X16) + (size_t)u.n0 * KK * 2; }
    __device__ __forceinline__ void epi(const f32x4 (&acc)[2][2][4][2], const Unit& u, int wr, int wc, int fr, int fq, LAS unsigned char* lds) const {
        LAS unsigned char* ep = lds + EP_OFF + wr * EP_GRP;
        const int tg = ep_tid() & 255, rrow = tg >> 4, ch = tg & 15;
        const int kvseg = (u.e == 0 && u.n0 >= 1024 && u.n0 < 2560) ? ((u.n0 - 1024) >> 8) : -1;
        _Float16* const Cb = (_Float16*)((char*)C16 + (u.e ? (long long)(WS_KVMEM16 - WS_PROJ16) : 0ll)); const int ldc = u.e ? 1024 : INW, nlim = u.e ? 1024 : INW, mb = u.e ? u.m0 - T_ : u.m0;
#pragma unroll
        for (int ai = 0; ai < 2; ++ai)
#pragma unroll
            for (int m = 0; m < 4; ++m) {
#pragma unroll
                for (int bj = 0; bj < 2; ++bj) *(LAS h8*)(ep + fr * EP_LD + (bj * 128 + wc * 32 + fq * 8) * 2) = cvt8(acc[ai][bj][m][0], acc[ai][bj][m][1]);
                ep_sync();
                const h8 x0 = *(const LAS h8*)(ep + rrow * EP_LD + ch * 32), x1 = *(const LAS h8*)(ep + rrow * EP_LD + ch * 32 + 16);
                const int grow = mb + ai * 128 + wr * 64 + m * 16 + rrow, gcol = u.n0 + ch * 16;
                if (kvseg >= 0) {
                    _Float16* dst = (_Float16*)((char*)C16 + (long long)(WS_KV16 - WS_PROJ16)) + ((size_t)(kvseg * B_ + (grow >> 11)) * 2 + (ch >> 3)) * KVSEG + (size_t)(grow & (S_ - 1)) * 128 + (ch & 7) * 16;
                    *(h8*)dst = x0; *(h8*)(dst + 8) = x1;
                } else {
                    if (gcol < nlim) *(h8*)(Cb + (size_t)grow * ldc + gcol) = x0;
                    if (gcol + 8 < nlim) *(h8*)(Cb + (size_t)grow * ldc + gcol + 8) = x1; }
                ep_sync();
            } }
};
struct ProbIn8 {
    static constexpr bool CD = true;
    static constexpr unsigned ROWB = 2048; static constexpr bool I8 = true;
    static constexpr int NT = 16; static constexpr size_t KS2 = 256;
    static constexpr bool PERM = true;
    const signed char* A; _Float16* C16; const float* sa; int G, c;
    __device__ __forceinline__ bool next(int i, Unit& u) const { const int L = i * G + c; if (L >= 640 + 32) return false;
        if (L < 640) { int pm, pn; tile_order(L, 64, 10, pm, pn); u.m0 = pm * 256; u.n0 = 1280 + pn * 256; u.e = 0; }
        else { const int v = L - 640; u.m0 = T_ + (v & 7) * 256; u.n0 = (v >> 3) * 256; u.e = 1; }
        u.cnt = 256; u.rbase = 0; return true; }
    __device__ __forceinline__ void a_offs(const Unit& u, const int (&R)[2], const int (&C2)[2], unsigned (&v)[2][2]) const {
#pragma unroll
        for (int h = 0; h < 2; ++h)
#pragma unroll
            for (int i = 0; i < 2; ++i) v[h][i] = (unsigned)(u.m0 + h * 128 + R[i]) * 2048u + (unsigned)C2[i]; }
    __device__ __forceinline__ const char* a_base() const { return (const char*)A; }
    __device__ __forceinline__ const char* b_base(const Unit& u) const { return (const char*)A + (u.e ? (long long)(WS_Q8MKV - WS_X8) + (long long)u.n0 * 2048 : (long long)(WS_Q8IN - WS_X8) + (long long)(u.n0 - 1280) * 2048); }
    __device__ __forceinline__ void const_dma(const Unit& u, LAS unsigned char* lds, int wid, int lane) const {
        const int i4 = wid & 3;
        if (wid < 4) cdma(lds, 1, i4, (const float*)((const char*)A + (u.e ? (long long)(WS_SMKV - WS_X8) : (long long)(WS_SIN8 - WS_X8))) + (u.e ? u.n0 : u.n0 - 1280) + i4 * 64 + lane);
        else cdma(lds, 2, i4, sa + u.m0 + i4 * 64 + lane);
    }
    __device__ __forceinline__ void epi(const i32x4 (&acc)[2][2][4][2], const Unit& u, int wr, int wc, int fr, int fq, LAS unsigned char* lds) const {
        asm volatile("s_waitcnt vmcnt(16)" ::: "memory");
        ep_sync();
        LAS unsigned char* ep = lds + EP_OFF + wr * EP_GRP;
        const int tg = ep_tid() & 255, rrow = tg >> 4, ch = tg & 15;
        const int kvseg = (u.e == 0 && u.n0 >= 1024 && u.n0 < 2560) ? ((u.n0 - 1024) >> 8) : -1;
        _Float16* const Cb = (_Float16*)((char*)C16 + (u.e ? (long long)(WS_KVMEM16 - WS_PROJ16) : 0ll)); const int ldc = u.e ? 1024 : INW, nlim = u.e ? 1024 : INW, mb = u.e ? u.m0 - T_ : u.m0;
        const LAS float* cst = (const LAS float*)(lds + CONST_OFF);
        f32x4 s0[2], s1[2]; float srv[8];
#pragma unroll
        for (int bj = 0; bj < 2; ++bj) { const int col = bj * 128 + wc * 32 + fq * 8; s0[bj] = *(const LAS f32x4*)(cst + 256 + col); s1[bj] = *(const LAS f32x4*)(cst + 256 + col + 4); }
#pragma unroll
        for (int q = 0; q < 8; ++q) srv[q] = cst[512 + (q >> 2) * 128 + wr * 64 + (q & 3) * 16 + fr];
#pragma unroll
        for (int ai = 0; ai < 2; ++ai)
#pragma unroll
            for (int m = 0; m < 4; ++m) { const float sr = srv[ai * 4 + m];
#pragma unroll
                for (int bj = 0; bj < 2; ++bj) { const i32x4 i0 = acc[ai][bj][m][0], i1 = acc[ai][bj][m][1];
                    *(LAS h8*)(ep + fr * EP_LD + (bj * 128 + wc * 32 + fq * 8) * 2) = cvt8((f32x4){(float)i0[0], (float)i0[1], (float)i0[2], (float)i0[3]} * (s0[bj] * sr), (f32x4){(float)i1[0], (float)i1[1], (float)i1[2], (float)i1[3]} * (s1[bj] * sr)); }
                ep_sync();
                const h8 x0 = *(const LAS h8*)(ep + rrow * EP_LD + ch * 32), x1 = *(const LAS h8*)(ep + rrow * EP_LD + ch * 32 + 16);
                const int grow = mb + ai * 128 + wr * 64 + m * 16 + rrow, gcol = u.n0 + ch * 16;
                if (kvseg >= 0) {
                    _Float16* dst = (_Float16*)((char*)C16 + (long long)(WS_KV16 - WS_PROJ16)) + ((size_t)(kvseg * B_ + (grow >> 11)) * 2 + (ch >> 3)) * KVSEG + (size_t)(grow & (S_ - 1)) * 128 + (ch & 7) * 16;
                    *(h8*)dst = x0; *(h8*)(dst + 8) = x1;
                } else {
                    if (gcol < nlim) *(h8*)(Cb + (size_t)grow * ldc + gcol) = x0;
                    if (gcol + 8 < nlim) *(h8*)(Cb + (size_t)grow * ldc + gcol + 8) = x1; }
                ep_sync();
            } }
};
struct ProbOut {
    static constexpr bool CD = false;
    static constexpr unsigned ROWB = 2048; static constexpr bool I8 = true;
    static constexpr int NT = 16; static constexpr size_t KS2 = 256;
    static constexpr bool PERM = true;
    const signed char* A; const signed char* Bt; _Float16* C; const _Float16* X; const float* sa; const float* sw; int G, c;
    __device__ __forceinline__ bool next(int i, Unit& u) const { const int L = i * G + c; if (L >= 64 * 8) return false; int pm, pn; tile_order(L, 64, 8, pm, pn); u.m0 = pm * 256; u.n0 = pn * 256; u.e = 0; u.cnt = 256; u.rbase = 0; return true; }
    __device__ __forceinline__ void a_offs(const Unit& u, const int (&R)[2], const int (&C2)[2], unsigned (&v)[2][2]) const {
#pragma unroll
        for (int h = 0; h < 2; ++h)
#pragma unroll
            for (int i = 0; i < 2; ++i) v[h][i] = (unsigned)(u.m0 + h * 128 + R[i]) * 2048u + (unsigned)C2[i]; }
    __device__ __forceinline__ const char* a_base() const { return (const char*)A; }
    __device__ __forceinline__ const char* b_base(const Unit& u) const { return (const char*)(Bt + (size_t)u.n0 * 2048); }
    __device__ __forceinline__ void epi(const i32x4 (&acc)[2][2][4][2], const Unit& u, int wr, int wc, int fr, int fq, LAS unsigned char* lds) const {
        LAS unsigned char* ep = lds + EP_OFF + wr * EP_GRP;
        const int tg = ep_tid() & 255, rrow = tg >> 4, ch = tg & 15;
        f32x4 s0[2], s1[2]; float srv[8];
#pragma unroll
        for (int bj = 0; bj < 2; ++bj) { const int col = u.n0 + bj * 128 + wc * 32 + fq * 8; s0[bj] = *(const f32x4*)(sw + col); s1[bj] = *(const f32x4*)(sw + col + 4); }
#pragma unroll
        for (int q = 0; q < 8; ++q) srv[q] = sa[u.m0 + (q >> 2) * 128 + wr * 64 + (q & 3) * 16 + fr];
#pragma unroll
        for (int ai = 0; ai < 2; ++ai)
#pragma unroll
            for (int m = 0; m < 4; ++m) { const float sr = srv[ai * 4 + m];
#pragma unroll
                for (int bj = 0; bj < 2; ++bj) { const i32x4 i0 = acc[ai][bj][m][0], i1 = acc[ai][bj][m][1];
                    *(LAS h8*)(ep + fr * EP_LD + (bj * 128 + wc * 32 + fq * 8) * 2) = cvt8((f32x4){(float)i0[0], (float)i0[1], (float)i0[2], (float)i0[3]} * (s0[bj] * sr), (f32x4){(float)i1[0], (float)i1[1], (float)i1[2], (float)i1[3]} * (s1[bj] * sr)); }
                const size_t go = (size_t)(u.m0 + ai * 128 + wr * 64 + m * 16 + rrow) * 2048 + u.n0 + ch * 16;
                const h8 r0 = *(const h8*)(X + go), r1 = *(const h8*)(X + go + 8);
                ep_sync();
                const h8 x0 = *(const LAS h8*)(ep + rrow * EP_LD + ch * 32), x1 = *(const LAS h8*)(ep + rrow * EP_LD + ch * 32 + 16);
                h8 o0, o1;
#pragma unroll
                for (int q = 0; q < 8; ++q) { o0[q] = (_Float16)(DN_ALPHA * (float)r0[q] + (float)x0[q]); o1[q] = (_Float16)(DN_ALPHA * (float)r1[q] + (float)x1[q]); }
                *(h8*)(C + go) = o0; *(h8*)(C + go + 8) = o1;
                ep_sync();
            } }
};
struct ProbCmp {
    static constexpr bool CD = false;
    static constexpr unsigned ROWB = 4096; static constexpr bool I8 = false;
    static constexpr int NT = 8; static constexpr size_t KS2 = 256;
    static constexpr bool PERM = false;
    const _Float16* A; const _Float16* Bt; float* C; int G, c;
    __device__ __forceinline__ bool next(int i, Unit& u) const { const int L = i * G + c; if (L >= 128) return false;
        u.e = L >> 6; const int r = L & 63; u.rbase = r & 3; u.n0 = ((r >> 2) & 1) * 256; u.m0 = (r >> 3) * 256; u.cnt = 256; return true; }
    __device__ __forceinline__ void a_offs(const Unit& u, const int (&R)[2], const int (&C2)[2], unsigned (&v)[2][2]) const {
#pragma unroll
        for (int h = 0; h < 2; ++h)
#pragma unroll
            for (int i = 0; i < 2; ++i) { const int row = u.m0 + h * 128 + R[i], kvh = row & 1, bj = row >> 1, b = bj >> 7, j = bj & 127;
                v[h][i] = (unsigned)((((u.e * B_ + b) * 2 + kvh) * S_ + 16 * j + 4 * u.rbase) * 128) * 2u + (unsigned)C2[i]; } }
    __device__ __forceinline__ const char* a_base() const { return (const char*)A; }
    __device__ __forceinline__ const char* b_base(const Unit& u) const { return (const char*)(Bt + ((size_t)u.e * 512 + u.n0) * KK + u.rbase * 512); }
    __device__ __forceinline__ void epi(const f32x4 (&acc)[2][2][4][2], const Unit& u, int wr, int wc, int fr, int fq, LAS unsigned char*) const {
        float* base = C + ((size_t)(u.e * 4 + u.rbase) * 2048) * 512;
#pragma unroll
        for (int ai = 0; ai < 2; ++ai)
#pragma unroll
            for (int m = 0; m < 4; ++m) { const int row = u.m0 + ai * 128 + wr * 64 + m * 16 + fr;
#pragma unroll
                for (int bj = 0; bj < 2; ++bj)
#pragma unroll
                    for (int n = 0; n < 2; ++n) { const int col = u.n0 + bj * 128 + wc * 32 + n * 16 + fq * 4;
                        *(f32x4*)(base + (size_t)row * 512 + col) = acc[ai][bj][m][n]; } } }
};
struct MoeTab { const LAS int* t; int NT; int i0, i1;
    __device__ __forceinline__ bool find_i(int i, Unit& u) const {
        if (i + i0 >= i1) return false;
        const LAS int* q = t + 128 + 8 * (i + i0);
        if (__builtin_amdgcn_readfirstlane(q[5]) == 0) return false;
        u.e = __builtin_amdgcn_readfirstlane(q[0]); u.m0 = __builtin_amdgcn_readfirstlane(q[1]); u.n0 = __builtin_amdgcn_readfirstlane(q[2]); u.cnt = __builtin_amdgcn_readfirstlane(q[3]); u.rbase = __builtin_amdgcn_readfirstlane(q[4]); return true; } };
__device__ __forceinline__ void moe_build(LAS int* t, int G, int vcu) {
    const int i = threadIdx.x;
    if (i < 40) { const int L = i * G + vcu; LAS int* q = t + 128 + 8 * i;
        if (L >= t[98]) q[5] = 0;
        else { int e = 0; for (; e < NE - 1; ++e) { if (L < t[32 + e + 1]) break; }
            const int ub = t[32 + e], cn = t[e], rs = t[65 + e]; const int nm = (cn + 255) >> 8, v = L - ub, mt = v % nm, ntile = v / nm;
            q[0] = e; q[1] = mt * 256; q[2] = ntile * 256; q[3] = min(256, cn - mt * 256); q[4] = rs; q[5] = 1; } }
}
struct ProbGu {
    static constexpr int NT = 16; static constexpr size_t KS2 = 256; static constexpr unsigned ROWB = 2048; static constexpr bool I8 = true;
    static constexpr bool PERM = true; static constexpr bool CD = true;
    const signed char* A; const signed char* Bt; unsigned char* act; const float* bgu; const int* list; const float* sa; const float* sw; MoeTab tab; int G, vcu;
    __device__ __forceinline__ bool next(int i, Unit& u) const { return tab.find_i(i, u); }
    __device__ __forceinline__ void a_offs(const Unit& u, const int (&R)[2], const int (&C2)[2], unsigned (&v)[2][2]) const {
#pragma unroll
        for (int h = 0; h < 2; ++h)
#pragma unroll
            for (int i = 0; i < 2; ++i) { int r = h * 128 + R[i]; r = r < u.cnt ? r : 0; const int a = list[(size_t)u.e * T_ + u.m0 + r]; v[h][i] = (unsigned)(a >> 2) * 2048u + (unsigned)C2[i]; } }
    __device__ __forceinline__ const char* a_base() const { return (const char*)A; }
    __device__ __forceinline__ const char* b_base(const Unit& u) const { return (const char*)(Bt + ((size_t)u.e * 4096 + u.n0) * 2048); }
    __device__ __forceinline__ void const_dma(const Unit& u, LAS unsigned char* lds, int wid, int lane) const {
        if (wid < 4) { cdma(lds, 0, wid, bgu + (size_t)u.e * 4096 + u.n0 + wid * 64 + lane); const int r = wid * 64 + lane; cdma(lds, 2, wid, sa + (size_t)u.e * T_ + u.m0 + (r < u.cnt ? r : 0)); }
        else cdma(lds, 1, wid - 4, sw + (size_t)u.e * 4096 + u.n0 + (wid - 4) * 64 + lane);
    }
    __device__ __forceinline__ void epi(const i32x4 (&acc)[2][2][4][2], const Unit& u, int wr, int wc, int fr, int fq, LAS unsigned char* lds) const {
        asm volatile("s_waitcnt vmcnt(16)" ::: "memory");
        ep_sync();
        const LAS float* cst = (const LAS float*)(lds + CONST_OFF);
        const int tg = ep_tid() & 255, rrow = tg >> 4, ch = tg & 15;
        f32x4 b0[2], b1[2], s0[2], s1[2];
#pragma unroll
        for (int bj = 0; bj < 2; ++bj) { const int col = bj * 128 + wc * 32 + fq * 8;
            b0[bj] = *(const LAS f32x4*)(cst + col); b1[bj] = *(const LAS f32x4*)(cst + col + 4); s0[bj] = *(const LAS f32x4*)(cst + 256 + col); s1[bj] = *(const LAS f32x4*)(cst + 256 + col + 4); }
        float srv[8];
#pragma unroll
        for (int q = 0; q < 8; ++q) srv[q] = cst[512 + (q >> 2) * 128 + wr * 64 + (q & 3) * 16 + fr];
        LAS unsigned char* ep2 = lds + EP_OFF + wr * (2 * 4608);
#define GU_WRITE(st) do { const int ai_ = (st) >> 1, mp_ = (st) & 1; LAS unsigned char* eb = ep2 + ((st) & 1) * 4608; \
            _Pragma("unroll") for (int mm = 0; mm < 2; ++mm) { const int m_ = mp_ * 2 + mm; const float sr = srv[ai_ * 4 + m_]; \
                _Pragma("unroll") for (int bj = 0; bj < 2; ++bj) { const i32x4 i0 = acc[ai_][bj][m_][0], i1 = acc[ai_][bj][m_][1]; \
                    const f32x4 v0 = (f32x4){(float)i0[0], (float)i0[1], (float)i0[2], (float)i0[3]} * (s0[bj] * sr) + b0[bj], v1 = (f32x4){(float)i1[0], (float)i1[1], (float)i1[2], (float)i1[3]} * (s1[bj] * sr) + b1[bj]; \
                    *(LAS unsigned*)(eb + (mm * 16 + fr) * 144 + (bj * 64 + wc * 16 + fq * 4)) = pk4_fp8(swiglu_fast(v0[0], v0[1]), swiglu_fast(v0[2], v0[3]), swiglu_fast(v1[0], v1[1]), swiglu_fast(v1[2], v1[3])); } } } while (0)
        GU_WRITE(0);
        ep_sync();
#pragma unroll
        for (int st = 0; st < 4; ++st) {
            if (st + 1 < 4) GU_WRITE(st + 1);
#pragma unroll
            for (int mm = 0; mm < 2; ++mm) { const u32x2 x0 = *(const LAS u32x2*)(ep2 + (st & 1) * 4608 + (mm * 16 + rrow) * 144 + ch * 8);
                const int rr = (st >> 1) * 128 + wr * 64 + ((st & 1) * 2 + mm) * 16 + rrow;
                if (rr < u.cnt) *(u32x2*)(act + (size_t)(u.rbase + u.m0 + rr) * 2048 + (u.n0 >> 1) + ch * 8) = x0; }
            ep_sync();
        }
#undef GU_WRITE
    }
};
struct ProbDn {
    static constexpr int NT = 16; static constexpr size_t KS2 = 256; static constexpr unsigned ROWB = 2048; static constexpr bool I8 = true;
    static constexpr bool PERM = true; static constexpr bool CD = true;
    const signed char* A; const signed char* Bt; unsigned char* y; const float* bdn; const int* list; const float* gate; const float* sa; const float* sw; MoeTab tab; int G, vcu;
    __device__ __forceinline__ bool next(int i, Unit& u) const { return tab.find_i(i, u); }
    __device__ __forceinline__ void a_offs(const Unit& u, const int (&R)[2], const int (&C2)[2], unsigned (&v)[2][2]) const {
#pragma unroll
        for (int h = 0; h < 2; ++h)
#pragma unroll
            for (int i = 0; i < 2; ++i) v[h][i] = (unsigned)(u.rbase + u.m0 + h * 128 + R[i]) * 2048u + (unsigned)C2[i]; }
    __device__ __forceinline__ const char* a_base() const { return (const char*)A; }
    __device__ __forceinline__ const char* b_base(const Unit& u) const { return (const char*)(Bt + ((size_t)u.e * 2048 + u.n0) * 2048); }
    __device__ __forceinline__ void const_dma(const Unit& u, LAS unsigned char* lds, int wid, int lane) const {
        const int i4 = wid & 3, r = i4 * 64 + lane, rc = r < u.cnt ? r : 0;
        if (wid < 4) { cdma(lds, 0, i4, bdn + (size_t)u.e * 2048 + u.n0 + r); cdma(lds, 2, i4, sa + u.rbase + u.m0 + rc); cdma(lds, 4, i4, list + (size_t)u.e * T_ + u.m0 + rc); }
        else { cdma(lds, 1, i4, sw + (size_t)u.e * 2048 + u.n0 + r); cdma(lds, 3, i4, gate + (size_t)u.e * T_ + u.m0 + rc); }
    }
    __device__ __forceinline__ void epi(const i32x4 (&acc)[2][2][4][2], const Unit& u, int wr, int wc, int fr, int fq, LAS unsigned char* lds) const {
        asm volatile("s_waitcnt vmcnt(16)" ::: "memory");
        ep_sync();
        const LAS float* cst = (const LAS float*)(lds + CONST_OFF);
        LAS unsigned char* ep = lds + EP_OFF + wr * (2 * 4352);
        const int tg = ep_tid() & 255, rrow = tg >> 4, ch = tg & 15;
        f32x4 b0[2], b1[2], s0[2], s1[2];
#pragma unroll
        for (int bj = 0; bj < 2; ++bj) { const int col = bj * 128 + wc * 32 + fq * 8;
            b0[bj] = *(const LAS f32x4*)(cst + col); b1[bj] = *(const LAS f32x4*)(cst + col + 4); s0[bj] = *(const LAS f32x4*)(cst + 256 + col); s1[bj] = *(const LAS f32x4*)(cst + 256 + col + 4); }
        float gv[8], srv[8]; int a2v[8];
#pragma unroll
        for (int q = 0; q < 8; ++q) { const int rl = (q >> 2) * 128 + wr * 64 + (q & 3) * 16 + fr; gv[q] = cst[768 + rl]; srv[q] = cst[512 + rl];
            a2v[q] = ((const LAS int*)cst)[1024 + (q >> 2) * 128 + wr * 64 + (q & 3) * 16 + rrow]; }
#define DN_WRITE(st) do { const int ai_ = (st) >> 2, m_ = (st) & 3; const float g = gv[st] * 16.f, sr = srv[st]; LAS unsigned char* eb = ep + ((st) & 1) * 4352; \
            _Pragma("unroll") for (int bj = 0; bj < 2; ++bj) { const i32x4 i0 = acc[ai_][bj][m_][0], i1 = acc[ai_][bj][m_][1]; \
                const f32x4 v0 = ((f32x4){(float)i0[0], (float)i0[1], (float)i0[2], (float)i0[3]} * (s0[bj] * sr) + b0[bj]) * g, v1 = ((f32x4){(float)i1[0], (float)i1[1], (float)i1[2], (float)i1[3]} * (s1[bj] * sr) + b1[bj]) * g; \
                u32x2 o; o[0] = pk4_fp8(__builtin_amdgcn_fmed3f(v0[0], -440.f, 440.f), __builtin_amdgcn_fmed3f(v0[1], -440.f, 440.f), __builtin_amdgcn_fmed3f(v0[2], -440.f, 440.f), __builtin_amdgcn_fmed3f(v0[3], -440.f, 440.f)); o[1] = pk4_fp8(__builtin_amdgcn_fmed3f(v1[0], -440.f, 440.f), __builtin_amdgcn_fmed3f(v1[1], -440.f, 440.f), __builtin_amdgcn_fmed3f(v1[2], -440.f, 440.f), __builtin_amdgcn_fmed3f(v1[3], -440.f, 440.f)); \
                *(LAS u32x2*)(eb + fr * 272 + (bj * 128 + wc * 32 + fq * 8)) = o; } } while (0)
        DN_WRITE(0);
        ep_sync();
#pragma unroll
        for (int st = 0; st < 8; ++st) {
            if (st + 1 < 8) DN_WRITE(st + 1);
            const int rr = (st >> 2) * 128 + wr * 64 + (st & 3) * 16 + rrow;
            const u32x4 x0 = *(const LAS u32x4*)(ep + (st & 1) * 4352 + rrow * 272 + ch * 16);
            if (rr < u.cnt) *(u32x4*)(y + (size_t)a2v[st] * 2048 + u.n0 + ch * 16) = x0;
            ep_sync();
        }
#undef DN_WRITE
    }
};
}

namespace at8 {
typedef float f32x16 __attribute__((ext_vector_type(16)));
typedef short s16x4 __attribute__((ext_vector_type(4)));
typedef unsigned u32x4 __attribute__((ext_vector_type(4)));
constexpr int SHM_K = 64 * 128 * 2, SHM_V = 64 * 128 * 2, SLOT = SHM_K + SHM_V;
constexpr int NSLOT = 4;
constexpr int LDS_WS = NSLOT * SLOT;
constexpr int LDS_END = LDS_WS + 8 * 64 * 4;
constexpr float CEXP = ATT_SCALE * 1.4426950408889634f;
constexpr float THR_RAW = 8.f / ATT_SCALE;
#define AT_KSWZ(row, colB) ((row) * 256 + ((colB) ^ (((row) & 7) << 4)))
#define AT_SBAR() __builtin_amdgcn_sched_barrier(0)
__device__ __forceinline__ int crow(int r, int hi) { return (r & 3) + 8 * (r >> 2) + 4 * hi; }
__device__ __forceinline__ unsigned cvtpk(float lo, float hi) { auto v = __builtin_amdgcn_cvt_pkrtz(lo, hi); return *reinterpret_cast<unsigned*>(&v); }
__device__ __forceinline__ int v_st(int k, int c) { const int kk = (k & ~0xC) | ((k & 4) << 1) | ((k & 8) >> 1); return ((kk >> 3) * 4 + (c >> 5)) * 512 + ((kk & 7) * 32 + (c & 31)) * 2; }
__device__ __forceinline__ int v_rd_base(int lane) { return ((lane & 3) << 3) | (((lane >> 2) & 3) << 6) | (((lane >> 4) & 1) << 5) | (((lane >> 5) & 1) << 8); }
constexpr int v_rd_off(int d0, int ks, int half) { return d0 * 512 + ks * 4096 + half * 2048; }
template <int OFF> __device__ __forceinline__ s16x4 tr_read(int vb) { s16x4 r; asm volatile("ds_read_b64_tr_b16 %0, %1 offset:%2" : "=&v"(r) : "v"(vb), "i"(OFF) : "memory"); return r; }
__device__ __forceinline__ h8 mk8(s16x4 l, s16x4 h) { typedef short s16x8 __attribute__((ext_vector_type(8))); s16x8 w = {l[0], l[1], l[2], l[3], h[0], h[1], h[2], h[3]}; return *reinterpret_cast<h8*>(&w); }
template <int D0> __device__ __forceinline__ void pv_one(f32x16& od, int vb, h8 pa0, h8 pa1, h8 pa2, h8 pa3) {
    const s16x4 l0 = tr_read<v_rd_off(D0, 0, 0)>(vb), h0 = tr_read<v_rd_off(D0, 0, 1)>(vb), l1 = tr_read<v_rd_off(D0, 1, 0)>(vb), h1 = tr_read<v_rd_off(D0, 1, 1)>(vb);
    const s16x4 l2 = tr_read<v_rd_off(D0, 2, 0)>(vb), h2 = tr_read<v_rd_off(D0, 2, 1)>(vb), l3 = tr_read<v_rd_off(D0, 3, 0)>(vb), h3 = tr_read<v_rd_off(D0, 3, 1)>(vb);
    asm volatile("s_waitcnt lgkmcnt(0)" ::: "memory"); AT_SBAR();
    od = __builtin_amdgcn_mfma_f32_32x32x16_f16(pa0, mk8(l0, h0), od, 0, 0, 0);
    od = __builtin_amdgcn_mfma_f32_32x32x16_f16(pa1, mk8(l1, h1), od, 0, 0, 0);
    od = __builtin_amdgcn_mfma_f32_32x32x16_f16(pa2, mk8(l2, h2), od, 0, 0, 0);
    od = __builtin_amdgcn_mfma_f32_32x32x16_f16(pa3, mk8(l3, h3), od, 0, 0, 0);
}
__device__ __forceinline__ void pv_d0(f32x16 (&o)[4], int vb, h8 pa0, h8 pa1, h8 pa2, h8 pa3) {
    pv_one<0>(o[0], vb, pa0, pa1, pa2, pa3); pv_one<1>(o[1], vb, pa0, pa1, pa2, pa3); pv_one<2>(o[2], vb, pa0, pa1, pa2, pa3); pv_one<3>(o[3], vb, pa0, pa1, pa2, pa3);
}
__device__ __forceinline__ void qkt(f32x16& p0, f32x16& p1, const char* Ks, const h8 (&qr)[8], int r32, int hi) {
    p0 = f32x16{}; p1 = f32x16{};
#pragma unroll
    for (int d0 = 0; d0 < 8; ++d0) { const int cb = (d0 * 16 + hi * 8) * 2;
        const h8 b0 = *reinterpret_cast<const h8*>(Ks + AT_KSWZ(r32, cb));
        const h8 b1 = *reinterpret_cast<const h8*>(Ks + AT_KSWZ(32 + r32, cb));
        p0 = __builtin_amdgcn_mfma_f32_32x32x16_f16(b0, qr[d0], p0, 0, 0, 0);
        p1 = __builtin_amdgcn_mfma_f32_32x32x16_f16(b1, qr[d0], p1, 0, 0, 0); }
}
__device__ __forceinline__ void pack_p(const f32x16& p0, const f32x16& p1, h8& pa0, h8& pa1, h8& pa2, h8& pa3) {
#define AT_PK4(P, BASE, OUT) do { unsigned a0 = cvtpk(P[BASE + 0], P[BASE + 1]), a1 = cvtpk(P[BASE + 2], P[BASE + 3]); \
    unsigned b0 = cvtpk(P[BASE + 4], P[BASE + 5]), b1 = cvtpk(P[BASE + 6], P[BASE + 7]); \
    auto r0 = __builtin_amdgcn_permlane32_swap(a0, b0, false, false); auto r1 = __builtin_amdgcn_permlane32_swap(a1, b1, false, false); \
    u32x4 w = {r0[0], r1[0], r0[1], r1[1]}; OUT = *reinterpret_cast<h8*>(&w); } while (0)
    AT_PK4(p0, 0, pa0); AT_PK4(p0, 8, pa1); AT_PK4(p1, 0, pa2); AT_PK4(p1, 8, pa3);
#undef AT_PK4
}
__device__ __forceinline__ float half_swap_max(float v) { auto rr = __builtin_amdgcn_permlane32_swap(__float_as_uint(v), __float_as_uint(v), false, false); return fmaxf(__uint_as_float(rr[0]), __uint_as_float(rr[1])); }
__device__ __forceinline__ float half_swap_sum(float v) { auto rr = __builtin_amdgcn_permlane32_swap(__float_as_uint(v), __float_as_uint(v), false, false); return __uint_as_float(rr[0]) + __uint_as_float(rr[1]); }

__device__ __forceinline__ int hidden_tid() { int tz = threadIdx.x; asm volatile("" : "+v"(tz)); return tz; }
__device__ __forceinline__ void dma_offsets(int ld, int (&ko)[2], int (&vo)[2]) {
    const int tz = hidden_tid(), w = tz >> 6, l = tz & 63;
#pragma unroll
    for (int q = 0; q < 2; ++q) {
        const int rr = 4 * (2 * w + q) + (l >> 4), pp = l & 15;
        ko[q] = rr * ld + ((pp ^ (rr & 7)) * 8);
        const int L = (2 * w + q) * 1024 + l * 16, sidx = L >> 9, o = L & 511;
        const int kk = (sidx >> 2) * 8 + (o >> 6), c = (sidx & 3) * 32 + ((o & 63) >> 1);
        const int k = (kk & ~0xC) | ((kk & 4) << 1) | ((kk & 8) >> 1);
        vo[q] = k * ld + c;
    }
}
__device__ __forceinline__ void dma_tile(char* slot, const _Float16* Kb, const _Float16* Vb, int ld, int tile, const int (&ko)[2], const int (&vo)[2], int wid) {
    const _Float16* kt = Kb + (size_t)tile * 64 * ld; const _Float16* vt = Vb + (size_t)tile * 64 * ld;
#pragma unroll
    for (int q = 0; q < 2; ++q) __builtin_amdgcn_global_load_lds((const unsigned*)(kt + ko[q]), (LAS unsigned*)(slot + (2 * wid + q) * 1024), 16, 0, 0);
#pragma unroll
    for (int q = 0; q < 2; ++q) __builtin_amdgcn_global_load_lds((const unsigned*)(vt + vo[q]), (LAS unsigned*)(slot + SHM_K + (2 * wid + q) * 1024), 16, 0, 0);
}
#define AT_WAITV(n) asm volatile("s_waitcnt vmcnt(" #n ")" ::: "memory")
#define AT_BAR() do { asm volatile("s_waitcnt lgkmcnt(0)" ::: "memory"); __builtin_amdgcn_s_barrier(); asm volatile("" ::: "memory"); } while (0)

__device__ __forceinline__ void attn_unit(char* lds, const _Float16* qrow, const _Float16* Kb, const _Float16* Vb, int ld, unsigned tmask, int wlen, int khi, unsigned selmask,
                                          _Float16* outw, int ostride) {
    const int tid = threadIdx.x, wid = __builtin_amdgcn_readfirstlane(tid >> 6), lane = tid & 63, r32 = lane & 31, hi = lane >> 5;
    float* wsf = (float*)(lds + LDS_WS) + wid * 64; float* li_l = wsf; float* al_l = wsf + 32;
    float m_reg = -1e30f, l_reg = 0.f; f32x16 o[4] = {}; h8 qr[8];
#pragma unroll
    for (int d0 = 0; d0 < 8; ++d0) qr[d0] = *(const h8*)(qrow + d0 * 16);
    int ko[2], vo[2]; dma_offsets(ld, ko, vo);
    const int vbase = (int)(uintptr_t)lds + SHM_K + v_rd_base(lane);
    unsigned rest = tmask; int j = __ffs(rest) - 1; rest &= rest - 1;
    int j1 = rest ? (__ffs(rest) - 1) : -1; if (j1 >= 0) rest &= rest - 1;
    dma_tile(lds, Kb, Vb, ld, j, ko, vo, wid);
    if (j1 >= 0) { dma_tile(lds + SLOT, Kb, Vb, ld, j1, ko, vo, wid); AT_WAITV(4); } else { AT_WAITV(0); }
    AT_BAR();
    int so = 0, sp = 0;
    const bool roleB = wid >= 4;
    bool first = true;
    h8 pa0, pa1, pa2, pa3;
    for (;;) {
        const int j2 = rest ? (__ffs(rest) - 1) : -1;
        if (j2 >= 0) { rest &= rest - 1; int s2 = so + 2 * SLOT; s2 = s2 >= NSLOT * SLOT ? s2 - NSLOT * SLOT : s2; dma_tile(lds + s2, Kb, Vb, ld, j2, ko, vo, wid); }
        if (roleB && !first) { AT_SBAR(); pv_d0(o, vbase + sp, pa0, pa1, pa2, pa3); }
        f32x16 p0, p1;
        AT_SBAR(); qkt(p0, p1, lds + so, qr, r32, hi);
        { const int klo = wlen > 0 ? khi - wlen + 1 : 0; const bool tb = (selmask >> j) & 1u; const bool inr = (j * 64 >= klo) && (j * 64 + 63 <= khi);
          if (!__all(tb && inr)) {
              if (__all(inr)) {
#pragma unroll
                  for (int r = 0; r < 16; ++r) { p0[r] = tb ? p0[r] : -INFINITY; p1[r] = tb ? p1[r] : -INFINITY; }
              } else {
                  const int kb = j * 64 + 4 * hi;
#pragma unroll
                  for (int r = 0; r < 16; ++r) { const int k0 = kb + (r & 3) + 8 * (r >> 2);
                      p0[r] = (tb && k0 >= klo && k0 <= khi) ? p0[r] : -INFINITY;
                      p1[r] = (tb && (k0 + 32) >= klo && (k0 + 32) <= khi) ? p1[r] : -INFINITY; }
              } } }
        float pmax = p0[0];
#pragma unroll
        for (int r = 1; r < 16; ++r) pmax = fmaxf(pmax, p0[r]);
#pragma unroll
        for (int r = 0; r < 16; ++r) pmax = fmaxf(pmax, p1[r]);
        pmax = half_swap_max(pmax);
        float mn, alpha;
        if (__all(pmax - m_reg <= THR_RAW)) { mn = m_reg; alpha = 1.f; }
        else { mn = fmaxf(m_reg, pmax); alpha = __builtin_amdgcn_exp2f((m_reg - mn) * CEXP); m_reg = mn; }
        const float mnC = -mn * CEXP;
        float ps = 0.f;
#pragma unroll
        for (int r = 0; r < 16; ++r) { p0[r] = __builtin_amdgcn_exp2f(fmaf(p0[r], CEXP, mnC)); ps += p0[r]; }
#pragma unroll
        for (int r = 0; r < 16; ++r) { p1[r] = __builtin_amdgcn_exp2f(fmaf(p1[r], CEXP, mnC)); ps += p1[r]; }
        ps = half_swap_sum(ps);
        l_reg = l_reg * alpha + ps;
        if (__any(alpha < 1.f)) { if (hi == 0) al_l[r32] = alpha; asm volatile("s_waitcnt lgkmcnt(0)" ::: "memory");
#pragma unroll
            for (int r = 0; r < 16; ++r) { const float a = al_l[crow(r, hi)];
#pragma unroll
                for (int d = 0; d < 4; ++d) o[d][r] *= a; } }
        pack_p(p0, p1, pa0, pa1, pa2, pa3);
        AT_SBAR();
        if (!roleB) pv_d0(o, vbase + so, pa0, pa1, pa2, pa3);
        if (j1 < 0) break;
        if (j2 >= 0) { AT_WAITV(4); } else { AT_WAITV(0); }
        AT_BAR();
        j = j1; j1 = j2; sp = so; so += SLOT; so = so >= NSLOT * SLOT ? so - NSLOT * SLOT : so; first = false;
    }
    if (roleB) { AT_SBAR(); pv_d0(o, vbase + so, pa0, pa1, pa2, pa3); }
    if (hi == 0) li_l[r32] = l_reg; asm volatile("s_waitcnt lgkmcnt(0)" ::: "memory");
#pragma unroll
    for (int r = 0; r < 16; ++r) { const int orow = crow(r, hi); const float l = li_l[orow]; const float rl = l > 0.f ? 1.f / l : 0.f;
#pragma unroll
        for (int d0 = 0; d0 < 4; ++d0) outw[(size_t)orow * ostride + d0 * 32 + r32] = (_Float16)(o[d0][r] * rl); }
    __syncthreads();
}

constexpr int LDS_AP = 0, LDS_BP = LDS_AP + 4 * 64 * 33 * 4, LDS_SELM = LDS_END, LDS_CS_END = LDS_SELM + 64 * 4;
static_assert(LDS_BP + 4 * 64 * 33 * 4 <= NSLOT * SLOT, "importance partials must fit inside the ring");
__device__ __forceinline__ void cmp_slc_unit(char* lds, const _Float16* qrow, const _Float16* Kc, const _Float16* Vc, const _Float16* Ks, const _Float16* Vs, int t, int tl, int g, int qi,
                                             _Float16* outc, _Float16* outs) {
    const int tid = threadIdx.x, wid = __builtin_amdgcn_readfirstlane(tid >> 6), lane = tid & 63, r32 = lane & 31, hi = lane >> 5;
    float* AP = (float*)(lds + LDS_AP); float* BP = (float*)(lds + LDS_BP); unsigned* selm = (unsigned*)(lds + LDS_SELM);
    {
        h8 qr[8];
#pragma unroll
        for (int d0 = 0; d0 < 8; ++d0) qr[d0] = *(const h8*)(qrow + d0 * 16);
        const int vb0 = (int)(uintptr_t)lds + SHM_K + v_rd_base(lane);
        { int ko[2], vo[2]; dma_offsets(256, ko, vo);
          dma_tile(lds, Kc, Vc, 256, 0, ko, vo, wid); dma_tile(lds + SLOT, Kc, Vc, 256, 1, ko, vo, wid); }
        AT_WAITV(0); AT_BAR();
        f32x16 pA0, pA1, pB0, pB1;
        AT_SBAR(); qkt(pA0, pA1, lds, qr, r32, hi); qkt(pB0, pB1, lds + SLOT, qr, r32, hi);
        const int khi = t >= 31 ? ((t - 31) >> 4) : -1;
#pragma unroll
        for (int r = 0; r < 16; ++r) { const int c0 = 4 * hi + (r & 3) + 8 * (r >> 2);
            pA0[r] = (c0 <= khi) ? pA0[r] : -INFINITY; pA1[r] = (c0 + 32 <= khi) ? pA1[r] : -INFINITY;
            pB0[r] = (c0 + 64 <= khi) ? pB0[r] : -INFINITY; pB1[r] = (c0 + 96 <= khi) ? pB1[r] : -INFINITY; }
        float pmax = -INFINITY;
#pragma unroll
        for (int r = 0; r < 16; ++r) pmax = fmaxf(fmaxf(pmax, pA0[r]), fmaxf(pA1[r], fmaxf(pB0[r], pB1[r])));
        pmax = half_swap_max(pmax);
        const float mC = (pmax == -INFINITY) ? 0.f : -pmax * CEXP;
        float ps = 0.f;
#pragma unroll
        for (int r = 0; r < 16; ++r) { pA0[r] = __builtin_amdgcn_exp2f(fmaf(pA0[r], CEXP, mC)); pA1[r] = __builtin_amdgcn_exp2f(fmaf(pA1[r], CEXP, mC));
            pB0[r] = __builtin_amdgcn_exp2f(fmaf(pB0[r], CEXP, mC)); pB1[r] = __builtin_amdgcn_exp2f(fmaf(pB1[r], CEXP, mC)); ps += (pA0[r] + pA1[r]) + (pB0[r] + pB1[r]); }
        ps = half_swap_sum(ps);
        const float inv = ps > 0.f ? 1.f / ps : 0.f;
#pragma unroll
        for (int r = 0; r < 16; ++r) { pA0[r] *= inv; pA1[r] *= inv; pB0[r] *= inv; pB1[r] *= inv; }
        f32x16 o[4] = {};
        h8 pa0, pa1, pa2, pa3;
        pack_p(pA0, pA1, pa0, pa1, pa2, pa3); AT_SBAR(); pv_d0(o, vb0, pa0, pa1, pa2, pa3);
        pack_p(pB0, pB1, pa0, pa1, pa2, pa3); AT_SBAR(); pv_d0(o, vb0 + SLOT, pa0, pa1, pa2, pa3);
#pragma unroll
        for (int r = 0; r < 16; ++r) { const int orow = crow(r, hi);
#pragma unroll
            for (int d0 = 0; d0 < 4; ++d0) outc[(size_t)orow * 1024 + d0 * 32 + r32] = (_Float16)o[d0][r]; }
        __syncthreads();
        { float* ap = AP + (g * 64 + tl) * 33; float* bp = BP + (g * 64 + tl) * 33;
          if (hi == 0) bp[0] = 0.f;
#define AT_IMP(P, JB) do { _Pragma("unroll") for (int k = 0; k < 4; ++k) { const int j = (JB) + 2 * k + hi; \
              ap[j] = 2.f * (P[4 * k] + P[4 * k + 1] + P[4 * k + 2]) + P[4 * k + 3]; if (j + 1 < 32) bp[j + 1] = P[4 * k + 3]; } } while (0)
          AT_IMP(pA0, 0); AT_IMP(pA1, 8); AT_IMP(pB0, 16); AT_IMP(pB1, 24);
#undef AT_IMP
        }
    }
    __syncthreads();
#pragma unroll 1
    for (int it = 0; it < 4; ++it) {
        const int tk = 8 * wid + 2 * it + hi, j = r32;
        float imp = 0.f;
#pragma unroll
        for (int gg = 0; gg < 4; ++gg) imp += AP[(gg * 64 + tk) * 33 + j] + BP[(gg * 64 + tk) * 33 + j];
        const bool forced = (j == 0) || (j == qi) || (j == qi - 1), valid = j <= qi;
        const float iv = forced ? 1e9f : (valid ? imp : -1e9f);
        int rank = 0;
        for (int i = 0; i < 32; ++i) { const float vi = __shfl(iv, i + 32 * hi); rank += (vi > iv || (vi == iv && i < j)) ? 1 : 0; }
        const unsigned long long bal = __ballot(rank < 16 && valid);
        if (r32 == 0) selm[tk] = (unsigned)(bal >> (32 * hi));
    }
    __syncthreads();
    unsigned tm = selm[lane];
#pragma unroll
    for (int o = 32; o > 0; o >>= 1) tm |= __shfl_xor(tm, o);
    const int tz2 = hidden_tid();
    const unsigned mysel = selm[((tz2 >> 6) & 1) * 32 + (tz2 & 31)];
    attn_unit(lds, qrow, Ks, Vs, 128, tm, 0, t, mysel, outs, 1024);
}
}

struct CUnit { const float* W; int ldw; int nvalid; _Float16* Wt; int k0; int n0; };
__device__ __forceinline__ CUnit conv_desc(int u, const float* win, const float* w1k, const float* w1v, const float* wmkv, _Float16* wtin, _Float16* wt1, _Float16* wtmkv) {
    CUnit d;
    if (u < 160) { d.W = win; d.ldw = INW; d.nvalid = INW; d.Wt = wtin; d.k0 = (u / 5) * 64; d.n0 = (u % 5) * 256; }
    else if (u < 288) { const int v = u - 160, kv = v >> 6, part = (v >> 5) & 1, kt = v & 31;
        d.W = (kv ? w1v : w1k) + (size_t)part * 2048 * 256; d.ldw = 256; d.nvalid = 256; d.Wt = wt1 + ((size_t)kv * 512 + part * 256) * 2048; d.k0 = kt * 64; d.n0 = 0; }
    else { d.W = wmkv; d.ldw = 1024; d.nvalid = 1024; d.Wt = wtmkv; d.k0 = 0; d.n0 = 0; }
    return d;
}
__device__ __forceinline__ void conv_all(float* lds, const float* win, const float* w1k, const float* w1v, const float* wmkv, _Float16* wtin, _Float16* wt1, _Float16* wtmkv, int bid, int nb) {
    constexpr int NU = 160 + 128;
    const int tid = threadIdx.x;
    int u = bid; if (u >= NU) return;
    CUnit d = conv_desc(u, win, w1k, w1v, wmkv, wtin, wt1, wtmkv);
    float4 v[8];
#define CL(D) do { _Pragma("unroll") for (int i = 0; i < 8; ++i) { const int idx = tid + 512 * i, r = idx >> 6, c4 = (idx & 63) * 4; \
        v[i] = ((D).n0 + c4 < (D).nvalid) ? *(const float4*)((D).W + (size_t)((D).k0 + r) * (D).ldw + (D).n0 + c4) : make_float4(0.f, 0.f, 0.f, 0.f); } } while (0)
    CL(d);
    for (;;) {
#pragma unroll
        for (int i = 0; i < 8; ++i) { const int idx = tid + 512 * i, r = idx >> 6, c4 = (idx & 63) * 4; float* dd = lds + r * 257 + c4; dd[0] = v[i].x; dd[1] = v[i].y; dd[2] = v[i].z; dd[3] = v[i].w; }
        __syncthreads();
        const int un = u + nb; const bool has = un < NU;
        CUnit dn = d; if (has) { dn = conv_desc(un, win, w1k, w1v, wmkv, wtin, wt1, wtmkv); CL(dn); }
#pragma unroll
        for (int j = 0; j < 4; ++j) { const int id = tid + 512 * j, n = id >> 3, k8 = (id & 7) * 8; h8 o;
#pragma unroll
            for (int q = 0; q < 8; ++q) o[q] = (_Float16)lds[(k8 + q) * 257 + n];
            *(h8*)(d.Wt + (size_t)(d.n0 + n) * 2048 + d.k0 + k8) = o; }
        __syncthreads();
        if (!has) break;
        u = un; d = dn;
    }
#undef CL
}

__device__ __forceinline__ unsigned pack4_i8(float a, float b, float c, float d) {
    const int ia = __float2int_rn(a), ib = __float2int_rn(b), ic = __float2int_rn(c), id = __float2int_rn(d);
    return (unsigned)(ia & 255) | ((unsigned)(ib & 255) << 8) | ((unsigned)(ic & 255) << 16) | ((unsigned)(id & 255) << 24);
}
constexpr int QP_LD2 = 1026;
struct QUnit { const float* W; int ldw; int n0; signed char* Q; float* sc; int nvalid; };
struct QExtra { const float* win; signed char* q8in; float* sin8; const float* wmkv; signed char* q8mkv; float* smkv; };
__device__ __forceinline__ QUnit quant_desc(int u, const float* wgu, const float* wdn, signed char* q8gu, signed char* q8dn, float* sgu, float* sdn, const float* wout, signed char* q8out, float* sout, const QExtra& x) {
    QUnit d; d.nvalid = 1 << 30;
    if (u >= NE * 192 + 64 + 73) { const int pn = u - (NE * 192 + 64 + 73); d.W = x.wmkv; d.ldw = 1024; d.n0 = pn * 32; d.Q = x.q8mkv; d.sc = x.smkv; }
    else if (u >= NE * 192 + 64) { const int pn = u - (NE * 192 + 64); d.W = x.win; d.ldw = INW; d.n0 = 1280 + pn * 32; d.Q = x.q8in - (size_t)1280 * 2048; d.sc = x.sin8 - 1280; d.nvalid = INW; }
    else if (u >= NE * 192) { const int pn = u - NE * 192; d.W = wout; d.ldw = 2048; d.n0 = pn * 32; d.Q = q8out; d.sc = sout; }
    else if (u < NE * 128) { const int e = u >> 7, pn = u & 127; d.W = wgu + (size_t)e * 2048 * 4096; d.ldw = 4096; d.n0 = pn * 32; d.Q = q8gu + (size_t)e * 4096 * 2048; d.sc = sgu + (size_t)e * 4096; }
    else { const int v = u - NE * 128, e = v >> 6, pn = v & 63; d.W = wdn + (size_t)e * 2048 * 2048; d.ldw = 2048; d.n0 = pn * 32; d.Q = q8dn + (size_t)e * 2048 * 2048; d.sc = sdn + (size_t)e * 2048; }
    return d;
}
__device__ __forceinline__ unsigned pk2h(float a, float b) { auto v = __builtin_amdgcn_cvt_pkrtz(a, b); return *reinterpret_cast<unsigned*>(&v); }
template <bool DYN>
__device__ __forceinline__ void quant_units(char* smem, const float* wgu, const float* wdn, signed char* q8gu, signed char* q8dn, float* sgu, float* sdn, const float* wout, signed char* q8out, float* sout, const QExtra& qx,
                                            int ubase, int nun, unsigned* ctr, int maxu, int bid, int nb) {
    typedef _Float16 h2v __attribute__((ext_vector_type(2)));
    typedef unsigned qu4 __attribute__((ext_vector_type(4)));
    unsigned* cmaxb = (unsigned*)(smem + g8::EP_OFF);
    volatile LAS int* slot = (volatile LAS int*)(smem + g8::EP_OFF + 256);
    int tid = threadIdx.x; asm volatile("" : "+v"(tid));
    const int c4 = (tid & 7) * 4, rg = tid >> 3;
    if (tid < 64) cmaxb[tid] = 0u;
    if (DYN) { if (tid == 0) slot[0] = maxu > 0 ? (int)__hip_atomic_fetch_add(ctr, 1u, __ATOMIC_RELAXED, __HIP_MEMORY_SCOPE_AGENT) : 0x7fffffff; }
    __syncthreads();
    int u = DYN ? slot[0] : bid;
    if (u >= nun) { __syncthreads(); return; }
    int taken = 1;
    QUnit d = quant_desc(ubase + u, wgu, wdn, q8gu, q8dn, sgu, sdn, wout, q8out, sout, qx);
    float4 L[32];
    char* hb = smem + tid * 16;
#define QLD(D, en) do { const char* p0 = (const char*)((D).W + (D).n0); const int cc = ((D).n0 + c4 < (D).nvalid) ? c4 : 0;     \
        const unsigned vo = (unsigned)(rg * 16 * (D).ldw + cc) * 4u, ldb = (unsigned)(D).ldw * 4u; \
        if (en) { _Pragma("unroll") for (int j = 0; j < 16; ++j) { L[j] = *(const float4*)(p0 + (size_t)(j * ldb) + vo); L[16 + j] = *(const float4*)(p0 + (size_t)((1024 + j) * ldb) + vo); } } \
        else { _Pragma("unroll") for (int j = 0; j < 32; ++j) L[j] = make_float4(0.f, 0.f, 0.f, 0.f); } } while (0)
#define QPK(a, b) ({ h2v t_; t_[0] = (_Float16)(a); t_[1] = (_Float16)(b); __builtin_bit_cast(unsigned, t_); })
#define QW(comp, ci) do { _Pragma("unroll") for (int hq = 0; hq < 4; ++hq) { uint4 w_; w_.x = QPK(L[hq * 8 + 0].comp, L[hq * 8 + 1].comp); w_.y = QPK(L[hq * 8 + 2].comp, L[hq * 8 + 3].comp); \
        w_.z = QPK(L[hq * 8 + 4].comp, L[hq * 8 + 5].comp); w_.w = QPK(L[hq * 8 + 6].comp, L[hq * 8 + 7].comp); *(uint4*)(hb + ((ci) * 4 + hq) * 8192) = w_; } } while (0)
#define QINV(x) ({ const float iv_ = (x) > 0.f ? fminf(127.f / (x), 65504.f) : 0.f; __builtin_bit_cast(unsigned, __builtin_amdgcn_cvt_pkrtz(iv_, iv_)); })
#define QF(w, iv) __builtin_bit_cast(unsigned, __builtin_elementwise_fma(__builtin_bit_cast(h2v, (unsigned)(w)), __builtin_bit_cast(h2v, (unsigned)(iv)), __builtin_bit_cast(h2v, 0x66006600u)))
#define QS(ci, half, iv) do { const uint4 w0 = *(const uint4*)(hb + ((ci) * 4 + (half) * 2) * 8192), w1 = *(const uint4*)(hb + ((ci) * 4 + (half) * 2 + 1) * 8192); uint4 o; \
        o.x = __builtin_amdgcn_perm(QF(w0.y, iv), QF(w0.x, iv), 0x06040200u); o.y = __builtin_amdgcn_perm(QF(w0.w, iv), QF(w0.z, iv), 0x06040200u); \
        o.z = __builtin_amdgcn_perm(QF(w1.y, iv), QF(w1.x, iv), 0x06040200u); o.w = __builtin_amdgcn_perm(QF(w1.w, iv), QF(w1.z, iv), 0x06040200u); \
        *(__attribute__((address_space(1))) qu4*)(d.Q + (size_t)(d.n0 + c4 + (ci)) * 2048 + (half) * 1024 + rg * 16) = (qu4){o.x, o.y, o.z, o.w}; } while (0)
    QLD(d, true);
    int par = 0;
    for (;;) {
        unsigned* cmax = cmaxb + par * 32;
        float m0 = 0.f, m1 = 0.f, m2 = 0.f, m3 = 0.f;
        if (DYN) { if (tid == 0) slot[par ^ 1] = taken < maxu ? (int)__hip_atomic_fetch_add(ctr, 1u, __ATOMIC_RELAXED, __HIP_MEMORY_SCOPE_AGENT) : 0x7fffffff; }
#pragma unroll
        for (int i = 0; i < 32; ++i) { m0 = fmaxf(m0, fabsf(L[i].x)); m1 = fmaxf(m1, fabsf(L[i].y)); m2 = fmaxf(m2, fabsf(L[i].z)); m3 = fmaxf(m3, fabsf(L[i].w)); }
        QW(x, 0); QW(y, 1); QW(z, 2); QW(w, 3);
        atomicMax(&cmax[c4 + 0], __float_as_uint(m0)); atomicMax(&cmax[c4 + 1], __float_as_uint(m1)); atomicMax(&cmax[c4 + 2], __float_as_uint(m2)); atomicMax(&cmax[c4 + 3], __float_as_uint(m3));
        __syncthreads();
        const int un = DYN ? slot[par ^ 1] : u + nb; const bool has = un < nun;
        QUnit dn = d; if (has) dn = quant_desc(ubase + un, wgu, wdn, q8gu, q8dn, sgu, sdn, wout, q8out, sout, qx);
        QLD(dn, has);
        if (tid < 32) cmaxb[(par ^ 1) * 32 + tid] = 0u;
        const float x0 = __uint_as_float(cmax[c4 + 0]), x1 = __uint_as_float(cmax[c4 + 1]), x2 = __uint_as_float(cmax[c4 + 2]), x3 = __uint_as_float(cmax[c4 + 3]);
        const unsigned i0 = QINV(x0), i1 = QINV(x1), i2 = QINV(x2), i3 = QINV(x3);
        QS(0, 0, i0); QS(1, 0, i1); QS(2, 0, i2); QS(3, 0, i3);
        QS(0, 1, i0); QS(1, 1, i1); QS(2, 1, i2); QS(3, 1, i3);
        if (tid < 32) { const float mx = __uint_as_float(cmax[tid]); const unsigned ih = QINV(mx); d.sc[d.n0 + tid] = mx > 0.f ? 1.f / (float)(__builtin_bit_cast(h2v, ih)[0]) : 1.f; }
        if (!has) break;
        u = un; d = dn; par ^= 1; ++taken;
        __syncthreads();
    }
    __syncthreads();
#undef QLD
#undef QPK
#undef QW
#undef QINV
#undef QF
#undef QS
}
__host__ __device__ constexpr int q_cnt(int k) { return k == 1 ? 1536 : k == 2 ? 768 : k == 3 ? 512 : k == 4 ? 512 : k == 5 ? 256 : k == 6 ? 256 : k == 7 ? 256 : k == 8 ? 2048 : 0; }
__host__ __device__ constexpr int q_beg(int k) { int s = 0; for (int i = 0; i < k; ++i) s += q_cnt(i); return s; }
static_assert(q_beg(8) == NE * 128 && q_beg(10) == NE * 192, "quota tables");
constexpr size_t CTL_QCTR = 20480;

__device__ __forceinline__ const float* karg_in(int i) {
    const __attribute__((address_space(4))) char* ka = (const __attribute__((address_space(4))) char*)__builtin_amdgcn_kernarg_segment_ptr();
    asm volatile("" : "+s"(ka));
    return *(const float* const __attribute__((address_space(4)))*)(ka + 8 * i);
}
#define DEFPTRS unsigned char* wsl_ = p.ws; asm volatile("" : "+s"(wsl_)); unsigned char* ws = wsl_; (void)ws; unsigned* ctl = (unsigned*)(wsl_ + WS_CTL); int* cnt = (int*)(wsl_ + CTL_CNT); float* proj = (float*)(wsl_ + WS_PROJ); float* kvmem = (float*)(wsl_ + WS_KVMEM); float* bias1 = (float*)(wsl_ + WS_BIAS1); float* hid = (float*)(wsl_ + WS_HID); float* kc = (float*)(wsl_ + WS_KC); float* vc = (float*)(wsl_ + WS_VC); float* pooled = (float*)(wsl_ + WS_POOLED); _Float16* opool = (_Float16*)(wsl_ + WS_OPOOL); _Float16* owin = (_Float16*)(wsl_ + WS_OWIN); _Float16* ocmp = (_Float16*)(wsl_ + WS_OCMP); _Float16* oslc = (_Float16*)(wsl_ + WS_OSLC); unsigned* sel = (unsigned*)(wsl_ + WS_SEL); _Float16* omem = (_Float16*)(wsl_ + WS_OMEM); _Float16* cat16 = (_Float16*)(wsl_ + WS_CAT16); _Float16* hpre16 = (_Float16*)(wsl_ + WS_HPRE); float* hbuf = (float*)(wsl_ + WS_H); float* gate = (float*)(wsl_ + WS_GATE); int* list = (int*)(wsl_ + WS_LIST); unsigned char* actf8 = (unsigned char*)(wsl_ + WS_ACT16); unsigned char* yf8 = (unsigned char*)(wsl_ + WS_Y16); _Float16* h16 = (_Float16*)(wsl_ + WS_H16); _Float16* x16 = (_Float16*)(wsl_ + WS_X16); _Float16* wtin = (_Float16*)(wsl_ + WS_WTIN); _Float16* wtout = (_Float16*)(wsl_ + WS_WTOUT); _Float16* wtgu = (_Float16*)(wsl_ + WS_WTGU); _Float16* wtdn = (_Float16*)(wsl_ + WS_WTDN); _Float16* proj16 = (_Float16*)(wsl_ + WS_PROJ16); _Float16* kvmem16 = (_Float16*)(wsl_ + WS_KVMEM16); _Float16* wt1 = (_Float16*)(wsl_ + WS_WT1); float* uv = (float*)(wsl_ + WS_UV); _Float16* kc16 = (_Float16*)(wsl_ + WS_KC16); _Float16* vc16 = (_Float16*)(wsl_ + WS_VC16); _Float16* wr16 = (_Float16*)(wsl_ + WS_WR16); _Float16* mem16 = (_Float16*)(wsl_ + WS_MEM16); _Float16* wtmkv = (_Float16*)(wsl_ + WS_WTMKV); _Float16* kv16 = (_Float16*)(wsl_ + WS_KV16); _Float16* wt2 = (_Float16*)(wsl_ + WS_WT2); float* sa2 = (float*)(wsl_ + WS_SA2); float* gate2 = (float*)(wsl_ + WS_GATE2); signed char* x8 = (signed char*)(wsl_ + WS_X8); float* sxa = (float*)(wsl_ + WS_SXA); signed char* q8in = (signed char*)(wsl_ + WS_Q8IN); float* sin8 = (float*)(wsl_ + WS_SIN8); signed char* q8mkv = (signed char*)(wsl_ + WS_Q8MKV); float* smkv = (float*)(wsl_ + WS_SMKV); signed char* q8out = (signed char*)(wsl_ + WS_Q8OUT); float* sout = (float*)(wsl_ + WS_SOUT); signed char* cat8 = (signed char*)(wsl_ + WS_CAT8); float* scat = (float*)(wsl_ + WS_SCAT); signed char* q8gu = (signed char*)(wsl_ + WS_Q8GU); signed char* q8dn = (signed char*)(wsl_ + WS_Q8DN); float* sgu = (float*)(wsl_ + WS_SGU); float* sdn = (float*)(wsl_ + WS_SDN); signed char* h8q = (signed char*)(wsl_ + WS_H8); float* sah = (float*)(wsl_ + WS_SAH); signed char* act8 = (signed char*)(wsl_ + WS_ACT8); float* sact = (float*)(wsl_ + WS_SACT);
__global__ void __launch_bounds__(512, 2) fwd(Params p) {
    extern __shared__ __attribute__((aligned(16))) char smem[];
    int tidk_ = threadIdx.x; asm volatile("" : "+v"(tidk_));
    const int tid = tidk_, wv = __builtin_amdgcn_readfirstlane(tid >> 6);
#define LANE_NOW ({ int _t = threadIdx.x; asm volatile("" : "+v"(_t)); _t & 63; })
    const int bid = blockIdx.x, nb = gridDim.x;
    const int gw = bid * 8 + wv, nw = nb * 8;
    const int lo = (int)(p.lo_hi & 0xffffffffll), hi = (int)(p.lo_hi >> 32);
    unsigned char* ws = p.ws;
    unsigned* ctl = (unsigned*)(ws + WS_CTL);
    int* cnt = (int*)(ws + CTL_CNT);
    float* proj = (float*)(ws + WS_PROJ);
    float* kvmem = (float*)(ws + WS_KVMEM);
    float* bias1 = (float*)(ws + WS_BIAS1);
    float* hid = (float*)(ws + WS_HID);
    float* kc = (float*)(ws + WS_KC);
    float* vc = (float*)(ws + WS_VC);
    float* pooled = (float*)(ws + WS_POOLED);
    _Float16* opool = (_Float16*)(ws + WS_OPOOL);
    _Float16* owin = (_Float16*)(ws + WS_OWIN);
    _Float16* ocmp = (_Float16*)(ws + WS_OCMP);
    _Float16* oslc = (_Float16*)(ws + WS_OSLC);
    unsigned* sel = (unsigned*)(ws + WS_SEL);
    _Float16* omem = (_Float16*)(ws + WS_OMEM);
    _Float16* cat16 = (_Float16*)(ws + WS_CAT16);
    _Float16* hpre16 = (_Float16*)(ws + WS_HPRE);
    float* hbuf = (float*)(ws + WS_H);
    float* gate = (float*)(ws + WS_GATE);
    int* list = (int*)(ws + WS_LIST);
    unsigned char* actf8 = (unsigned char*)(ws + WS_ACT16);
    unsigned char* yf8 = (unsigned char*)(ws + WS_Y16);
    _Float16* h16 = (_Float16*)(ws + WS_H16);
    _Float16* x16 = (_Float16*)(ws + WS_X16);
    _Float16* wtin = (_Float16*)(ws + WS_WTIN);
    _Float16* wtout = (_Float16*)(ws + WS_WTOUT);
    _Float16* wtgu = (_Float16*)(ws + WS_WTGU);
    _Float16* wtdn = (_Float16*)(ws + WS_WTDN);
    LAS unsigned char* lds = (LAS unsigned char*)smem;
    _Float16* proj16 = (_Float16*)(ws + WS_PROJ16);
    _Float16* kvmem16 = (_Float16*)(ws + WS_KVMEM16);
    _Float16* wt1 = (_Float16*)(ws + WS_WT1);
    float* uv = (float*)(ws + WS_UV);
    _Float16* kc16 = (_Float16*)(ws + WS_KC16);
    _Float16* vc16 = (_Float16*)(ws + WS_VC16);
    _Float16* wr16 = (_Float16*)(ws + WS_WR16);
    _Float16* mem16 = (_Float16*)(ws + WS_MEM16);
    _Float16* wtmkv = (_Float16*)(ws + WS_WTMKV);
    _Float16* kv16 = (_Float16*)(ws + WS_KV16);
    _Float16* wt2 = (_Float16*)(ws + WS_WT2);
    float* sa2 = (float*)(ws + WS_SA2); float* gate2 = (float*)(ws + WS_GATE2);
    signed char* x8 = (signed char*)(ws + WS_X8); float* sxa = (float*)(ws + WS_SXA); signed char* q8in = (signed char*)(ws + WS_Q8IN); float* sin8 = (float*)(ws + WS_SIN8);
    signed char* q8mkv = (signed char*)(ws + WS_Q8MKV); float* smkv = (float*)(ws + WS_SMKV);
    signed char* q8out = (signed char*)(ws + WS_Q8OUT); float* sout = (float*)(ws + WS_SOUT); signed char* cat8 = (signed char*)(ws + WS_CAT8); float* scat = (float*)(ws + WS_SCAT);
    signed char* q8gu = (signed char*)(ws + WS_Q8GU); signed char* q8dn = (signed char*)(ws + WS_Q8DN);
    float* sgu = (float*)(ws + WS_SGU); float* sdn = (float*)(ws + WS_SDN);
    signed char* h8q = (signed char*)(ws + WS_H8); float* sah = (float*)(ws + WS_SAH);
    signed char* act8 = (signed char*)(ws + WS_ACT8); float* sact = (float*)(ws + WS_SACT);
    const int vcu = (nb % 8 == 0) ? (bid % 8) * (nb / 8) + bid / 8 : bid;

    volatile LAS unsigned* xbw = (volatile LAS unsigned*)(smem + LDS_BYTES - 16);
    if (tid == 0) { xbw[0] = 0u; xbw[1] = 0u; xbw[2] = 0u; xbw[3] = 0u; }
    __syncthreads();
    XcdBarrier bar; bar.bar = ctl; bar.x = 0; bar.st = xbw;
    const bool multi = (hi - lo) > 1;
    if (multi) bar = xcd_barrier_post(ctl, xbw);
#define IN(k) (lo <= (k) && (k) < hi)
#define SEAM(k) do { if (IN(k) && IN((k) + 1)) xcd_barrier(bar); } while (0)
    float* sw = (float*)smem + wv * WLDS_FLOATS;
    const int qgrp = bid >> 3;
#define QDYN(k, mx) do { constexpr int qb_ = q_beg(k), qc_ = q_cnt(k); const QExtra qxd{nullptr, q8in, sin8, nullptr, q8mkv, smkv}; quant_units<true>(smem, karg_in(I_WGU), karg_in(I_WDN), q8gu, q8dn, sgu, sdn, nullptr, q8out, sout, qxd, qb_, qc_, (unsigned*)(ws + CTL_QCTR) + 16 * (k), (mx), bid, nb); } while (0)
#define QSLOT(k, sl, ns, share) QDYN(k, (qgrp % (ns)) == (sl) ? (share) : 0)
#define QPOST(k) do { __syncthreads(); QDYN(k, 1 << 30); } while (0)
    int* segw = (int*)(sw + 4096 + 512);

    if (IN(0)) {
        DEFPTRS;
        const int lane = LANE_NOW; (void)lane;
        if (wv == 0 && (bid & 1) == 0 && (bid >> 1) < 128) {
            const int task = bid >> 1, kv = task >> 6, jg = (task >> 4) & 3, kc = task & 15;
            const float* pos = p.in[kv ? I_POSV : I_POSK] + kc * 256; const float* w1 = p.in[kv ? I_W1V : I_W1K] + (size_t)kc * 256 * 256 + jg * 64 + lane;
            float s0 = 0.f, s1 = 0.f, s2 = 0.f, s3 = 0.f;
            for (int k = 0; k < 256; k += 4) { s0 += pos[k] * w1[(size_t)k * 256]; s1 += pos[k + 1] * w1[(size_t)(k + 1) * 256]; s2 += pos[k + 2] * w1[(size_t)(k + 2) * 256]; s3 += pos[k + 3] * w1[(size_t)(k + 3) * 256]; }
            bias1[(kv * 16 + kc) * 256 + jg * 64 + lane] = (s0 + s1) + (s2 + s3);
        }
        for (int i = bid * 512 + tid; i < 2 * 128 * 256; i += nb * 512) { const int kv = i >> 15, d = (i >> 8) & 127, n = i & 255; wt2[i] = (_Float16)p.in[kv ? I_W2V : I_W2K][(size_t)n * 128 + d]; }
        for (int i = bid * 512 + tid; i < 32 * 2048; i += nb * 512) { const int e = i >> 11, d = i & 2047; wr16[i] = (_Float16)p.in[I_WR][(size_t)d * 32 + e]; }
        {
            for (int row0 = gw; row0 < T_ + 2048; row0 += nw * 2) {
                float4 raw[2][8];
#pragma unroll
                for (int i = 0; i < 2; ++i) { const int row = row0 + i * nw; const float* src = row < T_ ? p.in[I_X] + (size_t)row * 2048 : p.in[I_MEM] + (size_t)(row - T_) * 2048;
#pragma unroll
                    for (int c = 0; c < 4; ++c) { raw[i][2 * c] = make_float4(0.f, 0.f, 0.f, 0.f); raw[i][2 * c + 1] = raw[i][2 * c];
                        if (row < T_ + 2048) { raw[i][2 * c] = *(const float4*)(src + (lane + 64 * c) * 8); raw[i][2 * c + 1] = *(const float4*)(src + (lane + 64 * c) * 8 + 4); } } }
#pragma unroll
                for (int i = 0; i < 2; ++i) { const int row = row0 + i * nw;
                    float amax = 0.f;
#pragma unroll
                    for (int k = 0; k < 8; ++k) amax = fmaxf(amax, fmaxf(fmaxf(fabsf(raw[i][k].x), fabsf(raw[i][k].y)), fmaxf(fabsf(raw[i][k].z), fabsf(raw[i][k].w))));
                    amax = wave_max(amax);
                    if (row < T_ + 2048) {
                        const float qinv = amax > 0.f ? 127.f / amax : 0.f;
                        if (lane == 0) sxa[row] = amax > 0.f ? amax / 127.f : 1.f;
#pragma unroll
                        for (int c = 0; c < 4; ++c) { const float4 a = raw[i][2 * c], b2 = raw[i][2 * c + 1];
                            uint2 q; q.x = pack4_i8(a.x * qinv, a.y * qinv, a.z * qinv, a.w * qinv); q.y = pack4_i8(b2.x * qinv, b2.y * qinv, b2.z * qinv, b2.w * qinv);
                            *(uint2*)(x8 + (size_t)row * 2048 + (lane + 64 * c) * 8) = q;
                            if (row < T_) { h8 o; o[0] = (_Float16)a.x; o[1] = (_Float16)a.y; o[2] = (_Float16)a.z; o[3] = (_Float16)a.w; o[4] = (_Float16)b2.x; o[5] = (_Float16)b2.y; o[6] = (_Float16)b2.z; o[7] = (_Float16)b2.w;
                                *(h8*)(x16 + (size_t)row * 2048 + (lane + 64 * c) * 8) = o; } } }
                }
            }
        }
        {
            const QExtra qx{p.in[I_WIN], q8in, sin8, p.in[I_WMEMKV], q8mkv, smkv};
            quant_units<false>(smem, p.in[I_WGU], p.in[I_WDN], q8gu, q8dn, sgu, sdn, p.in[I_WOUT], q8out, sout, qx, NE * 192, 64 + 73 + 32, nullptr, 0, bid, nb);
            __syncthreads();
            conv_all((float*)smem, p.in[I_WIN], p.in[I_W1K], p.in[I_W1V], p.in[I_WMEMKV], wtin, wt1, wtmkv, bid, nb);
            __syncthreads();
        }
    }
    SEAM(0);
    if (IN(1)) {
        DEFPTRS;
        const int lane = LANE_NOW; (void)lane;
        const int qs1 = (bid < 16 || (bid >= 64 && bid < 104)) ? 1 : (bid < 64 ? 4 : 8);
        QSLOT(1, 0, 3, qs1);
        { g8::ProbInF P{x16, proj16, nb, bid}; g8::gemm_phase(lds, P); }
        __syncthreads();
        QSLOT(1, 1, 3, qs1);
        { g8::ProbIn8 P{x8, proj16, sxa, nb, (bid + 192) & 255}; g8::gemm_phase(lds, P); }
        __syncthreads();
        QSLOT(1, 2, 3, qs1);
        QPOST(1);
    }
    SEAM(1);
    if (IN(2)) {
        DEFPTRS;
        const int lane = LANE_NOW; (void)lane;
        QSLOT(2, 0, 5, 3);
        { g8::ProbCmp P{kv16, wt1, uv, nb, bid}; g8::gemm_phase(lds, P); __syncthreads(); }
        for (int i = bid * 512 + tid; i < T_ * 64; i += nb * 512) {
            const int chn = i & 63, row = i >> 6, t = row & (S_ - 1), g = chn >> 4;
            const int win = 2 << g, n = min(win, t + 1);
            const _Float16* src = proj16 + (size_t)row * INW + C_UP + chn * 8;
            float a[8];
            const h8 cur = *(const h8*)src;
            h8 vv[15];
#pragma unroll
            for (int k = 0; k < 15; ++k) { vv[k] = (h8){0, 0, 0, 0, 0, 0, 0, 0}; if (k + 1 < n) vv[k] = *(const h8*)(src - (size_t)(k + 1) * INW); }
#pragma unroll
            for (int q = 0; q < 8; ++q) a[q] = (float)cur[q];
#pragma unroll
            for (int k = 0; k < 15; ++k) {
#pragma unroll
                for (int q = 0; q < 8; ++q) a[q] += (float)vv[k][q]; }
            const float rn = 1.f / (float)n;
            float4 o0, o1;
            o0.x = a[0] * rn - (float)cur[0]; o0.y = a[1] * rn - (float)cur[1]; o0.z = a[2] * rn - (float)cur[2]; o0.w = a[3] * rn - (float)cur[3];
            o1.x = a[4] * rn - (float)cur[4]; o1.y = a[5] * rn - (float)cur[5]; o1.z = a[6] * rn - (float)cur[6]; o1.w = a[7] * rn - (float)cur[7];
            *(float4*)(pooled + (size_t)row * 512 + chn * 8) = o0; *(float4*)(pooled + (size_t)row * 512 + chn * 8 + 4) = o1;
        }
        __syncthreads();
        QSLOT(2, 1, 5, 3);
        {
            const int r32 = lane & 31, hi = lane >> 5, g = wv >> 1, half = wv & 1;
            for (int uu = vcu; uu < 512; uu += nb) {
                const int v = uu & 255, bk = v >> 4, qi = (uu >> 8) ? 31 - (v & 15) : (v & 15), b = bk >> 1, kvh = bk & 1;
                const int t = qi * 64 + half * 32 + r32;
                const int lo_t = max(0, qi - 8);
                const unsigned tmask = (unsigned)(((1ull << (qi + 1)) - 1ull) & ~((1ull << lo_t) - 1ull));
                at8::attn_unit(smem, proj16 + (size_t)(b * S_ + t) * INW + C_Q + (kvh * 4 + g) * 128 + hi * 8,
                               kv16 + ((size_t)(4 * B_ + b) * 2 + kvh) * KVSEG, kv16 + ((size_t)(5 * B_ + b) * 2 + kvh) * KVSEG, 128, tmask, 512, t, 0xffffffffu,
                               owin + (size_t)(b * S_ + qi * 64 + half * 32) * 1024 + (kvh * 4 + g) * 128, 1024);
                QSLOT(2, 2 + (uu >> 8), 5, 3);
            }
            for (int u = vcu; u < 256; u += nb) {
                const int b = u >> 5, h = (u >> 3) & 3, qt = u & 7;
                const int t = qt * 256 + wv * 32 + r32;
                at8::attn_unit(smem, proj16 + (size_t)(b * S_ + t) * INW + C_QM + h * 128 + hi * 8,
                               kvmem16 + (size_t)b * 256 * 1024 + h * 128, kvmem16 + (size_t)b * 256 * 1024 + 512 + h * 128, 1024, 0xFu, 0, 255, 0xffffffffu,
                               omem + (size_t)(b * S_ + qt * 256 + wv * 32) * 512 + h * 128, 512);
            }
        }
        QPOST(2);
    }
    SEAM(2);
    if (IN(3)) {
        DEFPTRS;
        const int lane = LANE_NOW; (void)lane;
        QSLOT(3, 0, 3, 2);
        {
            float* bsum = (float*)smem;
            _Float16* hs = (_Float16*)(smem + 4096);
            { const int kv = tid >> 8, n = tid & 255; float a = 0.f;
#pragma unroll
              for (int kc = 0; kc < 16; ++kc) a += bias1[(kv * 16 + kc) * 256 + n];
              bsum[tid] = a; }
            __syncthreads();
            const int fr = lane & 15, fq = lane >> 4;
            for (int u = bid; u < 256; u += nb) {
                const int kv = u >> 7, rt = u & 127;
#pragma unroll
                for (int q = 0; q < 8; ++q) { const int e = tid + 512 * q, i = e >> 8, n = e & 255;
                    const int row = rt * 16 + i, c = (row >> 1) & 127;
                    float a = 0.f;
                    if (c != 127) { a = bsum[kv * 256 + n];
#pragma unroll
                        for (int sp = 0; sp < 4; ++sp) { const float* base = uv + ((size_t)(kv * 4 + sp) * 2048) * 512; a += base[(size_t)row * 512 + n] + base[(size_t)(row + 2) * 512 + 256 + n]; }
                        a = gelu_fast(a); }
                    hs[i * 264 + n] = (_Float16)a; }
                __syncthreads();
                { const _Float16* bp = wt2 + ((size_t)kv * 128 + wv * 16 + fr) * 256 + fq * 8;
                  f4 acc = (f4){0.f, 0.f, 0.f, 0.f};
#pragma unroll
                  for (int sI = 0; sI < 8; ++sI) { const h8 a = *(const h8*)(hs + fr * 264 + sI * 32 + fq * 8), bb = *(const h8*)(bp + sI * 32); acc = __builtin_amdgcn_mfma_f32_16x16x32_f16(a, bb, acc, 0, 0, 0); }
                  _Float16* dst = kv ? vc16 : kc16;
#pragma unroll
                  for (int j = 0; j < 4; ++j) { const int row = rt * 16 + fq * 4 + j; dst[(size_t)row * 128 + wv * 16 + fr] = (((row >> 1) & 127) == 127) ? (_Float16)0.f : (_Float16)acc[j]; } }
                __syncthreads();
            }
        }
        QSLOT(3, 1, 3, 2);
        for (int u = bid; u < 128 * 4; u += nb) { const int g = u >> 7, mt = u & 127;
            ARowPlain af{pooled + g * 128, 512, mt * 128, T_}; EpiPool ef{opool, p.in[I_POOLS], mt * 128, g};
            gemm_tile(smem, 128, af, p.in[I_POOLW] + (size_t)g * 128 * 128, 128, 0, 128, false, ef);
        }
        QPOST(3);
    }
    SEAM(3);
    if (IN(4)) {
        DEFPTRS;
        const int lane = LANE_NOW; (void)lane;
        QSLOT(4, 0, 3, 2);
        const int r32 = lane & 31, hi = lane >> 5, g = wv >> 1, half = wv & 1;
        for (int uu = vcu; uu < 512; uu += nb) {
            const int v = uu & 255, bk = v >> 4, qi = (uu >> 8) ? 31 - (v & 15) : (v & 15), b = bk >> 1, kvh = bk & 1;
            const int tl = half * 32 + r32, t = qi * 64 + tl;
            at8::cmp_slc_unit(smem, proj16 + (size_t)(b * S_ + t) * INW + C_Q + (kvh * 4 + g) * 128 + hi * 8,
                              kc16 + (size_t)(b * 128 * 2 + kvh) * 128, vc16 + (size_t)(b * 128 * 2 + kvh) * 128,
                              kv16 + ((size_t)(2 * B_ + b) * 2 + kvh) * KVSEG, kv16 + ((size_t)(3 * B_ + b) * 2 + kvh) * KVSEG, t, tl, g, qi,
                              ocmp + (size_t)(b * S_ + qi * 64 + half * 32) * 1024 + (kvh * 4 + g) * 128, oslc + (size_t)(b * S_ + qi * 64 + half * 32) * 1024 + (kvh * 4 + g) * 128);
            QSLOT(4, 1 + (uu >> 8), 3, 2);
        }
        QPOST(4);
    }
    SEAM(4);
    if (IN(5)) {
        DEFPTRS;
        QSLOT(5, 0, 2, 1);
        const int lane = LANE_NOW;
        for (int row = gw; row < T_; row += nw) {
            const _Float16* pr = proj16 + (size_t)row * INW + C_G;
            float v[32]; float ss = 0.f;
#pragma unroll
            for (int c = 0; c < 2; ++c) { const int col = (lane + 64 * c) * 8, h = col >> 7; const size_t o = (size_t)row * 1024 + col;
                const float g0 = sigmoidf_((float)pr[h * 3]), g1 = sigmoidf_((float)pr[h * 3 + 1]), g2 = sigmoidf_((float)pr[h * 3 + 2]);
                const h8 a = *(const h8*)(ocmp + o), b2 = *(const h8*)(oslc + o), c2 = *(const h8*)(owin + o);
#pragma unroll
                for (int q = 0; q < 8; ++q) { const float x = g0 * (float)a[q] + g1 * (float)b2[q] + g2 * (float)c2[q]; v[c * 8 + q] = x; ss += x * x; } }
            ss = wave_sum(ss); float r = rsqrtf(ss / 1024.f + LN_EPS);
#pragma unroll
            for (int c = 0; c < 2; ++c) { const int col = (lane + 64 * c) * 8; const float4 ga = *(const float4*)(p.in[I_GNNSA] + col), gb = *(const float4*)(p.in[I_GNNSA] + col + 4);
                v[c * 8 + 0] *= r * ga.x; v[c * 8 + 1] *= r * ga.y; v[c * 8 + 2] *= r * ga.z; v[c * 8 + 3] *= r * ga.w; v[c * 8 + 4] *= r * gb.x; v[c * 8 + 5] *= r * gb.y; v[c * 8 + 6] *= r * gb.z; v[c * 8 + 7] *= r * gb.w; }
            { const h8 a = *(const h8*)(opool + (size_t)row * 512 + lane * 8); ss = 0.f;
#pragma unroll
              for (int q = 0; q < 8; ++q) { v[16 + q] = (float)a[q]; ss += v[16 + q] * v[16 + q]; }
              ss = wave_sum(ss); r = rsqrtf(ss / 512.f + LN_EPS);
              const float4 ga = *(const float4*)(p.in[I_GNPOOL] + lane * 8), gb = *(const float4*)(p.in[I_GNPOOL] + lane * 8 + 4);
              v[16] *= r * ga.x; v[17] *= r * ga.y; v[18] *= r * ga.z; v[19] *= r * ga.w; v[20] *= r * gb.x; v[21] *= r * gb.y; v[22] *= r * gb.z; v[23] *= r * gb.w; }
            { const h8 a = *(const h8*)(omem + (size_t)row * 512 + lane * 8); ss = 0.f;
#pragma unroll
              for (int q = 0; q < 8; ++q) { v[24 + q] = (float)a[q]; ss += v[24 + q] * v[24 + q]; }
              ss = wave_sum(ss); r = rsqrtf(ss / 512.f + LN_EPS);
              const float4 ga = *(const float4*)(p.in[I_GNMEM] + lane * 8), gb = *(const float4*)(p.in[I_GNMEM] + lane * 8 + 4);
              v[24] *= r * ga.x; v[25] *= r * ga.y; v[26] *= r * ga.z; v[27] *= r * ga.w; v[28] *= r * gb.x; v[29] *= r * gb.y; v[30] *= r * gb.z; v[31] *= r * gb.w; }
            float amax = 0.f;
#pragma unroll
            for (int k = 0; k < 32; ++k) amax = fmaxf(amax, fabsf(v[k]));
            amax = wave_max(amax);
            const float qinv = amax > 0.f ? 127.f / amax : 0.f;
            if (lane == 0) scat[row] = amax > 0.f ? amax / 127.f : 1.f;
#pragma unroll
            for (int c = 0; c < 4; ++c) { const int col = c < 2 ? (lane + 64 * c) * 8 : (c == 2 ? 1024 + lane * 8 : 1536 + lane * 8);
                uint2 q; q.x = pack4_i8(v[c * 8 + 0] * qinv, v[c * 8 + 1] * qinv, v[c * 8 + 2] * qinv, v[c * 8 + 3] * qinv); q.y = pack4_i8(v[c * 8 + 4] * qinv, v[c * 8 + 5] * qinv, v[c * 8 + 6] * qinv, v[c * 8 + 7] * qinv);
                *(uint2*)(cat8 + (size_t)row * 2048 + col) = q; }
        }
        QPOST(5);
    }
    SEAM(5);
    if (IN(6)) {
        DEFPTRS;
        const int lane = LANE_NOW; (void)lane;
        QSLOT(6, 0, 2, 1);
        { g8::ProbOut P{cat8, q8out, hpre16, x16, scat, sout, nb, bid};
          g8::gemm_phase(lds, P); }
        QPOST(6);
    }
    SEAM(6);
    if (IN(7)) {
        DEFPTRS;
        const int lane = LANE_NOW; (void)lane;
        QSLOT(7, 0, 2, 1);
        float* lg = (float*)smem;
        const int r32 = lane & 31, hi = lane >> 5, fr = lane & 15, fq = lane >> 4;
        for (int u = bid; u < T_ / 64; u += nb) {
            const int base = u * 64;
            h8 raw[8][4];
#pragma unroll
            for (int i = 0; i < 8; ++i)
#pragma unroll
                for (int c = 0; c < 4; ++c) raw[i][c] = *(const h8*)(hpre16 + (size_t)(base + wv * 8 + i) * 2048 + (lane + 64 * c) * 8);
#pragma unroll
            for (int i = 0; i < 8; ++i) {
                const int row = base + wv * 8 + i;
                float v[32]; float s = 0.f;
#pragma unroll
                for (int c = 0; c < 4; ++c) {
#pragma unroll
                    for (int q = 0; q < 8; ++q) { v[c * 8 + q] = (float)raw[i][c][q]; s += v[c * 8 + q]; } }
                const float mu = wave_sum(s) / 2048.f; float q2 = 0.f;
#pragma unroll
                for (int k = 0; k < 32; ++k) { const float d = v[k] - mu; q2 += d * d; }
                const float rs = rsqrtf(wave_sum(q2) / 2048.f + LN_EPS);
                float amax = 0.f;
#pragma unroll
                for (int c = 0; c < 4; ++c) { const int col = (lane + 64 * c) * 8;
                    const float4 g0 = *(const float4*)(p.in[I_LN1G] + col), g1 = *(const float4*)(p.in[I_LN1G] + col + 4), b0 = *(const float4*)(p.in[I_LN1B] + col), b1 = *(const float4*)(p.in[I_LN1B] + col + 4);
                    float4 o0, o1;
                    o0.x = (v[c * 8 + 0] - mu) * rs * g0.x + b0.x; o0.y = (v[c * 8 + 1] - mu) * rs * g0.y + b0.y; o0.z = (v[c * 8 + 2] - mu) * rs * g0.z + b0.z; o0.w = (v[c * 8 + 3] - mu) * rs * g0.w + b0.w;
                    o1.x = (v[c * 8 + 4] - mu) * rs * g1.x + b1.x; o1.y = (v[c * 8 + 5] - mu) * rs * g1.y + b1.y; o1.z = (v[c * 8 + 6] - mu) * rs * g1.z + b1.z; o1.w = (v[c * 8 + 7] - mu) * rs * g1.w + b1.w;
                    h8 oh; oh[0] = (_Float16)o0.x; oh[1] = (_Float16)o0.y; oh[2] = (_Float16)o0.z; oh[3] = (_Float16)o0.w; oh[4] = (_Float16)o1.x; oh[5] = (_Float16)o1.y; oh[6] = (_Float16)o1.z; oh[7] = (_Float16)o1.w;
                    *(h8*)(h16 + (size_t)row * 2048 + col) = oh;
                    v[c * 8 + 0] = o0.x; v[c * 8 + 1] = o0.y; v[c * 8 + 2] = o0.z; v[c * 8 + 3] = o0.w; v[c * 8 + 4] = o1.x; v[c * 8 + 5] = o1.y; v[c * 8 + 6] = o1.z; v[c * 8 + 7] = o1.w;
                    amax = fmaxf(amax, fmaxf(fmaxf(fmaxf(fabsf(o0.x), fabsf(o0.y)), fmaxf(fabsf(o0.z), fabsf(o0.w))), fmaxf(fmaxf(fabsf(o1.x), fabsf(o1.y)), fmaxf(fabsf(o1.z), fabsf(o1.w))))); }
                amax = wave_max(amax);
                const float qinv = amax > 0.f ? 127.f / amax : 0.f;
                if (lane == 0) sah[row] = amax > 0.f ? amax / 127.f : 1.f;
#pragma unroll
                for (int c = 0; c < 4; ++c) { const int col = (lane + 64 * c) * 8;
                    uint2 q; q.x = pack4_i8(v[c * 8 + 0] * qinv, v[c * 8 + 1] * qinv, v[c * 8 + 2] * qinv, v[c * 8 + 3] * qinv); q.y = pack4_i8(v[c * 8 + 4] * qinv, v[c * 8 + 5] * qinv, v[c * 8 + 6] * qinv, v[c * 8 + 7] * qinv);
                    *(uint2*)(h8q + (size_t)row * 2048 + col) = q; }
            }
            asm volatile("s_waitcnt vmcnt(0)" ::: "memory");
            __syncthreads();
            {
                const int tok0 = base + 16 * (wv >> 1), e0 = 16 * (wv & 1);
                const _Float16* ap = h16 + (size_t)(tok0 + fr) * 2048 + fq * 8; const _Float16* bp = wr16 + (size_t)(e0 + fr) * 2048 + fq * 8;
                f4 acc = (f4){0.f, 0.f, 0.f, 0.f};
#pragma unroll 8
                for (int sI = 0; sI < 64; ++sI) { const h8 a = *(const h8*)(ap + sI * 32), bb = *(const h8*)(bp + sI * 32); acc = __builtin_amdgcn_mfma_f32_16x16x32_f16(a, bb, acc, 0, 0, 0); }
                const float br = p.in[I_BR][e0 + fr];
#pragma unroll
                for (int j = 0; j < 4; ++j) lg[(16 * (wv >> 1) + 4 * fq + j) * 33 + e0 + fr] = acc[j] + br;
            }
            __syncthreads();
#pragma unroll 1
            for (int it = 0; it < 4; ++it) {
                const int tk = 8 * wv + 2 * it + hi;
                const float iv = lg[tk * 33 + r32];
                int rank = 0;
                for (int i = 0; i < 32; ++i) { const float vi = __shfl(iv, i + 32 * hi); rank += (vi > iv || (vi == iv && i < r32)) ? 1 : 0; }
                float tv[4]; int te[4];
#pragma unroll
                for (int r = 0; r < 4; ++r) { const unsigned long long bm = __ballot(rank == r); const unsigned hm = (unsigned)(bm >> (32 * hi)); const int src = __ffs(hm) - 1; te[r] = src; tv[r] = __shfl(iv, src + 32 * hi); }
                const float e0v = 1.f, e1v = expf(tv[1] - tv[0]), e2v = expf(tv[2] - tv[0]), e3v = expf(tv[3] - tv[0]); const float inv = 1.f / (e0v + e1v + e2v + e3v);
                if (r32 < 4) { const int e = r32 == 0 ? te[0] : r32 == 1 ? te[1] : r32 == 2 ? te[2] : te[3]; const float g = (r32 == 0 ? e0v : r32 == 1 ? e1v : r32 == 2 ? e2v : e3v) * inv;
                    const int a = (base + tk) * 4 + r32; const int pos = atomicAdd(&cnt[e], 1); list[(size_t)e * T_ + pos] = a; gate[a] = g; gate2[(size_t)e * T_ + pos] = g; sa2[(size_t)e * T_ + pos] = sah[base + tk]; }
            }
            __syncthreads();
        }
        QPOST(7);
    }
    SEAM(7);
    LAS int* mtab = (LAS int*)(smem + g8::STAGE_BYTES);
    if (IN(8)) {
        DEFPTRS;
        const int lane = LANE_NOW; (void)lane;
        if (tid == 0) { int ub = 0, rs = 0;
            for (int e = 0; e < NE; ++e) { const int c = (int)__hip_atomic_load((unsigned*)&cnt[e], __ATOMIC_RELAXED, __HIP_MEMORY_SCOPE_AGENT); mtab[e] = c; mtab[32 + e] = ub; mtab[65 + e] = rs; ub += ((c + 255) >> 8) * 16; rs += c; }
            mtab[64] = ub; mtab[97] = rs; mtab[98] = ub; }
        __syncthreads();
        g8::moe_build(mtab, nb, vcu);
        __syncthreads();
        {
            const int total = mtab[98], nmine = total > vcu ? (total - vcu + nb - 1) / nb : 0, cut = (nmine * (qgrp & 7)) >> 3;
            { g8::ProbGu P{h8q, q8gu, actf8, p.in[I_BGU], list, sa2, sgu, g8::MoeTab{mtab, 16, 0, cut}, nb, vcu};
              g8::gemm_phase(lds, P); }
            __syncthreads();
            QDYN(8, 8);
            { g8::ProbGu P{h8q, q8gu, actf8, p.in[I_BGU], list, sa2, sgu, g8::MoeTab{mtab, 16, cut, 40}, nb, vcu};
              g8::gemm_phase(lds, P); }
        }
        QPOST(8);
    }
    SEAM(8);
    if (IN(9)) {
        DEFPTRS;
        const int lane = LANE_NOW;
        for (int row0 = gw; row0 < NA; row0 += nw * 8) {
            uint2 raw[8][4];
#pragma unroll
            for (int i = 0; i < 8; ++i)
#pragma unroll
                for (int c = 0; c < 4; ++c) raw[i][c] = *(const uint2*)(actf8 + (size_t)(row0 + i * nw) * 2048 + (lane + 64 * c) * 8);
#pragma unroll
            for (int i = 0; i < 8; ++i) { const int row = row0 + i * nw;
                float v[32]; float amax = 0.f;
#pragma unroll
                for (int c = 0; c < 4; ++c) { const uint2 a = raw[i][c];
                    dec4_fp8(a.x, v[c * 8 + 0], v[c * 8 + 1], v[c * 8 + 2], v[c * 8 + 3]); dec4_fp8(a.y, v[c * 8 + 4], v[c * 8 + 5], v[c * 8 + 6], v[c * 8 + 7]);
#pragma unroll
                    for (int q = 0; q < 8; ++q) amax = fmaxf(amax, fabsf(v[c * 8 + q])); }
                amax = wave_max(amax);
                const float qinv = amax > 0.f ? 127.f / amax : 0.f;
                if (lane == 0) sact[row] = amax > 0.f ? amax / 127.f : 1.f;
#pragma unroll
                for (int c = 0; c < 4; ++c) { uint2 q; q.x = pack4_i8(v[c * 8 + 0] * qinv, v[c * 8 + 1] * qinv, v[c * 8 + 2] * qinv, v[c * 8 + 3] * qinv); q.y = pack4_i8(v[c * 8 + 4] * qinv, v[c * 8 + 5] * qinv, v[c * 8 + 6] * qinv, v[c * 8 + 7] * qinv);
                    *(uint2*)(act8 + (size_t)row * 2048 + (lane + 64 * c) * 8) = q; }
            }
        }
    }
    SEAM(9);
    if (IN(10)) {
        DEFPTRS;
        const int lane = LANE_NOW; (void)lane;
        if (tid == 0) { int ub = 0, rs = 0;
            for (int e = 0; e < NE; ++e) { const int c = (int)__hip_atomic_load((unsigned*)&cnt[e], __ATOMIC_RELAXED, __HIP_MEMORY_SCOPE_AGENT); mtab[e] = c; mtab[32 + e] = ub; mtab[65 + e] = rs; ub += ((c + 255) >> 8) * 8; rs += c; }
            mtab[64] = ub; mtab[97] = rs; mtab[98] = ub; }
        __syncthreads();
        g8::moe_build(mtab, nb, vcu);
        __syncthreads();
        g8::ProbDn P{act8, q8dn, yf8, p.in[I_BDN], list, gate2, sact, sdn, g8::MoeTab{mtab, 8, 0, 40}, nb, vcu};
        g8::gemm_phase(lds, P);
        __syncthreads();
    }
    SEAM(10);
    if (IN(11)) {
        DEFPTRS;
        const int lane = LANE_NOW; (void)lane;
        for (int row0 = gw; row0 < T_; row0 += nw * 2) {
          h8 hraw[2][4]; uint2 yraw[2][4][4];
#pragma unroll
          for (int i = 0; i < 2; ++i)
#pragma unroll
            for (int c = 0; c < 4; ++c) { const int col = (lane + 64 * c) * 8; const size_t yo = (size_t)(row0 + i * nw) * 4 * 2048 + col;
                hraw[i][c] = *(const h8*)(h16 + (size_t)(row0 + i * nw) * 2048 + col);
                yraw[i][c][0] = *(const uint2*)(yf8 + yo); yraw[i][c][1] = *(const uint2*)(yf8 + yo + 2048); yraw[i][c][2] = *(const uint2*)(yf8 + yo + 4096); yraw[i][c][3] = *(const uint2*)(yf8 + yo + 6144); }
#pragma unroll
          for (int i = 0; i < 2; ++i) { const int row = row0 + i * nw;
            float v[32]; float s = 0.f;
#pragma unroll
            for (int c = 0; c < 4; ++c) {
                const h8 hh8 = hraw[i][c];
                const uint2 y0 = yraw[i][c][0], y1 = yraw[i][c][1], y2 = yraw[i][c][2], y3 = yraw[i][c][3];
                float ys[8], t0[8], t1[8], t2[8], t3[8];
                dec4_fp8(y0.x, t0[0], t0[1], t0[2], t0[3]); dec4_fp8(y0.y, t0[4], t0[5], t0[6], t0[7]); dec4_fp8(y1.x, t1[0], t1[1], t1[2], t1[3]); dec4_fp8(y1.y, t1[4], t1[5], t1[6], t1[7]);
                dec4_fp8(y2.x, t2[0], t2[1], t2[2], t2[3]); dec4_fp8(y2.y, t2[4], t2[5], t2[6], t2[7]); dec4_fp8(y3.x, t3[0], t3[1], t3[2], t3[3]); dec4_fp8(y3.y, t3[4], t3[5], t3[6], t3[7]);
#pragma unroll
                for (int q = 0; q < 8; ++q) ys[q] = (t0[q] + t1[q]) + (t2[q] + t3[q]);
#pragma unroll
                for (int q = 0; q < 8; ++q) { v[c * 8 + q] = DN_ALPHA * (float)hh8[q] + ys[q] * 0.0625f; s += v[c * 8 + q]; } }
            const float mu = wave_sum(s) / 2048.f; float q2 = 0.f;
#pragma unroll
            for (int i = 0; i < 32; ++i) { const float d = v[i] - mu; q2 += d * d; }
            const float rs = rsqrtf(wave_sum(q2) / 2048.f + LN_EPS);
#pragma unroll
            for (int c = 0; c < 4; ++c) { const int col = (lane + 64 * c) * 8;
                const float4 ga = *(const float4*)(p.in[I_LN2G] + col), gb = *(const float4*)(p.in[I_LN2G] + col + 4), ba = *(const float4*)(p.in[I_LN2B] + col), bb = *(const float4*)(p.in[I_LN2B] + col + 4);
                float4 o0, o1;
                o0.x = (v[c * 8 + 0] - mu) * rs * ga.x + ba.x; o0.y = (v[c * 8 + 1] - mu) * rs * ga.y + ba.y; o0.z = (v[c * 8 + 2] - mu) * rs * ga.z + ba.z; o0.w = (v[c * 8 + 3] - mu) * rs * ga.w + ba.w;
                o1.x = (v[c * 8 + 4] - mu) * rs * gb.x + bb.x; o1.y = (v[c * 8 + 5] - mu) * rs * gb.y + bb.y; o1.z = (v[c * 8 + 6] - mu) * rs * gb.z + bb.z; o1.w = (v[c * 8 + 7] - mu) * rs * gb.w + bb.w;
                *(float4*)(p.out + (size_t)row * 2048 + col) = o0; *(float4*)(p.out + (size_t)row * 2048 + col + 4) = o1; }
          }
        }
    }
}

constexpr int NPHASE = 12;

extern "C" void kernel_launch(void* const* d_in, const int* in_sizes, int n_in, void* d_out, int out_size, void* d_ws, size_t ws_size, hipStream_t stream) {
    static int grid = 0;
    if (grid == 0) {
        if (n_in != 26 || ws_size < WS_END) { fprintf(stderr, "kernel_launch: unexpected n_in %d or ws_size %zu (< %zu)\n", n_in, ws_size, (size_t)WS_END); grid = -1; return; }
        int dev = 0, cus = 0, per_cu = 0;
        hipGetDevice(&dev); hipDeviceGetAttribute(&cus, hipDeviceAttributeMultiprocessorCount, dev);
        if (hipFuncSetAttribute((const void*)fwd, hipFuncAttributeMaxDynamicSharedMemorySize, LDS_BYTES) != hipSuccess) { fprintf(stderr, "hipFuncSetAttribute failed\n"); grid = -1; return; }
        hipOccupancyMaxActiveBlocksPerMultiprocessor(&per_cu, (const void*)fwd, 512, LDS_BYTES);
        (void)hipGetLastError();
        if (per_cu < 1) fprintf(stderr, "occupancy query says %d blocks per CU\n", per_cu);
        grid = cus > 0 ? cus : 256;
    }
    if (grid < 0) return;
    hipMemsetAsync((char*)d_ws + WS_CTL, 0, CTL_BYTES, stream);
    Params p{};
    for (int i = 0; i < 26; ++i) p.in[i] = (const float*)d_in[i];
    p.out = (float*)d_out; p.ws = (unsigned char*)d_ws;
#if N_LAUNCH_MODE == 1
    p.lo_hi = (long long)0 | ((long long)NPHASE << 32);
    hipLaunchKernelGGL(fwd, dim3(grid), dim3(512), LDS_BYTES, stream, p);
#else
    for (int ph = 0; ph < NPHASE; ++ph) {
        p.lo_hi = (long long)ph | ((long long)(ph + 1) << 32);
        hipLaunchKernelGGL(fwd, dim3(grid), dim3(512), LDS_BYTES, stream, p);
    }
#endif
}
```

```cpp
#include <hip/hip_runtime.h>
#include <cstdio>
#include <cstdint>

#ifndef N_LAUNCH_MODE
#define N_LAUNCH_MODE 1
#endif

constexpr int B_ = 8, S_ = 2048, D_ = 2048, T_ = B_ * S_;
constexpr int INW = 3608;
constexpr int C_Q = 0, C_KC = 1024, C_VC = 1280, C_KS = 1536, C_VS = 1792, C_KW = 2048, C_VW = 2304, C_G = 2560, C_UP = 2584, C_QM = 3096;
constexpr int NC = 127;
constexpr int CROWS = B_ * NC * 2;
constexpr int NE = 32, DE = 2048, NA = T_ * 4;
constexpr float LN_EPS = 1e-5f;
constexpr float DN_ALPHA = 1.189207115002721f;
constexpr float ATT_SCALE = 0.08838834764831845f;

constexpr size_t al256(size_t x) { return (x + 255) & ~(size_t)255; }
constexpr size_t WS_CTL = 0;
constexpr size_t CTL_BYTES = 65536;
constexpr size_t CTL_CNT = 16384;
constexpr size_t WS_PROJ = CTL_BYTES;
constexpr size_t WS_KVMEM = WS_PROJ + al256((size_t)T_ * INW * 4);
constexpr size_t WS_BIAS1 = WS_KVMEM + al256((size_t)2048 * 1024 * 4);
constexpr size_t WS_HID = WS_BIAS1 + al256(2 * 16 * 256 * 4);
constexpr size_t WS_KC = WS_HID + al256((size_t)2 * 2048 * 256 * 4);
constexpr size_t WS_VC = WS_KC + al256((size_t)CROWS * 128 * 4);
constexpr size_t WS_POOLED = WS_VC + al256((size_t)CROWS * 128 * 4);
constexpr size_t WS_OPOOL = WS_POOLED + al256((size_t)T_ * 512 * 4);
constexpr size_t WS_OWIN = WS_OPOOL + al256((size_t)T_ * 512 * 4);
constexpr size_t WS_OCMP = WS_OWIN + al256((size_t)T_ * 1024 * 4);
constexpr size_t WS_OSLC = WS_OCMP + al256((size_t)T_ * 1024 * 4);
constexpr size_t WS_SEL = WS_OSLC + al256((size_t)T_ * 1024 * 4);
constexpr size_t WS_OMEM = WS_SEL + al256((size_t)T_ * 2 * 4);
constexpr size_t WS_CAT16 = WS_OMEM + al256((size_t)T_ * 512 * 4);
constexpr size_t WS_HPRE = WS_CAT16 + al256((size_t)T_ * 2048 * 2);
constexpr size_t WS_H = WS_HPRE + al256((size_t)T_ * 2048 * 4);
constexpr size_t WS_H16 = WS_H + al256((size_t)T_ * 2048 * 4);
constexpr size_t WS_GATE = WS_H16 + al256((size_t)T_ * 2048 * 2);
constexpr size_t WS_LIST = WS_GATE + al256((size_t)NA * 4);
constexpr size_t WS_ACT16 = WS_LIST + al256((size_t)NE * T_ * 4);
constexpr size_t WS_Y16 = WS_ACT16 + al256((size_t)(NA + 256) * 2048 * 2);
constexpr size_t WS_X16 = WS_Y16 + al256((size_t)NA * 2048 * 2);
constexpr size_t WS_MEM16 = WS_X16 + (size_t)T_ * 2048 * 2;
constexpr size_t WS_WTIN = WS_MEM16 + al256((size_t)2048 * 2048 * 2);
constexpr size_t WS_WTOUT = WS_WTIN + al256((size_t)3840 * 2048 * 2);
constexpr size_t WS_WTGU = WS_WTOUT + al256((size_t)2048 * 2048 * 2);
constexpr size_t WS_WTDN = WS_WTGU + al256((size_t)NE * 4096 * 2048 * 2);
constexpr size_t WS_PROJ16 = WS_WTDN + al256((size_t)NE * 2048 * 2048 * 2);
constexpr size_t WS_KVMEM16 = WS_PROJ16 + al256((size_t)(T_ + 64) * INW * 2);
constexpr size_t WS_WT1 = WS_KVMEM16 + al256((size_t)2048 * 1024 * 2);
constexpr size_t WS_UV = WS_WT1 + al256((size_t)2 * 512 * 2048 * 2);
constexpr size_t WS_KC16 = WS_UV + al256((size_t)2 * 4 * 2048 * 512 * 4);
constexpr size_t WS_VC16 = WS_KC16 + al256((size_t)B_ * 128 * 256 * 2);
constexpr size_t WS_WR16 = WS_VC16 + al256((size_t)B_ * 128 * 256 * 2);
constexpr size_t WS_Q8GU = WS_WR16 + al256((size_t)32 * 2048 * 2);
constexpr size_t WS_Q8DN = WS_Q8GU + al256((size_t)NE * 4096 * 2048);
constexpr size_t WS_SGU = WS_Q8DN + al256((size_t)NE * 2048 * 2048);
constexpr size_t WS_SDN = WS_SGU + al256((size_t)NE * 4096 * 4);
constexpr size_t WS_H8 = WS_SDN + al256((size_t)NE * 2048 * 4);
constexpr size_t WS_SAH = WS_H8 + al256((size_t)T_ * 2048);
constexpr size_t WS_ACT8 = WS_SAH + al256((size_t)T_ * 4);
constexpr size_t WS_SACT = WS_ACT8 + al256((size_t)(NA + 256) * 2048);
constexpr size_t WS_WTMKV = WS_SACT + al256((size_t)(NA + 256) * 4);
constexpr size_t WS_Q8OUT = WS_WTMKV + al256((size_t)1024 * 2048 * 2);
constexpr size_t WS_SOUT = WS_Q8OUT + al256((size_t)2048 * 2048);
constexpr size_t WS_CAT8 = WS_SOUT + al256(2048 * 4);
constexpr size_t WS_SCAT = WS_CAT8 + al256((size_t)T_ * 2048);
constexpr size_t WS_SA2 = WS_SCAT + al256((size_t)T_ * 4);
constexpr size_t WS_GATE2 = WS_SA2 + al256((size_t)NE * T_ * 4);
constexpr size_t WS_X8 = WS_GATE2 + al256((size_t)NE * T_ * 4);
constexpr size_t WS_SXA = WS_X8 + al256((size_t)(T_ + 2048) * 2048);
constexpr size_t WS_Q8IN = WS_SXA + al256((size_t)(T_ + 2048) * 4);
constexpr size_t WS_SIN8 = WS_Q8IN + al256((size_t)2560 * 2048);
constexpr size_t WS_Q8MKV = WS_SIN8 + al256(2560 * 4);
constexpr size_t WS_SMKV = WS_Q8MKV + al256((size_t)1024 * 2048);
constexpr size_t WS_WT2 = WS_SMKV + al256(1024 * 4);
constexpr size_t WS_KV16 = WS_WT2 + al256((size_t)2 * 128 * 256 * 2);
constexpr size_t KVSEG = (size_t)S_ * 128;
constexpr size_t WS_END = WS_KV16 + al256((size_t)6 * B_ * 2 * S_ * 128 * 2);

constexpr int LDS_BYTES = 159744;

struct Params {
    const float* in[26];
    float* out;
    unsigned char* ws;
    long long lo_hi;
};
enum { I_X = 0, I_MEM, I_WIN, I_POSK, I_W1K, I_W2K, I_POSV, I_W1V, I_W2V, I_POOLW, I_POOLS, I_WMEMKV, I_GNNSA, I_GNPOOL, I_GNMEM, I_WOUT,
       I_LN1G, I_LN1B, I_WR, I_BR, I_WGU, I_BGU, I_WDN, I_BDN, I_LN2G, I_LN2B };

#define XB_TMO      128
#define XB_XCNT(j)  (256  + 64 * (j))
#define XB_XSUB(j)  (1280 + 64 * (j))
#define XB_XGEN(j)  (2304 + 64 * (j))
#define XB_TOP      3328
#define XB_TOPGEN   3392
#define XCD_BAR_WORDS 3456
#define XB_SPIN_CAP (1u << 25)
#define LAS __attribute__((address_space(3)))

__device__ __forceinline__ unsigned xb_ld(unsigned* p)              { return __hip_atomic_load(p, __ATOMIC_RELAXED, __HIP_MEMORY_SCOPE_AGENT); }
__device__ __forceinline__ unsigned xb_add(unsigned* p, unsigned v) { return __hip_atomic_fetch_add(p, v, __ATOMIC_RELAXED, __HIP_MEMORY_SCOPE_AGENT); }
__device__ __forceinline__ unsigned xb_xcc_id() { return (unsigned)__builtin_amdgcn_s_getreg((3 << 11) | 20) & 0xFu; }
#define XB_SPIN(cond, bar) do { unsigned _sp = 0; while (cond) { __builtin_amdgcn_s_sleep(1); \
    if ((++_sp & 255u) == 0u) { if (xb_ld(&(bar)[XB_TMO])) break; if (_sp > XB_SPIN_CAP) { atomicAdd(&(bar)[XB_TMO], 1u); break; } } } } while (0)

struct XcdBarrier { unsigned* bar; unsigned x; volatile LAS unsigned* st; };

__device__ __forceinline__ XcdBarrier xcd_barrier_post(unsigned* bar, volatile LAS unsigned* st) {
    XcdBarrier b; b.bar = bar; b.x = xb_xcc_id(); b.st = st;
    if (threadIdx.x == 0) (void)xb_add(&bar[XB_XCNT(b.x)], 1u);
    return b;
}
__device__ __forceinline__ void xcd_barrier_complete(unsigned* bar, unsigned x, unsigned& nloc, unsigned& nx) {
    const unsigned G = gridDim.x * gridDim.y * gridDim.z;
    unsigned sum, cnt, mine, sp = 0u;
    for (;;) {
        sum = 0u; cnt = 0u; mine = 0u;
#pragma unroll
        for (unsigned j = 0; j < 16; ++j) { const unsigned c = xb_ld(&bar[XB_XCNT(j)]); sum += c; cnt += (c > 0u) ? 1u : 0u; mine = (j == x) ? c : mine; }
        if (sum == G) break;
        __builtin_amdgcn_s_sleep(1);
        if ((++sp & 255u) == 0u) { if (xb_ld(&bar[XB_TMO])) break; if (sp > XB_SPIN_CAP) { atomicAdd(&bar[XB_TMO], 1u); break; } }
    }
    nloc = mine > 0u ? mine : 1u; nx = cnt > 0u ? cnt : 1u;
}
__device__ __forceinline__ void xcd_barrier(const XcdBarrier& b) {
    asm volatile("s_waitcnt vmcnt(0)" ::: "memory");
    __syncthreads();
    if (threadIdx.x == 0) {
        unsigned* bar = b.bar;
        __builtin_amdgcn_s_waitcnt(0);
        unsigned nloc = b.st[0], nx = b.st[1];
        if (nloc == 0u) { xcd_barrier_complete(bar, b.x, nloc, nx); b.st[0] = nloc; b.st[1] = nx; }
        const unsigned old = xb_add(&bar[XB_XSUB(b.x)], 1u);
        const unsigned gen = old / nloc;
        if (old + 1u == (gen + 1u) * nloc) {
            __builtin_amdgcn_fence(__ATOMIC_RELEASE, "agent");
            asm volatile("s_waitcnt vmcnt(0)" ::: "memory");
            const unsigned og = xb_add(&bar[XB_TOP], 1u);
            const unsigned tg = og / nx;
            if (og + 1u == (tg + 1u) * nx) xb_add(&bar[XB_TOPGEN], 1u);
            else XB_SPIN(xb_ld(&bar[XB_TOPGEN]) == tg, bar);
            __builtin_amdgcn_fence(__ATOMIC_ACQUIRE, "agent");
            xb_add(&bar[XB_XGEN(b.x)], 1u);
            asm volatile("s_waitcnt vmcnt(0)" ::: "memory");
        } else {
            XB_SPIN(xb_ld(&bar[XB_XGEN(b.x)]) == gen, bar);
            __builtin_amdgcn_fence(__ATOMIC_ACQUIRE, "agent");
            asm volatile("s_waitcnt vmcnt(0)" ::: "memory");
        }
    }
    __syncthreads();
}

typedef _Float16 h8 __attribute__((ext_vector_type(8)));
typedef _Float16 h4 __attribute__((ext_vector_type(4)));
typedef float f4 __attribute__((ext_vector_type(4)));

__device__ __forceinline__ float wave_sum(float v) {
#pragma unroll
    for (int o = 32; o > 0; o >>= 1) v += __shfl_xor(v, o);
    return v;
}
__device__ __forceinline__ float wave_max(float v) {
#pragma unroll
    for (int o = 32; o > 0; o >>= 1) v = fmaxf(v, __shfl_xor(v, o));
    return v;
}
__device__ __forceinline__ void wave_sync() {
    asm volatile("s_waitcnt lgkmcnt(0)" ::: "memory");
    __builtin_amdgcn_wave_barrier();
}
__device__ __forceinline__ float gelu_tanh(float x) {
    const float u = 0.7978845608028654f * (x + 0.044715f * x * x * x);
    return 0.5f * x * (1.f + tanhf(u));
}
__device__ __forceinline__ float gelu_fast(float x) { const float u = 0.7978845608028654f * (x + 0.044715f * x * x * x); const float t = 1.f - 2.f * __builtin_amdgcn_rcpf(1.f + __builtin_amdgcn_exp2f(2.8853900817779268f * u)); return 0.5f * x * (1.f + t); }
__device__ __forceinline__ float sigmoidf_(float x) { return 1.f / (1.f + expf(-x)); }
__device__ __forceinline__ unsigned pk4_fp8(float a, float b, float c, float d) { int w = 0; w = __builtin_amdgcn_cvt_pk_fp8_f32(a, b, w, false); w = __builtin_amdgcn_cvt_pk_fp8_f32(c, d, w, true); return (unsigned)w; }
__device__ __forceinline__ void dec4_fp8(unsigned w, float& a, float& b, float& c, float& d) { a = __builtin_amdgcn_cvt_f32_fp8((int)w, 0); b = __builtin_amdgcn_cvt_f32_fp8((int)w, 1); c = __builtin_amdgcn_cvt_f32_fp8((int)w, 2); d = __builtin_amdgcn_cvt_f32_fp8((int)w, 3); }
__device__ __forceinline__ float swiglu_fast(float g, float l) { const float xg = fminf(g, 7.f), xl = fminf(fmaxf(l, -7.f), 7.f); return xg * __builtin_amdgcn_rcpf(1.f + __builtin_amdgcn_exp2f(-2.4554669595930156f * xg)) * (xl + 1.f); }

constexpr int G_LD = 40;
template <class AF, class EF>
__device__ __forceinline__ void gemm_tile(char* smem, int K, const AF& af, const float* __restrict__ Bm, int ldb, int n0, int Nlim, bool perm, const EF& ef) {
    _Float16* As = (_Float16*)smem;
    _Float16* Bs = As + 128 * G_LD;
    const int tid = threadIdx.x, lane = tid & 63, wid = tid >> 6, wr = wid >> 2, wc = wid & 3, fr = lane & 15, fq = lane >> 4;
    f4 acc[4][2];
#pragma unroll
    for (int m = 0; m < 4; ++m)
#pragma unroll
        for (int n = 0; n < 2; ++n) acc[m][n] = (f4){0.f, 0.f, 0.f, 0.f};
    const int ar = tid >> 3, ak = (tid & 7) * 4;
    const float* ap0 = af.row(ar);
    const float* ap1 = af.row(ar + 64);
    const int bk = tid >> 5, bn = (tid & 31) * 4;
    const bool bok = (n0 + bn) < Nlim;
    int bnp[4];
#pragma unroll
    for (int i = 0; i < 4; ++i) { const int c = bn + i; bnp[i] = perm ? ((c & ~31) | ((c & 1) << 4) | ((c & 31) >> 1)) : c; }
    for (int k0 = 0; k0 < K; k0 += 32) {
        const int ko = af.koff(k0 + ak);
        float4 a0 = make_float4(0.f, 0.f, 0.f, 0.f), a1 = a0, b0 = a0, b1 = a0;
        if (ap0) a0 = *(const float4*)(ap0 + ko);
        if (ap1) a1 = *(const float4*)(ap1 + ko);
        if (bok) { b0 = *(const float4*)(Bm + (size_t)(k0 + bk) * ldb + n0 + bn); b1 = *(const float4*)(Bm + (size_t)(k0 + bk + 16) * ldb + n0 + bn); }
        __syncthreads();
        *(h4*)&As[ar * G_LD + ak] = (h4){(_Float16)a0.x, (_Float16)a0.y, (_Float16)a0.z, (_Float16)a0.w};
        *(h4*)&As[(ar + 64) * G_LD + ak] = (h4){(_Float16)a1.x, (_Float16)a1.y, (_Float16)a1.z, (_Float16)a1.w};
        Bs[bnp[0] * G_LD + bk] = (_Float16)b0.x; Bs[bnp[1] * G_LD + bk] = (_Float16)b0.y; Bs[bnp[2] * G_LD + bk] = (_Float16)b0.z; Bs[bnp[3] * G_LD + bk] = (_Float16)b0.w;
        Bs[bnp[0] * G_LD + bk + 16] = (_Float16)b1.x; Bs[bnp[1] * G_LD + bk + 16] = (_Float16)b1.y; Bs[bnp[2] * G_LD + bk + 16] = (_Float16)b1.z; Bs[bnp[3] * G_LD + bk + 16] = (_Float16)b1.w;
        __syncthreads();
        h8 a[4], b[2];
#pragma unroll
        for (int m = 0; m < 4; ++m) a[m] = *(const h8*)&As[(wr * 64 + m * 16 + fr) * G_LD + fq * 8];
#pragma unroll
        for (int n = 0; n < 2; ++n) b[n] = *(const h8*)&Bs[(wc * 32 + n * 16 + fr) * G_LD + fq * 8];
#pragma unroll
        for (int m = 0; m < 4; ++m)
#pragma unroll
            for (int n = 0; n < 2; ++n) acc[m][n] = __builtin_amdgcn_mfma_f32_16x16x32_f16(a[m], b[n], acc[m][n], 0, 0, 0);
    }
    ef(acc, wr, wc, fr, fq);
    __syncthreads();
}

struct ARowPlain { const float* base; int ld; int m0; int mlim;
    __device__ __forceinline__ const float* row(int r) const { return (m0 + r) < mlim ? base + (size_t)(m0 + r) * ld : nullptr; }
    __device__ __forceinline__ int koff(int k) const { return k; } };
struct ARowCmp { const float* proj; int col; int m0;
    __device__ __forceinline__ const float* row(int r) const { const int g = m0 + r; if (g >= CROWS) return nullptr; const int kvh = g & 1, bc = g >> 1, b = bc / NC, c = bc % NC;
        return proj + (size_t)(b * S_ + 16 * c) * INW + col + kvh * 128; }
    __device__ __forceinline__ int koff(int k) const { return (k >> 7) * INW + (k & 127); } };
struct ARowList { const float* base; const int* list; int m0; int cnt; int shift;
    __device__ __forceinline__ const float* row(int r) const { if (m0 + r >= cnt) return nullptr; const int a = list[m0 + r]; return base + (size_t)(a >> shift) * 2048; }
    __device__ __forceinline__ int koff(int k) const { return k; } };

struct EpiStore { float* C; int ldc; int m0; int n0; int mlim; int nlim; _Float16* C16;
    __device__ __forceinline__ void operator()(const f4 (&acc)[4][2], int wr, int wc, int fr, int fq) const {
#pragma unroll
        for (int m = 0; m < 4; ++m)
#pragma unroll
            for (int n = 0; n < 2; ++n)
#pragma unroll
                for (int j = 0; j < 4; ++j) { const int r = m0 + wr * 64 + m * 16 + fq * 4 + j, c = n0 + wc * 32 + n * 16 + fr;
                    if (r < mlim && c < nlim) { C[(size_t)r * ldc + c] = acc[m][n][j]; if (C16) C16[(size_t)r * ldc + c] = (_Float16)acc[m][n][j]; } } } };
struct EpiKc { _Float16* C; int m0;
    __device__ __forceinline__ void operator()(const f4 (&acc)[4][2], int wr, int wc, int fr, int fq) const {
#pragma unroll
        for (int m = 0; m < 4; ++m)
#pragma unroll
            for (int n = 0; n < 2; ++n)
#pragma unroll
                for (int j = 0; j < 4; ++j) { const int r = m0 + wr * 64 + m * 16 + fq * 4 + j, c = wc * 32 + n * 16 + fr;
                    C[(size_t)r * 128 + c] = (((r >> 1) & 127) == 127) ? (_Float16)0.f : (_Float16)acc[m][n][j]; } } };
struct EpiPool { _Float16* C; const float* scale; int m0; int g;
    __device__ __forceinline__ void operator()(const f4 (&acc)[4][2], int wr, int wc, int fr, int fq) const {
#pragma unroll
        for (int m = 0; m < 4; ++m)
#pragma unroll
            for (int n = 0; n < 2; ++n)
#pragma unroll
                for (int j = 0; j < 4; ++j) { const int r = m0 + wr * 64 + m * 16 + fq * 4 + j, c = g * 128 + wc * 32 + n * 16 + fr;
                    C[(size_t)r * 512 + c] = (_Float16)(acc[m][n][j] * scale[c]); } } };
struct EpiHid { float* C; const float* bias; int m0; int n0;
    __device__ __forceinline__ void operator()(const f4 (&acc)[4][2], int wr, int wc, int fr, int fq) const {
#pragma unroll
        for (int m = 0; m < 4; ++m)
#pragma unroll
            for (int n = 0; n < 2; ++n)
#pragma unroll
                for (int j = 0; j < 4; ++j) { const int r = m0 + wr * 64 + m * 16 + fq * 4 + j, c = n0 + wc * 32 + n * 16 + fr;
                    if (r < CROWS) C[(size_t)r * 256 + c] = gelu_tanh(acc[m][n][j] + bias[c]); } } };
struct EpiOut { float* C; const float* x; int m0; int n0;
    __device__ __forceinline__ void operator()(const f4 (&acc)[4][2], int wr, int wc, int fr, int fq) const {
#pragma unroll
        for (int m = 0; m < 4; ++m)
#pragma unroll
            for (int n = 0; n < 2; ++n)
#pragma unroll
                for (int j = 0; j < 4; ++j) { const size_t o = (size_t)(m0 + wr * 64 + m * 16 + fq * 4 + j) * 2048 + n0 + wc * 32 + n * 16 + fr;
                    C[o] = DN_ALPHA * x[o] + acc[m][n][j]; } } };
struct EpiGu { float* act; const float* bgu; const int* list; int m0; int cnt; int n0;
    __device__ __forceinline__ void operator()(const f4 (&acc)[4][2], int wr, int wc, int fr, int fq) const {
        const int jc = (n0 + wc * 32) / 2 + fr;
        const float bg = bgu[2 * jc], bl = bgu[2 * jc + 1];
#pragma unroll
        for (int m = 0; m < 4; ++m)
#pragma unroll
            for (int j = 0; j < 4; ++j) { const int r = m0 + wr * 64 + m * 16 + fq * 4 + j;
                if (r < cnt) { const int a = list[r];
                    const float xg = fminf(acc[m][0][j] + bg, 7.f), xl = fminf(fmaxf(acc[m][1][j] + bl, -7.f), 7.f);
                    act[(size_t)a * 2048 + jc] = xg * sigmoidf_(1.702f * xg) * (xl + 1.f); } } } };
struct EpiDn { float* y; const float* bdn; const int* list; const float* gate; int m0; int cnt; int n0;
    __device__ __forceinline__ void operator()(const f4 (&acc)[4][2], int wr, int wc, int fr, int fq) const {
#pragma unroll
        for (int m = 0; m < 4; ++m)
#pragma unroll
            for (int j = 0; j < 4; ++j) { const int r = m0 + wr * 64 + m * 16 + fq * 4 + j;
                if (r < cnt) { const int a = list[r]; const float g = gate[a];
#pragma unroll
                    for (int n = 0; n < 2; ++n) { const int c = n0 + wc * 32 + n * 16 + fr; y[(size_t)a * 2048 + c] = (acc[m][n][j] + bdn[c]) * g; } } } } };

constexpr int WLDS_FLOATS = 4096 + 512 + 32;
template <bool SHARED>
__device__ __forceinline__ void wave_attn(float* sw, const float* __restrict__ qptr, const float* __restrict__ Kb, const float* __restrict__ Vb, int ld, int nseg, float scale, float* __restrict__ optr) {
    const int lane = threadIdx.x & 63;
    float* sq = sw + 4096; const int* segs = (const int*)(sw + 4096 + 512);
#pragma unroll
    for (int i = 0; i < 8; ++i) sq[lane + 64 * i] = qptr[lane + 64 * i];
    wave_sync();
    for (int sg = 0; sg < nseg; ++sg) {
        const int start = segs[sg], len = segs[16 + sg];
        float d0 = 0.f, d1 = 0.f, d2 = 0.f, d3 = 0.f;
        if (lane < len) {
            const float* kp = Kb + (size_t)(start + lane) * ld;
            for (int d4 = 0; d4 < 32; ++d4) {
                if (SHARED) {
                    const float4 kv = *(const float4*)(kp + d4 * 4);
                    const float4 q0 = *(const float4*)(sq + d4 * 4), q1 = *(const float4*)(sq + 128 + d4 * 4), q2 = *(const float4*)(sq + 256 + d4 * 4), q3 = *(const float4*)(sq + 384 + d4 * 4);
                    d0 += kv.x * q0.x + kv.y * q0.y + kv.z * q0.z + kv.w * q0.w;
                    d1 += kv.x * q1.x + kv.y * q1.y + kv.z * q1.z + kv.w * q1.w;
                    d2 += kv.x * q2.x + kv.y * q2.y + kv.z * q2.z + kv.w * q2.w;
                    d3 += kv.x * q3.x + kv.y * q3.y + kv.z * q3.z + kv.w * q3.w;
                } else {
                    const float4 k0 = *(const float4*)(kp + d4 * 4), k1 = *(const float4*)(kp + 128 + d4 * 4), k2 = *(const float4*)(kp + 256 + d4 * 4), k3 = *(const float4*)(kp + 384 + d4 * 4);
                    const float4 q0 = *(const float4*)(sq + d4 * 4), q1 = *(const float4*)(sq + 128 + d4 * 4), q2 = *(const float4*)(sq + 256 + d4 * 4), q3 = *(const float4*)(sq + 384 + d4 * 4);
                    d0 += k0.x * q0.x + k0.y * q0.y + k0.z * q0.z + k0.w * q0.w;
                    d1 += k1.x * q1.x + k1.y * q1.y + k1.z * q1.z + k1.w * q1.w;
                    d2 += k2.x * q2.x + k2.y * q2.y + k2.z * q2.z + k2.w * q2.w;
                    d3 += k3.x * q3.x + k3.y * q3.y + k3.z * q3.z + k3.w * q3.w;
                }
            }
        }
        const bool ok = lane < len;
        sw[sg * 64 + lane] = ok ? d0 * scale : -1e30f;
        sw[1024 + sg * 64 + lane] = ok ? d1 * scale : -1e30f;
        sw[2048 + sg * 64 + lane] = ok ? d2 * scale : -1e30f;
        sw[3072 + sg * 64 + lane] = ok ? d3 * scale : -1e30f;
    }
    wave_sync();
    const int n = nseg * 64;
#pragma unroll
    for (int g = 0; g < 4; ++g) {
        float mx = -1e30f;
        for (int i = lane; i < n; i += 64) mx = fmaxf(mx, sw[g * 1024 + i]);
        mx = wave_max(mx);
        float sm = 0.f;
        for (int i = lane; i < n; i += 64) { const float v = sw[g * 1024 + i]; sm += (v > -1e29f) ? expf(v - mx) : 0.f; }
        sm = wave_sum(sm);
        const float inv = sm > 0.f ? 1.f / sm : 0.f;
        for (int i = lane; i < n; i += 64) { const float v = sw[g * 1024 + i]; sw[g * 1024 + i] = (v > -1e29f) ? expf(v - mx) * inv : 0.f; }
    }
    wave_sync();
    float o[4][2];
#pragma unroll
    for (int g = 0; g < 4; ++g) { o[g][0] = 0.f; o[g][1] = 0.f; }
    for (int sg = 0; sg < nseg; ++sg) {
        const int start = segs[sg], len = segs[16 + sg];
        for (int l = 0; l < len; ++l) {
            const float* vp = Vb + (size_t)(start + l) * ld;
            if (SHARED) {
                const float v0 = vp[lane], v1 = vp[lane + 64];
#pragma unroll
                for (int g = 0; g < 4; ++g) { const float p = sw[g * 1024 + sg * 64 + l]; o[g][0] += p * v0; o[g][1] += p * v1; }
            } else {
#pragma unroll
                for (int g = 0; g < 4; ++g) { const float p = sw[g * 1024 + sg * 64 + l]; o[g][0] += p * vp[g * 128 + lane]; o[g][1] += p * vp[g * 128 + lane + 64]; }
            }
        }
    }
#pragma unroll
    for (int g = 0; g < 4; ++g) { optr[g * 128 + lane] = o[g][0]; optr[g * 128 + lane + 64] = o[g][1]; }
}

namespace g8 {
constexpr int BM = 256, BK = 64, HALF = 128, HTB = HALF * BK * 2, STAGE_BYTES = 8 * HTB;
constexpr int KK = 2048;
typedef float f32x4 __attribute__((ext_vector_type(4)));
__device__ __forceinline__ int lds_byte(int r, int c) { return r * 128 + ((((c >> 3) ^ (r >> 1)) & 7) << 4) + (c & 7) * 2; }
__device__ __forceinline__ void stage_rc(int b, int& R, int& C) { R = b >> 7; C = ((((b >> 4) ^ (R >> 1)) & 7)) * 8; }
__device__ __forceinline__ int perm32(int rho) { const int n = rho >> 4, i = rho & 15; return 8 * (i >> 2) + 4 * n + (i & 3); }

typedef int i32x4 __attribute__((ext_vector_type(4)));
typedef unsigned u32x2 __attribute__((ext_vector_type(2)));
typedef unsigned u32x4 __attribute__((ext_vector_type(4)));
template <bool I8> struct AccSel { typedef f32x4 T; };
template <> struct AccSel<true> { typedef i32x4 T; };
__device__ __forceinline__ f32x4 mma16(i32x4 a, i32x4 b, f32x4 c) { return __builtin_amdgcn_mfma_f32_16x16x32_f16(*reinterpret_cast<h8*>(&a), *reinterpret_cast<h8*>(&b), c, 0, 0, 0); }
__device__ __forceinline__ i32x4 mma16(i32x4 a, i32x4 b, i32x4 c) { return __builtin_amdgcn_mfma_i32_16x16x64_i8(a, b, c, 0, 0, 0); }
struct Unit { int m0, n0, e, cnt, rbase; };
constexpr int EP_OFF = STAGE_BYTES + 2048, EP_LD = 528, EP_GRP = 16 * EP_LD;
constexpr int CONST_OFF = EP_OFF + 18432;
__device__ __forceinline__ void cdma(LAS unsigned char* lds, int region, int idx, const void* src) { __builtin_amdgcn_global_load_lds((const unsigned*)src, (LAS unsigned*)(lds + CONST_OFF + region * 1024 + idx * 256), 4, 0, 0); }
__device__ __forceinline__ void ep_sync() { asm volatile("s_waitcnt lgkmcnt(0)" ::: "memory"); __builtin_amdgcn_s_barrier(); asm volatile("" ::: "memory"); }
__device__ __forceinline__ int ep_tid() { int tz = threadIdx.x; asm volatile("" : "+v"(tz)); return tz; }
__device__ __forceinline__ h8 cvt8(f32x4 a, f32x4 b) { h8 o; o[0] = (_Float16)a[0]; o[1] = (_Float16)a[1]; o[2] = (_Float16)a[2]; o[3] = (_Float16)a[3]; o[4] = (_Float16)b[0]; o[5] = (_Float16)b[1]; o[6] = (_Float16)b[2]; o[7] = (_Float16)b[3]; return o; }

__device__ __forceinline__ void tile_order(int L, int nM, int nN, int& pm, int& pn) {
    const int nwg = nM * nN; int wgid = L;
    { const int q = nwg / 8, r = nwg % 8, xcd = wgid % 8, off = wgid / 8; wgid = (xcd < r ? xcd * (q + 1) : r * (q + 1) + (xcd - r) * q) + off; }
    const int nig = 8 * nN, gid = wgid / nig, fm = gid * 8, gsz = (nM - fm) < 8 ? (nM - fm) : 8;
    pm = fm + ((wgid % nig) % gsz); pn = (wgid % nig) / gsz;
}

template <class Prob>
__device__ __forceinline__ void gemm_phase(LAS unsigned char* lds, const Prob& P) {
    int tidh_ = threadIdx.x; asm volatile("" : "+v"(tidh_));
    const int tid = tidh_, wid = __builtin_amdgcn_readfirstlane(tid >> 6), lane = tid & 63, wr = wid >> 2, wc = wid & 3, fr = lane & 15, fq = lane >> 4;
    constexpr int nt = Prob::NT; constexpr size_t KS2 = Prob::KS2; constexpr unsigned ROWB = Prob::ROWB; constexpr bool I8 = Prob::I8;
    int sR[2], sC2[2]; unsigned voffB[2];
#pragma unroll
    for (int i = 0; i < 2; ++i) { int R, C; stage_rc(tid * 16 + i * 8192, R, C); sR[i] = R; sC2[i] = C * 2; const int Rb = Prob::PERM ? ((R & ~31) + perm32(R & 31)) : R; voffB[i] = (unsigned)Rb * ROWB + (unsigned)C * 2u; }
    const size_t kstep = (size_t)(BK * 2);
    const size_t hstep = (size_t)HALF * ROWB;
    const unsigned ldsw = (unsigned)wid * 1024u;
    const int aoff = lds_byte(wr * 64 + fr, fq * 8), boff = lds_byte(wc * 32 + fr, fq * 8), aoff1 = lds_byte(wr * 64 + fr, fq * 8 + 32), boff1 = lds_byte(wc * 32 + fr, fq * 8 + 32);
#define G8_SA(b, h) (((b) * 2 + (h)) * HTB)
#define G8_SB(b, h) ((4 + (b) * 2 + (h)) * HTB)
#define G8_STAGE(bufoff, gbase, voff) do { _Pragma("unroll") for (int _i = 0; _i < 2; ++_i) \
        __builtin_amdgcn_global_load_lds((const unsigned*)((const char*)(gbase) + (voff)[_i]), (LAS unsigned*)(lds + (bufoff) + ldsw + _i * 8192), 16, 0, 0); } while (0)
#define G8_LDA(dst, b, h) do { _Pragma("unroll") for (int m = 0; m < 4; ++m) _Pragma("unroll") for (int k = 0; k < 2; ++k) dst[m][k] = *(const LAS i32x4*)(lds + G8_SA(b, h) + (k ? aoff1 : aoff) + m * 2048); } while (0)
#define G8_LDB(dst, b, h) do { _Pragma("unroll") for (int n = 0; n < 2; ++n) _Pragma("unroll") for (int k = 0; k < 2; ++k) dst[n][k] = *(const LAS i32x4*)(lds + G8_SB(b, h) + (k ? boff1 : boff) + n * 2048); } while (0)
#define G8_MMA(ai, bj, At, Bt) do { __builtin_amdgcn_s_setprio(1); _Pragma("unroll") for (int m = 0; m < 4; ++m) _Pragma("unroll") for (int n = 0; n < 2; ++n) _Pragma("unroll") for (int k = 0; k < 2; ++k) \
        acc[ai][bj][m][n] = mma16(Bt[n][k], At[m][k], acc[ai][bj][m][n]); __builtin_amdgcn_s_setprio(0); } while (0)
#define G8_WAIT_V(n) asm volatile("s_waitcnt vmcnt(" #n ")" ::: "memory")
#define G8_WAIT_L(n) asm volatile("s_waitcnt lgkmcnt(" #n ")" ::: "memory")
#define G8_BAR __builtin_amdgcn_s_barrier()
#define G8_SCHED __builtin_amdgcn_sched_barrier(0)
    Unit cur, nxt; int ui = 0;
    if (!P.next(0, cur)) return;
    typedef typename AccSel<I8>::T AccT;
    AccT acc[2][2][4][2];
#pragma unroll
    for (int a = 0; a < 2; ++a)
#pragma unroll
        for (int b = 0; b < 2; ++b)
#pragma unroll
            for (int m = 0; m < 4; ++m)
#pragma unroll
                for (int n = 0; n < 2; ++n) acc[a][b][m][n] = AccT{};
    i32x4 At[4][2], B0[2][2], B1[2][2];
    unsigned vc[2][2], vn[2][2];
    P.a_offs(cur, sR, sC2, vc);
    const char* const Ab = P.a_base();
    const char* cB = P.b_base(cur);
    G8_STAGE(G8_SB(0, 0), cB, voffB); G8_STAGE(G8_SA(0, 0), Ab, vc[0]); G8_STAGE(G8_SB(0, 1), cB + hstep, voffB); G8_STAGE(G8_SA(0, 1), Ab, vc[1]);
    if (wr == 1) G8_BAR;
    G8_WAIT_V(4); G8_BAR;
    G8_STAGE(G8_SB(1, 0), cB + kstep, voffB); G8_STAGE(G8_SA(1, 0), Ab + kstep, vc[0]); G8_STAGE(G8_SB(1, 1), cB + hstep + kstep, voffB);
    G8_WAIT_V(6); G8_BAR;
    for (;;) {
        const bool has_next = P.next(ui + 1, nxt);
        const char* nB = cB;
        if (has_next) { P.a_offs(nxt, sR, sC2, vn); nB = P.b_base(nxt); }
        else { vn[0][0] = vc[0][0]; vn[0][1] = vc[0][1]; vn[1][0] = vc[1][0]; vn[1][1] = vc[1][1]; }
        for (int t = 0; t < nt; t += 2) {
            const bool last = (t == nt - 2);
            if constexpr (Prob::CD) { if (last) P.const_dma(cur, lds, wid, lane); }
            const char* a1 = Ab + (size_t)(t >> 1) * KS2 + kstep;
            const char* a2 = last ? Ab : Ab + (size_t)((t + 2) >> 1) * KS2; const char* b2 = last ? nB : cB + (size_t)(t + 2) * kstep;
            const char* a3 = a2 + kstep; const char* b3 = b2 + kstep;
            unsigned o2[2][2];
            o2[0][0] = last ? vn[0][0] : vc[0][0]; o2[0][1] = last ? vn[0][1] : vc[0][1]; o2[1][0] = last ? vn[1][0] : vc[1][0]; o2[1][1] = last ? vn[1][1] : vc[1][1];
            G8_LDB(B0, 0, 0); G8_SCHED; G8_LDA(At, 0, 0); G8_STAGE(G8_SA(1, 1), a1, vc[1]);
            G8_WAIT_L(8); G8_BAR; G8_WAIT_L(0); G8_MMA(0, 0, At, B0); G8_BAR; G8_SCHED;
            G8_LDB(B1, 0, 1); G8_STAGE(G8_SB(0, 0), b2, voffB);
            G8_BAR; G8_WAIT_L(0); G8_MMA(0, 1, At, B1); G8_BAR;
            G8_LDA(At, 0, 1); G8_STAGE(G8_SA(0, 0), a2, o2[0]);
            G8_BAR; G8_WAIT_L(0); G8_MMA(1, 0, At, B0); G8_BAR; G8_SCHED;
            G8_STAGE(G8_SB(0, 1), b2 + hstep, voffB);
            G8_WAIT_V(6); G8_BAR; G8_MMA(1, 1, At, B1); G8_BAR;
            G8_LDB(B0, 1, 0); G8_SCHED; G8_LDA(At, 1, 0); G8_STAGE(G8_SA(0, 1), a2, o2[1]);
            G8_WAIT_L(8); G8_BAR; G8_WAIT_L(0); G8_MMA(0, 0, At, B0); G8_BAR; G8_SCHED;
            G8_LDB(B1, 1, 1); G8_STAGE(G8_SB(1, 0), b3, voffB);
            G8_BAR; G8_WAIT_L(0); G8_MMA(0, 1, At, B1); G8_BAR;
            G8_LDA(At, 1, 1); G8_STAGE(G8_SA(1, 0), a3, o2[0]);
            G8_BAR; G8_WAIT_L(0); G8_MMA(1, 0, At, B0); G8_BAR; G8_SCHED;
            G8_STAGE(G8_SB(1, 1), b3 + hstep, voffB);
            G8_WAIT_V(6); G8_BAR; G8_MMA(1, 1, At, B1); G8_BAR;
        }
        P.epi(acc, cur, wr, wc, fr, fq, lds);
        if (!has_next) break;
#pragma unroll
        for (int a = 0; a < 2; ++a)
#pragma unroll
            for (int b = 0; b < 2; ++b)
#pragma unroll
                for (int m = 0; m < 4; ++m)
#pragma unroll
                    for (int n = 0; n < 2; ++n) acc[a][b][m][n] = AccT{};
        cur = nxt; cB = nB; ++ui;
        vc[0][0] = vn[0][0]; vc[0][1] = vn[0][1]; vc[1][0] = vn[1][0]; vc[1][1] = vn[1][1];
    }
    G8_WAIT_V(0);
    if (wr == 0) G8_BAR;
    G8_BAR;
#undef G8_SA
#undef G8_SB
#undef G8_STAGE
#undef G8_LDA
#undef G8_LDB
#undef G8_MMA
#undef G8_WAIT_V
#undef G8_WAIT_L
#undef G8_BAR
#undef G8_SCHED
}

struct ProbInF {
    static constexpr bool CD = false;
    static constexpr unsigned ROWB = 4096; static constexpr bool I8 = false;
    static constexpr int NT = 32; static constexpr size_t KS2 = 256;
    static constexpr bool PERM = true;
    const _Float16* A; _Float16* C16; int G, c;
    __device__ __forceinline__ bool next(int i, Unit& u) const { const int L = i * G + c; if (L >= 64 * 5) return false;
        int pm, pn; tile_order(L, 64, 5, pm, pn); u.m0 = pm * 256; u.n0 = pn * 256; u.e = 0; u.cnt = 256; u.rbase = 0; return true; }
    __device__ __forceinline__ void a_offs(const Unit& u, const int (&R)[2], const int (&C2)[2], unsigned (&v)[2][2]) const {
#pragma unroll
        for (int h = 0; h < 2; ++h)
#pragma unroll
            for (int i = 0; i < 2; ++i) v[h][i] = (unsigned)(u.m0 + h * 128 + R[i]) * (unsigned)(KK * 2) + (unsigned)C2[i]; }
    __device__ __forceinline__ const char* a_base() const { return (const char*)A; }
    __device__ __forceinline__ const char* b_base(const Unit& u) const { return (const char*)A + (long long)(WS_WTIN - WS_X16) + (size_t)u.n0 * KK * 2; }
    __device__ __forceinline__ void epi(const f32x4 (&acc)[2][2][4][2], const Unit& u, int wr, int wc, int fr, int fq, LAS unsigned char* lds) const {
        LAS unsigned char* ep = lds + EP_OFF + wr * EP_GRP;
        const int tg = ep_tid() & 255, rrow = tg >> 4, ch = tg & 15;
        const int kvseg = (u.e == 0 && u.n0 >= 1024 && u.n0 < 2560) ? ((u.n0 - 1024) >> 8) : -1;
        _Float16* const Cb = (_Float16*)((char*)C16 + (u.e ? (long long)(WS_KVMEM16 - WS_PROJ16) : 0ll)); const int ldc = u.e ? 1024 : INW, nlim = u.e ? 1024 : INW, mb = u.e ? u.m0 - T_ : u.m0;
#pragma unroll
        for (int ai = 0; ai < 2; ++ai)
#pragma unroll
            for (int m = 0; m < 4; ++m) {
#pragma unroll
                for (int bj = 0; bj < 2; ++bj) *(LAS h8*)(ep + fr * EP_LD + (bj * 128 + wc * 32 + fq * 8) * 2) = cvt8(acc[ai][bj][m][0], acc[ai][bj][m][1]);
                ep_sync();
                const h8 x0 = *(const LAS h8*)(ep + rrow * EP_LD + ch * 32), x1 = *(const LAS h8*)(ep + rrow * EP_LD + ch * 32 + 16);
                const int grow = mb + ai * 128 + wr * 64 + m * 16 + rrow, gcol = u.n0 + ch * 16;
                if (kvseg >= 0) {
                    _Float16* dst = (_Float16*)((char*)C16 + (long long)(WS_KV16 - WS_PROJ16)) + ((size_t)(kvseg * B_ + (grow >> 11)) * 2 + (ch >> 3)) * KVSEG + (size_t)(grow & (S_ - 1)) * 128 + (ch & 7) * 16;
                    *(h8*)dst = x0; *(h8*)(dst + 8) = x1;
                } else {
                    if (gcol < nlim) *(h8*)(Cb + (size_t)grow * ldc + gcol) = x0;
                    if (gcol + 8 < nlim) *(h8*)(Cb + (size_t)grow * ldc + gcol + 8) = x1; }
                ep_sync();
            } }
};
struct ProbIn8 {
    static constexpr bool CD = true;
    static constexpr unsigned ROWB = 2048; static constexpr bool I8 = true;
    static constexpr int NT = 16; static constexpr size_t KS2 = 256;
    static constexpr bool PERM = true;
    const signed char* A; _Float16* C16; const float* sa; int G, c;
    __device__ __forceinline__ bool next(int i, Unit& u) const { const int L = i * G + c; if (L >= 640 + 32) return false;
        if (L < 640) { int pm, pn; tile_order(L, 64, 10, pm, pn); u.m0 = pm * 256; u.n0 = 1280 + pn * 256; u.e = 0; }
        else { const int v = L - 640; u.m0 = T_ + (v & 7) * 256; u.n0 = (v >> 3) * 256; u.e = 1; }
        u.cnt = 256; u.rbase = 0; return true; }
    __device__ __forceinline__ void a_offs(const Unit& u, const int (&R)[2], const int (&C2)[2], unsigned (&v)[2][2]) const {
#pragma unroll
        for (int h = 0; h < 2; ++h)
#pragma unroll
            for (int i = 0; i < 2; ++i) v[h][i] = (unsigned)(u.m0 + h * 128 + R[i]) * 2048u + (unsigned)C2[i]; }
    __device__ __forceinline__ const char* a_base() const { return (const char*)A; }
    __device__ __forceinline__ const char* b_base(const Unit& u) const { return (const char*)A + (u.e ? (long long)(WS_Q8MKV - WS_X8) + (long long)u.n0 * 2048 : (long long)(WS_Q8IN - WS_X8) + (long long)(u.n0 - 1280) * 2048); }
    __device__ __forceinline__ void const_dma(const Unit& u, LAS unsigned char* lds, int wid, int lane) const {
        const int i4 = wid & 3;
        if (wid < 4) cdma(lds, 1, i4, (const float*)((const char*)A + (u.e ? (long long)(WS_SMKV - WS_X8) : (long long)(WS_SIN8 - WS_X8))) + (u.e ? u.n0 : u.n0 - 1280) + i4 * 64 + lane);
        else cdma(lds, 2, i4, sa + u.m0 + i4 * 64 + lane);
    }
    __device__ __forceinline__ void epi(const i32x4 (&acc)[2][2][4][2], const Unit& u, int wr, int wc, int fr, int fq, LAS unsigned char* lds) const {
        asm volatile("s_waitcnt vmcnt(16)" ::: "memory");
        ep_sync();
        LAS unsigned char* ep = lds + EP_OFF + wr * EP_GRP;
        const int tg = ep_tid() & 255, rrow = tg >> 4, ch = tg & 15;
        const int kvseg = (u.e == 0 && u.n0 >= 1024 && u.n0 < 2560) ? ((u.n0 - 1024) >> 8) : -1;
        _Float16* const Cb = (_Float16*)((char*)C16 + (u.e ? (long long)(WS_KVMEM16 - WS_PROJ16) : 0ll)); const int ldc = u.e ? 1024 : INW, nlim = u.e ? 1024 : INW, mb = u.e ? u.m0 - T_ : u.m0;
        const LAS float* cst = (const LAS float*)(lds + CONST_OFF);
        f32x4 s0[2], s1[2]; float srv[8];
#pragma unroll
        for (int bj = 0; bj < 2; ++bj) { const int col = bj * 128 + wc * 32 + fq * 8; s0[bj] = *(const LAS f32x4*)(cst + 256 + col); s1[bj] = *(const LAS f32x4*)(cst + 256 + col + 4); }
#pragma unroll
        for (int q = 0; q < 8; ++q) srv[q] = cst[512 + (q >> 2) * 128 + wr * 64 + (q & 3) * 16 + fr];
#pragma unroll
        for (int ai = 0; ai < 2; ++ai)
#pragma unroll
            for (int m = 0; m < 4; ++m) { const float sr = srv[ai * 4 + m];
#pragma unroll
                for (int bj = 0; bj < 2; ++bj) { const i32x4 i0 = acc[ai][bj][m][0], i1 = acc[ai][bj][m][1];
                    *(LAS h8*)(ep + fr * EP_LD + (bj * 128 + wc * 32 + fq * 8) * 2) = cvt8((f32x4){(float)i0[0], (float)i0[1], (float)i0[2], (float)i0[3]} * (s0[bj] * sr), (f32x4){(float)i1[0], (float)i1[1], (float)i1[2], (float)i1[3]} * (s1[bj] * sr)); }
                ep_sync();
                const h8 x0 = *(const LAS h8*)(ep + rrow * EP_LD + ch * 32), x1 = *(const LAS h8*)(ep + rrow * EP_LD + ch * 32 + 16);
                const int grow = mb + ai * 128 + wr * 64 + m * 16 + rrow, gcol = u.n0 + ch * 16;
                if (kvseg >= 0) {
                    _Float16* dst = (_Float16*)((char*)C16 + (long long)(WS_KV16 - WS_PROJ16)) + ((size_t)(kvseg * B_ + (grow >> 11)) * 2 + (ch >> 3)) * KVSEG + (size_t)(grow & (S_ - 1)) * 128 + (ch & 7) * 16;
                    *(h8*)dst = x0; *(h8*)(dst + 8) = x1;
                } else {
                    if (gcol < nlim) *(h8*)(Cb + (size_t)grow * ldc + gcol) = x0;
                    if (gcol + 8 < nlim) *(h8*)(Cb + (size_t)grow * ldc + gcol + 8) = x1; }
                ep_sync();
            } }
};
struct ProbOut {
    static constexpr bool CD = false;
    static constexpr unsigned ROWB = 2048; static constexpr bool I8 = true;
    static constexpr int NT = 16; static constexpr size_t KS2 = 256;
    static constexpr bool PERM = true;
    const signed char* A; const signed char* Bt; _Float16* C; const _Float16* X; const float* sa; const float* sw; int G, c;
    __device__ __forceinline__ bool next(int i, Unit& u) const { const int L = i * G + c; if (L >= 64 * 8) return false; int pm, pn; tile_order(L, 64, 8, pm, pn); u.m0 = pm * 256; u.n0 = pn * 256; u.e = 0; u.cnt = 256; u.rbase = 0; return true; }
    __device__ __forceinline__ void a_offs(const Unit& u, const int (&R)[2], const int (&C2)[2], unsigned (&v)[2][2]) const {
#pragma unroll
        for (int h = 0; h < 2; ++h)
#pragma unroll
            for (int i = 0; i < 2; ++i) v[h][i] = (unsigned)(u.m0 + h * 128 + R[i]) * 2048u + (unsigned)C2[i]; }
    __device__ __forceinline__ const char* a_base() const { return (const char*)A; }
    __device__ __forceinline__ const char* b_base(const Unit& u) const { return (const char*)(Bt + (size_t)u.n0 * 2048); }
    __device__ __forceinline__ void epi(const i32x4 (&acc)[2][2][4][2], const Unit& u, int wr, int wc, int fr, int fq, LAS unsigned char* lds) const {
        LAS unsigned char* ep = lds + EP_OFF + wr * EP_GRP;
        const int tg = ep_tid() & 255, rrow = tg >> 4, ch = tg & 15;
        f32x4 s0[2], s1[2]; float srv[8];
#pragma unroll
        for (int bj = 0; bj < 2; ++bj) { const int col = u.n0 + bj * 128 + wc * 32 + fq * 8; s0[bj] = *(const f32x4*)(sw + col); s1[bj] = *(const f32x4*)(sw + col + 4); }
#pragma unroll
        for (int q = 0; q < 8; ++q) srv[q] = sa[u.m0 + (q >> 2) * 128 + wr * 64 + (q & 3) * 16 + fr];
#pragma unroll
        for (int ai = 0; ai < 2; ++ai)
#pragma unroll
            for (int m = 0; m < 4; ++m) { const float sr = srv[ai * 4 + m];
#pragma unroll
                for (int bj = 0; bj < 2; ++bj) { const i32x4 i0 = acc[ai][bj][m][0], i1 = acc[ai][bj][m][1];
                    *(LAS h8*)(ep + fr * EP_LD + (bj * 128 + wc * 32 + fq * 8) * 2) = cvt8((f32x4){(float)i0[0], (float)i0[1], (float)i0[2], (float)i0[3]} * (s0[bj] * sr), (f32x4){(float)i1[0], (float)i1[1], (float)i1[2], (float)i1[3]} * (s1[bj] * sr)); }
                const size_t go = (size_t)(u.m0 + ai * 128 + wr * 64 + m * 16 + rrow) * 2048 + u.n0 + ch * 16;
                const h8 r0 = *(const h8*)(X + go), r1 = *(const h8*)(X + go + 8);
                ep_sync();
                const h8 x0 = *(const LAS h8*)(ep + rrow * EP_LD + ch * 32), x1 = *(const LAS h8*)(ep + rrow * EP_LD + ch * 32 + 16);
                h8 o0, o1;
#pragma unroll
                for (int q = 0; q < 8; ++q) { o0[q] = (_Float16)(DN_ALPHA * (float)r0[q] + (float)x0[q]); o1[q] = (_Float16)(DN_ALPHA * (float)r1[q] + (float)x1[q]); }
                *(h8*)(C + go) = o0; *(h8*)(C + go + 8) = o1;
                ep_sync();
            } }
};
struct ProbCmp {
    static constexpr bool CD = false;
    static constexpr unsigned ROWB = 4096; static constexpr bool I8 = false;
    static constexpr int NT = 8; static constexpr size_t KS2 = 256;
    static constexpr bool PERM = false;
    const _Float16* A; const _Float16* Bt; float* C; int G, c;
    __device__ __forceinline__ bool next(int i, Unit& u) const { const int L = i * G + c; if (L >= 128) return false;
        u.e = L >> 6; const int r = L & 63; u.rbase = r & 3; u.n0 = ((r >> 2) & 1) * 256; u.m0 = (r >> 3) * 256; u.cnt = 256; return true; }
    __device__ __forceinline__ void a_offs(const Unit& u, const int (&R)[2], const int (&C2)[2], unsigned (&v)[2][2]) const {
#pragma unroll
        for (int h = 0; h < 2; ++h)
#pragma unroll
            for (int i = 0; i < 2; ++i) { const int row = u.m0 + h * 128 + R[i], kvh = row & 1, bj = row >> 1, b = bj >> 7, j = bj & 127;
                v[h][i] = (unsigned)((((u.e * B_ + b) * 2 + kvh) * S_ + 16 * j + 4 * u.rbase) * 128) * 2u + (unsigned)C2[i]; } }
    __device__ __forceinline__ const char* a_base() const { return (const char*)A; }
    __device__ __forceinline__ const char* b_base(const Unit& u) const { return (const char*)(Bt + ((size_t)u.e * 512 + u.n0) * KK + u.rbase * 512); }
    __device__ __forceinline__ void epi(const f32x4 (&acc)[2][2][4][2], const Unit& u, int wr, int wc, int fr, int fq, LAS unsigned char*) const {
        float* base = C + ((size_t)(u.e * 4 + u.rbase) * 2048) * 512;
#pragma unroll
        for (int ai = 0; ai < 2; ++ai)
#pragma unroll
            for (int m = 0; m < 4; ++m) { const int row = u.m0 + ai * 128 + wr * 64 + m * 16 + fr;
#pragma unroll
                for (int bj = 0; bj < 2; ++bj)
#pragma unroll
                    for (int n = 0; n < 2; ++n) { const int col = u.n0 + bj * 128 + wc * 32 + n * 16 + fq * 4;
                        *(f32x4*)(base + (size_t)row * 512 + col) = acc[ai][bj][m][n]; } } }
};
struct MoeTab { const LAS int* t; int NT; int i0, i1;
    __device__ __forceinline__ bool find_i(int i, Unit& u) const {
        if (i + i0 >= i1) return false;
        const LAS int* q = t + 128 + 8 * (i + i0);
        if (__builtin_amdgcn_readfirstlane(q[5]) == 0) return false;
        u.e = __builtin_amdgcn_readfirstlane(q[0]); u.m0 = __builtin_amdgcn_readfirstlane(q[1]); u.n0 = __builtin_amdgcn_readfirstlane(q[2]); u.cnt = __builtin_amdgcn_readfirstlane(q[3]); u.rbase = __builtin_amdgcn_readfirstlane(q[4]); return true; } };
__device__ __forceinline__ void moe_build(LAS int* t, int G, int vcu) {
    const int i = threadIdx.x;
    if (i < 40) { const int L = i * G + vcu; LAS int* q = t + 128 + 8 * i;
        if (L >= t[98]) q[5] = 0;
        else { int e = 0; for (; e < NE - 1; ++e) { if (L < t[32 + e + 1]) break; }
            const int ub = t[32 + e], cn = t[e], rs = t[65 + e]; const int nm = (cn + 255) >> 8, v = L - ub, mt = v % nm, ntile = v / nm;
            q[0] = e; q[1] = mt * 256; q[2] = ntile * 256; q[3] = min(256, cn - mt * 256); q[4] = rs; q[5] = 1; } }
}
struct ProbGu {
    static constexpr int NT = 16; static constexpr size_t KS2 = 256; static constexpr unsigned ROWB = 2048; static constexpr bool I8 = true;
    static constexpr bool PERM = true; static constexpr bool CD = true;
    const signed char* A; const signed char* Bt; unsigned char* act; const float* bgu; const int* list; const float* sa; const float* sw; MoeTab tab; int G, vcu;
    __device__ __forceinline__ bool next(int i, Unit& u) const { return tab.find_i(i, u); }
    __device__ __forceinline__ void a_offs(const Unit& u, const int (&R)[2], const int (&C2)[2], unsigned (&v)[2][2]) const {
#pragma unroll
        for (int h = 0; h < 2; ++h)
#pragma unroll
            for (int i = 0; i < 2; ++i) { int r = h * 128 + R[i]; r = r < u.cnt ? r : 0; const int a = list[(size_t)u.e * T_ + u.m0 + r]; v[h][i] = (unsigned)(a >> 2) * 2048u + (unsigned)C2[i]; } }
    __device__ __forceinline__ const char* a_base() const { return (const char*)A; }
    __device__ __forceinline__ const char* b_base(const Unit& u) const { return (const char*)(Bt + ((size_t)u.e * 4096 + u.n0) * 2048); }
    __device__ __forceinline__ void const_dma(const Unit& u, LAS unsigned char* lds, int wid, int lane) const {
        if (wid < 4) { cdma(lds, 0, wid, bgu + (size_t)u.e * 4096 + u.n0 + wid * 64 + lane); const int r = wid * 64 + lane; cdma(lds, 2, wid, sa + (size_t)u.e * T_ + u.m0 + (r < u.cnt ? r : 0)); }
        else cdma(lds, 1, wid - 4, sw + (size_t)u.e * 4096 + u.n0 + (wid - 4) * 64 + lane);
    }
    __device__ __forceinline__ void epi(const i32x4 (&acc)[2][2][4][2], const Unit& u, int wr, int wc, int fr, int fq, LAS unsigned char* lds) const {
        asm volatile("s_waitcnt vmcnt(16)" ::: "memory");
        ep_sync();
        const LAS float* cst = (const LAS float*)(lds + CONST_OFF);
        const int tg = ep_tid() & 255, rrow = tg >> 4, ch = tg & 15;
        f32x4 b0[2], b1[2], s0[2], s1[2];
#pragma unroll
        for (int bj = 0; bj < 2; ++bj) { const int col = bj * 128 + wc * 32 + fq * 8;
            b0[bj] = *(const LAS f32x4*)(cst + col); b1[bj] = *(const LAS f32x4*)(cst + col + 4); s0[bj] = *(const LAS f32x4*)(cst + 256 + col); s1[bj] = *(const LAS f32x4*)(cst + 256 + col + 4); }
        float srv[8];
#pragma unroll
        for (int q = 0; q < 8; ++q) srv[q] = cst[512 + (q >> 2) * 128 + wr * 64 + (q & 3) * 16 + fr];
        LAS unsigned char* ep2 = lds + EP_OFF + wr * (2 * 4608);
#define GU_WRITE(st) do { const int ai_ = (st) >> 1, mp_ = (st) & 1; LAS unsigned char* eb = ep2 + ((st) & 1) * 4608; \
            _Pragma("unroll") for (int mm = 0; mm < 2; ++mm) { const int m_ = mp_ * 2 + mm; const float sr = srv[ai_ * 4 + m_]; \
                _Pragma("unroll") for (int bj = 0; bj < 2; ++bj) { const i32x4 i0 = acc[ai_][bj][m_][0], i1 = acc[ai_][bj][m_][1]; \
                    const f32x4 v0 = (f32x4){(float)i0[0], (float)i0[1], (float)i0[2], (float)i0[3]} * (s0[bj] * sr) + b0[bj], v1 = (f32x4){(float)i1[0], (float)i1[1], (float)i1[2], (float)i1[3]} * (s1[bj] * sr) + b1[bj]; \
                    *(LAS unsigned*)(eb + (mm * 16 + fr) * 144 + (bj * 64 + wc * 16 + fq * 4)) = pk4_fp8(swiglu_fast(v0[0], v0[1]), swiglu_fast(v0[2], v0[3]), swiglu_fast(v1[0], v1[1]), swiglu_fast(v1[2], v1[3])); } } } while (0)
        GU_WRITE(0);
        ep_sync();
#pragma unroll
        for (int st = 0; st < 4; ++st) {
            if (st + 1 < 4) GU_WRITE(st + 1);
#pragma unroll
            for (int mm = 0; mm < 2; ++mm) { const u32x2 x0 = *(const LAS u32x2*)(ep2 + (st & 1) * 4608 + (mm * 16 + rrow) * 144 + ch * 8);
                const int rr = (st >> 1) * 128 + wr * 64 + ((st & 1) * 2 + mm) * 16 + rrow;
                if (rr < u.cnt) *(u32x2*)(act + (size_t)(u.rbase + u.m0 + rr) * 2048 + (u.n0 >> 1) + ch * 8) = x0; }
            ep_sync();
        }
#undef GU_WRITE
    }
};
struct ProbDn {
    static constexpr int NT = 16; static constexpr size_t KS2 = 256; static constexpr unsigned ROWB = 2048; static constexpr bool I8 = true;
    static constexpr bool PERM = true; static constexpr bool CD = true;
    const signed char* A; const signed char* Bt; unsigned char* y; const float* bdn; const int* list; const float* gate; const float* sa; const float* sw; MoeTab tab; int G, vcu;
    __device__ __forceinline__ bool next(int i, Unit& u) const { return tab.find_i(i, u); }
    __device__ __forceinline__ void a_offs(const Unit& u, const int (&R)[2], const int (&C2)[2], unsigned (&v)[2][2]) const {
#pragma unroll
        for (int h = 0; h < 2; ++h)
#pragma unroll
            for (int i = 0; i < 2; ++i) v[h][i] = (unsigned)(u.rbase + u.m0 + h * 128 + R[i]) * 2048u + (unsigned)C2[i]; }
    __device__ __forceinline__ const char* a_base() const { return (const char*)A; }
    __device__ __forceinline__ const char* b_base(const Unit& u) const { return (const char*)(Bt + ((size_t)u.e * 2048 + u.n0) * 2048); }
    __device__ __forceinline__ void const_dma(const Unit& u, LAS unsigned char* lds, int wid, int lane) const {
        const int i4 = wid & 3, r = i4 * 64 + lane, rc = r < u.cnt ? r : 0;
        if (wid < 4) { cdma(lds, 0, i4, bdn + (size_t)u.e * 2048 + u.n0 + r); cdma(lds, 2, i4, sa + u.rbase + u.m0 + rc); cdma(lds, 4, i4, list + (size_t)u.e * T_ + u.m0 + rc); }
        else { cdma(lds, 1, i4, sw + (size_t)u.e * 2048 + u.n0 + r); cdma(lds, 3, i4, gate + (size_t)u.e * T_ + u.m0 + rc); }
    }
    __device__ __forceinline__ void epi(const i32x4 (&acc)[2][2][4][2], const Unit& u, int wr, int wc, int fr, int fq, LAS unsigned char* lds) const {
        asm volatile("s_waitcnt vmcnt(16)" ::: "memory");
        ep_sync();
        const LAS float* cst = (const LAS float*)(lds + CONST_OFF);
        LAS unsigned char* ep = lds + EP_OFF + wr * (2 * 4352);
        const int tg = ep_tid() & 255, rrow = tg >> 4, ch = tg & 15;
        f32x4 b0[2], b1[2], s0[2], s1[2];
#pragma unroll
        for (int bj = 0; bj < 2; ++bj) { const int col = bj * 128 + wc * 32 + fq * 8;
            b0[bj] = *(const LAS f32x4*)(cst + col); b1[bj] = *(const LAS f32x4*)(cst + col + 4); s0[bj] = *(const LAS f32x4*)(cst + 256 + col); s1[bj] = *(const LAS f32x4*)(cst + 256 + col + 4); }
        float gv[8], srv[8]; int a2v[8];
#pragma unroll
        for (int q = 0; q < 8; ++q) { const int rl = (q >> 2) * 128 + wr * 64 + (q & 3) * 16 + fr; gv[q] = cst[768 + rl]; srv[q] = cst[512 + rl];
            a2v[q] = ((const LAS int*)cst)[1024 + (q >> 2) * 128 + wr * 64 + (q & 3) * 16 + rrow]; }
#define DN_WRITE(st) do { const int ai_ = (st) >> 2, m_ = (st) & 3; const float g = gv[st] * 16.f, sr = srv[st]; LAS unsigned char* eb = ep + ((st) & 1) * 4352; \
            _Pragma("unroll") for (int bj = 0; bj < 2; ++bj) { const i32x4 i0 = acc[ai_][bj][m_][0], i1 = acc[ai_][bj][m_][1]; \
                const f32x4 v0 = ((f32x4){(float)i0[0], (float)i0[1], (float)i0[2], (float)i0[3]} * (s0[bj] * sr) + b0[bj]) * g, v1 = ((f32x4){(float)i1[0], (float)i1[1], (float)i1[2], (float)i1[3]} * (s1[bj] * sr) + b1[bj]) * g; \
                u32x2 o; o[0] = pk4_fp8(__builtin_amdgcn_fmed3f(v0[0], -440.f, 440.f), __builtin_amdgcn_fmed3f(v0[1], -440.f, 440.f), __builtin_amdgcn_fmed3f(v0[2], -440.f, 440.f), __builtin_amdgcn_fmed3f(v0[3], -440.f, 440.f)); o[1] = pk4_fp8(__builtin_amdgcn_fmed3f(v1[0], -440.f, 440.f), __builtin_amdgcn_fmed3f(v1[1], -440.f, 440.f), __builtin_amdgcn_fmed3f(v1[2], -440.f, 440.f), __builtin_amdgcn_fmed3f(v1[3], -440.f, 440.f)); \
                *(LAS u32x2*)(eb + fr * 272 + (bj * 128 + wc * 32 + fq * 8)) = o; } } while (0)
        DN_WRITE(0);
        ep_sync();
#pragma unroll
        for (int st = 0; st < 8; ++st) {
            if (st + 1 < 8) DN_WRITE(st + 1);
            const int rr = (st >> 2) * 128 + wr * 64 + (st & 3) * 16 + rrow;
            const u32x4 x0 = *(const LAS u32x4*)(ep + (st & 1) * 4352 + rrow * 272 + ch * 16);
            if (rr < u.cnt) *(u32x4*)(y + (size_t)a2v[st] * 2048 + u.n0 + ch * 16) = x0;
            ep_sync();
        }
#undef DN_WRITE
    }
};
}

namespace at8 {
typedef float f32x16 __attribute__((ext_vector_type(16)));
typedef short s16x4 __attribute__((ext_vector_type(4)));
typedef unsigned u32x4 __attribute__((ext_vector_type(4)));
constexpr int SHM_K = 64 * 128 * 2, SHM_V = 64 * 128 * 2, SLOT = SHM_K + SHM_V;
constexpr int NSLOT = 4;
constexpr int LDS_WS = NSLOT * SLOT;
constexpr int LDS_END = LDS_WS + 8 * 64 * 4;
constexpr float CEXP = ATT_SCALE * 1.4426950408889634f;
constexpr float THR_RAW = 8.f / ATT_SCALE;
#define AT_KSWZ(row, colB) ((row) * 256 + ((colB) ^ (((row) & 7) << 4)))
#define AT_SBAR() __builtin_amdgcn_sched_barrier(0)
__device__ __forceinline__ int crow(int r, int hi) { return (r & 3) + 8 * (r >> 2) + 4 * hi; }
__device__ __forceinline__ unsigned cvtpk(float lo, float hi) { auto v = __builtin_amdgcn_cvt_pkrtz(lo, hi); return *reinterpret_cast<unsigned*>(&v); }
__device__ __forceinline__ int v_st(int k, int c) { const int kk = (k & ~0xC) | ((k & 4) << 1) | ((k & 8) >> 1); return ((kk >> 3) * 4 + (c >> 5)) * 512 + ((kk & 7) * 32 + (c & 31)) * 2; }
__device__ __forceinline__ int v_rd_base(int lane) { return ((lane & 3) << 3) | (((lane >> 2) & 3) << 6) | (((lane >> 4) & 1) << 5) | (((lane >> 5) & 1) << 8); }
constexpr int v_rd_off(int d0, int ks, int half) { return d0 * 512 + ks * 4096 + half * 2048; }
template <int OFF> __device__ __forceinline__ s16x4 tr_read(int vb) { s16x4 r; asm volatile("ds_read_b64_tr_b16 %0, %1 offset:%2" : "=&v"(r) : "v"(vb), "i"(OFF) : "memory"); return r; }
__device__ __forceinline__ h8 mk8(s16x4 l, s16x4 h) { typedef short s16x8 __attribute__((ext_vector_type(8))); s16x8 w = {l[0], l[1], l[2], l[3], h[0], h[1], h[2], h[3]}; return *reinterpret_cast<h8*>(&w); }
template <int D0> __device__ __forceinline__ void pv_one(f32x16& od, int vb, h8 pa0, h8 pa1, h8 pa2, h8 pa3) {
    const s16x4 l0 = tr_read<v_rd_off(D0, 0, 0)>(vb), h0 = tr_read<v_rd_off(D0, 0, 1)>(vb), l1 = tr_read<v_rd_off(D0, 1, 0)>(vb), h1 = tr_read<v_rd_off(D0, 1, 1)>(vb);
    const s16x4 l2 = tr_read<v_rd_off(D0, 2, 0)>(vb), h2 = tr_read<v_rd_off(D0, 2, 1)>(vb), l3 = tr_read<v_rd_off(D0, 3, 0)>(vb), h3 = tr_read<v_rd_off(D0, 3, 1)>(vb);
    asm volatile("s_waitcnt lgkmcnt(0)" ::: "memory"); AT_SBAR();
    od = __builtin_amdgcn_mfma_f32_32x32x16_f16(pa0, mk8(l0, h0), od, 0, 0, 0);
    od = __builtin_amdgcn_mfma_f32_32x32x16_f16(pa1, mk8(l1, h1), od, 0, 0, 0);
    od = __builtin_amdgcn_mfma_f32_32x32x16_f16(pa2, mk8(l2, h2), od, 0, 0, 0);
    od = __builtin_amdgcn_mfma_f32_32x32x16_f16(pa3, mk8(l3, h3), od, 0, 0, 0);
}
__device__ __forceinline__ void pv_d0(f32x16 (&o)[4], int vb, h8 pa0, h8 pa1, h8 pa2, h8 pa3) {
    pv_one<0>(o[0], vb, pa0, pa1, pa2, pa3); pv_one<1>(o[1], vb, pa0, pa1, pa2, pa3); pv_one<2>(o[2], vb, pa0, pa1, pa2, pa3); pv_one<3>(o[3], vb, pa0, pa1, pa2, pa3);
}
__device__ __forceinline__ void qkt(f32x16& p0, f32x16& p1, const char* Ks, const h8 (&qr)[8], int r32, int hi) {
    p0 = f32x16{}; p1 = f32x16{};
#pragma unroll
    for (int d0 = 0; d0 < 8; ++d0) { const int cb = (d0 * 16 + hi * 8) * 2;
        const h8 b0 = *reinterpret_cast<const h8*>(Ks + AT_KSWZ(r32, cb));
        const h8 b1 = *reinterpret_cast<const h8*>(Ks + AT_KSWZ(32 + r32, cb));
        p0 = __builtin_amdgcn_mfma_f32_32x32x16_f16(b0, qr[d0], p0, 0, 0, 0);
        p1 = __builtin_amdgcn_mfma_f32_32x32x16_f16(b1, qr[d0], p1, 0, 0, 0); }
}
__device__ __forceinline__ void pack_p(const f32x16& p0, const f32x16& p1, h8& pa0, h8& pa1, h8& pa2, h8& pa3) {
#define AT_PK4(P, BASE, OUT) do { unsigned a0 = cvtpk(P[BASE + 0], P[BASE + 1]), a1 = cvtpk(P[BASE + 2], P[BASE + 3]); \
    unsigned b0 = cvtpk(P[BASE + 4], P[BASE + 5]), b1 = cvtpk(P[BASE + 6], P[BASE + 7]); \
    auto r0 = __builtin_amdgcn_permlane32_swap(a0, b0, false, false); auto r1 = __builtin_amdgcn_permlane32_swap(a1, b1, false, false); \
    u32x4 w = {r0[0], r1[0], r0[1], r1[1]}; OUT = *reinterpret_cast<h8*>(&w); } while (0)
    AT_PK4(p0, 0, pa0); AT_PK4(p0, 8, pa1); AT_PK4(p1, 0, pa2); AT_PK4(p1, 8, pa3);
#undef AT_PK4
}
__device__ __forceinline__ float half_swap_max(float v) { auto rr = __builtin_amdgcn_permlane32_swap(__float_as_uint(v), __float_as_uint(v), false, false); return fmaxf(__uint_as_float(rr[0]), __uint_as_float(rr[1])); }
__device__ __forceinline__ float half_swap_sum(float v) { auto rr = __builtin_amdgcn_permlane32_swap(__float_as_uint(v), __float_as_uint(v), false, false); return __uint_as_float(rr[0]) + __uint_as_float(rr[1]); }

__device__ __forceinline__ int hidden_tid() { int tz = threadIdx.x; asm volatile("" : "+v"(tz)); return tz; }
__device__ __forceinline__ void dma_offsets(int ld, int (&ko)[2], int (&vo)[2]) {
    const int tz = hidden_tid(), w = tz >> 6, l = tz & 63;
#pragma unroll
    for (int q = 0; q < 2; ++q) {
        const int rr = 4 * (2 * w + q) + (l >> 4), pp = l & 15;
        ko[q] = rr * ld + ((pp ^ (rr & 7)) * 8);
        const int L = (2 * w + q) * 1024 + l * 16, sidx = L >> 9, o = L & 511;
        const int kk = (sidx >> 2) * 8 + (o >> 6), c = (sidx & 3) * 32 + ((o & 63) >> 1);
        const int k = (kk & ~0xC) | ((kk & 4) << 1) | ((kk & 8) >> 1);
        vo[q] = k * ld + c;
    }
}
__device__ __forceinline__ void dma_tile(char* slot, const _Float16* Kb, const _Float16* Vb, int ld, int tile, const int (&ko)[2], const int (&vo)[2], int wid) {
    const _Float16* kt = Kb + (size_t)tile * 64 * ld; const _Float16* vt = Vb + (size_t)tile * 64 * ld;
#pragma unroll
    for (int q = 0; q < 2; ++q) __builtin_amdgcn_global_load_lds((const unsigned*)(kt + ko[q]), (LAS unsigned*)(slot + (2 * wid + q) * 1024), 16, 0, 0);
#pragma unroll
    for (int q = 0; q < 2; ++q) __builtin_amdgcn_global_load_lds((const unsigned*)(vt + vo[q]), (LAS unsigned*)(slot + SHM_K + (2 * wid + q) * 1024), 16, 0, 0);
}
#define AT_WAITV(n) asm volatile("s_waitcnt vmcnt(" #n ")" ::: "memory")
#define AT_BAR() do { asm volatile("s_waitcnt lgkmcnt(0)" ::: "memory"); __builtin_amdgcn_s_barrier(); asm volatile("" ::: "memory"); } while (0)

__device__ __forceinline__ void attn_unit(char* lds, const _Float16* qrow, const _Float16* Kb, const _Float16* Vb, int ld, unsigned tmask, int wlen, int khi, unsigned selmask,
                                          _Float16* outw, int ostride) {
    const int tid = threadIdx.x, wid = __builtin_amdgcn_readfirstlane(tid >> 6), lane = tid & 63, r32 = lane & 31, hi = lane >> 5;
    float* wsf = (float*)(lds + LDS_WS) + wid * 64; float* li_l = wsf; float* al_l = wsf + 32;
    float m_reg = -1e30f, l_reg = 0.f; f32x16 o[4] = {}; h8 qr[8];
#pragma unroll
    for (int d0 = 0; d0 < 8; ++d0) qr[d0] = *(const h8*)(qrow + d0 * 16);
    int ko[2], vo[2]; dma_offsets(ld, ko, vo);
    const int vbase = (int)(uintptr_t)lds + SHM_K + v_rd_base(lane);
    unsigned rest = tmask; int j = __ffs(rest) - 1; rest &= rest - 1;
    int j1 = rest ? (__ffs(rest) - 1) : -1; if (j1 >= 0) rest &= rest - 1;
    dma_tile(lds, Kb, Vb, ld, j, ko, vo, wid);
    if (j1 >= 0) { dma_tile(lds + SLOT, Kb, Vb, ld, j1, ko, vo, wid); AT_WAITV(4); } else { AT_WAITV(0); }
    AT_BAR();
    int so = 0, sp = 0;
    const bool roleB = wid >= 4;
    bool first = true;
    h8 pa0, pa1, pa2, pa3;
    for (;;) {
        const int j2 = rest ? (__ffs(rest) - 1) : -1;
        if (j2 >= 0) { rest &= rest - 1; int s2 = so + 2 * SLOT; s2 = s2 >= NSLOT * SLOT ? s2 - NSLOT * SLOT : s2; dma_tile(lds + s2, Kb, Vb, ld, j2, ko, vo, wid); }
        if (roleB && !first) { AT_SBAR(); pv_d0(o, vbase + sp, pa0, pa1, pa2, pa3); }
        f32x16 p0, p1;
        AT_SBAR(); qkt(p0, p1, lds + so, qr, r32, hi);
        { const int klo = wlen > 0 ? khi - wlen + 1 : 0; const bool tb = (selmask >> j) & 1u; const bool inr = (j * 64 >= klo) && (j * 64 + 63 <= khi);
          if (!__all(tb && inr)) {
              if (__all(inr)) {
#pragma unroll
                  for (int r = 0; r < 16; ++r) { p0[r] = tb ? p0[r] : -INFINITY; p1[r] = tb ? p1[r] : -INFINITY; }
              } else {
                  const int kb = j * 64 + 4 * hi;
#pragma unroll
                  for (int r = 0; r < 16; ++r) { const int k0 = kb + (r & 3) + 8 * (r >> 2);
                      p0[r] = (tb && k0 >= klo && k0 <= khi) ? p0[r] : -INFINITY;
                      p1[r] = (tb && (k0 + 32) >= klo && (k0 + 32) <= khi) ? p1[r] : -INFINITY; }
              } } }
        float pmax = p0[0];
#pragma unroll
        for (int r = 1; r < 16; ++r) pmax = fmaxf(pmax, p0[r]);
#pragma unroll
        for (int r = 0; r < 16; ++r) pmax = fmaxf(pmax, p1[r]);
        pmax = half_swap_max(pmax);
        float mn, alpha;
        if (__all(pmax - m_reg <= THR_RAW)) { mn = m_reg; alpha = 1.f; }
        else { mn = fmaxf(m_reg, pmax); alpha = __builtin_amdgcn_exp2f((m_reg - mn) * CEXP); m_reg = mn; }
        const float mnC = -mn * CEXP;
        float ps = 0.f;
#pragma unroll
        for (int r = 0; r < 16; ++r) { p0[r] = __builtin_amdgcn_exp2f(fmaf(p0[r], CEXP, mnC)); ps += p0[r]; }
#pragma unroll
        for (int r = 0; r < 16; ++r) { p1[r] = __builtin_amdgcn_exp2f(fmaf(p1[r], CEXP, mnC)); ps += p1[r]; }
        ps = half_swap_sum(ps);
        l_reg = l_reg * alpha + ps;
        if (__any(alpha < 1.f)) { if (hi == 0) al_l[r32] = alpha; asm volatile("s_waitcnt lgkmcnt(0)" ::: "memory");
#pragma unroll
            for (int r = 0; r < 16; ++r) { const float a = al_l[crow(r, hi)];
#pragma unroll
                for (int d = 0; d < 4; ++d) o[d][r] *= a; } }
        pack_p(p0, p1, pa0, pa1, pa2, pa3);
        AT_SBAR();
        if (!roleB) pv_d0(o, vbase + so, pa0, pa1, pa2, pa3);
        if (j1 < 0) break;
        if (j2 >= 0) { AT_WAITV(4); } else { AT_WAITV(0); }
        AT_BAR();
        j = j1; j1 = j2; sp = so; so += SLOT; so = so >= NSLOT * SLOT ? so - NSLOT * SLOT : so; first = false;
    }
    if (roleB) { AT_SBAR(); pv_d0(o, vbase + so, pa0, pa1, pa2, pa3); }
    if (hi == 0) li_l[r32] = l_reg; asm volatile("s_waitcnt lgkmcnt(0)" ::: "memory");
#pragma unroll
    for (int r = 0; r < 16; ++r) { const int orow = crow(r, hi); const float l = li_l[orow]; const float rl = l > 0.f ? 1.f / l : 0.f;
#pragma unroll
        for (int d0 = 0; d0 < 4; ++d0) outw[(size_t)orow * ostride + d0 * 32 + r32] = (_Float16)(o[d0][r] * rl); }
    __syncthreads();
}

constexpr int LDS_AP = 0, LDS_BP = LDS_AP + 4 * 64 * 33 * 4, LDS_SELM = LDS_END, LDS_CS_END = LDS_SELM + 64 * 4;
static_assert(LDS_BP + 4 * 64 * 33 * 4 <= NSLOT * SLOT, "importance partials must fit inside the ring");
__device__ __forceinline__ void cmp_slc_unit(char* lds, const _Float16* qrow, const _Float16* Kc, const _Float16* Vc, const _Float16* Ks, const _Float16* Vs, int t, int tl, int g, int qi,
                                             _Float16* outc, _Float16* outs) {
    const int tid = threadIdx.x, wid = __builtin_amdgcn_readfirstlane(tid >> 6), lane = tid & 63, r32 = lane & 31, hi = lane >> 5;
    float* AP = (float*)(lds + LDS_AP); float* BP = (float*)(lds + LDS_BP); unsigned* selm = (unsigned*)(lds + LDS_SELM);
    {
        h8 qr[8];
#pragma unroll
        for (int d0 = 0; d0 < 8; ++d0) qr[d0] = *(const h8*)(qrow + d0 * 16);
        const int vb0 = (int)(uintptr_t)lds + SHM_K + v_rd_base(lane);
        { int ko[2], vo[2]; dma_offsets(256, ko, vo);
          dma_tile(lds, Kc, Vc, 256, 0, ko, vo, wid); dma_tile(lds + SLOT, Kc, Vc, 256, 1, ko, vo, wid); }
        AT_WAITV(0); AT_BAR();
        f32x16 pA0, pA1, pB0, pB1;
        AT_SBAR(); qkt(pA0, pA1, lds, qr, r32, hi); qkt(pB0, pB1, lds + SLOT, qr, r32, hi);
        const int khi = t >= 31 ? ((t - 31) >> 4) : -1;
#pragma unroll
        for (int r = 0; r < 16; ++r) { const int c0 = 4 * hi + (r & 3) + 8 * (r >> 2);
            pA0[r] = (c0 <= khi) ? pA0[r] : -INFINITY; pA1[r] = (c0 + 32 <= khi) ? pA1[r] : -INFINITY;
            pB0[r] = (c0 + 64 <= khi) ? pB0[r] : -INFINITY; pB1[r] = (c0 + 96 <= khi) ? pB1[r] : -INFINITY; }
        float pmax = -INFINITY;
#pragma unroll
        for (int r = 0; r < 16; ++r) pmax = fmaxf(fmaxf(pmax, pA0[r]), fmaxf(pA1[r], fmaxf(pB0[r], pB1[r])));
        pmax = half_swap_max(pmax);
        const float mC = (pmax == -INFINITY) ? 0.f : -pmax * CEXP;
        float ps = 0.f;
#pragma unroll
        for (int r = 0; r < 16; ++r) { pA0[r] = __builtin_amdgcn_exp2f(fmaf(pA0[r], CEXP, mC)); pA1[r] = __builtin_amdgcn_exp2f(fmaf(pA1[r], CEXP, mC));
            pB0[r] = __builtin_amdgcn_exp2f(fmaf(pB0[r], CEXP, mC)); pB1[r] = __builtin_amdgcn_exp2f(fmaf(pB1[r], CEXP, mC)); ps += (pA0[r] + pA1[r]) + (pB0[r] + pB1[r]); }
        ps = half_swap_sum(ps);
        const float inv = ps > 0.f ? 1.f / ps : 0.f;
#pragma unroll
        for (int r = 0; r < 16; ++r) { pA0[r] *= inv; pA1[r] *= inv; pB0[r] *= inv; pB1[r] *= inv; }
        f32x16 o[4] = {};
        h8 pa0, pa1, pa2, pa3;
        pack_p(pA0, pA1, pa0, pa1, pa2, pa3); AT_SBAR(); pv_d0(o, vb0, pa0, pa1, pa2, pa3);
        pack_p(pB0, pB1, pa0, pa1, pa2, pa3); AT_SBAR(); pv_d0(o, vb0 + SLOT, pa0, pa1, pa2, pa3);
#pragma unroll
        for (int r = 0; r < 16; ++r) { const int orow = crow(r, hi);
#pragma unroll
            for (int d0 = 0; d0 < 4; ++d0) outc[(size_t)orow * 1024 + d0 * 32 + r32] = (_Float16)o[d0][r]; }
        __syncthreads();
        { float* ap = AP + (g * 64 + tl) * 33; float* bp = BP + (g * 64 + tl) * 33;
          if (hi == 0) bp[0] = 0.f;
#define AT_IMP(P, JB) do { _Pragma("unroll") for (int k = 0; k < 4; ++k) { const int j = (JB) + 2 * k + hi; \
              ap[j] = 2.f * (P[4 * k] + P[4 * k + 1] + P[4 * k + 2]) + P[4 * k + 3]; if (j + 1 < 32) bp[j + 1] = P[4 * k + 3]; } } while (0)
          AT_IMP(pA0, 0); AT_IMP(pA1, 8); AT_IMP(pB0, 16); AT_IMP(pB1, 24);
#undef AT_IMP
        }
    }
    __syncthreads();
#pragma unroll 1
    for (int it = 0; it < 4; ++it) {
        const int tk = 8 * wid + 2 * it + hi, j = r32;
        float imp = 0.f;
#pragma unroll
        for (int gg = 0; gg < 4; ++gg) imp += AP[(gg * 64 + tk) * 33 + j] + BP[(gg * 64 + tk) * 33 + j];
        const bool forced = (j == 0) || (j == qi) || (j == qi - 1), valid = j <= qi;
        const float iv = forced ? 1e9f : (valid ? imp : -1e9f);
        int rank = 0;
        for (int i = 0; i < 32; ++i) { const float vi = __shfl(iv, i + 32 * hi); rank += (vi > iv || (vi == iv && i < j)) ? 1 : 0; }
        const unsigned long long bal = __ballot(rank < 16 && valid);
        if (r32 == 0) selm[tk] = (unsigned)(bal >> (32 * hi));
    }
    __syncthreads();
    unsigned tm = selm[lane];
#pragma unroll
    for (int o = 32; o > 0; o >>= 1) tm |= __shfl_xor(tm, o);
    const int tz2 = hidden_tid();
    const unsigned mysel = selm[((tz2 >> 6) & 1) * 32 + (tz2 & 31)];
    attn_unit(lds, qrow, Ks, Vs, 128, tm, 0, t, mysel, outs, 1024);
}
}

struct CUnit { const float* W; int ldw; int nvalid; _Float16* Wt; int k0; int n0; };
__device__ __forceinline__ CUnit conv_desc(int u, const float* win, const float* w1k, const float* w1v, const float* wmkv, _Float16* wtin, _Float16* wt1, _Float16* wtmkv) {
    CUnit d;
    if (u < 160) { d.W = win; d.ldw = INW; d.nvalid = INW; d.Wt = wtin; d.k0 = (u / 5) * 64; d.n0 = (u % 5) * 256; }
    else if (u < 288) { const int v = u - 160, kv = v >> 6, part = (v >> 5) & 1, kt = v & 31;
        d.W = (kv ? w1v : w1k) + (size_t)part * 2048 * 256; d.ldw = 256; d.nvalid = 256; d.Wt = wt1 + ((size_t)kv * 512 + part * 256) * 2048; d.k0 = kt * 64; d.n0 = 0; }
    else { d.W = wmkv; d.ldw = 1024; d.nvalid = 1024; d.Wt = wtmkv; d.k0 = 0; d.n0 = 0; }
    return d;
}
__device__ __forceinline__ void conv_all(float* lds, const float* win, const float* w1k, const float* w1v, const float* wmkv, _Float16* wtin, _Float16* wt1, _Float16* wtmkv, int bid, int nb) {
    constexpr int NU = 160 + 128;
    const int tid = threadIdx.x;
    int u = bid; if (u >= NU) return;
    CUnit d = conv_desc(u, win, w1k, w1v, wmkv, wtin, wt1, wtmkv);
    float4 v[8];
#define CL(D) do { _Pragma("unroll") for (int i = 0; i < 8; ++i) { const int idx = tid + 512 * i, r = idx >> 6, c4 = (idx & 63) * 4; \
        v[i] = ((D).n0 + c4 < (D).nvalid) ? *(const float4*)((D).W + (size_t)((D).k0 + r) * (D).ldw + (D).n0 + c4) : make_float4(0.f, 0.f, 0.f, 0.f); } } while (0)
    CL(d);
    for (;;) {
#pragma unroll
        for (int i = 0; i < 8; ++i) { const int idx = tid + 512 * i, r = idx >> 6, c4 = (idx & 63) * 4; float* dd = lds + r * 257 + c4; dd[0] = v[i].x; dd[1] = v[i].y; dd[2] = v[i].z; dd[3] = v[i].w; }
        __syncthreads();
        const int un = u + nb; const bool has = un < NU;
        CUnit dn = d; if (has) { dn = conv_desc(un, win, w1k, w1v, wmkv, wtin, wt1, wtmkv); CL(dn); }
#pragma unroll
        for (int j = 0; j < 4; ++j) { const int id = tid + 512 * j, n = id >> 3, k8 = (id & 7) * 8; h8 o;
#pragma unroll
            for (int q = 0; q < 8; ++q) o[q] = (_Float16)lds[(k8 + q) * 257 + n];
            *(h8*)(d.Wt + (size_t)(d.n0 + n) * 2048 + d.k0 + k8) = o; }
        __syncthreads();
        if (!has) break;
        u = un; d = dn;
    }
#undef CL
}

__device__ __forceinline__ unsigned pack4_i8(float a, float b, float c, float d) {
    const int ia = __float2int_rn(a), ib = __float2int_rn(b), ic = __float2int_rn(c), id = __float2int_rn(d);
    return (unsigned)(ia & 255) | ((unsigned)(ib & 255) << 8) | ((unsigned)(ic & 255) << 16) | ((unsigned)(id & 255) << 24);
}
constexpr int QP_LD2 = 1026;
struct QUnit { const float* W; int ldw; int n0; signed char* Q; float* sc; int nvalid; };
struct QExtra { const float* win; signed char* q8in; float* sin8; const float* wmkv; signed char* q8mkv; float* smkv; };
__device__ __forceinline__ QUnit quant_desc(int u, const float* wgu, const float* wdn, signed char* q8gu, signed char* q8dn, float* sgu, float* sdn, const float* wout, signed char* q8out, float* sout, const QExtra& x) {
    QUnit d; d.nvalid = 1 << 30;
    if (u >= NE * 192 + 64 + 73) { const int pn = u - (NE * 192 + 64 + 73); d.W = x.wmkv; d.ldw = 1024; d.n0 = pn * 32; d.Q = x.q8mkv; d.sc = x.smkv; }
    else if (u >= NE * 192 + 64) { const int pn = u - (NE * 192 + 64); d.W = x.win; d.ldw = INW; d.n0 = 1280 + pn * 32; d.Q = x.q8in - (size_t)1280 * 2048; d.sc = x.sin8 - 1280; d.nvalid = INW; }
    else if (u >= NE * 192) { const int pn = u - NE * 192; d.W = wout; d.ldw = 2048; d.n0 = pn * 32; d.Q = q8out; d.sc = sout; }
    else if (u < NE * 128) { const int e = u >> 7, pn = u & 127; d.W = wgu + (size_t)e * 2048 * 4096; d.ldw = 4096; d.n0 = pn * 32; d.Q = q8gu + (size_t)e * 4096 * 2048; d.sc = sgu + (size_t)e * 4096; }
    else { const int v = u - NE * 128, e = v >> 6, pn = v & 63; d.W = wdn + (size_t)e * 2048 * 2048; d.ldw = 2048; d.n0 = pn * 32; d.Q = q8dn + (size_t)e * 2048 * 2048; d.sc = sdn + (size_t)e * 2048; }
    return d;
}
__device__ __forceinline__ unsigned pk2h(float a, float b) { auto v = __builtin_amdgcn_cvt_pkrtz(a, b); return *reinterpret_cast<unsigned*>(&v); }
template <bool DYN>
__device__ __forceinline__ void quant_units(char* smem, const float* wgu, const float* wdn, signed char* q8gu, signed char* q8dn, float* sgu, float* sdn, const float* wout, signed char* q8out, float* sout, const QExtra& qx,
                                            int ubase, int nun, unsigned* ctr, int maxu, int bid, int nb) {
    typedef _Float16 h2v __attribute__((ext_vector_type(2)));
    typedef unsigned qu4 __attribute__((ext_vector_type(4)));
    unsigned* cmaxb = (unsigned*)(smem + g8::EP_OFF);
    volatile LAS int* slot = (volatile LAS int*)(smem + g8::EP_OFF + 256);
    int tid = threadIdx.x; asm volatile("" : "+v"(tid));
    const int c4 = (tid & 7) * 4, rg = tid >> 3;
    if (tid < 64) cmaxb[tid] = 0u;
    if (DYN) { if (tid == 0) slot[0] = maxu > 0 ? (int)__hip_atomic_fetch_add(ctr, 1u, __ATOMIC_RELAXED, __HIP_MEMORY_SCOPE_AGENT) : 0x7fffffff; }
    __syncthreads();
    int u = DYN ? slot[0] : bid;
    if (u >= nun) { __syncthreads(); return; }
    int taken = 1;
    QUnit d = quant_desc(ubase + u, wgu, wdn, q8gu, q8dn, sgu, sdn, wout, q8out, sout, qx);
    float4 L[32];
    char* hb = smem + tid * 16;
#define QLD(D, en) do { const char* p0 = (const char*)((D).W + (D).n0); const int cc = ((D).n0 + c4 < (D).nvalid) ? c4 : 0;     \
        const unsigned vo = (unsigned)(rg * 16 * (D).ldw + cc) * 4u, ldb = (unsigned)(D).ldw * 4u; \
        if (en) { _Pragma("unroll") for (int j = 0; j < 16; ++j) { L[j] = *(const float4*)(p0 + (size_t)(j * ldb) + vo); L[16 + j] = *(const float4*)(p0 + (size_t)((1024 + j) * ldb) + vo); } } \
        else { _Pragma("unroll") for (int j = 0; j < 32; ++j) L[j] = make_float4(0.f, 0.f, 0.f, 0.f); } } while (0)
#define QPK(a, b) ({ h2v t_; t_[0] = (_Float16)(a); t_[1] = (_Float16)(b); __builtin_bit_cast(unsigned, t_); })
#define QW(comp, ci) do { _Pragma("unroll") for (int hq = 0; hq < 4; ++hq) { uint4 w_; w_.x = QPK(L[hq * 8 + 0].comp, L[hq * 8 + 1].comp); w_.y = QPK(L[hq * 8 + 2].comp, L[hq * 8 + 3].comp); \
        w_.z = QPK(L[hq * 8 + 4].comp, L[hq * 8 + 5].comp); w_.w = QPK(L[hq * 8 + 6].comp, L[hq * 8 + 7].comp); *(uint4*)(hb + ((ci) * 4 + hq) * 8192) = w_; } } while (0)
#define QINV(x) ({ const float iv_ = (x) > 0.f ? fminf(127.f / (x), 65504.f) : 0.f; __builtin_bit_cast(unsigned, __builtin_amdgcn_cvt_pkrtz(iv_, iv_)); })
#define QF(w, iv) __builtin_bit_cast(unsigned, __builtin_elementwise_fma(__builtin_bit_cast(h2v, (unsigned)(w)), __builtin_bit_cast(h2v, (unsigned)(iv)), __builtin_bit_cast(h2v, 0x66006600u)))
#define QS(ci, half, iv) do { const uint4 w0 = *(const uint4*)(hb + ((ci) * 4 + (half) * 2) * 8192), w1 = *(const uint4*)(hb + ((ci) * 4 + (half) * 2 + 1) * 8192); uint4 o; \
        o.x = __builtin_amdgcn_perm(QF(w0.y, iv), QF(w0.x, iv), 0x06040200u); o.y = __builtin_amdgcn_perm(QF(w0.w, iv), QF(w0.z, iv), 0x06040200u); \
        o.z = __builtin_amdgcn_perm(QF(w1.y, iv), QF(w1.x, iv), 0x06040200u); o.w = __builtin_amdgcn_perm(QF(w1.w, iv), QF(w1.z, iv), 0x06040200u); \
        *(__attribute__((address_space(1))) qu4*)(d.Q + (size_t)(d.n0 + c4 + (ci)) * 2048 + (half) * 1024 + rg * 16) = (qu4){o.x, o.y, o.z, o.w}; } while (0)
    QLD(d, true);
    int par = 0;
    for (;;) {
        unsigned* cmax = cmaxb + par * 32;
        float m0 = 0.f, m1 = 0.f, m2 = 0.f, m3 = 0.f;
        if (DYN) { if (tid == 0) slot[par ^ 1] = taken < maxu ? (int)__hip_atomic_fetch_add(ctr, 1u, __ATOMIC_RELAXED, __HIP_MEMORY_SCOPE_AGENT) : 0x7fffffff; }
#pragma unroll
        for (int i = 0; i < 32; ++i) { m0 = fmaxf(m0, fabsf(L[i].x)); m1 = fmaxf(m1, fabsf(L[i].y)); m2 = fmaxf(m2, fabsf(L[i].z)); m3 = fmaxf(m3, fabsf(L[i].w)); }
        QW(x, 0); QW(y, 1); QW(z, 2); QW(w, 3);
        atomicMax(&cmax[c4 + 0], __float_as_uint(m0)); atomicMax(&cmax[c4 + 1], __float_as_uint(m1)); atomicMax(&cmax[c4 + 2], __float_as_uint(m2)); atomicMax(&cmax[c4 + 3], __float_as_uint(m3));
        __syncthreads();
        const int un = DYN ? slot[par ^ 1] : u + nb; const bool has = un < nun;
        QUnit dn = d; if (has) dn = quant_desc(ubase + un, wgu, wdn, q8gu, q8dn, sgu, sdn, wout, q8out, sout, qx);
        QLD(dn, has);
        if (tid < 32) cmaxb[(par ^ 1) * 32 + tid] = 0u;
        const float x0 = __uint_as_float(cmax[c4 + 0]), x1 = __uint_as_float(cmax[c4 + 1]), x2 = __uint_as_float(cmax[c4 + 2]), x3 = __uint_as_float(cmax[c4 + 3]);
        const unsigned i0 = QINV(x0), i1 = QINV(x1), i2 = QINV(x2), i3 = QINV(x3);
        QS(0, 0, i0); QS(1, 0, i1); QS(2, 0, i2); QS(3, 0, i3);
        QS(0, 1, i0); QS(1, 1, i1); QS(2, 1, i2); QS(3, 1, i3);
        if (tid < 32) { const float mx = __uint_as_float(cmax[tid]); const unsigned ih = QINV(mx); d.sc[d.n0 + tid] = mx > 0.f ? 1.f / (float)(__builtin_bit_cast(h2v, ih)[0]) : 1.f; }
        if (!has) break;
        u = un; d = dn; par ^= 1; ++taken;
        __syncthreads();
    }
    __syncthreads();
#undef QLD
#undef QPK
#undef QW
#undef QINV
#undef QF
#undef QS
}
__host__ __device__ constexpr int q_cnt(int k) { return k == 1 ? 1536 : k == 2 ? 768 : k == 3 ? 512 : k == 4 ? 512 : k == 5 ? 256 : k == 6 ? 256 : k == 7 ? 256 : k == 8 ? 2048 : 0; }
__host__ __device__ constexpr int q_beg(int k) { int s = 0; for (int i = 0; i < k; ++i) s += q_cnt(i); return s; }
static_assert(q_beg(8) == NE * 128 && q_beg(10) == NE * 192, "quota tables");
constexpr size_t CTL_QCTR = 20480;

__device__ __forceinline__ const float* karg_in(int i) {
    const __attribute__((address_space(4))) char* ka = (const __attribute__((address_space(4))) char*)__builtin_amdgcn_kernarg_segment_ptr();
    asm volatile("" : "+s"(ka));
    return *(const float* const __attribute__((address_space(4)))*)(ka + 8 * i);
}
#define DEFPTRS unsigned char* wsl_ = p.ws; asm volatile("" : "+s"(wsl_)); unsigned char* ws = wsl_; (void)ws; unsigned* ctl = (unsigned*)(wsl_ + WS_CTL); int* cnt = (int*)(wsl_ + CTL_CNT); float* proj = (float*)(wsl_ + WS_PROJ); float* kvmem = (float*)(wsl_ + WS_KVMEM); float* bias1 = (float*)(wsl_ + WS_BIAS1); float* hid = (float*)(wsl_ + WS_HID); float* kc = (float*)(wsl_ + WS_KC); float* vc = (float*)(wsl_ + WS_VC); float* pooled = (float*)(wsl_ + WS_POOLED); _Float16* opool = (_Float16*)(wsl_ + WS_OPOOL); _Float16* owin = (_Float16*)(wsl_ + WS_OWIN); _Float16* ocmp = (_Float16*)(wsl_ + WS_OCMP); _Float16* oslc = (_Float16*)(wsl_ + WS_OSLC); unsigned* sel = (unsigned*)(wsl_ + WS_SEL); _Float16* omem = (_Float16*)(wsl_ + WS_OMEM); _Float16* cat16 = (_Float16*)(wsl_ + WS_CAT16); _Float16* hpre16 = (_Float16*)(wsl_ + WS_HPRE); float* hbuf = (float*)(wsl_ + WS_H); float* gate = (float*)(wsl_ + WS_GATE); int* list = (int*)(wsl_ + WS_LIST); unsigned char* actf8 = (unsigned char*)(wsl_ + WS_ACT16); unsigned char* yf8 = (unsigned char*)(wsl_ + WS_Y16); _Float16* h16 = (_Float16*)(wsl_ + WS_H16); _Float16* x16 = (_Float16*)(wsl_ + WS_X16); _Float16* wtin = (_Float16*)(wsl_ + WS_WTIN); _Float16* wtout = (_Float16*)(wsl_ + WS_WTOUT); _Float16* wtgu = (_Float16*)(wsl_ + WS_WTGU); _Float16* wtdn = (_Float16*)(wsl_ + WS_WTDN); _Float16* proj16 = (_Float16*)(wsl_ + WS_PROJ16); _Float16* kvmem16 = (_Float16*)(wsl_ + WS_KVMEM16); _Float16* wt1 = (_Float16*)(wsl_ + WS_WT1); float* uv = (float*)(wsl_ + WS_UV); _Float16* kc16 = (_Float16*)(wsl_ + WS_KC16); _Float16* vc16 = (_Float16*)(wsl_ + WS_VC16); _Float16* wr16 = (_Float16*)(wsl_ + WS_WR16); _Float16* mem16 = (_Float16*)(wsl_ + WS_MEM16); _Float16* wtmkv = (_Float16*)(wsl_ + WS_WTMKV); _Float16* kv16 = (_Float16*)(wsl_ + WS_KV16); _Float16* wt2 = (_Float16*)(wsl_ + WS_WT2); float* sa2 = (float*)(wsl_ + WS_SA2); float* gate2 = (float*)(wsl_ + WS_GATE2); signed char* x8 = (signed char*)(wsl_ + WS_X8); float* sxa = (float*)(wsl_ + WS_SXA); signed char* q8in = (signed char*)(wsl_ + WS_Q8IN); float* sin8 = (float*)(wsl_ + WS_SIN8); signed char* q8mkv = (signed char*)(wsl_ + WS_Q8MKV); float* smkv = (float*)(wsl_ + WS_SMKV); signed char* q8out = (signed char*)(wsl_ + WS_Q8OUT); float* sout = (float*)(wsl_ + WS_SOUT); signed char* cat8 = (signed char*)(wsl_ + WS_CAT8); float* scat = (float*)(wsl_ + WS_SCAT); signed char* q8gu = (signed char*)(wsl_ + WS_Q8GU); signed char* q8dn = (signed char*)(wsl_ + WS_Q8DN); float* sgu = (float*)(wsl_ + WS_SGU); float* sdn = (float*)(wsl_ + WS_SDN); signed char* h8q = (signed char*)(wsl_ + WS_H8); float* sah = (float*)(wsl_ + WS_SAH); signed char* act8 = (signed char*)(wsl_ + WS_ACT8); float* sact = (float*)(wsl_ + WS_SACT);
__global__ void __launch_bounds__(512, 2) fwd(Params p) {
    extern __shared__ __attribute__((aligned(16))) char smem[];
    int tidk_ = threadIdx.x; asm volatile("" : "+v"(tidk_));
    const int tid = tidk_, wv = __builtin_amdgcn_readfirstlane(tid >> 6);
#define LANE_NOW ({ int _t = threadIdx.x; asm volatile("" : "+v"(_t)); _t & 63; })
    const int bid = blockIdx.x, nb = gridDim.x;
    const int gw = bid * 8 + wv, nw = nb * 8;
    const int lo = (int)(p.lo_hi & 0xffffffffll), hi = (int)(p.lo_hi >> 32);
    unsigned char* ws = p.ws;
    unsigned* ctl = (unsigned*)(ws + WS_CTL);
    int* cnt = (int*)(ws + CTL_CNT);
    float* proj = (float*)(ws + WS_PROJ);
    float* kvmem = (float*)(ws + WS_KVMEM);
    float* bias1 = (float*)(ws + WS_BIAS1);
    float* hid = (float*)(ws + WS_HID);
    float* kc = (float*)(ws + WS_KC);
    float* vc = (float*)(ws + WS_VC);
    float* pooled = (float*)(ws + WS_POOLED);
    _Float16* opool = (_Float16*)(ws + WS_OPOOL);
    _Float16* owin = (_Float16*)(ws + WS_OWIN);
    _Float16* ocmp = (_Float16*)(ws + WS_OCMP);
    _Float16* oslc = (_Float16*)(ws + WS_OSLC);
    unsigned* sel = (unsigned*)(ws + WS_SEL);
    _Float16* omem = (_Float16*)(ws + WS_OMEM);
    _Float16* cat16 = (_Float16*)(ws + WS_CAT16);
    _Float16* hpre16 = (_Float16*)(ws + WS_HPRE);
    float* hbuf = (float*)(ws + WS_H);
    float* gate = (float*)(ws + WS_GATE);
    int* list = (int*)(ws + WS_LIST);
    unsigned char* actf8 = (unsigned char*)(ws + WS_ACT16);
    unsigned char* yf8 = (unsigned char*)(ws + WS_Y16);
    _Float16* h16 = (_Float16*)(ws + WS_H16);
    _Float16* x16 = (_Float16*)(ws + WS_X16);
    _Float16* wtin = (_Float16*)(ws + WS_WTIN);
    _Float16* wtout = (_Float16*)(ws + WS_WTOUT);
    _Float16* wtgu = (_Float16*)(ws + WS_WTGU);
    _Float16* wtdn = (_Float16*)(ws + WS_WTDN);
    LAS unsigned char* lds = (LAS unsigned char*)smem;
    _Float16* proj16 = (_Float16*)(ws + WS_PROJ16);
    _Float16* kvmem16 = (_Float16*)(ws + WS_KVMEM16);
    _Float16* wt1 = (_Float16*)(ws + WS_WT1);
    float* uv = (float*)(ws + WS_UV);
    _Float16* kc16 = (_Float16*)(ws + WS_KC16);
    _Float16* vc16 = (_Float16*)(ws + WS_VC16);
    _Float16* wr16 = (_Float16*)(ws + WS_WR16);
    _Float16* mem16 = (_Float16*)(ws + WS_MEM16);
    _Float16* wtmkv = (_Float16*)(ws + WS_WTMKV);
    _Float16* kv16 = (_Float16*)(ws + WS_KV16);
    _Float16* wt2 = (_Float16*)(ws + WS_WT2);
    float* sa2 = (float*)(ws + WS_SA2); float* gate2 = (float*)(ws + WS_GATE2);
    signed char* x8 = (signed char*)(ws + WS_X8); float* sxa = (float*)(ws + WS_SXA); signed char* q8in = (signed char*)(ws + WS_Q8IN); float* sin8 = (float*)(ws + WS_SIN8);
    signed char* q8mkv = (signed char*)(ws + WS_Q8MKV); float* smkv = (float*)(ws + WS_SMKV);
    signed char* q8out = (signed char*)(ws + WS_Q8OUT); float* sout = (float*)(ws + WS_SOUT); signed char* cat8 = (signed char*)(ws + WS_CAT8); float* scat = (float*)(ws + WS_SCAT);
    signed char* q8gu = (signed char*)(ws + WS_Q8GU); signed char* q8dn = (signed char*)(ws + WS_Q8DN);
    float* sgu = (float*)(ws + WS_SGU); float* sdn = (float*)(ws + WS_SDN);
    signed char* h8q = (signed char*)(ws + WS_H8); float* sah = (float*)(ws + WS_SAH);
    signed char* act8 = (signed char*)(ws + WS_ACT8); float* sact = (float*)(ws + WS_SACT);
    const int vcu = (nb % 8 == 0) ? (bid % 8) * (nb / 8) + bid / 8 : bid;

    volatile LAS unsigned* xbw = (volatile LAS unsigned*)(smem + LDS_BYTES - 16);
    if (tid == 0) { xbw[0] = 0u; xbw[1] = 0u; xbw[2] = 0u; xbw[3] = 0u; }
    __syncthreads();
    XcdBarrier bar; bar.bar = ctl; bar.x = 0; bar.st = xbw;
    const bool multi = (hi - lo) > 1;
    if (multi) bar = xcd_barrier_post(ctl, xbw);
#define IN(k) (lo <= (k) && (k) < hi)
#define SEAM(k) do { if (IN(k) && IN((k) + 1)) xcd_barrier(bar); } while (0)
    float* sw = (float*)smem + wv * WLDS_FLOATS;
    const int qgrp = bid >> 3;
#define QDYN(k, mx) do { constexpr int qb_ = q_beg(k), qc_ = q_cnt(k); const QExtra qxd{nullptr, q8in, sin8, nullptr, q8mkv, smkv}; quant_units<true>(smem, karg_in(I_WGU), karg_in(I_WDN), q8gu, q8dn, sgu, sdn, nullptr, q8out, sout, qxd, qb_, qc_, (unsigned*)(ws + CTL_QCTR) + 16 * (k), (mx), bid, nb); } while (0)
#define QSLOT(k, sl, ns, share) QDYN(k, (qgrp % (ns)) == (sl) ? (share) : 0)
#define QPOST(k) do { __syncthreads(); QDYN(k, 1 << 30); } while (0)
    int* segw = (int*)(sw + 4096 + 512);

    if (IN(0)) {
        DEFPTRS;
        const int lane = LANE_NOW; (void)lane;
        if (wv == 0 && (bid & 1) == 0 && (bid >> 1) < 128) {
            const int task = bid >> 1, kv = task >> 6, jg = (task >> 4) & 3, kc = task & 15;
            const float* pos = p.in[kv ? I_POSV : I_POSK] + kc * 256; const float* w1 = p.in[kv ? I_W1V : I_W1K] + (size_t)kc * 256 * 256 + jg * 64 + lane;
            float s0 = 0.f, s1 = 0.f, s2 = 0.f, s3 = 0.f;
            for (int k = 0; k < 256; k += 4) { s0 += pos[k] * w1[(size_t)k * 256]; s1 += pos[k + 1] * w1[(size_t)(k + 1) * 256]; s2 += pos[k + 2] * w1[(size_t)(k + 2) * 256]; s3 += pos[k + 3] * w1[(size_t)(k + 3) * 256]; }
            bias1[(kv * 16 + kc) * 256 + jg * 64 + lane] = (s0 + s1) + (s2 + s3);
        }
        for (int i = bid * 512 + tid; i < 2 * 128 * 256; i += nb * 512) { const int kv = i >> 15, d = (i >> 8) & 127, n = i & 255; wt2[i] = (_Float16)p.in[kv ? I_W2V : I_W2K][(size_t)n * 128 + d]; }
        for (int i = bid * 512 + tid; i < 32 * 2048; i += nb * 512) { const int e = i >> 11, d = i & 2047; wr16[i] = (_Float16)p.in[I_WR][(size_t)d * 32 + e]; }
        {
            for (int row0 = gw; row0 < T_ + 2048; row0 += nw * 2) {
                float4 raw[2][8];
#pragma unroll
                for (int i = 0; i < 2; ++i) { const int row = row0 + i * nw; const float* src = row < T_ ? p.in[I_X] + (size_t)row * 2048 : p.in[I_MEM] + (size_t)(row - T_) * 2048;
#pragma unroll
                    for (int c = 0; c < 4; ++c) { raw[i][2 * c] = make_float4(0.f, 0.f, 0.f, 0.f); raw[i][2 * c + 1] = raw[i][2 * c];
                        if (row < T_ + 2048) { raw[i][2 * c] = *(const float4*)(src + (lane + 64 * c) * 8); raw[i][2 * c + 1] = *(const float4*)(src + (lane + 64 * c) * 8 + 4); } } }
#pragma unroll
                for (int i = 0; i < 2; ++i) { const int row = row0 + i * nw;
                    float amax = 0.f;
#pragma unroll
                    for (int k = 0; k < 8; ++k) amax = fmaxf(amax, fmaxf(fmaxf(fabsf(raw[i][k].x), fabsf(raw[i][k].y)), fmaxf(fabsf(raw[i][k].z), fabsf(raw[i][k].w))));
                    amax = wave_max(amax);
                    if (row < T_ + 2048) {
                        const float qinv = amax > 0.f ? 127.f / amax : 0.f;
                        if (lane == 0) sxa[row] = amax > 0.f ? amax / 127.f : 1.f;
#pragma unroll
                        for (int c = 0; c < 4; ++c) { const float4 a = raw[i][2 * c], b2 = raw[i][2 * c + 1];
                            uint2 q; q.x = pack4_i8(a.x * qinv, a.y * qinv, a.z * qinv, a.w * qinv); q.y = pack4_i8(b2.x * qinv, b2.y * qinv, b2.z * qinv, b2.w * qinv);
                            *(uint2*)(x8 + (size_t)row * 2048 + (lane + 64 * c) * 8) = q;
                            if (row < T_) { h8 o; o[0] = (_Float16)a.x; o[1] = (_Float16)a.y; o[2] = (_Float16)a.z; o[3] = (_Float16)a.w; o[4] = (_Float16)b2.x; o[5] = (_Float16)b2.y; o[6] = (_Float16)b2.z; o[7] = (_Float16)b2.w;
                                *(h8*)(x16 + (size_t)row * 2048 + (lane + 64 * c) * 8) = o; } } }
                }
            }
        }
        {
            const QExtra qx{p.in[I_WIN], q8in, sin8, p.in[I_WMEMKV], q8mkv, smkv};
            quant_units<false>(smem, p.in[I_WGU], p.in[I_WDN], q8gu, q8dn, sgu, sdn, p.in[I_WOUT], q8out, sout, qx, NE * 192, 64 + 73 + 32, nullptr, 0, bid, nb);
            __syncthreads();
            conv_all((float*)smem, p.in[I_WIN], p.in[I_W1K], p.in[I_W1V], p.in[I_WMEMKV], wtin, wt1, wtmkv, bid, nb);
            __syncthreads();
        }
    }
    SEAM(0);
    if (IN(1)) {
        DEFPTRS;
        const int lane = LANE_NOW; (void)lane;
        const int qs1 = (bid < 16 || (bid >= 64 && bid < 104)) ? 1 : (bid < 64 ? 4 : 8);
        QSLOT(1, 0, 3, qs1);
        { g8::ProbInF P{x16, proj16, nb, bid}; g8::gemm_phase(lds, P); }
        __syncthreads();
        QSLOT(1, 1, 3, qs1);
        { g8::ProbIn8 P{x8, proj16, sxa, nb, (bid + 192) & 255}; g8::gemm_phase(lds, P); }
        __syncthreads();
        QSLOT(1, 2, 3, qs1);
        QPOST(1);
    }
    SEAM(1);
    if (IN(2)) {
        DEFPTRS;
        const int lane = LANE_NOW; (void)lane;
        QSLOT(2, 0, 5, 3);
        { g8::ProbCmp P{kv16, wt1, uv, nb, bid}; g8::gemm_phase(lds, P); __syncthreads(); }
        for (int i = bid * 512 + tid; i < T_ * 64; i += nb * 512) {
            const int chn = i & 63, row = i >> 6, t = row & (S_ - 1), g = chn >> 4;
            const int win = 2 << g, n = min(win, t + 1);
            const _Float16* src = proj16 + (size_t)row * INW + C_UP + chn * 8;
            float a[8];
            const h8 cur = *(const h8*)src;
            h8 vv[15];
#pragma unroll
            for (int k = 0; k < 15; ++k) { vv[k] = (h8){0, 0, 0, 0, 0, 0, 0, 0}; if (k + 1 < n) vv[k] = *(const h8*)(src - (size_t)(k + 1) * INW); }
#pragma unroll
            for (int q = 0; q < 8; ++q) a[q] = (float)cur[q];
#pragma unroll
            for (int k = 0; k < 15; ++k) {
#pragma unroll
                for (int q = 0; q < 8; ++q) a[q] += (float)vv[k][q]; }
            const float rn = 1.f / (float)n;
            float4 o0, o1;
            o0.x = a[0] * rn - (float)cur[0]; o0.y = a[1] * rn - (float)cur[1]; o0.z = a[2] * rn - (float)cur[2]; o0.w = a[3] * rn - (float)cur[3];
            o1.x = a[4] * rn - (float)cur[4]; o1.y = a[5] * rn - (float)cur[5]; o1.z = a[6] * rn - (float)cur[6]; o1.w = a[7] * rn - (float)cur[7];
            *(float4*)(pooled + (size_t)row * 512 + chn * 8) = o0; *(float4*)(pooled + (size_t)row * 512 + chn * 8 + 4) = o1;
        }
        __syncthreads();
        QSLOT(2, 1, 5, 3);
        {
            const int r32 = lane & 31, hi = lane >> 5, g = wv >> 1, half = wv & 1;
            for (int uu = vcu; uu < 512; uu += nb) {
                const int v = uu & 255, bk = v >> 4, qi = (uu >> 8) ? 31 - (v & 15) : (v & 15), b = bk >> 1, kvh = bk & 1;
                const int t = qi * 64 + half * 32 + r32;
                const int lo_t = max(0, qi - 8);
                const unsigned tmask = (unsigned)(((1ull << (qi + 1)) - 1ull) & ~((1ull << lo_t) - 1ull));
                at8::attn_unit(smem, proj16 + (size_t)(b * S_ + t) * INW + C_Q + (kvh * 4 + g) * 128 + hi * 8,
                               kv16 + ((size_t)(4 * B_ + b) * 2 + kvh) * KVSEG, kv16 + ((size_t)(5 * B_ + b) * 2 + kvh) * KVSEG, 128, tmask, 512, t, 0xffffffffu,
                               owin + (size_t)(b * S_ + qi * 64 + half * 32) * 1024 + (kvh * 4 + g) * 128, 1024);
                QSLOT(2, 2 + (uu >> 8), 5, 3);
            }
            for (int u = vcu; u < 256; u += nb) {
                const int b = u >> 5, h = (u >> 3) & 3, qt = u & 7;
                const int t = qt * 256 + wv * 32 + r32;
                at8::attn_unit(smem, proj16 + (size_t)(b * S_ + t) * INW + C_QM + h * 128 + hi * 8,
                               kvmem16 + (size_t)b * 256 * 1024 + h * 128, kvmem16 + (size_t)b * 256 * 1024 + 512 + h * 128, 1024, 0xFu, 0, 255, 0xffffffffu,
                               omem + (size_t)(b * S_ + qt * 256 + wv * 32) * 512 + h * 128, 512);
            }
        }
        QPOST(2);
    }
    SEAM(2);
    if (IN(3)) {
        DEFPTRS;
        const int lane = LANE_NOW; (void)lane;
        QSLOT(3, 0, 3, 2);
        {
            float* bsum = (float*)smem;
            _Float16* hs = (_Float16*)(smem + 4096);
            { const int kv = tid >> 8, n = tid & 255; float a = 0.f;
#pragma unroll
              for (int kc = 0; kc < 16; ++kc) a += bias1[(kv * 16 + kc) * 256 + n];
              bsum[tid] = a; }
            __syncthreads();
            const int fr = lane & 15, fq = lane >> 4;
            for (int u = bid; u < 256; u += nb) {
                const int kv = u >> 7, rt = u & 127;
#pragma unroll
                for (int q = 0; q < 8; ++q) { const int e = tid + 512 * q, i = e >> 8, n = e & 255;
                    const int row = rt * 16 + i, c = (row >> 1) & 127;
                    float a = 0.f;
                    if (c != 127) { a = bsum[kv * 256 + n];
#pragma unroll
                        for (int sp = 0; sp < 4; ++sp) { const float* base = uv + ((size_t)(kv * 4 + sp) * 2048) * 512; a += base[(size_t)row * 512 + n] + base[(size_t)(row + 2) * 512 + 256 + n]; }
                        a = gelu_fast(a); }
                    hs[i * 264 + n] = (_Float16)a; }
                __syncthreads();
                { const _Float16* bp = wt2 + ((size_t)kv * 128 + wv * 16 + fr) * 256 + fq * 8;
                  f4 acc = (f4){0.f, 0.f, 0.f, 0.f};
#pragma unroll
                  for (int sI = 0; sI < 8; ++sI) { const h8 a = *(const h8*)(hs + fr * 264 + sI * 32 + fq * 8), bb = *(const h8*)(bp + sI * 32); acc = __builtin_amdgcn_mfma_f32_16x16x32_f16(a, bb, acc, 0, 0, 0); }
                  _Float16* dst = kv ? vc16 : kc16;
#pragma unroll
                  for (int j = 0; j < 4; ++j) { const int row = rt * 16 + fq * 4 + j; dst[(size_t)row * 128 + wv * 16 + fr] = (((row >> 1) & 127) == 127) ? (_Float16)0.f : (_Float16)acc[j]; } }
                __syncthreads();
            }
        }
        QSLOT(3, 1, 3, 2);
        for (int u = bid; u < 128 * 4; u += nb) { const int g = u >> 7, mt = u & 127;
            ARowPlain af{pooled + g * 128, 512, mt * 128, T_}; EpiPool ef{opool, p.in[I_POOLS], mt * 128, g};
            gemm_tile(smem, 128, af, p.in[I_POOLW] + (size_t)g * 128 * 128, 128, 0, 128, false, ef);
        }
        QPOST(3);
    }
    SEAM(3);
    if (IN(4)) {
        DEFPTRS;
        const int lane = LANE_NOW; (void)lane;
        QSLOT(4, 0, 3, 2);
        const int r32 = lane & 31, hi = lane >> 5, g = wv >> 1, half = wv & 1;
        for (int uu = vcu; uu < 512; uu += nb) {
            const int v = uu & 255, bk = v >> 4, qi = (uu >> 8) ? 31 - (v & 15) : (v & 15), b = bk >> 1, kvh = bk & 1;
            const int tl = half * 32 + r32, t = qi * 64 + tl;
            at8::cmp_slc_unit(smem, proj16 + (size_t)(b * S_ + t) * INW + C_Q + (kvh * 4 + g) * 128 + hi * 8,
                              kc16 + (size_t)(b * 128 * 2 + kvh) * 128, vc16 + (size_t)(b * 128 * 2 + kvh) * 128,
                              kv16 + ((size_t)(2 * B_ + b) * 2 + kvh) * KVSEG, kv16 + ((size_t)(3 * B_ + b) * 2 + kvh) * KVSEG, t, tl, g, qi,
                              ocmp + (size_t)(b * S_ + qi * 64 + half * 32) * 1024 + (kvh * 4 + g) * 128, oslc + (size_t)(b * S_ + qi * 64 + half * 32) * 1024 + (kvh * 4 + g) * 128);
            QSLOT(4, 1 + (uu >> 8), 3, 2);
        }
        QPOST(4);
    }
    SEAM(4);
    if (IN(5)) {
        DEFPTRS;
        QSLOT(5, 0, 2, 1);
        const int lane = LANE_NOW;
        for (int row = gw; row < T_; row += nw) {
            const _Float16* pr = proj16 + (size_t)row * INW + C_G;
            float v[32]; float ss = 0.f;
#pragma unroll
            for (int c = 0; c < 2; ++c) { const int col = (lane + 64 * c) * 8, h = col >> 7; const size_t o = (size_t)row * 1024 + col;
                const float g0 = sigmoidf_((float)pr[h * 3]), g1 = sigmoidf_((float)pr[h * 3 + 1]), g2 = sigmoidf_((float)pr[h * 3 + 2]);
                const h8 a = *(const h8*)(ocmp + o), b2 = *(const h8*)(oslc + o), c2 = *(const h8*)(owin + o);
#pragma unroll
                for (int q = 0; q < 8; ++q) { const float x = g0 * (float)a[q] + g1 * (float)b2[q] + g2 * (float)c2[q]; v[c * 8 + q] = x; ss += x * x; } }
            ss = wave_sum(ss); float r = rsqrtf(ss / 1024.f + LN_EPS);
#pragma unroll
            for (int c = 0; c < 2; ++c) { const int col = (lane + 64 * c) * 8; const float4 ga = *(const float4*)(p.in[I_GNNSA] + col), gb = *(const float4*)(p.in[I_GNNSA] + col + 4);
                v[c * 8 + 0] *= r * ga.x; v[c * 8 + 1] *= r * ga.y; v[c * 8 + 2] *= r * ga.z; v[c * 8 + 3] *= r * ga.w; v[c * 8 + 4] *= r * gb.x; v[c * 8 + 5] *= r * gb.y; v[c * 8 + 6] *= r * gb.z; v[c * 8 + 7] *= r * gb.w; }
            { const h8 a = *(const h8*)(opool + (size_t)row * 512 + lane * 8); ss = 0.f;
#pragma unroll
              for (int q = 0; q < 8; ++q) { v[16 + q] = (float)a[q]; ss += v[16 + q] * v[16 + q]; }
              ss = wave_sum(ss); r = rsqrtf(ss / 512.f + LN_EPS);
              const float4 ga = *(const float4*)(p.in[I_GNPOOL] + lane * 8), gb = *(const float4*)(p.in[I_GNPOOL] + lane * 8 + 4);
              v[16] *= r * ga.x; v[17] *= r * ga.y; v[18] *= r * ga.z; v[19] *= r * ga.w; v[20] *= r * gb.x; v[21] *= r * gb.y; v[22] *= r * gb.z; v[23] *= r * gb.w; }
            { const h8 a = *(const h8*)(omem + (size_t)row * 512 + lane * 8); ss = 0.f;
#pragma unroll
              for (int q = 0; q < 8; ++q) { v[24 + q] = (float)a[q]; ss += v[24 + q] * v[24 + q]; }
              ss = wave_sum(ss); r = rsqrtf(ss / 512.f + LN_EPS);
              const float4 ga = *(const float4*)(p.in[I_GNMEM] + lane * 8), gb = *(const float4*)(p.in[I_GNMEM] + lane * 8 + 4);
              v[24] *= r * ga.x; v[25] *= r * ga.y; v[26] *= r * ga.z; v[27] *= r * ga.w; v[28] *= r * gb.x; v[29] *= r * gb.y; v[30] *= r * gb.z; v[31] *= r * gb.w; }
            float amax = 0.f;
#pragma unroll
            for (int k = 0; k < 32; ++k) amax = fmaxf(amax, fabsf(v[k]));
            amax = wave_max(amax);
            const float qinv = amax > 0.f ? 127.f / amax : 0.f;
            if (lane == 0) scat[row] = amax > 0.f ? amax / 127.f : 1.f;
#pragma unroll
            for (int c = 0; c < 4; ++c) { const int col = c < 2 ? (lane + 64 * c) * 8 : (c == 2 ? 1024 + lane * 8 : 1536 + lane * 8);
                uint2 q; q.x = pack4_i8(v[c * 8 + 0] * qinv, v[c * 8 + 1] * qinv, v[c * 8 + 2] * qinv, v[c * 8 + 3] * qinv); q.y = pack4_i8(v[c * 8 + 4] * qinv, v[c * 8 + 5] * qinv, v[c * 8 + 6] * qinv, v[c * 8 + 7] * qinv);
                *(uint2*)(cat8 + (size_t)row * 2048 + col) = q; }
        }
        QPOST(5);
    }
    SEAM(5);
    if (IN(6)) {
        DEFPTRS;
        const int lane = LANE_NOW; (void)lane;
        QSLOT(6, 0, 2, 1);
        { g8::ProbOut P{cat8, q8out, hpre16, x16, scat, sout, nb, bid};
          g8::gemm_phase(lds, P); }
        QPOST(6);
    }
    SEAM(6);
    if (IN(7)) {
        DEFPTRS;
        const int lane = LANE_NOW; (void)lane;
        QSLOT(7, 0, 2, 1);
        float* lg = (float*)smem;
        const int r32 = lane & 31, hi = lane >> 5, fr = lane & 15, fq = lane >> 4;
        for (int u = bid; u < T_ / 64; u += nb) {
            const int base = u * 64;
            h8 raw[8][4];
#pragma unroll
            for (int i = 0; i < 8; ++i)
#pragma unroll
                for (int c = 0; c < 4; ++c) raw[i][c] = *(const h8*)(hpre16 + (size_t)(base + wv * 8 + i) * 2048 + (lane + 64 * c) * 8);
#pragma unroll
            for (int i = 0; i < 8; ++i) {
                const int row = base + wv * 8 + i;
                float v[32]; float s = 0.f;
#pragma unroll
                for (int c = 0; c < 4; ++c) {
#pragma unroll
                    for (int q = 0; q < 8; ++q) { v[c * 8 + q] = (float)raw[i][c][q]; s += v[c * 8 + q]; } }
                const float mu = wave_sum(s) / 2048.f; float q2 = 0.f;
#pragma unroll
                for (int k = 0; k < 32; ++k) { const float d = v[k] - mu; q2 += d * d; }
                const float rs = rsqrtf(wave_sum(q2) / 2048.f + LN_EPS);
                float amax = 0.f;
#pragma unroll
                for (int c = 0; c < 4; ++c) { const int col = (lane + 64 * c) * 8;
                    const float4 g0 = *(const float4*)(p.in[I_LN1G] + col), g1 = *(const float4*)(p.in[I_LN1G] + col + 4), b0 = *(const float4*)(p.in[I_LN1B] + col), b1 = *(const float4*)(p.in[I_LN1B] + col + 4);
                    float4 o0, o1;
                    o0.x = (v[c * 8 + 0] - mu) * rs * g0.x + b0.x; o0.y = (v[c * 8 + 1] - mu) * rs * g0.y + b0.y; o0.z = (v[c * 8 + 2] - mu) * rs * g0.z + b0.z; o0.w = (v[c * 8 + 3] - mu) * rs * g0.w + b0.w;
                    o1.x = (v[c * 8 + 4] - mu) * rs * g1.x + b1.x; o1.y = (v[c * 8 + 5] - mu) * rs * g1.y + b1.y; o1.z = (v[c * 8 + 6] - mu) * rs * g1.z + b1.z; o1.w = (v[c * 8 + 7] - mu) * rs * g1.w + b1.w;
                    h8 oh; oh[0] = (_Float16)o0.x; oh[1] = (_Float16)o0.y; oh[2] = (_Float16)o0.z; oh[3] = (_Float16)o0.w; oh[4] = (_Float16)o1.x; oh[5] = (_Float16)o1.y; oh[6] = (_Float16)o1.z; oh[7] = (_Float16)o1.w;
                    *(h8*)(h16 + (size_t)row * 2048 + col) = oh;
                    v[c * 8 + 0] = o0.x; v[c * 8 + 1] = o0.y; v[c * 8 + 2] = o0.z; v[c * 8 + 3] = o0.w; v[c * 8 + 4] = o1.x; v[c * 8 + 5] = o1.y; v[c * 8 + 6] = o1.z; v[c * 8 + 7] = o1.w;
                    amax = fmaxf(amax, fmaxf(fmaxf(fmaxf(fabsf(o0.x), fabsf(o0.y)), fmaxf(fabsf(o0.z), fabsf(o0.w))), fmaxf(fmaxf(fabsf(o1.x), fabsf(o1.y)), fmaxf(fabsf(o1.z), fabsf(o1.w))))); }
                amax = wave_max(amax);
                const float qinv = amax > 0.f ? 127.f / amax : 0.f;
                if (lane == 0) sah[row] = amax > 0.f ? amax / 127.f : 1.f;
#pragma unroll
                for (int c = 0; c < 4; ++c) { const int col = (lane + 64 * c) * 8;
                    uint2 q; q.x = pack4_i8(v[c * 8 + 0] * qinv, v[c * 8 + 1] * qinv, v[c * 8 + 2] * qinv, v[c * 8 + 3] * qinv); q.y = pack4_i8(v[c * 8 + 4] * qinv, v[c * 8 + 5] * qinv, v[c * 8 + 6] * qinv, v[c * 8 + 7] * qinv);
                    *(uint2*)(h8q + (size_t)row * 2048 + col) = q; }
            }
            asm volatile("s_waitcnt vmcnt(0)" ::: "memory");
            __syncthreads();
            {
                const int tok0 = base + 16 * (wv >> 1), e0 = 16 * (wv & 1);
                const _Float16* ap = h16 + (size_t)(tok0 + fr) * 2048 + fq * 8; const _Float16* bp = wr16 + (size_t)(e0 + fr) * 2048 + fq * 8;
                f4 acc = (f4){0.f, 0.f, 0.f, 0.f};
#pragma unroll 8
                for (int sI = 0; sI < 64; ++sI) { const h8 a = *(const h8*)(ap + sI * 32), bb = *(const h8*)(bp + sI * 32); acc = __builtin_amdgcn_mfma_f32_16x16x32_f16(a, bb, acc, 0, 0, 0); }
                const float br = p.in[I_BR][e0 + fr];
#pragma unroll
                for (int j = 0; j < 4; ++j) lg[(16 * (wv >> 1) + 4 * fq + j) * 33 + e0 + fr] = acc[j] + br;
            }
            __syncthreads();
#pragma unroll 1
            for (int it = 0; it < 4; ++it) {
                const int tk = 8 * wv + 2 * it + hi;
                const float iv = lg[tk * 33 + r32];
                int rank = 0;
                for (int i = 0; i < 32; ++i) { const float vi = __shfl(iv, i + 32 * hi); rank += (vi > iv || (vi == iv && i < r32)) ? 1 : 0; }
                float tv[4]; int te[4];
#pragma unroll
                for (int r = 0; r < 4; ++r) { const unsigned long long bm = __ballot(rank == r); const unsigned hm = (unsigned)(bm >> (32 * hi)); const int src = __ffs(hm) - 1; te[r] = src; tv[r] = __shfl(iv, src + 32 * hi); }
                const float e0v = 1.f, e1v = expf(tv[1] - tv[0]), e2v = expf(tv[2] - tv[0]), e3v = expf(tv[3] - tv[0]); const float inv = 1.f / (e0v + e1v + e2v + e3v);
                if (r32 < 4) { const int e = r32 == 0 ? te[0] : r32 == 1 ? te[1] : r32 == 2 ? te[2] : te[3]; const float g = (r32 == 0 ? e0v : r32 == 1 ? e1v : r32 == 2 ? e2v : e3v) * inv;
                    const int a = (base + tk) * 4 + r32; const int pos = atomicAdd(&cnt[e], 1); list[(size_t)e * T_ + pos] = a; gate[a] = g; gate2[(size_t)e * T_ + pos] = g; sa2[(size_t)e * T_ + pos] = sah[base + tk]; }
            }
            __syncthreads();
        }
        QPOST(7);
    }
    SEAM(7);
    LAS int* mtab = (LAS int*)(smem + g8::STAGE_BYTES);
    if (IN(8)) {
        DEFPTRS;
        const int lane = LANE_NOW; (void)lane;
        if (tid == 0) { int ub = 0, rs = 0;
            for (int e = 0; e < NE; ++e) { const int c = (int)__hip_atomic_load((unsigned*)&cnt[e], __ATOMIC_RELAXED, __HIP_MEMORY_SCOPE_AGENT); mtab[e] = c; mtab[32 + e] = ub; mtab[65 + e] = rs; ub += ((c + 255) >> 8) * 16; rs += c; }
            mtab[64] = ub; mtab[97] = rs; mtab[98] = ub; }
        __syncthreads();
        g8::moe_build(mtab, nb, vcu);
        __syncthreads();
        {
            const int total = mtab[98], nmine = total > vcu ? (total - vcu + nb - 1) / nb : 0, cut = (nmine * (qgrp & 7)) >> 3;
            const int nmax = (total + nb - 1) / nb, nlight = nb * nmax - total, s_lo = max(0, (q_cnt(8) - 3 * nlight) / nb), qs8 = nmine < nmax ? s_lo + 3 : s_lo;
            { g8::ProbGu P{h8q, q8gu, actf8, p.in[I_BGU], list, sa2, sgu, g8::MoeTab{mtab, 16, 0, cut}, nb, vcu};
              g8::gemm_phase(lds, P); }
            __syncthreads();
            QDYN(8, qs8);
            { g8::ProbGu P{h8q, q8gu, actf8, p.in[I_BGU], list, sa2, sgu, g8::MoeTab{mtab, 16, cut, 40}, nb, vcu};
              g8::gemm_phase(lds, P); }
        }
        QPOST(8);
    }
    SEAM(8);
    if (IN(9)) {
        DEFPTRS;
        const int lane = LANE_NOW;
        for (int row0 = gw; row0 < NA; row0 += nw * 8) {
            uint2 raw[8][4];
#pragma unroll
            for (int i = 0; i < 8; ++i)
#pragma unroll
                for (int c = 0; c < 4; ++c) raw[i][c] = *(const uint2*)(actf8 + (size_t)(row0 + i * nw) * 2048 + (lane + 64 * c) * 8);
#pragma unroll
            for (int i = 0; i < 8; ++i) { const int row = row0 + i * nw;
                float v[32]; float amax = 0.f;
#pragma unroll
                for (int c = 0; c < 4; ++c) { const uint2 a = raw[i][c];
                    dec4_fp8(a.x, v[c * 8 + 0], v[c * 8 + 1], v[c * 8 + 2], v[c * 8 + 3]); dec4_fp8(a.y, v[c * 8 + 4], v[c * 8 + 5], v[c * 8 + 6], v[c * 8 + 7]);
#pragma unroll
                    for (int q = 0; q < 8; ++q) amax = fmaxf(amax, fabsf(v[c * 8 + q])); }
                amax = wave_max(amax);
                const float qinv = amax > 0.f ? 127.f / amax : 0.f;
                if (lane == 0) sact[row] = amax > 0.f ? amax / 127.f : 1.f;
#pragma unroll
                for (int c = 0; c < 4; ++c) { uint2 q; q.x = pack4_i8(v[c * 8 + 0] * qinv, v[c * 8 + 1] * qinv, v[c * 8 + 2] * qinv, v[c * 8 + 3] * qinv); q.y = pack4_i8(v[c * 8 + 4] * qinv, v[c * 8 + 5] * qinv, v[c * 8 + 6] * qinv, v[c * 8 + 7] * qinv);
                    *(uint2*)(act8 + (size_t)row * 2048 + (lane + 64 * c) * 8) = q; }
            }
        }
    }
    SEAM(9);
    if (IN(10)) {
        DEFPTRS;
        const int lane = LANE_NOW; (void)lane;
        if (tid == 0) { int ub = 0, rs = 0;
            for (int e = 0; e < NE; ++e) { const int c = (int)__hip_atomic_load((unsigned*)&cnt[e], __ATOMIC_RELAXED, __HIP_MEMORY_SCOPE_AGENT); mtab[e] = c; mtab[32 + e] = ub; mtab[65 + e] = rs; ub += ((c + 255) >> 8) * 8; rs += c; }
            mtab[64] = ub; mtab[97] = rs; mtab[98] = ub; }
        __syncthreads();
        g8::moe_build(mtab, nb, vcu);
        __syncthreads();
        g8::ProbDn P{act8, q8dn, yf8, p.in[I_BDN], list, gate2, sact, sdn, g8::MoeTab{mtab, 8, 0, 40}, nb, vcu};
        g8::gemm_phase(lds, P);
        __syncthreads();
    }
    SEAM(10);
    if (IN(11)) {
        DEFPTRS;
        const int lane = LANE_NOW; (void)lane;
        for (int row0 = gw; row0 < T_; row0 += nw * 2) {
          h8 hraw[2][4]; uint2 yraw[2][4][4];
#pragma unroll
          for (int i = 0; i < 2; ++i)
#pragma unroll
            for (int c = 0; c < 4; ++c) { const int col = (lane + 64 * c) * 8; const size_t yo = (size_t)(row0 + i * nw) * 4 * 2048 + col;
                hraw[i][c] = *(const h8*)(h16 + (size_t)(row0 + i * nw) * 2048 + col);
                yraw[i][c][0] = *(const uint2*)(yf8 + yo); yraw[i][c][1] = *(const uint2*)(yf8 + yo + 2048); yraw[i][c][2] = *(const uint2*)(yf8 + yo + 4096); yraw[i][c][3] = *(const uint2*)(yf8 + yo + 6144); }
#pragma unroll
          for (int i = 0; i < 2; ++i) { const int row = row0 + i * nw;
            float v[32]; float s = 0.f;
#pragma unroll
            for (int c = 0; c < 4; ++c) {
                const h8 hh8 = hraw[i][c];
                const uint2 y0 = yraw[i][c][0], y1 = yraw[i][c][1], y2 = yraw[i][c][2], y3 = yraw[i][c][3];
                float ys[8], t0[8], t1[8], t2[8], t3[8];
                dec4_fp8(y0.x, t0[0], t0[1], t0[2], t0[3]); dec4_fp8(y0.y, t0[4], t0[5], t0[6], t0[7]); dec4_fp8(y1.x, t1[0], t1[1], t1[2], t1[3]); dec4_fp8(y1.y, t1[4], t1[5], t1[6], t1[7]);
                dec4_fp8(y2.x, t2[0], t2[1], t2[2], t2[3]); dec4_fp8(y2.y, t2[4], t2[5], t2[6], t2[7]); dec4_fp8(y3.x, t3[0], t3[1], t3[2], t3[3]); dec4_fp8(y3.y, t3[4], t3[5], t3[6], t3[7]);
#pragma unroll
                for (int q = 0; q < 8; ++q) ys[q] = (t0[q] + t1[q]) + (t2[q] + t3[q]);
#pragma unroll
                for (int q = 0; q < 8; ++q) { v[c * 8 + q] = DN_ALPHA * (float)hh8[q] + ys[q] * 0.0625f; s += v[c * 8 + q]; } }
            const float mu = wave_sum(s) / 2048.f; float q2 = 0.f;
#pragma unroll
            for (int i = 0; i < 32; ++i) { const float d = v[i] - mu; q2 += d * d; }
            const float rs = rsqrtf(wave_sum(q2) / 2048.f + LN_EPS);
#pragma unroll
            for (int c = 0; c < 4; ++c) { const int col = (lane + 64 * c) * 8;
                const float4 ga = *(const float4*)(p.in[I_LN2G] + col), gb = *(const float4*)(p.in[I_LN2G] + col + 4), ba = *(const float4*)(p.in[I_LN2B] + col), bb = *(const float4*)(p.in[I_LN2B] + col + 4);
                float4 o0, o1;
                o0.x = (v[c * 8 + 0] - mu) * rs * ga.x + ba.x; o0.y = (v[c * 8 + 1] - mu) * rs * ga.y + ba.y; o0.z = (v[c * 8 + 2] - mu) * rs * ga.z + ba.z; o0.w = (v[c * 8 + 3] - mu) * rs * ga.w + ba.w;
                o1.x = (v[c * 8 + 4] - mu) * rs * gb.x + bb.x; o1.y = (v[c * 8 + 5] - mu) * rs * gb.y + bb.y; o1.z = (v[c * 8 + 6] - mu) * rs * gb.z + bb.z; o1.w = (v[c * 8 + 7] - mu) * rs * gb.w + bb.w;
                *(float4*)(p.out + (size_t)row * 2048 + col) = o0; *(float4*)(p.out + (size_t)row * 2048 + col + 4) = o1; }
          }
        }
    }
}

constexpr int NPHASE = 12;

extern "C" void kernel_launch(void* const* d_in, const int* in_sizes, int n_in, void* d_out, int out_size, void* d_ws, size_t ws_size, hipStream_t stream) {
    static int grid = 0;
    if (grid == 0) {
        if (n_in != 26 || ws_size < WS_END) { fprintf(stderr, "kernel_launch: unexpected n_in %d or ws_size %zu (< %zu)\n", n_in, ws_size, (size_t)WS_END); grid = -1; return; }
        int dev = 0, cus = 0, per_cu = 0;
        hipGetDevice(&dev); hipDeviceGetAttribute(&cus, hipDeviceAttributeMultiprocessorCount, dev);
        if (hipFuncSetAttribute((const void*)fwd, hipFuncAttributeMaxDynamicSharedMemorySize, LDS_BYTES) != hipSuccess) { fprintf(stderr, "hipFuncSetAttribute failed\n"); grid = -1; return; }
        hipOccupancyMaxActiveBlocksPerMultiprocessor(&per_cu, (const void*)fwd, 512, LDS_BYTES);
        (void)hipGetLastError();
        if (per_cu < 1) fprintf(stderr, "occupancy query says %d blocks per CU\n", per_cu);
        grid = cus > 0 ? cus : 256;
    }
    if (grid < 0) return;
    hipMemsetAsync((char*)d_ws + WS_CTL, 0, CTL_BYTES, stream);
    Params p{};
    for (int i = 0; i < 26; ++i) p.in[i] = (const float*)d_in[i];
    p.out = (float*)d_out; p.ws = (unsigned char*)d_ws;
#if N_LAUNCH_MODE == 1
    p.lo_hi = (long long)0 | ((long long)NPHASE << 32);
    hipLaunchKernelGGL(fwd, dim3(grid), dim3(512), LDS_BYTES, stream, p);
#else
    for (int ph = 0; ph < NPHASE; ++ph) {
        p.lo_hi = (long long)ph | ((long long)(ph + 1) << 32);
        hipLaunchKernelGGL(fwd, dim3(grid), dim3(512), LDS_BYTES, stream, p);
    }
#endif
}
```

```cpp
#include <hip/hip_runtime.h>
#include <cstdio>
#include <cstdint>

#ifndef N_LAUNCH_MODE
#define N_LAUNCH_MODE 1
#endif

constexpr int B_ = 8, S_ = 2048, D_ = 2048, T_ = B_ * S_;
constexpr int INW = 3608;
constexpr int C_Q = 0, C_KC = 1024, C_VC = 1280, C_KS = 1536, C_VS = 1792, C_KW = 2048, C_VW = 2304, C_G = 2560, C_UP = 2584, C_QM = 3096;
constexpr int NC = 127;
constexpr int CROWS = B_ * NC * 2;
constexpr int NE = 32, DE = 2048, NA = T_ * 4;
constexpr float LN_EPS = 1e-5f;
constexpr float DN_ALPHA = 1.189207115002721f;
constexpr float ATT_SCALE = 0.08838834764831845f;

constexpr size_t al256(size_t x) { return (x + 255) & ~(size_t)255; }
constexpr size_t WS_CTL = 0;
constexpr size_t CTL_BYTES = 65536;
constexpr size_t CTL_CNT = 16384;
constexpr size_t WS_PROJ = CTL_BYTES;
constexpr size_t WS_KVMEM = WS_PROJ + al256((size_t)T_ * INW * 4);
constexpr size_t WS_BIAS1 = WS_KVMEM + al256((size_t)2048 * 1024 * 4);
constexpr size_t WS_HID = WS_BIAS1 + al256(2 * 16 * 256 * 4);
constexpr size_t WS_KC = WS_HID + al256((size_t)2 * 2048 * 256 * 4);
constexpr size_t WS_VC = WS_KC + al256((size_t)CROWS * 128 * 4);
constexpr size_t WS_POOLED = WS_VC + al256((size_t)CROWS * 128 * 4);
constexpr size_t WS_OPOOL = WS_POOLED + al256((size_t)T_ * 512 * 4);
constexpr size_t WS_OWIN = WS_OPOOL + al256((size_t)T_ * 512 * 4);
constexpr size_t WS_OCMP = WS_OWIN + al256((size_t)T_ * 1024 * 4);
constexpr size_t WS_OSLC = WS_OCMP + al256((size_t)T_ * 1024 * 4);
constexpr size_t WS_SEL = WS_OSLC + al256((size_t)T_ * 1024 * 4);
constexpr size_t WS_OMEM = WS_SEL + al256((size_t)T_ * 2 * 4);
constexpr size_t WS_CAT16 = WS_OMEM + al256((size_t)T_ * 512 * 4);
constexpr size_t WS_HPRE = WS_CAT16 + al256((size_t)T_ * 2048 * 2);
constexpr size_t WS_H = WS_HPRE + al256((size_t)T_ * 2048 * 4);
constexpr size_t WS_H16 = WS_H + al256((size_t)T_ * 2048 * 4);
constexpr size_t WS_GATE = WS_H16 + al256((size_t)T_ * 2048 * 2);
constexpr size_t WS_LIST = WS_GATE + al256((size_t)NA * 4);
constexpr size_t WS_ACT16 = WS_LIST + al256((size_t)NE * T_ * 4);
constexpr size_t WS_Y16 = WS_ACT16 + al256((size_t)(NA + 256) * 2048 * 2);
constexpr size_t WS_X16 = WS_Y16 + al256((size_t)NA * 2048 * 2);
constexpr size_t WS_MEM16 = WS_X16 + (size_t)T_ * 2048 * 2;
constexpr size_t WS_WTIN = WS_MEM16 + al256((size_t)2048 * 2048 * 2);
constexpr size_t WS_WTOUT = WS_WTIN + al256((size_t)3840 * 2048 * 2);
constexpr size_t WS_WTGU = WS_WTOUT + al256((size_t)2048 * 2048 * 2);
constexpr size_t WS_WTDN = WS_WTGU + al256((size_t)NE * 4096 * 2048 * 2);
constexpr size_t WS_PROJ16 = WS_WTDN + al256((size_t)NE * 2048 * 2048 * 2);
constexpr size_t WS_KVMEM16 = WS_PROJ16 + al256((size_t)(T_ + 64) * INW * 2);
constexpr size_t WS_WT1 = WS_KVMEM16 + al256((size_t)2048 * 1024 * 2);
constexpr size_t WS_UV = WS_WT1 + al256((size_t)2 * 512 * 2048 * 2);
constexpr size_t WS_KC16 = WS_UV + al256((size_t)2 * 4 * 2048 * 512 * 4);
constexpr size_t WS_VC16 = WS_KC16 + al256((size_t)B_ * 128 * 256 * 2);
constexpr size_t WS_WR16 = WS_VC16 + al256((size_t)B_ * 128 * 256 * 2);
constexpr size_t WS_Q8GU = WS_WR16 + al256((size_t)32 * 2048 * 2);
constexpr size_t WS_Q8DN = WS_Q8GU + al256((size_t)NE * 4096 * 2048);
constexpr size_t WS_SGU = WS_Q8DN + al256((size_t)NE * 2048 * 2048);
constexpr size_t WS_SDN = WS_SGU + al256((size_t)NE * 4096 * 4);
constexpr size_t WS_H8 = WS_SDN + al256((size_t)NE * 2048 * 4);
constexpr size_t WS_SAH = WS_H8 + al256((size_t)T_ * 2048);
constexpr size_t WS_ACT8 = WS_SAH + al256((size_t)T_ * 4);
constexpr size_t WS_SACT = WS_ACT8 + al256((size_t)(NA + 256) * 2048);
constexpr size_t WS_WTMKV = WS_SACT + al256((size_t)(NA + 256) * 4);
constexpr size_t WS_Q8OUT = WS_WTMKV + al256((size_t)1024 * 2048 * 2);
constexpr size_t WS_SOUT = WS_Q8OUT + al256((size_t)2048 * 2048);
constexpr size_t WS_CAT8 = WS_SOUT + al256(2048 * 4);
constexpr size_t WS_SCAT = WS_CAT8 + al256((size_t)T_ * 2048);
constexpr size_t WS_SA2 = WS_SCAT + al256((size_t)T_ * 4);
constexpr size_t WS_GATE2 = WS_SA2 + al256((size_t)NE * T_ * 4);
constexpr size_t WS_X8 = WS_GATE2 + al256((size_t)NE * T_ * 4);
constexpr size_t WS_SXA = WS_X8 + al256((size_t)(T_ + 2048) * 2048);
constexpr size_t WS_Q8IN = WS_SXA + al256((size_t)(T_ + 2048) * 4);
constexpr size_t WS_SIN8 = WS_Q8IN + al256((size_t)2560 * 2048);
constexpr size_t WS_Q8MKV = WS_SIN8 + al256(2560 * 4);
constexpr size_t WS_SMKV = WS_Q8MKV + al256((size_t)1024 * 2048);
constexpr size_t WS_WT2 = WS_SMKV + al256(1024 * 4);
constexpr size_t WS_KV16 = WS_WT2 + al256((size_t)2 * 128 * 256 * 2);
constexpr size_t KVSEG = (size_t)S_ * 128;
constexpr size_t WS_END = WS_KV16 + al256((size_t)6 * B_ * 2 * S_ * 128 * 2);

constexpr int LDS_BYTES = 159744;

struct Params {
    const float* in[26];
    float* out;
    unsigned char* ws;
    long long lo_hi;
};
enum { I_X = 0, I_MEM, I_WIN, I_POSK, I_W1K, I_W2K, I_POSV, I_W1V, I_W2V, I_POOLW, I_POOLS, I_WMEMKV, I_GNNSA, I_GNPOOL, I_GNMEM, I_WOUT,
       I_LN1G, I_LN1B, I_WR, I_BR, I_WGU, I_BGU, I_WDN, I_BDN, I_LN2G, I_LN2B };

#define XB_TMO      128
#define XB_XCNT(j)  (256  + 64 * (j))
#define XB_XSUB(j)  (1280 + 64 * (j))
#define XB_XGEN(j)  (2304 + 64 * (j))
#define XB_TOP      3328
#define XB_TOPGEN   3392
#define XCD_BAR_WORDS 3456
#define XB_SPIN_CAP (1u << 25)
#define LAS __attribute__((address_space(3)))

__device__ __forceinline__ unsigned xb_ld(unsigned* p)              { return __hip_atomic_load(p, __ATOMIC_RELAXED, __HIP_MEMORY_SCOPE_AGENT); }
__device__ __forceinline__ unsigned xb_add(unsigned* p, unsigned v) { return __hip_atomic_fetch_add(p, v, __ATOMIC_RELAXED, __HIP_MEMORY_SCOPE_AGENT); }
__device__ __forceinline__ unsigned xb_xcc_id() { return (unsigned)__builtin_amdgcn_s_getreg((3 << 11) | 20) & 0xFu; }
#define XB_SPIN(cond, bar) do { unsigned _sp = 0; while (cond) { __builtin_amdgcn_s_sleep(1); \
    if ((++_sp & 255u) == 0u) { if (xb_ld(&(bar)[XB_TMO])) break; if (_sp > XB_SPIN_CAP) { atomicAdd(&(bar)[XB_TMO], 1u); break; } } } } while (0)

struct XcdBarrier { unsigned* bar; unsigned x; volatile LAS unsigned* st; };

__device__ __forceinline__ XcdBarrier xcd_barrier_post(unsigned* bar, volatile LAS unsigned* st) {
    XcdBarrier b; b.bar = bar; b.x = xb_xcc_id(); b.st = st;
    if (threadIdx.x == 0) (void)xb_add(&bar[XB_XCNT(b.x)], 1u);
    return b;
}
__device__ __forceinline__ void xcd_barrier_complete(unsigned* bar, unsigned x, unsigned& nloc, unsigned& nx) {
    const unsigned G = gridDim.x * gridDim.y * gridDim.z;
    unsigned sum, cnt, mine, sp = 0u;
    for (;;) {
        sum = 0u; cnt = 0u; mine = 0u;
#pragma unroll
        for (unsigned j = 0; j < 16; ++j) { const unsigned c = xb_ld(&bar[XB_XCNT(j)]); sum += c; cnt += (c > 0u) ? 1u : 0u; mine = (j == x) ? c : mine; }
        if (sum == G) break;
        __builtin_amdgcn_s_sleep(1);
        if ((++sp & 255u) == 0u) { if (xb_ld(&bar[XB_TMO])) break; if (sp > XB_SPIN_CAP) { atomicAdd(&bar[XB_TMO], 1u); break; } }
    }
    nloc = mine > 0u ? mine : 1u; nx = cnt > 0u ? cnt : 1u;
}
__device__ __forceinline__ void xcd_barrier(const XcdBarrier& b) {
    asm volatile("s_waitcnt vmcnt(0)" ::: "memory");
    __syncthreads();
    if (threadIdx.x == 0) {
        unsigned* bar = b.bar;
        __builtin_amdgcn_s_waitcnt(0);
        unsigned nloc = b.st[0], nx = b.st[1];
        if (nloc == 0u) { xcd_barrier_complete(bar, b.x, nloc, nx); b.st[0] = nloc; b.st[1] = nx; }
        const unsigned old = xb_add(&bar[XB_XSUB(b.x)], 1u);
        const unsigned gen = old / nloc;
        if (old + 1u == (gen + 1u) * nloc) {
            __builtin_amdgcn_fence(__ATOMIC_RELEASE, "agent");
            asm volatile("s_waitcnt vmcnt(0)" ::: "memory");
            const unsigned og = xb_add(&bar[XB_TOP], 1u);
            const unsigned tg = og / nx;
            if (og + 1u == (tg + 1u) * nx) xb_add(&bar[XB_TOPGEN], 1u);
            else XB_SPIN(xb_ld(&bar[XB_TOPGEN]) == tg, bar);
            __builtin_amdgcn_fence(__ATOMIC_ACQUIRE, "agent");
            xb_add(&bar[XB_XGEN(b.x)], 1u);
            asm volatile("s_waitcnt vmcnt(0)" ::: "memory");
        } else {
            XB_SPIN(xb_ld(&bar[XB_XGEN(b.x)]) == gen, bar);
            __builtin_amdgcn_fence(__ATOMIC_ACQUIRE, "agent");
            asm volatile("s_waitcnt vmcnt(0)" ::: "memory");
        }
    }
    __syncthreads();
}

typedef _Float16 h8 __attribute__((ext_vector_type(8)));
typedef _Float16 h4 __attribute__((ext_vector_type(4)));
typedef float f4 __attribute__((ext_vector_type(4)));

__device__ __forceinline__ float wave_sum(float v) {
#pragma unroll
    for (int o = 32; o > 0; o >>= 1) v += __shfl_xor(v, o);
    return v;
}
__device__ __forceinline__ float wave_max(float v) {
#pragma unroll
    for (int o = 32; o > 0; o >>= 1) v = fmaxf(v, __shfl_xor(v, o));
    return v;
}
__device__ __forceinline__ void wave_sync() {
    asm volatile("s_waitcnt lgkmcnt(0)" ::: "memory");
    __builtin_amdgcn_wave_barrier();
}
__device__ __forceinline__ float gelu_tanh(float x) {
    const float u = 0.7978845608028654f * (x + 0.044715f * x * x * x);
    return 0.5f * x * (1.f + tanhf(u));
}
__device__ __forceinline__ float gelu_fast(float x) { const float u = 0.7978845608028654f * (x + 0.044715f * x * x * x); const float t = 1.f - 2.f * __builtin_amdgcn_rcpf(1.f + __builtin_amdgcn_exp2f(2.8853900817779268f * u)); return 0.5f * x * (1.f + t); }
__device__ __forceinline__ float sigmoidf_(float x) { return 1.f / (1.f + expf(-x)); }
__device__ __forceinline__ unsigned pk4_fp8(float a, float b, float c, float d) { int w = 0; w = __builtin_amdgcn_cvt_pk_fp8_f32(a, b, w, false); w = __builtin_amdgcn_cvt_pk_fp8_f32(c, d, w, true); return (unsigned)w; }
__device__ __forceinline__ void dec4_fp8(unsigned w, float& a, float& b, float& c, float& d) { a = __builtin_amdgcn_cvt_f32_fp8((int)w, 0); b = __builtin_amdgcn_cvt_f32_fp8((int)w, 1); c = __builtin_amdgcn_cvt_f32_fp8((int)w, 2); d = __builtin_amdgcn_cvt_f32_fp8((int)w, 3); }
__device__ __forceinline__ float swiglu_fast(float g, float l) { const float xg = fminf(g, 7.f), xl = fminf(fmaxf(l, -7.f), 7.f); return xg * __builtin_amdgcn_rcpf(1.f + __builtin_amdgcn_exp2f(-2.4554669595930156f * xg)) * (xl + 1.f); }

constexpr int G_LD = 40;
template <class AF, class EF>
__device__ __forceinline__ void gemm_tile(char* smem, int K, const AF& af, const float* __restrict__ Bm, int ldb, int n0, int Nlim, bool perm, const EF& ef) {
    _Float16* As = (_Float16*)smem;
    _Float16* Bs = As + 128 * G_LD;
    const int tid = threadIdx.x, lane = tid & 63, wid = tid >> 6, wr = wid >> 2, wc = wid & 3, fr = lane & 15, fq = lane >> 4;
    f4 acc[4][2];
#pragma unroll
    for (int m = 0; m < 4; ++m)
#pragma unroll
        for (int n = 0; n < 2; ++n) acc[m][n] = (f4){0.f, 0.f, 0.f, 0.f};
    const int ar = tid >> 3, ak = (tid & 7) * 4;
    const float* ap0 = af.row(ar);
    const float* ap1 = af.row(ar + 64);
    const int bk = tid >> 5, bn = (tid & 31) * 4;
    const bool bok = (n0 + bn) < Nlim;
    int bnp[4];
#pragma unroll
    for (int i = 0; i < 4; ++i) { const int c = bn + i; bnp[i] = perm ? ((c & ~31) | ((c & 1) << 4) | ((c & 31) >> 1)) : c; }
    for (int k0 = 0; k0 < K; k0 += 32) {
        const int ko = af.koff(k0 + ak);
        float4 a0 = make_float4(0.f, 0.f, 0.f, 0.f), a1 = a0, b0 = a0, b1 = a0;
        if (ap0) a0 = *(const float4*)(ap0 + ko);
        if (ap1) a1 = *(const float4*)(ap1 + ko);
        if (bok) { b0 = *(const float4*)(Bm + (size_t)(k0 + bk) * ldb + n0 + bn); b1 = *(const float4*)(Bm + (size_t)(k0 + bk + 16) * ldb + n0 + bn); }
        __syncthreads();
        *(h4*)&As[ar * G_LD + ak] = (h4){(_Float16)a0.x, (_Float16)a0.y, (_Float16)a0.z, (_Float16)a0.w};
        *(h4*)&As[(ar + 64) * G_LD + ak] = (h4){(_Float16)a1.x, (_Float16)a1.y, (_Float16)a1.z, (_Float16)a1.w};
        Bs[bnp[0] * G_LD + bk] = (_Float16)b0.x; Bs[bnp[1] * G_LD + bk] = (_Float16)b0.y; Bs[bnp[2] * G_LD + bk] = (_Float16)b0.z; Bs[bnp[3] * G_LD + bk] = (_Float16)b0.w;
        Bs[bnp[0] * G_LD + bk + 16] = (_Float16)b1.x; Bs[bnp[1] * G_LD + bk + 16] = (_Float16)b1.y; Bs[bnp[2] * G_LD + bk + 16] = (_Float16)b1.z; Bs[bnp[3] * G_LD + bk + 16] = (_Float16)b1.w;
        __syncthreads();
        h8 a[4], b[2];
#pragma unroll
        for (int m = 0; m < 4; ++m) a[m] = *(const h8*)&As[(wr * 64 + m * 16 + fr) * G_LD + fq * 8];
#pragma unroll
        for (int n = 0; n < 2; ++n) b[n] = *(const h8*)&Bs[(wc * 32 + n * 16 + fr) * G_LD + fq * 8];
#pragma unroll
        for (int m = 0; m < 4; ++m)
#pragma unroll
            for (int n = 0; n < 2; ++n) acc[m][n] = __builtin_amdgcn_mfma_f32_16x16x32_f16(a[m], b[n], acc[m][n], 0, 0, 0);
    }
    ef(acc, wr, wc, fr, fq);
    __syncthreads();
}

struct ARowPlain { const float* base; int ld; int m0; int mlim;
    __device__ __forceinline__ const float* row(int r) const { return (m0 + r) < mlim ? base + (size_t)(m0 + r) * ld : nullptr; }
    __device__ __forceinline__ int koff(int k) const { return k; } };
struct ARowCmp { const float* proj; int col; int m0;
    __device__ __forceinline__ const float* row(int r) const { const int g = m0 + r; if (g >= CROWS) return nullptr; const int kvh = g & 1, bc = g >> 1, b = bc / NC, c = bc % NC;
        return proj + (size_t)(b * S_ + 16 * c) * INW + col + kvh * 128; }
    __device__ __forceinline__ int koff(int k) const { return (k >> 7) * INW + (k & 127); } };
struct ARowList { const float* base; const int* list; int m0; int cnt; int shift;
    __device__ __forceinline__ const float* row(int r) const { if (m0 + r >= cnt) return nullptr; const int a = list[m0 + r]; return base + (size_t)(a >> shift) * 2048; }
    __device__ __forceinline__ int koff(int k) const { return k; } };

struct EpiStore { float* C; int ldc; int m0; int n0; int mlim; int nlim; _Float16* C16;
    __device__ __forceinline__ void operator()(const f4 (&acc)[4][2], int wr, int wc, int fr, int fq) const {
#pragma unroll
        for (int m = 0; m < 4; ++m)
#pragma unroll
            for (int n = 0; n < 2; ++n)
#pragma unroll
                for (int j = 0; j < 4; ++j) { const int r = m0 + wr * 64 + m * 16 + fq * 4 + j, c = n0 + wc * 32 + n * 16 + fr;
                    if (r < mlim && c < nlim) { C[(size_t)r * ldc + c] = acc[m][n][j]; if (C16) C16[(size_t)r * ldc + c] = (_Float16)acc[m][n][j]; } } } };
struct EpiKc { _Float16* C; int m0;
    __device__ __forceinline__ void operator()(const f4 (&acc)[4][2], int wr, int wc, int fr, int fq) const {
#pragma unroll
        for (int m = 0; m < 4; ++m)
#pragma unroll
            for (int n = 0; n < 2; ++n)
#pragma unroll
                for (int j = 0; j < 4; ++j) { const int r = m0 + wr * 64 + m * 16 + fq * 4 + j, c = wc * 32 + n * 16 + fr;
                    C[(size_t)r * 128 + c] = (((r >> 1) & 127) == 127) ? (_Float16)0.f : (_Float16)acc[m][n][j]; } } };
struct EpiPool { _Float16* C; const float* scale; int m0; int g;
    __device__ __forceinline__ void operator()(const f4 (&acc)[4][2], int wr, int wc, int fr, int fq) const {
#pragma unroll
        for (int m = 0; m < 4; ++m)
#pragma unroll
            for (int n = 0; n < 2; ++n)
#pragma unroll
                for (int j = 0; j < 4; ++j) { const int r = m0 + wr * 64 + m * 16 + fq * 4 + j, c = g * 128 + wc * 32 + n * 16 + fr;
                    C[(size_t)r * 512 + c] = (_Float16)(acc[m][n][j] * scale[c]); } } };
struct EpiHid { float* C; const float* bias; int m0; int n0;
    __device__ __forceinline__ void operator()(const f4 (&acc)[4][2], int wr, int wc, int fr, int fq) const {
#pragma unroll
        for (int m = 0; m < 4; ++m)
#pragma unroll
            for (int n = 0; n < 2; ++n)
#pragma unroll
                for (int j = 0; j < 4; ++j) { const int r = m0 + wr * 64 + m * 16 + fq * 4 + j, c = n0 + wc * 32 + n * 16 + fr;
                    if (r < CROWS) C[(size_t)r * 256 + c] = gelu_tanh(acc[m][n][j] + bias[c]); } } };
struct EpiOut { float* C; const float* x; int m0; int n0;
    __device__ __forceinline__ void operator()(const f4 (&acc)[4][2], int wr, int wc, int fr, int fq) const {
#pragma unroll
        for (int m = 0; m < 4; ++m)
#pragma unroll
            for (int n = 0; n < 2; ++n)
#pragma unroll
                for (int j = 0; j < 4; ++j) { const size_t o = (size_t)(m0 + wr * 64 + m * 16 + fq * 4 + j) * 2048 + n0 + wc * 32 + n * 16 + fr;
                    C[o] = DN_ALPHA * x[o] + acc[m][n][j]; } } };
struct EpiGu { float* act; const float* bgu; const int* list; int m0; int cnt; int n0;
    __device__ __forceinline__ void operator()(const f4 (&acc)[4][2], int wr, int wc, int fr, int fq) const {
        const int jc = (n0 + wc * 32) / 2 + fr;
        const float bg = bgu[2 * jc], bl = bgu[2 * jc + 1];
#pragma unroll
        for (int m = 0; m < 4; ++m)
#pragma unroll
            for (int j = 0; j < 4; ++j) { const int r = m0 + wr * 64 + m * 16 + fq * 4 + j;
                if (r < cnt) { const int a = list[r];
                    const float xg = fminf(acc[m][0][j] + bg, 7.f), xl = fminf(fmaxf(acc[m][1][j] + bl, -7.f), 7.f);
                    act[(size_t)a * 2048 + jc] = xg * sigmoidf_(1.702f * xg) * (xl + 1.f); } } } };
struct EpiDn { float* y; const float* bdn; const int* list; const float* gate; int m0; int cnt; int n0;
    __device__ __forceinline__ void operator()(const f4 (&acc)[4][2], int wr, int wc, int fr, int fq) const {
#pragma unroll
        for (int m = 0; m < 4; ++m)
#pragma unroll
            for (int j = 0; j < 4; ++j) { const int r = m0 + wr * 64 + m * 16 + fq * 4 + j;
                if (r < cnt) { const int a = list[r]; const float g = gate[a];
#pragma unroll
                    for (int n = 0; n < 2; ++n) { const int c = n0 + wc * 32 + n * 16 + fr; y[(size_t)a * 2048 + c] = (acc[m][n][j] + bdn[c]) * g; } } } } };

constexpr int WLDS_FLOATS = 4096 + 512 + 32;
template <bool SHARED>
__device__ __forceinline__ void wave_attn(float* sw, const float* __restrict__ qptr, const float* __restrict__ Kb, const float* __restrict__ Vb, int ld, int nseg, float scale, float* __restrict__ optr) {
    const int lane = threadIdx.x & 63;
    float* sq = sw + 4096; const int* segs = (const int*)(sw + 4096 + 512);
#pragma unroll
    for (int i = 0; i < 8; ++i) sq[lane + 64 * i] = qptr[lane + 64 * i];
    wave_sync();
    for (int sg = 0; sg < nseg; ++sg) {
        const int start = segs[sg], len = segs[16 + sg];
        float d0 = 0.f, d1 = 0.f, d2 = 0.f, d3 = 0.f;
        if (lane < len) {
            const float* kp = Kb + (size_t)(start + lane) * ld;
            for (int d4 = 0; d4 < 32; ++d4) {
                if (SHARED) {
                    const float4 kv = *(const float4*)(kp + d4 * 4);
                    const float4 q0 = *(const float4*)(sq + d4 * 4), q1 = *(const float4*)(sq + 128 + d4 * 4), q2 = *(const float4*)(sq + 256 + d4 * 4), q3 = *(const float4*)(sq + 384 + d4 * 4);
                    d0 += kv.x * q0.x + kv.y * q0.y + kv.z * q0.z + kv.w * q0.w;
                    d1 += kv.x * q1.x + kv.y * q1.y + kv.z * q1.z + kv.w * q1.w;
                    d2 += kv.x * q2.x + kv.y * q2.y + kv.z * q2.z + kv.w * q2.w;
                    d3 += kv.x * q3.x + kv.y * q3.y + kv.z * q3.z + kv.w * q3.w;
                } else {
                    const float4 k0 = *(const float4*)(kp + d4 * 4), k1 = *(const float4*)(kp + 128 + d4 * 4), k2 = *(const float4*)(kp + 256 + d4 * 4), k3 = *(const float4*)(kp + 384 + d4 * 4);
                    const float4 q0 = *(const float4*)(sq + d4 * 4), q1 = *(const float4*)(sq + 128 + d4 * 4), q2 = *(const float4*)(sq + 256 + d4 * 4), q3 = *(const float4*)(sq + 384 + d4 * 4);
                    d0 += k0.x * q0.x + k0.y * q0.y + k0.z * q0.z + k0.w * q0.w;
                    d1 += k1.x * q1.x + k1.y * q1.y + k1.z * q1.z + k1.w * q1.w;
                    d2 += k2.x * q2.x + k2.y * q2.y + k2.z * q2.z + k2.w * q2.w;
                    d3 += k3.x * q3.x + k3.y * q3.y + k3.z * q3.z + k3.w * q3.w;
                }
            }
        }
        const bool ok = lane < len;
        sw[sg * 64 + lane] = ok ? d0 * scale : -1e30f;
        sw[1024 + sg * 64 + lane] = ok ? d1 * scale : -1e30f;
        sw[2048 + sg * 64 + lane] = ok ? d2 * scale : -1e30f;
        sw[3072 + sg * 64 + lane] = ok ? d3 * scale : -1e30f;
    }
    wave_sync();
    const int n = nseg * 64;
#pragma unroll
    for (int g = 0; g < 4; ++g) {
        float mx = -1e30f;
        for (int i = lane; i < n; i += 64) mx = fmaxf(mx, sw[g * 1024 + i]);
        mx = wave_max(mx);
        float sm = 0.f;
        for (int i = lane; i < n; i += 64) { const float v = sw[g * 1024 + i]; sm += (v > -1e29f) ? expf(v - mx) : 0.f; }
        sm = wave_sum(sm);
        const float inv = sm > 0.f ? 1.f / sm : 0.f;
        for (int i = lane; i < n; i += 64) { const float v = sw[g * 1024 + i]; sw[g * 1024 + i] = (v > -1e29f) ? expf(v - mx) * inv : 0.f; }
    }
    wave_sync();
    float o[4][2];
#pragma unroll
    for (int g = 0; g < 4; ++g) { o[g][0] = 0.f; o[g][1] = 0.f; }
    for (int sg = 0; sg < nseg; ++sg) {
        const int start = segs[sg], len = segs[16 + sg];
        for (int l = 0; l < len; ++l) {
            const float* vp = Vb + (size_t)(start + l) * ld;
            if (SHARED) {
                const float v0 = vp[lane], v1 = vp[lane + 64];
#pragma unroll
                for (int g = 0; g < 4; ++g) { const float p = sw[g * 1024 + sg * 64 + l]; o[g][0] += p * v0; o[g][1] += p * v1; }
            } else {
#pragma unroll
                for (int g = 0; g < 4; ++g) { const float p = sw[g * 1024 + sg * 64 + l]; o[g][0] += p * vp[g * 128 + lane]; o[g][1] += p * vp[g * 128 + lane + 64]; }
            }
        }
    }
#pragma unroll
    for (int g = 0; g < 4; ++g) { optr[g * 128 + lane] = o[g][0]; optr[g * 128 + lane + 64] = o[g][1]; }
}

namespace g8 {
constexpr int BM = 256, BK = 64, HALF = 128, HTB = HALF * BK * 2, STAGE_BYTES = 8 * HTB;
constexpr int KK = 2048;
typedef float f32x4 __attribute__((ext_vector_type(4)));
__device__ __forceinline__ int lds_byte(int r, int c) { return r * 128 + ((((c >> 3) ^ (r >> 1)) & 7) << 4) + (c & 7) * 2; }
__device__ __forceinline__ void stage_rc(int b, int& R, int& C) { R = b >> 7; C = ((((b >> 4) ^ (R >> 1)) & 7)) * 8; }
__device__ __forceinline__ int perm32(int rho) { const int n = rho >> 4, i = rho & 15; return 8 * (i >> 2) + 4 * n + (i & 3); }

typedef int i32x4 __attribute__((ext_vector_type(4)));
typedef unsigned u32x2 __attribute__((ext_vector_type(2)));
typedef unsigned u32x4 __attribute__((ext_vector_type(4)));
template <bool I8> struct AccSel { typedef f32x4 T; };
template <> struct AccSel<true> { typedef i32x4 T; };
__device__ __forceinline__ f32x4 mma16(i32x4 a, i32x4 b, f32x4 c) { return __builtin_amdgcn_mfma_f32_16x16x32_f16(*reinterpret_cast<h8*>(&a), *reinterpret_cast<h8*>(&b), c, 0, 0, 0); }
__device__ __forceinline__ i32x4 mma16(i32x4 a, i32x4 b, i32x4 c) { return __builtin_amdgcn_mfma_i32_16x16x64_i8(a, b, c, 0, 0, 0); }
struct Unit { int m0, n0, e, cnt, rbase; };
constexpr int EP_OFF = STAGE_BYTES + 2048, EP_LD = 528, EP_GRP = 16 * EP_LD;
constexpr int CONST_OFF = EP_OFF + 18432;
__device__ __forceinline__ void cdma(LAS unsigned char* lds, int region, int idx, const void* src) { __builtin_amdgcn_global_load_lds((const unsigned*)src, (LAS unsigned*)(lds + CONST_OFF + region * 1024 + idx * 256), 4, 0, 0); }
__device__ __forceinline__ void ep_sync() { asm volatile("s_waitcnt lgkmcnt(0)" ::: "memory"); __builtin_amdgcn_s_barrier(); asm volatile("" ::: "memory"); }
__device__ __forceinline__ int ep_tid() { int tz = threadIdx.x; asm volatile("" : "+v"(tz)); return tz; }
__device__ __forceinline__ h8 cvt8(f32x4 a, f32x4 b) { h8 o; o[0] = (_Float16)a[0]; o[1] = (_Float16)a[1]; o[2] = (_Float16)a[2]; o[3] = (_Float16)a[3]; o[4] = (_Float16)b[0]; o[5] = (_Float16)b[1]; o[6] = (_Float16)b[2]; o[7] = (_Float16)b[3]; return o; }

__device__ __forceinline__ void tile_order(int L, int nM, int nN, int& pm, int& pn) {
    const int nwg = nM * nN; int wgid = L;
    { const int q = nwg / 8, r = nwg % 8, xcd = wgid % 8, off = wgid / 8; wgid = (xcd < r ? xcd * (q + 1) : r * (q + 1) + (xcd - r) * q) + off; }
    const int nig = 8 * nN, gid = wgid / nig, fm = gid * 8, gsz = (nM - fm) < 8 ? (nM - fm) : 8;
    pm = fm + ((wgid % nig) % gsz); pn = (wgid % nig) / gsz;
}

template <class Prob>
__device__ __forceinline__ void gemm_phase(LAS unsigned char* lds, const Prob& P) {
    int tidh_ = threadIdx.x; asm volatile("" : "+v"(tidh_));
    const int tid = tidh_, wid = __builtin_amdgcn_readfirstlane(tid >> 6), lane = tid & 63, wr = wid >> 2, wc = wid & 3, fr = lane & 15, fq = lane >> 4;
    constexpr int nt = Prob::NT; constexpr size_t KS2 = Prob::KS2; constexpr unsigned ROWB = Prob::ROWB; constexpr bool I8 = Prob::I8;
    int sR[2], sC2[2]; unsigned voffB[2];
#pragma unroll
    for (int i = 0; i < 2; ++i) { int R, C; stage_rc(tid * 16 + i * 8192, R, C); sR[i] = R; sC2[i] = C * 2; const int Rb = Prob::PERM ? ((R & ~31) + perm32(R & 31)) : R; voffB[i] = (unsigned)Rb * ROWB + (unsigned)C * 2u; }
    const size_t kstep = (size_t)(BK * 2);
    const size_t hstep = (size_t)HALF * ROWB;
    const unsigned ldsw = (unsigned)wid * 1024u;
    const int aoff = lds_byte(wr * 64 + fr, fq * 8), boff = lds_byte(wc * 32 + fr, fq * 8), aoff1 = lds_byte(wr * 64 + fr, fq * 8 + 32), boff1 = lds_byte(wc * 32 + fr, fq * 8 + 32);
#define G8_SA(b, h) (((b) * 2 + (h)) * HTB)
#define G8_SB(b, h) ((4 + (b) * 2 + (h)) * HTB)
#define G8_STAGE(bufoff, gbase, voff) do { _Pragma("unroll") for (int _i = 0; _i < 2; ++_i) \
        __builtin_amdgcn_global_load_lds((const unsigned*)((const char*)(gbase) + (voff)[_i]), (LAS unsigned*)(lds + (bufoff) + ldsw + _i * 8192), 16, 0, 0); } while (0)
#define G8_LDA(dst, b, h) do { _Pragma("unroll") for (int m = 0; m < 4; ++m) _Pragma("unroll") for (int k = 0; k < 2; ++k) dst[m][k] = *(const LAS i32x4*)(lds + G8_SA(b, h) + (k ? aoff1 : aoff) + m * 2048); } while (0)
#define G8_LDB(dst, b, h) do { _Pragma("unroll") for (int n = 0; n < 2; ++n) _Pragma("unroll") for (int k = 0; k < 2; ++k) dst[n][k] = *(const LAS i32x4*)(lds + G8_SB(b, h) + (k ? boff1 : boff) + n * 2048); } while (0)
#define G8_MMA(ai, bj, At, Bt) do { __builtin_amdgcn_s_setprio(1); _Pragma("unroll") for (int m = 0; m < 4; ++m) _Pragma("unroll") for (int n = 0; n < 2; ++n) _Pragma("unroll") for (int k = 0; k < 2; ++k) \
        acc[ai][bj][m][n] = mma16(Bt[n][k], At[m][k], acc[ai][bj][m][n]); __builtin_amdgcn_s_setprio(0); } while (0)
#define G8_WAIT_V(n) asm volatile("s_waitcnt vmcnt(" #n ")" ::: "memory")
#define G8_WAIT_L(n) asm volatile("s_waitcnt lgkmcnt(" #n ")" ::: "memory")
#define G8_BAR __builtin_amdgcn_s_barrier()
#define G8_SCHED __builtin_amdgcn_sched_barrier(0)
    Unit cur, nxt; int ui = 0;
    if (!P.next(0, cur)) return;
    typedef typename AccSel<I8>::T AccT;
    AccT acc[2][2][4][2];
#pragma unroll
    for (int a = 0; a < 2; ++a)
#pragma unroll
        for (int b = 0; b < 2; ++b)
#pragma unroll
            for (int m = 0; m < 4; ++m)
#pragma unroll
                for (int n = 0; n < 2; ++n) acc[a][b][m][n] = AccT{};
    i32x4 At[4][2], B0[2][2], B1[2][2];
    unsigned vc[2][2], vn[2][2];
    P.a_offs(cur, sR, sC2, vc);
    const char* const Ab = P.a_base();
    const char* cB = P.b_base(cur);
    G8_STAGE(G8_SB(0, 0), cB, voffB); G8_STAGE(G8_SA(0, 0), Ab, vc[0]); G8_STAGE(G8_SB(0, 1), cB + hstep, voffB); G8_STAGE(G8_SA(0, 1), Ab, vc[1]);
    if (wr == 1) G8_BAR;
    G8_WAIT_V(4); G8_BAR;
    G8_STAGE(G8_SB(1, 0), cB + kstep, voffB); G8_STAGE(G8_SA(1, 0), Ab + kstep, vc[0]); G8_STAGE(G8_SB(1, 1), cB + hstep + kstep, voffB);
    G8_WAIT_V(6); G8_BAR;
    for (;;) {
        const bool has_next = P.next(ui + 1, nxt);
        const char* nB = cB;
        if (has_next) { P.a_offs(nxt, sR, sC2, vn); nB = P.b_base(nxt); }
        else { vn[0][0] = vc[0][0]; vn[0][1] = vc[0][1]; vn[1][0] = vc[1][0]; vn[1][1] = vc[1][1]; }
        for (int t = 0; t < nt; t += 2) {
            const bool last = (t == nt - 2);
            if constexpr (Prob::CD) { if (last) P.const_dma(cur, lds, wid, lane); }
            const char* a1 = Ab + (size_t)(t >> 1) * KS2 + kstep;
            const char* a2 = last ? Ab : Ab + (size_t)((t + 2) >> 1) * KS2; const char* b2 = last ? nB : cB + (size_t)(t + 2) * kstep;
            const char* a3 = a2 + kstep; const char* b3 = b2 + kstep;
            unsigned o2[2][2];
            o2[0][0] = last ? vn[0][0] : vc[0][0]; o2[0][1] = last ? vn[0][1] : vc[0][1]; o2[1][0] = last ? vn[1][0] : vc[1][0]; o2[1][1] = last ? vn[1][1] : vc[1][1];
            G8_LDB(B0, 0, 0); G8_SCHED; G8_LDA(At, 0, 0); G8_STAGE(G8_SA(1, 1), a1, vc[1]);
            G8_WAIT_L(8); G8_BAR; G8_WAIT_L(0); G8_MMA(0, 0, At, B0); G8_BAR; G8_SCHED;
            G8_LDB(B1, 0, 1); G8_STAGE(G8_SB(0, 0), b2, voffB);
            G8_BAR; G8_WAIT_L(0); G8_MMA(0, 1, At, B1); G8_BAR;
            G8_LDA(At, 0, 1); G8_STAGE(G8_SA(0, 0), a2, o2[0]);
            G8_BAR; G8_WAIT_L(0); G8_MMA(1, 0, At, B0); G8_BAR; G8_SCHED;
            G8_STAGE(G8_SB(0, 1), b2 + hstep, voffB);
            G8_WAIT_V(6); G8_BAR; G8_MMA(1, 1, At, B1); G8_BAR;
            G8_LDB(B0, 1, 0); G8_SCHED; G8_LDA(At, 1, 0); G8_STAGE(G8_SA(0, 1), a2, o2[1]);
            G8_WAIT_L(8); G8_BAR; G8_WAIT_L(0); G8_MMA(0, 0, At, B0); G8_BAR; G8_SCHED;
            G8_LDB(B1, 1, 1); G8_STAGE(G8_SB(1, 0), b3, voffB);
            G8_BAR; G8_WAIT_L(0); G8_MMA(0, 1, At, B1); G8_BAR;
            G8_LDA(At, 1, 1); G8_STAGE(G8_SA(1, 0), a3, o2[0]);
            G8_BAR; G8_WAIT_L(0); G8_MMA(1, 0, At, B0); G8_BAR; G8_SCHED;
            G8_STAGE(G8_SB(1, 1), b3 + hstep, voffB);
            G8_WAIT_V(6); G8_BAR; G8_MMA(1, 1, At, B1); G8_BAR;
        }
        P.epi(acc, cur, wr, wc, fr, fq, lds);
        if (!has_next) break;
#pragma unroll
        for (int a = 0; a < 2; ++a)
#pragma unroll
            for (int b = 0; b < 2; ++b)
#pragma unroll
                for (int m = 0; m < 4; ++m)
#pragma unroll
                    for (int n = 0; n < 2; ++n) acc[a][b][m][n] = AccT{};
        cur = nxt; cB = nB; ++ui;
        vc[0][0] = vn[0][0]; vc[0][1] = vn[0][1]; vc[1][0] = vn[1][0]; vc[1][1] = vn[1][1];
    }
    G8_WAIT_V(0);
    if (wr == 0) G8_BAR;
    G8_BAR;
#undef G8_SA
#undef G8_SB
#undef G8_STAGE
#undef G8_LDA
#undef G8_LDB
#undef G8_MMA
#undef G8_WAIT_V
#undef G8_WAIT_L
#undef G8_BAR
#undef G8_SCHED
}

struct ProbInF {
    static constexpr bool CD = false;
    static constexpr unsigned ROWB = 4096; static constexpr bool I8 = false;
    static constexpr int NT = 32; static constexpr size_t KS2 = 256;
    static constexpr bool PERM = true;
    const _Float16* A; _Float16* C16; int G, c;
    __device__ __forceinline__ bool next(int i, Unit& u) const { const int L = i * G + c; if (L >= 64 * 5) return false;
        int pm, pn; tile_order(L, 64, 5, pm, pn); u.m0 = pm * 256; u.n0 = pn * 256; u.e = 0; u.cnt = 256; u.rbase = 0; return true; }
    __device__ __forceinline__ void a_offs(const Unit& u, const int (&R)[2], const int (&C2)[2], unsigned (&v)[2][2]) const {
#pragma unroll
        for (int h = 0; h < 2; ++h)
#pragma unroll
            for (int i = 0; i < 2; ++i) v[h][i] = (unsigned)(u.m0 + h * 128 + R[i]) * (unsigned)(KK * 2) + (unsigned)C2[i]; }
    __device__ __forceinline__ const char* a_base() const { return (const char*)A; }
    __device__ __forceinline__ const char* b_base(const Unit& u) const { return (const char*)A + (long long)(WS_WTIN - WS_X16) + (size_t)u.n0 * KK * 2; }
    __device__ __forceinline__ void epi(const f32x4 (&acc)[2][2][4][2], const Unit& u, int wr, int wc, int fr, int fq, LAS unsigned char* lds) const {
        LAS unsigned char* ep = lds + EP_OFF + wr * EP_GRP;
        const int tg = ep_tid() & 255, rrow = tg >> 4, ch = tg & 15;
        const int kvseg = (u.e == 0 && u.n0 >= 1024 && u.n0 < 2560) ? ((u.n0 - 1024) >> 8) : -1;
        _Float16* const Cb = (_Float16*)((char*)C16 + (u.e ? (long long)(WS_KVMEM16 - WS_PROJ16) : 0ll)); const int ldc = u.e ? 1024 : INW, nlim = u.e ? 1024 : INW, mb = u.e ? u.m0 - T_ : u.m0;
#pragma unroll
        for (int ai = 0; ai < 2; ++ai)
#pragma unroll
            for (int m = 0; m < 4; ++m) {
#pragma unroll
                for (int bj = 0; bj < 2; ++bj) *(LAS h8*)(ep + fr * EP_LD + (bj * 128 + wc * 32 + fq * 8) * 2) = cvt8(acc[ai][bj][m][0], acc[ai][bj][m][1]);
                ep_sync();
                const h8 x0 = *(const LAS h8*)(ep + rrow * EP_LD + ch * 32), x1 = *(const LAS h8*)(ep + rrow * EP_LD + ch * 32 + 16);
                const int grow = mb + ai * 128 + wr * 64 + m * 16 + rrow, gcol = u.n0 + ch * 16;
                if (kvseg >= 0) {
                    _Float16* dst = (_Float16*)((char*)C16 + (long long)(WS_KV16 - WS_PROJ16)) + ((size_t)(kvseg * B_ + (grow >> 11)) * 2 + (ch >> 3)) * KVSEG + (size_t)(grow & (S_ - 1)) * 128 + (ch & 7) * 16;
                    *(h8*)dst = x0; *(h8*)(dst + 8) = x1;
                } else {
                    if (gcol < nlim) *(h8*)(Cb + (size_t)grow * ldc + gcol) = x0;
                    if (gcol + 8 < nlim) *(h8*)(Cb + (size_t)grow * ldc + gcol + 8) = x1; }
                ep_sync();
            } }
};
struct ProbIn8 {
    static constexpr bool CD = true;
    static constexpr unsigned ROWB = 2048; static constexpr bool I8 = true;
    static constexpr int NT = 16; static constexpr size_t KS2 = 256;
    static constexpr bool PERM = true;
    const signed char* A; _Float16* C16; const float* sa; int G, c;
    __device__ __forceinline__ bool next(int i, Unit& u) const { const int L = i * G + c; if (L >= 640 + 32) return false;
        if (L < 640) { int pm, pn; tile_order(L, 64, 10, pm, pn); u.m0 = pm * 256; u.n0 = 1280 + pn * 256; u.e = 0; }
        else { const int v = L - 640; u.m0 = T_ + (v & 7) * 256; u.n0 = (v >> 3) * 256; u.e = 1; }
        u.cnt = 256; u.rbase = 0; return true; }
    __device__ __forceinline__ void a_offs(const Unit& u, const int (&R)[2], const int (&C2)[2], unsigned (&v)[2][2]) const {
#pragma unroll
        for (int h = 0; h < 2; ++h)
#pragma unroll
            for (int i = 0; i < 2; ++i) v[h][i] = (unsigned)(u.m0 + h * 128 + R[i]) * 2048u + (unsigned)C2[i]; }
    __device__ __forceinline__ const char* a_base() const { return (const char*)A; }
    __device__ __forceinline__ const char* b_base(const Unit& u) const { return (const char*)A + (u.e ? (long long)(WS_Q8MKV - WS_X8) + (long long)u.n0 * 2048 : (long long)(WS_Q8IN - WS_X8) + (long long)(u.n0 - 1280) * 2048); }
    __device__ __forceinline__ void const_dma(const Unit& u, LAS unsigned char* lds, int wid, int lane) const {
        const int i4 = wid & 3;
        if (wid < 4) cdma(lds, 1, i4, (const float*)((const char*)A + (u.e ? (long long)(WS_SMKV - WS_X8) : (long long)(WS_SIN8 - WS_X8))) + (u.e ? u.n0 : u.n0 - 1280) + i4 * 64 + lane);
        else cdma(lds, 2, i4, sa + u.m0 + i4 * 64 + lane);
    }
    __device__ __forceinline__ void epi(const i32x4 (&acc)[2][2][4][2], const Unit& u, int wr, int wc, int fr, int fq, LAS unsigned char* lds) const {
        asm volatile("s_waitcnt vmcnt(16)" ::: "memory");
        ep_sync();
        LAS unsigned char* ep = lds + EP_OFF + wr * EP_GRP;
        const int tg = ep_tid() & 255, rrow = tg >> 4, ch = tg & 15;
        const int kvseg = (u.e == 0 && u.n0 >= 1024 && u.n0 < 2560) ? ((u.n0 - 1024) >> 8) : -1;
        _Float16* const Cb = (_Float16*)((char*)C16 + (u.e ? (long long)(WS_KVMEM16 - WS_PROJ16) : 0ll)); const int ldc = u.e ? 1024 : INW, nlim = u.e ? 1024 : INW, mb = u.e ? u.m0 - T_ : u.m0;
        const LAS float* cst = (const LAS float*)(lds + CONST_OFF);
        f32x4 s0[2], s1[2]; float srv[8];
#pragma unroll
        for (int bj = 0; bj < 2; ++bj) { const int col = bj * 128 + wc * 32 + fq * 8; s0[bj] = *(const LAS f32x4*)(cst + 256 + col); s1[bj] = *(const LAS f32x4*)(cst + 256 + col + 4); }
#pragma unroll
        for (int q = 0; q < 8; ++q) srv[q] = cst[512 + (q >> 2) * 128 + wr * 64 + (q & 3) * 16 + fr];
#pragma unroll
        for (int ai = 0; ai < 2; ++ai)
#pragma unroll
            for (int m = 0; m < 4; ++m) { const float sr = srv[ai * 4 + m];
#pragma unroll
                for (int bj = 0; bj < 2; ++bj) { const i32x4 i0 = acc[ai][bj][m][0], i1 = acc[ai][bj][m][1];
                    *(LAS h8*)(ep + fr * EP_LD + (bj * 128 + wc * 32 + fq * 8) * 2) = cvt8((f32x4){(float)i0[0], (float)i0[1], (float)i0[2], (float)i0[3]} * (s0[bj] * sr), (f32x4){(float)i1[0], (float)i1[1], (float)i1[2], (float)i1[3]} * (s1[bj] * sr)); }
                ep_sync();
                const h8 x0 = *(const LAS h8*)(ep + rrow * EP_LD + ch * 32), x1 = *(const LAS h8*)(ep + rrow * EP_LD + ch * 32 + 16);
                const int grow = mb + ai * 128 + wr * 64 + m * 16 + rrow, gcol = u.n0 + ch * 16;
                if (kvseg >= 0) {
                    _Float16* dst = (_Float16*)((char*)C16 + (long long)(WS_KV16 - WS_PROJ16)) + ((size_t)(kvseg * B_ + (grow >> 11)) * 2 + (ch >> 3)) * KVSEG + (size_t)(grow & (S_ - 1)) * 128 + (ch & 7) * 16;
                    *(h8*)dst = x0; *(h8*)(dst + 8) = x1;
                } else {
                    if (gcol < nlim) *(h8*)(Cb + (size_t)grow * ldc + gcol) = x0;
                    if (gcol + 8 < nlim) *(h8*)(Cb + (size_t)grow * ldc + gcol + 8) = x1; }
                ep_sync();
            } }
};
struct ProbOut {
    static constexpr bool CD = false;
    static constexpr unsigned ROWB = 2048; static constexpr bool I8 = true;
    static constexpr int NT = 16; static constexpr size_t KS2 = 256;
    static constexpr bool PERM = true;
    const signed char* A; const signed char* Bt; _Float16* C; const _Float16* X; const float* sa; const float* sw; int G, c;
    __device__ __forceinline__ bool next(int i, Unit& u) const { const int L = i * G + c; if (L >= 64 * 8) return false; int pm, pn; tile_order(L, 64, 8, pm, pn); u.m0 = pm * 256; u.n0 = pn * 256; u.e = 0; u.cnt = 256; u.rbase = 0; return true; }
    __device__ __forceinline__ void a_offs(const Unit& u, const int (&R)[2], const int (&C2)[2], unsigned (&v)[2][2]) const {
#pragma unroll
        for (int h = 0; h < 2; ++h)
#pragma unroll
            for (int i = 0; i < 2; ++i) v[h][i] = (unsigned)(u.m0 + h * 128 + R[i]) * 2048u + (unsigned)C2[i]; }
    __device__ __forceinline__ const char* a_base() const { return (const char*)A; }
    __device__ __forceinline__ const char* b_base(const Unit& u) const { return (const char*)(Bt + (size_t)u.n0 * 2048); }
    __device__ __forceinline__ void epi(const i32x4 (&acc)[2][2][4][2], const Unit& u, int wr, int wc, int fr, int fq, LAS unsigned char* lds) const {
        LAS unsigned char* ep = lds + EP_OFF + wr * EP_GRP;
        const int tg = ep_tid() & 255, rrow = tg >> 4, ch = tg & 15;
        f32x4 s0[2], s1[2]; float srv[8];
#pragma unroll
        for (int bj = 0; bj < 2; ++bj) { const int col = u.n0 + bj * 128 + wc * 32 + fq * 8; s0[bj] = *(const f32x4*)(sw + col); s1[bj] = *(const f32x4*)(sw + col + 4); }
#pragma unroll
        for (int q = 0; q < 8; ++q) srv[q] = sa[u.m0 + (q >> 2) * 128 + wr * 64 + (q & 3) * 16 + fr];
#pragma unroll
        for (int ai = 0; ai < 2; ++ai)
#pragma unroll
            for (int m = 0; m < 4; ++m) { const float sr = srv[ai * 4 + m];
#pragma unroll
                for (int bj = 0; bj < 2; ++bj) { const i32x4 i0 = acc[ai][bj][m][0], i1 = acc[ai][bj][m][1];
                    *(LAS h8*)(ep + fr * EP_LD + (bj * 128 + wc * 32 + fq * 8) * 2) = cvt8((f32x4){(float)i0[0], (float)i0[1], (float)i0[2], (float)i0[3]} * (s0[bj] * sr), (f32x4){(float)i1[0], (float)i1[1], (float)i1[2], (float)i1[3]} * (s1[bj] * sr)); }
                const size_t go = (size_t)(u.m0 + ai * 128 + wr * 64 + m * 16 + rrow) * 2048 + u.n0 + ch * 16;
                const h8 r0 = *(const h8*)(X + go), r1 = *(const h8*)(X + go + 8);
                ep_sync();
                const h8 x0 = *(const LAS h8*)(ep + rrow * EP_LD + ch * 32), x1 = *(const LAS h8*)(ep + rrow * EP_LD + ch * 32 + 16);
                h8 o0, o1;
#pragma unroll
                for (int q = 0; q < 8; ++q) { o0[q] = (_Float16)(DN_ALPHA * (float)r0[q] + (float)x0[q]); o1[q] = (_Float16)(DN_ALPHA * (float)r1[q] + (float)x1[q]); }
                *(h8*)(C + go) = o0; *(h8*)(C + go + 8) = o1;
                ep_sync();
            } }
};
struct ProbCmp {
    static constexpr bool CD = false;
    static constexpr unsigned ROWB = 4096; static constexpr bool I8 = false;
    static constexpr int NT = 8; static constexpr size_t KS2 = 256;
    static constexpr bool PERM = false;
    const _Float16* A; const _Float16* Bt; float* C; int G, c;
    __device__ __forceinline__ bool next(int i, Unit& u) const { const int L = i * G + c; if (L >= 128) return false;
        u.e = L >> 6; const int r = L & 63; u.rbase = r & 3; u.n0 = ((r >> 2) & 1) * 256; u.m0 = (r >> 3) * 256; u.cnt = 256; return true; }
    __device__ __forceinline__ void a_offs(const Unit& u, const int (&R)[2], const int (&C2)[2], unsigned (&v)[2][2]) const {
#pragma unroll
        for (int h = 0; h < 2; ++h)
#pragma unroll
            for (int i = 0; i < 2; ++i) { const int row = u.m0 + h * 128 + R[i], kvh = row & 1, bj = row >> 1, b = bj >> 7, j = bj & 127;
                v[h][i] = (unsigned)((((u.e * B_ + b) * 2 + kvh) * S_ + 16 * j + 4 * u.rbase) * 128) * 2u + (unsigned)C2[i]; } }
    __device__ __forceinline__ const char* a_base() const { return (const char*)A; }
    __device__ __forceinline__ const char* b_base(const Unit& u) const { return (const char*)(Bt + ((size_t)u.e * 512 + u.n0) * KK + u.rbase * 512); }
    __device__ __forceinline__ void epi(const f32x4 (&acc)[2][2][4][2], const Unit& u, int wr, int wc, int fr, int fq, LAS unsigned char*) const {
        float* base = C + ((size_t)(u.e * 4 + u.rbase) * 2048) * 512;
#pragma unroll
        for (int ai = 0; ai < 2; ++ai)
#pragma unroll
            for (int m = 0; m < 4; ++m) { const int row = u.m0 + ai * 128 + wr * 64 + m * 16 + fr;
#pragma unroll
                for (int bj = 0; bj < 2; ++bj)
#pragma unroll
                    for (int n = 0; n < 2; ++n) { const int col = u.n0 + bj * 128 + wc * 32 + n * 16 + fq * 4;
                        *(f32x4*)(base + (size_t)row * 512 + col) = acc[ai][bj][m][n]; } } }
};
struct MoeTab { const LAS int* t; int NT; int i0, i1;
    __device__ __forceinline__ bool find_i(int i, Unit& u) const {
        if (i + i0 >= i1) return false;
        const LAS int* q = t + 128 + 8 * (i + i0);
        if (__builtin_amdgcn_readfirstlane(q[5]) == 0) return false;
        u.e = __builtin_amdgcn_readfirstlane(q[0]); u.m0 = __builtin_amdgcn_readfirstlane(q[1]); u.n0 = __builtin_amdgcn_readfirstlane(q[2]); u.cnt = __builtin_amdgcn_readfirstlane(q[3]); u.rbase = __builtin_amdgcn_readfirstlane(q[4]); return true; } };
__device__ __forceinline__ void moe_build(LAS int* t, int G, int vcu) {
    const int i = threadIdx.x;
    if (i < 40) { const int L = i * G + vcu; LAS int* q = t + 128 + 8 * i;
        if (L >= t[98]) q[5] = 0;
        else { int e = 0; for (; e < NE - 1; ++e) { if (L < t[32 + e + 1]) break; }
            const int ub = t[32 + e], cn = t[e], rs = t[65 + e]; const int nm = (cn + 255) >> 8, v = L - ub, mt = v % nm, ntile = v / nm;
            q[0] = e; q[1] = mt * 256; q[2] = ntile * 256; q[3] = min(256, cn - mt * 256); q[4] = rs; q[5] = 1; } }
}
struct ProbGu {
    static constexpr int NT = 16; static constexpr size_t KS2 = 256; static constexpr unsigned ROWB = 2048; static constexpr bool I8 = true;
    static constexpr bool PERM = true; static constexpr bool CD = true;
    const signed char* A; const signed char* Bt; unsigned char* act; const float* bgu; const int* list; const float* sa; const float* sw; MoeTab tab; int G, vcu;
    __device__ __forceinline__ bool next(int i, Unit& u) const { return tab.find_i(i, u); }
    __device__ __forceinline__ void a_offs(const Unit& u, const int (&R)[2], const int (&C2)[2], unsigned (&v)[2][2]) const {
#pragma unroll
        for (int h = 0; h < 2; ++h)
#pragma unroll
            for (int i = 0; i < 2; ++i) { int r = h * 128 + R[i]; r = r < u.cnt ? r : 0; const int a = list[(size_t)u.e * T_ + u.m0 + r]; v[h][i] = (unsigned)(a >> 2) * 2048u + (unsigned)C2[i]; } }
    __device__ __forceinline__ const char* a_base() const { return (const char*)A; }
    __device__ __forceinline__ const char* b_base(const Unit& u) const { return (const char*)(Bt + ((size_t)u.e * 4096 + u.n0) * 2048); }
    __device__ __forceinline__ void const_dma(const Unit& u, LAS unsigned char* lds, int wid, int lane) const {
        if (wid < 4) { cdma(lds, 0, wid, bgu + (size_t)u.e * 4096 + u.n0 + wid * 64 + lane); const int r = wid * 64 + lane; cdma(lds, 2, wid, sa + (size_t)u.e * T_ + u.m0 + (r < u.cnt ? r : 0)); }
        else cdma(lds, 1, wid - 4, sw + (size_t)u.e * 4096 + u.n0 + (wid - 4) * 64 + lane);
    }
    __device__ __forceinline__ void epi(const i32x4 (&acc)[2][2][4][2], const Unit& u, int wr, int wc, int fr, int fq, LAS unsigned char* lds) const {
        asm volatile("s_waitcnt vmcnt(16)" ::: "memory");
        ep_sync();
        const LAS float* cst = (const LAS float*)(lds + CONST_OFF);
        const int tg = ep_tid() & 255, rrow = tg >> 4, ch = tg & 15;
        f32x4 b0[2], b1[2], s0[2], s1[2];
#pragma unroll
        for (int bj = 0; bj < 2; ++bj) { const int col = bj * 128 + wc * 32 + fq * 8;
            b0[bj] = *(const LAS f32x4*)(cst + col); b1[bj] = *(const LAS f32x4*)(cst + col + 4); s0[bj] = *(const LAS f32x4*)(cst + 256 + col); s1[bj] = *(const LAS f32x4*)(cst + 256 + col + 4); }
        float srv[8];
#pragma unroll
        for (int q = 0; q < 8; ++q) srv[q] = cst[512 + (q >> 2) * 128 + wr * 64 + (q & 3) * 16 + fr];
        LAS unsigned char* ep2 = lds + EP_OFF + wr * (2 * 4608);
#define GU_WRITE(st) do { const int ai_ = (st) >> 1, mp_ = (st) & 1; LAS unsigned char* eb = ep2 + ((st) & 1) * 4608; \
            _Pragma("unroll") for (int mm = 0; mm < 2; ++mm) { const int m_ = mp_ * 2 + mm; const float sr = srv[ai_ * 4 + m_]; \
                _Pragma("unroll") for (int bj = 0; bj < 2; ++bj) { const i32x4 i0 = acc[ai_][bj][m_][0], i1 = acc[ai_][bj][m_][1]; \
                    const f32x4 v0 = (f32x4){(float)i0[0], (float)i0[1], (float)i0[2], (float)i0[3]} * (s0[bj] * sr) + b0[bj], v1 = (f32x4){(float)i1[0], (float)i1[1], (float)i1[2], (float)i1[3]} * (s1[bj] * sr) + b1[bj]; \
                    *(LAS unsigned*)(eb + (mm * 16 + fr) * 144 + (bj * 64 + wc * 16 + fq * 4)) = pk4_fp8(swiglu_fast(v0[0], v0[1]), swiglu_fast(v0[2], v0[3]), swiglu_fast(v1[0], v1[1]), swiglu_fast(v1[2], v1[3])); } } } while (0)
        GU_WRITE(0);
        ep_sync();
#pragma unroll
        for (int st = 0; st < 4; ++st) {
            if (st + 1 < 4) GU_WRITE(st + 1);
#pragma unroll
            for (int mm = 0; mm < 2; ++mm) { const u32x2 x0 = *(const LAS u32x2*)(ep2 + (st & 1) * 4608 + (mm * 16 + rrow) * 144 + ch * 8);
                const int rr = (st >> 1) * 128 + wr * 64 + ((st & 1) * 2 + mm) * 16 + rrow;
                if (rr < u.cnt) *(u32x2*)(act + (size_t)(u.rbase + u.m0 + rr) * 2048 + (u.n0 >> 1) + ch * 8) = x0; }
            ep_sync();
        }
#undef GU_WRITE
    }
};
struct ProbDn {
    static constexpr int NT = 16; static constexpr size_t KS2 = 256; static constexpr unsigned ROWB = 2048; static constexpr bool I8 = true;
    static constexpr bool PERM = true; static constexpr bool CD = true;
    const signed char* A; const signed char* Bt; unsigned char* y; const float* bdn; const int* list; const float* gate; const float* sa; const float* sw; MoeTab tab; int G, vcu;
    __device__ __forceinline__ bool next(int i, Unit& u) const { return tab.find_i(i, u); }
    __device__ __forceinline__ void a_offs(const Unit& u, const int (&R)[2], const int (&C2)[2], unsigned (&v)[2][2]) const {
#pragma unroll
        for (int h = 0; h < 2; ++h)
#pragma unroll
            for (int i = 0; i < 2; ++i) v[h][i] = (unsigned)(u.rbase + u.m0 + h * 128 + R[i]) * 2048u + (unsigned)C2[i]; }
    __device__ __forceinline__ const char* a_base() const { return (const char*)A; }
    __device__ __forceinline__ const char* b_base(const Unit& u) const { return (const char*)(Bt + ((size_t)u.e * 2048 + u.n0) * 2048); }
    __device__ __forceinline__ void const_dma(const Unit& u, LAS unsigned char* lds, int wid, int lane) const {
        const int i4 = wid & 3, r = i4 * 64 + lane, rc = r < u.cnt ? r : 0;
        if (wid < 4) { cdma(lds, 0, i4, bdn + (size_t)u.e * 2048 + u.n0 + r); cdma(lds, 2, i4, sa + u.rbase + u.m0 + rc); cdma(lds, 4, i4, list + (size_t)u.e * T_ + u.m0 + rc); }
        else { cdma(lds, 1, i4, sw + (size_t)u.e * 2048 + u.n0 + r); cdma(lds, 3, i4, gate + (size_t)u.e * T_ + u.m0 + rc); }
    }
    __device__ __forceinline__ void epi(const i32x4 (&acc)[2][2][4][2], const Unit& u, int wr, int wc, int fr, int fq, LAS unsigned char* lds) const {
        asm volatile("s_waitcnt vmcnt(16)" ::: "memory");
        ep_sync();
        const LAS float* cst = (const LAS float*)(lds + CONST_OFF);
        LAS unsigned char* ep = lds + EP_OFF + wr * (2 * 4352);
        const int tg = ep_tid() & 255, rrow = tg >> 4, ch = tg & 15;
        f32x4 b0[2], b1[2], s0[2], s1[2];
#pragma unroll
        for (int bj = 0; bj < 2; ++bj) { const int col = bj * 128 + wc * 32 + fq * 8;
            b0[bj] = *(const LAS f32x4*)(cst + col); b1[bj] = *(const LAS f32x4*)(cst + col + 4); s0[bj] = *(const LAS f32x4*)(cst + 256 + col); s1[bj] = *(const LAS f32x4*)(cst + 256 + col + 4); }
        float gv[8], srv[8]; int a2v[8];
#pragma unroll
        for (int q = 0; q < 8; ++q) { const int rl = (q >> 2) * 128 + wr * 64 + (q & 3) * 16 + fr; gv[q] = cst[768 + rl]; srv[q] = cst[512 + rl];
            a2v[q] = ((const LAS int*)cst)[1024 + (q >> 2) * 128 + wr * 64 + (q & 3) * 16 + rrow]; }
#define DN_WRITE(st) do { const int ai_ = (st) >> 2, m_ = (st) & 3; const float g = gv[st] * 16.f, sr = srv[st]; LAS unsigned char* eb = ep + ((st) & 1) * 4352; \
            _Pragma("unroll") for (int bj = 0; bj < 2; ++bj) { const i32x4 i0 = acc[ai_][bj][m_][0], i1 = acc[ai_][bj][m_][1]; \
                const f32x4 v0 = ((f32x4){(float)i0[0], (float)i0[1], (float)i0[2], (float)i0[3]} * (s0[bj] * sr) + b0[bj]) * g, v1 = ((f32x4){(float)i1[0], (float)i1[1], (float)i1[2], (float)i1[3]} * (s1[bj] * sr) + b1[bj]) * g; \
                u32x2 o; o[0] = pk4_fp8(__builtin_amdgcn_fmed3f(v0[0], -440.f, 440.f), __builtin_amdgcn_fmed3f(v0[1], -440.f, 440.f), __builtin_amdgcn_fmed3f(v0[2], -440.f, 440.f), __builtin_amdgcn_fmed3f(v0[3], -440.f, 440.f)); o[1] = pk4_fp8(__builtin_amdgcn_fmed3f(v1[0], -440.f, 440.f), __builtin_amdgcn_fmed3f(v1[1], -440.f, 440.f), __builtin_amdgcn_fmed3f(v1[2], -440.f, 440.f), __builtin_amdgcn_fmed3f(v1[3], -440.f, 440.f)); \
                *(LAS u32x2*)(eb + fr * 272 + (bj * 128 + wc * 32 + fq * 8)) = o; } } while (0)
        DN_WRITE(0);
        ep_sync();
#pragma unroll
        for (int st = 0; st < 8; ++st) {
            if (st + 1 < 8) DN_WRITE(st + 1);
            const int rr = (st >> 2) * 128 + wr * 64 + (st & 3) * 16 + rrow;
            const u32x4 x0 = *(const LAS u32x4*)(ep + (st & 1) * 4352 + rrow * 272 + ch * 16);
            if (rr < u.cnt) *(u32x4*)(y + (size_t)a2v[st] * 2048 + u.n0 + ch * 16) = x0;
            ep_sync();
        }
#undef DN_WRITE
    }
};
}

namespace at8 {
typedef float f32x16 __attribute__((ext_vector_type(16)));
typedef short s16x4 __attribute__((ext_vector_type(4)));
typedef unsigned u32x4 __attribute__((ext_vector_type(4)));
constexpr int SHM_K = 64 * 128 * 2, SHM_V = 64 * 128 * 2, SLOT = SHM_K + SHM_V;
constexpr int NSLOT = 4;
constexpr int LDS_WS = NSLOT * SLOT;
constexpr int LDS_END = LDS_WS + 8 * 64 * 4;
constexpr float CEXP = ATT_SCALE * 1.4426950408889634f;
constexpr float THR_RAW = 8.f / ATT_SCALE;
#define AT_KSWZ(row, colB) ((row) * 256 + ((colB) ^ (((row) & 7) << 4)))
#define AT_SBAR() __builtin_amdgcn_sched_barrier(0)
__device__ __forceinline__ int crow(int r, int hi) { return (r & 3) + 8 * (r >> 2) + 4 * hi; }
__device__ __forceinline__ unsigned cvtpk(float lo, float hi) { auto v = __builtin_amdgcn_cvt_pkrtz(lo, hi); return *reinterpret_cast<unsigned*>(&v); }
__device__ __forceinline__ int v_st(int k, int c) { const int kk = (k & ~0xC) | ((k & 4) << 1) | ((k & 8) >> 1); return ((kk >> 3) * 4 + (c >> 5)) * 512 + ((kk & 7) * 32 + (c & 31)) * 2; }
__device__ __forceinline__ int v_rd_base(int lane) { return ((lane & 3) << 3) | (((lane >> 2) & 3) << 6) | (((lane >> 4) & 1) << 5) | (((lane >> 5) & 1) << 8); }
constexpr int v_rd_off(int d0, int ks, int half) { return d0 * 512 + ks * 4096 + half * 2048; }
template <int OFF> __device__ __forceinline__ s16x4 tr_read(int vb) { s16x4 r; asm volatile("ds_read_b64_tr_b16 %0, %1 offset:%2" : "=&v"(r) : "v"(vb), "i"(OFF) : "memory"); return r; }
__device__ __forceinline__ h8 mk8(s16x4 l, s16x4 h) { typedef short s16x8 __attribute__((ext_vector_type(8))); s16x8 w = {l[0], l[1], l[2], l[3], h[0], h[1], h[2], h[3]}; return *reinterpret_cast<h8*>(&w); }
template <int D0> __device__ __forceinline__ void pv_one(f32x16& od, int vb, h8 pa0, h8 pa1, h8 pa2, h8 pa3) {
    const s16x4 l0 = tr_read<v_rd_off(D0, 0, 0)>(vb), h0 = tr_read<v_rd_off(D0, 0, 1)>(vb), l1 = tr_read<v_rd_off(D0, 1, 0)>(vb), h1 = tr_read<v_rd_off(D0, 1, 1)>(vb);
    const s16x4 l2 = tr_read<v_rd_off(D0, 2, 0)>(vb), h2 = tr_read<v_rd_off(D0, 2, 1)>(vb), l3 = tr_read<v_rd_off(D0, 3, 0)>(vb), h3 = tr_read<v_rd_off(D0, 3, 1)>(vb);
    asm volatile("s_waitcnt lgkmcnt(0)" ::: "memory"); AT_SBAR();
    od = __builtin_amdgcn_mfma_f32_32x32x16_f16(pa0, mk8(l0, h0), od, 0, 0, 0);
    od = __builtin_amdgcn_mfma_f32_32x32x16_f16(pa1, mk8(l1, h1), od, 0, 0, 0);
    od = __builtin_amdgcn_mfma_f32_32x32x16_f16(pa2, mk8(l2, h2), od, 0, 0, 0);
    od = __builtin_amdgcn_mfma_f32_32x32x16_f16(pa3, mk8(l3, h3), od, 0, 0, 0);
}
__device__ __forceinline__ void pv_d0(f32x16 (&o)[4], int vb, h8 pa0, h8 pa1, h8 pa2, h8 pa3) {
    pv_one<0>(o[0], vb, pa0, pa1, pa2, pa3); pv_one<1>(o[1], vb, pa0, pa1, pa2, pa3); pv_one<2>(o[2], vb, pa0, pa1, pa2, pa3); pv_one<3>(o[3], vb, pa0, pa1, pa2, pa3);
}
__device__ __forceinline__ void qkt(f32x16& p0, f32x16& p1, const char* Ks, const h8 (&qr)[8], int r32, int hi) {
    p0 = f32x16{}; p1 = f32x16{};
#pragma unroll
    for (int d0 = 0; d0 < 8; ++d0) { const int cb = (d0 * 16 + hi * 8) * 2;
        const h8 b0 = *reinterpret_cast<const h8*>(Ks + AT_KSWZ(r32, cb));
        const h8 b1 = *reinterpret_cast<const h8*>(Ks + AT_KSWZ(32 + r32, cb));
        p0 = __builtin_amdgcn_mfma_f32_32x32x16_f16(b0, qr[d0], p0, 0, 0, 0);
        p1 = __builtin_amdgcn_mfma_f32_32x32x16_f16(b1, qr[d0], p1, 0, 0, 0); }
}
__device__ __forceinline__ void pack_p(const f32x16& p0, const f32x16& p1, h8& pa0, h8& pa1, h8& pa2, h8& pa3) {
#define AT_PK4(P, BASE, OUT) do { unsigned a0 = cvtpk(P[BASE + 0], P[BASE + 1]), a1 = cvtpk(P[BASE + 2], P[BASE + 3]); \
    unsigned b0 = cvtpk(P[BASE + 4], P[BASE + 5]), b1 = cvtpk(P[BASE + 6], P[BASE + 7]); \
    auto r0 = __builtin_amdgcn_permlane32_swap(a0, b0, false, false); auto r1 = __builtin_amdgcn_permlane32_swap(a1, b1, false, false); \
    u32x4 w = {r0[0], r1[0], r0[1], r1[1]}; OUT = *reinterpret_cast<h8*>(&w); } while (0)
    AT_PK4(p0, 0, pa0); AT_PK4(p0, 8, pa1); AT_PK4(p1, 0, pa2); AT_PK4(p1, 8, pa3);
#undef AT_PK4
}
__device__ __forceinline__ float half_swap_max(float v) { auto rr = __builtin_amdgcn_permlane32_swap(__float_as_uint(v), __float_as_uint(v), false, false); return fmaxf(__uint_as_float(rr[0]), __uint_as_float(rr[1])); }
__device__ __forceinline__ float half_swap_sum(float v) { auto rr = __builtin_amdgcn_permlane32_swap(__float_as_uint(v), __float_as_uint(v), false, false); return __uint_as_float(rr[0]) + __uint_as_float(rr[1]); }

__device__ __forceinline__ int hidden_tid() { int tz = threadIdx.x; asm volatile("" : "+v"(tz)); return tz; }
__device__ __forceinline__ void dma_offsets(int ld, int (&ko)[2], int (&vo)[2]) {
    const int tz = hidden_tid(), w = tz >> 6, l = tz & 63;
#pragma unroll
    for (int q = 0; q < 2; ++q) {
        const int rr = 4 * (2 * w + q) + (l >> 4), pp = l & 15;
        ko[q] = rr * ld + ((pp ^ (rr & 7)) * 8);
        const int L = (2 * w + q) * 1024 + l * 16, sidx = L >> 9, o = L & 511;
        const int kk = (sidx >> 2) * 8 + (o >> 6), c = (sidx & 3) * 32 + ((o & 63) >> 1);
        const int k = (kk & ~0xC) | ((kk & 4) << 1) | ((kk & 8) >> 1);
        vo[q] = k * ld + c;
    }
}
__device__ __forceinline__ void dma_tile(char* slot, const _Float16* Kb, const _Float16* Vb, int ld, int tile, const int (&ko)[2], const int (&vo)[2], int wid) {
    const _Float16* kt = Kb + (size_t)tile * 64 * ld; const _Float16* vt = Vb + (size_t)tile * 64 * ld;
#pragma unroll
    for (int q = 0; q < 2; ++q) __builtin_amdgcn_global_load_lds((const unsigned*)(kt + ko[q]), (LAS unsigned*)(slot + (2 * wid + q) * 1024), 16, 0, 0);
#pragma unroll
    for (int q = 0; q < 2; ++q) __builtin_amdgcn_global_load_lds((const unsigned*)(vt + vo[q]), (LAS unsigned*)(slot + SHM_K + (2 * wid + q) * 1024), 16, 0, 0);
}
#define AT_WAITV(n) asm volatile("s_waitcnt vmcnt(" #n ")" ::: "memory")
#define AT_BAR() do { asm volatile("s_waitcnt lgkmcnt(0)" ::: "memory"); __builtin_amdgcn_s_barrier(); asm volatile("" ::: "memory"); } while (0)

__device__ __forceinline__ void attn_unit(char* lds, const _Float16* qrow, const _Float16* Kb, const _Float16* Vb, int ld, unsigned tmask, int wlen, int khi, unsigned selmask,
                                          _Float16* outw, int ostride) {
    const int tid = threadIdx.x, wid = __builtin_amdgcn_readfirstlane(tid >> 6), lane = tid & 63, r32 = lane & 31, hi = lane >> 5;
    float* wsf = (float*)(lds + LDS_WS) + wid * 64; float* li_l = wsf; float* al_l = wsf + 32;
    float m_reg = -1e30f, l_reg = 0.f; f32x16 o[4] = {}; h8 qr[8];
#pragma unroll
    for (int d0 = 0; d0 < 8; ++d0) qr[d0] = *(const h8*)(qrow + d0 * 16);
    int ko[2], vo[2]; dma_offsets(ld, ko, vo);
    const int vbase = (int)(uintptr_t)lds + SHM_K + v_rd_base(lane);
    unsigned rest = tmask; int j = __ffs(rest) - 1; rest &= rest - 1;
    int j1 = rest ? (__ffs(rest) - 1) : -1; if (j1 >= 0) rest &= rest - 1;
    dma_tile(lds, Kb, Vb, ld, j, ko, vo, wid);
    if (j1 >= 0) { dma_tile(lds + SLOT, Kb, Vb, ld, j1, ko, vo, wid); AT_WAITV(4); } else { AT_WAITV(0); }
    AT_BAR();
    int so = 0, sp = 0;
    const bool roleB = wid >= 4;
    bool first = true;
    h8 pa0, pa1, pa2, pa3;
    for (;;) {
        const int j2 = rest ? (__ffs(rest) - 1) : -1;
        if (j2 >= 0) { rest &= rest - 1; int s2 = so + 2 * SLOT; s2 = s2 >= NSLOT * SLOT ? s2 - NSLOT * SLOT : s2; dma_tile(lds + s2, Kb, Vb, ld, j2, ko, vo, wid); }
        if (roleB && !first) { AT_SBAR(); pv_d0(o, vbase + sp, pa0, pa1, pa2, pa3); }
        f32x16 p0, p1;
        AT_SBAR(); qkt(p0, p1, lds + so, qr, r32, hi);
        { const int klo = wlen > 0 ? khi - wlen + 1 : 0; const bool tb = (selmask >> j) & 1u; const bool inr = (j * 64 >= klo) && (j * 64 + 63 <= khi);
          if (!__all(tb && inr)) {
              if (__all(inr)) {
#pragma unroll
                  for (int r = 0; r < 16; ++r) { p0[r] = tb ? p0[r] : -INFINITY; p1[r] = tb ? p1[r] : -INFINITY; }
              } else {
                  const int kb = j * 64 + 4 * hi;
#pragma unroll
                  for (int r = 0; r < 16; ++r) { const int k0 = kb + (r & 3) + 8 * (r >> 2);
                      p0[r] = (tb && k0 >= klo && k0 <= khi) ? p0[r] : -INFINITY;
                      p1[r] = (tb && (k0 + 32) >= klo && (k0 + 32) <= khi) ? p1[r] : -INFINITY; }
              } } }
        float pmax = p0[0];
#pragma unroll
        for (int r = 1; r < 16; ++r) pmax = fmaxf(pmax, p0[r]);
#pragma unroll
        for (int r = 0; r < 16; ++r) pmax = fmaxf(pmax, p1[r]);
        pmax = half_swap_max(pmax);
        float mn, alpha;
        if (__all(pmax - m_reg <= THR_RAW)) { mn = m_reg; alpha = 1.f; }
        else { mn = fmaxf(m_reg, pmax); alpha = __builtin_amdgcn_exp2f((m_reg - mn) * CEXP); m_reg = mn; }
        const float mnC = -mn * CEXP;
        float ps = 0.f;
#pragma unroll
        for (int r = 0; r < 16; ++r) { p0[r] = __builtin_amdgcn_exp2f(fmaf(p0[r], CEXP, mnC)); ps += p0[r]; }
#pragma unroll
        for (int r = 0; r < 16; ++r) { p1[r] = __builtin_amdgcn_exp2f(fmaf(p1[r], CEXP, mnC)); ps += p1[r]; }
        ps = half_swap_sum(ps);
        l_reg = l_reg * alpha + ps;
        if (__any(alpha < 1.f)) { if (hi == 0) al_l[r32] = alpha; asm volatile("s_waitcnt lgkmcnt(0)" ::: "memory");
#pragma unroll
            for (int r = 0; r < 16; ++r) { const float a = al_l[crow(r, hi)];
#pragma unroll
                for (int d = 0; d < 4; ++d) o[d][r] *= a; } }
        pack_p(p0, p1, pa0, pa1, pa2, pa3);
        AT_SBAR();
        if (!roleB) pv_d0(o, vbase + so, pa0, pa1, pa2, pa3);
        if (j1 < 0) break;
        if (j2 >= 0) { AT_WAITV(4); } else { AT_WAITV(0); }
        AT_BAR();
        j = j1; j1 = j2; sp = so; so += SLOT; so = so >= NSLOT * SLOT ? so - NSLOT * SLOT : so; first = false;
    }
    if (roleB) { AT_SBAR(); pv_d0(o, vbase + so, pa0, pa1, pa2, pa3); }
    if (hi == 0) li_l[r32] = l_reg; asm volatile("s_waitcnt lgkmcnt(0)" ::: "memory");
#pragma unroll
    for (int r = 0; r < 16; ++r) { const int orow = crow(r, hi); const float l = li_l[orow]; const float rl = l > 0.f ? 1.f / l : 0.f;
#pragma unroll
        for (int d0 = 0; d0 < 4; ++d0) outw[(size_t)orow * ostride + d0 * 32 + r32] = (_Float16)(o[d0][r] * rl); }
    __syncthreads();
}

constexpr int LDS_AP = 0, LDS_BP = LDS_AP + 4 * 64 * 33 * 4, LDS_SELM = LDS_END, LDS_CS_END = LDS_SELM + 64 * 4;
static_assert(LDS_BP + 4 * 64 * 33 * 4 <= NSLOT * SLOT, "importance partials must fit inside the ring");
__device__ __forceinline__ void cmp_slc_unit(char* lds, const _Float16* qrow, const _Float16* Kc, const _Float16* Vc, const _Float16* Ks, const _Float16* Vs, int t, int tl, int g, int qi,
                                             _Float16* outc, _Float16* outs) {
    const int tid = threadIdx.x, wid = __builtin_amdgcn_readfirstlane(tid >> 6), lane = tid & 63, r32 = lane & 31, hi = lane >> 5;
    float* AP = (float*)(lds + LDS_AP); float* BP = (float*)(lds + LDS_BP); unsigned* selm = (unsigned*)(lds + LDS_SELM);
    {
        h8 qr[8];
#pragma unroll
        for (int d0 = 0; d0 < 8; ++d0) qr[d0] = *(const h8*)(qrow + d0 * 16);
        const int vb0 = (int)(uintptr_t)lds + SHM_K + v_rd_base(lane);
        { int ko[2], vo[2]; dma_offsets(256, ko, vo);
          dma_tile(lds, Kc, Vc, 256, 0, ko, vo, wid); dma_tile(lds + SLOT, Kc, Vc, 256, 1, ko, vo, wid); }
        AT_WAITV(0); AT_BAR();
        f32x16 pA0, pA1, pB0, pB1;
        AT_SBAR(); qkt(pA0, pA1, lds, qr, r32, hi); qkt(pB0, pB1, lds + SLOT, qr, r32, hi);
        const int khi = t >= 31 ? ((t - 31) >> 4) : -1;
#pragma unroll
        for (int r = 0; r < 16; ++r) { const int c0 = 4 * hi + (r & 3) + 8 * (r >> 2);
            pA0[r] = (c0 <= khi) ? pA0[r] : -INFINITY; pA1[r] = (c0 + 32 <= khi) ? pA1[r] : -INFINITY;
            pB0[r] = (c0 + 64 <= khi) ? pB0[r] : -INFINITY; pB1[r] = (c0 + 96 <= khi) ? pB1[r] : -INFINITY; }
        float pmax = -INFINITY;
#pragma unroll
        for (int r = 0; r < 16; ++r) pmax = fmaxf(fmaxf(pmax, pA0[r]), fmaxf(pA1[r], fmaxf(pB0[r], pB1[r])));
        pmax = half_swap_max(pmax);
        const float mC = (pmax == -INFINITY) ? 0.f : -pmax * CEXP;
        float ps = 0.f;
#pragma unroll
        for (int r = 0; r < 16; ++r) { pA0[r] = __builtin_amdgcn_exp2f(fmaf(pA0[r], CEXP, mC)); pA1[r] = __builtin_amdgcn_exp2f(fmaf(pA1[r], CEXP, mC));
            pB0[r] = __builtin_amdgcn_exp2f(fmaf(pB0[r], CEXP, mC)); pB1[r] = __builtin_amdgcn_exp2f(fmaf(pB1[r], CEXP, mC)); ps += (pA0[r] + pA1[r]) + (pB0[r] + pB1[r]); }
        ps = half_swap_sum(ps);
        const float inv = ps > 0.f ? 1.f / ps : 0.f;
#pragma unroll
        for (int r = 0; r < 16; ++r) { pA0[r] *= inv; pA1[r] *= inv; pB0[r] *= inv; pB1[r] *= inv; }
        f32x16 o[4] = {};
        h8 pa0, pa1, pa2, pa3;
        pack_p(pA0, pA1, pa0, pa1, pa2, pa3); AT_SBAR(); pv_d0(o, vb0, pa0, pa1, pa2, pa3);
        pack_p(pB0, pB1, pa0, pa1, pa2, pa3); AT_SBAR(); pv_d0(o, vb0 + SLOT, pa0, pa1, pa2, pa3);
#pragma unroll
        for (int r = 0; r < 16; ++r) { const int orow = crow(r, hi);
#pragma unroll
            for (int d0 = 0; d0 < 4; ++d0) outc[(size_t)orow * 1024 + d0 * 32 + r32] = (_Float16)o[d0][r]; }
        __syncthreads();
        { float* ap = AP + (g * 64 + tl) * 33; float* bp = BP + (g * 64 + tl) * 33;
          if (hi == 0) bp[0] = 0.f;
#define AT_IMP(P, JB) do { _Pragma("unroll") for (int k = 0; k < 4; ++k) { const int j = (JB) + 2 * k + hi; \
              ap[j] = 2.f * (P[4 * k] + P[4 * k + 1] + P[4 * k + 2]) + P[4 * k + 3]; if (j + 1 < 32) bp[j + 1] = P[4 * k + 3]; } } while (0)
          AT_IMP(pA0, 0); AT_IMP(pA1, 8); AT_IMP(pB0, 16); AT_IMP(pB1, 24);
#undef AT_IMP
        }
    }
    __syncthreads();
#pragma unroll 1
    for (int it = 0; it < 4; ++it) {
        const int tk = 8 * wid + 2 * it + hi, j = r32;
        float imp = 0.f;
#pragma unroll
        for (int gg = 0; gg < 4; ++gg) imp += AP[(gg * 64 + tk) * 33 + j] + BP[(gg * 64 + tk) * 33 + j];
        const bool forced = (j == 0) || (j == qi) || (j == qi - 1), valid = j <= qi;
        const float iv = forced ? 1e9f : (valid ? imp : -1e9f);
        int rank = 0;
        for (int i = 0; i < 32; ++i) { const float vi = __shfl(iv, i + 32 * hi); rank += (vi > iv || (vi == iv && i < j)) ? 1 : 0; }
        const unsigned long long bal = __ballot(rank < 16 && valid);
        if (r32 == 0) selm[tk] = (unsigned)(bal >> (32 * hi));
    }
    __syncthreads();
    unsigned tm = selm[lane];
#pragma unroll
    for (int o = 32; o > 0; o >>= 1) tm |= __shfl_xor(tm, o);
    const int tz2 = hidden_tid();
    const unsigned mysel = selm[((tz2 >> 6) & 1) * 32 + (tz2 & 31)];
    attn_unit(lds, qrow, Ks, Vs, 128, tm, 0, t, mysel, outs, 1024);
}
}

struct CUnit { const float* W; int ldw; int nvalid; _Float16* Wt; int k0; int n0; };
__device__ __forceinline__ CUnit conv_desc(int u, const float* win, const float* w1k, const float* w1v, const float* wmkv, _Float16* wtin, _Float16* wt1, _Float16* wtmkv) {
    CUnit d;
    if (u < 160) { d.W = win; d.ldw = INW; d.nvalid = INW; d.Wt = wtin; d.k0 = (u / 5) * 64; d.n0 = (u % 5) * 256; }
    else if (u < 288) { const int v = u - 160, kv = v >> 6, part = (v >> 5) & 1, kt = v & 31;
        d.W = (kv ? w1v : w1k) + (size_t)part * 2048 * 256; d.ldw = 256; d.nvalid = 256; d.Wt = wt1 + ((size_t)kv * 512 + part * 256) * 2048; d.k0 = kt * 64; d.n0 = 0; }
    else { d.W = wmkv; d.ldw = 1024; d.nvalid = 1024; d.Wt = wtmkv; d.k0 = 0; d.n0 = 0; }
    return d;
}
__device__ __forceinline__ void conv_all(float* lds, const float* win, const float* w1k, const float* w1v, const float* wmkv, _Float16* wtin, _Float16* wt1, _Float16* wtmkv, int bid, int nb) {
    constexpr int NU = 160 + 128;
    const int tid = threadIdx.x;
    int u = bid; if (u >= NU) return;
    CUnit d = conv_desc(u, win, w1k, w1v, wmkv, wtin, wt1, wtmkv);
    float4 v[8];
#define CL(D) do { _Pragma("unroll") for (int i = 0; i < 8; ++i) { const int idx = tid + 512 * i, r = idx >> 6, c4 = (idx & 63) * 4; \
        v[i] = ((D).n0 + c4 < (D).nvalid) ? *(const float4*)((D).W + (size_t)((D).k0 + r) * (D).ldw + (D).n0 + c4) : make_float4(0.f, 0.f, 0.f, 0.f); } } while (0)
    CL(d);
    for (;;) {
#pragma unroll
        for (int i = 0; i < 8; ++i) { const int idx = tid + 512 * i, r = idx >> 6, c4 = (idx & 63) * 4; float* dd = lds + r * 257 + c4; dd[0] = v[i].x; dd[1] = v[i].y; dd[2] = v[i].z; dd[3] = v[i].w; }
        __syncthreads();
        const int un = u + nb; const bool has = un < NU;
        CUnit dn = d; if (has) { dn = conv_desc(un, win, w1k, w1v, wmkv, wtin, wt1, wtmkv); CL(dn); }
#pragma unroll
        for (int j = 0; j < 4; ++j) { const int id = tid + 512 * j, n = id >> 3, k8 = (id & 7) * 8; h8 o;
#pragma unroll
            for (int q = 0; q < 8; ++q) o[q] = (_Float16)lds[(k8 + q) * 257 + n];
            *(h8*)(d.Wt + (size_t)(d.n0 + n) * 2048 + d.k0 + k8) = o; }
        __syncthreads();
        if (!has) break;
        u = un; d = dn;
    }
#undef CL
}

__device__ __forceinline__ unsigned pack4_i8(float a, float b, float c, float d) {
    const int ia = __float2int_rn(a), ib = __float2int_rn(b), ic = __float2int_rn(c), id = __float2int_rn(d);
    return (unsigned)(ia & 255) | ((unsigned)(ib & 255) << 8) | ((unsigned)(ic & 255) << 16) | ((unsigned)(id & 255) << 24);
}
constexpr int QP_LD2 = 1026;
struct QUnit { const float* W; int ldw; int n0; signed char* Q; float* sc; int nvalid; };
struct QExtra { const float* win; signed char* q8in; float* sin8; const float* wmkv; signed char* q8mkv; float* smkv; };
__device__ __forceinline__ QUnit quant_desc(int u, const float* wgu, const float* wdn, signed char* q8gu, signed char* q8dn, float* sgu, float* sdn, const float* wout, signed char* q8out, float* sout, const QExtra& x) {
    QUnit d; d.nvalid = 1 << 30;
    if (u >= NE * 192 + 64 + 73) { const int pn = u - (NE * 192 + 64 + 73); d.W = x.wmkv; d.ldw = 1024; d.n0 = pn * 32; d.Q = x.q8mkv; d.sc = x.smkv; }
    else if (u >= NE * 192 + 64) { const int pn = u - (NE * 192 + 64); d.W = x.win; d.ldw = INW; d.n0 = 1280 + pn * 32; d.Q = x.q8in - (size_t)1280 * 2048; d.sc = x.sin8 - 1280; d.nvalid = INW; }
    else if (u >= NE * 192) { const int pn = u - NE * 192; d.W = wout; d.ldw = 2048; d.n0 = pn * 32; d.Q = q8out; d.sc = sout; }
    else if (u < NE * 128) { const int e = u >> 7, pn = u & 127; d.W = wgu + (size_t)e * 2048 * 4096; d.ldw = 4096; d.n0 = pn * 32; d.Q = q8gu + (size_t)e * 4096 * 2048; d.sc = sgu + (size_t)e * 4096; }
    else { const int v = u - NE * 128, e = v >> 6, pn = v & 63; d.W = wdn + (size_t)e * 2048 * 2048; d.ldw = 2048; d.n0 = pn * 32; d.Q = q8dn + (size_t)e * 2048 * 2048; d.sc = sdn + (size_t)e * 2048; }
    return d;
}
__device__ __forceinline__ unsigned pk2h(float a, float b) { auto v = __builtin_amdgcn_cvt_pkrtz(a, b); return *reinterpret_cast<unsigned*>(&v); }
template <bool DYN>
__device__ __forceinline__ void quant_units(char* smem, const float* wgu, const float* wdn, signed char* q8gu, signed char* q8dn, float* sgu, float* sdn, const float* wout, signed char* q8out, float* sout, const QExtra& qx,
                                            int ubase, int nun, unsigned* ctr, int maxu, int bid, int nb) {
    typedef _Float16 h2v __attribute__((ext_vector_type(2)));
    typedef unsigned qu4 __attribute__((ext_vector_type(4)));
    unsigned* cmaxb = (unsigned*)(smem + g8::EP_OFF);
    volatile LAS int* slot = (volatile LAS int*)(smem + g8::EP_OFF + 256);
    int tid = threadIdx.x; asm volatile("" : "+v"(tid));
    const int c4 = (tid & 7) * 4, rg = tid >> 3;
    if (tid < 64) cmaxb[tid] = 0u;
    if (DYN) { if (tid == 0) slot[0] = maxu > 0 ? (int)__hip_atomic_fetch_add(ctr, 1u, __ATOMIC_RELAXED, __HIP_MEMORY_SCOPE_AGENT) : 0x7fffffff; }
    __syncthreads();
    int u = DYN ? slot[0] : bid;
    if (u >= nun) { __syncthreads(); return; }
    int taken = 1;
    QUnit d = quant_desc(ubase + u, wgu, wdn, q8gu, q8dn, sgu, sdn, wout, q8out, sout, qx);
    float4 L[32];
    char* hb = smem + tid * 16;
#define QLD(D, en) do { const char* p0 = (const char*)((D).W + (D).n0); const int cc = ((D).n0 + c4 < (D).nvalid) ? c4 : 0;     \
        const unsigned vo = (unsigned)(rg * 16 * (D).ldw + cc) * 4u, ldb = (unsigned)(D).ldw * 4u; \
        if (en) { _Pragma("unroll") for (int j = 0; j < 16; ++j) { L[j] = *(const float4*)(p0 + (size_t)(j * ldb) + vo); L[16 + j] = *(const float4*)(p0 + (size_t)((1024 + j) * ldb) + vo); } } \
        else { _Pragma("unroll") for (int j = 0; j < 32; ++j) L[j] = make_float4(0.f, 0.f, 0.f, 0.f); } } while (0)
#define QPK(a, b) ({ h2v t_; t_[0] = (_Float16)(a); t_[1] = (_Float16)(b); __builtin_bit_cast(unsigned, t_); })
#define QW(comp, ci) do { _Pragma("unroll") for (int hq = 0; hq < 4; ++hq) { uint4 w_; w_.x = QPK(L[hq * 8 + 0].comp, L[hq * 8 + 1].comp); w_.y = QPK(L[hq * 8 + 2].comp, L[hq * 8 + 3].comp); \
        w_.z = QPK(L[hq * 8 + 4].comp, L[hq * 8 + 5].comp); w_.w = QPK(L[hq * 8 + 6].comp, L[hq * 8 + 7].comp); *(uint4*)(hb + ((ci) * 4 + hq) * 8192) = w_; } } while (0)
#define QINV(x) ({ const float iv_ = (x) > 0.f ? fminf(127.f / (x), 65504.f) : 0.f; __builtin_bit_cast(unsigned, __builtin_amdgcn_cvt_pkrtz(iv_, iv_)); })
#define QF(w, iv) __builtin_bit_cast(unsigned, __builtin_elementwise_fma(__builtin_bit_cast(h2v, (unsigned)(w)), __builtin_bit_cast(h2v, (unsigned)(iv)), __builtin_bit_cast(h2v, 0x66006600u)))
#define QS(ci, half, iv) do { const uint4 w0 = *(const uint4*)(hb + ((ci) * 4 + (half) * 2) * 8192), w1 = *(const uint4*)(hb + ((ci) * 4 + (half) * 2 + 1) * 8192); uint4 o; \
        o.x = __builtin_amdgcn_perm(QF(w0.y, iv), QF(w0.x, iv), 0x06040200u); o.y = __builtin_amdgcn_perm(QF(w0.w, iv), QF(w0.z, iv), 0x06040200u); \
        o.z = __builtin_amdgcn_perm(QF(w1.y, iv), QF(w1.x, iv), 0x06040200u); o.w = __builtin_amdgcn_perm(QF(w1.w, iv), QF(w1.z, iv), 0x06040200u); \
        *(__attribute__((address_space(1))) qu4*)(d.Q + (size_t)(d.n0 + c4 + (ci)) * 2048 + (half) * 1024 + rg * 16) = (qu4){o.x, o.y, o.z, o.w}; } while (0)
    QLD(d, true);
    int par = 0;
    for (;;) {
        unsigned* cmax = cmaxb + par * 32;
        float m0 = 0.f, m1 = 0.f, m2 = 0.f, m3 = 0.f;
        if (DYN) { if (tid == 0) slot[par ^ 1] = taken < maxu ? (int)__hip_atomic_fetch_add(ctr, 1u, __ATOMIC_RELAXED, __HIP_MEMORY_SCOPE_AGENT) : 0x7fffffff; }
#pragma unroll
        for (int i = 0; i < 32; ++i) { m0 = fmaxf(m0, fabsf(L[i].x)); m1 = fmaxf(m1, fabsf(L[i].y)); m2 = fmaxf(m2, fabsf(L[i].z)); m3 = fmaxf(m3, fabsf(L[i].w)); }
        QW(x, 0); QW(y, 1); QW(z, 2); QW(w, 3);
        atomicMax(&cmax[c4 + 0], __float_as_uint(m0)); atomicMax(&cmax[c4 + 1], __float_as_uint(m1)); atomicMax(&cmax[c4 + 2], __float_as_uint(m2)); atomicMax(&cmax[c4 + 3], __float_as_uint(m3));
        __syncthreads();
        const int un = DYN ? slot[par ^ 1] : u + nb; const bool has = un < nun;
        QUnit dn = d; if (has) dn = quant_desc(ubase + un, wgu, wdn, q8gu, q8dn, sgu, sdn, wout, q8out, sout, qx);
        QLD(dn, has);
        if (tid < 32) cmaxb[(par ^ 1) * 32 + tid] = 0u;
        const float x0 = __uint_as_float(cmax[c4 + 0]), x1 = __uint_as_float(cmax[c4 + 1]), x2 = __uint_as_float(cmax[c4 + 2]), x3 = __uint_as_float(cmax[c4 + 3]);
        const unsigned i0 = QINV(x0), i1 = QINV(x1), i2 = QINV(x2), i3 = QINV(x3);
        QS(0, 0, i0); QS(1, 0, i1); QS(2, 0, i2); QS(3, 0, i3);
        QS(0, 1, i0); QS(1, 1, i1); QS(2, 1, i2); QS(3, 1, i3);
        if (tid < 32) { const float mx = __uint_as_float(cmax[tid]); const unsigned ih = QINV(mx); d.sc[d.n0 + tid] = mx > 0.f ? 1.f / (float)(__builtin_bit_cast(h2v, ih)[0]) : 1.f; }
        if (!has) break;
        u = un; d = dn; par ^= 1; ++taken;
        __syncthreads();
    }
    __syncthreads();
#undef QLD
#undef QPK
#undef QW
#undef QINV
#undef QF
#undef QS
}
__host__ __device__ constexpr int q_cnt(int k) { return k == 1 ? 1536 : k == 2 ? 768 : k == 3 ? 512 : k == 4 ? 512 : k == 5 ? 256 : k == 6 ? 256 : k == 7 ? 256 : k == 8 ? 2048 : 0; }
__host__ __device__ constexpr int q_beg(int k) { int s = 0; for (int i = 0; i < k; ++i) s += q_cnt(i); return s; }
static_assert(q_beg(8) == NE * 128 && q_beg(10) == NE * 192, "quota tables");
constexpr size_t CTL_QCTR = 20480;

__device__ __forceinline__ const float* karg_in(int i) {
    const __attribute__((address_space(4))) char* ka = (const __attribute__((address_space(4))) char*)__builtin_amdgcn_kernarg_segment_ptr();
    asm volatile("" : "+s"(ka));
    return *(const float* const __attribute__((address_space(4)))*)(ka + 8 * i);
}
#define DEFPTRS unsigned char* wsl_ = p.ws; asm volatile("" : "+s"(wsl_)); unsigned char* ws = wsl_; (void)ws; unsigned* ctl = (unsigned*)(wsl_ + WS_CTL); int* cnt = (int*)(wsl_ + CTL_CNT); float* proj = (float*)(wsl_ + WS_PROJ); float* kvmem = (float*)(wsl_ + WS_KVMEM); float* bias1 = (float*)(wsl_ + WS_BIAS1); float* hid = (float*)(wsl_ + WS_HID); float* kc = (float*)(wsl_ + WS_KC); float* vc = (float*)(wsl_ + WS_VC); float* pooled = (float*)(wsl_ + WS_POOLED); _Float16* opool = (_Float16*)(wsl_ + WS_OPOOL); _Float16* owin = (_Float16*)(wsl_ + WS_OWIN); _Float16* ocmp = (_Float16*)(wsl_ + WS_OCMP); _Float16* oslc = (_Float16*)(wsl_ + WS_OSLC); unsigned* sel = (unsigned*)(wsl_ + WS_SEL); _Float16* omem = (_Float16*)(wsl_ + WS_OMEM); _Float16* cat16 = (_Float16*)(wsl_ + WS_CAT16); _Float16* hpre16 = (_Float16*)(wsl_ + WS_HPRE); float* hbuf = (float*)(wsl_ + WS_H); float* gate = (float*)(wsl_ + WS_GATE); int* list = (int*)(wsl_ + WS_LIST); unsigned char* actf8 = (unsigned char*)(wsl_ + WS_ACT16); unsigned char* yf8 = (unsigned char*)(wsl_ + WS_Y16); _Float16* h16 = (_Float16*)(wsl_ + WS_H16); _Float16* x16 = (_Float16*)(wsl_ + WS_X16); _Float16* wtin = (_Float16*)(wsl_ + WS_WTIN); _Float16* wtout = (_Float16*)(wsl_ + WS_WTOUT); _Float16* wtgu = (_Float16*)(wsl_ + WS_WTGU); _Float16* wtdn = (_Float16*)(wsl_ + WS_WTDN); _Float16* proj16 = (_Float16*)(wsl_ + WS_PROJ16); _Float16* kvmem16 = (_Float16*)(wsl_ + WS_KVMEM16); _Float16* wt1 = (_Float16*)(wsl_ + WS_WT1); float* uv = (float*)(wsl_ + WS_UV); _Float16* kc16 = (_Float16*)(wsl_ + WS_KC16); _Float16* vc16 = (_Float16*)(wsl_ + WS_VC16); _Float16* wr16 = (_Float16*)(wsl_ + WS_WR16); _Float16* mem16 = (_Float16*)(wsl_ + WS_MEM16); _Float16* wtmkv = (_Float16*)(wsl_ + WS_WTMKV); _Float16* kv16 = (_Float16*)(wsl_ + WS_KV16); _Float16* wt2 = (_Float16*)(wsl_ + WS_WT2); float* sa2 = (float*)(wsl_ + WS_SA2); float* gate2 = (float*)(wsl_ + WS_GATE2); signed char* x8 = (signed char*)(wsl_ + WS_X8); float* sxa = (float*)(wsl_ + WS_SXA); signed char* q8in = (signed char*)(wsl_ + WS_Q8IN); float* sin8 = (float*)(wsl_ + WS_SIN8); signed char* q8mkv = (signed char*)(wsl_ + WS_Q8MKV); float* smkv = (float*)(wsl_ + WS_SMKV); signed char* q8out = (signed char*)(wsl_ + WS_Q8OUT); float* sout = (float*)(wsl_ + WS_SOUT); signed char* cat8 = (signed char*)(wsl_ + WS_CAT8); float* scat = (float*)(wsl_ + WS_SCAT); signed char* q8gu = (signed char*)(wsl_ + WS_Q8GU); signed char* q8dn = (signed char*)(wsl_ + WS_Q8DN); float* sgu = (float*)(wsl_ + WS_SGU); float* sdn = (float*)(wsl_ + WS_SDN); signed char* h8q = (signed char*)(wsl_ + WS_H8); float* sah = (float*)(wsl_ + WS_SAH); signed char* act8 = (signed char*)(wsl_ + WS_ACT8); float* sact = (float*)(wsl_ + WS_SACT);
__global__ void __launch_bounds__(512, 2) fwd(Params p) {
    extern __shared__ __attribute__((aligned(16))) char smem[];
    int tidk_ = threadIdx.x; asm volatile("" : "+v"(tidk_));
    const int tid = tidk_, wv = __builtin_amdgcn_readfirstlane(tid >> 6);
#define LANE_NOW ({ int _t = threadIdx.x; asm volatile("" : "+v"(_t)); _t & 63; })
    const int bid = blockIdx.x, nb = gridDim.x;
    const int gw = bid * 8 + wv, nw = nb * 8;
    const int lo = (int)(p.lo_hi & 0xffffffffll), hi = (int)(p.lo_hi >> 32);
    unsigned char* ws = p.ws;
    unsigned* ctl = (unsigned*)(ws + WS_CTL);
    int* cnt = (int*)(ws + CTL_CNT);
    float* proj = (float*)(ws + WS_PROJ);
    float* kvmem = (float*)(ws + WS_KVMEM);
    float* bias1 = (float*)(ws + WS_BIAS1);
    float* hid = (float*)(ws + WS_HID);
    float* kc = (float*)(ws + WS_KC);
    float* vc = (float*)(ws + WS_VC);
    float* pooled = (float*)(ws + WS_POOLED);
    _Float16* opool = (_Float16*)(ws + WS_OPOOL);
    _Float16* owin = (_Float16*)(ws + WS_OWIN);
    _Float16* ocmp = (_Float16*)(ws + WS_OCMP);
    _Float16* oslc = (_Float16*)(ws + WS_OSLC);
    unsigned* sel = (unsigned*)(ws + WS_SEL);
    _Float16* omem = (_Float16*)(ws + WS_OMEM);
    _Float16* cat16 = (_Float16*)(ws + WS_CAT16);
    _Float16* hpre16 = (_Float16*)(ws + WS_HPRE);
    float* hbuf = (float*)(ws + WS_H);
    float* gate = (float*)(ws + WS_GATE);
    int* list = (int*)(ws + WS_LIST);
    unsigned char* actf8 = (unsigned char*)(ws + WS_ACT16);
    unsigned char* yf8 = (unsigned char*)(ws + WS_Y16);
    _Float16* h16 = (_Float16*)(ws + WS_H16);
    _Float16* x16 = (_Float16*)(ws + WS_X16);
    _Float16* wtin = (_Float16*)(ws + WS_WTIN);
    _Float16* wtout = (_Float16*)(ws + WS_WTOUT);
    _Float16* wtgu = (_Float16*)(ws + WS_WTGU);
    _Float16* wtdn = (_Float16*)(ws + WS_WTDN);
    LAS unsigned char* lds = (LAS unsigned char*)smem;
    _Float16* proj16 = (_Float16*)(ws + WS_PROJ16);
    _Float16* kvmem16 = (_Float16*)(ws + WS_KVMEM16);
    _Float16* wt1 = (_Float16*)(ws + WS_WT1);
    float* uv = (float*)(ws + WS_UV);
    _Float16* kc16 = (_Float16*)(ws + WS_KC16);
    _Float16* vc16 = (_Float16*)(ws + WS_VC16);
    _Float16* wr16 = (_Float16*)(ws + WS_WR16);
    _Float16* mem16 = (_Float16*)(ws + WS_MEM16);
    _Float16* wtmkv = (_Float16*)(ws + WS_WTMKV);
    _Float16* kv16 = (_Float16*)(ws + WS_KV16);
    _Float16* wt2 = (_Float16*)(ws + WS_WT2);
    float* sa2 = (float*)(ws + WS_SA2); float* gate2 = (float*)(ws + WS_GATE2);
    signed char* x8 = (signed char*)(ws + WS_X8); float* sxa = (float*)(ws + WS_SXA); signed char* q8in = (signed char*)(ws + WS_Q8IN); float* sin8 = (float*)(ws + WS_SIN8);
    signed char* q8mkv = (signed char*)(ws + WS_Q8MKV); float* smkv = (float*)(ws + WS_SMKV);
    signed char* q8out = (signed char*)(ws + WS_Q8OUT); float* sout = (float*)(ws + WS_SOUT); signed char* cat8 = (signed char*)(ws + WS_CAT8); float* scat = (float*)(ws + WS_SCAT);
    signed char* q8gu = (signed char*)(ws + WS_Q8GU); signed char* q8dn = (signed char*)(ws + WS_Q8DN);
    float* sgu = (float*)(ws + WS_SGU); float* sdn = (float*)(ws + WS_SDN);
    signed char* h8q = (signed char*)(ws + WS_H8); float* sah = (float*)(ws + WS_SAH);
    signed char* act8 = (signed char*)(ws + WS_ACT8); float* sact = (float*)(ws + WS_SACT);
    const int vcu = (nb % 8 == 0) ? (bid % 8) * (nb / 8) + bid / 8 : bid;

    volatile LAS unsigned* xbw = (volatile LAS unsigned*)(smem + LDS_BYTES - 16);
    if (tid == 0) { xbw[0] = 0u; xbw[1] = 0u; xbw[2] = 0u; xbw[3] = 0u; }
    __syncthreads();
    XcdBarrier bar; bar.bar = ctl; bar.x = 0; bar.st = xbw;
    const bool multi = (hi - lo) > 1;
    if (multi) bar = xcd_barrier_post(ctl, xbw);
#define IN(k) (lo <= (k) && (k) < hi)
#define SEAM(k) do { if (IN(k) && IN((k) + 1)) xcd_barrier(bar); } while (0)
    float* sw = (float*)smem + wv * WLDS_FLOATS;
    const int qgrp = bid >> 3;
#define QDYN(k, mx) do { constexpr int qb_ = q_beg(k), qc_ = q_cnt(k); const QExtra qxd{nullptr, q8in, sin8, nullptr, q8mkv, smkv}; quant_units<true>(smem, karg_in(I_WGU), karg_in(I_WDN), q8gu, q8dn, sgu, sdn, nullptr, q8out, sout, qxd, qb_, qc_, (unsigned*)(ws + CTL_QCTR) + 16 * (k), (mx), bid, nb); } while (0)
#define QSLOT(k, sl, ns, share) QDYN(k, (qgrp % (ns)) == (sl) ? (share) : 0)
#define QPOST(k) do { __syncthreads(); QDYN(k, 1 << 30); } while (0)
    int* segw = (int*)(sw + 4096 + 512);

    if (IN(0)) {
        DEFPTRS;
        const int lane = LANE_NOW; (void)lane;
        if (wv == 0 && (bid & 1) == 0 && (bid >> 1) < 128) {
            const int task = bid >> 1, kv = task >> 6, jg = (task >> 4) & 3, kc = task & 15;
            const float* pos = p.in[kv ? I_POSV : I_POSK] + kc * 256; const float* w1 = p.in[kv ? I_W1V : I_W1K] + (size_t)kc * 256 * 256 + jg * 64 + lane;
            float s0 = 0.f, s1 = 0.f, s2 = 0.f, s3 = 0.f;
            for (int k = 0; k < 256; k += 4) { s0 += pos[k] * w1[(size_t)k * 256]; s1 += pos[k + 1] * w1[(size_t)(k + 1) * 256]; s2 += pos[k + 2] * w1[(size_t)(k + 2) * 256]; s3 += pos[k + 3] * w1[(size_t)(k + 3) * 256]; }
            bias1[(kv * 16 + kc) * 256 + jg * 64 + lane] = (s0 + s1) + (s2 + s3);
        }
        for (int i = bid * 512 + tid; i < 2 * 128 * 256; i += nb * 512) { const int kv = i >> 15, d = (i >> 8) & 127, n = i & 255; wt2[i] = (_Float16)p.in[kv ? I_W2V : I_W2K][(size_t)n * 128 + d]; }
        for (int i = bid * 512 + tid; i < 32 * 2048; i += nb * 512) { const int e = i >> 11, d = i & 2047; wr16[i] = (_Float16)p.in[I_WR][(size_t)d * 32 + e]; }
        {
            for (int row0 = gw; row0 < T_ + 2048; row0 += nw * 2) {
                float4 raw[2][8];
#pragma unroll
                for (int i = 0; i < 2; ++i) { const int row = row0 + i * nw; const float* src = row < T_ ? p.in[I_X] + (size_t)row * 2048 : p.in[I_MEM] + (size_t)(row - T_) * 2048;
#pragma unroll
                    for (int c = 0; c < 4; ++c) { raw[i][2 * c] = make_float4(0.f, 0.f, 0.f, 0.f); raw[i][2 * c + 1] = raw[i][2 * c];
                        if (row < T_ + 2048) { raw[i][2 * c] = *(const float4*)(src + (lane + 64 * c) * 8); raw[i][2 * c + 1] = *(const float4*)(src + (lane + 64 * c) * 8 + 4); } } }
#pragma unroll
                for (int i = 0; i < 2; ++i) { const int row = row0 + i * nw;
                    float amax = 0.f;
#pragma unroll
                    for (int k = 0; k < 8; ++k) amax = fmaxf(amax, fmaxf(fmaxf(fabsf(raw[i][k].x), fabsf(raw[i][k].y)), fmaxf(fabsf(raw[i][k].z), fabsf(raw[i][k].w))));
                    amax = wave_max(amax);
                    if (row < T_ + 2048) {
                        const float qinv = amax > 0.f ? 127.f / amax : 0.f;
                        if (lane == 0) sxa[row] = amax > 0.f ? amax / 127.f : 1.f;
#pragma unroll
                        for (int c = 0; c < 4; ++c) { const float4 a = raw[i][2 * c], b2 = raw[i][2 * c + 1];
                            uint2 q; q.x = pack4_i8(a.x * qinv, a.y * qinv, a.z * qinv, a.w * qinv); q.y = pack4_i8(b2.x * qinv, b2.y * qinv, b2.z * qinv, b2.w * qinv);
                            *(uint2*)(x8 + (size_t)row * 2048 + (lane + 64 * c) * 8) = q;
                            if (row < T_) { h8 o; o[0] = (_Float16)a.x; o[1] = (_Float16)a.y; o[2] = (_Float16)a.z; o[3] = (_Float16)a.w; o[4] = (_Float16)b2.x; o[5] = (_Float16)b2.y; o[6] = (_Float16)b2.z; o[7] = (_Float16)b2.w;
                                *(h8*)(x16 + (size_t)row * 2048 + (lane + 64 * c) * 8) = o; } } }
                }
            }
        }
        {
            const QExtra qx{p.in[I_WIN], q8in, sin8, p.in[I_WMEMKV], q8mkv, smkv};
            quant_units<false>(smem, p.in[I_WGU], p.in[I_WDN], q8gu, q8dn, sgu, sdn, p.in[I_WOUT], q8out, sout, qx, NE * 192, 64 + 73 + 32, nullptr, 0, bid, nb);
            __syncthreads();
            conv_all((float*)smem, p.in[I_WIN], p.in[I_W1K], p.in[I_W1V], p.in[I_WMEMKV], wtin, wt1, wtmkv, bid, nb);
            __syncthreads();
        }
    }
    SEAM(0);
    if (IN(1)) {
        DEFPTRS;
        const int lane = LANE_NOW; (void)lane;
        const int qs1 = (bid < 16 || (bid >= 64 && bid < 104)) ? 1 : (bid < 64 ? 4 : 8);
        QSLOT(1, 0, 3, qs1);
        { g8::ProbInF P{x16, proj16, nb, bid}; g8::gemm_phase(lds, P); }
        __syncthreads();
        QSLOT(1, 1, 3, qs1);
        { g8::ProbIn8 P{x8, proj16, sxa, nb, (bid + 192) & 255}; g8::gemm_phase(lds, P); }
        __syncthreads();
        QSLOT(1, 2, 3, qs1);
        QPOST(1);
    }
    SEAM(1);
    if (IN(2)) {
        DEFPTRS;
        const int lane = LANE_NOW; (void)lane;
        QSLOT(2, 0, 5, 3);
        { g8::ProbCmp P{kv16, wt1, uv, nb, bid}; g8::gemm_phase(lds, P); __syncthreads(); }
        for (int i = bid * 512 + tid; i < T_ * 64; i += nb * 512) {
            const int chn = i & 63, row = i >> 6, t = row & (S_ - 1), g = chn >> 4;
            const int win = 2 << g, n = min(win, t + 1);
            const _Float16* src = proj16 + (size_t)row * INW + C_UP + chn * 8;
            float a[8];
            const h8 cur = *(const h8*)src;
            h8 vv[15];
#pragma unroll
            for (int k = 0; k < 15; ++k) { vv[k] = (h8){0, 0, 0, 0, 0, 0, 0, 0}; if (k + 1 < n) vv[k] = *(const h8*)(src - (size_t)(k + 1) * INW); }
#pragma unroll
            for (int q = 0; q < 8; ++q) a[q] = (float)cur[q];
#pragma unroll
            for (int k = 0; k < 15; ++k) {
#pragma unroll
                for (int q = 0; q < 8; ++q) a[q] += (float)vv[k][q]; }
            const float rn = 1.f / (float)n;
            float4 o0, o1;
            o0.x = a[0] * rn - (float)cur[0]; o0.y = a[1] * rn - (float)cur[1]; o0.z = a[2] * rn - (float)cur[2]; o0.w = a[3] * rn - (float)cur[3];
            o1.x = a[4] * rn - (float)cur[4]; o1.y = a[5] * rn - (float)cur[5]; o1.z = a[6] * rn - (float)cur[6]; o1.w = a[7] * rn - (float)cur[7];
            *(float4*)(pooled + (size_t)row * 512 + chn * 8) = o0; *(float4*)(pooled + (size_t)row * 512 + chn * 8 + 4) = o1;
        }
        __syncthreads();
        QSLOT(2, 1, 5, 3);
        {
            const int r32 = lane & 31, hi = lane >> 5, g = wv >> 1, half = wv & 1;
            for (int uu = vcu; uu < 512; uu += nb) {
                const int v = uu & 255, bk = v >> 4, qi = (uu >> 8) ? 31 - (v & 15) : (v & 15), b = bk >> 1, kvh = bk & 1;
                const int t = qi * 64 + half * 32 + r32;
                const int lo_t = max(0, qi - 8);
                const unsigned tmask = (unsigned)(((1ull << (qi + 1)) - 1ull) & ~((1ull << lo_t) - 1ull));
                at8::attn_unit(smem, proj16 + (size_t)(b * S_ + t) * INW + C_Q + (kvh * 4 + g) * 128 + hi * 8,
                               kv16 + ((size_t)(4 * B_ + b) * 2 + kvh) * KVSEG, kv16 + ((size_t)(5 * B_ + b) * 2 + kvh) * KVSEG, 128, tmask, 512, t, 0xffffffffu,
                               owin + (size_t)(b * S_ + qi * 64 + half * 32) * 1024 + (kvh * 4 + g) * 128, 1024);
                QSLOT(2, 2 + (uu >> 8), 5, 3);
            }
            for (int u = vcu; u < 256; u += nb) {
                const int b = u >> 5, h = (u >> 3) & 3, qt = u & 7;
                const int t = qt * 256 + wv * 32 + r32;
                at8::attn_unit(smem, proj16 + (size_t)(b * S_ + t) * INW + C_QM + h * 128 + hi * 8,
                               kvmem16 + (size_t)b * 256 * 1024 + h * 128, kvmem16 + (size_t)b * 256 * 1024 + 512 + h * 128, 1024, 0xFu, 0, 255, 0xffffffffu,
                               omem + (size_t)(b * S_ + qt * 256 + wv * 32) * 512 + h * 128, 512);
            }
        }
        QPOST(2);
    }
    SEAM(2);
    if (IN(3)) {
        DEFPTRS;
        const int lane = LANE_NOW; (void)lane;
        QSLOT(3, 0, 3, 2);
        {
            float* bsum = (float*)smem;
            _Float16* hs = (_Float16*)(smem + 4096);
            { const int kv = tid >> 8, n = tid & 255; float a = 0.f;
#pragma unroll
              for (int kc = 0; kc < 16; ++kc) a += bias1[(kv * 16 + kc) * 256 + n];
              bsum[tid] = a; }
            __syncthreads();
            const int fr = lane & 15, fq = lane >> 4;
            for (int u = bid; u < 256; u += nb) {
                const int kv = u >> 7, rt = u & 127;
#pragma unroll
                for (int q = 0; q < 8; ++q) { const int e = tid + 512 * q, i = e >> 8, n = e & 255;
                    const int row = rt * 16 + i, c = (row >> 1) & 127;
                    float a = 0.f;
                    if (c != 127) { a = bsum[kv * 256 + n];
#pragma unroll
                        for (int sp = 0; sp < 4; ++sp) { const float* base = uv + ((size_t)(kv * 4 + sp) * 2048) * 512; a += base[(size_t)row * 512 + n] + base[(size_t)(row + 2) * 512 + 256 + n]; }
                        a = gelu_fast(a); }
                    hs[i * 264 + n] = (_Float16)a; }
                __syncthreads();
                { const _Float16* bp = wt2 + ((size_t)kv * 128 + wv * 16 + fr) * 256 + fq * 8;
                  f4 acc = (f4){0.f, 0.f, 0.f, 0.f};
#pragma unroll
                  for (int sI = 0; sI < 8; ++sI) { const h8 a = *(const h8*)(hs + fr * 264 + sI * 32 + fq * 8), bb = *(const h8*)(bp + sI * 32); acc = __builtin_amdgcn_mfma_f32_16x16x32_f16(a, bb, acc, 0, 0, 0); }
                  _Float16* dst = kv ? vc16 : kc16;
#pragma unroll
                  for (int j = 0; j < 4; ++j) { const int row = rt * 16 + fq * 4 + j; dst[(size_t)row * 128 + wv * 16 + fr] = (((row >> 1) & 127) == 127) ? (_Float16)0.f : (_Float16)acc[j]; } }
                __syncthreads();
            }
        }
        QSLOT(3, 1, 3, 2);
        for (int u = bid; u < 128 * 4; u += nb) { const int g = u >> 7, mt = u & 127;
            ARowPlain af{pooled + g * 128, 512, mt * 128, T_}; EpiPool ef{opool, p.in[I_POOLS], mt * 128, g};
            gemm_tile(smem, 128, af, p.in[I_POOLW] + (size_t)g * 128 * 128, 128, 0, 128, false, ef);
        }
        QPOST(3);
    }
    SEAM(3);
    if (IN(4)) {
        DEFPTRS;
        const int lane = LANE_NOW; (void)lane;
        QSLOT(4, 0, 3, 2);
        const int r32 = lane & 31, hi = lane >> 5, g = wv >> 1, half = wv & 1;
        for (int uu = vcu; uu < 512; uu += nb) {
            const int v = uu & 255, bk = v >> 4, qi = (uu >> 8) ? 31 - (v & 15) : (v & 15), b = bk >> 1, kvh = bk & 1;
            const int tl = half * 32 + r32, t = qi * 64 + tl;
            at8::cmp_slc_unit(smem, proj16 + (size_t)(b * S_ + t) * INW + C_Q + (kvh * 4 + g) * 128 + hi * 8,
                              kc16 + (size_t)(b * 128 * 2 + kvh) * 128, vc16 + (size_t)(b * 128 * 2 + kvh) * 128,
                              kv16 + ((size_t)(2 * B_ + b) * 2 + kvh) * KVSEG, kv16 + ((size_t)(3 * B_ + b) * 2 + kvh) * KVSEG, t, tl, g, qi,
                              ocmp + (size_t)(b * S_ + qi * 64 + half * 32) * 1024 + (kvh * 4 + g) * 128, oslc + (size_t)(b * S_ + qi * 64 + half * 32) * 1024 + (kvh * 4 + g) * 128);
            QSLOT(4, 1 + (uu >> 8), 3, 2);
        }
        QPOST(4);
    }
    SEAM(4);
    if (IN(5)) {
        DEFPTRS;
        QSLOT(5, 0, 2, 1);
        const int lane = LANE_NOW;
        for (int row = gw; row < T_; row += nw) {
            const _Float16* pr = proj16 + (size_t)row * INW + C_G;
            float v[32]; float ss = 0.f;
#pragma unroll
            for (int c = 0; c < 2; ++c) { const int col = (lane + 64 * c) * 8, h = col >> 7; const size_t o = (size_t)row * 1024 + col;
                const float g0 = sigmoidf_((float)pr[h * 3]), g1 = sigmoidf_((float)pr[h * 3 + 1]), g2 = sigmoidf_((float)pr[h * 3 + 2]);
                const h8 a = *(const h8*)(ocmp + o), b2 = *(const h8*)(oslc + o), c2 = *(const h8*)(owin + o);
#pragma unroll
                for (int q = 0; q < 8; ++q) { const float x = g0 * (float)a[q] + g1 * (float)b2[q] + g2 * (float)c2[q]; v[c * 8 + q] = x; ss += x * x; } }
            ss = wave_sum(ss); float r = rsqrtf(ss / 1024.f + LN_EPS);
#pragma unroll
            for (int c = 0; c < 2; ++c) { const int col = (lane + 64 * c) * 8; const float4 ga = *(const float4*)(p.in[I_GNNSA] + col), gb = *(const float4*)(p.in[I_GNNSA] + col + 4);
                v[c * 8 + 0] *= r * ga.x; v[c * 8 + 1] *= r * ga.y; v[c * 8 + 2] *= r * ga.z; v[c * 8 + 3] *= r * ga.w; v[c * 8 + 4] *= r * gb.x; v[c * 8 + 5] *= r * gb.y; v[c * 8 + 6] *= r * gb.z; v[c * 8 + 7] *= r * gb.w; }
            { const h8 a = *(const h8*)(opool + (size_t)row * 512 + lane * 8); ss = 0.f;
#pragma unroll
              for (int q = 0; q < 8; ++q) { v[16 + q] = (float)a[q]; ss += v[16 + q] * v[16 + q]; }
              ss = wave_sum(ss); r = rsqrtf(ss / 512.f + LN_EPS);
              const float4 ga = *(const float4*)(p.in[I_GNPOOL] + lane * 8), gb = *(const float4*)(p.in[I_GNPOOL] + lane * 8 + 4);
              v[16] *= r * ga.x; v[17] *= r * ga.y; v[18] *= r * ga.z; v[19] *= r * ga.w; v[20] *= r * gb.x; v[21] *= r * gb.y; v[22] *= r * gb.z; v[23] *= r * gb.w; }
            { const h8 a = *(const h8*)(omem + (size_t)row * 512 + lane * 8); ss = 0.f;
#pragma unroll
              for (int q = 0; q < 8; ++q) { v[24 + q] = (float)a[q]; ss += v[24 + q] * v[24 + q]; }
              ss = wave_sum(ss); r = rsqrtf(ss / 512.f + LN_EPS);
              const float4 ga = *(const float4*)(p.in[I_GNMEM] + lane * 8), gb = *(const float4*)(p.in[I_GNMEM] + lane * 8 + 4);
              v[24] *= r * ga.x; v[25] *= r * ga.y; v[26] *= r * ga.z; v[27] *= r * ga.w; v[28] *= r * gb.x; v[29] *= r * gb.y; v[30] *= r * gb.z; v[31] *= r * gb.w; }
            float amax = 0.f;
#pragma unroll
            for (int k = 0; k < 32; ++k) amax = fmaxf(amax, fabsf(v[k]));
            amax = wave_max(amax);
            const float qinv = amax > 0.f ? 127.f / amax : 0.f;
            if (lane == 0) scat[row] = amax > 0.f ? amax / 127.f : 1.f;
#pragma unroll
            for (int c = 0; c < 4; ++c) { const int col = c < 2 ? (lane + 64 * c) * 8 : (c == 2 ? 1024 + lane * 8 : 1536 + lane * 8);
                uint2 q; q.x = pack4_i8(v[c * 8 + 0] * qinv, v[c * 8 + 1] * qinv, v[c * 8 + 2] * qinv, v[c * 8 + 3] * qinv); q.y = pack4_i8(v[c * 8 + 4] * qinv, v[c * 8 + 5] * qinv, v[c * 8 + 6] * qinv, v[c * 8 + 7] * qinv);
                *(uint2*)(cat8 + (size_t)row * 2048 + col) = q; }
        }
        QPOST(5);
    }
    SEAM(5);
    if (IN(6)) {
        DEFPTRS;
        const int lane = LANE_NOW; (void)lane;
        QSLOT(6, 0, 2, 1);
        { g8::ProbOut P{cat8, q8out, hpre16, x16, scat, sout, nb, bid};
          g8::gemm_phase(lds, P); }
        QPOST(6);
    }
    SEAM(6);
    if (IN(7)) {
        DEFPTRS;
        const int lane = LANE_NOW; (void)lane;
        QSLOT(7, 0, 2, 1);
        float* lg = (float*)smem;
        const int r32 = lane & 31, hi = lane >> 5, fr = lane & 15, fq = lane >> 4;
        for (int u = bid; u < T_ / 64; u += nb) {
            const int base = u * 64;
            h8 raw[8][4];
#pragma unroll
            for (int i = 0; i < 8; ++i)
#pragma unroll
                for (int c = 0; c < 4; ++c) raw[i][c] = *(const h8*)(hpre16 + (size_t)(base + wv * 8 + i) * 2048 + (lane + 64 * c) * 8);
#pragma unroll
            for (int i = 0; i < 8; ++i) {
                const int row = base + wv * 8 + i;
                float v[32]; float s = 0.f;
#pragma unroll
                for (int c = 0; c < 4; ++c) {
#pragma unroll
                    for (int q = 0; q < 8; ++q) { v[c * 8 + q] = (float)raw[i][c][q]; s += v[c * 8 + q]; } }
                const float mu = wave_sum(s) / 2048.f; float q2 = 0.f;
#pragma unroll
                for (int k = 0; k < 32; ++k) { const float d = v[k] - mu; q2 += d * d; }
                const float rs = rsqrtf(wave_sum(q2) / 2048.f + LN_EPS);
                float amax = 0.f;
#pragma unroll
                for (int c = 0; c < 4; ++c) { const int col = (lane + 64 * c) * 8;
                    const float4 g0 = *(const float4*)(p.in[I_LN1G] + col), g1 = *(const float4*)(p.in[I_LN1G] + col + 4), b0 = *(const float4*)(p.in[I_LN1B] + col), b1 = *(const float4*)(p.in[I_LN1B] + col + 4);
                    float4 o0, o1;
                    o0.x = (v[c * 8 + 0] - mu) * rs * g0.x + b0.x; o0.y = (v[c * 8 + 1] - mu) * rs * g0.y + b0.y; o0.z = (v[c * 8 + 2] - mu) * rs * g0.z + b0.z; o0.w = (v[c * 8 + 3] - mu) * rs * g0.w + b0.w;
                    o1.x = (v[c * 8 + 4] - mu) * rs * g1.x + b1.x; o1.y = (v[c * 8 + 5] - mu) * rs * g1.y + b1.y; o1.z = (v[c * 8 + 6] - mu) * rs * g1.z + b1.z; o1.w = (v[c * 8 + 7] - mu) * rs * g1.w + b1.w;
                    h8 oh; oh[0] = (_Float16)o0.x; oh[1] = (_Float16)o0.y; oh[2] = (_Float16)o0.z; oh[3] = (_Float16)o0.w; oh[4] = (_Float16)o1.x; oh[5] = (_Float16)o1.y; oh[6] = (_Float16)o1.z; oh[7] = (_Float16)o1.w;
                    *(h8*)(h16 + (size_t)row * 2048 + col) = oh;
                    v[c * 8 + 0] = o0.x; v[c * 8 + 1] = o0.y; v[c * 8 + 2] = o0.z; v[c * 8 + 3] = o0.w; v[c * 8 + 4] = o1.x; v[c * 8 + 5] = o1.y; v[c * 8 + 6] = o1.z; v[c * 8 + 7] = o1.w;
                    amax = fmaxf(amax, fmaxf(fmaxf(fmaxf(fabsf(o0.x), fabsf(o0.y)), fmaxf(fabsf(o0.z), fabsf(o0.w))), fmaxf(fmaxf(fabsf(o1.x), fabsf(o1.y)), fmaxf(fabsf(o1.z), fabsf(o1.w))))); }
                amax = wave_max(amax);
                const float qinv = amax > 0.f ? 127.f / amax : 0.f;
                if (lane == 0) sah[row] = amax > 0.f ? amax / 127.f : 1.f;
#pragma unroll
                for (int c = 0; c < 4; ++c) { const int col = (lane + 64 * c) * 8;
                    uint2 q; q.x = pack4_i8(v[c * 8 + 0] * qinv, v[c * 8 + 1] * qinv, v[c * 8 + 2] * qinv, v[c * 8 + 3] * qinv); q.y = pack4_i8(v[c * 8 + 4] * qinv, v[c * 8 + 5] * qinv, v[c * 8 + 6] * qinv, v[c * 8 + 7] * qinv);
                    *(uint2*)(h8q + (size_t)row * 2048 + col) = q; }
            }
            asm volatile("s_waitcnt vmcnt(0)" ::: "memory");
            __syncthreads();
            {
                const int tok0 = base + 16 * (wv >> 1), e0 = 16 * (wv & 1);
                const _Float16* ap = h16 + (size_t)(tok0 + fr) * 2048 + fq * 8; const _Float16* bp = wr16 + (size_t)(e0 + fr) * 2048 + fq * 8;
                f4 acc = (f4){0.f, 0.f, 0.f, 0.f};
#pragma unroll 8
                for (int sI = 0; sI < 64; ++sI) { const h8 a = *(const h8*)(ap + sI * 32), bb = *(const h8*)(bp + sI * 32); acc = __builtin_amdgcn_mfma_f32_16x16x32_f16(a, bb, acc, 0, 0, 0); }
                const float br = p.in[I_BR][e0 + fr];
#pragma unroll
                for (int j = 0; j < 4; ++j) lg[(16 * (wv >> 1) + 4 * fq + j) * 33 + e0 + fr] = acc[j] + br;
            }
            int* lcnt = (int*)(smem + 16384); int* lbase = lcnt + 32; int* st_e = lcnt + 64; int* st_p = st_e + 256; float* st_g = (float*)(st_p + 256);
            const int t7 = ({ int _t = threadIdx.x; asm volatile("" : "+v"(_t)); _t; });
            if (t7 < 32) lcnt[t7] = 0;
            __syncthreads();
#pragma unroll 1
            for (int it = 0; it < 4; ++it) {
                const int tk = 8 * wv + 2 * it + hi;
                const float iv = lg[tk * 33 + r32];
                int rank = 0;
                for (int i = 0; i < 32; ++i) { const float vi = __shfl(iv, i + 32 * hi); rank += (vi > iv || (vi == iv && i < r32)) ? 1 : 0; }
                float tv[4]; int te[4];
#pragma unroll
                for (int r = 0; r < 4; ++r) { const unsigned long long bm = __ballot(rank == r); const unsigned hm = (unsigned)(bm >> (32 * hi)); const int src = __ffs(hm) - 1; te[r] = src; tv[r] = __shfl(iv, src + 32 * hi); }
                const float e0v = 1.f, e1v = expf(tv[1] - tv[0]), e2v = expf(tv[2] - tv[0]), e3v = expf(tv[3] - tv[0]); const float inv = 1.f / (e0v + e1v + e2v + e3v);
                if (r32 < 4) { const int e = r32 == 0 ? te[0] : r32 == 1 ? te[1] : r32 == 2 ? te[2] : te[3]; const float g = (r32 == 0 ? e0v : r32 == 1 ? e1v : r32 == 2 ? e2v : e3v) * inv;
                    st_e[tk * 4 + r32] = e; st_g[tk * 4 + r32] = g; st_p[tk * 4 + r32] = atomicAdd(&lcnt[e], 1); }
            }
            __syncthreads();
            if (t7 < 32) { const int c = lcnt[t7]; lbase[t7] = c ? atomicAdd(&cnt[t7], c) : 0; }
            __syncthreads();
            if (t7 < 256) { const int tkl = t7 >> 2, e = st_e[t7], pos = lbase[e] + st_p[t7], a = (base + tkl) * 4 + (t7 & 3); const float g = st_g[t7];
                list[(size_t)e * T_ + pos] = a; gate[a] = g; gate2[(size_t)e * T_ + pos] = g; sa2[(size_t)e * T_ + pos] = sah[base + tkl]; }
            __syncthreads();
        }
        QPOST(7);
    }
    SEAM(7);
    LAS int* mtab = (LAS int*)(smem + g8::STAGE_BYTES);
    if (IN(8)) {
        DEFPTRS;
        const int lane = LANE_NOW; (void)lane;
        if (tid == 0) { int ub = 0, rs = 0;
            for (int e = 0; e < NE; ++e) { const int c = (int)__hip_atomic_load((unsigned*)&cnt[e], __ATOMIC_RELAXED, __HIP_MEMORY_SCOPE_AGENT); mtab[e] = c; mtab[32 + e] = ub; mtab[65 + e] = rs; ub += ((c + 255) >> 8) * 16; rs += c; }
            mtab[64] = ub; mtab[97] = rs; mtab[98] = ub; }
        __syncthreads();
        g8::moe_build(mtab, nb, vcu);
        __syncthreads();
        {
            const int total = mtab[98], nmine = total > vcu ? (total - vcu + nb - 1) / nb : 0, cut = (nmine * (qgrp & 7)) >> 3;
            const int nmax = (total + nb - 1) / nb, nlight = nb * nmax - total, s_lo = max(0, (q_cnt(8) - 3 * nlight) / nb), qs8 = nmine < nmax ? s_lo + 3 : s_lo;
            { g8::ProbGu P{h8q, q8gu, actf8, p.in[I_BGU], list, sa2, sgu, g8::MoeTab{mtab, 16, 0, cut}, nb, vcu};
              g8::gemm_phase(lds, P); }
            __syncthreads();
            QDYN(8, qs8);
            { g8::ProbGu P{h8q, q8gu, actf8, p.in[I_BGU], list, sa2, sgu, g8::MoeTab{mtab, 16, cut, 40}, nb, vcu};
              g8::gemm_phase(lds, P); }
        }
        QPOST(8);
    }
    SEAM(8);
    if (IN(9)) {
        DEFPTRS;
        const int lane = LANE_NOW;
        for (int row0 = gw; row0 < NA; row0 += nw * 8) {
            uint2 raw[8][4];
#pragma unroll
            for (int i = 0; i < 8; ++i)
#pragma unroll
                for (int c = 0; c < 4; ++c) raw[i][c] = *(const uint2*)(actf8 + (size_t)(row0 + i * nw) * 2048 + (lane + 64 * c) * 8);
#pragma unroll
            for (int i = 0; i < 8; ++i) { const int row = row0 + i * nw;
                float v[32]; float amax = 0.f;
#pragma unroll
                for (int c = 0; c < 4; ++c) { const uint2 a = raw[i][c];
                    dec4_fp8(a.x, v[c * 8 + 0], v[c * 8 + 1], v[c * 8 + 2], v[c * 8 + 3]); dec4_fp8(a.y, v[c * 8 + 4], v[c * 8 + 5], v[c * 8 + 6], v[c * 8 + 7]);
#pragma unroll
                    for (int q = 0; q < 8; ++q) amax = fmaxf(amax, fabsf(v[c * 8 + q])); }
                amax = wave_max(amax);
                const float qinv = amax > 0.f ? 127.f / amax : 0.f;
                if (lane == 0) sact[row] = amax > 0.f ? amax / 127.f : 1.f;
#pragma unroll
                for (int c = 0; c < 4; ++c) { uint2 q; q.x = pack4_i8(v[c * 8 + 0] * qinv, v[c * 8 + 1] * qinv, v[c * 8 + 2] * qinv, v[c * 8 + 3] * qinv); q.y = pack4_i8(v[c * 8 + 4] * qinv, v[c * 8 + 5] * qinv, v[c * 8 + 6] * qinv, v[c * 8 + 7] * qinv);
                    *(uint2*)(act8 + (size_t)row * 2048 + (lane + 64 * c) * 8) = q; }
            }
        }
    }
    SEAM(9);
    if (IN(10)) {
        DEFPTRS;
        const int lane = LANE_NOW; (void)lane;
        if (tid == 0) { int ub = 0, rs = 0;
            for (int e = 0; e < NE; ++e) { const int c = (int)__hip_atomic_load((unsigned*)&cnt[e], __ATOMIC_RELAXED, __HIP_MEMORY_SCOPE_AGENT); mtab[e] = c; mtab[32 + e] = ub; mtab[65 + e] = rs; ub += ((c + 255) >> 8) * 8; rs += c; }
            mtab[64] = ub; mtab[97] = rs; mtab[98] = ub; }
        __syncthreads();
        g8::moe_build(mtab, nb, vcu);
        __syncthreads();
        g8::ProbDn P{act8, q8dn, yf8, p.in[I_BDN], list, gate2, sact, sdn, g8::MoeTab{mtab, 8, 0, 40}, nb, vcu};
        g8::gemm_phase(lds, P);
        __syncthreads();
    }
    SEAM(10);
    if (IN(11)) {
        DEFPTRS;
        const int lane = LANE_NOW; (void)lane;
        for (int row0 = gw; row0 < T_; row0 += nw * 2) {
          h8 hraw[2][4]; uint2 yraw[2][4][4];
#pragma unroll
          for (int i = 0; i < 2; ++i)
#pragma unroll
            for (int c = 0; c < 4; ++c) { const int col = (lane + 64 * c) * 8; const size_t yo = (size_t)(row0 + i * nw) * 4 * 2048 + col;
                hraw[i][c] = *(const h8*)(h16 + (size_t)(row0 + i * nw) * 2048 + col);
                yraw[i][c][0] = *(const uint2*)(yf8 + yo); yraw[i][c][1] = *(const uint2*)(yf8 + yo + 2048); yraw[i][c][2] = *(const uint2*)(yf8 + yo + 4096); yraw[i][c][3] = *(const uint2*)(yf8 + yo + 6144); }
#pragma unroll
          for (int i = 0; i < 2; ++i) { const int row = row0 + i * nw;
            float v[32]; float s = 0.f;
#pragma unroll
            for (int c = 0; c < 4; ++c) {
                const h8 hh8 = hraw[i][c];
                const uint2 y0 = yraw[i][c][0], y1 = yraw[i][c][1], y2 = yraw[i][c][2], y3 = yraw[i][c][3];
                float ys[8], t0[8], t1[8], t2[8], t3[8];
                dec4_fp8(y0.x, t0[0], t0[1], t0[2], t0[3]); dec4_fp8(y0.y, t0[4], t0[5], t0[6], t0[7]); dec4_fp8(y1.x, t1[0], t1[1], t1[2], t1[3]); dec4_fp8(y1.y, t1[4], t1[5], t1[6], t1[7]);
                dec4_fp8(y2.x, t2[0], t2[1], t2[2], t2[3]); dec4_fp8(y2.y, t2[4], t2[5], t2[6], t2[7]); dec4_fp8(y3.x, t3[0], t3[1], t3[2], t3[3]); dec4_fp8(y3.y, t3[4], t3[5], t3[6], t3[7]);
#pragma unroll
                for (int q = 0; q < 8; ++q) ys[q] = (t0[q] + t1[q]) + (t2[q] + t3[q]);
#pragma unroll
                for (int q = 0; q < 8; ++q) { v[c * 8 + q] = DN_ALPHA * (float)hh8[q] + ys[q] * 0.0625f; s += v[c * 8 + q]; } }
            const float mu = wave_sum(s) / 2048.f; float q2 = 0.f;
#pragma unroll
            for (int i = 0; i < 32; ++i) { const float d = v[i] - mu; q2 += d * d; }
            const float rs = rsqrtf(wave_sum(q2) / 2048.f + LN_EPS);
#pragma unroll
            for (int c = 0; c < 4; ++c) { const int col = (lane + 64 * c) * 8;
                const float4 ga = *(const float4*)(p.in[I_LN2G] + col), gb = *(const float4*)(p.in[I_LN2G] + col + 4), ba = *(const float4*)(p.in[I_LN2B] + col), bb = *(const float4*)(p.in[I_LN2B] + col + 4);
                float4 o0, o1;
                o0.x = (v[c * 8 + 0] - mu) * rs * ga.x + ba.x; o0.y = (v[c * 8 + 1] - mu) * rs * ga.y + ba.y; o0.z = (v[c * 8 + 2] - mu) * rs * ga.z + ba.z; o0.w = (v[c * 8 + 3] - mu) * rs * ga.w + ba.w;
                o1.x = (v[c * 8 + 4] - mu) * rs * gb.x + bb.x; o1.y = (v[c * 8 + 5] - mu) * rs * gb.y + bb.y; o1.z = (v[c * 8 + 6] - mu) * rs * gb.z + bb.z; o1.w = (v[c * 8 + 7] - mu) * rs * gb.w + bb.w;
                *(float4*)(p.out + (size_t)row * 2048 + col) = o0; *(float4*)(p.out + (size_t)row * 2048 + col + 4) = o1; }
          }
        }
    }
}

constexpr int NPHASE = 12;

extern "C" void kernel_launch(void* const* d_in, const int* in_sizes, int n_in, void* d_out, int out_size, void* d_ws, size_t ws_size, hipStream_t stream) {
    static int grid = 0;
    if (grid == 0) {
        if (n_in != 26 || ws_size < WS_END) { fprintf(stderr, "kernel_launch: unexpected n_in %d or ws_size %zu (< %zu)\n", n_in, ws_size, (size_t)WS_END); grid = -1; return; }
        int dev = 0, cus = 0, per_cu = 0;
        hipGetDevice(&dev); hipDeviceGetAttribute(&cus, hipDeviceAttributeMultiprocessorCount, dev);
        if (hipFuncSetAttribute((const void*)fwd, hipFuncAttributeMaxDynamicSharedMemorySize, LDS_BYTES) != hipSuccess) { fprintf(stderr, "hipFuncSetAttribute failed\n"); grid = -1; return; }
        hipOccupancyMaxActiveBlocksPerMultiprocessor(&per_cu, (const void*)fwd, 512, LDS_BYTES);
        (void)hipGetLastError();
        if (per_cu < 1) fprintf(stderr, "occupancy query says %d blocks per CU\n", per_cu);
        grid = cus > 0 ? cus : 256;
    }
    if (grid < 0) return;
    hipMemsetAsync((char*)d_ws + WS_CTL, 0, CTL_BYTES, stream);
    Params p{};
    for (int i = 0; i < 26; ++i) p.in[i] = (const float*)d_in[i];
    p.out = (float*)d_out; p.ws = (unsigned char*)d_ws;
#if N_LAUNCH_MODE == 1
    p.lo_hi = (long long)0 | ((long long)NPHASE << 32);
    hipLaunchKernelGGL(fwd, dim3(grid), dim3(512), LDS_BYTES, stream, p);
#else
    for (int ph = 0; ph < NPHASE; ++ph) {
        p.lo_hi = (long long)ph | ((long long)(ph + 1) << 32);
        hipLaunchKernelGGL(fwd, dim3(grid), dim3(512), LDS_BYTES, stream, p);
    }
#endif
}
```

```cpp
#include <hip/hip_runtime.h>
#include <cstdio>
#include <cstdint>

#ifndef N_LAUNCH_MODE
#define N_LAUNCH_MODE 1
#endif

constexpr int B_ = 8, S_ = 2048, D_ = 2048, T_ = B_ * S_;
constexpr int INW = 3608;
constexpr int C_Q = 0, C_KC = 1024, C_VC = 1280, C_KS = 1536, C_VS = 1792, C_KW = 2048, C_VW = 2304, C_G = 2560, C_UP = 2584, C_QM = 3096;
constexpr int NC = 127;
constexpr int CROWS = B_ * NC * 2;
constexpr int NE = 32, DE = 2048, NA = T_ * 4;
constexpr float LN_EPS = 1e-5f;
constexpr float DN_ALPHA = 1.189207115002721f;
constexpr float ATT_SCALE = 0.08838834764831845f;

constexpr size_t al256(size_t x) { return (x + 255) & ~(size_t)255; }
constexpr size_t WS_CTL = 0;
constexpr size_t CTL_BYTES = 65536;
constexpr size_t CTL_CNT = 16384;
constexpr size_t WS_PROJ = CTL_BYTES;
constexpr size_t WS_KVMEM = WS_PROJ + al256((size_t)T_ * INW * 4);
constexpr size_t WS_BIAS1 = WS_KVMEM + al256((size_t)2048 * 1024 * 4);
constexpr size_t WS_HID = WS_BIAS1 + al256(2 * 16 * 256 * 4);
constexpr size_t WS_KC = WS_HID + al256((size_t)2 * 2048 * 256 * 4);
constexpr size_t WS_VC = WS_KC + al256((size_t)CROWS * 128 * 4);
constexpr size_t WS_POOLED = WS_VC + al256((size_t)CROWS * 128 * 4);
constexpr size_t WS_OPOOL = WS_POOLED + al256((size_t)T_ * 512 * 4);
constexpr size_t WS_OWIN = WS_OPOOL + al256((size_t)T_ * 512 * 4);
constexpr size_t WS_OCMP = WS_OWIN + al256((size_t)T_ * 1024 * 4);
constexpr size_t WS_OSLC = WS_OCMP + al256((size_t)T_ * 1024 * 4);
constexpr size_t WS_SEL = WS_OSLC + al256((size_t)T_ * 1024 * 4);
constexpr size_t WS_OMEM = WS_SEL + al256((size_t)T_ * 2 * 4);
constexpr size_t WS_CAT16 = WS_OMEM + al256((size_t)T_ * 512 * 4);
constexpr size_t WS_HPRE = WS_CAT16 + al256((size_t)T_ * 2048 * 2);
constexpr size_t WS_H = WS_HPRE + al256((size_t)T_ * 2048 * 4);
constexpr size_t WS_H16 = WS_H + al256((size_t)T_ * 2048 * 4);
constexpr size_t WS_GATE = WS_H16 + al256((size_t)T_ * 2048 * 2);
constexpr size_t WS_LIST = WS_GATE + al256((size_t)NA * 4);
constexpr size_t WS_ACT16 = WS_LIST + al256((size_t)NE * T_ * 4);
constexpr size_t WS_Y16 = WS_ACT16 + al256((size_t)(NA + 256) * 2048 * 2);
constexpr size_t WS_X16 = WS_Y16 + al256((size_t)NA * 2048 * 2);
constexpr size_t WS_MEM16 = WS_X16 + (size_t)T_ * 2048 * 2;
constexpr size_t WS_WTIN = WS_MEM16 + al256((size_t)2048 * 2048 * 2);
constexpr size_t WS_WTOUT = WS_WTIN + al256((size_t)3840 * 2048 * 2);
constexpr size_t WS_WTGU = WS_WTOUT + al256((size_t)2048 * 2048 * 2);
constexpr size_t WS_WTDN = WS_WTGU + al256((size_t)NE * 4096 * 2048 * 2);
constexpr size_t WS_PROJ16 = WS_WTDN + al256((size_t)NE * 2048 * 2048 * 2);
constexpr size_t WS_KVMEM16 = WS_PROJ16 + al256((size_t)(T_ + 64) * INW * 2);
constexpr size_t WS_WT1 = WS_KVMEM16 + al256((size_t)2048 * 1024 * 2);
constexpr size_t WS_UV = WS_WT1 + al256((size_t)2 * 512 * 2048 * 2);
constexpr size_t WS_KC16 = WS_UV + al256((size_t)2 * 4 * 2048 * 512 * 4);
constexpr size_t WS_VC16 = WS_KC16 + al256((size_t)B_ * 128 * 256 * 2);
constexpr size_t WS_WR16 = WS_VC16 + al256((size_t)B_ * 128 * 256 * 2);
constexpr size_t WS_Q8GU = WS_WR16 + al256((size_t)32 * 2048 * 2);
constexpr size_t WS_Q8DN = WS_Q8GU + al256((size_t)NE * 4096 * 2048);
constexpr size_t WS_SGU = WS_Q8DN + al256((size_t)NE * 2048 * 2048);
constexpr size_t WS_SDN = WS_SGU + al256((size_t)NE * 4096 * 4);
constexpr size_t WS_H8 = WS_SDN + al256((size_t)NE * 2048 * 4);
constexpr size_t WS_SAH = WS_H8 + al256((size_t)T_ * 2048);
constexpr size_t WS_ACT8 = WS_SAH + al256((size_t)T_ * 4);
constexpr size_t WS_SACT = WS_ACT8 + al256((size_t)(NA + 256) * 2048);
constexpr size_t WS_WTMKV = WS_SACT + al256((size_t)(NA + 256) * 4);
constexpr size_t WS_Q8OUT = WS_WTMKV + al256((size_t)1024 * 2048 * 2);
constexpr size_t WS_SOUT = WS_Q8OUT + al256((size_t)2048 * 2048);
constexpr size_t WS_CAT8 = WS_SOUT + al256(2048 * 4);
constexpr size_t WS_SCAT = WS_CAT8 + al256((size_t)T_ * 2048);
constexpr size_t WS_SA2 = WS_SCAT + al256((size_t)T_ * 4);
constexpr size_t WS_GATE2 = WS_SA2 + al256((size_t)NE * T_ * 4);
constexpr size_t WS_X8 = WS_GATE2 + al256((size_t)NE * T_ * 4);
constexpr size_t WS_SXA = WS_X8 + al256((size_t)(T_ + 2048) * 2048);
constexpr size_t WS_Q8IN = WS_SXA + al256((size_t)(T_ + 2048) * 4);
constexpr size_t WS_SIN8 = WS_Q8IN + al256((size_t)2560 * 2048);
constexpr size_t WS_Q8MKV = WS_SIN8 + al256(2560 * 4);
constexpr size_t WS_SMKV = WS_Q8MKV + al256((size_t)1024 * 2048);
constexpr size_t WS_WT2 = WS_SMKV + al256(1024 * 4);
constexpr size_t WS_KV16 = WS_WT2 + al256((size_t)2 * 128 * 256 * 2);
constexpr size_t KVSEG = (size_t)S_ * 128;
constexpr size_t WS_END = WS_KV16 + al256((size_t)6 * B_ * 2 * S_ * 128 * 2);

constexpr int LDS_BYTES = 159744;

struct Params {
    const float* in[26];
    float* out;
    unsigned char* ws;
    long long lo_hi;
};
enum { I_X = 0, I_MEM, I_WIN, I_POSK, I_W1K, I_W2K, I_POSV, I_W1V, I_W2V, I_POOLW, I_POOLS, I_WMEMKV, I_GNNSA, I_GNPOOL, I_GNMEM, I_WOUT,
       I_LN1G, I_LN1B, I_WR, I_BR, I_WGU, I_BGU, I_WDN, I_BDN, I_LN2G, I_LN2B };

#define XB_TMO      128
#define XB_XCNT(j)  (256  + 64 * (j))
#define XB_XSUB(j)  (1280 + 64 * (j))
#define XB_XGEN(j)  (2304 + 64 * (j))
#define XB_TOP      3328
#define XB_TOPGEN   3392
#define XCD_BAR_WORDS 3456
#define XB_SPIN_CAP (1u << 25)
#define LAS __attribute__((address_space(3)))

__device__ __forceinline__ unsigned xb_ld(unsigned* p)              { return __hip_atomic_load(p, __ATOMIC_RELAXED, __HIP_MEMORY_SCOPE_AGENT); }
__device__ __forceinline__ unsigned xb_add(unsigned* p, unsigned v) { return __hip_atomic_fetch_add(p, v, __ATOMIC_RELAXED, __HIP_MEMORY_SCOPE_AGENT); }
__device__ __forceinline__ unsigned xb_xcc_id() { return (unsigned)__builtin_amdgcn_s_getreg((3 << 11) | 20) & 0xFu; }
#define XB_SPIN(cond, bar) do { unsigned _sp = 0; while (cond) { __builtin_amdgcn_s_sleep(1); \
    if ((++_sp & 255u) == 0u) { if (xb_ld(&(bar)[XB_TMO])) break; if (_sp > XB_SPIN_CAP) { atomicAdd(&(bar)[XB_TMO], 1u); break; } } } } while (0)

struct XcdBarrier { unsigned* bar; unsigned x; volatile LAS unsigned* st; };

__device__ __forceinline__ XcdBarrier xcd_barrier_post(unsigned* bar, volatile LAS unsigned* st) {
    XcdBarrier b; b.bar = bar; b.x = xb_xcc_id(); b.st = st;
    if (threadIdx.x == 0) (void)xb_add(&bar[XB_XCNT(b.x)], 1u);
    return b;
}
__device__ __forceinline__ void xcd_barrier_complete(unsigned* bar, unsigned x, unsigned& nloc, unsigned& nx) {
    const unsigned G = gridDim.x * gridDim.y * gridDim.z;
    unsigned sum, cnt, mine, sp = 0u;
    for (;;) {
        sum = 0u; cnt = 0u; mine = 0u;
#pragma unroll
        for (unsigned j = 0; j < 16; ++j) { const unsigned c = xb_ld(&bar[XB_XCNT(j)]); sum += c; cnt += (c > 0u) ? 1u : 0u; mine = (j == x) ? c : mine; }
        if (sum == G) break;
        __builtin_amdgcn_s_sleep(1);
        if ((++sp & 255u) == 0u) { if (xb_ld(&bar[XB_TMO])) break; if (sp > XB_SPIN_CAP) { atomicAdd(&bar[XB_TMO], 1u); break; } }
    }
    nloc = mine > 0u ? mine : 1u; nx = cnt > 0u ? cnt : 1u;
}
__device__ __forceinline__ void xcd_barrier(const XcdBarrier& b) {
    asm volatile("s_waitcnt vmcnt(0)" ::: "memory");
    __syncthreads();
    if (threadIdx.x == 0) {
        unsigned* bar = b.bar;
        __builtin_amdgcn_s_waitcnt(0);
        unsigned nloc = b.st[0], nx = b.st[1];
        if (nloc == 0u) { xcd_barrier_complete(bar, b.x, nloc, nx); b.st[0] = nloc; b.st[1] = nx; }
        const unsigned old = xb_add(&bar[XB_XSUB(b.x)], 1u);
        const unsigned gen = old / nloc;
        if (old + 1u == (gen + 1u) * nloc) {
            __builtin_amdgcn_fence(__ATOMIC_RELEASE, "agent");
            asm volatile("s_waitcnt vmcnt(0)" ::: "memory");
            const unsigned og = xb_add(&bar[XB_TOP], 1u);
            const unsigned tg = og / nx;
            if (og + 1u == (tg + 1u) * nx) xb_add(&bar[XB_TOPGEN], 1u);
            else XB_SPIN(xb_ld(&bar[XB_TOPGEN]) == tg, bar);
            __builtin_amdgcn_fence(__ATOMIC_ACQUIRE, "agent");
            xb_add(&bar[XB_XGEN(b.x)], 1u);
            asm volatile("s_waitcnt vmcnt(0)" ::: "memory");
        } else {
            XB_SPIN(xb_ld(&bar[XB_XGEN(b.x)]) == gen, bar);
            __builtin_amdgcn_fence(__ATOMIC_ACQUIRE, "agent");
            asm volatile("s_waitcnt vmcnt(0)" ::: "memory");
        }
    }
    __syncthreads();
}

typedef _Float16 h8 __attribute__((ext_vector_type(8)));
typedef _Float16 h4 __attribute__((ext_vector_type(4)));
typedef float f4 __attribute__((ext_vector_type(4)));

template <int CTRL> __device__ __forceinline__ float dpp_mov(float v) { return __uint_as_float((unsigned)__builtin_amdgcn_update_dpp(0, (int)__float_as_uint(v), CTRL, 0xf, 0xf, false)); }
__device__ __forceinline__ float wave_sum(float v) {
    v += dpp_mov<0xB1>(v); v += dpp_mov<0x4E>(v); v += dpp_mov<0x141>(v); v += dpp_mov<0x140>(v);
    { auto rr = __builtin_amdgcn_permlane16_swap(__float_as_uint(v), __float_as_uint(v), false, false); v = __uint_as_float(rr[0]) + __uint_as_float(rr[1]); }
    { auto rr = __builtin_amdgcn_permlane32_swap(__float_as_uint(v), __float_as_uint(v), false, false); v = __uint_as_float(rr[0]) + __uint_as_float(rr[1]); }
    return v;
}
__device__ __forceinline__ float wave_max(float v) {
    v = fmaxf(v, dpp_mov<0xB1>(v)); v = fmaxf(v, dpp_mov<0x4E>(v)); v = fmaxf(v, dpp_mov<0x141>(v)); v = fmaxf(v, dpp_mov<0x140>(v));
    { auto rr = __builtin_amdgcn_permlane16_swap(__float_as_uint(v), __float_as_uint(v), false, false); v = fmaxf(__uint_as_float(rr[0]), __uint_as_float(rr[1])); }
    { auto rr = __builtin_amdgcn_permlane32_swap(__float_as_uint(v), __float_as_uint(v), false, false); v = fmaxf(__uint_as_float(rr[0]), __uint_as_float(rr[1])); }
    return v;
}
__device__ __forceinline__ void wave_sync() {
    asm volatile("s_waitcnt lgkmcnt(0)" ::: "memory");
    __builtin_amdgcn_wave_barrier();
}
__device__ __forceinline__ float gelu_tanh(float x) {
    const float u = 0.7978845608028654f * (x + 0.044715f * x * x * x);
    return 0.5f * x * (1.f + tanhf(u));
}
__device__ __forceinline__ float gelu_fast(float x) { const float u = 0.7978845608028654f * (x + 0.044715f * x * x * x); const float t = 1.f - 2.f * __builtin_amdgcn_rcpf(1.f + __builtin_amdgcn_exp2f(2.8853900817779268f * u)); return 0.5f * x * (1.f + t); }
__device__ __forceinline__ float sigmoidf_(float x) { return 1.f / (1.f + expf(-x)); }
__device__ __forceinline__ unsigned pk4_fp8(float a, float b, float c, float d) { int w = 0; w = __builtin_amdgcn_cvt_pk_fp8_f32(a, b, w, false); w = __builtin_amdgcn_cvt_pk_fp8_f32(c, d, w, true); return (unsigned)w; }
__device__ __forceinline__ void dec4_fp8(unsigned w, float& a, float& b, float& c, float& d) { a = __builtin_amdgcn_cvt_f32_fp8((int)w, 0); b = __builtin_amdgcn_cvt_f32_fp8((int)w, 1); c = __builtin_amdgcn_cvt_f32_fp8((int)w, 2); d = __builtin_amdgcn_cvt_f32_fp8((int)w, 3); }
__device__ __forceinline__ float swiglu_fast(float g, float l) { const float xg = fminf(g, 7.f), xl = fminf(fmaxf(l, -7.f), 7.f); return xg * __builtin_amdgcn_rcpf(1.f + __builtin_amdgcn_exp2f(-2.4554669595930156f * xg)) * (xl + 1.f); }

constexpr int G_LD = 40;
template <class AF, class EF>
__device__ __forceinline__ void gemm_tile(char* smem, int K, const AF& af, const float* __restrict__ Bm, int ldb, int n0, int Nlim, bool perm, const EF& ef) {
    _Float16* As = (_Float16*)smem;
    _Float16* Bs = As + 128 * G_LD;
    const int tid = threadIdx.x, lane = tid & 63, wid = tid >> 6, wr = wid >> 2, wc = wid & 3, fr = lane & 15, fq = lane >> 4;
    f4 acc[4][2];
#pragma unroll
    for (int m = 0; m < 4; ++m)
#pragma unroll
        for (int n = 0; n < 2; ++n) acc[m][n] = (f4){0.f, 0.f, 0.f, 0.f};
    const int ar = tid >> 3, ak = (tid & 7) * 4;
    const float* ap0 = af.row(ar);
    const float* ap1 = af.row(ar + 64);
    const int bk = tid >> 5, bn = (tid & 31) * 4;
    const bool bok = (n0 + bn) < Nlim;
    int bnp[4];
#pragma unroll
    for (int i = 0; i < 4; ++i) { const int c = bn + i; bnp[i] = perm ? ((c & ~31) | ((c & 1) << 4) | ((c & 31) >> 1)) : c; }
    for (int k0 = 0; k0 < K; k0 += 32) {
        const int ko = af.koff(k0 + ak);
        float4 a0 = make_float4(0.f, 0.f, 0.f, 0.f), a1 = a0, b0 = a0, b1 = a0;
        if (ap0) a0 = *(const float4*)(ap0 + ko);
        if (ap1) a1 = *(const float4*)(ap1 + ko);
        if (bok) { b0 = *(const float4*)(Bm + (size_t)(k0 + bk) * ldb + n0 + bn); b1 = *(const float4*)(Bm + (size_t)(k0 + bk + 16) * ldb + n0 + bn); }
        __syncthreads();
        *(h4*)&As[ar * G_LD + ak] = (h4){(_Float16)a0.x, (_Float16)a0.y, (_Float16)a0.z, (_Float16)a0.w};
        *(h4*)&As[(ar + 64) * G_LD + ak] = (h4){(_Float16)a1.x, (_Float16)a1.y, (_Float16)a1.z, (_Float16)a1.w};
        Bs[bnp[0] * G_LD + bk] = (_Float16)b0.x; Bs[bnp[1] * G_LD + bk] = (_Float16)b0.y; Bs[bnp[2] * G_LD + bk] = (_Float16)b0.z; Bs[bnp[3] * G_LD + bk] = (_Float16)b0.w;
        Bs[bnp[0] * G_LD + bk + 16] = (_Float16)b1.x; Bs[bnp[1] * G_LD + bk + 16] = (_Float16)b1.y; Bs[bnp[2] * G_LD + bk + 16] = (_Float16)b1.z; Bs[bnp[3] * G_LD + bk + 16] = (_Float16)b1.w;
        __syncthreads();
        h8 a[4], b[2];
#pragma unroll
        for (int m = 0; m < 4; ++m) a[m] = *(const h8*)&As[(wr * 64 + m * 16 + fr) * G_LD + fq * 8];
#pragma unroll
        for (int n = 0; n < 2; ++n) b[n] = *(const h8*)&Bs[(wc * 32 + n * 16 + fr) * G_LD + fq * 8];
#pragma unroll
        for (int m = 0; m < 4; ++m)
#pragma unroll
            for (int n = 0; n < 2; ++n) acc[m][n] = __builtin_amdgcn_mfma_f32_16x16x32_f16(a[m], b[n], acc[m][n], 0, 0, 0);
    }
    ef(acc, wr, wc, fr, fq);
    __syncthreads();
}

struct ARowPlain { const float* base; int ld; int m0; int mlim;
    __device__ __forceinline__ const float* row(int r) const { return (m0 + r) < mlim ? base + (size_t)(m0 + r) * ld : nullptr; }
    __device__ __forceinline__ int koff(int k) const { return k; } };
struct ARowCmp { const float* proj; int col; int m0;
    __device__ __forceinline__ const float* row(int r) const { const int g = m0 + r; if (g >= CROWS) return nullptr; const int kvh = g & 1, bc = g >> 1, b = bc / NC, c = bc % NC;
        return proj + (size_t)(b * S_ + 16 * c) * INW + col + kvh * 128; }
    __device__ __forceinline__ int koff(int k) const { return (k >> 7) * INW + (k & 127); } };
struct ARowList { const float* base; const int* list; int m0; int cnt; int shift;
    __device__ __forceinline__ const float* row(int r) const { if (m0 + r >= cnt) return nullptr; const int a = list[m0 + r]; return base + (size_t)(a >> shift) * 2048; }
    __device__ __forceinline__ int koff(int k) const { return k; } };

struct EpiStore { float* C; int ldc; int m0; int n0; int mlim; int nlim; _Float16* C16;
    __device__ __forceinline__ void operator()(const f4 (&acc)[4][2], int wr, int wc, int fr, int fq) const {
#pragma unroll
        for (int m = 0; m < 4; ++m)
#pragma unroll
            for (int n = 0; n < 2; ++n)
#pragma unroll
                for (int j = 0; j < 4; ++j) { const int r = m0 + wr * 64 + m * 16 + fq * 4 + j, c = n0 + wc * 32 + n * 16 + fr;
                    if (r < mlim && c < nlim) { C[(size_t)r * ldc + c] = acc[m][n][j]; if (C16) C16[(size_t)r * ldc + c] = (_Float16)acc[m][n][j]; } } } };
struct EpiKc { _Float16* C; int m0;
    __device__ __forceinline__ void operator()(const f4 (&acc)[4][2], int wr, int wc, int fr, int fq) const {
#pragma unroll
        for (int m = 0; m < 4; ++m)
#pragma unroll
            for (int n = 0; n < 2; ++n)
#pragma unroll
                for (int j = 0; j < 4; ++j) { const int r = m0 + wr * 64 + m * 16 + fq * 4 + j, c = wc * 32 + n * 16 + fr;
                    C[(size_t)r * 128 + c] = (((r >> 1) & 127) == 127) ? (_Float16)0.f : (_Float16)acc[m][n][j]; } } };
struct EpiPool { _Float16* C; const float* scale; int m0; int g;
    __device__ __forceinline__ void operator()(const f4 (&acc)[4][2], int wr, int wc, int fr, int fq) const {
#pragma unroll
        for (int m = 0; m < 4; ++m)
#pragma unroll
            for (int n = 0; n < 2; ++n)
#pragma unroll
                for (int j = 0; j < 4; ++j) { const int r = m0 + wr * 64 + m * 16 + fq * 4 + j, c = g * 128 + wc * 32 + n * 16 + fr;
                    C[(size_t)r * 512 + c] = (_Float16)(acc[m][n][j] * scale[c]); } } };
struct EpiHid { float* C; const float* bias; int m0; int n0;
    __device__ __forceinline__ void operator()(const f4 (&acc)[4][2], int wr, int wc, int fr, int fq) const {
#pragma unroll
        for (int m = 0; m < 4; ++m)
#pragma unroll
            for (int n = 0; n < 2; ++n)
#pragma unroll
                for (int j = 0; j < 4; ++j) { const int r = m0 + wr * 64 + m * 16 + fq * 4 + j, c = n0 + wc * 32 + n * 16 + fr;
                    if (r < CROWS) C[(size_t)r * 256 + c] = gelu_tanh(acc[m][n][j] + bias[c]); } } };
struct EpiOut { float* C; const float* x; int m0; int n0;
    __device__ __forceinline__ void operator()(const f4 (&acc)[4][2], int wr, int wc, int fr, int fq) const {
#pragma unroll
        for (int m = 0; m < 4; ++m)
#pragma unroll
            for (int n = 0; n < 2; ++n)
#pragma unroll
                for (int j = 0; j < 4; ++j) { const size_t o = (size_t)(m0 + wr * 64 + m * 16 + fq * 4 + j) * 2048 + n0 + wc * 32 + n * 16 + fr;
                    C[o] = DN_ALPHA * x[o] + acc[m][n][j]; } } };
struct EpiGu { float* act; const float* bgu; const int* list; int m0; int cnt; int n0;
    __device__ __forceinline__ void operator()(const f4 (&acc)[4][2], int wr, int wc, int fr, int fq) const {
        const int jc = (n0 + wc * 32) / 2 + fr;
        const float bg = bgu[2 * jc], bl = bgu[2 * jc + 1];
#pragma unroll
        for (int m = 0; m < 4; ++m)
#pragma unroll
            for (int j = 0; j < 4; ++j) { const int r = m0 + wr * 64 + m * 16 + fq * 4 + j;
                if (r < cnt) { const int a = list[r];
                    const float xg = fminf(acc[m][0][j] + bg, 7.f), xl = fminf(fmaxf(acc[m][1][j] + bl, -7.f), 7.f);
                    act[(size_t)a * 2048 + jc] = xg * sigmoidf_(1.702f * xg) * (xl + 1.f); } } } };
struct EpiDn { float* y; const float* bdn; const int* list; const float* gate; int m0; int cnt; int n0;
    __device__ __forceinline__ void operator()(const f4 (&acc)[4][2], int wr, int wc, int fr, int fq) const {
#pragma unroll
        for (int m = 0; m < 4; ++m)
#pragma unroll
            for (int j = 0; j < 4; ++j) { const int r = m0 + wr * 64 + m * 16 + fq * 4 + j;
                if (r < cnt) { const int a = list[r]; const float g = gate[a];
#pragma unroll
                    for (int n = 0; n < 2; ++n) { const int c = n0 + wc * 32 + n * 16 + fr; y[(size_t)a * 2048 + c] = (acc[m][n][j] + bdn[c]) * g; } } } } };

constexpr int WLDS_FLOATS = 4096 + 512 + 32;
template <bool SHARED>
__device__ __forceinline__ void wave_attn(float* sw, const float* __restrict__ qptr, const float* __restrict__ Kb, const float* __restrict__ Vb, int ld, int nseg, float scale, float* __restrict__ optr) {
    const int lane = threadIdx.x & 63;
    float* sq = sw + 4096; const int* segs = (const int*)(sw + 4096 + 512);
#pragma unroll
    for (int i = 0; i < 8; ++i) sq[lane + 64 * i] = qptr[lane + 64 * i];
    wave_sync();
    for (int sg = 0; sg < nseg; ++sg) {
        const int start = segs[sg], len = segs[16 + sg];
        float d0 = 0.f, d1 = 0.f, d2 = 0.f, d3 = 0.f;
        if (lane < len) {
            const float* kp = Kb + (size_t)(start + lane) * ld;
            for (int d4 = 0; d4 < 32; ++d4) {
                if (SHARED) {
                    const float4 kv = *(const float4*)(kp + d4 * 4);
                    const float4 q0 = *(const float4*)(sq + d4 * 4), q1 = *(const float4*)(sq + 128 + d4 * 4), q2 = *(const float4*)(sq + 256 + d4 * 4), q3 = *(const float4*)(sq + 384 + d4 * 4);
                    d0 += kv.x * q0.x + kv.y * q0.y + kv.z * q0.z + kv.w * q0.w;
                    d1 += kv.x * q1.x + kv.y * q1.y + kv.z * q1.z + kv.w * q1.w;
                    d2 += kv.x * q2.x + kv.y * q2.y + kv.z * q2.z + kv.w * q2.w;
                    d3 += kv.x * q3.x + kv.y * q3.y + kv.z * q3.z + kv.w * q3.w;
                } else {
                    const float4 k0 = *(const float4*)(kp + d4 * 4), k1 = *(const float4*)(kp + 128 + d4 * 4), k2 = *(const float4*)(kp + 256 + d4 * 4), k3 = *(const float4*)(kp + 384 + d4 * 4);
                    const float4 q0 = *(const float4*)(sq + d4 * 4), q1 = *(const float4*)(sq + 128 + d4 * 4), q2 = *(const float4*)(sq + 256 + d4 * 4), q3 = *(const float4*)(sq + 384 + d4 * 4);
                    d0 += k0.x * q0.x + k0.y * q0.y + k0.z * q0.z + k0.w * q0.w;
                    d1 += k1.x * q1.x + k1.y * q1.y + k1.z * q1.z + k1.w * q1.w;
                    d2 += k2.x * q2.x + k2.y * q2.y + k2.z * q2.z + k2.w * q2.w;
                    d3 += k3.x * q3.x + k3.y * q3.y + k3.z * q3.z + k3.w * q3.w;
                }
            }
        }
        const bool ok = lane < len;
        sw[sg * 64 + lane] = ok ? d0 * scale : -1e30f;
        sw[1024 + sg * 64 + lane] = ok ? d1 * scale : -1e30f;
        sw[2048 + sg * 64 + lane] = ok ? d2 * scale : -1e30f;
        sw[3072 + sg * 64 + lane] = ok ? d3 * scale : -1e30f;
    }
    wave_sync();
    const int n = nseg * 64;
#pragma unroll
    for (int g = 0; g < 4; ++g) {
        float mx = -1e30f;
        for (int i = lane; i < n; i += 64) mx = fmaxf(mx, sw[g * 1024 + i]);
        mx = wave_max(mx);
        float sm = 0.f;
        for (int i = lane; i < n; i += 64) { const float v = sw[g * 1024 + i]; sm += (v > -1e29f) ? expf(v - mx) : 0.f; }
        sm = wave_sum(sm);
        const float inv = sm > 0.f ? 1.f / sm : 0.f;
        for (int i = lane; i < n; i += 64) { const float v = sw[g * 1024 + i]; sw[g * 1024 + i] = (v > -1e29f) ? expf(v - mx) * inv : 0.f; }
    }
    wave_sync();
    float o[4][2];
#pragma unroll
    for (int g = 0; g < 4; ++g) { o[g][0] = 0.f; o[g][1] = 0.f; }
    for (int sg = 0; sg < nseg; ++sg) {
        const int start = segs[sg], len = segs[16 + sg];
        for (int l = 0; l < len; ++l) {
            const float* vp = Vb + (size_t)(start + l) * ld;
            if (SHARED) {
                const float v0 = vp[lane], v1 = vp[lane + 64];
#pragma unroll
                for (int g = 0; g < 4; ++g) { const float p = sw[g * 1024 + sg * 64 + l]; o[g][0] += p * v0; o[g][1] += p * v1; }
            } else {
#pragma unroll
                for (int g = 0; g < 4; ++g) { const float p = sw[g * 1024 + sg * 64 + l]; o[g][0] += p * vp[g * 128 + lane]; o[g][1] += p * vp[g * 128 + lane + 64]; }
            }
        }
    }
#pragma unroll
    for (int g = 0; g < 4; ++g) { optr[g * 128 + lane] = o[g][0]; optr[g * 128 + lane + 64] = o[g][1]; }
}

namespace g8 {
constexpr int BM = 256, BK = 64, HALF = 128, HTB = HALF * BK * 2, STAGE_BYTES = 8 * HTB;
constexpr int KK = 2048;
typedef float f32x4 __attribute__((ext_vector_type(4)));
__device__ __forceinline__ int lds_byte(int r, int c) { return r * 128 + ((((c >> 3) ^ (r >> 1)) & 7) << 4) + (c & 7) * 2; }
__device__ __forceinline__ void stage_rc(int b, int& R, int& C) { R = b >> 7; C = ((((b >> 4) ^ (R >> 1)) & 7)) * 8; }
__device__ __forceinline__ int perm32(int rho) { const int n = rho >> 4, i = rho & 15; return 8 * (i >> 2) + 4 * n + (i & 3); }

typedef int i32x4 __attribute__((ext_vector_type(4)));
typedef unsigned u32x2 __attribute__((ext_vector_type(2)));
typedef unsigned u32x4 __attribute__((ext_vector_type(4)));
template <bool I8> struct AccSel { typedef f32x4 T; };
template <> struct AccSel<true> { typedef i32x4 T; };
__device__ __forceinline__ f32x4 mma16(i32x4 a, i32x4 b, f32x4 c) { return __builtin_amdgcn_mfma_f32_16x16x32_f16(*reinterpret_cast<h8*>(&a), *reinterpret_cast<h8*>(&b), c, 0, 0, 0); }
__device__ __forceinline__ i32x4 mma16(i32x4 a, i32x4 b, i32x4 c) { return __builtin_amdgcn_mfma_i32_16x16x64_i8(a, b, c, 0, 0, 0); }
struct Unit { int m0, n0, e, cnt, rbase; };
constexpr int EP_OFF = STAGE_BYTES + 2048, EP_LD = 528, EP_GRP = 16 * EP_LD;
constexpr int CONST_OFF = EP_OFF + 18432;
__device__ __forceinline__ void cdma(LAS unsigned char* lds, int region, int idx, const void* src) { __builtin_amdgcn_global_load_lds((const unsigned*)src, (LAS unsigned*)(lds + CONST_OFF + region * 1024 + idx * 256), 4, 0, 0); }
__device__ __forceinline__ void ep_sync() { asm volatile("s_waitcnt lgkmcnt(0)" ::: "memory"); __builtin_amdgcn_s_barrier(); asm volatile("" ::: "memory"); }
__device__ __forceinline__ int ep_tid() { int tz = threadIdx.x; asm volatile("" : "+v"(tz)); return tz; }
__device__ __forceinline__ h8 cvt8(f32x4 a, f32x4 b) { h8 o; o[0] = (_Float16)a[0]; o[1] = (_Float16)a[1]; o[2] = (_Float16)a[2]; o[3] = (_Float16)a[3]; o[4] = (_Float16)b[0]; o[5] = (_Float16)b[1]; o[6] = (_Float16)b[2]; o[7] = (_Float16)b[3]; return o; }

__device__ __forceinline__ void tile_order(int L, int nM, int nN, int& pm, int& pn) {
    const int nwg = nM * nN; int wgid = L;
    { const int q = nwg / 8, r = nwg % 8, xcd = wgid % 8, off = wgid / 8; wgid = (xcd < r ? xcd * (q + 1) : r * (q + 1) + (xcd - r) * q) + off; }
    const int nig = 8 * nN, gid = wgid / nig, fm = gid * 8, gsz = (nM - fm) < 8 ? (nM - fm) : 8;
    pm = fm + ((wgid % nig) % gsz); pn = (wgid % nig) / gsz;
}

template <class Prob>
__device__ __forceinline__ void gemm_phase(LAS unsigned char* lds, const Prob& P) {
    int tidh_ = threadIdx.x; asm volatile("" : "+v"(tidh_));
    const int tid = tidh_, wid = __builtin_amdgcn_readfirstlane(tid >> 6), lane = tid & 63, wr = wid >> 2, wc = wid & 3, fr = lane & 15, fq = lane >> 4;
    constexpr int nt = Prob::NT; constexpr size_t KS2 = Prob::KS2; constexpr unsigned ROWB = Prob::ROWB; constexpr bool I8 = Prob::I8;
    int sR[2], sC2[2]; unsigned voffB[2];
#pragma unroll
    for (int i = 0; i < 2; ++i) { int R, C; stage_rc(tid * 16 + i * 8192, R, C); sR[i] = R; sC2[i] = C * 2; const int Rb = Prob::PERM ? ((R & ~31) + perm32(R & 31)) : R; voffB[i] = (unsigned)Rb * ROWB + (unsigned)C * 2u; }
    const size_t kstep = (size_t)(BK * 2);
    const size_t hstep = (size_t)HALF * ROWB;
    const unsigned ldsw = (unsigned)wid * 1024u;
    const int aoff = lds_byte(wr * 64 + fr, fq * 8), boff = lds_byte(wc * 32 + fr, fq * 8), aoff1 = lds_byte(wr * 64 + fr, fq * 8 + 32), boff1 = lds_byte(wc * 32 + fr, fq * 8 + 32);
#define G8_SA(b, h) (((b) * 2 + (h)) * HTB)
#define G8_SB(b, h) ((4 + (b) * 2 + (h)) * HTB)
#define G8_STAGE(bufoff, gbase, voff) do { _Pragma("unroll") for (int _i = 0; _i < 2; ++_i) \
        __builtin_amdgcn_global_load_lds((const unsigned*)((const char*)(gbase) + (voff)[_i]), (LAS unsigned*)(lds + (bufoff) + ldsw + _i * 8192), 16, 0, 0); } while (0)
#define G8_LDA(dst, b, h) do { _Pragma("unroll") for (int m = 0; m < 4; ++m) _Pragma("unroll") for (int k = 0; k < 2; ++k) dst[m][k] = *(const LAS i32x4*)(lds + G8_SA(b, h) + (k ? aoff1 : aoff) + m * 2048); } while (0)
#define G8_LDB(dst, b, h) do { _Pragma("unroll") for (int n = 0; n < 2; ++n) _Pragma("unroll") for (int k = 0; k < 2; ++k) dst[n][k] = *(const LAS i32x4*)(lds + G8_SB(b, h) + (k ? boff1 : boff) + n * 2048); } while (0)
#define G8_MMA(ai, bj, At, Bt) do { __builtin_amdgcn_s_setprio(1); _Pragma("unroll") for (int m = 0; m < 4; ++m) _Pragma("unroll") for (int n = 0; n < 2; ++n) _Pragma("unroll") for (int k = 0; k < 2; ++k) \
        acc[ai][bj][m][n] = mma16(Bt[n][k], At[m][k], acc[ai][bj][m][n]); __builtin_amdgcn_s_setprio(0); } while (0)
#define G8_WAIT_V(n) asm volatile("s_waitcnt vmcnt(" #n ")" ::: "memory")
#define G8_WAIT_L(n) asm volatile("s_waitcnt lgkmcnt(" #n ")" ::: "memory")
#define G8_BAR __builtin_amdgcn_s_barrier()
#define G8_SCHED __builtin_amdgcn_sched_barrier(0)
    Unit cur, nxt; int ui = 0;
    if (!P.next(0, cur)) return;
    typedef typename AccSel<I8>::T AccT;
    AccT acc[2][2][4][2];
#pragma unroll
    for (int a = 0; a < 2; ++a)
#pragma unroll
        for (int b = 0; b < 2; ++b)
#pragma unroll
            for (int m = 0; m < 4; ++m)
#pragma unroll
                for (int n = 0; n < 2; ++n) acc[a][b][m][n] = AccT{};
    i32x4 At[4][2], B0[2][2], B1[2][2];
    unsigned vc[2][2], vn[2][2];
    P.a_offs(cur, sR, sC2, vc);
    const char* const Ab = P.a_base();
    const char* cB = P.b_base(cur);
    G8_STAGE(G8_SB(0, 0), cB, voffB); G8_STAGE(G8_SA(0, 0), Ab, vc[0]); G8_STAGE(G8_SB(0, 1), cB + hstep, voffB); G8_STAGE(G8_SA(0, 1), Ab, vc[1]);
    if (wr == 1) G8_BAR;
    G8_WAIT_V(4); G8_BAR;
    G8_STAGE(G8_SB(1, 0), cB + kstep, voffB); G8_STAGE(G8_SA(1, 0), Ab + kstep, vc[0]); G8_STAGE(G8_SB(1, 1), cB + hstep + kstep, voffB);
    G8_WAIT_V(6); G8_BAR;
    for (;;) {
        const bool has_next = P.next(ui + 1, nxt);
        const char* nB = cB;
        if (has_next) { P.a_offs(nxt, sR, sC2, vn); nB = P.b_base(nxt); }
        else { vn[0][0] = vc[0][0]; vn[0][1] = vc[0][1]; vn[1][0] = vc[1][0]; vn[1][1] = vc[1][1]; }
        for (int t = 0; t < nt; t += 2) {
            const bool last = (t == nt - 2);
            if constexpr (Prob::CD) { if (last) P.const_dma(cur, lds, wid, lane); }
            const char* a1 = Ab + (size_t)(t >> 1) * KS2 + kstep;
            const char* a2 = last ? Ab : Ab + (size_t)((t + 2) >> 1) * KS2; const char* b2 = last ? nB : cB + (size_t)(t + 2) * kstep;
            const char* a3 = a2 + kstep; const char* b3 = b2 + kstep;
            unsigned o2[2][2];
            o2[0][0] = last ? vn[0][0] : vc[0][0]; o2[0][1] = last ? vn[0][1] : vc[0][1]; o2[1][0] = last ? vn[1][0] : vc[1][0]; o2[1][1] = last ? vn[1][1] : vc[1][1];
            G8_LDB(B0, 0, 0); G8_SCHED; G8_LDA(At, 0, 0); G8_STAGE(G8_SA(1, 1), a1, vc[1]);
            G8_WAIT_L(8); G8_BAR; G8_WAIT_L(0); G8_MMA(0, 0, At, B0); G8_BAR; G8_SCHED;
            G8_LDB(B1, 0, 1); G8_STAGE(G8_SB(0, 0), b2, voffB);
            G8_BAR; G8_WAIT_L(0); G8_MMA(0, 1, At, B1); G8_BAR;
            G8_LDA(At, 0, 1); G8_STAGE(G8_SA(0, 0), a2, o2[0]);
            G8_BAR; G8_WAIT_L(0); G8_MMA(1, 0, At, B0); G8_BAR; G8_SCHED;
            G8_STAGE(G8_SB(0, 1), b2 + hstep, voffB);
            G8_WAIT_V(6); G8_BAR; G8_MMA(1, 1, At, B1); G8_BAR;
            G8_LDB(B0, 1, 0); G8_SCHED; G8_LDA(At, 1, 0); G8_STAGE(G8_SA(0, 1), a2, o2[1]);
            G8_WAIT_L(8); G8_BAR; G8_WAIT_L(0); G8_MMA(0, 0, At, B0); G8_BAR; G8_SCHED;
            G8_LDB(B1, 1, 1); G8_STAGE(G8_SB(1, 0), b3, voffB);
            G8_BAR; G8_WAIT_L(0); G8_MMA(0, 1, At, B1); G8_BAR;
            G8_LDA(At, 1, 1); G8_STAGE(G8_SA(1, 0), a3, o2[0]);
            G8_BAR; G8_WAIT_L(0); G8_MMA(1, 0, At, B0); G8_BAR; G8_SCHED;
            G8_STAGE(G8_SB(1, 1), b3 + hstep, voffB);
            G8_WAIT_V(6); G8_BAR; G8_MMA(1, 1, At, B1); G8_BAR;
        }
        P.epi(acc, cur, wr, wc, fr, fq, lds);
        if (!has_next) break;
#pragma unroll
        for (int a = 0; a < 2; ++a)
#pragma unroll
            for (int b = 0; b < 2; ++b)
#pragma unroll
                for (int m = 0; m < 4; ++m)
#pragma unroll
                    for (int n = 0; n < 2; ++n) acc[a][b][m][n] = AccT{};
        cur = nxt; cB = nB; ++ui;
        vc[0][0] = vn[0][0]; vc[0][1] = vn[0][1]; vc[1][0] = vn[1][0]; vc[1][1] = vn[1][1];
    }
    G8_WAIT_V(0);
    if (wr == 0) G8_BAR;
    G8_BAR;
#undef G8_SA
#undef G8_SB
#undef G8_STAGE
#undef G8_LDA
#undef G8_LDB
#undef G8_MMA
#undef G8_WAIT_V
#undef G8_WAIT_L
#undef G8_BAR
#undef G8_SCHED
}

struct ProbInF {
    static constexpr bool CD = false;
    static constexpr unsigned ROWB = 4096; static constexpr bool I8 = false;
    static constexpr int NT = 32; static constexpr size_t KS2 = 256;
    static constexpr bool PERM = true;
    const _Float16* A; _Float16* C16; int G, c;
    __device__ __forceinline__ bool next(int i, Unit& u) const { const int L = i * G + c; if (L >= 64 * 5) return false;
        int pm, pn; tile_order(L, 64, 5, pm, pn); u.m0 = pm * 256; u.n0 = pn * 256; u.e = 0; u.cnt = 256; u.rbase = 0; return true; }
    __device__ __forceinline__ void a_offs(const Unit& u, const int (&R)[2], const int (&C2)[2], unsigned (&v)[2][2]) const {
#pragma unroll
        for (int h = 0; h < 2; ++h)
#pragma unroll
            for (int i = 0; i < 2; ++i) v[h][i] = (unsigned)(u.m0 + h * 128 + R[i]) * (unsigned)(KK * 2) + (unsigned)C2[i]; }
    __device__ __forceinline__ const char* a_base() const { return (const char*)A; }
    __device__ __forceinline__ const char* b_base(const Unit& u) const { return (const char*)A + (long long)(WS_WTIN - WS_X16) + (size_t)u.n0 * KK * 2; }
    __device__ __forceinline__ void epi(const f32x4 (&acc)[2][2][4][2], const Unit& u, int wr, int wc, int fr, int fq, LAS unsigned char* lds) const {
        LAS unsigned char* ep = lds + EP_OFF + wr * EP_GRP;
        const int tg = ep_tid() & 255, rrow = tg >> 4, ch = tg & 15;
        const int kvseg = (u.e == 0 && u.n0 >= 1024 && u.n0 < 2560) ? ((u.n0 - 1024) >> 8) : -1;
        _Float16* const Cb = (_Float16*)((char*)C16 + (u.e ? (long long)(WS_KVMEM16 - WS_PROJ16) : 0ll)); const int ldc = u.e ? 1024 : INW, nlim = u.e ? 1024 : INW, mb = u.e ? u.m0 - T_ : u.m0;
#pragma unroll
        for (int ai = 0; ai < 2; ++ai)
#pragma unroll
            for (int m = 0; m < 4; ++m) {
#pragma unroll
                for (int bj = 0; bj < 2; ++bj) *(LAS h8*)(ep + fr * EP_LD + (bj * 128 + wc * 32 + fq * 8) * 2) = cvt8(acc[ai][bj][m][0], acc[ai][bj][m][1]);
                ep_sync();
                const h8 x0 = *(const LAS h8*)(ep + rrow * EP_LD + ch * 32), x1 = *(const LAS h8*)(ep + rrow * EP_LD + ch * 32 + 16);
                const int grow = mb + ai * 128 + wr * 64 + m * 16 + rrow, gcol = u.n0 + ch * 16;
                if (kvseg >= 0) {
                    _Float16* dst = (_Float16*)((char*)C16 + (long long)(WS_KV16 - WS_PROJ16)) + ((size_t)(kvseg * B_ + (grow >> 11)) * 2 + (ch >> 3)) * KVSEG + (size_t)(grow & (S_ - 1)) * 128 + (ch & 7) * 16;
                    *(h8*)dst = x0; *(h8*)(dst + 8) = x1;
                } else {
                    if (gcol < nlim) *(h8*)(Cb + (size_t)grow * ldc + gcol) = x0;
                    if (gcol + 8 < nlim) *(h8*)(Cb + (size_t)grow * ldc + gcol + 8) = x1; }
                ep_sync();
            } }
};
struct ProbIn8 {
    static constexpr bool CD = true;
    static constexpr unsigned ROWB = 2048; static constexpr bool I8 = true;
    static constexpr int NT = 16; static constexpr size_t KS2 = 256;
    static constexpr bool PERM = true;
    const signed char* A; _Float16* C16; const float* sa; int G, c;
    __device__ __forceinline__ bool next(int i, Unit& u) const { const int L = i * G + c; if (L >= 640 + 32) return false;
        if (L < 640) { int pm, pn; tile_order(L, 64, 10, pm, pn); u.m0 = pm * 256; u.n0 = 1280 + pn * 256; u.e = 0; }
        else { const int v = L - 640; u.m0 = T_ + (v & 7) * 256; u.n0 = (v >> 3) * 256; u.e = 1; }
        u.cnt = 256; u.rbase = 0; return true; }
    __device__ __forceinline__ void a_offs(const Unit& u, const int (&R)[2], const int (&C2)[2], unsigned (&v)[2][2]) const {
#pragma unroll
        for (int h = 0; h < 2; ++h)
#pragma unroll
            for (int i = 0; i < 2; ++i) v[h][i] = (unsigned)(u.m0 + h * 128 + R[i]) * 2048u + (unsigned)C2[i]; }
    __device__ __forceinline__ const char* a_base() const { return (const char*)A; }
    __device__ __forceinline__ const char* b_base(const Unit& u) const { return (const char*)A + (u.e ? (long long)(WS_Q8MKV - WS_X8) + (long long)u.n0 * 2048 : (long long)(WS_Q8IN - WS_X8) + (long long)(u.n0 - 1280) * 2048); }
    __device__ __forceinline__ void const_dma(const Unit& u, LAS unsigned char* lds, int wid, int lane) const {
        const int i4 = wid & 3;
        if (wid < 4) cdma(lds, 1, i4, (const float*)((const char*)A + (u.e ? (long long)(WS_SMKV - WS_X8) : (long long)(WS_SIN8 - WS_X8))) + (u.e ? u.n0 : u.n0 - 1280) + i4 * 64 + lane);
        else cdma(lds, 2, i4, sa + u.m0 + i4 * 64 + lane);
    }
    __device__ __forceinline__ void epi(const i32x4 (&acc)[2][2][4][2], const Unit& u, int wr, int wc, int fr, int fq, LAS unsigned char* lds) const {
        asm volatile("s_waitcnt vmcnt(16)" ::: "memory");
        ep_sync();
        LAS unsigned char* ep = lds + EP_OFF + wr * EP_GRP;
        const int tg = ep_tid() & 255, rrow = tg >> 4, ch = tg & 15;
        const int kvseg = (u.e == 0 && u.n0 >= 1024 && u.n0 < 2560) ? ((u.n0 - 1024) >> 8) : -1;
        _Float16* const Cb = (_Float16*)((char*)C16 + (u.e ? (long long)(WS_KVMEM16 - WS_PROJ16) : 0ll)); const int ldc = u.e ? 1024 : INW, nlim = u.e ? 1024 : INW, mb = u.e ? u.m0 - T_ : u.m0;
        const LAS float* cst = (const LAS float*)(lds + CONST_OFF);
        f32x4 s0[2], s1[2]; float srv[8];
#pragma unroll
        for (int bj = 0; bj < 2; ++bj) { const int col = bj * 128 + wc * 32 + fq * 8; s0[bj] = *(const LAS f32x4*)(cst + 256 + col); s1[bj] = *(const LAS f32x4*)(cst + 256 + col + 4); }
#pragma unroll
        for (int q = 0; q < 8; ++q) srv[q] = cst[512 + (q >> 2) * 128 + wr * 64 + (q & 3) * 16 + fr];
#pragma unroll
        for (int ai = 0; ai < 2; ++ai)
#pragma unroll
            for (int m = 0; m < 4; ++m) { const float sr = srv[ai * 4 + m];
#pragma unroll
                for (int bj = 0; bj < 2; ++bj) { const i32x4 i0 = acc[ai][bj][m][0], i1 = acc[ai][bj][m][1];
                    *(LAS h8*)(ep + fr * EP_LD + (bj * 128 + wc * 32 + fq * 8) * 2) = cvt8((f32x4){(float)i0[0], (float)i0[1], (float)i0[2], (float)i0[3]} * (s0[bj] * sr), (f32x4){(float)i1[0], (float)i1[1], (float)i1[2], (float)i1[3]} * (s1[bj] * sr)); }
                ep_sync();
                const h8 x0 = *(const LAS h8*)(ep + rrow * EP_LD + ch * 32), x1 = *(const LAS h8*)(ep + rrow * EP_LD + ch * 32 + 16);
                const int grow = mb + ai * 128 + wr * 64 + m * 16 + rrow, gcol = u.n0 + ch * 16;
                if (kvseg >= 0) {
                    _Float16* dst = (_Float16*)((char*)C16 + (long long)(WS_KV16 - WS_PROJ16)) + ((size_t)(kvseg * B_ + (grow >> 11)) * 2 + (ch >> 3)) * KVSEG + (size_t)(grow & (S_ - 1)) * 128 + (ch & 7) * 16;
                    *(h8*)dst = x0; *(h8*)(dst + 8) = x1;
                } else {
                    if (gcol < nlim) *(h8*)(Cb + (size_t)grow * ldc + gcol) = x0;
                    if (gcol + 8 < nlim) *(h8*)(Cb + (size_t)grow * ldc + gcol + 8) = x1; }
                ep_sync();
            } }
};
struct ProbOut {
    static constexpr bool CD = false;
    static constexpr unsigned ROWB = 2048; static constexpr bool I8 = true;
    static constexpr int NT = 16; static constexpr size_t KS2 = 256;
    static constexpr bool PERM = true;
    const signed char* A; const signed char* Bt; _Float16* C; const _Float16* X; const float* sa; const float* sw; int G, c;
    __device__ __forceinline__ bool next(int i, Unit& u) const { const int L = i * G + c; if (L >= 64 * 8) return false; int pm, pn; tile_order(L, 64, 8, pm, pn); u.m0 = pm * 256; u.n0 = pn * 256; u.e = 0; u.cnt = 256; u.rbase = 0; return true; }
    __device__ __forceinline__ void a_offs(const Unit& u, const int (&R)[2], const int (&C2)[2], unsigned (&v)[2][2]) const {
#pragma unroll
        for (int h = 0; h < 2; ++h)
#pragma unroll
            for (int i = 0; i < 2; ++i) v[h][i] = (unsigned)(u.m0 + h * 128 + R[i]) * 2048u + (unsigned)C2[i]; }
    __device__ __forceinline__ const char* a_base() const { return (const char*)A; }
    __device__ __forceinline__ const char* b_base(const Unit& u) const { return (const char*)(Bt + (size_t)u.n0 * 2048); }
    __device__ __forceinline__ void epi(const i32x4 (&acc)[2][2][4][2], const Unit& u, int wr, int wc, int fr, int fq, LAS unsigned char* lds) const {
        LAS unsigned char* ep = lds + EP_OFF + wr * EP_GRP;
        const int tg = ep_tid() & 255, rrow = tg >> 4, ch = tg & 15;
        f32x4 s0[2], s1[2]; float srv[8];
#pragma unroll
        for (int bj = 0; bj < 2; ++bj) { const int col = u.n0 + bj * 128 + wc * 32 + fq * 8; s0[bj] = *(const f32x4*)(sw + col); s1[bj] = *(const f32x4*)(sw + col + 4); }
#pragma unroll
        for (int q = 0; q < 8; ++q) srv[q] = sa[u.m0 + (q >> 2) * 128 + wr * 64 + (q & 3) * 16 + fr];
#pragma unroll
        for (int ai = 0; ai < 2; ++ai)
#pragma unroll
            for (int m = 0; m < 4; ++m) { const float sr = srv[ai * 4 + m];
#pragma unroll
                for (int bj = 0; bj < 2; ++bj) { const i32x4 i0 = acc[ai][bj][m][0], i1 = acc[ai][bj][m][1];
                    *(LAS h8*)(ep + fr * EP_LD + (bj * 128 + wc * 32 + fq * 8) * 2) = cvt8((f32x4){(float)i0[0], (float)i0[1], (float)i0[2], (float)i0[3]} * (s0[bj] * sr), (f32x4){(float)i1[0], (float)i1[1], (float)i1[2], (float)i1[3]} * (s1[bj] * sr)); }
                const size_t go = (size_t)(u.m0 + ai * 128 + wr * 64 + m * 16 + rrow) * 2048 + u.n0 + ch * 16;
                const h8 r0 = *(const h8*)(X + go), r1 = *(const h8*)(X + go + 8);
                ep_sync();
                const h8 x0 = *(const LAS h8*)(ep + rrow * EP_LD + ch * 32), x1 = *(const LAS h8*)(ep + rrow * EP_LD + ch * 32 + 16);
                h8 o0, o1;
#pragma unroll
                for (int q = 0; q < 8; ++q) { o0[q] = (_Float16)(DN_ALPHA * (float)r0[q] + (float)x0[q]); o1[q] = (_Float16)(DN_ALPHA * (float)r1[q] + (float)x1[q]); }
                *(h8*)(C + go) = o0; *(h8*)(C + go + 8) = o1;
                ep_sync();
            } }
};
struct ProbCmp {
    static constexpr bool CD = false;
    static constexpr unsigned ROWB = 4096; static constexpr bool I8 = false;
    static constexpr int NT = 8; static constexpr size_t KS2 = 256;
    static constexpr bool PERM = false;
    const _Float16* A; const _Float16* Bt; float* C; int G, c;
    __device__ __forceinline__ bool next(int i, Unit& u) const { const int L = i * G + c; if (L >= 128) return false;
        u.e = L >> 6; const int r = L & 63; u.rbase = r & 3; u.n0 = ((r >> 2) & 1) * 256; u.m0 = (r >> 3) * 256; u.cnt = 256; return true; }
    __device__ __forceinline__ void a_offs(const Unit& u, const int (&R)[2], const int (&C2)[2], unsigned (&v)[2][2]) const {
#pragma unroll
        for (int h = 0; h < 2; ++h)
#pragma unroll
            for (int i = 0; i < 2; ++i) { const int row = u.m0 + h * 128 + R[i], kvh = row & 1, bj = row >> 1, b = bj >> 7, j = bj & 127;
                v[h][i] = (unsigned)((((u.e * B_ + b) * 2 + kvh) * S_ + 16 * j + 4 * u.rbase) * 128) * 2u + (unsigned)C2[i]; } }
    __device__ __forceinline__ const char* a_base() const { return (const char*)A; }
    __device__ __forceinline__ const char* b_base(const Unit& u) const { return (const char*)(Bt + ((size_t)u.e * 512 + u.n0) * KK + u.rbase * 512); }
    __device__ __forceinline__ void epi(const f32x4 (&acc)[2][2][4][2], const Unit& u, int wr, int wc, int fr, int fq, LAS unsigned char*) const {
        float* base = C + ((size_t)(u.e * 4 + u.rbase) * 2048) * 512;
#pragma unroll
        for (int ai = 0; ai < 2; ++ai)
#pragma unroll
            for (int m = 0; m < 4; ++m) { const int row = u.m0 + ai * 128 + wr * 64 + m * 16 + fr;
#pragma unroll
                for (int bj = 0; bj < 2; ++bj)
#pragma unroll
                    for (int n = 0; n < 2; ++n) { const int col = u.n0 + bj * 128 + wc * 32 + n * 16 + fq * 4;
                        *(f32x4*)(base + (size_t)row * 512 + col) = acc[ai][bj][m][n]; } } }
};
struct MoeTab { const LAS int* t; int NT; int i0, i1;
    __device__ __forceinline__ bool find_i(int i, Unit& u) const {
        if (i + i0 >= i1) return false;
        const LAS int* q = t + 128 + 8 * (i + i0);
        if (__builtin_amdgcn_readfirstlane(q[5]) == 0) return false;
        u.e = __builtin_amdgcn_readfirstlane(q[0]); u.m0 = __builtin_amdgcn_readfirstlane(q[1]); u.n0 = __builtin_amdgcn_readfirstlane(q[2]); u.cnt = __builtin_amdgcn_readfirstlane(q[3]); u.rbase = __builtin_amdgcn_readfirstlane(q[4]); return true; } };
__device__ __forceinline__ void moe_build(LAS int* t, int G, int vcu) {
    const int i = threadIdx.x;
    if (i < 40) { const int L = i * G + vcu; LAS int* q = t + 128 + 8 * i;
        if (L >= t[98]) q[5] = 0;
        else { int e = 0; for (; e < NE - 1; ++e) { if (L < t[32 + e + 1]) break; }
            const int ub = t[32 + e], cn = t[e], rs = t[65 + e]; const int nm = (cn + 255) >> 8, v = L - ub, mt = v % nm, ntile = v / nm;
            q[0] = e; q[1] = mt * 256; q[2] = ntile * 256; q[3] = min(256, cn - mt * 256); q[4] = rs; q[5] = 1; } }
}
struct ProbGu {
    static constexpr int NT = 16; static constexpr size_t KS2 = 256; static constexpr unsigned ROWB = 2048; static constexpr bool I8 = true;
    static constexpr bool PERM = true; static constexpr bool CD = true;
    const signed char* A; const signed char* Bt; unsigned char* act; const float* bgu; const int* list; const float* sa; const float* sw; MoeTab tab; int G, vcu;
    __device__ __forceinline__ bool next(int i, Unit& u) const { return tab.find_i(i, u); }
    __device__ __forceinline__ void a_offs(const Unit& u, const int (&R)[2], const int (&C2)[2], unsigned (&v)[2][2]) const {
#pragma unroll
        for (int h = 0; h < 2; ++h)
#pragma unroll
            for (int i = 0; i < 2; ++i) { int r = h * 128 + R[i]; r = r < u.cnt ? r : 0; const int a = list[(size_t)u.e * T_ + u.m0 + r]; v[h][i] = (unsigned)(a >> 2) * 2048u + (unsigned)C2[i]; } }
    __device__ __forceinline__ const char* a_base() const { return (const char*)A; }
    __device__ __forceinline__ const char* b_base(const Unit& u) const { return (const char*)(Bt + ((size_t)u.e * 4096 + u.n0) * 2048); }
    __device__ __forceinline__ void const_dma(const Unit& u, LAS unsigned char* lds, int wid, int lane) const {
        if (wid < 4) { cdma(lds, 0, wid, bgu + (size_t)u.e * 4096 + u.n0 + wid * 64 + lane); const int r = wid * 64 + lane; cdma(lds, 2, wid, sa + (size_t)u.e * T_ + u.m0 + (r < u.cnt ? r : 0)); }
        else cdma(lds, 1, wid - 4, sw + (size_t)u.e * 4096 + u.n0 + (wid - 4) * 64 + lane);
    }
    __device__ __forceinline__ void epi(const i32x4 (&acc)[2][2][4][2], const Unit& u, int wr, int wc, int fr, int fq, LAS unsigned char* lds) const {
        asm volatile("s_waitcnt vmcnt(16)" ::: "memory");
        ep_sync();
        const LAS float* cst = (const LAS float*)(lds + CONST_OFF);
        const int tg = ep_tid() & 255, rrow = tg >> 4, ch = tg & 15;
        f32x4 b0[2], b1[2], s0[2], s1[2];
#pragma unroll
        for (int bj = 0; bj < 2; ++bj) { const int col = bj * 128 + wc * 32 + fq * 8;
            b0[bj] = *(const LAS f32x4*)(cst + col); b1[bj] = *(const LAS f32x4*)(cst + col + 4); s0[bj] = *(const LAS f32x4*)(cst + 256 + col); s1[bj] = *(const LAS f32x4*)(cst + 256 + col + 4); }
        float srv[8];
#pragma unroll
        for (int q = 0; q < 8; ++q) srv[q] = cst[512 + (q >> 2) * 128 + wr * 64 + (q & 3) * 16 + fr];
        LAS unsigned char* ep2 = lds + EP_OFF + wr * (2 * 4608);
#define GU_WRITE(st) do { const int ai_ = (st) >> 1, mp_ = (st) & 1; LAS unsigned char* eb = ep2 + ((st) & 1) * 4608; \
            _Pragma("unroll") for (int mm = 0; mm < 2; ++mm) { const int m_ = mp_ * 2 + mm; const float sr = srv[ai_ * 4 + m_]; \
                _Pragma("unroll") for (int bj = 0; bj < 2; ++bj) { const i32x4 i0 = acc[ai_][bj][m_][0], i1 = acc[ai_][bj][m_][1]; \
                    const f32x4 v0 = (f32x4){(float)i0[0], (float)i0[1], (float)i0[2], (float)i0[3]} * (s0[bj] * sr) + b0[bj], v1 = (f32x4){(float)i1[0], (float)i1[1], (float)i1[2], (float)i1[3]} * (s1[bj] * sr) + b1[bj]; \
                    *(LAS unsigned*)(eb + (mm * 16 + fr) * 144 + (bj * 64 + wc * 16 + fq * 4)) = pk4_fp8(swiglu_fast(v0[0], v0[1]), swiglu_fast(v0[2], v0[3]), swiglu_fast(v1[0], v1[1]), swiglu_fast(v1[2], v1[3])); } } } while (0)
        GU_WRITE(0);
        ep_sync();
#pragma unroll
        for (int st = 0; st < 4; ++st) {
            if (st + 1 < 4) GU_WRITE(st + 1);
#pragma unroll
            for (int mm = 0; mm < 2; ++mm) { const u32x2 x0 = *(const LAS u32x2*)(ep2 + (st & 1) * 4608 + (mm * 16 + rrow) * 144 + ch * 8);
                const int rr = (st >> 1) * 128 + wr * 64 + ((st & 1) * 2 + mm) * 16 + rrow;
                if (rr < u.cnt) *(u32x2*)(act + (size_t)(u.rbase + u.m0 + rr) * 2048 + (u.n0 >> 1) + ch * 8) = x0; }
            ep_sync();
        }
#undef GU_WRITE
    }
};
struct ProbDn {
    static constexpr int NT = 16; static constexpr size_t KS2 = 256; static constexpr unsigned ROWB = 2048; static constexpr bool I8 = true;
    static constexpr bool PERM = true; static constexpr bool CD = true;
    const signed char* A; const signed char* Bt; unsigned char* y; const float* bdn; const int* list; const float* gate; const float* sa; const float* sw; MoeTab tab; int G, vcu;
    __device__ __forceinline__ bool next(int i, Unit& u) const { return tab.find_i(i, u); }
    __device__ __forceinline__ void a_offs(const Unit& u, const int (&R)[2], const int (&C2)[2], unsigned (&v)[2][2]) const {
#pragma unroll
        for (int h = 0; h < 2; ++h)
#pragma unroll
            for (int i = 0; i < 2; ++i) v[h][i] = (unsigned)(u.rbase + u.m0 + h * 128 + R[i]) * 2048u + (unsigned)C2[i]; }
    __device__ __forceinline__ const char* a_base() const { return (const char*)A; }
    __device__ __forceinline__ const char* b_base(const Unit& u) const { return (const char*)(Bt + ((size_t)u.e * 2048 + u.n0) * 2048); }
    __device__ __forceinline__ void const_dma(const Unit& u, LAS unsigned char* lds, int wid, int lane) const {
        const int i4 = wid & 3, r = i4 * 64 + lane, rc = r < u.cnt ? r : 0;
        if (wid < 4) { cdma(lds, 0, i4, bdn + (size_t)u.e * 2048 + u.n0 + r); cdma(lds, 2, i4, sa + u.rbase + u.m0 + rc); cdma(lds, 4, i4, list + (size_t)u.e * T_ + u.m0 + rc); }
        else { cdma(lds, 1, i4, sw + (size_t)u.e * 2048 + u.n0 + r); cdma(lds, 3, i4, gate + (size_t)u.e * T_ + u.m0 + rc); }
    }
    __device__ __forceinline__ void epi(const i32x4 (&acc)[2][2][4][2], const Unit& u, int wr, int wc, int fr, int fq, LAS unsigned char* lds) const {
        asm volatile("s_waitcnt vmcnt(16)" ::: "memory");
        ep_sync();
        const LAS float* cst = (const LAS float*)(lds + CONST_OFF);
        LAS unsigned char* ep = lds + EP_OFF + wr * (2 * 4352);
        const int tg = ep_tid() & 255, rrow = tg >> 4, ch = tg & 15;
        f32x4 b0[2], b1[2], s0[2], s1[2];
#pragma unroll
        for (int bj = 0; bj < 2; ++bj) { const int col = bj * 128 + wc * 32 + fq * 8;
            b0[bj] = *(const LAS f32x4*)(cst + col); b1[bj] = *(const LAS f32x4*)(cst + col + 4); s0[bj] = *(const LAS f32x4*)(cst + 256 + col); s1[bj] = *(const LAS f32x4*)(cst + 256 + col + 4); }
        float gv[8], srv[8]; int a2v[8];
#pragma unroll
        for (int q = 0; q < 8; ++q) { const int rl = (q >> 2) * 128 + wr * 64 + (q & 3) * 16 + fr; gv[q] = cst[768 + rl]; srv[q] = cst[512 + rl];
            a2v[q] = ((const LAS int*)cst)[1024 + (q >> 2) * 128 + wr * 64 + (q & 3) * 16 + rrow]; }
#define DN_WRITE(st) do { const int ai_ = (st) >> 2, m_ = (st) & 3; const float g = gv[st] * 16.f, sr = srv[st]; LAS unsigned char* eb = ep + ((st) & 1) * 4352; \
            _Pragma("unroll") for (int bj = 0; bj < 2; ++bj) { const i32x4 i0 = acc[ai_][bj][m_][0], i1 = acc[ai_][bj][m_][1]; \
                const f32x4 v0 = ((f32x4){(float)i0[0], (float)i0[1], (float)i0[2], (float)i0[3]} * (s0[bj] * sr) + b0[bj]) * g, v1 = ((f32x4){(float)i1[0], (float)i1[1], (float)i1[2], (float)i1[3]} * (s1[bj] * sr) + b1[bj]) * g; \
                u32x2 o; o[0] = pk4_fp8(__builtin_amdgcn_fmed3f(v0[0], -440.f, 440.f), __builtin_amdgcn_fmed3f(v0[1], -440.f, 440.f), __builtin_amdgcn_fmed3f(v0[2], -440.f, 440.f), __builtin_amdgcn_fmed3f(v0[3], -440.f, 440.f)); o[1] = pk4_fp8(__builtin_amdgcn_fmed3f(v1[0], -440.f, 440.f), __builtin_amdgcn_fmed3f(v1[1], -440.f, 440.f), __builtin_amdgcn_fmed3f(v1[2], -440.f, 440.f), __builtin_amdgcn_fmed3f(v1[3], -440.f, 440.f)); \
                *(LAS u32x2*)(eb + fr * 272 + (bj * 128 + wc * 32 + fq * 8)) = o; } } while (0)
        DN_WRITE(0);
        ep_sync();
#pragma unroll
        for (int st = 0; st < 8; ++st) {
            if (st + 1 < 8) DN_WRITE(st + 1);
            const int rr = (st >> 2) * 128 + wr * 64 + (st & 3) * 16 + rrow;
            const u32x4 x0 = *(const LAS u32x4*)(ep + (st & 1) * 4352 + rrow * 272 + ch * 16);
            if (rr < u.cnt) *(u32x4*)(y + (size_t)a2v[st] * 2048 + u.n0 + ch * 16) = x0;
            ep_sync();
        }
#undef DN_WRITE
    }
};
}

namespace at8 {
typedef float f32x16 __attribute__((ext_vector_type(16)));
typedef short s16x4 __attribute__((ext_vector_type(4)));
typedef unsigned u32x4 __attribute__((ext_vector_type(4)));
constexpr int SHM_K = 64 * 128 * 2, SHM_V = 64 * 128 * 2, SLOT = SHM_K + SHM_V;
constexpr int NSLOT = 4;
constexpr int LDS_WS = NSLOT * SLOT;
constexpr int LDS_END = LDS_WS + 8 * 64 * 4;
constexpr float CEXP = ATT_SCALE * 1.4426950408889634f;
constexpr float THR_RAW = 8.f / ATT_SCALE;
#define AT_KSWZ(row, colB) ((row) * 256 + ((colB) ^ (((row) & 7) << 4)))
#define AT_SBAR() __builtin_amdgcn_sched_barrier(0)
__device__ __forceinline__ int crow(int r, int hi) { return (r & 3) + 8 * (r >> 2) + 4 * hi; }
__device__ __forceinline__ unsigned cvtpk(float lo, float hi) { auto v = __builtin_amdgcn_cvt_pkrtz(lo, hi); return *reinterpret_cast<unsigned*>(&v); }
__device__ __forceinline__ int v_st(int k, int c) { const int kk = (k & ~0xC) | ((k & 4) << 1) | ((k & 8) >> 1); return ((kk >> 3) * 4 + (c >> 5)) * 512 + ((kk & 7) * 32 + (c & 31)) * 2; }
__device__ __forceinline__ int v_rd_base(int lane) { return ((lane & 3) << 3) | (((lane >> 2) & 3) << 6) | (((lane >> 4) & 1) << 5) | (((lane >> 5) & 1) << 8); }
constexpr int v_rd_off(int d0, int ks, int half) { return d0 * 512 + ks * 4096 + half * 2048; }
template <int OFF> __device__ __forceinline__ s16x4 tr_read(int vb) { s16x4 r; asm volatile("ds_read_b64_tr_b16 %0, %1 offset:%2" : "=&v"(r) : "v"(vb), "i"(OFF) : "memory"); return r; }
__device__ __forceinline__ h8 mk8(s16x4 l, s16x4 h) { typedef short s16x8 __attribute__((ext_vector_type(8))); s16x8 w = {l[0], l[1], l[2], l[3], h[0], h[1], h[2], h[3]}; return *reinterpret_cast<h8*>(&w); }
template <int D0> __device__ __forceinline__ void pv_one(f32x16& od, int vb, h8 pa0, h8 pa1, h8 pa2, h8 pa3) {
    const s16x4 l0 = tr_read<v_rd_off(D0, 0, 0)>(vb), h0 = tr_read<v_rd_off(D0, 0, 1)>(vb), l1 = tr_read<v_rd_off(D0, 1, 0)>(vb), h1 = tr_read<v_rd_off(D0, 1, 1)>(vb);
    const s16x4 l2 = tr_read<v_rd_off(D0, 2, 0)>(vb), h2 = tr_read<v_rd_off(D0, 2, 1)>(vb), l3 = tr_read<v_rd_off(D0, 3, 0)>(vb), h3 = tr_read<v_rd_off(D0, 3, 1)>(vb);
    asm volatile("s_waitcnt lgkmcnt(0)" ::: "memory"); AT_SBAR();
    od = __builtin_amdgcn_mfma_f32_32x32x16_f16(pa0, mk8(l0, h0), od, 0, 0, 0);
    od = __builtin_amdgcn_mfma_f32_32x32x16_f16(pa1, mk8(l1, h1), od, 0, 0, 0);
    od = __builtin_amdgcn_mfma_f32_32x32x16_f16(pa2, mk8(l2, h2), od, 0, 0, 0);
    od = __builtin_amdgcn_mfma_f32_32x32x16_f16(pa3, mk8(l3, h3), od, 0, 0, 0);
}
__device__ __forceinline__ void pv_d0(f32x16 (&o)[4], int vb, h8 pa0, h8 pa1, h8 pa2, h8 pa3) {
    pv_one<0>(o[0], vb, pa0, pa1, pa2, pa3); pv_one<1>(o[1], vb, pa0, pa1, pa2, pa3); pv_one<2>(o[2], vb, pa0, pa1, pa2, pa3); pv_one<3>(o[3], vb, pa0, pa1, pa2, pa3);
}
__device__ __forceinline__ void qkt(f32x16& p0, f32x16& p1, const char* Ks, const h8 (&qr)[8], int r32, int hi) {
    p0 = f32x16{}; p1 = f32x16{};
#pragma unroll
    for (int d0 = 0; d0 < 8; ++d0) { const int cb = (d0 * 16 + hi * 8) * 2;
        const h8 b0 = *reinterpret_cast<const h8*>(Ks + AT_KSWZ(r32, cb));
        const h8 b1 = *reinterpret_cast<const h8*>(Ks + AT_KSWZ(32 + r32, cb));
        p0 = __builtin_amdgcn_mfma_f32_32x32x16_f16(b0, qr[d0], p0, 0, 0, 0);
        p1 = __builtin_amdgcn_mfma_f32_32x32x16_f16(b1, qr[d0], p1, 0, 0, 0); }
}
__device__ __forceinline__ void pack_p(const f32x16& p0, const f32x16& p1, h8& pa0, h8& pa1, h8& pa2, h8& pa3) {
#define AT_PK4(P, BASE, OUT) do { unsigned a0 = cvtpk(P[BASE + 0], P[BASE + 1]), a1 = cvtpk(P[BASE + 2], P[BASE + 3]); \
    unsigned b0 = cvtpk(P[BASE + 4], P[BASE + 5]), b1 = cvtpk(P[BASE + 6], P[BASE + 7]); \
    auto r0 = __builtin_amdgcn_permlane32_swap(a0, b0, false, false); auto r1 = __builtin_amdgcn_permlane32_swap(a1, b1, false, false); \
    u32x4 w = {r0[0], r1[0], r0[1], r1[1]}; OUT = *reinterpret_cast<h8*>(&w); } while (0)
    AT_PK4(p0, 0, pa0); AT_PK4(p0, 8, pa1); AT_PK4(p1, 0, pa2); AT_PK4(p1, 8, pa3);
#undef AT_PK4
}
__device__ __forceinline__ float half_swap_max(float v) { auto rr = __builtin_amdgcn_permlane32_swap(__float_as_uint(v), __float_as_uint(v), false, false); return fmaxf(__uint_as_float(rr[0]), __uint_as_float(rr[1])); }
__device__ __forceinline__ float half_swap_sum(float v) { auto rr = __builtin_amdgcn_permlane32_swap(__float_as_uint(v), __float_as_uint(v), false, false); return __uint_as_float(rr[0]) + __uint_as_float(rr[1]); }

__device__ __forceinline__ int hidden_tid() { int tz = threadIdx.x; asm volatile("" : "+v"(tz)); return tz; }
__device__ __forceinline__ void dma_offsets(int ld, int (&ko)[2], int (&vo)[2]) {
    const int tz = hidden_tid(), w = tz >> 6, l = tz & 63;
#pragma unroll
    for (int q = 0; q < 2; ++q) {
        const int rr = 4 * (2 * w + q) + (l >> 4), pp = l & 15;
        ko[q] = rr * ld + ((pp ^ (rr & 7)) * 8);
        const int L = (2 * w + q) * 1024 + l * 16, sidx = L >> 9, o = L & 511;
        const int kk = (sidx >> 2) * 8 + (o >> 6), c = (sidx & 3) * 32 + ((o & 63) >> 1);
        const int k = (kk & ~0xC) | ((kk & 4) << 1) | ((kk & 8) >> 1);
        vo[q] = k * ld + c;
    }
}
__device__ __forceinline__ void dma_tile(char* slot, const _Float16* Kb, const _Float16* Vb, int ld, int tile, const int (&ko)[2], const int (&vo)[2], int wid) {
    const _Float16* kt = Kb + (size_t)tile * 64 * ld; const _Float16* vt = Vb + (size_t)tile * 64 * ld;
#pragma unroll
    for (int q = 0; q < 2; ++q) __builtin_amdgcn_global_load_lds((const unsigned*)(kt + ko[q]), (LAS unsigned*)(slot + (2 * wid + q) * 1024), 16, 0, 0);
#pragma unroll
    for (int q = 0; q < 2; ++q) __builtin_amdgcn_global_load_lds((const unsigned*)(vt + vo[q]), (LAS unsigned*)(slot + SHM_K + (2 * wid + q) * 1024), 16, 0, 0);
}
#define AT_WAITV(n) asm volatile("s_waitcnt vmcnt(" #n ")" ::: "memory")
#define AT_BAR() do { asm volatile("s_waitcnt lgkmcnt(0)" ::: "memory"); __builtin_amdgcn_s_barrier(); asm volatile("" ::: "memory"); } while (0)

__device__ __forceinline__ void attn_unit(char* lds, const _Float16* qrow, const _Float16* Kb, const _Float16* Vb, int ld, unsigned tmask, int wlen, int khi, unsigned selmask,
                                          _Float16* outw, int ostride) {
    const int tid = threadIdx.x, wid = __builtin_amdgcn_readfirstlane(tid >> 6), lane = tid & 63, r32 = lane & 31, hi = lane >> 5;
    float* wsf = (float*)(lds + LDS_WS) + wid * 64; float* li_l = wsf; float* al_l = wsf + 32;
    float m_reg = -1e30f, l_reg = 0.f; f32x16 o[4] = {}; h8 qr[8];
#pragma unroll
    for (int d0 = 0; d0 < 8; ++d0) qr[d0] = *(const h8*)(qrow + d0 * 16);
    int ko[2], vo[2]; dma_offsets(ld, ko, vo);
    const int vbase = (int)(uintptr_t)lds + SHM_K + v_rd_base(lane);
    unsigned rest = tmask; int j = __ffs(rest) - 1; rest &= rest - 1;
    int j1 = rest ? (__ffs(rest) - 1) : -1; if (j1 >= 0) rest &= rest - 1;
    dma_tile(lds, Kb, Vb, ld, j, ko, vo, wid);
    if (j1 >= 0) { dma_tile(lds + SLOT, Kb, Vb, ld, j1, ko, vo, wid); AT_WAITV(4); } else { AT_WAITV(0); }
    AT_BAR();
    int so = 0, sp = 0;
    const bool roleB = wid >= 4;
    bool first = true;
    h8 pa0, pa1, pa2, pa3;
    for (;;) {
        const int j2 = rest ? (__ffs(rest) - 1) : -1;
        if (j2 >= 0) { rest &= rest - 1; int s2 = so + 2 * SLOT; s2 = s2 >= NSLOT * SLOT ? s2 - NSLOT * SLOT : s2; dma_tile(lds + s2, Kb, Vb, ld, j2, ko, vo, wid); }
        if (roleB && !first) { AT_SBAR(); pv_d0(o, vbase + sp, pa0, pa1, pa2, pa3); }
        f32x16 p0, p1;
        AT_SBAR(); qkt(p0, p1, lds + so, qr, r32, hi);
        { const int klo = wlen > 0 ? khi - wlen + 1 : 0; const bool tb = (selmask >> j) & 1u; const bool inr = (j * 64 >= klo) && (j * 64 + 63 <= khi);
          if (!__all(tb && inr)) {
              if (__all(inr)) {
#pragma unroll
                  for (int r = 0; r < 16; ++r) { p0[r] = tb ? p0[r] : -INFINITY; p1[r] = tb ? p1[r] : -INFINITY; }
              } else {
                  const int kb = j * 64 + 4 * hi;
#pragma unroll
                  for (int r = 0; r < 16; ++r) { const int k0 = kb + (r & 3) + 8 * (r >> 2);
                      p0[r] = (tb && k0 >= klo && k0 <= khi) ? p0[r] : -INFINITY;
                      p1[r] = (tb && (k0 + 32) >= klo && (k0 + 32) <= khi) ? p1[r] : -INFINITY; }
              } } }
        float pmax = p0[0];
#pragma unroll
        for (int r = 1; r < 16; ++r) pmax = fmaxf(pmax, p0[r]);
#pragma unroll
        for (int r = 0; r < 16; ++r) pmax = fmaxf(pmax, p1[r]);
        pmax = half_swap_max(pmax);
        float mn, alpha;
        if (__all(pmax - m_reg <= THR_RAW)) { mn = m_reg; alpha = 1.f; }
        else { mn = fmaxf(m_reg, pmax); alpha = __builtin_amdgcn_exp2f((m_reg - mn) * CEXP); m_reg = mn; }
        const float mnC = -mn * CEXP;
        float ps = 0.f;
#pragma unroll
        for (int r = 0; r < 16; ++r) { p0[r] = __builtin_amdgcn_exp2f(fmaf(p0[r], CEXP, mnC)); ps += p0[r]; }
#pragma unroll
        for (int r = 0; r < 16; ++r) { p1[r] = __builtin_amdgcn_exp2f(fmaf(p1[r], CEXP, mnC)); ps += p1[r]; }
        ps = half_swap_sum(ps);
        l_reg = l_reg * alpha + ps;
        if (__any(alpha < 1.f)) { if (hi == 0) al_l[r32] = alpha; asm volatile("s_waitcnt lgkmcnt(0)" ::: "memory");
#pragma unroll
            for (int r = 0; r < 16; ++r) { const float a = al_l[crow(r, hi)];
#pragma unroll
                for (int d = 0; d < 4; ++d) o[d][r] *= a; } }
        pack_p(p0, p1, pa0, pa1, pa2, pa3);
        AT_SBAR();
        if (!roleB) pv_d0(o, vbase + so, pa0, pa1, pa2, pa3);
        if (j1 < 0) break;
        if (j2 >= 0) { AT_WAITV(4); } else { AT_WAITV(0); }
        AT_BAR();
        j = j1; j1 = j2; sp = so; so += SLOT; so = so >= NSLOT * SLOT ? so - NSLOT * SLOT : so; first = false;
    }
    if (roleB) { AT_SBAR(); pv_d0(o, vbase + so, pa0, pa1, pa2, pa3); }
    if (hi == 0) li_l[r32] = l_reg; asm volatile("s_waitcnt lgkmcnt(0)" ::: "memory");
#pragma unroll
    for (int r = 0; r < 16; ++r) { const int orow = crow(r, hi); const float l = li_l[orow]; const float rl = l > 0.f ? 1.f / l : 0.f;
#pragma unroll
        for (int d0 = 0; d0 < 4; ++d0) outw[(size_t)orow * ostride + d0 * 32 + r32] = (_Float16)(o[d0][r] * rl); }
    __syncthreads();
}

constexpr int LDS_AP = 0, LDS_BP = LDS_AP + 4 * 64 * 33 * 4, LDS_SELM = LDS_END, LDS_CS_END = LDS_SELM + 64 * 4;
static_assert(LDS_BP + 4 * 64 * 33 * 4 <= NSLOT * SLOT, "importance partials must fit inside the ring");
__device__ __forceinline__ void cmp_slc_unit(char* lds, const _Float16* qrow, const _Float16* Kc, const _Float16* Vc, const _Float16* Ks, const _Float16* Vs, int t, int tl, int g, int qi,
                                             _Float16* outc, _Float16* outs) {
    const int tid = threadIdx.x, wid = __builtin_amdgcn_readfirstlane(tid >> 6), lane = tid & 63, r32 = lane & 31, hi = lane >> 5;
    float* AP = (float*)(lds + LDS_AP); float* BP = (float*)(lds + LDS_BP); unsigned* selm = (unsigned*)(lds + LDS_SELM);
    {
        h8 qr[8];
#pragma unroll
        for (int d0 = 0; d0 < 8; ++d0) qr[d0] = *(const h8*)(qrow + d0 * 16);
        const int vb0 = (int)(uintptr_t)lds + SHM_K + v_rd_base(lane);
        { int ko[2], vo[2]; dma_offsets(256, ko, vo);
          dma_tile(lds, Kc, Vc, 256, 0, ko, vo, wid); dma_tile(lds + SLOT, Kc, Vc, 256, 1, ko, vo, wid); }
        AT_WAITV(0); AT_BAR();
        f32x16 pA0, pA1, pB0, pB1;
        AT_SBAR(); qkt(pA0, pA1, lds, qr, r32, hi); qkt(pB0, pB1, lds + SLOT, qr, r32, hi);
        const int khi = t >= 31 ? ((t - 31) >> 4) : -1;
#pragma unroll
        for (int r = 0; r < 16; ++r) { const int c0 = 4 * hi + (r & 3) + 8 * (r >> 2);
            pA0[r] = (c0 <= khi) ? pA0[r] : -INFINITY; pA1[r] = (c0 + 32 <= khi) ? pA1[r] : -INFINITY;
            pB0[r] = (c0 + 64 <= khi) ? pB0[r] : -INFINITY; pB1[r] = (c0 + 96 <= khi) ? pB1[r] : -INFINITY; }
        float pmax = -INFINITY;
#pragma unroll
        for (int r = 0; r < 16; ++r) pmax = fmaxf(fmaxf(pmax, pA0[r]), fmaxf(pA1[r], fmaxf(pB0[r], pB1[r])));
        pmax = half_swap_max(pmax);
        const float mC = (pmax == -INFINITY) ? 0.f : -pmax * CEXP;
        float ps = 0.f;
#pragma unroll
        for (int r = 0; r < 16; ++r) { pA0[r] = __builtin_amdgcn_exp2f(fmaf(pA0[r], CEXP, mC)); pA1[r] = __builtin_amdgcn_exp2f(fmaf(pA1[r], CEXP, mC));
            pB0[r] = __builtin_amdgcn_exp2f(fmaf(pB0[r], CEXP, mC)); pB1[r] = __builtin_amdgcn_exp2f(fmaf(pB1[r], CEXP, mC)); ps += (pA0[r] + pA1[r]) + (pB0[r] + pB1[r]); }
        ps = half_swap_sum(ps);
        const float inv = ps > 0.f ? 1.f / ps : 0.f;
#pragma unroll
        for (int r = 0; r < 16; ++r) { pA0[r] *= inv; pA1[r] *= inv; pB0[r] *= inv; pB1[r] *= inv; }
        f32x16 o[4] = {};
        h8 pa0, pa1, pa2, pa3;
        pack_p(pA0, pA1, pa0, pa1, pa2, pa3); AT_SBAR(); pv_d0(o, vb0, pa0, pa1, pa2, pa3);
        pack_p(pB0, pB1, pa0, pa1, pa2, pa3); AT_SBAR(); pv_d0(o, vb0 + SLOT, pa0, pa1, pa2, pa3);
#pragma unroll
        for (int r = 0; r < 16; ++r) { const int orow = crow(r, hi);
#pragma unroll
            for (int d0 = 0; d0 < 4; ++d0) outc[(size_t)orow * 1024 + d0 * 32 + r32] = (_Float16)o[d0][r]; }
        __syncthreads();
        { float* ap = AP + (g * 64 + tl) * 33; float* bp = BP + (g * 64 + tl) * 33;
          if (hi == 0) bp[0] = 0.f;
#define AT_IMP(P, JB) do { _Pragma("unroll") for (int k = 0; k < 4; ++k) { const int j = (JB) + 2 * k + hi; \
              ap[j] = 2.f * (P[4 * k] + P[4 * k + 1] + P[4 * k + 2]) + P[4 * k + 3]; if (j + 1 < 32) bp[j + 1] = P[4 * k + 3]; } } while (0)
          AT_IMP(pA0, 0); AT_IMP(pA1, 8); AT_IMP(pB0, 16); AT_IMP(pB1, 24);
#undef AT_IMP
        }
    }
    __syncthreads();
#pragma unroll 1
    for (int it = 0; it < 4; ++it) {
        const int tk = 8 * wid + 2 * it + hi, j = r32;
        float imp = 0.f;
#pragma unroll
        for (int gg = 0; gg < 4; ++gg) imp += AP[(gg * 64 + tk) * 33 + j] + BP[(gg * 64 + tk) * 33 + j];
        const bool forced = (j == 0) || (j == qi) || (j == qi - 1), valid = j <= qi;
        const float iv = forced ? 1e9f : (valid ? imp : -1e9f);
        int rank = 0;
        for (int i = 0; i < 32; ++i) { const float vi = __shfl(iv, i + 32 * hi); rank += (vi > iv || (vi == iv && i < j)) ? 1 : 0; }
        const unsigned long long bal = __ballot(rank < 16 && valid);
        if (r32 == 0) selm[tk] = (unsigned)(bal >> (32 * hi));
    }
    __syncthreads();
    unsigned tm = selm[lane];
#pragma unroll
    for (int o = 32; o > 0; o >>= 1) tm |= __shfl_xor(tm, o);
    const int tz2 = hidden_tid();
    const unsigned mysel = selm[((tz2 >> 6) & 1) * 32 + (tz2 & 31)];
    attn_unit(lds, qrow, Ks, Vs, 128, tm, 0, t, mysel, outs, 1024);
}
}

struct CUnit { const float* W; int ldw; int nvalid; _Float16* Wt; int k0; int n0; };
__device__ __forceinline__ CUnit conv_desc(int u, const float* win, const float* w1k, const float* w1v, const float* wmkv, _Float16* wtin, _Float16* wt1, _Float16* wtmkv) {
    CUnit d;
    if (u < 160) { d.W = win; d.ldw = INW; d.nvalid = INW; d.Wt = wtin; d.k0 = (u / 5) * 64; d.n0 = (u % 5) * 256; }
    else if (u < 288) { const int v = u - 160, kv = v >> 6, part = (v >> 5) & 1, kt = v & 31;
        d.W = (kv ? w1v : w1k) + (size_t)part * 2048 * 256; d.ldw = 256; d.nvalid = 256; d.Wt = wt1 + ((size_t)kv * 512 + part * 256) * 2048; d.k0 = kt * 64; d.n0 = 0; }
    else { d.W = wmkv; d.ldw = 1024; d.nvalid = 1024; d.Wt = wtmkv; d.k0 = 0; d.n0 = 0; }
    return d;
}
__device__ __forceinline__ void conv_all(float* lds, const float* win, const float* w1k, const float* w1v, const float* wmkv, _Float16* wtin, _Float16* wt1, _Float16* wtmkv, int bid, int nb) {
    constexpr int NU = 160 + 128;
    const int tid = threadIdx.x;
    int u = bid; if (u >= NU) return;
    CUnit d = conv_desc(u, win, w1k, w1v, wmkv, wtin, wt1, wtmkv);
    float4 v[8];
#define CL(D) do { _Pragma("unroll") for (int i = 0; i < 8; ++i) { const int idx = tid + 512 * i, r = idx >> 6, c4 = (idx & 63) * 4; \
        v[i] = ((D).n0 + c4 < (D).nvalid) ? *(const float4*)((D).W + (size_t)((D).k0 + r) * (D).ldw + (D).n0 + c4) : make_float4(0.f, 0.f, 0.f, 0.f); } } while (0)
    CL(d);
    for (;;) {
#pragma unroll
        for (int i = 0; i < 8; ++i) { const int idx = tid + 512 * i, r = idx >> 6, c4 = (idx & 63) * 4; float* dd = lds + r * 257 + c4; dd[0] = v[i].x; dd[1] = v[i].y; dd[2] = v[i].z; dd[3] = v[i].w; }
        __syncthreads();
        const int un = u + nb; const bool has = un < NU;
        CUnit dn = d; if (has) { dn = conv_desc(un, win, w1k, w1v, wmkv, wtin, wt1, wtmkv); CL(dn); }
#pragma unroll
        for (int j = 0; j < 4; ++j) { const int id = tid + 512 * j, n = id >> 3, k8 = (id & 7) * 8; h8 o;
#pragma unroll
            for (int q = 0; q < 8; ++q) o[q] = (_Float16)lds[(k8 + q) * 257 + n];
            *(h8*)(d.Wt + (size_t)(d.n0 + n) * 2048 + d.k0 + k8) = o; }
        __syncthreads();
        if (!has) break;
        u = un; d = dn;
    }
#undef CL
}

__device__ __forceinline__ unsigned pack4_i8(float a, float b, float c, float d) {
    const int ia = __float2int_rn(a), ib = __float2int_rn(b), ic = __float2int_rn(c), id = __float2int_rn(d);
    return (unsigned)(ia & 255) | ((unsigned)(ib & 255) << 8) | ((unsigned)(ic & 255) << 16) | ((unsigned)(id & 255) << 24);
}
constexpr int QP_LD2 = 1026;
struct QUnit { const float* W; int ldw; int n0; signed char* Q; float* sc; int nvalid; };
struct QExtra { const float* win; signed char* q8in; float* sin8; const float* wmkv; signed char* q8mkv; float* smkv; };
__device__ __forceinline__ QUnit quant_desc(int u, const float* wgu, const float* wdn, signed char* q8gu, signed char* q8dn, float* sgu, float* sdn, const float* wout, signed char* q8out, float* sout, const QExtra& x) {
    QUnit d; d.nvalid = 1 << 30;
    if (u >= NE * 192 + 64 + 73) { const int pn = u - (NE * 192 + 64 + 73); d.W = x.wmkv; d.ldw = 1024; d.n0 = pn * 32; d.Q = x.q8mkv; d.sc = x.smkv; }
    else if (u >= NE * 192 + 64) { const int pn = u - (NE * 192 + 64); d.W = x.win; d.ldw = INW; d.n0 = 1280 + pn * 32; d.Q = x.q8in - (size_t)1280 * 2048; d.sc = x.sin8 - 1280; d.nvalid = INW; }
    else if (u >= NE * 192) { const int pn = u - NE * 192; d.W = wout; d.ldw = 2048; d.n0 = pn * 32; d.Q = q8out; d.sc = sout; }
    else if (u < NE * 128) { const int e = u >> 7, pn = u & 127; d.W = wgu + (size_t)e * 2048 * 4096; d.ldw = 4096; d.n0 = pn * 32; d.Q = q8gu + (size_t)e * 4096 * 2048; d.sc = sgu + (size_t)e * 4096; }
    else { const int v = u - NE * 128, e = v >> 6, pn = v & 63; d.W = wdn + (size_t)e * 2048 * 2048; d.ldw = 2048; d.n0 = pn * 32; d.Q = q8dn + (size_t)e * 2048 * 2048; d.sc = sdn + (size_t)e * 2048; }
    return d;
}
__device__ __forceinline__ unsigned pk2h(float a, float b) { auto v = __builtin_amdgcn_cvt_pkrtz(a, b); return *reinterpret_cast<unsigned*>(&v); }
template <bool DYN>
__device__ __forceinline__ void quant_units(char* smem, const float* wgu, const float* wdn, signed char* q8gu, signed char* q8dn, float* sgu, float* sdn, const float* wout, signed char* q8out, float* sout, const QExtra& qx,
                                            int ubase, int nun, unsigned* ctr, int maxu, int bid, int nb) {
    typedef _Float16 h2v __attribute__((ext_vector_type(2)));
    typedef unsigned qu4 __attribute__((ext_vector_type(4)));
    unsigned* cmaxb = (unsigned*)(smem + g8::EP_OFF);
    volatile LAS int* slot = (volatile LAS int*)(smem + g8::EP_OFF + 256);
    int tid = threadIdx.x; asm volatile("" : "+v"(tid));
    const int c4 = (tid & 7) * 4, rg = tid >> 3;
    if (tid < 64) cmaxb[tid] = 0u;
    if (DYN) { if (tid == 0) slot[0] = maxu > 0 ? (int)__hip_atomic_fetch_add(ctr, 1u, __ATOMIC_RELAXED, __HIP_MEMORY_SCOPE_AGENT) : 0x7fffffff; }
    __syncthreads();
    int u = DYN ? slot[0] : bid;
    if (u >= nun) { __syncthreads(); return; }
    int taken = 1;
    QUnit d = quant_desc(ubase + u, wgu, wdn, q8gu, q8dn, sgu, sdn, wout, q8out, sout, qx);
    float4 L[32];
    char* hb = smem + tid * 16;
#define QLD(D, en) do { const char* p0 = (const char*)((D).W + (D).n0); const int cc = ((D).n0 + c4 < (D).nvalid) ? c4 : 0;     \
        const unsigned vo = (unsigned)(rg * 16 * (D).ldw + cc) * 4u, ldb = (unsigned)(D).ldw * 4u; \
        if (en) { _Pragma("unroll") for (int j = 0; j < 16; ++j) { L[j] = *(const float4*)(p0 + (size_t)(j * ldb) + vo); L[16 + j] = *(const float4*)(p0 + (size_t)((1024 + j) * ldb) + vo); } } \
        else { _Pragma("unroll") for (int j = 0; j < 32; ++j) L[j] = make_float4(0.f, 0.f, 0.f, 0.f); } } while (0)
#define QPK(a, b) ({ h2v t_; t_[0] = (_Float16)(a); t_[1] = (_Float16)(b); __builtin_bit_cast(unsigned, t_); })
#define QW(comp, ci) do { _Pragma("unroll") for (int hq = 0; hq < 4; ++hq) { uint4 w_; w_.x = QPK(L[hq * 8 + 0].comp, L[hq * 8 + 1].comp); w_.y = QPK(L[hq * 8 + 2].comp, L[hq * 8 + 3].comp); \
        w_.z = QPK(L[hq * 8 + 4].comp, L[hq * 8 + 5].comp); w_.w = QPK(L[hq * 8 + 6].comp, L[hq * 8 + 7].comp); *(uint4*)(hb + ((ci) * 4 + hq) * 8192) = w_; } } while (0)
#define QINV(x) ({ const float iv_ = (x) > 0.f ? fminf(127.f / (x), 65504.f) : 0.f; __builtin_bit_cast(unsigned, __builtin_amdgcn_cvt_pkrtz(iv_, iv_)); })
#define QF(w, iv) __builtin_bit_cast(unsigned, __builtin_elementwise_fma(__builtin_bit_cast(h2v, (unsigned)(w)), __builtin_bit_cast(h2v, (unsigned)(iv)), __builtin_bit_cast(h2v, 0x66006600u)))
#define QS(ci, half, iv) do { const uint4 w0 = *(const uint4*)(hb + ((ci) * 4 + (half) * 2) * 8192), w1 = *(const uint4*)(hb + ((ci) * 4 + (half) * 2 + 1) * 8192); uint4 o; \
        o.x = __builtin_amdgcn_perm(QF(w0.y, iv), QF(w0.x, iv), 0x06040200u); o.y = __builtin_amdgcn_perm(QF(w0.w, iv), QF(w0.z, iv), 0x06040200u); \
        o.z = __builtin_amdgcn_perm(QF(w1.y, iv), QF(w1.x, iv), 0x06040200u); o.w = __builtin_amdgcn_perm(QF(w1.w, iv), QF(w1.z, iv), 0x06040200u); \
        *(__attribute__((address_space(1))) qu4*)(d.Q + (size_t)(d.n0 + c4 + (ci)) * 2048 + (half) * 1024 + rg * 16) = (qu4){o.x, o.y, o.z, o.w}; } while (0)
    QLD(d, true);
    int par = 0;
    for (;;) {
        unsigned* cmax = cmaxb + par * 32;
        float m0 = 0.f, m1 = 0.f, m2 = 0.f, m3 = 0.f;
        if (DYN) { if (tid == 0) slot[par ^ 1] = taken < maxu ? (int)__hip_atomic_fetch_add(ctr, 1u, __ATOMIC_RELAXED, __HIP_MEMORY_SCOPE_AGENT) : 0x7fffffff; }
#pragma unroll
        for (int i = 0; i < 32; ++i) { m0 = fmaxf(m0, fabsf(L[i].x)); m1 = fmaxf(m1, fabsf(L[i].y)); m2 = fmaxf(m2, fabsf(L[i].z)); m3 = fmaxf(m3, fabsf(L[i].w)); }
        QW(x, 0); QW(y, 1); QW(z, 2); QW(w, 3);
        atomicMax(&cmax[c4 + 0], __float_as_uint(m0)); atomicMax(&cmax[c4 + 1], __float_as_uint(m1)); atomicMax(&cmax[c4 + 2], __float_as_uint(m2)); atomicMax(&cmax[c4 + 3], __float_as_uint(m3));
        __syncthreads();
        const int un = DYN ? slot[par ^ 1] : u + nb; const bool has = un < nun;
        QUnit dn = d; if (has) dn = quant_desc(ubase + un, wgu, wdn, q8gu, q8dn, sgu, sdn, wout, q8out, sout, qx);
        QLD(dn, has);
        if (tid < 32) cmaxb[(par ^ 1) * 32 + tid] = 0u;
        const float x0 = __uint_as_float(cmax[c4 + 0]), x1 = __uint_as_float(cmax[c4 + 1]), x2 = __uint_as_float(cmax[c4 + 2]), x3 = __uint_as_float(cmax[c4 + 3]);
        const unsigned i0 = QINV(x0), i1 = QINV(x1), i2 = QINV(x2), i3 = QINV(x3);
        QS(0, 0, i0); QS(1, 0, i1); QS(2, 0, i2); QS(3, 0, i3);
        QS(0, 1, i0); QS(1, 1, i1); QS(2, 1, i2); QS(3, 1, i3);
        if (tid < 32) { const float mx = __uint_as_float(cmax[tid]); const unsigned ih = QINV(mx); d.sc[d.n0 + tid] = mx > 0.f ? 1.f / (float)(__builtin_bit_cast(h2v, ih)[0]) : 1.f; }
        if (!has) break;
        u = un; d = dn; par ^= 1; ++taken;
        __syncthreads();
    }
    __syncthreads();
#undef QLD
#undef QPK
#undef QW
#undef QINV
#undef QF
#undef QS
}
__host__ __device__ constexpr int q_cnt(int k) { return k == 1 ? 1536 : k == 2 ? 768 : k == 3 ? 512 : k == 4 ? 512 : k == 5 ? 256 : k == 6 ? 256 : k == 7 ? 256 : k == 8 ? 2048 : 0; }
__host__ __device__ constexpr int q_beg(int k) { int s = 0; for (int i = 0; i < k; ++i) s += q_cnt(i); return s; }
static_assert(q_beg(8) == NE * 128 && q_beg(10) == NE * 192, "quota tables");
constexpr size_t CTL_QCTR = 20480;

__device__ __forceinline__ const float* karg_in(int i) {
    const __attribute__((address_space(4))) char* ka = (const __attribute__((address_space(4))) char*)__builtin_amdgcn_kernarg_segment_ptr();
    asm volatile("" : "+s"(ka));
    return *(const float* const __attribute__((address_space(4)))*)(ka + 8 * i);
}
#define DEFPTRS unsigned char* wsl_ = p.ws; asm volatile("" : "+s"(wsl_)); unsigned char* ws = wsl_; (void)ws; unsigned* ctl = (unsigned*)(wsl_ + WS_CTL); int* cnt = (int*)(wsl_ + CTL_CNT); float* proj = (float*)(wsl_ + WS_PROJ); float* kvmem = (float*)(wsl_ + WS_KVMEM); float* bias1 = (float*)(wsl_ + WS_BIAS1); float* hid = (float*)(wsl_ + WS_HID); float* kc = (float*)(wsl_ + WS_KC); float* vc = (float*)(wsl_ + WS_VC); float* pooled = (float*)(wsl_ + WS_POOLED); _Float16* opool = (_Float16*)(wsl_ + WS_OPOOL); _Float16* owin = (_Float16*)(wsl_ + WS_OWIN); _Float16* ocmp = (_Float16*)(wsl_ + WS_OCMP); _Float16* oslc = (_Float16*)(wsl_ + WS_OSLC); unsigned* sel = (unsigned*)(wsl_ + WS_SEL); _Float16* omem = (_Float16*)(wsl_ + WS_OMEM); _Float16* cat16 = (_Float16*)(wsl_ + WS_CAT16); _Float16* hpre16 = (_Float16*)(wsl_ + WS_HPRE); float* hbuf = (float*)(wsl_ + WS_H); float* gate = (float*)(wsl_ + WS_GATE); int* list = (int*)(wsl_ + WS_LIST); unsigned char* actf8 = (unsigned char*)(wsl_ + WS_ACT16); unsigned char* yf8 = (unsigned char*)(wsl_ + WS_Y16); _Float16* h16 = (_Float16*)(wsl_ + WS_H16); _Float16* x16 = (_Float16*)(wsl_ + WS_X16); _Float16* wtin = (_Float16*)(wsl_ + WS_WTIN); _Float16* wtout = (_Float16*)(wsl_ + WS_WTOUT); _Float16* wtgu = (_Float16*)(wsl_ + WS_WTGU); _Float16* wtdn = (_Float16*)(wsl_ + WS_WTDN); _Float16* proj16 = (_Float16*)(wsl_ + WS_PROJ16); _Float16* kvmem16 = (_Float16*)(wsl_ + WS_KVMEM16); _Float16* wt1 = (_Float16*)(wsl_ + WS_WT1); float* uv = (float*)(wsl_ + WS_UV); _Float16* kc16 = (_Float16*)(wsl_ + WS_KC16); _Float16* vc16 = (_Float16*)(wsl_ + WS_VC16); _Float16* wr16 = (_Float16*)(wsl_ + WS_WR16); _Float16* mem16 = (_Float16*)(wsl_ + WS_MEM16); _Float16* wtmkv = (_Float16*)(wsl_ + WS_WTMKV); _Float16* kv16 = (_Float16*)(wsl_ + WS_KV16); _Float16* wt2 = (_Float16*)(wsl_ + WS_WT2); float* sa2 = (float*)(wsl_ + WS_SA2); float* gate2 = (float*)(wsl_ + WS_GATE2); signed char* x8 = (signed char*)(wsl_ + WS_X8); float* sxa = (float*)(wsl_ + WS_SXA); signed char* q8in = (signed char*)(wsl_ + WS_Q8IN); float* sin8 = (float*)(wsl_ + WS_SIN8); signed char* q8mkv = (signed char*)(wsl_ + WS_Q8MKV); float* smkv = (float*)(wsl_ + WS_SMKV); signed char* q8out = (signed char*)(wsl_ + WS_Q8OUT); float* sout = (float*)(wsl_ + WS_SOUT); signed char* cat8 = (signed char*)(wsl_ + WS_CAT8); float* scat = (float*)(wsl_ + WS_SCAT); signed char* q8gu = (signed char*)(wsl_ + WS_Q8GU); signed char* q8dn = (signed char*)(wsl_ + WS_Q8DN); float* sgu = (float*)(wsl_ + WS_SGU); float* sdn = (float*)(wsl_ + WS_SDN); signed char* h8q = (signed char*)(wsl_ + WS_H8); float* sah = (float*)(wsl_ + WS_SAH); signed char* act8 = (signed char*)(wsl_ + WS_ACT8); float* sact = (float*)(wsl_ + WS_SACT);
__global__ void __launch_bounds__(512, 2) fwd(Params p) {
    extern __shared__ __attribute__((aligned(16))) char smem[];
    int tidk_ = threadIdx.x; asm volatile("" : "+v"(tidk_));
    const int tid = tidk_, wv = __builtin_amdgcn_readfirstlane(tid >> 6);
#define LANE_NOW ({ int _t = threadIdx.x; asm volatile("" : "+v"(_t)); _t & 63; })
    const int bid = blockIdx.x, nb = gridDim.x;
    const int gw = bid * 8 + wv, nw = nb * 8;
    const int lo = (int)(p.lo_hi & 0xffffffffll), hi = (int)(p.lo_hi >> 32);
    unsigned char* ws = p.ws;
    unsigned* ctl = (unsigned*)(ws + WS_CTL);
    int* cnt = (int*)(ws + CTL_CNT);
    float* proj = (float*)(ws + WS_PROJ);
    float* kvmem = (float*)(ws + WS_KVMEM);
    float* bias1 = (float*)(ws + WS_BIAS1);
    float* hid = (float*)(ws + WS_HID);
    float* kc = (float*)(ws + WS_KC);
    float* vc = (float*)(ws + WS_VC);
    float* pooled = (float*)(ws + WS_POOLED);
    _Float16* opool = (_Float16*)(ws + WS_OPOOL);
    _Float16* owin = (_Float16*)(ws + WS_OWIN);
    _Float16* ocmp = (_Float16*)(ws + WS_OCMP);
    _Float16* oslc = (_Float16*)(ws + WS_OSLC);
    unsigned* sel = (unsigned*)(ws + WS_SEL);
    _Float16* omem = (_Float16*)(ws + WS_OMEM);
    _Float16* cat16 = (_Float16*)(ws + WS_CAT16);
    _Float16* hpre16 = (_Float16*)(ws + WS_HPRE);
    float* hbuf = (float*)(ws + WS_H);
    float* gate = (float*)(ws + WS_GATE);
    int* list = (int*)(ws + WS_LIST);
    unsigned char* actf8 = (unsigned char*)(ws + WS_ACT16);
    unsigned char* yf8 = (unsigned char*)(ws + WS_Y16);
    _Float16* h16 = (_Float16*)(ws + WS_H16);
    _Float16* x16 = (_Float16*)(ws + WS_X16);
    _Float16* wtin = (_Float16*)(ws + WS_WTIN);
    _Float16* wtout = (_Float16*)(ws + WS_WTOUT);
    _Float16* wtgu = (_Float16*)(ws + WS_WTGU);
    _Float16* wtdn = (_Float16*)(ws + WS_WTDN);
    LAS unsigned char* lds = (LAS unsigned char*)smem;
    _Float16* proj16 = (_Float16*)(ws + WS_PROJ16);
    _Float16* kvmem16 = (_Float16*)(ws + WS_KVMEM16);
    _Float16* wt1 = (_Float16*)(ws + WS_WT1);
    float* uv = (float*)(ws + WS_UV);
    _Float16* kc16 = (_Float16*)(ws + WS_KC16);
    _Float16* vc16 = (_Float16*)(ws + WS_VC16);
    _Float16* wr16 = (_Float16*)(ws + WS_WR16);
    _Float16* mem16 = (_Float16*)(ws + WS_MEM16);
    _Float16* wtmkv = (_Float16*)(ws + WS_WTMKV);
    _Float16* kv16 = (_Float16*)(ws + WS_KV16);
    _Float16* wt2 = (_Float16*)(ws + WS_WT2);
    float* sa2 = (float*)(ws + WS_SA2); float* gate2 = (float*)(ws + WS_GATE2);
    signed char* x8 = (signed char*)(ws + WS_X8); float* sxa = (float*)(ws + WS_SXA); signed char* q8in = (signed char*)(ws + WS_Q8IN); float* sin8 = (float*)(ws + WS_SIN8);
    signed char* q8mkv = (signed char*)(ws + WS_Q8MKV); float* smkv = (float*)(ws + WS_SMKV);
    signed char* q8out = (signed char*)(ws + WS_Q8OUT); float* sout = (float*)(ws + WS_SOUT); signed char* cat8 = (signed char*)(ws + WS_CAT8); float* scat = (float*)(ws + WS_SCAT);
    signed char* q8gu = (signed char*)(ws + WS_Q8GU); signed char* q8dn = (signed char*)(ws + WS_Q8DN);
    float* sgu = (float*)(ws + WS_SGU); float* sdn = (float*)(ws + WS_SDN);
    signed char* h8q = (signed char*)(ws + WS_H8); float* sah = (float*)(ws + WS_SAH);
    signed char* act8 = (signed char*)(ws + WS_ACT8); float* sact = (float*)(ws + WS_SACT);
    const int vcu = (nb % 8 == 0) ? (bid % 8) * (nb / 8) + bid / 8 : bid;

    volatile LAS unsigned* xbw = (volatile LAS unsigned*)(smem + LDS_BYTES - 16);
    if (tid == 0) { xbw[0] = 0u; xbw[1] = 0u; xbw[2] = 0u; xbw[3] = 0u; }
    __syncthreads();
    XcdBarrier bar; bar.bar = ctl; bar.x = 0; bar.st = xbw;
    const bool multi = (hi - lo) > 1;
    if (multi) bar = xcd_barrier_post(ctl, xbw);
#define IN(k) (lo <= (k) && (k) < hi)
#define SEAM(k) do { if (IN(k) && IN((k) + 1)) xcd_barrier(bar); } while (0)
    float* sw = (float*)smem + wv * WLDS_FLOATS;
    const int qgrp = bid >> 3;
#define QDYN(k, mx) do { constexpr int qb_ = q_beg(k), qc_ = q_cnt(k); const QExtra qxd{nullptr, q8in, sin8, nullptr, q8mkv, smkv}; quant_units<true>(smem, karg_in(I_WGU), karg_in(I_WDN), q8gu, q8dn, sgu, sdn, nullptr, q8out, sout, qxd, qb_, qc_, (unsigned*)(ws + CTL_QCTR) + 16 * (k), (mx), bid, nb); } while (0)
#define QSLOT(k, sl, ns, share) QDYN(k, (qgrp % (ns)) == (sl) ? (share) : 0)
#define QPOST(k) do { __syncthreads(); QDYN(k, 1 << 30); } while (0)
    int* segw = (int*)(sw + 4096 + 512);

    if (IN(0)) {
        DEFPTRS;
        const int lane = LANE_NOW; (void)lane;
        if (wv == 0 && (bid & 1) == 0 && (bid >> 1) < 128) {
            const int task = bid >> 1, kv = task >> 6, jg = (task >> 4) & 3, kc = task & 15;
            const float* pos = p.in[kv ? I_POSV : I_POSK] + kc * 256; const float* w1 = p.in[kv ? I_W1V : I_W1K] + (size_t)kc * 256 * 256 + jg * 64 + lane;
            float s0 = 0.f, s1 = 0.f, s2 = 0.f, s3 = 0.f;
            for (int k = 0; k < 256; k += 4) { s0 += pos[k] * w1[(size_t)k * 256]; s1 += pos[k + 1] * w1[(size_t)(k + 1) * 256]; s2 += pos[k + 2] * w1[(size_t)(k + 2) * 256]; s3 += pos[k + 3] * w1[(size_t)(k + 3) * 256]; }
            bias1[(kv * 16 + kc) * 256 + jg * 64 + lane] = (s0 + s1) + (s2 + s3);
        }
        for (int i = bid * 512 + tid; i < 2 * 128 * 256; i += nb * 512) { const int kv = i >> 15, d = (i >> 8) & 127, n = i & 255; wt2[i] = (_Float16)p.in[kv ? I_W2V : I_W2K][(size_t)n * 128 + d]; }
        for (int i = bid * 512 + tid; i < 32 * 2048; i += nb * 512) { const int e = i >> 11, d = i & 2047; wr16[i] = (_Float16)p.in[I_WR][(size_t)d * 32 + e]; }
        {
            for (int row0 = gw; row0 < T_ + 2048; row0 += nw * 2) {
                float4 raw[2][8];
#pragma unroll
                for (int i = 0; i < 2; ++i) { const int row = row0 + i * nw; const float* src = row < T_ ? p.in[I_X] + (size_t)row * 2048 : p.in[I_MEM] + (size_t)(row - T_) * 2048;
#pragma unroll
                    for (int c = 0; c < 4; ++c) { raw[i][2 * c] = make_float4(0.f, 0.f, 0.f, 0.f); raw[i][2 * c + 1] = raw[i][2 * c];
                        if (row < T_ + 2048) { raw[i][2 * c] = *(const float4*)(src + (lane + 64 * c) * 8); raw[i][2 * c + 1] = *(const float4*)(src + (lane + 64 * c) * 8 + 4); } } }
#pragma unroll
                for (int i = 0; i < 2; ++i) { const int row = row0 + i * nw;
                    float amax = 0.f;
#pragma unroll
                    for (int k = 0; k < 8; ++k) amax = fmaxf(amax, fmaxf(fmaxf(fabsf(raw[i][k].x), fabsf(raw[i][k].y)), fmaxf(fabsf(raw[i][k].z), fabsf(raw[i][k].w))));
                    amax = wave_max(amax);
                    if (row < T_ + 2048) {
                        const float qinv = amax > 0.f ? 127.f / amax : 0.f;
                        if (lane == 0) sxa[row] = amax > 0.f ? amax / 127.f : 1.f;
#pragma unroll
                        for (int c = 0; c < 4; ++c) { const float4 a = raw[i][2 * c], b2 = raw[i][2 * c + 1];
                            uint2 q; q.x = pack4_i8(a.x * qinv, a.y * qinv, a.z * qinv, a.w * qinv); q.y = pack4_i8(b2.x * qinv, b2.y * qinv, b2.z * qinv, b2.w * qinv);
                            *(uint2*)(x8 + (size_t)row * 2048 + (lane + 64 * c) * 8) = q;
                            if (row < T_) { h8 o; o[0] = (_Float16)a.x; o[1] = (_Float16)a.y; o[2] = (_Float16)a.z; o[3] = (_Float16)a.w; o[4] = (_Float16)b2.x; o[5] = (_Float16)b2.y; o[6] = (_Float16)b2.z; o[7] = (_Float16)b2.w;
                                *(h8*)(x16 + (size_t)row * 2048 + (lane + 64 * c) * 8) = o; } } }
                }
            }
        }
        {
            const QExtra qx{p.in[I_WIN], q8in, sin8, p.in[I_WMEMKV], q8mkv, smkv};
            quant_units<false>(smem, p.in[I_WGU], p.in[I_WDN], q8gu, q8dn, sgu, sdn, p.in[I_WOUT], q8out, sout, qx, NE * 192, 64 + 73 + 32, nullptr, 0, bid, nb);
            __syncthreads();
            conv_all((float*)smem, p.in[I_WIN], p.in[I_W1K], p.in[I_W1V], p.in[I_WMEMKV], wtin, wt1, wtmkv, bid, nb);
            __syncthreads();
        }
    }
    SEAM(0);
    if (IN(1)) {
        DEFPTRS;
        const int lane = LANE_NOW; (void)lane;
        const int qs1 = (bid < 16 || (bid >= 64 && bid < 104)) ? 1 : (bid < 64 ? 4 : 8);
        QSLOT(1, 0, 3, qs1);
        { g8::ProbInF P{x16, proj16, nb, bid}; g8::gemm_phase(lds, P); }
        __syncthreads();
        QSLOT(1, 1, 3, qs1);
        { g8::ProbIn8 P{x8, proj16, sxa, nb, (bid + 192) & 255}; g8::gemm_phase(lds, P); }
        __syncthreads();
        QSLOT(1, 2, 3, qs1);
        QPOST(1);
    }
    SEAM(1);
    if (IN(2)) {
        DEFPTRS;
        const int lane = LANE_NOW; (void)lane;
        QSLOT(2, 0, 5, 3);
        { g8::ProbCmp P{kv16, wt1, uv, nb, bid}; g8::gemm_phase(lds, P); __syncthreads(); }
        for (int i = bid * 512 + tid; i < T_ * 64; i += nb * 512) {
            const int chn = i & 63, row = i >> 6, t = row & (S_ - 1), g = chn >> 4;
            const int win = 2 << g, n = min(win, t + 1);
            const _Float16* src = proj16 + (size_t)row * INW + C_UP + chn * 8;
            float a[8];
            const h8 cur = *(const h8*)src;
            h8 vv[15];
#pragma unroll
            for (int k = 0; k < 15; ++k) { vv[k] = (h8){0, 0, 0, 0, 0, 0, 0, 0}; if (k + 1 < n) vv[k] = *(const h8*)(src - (size_t)(k + 1) * INW); }
#pragma unroll
            for (int q = 0; q < 8; ++q) a[q] = (float)cur[q];
#pragma unroll
            for (int k = 0; k < 15; ++k) {
#pragma unroll
                for (int q = 0; q < 8; ++q) a[q] += (float)vv[k][q]; }
            const float rn = 1.f / (float)n;
            float4 o0, o1;
            o0.x = a[0] * rn - (float)cur[0]; o0.y = a[1] * rn - (float)cur[1]; o0.z = a[2] * rn - (float)cur[2]; o0.w = a[3] * rn - (float)cur[3];
            o1.x = a[4] * rn - (float)cur[4]; o1.y = a[5] * rn - (float)cur[5]; o1.z = a[6] * rn - (float)cur[6]; o1.w = a[7] * rn - (float)cur[7];
            *(float4*)(pooled + (size_t)row * 512 + chn * 8) = o0; *(float4*)(pooled + (size_t)row * 512 + chn * 8 + 4) = o1;
        }
        __syncthreads();
        QSLOT(2, 1, 5, 3);
        {
            const int r32 = lane & 31, hi = lane >> 5, g = wv >> 1, half = wv & 1;
            for (int uu = vcu; uu < 512; uu += nb) {
                const int v = uu & 255, bk = v >> 4, qi = (uu >> 8) ? 31 - (v & 15) : (v & 15), b = bk >> 1, kvh = bk & 1;
                const int t = qi * 64 + half * 32 + r32;
                const int lo_t = max(0, qi - 8);
                const unsigned tmask = (unsigned)(((1ull << (qi + 1)) - 1ull) & ~((1ull << lo_t) - 1ull));
                at8::attn_unit(smem, proj16 + (size_t)(b * S_ + t) * INW + C_Q + (kvh * 4 + g) * 128 + hi * 8,
                               kv16 + ((size_t)(4 * B_ + b) * 2 + kvh) * KVSEG, kv16 + ((size_t)(5 * B_ + b) * 2 + kvh) * KVSEG, 128, tmask, 512, t, 0xffffffffu,
                               owin + (size_t)(b * S_ + qi * 64 + half * 32) * 1024 + (kvh * 4 + g) * 128, 1024);
                QSLOT(2, 2 + (uu >> 8), 5, 3);
            }
            for (int u = vcu; u < 256; u += nb) {
                const int b = u >> 5, h = (u >> 3) & 3, qt = u & 7;
                const int t = qt * 256 + wv * 32 + r32;
                at8::attn_unit(smem, proj16 + (size_t)(b * S_ + t) * INW + C_QM + h * 128 + hi * 8,
                               kvmem16 + (size_t)b * 256 * 1024 + h * 128, kvmem16 + (size_t)b * 256 * 1024 + 512 + h * 128, 1024, 0xFu, 0, 255, 0xffffffffu,
                               omem + (size_t)(b * S_ + qt * 256 + wv * 32) * 512 + h * 128, 512);
            }
        }
        QPOST(2);
    }
    SEAM(2);
    if (IN(3)) {
        DEFPTRS;
        const int lane = LANE_NOW; (void)lane;
        QSLOT(3, 0, 3, 2);
        {
            float* bsum = (float*)smem;
            _Float16* hs = (_Float16*)(smem + 4096);
            { const int kv = tid >> 8, n = tid & 255; float a = 0.f;
#pragma unroll
              for (int kc = 0; kc < 16; ++kc) a += bias1[(kv * 16 + kc) * 256 + n];
              bsum[tid] = a; }
            __syncthreads();
            const int fr = lane & 15, fq = lane >> 4;
            for (int u = bid; u < 256; u += nb) {
                const int kv = u >> 7, rt = u & 127;
#pragma unroll
                for (int q = 0; q < 8; ++q) { const int e = tid + 512 * q, i = e >> 8, n = e & 255;
                    const int row = rt * 16 + i, c = (row >> 1) & 127;
                    float a = 0.f;
                    if (c != 127) { a = bsum[kv * 256 + n];
#pragma unroll
                        for (int sp = 0; sp < 4; ++sp) { const float* base = uv + ((size_t)(kv * 4 + sp) * 2048) * 512; a += base[(size_t)row * 512 + n] + base[(size_t)(row + 2) * 512 + 256 + n]; }
                        a = gelu_fast(a); }
                    hs[i * 264 + n] = (_Float16)a; }
                __syncthreads();
                { const _Float16* bp = wt2 + ((size_t)kv * 128 + wv * 16 + fr) * 256 + fq * 8;
                  f4 acc = (f4){0.f, 0.f, 0.f, 0.f};
#pragma unroll
                  for (int sI = 0; sI < 8; ++sI) { const h8 a = *(const h8*)(hs + fr * 264 + sI * 32 + fq * 8), bb = *(const h8*)(bp + sI * 32); acc = __builtin_amdgcn_mfma_f32_16x16x32_f16(a, bb, acc, 0, 0, 0); }
                  _Float16* dst = kv ? vc16 : kc16;
#pragma unroll
                  for (int j = 0; j < 4; ++j) { const int row = rt * 16 + fq * 4 + j; dst[(size_t)row * 128 + wv * 16 + fr] = (((row >> 1) & 127) == 127) ? (_Float16)0.f : (_Float16)acc[j]; } }
                __syncthreads();
            }
        }
        QSLOT(3, 1, 3, 2);
        for (int u = bid; u < 128 * 4; u += nb) { const int g = u >> 7, mt = u & 127;
            ARowPlain af{pooled + g * 128, 512, mt * 128, T_}; EpiPool ef{opool, p.in[I_POOLS], mt * 128, g};
            gemm_tile(smem, 128, af, p.in[I_POOLW] + (size_t)g * 128 * 128, 128, 0, 128, false, ef);
        }
        QPOST(3);
    }
    SEAM(3);
    if (IN(4)) {
        DEFPTRS;
        const int lane = LANE_NOW; (void)lane;
        QSLOT(4, 0, 3, 2);
        const int r32 = lane & 31, hi = lane >> 5, g = wv >> 1, half = wv & 1;
        for (int uu = vcu; uu < 512; uu += nb) {
            const int v = uu & 255, bk = v >> 4, qi = (uu >> 8) ? 31 - (v & 15) : (v & 15), b = bk >> 1, kvh = bk & 1;
            const int tl = half * 32 + r32, t = qi * 64 + tl;
            at8::cmp_slc_unit(smem, proj16 + (size_t)(b * S_ + t) * INW + C_Q + (kvh * 4 + g) * 128 + hi * 8,
                              kc16 + (size_t)(b * 128 * 2 + kvh) * 128, vc16 + (size_t)(b * 128 * 2 + kvh) * 128,
                              kv16 + ((size_t)(2 * B_ + b) * 2 + kvh) * KVSEG, kv16 + ((size_t)(3 * B_ + b) * 2 + kvh) * KVSEG, t, tl, g, qi,
                              ocmp + (size_t)(b * S_ + qi * 64 + half * 32) * 1024 + (kvh * 4 + g) * 128, oslc + (size_t)(b * S_ + qi * 64 + half * 32) * 1024 + (kvh * 4 + g) * 128);
            QSLOT(4, 1 + (uu >> 8), 3, 2);
        }
        QPOST(4);
    }
    SEAM(4);
    if (IN(5)) {
        DEFPTRS;
        QSLOT(5, 0, 2, 1);
        const int lane = LANE_NOW;
        float* gl = (float*)(smem + 32768);
        { const int t5 = ({ int _t = threadIdx.x; asm volatile("" : "+v"(_t)); _t; });
          const float* src = t5 < 256 ? p.in[I_GNNSA] + t5 * 4 : (t5 < 384 ? p.in[I_GNPOOL] + (t5 - 256) * 4 : p.in[I_GNMEM] + (t5 - 384) * 4);
          ((float4*)gl)[t5] = *(const float4*)src; }
        __syncthreads();
        for (int row = gw; row < T_; row += nw) {
            const _Float16* pr = proj16 + (size_t)row * INW + C_G;
            float v[32]; float ss = 0.f;
#pragma unroll
            for (int c = 0; c < 2; ++c) { const int col = (lane + 64 * c) * 8, h = col >> 7; const size_t o = (size_t)row * 1024 + col;
                const float g0 = sigmoidf_((float)pr[h * 3]), g1 = sigmoidf_((float)pr[h * 3 + 1]), g2 = sigmoidf_((float)pr[h * 3 + 2]);
                const h8 a = *(const h8*)(ocmp + o), b2 = *(const h8*)(oslc + o), c2 = *(const h8*)(owin + o);
#pragma unroll
                for (int q = 0; q < 8; ++q) { const float x = g0 * (float)a[q] + g1 * (float)b2[q] + g2 * (float)c2[q]; v[c * 8 + q] = x; ss += x * x; } }
            ss = wave_sum(ss); float r = rsqrtf(ss / 1024.f + LN_EPS);
#pragma unroll
            for (int c = 0; c < 2; ++c) { const int col = (lane + 64 * c) * 8; const float4 ga = *(const float4*)(gl + col), gb = *(const float4*)(gl + col + 4);
                v[c * 8 + 0] *= r * ga.x; v[c * 8 + 1] *= r * ga.y; v[c * 8 + 2] *= r * ga.z; v[c * 8 + 3] *= r * ga.w; v[c * 8 + 4] *= r * gb.x; v[c * 8 + 5] *= r * gb.y; v[c * 8 + 6] *= r * gb.z; v[c * 8 + 7] *= r * gb.w; }
            { const h8 a = *(const h8*)(opool + (size_t)row * 512 + lane * 8); ss = 0.f;
#pragma unroll
              for (int q = 0; q < 8; ++q) { v[16 + q] = (float)a[q]; ss += v[16 + q] * v[16 + q]; }
              ss = wave_sum(ss); r = rsqrtf(ss / 512.f + LN_EPS);
              const float4 ga = *(const float4*)(gl + 1024 + lane * 8), gb = *(const float4*)(gl + 1024 + lane * 8 + 4);
              v[16] *= r * ga.x; v[17] *= r * ga.y; v[18] *= r * ga.z; v[19] *= r * ga.w; v[20] *= r * gb.x; v[21] *= r * gb.y; v[22] *= r * gb.z; v[23] *= r * gb.w; }
            { const h8 a = *(const h8*)(omem + (size_t)row * 512 + lane * 8); ss = 0.f;
#pragma unroll
              for (int q = 0; q < 8; ++q) { v[24 + q] = (float)a[q]; ss += v[24 + q] * v[24 + q]; }
              ss = wave_sum(ss); r = rsqrtf(ss / 512.f + LN_EPS);
              const float4 ga = *(const float4*)(gl + 1536 + lane * 8), gb = *(const float4*)(gl + 1536 + lane * 8 + 4);
              v[24] *= r * ga.x; v[25] *= r * ga.y; v[26] *= r * ga.z; v[27] *= r * ga.w; v[28] *= r * gb.x; v[29] *= r * gb.y; v[30] *= r * gb.z; v[31] *= r * gb.w; }
            float amax = 0.f;
#pragma unroll
            for (int k = 0; k < 32; ++k) amax = fmaxf(amax, fabsf(v[k]));
            amax = wave_max(amax);
            const float qinv = amax > 0.f ? 127.f / amax : 0.f;
            if (lane == 0) scat[row] = amax > 0.f ? amax / 127.f : 1.f;
#pragma unroll
            for (int c = 0; c < 4; ++c) { const int col = c < 2 ? (lane + 64 * c) * 8 : (c == 2 ? 1024 + lane * 8 : 1536 + lane * 8);
                uint2 q; q.x = pack4_i8(v[c * 8 + 0] * qinv, v[c * 8 + 1] * qinv, v[c * 8 + 2] * qinv, v[c * 8 + 3] * qinv); q.y = pack4_i8(v[c * 8 + 4] * qinv, v[c * 8 + 5] * qinv, v[c * 8 + 6] * qinv, v[c * 8 + 7] * qinv);
                *(uint2*)(cat8 + (size_t)row * 2048 + col) = q; }
        }
        QPOST(5);
    }
    SEAM(5);
    if (IN(6)) {
        DEFPTRS;
        const int lane = LANE_NOW; (void)lane;
        QSLOT(6, 0, 2, 1);
        { g8::ProbOut P{cat8, q8out, hpre16, x16, scat, sout, nb, bid};
          g8::gemm_phase(lds, P); }
        QPOST(6);
    }
    SEAM(6);
    if (IN(7)) {
        DEFPTRS;
        const int lane = LANE_NOW; (void)lane;
        QSLOT(7, 0, 2, 1);
        float* lg = (float*)smem;
        float* gl = (float*)(smem + 32768);
        { const int t7s = ({ int _t = threadIdx.x; asm volatile("" : "+v"(_t)); _t; });
          ((float4*)gl)[t7s] = ((const float4*)p.in[I_LN1G])[t7s]; ((float4*)gl)[512 + t7s] = ((const float4*)p.in[I_LN1B])[t7s]; }
        __syncthreads();
        const int r32 = lane & 31, hi = lane >> 5, fr = lane & 15, fq = lane >> 4;
        for (int u = bid; u < T_ / 64; u += nb) {
            const int base = u * 64;
            h8 raw[8][4];
#pragma unroll
            for (int i = 0; i < 8; ++i)
#pragma unroll
                for (int c = 0; c < 4; ++c) raw[i][c] = *(const h8*)(hpre16 + (size_t)(base + wv * 8 + i) * 2048 + (lane + 64 * c) * 8);
#pragma unroll
            for (int i = 0; i < 8; ++i) {
                const int row = base + wv * 8 + i;
                float v[32]; float s = 0.f;
#pragma unroll
                for (int c = 0; c < 4; ++c) {
#pragma unroll
                    for (int q = 0; q < 8; ++q) { v[c * 8 + q] = (float)raw[i][c][q]; s += v[c * 8 + q]; } }
                const float mu = wave_sum(s) / 2048.f; float q2 = 0.f;
#pragma unroll
                for (int k = 0; k < 32; ++k) { const float d = v[k] - mu; q2 += d * d; }
                const float rs = rsqrtf(wave_sum(q2) / 2048.f + LN_EPS);
                float amax = 0.f;
#pragma unroll
                for (int c = 0; c < 4; ++c) { const int col = (lane + 64 * c) * 8;
                    asm volatile("" ::: "memory");
                    const float4 g0 = *(const float4*)(gl + col), g1 = *(const float4*)(gl + col + 4), b0 = *(const float4*)(gl + 2048 + col), b1 = *(const float4*)(gl + 2048 + col + 4);
                    float4 o0, o1;
                    o0.x = (v[c * 8 + 0] - mu) * rs * g0.x + b0.x; o0.y = (v[c * 8 + 1] - mu) * rs * g0.y + b0.y; o0.z = (v[c * 8 + 2] - mu) * rs * g0.z + b0.z; o0.w = (v[c * 8 + 3] - mu) * rs * g0.w + b0.w;
                    o1.x = (v[c * 8 + 4] - mu) * rs * g1.x + b1.x; o1.y = (v[c * 8 + 5] - mu) * rs * g1.y + b1.y; o1.z = (v[c * 8 + 6] - mu) * rs * g1.z + b1.z; o1.w = (v[c * 8 + 7] - mu) * rs * g1.w + b1.w;
                    h8 oh; oh[0] = (_Float16)o0.x; oh[1] = (_Float16)o0.y; oh[2] = (_Float16)o0.z; oh[3] = (_Float16)o0.w; oh[4] = (_Float16)o1.x; oh[5] = (_Float16)o1.y; oh[6] = (_Float16)o1.z; oh[7] = (_Float16)o1.w;
                    *(h8*)(h16 + (size_t)row * 2048 + col) = oh;
                    v[c * 8 + 0] = o0.x; v[c * 8 + 1] = o0.y; v[c * 8 + 2] = o0.z; v[c * 8 + 3] = o0.w; v[c * 8 + 4] = o1.x; v[c * 8 + 5] = o1.y; v[c * 8 + 6] = o1.z; v[c * 8 + 7] = o1.w;
                    amax = fmaxf(amax, fmaxf(fmaxf(fmaxf(fabsf(o0.x), fabsf(o0.y)), fmaxf(fabsf(o0.z), fabsf(o0.w))), fmaxf(fmaxf(fabsf(o1.x), fabsf(o1.y)), fmaxf(fabsf(o1.z), fabsf(o1.w))))); }
                amax = wave_max(amax);
                const float qinv = amax > 0.f ? 127.f / amax : 0.f;
                if (lane == 0) sah[row] = amax > 0.f ? amax / 127.f : 1.f;
#pragma unroll
                for (int c = 0; c < 4; ++c) { const int col = (lane + 64 * c) * 8;
                    uint2 q; q.x = pack4_i8(v[c * 8 + 0] * qinv, v[c * 8 + 1] * qinv, v[c * 8 + 2] * qinv, v[c * 8 + 3] * qinv); q.y = pack4_i8(v[c * 8 + 4] * qinv, v[c * 8 + 5] * qinv, v[c * 8 + 6] * qinv, v[c * 8 + 7] * qinv);
                    *(uint2*)(h8q + (size_t)row * 2048 + col) = q; }
            }
            asm volatile("s_waitcnt vmcnt(0)" ::: "memory");
            __syncthreads();
            {
                const int tok0 = base + 16 * (wv >> 1), e0 = 16 * (wv & 1);
                const _Float16* ap = h16 + (size_t)(tok0 + fr) * 2048 + fq * 8; const _Float16* bp = wr16 + (size_t)(e0 + fr) * 2048 + fq * 8;
                f4 acc = (f4){0.f, 0.f, 0.f, 0.f};
#pragma unroll 8
                for (int sI = 0; sI < 64; ++sI) { const h8 a = *(const h8*)(ap + sI * 32), bb = *(const h8*)(bp + sI * 32); acc = __builtin_amdgcn_mfma_f32_16x16x32_f16(a, bb, acc, 0, 0, 0); }
                const float br = p.in[I_BR][e0 + fr];
#pragma unroll
                for (int j = 0; j < 4; ++j) lg[(16 * (wv >> 1) + 4 * fq + j) * 33 + e0 + fr] = acc[j] + br;
            }
            int* lcnt = (int*)(smem + 16384); int* lbase = lcnt + 32; int* st_e = lcnt + 64; int* st_p = st_e + 256; float* st_g = (float*)(st_p + 256);
            const int t7 = ({ int _t = threadIdx.x; asm volatile("" : "+v"(_t)); _t; });
            if (t7 < 32) lcnt[t7] = 0;
            __syncthreads();
#pragma unroll 1
            for (int it = 0; it < 4; ++it) {
                const int tk = 8 * wv + 2 * it + hi;
                const float iv = lg[tk * 33 + r32];
                int rank = 0;
                for (int i = 0; i < 32; ++i) { const float vi = __shfl(iv, i + 32 * hi); rank += (vi > iv || (vi == iv && i < r32)) ? 1 : 0; }
                float tv[4]; int te[4];
#pragma unroll
                for (int r = 0; r < 4; ++r) { const unsigned long long bm = __ballot(rank == r); const unsigned hm = (unsigned)(bm >> (32 * hi)); const int src = __ffs(hm) - 1; te[r] = src; tv[r] = __shfl(iv, src + 32 * hi); }
                const float e0v = 1.f, e1v = expf(tv[1] - tv[0]), e2v = expf(tv[2] - tv[0]), e3v = expf(tv[3] - tv[0]); const float inv = 1.f / (e0v + e1v + e2v + e3v);
                if (r32 < 4) { const int e = r32 == 0 ? te[0] : r32 == 1 ? te[1] : r32 == 2 ? te[2] : te[3]; const float g = (r32 == 0 ? e0v : r32 == 1 ? e1v : r32 == 2 ? e2v : e3v) * inv;
                    st_e[tk * 4 + r32] = e; st_g[tk * 4 + r32] = g; st_p[tk * 4 + r32] = atomicAdd(&lcnt[e], 1); }
            }
            __syncthreads();
            if (t7 < 32) { const int c = lcnt[t7]; lbase[t7] = c ? atomicAdd(&cnt[t7], c) : 0; }
            __syncthreads();
            if (t7 < 256) { const int tkl = t7 >> 2, e = st_e[t7], pos = lbase[e] + st_p[t7], a = (base + tkl) * 4 + (t7 & 3); const float g = st_g[t7];
                list[(size_t)e * T_ + pos] = a; gate[a] = g; gate2[(size_t)e * T_ + pos] = g; sa2[(size_t)e * T_ + pos] = sah[base + tkl]; }
            __syncthreads();
        }
        QPOST(7);
    }
    SEAM(7);
    LAS int* mtab = (LAS int*)(smem + g8::STAGE_BYTES);
    if (IN(8)) {
        DEFPTRS;
        const int lane = LANE_NOW; (void)lane;
        if (tid == 0) { int ub = 0, rs = 0;
            for (int e = 0; e < NE; ++e) { const int c = (int)__hip_atomic_load((unsigned*)&cnt[e], __ATOMIC_RELAXED, __HIP_MEMORY_SCOPE_AGENT); mtab[e] = c; mtab[32 + e] = ub; mtab[65 + e] = rs; ub += ((c + 255) >> 8) * 16; rs += c; }
            mtab[64] = ub; mtab[97] = rs; mtab[98] = ub; }
        __syncthreads();
        g8::moe_build(mtab, nb, vcu);
        __syncthreads();
        {
            const int total = mtab[98], nmine = total > vcu ? (total - vcu + nb - 1) / nb : 0, cut = (nmine * (qgrp & 7)) >> 3;
            const int nmax = (total + nb - 1) / nb, nlight = nb * nmax - total, s_lo = max(0, (q_cnt(8) - 3 * nlight) / nb), qs8 = nmine < nmax ? s_lo + 3 : s_lo;
            { g8::ProbGu P{h8q, q8gu, actf8, p.in[I_BGU], list, sa2, sgu, g8::MoeTab{mtab, 16, 0, cut}, nb, vcu};
              g8::gemm_phase(lds, P); }
            __syncthreads();
            QDYN(8, qs8);
            { g8::ProbGu P{h8q, q8gu, actf8, p.in[I_BGU], list, sa2, sgu, g8::MoeTab{mtab, 16, cut, 40}, nb, vcu};
              g8::gemm_phase(lds, P); }
        }
        QPOST(8);
    }
    SEAM(8);
    if (IN(9)) {
        DEFPTRS;
        const int lane = LANE_NOW;
        for (int row0 = gw; row0 < NA; row0 += nw * 8) {
            uint2 raw[8][4];
#pragma unroll
            for (int i = 0; i < 8; ++i)
#pragma unroll
                for (int c = 0; c < 4; ++c) raw[i][c] = *(const uint2*)(actf8 + (size_t)(row0 + i * nw) * 2048 + (lane + 64 * c) * 8);
#pragma unroll
            for (int i = 0; i < 8; ++i) { const int row = row0 + i * nw;
                float v[32]; float amax = 0.f;
#pragma unroll
                for (int c = 0; c < 4; ++c) { const uint2 a = raw[i][c];
                    dec4_fp8(a.x, v[c * 8 + 0], v[c * 8 + 1], v[c * 8 + 2], v[c * 8 + 3]); dec4_fp8(a.y, v[c * 8 + 4], v[c * 8 + 5], v[c * 8 + 6], v[c * 8 + 7]);
#pragma unroll
                    for (int q = 0; q < 8; ++q) amax = fmaxf(amax, fabsf(v[c * 8 + q])); }
                amax = wave_max(amax);
                const float qinv = amax > 0.f ? 127.f / amax : 0.f;
                if (lane == 0) sact[row] = amax > 0.f ? amax / 127.f : 1.f;
#pragma unroll
                for (int c = 0; c < 4; ++c) { uint2 q; q.x = pack4_i8(v[c * 8 + 0] * qinv, v[c * 8 + 1] * qinv, v[c * 8 + 2] * qinv, v[c * 8 + 3] * qinv); q.y = pack4_i8(v[c * 8 + 4] * qinv, v[c * 8 + 5] * qinv, v[c * 8 + 6] * qinv, v[c * 8 + 7] * qinv);
                    *(uint2*)(act8 + (size_t)row * 2048 + (lane + 64 * c) * 8) = q; }
            }
        }
    }
    SEAM(9);
    if (IN(10)) {
        DEFPTRS;
        const int lane = LANE_NOW; (void)lane;
        if (tid == 0) { int ub = 0, rs = 0;
            for (int e = 0; e < NE; ++e) { const int c = (int)__hip_atomic_load((unsigned*)&cnt[e], __ATOMIC_RELAXED, __HIP_MEMORY_SCOPE_AGENT); mtab[e] = c; mtab[32 + e] = ub; mtab[65 + e] = rs; ub += ((c + 255) >> 8) * 8; rs += c; }
            mtab[64] = ub; mtab[97] = rs; mtab[98] = ub; }
        __syncthreads();
        g8::moe_build(mtab, nb, vcu);
        __syncthreads();
        g8::ProbDn P{act8, q8dn, yf8, p.in[I_BDN], list, gate2, sact, sdn, g8::MoeTab{mtab, 8, 0, 40}, nb, vcu};
        g8::gemm_phase(lds, P);
        __syncthreads();
    }
    SEAM(10);
    if (IN(11)) {
        DEFPTRS;
        const int lane = LANE_NOW; (void)lane;
        float* gl = (float*)smem;
        { const int t11 = ({ int _t = threadIdx.x; asm volatile("" : "+v"(_t)); _t; });
          ((float4*)gl)[t11] = ((const float4*)p.in[I_LN2G])[t11]; ((float4*)gl)[512 + t11] = ((const float4*)p.in[I_LN2B])[t11]; }
        __syncthreads();
        for (int row0 = gw; row0 < T_; row0 += nw * 2) {
          h8 hraw[2][4]; uint2 yraw[2][4][4];
#pragma unroll
          for (int i = 0; i < 2; ++i)
#pragma unroll
            for (int c = 0; c < 4; ++c) { const int col = (lane + 64 * c) * 8; const size_t yo = (size_t)(row0 + i * nw) * 4 * 2048 + col;
                hraw[i][c] = *(const h8*)(h16 + (size_t)(row0 + i * nw) * 2048 + col);
                yraw[i][c][0] = *(const uint2*)(yf8 + yo); yraw[i][c][1] = *(const uint2*)(yf8 + yo + 2048); yraw[i][c][2] = *(const uint2*)(yf8 + yo + 4096); yraw[i][c][3] = *(const uint2*)(yf8 + yo + 6144); }
#pragma unroll
          for (int i = 0; i < 2; ++i) { const int row = row0 + i * nw;
            float v[32]; float s = 0.f;
#pragma unroll
            for (int c = 0; c < 4; ++c) {
                const h8 hh8 = hraw[i][c];
                const uint2 y0 = yraw[i][c][0], y1 = yraw[i][c][1], y2 = yraw[i][c][2], y3 = yraw[i][c][3];
                float ys[8], t0[8], t1[8], t2[8], t3[8];
                dec4_fp8(y0.x, t0[0], t0[1], t0[2], t0[3]); dec4_fp8(y0.y, t0[4], t0[5], t0[6], t0[7]); dec4_fp8(y1.x, t1[0], t1[1], t1[2], t1[3]); dec4_fp8(y1.y, t1[4], t1[5], t1[6], t1[7]);
                dec4_fp8(y2.x, t2[0], t2[1], t2[2], t2[3]); dec4_fp8(y2.y, t2[4], t2[5], t2[6], t2[7]); dec4_fp8(y3.x, t3[0], t3[1], t3[2], t3[3]); dec4_fp8(y3.y, t3[4], t3[5], t3[6], t3[7]);
#pragma unroll
                for (int q = 0; q < 8; ++q) ys[q] = (t0[q] + t1[q]) + (t2[q] + t3[q]);
#pragma unroll
                for (int q = 0; q < 8; ++q) { v[c * 8 + q] = DN_ALPHA * (float)hh8[q] + ys[q] * 0.0625f; s += v[c * 8 + q]; } }
            const float mu = wave_sum(s) / 2048.f; float q2 = 0.f;
#pragma unroll
            for (int i = 0; i < 32; ++i) { const float d = v[i] - mu; q2 += d * d; }
            const float rs = rsqrtf(wave_sum(q2) / 2048.f + LN_EPS);
#pragma unroll
            for (int c = 0; c < 4; ++c) { const int col = (lane + 64 * c) * 8;
                asm volatile("" ::: "memory");
                const float4 ga = *(const float4*)(gl + col), gb = *(const float4*)(gl + col + 4), ba = *(const float4*)(gl + 2048 + col), bb = *(const float4*)(gl + 2048 + col + 4);
                float4 o0, o1;
                o0.x = (v[c * 8 + 0] - mu) * rs * ga.x + ba.x; o0.y = (v[c * 8 + 1] - mu) * rs * ga.y + ba.y; o0.z = (v[c * 8 + 2] - mu) * rs * ga.z + ba.z; o0.w = (v[c * 8 + 3] - mu) * rs * ga.w + ba.w;
                o1.x = (v[c * 8 + 4] - mu) * rs * gb.x + bb.x; o1.y = (v[c * 8 + 5] - mu) * rs * gb.y + bb.y; o1.z = (v[c * 8 + 6] - mu) * rs * gb.z + bb.z; o1.w = (v[c * 8 + 7] - mu) * rs * gb.w + bb.w;
                *(float4*)(p.out + (size_t)row * 2048 + col) = o0; *(float4*)(p.out + (size_t)row * 2048 + col + 4) = o1; }
          }
        }
    }
}

constexpr int NPHASE = 12;

extern "C" void kernel_launch(void* const* d_in, const int* in_sizes, int n_in, void* d_out, int out_size, void* d_ws, size_t ws_size, hipStream_t stream) {
    static int grid = 0;
    if (grid == 0) {
        if (n_in != 26 || ws_size < WS_END) { fprintf(stderr, "kernel_launch: unexpected n_in %d or ws_size %zu (< %zu)\n", n_in, ws_size, (size_t)WS_END); grid = -1; return; }
        int dev = 0, cus = 0, per_cu = 0;
        hipGetDevice(&dev); hipDeviceGetAttribute(&cus, hipDeviceAttributeMultiprocessorCount, dev);
        if (hipFuncSetAttribute((const void*)fwd, hipFuncAttributeMaxDynamicSharedMemorySize, LDS_BYTES) != hipSuccess) { fprintf(stderr, "hipFuncSetAttribute failed\n"); grid = -1; return; }
        hipOccupancyMaxActiveBlocksPerMultiprocessor(&per_cu, (const void*)fwd, 512, LDS_BYTES);
        (void)hipGetLastError();
        if (per_cu < 1) fprintf(stderr, "occupancy query says %d blocks per CU\n", per_cu);
        grid = cus > 0 ? cus : 256;
    }
    if (grid < 0) return;
    hipMemsetAsync((char*)d_ws + WS_CTL, 0, CTL_BYTES, stream);
    Params p{};
    for (int i = 0; i < 26; ++i) p.in[i] = (const float*)d_in[i];
    p.out = (float*)d_out; p.ws = (unsigned char*)d_ws;
#if N_LAUNCH_MODE == 1
    p.lo_hi = (long long)0 | ((long long)NPHASE << 32);
    hipLaunchKernelGGL(fwd, dim3(grid), dim3(512), LDS_BYTES, stream, p);
#else
    for (int ph = 0; ph < NPHASE; ++ph) {
        p.lo_hi = (long long)ph | ((long long)(ph + 1) << 32);
        hipLaunchKernelGGL(fwd, dim3(grid), dim3(512), LDS_BYTES, stream, p);
    }
#endif
}
```
